# Optimizing an MI355X kernel written in HIP

```python
import jax, jax.numpy as jnp
from jax import lax
import numpy as np

D_MODEL = 1024
BATCH = 4
SEQ = 4096
DEPTH = 4

GRID_W = 64
CTX_LEN = 256
N_MIXERS = 2
N_A_LAYERS = (DEPTH + N_MIXERS - 1) // N_MIXERS
N_B_LAYERS = DEPTH // N_MIXERS

MLA_HEADS = 8
MLA_NOPE = 128
MLA_ROPE = 64
MLA_V = 128
MLA_Q_LORA = 256
MLA_KV_LORA = 128
MLA_SCALE = (MLA_NOPE + MLA_ROPE) ** -0.5
ROPE_THETA = 10000.0
Q_BLOCK = 128

RW_HEAD = 64
RW_HEADS = D_MODEL // RW_HEAD
RW_DECAY_LORA = 64
RW_AAA_LORA = 64
RW_MV_LORA = 32
RW_GATE_LORA = 128
RW_LNX_EPS = 64e-5

N_EXPERTS = 16
CAPACITY_FACTOR = 2
EXPERT_FF = 1408

RMS_EPS = 1e-6
F32 = jnp.float32

kernel_name = 'hybrid_mla_rwkv7_ecmoe_diffusion_block'


def rmsnorm(x, g):
    x32 = x.astype(F32)
    y = x32 * lax.rsqrt(jnp.mean(x32 * x32, axis=-1, keepdims=True) + RMS_EPS)
    return (y * g.astype(F32)).astype(x.dtype)


def axial_rope_tables(rows):
    r = jnp.broadcast_to(jnp.arange(rows)[:, None], (rows, GRID_W)).reshape(-1).astype(F32)
    col = jnp.broadcast_to(jnp.arange(GRID_W)[None, :], (rows, GRID_W)).reshape(-1).astype(F32)
    n_freq = MLA_ROPE // 4
    inv = ROPE_THETA ** (-jnp.arange(n_freq, dtype=F32) / n_freq)
    ang = jnp.concatenate([r[:, None] * inv, col[:, None] * inv], axis=-1)
    return jnp.cos(ang), jnp.sin(ang)


def apply_rope(x, cos, sin):
    half = x.shape[-1] // 2
    x1, x2 = x[..., :half], x[..., half:]
    return jnp.concatenate([x1 * cos - x2 * sin, x1 * sin + x2 * cos], axis=-1).astype(x.dtype)


def mla_project(h, w_in, g_q, g_kv, w_uq, w_ukv, rope):
    B, T, _ = h.shape
    z = h @ w_in
    cq, ckv, k_rope = jnp.split(z, [MLA_Q_LORA, MLA_Q_LORA + MLA_KV_LORA], axis=-1)
    q = (rmsnorm(cq, g_q) @ w_uq).reshape(B, T, MLA_HEADS, MLA_NOPE + MLA_ROPE)
    kv = (rmsnorm(ckv, g_kv) @ w_ukv).reshape(B, T, MLA_HEADS, MLA_NOPE + MLA_V)
    q_nope, q_rope = q[..., :MLA_NOPE], q[..., MLA_NOPE:]
    k_nope, v = kv[..., :MLA_NOPE], kv[..., MLA_NOPE:]
    if rope is not None:
        cos, sin = rope
        q_rope = apply_rope(q_rope, cos[:, None, :], sin[:, None, :])
        k_rope = apply_rope(k_rope, cos, sin)
    return q_nope, q_rope, k_nope, k_rope, v


def mla_attend(q_nope, q_rope, k_nope, k_rope, v):
    s = (jnp.einsum('bqhn,bkhn->bhqk', q_nope, k_nope)
         + jnp.einsum('bqhr,bkr->bhqk', q_rope, k_rope))
    p = jax.nn.softmax(s.astype(F32) * MLA_SCALE, axis=-1).astype(v.dtype)
    return jnp.einsum('bhqk,bkhv->bqhv', p, v)


def blocked_attend(q_nope, q_rope, k_nope, k_rope, v):
    B, T, H, _ = q_nope.shape
    nb = T // Q_BLOCK

    def to_blocks(a):
        return jnp.moveaxis(a.reshape(B, nb, Q_BLOCK, *a.shape[2:]), 1, 0)

    out = lax.map(lambda qs: mla_attend(qs[0], qs[1], k_nope, k_rope, v),
                  (to_blocks(q_nope), to_blocks(q_rope)))
    return jnp.moveaxis(out, 0, 1).reshape(B, T, H * MLA_V)


def mla_mixer(h_lat, h_ctx, w_in, g_q, g_kv, w_uq, w_ukv, w_o, rope, need_ctx):
    qn_c, qr_c, kn_c, kr_c, v_c = mla_project(h_ctx, w_in, g_q, g_kv, w_uq, w_ukv, None)
    qn_l, qr_l, kn_l, kr_l, v_l = mla_project(h_lat, w_in, g_q, g_kv, w_uq, w_ukv, rope)
    kn = jnp.concatenate([kn_c, kn_l], axis=1)
    kr = jnp.concatenate([kr_c, kr_l], axis=1)
    vv = jnp.concatenate([v_c, v_l], axis=1)
    y_lat = blocked_attend(qn_l, qr_l, kn, kr, vv) @ w_o
    y_ctx = None
    if need_ctx:
        B, L = h_ctx.shape[:2]
        y_ctx = mla_attend(qn_c, qr_c, kn_c, kr_c, v_c).reshape(B, L, MLA_HEADS * MLA_V) @ w_o
    return y_lat, y_ctx


def token_shift_centred(x):
    prev = jnp.pad(x[:, :-1], ((0, 0), (1, 0), (0, 0)))
    nxt = jnp.pad(x[:, 1:], ((0, 0), (0, 1), (0, 0)))
    return 0.5 * (prev + nxt) - x


def to_heads(t):
    return t.reshape(*t.shape[:-1], RW_HEADS, RW_HEAD)


def rwkv_stream(h, mu, w_rkv, w0, w1, w2, a0, a1, a2, g1, g2, k_k, k_a, vres):
    B, T, D = h.shape
    xx = token_shift_centred(h)
    xs = h[None] + xx[None] * mu[:, None, None, :]
    r, k, v = jnp.einsum('mbtd,mde->mbte', xs[:3], w_rkv)
    xw, xa, xg = xs[3], xs[4], xs[5]
    if vres is not None:
        v_first, v0, v1, v2 = vres
        v = v + (v_first - v) * jax.nn.sigmoid(v0 + (xs[2] @ v1) @ v2)
    wz = w0[:, None, None, :] + jnp.einsum('zbtl,zld->zbtd', jnp.tanh(jnp.einsum('btd,zdl->zbtl', xw, w1)), w2)
    decay = jnp.exp(-jnp.exp(-jax.nn.softplus(-wz.astype(F32)) - 0.5))
    az = a0[:, None, None, :] + jnp.einsum('zbtl,zld->zbtd', jnp.einsum('btd,zdl->zbtl', xa, a1), a2)
    a = jax.nn.sigmoid(az.astype(F32))
    g = jax.nn.sigmoid(xg @ g1) @ g2
    kk = to_heads((k * k_k).astype(F32))
    kk = kk / jnp.maximum(jnp.sqrt(jnp.sum(kk * kk, axis=-1, keepdims=True)), 1e-12)
    k_dir = k.astype(F32)[None] * (1.0 + (a - 1.0) * k_a.astype(F32))
    return r, v, g, to_heads(decay), to_heads(a), to_heads(k_dir), kk


def wkv_scan(state0, r, w, k, v, kk, a, reverse):
    seq = tuple(jnp.moveaxis(t.astype(F32), 1, 0) for t in (r, w, k, v, kk, kk * a))

    def step(S, inp):
        r_t, w_t, k_t, v_t, kk_t, b_t = inp
        sa = jnp.einsum('bhvk,bhk->bhv', S, -kk_t)
        S = S * w_t[:, :, None, :] + sa[..., None] * b_t[:, :, None, :] + v_t[..., None] * k_t[:, :, None, :]
        return S, jnp.einsum('bhvk,bhk->bhv', S, r_t)

    s_final, ys = lax.scan(step, state0, seq, reverse=reverse)
    return s_final, jnp.moveaxis(ys, 0, 1)


def rwkv_output(y, r, k_dir, v, g, r_k, lnx_g, lnx_b, w_o):
    B, T, H, N = y.shape
    mean = jnp.mean(y, axis=-1, keepdims=True)
    var = jnp.mean(jnp.square(y - mean), axis=-1, keepdims=True)
    yn = ((y - mean) * lax.rsqrt(var + RW_LNX_EPS)).reshape(B, T, H * N) * lnx_g + lnx_b
    bonus = jnp.sum(to_heads(r).astype(F32) * (k_dir[0] + k_dir[1]) * r_k, axis=-1, keepdims=True) * to_heads(v).astype(F32)
    out = ((yn + bonus.reshape(B, T, H * N)) * g).astype(g.dtype)
    return out @ w_o


def rwkv_mixer(h_lat, h_ctx, mu, w_rkv, w0, w1, w2, a0, a1, a2, g1, g2, k_k, k_a, r_k,
               lnx_g, lnx_b, w_o, vres, v_first, need_ctx):
    shared = (mu, w_rkv, w0, w1, w2, a0, a1, a2, g1, g2, k_k, k_a)
    vres_c = None if vres is None else (v_first[0],) + vres
    vres_l = None if vres is None else (v_first[1],) + vres
    rc, vc, gc, dc, ac, kc, kkc = rwkv_stream(h_ctx, *shared, vres_c)
    rl, vl, gl, dl, al, kl, kkl = rwkv_stream(h_lat, *shared, vres_l)
    s0 = jnp.zeros((h_lat.shape[0], RW_HEADS, RW_HEAD, RW_HEAD), F32)
    y_ctx = 0.0
    y_lat = 0.0
    for z in range(2):
        rev = z == 1
        s_ctx, yc = wkv_scan(s0, to_heads(rc), dc[z], kc[z], to_heads(vc), kkc, ac[z], rev)
        _, yl = wkv_scan(s_ctx, to_heads(rl), dl[z], kl[z], to_heads(vl), kkl, al[z], rev)
        y_ctx = y_ctx + yc
        y_lat = y_lat + yl
    out_lat = rwkv_output(y_lat, rl, kl, vl, gl, r_k, lnx_g, lnx_b, w_o)
    out_ctx = rwkv_output(y_ctx, rc, kc, vc, gc, r_k, lnx_g, lnx_b, w_o) if need_ctx else None
    return out_lat, out_ctx, (vc, vl)


def expert_choice_moe(h, router, w1, w3, w2):
    B, T, D = h.shape
    cap = CAPACITY_FACTOR * T // N_EXPERTS
    aff = jax.nn.softmax((h @ router).astype(F32), axis=-1)
    gate, idx = lax.top_k(jnp.swapaxes(aff, 1, 2), cap)
    bidx = jnp.arange(B)[:, None, None]
    xe = h[bidx, idx]
    hid = jax.nn.silu(jnp.einsum('becd,edf->becf', xe, w1)) * jnp.einsum('becd,edf->becf', xe, w3)
    ye = jnp.einsum('becf,efd->becd', hid, w2) * gate[..., None].astype(h.dtype)
    return jnp.zeros_like(h).at[bidx, idx].add(ye)


def setup_inputs(seed: int = 0) -> dict:
    key = jax.random.key(seed)
    ks = iter(jax.random.split(key, 48))
    D = D_MODEL

    def nrm(shape, scale):
        return jax.random.normal(next(ks), shape, F32) * scale

    def uni(shape, lo, hi):
        return jax.random.uniform(next(ks), shape, F32, lo, hi)

    nv = max(N_B_LAYERS - 1, 0)
    return {
        'x': nrm((BATCH, SEQ, D), 1.0),
        'c': nrm((BATCH, D), 1.0),
        'ctx': nrm((BATCH, CTX_LEN, D), 1.0),
        'c_ctx': nrm((D,), 1.0),
        'mod_w': nrm((DEPTH, D, 6 * D), D ** -0.5),
        'mod_b': nrm((DEPTH, 6 * D), 0.02),
        'norm1_g': 1.0 + nrm((DEPTH, D), 0.02),
        'norm2_g': 1.0 + nrm((DEPTH, D), 0.02),
        'final_g': 1.0 + nrm((D,), 0.02),
        'mla_w_in': nrm((N_A_LAYERS, D, MLA_Q_LORA + MLA_KV_LORA + MLA_ROPE), D ** -0.5),
        'mla_g_q': 1.0 + nrm((N_A_LAYERS, MLA_Q_LORA), 0.02),
        'mla_g_kv': 1.0 + nrm((N_A_LAYERS, MLA_KV_LORA), 0.02),
        'mla_w_uq': nrm((N_A_LAYERS, MLA_Q_LORA, MLA_HEADS * (MLA_NOPE + MLA_ROPE)), MLA_Q_LORA ** -0.5),
        'mla_w_ukv': nrm((N_A_LAYERS, MLA_KV_LORA, MLA_HEADS * (MLA_NOPE + MLA_V)), MLA_KV_LORA ** -0.5),
        'mla_w_o': nrm((N_A_LAYERS, MLA_HEADS * MLA_V, D), (MLA_HEADS * MLA_V) ** -0.5),
        'rw_mu': uni((N_B_LAYERS, 6, D), 0.0, 1.0),
        'rw_w_rkv': nrm((N_B_LAYERS, 3, D, D), D ** -0.5),
        'rw_w0': uni((N_B_LAYERS, 2, D), -5.0, -0.5),
        'rw_w1': nrm((N_B_LAYERS, 2, D, RW_DECAY_LORA), 0.1 * D ** -0.5),
        'rw_w2': nrm((N_B_LAYERS, 2, RW_DECAY_LORA, D), 0.5 * RW_DECAY_LORA ** -0.5),
        'rw_a0': nrm((N_B_LAYERS, 2, D), 0.1),
        'rw_a1': nrm((N_B_LAYERS, 2, D, RW_AAA_LORA), 0.1 * D ** -0.5),
        'rw_a2': nrm((N_B_LAYERS, 2, RW_AAA_LORA, D), 0.5 * RW_AAA_LORA ** -0.5),
        'rw_v0': 1.0 + nrm((nv, D), 0.1),
        'rw_v1': nrm((nv, D, RW_MV_LORA), 0.1 * D ** -0.5),
        'rw_v2': nrm((nv, RW_MV_LORA, D), 0.5 * RW_MV_LORA ** -0.5),
        'rw_g1': nrm((N_B_LAYERS, D, RW_GATE_LORA), D ** -0.5),
        'rw_g2': nrm((N_B_LAYERS, RW_GATE_LORA, D), RW_GATE_LORA ** -0.5),
        'rw_k_k': 0.85 + nrm((N_B_LAYERS, D), 0.02),
        'rw_k_a': 1.0 + nrm((N_B_LAYERS, D), 0.02),
        'rw_r_k': nrm((N_B_LAYERS, RW_HEADS, RW_HEAD), 0.1),
        'rw_lnx_g': 1.0 + nrm((N_B_LAYERS, D), 0.02),
        'rw_lnx_b': nrm((N_B_LAYERS, D), 0.02),
        'rw_w_o': nrm((N_B_LAYERS, D, D), D ** -0.5),
        'moe_router': nrm((DEPTH, D, N_EXPERTS), D ** -0.5),
        'moe_w1': nrm((DEPTH, N_EXPERTS, D, EXPERT_FF), D ** -0.5),
        'moe_w3': nrm((DEPTH, N_EXPERTS, D, EXPERT_FF), D ** -0.5),
        'moe_w2': nrm((DEPTH, N_EXPERTS, EXPERT_FF, D), EXPERT_FF ** -0.5),
    }


def reference(x, c, ctx, c_ctx, mod_w, mod_b, norm1_g, norm2_g, final_g,
              mla_w_in, mla_g_q, mla_g_kv, mla_w_uq, mla_w_ukv, mla_w_o,
              rw_mu, rw_w_rkv, rw_w0, rw_w1, rw_w2, rw_a0, rw_a1, rw_a2,
              rw_v0, rw_v1, rw_v2, rw_g1, rw_g2, rw_k_k, rw_k_a, rw_r_k,
              rw_lnx_g, rw_lnx_b, rw_w_o,
              moe_router, moe_w1, moe_w3, moe_w2):
    rows = x.shape[1] // GRID_W
    rope = axial_rope_tables(rows)
    sc_lat = jax.nn.silu(c)
    sc_ctx = jax.nn.silu(c_ctx)
    x_lat, x_ctx = x, ctx
    v_first = None
    for layer in range(DEPTH):
        need_ctx = layer < DEPTH - 1
        m_l = (sc_lat @ mod_w[layer] + mod_b[layer])[:, None, :]
        m_c = (sc_ctx @ mod_w[layer] + mod_b[layer])[None, None, :]
        sh1_l, sc1_l, gt1_l, sh2_l, sc2_l, gt2_l = jnp.split(m_l, 6, axis=-1)
        sh1_c, sc1_c, gt1_c, sh2_c, sc2_c, gt2_c = jnp.split(m_c, 6, axis=-1)
        h_lat = rmsnorm(x_lat, norm1_g[layer]) * (1.0 + sc1_l) + sh1_l
        h_ctx = rmsnorm(x_ctx, norm1_g[layer]) * (1.0 + sc1_c) + sh1_c
        j = layer // N_MIXERS
        if layer % N_MIXERS == 0:
            y_lat, y_ctx = mla_mixer(h_lat, h_ctx, mla_w_in[j], mla_g_q[j], mla_g_kv[j],
                                     mla_w_uq[j], mla_w_ukv[j], mla_w_o[j], rope, need_ctx)
        else:
            vres = None if j == 0 else (rw_v0[j - 1], rw_v1[j - 1], rw_v2[j - 1])
            y_lat, y_ctx, v_pair = rwkv_mixer(h_lat, h_ctx, rw_mu[j], rw_w_rkv[j], rw_w0[j], rw_w1[j], rw_w2[j],
                                              rw_a0[j], rw_a1[j], rw_a2[j], rw_g1[j], rw_g2[j], rw_k_k[j],
                                              rw_k_a[j], rw_r_k[j], rw_lnx_g[j], rw_lnx_b[j], rw_w_o[j],
                                              vres, v_first, need_ctx)
            if j == 0:
                v_first = v_pair
        x_lat = x_lat + gt1_l * y_lat
        b_lat = rmsnorm(x_lat, norm2_g[layer]) * (1.0 + sc2_l) + sh2_l
        x_lat = x_lat + gt2_l * expert_choice_moe(b_lat, moe_router[layer], moe_w1[layer], moe_w3[layer], moe_w2[layer])
        if need_ctx:
            x_ctx = x_ctx + gt1_c * y_ctx
            b_ctx = rmsnorm(x_ctx, norm2_g[layer]) * (1.0 + sc2_c) + sh2_c
            x_ctx = x_ctx + gt2_c * expert_choice_moe(b_ctx, moe_router[layer], moe_w1[layer], moe_w3[layer], moe_w2[layer])
    return rmsnorm(x_lat, final_g)
```

```cpp
#include <hip/hip_runtime.h>
#include <stdint.h>
#include <stdio.h>

#ifndef ONE_LAUNCH
#define ONE_LAUNCH 1
#endif

#define NTHR 512
typedef unsigned short bf16_t;
typedef short bf16x8 __attribute__((ext_vector_type(8)));
typedef float f32x4 __attribute__((ext_vector_type(4)));
typedef unsigned u32x4 __attribute__((ext_vector_type(4)));

constexpr int D = 1024, NB = 4, TL = 4096, TC = 256, NLAT = NB * TL, NCTX = NB * TC, NROW = NLAT + NCTX;
constexpr int TK = TL + TC;
constexpr int NE = 16, FF = 1408, CAPL = 512, CAPC = 32, ESLOTS = NB * CAPL + NB * CAPC;
constexpr float RMS_EPS = 1e-6f, LNX_EPS = 64e-5f;
constexpr float ATT_SCALE = 0.07216878364870322f;

constexpr size_t al256(size_t x) { return (x + 255) / 256 * 256; }
constexpr size_t OFF_BAR = 0;
constexpr size_t OFF_MOD = 16384;
constexpr size_t OFF_ROPE_C = OFF_MOD + al256(4 * 5 * 6144 * 4);
constexpr size_t OFF_ROPE_S = OFF_ROPE_C + al256(TL * 32 * 4);
constexpr size_t OFF_X = OFF_ROPE_S + al256(TL * 32 * 4);
constexpr size_t SZ_F32 = (size_t)NROW * D * 4, SZ_BF = (size_t)NROW * D * 2;
constexpr size_t OFF_VFIRST = OFF_X + SZ_F32;
constexpr size_t OFF_H = OFF_VFIRST + SZ_F32;
constexpr size_t OFF_S = OFF_H + SZ_BF;
constexpr size_t OFF_Z = OFF_S;
constexpr size_t OFF_CQN = OFF_Z + al256((size_t)NROW * 448 * 4);
constexpr size_t OFF_CKVN = OFF_CQN + al256((size_t)NROW * 256 * 2);
constexpr size_t OFF_KR = OFF_CKVN + al256((size_t)NROW * 128 * 2);
constexpr size_t OFF_QRAW = OFF_KR + al256((size_t)NROW * 64 * 4);
constexpr size_t OFF_KVRAW = OFF_QRAW + al256((size_t)NROW * 1536 * 4);
constexpr size_t OFF_Q = OFF_KVRAW + al256((size_t)NROW * 2048 * 4);
constexpr size_t OFF_K = OFF_Q + al256((size_t)NB * 8 * TK * 192 * 2);
constexpr size_t OFF_V = OFF_K + al256((size_t)NB * 8 * TK * 192 * 2);
constexpr size_t OFF_O = OFF_V + al256((size_t)NB * 8 * TK * 128 * 2);
constexpr size_t END_MLA = OFF_O + SZ_BF;
constexpr size_t OFF_HF = OFF_S;
constexpr size_t OFF_XS = OFF_HF + SZ_F32;
constexpr size_t OFF_RKV = OFF_XS + 6 * SZ_BF;
constexpr size_t OFF_W = OFF_RKV + 3 * SZ_F32;
constexpr size_t OFF_AV = OFF_W + 2 * SZ_F32;
constexpr size_t OFF_KD = OFF_AV + 2 * SZ_F32;
constexpr size_t OFF_G = OFF_KD + 2 * SZ_F32;
constexpr size_t OFF_LW = OFF_G + SZ_F32;
constexpr size_t OFF_LA = OFF_LW + al256((size_t)NROW * 128 * 2);
constexpr size_t OFF_LG = OFF_LA + al256((size_t)NROW * 128 * 2);
constexpr size_t OFF_LV = OFF_LG + al256((size_t)NROW * 128 * 2);
constexpr size_t END_RW = OFF_LV + al256((size_t)NROW * 32 * 2);
constexpr size_t OFF_Y = OFF_HF;
constexpr size_t OFF_AFF = OFF_S;
constexpr size_t OFF_ROWIDX = OFF_AFF + al256((size_t)NROW * 16 * 4);
constexpr size_t OFF_GATE = OFF_ROWIDX + al256((size_t)NE * ESLOTS * 4);
constexpr size_t OFF_SLOT = OFF_GATE + al256((size_t)NE * ESLOTS * 4);
constexpr size_t OFF_XE = OFF_SLOT + al256((size_t)NROW * 16 * 4);
constexpr size_t OFF_G1 = OFF_XE + al256((size_t)NE * ESLOTS * D * 2);
constexpr size_t OFF_HID = OFF_G1 + al256((size_t)NE * ESLOTS * FF * 4);
constexpr size_t OFF_YE = OFF_HID + al256((size_t)NE * ESLOTS * FF * 2);
constexpr size_t END_MOE = OFF_YE + al256((size_t)NE * ESLOTS * D * 2);
constexpr size_t WS_NEED = END_RW > END_MLA ? (END_RW > END_MOE ? END_RW : END_MOE) : (END_MLA > END_MOE ? END_MLA : END_MOE);

constexpr int LDS_BYTES = 81920;

struct Params {
    const float *x, *c, *ctx, *c_ctx, *mod_w, *mod_b, *norm1_g, *norm2_g, *final_g;
    const float *mla_w_in, *mla_g_q, *mla_g_kv, *mla_w_uq, *mla_w_ukv, *mla_w_o;
    const float *rw_mu, *rw_w_rkv, *rw_w0, *rw_w1, *rw_w2, *rw_a0, *rw_a1, *rw_a2, *rw_v0, *rw_v1, *rw_v2, *rw_g1, *rw_g2, *rw_k_k, *rw_k_a, *rw_r_k, *rw_lnx_g, *rw_lnx_b, *rw_w_o;
    const float *moe_router, *moe_w1, *moe_w3, *moe_w2;
    float* out; char* ws;
};

__device__ __forceinline__ int tidx() { int t = threadIdx.x; asm volatile("" : "+v"(t)); return t; }
#define XB_TMO      128
#define XB_XCNT(j)  (256  + 64 * (j))
#define XB_XSUB(j)  (1280 + 64 * (j))
#define XB_XGEN(j)  (2304 + 64 * (j))
#define XB_TOP      3328
#define XB_TOPGEN   3392
#define XCD_BAR_WORDS 3456
#define XB_SPIN_CAP (1u << 22)
#define LAS __attribute__((address_space(3)))

__device__ __forceinline__ unsigned xb_ld(unsigned* p)              { return __hip_atomic_load(p, __ATOMIC_RELAXED, __HIP_MEMORY_SCOPE_AGENT); }
__device__ __forceinline__ unsigned xb_add(unsigned* p, unsigned v) { return __hip_atomic_fetch_add(p, v, __ATOMIC_RELAXED, __HIP_MEMORY_SCOPE_AGENT); }
__device__ __forceinline__ unsigned xb_xcc_id() { return (unsigned)__builtin_amdgcn_s_getreg((3 << 11) | 20) & 0xFu; }
#define XB_SPIN(cond, bar) do { unsigned _sp = 0; while (cond) { __builtin_amdgcn_s_sleep(1); \
    if ((++_sp & 255u) == 0u) { if (xb_ld(&(bar)[XB_TMO])) break; if (_sp > XB_SPIN_CAP) { atomicAdd(&(bar)[XB_TMO], 1u); break; } } } } while (0)

struct XcdBarrier { unsigned* bar; unsigned x; volatile LAS unsigned* st; };

__device__ __forceinline__ XcdBarrier xcd_barrier_post(unsigned* bar, volatile LAS unsigned* st) {
    XcdBarrier b; b.bar = bar; b.x = xb_xcc_id(); b.st = st;
    if (tidx() == 0) (void)xb_add(&bar[XB_XCNT(b.x)], 1u);
    return b;
}
__device__ __forceinline__ void xcd_barrier_complete(unsigned* bar, unsigned x, unsigned& nloc, unsigned& nx) {
    const unsigned G = gridDim.x * gridDim.y * gridDim.z;
    unsigned sum, cnt, mine, sp = 0u;
    for (;;) {
        sum = 0u; cnt = 0u; mine = 0u;
#pragma unroll
        for (unsigned j = 0; j < 16; ++j) { const unsigned c = xb_ld(&bar[XB_XCNT(j)]); sum += c; cnt += (c > 0u) ? 1u : 0u; mine = (j == x) ? c : mine; }
        if (sum == G) break;
        __builtin_amdgcn_s_sleep(1);
        if ((++sp & 255u) == 0u) { if (xb_ld(&bar[XB_TMO])) break; if (sp > XB_SPIN_CAP) { atomicAdd(&bar[XB_TMO], 1u); break; } }
    }
    nloc = mine > 0u ? mine : 1u; nx = cnt > 0u ? cnt : 1u;
}
__device__ __forceinline__ void xcd_barrier(const XcdBarrier& b) {
    asm volatile("s_waitcnt vmcnt(0)" ::: "memory");
    __syncthreads();
    if (tidx() == 0) {
        unsigned* bar = b.bar;
        __builtin_amdgcn_s_waitcnt(0);
        unsigned nloc = b.st[0], nx = b.st[1];
        if (nloc == 0u) { xcd_barrier_complete(bar, b.x, nloc, nx); b.st[0] = nloc; b.st[1] = nx; }
        const unsigned old = xb_add(&bar[XB_XSUB(b.x)], 1u);
        const unsigned gen = old / nloc;
        if (old + 1u == (gen + 1u) * nloc) {
            __builtin_amdgcn_fence(__ATOMIC_RELEASE, "agent");
            asm volatile("s_waitcnt vmcnt(0)" ::: "memory");
            const unsigned og = xb_add(&bar[XB_TOP], 1u);
            const unsigned tg = og / nx;
            if (og + 1u == (tg + 1u) * nx) xb_add(&bar[XB_TOPGEN], 1u);
            else XB_SPIN(xb_ld(&bar[XB_TOPGEN]) == tg, bar);
            __builtin_amdgcn_fence(__ATOMIC_ACQUIRE, "agent");
            xb_add(&bar[XB_XGEN(b.x)], 1u);
            asm volatile("s_waitcnt vmcnt(0)" ::: "memory");
        } else {
            XB_SPIN(xb_ld(&bar[XB_XGEN(b.x)]) == gen, bar);
            __builtin_amdgcn_fence(__ATOMIC_ACQUIRE, "agent");
            asm volatile("s_waitcnt vmcnt(0)" ::: "memory");
        }
    }
    __syncthreads();
}

__device__ __forceinline__ bf16_t f2bf(float f) { unsigned u = __float_as_uint(f); u += 0x7FFFu + ((u >> 16) & 1u); return (bf16_t)(u >> 16); }
__device__ __forceinline__ float bf2f(bf16_t b) { return __uint_as_float(((unsigned)b) << 16); }
__device__ __forceinline__ unsigned pk2(float lo, float hi) { return (unsigned)f2bf(lo) | ((unsigned)f2bf(hi) << 16); }
__device__ __forceinline__ float wave_sum(float v) { for (int o = 32; o >= 1; o >>= 1) v += __shfl_xor(v, o); return v; }
__device__ __forceinline__ float sigmoidf_(float x) { return 1.f / (1.f + expf(-x)); }
__device__ __forceinline__ int row_stream(int row) { return row < NLAT ? (row >> 12) : 4; }
__device__ __forceinline__ const float* modp(const Params& p, int layer, int s, int part) { return (const float*)(p.ws + OFF_MOD) + ((size_t)layer * 5 + s) * 6144 + part * 1024; }

struct SgArgs { const bf16_t* A; int lda; size_t strideA; const float* B; int ldb; size_t strideB; int M, N, K, nbatch; };
template <class Epi>
__device__ __forceinline__ void sg_gemm(char* lds, const SgArgs g, const Epi& epi) {
    bf16_t* As = (bf16_t*)lds;
    bf16_t* Bs = As + 128 * 40;
    const int tid = tidx(), wid = tid >> 6, lane = tid & 63;
    const int wr = wid >> 2, wc = wid & 3;
    const int tilesN = (g.N + 127) / 128, tilesM = g.M / 128, per = tilesM * tilesN, ntiles = per * g.nbatch;
    const int ar = tid >> 2, ak = (tid & 3) * 8;
    const int bn = tid & 127, bk = (tid >> 7) * 8;
    for (int tile = blockIdx.x; tile < ntiles; tile += gridDim.x) {
        const int bt = tile / per, tt = tile % per;
        const int tm = tt / tilesN, tn = tt % tilesN;
        const int m0 = tm * 128, n0 = tn * 128;
        f32x4 acc[4][2];
#pragma unroll
        for (int m = 0; m < 4; ++m)
#pragma unroll
            for (int n = 0; n < 2; ++n) acc[m][n] = (f32x4){0.f, 0.f, 0.f, 0.f};
        const bool bvalid = (n0 + bn) < g.N;
        const bf16_t* ap = g.A + bt * g.strideA + (size_t)(m0 + ar) * g.lda + ak;
        const float* bp = g.B + bt * g.strideB + (size_t)bk * g.ldb + n0 + bn;
        bf16x8 areg; float breg[8];
        areg = *(const bf16x8*)ap;
#pragma unroll
        for (int j = 0; j < 8; ++j) breg[j] = bvalid ? bp[(size_t)j * g.ldb] : 0.f;
        for (int k0 = 0; k0 < g.K; k0 += 32) {
            __syncthreads();
            *(bf16x8*)(As + ar * 40 + ak) = areg;
            { u32x4 w; w.x = pk2(breg[0], breg[1]); w.y = pk2(breg[2], breg[3]); w.z = pk2(breg[4], breg[5]); w.w = pk2(breg[6], breg[7]); *(u32x4*)(Bs + bn * 40 + bk) = w; }
            __syncthreads();
            if (k0 + 32 < g.K) {
                areg = *(const bf16x8*)(ap + k0 + 32);
#pragma unroll
                for (int j = 0; j < 8; ++j) breg[j] = bvalid ? bp[(size_t)(k0 + 32 + j) * g.ldb] : 0.f;
            }
            bf16x8 af[4], bfr[2];
#pragma unroll
            for (int m = 0; m < 4; ++m) af[m] = *(const bf16x8*)(As + (wr * 64 + m * 16 + (lane & 15)) * 40 + (lane >> 4) * 8);
#pragma unroll
            for (int n = 0; n < 2; ++n) bfr[n] = *(const bf16x8*)(Bs + (wc * 32 + n * 16 + (lane & 15)) * 40 + (lane >> 4) * 8);
#pragma unroll
            for (int m = 0; m < 4; ++m)
#pragma unroll
                for (int n = 0; n < 2; ++n) acc[m][n] = __builtin_amdgcn_mfma_f32_16x16x32_bf16(af[m], bfr[n], acc[m][n], 0, 0, 0);
        }
#pragma unroll
        for (int m = 0; m < 4; ++m)
#pragma unroll
            for (int n = 0; n < 2; ++n) {
                const int col = n0 + wc * 32 + n * 16 + (lane & 15);
                if (col < g.N) {
#pragma unroll
                    for (int r = 0; r < 4; ++r) epi(bt, m0 + wr * 64 + m * 16 + (lane >> 4) * 4 + r, col, acc[m][n][r]);
                }
            }
    }
}

__device__ void ph_init(const Params& p, char* lds) {
    const int tid = tidx(), gtid = blockIdx.x * NTHR + tid, gsz = gridDim.x * NTHR;
    float4* X4 = (float4*)(p.ws + OFF_X);
    const float4* x4 = (const float4*)p.x; const float4* c4 = (const float4*)p.ctx;
    for (int i = gtid; i < NROW * 256; i += gsz) X4[i] = i < NLAT * 256 ? x4[i] : c4[i - NLAT * 256];
    float* rc = (float*)(p.ws + OFF_ROPE_C); float* rs = (float*)(p.ws + OFF_ROPE_S);
    for (int i = gtid; i < TL * 32; i += gsz) {
        const int t = i >> 5, f = i & 31; const float pos = (float)((f < 16) ? (t >> 6) : (t & 63));
        const float inv = powf(10000.f, -(float)(f & 15) / 16.f); const float ang = pos * inv; rc[i] = cosf(ang); rs[i] = sinf(ang);
    }
    float* sc = (float*)lds;
    float* red = sc + 5 * 1024;
    for (int i = tid; i < 5 * 1024; i += NTHR) { const float v = i < 4096 ? p.c[i] : p.c_ctx[i - 4096]; sc[i] = v / (1.f + expf(-v)); }
    __syncthreads();
    float* MOD = (float*)(p.ws + OFF_MOD);
    for (int item = blockIdx.x; item < 4 * 96; item += gridDim.x) {
        const int l = item / 96, cg = item % 96, col = tid & 63, n = cg * 64 + col, kg = tid >> 6;
        const float* w = p.mod_w + ((size_t)l * 1024 + kg * 128) * 6144 + n;
        float a0 = 0, a1 = 0, a2 = 0, a3 = 0, a4 = 0;
        for (int k = 0; k < 128; ++k) { const float wv = w[(size_t)k * 6144]; const int kk = kg * 128 + k;
            a0 += sc[kk] * wv; a1 += sc[1024 + kk] * wv; a2 += sc[2048 + kk] * wv; a3 += sc[3072 + kk] * wv; a4 += sc[4096 + kk] * wv; }
        float* rr = red + (kg * 64 + col) * 5; rr[0] = a0; rr[1] = a1; rr[2] = a2; rr[3] = a3; rr[4] = a4;
        __syncthreads();
        if (tid < 320) { const int c2 = tid & 63, s = tid >> 6; float sum = 0;
            for (int q = 0; q < 8; ++q) sum += red[(q * 64 + c2) * 5 + s];
            MOD[((size_t)l * 5 + s) * 6144 + cg * 64 + c2] = sum + p.mod_b[l * 6144 + cg * 64 + c2]; }
        __syncthreads();
    }
}

template <bool OUTF32>
__device__ void ph_norm_mod(const Params& p, int layer, const float* g, int part_sh, int part_sc, void* outp) {
    const int wid = tidx() >> 6, lane = tidx() & 63;
    const float* X = (const float*)(p.ws + OFF_X);
    for (int row = blockIdx.x * 8 + wid; row < NROW; row += gridDim.x * 8) {
        const int s = row_stream(row);
        const float* sh = modp(p, layer, s, part_sh); const float* sc = modp(p, layer, s, part_sc);
        const float4* xr = (const float4*)(X + (size_t)row * D);
        float4 v[4]; float ss = 0;
#pragma unroll
        for (int i = 0; i < 4; ++i) { v[i] = xr[lane + i * 64]; ss += v[i].x * v[i].x + v[i].y * v[i].y + v[i].z * v[i].z + v[i].w * v[i].w; }
        ss = wave_sum(ss); const float rs = rsqrtf(ss * (1.f / D) + RMS_EPS);
#pragma unroll
        for (int i = 0; i < 4; ++i) {
            const int d = (lane + i * 64) * 4;
            const float4 gg = *(const float4*)(g + d), a = *(const float4*)(sc + d), b = *(const float4*)(sh + d);
            float4 o; o.x = v[i].x * rs * gg.x * (1.f + a.x) + b.x; o.y = v[i].y * rs * gg.y * (1.f + a.y) + b.y; o.z = v[i].z * rs * gg.z * (1.f + a.z) + b.z; o.w = v[i].w * rs * gg.w * (1.f + a.w) + b.w;
            if (OUTF32) *(float4*)((float*)outp + (size_t)row * D + d) = o;
            else { uint2 w; w.x = pk2(o.x, o.y); w.y = pk2(o.z, o.w); *(uint2*)((bf16_t*)outp + (size_t)row * D + d) = w; }
        }
    }
}

__device__ void ph_mla_mid(const Params& p, int j) {
    const int wid = tidx() >> 6, lane = tidx() & 63;
    const float* Z = (const float*)(p.ws + OFF_Z);
    bf16_t* CQN = (bf16_t*)(p.ws + OFF_CQN); bf16_t* CKVN = (bf16_t*)(p.ws + OFF_CKVN); float* KR = (float*)(p.ws + OFF_KR);
    const float* gq = p.mla_g_q + j * 256; const float* gkv = p.mla_g_kv + j * 128;
    const float* rc = (const float*)(p.ws + OFF_ROPE_C); const float* rs = (const float*)(p.ws + OFF_ROPE_S);
    for (int row = blockIdx.x * 8 + wid; row < NROW; row += gridDim.x * 8) {
        const float* z = Z + (size_t)row * 448;
        const float4 q = *(const float4*)(z + lane * 4);
        const float2 kv = *(const float2*)(z + 256 + lane * 2);
        const float kr = z[384 + lane];
        float sq = wave_sum(q.x * q.x + q.y * q.y + q.z * q.z + q.w * q.w); const float rq = rsqrtf(sq * (1.f / 256.f) + RMS_EPS);
        float sk = wave_sum(kv.x * kv.x + kv.y * kv.y); const float rk = rsqrtf(sk * (1.f / 128.f) + RMS_EPS);
        const float4 g4 = *(const float4*)(gq + lane * 4); const float2 g2 = *(const float2*)(gkv + lane * 2);
        uint2 w; w.x = pk2(q.x * rq * g4.x, q.y * rq * g4.y); w.y = pk2(q.z * rq * g4.z, q.w * rq * g4.w);
        *(uint2*)(CQN + (size_t)row * 256 + lane * 4) = w;
        *(unsigned*)(CKVN + (size_t)row * 128 + lane * 2) = pk2(kv.x * rk * g2.x, kv.y * rk * g2.y);
        float o = kr;
        const float other = __shfl_xor(kr, 32);
        if (row < NLAT) { const int t = row & (TL - 1), i = lane & 31; const float c = rc[t * 32 + i], s = rs[t * 32 + i];
            const float x1 = lane < 32 ? kr : other, x2 = lane < 32 ? other : kr;
            o = lane < 32 ? (x1 * c - x2 * s) : (x1 * s + x2 * c); }
        KR[(size_t)row * 64 + lane] = o;
    }
}

__device__ void ph_qkv_post(const Params& p) {
    const int wid = tidx() >> 6, lane = tidx() & 63;
    const float* QRAW = (const float*)(p.ws + OFF_QRAW); const float* KVRAW = (const float*)(p.ws + OFF_KVRAW); const float* KR = (const float*)(p.ws + OFF_KR);
    bf16_t* Q = (bf16_t*)(p.ws + OFF_Q); bf16_t* K = (bf16_t*)(p.ws + OFF_K); bf16_t* V = (bf16_t*)(p.ws + OFF_V);
    const float* rc = (const float*)(p.ws + OFF_ROPE_C); const float* rs = (const float*)(p.ws + OFF_ROPE_S);
    for (int it = blockIdx.x * 8 + wid; it < NROW * 8; it += gridDim.x * 8) {
        const int row = it >> 3, h = it & 7;
        const bool lat = row < NLAT; const int b = lat ? (row >> 12) : ((row - NLAT) >> 8); const int tk = lat ? 256 + (row & (TL - 1)) : ((row - NLAT) & 255);
        const size_t orow = (size_t)(b * 8 + h) * TK + tk;
        const float* q = QRAW + (size_t)row * 1536 + h * 192;
        const float q0 = q[lane], q1 = q[64 + lane]; float q2 = q[128 + lane];
        const float other = __shfl_xor(q2, 32);
        if (lat) { const int t = row & (TL - 1), i = lane & 31; const float c = rc[t * 32 + i], s = rs[t * 32 + i];
            const float x1 = lane < 32 ? q2 : other, x2 = lane < 32 ? other : q2; q2 = lane < 32 ? (x1 * c - x2 * s) : (x1 * s + x2 * c); }
        bf16_t* qo = Q + orow * 192; qo[lane] = f2bf(q0); qo[64 + lane] = f2bf(q1); qo[128 + lane] = f2bf(q2);
        const float* kv = KVRAW + (size_t)row * 2048 + h * 256;
        bf16_t* ko = K + orow * 192; ko[lane] = f2bf(kv[lane]); ko[64 + lane] = f2bf(kv[64 + lane]); ko[128 + lane] = f2bf(KR[(size_t)row * 64 + lane]);
        bf16_t* vo = V + orow * 128; vo[lane] = f2bf(kv[128 + lane]); vo[64 + lane] = f2bf(kv[192 + lane]);
    }
}

__device__ void ph_attn_naive(const Params& p, char* lds) {
    const int tid = tidx(), qi = tid >> 2, part = tid & 3;
    const bf16_t* Q = (const bf16_t*)(p.ws + OFF_Q); const bf16_t* K = (const bf16_t*)(p.ws + OFF_K); const bf16_t* V = (const bf16_t*)(p.ws + OFF_V);
    bf16_t* O = (bf16_t*)(p.ws + OFF_O);
    bf16_t* Ks = (bf16_t*)lds;
    bf16_t* Vs = Ks + 32 * 192;
    const int nitems = 32 * 34;
    for (int it = blockIdx.x; it < nitems; it += gridDim.x) {
        const int bh = it / 34, qb = it % 34; const int b = bh >> 3, h = bh & 7;
        const int nkeys = qb < 2 ? TC : TK;
        const int tq = qb * 128 + qi;
        const bf16_t* qp = Q + ((size_t)bh * TK + tq) * 192 + part * 48;
        float q[48];
#pragma unroll
        for (int i = 0; i < 48; ++i) q[i] = bf2f(qp[i]) * ATT_SCALE;
        float o[32];
#pragma unroll
        for (int i = 0; i < 32; ++i) o[i] = 0.f;
        float m = -1e30f, l = 0.f;
        for (int k0 = 0; k0 < nkeys; k0 += 32) {
            __syncthreads();
            {
                const bf16_t* kg = K + ((size_t)bh * TK + k0) * 192; const bf16_t* vg = V + ((size_t)bh * TK + k0) * 128;
                for (int c = tid; c < 768; c += NTHR) *(u32x4*)(Ks + c * 8) = *(const u32x4*)(kg + c * 8);
                *(u32x4*)(Vs + tid * 8) = *(const u32x4*)(vg + tid * 8);
            }
            __syncthreads();
#pragma unroll 1
            for (int kg = 0; kg < 32; kg += 8) {
                float s[8]; float tmax = -1e30f;
#pragma unroll
                for (int kk = 0; kk < 8; ++kk) {
                    const bf16_t* kr = Ks + (kg + kk) * 192 + part * 48; float acc = 0.f;
#pragma unroll
                    for (int i = 0; i < 48; ++i) acc += q[i] * bf2f(kr[i]);
                    acc += __shfl_xor(acc, 1); acc += __shfl_xor(acc, 2);
                    s[kk] = acc; tmax = fmaxf(tmax, acc);
                    asm volatile("" ::: "memory");
                }
                const float mn = fmaxf(m, tmax), alpha = expf(m - mn); m = mn; l *= alpha;
#pragma unroll
                for (int i = 0; i < 32; ++i) o[i] *= alpha;
#pragma unroll
                for (int kk = 0; kk < 8; ++kk) {
                    const float pw = expf(s[kk] - mn); l += pw;
                    const bf16_t* vr = Vs + (kg + kk) * 128 + part * 32;
#pragma unroll
                    for (int i = 0; i < 32; ++i) o[i] += pw * bf2f(vr[i]);
                    asm volatile("" ::: "memory");
                }
            }
        }
        const float rl = 1.f / l;
        const int row = qb < 2 ? (NLAT + b * TC + tq) : (b * TL + tq - TC);
        bf16_t* op = O + (size_t)row * D + h * 128 + part * 32;
#pragma unroll
        for (int i = 0; i < 32; ++i) op[i] = f2bf(o[i] * rl);
    }
}

__device__ void ph_norm2_router(const Params& p, int layer, char* lds) {
    const int tid = tidx(), wid = tid >> 6, lane = tid & 63;
    float* rt = (float*)lds;
    const float* rg = p.moe_router + (size_t)layer * D * NE;
    for (int i = tid; i < D * NE / 4; i += NTHR) ((float4*)rt)[i] = ((const float4*)rg)[i];
    __syncthreads();
    const float* X = (const float*)(p.ws + OFF_X); bf16_t* BN = (bf16_t*)(p.ws + OFF_H); float* AFF = (float*)(p.ws + OFF_AFF);
    const float* g = p.norm2_g + layer * D;
    for (int row = blockIdx.x * 8 + wid; row < NROW; row += gridDim.x * 8) {
        const int s = row_stream(row);
        const float* sh = modp(p, layer, s, 3); const float* sc = modp(p, layer, s, 4);
        const float4* xr = (const float4*)(X + (size_t)row * D);
        float4 v[4]; float ss = 0;
#pragma unroll
        for (int i = 0; i < 4; ++i) { v[i] = xr[lane + i * 64]; ss += v[i].x * v[i].x + v[i].y * v[i].y + v[i].z * v[i].z + v[i].w * v[i].w; }
        ss = wave_sum(ss); const float rs = rsqrtf(ss * (1.f / D) + RMS_EPS);
        float lg[16];
#pragma unroll
        for (int e = 0; e < 16; ++e) lg[e] = 0.f;
#pragma unroll
        for (int i = 0; i < 4; ++i) {
            const int d = (lane + i * 64) * 4;
            const float4 gg = *(const float4*)(g + d), a = *(const float4*)(sc + d), b = *(const float4*)(sh + d);
            float o[4]; o[0] = v[i].x * rs * gg.x * (1.f + a.x) + b.x; o[1] = v[i].y * rs * gg.y * (1.f + a.y) + b.y; o[2] = v[i].z * rs * gg.z * (1.f + a.z) + b.z; o[3] = v[i].w * rs * gg.w * (1.f + a.w) + b.w;
            uint2 w; w.x = pk2(o[0], o[1]); w.y = pk2(o[2], o[3]); *(uint2*)(BN + (size_t)row * D + d) = w;
#pragma unroll
            for (int jj = 0; jj < 4; ++jj) { const float* rr = rt + (d + jj) * 16;
#pragma unroll
                for (int e = 0; e < 16; ++e) lg[e] += o[jj] * rr[e];
                asm volatile("" ::: "memory"); }
        }
        float mx = -1e30f;
#pragma unroll
        for (int e = 0; e < 16; ++e) { lg[e] = wave_sum(lg[e]); mx = fmaxf(mx, lg[e]); }
        float sum = 0;
#pragma unroll
        for (int e = 0; e < 16; ++e) { lg[e] = expf(lg[e] - mx); sum += lg[e]; }
        const float inv = 1.f / sum;
        if (lane < 16) { float val = 0;
#pragma unroll
            for (int e = 0; e < 16; ++e) val = (lane == e) ? lg[e] : val;
            AFF[(size_t)row * 16 + lane] = val * inv; }
    }
}

__device__ void ph_select(const Params& p, char* lds) {
    const int tid = tidx();
    float* vals = (float*)lds;
    const float* AFF = (const float*)(p.ws + OFF_AFF);
    int* ROWIDX = (int*)(p.ws + OFF_ROWIDX); float* GATE = (float*)(p.ws + OFF_GATE); int* SLOT = (int*)(p.ws + OFF_SLOT);
    for (int gidx = blockIdx.x; gidx < 128; gidx += gridDim.x) {
        const bool lat = gidx < 64; const int b = (gidx & 63) >> 4, e = gidx & 15;
        const int n = lat ? TL : TC, cap = lat ? CAPL : CAPC;
        const int row0 = lat ? b * TL : NLAT + b * TC, slot0 = lat ? b * CAPL : NB * CAPL + b * CAPC;
        __syncthreads();
        for (int i = tid; i < n; i += NTHR) vals[i] = AFF[(size_t)(row0 + i) * 16 + e];
        __syncthreads();
        for (int i = tid; i < n; i += NTHR) {
            const float v = vals[i]; int rank = 0;
            for (int jj = 0; jj < n; ++jj) { const float u = vals[jj]; rank += (u > v || (u == v && jj < i)) ? 1 : 0; }
            if (rank < cap) { ROWIDX[e * ESLOTS + slot0 + rank] = row0 + i; GATE[e * ESLOTS + slot0 + rank] = v; SLOT[(size_t)(row0 + i) * 16 + e] = slot0 + rank; }
            else SLOT[(size_t)(row0 + i) * 16 + e] = -1;
        }
    }
}

__device__ void ph_gather(const Params& p) {
    const int wid = tidx() >> 6, lane = tidx() & 63;
    const int* ROWIDX = (const int*)(p.ws + OFF_ROWIDX); const bf16_t* BN = (const bf16_t*)(p.ws + OFF_H); bf16_t* XE = (bf16_t*)(p.ws + OFF_XE);
    for (int it = blockIdx.x * 8 + wid; it < NE * ESLOTS; it += gridDim.x * 8) {
        const int row = ROWIDX[it];
        const u32x4* src = (const u32x4*)(BN + (size_t)row * D); u32x4* dst = (u32x4*)(XE + (size_t)it * D);
        dst[lane] = src[lane]; dst[lane + 64] = src[lane + 64];
    }
}

__device__ void ph_combine(const Params& p, int layer) {
    const int wid = tidx() >> 6, lane = tidx() & 63;
    const int* SLOT = (const int*)(p.ws + OFF_SLOT); const bf16_t* YE = (const bf16_t*)(p.ws + OFF_YE); float* X = (float*)(p.ws + OFF_X);
    for (int row = blockIdx.x * 8 + wid; row < NROW; row += gridDim.x * 8) {
        const float* gt = modp(p, layer, row_stream(row), 5);
        float acc[16];
#pragma unroll
        for (int i = 0; i < 16; ++i) acc[i] = 0.f;
        for (int e = 0; e < NE; ++e) {
            const int s = SLOT[(size_t)row * 16 + e];
            if (s >= 0) { const bf16_t* y = YE + ((size_t)e * ESLOTS + s) * D + lane * 16;
                const u32x4 a = *(const u32x4*)y, b = *(const u32x4*)(y + 8);
                const unsigned w[8] = {a.x, a.y, a.z, a.w, b.x, b.y, b.z, b.w};
#pragma unroll
                for (int i = 0; i < 8; ++i) { acc[2 * i] += __uint_as_float(w[i] << 16); acc[2 * i + 1] += __uint_as_float(w[i] & 0xffff0000u); } }
        }
        float* xr = X + (size_t)row * D + lane * 16; const float* g = gt + lane * 16;
#pragma unroll
        for (int i = 0; i < 16; i += 4) { float4 xv = *(float4*)(xr + i); const float4 gv = *(const float4*)(g + i);
            xv.x += gv.x * acc[i]; xv.y += gv.y * acc[i + 1]; xv.z += gv.z * acc[i + 2]; xv.w += gv.w * acc[i + 3]; *(float4*)(xr + i) = xv; }
    }
}

__device__ void ph_rw_xs(const Params& p, int j) {
    const float* HF = (const float*)(p.ws + OFF_HF); bf16_t* XS = (bf16_t*)(p.ws + OFF_XS);
    const float* mu = p.rw_mu + (size_t)j * 6 * D;
    const int gtid = blockIdx.x * NTHR + tidx(), gsz = gridDim.x * NTHR;
    for (int i = gtid; i < NROW * 256; i += gsz) {
        const int row = i >> 8, d = (i & 255) * 4;
        const bool lat = row < NLAT; const int t = lat ? (row & (TL - 1)) : ((row - NLAT) & (TC - 1)); const int len = lat ? TL : TC;
        const float4 h = *(const float4*)(HF + (size_t)row * D + d);
        float4 pv = make_float4(0, 0, 0, 0), nx = make_float4(0, 0, 0, 0);
        if (t > 0) pv = *(const float4*)(HF + (size_t)(row - 1) * D + d);
        if (t < len - 1) nx = *(const float4*)(HF + (size_t)(row + 1) * D + d);
        float4 xx; xx.x = 0.5f * (pv.x + nx.x) - h.x; xx.y = 0.5f * (pv.y + nx.y) - h.y; xx.z = 0.5f * (pv.z + nx.z) - h.z; xx.w = 0.5f * (pv.w + nx.w) - h.w;
#pragma unroll
        for (int m = 0; m < 6; ++m) { const float4 u = *(const float4*)(mu + m * D + d);
            uint2 w; w.x = pk2(h.x + xx.x * u.x, h.y + xx.y * u.y); w.y = pk2(h.z + xx.z * u.z, h.w + xx.w * u.w);
            *(uint2*)(XS + ((size_t)m * NROW + row) * D + d) = w; }
    }
}

__device__ void ph_rw_prep(const Params& p, int j) {
    const int wid = tidx() >> 6, lane = tidx() & 63;
    float* RKV = (float*)(p.ws + OFF_RKV); float* AV = (float*)(p.ws + OFF_AV); float* KD = (float*)(p.ws + OFF_KD);
    const float* k_k = p.rw_k_k + j * D; const float* k_a = p.rw_k_a + j * D;
    for (int row = blockIdx.x * 8 + wid; row < NROW; row += gridDim.x * 8) {
        const size_t o = (size_t)row * D + lane * 16;
        float k[16], kk[16]; float ss = 0;
#pragma unroll
        for (int i = 0; i < 16; ++i) { k[i] = RKV[(size_t)NROW * D + o + i]; kk[i] = k[i] * k_k[lane * 16 + i]; ss += kk[i] * kk[i]; }
        ss += __shfl_xor(ss, 1); ss += __shfl_xor(ss, 2);
        const float inv = 1.f / fmaxf(sqrtf(ss), 1e-12f);
#pragma unroll
        for (int i = 0; i < 16; ++i) kk[i] *= inv;
#pragma unroll
        for (int z = 0; z < 2; ++z)
#pragma unroll
            for (int i = 0; i < 16; ++i) { const float a = AV[(size_t)z * NROW * D + o + i];
                KD[(size_t)z * NROW * D + o + i] = k[i] * (1.f + (a - 1.f) * k_a[lane * 16 + i]);
                AV[(size_t)z * NROW * D + o + i] = kk[i] * a; }
#pragma unroll
        for (int i = 0; i < 16; ++i) RKV[(size_t)NROW * D + o + i] = kk[i];
    }
}

__device__ void ph_rw_scan(const Params& p) {
    const int tid = tidx(), wid = tid >> 6, lane = tid & 63, vr = lane >> 3, ks = lane & 7;
    const float* RKV = (const float*)(p.ws + OFF_RKV); const float* W = (const float*)(p.ws + OFF_W); const float* BBp = (const float*)(p.ws + OFF_AV); const float* KD = (const float*)(p.ws + OFF_KD);
    float* Y = (float*)(p.ws + OFF_Y);
    const size_t PL = (size_t)NROW * D;
    for (int it = blockIdx.x; it < 128; it += gridDim.x) {
        const int z = it & 1, h = (it >> 1) & 15, b = it >> 5;
        float S[8];
#pragma unroll
        for (int i = 0; i < 8; ++i) S[i] = 0.f;
        const int co = h * 64 + ks * 8, vo = h * 64 + wid * 8 + vr;
        for (int ph = 0; ph < 2; ++ph) {
            const int n = ph == 0 ? TC : TL; const int base = ph == 0 ? NLAT + b * TC : b * TL;
            for (int st = 0; st < n; ++st) {
                const int t = z == 0 ? st : n - 1 - st; const size_t ro = (size_t)(base + t) * D;
                float w[8], kk[8], bb[8], kd[8], r[8];
                *(float4*)w = *(const float4*)(W + z * PL + ro + co); *(float4*)(w + 4) = *(const float4*)(W + z * PL + ro + co + 4);
                *(float4*)kk = *(const float4*)(RKV + PL + ro + co); *(float4*)(kk + 4) = *(const float4*)(RKV + PL + ro + co + 4);
                *(float4*)bb = *(const float4*)(BBp + z * PL + ro + co); *(float4*)(bb + 4) = *(const float4*)(BBp + z * PL + ro + co + 4);
                *(float4*)kd = *(const float4*)(KD + z * PL + ro + co); *(float4*)(kd + 4) = *(const float4*)(KD + z * PL + ro + co + 4);
                *(float4*)r = *(const float4*)(RKV + ro + co); *(float4*)(r + 4) = *(const float4*)(RKV + ro + co + 4);
                const float v = RKV[2 * PL + ro + vo];
                float sa = 0;
#pragma unroll
                for (int i = 0; i < 8; ++i) sa -= S[i] * kk[i];
                sa += __shfl_xor(sa, 1); sa += __shfl_xor(sa, 2); sa += __shfl_xor(sa, 4);
                float y = 0;
#pragma unroll
                for (int i = 0; i < 8; ++i) { S[i] = S[i] * w[i] + sa * bb[i] + v * kd[i]; y += S[i] * r[i]; }
                y += __shfl_xor(y, 1); y += __shfl_xor(y, 2); y += __shfl_xor(y, 4);
                if (ks == 0) Y[z * PL + ro + vo] = y;
            }
        }
    }
}

__device__ void ph_rw_out(const Params& p, int j) {
    const int wid = tidx() >> 6, lane = tidx() & 63;
    const float* RKV = (const float*)(p.ws + OFF_RKV); const float* KD = (const float*)(p.ws + OFF_KD); const float* G = (const float*)(p.ws + OFF_G); const float* Y = (const float*)(p.ws + OFF_Y);
    bf16_t* OUT = (bf16_t*)(p.ws + OFF_H);
    const size_t PL = (size_t)NROW * D;
    const float* r_k = p.rw_r_k + j * D; const float* lg = p.rw_lnx_g + j * D; const float* lb = p.rw_lnx_b + j * D;
    for (int row = blockIdx.x * 8 + wid; row < NROW; row += gridDim.x * 8) {
        const size_t o = (size_t)row * D + lane * 16;
        float y[16]; float s = 0;
#pragma unroll
        for (int i = 0; i < 16; ++i) { y[i] = Y[o + i] + Y[PL + o + i]; s += y[i]; }
        s += __shfl_xor(s, 1); s += __shfl_xor(s, 2); const float mean = s * (1.f / 64.f);
        float q = 0;
#pragma unroll
        for (int i = 0; i < 16; ++i) { const float dd = y[i] - mean; q += dd * dd; }
        q += __shfl_xor(q, 1); q += __shfl_xor(q, 2); const float rstd = rsqrtf(q * (1.f / 64.f) + LNX_EPS);
        float bs = 0;
#pragma unroll
        for (int i = 0; i < 16; ++i) bs += RKV[o + i] * (KD[o + i] + KD[PL + o + i]) * r_k[lane * 16 + i];
        bs += __shfl_xor(bs, 1); bs += __shfl_xor(bs, 2);
        unsigned w[8];
#pragma unroll
        for (int i = 0; i < 16; i += 2) {
            const float o0 = ((y[i] - mean) * rstd * lg[lane * 16 + i] + lb[lane * 16 + i] + bs * RKV[2 * PL + o + i]) * G[o + i];
            const float o1 = ((y[i + 1] - mean) * rstd * lg[lane * 16 + i + 1] + lb[lane * 16 + i + 1] + bs * RKV[2 * PL + o + i + 1]) * G[o + i + 1];
            w[i >> 1] = pk2(o0, o1); }
        *(u32x4*)(OUT + o) = (u32x4){w[0], w[1], w[2], w[3]}; *(u32x4*)(OUT + o + 8) = (u32x4){w[4], w[5], w[6], w[7]};
    }
}

__device__ void ph_final(const Params& p) {
    const int wid = tidx() >> 6, lane = tidx() & 63;
    const float* X = (const float*)(p.ws + OFF_X);
    for (int row = blockIdx.x * 8 + wid; row < NLAT; row += gridDim.x * 8) {
        const float4* xr = (const float4*)(X + (size_t)row * D);
        float4 v[4]; float ss = 0;
#pragma unroll
        for (int i = 0; i < 4; ++i) { v[i] = xr[lane + i * 64]; ss += v[i].x * v[i].x + v[i].y * v[i].y + v[i].z * v[i].z + v[i].w * v[i].w; }
        ss = wave_sum(ss); const float rs = rsqrtf(ss * (1.f / D) + RMS_EPS);
#pragma unroll
        for (int i = 0; i < 4; ++i) { const int d = (lane + i * 64) * 4; const float4 gg = *(const float4*)(p.final_g + d);
            float4 o; o.x = v[i].x * rs * gg.x; o.y = v[i].y * rs * gg.y; o.z = v[i].z * rs * gg.z; o.w = v[i].w * rs * gg.w;
            *(float4*)(p.out + (size_t)row * D + d) = o; }
    }
}

enum { PH_INIT = 0, PH_A_NORM, PH_A_Z, PH_A_MID, PH_A_QKV, PH_A_POST, PH_A_ATTN, PH_A_WO,
       PH_R_NORM, PH_R_XS, PH_R_G1, PH_R_G2, PH_R_PREP, PH_R_SCAN, PH_R_OUT, PH_R_WO,
       PH_M_NORM, PH_M_SEL, PH_M_GATHER, PH_M_G1, PH_M_G2, PH_M_COMB, PH_FINAL };

template <int PH>
__device__ __forceinline__ void run_phase(const Params& p, int layer, char* lds) {
    const int j = layer >> 1;
    char* ws = p.ws;
    if constexpr (PH == PH_INIT) ph_init(p, lds);
    else if constexpr (PH == PH_A_NORM) ph_norm_mod<false>(p, layer, p.norm1_g + layer * D, 0, 1, ws + OFF_H);
    else if constexpr (PH == PH_A_Z) {
        float* Z = (float*)(ws + OFF_Z);
        SgArgs g{(const bf16_t*)(ws + OFF_H), D, 0, p.mla_w_in + (size_t)j * D * 448, 448, 0, NROW, 448, D, 1};
        sg_gemm(lds, g, [=](int, int row, int col, float v) { Z[(size_t)row * 448 + col] = v; });
    }
    else if constexpr (PH == PH_A_MID) ph_mla_mid(p, j);
    else if constexpr (PH == PH_A_QKV) {
        float* QRAW = (float*)(ws + OFF_QRAW); float* KVRAW = (float*)(ws + OFF_KVRAW);
        SgArgs g1{(const bf16_t*)(ws + OFF_CQN), 256, 0, p.mla_w_uq + (size_t)j * 256 * 1536, 1536, 0, NROW, 1536, 256, 1};
        sg_gemm(lds, g1, [=](int, int row, int col, float v) { QRAW[(size_t)row * 1536 + col] = v; });
        SgArgs g2{(const bf16_t*)(ws + OFF_CKVN), 128, 0, p.mla_w_ukv + (size_t)j * 128 * 2048, 2048, 0, NROW, 2048, 128, 1};
        sg_gemm(lds, g2, [=](int, int row, int col, float v) { KVRAW[(size_t)row * 2048 + col] = v; });
    }
    else if constexpr (PH == PH_A_POST) ph_qkv_post(p);
    else if constexpr (PH == PH_A_ATTN) ph_attn_naive(p, lds);
    else if constexpr (PH == PH_A_WO || PH == PH_R_WO) {
        float* X = (float*)(ws + OFF_X); const float* MOD = (const float*)(ws + OFF_MOD);
        const bf16_t* A = (const bf16_t*)(ws + (PH == PH_A_WO ? OFF_O : OFF_H));
        const float* B = (PH == PH_A_WO ? p.mla_w_o : p.rw_w_o) + (size_t)j * D * D;
        SgArgs g{A, D, 0, B, D, 0, NROW, D, D, 1};
        sg_gemm(lds, g, [=](int, int row, int col, float v) { const float gt = MOD[((size_t)layer * 5 + row_stream(row)) * 6144 + 2048 + col]; X[(size_t)row * D + col] += gt * v; });
    }
    else if constexpr (PH == PH_R_NORM) ph_norm_mod<true>(p, layer, p.norm1_g + layer * D, 0, 1, ws + OFF_HF);
    else if constexpr (PH == PH_R_XS) ph_rw_xs(p, j);
    else if constexpr (PH == PH_R_G1) {
        const bf16_t* XS = (const bf16_t*)(ws + OFF_XS);
        float* RKV = (float*)(ws + OFF_RKV); float* VF = (float*)(ws + OFF_VFIRST);
        const bool first = (j == 0);
        SgArgs g{XS, D, (size_t)NROW * D, p.rw_w_rkv + (size_t)j * 3 * D * D, D, (size_t)D * D, NROW, D, D, 3};
        sg_gemm(lds, g, [=](int m, int row, int col, float v) { RKV[((size_t)m * NROW + row) * D + col] = v; if (first && m == 2) VF[(size_t)row * D + col] = v; });
        bf16_t* LW = (bf16_t*)(ws + OFF_LW); bf16_t* LA = (bf16_t*)(ws + OFF_LA); bf16_t* LG = (bf16_t*)(ws + OFF_LG); bf16_t* LV = (bf16_t*)(ws + OFF_LV);
        SgArgs gw{XS + (size_t)3 * NROW * D, D, 0, p.rw_w1 + (size_t)j * 2 * D * 64, 64, (size_t)D * 64, NROW, 64, D, 2};
        sg_gemm(lds, gw, [=](int z, int row, int col, float v) { LW[(size_t)row * 128 + z * 64 + col] = f2bf(tanhf(v)); });
        SgArgs ga{XS + (size_t)4 * NROW * D, D, 0, p.rw_a1 + (size_t)j * 2 * D * 64, 64, (size_t)D * 64, NROW, 64, D, 2};
        sg_gemm(lds, ga, [=](int z, int row, int col, float v) { LA[(size_t)row * 128 + z * 64 + col] = f2bf(v); });
        SgArgs gg{XS + (size_t)5 * NROW * D, D, 0, p.rw_g1 + (size_t)j * D * 128, 128, 0, NROW, 128, D, 1};
        sg_gemm(lds, gg, [=](int, int row, int col, float v) { LG[(size_t)row * 128 + col] = f2bf(sigmoidf_(v)); });
        if (!first) {
            SgArgs gv{XS + (size_t)2 * NROW * D, D, 0, p.rw_v1, 32, 0, NROW, 32, D, 1};
            sg_gemm(lds, gv, [=](int, int row, int col, float v) { LV[(size_t)row * 32 + col] = f2bf(v); });
        }
    }
    else if constexpr (PH == PH_R_G2) {
        const bool first = (j == 0);
        float* W = (float*)(ws + OFF_W); float* AV = (float*)(ws + OFF_AV); float* G = (float*)(ws + OFF_G); float* RKV = (float*)(ws + OFF_RKV); const float* VF = (const float*)(ws + OFF_VFIRST);
        const float* w0 = p.rw_w0 + (size_t)j * 2 * D; const float* a0 = p.rw_a0 + (size_t)j * 2 * D; const float* v0 = p.rw_v0;
        SgArgs gw{(const bf16_t*)(ws + OFF_LW), 128, 64, p.rw_w2 + (size_t)j * 2 * 64 * D, D, (size_t)64 * D, NROW, D, 64, 2};
        sg_gemm(lds, gw, [=](int z, int row, int col, float v) { const float wz = v + w0[z * D + col];
            const float sp = (-wz > 20.f) ? -wz : log1pf(expf(-wz));
            W[((size_t)z * NROW + row) * D + col] = expf(-expf(-sp - 0.5f)); });
        SgArgs ga{(const bf16_t*)(ws + OFF_LA), 128, 64, p.rw_a2 + (size_t)j * 2 * 64 * D, D, (size_t)64 * D, NROW, D, 64, 2};
        sg_gemm(lds, ga, [=](int z, int row, int col, float v) { AV[((size_t)z * NROW + row) * D + col] = sigmoidf_(v + a0[z * D + col]); });
        SgArgs gg{(const bf16_t*)(ws + OFF_LG), 128, 0, p.rw_g2 + (size_t)j * 128 * D, D, 0, NROW, D, 128, 1};
        sg_gemm(lds, gg, [=](int, int row, int col, float v) { G[(size_t)row * D + col] = v; });
        if (!first) {
            SgArgs gv{(const bf16_t*)(ws + OFF_LV), 32, 0, p.rw_v2, D, 0, NROW, D, 32, 1};
            sg_gemm(lds, gv, [=](int, int row, int col, float v) { const size_t o = (size_t)row * D + col; const float vv = RKV[(size_t)2 * NROW * D + o];
                RKV[(size_t)2 * NROW * D + o] = vv + (VF[o] - vv) * sigmoidf_(v + v0[col]); });
        }
    }
    else if constexpr (PH == PH_R_PREP) ph_rw_prep(p, j);
    else if constexpr (PH == PH_R_SCAN) ph_rw_scan(p);
    else if constexpr (PH == PH_R_OUT) ph_rw_out(p, j);
    else if constexpr (PH == PH_M_NORM) ph_norm2_router(p, layer, lds);
    else if constexpr (PH == PH_M_SEL) ph_select(p, lds);
    else if constexpr (PH == PH_M_GATHER) ph_gather(p);
    else if constexpr (PH == PH_M_G1) {
        float* G1 = (float*)(ws + OFF_G1); bf16_t* HID = (bf16_t*)(ws + OFF_HID);
        SgArgs g1{(const bf16_t*)(ws + OFF_XE), D, (size_t)ESLOTS * D, p.moe_w1 + (size_t)layer * NE * D * FF, FF, (size_t)D * FF, ESLOTS, FF, D, NE};
        sg_gemm(lds, g1, [=](int e, int row, int col, float v) { G1[((size_t)e * ESLOTS + row) * FF + col] = v; });
        SgArgs g3{(const bf16_t*)(ws + OFF_XE), D, (size_t)ESLOTS * D, p.moe_w3 + (size_t)layer * NE * D * FF, FF, (size_t)D * FF, ESLOTS, FF, D, NE};
        sg_gemm(lds, g3, [=](int e, int row, int col, float v) { const size_t o = ((size_t)e * ESLOTS + row) * FF + col; const float a = G1[o]; HID[o] = f2bf(a / (1.f + expf(-a)) * v); });
    }
    else if constexpr (PH == PH_M_G2) {
        bf16_t* YE = (bf16_t*)(ws + OFF_YE); const float* GATE = (const float*)(ws + OFF_GATE);
        SgArgs g{(const bf16_t*)(ws + OFF_HID), FF, (size_t)ESLOTS * FF, p.moe_w2 + (size_t)layer * NE * FF * D, D, (size_t)FF * D, ESLOTS, D, FF, NE};
        sg_gemm(lds, g, [=](int e, int row, int col, float v) { YE[((size_t)e * ESLOTS + row) * D + col] = f2bf(v * GATE[e * ESLOTS + row]); });
    }
    else if constexpr (PH == PH_M_COMB) ph_combine(p, layer);
    else if constexpr (PH == PH_FINAL) ph_final(p);
}

#if ONE_LAUNCH
#define SYNC() xcd_barrier(bar)
#define RUN(PH) do { Params q = p; asm volatile("" : "+s"(q.ws)); run_phase<PH>(q, layer, smem); SYNC(); } while (0)
__global__ void __launch_bounds__(NTHR, 2) mega(Params p) {
    extern __shared__ __attribute__((aligned(16))) char smem[];
    if (tidx() == 0) *(uint4*)(smem + LDS_BYTES) = make_uint4(0u, 0u, 0u, 0u);
    __syncthreads();
    XcdBarrier bar = xcd_barrier_post((unsigned*)(p.ws + OFF_BAR), (volatile LAS unsigned*)(smem + LDS_BYTES));
    { const int layer = 0; RUN(PH_INIT); }
    for (int layer = 0; layer < 4; ++layer) {
        if ((layer & 1) == 0) {
            RUN(PH_A_NORM);
            RUN(PH_A_Z);
            RUN(PH_A_MID);
            RUN(PH_A_QKV);
            RUN(PH_A_POST);
            RUN(PH_A_ATTN);
            RUN(PH_A_WO);
        } else {
            RUN(PH_R_NORM);
            RUN(PH_R_XS);
            RUN(PH_R_G1);
            RUN(PH_R_G2);
            RUN(PH_R_PREP);
            RUN(PH_R_SCAN);
            RUN(PH_R_OUT);
            RUN(PH_R_WO);
        }
        RUN(PH_M_NORM);
        RUN(PH_M_SEL);
        RUN(PH_M_GATHER);
        RUN(PH_M_G1);
        RUN(PH_M_G2);
        RUN(PH_M_COMB);
    }
    run_phase<PH_FINAL>(p, 0, smem);
}
#else
template <int PH> __global__ void __launch_bounds__(NTHR, 2) kph(Params p, int layer) {
    extern __shared__ __attribute__((aligned(16))) char smem[];
    run_phase<PH>(p, layer, smem);
}
#endif

extern "C" void kernel_launch(void* const* d_in, const int* in_sizes, int n_in, void* d_out, int out_size, void* d_ws, size_t ws_size, hipStream_t stream) {
    if (n_in != 38 || ws_size < WS_NEED) { fprintf(stderr, "kernel_launch: bad args n_in %d ws %zu need %zu\n", n_in, ws_size, (size_t)WS_NEED); return; }
    Params p{};
    const float** pp = (const float**)&p;
    for (int i = 0; i < 38; ++i) pp[i] = (const float*)d_in[i];
    p.out = (float*)d_out; p.ws = (char*)d_ws;
    static int cus = 0;
    if (!cus) { int dev = 0; hipGetDevice(&dev); hipDeviceGetAttribute(&cus, hipDeviceAttributeMultiprocessorCount, dev); if (cus <= 0) cus = 256; }
    const int grid = cus;
#if ONE_LAUNCH
    hipFuncSetAttribute((const void*)mega, hipFuncAttributeMaxDynamicSharedMemorySize, LDS_BYTES + 16);
    hipMemsetAsync(d_ws, 0, XCD_BAR_WORDS * sizeof(unsigned), stream);
    hipLaunchKernelGGL(mega, dim3(grid), dim3(NTHR), LDS_BYTES + 16, stream, p);
#else
#define LAUNCH(PH, L) do { hipFuncSetAttribute((const void*)kph<PH>, hipFuncAttributeMaxDynamicSharedMemorySize, LDS_BYTES + 16); hipLaunchKernelGGL(kph<PH>, dim3(grid), dim3(NTHR), LDS_BYTES + 16, stream, p, L); } while (0)
    LAUNCH(PH_INIT, 0);
    for (int layer = 0; layer < 4; ++layer) {
        if ((layer & 1) == 0) { LAUNCH(PH_A_NORM, layer); LAUNCH(PH_A_Z, layer); LAUNCH(PH_A_MID, layer); LAUNCH(PH_A_QKV, layer); LAUNCH(PH_A_POST, layer); LAUNCH(PH_A_ATTN, layer); LAUNCH(PH_A_WO, layer); }
        else { LAUNCH(PH_R_NORM, layer); LAUNCH(PH_R_XS, layer); LAUNCH(PH_R_G1, layer); LAUNCH(PH_R_G2, layer); LAUNCH(PH_R_PREP, layer); LAUNCH(PH_R_SCAN, layer); LAUNCH(PH_R_OUT, layer); LAUNCH(PH_R_WO, layer); }
        LAUNCH(PH_M_NORM, layer); LAUNCH(PH_M_SEL, layer); LAUNCH(PH_M_GATHER, layer); LAUNCH(PH_M_G1, layer); LAUNCH(PH_M_G2, layer); LAUNCH(PH_M_COMB, layer);
    }
    LAUNCH(PH_FINAL, 0);
#endif
}
```

```cpp
#include <hip/hip_runtime.h>
#include <stdint.h>
#include <stdio.h>

#ifndef ONE_LAUNCH
#define ONE_LAUNCH 1
#endif

#define NTHR 512
typedef unsigned short bf16_t;
typedef short bf16x8 __attribute__((ext_vector_type(8)));
typedef float f32x4 __attribute__((ext_vector_type(4)));
typedef unsigned u32x4 __attribute__((ext_vector_type(4)));

constexpr int D = 1024, NB = 4, TL = 4096, TC = 256, NLAT = NB * TL, NCTX = NB * TC, NROW = NLAT + NCTX;
constexpr int TK = TL + TC;
constexpr int NE = 16, FF = 1408, CAPL = 512, CAPC = 32, ESLOTS = NB * CAPL + NB * CAPC;
constexpr int EPAD = 2304;
constexpr float RMS_EPS = 1e-6f, LNX_EPS = 64e-5f;
constexpr float ATT_SCALE = 0.07216878364870322f;

constexpr size_t al256(size_t x) { return (x + 255) / 256 * 256; }
constexpr size_t OFF_BAR = 0;
constexpr size_t OFF_MOD = 16384;
constexpr size_t OFF_ROPE_C = OFF_MOD + al256(4 * 5 * 6144 * 4);
constexpr size_t OFF_ROPE_S = OFF_ROPE_C + al256(TL * 32 * 4);
constexpr size_t OFF_X = OFF_ROPE_S + al256(TL * 32 * 4);
constexpr size_t SZ_F32 = (size_t)NROW * D * 4, SZ_BF = (size_t)NROW * D * 2;
constexpr size_t OFF_VFIRST = OFF_X + SZ_F32;
constexpr size_t OFF_H = OFF_VFIRST + SZ_F32;
constexpr size_t OFF_W13T = OFF_H + SZ_BF;
constexpr size_t OFF_W2T = OFF_W13T + (size_t)NE * 2816 * D * 2;
constexpr size_t OFF_S = OFF_W2T + (size_t)NE * D * FF * 2;
constexpr size_t OFF_Z = OFF_S;
constexpr size_t OFF_CQN = OFF_Z + al256((size_t)NROW * 448 * 4);
constexpr size_t OFF_CKVN = OFF_CQN + al256((size_t)NROW * 256 * 2);
constexpr size_t OFF_KR = OFF_CKVN + al256((size_t)NROW * 128 * 2);
constexpr size_t OFF_QRAW = OFF_KR + al256((size_t)NROW * 64 * 4);
constexpr size_t OFF_KVRAW = OFF_QRAW + al256((size_t)NROW * 1536 * 4);
constexpr size_t OFF_Q = OFF_KVRAW + al256((size_t)NROW * 2048 * 4);
constexpr size_t OFF_K = OFF_Q + al256((size_t)NB * 8 * TK * 192 * 2);
constexpr size_t OFF_V = OFF_K + al256((size_t)NB * 8 * TK * 192 * 2);
constexpr size_t OFF_O = OFF_V + al256((size_t)NB * 8 * TK * 128 * 2);
constexpr size_t END_MLA = OFF_O + SZ_BF;
constexpr size_t OFF_HF = OFF_S;
constexpr size_t OFF_XS = OFF_HF + SZ_F32;
constexpr size_t OFF_RKV = OFF_XS + 6 * SZ_BF;
constexpr size_t OFF_W = OFF_RKV + 3 * SZ_F32;
constexpr size_t OFF_AV = OFF_W + 2 * SZ_F32;
constexpr size_t OFF_KD = OFF_AV + 2 * SZ_F32;
constexpr size_t OFF_G = OFF_KD + 2 * SZ_F32;
constexpr size_t OFF_LW = OFF_G + SZ_F32;
constexpr size_t OFF_LA = OFF_LW + al256((size_t)NROW * 128 * 2);
constexpr size_t OFF_LG = OFF_LA + al256((size_t)NROW * 128 * 2);
constexpr size_t OFF_LV = OFF_LG + al256((size_t)NROW * 128 * 2);
constexpr size_t END_RW = OFF_LV + al256((size_t)NROW * 32 * 2);
constexpr size_t OFF_Y = OFF_HF;
constexpr size_t OFF_AFF = OFF_S;
constexpr size_t OFF_ROWIDX = OFF_AFF + al256((size_t)NROW * 16 * 4);
constexpr size_t OFF_GATE = OFF_ROWIDX + al256((size_t)NE * ESLOTS * 4);
constexpr size_t OFF_SLOT = OFF_GATE + al256((size_t)NE * EPAD * 4);
constexpr size_t OFF_XE = OFF_SLOT + al256((size_t)NROW * 16 * 4);
constexpr size_t OFF_HID = OFF_XE + al256((size_t)NE * EPAD * D * 2);
constexpr size_t OFF_YE = OFF_HID + al256((size_t)NE * EPAD * FF * 2);
constexpr size_t END_MOE = OFF_YE + al256((size_t)NE * EPAD * D * 2);
constexpr size_t WS_NEED = END_RW > END_MLA ? (END_RW > END_MOE ? END_RW : END_MOE) : (END_MLA > END_MOE ? END_MLA : END_MOE);

constexpr int LDS_BYTES = 131072;

struct Params {
    const float *x, *c, *ctx, *c_ctx, *mod_w, *mod_b, *norm1_g, *norm2_g, *final_g;
    const float *mla_w_in, *mla_g_q, *mla_g_kv, *mla_w_uq, *mla_w_ukv, *mla_w_o;
    const float *rw_mu, *rw_w_rkv, *rw_w0, *rw_w1, *rw_w2, *rw_a0, *rw_a1, *rw_a2, *rw_v0, *rw_v1, *rw_v2, *rw_g1, *rw_g2, *rw_k_k, *rw_k_a, *rw_r_k, *rw_lnx_g, *rw_lnx_b, *rw_w_o;
    const float *moe_router, *moe_w1, *moe_w3, *moe_w2;
    float* out; char* ws;
};

__device__ __forceinline__ int tidx() { int t = threadIdx.x; asm volatile("" : "+v"(t)); return t; }
#define XB_TMO      128
#define XB_XCNT(j)  (256  + 64 * (j))
#define XB_XSUB(j)  (1280 + 64 * (j))
#define XB_XGEN(j)  (2304 + 64 * (j))
#define XB_TOP      3328
#define XB_TOPGEN   3392
#define XCD_BAR_WORDS 3456
#define XB_SPIN_CAP (1u << 22)
#define LAS __attribute__((address_space(3)))

__device__ __forceinline__ unsigned xb_ld(unsigned* p)              { return __hip_atomic_load(p, __ATOMIC_RELAXED, __HIP_MEMORY_SCOPE_AGENT); }
__device__ __forceinline__ unsigned xb_add(unsigned* p, unsigned v) { return __hip_atomic_fetch_add(p, v, __ATOMIC_RELAXED, __HIP_MEMORY_SCOPE_AGENT); }
__device__ __forceinline__ unsigned xb_xcc_id() { return (unsigned)__builtin_amdgcn_s_getreg((3 << 11) | 20) & 0xFu; }
#define XB_SPIN(cond, bar) do { unsigned _sp = 0; while (cond) { __builtin_amdgcn_s_sleep(1); \
    if ((++_sp & 255u) == 0u) { if (xb_ld(&(bar)[XB_TMO])) break; if (_sp > XB_SPIN_CAP) { atomicAdd(&(bar)[XB_TMO], 1u); break; } } } } while (0)

struct XcdBarrier { unsigned* bar; unsigned x; volatile LAS unsigned* st; };

__device__ __forceinline__ XcdBarrier xcd_barrier_post(unsigned* bar, volatile LAS unsigned* st) {
    XcdBarrier b; b.bar = bar; b.x = xb_xcc_id(); b.st = st;
    if (tidx() == 0) (void)xb_add(&bar[XB_XCNT(b.x)], 1u);
    return b;
}
__device__ __forceinline__ void xcd_barrier_complete(unsigned* bar, unsigned x, unsigned& nloc, unsigned& nx) {
    const unsigned G = gridDim.x * gridDim.y * gridDim.z;
    unsigned sum, cnt, mine, sp = 0u;
    for (;;) {
        sum = 0u; cnt = 0u; mine = 0u;
#pragma unroll
        for (unsigned j = 0; j < 16; ++j) { const unsigned c = xb_ld(&bar[XB_XCNT(j)]); sum += c; cnt += (c > 0u) ? 1u : 0u; mine = (j == x) ? c : mine; }
        if (sum == G) break;
        __builtin_amdgcn_s_sleep(1);
        if ((++sp & 255u) == 0u) { if (xb_ld(&bar[XB_TMO])) break; if (sp > XB_SPIN_CAP) { atomicAdd(&bar[XB_TMO], 1u); break; } }
    }
    nloc = mine > 0u ? mine : 1u; nx = cnt > 0u ? cnt : 1u;
}
__device__ __forceinline__ void xcd_barrier(const XcdBarrier& b) {
    asm volatile("s_waitcnt vmcnt(0)" ::: "memory");
    __syncthreads();
    if (tidx() == 0) {
        unsigned* bar = b.bar;
        __builtin_amdgcn_s_waitcnt(0);
        unsigned nloc = b.st[0], nx = b.st[1];
        if (nloc == 0u) { xcd_barrier_complete(bar, b.x, nloc, nx); b.st[0] = nloc; b.st[1] = nx; }
        const unsigned old = xb_add(&bar[XB_XSUB(b.x)], 1u);
        const unsigned gen = old / nloc;
        if (old + 1u == (gen + 1u) * nloc) {
            __builtin_amdgcn_fence(__ATOMIC_RELEASE, "agent");
            asm volatile("s_waitcnt vmcnt(0)" ::: "memory");
            const unsigned og = xb_add(&bar[XB_TOP], 1u);
            const unsigned tg = og / nx;
            if (og + 1u == (tg + 1u) * nx) xb_add(&bar[XB_TOPGEN], 1u);
            else XB_SPIN(xb_ld(&bar[XB_TOPGEN]) == tg, bar);
            __builtin_amdgcn_fence(__ATOMIC_ACQUIRE, "agent");
            xb_add(&bar[XB_XGEN(b.x)], 1u);
            asm volatile("s_waitcnt vmcnt(0)" ::: "memory");
        } else {
            XB_SPIN(xb_ld(&bar[XB_XGEN(b.x)]) == gen, bar);
            __builtin_amdgcn_fence(__ATOMIC_ACQUIRE, "agent");
            asm volatile("s_waitcnt vmcnt(0)" ::: "memory");
        }
    }
    __syncthreads();
}

__device__ __forceinline__ bf16_t f2bf(float f) { unsigned u = __float_as_uint(f); u += 0x7FFFu + ((u >> 16) & 1u); return (bf16_t)(u >> 16); }
__device__ __forceinline__ float bf2f(bf16_t b) { return __uint_as_float(((unsigned)b) << 16); }
__device__ __forceinline__ unsigned pk2(float lo, float hi) { return (unsigned)f2bf(lo) | ((unsigned)f2bf(hi) << 16); }
__device__ __forceinline__ float wave_sum(float v) { for (int o = 32; o >= 1; o >>= 1) v += __shfl_xor(v, o); return v; }
__device__ __forceinline__ float sigmoidf_(float x) { return 1.f / (1.f + expf(-x)); }
__device__ __forceinline__ int row_stream(int row) { return row < NLAT ? (row >> 12) : 4; }
__device__ __forceinline__ const float* modp(const Params& p, int layer, int s, int part) { return (const float*)(p.ws + OFF_MOD) + ((size_t)layer * 5 + s) * 6144 + part * 1024; }

struct SgArgs { const bf16_t* A; int lda; size_t strideA; const float* B; int ldb; size_t strideB; int M, N, K, nbatch; };
template <class Epi>
__device__ __forceinline__ void sg_gemm(char* lds, const SgArgs g, const Epi& epi) {
    bf16_t* As = (bf16_t*)lds;
    bf16_t* Bs = As + 128 * 40;
    const int tid = tidx(), wid = tid >> 6, lane = tid & 63;
    const int wr = wid >> 2, wc = wid & 3;
    const int tilesN = (g.N + 127) / 128, tilesM = g.M / 128, per = tilesM * tilesN, ntiles = per * g.nbatch;
    const int ar = tid >> 2, ak = (tid & 3) * 8;
    const int bn = tid & 127, bk = (tid >> 7) * 8;
    for (int tile = blockIdx.x; tile < ntiles; tile += gridDim.x) {
        const int bt = tile / per, tt = tile % per;
        const int tm = tt / tilesN, tn = tt % tilesN;
        const int m0 = tm * 128, n0 = tn * 128;
        f32x4 acc[4][2];
#pragma unroll
        for (int m = 0; m < 4; ++m)
#pragma unroll
            for (int n = 0; n < 2; ++n) acc[m][n] = (f32x4){0.f, 0.f, 0.f, 0.f};
        const bool bvalid = (n0 + bn) < g.N;
        const bf16_t* ap = g.A + bt * g.strideA + (size_t)(m0 + ar) * g.lda + ak;
        const float* bp = g.B + bt * g.strideB + (size_t)bk * g.ldb + n0 + bn;
        bf16x8 areg; float breg[8];
        areg = *(const bf16x8*)ap;
#pragma unroll
        for (int j = 0; j < 8; ++j) breg[j] = bvalid ? bp[(size_t)j * g.ldb] : 0.f;
        for (int k0 = 0; k0 < g.K; k0 += 32) {
            __syncthreads();
            *(bf16x8*)(As + ar * 40 + ak) = areg;
            { u32x4 w; w.x = pk2(breg[0], breg[1]); w.y = pk2(breg[2], breg[3]); w.z = pk2(breg[4], breg[5]); w.w = pk2(breg[6], breg[7]); *(u32x4*)(Bs + bn * 40 + bk) = w; }
            __syncthreads();
            if (k0 + 32 < g.K) {
                areg = *(const bf16x8*)(ap + k0 + 32);
#pragma unroll
                for (int j = 0; j < 8; ++j) breg[j] = bvalid ? bp[(size_t)(k0 + 32 + j) * g.ldb] : 0.f;
            }
            bf16x8 af[4], bfr[2];
#pragma unroll
            for (int m = 0; m < 4; ++m) af[m] = *(const bf16x8*)(As + (wr * 64 + m * 16 + (lane & 15)) * 40 + (lane >> 4) * 8);
#pragma unroll
            for (int n = 0; n < 2; ++n) bfr[n] = *(const bf16x8*)(Bs + (wc * 32 + n * 16 + (lane & 15)) * 40 + (lane >> 4) * 8);
#pragma unroll
            for (int m = 0; m < 4; ++m)
#pragma unroll
                for (int n = 0; n < 2; ++n) acc[m][n] = __builtin_amdgcn_mfma_f32_16x16x32_bf16(af[m], bfr[n], acc[m][n], 0, 0, 0);
        }
#pragma unroll
        for (int m = 0; m < 4; ++m)
#pragma unroll
            for (int n = 0; n < 2; ++n) {
                const int col = n0 + wc * 32 + n * 16 + (lane & 15);
                if (col < g.N) {
#pragma unroll
                    for (int r = 0; r < 4; ++r) epi(bt, m0 + wr * 64 + m * 16 + (lane >> 4) * 4 + r, col, acc[m][n][r]);
                }
            }
    }
}


namespace g8 {
#define PG8_LAS __attribute__((address_space(3)))
constexpr int BM = 256, BK = 64, HALF = 128, HTB = HALF * BK * 2, STAGE_BYTES = 8 * HTB;
__device__ __forceinline__ int lds_byte(int r, int c) { const int st = (r >> 4) * 2 + (c >> 5), rr = r & 15, cc = c & 31, ob = rr * 64 + cc * 2; return st * 1024 + (ob ^ (((ob >> 9) & 1) << 5)); }
__device__ __forceinline__ void stage_rc(int b, int& R, int& C) { const int st = b / 1024, sb = b % 1024, swz = sb ^ (((sb >> 9) & 1) << 5); R = (st >> 1) * 16 + swz / 64; C = (st & 1) * 32 + (swz % 64) / 2; }
struct Unit { int pm, pn, g; const char* A; const char* B; };
__device__ __forceinline__ int xcd_remap(int L, int nwg) { const int q = nwg / 8, r = nwg % 8, xcd = L % 8, off = L / 8; return (xcd < r ? xcd * (q + 1) : r * (q + 1) + (xcd - r) * q) + off; }

template <class Epi, class Sched>
__device__ __forceinline__ void gemm_phase(PG8_LAS unsigned char* lds, const int K, const Sched& S, const Epi& E) {
    const int tid = tidx(), wid = __builtin_amdgcn_readfirstlane(tid >> 6), lane = tid & 63, wr = wid >> 2, wc = wid & 3, fr = lane & 15, fq = lane >> 4;
    const int nt = K / BK;
    unsigned voffA[2];
#pragma unroll
    for (int i = 0; i < 2; ++i) { int R, C; stage_rc(tid * 16 + i * 8192, R, C); voffA[i] = (unsigned)(R * K + C) * 2u; }
    const size_t kstep = (size_t)(BK * 2);
    const size_t hstep = (size_t)HALF * K * 2;
    const unsigned ldsw = (unsigned)wid * 1024u;
    const int aoff = lds_byte(wr * 64 + fr, fq * 8), boff = lds_byte(wc * 32 + fr, fq * 8);
#define PG8_SA(b, h) (((b) * 2 + (h)) * HTB)
#define PG8_SB(b, h) ((4 + (b) * 2 + (h)) * HTB)
#define PG8_STAGE(bufoff, gbase, voff) do { _Pragma("unroll") for (int _i = 0; _i < 2; ++_i) \
        __builtin_amdgcn_global_load_lds((const unsigned*)((const char*)(gbase) + (voff)[_i]), (PG8_LAS unsigned*)(lds + (bufoff) + ldsw + _i * 8192), 16, 0, 0); } while (0)
#define PG8_LDA(dst, b, h) do { _Pragma("unroll") for (int m = 0; m < 4; ++m) _Pragma("unroll") for (int k = 0; k < 2; ++k) dst[m][k] = *(const PG8_LAS bf16x8*)(lds + PG8_SA(b, h) + aoff + m * 2048 + k * 1024); } while (0)
#define PG8_LDB(dst, b, h) do { _Pragma("unroll") for (int n = 0; n < 2; ++n) _Pragma("unroll") for (int k = 0; k < 2; ++k) dst[n][k] = *(const PG8_LAS bf16x8*)(lds + PG8_SB(b, h) + boff + n * 2048 + k * 1024); } while (0)
#define PG8_MMA(ai, bj, At, Bt) do { __builtin_amdgcn_s_setprio(1); _Pragma("unroll") for (int m = 0; m < 4; ++m) _Pragma("unroll") for (int n = 0; n < 2; ++n) _Pragma("unroll") for (int k = 0; k < 2; ++k) \
        acc[ai][bj][m][n] = __builtin_amdgcn_mfma_f32_16x16x32_bf16(Bt[n][k], At[m][k], acc[ai][bj][m][n], 0, 0, 0); __builtin_amdgcn_s_setprio(0); } while (0)
#define PG8_WAIT_V(n) asm volatile("s_waitcnt vmcnt(" #n ")" ::: "memory")
#define PG8_WAIT_L(n) asm volatile("s_waitcnt lgkmcnt(" #n ")" ::: "memory")
#define PG8_BAR __builtin_amdgcn_s_barrier()
#define PG8_SCHED __builtin_amdgcn_sched_barrier(0)
    Unit cur, nxt; int ui = 0;
    if (!S.next(0, cur)) return;
    f32x4 acc[2][2][4][2];
#pragma unroll
    for (int a = 0; a < 2; ++a)
#pragma unroll
        for (int b = 0; b < 2; ++b)
#pragma unroll
            for (int m = 0; m < 4; ++m)
#pragma unroll
                for (int n = 0; n < 2; ++n) acc[a][b][m][n] = (f32x4){0.f, 0.f, 0.f, 0.f};
    bf16x8 At[4][2], B0[2][2], B1[2][2];
    const char* cA = cur.A; const char* cB = cur.B;
    PG8_STAGE(PG8_SB(0, 0), cB, voffA); PG8_STAGE(PG8_SA(0, 0), cA, voffA); PG8_STAGE(PG8_SB(0, 1), cB + hstep, voffA); PG8_STAGE(PG8_SA(0, 1), cA + hstep, voffA);
    if (wr == 1) PG8_BAR;
    PG8_WAIT_V(4); PG8_BAR;
    PG8_STAGE(PG8_SB(1, 0), cB + kstep, voffA); PG8_STAGE(PG8_SA(1, 0), cA + kstep, voffA); PG8_STAGE(PG8_SB(1, 1), cB + hstep + kstep, voffA);
    PG8_WAIT_V(6); PG8_BAR;
    for (;;) {
        const bool has_next = S.next(ui + 1, nxt);
        const char* nA = has_next ? nxt.A : cA; const char* nB = has_next ? nxt.B : cB;
        for (int t = 0; t < nt; t += 2) {
            const bool last = (t == nt - 2);
            const char* a1 = cA + (size_t)(t + 1) * kstep;
            const char* a2 = last ? nA : cA + (size_t)(t + 2) * kstep; const char* b2 = last ? nB : cB + (size_t)(t + 2) * kstep;
            const char* a3 = a2 + kstep; const char* b3 = b2 + kstep;
            PG8_LDB(B0, 0, 0); PG8_SCHED; PG8_LDA(At, 0, 0); PG8_STAGE(PG8_SA(1, 1), a1 + hstep, voffA);
            PG8_WAIT_L(8); PG8_BAR; PG8_WAIT_L(0); PG8_MMA(0, 0, At, B0); PG8_BAR; PG8_SCHED;
            PG8_LDB(B1, 0, 1); PG8_STAGE(PG8_SB(0, 0), b2, voffA);
            PG8_BAR; PG8_WAIT_L(0); PG8_MMA(0, 1, At, B1); PG8_BAR;
            PG8_LDA(At, 0, 1); PG8_STAGE(PG8_SA(0, 0), a2, voffA);
            PG8_BAR; PG8_WAIT_L(0); PG8_MMA(1, 0, At, B0); PG8_BAR; PG8_SCHED;
            PG8_STAGE(PG8_SB(0, 1), b2 + hstep, voffA);
            PG8_WAIT_V(6); PG8_BAR; PG8_MMA(1, 1, At, B1); PG8_BAR;
            PG8_LDB(B0, 1, 0); PG8_SCHED; PG8_LDA(At, 1, 0); PG8_STAGE(PG8_SA(0, 1), a2 + hstep, voffA);
            PG8_WAIT_L(8); PG8_BAR; PG8_WAIT_L(0); PG8_MMA(0, 0, At, B0); PG8_BAR; PG8_SCHED;
            PG8_LDB(B1, 1, 1); PG8_STAGE(PG8_SB(1, 0), b3, voffA);
            PG8_BAR; PG8_WAIT_L(0); PG8_MMA(0, 1, At, B1); PG8_BAR;
            PG8_LDA(At, 1, 1); PG8_STAGE(PG8_SA(1, 0), a3, voffA);
            PG8_BAR; PG8_WAIT_L(0); PG8_MMA(1, 0, At, B0); PG8_BAR; PG8_SCHED;
            PG8_STAGE(PG8_SB(1, 1), b3 + hstep, voffA);
            PG8_WAIT_V(6); PG8_BAR; PG8_MMA(1, 1, At, B1); PG8_BAR;
        }
        E(acc, cur, wr, wc, fr, fq);
        if (!has_next) break;
#pragma unroll
        for (int a = 0; a < 2; ++a)
#pragma unroll
            for (int b = 0; b < 2; ++b)
#pragma unroll
                for (int m = 0; m < 4; ++m)
#pragma unroll
                    for (int n = 0; n < 2; ++n) acc[a][b][m][n] = (f32x4){0.f, 0.f, 0.f, 0.f};
        cur = nxt; cA = nA; cB = nB; ++ui;
    }
    PG8_WAIT_V(0);
    if (wr == 0) PG8_BAR;
    PG8_BAR;
#undef PG8_SA
#undef PG8_SB
#undef PG8_STAGE
#undef PG8_LDA
#undef PG8_LDB
#undef PG8_MMA
#undef PG8_WAIT_V
#undef PG8_WAIT_L
#undef PG8_BAR
#undef PG8_SCHED
}
template <class F> struct EpiRC { F f;
    __device__ __forceinline__ void operator()(const f32x4 (&acc)[2][2][4][2], const Unit& u, int wr, int wc, int fr, int fq) const {
#pragma unroll
        for (int ai = 0; ai < 2; ++ai)
#pragma unroll
            for (int m = 0; m < 4; ++m) { const int row = u.pm * BM + ai * HALF + wr * 64 + m * 16 + fr;
#pragma unroll
                for (int bj = 0; bj < 2; ++bj)
#pragma unroll
                    for (int n = 0; n < 2; ++n) f(u, row, u.pn * BM + bj * HALF + wc * 32 + n * 16 + 4 * fq, acc[ai][bj][m][n]); }
    } };
template <class F> __device__ __forceinline__ EpiRC<F> epi_rc(const F& f) { return EpiRC<F>{f}; }
template <class F> struct EpiPair { F f;
    __device__ __forceinline__ void operator()(const f32x4 (&acc)[2][2][4][2], const Unit& u, int wr, int wc, int fr, int fq) const {
#pragma unroll
        for (int ai = 0; ai < 2; ++ai)
#pragma unroll
            for (int m = 0; m < 4; ++m) { const int row = u.pm * BM + ai * HALF + wr * 64 + m * 16 + fr;
#pragma unroll
                for (int n = 0; n < 2; ++n) f(u, row, u.pn * HALF + wc * 32 + n * 16 + 4 * fq, acc[ai][0][m][n], acc[ai][1][m][n]); }
    } };
template <class F> __device__ __forceinline__ EpiPair<F> epi_pair(const F& f) { return EpiPair<F>{f}; }
struct BatchSched { const char* A; const char* B; size_t strideA, strideB; int nM, nN, nb, K;
    __device__ __forceinline__ bool next(int i, Unit& u) const {
        const int nwg = nM * nN * nb; const int L = i * (int)gridDim.x + (int)blockIdx.x; if (L >= nwg) return false;
        const int w = xcd_remap(L, nwg); const int per = nM * nN; u.g = w / per; const int r = w % per; u.pm = r / nN; u.pn = r % nN;
        u.A = A + u.g * strideA + (size_t)u.pm * BM * K * 2; u.B = B + u.g * strideB + (size_t)u.pn * BM * K * 2; return true; } };
}

template <class SrcF, class DRow>
__device__ __forceinline__ void cvt_tiles(char* lds, bf16_t* dst, int Kd, int Nd, int nbatch, size_t dstride, const SrcF& src, const DRow& drow) {
    bf16_t* T = (bf16_t*)lds;
    const int tid = tidx();
    const int tk = Kd / 128, tn = Nd / 64, per = tk * tn, total = per * nbatch;
    for (int t = blockIdx.x; t < total; t += gridDim.x) {
        const int bt = t / per, r = t % per, k0 = (r % tk) * 128, n0 = (r / tk) * 64;
        float4 v[4];
#pragma unroll
        for (int i = 0; i < 4; ++i) { const int k = k0 + i * 32 + (tid >> 4), n = n0 + (tid & 15) * 4; const float* sp = src(bt, k, n); v[i] = sp ? *(const float4*)sp : make_float4(0.f, 0.f, 0.f, 0.f); }
        __syncthreads();
#pragma unroll
        for (int i = 0; i < 4; ++i) { const int k = i * 32 + (tid >> 4), n = (tid & 15) * 4;
            T[(n + 0) * 136 + k] = f2bf(v[i].x); T[(n + 1) * 136 + k] = f2bf(v[i].y); T[(n + 2) * 136 + k] = f2bf(v[i].z); T[(n + 3) * 136 + k] = f2bf(v[i].w); }
        __syncthreads();
        { const int n = tid >> 3, kc = (tid & 7) * 16;
          const u32x4 a = *(const u32x4*)(T + n * 136 + kc), b = *(const u32x4*)(T + n * 136 + kc + 8);
          bf16_t* dp = dst + bt * dstride + (size_t)drow(n0 + n) * Kd + k0 + kc;
          *(u32x4*)dp = a; *(u32x4*)(dp + 8) = b; }
    }
}
__device__ void ph_moe_cvt(const Params& p, int layer, char* lds) {
    const float* w1 = p.moe_w1 + (size_t)layer * NE * D * FF; const float* w3 = p.moe_w3 + (size_t)layer * NE * D * FF; const float* w2 = p.moe_w2 + (size_t)layer * NE * FF * D;
    cvt_tiles(lds, (bf16_t*)(p.ws + OFF_W13T), D, 2816, NE, (size_t)2816 * D,
        [=](int e, int k, int n) -> const float* { const int pn = n >> 8, half = (n >> 7) & 1, c = pn * 128 + (n & 127); return (half ? w3 : w1) + ((size_t)e * D + k) * FF + c; },
        [=](int n) { return n; });
    cvt_tiles(lds, (bf16_t*)(p.ws + OFF_W2T), FF, D, NE, (size_t)D * FF,
        [=](int e, int k, int n) -> const float* { return w2 + ((size_t)e * FF + k) * D + n; },
        [=](int n) { return n; });
}

__device__ void ph_init(const Params& p, char* lds) {
    const int tid = tidx(), gtid = blockIdx.x * NTHR + tid, gsz = gridDim.x * NTHR;
    float4* X4 = (float4*)(p.ws + OFF_X);
    const float4* x4 = (const float4*)p.x; const float4* c4 = (const float4*)p.ctx;
    for (int i = gtid; i < NROW * 256; i += gsz) X4[i] = i < NLAT * 256 ? x4[i] : c4[i - NLAT * 256];
    float* rc = (float*)(p.ws + OFF_ROPE_C); float* rs = (float*)(p.ws + OFF_ROPE_S);
    for (int i = gtid; i < TL * 32; i += gsz) {
        const int t = i >> 5, f = i & 31; const float pos = (float)((f < 16) ? (t >> 6) : (t & 63));
        const float inv = powf(10000.f, -(float)(f & 15) / 16.f); const float ang = pos * inv; rc[i] = cosf(ang); rs[i] = sinf(ang);
    }
    float* sc = (float*)lds;
    float* red = sc + 5 * 1024;
    for (int i = tid; i < 5 * 1024; i += NTHR) { const float v = i < 4096 ? p.c[i] : p.c_ctx[i - 4096]; sc[i] = v / (1.f + expf(-v)); }
    __syncthreads();
    float* MOD = (float*)(p.ws + OFF_MOD);
    for (int item = blockIdx.x; item < 4 * 96; item += gridDim.x) {
        const int l = item / 96, cg = item % 96, col = tid & 63, n = cg * 64 + col, kg = tid >> 6;
        const float* w = p.mod_w + ((size_t)l * 1024 + kg * 128) * 6144 + n;
        float a0 = 0, a1 = 0, a2 = 0, a3 = 0, a4 = 0;
        for (int k = 0; k < 128; ++k) { const float wv = w[(size_t)k * 6144]; const int kk = kg * 128 + k;
            a0 += sc[kk] * wv; a1 += sc[1024 + kk] * wv; a2 += sc[2048 + kk] * wv; a3 += sc[3072 + kk] * wv; a4 += sc[4096 + kk] * wv; }
        float* rr = red + (kg * 64 + col) * 5; rr[0] = a0; rr[1] = a1; rr[2] = a2; rr[3] = a3; rr[4] = a4;
        __syncthreads();
        if (tid < 320) { const int c2 = tid & 63, s = tid >> 6; float sum = 0;
            for (int q = 0; q < 8; ++q) sum += red[(q * 64 + c2) * 5 + s];
            MOD[((size_t)l * 5 + s) * 6144 + cg * 64 + c2] = sum + p.mod_b[l * 6144 + cg * 64 + c2]; }
        __syncthreads();
    }
}

template <bool OUTF32>
__device__ void ph_norm_mod(const Params& p, int layer, const float* g, int part_sh, int part_sc, void* outp) {
    const int wid = tidx() >> 6, lane = tidx() & 63;
    const float* X = (const float*)(p.ws + OFF_X);
    for (int row = blockIdx.x * 8 + wid; row < NROW; row += gridDim.x * 8) {
        const int s = row_stream(row);
        const float* sh = modp(p, layer, s, part_sh); const float* sc = modp(p, layer, s, part_sc);
        const float4* xr = (const float4*)(X + (size_t)row * D);
        float4 v[4]; float ss = 0;
#pragma unroll
        for (int i = 0; i < 4; ++i) { v[i] = xr[lane + i * 64]; ss += v[i].x * v[i].x + v[i].y * v[i].y + v[i].z * v[i].z + v[i].w * v[i].w; }
        ss = wave_sum(ss); const float rs = rsqrtf(ss * (1.f / D) + RMS_EPS);
#pragma unroll
        for (int i = 0; i < 4; ++i) {
            const int d = (lane + i * 64) * 4;
            const float4 gg = *(const float4*)(g + d), a = *(const float4*)(sc + d), b = *(const float4*)(sh + d);
            float4 o; o.x = v[i].x * rs * gg.x * (1.f + a.x) + b.x; o.y = v[i].y * rs * gg.y * (1.f + a.y) + b.y; o.z = v[i].z * rs * gg.z * (1.f + a.z) + b.z; o.w = v[i].w * rs * gg.w * (1.f + a.w) + b.w;
            if (OUTF32) *(float4*)((float*)outp + (size_t)row * D + d) = o;
            else { uint2 w; w.x = pk2(o.x, o.y); w.y = pk2(o.z, o.w); *(uint2*)((bf16_t*)outp + (size_t)row * D + d) = w; }
        }
    }
}

__device__ void ph_mla_mid(const Params& p, int j) {
    const int wid = tidx() >> 6, lane = tidx() & 63;
    const float* Z = (const float*)(p.ws + OFF_Z);
    bf16_t* CQN = (bf16_t*)(p.ws + OFF_CQN); bf16_t* CKVN = (bf16_t*)(p.ws + OFF_CKVN); float* KR = (float*)(p.ws + OFF_KR);
    const float* gq = p.mla_g_q + j * 256; const float* gkv = p.mla_g_kv + j * 128;
    const float* rc = (const float*)(p.ws + OFF_ROPE_C); const float* rs = (const float*)(p.ws + OFF_ROPE_S);
    for (int row = blockIdx.x * 8 + wid; row < NROW; row += gridDim.x * 8) {
        const float* z = Z + (size_t)row * 448;
        const float4 q = *(const float4*)(z + lane * 4);
        const float2 kv = *(const float2*)(z + 256 + lane * 2);
        const float kr = z[384 + lane];
        float sq = wave_sum(q.x * q.x + q.y * q.y + q.z * q.z + q.w * q.w); const float rq = rsqrtf(sq * (1.f / 256.f) + RMS_EPS);
        float sk = wave_sum(kv.x * kv.x + kv.y * kv.y); const float rk = rsqrtf(sk * (1.f / 128.f) + RMS_EPS);
        const float4 g4 = *(const float4*)(gq + lane * 4); const float2 g2 = *(const float2*)(gkv + lane * 2);
        uint2 w; w.x = pk2(q.x * rq * g4.x, q.y * rq * g4.y); w.y = pk2(q.z * rq * g4.z, q.w * rq * g4.w);
        *(uint2*)(CQN + (size_t)row * 256 + lane * 4) = w;
        *(unsigned*)(CKVN + (size_t)row * 128 + lane * 2) = pk2(kv.x * rk * g2.x, kv.y * rk * g2.y);
        float o = kr;
        const float other = __shfl_xor(kr, 32);
        if (row < NLAT) { const int t = row & (TL - 1), i = lane & 31; const float c = rc[t * 32 + i], s = rs[t * 32 + i];
            const float x1 = lane < 32 ? kr : other, x2 = lane < 32 ? other : kr;
            o = lane < 32 ? (x1 * c - x2 * s) : (x1 * s + x2 * c); }
        KR[(size_t)row * 64 + lane] = o;
    }
}

__device__ void ph_qkv_post(const Params& p) {
    const int wid = tidx() >> 6, lane = tidx() & 63;
    const float* QRAW = (const float*)(p.ws + OFF_QRAW); const float* KVRAW = (const float*)(p.ws + OFF_KVRAW); const float* KR = (const float*)(p.ws + OFF_KR);
    bf16_t* Q = (bf16_t*)(p.ws + OFF_Q); bf16_t* K = (bf16_t*)(p.ws + OFF_K); bf16_t* V = (bf16_t*)(p.ws + OFF_V);
    const float* rc = (const float*)(p.ws + OFF_ROPE_C); const float* rs = (const float*)(p.ws + OFF_ROPE_S);
    for (int it = blockIdx.x * 8 + wid; it < NROW * 8; it += gridDim.x * 8) {
        const int row = it >> 3, h = it & 7;
        const bool lat = row < NLAT; const int b = lat ? (row >> 12) : ((row - NLAT) >> 8); const int tk = lat ? 256 + (row & (TL - 1)) : ((row - NLAT) & 255);
        const size_t orow = (size_t)(b * 8 + h) * TK + tk;
        const float* q = QRAW + (size_t)row * 1536 + h * 192;
        const float q0 = q[lane], q1 = q[64 + lane]; float q2 = q[128 + lane];
        const float other = __shfl_xor(q2, 32);
        if (lat) { const int t = row & (TL - 1), i = lane & 31; const float c = rc[t * 32 + i], s = rs[t * 32 + i];
            const float x1 = lane < 32 ? q2 : other, x2 = lane < 32 ? other : q2; q2 = lane < 32 ? (x1 * c - x2 * s) : (x1 * s + x2 * c); }
        bf16_t* qo = Q + orow * 192; qo[lane] = f2bf(q0); qo[64 + lane] = f2bf(q1); qo[128 + lane] = f2bf(q2);
        const float* kv = KVRAW + (size_t)row * 2048 + h * 256;
        bf16_t* ko = K + orow * 192; ko[lane] = f2bf(kv[lane]); ko[64 + lane] = f2bf(kv[64 + lane]); ko[128 + lane] = f2bf(KR[(size_t)row * 64 + lane]);
        bf16_t* vo = V + orow * 128; vo[lane] = f2bf(kv[128 + lane]); vo[64 + lane] = f2bf(kv[192 + lane]);
    }
}

__device__ void ph_attn_naive(const Params& p, char* lds) {
    const int tid = tidx(), qi = tid >> 2, part = tid & 3;
    const bf16_t* Q = (const bf16_t*)(p.ws + OFF_Q); const bf16_t* K = (const bf16_t*)(p.ws + OFF_K); const bf16_t* V = (const bf16_t*)(p.ws + OFF_V);
    bf16_t* O = (bf16_t*)(p.ws + OFF_O);
    bf16_t* Ks = (bf16_t*)lds;
    bf16_t* Vs = Ks + 32 * 192;
    const int nitems = 32 * 34;
    for (int it = blockIdx.x; it < nitems; it += gridDim.x) {
        const int bh = it / 34, qb = it % 34; const int b = bh >> 3, h = bh & 7;
        const int nkeys = qb < 2 ? TC : TK;
        const int tq = qb * 128 + qi;
        const bf16_t* qp = Q + ((size_t)bh * TK + tq) * 192 + part * 48;
        float q[48];
#pragma unroll
        for (int i = 0; i < 48; ++i) q[i] = bf2f(qp[i]) * ATT_SCALE;
        float o[32];
#pragma unroll
        for (int i = 0; i < 32; ++i) o[i] = 0.f;
        float m = -1e30f, l = 0.f;
        for (int k0 = 0; k0 < nkeys; k0 += 32) {
            __syncthreads();
            {
                const bf16_t* kg = K + ((size_t)bh * TK + k0) * 192; const bf16_t* vg = V + ((size_t)bh * TK + k0) * 128;
                for (int c = tid; c < 768; c += NTHR) *(u32x4*)(Ks + c * 8) = *(const u32x4*)(kg + c * 8);
                *(u32x4*)(Vs + tid * 8) = *(const u32x4*)(vg + tid * 8);
            }
            __syncthreads();
#pragma unroll 1
            for (int kg = 0; kg < 32; kg += 8) {
                float s[8]; float tmax = -1e30f;
#pragma unroll
                for (int kk = 0; kk < 8; ++kk) {
                    const bf16_t* kr = Ks + (kg + kk) * 192 + part * 48; float acc = 0.f;
#pragma unroll
                    for (int i = 0; i < 48; ++i) acc += q[i] * bf2f(kr[i]);
                    acc += __shfl_xor(acc, 1); acc += __shfl_xor(acc, 2);
                    s[kk] = acc; tmax = fmaxf(tmax, acc);
                    asm volatile("" ::: "memory");
                }
                const float mn = fmaxf(m, tmax), alpha = expf(m - mn); m = mn; l *= alpha;
#pragma unroll
                for (int i = 0; i < 32; ++i) o[i] *= alpha;
#pragma unroll
                for (int kk = 0; kk < 8; ++kk) {
                    const float pw = expf(s[kk] - mn); l += pw;
                    const bf16_t* vr = Vs + (kg + kk) * 128 + part * 32;
#pragma unroll
                    for (int i = 0; i < 32; ++i) o[i] += pw * bf2f(vr[i]);
                    asm volatile("" ::: "memory");
                }
            }
        }
        const float rl = 1.f / l;
        const int row = qb < 2 ? (NLAT + b * TC + tq) : (b * TL + tq - TC);
        bf16_t* op = O + (size_t)row * D + h * 128 + part * 32;
#pragma unroll
        for (int i = 0; i < 32; ++i) op[i] = f2bf(o[i] * rl);
    }
}

__device__ void ph_norm2_router(const Params& p, int layer, char* lds) {
    const int tid = tidx(), wid = tid >> 6, lane = tid & 63;
    float* rt = (float*)lds;
    const float* rg = p.moe_router + (size_t)layer * D * NE;
    for (int i = tid; i < D * NE / 4; i += NTHR) ((float4*)rt)[i] = ((const float4*)rg)[i];
    __syncthreads();
    const float* X = (const float*)(p.ws + OFF_X); bf16_t* BN = (bf16_t*)(p.ws + OFF_H); float* AFF = (float*)(p.ws + OFF_AFF);
    const float* g = p.norm2_g + layer * D;
    for (int row = blockIdx.x * 8 + wid; row < NROW; row += gridDim.x * 8) {
        const int s = row_stream(row);
        const float* sh = modp(p, layer, s, 3); const float* sc = modp(p, layer, s, 4);
        const float4* xr = (const float4*)(X + (size_t)row * D);
        float4 v[4]; float ss = 0;
#pragma unroll
        for (int i = 0; i < 4; ++i) { v[i] = xr[lane + i * 64]; ss += v[i].x * v[i].x + v[i].y * v[i].y + v[i].z * v[i].z + v[i].w * v[i].w; }
        ss = wave_sum(ss); const float rs = rsqrtf(ss * (1.f / D) + RMS_EPS);
        float lg[16];
#pragma unroll
        for (int e = 0; e < 16; ++e) lg[e] = 0.f;
#pragma unroll
        for (int i = 0; i < 4; ++i) {
            const int d = (lane + i * 64) * 4;
            const float4 gg = *(const float4*)(g + d), a = *(const float4*)(sc + d), b = *(const float4*)(sh + d);
            float o[4]; o[0] = v[i].x * rs * gg.x * (1.f + a.x) + b.x; o[1] = v[i].y * rs * gg.y * (1.f + a.y) + b.y; o[2] = v[i].z * rs * gg.z * (1.f + a.z) + b.z; o[3] = v[i].w * rs * gg.w * (1.f + a.w) + b.w;
            uint2 w; w.x = pk2(o[0], o[1]); w.y = pk2(o[2], o[3]); *(uint2*)(BN + (size_t)row * D + d) = w;
#pragma unroll
            for (int jj = 0; jj < 4; ++jj) { const float* rr = rt + (d + jj) * 16;
#pragma unroll
                for (int e = 0; e < 16; ++e) lg[e] += o[jj] * rr[e];
                asm volatile("" ::: "memory"); }
        }
        float mx = -1e30f;
#pragma unroll
        for (int e = 0; e < 16; ++e) { lg[e] = wave_sum(lg[e]); mx = fmaxf(mx, lg[e]); }
        float sum = 0;
#pragma unroll
        for (int e = 0; e < 16; ++e) { lg[e] = expf(lg[e] - mx); sum += lg[e]; }
        const float inv = 1.f / sum;
        if (lane < 16) { float val = 0;
#pragma unroll
            for (int e = 0; e < 16; ++e) val = (lane == e) ? lg[e] : val;
            AFF[(size_t)row * 16 + lane] = val * inv; }
    }
}

__device__ void ph_select(const Params& p, char* lds) {
    const int tid = tidx();
    float* vals = (float*)lds;
    const float* AFF = (const float*)(p.ws + OFF_AFF);
    int* ROWIDX = (int*)(p.ws + OFF_ROWIDX); float* GATE = (float*)(p.ws + OFF_GATE); int* SLOT = (int*)(p.ws + OFF_SLOT);
    for (int gidx = blockIdx.x; gidx < 128; gidx += gridDim.x) {
        const bool lat = gidx < 64; const int b = (gidx & 63) >> 4, e = gidx & 15;
        const int n = lat ? TL : TC, cap = lat ? CAPL : CAPC;
        const int row0 = lat ? b * TL : NLAT + b * TC, slot0 = lat ? b * CAPL : NB * CAPL + b * CAPC;
        __syncthreads();
        for (int i = tid; i < n; i += NTHR) vals[i] = AFF[(size_t)(row0 + i) * 16 + e];
        __syncthreads();
        for (int i = tid; i < n; i += NTHR) {
            const float v = vals[i]; int rank = 0;
            for (int jj = 0; jj < n; ++jj) { const float u = vals[jj]; rank += (u > v || (u == v && jj < i)) ? 1 : 0; }
            if (rank < cap) { ROWIDX[e * ESLOTS + slot0 + rank] = row0 + i; GATE[e * EPAD + slot0 + rank] = v; SLOT[(size_t)(row0 + i) * 16 + e] = slot0 + rank; }
            else SLOT[(size_t)(row0 + i) * 16 + e] = -1;
        }
    }
}

__device__ void ph_gather(const Params& p) {
    const int wid = tidx() >> 6, lane = tidx() & 63;
    const int* ROWIDX = (const int*)(p.ws + OFF_ROWIDX); const bf16_t* BN = (const bf16_t*)(p.ws + OFF_H); bf16_t* XE = (bf16_t*)(p.ws + OFF_XE);
    for (int it = blockIdx.x * 8 + wid; it < NE * ESLOTS; it += gridDim.x * 8) {
        const int row = ROWIDX[it]; const int e = it / ESLOTS, sl = it % ESLOTS;
        const u32x4* src = (const u32x4*)(BN + (size_t)row * D); u32x4* dst = (u32x4*)(XE + ((size_t)e * EPAD + sl) * D);
        dst[lane] = src[lane]; dst[lane + 64] = src[lane + 64];
    }
}

__device__ void ph_combine(const Params& p, int layer) {
    const int wid = tidx() >> 6, lane = tidx() & 63;
    const int* SLOT = (const int*)(p.ws + OFF_SLOT); const bf16_t* YE = (const bf16_t*)(p.ws + OFF_YE); float* X = (float*)(p.ws + OFF_X);
    for (int row = blockIdx.x * 8 + wid; row < NROW; row += gridDim.x * 8) {
        const float* gt = modp(p, layer, row_stream(row), 5);
        float acc[16];
#pragma unroll
        for (int i = 0; i < 16; ++i) acc[i] = 0.f;
        for (int e = 0; e < NE; ++e) {
            const int s = SLOT[(size_t)row * 16 + e];
            if (s >= 0) { const bf16_t* y = YE + ((size_t)e * EPAD + s) * D + lane * 16;
                const u32x4 a = *(const u32x4*)y, b = *(const u32x4*)(y + 8);
                const unsigned w[8] = {a.x, a.y, a.z, a.w, b.x, b.y, b.z, b.w};
#pragma unroll
                for (int i = 0; i < 8; ++i) { acc[2 * i] += __uint_as_float(w[i] << 16); acc[2 * i + 1] += __uint_as_float(w[i] & 0xffff0000u); } }
        }
        float* xr = X + (size_t)row * D + lane * 16; const float* g = gt + lane * 16;
#pragma unroll
        for (int i = 0; i < 16; i += 4) { float4 xv = *(float4*)(xr + i); const float4 gv = *(const float4*)(g + i);
            xv.x += gv.x * acc[i]; xv.y += gv.y * acc[i + 1]; xv.z += gv.z * acc[i + 2]; xv.w += gv.w * acc[i + 3]; *(float4*)(xr + i) = xv; }
    }
}

__device__ void ph_rw_xs(const Params& p, int j) {
    const float* HF = (const float*)(p.ws + OFF_HF); bf16_t* XS = (bf16_t*)(p.ws + OFF_XS);
    const float* mu = p.rw_mu + (size_t)j * 6 * D;
    const int gtid = blockIdx.x * NTHR + tidx(), gsz = gridDim.x * NTHR;
    for (int i = gtid; i < NROW * 256; i += gsz) {
        const int row = i >> 8, d = (i & 255) * 4;
        const bool lat = row < NLAT; const int t = lat ? (row & (TL - 1)) : ((row - NLAT) & (TC - 1)); const int len = lat ? TL : TC;
        const float4 h = *(const float4*)(HF + (size_t)row * D + d);
        float4 pv = make_float4(0, 0, 0, 0), nx = make_float4(0, 0, 0, 0);
        if (t > 0) pv = *(const float4*)(HF + (size_t)(row - 1) * D + d);
        if (t < len - 1) nx = *(const float4*)(HF + (size_t)(row + 1) * D + d);
        float4 xx; xx.x = 0.5f * (pv.x + nx.x) - h.x; xx.y = 0.5f * (pv.y + nx.y) - h.y; xx.z = 0.5f * (pv.z + nx.z) - h.z; xx.w = 0.5f * (pv.w + nx.w) - h.w;
#pragma unroll
        for (int m = 0; m < 6; ++m) { const float4 u = *(const float4*)(mu + m * D + d);
            uint2 w; w.x = pk2(h.x + xx.x * u.x, h.y + xx.y * u.y); w.y = pk2(h.z + xx.z * u.z, h.w + xx.w * u.w);
            *(uint2*)(XS + ((size_t)m * NROW + row) * D + d) = w; }
    }
}

__device__ void ph_rw_prep(const Params& p, int j) {
    const int wid = tidx() >> 6, lane = tidx() & 63;
    float* RKV = (float*)(p.ws + OFF_RKV); float* AV = (float*)(p.ws + OFF_AV); float* KD = (float*)(p.ws + OFF_KD);
    const float* k_k = p.rw_k_k + j * D; const float* k_a = p.rw_k_a + j * D;
    for (int row = blockIdx.x * 8 + wid; row < NROW; row += gridDim.x * 8) {
        const size_t o = (size_t)row * D + lane * 16;
        float k[16], kk[16]; float ss = 0;
#pragma unroll
        for (int i = 0; i < 16; ++i) { k[i] = RKV[(size_t)NROW * D + o + i]; kk[i] = k[i] * k_k[lane * 16 + i]; ss += kk[i] * kk[i]; }
        ss += __shfl_xor(ss, 1); ss += __shfl_xor(ss, 2);
        const float inv = 1.f / fmaxf(sqrtf(ss), 1e-12f);
#pragma unroll
        for (int i = 0; i < 16; ++i) kk[i] *= inv;
#pragma unroll
        for (int z = 0; z < 2; ++z)
#pragma unroll
            for (int i = 0; i < 16; ++i) { const float a = AV[(size_t)z * NROW * D + o + i];
                KD[(size_t)z * NROW * D + o + i] = k[i] * (1.f + (a - 1.f) * k_a[lane * 16 + i]);
                AV[(size_t)z * NROW * D + o + i] = kk[i] * a; }
#pragma unroll
        for (int i = 0; i < 16; ++i) RKV[(size_t)NROW * D + o + i] = kk[i];
    }
}

__device__ void ph_rw_scan(const Params& p) {
    const int tid = tidx(), wid = tid >> 6, lane = tid & 63, vr = lane >> 3, ks = lane & 7;
    const float* RKV = (const float*)(p.ws + OFF_RKV); const float* W = (const float*)(p.ws + OFF_W); const float* BBp = (const float*)(p.ws + OFF_AV); const float* KD = (const float*)(p.ws + OFF_KD);
    float* Y = (float*)(p.ws + OFF_Y);
    const size_t PL = (size_t)NROW * D;
    for (int it = blockIdx.x; it < 128; it += gridDim.x) {
        const int z = it & 1, h = (it >> 1) & 15, b = it >> 5;
        float S[8];
#pragma unroll
        for (int i = 0; i < 8; ++i) S[i] = 0.f;
        const int co = h * 64 + ks * 8, vo = h * 64 + wid * 8 + vr;
        for (int ph = 0; ph < 2; ++ph) {
            const int n = ph == 0 ? TC : TL; const int base = ph == 0 ? NLAT + b * TC : b * TL;
            for (int st = 0; st < n; ++st) {
                const int t = z == 0 ? st : n - 1 - st; const size_t ro = (size_t)(base + t) * D;
                float w[8], kk[8], bb[8], kd[8], r[8];
                *(float4*)w = *(const float4*)(W + z * PL + ro + co); *(float4*)(w + 4) = *(const float4*)(W + z * PL + ro + co + 4);
                *(float4*)kk = *(const float4*)(RKV + PL + ro + co); *(float4*)(kk + 4) = *(const float4*)(RKV + PL + ro + co + 4);
                *(float4*)bb = *(const float4*)(BBp + z * PL + ro + co); *(float4*)(bb + 4) = *(const float4*)(BBp + z * PL + ro + co + 4);
                *(float4*)kd = *(const float4*)(KD + z * PL + ro + co); *(float4*)(kd + 4) = *(const float4*)(KD + z * PL + ro + co + 4);
                *(float4*)r = *(const float4*)(RKV + ro + co); *(float4*)(r + 4) = *(const float4*)(RKV + ro + co + 4);
                const float v = RKV[2 * PL + ro + vo];
                float sa = 0;
#pragma unroll
                for (int i = 0; i < 8; ++i) sa -= S[i] * kk[i];
                sa += __shfl_xor(sa, 1); sa += __shfl_xor(sa, 2); sa += __shfl_xor(sa, 4);
                float y = 0;
#pragma unroll
                for (int i = 0; i < 8; ++i) { S[i] = S[i] * w[i] + sa * bb[i] + v * kd[i]; y += S[i] * r[i]; }
                y += __shfl_xor(y, 1); y += __shfl_xor(y, 2); y += __shfl_xor(y, 4);
                if (ks == 0) Y[z * PL + ro + vo] = y;
            }
        }
    }
}

__device__ void ph_rw_out(const Params& p, int j) {
    const int wid = tidx() >> 6, lane = tidx() & 63;
    const float* RKV = (const float*)(p.ws + OFF_RKV); const float* KD = (const float*)(p.ws + OFF_KD); const float* G = (const float*)(p.ws + OFF_G); const float* Y = (const float*)(p.ws + OFF_Y);
    bf16_t* OUT = (bf16_t*)(p.ws + OFF_H);
    const size_t PL = (size_t)NROW * D;
    const float* r_k = p.rw_r_k + j * D; const float* lg = p.rw_lnx_g + j * D; const float* lb = p.rw_lnx_b + j * D;
    for (int row = blockIdx.x * 8 + wid; row < NROW; row += gridDim.x * 8) {
        const size_t o = (size_t)row * D + lane * 16;
        float y[16]; float s = 0;
#pragma unroll
        for (int i = 0; i < 16; ++i) { y[i] = Y[o + i] + Y[PL + o + i]; s += y[i]; }
        s += __shfl_xor(s, 1); s += __shfl_xor(s, 2); const float mean = s * (1.f / 64.f);
        float q = 0;
#pragma unroll
        for (int i = 0; i < 16; ++i) { const float dd = y[i] - mean; q += dd * dd; }
        q += __shfl_xor(q, 1); q += __shfl_xor(q, 2); const float rstd = rsqrtf(q * (1.f / 64.f) + LNX_EPS);
        float bs = 0;
#pragma unroll
        for (int i = 0; i < 16; ++i) bs += RKV[o + i] * (KD[o + i] + KD[PL + o + i]) * r_k[lane * 16 + i];
        bs += __shfl_xor(bs, 1); bs += __shfl_xor(bs, 2);
        unsigned w[8];
#pragma unroll
        for (int i = 0; i < 16; i += 2) {
            const float o0 = ((y[i] - mean) * rstd * lg[lane * 16 + i] + lb[lane * 16 + i] + bs * RKV[2 * PL + o + i]) * G[o + i];
            const float o1 = ((y[i + 1] - mean) * rstd * lg[lane * 16 + i + 1] + lb[lane * 16 + i + 1] + bs * RKV[2 * PL + o + i + 1]) * G[o + i + 1];
            w[i >> 1] = pk2(o0, o1); }
        *(u32x4*)(OUT + o) = (u32x4){w[0], w[1], w[2], w[3]}; *(u32x4*)(OUT + o + 8) = (u32x4){w[4], w[5], w[6], w[7]};
    }
}

__device__ void ph_final(const Params& p) {
    const int wid = tidx() >> 6, lane = tidx() & 63;
    const float* X = (const float*)(p.ws + OFF_X);
    for (int row = blockIdx.x * 8 + wid; row < NLAT; row += gridDim.x * 8) {
        const float4* xr = (const float4*)(X + (size_t)row * D);
        float4 v[4]; float ss = 0;
#pragma unroll
        for (int i = 0; i < 4; ++i) { v[i] = xr[lane + i * 64]; ss += v[i].x * v[i].x + v[i].y * v[i].y + v[i].z * v[i].z + v[i].w * v[i].w; }
        ss = wave_sum(ss); const float rs = rsqrtf(ss * (1.f / D) + RMS_EPS);
#pragma unroll
        for (int i = 0; i < 4; ++i) { const int d = (lane + i * 64) * 4; const float4 gg = *(const float4*)(p.final_g + d);
            float4 o; o.x = v[i].x * rs * gg.x; o.y = v[i].y * rs * gg.y; o.z = v[i].z * rs * gg.z; o.w = v[i].w * rs * gg.w;
            *(float4*)(p.out + (size_t)row * D + d) = o; }
    }
}

enum { PH_INIT = 0, PH_A_NORM, PH_A_Z, PH_A_MID, PH_A_QKV, PH_A_POST, PH_A_ATTN, PH_A_WO,
       PH_R_NORM, PH_R_XS, PH_R_G1, PH_R_G2, PH_R_PREP, PH_R_SCAN, PH_R_OUT, PH_R_WO,
       PH_M_NORM, PH_M_SEL, PH_M_GATHER, PH_M_G1, PH_M_G2, PH_M_COMB, PH_FINAL, PH_M_CVT };

template <int PH>
__device__ __forceinline__ void run_phase(const Params& p, int layer, char* lds) {
    const int j = layer >> 1;
    char* ws = p.ws;
    if constexpr (PH == PH_INIT) ph_init(p, lds);
    else if constexpr (PH == PH_A_NORM) ph_norm_mod<false>(p, layer, p.norm1_g + layer * D, 0, 1, ws + OFF_H);
    else if constexpr (PH == PH_A_Z) {
        float* Z = (float*)(ws + OFF_Z);
        SgArgs g{(const bf16_t*)(ws + OFF_H), D, 0, p.mla_w_in + (size_t)j * D * 448, 448, 0, NROW, 448, D, 1};
        sg_gemm(lds, g, [=](int, int row, int col, float v) { Z[(size_t)row * 448 + col] = v; });
    }
    else if constexpr (PH == PH_A_MID) ph_mla_mid(p, j);
    else if constexpr (PH == PH_A_QKV) {
        float* QRAW = (float*)(ws + OFF_QRAW); float* KVRAW = (float*)(ws + OFF_KVRAW);
        SgArgs g1{(const bf16_t*)(ws + OFF_CQN), 256, 0, p.mla_w_uq + (size_t)j * 256 * 1536, 1536, 0, NROW, 1536, 256, 1};
        sg_gemm(lds, g1, [=](int, int row, int col, float v) { QRAW[(size_t)row * 1536 + col] = v; });
        SgArgs g2{(const bf16_t*)(ws + OFF_CKVN), 128, 0, p.mla_w_ukv + (size_t)j * 128 * 2048, 2048, 0, NROW, 2048, 128, 1};
        sg_gemm(lds, g2, [=](int, int row, int col, float v) { KVRAW[(size_t)row * 2048 + col] = v; });
    }
    else if constexpr (PH == PH_A_POST) ph_qkv_post(p);
    else if constexpr (PH == PH_A_ATTN) ph_attn_naive(p, lds);
    else if constexpr (PH == PH_A_WO || PH == PH_R_WO) {
        float* X = (float*)(ws + OFF_X); const float* MOD = (const float*)(ws + OFF_MOD);
        const bf16_t* A = (const bf16_t*)(ws + (PH == PH_A_WO ? OFF_O : OFF_H));
        const float* B = (PH == PH_A_WO ? p.mla_w_o : p.rw_w_o) + (size_t)j * D * D;
        SgArgs g{A, D, 0, B, D, 0, NROW, D, D, 1};
        sg_gemm(lds, g, [=](int, int row, int col, float v) { const float gt = MOD[((size_t)layer * 5 + row_stream(row)) * 6144 + 2048 + col]; X[(size_t)row * D + col] += gt * v; });
    }
    else if constexpr (PH == PH_R_NORM) ph_norm_mod<true>(p, layer, p.norm1_g + layer * D, 0, 1, ws + OFF_HF);
    else if constexpr (PH == PH_R_XS) ph_rw_xs(p, j);
    else if constexpr (PH == PH_R_G1) {
        const bf16_t* XS = (const bf16_t*)(ws + OFF_XS);
        float* RKV = (float*)(ws + OFF_RKV); float* VF = (float*)(ws + OFF_VFIRST);
        const bool first = (j == 0);
        SgArgs g{XS, D, (size_t)NROW * D, p.rw_w_rkv + (size_t)j * 3 * D * D, D, (size_t)D * D, NROW, D, D, 3};
        sg_gemm(lds, g, [=](int m, int row, int col, float v) { RKV[((size_t)m * NROW + row) * D + col] = v; if (first && m == 2) VF[(size_t)row * D + col] = v; });
        bf16_t* LW = (bf16_t*)(ws + OFF_LW); bf16_t* LA = (bf16_t*)(ws + OFF_LA); bf16_t* LG = (bf16_t*)(ws + OFF_LG); bf16_t* LV = (bf16_t*)(ws + OFF_LV);
        SgArgs gw{XS + (size_t)3 * NROW * D, D, 0, p.rw_w1 + (size_t)j * 2 * D * 64, 64, (size_t)D * 64, NROW, 64, D, 2};
        sg_gemm(lds, gw, [=](int z, int row, int col, float v) { LW[(size_t)row * 128 + z * 64 + col] = f2bf(tanhf(v)); });
        SgArgs ga{XS + (size_t)4 * NROW * D, D, 0, p.rw_a1 + (size_t)j * 2 * D * 64, 64, (size_t)D * 64, NROW, 64, D, 2};
        sg_gemm(lds, ga, [=](int z, int row, int col, float v) { LA[(size_t)row * 128 + z * 64 + col] = f2bf(v); });
        SgArgs gg{XS + (size_t)5 * NROW * D, D, 0, p.rw_g1 + (size_t)j * D * 128, 128, 0, NROW, 128, D, 1};
        sg_gemm(lds, gg, [=](int, int row, int col, float v) { LG[(size_t)row * 128 + col] = f2bf(sigmoidf_(v)); });
        if (!first) {
            SgArgs gv{XS + (size_t)2 * NROW * D, D, 0, p.rw_v1, 32, 0, NROW, 32, D, 1};
            sg_gemm(lds, gv, [=](int, int row, int col, float v) { LV[(size_t)row * 32 + col] = f2bf(v); });
        }
    }
    else if constexpr (PH == PH_R_G2) {
        const bool first = (j == 0);
        float* W = (float*)(ws + OFF_W); float* AV = (float*)(ws + OFF_AV); float* G = (float*)(ws + OFF_G); float* RKV = (float*)(ws + OFF_RKV); const float* VF = (const float*)(ws + OFF_VFIRST);
        const float* w0 = p.rw_w0 + (size_t)j * 2 * D; const float* a0 = p.rw_a0 + (size_t)j * 2 * D; const float* v0 = p.rw_v0;
        SgArgs gw{(const bf16_t*)(ws + OFF_LW), 128, 64, p.rw_w2 + (size_t)j * 2 * 64 * D, D, (size_t)64 * D, NROW, D, 64, 2};
        sg_gemm(lds, gw, [=](int z, int row, int col, float v) { const float wz = v + w0[z * D + col];
            const float sp = (-wz > 20.f) ? -wz : log1pf(expf(-wz));
            W[((size_t)z * NROW + row) * D + col] = expf(-expf(-sp - 0.5f)); });
        SgArgs ga{(const bf16_t*)(ws + OFF_LA), 128, 64, p.rw_a2 + (size_t)j * 2 * 64 * D, D, (size_t)64 * D, NROW, D, 64, 2};
        sg_gemm(lds, ga, [=](int z, int row, int col, float v) { AV[((size_t)z * NROW + row) * D + col] = sigmoidf_(v + a0[z * D + col]); });
        SgArgs gg{(const bf16_t*)(ws + OFF_LG), 128, 0, p.rw_g2 + (size_t)j * 128 * D, D, 0, NROW, D, 128, 1};
        sg_gemm(lds, gg, [=](int, int row, int col, float v) { G[(size_t)row * D + col] = v; });
        if (!first) {
            SgArgs gv{(const bf16_t*)(ws + OFF_LV), 32, 0, p.rw_v2, D, 0, NROW, D, 32, 1};
            sg_gemm(lds, gv, [=](int, int row, int col, float v) { const size_t o = (size_t)row * D + col; const float vv = RKV[(size_t)2 * NROW * D + o];
                RKV[(size_t)2 * NROW * D + o] = vv + (VF[o] - vv) * sigmoidf_(v + v0[col]); });
        }
    }
    else if constexpr (PH == PH_R_PREP) ph_rw_prep(p, j);
    else if constexpr (PH == PH_R_SCAN) ph_rw_scan(p);
    else if constexpr (PH == PH_R_OUT) ph_rw_out(p, j);
    else if constexpr (PH == PH_M_NORM) ph_norm2_router(p, layer, lds);
    else if constexpr (PH == PH_M_SEL) ph_select(p, lds);
    else if constexpr (PH == PH_M_GATHER) ph_gather(p);
    else if constexpr (PH == PH_M_G1) {
        bf16_t* HID = (bf16_t*)(ws + OFF_HID);
        g8::BatchSched S{ws + OFF_XE, ws + OFF_W13T, (size_t)EPAD * D * 2, (size_t)2816 * D * 2, EPAD / 256, 11, NE, D};
        g8::gemm_phase((PG8_LAS unsigned char*)lds, D, S, g8::epi_pair([=](const g8::Unit& u, int row, int col, f32x4 a, f32x4 b) {
            uint2 w; w.x = pk2(a[0] / (1.f + __expf(-a[0])) * b[0], a[1] / (1.f + __expf(-a[1])) * b[1]); w.y = pk2(a[2] / (1.f + __expf(-a[2])) * b[2], a[3] / (1.f + __expf(-a[3])) * b[3]);
            *(uint2*)(HID + ((size_t)u.g * EPAD + row) * FF + col) = w; }));
    }
    else if constexpr (PH == PH_M_G2) {
        bf16_t* YE = (bf16_t*)(ws + OFF_YE); const float* GATE = (const float*)(ws + OFF_GATE);
        g8::BatchSched S{ws + OFF_HID, ws + OFF_W2T, (size_t)EPAD * FF * 2, (size_t)D * FF * 2, EPAD / 256, 4, NE, FF};
        g8::gemm_phase((PG8_LAS unsigned char*)lds, FF, S, g8::epi_rc([=](const g8::Unit& u, int row, int col, f32x4 v) {
            const float gt = GATE[u.g * EPAD + row];
            uint2 w; w.x = pk2(v[0] * gt, v[1] * gt); w.y = pk2(v[2] * gt, v[3] * gt);
            *(uint2*)(YE + ((size_t)u.g * EPAD + row) * D + col) = w; }));
    }
    else if constexpr (PH == PH_M_COMB) ph_combine(p, layer);
    else if constexpr (PH == PH_M_CVT) ph_moe_cvt(p, layer, lds);
    else if constexpr (PH == PH_FINAL) ph_final(p);
}

#if ONE_LAUNCH
#define SYNC() xcd_barrier(bar)
#define RUN(PH) do { Params q = p; asm volatile("" : "+s"(q.ws)); run_phase<PH>(q, layer, smem); SYNC(); } while (0)
__global__ void __launch_bounds__(NTHR, 2) mega(Params p) {
    extern __shared__ __attribute__((aligned(16))) char smem[];
    if (tidx() == 0) *(uint4*)(smem + LDS_BYTES) = make_uint4(0u, 0u, 0u, 0u);
    __syncthreads();
    XcdBarrier bar = xcd_barrier_post((unsigned*)(p.ws + OFF_BAR), (volatile LAS unsigned*)(smem + LDS_BYTES));
    { const int layer = 0; RUN(PH_INIT); }
    for (int layer = 0; layer < 4; ++layer) {
        if ((layer & 1) == 0) {
            RUN(PH_A_NORM);
            RUN(PH_A_Z);
            RUN(PH_A_MID);
            RUN(PH_A_QKV);
            RUN(PH_A_POST);
            RUN(PH_A_ATTN);
            RUN(PH_A_WO);
        } else {
            RUN(PH_R_NORM);
            RUN(PH_R_XS);
            RUN(PH_R_G1);
            RUN(PH_R_G2);
            RUN(PH_R_PREP);
            RUN(PH_R_SCAN);
            RUN(PH_R_OUT);
            RUN(PH_R_WO);
        }
        RUN(PH_M_CVT);
        RUN(PH_M_NORM);
        RUN(PH_M_SEL);
        RUN(PH_M_GATHER);
        RUN(PH_M_G1);
        RUN(PH_M_G2);
        RUN(PH_M_COMB);
    }
    run_phase<PH_FINAL>(p, 0, smem);
}
#else
template <int PH> __global__ void __launch_bounds__(NTHR, 2) kph(Params p, int layer) {
    extern __shared__ __attribute__((aligned(16))) char smem[];
    run_phase<PH>(p, layer, smem);
}
#endif

extern "C" void kernel_launch(void* const* d_in, const int* in_sizes, int n_in, void* d_out, int out_size, void* d_ws, size_t ws_size, hipStream_t stream) {
    if (n_in != 38 || ws_size < WS_NEED) { fprintf(stderr, "kernel_launch: bad args n_in %d ws %zu need %zu\n", n_in, ws_size, (size_t)WS_NEED); return; }
    Params p{};
    const float** pp = (const float**)&p;
    for (int i = 0; i < 38; ++i) pp[i] = (const float*)d_in[i];
    p.out = (float*)d_out; p.ws = (char*)d_ws;
    static int cus = 0;
    if (!cus) { int dev = 0; hipGetDevice(&dev); hipDeviceGetAttribute(&cus, hipDeviceAttributeMultiprocessorCount, dev); if (cus <= 0) cus = 256; }
    const int grid = cus;
#if ONE_LAUNCH
    hipFuncSetAttribute((const void*)mega, hipFuncAttributeMaxDynamicSharedMemorySize, LDS_BYTES + 16);
    hipMemsetAsync(d_ws, 0, XCD_BAR_WORDS * sizeof(unsigned), stream);
    hipLaunchKernelGGL(mega, dim3(grid), dim3(NTHR), LDS_BYTES + 16, stream, p);
#else
#define LAUNCH(PH, L) do { hipFuncSetAttribute((const void*)kph<PH>, hipFuncAttributeMaxDynamicSharedMemorySize, LDS_BYTES + 16); hipLaunchKernelGGL(kph<PH>, dim3(grid), dim3(NTHR), LDS_BYTES + 16, stream, p, L); } while (0)
    LAUNCH(PH_INIT, 0);
    for (int layer = 0; layer < 4; ++layer) {
        if ((layer & 1) == 0) { LAUNCH(PH_A_NORM, layer); LAUNCH(PH_A_Z, layer); LAUNCH(PH_A_MID, layer); LAUNCH(PH_A_QKV, layer); LAUNCH(PH_A_POST, layer); LAUNCH(PH_A_ATTN, layer); LAUNCH(PH_A_WO, layer); }
        else { LAUNCH(PH_R_NORM, layer); LAUNCH(PH_R_XS, layer); LAUNCH(PH_R_G1, layer); LAUNCH(PH_R_G2, layer); LAUNCH(PH_R_PREP, layer); LAUNCH(PH_R_SCAN, layer); LAUNCH(PH_R_OUT, layer); LAUNCH(PH_R_WO, layer); }
        LAUNCH(PH_M_CVT, layer); LAUNCH(PH_M_NORM, layer); LAUNCH(PH_M_SEL, layer); LAUNCH(PH_M_GATHER, layer); LAUNCH(PH_M_G1, layer); LAUNCH(PH_M_G2, layer); LAUNCH(PH_M_COMB, layer);
    }
    LAUNCH(PH_FINAL, 0);
#endif
}
```

```cpp
#include <hip/hip_runtime.h>
#include <stdint.h>
#include <stdio.h>

#ifndef ONE_LAUNCH
#define ONE_LAUNCH 1
#endif

#define NTHR 512
typedef unsigned short bf16_t;
typedef short bf16x8 __attribute__((ext_vector_type(8)));
typedef float f32x4 __attribute__((ext_vector_type(4)));
typedef unsigned u32x4 __attribute__((ext_vector_type(4)));

constexpr int D = 1024, NB = 4, TL = 4096, TC = 256, NLAT = NB * TL, NCTX = NB * TC, NROW = NLAT + NCTX;
constexpr int TK = TL + TC;
constexpr int NE = 16, FF = 1408, CAPL = 512, CAPC = 32, ESLOTS = NB * CAPL + NB * CAPC;
constexpr int EPAD = 2304;
constexpr float RMS_EPS = 1e-6f, LNX_EPS = 64e-5f;
constexpr float ATT_SCALE = 0.07216878364870322f;

constexpr size_t al256(size_t x) { return (x + 255) / 256 * 256; }
constexpr size_t OFF_BAR = 0;
constexpr size_t OFF_MOD = 16384;
constexpr size_t OFF_ROPE_C = OFF_MOD + al256(4 * 5 * 6144 * 4);
constexpr size_t OFF_ROPE_S = OFF_ROPE_C + al256(TL * 32 * 4);
constexpr size_t OFF_X = OFF_ROPE_S + al256(TL * 32 * 4);
constexpr size_t SZ_F32 = (size_t)NROW * D * 4, SZ_BF = (size_t)NROW * D * 2;
constexpr size_t OFF_VFIRST = OFF_X + SZ_F32;
constexpr size_t OFF_H = OFF_VFIRST + SZ_F32;
constexpr size_t SZ_WMLA = (size_t)(512 * 1024 + 1536 * 256 + 2048 * 256 + 1024 * 1024) * 2;
constexpr size_t WM_IN = 0, WM_UQ = (size_t)512 * 1024 * 2, WM_UKV = WM_UQ + (size_t)1536 * 256 * 2, WM_O = WM_UKV + (size_t)2048 * 256 * 2;
constexpr size_t SZ_WRW = (size_t)(3 * 1024 * 1024 + 4 * 256 * 1024 + 1024 * 1024) * 2;
constexpr size_t WR_RKV = 0, WR_L = (size_t)3 * 1024 * 1024 * 2, WR_O = WR_L + (size_t)4 * 256 * 1024 * 2;
constexpr size_t OFF_WMLA = OFF_H + SZ_BF;
constexpr size_t OFF_WRW = OFF_WMLA + 2 * SZ_WMLA;
constexpr size_t OFF_W13T = OFF_WRW + 2 * SZ_WRW;
constexpr size_t OFF_W2T = OFF_W13T + (size_t)NE * 2816 * D * 2;
constexpr size_t OFF_S = OFF_W2T + (size_t)NE * D * FF * 2;
constexpr size_t OFF_Z = OFF_S;
constexpr size_t OFF_CQN = OFF_Z + al256((size_t)NROW * 512 * 4);
constexpr size_t OFF_CKVN = OFF_CQN + al256((size_t)NROW * 256 * 2);
constexpr size_t OFF_KR = OFF_CKVN + al256((size_t)NROW * 256 * 2);
constexpr size_t OFF_QRAW = OFF_KR + al256((size_t)NROW * 64 * 4);
constexpr size_t OFF_KVRAW = OFF_QRAW + al256((size_t)NROW * 1536 * 4);
constexpr size_t OFF_Q = OFF_KVRAW + al256((size_t)NROW * 2048 * 4);
constexpr size_t OFF_K = OFF_Q + al256((size_t)NB * 8 * TK * 192 * 2);
constexpr size_t OFF_V = OFF_K + al256((size_t)NB * 8 * TK * 192 * 2);
constexpr size_t OFF_O = OFF_V + al256((size_t)NB * 8 * TK * 128 * 2);
constexpr size_t END_MLA = OFF_O + SZ_BF;
constexpr size_t OFF_HF = OFF_S;
constexpr size_t OFF_XS = OFF_HF + SZ_F32;
constexpr size_t OFF_RKV = OFF_XS + 6 * SZ_BF;
constexpr size_t OFF_W = OFF_RKV + 3 * SZ_F32;
constexpr size_t OFF_AV = OFF_W + 2 * SZ_F32;
constexpr size_t OFF_KD = OFF_AV + 2 * SZ_F32;
constexpr size_t OFF_G = OFF_KD + 2 * SZ_F32;
constexpr size_t OFF_LW = OFF_G + SZ_F32;
constexpr size_t OFF_LA = OFF_LW + al256((size_t)NROW * 128 * 2);
constexpr size_t OFF_LG = OFF_LA + al256((size_t)NROW * 128 * 2);
constexpr size_t OFF_LV = OFF_LG + al256((size_t)NROW * 128 * 2);
constexpr size_t END_RW = OFF_LV + al256((size_t)NROW * 32 * 2);
constexpr size_t OFF_Y = OFF_HF;
constexpr size_t OFF_AFF = OFF_S;
constexpr size_t OFF_ROWIDX = OFF_AFF + al256((size_t)NROW * 16 * 4);
constexpr size_t OFF_GATE = OFF_ROWIDX + al256((size_t)NE * ESLOTS * 4);
constexpr size_t OFF_SLOT = OFF_GATE + al256((size_t)NE * EPAD * 4);
constexpr size_t OFF_XE = OFF_SLOT + al256((size_t)NROW * 16 * 4);
constexpr size_t OFF_HID = OFF_XE + al256((size_t)NE * EPAD * D * 2);
constexpr size_t OFF_YE = OFF_HID + al256((size_t)NE * EPAD * FF * 2);
constexpr size_t END_MOE = OFF_YE + al256((size_t)NE * EPAD * D * 2);
constexpr size_t WS_NEED = END_RW > END_MLA ? (END_RW > END_MOE ? END_RW : END_MOE) : (END_MLA > END_MOE ? END_MLA : END_MOE);

constexpr int LDS_BYTES = 131072;

struct Params {
    const float *x, *c, *ctx, *c_ctx, *mod_w, *mod_b, *norm1_g, *norm2_g, *final_g;
    const float *mla_w_in, *mla_g_q, *mla_g_kv, *mla_w_uq, *mla_w_ukv, *mla_w_o;
    const float *rw_mu, *rw_w_rkv, *rw_w0, *rw_w1, *rw_w2, *rw_a0, *rw_a1, *rw_a2, *rw_v0, *rw_v1, *rw_v2, *rw_g1, *rw_g2, *rw_k_k, *rw_k_a, *rw_r_k, *rw_lnx_g, *rw_lnx_b, *rw_w_o;
    const float *moe_router, *moe_w1, *moe_w3, *moe_w2;
    float* out; char* ws;
};

__device__ __forceinline__ int tidx() { int t = threadIdx.x; asm volatile("" : "+v"(t)); return t; }
#define XB_TMO      128
#define XB_XCNT(j)  (256  + 64 * (j))
#define XB_XSUB(j)  (1280 + 64 * (j))
#define XB_XGEN(j)  (2304 + 64 * (j))
#define XB_TOP      3328
#define XB_TOPGEN   3392
#define XCD_BAR_WORDS 3456
#define XB_SPIN_CAP (1u << 22)
#define LAS __attribute__((address_space(3)))

__device__ __forceinline__ unsigned xb_ld(unsigned* p)              { return __hip_atomic_load(p, __ATOMIC_RELAXED, __HIP_MEMORY_SCOPE_AGENT); }
__device__ __forceinline__ unsigned xb_add(unsigned* p, unsigned v) { return __hip_atomic_fetch_add(p, v, __ATOMIC_RELAXED, __HIP_MEMORY_SCOPE_AGENT); }
__device__ __forceinline__ unsigned xb_xcc_id() { return (unsigned)__builtin_amdgcn_s_getreg((3 << 11) | 20) & 0xFu; }
#define XB_SPIN(cond, bar) do { unsigned _sp = 0; while (cond) { __builtin_amdgcn_s_sleep(1); \
    if ((++_sp & 255u) == 0u) { if (xb_ld(&(bar)[XB_TMO])) break; if (_sp > XB_SPIN_CAP) { atomicAdd(&(bar)[XB_TMO], 1u); break; } } } } while (0)

struct XcdBarrier { unsigned* bar; unsigned x; volatile LAS unsigned* st; };

__device__ __forceinline__ XcdBarrier xcd_barrier_post(unsigned* bar, volatile LAS unsigned* st) {
    XcdBarrier b; b.bar = bar; b.x = xb_xcc_id(); b.st = st;
    if (tidx() == 0) (void)xb_add(&bar[XB_XCNT(b.x)], 1u);
    return b;
}
__device__ __forceinline__ void xcd_barrier_complete(unsigned* bar, unsigned x, unsigned& nloc, unsigned& nx) {
    const unsigned G = gridDim.x * gridDim.y * gridDim.z;
    unsigned sum, cnt, mine, sp = 0u;
    for (;;) {
        sum = 0u; cnt = 0u; mine = 0u;
#pragma unroll
        for (unsigned j = 0; j < 16; ++j) { const unsigned c = xb_ld(&bar[XB_XCNT(j)]); sum += c; cnt += (c > 0u) ? 1u : 0u; mine = (j == x) ? c : mine; }
        if (sum == G) break;
        __builtin_amdgcn_s_sleep(1);
        if ((++sp & 255u) == 0u) { if (xb_ld(&bar[XB_TMO])) break; if (sp > XB_SPIN_CAP) { atomicAdd(&bar[XB_TMO], 1u); break; } }
    }
    nloc = mine > 0u ? mine : 1u; nx = cnt > 0u ? cnt : 1u;
}
__device__ __forceinline__ void xcd_barrier(const XcdBarrier& b) {
    asm volatile("s_waitcnt vmcnt(0)" ::: "memory");
    __syncthreads();
    if (tidx() == 0) {
        unsigned* bar = b.bar;
        __builtin_amdgcn_s_waitcnt(0);
        unsigned nloc = b.st[0], nx = b.st[1];
        if (nloc == 0u) { xcd_barrier_complete(bar, b.x, nloc, nx); b.st[0] = nloc; b.st[1] = nx; }
        const unsigned old = xb_add(&bar[XB_XSUB(b.x)], 1u);
        const unsigned gen = old / nloc;
        if (old + 1u == (gen + 1u) * nloc) {
            __builtin_amdgcn_fence(__ATOMIC_RELEASE, "agent");
            asm volatile("s_waitcnt vmcnt(0)" ::: "memory");
            const unsigned og = xb_add(&bar[XB_TOP], 1u);
            const unsigned tg = og / nx;
            if (og + 1u == (tg + 1u) * nx) xb_add(&bar[XB_TOPGEN], 1u);
            else XB_SPIN(xb_ld(&bar[XB_TOPGEN]) == tg, bar);
            __builtin_amdgcn_fence(__ATOMIC_ACQUIRE, "agent");
            xb_add(&bar[XB_XGEN(b.x)], 1u);
            asm volatile("s_waitcnt vmcnt(0)" ::: "memory");
        } else {
            XB_SPIN(xb_ld(&bar[XB_XGEN(b.x)]) == gen, bar);
            __builtin_amdgcn_fence(__ATOMIC_ACQUIRE, "agent");
            asm volatile("s_waitcnt vmcnt(0)" ::: "memory");
        }
    }
    __syncthreads();
}

__device__ __forceinline__ bf16_t f2bf(float f) { unsigned u = __float_as_uint(f); u += 0x7FFFu + ((u >> 16) & 1u); return (bf16_t)(u >> 16); }
__device__ __forceinline__ float bf2f(bf16_t b) { return __uint_as_float(((unsigned)b) << 16); }
__device__ __forceinline__ unsigned pk2(float lo, float hi) { return (unsigned)f2bf(lo) | ((unsigned)f2bf(hi) << 16); }
__device__ __forceinline__ float wave_sum(float v) { for (int o = 32; o >= 1; o >>= 1) v += __shfl_xor(v, o); return v; }
__device__ __forceinline__ float sigmoidf_(float x) { return 1.f / (1.f + expf(-x)); }
__device__ __forceinline__ int row_stream(int row) { return row < NLAT ? (row >> 12) : 4; }
__device__ __forceinline__ const float* modp(const Params& p, int layer, int s, int part) { return (const float*)(p.ws + OFF_MOD) + ((size_t)layer * 5 + s) * 6144 + part * 1024; }

struct SgArgs { const bf16_t* A; int lda; size_t strideA; const float* B; int ldb; size_t strideB; int M, N, K, nbatch; };
template <class Epi>
__device__ __forceinline__ void sg_gemm(char* lds, const SgArgs g, const Epi& epi) {
    bf16_t* As = (bf16_t*)lds;
    bf16_t* Bs = As + 128 * 40;
    const int tid = tidx(), wid = tid >> 6, lane = tid & 63;
    const int wr = wid >> 2, wc = wid & 3;
    const int tilesN = (g.N + 127) / 128, tilesM = g.M / 128, per = tilesM * tilesN, ntiles = per * g.nbatch;
    const int ar = tid >> 2, ak = (tid & 3) * 8;
    const int bn = tid & 127, bk = (tid >> 7) * 8;
    for (int tile = blockIdx.x; tile < ntiles; tile += gridDim.x) {
        const int bt = tile / per, tt = tile % per;
        const int tm = tt / tilesN, tn = tt % tilesN;
        const int m0 = tm * 128, n0 = tn * 128;
        f32x4 acc[4][2];
#pragma unroll
        for (int m = 0; m < 4; ++m)
#pragma unroll
            for (int n = 0; n < 2; ++n) acc[m][n] = (f32x4){0.f, 0.f, 0.f, 0.f};
        const bool bvalid = (n0 + bn) < g.N;
        const bf16_t* ap = g.A + bt * g.strideA + (size_t)(m0 + ar) * g.lda + ak;
        const float* bp = g.B + bt * g.strideB + (size_t)bk * g.ldb + n0 + bn;
        bf16x8 areg; float breg[8];
        areg = *(const bf16x8*)ap;
#pragma unroll
        for (int j = 0; j < 8; ++j) breg[j] = bvalid ? bp[(size_t)j * g.ldb] : 0.f;
        for (int k0 = 0; k0 < g.K; k0 += 32) {
            __syncthreads();
            *(bf16x8*)(As + ar * 40 + ak) = areg;
            { u32x4 w; w.x = pk2(breg[0], breg[1]); w.y = pk2(breg[2], breg[3]); w.z = pk2(breg[4], breg[5]); w.w = pk2(breg[6], breg[7]); *(u32x4*)(Bs + bn * 40 + bk) = w; }
            __syncthreads();
            if (k0 + 32 < g.K) {
                areg = *(const bf16x8*)(ap + k0 + 32);
#pragma unroll
                for (int j = 0; j < 8; ++j) breg[j] = bvalid ? bp[(size_t)(k0 + 32 + j) * g.ldb] : 0.f;
            }
            bf16x8 af[4], bfr[2];
#pragma unroll
            for (int m = 0; m < 4; ++m) af[m] = *(const bf16x8*)(As + (wr * 64 + m * 16 + (lane & 15)) * 40 + (lane >> 4) * 8);
#pragma unroll
            for (int n = 0; n < 2; ++n) bfr[n] = *(const bf16x8*)(Bs + (wc * 32 + n * 16 + (lane & 15)) * 40 + (lane >> 4) * 8);
#pragma unroll
            for (int m = 0; m < 4; ++m)
#pragma unroll
                for (int n = 0; n < 2; ++n) acc[m][n] = __builtin_amdgcn_mfma_f32_16x16x32_bf16(af[m], bfr[n], acc[m][n], 0, 0, 0);
        }
#pragma unroll
        for (int m = 0; m < 4; ++m)
#pragma unroll
            for (int n = 0; n < 2; ++n) {
                const int col = n0 + wc * 32 + n * 16 + (lane & 15);
                if (col < g.N) {
#pragma unroll
                    for (int r = 0; r < 4; ++r) epi(bt, m0 + wr * 64 + m * 16 + (lane >> 4) * 4 + r, col, acc[m][n][r]);
                }
            }
    }
}


namespace g8 {
#define PG8_LAS __attribute__((address_space(3)))
constexpr int BM = 256, BK = 64, HALF = 128, HTB = HALF * BK * 2, STAGE_BYTES = 8 * HTB;
__device__ __forceinline__ int lds_byte(int r, int c) { const int st = (r >> 4) * 2 + (c >> 5), rr = r & 15, cc = c & 31, ob = rr * 64 + cc * 2; return st * 1024 + (ob ^ (((ob >> 9) & 1) << 5)); }
__device__ __forceinline__ void stage_rc(int b, int& R, int& C) { const int st = b / 1024, sb = b % 1024, swz = sb ^ (((sb >> 9) & 1) << 5); R = (st >> 1) * 16 + swz / 64; C = (st & 1) * 32 + (swz % 64) / 2; }
struct Unit { int pm, pn, g; const char* A; const char* B; };
__device__ __forceinline__ int xcd_remap(int L, int nwg) { const int q = nwg / 8, r = nwg % 8, xcd = L % 8, off = L / 8; return (xcd < r ? xcd * (q + 1) : r * (q + 1) + (xcd - r) * q) + off; }

template <class Epi, class Sched>
__device__ __forceinline__ void gemm_phase(PG8_LAS unsigned char* lds, const int K, const Sched& S, const Epi& E) {
    const int tid = tidx(), wid = __builtin_amdgcn_readfirstlane(tid >> 6), lane = tid & 63, wr = wid >> 2, wc = wid & 3, fr = lane & 15, fq = lane >> 4;
    const int nt = K / BK;
    unsigned voffA[2];
#pragma unroll
    for (int i = 0; i < 2; ++i) { int R, C; stage_rc(tid * 16 + i * 8192, R, C); voffA[i] = (unsigned)(R * K + C) * 2u; }
    const size_t kstep = (size_t)(BK * 2);
    const size_t hstep = (size_t)HALF * K * 2;
    const unsigned ldsw = (unsigned)wid * 1024u;
    const int aoff = lds_byte(wr * 64 + fr, fq * 8), boff = lds_byte(wc * 32 + fr, fq * 8);
#define PG8_SA(b, h) (((b) * 2 + (h)) * HTB)
#define PG8_SB(b, h) ((4 + (b) * 2 + (h)) * HTB)
#define PG8_STAGE(bufoff, gbase, voff) do { _Pragma("unroll") for (int _i = 0; _i < 2; ++_i) \
        __builtin_amdgcn_global_load_lds((const unsigned*)((const char*)(gbase) + (voff)[_i]), (PG8_LAS unsigned*)(lds + (bufoff) + ldsw + _i * 8192), 16, 0, 0); } while (0)
#define PG8_LDA(dst, b, h) do { _Pragma("unroll") for (int m = 0; m < 4; ++m) _Pragma("unroll") for (int k = 0; k < 2; ++k) dst[m][k] = *(const PG8_LAS bf16x8*)(lds + PG8_SA(b, h) + aoff + m * 2048 + k * 1024); } while (0)
#define PG8_LDB(dst, b, h) do { _Pragma("unroll") for (int n = 0; n < 2; ++n) _Pragma("unroll") for (int k = 0; k < 2; ++k) dst[n][k] = *(const PG8_LAS bf16x8*)(lds + PG8_SB(b, h) + boff + n * 2048 + k * 1024); } while (0)
#define PG8_MMA(ai, bj, At, Bt) do { __builtin_amdgcn_s_setprio(1); _Pragma("unroll") for (int m = 0; m < 4; ++m) _Pragma("unroll") for (int n = 0; n < 2; ++n) _Pragma("unroll") for (int k = 0; k < 2; ++k) \
        acc[ai][bj][m][n] = __builtin_amdgcn_mfma_f32_16x16x32_bf16(Bt[n][k], At[m][k], acc[ai][bj][m][n], 0, 0, 0); __builtin_amdgcn_s_setprio(0); } while (0)
#define PG8_WAIT_V(n) asm volatile("s_waitcnt vmcnt(" #n ")" ::: "memory")
#define PG8_WAIT_L(n) asm volatile("s_waitcnt lgkmcnt(" #n ")" ::: "memory")
#define PG8_BAR __builtin_amdgcn_s_barrier()
#define PG8_SCHED __builtin_amdgcn_sched_barrier(0)
    Unit cur, nxt; int ui = 0;
    if (!S.next(0, cur)) return;
    f32x4 acc[2][2][4][2];
#pragma unroll
    for (int a = 0; a < 2; ++a)
#pragma unroll
        for (int b = 0; b < 2; ++b)
#pragma unroll
            for (int m = 0; m < 4; ++m)
#pragma unroll
                for (int n = 0; n < 2; ++n) acc[a][b][m][n] = (f32x4){0.f, 0.f, 0.f, 0.f};
    bf16x8 At[4][2], B0[2][2], B1[2][2];
    const char* cA = cur.A; const char* cB = cur.B;
    PG8_STAGE(PG8_SB(0, 0), cB, voffA); PG8_STAGE(PG8_SA(0, 0), cA, voffA); PG8_STAGE(PG8_SB(0, 1), cB + hstep, voffA); PG8_STAGE(PG8_SA(0, 1), cA + hstep, voffA);
    if (wr == 1) PG8_BAR;
    PG8_WAIT_V(4); PG8_BAR;
    PG8_STAGE(PG8_SB(1, 0), cB + kstep, voffA); PG8_STAGE(PG8_SA(1, 0), cA + kstep, voffA); PG8_STAGE(PG8_SB(1, 1), cB + hstep + kstep, voffA);
    PG8_WAIT_V(6); PG8_BAR;
    for (;;) {
        const bool has_next = S.next(ui + 1, nxt);
        const char* nA = has_next ? nxt.A : cA; const char* nB = has_next ? nxt.B : cB;
        for (int t = 0; t < nt; t += 2) {
            const bool last = (t == nt - 2);
            const char* a1 = cA + (size_t)(t + 1) * kstep;
            const char* a2 = last ? nA : cA + (size_t)(t + 2) * kstep; const char* b2 = last ? nB : cB + (size_t)(t + 2) * kstep;
            const char* a3 = a2 + kstep; const char* b3 = b2 + kstep;
            PG8_LDB(B0, 0, 0); PG8_SCHED; PG8_LDA(At, 0, 0); PG8_STAGE(PG8_SA(1, 1), a1 + hstep, voffA);
            PG8_WAIT_L(8); PG8_BAR; PG8_WAIT_L(0); PG8_MMA(0, 0, At, B0); PG8_BAR; PG8_SCHED;
            PG8_LDB(B1, 0, 1); PG8_STAGE(PG8_SB(0, 0), b2, voffA);
            PG8_BAR; PG8_WAIT_L(0); PG8_MMA(0, 1, At, B1); PG8_BAR;
            PG8_LDA(At, 0, 1); PG8_STAGE(PG8_SA(0, 0), a2, voffA);
            PG8_BAR; PG8_WAIT_L(0); PG8_MMA(1, 0, At, B0); PG8_BAR; PG8_SCHED;
            PG8_STAGE(PG8_SB(0, 1), b2 + hstep, voffA);
            PG8_WAIT_V(6); PG8_BAR; PG8_MMA(1, 1, At, B1); PG8_BAR;
            PG8_LDB(B0, 1, 0); PG8_SCHED; PG8_LDA(At, 1, 0); PG8_STAGE(PG8_SA(0, 1), a2 + hstep, voffA);
            PG8_WAIT_L(8); PG8_BAR; PG8_WAIT_L(0); PG8_MMA(0, 0, At, B0); PG8_BAR; PG8_SCHED;
            PG8_LDB(B1, 1, 1); PG8_STAGE(PG8_SB(1, 0), b3, voffA);
            PG8_BAR; PG8_WAIT_L(0); PG8_MMA(0, 1, At, B1); PG8_BAR;
            PG8_LDA(At, 1, 1); PG8_STAGE(PG8_SA(1, 0), a3, voffA);
            PG8_BAR; PG8_WAIT_L(0); PG8_MMA(1, 0, At, B0); PG8_BAR; PG8_SCHED;
            PG8_STAGE(PG8_SB(1, 1), b3 + hstep, voffA);
            PG8_WAIT_V(6); PG8_BAR; PG8_MMA(1, 1, At, B1); PG8_BAR;
        }
        E(acc, cur, wr, wc, fr, fq);
        if (!has_next) break;
#pragma unroll
        for (int a = 0; a < 2; ++a)
#pragma unroll
            for (int b = 0; b < 2; ++b)
#pragma unroll
                for (int m = 0; m < 4; ++m)
#pragma unroll
                    for (int n = 0; n < 2; ++n) acc[a][b][m][n] = (f32x4){0.f, 0.f, 0.f, 0.f};
        cur = nxt; cA = nA; cB = nB; ++ui;
    }
    PG8_WAIT_V(0);
    if (wr == 0) PG8_BAR;
    PG8_BAR;
#undef PG8_SA
#undef PG8_SB
#undef PG8_STAGE
#undef PG8_LDA
#undef PG8_LDB
#undef PG8_MMA
#undef PG8_WAIT_V
#undef PG8_WAIT_L
#undef PG8_BAR
#undef PG8_SCHED
}
template <class F> struct EpiRC { F f;
    __device__ __forceinline__ void operator()(const f32x4 (&acc)[2][2][4][2], const Unit& u, int wr, int wc, int fr, int fq) const {
#pragma unroll
        for (int ai = 0; ai < 2; ++ai)
#pragma unroll
            for (int m = 0; m < 4; ++m) { const int row = u.pm * BM + ai * HALF + wr * 64 + m * 16 + fr;
#pragma unroll
                for (int bj = 0; bj < 2; ++bj)
#pragma unroll
                    for (int n = 0; n < 2; ++n) f(u, row, u.pn * BM + bj * HALF + wc * 32 + n * 16 + 4 * fq, acc[ai][bj][m][n]); }
    } };
template <class F> __device__ __forceinline__ EpiRC<F> epi_rc(const F& f) { return EpiRC<F>{f}; }
template <class F> struct EpiPair { F f;
    __device__ __forceinline__ void operator()(const f32x4 (&acc)[2][2][4][2], const Unit& u, int wr, int wc, int fr, int fq) const {
#pragma unroll
        for (int ai = 0; ai < 2; ++ai)
#pragma unroll
            for (int m = 0; m < 4; ++m) { const int row = u.pm * BM + ai * HALF + wr * 64 + m * 16 + fr;
#pragma unroll
                for (int n = 0; n < 2; ++n) f(u, row, u.pn * HALF + wc * 32 + n * 16 + 4 * fq, acc[ai][0][m][n], acc[ai][1][m][n]); }
    } };
template <class F> __device__ __forceinline__ EpiPair<F> epi_pair(const F& f) { return EpiPair<F>{f}; }
struct BatchSched { const char* A; const char* B; size_t strideA, strideB; int nM, nN, nb, K;
    __device__ __forceinline__ bool next(int i, Unit& u) const {
        const int nwg = nM * nN * nb; const int L = i * (int)gridDim.x + (int)blockIdx.x; if (L >= nwg) return false;
        const int w = xcd_remap(L, nwg); const int per = nM * nN; u.g = w / per; const int r = w % per; u.pm = r / nN; u.pn = r % nN;
        u.A = A + u.g * strideA + (size_t)u.pm * BM * K * 2; u.B = B + u.g * strideB + (size_t)u.pn * BM * K * 2; return true; } };
}

template <class SrcF, class DRow>
__device__ __forceinline__ void cvt_tiles(char* lds, bf16_t* dst, int Kd, int Nd, int nbatch, size_t dstride, const SrcF& src, const DRow& drow) {
    bf16_t* T = (bf16_t*)lds;
    const int tid = tidx();
    const int tk = Kd / 128, tn = Nd / 64, per = tk * tn, total = per * nbatch;
    for (int t = blockIdx.x; t < total; t += gridDim.x) {
        const int bt = t / per, r = t % per, k0 = (r % tk) * 128, n0 = (r / tk) * 64;
        float4 v[4];
#pragma unroll
        for (int i = 0; i < 4; ++i) { const int k = k0 + i * 32 + (tid >> 4), n = n0 + (tid & 15) * 4; const float* sp = src(bt, k, n); v[i] = sp ? *(const float4*)sp : make_float4(0.f, 0.f, 0.f, 0.f); }
        __syncthreads();
#pragma unroll
        for (int i = 0; i < 4; ++i) { const int k = i * 32 + (tid >> 4), n = (tid & 15) * 4;
            T[(n + 0) * 136 + k] = f2bf(v[i].x); T[(n + 1) * 136 + k] = f2bf(v[i].y); T[(n + 2) * 136 + k] = f2bf(v[i].z); T[(n + 3) * 136 + k] = f2bf(v[i].w); }
        __syncthreads();
        { const int n = tid >> 3, kc = (tid & 7) * 16;
          const u32x4 a = *(const u32x4*)(T + n * 136 + kc), b = *(const u32x4*)(T + n * 136 + kc + 8);
          bf16_t* dp = dst + bt * dstride + (size_t)drow(n0 + n) * Kd + k0 + kc;
          *(u32x4*)dp = a; *(u32x4*)(dp + 8) = b; }
    }
}
__device__ void ph_moe_cvt(const Params& p, int layer, char* lds) {
    const float* w1 = p.moe_w1 + (size_t)layer * NE * D * FF; const float* w3 = p.moe_w3 + (size_t)layer * NE * D * FF; const float* w2 = p.moe_w2 + (size_t)layer * NE * FF * D;
    cvt_tiles(lds, (bf16_t*)(p.ws + OFF_W13T), D, 2816, NE, (size_t)2816 * D,
        [=](int e, int k, int n) -> const float* { const int pn = n >> 8, half = (n >> 7) & 1, c = pn * 128 + (n & 127); return (half ? w3 : w1) + ((size_t)e * D + k) * FF + c; },
        [=](int n) { return n; });
    cvt_tiles(lds, (bf16_t*)(p.ws + OFF_W2T), FF, D, NE, (size_t)D * FF,
        [=](int e, int k, int n) -> const float* { return w2 + ((size_t)e * FF + k) * D + n; },
        [=](int n) { return n; });
}

__device__ void ph_init(const Params& p, char* lds) {
    const int tid = tidx(), gtid = blockIdx.x * NTHR + tid, gsz = gridDim.x * NTHR;
    float4* X4 = (float4*)(p.ws + OFF_X);
    const float4* x4 = (const float4*)p.x; const float4* c4 = (const float4*)p.ctx;
    for (int i = gtid; i < NROW * 256; i += gsz) X4[i] = i < NLAT * 256 ? x4[i] : c4[i - NLAT * 256];
    float* rc = (float*)(p.ws + OFF_ROPE_C); float* rs = (float*)(p.ws + OFF_ROPE_S);
    for (int i = gtid; i < TL * 32; i += gsz) {
        const int t = i >> 5, f = i & 31; const float pos = (float)((f < 16) ? (t >> 6) : (t & 63));
        const float inv = powf(10000.f, -(float)(f & 15) / 16.f); const float ang = pos * inv; rc[i] = cosf(ang); rs[i] = sinf(ang);
    }
    float* sc = (float*)lds;
    float* red = sc + 5 * 1024;
    for (int i = tid; i < 5 * 1024; i += NTHR) { const float v = i < 4096 ? p.c[i] : p.c_ctx[i - 4096]; sc[i] = v / (1.f + expf(-v)); }
    __syncthreads();
    float* MOD = (float*)(p.ws + OFF_MOD);
    for (int item = blockIdx.x; item < 4 * 96; item += gridDim.x) {
        const int l = item / 96, cg = item % 96, col = tid & 63, n = cg * 64 + col, kg = tid >> 6;
        const float* w = p.mod_w + ((size_t)l * 1024 + kg * 128) * 6144 + n;
        float a0 = 0, a1 = 0, a2 = 0, a3 = 0, a4 = 0;
        for (int k = 0; k < 128; ++k) { const float wv = w[(size_t)k * 6144]; const int kk = kg * 128 + k;
            a0 += sc[kk] * wv; a1 += sc[1024 + kk] * wv; a2 += sc[2048 + kk] * wv; a3 += sc[3072 + kk] * wv; a4 += sc[4096 + kk] * wv; }
        float* rr = red + (kg * 64 + col) * 5; rr[0] = a0; rr[1] = a1; rr[2] = a2; rr[3] = a3; rr[4] = a4;
        __syncthreads();
        if (tid < 320) { const int c2 = tid & 63, s = tid >> 6; float sum = 0;
            for (int q = 0; q < 8; ++q) sum += red[(q * 64 + c2) * 5 + s];
            MOD[((size_t)l * 5 + s) * 6144 + cg * 64 + c2] = sum + p.mod_b[l * 6144 + cg * 64 + c2]; }
        __syncthreads();
    }
}


__device__ void ph_small_cvt(const Params& p, char* lds) {
    for (int j = 0; j < 2; ++j) {
        char* wm = p.ws + OFF_WMLA + j * SZ_WMLA; char* wr = p.ws + OFF_WRW + j * SZ_WRW;
        const float* w_in = p.mla_w_in + (size_t)j * D * 448; const float* w_uq = p.mla_w_uq + (size_t)j * 256 * 1536; const float* w_ukv = p.mla_w_ukv + (size_t)j * 128 * 2048; const float* w_o = p.mla_w_o + (size_t)j * D * D;
        cvt_tiles(lds, (bf16_t*)(wm + WM_IN), 1024, 512, 1, 0, [=](int, int k, int n) -> const float* { return n < 448 ? w_in + (size_t)k * 448 + n : nullptr; }, [=](int n) { return n; });
        cvt_tiles(lds, (bf16_t*)(wm + WM_UQ), 256, 1536, 1, 0, [=](int, int k, int n) -> const float* { return w_uq + (size_t)k * 1536 + n; }, [=](int n) { return n; });
        cvt_tiles(lds, (bf16_t*)(wm + WM_UKV), 256, 2048, 1, 0, [=](int, int k, int n) -> const float* { return k < 128 ? w_ukv + (size_t)k * 2048 + n : nullptr; }, [=](int n) { return n; });
        cvt_tiles(lds, (bf16_t*)(wm + WM_O), 1024, 1024, 1, 0, [=](int, int k, int n) -> const float* { return w_o + (size_t)k * D + n; }, [=](int n) { return n; });
        const float* w_rkv = p.rw_w_rkv + (size_t)j * 3 * D * D; const float* w1 = p.rw_w1 + (size_t)j * 2 * D * 64; const float* a1 = p.rw_a1 + (size_t)j * 2 * D * 64;
        const float* g1 = p.rw_g1 + (size_t)j * D * 128; const float* v1 = p.rw_v1; const float* rwo = p.rw_w_o + (size_t)j * D * D;
        cvt_tiles(lds, (bf16_t*)(wr + WR_RKV), 1024, 1024, 3, (size_t)D * D, [=](int m, int k, int n) -> const float* { return w_rkv + ((size_t)m * D + k) * D + n; }, [=](int n) { return n; });
        cvt_tiles(lds, (bf16_t*)(wr + WR_L), 1024, 256, 1, 0, [=](int, int k, int n) -> const float* { return n < 128 ? w1 + ((size_t)(n >> 6) * D + k) * 64 + (n & 63) : nullptr; }, [=](int n) { return n; });
        cvt_tiles(lds, (bf16_t*)(wr + WR_L) + 256 * 1024, 1024, 256, 1, 0, [=](int, int k, int n) -> const float* { return n < 128 ? a1 + ((size_t)(n >> 6) * D + k) * 64 + (n & 63) : nullptr; }, [=](int n) { return n; });
        cvt_tiles(lds, (bf16_t*)(wr + WR_L) + 2 * 256 * 1024, 1024, 256, 1, 0, [=](int, int k, int n) -> const float* { return n < 128 ? g1 + (size_t)k * 128 + n : nullptr; }, [=](int n) { return n; });
        cvt_tiles(lds, (bf16_t*)(wr + WR_L) + 3 * 256 * 1024, 1024, 256, 1, 0, [=](int, int k, int n) -> const float* { return n < 32 ? v1 + (size_t)k * 32 + n : nullptr; }, [=](int n) { return n; });
        cvt_tiles(lds, (bf16_t*)(wr + WR_O), 1024, 1024, 1, 0, [=](int, int k, int n) -> const float* { return rwo + (size_t)k * D + n; }, [=](int n) { return n; });
    }
}

template <bool OUTF32>
__device__ void ph_norm_mod(const Params& p, int layer, const float* g, int part_sh, int part_sc, void* outp) {
    const int wid = tidx() >> 6, lane = tidx() & 63;
    const float* X = (const float*)(p.ws + OFF_X);
    for (int row = blockIdx.x * 8 + wid; row < NROW; row += gridDim.x * 8) {
        const int s = row_stream(row);
        const float* sh = modp(p, layer, s, part_sh); const float* sc = modp(p, layer, s, part_sc);
        const float4* xr = (const float4*)(X + (size_t)row * D);
        float4 v[4]; float ss = 0;
#pragma unroll
        for (int i = 0; i < 4; ++i) { v[i] = xr[lane + i * 64]; ss += v[i].x * v[i].x + v[i].y * v[i].y + v[i].z * v[i].z + v[i].w * v[i].w; }
        ss = wave_sum(ss); const float rs = rsqrtf(ss * (1.f / D) + RMS_EPS);
#pragma unroll
        for (int i = 0; i < 4; ++i) {
            const int d = (lane + i * 64) * 4;
            const float4 gg = *(const float4*)(g + d), a = *(const float4*)(sc + d), b = *(const float4*)(sh + d);
            float4 o; o.x = v[i].x * rs * gg.x * (1.f + a.x) + b.x; o.y = v[i].y * rs * gg.y * (1.f + a.y) + b.y; o.z = v[i].z * rs * gg.z * (1.f + a.z) + b.z; o.w = v[i].w * rs * gg.w * (1.f + a.w) + b.w;
            if (OUTF32) *(float4*)((float*)outp + (size_t)row * D + d) = o;
            else { uint2 w; w.x = pk2(o.x, o.y); w.y = pk2(o.z, o.w); *(uint2*)((bf16_t*)outp + (size_t)row * D + d) = w; }
        }
    }
}

__device__ void ph_mla_mid(const Params& p, int j) {
    const int wid = tidx() >> 6, lane = tidx() & 63;
    const float* Z = (const float*)(p.ws + OFF_Z);
    bf16_t* CQN = (bf16_t*)(p.ws + OFF_CQN); bf16_t* CKVN = (bf16_t*)(p.ws + OFF_CKVN); float* KR = (float*)(p.ws + OFF_KR);
    const float* gq = p.mla_g_q + j * 256; const float* gkv = p.mla_g_kv + j * 128;
    const float* rc = (const float*)(p.ws + OFF_ROPE_C); const float* rs = (const float*)(p.ws + OFF_ROPE_S);
    for (int row = blockIdx.x * 8 + wid; row < NROW; row += gridDim.x * 8) {
        const float* z = Z + (size_t)row * 512;
        const float4 q = *(const float4*)(z + lane * 4);
        const float2 kv = *(const float2*)(z + 256 + lane * 2);
        const float kr = z[384 + lane];
        float sq = wave_sum(q.x * q.x + q.y * q.y + q.z * q.z + q.w * q.w); const float rq = rsqrtf(sq * (1.f / 256.f) + RMS_EPS);
        float sk = wave_sum(kv.x * kv.x + kv.y * kv.y); const float rk = rsqrtf(sk * (1.f / 128.f) + RMS_EPS);
        const float4 g4 = *(const float4*)(gq + lane * 4); const float2 g2 = *(const float2*)(gkv + lane * 2);
        uint2 w; w.x = pk2(q.x * rq * g4.x, q.y * rq * g4.y); w.y = pk2(q.z * rq * g4.z, q.w * rq * g4.w);
        *(uint2*)(CQN + (size_t)row * 256 + lane * 4) = w;
        *(unsigned*)(CKVN + (size_t)row * 256 + lane * 2) = pk2(kv.x * rk * g2.x, kv.y * rk * g2.y);
        *(unsigned*)(CKVN + (size_t)row * 256 + 128 + lane * 2) = 0u;
        float o = kr;
        const float other = __shfl_xor(kr, 32);
        if (row < NLAT) { const int t = row & (TL - 1), i = lane & 31; const float c = rc[t * 32 + i], s = rs[t * 32 + i];
            const float x1 = lane < 32 ? kr : other, x2 = lane < 32 ? other : kr;
            o = lane < 32 ? (x1 * c - x2 * s) : (x1 * s + x2 * c); }
        KR[(size_t)row * 64 + lane] = o;
    }
}

__device__ void ph_qkv_post(const Params& p) {
    const int wid = tidx() >> 6, lane = tidx() & 63;
    const float* QRAW = (const float*)(p.ws + OFF_QRAW); const float* KVRAW = (const float*)(p.ws + OFF_KVRAW); const float* KR = (const float*)(p.ws + OFF_KR);
    bf16_t* Q = (bf16_t*)(p.ws + OFF_Q); bf16_t* K = (bf16_t*)(p.ws + OFF_K); bf16_t* V = (bf16_t*)(p.ws + OFF_V);
    const float* rc = (const float*)(p.ws + OFF_ROPE_C); const float* rs = (const float*)(p.ws + OFF_ROPE_S);
    for (int it = blockIdx.x * 8 + wid; it < NROW * 8; it += gridDim.x * 8) {
        const int row = it >> 3, h = it & 7;
        const bool lat = row < NLAT; const int b = lat ? (row >> 12) : ((row - NLAT) >> 8); const int tk = lat ? 256 + (row & (TL - 1)) : ((row - NLAT) & 255);
        const size_t orow = (size_t)(b * 8 + h) * TK + tk;
        const float* q = QRAW + (size_t)row * 1536 + h * 192;
        const float q0 = q[lane], q1 = q[64 + lane]; float q2 = q[128 + lane];
        const float other = __shfl_xor(q2, 32);
        if (lat) { const int t = row & (TL - 1), i = lane & 31; const float c = rc[t * 32 + i], s = rs[t * 32 + i];
            const float x1 = lane < 32 ? q2 : other, x2 = lane < 32 ? other : q2; q2 = lane < 32 ? (x1 * c - x2 * s) : (x1 * s + x2 * c); }
        bf16_t* qo = Q + orow * 192; qo[lane] = f2bf(q0); qo[64 + lane] = f2bf(q1); qo[128 + lane] = f2bf(q2);
        const float* kv = KVRAW + (size_t)row * 2048 + h * 256;
        bf16_t* ko = K + orow * 192; ko[lane] = f2bf(kv[lane]); ko[64 + lane] = f2bf(kv[64 + lane]); ko[128 + lane] = f2bf(KR[(size_t)row * 64 + lane]);
        bf16_t* vo = V + orow * 128; vo[lane] = f2bf(kv[128 + lane]); vo[64 + lane] = f2bf(kv[192 + lane]);
    }
}

__device__ void ph_attn_naive(const Params& p, char* lds) {
    const int tid = tidx(), qi = tid >> 2, part = tid & 3;
    const bf16_t* Q = (const bf16_t*)(p.ws + OFF_Q); const bf16_t* K = (const bf16_t*)(p.ws + OFF_K); const bf16_t* V = (const bf16_t*)(p.ws + OFF_V);
    bf16_t* O = (bf16_t*)(p.ws + OFF_O);
    bf16_t* Ks = (bf16_t*)lds;
    bf16_t* Vs = Ks + 32 * 192;
    const int nitems = 32 * 34;
    for (int it = blockIdx.x; it < nitems; it += gridDim.x) {
        const int bh = it / 34, qb = it % 34; const int b = bh >> 3, h = bh & 7;
        const int nkeys = qb < 2 ? TC : TK;
        const int tq = qb * 128 + qi;
        const bf16_t* qp = Q + ((size_t)bh * TK + tq) * 192 + part * 48;
        float q[48];
#pragma unroll
        for (int i = 0; i < 48; ++i) q[i] = bf2f(qp[i]) * ATT_SCALE;
        float o[32];
#pragma unroll
        for (int i = 0; i < 32; ++i) o[i] = 0.f;
        float m = -1e30f, l = 0.f;
        for (int k0 = 0; k0 < nkeys; k0 += 32) {
            __syncthreads();
            {
                const bf16_t* kg = K + ((size_t)bh * TK + k0) * 192; const bf16_t* vg = V + ((size_t)bh * TK + k0) * 128;
                for (int c = tid; c < 768; c += NTHR) *(u32x4*)(Ks + c * 8) = *(const u32x4*)(kg + c * 8);
                *(u32x4*)(Vs + tid * 8) = *(const u32x4*)(vg + tid * 8);
            }
            __syncthreads();
#pragma unroll 1
            for (int kg = 0; kg < 32; kg += 8) {
                float s[8]; float tmax = -1e30f;
#pragma unroll
                for (int kk = 0; kk < 8; ++kk) {
                    const bf16_t* kr = Ks + (kg + kk) * 192 + part * 48; float acc = 0.f;
#pragma unroll
                    for (int i = 0; i < 48; ++i) acc += q[i] * bf2f(kr[i]);
                    acc += __shfl_xor(acc, 1); acc += __shfl_xor(acc, 2);
                    s[kk] = acc; tmax = fmaxf(tmax, acc);
                    asm volatile("" ::: "memory");
                }
                const float mn = fmaxf(m, tmax), alpha = expf(m - mn); m = mn; l *= alpha;
#pragma unroll
                for (int i = 0; i < 32; ++i) o[i] *= alpha;
#pragma unroll
                for (int kk = 0; kk < 8; ++kk) {
                    const float pw = expf(s[kk] - mn); l += pw;
                    const bf16_t* vr = Vs + (kg + kk) * 128 + part * 32;
#pragma unroll
                    for (int i = 0; i < 32; ++i) o[i] += pw * bf2f(vr[i]);
                    asm volatile("" ::: "memory");
                }
            }
        }
        const float rl = 1.f / l;
        const int row = qb < 2 ? (NLAT + b * TC + tq) : (b * TL + tq - TC);
        bf16_t* op = O + (size_t)row * D + h * 128 + part * 32;
#pragma unroll
        for (int i = 0; i < 32; ++i) op[i] = f2bf(o[i] * rl);
    }
}

__device__ void ph_norm2_router(const Params& p, int layer, char* lds) {
    const int tid = tidx(), wid = tid >> 6, lane = tid & 63;
    float* rt = (float*)lds;
    const float* rg = p.moe_router + (size_t)layer * D * NE;
    for (int i = tid; i < D * NE / 4; i += NTHR) ((float4*)rt)[i] = ((const float4*)rg)[i];
    __syncthreads();
    const float* X = (const float*)(p.ws + OFF_X); bf16_t* BN = (bf16_t*)(p.ws + OFF_H); float* AFF = (float*)(p.ws + OFF_AFF);
    const float* g = p.norm2_g + layer * D;
    for (int row = blockIdx.x * 8 + wid; row < NROW; row += gridDim.x * 8) {
        const int s = row_stream(row);
        const float* sh = modp(p, layer, s, 3); const float* sc = modp(p, layer, s, 4);
        const float4* xr = (const float4*)(X + (size_t)row * D);
        float4 v[4]; float ss = 0;
#pragma unroll
        for (int i = 0; i < 4; ++i) { v[i] = xr[lane + i * 64]; ss += v[i].x * v[i].x + v[i].y * v[i].y + v[i].z * v[i].z + v[i].w * v[i].w; }
        ss = wave_sum(ss); const float rs = rsqrtf(ss * (1.f / D) + RMS_EPS);
        float lg[16];
#pragma unroll
        for (int e = 0; e < 16; ++e) lg[e] = 0.f;
#pragma unroll
        for (int i = 0; i < 4; ++i) {
            const int d = (lane + i * 64) * 4;
            const float4 gg = *(const float4*)(g + d), a = *(const float4*)(sc + d), b = *(const float4*)(sh + d);
            float o[4]; o[0] = v[i].x * rs * gg.x * (1.f + a.x) + b.x; o[1] = v[i].y * rs * gg.y * (1.f + a.y) + b.y; o[2] = v[i].z * rs * gg.z * (1.f + a.z) + b.z; o[3] = v[i].w * rs * gg.w * (1.f + a.w) + b.w;
            uint2 w; w.x = pk2(o[0], o[1]); w.y = pk2(o[2], o[3]); *(uint2*)(BN + (size_t)row * D + d) = w;
#pragma unroll
            for (int jj = 0; jj < 4; ++jj) { const float* rr = rt + (d + jj) * 16;
#pragma unroll
                for (int e = 0; e < 16; ++e) lg[e] += o[jj] * rr[e];
                asm volatile("" ::: "memory"); }
        }
        float mx = -1e30f;
#pragma unroll
        for (int e = 0; e < 16; ++e) { lg[e] = wave_sum(lg[e]); mx = fmaxf(mx, lg[e]); }
        float sum = 0;
#pragma unroll
        for (int e = 0; e < 16; ++e) { lg[e] = expf(lg[e] - mx); sum += lg[e]; }
        const float inv = 1.f / sum;
        if (lane < 16) { float val = 0;
#pragma unroll
            for (int e = 0; e < 16; ++e) val = (lane == e) ? lg[e] : val;
            AFF[(size_t)row * 16 + lane] = val * inv; }
    }
}

__device__ void ph_select(const Params& p, char* lds) {
    const int tid = tidx();
    float* vals = (float*)lds;
    const float* AFF = (const float*)(p.ws + OFF_AFF);
    int* ROWIDX = (int*)(p.ws + OFF_ROWIDX); float* GATE = (float*)(p.ws + OFF_GATE); int* SLOT = (int*)(p.ws + OFF_SLOT);
    for (int gidx = blockIdx.x; gidx < 128; gidx += gridDim.x) {
        const bool lat = gidx < 64; const int b = (gidx & 63) >> 4, e = gidx & 15;
        const int n = lat ? TL : TC, cap = lat ? CAPL : CAPC;
        const int row0 = lat ? b * TL : NLAT + b * TC, slot0 = lat ? b * CAPL : NB * CAPL + b * CAPC;
        __syncthreads();
        for (int i = tid; i < n; i += NTHR) vals[i] = AFF[(size_t)(row0 + i) * 16 + e];
        __syncthreads();
        for (int i = tid; i < n; i += NTHR) {
            const float v = vals[i]; int rank = 0;
            for (int jj = 0; jj < n; ++jj) { const float u = vals[jj]; rank += (u > v || (u == v && jj < i)) ? 1 : 0; }
            if (rank < cap) { ROWIDX[e * ESLOTS + slot0 + rank] = row0 + i; GATE[e * EPAD + slot0 + rank] = v; SLOT[(size_t)(row0 + i) * 16 + e] = slot0 + rank; }
            else SLOT[(size_t)(row0 + i) * 16 + e] = -1;
        }
    }
}

__device__ void ph_gather(const Params& p) {
    const int wid = tidx() >> 6, lane = tidx() & 63;
    const int* ROWIDX = (const int*)(p.ws + OFF_ROWIDX); const bf16_t* BN = (const bf16_t*)(p.ws + OFF_H); bf16_t* XE = (bf16_t*)(p.ws + OFF_XE);
    for (int it = blockIdx.x * 8 + wid; it < NE * ESLOTS; it += gridDim.x * 8) {
        const int row = ROWIDX[it]; const int e = it / ESLOTS, sl = it % ESLOTS;
        const u32x4* src = (const u32x4*)(BN + (size_t)row * D); u32x4* dst = (u32x4*)(XE + ((size_t)e * EPAD + sl) * D);
        dst[lane] = src[lane]; dst[lane + 64] = src[lane + 64];
    }
}

__device__ void ph_combine(const Params& p, int layer) {
    const int wid = tidx() >> 6, lane = tidx() & 63;
    const int* SLOT = (const int*)(p.ws + OFF_SLOT); const bf16_t* YE = (const bf16_t*)(p.ws + OFF_YE); float* X = (float*)(p.ws + OFF_X);
    for (int row = blockIdx.x * 8 + wid; row < NROW; row += gridDim.x * 8) {
        const float* gt = modp(p, layer, row_stream(row), 5);
        float acc[16];
#pragma unroll
        for (int i = 0; i < 16; ++i) acc[i] = 0.f;
        for (int e = 0; e < NE; ++e) {
            const int s = SLOT[(size_t)row * 16 + e];
            if (s >= 0) { const bf16_t* y = YE + ((size_t)e * EPAD + s) * D + lane * 16;
                const u32x4 a = *(const u32x4*)y, b = *(const u32x4*)(y + 8);
                const unsigned w[8] = {a.x, a.y, a.z, a.w, b.x, b.y, b.z, b.w};
#pragma unroll
                for (int i = 0; i < 8; ++i) { acc[2 * i] += __uint_as_float(w[i] << 16); acc[2 * i + 1] += __uint_as_float(w[i] & 0xffff0000u); } }
        }
        float* xr = X + (size_t)row * D + lane * 16; const float* g = gt + lane * 16;
#pragma unroll
        for (int i = 0; i < 16; i += 4) { float4 xv = *(float4*)(xr + i); const float4 gv = *(const float4*)(g + i);
            xv.x += gv.x * acc[i]; xv.y += gv.y * acc[i + 1]; xv.z += gv.z * acc[i + 2]; xv.w += gv.w * acc[i + 3]; *(float4*)(xr + i) = xv; }
    }
}

__device__ void ph_rw_xs(const Params& p, int j) {
    const float* HF = (const float*)(p.ws + OFF_HF); bf16_t* XS = (bf16_t*)(p.ws + OFF_XS);
    const float* mu = p.rw_mu + (size_t)j * 6 * D;
    const int gtid = blockIdx.x * NTHR + tidx(), gsz = gridDim.x * NTHR;
    for (int i = gtid; i < NROW * 256; i += gsz) {
        const int row = i >> 8, d = (i & 255) * 4;
        const bool lat = row < NLAT; const int t = lat ? (row & (TL - 1)) : ((row - NLAT) & (TC - 1)); const int len = lat ? TL : TC;
        const float4 h = *(const float4*)(HF + (size_t)row * D + d);
        float4 pv = make_float4(0, 0, 0, 0), nx = make_float4(0, 0, 0, 0);
        if (t > 0) pv = *(const float4*)(HF + (size_t)(row - 1) * D + d);
        if (t < len - 1) nx = *(const float4*)(HF + (size_t)(row + 1) * D + d);
        float4 xx; xx.x = 0.5f * (pv.x + nx.x) - h.x; xx.y = 0.5f * (pv.y + nx.y) - h.y; xx.z = 0.5f * (pv.z + nx.z) - h.z; xx.w = 0.5f * (pv.w + nx.w) - h.w;
#pragma unroll
        for (int m = 0; m < 6; ++m) { const float4 u = *(const float4*)(mu + m * D + d);
            uint2 w; w.x = pk2(h.x + xx.x * u.x, h.y + xx.y * u.y); w.y = pk2(h.z + xx.z * u.z, h.w + xx.w * u.w);
            *(uint2*)(XS + ((size_t)m * NROW + row) * D + d) = w; }
    }
}

__device__ void ph_rw_prep(const Params& p, int j) {
    const int wid = tidx() >> 6, lane = tidx() & 63;
    float* RKV = (float*)(p.ws + OFF_RKV); float* AV = (float*)(p.ws + OFF_AV); float* KD = (float*)(p.ws + OFF_KD);
    const float* k_k = p.rw_k_k + j * D; const float* k_a = p.rw_k_a + j * D;
    for (int row = blockIdx.x * 8 + wid; row < NROW; row += gridDim.x * 8) {
        const size_t o = (size_t)row * D + lane * 16;
        float k[16], kk[16]; float ss = 0;
#pragma unroll
        for (int i = 0; i < 16; ++i) { k[i] = RKV[(size_t)NROW * D + o + i]; kk[i] = k[i] * k_k[lane * 16 + i]; ss += kk[i] * kk[i]; }
        ss += __shfl_xor(ss, 1); ss += __shfl_xor(ss, 2);
        const float inv = 1.f / fmaxf(sqrtf(ss), 1e-12f);
#pragma unroll
        for (int i = 0; i < 16; ++i) kk[i] *= inv;
#pragma unroll
        for (int z = 0; z < 2; ++z)
#pragma unroll
            for (int i = 0; i < 16; ++i) { const float a = AV[(size_t)z * NROW * D + o + i];
                KD[(size_t)z * NROW * D + o + i] = k[i] * (1.f + (a - 1.f) * k_a[lane * 16 + i]);
                AV[(size_t)z * NROW * D + o + i] = kk[i] * a; }
#pragma unroll
        for (int i = 0; i < 16; ++i) RKV[(size_t)NROW * D + o + i] = kk[i];
    }
}

__device__ void ph_rw_scan(const Params& p) {
    const int tid = tidx(), wid = tid >> 6, lane = tid & 63, vr = lane >> 3, ks = lane & 7;
    const float* RKV = (const float*)(p.ws + OFF_RKV); const float* W = (const float*)(p.ws + OFF_W); const float* BBp = (const float*)(p.ws + OFF_AV); const float* KD = (const float*)(p.ws + OFF_KD);
    float* Y = (float*)(p.ws + OFF_Y);
    const size_t PL = (size_t)NROW * D;
    for (int it = blockIdx.x; it < 128; it += gridDim.x) {
        const int z = it & 1, h = (it >> 1) & 15, b = it >> 5;
        float S[8];
#pragma unroll
        for (int i = 0; i < 8; ++i) S[i] = 0.f;
        const int co = h * 64 + ks * 8, vo = h * 64 + wid * 8 + vr;
        for (int ph = 0; ph < 2; ++ph) {
            const int n = ph == 0 ? TC : TL; const int base = ph == 0 ? NLAT + b * TC : b * TL;
            for (int st = 0; st < n; ++st) {
                const int t = z == 0 ? st : n - 1 - st; const size_t ro = (size_t)(base + t) * D;
                float w[8], kk[8], bb[8], kd[8], r[8];
                *(float4*)w = *(const float4*)(W + z * PL + ro + co); *(float4*)(w + 4) = *(const float4*)(W + z * PL + ro + co + 4);
                *(float4*)kk = *(const float4*)(RKV + PL + ro + co); *(float4*)(kk + 4) = *(const float4*)(RKV + PL + ro + co + 4);
                *(float4*)bb = *(const float4*)(BBp + z * PL + ro + co); *(float4*)(bb + 4) = *(const float4*)(BBp + z * PL + ro + co + 4);
                *(float4*)kd = *(const float4*)(KD + z * PL + ro + co); *(float4*)(kd + 4) = *(const float4*)(KD + z * PL + ro + co + 4);
                *(float4*)r = *(const float4*)(RKV + ro + co); *(float4*)(r + 4) = *(const float4*)(RKV + ro + co + 4);
                const float v = RKV[2 * PL + ro + vo];
                float sa = 0;
#pragma unroll
                for (int i = 0; i < 8; ++i) sa -= S[i] * kk[i];
                sa += __shfl_xor(sa, 1); sa += __shfl_xor(sa, 2); sa += __shfl_xor(sa, 4);
                float y = 0;
#pragma unroll
                for (int i = 0; i < 8; ++i) { S[i] = S[i] * w[i] + sa * bb[i] + v * kd[i]; y += S[i] * r[i]; }
                y += __shfl_xor(y, 1); y += __shfl_xor(y, 2); y += __shfl_xor(y, 4);
                if (ks == 0) Y[z * PL + ro + vo] = y;
            }
        }
    }
}

__device__ void ph_rw_out(const Params& p, int j) {
    const int wid = tidx() >> 6, lane = tidx() & 63;
    const float* RKV = (const float*)(p.ws + OFF_RKV); const float* KD = (const float*)(p.ws + OFF_KD); const float* G = (const float*)(p.ws + OFF_G); const float* Y = (const float*)(p.ws + OFF_Y);
    bf16_t* OUT = (bf16_t*)(p.ws + OFF_H);
    const size_t PL = (size_t)NROW * D;
    const float* r_k = p.rw_r_k + j * D; const float* lg = p.rw_lnx_g + j * D; const float* lb = p.rw_lnx_b + j * D;
    for (int row = blockIdx.x * 8 + wid; row < NROW; row += gridDim.x * 8) {
        const size_t o = (size_t)row * D + lane * 16;
        float y[16]; float s = 0;
#pragma unroll
        for (int i = 0; i < 16; ++i) { y[i] = Y[o + i] + Y[PL + o + i]; s += y[i]; }
        s += __shfl_xor(s, 1); s += __shfl_xor(s, 2); const float mean = s * (1.f / 64.f);
        float q = 0;
#pragma unroll
        for (int i = 0; i < 16; ++i) { const float dd = y[i] - mean; q += dd * dd; }
        q += __shfl_xor(q, 1); q += __shfl_xor(q, 2); const float rstd = rsqrtf(q * (1.f / 64.f) + LNX_EPS);
        float bs = 0;
#pragma unroll
        for (int i = 0; i < 16; ++i) bs += RKV[o + i] * (KD[o + i] + KD[PL + o + i]) * r_k[lane * 16 + i];
        bs += __shfl_xor(bs, 1); bs += __shfl_xor(bs, 2);
        unsigned w[8];
#pragma unroll
        for (int i = 0; i < 16; i += 2) {
            const float o0 = ((y[i] - mean) * rstd * lg[lane * 16 + i] + lb[lane * 16 + i] + bs * RKV[2 * PL + o + i]) * G[o + i];
            const float o1 = ((y[i + 1] - mean) * rstd * lg[lane * 16 + i + 1] + lb[lane * 16 + i + 1] + bs * RKV[2 * PL + o + i + 1]) * G[o + i + 1];
            w[i >> 1] = pk2(o0, o1); }
        *(u32x4*)(OUT + o) = (u32x4){w[0], w[1], w[2], w[3]}; *(u32x4*)(OUT + o + 8) = (u32x4){w[4], w[5], w[6], w[7]};
    }
}

__device__ void ph_final(const Params& p) {
    const int wid = tidx() >> 6, lane = tidx() & 63;
    const float* X = (const float*)(p.ws + OFF_X);
    for (int row = blockIdx.x * 8 + wid; row < NLAT; row += gridDim.x * 8) {
        const float4* xr = (const float4*)(X + (size_t)row * D);
        float4 v[4]; float ss = 0;
#pragma unroll
        for (int i = 0; i < 4; ++i) { v[i] = xr[lane + i * 64]; ss += v[i].x * v[i].x + v[i].y * v[i].y + v[i].z * v[i].z + v[i].w * v[i].w; }
        ss = wave_sum(ss); const float rs = rsqrtf(ss * (1.f / D) + RMS_EPS);
#pragma unroll
        for (int i = 0; i < 4; ++i) { const int d = (lane + i * 64) * 4; const float4 gg = *(const float4*)(p.final_g + d);
            float4 o; o.x = v[i].x * rs * gg.x; o.y = v[i].y * rs * gg.y; o.z = v[i].z * rs * gg.z; o.w = v[i].w * rs * gg.w;
            *(float4*)(p.out + (size_t)row * D + d) = o; }
    }
}

enum { PH_INIT = 0, PH_A_NORM, PH_A_Z, PH_A_MID, PH_A_QKV, PH_A_POST, PH_A_ATTN, PH_A_WO,
       PH_R_NORM, PH_R_XS, PH_R_G1, PH_R_G2, PH_R_PREP, PH_R_SCAN, PH_R_OUT, PH_R_WO,
       PH_M_NORM, PH_M_SEL, PH_M_GATHER, PH_M_G1, PH_M_G2, PH_M_COMB, PH_FINAL, PH_M_CVT };

template <int PH>
__device__ __forceinline__ void run_phase(const Params& p, int layer, char* lds) {
    const int j = layer >> 1;
    char* ws = p.ws;
    if constexpr (PH == PH_INIT) { ph_init(p, lds); __syncthreads(); ph_small_cvt(p, lds); }
    else if constexpr (PH == PH_A_NORM) ph_norm_mod<false>(p, layer, p.norm1_g + layer * D, 0, 1, ws + OFF_H);
    else if constexpr (PH == PH_A_Z) {
        float* Z = (float*)(ws + OFF_Z);
        g8::BatchSched S{ws + OFF_H, ws + OFF_WMLA + j * SZ_WMLA + WM_IN, 0, 0, NROW / 256, 2, 1, D};
        g8::gemm_phase((PG8_LAS unsigned char*)lds, D, S, g8::epi_rc([=](const g8::Unit&, int row, int col, f32x4 v) { *(f32x4*)(Z + (size_t)row * 512 + col) = v; }));
    }
    else if constexpr (PH == PH_A_MID) ph_mla_mid(p, j);
    else if constexpr (PH == PH_A_QKV) {
        float* QRAW = (float*)(ws + OFF_QRAW); float* KVRAW = (float*)(ws + OFF_KVRAW);
        g8::BatchSched S1{ws + OFF_CQN, ws + OFF_WMLA + j * SZ_WMLA + WM_UQ, 0, 0, NROW / 256, 6, 1, 256};
        g8::gemm_phase((PG8_LAS unsigned char*)lds, 256, S1, g8::epi_rc([=](const g8::Unit&, int row, int col, f32x4 v) { *(f32x4*)(QRAW + (size_t)row * 1536 + col) = v; }));
        g8::BatchSched S2{ws + OFF_CKVN, ws + OFF_WMLA + j * SZ_WMLA + WM_UKV, 0, 0, NROW / 256, 8, 1, 256};
        g8::gemm_phase((PG8_LAS unsigned char*)lds, 256, S2, g8::epi_rc([=](const g8::Unit&, int row, int col, f32x4 v) { *(f32x4*)(KVRAW + (size_t)row * 2048 + col) = v; }));
    }
    else if constexpr (PH == PH_A_POST) ph_qkv_post(p);
    else if constexpr (PH == PH_A_ATTN) ph_attn_naive(p, lds);
    else if constexpr (PH == PH_A_WO || PH == PH_R_WO) {
        float* X = (float*)(ws + OFF_X); const float* MOD = (const float*)(ws + OFF_MOD);
        g8::BatchSched S{ws + (PH == PH_A_WO ? OFF_O : OFF_H), PH == PH_A_WO ? ws + OFF_WMLA + j * SZ_WMLA + WM_O : ws + OFF_WRW + j * SZ_WRW + WR_O, 0, 0, NROW / 256, 4, 1, D};
        g8::gemm_phase((PG8_LAS unsigned char*)lds, D, S, g8::epi_rc([=](const g8::Unit&, int row, int col, f32x4 v) {
            const f32x4 gt = *(const f32x4*)(MOD + ((size_t)layer * 5 + row_stream(row)) * 6144 + 2048 + col);
            f32x4* xp = (f32x4*)(X + (size_t)row * D + col); *xp = *xp + gt * v; }));
    }
    else if constexpr (PH == PH_R_NORM) ph_norm_mod<true>(p, layer, p.norm1_g + layer * D, 0, 1, ws + OFF_HF);
    else if constexpr (PH == PH_R_XS) ph_rw_xs(p, j);
    else if constexpr (PH == PH_R_G1) {
        float* RKV = (float*)(ws + OFF_RKV); float* VF = (float*)(ws + OFF_VFIRST);
        bf16_t* LW = (bf16_t*)(ws + OFF_LW); bf16_t* LA = (bf16_t*)(ws + OFF_LA); bf16_t* LG = (bf16_t*)(ws + OFF_LG); bf16_t* LV = (bf16_t*)(ws + OFF_LV);
        const bool first = (j == 0);
        struct RSched { const char* XS; const char* WB; int nwg;
            __device__ __forceinline__ bool next(int i, g8::Unit& u) const {
                const int L = i * (int)gridDim.x + (int)blockIdx.x; if (L >= nwg) return false;
                const int w = g8::xcd_remap(L, nwg);
                if (w < 816) { u.g = w / 272; const int r = w % 272; u.pm = r >> 2; u.pn = r & 3; u.B = WB + WR_RKV + (size_t)u.g * D * D * 2 + (size_t)u.pn * 256 * D * 2; }
                else { u.g = 3 + (w - 816) / 68; u.pm = (w - 816) % 68; u.pn = 0; u.B = WB + WR_L + (size_t)(u.g - 3) * 256 * D * 2; }
                u.A = XS + (size_t)(u.g == 6 ? 2 : u.g) * NROW * D * 2 + (size_t)u.pm * 256 * D * 2; return true; } };
        RSched S{ws + OFF_XS, ws + OFF_WRW + j * SZ_WRW, first ? 816 + 204 : 816 + 272};
        g8::gemm_phase((PG8_LAS unsigned char*)lds, D, S, g8::epi_rc([=](const g8::Unit& u, int row, int col, f32x4 v) {
            if (u.g < 3) { *(f32x4*)(RKV + ((size_t)u.g * NROW + row) * D + col) = v; if (first && u.g == 2) *(f32x4*)(VF + (size_t)row * D + col) = v; }
            else if (u.g == 3) { if (col < 128) { uint2 w; w.x = pk2(tanhf(v[0]), tanhf(v[1])); w.y = pk2(tanhf(v[2]), tanhf(v[3])); *(uint2*)(LW + (size_t)row * 128 + col) = w; } }
            else if (u.g == 4) { if (col < 128) { uint2 w; w.x = pk2(v[0], v[1]); w.y = pk2(v[2], v[3]); *(uint2*)(LA + (size_t)row * 128 + col) = w; } }
            else if (u.g == 5) { if (col < 128) { uint2 w; w.x = pk2(sigmoidf_(v[0]), sigmoidf_(v[1])); w.y = pk2(sigmoidf_(v[2]), sigmoidf_(v[3])); *(uint2*)(LG + (size_t)row * 128 + col) = w; } }
            else { if (col < 32) { uint2 w; w.x = pk2(v[0], v[1]); w.y = pk2(v[2], v[3]); *(uint2*)(LV + (size_t)row * 32 + col) = w; } } }));
    }
    else if constexpr (PH == PH_R_G2) {
        const bool first = (j == 0);
        float* W = (float*)(ws + OFF_W); float* AV = (float*)(ws + OFF_AV); float* G = (float*)(ws + OFF_G); float* RKV = (float*)(ws + OFF_RKV); const float* VF = (const float*)(ws + OFF_VFIRST);
        const float* w0 = p.rw_w0 + (size_t)j * 2 * D; const float* a0 = p.rw_a0 + (size_t)j * 2 * D; const float* v0 = p.rw_v0;
        SgArgs gw{(const bf16_t*)(ws + OFF_LW), 128, 64, p.rw_w2 + (size_t)j * 2 * 64 * D, D, (size_t)64 * D, NROW, D, 64, 2};
        sg_gemm(lds, gw, [=](int z, int row, int col, float v) { const float wz = v + w0[z * D + col];
            const float sp = (-wz > 20.f) ? -wz : log1pf(expf(-wz));
            W[((size_t)z * NROW + row) * D + col] = expf(-expf(-sp - 0.5f)); });
        SgArgs ga{(const bf16_t*)(ws + OFF_LA), 128, 64, p.rw_a2 + (size_t)j * 2 * 64 * D, D, (size_t)64 * D, NROW, D, 64, 2};
        sg_gemm(lds, ga, [=](int z, int row, int col, float v) { AV[((size_t)z * NROW + row) * D + col] = sigmoidf_(v + a0[z * D + col]); });
        SgArgs gg{(const bf16_t*)(ws + OFF_LG), 128, 0, p.rw_g2 + (size_t)j * 128 * D, D, 0, NROW, D, 128, 1};
        sg_gemm(lds, gg, [=](int, int row, int col, float v) { G[(size_t)row * D + col] = v; });
        if (!first) {
            SgArgs gv{(const bf16_t*)(ws + OFF_LV), 32, 0, p.rw_v2, D, 0, NROW, D, 32, 1};
            sg_gemm(lds, gv, [=](int, int row, int col, float v) { const size_t o = (size_t)row * D + col; const float vv = RKV[(size_t)2 * NROW * D + o];
                RKV[(size_t)2 * NROW * D + o] = vv + (VF[o] - vv) * sigmoidf_(v + v0[col]); });
        }
    }
    else if constexpr (PH == PH_R_PREP) ph_rw_prep(p, j);
    else if constexpr (PH == PH_R_SCAN) ph_rw_scan(p);
    else if constexpr (PH == PH_R_OUT) ph_rw_out(p, j);
    else if constexpr (PH == PH_M_NORM) ph_norm2_router(p, layer, lds);
    else if constexpr (PH == PH_M_SEL) ph_select(p, lds);
    else if constexpr (PH == PH_M_GATHER) ph_gather(p);
    else if constexpr (PH == PH_M_G1) {
        bf16_t* HID = (bf16_t*)(ws + OFF_HID);
        g8::BatchSched S{ws + OFF_XE, ws + OFF_W13T, (size_t)EPAD * D * 2, (size_t)2816 * D * 2, EPAD / 256, 11, NE, D};
        g8::gemm_phase((PG8_LAS unsigned char*)lds, D, S, g8::epi_pair([=](const g8::Unit& u, int row, int col, f32x4 a, f32x4 b) {
            uint2 w; w.x = pk2(a[0] / (1.f + __expf(-a[0])) * b[0], a[1] / (1.f + __expf(-a[1])) * b[1]); w.y = pk2(a[2] / (1.f + __expf(-a[2])) * b[2], a[3] / (1.f + __expf(-a[3])) * b[3]);
            *(uint2*)(HID + ((size_t)u.g * EPAD + row) * FF + col) = w; }));
    }
    else if constexpr (PH == PH_M_G2) {
        bf16_t* YE = (bf16_t*)(ws + OFF_YE); const float* GATE = (const float*)(ws + OFF_GATE);
        g8::BatchSched S{ws + OFF_HID, ws + OFF_W2T, (size_t)EPAD * FF * 2, (size_t)D * FF * 2, EPAD / 256, 4, NE, FF};
        g8::gemm_phase((PG8_LAS unsigned char*)lds, FF, S, g8::epi_rc([=](const g8::Unit& u, int row, int col, f32x4 v) {
            const float gt = GATE[u.g * EPAD + row];
            uint2 w; w.x = pk2(v[0] * gt, v[1] * gt); w.y = pk2(v[2] * gt, v[3] * gt);
            *(uint2*)(YE + ((size_t)u.g * EPAD + row) * D + col) = w; }));
    }
    else if constexpr (PH == PH_M_COMB) ph_combine(p, layer);
    else if constexpr (PH == PH_M_CVT) ph_moe_cvt(p, layer, lds);
    else if constexpr (PH == PH_FINAL) ph_final(p);
}

#if ONE_LAUNCH
#define SYNC() xcd_barrier(bar)
#define RUN(PH) do { Params q = p; asm volatile("" : "+s"(q.ws)); run_phase<PH>(q, layer, smem); SYNC(); } while (0)
__global__ void __launch_bounds__(NTHR, 2) mega(Params p) {
    extern __shared__ __attribute__((aligned(16))) char smem[];
    if (tidx() == 0) *(uint4*)(smem + LDS_BYTES) = make_uint4(0u, 0u, 0u, 0u);
    __syncthreads();
    XcdBarrier bar = xcd_barrier_post((unsigned*)(p.ws + OFF_BAR), (volatile LAS unsigned*)(smem + LDS_BYTES));
    { const int layer = 0; RUN(PH_INIT); }
    for (int layer = 0; layer < 4; ++layer) {
        if ((layer & 1) == 0) {
            RUN(PH_A_NORM);
            RUN(PH_A_Z);
            RUN(PH_A_MID);
            RUN(PH_A_QKV);
            RUN(PH_A_POST);
            RUN(PH_A_ATTN);
            RUN(PH_A_WO);
        } else {
            RUN(PH_R_NORM);
            RUN(PH_R_XS);
            RUN(PH_R_G1);
            RUN(PH_R_G2);
            RUN(PH_R_PREP);
            RUN(PH_R_SCAN);
            RUN(PH_R_OUT);
            RUN(PH_R_WO);
        }
        RUN(PH_M_CVT);
        RUN(PH_M_NORM);
        RUN(PH_M_SEL);
        RUN(PH_M_GATHER);
        RUN(PH_M_G1);
        RUN(PH_M_G2);
        RUN(PH_M_COMB);
    }
    run_phase<PH_FINAL>(p, 0, smem);
}
#else
template <int PH> __global__ void __launch_bounds__(NTHR, 2) kph(Params p, int layer) {
    extern __shared__ __attribute__((aligned(16))) char smem[];
    run_phase<PH>(p, layer, smem);
}
#endif

extern "C" void kernel_launch(void* const* d_in, const int* in_sizes, int n_in, void* d_out, int out_size, void* d_ws, size_t ws_size, hipStream_t stream) {
    if (n_in != 38 || ws_size < WS_NEED) { fprintf(stderr, "kernel_launch: bad args n_in %d ws %zu need %zu\n", n_in, ws_size, (size_t)WS_NEED); return; }
    Params p{};
    const float** pp = (const float**)&p;
    for (int i = 0; i < 38; ++i) pp[i] = (const float*)d_in[i];
    p.out = (float*)d_out; p.ws = (char*)d_ws;
    static int cus = 0;
    if (!cus) { int dev = 0; hipGetDevice(&dev); hipDeviceGetAttribute(&cus, hipDeviceAttributeMultiprocessorCount, dev); if (cus <= 0) cus = 256; }
    const int grid = cus;
#if ONE_LAUNCH
    hipFuncSetAttribute((const void*)mega, hipFuncAttributeMaxDynamicSharedMemorySize, LDS_BYTES + 16);
    hipMemsetAsync(d_ws, 0, XCD_BAR_WORDS * sizeof(unsigned), stream);
    hipLaunchKernelGGL(mega, dim3(grid), dim3(NTHR), LDS_BYTES + 16, stream, p);
#else
#define LAUNCH(PH, L) do { hipFuncSetAttribute((const void*)kph<PH>, hipFuncAttributeMaxDynamicSharedMemorySize, LDS_BYTES + 16); hipLaunchKernelGGL(kph<PH>, dim3(grid), dim3(NTHR), LDS_BYTES + 16, stream, p, L); } while (0)
    LAUNCH(PH_INIT, 0);
    for (int layer = 0; layer < 4; ++layer) {
        if ((layer & 1) == 0) { LAUNCH(PH_A_NORM, layer); LAUNCH(PH_A_Z, layer); LAUNCH(PH_A_MID, layer); LAUNCH(PH_A_QKV, layer); LAUNCH(PH_A_POST, layer); LAUNCH(PH_A_ATTN, layer); LAUNCH(PH_A_WO, layer); }
        else { LAUNCH(PH_R_NORM, layer); LAUNCH(PH_R_XS, layer); LAUNCH(PH_R_G1, layer); LAUNCH(PH_R_G2, layer); LAUNCH(PH_R_PREP, layer); LAUNCH(PH_R_SCAN, layer); LAUNCH(PH_R_OUT, layer); LAUNCH(PH_R_WO, layer); }
        LAUNCH(PH_M_CVT, layer); LAUNCH(PH_M_NORM, layer); LAUNCH(PH_M_SEL, layer); LAUNCH(PH_M_GATHER, layer); LAUNCH(PH_M_G1, layer); LAUNCH(PH_M_G2, layer); LAUNCH(PH_M_COMB, layer);
    }
    LAUNCH(PH_FINAL, 0);
#endif
}
```

```cpp
#include <hip/hip_runtime.h>
#include <stdint.h>
#include <stdio.h>

#ifndef ONE_LAUNCH
#define ONE_LAUNCH 1
#endif

#define NTHR 512
typedef unsigned short bf16_t;
typedef short bf16x8 __attribute__((ext_vector_type(8)));
typedef float f32x4 __attribute__((ext_vector_type(4)));
typedef unsigned u32x4 __attribute__((ext_vector_type(4)));

constexpr int D = 1024, NB = 4, TL = 4096, TC = 256, NLAT = NB * TL, NCTX = NB * TC, NROW = NLAT + NCTX;
constexpr int TK = TL + TC;
constexpr int NE = 16, FF = 1408, CAPL = 512, CAPC = 32, ESLOTS = NB * CAPL + NB * CAPC;
constexpr int EPAD = 2304;
constexpr float RMS_EPS = 1e-6f, LNX_EPS = 64e-5f;
constexpr float ATT_SCALE = 0.07216878364870322f;

constexpr size_t al256(size_t x) { return (x + 255) / 256 * 256; }
constexpr size_t OFF_BAR = 0;
constexpr size_t OFF_MOD = 16384;
constexpr size_t OFF_ROPE_C = OFF_MOD + al256(4 * 5 * 6144 * 4);
constexpr size_t OFF_ROPE_S = OFF_ROPE_C + al256(TL * 32 * 4);
constexpr size_t OFF_X = OFF_ROPE_S + al256(TL * 32 * 4);
constexpr size_t SZ_F32 = (size_t)NROW * D * 4, SZ_BF = (size_t)NROW * D * 2;
constexpr size_t OFF_VFIRST = OFF_X + SZ_F32;
constexpr size_t OFF_H = OFF_VFIRST + SZ_F32;
constexpr size_t SZ_WMLA = (size_t)(512 * 1024 + 1536 * 256 + 2048 * 256 + 1024 * 1024) * 2;
constexpr size_t WM_IN = 0, WM_UQ = (size_t)512 * 1024 * 2, WM_UKV = WM_UQ + (size_t)1536 * 256 * 2, WM_O = WM_UKV + (size_t)2048 * 256 * 2;
constexpr size_t SZ_WRW = (size_t)(3 * 1024 * 1024 + 4 * 256 * 1024 + 1024 * 1024) * 2;
constexpr size_t WR_RKV = 0, WR_L = (size_t)3 * 1024 * 1024 * 2, WR_O = WR_L + (size_t)4 * 256 * 1024 * 2;
constexpr size_t OFF_WMLA = OFF_H + SZ_BF;
constexpr size_t OFF_WRW = OFF_WMLA + 2 * SZ_WMLA;
constexpr size_t OFF_W13T = OFF_WRW + 2 * SZ_WRW;
constexpr size_t OFF_W2T = OFF_W13T + (size_t)NE * 2816 * D * 2;
constexpr size_t OFF_S = OFF_W2T + (size_t)NE * D * FF * 2;
constexpr size_t OFF_Z = OFF_S;
constexpr size_t OFF_CQN = OFF_Z + al256((size_t)NROW * 512 * 4);
constexpr size_t OFF_CKVN = OFF_CQN + al256((size_t)NROW * 256 * 2);
constexpr size_t OFF_KR = OFF_CKVN + al256((size_t)NROW * 256 * 2);
constexpr size_t OFF_QRAW = OFF_KR + al256((size_t)NROW * 64 * 4);
constexpr size_t OFF_KVRAW = OFF_QRAW + al256((size_t)NROW * 1536 * 4);
constexpr size_t OFF_Q = OFF_KVRAW + al256((size_t)NROW * 2048 * 4);
constexpr size_t OFF_K = OFF_Q + al256((size_t)NB * 8 * TK * 192 * 2);
constexpr size_t OFF_V = OFF_K + al256((size_t)NB * 8 * TK * 192 * 2);
constexpr size_t OFF_O = OFF_V + al256((size_t)NB * 8 * TK * 128 * 2);
constexpr size_t END_MLA = OFF_O + SZ_BF;
constexpr size_t OFF_HF = OFF_S;
constexpr size_t OFF_XS = OFF_HF + SZ_F32;
constexpr size_t OFF_RKV = OFF_XS + 6 * SZ_BF;
constexpr size_t OFF_W = OFF_RKV + 3 * SZ_F32;
constexpr size_t OFF_AV = OFF_W + 2 * SZ_F32;
constexpr size_t OFF_KD = OFF_AV + 2 * SZ_F32;
constexpr size_t OFF_G = OFF_KD + 2 * SZ_F32;
constexpr size_t OFF_LW = OFF_G + SZ_F32;
constexpr size_t OFF_LA = OFF_LW + al256((size_t)NROW * 128 * 2);
constexpr size_t OFF_LG = OFF_LA + al256((size_t)NROW * 128 * 2);
constexpr size_t OFF_LV = OFF_LG + al256((size_t)NROW * 128 * 2);
constexpr size_t END_RW = OFF_LV + al256((size_t)NROW * 32 * 2);
constexpr size_t OFF_Y = OFF_HF;
constexpr size_t OFF_AFF = OFF_S;
constexpr size_t OFF_ROWIDX = OFF_AFF + al256((size_t)NROW * 16 * 4);
constexpr size_t OFF_GATE = OFF_ROWIDX + al256((size_t)NE * ESLOTS * 4);
constexpr size_t OFF_SLOT = OFF_GATE + al256((size_t)NE * EPAD * 4);
constexpr size_t OFF_XE = OFF_SLOT + al256((size_t)NROW * 16 * 4);
constexpr size_t OFF_HID = OFF_XE + al256((size_t)NE * EPAD * D * 2);
constexpr size_t OFF_YE = OFF_HID + al256((size_t)NE * EPAD * FF * 2);
constexpr size_t END_MOE = OFF_YE + al256((size_t)NE * EPAD * D * 2);
constexpr size_t WS_NEED = END_RW > END_MLA ? (END_RW > END_MOE ? END_RW : END_MOE) : (END_MLA > END_MOE ? END_MLA : END_MOE);

constexpr int LDS_BYTES = 131072;

struct Params {
    const float *x, *c, *ctx, *c_ctx, *mod_w, *mod_b, *norm1_g, *norm2_g, *final_g;
    const float *mla_w_in, *mla_g_q, *mla_g_kv, *mla_w_uq, *mla_w_ukv, *mla_w_o;
    const float *rw_mu, *rw_w_rkv, *rw_w0, *rw_w1, *rw_w2, *rw_a0, *rw_a1, *rw_a2, *rw_v0, *rw_v1, *rw_v2, *rw_g1, *rw_g2, *rw_k_k, *rw_k_a, *rw_r_k, *rw_lnx_g, *rw_lnx_b, *rw_w_o;
    const float *moe_router, *moe_w1, *moe_w3, *moe_w2;
    float* out; char* ws;
};

__device__ __forceinline__ int tidx() { int t = threadIdx.x; asm volatile("" : "+v"(t)); return t; }
#define XB_TMO      128
#define XB_XCNT(j)  (256  + 64 * (j))
#define XB_XSUB(j)  (1280 + 64 * (j))
#define XB_XGEN(j)  (2304 + 64 * (j))
#define XB_TOP      3328
#define XB_TOPGEN   3392
#define XCD_BAR_WORDS 3456
#define XB_SPIN_CAP (1u << 22)
#define LAS __attribute__((address_space(3)))

__device__ __forceinline__ unsigned xb_ld(unsigned* p)              { return __hip_atomic_load(p, __ATOMIC_RELAXED, __HIP_MEMORY_SCOPE_AGENT); }
__device__ __forceinline__ unsigned xb_add(unsigned* p, unsigned v) { return __hip_atomic_fetch_add(p, v, __ATOMIC_RELAXED, __HIP_MEMORY_SCOPE_AGENT); }
__device__ __forceinline__ unsigned xb_xcc_id() { return (unsigned)__builtin_amdgcn_s_getreg((3 << 11) | 20) & 0xFu; }
#define XB_SPIN(cond, bar) do { unsigned _sp = 0; while (cond) { __builtin_amdgcn_s_sleep(1); \
    if ((++_sp & 255u) == 0u) { if (xb_ld(&(bar)[XB_TMO])) break; if (_sp > XB_SPIN_CAP) { atomicAdd(&(bar)[XB_TMO], 1u); break; } } } } while (0)

struct XcdBarrier { unsigned* bar; unsigned x; volatile LAS unsigned* st; };

__device__ __forceinline__ XcdBarrier xcd_barrier_post(unsigned* bar, volatile LAS unsigned* st) {
    XcdBarrier b; b.bar = bar; b.x = xb_xcc_id(); b.st = st;
    if (tidx() == 0) (void)xb_add(&bar[XB_XCNT(b.x)], 1u);
    return b;
}
__device__ __forceinline__ void xcd_barrier_complete(unsigned* bar, unsigned x, unsigned& nloc, unsigned& nx) {
    const unsigned G = gridDim.x * gridDim.y * gridDim.z;
    unsigned sum, cnt, mine, sp = 0u;
    for (;;) {
        sum = 0u; cnt = 0u; mine = 0u;
#pragma unroll
        for (unsigned j = 0; j < 16; ++j) { const unsigned c = xb_ld(&bar[XB_XCNT(j)]); sum += c; cnt += (c > 0u) ? 1u : 0u; mine = (j == x) ? c : mine; }
        if (sum == G) break;
        __builtin_amdgcn_s_sleep(1);
        if ((++sp & 255u) == 0u) { if (xb_ld(&bar[XB_TMO])) break; if (sp > XB_SPIN_CAP) { atomicAdd(&bar[XB_TMO], 1u); break; } }
    }
    nloc = mine > 0u ? mine : 1u; nx = cnt > 0u ? cnt : 1u;
}
__device__ __forceinline__ void xcd_barrier(const XcdBarrier& b) {
    asm volatile("s_waitcnt vmcnt(0)" ::: "memory");
    __syncthreads();
    if (tidx() == 0) {
        unsigned* bar = b.bar;
        __builtin_amdgcn_s_waitcnt(0);
        unsigned nloc = b.st[0], nx = b.st[1];
        if (nloc == 0u) { xcd_barrier_complete(bar, b.x, nloc, nx); b.st[0] = nloc; b.st[1] = nx; }
        const unsigned old = xb_add(&bar[XB_XSUB(b.x)], 1u);
        const unsigned gen = old / nloc;
        if (old + 1u == (gen + 1u) * nloc) {
            __builtin_amdgcn_fence(__ATOMIC_RELEASE, "agent");
            asm volatile("s_waitcnt vmcnt(0)" ::: "memory");
            const unsigned og = xb_add(&bar[XB_TOP], 1u);
            const unsigned tg = og / nx;
            if (og + 1u == (tg + 1u) * nx) xb_add(&bar[XB_TOPGEN], 1u);
            else XB_SPIN(xb_ld(&bar[XB_TOPGEN]) == tg, bar);
            __builtin_amdgcn_fence(__ATOMIC_ACQUIRE, "agent");
            xb_add(&bar[XB_XGEN(b.x)], 1u);
            asm volatile("s_waitcnt vmcnt(0)" ::: "memory");
        } else {
            XB_SPIN(xb_ld(&bar[XB_XGEN(b.x)]) == gen, bar);
            __builtin_amdgcn_fence(__ATOMIC_ACQUIRE, "agent");
            asm volatile("s_waitcnt vmcnt(0)" ::: "memory");
        }
    }
    __syncthreads();
}

__device__ __forceinline__ bf16_t f2bf(float f) { unsigned u = __float_as_uint(f); u += 0x7FFFu + ((u >> 16) & 1u); return (bf16_t)(u >> 16); }
__device__ __forceinline__ float bf2f(bf16_t b) { return __uint_as_float(((unsigned)b) << 16); }
__device__ __forceinline__ unsigned pk2(float lo, float hi) { return (unsigned)f2bf(lo) | ((unsigned)f2bf(hi) << 16); }
__device__ __forceinline__ float wave_sum(float v) { for (int o = 32; o >= 1; o >>= 1) v += __shfl_xor(v, o); return v; }
__device__ __forceinline__ float sigmoidf_(float x) { return 1.f / (1.f + expf(-x)); }
__device__ __forceinline__ int row_stream(int row) { return row < NLAT ? (row >> 12) : 4; }
__device__ __forceinline__ const float* modp(const Params& p, int layer, int s, int part) { return (const float*)(p.ws + OFF_MOD) + ((size_t)layer * 5 + s) * 6144 + part * 1024; }

struct SgArgs { const bf16_t* A; int lda; size_t strideA; const float* B; int ldb; size_t strideB; int M, N, K, nbatch; };
template <class Epi>
__device__ __forceinline__ void sg_gemm(char* lds, const SgArgs g, const Epi& epi) {
    bf16_t* As = (bf16_t*)lds;
    bf16_t* Bs = As + 128 * 40;
    const int tid = tidx(), wid = tid >> 6, lane = tid & 63;
    const int wr = wid >> 2, wc = wid & 3;
    const int tilesN = (g.N + 127) / 128, tilesM = g.M / 128, per = tilesM * tilesN, ntiles = per * g.nbatch;
    const int ar = tid >> 2, ak = (tid & 3) * 8;
    const int bn = tid & 127, bk = (tid >> 7) * 8;
    for (int tile = blockIdx.x; tile < ntiles; tile += gridDim.x) {
        const int bt = tile / per, tt = tile % per;
        const int tm = tt / tilesN, tn = tt % tilesN;
        const int m0 = tm * 128, n0 = tn * 128;
        f32x4 acc[4][2];
#pragma unroll
        for (int m = 0; m < 4; ++m)
#pragma unroll
            for (int n = 0; n < 2; ++n) acc[m][n] = (f32x4){0.f, 0.f, 0.f, 0.f};
        const bool bvalid = (n0 + bn) < g.N;
        const bf16_t* ap = g.A + bt * g.strideA + (size_t)(m0 + ar) * g.lda + ak;
        const float* bp = g.B + bt * g.strideB + (size_t)bk * g.ldb + n0 + bn;
        bf16x8 areg; float breg[8];
        areg = *(const bf16x8*)ap;
#pragma unroll
        for (int j = 0; j < 8; ++j) breg[j] = bvalid ? bp[(size_t)j * g.ldb] : 0.f;
        for (int k0 = 0; k0 < g.K; k0 += 32) {
            __syncthreads();
            *(bf16x8*)(As + ar * 40 + ak) = areg;
            { u32x4 w; w.x = pk2(breg[0], breg[1]); w.y = pk2(breg[2], breg[3]); w.z = pk2(breg[4], breg[5]); w.w = pk2(breg[6], breg[7]); *(u32x4*)(Bs + bn * 40 + bk) = w; }
            __syncthreads();
            if (k0 + 32 < g.K) {
                areg = *(const bf16x8*)(ap + k0 + 32);
#pragma unroll
                for (int j = 0; j < 8; ++j) breg[j] = bvalid ? bp[(size_t)(k0 + 32 + j) * g.ldb] : 0.f;
            }
            bf16x8 af[4], bfr[2];
#pragma unroll
            for (int m = 0; m < 4; ++m) af[m] = *(const bf16x8*)(As + (wr * 64 + m * 16 + (lane & 15)) * 40 + (lane >> 4) * 8);
#pragma unroll
            for (int n = 0; n < 2; ++n) bfr[n] = *(const bf16x8*)(Bs + (wc * 32 + n * 16 + (lane & 15)) * 40 + (lane >> 4) * 8);
#pragma unroll
            for (int m = 0; m < 4; ++m)
#pragma unroll
                for (int n = 0; n < 2; ++n) acc[m][n] = __builtin_amdgcn_mfma_f32_16x16x32_bf16(af[m], bfr[n], acc[m][n], 0, 0, 0);
        }
#pragma unroll
        for (int m = 0; m < 4; ++m)
#pragma unroll
            for (int n = 0; n < 2; ++n) {
                const int col = n0 + wc * 32 + n * 16 + (lane & 15);
                if (col < g.N) {
#pragma unroll
                    for (int r = 0; r < 4; ++r) epi(bt, m0 + wr * 64 + m * 16 + (lane >> 4) * 4 + r, col, acc[m][n][r]);
                }
            }
    }
}


namespace g8 {
#define PG8_LAS __attribute__((address_space(3)))
constexpr int BM = 256, BK = 64, HALF = 128, HTB = HALF * BK * 2, STAGE_BYTES = 8 * HTB;
__device__ __forceinline__ int lds_byte(int r, int c) { const int st = (r >> 4) * 2 + (c >> 5), rr = r & 15, cc = c & 31, ob = rr * 64 + cc * 2; return st * 1024 + (ob ^ (((ob >> 9) & 1) << 5)); }
__device__ __forceinline__ void stage_rc(int b, int& R, int& C) { const int st = b / 1024, sb = b % 1024, swz = sb ^ (((sb >> 9) & 1) << 5); R = (st >> 1) * 16 + swz / 64; C = (st & 1) * 32 + (swz % 64) / 2; }
struct Unit { int pm, pn, g; const char* A; const char* B; };
__device__ __forceinline__ int xcd_remap(int L, int nwg) { const int q = nwg / 8, r = nwg % 8, xcd = L % 8, off = L / 8; return (xcd < r ? xcd * (q + 1) : r * (q + 1) + (xcd - r) * q) + off; }

template <class Epi, class Sched>
__device__ __forceinline__ void gemm_phase(PG8_LAS unsigned char* lds, const int K, const Sched& S, const Epi& E) {
    const int tid = tidx(), wid = __builtin_amdgcn_readfirstlane(tid >> 6), lane = tid & 63, wr = wid >> 2, wc = wid & 3, fr = lane & 15, fq = lane >> 4;
    const int nt = K / BK;
    unsigned voffA[2];
#pragma unroll
    for (int i = 0; i < 2; ++i) { int R, C; stage_rc(tid * 16 + i * 8192, R, C); voffA[i] = (unsigned)(R * K + C) * 2u; }
    const size_t kstep = (size_t)(BK * 2);
    const size_t hstep = (size_t)HALF * K * 2;
    const unsigned ldsw = (unsigned)wid * 1024u;
    const int aoff = lds_byte(wr * 64 + fr, fq * 8), boff = lds_byte(wc * 32 + fr, fq * 8);
#define PG8_SA(b, h) (((b) * 2 + (h)) * HTB)
#define PG8_SB(b, h) ((4 + (b) * 2 + (h)) * HTB)
#define PG8_STAGE(bufoff, gbase, voff) do { _Pragma("unroll") for (int _i = 0; _i < 2; ++_i) \
        __builtin_amdgcn_global_load_lds((const unsigned*)((const char*)(gbase) + (voff)[_i]), (PG8_LAS unsigned*)(lds + (bufoff) + ldsw + _i * 8192), 16, 0, 0); } while (0)
#define PG8_LDA(dst, b, h) do { _Pragma("unroll") for (int m = 0; m < 4; ++m) _Pragma("unroll") for (int k = 0; k < 2; ++k) dst[m][k] = *(const PG8_LAS bf16x8*)(lds + PG8_SA(b, h) + aoff + m * 2048 + k * 1024); } while (0)
#define PG8_LDB(dst, b, h) do { _Pragma("unroll") for (int n = 0; n < 2; ++n) _Pragma("unroll") for (int k = 0; k < 2; ++k) dst[n][k] = *(const PG8_LAS bf16x8*)(lds + PG8_SB(b, h) + boff + n * 2048 + k * 1024); } while (0)
#define PG8_MMA(ai, bj, At, Bt) do { __builtin_amdgcn_s_setprio(1); _Pragma("unroll") for (int m = 0; m < 4; ++m) _Pragma("unroll") for (int n = 0; n < 2; ++n) _Pragma("unroll") for (int k = 0; k < 2; ++k) \
        acc[ai][bj][m][n] = __builtin_amdgcn_mfma_f32_16x16x32_bf16(Bt[n][k], At[m][k], acc[ai][bj][m][n], 0, 0, 0); __builtin_amdgcn_s_setprio(0); } while (0)
#define PG8_WAIT_V(n) asm volatile("s_waitcnt vmcnt(" #n ")" ::: "memory")
#define PG8_WAIT_L(n) asm volatile("s_waitcnt lgkmcnt(" #n ")" ::: "memory")
#define PG8_BAR __builtin_amdgcn_s_barrier()
#define PG8_SCHED __builtin_amdgcn_sched_barrier(0)
    Unit cur, nxt; int ui = 0;
    if (!S.next(0, cur)) return;
    f32x4 acc[2][2][4][2];
#pragma unroll
    for (int a = 0; a < 2; ++a)
#pragma unroll
        for (int b = 0; b < 2; ++b)
#pragma unroll
            for (int m = 0; m < 4; ++m)
#pragma unroll
                for (int n = 0; n < 2; ++n) acc[a][b][m][n] = (f32x4){0.f, 0.f, 0.f, 0.f};
    bf16x8 At[4][2], B0[2][2], B1[2][2];
    const char* cA = cur.A; const char* cB = cur.B;
    PG8_STAGE(PG8_SB(0, 0), cB, voffA); PG8_STAGE(PG8_SA(0, 0), cA, voffA); PG8_STAGE(PG8_SB(0, 1), cB + hstep, voffA); PG8_STAGE(PG8_SA(0, 1), cA + hstep, voffA);
    if (wr == 1) PG8_BAR;
    PG8_WAIT_V(4); PG8_BAR;
    PG8_STAGE(PG8_SB(1, 0), cB + kstep, voffA); PG8_STAGE(PG8_SA(1, 0), cA + kstep, voffA); PG8_STAGE(PG8_SB(1, 1), cB + hstep + kstep, voffA);
    PG8_WAIT_V(6); PG8_BAR;
    for (;;) {
        const bool has_next = S.next(ui + 1, nxt);
        const char* nA = has_next ? nxt.A : cA; const char* nB = has_next ? nxt.B : cB;
        for (int t = 0; t < nt; t += 2) {
            const bool last = (t == nt - 2);
            const char* a1 = cA + (size_t)(t + 1) * kstep;
            const char* a2 = last ? nA : cA + (size_t)(t + 2) * kstep; const char* b2 = last ? nB : cB + (size_t)(t + 2) * kstep;
            const char* a3 = a2 + kstep; const char* b3 = b2 + kstep;
            PG8_LDB(B0, 0, 0); PG8_SCHED; PG8_LDA(At, 0, 0); PG8_STAGE(PG8_SA(1, 1), a1 + hstep, voffA);
            PG8_WAIT_L(8); PG8_BAR; PG8_WAIT_L(0); PG8_MMA(0, 0, At, B0); PG8_BAR; PG8_SCHED;
            PG8_LDB(B1, 0, 1); PG8_STAGE(PG8_SB(0, 0), b2, voffA);
            PG8_BAR; PG8_WAIT_L(0); PG8_MMA(0, 1, At, B1); PG8_BAR;
            PG8_LDA(At, 0, 1); PG8_STAGE(PG8_SA(0, 0), a2, voffA);
            PG8_BAR; PG8_WAIT_L(0); PG8_MMA(1, 0, At, B0); PG8_BAR; PG8_SCHED;
            PG8_STAGE(PG8_SB(0, 1), b2 + hstep, voffA);
            PG8_WAIT_V(6); PG8_BAR; PG8_MMA(1, 1, At, B1); PG8_BAR;
            PG8_LDB(B0, 1, 0); PG8_SCHED; PG8_LDA(At, 1, 0); PG8_STAGE(PG8_SA(0, 1), a2 + hstep, voffA);
            PG8_WAIT_L(8); PG8_BAR; PG8_WAIT_L(0); PG8_MMA(0, 0, At, B0); PG8_BAR; PG8_SCHED;
            PG8_LDB(B1, 1, 1); PG8_STAGE(PG8_SB(1, 0), b3, voffA);
            PG8_BAR; PG8_WAIT_L(0); PG8_MMA(0, 1, At, B1); PG8_BAR;
            PG8_LDA(At, 1, 1); PG8_STAGE(PG8_SA(1, 0), a3, voffA);
            PG8_BAR; PG8_WAIT_L(0); PG8_MMA(1, 0, At, B0); PG8_BAR; PG8_SCHED;
            PG8_STAGE(PG8_SB(1, 1), b3 + hstep, voffA);
            PG8_WAIT_V(6); PG8_BAR; PG8_MMA(1, 1, At, B1); PG8_BAR;
        }
        E(acc, cur, wr, wc, fr, fq);
        if (!has_next) break;
#pragma unroll
        for (int a = 0; a < 2; ++a)
#pragma unroll
            for (int b = 0; b < 2; ++b)
#pragma unroll
                for (int m = 0; m < 4; ++m)
#pragma unroll
                    for (int n = 0; n < 2; ++n) acc[a][b][m][n] = (f32x4){0.f, 0.f, 0.f, 0.f};
        cur = nxt; cA = nA; cB = nB; ++ui;
    }
    PG8_WAIT_V(0);
    if (wr == 0) PG8_BAR;
    PG8_BAR;
#undef PG8_SA
#undef PG8_SB
#undef PG8_STAGE
#undef PG8_LDA
#undef PG8_LDB
#undef PG8_MMA
#undef PG8_WAIT_V
#undef PG8_WAIT_L
#undef PG8_BAR
#undef PG8_SCHED
}
template <class F> struct EpiRC { F f;
    __device__ __forceinline__ void operator()(const f32x4 (&acc)[2][2][4][2], const Unit& u, int wr, int wc, int fr, int fq) const {
#pragma unroll
        for (int ai = 0; ai < 2; ++ai)
#pragma unroll
            for (int m = 0; m < 4; ++m) { const int row = u.pm * BM + ai * HALF + wr * 64 + m * 16 + fr;
#pragma unroll
                for (int bj = 0; bj < 2; ++bj)
#pragma unroll
                    for (int n = 0; n < 2; ++n) f(u, row, u.pn * BM + bj * HALF + wc * 32 + n * 16 + 4 * fq, acc[ai][bj][m][n]); }
    } };
template <class F> __device__ __forceinline__ EpiRC<F> epi_rc(const F& f) { return EpiRC<F>{f}; }
template <class F> struct EpiPair { F f;
    __device__ __forceinline__ void operator()(const f32x4 (&acc)[2][2][4][2], const Unit& u, int wr, int wc, int fr, int fq) const {
#pragma unroll
        for (int ai = 0; ai < 2; ++ai)
#pragma unroll
            for (int m = 0; m < 4; ++m) { const int row = u.pm * BM + ai * HALF + wr * 64 + m * 16 + fr;
#pragma unroll
                for (int n = 0; n < 2; ++n) f(u, row, u.pn * HALF + wc * 32 + n * 16 + 4 * fq, acc[ai][0][m][n], acc[ai][1][m][n]); }
    } };
template <class F> __device__ __forceinline__ EpiPair<F> epi_pair(const F& f) { return EpiPair<F>{f}; }
struct BatchSched { const char* A; const char* B; size_t strideA, strideB; int nM, nN, nb, K;
    __device__ __forceinline__ bool next(int i, Unit& u) const {
        const int nwg = nM * nN * nb; const int L = i * (int)gridDim.x + (int)blockIdx.x; if (L >= nwg) return false;
        const int w = xcd_remap(L, nwg); const int per = nM * nN; u.g = w / per; const int r = w % per; u.pm = r / nN; u.pn = r % nN;
        u.A = A + u.g * strideA + (size_t)u.pm * BM * K * 2; u.B = B + u.g * strideB + (size_t)u.pn * BM * K * 2; return true; } };
}

template <class SrcF, class DRow>
__device__ __forceinline__ void cvt_tiles(char* lds, bf16_t* dst, int Kd, int Nd, int nbatch, size_t dstride, const SrcF& src, const DRow& drow) {
    bf16_t* T = (bf16_t*)lds;
    const int tid = tidx();
    const int tk = Kd / 128, tn = Nd / 64, per = tk * tn, total = per * nbatch;
    for (int t = blockIdx.x; t < total; t += gridDim.x) {
        const int bt = t / per, r = t % per, k0 = (r % tk) * 128, n0 = (r / tk) * 64;
        float4 v[4];
#pragma unroll
        for (int i = 0; i < 4; ++i) { const int k = k0 + i * 32 + (tid >> 4), n = n0 + (tid & 15) * 4; const float* sp = src(bt, k, n); v[i] = sp ? *(const float4*)sp : make_float4(0.f, 0.f, 0.f, 0.f); }
        __syncthreads();
#pragma unroll
        for (int i = 0; i < 4; ++i) { const int k = i * 32 + (tid >> 4), n = (tid & 15) * 4;
            T[(n + 0) * 136 + k] = f2bf(v[i].x); T[(n + 1) * 136 + k] = f2bf(v[i].y); T[(n + 2) * 136 + k] = f2bf(v[i].z); T[(n + 3) * 136 + k] = f2bf(v[i].w); }
        __syncthreads();
        { const int n = tid >> 3, kc = (tid & 7) * 16;
          const u32x4 a = *(const u32x4*)(T + n * 136 + kc), b = *(const u32x4*)(T + n * 136 + kc + 8);
          bf16_t* dp = dst + bt * dstride + (size_t)drow(n0 + n) * Kd + k0 + kc;
          *(u32x4*)dp = a; *(u32x4*)(dp + 8) = b; }
    }
}
__device__ void ph_moe_cvt(const Params& p, int layer, char* lds) {
    const float* w1 = p.moe_w1 + (size_t)layer * NE * D * FF; const float* w3 = p.moe_w3 + (size_t)layer * NE * D * FF; const float* w2 = p.moe_w2 + (size_t)layer * NE * FF * D;
    cvt_tiles(lds, (bf16_t*)(p.ws + OFF_W13T), D, 2816, NE, (size_t)2816 * D,
        [=](int e, int k, int n) -> const float* { const int pn = n >> 8, half = (n >> 7) & 1, c = pn * 128 + (n & 127); return (half ? w3 : w1) + ((size_t)e * D + k) * FF + c; },
        [=](int n) { return n; });
    cvt_tiles(lds, (bf16_t*)(p.ws + OFF_W2T), FF, D, NE, (size_t)D * FF,
        [=](int e, int k, int n) -> const float* { return w2 + ((size_t)e * FF + k) * D + n; },
        [=](int n) { return n; });
}

__device__ void ph_init(const Params& p, char* lds) {
    const int tid = tidx(), gtid = blockIdx.x * NTHR + tid, gsz = gridDim.x * NTHR;
    float4* X4 = (float4*)(p.ws + OFF_X);
    const float4* x4 = (const float4*)p.x; const float4* c4 = (const float4*)p.ctx;
    for (int i = gtid; i < NROW * 256; i += gsz) X4[i] = i < NLAT * 256 ? x4[i] : c4[i - NLAT * 256];
    float* rc = (float*)(p.ws + OFF_ROPE_C); float* rs = (float*)(p.ws + OFF_ROPE_S);
    for (int i = gtid; i < TL * 32; i += gsz) {
        const int t = i >> 5, f = i & 31; const float pos = (float)((f < 16) ? (t >> 6) : (t & 63));
        const float inv = powf(10000.f, -(float)(f & 15) / 16.f); const float ang = pos * inv; rc[i] = cosf(ang); rs[i] = sinf(ang);
    }
    float* sc = (float*)lds;
    float* red = sc + 5 * 1024;
    for (int i = tid; i < 5 * 1024; i += NTHR) { const float v = i < 4096 ? p.c[i] : p.c_ctx[i - 4096]; sc[i] = v / (1.f + expf(-v)); }
    __syncthreads();
    float* MOD = (float*)(p.ws + OFF_MOD);
    for (int item = blockIdx.x; item < 4 * 96; item += gridDim.x) {
        const int l = item / 96, cg = item % 96, col = tid & 63, n = cg * 64 + col, kg = tid >> 6;
        const float* w = p.mod_w + ((size_t)l * 1024 + kg * 128) * 6144 + n;
        float a0 = 0, a1 = 0, a2 = 0, a3 = 0, a4 = 0;
        for (int k = 0; k < 128; ++k) { const float wv = w[(size_t)k * 6144]; const int kk = kg * 128 + k;
            a0 += sc[kk] * wv; a1 += sc[1024 + kk] * wv; a2 += sc[2048 + kk] * wv; a3 += sc[3072 + kk] * wv; a4 += sc[4096 + kk] * wv; }
        float* rr = red + (kg * 64 + col) * 5; rr[0] = a0; rr[1] = a1; rr[2] = a2; rr[3] = a3; rr[4] = a4;
        __syncthreads();
        if (tid < 320) { const int c2 = tid & 63, s = tid >> 6; float sum = 0;
            for (int q = 0; q < 8; ++q) sum += red[(q * 64 + c2) * 5 + s];
            MOD[((size_t)l * 5 + s) * 6144 + cg * 64 + c2] = sum + p.mod_b[l * 6144 + cg * 64 + c2]; }
        __syncthreads();
    }
}


__device__ void ph_small_cvt(const Params& p, char* lds) {
    for (int j = 0; j < 2; ++j) {
        char* wm = p.ws + OFF_WMLA + j * SZ_WMLA; char* wr = p.ws + OFF_WRW + j * SZ_WRW;
        const float* w_in = p.mla_w_in + (size_t)j * D * 448; const float* w_uq = p.mla_w_uq + (size_t)j * 256 * 1536; const float* w_ukv = p.mla_w_ukv + (size_t)j * 128 * 2048; const float* w_o = p.mla_w_o + (size_t)j * D * D;
        cvt_tiles(lds, (bf16_t*)(wm + WM_IN), 1024, 512, 1, 0, [=](int, int k, int n) -> const float* { return n < 448 ? w_in + (size_t)k * 448 + n : nullptr; }, [=](int n) { return n; });
        cvt_tiles(lds, (bf16_t*)(wm + WM_UQ), 256, 1536, 1, 0, [=](int, int k, int n) -> const float* { return w_uq + (size_t)k * 1536 + n; }, [=](int n) { return n; });
        cvt_tiles(lds, (bf16_t*)(wm + WM_UKV), 256, 2048, 1, 0, [=](int, int k, int n) -> const float* { return k < 128 ? w_ukv + (size_t)k * 2048 + n : nullptr; }, [=](int n) { return n; });
        cvt_tiles(lds, (bf16_t*)(wm + WM_O), 1024, 1024, 1, 0, [=](int, int k, int n) -> const float* { return w_o + (size_t)k * D + n; }, [=](int n) { return n; });
        const float* w_rkv = p.rw_w_rkv + (size_t)j * 3 * D * D; const float* w1 = p.rw_w1 + (size_t)j * 2 * D * 64; const float* a1 = p.rw_a1 + (size_t)j * 2 * D * 64;
        const float* g1 = p.rw_g1 + (size_t)j * D * 128; const float* v1 = p.rw_v1; const float* rwo = p.rw_w_o + (size_t)j * D * D;
        cvt_tiles(lds, (bf16_t*)(wr + WR_RKV), 1024, 1024, 3, (size_t)D * D, [=](int m, int k, int n) -> const float* { return w_rkv + ((size_t)m * D + k) * D + n; }, [=](int n) { return n; });
        cvt_tiles(lds, (bf16_t*)(wr + WR_L), 1024, 256, 1, 0, [=](int, int k, int n) -> const float* { return n < 128 ? w1 + ((size_t)(n >> 6) * D + k) * 64 + (n & 63) : nullptr; }, [=](int n) { return n; });
        cvt_tiles(lds, (bf16_t*)(wr + WR_L) + 256 * 1024, 1024, 256, 1, 0, [=](int, int k, int n) -> const float* { return n < 128 ? a1 + ((size_t)(n >> 6) * D + k) * 64 + (n & 63) : nullptr; }, [=](int n) { return n; });
        cvt_tiles(lds, (bf16_t*)(wr + WR_L) + 2 * 256 * 1024, 1024, 256, 1, 0, [=](int, int k, int n) -> const float* { return n < 128 ? g1 + (size_t)k * 128 + n : nullptr; }, [=](int n) { return n; });
        cvt_tiles(lds, (bf16_t*)(wr + WR_L) + 3 * 256 * 1024, 1024, 256, 1, 0, [=](int, int k, int n) -> const float* { return n < 32 ? v1 + (size_t)k * 32 + n : nullptr; }, [=](int n) { return n; });
        cvt_tiles(lds, (bf16_t*)(wr + WR_O), 1024, 1024, 1, 0, [=](int, int k, int n) -> const float* { return rwo + (size_t)k * D + n; }, [=](int n) { return n; });
    }
}

template <bool OUTF32>
__device__ void ph_norm_mod(const Params& p, int layer, const float* g, int part_sh, int part_sc, void* outp) {
    const int wid = tidx() >> 6, lane = tidx() & 63;
    const float* X = (const float*)(p.ws + OFF_X);
    for (int row = blockIdx.x * 8 + wid; row < NROW; row += gridDim.x * 8) {
        const int s = row_stream(row);
        const float* sh = modp(p, layer, s, part_sh); const float* sc = modp(p, layer, s, part_sc);
        const float4* xr = (const float4*)(X + (size_t)row * D);
        float4 v[4]; float ss = 0;
#pragma unroll
        for (int i = 0; i < 4; ++i) { v[i] = xr[lane + i * 64]; ss += v[i].x * v[i].x + v[i].y * v[i].y + v[i].z * v[i].z + v[i].w * v[i].w; }
        ss = wave_sum(ss); const float rs = rsqrtf(ss * (1.f / D) + RMS_EPS);
#pragma unroll
        for (int i = 0; i < 4; ++i) {
            const int d = (lane + i * 64) * 4;
            const float4 gg = *(const float4*)(g + d), a = *(const float4*)(sc + d), b = *(const float4*)(sh + d);
            float4 o; o.x = v[i].x * rs * gg.x * (1.f + a.x) + b.x; o.y = v[i].y * rs * gg.y * (1.f + a.y) + b.y; o.z = v[i].z * rs * gg.z * (1.f + a.z) + b.z; o.w = v[i].w * rs * gg.w * (1.f + a.w) + b.w;
            if (OUTF32) *(float4*)((float*)outp + (size_t)row * D + d) = o;
            else { uint2 w; w.x = pk2(o.x, o.y); w.y = pk2(o.z, o.w); *(uint2*)((bf16_t*)outp + (size_t)row * D + d) = w; }
        }
    }
}

__device__ void ph_mla_mid(const Params& p, int j) {
    const int wid = tidx() >> 6, lane = tidx() & 63;
    const float* Z = (const float*)(p.ws + OFF_Z);
    bf16_t* CQN = (bf16_t*)(p.ws + OFF_CQN); bf16_t* CKVN = (bf16_t*)(p.ws + OFF_CKVN); float* KR = (float*)(p.ws + OFF_KR);
    const float* gq = p.mla_g_q + j * 256; const float* gkv = p.mla_g_kv + j * 128;
    const float* rc = (const float*)(p.ws + OFF_ROPE_C); const float* rs = (const float*)(p.ws + OFF_ROPE_S);
    for (int row = blockIdx.x * 8 + wid; row < NROW; row += gridDim.x * 8) {
        const float* z = Z + (size_t)row * 512;
        const float4 q = *(const float4*)(z + lane * 4);
        const float2 kv = *(const float2*)(z + 256 + lane * 2);
        const float kr = z[384 + lane];
        float sq = wave_sum(q.x * q.x + q.y * q.y + q.z * q.z + q.w * q.w); const float rq = rsqrtf(sq * (1.f / 256.f) + RMS_EPS);
        float sk = wave_sum(kv.x * kv.x + kv.y * kv.y); const float rk = rsqrtf(sk * (1.f / 128.f) + RMS_EPS);
        const float4 g4 = *(const float4*)(gq + lane * 4); const float2 g2 = *(const float2*)(gkv + lane * 2);
        uint2 w; w.x = pk2(q.x * rq * g4.x, q.y * rq * g4.y); w.y = pk2(q.z * rq * g4.z, q.w * rq * g4.w);
        *(uint2*)(CQN + (size_t)row * 256 + lane * 4) = w;
        *(unsigned*)(CKVN + (size_t)row * 256 + lane * 2) = pk2(kv.x * rk * g2.x, kv.y * rk * g2.y);
        *(unsigned*)(CKVN + (size_t)row * 256 + 128 + lane * 2) = 0u;
        float o = kr;
        const float other = __shfl_xor(kr, 32);
        if (row < NLAT) { const int t = row & (TL - 1), i = lane & 31; const float c = rc[t * 32 + i], s = rs[t * 32 + i];
            const float x1 = lane < 32 ? kr : other, x2 = lane < 32 ? other : kr;
            o = lane < 32 ? (x1 * c - x2 * s) : (x1 * s + x2 * c); }
        KR[(size_t)row * 64 + lane] = o;
    }
}

__device__ void ph_qkv_post(const Params& p) {
    const int wid = tidx() >> 6, lane = tidx() & 63;
    const float* QRAW = (const float*)(p.ws + OFF_QRAW); const float* KVRAW = (const float*)(p.ws + OFF_KVRAW); const float* KR = (const float*)(p.ws + OFF_KR);
    bf16_t* Q = (bf16_t*)(p.ws + OFF_Q); bf16_t* K = (bf16_t*)(p.ws + OFF_K); bf16_t* V = (bf16_t*)(p.ws + OFF_V);
    const float* rc = (const float*)(p.ws + OFF_ROPE_C); const float* rs = (const float*)(p.ws + OFF_ROPE_S);
    for (int it = blockIdx.x * 8 + wid; it < NROW * 8; it += gridDim.x * 8) {
        const int row = it >> 3, h = it & 7;
        const bool lat = row < NLAT; const int b = lat ? (row >> 12) : ((row - NLAT) >> 8); const int tk = lat ? 256 + (row & (TL - 1)) : ((row - NLAT) & 255);
        const size_t orow = (size_t)(b * 8 + h) * TK + tk;
        const float* q = QRAW + (size_t)row * 1536 + h * 192;
        const float q0 = q[lane], q1 = q[64 + lane]; float q2 = q[128 + lane];
        const float other = __shfl_xor(q2, 32);
        if (lat) { const int t = row & (TL - 1), i = lane & 31; const float c = rc[t * 32 + i], s = rs[t * 32 + i];
            const float x1 = lane < 32 ? q2 : other, x2 = lane < 32 ? other : q2; q2 = lane < 32 ? (x1 * c - x2 * s) : (x1 * s + x2 * c); }
        bf16_t* qo = Q + orow * 192; qo[lane] = f2bf(q0); qo[64 + lane] = f2bf(q1); qo[128 + lane] = f2bf(q2);
        const float* kv = KVRAW + (size_t)row * 2048 + h * 256;
        bf16_t* ko = K + orow * 192; ko[lane] = f2bf(kv[lane]); ko[64 + lane] = f2bf(kv[64 + lane]); ko[128 + lane] = f2bf(KR[(size_t)row * 64 + lane]);
        bf16_t* vo = V + orow * 128; vo[lane] = f2bf(kv[128 + lane]); vo[64 + lane] = f2bf(kv[192 + lane]);
    }
}

__device__ void ph_attn_naive(const Params& p, char* lds) {
    const int tid = tidx(), qi = tid >> 2, part = tid & 3;
    const bf16_t* Q = (const bf16_t*)(p.ws + OFF_Q); const bf16_t* K = (const bf16_t*)(p.ws + OFF_K); const bf16_t* V = (const bf16_t*)(p.ws + OFF_V);
    bf16_t* O = (bf16_t*)(p.ws + OFF_O);
    bf16_t* Ks = (bf16_t*)lds;
    bf16_t* Vs = Ks + 32 * 192;
    const int nitems = 32 * 34;
    for (int it = blockIdx.x; it < nitems; it += gridDim.x) {
        const int bh = it / 34, qb = it % 34; const int b = bh >> 3, h = bh & 7;
        const int nkeys = qb < 2 ? TC : TK;
        const int tq = qb * 128 + qi;
        const bf16_t* qp = Q + ((size_t)bh * TK + tq) * 192 + part * 48;
        float q[48];
#pragma unroll
        for (int i = 0; i < 48; ++i) q[i] = bf2f(qp[i]) * ATT_SCALE;
        float o[32];
#pragma unroll
        for (int i = 0; i < 32; ++i) o[i] = 0.f;
        float m = -1e30f, l = 0.f;
        for (int k0 = 0; k0 < nkeys; k0 += 32) {
            __syncthreads();
            {
                const bf16_t* kg = K + ((size_t)bh * TK + k0) * 192; const bf16_t* vg = V + ((size_t)bh * TK + k0) * 128;
                for (int c = tid; c < 768; c += NTHR) *(u32x4*)(Ks + c * 8) = *(const u32x4*)(kg + c * 8);
                *(u32x4*)(Vs + tid * 8) = *(const u32x4*)(vg + tid * 8);
            }
            __syncthreads();
#pragma unroll 1
            for (int kg = 0; kg < 32; kg += 8) {
                float s[8]; float tmax = -1e30f;
#pragma unroll
                for (int kk = 0; kk < 8; ++kk) {
                    const bf16_t* kr = Ks + (kg + kk) * 192 + part * 48; float acc = 0.f;
#pragma unroll
                    for (int i = 0; i < 48; ++i) acc += q[i] * bf2f(kr[i]);
                    acc += __shfl_xor(acc, 1); acc += __shfl_xor(acc, 2);
                    s[kk] = acc; tmax = fmaxf(tmax, acc);
                    asm volatile("" ::: "memory");
                }
                const float mn = fmaxf(m, tmax), alpha = expf(m - mn); m = mn; l *= alpha;
#pragma unroll
                for (int i = 0; i < 32; ++i) o[i] *= alpha;
#pragma unroll
                for (int kk = 0; kk < 8; ++kk) {
                    const float pw = expf(s[kk] - mn); l += pw;
                    const bf16_t* vr = Vs + (kg + kk) * 128 + part * 32;
#pragma unroll
                    for (int i = 0; i < 32; ++i) o[i] += pw * bf2f(vr[i]);
                    asm volatile("" ::: "memory");
                }
            }
        }
        const float rl = 1.f / l;
        const int row = qb < 2 ? (NLAT + b * TC + tq) : (b * TL + tq - TC);
        bf16_t* op = O + (size_t)row * D + h * 128 + part * 32;
#pragma unroll
        for (int i = 0; i < 32; ++i) op[i] = f2bf(o[i] * rl);
    }
}


namespace fa {
using s16x4  = __attribute__((ext_vector_type(4))) short;
using f32x16 = __attribute__((ext_vector_type(16))) float;
constexpr int DQK = 192, DV = 128, KVBLK = 64;
constexpr float THR = 8.f;
constexpr int SHM_V = KVBLK * DV * 2, SHM_K = KVBLK * DQK * 2;
constexpr int SHM_ATTN = 2 * SHM_V + 2 * SHM_K + 8 * 64 * 4;
#define KSWZ(row, colB) ((row) * 384 + ((colB) ^ (((row) & 7) << 4)))
#define SBAR() __builtin_amdgcn_sched_barrier(0)
__device__ __forceinline__ int crow(int r, int hi) { return (r & 3) + 8 * (r >> 2) + 4 * hi; }
__device__ __forceinline__ unsigned cvtpk(float lo, float hi) { unsigned r; asm volatile("v_cvt_pk_bf16_f32 %0, %1, %2" : "=v"(r) : "v"(lo), "v"(hi)); return r; }
__device__ __forceinline__ void partialSM(f32x16& p0, f32x16& p1, float& m_reg, float& mn, float& alpha) {
  constexpr float C = ATT_SCALE * 1.4426950408889634f;
  float pmax = p0[0];
#pragma unroll
  for (int r = 1; r < 16; ++r) pmax = fmaxf(pmax, p0[r]);
#pragma unroll
  for (int r = 0; r < 16; ++r) pmax = fmaxf(pmax, p1[r]);
  { auto rr = __builtin_amdgcn_permlane32_swap(__float_as_uint(pmax), __float_as_uint(pmax), false, false);
    pmax = fmaxf(__uint_as_float(rr[0]), __uint_as_float(rr[1])); }
  if (__builtin_expect(__all(pmax - m_reg <= THR / ATT_SCALE), 1)) { mn = m_reg; alpha = 1.f; }
  else { mn = fmaxf(m_reg, pmax); alpha = __builtin_amdgcn_exp2f((m_reg - mn) * C); m_reg = mn; }
  float mnC = -mn * C;
#pragma unroll
  for (int r = 0; r < 16; ++r) p0[r] = fmaf(p0[r], C, mnC);
#pragma unroll
  for (int r = 0; r < 16; ++r) p1[r] = fmaf(p1[r], C, mnC);
#pragma unroll
  for (int r = 0; r < 16; ++r) p0[r] = __builtin_amdgcn_exp2f(p0[r]);
}
__device__ __forceinline__ void finishSM(f32x16& p0, f32x16& p1, float alpha, float& l_reg, bf16x8& pa0, bf16x8& pa1, bf16x8& pa2, bf16x8& pa3) {
#pragma unroll
  for (int r = 0; r < 16; ++r) p1[r] = __builtin_amdgcn_exp2f(p1[r]);
  float ps = 0;
#pragma unroll
  for (int r = 0; r < 16; ++r) ps += p0[r];
#pragma unroll
  for (int r = 0; r < 16; ++r) ps += p1[r];
  { auto rr = __builtin_amdgcn_permlane32_swap(__float_as_uint(ps), __float_as_uint(ps), false, false);
    ps = __uint_as_float(rr[0]) + __uint_as_float(rr[1]); }
  l_reg = l_reg * alpha + ps;
#define PK4(P, BASE, OUT) do { unsigned a0 = cvtpk(P[BASE + 0], P[BASE + 1]), a1 = cvtpk(P[BASE + 2], P[BASE + 3]);   \
    unsigned b0 = cvtpk(P[BASE + 4], P[BASE + 5]), b1 = cvtpk(P[BASE + 6], P[BASE + 7]);                              \
    auto r0 = __builtin_amdgcn_permlane32_swap(a0, b0, false, false); auto r1 = __builtin_amdgcn_permlane32_swap(a1, b1, false, false); \
    u32x4 w = {r0[0], r1[0], r0[1], r1[1]}; OUT = *reinterpret_cast<bf16x8*>(&w); } while (0)
  PK4(p0, 0, pa0); PK4(p0, 8, pa1); PK4(p1, 0, pa2); PK4(p1, 8, pa3);
#undef PK4
}
__device__ __forceinline__ void qkt(f32x16& p0, f32x16& p1, const char* Ks, const bf16x8* qr, int r32, int hi) {
  p0 = f32x16{}; p1 = f32x16{};
  const int swz = (r32 & 7) << 4;
  const char* b4[4];
#pragma unroll
  for (int dr = 0; dr < 4; ++dr) b4[dr] = Ks + r32 * 384 + ((dr * 32 + hi * 16) ^ swz);
#pragma unroll
  for (int d0 = 0; d0 < 12; ++d0) {
    bf16x8 b0 = *reinterpret_cast<const bf16x8*>(b4[d0 & 3] + (d0 >> 2) * 128);
    bf16x8 b1 = *reinterpret_cast<const bf16x8*>(b4[d0 & 3] + (d0 >> 2) * 128 + 32 * 384);
    p0 = __builtin_amdgcn_mfma_f32_32x32x16_bf16(b0, qr[d0], p0, 0, 0, 0);
    p1 = __builtin_amdgcn_mfma_f32_32x32x16_bf16(b1, qr[d0], p1, 0, 0, 0); }
}
__device__ __forceinline__ int v_st(int k, int c) { const int kk = (k & ~0xC) | ((k & 4) << 1) | ((k & 8) >> 1); return ((kk >> 3) * 4 + (c >> 5)) * 512 + ((kk & 7) * 32 + (c & 31)) * 2; }
__device__ __forceinline__ int v_rd_base(int lane) { return ((lane & 3) << 3) | (((lane >> 2) & 3) << 6) | (((lane >> 4) & 1) << 5) | (((lane >> 5) & 1) << 8); }
constexpr int v_rd_off(int d0, int ks, int half) { return d0 * 512 + ks * 4096 + half * 2048; }
template <int OFF> __device__ __forceinline__ s16x4 tr_read(int vb) {
  s16x4 r; asm volatile("ds_read_b64_tr_b16 %0, %1 offset:%2" : "=&v"(r) : "v"(vb), "i"(OFF) : "memory"); return r;
}
template <int D0> __device__ __forceinline__ void pv_one(f32x16& od, int vb, bf16x8 pa0, bf16x8 pa1, bf16x8 pa2, bf16x8 pa3) {
  const s16x4 l0 = tr_read<v_rd_off(D0, 0, 0)>(vb), h0 = tr_read<v_rd_off(D0, 0, 1)>(vb), l1 = tr_read<v_rd_off(D0, 1, 0)>(vb), h1 = tr_read<v_rd_off(D0, 1, 1)>(vb);
  const s16x4 l2 = tr_read<v_rd_off(D0, 2, 0)>(vb), h2 = tr_read<v_rd_off(D0, 2, 1)>(vb), l3 = tr_read<v_rd_off(D0, 3, 0)>(vb), h3 = tr_read<v_rd_off(D0, 3, 1)>(vb);
  asm volatile("s_waitcnt lgkmcnt(0)" ::: "memory"); SBAR();
#define PK(L, H) (bf16x8){L[0], L[1], L[2], L[3], H[0], H[1], H[2], H[3]}
  od = __builtin_amdgcn_mfma_f32_32x32x16_bf16(pa0, PK(l0, h0), od, 0, 0, 0);
  od = __builtin_amdgcn_mfma_f32_32x32x16_bf16(pa1, PK(l1, h1), od, 0, 0, 0);
  od = __builtin_amdgcn_mfma_f32_32x32x16_bf16(pa2, PK(l2, h2), od, 0, 0, 0);
  od = __builtin_amdgcn_mfma_f32_32x32x16_bf16(pa3, PK(l3, h3), od, 0, 0, 0);
#undef PK
}
__device__ __forceinline__ void pv_d0(f32x16* o, int vb, bf16x8 pa0, bf16x8 pa1, bf16x8 pa2, bf16x8 pa3) {
  pv_one<0>(o[0], vb, pa0, pa1, pa2, pa3); pv_one<1>(o[1], vb, pa0, pa1, pa2, pa3); pv_one<2>(o[2], vb, pa0, pa1, pa2, pa3); pv_one<3>(o[3], vb, pa0, pa1, pa2, pa3);
}
__device__ __forceinline__ void attn_body(const bf16_t* __restrict__ Qb, const bf16_t* __restrict__ Kh, const bf16_t* __restrict__ Vh, bf16_t* __restrict__ Ob, int ldo, int seq, char* lds) {
  const int tid = tidx(), wid = tid >> 6, lane = tid & 63, r32 = lane & 31, hi = lane >> 5;
  char* V_lds = lds; char* K_lds = lds + 2 * SHM_V;
  float* ws = (float*)(lds + 2 * SHM_V + 2 * SHM_K) + wid * 64; float* li_l = ws; float* al_l = ws + 32;
  float m_reg = -1e30f, l_reg = 0; f32x16 o[4] = {}; bf16x8 qr[12];
  const bf16_t* Qw = Qb + (long)(wid * 32 + r32) * DQK + hi * 8;
#pragma unroll
  for (int d0 = 0; d0 < 12; ++d0) qr[d0] = *reinterpret_cast<const bf16x8*>(Qw + d0 * 16);
  const int sr = tid >> 4, sc = (tid & 15) * 8, vst0 = v_st(sr, sc), vst1 = v_st(32 + sr, sc);
  int kst[3];
#pragma unroll
  for (int i = 0; i < 3; ++i) { const int c = tid + 512 * i, row = c / 24, cc = c % 24; kst[i] = KSWZ(row, cc * 16); }
  const int vb0 = (int)(uintptr_t)V_lds + v_rd_base(lane);
  struct { bf16x8 vs0, vs1, ks0, ks1, ks2; } sr_[1];
#define SLOAD(i, k0) do { const bf16_t* vt = Vh + (long)(k0) * DV; const bf16_t* kt = Kh + (long)(k0) * DQK; \
    sr_[i].vs0 = *reinterpret_cast<const bf16x8*>(vt + (sr) * DV + sc); sr_[i].vs1 = *reinterpret_cast<const bf16x8*>(vt + (32 + sr) * DV + sc); \
    sr_[i].ks0 = *reinterpret_cast<const bf16x8*>(kt + tid * 8); sr_[i].ks1 = *reinterpret_cast<const bf16x8*>(kt + (tid + 512) * 8); sr_[i].ks2 = *reinterpret_cast<const bf16x8*>(kt + (tid + 1024) * 8); } while (0)
#define SWRITE(b, i) do { *(bf16x8*)(V_lds + (b) * SHM_V + vst0) = sr_[i].vs0; *(bf16x8*)(V_lds + (b) * SHM_V + vst1) = sr_[i].vs1; \
    *(bf16x8*)(K_lds + (b) * SHM_K + kst[0]) = sr_[i].ks0; *(bf16x8*)(K_lds + (b) * SHM_K + kst[1]) = sr_[i].ks1; *(bf16x8*)(K_lds + (b) * SHM_K + kst[2]) = sr_[i].ks2; } while (0)
#define SWAIT() asm volatile("s_waitcnt vmcnt(5)" ::: "memory")
#define RESC(a) do { if (__any((a) < 1.f)) { if (hi == 0) al_l[r32] = (a); asm volatile("s_waitcnt lgkmcnt(0)" ::: "memory"); \
    _Pragma("unroll") for (int d = 0; d < 4; ++d) _Pragma("unroll") for (int r = 0; r < 16; ++r) o[d][r] *= al_l[crow(r, hi)]; } } while (0)
  f32x16 pA0, pA1; float mnA, alA; bf16x8 pa0, pa1, pa2, pa3; const int NT = seq / KVBLK;
  SLOAD(0, 0); SWRITE(0, 0);
  SLOAD(0, KVBLK);
  __syncthreads();
  for (int j = 0; j < NT; j += 2) {
    SBAR(); qkt(pA0, pA1, K_lds, qr, r32, hi);
    partialSM(pA0, pA1, m_reg, mnA, alA); RESC(alA);
    finishSM(pA0, pA1, alA, l_reg, pa0, pa1, pa2, pa3); SBAR();
    SWRITE(1, 0);
    if (j + 2 < NT) SLOAD(0, (j + 2) * KVBLK);
    SBAR();
    pv_d0(o, vb0, pa0, pa1, pa2, pa3);
    __syncthreads();
    SBAR(); qkt(pA0, pA1, K_lds + SHM_K, qr, r32, hi);
    partialSM(pA0, pA1, m_reg, mnA, alA); RESC(alA);
    finishSM(pA0, pA1, alA, l_reg, pa0, pa1, pa2, pa3); SBAR();
    if (j + 2 < NT) { SWRITE(0, 0); if (j + 3 < NT) SLOAD(0, (j + 3) * KVBLK); }
    SBAR();
    pv_d0(o, vb0 + SHM_V, pa0, pa1, pa2, pa3);
    __syncthreads();
  }
  if (hi == 0) li_l[r32] = l_reg; asm volatile("s_waitcnt lgkmcnt(0)" ::: "memory");
  float rli[16];
#pragma unroll
  for (int r = 0; r < 16; ++r) rli[r] = __builtin_amdgcn_rcpf(li_l[crow(r, hi)]);
  bf16_t* Ow = Ob + (long)(wid * 32) * ldo;
#pragma unroll
  for (int r = 0; r < 16; ++r) { int orow = crow(r, hi);
#pragma unroll
    for (int d0 = 0; d0 < 4; ++d0) Ow[(long)orow * ldo + d0 * 32 + r32] = f2bf(o[d0][r] * rli[r]); }
  __syncthreads();
#undef SLOAD
#undef SWRITE
#undef SWAIT
#undef RESC
}
#undef KSWZ
}

__device__ void ph_attn(const Params& p, char* lds) {
    const bf16_t* Q = (const bf16_t*)(p.ws + OFF_Q); const bf16_t* K = (const bf16_t*)(p.ws + OFF_K); const bf16_t* V = (const bf16_t*)(p.ws + OFF_V);
    bf16_t* O = (bf16_t*)(p.ws + OFF_O);
    const int G = gridDim.x;
    for (int i = 0;; ++i) {
        const int L = i * G + (int)blockIdx.x; if (L >= 544) break;
        int bh, qb;
        if (L < 512) { const int w = g8::xcd_remap(L, 512); bh = w >> 4; qb = 1 + (w & 15); } else { bh = L - 512; qb = 0; }
        const int b = bh >> 3, h = bh & 7;
        const int seq = qb == 0 ? TC : TK;
        const int row0 = qb == 0 ? NLAT + b * TC : b * TL + (qb - 1) * 256;
        fa::attn_body(Q + ((size_t)bh * TK + qb * 256) * 192, K + (size_t)bh * TK * 192, V + (size_t)bh * TK * 128, O + (size_t)row0 * D + h * 128, D, seq, lds);
    }
}

__device__ void ph_norm2_router(const Params& p, int layer, char* lds) {
    const int tid = tidx(), wid = tid >> 6, lane = tid & 63;
    float* rt = (float*)lds;
    const float* rg = p.moe_router + (size_t)layer * D * NE;
    for (int i = tid; i < D * NE / 4; i += NTHR) ((float4*)rt)[i] = ((const float4*)rg)[i];
    __syncthreads();
    const float* X = (const float*)(p.ws + OFF_X); bf16_t* BN = (bf16_t*)(p.ws + OFF_H); float* AFF = (float*)(p.ws + OFF_AFF);
    const float* g = p.norm2_g + layer * D;
    for (int row = blockIdx.x * 8 + wid; row < NROW; row += gridDim.x * 8) {
        const int s = row_stream(row);
        const float* sh = modp(p, layer, s, 3); const float* sc = modp(p, layer, s, 4);
        const float4* xr = (const float4*)(X + (size_t)row * D);
        float4 v[4]; float ss = 0;
#pragma unroll
        for (int i = 0; i < 4; ++i) { v[i] = xr[lane + i * 64]; ss += v[i].x * v[i].x + v[i].y * v[i].y + v[i].z * v[i].z + v[i].w * v[i].w; }
        ss = wave_sum(ss); const float rs = rsqrtf(ss * (1.f / D) + RMS_EPS);
        float lg[16];
#pragma unroll
        for (int e = 0; e < 16; ++e) lg[e] = 0.f;
#pragma unroll
        for (int i = 0; i < 4; ++i) {
            const int d = (lane + i * 64) * 4;
            const float4 gg = *(const float4*)(g + d), a = *(const float4*)(sc + d), b = *(const float4*)(sh + d);
            float o[4]; o[0] = v[i].x * rs * gg.x * (1.f + a.x) + b.x; o[1] = v[i].y * rs * gg.y * (1.f + a.y) + b.y; o[2] = v[i].z * rs * gg.z * (1.f + a.z) + b.z; o[3] = v[i].w * rs * gg.w * (1.f + a.w) + b.w;
            uint2 w; w.x = pk2(o[0], o[1]); w.y = pk2(o[2], o[3]); *(uint2*)(BN + (size_t)row * D + d) = w;
#pragma unroll
            for (int jj = 0; jj < 4; ++jj) { const float* rr = rt + (d + jj) * 16;
#pragma unroll
                for (int e = 0; e < 16; ++e) lg[e] += o[jj] * rr[e];
                asm volatile("" ::: "memory"); }
        }
        float mx = -1e30f;
#pragma unroll
        for (int e = 0; e < 16; ++e) { lg[e] = wave_sum(lg[e]); mx = fmaxf(mx, lg[e]); }
        float sum = 0;
#pragma unroll
        for (int e = 0; e < 16; ++e) { lg[e] = expf(lg[e] - mx); sum += lg[e]; }
        const float inv = 1.f / sum;
        if (lane < 16) { float val = 0;
#pragma unroll
            for (int e = 0; e < 16; ++e) val = (lane == e) ? lg[e] : val;
            AFF[(size_t)row * 16 + lane] = val * inv; }
    }
}

__device__ void ph_select(const Params& p, char* lds) {
    const int tid = tidx();
    float* vals = (float*)lds;
    const float* AFF = (const float*)(p.ws + OFF_AFF);
    int* ROWIDX = (int*)(p.ws + OFF_ROWIDX); float* GATE = (float*)(p.ws + OFF_GATE); int* SLOT = (int*)(p.ws + OFF_SLOT);
    for (int gidx = blockIdx.x; gidx < 128; gidx += gridDim.x) {
        const bool lat = gidx < 64; const int b = (gidx & 63) >> 4, e = gidx & 15;
        const int n = lat ? TL : TC, cap = lat ? CAPL : CAPC;
        const int row0 = lat ? b * TL : NLAT + b * TC, slot0 = lat ? b * CAPL : NB * CAPL + b * CAPC;
        __syncthreads();
        for (int i = tid; i < n; i += NTHR) vals[i] = AFF[(size_t)(row0 + i) * 16 + e];
        __syncthreads();
        for (int i = tid; i < n; i += NTHR) {
            const float v = vals[i]; int rank = 0;
            for (int jj = 0; jj < n; ++jj) { const float u = vals[jj]; rank += (u > v || (u == v && jj < i)) ? 1 : 0; }
            if (rank < cap) { ROWIDX[e * ESLOTS + slot0 + rank] = row0 + i; GATE[e * EPAD + slot0 + rank] = v; SLOT[(size_t)(row0 + i) * 16 + e] = slot0 + rank; }
            else SLOT[(size_t)(row0 + i) * 16 + e] = -1;
        }
    }
}

__device__ void ph_gather(const Params& p) {
    const int wid = tidx() >> 6, lane = tidx() & 63;
    const int* ROWIDX = (const int*)(p.ws + OFF_ROWIDX); const bf16_t* BN = (const bf16_t*)(p.ws + OFF_H); bf16_t* XE = (bf16_t*)(p.ws + OFF_XE);
    for (int it = blockIdx.x * 8 + wid; it < NE * ESLOTS; it += gridDim.x * 8) {
        const int row = ROWIDX[it]; const int e = it / ESLOTS, sl = it % ESLOTS;
        const u32x4* src = (const u32x4*)(BN + (size_t)row * D); u32x4* dst = (u32x4*)(XE + ((size_t)e * EPAD + sl) * D);
        dst[lane] = src[lane]; dst[lane + 64] = src[lane + 64];
    }
}

__device__ void ph_combine(const Params& p, int layer) {
    const int wid = tidx() >> 6, lane = tidx() & 63;
    const int* SLOT = (const int*)(p.ws + OFF_SLOT); const bf16_t* YE = (const bf16_t*)(p.ws + OFF_YE); float* X = (float*)(p.ws + OFF_X);
    for (int row = blockIdx.x * 8 + wid; row < NROW; row += gridDim.x * 8) {
        const float* gt = modp(p, layer, row_stream(row), 5);
        float acc[16];
#pragma unroll
        for (int i = 0; i < 16; ++i) acc[i] = 0.f;
        for (int e = 0; e < NE; ++e) {
            const int s = SLOT[(size_t)row * 16 + e];
            if (s >= 0) { const bf16_t* y = YE + ((size_t)e * EPAD + s) * D + lane * 16;
                const u32x4 a = *(const u32x4*)y, b = *(const u32x4*)(y + 8);
                const unsigned w[8] = {a.x, a.y, a.z, a.w, b.x, b.y, b.z, b.w};
#pragma unroll
                for (int i = 0; i < 8; ++i) { acc[2 * i] += __uint_as_float(w[i] << 16); acc[2 * i + 1] += __uint_as_float(w[i] & 0xffff0000u); } }
        }
        float* xr = X + (size_t)row * D + lane * 16; const float* g = gt + lane * 16;
#pragma unroll
        for (int i = 0; i < 16; i += 4) { float4 xv = *(float4*)(xr + i); const float4 gv = *(const float4*)(g + i);
            xv.x += gv.x * acc[i]; xv.y += gv.y * acc[i + 1]; xv.z += gv.z * acc[i + 2]; xv.w += gv.w * acc[i + 3]; *(float4*)(xr + i) = xv; }
    }
}

__device__ void ph_rw_xs(const Params& p, int j) {
    const float* HF = (const float*)(p.ws + OFF_HF); bf16_t* XS = (bf16_t*)(p.ws + OFF_XS);
    const float* mu = p.rw_mu + (size_t)j * 6 * D;
    const int gtid = blockIdx.x * NTHR + tidx(), gsz = gridDim.x * NTHR;
    for (int i = gtid; i < NROW * 256; i += gsz) {
        const int row = i >> 8, d = (i & 255) * 4;
        const bool lat = row < NLAT; const int t = lat ? (row & (TL - 1)) : ((row - NLAT) & (TC - 1)); const int len = lat ? TL : TC;
        const float4 h = *(const float4*)(HF + (size_t)row * D + d);
        float4 pv = make_float4(0, 0, 0, 0), nx = make_float4(0, 0, 0, 0);
        if (t > 0) pv = *(const float4*)(HF + (size_t)(row - 1) * D + d);
        if (t < len - 1) nx = *(const float4*)(HF + (size_t)(row + 1) * D + d);
        float4 xx; xx.x = 0.5f * (pv.x + nx.x) - h.x; xx.y = 0.5f * (pv.y + nx.y) - h.y; xx.z = 0.5f * (pv.z + nx.z) - h.z; xx.w = 0.5f * (pv.w + nx.w) - h.w;
#pragma unroll
        for (int m = 0; m < 6; ++m) { const float4 u = *(const float4*)(mu + m * D + d);
            uint2 w; w.x = pk2(h.x + xx.x * u.x, h.y + xx.y * u.y); w.y = pk2(h.z + xx.z * u.z, h.w + xx.w * u.w);
            *(uint2*)(XS + ((size_t)m * NROW + row) * D + d) = w; }
    }
}

__device__ void ph_rw_prep(const Params& p, int j) {
    const int wid = tidx() >> 6, lane = tidx() & 63;
    float* RKV = (float*)(p.ws + OFF_RKV); float* AV = (float*)(p.ws + OFF_AV); float* KD = (float*)(p.ws + OFF_KD);
    const float* k_k = p.rw_k_k + j * D; const float* k_a = p.rw_k_a + j * D;
    for (int row = blockIdx.x * 8 + wid; row < NROW; row += gridDim.x * 8) {
        const size_t o = (size_t)row * D + lane * 16;
        float k[16], kk[16]; float ss = 0;
#pragma unroll
        for (int i = 0; i < 16; ++i) { k[i] = RKV[(size_t)NROW * D + o + i]; kk[i] = k[i] * k_k[lane * 16 + i]; ss += kk[i] * kk[i]; }
        ss += __shfl_xor(ss, 1); ss += __shfl_xor(ss, 2);
        const float inv = 1.f / fmaxf(sqrtf(ss), 1e-12f);
#pragma unroll
        for (int i = 0; i < 16; ++i) kk[i] *= inv;
#pragma unroll
        for (int z = 0; z < 2; ++z)
#pragma unroll
            for (int i = 0; i < 16; ++i) { const float a = AV[(size_t)z * NROW * D + o + i];
                KD[(size_t)z * NROW * D + o + i] = k[i] * (1.f + (a - 1.f) * k_a[lane * 16 + i]);
                AV[(size_t)z * NROW * D + o + i] = kk[i] * a; }
#pragma unroll
        for (int i = 0; i < 16; ++i) RKV[(size_t)NROW * D + o + i] = kk[i];
    }
}

__device__ void ph_rw_scan(const Params& p) {
    const int tid = tidx(), wid = tid >> 6, lane = tid & 63, vr = lane >> 3, ks = lane & 7;
    const float* RKV = (const float*)(p.ws + OFF_RKV); const float* W = (const float*)(p.ws + OFF_W); const float* BBp = (const float*)(p.ws + OFF_AV); const float* KD = (const float*)(p.ws + OFF_KD);
    float* Y = (float*)(p.ws + OFF_Y);
    const size_t PL = (size_t)NROW * D;
    for (int it = blockIdx.x; it < 128; it += gridDim.x) {
        const int z = it & 1, h = (it >> 1) & 15, b = it >> 5;
        float S[8];
#pragma unroll
        for (int i = 0; i < 8; ++i) S[i] = 0.f;
        const int co = h * 64 + ks * 8, vo = h * 64 + wid * 8 + vr;
        for (int ph = 0; ph < 2; ++ph) {
            const int n = ph == 0 ? TC : TL; const int base = ph == 0 ? NLAT + b * TC : b * TL;
            for (int st = 0; st < n; ++st) {
                const int t = z == 0 ? st : n - 1 - st; const size_t ro = (size_t)(base + t) * D;
                float w[8], kk[8], bb[8], kd[8], r[8];
                *(float4*)w = *(const float4*)(W + z * PL + ro + co); *(float4*)(w + 4) = *(const float4*)(W + z * PL + ro + co + 4);
                *(float4*)kk = *(const float4*)(RKV + PL + ro + co); *(float4*)(kk + 4) = *(const float4*)(RKV + PL + ro + co + 4);
                *(float4*)bb = *(const float4*)(BBp + z * PL + ro + co); *(float4*)(bb + 4) = *(const float4*)(BBp + z * PL + ro + co + 4);
                *(float4*)kd = *(const float4*)(KD + z * PL + ro + co); *(float4*)(kd + 4) = *(const float4*)(KD + z * PL + ro + co + 4);
                *(float4*)r = *(const float4*)(RKV + ro + co); *(float4*)(r + 4) = *(const float4*)(RKV + ro + co + 4);
                const float v = RKV[2 * PL + ro + vo];
                float sa = 0;
#pragma unroll
                for (int i = 0; i < 8; ++i) sa -= S[i] * kk[i];
                sa += __shfl_xor(sa, 1); sa += __shfl_xor(sa, 2); sa += __shfl_xor(sa, 4);
                float y = 0;
#pragma unroll
                for (int i = 0; i < 8; ++i) { S[i] = S[i] * w[i] + sa * bb[i] + v * kd[i]; y += S[i] * r[i]; }
                y += __shfl_xor(y, 1); y += __shfl_xor(y, 2); y += __shfl_xor(y, 4);
                if (ks == 0) Y[z * PL + ro + vo] = y;
            }
        }
    }
}

__device__ void ph_rw_out(const Params& p, int j) {
    const int wid = tidx() >> 6, lane = tidx() & 63;
    const float* RKV = (const float*)(p.ws + OFF_RKV); const float* KD = (const float*)(p.ws + OFF_KD); const float* G = (const float*)(p.ws + OFF_G); const float* Y = (const float*)(p.ws + OFF_Y);
    bf16_t* OUT = (bf16_t*)(p.ws + OFF_H);
    const size_t PL = (size_t)NROW * D;
    const float* r_k = p.rw_r_k + j * D; const float* lg = p.rw_lnx_g + j * D; const float* lb = p.rw_lnx_b + j * D;
    for (int row = blockIdx.x * 8 + wid; row < NROW; row += gridDim.x * 8) {
        const size_t o = (size_t)row * D + lane * 16;
        float y[16]; float s = 0;
#pragma unroll
        for (int i = 0; i < 16; ++i) { y[i] = Y[o + i] + Y[PL + o + i]; s += y[i]; }
        s += __shfl_xor(s, 1); s += __shfl_xor(s, 2); const float mean = s * (1.f / 64.f);
        float q = 0;
#pragma unroll
        for (int i = 0; i < 16; ++i) { const float dd = y[i] - mean; q += dd * dd; }
        q += __shfl_xor(q, 1); q += __shfl_xor(q, 2); const float rstd = rsqrtf(q * (1.f / 64.f) + LNX_EPS);
        float bs = 0;
#pragma unroll
        for (int i = 0; i < 16; ++i) bs += RKV[o + i] * (KD[o + i] + KD[PL + o + i]) * r_k[lane * 16 + i];
        bs += __shfl_xor(bs, 1); bs += __shfl_xor(bs, 2);
        unsigned w[8];
#pragma unroll
        for (int i = 0; i < 16; i += 2) {
            const float o0 = ((y[i] - mean) * rstd * lg[lane * 16 + i] + lb[lane * 16 + i] + bs * RKV[2 * PL + o + i]) * G[o + i];
            const float o1 = ((y[i + 1] - mean) * rstd * lg[lane * 16 + i + 1] + lb[lane * 16 + i + 1] + bs * RKV[2 * PL + o + i + 1]) * G[o + i + 1];
            w[i >> 1] = pk2(o0, o1); }
        *(u32x4*)(OUT + o) = (u32x4){w[0], w[1], w[2], w[3]}; *(u32x4*)(OUT + o + 8) = (u32x4){w[4], w[5], w[6], w[7]};
    }
}

__device__ void ph_final(const Params& p) {
    const int wid = tidx() >> 6, lane = tidx() & 63;
    const float* X = (const float*)(p.ws + OFF_X);
    for (int row = blockIdx.x * 8 + wid; row < NLAT; row += gridDim.x * 8) {
        const float4* xr = (const float4*)(X + (size_t)row * D);
        float4 v[4]; float ss = 0;
#pragma unroll
        for (int i = 0; i < 4; ++i) { v[i] = xr[lane + i * 64]; ss += v[i].x * v[i].x + v[i].y * v[i].y + v[i].z * v[i].z + v[i].w * v[i].w; }
        ss = wave_sum(ss); const float rs = rsqrtf(ss * (1.f / D) + RMS_EPS);
#pragma unroll
        for (int i = 0; i < 4; ++i) { const int d = (lane + i * 64) * 4; const float4 gg = *(const float4*)(p.final_g + d);
            float4 o; o.x = v[i].x * rs * gg.x; o.y = v[i].y * rs * gg.y; o.z = v[i].z * rs * gg.z; o.w = v[i].w * rs * gg.w;
            *(float4*)(p.out + (size_t)row * D + d) = o; }
    }
}

enum { PH_INIT = 0, PH_A_NORM, PH_A_Z, PH_A_MID, PH_A_QKV, PH_A_POST, PH_A_ATTN, PH_A_WO,
       PH_R_NORM, PH_R_XS, PH_R_G1, PH_R_G2, PH_R_PREP, PH_R_SCAN, PH_R_OUT, PH_R_WO,
       PH_M_NORM, PH_M_SEL, PH_M_GATHER, PH_M_G1, PH_M_G2, PH_M_COMB, PH_FINAL, PH_M_CVT };

template <int PH>
__device__ __forceinline__ void run_phase(const Params& p, int layer, char* lds) {
    const int j = layer >> 1;
    char* ws = p.ws;
    if constexpr (PH == PH_INIT) { ph_init(p, lds); __syncthreads(); ph_small_cvt(p, lds); }
    else if constexpr (PH == PH_A_NORM) ph_norm_mod<false>(p, layer, p.norm1_g + layer * D, 0, 1, ws + OFF_H);
    else if constexpr (PH == PH_A_Z) {
        float* Z = (float*)(ws + OFF_Z);
        g8::BatchSched S{ws + OFF_H, ws + OFF_WMLA + j * SZ_WMLA + WM_IN, 0, 0, NROW / 256, 2, 1, D};
        g8::gemm_phase((PG8_LAS unsigned char*)lds, D, S, g8::epi_rc([=](const g8::Unit&, int row, int col, f32x4 v) { *(f32x4*)(Z + (size_t)row * 512 + col) = v; }));
    }
    else if constexpr (PH == PH_A_MID) ph_mla_mid(p, j);
    else if constexpr (PH == PH_A_QKV) {
        float* QRAW = (float*)(ws + OFF_QRAW); float* KVRAW = (float*)(ws + OFF_KVRAW);
        g8::BatchSched S1{ws + OFF_CQN, ws + OFF_WMLA + j * SZ_WMLA + WM_UQ, 0, 0, NROW / 256, 6, 1, 256};
        g8::gemm_phase((PG8_LAS unsigned char*)lds, 256, S1, g8::epi_rc([=](const g8::Unit&, int row, int col, f32x4 v) { *(f32x4*)(QRAW + (size_t)row * 1536 + col) = v; }));
        g8::BatchSched S2{ws + OFF_CKVN, ws + OFF_WMLA + j * SZ_WMLA + WM_UKV, 0, 0, NROW / 256, 8, 1, 256};
        g8::gemm_phase((PG8_LAS unsigned char*)lds, 256, S2, g8::epi_rc([=](const g8::Unit&, int row, int col, f32x4 v) { *(f32x4*)(KVRAW + (size_t)row * 2048 + col) = v; }));
    }
    else if constexpr (PH == PH_A_POST) ph_qkv_post(p);
    else if constexpr (PH == PH_A_ATTN) ph_attn(p, lds);
    else if constexpr (PH == PH_A_WO || PH == PH_R_WO) {
        float* X = (float*)(ws + OFF_X); const float* MOD = (const float*)(ws + OFF_MOD);
        g8::BatchSched S{ws + (PH == PH_A_WO ? OFF_O : OFF_H), PH == PH_A_WO ? ws + OFF_WMLA + j * SZ_WMLA + WM_O : ws + OFF_WRW + j * SZ_WRW + WR_O, 0, 0, NROW / 256, 4, 1, D};
        g8::gemm_phase((PG8_LAS unsigned char*)lds, D, S, g8::epi_rc([=](const g8::Unit&, int row, int col, f32x4 v) {
            const f32x4 gt = *(const f32x4*)(MOD + ((size_t)layer * 5 + row_stream(row)) * 6144 + 2048 + col);
            f32x4* xp = (f32x4*)(X + (size_t)row * D + col); *xp = *xp + gt * v; }));
    }
    else if constexpr (PH == PH_R_NORM) ph_norm_mod<true>(p, layer, p.norm1_g + layer * D, 0, 1, ws + OFF_HF);
    else if constexpr (PH == PH_R_XS) ph_rw_xs(p, j);
    else if constexpr (PH == PH_R_G1) {
        float* RKV = (float*)(ws + OFF_RKV); float* VF = (float*)(ws + OFF_VFIRST);
        bf16_t* LW = (bf16_t*)(ws + OFF_LW); bf16_t* LA = (bf16_t*)(ws + OFF_LA); bf16_t* LG = (bf16_t*)(ws + OFF_LG); bf16_t* LV = (bf16_t*)(ws + OFF_LV);
        const bool first = (j == 0);
        struct RSched { const char* XS; const char* WB; int nwg;
            __device__ __forceinline__ bool next(int i, g8::Unit& u) const {
                const int L = i * (int)gridDim.x + (int)blockIdx.x; if (L >= nwg) return false;
                const int w = g8::xcd_remap(L, nwg);
                if (w < 816) { u.g = w / 272; const int r = w % 272; u.pm = r >> 2; u.pn = r & 3; u.B = WB + WR_RKV + (size_t)u.g * D * D * 2 + (size_t)u.pn * 256 * D * 2; }
                else { u.g = 3 + (w - 816) / 68; u.pm = (w - 816) % 68; u.pn = 0; u.B = WB + WR_L + (size_t)(u.g - 3) * 256 * D * 2; }
                u.A = XS + (size_t)(u.g == 6 ? 2 : u.g) * NROW * D * 2 + (size_t)u.pm * 256 * D * 2; return true; } };
        RSched S{ws + OFF_XS, ws + OFF_WRW + j * SZ_WRW, first ? 816 + 204 : 816 + 272};
        g8::gemm_phase((PG8_LAS unsigned char*)lds, D, S, g8::epi_rc([=](const g8::Unit& u, int row, int col, f32x4 v) {
            if (u.g < 3) { *(f32x4*)(RKV + ((size_t)u.g * NROW + row) * D + col) = v; if (first && u.g == 2) *(f32x4*)(VF + (size_t)row * D + col) = v; }
            else if (u.g == 3) { if (col < 128) { uint2 w; w.x = pk2(tanhf(v[0]), tanhf(v[1])); w.y = pk2(tanhf(v[2]), tanhf(v[3])); *(uint2*)(LW + (size_t)row * 128 + col) = w; } }
            else if (u.g == 4) { if (col < 128) { uint2 w; w.x = pk2(v[0], v[1]); w.y = pk2(v[2], v[3]); *(uint2*)(LA + (size_t)row * 128 + col) = w; } }
            else if (u.g == 5) { if (col < 128) { uint2 w; w.x = pk2(sigmoidf_(v[0]), sigmoidf_(v[1])); w.y = pk2(sigmoidf_(v[2]), sigmoidf_(v[3])); *(uint2*)(LG + (size_t)row * 128 + col) = w; } }
            else { if (col < 32) { uint2 w; w.x = pk2(v[0], v[1]); w.y = pk2(v[2], v[3]); *(uint2*)(LV + (size_t)row * 32 + col) = w; } } }));
    }
    else if constexpr (PH == PH_R_G2) {
        const bool first = (j == 0);
        float* W = (float*)(ws + OFF_W); float* AV = (float*)(ws + OFF_AV); float* G = (float*)(ws + OFF_G); float* RKV = (float*)(ws + OFF_RKV); const float* VF = (const float*)(ws + OFF_VFIRST);
        const float* w0 = p.rw_w0 + (size_t)j * 2 * D; const float* a0 = p.rw_a0 + (size_t)j * 2 * D; const float* v0 = p.rw_v0;
        SgArgs gw{(const bf16_t*)(ws + OFF_LW), 128, 64, p.rw_w2 + (size_t)j * 2 * 64 * D, D, (size_t)64 * D, NROW, D, 64, 2};
        sg_gemm(lds, gw, [=](int z, int row, int col, float v) { const float wz = v + w0[z * D + col];
            const float sp = (-wz > 20.f) ? -wz : log1pf(expf(-wz));
            W[((size_t)z * NROW + row) * D + col] = expf(-expf(-sp - 0.5f)); });
        SgArgs ga{(const bf16_t*)(ws + OFF_LA), 128, 64, p.rw_a2 + (size_t)j * 2 * 64 * D, D, (size_t)64 * D, NROW, D, 64, 2};
        sg_gemm(lds, ga, [=](int z, int row, int col, float v) { AV[((size_t)z * NROW + row) * D + col] = sigmoidf_(v + a0[z * D + col]); });
        SgArgs gg{(const bf16_t*)(ws + OFF_LG), 128, 0, p.rw_g2 + (size_t)j * 128 * D, D, 0, NROW, D, 128, 1};
        sg_gemm(lds, gg, [=](int, int row, int col, float v) { G[(size_t)row * D + col] = v; });
        if (!first) {
            SgArgs gv{(const bf16_t*)(ws + OFF_LV), 32, 0, p.rw_v2, D, 0, NROW, D, 32, 1};
            sg_gemm(lds, gv, [=](int, int row, int col, float v) { const size_t o = (size_t)row * D + col; const float vv = RKV[(size_t)2 * NROW * D + o];
                RKV[(size_t)2 * NROW * D + o] = vv + (VF[o] - vv) * sigmoidf_(v + v0[col]); });
        }
    }
    else if constexpr (PH == PH_R_PREP) ph_rw_prep(p, j);
    else if constexpr (PH == PH_R_SCAN) ph_rw_scan(p);
    else if constexpr (PH == PH_R_OUT) ph_rw_out(p, j);
    else if constexpr (PH == PH_M_NORM) ph_norm2_router(p, layer, lds);
    else if constexpr (PH == PH_M_SEL) ph_select(p, lds);
    else if constexpr (PH == PH_M_GATHER) ph_gather(p);
    else if constexpr (PH == PH_M_G1) {
        bf16_t* HID = (bf16_t*)(ws + OFF_HID);
        g8::BatchSched S{ws + OFF_XE, ws + OFF_W13T, (size_t)EPAD * D * 2, (size_t)2816 * D * 2, EPAD / 256, 11, NE, D};
        g8::gemm_phase((PG8_LAS unsigned char*)lds, D, S, g8::epi_pair([=](const g8::Unit& u, int row, int col, f32x4 a, f32x4 b) {
            uint2 w; w.x = pk2(a[0] / (1.f + __expf(-a[0])) * b[0], a[1] / (1.f + __expf(-a[1])) * b[1]); w.y = pk2(a[2] / (1.f + __expf(-a[2])) * b[2], a[3] / (1.f + __expf(-a[3])) * b[3]);
            *(uint2*)(HID + ((size_t)u.g * EPAD + row) * FF + col) = w; }));
    }
    else if constexpr (PH == PH_M_G2) {
        bf16_t* YE = (bf16_t*)(ws + OFF_YE); const float* GATE = (const float*)(ws + OFF_GATE);
        g8::BatchSched S{ws + OFF_HID, ws + OFF_W2T, (size_t)EPAD * FF * 2, (size_t)D * FF * 2, EPAD / 256, 4, NE, FF};
        g8::gemm_phase((PG8_LAS unsigned char*)lds, FF, S, g8::epi_rc([=](const g8::Unit& u, int row, int col, f32x4 v) {
            const float gt = GATE[u.g * EPAD + row];
            uint2 w; w.x = pk2(v[0] * gt, v[1] * gt); w.y = pk2(v[2] * gt, v[3] * gt);
            *(uint2*)(YE + ((size_t)u.g * EPAD + row) * D + col) = w; }));
    }
    else if constexpr (PH == PH_M_COMB) ph_combine(p, layer);
    else if constexpr (PH == PH_M_CVT) ph_moe_cvt(p, layer, lds);
    else if constexpr (PH == PH_FINAL) ph_final(p);
}

#if ONE_LAUNCH
#define SYNC() xcd_barrier(bar)
#define RUN(PH) do { Params q = p; asm volatile("" : "+s"(q.ws)); run_phase<PH>(q, layer, smem); SYNC(); } while (0)
__global__ void __launch_bounds__(NTHR, 2) mega(Params p) {
    extern __shared__ __attribute__((aligned(16))) char smem[];
    if (tidx() == 0) *(uint4*)(smem + LDS_BYTES) = make_uint4(0u, 0u, 0u, 0u);
    __syncthreads();
    XcdBarrier bar = xcd_barrier_post((unsigned*)(p.ws + OFF_BAR), (volatile LAS unsigned*)(smem + LDS_BYTES));
    { const int layer = 0; RUN(PH_INIT); }
    for (int layer = 0; layer < 4; ++layer) {
        if ((layer & 1) == 0) {
            RUN(PH_A_NORM);
            RUN(PH_A_Z);
            RUN(PH_A_MID);
            RUN(PH_A_QKV);
            RUN(PH_A_POST);
            RUN(PH_A_ATTN);
            RUN(PH_A_WO);
        } else {
            RUN(PH_R_NORM);
            RUN(PH_R_XS);
            RUN(PH_R_G1);
            RUN(PH_R_G2);
            RUN(PH_R_PREP);
            RUN(PH_R_SCAN);
            RUN(PH_R_OUT);
            RUN(PH_R_WO);
        }
        RUN(PH_M_CVT);
        RUN(PH_M_NORM);
        RUN(PH_M_SEL);
        RUN(PH_M_GATHER);
        RUN(PH_M_G1);
        RUN(PH_M_G2);
        RUN(PH_M_COMB);
    }
    run_phase<PH_FINAL>(p, 0, smem);
}
#else
template <int PH> __global__ void __launch_bounds__(NTHR, 2) kph(Params p, int layer) {
    extern __shared__ __attribute__((aligned(16))) char smem[];
    run_phase<PH>(p, layer, smem);
}
#endif

extern "C" void kernel_launch(void* const* d_in, const int* in_sizes, int n_in, void* d_out, int out_size, void* d_ws, size_t ws_size, hipStream_t stream) {
    if (n_in != 38 || ws_size < WS_NEED) { fprintf(stderr, "kernel_launch: bad args n_in %d ws %zu need %zu\n", n_in, ws_size, (size_t)WS_NEED); return; }
    Params p{};
    const float** pp = (const float**)&p;
    for (int i = 0; i < 38; ++i) pp[i] = (const float*)d_in[i];
    p.out = (float*)d_out; p.ws = (char*)d_ws;
    static int cus = 0;
    if (!cus) { int dev = 0; hipGetDevice(&dev); hipDeviceGetAttribute(&cus, hipDeviceAttributeMultiprocessorCount, dev); if (cus <= 0) cus = 256; }
    const int grid = cus;
#if ONE_LAUNCH
    hipFuncSetAttribute((const void*)mega, hipFuncAttributeMaxDynamicSharedMemorySize, LDS_BYTES + 16);
    hipMemsetAsync(d_ws, 0, XCD_BAR_WORDS * sizeof(unsigned), stream);
    hipLaunchKernelGGL(mega, dim3(grid), dim3(NTHR), LDS_BYTES + 16, stream, p);
#else
#define LAUNCH(PH, L) do { hipFuncSetAttribute((const void*)kph<PH>, hipFuncAttributeMaxDynamicSharedMemorySize, LDS_BYTES + 16); hipLaunchKernelGGL(kph<PH>, dim3(grid), dim3(NTHR), LDS_BYTES + 16, stream, p, L); } while (0)
    LAUNCH(PH_INIT, 0);
    for (int layer = 0; layer < 4; ++layer) {
        if ((layer & 1) == 0) { LAUNCH(PH_A_NORM, layer); LAUNCH(PH_A_Z, layer); LAUNCH(PH_A_MID, layer); LAUNCH(PH_A_QKV, layer); LAUNCH(PH_A_POST, layer); LAUNCH(PH_A_ATTN, layer); LAUNCH(PH_A_WO, layer); }
        else { LAUNCH(PH_R_NORM, layer); LAUNCH(PH_R_XS, layer); LAUNCH(PH_R_G1, layer); LAUNCH(PH_R_G2, layer); LAUNCH(PH_R_PREP, layer); LAUNCH(PH_R_SCAN, layer); LAUNCH(PH_R_OUT, layer); LAUNCH(PH_R_WO, layer); }
        LAUNCH(PH_M_CVT, layer); LAUNCH(PH_M_NORM, layer); LAUNCH(PH_M_SEL, layer); LAUNCH(PH_M_GATHER, layer); LAUNCH(PH_M_G1, layer); LAUNCH(PH_M_G2, layer); LAUNCH(PH_M_COMB, layer);
    }
    LAUNCH(PH_FINAL, 0);
#endif
}
```

```cpp
#include <hip/hip_runtime.h>
#include <stdint.h>
#include <stdio.h>

#ifndef ONE_LAUNCH
#define ONE_LAUNCH 1
#endif

#define NTHR 512
typedef unsigned short bf16_t;
typedef short bf16x8 __attribute__((ext_vector_type(8)));
typedef float f32x4 __attribute__((ext_vector_type(4)));
typedef unsigned u32x4 __attribute__((ext_vector_type(4)));

constexpr int D = 1024, NB = 4, TL = 4096, TC = 256, NLAT = NB * TL, NCTX = NB * TC, NROW = NLAT + NCTX;
constexpr int TK = TL + TC;
constexpr int NE = 16, FF = 1408, CAPL = 512, CAPC = 32, ESLOTS = NB * CAPL + NB * CAPC;
constexpr int EPAD = 2304;
constexpr float RMS_EPS = 1e-6f, LNX_EPS = 64e-5f;
constexpr float ATT_SCALE = 0.07216878364870322f;

constexpr size_t al256(size_t x) { return (x + 255) / 256 * 256; }
constexpr size_t OFF_BAR = 0;
constexpr size_t OFF_MOD = 16384;
constexpr size_t OFF_ROPE_C = OFF_MOD + al256(4 * 5 * 6144 * 4);
constexpr size_t OFF_ROPE_S = OFF_ROPE_C + al256(TL * 32 * 4);
constexpr size_t OFF_X = OFF_ROPE_S + al256(TL * 32 * 4);
constexpr size_t SZ_F32 = (size_t)NROW * D * 4, SZ_BF = (size_t)NROW * D * 2;
constexpr size_t OFF_VFIRST = OFF_X + SZ_F32;
constexpr size_t OFF_H = OFF_VFIRST + SZ_F32;
constexpr size_t SZ_WMLA = (size_t)(512 * 1024 + 1536 * 256 + 2048 * 256 + 1024 * 1024) * 2;
constexpr size_t WM_IN = 0, WM_UQ = (size_t)512 * 1024 * 2, WM_UKV = WM_UQ + (size_t)1536 * 256 * 2, WM_O = WM_UKV + (size_t)2048 * 256 * 2;
constexpr size_t SZ_WRW = (size_t)(3 * 1024 * 1024 + 4 * 256 * 1024 + 1024 * 1024) * 2;
constexpr size_t WR_RKV = 0, WR_L = (size_t)3 * 1024 * 1024 * 2, WR_O = WR_L + (size_t)4 * 256 * 1024 * 2;
constexpr size_t OFF_WMLA = OFF_H + SZ_BF;
constexpr size_t OFF_WRW = OFF_WMLA + 2 * SZ_WMLA;
constexpr size_t OFF_W13T = OFF_WRW + 2 * SZ_WRW;
constexpr size_t OFF_W2T = OFF_W13T + (size_t)NE * 2816 * D * 2;
constexpr size_t OFF_S = OFF_W2T + (size_t)NE * D * FF * 2;
constexpr size_t OFF_Z = OFF_S;
constexpr size_t OFF_CQN = OFF_Z + al256((size_t)NROW * 512 * 4);
constexpr size_t OFF_CKVN = OFF_CQN + al256((size_t)NROW * 256 * 2);
constexpr size_t OFF_KR = OFF_CKVN + al256((size_t)NROW * 256 * 2);
constexpr size_t OFF_QRAW = OFF_KR + al256((size_t)NROW * 64 * 4);
constexpr size_t OFF_KVRAW = OFF_QRAW + al256((size_t)NROW * 1536 * 4);
constexpr size_t OFF_Q = OFF_KVRAW + al256((size_t)NROW * 2048 * 4);
constexpr size_t OFF_K = OFF_Q + al256((size_t)NB * 8 * TK * 192 * 2);
constexpr size_t OFF_V = OFF_K + al256((size_t)NB * 8 * TK * 192 * 2);
constexpr size_t OFF_O = OFF_V + al256((size_t)NB * 8 * TK * 128 * 2);
constexpr size_t END_MLA = OFF_O + SZ_BF;
constexpr size_t OFF_HF = OFF_S;
constexpr size_t OFF_XS = OFF_HF + SZ_F32;
constexpr size_t OFF_RKV = OFF_XS + 6 * SZ_BF;
constexpr size_t OFF_W = OFF_RKV + 3 * SZ_F32;
constexpr size_t OFF_AV = OFF_W + 2 * SZ_F32;
constexpr size_t OFF_KD = OFF_AV + 2 * SZ_F32;
constexpr size_t OFF_G = OFF_KD + 2 * SZ_F32;
constexpr size_t OFF_LW = OFF_G + SZ_F32;
constexpr size_t OFF_LA = OFF_LW + al256((size_t)NROW * 128 * 2);
constexpr size_t OFF_LG = OFF_LA + al256((size_t)NROW * 128 * 2);
constexpr size_t OFF_LV = OFF_LG + al256((size_t)NROW * 128 * 2);
constexpr size_t END_RW = OFF_LV + al256((size_t)NROW * 32 * 2);
constexpr size_t OFF_Y = OFF_HF;
constexpr size_t OFF_AFF = OFF_S;
constexpr size_t OFF_ROWIDX = OFF_AFF + al256((size_t)NROW * 16 * 4);
constexpr size_t OFF_GATE = OFF_ROWIDX + al256((size_t)NE * ESLOTS * 4);
constexpr size_t OFF_SLOT = OFF_GATE + al256((size_t)NE * EPAD * 4);
constexpr size_t OFF_XE = OFF_SLOT + al256((size_t)NROW * 16 * 4);
constexpr size_t OFF_HID = OFF_XE + al256((size_t)NE * EPAD * D * 2);
constexpr size_t OFF_YE = OFF_HID + al256((size_t)NE * EPAD * FF * 2);
constexpr size_t END_MOE = OFF_YE + al256((size_t)NE * EPAD * D * 2);
constexpr size_t WS_NEED = END_RW > END_MLA ? (END_RW > END_MOE ? END_RW : END_MOE) : (END_MLA > END_MOE ? END_MLA : END_MOE);

constexpr int LDS_BYTES = 131072;

struct Params {
    const float *x, *c, *ctx, *c_ctx, *mod_w, *mod_b, *norm1_g, *norm2_g, *final_g;
    const float *mla_w_in, *mla_g_q, *mla_g_kv, *mla_w_uq, *mla_w_ukv, *mla_w_o;
    const float *rw_mu, *rw_w_rkv, *rw_w0, *rw_w1, *rw_w2, *rw_a0, *rw_a1, *rw_a2, *rw_v0, *rw_v1, *rw_v2, *rw_g1, *rw_g2, *rw_k_k, *rw_k_a, *rw_r_k, *rw_lnx_g, *rw_lnx_b, *rw_w_o;
    const float *moe_router, *moe_w1, *moe_w3, *moe_w2;
    float* out; char* ws;
};

__device__ __forceinline__ int tidx() { int t = threadIdx.x; asm volatile("" : "+v"(t)); return t; }
#define XB_TMO      128
#define XB_XCNT(j)  (256  + 64 * (j))
#define XB_XSUB(j)  (1280 + 64 * (j))
#define XB_XGEN(j)  (2304 + 64 * (j))
#define XB_TOP      3328
#define XB_TOPGEN   3392
#define XCD_BAR_WORDS 3456
#define XB_SPIN_CAP (1u << 22)
#define LAS __attribute__((address_space(3)))

__device__ __forceinline__ unsigned xb_ld(unsigned* p)              { return __hip_atomic_load(p, __ATOMIC_RELAXED, __HIP_MEMORY_SCOPE_AGENT); }
__device__ __forceinline__ unsigned xb_add(unsigned* p, unsigned v) { return __hip_atomic_fetch_add(p, v, __ATOMIC_RELAXED, __HIP_MEMORY_SCOPE_AGENT); }
__device__ __forceinline__ unsigned xb_xcc_id() { return (unsigned)__builtin_amdgcn_s_getreg((3 << 11) | 20) & 0xFu; }
#define XB_SPIN(cond, bar) do { unsigned _sp = 0; while (cond) { __builtin_amdgcn_s_sleep(1); \
    if ((++_sp & 255u) == 0u) { if (xb_ld(&(bar)[XB_TMO])) break; if (_sp > XB_SPIN_CAP) { atomicAdd(&(bar)[XB_TMO], 1u); break; } } } } while (0)

struct XcdBarrier { unsigned* bar; unsigned x; volatile LAS unsigned* st; };

__device__ __forceinline__ XcdBarrier xcd_barrier_post(unsigned* bar, volatile LAS unsigned* st) {
    XcdBarrier b; b.bar = bar; b.x = xb_xcc_id(); b.st = st;
    if (tidx() == 0) (void)xb_add(&bar[XB_XCNT(b.x)], 1u);
    return b;
}
__device__ __forceinline__ void xcd_barrier_complete(unsigned* bar, unsigned x, unsigned& nloc, unsigned& nx) {
    const unsigned G = gridDim.x * gridDim.y * gridDim.z;
    unsigned sum, cnt, mine, sp = 0u;
    for (;;) {
        sum = 0u; cnt = 0u; mine = 0u;
#pragma unroll
        for (unsigned j = 0; j < 16; ++j) { const unsigned c = xb_ld(&bar[XB_XCNT(j)]); sum += c; cnt += (c > 0u) ? 1u : 0u; mine = (j == x) ? c : mine; }
        if (sum == G) break;
        __builtin_amdgcn_s_sleep(1);
        if ((++sp & 255u) == 0u) { if (xb_ld(&bar[XB_TMO])) break; if (sp > XB_SPIN_CAP) { atomicAdd(&bar[XB_TMO], 1u); break; } }
    }
    nloc = mine > 0u ? mine : 1u; nx = cnt > 0u ? cnt : 1u;
}
__device__ __forceinline__ void xcd_barrier(const XcdBarrier& b) {
    asm volatile("s_waitcnt vmcnt(0)" ::: "memory");
    __syncthreads();
    if (tidx() == 0) {
        unsigned* bar = b.bar;
        __builtin_amdgcn_s_waitcnt(0);
        unsigned nloc = b.st[0], nx = b.st[1];
        if (nloc == 0u) { xcd_barrier_complete(bar, b.x, nloc, nx); b.st[0] = nloc; b.st[1] = nx; }
        const unsigned old = xb_add(&bar[XB_XSUB(b.x)], 1u);
        const unsigned gen = old / nloc;
        if (old + 1u == (gen + 1u) * nloc) {
            __builtin_amdgcn_fence(__ATOMIC_RELEASE, "agent");
            asm volatile("s_waitcnt vmcnt(0)" ::: "memory");
            const unsigned og = xb_add(&bar[XB_TOP], 1u);
            const unsigned tg = og / nx;
            if (og + 1u == (tg + 1u) * nx) xb_add(&bar[XB_TOPGEN], 1u);
            else XB_SPIN(xb_ld(&bar[XB_TOPGEN]) == tg, bar);
            __builtin_amdgcn_fence(__ATOMIC_ACQUIRE, "agent");
            xb_add(&bar[XB_XGEN(b.x)], 1u);
            asm volatile("s_waitcnt vmcnt(0)" ::: "memory");
        } else {
            XB_SPIN(xb_ld(&bar[XB_XGEN(b.x)]) == gen, bar);
            __builtin_amdgcn_fence(__ATOMIC_ACQUIRE, "agent");
            asm volatile("s_waitcnt vmcnt(0)" ::: "memory");
        }
    }
    __syncthreads();
}

__device__ __forceinline__ bf16_t f2bf(float f) { unsigned u = __float_as_uint(f); u += 0x7FFFu + ((u >> 16) & 1u); return (bf16_t)(u >> 16); }
__device__ __forceinline__ float bf2f(bf16_t b) { return __uint_as_float(((unsigned)b) << 16); }
__device__ __forceinline__ unsigned pk2(float lo, float hi) { return (unsigned)f2bf(lo) | ((unsigned)f2bf(hi) << 16); }
__device__ __forceinline__ float wave_sum(float v) { for (int o = 32; o >= 1; o >>= 1) v += __shfl_xor(v, o); return v; }
__device__ __forceinline__ float sigmoidf_(float x) { return 1.f / (1.f + expf(-x)); }
__device__ __forceinline__ int row_stream(int row) { return row < NLAT ? (row >> 12) : 4; }
__device__ __forceinline__ const float* modp(const Params& p, int layer, int s, int part) { return (const float*)(p.ws + OFF_MOD) + ((size_t)layer * 5 + s) * 6144 + part * 1024; }

struct SgArgs { const bf16_t* A; int lda; size_t strideA; const float* B; int ldb; size_t strideB; int M, N, K, nbatch; };
template <class Epi>
__device__ __forceinline__ void sg_gemm(char* lds, const SgArgs g, const Epi& epi) {
    bf16_t* As = (bf16_t*)lds;
    bf16_t* Bs = As + 128 * 40;
    const int tid = tidx(), wid = tid >> 6, lane = tid & 63;
    const int wr = wid >> 2, wc = wid & 3;
    const int tilesN = (g.N + 127) / 128, tilesM = g.M / 128, per = tilesM * tilesN, ntiles = per * g.nbatch;
    const int ar = tid >> 2, ak = (tid & 3) * 8;
    const int bn = tid & 127, bk = (tid >> 7) * 8;
    for (int tile = blockIdx.x; tile < ntiles; tile += gridDim.x) {
        const int bt = tile / per, tt = tile % per;
        const int tm = tt / tilesN, tn = tt % tilesN;
        const int m0 = tm * 128, n0 = tn * 128;
        f32x4 acc[4][2];
#pragma unroll
        for (int m = 0; m < 4; ++m)
#pragma unroll
            for (int n = 0; n < 2; ++n) acc[m][n] = (f32x4){0.f, 0.f, 0.f, 0.f};
        const bool bvalid = (n0 + bn) < g.N;
        const bf16_t* ap = g.A + bt * g.strideA + (size_t)(m0 + ar) * g.lda + ak;
        const float* bp = g.B + bt * g.strideB + (size_t)bk * g.ldb + n0 + bn;
        bf16x8 areg; float breg[8];
        areg = *(const bf16x8*)ap;
#pragma unroll
        for (int j = 0; j < 8; ++j) breg[j] = bvalid ? bp[(size_t)j * g.ldb] : 0.f;
        for (int k0 = 0; k0 < g.K; k0 += 32) {
            __syncthreads();
            *(bf16x8*)(As + ar * 40 + ak) = areg;
            { u32x4 w; w.x = pk2(breg[0], breg[1]); w.y = pk2(breg[2], breg[3]); w.z = pk2(breg[4], breg[5]); w.w = pk2(breg[6], breg[7]); *(u32x4*)(Bs + bn * 40 + bk) = w; }
            __syncthreads();
            if (k0 + 32 < g.K) {
                areg = *(const bf16x8*)(ap + k0 + 32);
#pragma unroll
                for (int j = 0; j < 8; ++j) breg[j] = bvalid ? bp[(size_t)(k0 + 32 + j) * g.ldb] : 0.f;
            }
            bf16x8 af[4], bfr[2];
#pragma unroll
            for (int m = 0; m < 4; ++m) af[m] = *(const bf16x8*)(As + (wr * 64 + m * 16 + (lane & 15)) * 40 + (lane >> 4) * 8);
#pragma unroll
            for (int n = 0; n < 2; ++n) bfr[n] = *(const bf16x8*)(Bs + (wc * 32 + n * 16 + (lane & 15)) * 40 + (lane >> 4) * 8);
#pragma unroll
            for (int m = 0; m < 4; ++m)
#pragma unroll
                for (int n = 0; n < 2; ++n) acc[m][n] = __builtin_amdgcn_mfma_f32_16x16x32_bf16(af[m], bfr[n], acc[m][n], 0, 0, 0);
        }
#pragma unroll
        for (int m = 0; m < 4; ++m)
#pragma unroll
            for (int n = 0; n < 2; ++n) {
                const int col = n0 + wc * 32 + n * 16 + (lane & 15);
                if (col < g.N) {
#pragma unroll
                    for (int r = 0; r < 4; ++r) epi(bt, m0 + wr * 64 + m * 16 + (lane >> 4) * 4 + r, col, acc[m][n][r]);
                }
            }
    }
}


namespace g8 {
#define PG8_LAS __attribute__((address_space(3)))
constexpr int BM = 256, BK = 64, HALF = 128, HTB = HALF * BK * 2, STAGE_BYTES = 8 * HTB;
__device__ __forceinline__ int lds_byte(int r, int c) { const int st = (r >> 4) * 2 + (c >> 5), rr = r & 15, cc = c & 31, ob = rr * 64 + cc * 2; return st * 1024 + (ob ^ (((ob >> 9) & 1) << 5)); }
__device__ __forceinline__ void stage_rc(int b, int& R, int& C) { const int st = b / 1024, sb = b % 1024, swz = sb ^ (((sb >> 9) & 1) << 5); R = (st >> 1) * 16 + swz / 64; C = (st & 1) * 32 + (swz % 64) / 2; }
struct Unit { int pm, pn, g; const char* A; const char* B; };
__device__ __forceinline__ int xcd_remap(int L, int nwg) { const int q = nwg / 8, r = nwg % 8, xcd = L % 8, off = L / 8; return (xcd < r ? xcd * (q + 1) : r * (q + 1) + (xcd - r) * q) + off; }

template <class Epi, class Sched>
__device__ __forceinline__ void gemm_phase(PG8_LAS unsigned char* lds, const int K, const Sched& S, const Epi& E) {
    const int tid = tidx(), wid = __builtin_amdgcn_readfirstlane(tid >> 6), lane = tid & 63, wr = wid >> 2, wc = wid & 3, fr = lane & 15, fq = lane >> 4;
    const int nt = K / BK;
    unsigned voffA[2];
#pragma unroll
    for (int i = 0; i < 2; ++i) { int R, C; stage_rc(tid * 16 + i * 8192, R, C); voffA[i] = (unsigned)(R * K + C) * 2u; }
    const size_t kstep = (size_t)(BK * 2);
    const size_t hstep = (size_t)HALF * K * 2;
    const unsigned ldsw = (unsigned)wid * 1024u;
    const int aoff = lds_byte(wr * 64 + fr, fq * 8), boff = lds_byte(wc * 32 + fr, fq * 8);
#define PG8_SA(b, h) (((b) * 2 + (h)) * HTB)
#define PG8_SB(b, h) ((4 + (b) * 2 + (h)) * HTB)
#define PG8_STAGE(bufoff, gbase, voff) do { _Pragma("unroll") for (int _i = 0; _i < 2; ++_i) \
        __builtin_amdgcn_global_load_lds((const unsigned*)((const char*)(gbase) + (voff)[_i]), (PG8_LAS unsigned*)(lds + (bufoff) + ldsw + _i * 8192), 16, 0, 0); } while (0)
#define PG8_LDA(dst, b, h) do { _Pragma("unroll") for (int m = 0; m < 4; ++m) _Pragma("unroll") for (int k = 0; k < 2; ++k) dst[m][k] = *(const PG8_LAS bf16x8*)(lds + PG8_SA(b, h) + aoff + m * 2048 + k * 1024); } while (0)
#define PG8_LDB(dst, b, h) do { _Pragma("unroll") for (int n = 0; n < 2; ++n) _Pragma("unroll") for (int k = 0; k < 2; ++k) dst[n][k] = *(const PG8_LAS bf16x8*)(lds + PG8_SB(b, h) + boff + n * 2048 + k * 1024); } while (0)
#define PG8_MMA(ai, bj, At, Bt) do { __builtin_amdgcn_s_setprio(1); _Pragma("unroll") for (int m = 0; m < 4; ++m) _Pragma("unroll") for (int n = 0; n < 2; ++n) _Pragma("unroll") for (int k = 0; k < 2; ++k) \
        acc[ai][bj][m][n] = __builtin_amdgcn_mfma_f32_16x16x32_bf16(Bt[n][k], At[m][k], acc[ai][bj][m][n], 0, 0, 0); __builtin_amdgcn_s_setprio(0); } while (0)
#define PG8_WAIT_V(n) asm volatile("s_waitcnt vmcnt(" #n ")" ::: "memory")
#define PG8_WAIT_L(n) asm volatile("s_waitcnt lgkmcnt(" #n ")" ::: "memory")
#define PG8_BAR __builtin_amdgcn_s_barrier()
#define PG8_SCHED __builtin_amdgcn_sched_barrier(0)
    Unit cur, nxt; int ui = 0;
    if (!S.next(0, cur)) return;
    f32x4 acc[2][2][4][2];
#pragma unroll
    for (int a = 0; a < 2; ++a)
#pragma unroll
        for (int b = 0; b < 2; ++b)
#pragma unroll
            for (int m = 0; m < 4; ++m)
#pragma unroll
                for (int n = 0; n < 2; ++n) acc[a][b][m][n] = (f32x4){0.f, 0.f, 0.f, 0.f};
    bf16x8 At[4][2], B0[2][2], B1[2][2];
    const char* cA = cur.A; const char* cB = cur.B;
    PG8_STAGE(PG8_SB(0, 0), cB, voffA); PG8_STAGE(PG8_SA(0, 0), cA, voffA); PG8_STAGE(PG8_SB(0, 1), cB + hstep, voffA); PG8_STAGE(PG8_SA(0, 1), cA + hstep, voffA);
    if (wr == 1) PG8_BAR;
    PG8_WAIT_V(4); PG8_BAR;
    PG8_STAGE(PG8_SB(1, 0), cB + kstep, voffA); PG8_STAGE(PG8_SA(1, 0), cA + kstep, voffA); PG8_STAGE(PG8_SB(1, 1), cB + hstep + kstep, voffA);
    PG8_WAIT_V(6); PG8_BAR;
    for (;;) {
        const bool has_next = S.next(ui + 1, nxt);
        const char* nA = has_next ? nxt.A : cA; const char* nB = has_next ? nxt.B : cB;
        for (int t = 0; t < nt; t += 2) {
            const bool last = (t == nt - 2);
            const char* a1 = cA + (size_t)(t + 1) * kstep;
            const char* a2 = last ? nA : cA + (size_t)(t + 2) * kstep; const char* b2 = last ? nB : cB + (size_t)(t + 2) * kstep;
            const char* a3 = a2 + kstep; const char* b3 = b2 + kstep;
            PG8_LDB(B0, 0, 0); PG8_SCHED; PG8_LDA(At, 0, 0); PG8_STAGE(PG8_SA(1, 1), a1 + hstep, voffA);
            PG8_WAIT_L(8); PG8_BAR; PG8_WAIT_L(0); PG8_MMA(0, 0, At, B0); PG8_BAR; PG8_SCHED;
            PG8_LDB(B1, 0, 1); PG8_STAGE(PG8_SB(0, 0), b2, voffA);
            PG8_BAR; PG8_WAIT_L(0); PG8_MMA(0, 1, At, B1); PG8_BAR;
            PG8_LDA(At, 0, 1); PG8_STAGE(PG8_SA(0, 0), a2, voffA);
            PG8_BAR; PG8_WAIT_L(0); PG8_MMA(1, 0, At, B0); PG8_BAR; PG8_SCHED;
            PG8_STAGE(PG8_SB(0, 1), b2 + hstep, voffA);
            PG8_WAIT_V(6); PG8_BAR; PG8_MMA(1, 1, At, B1); PG8_BAR;
            PG8_LDB(B0, 1, 0); PG8_SCHED; PG8_LDA(At, 1, 0); PG8_STAGE(PG8_SA(0, 1), a2 + hstep, voffA);
            PG8_WAIT_L(8); PG8_BAR; PG8_WAIT_L(0); PG8_MMA(0, 0, At, B0); PG8_BAR; PG8_SCHED;
            PG8_LDB(B1, 1, 1); PG8_STAGE(PG8_SB(1, 0), b3, voffA);
            PG8_BAR; PG8_WAIT_L(0); PG8_MMA(0, 1, At, B1); PG8_BAR;
            PG8_LDA(At, 1, 1); PG8_STAGE(PG8_SA(1, 0), a3, voffA);
            PG8_BAR; PG8_WAIT_L(0); PG8_MMA(1, 0, At, B0); PG8_BAR; PG8_SCHED;
            PG8_STAGE(PG8_SB(1, 1), b3 + hstep, voffA);
            PG8_WAIT_V(6); PG8_BAR; PG8_MMA(1, 1, At, B1); PG8_BAR;
        }
        E(acc, cur, wr, wc, fr, fq);
        if (!has_next) break;
#pragma unroll
        for (int a = 0; a < 2; ++a)
#pragma unroll
            for (int b = 0; b < 2; ++b)
#pragma unroll
                for (int m = 0; m < 4; ++m)
#pragma unroll
                    for (int n = 0; n < 2; ++n) acc[a][b][m][n] = (f32x4){0.f, 0.f, 0.f, 0.f};
        cur = nxt; cA = nA; cB = nB; ++ui;
    }
    PG8_WAIT_V(0);
    if (wr == 0) PG8_BAR;
    PG8_BAR;
#undef PG8_SA
#undef PG8_SB
#undef PG8_STAGE
#undef PG8_LDA
#undef PG8_LDB
#undef PG8_MMA
#undef PG8_WAIT_V
#undef PG8_WAIT_L
#undef PG8_BAR
#undef PG8_SCHED
}
template <class F> struct EpiRC { F f;
    __device__ __forceinline__ void operator()(const f32x4 (&acc)[2][2][4][2], const Unit& u, int wr, int wc, int fr, int fq) const {
#pragma unroll
        for (int ai = 0; ai < 2; ++ai)
#pragma unroll
            for (int m = 0; m < 4; ++m) { const int row = u.pm * BM + ai * HALF + wr * 64 + m * 16 + fr;
#pragma unroll
                for (int bj = 0; bj < 2; ++bj)
#pragma unroll
                    for (int n = 0; n < 2; ++n) f(u, row, u.pn * BM + bj * HALF + wc * 32 + n * 16 + 4 * fq, acc[ai][bj][m][n]); }
    } };
template <class F> __device__ __forceinline__ EpiRC<F> epi_rc(const F& f) { return EpiRC<F>{f}; }
template <class F> struct EpiPair { F f;
    __device__ __forceinline__ void operator()(const f32x4 (&acc)[2][2][4][2], const Unit& u, int wr, int wc, int fr, int fq) const {
#pragma unroll
        for (int ai = 0; ai < 2; ++ai)
#pragma unroll
            for (int m = 0; m < 4; ++m) { const int row = u.pm * BM + ai * HALF + wr * 64 + m * 16 + fr;
#pragma unroll
                for (int n = 0; n < 2; ++n) f(u, row, u.pn * HALF + wc * 32 + n * 16 + 4 * fq, acc[ai][0][m][n], acc[ai][1][m][n]); }
    } };
template <class F> __device__ __forceinline__ EpiPair<F> epi_pair(const F& f) { return EpiPair<F>{f}; }
struct BatchSched { const char* A; const char* B; size_t strideA, strideB; int nM, nN, nb, K;
    __device__ __forceinline__ bool next(int i, Unit& u) const {
        const int nwg = nM * nN * nb; const int L = i * (int)gridDim.x + (int)blockIdx.x; if (L >= nwg) return false;
        const int w = xcd_remap(L, nwg); const int per = nM * nN; u.g = w / per; const int r = w % per; u.pm = r / nN; u.pn = r % nN;
        u.A = A + u.g * strideA + (size_t)u.pm * BM * K * 2; u.B = B + u.g * strideB + (size_t)u.pn * BM * K * 2; return true; } };
}

template <class SrcF, class DRow>
__device__ __forceinline__ void cvt_tiles(char* lds, bf16_t* dst, int Kd, int Nd, int nbatch, size_t dstride, const SrcF& src, const DRow& drow) {
    bf16_t* T = (bf16_t*)lds;
    const int tid = tidx();
    const int tk = Kd / 128, tn = Nd / 64, per = tk * tn, total = per * nbatch;
    for (int t = blockIdx.x; t < total; t += gridDim.x) {
        const int bt = t / per, r = t % per, k0 = (r % tk) * 128, n0 = (r / tk) * 64;
        float4 v[4];
#pragma unroll
        for (int i = 0; i < 4; ++i) { const int k = k0 + i * 32 + (tid >> 4), n = n0 + (tid & 15) * 4; const float* sp = src(bt, k, n); v[i] = sp ? *(const float4*)sp : make_float4(0.f, 0.f, 0.f, 0.f); }
        __syncthreads();
#pragma unroll
        for (int i = 0; i < 4; ++i) { const int k = i * 32 + (tid >> 4), n = (tid & 15) * 4;
            T[(n + 0) * 136 + k] = f2bf(v[i].x); T[(n + 1) * 136 + k] = f2bf(v[i].y); T[(n + 2) * 136 + k] = f2bf(v[i].z); T[(n + 3) * 136 + k] = f2bf(v[i].w); }
        __syncthreads();
        { const int n = tid >> 3, kc = (tid & 7) * 16;
          const u32x4 a = *(const u32x4*)(T + n * 136 + kc), b = *(const u32x4*)(T + n * 136 + kc + 8);
          bf16_t* dp = dst + bt * dstride + (size_t)drow(n0 + n) * Kd + k0 + kc;
          *(u32x4*)dp = a; *(u32x4*)(dp + 8) = b; }
    }
}
__device__ void ph_moe_cvt(const Params& p, int layer, char* lds) {
    const float* w1 = p.moe_w1 + (size_t)layer * NE * D * FF; const float* w3 = p.moe_w3 + (size_t)layer * NE * D * FF; const float* w2 = p.moe_w2 + (size_t)layer * NE * FF * D;
    cvt_tiles(lds, (bf16_t*)(p.ws + OFF_W13T), D, 2816, NE, (size_t)2816 * D,
        [=](int e, int k, int n) -> const float* { const int pn = n >> 8, half = (n >> 7) & 1, c = pn * 128 + (n & 127); return (half ? w3 : w1) + ((size_t)e * D + k) * FF + c; },
        [=](int n) { return n; });
    cvt_tiles(lds, (bf16_t*)(p.ws + OFF_W2T), FF, D, NE, (size_t)D * FF,
        [=](int e, int k, int n) -> const float* { return w2 + ((size_t)e * FF + k) * D + n; },
        [=](int n) { return n; });
}

__device__ void ph_init(const Params& p, char* lds) {
    const int tid = tidx(), gtid = blockIdx.x * NTHR + tid, gsz = gridDim.x * NTHR;
    float4* X4 = (float4*)(p.ws + OFF_X);
    const float4* x4 = (const float4*)p.x; const float4* c4 = (const float4*)p.ctx;
    for (int i = gtid; i < NROW * 256; i += gsz) X4[i] = i < NLAT * 256 ? x4[i] : c4[i - NLAT * 256];
    float* rc = (float*)(p.ws + OFF_ROPE_C); float* rs = (float*)(p.ws + OFF_ROPE_S);
    for (int i = gtid; i < TL * 32; i += gsz) {
        const int t = i >> 5, f = i & 31; const float pos = (float)((f < 16) ? (t >> 6) : (t & 63));
        const float inv = powf(10000.f, -(float)(f & 15) / 16.f); const float ang = pos * inv; rc[i] = cosf(ang); rs[i] = sinf(ang);
    }
    float* sc = (float*)lds;
    float* red = sc + 5 * 1024;
    for (int i = tid; i < 5 * 1024; i += NTHR) { const float v = i < 4096 ? p.c[i] : p.c_ctx[i - 4096]; sc[i] = v / (1.f + expf(-v)); }
    __syncthreads();
    float* MOD = (float*)(p.ws + OFF_MOD);
    for (int item = blockIdx.x; item < 4 * 96; item += gridDim.x) {
        const int l = item / 96, cg = item % 96, col = tid & 63, n = cg * 64 + col, kg = tid >> 6;
        const float* w = p.mod_w + ((size_t)l * 1024 + kg * 128) * 6144 + n;
        float a0 = 0, a1 = 0, a2 = 0, a3 = 0, a4 = 0;
        for (int k = 0; k < 128; ++k) { const float wv = w[(size_t)k * 6144]; const int kk = kg * 128 + k;
            a0 += sc[kk] * wv; a1 += sc[1024 + kk] * wv; a2 += sc[2048 + kk] * wv; a3 += sc[3072 + kk] * wv; a4 += sc[4096 + kk] * wv; }
        float* rr = red + (kg * 64 + col) * 5; rr[0] = a0; rr[1] = a1; rr[2] = a2; rr[3] = a3; rr[4] = a4;
        __syncthreads();
        if (tid < 320) { const int c2 = tid & 63, s = tid >> 6; float sum = 0;
            for (int q = 0; q < 8; ++q) sum += red[(q * 64 + c2) * 5 + s];
            MOD[((size_t)l * 5 + s) * 6144 + cg * 64 + c2] = sum + p.mod_b[l * 6144 + cg * 64 + c2]; }
        __syncthreads();
    }
}


__device__ void ph_small_cvt(const Params& p, char* lds) {
    for (int j = 0; j < 2; ++j) {
        char* wm = p.ws + OFF_WMLA + j * SZ_WMLA; char* wr = p.ws + OFF_WRW + j * SZ_WRW;
        const float* w_in = p.mla_w_in + (size_t)j * D * 448; const float* w_uq = p.mla_w_uq + (size_t)j * 256 * 1536; const float* w_ukv = p.mla_w_ukv + (size_t)j * 128 * 2048; const float* w_o = p.mla_w_o + (size_t)j * D * D;
        cvt_tiles(lds, (bf16_t*)(wm + WM_IN), 1024, 512, 1, 0, [=](int, int k, int n) -> const float* { return n < 448 ? w_in + (size_t)k * 448 + n : nullptr; }, [=](int n) { return n; });
        cvt_tiles(lds, (bf16_t*)(wm + WM_UQ), 256, 1536, 1, 0, [=](int, int k, int n) -> const float* { return w_uq + (size_t)k * 1536 + n; }, [=](int n) { return n; });
        cvt_tiles(lds, (bf16_t*)(wm + WM_UKV), 256, 2048, 1, 0, [=](int, int k, int n) -> const float* { return k < 128 ? w_ukv + (size_t)k * 2048 + n : nullptr; }, [=](int n) { return n; });
        cvt_tiles(lds, (bf16_t*)(wm + WM_O), 1024, 1024, 1, 0, [=](int, int k, int n) -> const float* { return w_o + (size_t)k * D + n; }, [=](int n) { return n; });
        const float* w_rkv = p.rw_w_rkv + (size_t)j * 3 * D * D; const float* w1 = p.rw_w1 + (size_t)j * 2 * D * 64; const float* a1 = p.rw_a1 + (size_t)j * 2 * D * 64;
        const float* g1 = p.rw_g1 + (size_t)j * D * 128; const float* v1 = p.rw_v1; const float* rwo = p.rw_w_o + (size_t)j * D * D;
        cvt_tiles(lds, (bf16_t*)(wr + WR_RKV), 1024, 1024, 3, (size_t)D * D, [=](int m, int k, int n) -> const float* { return w_rkv + ((size_t)m * D + k) * D + n; }, [=](int n) { return n; });
        cvt_tiles(lds, (bf16_t*)(wr + WR_L), 1024, 256, 1, 0, [=](int, int k, int n) -> const float* { return n < 128 ? w1 + ((size_t)(n >> 6) * D + k) * 64 + (n & 63) : nullptr; }, [=](int n) { return n; });
        cvt_tiles(lds, (bf16_t*)(wr + WR_L) + 256 * 1024, 1024, 256, 1, 0, [=](int, int k, int n) -> const float* { return n < 128 ? a1 + ((size_t)(n >> 6) * D + k) * 64 + (n & 63) : nullptr; }, [=](int n) { return n; });
        cvt_tiles(lds, (bf16_t*)(wr + WR_L) + 2 * 256 * 1024, 1024, 256, 1, 0, [=](int, int k, int n) -> const float* { return n < 128 ? g1 + (size_t)k * 128 + n : nullptr; }, [=](int n) { return n; });
        cvt_tiles(lds, (bf16_t*)(wr + WR_L) + 3 * 256 * 1024, 1024, 256, 1, 0, [=](int, int k, int n) -> const float* { return n < 32 ? v1 + (size_t)k * 32 + n : nullptr; }, [=](int n) { return n; });
        cvt_tiles(lds, (bf16_t*)(wr + WR_O), 1024, 1024, 1, 0, [=](int, int k, int n) -> const float* { return rwo + (size_t)k * D + n; }, [=](int n) { return n; });
    }
}

template <bool OUTF32>
__device__ void ph_norm_mod(const Params& p, int layer, const float* g, int part_sh, int part_sc, void* outp) {
    const int wid = tidx() >> 6, lane = tidx() & 63;
    const float* X = (const float*)(p.ws + OFF_X);
    for (int row = blockIdx.x * 8 + wid; row < NROW; row += gridDim.x * 8) {
        const int s = row_stream(row);
        const float* sh = modp(p, layer, s, part_sh); const float* sc = modp(p, layer, s, part_sc);
        const float4* xr = (const float4*)(X + (size_t)row * D);
        float4 v[4]; float ss = 0;
#pragma unroll
        for (int i = 0; i < 4; ++i) { v[i] = xr[lane + i * 64]; ss += v[i].x * v[i].x + v[i].y * v[i].y + v[i].z * v[i].z + v[i].w * v[i].w; }
        ss = wave_sum(ss); const float rs = rsqrtf(ss * (1.f / D) + RMS_EPS);
#pragma unroll
        for (int i = 0; i < 4; ++i) {
            const int d = (lane + i * 64) * 4;
            const float4 gg = *(const float4*)(g + d), a = *(const float4*)(sc + d), b = *(const float4*)(sh + d);
            float4 o; o.x = v[i].x * rs * gg.x * (1.f + a.x) + b.x; o.y = v[i].y * rs * gg.y * (1.f + a.y) + b.y; o.z = v[i].z * rs * gg.z * (1.f + a.z) + b.z; o.w = v[i].w * rs * gg.w * (1.f + a.w) + b.w;
            if (OUTF32) *(float4*)((float*)outp + (size_t)row * D + d) = o;
            else { uint2 w; w.x = pk2(o.x, o.y); w.y = pk2(o.z, o.w); *(uint2*)((bf16_t*)outp + (size_t)row * D + d) = w; }
        }
    }
}

__device__ void ph_mla_mid(const Params& p, int j) {
    const int wid = tidx() >> 6, lane = tidx() & 63;
    const float* Z = (const float*)(p.ws + OFF_Z);
    bf16_t* CQN = (bf16_t*)(p.ws + OFF_CQN); bf16_t* CKVN = (bf16_t*)(p.ws + OFF_CKVN); float* KR = (float*)(p.ws + OFF_KR);
    const float* gq = p.mla_g_q + j * 256; const float* gkv = p.mla_g_kv + j * 128;
    const float* rc = (const float*)(p.ws + OFF_ROPE_C); const float* rs = (const float*)(p.ws + OFF_ROPE_S);
    for (int row = blockIdx.x * 8 + wid; row < NROW; row += gridDim.x * 8) {
        const float* z = Z + (size_t)row * 512;
        const float4 q = *(const float4*)(z + lane * 4);
        const float2 kv = *(const float2*)(z + 256 + lane * 2);
        const float kr = z[384 + lane];
        float sq = wave_sum(q.x * q.x + q.y * q.y + q.z * q.z + q.w * q.w); const float rq = rsqrtf(sq * (1.f / 256.f) + RMS_EPS);
        float sk = wave_sum(kv.x * kv.x + kv.y * kv.y); const float rk = rsqrtf(sk * (1.f / 128.f) + RMS_EPS);
        const float4 g4 = *(const float4*)(gq + lane * 4); const float2 g2 = *(const float2*)(gkv + lane * 2);
        uint2 w; w.x = pk2(q.x * rq * g4.x, q.y * rq * g4.y); w.y = pk2(q.z * rq * g4.z, q.w * rq * g4.w);
        *(uint2*)(CQN + (size_t)row * 256 + lane * 4) = w;
        *(unsigned*)(CKVN + (size_t)row * 256 + lane * 2) = pk2(kv.x * rk * g2.x, kv.y * rk * g2.y);
        *(unsigned*)(CKVN + (size_t)row * 256 + 128 + lane * 2) = 0u;
        float o = kr;
        const float other = __shfl_xor(kr, 32);
        if (row < NLAT) { const int t = row & (TL - 1), i = lane & 31; const float c = rc[t * 32 + i], s = rs[t * 32 + i];
            const float x1 = lane < 32 ? kr : other, x2 = lane < 32 ? other : kr;
            o = lane < 32 ? (x1 * c - x2 * s) : (x1 * s + x2 * c); }
        KR[(size_t)row * 64 + lane] = o;
    }
}

__device__ void ph_qkv_post(const Params& p) {
    const int wid = tidx() >> 6, lane = tidx() & 63;
    const float* QRAW = (const float*)(p.ws + OFF_QRAW); const float* KVRAW = (const float*)(p.ws + OFF_KVRAW); const float* KR = (const float*)(p.ws + OFF_KR);
    bf16_t* Q = (bf16_t*)(p.ws + OFF_Q); bf16_t* K = (bf16_t*)(p.ws + OFF_K); bf16_t* V = (bf16_t*)(p.ws + OFF_V);
    const float* rc = (const float*)(p.ws + OFF_ROPE_C); const float* rs = (const float*)(p.ws + OFF_ROPE_S);
    for (int it = blockIdx.x * 8 + wid; it < NROW * 8; it += gridDim.x * 8) {
        const int row = it >> 3, h = it & 7;
        const bool lat = row < NLAT; const int b = lat ? (row >> 12) : ((row - NLAT) >> 8); const int tk = lat ? 256 + (row & (TL - 1)) : ((row - NLAT) & 255);
        const size_t orow = (size_t)(b * 8 + h) * TK + tk;
        const float* q = QRAW + (size_t)row * 1536 + h * 192;
        const float q0 = q[lane], q1 = q[64 + lane]; float q2 = q[128 + lane];
        const float other = __shfl_xor(q2, 32);
        if (lat) { const int t = row & (TL - 1), i = lane & 31; const float c = rc[t * 32 + i], s = rs[t * 32 + i];
            const float x1 = lane < 32 ? q2 : other, x2 = lane < 32 ? other : q2; q2 = lane < 32 ? (x1 * c - x2 * s) : (x1 * s + x2 * c); }
        bf16_t* qo = Q + orow * 192; qo[lane] = f2bf(q0); qo[64 + lane] = f2bf(q1); qo[128 + lane] = f2bf(q2);
        const float* kv = KVRAW + (size_t)row * 2048 + h * 256;
        bf16_t* ko = K + orow * 192; ko[lane] = f2bf(kv[lane]); ko[64 + lane] = f2bf(kv[64 + lane]); ko[128 + lane] = f2bf(KR[(size_t)row * 64 + lane]);
        bf16_t* vo = V + orow * 128; vo[lane] = f2bf(kv[128 + lane]); vo[64 + lane] = f2bf(kv[192 + lane]);
    }
}

__device__ void ph_attn_naive(const Params& p, char* lds) {
    const int tid = tidx(), qi = tid >> 2, part = tid & 3;
    const bf16_t* Q = (const bf16_t*)(p.ws + OFF_Q); const bf16_t* K = (const bf16_t*)(p.ws + OFF_K); const bf16_t* V = (const bf16_t*)(p.ws + OFF_V);
    bf16_t* O = (bf16_t*)(p.ws + OFF_O);
    bf16_t* Ks = (bf16_t*)lds;
    bf16_t* Vs = Ks + 32 * 192;
    const int nitems = 32 * 34;
    for (int it = blockIdx.x; it < nitems; it += gridDim.x) {
        const int bh = it / 34, qb = it % 34; const int b = bh >> 3, h = bh & 7;
        const int nkeys = qb < 2 ? TC : TK;
        const int tq = qb * 128 + qi;
        const bf16_t* qp = Q + ((size_t)bh * TK + tq) * 192 + part * 48;
        float q[48];
#pragma unroll
        for (int i = 0; i < 48; ++i) q[i] = bf2f(qp[i]) * ATT_SCALE;
        float o[32];
#pragma unroll
        for (int i = 0; i < 32; ++i) o[i] = 0.f;
        float m = -1e30f, l = 0.f;
        for (int k0 = 0; k0 < nkeys; k0 += 32) {
            __syncthreads();
            {
                const bf16_t* kg = K + ((size_t)bh * TK + k0) * 192; const bf16_t* vg = V + ((size_t)bh * TK + k0) * 128;
                for (int c = tid; c < 768; c += NTHR) *(u32x4*)(Ks + c * 8) = *(const u32x4*)(kg + c * 8);
                *(u32x4*)(Vs + tid * 8) = *(const u32x4*)(vg + tid * 8);
            }
            __syncthreads();
#pragma unroll 1
            for (int kg = 0; kg < 32; kg += 8) {
                float s[8]; float tmax = -1e30f;
#pragma unroll
                for (int kk = 0; kk < 8; ++kk) {
                    const bf16_t* kr = Ks + (kg + kk) * 192 + part * 48; float acc = 0.f;
#pragma unroll
                    for (int i = 0; i < 48; ++i) acc += q[i] * bf2f(kr[i]);
                    acc += __shfl_xor(acc, 1); acc += __shfl_xor(acc, 2);
                    s[kk] = acc; tmax = fmaxf(tmax, acc);
                    asm volatile("" ::: "memory");
                }
                const float mn = fmaxf(m, tmax), alpha = expf(m - mn); m = mn; l *= alpha;
#pragma unroll
                for (int i = 0; i < 32; ++i) o[i] *= alpha;
#pragma unroll
                for (int kk = 0; kk < 8; ++kk) {
                    const float pw = expf(s[kk] - mn); l += pw;
                    const bf16_t* vr = Vs + (kg + kk) * 128 + part * 32;
#pragma unroll
                    for (int i = 0; i < 32; ++i) o[i] += pw * bf2f(vr[i]);
                    asm volatile("" ::: "memory");
                }
            }
        }
        const float rl = 1.f / l;
        const int row = qb < 2 ? (NLAT + b * TC + tq) : (b * TL + tq - TC);
        bf16_t* op = O + (size_t)row * D + h * 128 + part * 32;
#pragma unroll
        for (int i = 0; i < 32; ++i) op[i] = f2bf(o[i] * rl);
    }
}


namespace fa {
using s16x4  = __attribute__((ext_vector_type(4))) short;
using f32x16 = __attribute__((ext_vector_type(16))) float;
constexpr int DQK = 192, DV = 128, KVBLK = 64;
constexpr float THR = 8.f;
constexpr int SHM_V = KVBLK * DV * 2, SHM_K = KVBLK * DQK * 2;
constexpr int SHM_ATTN = 2 * SHM_V + 2 * SHM_K + 8 * 64 * 4;
#define KSWZ(row, colB) ((row) * 384 + ((colB) ^ (((row) & 7) << 4)))
#define SBAR() __builtin_amdgcn_sched_barrier(0)
__device__ __forceinline__ int crow(int r, int hi) { return (r & 3) + 8 * (r >> 2) + 4 * hi; }
__device__ __forceinline__ unsigned cvtpk(float lo, float hi) { unsigned r; asm volatile("v_cvt_pk_bf16_f32 %0, %1, %2" : "=v"(r) : "v"(lo), "v"(hi)); return r; }
__device__ __forceinline__ void partialSM(f32x16& p0, f32x16& p1, float& m_reg, float& mn, float& alpha) {
  constexpr float C = ATT_SCALE * 1.4426950408889634f;
  float pmax = p0[0];
#pragma unroll
  for (int r = 1; r < 16; ++r) pmax = fmaxf(pmax, p0[r]);
#pragma unroll
  for (int r = 0; r < 16; ++r) pmax = fmaxf(pmax, p1[r]);
  { auto rr = __builtin_amdgcn_permlane32_swap(__float_as_uint(pmax), __float_as_uint(pmax), false, false);
    pmax = fmaxf(__uint_as_float(rr[0]), __uint_as_float(rr[1])); }
  if (__builtin_expect(__all(pmax - m_reg <= THR / ATT_SCALE), 1)) { mn = m_reg; alpha = 1.f; }
  else { mn = fmaxf(m_reg, pmax); alpha = __builtin_amdgcn_exp2f((m_reg - mn) * C); m_reg = mn; }
  float mnC = -mn * C;
#pragma unroll
  for (int r = 0; r < 16; ++r) p0[r] = fmaf(p0[r], C, mnC);
#pragma unroll
  for (int r = 0; r < 16; ++r) p1[r] = fmaf(p1[r], C, mnC);
#pragma unroll
  for (int r = 0; r < 16; ++r) p0[r] = __builtin_amdgcn_exp2f(p0[r]);
}
__device__ __forceinline__ void finishSM(f32x16& p0, f32x16& p1, float alpha, float& l_reg, bf16x8& pa0, bf16x8& pa1, bf16x8& pa2, bf16x8& pa3) {
#pragma unroll
  for (int r = 0; r < 16; ++r) p1[r] = __builtin_amdgcn_exp2f(p1[r]);
  float ps = 0;
#pragma unroll
  for (int r = 0; r < 16; ++r) ps += p0[r];
#pragma unroll
  for (int r = 0; r < 16; ++r) ps += p1[r];
  { auto rr = __builtin_amdgcn_permlane32_swap(__float_as_uint(ps), __float_as_uint(ps), false, false);
    ps = __uint_as_float(rr[0]) + __uint_as_float(rr[1]); }
  l_reg = l_reg * alpha + ps;
#define PK4(P, BASE, OUT) do { unsigned a0 = cvtpk(P[BASE + 0], P[BASE + 1]), a1 = cvtpk(P[BASE + 2], P[BASE + 3]);   \
    unsigned b0 = cvtpk(P[BASE + 4], P[BASE + 5]), b1 = cvtpk(P[BASE + 6], P[BASE + 7]);                              \
    auto r0 = __builtin_amdgcn_permlane32_swap(a0, b0, false, false); auto r1 = __builtin_amdgcn_permlane32_swap(a1, b1, false, false); \
    u32x4 w = {r0[0], r1[0], r0[1], r1[1]}; OUT = *reinterpret_cast<bf16x8*>(&w); } while (0)
  PK4(p0, 0, pa0); PK4(p0, 8, pa1); PK4(p1, 0, pa2); PK4(p1, 8, pa3);
#undef PK4
}
__device__ __forceinline__ void qkt(f32x16& p0, f32x16& p1, const char* Ks, const bf16x8* qr, int r32, int hi) {
  p0 = f32x16{}; p1 = f32x16{};
  const int swz = (r32 & 7) << 4;
  const char* b4[4];
#pragma unroll
  for (int dr = 0; dr < 4; ++dr) b4[dr] = Ks + r32 * 384 + ((dr * 32 + hi * 16) ^ swz);
#pragma unroll
  for (int d0 = 0; d0 < 12; ++d0) {
    bf16x8 b0 = *reinterpret_cast<const bf16x8*>(b4[d0 & 3] + (d0 >> 2) * 128);
    bf16x8 b1 = *reinterpret_cast<const bf16x8*>(b4[d0 & 3] + (d0 >> 2) * 128 + 32 * 384);
    p0 = __builtin_amdgcn_mfma_f32_32x32x16_bf16(b0, qr[d0], p0, 0, 0, 0);
    p1 = __builtin_amdgcn_mfma_f32_32x32x16_bf16(b1, qr[d0], p1, 0, 0, 0); }
}
__device__ __forceinline__ int v_st(int k, int c) { const int kk = (k & ~0xC) | ((k & 4) << 1) | ((k & 8) >> 1); return ((kk >> 3) * 4 + (c >> 5)) * 512 + ((kk & 7) * 32 + (c & 31)) * 2; }
__device__ __forceinline__ int v_rd_base(int lane) { return ((lane & 3) << 3) | (((lane >> 2) & 3) << 6) | (((lane >> 4) & 1) << 5) | (((lane >> 5) & 1) << 8); }
constexpr int v_rd_off(int d0, int ks, int half) { return d0 * 512 + ks * 4096 + half * 2048; }
template <int OFF> __device__ __forceinline__ s16x4 tr_read(int vb) {
  s16x4 r; asm volatile("ds_read_b64_tr_b16 %0, %1 offset:%2" : "=&v"(r) : "v"(vb), "i"(OFF) : "memory"); return r;
}
template <int D0> __device__ __forceinline__ void pv_one(f32x16& od, int vb, bf16x8 pa0, bf16x8 pa1, bf16x8 pa2, bf16x8 pa3) {
  const s16x4 l0 = tr_read<v_rd_off(D0, 0, 0)>(vb), h0 = tr_read<v_rd_off(D0, 0, 1)>(vb), l1 = tr_read<v_rd_off(D0, 1, 0)>(vb), h1 = tr_read<v_rd_off(D0, 1, 1)>(vb);
  const s16x4 l2 = tr_read<v_rd_off(D0, 2, 0)>(vb), h2 = tr_read<v_rd_off(D0, 2, 1)>(vb), l3 = tr_read<v_rd_off(D0, 3, 0)>(vb), h3 = tr_read<v_rd_off(D0, 3, 1)>(vb);
  asm volatile("s_waitcnt lgkmcnt(0)" ::: "memory"); SBAR();
#define PK(L, H) (bf16x8){L[0], L[1], L[2], L[3], H[0], H[1], H[2], H[3]}
  od = __builtin_amdgcn_mfma_f32_32x32x16_bf16(pa0, PK(l0, h0), od, 0, 0, 0);
  od = __builtin_amdgcn_mfma_f32_32x32x16_bf16(pa1, PK(l1, h1), od, 0, 0, 0);
  od = __builtin_amdgcn_mfma_f32_32x32x16_bf16(pa2, PK(l2, h2), od, 0, 0, 0);
  od = __builtin_amdgcn_mfma_f32_32x32x16_bf16(pa3, PK(l3, h3), od, 0, 0, 0);
#undef PK
}
__device__ __forceinline__ void pv_d0(f32x16* o, int vb, bf16x8 pa0, bf16x8 pa1, bf16x8 pa2, bf16x8 pa3) {
  pv_one<0>(o[0], vb, pa0, pa1, pa2, pa3); pv_one<1>(o[1], vb, pa0, pa1, pa2, pa3); pv_one<2>(o[2], vb, pa0, pa1, pa2, pa3); pv_one<3>(o[3], vb, pa0, pa1, pa2, pa3);
}
__device__ __forceinline__ void attn_body(const bf16_t* __restrict__ Qb, const bf16_t* __restrict__ Kh, const bf16_t* __restrict__ Vh, bf16_t* __restrict__ Ob, int ldo, int seq, char* lds) {
  const int tid = tidx(), wid = tid >> 6, lane = tid & 63, r32 = lane & 31, hi = lane >> 5;
  char* V_lds = lds; char* K_lds = lds + 2 * SHM_V;
  float* ws = (float*)(lds + 2 * SHM_V + 2 * SHM_K) + wid * 64; float* li_l = ws; float* al_l = ws + 32;
  float m_reg = -1e30f, l_reg = 0; f32x16 o[4] = {}; bf16x8 qr[12];
  const bf16_t* Qw = Qb + (long)(wid * 32 + r32) * DQK + hi * 8;
#pragma unroll
  for (int d0 = 0; d0 < 12; ++d0) qr[d0] = *reinterpret_cast<const bf16x8*>(Qw + d0 * 16);
  const int sr = tid >> 4, sc = (tid & 15) * 8, vst0 = v_st(sr, sc), vst1 = v_st(32 + sr, sc);
  int kst[3];
#pragma unroll
  for (int i = 0; i < 3; ++i) { const int c = tid + 512 * i, row = c / 24, cc = c % 24; kst[i] = KSWZ(row, cc * 16); }
  const int vb0 = (int)(uintptr_t)V_lds + v_rd_base(lane);
  struct { bf16x8 vs0, vs1, ks0, ks1, ks2; } sr_[1];
#define SLOAD(i, k0) do { const bf16_t* vt = Vh + (long)(k0) * DV; const bf16_t* kt = Kh + (long)(k0) * DQK; \
    sr_[i].vs0 = *reinterpret_cast<const bf16x8*>(vt + (sr) * DV + sc); sr_[i].vs1 = *reinterpret_cast<const bf16x8*>(vt + (32 + sr) * DV + sc); \
    sr_[i].ks0 = *reinterpret_cast<const bf16x8*>(kt + tid * 8); sr_[i].ks1 = *reinterpret_cast<const bf16x8*>(kt + (tid + 512) * 8); sr_[i].ks2 = *reinterpret_cast<const bf16x8*>(kt + (tid + 1024) * 8); } while (0)
#define SWRITE(b, i) do { *(bf16x8*)(V_lds + (b) * SHM_V + vst0) = sr_[i].vs0; *(bf16x8*)(V_lds + (b) * SHM_V + vst1) = sr_[i].vs1; \
    *(bf16x8*)(K_lds + (b) * SHM_K + kst[0]) = sr_[i].ks0; *(bf16x8*)(K_lds + (b) * SHM_K + kst[1]) = sr_[i].ks1; *(bf16x8*)(K_lds + (b) * SHM_K + kst[2]) = sr_[i].ks2; } while (0)
#define SWAIT() asm volatile("s_waitcnt vmcnt(5)" ::: "memory")
#define RESC(a) do { if (__any((a) < 1.f)) { if (hi == 0) al_l[r32] = (a); asm volatile("s_waitcnt lgkmcnt(0)" ::: "memory"); \
    _Pragma("unroll") for (int d = 0; d < 4; ++d) _Pragma("unroll") for (int r = 0; r < 16; ++r) o[d][r] *= al_l[crow(r, hi)]; } } while (0)
  f32x16 pA0, pA1; float mnA, alA; bf16x8 pa0, pa1, pa2, pa3; const int NT = seq / KVBLK;
  SLOAD(0, 0); SWRITE(0, 0);
  SLOAD(0, KVBLK);
  __syncthreads();
  for (int j = 0; j < NT; j += 2) {
    SBAR(); qkt(pA0, pA1, K_lds, qr, r32, hi);
    partialSM(pA0, pA1, m_reg, mnA, alA); RESC(alA);
    finishSM(pA0, pA1, alA, l_reg, pa0, pa1, pa2, pa3); SBAR();
    SWRITE(1, 0);
    if (j + 2 < NT) SLOAD(0, (j + 2) * KVBLK);
    SBAR();
    pv_d0(o, vb0, pa0, pa1, pa2, pa3);
    __syncthreads();
    SBAR(); qkt(pA0, pA1, K_lds + SHM_K, qr, r32, hi);
    partialSM(pA0, pA1, m_reg, mnA, alA); RESC(alA);
    finishSM(pA0, pA1, alA, l_reg, pa0, pa1, pa2, pa3); SBAR();
    if (j + 2 < NT) { SWRITE(0, 0); if (j + 3 < NT) SLOAD(0, (j + 3) * KVBLK); }
    SBAR();
    pv_d0(o, vb0 + SHM_V, pa0, pa1, pa2, pa3);
    __syncthreads();
  }
  if (hi == 0) li_l[r32] = l_reg; asm volatile("s_waitcnt lgkmcnt(0)" ::: "memory");
  float rli[16];
#pragma unroll
  for (int r = 0; r < 16; ++r) rli[r] = __builtin_amdgcn_rcpf(li_l[crow(r, hi)]);
  bf16_t* Ow = Ob + (long)(wid * 32) * ldo;
#pragma unroll
  for (int r = 0; r < 16; ++r) { int orow = crow(r, hi);
#pragma unroll
    for (int d0 = 0; d0 < 4; ++d0) Ow[(long)orow * ldo + d0 * 32 + r32] = f2bf(o[d0][r] * rli[r]); }
  __syncthreads();
#undef SLOAD
#undef SWRITE
#undef SWAIT
#undef RESC
}
#undef KSWZ
}

__device__ void ph_attn(const Params& p, char* lds) {
    const bf16_t* Q = (const bf16_t*)(p.ws + OFF_Q); const bf16_t* K = (const bf16_t*)(p.ws + OFF_K); const bf16_t* V = (const bf16_t*)(p.ws + OFF_V);
    bf16_t* O = (bf16_t*)(p.ws + OFF_O);
    const int G = gridDim.x;
    for (int i = 0;; ++i) {
        const int L = i * G + (int)blockIdx.x; if (L >= 544) break;
        int bh, qb;
        if (L < 512) { const int w = g8::xcd_remap(L, 512); bh = w >> 4; qb = 1 + (w & 15); } else { bh = L - 512; qb = 0; }
        const int b = bh >> 3, h = bh & 7;
        const int seq = qb == 0 ? TC : TK;
        const int row0 = qb == 0 ? NLAT + b * TC : b * TL + (qb - 1) * 256;
        fa::attn_body(Q + ((size_t)bh * TK + qb * 256) * 192, K + (size_t)bh * TK * 192, V + (size_t)bh * TK * 128, O + (size_t)row0 * D + h * 128, D, seq, lds);
    }
}

__device__ void ph_norm2_router(const Params& p, int layer, char* lds) {
    const int tid = tidx(), wid = tid >> 6, lane = tid & 63;
    float* rt = (float*)lds;
    const float* rg = p.moe_router + (size_t)layer * D * NE;
    for (int i = tid; i < D * NE / 4; i += NTHR) ((float4*)rt)[i] = ((const float4*)rg)[i];
    __syncthreads();
    const float* X = (const float*)(p.ws + OFF_X); bf16_t* BN = (bf16_t*)(p.ws + OFF_H); float* AFF = (float*)(p.ws + OFF_AFF);
    const float* g = p.norm2_g + layer * D;
    for (int row = blockIdx.x * 8 + wid; row < NROW; row += gridDim.x * 8) {
        const int s = row_stream(row);
        const float* sh = modp(p, layer, s, 3); const float* sc = modp(p, layer, s, 4);
        const float4* xr = (const float4*)(X + (size_t)row * D);
        float4 v[4]; float ss = 0;
#pragma unroll
        for (int i = 0; i < 4; ++i) { v[i] = xr[lane + i * 64]; ss += v[i].x * v[i].x + v[i].y * v[i].y + v[i].z * v[i].z + v[i].w * v[i].w; }
        ss = wave_sum(ss); const float rs = rsqrtf(ss * (1.f / D) + RMS_EPS);
        float lg[16];
#pragma unroll
        for (int e = 0; e < 16; ++e) lg[e] = 0.f;
#pragma unroll
        for (int i = 0; i < 4; ++i) {
            const int d = (lane + i * 64) * 4;
            const float4 gg = *(const float4*)(g + d), a = *(const float4*)(sc + d), b = *(const float4*)(sh + d);
            float o[4]; o[0] = v[i].x * rs * gg.x * (1.f + a.x) + b.x; o[1] = v[i].y * rs * gg.y * (1.f + a.y) + b.y; o[2] = v[i].z * rs * gg.z * (1.f + a.z) + b.z; o[3] = v[i].w * rs * gg.w * (1.f + a.w) + b.w;
            uint2 w; w.x = pk2(o[0], o[1]); w.y = pk2(o[2], o[3]); *(uint2*)(BN + (size_t)row * D + d) = w;
#pragma unroll
            for (int jj = 0; jj < 4; ++jj) { const float* rr = rt + (d + jj) * 16;
#pragma unroll
                for (int e = 0; e < 16; ++e) lg[e] += o[jj] * rr[e];
                asm volatile("" ::: "memory"); }
        }
        float mx = -1e30f;
#pragma unroll
        for (int e = 0; e < 16; ++e) { lg[e] = wave_sum(lg[e]); mx = fmaxf(mx, lg[e]); }
        float sum = 0;
#pragma unroll
        for (int e = 0; e < 16; ++e) { lg[e] = expf(lg[e] - mx); sum += lg[e]; }
        const float inv = 1.f / sum;
        if (lane < 16) { float val = 0;
#pragma unroll
            for (int e = 0; e < 16; ++e) val = (lane == e) ? lg[e] : val;
            AFF[(size_t)row * 16 + lane] = val * inv; }
    }
}

__device__ void ph_select(const Params& p, char* lds) {
    const int tid = tidx();
    float* vals = (float*)lds;
    const float* AFF = (const float*)(p.ws + OFF_AFF);
    int* ROWIDX = (int*)(p.ws + OFF_ROWIDX); float* GATE = (float*)(p.ws + OFF_GATE); int* SLOT = (int*)(p.ws + OFF_SLOT);
    for (int gidx = blockIdx.x; gidx < 128; gidx += gridDim.x) {
        const bool lat = gidx < 64; const int b = (gidx & 63) >> 4, e = gidx & 15;
        const int n = lat ? TL : TC, cap = lat ? CAPL : CAPC;
        const int row0 = lat ? b * TL : NLAT + b * TC, slot0 = lat ? b * CAPL : NB * CAPL + b * CAPC;
        __syncthreads();
        for (int i = tid; i < n; i += NTHR) vals[i] = AFF[(size_t)(row0 + i) * 16 + e];
        __syncthreads();
        for (int i = tid; i < n; i += NTHR) {
            const float v = vals[i]; int rank = 0;
            for (int jj = 0; jj < n; ++jj) { const float u = vals[jj]; rank += (u > v || (u == v && jj < i)) ? 1 : 0; }
            if (rank < cap) { ROWIDX[e * ESLOTS + slot0 + rank] = row0 + i; GATE[e * EPAD + slot0 + rank] = v; SLOT[(size_t)(row0 + i) * 16 + e] = slot0 + rank; }
            else SLOT[(size_t)(row0 + i) * 16 + e] = -1;
        }
    }
}

__device__ void ph_gather(const Params& p) {
    const int wid = tidx() >> 6, lane = tidx() & 63;
    const int* ROWIDX = (const int*)(p.ws + OFF_ROWIDX); const bf16_t* BN = (const bf16_t*)(p.ws + OFF_H); bf16_t* XE = (bf16_t*)(p.ws + OFF_XE);
    for (int it = blockIdx.x * 8 + wid; it < NE * ESLOTS; it += gridDim.x * 8) {
        const int row = ROWIDX[it]; const int e = it / ESLOTS, sl = it % ESLOTS;
        const u32x4* src = (const u32x4*)(BN + (size_t)row * D); u32x4* dst = (u32x4*)(XE + ((size_t)e * EPAD + sl) * D);
        dst[lane] = src[lane]; dst[lane + 64] = src[lane + 64];
    }
}

__device__ void ph_combine(const Params& p, int layer) {
    const int wid = tidx() >> 6, lane = tidx() & 63;
    const int* SLOT = (const int*)(p.ws + OFF_SLOT); const bf16_t* YE = (const bf16_t*)(p.ws + OFF_YE); float* X = (float*)(p.ws + OFF_X);
    for (int row = blockIdx.x * 8 + wid; row < NROW; row += gridDim.x * 8) {
        const float* gt = modp(p, layer, row_stream(row), 5);
        float acc[16];
#pragma unroll
        for (int i = 0; i < 16; ++i) acc[i] = 0.f;
        for (int e = 0; e < NE; ++e) {
            const int s = SLOT[(size_t)row * 16 + e];
            if (s >= 0) { const bf16_t* y = YE + ((size_t)e * EPAD + s) * D + lane * 16;
                const u32x4 a = *(const u32x4*)y, b = *(const u32x4*)(y + 8);
                const unsigned w[8] = {a.x, a.y, a.z, a.w, b.x, b.y, b.z, b.w};
#pragma unroll
                for (int i = 0; i < 8; ++i) { acc[2 * i] += __uint_as_float(w[i] << 16); acc[2 * i + 1] += __uint_as_float(w[i] & 0xffff0000u); } }
        }
        float* xr = X + (size_t)row * D + lane * 16; const float* g = gt + lane * 16;
#pragma unroll
        for (int i = 0; i < 16; i += 4) { float4 xv = *(float4*)(xr + i); const float4 gv = *(const float4*)(g + i);
            xv.x += gv.x * acc[i]; xv.y += gv.y * acc[i + 1]; xv.z += gv.z * acc[i + 2]; xv.w += gv.w * acc[i + 3]; *(float4*)(xr + i) = xv; }
    }
}

__device__ void ph_rw_xs(const Params& p, int j) {
    const float* HF = (const float*)(p.ws + OFF_HF); bf16_t* XS = (bf16_t*)(p.ws + OFF_XS);
    const float* mu = p.rw_mu + (size_t)j * 6 * D;
    const int gtid = blockIdx.x * NTHR + tidx(), gsz = gridDim.x * NTHR;
    for (int i = gtid; i < NROW * 256; i += gsz) {
        const int row = i >> 8, d = (i & 255) * 4;
        const bool lat = row < NLAT; const int t = lat ? (row & (TL - 1)) : ((row - NLAT) & (TC - 1)); const int len = lat ? TL : TC;
        const float4 h = *(const float4*)(HF + (size_t)row * D + d);
        float4 pv = make_float4(0, 0, 0, 0), nx = make_float4(0, 0, 0, 0);
        if (t > 0) pv = *(const float4*)(HF + (size_t)(row - 1) * D + d);
        if (t < len - 1) nx = *(const float4*)(HF + (size_t)(row + 1) * D + d);
        float4 xx; xx.x = 0.5f * (pv.x + nx.x) - h.x; xx.y = 0.5f * (pv.y + nx.y) - h.y; xx.z = 0.5f * (pv.z + nx.z) - h.z; xx.w = 0.5f * (pv.w + nx.w) - h.w;
#pragma unroll
        for (int m = 0; m < 6; ++m) { const float4 u = *(const float4*)(mu + m * D + d);
            uint2 w; w.x = pk2(h.x + xx.x * u.x, h.y + xx.y * u.y); w.y = pk2(h.z + xx.z * u.z, h.w + xx.w * u.w);
            *(uint2*)(XS + ((size_t)m * NROW + row) * D + d) = w; }
    }
}

__device__ void ph_rw_prep(const Params& p, int j) {
    const int wid = tidx() >> 6, lane = tidx() & 63;
    float* RKV = (float*)(p.ws + OFF_RKV); float* AV = (float*)(p.ws + OFF_AV); float* KD = (float*)(p.ws + OFF_KD);
    const float* k_k = p.rw_k_k + j * D; const float* k_a = p.rw_k_a + j * D;
    for (int row = blockIdx.x * 8 + wid; row < NROW; row += gridDim.x * 8) {
        const size_t o = (size_t)row * D + lane * 16;
        float k[16], kk[16]; float ss = 0;
#pragma unroll
        for (int i = 0; i < 16; ++i) { k[i] = RKV[(size_t)NROW * D + o + i]; kk[i] = k[i] * k_k[lane * 16 + i]; ss += kk[i] * kk[i]; }
        ss += __shfl_xor(ss, 1); ss += __shfl_xor(ss, 2);
        const float inv = 1.f / fmaxf(sqrtf(ss), 1e-12f);
#pragma unroll
        for (int i = 0; i < 16; ++i) kk[i] *= inv;
#pragma unroll
        for (int z = 0; z < 2; ++z)
#pragma unroll
            for (int i = 0; i < 16; ++i) { const float a = AV[(size_t)z * NROW * D + o + i];
                KD[(size_t)z * NROW * D + o + i] = k[i] * (1.f + (a - 1.f) * k_a[lane * 16 + i]);
                AV[(size_t)z * NROW * D + o + i] = kk[i] * a; }
#pragma unroll
        for (int i = 0; i < 16; ++i) RKV[(size_t)NROW * D + o + i] = kk[i];
    }
}

__device__ __forceinline__ float dpp_sum16(float x) {
    x += __builtin_bit_cast(float, __builtin_amdgcn_update_dpp(0, __builtin_bit_cast(int, x), 0xB1, 0xF, 0xF, true));
    x += __builtin_bit_cast(float, __builtin_amdgcn_update_dpp(0, __builtin_bit_cast(int, x), 0x4E, 0xF, 0xF, true));
    x += __builtin_bit_cast(float, __builtin_amdgcn_update_dpp(0, __builtin_bit_cast(int, x), 0x141, 0xF, 0xF, true));
    x += __builtin_bit_cast(float, __builtin_amdgcn_update_dpp(0, __builtin_bit_cast(int, x), 0x140, 0xF, 0xF, true));
    return x;
}
__device__ __forceinline__ int scan_row(int i, int b, int z) {
    return i < TC ? NLAT + b * TC + (z ? TC - 1 - i : i) : b * TL + (z ? TL - 1 - (i - TC) : i - TC);
}
__device__ void ph_rw_scan(const Params& p, char* lds) {
    const int tid = tidx(), wid = __builtin_amdgcn_readfirstlane(tid >> 6), lane = tid & 63, vr = lane >> 4, ks = lane & 15;
    const size_t PL = (size_t)NROW * D;
    const float* RKV = (const float*)(p.ws + OFF_RKV); float* Y = (float*)(p.ws + OFF_Y);
    constexpr int CH = 32, BUFB = 5 * CH * 256 + CH * 128, YB = CH * 32 * 4;
    for (int it = blockIdx.x; it < 256; it += gridDim.x) {
        const int vh = it & 1, z = (it >> 1) & 1, h = (it >> 2) & 15, b = it >> 6;
        const char* pl[5];
        pl[0] = (const char*)((const float*)(p.ws + OFF_W) + z * PL); pl[1] = (const char*)(RKV + PL); pl[2] = (const char*)((const float*)(p.ws + OFF_AV) + z * PL);
        pl[3] = (const char*)((const float*)(p.ws + OFF_KD) + z * PL); pl[4] = (const char*)RKV;
        const char* vpl = (const char*)(RKV + 2 * PL);
        float* yout = Y + z * PL;
        auto issue = [&](int c) {
            char* buf = lds + (c & 1) * BUFB;
#pragma unroll
            for (int q0 = 0; q0 < 48; q0 += 8) {
                const int q = q0 + wid;
                if (q < 40) { const int pi = q >> 3, tg = q & 7; const int row = scan_row(c * CH + tg * 4 + (lane >> 4), b, z);
                    const char* base = pi == 0 ? pl[0] : pi == 1 ? pl[1] : pi == 2 ? pl[2] : pi == 3 ? pl[3] : pl[4];
                    __builtin_amdgcn_global_load_lds((const unsigned*)(base + (size_t)row * D * 4 + h * 256 + (lane & 15) * 16), (LAS unsigned*)(buf + pi * (CH * 256) + tg * 1024), 16, 0, 0); }
                else if (q < 44) { const int tg = q - 40; const int row = scan_row(c * CH + tg * 8 + (lane >> 3), b, z);
                    __builtin_amdgcn_global_load_lds((const unsigned*)(vpl + (size_t)row * D * 4 + (h * 64 + vh * 32) * 4 + (lane & 7) * 16), (LAS unsigned*)(buf + 5 * CH * 256 + tg * 1024), 16, 0, 0); }
            }
        };
        float S0 = 0.f, S1 = 0.f, S2 = 0.f, S3 = 0.f;
        __syncthreads();
        issue(0);
        asm volatile("s_waitcnt vmcnt(0)" ::: "memory"); __syncthreads();
        constexpr int NCH = (TC + TL) / CH;
        for (int c = 0; c < NCH; ++c) {
            if (c + 1 < NCH) issue(c + 1);
            const char* buf = lds + (c & 1) * BUFB; float* yb = (float*)(lds + 2 * BUFB + (c & 1) * YB);
#pragma unroll 4
            for (int t = 0; t < CH; ++t) {
                const f32x4 w = *(const f32x4*)(buf + t * 256 + ks * 16), kk = *(const f32x4*)(buf + CH * 256 + t * 256 + ks * 16), bb = *(const f32x4*)(buf + 2 * CH * 256 + t * 256 + ks * 16);
                const f32x4 kd = *(const f32x4*)(buf + 3 * CH * 256 + t * 256 + ks * 16), r = *(const f32x4*)(buf + 4 * CH * 256 + t * 256 + ks * 16);
                const float v = *(const float*)(buf + 5 * CH * 256 + t * 128 + (wid * 4 + vr) * 4);
                float sa = -(S0 * kk[0] + S1 * kk[1] + S2 * kk[2] + S3 * kk[3]);
                sa = dpp_sum16(sa);
                S0 = S0 * w[0] + sa * bb[0] + v * kd[0]; S1 = S1 * w[1] + sa * bb[1] + v * kd[1]; S2 = S2 * w[2] + sa * bb[2] + v * kd[2]; S3 = S3 * w[3] + sa * bb[3] + v * kd[3];
                float y = S0 * r[0] + S1 * r[1] + S2 * r[2] + S3 * r[3];
                y = dpp_sum16(y);
                if (ks == 0) yb[t * 32 + wid * 4 + vr] = y;
            }
            asm volatile("s_waitcnt vmcnt(0)" ::: "memory"); __syncthreads();
            if (tid < 256) { const int t = tid >> 3, q = tid & 7; const int row = scan_row(c * CH + t, b, z);
                *(f32x4*)(yout + (size_t)row * D + h * 64 + vh * 32 + q * 4) = *(const f32x4*)(yb + t * 32 + q * 4); }
        }
    }
}

__device__ void ph_rw_out(const Params& p, int j) {
    const int wid = tidx() >> 6, lane = tidx() & 63;
    const float* RKV = (const float*)(p.ws + OFF_RKV); const float* KD = (const float*)(p.ws + OFF_KD); const float* G = (const float*)(p.ws + OFF_G); const float* Y = (const float*)(p.ws + OFF_Y);
    bf16_t* OUT = (bf16_t*)(p.ws + OFF_H);
    const size_t PL = (size_t)NROW * D;
    const float* r_k = p.rw_r_k + j * D; const float* lg = p.rw_lnx_g + j * D; const float* lb = p.rw_lnx_b + j * D;
    for (int row = blockIdx.x * 8 + wid; row < NROW; row += gridDim.x * 8) {
        const size_t o = (size_t)row * D + lane * 16;
        float y[16]; float s = 0;
#pragma unroll
        for (int i = 0; i < 16; ++i) { y[i] = Y[o + i] + Y[PL + o + i]; s += y[i]; }
        s += __shfl_xor(s, 1); s += __shfl_xor(s, 2); const float mean = s * (1.f / 64.f);
        float q = 0;
#pragma unroll
        for (int i = 0; i < 16; ++i) { const float dd = y[i] - mean; q += dd * dd; }
        q += __shfl_xor(q, 1); q += __shfl_xor(q, 2); const float rstd = rsqrtf(q * (1.f / 64.f) + LNX_EPS);
        float bs = 0;
#pragma unroll
        for (int i = 0; i < 16; ++i) bs += RKV[o + i] * (KD[o + i] + KD[PL + o + i]) * r_k[lane * 16 + i];
        bs += __shfl_xor(bs, 1); bs += __shfl_xor(bs, 2);
        unsigned w[8];
#pragma unroll
        for (int i = 0; i < 16; i += 2) {
            const float o0 = ((y[i] - mean) * rstd * lg[lane * 16 + i] + lb[lane * 16 + i] + bs * RKV[2 * PL + o + i]) * G[o + i];
            const float o1 = ((y[i + 1] - mean) * rstd * lg[lane * 16 + i + 1] + lb[lane * 16 + i + 1] + bs * RKV[2 * PL + o + i + 1]) * G[o + i + 1];
            w[i >> 1] = pk2(o0, o1); }
        *(u32x4*)(OUT + o) = (u32x4){w[0], w[1], w[2], w[3]}; *(u32x4*)(OUT + o + 8) = (u32x4){w[4], w[5], w[6], w[7]};
    }
}

__device__ void ph_final(const Params& p) {
    const int wid = tidx() >> 6, lane = tidx() & 63;
    const float* X = (const float*)(p.ws + OFF_X);
    for (int row = blockIdx.x * 8 + wid; row < NLAT; row += gridDim.x * 8) {
        const float4* xr = (const float4*)(X + (size_t)row * D);
        float4 v[4]; float ss = 0;
#pragma unroll
        for (int i = 0; i < 4; ++i) { v[i] = xr[lane + i * 64]; ss += v[i].x * v[i].x + v[i].y * v[i].y + v[i].z * v[i].z + v[i].w * v[i].w; }
        ss = wave_sum(ss); const float rs = rsqrtf(ss * (1.f / D) + RMS_EPS);
#pragma unroll
        for (int i = 0; i < 4; ++i) { const int d = (lane + i * 64) * 4; const float4 gg = *(const float4*)(p.final_g + d);
            float4 o; o.x = v[i].x * rs * gg.x; o.y = v[i].y * rs * gg.y; o.z = v[i].z * rs * gg.z; o.w = v[i].w * rs * gg.w;
            *(float4*)(p.out + (size_t)row * D + d) = o; }
    }
}

enum { PH_INIT = 0, PH_A_NORM, PH_A_Z, PH_A_MID, PH_A_QKV, PH_A_POST, PH_A_ATTN, PH_A_WO,
       PH_R_NORM, PH_R_XS, PH_R_G1, PH_R_G2, PH_R_PREP, PH_R_SCAN, PH_R_OUT, PH_R_WO,
       PH_M_NORM, PH_M_SEL, PH_M_GATHER, PH_M_G1, PH_M_G2, PH_M_COMB, PH_FINAL, PH_M_CVT };

template <int PH>
__device__ __forceinline__ void run_phase(const Params& p, int layer, char* lds) {
    const int j = layer >> 1;
    char* ws = p.ws;
    if constexpr (PH == PH_INIT) { ph_init(p, lds); __syncthreads(); ph_small_cvt(p, lds); }
    else if constexpr (PH == PH_A_NORM) ph_norm_mod<false>(p, layer, p.norm1_g + layer * D, 0, 1, ws + OFF_H);
    else if constexpr (PH == PH_A_Z) {
        float* Z = (float*)(ws + OFF_Z);
        g8::BatchSched S{ws + OFF_H, ws + OFF_WMLA + j * SZ_WMLA + WM_IN, 0, 0, NROW / 256, 2, 1, D};
        g8::gemm_phase((PG8_LAS unsigned char*)lds, D, S, g8::epi_rc([=](const g8::Unit&, int row, int col, f32x4 v) { *(f32x4*)(Z + (size_t)row * 512 + col) = v; }));
    }
    else if constexpr (PH == PH_A_MID) ph_mla_mid(p, j);
    else if constexpr (PH == PH_A_QKV) {
        float* QRAW = (float*)(ws + OFF_QRAW); float* KVRAW = (float*)(ws + OFF_KVRAW);
        g8::BatchSched S1{ws + OFF_CQN, ws + OFF_WMLA + j * SZ_WMLA + WM_UQ, 0, 0, NROW / 256, 6, 1, 256};
        g8::gemm_phase((PG8_LAS unsigned char*)lds, 256, S1, g8::epi_rc([=](const g8::Unit&, int row, int col, f32x4 v) { *(f32x4*)(QRAW + (size_t)row * 1536 + col) = v; }));
        g8::BatchSched S2{ws + OFF_CKVN, ws + OFF_WMLA + j * SZ_WMLA + WM_UKV, 0, 0, NROW / 256, 8, 1, 256};
        g8::gemm_phase((PG8_LAS unsigned char*)lds, 256, S2, g8::epi_rc([=](const g8::Unit&, int row, int col, f32x4 v) { *(f32x4*)(KVRAW + (size_t)row * 2048 + col) = v; }));
    }
    else if constexpr (PH == PH_A_POST) ph_qkv_post(p);
    else if constexpr (PH == PH_A_ATTN) ph_attn(p, lds);
    else if constexpr (PH == PH_A_WO || PH == PH_R_WO) {
        float* X = (float*)(ws + OFF_X); const float* MOD = (const float*)(ws + OFF_MOD);
        g8::BatchSched S{ws + (PH == PH_A_WO ? OFF_O : OFF_H), PH == PH_A_WO ? ws + OFF_WMLA + j * SZ_WMLA + WM_O : ws + OFF_WRW + j * SZ_WRW + WR_O, 0, 0, NROW / 256, 4, 1, D};
        g8::gemm_phase((PG8_LAS unsigned char*)lds, D, S, g8::epi_rc([=](const g8::Unit&, int row, int col, f32x4 v) {
            const f32x4 gt = *(const f32x4*)(MOD + ((size_t)layer * 5 + row_stream(row)) * 6144 + 2048 + col);
            f32x4* xp = (f32x4*)(X + (size_t)row * D + col); *xp = *xp + gt * v; }));
    }
    else if constexpr (PH == PH_R_NORM) ph_norm_mod<true>(p, layer, p.norm1_g + layer * D, 0, 1, ws + OFF_HF);
    else if constexpr (PH == PH_R_XS) ph_rw_xs(p, j);
    else if constexpr (PH == PH_R_G1) {
        float* RKV = (float*)(ws + OFF_RKV); float* VF = (float*)(ws + OFF_VFIRST);
        bf16_t* LW = (bf16_t*)(ws + OFF_LW); bf16_t* LA = (bf16_t*)(ws + OFF_LA); bf16_t* LG = (bf16_t*)(ws + OFF_LG); bf16_t* LV = (bf16_t*)(ws + OFF_LV);
        const bool first = (j == 0);
        struct RSched { const char* XS; const char* WB; int nwg;
            __device__ __forceinline__ bool next(int i, g8::Unit& u) const {
                const int L = i * (int)gridDim.x + (int)blockIdx.x; if (L >= nwg) return false;
                const int w = g8::xcd_remap(L, nwg);
                if (w < 816) { u.g = w / 272; const int r = w % 272; u.pm = r >> 2; u.pn = r & 3; u.B = WB + WR_RKV + (size_t)u.g * D * D * 2 + (size_t)u.pn * 256 * D * 2; }
                else { u.g = 3 + (w - 816) / 68; u.pm = (w - 816) % 68; u.pn = 0; u.B = WB + WR_L + (size_t)(u.g - 3) * 256 * D * 2; }
                u.A = XS + (size_t)(u.g == 6 ? 2 : u.g) * NROW * D * 2 + (size_t)u.pm * 256 * D * 2; return true; } };
        RSched S{ws + OFF_XS, ws + OFF_WRW + j * SZ_WRW, first ? 816 + 204 : 816 + 272};
        g8::gemm_phase((PG8_LAS unsigned char*)lds, D, S, g8::epi_rc([=](const g8::Unit& u, int row, int col, f32x4 v) {
            if (u.g < 3) { *(f32x4*)(RKV + ((size_t)u.g * NROW + row) * D + col) = v; if (first && u.g == 2) *(f32x4*)(VF + (size_t)row * D + col) = v; }
            else if (u.g == 3) { if (col < 128) { uint2 w; w.x = pk2(tanhf(v[0]), tanhf(v[1])); w.y = pk2(tanhf(v[2]), tanhf(v[3])); *(uint2*)(LW + (size_t)row * 128 + col) = w; } }
            else if (u.g == 4) { if (col < 128) { uint2 w; w.x = pk2(v[0], v[1]); w.y = pk2(v[2], v[3]); *(uint2*)(LA + (size_t)row * 128 + col) = w; } }
            else if (u.g == 5) { if (col < 128) { uint2 w; w.x = pk2(sigmoidf_(v[0]), sigmoidf_(v[1])); w.y = pk2(sigmoidf_(v[2]), sigmoidf_(v[3])); *(uint2*)(LG + (size_t)row * 128 + col) = w; } }
            else { if (col < 32) { uint2 w; w.x = pk2(v[0], v[1]); w.y = pk2(v[2], v[3]); *(uint2*)(LV + (size_t)row * 32 + col) = w; } } }));
    }
    else if constexpr (PH == PH_R_G2) {
        const bool first = (j == 0);
        float* W = (float*)(ws + OFF_W); float* AV = (float*)(ws + OFF_AV); float* G = (float*)(ws + OFF_G); float* RKV = (float*)(ws + OFF_RKV); const float* VF = (const float*)(ws + OFF_VFIRST);
        const float* w0 = p.rw_w0 + (size_t)j * 2 * D; const float* a0 = p.rw_a0 + (size_t)j * 2 * D; const float* v0 = p.rw_v0;
        SgArgs gw{(const bf16_t*)(ws + OFF_LW), 128, 64, p.rw_w2 + (size_t)j * 2 * 64 * D, D, (size_t)64 * D, NROW, D, 64, 2};
        sg_gemm(lds, gw, [=](int z, int row, int col, float v) { const float wz = v + w0[z * D + col];
            const float sp = (-wz > 20.f) ? -wz : log1pf(expf(-wz));
            W[((size_t)z * NROW + row) * D + col] = expf(-expf(-sp - 0.5f)); });
        SgArgs ga{(const bf16_t*)(ws + OFF_LA), 128, 64, p.rw_a2 + (size_t)j * 2 * 64 * D, D, (size_t)64 * D, NROW, D, 64, 2};
        sg_gemm(lds, ga, [=](int z, int row, int col, float v) { AV[((size_t)z * NROW + row) * D + col] = sigmoidf_(v + a0[z * D + col]); });
        SgArgs gg{(const bf16_t*)(ws + OFF_LG), 128, 0, p.rw_g2 + (size_t)j * 128 * D, D, 0, NROW, D, 128, 1};
        sg_gemm(lds, gg, [=](int, int row, int col, float v) { G[(size_t)row * D + col] = v; });
        if (!first) {
            SgArgs gv{(const bf16_t*)(ws + OFF_LV), 32, 0, p.rw_v2, D, 0, NROW, D, 32, 1};
            sg_gemm(lds, gv, [=](int, int row, int col, float v) { const size_t o = (size_t)row * D + col; const float vv = RKV[(size_t)2 * NROW * D + o];
                RKV[(size_t)2 * NROW * D + o] = vv + (VF[o] - vv) * sigmoidf_(v + v0[col]); });
        }
    }
    else if constexpr (PH == PH_R_PREP) ph_rw_prep(p, j);
    else if constexpr (PH == PH_R_SCAN) ph_rw_scan(p, lds);
    else if constexpr (PH == PH_R_OUT) ph_rw_out(p, j);
    else if constexpr (PH == PH_M_NORM) ph_norm2_router(p, layer, lds);
    else if constexpr (PH == PH_M_SEL) ph_select(p, lds);
    else if constexpr (PH == PH_M_GATHER) ph_gather(p);
    else if constexpr (PH == PH_M_G1) {
        bf16_t* HID = (bf16_t*)(ws + OFF_HID);
        g8::BatchSched S{ws + OFF_XE, ws + OFF_W13T, (size_t)EPAD * D * 2, (size_t)2816 * D * 2, EPAD / 256, 11, NE, D};
        g8::gemm_phase((PG8_LAS unsigned char*)lds, D, S, g8::epi_pair([=](const g8::Unit& u, int row, int col, f32x4 a, f32x4 b) {
            uint2 w; w.x = pk2(a[0] / (1.f + __expf(-a[0])) * b[0], a[1] / (1.f + __expf(-a[1])) * b[1]); w.y = pk2(a[2] / (1.f + __expf(-a[2])) * b[2], a[3] / (1.f + __expf(-a[3])) * b[3]);
            *(uint2*)(HID + ((size_t)u.g * EPAD + row) * FF + col) = w; }));
    }
    else if constexpr (PH == PH_M_G2) {
        bf16_t* YE = (bf16_t*)(ws + OFF_YE); const float* GATE = (const float*)(ws + OFF_GATE);
        g8::BatchSched S{ws + OFF_HID, ws + OFF_W2T, (size_t)EPAD * FF * 2, (size_t)D * FF * 2, EPAD / 256, 4, NE, FF};
        g8::gemm_phase((PG8_LAS unsigned char*)lds, FF, S, g8::epi_rc([=](const g8::Unit& u, int row, int col, f32x4 v) {
            const float gt = GATE[u.g * EPAD + row];
            uint2 w; w.x = pk2(v[0] * gt, v[1] * gt); w.y = pk2(v[2] * gt, v[3] * gt);
            *(uint2*)(YE + ((size_t)u.g * EPAD + row) * D + col) = w; }));
    }
    else if constexpr (PH == PH_M_COMB) ph_combine(p, layer);
    else if constexpr (PH == PH_M_CVT) ph_moe_cvt(p, layer, lds);
    else if constexpr (PH == PH_FINAL) ph_final(p);
}

#if ONE_LAUNCH
#define SYNC() xcd_barrier(bar)
#define RUN(PH) do { Params q = p; asm volatile("" : "+s"(q.ws)); run_phase<PH>(q, layer, smem); SYNC(); } while (0)
__global__ void __launch_bounds__(NTHR, 2) mega(Params p) {
    extern __shared__ __attribute__((aligned(16))) char smem[];
    if (tidx() == 0) *(uint4*)(smem + LDS_BYTES) = make_uint4(0u, 0u, 0u, 0u);
    __syncthreads();
    XcdBarrier bar = xcd_barrier_post((unsigned*)(p.ws + OFF_BAR), (volatile LAS unsigned*)(smem + LDS_BYTES));
    { const int layer = 0; RUN(PH_INIT); }
    for (int layer = 0; layer < 4; ++layer) {
        if ((layer & 1) == 0) {
            RUN(PH_A_NORM);
            RUN(PH_A_Z);
            RUN(PH_A_MID);
            RUN(PH_A_QKV);
            RUN(PH_A_POST);
            RUN(PH_A_ATTN);
            RUN(PH_A_WO);
        } else {
            RUN(PH_R_NORM);
            RUN(PH_R_XS);
            RUN(PH_R_G1);
            RUN(PH_R_G2);
            RUN(PH_R_PREP);
            RUN(PH_R_SCAN);
            RUN(PH_R_OUT);
            RUN(PH_R_WO);
        }
        RUN(PH_M_CVT);
        RUN(PH_M_NORM);
        RUN(PH_M_SEL);
        RUN(PH_M_GATHER);
        RUN(PH_M_G1);
        RUN(PH_M_G2);
        RUN(PH_M_COMB);
    }
    run_phase<PH_FINAL>(p, 0, smem);
}
#else
template <int PH> __global__ void __launch_bounds__(NTHR, 2) kph(Params p, int layer) {
    extern __shared__ __attribute__((aligned(16))) char smem[];
    run_phase<PH>(p, layer, smem);
}
#endif

extern "C" void kernel_launch(void* const* d_in, const int* in_sizes, int n_in, void* d_out, int out_size, void* d_ws, size_t ws_size, hipStream_t stream) {
    if (n_in != 38 || ws_size < WS_NEED) { fprintf(stderr, "kernel_launch: bad args n_in %d ws %zu need %zu\n", n_in, ws_size, (size_t)WS_NEED); return; }
    Params p{};
    const float** pp = (const float**)&p;
    for (int i = 0; i < 38; ++i) pp[i] = (const float*)d_in[i];
    p.out = (float*)d_out; p.ws = (char*)d_ws;
    static int cus = 0;
    if (!cus) { int dev = 0; hipGetDevice(&dev); hipDeviceGetAttribute(&cus, hipDeviceAttributeMultiprocessorCount, dev); if (cus <= 0) cus = 256; }
    const int grid = cus;
#if ONE_LAUNCH
    hipFuncSetAttribute((const void*)mega, hipFuncAttributeMaxDynamicSharedMemorySize, LDS_BYTES + 16);
    hipMemsetAsync(d_ws, 0, XCD_BAR_WORDS * sizeof(unsigned), stream);
    hipLaunchKernelGGL(mega, dim3(grid), dim3(NTHR), LDS_BYTES + 16, stream, p);
#else
#define LAUNCH(PH, L) do { hipFuncSetAttribute((const void*)kph<PH>, hipFuncAttributeMaxDynamicSharedMemorySize, LDS_BYTES + 16); hipLaunchKernelGGL(kph<PH>, dim3(grid), dim3(NTHR), LDS_BYTES + 16, stream, p, L); } while (0)
    LAUNCH(PH_INIT, 0);
    for (int layer = 0; layer < 4; ++layer) {
        if ((layer & 1) == 0) { LAUNCH(PH_A_NORM, layer); LAUNCH(PH_A_Z, layer); LAUNCH(PH_A_MID, layer); LAUNCH(PH_A_QKV, layer); LAUNCH(PH_A_POST, layer); LAUNCH(PH_A_ATTN, layer); LAUNCH(PH_A_WO, layer); }
        else { LAUNCH(PH_R_NORM, layer); LAUNCH(PH_R_XS, layer); LAUNCH(PH_R_G1, layer); LAUNCH(PH_R_G2, layer); LAUNCH(PH_R_PREP, layer); LAUNCH(PH_R_SCAN, layer); LAUNCH(PH_R_OUT, layer); LAUNCH(PH_R_WO, layer); }
        LAUNCH(PH_M_CVT, layer); LAUNCH(PH_M_NORM, layer); LAUNCH(PH_M_SEL, layer); LAUNCH(PH_M_GATHER, layer); LAUNCH(PH_M_G1, layer); LAUNCH(PH_M_G2, layer); LAUNCH(PH_M_COMB, layer);
    }
    LAUNCH(PH_FINAL, 0);
#endif
}
```

```cpp
#include <hip/hip_runtime.h>
#include <stdint.h>
#include <stdio.h>

#ifndef ONE_LAUNCH
#define ONE_LAUNCH 1
#endif

#define NTHR 512
typedef unsigned short bf16_t;
typedef short bf16x8 __attribute__((ext_vector_type(8)));
typedef float f32x4 __attribute__((ext_vector_type(4)));
typedef unsigned u32x4 __attribute__((ext_vector_type(4)));

constexpr int D = 1024, NB = 4, TL = 4096, TC = 256, NLAT = NB * TL, NCTX = NB * TC, NROW = NLAT + NCTX;
constexpr int TK = TL + TC;
constexpr int NE = 16, FF = 1408, CAPL = 512, CAPC = 32, ESLOTS = NB * CAPL + NB * CAPC;
constexpr int EPAD = 2304;
constexpr float RMS_EPS = 1e-6f, LNX_EPS = 64e-5f;
constexpr float ATT_SCALE = 0.07216878364870322f;

constexpr size_t al256(size_t x) { return (x + 255) / 256 * 256; }
constexpr size_t OFF_BAR = 0;
constexpr size_t OFF_MOD = 16384;
constexpr size_t OFF_ROPE_C = OFF_MOD + al256(4 * 5 * 6144 * 4);
constexpr size_t OFF_ROPE_S = OFF_ROPE_C + al256(TL * 32 * 4);
constexpr size_t OFF_X = OFF_ROPE_S + al256(TL * 32 * 4);
constexpr size_t SZ_F32 = (size_t)NROW * D * 4, SZ_BF = (size_t)NROW * D * 2;
constexpr size_t OFF_VFIRST = OFF_X + SZ_F32;
constexpr size_t OFF_H = OFF_VFIRST + SZ_F32;
constexpr size_t SZ_WMLA = (size_t)(512 * 1024 + 1536 * 256 + 2048 * 256 + 1024 * 1024) * 2;
constexpr size_t WM_IN = 0, WM_UQ = (size_t)512 * 1024 * 2, WM_UKV = WM_UQ + (size_t)1536 * 256 * 2, WM_O = WM_UKV + (size_t)2048 * 256 * 2;
constexpr size_t SZ_WRW = (size_t)(3 * 1024 * 1024 + 4 * 256 * 1024 + 1024 * 1024) * 2;
constexpr size_t WR_RKV = 0, WR_L = (size_t)3 * 1024 * 1024 * 2, WR_O = WR_L + (size_t)4 * 256 * 1024 * 2;
constexpr size_t OFF_WMLA = OFF_H + SZ_BF;
constexpr size_t OFF_WRW = OFF_WMLA + 2 * SZ_WMLA;
constexpr size_t OFF_W13T = OFF_WRW + 2 * SZ_WRW;
constexpr size_t OFF_W2T = OFF_W13T + (size_t)NE * 2816 * D * 2;
constexpr size_t OFF_S = OFF_W2T + (size_t)NE * D * FF * 2;
constexpr size_t OFF_Z = OFF_S;
constexpr size_t OFF_CQN = OFF_Z + al256((size_t)NROW * 512 * 4);
constexpr size_t OFF_CKVN = OFF_CQN + al256((size_t)NROW * 256 * 2);
constexpr size_t OFF_KR = OFF_CKVN + al256((size_t)NROW * 256 * 2);
constexpr size_t OFF_QRAW = OFF_KR + al256((size_t)NROW * 64 * 4);
constexpr size_t OFF_KVRAW = OFF_QRAW + al256((size_t)NROW * 1536 * 4);
constexpr size_t OFF_Q = OFF_KVRAW + al256((size_t)NROW * 2048 * 4);
constexpr size_t OFF_K = OFF_Q + al256((size_t)NB * 8 * TK * 192 * 2);
constexpr size_t OFF_V = OFF_K + al256((size_t)NB * 8 * TK * 192 * 2);
constexpr size_t OFF_O = OFF_V + al256((size_t)NB * 8 * TK * 128 * 2);
constexpr size_t END_MLA = OFF_O + SZ_BF;
constexpr size_t OFF_HF = OFF_S;
constexpr size_t OFF_XS = OFF_HF + SZ_F32;
constexpr size_t OFF_RKV = OFF_XS + 6 * SZ_BF;
constexpr size_t OFF_W = OFF_RKV + 3 * SZ_F32;
constexpr size_t OFF_AV = OFF_W + 2 * SZ_F32;
constexpr size_t OFF_KD = OFF_AV + 2 * SZ_F32;
constexpr size_t OFF_G = OFF_KD + 2 * SZ_F32;
constexpr size_t OFF_LW = OFF_G + SZ_F32;
constexpr size_t OFF_LA = OFF_LW + al256((size_t)NROW * 128 * 2);
constexpr size_t OFF_LG = OFF_LA + al256((size_t)NROW * 128 * 2);
constexpr size_t OFF_LV = OFF_LG + al256((size_t)NROW * 128 * 2);
constexpr size_t END_RW = OFF_LV + al256((size_t)NROW * 32 * 2);
constexpr size_t OFF_Y = OFF_HF;
constexpr size_t OFF_AFF = OFF_S;
constexpr size_t OFF_ROWIDX = OFF_AFF + al256((size_t)NROW * 16 * 4);
constexpr size_t OFF_GATE = OFF_ROWIDX + al256((size_t)NE * ESLOTS * 4);
constexpr size_t OFF_SLOT = OFF_GATE + al256((size_t)NE * EPAD * 4);
constexpr size_t OFF_XE = OFF_SLOT + al256((size_t)NROW * 16 * 4);
constexpr size_t OFF_HID = OFF_XE + al256((size_t)NE * EPAD * D * 2);
constexpr size_t OFF_YE = OFF_HID + al256((size_t)NE * EPAD * FF * 2);
constexpr size_t END_MOE = OFF_YE + al256((size_t)NE * EPAD * D * 2);
constexpr size_t WS_NEED = END_RW > END_MLA ? (END_RW > END_MOE ? END_RW : END_MOE) : (END_MLA > END_MOE ? END_MLA : END_MOE);

constexpr int LDS_BYTES = 131072;

struct Params {
    const float *x, *c, *ctx, *c_ctx, *mod_w, *mod_b, *norm1_g, *norm2_g, *final_g;
    const float *mla_w_in, *mla_g_q, *mla_g_kv, *mla_w_uq, *mla_w_ukv, *mla_w_o;
    const float *rw_mu, *rw_w_rkv, *rw_w0, *rw_w1, *rw_w2, *rw_a0, *rw_a1, *rw_a2, *rw_v0, *rw_v1, *rw_v2, *rw_g1, *rw_g2, *rw_k_k, *rw_k_a, *rw_r_k, *rw_lnx_g, *rw_lnx_b, *rw_w_o;
    const float *moe_router, *moe_w1, *moe_w3, *moe_w2;
    float* out; char* ws;
};

__device__ __forceinline__ int tidx() { int t = threadIdx.x; asm volatile("" : "+v"(t)); return t; }
#define XB_TMO      128
#define XB_XCNT(j)  (256  + 64 * (j))
#define XB_XSUB(j)  (1280 + 64 * (j))
#define XB_XGEN(j)  (2304 + 64 * (j))
#define XB_TOP      3328
#define XB_TOPGEN   3392
#define XCD_BAR_WORDS 3456
#define XB_SPIN_CAP (1u << 22)
#define LAS __attribute__((address_space(3)))

__device__ __forceinline__ unsigned xb_ld(unsigned* p)              { return __hip_atomic_load(p, __ATOMIC_RELAXED, __HIP_MEMORY_SCOPE_AGENT); }
__device__ __forceinline__ unsigned xb_add(unsigned* p, unsigned v) { return __hip_atomic_fetch_add(p, v, __ATOMIC_RELAXED, __HIP_MEMORY_SCOPE_AGENT); }
__device__ __forceinline__ unsigned xb_xcc_id() { return (unsigned)__builtin_amdgcn_s_getreg((3 << 11) | 20) & 0xFu; }
#define XB_SPIN(cond, bar) do { unsigned _sp = 0; while (cond) { __builtin_amdgcn_s_sleep(1); \
    if ((++_sp & 255u) == 0u) { if (xb_ld(&(bar)[XB_TMO])) break; if (_sp > XB_SPIN_CAP) { atomicAdd(&(bar)[XB_TMO], 1u); break; } } } } while (0)

struct XcdBarrier { unsigned* bar; unsigned x; volatile LAS unsigned* st; };

__device__ __forceinline__ XcdBarrier xcd_barrier_post(unsigned* bar, volatile LAS unsigned* st) {
    XcdBarrier b; b.bar = bar; b.x = xb_xcc_id(); b.st = st;
    if (tidx() == 0) (void)xb_add(&bar[XB_XCNT(b.x)], 1u);
    return b;
}
__device__ __forceinline__ void xcd_barrier_complete(unsigned* bar, unsigned x, unsigned& nloc, unsigned& nx) {
    const unsigned G = gridDim.x * gridDim.y * gridDim.z;
    unsigned sum, cnt, mine, sp = 0u;
    for (;;) {
        sum = 0u; cnt = 0u; mine = 0u;
#pragma unroll
        for (unsigned j = 0; j < 16; ++j) { const unsigned c = xb_ld(&bar[XB_XCNT(j)]); sum += c; cnt += (c > 0u) ? 1u : 0u; mine = (j == x) ? c : mine; }
        if (sum == G) break;
        __builtin_amdgcn_s_sleep(1);
        if ((++sp & 255u) == 0u) { if (xb_ld(&bar[XB_TMO])) break; if (sp > XB_SPIN_CAP) { atomicAdd(&bar[XB_TMO], 1u); break; } }
    }
    nloc = mine > 0u ? mine : 1u; nx = cnt > 0u ? cnt : 1u;
}
__device__ __forceinline__ void xcd_barrier(const XcdBarrier& b) {
    asm volatile("s_waitcnt vmcnt(0)" ::: "memory");
    __syncthreads();
    if (tidx() == 0) {
        unsigned* bar = b.bar;
        __builtin_amdgcn_s_waitcnt(0);
        unsigned nloc = b.st[0], nx = b.st[1];
        if (nloc == 0u) { xcd_barrier_complete(bar, b.x, nloc, nx); b.st[0] = nloc; b.st[1] = nx; }
        const unsigned old = xb_add(&bar[XB_XSUB(b.x)], 1u);
        const unsigned gen = old / nloc;
        if (old + 1u == (gen + 1u) * nloc) {
            __builtin_amdgcn_fence(__ATOMIC_RELEASE, "agent");
            asm volatile("s_waitcnt vmcnt(0)" ::: "memory");
            const unsigned og = xb_add(&bar[XB_TOP], 1u);
            const unsigned tg = og / nx;
            if (og + 1u == (tg + 1u) * nx) xb_add(&bar[XB_TOPGEN], 1u);
            else XB_SPIN(xb_ld(&bar[XB_TOPGEN]) == tg, bar);
            __builtin_amdgcn_fence(__ATOMIC_ACQUIRE, "agent");
            xb_add(&bar[XB_XGEN(b.x)], 1u);
            asm volatile("s_waitcnt vmcnt(0)" ::: "memory");
        } else {
            XB_SPIN(xb_ld(&bar[XB_XGEN(b.x)]) == gen, bar);
            __builtin_amdgcn_fence(__ATOMIC_ACQUIRE, "agent");
            asm volatile("s_waitcnt vmcnt(0)" ::: "memory");
        }
    }
    __syncthreads();
}

__device__ __forceinline__ bf16_t f2bf(float f) { unsigned u = __float_as_uint(f); u += 0x7FFFu + ((u >> 16) & 1u); return (bf16_t)(u >> 16); }
__device__ __forceinline__ float bf2f(bf16_t b) { return __uint_as_float(((unsigned)b) << 16); }
__device__ __forceinline__ unsigned pk2(float lo, float hi) { return (unsigned)f2bf(lo) | ((unsigned)f2bf(hi) << 16); }
__device__ __forceinline__ float wave_sum(float v) { for (int o = 32; o >= 1; o >>= 1) v += __shfl_xor(v, o); return v; }
__device__ __forceinline__ float sigmoidf_(float x) { return 1.f / (1.f + expf(-x)); }
__device__ __forceinline__ int row_stream(int row) { return row < NLAT ? (row >> 12) : 4; }
__device__ __forceinline__ const float* modp(const Params& p, int layer, int s, int part) { return (const float*)(p.ws + OFF_MOD) + ((size_t)layer * 5 + s) * 6144 + part * 1024; }

struct SgArgs { const bf16_t* A; int lda; size_t strideA; const float* B; int ldb; size_t strideB; int M, N, K, nbatch; };
template <class Epi>
__device__ __forceinline__ void sg_gemm(char* lds, const SgArgs g, const Epi& epi) {
    bf16_t* As = (bf16_t*)lds;
    bf16_t* Bs = As + 128 * 40;
    const int tid = tidx(), wid = tid >> 6, lane = tid & 63;
    const int wr = wid >> 2, wc = wid & 3;
    const int tilesN = (g.N + 127) / 128, tilesM = g.M / 128, per = tilesM * tilesN, ntiles = per * g.nbatch;
    const int ar = tid >> 2, ak = (tid & 3) * 8;
    const int bn = tid & 127, bk = (tid >> 7) * 8;
    for (int tile = blockIdx.x; tile < ntiles; tile += gridDim.x) {
        const int bt = tile / per, tt = tile % per;
        const int tm = tt / tilesN, tn = tt % tilesN;
        const int m0 = tm * 128, n0 = tn * 128;
        f32x4 acc[4][2];
#pragma unroll
        for (int m = 0; m < 4; ++m)
#pragma unroll
            for (int n = 0; n < 2; ++n) acc[m][n] = (f32x4){0.f, 0.f, 0.f, 0.f};
        const bool bvalid = (n0 + bn) < g.N;
        const bf16_t* ap = g.A + bt * g.strideA + (size_t)(m0 + ar) * g.lda + ak;
        const float* bp = g.B + bt * g.strideB + (size_t)bk * g.ldb + n0 + bn;
        bf16x8 areg; float breg[8];
        areg = *(const bf16x8*)ap;
#pragma unroll
        for (int j = 0; j < 8; ++j) breg[j] = bvalid ? bp[(size_t)j * g.ldb] : 0.f;
        for (int k0 = 0; k0 < g.K; k0 += 32) {
            __syncthreads();
            *(bf16x8*)(As + ar * 40 + ak) = areg;
            { u32x4 w; w.x = pk2(breg[0], breg[1]); w.y = pk2(breg[2], breg[3]); w.z = pk2(breg[4], breg[5]); w.w = pk2(breg[6], breg[7]); *(u32x4*)(Bs + bn * 40 + bk) = w; }
            __syncthreads();
            if (k0 + 32 < g.K) {
                areg = *(const bf16x8*)(ap + k0 + 32);
#pragma unroll
                for (int j = 0; j < 8; ++j) breg[j] = bvalid ? bp[(size_t)(k0 + 32 + j) * g.ldb] : 0.f;
            }
            bf16x8 af[4], bfr[2];
#pragma unroll
            for (int m = 0; m < 4; ++m) af[m] = *(const bf16x8*)(As + (wr * 64 + m * 16 + (lane & 15)) * 40 + (lane >> 4) * 8);
#pragma unroll
            for (int n = 0; n < 2; ++n) bfr[n] = *(const bf16x8*)(Bs + (wc * 32 + n * 16 + (lane & 15)) * 40 + (lane >> 4) * 8);
#pragma unroll
            for (int m = 0; m < 4; ++m)
#pragma unroll
                for (int n = 0; n < 2; ++n) acc[m][n] = __builtin_amdgcn_mfma_f32_16x16x32_bf16(af[m], bfr[n], acc[m][n], 0, 0, 0);
        }
#pragma unroll
        for (int m = 0; m < 4; ++m)
#pragma unroll
            for (int n = 0; n < 2; ++n) {
                const int col = n0 + wc * 32 + n * 16 + (lane & 15);
                if (col < g.N) {
#pragma unroll
                    for (int r = 0; r < 4; ++r) epi(bt, m0 + wr * 64 + m * 16 + (lane >> 4) * 4 + r, col, acc[m][n][r]);
                }
            }
    }
}


namespace g8 {
#define PG8_LAS __attribute__((address_space(3)))
constexpr int BM = 256, BK = 64, HALF = 128, HTB = HALF * BK * 2, STAGE_BYTES = 8 * HTB;
__device__ __forceinline__ int lds_byte(int r, int c) { const int st = (r >> 4) * 2 + (c >> 5), rr = r & 15, cc = c & 31, ob = rr * 64 + cc * 2; return st * 1024 + (ob ^ (((ob >> 9) & 1) << 5)); }
__device__ __forceinline__ void stage_rc(int b, int& R, int& C) { const int st = b / 1024, sb = b % 1024, swz = sb ^ (((sb >> 9) & 1) << 5); R = (st >> 1) * 16 + swz / 64; C = (st & 1) * 32 + (swz % 64) / 2; }
struct Unit { int pm, pn, g; const char* A; const char* B; };
__device__ __forceinline__ int xcd_remap(int L, int nwg) { const int q = nwg / 8, r = nwg % 8, xcd = L % 8, off = L / 8; return (xcd < r ? xcd * (q + 1) : r * (q + 1) + (xcd - r) * q) + off; }

template <class Epi, class Sched>
__device__ __forceinline__ void gemm_phase(PG8_LAS unsigned char* lds, const int K, const Sched& S, const Epi& E) {
    const int tid = tidx(), wid = __builtin_amdgcn_readfirstlane(tid >> 6), lane = tid & 63, wr = wid >> 2, wc = wid & 3, fr = lane & 15, fq = lane >> 4;
    const int nt = K / BK;
    unsigned voffA[2];
#pragma unroll
    for (int i = 0; i < 2; ++i) { int R, C; stage_rc(tid * 16 + i * 8192, R, C); voffA[i] = (unsigned)(R * K + C) * 2u; }
    const size_t kstep = (size_t)(BK * 2);
    const size_t hstep = (size_t)HALF * K * 2;
    const unsigned ldsw = (unsigned)wid * 1024u;
    const int aoff = lds_byte(wr * 64 + fr, fq * 8), boff = lds_byte(wc * 32 + fr, fq * 8);
#define PG8_SA(b, h) (((b) * 2 + (h)) * HTB)
#define PG8_SB(b, h) ((4 + (b) * 2 + (h)) * HTB)
#define PG8_STAGE(bufoff, gbase, voff) do { _Pragma("unroll") for (int _i = 0; _i < 2; ++_i) \
        __builtin_amdgcn_global_load_lds((const unsigned*)((const char*)(gbase) + (voff)[_i]), (PG8_LAS unsigned*)(lds + (bufoff) + ldsw + _i * 8192), 16, 0, 0); } while (0)
#define PG8_LDA(dst, b, h) do { _Pragma("unroll") for (int m = 0; m < 4; ++m) _Pragma("unroll") for (int k = 0; k < 2; ++k) dst[m][k] = *(const PG8_LAS bf16x8*)(lds + PG8_SA(b, h) + aoff + m * 2048 + k * 1024); } while (0)
#define PG8_LDB(dst, b, h) do { _Pragma("unroll") for (int n = 0; n < 2; ++n) _Pragma("unroll") for (int k = 0; k < 2; ++k) dst[n][k] = *(const PG8_LAS bf16x8*)(lds + PG8_SB(b, h) + boff + n * 2048 + k * 1024); } while (0)
#define PG8_MMA(ai, bj, At, Bt) do { __builtin_amdgcn_s_setprio(1); _Pragma("unroll") for (int m = 0; m < 4; ++m) _Pragma("unroll") for (int n = 0; n < 2; ++n) _Pragma("unroll") for (int k = 0; k < 2; ++k) \
        acc[ai][bj][m][n] = __builtin_amdgcn_mfma_f32_16x16x32_bf16(Bt[n][k], At[m][k], acc[ai][bj][m][n], 0, 0, 0); __builtin_amdgcn_s_setprio(0); } while (0)
#define PG8_WAIT_V(n) asm volatile("s_waitcnt vmcnt(" #n ")" ::: "memory")
#define PG8_WAIT_L(n) asm volatile("s_waitcnt lgkmcnt(" #n ")" ::: "memory")
#define PG8_BAR __builtin_amdgcn_s_barrier()
#define PG8_SCHED __builtin_amdgcn_sched_barrier(0)
    Unit cur, nxt; int ui = 0;
    if (!S.next(0, cur)) return;
    f32x4 acc[2][2][4][2];
#pragma unroll
    for (int a = 0; a < 2; ++a)
#pragma unroll
        for (int b = 0; b < 2; ++b)
#pragma unroll
            for (int m = 0; m < 4; ++m)
#pragma unroll
                for (int n = 0; n < 2; ++n) acc[a][b][m][n] = (f32x4){0.f, 0.f, 0.f, 0.f};
    bf16x8 At[4][2], B0[2][2], B1[2][2];
    const char* cA = cur.A; const char* cB = cur.B;
    PG8_STAGE(PG8_SB(0, 0), cB, voffA); PG8_STAGE(PG8_SA(0, 0), cA, voffA); PG8_STAGE(PG8_SB(0, 1), cB + hstep, voffA); PG8_STAGE(PG8_SA(0, 1), cA + hstep, voffA);
    if (wr == 1) PG8_BAR;
    PG8_WAIT_V(4); PG8_BAR;
    PG8_STAGE(PG8_SB(1, 0), cB + kstep, voffA); PG8_STAGE(PG8_SA(1, 0), cA + kstep, voffA); PG8_STAGE(PG8_SB(1, 1), cB + hstep + kstep, voffA);
    PG8_WAIT_V(6); PG8_BAR;
    for (;;) {
        const bool has_next = S.next(ui + 1, nxt);
        const char* nA = has_next ? nxt.A : cA; const char* nB = has_next ? nxt.B : cB;
        for (int t = 0; t < nt; t += 2) {
            const bool last = (t == nt - 2);
            const char* a1 = cA + (size_t)(t + 1) * kstep;
            const char* a2 = last ? nA : cA + (size_t)(t + 2) * kstep; const char* b2 = last ? nB : cB + (size_t)(t + 2) * kstep;
            const char* a3 = a2 + kstep; const char* b3 = b2 + kstep;
            PG8_LDB(B0, 0, 0); PG8_SCHED; PG8_LDA(At, 0, 0); PG8_STAGE(PG8_SA(1, 1), a1 + hstep, voffA);
            PG8_WAIT_L(8); PG8_BAR; PG8_WAIT_L(0); PG8_MMA(0, 0, At, B0); PG8_BAR; PG8_SCHED;
            PG8_LDB(B1, 0, 1); PG8_STAGE(PG8_SB(0, 0), b2, voffA);
            PG8_BAR; PG8_WAIT_L(0); PG8_MMA(0, 1, At, B1); PG8_BAR;
            PG8_LDA(At, 0, 1); PG8_STAGE(PG8_SA(0, 0), a2, voffA);
            PG8_BAR; PG8_WAIT_L(0); PG8_MMA(1, 0, At, B0); PG8_BAR; PG8_SCHED;
            PG8_STAGE(PG8_SB(0, 1), b2 + hstep, voffA);
            PG8_WAIT_V(6); PG8_BAR; PG8_MMA(1, 1, At, B1); PG8_BAR;
            PG8_LDB(B0, 1, 0); PG8_SCHED; PG8_LDA(At, 1, 0); PG8_STAGE(PG8_SA(0, 1), a2 + hstep, voffA);
            PG8_WAIT_L(8); PG8_BAR; PG8_WAIT_L(0); PG8_MMA(0, 0, At, B0); PG8_BAR; PG8_SCHED;
            PG8_LDB(B1, 1, 1); PG8_STAGE(PG8_SB(1, 0), b3, voffA);
            PG8_BAR; PG8_WAIT_L(0); PG8_MMA(0, 1, At, B1); PG8_BAR;
            PG8_LDA(At, 1, 1); PG8_STAGE(PG8_SA(1, 0), a3, voffA);
            PG8_BAR; PG8_WAIT_L(0); PG8_MMA(1, 0, At, B0); PG8_BAR; PG8_SCHED;
            PG8_STAGE(PG8_SB(1, 1), b3 + hstep, voffA);
            PG8_WAIT_V(6); PG8_BAR; PG8_MMA(1, 1, At, B1); PG8_BAR;
        }
        E(acc, cur, wr, wc, fr, fq);
        if (!has_next) break;
#pragma unroll
        for (int a = 0; a < 2; ++a)
#pragma unroll
            for (int b = 0; b < 2; ++b)
#pragma unroll
                for (int m = 0; m < 4; ++m)
#pragma unroll
                    for (int n = 0; n < 2; ++n) acc[a][b][m][n] = (f32x4){0.f, 0.f, 0.f, 0.f};
        cur = nxt; cA = nA; cB = nB; ++ui;
    }
    PG8_WAIT_V(0);
    if (wr == 0) PG8_BAR;
    PG8_BAR;
#undef PG8_SA
#undef PG8_SB
#undef PG8_STAGE
#undef PG8_LDA
#undef PG8_LDB
#undef PG8_MMA
#undef PG8_WAIT_V
#undef PG8_WAIT_L
#undef PG8_BAR
#undef PG8_SCHED
}
template <class F> struct EpiRC { F f;
    __device__ __forceinline__ void operator()(const f32x4 (&acc)[2][2][4][2], const Unit& u, int wr, int wc, int fr, int fq) const {
#pragma unroll
        for (int ai = 0; ai < 2; ++ai)
#pragma unroll
            for (int m = 0; m < 4; ++m) { const int row = u.pm * BM + ai * HALF + wr * 64 + m * 16 + fr;
#pragma unroll
                for (int bj = 0; bj < 2; ++bj)
#pragma unroll
                    for (int n = 0; n < 2; ++n) f(u, row, u.pn * BM + bj * HALF + wc * 32 + n * 16 + 4 * fq, acc[ai][bj][m][n]); }
    } };
template <class F> __device__ __forceinline__ EpiRC<F> epi_rc(const F& f) { return EpiRC<F>{f}; }
template <class F> struct EpiPair { F f;
    __device__ __forceinline__ void operator()(const f32x4 (&acc)[2][2][4][2], const Unit& u, int wr, int wc, int fr, int fq) const {
#pragma unroll
        for (int ai = 0; ai < 2; ++ai)
#pragma unroll
            for (int m = 0; m < 4; ++m) { const int row = u.pm * BM + ai * HALF + wr * 64 + m * 16 + fr;
#pragma unroll
                for (int n = 0; n < 2; ++n) f(u, row, u.pn * HALF + wc * 32 + n * 16 + 4 * fq, acc[ai][0][m][n], acc[ai][1][m][n]); }
    } };
template <class F> __device__ __forceinline__ EpiPair<F> epi_pair(const F& f) { return EpiPair<F>{f}; }
struct BatchSched { const char* A; const char* B; size_t strideA, strideB; int nM, nN, nb, K;
    __device__ __forceinline__ bool next(int i, Unit& u) const {
        const int nwg = nM * nN * nb; const int L = i * (int)gridDim.x + (int)blockIdx.x; if (L >= nwg) return false;
        const int w = xcd_remap(L, nwg); const int per = nM * nN; u.g = w / per; const int r = w % per; u.pm = r / nN; u.pn = r % nN;
        u.A = A + u.g * strideA + (size_t)u.pm * BM * K * 2; u.B = B + u.g * strideB + (size_t)u.pn * BM * K * 2; return true; } };
}

template <class SrcF, class DRow>
__device__ __forceinline__ void cvt_tiles(char* lds, bf16_t* dst, int Kd, int Nd, int nbatch, size_t dstride, const SrcF& src, const DRow& drow) {
    bf16_t* T = (bf16_t*)lds;
    const int tid = tidx();
    const int tk = Kd / 128, tn = Nd / 64, per = tk * tn, total = per * nbatch;
    for (int t = blockIdx.x; t < total; t += gridDim.x) {
        const int bt = t / per, r = t % per, k0 = (r % tk) * 128, n0 = (r / tk) * 64;
        float4 v[4];
#pragma unroll
        for (int i = 0; i < 4; ++i) { const int k = k0 + i * 32 + (tid >> 4), n = n0 + (tid & 15) * 4; const float* sp = src(bt, k, n); v[i] = sp ? *(const float4*)sp : make_float4(0.f, 0.f, 0.f, 0.f); }
        __syncthreads();
#pragma unroll
        for (int i = 0; i < 4; ++i) { const int k = i * 32 + (tid >> 4), n = (tid & 15) * 4;
            T[(n + 0) * 136 + k] = f2bf(v[i].x); T[(n + 1) * 136 + k] = f2bf(v[i].y); T[(n + 2) * 136 + k] = f2bf(v[i].z); T[(n + 3) * 136 + k] = f2bf(v[i].w); }
        __syncthreads();
        { const int n = tid >> 3, kc = (tid & 7) * 16;
          const u32x4 a = *(const u32x4*)(T + n * 136 + kc), b = *(const u32x4*)(T + n * 136 + kc + 8);
          bf16_t* dp = dst + bt * dstride + (size_t)drow(n0 + n) * Kd + k0 + kc;
          *(u32x4*)dp = a; *(u32x4*)(dp + 8) = b; }
    }
}
__device__ void ph_moe_cvt(const Params& p, int layer, char* lds) {
    const float* w1 = p.moe_w1 + (size_t)layer * NE * D * FF; const float* w3 = p.moe_w3 + (size_t)layer * NE * D * FF; const float* w2 = p.moe_w2 + (size_t)layer * NE * FF * D;
    cvt_tiles(lds, (bf16_t*)(p.ws + OFF_W13T), D, 2816, NE, (size_t)2816 * D,
        [=](int e, int k, int n) -> const float* { const int pn = n >> 8, half = (n >> 7) & 1, c = pn * 128 + (n & 127); return (half ? w3 : w1) + ((size_t)e * D + k) * FF + c; },
        [=](int n) { return n; });
    cvt_tiles(lds, (bf16_t*)(p.ws + OFF_W2T), FF, D, NE, (size_t)D * FF,
        [=](int e, int k, int n) -> const float* { return w2 + ((size_t)e * FF + k) * D + n; },
        [=](int n) { return n; });
}

__device__ void ph_init(const Params& p, char* lds) {
    const int tid = tidx(), gtid = blockIdx.x * NTHR + tid, gsz = gridDim.x * NTHR;
    float4* X4 = (float4*)(p.ws + OFF_X);
    const float4* x4 = (const float4*)p.x; const float4* c4 = (const float4*)p.ctx;
    for (int i = gtid; i < NROW * 256; i += gsz) X4[i] = i < NLAT * 256 ? x4[i] : c4[i - NLAT * 256];
    float* rc = (float*)(p.ws + OFF_ROPE_C); float* rs = (float*)(p.ws + OFF_ROPE_S);
    for (int i = gtid; i < TL * 32; i += gsz) {
        const int t = i >> 5, f = i & 31; const float pos = (float)((f < 16) ? (t >> 6) : (t & 63));
        const float inv = powf(10000.f, -(float)(f & 15) / 16.f); const float ang = pos * inv; rc[i] = cosf(ang); rs[i] = sinf(ang);
    }
    float* sc = (float*)lds;
    float* red = sc + 5 * 1024;
    for (int i = tid; i < 5 * 1024; i += NTHR) { const float v = i < 4096 ? p.c[i] : p.c_ctx[i - 4096]; sc[i] = v / (1.f + expf(-v)); }
    __syncthreads();
    float* MOD = (float*)(p.ws + OFF_MOD);
    for (int item = blockIdx.x; item < 4 * 96; item += gridDim.x) {
        const int l = item / 96, cg = item % 96, col = tid & 63, n = cg * 64 + col, kg = tid >> 6;
        const float* w = p.mod_w + ((size_t)l * 1024 + kg * 128) * 6144 + n;
        float a0 = 0, a1 = 0, a2 = 0, a3 = 0, a4 = 0;
        for (int k = 0; k < 128; ++k) { const float wv = w[(size_t)k * 6144]; const int kk = kg * 128 + k;
            a0 += sc[kk] * wv; a1 += sc[1024 + kk] * wv; a2 += sc[2048 + kk] * wv; a3 += sc[3072 + kk] * wv; a4 += sc[4096 + kk] * wv; }
        float* rr = red + (kg * 64 + col) * 5; rr[0] = a0; rr[1] = a1; rr[2] = a2; rr[3] = a3; rr[4] = a4;
        __syncthreads();
        if (tid < 320) { const int c2 = tid & 63, s = tid >> 6; float sum = 0;
            for (int q = 0; q < 8; ++q) sum += red[(q * 64 + c2) * 5 + s];
            MOD[((size_t)l * 5 + s) * 6144 + cg * 64 + c2] = sum + p.mod_b[l * 6144 + cg * 64 + c2]; }
        __syncthreads();
    }
}


__device__ void ph_small_cvt(const Params& p, char* lds) {
    for (int j = 0; j < 2; ++j) {
        char* wm = p.ws + OFF_WMLA + j * SZ_WMLA; char* wr = p.ws + OFF_WRW + j * SZ_WRW;
        const float* w_in = p.mla_w_in + (size_t)j * D * 448; const float* w_uq = p.mla_w_uq + (size_t)j * 256 * 1536; const float* w_ukv = p.mla_w_ukv + (size_t)j * 128 * 2048; const float* w_o = p.mla_w_o + (size_t)j * D * D;
        cvt_tiles(lds, (bf16_t*)(wm + WM_IN), 1024, 512, 1, 0, [=](int, int k, int n) -> const float* { return n < 448 ? w_in + (size_t)k * 448 + n : nullptr; }, [=](int n) { return n; });
        cvt_tiles(lds, (bf16_t*)(wm + WM_UQ), 256, 1536, 1, 0, [=](int, int k, int n) -> const float* { return w_uq + (size_t)k * 1536 + n; }, [=](int n) { return n; });
        cvt_tiles(lds, (bf16_t*)(wm + WM_UKV), 256, 2048, 1, 0, [=](int, int k, int n) -> const float* { return k < 128 ? w_ukv + (size_t)k * 2048 + n : nullptr; }, [=](int n) { return n; });
        cvt_tiles(lds, (bf16_t*)(wm + WM_O), 1024, 1024, 1, 0, [=](int, int k, int n) -> const float* { return w_o + (size_t)k * D + n; }, [=](int n) { return n; });
        const float* w_rkv = p.rw_w_rkv + (size_t)j * 3 * D * D; const float* w1 = p.rw_w1 + (size_t)j * 2 * D * 64; const float* a1 = p.rw_a1 + (size_t)j * 2 * D * 64;
        const float* g1 = p.rw_g1 + (size_t)j * D * 128; const float* v1 = p.rw_v1; const float* rwo = p.rw_w_o + (size_t)j * D * D;
        cvt_tiles(lds, (bf16_t*)(wr + WR_RKV), 1024, 1024, 3, (size_t)D * D, [=](int m, int k, int n) -> const float* { return w_rkv + ((size_t)m * D + k) * D + n; }, [=](int n) { return n; });
        cvt_tiles(lds, (bf16_t*)(wr + WR_L), 1024, 256, 1, 0, [=](int, int k, int n) -> const float* { return n < 128 ? w1 + ((size_t)(n >> 6) * D + k) * 64 + (n & 63) : nullptr; }, [=](int n) { return n; });
        cvt_tiles(lds, (bf16_t*)(wr + WR_L) + 256 * 1024, 1024, 256, 1, 0, [=](int, int k, int n) -> const float* { return n < 128 ? a1 + ((size_t)(n >> 6) * D + k) * 64 + (n & 63) : nullptr; }, [=](int n) { return n; });
        cvt_tiles(lds, (bf16_t*)(wr + WR_L) + 2 * 256 * 1024, 1024, 256, 1, 0, [=](int, int k, int n) -> const float* { return n < 128 ? g1 + (size_t)k * 128 + n : nullptr; }, [=](int n) { return n; });
        cvt_tiles(lds, (bf16_t*)(wr + WR_L) + 3 * 256 * 1024, 1024, 256, 1, 0, [=](int, int k, int n) -> const float* { return n < 32 ? v1 + (size_t)k * 32 + n : nullptr; }, [=](int n) { return n; });
        cvt_tiles(lds, (bf16_t*)(wr + WR_O), 1024, 1024, 1, 0, [=](int, int k, int n) -> const float* { return rwo + (size_t)k * D + n; }, [=](int n) { return n; });
    }
}

template <bool OUTF32>
__device__ void ph_norm_mod(const Params& p, int layer, const float* g, int part_sh, int part_sc, void* outp) {
    const int wid = tidx() >> 6, lane = tidx() & 63;
    const float* X = (const float*)(p.ws + OFF_X);
    for (int row = blockIdx.x * 8 + wid; row < NROW; row += gridDim.x * 8) {
        const int s = row_stream(row);
        const float* sh = modp(p, layer, s, part_sh); const float* sc = modp(p, layer, s, part_sc);
        const float4* xr = (const float4*)(X + (size_t)row * D);
        float4 v[4]; float ss = 0;
#pragma unroll
        for (int i = 0; i < 4; ++i) { v[i] = xr[lane + i * 64]; ss += v[i].x * v[i].x + v[i].y * v[i].y + v[i].z * v[i].z + v[i].w * v[i].w; }
        ss = wave_sum(ss); const float rs = rsqrtf(ss * (1.f / D) + RMS_EPS);
#pragma unroll
        for (int i = 0; i < 4; ++i) {
            const int d = (lane + i * 64) * 4;
            const float4 gg = *(const float4*)(g + d), a = *(const float4*)(sc + d), b = *(const float4*)(sh + d);
            float4 o; o.x = v[i].x * rs * gg.x * (1.f + a.x) + b.x; o.y = v[i].y * rs * gg.y * (1.f + a.y) + b.y; o.z = v[i].z * rs * gg.z * (1.f + a.z) + b.z; o.w = v[i].w * rs * gg.w * (1.f + a.w) + b.w;
            if (OUTF32) *(float4*)((float*)outp + (size_t)row * D + d) = o;
            else { uint2 w; w.x = pk2(o.x, o.y); w.y = pk2(o.z, o.w); *(uint2*)((bf16_t*)outp + (size_t)row * D + d) = w; }
        }
    }
}

__device__ void ph_mla_mid(const Params& p, int j) {
    const int wid = tidx() >> 6, lane = tidx() & 63;
    const float* Z = (const float*)(p.ws + OFF_Z);
    bf16_t* CQN = (bf16_t*)(p.ws + OFF_CQN); bf16_t* CKVN = (bf16_t*)(p.ws + OFF_CKVN); float* KR = (float*)(p.ws + OFF_KR);
    const float* gq = p.mla_g_q + j * 256; const float* gkv = p.mla_g_kv + j * 128;
    const float* rc = (const float*)(p.ws + OFF_ROPE_C); const float* rs = (const float*)(p.ws + OFF_ROPE_S);
    for (int row = blockIdx.x * 8 + wid; row < NROW; row += gridDim.x * 8) {
        const float* z = Z + (size_t)row * 512;
        const float4 q = *(const float4*)(z + lane * 4);
        const float2 kv = *(const float2*)(z + 256 + lane * 2);
        const float kr = z[384 + lane];
        float sq = wave_sum(q.x * q.x + q.y * q.y + q.z * q.z + q.w * q.w); const float rq = rsqrtf(sq * (1.f / 256.f) + RMS_EPS);
        float sk = wave_sum(kv.x * kv.x + kv.y * kv.y); const float rk = rsqrtf(sk * (1.f / 128.f) + RMS_EPS);
        const float4 g4 = *(const float4*)(gq + lane * 4); const float2 g2 = *(const float2*)(gkv + lane * 2);
        uint2 w; w.x = pk2(q.x * rq * g4.x, q.y * rq * g4.y); w.y = pk2(q.z * rq * g4.z, q.w * rq * g4.w);
        *(uint2*)(CQN + (size_t)row * 256 + lane * 4) = w;
        *(unsigned*)(CKVN + (size_t)row * 256 + lane * 2) = pk2(kv.x * rk * g2.x, kv.y * rk * g2.y);
        *(unsigned*)(CKVN + (size_t)row * 256 + 128 + lane * 2) = 0u;
        float o = kr;
        const float other = __shfl_xor(kr, 32);
        if (row < NLAT) { const int t = row & (TL - 1), i = lane & 31; const float c = rc[t * 32 + i], s = rs[t * 32 + i];
            const float x1 = lane < 32 ? kr : other, x2 = lane < 32 ? other : kr;
            o = lane < 32 ? (x1 * c - x2 * s) : (x1 * s + x2 * c); }
        KR[(size_t)row * 64 + lane] = o;
    }
}

__device__ void ph_qkv_post(const Params& p) {
    const int wid = tidx() >> 6, lane = tidx() & 63;
    const float* QRAW = (const float*)(p.ws + OFF_QRAW); const float* KVRAW = (const float*)(p.ws + OFF_KVRAW); const float* KR = (const float*)(p.ws + OFF_KR);
    bf16_t* Q = (bf16_t*)(p.ws + OFF_Q); bf16_t* K = (bf16_t*)(p.ws + OFF_K); bf16_t* V = (bf16_t*)(p.ws + OFF_V);
    const float* rc = (const float*)(p.ws + OFF_ROPE_C); const float* rs = (const float*)(p.ws + OFF_ROPE_S);
    for (int it = blockIdx.x * 8 + wid; it < NROW * 8; it += gridDim.x * 8) {
        const int row = it >> 3, h = it & 7;
        const bool lat = row < NLAT; const int b = lat ? (row >> 12) : ((row - NLAT) >> 8); const int tk = lat ? 256 + (row & (TL - 1)) : ((row - NLAT) & 255);
        const size_t orow = (size_t)(b * 8 + h) * TK + tk;
        const float* q = QRAW + (size_t)row * 1536 + h * 192;
        const float q0 = q[lane], q1 = q[64 + lane]; float q2 = q[128 + lane];
        const float other = __shfl_xor(q2, 32);
        if (lat) { const int t = row & (TL - 1), i = lane & 31; const float c = rc[t * 32 + i], s = rs[t * 32 + i];
            const float x1 = lane < 32 ? q2 : other, x2 = lane < 32 ? other : q2; q2 = lane < 32 ? (x1 * c - x2 * s) : (x1 * s + x2 * c); }
        bf16_t* qo = Q + orow * 192; qo[lane] = f2bf(q0); qo[64 + lane] = f2bf(q1); qo[128 + lane] = f2bf(q2);
        const float* kv = KVRAW + (size_t)row * 2048 + h * 256;
        bf16_t* ko = K + orow * 192; ko[lane] = f2bf(kv[lane]); ko[64 + lane] = f2bf(kv[64 + lane]); ko[128 + lane] = f2bf(KR[(size_t)row * 64 + lane]);
        bf16_t* vo = V + orow * 128; vo[lane] = f2bf(kv[128 + lane]); vo[64 + lane] = f2bf(kv[192 + lane]);
    }
}

__device__ void ph_attn_naive(const Params& p, char* lds) {
    const int tid = tidx(), qi = tid >> 2, part = tid & 3;
    const bf16_t* Q = (const bf16_t*)(p.ws + OFF_Q); const bf16_t* K = (const bf16_t*)(p.ws + OFF_K); const bf16_t* V = (const bf16_t*)(p.ws + OFF_V);
    bf16_t* O = (bf16_t*)(p.ws + OFF_O);
    bf16_t* Ks = (bf16_t*)lds;
    bf16_t* Vs = Ks + 32 * 192;
    const int nitems = 32 * 34;
    for (int it = blockIdx.x; it < nitems; it += gridDim.x) {
        const int bh = it / 34, qb = it % 34; const int b = bh >> 3, h = bh & 7;
        const int nkeys = qb < 2 ? TC : TK;
        const int tq = qb * 128 + qi;
        const bf16_t* qp = Q + ((size_t)bh * TK + tq) * 192 + part * 48;
        float q[48];
#pragma unroll
        for (int i = 0; i < 48; ++i) q[i] = bf2f(qp[i]) * ATT_SCALE;
        float o[32];
#pragma unroll
        for (int i = 0; i < 32; ++i) o[i] = 0.f;
        float m = -1e30f, l = 0.f;
        for (int k0 = 0; k0 < nkeys; k0 += 32) {
            __syncthreads();
            {
                const bf16_t* kg = K + ((size_t)bh * TK + k0) * 192; const bf16_t* vg = V + ((size_t)bh * TK + k0) * 128;
                for (int c = tid; c < 768; c += NTHR) *(u32x4*)(Ks + c * 8) = *(const u32x4*)(kg + c * 8);
                *(u32x4*)(Vs + tid * 8) = *(const u32x4*)(vg + tid * 8);
            }
            __syncthreads();
#pragma unroll 1
            for (int kg = 0; kg < 32; kg += 8) {
                float s[8]; float tmax = -1e30f;
#pragma unroll
                for (int kk = 0; kk < 8; ++kk) {
                    const bf16_t* kr = Ks + (kg + kk) * 192 + part * 48; float acc = 0.f;
#pragma unroll
                    for (int i = 0; i < 48; ++i) acc += q[i] * bf2f(kr[i]);
                    acc += __shfl_xor(acc, 1); acc += __shfl_xor(acc, 2);
                    s[kk] = acc; tmax = fmaxf(tmax, acc);
                    asm volatile("" ::: "memory");
                }
                const float mn = fmaxf(m, tmax), alpha = expf(m - mn); m = mn; l *= alpha;
#pragma unroll
                for (int i = 0; i < 32; ++i) o[i] *= alpha;
#pragma unroll
                for (int kk = 0; kk < 8; ++kk) {
                    const float pw = expf(s[kk] - mn); l += pw;
                    const bf16_t* vr = Vs + (kg + kk) * 128 + part * 32;
#pragma unroll
                    for (int i = 0; i < 32; ++i) o[i] += pw * bf2f(vr[i]);
                    asm volatile("" ::: "memory");
                }
            }
        }
        const float rl = 1.f / l;
        const int row = qb < 2 ? (NLAT + b * TC + tq) : (b * TL + tq - TC);
        bf16_t* op = O + (size_t)row * D + h * 128 + part * 32;
#pragma unroll
        for (int i = 0; i < 32; ++i) op[i] = f2bf(o[i] * rl);
    }
}


namespace fa {
using s16x4  = __attribute__((ext_vector_type(4))) short;
using f32x16 = __attribute__((ext_vector_type(16))) float;
constexpr int DQK = 192, DV = 128, KVBLK = 64;
constexpr float THR = 8.f;
constexpr int SHM_V = KVBLK * DV * 2, SHM_K = KVBLK * DQK * 2;
constexpr int SHM_ATTN = 2 * SHM_V + 2 * SHM_K + 8 * 64 * 4;
#define KSWZ(row, colB) ((row) * 384 + ((colB) ^ (((row) & 7) << 4)))
#define SBAR() __builtin_amdgcn_sched_barrier(0)
__device__ __forceinline__ int crow(int r, int hi) { return (r & 3) + 8 * (r >> 2) + 4 * hi; }
__device__ __forceinline__ unsigned cvtpk(float lo, float hi) { unsigned r; asm volatile("v_cvt_pk_bf16_f32 %0, %1, %2" : "=v"(r) : "v"(lo), "v"(hi)); return r; }
__device__ __forceinline__ void partialSM(f32x16& p0, f32x16& p1, float& m_reg, float& mn, float& alpha) {
  constexpr float C = ATT_SCALE * 1.4426950408889634f;
  float pmax = p0[0];
#pragma unroll
  for (int r = 1; r < 16; ++r) pmax = fmaxf(pmax, p0[r]);
#pragma unroll
  for (int r = 0; r < 16; ++r) pmax = fmaxf(pmax, p1[r]);
  { auto rr = __builtin_amdgcn_permlane32_swap(__float_as_uint(pmax), __float_as_uint(pmax), false, false);
    pmax = fmaxf(__uint_as_float(rr[0]), __uint_as_float(rr[1])); }
  if (__builtin_expect(__all(pmax - m_reg <= THR / ATT_SCALE), 1)) { mn = m_reg; alpha = 1.f; }
  else { mn = fmaxf(m_reg, pmax); alpha = __builtin_amdgcn_exp2f((m_reg - mn) * C); m_reg = mn; }
  float mnC = -mn * C;
#pragma unroll
  for (int r = 0; r < 16; ++r) p0[r] = fmaf(p0[r], C, mnC);
#pragma unroll
  for (int r = 0; r < 16; ++r) p1[r] = fmaf(p1[r], C, mnC);
#pragma unroll
  for (int r = 0; r < 16; ++r) p0[r] = __builtin_amdgcn_exp2f(p0[r]);
}
__device__ __forceinline__ void finishSM(f32x16& p0, f32x16& p1, float alpha, float& l_reg, bf16x8& pa0, bf16x8& pa1, bf16x8& pa2, bf16x8& pa3) {
#pragma unroll
  for (int r = 0; r < 16; ++r) p1[r] = __builtin_amdgcn_exp2f(p1[r]);
  float ps = 0;
#pragma unroll
  for (int r = 0; r < 16; ++r) ps += p0[r];
#pragma unroll
  for (int r = 0; r < 16; ++r) ps += p1[r];
  { auto rr = __builtin_amdgcn_permlane32_swap(__float_as_uint(ps), __float_as_uint(ps), false, false);
    ps = __uint_as_float(rr[0]) + __uint_as_float(rr[1]); }
  l_reg = l_reg * alpha + ps;
#define PK4(P, BASE, OUT) do { unsigned a0 = cvtpk(P[BASE + 0], P[BASE + 1]), a1 = cvtpk(P[BASE + 2], P[BASE + 3]);   \
    unsigned b0 = cvtpk(P[BASE + 4], P[BASE + 5]), b1 = cvtpk(P[BASE + 6], P[BASE + 7]);                              \
    auto r0 = __builtin_amdgcn_permlane32_swap(a0, b0, false, false); auto r1 = __builtin_amdgcn_permlane32_swap(a1, b1, false, false); \
    u32x4 w = {r0[0], r1[0], r0[1], r1[1]}; OUT = *reinterpret_cast<bf16x8*>(&w); } while (0)
  PK4(p0, 0, pa0); PK4(p0, 8, pa1); PK4(p1, 0, pa2); PK4(p1, 8, pa3);
#undef PK4
}
__device__ __forceinline__ void qkt(f32x16& p0, f32x16& p1, const char* Ks, const bf16x8* qr, int r32, int hi) {
  p0 = f32x16{}; p1 = f32x16{};
  const int swz = (r32 & 7) << 4;
  const char* b4[4];
#pragma unroll
  for (int dr = 0; dr < 4; ++dr) b4[dr] = Ks + r32 * 384 + ((dr * 32 + hi * 16) ^ swz);
#pragma unroll
  for (int d0 = 0; d0 < 12; ++d0) {
    bf16x8 b0 = *reinterpret_cast<const bf16x8*>(b4[d0 & 3] + (d0 >> 2) * 128);
    bf16x8 b1 = *reinterpret_cast<const bf16x8*>(b4[d0 & 3] + (d0 >> 2) * 128 + 32 * 384);
    p0 = __builtin_amdgcn_mfma_f32_32x32x16_bf16(b0, qr[d0], p0, 0, 0, 0);
    p1 = __builtin_amdgcn_mfma_f32_32x32x16_bf16(b1, qr[d0], p1, 0, 0, 0); }
}
__device__ __forceinline__ int v_st(int k, int c) { const int kk = (k & ~0xC) | ((k & 4) << 1) | ((k & 8) >> 1); return ((kk >> 3) * 4 + (c >> 5)) * 512 + ((kk & 7) * 32 + (c & 31)) * 2; }
__device__ __forceinline__ int v_rd_base(int lane) { return ((lane & 3) << 3) | (((lane >> 2) & 3) << 6) | (((lane >> 4) & 1) << 5) | (((lane >> 5) & 1) << 8); }
constexpr int v_rd_off(int d0, int ks, int half) { return d0 * 512 + ks * 4096 + half * 2048; }
template <int OFF> __device__ __forceinline__ s16x4 tr_read(int vb) {
  s16x4 r; asm volatile("ds_read_b64_tr_b16 %0, %1 offset:%2" : "=&v"(r) : "v"(vb), "i"(OFF) : "memory"); return r;
}
template <int D0> __device__ __forceinline__ void pv_one(f32x16& od, int vb, bf16x8 pa0, bf16x8 pa1, bf16x8 pa2, bf16x8 pa3) {
  const s16x4 l0 = tr_read<v_rd_off(D0, 0, 0)>(vb), h0 = tr_read<v_rd_off(D0, 0, 1)>(vb), l1 = tr_read<v_rd_off(D0, 1, 0)>(vb), h1 = tr_read<v_rd_off(D0, 1, 1)>(vb);
  const s16x4 l2 = tr_read<v_rd_off(D0, 2, 0)>(vb), h2 = tr_read<v_rd_off(D0, 2, 1)>(vb), l3 = tr_read<v_rd_off(D0, 3, 0)>(vb), h3 = tr_read<v_rd_off(D0, 3, 1)>(vb);
  asm volatile("s_waitcnt lgkmcnt(0)" ::: "memory"); SBAR();
#define PK(L, H) (bf16x8){L[0], L[1], L[2], L[3], H[0], H[1], H[2], H[3]}
  od = __builtin_amdgcn_mfma_f32_32x32x16_bf16(pa0, PK(l0, h0), od, 0, 0, 0);
  od = __builtin_amdgcn_mfma_f32_32x32x16_bf16(pa1, PK(l1, h1), od, 0, 0, 0);
  od = __builtin_amdgcn_mfma_f32_32x32x16_bf16(pa2, PK(l2, h2), od, 0, 0, 0);
  od = __builtin_amdgcn_mfma_f32_32x32x16_bf16(pa3, PK(l3, h3), od, 0, 0, 0);
#undef PK
}
__device__ __forceinline__ void pv_d0(f32x16* o, int vb, bf16x8 pa0, bf16x8 pa1, bf16x8 pa2, bf16x8 pa3) {
  pv_one<0>(o[0], vb, pa0, pa1, pa2, pa3); pv_one<1>(o[1], vb, pa0, pa1, pa2, pa3); pv_one<2>(o[2], vb, pa0, pa1, pa2, pa3); pv_one<3>(o[3], vb, pa0, pa1, pa2, pa3);
}
__device__ __forceinline__ void attn_body(const bf16_t* __restrict__ Qb, const bf16_t* __restrict__ Kh, const bf16_t* __restrict__ Vh, bf16_t* __restrict__ Ob, int ldo, int seq, char* lds) {
  const int tid = tidx(), wid = tid >> 6, lane = tid & 63, r32 = lane & 31, hi = lane >> 5;
  char* V_lds = lds; char* K_lds = lds + 2 * SHM_V;
  float* ws = (float*)(lds + 2 * SHM_V + 2 * SHM_K) + wid * 64; float* li_l = ws; float* al_l = ws + 32;
  float m_reg = -1e30f, l_reg = 0; f32x16 o[4] = {}; bf16x8 qr[12];
  const bf16_t* Qw = Qb + (long)(wid * 32 + r32) * DQK + hi * 8;
#pragma unroll
  for (int d0 = 0; d0 < 12; ++d0) qr[d0] = *reinterpret_cast<const bf16x8*>(Qw + d0 * 16);
  const int sr = tid >> 4, sc = (tid & 15) * 8, vst0 = v_st(sr, sc), vst1 = v_st(32 + sr, sc);
  int kst[3];
#pragma unroll
  for (int i = 0; i < 3; ++i) { const int c = tid + 512 * i, row = c / 24, cc = c % 24; kst[i] = KSWZ(row, cc * 16); }
  const int vb0 = (int)(uintptr_t)V_lds + v_rd_base(lane);
  struct { bf16x8 vs0, vs1, ks0, ks1, ks2; } sr_[1];
#define SLOAD(i, k0) do { const bf16_t* vt = Vh + (long)(k0) * DV; const bf16_t* kt = Kh + (long)(k0) * DQK; \
    sr_[i].vs0 = *reinterpret_cast<const bf16x8*>(vt + (sr) * DV + sc); sr_[i].vs1 = *reinterpret_cast<const bf16x8*>(vt + (32 + sr) * DV + sc); \
    sr_[i].ks0 = *reinterpret_cast<const bf16x8*>(kt + tid * 8); sr_[i].ks1 = *reinterpret_cast<const bf16x8*>(kt + (tid + 512) * 8); sr_[i].ks2 = *reinterpret_cast<const bf16x8*>(kt + (tid + 1024) * 8); } while (0)
#define SWRITE(b, i) do { *(bf16x8*)(V_lds + (b) * SHM_V + vst0) = sr_[i].vs0; *(bf16x8*)(V_lds + (b) * SHM_V + vst1) = sr_[i].vs1; \
    *(bf16x8*)(K_lds + (b) * SHM_K + kst[0]) = sr_[i].ks0; *(bf16x8*)(K_lds + (b) * SHM_K + kst[1]) = sr_[i].ks1; *(bf16x8*)(K_lds + (b) * SHM_K + kst[2]) = sr_[i].ks2; } while (0)
#define SWAIT() asm volatile("s_waitcnt vmcnt(5)" ::: "memory")
#define RESC(a) do { if (__any((a) < 1.f)) { if (hi == 0) al_l[r32] = (a); asm volatile("s_waitcnt lgkmcnt(0)" ::: "memory"); \
    _Pragma("unroll") for (int d = 0; d < 4; ++d) _Pragma("unroll") for (int r = 0; r < 16; ++r) o[d][r] *= al_l[crow(r, hi)]; } } while (0)
  f32x16 pA0, pA1; float mnA, alA; bf16x8 pa0, pa1, pa2, pa3; const int NT = seq / KVBLK;
  SLOAD(0, 0); SWRITE(0, 0);
  SLOAD(0, KVBLK);
  __syncthreads();
  for (int j = 0; j < NT; j += 2) {
    SBAR(); qkt(pA0, pA1, K_lds, qr, r32, hi);
    partialSM(pA0, pA1, m_reg, mnA, alA); RESC(alA);
    finishSM(pA0, pA1, alA, l_reg, pa0, pa1, pa2, pa3); SBAR();
    SWRITE(1, 0);
    if (j + 2 < NT) SLOAD(0, (j + 2) * KVBLK);
    SBAR();
    pv_d0(o, vb0, pa0, pa1, pa2, pa3);
    __syncthreads();
    SBAR(); qkt(pA0, pA1, K_lds + SHM_K, qr, r32, hi);
    partialSM(pA0, pA1, m_reg, mnA, alA); RESC(alA);
    finishSM(pA0, pA1, alA, l_reg, pa0, pa1, pa2, pa3); SBAR();
    if (j + 2 < NT) { SWRITE(0, 0); if (j + 3 < NT) SLOAD(0, (j + 3) * KVBLK); }
    SBAR();
    pv_d0(o, vb0 + SHM_V, pa0, pa1, pa2, pa3);
    __syncthreads();
  }
  if (hi == 0) li_l[r32] = l_reg; asm volatile("s_waitcnt lgkmcnt(0)" ::: "memory");
  float rli[16];
#pragma unroll
  for (int r = 0; r < 16; ++r) rli[r] = __builtin_amdgcn_rcpf(li_l[crow(r, hi)]);
  bf16_t* Ow = Ob + (long)(wid * 32) * ldo;
#pragma unroll
  for (int r = 0; r < 16; ++r) { int orow = crow(r, hi);
#pragma unroll
    for (int d0 = 0; d0 < 4; ++d0) Ow[(long)orow * ldo + d0 * 32 + r32] = f2bf(o[d0][r] * rli[r]); }
  __syncthreads();
#undef SLOAD
#undef SWRITE
#undef SWAIT
#undef RESC
}
#undef KSWZ
}

__device__ void ph_attn(const Params& p, char* lds) {
    const bf16_t* Q = (const bf16_t*)(p.ws + OFF_Q); const bf16_t* K = (const bf16_t*)(p.ws + OFF_K); const bf16_t* V = (const bf16_t*)(p.ws + OFF_V);
    bf16_t* O = (bf16_t*)(p.ws + OFF_O);
    const int G = gridDim.x;
    for (int i = 0;; ++i) {
        const int L = i * G + (int)blockIdx.x; if (L >= 544) break;
        int bh, qb;
        if (L < 512) { const int w = g8::xcd_remap(L, 512); bh = w >> 4; qb = 1 + (w & 15); } else { bh = L - 512; qb = 0; }
        const int b = bh >> 3, h = bh & 7;
        const int seq = qb == 0 ? TC : TK;
        const int row0 = qb == 0 ? NLAT + b * TC : b * TL + (qb - 1) * 256;
        fa::attn_body(Q + ((size_t)bh * TK + qb * 256) * 192, K + (size_t)bh * TK * 192, V + (size_t)bh * TK * 128, O + (size_t)row0 * D + h * 128, D, seq, lds);
    }
}

__device__ void ph_norm2_router(const Params& p, int layer, char* lds) {
    const int tid = tidx(), wid = tid >> 6, lane = tid & 63;
    float* rt = (float*)lds;
    const float* rg = p.moe_router + (size_t)layer * D * NE;
    for (int i = tid; i < D * NE / 4; i += NTHR) ((float4*)rt)[i] = ((const float4*)rg)[i];
    __syncthreads();
    const float* X = (const float*)(p.ws + OFF_X); bf16_t* BN = (bf16_t*)(p.ws + OFF_H); float* AFF = (float*)(p.ws + OFF_AFF);
    const float* g = p.norm2_g + layer * D;
    for (int row = blockIdx.x * 8 + wid; row < NROW; row += gridDim.x * 8) {
        const int s = row_stream(row);
        const float* sh = modp(p, layer, s, 3); const float* sc = modp(p, layer, s, 4);
        const float4* xr = (const float4*)(X + (size_t)row * D);
        float4 v[4]; float ss = 0;
#pragma unroll
        for (int i = 0; i < 4; ++i) { v[i] = xr[lane + i * 64]; ss += v[i].x * v[i].x + v[i].y * v[i].y + v[i].z * v[i].z + v[i].w * v[i].w; }
        ss = wave_sum(ss); const float rs = rsqrtf(ss * (1.f / D) + RMS_EPS);
        float lg[16];
#pragma unroll
        for (int e = 0; e < 16; ++e) lg[e] = 0.f;
#pragma unroll
        for (int i = 0; i < 4; ++i) {
            const int d = (lane + i * 64) * 4;
            const float4 gg = *(const float4*)(g + d), a = *(const float4*)(sc + d), b = *(const float4*)(sh + d);
            float o[4]; o[0] = v[i].x * rs * gg.x * (1.f + a.x) + b.x; o[1] = v[i].y * rs * gg.y * (1.f + a.y) + b.y; o[2] = v[i].z * rs * gg.z * (1.f + a.z) + b.z; o[3] = v[i].w * rs * gg.w * (1.f + a.w) + b.w;
            uint2 w; w.x = pk2(o[0], o[1]); w.y = pk2(o[2], o[3]); *(uint2*)(BN + (size_t)row * D + d) = w;
#pragma unroll
            for (int jj = 0; jj < 4; ++jj) { const float* rr = rt + (d + jj) * 16;
#pragma unroll
                for (int e = 0; e < 16; ++e) lg[e] += o[jj] * rr[e];
                asm volatile("" ::: "memory"); }
        }
        float mx = -1e30f;
#pragma unroll
        for (int e = 0; e < 16; ++e) { lg[e] = wave_sum(lg[e]); mx = fmaxf(mx, lg[e]); }
        float sum = 0;
#pragma unroll
        for (int e = 0; e < 16; ++e) { lg[e] = expf(lg[e] - mx); sum += lg[e]; }
        const float inv = 1.f / sum;
        if (lane < 16) { float val = 0;
#pragma unroll
            for (int e = 0; e < 16; ++e) val = (lane == e) ? lg[e] : val;
            AFF[(size_t)row * 16 + lane] = val * inv; }
    }
}

__device__ void ph_select(const Params& p, char* lds) {
    const int tid = tidx(), wid = tid >> 6, lane = tid & 63;
    unsigned* hist = (unsigned*)lds;
    unsigned* ctl = hist + 256;
    unsigned* wsum = ctl + 8;
    const float* AFF = (const float*)(p.ws + OFF_AFF);
    int* ROWIDX = (int*)(p.ws + OFF_ROWIDX); float* GATE = (float*)(p.ws + OFF_GATE); int* SLOT = (int*)(p.ws + OFF_SLOT);
    for (int gidx = blockIdx.x; gidx < 128; gidx += gridDim.x) {
        const bool lat = gidx < 64; const int b = (gidx & 63) >> 4, e = gidx & 15;
        const int n = lat ? TL : TC, cap = lat ? CAPL : CAPC;
        const int row0 = lat ? b * TL : NLAT + b * TC, slot0 = lat ? b * CAPL : NB * CAPL + b * CAPC;
        unsigned key[8];
#pragma unroll
        for (int i = 0; i < 8; ++i) { const int idx = tid * 8 + i; key[i] = idx < n ? __float_as_uint(AFF[(size_t)(row0 + idx) * 16 + e]) : 0u; }
        unsigned prefix = 0u, remaining = (unsigned)cap;
#pragma unroll
        for (int pass = 0; pass < 4; ++pass) {
            const int sh = 24 - 8 * pass;
            __syncthreads();
            if (tid < 256) hist[tid] = 0u;
            __syncthreads();
#pragma unroll
            for (int i = 0; i < 8; ++i) { const int idx = tid * 8 + i;
                const bool cand = idx < n && (pass == 0 || (key[i] >> (sh + 8)) == prefix);
                if (cand) atomicAdd(&hist[(key[i] >> sh) & 255u], 1u); }
            __syncthreads();
            if (tid < 256) { unsigned gt = 0; for (int jj = tid + 1; jj < 256; ++jj) gt += hist[jj];
                const unsigned mine = hist[tid];
                if (gt < remaining && remaining <= gt + mine) { ctl[0] = (unsigned)tid; ctl[1] = remaining - gt; } }
            __syncthreads();
            prefix = (prefix << 8) | ctl[0]; remaining = ctl[1];
        }
        const unsigned T = prefix, m = remaining;
        unsigned cgt = 0, ceq = 0;
#pragma unroll
        for (int i = 0; i < 8; ++i) { const int idx = tid * 8 + i; if (idx < n) { cgt += key[i] > T ? 1u : 0u; ceq += key[i] == T ? 1u : 0u; } }
        auto block_excl = [&](unsigned v) -> unsigned {
            unsigned inc = v;
#pragma unroll
            for (int o = 1; o < 64; o <<= 1) { const unsigned t = __shfl_up(inc, o); if (lane >= o) inc += t; }
            __syncthreads();
            if (lane == 63) wsum[wid] = inc;
            __syncthreads();
            unsigned base = 0;
#pragma unroll
            for (int w = 0; w < 8; ++w) base += (w < wid) ? wsum[w] : 0u;
            return base + inc - v; };
        unsigned eqbase = block_excl(ceq);
        unsigned nsel = 0; bool sel[8];
#pragma unroll
        for (int i = 0; i < 8; ++i) { const int idx = tid * 8 + i; bool s_ = false;
            if (idx < n) { if (key[i] > T) s_ = true; else if (key[i] == T) { s_ = eqbase < m; ++eqbase; } }
            sel[i] = s_; nsel += s_ ? 1u : 0u; }
        unsigned sbase = block_excl(nsel);
#pragma unroll
        for (int i = 0; i < 8; ++i) { const int idx = tid * 8 + i;
            if (idx < n) {
                if (sel[i]) { const int sl = slot0 + (int)sbase; ++sbase; ROWIDX[e * ESLOTS + sl] = row0 + idx; GATE[e * EPAD + sl] = __uint_as_float(key[i]); SLOT[(size_t)(row0 + idx) * 16 + e] = sl; }
                else SLOT[(size_t)(row0 + idx) * 16 + e] = -1; } }
    }
}

__device__ void ph_gather(const Params& p) {
    const int wid = tidx() >> 6, lane = tidx() & 63;
    const int* ROWIDX = (const int*)(p.ws + OFF_ROWIDX); const bf16_t* BN = (const bf16_t*)(p.ws + OFF_H); bf16_t* XE = (bf16_t*)(p.ws + OFF_XE);
    for (int it = blockIdx.x * 8 + wid; it < NE * ESLOTS; it += gridDim.x * 8) {
        const int row = ROWIDX[it]; const int e = it / ESLOTS, sl = it % ESLOTS;
        const u32x4* src = (const u32x4*)(BN + (size_t)row * D); u32x4* dst = (u32x4*)(XE + ((size_t)e * EPAD + sl) * D);
        dst[lane] = src[lane]; dst[lane + 64] = src[lane + 64];
    }
}

__device__ void ph_combine(const Params& p, int layer) {
    const int wid = tidx() >> 6, lane = tidx() & 63;
    const int* SLOT = (const int*)(p.ws + OFF_SLOT); const bf16_t* YE = (const bf16_t*)(p.ws + OFF_YE); float* X = (float*)(p.ws + OFF_X);
    for (int row = blockIdx.x * 8 + wid; row < NROW; row += gridDim.x * 8) {
        const float* gt = modp(p, layer, row_stream(row), 5);
        float acc[16];
#pragma unroll
        for (int i = 0; i < 16; ++i) acc[i] = 0.f;
        for (int e = 0; e < NE; ++e) {
            const int s = SLOT[(size_t)row * 16 + e];
            if (s >= 0) { const bf16_t* y = YE + ((size_t)e * EPAD + s) * D + lane * 16;
                const u32x4 a = *(const u32x4*)y, b = *(const u32x4*)(y + 8);
                const unsigned w[8] = {a.x, a.y, a.z, a.w, b.x, b.y, b.z, b.w};
#pragma unroll
                for (int i = 0; i < 8; ++i) { acc[2 * i] += __uint_as_float(w[i] << 16); acc[2 * i + 1] += __uint_as_float(w[i] & 0xffff0000u); } }
        }
        float* xr = X + (size_t)row * D + lane * 16; const float* g = gt + lane * 16;
#pragma unroll
        for (int i = 0; i < 16; i += 4) { float4 xv = *(float4*)(xr + i); const float4 gv = *(const float4*)(g + i);
            xv.x += gv.x * acc[i]; xv.y += gv.y * acc[i + 1]; xv.z += gv.z * acc[i + 2]; xv.w += gv.w * acc[i + 3]; *(float4*)(xr + i) = xv; }
    }
}

__device__ void ph_rw_xs(const Params& p, int j) {
    const float* HF = (const float*)(p.ws + OFF_HF); bf16_t* XS = (bf16_t*)(p.ws + OFF_XS);
    const float* mu = p.rw_mu + (size_t)j * 6 * D;
    const int gtid = blockIdx.x * NTHR + tidx(), gsz = gridDim.x * NTHR;
    for (int i = gtid; i < NROW * 256; i += gsz) {
        const int row = i >> 8, d = (i & 255) * 4;
        const bool lat = row < NLAT; const int t = lat ? (row & (TL - 1)) : ((row - NLAT) & (TC - 1)); const int len = lat ? TL : TC;
        const float4 h = *(const float4*)(HF + (size_t)row * D + d);
        float4 pv = make_float4(0, 0, 0, 0), nx = make_float4(0, 0, 0, 0);
        if (t > 0) pv = *(const float4*)(HF + (size_t)(row - 1) * D + d);
        if (t < len - 1) nx = *(const float4*)(HF + (size_t)(row + 1) * D + d);
        float4 xx; xx.x = 0.5f * (pv.x + nx.x) - h.x; xx.y = 0.5f * (pv.y + nx.y) - h.y; xx.z = 0.5f * (pv.z + nx.z) - h.z; xx.w = 0.5f * (pv.w + nx.w) - h.w;
#pragma unroll
        for (int m = 0; m < 6; ++m) { const float4 u = *(const float4*)(mu + m * D + d);
            uint2 w; w.x = pk2(h.x + xx.x * u.x, h.y + xx.y * u.y); w.y = pk2(h.z + xx.z * u.z, h.w + xx.w * u.w);
            *(uint2*)(XS + ((size_t)m * NROW + row) * D + d) = w; }
    }
}

__device__ void ph_rw_prep(const Params& p, int j) {
    const int wid = tidx() >> 6, lane = tidx() & 63;
    float* RKV = (float*)(p.ws + OFF_RKV); float* AV = (float*)(p.ws + OFF_AV); float* KD = (float*)(p.ws + OFF_KD);
    const float* k_k = p.rw_k_k + j * D; const float* k_a = p.rw_k_a + j * D;
    for (int row = blockIdx.x * 8 + wid; row < NROW; row += gridDim.x * 8) {
        const size_t o = (size_t)row * D + lane * 16;
        float k[16], kk[16]; float ss = 0;
#pragma unroll
        for (int i = 0; i < 16; ++i) { k[i] = RKV[(size_t)NROW * D + o + i]; kk[i] = k[i] * k_k[lane * 16 + i]; ss += kk[i] * kk[i]; }
        ss += __shfl_xor(ss, 1); ss += __shfl_xor(ss, 2);
        const float inv = 1.f / fmaxf(sqrtf(ss), 1e-12f);
#pragma unroll
        for (int i = 0; i < 16; ++i) kk[i] *= inv;
#pragma unroll
        for (int z = 0; z < 2; ++z)
#pragma unroll
            for (int i = 0; i < 16; ++i) { const float a = AV[(size_t)z * NROW * D + o + i];
                KD[(size_t)z * NROW * D + o + i] = k[i] * (1.f + (a - 1.f) * k_a[lane * 16 + i]);
                AV[(size_t)z * NROW * D + o + i] = kk[i] * a; }
#pragma unroll
        for (int i = 0; i < 16; ++i) RKV[(size_t)NROW * D + o + i] = kk[i];
    }
}

__device__ __forceinline__ float dpp_sum16(float x) {
    x += __builtin_bit_cast(float, __builtin_amdgcn_update_dpp(0, __builtin_bit_cast(int, x), 0xB1, 0xF, 0xF, true));
    x += __builtin_bit_cast(float, __builtin_amdgcn_update_dpp(0, __builtin_bit_cast(int, x), 0x4E, 0xF, 0xF, true));
    x += __builtin_bit_cast(float, __builtin_amdgcn_update_dpp(0, __builtin_bit_cast(int, x), 0x141, 0xF, 0xF, true));
    x += __builtin_bit_cast(float, __builtin_amdgcn_update_dpp(0, __builtin_bit_cast(int, x), 0x140, 0xF, 0xF, true));
    return x;
}
__device__ __forceinline__ int scan_row(int i, int b, int z) {
    return i < TC ? NLAT + b * TC + (z ? TC - 1 - i : i) : b * TL + (z ? TL - 1 - (i - TC) : i - TC);
}
__device__ void ph_rw_scan(const Params& p, char* lds) {
    const int tid = tidx(), wid = __builtin_amdgcn_readfirstlane(tid >> 6), lane = tid & 63, vr = lane >> 4, ks = lane & 15;
    const size_t PL = (size_t)NROW * D;
    const float* RKV = (const float*)(p.ws + OFF_RKV); float* Y = (float*)(p.ws + OFF_Y);
    constexpr int CH = 32, BUFB = 5 * CH * 256 + CH * 128, YB = CH * 32 * 4;
    for (int it = blockIdx.x; it < 256; it += gridDim.x) {
        const int vh = it & 1, z = (it >> 1) & 1, h = (it >> 2) & 15, b = it >> 6;
        const char* pl[5];
        pl[0] = (const char*)((const float*)(p.ws + OFF_W) + z * PL); pl[1] = (const char*)(RKV + PL); pl[2] = (const char*)((const float*)(p.ws + OFF_AV) + z * PL);
        pl[3] = (const char*)((const float*)(p.ws + OFF_KD) + z * PL); pl[4] = (const char*)RKV;
        const char* vpl = (const char*)(RKV + 2 * PL);
        float* yout = Y + z * PL;
        auto issue = [&](int c) {
            char* buf = lds + (c & 1) * BUFB;
#pragma unroll
            for (int q0 = 0; q0 < 48; q0 += 8) {
                const int q = q0 + wid;
                if (q < 40) { const int pi = q >> 3, tg = q & 7; const int row = scan_row(c * CH + tg * 4 + (lane >> 4), b, z);
                    const char* base = pi == 0 ? pl[0] : pi == 1 ? pl[1] : pi == 2 ? pl[2] : pi == 3 ? pl[3] : pl[4];
                    __builtin_amdgcn_global_load_lds((const unsigned*)(base + (size_t)row * D * 4 + h * 256 + (lane & 15) * 16), (LAS unsigned*)(buf + pi * (CH * 256) + tg * 1024), 16, 0, 0); }
                else if (q < 44) { const int tg = q - 40; const int row = scan_row(c * CH + tg * 8 + (lane >> 3), b, z);
                    __builtin_amdgcn_global_load_lds((const unsigned*)(vpl + (size_t)row * D * 4 + (h * 64 + vh * 32) * 4 + (lane & 7) * 16), (LAS unsigned*)(buf + 5 * CH * 256 + tg * 1024), 16, 0, 0); }
            }
        };
        float S0 = 0.f, S1 = 0.f, S2 = 0.f, S3 = 0.f;
        __syncthreads();
        issue(0);
        asm volatile("s_waitcnt vmcnt(0)" ::: "memory"); __syncthreads();
        constexpr int NCH = (TC + TL) / CH;
        for (int c = 0; c < NCH; ++c) {
            if (c + 1 < NCH) issue(c + 1);
            const char* buf = lds + (c & 1) * BUFB; float* yb = (float*)(lds + 2 * BUFB + (c & 1) * YB);
#pragma unroll 4
            for (int t = 0; t < CH; ++t) {
                const f32x4 w = *(const f32x4*)(buf + t * 256 + ks * 16), kk = *(const f32x4*)(buf + CH * 256 + t * 256 + ks * 16), bb = *(const f32x4*)(buf + 2 * CH * 256 + t * 256 + ks * 16);
                const f32x4 kd = *(const f32x4*)(buf + 3 * CH * 256 + t * 256 + ks * 16), r = *(const f32x4*)(buf + 4 * CH * 256 + t * 256 + ks * 16);
                const float v = *(const float*)(buf + 5 * CH * 256 + t * 128 + (wid * 4 + vr) * 4);
                float sa = -(S0 * kk[0] + S1 * kk[1] + S2 * kk[2] + S3 * kk[3]);
                sa = dpp_sum16(sa);
                S0 = S0 * w[0] + sa * bb[0] + v * kd[0]; S1 = S1 * w[1] + sa * bb[1] + v * kd[1]; S2 = S2 * w[2] + sa * bb[2] + v * kd[2]; S3 = S3 * w[3] + sa * bb[3] + v * kd[3];
                float y = S0 * r[0] + S1 * r[1] + S2 * r[2] + S3 * r[3];
                y = dpp_sum16(y);
                if (ks == 0) yb[t * 32 + wid * 4 + vr] = y;
            }
            asm volatile("s_waitcnt vmcnt(0)" ::: "memory"); __syncthreads();
            if (tid < 256) { const int t = tid >> 3, q = tid & 7; const int row = scan_row(c * CH + t, b, z);
                *(f32x4*)(yout + (size_t)row * D + h * 64 + vh * 32 + q * 4) = *(const f32x4*)(yb + t * 32 + q * 4); }
        }
    }
}

__device__ void ph_rw_out(const Params& p, int j) {
    const int wid = tidx() >> 6, lane = tidx() & 63;
    const float* RKV = (const float*)(p.ws + OFF_RKV); const float* KD = (const float*)(p.ws + OFF_KD); const float* G = (const float*)(p.ws + OFF_G); const float* Y = (const float*)(p.ws + OFF_Y);
    bf16_t* OUT = (bf16_t*)(p.ws + OFF_H);
    const size_t PL = (size_t)NROW * D;
    const float* r_k = p.rw_r_k + j * D; const float* lg = p.rw_lnx_g + j * D; const float* lb = p.rw_lnx_b + j * D;
    for (int row = blockIdx.x * 8 + wid; row < NROW; row += gridDim.x * 8) {
        const size_t o = (size_t)row * D + lane * 16;
        float y[16]; float s = 0;
#pragma unroll
        for (int i = 0; i < 16; ++i) { y[i] = Y[o + i] + Y[PL + o + i]; s += y[i]; }
        s += __shfl_xor(s, 1); s += __shfl_xor(s, 2); const float mean = s * (1.f / 64.f);
        float q = 0;
#pragma unroll
        for (int i = 0; i < 16; ++i) { const float dd = y[i] - mean; q += dd * dd; }
        q += __shfl_xor(q, 1); q += __shfl_xor(q, 2); const float rstd = rsqrtf(q * (1.f / 64.f) + LNX_EPS);
        float bs = 0;
#pragma unroll
        for (int i = 0; i < 16; ++i) bs += RKV[o + i] * (KD[o + i] + KD[PL + o + i]) * r_k[lane * 16 + i];
        bs += __shfl_xor(bs, 1); bs += __shfl_xor(bs, 2);
        unsigned w[8];
#pragma unroll
        for (int i = 0; i < 16; i += 2) {
            const float o0 = ((y[i] - mean) * rstd * lg[lane * 16 + i] + lb[lane * 16 + i] + bs * RKV[2 * PL + o + i]) * G[o + i];
            const float o1 = ((y[i + 1] - mean) * rstd * lg[lane * 16 + i + 1] + lb[lane * 16 + i + 1] + bs * RKV[2 * PL + o + i + 1]) * G[o + i + 1];
            w[i >> 1] = pk2(o0, o1); }
        *(u32x4*)(OUT + o) = (u32x4){w[0], w[1], w[2], w[3]}; *(u32x4*)(OUT + o + 8) = (u32x4){w[4], w[5], w[6], w[7]};
    }
}

__device__ void ph_final(const Params& p) {
    const int wid = tidx() >> 6, lane = tidx() & 63;
    const float* X = (const float*)(p.ws + OFF_X);
    for (int row = blockIdx.x * 8 + wid; row < NLAT; row += gridDim.x * 8) {
        const float4* xr = (const float4*)(X + (size_t)row * D);
        float4 v[4]; float ss = 0;
#pragma unroll
        for (int i = 0; i < 4; ++i) { v[i] = xr[lane + i * 64]; ss += v[i].x * v[i].x + v[i].y * v[i].y + v[i].z * v[i].z + v[i].w * v[i].w; }
        ss = wave_sum(ss); const float rs = rsqrtf(ss * (1.f / D) + RMS_EPS);
#pragma unroll
        for (int i = 0; i < 4; ++i) { const int d = (lane + i * 64) * 4; const float4 gg = *(const float4*)(p.final_g + d);
            float4 o; o.x = v[i].x * rs * gg.x; o.y = v[i].y * rs * gg.y; o.z = v[i].z * rs * gg.z; o.w = v[i].w * rs * gg.w;
            *(float4*)(p.out + (size_t)row * D + d) = o; }
    }
}

enum { PH_INIT = 0, PH_A_NORM, PH_A_Z, PH_A_MID, PH_A_QKV, PH_A_POST, PH_A_ATTN, PH_A_WO,
       PH_R_NORM, PH_R_XS, PH_R_G1, PH_R_G2, PH_R_PREP, PH_R_SCAN, PH_R_OUT, PH_R_WO,
       PH_M_NORM, PH_M_SEL, PH_M_GATHER, PH_M_G1, PH_M_G2, PH_M_COMB, PH_FINAL, PH_M_CVT };

template <int PH>
__device__ __forceinline__ void run_phase(const Params& p, int layer, char* lds) {
    const int j = layer >> 1;
    char* ws = p.ws;
    if constexpr (PH == PH_INIT) { ph_init(p, lds); __syncthreads(); ph_small_cvt(p, lds); }
    else if constexpr (PH == PH_A_NORM) ph_norm_mod<false>(p, layer, p.norm1_g + layer * D, 0, 1, ws + OFF_H);
    else if constexpr (PH == PH_A_Z) {
        float* Z = (float*)(ws + OFF_Z);
        g8::BatchSched S{ws + OFF_H, ws + OFF_WMLA + j * SZ_WMLA + WM_IN, 0, 0, NROW / 256, 2, 1, D};
        g8::gemm_phase((PG8_LAS unsigned char*)lds, D, S, g8::epi_rc([=](const g8::Unit&, int row, int col, f32x4 v) { *(f32x4*)(Z + (size_t)row * 512 + col) = v; }));
    }
    else if constexpr (PH == PH_A_MID) ph_mla_mid(p, j);
    else if constexpr (PH == PH_A_QKV) {
        float* QRAW = (float*)(ws + OFF_QRAW); float* KVRAW = (float*)(ws + OFF_KVRAW);
        g8::BatchSched S1{ws + OFF_CQN, ws + OFF_WMLA + j * SZ_WMLA + WM_UQ, 0, 0, NROW / 256, 6, 1, 256};
        g8::gemm_phase((PG8_LAS unsigned char*)lds, 256, S1, g8::epi_rc([=](const g8::Unit&, int row, int col, f32x4 v) { *(f32x4*)(QRAW + (size_t)row * 1536 + col) = v; }));
        g8::BatchSched S2{ws + OFF_CKVN, ws + OFF_WMLA + j * SZ_WMLA + WM_UKV, 0, 0, NROW / 256, 8, 1, 256};
        g8::gemm_phase((PG8_LAS unsigned char*)lds, 256, S2, g8::epi_rc([=](const g8::Unit&, int row, int col, f32x4 v) { *(f32x4*)(KVRAW + (size_t)row * 2048 + col) = v; }));
    }
    else if constexpr (PH == PH_A_POST) ph_qkv_post(p);
    else if constexpr (PH == PH_A_ATTN) ph_attn(p, lds);
    else if constexpr (PH == PH_A_WO || PH == PH_R_WO) {
        float* X = (float*)(ws + OFF_X); const float* MOD = (const float*)(ws + OFF_MOD);
        g8::BatchSched S{ws + (PH == PH_A_WO ? OFF_O : OFF_H), PH == PH_A_WO ? ws + OFF_WMLA + j * SZ_WMLA + WM_O : ws + OFF_WRW + j * SZ_WRW + WR_O, 0, 0, NROW / 256, 4, 1, D};
        g8::gemm_phase((PG8_LAS unsigned char*)lds, D, S, g8::epi_rc([=](const g8::Unit&, int row, int col, f32x4 v) {
            const f32x4 gt = *(const f32x4*)(MOD + ((size_t)layer * 5 + row_stream(row)) * 6144 + 2048 + col);
            f32x4* xp = (f32x4*)(X + (size_t)row * D + col); *xp = *xp + gt * v; }));
    }
    else if constexpr (PH == PH_R_NORM) ph_norm_mod<true>(p, layer, p.norm1_g + layer * D, 0, 1, ws + OFF_HF);
    else if constexpr (PH == PH_R_XS) ph_rw_xs(p, j);
    else if constexpr (PH == PH_R_G1) {
        float* RKV = (float*)(ws + OFF_RKV); float* VF = (float*)(ws + OFF_VFIRST);
        bf16_t* LW = (bf16_t*)(ws + OFF_LW); bf16_t* LA = (bf16_t*)(ws + OFF_LA); bf16_t* LG = (bf16_t*)(ws + OFF_LG); bf16_t* LV = (bf16_t*)(ws + OFF_LV);
        const bool first = (j == 0);
        struct RSched { const char* XS; const char* WB; int nwg;
            __device__ __forceinline__ bool next(int i, g8::Unit& u) const {
                const int L = i * (int)gridDim.x + (int)blockIdx.x; if (L >= nwg) return false;
                const int w = g8::xcd_remap(L, nwg);
                if (w < 816) { u.g = w / 272; const int r = w % 272; u.pm = r >> 2; u.pn = r & 3; u.B = WB + WR_RKV + (size_t)u.g * D * D * 2 + (size_t)u.pn * 256 * D * 2; }
                else { u.g = 3 + (w - 816) / 68; u.pm = (w - 816) % 68; u.pn = 0; u.B = WB + WR_L + (size_t)(u.g - 3) * 256 * D * 2; }
                u.A = XS + (size_t)(u.g == 6 ? 2 : u.g) * NROW * D * 2 + (size_t)u.pm * 256 * D * 2; return true; } };
        RSched S{ws + OFF_XS, ws + OFF_WRW + j * SZ_WRW, first ? 816 + 204 : 816 + 272};
        g8::gemm_phase((PG8_LAS unsigned char*)lds, D, S, g8::epi_rc([=](const g8::Unit& u, int row, int col, f32x4 v) {
            if (u.g < 3) { *(f32x4*)(RKV + ((size_t)u.g * NROW + row) * D + col) = v; if (first && u.g == 2) *(f32x4*)(VF + (size_t)row * D + col) = v; }
            else if (u.g == 3) { if (col < 128) { uint2 w; w.x = pk2(tanhf(v[0]), tanhf(v[1])); w.y = pk2(tanhf(v[2]), tanhf(v[3])); *(uint2*)(LW + (size_t)row * 128 + col) = w; } }
            else if (u.g == 4) { if (col < 128) { uint2 w; w.x = pk2(v[0], v[1]); w.y = pk2(v[2], v[3]); *(uint2*)(LA + (size_t)row * 128 + col) = w; } }
            else if (u.g == 5) { if (col < 128) { uint2 w; w.x = pk2(sigmoidf_(v[0]), sigmoidf_(v[1])); w.y = pk2(sigmoidf_(v[2]), sigmoidf_(v[3])); *(uint2*)(LG + (size_t)row * 128 + col) = w; } }
            else { if (col < 32) { uint2 w; w.x = pk2(v[0], v[1]); w.y = pk2(v[2], v[3]); *(uint2*)(LV + (size_t)row * 32 + col) = w; } } }));
    }
    else if constexpr (PH == PH_R_G2) {
        const bool first = (j == 0);
        float* W = (float*)(ws + OFF_W); float* AV = (float*)(ws + OFF_AV); float* G = (float*)(ws + OFF_G); float* RKV = (float*)(ws + OFF_RKV); const float* VF = (const float*)(ws + OFF_VFIRST);
        const float* w0 = p.rw_w0 + (size_t)j * 2 * D; const float* a0 = p.rw_a0 + (size_t)j * 2 * D; const float* v0 = p.rw_v0;
        SgArgs gw{(const bf16_t*)(ws + OFF_LW), 128, 64, p.rw_w2 + (size_t)j * 2 * 64 * D, D, (size_t)64 * D, NROW, D, 64, 2};
        sg_gemm(lds, gw, [=](int z, int row, int col, float v) { const float wz = v + w0[z * D + col];
            const float sp = (-wz > 20.f) ? -wz : log1pf(expf(-wz));
            W[((size_t)z * NROW + row) * D + col] = expf(-expf(-sp - 0.5f)); });
        SgArgs ga{(const bf16_t*)(ws + OFF_LA), 128, 64, p.rw_a2 + (size_t)j * 2 * 64 * D, D, (size_t)64 * D, NROW, D, 64, 2};
        sg_gemm(lds, ga, [=](int z, int row, int col, float v) { AV[((size_t)z * NROW + row) * D + col] = sigmoidf_(v + a0[z * D + col]); });
        SgArgs gg{(const bf16_t*)(ws + OFF_LG), 128, 0, p.rw_g2 + (size_t)j * 128 * D, D, 0, NROW, D, 128, 1};
        sg_gemm(lds, gg, [=](int, int row, int col, float v) { G[(size_t)row * D + col] = v; });
        if (!first) {
            SgArgs gv{(const bf16_t*)(ws + OFF_LV), 32, 0, p.rw_v2, D, 0, NROW, D, 32, 1};
            sg_gemm(lds, gv, [=](int, int row, int col, float v) { const size_t o = (size_t)row * D + col; const float vv = RKV[(size_t)2 * NROW * D + o];
                RKV[(size_t)2 * NROW * D + o] = vv + (VF[o] - vv) * sigmoidf_(v + v0[col]); });
        }
    }
    else if constexpr (PH == PH_R_PREP) ph_rw_prep(p, j);
    else if constexpr (PH == PH_R_SCAN) ph_rw_scan(p, lds);
    else if constexpr (PH == PH_R_OUT) ph_rw_out(p, j);
    else if constexpr (PH == PH_M_NORM) ph_norm2_router(p, layer, lds);
    else if constexpr (PH == PH_M_SEL) ph_select(p, lds);
    else if constexpr (PH == PH_M_GATHER) ph_gather(p);
    else if constexpr (PH == PH_M_G1) {
        bf16_t* HID = (bf16_t*)(ws + OFF_HID);
        g8::BatchSched S{ws + OFF_XE, ws + OFF_W13T, (size_t)EPAD * D * 2, (size_t)2816 * D * 2, EPAD / 256, 11, NE, D};
        g8::gemm_phase((PG8_LAS unsigned char*)lds, D, S, g8::epi_pair([=](const g8::Unit& u, int row, int col, f32x4 a, f32x4 b) {
            uint2 w; w.x = pk2(a[0] / (1.f + __expf(-a[0])) * b[0], a[1] / (1.f + __expf(-a[1])) * b[1]); w.y = pk2(a[2] / (1.f + __expf(-a[2])) * b[2], a[3] / (1.f + __expf(-a[3])) * b[3]);
            *(uint2*)(HID + ((size_t)u.g * EPAD + row) * FF + col) = w; }));
    }
    else if constexpr (PH == PH_M_G2) {
        bf16_t* YE = (bf16_t*)(ws + OFF_YE); const float* GATE = (const float*)(ws + OFF_GATE);
        g8::BatchSched S{ws + OFF_HID, ws + OFF_W2T, (size_t)EPAD * FF * 2, (size_t)D * FF * 2, EPAD / 256, 4, NE, FF};
        g8::gemm_phase((PG8_LAS unsigned char*)lds, FF, S, g8::epi_rc([=](const g8::Unit& u, int row, int col, f32x4 v) {
            const float gt = GATE[u.g * EPAD + row];
            uint2 w; w.x = pk2(v[0] * gt, v[1] * gt); w.y = pk2(v[2] * gt, v[3] * gt);
            *(uint2*)(YE + ((size_t)u.g * EPAD + row) * D + col) = w; }));
    }
    else if constexpr (PH == PH_M_COMB) ph_combine(p, layer);
    else if constexpr (PH == PH_M_CVT) ph_moe_cvt(p, layer, lds);
    else if constexpr (PH == PH_FINAL) ph_final(p);
}

#if ONE_LAUNCH
#define SYNC() xcd_barrier(bar)
#ifndef PROBE_PH
#define PROBE_PH -1
#endif
#ifndef PROBE_REP
#define PROBE_REP 1
#endif
#define RUN(PH) do { for (int rep_ = 0; rep_ < ((PH) == PROBE_PH ? PROBE_REP : 1); ++rep_) { Params q = p; asm volatile("" : "+s"(q.ws)); run_phase<PH>(q, layer, smem); SYNC(); } } while (0)
__global__ void __launch_bounds__(NTHR, 2) mega(Params p) {
    extern __shared__ __attribute__((aligned(16))) char smem[];
    if (tidx() == 0) *(uint4*)(smem + LDS_BYTES) = make_uint4(0u, 0u, 0u, 0u);
    __syncthreads();
    XcdBarrier bar = xcd_barrier_post((unsigned*)(p.ws + OFF_BAR), (volatile LAS unsigned*)(smem + LDS_BYTES));
    { const int layer = 0; RUN(PH_INIT); }
    for (int layer = 0; layer < 4; ++layer) {
        if ((layer & 1) == 0) {
            RUN(PH_A_NORM);
            RUN(PH_A_Z);
            RUN(PH_A_MID);
            RUN(PH_A_QKV);
            RUN(PH_A_POST);
            RUN(PH_A_ATTN);
            RUN(PH_A_WO);
        } else {
            RUN(PH_R_NORM);
            RUN(PH_R_XS);
            RUN(PH_R_G1);
            RUN(PH_R_G2);
            RUN(PH_R_PREP);
            RUN(PH_R_SCAN);
            RUN(PH_R_OUT);
            RUN(PH_R_WO);
        }
        RUN(PH_M_CVT);
        RUN(PH_M_NORM);
        RUN(PH_M_SEL);
        RUN(PH_M_GATHER);
        RUN(PH_M_G1);
        RUN(PH_M_G2);
        RUN(PH_M_COMB);
    }
    run_phase<PH_FINAL>(p, 0, smem);
}
#else
template <int PH> __global__ void __launch_bounds__(NTHR, 2) kph(Params p, int layer) {
    extern __shared__ __attribute__((aligned(16))) char smem[];
    run_phase<PH>(p, layer, smem);
}
#endif

extern "C" void kernel_launch(void* const* d_in, const int* in_sizes, int n_in, void* d_out, int out_size, void* d_ws, size_t ws_size, hipStream_t stream) {
    if (n_in != 38 || ws_size < WS_NEED) { fprintf(stderr, "kernel_launch: bad args n_in %d ws %zu need %zu\n", n_in, ws_size, (size_t)WS_NEED); return; }
    Params p{};
    const float** pp = (const float**)&p;
    for (int i = 0; i < 38; ++i) pp[i] = (const float*)d_in[i];
    p.out = (float*)d_out; p.ws = (char*)d_ws;
    static int cus = 0;
    if (!cus) { int dev = 0; hipGetDevice(&dev); hipDeviceGetAttribute(&cus, hipDeviceAttributeMultiprocessorCount, dev); if (cus <= 0) cus = 256; }
    const int grid = cus;
#if ONE_LAUNCH
    hipFuncSetAttribute((const void*)mega, hipFuncAttributeMaxDynamicSharedMemorySize, LDS_BYTES + 16);
    hipMemsetAsync(d_ws, 0, XCD_BAR_WORDS * sizeof(unsigned), stream);
    hipLaunchKernelGGL(mega, dim3(grid), dim3(NTHR), LDS_BYTES + 16, stream, p);
#else
#define LAUNCH(PH, L) do { hipFuncSetAttribute((const void*)kph<PH>, hipFuncAttributeMaxDynamicSharedMemorySize, LDS_BYTES + 16); hipLaunchKernelGGL(kph<PH>, dim3(grid), dim3(NTHR), LDS_BYTES + 16, stream, p, L); } while (0)
    LAUNCH(PH_INIT, 0);
    for (int layer = 0; layer < 4; ++layer) {
        if ((layer & 1) == 0) { LAUNCH(PH_A_NORM, layer); LAUNCH(PH_A_Z, layer); LAUNCH(PH_A_MID, layer); LAUNCH(PH_A_QKV, layer); LAUNCH(PH_A_POST, layer); LAUNCH(PH_A_ATTN, layer); LAUNCH(PH_A_WO, layer); }
        else { LAUNCH(PH_R_NORM, layer); LAUNCH(PH_R_XS, layer); LAUNCH(PH_R_G1, layer); LAUNCH(PH_R_G2, layer); LAUNCH(PH_R_PREP, layer); LAUNCH(PH_R_SCAN, layer); LAUNCH(PH_R_OUT, layer); LAUNCH(PH_R_WO, layer); }
        LAUNCH(PH_M_CVT, layer); LAUNCH(PH_M_NORM, layer); LAUNCH(PH_M_SEL, layer); LAUNCH(PH_M_GATHER, layer); LAUNCH(PH_M_G1, layer); LAUNCH(PH_M_G2, layer); LAUNCH(PH_M_COMB, layer);
    }
    LAUNCH(PH_FINAL, 0);
#endif
}
```

```cpp
#include <hip/hip_runtime.h>
#include <stdint.h>
#include <stdio.h>

#ifndef ONE_LAUNCH
#define ONE_LAUNCH 1
#endif

#define NTHR 512
typedef unsigned short bf16_t;
typedef short bf16x8 __attribute__((ext_vector_type(8)));
typedef float f32x4 __attribute__((ext_vector_type(4)));
typedef unsigned u32x4 __attribute__((ext_vector_type(4)));

constexpr int D = 1024, NB = 4, TL = 4096, TC = 256, NLAT = NB * TL, NCTX = NB * TC, NROW = NLAT + NCTX;
constexpr int TK = TL + TC;
constexpr int NE = 16, FF = 1408, CAPL = 512, CAPC = 32, ESLOTS = NB * CAPL + NB * CAPC;
constexpr int EPAD = 2304;
constexpr float RMS_EPS = 1e-6f, LNX_EPS = 64e-5f;
constexpr float ATT_SCALE = 0.07216878364870322f;

constexpr size_t al256(size_t x) { return (x + 255) / 256 * 256; }
constexpr size_t OFF_BAR = 0;
constexpr size_t OFF_MOD = 16384;
constexpr size_t OFF_ROPE_C = OFF_MOD + al256(4 * 5 * 6144 * 4);
constexpr size_t OFF_ROPE_S = OFF_ROPE_C + al256(TL * 32 * 4);
constexpr size_t OFF_X = OFF_ROPE_S + al256(TL * 32 * 4);
constexpr size_t SZ_F32 = (size_t)NROW * D * 4, SZ_BF = (size_t)NROW * D * 2;
constexpr size_t OFF_VFIRST = OFF_X + SZ_F32;
constexpr size_t OFF_H = OFF_VFIRST + SZ_F32;
constexpr size_t SZ_WMLA = (size_t)(512 * 1024 + 1536 * 256 + 2048 * 256 + 1024 * 1024) * 2;
constexpr size_t WM_IN = 0, WM_UQ = (size_t)512 * 1024 * 2, WM_UKV = WM_UQ + (size_t)1536 * 256 * 2, WM_O = WM_UKV + (size_t)2048 * 256 * 2;
constexpr size_t SZ_WRW = (size_t)(3 * 1024 * 1024 + 4 * 256 * 1024 + 1024 * 1024 + 4096 * 256 + 2048 * 256) * 2;
constexpr size_t WR_RKV = 0, WR_L = (size_t)3 * 1024 * 1024 * 2, WR_O = WR_L + (size_t)4 * 256 * 1024 * 2, WR_B2 = WR_O + (size_t)1024 * 1024 * 2, WR_B3 = WR_B2 + (size_t)4096 * 256 * 2;
constexpr size_t OFF_WMLA = OFF_H + SZ_BF;
constexpr size_t OFF_WRW = OFF_WMLA + 2 * SZ_WMLA;
constexpr size_t OFF_W13T = OFF_WRW + 2 * SZ_WRW;
constexpr size_t OFF_W2T = OFF_W13T + (size_t)NE * 2816 * D * 2;
constexpr size_t OFF_S = OFF_W2T + (size_t)NE * D * FF * 2;
constexpr size_t OFF_Z = OFF_S;
constexpr size_t OFF_CQN = OFF_Z + al256((size_t)NROW * 512 * 4);
constexpr size_t OFF_CKVN = OFF_CQN + al256((size_t)NROW * 256 * 2);
constexpr size_t OFF_KR = OFF_CKVN + al256((size_t)NROW * 256 * 2);
constexpr size_t OFF_QRAW = OFF_KR + al256((size_t)NROW * 64 * 4);
constexpr size_t OFF_KVRAW = OFF_QRAW + al256((size_t)NROW * 1536 * 4);
constexpr size_t OFF_Q = OFF_KVRAW + al256((size_t)NROW * 2048 * 4);
constexpr size_t OFF_K = OFF_Q + al256((size_t)NB * 8 * TK * 192 * 2);
constexpr size_t OFF_V = OFF_K + al256((size_t)NB * 8 * TK * 192 * 2);
constexpr size_t OFF_O = OFF_V + al256((size_t)NB * 8 * TK * 128 * 2);
constexpr size_t END_MLA = OFF_O + SZ_BF;
constexpr size_t OFF_XS = OFF_S;
constexpr size_t OFF_RKV = OFF_XS + 6 * SZ_BF;
constexpr size_t OFF_W = OFF_RKV + 3 * SZ_F32;
constexpr size_t OFF_AV = OFF_W + 2 * SZ_F32;
constexpr size_t OFF_G = OFF_AV + 2 * SZ_F32;
constexpr size_t OFF_A2 = OFF_G + SZ_F32;
constexpr size_t OFF_A3 = OFF_A2 + al256((size_t)NROW * 256 * 2);
constexpr size_t END_RW = OFF_A3 + al256((size_t)NROW * 256 * 2);
constexpr size_t OFF_Y = OFF_XS;
constexpr size_t OFF_AFF = OFF_S;
constexpr size_t OFF_ROWIDX = OFF_AFF + al256((size_t)NROW * 16 * 4);
constexpr size_t OFF_GATE = OFF_ROWIDX + al256((size_t)NE * ESLOTS * 4);
constexpr size_t OFF_SLOT = OFF_GATE + al256((size_t)NE * EPAD * 4);
constexpr size_t OFF_XE = OFF_SLOT + al256((size_t)NROW * 16 * 4);
constexpr size_t OFF_HID = OFF_XE + al256((size_t)NE * EPAD * D * 2);
constexpr size_t OFF_YE = OFF_HID + al256((size_t)NE * EPAD * FF * 2);
constexpr size_t END_MOE = OFF_YE + al256((size_t)NE * EPAD * D * 2);
constexpr size_t WS_NEED = END_RW > END_MLA ? (END_RW > END_MOE ? END_RW : END_MOE) : (END_MLA > END_MOE ? END_MLA : END_MOE);

constexpr int LDS_BYTES = 131072;

struct Params {
    const float *x, *c, *ctx, *c_ctx, *mod_w, *mod_b, *norm1_g, *norm2_g, *final_g;
    const float *mla_w_in, *mla_g_q, *mla_g_kv, *mla_w_uq, *mla_w_ukv, *mla_w_o;
    const float *rw_mu, *rw_w_rkv, *rw_w0, *rw_w1, *rw_w2, *rw_a0, *rw_a1, *rw_a2, *rw_v0, *rw_v1, *rw_v2, *rw_g1, *rw_g2, *rw_k_k, *rw_k_a, *rw_r_k, *rw_lnx_g, *rw_lnx_b, *rw_w_o;
    const float *moe_router, *moe_w1, *moe_w3, *moe_w2;
    float* out; char* ws;
};

__device__ __forceinline__ int bidx() { int t = blockIdx.x; asm volatile("" : "+s"(t)); return t; }
__device__ __forceinline__ int gdim() { int t = gridDim.x; asm volatile("" : "+s"(t)); return t; }
__device__ __forceinline__ int tidx() { int t = threadIdx.x; asm volatile("" : "+v"(t)); return t; }
#define XB_TMO      128
#define XB_XCNT(j)  (256  + 64 * (j))
#define XB_XSUB(j)  (1280 + 64 * (j))
#define XB_XGEN(j)  (2304 + 64 * (j))
#define XB_TOP      3328
#define XB_TOPGEN   3392
#define XCD_BAR_WORDS 3456
#define XB_SPIN_CAP (1u << 22)
#define LAS __attribute__((address_space(3)))

__device__ __forceinline__ unsigned xb_ld(unsigned* p)              { return __hip_atomic_load(p, __ATOMIC_RELAXED, __HIP_MEMORY_SCOPE_AGENT); }
__device__ __forceinline__ unsigned xb_add(unsigned* p, unsigned v) { return __hip_atomic_fetch_add(p, v, __ATOMIC_RELAXED, __HIP_MEMORY_SCOPE_AGENT); }
__device__ __forceinline__ unsigned xb_xcc_id() { return (unsigned)__builtin_amdgcn_s_getreg((3 << 11) | 20) & 0xFu; }
#define XB_SPIN(cond, bar) do { unsigned _sp = 0; while (cond) { __builtin_amdgcn_s_sleep(1); \
    if ((++_sp & 255u) == 0u) { if (xb_ld(&(bar)[XB_TMO])) break; if (_sp > XB_SPIN_CAP) { atomicAdd(&(bar)[XB_TMO], 1u); break; } } } } while (0)

struct XcdBarrier { unsigned* bar; unsigned x; volatile LAS unsigned* st; };

__device__ __forceinline__ XcdBarrier xcd_barrier_post(unsigned* bar, volatile LAS unsigned* st) {
    XcdBarrier b; b.bar = bar; b.x = xb_xcc_id(); b.st = st;
    if (tidx() == 0) (void)xb_add(&bar[XB_XCNT(b.x)], 1u);
    return b;
}
__device__ __forceinline__ void xcd_barrier_complete(unsigned* bar, unsigned x, unsigned& nloc, unsigned& nx) {
    const unsigned G = gridDim.x * gridDim.y * gridDim.z;
    unsigned sum, cnt, mine, sp = 0u;
    for (;;) {
        sum = 0u; cnt = 0u; mine = 0u;
#pragma unroll
        for (unsigned j = 0; j < 16; ++j) { const unsigned c = xb_ld(&bar[XB_XCNT(j)]); sum += c; cnt += (c > 0u) ? 1u : 0u; mine = (j == x) ? c : mine; }
        if (sum == G) break;
        __builtin_amdgcn_s_sleep(1);
        if ((++sp & 255u) == 0u) { if (xb_ld(&bar[XB_TMO])) break; if (sp > XB_SPIN_CAP) { atomicAdd(&bar[XB_TMO], 1u); break; } }
    }
    nloc = mine > 0u ? mine : 1u; nx = cnt > 0u ? cnt : 1u;
}
__device__ __forceinline__ void xcd_barrier(const XcdBarrier& b) {
    asm volatile("s_waitcnt vmcnt(0)" ::: "memory");
    __syncthreads();
    if (tidx() == 0) {
        unsigned* bar = b.bar;
        __builtin_amdgcn_s_waitcnt(0);
        unsigned nloc = b.st[0], nx = b.st[1];
        if (nloc == 0u) { xcd_barrier_complete(bar, b.x, nloc, nx); b.st[0] = nloc; b.st[1] = nx; }
        const unsigned old = xb_add(&bar[XB_XSUB(b.x)], 1u);
        const unsigned gen = old / nloc;
        if (old + 1u == (gen + 1u) * nloc) {
            __builtin_amdgcn_fence(__ATOMIC_RELEASE, "agent");
            asm volatile("s_waitcnt vmcnt(0)" ::: "memory");
            const unsigned og = xb_add(&bar[XB_TOP], 1u);
            const unsigned tg = og / nx;
            if (og + 1u == (tg + 1u) * nx) xb_add(&bar[XB_TOPGEN], 1u);
            else XB_SPIN(xb_ld(&bar[XB_TOPGEN]) == tg, bar);
            __builtin_amdgcn_fence(__ATOMIC_ACQUIRE, "agent");
            xb_add(&bar[XB_XGEN(b.x)], 1u);
            asm volatile("s_waitcnt vmcnt(0)" ::: "memory");
        } else {
            XB_SPIN(xb_ld(&bar[XB_XGEN(b.x)]) == gen, bar);
            __builtin_amdgcn_fence(__ATOMIC_ACQUIRE, "agent");
            asm volatile("s_waitcnt vmcnt(0)" ::: "memory");
        }
    }
    __syncthreads();
}

__device__ __forceinline__ bf16_t f2bf(float f) { unsigned u = __float_as_uint(f); u += 0x7FFFu + ((u >> 16) & 1u); return (bf16_t)(u >> 16); }
__device__ __forceinline__ float bf2f(bf16_t b) { return __uint_as_float(((unsigned)b) << 16); }
__device__ __forceinline__ unsigned pk2(float lo, float hi) { return (unsigned)f2bf(lo) | ((unsigned)f2bf(hi) << 16); }
__device__ __forceinline__ float dpp_sum16(float x) {
    x += __builtin_bit_cast(float, __builtin_amdgcn_update_dpp(0, __builtin_bit_cast(int, x), 0xB1, 0xF, 0xF, true));
    x += __builtin_bit_cast(float, __builtin_amdgcn_update_dpp(0, __builtin_bit_cast(int, x), 0x4E, 0xF, 0xF, true));
    x += __builtin_bit_cast(float, __builtin_amdgcn_update_dpp(0, __builtin_bit_cast(int, x), 0x141, 0xF, 0xF, true));
    x += __builtin_bit_cast(float, __builtin_amdgcn_update_dpp(0, __builtin_bit_cast(int, x), 0x140, 0xF, 0xF, true));
    return x;
}
__device__ __forceinline__ float wave_sum(float v) {
    v = dpp_sum16(v); const int i = __builtin_bit_cast(int, v);
    return __builtin_bit_cast(float, __builtin_amdgcn_readlane(i, 0)) + __builtin_bit_cast(float, __builtin_amdgcn_readlane(i, 16)) + __builtin_bit_cast(float, __builtin_amdgcn_readlane(i, 32)) + __builtin_bit_cast(float, __builtin_amdgcn_readlane(i, 48));
}
__device__ __forceinline__ float sigmoidf_(float x) { return 1.f / (1.f + expf(-x)); }
__device__ __forceinline__ int row_stream(int row) { return row < NLAT ? (row >> 12) : 4; }
__device__ __forceinline__ const float* modp(const Params& p, int layer, int s, int part) { return (const float*)(p.ws + OFF_MOD) + ((size_t)layer * 5 + s) * 6144 + part * 1024; }

struct SgArgs { const bf16_t* A; int lda; size_t strideA; const float* B; int ldb; size_t strideB; int M, N, K, nbatch; };
template <class Epi>
__device__ __forceinline__ void sg_gemm(char* lds, const SgArgs g, const Epi& epi) {
    bf16_t* As = (bf16_t*)lds;
    bf16_t* Bs = As + 128 * 40;
    const int tid = tidx(), wid = tid >> 6, lane = tid & 63;
    const int wr = wid >> 2, wc = wid & 3;
    const int tilesN = (g.N + 127) / 128, tilesM = g.M / 128, per = tilesM * tilesN, ntiles = per * g.nbatch;
    const int ar = tid >> 2, ak = (tid & 3) * 8;
    const int bn = tid & 127, bk = (tid >> 7) * 8;
    for (int tile = bidx(); tile < ntiles; tile += gdim()) {
        const int bt = tile / per, tt = tile % per;
        const int tm = tt / tilesN, tn = tt % tilesN;
        const int m0 = tm * 128, n0 = tn * 128;
        f32x4 acc[4][2];
#pragma unroll
        for (int m = 0; m < 4; ++m)
#pragma unroll
            for (int n = 0; n < 2; ++n) acc[m][n] = (f32x4){0.f, 0.f, 0.f, 0.f};
        const bool bvalid = (n0 + bn) < g.N;
        const bf16_t* ap = g.A + bt * g.strideA + (size_t)(m0 + ar) * g.lda + ak;
        const float* bp = g.B + bt * g.strideB + (size_t)bk * g.ldb + n0 + bn;
        bf16x8 areg; float breg[8];
        areg = *(const bf16x8*)ap;
#pragma unroll
        for (int j = 0; j < 8; ++j) breg[j] = bvalid ? bp[(size_t)j * g.ldb] : 0.f;
        for (int k0 = 0; k0 < g.K; k0 += 32) {
            __syncthreads();
            *(bf16x8*)(As + ar * 40 + ak) = areg;
            { u32x4 w; w.x = pk2(breg[0], breg[1]); w.y = pk2(breg[2], breg[3]); w.z = pk2(breg[4], breg[5]); w.w = pk2(breg[6], breg[7]); *(u32x4*)(Bs + bn * 40 + bk) = w; }
            __syncthreads();
            if (k0 + 32 < g.K) {
                areg = *(const bf16x8*)(ap + k0 + 32);
#pragma unroll
                for (int j = 0; j < 8; ++j) breg[j] = bvalid ? bp[(size_t)(k0 + 32 + j) * g.ldb] : 0.f;
            }
            bf16x8 af[4], bfr[2];
#pragma unroll
            for (int m = 0; m < 4; ++m) af[m] = *(const bf16x8*)(As + (wr * 64 + m * 16 + (lane & 15)) * 40 + (lane >> 4) * 8);
#pragma unroll
            for (int n = 0; n < 2; ++n) bfr[n] = *(const bf16x8*)(Bs + (wc * 32 + n * 16 + (lane & 15)) * 40 + (lane >> 4) * 8);
#pragma unroll
            for (int m = 0; m < 4; ++m)
#pragma unroll
                for (int n = 0; n < 2; ++n) acc[m][n] = __builtin_amdgcn_mfma_f32_16x16x32_bf16(af[m], bfr[n], acc[m][n], 0, 0, 0);
        }
#pragma unroll
        for (int m = 0; m < 4; ++m)
#pragma unroll
            for (int n = 0; n < 2; ++n) {
                const int col = n0 + wc * 32 + n * 16 + (lane & 15);
                if (col < g.N) {
#pragma unroll
                    for (int r = 0; r < 4; ++r) epi(bt, m0 + wr * 64 + m * 16 + (lane >> 4) * 4 + r, col, acc[m][n][r]);
                }
            }
    }
}


namespace g8 {
#define PG8_LAS __attribute__((address_space(3)))
constexpr int BM = 256, BK = 64, HALF = 128, HTB = HALF * BK * 2, STAGE_BYTES = 8 * HTB;
__device__ __forceinline__ int lds_byte(int r, int c) { const int st = (r >> 4) * 2 + (c >> 5), rr = r & 15, cc = c & 31, ob = rr * 64 + cc * 2; return st * 1024 + (ob ^ (((ob >> 9) & 1) << 5)); }
__device__ __forceinline__ void stage_rc(int b, int& R, int& C) { const int st = b / 1024, sb = b % 1024, swz = sb ^ (((sb >> 9) & 1) << 5); R = (st >> 1) * 16 + swz / 64; C = (st & 1) * 32 + (swz % 64) / 2; }
struct Unit { int pm, pn, g; const char* A; const char* B; };
__device__ __forceinline__ int xcd_remap(int L, int nwg) { const int q = nwg / 8, r = nwg % 8, xcd = L % 8, off = L / 8; return (xcd < r ? xcd * (q + 1) : r * (q + 1) + (xcd - r) * q) + off; }

template <class Epi, class Sched>
__device__ __forceinline__ void gemm_phase(PG8_LAS unsigned char* lds, const int K, const Sched& S, const Epi& E) {
    const int tid = tidx(), wid = __builtin_amdgcn_readfirstlane(tid >> 6), lane = tid & 63, wr = wid >> 2, wc = wid & 3, fr = lane & 15, fq = lane >> 4;
    const int nt = K / BK;
    unsigned voffA[2];
#pragma unroll
    for (int i = 0; i < 2; ++i) { int R, C; stage_rc(tid * 16 + i * 8192, R, C); voffA[i] = (unsigned)(R * K + C) * 2u; }
    const size_t kstep = (size_t)(BK * 2);
    const size_t hstep = (size_t)HALF * K * 2;
    const unsigned ldsw = (unsigned)wid * 1024u;
    const int aoff = lds_byte(wr * 64 + fr, fq * 8), boff = lds_byte(wc * 32 + fr, fq * 8);
#define PG8_SA(b, h) (((b) * 2 + (h)) * HTB)
#define PG8_SB(b, h) ((4 + (b) * 2 + (h)) * HTB)
#define PG8_STAGE(bufoff, gbase, voff) do { _Pragma("unroll") for (int _i = 0; _i < 2; ++_i) \
        __builtin_amdgcn_global_load_lds((const unsigned*)((const char*)(gbase) + (voff)[_i]), (PG8_LAS unsigned*)(lds + (bufoff) + ldsw + _i * 8192), 16, 0, 0); } while (0)
#define PG8_LDA(dst, b, h) do { _Pragma("unroll") for (int m = 0; m < 4; ++m) _Pragma("unroll") for (int k = 0; k < 2; ++k) dst[m][k] = *(const PG8_LAS bf16x8*)(lds + PG8_SA(b, h) + aoff + m * 2048 + k * 1024); } while (0)
#define PG8_LDB(dst, b, h) do { _Pragma("unroll") for (int n = 0; n < 2; ++n) _Pragma("unroll") for (int k = 0; k < 2; ++k) dst[n][k] = *(const PG8_LAS bf16x8*)(lds + PG8_SB(b, h) + boff + n * 2048 + k * 1024); } while (0)
#define PG8_MMA(ai, bj, At, Bt) do { __builtin_amdgcn_s_setprio(1); _Pragma("unroll") for (int m = 0; m < 4; ++m) _Pragma("unroll") for (int n = 0; n < 2; ++n) _Pragma("unroll") for (int k = 0; k < 2; ++k) \
        acc[ai][bj][m][n] = __builtin_amdgcn_mfma_f32_16x16x32_bf16(Bt[n][k], At[m][k], acc[ai][bj][m][n], 0, 0, 0); __builtin_amdgcn_s_setprio(0); } while (0)
#define PG8_WAIT_V(n) asm volatile("s_waitcnt vmcnt(" #n ")" ::: "memory")
#define PG8_WAIT_L(n) asm volatile("s_waitcnt lgkmcnt(" #n ")" ::: "memory")
#define PG8_BAR __builtin_amdgcn_s_barrier()
#define PG8_SCHED __builtin_amdgcn_sched_barrier(0)
    Unit cur, nxt; int ui = 0;
    if (!S.next(0, cur)) return;
    f32x4 acc[2][2][4][2];
#pragma unroll
    for (int a = 0; a < 2; ++a)
#pragma unroll
        for (int b = 0; b < 2; ++b)
#pragma unroll
            for (int m = 0; m < 4; ++m)
#pragma unroll
                for (int n = 0; n < 2; ++n) acc[a][b][m][n] = (f32x4){0.f, 0.f, 0.f, 0.f};
    bf16x8 At[4][2], B0[2][2], B1[2][2];
    const char* cA = cur.A; const char* cB = cur.B;
    PG8_STAGE(PG8_SB(0, 0), cB, voffA); PG8_STAGE(PG8_SA(0, 0), cA, voffA); PG8_STAGE(PG8_SB(0, 1), cB + hstep, voffA); PG8_STAGE(PG8_SA(0, 1), cA + hstep, voffA);
    if (wr == 1) PG8_BAR;
    PG8_WAIT_V(4); PG8_BAR;
    PG8_STAGE(PG8_SB(1, 0), cB + kstep, voffA); PG8_STAGE(PG8_SA(1, 0), cA + kstep, voffA); PG8_STAGE(PG8_SB(1, 1), cB + hstep + kstep, voffA);
    PG8_WAIT_V(6); PG8_BAR;
    for (;;) {
        const bool has_next = S.next(ui + 1, nxt);
        const char* nA = has_next ? nxt.A : cA; const char* nB = has_next ? nxt.B : cB;
        for (int t = 0; t < nt; t += 2) {
            const bool last = (t == nt - 2);
            const char* a1 = cA + (size_t)(t + 1) * kstep;
            const char* a2 = last ? nA : cA + (size_t)(t + 2) * kstep; const char* b2 = last ? nB : cB + (size_t)(t + 2) * kstep;
            const char* a3 = a2 + kstep; const char* b3 = b2 + kstep;
            PG8_LDB(B0, 0, 0); PG8_SCHED; PG8_LDA(At, 0, 0); PG8_STAGE(PG8_SA(1, 1), a1 + hstep, voffA);
            PG8_WAIT_L(8); PG8_BAR; PG8_WAIT_L(0); PG8_MMA(0, 0, At, B0); PG8_BAR; PG8_SCHED;
            PG8_LDB(B1, 0, 1); PG8_STAGE(PG8_SB(0, 0), b2, voffA);
            PG8_BAR; PG8_WAIT_L(0); PG8_MMA(0, 1, At, B1); PG8_BAR;
            PG8_LDA(At, 0, 1); PG8_STAGE(PG8_SA(0, 0), a2, voffA);
            PG8_BAR; PG8_WAIT_L(0); PG8_MMA(1, 0, At, B0); PG8_BAR; PG8_SCHED;
            PG8_STAGE(PG8_SB(0, 1), b2 + hstep, voffA);
            PG8_WAIT_V(6); PG8_BAR; PG8_MMA(1, 1, At, B1); PG8_BAR;
            PG8_LDB(B0, 1, 0); PG8_SCHED; PG8_LDA(At, 1, 0); PG8_STAGE(PG8_SA(0, 1), a2 + hstep, voffA);
            PG8_WAIT_L(8); PG8_BAR; PG8_WAIT_L(0); PG8_MMA(0, 0, At, B0); PG8_BAR; PG8_SCHED;
            PG8_LDB(B1, 1, 1); PG8_STAGE(PG8_SB(1, 0), b3, voffA);
            PG8_BAR; PG8_WAIT_L(0); PG8_MMA(0, 1, At, B1); PG8_BAR;
            PG8_LDA(At, 1, 1); PG8_STAGE(PG8_SA(1, 0), a3, voffA);
            PG8_BAR; PG8_WAIT_L(0); PG8_MMA(1, 0, At, B0); PG8_BAR; PG8_SCHED;
            PG8_STAGE(PG8_SB(1, 1), b3 + hstep, voffA);
            PG8_WAIT_V(6); PG8_BAR; PG8_MMA(1, 1, At, B1); PG8_BAR;
        }
        E(acc, cur, wr, wc, fr, fq);
        if (!has_next) break;
#pragma unroll
        for (int a = 0; a < 2; ++a)
#pragma unroll
            for (int b = 0; b < 2; ++b)
#pragma unroll
                for (int m = 0; m < 4; ++m)
#pragma unroll
                    for (int n = 0; n < 2; ++n) acc[a][b][m][n] = (f32x4){0.f, 0.f, 0.f, 0.f};
        cur = nxt; cA = nA; cB = nB; ++ui;
    }
    PG8_WAIT_V(0);
    if (wr == 0) PG8_BAR;
    PG8_BAR;
#undef PG8_SA
#undef PG8_SB
#undef PG8_STAGE
#undef PG8_LDA
#undef PG8_LDB
#undef PG8_MMA
#undef PG8_WAIT_V
#undef PG8_WAIT_L
#undef PG8_BAR
#undef PG8_SCHED
}
template <class F> struct EpiRC { F f;
    __device__ __forceinline__ void operator()(const f32x4 (&acc)[2][2][4][2], const Unit& u, int wr, int wc, int fr, int fq) const {
#pragma unroll
        for (int ai = 0; ai < 2; ++ai)
#pragma unroll
            for (int m = 0; m < 4; ++m) { const int row = u.pm * BM + ai * HALF + wr * 64 + m * 16 + fr;
#pragma unroll
                for (int bj = 0; bj < 2; ++bj)
#pragma unroll
                    for (int n = 0; n < 2; ++n) f(u, row, u.pn * BM + bj * HALF + wc * 32 + n * 16 + 4 * fq, acc[ai][bj][m][n]);
                asm volatile("" ::: "memory"); }
    } };
template <class F> __device__ __forceinline__ EpiRC<F> epi_rc(const F& f) { return EpiRC<F>{f}; }
template <class F> struct EpiPair { F f;
    __device__ __forceinline__ void operator()(const f32x4 (&acc)[2][2][4][2], const Unit& u, int wr, int wc, int fr, int fq) const {
#pragma unroll
        for (int ai = 0; ai < 2; ++ai)
#pragma unroll
            for (int m = 0; m < 4; ++m) { const int row = u.pm * BM + ai * HALF + wr * 64 + m * 16 + fr;
#pragma unroll
                for (int n = 0; n < 2; ++n) f(u, row, u.pn * HALF + wc * 32 + n * 16 + 4 * fq, acc[ai][0][m][n], acc[ai][1][m][n]);
                asm volatile("" ::: "memory"); }
    } };
template <class F> __device__ __forceinline__ EpiPair<F> epi_pair(const F& f) { return EpiPair<F>{f}; }
struct BatchSched { const char* A; const char* B; size_t strideA, strideB; int nM, nN, nb, K;
    __device__ __forceinline__ bool next(int i, Unit& u) const {
        const int nwg = nM * nN * nb; const int L = i * gdim() + bidx(); if (L >= nwg) return false;
        const int w = xcd_remap(L, nwg); const int per = nM * nN; u.g = w / per; const int r = w % per; u.pm = r / nN; u.pn = r % nN;
        u.A = A + u.g * strideA + (size_t)u.pm * BM * K * 2; u.B = B + u.g * strideB + (size_t)u.pn * BM * K * 2; return true; } };
}

template <class SrcF, class DRow>
__device__ __forceinline__ void cvt_tiles(char* lds, bf16_t* dst, int Kd, int Nd, int nbatch, size_t dstride, const SrcF& src, const DRow& drow) {
    bf16_t* T = (bf16_t*)lds;
    const int tid = tidx();
    const int tk = Kd / 128, tn = Nd / 64, per = tk * tn, total = per * nbatch;
    for (int t = bidx(); t < total; t += gdim()) {
        const int bt = t / per, r = t % per, k0 = (r % tk) * 128, n0 = (r / tk) * 64;
        float4 v[4];
#pragma unroll
        for (int i = 0; i < 4; ++i) { const int k = k0 + i * 32 + (tid >> 4), n = n0 + (tid & 15) * 4; const float* sp = src(bt, k, n); v[i] = sp ? *(const float4*)sp : make_float4(0.f, 0.f, 0.f, 0.f); }
        __syncthreads();
#pragma unroll
        for (int i = 0; i < 4; ++i) { const int k = i * 32 + (tid >> 4), n = (tid & 15) * 4;
            T[(n + 0) * 136 + k] = f2bf(v[i].x); T[(n + 1) * 136 + k] = f2bf(v[i].y); T[(n + 2) * 136 + k] = f2bf(v[i].z); T[(n + 3) * 136 + k] = f2bf(v[i].w); }
        __syncthreads();
        { const int n = tid >> 3, kc = (tid & 7) * 16;
          const u32x4 a = *(const u32x4*)(T + n * 136 + kc), b = *(const u32x4*)(T + n * 136 + kc + 8);
          bf16_t* dp = dst + bt * dstride + (size_t)drow(n0 + n) * Kd + k0 + kc;
          *(u32x4*)dp = a; *(u32x4*)(dp + 8) = b; }
    }
}
__device__ void ph_moe_cvt(const Params& p, int layer, char* lds) {
    const float* w1 = p.moe_w1 + (size_t)layer * NE * D * FF; const float* w3 = p.moe_w3 + (size_t)layer * NE * D * FF; const float* w2 = p.moe_w2 + (size_t)layer * NE * FF * D;
    cvt_tiles(lds, (bf16_t*)(p.ws + OFF_W13T), D, 2816, NE, (size_t)2816 * D,
        [=](int e, int k, int n) -> const float* { const int pn = n >> 8, half = (n >> 7) & 1, c = pn * 128 + (n & 127); return (half ? w3 : w1) + ((size_t)e * D + k) * FF + c; },
        [=](int n) { return n; });
    cvt_tiles(lds, (bf16_t*)(p.ws + OFF_W2T), FF, D, NE, (size_t)D * FF,
        [=](int e, int k, int n) -> const float* { return w2 + ((size_t)e * FF + k) * D + n; },
        [=](int n) { return n; });
}

__device__ void ph_init(const Params& p, char* lds) {
    const int tid = tidx(), gtid = bidx() * NTHR + tid, gsz = gdim() * NTHR;
    float4* X4 = (float4*)(p.ws + OFF_X);
    const float4* x4 = (const float4*)p.x; const float4* c4 = (const float4*)p.ctx;
    for (int i = gtid; i < NROW * 256; i += gsz) X4[i] = i < NLAT * 256 ? x4[i] : c4[i - NLAT * 256];
    float* rc = (float*)(p.ws + OFF_ROPE_C); float* rs = (float*)(p.ws + OFF_ROPE_S);
    for (int i = gtid; i < TL * 32; i += gsz) {
        const int t = i >> 5, f = i & 31; const float pos = (float)((f < 16) ? (t >> 6) : (t & 63));
        const float inv = powf(10000.f, -(float)(f & 15) / 16.f); const float ang = pos * inv; rc[i] = cosf(ang); rs[i] = sinf(ang);
    }
    float* sc = (float*)lds;
    float* red = sc + 5 * 1024;
    for (int i = tid; i < 5 * 1024; i += NTHR) { const float v = i < 4096 ? p.c[i] : p.c_ctx[i - 4096]; sc[i] = v / (1.f + expf(-v)); }
    __syncthreads();
    float* MOD = (float*)(p.ws + OFF_MOD);
    for (int item = bidx(); item < 4 * 96; item += gdim()) {
        const int l = item / 96, cg = item % 96, col = tid & 63, n = cg * 64 + col, kg = tid >> 6;
        const float* w = p.mod_w + ((size_t)l * 1024 + kg * 128) * 6144 + n;
        float a0 = 0, a1 = 0, a2 = 0, a3 = 0, a4 = 0;
        for (int k = 0; k < 128; ++k) { const float wv = w[(size_t)k * 6144]; const int kk = kg * 128 + k;
            a0 += sc[kk] * wv; a1 += sc[1024 + kk] * wv; a2 += sc[2048 + kk] * wv; a3 += sc[3072 + kk] * wv; a4 += sc[4096 + kk] * wv; }
        float* rr = red + (kg * 64 + col) * 5; rr[0] = a0; rr[1] = a1; rr[2] = a2; rr[3] = a3; rr[4] = a4;
        __syncthreads();
        if (tid < 320) { const int c2 = tid & 63, s = tid >> 6; float sum = 0;
            for (int q = 0; q < 8; ++q) sum += red[(q * 64 + c2) * 5 + s];
            MOD[((size_t)l * 5 + s) * 6144 + cg * 64 + c2] = sum + p.mod_b[l * 6144 + cg * 64 + c2]; }
        __syncthreads();
    }
}


__device__ void ph_small_cvt(const Params& p, char* lds) {
    for (int j = 0; j < 2; ++j) {
        char* wm = p.ws + OFF_WMLA + j * SZ_WMLA; char* wr = p.ws + OFF_WRW + j * SZ_WRW;
        const float* w_in = p.mla_w_in + (size_t)j * D * 448; const float* w_uq = p.mla_w_uq + (size_t)j * 256 * 1536; const float* w_ukv = p.mla_w_ukv + (size_t)j * 128 * 2048; const float* w_o = p.mla_w_o + (size_t)j * D * D;
        cvt_tiles(lds, (bf16_t*)(wm + WM_IN), 1024, 512, 1, 0, [=](int, int k, int n) -> const float* { return n < 448 ? w_in + (size_t)k * 448 + n : nullptr; }, [=](int n) { return n; });
        cvt_tiles(lds, (bf16_t*)(wm + WM_UQ), 256, 1536, 1, 0, [=](int, int k, int n) -> const float* { return w_uq + (size_t)k * 1536 + n; }, [=](int n) { return n; });
        cvt_tiles(lds, (bf16_t*)(wm + WM_UKV), 256, 2048, 1, 0, [=](int, int k, int n) -> const float* { return k < 128 ? w_ukv + (size_t)k * 2048 + n : nullptr; }, [=](int n) { return n; });
        cvt_tiles(lds, (bf16_t*)(wm + WM_O), 1024, 1024, 1, 0, [=](int, int k, int n) -> const float* { return w_o + (size_t)k * D + n; }, [=](int n) { return n; });
        const float* w_rkv = p.rw_w_rkv + (size_t)j * 3 * D * D; const float* w1 = p.rw_w1 + (size_t)j * 2 * D * 64; const float* a1 = p.rw_a1 + (size_t)j * 2 * D * 64;
        const float* g1 = p.rw_g1 + (size_t)j * D * 128; const float* v1 = p.rw_v1; const float* rwo = p.rw_w_o + (size_t)j * D * D;
        cvt_tiles(lds, (bf16_t*)(wr + WR_RKV), 1024, 1024, 3, (size_t)D * D, [=](int m, int k, int n) -> const float* { return w_rkv + ((size_t)m * D + k) * D + n; }, [=](int n) { return n; });
        cvt_tiles(lds, (bf16_t*)(wr + WR_L), 1024, 256, 1, 0, [=](int, int k, int n) -> const float* { return n < 128 ? w1 + ((size_t)(n >> 6) * D + k) * 64 + (n & 63) : nullptr; }, [=](int n) { return n; });
        cvt_tiles(lds, (bf16_t*)(wr + WR_L) + 256 * 1024, 1024, 256, 1, 0, [=](int, int k, int n) -> const float* { return n < 128 ? a1 + ((size_t)(n >> 6) * D + k) * 64 + (n & 63) : nullptr; }, [=](int n) { return n; });
        cvt_tiles(lds, (bf16_t*)(wr + WR_L) + 2 * 256 * 1024, 1024, 256, 1, 0, [=](int, int k, int n) -> const float* { return n < 128 ? g1 + (size_t)k * 128 + n : nullptr; }, [=](int n) { return n; });
        cvt_tiles(lds, (bf16_t*)(wr + WR_L) + 3 * 256 * 1024, 1024, 256, 1, 0, [=](int, int k, int n) -> const float* { return n < 32 ? v1 + (size_t)k * 32 + n : nullptr; }, [=](int n) { return n; });
        cvt_tiles(lds, (bf16_t*)(wr + WR_O), 1024, 1024, 1, 0, [=](int, int k, int n) -> const float* { return rwo + (size_t)k * D + n; }, [=](int n) { return n; });
        const float* w2 = p.rw_w2 + (size_t)j * 2 * 64 * D; const float* a2 = p.rw_a2 + (size_t)j * 2 * 64 * D; const float* g2 = p.rw_g2 + (size_t)j * 128 * D; const float* v2 = p.rw_v2;
        cvt_tiles(lds, (bf16_t*)(wr + WR_B2), 256, 4096, 1, 0, [=](int, int k, int n) -> const float* { const int blk = n >> 10, c = n & 1023, l = k - blk * 64;
            if (l < 0 || l >= 64) return nullptr; return (blk < 2 ? w2 + ((size_t)blk * 64 + l) * D : a2 + ((size_t)(blk - 2) * 64 + l) * D) + c; }, [=](int n) { return n; });
        cvt_tiles(lds, (bf16_t*)(wr + WR_B3), 256, 2048, 1, 0, [=](int, int k, int n) -> const float* {
            if (n < 1024) return k < 128 ? g2 + (size_t)k * D + n : nullptr; return (k >= 128 && k < 160) ? v2 + (size_t)(k - 128) * D + (n - 1024) : nullptr; }, [=](int n) { return n; });
    }
}

template <bool OUTF32>
__device__ void ph_norm_mod(const Params& p, int layer, const float* g, int part_sh, int part_sc, void* outp) {
    const int wid = tidx() >> 6, lane = tidx() & 63;
    const float* X = (const float*)(p.ws + OFF_X);
    for (int row = bidx() * 8 + wid; row < NROW; row += gdim() * 8) {
        const int s = row_stream(row);
        const float* sh = modp(p, layer, s, part_sh); const float* sc = modp(p, layer, s, part_sc);
        const float4* xr = (const float4*)(X + (size_t)row * D);
        float4 v[4]; float ss = 0;
#pragma unroll
        for (int i = 0; i < 4; ++i) { v[i] = xr[lane + i * 64]; ss += v[i].x * v[i].x + v[i].y * v[i].y + v[i].z * v[i].z + v[i].w * v[i].w; }
        ss = wave_sum(ss); const float rs = rsqrtf(ss * (1.f / D) + RMS_EPS);
#pragma unroll
        for (int i = 0; i < 4; ++i) {
            const int d = (lane + i * 64) * 4;
            const float4 gg = *(const float4*)(g + d), a = *(const float4*)(sc + d), b = *(const float4*)(sh + d);
            float4 o; o.x = v[i].x * rs * gg.x * (1.f + a.x) + b.x; o.y = v[i].y * rs * gg.y * (1.f + a.y) + b.y; o.z = v[i].z * rs * gg.z * (1.f + a.z) + b.z; o.w = v[i].w * rs * gg.w * (1.f + a.w) + b.w;
            if (OUTF32) *(float4*)((float*)outp + (size_t)row * D + d) = o;
            else { uint2 w; w.x = pk2(o.x, o.y); w.y = pk2(o.z, o.w); *(uint2*)((bf16_t*)outp + (size_t)row * D + d) = w; }
        }
    }
}

__device__ void ph_mla_mid(const Params& p, int j) {
    const int wid = tidx() >> 6, lane = tidx() & 63;
    const float* Z = (const float*)(p.ws + OFF_Z);
    bf16_t* CQN = (bf16_t*)(p.ws + OFF_CQN); bf16_t* CKVN = (bf16_t*)(p.ws + OFF_CKVN); float* KR = (float*)(p.ws + OFF_KR);
    const float* gq = p.mla_g_q + j * 256; const float* gkv = p.mla_g_kv + j * 128;
    const float* rc = (const float*)(p.ws + OFF_ROPE_C); const float* rs = (const float*)(p.ws + OFF_ROPE_S);
    for (int row = bidx() * 8 + wid; row < NROW; row += gdim() * 8) {
        const float* z = Z + (size_t)row * 512;
        const float4 q = *(const float4*)(z + lane * 4);
        const float2 kv = *(const float2*)(z + 256 + lane * 2);
        const float kr = z[384 + lane];
        float sq = wave_sum(q.x * q.x + q.y * q.y + q.z * q.z + q.w * q.w); const float rq = rsqrtf(sq * (1.f / 256.f) + RMS_EPS);
        float sk = wave_sum(kv.x * kv.x + kv.y * kv.y); const float rk = rsqrtf(sk * (1.f / 128.f) + RMS_EPS);
        const float4 g4 = *(const float4*)(gq + lane * 4); const float2 g2 = *(const float2*)(gkv + lane * 2);
        uint2 w; w.x = pk2(q.x * rq * g4.x, q.y * rq * g4.y); w.y = pk2(q.z * rq * g4.z, q.w * rq * g4.w);
        *(uint2*)(CQN + (size_t)row * 256 + lane * 4) = w;
        *(unsigned*)(CKVN + (size_t)row * 256 + lane * 2) = pk2(kv.x * rk * g2.x, kv.y * rk * g2.y);
        *(unsigned*)(CKVN + (size_t)row * 256 + 128 + lane * 2) = 0u;
        float o = kr;
        const auto sw = __builtin_amdgcn_permlane32_swap(__float_as_uint(kr), __float_as_uint(kr), false, false);
        if (row < NLAT) { const int t = row & (TL - 1), i = lane & 31; const float c = rc[t * 32 + i], s = rs[t * 32 + i];
            const float x1 = __uint_as_float(sw[0]), x2 = __uint_as_float(sw[1]);
            o = lane < 32 ? (x1 * c - x2 * s) : (x1 * s + x2 * c); }
        KR[(size_t)row * 64 + lane] = o;
    }
}

__device__ void ph_qkv_post(const Params& p) {
    const int wid = tidx() >> 6, lane = tidx() & 63;
    const float* QRAW = (const float*)(p.ws + OFF_QRAW); const float* KVRAW = (const float*)(p.ws + OFF_KVRAW); const float* KR = (const float*)(p.ws + OFF_KR);
    bf16_t* Q = (bf16_t*)(p.ws + OFF_Q); bf16_t* K = (bf16_t*)(p.ws + OFF_K); bf16_t* V = (bf16_t*)(p.ws + OFF_V);
    const float* rc = (const float*)(p.ws + OFF_ROPE_C); const float* rs = (const float*)(p.ws + OFF_ROPE_S);
    for (int it = bidx() * 8 + wid; it < NROW * 8; it += gdim() * 8) {
        const int row = it >> 3, h = it & 7;
        const bool lat = row < NLAT; const int b = lat ? (row >> 12) : ((row - NLAT) >> 8); const int tk = lat ? 256 + (row & (TL - 1)) : ((row - NLAT) & 255);
        const size_t orow = (size_t)(b * 8 + h) * TK + tk;
        const float* q = QRAW + (size_t)row * 1536 + h * 192;
        const float q0 = q[lane], q1 = q[64 + lane]; float q2 = q[128 + lane];
        const auto sw = __builtin_amdgcn_permlane32_swap(__float_as_uint(q2), __float_as_uint(q2), false, false);
        if (lat) { const int t = row & (TL - 1), i = lane & 31; const float c = rc[t * 32 + i], s = rs[t * 32 + i];
            const float x1 = __uint_as_float(sw[0]), x2 = __uint_as_float(sw[1]); q2 = lane < 32 ? (x1 * c - x2 * s) : (x1 * s + x2 * c); }
        bf16_t* qo = Q + orow * 192; qo[lane] = f2bf(q0); qo[64 + lane] = f2bf(q1); qo[128 + lane] = f2bf(q2);
        const float* kv = KVRAW + (size_t)row * 2048 + h * 256;
        bf16_t* ko = K + orow * 192; ko[lane] = f2bf(kv[lane]); ko[64 + lane] = f2bf(kv[64 + lane]); ko[128 + lane] = f2bf(KR[(size_t)row * 64 + lane]);
        bf16_t* vo = V + orow * 128; vo[lane] = f2bf(kv[128 + lane]); vo[64 + lane] = f2bf(kv[192 + lane]);
    }
}

__device__ void ph_attn_naive(const Params& p, char* lds) {
    const int tid = tidx(), qi = tid >> 2, part = tid & 3;
    const bf16_t* Q = (const bf16_t*)(p.ws + OFF_Q); const bf16_t* K = (const bf16_t*)(p.ws + OFF_K); const bf16_t* V = (const bf16_t*)(p.ws + OFF_V);
    bf16_t* O = (bf16_t*)(p.ws + OFF_O);
    bf16_t* Ks = (bf16_t*)lds;
    bf16_t* Vs = Ks + 32 * 192;
    const int nitems = 32 * 34;
    for (int it = bidx(); it < nitems; it += gdim()) {
        const int bh = it / 34, qb = it % 34; const int b = bh >> 3, h = bh & 7;
        const int nkeys = qb < 2 ? TC : TK;
        const int tq = qb * 128 + qi;
        const bf16_t* qp = Q + ((size_t)bh * TK + tq) * 192 + part * 48;
        float q[48];
#pragma unroll
        for (int i = 0; i < 48; ++i) q[i] = bf2f(qp[i]) * ATT_SCALE;
        float o[32];
#pragma unroll
        for (int i = 0; i < 32; ++i) o[i] = 0.f;
        float m = -1e30f, l = 0.f;
        for (int k0 = 0; k0 < nkeys; k0 += 32) {
            __syncthreads();
            {
                const bf16_t* kg = K + ((size_t)bh * TK + k0) * 192; const bf16_t* vg = V + ((size_t)bh * TK + k0) * 128;
                for (int c = tid; c < 768; c += NTHR) *(u32x4*)(Ks + c * 8) = *(const u32x4*)(kg + c * 8);
                *(u32x4*)(Vs + tid * 8) = *(const u32x4*)(vg + tid * 8);
            }
            __syncthreads();
#pragma unroll 1
            for (int kg = 0; kg < 32; kg += 8) {
                float s[8]; float tmax = -1e30f;
#pragma unroll
                for (int kk = 0; kk < 8; ++kk) {
                    const bf16_t* kr = Ks + (kg + kk) * 192 + part * 48; float acc = 0.f;
#pragma unroll
                    for (int i = 0; i < 48; ++i) acc += q[i] * bf2f(kr[i]);
                    acc += __shfl_xor(acc, 1); acc += __shfl_xor(acc, 2);
                    s[kk] = acc; tmax = fmaxf(tmax, acc);
                    asm volatile("" ::: "memory");
                }
                const float mn = fmaxf(m, tmax), alpha = expf(m - mn); m = mn; l *= alpha;
#pragma unroll
                for (int i = 0; i < 32; ++i) o[i] *= alpha;
#pragma unroll
                for (int kk = 0; kk < 8; ++kk) {
                    const float pw = expf(s[kk] - mn); l += pw;
                    const bf16_t* vr = Vs + (kg + kk) * 128 + part * 32;
#pragma unroll
                    for (int i = 0; i < 32; ++i) o[i] += pw * bf2f(vr[i]);
                    asm volatile("" ::: "memory");
                }
            }
        }
        const float rl = 1.f / l;
        const int row = qb < 2 ? (NLAT + b * TC + tq) : (b * TL + tq - TC);
        bf16_t* op = O + (size_t)row * D + h * 128 + part * 32;
#pragma unroll
        for (int i = 0; i < 32; ++i) op[i] = f2bf(o[i] * rl);
    }
}


namespace fa {
using s16x4  = __attribute__((ext_vector_type(4))) short;
using f32x16 = __attribute__((ext_vector_type(16))) float;
constexpr int DQK = 192, DV = 128, KVBLK = 64;
constexpr float THR = 8.f;
constexpr int SHM_V = KVBLK * DV * 2, SHM_K = KVBLK * DQK * 2;
constexpr int SHM_ATTN = 2 * SHM_V + 2 * SHM_K + 8 * 64 * 4;
#define KSWZ(row, colB) ((row) * 384 + ((colB) ^ (((row) & 7) << 4)))
#define SBAR() __builtin_amdgcn_sched_barrier(0)
__device__ __forceinline__ int crow(int r, int hi) { return (r & 3) + 8 * (r >> 2) + 4 * hi; }
__device__ __forceinline__ unsigned cvtpk(float lo, float hi) { unsigned r; asm volatile("v_cvt_pk_bf16_f32 %0, %1, %2" : "=v"(r) : "v"(lo), "v"(hi)); return r; }
__device__ __forceinline__ void partialSM(f32x16& p0, f32x16& p1, float& m_reg, float& mn, float& alpha) {
  constexpr float C = ATT_SCALE * 1.4426950408889634f;
  float pmax = p0[0];
#pragma unroll
  for (int r = 1; r < 16; ++r) pmax = fmaxf(pmax, p0[r]);
#pragma unroll
  for (int r = 0; r < 16; ++r) pmax = fmaxf(pmax, p1[r]);
  { auto rr = __builtin_amdgcn_permlane32_swap(__float_as_uint(pmax), __float_as_uint(pmax), false, false);
    pmax = fmaxf(__uint_as_float(rr[0]), __uint_as_float(rr[1])); }
  if (__builtin_expect(__all(pmax - m_reg <= THR / ATT_SCALE), 1)) { mn = m_reg; alpha = 1.f; }
  else { mn = fmaxf(m_reg, pmax); alpha = __builtin_amdgcn_exp2f((m_reg - mn) * C); m_reg = mn; }
  float mnC = -mn * C;
#pragma unroll
  for (int r = 0; r < 16; ++r) p0[r] = fmaf(p0[r], C, mnC);
#pragma unroll
  for (int r = 0; r < 16; ++r) p1[r] = fmaf(p1[r], C, mnC);
#pragma unroll
  for (int r = 0; r < 16; ++r) p0[r] = __builtin_amdgcn_exp2f(p0[r]);
}
__device__ __forceinline__ void finishSM(f32x16& p0, f32x16& p1, float alpha, float& l_reg, bf16x8& pa0, bf16x8& pa1, bf16x8& pa2, bf16x8& pa3) {
#pragma unroll
  for (int r = 0; r < 16; ++r) p1[r] = __builtin_amdgcn_exp2f(p1[r]);
  float ps = 0;
#pragma unroll
  for (int r = 0; r < 16; ++r) ps += p0[r];
#pragma unroll
  for (int r = 0; r < 16; ++r) ps += p1[r];
  { auto rr = __builtin_amdgcn_permlane32_swap(__float_as_uint(ps), __float_as_uint(ps), false, false);
    ps = __uint_as_float(rr[0]) + __uint_as_float(rr[1]); }
  l_reg = l_reg * alpha + ps;
#define PK4(P, BASE, OUT) do { unsigned a0 = cvtpk(P[BASE + 0], P[BASE + 1]), a1 = cvtpk(P[BASE + 2], P[BASE + 3]);   \
    unsigned b0 = cvtpk(P[BASE + 4], P[BASE + 5]), b1 = cvtpk(P[BASE + 6], P[BASE + 7]);                              \
    auto r0 = __builtin_amdgcn_permlane32_swap(a0, b0, false, false); auto r1 = __builtin_amdgcn_permlane32_swap(a1, b1, false, false); \
    u32x4 w = {r0[0], r1[0], r0[1], r1[1]}; OUT = *reinterpret_cast<bf16x8*>(&w); } while (0)
  PK4(p0, 0, pa0); PK4(p0, 8, pa1); PK4(p1, 0, pa2); PK4(p1, 8, pa3);
#undef PK4
}
__device__ __forceinline__ void qkt(f32x16& p0, f32x16& p1, const char* Ks, const bf16x8* qr, int r32, int hi) {
  p0 = f32x16{}; p1 = f32x16{};
  const int swz = (r32 & 7) << 4;
  const char* b4[4];
#pragma unroll
  for (int dr = 0; dr < 4; ++dr) b4[dr] = Ks + r32 * 384 + ((dr * 32 + hi * 16) ^ swz);
#pragma unroll
  for (int d0 = 0; d0 < 12; ++d0) {
    bf16x8 b0 = *reinterpret_cast<const bf16x8*>(b4[d0 & 3] + (d0 >> 2) * 128);
    bf16x8 b1 = *reinterpret_cast<const bf16x8*>(b4[d0 & 3] + (d0 >> 2) * 128 + 32 * 384);
    p0 = __builtin_amdgcn_mfma_f32_32x32x16_bf16(b0, qr[d0], p0, 0, 0, 0);
    p1 = __builtin_amdgcn_mfma_f32_32x32x16_bf16(b1, qr[d0], p1, 0, 0, 0); }
}
__device__ __forceinline__ int v_st(int k, int c) { const int kk = (k & ~0xC) | ((k & 4) << 1) | ((k & 8) >> 1); return ((kk >> 3) * 4 + (c >> 5)) * 512 + ((kk & 7) * 32 + (c & 31)) * 2; }
__device__ __forceinline__ int v_rd_base(int lane) { return ((lane & 3) << 3) | (((lane >> 2) & 3) << 6) | (((lane >> 4) & 1) << 5) | (((lane >> 5) & 1) << 8); }
constexpr int v_rd_off(int d0, int ks, int half) { return d0 * 512 + ks * 4096 + half * 2048; }
template <int OFF> __device__ __forceinline__ s16x4 tr_read(int vb) {
  s16x4 r; asm volatile("ds_read_b64_tr_b16 %0, %1 offset:%2" : "=&v"(r) : "v"(vb), "i"(OFF) : "memory"); return r;
}
template <int D0> __device__ __forceinline__ void pv_one(f32x16& od, int vb, bf16x8 pa0, bf16x8 pa1, bf16x8 pa2, bf16x8 pa3) {
  const s16x4 l0 = tr_read<v_rd_off(D0, 0, 0)>(vb), h0 = tr_read<v_rd_off(D0, 0, 1)>(vb), l1 = tr_read<v_rd_off(D0, 1, 0)>(vb), h1 = tr_read<v_rd_off(D0, 1, 1)>(vb);
  const s16x4 l2 = tr_read<v_rd_off(D0, 2, 0)>(vb), h2 = tr_read<v_rd_off(D0, 2, 1)>(vb), l3 = tr_read<v_rd_off(D0, 3, 0)>(vb), h3 = tr_read<v_rd_off(D0, 3, 1)>(vb);
  asm volatile("s_waitcnt lgkmcnt(0)" ::: "memory"); SBAR();
#define PK(L, H) (bf16x8){L[0], L[1], L[2], L[3], H[0], H[1], H[2], H[3]}
  od = __builtin_amdgcn_mfma_f32_32x32x16_bf16(pa0, PK(l0, h0), od, 0, 0, 0);
  od = __builtin_amdgcn_mfma_f32_32x32x16_bf16(pa1, PK(l1, h1), od, 0, 0, 0);
  od = __builtin_amdgcn_mfma_f32_32x32x16_bf16(pa2, PK(l2, h2), od, 0, 0, 0);
  od = __builtin_amdgcn_mfma_f32_32x32x16_bf16(pa3, PK(l3, h3), od, 0, 0, 0);
#undef PK
}
__device__ __forceinline__ void pv_d0(f32x16* o, int vb, bf16x8 pa0, bf16x8 pa1, bf16x8 pa2, bf16x8 pa3) {
  pv_one<0>(o[0], vb, pa0, pa1, pa2, pa3); pv_one<1>(o[1], vb, pa0, pa1, pa2, pa3); pv_one<2>(o[2], vb, pa0, pa1, pa2, pa3); pv_one<3>(o[3], vb, pa0, pa1, pa2, pa3);
}
__device__ __forceinline__ void attn_body(const bf16_t* __restrict__ Qb, const bf16_t* __restrict__ Kh, const bf16_t* __restrict__ Vh, bf16_t* __restrict__ Ob, int ldo, int seq, char* lds) {
  const int tid = tidx(), wid = tid >> 6, lane = tid & 63, r32 = lane & 31, hi = lane >> 5;
  char* V_lds = lds; char* K_lds = lds + 2 * SHM_V;
  float* ws = (float*)(lds + 2 * SHM_V + 2 * SHM_K) + wid * 64; float* li_l = ws; float* al_l = ws + 32;
  float m_reg = -1e30f, l_reg = 0; f32x16 o[4] = {}; bf16x8 qr[12];
  const bf16_t* Qw = Qb + (long)(wid * 32 + r32) * DQK + hi * 8;
#pragma unroll
  for (int d0 = 0; d0 < 12; ++d0) qr[d0] = *reinterpret_cast<const bf16x8*>(Qw + d0 * 16);
  const int sr = tid >> 4, sc = (tid & 15) * 8, vst0 = v_st(sr, sc), vst1 = v_st(32 + sr, sc);
  int kst[3];
#pragma unroll
  for (int i = 0; i < 3; ++i) { const int c = tid + 512 * i, row = c / 24, cc = c % 24; kst[i] = KSWZ(row, cc * 16); }
  const int vb0 = (int)(uintptr_t)V_lds + v_rd_base(lane);
  struct { bf16x8 vs0, vs1, ks0, ks1, ks2; } sr_[1];
#define SLOAD(i, k0) do { const bf16_t* vt = Vh + (long)(k0) * DV; const bf16_t* kt = Kh + (long)(k0) * DQK; \
    sr_[i].vs0 = *reinterpret_cast<const bf16x8*>(vt + (sr) * DV + sc); sr_[i].vs1 = *reinterpret_cast<const bf16x8*>(vt + (32 + sr) * DV + sc); \
    sr_[i].ks0 = *reinterpret_cast<const bf16x8*>(kt + tid * 8); sr_[i].ks1 = *reinterpret_cast<const bf16x8*>(kt + (tid + 512) * 8); sr_[i].ks2 = *reinterpret_cast<const bf16x8*>(kt + (tid + 1024) * 8); } while (0)
#define SWRITE(b, i) do { *(bf16x8*)(V_lds + (b) * SHM_V + vst0) = sr_[i].vs0; *(bf16x8*)(V_lds + (b) * SHM_V + vst1) = sr_[i].vs1; \
    *(bf16x8*)(K_lds + (b) * SHM_K + kst[0]) = sr_[i].ks0; *(bf16x8*)(K_lds + (b) * SHM_K + kst[1]) = sr_[i].ks1; *(bf16x8*)(K_lds + (b) * SHM_K + kst[2]) = sr_[i].ks2; } while (0)
#define SWAIT() asm volatile("s_waitcnt vmcnt(5)" ::: "memory")
#define RESC(a) do { if (__any((a) < 1.f)) { if (hi == 0) al_l[r32] = (a); asm volatile("s_waitcnt lgkmcnt(0)" ::: "memory"); \
    _Pragma("unroll") for (int d = 0; d < 4; ++d) _Pragma("unroll") for (int r = 0; r < 16; ++r) o[d][r] *= al_l[crow(r, hi)]; } } while (0)
  f32x16 pA0, pA1; float mnA, alA; bf16x8 pa0, pa1, pa2, pa3; const int NT = seq / KVBLK;
  SLOAD(0, 0); SWRITE(0, 0);
  SLOAD(0, KVBLK);
  __syncthreads();
  for (int j = 0; j < NT; j += 2) {
    SBAR(); qkt(pA0, pA1, K_lds, qr, r32, hi);
    partialSM(pA0, pA1, m_reg, mnA, alA); RESC(alA);
    finishSM(pA0, pA1, alA, l_reg, pa0, pa1, pa2, pa3); SBAR();
    SWRITE(1, 0);
    if (j + 2 < NT) SLOAD(0, (j + 2) * KVBLK);
    SBAR();
    pv_d0(o, vb0, pa0, pa1, pa2, pa3);
    __syncthreads();
    SBAR(); qkt(pA0, pA1, K_lds + SHM_K, qr, r32, hi);
    partialSM(pA0, pA1, m_reg, mnA, alA); RESC(alA);
    finishSM(pA0, pA1, alA, l_reg, pa0, pa1, pa2, pa3); SBAR();
    if (j + 2 < NT) { SWRITE(0, 0); if (j + 3 < NT) SLOAD(0, (j + 3) * KVBLK); }
    SBAR();
    pv_d0(o, vb0 + SHM_V, pa0, pa1, pa2, pa3);
    __syncthreads();
  }
  if (hi == 0) li_l[r32] = l_reg; asm volatile("s_waitcnt lgkmcnt(0)" ::: "memory");
  float rli[16];
#pragma unroll
  for (int r = 0; r < 16; ++r) rli[r] = __builtin_amdgcn_rcpf(li_l[crow(r, hi)]);
  bf16_t* Ow = Ob + (long)(wid * 32) * ldo;
#pragma unroll
  for (int r = 0; r < 16; ++r) { int orow = crow(r, hi);
#pragma unroll
    for (int d0 = 0; d0 < 4; ++d0) Ow[(long)orow * ldo + d0 * 32 + r32] = f2bf(o[d0][r] * rli[r]); }
  __syncthreads();
#undef SLOAD
#undef SWRITE
#undef SWAIT
#undef RESC
}
#undef KSWZ
}

__device__ void ph_attn(const Params& p, char* lds) {
    const bf16_t* Q = (const bf16_t*)(p.ws + OFF_Q); const bf16_t* K = (const bf16_t*)(p.ws + OFF_K); const bf16_t* V = (const bf16_t*)(p.ws + OFF_V);
    bf16_t* O = (bf16_t*)(p.ws + OFF_O);
    const int G = gdim();
    for (int i = 0;; ++i) {
        const int L = i * G + bidx(); if (L >= 544) break;
        int bh, qb;
        if (L < 512) { const int w = g8::xcd_remap(L, 512); bh = w >> 4; qb = 1 + (w & 15); } else { bh = L - 512; qb = 0; }
        const int b = bh >> 3, h = bh & 7;
        const int seq = qb == 0 ? TC : TK;
        const int row0 = qb == 0 ? NLAT + b * TC : b * TL + (qb - 1) * 256;
        fa::attn_body(Q + ((size_t)bh * TK + qb * 256) * 192, K + (size_t)bh * TK * 192, V + (size_t)bh * TK * 128, O + (size_t)row0 * D + h * 128, D, seq, lds);
    }
}

__device__ void ph_norm2_router(const Params& p, int layer, char* lds) {
    const int tid = tidx(), wid = tid >> 6, lane = tid & 63;
    float* rt = (float*)lds;
    const float* rg = p.moe_router + (size_t)layer * D * NE;
    for (int i = tid; i < D * NE / 4; i += NTHR) ((float4*)rt)[i] = ((const float4*)rg)[i];
    __syncthreads();
    const float* X = (const float*)(p.ws + OFF_X); bf16_t* BN = (bf16_t*)(p.ws + OFF_H); float* AFF = (float*)(p.ws + OFF_AFF);
    const float* g = p.norm2_g + layer * D;
    for (int row = bidx() * 8 + wid; row < NROW; row += gdim() * 8) {
        const int s = row_stream(row);
        const float* sh = modp(p, layer, s, 3); const float* sc = modp(p, layer, s, 4);
        const float4* xr = (const float4*)(X + (size_t)row * D);
        float4 v[4]; float ss = 0;
#pragma unroll
        for (int i = 0; i < 4; ++i) { v[i] = xr[lane + i * 64]; ss += v[i].x * v[i].x + v[i].y * v[i].y + v[i].z * v[i].z + v[i].w * v[i].w; }
        ss = wave_sum(ss); const float rs = rsqrtf(ss * (1.f / D) + RMS_EPS);
        float lg[16];
#pragma unroll
        for (int e = 0; e < 16; ++e) lg[e] = 0.f;
#pragma unroll
        for (int i = 0; i < 4; ++i) {
            const int d = (lane + i * 64) * 4;
            const float4 gg = *(const float4*)(g + d), a = *(const float4*)(sc + d), b = *(const float4*)(sh + d);
            float o[4]; o[0] = v[i].x * rs * gg.x * (1.f + a.x) + b.x; o[1] = v[i].y * rs * gg.y * (1.f + a.y) + b.y; o[2] = v[i].z * rs * gg.z * (1.f + a.z) + b.z; o[3] = v[i].w * rs * gg.w * (1.f + a.w) + b.w;
            uint2 w; w.x = pk2(o[0], o[1]); w.y = pk2(o[2], o[3]); *(uint2*)(BN + (size_t)row * D + d) = w;
#pragma unroll
            for (int jj = 0; jj < 4; ++jj) { const float* rr = rt + (d + jj) * 16;
#pragma unroll
                for (int e = 0; e < 16; ++e) lg[e] += o[jj] * rr[e];
                asm volatile("" ::: "memory"); }
        }
        float mx = -1e30f;
#pragma unroll
        for (int e = 0; e < 16; ++e) { lg[e] = wave_sum(lg[e]); mx = fmaxf(mx, lg[e]); }
        float sum = 0;
#pragma unroll
        for (int e = 0; e < 16; ++e) { lg[e] = expf(lg[e] - mx); sum += lg[e]; }
        const float inv = 1.f / sum;
        if (lane < 16) { float val = 0;
#pragma unroll
            for (int e = 0; e < 16; ++e) val = (lane == e) ? lg[e] : val;
            AFF[(size_t)row * 16 + lane] = val * inv; }
    }
}

__device__ void ph_select(const Params& p, char* lds) {
    const int tid = tidx(), wid = tid >> 6, lane = tid & 63;
    unsigned* hist = (unsigned*)lds;
    unsigned* ctl = hist + 256;
    unsigned* wsum = ctl + 8;
    const float* AFF = (const float*)(p.ws + OFF_AFF);
    int* ROWIDX = (int*)(p.ws + OFF_ROWIDX); float* GATE = (float*)(p.ws + OFF_GATE); int* SLOT = (int*)(p.ws + OFF_SLOT);
    for (int gidx = bidx(); gidx < 128; gidx += gdim()) {
        const bool lat = gidx < 64; const int b = (gidx & 63) >> 4, e = gidx & 15;
        const int n = lat ? TL : TC, cap = lat ? CAPL : CAPC;
        const int row0 = lat ? b * TL : NLAT + b * TC, slot0 = lat ? b * CAPL : NB * CAPL + b * CAPC;
        unsigned key[8];
#pragma unroll
        for (int i = 0; i < 8; ++i) { const int idx = tid * 8 + i; key[i] = idx < n ? __float_as_uint(AFF[(size_t)(row0 + idx) * 16 + e]) : 0u; }
        unsigned prefix = 0u, remaining = (unsigned)cap;
#pragma unroll
        for (int pass = 0; pass < 4; ++pass) {
            const int sh = 24 - 8 * pass;
            __syncthreads();
            if (tid < 256) hist[tid] = 0u;
            __syncthreads();
#pragma unroll
            for (int i = 0; i < 8; ++i) { const int idx = tid * 8 + i;
                const bool cand = idx < n && (pass == 0 || (key[i] >> (sh + 8)) == prefix);
                if (cand) atomicAdd(&hist[(key[i] >> sh) & 255u], 1u); }
            __syncthreads();
            if (tid < 256) { unsigned gt = 0; for (int jj = tid + 1; jj < 256; ++jj) gt += hist[jj];
                const unsigned mine = hist[tid];
                if (gt < remaining && remaining <= gt + mine) { ctl[0] = (unsigned)tid; ctl[1] = remaining - gt; } }
            __syncthreads();
            prefix = (prefix << 8) | ctl[0]; remaining = ctl[1];
        }
        const unsigned T = prefix, m = remaining;
        unsigned cgt = 0, ceq = 0;
#pragma unroll
        for (int i = 0; i < 8; ++i) { const int idx = tid * 8 + i; if (idx < n) { cgt += key[i] > T ? 1u : 0u; ceq += key[i] == T ? 1u : 0u; } }
        auto block_excl = [&](unsigned v) -> unsigned {
            unsigned inc = v;
#pragma unroll
            for (int o = 1; o < 64; o <<= 1) { const unsigned t = (unsigned)__builtin_amdgcn_ds_bpermute((lane - o) << 2, (int)inc); if (lane >= o) inc += t; }
            __syncthreads();
            if (lane == 63) wsum[wid] = inc;
            __syncthreads();
            unsigned base = 0;
#pragma unroll
            for (int w = 0; w < 8; ++w) base += (w < wid) ? wsum[w] : 0u;
            return base + inc - v; };
        unsigned eqbase = block_excl(ceq);
        unsigned nsel = 0; bool sel[8];
#pragma unroll
        for (int i = 0; i < 8; ++i) { const int idx = tid * 8 + i; bool s_ = false;
            if (idx < n) { if (key[i] > T) s_ = true; else if (key[i] == T) { s_ = eqbase < m; ++eqbase; } }
            sel[i] = s_; nsel += s_ ? 1u : 0u; }
        unsigned sbase = block_excl(nsel);
#pragma unroll
        for (int i = 0; i < 8; ++i) { const int idx = tid * 8 + i;
            if (idx < n) {
                if (sel[i]) { const int sl = slot0 + (int)sbase; ++sbase; ROWIDX[e * ESLOTS + sl] = row0 + idx; GATE[e * EPAD + sl] = __uint_as_float(key[i]); SLOT[(size_t)(row0 + idx) * 16 + e] = sl; }
                else SLOT[(size_t)(row0 + idx) * 16 + e] = -1; } }
    }
}

__device__ void ph_gather(const Params& p) {
    const int wid = tidx() >> 6, lane = tidx() & 63;
    const int* ROWIDX = (const int*)(p.ws + OFF_ROWIDX); const bf16_t* BN = (const bf16_t*)(p.ws + OFF_H); bf16_t* XE = (bf16_t*)(p.ws + OFF_XE);
    for (int it = bidx() * 8 + wid; it < NE * ESLOTS; it += gdim() * 8) {
        const int row = ROWIDX[it]; const int e = it / ESLOTS, sl = it % ESLOTS;
        const u32x4* src = (const u32x4*)(BN + (size_t)row * D); u32x4* dst = (u32x4*)(XE + ((size_t)e * EPAD + sl) * D);
        dst[lane] = src[lane]; dst[lane + 64] = src[lane + 64];
    }
}

__device__ void ph_combine(const Params& p, int layer) {
    const int wid = tidx() >> 6, lane = tidx() & 63;
    const int* SLOT = (const int*)(p.ws + OFF_SLOT); const bf16_t* YE = (const bf16_t*)(p.ws + OFF_YE); float* X = (float*)(p.ws + OFF_X);
    for (int row = bidx() * 8 + wid; row < NROW; row += gdim() * 8) {
        const float* gt = modp(p, layer, row_stream(row), 5);
        float acc[16];
#pragma unroll
        for (int i = 0; i < 16; ++i) acc[i] = 0.f;
        for (int e = 0; e < NE; ++e) {
            const int s = SLOT[(size_t)row * 16 + e];
            if (s >= 0) { const bf16_t* y = YE + ((size_t)e * EPAD + s) * D + lane * 16;
                const u32x4 a = *(const u32x4*)y, b = *(const u32x4*)(y + 8);
                const unsigned w[8] = {a.x, a.y, a.z, a.w, b.x, b.y, b.z, b.w};
#pragma unroll
                for (int i = 0; i < 8; ++i) { acc[2 * i] += __uint_as_float(w[i] << 16); acc[2 * i + 1] += __uint_as_float(w[i] & 0xffff0000u); } }
        }
        float* xr = X + (size_t)row * D + lane * 16; const float* g = gt + lane * 16;
#pragma unroll
        for (int i = 0; i < 16; i += 4) { float4 xv = *(float4*)(xr + i); const float4 gv = *(const float4*)(g + i);
            xv.x += gv.x * acc[i]; xv.y += gv.y * acc[i + 1]; xv.z += gv.z * acc[i + 2]; xv.w += gv.w * acc[i + 3]; *(float4*)(xr + i) = xv; }
    }
}

__device__ void ph_rw_normxs(const Params& p, int layer, int j) {
    const int wid = tidx() >> 6, lane = tidx() & 63;
    const float* X = (const float*)(p.ws + OFF_X); bf16_t* XS = (bf16_t*)(p.ws + OFF_XS);
    const float* mu = p.rw_mu + (size_t)j * 6 * D; const float* g = p.norm1_g + layer * D;
    for (int row = bidx() * 8 + wid; row < NROW; row += gdim() * 8) {
        const int s_ = row_stream(row);
        const float* sh = modp(p, layer, s_, 0); const float* sc = modp(p, layer, s_, 1);
        const bool lat = row < NLAT; const int t = lat ? (row & (TL - 1)) : ((row - NLAT) & (TC - 1)); const int len = lat ? TL : TC;
        const bool hp = t > 0, hn = t < len - 1;
        float4 xc[4], xp[4], xn[4]; float sc_ = 0, sp_ = 0, sn_ = 0;
#pragma unroll
        for (int i = 0; i < 4; ++i) {
            xc[i] = ((const float4*)(X + (size_t)row * D))[lane + i * 64];
            xp[i] = hp ? ((const float4*)(X + (size_t)(row - 1) * D))[lane + i * 64] : make_float4(0, 0, 0, 0);
            xn[i] = hn ? ((const float4*)(X + (size_t)(row + 1) * D))[lane + i * 64] : make_float4(0, 0, 0, 0);
            sc_ += xc[i].x * xc[i].x + xc[i].y * xc[i].y + xc[i].z * xc[i].z + xc[i].w * xc[i].w;
            sp_ += xp[i].x * xp[i].x + xp[i].y * xp[i].y + xp[i].z * xp[i].z + xp[i].w * xp[i].w;
            sn_ += xn[i].x * xn[i].x + xn[i].y * xn[i].y + xn[i].z * xn[i].z + xn[i].w * xn[i].w; }
        sc_ = wave_sum(sc_); sp_ = wave_sum(sp_); sn_ = wave_sum(sn_);
        const float rc = rsqrtf(sc_ * (1.f / D) + RMS_EPS), rp = hp ? rsqrtf(sp_ * (1.f / D) + RMS_EPS) : 0.f, rn = hn ? rsqrtf(sn_ * (1.f / D) + RMS_EPS) : 0.f;
#pragma unroll
        for (int i = 0; i < 4; ++i) {
            const int d = (lane + i * 64) * 4;
            const float4 gg = *(const float4*)(g + d), a = *(const float4*)(sc + d), bsh = *(const float4*)(sh + d);
            float h[4], xx[4];
            const float gm[4] = {gg.x * (1.f + a.x), gg.y * (1.f + a.y), gg.z * (1.f + a.z), gg.w * (1.f + a.w)}; const float bb[4] = {bsh.x, bsh.y, bsh.z, bsh.w};
            const float c4[4] = {xc[i].x, xc[i].y, xc[i].z, xc[i].w}, p4[4] = {xp[i].x, xp[i].y, xp[i].z, xp[i].w}, n4[4] = {xn[i].x, xn[i].y, xn[i].z, xn[i].w};
#pragma unroll
            for (int e = 0; e < 4; ++e) { h[e] = c4[e] * rc * gm[e] + bb[e];
                const float hpv = hp ? p4[e] * rp * gm[e] + bb[e] : 0.f, hnv = hn ? n4[e] * rn * gm[e] + bb[e] : 0.f;
                xx[e] = 0.5f * (hpv + hnv) - h[e]; }
#pragma unroll
            for (int m = 0; m < 6; ++m) { const float4 u = *(const float4*)(mu + m * D + d);
                uint2 w; w.x = pk2(h[0] + xx[0] * u.x, h[1] + xx[1] * u.y); w.y = pk2(h[2] + xx[2] * u.z, h[3] + xx[3] * u.w);
                *(uint2*)(XS + ((size_t)m * NROW + row) * D + d) = w; }
        }
    }
}

__device__ __forceinline__ int scan_row(int i, int b, int z) {
    return i < TC ? NLAT + b * TC + (z ? TC - 1 - i : i) : b * TL + (z ? TL - 1 - (i - TC) : i - TC);
}
__device__ void ph_rw_scan(const Params& p, int j, char* lds) {
    const int tid = tidx(), wid = __builtin_amdgcn_readfirstlane(tid >> 6), lane = tid & 63, vr = lane >> 4, ks = lane & 15;
    const size_t PL = (size_t)NROW * D;
    const float* RKV = (const float*)(p.ws + OFF_RKV); float* Y = (float*)(p.ws + OFF_Y);
    constexpr int CH = 32, BUFB = 5 * CH * 256 + CH * 128, YB = CH * 32 * 4;
    for (int it = bidx(); it < 256; it += gdim()) {
        const int vh = it & 1, z = (it >> 1) & 1, h = (it >> 2) & 15, b = it >> 6;
        const char* pl0 = (const char*)((const float*)(p.ws + OFF_W) + z * PL); const char* pl1 = (const char*)(RKV + PL);
        const char* pl2 = (const char*)((const float*)(p.ws + OFF_AV) + z * PL); const char* pl3 = (const char*)RKV;
        const char* vpl = (const char*)(RKV + 2 * PL);
        float* yout = Y + z * PL;
        const int ptok = tid >> 4, pq = tid & 15;
        const f32x4 kkv = *(const f32x4*)(p.rw_k_k + j * D + h * 64 + pq * 4), kav = *(const f32x4*)(p.rw_k_a + j * D + h * 64 + pq * 4);
        auto issue = [&](int c) {
            char* buf = lds + (c & 1) * BUFB;
#pragma unroll
            for (int q0 = 0; q0 < 40; q0 += 8) {
                const int q = q0 + wid;
                if (q < 32) { const int pi = q >> 3, tg = q & 7; const int row = scan_row(c * CH + tg * 4 + (lane >> 4), b, z);
                    const char* base = pi == 0 ? pl0 : pi == 1 ? pl1 : pi == 2 ? pl2 : pl3;
                    __builtin_amdgcn_global_load_lds((const unsigned*)(base + (size_t)row * D * 4 + h * 256 + (lane & 15) * 16), (LAS unsigned*)(buf + pi * (CH * 256) + tg * 1024), 16, 0, 0); }
                else if (q < 36) { const int tg = q - 32; const int row = scan_row(c * CH + tg * 8 + (lane >> 3), b, z);
                    __builtin_amdgcn_global_load_lds((const unsigned*)(vpl + (size_t)row * D * 4 + (h * 64 + vh * 32) * 4 + (lane & 7) * 16), (LAS unsigned*)(buf + 5 * CH * 256 + tg * 1024), 16, 0, 0); }
            }
        };
        auto prep = [&](int c) {
            char* buf = lds + (c & 1) * BUFB;
            f32x4* kp = (f32x4*)(buf + 1 * CH * 256 + ptok * 256 + pq * 16); f32x4* ap = (f32x4*)(buf + 2 * CH * 256 + ptok * 256 + pq * 16); f32x4* dp = (f32x4*)(buf + 4 * CH * 256 + ptok * 256 + pq * 16);
            const f32x4 k = *kp, a = *ap; f32x4 kk = k * kkv;
            float ss = kk[0] * kk[0] + kk[1] * kk[1] + kk[2] * kk[2] + kk[3] * kk[3]; ss = dpp_sum16(ss);
            const float inv = 1.f / fmaxf(sqrtf(ss), 1e-12f); kk = kk * inv;
            *dp = k * (1.f + (a - 1.f) * kav); *ap = kk * a; *kp = kk;
        };
        float S0 = 0.f, S1 = 0.f, S2 = 0.f, S3 = 0.f;
        __syncthreads();
        issue(0);
        asm volatile("s_waitcnt vmcnt(0)" ::: "memory"); __syncthreads();
        prep(0); __syncthreads();
        constexpr int NCH = (TC + TL) / CH;
        for (int c = 0; c < NCH; ++c) {
            if (c + 1 < NCH) issue(c + 1);
            const char* buf = lds + (c & 1) * BUFB; float* yb = (float*)(lds + 2 * BUFB + (c & 1) * YB);
            const char* bq = buf + ks * 16; const char* vq = buf + 5 * CH * 256 + (wid * 4 + vr) * 4;
            struct Ops { f32x4 w, kk, bb, r, kd; float v; };
#define SC_LOAD(O, t) do { O.w = *(const f32x4*)(bq + (t) * 256); O.kk = *(const f32x4*)(bq + CH * 256 + (t) * 256); O.bb = *(const f32x4*)(bq + 2 * CH * 256 + (t) * 256); \
                O.r = *(const f32x4*)(bq + 3 * CH * 256 + (t) * 256); O.kd = *(const f32x4*)(bq + 4 * CH * 256 + (t) * 256); O.v = *(const float*)(vq + (t) * 128); } while (0)
#define SC_STEP(O, t) do { float sa = -(S0 * O.kk[0] + S1 * O.kk[1] + S2 * O.kk[2] + S3 * O.kk[3]); sa = dpp_sum16(sa); \
                S0 = S0 * O.w[0] + sa * O.bb[0] + O.v * O.kd[0]; S1 = S1 * O.w[1] + sa * O.bb[1] + O.v * O.kd[1]; S2 = S2 * O.w[2] + sa * O.bb[2] + O.v * O.kd[2]; S3 = S3 * O.w[3] + sa * O.bb[3] + O.v * O.kd[3]; \
                float y = S0 * O.r[0] + S1 * O.r[1] + S2 * O.r[2] + S3 * O.r[3]; y = dpp_sum16(y); if (ks == 0) yb[(t) * 32 + wid * 4 + vr] = y; } while (0)
            Ops oA, oB, oC, oE;
            SC_LOAD(oA, 0); SC_LOAD(oB, 1);
#pragma unroll
            for (int t = 0; t < CH; t += 4) {
                SC_LOAD(oC, t + 2); SC_STEP(oA, t);
                SC_LOAD(oE, t + 3); SC_STEP(oB, t + 1);
                if (t + 4 < CH) SC_LOAD(oA, t + 4);
                SC_STEP(oC, t + 2);
                if (t + 5 < CH) SC_LOAD(oB, t + 5);
                SC_STEP(oE, t + 3);
            }
#undef SC_LOAD
#undef SC_STEP
            asm volatile("s_waitcnt vmcnt(0)" ::: "memory"); __syncthreads();
            if (c + 1 < NCH) prep(c + 1);
            if (tid < 256) { const int t = tid >> 3, q = tid & 7; const int row = scan_row(c * CH + t, b, z);
                *(f32x4*)(yout + (size_t)row * D + h * 64 + vh * 32 + q * 4) = *(const f32x4*)(yb + t * 32 + q * 4); }
            __syncthreads();
        }
    }
}

__device__ void ph_rw_out(const Params& p, int j) {
    const int wid = tidx() >> 6, lane = tidx() & 63;
    const float* RKV = (const float*)(p.ws + OFF_RKV); const float* AV = (const float*)(p.ws + OFF_AV); const float* G = (const float*)(p.ws + OFF_G); const float* Y = (const float*)(p.ws + OFF_Y);
    bf16_t* OUT = (bf16_t*)(p.ws + OFF_H);
    const size_t PL = (size_t)NROW * D;
    const float* r_k = p.rw_r_k + j * D; const float* lg = p.rw_lnx_g + j * D; const float* lb = p.rw_lnx_b + j * D; const float* k_a = p.rw_k_a + j * D;
    for (int row = bidx() * 8 + wid; row < NROW; row += gdim() * 8) {
#pragma unroll
        for (int i = 0; i < 4; ++i) {
            const size_t o = (size_t)row * D + lane * 4 + i * 256; const int c = lane * 4 + i * 256;
            const f32x4 y = *(const f32x4*)(Y + o) + *(const f32x4*)(Y + PL + o);
            const float mean = dpp_sum16(y[0] + y[1] + y[2] + y[3]) * (1.f / 64.f);
            const f32x4 dd = y - mean;
            const float rstd = rsqrtf(dpp_sum16(dd[0] * dd[0] + dd[1] * dd[1] + dd[2] * dd[2] + dd[3] * dd[3]) * (1.f / 64.f) + LNX_EPS);
            const f32x4 r = *(const f32x4*)(RKV + o), k = *(const f32x4*)(RKV + PL + o), v = *(const f32x4*)(RKV + 2 * PL + o);
            const f32x4 a0 = *(const f32x4*)(AV + o), a1 = *(const f32x4*)(AV + PL + o);
            const f32x4 kds = k * (2.f + (a0 + a1 - 2.f) * *(const f32x4*)(k_a + c));
            const f32x4 t4 = r * kds * *(const f32x4*)(r_k + c);
            const float bs = dpp_sum16(t4[0] + t4[1] + t4[2] + t4[3]);
            const f32x4 res = (dd * rstd * *(const f32x4*)(lg + c) + *(const f32x4*)(lb + c) + bs * v) * *(const f32x4*)(G + o);
            uint2 w; w.x = pk2(res[0], res[1]); w.y = pk2(res[2], res[3]); *(uint2*)(OUT + o) = w;
        }
    }
}

__device__ void ph_final(const Params& p) {
    const int wid = tidx() >> 6, lane = tidx() & 63;
    const float* X = (const float*)(p.ws + OFF_X);
    for (int row = bidx() * 8 + wid; row < NLAT; row += gdim() * 8) {
        const float4* xr = (const float4*)(X + (size_t)row * D);
        float4 v[4]; float ss = 0;
#pragma unroll
        for (int i = 0; i < 4; ++i) { v[i] = xr[lane + i * 64]; ss += v[i].x * v[i].x + v[i].y * v[i].y + v[i].z * v[i].z + v[i].w * v[i].w; }
        ss = wave_sum(ss); const float rs = rsqrtf(ss * (1.f / D) + RMS_EPS);
#pragma unroll
        for (int i = 0; i < 4; ++i) { const int d = (lane + i * 64) * 4; const float4 gg = *(const float4*)(p.final_g + d);
            float4 o; o.x = v[i].x * rs * gg.x; o.y = v[i].y * rs * gg.y; o.z = v[i].z * rs * gg.z; o.w = v[i].w * rs * gg.w;
            *(float4*)(p.out + (size_t)row * D + d) = o; }
    }
}

enum { PH_INIT = 0, PH_A_NORM, PH_A_Z, PH_A_MID, PH_A_QKV, PH_A_POST, PH_A_ATTN, PH_A_WO,
       PH_R_NORM, PH_R_XS, PH_R_G1, PH_R_G2, PH_R_PREP, PH_R_SCAN, PH_R_OUT, PH_R_WO,
       PH_M_NORM, PH_M_SEL, PH_M_GATHER, PH_M_G1, PH_M_G2, PH_M_COMB, PH_FINAL, PH_M_CVT };

template <int PH>
__device__ __forceinline__ void run_phase(const Params& p, int layer, char* lds) {
    const int j = layer >> 1;
    char* ws = p.ws;
    if constexpr (PH == PH_INIT) { ph_init(p, lds); __syncthreads(); ph_small_cvt(p, lds); }
    else if constexpr (PH == PH_A_NORM) ph_norm_mod<false>(p, layer, p.norm1_g + layer * D, 0, 1, ws + OFF_H);
    else if constexpr (PH == PH_A_Z) {
        float* Z = (float*)(ws + OFF_Z);
        g8::BatchSched S{ws + OFF_H, ws + OFF_WMLA + j * SZ_WMLA + WM_IN, 0, 0, NROW / 256, 2, 1, D};
        g8::gemm_phase((PG8_LAS unsigned char*)lds, D, S, g8::epi_rc([=](const g8::Unit&, int row, int col, f32x4 v) { *(f32x4*)(Z + (size_t)row * 512 + col) = v; }));
    }
    else if constexpr (PH == PH_A_MID) ph_mla_mid(p, j);
    else if constexpr (PH == PH_A_QKV) {
        float* QRAW = (float*)(ws + OFF_QRAW); float* KVRAW = (float*)(ws + OFF_KVRAW);
        g8::BatchSched S1{ws + OFF_CQN, ws + OFF_WMLA + j * SZ_WMLA + WM_UQ, 0, 0, NROW / 256, 6, 1, 256};
        g8::gemm_phase((PG8_LAS unsigned char*)lds, 256, S1, g8::epi_rc([=](const g8::Unit&, int row, int col, f32x4 v) { *(f32x4*)(QRAW + (size_t)row * 1536 + col) = v; }));
        g8::BatchSched S2{ws + OFF_CKVN, ws + OFF_WMLA + j * SZ_WMLA + WM_UKV, 0, 0, NROW / 256, 8, 1, 256};
        g8::gemm_phase((PG8_LAS unsigned char*)lds, 256, S2, g8::epi_rc([=](const g8::Unit&, int row, int col, f32x4 v) { *(f32x4*)(KVRAW + (size_t)row * 2048 + col) = v; }));
    }
    else if constexpr (PH == PH_A_POST) ph_qkv_post(p);
    else if constexpr (PH == PH_A_ATTN) ph_attn(p, lds);
    else if constexpr (PH == PH_A_WO || PH == PH_R_WO) {
        float* X = (float*)(ws + OFF_X); const float* MOD = (const float*)(ws + OFF_MOD);
        g8::BatchSched S{ws + (PH == PH_A_WO ? OFF_O : OFF_H), PH == PH_A_WO ? ws + OFF_WMLA + j * SZ_WMLA + WM_O : ws + OFF_WRW + j * SZ_WRW + WR_O, 0, 0, NROW / 256, 4, 1, D};
        g8::gemm_phase((PG8_LAS unsigned char*)lds, D, S, g8::epi_rc([=](const g8::Unit&, int row, int col, f32x4 v) {
            const f32x4 gt = *(const f32x4*)(MOD + ((size_t)layer * 5 + row_stream(row)) * 6144 + 2048 + col);
            f32x4* xp = (f32x4*)(X + (size_t)row * D + col); *xp = *xp + gt * v; }));
    }
    else if constexpr (PH == PH_R_XS) ph_rw_normxs(p, layer, j);
    else if constexpr (PH == PH_R_G1) {
        float* RKV = (float*)(ws + OFF_RKV); float* VF = (float*)(ws + OFF_VFIRST);
        bf16_t* A2 = (bf16_t*)(ws + OFF_A2); bf16_t* A3 = (bf16_t*)(ws + OFF_A3);
        const bool first = (j == 0);
        struct RSched { const char* XS; const char* WB; int nwg;
            __device__ __forceinline__ bool next(int i, g8::Unit& u) const {
                const int L = i * gdim() + bidx(); if (L >= nwg) return false;
                const int w = g8::xcd_remap(L, nwg);
                if (w < 816) { u.g = w / 272; const int r = w % 272; u.pm = r >> 2; u.pn = r & 3; u.B = WB + WR_RKV + (size_t)u.g * D * D * 2 + (size_t)u.pn * 256 * D * 2; }
                else { u.g = 3 + (w - 816) / 68; u.pm = (w - 816) % 68; u.pn = 0; u.B = WB + WR_L + (size_t)(u.g - 3) * 256 * D * 2; }
                u.A = XS + (size_t)(u.g == 6 ? 2 : u.g) * NROW * D * 2 + (size_t)u.pm * 256 * D * 2; return true; } };
        RSched S{ws + OFF_XS, ws + OFF_WRW + j * SZ_WRW, first ? 816 + 204 : 816 + 272};
        g8::gemm_phase((PG8_LAS unsigned char*)lds, D, S, g8::epi_rc([=](const g8::Unit& u, int row, int col, f32x4 v) {
            if (u.g < 3) { *(f32x4*)(RKV + ((size_t)u.g * NROW + row) * D + col) = v; if (first && u.g == 2) *(f32x4*)(VF + (size_t)row * D + col) = v; }
            else if (u.g == 3) { if (col < 128) { uint2 w; w.x = pk2(tanhf(v[0]), tanhf(v[1])); w.y = pk2(tanhf(v[2]), tanhf(v[3])); *(uint2*)(A2 + (size_t)row * 256 + col) = w; } }
            else if (u.g == 4) { if (col < 128) { uint2 w; w.x = pk2(v[0], v[1]); w.y = pk2(v[2], v[3]); *(uint2*)(A2 + (size_t)row * 256 + 128 + col) = w; } }
            else if (u.g == 5) { uint2 w; if (col < 128) { w.x = pk2(sigmoidf_(v[0]), sigmoidf_(v[1])); w.y = pk2(sigmoidf_(v[2]), sigmoidf_(v[3])); } else { w.x = 0u; w.y = 0u; }
                                 if (col < 128 || first || col >= 160) *(uint2*)(A3 + (size_t)row * 256 + col) = w; }
            else { if (col < 32) { uint2 w; w.x = pk2(v[0], v[1]); w.y = pk2(v[2], v[3]); *(uint2*)(A3 + (size_t)row * 256 + 128 + col) = w; } } }));
    }
    else if constexpr (PH == PH_R_G2) {
        const bool first = (j == 0);
        float* W = (float*)(ws + OFF_W); float* AV = (float*)(ws + OFF_AV); float* G = (float*)(ws + OFF_G); float* RKV = (float*)(ws + OFF_RKV); const float* VF = (const float*)(ws + OFF_VFIRST);
        const float* w0 = p.rw_w0 + (size_t)j * 2 * D; const float* a0 = p.rw_a0 + (size_t)j * 2 * D; const float* v0 = p.rw_v0;
        g8::BatchSched S1{ws + OFF_A2, ws + OFF_WRW + j * SZ_WRW + WR_B2, 0, 0, NROW / 256, 16, 1, 256};
        g8::gemm_phase((PG8_LAS unsigned char*)lds, 256, S1, g8::epi_rc([=](const g8::Unit& u, int row, int col, f32x4 v) {
            const int blk = u.pn >> 2, c = col & 1023; const bool dec = blk < 2;
            const float* bias = (dec ? w0 + blk * D : a0 + (blk - 2) * D) + c; float* dst = (dec ? W + (size_t)blk * NROW * D : AV + (size_t)(blk - 2) * NROW * D) + (size_t)row * D + c;
            const f32x4 x = v + *(const f32x4*)bias; f32x4 o;
#pragma unroll
            for (int e = 0; e < 4; ++e) { const float sg = 1.f / (1.f + __expf(-x[e])); o[e] = dec ? __expf(-0.6065306597126334f * sg) : sg; }
            *(f32x4*)dst = o; }));
        g8::BatchSched S2{ws + OFF_A3, ws + OFF_WRW + j * SZ_WRW + WR_B3, 0, 0, NROW / 256, first ? 4 : 8, 1, 256};
        g8::gemm_phase((PG8_LAS unsigned char*)lds, 256, S2, g8::epi_rc([=](const g8::Unit&, int row, int col, f32x4 v) {
            if (col < 1024) *(f32x4*)(G + (size_t)row * D + col) = v;
            else { const int c = col - 1024; const size_t o = (size_t)row * D + c; const f32x4 vv = *(const f32x4*)(RKV + (size_t)2 * NROW * D + o), vf = *(const f32x4*)(VF + o), gz = v + *(const f32x4*)(v0 + c); f32x4 r;
#pragma unroll
                for (int e = 0; e < 4; ++e) r[e] = vv[e] + (vf[e] - vv[e]) / (1.f + __expf(-gz[e]));
                *(f32x4*)(RKV + (size_t)2 * NROW * D + o) = r; } }));
    }
    else if constexpr (PH == PH_R_SCAN) ph_rw_scan(p, j, lds);
    else if constexpr (PH == PH_R_OUT) ph_rw_out(p, j);
    else if constexpr (PH == PH_M_NORM) ph_norm2_router(p, layer, lds);
    else if constexpr (PH == PH_M_SEL) ph_select(p, lds);
    else if constexpr (PH == PH_M_GATHER) ph_gather(p);
    else if constexpr (PH == PH_M_G1) {
        bf16_t* HID = (bf16_t*)(ws + OFF_HID);
        g8::BatchSched S{ws + OFF_XE, ws + OFF_W13T, (size_t)EPAD * D * 2, (size_t)2816 * D * 2, EPAD / 256, 11, NE, D};
        g8::gemm_phase((PG8_LAS unsigned char*)lds, D, S, g8::epi_pair([=](const g8::Unit& u, int row, int col, f32x4 a, f32x4 b) {
            uint2 w; w.x = pk2(a[0] / (1.f + __expf(-a[0])) * b[0], a[1] / (1.f + __expf(-a[1])) * b[1]); w.y = pk2(a[2] / (1.f + __expf(-a[2])) * b[2], a[3] / (1.f + __expf(-a[3])) * b[3]);
            *(uint2*)(HID + ((size_t)u.g * EPAD + row) * FF + col) = w; }));
    }
    else if constexpr (PH == PH_M_G2) {
        bf16_t* YE = (bf16_t*)(ws + OFF_YE); const float* GATE = (const float*)(ws + OFF_GATE);
        g8::BatchSched S{ws + OFF_HID, ws + OFF_W2T, (size_t)EPAD * FF * 2, (size_t)D * FF * 2, EPAD / 256, 4, NE, FF};
        g8::gemm_phase((PG8_LAS unsigned char*)lds, FF, S, g8::epi_rc([=](const g8::Unit& u, int row, int col, f32x4 v) {
            const float gt = GATE[u.g * EPAD + row];
            uint2 w; w.x = pk2(v[0] * gt, v[1] * gt); w.y = pk2(v[2] * gt, v[3] * gt);
            *(uint2*)(YE + ((size_t)u.g * EPAD + row) * D + col) = w; }));
    }
    else if constexpr (PH == PH_M_COMB) ph_combine(p, layer);
    else if constexpr (PH == PH_M_CVT) ph_moe_cvt(p, layer, lds);
    else if constexpr (PH == PH_FINAL) ph_final(p);
}

#if ONE_LAUNCH
#define SYNC() xcd_barrier(bar)
#ifndef PROBE_PH
#define PROBE_PH -1
#endif
#ifndef PROBE_REP
#define PROBE_REP 1
#endif
__device__ __forceinline__ Params load_params() {
    Params q{};
#if defined(__HIP_DEVICE_COMPILE__)
    typedef const __attribute__((address_space(4))) unsigned long long* KargP;
    KargP kp_ = (KargP)__builtin_amdgcn_kernarg_segment_ptr(); asm volatile("" : "+s"(kp_));
#pragma unroll
    for (int i = 0; i < (int)(sizeof(Params) / 8); ++i) ((unsigned long long*)&q)[i] = kp_[i];
#endif
    return q;
}
#define RUN(PH) do { for (int rep_ = 0; rep_ < ((PH) == PROBE_PH ? PROBE_REP : 1); ++rep_) { const Params q = load_params(); run_phase<PH>(q, layer, smem); SYNC(); } } while (0)
__global__ void __launch_bounds__(NTHR, 2) mega(Params p) {
    extern __shared__ __attribute__((aligned(16))) char smem[];
    if (tidx() == 0) *(uint4*)(smem + LDS_BYTES) = make_uint4(0u, 0u, 0u, 0u);
    __syncthreads();
    XcdBarrier bar = xcd_barrier_post((unsigned*)(p.ws + OFF_BAR), (volatile LAS unsigned*)(smem + LDS_BYTES));
    { const int layer = 0; RUN(PH_INIT); }
    for (int layer = 0; layer < 4; ++layer) {
        if ((layer & 1) == 0) {
            RUN(PH_A_NORM);
            RUN(PH_A_Z);
            RUN(PH_A_MID);
            RUN(PH_A_QKV);
            RUN(PH_A_POST);
            RUN(PH_A_ATTN);
            RUN(PH_A_WO);
        } else {
            RUN(PH_R_XS);
            RUN(PH_R_G1);
            RUN(PH_R_G2);
            RUN(PH_R_SCAN);
            RUN(PH_R_OUT);
            RUN(PH_R_WO);
        }
        RUN(PH_M_CVT);
        RUN(PH_M_NORM);
        RUN(PH_M_SEL);
        RUN(PH_M_GATHER);
        RUN(PH_M_G1);
        RUN(PH_M_G2);
        RUN(PH_M_COMB);
    }
    { const Params q = load_params(); run_phase<PH_FINAL>(q, 0, smem); }
}
#else
template <int PH> __global__ void __launch_bounds__(NTHR, 2) kph(Params p, int layer) {
    extern __shared__ __attribute__((aligned(16))) char smem[];
    run_phase<PH>(p, layer, smem);
}
#endif

extern "C" void kernel_launch(void* const* d_in, const int* in_sizes, int n_in, void* d_out, int out_size, void* d_ws, size_t ws_size, hipStream_t stream) {
    if (n_in != 38 || ws_size < WS_NEED) { fprintf(stderr, "kernel_launch: bad args n_in %d ws %zu need %zu\n", n_in, ws_size, (size_t)WS_NEED); return; }
    Params p{};
    const float** pp = (const float**)&p;
    for (int i = 0; i < 38; ++i) pp[i] = (const float*)d_in[i];
    p.out = (float*)d_out; p.ws = (char*)d_ws;
    static int cus = 0;
    if (!cus) { int dev = 0; hipGetDevice(&dev); hipDeviceGetAttribute(&cus, hipDeviceAttributeMultiprocessorCount, dev); if (cus <= 0) cus = 256; }
    const int grid = cus;
#if ONE_LAUNCH
    hipFuncSetAttribute((const void*)mega, hipFuncAttributeMaxDynamicSharedMemorySize, LDS_BYTES + 16);
    hipMemsetAsync(d_ws, 0, XCD_BAR_WORDS * sizeof(unsigned), stream);
    hipLaunchKernelGGL(mega, dim3(grid), dim3(NTHR), LDS_BYTES + 16, stream, p);
#else
#define LAUNCH(PH, L) do { hipFuncSetAttribute((const void*)kph<PH>, hipFuncAttributeMaxDynamicSharedMemorySize, LDS_BYTES + 16); hipLaunchKernelGGL(kph<PH>, dim3(grid), dim3(NTHR), LDS_BYTES + 16, stream, p, L); } while (0)
    LAUNCH(PH_INIT, 0);
    for (int layer = 0; layer < 4; ++layer) {
        if ((layer & 1) == 0) { LAUNCH(PH_A_NORM, layer); LAUNCH(PH_A_Z, layer); LAUNCH(PH_A_MID, layer); LAUNCH(PH_A_QKV, layer); LAUNCH(PH_A_POST, layer); LAUNCH(PH_A_ATTN, layer); LAUNCH(PH_A_WO, layer); }
        else { LAUNCH(PH_R_XS, layer); LAUNCH(PH_R_G1, layer); LAUNCH(PH_R_G2, layer); LAUNCH(PH_R_SCAN, layer); LAUNCH(PH_R_OUT, layer); LAUNCH(PH_R_WO, layer); }
        LAUNCH(PH_M_CVT, layer); LAUNCH(PH_M_NORM, layer); LAUNCH(PH_M_SEL, layer); LAUNCH(PH_M_GATHER, layer); LAUNCH(PH_M_G1, layer); LAUNCH(PH_M_G2, layer); LAUNCH(PH_M_COMB, layer);
    }
    LAUNCH(PH_FINAL, 0);
#endif
}
```

```cpp
#include <hip/hip_runtime.h>
#include <stdint.h>
#include <stdio.h>

#ifndef ONE_LAUNCH
#define ONE_LAUNCH 1
#endif

#define NTHR 512
typedef unsigned short bf16_t;
typedef short bf16x8 __attribute__((ext_vector_type(8)));
typedef float f32x4 __attribute__((ext_vector_type(4)));
typedef unsigned u32x4 __attribute__((ext_vector_type(4)));

constexpr int D = 1024, NB = 4, TL = 4096, TC = 256, NLAT = NB * TL, NCTX = NB * TC, NROW = NLAT + NCTX;
constexpr int TK = TL + TC;
constexpr int NE = 16, FF = 1408, CAPL = 512, CAPC = 32, ESLOTS = NB * CAPL + NB * CAPC;
constexpr int EPAD = 2304;
constexpr float RMS_EPS = 1e-6f, LNX_EPS = 64e-5f;
constexpr float ATT_SCALE = 0.07216878364870322f;

constexpr size_t al256(size_t x) { return (x + 255) / 256 * 256; }
constexpr size_t OFF_BAR = 0;
constexpr size_t OFF_MOD = 16384;
constexpr size_t OFF_ROPE_C = OFF_MOD + al256(4 * 5 * 6144 * 4);
constexpr size_t OFF_ROPE_S = OFF_ROPE_C + al256(TL * 32 * 4);
constexpr size_t OFF_X = OFF_ROPE_S + al256(TL * 32 * 4);
constexpr size_t SZ_F32 = (size_t)NROW * D * 4, SZ_BF = (size_t)NROW * D * 2;
constexpr size_t OFF_VFIRST = OFF_X + SZ_F32;
constexpr size_t OFF_H = OFF_VFIRST + SZ_F32;
constexpr size_t SZ_WMLA = (size_t)(512 * 1024 + 1536 * 256 + 2048 * 256 + 1024 * 1024) * 2;
constexpr size_t WM_IN = 0, WM_UQ = (size_t)512 * 1024 * 2, WM_UKV = WM_UQ + (size_t)1536 * 256 * 2, WM_O = WM_UKV + (size_t)2048 * 256 * 2;
constexpr size_t SZ_WRW = (size_t)(3 * 1024 * 1024 + 4 * 256 * 1024 + 1024 * 1024 + 4096 * 256 + 2048 * 256) * 2;
constexpr size_t WR_RKV = 0, WR_L = (size_t)3 * 1024 * 1024 * 2, WR_O = WR_L + (size_t)4 * 256 * 1024 * 2, WR_B2 = WR_O + (size_t)1024 * 1024 * 2, WR_B3 = WR_B2 + (size_t)4096 * 256 * 2;
constexpr size_t OFF_WMLA = OFF_H + SZ_BF;
constexpr size_t OFF_WRW = OFF_WMLA + 2 * SZ_WMLA;
constexpr size_t OFF_W13T = OFF_WRW + 2 * SZ_WRW;
constexpr size_t OFF_W2T = OFF_W13T + (size_t)NE * 2816 * D * 2;
constexpr size_t OFF_S = OFF_W2T + (size_t)NE * D * FF * 2;
constexpr size_t OFF_Z = OFF_S;
constexpr size_t OFF_CQN = OFF_Z + al256((size_t)NROW * 512 * 4);
constexpr size_t OFF_CKVN = OFF_CQN + al256((size_t)NROW * 256 * 2);
constexpr size_t OFF_KR = OFF_CKVN + al256((size_t)NROW * 256 * 2);
constexpr size_t OFF_QRAW = OFF_KR + al256((size_t)NROW * 64 * 4);
constexpr size_t OFF_KVRAW = OFF_QRAW + al256((size_t)NROW * 1536 * 4);
constexpr size_t OFF_Q = OFF_KVRAW + al256((size_t)NROW * 2048 * 4);
constexpr size_t OFF_K = OFF_Q + al256((size_t)NB * 8 * TK * 192 * 2);
constexpr size_t OFF_V = OFF_K + al256((size_t)NB * 8 * TK * 192 * 2);
constexpr size_t OFF_O = OFF_V + al256((size_t)NB * 8 * TK * 128 * 2);
constexpr size_t END_MLA = OFF_O + SZ_BF;
constexpr size_t OFF_XS = OFF_S;
constexpr size_t OFF_RKV = OFF_XS + 6 * SZ_BF;
constexpr size_t OFF_W = OFF_RKV + 3 * SZ_F32;
constexpr size_t OFF_AV = OFF_W + 2 * SZ_F32;
constexpr size_t OFF_G = OFF_AV + 2 * SZ_F32;
constexpr size_t OFF_A2 = OFF_G + SZ_F32;
constexpr size_t OFF_A3 = OFF_A2 + al256((size_t)NROW * 256 * 2);
constexpr size_t END_RW = OFF_A3 + al256((size_t)NROW * 256 * 2);
constexpr size_t OFF_Y = OFF_XS;
constexpr size_t OFF_AFF = OFF_S;
constexpr size_t OFF_ROWIDX = OFF_AFF + al256((size_t)NROW * 16 * 4);
constexpr size_t OFF_GATE = OFF_ROWIDX + al256((size_t)NE * ESLOTS * 4);
constexpr size_t OFF_SLOT = OFF_GATE + al256((size_t)NE * EPAD * 4);
constexpr size_t OFF_XE = OFF_SLOT + al256((size_t)NROW * 16 * 4);
constexpr size_t OFF_HID = OFF_XE + al256((size_t)NE * EPAD * D * 2);
constexpr size_t OFF_YE = OFF_HID + al256((size_t)NE * EPAD * FF * 2);
constexpr size_t END_MOE = OFF_YE + al256((size_t)NE * EPAD * D * 2);
constexpr size_t WS_NEED = END_RW > END_MLA ? (END_RW > END_MOE ? END_RW : END_MOE) : (END_MLA > END_MOE ? END_MLA : END_MOE);

constexpr int LDS_BYTES = 147456;

struct Params {
    const float *x, *c, *ctx, *c_ctx, *mod_w, *mod_b, *norm1_g, *norm2_g, *final_g;
    const float *mla_w_in, *mla_g_q, *mla_g_kv, *mla_w_uq, *mla_w_ukv, *mla_w_o;
    const float *rw_mu, *rw_w_rkv, *rw_w0, *rw_w1, *rw_w2, *rw_a0, *rw_a1, *rw_a2, *rw_v0, *rw_v1, *rw_v2, *rw_g1, *rw_g2, *rw_k_k, *rw_k_a, *rw_r_k, *rw_lnx_g, *rw_lnx_b, *rw_w_o;
    const float *moe_router, *moe_w1, *moe_w3, *moe_w2;
    float* out; char* ws;
};

__device__ __forceinline__ int bidx() { int t = blockIdx.x; asm volatile("" : "+s"(t)); return t; }
__device__ __forceinline__ int gdim() { int t = gridDim.x; asm volatile("" : "+s"(t)); return t; }
__device__ __forceinline__ int tidx() { int t = threadIdx.x; asm volatile("" : "+v"(t)); return t; }
#define XB_TMO      128
#define XB_XCNT(j)  (256  + 64 * (j))
#define XB_XSUB(j)  (1280 + 64 * (j))
#define XB_XGEN(j)  (2304 + 64 * (j))
#define XB_TOP      3328
#define XB_TOPGEN   3392
#define XCD_BAR_WORDS 3456
#define XB_SPIN_CAP (1u << 22)
#define LAS __attribute__((address_space(3)))

__device__ __forceinline__ unsigned xb_ld(unsigned* p)              { return __hip_atomic_load(p, __ATOMIC_RELAXED, __HIP_MEMORY_SCOPE_AGENT); }
__device__ __forceinline__ unsigned xb_add(unsigned* p, unsigned v) { return __hip_atomic_fetch_add(p, v, __ATOMIC_RELAXED, __HIP_MEMORY_SCOPE_AGENT); }
__device__ __forceinline__ unsigned xb_xcc_id() { return (unsigned)__builtin_amdgcn_s_getreg((3 << 11) | 20) & 0xFu; }
#define XB_SPIN(cond, bar) do { unsigned _sp = 0; while (cond) { __builtin_amdgcn_s_sleep(1); \
    if ((++_sp & 255u) == 0u) { if (xb_ld(&(bar)[XB_TMO])) break; if (_sp > XB_SPIN_CAP) { atomicAdd(&(bar)[XB_TMO], 1u); break; } } } } while (0)

struct XcdBarrier { unsigned* bar; unsigned x; volatile LAS unsigned* st; };

__device__ __forceinline__ XcdBarrier xcd_barrier_post(unsigned* bar, volatile LAS unsigned* st) {
    XcdBarrier b; b.bar = bar; b.x = xb_xcc_id(); b.st = st;
    if (tidx() == 0) (void)xb_add(&bar[XB_XCNT(b.x)], 1u);
    return b;
}
__device__ __forceinline__ void xcd_barrier_complete(unsigned* bar, unsigned x, unsigned& nloc, unsigned& nx) {
    const unsigned G = gridDim.x * gridDim.y * gridDim.z;
    unsigned sum, cnt, mine, sp = 0u;
    for (;;) {
        sum = 0u; cnt = 0u; mine = 0u;
#pragma unroll
        for (unsigned j = 0; j < 16; ++j) { const unsigned c = xb_ld(&bar[XB_XCNT(j)]); sum += c; cnt += (c > 0u) ? 1u : 0u; mine = (j == x) ? c : mine; }
        if (sum == G) break;
        __builtin_amdgcn_s_sleep(1);
        if ((++sp & 255u) == 0u) { if (xb_ld(&bar[XB_TMO])) break; if (sp > XB_SPIN_CAP) { atomicAdd(&bar[XB_TMO], 1u); break; } }
    }
    nloc = mine > 0u ? mine : 1u; nx = cnt > 0u ? cnt : 1u;
}
__device__ __forceinline__ void xcd_barrier(const XcdBarrier& b) {
    asm volatile("s_waitcnt vmcnt(0)" ::: "memory");
    __syncthreads();
    if (tidx() == 0) {
        unsigned* bar = b.bar;
        __builtin_amdgcn_s_waitcnt(0);
        unsigned nloc = b.st[0], nx = b.st[1];
        if (nloc == 0u) { xcd_barrier_complete(bar, b.x, nloc, nx); b.st[0] = nloc; b.st[1] = nx; }
        const unsigned old = xb_add(&bar[XB_XSUB(b.x)], 1u);
        const unsigned gen = old / nloc;
        if (old + 1u == (gen + 1u) * nloc) {
            __builtin_amdgcn_fence(__ATOMIC_RELEASE, "agent");
            asm volatile("s_waitcnt vmcnt(0)" ::: "memory");
            const unsigned og = xb_add(&bar[XB_TOP], 1u);
            const unsigned tg = og / nx;
            if (og + 1u == (tg + 1u) * nx) xb_add(&bar[XB_TOPGEN], 1u);
            else XB_SPIN(xb_ld(&bar[XB_TOPGEN]) == tg, bar);
            __builtin_amdgcn_fence(__ATOMIC_ACQUIRE, "agent");
            xb_add(&bar[XB_XGEN(b.x)], 1u);
            asm volatile("s_waitcnt vmcnt(0)" ::: "memory");
        } else {
            XB_SPIN(xb_ld(&bar[XB_XGEN(b.x)]) == gen, bar);
            __builtin_amdgcn_fence(__ATOMIC_ACQUIRE, "agent");
            asm volatile("s_waitcnt vmcnt(0)" ::: "memory");
        }
    }
    __syncthreads();
}

__device__ __forceinline__ bf16_t f2bf(float f) { unsigned u = __float_as_uint(f); u += 0x7FFFu + ((u >> 16) & 1u); return (bf16_t)(u >> 16); }
__device__ __forceinline__ float bf2f(bf16_t b) { return __uint_as_float(((unsigned)b) << 16); }
__device__ __forceinline__ unsigned pk2(float lo, float hi) { return (unsigned)f2bf(lo) | ((unsigned)f2bf(hi) << 16); }
__device__ __forceinline__ float dpp_sum16(float x) {
    x += __builtin_bit_cast(float, __builtin_amdgcn_update_dpp(0, __builtin_bit_cast(int, x), 0xB1, 0xF, 0xF, true));
    x += __builtin_bit_cast(float, __builtin_amdgcn_update_dpp(0, __builtin_bit_cast(int, x), 0x4E, 0xF, 0xF, true));
    x += __builtin_bit_cast(float, __builtin_amdgcn_update_dpp(0, __builtin_bit_cast(int, x), 0x141, 0xF, 0xF, true));
    x += __builtin_bit_cast(float, __builtin_amdgcn_update_dpp(0, __builtin_bit_cast(int, x), 0x140, 0xF, 0xF, true));
    return x;
}
__device__ __forceinline__ float wave_sum(float v) {
    v = dpp_sum16(v); const int i = __builtin_bit_cast(int, v);
    return __builtin_bit_cast(float, __builtin_amdgcn_readlane(i, 0)) + __builtin_bit_cast(float, __builtin_amdgcn_readlane(i, 16)) + __builtin_bit_cast(float, __builtin_amdgcn_readlane(i, 32)) + __builtin_bit_cast(float, __builtin_amdgcn_readlane(i, 48));
}
__device__ __forceinline__ float sigmoidf_(float x) { return 1.f / (1.f + expf(-x)); }
__device__ __forceinline__ int row_stream(int row) { return row < NLAT ? (row >> 12) : 4; }
__device__ __forceinline__ const float* modp(const Params& p, int layer, int s, int part) { return (const float*)(p.ws + OFF_MOD) + ((size_t)layer * 5 + s) * 6144 + part * 1024; }

struct SgArgs { const bf16_t* A; int lda; size_t strideA; const float* B; int ldb; size_t strideB; int M, N, K, nbatch; };
template <class Epi>
__device__ __forceinline__ void sg_gemm(char* lds, const SgArgs g, const Epi& epi) {
    bf16_t* As = (bf16_t*)lds;
    bf16_t* Bs = As + 128 * 40;
    const int tid = tidx(), wid = tid >> 6, lane = tid & 63;
    const int wr = wid >> 2, wc = wid & 3;
    const int tilesN = (g.N + 127) / 128, tilesM = g.M / 128, per = tilesM * tilesN, ntiles = per * g.nbatch;
    const int ar = tid >> 2, ak = (tid & 3) * 8;
    const int bn = tid & 127, bk = (tid >> 7) * 8;
    for (int tile = bidx(); tile < ntiles; tile += gdim()) {
        const int bt = tile / per, tt = tile % per;
        const int tm = tt / tilesN, tn = tt % tilesN;
        const int m0 = tm * 128, n0 = tn * 128;
        f32x4 acc[4][2];
#pragma unroll
        for (int m = 0; m < 4; ++m)
#pragma unroll
            for (int n = 0; n < 2; ++n) acc[m][n] = (f32x4){0.f, 0.f, 0.f, 0.f};
        const bool bvalid = (n0 + bn) < g.N;
        const bf16_t* ap = g.A + bt * g.strideA + (size_t)(m0 + ar) * g.lda + ak;
        const float* bp = g.B + bt * g.strideB + (size_t)bk * g.ldb + n0 + bn;
        bf16x8 areg; float breg[8];
        areg = *(const bf16x8*)ap;
#pragma unroll
        for (int j = 0; j < 8; ++j) breg[j] = bvalid ? bp[(size_t)j * g.ldb] : 0.f;
        for (int k0 = 0; k0 < g.K; k0 += 32) {
            __syncthreads();
            *(bf16x8*)(As + ar * 40 + ak) = areg;
            { u32x4 w; w.x = pk2(breg[0], breg[1]); w.y = pk2(breg[2], breg[3]); w.z = pk2(breg[4], breg[5]); w.w = pk2(breg[6], breg[7]); *(u32x4*)(Bs + bn * 40 + bk) = w; }
            __syncthreads();
            if (k0 + 32 < g.K) {
                areg = *(const bf16x8*)(ap + k0 + 32);
#pragma unroll
                for (int j = 0; j < 8; ++j) breg[j] = bvalid ? bp[(size_t)(k0 + 32 + j) * g.ldb] : 0.f;
            }
            bf16x8 af[4], bfr[2];
#pragma unroll
            for (int m = 0; m < 4; ++m) af[m] = *(const bf16x8*)(As + (wr * 64 + m * 16 + (lane & 15)) * 40 + (lane >> 4) * 8);
#pragma unroll
            for (int n = 0; n < 2; ++n) bfr[n] = *(const bf16x8*)(Bs + (wc * 32 + n * 16 + (lane & 15)) * 40 + (lane >> 4) * 8);
#pragma unroll
            for (int m = 0; m < 4; ++m)
#pragma unroll
                for (int n = 0; n < 2; ++n) acc[m][n] = __builtin_amdgcn_mfma_f32_16x16x32_bf16(af[m], bfr[n], acc[m][n], 0, 0, 0);
        }
#pragma unroll
        for (int m = 0; m < 4; ++m)
#pragma unroll
            for (int n = 0; n < 2; ++n) {
                const int col = n0 + wc * 32 + n * 16 + (lane & 15);
                if (col < g.N) {
#pragma unroll
                    for (int r = 0; r < 4; ++r) epi(bt, m0 + wr * 64 + m * 16 + (lane >> 4) * 4 + r, col, acc[m][n][r]);
                }
            }
    }
}


namespace g8 {
#define PG8_LAS __attribute__((address_space(3)))
constexpr int BM = 256, BK = 64, HALF = 128, HTB = HALF * BK * 2, STAGE_BYTES = 8 * HTB;
__device__ __forceinline__ int lds_byte(int r, int c) { const int st = (r >> 4) * 2 + (c >> 5), rr = r & 15, cc = c & 31, ob = rr * 64 + cc * 2; return st * 1024 + (ob ^ (((ob >> 9) & 1) << 5)); }
__device__ __forceinline__ void stage_rc(int b, int& R, int& C) { const int st = b / 1024, sb = b % 1024, swz = sb ^ (((sb >> 9) & 1) << 5); R = (st >> 1) * 16 + swz / 64; C = (st & 1) * 32 + (swz % 64) / 2; }
struct Unit { int pm, pn, g; const char* A; const char* B; };
__device__ __forceinline__ int xcd_remap(int L, int nwg) { const int q = nwg / 8, r = nwg % 8, xcd = L % 8, off = L / 8; return (xcd < r ? xcd * (q + 1) : r * (q + 1) + (xcd - r) * q) + off; }

template <class Epi, class Sched>
__device__ __forceinline__ void gemm_phase(PG8_LAS unsigned char* lds, const int K, const Sched& S, const Epi& E) {
    const int tid = tidx(), wid = __builtin_amdgcn_readfirstlane(tid >> 6), lane = tid & 63, wr = wid >> 2, wc = wid & 3, fr = lane & 15, fq = lane >> 4;
    const int nt = K / BK;
    unsigned voffA[2];
#pragma unroll
    for (int i = 0; i < 2; ++i) { int R, C; stage_rc(tid * 16 + i * 8192, R, C); voffA[i] = (unsigned)(R * K + C) * 2u; }
    const size_t kstep = (size_t)(BK * 2);
    const size_t hstep = (size_t)HALF * K * 2;
    const unsigned ldsw = (unsigned)wid * 1024u;
    const int aoff = lds_byte(wr * 64 + fr, fq * 8), boff = lds_byte(wc * 32 + fr, fq * 8);
#define PG8_SA(b, h) (((b) * 2 + (h)) * HTB)
#define PG8_SB(b, h) ((4 + (b) * 2 + (h)) * HTB)
#define PG8_STAGE(bufoff, gbase, voff) do { _Pragma("unroll") for (int _i = 0; _i < 2; ++_i) \
        __builtin_amdgcn_global_load_lds((const unsigned*)((const char*)(gbase) + (voff)[_i]), (PG8_LAS unsigned*)(lds + (bufoff) + ldsw + _i * 8192), 16, 0, 0); } while (0)
#define PG8_LDA(dst, b, h) do { _Pragma("unroll") for (int m = 0; m < 4; ++m) _Pragma("unroll") for (int k = 0; k < 2; ++k) dst[m][k] = *(const PG8_LAS bf16x8*)(lds + PG8_SA(b, h) + aoff + m * 2048 + k * 1024); } while (0)
#define PG8_LDB(dst, b, h) do { _Pragma("unroll") for (int n = 0; n < 2; ++n) _Pragma("unroll") for (int k = 0; k < 2; ++k) dst[n][k] = *(const PG8_LAS bf16x8*)(lds + PG8_SB(b, h) + boff + n * 2048 + k * 1024); } while (0)
#define PG8_MMA(ai, bj, At, Bt) do { __builtin_amdgcn_s_setprio(1); _Pragma("unroll") for (int m = 0; m < 4; ++m) _Pragma("unroll") for (int n = 0; n < 2; ++n) _Pragma("unroll") for (int k = 0; k < 2; ++k) \
        acc[ai][bj][m][n] = __builtin_amdgcn_mfma_f32_16x16x32_bf16(Bt[n][k], At[m][k], acc[ai][bj][m][n], 0, 0, 0); __builtin_amdgcn_s_setprio(0); } while (0)
#define PG8_WAIT_V(n) asm volatile("s_waitcnt vmcnt(" #n ")" ::: "memory")
#define PG8_WAIT_L(n) asm volatile("s_waitcnt lgkmcnt(" #n ")" ::: "memory")
#define PG8_BAR __builtin_amdgcn_s_barrier()
#define PG8_SCHED __builtin_amdgcn_sched_barrier(0)
    Unit cur, nxt; int ui = 0;
    if (!S.next(0, cur)) return;
    f32x4 acc[2][2][4][2];
#pragma unroll
    for (int a = 0; a < 2; ++a)
#pragma unroll
        for (int b = 0; b < 2; ++b)
#pragma unroll
            for (int m = 0; m < 4; ++m)
#pragma unroll
                for (int n = 0; n < 2; ++n) acc[a][b][m][n] = (f32x4){0.f, 0.f, 0.f, 0.f};
    bf16x8 At[4][2], B0[2][2], B1[2][2];
    const char* cA = cur.A; const char* cB = cur.B;
    PG8_STAGE(PG8_SB(0, 0), cB, voffA); PG8_STAGE(PG8_SA(0, 0), cA, voffA); PG8_STAGE(PG8_SB(0, 1), cB + hstep, voffA); PG8_STAGE(PG8_SA(0, 1), cA + hstep, voffA);
    if (wr == 1) PG8_BAR;
    PG8_WAIT_V(4); PG8_BAR;
    PG8_STAGE(PG8_SB(1, 0), cB + kstep, voffA); PG8_STAGE(PG8_SA(1, 0), cA + kstep, voffA); PG8_STAGE(PG8_SB(1, 1), cB + hstep + kstep, voffA);
    PG8_WAIT_V(6); PG8_BAR;
    for (;;) {
        const bool has_next = S.next(ui + 1, nxt);
        const char* nA = has_next ? nxt.A : cA; const char* nB = has_next ? nxt.B : cB;
        for (int t = 0; t < nt; t += 2) {
            const bool last = (t == nt - 2);
            const char* a1 = cA + (size_t)(t + 1) * kstep;
            const char* a2 = last ? nA : cA + (size_t)(t + 2) * kstep; const char* b2 = last ? nB : cB + (size_t)(t + 2) * kstep;
            const char* a3 = a2 + kstep; const char* b3 = b2 + kstep;
            PG8_LDB(B0, 0, 0); PG8_SCHED; PG8_LDA(At, 0, 0); PG8_STAGE(PG8_SA(1, 1), a1 + hstep, voffA);
            PG8_WAIT_L(8); PG8_BAR; PG8_WAIT_L(0); PG8_MMA(0, 0, At, B0); PG8_BAR; PG8_SCHED;
            PG8_LDB(B1, 0, 1); PG8_STAGE(PG8_SB(0, 0), b2, voffA);
            PG8_BAR; PG8_WAIT_L(0); PG8_MMA(0, 1, At, B1); PG8_BAR;
            PG8_LDA(At, 0, 1); PG8_STAGE(PG8_SA(0, 0), a2, voffA);
            PG8_BAR; PG8_WAIT_L(0); PG8_MMA(1, 0, At, B0); PG8_BAR; PG8_SCHED;
            PG8_STAGE(PG8_SB(0, 1), b2 + hstep, voffA);
            PG8_WAIT_V(6); PG8_BAR; PG8_MMA(1, 1, At, B1); PG8_BAR;
            PG8_LDB(B0, 1, 0); PG8_SCHED; PG8_LDA(At, 1, 0); PG8_STAGE(PG8_SA(0, 1), a2 + hstep, voffA);
            PG8_WAIT_L(8); PG8_BAR; PG8_WAIT_L(0); PG8_MMA(0, 0, At, B0); PG8_BAR; PG8_SCHED;
            PG8_LDB(B1, 1, 1); PG8_STAGE(PG8_SB(1, 0), b3, voffA);
            PG8_BAR; PG8_WAIT_L(0); PG8_MMA(0, 1, At, B1); PG8_BAR;
            PG8_LDA(At, 1, 1); PG8_STAGE(PG8_SA(1, 0), a3, voffA);
            PG8_BAR; PG8_WAIT_L(0); PG8_MMA(1, 0, At, B0); PG8_BAR; PG8_SCHED;
            PG8_STAGE(PG8_SB(1, 1), b3 + hstep, voffA);
            PG8_WAIT_V(6); PG8_BAR; PG8_MMA(1, 1, At, B1); PG8_BAR;
        }
        E(acc, cur, wr, wc, fr, fq);
        if (!has_next) break;
#pragma unroll
        for (int a = 0; a < 2; ++a)
#pragma unroll
            for (int b = 0; b < 2; ++b)
#pragma unroll
                for (int m = 0; m < 4; ++m)
#pragma unroll
                    for (int n = 0; n < 2; ++n) acc[a][b][m][n] = (f32x4){0.f, 0.f, 0.f, 0.f};
        cur = nxt; cA = nA; cB = nB; ++ui;
    }
    PG8_WAIT_V(0);
    if (wr == 0) PG8_BAR;
    PG8_BAR;
#undef PG8_SA
#undef PG8_SB
#undef PG8_STAGE
#undef PG8_LDA
#undef PG8_LDB
#undef PG8_MMA
#undef PG8_WAIT_V
#undef PG8_WAIT_L
#undef PG8_BAR
#undef PG8_SCHED
}
template <class F> struct EpiRC { F f;
    __device__ __forceinline__ void operator()(const f32x4 (&acc)[2][2][4][2], const Unit& u, int wr, int wc, int fr, int fq) const {
#pragma unroll
        for (int ai = 0; ai < 2; ++ai)
#pragma unroll
            for (int m = 0; m < 4; ++m) { const int row = u.pm * BM + ai * HALF + wr * 64 + m * 16 + fr;
#pragma unroll
                for (int bj = 0; bj < 2; ++bj)
#pragma unroll
                    for (int n = 0; n < 2; ++n) f(u, row, u.pn * BM + bj * HALF + wc * 32 + n * 16 + 4 * fq, acc[ai][bj][m][n]);
                asm volatile("" ::: "memory"); }
    } };
template <class F> __device__ __forceinline__ EpiRC<F> epi_rc(const F& f) { return EpiRC<F>{f}; }
template <class F> struct EpiPair { F f;
    __device__ __forceinline__ void operator()(const f32x4 (&acc)[2][2][4][2], const Unit& u, int wr, int wc, int fr, int fq) const {
#pragma unroll
        for (int ai = 0; ai < 2; ++ai)
#pragma unroll
            for (int m = 0; m < 4; ++m) { const int row = u.pm * BM + ai * HALF + wr * 64 + m * 16 + fr;
#pragma unroll
                for (int n = 0; n < 2; ++n) f(u, row, u.pn * HALF + wc * 32 + n * 16 + 4 * fq, acc[ai][0][m][n], acc[ai][1][m][n]);
                asm volatile("" ::: "memory"); }
    } };
template <class F> __device__ __forceinline__ EpiPair<F> epi_pair(const F& f) { return EpiPair<F>{f}; }
struct BatchSched { const char* A; const char* B; size_t strideA, strideB; int nM, nN, nb, K;
    __device__ __forceinline__ bool next(int i, Unit& u) const {
        const int nwg = nM * nN * nb; const int L = i * gdim() + bidx(); if (L >= nwg) return false;
        const int w = xcd_remap(L, nwg); const int per = nM * nN; u.g = w / per; const int r = w % per; u.pm = r / nN; u.pn = r % nN;
        u.A = A + u.g * strideA + (size_t)u.pm * BM * K * 2; u.B = B + u.g * strideB + (size_t)u.pn * BM * K * 2; return true; } };
}

template <class SrcF, class DRow>
__device__ __forceinline__ void cvt_tiles(char* lds, bf16_t* dst, int Kd, int Nd, int nbatch, size_t dstride, const SrcF& src, const DRow& drow) {
    bf16_t* T = (bf16_t*)lds;
    const int tid = tidx();
    const int tk = Kd / 128, tn = Nd / 64, per = tk * tn, total = per * nbatch;
    for (int t = bidx(); t < total; t += gdim()) {
        const int bt = t / per, r = t % per, k0 = (r % tk) * 128, n0 = (r / tk) * 64;
        float4 v[4];
#pragma unroll
        for (int i = 0; i < 4; ++i) { const int k = k0 + i * 32 + (tid >> 4), n = n0 + (tid & 15) * 4; const float* sp = src(bt, k, n); v[i] = sp ? *(const float4*)sp : make_float4(0.f, 0.f, 0.f, 0.f); }
        __syncthreads();
#pragma unroll
        for (int i = 0; i < 4; ++i) { const int k = i * 32 + (tid >> 4), n = (tid & 15) * 4;
            T[(n + 0) * 136 + k] = f2bf(v[i].x); T[(n + 1) * 136 + k] = f2bf(v[i].y); T[(n + 2) * 136 + k] = f2bf(v[i].z); T[(n + 3) * 136 + k] = f2bf(v[i].w); }
        __syncthreads();
        { const int n = tid >> 3, kc = (tid & 7) * 16;
          const u32x4 a = *(const u32x4*)(T + n * 136 + kc), b = *(const u32x4*)(T + n * 136 + kc + 8);
          bf16_t* dp = dst + bt * dstride + (size_t)drow(n0 + n) * Kd + k0 + kc;
          *(u32x4*)dp = a; *(u32x4*)(dp + 8) = b; }
    }
}
__device__ void ph_moe_cvt(const Params& p, int layer, char* lds) {
    const float* w1 = p.moe_w1 + (size_t)layer * NE * D * FF; const float* w3 = p.moe_w3 + (size_t)layer * NE * D * FF; const float* w2 = p.moe_w2 + (size_t)layer * NE * FF * D;
    cvt_tiles(lds, (bf16_t*)(p.ws + OFF_W13T), D, 2816, NE, (size_t)2816 * D,
        [=](int e, int k, int n) -> const float* { const int pn = n >> 8, half = (n >> 7) & 1, c = pn * 128 + (n & 127); return (half ? w3 : w1) + ((size_t)e * D + k) * FF + c; },
        [=](int n) { return n; });
    cvt_tiles(lds, (bf16_t*)(p.ws + OFF_W2T), FF, D, NE, (size_t)D * FF,
        [=](int e, int k, int n) -> const float* { return w2 + ((size_t)e * FF + k) * D + n; },
        [=](int n) { return n; });
}

__device__ void ph_init(const Params& p, char* lds) {
    const int tid = tidx(), gtid = bidx() * NTHR + tid, gsz = gdim() * NTHR;
    float4* X4 = (float4*)(p.ws + OFF_X);
    const float4* x4 = (const float4*)p.x; const float4* c4 = (const float4*)p.ctx;
    for (int i = gtid; i < NROW * 256; i += gsz) X4[i] = i < NLAT * 256 ? x4[i] : c4[i - NLAT * 256];
    float* rc = (float*)(p.ws + OFF_ROPE_C); float* rs = (float*)(p.ws + OFF_ROPE_S);
    for (int i = gtid; i < TL * 32; i += gsz) {
        const int t = i >> 5, f = i & 31; const float pos = (float)((f < 16) ? (t >> 6) : (t & 63));
        const float inv = powf(10000.f, -(float)(f & 15) / 16.f); const float ang = pos * inv; rc[i] = cosf(ang); rs[i] = sinf(ang);
    }
    float* sc = (float*)lds;
    float* red = sc + 5 * 1024;
    for (int i = tid; i < 5 * 1024; i += NTHR) { const float v = i < 4096 ? p.c[i] : p.c_ctx[i - 4096]; sc[i] = v / (1.f + expf(-v)); }
    __syncthreads();
    float* MOD = (float*)(p.ws + OFF_MOD);
    for (int item = bidx(); item < 4 * 96; item += gdim()) {
        const int l = item / 96, cg = item % 96, col = tid & 63, n = cg * 64 + col, kg = tid >> 6;
        const float* w = p.mod_w + ((size_t)l * 1024 + kg * 128) * 6144 + n;
        float a0 = 0, a1 = 0, a2 = 0, a3 = 0, a4 = 0;
        for (int k = 0; k < 128; ++k) { const float wv = w[(size_t)k * 6144]; const int kk = kg * 128 + k;
            a0 += sc[kk] * wv; a1 += sc[1024 + kk] * wv; a2 += sc[2048 + kk] * wv; a3 += sc[3072 + kk] * wv; a4 += sc[4096 + kk] * wv; }
        float* rr = red + (kg * 64 + col) * 5; rr[0] = a0; rr[1] = a1; rr[2] = a2; rr[3] = a3; rr[4] = a4;
        __syncthreads();
        if (tid < 320) { const int c2 = tid & 63, s = tid >> 6; float sum = 0;
            for (int q = 0; q < 8; ++q) sum += red[(q * 64 + c2) * 5 + s];
            MOD[((size_t)l * 5 + s) * 6144 + cg * 64 + c2] = sum + p.mod_b[l * 6144 + cg * 64 + c2]; }
        __syncthreads();
    }
}


__device__ void ph_small_cvt(const Params& p, char* lds) {
    for (int j = 0; j < 2; ++j) {
        char* wm = p.ws + OFF_WMLA + j * SZ_WMLA; char* wr = p.ws + OFF_WRW + j * SZ_WRW;
        const float* w_in = p.mla_w_in + (size_t)j * D * 448; const float* w_uq = p.mla_w_uq + (size_t)j * 256 * 1536; const float* w_ukv = p.mla_w_ukv + (size_t)j * 128 * 2048; const float* w_o = p.mla_w_o + (size_t)j * D * D;
        cvt_tiles(lds, (bf16_t*)(wm + WM_IN), 1024, 512, 1, 0, [=](int, int k, int n) -> const float* { return n < 448 ? w_in + (size_t)k * 448 + n : nullptr; }, [=](int n) { return n; });
        cvt_tiles(lds, (bf16_t*)(wm + WM_UQ), 256, 1536, 1, 0, [=](int, int k, int n) -> const float* { return w_uq + (size_t)k * 1536 + n; }, [=](int n) { return n; });
        cvt_tiles(lds, (bf16_t*)(wm + WM_UKV), 256, 2048, 1, 0, [=](int, int k, int n) -> const float* { return k < 128 ? w_ukv + (size_t)k * 2048 + n : nullptr; }, [=](int n) { return n; });
        cvt_tiles(lds, (bf16_t*)(wm + WM_O), 1024, 1024, 1, 0, [=](int, int k, int n) -> const float* { return w_o + (size_t)k * D + n; }, [=](int n) { return n; });
        const float* w_rkv = p.rw_w_rkv + (size_t)j * 3 * D * D; const float* w1 = p.rw_w1 + (size_t)j * 2 * D * 64; const float* a1 = p.rw_a1 + (size_t)j * 2 * D * 64;
        const float* g1 = p.rw_g1 + (size_t)j * D * 128; const float* v1 = p.rw_v1; const float* rwo = p.rw_w_o + (size_t)j * D * D;
        cvt_tiles(lds, (bf16_t*)(wr + WR_RKV), 1024, 1024, 3, (size_t)D * D, [=](int m, int k, int n) -> const float* { return w_rkv + ((size_t)m * D + k) * D + n; }, [=](int n) { return n; });
        cvt_tiles(lds, (bf16_t*)(wr + WR_L), 1024, 256, 1, 0, [=](int, int k, int n) -> const float* { return n < 128 ? w1 + ((size_t)(n >> 6) * D + k) * 64 + (n & 63) : nullptr; }, [=](int n) { return n; });
        cvt_tiles(lds, (bf16_t*)(wr + WR_L) + 256 * 1024, 1024, 256, 1, 0, [=](int, int k, int n) -> const float* { return n < 128 ? a1 + ((size_t)(n >> 6) * D + k) * 64 + (n & 63) : nullptr; }, [=](int n) { return n; });
        cvt_tiles(lds, (bf16_t*)(wr + WR_L) + 2 * 256 * 1024, 1024, 256, 1, 0, [=](int, int k, int n) -> const float* { return n < 128 ? g1 + (size_t)k * 128 + n : nullptr; }, [=](int n) { return n; });
        cvt_tiles(lds, (bf16_t*)(wr + WR_L) + 3 * 256 * 1024, 1024, 256, 1, 0, [=](int, int k, int n) -> const float* { return n < 32 ? v1 + (size_t)k * 32 + n : nullptr; }, [=](int n) { return n; });
        cvt_tiles(lds, (bf16_t*)(wr + WR_O), 1024, 1024, 1, 0, [=](int, int k, int n) -> const float* { return rwo + (size_t)k * D + n; }, [=](int n) { return n; });
        const float* w2 = p.rw_w2 + (size_t)j * 2 * 64 * D; const float* a2 = p.rw_a2 + (size_t)j * 2 * 64 * D; const float* g2 = p.rw_g2 + (size_t)j * 128 * D; const float* v2 = p.rw_v2;
        cvt_tiles(lds, (bf16_t*)(wr + WR_B2), 256, 4096, 1, 0, [=](int, int k, int n) -> const float* { const int blk = n >> 10, c = n & 1023, l = k - blk * 64;
            if (l < 0 || l >= 64) return nullptr; return (blk < 2 ? w2 + ((size_t)blk * 64 + l) * D : a2 + ((size_t)(blk - 2) * 64 + l) * D) + c; }, [=](int n) { return n; });
        cvt_tiles(lds, (bf16_t*)(wr + WR_B3), 256, 2048, 1, 0, [=](int, int k, int n) -> const float* {
            if (n < 1024) return k < 128 ? g2 + (size_t)k * D + n : nullptr; return (k >= 128 && k < 160) ? v2 + (size_t)(k - 128) * D + (n - 1024) : nullptr; }, [=](int n) { return n; });
    }
}

template <bool OUTF32>
__device__ void ph_norm_mod(const Params& p, int layer, const float* g, int part_sh, int part_sc, void* outp) {
    const int wid = tidx() >> 6, lane = tidx() & 63;
    const float* X = (const float*)(p.ws + OFF_X);
    for (int row = bidx() * 8 + wid; row < NROW; row += gdim() * 8) {
        const int s = row_stream(row);
        const float* sh = modp(p, layer, s, part_sh); const float* sc = modp(p, layer, s, part_sc);
        const float4* xr = (const float4*)(X + (size_t)row * D);
        float4 v[4]; float ss = 0;
#pragma unroll
        for (int i = 0; i < 4; ++i) { v[i] = xr[lane + i * 64]; ss += v[i].x * v[i].x + v[i].y * v[i].y + v[i].z * v[i].z + v[i].w * v[i].w; }
        ss = wave_sum(ss); const float rs = rsqrtf(ss * (1.f / D) + RMS_EPS);
#pragma unroll
        for (int i = 0; i < 4; ++i) {
            const int d = (lane + i * 64) * 4;
            const float4 gg = *(const float4*)(g + d), a = *(const float4*)(sc + d), b = *(const float4*)(sh + d);
            float4 o; o.x = v[i].x * rs * gg.x * (1.f + a.x) + b.x; o.y = v[i].y * rs * gg.y * (1.f + a.y) + b.y; o.z = v[i].z * rs * gg.z * (1.f + a.z) + b.z; o.w = v[i].w * rs * gg.w * (1.f + a.w) + b.w;
            if (OUTF32) *(float4*)((float*)outp + (size_t)row * D + d) = o;
            else { uint2 w; w.x = pk2(o.x, o.y); w.y = pk2(o.z, o.w); *(uint2*)((bf16_t*)outp + (size_t)row * D + d) = w; }
        }
    }
}

__device__ void ph_mla_mid(const Params& p, int j) {
    const int wid = tidx() >> 6, lane = tidx() & 63;
    const float* Z = (const float*)(p.ws + OFF_Z);
    bf16_t* CQN = (bf16_t*)(p.ws + OFF_CQN); bf16_t* CKVN = (bf16_t*)(p.ws + OFF_CKVN); float* KR = (float*)(p.ws + OFF_KR);
    const float* gq = p.mla_g_q + j * 256; const float* gkv = p.mla_g_kv + j * 128;
    const float* rc = (const float*)(p.ws + OFF_ROPE_C); const float* rs = (const float*)(p.ws + OFF_ROPE_S);
    for (int row = bidx() * 8 + wid; row < NROW; row += gdim() * 8) {
        const float* z = Z + (size_t)row * 512;
        const float4 q = *(const float4*)(z + lane * 4);
        const float2 kv = *(const float2*)(z + 256 + lane * 2);
        const float kr = z[384 + lane];
        float sq = wave_sum(q.x * q.x + q.y * q.y + q.z * q.z + q.w * q.w); const float rq = rsqrtf(sq * (1.f / 256.f) + RMS_EPS);
        float sk = wave_sum(kv.x * kv.x + kv.y * kv.y); const float rk = rsqrtf(sk * (1.f / 128.f) + RMS_EPS);
        const float4 g4 = *(const float4*)(gq + lane * 4); const float2 g2 = *(const float2*)(gkv + lane * 2);
        uint2 w; w.x = pk2(q.x * rq * g4.x, q.y * rq * g4.y); w.y = pk2(q.z * rq * g4.z, q.w * rq * g4.w);
        *(uint2*)(CQN + (size_t)row * 256 + lane * 4) = w;
        *(unsigned*)(CKVN + (size_t)row * 256 + lane * 2) = pk2(kv.x * rk * g2.x, kv.y * rk * g2.y);
        *(unsigned*)(CKVN + (size_t)row * 256 + 128 + lane * 2) = 0u;
        float o = kr;
        const auto sw = __builtin_amdgcn_permlane32_swap(__float_as_uint(kr), __float_as_uint(kr), false, false);
        if (row < NLAT) { const int t = row & (TL - 1), i = lane & 31; const float c = rc[t * 32 + i], s = rs[t * 32 + i];
            const float x1 = __uint_as_float(sw[0]), x2 = __uint_as_float(sw[1]);
            o = lane < 32 ? (x1 * c - x2 * s) : (x1 * s + x2 * c); }
        KR[(size_t)row * 64 + lane] = o;
    }
}

__device__ void ph_qkv_post(const Params& p) {
    const int wid = tidx() >> 6, lane = tidx() & 63;
    const float* QRAW = (const float*)(p.ws + OFF_QRAW); const float* KVRAW = (const float*)(p.ws + OFF_KVRAW); const float* KR = (const float*)(p.ws + OFF_KR);
    bf16_t* Q = (bf16_t*)(p.ws + OFF_Q); bf16_t* K = (bf16_t*)(p.ws + OFF_K); bf16_t* V = (bf16_t*)(p.ws + OFF_V);
    const float* rc = (const float*)(p.ws + OFF_ROPE_C); const float* rs = (const float*)(p.ws + OFF_ROPE_S);
    for (int it = bidx() * 8 + wid; it < NROW * 8; it += gdim() * 8) {
        const int row = it >> 3, h = it & 7;
        const bool lat = row < NLAT; const int b = lat ? (row >> 12) : ((row - NLAT) >> 8); const int tk = lat ? 256 + (row & (TL - 1)) : ((row - NLAT) & 255);
        const size_t orow = (size_t)(b * 8 + h) * TK + tk;
        const float* q = QRAW + (size_t)row * 1536 + h * 192;
        const float q0 = q[lane], q1 = q[64 + lane]; float q2 = q[128 + lane];
        const auto sw = __builtin_amdgcn_permlane32_swap(__float_as_uint(q2), __float_as_uint(q2), false, false);
        if (lat) { const int t = row & (TL - 1), i = lane & 31; const float c = rc[t * 32 + i], s = rs[t * 32 + i];
            const float x1 = __uint_as_float(sw[0]), x2 = __uint_as_float(sw[1]); q2 = lane < 32 ? (x1 * c - x2 * s) : (x1 * s + x2 * c); }
        bf16_t* qo = Q + orow * 192; qo[lane] = f2bf(q0); qo[64 + lane] = f2bf(q1); qo[128 + lane] = f2bf(q2);
        const float* kv = KVRAW + (size_t)row * 2048 + h * 256;
        bf16_t* ko = K + orow * 192; ko[lane] = f2bf(kv[lane]); ko[64 + lane] = f2bf(kv[64 + lane]); ko[128 + lane] = f2bf(KR[(size_t)row * 64 + lane]);
        bf16_t* vo = V + orow * 128; vo[lane] = f2bf(kv[128 + lane]); vo[64 + lane] = f2bf(kv[192 + lane]);
    }
}

__device__ void ph_attn_naive(const Params& p, char* lds) {
    const int tid = tidx(), qi = tid >> 2, part = tid & 3;
    const bf16_t* Q = (const bf16_t*)(p.ws + OFF_Q); const bf16_t* K = (const bf16_t*)(p.ws + OFF_K); const bf16_t* V = (const bf16_t*)(p.ws + OFF_V);
    bf16_t* O = (bf16_t*)(p.ws + OFF_O);
    bf16_t* Ks = (bf16_t*)lds;
    bf16_t* Vs = Ks + 32 * 192;
    const int nitems = 32 * 34;
    for (int it = bidx(); it < nitems; it += gdim()) {
        const int bh = it / 34, qb = it % 34; const int b = bh >> 3, h = bh & 7;
        const int nkeys = qb < 2 ? TC : TK;
        const int tq = qb * 128 + qi;
        const bf16_t* qp = Q + ((size_t)bh * TK + tq) * 192 + part * 48;
        float q[48];
#pragma unroll
        for (int i = 0; i < 48; ++i) q[i] = bf2f(qp[i]) * ATT_SCALE;
        float o[32];
#pragma unroll
        for (int i = 0; i < 32; ++i) o[i] = 0.f;
        float m = -1e30f, l = 0.f;
        for (int k0 = 0; k0 < nkeys; k0 += 32) {
            __syncthreads();
            {
                const bf16_t* kg = K + ((size_t)bh * TK + k0) * 192; const bf16_t* vg = V + ((size_t)bh * TK + k0) * 128;
                for (int c = tid; c < 768; c += NTHR) *(u32x4*)(Ks + c * 8) = *(const u32x4*)(kg + c * 8);
                *(u32x4*)(Vs + tid * 8) = *(const u32x4*)(vg + tid * 8);
            }
            __syncthreads();
#pragma unroll 1
            for (int kg = 0; kg < 32; kg += 8) {
                float s[8]; float tmax = -1e30f;
#pragma unroll
                for (int kk = 0; kk < 8; ++kk) {
                    const bf16_t* kr = Ks + (kg + kk) * 192 + part * 48; float acc = 0.f;
#pragma unroll
                    for (int i = 0; i < 48; ++i) acc += q[i] * bf2f(kr[i]);
                    acc += __shfl_xor(acc, 1); acc += __shfl_xor(acc, 2);
                    s[kk] = acc; tmax = fmaxf(tmax, acc);
                    asm volatile("" ::: "memory");
                }
                const float mn = fmaxf(m, tmax), alpha = expf(m - mn); m = mn; l *= alpha;
#pragma unroll
                for (int i = 0; i < 32; ++i) o[i] *= alpha;
#pragma unroll
                for (int kk = 0; kk < 8; ++kk) {
                    const float pw = expf(s[kk] - mn); l += pw;
                    const bf16_t* vr = Vs + (kg + kk) * 128 + part * 32;
#pragma unroll
                    for (int i = 0; i < 32; ++i) o[i] += pw * bf2f(vr[i]);
                    asm volatile("" ::: "memory");
                }
            }
        }
        const float rl = 1.f / l;
        const int row = qb < 2 ? (NLAT + b * TC + tq) : (b * TL + tq - TC);
        bf16_t* op = O + (size_t)row * D + h * 128 + part * 32;
#pragma unroll
        for (int i = 0; i < 32; ++i) op[i] = f2bf(o[i] * rl);
    }
}


namespace fa {
using s16x4  = __attribute__((ext_vector_type(4))) short;
using f32x16 = __attribute__((ext_vector_type(16))) float;
constexpr int DQK = 192, DV = 128, KVBLK = 64;
constexpr float THR = 8.f;
constexpr int SHM_V = KVBLK * DV * 2, SHM_K = KVBLK * DQK * 2;
constexpr int SHM_ATTN = 2 * SHM_V + 2 * SHM_K + 8 * 64 * 4;
#define KSWZ(row, colB) ((row) * 384 + ((colB) ^ (((row) & 7) << 4)))
#define SBAR() __builtin_amdgcn_sched_barrier(0)
__device__ __forceinline__ int crow(int r, int hi) { return (r & 3) + 8 * (r >> 2) + 4 * hi; }
__device__ __forceinline__ unsigned cvtpk(float lo, float hi) { unsigned r; asm volatile("v_cvt_pk_bf16_f32 %0, %1, %2" : "=v"(r) : "v"(lo), "v"(hi)); return r; }
__device__ __forceinline__ void partialSM(f32x16& p0, f32x16& p1, float& m_reg, float& mn, float& alpha) {
  constexpr float C = ATT_SCALE * 1.4426950408889634f;
  float pmax = p0[0];
#pragma unroll
  for (int r = 1; r < 16; ++r) pmax = fmaxf(pmax, p0[r]);
#pragma unroll
  for (int r = 0; r < 16; ++r) pmax = fmaxf(pmax, p1[r]);
  { auto rr = __builtin_amdgcn_permlane32_swap(__float_as_uint(pmax), __float_as_uint(pmax), false, false);
    pmax = fmaxf(__uint_as_float(rr[0]), __uint_as_float(rr[1])); }
  if (__builtin_expect(__all(pmax - m_reg <= THR / ATT_SCALE), 1)) { mn = m_reg; alpha = 1.f; }
  else { mn = fmaxf(m_reg, pmax); alpha = __builtin_amdgcn_exp2f((m_reg - mn) * C); m_reg = mn; }
  float mnC = -mn * C;
#pragma unroll
  for (int r = 0; r < 16; ++r) p0[r] = fmaf(p0[r], C, mnC);
#pragma unroll
  for (int r = 0; r < 16; ++r) p1[r] = fmaf(p1[r], C, mnC);
#pragma unroll
  for (int r = 0; r < 16; ++r) p0[r] = __builtin_amdgcn_exp2f(p0[r]);
}
__device__ __forceinline__ void finishSM(f32x16& p0, f32x16& p1, float alpha, float& l_reg, bf16x8& pa0, bf16x8& pa1, bf16x8& pa2, bf16x8& pa3) {
#pragma unroll
  for (int r = 0; r < 16; ++r) p1[r] = __builtin_amdgcn_exp2f(p1[r]);
  float ps = 0;
#pragma unroll
  for (int r = 0; r < 16; ++r) ps += p0[r];
#pragma unroll
  for (int r = 0; r < 16; ++r) ps += p1[r];
  { auto rr = __builtin_amdgcn_permlane32_swap(__float_as_uint(ps), __float_as_uint(ps), false, false);
    ps = __uint_as_float(rr[0]) + __uint_as_float(rr[1]); }
  l_reg = l_reg * alpha + ps;
#define PK4(P, BASE, OUT) do { unsigned a0 = cvtpk(P[BASE + 0], P[BASE + 1]), a1 = cvtpk(P[BASE + 2], P[BASE + 3]);   \
    unsigned b0 = cvtpk(P[BASE + 4], P[BASE + 5]), b1 = cvtpk(P[BASE + 6], P[BASE + 7]);                              \
    auto r0 = __builtin_amdgcn_permlane32_swap(a0, b0, false, false); auto r1 = __builtin_amdgcn_permlane32_swap(a1, b1, false, false); \
    u32x4 w = {r0[0], r1[0], r0[1], r1[1]}; OUT = *reinterpret_cast<bf16x8*>(&w); } while (0)
  PK4(p0, 0, pa0); PK4(p0, 8, pa1); PK4(p1, 0, pa2); PK4(p1, 8, pa3);
#undef PK4
}
__device__ __forceinline__ void qkt(f32x16& p0, f32x16& p1, const char* Ks, const bf16x8* qr, int r32, int hi) {
  p0 = f32x16{}; p1 = f32x16{};
  const int swz = (r32 & 7) << 4;
  const char* b4[4];
#pragma unroll
  for (int dr = 0; dr < 4; ++dr) b4[dr] = Ks + r32 * 384 + ((dr * 32 + hi * 16) ^ swz);
#pragma unroll
  for (int d0 = 0; d0 < 12; ++d0) {
    bf16x8 b0 = *reinterpret_cast<const bf16x8*>(b4[d0 & 3] + (d0 >> 2) * 128);
    bf16x8 b1 = *reinterpret_cast<const bf16x8*>(b4[d0 & 3] + (d0 >> 2) * 128 + 32 * 384);
    p0 = __builtin_amdgcn_mfma_f32_32x32x16_bf16(b0, qr[d0], p0, 0, 0, 0);
    p1 = __builtin_amdgcn_mfma_f32_32x32x16_bf16(b1, qr[d0], p1, 0, 0, 0); }
}
__device__ __forceinline__ int v_st(int k, int c) { const int kk = (k & ~0xC) | ((k & 4) << 1) | ((k & 8) >> 1); return ((kk >> 3) * 4 + (c >> 5)) * 512 + ((kk & 7) * 32 + (c & 31)) * 2; }
__device__ __forceinline__ int v_rd_base(int lane) { return ((lane & 3) << 3) | (((lane >> 2) & 3) << 6) | (((lane >> 4) & 1) << 5) | (((lane >> 5) & 1) << 8); }
constexpr int v_rd_off(int d0, int ks, int half) { return d0 * 512 + ks * 4096 + half * 2048; }
template <int OFF> __device__ __forceinline__ s16x4 tr_read(int vb) {
  s16x4 r; asm volatile("ds_read_b64_tr_b16 %0, %1 offset:%2" : "=&v"(r) : "v"(vb), "i"(OFF) : "memory"); return r;
}
template <int D0> __device__ __forceinline__ void pv_one(f32x16& od, int vb, bf16x8 pa0, bf16x8 pa1, bf16x8 pa2, bf16x8 pa3) {
  const s16x4 l0 = tr_read<v_rd_off(D0, 0, 0)>(vb), h0 = tr_read<v_rd_off(D0, 0, 1)>(vb), l1 = tr_read<v_rd_off(D0, 1, 0)>(vb), h1 = tr_read<v_rd_off(D0, 1, 1)>(vb);
  const s16x4 l2 = tr_read<v_rd_off(D0, 2, 0)>(vb), h2 = tr_read<v_rd_off(D0, 2, 1)>(vb), l3 = tr_read<v_rd_off(D0, 3, 0)>(vb), h3 = tr_read<v_rd_off(D0, 3, 1)>(vb);
  asm volatile("s_waitcnt lgkmcnt(0)" ::: "memory"); SBAR();
#define PK(L, H) (bf16x8){L[0], L[1], L[2], L[3], H[0], H[1], H[2], H[3]}
  od = __builtin_amdgcn_mfma_f32_32x32x16_bf16(pa0, PK(l0, h0), od, 0, 0, 0);
  od = __builtin_amdgcn_mfma_f32_32x32x16_bf16(pa1, PK(l1, h1), od, 0, 0, 0);
  od = __builtin_amdgcn_mfma_f32_32x32x16_bf16(pa2, PK(l2, h2), od, 0, 0, 0);
  od = __builtin_amdgcn_mfma_f32_32x32x16_bf16(pa3, PK(l3, h3), od, 0, 0, 0);
#undef PK
}
__device__ __forceinline__ void pv_d0(f32x16* o, int vb, bf16x8 pa0, bf16x8 pa1, bf16x8 pa2, bf16x8 pa3) {
  pv_one<0>(o[0], vb, pa0, pa1, pa2, pa3); pv_one<1>(o[1], vb, pa0, pa1, pa2, pa3); pv_one<2>(o[2], vb, pa0, pa1, pa2, pa3); pv_one<3>(o[3], vb, pa0, pa1, pa2, pa3);
}
__device__ __forceinline__ void attn_body(const bf16_t* __restrict__ Qb, const bf16_t* __restrict__ Kh, const bf16_t* __restrict__ Vh, bf16_t* __restrict__ Ob, int ldo, int seq, char* lds) {
  const int tid = tidx(), wid = tid >> 6, lane = tid & 63, r32 = lane & 31, hi = lane >> 5;
  char* V_lds = lds; char* K_lds = lds + 2 * SHM_V;
  float* ws = (float*)(lds + 2 * SHM_V + 2 * SHM_K) + wid * 64; float* li_l = ws; float* al_l = ws + 32;
  float m_reg = -1e30f, l_reg = 0; f32x16 o[4] = {}; bf16x8 qr[12];
  const bf16_t* Qw = Qb + (long)(wid * 32 + r32) * DQK + hi * 8;
#pragma unroll
  for (int d0 = 0; d0 < 12; ++d0) qr[d0] = *reinterpret_cast<const bf16x8*>(Qw + d0 * 16);
  const int sr = tid >> 4, sc = (tid & 15) * 8, vst0 = v_st(sr, sc), vst1 = v_st(32 + sr, sc);
  int kst[3];
#pragma unroll
  for (int i = 0; i < 3; ++i) { const int c = tid + 512 * i, row = c / 24, cc = c % 24; kst[i] = KSWZ(row, cc * 16); }
  const int vb0 = (int)(uintptr_t)V_lds + v_rd_base(lane);
  struct { bf16x8 vs0, vs1, ks0, ks1, ks2; } sr_[1];
#define SLOAD(i, k0) do { const bf16_t* vt = Vh + (long)(k0) * DV; const bf16_t* kt = Kh + (long)(k0) * DQK; \
    sr_[i].vs0 = *reinterpret_cast<const bf16x8*>(vt + (sr) * DV + sc); sr_[i].vs1 = *reinterpret_cast<const bf16x8*>(vt + (32 + sr) * DV + sc); \
    sr_[i].ks0 = *reinterpret_cast<const bf16x8*>(kt + tid * 8); sr_[i].ks1 = *reinterpret_cast<const bf16x8*>(kt + (tid + 512) * 8); sr_[i].ks2 = *reinterpret_cast<const bf16x8*>(kt + (tid + 1024) * 8); } while (0)
#define SWRITE(b, i) do { *(bf16x8*)(V_lds + (b) * SHM_V + vst0) = sr_[i].vs0; *(bf16x8*)(V_lds + (b) * SHM_V + vst1) = sr_[i].vs1; \
    *(bf16x8*)(K_lds + (b) * SHM_K + kst[0]) = sr_[i].ks0; *(bf16x8*)(K_lds + (b) * SHM_K + kst[1]) = sr_[i].ks1; *(bf16x8*)(K_lds + (b) * SHM_K + kst[2]) = sr_[i].ks2; } while (0)
#define SWAIT() asm volatile("s_waitcnt vmcnt(5)" ::: "memory")
#define RESC(a) do { if (__any((a) < 1.f)) { if (hi == 0) al_l[r32] = (a); asm volatile("s_waitcnt lgkmcnt(0)" ::: "memory"); \
    _Pragma("unroll") for (int d = 0; d < 4; ++d) _Pragma("unroll") for (int r = 0; r < 16; ++r) o[d][r] *= al_l[crow(r, hi)]; } } while (0)
  f32x16 pA0, pA1; float mnA, alA; bf16x8 pa0, pa1, pa2, pa3; const int NT = seq / KVBLK;
  SLOAD(0, 0); SWRITE(0, 0);
  SLOAD(0, KVBLK);
  __syncthreads();
  for (int j = 0; j < NT; j += 2) {
    SBAR(); qkt(pA0, pA1, K_lds, qr, r32, hi);
    partialSM(pA0, pA1, m_reg, mnA, alA); RESC(alA);
    finishSM(pA0, pA1, alA, l_reg, pa0, pa1, pa2, pa3); SBAR();
    SWRITE(1, 0);
    if (j + 2 < NT) SLOAD(0, (j + 2) * KVBLK);
    SBAR();
    pv_d0(o, vb0, pa0, pa1, pa2, pa3);
    __syncthreads();
    SBAR(); qkt(pA0, pA1, K_lds + SHM_K, qr, r32, hi);
    partialSM(pA0, pA1, m_reg, mnA, alA); RESC(alA);
    finishSM(pA0, pA1, alA, l_reg, pa0, pa1, pa2, pa3); SBAR();
    if (j + 2 < NT) { SWRITE(0, 0); if (j + 3 < NT) SLOAD(0, (j + 3) * KVBLK); }
    SBAR();
    pv_d0(o, vb0 + SHM_V, pa0, pa1, pa2, pa3);
    __syncthreads();
  }
  if (hi == 0) li_l[r32] = l_reg; asm volatile("s_waitcnt lgkmcnt(0)" ::: "memory");
  float rli[16];
#pragma unroll
  for (int r = 0; r < 16; ++r) rli[r] = __builtin_amdgcn_rcpf(li_l[crow(r, hi)]);
  bf16_t* Ow = Ob + (long)(wid * 32) * ldo;
#pragma unroll
  for (int r = 0; r < 16; ++r) { int orow = crow(r, hi);
#pragma unroll
    for (int d0 = 0; d0 < 4; ++d0) Ow[(long)orow * ldo + d0 * 32 + r32] = f2bf(o[d0][r] * rli[r]); }
  __syncthreads();
#undef SLOAD
#undef SWRITE
#undef SWAIT
#undef RESC
}
#undef KSWZ
}

__device__ void ph_attn(const Params& p, char* lds) {
    const bf16_t* Q = (const bf16_t*)(p.ws + OFF_Q); const bf16_t* K = (const bf16_t*)(p.ws + OFF_K); const bf16_t* V = (const bf16_t*)(p.ws + OFF_V);
    bf16_t* O = (bf16_t*)(p.ws + OFF_O);
    const int G = gdim();
    for (int i = 0;; ++i) {
        const int L = i * G + bidx(); if (L >= 544) break;
        int bh, qb;
        if (L < 512) { const int w = g8::xcd_remap(L, 512); bh = w >> 4; qb = 1 + (w & 15); } else { bh = L - 512; qb = 0; }
        const int b = bh >> 3, h = bh & 7;
        const int seq = qb == 0 ? TC : TK;
        const int row0 = qb == 0 ? NLAT + b * TC : b * TL + (qb - 1) * 256;
        fa::attn_body(Q + ((size_t)bh * TK + qb * 256) * 192, K + (size_t)bh * TK * 192, V + (size_t)bh * TK * 128, O + (size_t)row0 * D + h * 128, D, seq, lds);
    }
}

__device__ void ph_norm2_router(const Params& p, int layer, char* lds) {
    const int tid = tidx(), wid = tid >> 6, lane = tid & 63;
    float* rt = (float*)lds;
    const float* rg = p.moe_router + (size_t)layer * D * NE;
    for (int i = tid; i < D * NE / 4; i += NTHR) ((float4*)rt)[i] = ((const float4*)rg)[i];
    __syncthreads();
    const float* X = (const float*)(p.ws + OFF_X); bf16_t* BN = (bf16_t*)(p.ws + OFF_H); float* AFF = (float*)(p.ws + OFF_AFF);
    const float* g = p.norm2_g + layer * D;
    for (int row = bidx() * 8 + wid; row < NROW; row += gdim() * 8) {
        const int s = row_stream(row);
        const float* sh = modp(p, layer, s, 3); const float* sc = modp(p, layer, s, 4);
        const float4* xr = (const float4*)(X + (size_t)row * D);
        float4 v[4]; float ss = 0;
#pragma unroll
        for (int i = 0; i < 4; ++i) { v[i] = xr[lane + i * 64]; ss += v[i].x * v[i].x + v[i].y * v[i].y + v[i].z * v[i].z + v[i].w * v[i].w; }
        ss = wave_sum(ss); const float rs = rsqrtf(ss * (1.f / D) + RMS_EPS);
        float lg[16];
#pragma unroll
        for (int e = 0; e < 16; ++e) lg[e] = 0.f;
#pragma unroll
        for (int i = 0; i < 4; ++i) {
            const int d = (lane + i * 64) * 4;
            const float4 gg = *(const float4*)(g + d), a = *(const float4*)(sc + d), b = *(const float4*)(sh + d);
            float o[4]; o[0] = v[i].x * rs * gg.x * (1.f + a.x) + b.x; o[1] = v[i].y * rs * gg.y * (1.f + a.y) + b.y; o[2] = v[i].z * rs * gg.z * (1.f + a.z) + b.z; o[3] = v[i].w * rs * gg.w * (1.f + a.w) + b.w;
            uint2 w; w.x = pk2(o[0], o[1]); w.y = pk2(o[2], o[3]); *(uint2*)(BN + (size_t)row * D + d) = w;
#pragma unroll
            for (int jj = 0; jj < 4; ++jj) { const float* rr = rt + (d + jj) * 16;
#pragma unroll
                for (int e = 0; e < 16; ++e) lg[e] += o[jj] * rr[e];
                asm volatile("" ::: "memory"); }
        }
        float mx = -1e30f;
#pragma unroll
        for (int e = 0; e < 16; ++e) { lg[e] = wave_sum(lg[e]); mx = fmaxf(mx, lg[e]); }
        float sum = 0;
#pragma unroll
        for (int e = 0; e < 16; ++e) { lg[e] = expf(lg[e] - mx); sum += lg[e]; }
        const float inv = 1.f / sum;
        if (lane < 16) { float val = 0;
#pragma unroll
            for (int e = 0; e < 16; ++e) val = (lane == e) ? lg[e] : val;
            AFF[(size_t)row * 16 + lane] = val * inv; }
    }
}

__device__ void ph_select(const Params& p, char* lds) {
    const int tid = tidx(), wid = tid >> 6, lane = tid & 63;
    unsigned* hist = (unsigned*)lds;
    unsigned* ctl = hist + 256;
    unsigned* wsum = ctl + 8;
    const float* AFF = (const float*)(p.ws + OFF_AFF);
    int* ROWIDX = (int*)(p.ws + OFF_ROWIDX); float* GATE = (float*)(p.ws + OFF_GATE); int* SLOT = (int*)(p.ws + OFF_SLOT);
    for (int gidx = bidx(); gidx < 128; gidx += gdim()) {
        const bool lat = gidx < 64; const int b = (gidx & 63) >> 4, e = gidx & 15;
        const int n = lat ? TL : TC, cap = lat ? CAPL : CAPC;
        const int row0 = lat ? b * TL : NLAT + b * TC, slot0 = lat ? b * CAPL : NB * CAPL + b * CAPC;
        unsigned key[8];
#pragma unroll
        for (int i = 0; i < 8; ++i) { const int idx = tid * 8 + i; key[i] = idx < n ? __float_as_uint(AFF[(size_t)(row0 + idx) * 16 + e]) : 0u; }
        unsigned prefix = 0u, remaining = (unsigned)cap;
#pragma unroll
        for (int pass = 0; pass < 4; ++pass) {
            const int sh = 24 - 8 * pass;
            __syncthreads();
            if (tid < 256) hist[tid] = 0u;
            __syncthreads();
#pragma unroll
            for (int i = 0; i < 8; ++i) { const int idx = tid * 8 + i;
                const bool cand = idx < n && (pass == 0 || (key[i] >> (sh + 8)) == prefix);
                if (cand) atomicAdd(&hist[(key[i] >> sh) & 255u], 1u); }
            __syncthreads();
            if (tid < 256) { unsigned gt = 0; for (int jj = tid + 1; jj < 256; ++jj) gt += hist[jj];
                const unsigned mine = hist[tid];
                if (gt < remaining && remaining <= gt + mine) { ctl[0] = (unsigned)tid; ctl[1] = remaining - gt; } }
            __syncthreads();
            prefix = (prefix << 8) | ctl[0]; remaining = ctl[1];
        }
        const unsigned T = prefix, m = remaining;
        unsigned cgt = 0, ceq = 0;
#pragma unroll
        for (int i = 0; i < 8; ++i) { const int idx = tid * 8 + i; if (idx < n) { cgt += key[i] > T ? 1u : 0u; ceq += key[i] == T ? 1u : 0u; } }
        auto block_excl = [&](unsigned v) -> unsigned {
            unsigned inc = v;
#pragma unroll
            for (int o = 1; o < 64; o <<= 1) { const unsigned t = (unsigned)__builtin_amdgcn_ds_bpermute((lane - o) << 2, (int)inc); if (lane >= o) inc += t; }
            __syncthreads();
            if (lane == 63) wsum[wid] = inc;
            __syncthreads();
            unsigned base = 0;
#pragma unroll
            for (int w = 0; w < 8; ++w) base += (w < wid) ? wsum[w] : 0u;
            return base + inc - v; };
        unsigned eqbase = block_excl(ceq);
        unsigned nsel = 0; bool sel[8];
#pragma unroll
        for (int i = 0; i < 8; ++i) { const int idx = tid * 8 + i; bool s_ = false;
            if (idx < n) { if (key[i] > T) s_ = true; else if (key[i] == T) { s_ = eqbase < m; ++eqbase; } }
            sel[i] = s_; nsel += s_ ? 1u : 0u; }
        unsigned sbase = block_excl(nsel);
#pragma unroll
        for (int i = 0; i < 8; ++i) { const int idx = tid * 8 + i;
            if (idx < n) {
                if (sel[i]) { const int sl = slot0 + (int)sbase; ++sbase; ROWIDX[e * ESLOTS + sl] = row0 + idx; GATE[e * EPAD + sl] = __uint_as_float(key[i]); SLOT[(size_t)(row0 + idx) * 16 + e] = sl; }
                else SLOT[(size_t)(row0 + idx) * 16 + e] = -1; } }
    }
}

__device__ void ph_gather(const Params& p) {
    const int wid = tidx() >> 6, lane = tidx() & 63;
    const int* ROWIDX = (const int*)(p.ws + OFF_ROWIDX); const bf16_t* BN = (const bf16_t*)(p.ws + OFF_H); bf16_t* XE = (bf16_t*)(p.ws + OFF_XE);
    for (int it = bidx() * 8 + wid; it < NE * ESLOTS; it += gdim() * 8) {
        const int row = ROWIDX[it]; const int e = it / ESLOTS, sl = it % ESLOTS;
        const u32x4* src = (const u32x4*)(BN + (size_t)row * D); u32x4* dst = (u32x4*)(XE + ((size_t)e * EPAD + sl) * D);
        dst[lane] = src[lane]; dst[lane + 64] = src[lane + 64];
    }
}

__device__ void ph_combine(const Params& p, int layer) {
    const int wid = tidx() >> 6, lane = tidx() & 63;
    const int* SLOT = (const int*)(p.ws + OFF_SLOT); const bf16_t* YE = (const bf16_t*)(p.ws + OFF_YE); float* X = (float*)(p.ws + OFF_X);
    for (int row = bidx() * 8 + wid; row < NROW; row += gdim() * 8) {
        const float* gt = modp(p, layer, row_stream(row), 5);
        float acc[16];
#pragma unroll
        for (int i = 0; i < 16; ++i) acc[i] = 0.f;
        for (int e = 0; e < NE; ++e) {
            const int s = SLOT[(size_t)row * 16 + e];
            if (s >= 0) { const bf16_t* y = YE + ((size_t)e * EPAD + s) * D + lane * 16;
                const u32x4 a = *(const u32x4*)y, b = *(const u32x4*)(y + 8);
                const unsigned w[8] = {a.x, a.y, a.z, a.w, b.x, b.y, b.z, b.w};
#pragma unroll
                for (int i = 0; i < 8; ++i) { acc[2 * i] += __uint_as_float(w[i] << 16); acc[2 * i + 1] += __uint_as_float(w[i] & 0xffff0000u); } }
        }
        float* xr = X + (size_t)row * D + lane * 16; const float* g = gt + lane * 16;
#pragma unroll
        for (int i = 0; i < 16; i += 4) { float4 xv = *(float4*)(xr + i); const float4 gv = *(const float4*)(g + i);
            xv.x += gv.x * acc[i]; xv.y += gv.y * acc[i + 1]; xv.z += gv.z * acc[i + 2]; xv.w += gv.w * acc[i + 3]; *(float4*)(xr + i) = xv; }
    }
}

__device__ void ph_rw_normxs(const Params& p, int layer, int j) {
    const int wid = tidx() >> 6, lane = tidx() & 63;
    const float* X = (const float*)(p.ws + OFF_X); bf16_t* XS = (bf16_t*)(p.ws + OFF_XS);
    const float* mu = p.rw_mu + (size_t)j * 6 * D; const float* g = p.norm1_g + layer * D;
    for (int row = bidx() * 8 + wid; row < NROW; row += gdim() * 8) {
        const int s_ = row_stream(row);
        const float* sh = modp(p, layer, s_, 0); const float* sc = modp(p, layer, s_, 1);
        const bool lat = row < NLAT; const int t = lat ? (row & (TL - 1)) : ((row - NLAT) & (TC - 1)); const int len = lat ? TL : TC;
        const bool hp = t > 0, hn = t < len - 1;
        float4 xc[4], xp[4], xn[4]; float sc_ = 0, sp_ = 0, sn_ = 0;
#pragma unroll
        for (int i = 0; i < 4; ++i) {
            xc[i] = ((const float4*)(X + (size_t)row * D))[lane + i * 64];
            xp[i] = hp ? ((const float4*)(X + (size_t)(row - 1) * D))[lane + i * 64] : make_float4(0, 0, 0, 0);
            xn[i] = hn ? ((const float4*)(X + (size_t)(row + 1) * D))[lane + i * 64] : make_float4(0, 0, 0, 0);
            sc_ += xc[i].x * xc[i].x + xc[i].y * xc[i].y + xc[i].z * xc[i].z + xc[i].w * xc[i].w;
            sp_ += xp[i].x * xp[i].x + xp[i].y * xp[i].y + xp[i].z * xp[i].z + xp[i].w * xp[i].w;
            sn_ += xn[i].x * xn[i].x + xn[i].y * xn[i].y + xn[i].z * xn[i].z + xn[i].w * xn[i].w; }
        sc_ = wave_sum(sc_); sp_ = wave_sum(sp_); sn_ = wave_sum(sn_);
        const float rc = rsqrtf(sc_ * (1.f / D) + RMS_EPS), rp = hp ? rsqrtf(sp_ * (1.f / D) + RMS_EPS) : 0.f, rn = hn ? rsqrtf(sn_ * (1.f / D) + RMS_EPS) : 0.f;
#pragma unroll
        for (int i = 0; i < 4; ++i) {
            const int d = (lane + i * 64) * 4;
            const float4 gg = *(const float4*)(g + d), a = *(const float4*)(sc + d), bsh = *(const float4*)(sh + d);
            float h[4], xx[4];
            const float gm[4] = {gg.x * (1.f + a.x), gg.y * (1.f + a.y), gg.z * (1.f + a.z), gg.w * (1.f + a.w)}; const float bb[4] = {bsh.x, bsh.y, bsh.z, bsh.w};
            const float c4[4] = {xc[i].x, xc[i].y, xc[i].z, xc[i].w}, p4[4] = {xp[i].x, xp[i].y, xp[i].z, xp[i].w}, n4[4] = {xn[i].x, xn[i].y, xn[i].z, xn[i].w};
#pragma unroll
            for (int e = 0; e < 4; ++e) { h[e] = c4[e] * rc * gm[e] + bb[e];
                const float hpv = hp ? p4[e] * rp * gm[e] + bb[e] : 0.f, hnv = hn ? n4[e] * rn * gm[e] + bb[e] : 0.f;
                xx[e] = 0.5f * (hpv + hnv) - h[e]; }
#pragma unroll
            for (int m = 0; m < 6; ++m) { const float4 u = *(const float4*)(mu + m * D + d);
                uint2 w; w.x = pk2(h[0] + xx[0] * u.x, h[1] + xx[1] * u.y); w.y = pk2(h[2] + xx[2] * u.z, h[3] + xx[3] * u.w);
                *(uint2*)(XS + ((size_t)m * NROW + row) * D + d) = w; }
        }
    }
}

__device__ __forceinline__ int scan_row(int i, int b, int z) {
    return i < TC ? NLAT + b * TC + (z ? TC - 1 - i : i) : b * TL + (z ? TL - 1 - (i - TC) : i - TC);
}
__device__ __forceinline__ float dpp_sum8(float x) {
    x += __builtin_bit_cast(float, __builtin_amdgcn_update_dpp(0, __builtin_bit_cast(int, x), 0xB1, 0xF, 0xF, true));
    x += __builtin_bit_cast(float, __builtin_amdgcn_update_dpp(0, __builtin_bit_cast(int, x), 0x4E, 0xF, 0xF, true));
    x += __builtin_bit_cast(float, __builtin_amdgcn_update_dpp(0, __builtin_bit_cast(int, x), 0x141, 0xF, 0xF, true));
    return x;
}
__device__ void ph_rw_scan(const Params& p, int j, char* lds) {
    const int tid = tidx(), wid = __builtin_amdgcn_readfirstlane(tid >> 6), lane = tid & 63;
    const size_t PL = (size_t)NROW * D;
    const float* RKV = (const float*)(p.ws + OFF_RKV); float* Y = (float*)(p.ws + OFF_Y);
    constexpr int CH = 32, BUFB = 5 * CH * 256 + CH * 128 + CH * 16, YB = CH * 32 * 4, NCH = (TC + TL) / CH;
    const bool loader = wid >= 4; const int lw = wid - 4;
    for (int it = bidx(); it < 256; it += gdim()) {
        const int vh = it & 1, z = (it >> 1) & 1, h = (it >> 2) & 15, b = it >> 6;
        const char* pl0 = (const char*)((const float*)(p.ws + OFF_W) + z * PL); const char* pl1 = (const char*)(RKV + PL);
        const char* pl2 = (const char*)((const float*)(p.ws + OFF_AV) + z * PL); const char* pl3 = (const char*)RKV;
        const char* vpl = (const char*)(RKV + 2 * PL);
        float* yout = Y + z * PL;
        __builtin_amdgcn_s_barrier();
        if (loader) {
            const int pq = lane & 15;
            const f32x4 kkv = *(const f32x4*)(p.rw_k_k + j * D + h * 64 + pq * 4), kav = *(const f32x4*)(p.rw_k_a + j * D + h * 64 + pq * 4);
            auto issue = [&](int c) {
                char* buf = lds + (c % 3) * BUFB;
#pragma unroll
                for (int q = 0; q < 8; ++q) { const int pi = q >> 1, tg = lw * 2 + (q & 1); const int row = scan_row(c * CH + tg * 4 + (lane >> 4), b, z);
                    const char* base = pi == 0 ? pl0 : pi == 1 ? pl1 : pi == 2 ? pl2 : pl3;
                    __builtin_amdgcn_global_load_lds((const unsigned*)(base + (size_t)row * D * 4 + h * 256 + (lane & 15) * 16), (LAS unsigned*)(buf + pi * (CH * 256) + tg * 1024), 16, 0, 0); }
                { const int row = scan_row(c * CH + lw * 8 + (lane >> 3), b, z);
                  __builtin_amdgcn_global_load_lds((const unsigned*)(vpl + (size_t)row * D * 4 + (h * 64 + vh * 32) * 4 + (lane & 7) * 16), (LAS unsigned*)(buf + 5 * CH * 256 + lw * 1024), 16, 0, 0); }
            };
            auto prep = [&](int c) {
                char* buf = lds + (c % 3) * BUFB;
#pragma unroll
                for (int ps = 0; ps < 2; ++ps) { const int ptok = lw * 8 + ps * 4 + (lane >> 4);
                    f32x4* kp = (f32x4*)(buf + 1 * CH * 256 + ptok * 256 + pq * 16); f32x4* ap = (f32x4*)(buf + 2 * CH * 256 + ptok * 256 + pq * 16); f32x4* dp = (f32x4*)(buf + 4 * CH * 256 + ptok * 256 + pq * 16);
                    f32x4* rp = (f32x4*)(buf + 3 * CH * 256 + ptok * 256 + pq * 16); const f32x4 wv = *(const f32x4*)(buf + ptok * 256 + pq * 16);
                    const f32x4 k = *kp, a = *ap, r = *rp; f32x4 kk = k * kkv;
                    float ss = kk[0] * kk[0] + kk[1] * kk[1] + kk[2] * kk[2] + kk[3] * kk[3]; ss = dpp_sum16(ss);
                    const float inv = 1.f / fmaxf(sqrtf(ss), 1e-12f); kk = kk * inv;
                    const f32x4 kd = k * (1.f + (a - 1.f) * kav), bb = kk * a;
                    const f32x4 t1 = bb * r, t2 = kd * r;
                    const float br = dpp_sum16((t1[0] + t1[1]) + (t1[2] + t1[3])), kr = dpp_sum16((t2[0] + t2[1]) + (t2[2] + t2[3]));
                    *dp = kd; *ap = bb; *kp = kk; *rp = wv * r;
                    if (pq == 0) *(float2*)(buf + 5 * CH * 256 + CH * 128 + ptok * 16) = make_float2(br, kr); }
            };
            issue(0); issue(1);
            asm volatile("s_waitcnt vmcnt(9)" ::: "memory");
            prep(0);
            asm volatile("s_waitcnt lgkmcnt(0)" ::: "memory"); __builtin_amdgcn_s_barrier();
            for (int c = 0; c < NCH; ++c) {
                if (c >= 1) { const float* yb = (const float*)(lds + 3 * BUFB + ((c - 1) & 1) * YB);
                    const int lt = tid - 256, t = lt >> 3, q = lt & 7; const int row = scan_row((c - 1) * CH + t, b, z);
                    *(f32x4*)(yout + (size_t)row * D + h * 64 + vh * 32 + q * 4) = *(const f32x4*)(yb + t * 32 + q * 4); }
                if (c + 2 < NCH) { issue(c + 2); asm volatile("s_waitcnt vmcnt(9)" ::: "memory"); } else asm volatile("s_waitcnt vmcnt(0)" ::: "memory");
                if (c + 1 < NCH) prep(c + 1);
                asm volatile("s_waitcnt lgkmcnt(0)" ::: "memory"); __builtin_amdgcn_s_barrier();
            }
            { const float* yb = (const float*)(lds + 3 * BUFB + ((NCH - 1) & 1) * YB);
              const int lt = tid - 256, t = lt >> 3, q = lt & 7; const int row = scan_row((NCH - 1) * CH + t, b, z);
              *(f32x4*)(yout + (size_t)row * D + h * 64 + vh * 32 + q * 4) = *(const f32x4*)(yb + t * 32 + q * 4); }
        } else {
            const int vr = lane >> 3, ks = lane & 7;
            f32x4 Sa = {0.f, 0.f, 0.f, 0.f}, Sb = {0.f, 0.f, 0.f, 0.f};
            __builtin_amdgcn_s_barrier();
            struct Ops { f32x4 w0, w1, kk0, kk1, bb0, bb1, r0, r1, kd0, kd1; float v; float2 sc; };
#define SC_LOAD(O, t) do { const char* q_ = bq + (t) * 256; O.w0 = *(const f32x4*)(q_); O.w1 = *(const f32x4*)(q_ + 16); O.kk0 = *(const f32x4*)(q_ + CH * 256); O.kk1 = *(const f32x4*)(q_ + CH * 256 + 16); \
                O.bb0 = *(const f32x4*)(q_ + 2 * CH * 256); O.bb1 = *(const f32x4*)(q_ + 2 * CH * 256 + 16); O.r0 = *(const f32x4*)(q_ + 3 * CH * 256); O.r1 = *(const f32x4*)(q_ + 3 * CH * 256 + 16); \
                O.kd0 = *(const f32x4*)(q_ + 4 * CH * 256); O.kd1 = *(const f32x4*)(q_ + 4 * CH * 256 + 16); O.v = *(const float*)(vq + (t) * 128); O.sc = *(const float2*)(buf + 5 * CH * 256 + CH * 128 + (t) * 16); } while (0)
#define SC_STEP(O, t) do { const f32x4 d1 = Sa * O.kk0 + Sb * O.kk1, d2 = Sa * O.r0 + Sb * O.r1; \
                float sa = -((d1[0] + d1[1]) + (d1[2] + d1[3])), yy = (d2[0] + d2[1]) + (d2[2] + d2[3]); \
                sa = dpp_sum8(sa); yy = dpp_sum8(yy); \
                Sa = Sa * O.w0 + (sa * O.bb0 + O.v * O.kd0); Sb = Sb * O.w1 + (sa * O.bb1 + O.v * O.kd1); \
                if (ks == 0) yb[(t) * 32 + wid * 8 + vr] = yy + sa * O.sc.x + O.v * O.sc.y; } while (0)
            for (int c = 0; c < NCH; ++c) {
                const char* buf = lds + (c % 3) * BUFB; float* yb = (float*)(lds + 3 * BUFB + (c & 1) * YB);
                const char* bq = buf + ks * 32; const char* vq = buf + 5 * CH * 256 + (wid * 8 + vr) * 4;
                Ops oA, oB, oC;
                SC_LOAD(oA, 0); SC_LOAD(oB, 1);
#pragma unroll
                for (int t = 0; t < CH; t += 3) {
                    if (t + 2 < CH) SC_LOAD(oC, t + 2);
                    SC_STEP(oA, t);
                    if (t + 3 < CH) SC_LOAD(oA, t + 3);
                    if (t + 1 < CH) SC_STEP(oB, t + 1);
                    if (t + 4 < CH) SC_LOAD(oB, t + 4);
                    if (t + 2 < CH) SC_STEP(oC, t + 2);
                }
                asm volatile("s_waitcnt lgkmcnt(0)" ::: "memory"); __builtin_amdgcn_s_barrier();
            }
#undef SC_LOAD
#undef SC_STEP
        }
    }
}

__device__ void ph_rw_out(const Params& p, int j) {
    const int wid = tidx() >> 6, lane = tidx() & 63;
    const float* RKV = (const float*)(p.ws + OFF_RKV); const float* AV = (const float*)(p.ws + OFF_AV); const float* G = (const float*)(p.ws + OFF_G); const float* Y = (const float*)(p.ws + OFF_Y);
    bf16_t* OUT = (bf16_t*)(p.ws + OFF_H);
    const size_t PL = (size_t)NROW * D;
    const float* r_k = p.rw_r_k + j * D; const float* lg = p.rw_lnx_g + j * D; const float* lb = p.rw_lnx_b + j * D; const float* k_a = p.rw_k_a + j * D;
    for (int row = bidx() * 8 + wid; row < NROW; row += gdim() * 8) {
#pragma unroll
        for (int i = 0; i < 4; ++i) {
            const size_t o = (size_t)row * D + lane * 4 + i * 256; const int c = lane * 4 + i * 256;
            const f32x4 y = *(const f32x4*)(Y + o) + *(const f32x4*)(Y + PL + o);
            const float mean = dpp_sum16(y[0] + y[1] + y[2] + y[3]) * (1.f / 64.f);
            const f32x4 dd = y - mean;
            const float rstd = rsqrtf(dpp_sum16(dd[0] * dd[0] + dd[1] * dd[1] + dd[2] * dd[2] + dd[3] * dd[3]) * (1.f / 64.f) + LNX_EPS);
            const f32x4 r = *(const f32x4*)(RKV + o), k = *(const f32x4*)(RKV + PL + o), v = *(const f32x4*)(RKV + 2 * PL + o);
            const f32x4 a0 = *(const f32x4*)(AV + o), a1 = *(const f32x4*)(AV + PL + o);
            const f32x4 kds = k * (2.f + (a0 + a1 - 2.f) * *(const f32x4*)(k_a + c));
            const f32x4 t4 = r * kds * *(const f32x4*)(r_k + c);
            const float bs = dpp_sum16(t4[0] + t4[1] + t4[2] + t4[3]);
            const f32x4 res = (dd * rstd * *(const f32x4*)(lg + c) + *(const f32x4*)(lb + c) + bs * v) * *(const f32x4*)(G + o);
            uint2 w; w.x = pk2(res[0], res[1]); w.y = pk2(res[2], res[3]); *(uint2*)(OUT + o) = w;
        }
    }
}

__device__ void ph_final(const Params& p) {
    const int wid = tidx() >> 6, lane = tidx() & 63;
    const float* X = (const float*)(p.ws + OFF_X);
    for (int row = bidx() * 8 + wid; row < NLAT; row += gdim() * 8) {
        const float4* xr = (const float4*)(X + (size_t)row * D);
        float4 v[4]; float ss = 0;
#pragma unroll
        for (int i = 0; i < 4; ++i) { v[i] = xr[lane + i * 64]; ss += v[i].x * v[i].x + v[i].y * v[i].y + v[i].z * v[i].z + v[i].w * v[i].w; }
        ss = wave_sum(ss); const float rs = rsqrtf(ss * (1.f / D) + RMS_EPS);
#pragma unroll
        for (int i = 0; i < 4; ++i) { const int d = (lane + i * 64) * 4; const float4 gg = *(const float4*)(p.final_g + d);
            float4 o; o.x = v[i].x * rs * gg.x; o.y = v[i].y * rs * gg.y; o.z = v[i].z * rs * gg.z; o.w = v[i].w * rs * gg.w;
            *(float4*)(p.out + (size_t)row * D + d) = o; }
    }
}

enum { PH_INIT = 0, PH_A_NORM, PH_A_Z, PH_A_MID, PH_A_QKV, PH_A_POST, PH_A_ATTN, PH_A_WO,
       PH_R_NORM, PH_R_XS, PH_R_G1, PH_R_G2, PH_R_PREP, PH_R_SCAN, PH_R_OUT, PH_R_WO,
       PH_M_NORM, PH_M_SEL, PH_M_GATHER, PH_M_G1, PH_M_G2, PH_M_COMB, PH_FINAL, PH_M_CVT };

template <int PH>
__device__ __forceinline__ void run_phase(const Params& p, int layer, char* lds) {
    const int j = layer >> 1;
    char* ws = p.ws;
    if constexpr (PH == PH_INIT) { ph_init(p, lds); __syncthreads(); ph_small_cvt(p, lds); }
    else if constexpr (PH == PH_A_NORM) ph_norm_mod<false>(p, layer, p.norm1_g + layer * D, 0, 1, ws + OFF_H);
    else if constexpr (PH == PH_A_Z) {
        float* Z = (float*)(ws + OFF_Z);
        g8::BatchSched S{ws + OFF_H, ws + OFF_WMLA + j * SZ_WMLA + WM_IN, 0, 0, NROW / 256, 2, 1, D};
        g8::gemm_phase((PG8_LAS unsigned char*)lds, D, S, g8::epi_rc([=](const g8::Unit&, int row, int col, f32x4 v) { *(f32x4*)(Z + (size_t)row * 512 + col) = v; }));
    }
    else if constexpr (PH == PH_A_MID) ph_mla_mid(p, j);
    else if constexpr (PH == PH_A_QKV) {
        float* QRAW = (float*)(ws + OFF_QRAW); float* KVRAW = (float*)(ws + OFF_KVRAW);
        g8::BatchSched S1{ws + OFF_CQN, ws + OFF_WMLA + j * SZ_WMLA + WM_UQ, 0, 0, NROW / 256, 6, 1, 256};
        g8::gemm_phase((PG8_LAS unsigned char*)lds, 256, S1, g8::epi_rc([=](const g8::Unit&, int row, int col, f32x4 v) { *(f32x4*)(QRAW + (size_t)row * 1536 + col) = v; }));
        g8::BatchSched S2{ws + OFF_CKVN, ws + OFF_WMLA + j * SZ_WMLA + WM_UKV, 0, 0, NROW / 256, 8, 1, 256};
        g8::gemm_phase((PG8_LAS unsigned char*)lds, 256, S2, g8::epi_rc([=](const g8::Unit&, int row, int col, f32x4 v) { *(f32x4*)(KVRAW + (size_t)row * 2048 + col) = v; }));
    }
    else if constexpr (PH == PH_A_POST) ph_qkv_post(p);
    else if constexpr (PH == PH_A_ATTN) ph_attn(p, lds);
    else if constexpr (PH == PH_A_WO || PH == PH_R_WO) {
        float* X = (float*)(ws + OFF_X); const float* MOD = (const float*)(ws + OFF_MOD);
        g8::BatchSched S{ws + (PH == PH_A_WO ? OFF_O : OFF_H), PH == PH_A_WO ? ws + OFF_WMLA + j * SZ_WMLA + WM_O : ws + OFF_WRW + j * SZ_WRW + WR_O, 0, 0, NROW / 256, 4, 1, D};
        g8::gemm_phase((PG8_LAS unsigned char*)lds, D, S, g8::epi_rc([=](const g8::Unit&, int row, int col, f32x4 v) {
            const f32x4 gt = *(const f32x4*)(MOD + ((size_t)layer * 5 + row_stream(row)) * 6144 + 2048 + col);
            f32x4* xp = (f32x4*)(X + (size_t)row * D + col); *xp = *xp + gt * v; }));
    }
    else if constexpr (PH == PH_R_XS) ph_rw_normxs(p, layer, j);
    else if constexpr (PH == PH_R_G1) {
        float* RKV = (float*)(ws + OFF_RKV); float* VF = (float*)(ws + OFF_VFIRST);
        bf16_t* A2 = (bf16_t*)(ws + OFF_A2); bf16_t* A3 = (bf16_t*)(ws + OFF_A3);
        const bool first = (j == 0);
        struct RSched { const char* XS; const char* WB; int nwg;
            __device__ __forceinline__ bool next(int i, g8::Unit& u) const {
                const int L = i * gdim() + bidx(); if (L >= nwg) return false;
                const int w = g8::xcd_remap(L, nwg);
                if (w < 816) { u.g = w / 272; const int r = w % 272; u.pm = r >> 2; u.pn = r & 3; u.B = WB + WR_RKV + (size_t)u.g * D * D * 2 + (size_t)u.pn * 256 * D * 2; }
                else { u.g = 3 + (w - 816) / 68; u.pm = (w - 816) % 68; u.pn = 0; u.B = WB + WR_L + (size_t)(u.g - 3) * 256 * D * 2; }
                u.A = XS + (size_t)(u.g == 6 ? 2 : u.g) * NROW * D * 2 + (size_t)u.pm * 256 * D * 2; return true; } };
        RSched S{ws + OFF_XS, ws + OFF_WRW + j * SZ_WRW, first ? 816 + 204 : 816 + 272};
        g8::gemm_phase((PG8_LAS unsigned char*)lds, D, S, g8::epi_rc([=](const g8::Unit& u, int row, int col, f32x4 v) {
            if (u.g < 3) { *(f32x4*)(RKV + ((size_t)u.g * NROW + row) * D + col) = v; if (first && u.g == 2) *(f32x4*)(VF + (size_t)row * D + col) = v; }
            else if (u.g == 3) { if (col < 128) { uint2 w; w.x = pk2(tanhf(v[0]), tanhf(v[1])); w.y = pk2(tanhf(v[2]), tanhf(v[3])); *(uint2*)(A2 + (size_t)row * 256 + col) = w; } }
            else if (u.g == 4) { if (col < 128) { uint2 w; w.x = pk2(v[0], v[1]); w.y = pk2(v[2], v[3]); *(uint2*)(A2 + (size_t)row * 256 + 128 + col) = w; } }
            else if (u.g == 5) { uint2 w; if (col < 128) { w.x = pk2(sigmoidf_(v[0]), sigmoidf_(v[1])); w.y = pk2(sigmoidf_(v[2]), sigmoidf_(v[3])); } else { w.x = 0u; w.y = 0u; }
                                 if (col < 128 || first || col >= 160) *(uint2*)(A3 + (size_t)row * 256 + col) = w; }
            else { if (col < 32) { uint2 w; w.x = pk2(v[0], v[1]); w.y = pk2(v[2], v[3]); *(uint2*)(A3 + (size_t)row * 256 + 128 + col) = w; } } }));
    }
    else if constexpr (PH == PH_R_G2) {
        const bool first = (j == 0);
        float* W = (float*)(ws + OFF_W); float* AV = (float*)(ws + OFF_AV); float* G = (float*)(ws + OFF_G); float* RKV = (float*)(ws + OFF_RKV); const float* VF = (const float*)(ws + OFF_VFIRST);
        const float* w0 = p.rw_w0 + (size_t)j * 2 * D; const float* a0 = p.rw_a0 + (size_t)j * 2 * D; const float* v0 = p.rw_v0;
        g8::BatchSched S1{ws + OFF_A2, ws + OFF_WRW + j * SZ_WRW + WR_B2, 0, 0, NROW / 256, 16, 1, 256};
        g8::gemm_phase((PG8_LAS unsigned char*)lds, 256, S1, g8::epi_rc([=](const g8::Unit& u, int row, int col, f32x4 v) {
            const int blk = u.pn >> 2, c = col & 1023; const bool dec = blk < 2;
            const float* bias = (dec ? w0 + blk * D : a0 + (blk - 2) * D) + c; float* dst = (dec ? W + (size_t)blk * NROW * D : AV + (size_t)(blk - 2) * NROW * D) + (size_t)row * D + c;
            const f32x4 x = v + *(const f32x4*)bias; f32x4 o;
#pragma unroll
            for (int e = 0; e < 4; ++e) { const float sg = 1.f / (1.f + __expf(-x[e])); o[e] = dec ? __expf(-0.6065306597126334f * sg) : sg; }
            *(f32x4*)dst = o; }));
        g8::BatchSched S2{ws + OFF_A3, ws + OFF_WRW + j * SZ_WRW + WR_B3, 0, 0, NROW / 256, first ? 4 : 8, 1, 256};
        g8::gemm_phase((PG8_LAS unsigned char*)lds, 256, S2, g8::epi_rc([=](const g8::Unit&, int row, int col, f32x4 v) {
            if (col < 1024) *(f32x4*)(G + (size_t)row * D + col) = v;
            else { const int c = col - 1024; const size_t o = (size_t)row * D + c; const f32x4 vv = *(const f32x4*)(RKV + (size_t)2 * NROW * D + o), vf = *(const f32x4*)(VF + o), gz = v + *(const f32x4*)(v0 + c); f32x4 r;
#pragma unroll
                for (int e = 0; e < 4; ++e) r[e] = vv[e] + (vf[e] - vv[e]) / (1.f + __expf(-gz[e]));
                *(f32x4*)(RKV + (size_t)2 * NROW * D + o) = r; } }));
    }
    else if constexpr (PH == PH_R_SCAN) ph_rw_scan(p, j, lds);
    else if constexpr (PH == PH_R_OUT) ph_rw_out(p, j);
    else if constexpr (PH == PH_M_NORM) ph_norm2_router(p, layer, lds);
    else if constexpr (PH == PH_M_SEL) ph_select(p, lds);
    else if constexpr (PH == PH_M_GATHER) ph_gather(p);
    else if constexpr (PH == PH_M_G1) {
        bf16_t* HID = (bf16_t*)(ws + OFF_HID);
        g8::BatchSched S{ws + OFF_XE, ws + OFF_W13T, (size_t)EPAD * D * 2, (size_t)2816 * D * 2, EPAD / 256, 11, NE, D};
        g8::gemm_phase((PG8_LAS unsigned char*)lds, D, S, g8::epi_pair([=](const g8::Unit& u, int row, int col, f32x4 a, f32x4 b) {
            uint2 w; w.x = pk2(a[0] / (1.f + __expf(-a[0])) * b[0], a[1] / (1.f + __expf(-a[1])) * b[1]); w.y = pk2(a[2] / (1.f + __expf(-a[2])) * b[2], a[3] / (1.f + __expf(-a[3])) * b[3]);
            *(uint2*)(HID + ((size_t)u.g * EPAD + row) * FF + col) = w; }));
    }
    else if constexpr (PH == PH_M_G2) {
        bf16_t* YE = (bf16_t*)(ws + OFF_YE); const float* GATE = (const float*)(ws + OFF_GATE);
        g8::BatchSched S{ws + OFF_HID, ws + OFF_W2T, (size_t)EPAD * FF * 2, (size_t)D * FF * 2, EPAD / 256, 4, NE, FF};
        g8::gemm_phase((PG8_LAS unsigned char*)lds, FF, S, g8::epi_rc([=](const g8::Unit& u, int row, int col, f32x4 v) {
            const float gt = GATE[u.g * EPAD + row];
            uint2 w; w.x = pk2(v[0] * gt, v[1] * gt); w.y = pk2(v[2] * gt, v[3] * gt);
            *(uint2*)(YE + ((size_t)u.g * EPAD + row) * D + col) = w; }));
    }
    else if constexpr (PH == PH_M_COMB) ph_combine(p, layer);
    else if constexpr (PH == PH_M_CVT) ph_moe_cvt(p, layer, lds);
    else if constexpr (PH == PH_FINAL) ph_final(p);
}

#if ONE_LAUNCH
#define SYNC() xcd_barrier(bar)
#ifndef PROBE_PH
#define PROBE_PH -1
#endif
#ifndef PROBE_REP
#define PROBE_REP 1
#endif
__device__ __forceinline__ Params load_params() {
    Params q{};
#if defined(__HIP_DEVICE_COMPILE__)
    typedef const __attribute__((address_space(4))) unsigned long long* KargP;
    KargP kp_ = (KargP)__builtin_amdgcn_kernarg_segment_ptr(); asm volatile("" : "+s"(kp_));
#pragma unroll
    for (int i = 0; i < (int)(sizeof(Params) / 8); ++i) ((unsigned long long*)&q)[i] = kp_[i];
#endif
    return q;
}
#define RUN(PH) do { for (int rep_ = 0; rep_ < ((PH) == PROBE_PH ? PROBE_REP : 1); ++rep_) { const Params q = load_params(); run_phase<PH>(q, layer, smem); SYNC(); } } while (0)
__global__ void __launch_bounds__(NTHR, 2) mega(Params p) {
    extern __shared__ __attribute__((aligned(16))) char smem[];
    if (tidx() == 0) *(uint4*)(smem + LDS_BYTES) = make_uint4(0u, 0u, 0u, 0u);
    __syncthreads();
    XcdBarrier bar = xcd_barrier_post((unsigned*)(p.ws + OFF_BAR), (volatile LAS unsigned*)(smem + LDS_BYTES));
    { const int layer = 0; RUN(PH_INIT); }
    for (int layer = 0; layer < 4; ++layer) {
        if ((layer & 1) == 0) {
            RUN(PH_A_NORM);
            RUN(PH_A_Z);
            RUN(PH_A_MID);
            RUN(PH_A_QKV);
            RUN(PH_A_POST);
            RUN(PH_A_ATTN);
            RUN(PH_A_WO);
        } else {
            RUN(PH_R_XS);
            RUN(PH_R_G1);
            RUN(PH_R_G2);
            RUN(PH_R_SCAN);
            RUN(PH_R_OUT);
            RUN(PH_R_WO);
        }
        RUN(PH_M_CVT);
        RUN(PH_M_NORM);
        RUN(PH_M_SEL);
        RUN(PH_M_GATHER);
        RUN(PH_M_G1);
        RUN(PH_M_G2);
        RUN(PH_M_COMB);
    }
    { const Params q = load_params(); run_phase<PH_FINAL>(q, 0, smem); }
}
#else
template <int PH> __global__ void __launch_bounds__(NTHR, 2) kph(Params p, int layer) {
    extern __shared__ __attribute__((aligned(16))) char smem[];
    run_phase<PH>(p, layer, smem);
}
#endif

extern "C" void kernel_launch(void* const* d_in, const int* in_sizes, int n_in, void* d_out, int out_size, void* d_ws, size_t ws_size, hipStream_t stream) {
    if (n_in != 38 || ws_size < WS_NEED) { fprintf(stderr, "kernel_launch: bad args n_in %d ws %zu need %zu\n", n_in, ws_size, (size_t)WS_NEED); return; }
    Params p{};
    const float** pp = (const float**)&p;
    for (int i = 0; i < 38; ++i) pp[i] = (const float*)d_in[i];
    p.out = (float*)d_out; p.ws = (char*)d_ws;
    static int cus = 0;
    if (!cus) { int dev = 0; hipGetDevice(&dev); hipDeviceGetAttribute(&cus, hipDeviceAttributeMultiprocessorCount, dev); if (cus <= 0) cus = 256; }
    const int grid = cus;
#if ONE_LAUNCH
    hipFuncSetAttribute((const void*)mega, hipFuncAttributeMaxDynamicSharedMemorySize, LDS_BYTES + 16);
    hipMemsetAsync(d_ws, 0, XCD_BAR_WORDS * sizeof(unsigned), stream);
    hipLaunchKernelGGL(mega, dim3(grid), dim3(NTHR), LDS_BYTES + 16, stream, p);
#else
#define LAUNCH(PH, L) do { hipFuncSetAttribute((const void*)kph<PH>, hipFuncAttributeMaxDynamicSharedMemorySize, LDS_BYTES + 16); hipLaunchKernelGGL(kph<PH>, dim3(grid), dim3(NTHR), LDS_BYTES + 16, stream, p, L); } while (0)
    LAUNCH(PH_INIT, 0);
    for (int layer = 0; layer < 4; ++layer) {
        if ((layer & 1) == 0) { LAUNCH(PH_A_NORM, layer); LAUNCH(PH_A_Z, layer); LAUNCH(PH_A_MID, layer); LAUNCH(PH_A_QKV, layer); LAUNCH(PH_A_POST, layer); LAUNCH(PH_A_ATTN, layer); LAUNCH(PH_A_WO, layer); }
        else { LAUNCH(PH_R_XS, layer); LAUNCH(PH_R_G1, layer); LAUNCH(PH_R_G2, layer); LAUNCH(PH_R_SCAN, layer); LAUNCH(PH_R_OUT, layer); LAUNCH(PH_R_WO, layer); }
        LAUNCH(PH_M_CVT, layer); LAUNCH(PH_M_NORM, layer); LAUNCH(PH_M_SEL, layer); LAUNCH(PH_M_GATHER, layer); LAUNCH(PH_M_G1, layer); LAUNCH(PH_M_G2, layer); LAUNCH(PH_M_COMB, layer);
    }
    LAUNCH(PH_FINAL, 0);
#endif
}
```

```cpp
#include <hip/hip_runtime.h>
#include <stdint.h>
#include <stdio.h>

#ifndef ONE_LAUNCH
#define ONE_LAUNCH 1
#endif

#define NTHR 512
typedef unsigned short bf16_t;
typedef short bf16x8 __attribute__((ext_vector_type(8)));
typedef float f32x4 __attribute__((ext_vector_type(4)));
typedef unsigned u32x4 __attribute__((ext_vector_type(4)));
typedef unsigned u32x2 __attribute__((ext_vector_type(2)));

constexpr int D = 1024, NB = 4, TL = 4096, TC = 256, NLAT = NB * TL, NCTX = NB * TC, NROW = NLAT + NCTX;
constexpr int TK = TL + TC;
constexpr int NE = 16, FF = 1408, CAPL = 512, CAPC = 32, ESLOTS = NB * CAPL + NB * CAPC;
constexpr int EPAD = 2304;
constexpr float RMS_EPS = 1e-6f, LNX_EPS = 64e-5f;
constexpr float ATT_SCALE = 0.07216878364870322f;

constexpr size_t al256(size_t x) { return (x + 255) / 256 * 256; }
constexpr size_t OFF_BAR = 0;
constexpr size_t OFF_MOD = 16384;
constexpr size_t OFF_ROPE_C = OFF_MOD + al256(4 * 5 * 6144 * 4);
constexpr size_t OFF_ROPE_S = OFF_ROPE_C + al256(TL * 32 * 4);
constexpr size_t OFF_X = OFF_ROPE_S + al256(TL * 32 * 4);
constexpr size_t SZ_F32 = (size_t)NROW * D * 4, SZ_BF = (size_t)NROW * D * 2;
constexpr size_t OFF_VFIRST = OFF_X + SZ_F32;
constexpr size_t OFF_H = OFF_VFIRST + SZ_F32;
constexpr size_t SZ_WMLA = (size_t)(512 * 1024 + 1536 * 256 + 2048 * 256 + 1024 * 1024) * 2;
constexpr size_t WM_IN = 0, WM_UQ = (size_t)512 * 1024 * 2, WM_UKV = WM_UQ + (size_t)1536 * 256 * 2, WM_O = WM_UKV + (size_t)2048 * 256 * 2;
constexpr size_t SZ_WRW = (size_t)(3 * 1024 * 1024 + 4 * 256 * 1024 + 1024 * 1024 + 4096 * 256 + 2048 * 256) * 2;
constexpr size_t WR_RKV = 0, WR_L = (size_t)3 * 1024 * 1024 * 2, WR_O = WR_L + (size_t)4 * 256 * 1024 * 2, WR_B2 = WR_O + (size_t)1024 * 1024 * 2, WR_B3 = WR_B2 + (size_t)4096 * 256 * 2;
constexpr size_t OFF_WMLA = OFF_H + SZ_BF;
constexpr size_t OFF_WRW = OFF_WMLA + 2 * SZ_WMLA;
constexpr size_t OFF_W13T = OFF_WRW + 2 * SZ_WRW;
constexpr size_t OFF_W2T = OFF_W13T + (size_t)NE * 2816 * D * 2;
constexpr size_t OFF_S = OFF_W2T + (size_t)NE * D * FF * 2;
constexpr size_t OFF_Z = OFF_S;
constexpr size_t OFF_CQN = OFF_Z + al256((size_t)NROW * 512 * 4);
constexpr size_t OFF_CKVN = OFF_CQN + al256((size_t)NROW * 256 * 2);
constexpr size_t OFF_KR = OFF_CKVN + al256((size_t)NROW * 256 * 2);
constexpr size_t OFF_QRAW = OFF_KR + al256((size_t)NROW * 64 * 4);
constexpr size_t OFF_KVRAW = OFF_QRAW + al256((size_t)NROW * 1536 * 4);
constexpr size_t OFF_Q = OFF_KVRAW + al256((size_t)NROW * 2048 * 4);
constexpr size_t OFF_K = OFF_Q + al256((size_t)NB * 8 * TK * 192 * 2);
constexpr size_t OFF_V = OFF_K + al256((size_t)NB * 8 * TK * 192 * 2);
constexpr size_t OFF_O = OFF_V + al256((size_t)NB * 8 * TK * 128 * 2);
constexpr size_t END_MLA = OFF_O + SZ_BF;
constexpr size_t OFF_XS = OFF_S;
constexpr size_t OFF_RKV = OFF_XS + 6 * SZ_BF;
constexpr size_t OFF_W = OFF_RKV + 3 * SZ_F32;
constexpr size_t OFF_AV = OFF_W + 2 * SZ_F32;
constexpr size_t OFF_G = OFF_AV + 2 * SZ_F32;
constexpr size_t OFF_A2 = OFF_G + SZ_F32;
constexpr size_t OFF_A3 = OFF_A2 + al256((size_t)NROW * 256 * 2);
constexpr size_t END_RW = OFF_A3 + al256((size_t)NROW * 256 * 2);
constexpr size_t OFF_Y = OFF_XS;
constexpr int NCHK = (TC + TL) / 64;
constexpr size_t OFF_CK = END_RW;
constexpr size_t END_RW2 = OFF_CK + (size_t)128 * NCHK * 4 * 4096 * 2;
constexpr size_t OFF_AFF = OFF_S;
constexpr size_t OFF_ROWIDX = OFF_AFF + al256((size_t)NROW * 16 * 4);
constexpr size_t OFF_GATE = OFF_ROWIDX + al256((size_t)NE * ESLOTS * 4);
constexpr size_t OFF_SLOT = OFF_GATE + al256((size_t)NE * EPAD * 4);
constexpr size_t OFF_XE = OFF_SLOT + al256((size_t)NROW * 16 * 4);
constexpr size_t OFF_HID = OFF_XE + al256((size_t)NE * EPAD * D * 2);
constexpr size_t OFF_YE = OFF_HID + al256((size_t)NE * EPAD * FF * 2);
constexpr size_t END_MOE = OFF_YE + al256((size_t)NE * EPAD * D * 2);
constexpr size_t WS_NEED = END_RW2 > END_MLA ? (END_RW2 > END_MOE ? END_RW2 : END_MOE) : (END_MLA > END_MOE ? END_MLA : END_MOE);

constexpr int LDS_BYTES = 152064;

struct Params {
    const float *x, *c, *ctx, *c_ctx, *mod_w, *mod_b, *norm1_g, *norm2_g, *final_g;
    const float *mla_w_in, *mla_g_q, *mla_g_kv, *mla_w_uq, *mla_w_ukv, *mla_w_o;
    const float *rw_mu, *rw_w_rkv, *rw_w0, *rw_w1, *rw_w2, *rw_a0, *rw_a1, *rw_a2, *rw_v0, *rw_v1, *rw_v2, *rw_g1, *rw_g2, *rw_k_k, *rw_k_a, *rw_r_k, *rw_lnx_g, *rw_lnx_b, *rw_w_o;
    const float *moe_router, *moe_w1, *moe_w3, *moe_w2;
    float* out; char* ws;
    int wv, pad_;
};

__device__ __forceinline__ int bidx() { int t = blockIdx.x; asm volatile("" : "+s"(t)); return t; }
__device__ __forceinline__ int gdim() { int t = gridDim.x; asm volatile("" : "+s"(t)); return t; }
__device__ __forceinline__ int tidx_w(int wv) { int l; asm volatile("v_mbcnt_lo_u32_b32 %0, -1, 0\n\tv_mbcnt_hi_u32_b32 %0, -1, %0" : "=v"(l)); return (wv << 6) | l; }
#define tidx() tidx_w(p.wv)
#define XB_TMO      128
#define XB_XCNT(j)  (256  + 64 * (j))
#define XB_XSUB(j)  (1280 + 64 * (j))
#define XB_XGEN(j)  (2304 + 64 * (j))
#define XB_TOP      3328
#define XB_TOPGEN   3392
#define XCD_BAR_WORDS 3456
#define XB_SPIN_CAP (1u << 22)
#define LAS __attribute__((address_space(3)))

__device__ __forceinline__ unsigned xb_ld(unsigned* p)              { return __hip_atomic_load(p, __ATOMIC_RELAXED, __HIP_MEMORY_SCOPE_AGENT); }
__device__ __forceinline__ unsigned xb_add(unsigned* p, unsigned v) { return __hip_atomic_fetch_add(p, v, __ATOMIC_RELAXED, __HIP_MEMORY_SCOPE_AGENT); }
__device__ __forceinline__ unsigned xb_xcc_id() { return (unsigned)__builtin_amdgcn_s_getreg((3 << 11) | 20) & 0xFu; }
#define XB_SPIN(cond, bar) do { unsigned _sp = 0; while (cond) { __builtin_amdgcn_s_sleep(1); \
    if ((++_sp & 255u) == 0u) { if (xb_ld(&(bar)[XB_TMO])) break; if (_sp > XB_SPIN_CAP) { atomicAdd(&(bar)[XB_TMO], 1u); break; } } } } while (0)

struct XcdBarrier { unsigned* bar; unsigned x; volatile LAS unsigned* st; };

__device__ __forceinline__ XcdBarrier xcd_barrier_post(unsigned* bar, volatile LAS unsigned* st) {
    XcdBarrier b; b.bar = bar; b.x = xb_xcc_id(); b.st = st;
    if (threadIdx.x == 0) (void)xb_add(&bar[XB_XCNT(b.x)], 1u);
    return b;
}
__device__ __forceinline__ void xcd_barrier_complete(unsigned* bar, unsigned x, unsigned& nloc, unsigned& nx) {
    const unsigned G = gridDim.x * gridDim.y * gridDim.z;
    unsigned sum, cnt, mine, sp = 0u;
    for (;;) {
        sum = 0u; cnt = 0u; mine = 0u;
#pragma unroll
        for (unsigned j = 0; j < 16; ++j) { const unsigned c = xb_ld(&bar[XB_XCNT(j)]); sum += c; cnt += (c > 0u) ? 1u : 0u; mine = (j == x) ? c : mine; }
        if (sum == G) break;
        __builtin_amdgcn_s_sleep(1);
        if ((++sp & 255u) == 0u) { if (xb_ld(&bar[XB_TMO])) break; if (sp > XB_SPIN_CAP) { atomicAdd(&bar[XB_TMO], 1u); break; } }
    }
    nloc = mine > 0u ? mine : 1u; nx = cnt > 0u ? cnt : 1u;
}
__device__ __forceinline__ void xcd_barrier(const XcdBarrier& b) {
    asm volatile("s_waitcnt vmcnt(0)" ::: "memory");
    __syncthreads();
    if (threadIdx.x == 0) {
        unsigned* bar = b.bar;
        __builtin_amdgcn_s_waitcnt(0);
        unsigned nloc = b.st[0], nx = b.st[1];
        if (nloc == 0u) { xcd_barrier_complete(bar, b.x, nloc, nx); b.st[0] = nloc; b.st[1] = nx; }
        const unsigned old = xb_add(&bar[XB_XSUB(b.x)], 1u);
        const unsigned gen = old / nloc;
        if (old + 1u == (gen + 1u) * nloc) {
            __builtin_amdgcn_fence(__ATOMIC_RELEASE, "agent");
            asm volatile("s_waitcnt vmcnt(0)" ::: "memory");
            const unsigned og = xb_add(&bar[XB_TOP], 1u);
            const unsigned tg = og / nx;
            if (og + 1u == (tg + 1u) * nx) xb_add(&bar[XB_TOPGEN], 1u);
            else XB_SPIN(xb_ld(&bar[XB_TOPGEN]) == tg, bar);
            __builtin_amdgcn_fence(__ATOMIC_ACQUIRE, "agent");
            xb_add(&bar[XB_XGEN(b.x)], 1u);
            asm volatile("s_waitcnt vmcnt(0)" ::: "memory");
        } else {
            XB_SPIN(xb_ld(&bar[XB_XGEN(b.x)]) == gen, bar);
            __builtin_amdgcn_fence(__ATOMIC_ACQUIRE, "agent");
            asm volatile("s_waitcnt vmcnt(0)" ::: "memory");
        }
    }
    __syncthreads();
}

__device__ __forceinline__ bf16_t f2bf(float f) { unsigned u = __float_as_uint(f); u += 0x7FFFu + ((u >> 16) & 1u); return (bf16_t)(u >> 16); }
__device__ __forceinline__ float bf2f(bf16_t b) { return __uint_as_float(((unsigned)b) << 16); }
__device__ __forceinline__ unsigned pk2(float lo, float hi) { return (unsigned)f2bf(lo) | ((unsigned)f2bf(hi) << 16); }
__device__ __forceinline__ float dpp_sum16(float x) {
    x += __builtin_bit_cast(float, __builtin_amdgcn_update_dpp(0, __builtin_bit_cast(int, x), 0xB1, 0xF, 0xF, true));
    x += __builtin_bit_cast(float, __builtin_amdgcn_update_dpp(0, __builtin_bit_cast(int, x), 0x4E, 0xF, 0xF, true));
    x += __builtin_bit_cast(float, __builtin_amdgcn_update_dpp(0, __builtin_bit_cast(int, x), 0x141, 0xF, 0xF, true));
    x += __builtin_bit_cast(float, __builtin_amdgcn_update_dpp(0, __builtin_bit_cast(int, x), 0x140, 0xF, 0xF, true));
    return x;
}
__device__ __forceinline__ float wave_sum(float v) {
    v = dpp_sum16(v); const int i = __builtin_bit_cast(int, v);
    return __builtin_bit_cast(float, __builtin_amdgcn_readlane(i, 0)) + __builtin_bit_cast(float, __builtin_amdgcn_readlane(i, 16)) + __builtin_bit_cast(float, __builtin_amdgcn_readlane(i, 32)) + __builtin_bit_cast(float, __builtin_amdgcn_readlane(i, 48));
}
__device__ __forceinline__ float sigmoidf_(float x) { return __builtin_amdgcn_rcpf(1.f + __expf(-x)); }
__device__ __forceinline__ int row_stream(int row) { return row < NLAT ? (row >> 12) : 4; }
__device__ __forceinline__ const float* modp(const Params& p, int layer, int s, int part) { return (const float*)(p.ws + OFF_MOD) + ((size_t)layer * 5 + s) * 6144 + part * 1024; }

struct SgArgs { const bf16_t* A; int lda; size_t strideA; const float* B; int ldb; size_t strideB; int M, N, K, nbatch; };
template <class Epi>
__device__ __forceinline__ void sg_gemm(const Params& p, char* lds, const SgArgs g, const Epi& epi) {
    bf16_t* As = (bf16_t*)lds;
    bf16_t* Bs = As + 128 * 40;
    const int tid = tidx(), wid = tid >> 6, lane = tid & 63;
    const int wr = wid >> 2, wc = wid & 3;
    const int tilesN = (g.N + 127) / 128, tilesM = g.M / 128, per = tilesM * tilesN, ntiles = per * g.nbatch;
    const int ar = tid >> 2, ak = (tid & 3) * 8;
    const int bn = tid & 127, bk = (tid >> 7) * 8;
    for (int tile = bidx(); tile < ntiles; tile += gdim()) {
        const int bt = tile / per, tt = tile % per;
        const int tm = tt / tilesN, tn = tt % tilesN;
        const int m0 = tm * 128, n0 = tn * 128;
        f32x4 acc[4][2];
#pragma unroll
        for (int m = 0; m < 4; ++m)
#pragma unroll
            for (int n = 0; n < 2; ++n) acc[m][n] = (f32x4){0.f, 0.f, 0.f, 0.f};
        const bool bvalid = (n0 + bn) < g.N;
        const bf16_t* ap = g.A + bt * g.strideA + (size_t)(m0 + ar) * g.lda + ak;
        const float* bp = g.B + bt * g.strideB + (size_t)bk * g.ldb + n0 + bn;
        bf16x8 areg; float breg[8];
        areg = *(const bf16x8*)ap;
#pragma unroll
        for (int j = 0; j < 8; ++j) breg[j] = bvalid ? bp[(size_t)j * g.ldb] : 0.f;
        for (int k0 = 0; k0 < g.K; k0 += 32) {
            __syncthreads();
            *(bf16x8*)(As + ar * 40 + ak) = areg;
            { u32x4 w; w.x = pk2(breg[0], breg[1]); w.y = pk2(breg[2], breg[3]); w.z = pk2(breg[4], breg[5]); w.w = pk2(breg[6], breg[7]); *(u32x4*)(Bs + bn * 40 + bk) = w; }
            __syncthreads();
            if (k0 + 32 < g.K) {
                areg = *(const bf16x8*)(ap + k0 + 32);
#pragma unroll
                for (int j = 0; j < 8; ++j) breg[j] = bvalid ? bp[(size_t)(k0 + 32 + j) * g.ldb] : 0.f;
            }
            bf16x8 af[4], bfr[2];
#pragma unroll
            for (int m = 0; m < 4; ++m) af[m] = *(const bf16x8*)(As + (wr * 64 + m * 16 + (lane & 15)) * 40 + (lane >> 4) * 8);
#pragma unroll
            for (int n = 0; n < 2; ++n) bfr[n] = *(const bf16x8*)(Bs + (wc * 32 + n * 16 + (lane & 15)) * 40 + (lane >> 4) * 8);
#pragma unroll
            for (int m = 0; m < 4; ++m)
#pragma unroll
                for (int n = 0; n < 2; ++n) acc[m][n] = __builtin_amdgcn_mfma_f32_16x16x32_bf16(af[m], bfr[n], acc[m][n], 0, 0, 0);
        }
#pragma unroll
        for (int m = 0; m < 4; ++m)
#pragma unroll
            for (int n = 0; n < 2; ++n) {
                const int col = n0 + wc * 32 + n * 16 + (lane & 15);
                if (col < g.N) {
#pragma unroll
                    for (int r = 0; r < 4; ++r) epi(bt, m0 + wr * 64 + m * 16 + (lane >> 4) * 4 + r, col, acc[m][n][r]);
                }
            }
    }
}


namespace g8 {
#define PG8_LAS __attribute__((address_space(3)))
constexpr int BM = 256, BK = 64, HALF = 128, HTB = HALF * BK * 2, STAGE_BYTES = 8 * HTB;
__device__ __forceinline__ int lds_byte(int r, int c) { const int st = (r >> 4) * 2 + (c >> 5), rr = r & 15, cc = c & 31, ob = rr * 64 + cc * 2; return st * 1024 + (ob ^ (((ob >> 9) & 1) << 5)); }
__device__ __forceinline__ void stage_rc(int b, int& R, int& C) { const int st = b / 1024, sb = b % 1024, swz = sb ^ (((sb >> 9) & 1) << 5); R = (st >> 1) * 16 + swz / 64; C = (st & 1) * 32 + (swz % 64) / 2; }
struct Unit { int pm, pn, g; const char* A; const char* B; };
__device__ __forceinline__ int xcd_remap(int L, int nwg) { const int q = nwg / 8, r = nwg % 8, xcd = L % 8, off = L / 8; return (xcd < r ? xcd * (q + 1) : r * (q + 1) + (xcd - r) * q) + off; }

template <class Epi, class Sched>
__device__ __forceinline__ void gemm_phase(const int wv_, PG8_LAS unsigned char* lds, const int K, const Sched& S, const Epi& E) {
    const int tid = tidx_w(wv_), wid = __builtin_amdgcn_readfirstlane(tid >> 6), lane = tid & 63, wr = wid >> 2, wc = wid & 3, fr = lane & 15, fq = lane >> 4;
    const int nt = K / BK;
    unsigned voffA[2];
#pragma unroll
    for (int i = 0; i < 2; ++i) { int R, C; stage_rc(tid * 16 + i * 8192, R, C); voffA[i] = (unsigned)(R * K + C) * 2u; }
    const size_t kstep = (size_t)(BK * 2);
    const size_t hstep = (size_t)HALF * K * 2;
    const unsigned ldsw = (unsigned)wid * 1024u;
    const int aoff = lds_byte(wr * 64 + fr, fq * 8), boff = lds_byte(wc * 32 + fr, fq * 8);
#define PG8_SA(b, h) (((b) * 2 + (h)) * HTB)
#define PG8_SB(b, h) ((4 + (b) * 2 + (h)) * HTB)
#define PG8_STAGE(bufoff, gbase, voff) do { _Pragma("unroll") for (int _i = 0; _i < 2; ++_i) \
        __builtin_amdgcn_global_load_lds((const unsigned*)((const char*)(gbase) + (voff)[_i]), (PG8_LAS unsigned*)(lds + (bufoff) + ldsw + _i * 8192), 16, 0, 0); } while (0)
#define PG8_LDA(dst, b, h) do { _Pragma("unroll") for (int m = 0; m < 4; ++m) _Pragma("unroll") for (int k = 0; k < 2; ++k) dst[m][k] = *(const PG8_LAS bf16x8*)(lds + PG8_SA(b, h) + aoff + m * 2048 + k * 1024); } while (0)
#define PG8_LDB(dst, b, h) do { _Pragma("unroll") for (int n = 0; n < 2; ++n) _Pragma("unroll") for (int k = 0; k < 2; ++k) dst[n][k] = *(const PG8_LAS bf16x8*)(lds + PG8_SB(b, h) + boff + n * 2048 + k * 1024); } while (0)
#define PG8_MMA(ai, bj, At, Bt) do { __builtin_amdgcn_s_setprio(1); _Pragma("unroll") for (int m = 0; m < 4; ++m) _Pragma("unroll") for (int n = 0; n < 2; ++n) _Pragma("unroll") for (int k = 0; k < 2; ++k) \
        acc[ai][bj][m][n] = __builtin_amdgcn_mfma_f32_16x16x32_bf16(Bt[n][k], At[m][k], acc[ai][bj][m][n], 0, 0, 0); __builtin_amdgcn_s_setprio(0); } while (0)
#define PG8_WAIT_V(n) asm volatile("s_waitcnt vmcnt(" #n ")" ::: "memory")
#define PG8_WAIT_L(n) asm volatile("s_waitcnt lgkmcnt(" #n ")" ::: "memory")
#define PG8_BAR __builtin_amdgcn_s_barrier()
#define PG8_SCHED __builtin_amdgcn_sched_barrier(0)
    Unit cur, nxt; int ui = 0;
    if (!S.next(0, cur)) return;
    f32x4 acc[2][2][4][2];
#pragma unroll
    for (int a = 0; a < 2; ++a)
#pragma unroll
        for (int b = 0; b < 2; ++b)
#pragma unroll
            for (int m = 0; m < 4; ++m)
#pragma unroll
                for (int n = 0; n < 2; ++n) acc[a][b][m][n] = (f32x4){0.f, 0.f, 0.f, 0.f};
    bf16x8 At[4][2], B0[2][2], B1[2][2];
    const char* cA = cur.A; const char* cB = cur.B;
    PG8_STAGE(PG8_SB(0, 0), cB, voffA); PG8_STAGE(PG8_SA(0, 0), cA, voffA); PG8_STAGE(PG8_SB(0, 1), cB + hstep, voffA); PG8_STAGE(PG8_SA(0, 1), cA + hstep, voffA);
    if (wr == 1) PG8_BAR;
    PG8_WAIT_V(4); PG8_BAR;
    PG8_STAGE(PG8_SB(1, 0), cB + kstep, voffA); PG8_STAGE(PG8_SA(1, 0), cA + kstep, voffA); PG8_STAGE(PG8_SB(1, 1), cB + hstep + kstep, voffA);
    PG8_WAIT_V(6); PG8_BAR;
    for (;;) {
        const bool has_next = S.next(ui + 1, nxt);
        const char* nA = has_next ? nxt.A : cA; const char* nB = has_next ? nxt.B : cB;
        for (int t = 0; t < nt; t += 2) {
            const bool last = (t == nt - 2);
            const char* a1 = cA + (size_t)(t + 1) * kstep;
            const char* a2 = last ? nA : cA + (size_t)(t + 2) * kstep; const char* b2 = last ? nB : cB + (size_t)(t + 2) * kstep;
            const char* a3 = a2 + kstep; const char* b3 = b2 + kstep;
            PG8_LDB(B0, 0, 0); PG8_SCHED; PG8_LDA(At, 0, 0); PG8_STAGE(PG8_SA(1, 1), a1 + hstep, voffA);
            PG8_WAIT_L(8); PG8_BAR; PG8_WAIT_L(0); PG8_MMA(0, 0, At, B0); PG8_BAR; PG8_SCHED;
            PG8_LDB(B1, 0, 1); PG8_STAGE(PG8_SB(0, 0), b2, voffA);
            PG8_BAR; PG8_WAIT_L(0); PG8_MMA(0, 1, At, B1); PG8_BAR;
            PG8_LDA(At, 0, 1); PG8_STAGE(PG8_SA(0, 0), a2, voffA);
            PG8_BAR; PG8_WAIT_L(0); PG8_MMA(1, 0, At, B0); PG8_BAR; PG8_SCHED;
            PG8_STAGE(PG8_SB(0, 1), b2 + hstep, voffA);
            PG8_WAIT_V(6); PG8_BAR; PG8_MMA(1, 1, At, B1); PG8_BAR;
            PG8_LDB(B0, 1, 0); PG8_SCHED; PG8_LDA(At, 1, 0); PG8_STAGE(PG8_SA(0, 1), a2 + hstep, voffA);
            PG8_WAIT_L(8); PG8_BAR; PG8_WAIT_L(0); PG8_MMA(0, 0, At, B0); PG8_BAR; PG8_SCHED;
            PG8_LDB(B1, 1, 1); PG8_STAGE(PG8_SB(1, 0), b3, voffA);
            PG8_BAR; PG8_WAIT_L(0); PG8_MMA(0, 1, At, B1); PG8_BAR;
            PG8_LDA(At, 1, 1); PG8_STAGE(PG8_SA(1, 0), a3, voffA);
            PG8_BAR; PG8_WAIT_L(0); PG8_MMA(1, 0, At, B0); PG8_BAR; PG8_SCHED;
            PG8_STAGE(PG8_SB(1, 1), b3 + hstep, voffA);
            PG8_WAIT_V(6); PG8_BAR; PG8_MMA(1, 1, At, B1); PG8_BAR;
        }
        E(acc, cur, wr, wc, fr, fq);
        if (!has_next) break;
#pragma unroll
        for (int a = 0; a < 2; ++a)
#pragma unroll
            for (int b = 0; b < 2; ++b)
#pragma unroll
                for (int m = 0; m < 4; ++m)
#pragma unroll
                    for (int n = 0; n < 2; ++n) acc[a][b][m][n] = (f32x4){0.f, 0.f, 0.f, 0.f};
        cur = nxt; cA = nA; cB = nB; ++ui;
    }
    PG8_WAIT_V(0);
    if (wr == 0) PG8_BAR;
    PG8_BAR;
#undef PG8_SA
#undef PG8_SB
#undef PG8_STAGE
#undef PG8_LDA
#undef PG8_LDB
#undef PG8_MMA
#undef PG8_WAIT_V
#undef PG8_WAIT_L
#undef PG8_BAR
#undef PG8_SCHED
}
template <class F> struct EpiRC { F f;
    __device__ __forceinline__ void operator()(const f32x4 (&acc)[2][2][4][2], const Unit& u, int wr, int wc, int fr, int fq) const {
#pragma unroll
        for (int ai = 0; ai < 2; ++ai)
#pragma unroll
            for (int m = 0; m < 4; ++m) { const int row = u.pm * BM + ai * HALF + wr * 64 + m * 16 + fr;
#pragma unroll
                for (int bj = 0; bj < 2; ++bj)
#pragma unroll
                    for (int n = 0; n < 2; ++n) f(u, row, u.pn * BM + bj * HALF + wc * 32 + n * 16 + 4 * fq, acc[ai][bj][m][n]);
                asm volatile("" ::: "memory"); }
    } };
template <class F> __device__ __forceinline__ EpiRC<F> epi_rc(const F& f) { return EpiRC<F>{f}; }
template <class F> struct EpiPair { F f;
    __device__ __forceinline__ void operator()(const f32x4 (&acc)[2][2][4][2], const Unit& u, int wr, int wc, int fr, int fq) const {
#pragma unroll
        for (int ai = 0; ai < 2; ++ai)
#pragma unroll
            for (int m = 0; m < 4; ++m) { const int row = u.pm * BM + ai * HALF + wr * 64 + m * 16 + fr;
#pragma unroll
                for (int n = 0; n < 2; ++n) f(u, row, u.pn * HALF + wc * 32 + n * 16 + 4 * fq, acc[ai][0][m][n], acc[ai][1][m][n]);
                asm volatile("" ::: "memory"); }
    } };
template <class F> __device__ __forceinline__ EpiPair<F> epi_pair(const F& f) { return EpiPair<F>{f}; }
struct BatchSched { const char* A; const char* B; size_t strideA, strideB; int nM, nN, nb, K;
    __device__ __forceinline__ bool next(int i, Unit& u) const {
        const int nwg = nM * nN * nb; const int L = i * gdim() + bidx(); if (L >= nwg) return false;
        const int w = xcd_remap(L, nwg); const int per = nM * nN; u.g = w / per; const int r = w % per; u.pm = r / nN; u.pn = r % nN;
        u.A = A + u.g * strideA + (size_t)u.pm * BM * K * 2; u.B = B + u.g * strideB + (size_t)u.pn * BM * K * 2; return true; } };
}

template <class SrcF, class DRow>
__device__ __forceinline__ void cvt_tiles(const int wv_, char* lds, bf16_t* dst, int Kd, int Nd, int nbatch, size_t dstride, const SrcF& src, const DRow& drow) {
    bf16_t* T = (bf16_t*)lds;
    const int tid = tidx_w(wv_);
    const int tk = Kd / 128, tn = Nd / 64, per = tk * tn, total = per * nbatch;
    for (int t = bidx(); t < total; t += gdim()) {
        const int bt = t / per, r = t % per, k0 = (r % tk) * 128, n0 = (r / tk) * 64;
        float4 v[4];
#pragma unroll
        for (int i = 0; i < 4; ++i) { const int k = k0 + i * 32 + (tid >> 4), n = n0 + (tid & 15) * 4; const float* sp = src(bt, k, n); v[i] = sp ? *(const float4*)sp : make_float4(0.f, 0.f, 0.f, 0.f); }
        __syncthreads();
#pragma unroll
        for (int i = 0; i < 4; ++i) { const int k = i * 32 + (tid >> 4), n = (tid & 15) * 4;
            T[(n + 0) * 136 + k] = f2bf(v[i].x); T[(n + 1) * 136 + k] = f2bf(v[i].y); T[(n + 2) * 136 + k] = f2bf(v[i].z); T[(n + 3) * 136 + k] = f2bf(v[i].w); }
        __syncthreads();
        { const int n = tid >> 3, kc = (tid & 7) * 16;
          const u32x4 a = *(const u32x4*)(T + n * 136 + kc), b = *(const u32x4*)(T + n * 136 + kc + 8);
          bf16_t* dp = dst + bt * dstride + (size_t)drow(n0 + n) * Kd + k0 + kc;
          *(u32x4*)dp = a; *(u32x4*)(dp + 8) = b; }
    }
}
__device__ void ph_moe_cvt(const Params& p, int layer, char* lds) {
    const float* w1 = p.moe_w1 + (size_t)layer * NE * D * FF; const float* w3 = p.moe_w3 + (size_t)layer * NE * D * FF; const float* w2 = p.moe_w2 + (size_t)layer * NE * FF * D;
    cvt_tiles(p.wv, lds, (bf16_t*)(p.ws + OFF_W13T), D, 2816, NE, (size_t)2816 * D,
        [=](int e, int k, int n) -> const float* { const int pn = n >> 8, half = (n >> 7) & 1, c = pn * 128 + (n & 127); return (half ? w3 : w1) + ((size_t)e * D + k) * FF + c; },
        [=](int n) { return n; });
    cvt_tiles(p.wv, lds, (bf16_t*)(p.ws + OFF_W2T), FF, D, NE, (size_t)D * FF,
        [=](int e, int k, int n) -> const float* { return w2 + ((size_t)e * FF + k) * D + n; },
        [=](int n) { return n; });
}

__device__ void ph_init(const Params& p, char* lds) {
    const int tid = tidx(), gtid = bidx() * NTHR + tid, gsz = gdim() * NTHR;
    float4* X4 = (float4*)(p.ws + OFF_X);
    const float4* x4 = (const float4*)p.x; const float4* c4 = (const float4*)p.ctx;
    for (int i = gtid; i < NROW * 256; i += gsz) X4[i] = i < NLAT * 256 ? x4[i] : c4[i - NLAT * 256];
    float* rc = (float*)(p.ws + OFF_ROPE_C); float* rs = (float*)(p.ws + OFF_ROPE_S);
    for (int i = gtid; i < TL * 32; i += gsz) {
        const int t = i >> 5, f = i & 31; const float pos = (float)((f < 16) ? (t >> 6) : (t & 63));
        const float inv = powf(10000.f, -(float)(f & 15) / 16.f); const float ang = pos * inv; rc[2 * i] = cosf(ang); rc[2 * i + 1] = sinf(ang);
    }
    float* sc = (float*)lds;
    float* red = sc + 5 * 1024;
    for (int i = tid; i < 5 * 1024; i += NTHR) { const float v = i < 4096 ? p.c[i] : p.c_ctx[i - 4096]; sc[i] = v / (1.f + expf(-v)); }
    __syncthreads();
    float* MOD = (float*)(p.ws + OFF_MOD);
    for (int item = bidx(); item < 4 * 96; item += gdim()) {
        const int l = item / 96, cg = item % 96, col = tid & 63, n = cg * 64 + col, kg = tid >> 6;
        const float* w = p.mod_w + ((size_t)l * 1024 + kg * 128) * 6144 + n;
        float a0 = 0, a1 = 0, a2 = 0, a3 = 0, a4 = 0;
        for (int k = 0; k < 128; ++k) { const float wv = w[(size_t)k * 6144]; const int kk = kg * 128 + k;
            a0 += sc[kk] * wv; a1 += sc[1024 + kk] * wv; a2 += sc[2048 + kk] * wv; a3 += sc[3072 + kk] * wv; a4 += sc[4096 + kk] * wv; }
        float* rr = red + (kg * 64 + col) * 5; rr[0] = a0; rr[1] = a1; rr[2] = a2; rr[3] = a3; rr[4] = a4;
        __syncthreads();
        if (tid < 320) { const int c2 = tid & 63, s = tid >> 6; float sum = 0;
            for (int q = 0; q < 8; ++q) sum += red[(q * 64 + c2) * 5 + s];
            MOD[((size_t)l * 5 + s) * 6144 + cg * 64 + c2] = sum + p.mod_b[l * 6144 + cg * 64 + c2]; }
        __syncthreads();
    }
}


__device__ void ph_small_cvt(const Params& p, char* lds) {
    for (int j = 0; j < 2; ++j) {
        char* wm = p.ws + OFF_WMLA + j * SZ_WMLA; char* wr = p.ws + OFF_WRW + j * SZ_WRW;
        const float* w_in = p.mla_w_in + (size_t)j * D * 448; const float* w_uq = p.mla_w_uq + (size_t)j * 256 * 1536; const float* w_ukv = p.mla_w_ukv + (size_t)j * 128 * 2048; const float* w_o = p.mla_w_o + (size_t)j * D * D;
        cvt_tiles(p.wv, lds, (bf16_t*)(wm + WM_IN), 1024, 512, 1, 0, [=](int, int k, int n) -> const float* { return n < 448 ? w_in + (size_t)k * 448 + n : nullptr; },
                  [=](int n) { if (n < 384 || n >= 448) return n; const int jj = n - 384; return 384 + (jj < 32 ? 2 * jj : 2 * (jj - 32) + 1); });
        cvt_tiles(p.wv, lds, (bf16_t*)(wm + WM_UQ), 256, 1536, 1, 0, [=](int, int k, int n) -> const float* { return w_uq + (size_t)k * 1536 + n; },
                  [=](int n) { const int h = n / 192, d = n % 192; if (d < 128) return n; const int jj = d - 128; return h * 192 + 128 + (jj < 32 ? 2 * jj : 2 * (jj - 32) + 1); });
        cvt_tiles(p.wv, lds, (bf16_t*)(wm + WM_UKV), 256, 2048, 1, 0, [=](int, int k, int n) -> const float* { return k < 128 ? w_ukv + (size_t)k * 2048 + n : nullptr; }, [=](int n) { return n; });
        cvt_tiles(p.wv, lds, (bf16_t*)(wm + WM_O), 1024, 1024, 1, 0, [=](int, int k, int n) -> const float* { return w_o + (size_t)k * D + n; }, [=](int n) { return n; });
        const float* w_rkv = p.rw_w_rkv + (size_t)j * 3 * D * D; const float* w1 = p.rw_w1 + (size_t)j * 2 * D * 64; const float* a1 = p.rw_a1 + (size_t)j * 2 * D * 64;
        const float* g1 = p.rw_g1 + (size_t)j * D * 128; const float* v1 = p.rw_v1; const float* rwo = p.rw_w_o + (size_t)j * D * D;
        cvt_tiles(p.wv, lds, (bf16_t*)(wr + WR_RKV), 1024, 1024, 3, (size_t)D * D, [=](int m, int k, int n) -> const float* { return w_rkv + ((size_t)m * D + k) * D + n; }, [=](int n) { return n; });
        cvt_tiles(p.wv, lds, (bf16_t*)(wr + WR_L), 1024, 256, 1, 0, [=](int, int k, int n) -> const float* { return n < 128 ? w1 + ((size_t)(n >> 6) * D + k) * 64 + (n & 63) : nullptr; }, [=](int n) { return n; });
        cvt_tiles(p.wv, lds, (bf16_t*)(wr + WR_L) + 256 * 1024, 1024, 256, 1, 0, [=](int, int k, int n) -> const float* { return n < 128 ? a1 + ((size_t)(n >> 6) * D + k) * 64 + (n & 63) : nullptr; }, [=](int n) { return n; });
        cvt_tiles(p.wv, lds, (bf16_t*)(wr + WR_L) + 2 * 256 * 1024, 1024, 256, 1, 0, [=](int, int k, int n) -> const float* { return n < 128 ? g1 + (size_t)k * 128 + n : nullptr; }, [=](int n) { return n; });
        cvt_tiles(p.wv, lds, (bf16_t*)(wr + WR_L) + 3 * 256 * 1024, 1024, 256, 1, 0, [=](int, int k, int n) -> const float* { return n < 32 ? v1 + (size_t)k * 32 + n : nullptr; }, [=](int n) { return n; });
        cvt_tiles(p.wv, lds, (bf16_t*)(wr + WR_O), 1024, 1024, 1, 0, [=](int, int k, int n) -> const float* { return rwo + (size_t)k * D + n; }, [=](int n) { return n; });
        const float* w2 = p.rw_w2 + (size_t)j * 2 * 64 * D; const float* a2 = p.rw_a2 + (size_t)j * 2 * 64 * D; const float* g2 = p.rw_g2 + (size_t)j * 128 * D; const float* v2 = p.rw_v2;
        cvt_tiles(p.wv, lds, (bf16_t*)(wr + WR_B2), 256, 4096, 1, 0, [=](int, int k, int n) -> const float* { const int blk = n >> 10, c = n & 1023, l = k - blk * 64;
            if (l < 0 || l >= 64) return nullptr; return (blk < 2 ? w2 + ((size_t)blk * 64 + l) * D : a2 + ((size_t)(blk - 2) * 64 + l) * D) + c; }, [=](int n) { return n; });
        cvt_tiles(p.wv, lds, (bf16_t*)(wr + WR_B3), 256, 2048, 1, 0, [=](int, int k, int n) -> const float* {
            if (n < 1024) return k < 128 ? g2 + (size_t)k * D + n : nullptr; return (k >= 128 && k < 160) ? v2 + (size_t)(k - 128) * D + (n - 1024) : nullptr; }, [=](int n) { return n; });
    }
}

template <bool OUTF32>
__device__ void ph_norm_mod(const Params& p, int layer, const float* g, int part_sh, int part_sc, void* outp) {
    const int wid = tidx() >> 6, lane = tidx() & 63;
    const float* X = (const float*)(p.ws + OFF_X);
    for (int row = bidx() * 8 + wid; row < NROW; row += gdim() * 8) {
        const int s = row_stream(row);
        const float* sh = modp(p, layer, s, part_sh); const float* sc = modp(p, layer, s, part_sc);
        const float4* xr = (const float4*)(X + (size_t)row * D);
        float4 v[4]; float ss = 0;
#pragma unroll
        for (int i = 0; i < 4; ++i) { v[i] = xr[lane + i * 64]; ss += v[i].x * v[i].x + v[i].y * v[i].y + v[i].z * v[i].z + v[i].w * v[i].w; }
        ss = wave_sum(ss); const float rs = rsqrtf(ss * (1.f / D) + RMS_EPS);
#pragma unroll
        for (int i = 0; i < 4; ++i) {
            const int d = (lane + i * 64) * 4;
            const float4 gg = *(const float4*)(g + d), a = *(const float4*)(sc + d), b = *(const float4*)(sh + d);
            float4 o; o.x = v[i].x * rs * gg.x * (1.f + a.x) + b.x; o.y = v[i].y * rs * gg.y * (1.f + a.y) + b.y; o.z = v[i].z * rs * gg.z * (1.f + a.z) + b.z; o.w = v[i].w * rs * gg.w * (1.f + a.w) + b.w;
            if (OUTF32) *(float4*)((float*)outp + (size_t)row * D + d) = o;
            else { uint2 w; w.x = pk2(o.x, o.y); w.y = pk2(o.z, o.w); *(uint2*)((bf16_t*)outp + (size_t)row * D + d) = w; }
        }
    }
}

__device__ void ph_mla_mid(const Params& p, int j) {
    const int wid = tidx() >> 6, lane = tidx() & 63;
    const float* Z = (const float*)(p.ws + OFF_Z);
    bf16_t* CQN = (bf16_t*)(p.ws + OFF_CQN); bf16_t* CKVN = (bf16_t*)(p.ws + OFF_CKVN); bf16_t* K = (bf16_t*)(p.ws + OFF_K);
    const float* gq = p.mla_g_q + j * 256; const float* gkv = p.mla_g_kv + j * 128;
    const float* rc = (const float*)(p.ws + OFF_ROPE_C); const float* rs = (const float*)(p.ws + OFF_ROPE_S);
    for (int row = bidx() * 8 + wid; row < NROW; row += gdim() * 8) {
        const float* z = Z + (size_t)row * 512;
        const float4 q = *(const float4*)(z + lane * 4);
        const float2 kv = *(const float2*)(z + 256 + lane * 2);
        const float kr = z[384 + lane];
        float sq = wave_sum(q.x * q.x + q.y * q.y + q.z * q.z + q.w * q.w); const float rq = rsqrtf(sq * (1.f / 256.f) + RMS_EPS);
        float sk = wave_sum(kv.x * kv.x + kv.y * kv.y); const float rk = rsqrtf(sk * (1.f / 128.f) + RMS_EPS);
        const float4 g4 = *(const float4*)(gq + lane * 4); const float2 g2 = *(const float2*)(gkv + lane * 2);
        uint2 w; w.x = pk2(q.x * rq * g4.x, q.y * rq * g4.y); w.y = pk2(q.z * rq * g4.z, q.w * rq * g4.w);
        *(uint2*)(CQN + (size_t)row * 256 + lane * 4) = w;
        *(unsigned*)(CKVN + (size_t)row * 256 + lane * 2) = pk2(kv.x * rk * g2.x, kv.y * rk * g2.y);
        *(unsigned*)(CKVN + (size_t)row * 256 + 128 + lane * 2) = 0u;
        float o = kr;
        const float other = __builtin_bit_cast(float, __builtin_amdgcn_update_dpp(0, __builtin_bit_cast(int, kr), 0xB1, 0xF, 0xF, true));
        const bool lat = row < NLAT;
        if (lat) { const int t = row & (TL - 1), i = lane >> 1; const float2 cs = *(const float2*)(rc + (t * 32 + i) * 2); const float c = cs.x, s = cs.y;
            o = (lane & 1) ? (other * s + kr * c) : (kr * c - other * s); }
        const int b = lat ? (row >> 12) : ((row - NLAT) >> 8); const int tk = lat ? 256 + (row & (TL - 1)) : ((row - NLAT) & 255);
        const bf16_t ob = f2bf(o);
#pragma unroll
        for (int h = 0; h < 8; ++h) K[((size_t)(b * 8 + h) * TK + tk) * 192 + 128 + lane] = ob;
    }
}

__device__ void ph_qkv_post(const Params& p) {
    const int wid = tidx() >> 6, lane = tidx() & 63;
    const float* QRAW = (const float*)(p.ws + OFF_QRAW); const float* KVRAW = (const float*)(p.ws + OFF_KVRAW); const float* KR = (const float*)(p.ws + OFF_KR);
    bf16_t* Q = (bf16_t*)(p.ws + OFF_Q); bf16_t* K = (bf16_t*)(p.ws + OFF_K); bf16_t* V = (bf16_t*)(p.ws + OFF_V);
    const float* rc = (const float*)(p.ws + OFF_ROPE_C); const float* rs = (const float*)(p.ws + OFF_ROPE_S);
    for (int it = bidx() * 8 + wid; it < NROW * 8; it += gdim() * 8) {
        const int row = it >> 3, h = it & 7;
        const bool lat = row < NLAT; const int b = lat ? (row >> 12) : ((row - NLAT) >> 8); const int tk = lat ? 256 + (row & (TL - 1)) : ((row - NLAT) & 255);
        const size_t orow = (size_t)(b * 8 + h) * TK + tk;
        const float* q = QRAW + (size_t)row * 1536 + h * 192;
        const float q0 = q[lane], q1 = q[64 + lane]; float q2 = q[128 + lane];
        const auto sw = __builtin_amdgcn_permlane32_swap(__float_as_uint(q2), __float_as_uint(q2), false, false);
        if (lat) { const int t = row & (TL - 1), i = lane & 31; const float c = rc[t * 32 + i], s = rs[t * 32 + i];
            const float x1 = __uint_as_float(sw[0]), x2 = __uint_as_float(sw[1]); q2 = lane < 32 ? (x1 * c - x2 * s) : (x1 * s + x2 * c); }
        bf16_t* qo = Q + orow * 192; qo[lane] = f2bf(q0); qo[64 + lane] = f2bf(q1); qo[128 + lane] = f2bf(q2);
        const float* kv = KVRAW + (size_t)row * 2048 + h * 256;
        bf16_t* ko = K + orow * 192; ko[lane] = f2bf(kv[lane]); ko[64 + lane] = f2bf(kv[64 + lane]); ko[128 + lane] = f2bf(KR[(size_t)row * 64 + lane]);
        bf16_t* vo = V + orow * 128; vo[lane] = f2bf(kv[128 + lane]); vo[64 + lane] = f2bf(kv[192 + lane]);
    }
}

__device__ void ph_attn_naive(const Params& p, char* lds) {
    const int tid = tidx(), qi = tid >> 2, part = tid & 3;
    const bf16_t* Q = (const bf16_t*)(p.ws + OFF_Q); const bf16_t* K = (const bf16_t*)(p.ws + OFF_K); const bf16_t* V = (const bf16_t*)(p.ws + OFF_V);
    bf16_t* O = (bf16_t*)(p.ws + OFF_O);
    bf16_t* Ks = (bf16_t*)lds;
    bf16_t* Vs = Ks + 32 * 192;
    const int nitems = 32 * 34;
    for (int it = bidx(); it < nitems; it += gdim()) {
        const int bh = it / 34, qb = it % 34; const int b = bh >> 3, h = bh & 7;
        const int nkeys = qb < 2 ? TC : TK;
        const int tq = qb * 128 + qi;
        const bf16_t* qp = Q + ((size_t)bh * TK + tq) * 192 + part * 48;
        float q[48];
#pragma unroll
        for (int i = 0; i < 48; ++i) q[i] = bf2f(qp[i]) * ATT_SCALE;
        float o[32];
#pragma unroll
        for (int i = 0; i < 32; ++i) o[i] = 0.f;
        float m = -1e30f, l = 0.f;
        for (int k0 = 0; k0 < nkeys; k0 += 32) {
            __syncthreads();
            {
                const bf16_t* kg = K + ((size_t)bh * TK + k0) * 192; const bf16_t* vg = V + ((size_t)bh * TK + k0) * 128;
                for (int c = tid; c < 768; c += NTHR) *(u32x4*)(Ks + c * 8) = *(const u32x4*)(kg + c * 8);
                *(u32x4*)(Vs + tid * 8) = *(const u32x4*)(vg + tid * 8);
            }
            __syncthreads();
#pragma unroll 1
            for (int kg = 0; kg < 32; kg += 8) {
                float s[8]; float tmax = -1e30f;
#pragma unroll
                for (int kk = 0; kk < 8; ++kk) {
                    const bf16_t* kr = Ks + (kg + kk) * 192 + part * 48; float acc = 0.f;
#pragma unroll
                    for (int i = 0; i < 48; ++i) acc += q[i] * bf2f(kr[i]);
                    acc += __shfl_xor(acc, 1); acc += __shfl_xor(acc, 2);
                    s[kk] = acc; tmax = fmaxf(tmax, acc);
                    asm volatile("" ::: "memory");
                }
                const float mn = fmaxf(m, tmax), alpha = expf(m - mn); m = mn; l *= alpha;
#pragma unroll
                for (int i = 0; i < 32; ++i) o[i] *= alpha;
#pragma unroll
                for (int kk = 0; kk < 8; ++kk) {
                    const float pw = expf(s[kk] - mn); l += pw;
                    const bf16_t* vr = Vs + (kg + kk) * 128 + part * 32;
#pragma unroll
                    for (int i = 0; i < 32; ++i) o[i] += pw * bf2f(vr[i]);
                    asm volatile("" ::: "memory");
                }
            }
        }
        const float rl = 1.f / l;
        const int row = qb < 2 ? (NLAT + b * TC + tq) : (b * TL + tq - TC);
        bf16_t* op = O + (size_t)row * D + h * 128 + part * 32;
#pragma unroll
        for (int i = 0; i < 32; ++i) op[i] = f2bf(o[i] * rl);
    }
}


namespace fa {
using s16x4  = __attribute__((ext_vector_type(4))) short;
using f32x16 = __attribute__((ext_vector_type(16))) float;
constexpr int DQK = 192, DV = 128, KVBLK = 64;
constexpr float THR = 8.f;
constexpr int SHM_V = KVBLK * DV * 2, SHM_K = KVBLK * DQK * 2;
constexpr int SHM_ATTN = 2 * SHM_V + 2 * SHM_K + 8 * 64 * 4;
#define KSWZ(row, colB) ((row) * 384 + ((colB) ^ (((row) & 7) << 4)))
#define SBAR() __builtin_amdgcn_sched_barrier(0)
__device__ __forceinline__ int crow(int r, int hi) { return (r & 3) + 8 * (r >> 2) + 4 * hi; }
__device__ __forceinline__ unsigned cvtpk(float lo, float hi) { unsigned r; asm volatile("v_cvt_pk_bf16_f32 %0, %1, %2" : "=v"(r) : "v"(lo), "v"(hi)); return r; }
__device__ __forceinline__ void partialSM(f32x16& p0, f32x16& p1, float& m_reg, float& mn, float& alpha) {
  constexpr float C = ATT_SCALE * 1.4426950408889634f;
  float pmax = p0[0];
#pragma unroll
  for (int r = 1; r < 16; ++r) pmax = fmaxf(pmax, p0[r]);
#pragma unroll
  for (int r = 0; r < 16; ++r) pmax = fmaxf(pmax, p1[r]);
  { auto rr = __builtin_amdgcn_permlane32_swap(__float_as_uint(pmax), __float_as_uint(pmax), false, false);
    pmax = fmaxf(__uint_as_float(rr[0]), __uint_as_float(rr[1])); }
  if (__builtin_expect(__all(pmax - m_reg <= THR / ATT_SCALE), 1)) { mn = m_reg; alpha = 1.f; }
  else { mn = fmaxf(m_reg, pmax); alpha = __builtin_amdgcn_exp2f((m_reg - mn) * C); m_reg = mn; }
  float mnC = -mn * C;
#pragma unroll
  for (int r = 0; r < 16; ++r) p0[r] = fmaf(p0[r], C, mnC);
#pragma unroll
  for (int r = 0; r < 16; ++r) p1[r] = fmaf(p1[r], C, mnC);
#pragma unroll
  for (int r = 0; r < 16; ++r) p0[r] = __builtin_amdgcn_exp2f(p0[r]);
}
__device__ __forceinline__ void finishSM(f32x16& p0, f32x16& p1, float alpha, float& l_reg, bf16x8& pa0, bf16x8& pa1, bf16x8& pa2, bf16x8& pa3) {
#pragma unroll
  for (int r = 0; r < 16; ++r) p1[r] = __builtin_amdgcn_exp2f(p1[r]);
  float ps = 0;
#pragma unroll
  for (int r = 0; r < 16; ++r) ps += p0[r];
#pragma unroll
  for (int r = 0; r < 16; ++r) ps += p1[r];
  { auto rr = __builtin_amdgcn_permlane32_swap(__float_as_uint(ps), __float_as_uint(ps), false, false);
    ps = __uint_as_float(rr[0]) + __uint_as_float(rr[1]); }
  l_reg = l_reg * alpha + ps;
#define PK4(P, BASE, OUT) do { unsigned a0 = cvtpk(P[BASE + 0], P[BASE + 1]), a1 = cvtpk(P[BASE + 2], P[BASE + 3]);   \
    unsigned b0 = cvtpk(P[BASE + 4], P[BASE + 5]), b1 = cvtpk(P[BASE + 6], P[BASE + 7]);                              \
    auto r0 = __builtin_amdgcn_permlane32_swap(a0, b0, false, false); auto r1 = __builtin_amdgcn_permlane32_swap(a1, b1, false, false); \
    u32x4 w = {r0[0], r1[0], r0[1], r1[1]}; OUT = *reinterpret_cast<bf16x8*>(&w); } while (0)
  PK4(p0, 0, pa0); PK4(p0, 8, pa1); PK4(p1, 0, pa2); PK4(p1, 8, pa3);
#undef PK4
}
__device__ __forceinline__ void qkt(f32x16& p0, f32x16& p1, const char* Ks, const bf16x8* qr, int r32, int hi) {
  p0 = f32x16{}; p1 = f32x16{};
  const int swz = (r32 & 7) << 4;
  const char* b4[4];
#pragma unroll
  for (int dr = 0; dr < 4; ++dr) b4[dr] = Ks + r32 * 384 + ((dr * 32 + hi * 16) ^ swz);
#pragma unroll
  for (int d0 = 0; d0 < 12; ++d0) {
    bf16x8 b0 = *reinterpret_cast<const bf16x8*>(b4[d0 & 3] + (d0 >> 2) * 128);
    bf16x8 b1 = *reinterpret_cast<const bf16x8*>(b4[d0 & 3] + (d0 >> 2) * 128 + 32 * 384);
    p0 = __builtin_amdgcn_mfma_f32_32x32x16_bf16(b0, qr[d0], p0, 0, 0, 0);
    p1 = __builtin_amdgcn_mfma_f32_32x32x16_bf16(b1, qr[d0], p1, 0, 0, 0); }
}
__device__ __forceinline__ int v_st(int k, int c) { const int kk = (k & ~0xC) | ((k & 4) << 1) | ((k & 8) >> 1); return ((kk >> 3) * 4 + (c >> 5)) * 512 + ((kk & 7) * 32 + (c & 31)) * 2; }
__device__ __forceinline__ int v_rd_base(int lane) { return ((lane & 3) << 3) | (((lane >> 2) & 3) << 6) | (((lane >> 4) & 1) << 5) | (((lane >> 5) & 1) << 8); }
constexpr int v_rd_off(int d0, int ks, int half) { return d0 * 512 + ks * 4096 + half * 2048; }
template <int OFF> __device__ __forceinline__ s16x4 tr_read(int vb) {
  s16x4 r; asm volatile("ds_read_b64_tr_b16 %0, %1 offset:%2" : "=&v"(r) : "v"(vb), "i"(OFF) : "memory"); return r;
}
template <int D0> __device__ __forceinline__ void pv_one(f32x16& od, int vb, bf16x8 pa0, bf16x8 pa1, bf16x8 pa2, bf16x8 pa3) {
  const s16x4 l0 = tr_read<v_rd_off(D0, 0, 0)>(vb), h0 = tr_read<v_rd_off(D0, 0, 1)>(vb), l1 = tr_read<v_rd_off(D0, 1, 0)>(vb), h1 = tr_read<v_rd_off(D0, 1, 1)>(vb);
  const s16x4 l2 = tr_read<v_rd_off(D0, 2, 0)>(vb), h2 = tr_read<v_rd_off(D0, 2, 1)>(vb), l3 = tr_read<v_rd_off(D0, 3, 0)>(vb), h3 = tr_read<v_rd_off(D0, 3, 1)>(vb);
  asm volatile("s_waitcnt lgkmcnt(0)" ::: "memory"); SBAR();
#define PK(L, H) (bf16x8){L[0], L[1], L[2], L[3], H[0], H[1], H[2], H[3]}
  od = __builtin_amdgcn_mfma_f32_32x32x16_bf16(pa0, PK(l0, h0), od, 0, 0, 0);
  od = __builtin_amdgcn_mfma_f32_32x32x16_bf16(pa1, PK(l1, h1), od, 0, 0, 0);
  od = __builtin_amdgcn_mfma_f32_32x32x16_bf16(pa2, PK(l2, h2), od, 0, 0, 0);
  od = __builtin_amdgcn_mfma_f32_32x32x16_bf16(pa3, PK(l3, h3), od, 0, 0, 0);
#undef PK
}
__device__ __forceinline__ void pv_d0(f32x16* o, int vb, bf16x8 pa0, bf16x8 pa1, bf16x8 pa2, bf16x8 pa3) {
  pv_one<0>(o[0], vb, pa0, pa1, pa2, pa3); pv_one<1>(o[1], vb, pa0, pa1, pa2, pa3); pv_one<2>(o[2], vb, pa0, pa1, pa2, pa3); pv_one<3>(o[3], vb, pa0, pa1, pa2, pa3);
}
__device__ __forceinline__ void attn_body(const int wv_, const bf16_t* __restrict__ Qb, const bf16_t* __restrict__ Kh, const bf16_t* __restrict__ Vh, bf16_t* __restrict__ Ob, int ldo, int seq, char* lds, const float* __restrict__ ropecs  ) {
  const int tid = tidx_w(wv_), wid = tid >> 6, lane = tid & 63, r32 = lane & 31, hi = lane >> 5;
  char* V_lds = lds; char* K_lds = lds + 2 * SHM_V;
  float* ws = (float*)(lds + 2 * SHM_V + 2 * SHM_K) + wid * 64; float* li_l = ws; float* al_l = ws + 32;
  float m_reg = -1e30f, l_reg = 0; f32x16 o[4] = {}; bf16x8 qr[12];
  const bf16_t* Qw = Qb + (long)(wid * 32 + r32) * DQK + hi * 8;
#pragma unroll
  for (int d0 = 0; d0 < 12; ++d0) qr[d0] = *reinterpret_cast<const bf16x8*>(Qw + d0 * 16);
  if (ropecs) {
    const float* cs = ropecs + (size_t)(wid * 32 + r32) * 64;
#pragma unroll
    for (int d0 = 8; d0 < 12; ++d0) { const int i0 = (d0 - 8) * 8 + hi * 4; const f32x4 c0 = *(const f32x4*)(cs + i0 * 2), c1 = *(const f32x4*)(cs + i0 * 2 + 4);
      u32x4 w = *reinterpret_cast<u32x4*>(&qr[d0]); const float cc[4] = {c0[0], c0[2], c1[0], c1[2]}, ss[4] = {c0[1], c0[3], c1[1], c1[3]};
#pragma unroll
      for (int m = 0; m < 4; ++m) { const float x1 = __uint_as_float(w[m] << 16), x2 = __uint_as_float(w[m] & 0xffff0000u); w[m] = cvtpk(x1 * cc[m] - x2 * ss[m], x1 * ss[m] + x2 * cc[m]); }
      qr[d0] = *reinterpret_cast<bf16x8*>(&w); }
  }
  const int sr = tid >> 4, sc = (tid & 15) * 8, vst0 = v_st(sr, sc), vst1 = v_st(32 + sr, sc);
  int kst[3];
#pragma unroll
  for (int i = 0; i < 3; ++i) { const int c = tid + 512 * i, row = c / 24, cc = c % 24; kst[i] = KSWZ(row, cc * 16); }
  const int vb0 = (int)(uintptr_t)V_lds + v_rd_base(lane);
  struct { bf16x8 vs0, vs1, ks0, ks1, ks2; } sr_[1];
#define SLOAD(i, k0) do { const bf16_t* vt = Vh + (long)(k0) * DV; const bf16_t* kt = Kh + (long)(k0) * DQK; \
    sr_[i].vs0 = *reinterpret_cast<const bf16x8*>(vt + (sr) * DV + sc); sr_[i].vs1 = *reinterpret_cast<const bf16x8*>(vt + (32 + sr) * DV + sc); \
    sr_[i].ks0 = *reinterpret_cast<const bf16x8*>(kt + tid * 8); sr_[i].ks1 = *reinterpret_cast<const bf16x8*>(kt + (tid + 512) * 8); sr_[i].ks2 = *reinterpret_cast<const bf16x8*>(kt + (tid + 1024) * 8); } while (0)
#define SWRITE(b, i) do { *(bf16x8*)(V_lds + (b) * SHM_V + vst0) = sr_[i].vs0; *(bf16x8*)(V_lds + (b) * SHM_V + vst1) = sr_[i].vs1; \
    *(bf16x8*)(K_lds + (b) * SHM_K + kst[0]) = sr_[i].ks0; *(bf16x8*)(K_lds + (b) * SHM_K + kst[1]) = sr_[i].ks1; *(bf16x8*)(K_lds + (b) * SHM_K + kst[2]) = sr_[i].ks2; } while (0)
#define SWAIT() asm volatile("s_waitcnt vmcnt(5)" ::: "memory")
#define RESC(a) do { if (__any((a) < 1.f)) { if (hi == 0) al_l[r32] = (a); asm volatile("s_waitcnt lgkmcnt(0)" ::: "memory"); \
    _Pragma("unroll") for (int d = 0; d < 4; ++d) _Pragma("unroll") for (int r = 0; r < 16; ++r) o[d][r] *= al_l[crow(r, hi)]; } } while (0)
  f32x16 pA0, pA1; float mnA, alA; bf16x8 pa0, pa1, pa2, pa3; const int NT = seq / KVBLK;
  SLOAD(0, 0); SWRITE(0, 0);
  SLOAD(0, KVBLK);
  __syncthreads();
  for (int j = 0; j < NT; j += 2) {
    SBAR(); qkt(pA0, pA1, K_lds, qr, r32, hi);
    partialSM(pA0, pA1, m_reg, mnA, alA); RESC(alA);
    finishSM(pA0, pA1, alA, l_reg, pa0, pa1, pa2, pa3); SBAR();
    SWRITE(1, 0);
    if (j + 2 < NT) SLOAD(0, (j + 2) * KVBLK);
    SBAR();
    pv_d0(o, vb0, pa0, pa1, pa2, pa3);
    __syncthreads();
    SBAR(); qkt(pA0, pA1, K_lds + SHM_K, qr, r32, hi);
    partialSM(pA0, pA1, m_reg, mnA, alA); RESC(alA);
    finishSM(pA0, pA1, alA, l_reg, pa0, pa1, pa2, pa3); SBAR();
    if (j + 2 < NT) { SWRITE(0, 0); if (j + 3 < NT) SLOAD(0, (j + 3) * KVBLK); }
    SBAR();
    pv_d0(o, vb0 + SHM_V, pa0, pa1, pa2, pa3);
    __syncthreads();
  }
  if (hi == 0) li_l[r32] = l_reg; asm volatile("s_waitcnt lgkmcnt(0)" ::: "memory");
  float rli[16];
#pragma unroll
  for (int r = 0; r < 16; ++r) rli[r] = __builtin_amdgcn_rcpf(li_l[crow(r, hi)]);
  bf16_t* Ow = Ob + (long)(wid * 32) * ldo;
#pragma unroll
  for (int r = 0; r < 16; ++r) { int orow = crow(r, hi);
#pragma unroll
    for (int d0 = 0; d0 < 4; ++d0) Ow[(long)orow * ldo + d0 * 32 + r32] = f2bf(o[d0][r] * rli[r]); }
  __syncthreads();
#undef SLOAD
#undef SWRITE
#undef SWAIT
#undef RESC
}
#undef KSWZ
}

__device__ void ph_attn(const Params& p, char* lds) {
    const bf16_t* Q = (const bf16_t*)(p.ws + OFF_Q); const bf16_t* K = (const bf16_t*)(p.ws + OFF_K); const bf16_t* V = (const bf16_t*)(p.ws + OFF_V);
    bf16_t* O = (bf16_t*)(p.ws + OFF_O);
    const int G = gdim();
    for (int i = 0;; ++i) {
        const int L = i * G + bidx(); if (L >= 544) break;
        int bh, qb;
        if (L < 512) { const int w = g8::xcd_remap(L, 512); bh = w >> 4; qb = 1 + (w & 15); } else { bh = L - 512; qb = 0; }
        const int b = bh >> 3, h = bh & 7;
        const int seq = qb == 0 ? TC : TK;
        const int row0 = qb == 0 ? NLAT + b * TC : b * TL + (qb - 1) * 256;
        fa::attn_body(p.wv, Q + ((size_t)bh * TK + qb * 256) * 192, K + (size_t)bh * TK * 192, V + (size_t)bh * TK * 128, O + (size_t)row0 * D + h * 128, D, seq, lds,
                      qb == 0 ? nullptr : (const float*)(p.ws + OFF_ROPE_C) + (size_t)(qb - 1) * 256 * 64);
    }
}

__device__ void ph_norm2_router(const Params& p, int layer, char* lds, int nrows) {
    const int tid = tidx(), wid = tid >> 6, lane = tid & 63;
    float* rt = (float*)lds;
    const float* rg = p.moe_router + (size_t)layer * D * NE;
    for (int i = tid; i < D * NE / 4; i += NTHR) ((float4*)rt)[i] = ((const float4*)rg)[i];
    __syncthreads();
    const float* X = (const float*)(p.ws + OFF_X); bf16_t* BN = (bf16_t*)(p.ws + OFF_H); float* AFF = (float*)(p.ws + OFF_AFF);
    const float* g = p.norm2_g + layer * D;
    for (int row = bidx() * 8 + wid; row < nrows; row += gdim() * 8) {
        const int s = row_stream(row);
        const float* sh = modp(p, layer, s, 3); const float* sc = modp(p, layer, s, 4);
        const float4* xr = (const float4*)(X + (size_t)row * D);
        float4 v[4]; float ss = 0;
#pragma unroll
        for (int i = 0; i < 4; ++i) { v[i] = xr[lane + i * 64]; ss += v[i].x * v[i].x + v[i].y * v[i].y + v[i].z * v[i].z + v[i].w * v[i].w; }
        ss = wave_sum(ss); const float rs = rsqrtf(ss * (1.f / D) + RMS_EPS);
        float lg[16];
#pragma unroll
        for (int e = 0; e < 16; ++e) lg[e] = 0.f;
#pragma unroll
        for (int i = 0; i < 4; ++i) {
            const int d = (lane + i * 64) * 4;
            const float4 gg = *(const float4*)(g + d), a = *(const float4*)(sc + d), b = *(const float4*)(sh + d);
            float o[4]; o[0] = v[i].x * rs * gg.x * (1.f + a.x) + b.x; o[1] = v[i].y * rs * gg.y * (1.f + a.y) + b.y; o[2] = v[i].z * rs * gg.z * (1.f + a.z) + b.z; o[3] = v[i].w * rs * gg.w * (1.f + a.w) + b.w;
            uint2 w; w.x = pk2(o[0], o[1]); w.y = pk2(o[2], o[3]); *(uint2*)(BN + (size_t)row * D + d) = w;
#pragma unroll
            for (int jj = 0; jj < 4; ++jj) { const float* rr = rt + (d + jj) * 16;
#pragma unroll
                for (int e = 0; e < 16; ++e) lg[e] += o[jj] * rr[e];
                asm volatile("" ::: "memory"); }
        }
        float mx = -1e30f;
#pragma unroll
        for (int e = 0; e < 16; ++e) { lg[e] = wave_sum(lg[e]); mx = fmaxf(mx, lg[e]); }
        float sum = 0;
#pragma unroll
        for (int e = 0; e < 16; ++e) { lg[e] = expf(lg[e] - mx); sum += lg[e]; }
        const float inv = 1.f / sum;
        if (lane < 16) { float val = 0;
#pragma unroll
            for (int e = 0; e < 16; ++e) val = (lane == e) ? lg[e] : val;
            AFF[(size_t)row * 16 + lane] = val * inv; }
    }
}

__device__ void ph_select(const Params& p, char* lds, int ngroups) {
    const int tid = tidx(), wid = tid >> 6, lane = tid & 63;
    unsigned* hist = (unsigned*)lds;
    unsigned* ctl = hist + 256;
    unsigned* wsum = ctl + 8;
    const float* AFF = (const float*)(p.ws + OFF_AFF);
    int* ROWIDX = (int*)(p.ws + OFF_ROWIDX); float* GATE = (float*)(p.ws + OFF_GATE); int* SLOT = (int*)(p.ws + OFF_SLOT);
    for (int gidx = bidx(); gidx < ngroups; gidx += gdim()) {
        const bool lat = gidx < 64; const int b = (gidx & 63) >> 4, e = gidx & 15;
        const int n = lat ? TL : TC, cap = lat ? CAPL : CAPC;
        const int row0 = lat ? b * TL : NLAT + b * TC, slot0 = lat ? b * CAPL : NB * CAPL + b * CAPC;
        unsigned key[8];
#pragma unroll
        for (int i = 0; i < 8; ++i) { const int idx = tid * 8 + i; key[i] = idx < n ? __float_as_uint(AFF[(size_t)(row0 + idx) * 16 + e]) : 0u; }
        unsigned prefix = 0u, remaining = (unsigned)cap;
#pragma unroll
        for (int pass = 0; pass < 4; ++pass) {
            const int sh = 24 - 8 * pass;
            __syncthreads();
            if (tid < 256) hist[tid] = 0u;
            __syncthreads();
#pragma unroll
            for (int i = 0; i < 8; ++i) { const int idx = tid * 8 + i;
                const bool cand = idx < n && (pass == 0 || (key[i] >> (sh + 8)) == prefix);
                if (cand) atomicAdd(&hist[(key[i] >> sh) & 255u], 1u); }
            __syncthreads();
            if (tid < 256) { unsigned gt = 0; for (int jj = tid + 1; jj < 256; ++jj) gt += hist[jj];
                const unsigned mine = hist[tid];
                if (gt < remaining && remaining <= gt + mine) { ctl[0] = (unsigned)tid; ctl[1] = remaining - gt; } }
            __syncthreads();
            prefix = (prefix << 8) | ctl[0]; remaining = ctl[1];
        }
        const unsigned T = prefix, m = remaining;
        unsigned cgt = 0, ceq = 0;
#pragma unroll
        for (int i = 0; i < 8; ++i) { const int idx = tid * 8 + i; if (idx < n) { cgt += key[i] > T ? 1u : 0u; ceq += key[i] == T ? 1u : 0u; } }
        auto block_excl = [&](unsigned v) -> unsigned {
            unsigned inc = v;
#pragma unroll
            for (int o = 1; o < 64; o <<= 1) { const unsigned t = (unsigned)__builtin_amdgcn_ds_bpermute((lane - o) << 2, (int)inc); if (lane >= o) inc += t; }
            __syncthreads();
            if (lane == 63) wsum[wid] = inc;
            __syncthreads();
            unsigned base = 0;
#pragma unroll
            for (int w = 0; w < 8; ++w) base += (w < wid) ? wsum[w] : 0u;
            return base + inc - v; };
        unsigned eqbase = block_excl(ceq);
        unsigned nsel = 0; bool sel[8];
#pragma unroll
        for (int i = 0; i < 8; ++i) { const int idx = tid * 8 + i; bool s_ = false;
            if (idx < n) { if (key[i] > T) s_ = true; else if (key[i] == T) { s_ = eqbase < m; ++eqbase; } }
            sel[i] = s_; nsel += s_ ? 1u : 0u; }
        unsigned sbase = block_excl(nsel);
#pragma unroll
        for (int i = 0; i < 8; ++i) { const int idx = tid * 8 + i;
            if (idx < n) {
                if (sel[i]) { const int sl = slot0 + (int)sbase; ++sbase; ROWIDX[e * ESLOTS + sl] = row0 + idx; GATE[e * EPAD + sl] = __uint_as_float(key[i]); SLOT[(size_t)(row0 + idx) * 16 + e] = sl; }
                else SLOT[(size_t)(row0 + idx) * 16 + e] = -1; } }
    }
}

__device__ void ph_gather(const Params& p, int nslots) {
    const int wid = tidx() >> 6, lane = tidx() & 63;
    const int* ROWIDX = (const int*)(p.ws + OFF_ROWIDX); const bf16_t* BN = (const bf16_t*)(p.ws + OFF_H); bf16_t* XE = (bf16_t*)(p.ws + OFF_XE);
    for (int it = bidx() * 8 + wid; it < NE * ESLOTS; it += gdim() * 8) {
        const int e = it / ESLOTS, sl = it % ESLOTS; if (sl >= nslots) continue; const int row = ROWIDX[it];
        const u32x4* src = (const u32x4*)(BN + (size_t)row * D); u32x4* dst = (u32x4*)(XE + ((size_t)e * EPAD + sl) * D);
        dst[lane] = src[lane]; dst[lane + 64] = src[lane + 64];
    }
}

__device__ void ph_combine(const Params& p, int layer, int nrows) {
    const int wid = tidx() >> 6, lane = tidx() & 63;
    const int* SLOT = (const int*)(p.ws + OFF_SLOT); const bf16_t* YE = (const bf16_t*)(p.ws + OFF_YE); float* X = (float*)(p.ws + OFF_X);
    for (int row = bidx() * 8 + wid; row < nrows; row += gdim() * 8) {
        const float* gt = modp(p, layer, row_stream(row), 5);
        float acc[16];
#pragma unroll
        for (int i = 0; i < 16; ++i) acc[i] = 0.f;
        for (int e = 0; e < NE; ++e) {
            const int s = SLOT[(size_t)row * 16 + e];
            if (s >= 0) { const bf16_t* y = YE + ((size_t)e * EPAD + s) * D + lane * 16;
                const u32x4 a = *(const u32x4*)y, b = *(const u32x4*)(y + 8);
                const unsigned w[8] = {a.x, a.y, a.z, a.w, b.x, b.y, b.z, b.w};
#pragma unroll
                for (int i = 0; i < 8; ++i) { acc[2 * i] += __uint_as_float(w[i] << 16); acc[2 * i + 1] += __uint_as_float(w[i] & 0xffff0000u); } }
        }
        float* xr = X + (size_t)row * D + lane * 16; const float* g = gt + lane * 16;
#pragma unroll
        for (int i = 0; i < 16; i += 4) { float4 xv = *(float4*)(xr + i); const float4 gv = *(const float4*)(g + i);
            xv.x += gv.x * acc[i]; xv.y += gv.y * acc[i + 1]; xv.z += gv.z * acc[i + 2]; xv.w += gv.w * acc[i + 3]; *(float4*)(xr + i) = xv; }
    }
}

__device__ void ph_rw_normxs(const Params& p, int layer, int j) {
    const int wid = tidx() >> 6, lane = tidx() & 63;
    const float* X = (const float*)(p.ws + OFF_X); bf16_t* XS = (bf16_t*)(p.ws + OFF_XS);
    const float* mu = p.rw_mu + (size_t)j * 6 * D; const float* g = p.norm1_g + layer * D;
    for (int row = bidx() * 8 + wid; row < NROW; row += gdim() * 8) {
        const int s_ = row_stream(row);
        const float* sh = modp(p, layer, s_, 0); const float* sc = modp(p, layer, s_, 1);
        const bool lat = row < NLAT; const int t = lat ? (row & (TL - 1)) : ((row - NLAT) & (TC - 1)); const int len = lat ? TL : TC;
        const bool hp = t > 0, hn = t < len - 1;
        float4 xc[4], xp[4], xn[4]; float sc_ = 0, sp_ = 0, sn_ = 0;
#pragma unroll
        for (int i = 0; i < 4; ++i) {
            xc[i] = ((const float4*)(X + (size_t)row * D))[lane + i * 64];
            xp[i] = hp ? ((const float4*)(X + (size_t)(row - 1) * D))[lane + i * 64] : make_float4(0, 0, 0, 0);
            xn[i] = hn ? ((const float4*)(X + (size_t)(row + 1) * D))[lane + i * 64] : make_float4(0, 0, 0, 0);
            sc_ += xc[i].x * xc[i].x + xc[i].y * xc[i].y + xc[i].z * xc[i].z + xc[i].w * xc[i].w;
            sp_ += xp[i].x * xp[i].x + xp[i].y * xp[i].y + xp[i].z * xp[i].z + xp[i].w * xp[i].w;
            sn_ += xn[i].x * xn[i].x + xn[i].y * xn[i].y + xn[i].z * xn[i].z + xn[i].w * xn[i].w; }
        sc_ = wave_sum(sc_); sp_ = wave_sum(sp_); sn_ = wave_sum(sn_);
        const float rc = rsqrtf(sc_ * (1.f / D) + RMS_EPS), rp = hp ? rsqrtf(sp_ * (1.f / D) + RMS_EPS) : 0.f, rn = hn ? rsqrtf(sn_ * (1.f / D) + RMS_EPS) : 0.f;
#pragma unroll
        for (int i = 0; i < 4; ++i) {
            const int d = (lane + i * 64) * 4;
            const float4 gg = *(const float4*)(g + d), a = *(const float4*)(sc + d), bsh = *(const float4*)(sh + d);
            float h[4], xx[4];
            const float gm[4] = {gg.x * (1.f + a.x), gg.y * (1.f + a.y), gg.z * (1.f + a.z), gg.w * (1.f + a.w)}; const float bb[4] = {bsh.x, bsh.y, bsh.z, bsh.w};
            const float c4[4] = {xc[i].x, xc[i].y, xc[i].z, xc[i].w}, p4[4] = {xp[i].x, xp[i].y, xp[i].z, xp[i].w}, n4[4] = {xn[i].x, xn[i].y, xn[i].z, xn[i].w};
#pragma unroll
            for (int e = 0; e < 4; ++e) { h[e] = c4[e] * rc * gm[e] + bb[e];
                const float hpv = hp ? p4[e] * rp * gm[e] + bb[e] : 0.f, hnv = hn ? n4[e] * rn * gm[e] + bb[e] : 0.f;
                xx[e] = 0.5f * (hpv + hnv) - h[e]; }
#pragma unroll
            for (int m = 0; m < 6; ++m) { const float4 u = *(const float4*)(mu + m * D + d);
                uint2 w; w.x = pk2(h[0] + xx[0] * u.x, h[1] + xx[1] * u.y); w.y = pk2(h[2] + xx[2] * u.z, h[3] + xx[3] * u.w);
                *(uint2*)(XS + ((size_t)m * NROW + row) * D + d) = w; }
        }
    }
}

__device__ __forceinline__ int scan_row(int i, int b, int z) {
    return i < TC ? NLAT + b * TC + (z ? TC - 1 - i : i) : b * TL + (z ? TL - 1 - (i - TC) : i - TC);
}
__device__ __forceinline__ float dpp_sum8(float x) {
    x += __builtin_bit_cast(float, __builtin_amdgcn_update_dpp(0, __builtin_bit_cast(int, x), 0xB1, 0xF, 0xF, true));
    x += __builtin_bit_cast(float, __builtin_amdgcn_update_dpp(0, __builtin_bit_cast(int, x), 0x4E, 0xF, 0xF, true));
    x += __builtin_bit_cast(float, __builtin_amdgcn_update_dpp(0, __builtin_bit_cast(int, x), 0x141, 0xF, 0xF, true));
    return x;
}
__device__ void ph_rw_scan(const Params& p, int j, char* lds) {
    const int tid = tidx(), wid = __builtin_amdgcn_readfirstlane(tid >> 6), lane = tid & 63;
    const size_t PL = (size_t)NROW * D;
    const float* RKV = (const float*)(p.ws + OFF_RKV); float* Y = (float*)(p.ws + OFF_Y);
    constexpr int CH = 32, BUFB = 5 * CH * 256 + CH * 128 + CH * 16, YB = CH * 32 * 4, NCH = (TC + TL) / CH;
    const bool loader = wid >= 4; const int lw = wid - 4;
    for (int it = bidx(); it < 256; it += gdim()) {
        const int vh = it & 1, z = (it >> 1) & 1, h = (it >> 2) & 15, b = it >> 6;
        const char* pl0 = (const char*)((const float*)(p.ws + OFF_W) + z * PL); const char* pl1 = (const char*)(RKV + PL);
        const char* pl2 = (const char*)((const float*)(p.ws + OFF_AV) + z * PL); const char* pl3 = (const char*)RKV;
        const char* vpl = (const char*)(RKV + 2 * PL);
        float* yout = Y + z * PL;
        __builtin_amdgcn_s_barrier();
        if (loader) {
            const int pq = lane & 15;
            const f32x4 kkv = *(const f32x4*)(p.rw_k_k + j * D + h * 64 + pq * 4), kav = *(const f32x4*)(p.rw_k_a + j * D + h * 64 + pq * 4);
            auto issue = [&](int c) {
                char* buf = lds + (c % 3) * BUFB;
#pragma unroll
                for (int q = 0; q < 8; ++q) { const int pi = q >> 1, tg = lw * 2 + (q & 1); const int row = scan_row(c * CH + tg * 4 + (lane >> 4), b, z);
                    const char* base = pi == 0 ? pl0 : pi == 1 ? pl1 : pi == 2 ? pl2 : pl3;
                    __builtin_amdgcn_global_load_lds((const unsigned*)(base + (size_t)row * D * 4 + h * 256 + (lane & 15) * 16), (LAS unsigned*)(buf + pi * (CH * 256) + tg * 1024), 16, 0, 0); }
                { const int row = scan_row(c * CH + lw * 8 + (lane >> 3), b, z);
                  __builtin_amdgcn_global_load_lds((const unsigned*)(vpl + (size_t)row * D * 4 + (h * 64 + vh * 32) * 4 + (lane & 7) * 16), (LAS unsigned*)(buf + 5 * CH * 256 + lw * 1024), 16, 0, 0); }
            };
            auto prep = [&](int c) {
                char* buf = lds + (c % 3) * BUFB;
#pragma unroll
                for (int ps = 0; ps < 2; ++ps) { const int ptok = lw * 8 + ps * 4 + (lane >> 4);
                    f32x4* kp = (f32x4*)(buf + 1 * CH * 256 + ptok * 256 + pq * 16); f32x4* ap = (f32x4*)(buf + 2 * CH * 256 + ptok * 256 + pq * 16); f32x4* dp = (f32x4*)(buf + 4 * CH * 256 + ptok * 256 + pq * 16);
                    f32x4* rp = (f32x4*)(buf + 3 * CH * 256 + ptok * 256 + pq * 16); const f32x4 wv = *(const f32x4*)(buf + ptok * 256 + pq * 16);
                    const f32x4 k = *kp, a = *ap, r = *rp; f32x4 kk = k * kkv;
                    float ss = kk[0] * kk[0] + kk[1] * kk[1] + kk[2] * kk[2] + kk[3] * kk[3]; ss = dpp_sum16(ss);
                    const float inv = 1.f / fmaxf(sqrtf(ss), 1e-12f); kk = kk * inv;
                    const f32x4 kd = k * (1.f + (a - 1.f) * kav), bb = kk * a;
                    const f32x4 t1 = bb * r, t2 = kd * r;
                    const float br = dpp_sum16((t1[0] + t1[1]) + (t1[2] + t1[3])), kr = dpp_sum16((t2[0] + t2[1]) + (t2[2] + t2[3]));
                    *dp = kd; *ap = bb; *kp = kk; *rp = wv * r;
                    if (pq == 0) *(float2*)(buf + 5 * CH * 256 + CH * 128 + ptok * 16) = make_float2(br, kr); }
            };
            issue(0); issue(1);
            asm volatile("s_waitcnt vmcnt(9)" ::: "memory");
            prep(0);
            asm volatile("s_waitcnt lgkmcnt(0)" ::: "memory"); __builtin_amdgcn_s_barrier();
            for (int c = 0; c < NCH; ++c) {
                if (c >= 1) { const float* yb = (const float*)(lds + 3 * BUFB + ((c - 1) & 1) * YB);
                    const int lt = tid - 256, t = lt >> 3, q = lt & 7; const int row = scan_row((c - 1) * CH + t, b, z);
                    *(f32x4*)(yout + (size_t)row * D + h * 64 + vh * 32 + q * 4) = *(const f32x4*)(yb + t * 32 + q * 4); }
                if (c + 2 < NCH) { issue(c + 2); asm volatile("s_waitcnt vmcnt(9)" ::: "memory"); } else asm volatile("s_waitcnt vmcnt(0)" ::: "memory");
                if (c + 1 < NCH) prep(c + 1);
                asm volatile("s_waitcnt lgkmcnt(0)" ::: "memory"); __builtin_amdgcn_s_barrier();
            }
            { const float* yb = (const float*)(lds + 3 * BUFB + ((NCH - 1) & 1) * YB);
              const int lt = tid - 256, t = lt >> 3, q = lt & 7; const int row = scan_row((NCH - 1) * CH + t, b, z);
              *(f32x4*)(yout + (size_t)row * D + h * 64 + vh * 32 + q * 4) = *(const f32x4*)(yb + t * 32 + q * 4); }
        } else {
            const int vr = lane >> 3, ks = lane & 7;
            f32x4 Sa = {0.f, 0.f, 0.f, 0.f}, Sb = {0.f, 0.f, 0.f, 0.f};
            __builtin_amdgcn_s_barrier();
            struct Ops { f32x4 w0, w1, kk0, kk1, bb0, bb1, r0, r1, kd0, kd1; float v; float2 sc; };
#define SC_LOAD(O, t) do { const char* q_ = bq + (t) * 256; O.w0 = *(const f32x4*)(q_); O.w1 = *(const f32x4*)(q_ + 16); O.kk0 = *(const f32x4*)(q_ + CH * 256); O.kk1 = *(const f32x4*)(q_ + CH * 256 + 16); \
                O.bb0 = *(const f32x4*)(q_ + 2 * CH * 256); O.bb1 = *(const f32x4*)(q_ + 2 * CH * 256 + 16); O.r0 = *(const f32x4*)(q_ + 3 * CH * 256); O.r1 = *(const f32x4*)(q_ + 3 * CH * 256 + 16); \
                O.kd0 = *(const f32x4*)(q_ + 4 * CH * 256); O.kd1 = *(const f32x4*)(q_ + 4 * CH * 256 + 16); O.v = *(const float*)(vq + (t) * 128); O.sc = *(const float2*)(buf + 5 * CH * 256 + CH * 128 + (t) * 16); } while (0)
#define SC_STEP(O, t) do { const f32x4 d1 = Sa * O.kk0 + Sb * O.kk1, d2 = Sa * O.r0 + Sb * O.r1; \
                float sa = -((d1[0] + d1[1]) + (d1[2] + d1[3])), yy = (d2[0] + d2[1]) + (d2[2] + d2[3]); \
                sa = dpp_sum8(sa); yy = dpp_sum8(yy); \
                Sa = Sa * O.w0 + (sa * O.bb0 + O.v * O.kd0); Sb = Sb * O.w1 + (sa * O.bb1 + O.v * O.kd1); \
                if (ks == 0) yb[(t) * 32 + wid * 8 + vr] = yy + sa * O.sc.x + O.v * O.sc.y; } while (0)
            for (int c = 0; c < NCH; ++c) {
                const char* buf = lds + (c % 3) * BUFB; float* yb = (float*)(lds + 3 * BUFB + (c & 1) * YB);
                const char* bq = buf + ks * 32; const char* vq = buf + 5 * CH * 256 + (wid * 8 + vr) * 4;
                Ops oA, oB, oC;
                SC_LOAD(oA, 0); SC_LOAD(oB, 1);
#pragma unroll
                for (int t = 0; t < CH; t += 3) {
                    if (t + 2 < CH) SC_LOAD(oC, t + 2);
                    SC_STEP(oA, t);
                    if (t + 3 < CH) SC_LOAD(oA, t + 3);
                    if (t + 1 < CH) SC_STEP(oB, t + 1);
                    if (t + 4 < CH) SC_LOAD(oB, t + 4);
                    if (t + 2 < CH) SC_STEP(oC, t + 2);
                }
                asm volatile("s_waitcnt lgkmcnt(0)" ::: "memory"); __builtin_amdgcn_s_barrier();
            }
#undef SC_LOAD
#undef SC_STEP
        }
    }
}


namespace ck {
constexpr int P = 72, MB = 64 * P * 2;
typedef __attribute__((address_space(3))) char lchar;
__device__ __forceinline__ f32x4 mm_tile(const lchar* Aop, const lchar* Bop, int ti, int tj, int c, int q, f32x4 acc) {
#pragma unroll
    for (int ks = 0; ks < 2; ++ks) {
        const bf16x8 a = *(const LAS bf16x8*)(Aop + ((16 * ti + c) * P + 32 * ks + 8 * q) * 2);
        const bf16x8 b = *(const LAS bf16x8*)(Bop + ((16 * tj + c) * P + 32 * ks + 8 * q) * 2);
        acc = __builtin_amdgcn_mfma_f32_16x16x32_bf16(a, b, acc, 0, 0, 0);
    }
    return acc;
}
__device__ __forceinline__ f32x4 mm_diag(const lchar* Aop, const lchar* Bop, int tt, int c, int q, f32x4 acc) {
    const int ks = tt >> 1;
    bf16x8 a = *(const LAS bf16x8*)(Aop + ((16 * tt + c) * P + 32 * ks + 8 * q) * 2);
    const bf16x8 b = *(const LAS bf16x8*)(Bop + ((16 * tt + c) * P + 32 * ks + 8 * q) * 2);
    if ((q >> 1) != (tt & 1)) a = (bf16x8){0, 0, 0, 0, 0, 0, 0, 0};
    return __builtin_amdgcn_mfma_f32_16x16x32_bf16(a, b, acc, 0, 0, 0);
}
__device__ __forceinline__ void st_tile(lchar* dst, int ti, int tj, int c, int q, f32x4 v) {
    u32x2 w; w.x = pk2(v[0], v[1]); w.y = pk2(v[2], v[3]); *(LAS u32x2*)(dst + ((16 * tj + c) * P + 16 * ti + 4 * q) * 2) = w;
}
__device__ __forceinline__ f32x4 ld_tile(const lchar* src, int ti, int tj, int c, int q) {
    const u32x2 w = *(const LAS u32x2*)(src + ((16 * tj + c) * P + 16 * ti + 4 * q) * 2);
    return (f32x4){__uint_as_float(w.x << 16), __uint_as_float(w.x & 0xffff0000u), __uint_as_float(w.y << 16), __uint_as_float(w.y & 0xffff0000u)};
}
__device__ __forceinline__ void st_glob(bf16_t* dst, int ti, int tj, int c, int q, f32x4 v) {
    uint2 w; w.x = pk2(v[0], v[1]); w.y = pk2(v[2], v[3]); *(uint2*)(dst + (16 * tj + c) * 64 + 16 * ti + 4 * q) = w;
}
typedef float f32x16 __attribute__((ext_vector_type(16)));
__device__ __forceinline__ f32x16 mm32(const lchar* Aop, const lchar* Bop, int ti, int tj, int r32, int hi, f32x16 acc) {
#pragma unroll
    for (int ks = 0; ks < 4; ++ks) {
        const bf16x8 a = *(const LAS bf16x8*)(Aop + ((32 * ti + r32) * P + 16 * ks + 8 * hi) * 2);
        const bf16x8 b = *(const LAS bf16x8*)(Bop + ((32 * tj + r32) * P + 16 * ks + 8 * hi) * 2);
        acc = __builtin_amdgcn_mfma_f32_32x32x16_bf16(a, b, acc, 0, 0, 0);
    }
    return acc;
}
__device__ __forceinline__ void st32(lchar* dst, int ti, int tj, int r32, int hi, const f32x16& v) {
#pragma unroll
    for (int g = 0; g < 4; ++g) { u32x2 w; w.x = pk2(v[4 * g], v[4 * g + 1]); w.y = pk2(v[4 * g + 2], v[4 * g + 3]); *(LAS u32x2*)(dst + ((32 * tj + r32) * P + 32 * ti + 8 * g + 4 * hi) * 2) = w; }
}
__device__ __forceinline__ f32x16 ld32(const lchar* src, int ti, int tj, int r32, int hi) {
    f32x16 v;
#pragma unroll
    for (int g = 0; g < 4; ++g) { const u32x2 w = *(const LAS u32x2*)(src + ((32 * tj + r32) * P + 32 * ti + 8 * g + 4 * hi) * 2);
        v[4 * g] = __uint_as_float(w.x << 16); v[4 * g + 1] = __uint_as_float(w.x & 0xffff0000u); v[4 * g + 2] = __uint_as_float(w.y << 16); v[4 * g + 3] = __uint_as_float(w.y & 0xffff0000u); }
    return v;
}
__device__ __forceinline__ void stg32(bf16_t* dst, int ti, int tj, int r32, int hi, const f32x16& v) {
#pragma unroll
    for (int g = 0; g < 4; ++g) { uint2 w; w.x = pk2(v[4 * g], v[4 * g + 1]); w.y = pk2(v[4 * g + 2], v[4 * g + 3]); *(uint2*)(dst + (32 * tj + r32) * 64 + 32 * ti + 8 * g + 4 * hi) = w; }
}
}

#define LBAR() do { asm volatile("s_waitcnt lgkmcnt(0)" ::: "memory"); __builtin_amdgcn_s_barrier(); asm volatile("" ::: "memory"); } while (0)
__device__ void ph_rw_sc1(const Params& p, int j, char* lds) {
    using namespace ck;
    const int tid = tidx(), wid = __builtin_amdgcn_readfirstlane(tid >> 6), lane = tid & 63, c = lane & 15, q = lane >> 4;
    const size_t PL = (size_t)NROW * D;
    const float* RKV = (const float*)(p.ws + OFF_RKV); const float* LW = (const float*)(p.ws + OFF_W); const float* AV = (const float*)(p.ws + OFF_AV);
    bf16_t* CK = (bf16_t*)(p.ws + OFF_CK);
    lchar* B0 = (lchar*)lds;
#define BUF(i) (B0 + (i) * MB)
    LAS float* Lbuf = (LAS float*)BUF(8);
    LAS float* Lseg = (LAS float*)(B0 + 16 * MB);
    LAS float* GC = Lseg + 8 * 64;
    const int pt = tid >> 3, cg = tid & 7;
    f32x4 nlw[2], nkx[2], nax[2], nrx[2], nvx[2];
#define SC1_LOAD(IT) do { const int seq_ = (IT) / NCHK, ch_ = (IT) % NCHK; const int z_ = seq_ & 1, h_ = (seq_ >> 1) & 15, b_ = seq_ >> 5; \
        const size_t go_ = (size_t)scan_row(ch_ * 64 + pt, b_, z_) * D + h_ * 64 + cg * 8; \
        _Pragma("unroll") for (int e = 0; e < 2; ++e) { nlw[e] = *(const f32x4*)(LW + z_ * PL + go_ + 4 * e); nkx[e] = *(const f32x4*)(RKV + PL + go_ + 4 * e); nax[e] = *(const f32x4*)(AV + z_ * PL + go_ + 4 * e); \
            nrx[e] = *(const f32x4*)(RKV + go_ + 4 * e); nvx[e] = *(const f32x4*)(RKV + 2 * PL + go_ + 4 * e); } } while (0)
    if (bidx() < 128 * NCHK) SC1_LOAD(bidx());
    for (int it = bidx(); it < 128 * NCHK; it += gdim()) {
        const int seq = it / NCHK; const int h = (seq >> 1) & 15;
        f32x4 lw[2], kx[2], ax[2], rx[2], vx[2];
#pragma unroll
        for (int e = 0; e < 2; ++e) { lw[e] = nlw[e]; kx[e] = nkx[e]; ax[e] = nax[e]; rx[e] = nrx[e]; vx[e] = nvx[e]; }
        if (it + gdim() < 128 * NCHK) SC1_LOAD(it + gdim());
        LBAR();
#pragma unroll
        for (int e = 0; e < 2; ++e) *(LAS f32x4*)(Lbuf + pt * 64 + cg * 8 + 4 * e) = lw[e];
        f32x4 kk[2], bq[2], kd[2];
        { float ss = 0.f;
#pragma unroll
          for (int e = 0; e < 2; ++e) { kk[e] = kx[e] * *(const f32x4*)(p.rw_k_k + j * D + h * 64 + cg * 8 + 4 * e); ss += kk[e][0] * kk[e][0] + kk[e][1] * kk[e][1] + kk[e][2] * kk[e][2] + kk[e][3] * kk[e][3]; }
          ss = dpp_sum8(ss); const float inv = 1.f / fmaxf(sqrtf(ss), 1e-12f);
#pragma unroll
          for (int e = 0; e < 2; ++e) { kk[e] = kk[e] * inv; bq[e] = kk[e] * ax[e]; kd[e] = kx[e] * (1.f + (ax[e] - 1.f) * *(const f32x4*)(p.rw_k_a + j * D + h * 64 + cg * 8 + 4 * e)); } }
        LBAR();
        { const int k = tid & 63, sg = tid >> 6; float run = 0.f;
#pragma unroll
          for (int u = 0; u < 8; ++u) { run += Lbuf[(sg * 8 + u) * 64 + k]; Lbuf[(sg * 8 + u) * 64 + k] = run; }
          Lseg[sg * 64 + k] = run; }
        LBAR();
        f32x4 Lt[2], Lp[2], Lc[2];
        { const int sg = pt >> 3, sgp = (pt - 1) >> 3;
#pragma unroll
          for (int e = 0; e < 2; ++e) { f32x4 o0 = {0.f, 0.f, 0.f, 0.f}, o1 = o0, oc = o0;
#pragma unroll
              for (int u = 0; u < 8; ++u) { const f32x4 sv = *(const LAS f32x4*)(Lseg + u * 64 + cg * 8 + 4 * e); if (u < sg) o0 = o0 + sv; if (u < sgp) o1 = o1 + sv; if (u < 7) oc = oc + sv; }
              Lt[e] = *(const LAS f32x4*)(Lbuf + pt * 64 + cg * 8 + 4 * e) + o0;
              Lp[e] = pt > 0 ? *(const LAS f32x4*)(Lbuf + (pt - 1) * 64 + cg * 8 + 4 * e) + o1 : (f32x4){0.f, 0.f, 0.f, 0.f};
              Lc[e] = *(const LAS f32x4*)(Lbuf + 63 * 64 + cg * 8 + 4 * e) + oc; } }
        LBAR();
        {
            float at[8], bt[8], kt[8], rt[8], bh[8], kh[8], vv[8];
#pragma unroll
            for (int e = 0; e < 2; ++e)
#pragma unroll
                for (int u = 0; u < 4; ++u) { const int x = 4 * e + u; const float eL = __expf(Lt[e][u]), emL = __expf(-Lt[e][u]), eP = __expf(Lp[e][u]), eC = __expf(Lc[e][u] - Lt[e][u]);
                    at[x] = -kk[e][u] * eP; bt[x] = bq[e][u] * emL; kt[x] = kd[e][u] * emL; rt[x] = rx[e][u] * eL; bh[x] = bq[e][u] * eC; kh[x] = kd[e][u] * eC; vv[x] = vx[e][u];
                    if (pt == 63) GC[cg * 8 + x] = eL; }
#define ST8(bufi, arr) do { u32x4 w_ = {pk2(arr[0], arr[1]), pk2(arr[2], arr[3]), pk2(arr[4], arr[5]), pk2(arr[6], arr[7])}; *(LAS u32x4*)(BUF(bufi) + (pt * P + cg * 8) * 2) = w_; } while (0)
            ST8(0, at); ST8(1, bt); ST8(2, kt); ST8(3, rt); ST8(8, bh); ST8(9, kh); ST8(10, vv);
#undef ST8
        }
        LBAR();
        {
            const int k = tid & 63, tg = tid >> 6;
#define TR8(src, dst) do { unsigned w_[4]; _Pragma("unroll") for (int x = 0; x < 4; ++x) { const unsigned lo = *(const LAS bf16_t*)(BUF(src) + ((tg * 8 + 2 * x) * P + k) * 2), hi2 = *(const LAS bf16_t*)(BUF(src) + ((tg * 8 + 2 * x + 1) * P + k) * 2); w_[x] = lo | (hi2 << 16); } \
                *(LAS u32x4*)(BUF(dst) + (k * P + tg * 8) * 2) = (u32x4){w_[0], w_[1], w_[2], w_[3]}; } while (0)
            TR8(0, 4); TR8(8, 5); TR8(9, 6); TR8(10, 7);
#undef TR8
        }
        LBAR();
        const f32x4 Z4 = {0.f, 0.f, 0.f, 0.f};
        const f32x16 Z16 = {0.f, 0.f, 0.f, 0.f, 0.f, 0.f, 0.f, 0.f, 0.f, 0.f, 0.f, 0.f, 0.f, 0.f, 0.f, 0.f};
        const int r32 = lane & 31, hi = lane >> 5;
#pragma unroll 1
        for (int u = 0; u < 3; ++u) { const int tl = u * 8 + wid; if (tl >= 20) break; const int m = tl >> 2, ti = (tl >> 1) & 1, tj = tl & 1; const int jj = 32 * tj + r32;
            if (m == 0) { f32x16 v = mm32(BUF(0), BUF(1), ti, tj, r32, hi, Z16), w;
#pragma unroll
                for (int e = 0; e < 16; ++e) { const int ii = 32 * ti + 8 * (e >> 2) + 4 * hi + (e & 3); const bool dg = (ii >> 4) == (jj >> 4);
                    v[e] = (dg && jj < ii) ? v[e] : 0.f; w[e] = v[e] + ((ii == jj) ? 1.f : 0.f); }
                st32(BUF(8), ti, tj, r32, hi, v); st32(BUF(14), ti, tj, r32, hi, w); }
            else if (m == 1) { const f32x16 v = mm32(BUF(1), BUF(0), ti, tj, r32, hi, Z16); f32x16 vd, vo, w;
#pragma unroll
                for (int e = 0; e < 16; ++e) { const int ii = 32 * ti + 8 * (e >> 2) + 4 * hi + (e & 3); const bool dg = (ii >> 4) == (jj >> 4), up = ii < jj;
                    vd[e] = (dg && up) ? v[e] : 0.f; vo[e] = (!dg && up) ? v[e] : 0.f; w[e] = vd[e] + ((ii == jj) ? 1.f : 0.f); }
                st32(BUF(9), ti, tj, r32, hi, vd); st32(BUF(15), ti, tj, r32, hi, vo); st32(BUF(13), ti, tj, r32, hi, w); }
            else if (m == 2) { f32x16 v = mm32(BUF(0), BUF(2), ti, tj, r32, hi, Z16);
#pragma unroll
                for (int e = 0; e < 16; ++e) { const int ii = 32 * ti + 8 * (e >> 2) + 4 * hi + (e & 3); v[e] = jj < ii ? v[e] : 0.f; }
                st32(BUF(10), ti, tj, r32, hi, v); }
            else { f32x16 v = mm32(m == 3 ? BUF(1) : BUF(2), BUF(3), ti, tj, r32, hi, Z16);
#pragma unroll
                for (int e = 0; e < 16; ++e) { const int ii = 32 * ti + 8 * (e >> 2) + 4 * hi + (e & 3); v[e] = ii <= jj ? v[e] : 0.f; }
                st32(m == 3 ? BUF(11) : BUF(12), ti, tj, r32, hi, v); } }
        LBAR();
#define SQD(sr, st, dr, dt) do { if (wid >= 4) { const int tt = wid - 4; const f32x4 a_ = mm_diag(BUF(st), BUF(sr), tt, c, q, Z4), b_ = mm_diag(BUF(sr), BUF(st), tt, c, q, Z4); \
            st_tile(BUF(dr), tt, tt, c, q, a_); st_tile(BUF(dt), tt, tt, c, q, b_); } } while (0)
#define UPD(pr) do { if (wid < 4) { const int tt = wid; \
            const f32x4 dt_ = mm_diag(BUF(pr), BUF(13), tt, c, q, ld_tile(BUF(13), tt, tt, c, q));      \
            const f32x4 dr_ = mm_diag(BUF(13), BUF(pr), tt, c, q, ld_tile(BUF(14), tt, tt, c, q));      \
            asm volatile("s_waitcnt lgkmcnt(0)" ::: "memory"); \
            st_tile(BUF(13), tt, tt, c, q, dt_); st_tile(BUF(14), tt, tt, c, q, dr_); } } while (0)
        SQD(8, 9, 0, 1); LBAR();
        UPD(0); SQD(0, 1, 8, 9); LBAR();
        UPD(8); SQD(8, 9, 0, 1); LBAR();
        UPD(0); LBAR();
#undef SQD
#undef UPD
        { const int m = wid >> 2, ti = (wid >> 1) & 1, tj = wid & 1;
          if (m == 0) st32(BUF(8), ti, tj, r32, hi, mm32(BUF(15), BUF(14), ti, tj, r32, hi, Z16));
          else        st32(BUF(9), ti, tj, r32, hi, mm32(BUF(14), BUF(15), ti, tj, r32, hi, Z16)); }
        LBAR();
        if (wid < 4) { const int ti = (wid >> 1) & 1, tj = wid & 1; st32(BUF(0), ti, tj, r32, hi, mm32(BUF(9), BUF(8), ti, tj, r32, hi, Z16)); }
        LBAR();
        if (wid < 4) { const int ti = (wid >> 1) & 1, tj = wid & 1; st32(BUF(1), ti, tj, r32, hi, mm32(BUF(0), BUF(13), ti, tj, r32, hi, ld32(BUF(13), ti, tj, r32, hi))); }
        LBAR();
        if (wid < 4) { const int ti = (wid >> 1) & 1, tj = wid & 1; st32(BUF(14), ti, tj, r32, hi, mm32(BUF(8), BUF(1), ti, tj, r32, hi, ld32(BUF(1), ti, tj, r32, hi))); }
        LBAR();
        { const int m = wid >> 2, ti = (wid >> 1) & 1, tj = wid & 1;
          if (m == 0) st32(BUF(8), ti, tj, r32, hi, mm32(BUF(14), BUF(4), ti, tj, r32, hi, Z16));
          else        st32(BUF(9), ti, tj, r32, hi, mm32(BUF(10), BUF(14), ti, tj, r32, hi, Z16)); }
        LBAR();
        bf16_t* ckp = CK + (size_t)it * 4 * 4096;
#pragma unroll 1
        for (int u = 0; u < 2; ++u) { const int tl = u * 8 + wid; if (tl >= 12) break; const int m = tl >> 2, ti = (tl >> 1) & 1, tj = tl & 1;
            if (m == 0) st32(BUF(0), ti, tj, r32, hi, mm32(BUF(9), BUF(7), ti, tj, r32, hi, Z16));
            else if (m == 1) { f32x16 v = mm32(BUF(8), BUF(5), ti, tj, r32, hi, Z16); const int jj = 32 * tj + r32; const float gc = GC[jj];
#pragma unroll
                for (int e = 0; e < 16; ++e) { const int ii = 32 * ti + 8 * (e >> 2) + 4 * hi + (e & 3); v[e] += (ii == jj) ? gc : 0.f; }
                stg32(ckp, ti, tj, r32, hi, v); }
            else stg32(ckp + 2 * 4096, ti, tj, r32, hi, mm32(BUF(8), BUF(11), ti, tj, r32, hi, ld32(BUF(3), ti, tj, r32, hi))); }
        LBAR();
        { const int m = wid >> 2, ti = (wid >> 1) & 1, tj = wid & 1;
          if (m == 0) stg32(ckp + 4096, ti, tj, r32, hi, mm32(BUF(6), BUF(7), ti, tj, r32, hi, mm32(BUF(5), BUF(0), ti, tj, r32, hi, Z16)));
          else        stg32(ckp + 3 * 4096, ti, tj, r32, hi, mm32(BUF(7), BUF(12), ti, tj, r32, hi, mm32(BUF(0), BUF(11), ti, tj, r32, hi, Z16))); }
    }
#undef BUF
#undef SC1_LOAD
}

__device__ void ph_rw_sc2(const Params& p, char* lds) {
    using namespace ck;
    const int tid = tidx(), wid = __builtin_amdgcn_readfirstlane(tid >> 6), lane = tid & 63, c = lane & 15, q = lane >> 4;
    const size_t PL = (size_t)NROW * D;
    const bf16_t* CK = (const bf16_t*)(p.ws + OFF_CK); float* Y = (float*)(p.ws + OFF_Y);
    lchar* GB = (lchar*)lds;
    lchar* RB = GB + 2 * MB;
    lchar* SB = GB + 4 * MB;
    constexpr int SBB = 32 * P * 2;
    for (int it = bidx(); it < 256; it += gdim()) {
        const int vh = it & 1, seq = it >> 1, z = seq & 1, h = (seq >> 1) & 15, b = seq >> 5;
        const bf16_t* ck0 = CK + (size_t)seq * NCHK * 4 * 4096;
        LBAR();
        for (int i = tid; i < SBB / 4; i += NTHR) ((LAS unsigned*)SB)[i] = 0u;
        u32x4 g0 = *(const u32x4*)(ck0 + tid * 8), r0 = *(const u32x4*)(ck0 + 2 * 4096 + tid * 8);
        *(LAS u32x4*)(GB + ((tid >> 3) * P + (tid & 7) * 8) * 2) = g0; *(LAS u32x4*)(RB + ((tid >> 3) * P + (tid & 7) * 8) * 2) = r0;
        LBAR();
        const int s_ti = wid & 3, s_tj = wid >> 2;
        const int y_ti = wid & 1, y_tj = wid >> 1;
        for (int ch = 0; ch < NCHK; ++ch) {
            const bf16_t* ckc = ck0 + (size_t)ch * 4 * 4096; const int cur = ch & 1;
            u32x4 gn, rn; const bool more = ch + 1 < NCHK;
            if (more) { gn = *(const u32x4*)(ckc + 4 * 4096 + tid * 8); rn = *(const u32x4*)(ckc + 6 * 4096 + tid * 8); }
            const uint2 hi_ = *(const uint2*)(ckc + 4096 + (vh * 32 + 16 * s_tj + c) * 64 + 16 * s_ti + 4 * q);
            const uint2 yi_ = *(const uint2*)(ckc + 3 * 4096 + (16 * y_tj + c) * 64 + vh * 32 + 16 * y_ti + 4 * q);
            const f32x4 hinit = {__uint_as_float(hi_.x << 16), __uint_as_float(hi_.x & 0xffff0000u), __uint_as_float(hi_.y << 16), __uint_as_float(hi_.y & 0xffff0000u)};
            const f32x4 yinit = {__uint_as_float(yi_.x << 16), __uint_as_float(yi_.x & 0xffff0000u), __uint_as_float(yi_.y << 16), __uint_as_float(yi_.y & 0xffff0000u)};
            const lchar* Sold = SB + cur * SBB; lchar* Snew = SB + (cur ^ 1) * SBB;
            const f32x4 sn = mm_tile(GB + cur * MB, Sold, s_ti, s_tj, c, q, hinit);
            const f32x4 yv = mm_tile(Sold, RB + cur * MB, y_ti, y_tj, c, q, yinit);
            st_tile(Snew, s_ti, s_tj, c, q, sn);
            { const int row = scan_row(ch * 64 + 16 * y_tj + c, b, z);
              *(f32x4*)(Y + z * PL + (size_t)row * D + h * 64 + vh * 32 + 16 * y_ti + 4 * q) = yv; }
            if (more) { *(LAS u32x4*)(GB + (cur ^ 1) * MB + ((tid >> 3) * P + (tid & 7) * 8) * 2) = gn; *(LAS u32x4*)(RB + (cur ^ 1) * MB + ((tid >> 3) * P + (tid & 7) * 8) * 2) = rn; }
            LBAR();
        }
    }
}

#undef LBAR
__device__ void ph_rw_out(const Params& p, int j, int nrows) {
    const int wid = tidx() >> 6, lane = tidx() & 63;
    const float* RKV = (const float*)(p.ws + OFF_RKV); const float* AV = (const float*)(p.ws + OFF_AV); const float* G = (const float*)(p.ws + OFF_G); const float* Y = (const float*)(p.ws + OFF_Y);
    bf16_t* OUT = (bf16_t*)(p.ws + OFF_H);
    const size_t PL = (size_t)NROW * D;
    const float* r_k = p.rw_r_k + j * D; const float* lg = p.rw_lnx_g + j * D; const float* lb = p.rw_lnx_b + j * D; const float* k_a = p.rw_k_a + j * D;
    for (int row = bidx() * 8 + wid; row < nrows; row += gdim() * 8) {
#pragma unroll
        for (int i = 0; i < 4; ++i) {
            const size_t o = (size_t)row * D + lane * 4 + i * 256; const int c = lane * 4 + i * 256;
            const f32x4 y = *(const f32x4*)(Y + o) + *(const f32x4*)(Y + PL + o);
            const float mean = dpp_sum16(y[0] + y[1] + y[2] + y[3]) * (1.f / 64.f);
            const f32x4 dd = y - mean;
            const float rstd = rsqrtf(dpp_sum16(dd[0] * dd[0] + dd[1] * dd[1] + dd[2] * dd[2] + dd[3] * dd[3]) * (1.f / 64.f) + LNX_EPS);
            const f32x4 r = *(const f32x4*)(RKV + o), k = *(const f32x4*)(RKV + PL + o), v = *(const f32x4*)(RKV + 2 * PL + o);
            const f32x4 a0 = *(const f32x4*)(AV + o), a1 = *(const f32x4*)(AV + PL + o);
            const f32x4 kds = k * (2.f + (a0 + a1 - 2.f) * *(const f32x4*)(k_a + c));
            const f32x4 t4 = r * kds * *(const f32x4*)(r_k + c);
            const float bs = dpp_sum16(t4[0] + t4[1] + t4[2] + t4[3]);
            const f32x4 res = (dd * rstd * *(const f32x4*)(lg + c) + *(const f32x4*)(lb + c) + bs * v) * *(const f32x4*)(G + o);
            uint2 w; w.x = pk2(res[0], res[1]); w.y = pk2(res[2], res[3]); *(uint2*)(OUT + o) = w;
        }
    }
}

__device__ void ph_final(const Params& p) {
    const int wid = tidx() >> 6, lane = tidx() & 63;
    const float* X = (const float*)(p.ws + OFF_X);
    for (int row = bidx() * 8 + wid; row < NLAT; row += gdim() * 8) {
        const float4* xr = (const float4*)(X + (size_t)row * D);
        float4 v[4]; float ss = 0;
#pragma unroll
        for (int i = 0; i < 4; ++i) { v[i] = xr[lane + i * 64]; ss += v[i].x * v[i].x + v[i].y * v[i].y + v[i].z * v[i].z + v[i].w * v[i].w; }
        ss = wave_sum(ss); const float rs = rsqrtf(ss * (1.f / D) + RMS_EPS);
#pragma unroll
        for (int i = 0; i < 4; ++i) { const int d = (lane + i * 64) * 4; const float4 gg = *(const float4*)(p.final_g + d);
            float4 o; o.x = v[i].x * rs * gg.x; o.y = v[i].y * rs * gg.y; o.z = v[i].z * rs * gg.z; o.w = v[i].w * rs * gg.w;
            *(float4*)(p.out + (size_t)row * D + d) = o; }
    }
}

enum { PH_INIT = 0, PH_A_NORM, PH_A_Z, PH_A_MID, PH_A_QKV, PH_A_POST, PH_A_ATTN, PH_A_WO,
       PH_R_NORM, PH_R_XS, PH_R_G1, PH_R_G2, PH_R_PREP, PH_R_SCAN, PH_R_OUT, PH_R_WO,
       PH_M_NORM, PH_M_SEL, PH_M_GATHER, PH_M_G1, PH_M_G2, PH_M_COMB, PH_FINAL, PH_M_CVT, PH_R_SC1, PH_R_SC2 };

template <int PH>
__device__ __forceinline__ void run_phase(const Params& p, int layer, char* lds) {
    const int j = layer >> 1;
    char* ws = p.ws;
    if constexpr (PH == PH_INIT) { ph_init(p, lds); __syncthreads(); ph_small_cvt(p, lds); }
    else if constexpr (PH == PH_A_NORM) ph_norm_mod<false>(p, layer, p.norm1_g + layer * D, 0, 1, ws + OFF_H);
    else if constexpr (PH == PH_A_Z) {
        float* Z = (float*)(ws + OFF_Z);
        g8::BatchSched S{ws + OFF_H, ws + OFF_WMLA + j * SZ_WMLA + WM_IN, 0, 0, NROW / 256, 2, 1, D};
        g8::gemm_phase(p.wv, (PG8_LAS unsigned char*)lds, D, S, g8::epi_rc([=](const g8::Unit&, int row, int col, f32x4 v) { *(f32x4*)(Z + (size_t)row * 512 + col) = v; }));
    }
    else if constexpr (PH == PH_A_MID) ph_mla_mid(p, j);
    else if constexpr (PH == PH_A_QKV) {
        bf16_t* Q = (bf16_t*)(ws + OFF_Q); bf16_t* K = (bf16_t*)(ws + OFF_K); bf16_t* V = (bf16_t*)(ws + OFF_V);
        g8::BatchSched S1{ws + OFF_CQN, ws + OFF_WMLA + j * SZ_WMLA + WM_UQ, 0, 0, NROW / 256, 6, 1, 256};
        g8::gemm_phase(p.wv, (PG8_LAS unsigned char*)lds, 256, S1, g8::epi_rc([=](const g8::Unit&, int row, int col, f32x4 v) {
            const bool lat = row < NLAT; const int b = lat ? (row >> 12) : ((row - NLAT) >> 8); const int tk = lat ? 256 + (row & (TL - 1)) : ((row - NLAT) & 255);
            const int h = col / 192, d = col - h * 192;
            uint2 w; w.x = pk2(v[0], v[1]); w.y = pk2(v[2], v[3]);
            *(uint2*)(Q + ((size_t)(b * 8 + h) * TK + tk) * 192 + d) = w; }));
        g8::BatchSched S2{ws + OFF_CKVN, ws + OFF_WMLA + j * SZ_WMLA + WM_UKV, 0, 0, NROW / 256, 8, 1, 256};
        g8::gemm_phase(p.wv, (PG8_LAS unsigned char*)lds, 256, S2, g8::epi_rc([=](const g8::Unit&, int row, int col, f32x4 v) {
            const bool lat = row < NLAT; const int b = lat ? (row >> 12) : ((row - NLAT) >> 8); const int tk = lat ? 256 + (row & (TL - 1)) : ((row - NLAT) & 255);
            const int h = col >> 8, d = col & 255; const size_t orow = (size_t)(b * 8 + h) * TK + tk;
            uint2 w; w.x = pk2(v[0], v[1]); w.y = pk2(v[2], v[3]);
            if (d < 128) *(uint2*)(K + orow * 192 + d) = w; else *(uint2*)(V + orow * 128 + (d - 128)) = w; }));
    }
    else if constexpr (PH == PH_A_ATTN) ph_attn(p, lds);
    else if constexpr (PH == PH_A_WO || PH == PH_R_WO) {
        float* X = (float*)(ws + OFF_X); const float* MOD = (const float*)(ws + OFF_MOD);
        g8::BatchSched S{ws + (PH == PH_A_WO ? OFF_O : OFF_H), PH == PH_A_WO ? ws + OFF_WMLA + j * SZ_WMLA + WM_O : ws + OFF_WRW + j * SZ_WRW + WR_O, 0, 0, (layer < 3 ? NROW : NLAT) / 256, 4, 1, D};
        g8::gemm_phase(p.wv, (PG8_LAS unsigned char*)lds, D, S, g8::epi_rc([=](const g8::Unit&, int row, int col, f32x4 v) {
            const f32x4 gt = *(const f32x4*)(MOD + ((size_t)layer * 5 + row_stream(row)) * 6144 + 2048 + col);
            f32x4* xp = (f32x4*)(X + (size_t)row * D + col); *xp = *xp + gt * v; }));
    }
    else if constexpr (PH == PH_R_XS) ph_rw_normxs(p, layer, j);
    else if constexpr (PH == PH_R_G1) {
        float* RKV = (float*)(ws + OFF_RKV); float* VF = (float*)(ws + OFF_VFIRST);
        bf16_t* A2 = (bf16_t*)(ws + OFF_A2); bf16_t* A3 = (bf16_t*)(ws + OFF_A3);
        const bool first = (j == 0);
        struct RSched { const char* XS; const char* WB; int nwg;
            __device__ __forceinline__ bool next(int i, g8::Unit& u) const {
                const int L = i * gdim() + bidx(); if (L >= nwg) return false;
                const int w = g8::xcd_remap(L, nwg);
                if (w < 816) { u.g = w / 272; const int r = w % 272; u.pm = r >> 2; u.pn = r & 3; u.B = WB + WR_RKV + (size_t)u.g * D * D * 2 + (size_t)u.pn * 256 * D * 2; }
                else { u.g = 3 + (w - 816) / 68; u.pm = (w - 816) % 68; u.pn = 0; u.B = WB + WR_L + (size_t)(u.g - 3) * 256 * D * 2; }
                u.A = XS + (size_t)(u.g == 6 ? 2 : u.g) * NROW * D * 2 + (size_t)u.pm * 256 * D * 2; return true; } };
        RSched S{ws + OFF_XS, ws + OFF_WRW + j * SZ_WRW, first ? 816 + 204 : 816 + 272};
        g8::gemm_phase(p.wv, (PG8_LAS unsigned char*)lds, D, S, g8::epi_rc([=](const g8::Unit& u, int row, int col, f32x4 v) {
            if (u.g < 3) { *(f32x4*)(RKV + ((size_t)u.g * NROW + row) * D + col) = v; if (first && u.g == 2) *(f32x4*)(VF + (size_t)row * D + col) = v; }
            else if (u.g == 3) { if (col < 128) { uint2 w; w.x = pk2(tanhf(v[0]), tanhf(v[1])); w.y = pk2(tanhf(v[2]), tanhf(v[3])); *(uint2*)(A2 + (size_t)row * 256 + col) = w; } }
            else if (u.g == 4) { if (col < 128) { uint2 w; w.x = pk2(v[0], v[1]); w.y = pk2(v[2], v[3]); *(uint2*)(A2 + (size_t)row * 256 + 128 + col) = w; } }
            else if (u.g == 5) { uint2 w; if (col < 128) { w.x = pk2(sigmoidf_(v[0]), sigmoidf_(v[1])); w.y = pk2(sigmoidf_(v[2]), sigmoidf_(v[3])); } else { w.x = 0u; w.y = 0u; }
                                 if (col < 128 || first || col >= 160) *(uint2*)(A3 + (size_t)row * 256 + col) = w; }
            else { if (col < 32) { uint2 w; w.x = pk2(v[0], v[1]); w.y = pk2(v[2], v[3]); *(uint2*)(A3 + (size_t)row * 256 + 128 + col) = w; } } }));
    }
    else if constexpr (PH == PH_R_G2) {
        const bool first = (j == 0);
        float* W = (float*)(ws + OFF_W); float* AV = (float*)(ws + OFF_AV); float* G = (float*)(ws + OFF_G); float* RKV = (float*)(ws + OFF_RKV); const float* VF = (const float*)(ws + OFF_VFIRST);
        const float* w0 = p.rw_w0 + (size_t)j * 2 * D; const float* a0 = p.rw_a0 + (size_t)j * 2 * D; const float* v0 = p.rw_v0;
        g8::BatchSched S1{ws + OFF_A2, ws + OFF_WRW + j * SZ_WRW + WR_B2, 0, 0, NROW / 256, 16, 1, 256};
        g8::gemm_phase(p.wv, (PG8_LAS unsigned char*)lds, 256, S1, g8::epi_rc([=](const g8::Unit& u, int row, int col, f32x4 v) {
            const int blk = u.pn >> 2, c = col & 1023; const bool dec = blk < 2;
            const float* bias = (dec ? w0 + blk * D : a0 + (blk - 2) * D) + c; float* dst = (dec ? W + (size_t)blk * NROW * D : AV + (size_t)(blk - 2) * NROW * D) + (size_t)row * D + c;
            const f32x4 x = v + *(const f32x4*)bias; f32x4 o;
#pragma unroll
            for (int e = 0; e < 4; ++e) { const float sg = __builtin_amdgcn_rcpf(1.f + __expf(-x[e])); o[e] = dec ? (-0.6065306597126334f * sg) : sg; }
            *(f32x4*)dst = o; }));
        g8::BatchSched S2{ws + OFF_A3, ws + OFF_WRW + j * SZ_WRW + WR_B3, 0, 0, NROW / 256, first ? 4 : 8, 1, 256};
        g8::gemm_phase(p.wv, (PG8_LAS unsigned char*)lds, 256, S2, g8::epi_rc([=](const g8::Unit&, int row, int col, f32x4 v) {
            if (col < 1024) *(f32x4*)(G + (size_t)row * D + col) = v;
            else { const int c = col - 1024; const size_t o = (size_t)row * D + c; const f32x4 vv = *(const f32x4*)(RKV + (size_t)2 * NROW * D + o), vf = *(const f32x4*)(VF + o), gz = v + *(const f32x4*)(v0 + c); f32x4 r;
#pragma unroll
                for (int e = 0; e < 4; ++e) r[e] = vv[e] + (vf[e] - vv[e]) * __builtin_amdgcn_rcpf(1.f + __expf(-gz[e]));
                *(f32x4*)(RKV + (size_t)2 * NROW * D + o) = r; } }));
    }
    else if constexpr (PH == PH_R_SCAN) ph_rw_scan(p, j, lds);
    else if constexpr (PH == PH_R_SC1) ph_rw_sc1(p, j, lds);
    else if constexpr (PH == PH_R_SC2) ph_rw_sc2(p, lds);
    else if constexpr (PH == PH_R_OUT) ph_rw_out(p, j, layer < 3 ? NROW : NLAT);
    else if constexpr (PH == PH_M_NORM) ph_norm2_router(p, layer, lds, layer < 3 ? NROW : NLAT);
    else if constexpr (PH == PH_M_SEL) ph_select(p, lds, layer < 3 ? 128 : 64);
    else if constexpr (PH == PH_M_GATHER) ph_gather(p, layer < 3 ? ESLOTS : NB * CAPL);
    else if constexpr (PH == PH_M_G1) {
        bf16_t* HID = (bf16_t*)(ws + OFF_HID);
        g8::BatchSched S{ws + OFF_XE, ws + OFF_W13T, (size_t)EPAD * D * 2, (size_t)2816 * D * 2, layer < 3 ? 9 : 8, 11, NE, D};
        g8::gemm_phase(p.wv, (PG8_LAS unsigned char*)lds, D, S, g8::epi_pair([=](const g8::Unit& u, int row, int col, f32x4 a, f32x4 b) {
            uint2 w; w.x = pk2(a[0] * __builtin_amdgcn_rcpf(1.f + __expf(-a[0])) * b[0], a[1] * __builtin_amdgcn_rcpf(1.f + __expf(-a[1])) * b[1]); w.y = pk2(a[2] * __builtin_amdgcn_rcpf(1.f + __expf(-a[2])) * b[2], a[3] * __builtin_amdgcn_rcpf(1.f + __expf(-a[3])) * b[3]);
            *(uint2*)(HID + ((size_t)u.g * EPAD + row) * FF + col) = w; }));
    }
    else if constexpr (PH == PH_M_G2) {
        bf16_t* YE = (bf16_t*)(ws + OFF_YE); const float* GATE = (const float*)(ws + OFF_GATE);
        g8::BatchSched S{ws + OFF_HID, ws + OFF_W2T, (size_t)EPAD * FF * 2, (size_t)D * FF * 2, layer < 3 ? 9 : 8, 4, NE, FF};
        g8::gemm_phase(p.wv, (PG8_LAS unsigned char*)lds, FF, S, g8::epi_rc([=](const g8::Unit& u, int row, int col, f32x4 v) {
            const float gt = GATE[u.g * EPAD + row];
            uint2 w; w.x = pk2(v[0] * gt, v[1] * gt); w.y = pk2(v[2] * gt, v[3] * gt);
            *(uint2*)(YE + ((size_t)u.g * EPAD + row) * D + col) = w; }));
    }
    else if constexpr (PH == PH_M_COMB) ph_combine(p, layer, layer < 3 ? NROW : NLAT);
    else if constexpr (PH == PH_M_CVT) ph_moe_cvt(p, layer, lds);
    else if constexpr (PH == PH_FINAL) ph_final(p);
}

#if ONE_LAUNCH
#define SYNC() xcd_barrier(bar)
#ifndef PROBE_PH
#define PROBE_PH -1
#endif
#ifndef PROBE_REP
#define PROBE_REP 1
#endif
__device__ __forceinline__ Params load_params() {
    Params q{};
#if defined(__HIP_DEVICE_COMPILE__)
    typedef const __attribute__((address_space(4))) unsigned long long* KargP;
    KargP kp_ = (KargP)__builtin_amdgcn_kernarg_segment_ptr(); asm volatile("" : "+s"(kp_));
#pragma unroll
    for (int i = 0; i < 40; ++i) ((const float**)&q)[i] = (const float*)(const __attribute__((address_space(1))) float*)kp_[i];
#endif
    return q;
}
#define RUN(PH) do { for (int rep_ = 0; rep_ < ((PH) == PROBE_PH ? PROBE_REP : 1); ++rep_) { Params q = load_params(); q.wv = wv0_; run_phase<PH>(q, layer, smem); SYNC(); } } while (0)
__global__ void __launch_bounds__(NTHR, 2) mega(Params p) {
    extern __shared__ __attribute__((aligned(16))) char smem[];
    const int wv0_ = __builtin_amdgcn_readfirstlane((int)threadIdx.x >> 6);
    if (threadIdx.x == 0) *(uint4*)(smem + LDS_BYTES) = make_uint4(0u, 0u, 0u, 0u);
    __syncthreads();
    XcdBarrier bar = xcd_barrier_post((unsigned*)(p.ws + OFF_BAR), (volatile LAS unsigned*)(smem + LDS_BYTES));
    { const int layer = 0; RUN(PH_INIT); }
    for (int layer = 0; layer < 4; ++layer) {
        if ((layer & 1) == 0) {
            RUN(PH_A_NORM);
            RUN(PH_A_Z);
            RUN(PH_A_MID);
            RUN(PH_A_QKV);
            RUN(PH_A_ATTN);
            RUN(PH_A_WO);
        } else {
            RUN(PH_R_XS);
            RUN(PH_R_G1);
            RUN(PH_R_G2);
            RUN(PH_R_SC1);
            RUN(PH_R_SC2);
            RUN(PH_R_OUT);
            RUN(PH_R_WO);
        }
        RUN(PH_M_CVT);
        RUN(PH_M_NORM);
        RUN(PH_M_SEL);
        RUN(PH_M_GATHER);
        RUN(PH_M_G1);
        RUN(PH_M_G2);
        RUN(PH_M_COMB);
    }
    { Params q = load_params(); q.wv = wv0_; run_phase<PH_FINAL>(q, 0, smem); }
}
#else
template <int PH> __global__ void __launch_bounds__(NTHR, 2) kph(Params p, int layer) {
    extern __shared__ __attribute__((aligned(16))) char smem[];
    Params q = p; q.wv = __builtin_amdgcn_readfirstlane((int)threadIdx.x >> 6);
    run_phase<PH>(q, layer, smem);
}
#endif

extern "C" void kernel_launch(void* const* d_in, const int* in_sizes, int n_in, void* d_out, int out_size, void* d_ws, size_t ws_size, hipStream_t stream) {
    if (n_in != 38 || ws_size < WS_NEED) { fprintf(stderr, "kernel_launch: bad args n_in %d ws %zu need %zu\n", n_in, ws_size, (size_t)WS_NEED); return; }
    Params p{};
    const float** pp = (const float**)&p;
    for (int i = 0; i < 38; ++i) pp[i] = (const float*)d_in[i];
    p.out = (float*)d_out; p.ws = (char*)d_ws;
    static int cus = 0;
    if (!cus) { int dev = 0; hipGetDevice(&dev); hipDeviceGetAttribute(&cus, hipDeviceAttributeMultiprocessorCount, dev); if (cus <= 0) cus = 256; }
    const int grid = cus;
#if ONE_LAUNCH
    hipFuncSetAttribute((const void*)mega, hipFuncAttributeMaxDynamicSharedMemorySize, LDS_BYTES + 16);
    hipMemsetAsync(d_ws, 0, XCD_BAR_WORDS * sizeof(unsigned), stream);
    hipLaunchKernelGGL(mega, dim3(grid), dim3(NTHR), LDS_BYTES + 16, stream, p);
#else
#define LAUNCH(PH, L) do { hipFuncSetAttribute((const void*)kph<PH>, hipFuncAttributeMaxDynamicSharedMemorySize, LDS_BYTES + 16); hipLaunchKernelGGL(kph<PH>, dim3(grid), dim3(NTHR), LDS_BYTES + 16, stream, p, L); } while (0)
    LAUNCH(PH_INIT, 0);
    for (int layer = 0; layer < 4; ++layer) {
        if ((layer & 1) == 0) { LAUNCH(PH_A_NORM, layer); LAUNCH(PH_A_Z, layer); LAUNCH(PH_A_MID, layer); LAUNCH(PH_A_QKV, layer); LAUNCH(PH_A_ATTN, layer); LAUNCH(PH_A_WO, layer); }
        else { LAUNCH(PH_R_XS, layer); LAUNCH(PH_R_G1, layer); LAUNCH(PH_R_G2, layer); LAUNCH(PH_R_SC1, layer); LAUNCH(PH_R_SC2, layer); LAUNCH(PH_R_OUT, layer); LAUNCH(PH_R_WO, layer); }
        LAUNCH(PH_M_CVT, layer); LAUNCH(PH_M_NORM, layer); LAUNCH(PH_M_SEL, layer); LAUNCH(PH_M_GATHER, layer); LAUNCH(PH_M_G1, layer); LAUNCH(PH_M_G2, layer); LAUNCH(PH_M_COMB, layer);
    }
    LAUNCH(PH_FINAL, 0);
#endif
}
```

```cpp
#include <hip/hip_runtime.h>
#include <stdint.h>
#include <stdio.h>

#ifndef ONE_LAUNCH
#define ONE_LAUNCH 1
#endif

#define NTHR 512
typedef unsigned short bf16_t;
typedef short bf16x8 __attribute__((ext_vector_type(8)));
typedef float f32x4 __attribute__((ext_vector_type(4)));
typedef unsigned u32x4 __attribute__((ext_vector_type(4)));
typedef unsigned u32x2 __attribute__((ext_vector_type(2)));

constexpr int D = 1024, NB = 4, TL = 4096, TC = 256, NLAT = NB * TL, NCTX = NB * TC, NROW = NLAT + NCTX;
constexpr int TK = TL + TC;
constexpr int NE = 16, FF = 1408, CAPL = 512, CAPC = 32, ESLOTS = NB * CAPL + NB * CAPC;
constexpr int EPAD = 2304;
constexpr float RMS_EPS = 1e-6f, LNX_EPS = 64e-5f;
constexpr float ATT_SCALE = 0.07216878364870322f;

constexpr size_t al256(size_t x) { return (x + 255) / 256 * 256; }
constexpr size_t OFF_BAR = 0;
constexpr size_t OFF_QUEUE = 14336;
constexpr size_t OFF_MOD = 16384;
constexpr size_t OFF_ROPE_C = OFF_MOD + al256(4 * 5 * 6144 * 4);
constexpr size_t OFF_ROPE_S = OFF_ROPE_C + al256(TL * 32 * 4);
constexpr size_t OFF_X = OFF_ROPE_S + al256(TL * 32 * 4);
constexpr size_t SZ_F32 = (size_t)NROW * D * 4, SZ_BF = (size_t)NROW * D * 2;
constexpr size_t OFF_VFIRST = OFF_X + SZ_F32;
constexpr size_t OFF_H = OFF_VFIRST + SZ_F32;
constexpr size_t SZ_WMLA = (size_t)(512 * 1024 + 1536 * 256 + 2048 * 256 + 1024 * 1024) * 2;
constexpr size_t WM_IN = 0, WM_UQ = (size_t)512 * 1024 * 2, WM_UKV = WM_UQ + (size_t)1536 * 256 * 2, WM_O = WM_UKV + (size_t)2048 * 256 * 2;
constexpr size_t SZ_WRW = (size_t)(3 * 1024 * 1024 + 4 * 256 * 1024 + 1024 * 1024 + 4096 * 256 + 2048 * 256) * 2;
constexpr size_t WR_RKV = 0, WR_L = (size_t)3 * 1024 * 1024 * 2, WR_O = WR_L + (size_t)4 * 256 * 1024 * 2, WR_B2 = WR_O + (size_t)1024 * 1024 * 2, WR_B3 = WR_B2 + (size_t)4096 * 256 * 2;
constexpr size_t OFF_WMLA = OFF_H + SZ_BF;
constexpr size_t OFF_WRW = OFF_WMLA + 2 * SZ_WMLA;
constexpr size_t OFF_W13T = OFF_WRW + 2 * SZ_WRW;
constexpr size_t OFF_W2T = OFF_W13T + (size_t)NE * 2816 * D * 2;
constexpr size_t OFF_S = OFF_W2T + (size_t)NE * D * FF * 2;
constexpr size_t OFF_Z = OFF_S;
constexpr size_t OFF_CQN = OFF_Z + al256((size_t)NROW * 512 * 4);
constexpr size_t OFF_CKVN = OFF_CQN + al256((size_t)NROW * 256 * 2);
constexpr size_t OFF_KR = OFF_CKVN + al256((size_t)NROW * 256 * 2);
constexpr size_t OFF_QRAW = OFF_KR + al256((size_t)NROW * 64 * 4);
constexpr size_t OFF_KVRAW = OFF_QRAW + al256((size_t)NROW * 1536 * 4);
constexpr size_t OFF_Q = OFF_KVRAW + al256((size_t)NROW * 2048 * 4);
constexpr size_t OFF_K = OFF_Q + al256((size_t)NB * 8 * TK * 192 * 2);
constexpr size_t OFF_V = OFF_K + al256((size_t)NB * 8 * TK * 192 * 2);
constexpr size_t OFF_O = OFF_V + al256((size_t)NB * 8 * TK * 128 * 2);
constexpr size_t END_MLA = OFF_O + SZ_BF;
constexpr size_t OFF_XS = OFF_S;
constexpr size_t OFF_RKV = OFF_XS + 6 * SZ_BF;
constexpr size_t OFF_W = OFF_RKV + 3 * SZ_F32;
constexpr size_t OFF_AV = OFF_W + 2 * SZ_F32;
constexpr size_t OFF_G = OFF_AV + 2 * SZ_F32;
constexpr size_t OFF_A2 = OFF_G + SZ_F32;
constexpr size_t OFF_A3 = OFF_A2 + al256((size_t)NROW * 256 * 2);
constexpr size_t END_RW = OFF_A3 + al256((size_t)NROW * 256 * 2);
constexpr size_t OFF_Y = OFF_XS;
constexpr int NCHK = (TC + TL) / 64;
constexpr size_t OFF_CK = END_RW;
constexpr size_t END_RW2 = OFF_CK + (size_t)128 * NCHK * 4 * 4096 * 2;
constexpr size_t OFF_AFF = OFF_S;
constexpr size_t OFF_ROWIDX = OFF_AFF + al256((size_t)NROW * 16 * 4);
constexpr size_t OFF_GATE = OFF_ROWIDX + al256((size_t)NE * ESLOTS * 4);
constexpr size_t OFF_SLOT = OFF_GATE + al256((size_t)NE * EPAD * 4);
constexpr size_t OFF_XE = OFF_SLOT + al256((size_t)NROW * 16 * 4);
constexpr size_t OFF_HID = OFF_XE + al256((size_t)NE * EPAD * D * 2);
constexpr size_t OFF_YE = OFF_HID + al256((size_t)NE * EPAD * FF * 2);
constexpr size_t END_MOE = OFF_YE + al256((size_t)NE * EPAD * D * 2);
constexpr size_t WS_NEED = END_RW2 > END_MLA ? (END_RW2 > END_MOE ? END_RW2 : END_MOE) : (END_MLA > END_MOE ? END_MLA : END_MOE);

constexpr int LDS_BYTES = 152064;

struct Params {
    const float *x, *c, *ctx, *c_ctx, *mod_w, *mod_b, *norm1_g, *norm2_g, *final_g;
    const float *mla_w_in, *mla_g_q, *mla_g_kv, *mla_w_uq, *mla_w_ukv, *mla_w_o;
    const float *rw_mu, *rw_w_rkv, *rw_w0, *rw_w1, *rw_w2, *rw_a0, *rw_a1, *rw_a2, *rw_v0, *rw_v1, *rw_v2, *rw_g1, *rw_g2, *rw_k_k, *rw_k_a, *rw_r_k, *rw_lnx_g, *rw_lnx_b, *rw_w_o;
    const float *moe_router, *moe_w1, *moe_w3, *moe_w2;
    float* out; char* ws;
    int wv, pad_;
};

__device__ __forceinline__ int bidx() { int t = blockIdx.x; asm volatile("" : "+s"(t)); return t; }
__device__ __forceinline__ int gdim() { int t = gridDim.x; asm volatile("" : "+s"(t)); return t; }
__device__ __forceinline__ int tidx_w(int wv) { int l; asm volatile("v_mbcnt_lo_u32_b32 %0, -1, 0\n\tv_mbcnt_hi_u32_b32 %0, -1, %0" : "=v"(l)); return (wv << 6) | l; }
#define tidx() tidx_w(p.wv)
#define XB_TMO      128
#define XB_XCNT(j)  (256  + 64 * (j))
#define XB_XSUB(j)  (1280 + 64 * (j))
#define XB_XGEN(j)  (2304 + 64 * (j))
#define XB_TOP      3328
#define XB_TOPGEN   3392
#define XCD_BAR_WORDS 3456
#define XB_SPIN_CAP (1u << 22)
#define LAS __attribute__((address_space(3)))

__device__ __forceinline__ unsigned xb_ld(unsigned* p)              { return __hip_atomic_load(p, __ATOMIC_RELAXED, __HIP_MEMORY_SCOPE_AGENT); }
__device__ __forceinline__ unsigned xb_add(unsigned* p, unsigned v) { return __hip_atomic_fetch_add(p, v, __ATOMIC_RELAXED, __HIP_MEMORY_SCOPE_AGENT); }
__device__ __forceinline__ unsigned xb_xcc_id() { return (unsigned)__builtin_amdgcn_s_getreg((3 << 11) | 20) & 0xFu; }
#define XB_SPIN(cond, bar) do { unsigned _sp = 0; while (cond) { __builtin_amdgcn_s_sleep(1); \
    if ((++_sp & 255u) == 0u) { if (xb_ld(&(bar)[XB_TMO])) break; if (_sp > XB_SPIN_CAP) { atomicAdd(&(bar)[XB_TMO], 1u); break; } } } } while (0)

struct XcdBarrier { unsigned* bar; unsigned x; volatile LAS unsigned* st; };

__device__ __forceinline__ XcdBarrier xcd_barrier_post(unsigned* bar, volatile LAS unsigned* st) {
    XcdBarrier b; b.bar = bar; b.x = xb_xcc_id(); b.st = st;
    if (threadIdx.x == 0) (void)xb_add(&bar[XB_XCNT(b.x)], 1u);
    return b;
}
__device__ __forceinline__ void xcd_barrier_complete(unsigned* bar, unsigned x, unsigned& nloc, unsigned& nx) {
    const unsigned G = gridDim.x * gridDim.y * gridDim.z;
    unsigned sum, cnt, mine, sp = 0u;
    for (;;) {
        sum = 0u; cnt = 0u; mine = 0u;
#pragma unroll
        for (unsigned j = 0; j < 16; ++j) { const unsigned c = xb_ld(&bar[XB_XCNT(j)]); sum += c; cnt += (c > 0u) ? 1u : 0u; mine = (j == x) ? c : mine; }
        if (sum == G) break;
        __builtin_amdgcn_s_sleep(1);
        if ((++sp & 255u) == 0u) { if (xb_ld(&bar[XB_TMO])) break; if (sp > XB_SPIN_CAP) { atomicAdd(&bar[XB_TMO], 1u); break; } }
    }
    nloc = mine > 0u ? mine : 1u; nx = cnt > 0u ? cnt : 1u;
}
__device__ __forceinline__ void xcd_barrier(const XcdBarrier& b) {
    asm volatile("s_waitcnt vmcnt(0)" ::: "memory");
    __syncthreads();
    if (threadIdx.x == 0) {
        unsigned* bar = b.bar;
        __builtin_amdgcn_s_waitcnt(0);
        unsigned nloc = b.st[0], nx = b.st[1];
        if (nloc == 0u) { xcd_barrier_complete(bar, b.x, nloc, nx); b.st[0] = nloc; b.st[1] = nx; }
        const unsigned old = xb_add(&bar[XB_XSUB(b.x)], 1u);
        const unsigned gen = old / nloc;
        if (old + 1u == (gen + 1u) * nloc) {
            __builtin_amdgcn_fence(__ATOMIC_RELEASE, "agent");
            asm volatile("s_waitcnt vmcnt(0)" ::: "memory");
            const unsigned og = xb_add(&bar[XB_TOP], 1u);
            const unsigned tg = og / nx;
            if (og + 1u == (tg + 1u) * nx) xb_add(&bar[XB_TOPGEN], 1u);
            else XB_SPIN(xb_ld(&bar[XB_TOPGEN]) == tg, bar);
            __builtin_amdgcn_fence(__ATOMIC_ACQUIRE, "agent");
            xb_add(&bar[XB_XGEN(b.x)], 1u);
            asm volatile("s_waitcnt vmcnt(0)" ::: "memory");
        } else {
            XB_SPIN(xb_ld(&bar[XB_XGEN(b.x)]) == gen, bar);
            __builtin_amdgcn_fence(__ATOMIC_ACQUIRE, "agent");
            asm volatile("s_waitcnt vmcnt(0)" ::: "memory");
        }
    }
    __syncthreads();
}

__device__ __forceinline__ float bf2f(bf16_t b) { return __uint_as_float(((unsigned)b) << 16); }
typedef float f32x2_ __attribute__((ext_vector_type(2)));
typedef __bf16 bf16x2_ __attribute__((ext_vector_type(2)));
__device__ __forceinline__ unsigned pk2(float lo, float hi) { const f32x2_ v = {lo, hi}; return __builtin_bit_cast(unsigned, __builtin_convertvector(v, bf16x2_)); }
__device__ __forceinline__ bf16_t f2bf(float f) { return (bf16_t)(pk2(f, f) & 0xffffu); }
__device__ __forceinline__ float dpp_sum16(float x) {
    x += __builtin_bit_cast(float, __builtin_amdgcn_update_dpp(0, __builtin_bit_cast(int, x), 0xB1, 0xF, 0xF, true));
    x += __builtin_bit_cast(float, __builtin_amdgcn_update_dpp(0, __builtin_bit_cast(int, x), 0x4E, 0xF, 0xF, true));
    x += __builtin_bit_cast(float, __builtin_amdgcn_update_dpp(0, __builtin_bit_cast(int, x), 0x141, 0xF, 0xF, true));
    x += __builtin_bit_cast(float, __builtin_amdgcn_update_dpp(0, __builtin_bit_cast(int, x), 0x140, 0xF, 0xF, true));
    return x;
}
__device__ __forceinline__ f32x4 ldbf4(const bf16_t* p) { const uint2 w = *(const uint2*)p; return (f32x4){__uint_as_float(w.x << 16), __uint_as_float(w.x & 0xffff0000u), __uint_as_float(w.y << 16), __uint_as_float(w.y & 0xffff0000u)}; }
__device__ __forceinline__ void stbf4(bf16_t* p, f32x4 v) { uint2 w; w.x = pk2(v[0], v[1]); w.y = pk2(v[2], v[3]); *(uint2*)p = w; }
__device__ __forceinline__ float wave_sum(float v) {
    v = dpp_sum16(v); const int i = __builtin_bit_cast(int, v);
    return __builtin_bit_cast(float, __builtin_amdgcn_readlane(i, 0)) + __builtin_bit_cast(float, __builtin_amdgcn_readlane(i, 16)) + __builtin_bit_cast(float, __builtin_amdgcn_readlane(i, 32)) + __builtin_bit_cast(float, __builtin_amdgcn_readlane(i, 48));
}
__device__ __forceinline__ float sigmoidf_(float x) { return __builtin_amdgcn_rcpf(1.f + __expf(-x)); }
__device__ __forceinline__ int row_stream(int row) { return row < NLAT ? (row >> 12) : 4; }
__device__ __forceinline__ const float* modp(const Params& p, int layer, int s, int part) { return (const float*)(p.ws + OFF_MOD) + ((size_t)layer * 5 + s) * 6144 + part * 1024; }

struct SgArgs { const bf16_t* A; int lda; size_t strideA; const float* B; int ldb; size_t strideB; int M, N, K, nbatch; };
template <class Epi>
__device__ __forceinline__ void sg_gemm(const Params& p, char* lds, const SgArgs g, const Epi& epi) {
    bf16_t* As = (bf16_t*)lds;
    bf16_t* Bs = As + 128 * 40;
    const int tid = tidx(), wid = tid >> 6, lane = tid & 63;
    const int wr = wid >> 2, wc = wid & 3;
    const int tilesN = (g.N + 127) / 128, tilesM = g.M / 128, per = tilesM * tilesN, ntiles = per * g.nbatch;
    const int ar = tid >> 2, ak = (tid & 3) * 8;
    const int bn = tid & 127, bk = (tid >> 7) * 8;
    for (int tile = bidx(); tile < ntiles; tile += gdim()) {
        const int bt = tile / per, tt = tile % per;
        const int tm = tt / tilesN, tn = tt % tilesN;
        const int m0 = tm * 128, n0 = tn * 128;
        f32x4 acc[4][2];
#pragma unroll
        for (int m = 0; m < 4; ++m)
#pragma unroll
            for (int n = 0; n < 2; ++n) acc[m][n] = (f32x4){0.f, 0.f, 0.f, 0.f};
        const bool bvalid = (n0 + bn) < g.N;
        const bf16_t* ap = g.A + bt * g.strideA + (size_t)(m0 + ar) * g.lda + ak;
        const float* bp = g.B + bt * g.strideB + (size_t)bk * g.ldb + n0 + bn;
        bf16x8 areg; float breg[8];
        areg = *(const bf16x8*)ap;
#pragma unroll
        for (int j = 0; j < 8; ++j) breg[j] = bvalid ? bp[(size_t)j * g.ldb] : 0.f;
        for (int k0 = 0; k0 < g.K; k0 += 32) {
            __syncthreads();
            *(bf16x8*)(As + ar * 40 + ak) = areg;
            { u32x4 w; w.x = pk2(breg[0], breg[1]); w.y = pk2(breg[2], breg[3]); w.z = pk2(breg[4], breg[5]); w.w = pk2(breg[6], breg[7]); *(u32x4*)(Bs + bn * 40 + bk) = w; }
            __syncthreads();
            if (k0 + 32 < g.K) {
                areg = *(const bf16x8*)(ap + k0 + 32);
#pragma unroll
                for (int j = 0; j < 8; ++j) breg[j] = bvalid ? bp[(size_t)(k0 + 32 + j) * g.ldb] : 0.f;
            }
            bf16x8 af[4], bfr[2];
#pragma unroll
            for (int m = 0; m < 4; ++m) af[m] = *(const bf16x8*)(As + (wr * 64 + m * 16 + (lane & 15)) * 40 + (lane >> 4) * 8);
#pragma unroll
            for (int n = 0; n < 2; ++n) bfr[n] = *(const bf16x8*)(Bs + (wc * 32 + n * 16 + (lane & 15)) * 40 + (lane >> 4) * 8);
#pragma unroll
            for (int m = 0; m < 4; ++m)
#pragma unroll
                for (int n = 0; n < 2; ++n) acc[m][n] = __builtin_amdgcn_mfma_f32_16x16x32_bf16(af[m], bfr[n], acc[m][n], 0, 0, 0);
        }
#pragma unroll
        for (int m = 0; m < 4; ++m)
#pragma unroll
            for (int n = 0; n < 2; ++n) {
                const int col = n0 + wc * 32 + n * 16 + (lane & 15);
                if (col < g.N) {
#pragma unroll
                    for (int r = 0; r < 4; ++r) epi(bt, m0 + wr * 64 + m * 16 + (lane >> 4) * 4 + r, col, acc[m][n][r]);
                }
            }
    }
}


namespace g8 {
#define PG8_LAS __attribute__((address_space(3)))
constexpr int BM = 256, BK = 64, HALF = 128, HTB = HALF * BK * 2, STAGE_BYTES = 8 * HTB;
__device__ __forceinline__ int lds_byte(int r, int c) { const int st = (r >> 4) * 2 + (c >> 5), rr = r & 15, cc = c & 31, ob = rr * 64 + cc * 2; return st * 1024 + (ob ^ (((ob >> 9) & 1) << 5)); }
__device__ __forceinline__ void stage_rc(int b, int& R, int& C) { const int st = b / 1024, sb = b % 1024, swz = sb ^ (((sb >> 9) & 1) << 5); R = (st >> 1) * 16 + swz / 64; C = (st & 1) * 32 + (swz % 64) / 2; }
struct Unit { int pm, pn, g; const char* A; const char* B; };
__device__ __forceinline__ int xcd_remap(int L, int nwg) { const int q = nwg / 8, r = nwg % 8, xcd = L % 8, off = L / 8; return (xcd < r ? xcd * (q + 1) : r * (q + 1) + (xcd - r) * q) + off; }

template <class Epi, class Sched>
__device__ __forceinline__ void gemm_phase(const int wv_, PG8_LAS unsigned char* lds, const int K, const Sched& S, const Epi& E) {
    const int tid = tidx_w(wv_), wid = __builtin_amdgcn_readfirstlane(tid >> 6), lane = tid & 63, wr = wid >> 2, wc = wid & 3, fr = lane & 15, fq = lane >> 4;
    const int nt = K / BK;
    unsigned voffA[2];
#pragma unroll
    for (int i = 0; i < 2; ++i) { int R, C; stage_rc(tid * 16 + i * 8192, R, C); voffA[i] = (unsigned)(R * K + C) * 2u; }
    const size_t kstep = (size_t)(BK * 2);
    const size_t hstep = (size_t)HALF * K * 2;
    const unsigned ldsw = (unsigned)wid * 1024u;
    const int aoff = lds_byte(wr * 64 + fr, fq * 8), boff = lds_byte(wc * 32 + fr, fq * 8);
#define PG8_SA(b, h) (((b) * 2 + (h)) * HTB)
#define PG8_SB(b, h) ((4 + (b) * 2 + (h)) * HTB)
#define PG8_STAGE(bufoff, gbase, voff) do { _Pragma("unroll") for (int _i = 0; _i < 2; ++_i) \
        __builtin_amdgcn_global_load_lds((const unsigned*)((const char*)(gbase) + (voff)[_i]), (PG8_LAS unsigned*)(lds + (bufoff) + ldsw + _i * 8192), 16, 0, 0); } while (0)
#define PG8_LDA(dst, b, h) do { _Pragma("unroll") for (int m = 0; m < 4; ++m) _Pragma("unroll") for (int k = 0; k < 2; ++k) dst[m][k] = *(const PG8_LAS bf16x8*)(lds + PG8_SA(b, h) + aoff + m * 2048 + k * 1024); } while (0)
#define PG8_LDB(dst, b, h) do { _Pragma("unroll") for (int n = 0; n < 2; ++n) _Pragma("unroll") for (int k = 0; k < 2; ++k) dst[n][k] = *(const PG8_LAS bf16x8*)(lds + PG8_SB(b, h) + boff + n * 2048 + k * 1024); } while (0)
#define PG8_MMA(ai, bj, At, Bt) do { __builtin_amdgcn_s_setprio(1); _Pragma("unroll") for (int m = 0; m < 4; ++m) _Pragma("unroll") for (int n = 0; n < 2; ++n) _Pragma("unroll") for (int k = 0; k < 2; ++k) \
        acc[ai][bj][m][n] = __builtin_amdgcn_mfma_f32_16x16x32_bf16(Bt[n][k], At[m][k], acc[ai][bj][m][n], 0, 0, 0); __builtin_amdgcn_s_setprio(0); } while (0)
#define PG8_WAIT_V(n) asm volatile("s_waitcnt vmcnt(" #n ")" ::: "memory")
#define PG8_WAIT_L(n) asm volatile("s_waitcnt lgkmcnt(" #n ")" ::: "memory")
#define PG8_BAR __builtin_amdgcn_s_barrier()
#define PG8_SCHED __builtin_amdgcn_sched_barrier(0)
    Unit cur, nxt; int ui = 0;
    if (!S.next(0, cur)) return;
    f32x4 acc[2][2][4][2];
#pragma unroll
    for (int a = 0; a < 2; ++a)
#pragma unroll
        for (int b = 0; b < 2; ++b)
#pragma unroll
            for (int m = 0; m < 4; ++m)
#pragma unroll
                for (int n = 0; n < 2; ++n) acc[a][b][m][n] = (f32x4){0.f, 0.f, 0.f, 0.f};
    bf16x8 At[4][2], B0[2][2], B1[2][2];
    const char* cA = cur.A; const char* cB = cur.B;
    PG8_STAGE(PG8_SB(0, 0), cB, voffA); PG8_STAGE(PG8_SA(0, 0), cA, voffA); PG8_STAGE(PG8_SB(0, 1), cB + hstep, voffA); PG8_STAGE(PG8_SA(0, 1), cA + hstep, voffA);
    if (wr == 1) PG8_BAR;
    PG8_WAIT_V(4); PG8_BAR;
    PG8_STAGE(PG8_SB(1, 0), cB + kstep, voffA); PG8_STAGE(PG8_SA(1, 0), cA + kstep, voffA); PG8_STAGE(PG8_SB(1, 1), cB + hstep + kstep, voffA);
    PG8_WAIT_V(6); PG8_BAR;
    for (;;) {
        const bool has_next = S.next(ui + 1, nxt);
        const char* nA = has_next ? nxt.A : cA; const char* nB = has_next ? nxt.B : cB;
        for (int t = 0; t < nt; t += 2) {
            const bool last = (t == nt - 2);
            const char* a1 = cA + (size_t)(t + 1) * kstep;
            const char* a2 = last ? nA : cA + (size_t)(t + 2) * kstep; const char* b2 = last ? nB : cB + (size_t)(t + 2) * kstep;
            const char* a3 = a2 + kstep; const char* b3 = b2 + kstep;
            PG8_LDB(B0, 0, 0); PG8_SCHED; PG8_LDA(At, 0, 0); PG8_STAGE(PG8_SA(1, 1), a1 + hstep, voffA);
            PG8_WAIT_L(8); PG8_BAR; PG8_WAIT_L(0); PG8_MMA(0, 0, At, B0); PG8_BAR; PG8_SCHED;
            PG8_LDB(B1, 0, 1); PG8_STAGE(PG8_SB(0, 0), b2, voffA);
            PG8_BAR; PG8_WAIT_L(0); PG8_MMA(0, 1, At, B1); PG8_BAR;
            PG8_LDA(At, 0, 1); PG8_STAGE(PG8_SA(0, 0), a2, voffA);
            PG8_BAR; PG8_WAIT_L(0); PG8_MMA(1, 0, At, B0); PG8_BAR; PG8_SCHED;
            PG8_STAGE(PG8_SB(0, 1), b2 + hstep, voffA);
            PG8_WAIT_V(6); PG8_BAR; PG8_MMA(1, 1, At, B1); PG8_BAR;
            PG8_LDB(B0, 1, 0); PG8_SCHED; PG8_LDA(At, 1, 0); PG8_STAGE(PG8_SA(0, 1), a2 + hstep, voffA);
            PG8_WAIT_L(8); PG8_BAR; PG8_WAIT_L(0); PG8_MMA(0, 0, At, B0); PG8_BAR; PG8_SCHED;
            PG8_LDB(B1, 1, 1); PG8_STAGE(PG8_SB(1, 0), b3, voffA);
            PG8_BAR; PG8_WAIT_L(0); PG8_MMA(0, 1, At, B1); PG8_BAR;
            PG8_LDA(At, 1, 1); PG8_STAGE(PG8_SA(1, 0), a3, voffA);
            PG8_BAR; PG8_WAIT_L(0); PG8_MMA(1, 0, At, B0); PG8_BAR; PG8_SCHED;
            PG8_STAGE(PG8_SB(1, 1), b3 + hstep, voffA);
            PG8_WAIT_V(6); PG8_BAR; PG8_MMA(1, 1, At, B1); PG8_BAR;
        }
        E(acc, cur, wr, wc, fr, fq);
        if (!has_next) break;
#pragma unroll
        for (int a = 0; a < 2; ++a)
#pragma unroll
            for (int b = 0; b < 2; ++b)
#pragma unroll
                for (int m = 0; m < 4; ++m)
#pragma unroll
                    for (int n = 0; n < 2; ++n) acc[a][b][m][n] = (f32x4){0.f, 0.f, 0.f, 0.f};
        cur = nxt; cA = nA; cB = nB; ++ui;
    }
    PG8_WAIT_V(0);
    if (wr == 0) PG8_BAR;
    PG8_BAR;
#undef PG8_SA
#undef PG8_SB
#undef PG8_STAGE
#undef PG8_LDA
#undef PG8_LDB
#undef PG8_MMA
#undef PG8_WAIT_V
#undef PG8_WAIT_L
#undef PG8_BAR
#undef PG8_SCHED
}
template <class F> struct EpiRC { F f;
    __device__ __forceinline__ void operator()(const f32x4 (&acc)[2][2][4][2], const Unit& u, int wr, int wc, int fr, int fq) const {
#pragma unroll
        for (int ai = 0; ai < 2; ++ai)
#pragma unroll
            for (int m = 0; m < 4; ++m) { const int row = u.pm * BM + ai * HALF + wr * 64 + m * 16 + fr;
#pragma unroll
                for (int bj = 0; bj < 2; ++bj)
#pragma unroll
                    for (int n = 0; n < 2; ++n) f(u, row, u.pn * BM + bj * HALF + wc * 32 + n * 16 + 4 * fq, acc[ai][bj][m][n]);
                asm volatile("" ::: "memory"); }
    } };
template <class F> __device__ __forceinline__ EpiRC<F> epi_rc(const F& f) { return EpiRC<F>{f}; }
template <class F> struct EpiPair { F f;
    __device__ __forceinline__ void operator()(const f32x4 (&acc)[2][2][4][2], const Unit& u, int wr, int wc, int fr, int fq) const {
#pragma unroll
        for (int ai = 0; ai < 2; ++ai)
#pragma unroll
            for (int m = 0; m < 4; ++m) { const int row = u.pm * BM + ai * HALF + wr * 64 + m * 16 + fr;
#pragma unroll
                for (int n = 0; n < 2; ++n) f(u, row, u.pn * HALF + wc * 32 + n * 16 + 4 * fq, acc[ai][0][m][n], acc[ai][1][m][n]);
                asm volatile("" ::: "memory"); }
    } };
template <class F> __device__ __forceinline__ EpiPair<F> epi_pair(const F& f) { return EpiPair<F>{f}; }
struct BatchSched { const char* A; const char* B; size_t strideA, strideB; int nM, nN, nb, K;
    __device__ __forceinline__ bool next(int i, Unit& u) const {
        const int nwg = nM * nN * nb; const int L = i * gdim() + bidx(); if (L >= nwg) return false;
        const int w = xcd_remap(L, nwg); const int per = nM * nN; u.g = w / per; const int r = w % per; u.pm = r / nN; u.pn = r % nN;
        u.A = A + u.g * strideA + (size_t)u.pm * BM * K * 2; u.B = B + u.g * strideB + (size_t)u.pn * BM * K * 2; return true; } };
}

template <class SrcF, class DRow>
__device__ __forceinline__ void cvt_tiles(const int wv_, char* lds, bf16_t* dst, int Kd, int Nd, int nbatch, size_t dstride, const SrcF& src, const DRow& drow, unsigned* queue = nullptr) {
    bf16_t* T = (bf16_t*)lds;
    int* qslot = (int*)(lds + 64 * 136 * 2);
    const int tid = tidx_w(wv_);
    const int tk = Kd / 128, tn = Nd / 64, per = tk * tn, total = per * nbatch;
    constexpr int QG = 8;
    int t = queue ? 0 : bidx(), tnext = 0, sub = 0;
    if (queue) { if (tid == 0) { qslot[0] = QG * (int)__hip_atomic_fetch_add(queue, 1u, __ATOMIC_RELAXED, __HIP_MEMORY_SCOPE_AGENT); } __syncthreads(); t = qslot[0]; __syncthreads(); }
    while (t < total) {
        if (queue && sub == 0 && tid == 0) tnext = QG * (int)__hip_atomic_fetch_add(queue, 1u, __ATOMIC_RELAXED, __HIP_MEMORY_SCOPE_AGENT);
        const int bt = t / per, r = t % per, k0 = (r % tk) * 128, n0 = (r / tk) * 64;
        float4 v[4];
#pragma unroll
        for (int i = 0; i < 4; ++i) { const int k = k0 + i * 32 + (tid >> 4), n = n0 + (tid & 15) * 4; const float* sp = src(bt, k, n); v[i] = sp ? *(const float4*)sp : make_float4(0.f, 0.f, 0.f, 0.f); }
        __syncthreads();
#pragma unroll
        for (int i = 0; i < 4; ++i) { const int k = i * 32 + (tid >> 4), n = (tid & 15) * 4;
            T[(n + 0) * 136 + k] = f2bf(v[i].x); T[(n + 1) * 136 + k] = f2bf(v[i].y); T[(n + 2) * 136 + k] = f2bf(v[i].z); T[(n + 3) * 136 + k] = f2bf(v[i].w); }
        if (queue && sub == QG - 1 && tid == 0) qslot[0] = tnext;
        __syncthreads();
        { const int n = tid >> 3, kc = (tid & 7) * 16;
          const u32x4 a = *(const u32x4*)(T + n * 136 + kc), b = *(const u32x4*)(T + n * 136 + kc + 8);
          bf16_t* dp = dst + bt * dstride + (size_t)drow(n0 + n) * Kd + k0 + kc;
          *(u32x4*)dp = a; *(u32x4*)(dp + 8) = b; }
        if (queue) { if (++sub == QG) { sub = 0; t = qslot[0]; } else ++t; } else t += gdim();
    }
}
__device__ void ph_moe_cvt(const Params& p, int layer, char* lds) {
    const float* w1 = p.moe_w1 + (size_t)layer * NE * D * FF; const float* w3 = p.moe_w3 + (size_t)layer * NE * D * FF; const float* w2 = p.moe_w2 + (size_t)layer * NE * FF * D;
    cvt_tiles(p.wv, lds, (bf16_t*)(p.ws + OFF_W13T), D, 2816, NE, (size_t)2816 * D,
        [=](int e, int k, int n) -> const float* { const int pn = n >> 8, half = (n >> 7) & 1, c = pn * 128 + (n & 127); return (half ? w3 : w1) + ((size_t)e * D + k) * FF + c; },
        [=](int n) { return n; }, (unsigned*)(p.ws + OFF_QUEUE) + (layer * 2) * 16);
    cvt_tiles(p.wv, lds, (bf16_t*)(p.ws + OFF_W2T), FF, D, NE, (size_t)D * FF,
        [=](int e, int k, int n) -> const float* { return w2 + ((size_t)e * FF + k) * D + n; },
        [=](int n) { return n; }, (unsigned*)(p.ws + OFF_QUEUE) + (layer * 2 + 1) * 16);
}

__device__ void ph_init(const Params& p, char* lds) {
    const int tid = tidx(), gtid = bidx() * NTHR + tid, gsz = gdim() * NTHR;
    float4* X4 = (float4*)(p.ws + OFF_X);
    const float4* x4 = (const float4*)p.x; const float4* c4 = (const float4*)p.ctx;
    for (int i = gtid; i < NROW * 256; i += gsz) X4[i] = i < NLAT * 256 ? x4[i] : c4[i - NLAT * 256];
    float* rc = (float*)(p.ws + OFF_ROPE_C); float* rs = (float*)(p.ws + OFF_ROPE_S);
    for (int i = gtid; i < TL * 32; i += gsz) {
        const int t = i >> 5, f = i & 31; const float pos = (float)((f < 16) ? (t >> 6) : (t & 63));
        const float inv = powf(10000.f, -(float)(f & 15) / 16.f); const float ang = pos * inv; rc[2 * i] = cosf(ang); rc[2 * i + 1] = sinf(ang);
    }
    float* sc = (float*)lds;
    float* red = sc + 5 * 1024;
    for (int i = tid; i < 5 * 1024; i += NTHR) { const float v = i < 4096 ? p.c[i] : p.c_ctx[i - 4096]; sc[i] = v / (1.f + expf(-v)); }
    __syncthreads();
    float* MOD = (float*)(p.ws + OFF_MOD);
    for (int item = bidx(); item < 4 * 96; item += gdim()) {
        const int l = item / 96, cg = item % 96, col = tid & 63, n = cg * 64 + col, kg = tid >> 6;
        const float* w = p.mod_w + ((size_t)l * 1024 + kg * 128) * 6144 + n;
        float a0 = 0, a1 = 0, a2 = 0, a3 = 0, a4 = 0;
        for (int k = 0; k < 128; ++k) { const float wv = w[(size_t)k * 6144]; const int kk = kg * 128 + k;
            a0 += sc[kk] * wv; a1 += sc[1024 + kk] * wv; a2 += sc[2048 + kk] * wv; a3 += sc[3072 + kk] * wv; a4 += sc[4096 + kk] * wv; }
        float* rr = red + (kg * 64 + col) * 5; rr[0] = a0; rr[1] = a1; rr[2] = a2; rr[3] = a3; rr[4] = a4;
        __syncthreads();
        if (tid < 320) { const int c2 = tid & 63, s = tid >> 6; float sum = 0;
            for (int q = 0; q < 8; ++q) sum += red[(q * 64 + c2) * 5 + s];
            MOD[((size_t)l * 5 + s) * 6144 + cg * 64 + c2] = sum + p.mod_b[l * 6144 + cg * 64 + c2]; }
        __syncthreads();
    }
}


__device__ void ph_small_cvt(const Params& p, char* lds) {
    for (int j = 0; j < 2; ++j) {
        char* wm = p.ws + OFF_WMLA + j * SZ_WMLA; char* wr = p.ws + OFF_WRW + j * SZ_WRW;
        const float* w_in = p.mla_w_in + (size_t)j * D * 448; const float* w_uq = p.mla_w_uq + (size_t)j * 256 * 1536; const float* w_ukv = p.mla_w_ukv + (size_t)j * 128 * 2048; const float* w_o = p.mla_w_o + (size_t)j * D * D;
        cvt_tiles(p.wv, lds, (bf16_t*)(wm + WM_IN), 1024, 512, 1, 0, [=](int, int k, int n) -> const float* { return n < 448 ? w_in + (size_t)k * 448 + n : nullptr; },
                  [=](int n) { if (n < 384 || n >= 448) return n; const int jj = n - 384; return 384 + (jj < 32 ? 2 * jj : 2 * (jj - 32) + 1); });
        cvt_tiles(p.wv, lds, (bf16_t*)(wm + WM_UQ), 256, 1536, 1, 0, [=](int, int k, int n) -> const float* { return w_uq + (size_t)k * 1536 + n; },
                  [=](int n) { const int h = n / 192, d = n % 192; if (d < 128) return n; const int jj = d - 128; return h * 192 + 128 + (jj < 32 ? 2 * jj : 2 * (jj - 32) + 1); });
        cvt_tiles(p.wv, lds, (bf16_t*)(wm + WM_UKV), 256, 2048, 1, 0, [=](int, int k, int n) -> const float* { return k < 128 ? w_ukv + (size_t)k * 2048 + n : nullptr; }, [=](int n) { return n; });
        cvt_tiles(p.wv, lds, (bf16_t*)(wm + WM_O), 1024, 1024, 1, 0, [=](int, int k, int n) -> const float* { return w_o + (size_t)k * D + n; }, [=](int n) { return n; });
        const float* w_rkv = p.rw_w_rkv + (size_t)j * 3 * D * D; const float* w1 = p.rw_w1 + (size_t)j * 2 * D * 64; const float* a1 = p.rw_a1 + (size_t)j * 2 * D * 64;
        const float* g1 = p.rw_g1 + (size_t)j * D * 128; const float* v1 = p.rw_v1; const float* rwo = p.rw_w_o + (size_t)j * D * D;
        cvt_tiles(p.wv, lds, (bf16_t*)(wr + WR_RKV), 1024, 1024, 3, (size_t)D * D, [=](int m, int k, int n) -> const float* { return w_rkv + ((size_t)m * D + k) * D + n; }, [=](int n) { return n; });
        cvt_tiles(p.wv, lds, (bf16_t*)(wr + WR_L), 1024, 256, 1, 0, [=](int, int k, int n) -> const float* { return n < 128 ? w1 + ((size_t)(n >> 6) * D + k) * 64 + (n & 63) : nullptr; }, [=](int n) { return n; });
        cvt_tiles(p.wv, lds, (bf16_t*)(wr + WR_L) + 256 * 1024, 1024, 256, 1, 0, [=](int, int k, int n) -> const float* { return n < 128 ? a1 + ((size_t)(n >> 6) * D + k) * 64 + (n & 63) : nullptr; }, [=](int n) { return n; });
        cvt_tiles(p.wv, lds, (bf16_t*)(wr + WR_L) + 2 * 256 * 1024, 1024, 256, 1, 0, [=](int, int k, int n) -> const float* { return n < 128 ? g1 + (size_t)k * 128 + n : nullptr; }, [=](int n) { return n; });
        cvt_tiles(p.wv, lds, (bf16_t*)(wr + WR_L) + 3 * 256 * 1024, 1024, 256, 1, 0, [=](int, int k, int n) -> const float* { return n < 32 ? v1 + (size_t)k * 32 + n : nullptr; }, [=](int n) { return n; });
        cvt_tiles(p.wv, lds, (bf16_t*)(wr + WR_O), 1024, 1024, 1, 0, [=](int, int k, int n) -> const float* { return rwo + (size_t)k * D + n; }, [=](int n) { return n; });
        const float* w2 = p.rw_w2 + (size_t)j * 2 * 64 * D; const float* a2 = p.rw_a2 + (size_t)j * 2 * 64 * D; const float* g2 = p.rw_g2 + (size_t)j * 128 * D; const float* v2 = p.rw_v2;
        cvt_tiles(p.wv, lds, (bf16_t*)(wr + WR_B2), 256, 4096, 1, 0, [=](int, int k, int n) -> const float* { const int blk = n >> 10, c = n & 1023, l = k - blk * 64;
            if (l < 0 || l >= 64) return nullptr; return (blk < 2 ? w2 + ((size_t)blk * 64 + l) * D : a2 + ((size_t)(blk - 2) * 64 + l) * D) + c; }, [=](int n) { return n; });
        cvt_tiles(p.wv, lds, (bf16_t*)(wr + WR_B3), 256, 2048, 1, 0, [=](int, int k, int n) -> const float* {
            if (n < 1024) return k < 128 ? g2 + (size_t)k * D + n : nullptr; return (k >= 128 && k < 160) ? v2 + (size_t)(k - 128) * D + (n - 1024) : nullptr; }, [=](int n) { return n; });
    }
}

template <bool OUTF32>
__device__ void ph_norm_mod(const Params& p, int layer, const float* g, int part_sh, int part_sc, void* outp) {
    const int wid = tidx() >> 6, lane = tidx() & 63;
    const float* X = (const float*)(p.ws + OFF_X);
    for (int row = bidx() * 8 + wid; row < NROW; row += gdim() * 8) {
        const int s = row_stream(row);
        const float* sh = modp(p, layer, s, part_sh); const float* sc = modp(p, layer, s, part_sc);
        const float4* xr = (const float4*)(X + (size_t)row * D);
        float4 v[4]; float ss = 0;
#pragma unroll
        for (int i = 0; i < 4; ++i) { v[i] = xr[lane + i * 64]; ss += v[i].x * v[i].x + v[i].y * v[i].y + v[i].z * v[i].z + v[i].w * v[i].w; }
        ss = wave_sum(ss); const float rs = rsqrtf(ss * (1.f / D) + RMS_EPS);
#pragma unroll
        for (int i = 0; i < 4; ++i) {
            const int d = (lane + i * 64) * 4;
            const float4 gg = *(const float4*)(g + d), a = *(const float4*)(sc + d), b = *(const float4*)(sh + d);
            float4 o; o.x = v[i].x * rs * gg.x * (1.f + a.x) + b.x; o.y = v[i].y * rs * gg.y * (1.f + a.y) + b.y; o.z = v[i].z * rs * gg.z * (1.f + a.z) + b.z; o.w = v[i].w * rs * gg.w * (1.f + a.w) + b.w;
            if (OUTF32) *(float4*)((float*)outp + (size_t)row * D + d) = o;
            else { uint2 w; w.x = pk2(o.x, o.y); w.y = pk2(o.z, o.w); *(uint2*)((bf16_t*)outp + (size_t)row * D + d) = w; }
        }
    }
}

__device__ void ph_mla_mid(const Params& p, int j) {
    const int wid = tidx() >> 6, lane = tidx() & 63;
    const float* Z = (const float*)(p.ws + OFF_Z);
    bf16_t* CQN = (bf16_t*)(p.ws + OFF_CQN); bf16_t* CKVN = (bf16_t*)(p.ws + OFF_CKVN); bf16_t* K = (bf16_t*)(p.ws + OFF_K);
    const float* gq = p.mla_g_q + j * 256; const float* gkv = p.mla_g_kv + j * 128;
    const float* rc = (const float*)(p.ws + OFF_ROPE_C); const float* rs = (const float*)(p.ws + OFF_ROPE_S);
    for (int row = bidx() * 8 + wid; row < NROW; row += gdim() * 8) {
        const float* z = Z + (size_t)row * 512;
        const float4 q = *(const float4*)(z + lane * 4);
        const float2 kv = *(const float2*)(z + 256 + lane * 2);
        const float kr = z[384 + lane];
        float sq = wave_sum(q.x * q.x + q.y * q.y + q.z * q.z + q.w * q.w); const float rq = rsqrtf(sq * (1.f / 256.f) + RMS_EPS);
        float sk = wave_sum(kv.x * kv.x + kv.y * kv.y); const float rk = rsqrtf(sk * (1.f / 128.f) + RMS_EPS);
        const float4 g4 = *(const float4*)(gq + lane * 4); const float2 g2 = *(const float2*)(gkv + lane * 2);
        uint2 w; w.x = pk2(q.x * rq * g4.x, q.y * rq * g4.y); w.y = pk2(q.z * rq * g4.z, q.w * rq * g4.w);
        *(uint2*)(CQN + (size_t)row * 256 + lane * 4) = w;
        *(unsigned*)(CKVN + (size_t)row * 256 + lane * 2) = pk2(kv.x * rk * g2.x, kv.y * rk * g2.y);
        *(unsigned*)(CKVN + (size_t)row * 256 + 128 + lane * 2) = 0u;
        float o = kr;
        const float other = __builtin_bit_cast(float, __builtin_amdgcn_update_dpp(0, __builtin_bit_cast(int, kr), 0xB1, 0xF, 0xF, true));
        const bool lat = row < NLAT;
        if (lat) { const int t = row & (TL - 1), i = lane >> 1; const float2 cs = *(const float2*)(rc + (t * 32 + i) * 2); const float c = cs.x, s = cs.y;
            o = (lane & 1) ? (other * s + kr * c) : (kr * c - other * s); }
        const int b = lat ? (row >> 12) : ((row - NLAT) >> 8); const int tk = lat ? 256 + (row & (TL - 1)) : ((row - NLAT) & 255);
        const bf16_t ob = f2bf(o);
#pragma unroll
        for (int h = 0; h < 8; ++h) K[((size_t)(b * 8 + h) * TK + tk) * 192 + 128 + lane] = ob;
    }
}

__device__ void ph_qkv_post(const Params& p) {
    const int wid = tidx() >> 6, lane = tidx() & 63;
    const float* QRAW = (const float*)(p.ws + OFF_QRAW); const float* KVRAW = (const float*)(p.ws + OFF_KVRAW); const float* KR = (const float*)(p.ws + OFF_KR);
    bf16_t* Q = (bf16_t*)(p.ws + OFF_Q); bf16_t* K = (bf16_t*)(p.ws + OFF_K); bf16_t* V = (bf16_t*)(p.ws + OFF_V);
    const float* rc = (const float*)(p.ws + OFF_ROPE_C); const float* rs = (const float*)(p.ws + OFF_ROPE_S);
    for (int it = bidx() * 8 + wid; it < NROW * 8; it += gdim() * 8) {
        const int row = it >> 3, h = it & 7;
        const bool lat = row < NLAT; const int b = lat ? (row >> 12) : ((row - NLAT) >> 8); const int tk = lat ? 256 + (row & (TL - 1)) : ((row - NLAT) & 255);
        const size_t orow = (size_t)(b * 8 + h) * TK + tk;
        const float* q = QRAW + (size_t)row * 1536 + h * 192;
        const float q0 = q[lane], q1 = q[64 + lane]; float q2 = q[128 + lane];
        const auto sw = __builtin_amdgcn_permlane32_swap(__float_as_uint(q2), __float_as_uint(q2), false, false);
        if (lat) { const int t = row & (TL - 1), i = lane & 31; const float c = rc[t * 32 + i], s = rs[t * 32 + i];
            const float x1 = __uint_as_float(sw[0]), x2 = __uint_as_float(sw[1]); q2 = lane < 32 ? (x1 * c - x2 * s) : (x1 * s + x2 * c); }
        bf16_t* qo = Q + orow * 192; qo[lane] = f2bf(q0); qo[64 + lane] = f2bf(q1); qo[128 + lane] = f2bf(q2);
        const float* kv = KVRAW + (size_t)row * 2048 + h * 256;
        bf16_t* ko = K + orow * 192; ko[lane] = f2bf(kv[lane]); ko[64 + lane] = f2bf(kv[64 + lane]); ko[128 + lane] = f2bf(KR[(size_t)row * 64 + lane]);
        bf16_t* vo = V + orow * 128; vo[lane] = f2bf(kv[128 + lane]); vo[64 + lane] = f2bf(kv[192 + lane]);
    }
}

__device__ void ph_attn_naive(const Params& p, char* lds) {
    const int tid = tidx(), qi = tid >> 2, part = tid & 3;
    const bf16_t* Q = (const bf16_t*)(p.ws + OFF_Q); const bf16_t* K = (const bf16_t*)(p.ws + OFF_K); const bf16_t* V = (const bf16_t*)(p.ws + OFF_V);
    bf16_t* O = (bf16_t*)(p.ws + OFF_O);
    bf16_t* Ks = (bf16_t*)lds;
    bf16_t* Vs = Ks + 32 * 192;
    const int nitems = 32 * 34;
    for (int it = bidx(); it < nitems; it += gdim()) {
        const int bh = it / 34, qb = it % 34; const int b = bh >> 3, h = bh & 7;
        const int nkeys = qb < 2 ? TC : TK;
        const int tq = qb * 128 + qi;
        const bf16_t* qp = Q + ((size_t)bh * TK + tq) * 192 + part * 48;
        float q[48];
#pragma unroll
        for (int i = 0; i < 48; ++i) q[i] = bf2f(qp[i]) * ATT_SCALE;
        float o[32];
#pragma unroll
        for (int i = 0; i < 32; ++i) o[i] = 0.f;
        float m = -1e30f, l = 0.f;
        for (int k0 = 0; k0 < nkeys; k0 += 32) {
            __syncthreads();
            {
                const bf16_t* kg = K + ((size_t)bh * TK + k0) * 192; const bf16_t* vg = V + ((size_t)bh * TK + k0) * 128;
                for (int c = tid; c < 768; c += NTHR) *(u32x4*)(Ks + c * 8) = *(const u32x4*)(kg + c * 8);
                *(u32x4*)(Vs + tid * 8) = *(const u32x4*)(vg + tid * 8);
            }
            __syncthreads();
#pragma unroll 1
            for (int kg = 0; kg < 32; kg += 8) {
                float s[8]; float tmax = -1e30f;
#pragma unroll
                for (int kk = 0; kk < 8; ++kk) {
                    const bf16_t* kr = Ks + (kg + kk) * 192 + part * 48; float acc = 0.f;
#pragma unroll
                    for (int i = 0; i < 48; ++i) acc += q[i] * bf2f(kr[i]);
                    acc += __shfl_xor(acc, 1); acc += __shfl_xor(acc, 2);
                    s[kk] = acc; tmax = fmaxf(tmax, acc);
                    asm volatile("" ::: "memory");
                }
                const float mn = fmaxf(m, tmax), alpha = expf(m - mn); m = mn; l *= alpha;
#pragma unroll
                for (int i = 0; i < 32; ++i) o[i] *= alpha;
#pragma unroll
                for (int kk = 0; kk < 8; ++kk) {
                    const float pw = expf(s[kk] - mn); l += pw;
                    const bf16_t* vr = Vs + (kg + kk) * 128 + part * 32;
#pragma unroll
                    for (int i = 0; i < 32; ++i) o[i] += pw * bf2f(vr[i]);
                    asm volatile("" ::: "memory");
                }
            }
        }
        const float rl = 1.f / l;
        const int row = qb < 2 ? (NLAT + b * TC + tq) : (b * TL + tq - TC);
        bf16_t* op = O + (size_t)row * D + h * 128 + part * 32;
#pragma unroll
        for (int i = 0; i < 32; ++i) op[i] = f2bf(o[i] * rl);
    }
}


namespace fa {
using s16x4  = __attribute__((ext_vector_type(4))) short;
using f32x16 = __attribute__((ext_vector_type(16))) float;
constexpr int DQK = 192, DV = 128, KVBLK = 64;
constexpr float THR = 8.f;
constexpr int SHM_V = KVBLK * DV * 2, SHM_K = KVBLK * DQK * 2;
constexpr int SHM_ATTN = 2 * SHM_V + 2 * SHM_K + 8 * 64 * 4;
#define KSWZ(row, colB) ((row) * 384 + ((colB) ^ (((row) & 7) << 4)))
#define SBAR() __builtin_amdgcn_sched_barrier(0)
__device__ __forceinline__ int crow(int r, int hi) { return (r & 3) + 8 * (r >> 2) + 4 * hi; }
__device__ __forceinline__ unsigned cvtpk(float lo, float hi) { unsigned r; asm volatile("v_cvt_pk_bf16_f32 %0, %1, %2" : "=v"(r) : "v"(lo), "v"(hi)); return r; }
__device__ __forceinline__ void partialSM(f32x16& p0, f32x16& p1, float& m_reg, float& mn, float& alpha) {
  constexpr float C = ATT_SCALE * 1.4426950408889634f;
  float pmax = p0[0];
#pragma unroll
  for (int r = 1; r < 16; ++r) pmax = fmaxf(pmax, p0[r]);
#pragma unroll
  for (int r = 0; r < 16; ++r) pmax = fmaxf(pmax, p1[r]);
  { auto rr = __builtin_amdgcn_permlane32_swap(__float_as_uint(pmax), __float_as_uint(pmax), false, false);
    pmax = fmaxf(__uint_as_float(rr[0]), __uint_as_float(rr[1])); }
  if (__builtin_expect(__all(pmax - m_reg <= THR / ATT_SCALE), 1)) { mn = m_reg; alpha = 1.f; }
  else { mn = fmaxf(m_reg, pmax); alpha = __builtin_amdgcn_exp2f((m_reg - mn) * C); m_reg = mn; }
  float mnC = -mn * C;
#pragma unroll
  for (int r = 0; r < 16; ++r) p0[r] = fmaf(p0[r], C, mnC);
#pragma unroll
  for (int r = 0; r < 16; ++r) p1[r] = fmaf(p1[r], C, mnC);
#pragma unroll
  for (int r = 0; r < 16; ++r) p0[r] = __builtin_amdgcn_exp2f(p0[r]);
}
__device__ __forceinline__ void finishSM(f32x16& p0, f32x16& p1, float alpha, float& l_reg, bf16x8& pa0, bf16x8& pa1, bf16x8& pa2, bf16x8& pa3) {
#pragma unroll
  for (int r = 0; r < 16; ++r) p1[r] = __builtin_amdgcn_exp2f(p1[r]);
  float ps = 0;
#pragma unroll
  for (int r = 0; r < 16; ++r) ps += p0[r];
#pragma unroll
  for (int r = 0; r < 16; ++r) ps += p1[r];
  { auto rr = __builtin_amdgcn_permlane32_swap(__float_as_uint(ps), __float_as_uint(ps), false, false);
    ps = __uint_as_float(rr[0]) + __uint_as_float(rr[1]); }
  l_reg = l_reg * alpha + ps;
#define PK4(P, BASE, OUT) do { unsigned a0 = cvtpk(P[BASE + 0], P[BASE + 1]), a1 = cvtpk(P[BASE + 2], P[BASE + 3]);   \
    unsigned b0 = cvtpk(P[BASE + 4], P[BASE + 5]), b1 = cvtpk(P[BASE + 6], P[BASE + 7]);                              \
    auto r0 = __builtin_amdgcn_permlane32_swap(a0, b0, false, false); auto r1 = __builtin_amdgcn_permlane32_swap(a1, b1, false, false); \
    u32x4 w = {r0[0], r1[0], r0[1], r1[1]}; OUT = *reinterpret_cast<bf16x8*>(&w); } while (0)
  PK4(p0, 0, pa0); PK4(p0, 8, pa1); PK4(p1, 0, pa2); PK4(p1, 8, pa3);
#undef PK4
}
__device__ __forceinline__ void qkt(f32x16& p0, f32x16& p1, const char* Ks, const bf16x8* qr, int r32, int hi) {
  p0 = f32x16{}; p1 = f32x16{};
  const int swz = (r32 & 7) << 4;
  const char* b4[4];
#pragma unroll
  for (int dr = 0; dr < 4; ++dr) b4[dr] = Ks + r32 * 384 + ((dr * 32 + hi * 16) ^ swz);
#pragma unroll
  for (int d0 = 0; d0 < 12; ++d0) {
    bf16x8 b0 = *reinterpret_cast<const bf16x8*>(b4[d0 & 3] + (d0 >> 2) * 128);
    bf16x8 b1 = *reinterpret_cast<const bf16x8*>(b4[d0 & 3] + (d0 >> 2) * 128 + 32 * 384);
    p0 = __builtin_amdgcn_mfma_f32_32x32x16_bf16(b0, qr[d0], p0, 0, 0, 0);
    p1 = __builtin_amdgcn_mfma_f32_32x32x16_bf16(b1, qr[d0], p1, 0, 0, 0); }
}
__device__ __forceinline__ int v_st(int k, int c) { const int kk = (k & ~0xC) | ((k & 4) << 1) | ((k & 8) >> 1); return ((kk >> 3) * 4 + (c >> 5)) * 512 + ((kk & 7) * 32 + (c & 31)) * 2; }
__device__ __forceinline__ int v_rd_base(int lane) { return ((lane & 3) << 3) | (((lane >> 2) & 3) << 6) | (((lane >> 4) & 1) << 5) | (((lane >> 5) & 1) << 8); }
constexpr int v_rd_off(int d0, int ks, int half) { return d0 * 512 + ks * 4096 + half * 2048; }
template <int OFF> __device__ __forceinline__ s16x4 tr_read(int vb) {
  s16x4 r; asm volatile("ds_read_b64_tr_b16 %0, %1 offset:%2" : "=&v"(r) : "v"(vb), "i"(OFF) : "memory"); return r;
}
template <int D0> __device__ __forceinline__ void pv_one(f32x16& od, int vb, bf16x8 pa0, bf16x8 pa1, bf16x8 pa2, bf16x8 pa3) {
  const s16x4 l0 = tr_read<v_rd_off(D0, 0, 0)>(vb), h0 = tr_read<v_rd_off(D0, 0, 1)>(vb), l1 = tr_read<v_rd_off(D0, 1, 0)>(vb), h1 = tr_read<v_rd_off(D0, 1, 1)>(vb);
  const s16x4 l2 = tr_read<v_rd_off(D0, 2, 0)>(vb), h2 = tr_read<v_rd_off(D0, 2, 1)>(vb), l3 = tr_read<v_rd_off(D0, 3, 0)>(vb), h3 = tr_read<v_rd_off(D0, 3, 1)>(vb);
  asm volatile("s_waitcnt lgkmcnt(0)" ::: "memory"); SBAR();
#define PK(L, H) (bf16x8){L[0], L[1], L[2], L[3], H[0], H[1], H[2], H[3]}
  od = __builtin_amdgcn_mfma_f32_32x32x16_bf16(pa0, PK(l0, h0), od, 0, 0, 0);
  od = __builtin_amdgcn_mfma_f32_32x32x16_bf16(pa1, PK(l1, h1), od, 0, 0, 0);
  od = __builtin_amdgcn_mfma_f32_32x32x16_bf16(pa2, PK(l2, h2), od, 0, 0, 0);
  od = __builtin_amdgcn_mfma_f32_32x32x16_bf16(pa3, PK(l3, h3), od, 0, 0, 0);
#undef PK
}
__device__ __forceinline__ void pv_d0(f32x16* o, int vb, bf16x8 pa0, bf16x8 pa1, bf16x8 pa2, bf16x8 pa3) {
  pv_one<0>(o[0], vb, pa0, pa1, pa2, pa3); pv_one<1>(o[1], vb, pa0, pa1, pa2, pa3); pv_one<2>(o[2], vb, pa0, pa1, pa2, pa3); pv_one<3>(o[3], vb, pa0, pa1, pa2, pa3);
}
__device__ __forceinline__ void attn_body(const int wv_, const bf16_t* __restrict__ Qb, const bf16_t* __restrict__ Kh, const bf16_t* __restrict__ Vh, bf16_t* __restrict__ Ob, int ldo, int seq, char* lds, const float* __restrict__ ropecs  ) {
  const int tid = tidx_w(wv_), wid = tid >> 6, lane = tid & 63, r32 = lane & 31, hi = lane >> 5;
  char* V_lds = lds; char* K_lds = lds + 2 * SHM_V;
  float* ws = (float*)(lds + 2 * SHM_V + 2 * SHM_K) + wid * 64; float* li_l = ws; float* al_l = ws + 32;
  float m_reg = -1e30f, l_reg = 0; f32x16 o[4] = {}; bf16x8 qr[12];
  const bf16_t* Qw = Qb + (long)(wid * 32 + r32) * DQK + hi * 8;
#pragma unroll
  for (int d0 = 0; d0 < 12; ++d0) qr[d0] = *reinterpret_cast<const bf16x8*>(Qw + d0 * 16);
  if (ropecs) {
    const float* cs = ropecs + (size_t)(wid * 32 + r32) * 64;
#pragma unroll
    for (int d0 = 8; d0 < 12; ++d0) { const int i0 = (d0 - 8) * 8 + hi * 4; const f32x4 c0 = *(const f32x4*)(cs + i0 * 2), c1 = *(const f32x4*)(cs + i0 * 2 + 4);
      u32x4 w = *reinterpret_cast<u32x4*>(&qr[d0]); const float cc[4] = {c0[0], c0[2], c1[0], c1[2]}, ss[4] = {c0[1], c0[3], c1[1], c1[3]};
#pragma unroll
      for (int m = 0; m < 4; ++m) { const float x1 = __uint_as_float(w[m] << 16), x2 = __uint_as_float(w[m] & 0xffff0000u); w[m] = cvtpk(x1 * cc[m] - x2 * ss[m], x1 * ss[m] + x2 * cc[m]); }
      qr[d0] = *reinterpret_cast<bf16x8*>(&w); }
  }
  const int sr = tid >> 4, sc = (tid & 15) * 8, vst0 = v_st(sr, sc), vst1 = v_st(32 + sr, sc);
  int kst[3];
#pragma unroll
  for (int i = 0; i < 3; ++i) { const int c = tid + 512 * i, row = c / 24, cc = c % 24; kst[i] = KSWZ(row, cc * 16); }
  const int vb0 = (int)(uintptr_t)V_lds + v_rd_base(lane);
  struct { bf16x8 vs0, vs1, ks0, ks1, ks2; } sr_[1];
#define SLOAD(i, k0) do { const bf16_t* vt = Vh + (long)(k0) * DV; const bf16_t* kt = Kh + (long)(k0) * DQK; \
    sr_[i].vs0 = *reinterpret_cast<const bf16x8*>(vt + (sr) * DV + sc); sr_[i].vs1 = *reinterpret_cast<const bf16x8*>(vt + (32 + sr) * DV + sc); \
    sr_[i].ks0 = *reinterpret_cast<const bf16x8*>(kt + tid * 8); sr_[i].ks1 = *reinterpret_cast<const bf16x8*>(kt + (tid + 512) * 8); sr_[i].ks2 = *reinterpret_cast<const bf16x8*>(kt + (tid + 1024) * 8); } while (0)
#define SWRITE(b, i) do { *(bf16x8*)(V_lds + (b) * SHM_V + vst0) = sr_[i].vs0; *(bf16x8*)(V_lds + (b) * SHM_V + vst1) = sr_[i].vs1; \
    *(bf16x8*)(K_lds + (b) * SHM_K + kst[0]) = sr_[i].ks0; *(bf16x8*)(K_lds + (b) * SHM_K + kst[1]) = sr_[i].ks1; *(bf16x8*)(K_lds + (b) * SHM_K + kst[2]) = sr_[i].ks2; } while (0)
#define SWAIT() asm volatile("s_waitcnt vmcnt(5)" ::: "memory")
#define RESC(a) do { if (__any((a) < 1.f)) { if (hi == 0) al_l[r32] = (a); asm volatile("s_waitcnt lgkmcnt(0)" ::: "memory"); \
    _Pragma("unroll") for (int d = 0; d < 4; ++d) _Pragma("unroll") for (int r = 0; r < 16; ++r) o[d][r] *= al_l[crow(r, hi)]; } } while (0)
  f32x16 pA0, pA1; float mnA, alA; bf16x8 pa0, pa1, pa2, pa3; const int NT = seq / KVBLK;
  SLOAD(0, 0); SWRITE(0, 0);
  SLOAD(0, KVBLK);
  __syncthreads();
  for (int j = 0; j < NT; j += 2) {
    SBAR(); qkt(pA0, pA1, K_lds, qr, r32, hi);
    partialSM(pA0, pA1, m_reg, mnA, alA); RESC(alA);
    finishSM(pA0, pA1, alA, l_reg, pa0, pa1, pa2, pa3); SBAR();
    SWRITE(1, 0);
    if (j + 2 < NT) SLOAD(0, (j + 2) * KVBLK);
    SBAR();
    pv_d0(o, vb0, pa0, pa1, pa2, pa3);
    __syncthreads();
    SBAR(); qkt(pA0, pA1, K_lds + SHM_K, qr, r32, hi);
    partialSM(pA0, pA1, m_reg, mnA, alA); RESC(alA);
    finishSM(pA0, pA1, alA, l_reg, pa0, pa1, pa2, pa3); SBAR();
    if (j + 2 < NT) { SWRITE(0, 0); if (j + 3 < NT) SLOAD(0, (j + 3) * KVBLK); }
    SBAR();
    pv_d0(o, vb0 + SHM_V, pa0, pa1, pa2, pa3);
    __syncthreads();
  }
  if (hi == 0) li_l[r32] = l_reg; asm volatile("s_waitcnt lgkmcnt(0)" ::: "memory");
  float rli[16];
#pragma unroll
  for (int r = 0; r < 16; ++r) rli[r] = __builtin_amdgcn_rcpf(li_l[crow(r, hi)]);
  bf16_t* Ow = Ob + (long)(wid * 32) * ldo;
#pragma unroll
  for (int r = 0; r < 16; ++r) { int orow = crow(r, hi);
#pragma unroll
    for (int d0 = 0; d0 < 4; ++d0) Ow[(long)orow * ldo + d0 * 32 + r32] = f2bf(o[d0][r] * rli[r]); }
  __syncthreads();
#undef SLOAD
#undef SWRITE
#undef SWAIT
#undef RESC
}
#undef KSWZ
}

__device__ void ph_attn(const Params& p, char* lds) {
    const bf16_t* Q = (const bf16_t*)(p.ws + OFF_Q); const bf16_t* K = (const bf16_t*)(p.ws + OFF_K); const bf16_t* V = (const bf16_t*)(p.ws + OFF_V);
    bf16_t* O = (bf16_t*)(p.ws + OFF_O);
    const int G = gdim();
    for (int i = 0;; ++i) {
        const int L = i * G + bidx(); if (L >= 544) break;
        int bh, qb;
        if (L < 512) { const int w = g8::xcd_remap(L, 512); bh = w >> 4; qb = 1 + (w & 15); } else { bh = L - 512; qb = 0; }
        const int b = bh >> 3, h = bh & 7;
        const int seq = qb == 0 ? TC : TK;
        const int row0 = qb == 0 ? NLAT + b * TC : b * TL + (qb - 1) * 256;
        fa::attn_body(p.wv, Q + ((size_t)bh * TK + qb * 256) * 192, K + (size_t)bh * TK * 192, V + (size_t)bh * TK * 128, O + (size_t)row0 * D + h * 128, D, seq, lds,
                      qb == 0 ? nullptr : (const float*)(p.ws + OFF_ROPE_C) + (size_t)(qb - 1) * 256 * 64);
    }
}

__device__ void ph_norm2_router(const Params& p, int layer, char* lds, int nrows) {
    const int tid = tidx(), wid = tid >> 6, lane = tid & 63;
    float* rt = (float*)lds;
    const float* rg = p.moe_router + (size_t)layer * D * NE;
    for (int i = tid; i < D * NE / 4; i += NTHR) ((float4*)rt)[i] = ((const float4*)rg)[i];
    __syncthreads();
    const float* X = (const float*)(p.ws + OFF_X); bf16_t* BN = (bf16_t*)(p.ws + OFF_H); float* AFF = (float*)(p.ws + OFF_AFF);
    const float* g = p.norm2_g + layer * D;
    for (int row = bidx() * 8 + wid; row < nrows; row += gdim() * 8) {
        const int s = row_stream(row);
        const float* sh = modp(p, layer, s, 3); const float* sc = modp(p, layer, s, 4);
        const float4* xr = (const float4*)(X + (size_t)row * D);
        float4 v[4]; float ss = 0;
#pragma unroll
        for (int i = 0; i < 4; ++i) { v[i] = xr[lane + i * 64]; ss += v[i].x * v[i].x + v[i].y * v[i].y + v[i].z * v[i].z + v[i].w * v[i].w; }
        ss = wave_sum(ss); const float rs = rsqrtf(ss * (1.f / D) + RMS_EPS);
        float lg[16];
#pragma unroll
        for (int e = 0; e < 16; ++e) lg[e] = 0.f;
#pragma unroll
        for (int i = 0; i < 4; ++i) {
            const int d = (lane + i * 64) * 4;
            const float4 gg = *(const float4*)(g + d), a = *(const float4*)(sc + d), b = *(const float4*)(sh + d);
            float o[4]; o[0] = v[i].x * rs * gg.x * (1.f + a.x) + b.x; o[1] = v[i].y * rs * gg.y * (1.f + a.y) + b.y; o[2] = v[i].z * rs * gg.z * (1.f + a.z) + b.z; o[3] = v[i].w * rs * gg.w * (1.f + a.w) + b.w;
            uint2 w; w.x = pk2(o[0], o[1]); w.y = pk2(o[2], o[3]); *(uint2*)(BN + (size_t)row * D + d) = w;
#pragma unroll
            for (int jj = 0; jj < 4; ++jj) { const float* rr = rt + (d + jj) * 16;
#pragma unroll
                for (int e = 0; e < 16; ++e) lg[e] += o[jj] * rr[e];
                asm volatile("" ::: "memory"); }
        }
        float mx = -1e30f;
#pragma unroll
        for (int e = 0; e < 16; ++e) { lg[e] = wave_sum(lg[e]); mx = fmaxf(mx, lg[e]); }
        float sum = 0;
#pragma unroll
        for (int e = 0; e < 16; ++e) { lg[e] = expf(lg[e] - mx); sum += lg[e]; }
        const float inv = 1.f / sum;
        if (lane < 16) { float val = 0;
#pragma unroll
            for (int e = 0; e < 16; ++e) val = (lane == e) ? lg[e] : val;
            AFF[(size_t)row * 16 + lane] = val * inv; }
    }
}

__device__ void ph_select(const Params& p, char* lds, int ngroups) {
    const int tid = tidx(), wid = tid >> 6, lane = tid & 63;
    unsigned* hist = (unsigned*)lds;
    unsigned* ctl = hist + 256;
    unsigned* wsum = ctl + 8;
    int* rowl = (int*)(wsum + 16);
    const float* AFF = (const float*)(p.ws + OFF_AFF);
    int* ROWIDX = (int*)(p.ws + OFF_ROWIDX); float* GATE = (float*)(p.ws + OFF_GATE); int* SLOT = (int*)(p.ws + OFF_SLOT);
    for (int gidx = bidx(); gidx < ngroups; gidx += gdim()) {
        const bool lat = gidx < 64; const int b = (gidx & 63) >> 4, e = gidx & 15;
        const int n = lat ? TL : TC, cap = lat ? CAPL : CAPC;
        const int row0 = lat ? b * TL : NLAT + b * TC, slot0 = lat ? b * CAPL : NB * CAPL + b * CAPC;
        unsigned key[8];
#pragma unroll
        for (int i = 0; i < 8; ++i) { const int idx = tid * 8 + i; key[i] = idx < n ? __float_as_uint(AFF[(size_t)(row0 + idx) * 16 + e]) : 0u; }
        unsigned prefix = 0u, remaining = (unsigned)cap;
#pragma unroll
        for (int pass = 0; pass < 4; ++pass) {
            const int sh = 24 - 8 * pass;
            __syncthreads();
            if (tid < 256) hist[tid] = 0u;
            __syncthreads();
#pragma unroll
            for (int i = 0; i < 8; ++i) { const int idx = tid * 8 + i;
                const bool cand = idx < n && (pass == 0 || (key[i] >> (sh + 8)) == prefix);
                if (cand) atomicAdd(&hist[(key[i] >> sh) & 255u], 1u); }
            __syncthreads();
            if (tid < 256) { unsigned gt = 0; for (int jj = tid + 1; jj < 256; ++jj) gt += hist[jj];
                const unsigned mine = hist[tid];
                if (gt < remaining && remaining <= gt + mine) { ctl[0] = (unsigned)tid; ctl[1] = remaining - gt; } }
            __syncthreads();
            prefix = (prefix << 8) | ctl[0]; remaining = ctl[1];
        }
        const unsigned T = prefix, m = remaining;
        unsigned cgt = 0, ceq = 0;
#pragma unroll
        for (int i = 0; i < 8; ++i) { const int idx = tid * 8 + i; if (idx < n) { cgt += key[i] > T ? 1u : 0u; ceq += key[i] == T ? 1u : 0u; } }
        auto block_excl = [&](unsigned v) -> unsigned {
            unsigned inc = v;
#pragma unroll
            for (int o = 1; o < 64; o <<= 1) { const unsigned t = (unsigned)__builtin_amdgcn_ds_bpermute((lane - o) << 2, (int)inc); if (lane >= o) inc += t; }
            __syncthreads();
            if (lane == 63) wsum[wid] = inc;
            __syncthreads();
            unsigned base = 0;
#pragma unroll
            for (int w = 0; w < 8; ++w) base += (w < wid) ? wsum[w] : 0u;
            return base + inc - v; };
        unsigned eqbase = block_excl(ceq);
        unsigned nsel = 0; bool sel[8];
#pragma unroll
        for (int i = 0; i < 8; ++i) { const int idx = tid * 8 + i; bool s_ = false;
            if (idx < n) { if (key[i] > T) s_ = true; else if (key[i] == T) { s_ = eqbase < m; ++eqbase; } }
            sel[i] = s_; nsel += s_ ? 1u : 0u; }
        unsigned sbase = block_excl(nsel);
#pragma unroll
        for (int i = 0; i < 8; ++i) { const int idx = tid * 8 + i;
            if (idx < n) {
                if (sel[i]) { const int sl = slot0 + (int)sbase; rowl[sbase] = row0 + idx; ++sbase; ROWIDX[e * ESLOTS + sl] = row0 + idx; GATE[e * EPAD + sl] = __uint_as_float(key[i]); SLOT[(size_t)(row0 + idx) * 16 + e] = sl; }
                else SLOT[(size_t)(row0 + idx) * 16 + e] = -1; } }
        __syncthreads();
        { const bf16_t* BN = (const bf16_t*)(p.ws + OFF_H); bf16_t* XE = (bf16_t*)(p.ws + OFF_XE);
          for (int r = wid; r < cap; r += 8) { const u32x4* src = (const u32x4*)(BN + (size_t)rowl[r] * D); u32x4* dst = (u32x4*)(XE + ((size_t)e * EPAD + slot0 + r) * D); dst[lane] = src[lane]; dst[lane + 64] = src[lane + 64]; } }
    }
}

__device__ void ph_gather(const Params& p, int nslots) {
    const int wid = tidx() >> 6, lane = tidx() & 63;
    const int* ROWIDX = (const int*)(p.ws + OFF_ROWIDX); const bf16_t* BN = (const bf16_t*)(p.ws + OFF_H); bf16_t* XE = (bf16_t*)(p.ws + OFF_XE);
    for (int it = bidx() * 8 + wid; it < NE * ESLOTS; it += gdim() * 8) {
        const int e = it / ESLOTS, sl = it % ESLOTS; if (sl >= nslots) continue; const int row = ROWIDX[it];
        const u32x4* src = (const u32x4*)(BN + (size_t)row * D); u32x4* dst = (u32x4*)(XE + ((size_t)e * EPAD + sl) * D);
        dst[lane] = src[lane]; dst[lane + 64] = src[lane + 64];
    }
}

__device__ void ph_combine(const Params& p, int layer, int nrows) {
    const int wid = tidx() >> 6, lane = tidx() & 63;
    const int* SLOT = (const int*)(p.ws + OFF_SLOT); const bf16_t* YE = (const bf16_t*)(p.ws + OFF_YE); float* X = (float*)(p.ws + OFF_X);
    for (int row = bidx() * 8 + wid; row < nrows; row += gdim() * 8) {
        const float* gt = modp(p, layer, row_stream(row), 5);
        float acc[16];
#pragma unroll
        for (int i = 0; i < 16; ++i) acc[i] = 0.f;
        for (int e = 0; e < NE; ++e) {
            const int s = SLOT[(size_t)row * 16 + e];
            if (s >= 0) { const bf16_t* y = YE + ((size_t)e * EPAD + s) * D + lane * 16;
                const u32x4 a = *(const u32x4*)y, b = *(const u32x4*)(y + 8);
                const unsigned w[8] = {a.x, a.y, a.z, a.w, b.x, b.y, b.z, b.w};
#pragma unroll
                for (int i = 0; i < 8; ++i) { acc[2 * i] += __uint_as_float(w[i] << 16); acc[2 * i + 1] += __uint_as_float(w[i] & 0xffff0000u); } }
        }
        float* xr = X + (size_t)row * D + lane * 16; const float* g = gt + lane * 16;
#pragma unroll
        for (int i = 0; i < 16; i += 4) { float4 xv = *(float4*)(xr + i); const float4 gv = *(const float4*)(g + i);
            xv.x += gv.x * acc[i]; xv.y += gv.y * acc[i + 1]; xv.z += gv.z * acc[i + 2]; xv.w += gv.w * acc[i + 3]; *(float4*)(xr + i) = xv; }
    }
}

__device__ void ph_rw_normxs(const Params& p, int layer, int j) {
    const int wid = tidx() >> 6, lane = tidx() & 63;
    const float* X = (const float*)(p.ws + OFF_X); bf16_t* XS = (bf16_t*)(p.ws + OFF_XS);
    const float* mu = p.rw_mu + (size_t)j * 6 * D; const float* g = p.norm1_g + layer * D;
    for (int row = bidx() * 8 + wid; row < NROW; row += gdim() * 8) {
        const int s_ = row_stream(row);
        const float* sh = modp(p, layer, s_, 0); const float* sc = modp(p, layer, s_, 1);
        const bool lat = row < NLAT; const int t = lat ? (row & (TL - 1)) : ((row - NLAT) & (TC - 1)); const int len = lat ? TL : TC;
        const bool hp = t > 0, hn = t < len - 1;
        float4 xc[4], xp[4], xn[4]; float sc_ = 0, sp_ = 0, sn_ = 0;
#pragma unroll
        for (int i = 0; i < 4; ++i) {
            xc[i] = ((const float4*)(X + (size_t)row * D))[lane + i * 64];
            xp[i] = hp ? ((const float4*)(X + (size_t)(row - 1) * D))[lane + i * 64] : make_float4(0, 0, 0, 0);
            xn[i] = hn ? ((const float4*)(X + (size_t)(row + 1) * D))[lane + i * 64] : make_float4(0, 0, 0, 0);
            sc_ += xc[i].x * xc[i].x + xc[i].y * xc[i].y + xc[i].z * xc[i].z + xc[i].w * xc[i].w;
            sp_ += xp[i].x * xp[i].x + xp[i].y * xp[i].y + xp[i].z * xp[i].z + xp[i].w * xp[i].w;
            sn_ += xn[i].x * xn[i].x + xn[i].y * xn[i].y + xn[i].z * xn[i].z + xn[i].w * xn[i].w; }
        sc_ = wave_sum(sc_); sp_ = wave_sum(sp_); sn_ = wave_sum(sn_);
        const float rc = rsqrtf(sc_ * (1.f / D) + RMS_EPS), rp = hp ? rsqrtf(sp_ * (1.f / D) + RMS_EPS) : 0.f, rn = hn ? rsqrtf(sn_ * (1.f / D) + RMS_EPS) : 0.f;
#pragma unroll
        for (int i = 0; i < 4; ++i) {
            const int d = (lane + i * 64) * 4;
            const float4 gg = *(const float4*)(g + d), a = *(const float4*)(sc + d), bsh = *(const float4*)(sh + d);
            float h[4], xx[4];
            const float gm[4] = {gg.x * (1.f + a.x), gg.y * (1.f + a.y), gg.z * (1.f + a.z), gg.w * (1.f + a.w)}; const float bb[4] = {bsh.x, bsh.y, bsh.z, bsh.w};
            const float c4[4] = {xc[i].x, xc[i].y, xc[i].z, xc[i].w}, p4[4] = {xp[i].x, xp[i].y, xp[i].z, xp[i].w}, n4[4] = {xn[i].x, xn[i].y, xn[i].z, xn[i].w};
#pragma unroll
            for (int e = 0; e < 4; ++e) { h[e] = c4[e] * rc * gm[e] + bb[e];
                const float hpv = hp ? p4[e] * rp * gm[e] + bb[e] : 0.f, hnv = hn ? n4[e] * rn * gm[e] + bb[e] : 0.f;
                xx[e] = 0.5f * (hpv + hnv) - h[e]; }
#pragma unroll
            for (int m = 0; m < 6; ++m) { const float4 u = *(const float4*)(mu + m * D + d);
                uint2 w; w.x = pk2(h[0] + xx[0] * u.x, h[1] + xx[1] * u.y); w.y = pk2(h[2] + xx[2] * u.z, h[3] + xx[3] * u.w);
                *(uint2*)(XS + ((size_t)m * NROW + row) * D + d) = w; }
        }
    }
}

__device__ __forceinline__ int scan_row(int i, int b, int z) {
    return i < TC ? NLAT + b * TC + (z ? TC - 1 - i : i) : b * TL + (z ? TL - 1 - (i - TC) : i - TC);
}
__device__ __forceinline__ float dpp_sum8(float x) {
    x += __builtin_bit_cast(float, __builtin_amdgcn_update_dpp(0, __builtin_bit_cast(int, x), 0xB1, 0xF, 0xF, true));
    x += __builtin_bit_cast(float, __builtin_amdgcn_update_dpp(0, __builtin_bit_cast(int, x), 0x4E, 0xF, 0xF, true));
    x += __builtin_bit_cast(float, __builtin_amdgcn_update_dpp(0, __builtin_bit_cast(int, x), 0x141, 0xF, 0xF, true));
    return x;
}
__device__ void ph_rw_scan(const Params& p, int j, char* lds) {
    const int tid = tidx(), wid = __builtin_amdgcn_readfirstlane(tid >> 6), lane = tid & 63;
    const size_t PL = (size_t)NROW * D;
    const float* RKV = (const float*)(p.ws + OFF_RKV); float* Y = (float*)(p.ws + OFF_Y);
    constexpr int CH = 32, BUFB = 5 * CH * 256 + CH * 128 + CH * 16, YB = CH * 32 * 4, NCH = (TC + TL) / CH;
    const bool loader = wid >= 4; const int lw = wid - 4;
    for (int it = bidx(); it < 256; it += gdim()) {
        const int vh = it & 1, z = (it >> 1) & 1, h = (it >> 2) & 15, b = it >> 6;
        const char* pl0 = (const char*)((const float*)(p.ws + OFF_W) + z * PL); const char* pl1 = (const char*)(RKV + PL);
        const char* pl2 = (const char*)((const float*)(p.ws + OFF_AV) + z * PL); const char* pl3 = (const char*)RKV;
        const char* vpl = (const char*)(RKV + 2 * PL);
        float* yout = Y + z * PL;
        __builtin_amdgcn_s_barrier();
        if (loader) {
            const int pq = lane & 15;
            const f32x4 kkv = *(const f32x4*)(p.rw_k_k + j * D + h * 64 + pq * 4), kav = *(const f32x4*)(p.rw_k_a + j * D + h * 64 + pq * 4);
            auto issue = [&](int c) {
                char* buf = lds + (c % 3) * BUFB;
#pragma unroll
                for (int q = 0; q < 8; ++q) { const int pi = q >> 1, tg = lw * 2 + (q & 1); const int row = scan_row(c * CH + tg * 4 + (lane >> 4), b, z);
                    const char* base = pi == 0 ? pl0 : pi == 1 ? pl1 : pi == 2 ? pl2 : pl3;
                    __builtin_amdgcn_global_load_lds((const unsigned*)(base + (size_t)row * D * 4 + h * 256 + (lane & 15) * 16), (LAS unsigned*)(buf + pi * (CH * 256) + tg * 1024), 16, 0, 0); }
                { const int row = scan_row(c * CH + lw * 8 + (lane >> 3), b, z);
                  __builtin_amdgcn_global_load_lds((const unsigned*)(vpl + (size_t)row * D * 4 + (h * 64 + vh * 32) * 4 + (lane & 7) * 16), (LAS unsigned*)(buf + 5 * CH * 256 + lw * 1024), 16, 0, 0); }
            };
            auto prep = [&](int c) {
                char* buf = lds + (c % 3) * BUFB;
#pragma unroll
                for (int ps = 0; ps < 2; ++ps) { const int ptok = lw * 8 + ps * 4 + (lane >> 4);
                    f32x4* kp = (f32x4*)(buf + 1 * CH * 256 + ptok * 256 + pq * 16); f32x4* ap = (f32x4*)(buf + 2 * CH * 256 + ptok * 256 + pq * 16); f32x4* dp = (f32x4*)(buf + 4 * CH * 256 + ptok * 256 + pq * 16);
                    f32x4* rp = (f32x4*)(buf + 3 * CH * 256 + ptok * 256 + pq * 16); const f32x4 wv = *(const f32x4*)(buf + ptok * 256 + pq * 16);
                    const f32x4 k = *kp, a = *ap, r = *rp; f32x4 kk = k * kkv;
                    float ss = kk[0] * kk[0] + kk[1] * kk[1] + kk[2] * kk[2] + kk[3] * kk[3]; ss = dpp_sum16(ss);
                    const float inv = 1.f / fmaxf(sqrtf(ss), 1e-12f); kk = kk * inv;
                    const f32x4 kd = k * (1.f + (a - 1.f) * kav), bb = kk * a;
                    const f32x4 t1 = bb * r, t2 = kd * r;
                    const float br = dpp_sum16((t1[0] + t1[1]) + (t1[2] + t1[3])), kr = dpp_sum16((t2[0] + t2[1]) + (t2[2] + t2[3]));
                    *dp = kd; *ap = bb; *kp = kk; *rp = wv * r;
                    if (pq == 0) *(float2*)(buf + 5 * CH * 256 + CH * 128 + ptok * 16) = make_float2(br, kr); }
            };
            issue(0); issue(1);
            asm volatile("s_waitcnt vmcnt(9)" ::: "memory");
            prep(0);
            asm volatile("s_waitcnt lgkmcnt(0)" ::: "memory"); __builtin_amdgcn_s_barrier();
            for (int c = 0; c < NCH; ++c) {
                if (c >= 1) { const float* yb = (const float*)(lds + 3 * BUFB + ((c - 1) & 1) * YB);
                    const int lt = tid - 256, t = lt >> 3, q = lt & 7; const int row = scan_row((c - 1) * CH + t, b, z);
                    *(f32x4*)(yout + (size_t)row * D + h * 64 + vh * 32 + q * 4) = *(const f32x4*)(yb + t * 32 + q * 4); }
                if (c + 2 < NCH) { issue(c + 2); asm volatile("s_waitcnt vmcnt(9)" ::: "memory"); } else asm volatile("s_waitcnt vmcnt(0)" ::: "memory");
                if (c + 1 < NCH) prep(c + 1);
                asm volatile("s_waitcnt lgkmcnt(0)" ::: "memory"); __builtin_amdgcn_s_barrier();
            }
            { const float* yb = (const float*)(lds + 3 * BUFB + ((NCH - 1) & 1) * YB);
              const int lt = tid - 256, t = lt >> 3, q = lt & 7; const int row = scan_row((NCH - 1) * CH + t, b, z);
              *(f32x4*)(yout + (size_t)row * D + h * 64 + vh * 32 + q * 4) = *(const f32x4*)(yb + t * 32 + q * 4); }
        } else {
            const int vr = lane >> 3, ks = lane & 7;
            f32x4 Sa = {0.f, 0.f, 0.f, 0.f}, Sb = {0.f, 0.f, 0.f, 0.f};
            __builtin_amdgcn_s_barrier();
            struct Ops { f32x4 w0, w1, kk0, kk1, bb0, bb1, r0, r1, kd0, kd1; float v; float2 sc; };
#define SC_LOAD(O, t) do { const char* q_ = bq + (t) * 256; O.w0 = *(const f32x4*)(q_); O.w1 = *(const f32x4*)(q_ + 16); O.kk0 = *(const f32x4*)(q_ + CH * 256); O.kk1 = *(const f32x4*)(q_ + CH * 256 + 16); \
                O.bb0 = *(const f32x4*)(q_ + 2 * CH * 256); O.bb1 = *(const f32x4*)(q_ + 2 * CH * 256 + 16); O.r0 = *(const f32x4*)(q_ + 3 * CH * 256); O.r1 = *(const f32x4*)(q_ + 3 * CH * 256 + 16); \
                O.kd0 = *(const f32x4*)(q_ + 4 * CH * 256); O.kd1 = *(const f32x4*)(q_ + 4 * CH * 256 + 16); O.v = *(const float*)(vq + (t) * 128); O.sc = *(const float2*)(buf + 5 * CH * 256 + CH * 128 + (t) * 16); } while (0)
#define SC_STEP(O, t) do { const f32x4 d1 = Sa * O.kk0 + Sb * O.kk1, d2 = Sa * O.r0 + Sb * O.r1; \
                float sa = -((d1[0] + d1[1]) + (d1[2] + d1[3])), yy = (d2[0] + d2[1]) + (d2[2] + d2[3]); \
                sa = dpp_sum8(sa); yy = dpp_sum8(yy); \
                Sa = Sa * O.w0 + (sa * O.bb0 + O.v * O.kd0); Sb = Sb * O.w1 + (sa * O.bb1 + O.v * O.kd1); \
                if (ks == 0) yb[(t) * 32 + wid * 8 + vr] = yy + sa * O.sc.x + O.v * O.sc.y; } while (0)
            for (int c = 0; c < NCH; ++c) {
                const char* buf = lds + (c % 3) * BUFB; float* yb = (float*)(lds + 3 * BUFB + (c & 1) * YB);
                const char* bq = buf + ks * 32; const char* vq = buf + 5 * CH * 256 + (wid * 8 + vr) * 4;
                Ops oA, oB, oC;
                SC_LOAD(oA, 0); SC_LOAD(oB, 1);
#pragma unroll
                for (int t = 0; t < CH; t += 3) {
                    if (t + 2 < CH) SC_LOAD(oC, t + 2);
                    SC_STEP(oA, t);
                    if (t + 3 < CH) SC_LOAD(oA, t + 3);
                    if (t + 1 < CH) SC_STEP(oB, t + 1);
                    if (t + 4 < CH) SC_LOAD(oB, t + 4);
                    if (t + 2 < CH) SC_STEP(oC, t + 2);
                }
                asm volatile("s_waitcnt lgkmcnt(0)" ::: "memory"); __builtin_amdgcn_s_barrier();
            }
#undef SC_LOAD
#undef SC_STEP
        }
    }
}


namespace ck {
constexpr int P = 72, MB = 64 * P * 2;
typedef __attribute__((address_space(3))) char lchar;
__device__ __forceinline__ f32x4 mm_tile(const lchar* Aop, const lchar* Bop, int ti, int tj, int c, int q, f32x4 acc) {
#pragma unroll
    for (int ks = 0; ks < 2; ++ks) {
        const bf16x8 a = *(const LAS bf16x8*)(Aop + ((16 * ti + c) * P + 32 * ks + 8 * q) * 2);
        const bf16x8 b = *(const LAS bf16x8*)(Bop + ((16 * tj + c) * P + 32 * ks + 8 * q) * 2);
        acc = __builtin_amdgcn_mfma_f32_16x16x32_bf16(a, b, acc, 0, 0, 0);
    }
    return acc;
}
__device__ __forceinline__ f32x4 mm_diag(const lchar* Aop, const lchar* Bop, int tt, int c, int q, f32x4 acc) {
    const int ks = tt >> 1;
    bf16x8 a = *(const LAS bf16x8*)(Aop + ((16 * tt + c) * P + 32 * ks + 8 * q) * 2);
    const bf16x8 b = *(const LAS bf16x8*)(Bop + ((16 * tt + c) * P + 32 * ks + 8 * q) * 2);
    if ((q >> 1) != (tt & 1)) a = (bf16x8){0, 0, 0, 0, 0, 0, 0, 0};
    return __builtin_amdgcn_mfma_f32_16x16x32_bf16(a, b, acc, 0, 0, 0);
}
__device__ __forceinline__ void st_tile(lchar* dst, int ti, int tj, int c, int q, f32x4 v) {
    u32x2 w; w.x = pk2(v[0], v[1]); w.y = pk2(v[2], v[3]); *(LAS u32x2*)(dst + ((16 * tj + c) * P + 16 * ti + 4 * q) * 2) = w;
}
__device__ __forceinline__ f32x4 ld_tile(const lchar* src, int ti, int tj, int c, int q) {
    const u32x2 w = *(const LAS u32x2*)(src + ((16 * tj + c) * P + 16 * ti + 4 * q) * 2);
    return (f32x4){__uint_as_float(w.x << 16), __uint_as_float(w.x & 0xffff0000u), __uint_as_float(w.y << 16), __uint_as_float(w.y & 0xffff0000u)};
}
__device__ __forceinline__ void st_glob(bf16_t* dst, int ti, int tj, int c, int q, f32x4 v) {
    uint2 w; w.x = pk2(v[0], v[1]); w.y = pk2(v[2], v[3]); *(uint2*)(dst + (16 * tj + c) * 64 + 16 * ti + 4 * q) = w;
}
typedef float f32x16 __attribute__((ext_vector_type(16)));
__device__ __forceinline__ f32x16 mm32(const lchar* Aop, const lchar* Bop, int ti, int tj, int r32, int hi, f32x16 acc) {
#pragma unroll
    for (int ks = 0; ks < 4; ++ks) {
        const bf16x8 a = *(const LAS bf16x8*)(Aop + ((32 * ti + r32) * P + 16 * ks + 8 * hi) * 2);
        const bf16x8 b = *(const LAS bf16x8*)(Bop + ((32 * tj + r32) * P + 16 * ks + 8 * hi) * 2);
        acc = __builtin_amdgcn_mfma_f32_32x32x16_bf16(a, b, acc, 0, 0, 0);
    }
    return acc;
}
__device__ __forceinline__ void st32(lchar* dst, int ti, int tj, int r32, int hi, const f32x16& v) {
#pragma unroll
    for (int g = 0; g < 4; ++g) { u32x2 w; w.x = pk2(v[4 * g], v[4 * g + 1]); w.y = pk2(v[4 * g + 2], v[4 * g + 3]); *(LAS u32x2*)(dst + ((32 * tj + r32) * P + 32 * ti + 8 * g + 4 * hi) * 2) = w; }
}
__device__ __forceinline__ f32x16 ld32(const lchar* src, int ti, int tj, int r32, int hi) {
    f32x16 v;
#pragma unroll
    for (int g = 0; g < 4; ++g) { const u32x2 w = *(const LAS u32x2*)(src + ((32 * tj + r32) * P + 32 * ti + 8 * g + 4 * hi) * 2);
        v[4 * g] = __uint_as_float(w.x << 16); v[4 * g + 1] = __uint_as_float(w.x & 0xffff0000u); v[4 * g + 2] = __uint_as_float(w.y << 16); v[4 * g + 3] = __uint_as_float(w.y & 0xffff0000u); }
    return v;
}
__device__ __forceinline__ void stg32(bf16_t* dst, int ti, int tj, int r32, int hi, const f32x16& v) {
#pragma unroll
    for (int g = 0; g < 4; ++g) { uint2 w; w.x = pk2(v[4 * g], v[4 * g + 1]); w.y = pk2(v[4 * g + 2], v[4 * g + 3]); *(uint2*)(dst + (32 * tj + r32) * 64 + 32 * ti + 8 * g + 4 * hi) = w; }
}
}

#define LBAR() do { asm volatile("s_waitcnt lgkmcnt(0)" ::: "memory"); __builtin_amdgcn_s_barrier(); asm volatile("" ::: "memory"); } while (0)
__device__ void ph_rw_sc1(const Params& p, int j, char* lds) {
    using namespace ck;
    const int tid = tidx(), wid = __builtin_amdgcn_readfirstlane(tid >> 6), lane = tid & 63, c = lane & 15, q = lane >> 4;
    const size_t PL = (size_t)NROW * D;
    const bf16_t* RKV = (const bf16_t*)(p.ws + OFF_RKV); const float* LW = (const float*)(p.ws + OFF_W); const bf16_t* AV = (const bf16_t*)(p.ws + OFF_AV);
    bf16_t* CK = (bf16_t*)(p.ws + OFF_CK);
    lchar* B0 = (lchar*)lds;
#define BUF(i) (B0 + (i) * MB)
    LAS float* Lbuf = (LAS float*)BUF(8);
    LAS float* Lseg = (LAS float*)(B0 + 16 * MB);
    LAS float* GC = Lseg + 8 * 64;
    const int pt = tid >> 3, cg = tid & 7;
    f32x4 nlw[2], nkk[2], nka[2]; u32x4 nkx, nax, nrx, nvx;
#define SC1_LOAD(IT) do { const int seq_ = (IT) / NCHK, ch_ = (IT) % NCHK; const int z_ = seq_ & 1, h_ = (seq_ >> 1) & 15, b_ = seq_ >> 5; \
        const size_t go_ = (size_t)scan_row(ch_ * 64 + pt, b_, z_) * D + h_ * 64 + cg * 8; \
        _Pragma("unroll") for (int e = 0; e < 2; ++e) nlw[e] = *(const f32x4*)(LW + z_ * PL + go_ + 4 * e); \
        nkx = *(const u32x4*)(RKV + PL + go_); nax = *(const u32x4*)(AV + z_ * PL + go_); nrx = *(const u32x4*)(RKV + go_); nvx = *(const u32x4*)(RKV + 2 * PL + go_); \
        _Pragma("unroll") for (int e = 0; e < 2; ++e) { nkk[e] = *(const f32x4*)(p.rw_k_k + j * D + h_ * 64 + cg * 8 + 4 * e); nka[e] = *(const f32x4*)(p.rw_k_a + j * D + h_ * 64 + cg * 8 + 4 * e); } } while (0)
    if (bidx() < 128 * NCHK) SC1_LOAD(bidx());
    for (int it = bidx(); it < 128 * NCHK; it += gdim()) {
        const int seq = it / NCHK; const int h = (seq >> 1) & 15;
        f32x4 lw[2], kx[2], ax[2], rx[2], vx[2], kkc[2], kac[2];
#pragma unroll
        for (int e = 0; e < 2; ++e) { lw[e] = nlw[e]; kkc[e] = nkk[e]; kac[e] = nka[e];
            kx[e] = (f32x4){__uint_as_float(nkx[2 * e] << 16), __uint_as_float(nkx[2 * e] & 0xffff0000u), __uint_as_float(nkx[2 * e + 1] << 16), __uint_as_float(nkx[2 * e + 1] & 0xffff0000u)};
            ax[e] = (f32x4){__uint_as_float(nax[2 * e] << 16), __uint_as_float(nax[2 * e] & 0xffff0000u), __uint_as_float(nax[2 * e + 1] << 16), __uint_as_float(nax[2 * e + 1] & 0xffff0000u)};
            rx[e] = (f32x4){__uint_as_float(nrx[2 * e] << 16), __uint_as_float(nrx[2 * e] & 0xffff0000u), __uint_as_float(nrx[2 * e + 1] << 16), __uint_as_float(nrx[2 * e + 1] & 0xffff0000u)};
            vx[e] = (f32x4){__uint_as_float(nvx[2 * e] << 16), __uint_as_float(nvx[2 * e] & 0xffff0000u), __uint_as_float(nvx[2 * e + 1] << 16), __uint_as_float(nvx[2 * e + 1] & 0xffff0000u)}; }
        if (it + gdim() < 128 * NCHK) SC1_LOAD(it + gdim());
        LBAR();
#pragma unroll
        for (int e = 0; e < 2; ++e) *(LAS f32x4*)(Lbuf + pt * 64 + cg * 8 + 4 * e) = lw[e];
        f32x4 kk[2], bq[2], kd[2];
        { float ss = 0.f;
#pragma unroll
          for (int e = 0; e < 2; ++e) { kk[e] = kx[e] * kkc[e]; ss += kk[e][0] * kk[e][0] + kk[e][1] * kk[e][1] + kk[e][2] * kk[e][2] + kk[e][3] * kk[e][3]; }
          ss = dpp_sum8(ss); const float inv = __builtin_amdgcn_rsqf(fmaxf(ss, 1e-24f));
#pragma unroll
          for (int e = 0; e < 2; ++e) { kk[e] = kk[e] * inv; bq[e] = kk[e] * ax[e]; kd[e] = kx[e] * (1.f + (ax[e] - 1.f) * kac[e]); } }
        LBAR();
        { const int k = tid & 63, sg = tid >> 6; float run = 0.f;
#pragma unroll
          for (int u = 0; u < 8; ++u) { run += Lbuf[(sg * 8 + u) * 64 + k]; Lbuf[(sg * 8 + u) * 64 + k] = run; }
          Lseg[sg * 64 + k] = run; }
        LBAR();
        f32x4 Lt[2], Lp[2], Lc[2];
        { const int sg = pt >> 3, sgp = (pt - 1) >> 3;
#pragma unroll
          for (int e = 0; e < 2; ++e) { f32x4 o0 = {0.f, 0.f, 0.f, 0.f}, o1 = o0, oc = o0;
#pragma unroll
              for (int u = 0; u < 8; ++u) { const f32x4 sv = *(const LAS f32x4*)(Lseg + u * 64 + cg * 8 + 4 * e); if (u < sg) o0 = o0 + sv; if (u < sgp) o1 = o1 + sv; if (u < 7) oc = oc + sv; }
              Lt[e] = *(const LAS f32x4*)(Lbuf + pt * 64 + cg * 8 + 4 * e) + o0;
              Lp[e] = pt > 0 ? *(const LAS f32x4*)(Lbuf + (pt - 1) * 64 + cg * 8 + 4 * e) + o1 : (f32x4){0.f, 0.f, 0.f, 0.f};
              Lc[e] = *(const LAS f32x4*)(Lbuf + 63 * 64 + cg * 8 + 4 * e) + oc; } }
        LBAR();
        {
            float at[8], bt[8], kt[8], rt[8], bh[8], kh[8], vv[8];
#pragma unroll
            for (int e = 0; e < 2; ++e)
#pragma unroll
                for (int u = 0; u < 4; ++u) { const int x = 4 * e + u; const float eL = __expf(Lt[e][u]), emL = __expf(-Lt[e][u]), eP = __expf(Lp[e][u]), eC = __expf(Lc[e][u] - Lt[e][u]);
                    at[x] = -kk[e][u] * eP; bt[x] = bq[e][u] * emL; kt[x] = kd[e][u] * emL; rt[x] = rx[e][u] * eL; bh[x] = bq[e][u] * eC; kh[x] = kd[e][u] * eC; vv[x] = vx[e][u];
                    if (pt == 63) GC[cg * 8 + x] = eL; }
#define ST8(bufi, arr) do { u32x4 w_ = {pk2(arr[0], arr[1]), pk2(arr[2], arr[3]), pk2(arr[4], arr[5]), pk2(arr[6], arr[7])}; *(LAS u32x4*)(BUF(bufi) + (pt * P + cg * 8) * 2) = w_; } while (0)
            ST8(0, at); ST8(1, bt); ST8(2, kt); ST8(3, rt); ST8(8, bh); ST8(9, kh); ST8(10, vv);
#undef ST8
        }
        LBAR();
        {
            const int k = tid & 63, tg = tid >> 6;
#define TR8(src, dst) do { unsigned w_[4]; _Pragma("unroll") for (int x = 0; x < 4; ++x) { const unsigned lo = *(const LAS bf16_t*)(BUF(src) + ((tg * 8 + 2 * x) * P + k) * 2), hi2 = *(const LAS bf16_t*)(BUF(src) + ((tg * 8 + 2 * x + 1) * P + k) * 2); w_[x] = lo | (hi2 << 16); } \
                *(LAS u32x4*)(BUF(dst) + (k * P + tg * 8) * 2) = (u32x4){w_[0], w_[1], w_[2], w_[3]}; } while (0)
            TR8(0, 4); TR8(8, 5); TR8(9, 6); TR8(10, 7);
#undef TR8
        }
        LBAR();
        const f32x4 Z4 = {0.f, 0.f, 0.f, 0.f};
        const f32x16 Z16 = {0.f, 0.f, 0.f, 0.f, 0.f, 0.f, 0.f, 0.f, 0.f, 0.f, 0.f, 0.f, 0.f, 0.f, 0.f, 0.f};
        const int r32 = lane & 31, hi = lane >> 5;
#pragma unroll 1
        for (int u = 0; u < 3; ++u) { const int tl = u * 8 + wid; if (tl >= 20) break; const int m = tl >> 2, ti = (tl >> 1) & 1, tj = tl & 1; const int jj = 32 * tj + r32;
            if (m == 0) { f32x16 v = mm32(BUF(0), BUF(1), ti, tj, r32, hi, Z16), w;
#pragma unroll
                for (int e = 0; e < 16; ++e) { const int ii = 32 * ti + 8 * (e >> 2) + 4 * hi + (e & 3); const bool dg = (ii >> 4) == (jj >> 4);
                    v[e] = (dg && jj < ii) ? v[e] : 0.f; w[e] = v[e] + ((ii == jj) ? 1.f : 0.f); }
                st32(BUF(8), ti, tj, r32, hi, v); st32(BUF(14), ti, tj, r32, hi, w); }
            else if (m == 1) { const f32x16 v = mm32(BUF(1), BUF(0), ti, tj, r32, hi, Z16); f32x16 vd, vo, w;
#pragma unroll
                for (int e = 0; e < 16; ++e) { const int ii = 32 * ti + 8 * (e >> 2) + 4 * hi + (e & 3); const bool dg = (ii >> 4) == (jj >> 4), up = ii < jj;
                    vd[e] = (dg && up) ? v[e] : 0.f; vo[e] = (!dg && up) ? v[e] : 0.f; w[e] = vd[e] + ((ii == jj) ? 1.f : 0.f); }
                st32(BUF(9), ti, tj, r32, hi, vd); st32(BUF(15), ti, tj, r32, hi, vo); st32(BUF(13), ti, tj, r32, hi, w); }
            else if (m == 2) { f32x16 v = mm32(BUF(2), BUF(0), ti, tj, r32, hi, Z16);
#pragma unroll
                for (int e = 0; e < 16; ++e) { const int ii = 32 * ti + 8 * (e >> 2) + 4 * hi + (e & 3); v[e] = ii < jj ? v[e] : 0.f; }
                st32(BUF(10), ti, tj, r32, hi, v); }
            else { f32x16 v = mm32(m == 3 ? BUF(1) : BUF(2), BUF(3), ti, tj, r32, hi, Z16);
#pragma unroll
                for (int e = 0; e < 16; ++e) { const int ii = 32 * ti + 8 * (e >> 2) + 4 * hi + (e & 3); v[e] = ii <= jj ? v[e] : 0.f; }
                st32(m == 3 ? BUF(11) : BUF(12), ti, tj, r32, hi, v); } }
        LBAR();
#define WSYNC() asm volatile("s_waitcnt lgkmcnt(0)" ::: "memory")
        if (wid < 4) {
            const int tt = wid;
#define SQD(sr, st, dr, dt) do { const f32x4 a_ = mm_diag(BUF(st), BUF(sr), tt, c, q, Z4), b_ = mm_diag(BUF(sr), BUF(st), tt, c, q, Z4); WSYNC(); \
                st_tile(BUF(dr), tt, tt, c, q, a_); st_tile(BUF(dt), tt, tt, c, q, b_); WSYNC(); } while (0)
#define UPD(pr) do { const f32x4 dt_ = mm_diag(BUF(pr), BUF(13), tt, c, q, ld_tile(BUF(13), tt, tt, c, q)); \
                const f32x4 dr_ = mm_diag(BUF(13), BUF(pr), tt, c, q, ld_tile(BUF(14), tt, tt, c, q)); WSYNC(); \
                st_tile(BUF(13), tt, tt, c, q, dt_); st_tile(BUF(14), tt, tt, c, q, dr_); WSYNC(); } while (0)
            SQD(8, 9, 0, 1); UPD(0); SQD(0, 1, 8, 9); UPD(8); SQD(8, 9, 0, 1); UPD(0);
#undef SQD
#undef UPD
        } else {
            const int ti = (wid >> 1) & 1, tj = wid & 1; st32(BUF(2), ti, tj, r32, hi, mm32(BUF(10), BUF(7), ti, tj, r32, hi, Z16));
        }
        LBAR();
        { const int m = wid >> 2, ti = (wid >> 1) & 1, tj = wid & 1;
          if (m == 0) st32(BUF(8), ti, tj, r32, hi, mm32(BUF(15), BUF(14), ti, tj, r32, hi, Z16));
          else        st32(BUF(9), ti, tj, r32, hi, mm32(BUF(14), BUF(15), ti, tj, r32, hi, Z16)); }
        LBAR();
        if (wid < 4) { const int ti = (wid >> 1) & 1, tj = wid & 1; st32(BUF(0), ti, tj, r32, hi, mm32(BUF(9), BUF(8), ti, tj, r32, hi, Z16)); }
        LBAR();
        if (wid < 4) { const int ti = (wid >> 1) & 1, tj = wid & 1; st32(BUF(1), ti, tj, r32, hi, mm32(BUF(0), BUF(13), ti, tj, r32, hi, ld32(BUF(13), ti, tj, r32, hi))); }
        LBAR();
        if (wid < 4) { const int ti = (wid >> 1) & 1, tj = wid & 1; st32(BUF(14), ti, tj, r32, hi, mm32(BUF(8), BUF(1), ti, tj, r32, hi, ld32(BUF(1), ti, tj, r32, hi))); }
        LBAR();
        { const int m = wid >> 2, ti = (wid >> 1) & 1, tj = wid & 1;
          if (m == 0) st32(BUF(8), ti, tj, r32, hi, mm32(BUF(14), BUF(4), ti, tj, r32, hi, Z16));
          else        st32(BUF(0), ti, tj, r32, hi, mm32(BUF(14), BUF(2), ti, tj, r32, hi, Z16)); }
        LBAR();
        bf16_t* ckp = CK + (size_t)it * 4 * 4096;
#pragma unroll 1
        for (int u = 0; u < 2; ++u) { const int tl = u * 8 + wid, m = tl >> 2, ti = (tl >> 1) & 1, tj = tl & 1;
            if (m == 0) { f32x16 v = mm32(BUF(8), BUF(5), ti, tj, r32, hi, Z16); const int jj = 32 * tj + r32; const float gc = GC[jj];
#pragma unroll
                for (int e = 0; e < 16; ++e) { const int ii = 32 * ti + 8 * (e >> 2) + 4 * hi + (e & 3); v[e] += (ii == jj) ? gc : 0.f; }
                st32(BUF(1), ti, tj, r32, hi, v); }
            else if (m == 1) st32(BUF(4), ti, tj, r32, hi, mm32(BUF(8), BUF(11), ti, tj, r32, hi, ld32(BUF(3), ti, tj, r32, hi)));
            else if (m == 2) st32(BUF(2), ti, tj, r32, hi, mm32(BUF(6), BUF(7), ti, tj, r32, hi, mm32(BUF(5), BUF(0), ti, tj, r32, hi, Z16)));
            else             st32(BUF(9), ti, tj, r32, hi, mm32(BUF(7), BUF(12), ti, tj, r32, hi, mm32(BUF(0), BUF(11), ti, tj, r32, hi, Z16))); }
        LBAR();
        { const int orow = tid >> 3, oc = (tid & 7) * 8;
          *(u32x4*)(ckp + orow * 64 + oc) = *(const LAS u32x4*)(BUF(1) + (orow * P + oc) * 2);
          *(u32x4*)(ckp + 4096 + orow * 64 + oc) = *(const LAS u32x4*)(BUF(2) + (orow * P + oc) * 2);
          *(u32x4*)(ckp + 2 * 4096 + orow * 64 + oc) = *(const LAS u32x4*)(BUF(4) + (orow * P + oc) * 2);
          *(u32x4*)(ckp + 3 * 4096 + orow * 64 + oc) = *(const LAS u32x4*)(BUF(9) + (orow * P + oc) * 2); }
    }
#undef BUF
#undef SC1_LOAD
}

__device__ void ph_rw_sc2(const Params& p, char* lds) {
    using namespace ck;
    const int tid = tidx(), wid = __builtin_amdgcn_readfirstlane(tid >> 6), lane = tid & 63, c = lane & 15, q = lane >> 4;
    const size_t PL = (size_t)NROW * D;
    const bf16_t* CK = (const bf16_t*)(p.ws + OFF_CK); bf16_t* Y = (bf16_t*)(p.ws + OFF_Y);
    lchar* GB = (lchar*)lds;
    lchar* RB = GB + 2 * MB;
    lchar* SB = GB + 4 * MB;
    constexpr int SBB = 32 * P * 2;
    for (int it = bidx(); it < 256; it += gdim()) {
        const int vh = it & 1, seq = it >> 1, z = seq & 1, h = (seq >> 1) & 15, b = seq >> 5;
        const bf16_t* ck0 = CK + (size_t)seq * NCHK * 4 * 4096;
        const int s_ti = wid & 3, s_tj = wid >> 2;
        const int y_ti = wid & 1, y_tj = wid >> 1;
        const int hoff = 4096 + (vh * 32 + 16 * s_tj + c) * 64 + 16 * s_ti + 4 * q, yoff = 3 * 4096 + (16 * y_tj + c) * 64 + vh * 32 + 16 * y_ti + 4 * q;
        struct PF { u32x4 g, r; uint2 h, y; };
#define PF_LOAD(X, k) do { const bf16_t* cc_ = ck0 + (size_t)(k) * 4 * 4096; X.h = *(const uint2*)(cc_ + hoff); X.y = *(const uint2*)(cc_ + yoff); X.g = *(const u32x4*)(cc_ + tid * 8); X.r = *(const u32x4*)(cc_ + 2 * 4096 + tid * 8); } while (0)
#define PF_STAGE(X, bufi) do { *(LAS u32x4*)(GB + (bufi) * MB + ((tid >> 3) * P + (tid & 7) * 8) * 2) = X.g; *(LAS u32x4*)(RB + (bufi) * MB + ((tid >> 3) * P + (tid & 7) * 8) * 2) = X.r; } while (0)
#define SC2_STEP(k, CUR, NXT) do { const uint2 hi_ = CUR.h, yi_ = CUR.y; const int cur = (k) & 1; \
            if ((k) + 4 < NCHK) PF_LOAD(CUR, (k) + 4); \
            const f32x4 hinit = {__uint_as_float(hi_.x << 16), __uint_as_float(hi_.x & 0xffff0000u), __uint_as_float(hi_.y << 16), __uint_as_float(hi_.y & 0xffff0000u)}; \
            const f32x4 yinit = {__uint_as_float(yi_.x << 16), __uint_as_float(yi_.x & 0xffff0000u), __uint_as_float(yi_.y << 16), __uint_as_float(yi_.y & 0xffff0000u)}; \
            const lchar* Sold = SB + cur * SBB; lchar* Snew = SB + (cur ^ 1) * SBB; \
            const f32x4 sn = mm_tile(GB + cur * MB, Sold, s_ti, s_tj, c, q, hinit);        \
            const f32x4 yv = mm_tile(Sold, RB + cur * MB, y_ti, y_tj, c, q, yinit);        \
            st_tile(Snew, s_ti, s_tj, c, q, sn); \
            { const int row = scan_row((k) * 64 + 16 * y_tj + c, b, z); stbf4(Y + z * PL + (size_t)row * D + h * 64 + vh * 32 + 16 * y_ti + 4 * q, yv); } \
            if ((k) + 1 < NCHK) PF_STAGE(NXT, cur ^ 1); \
            LBAR(); } while (0)
        PF s0, s1, s2, s3;
        PF_LOAD(s0, 0); PF_LOAD(s1, 1); PF_LOAD(s2, 2); PF_LOAD(s3, 3);
        LBAR();
        for (int i = tid; i < SBB / 4; i += NTHR) ((LAS unsigned*)SB)[i] = 0u;
        PF_STAGE(s0, 0);
        LBAR();
        for (int ch = 0; ch < NCHK; ch += 4) {
            SC2_STEP(ch, s0, s1); SC2_STEP(ch + 1, s1, s2); SC2_STEP(ch + 2, s2, s3); SC2_STEP(ch + 3, s3, s0);
        }
#undef PF_LOAD
#undef PF_STAGE
#undef SC2_STEP
    }
}
#undef LBAR

__device__ void ph_rw_out(const Params& p, int j, int nrows) {
    const int wid = tidx() >> 6, lane = tidx() & 63;
    const bf16_t* RKV = (const bf16_t*)(p.ws + OFF_RKV); const bf16_t* AV = (const bf16_t*)(p.ws + OFF_AV); const bf16_t* G = (const bf16_t*)(p.ws + OFF_G); const bf16_t* Y = (const bf16_t*)(p.ws + OFF_Y);
    bf16_t* OUT = (bf16_t*)(p.ws + OFF_H);
    const size_t PL = (size_t)NROW * D;
    const float* r_k = p.rw_r_k + j * D; const float* lg = p.rw_lnx_g + j * D; const float* lb = p.rw_lnx_b + j * D; const float* k_a = p.rw_k_a + j * D;
    for (int row = bidx() * 8 + wid; row < nrows; row += gdim() * 8) {
#pragma unroll
        for (int i = 0; i < 4; ++i) {
            const size_t o = (size_t)row * D + lane * 4 + i * 256; const int c = lane * 4 + i * 256;
            const f32x4 y = ldbf4(Y + o) + ldbf4(Y + PL + o);
            const float mean = dpp_sum16(y[0] + y[1] + y[2] + y[3]) * (1.f / 64.f);
            const f32x4 dd = y - mean;
            const float rstd = rsqrtf(dpp_sum16(dd[0] * dd[0] + dd[1] * dd[1] + dd[2] * dd[2] + dd[3] * dd[3]) * (1.f / 64.f) + LNX_EPS);
            const f32x4 r = ldbf4(RKV + o), k = ldbf4(RKV + PL + o), v = ldbf4(RKV + 2 * PL + o);
            const f32x4 a0 = ldbf4(AV + o), a1 = ldbf4(AV + PL + o);
            const f32x4 kds = k * (2.f + (a0 + a1 - 2.f) * *(const f32x4*)(k_a + c));
            const f32x4 t4 = r * kds * *(const f32x4*)(r_k + c);
            const float bs = dpp_sum16(t4[0] + t4[1] + t4[2] + t4[3]);
            const f32x4 res = (dd * rstd * *(const f32x4*)(lg + c) + *(const f32x4*)(lb + c) + bs * v) * ldbf4(G + o);
            uint2 w; w.x = pk2(res[0], res[1]); w.y = pk2(res[2], res[3]); *(uint2*)(OUT + o) = w;
        }
    }
}

__device__ void ph_final(const Params& p) {
    const int wid = tidx() >> 6, lane = tidx() & 63;
    const float* X = (const float*)(p.ws + OFF_X);
    for (int row = bidx() * 8 + wid; row < NLAT; row += gdim() * 8) {
        const float4* xr = (const float4*)(X + (size_t)row * D);
        float4 v[4]; float ss = 0;
#pragma unroll
        for (int i = 0; i < 4; ++i) { v[i] = xr[lane + i * 64]; ss += v[i].x * v[i].x + v[i].y * v[i].y + v[i].z * v[i].z + v[i].w * v[i].w; }
        ss = wave_sum(ss); const float rs = rsqrtf(ss * (1.f / D) + RMS_EPS);
#pragma unroll
        for (int i = 0; i < 4; ++i) { const int d = (lane + i * 64) * 4; const float4 gg = *(const float4*)(p.final_g + d);
            float4 o; o.x = v[i].x * rs * gg.x; o.y = v[i].y * rs * gg.y; o.z = v[i].z * rs * gg.z; o.w = v[i].w * rs * gg.w;
            *(float4*)(p.out + (size_t)row * D + d) = o; }
    }
}

enum { PH_INIT = 0, PH_A_NORM, PH_A_Z, PH_A_MID, PH_A_QKV, PH_A_POST, PH_A_ATTN, PH_A_WO,
       PH_R_NORM, PH_R_XS, PH_R_G1, PH_R_G2, PH_R_PREP, PH_R_SCAN, PH_R_OUT, PH_R_WO,
       PH_M_NORM, PH_M_SEL, PH_M_GATHER, PH_M_G1, PH_M_G2, PH_M_COMB, PH_FINAL, PH_M_CVT, PH_R_SC1, PH_R_SC2 };

template <int PH>
__device__ __forceinline__ void run_phase(const Params& p, int layer, char* lds) {
    const int j = layer >> 1;
    char* ws = p.ws;
    if constexpr (PH == PH_INIT) { ph_init(p, lds); __syncthreads(); ph_small_cvt(p, lds); }
    else if constexpr (PH == PH_A_NORM) ph_norm_mod<false>(p, layer, p.norm1_g + layer * D, 0, 1, ws + OFF_H);
    else if constexpr (PH == PH_A_Z) {
        float* Z = (float*)(ws + OFF_Z);
        g8::BatchSched S{ws + OFF_H, ws + OFF_WMLA + j * SZ_WMLA + WM_IN, 0, 0, NROW / 256, 2, 1, D};
        g8::gemm_phase(p.wv, (PG8_LAS unsigned char*)lds, D, S, g8::epi_rc([=](const g8::Unit&, int row, int col, f32x4 v) { *(f32x4*)(Z + (size_t)row * 512 + col) = v; }));
    }
    else if constexpr (PH == PH_A_MID) ph_mla_mid(p, j);
    else if constexpr (PH == PH_A_QKV) {
        bf16_t* Q = (bf16_t*)(ws + OFF_Q); bf16_t* K = (bf16_t*)(ws + OFF_K); bf16_t* V = (bf16_t*)(ws + OFF_V);
        g8::BatchSched S1{ws + OFF_CQN, ws + OFF_WMLA + j * SZ_WMLA + WM_UQ, 0, 0, NROW / 256, 6, 1, 256};
        g8::gemm_phase(p.wv, (PG8_LAS unsigned char*)lds, 256, S1, g8::epi_rc([=](const g8::Unit&, int row, int col, f32x4 v) {
            const bool lat = row < NLAT; const int b = lat ? (row >> 12) : ((row - NLAT) >> 8); const int tk = lat ? 256 + (row & (TL - 1)) : ((row - NLAT) & 255);
            const int h = col / 192, d = col - h * 192;
            uint2 w; w.x = pk2(v[0], v[1]); w.y = pk2(v[2], v[3]);
            *(uint2*)(Q + ((size_t)(b * 8 + h) * TK + tk) * 192 + d) = w; }));
        g8::BatchSched S2{ws + OFF_CKVN, ws + OFF_WMLA + j * SZ_WMLA + WM_UKV, 0, 0, NROW / 256, 8, 1, 256};
        g8::gemm_phase(p.wv, (PG8_LAS unsigned char*)lds, 256, S2, g8::epi_rc([=](const g8::Unit&, int row, int col, f32x4 v) {
            const bool lat = row < NLAT; const int b = lat ? (row >> 12) : ((row - NLAT) >> 8); const int tk = lat ? 256 + (row & (TL - 1)) : ((row - NLAT) & 255);
            const int h = col >> 8, d = col & 255; const size_t orow = (size_t)(b * 8 + h) * TK + tk;
            uint2 w; w.x = pk2(v[0], v[1]); w.y = pk2(v[2], v[3]);
            if (d < 128) *(uint2*)(K + orow * 192 + d) = w; else *(uint2*)(V + orow * 128 + (d - 128)) = w; }));
    }
    else if constexpr (PH == PH_A_ATTN) ph_attn(p, lds);
    else if constexpr (PH == PH_A_WO || PH == PH_R_WO) {
        float* X = (float*)(ws + OFF_X); const float* MOD = (const float*)(ws + OFF_MOD);
        g8::BatchSched S{ws + (PH == PH_A_WO ? OFF_O : OFF_H), PH == PH_A_WO ? ws + OFF_WMLA + j * SZ_WMLA + WM_O : ws + OFF_WRW + j * SZ_WRW + WR_O, 0, 0, (layer < 3 ? NROW : NLAT) / 256, 4, 1, D};
        g8::gemm_phase(p.wv, (PG8_LAS unsigned char*)lds, D, S, g8::epi_rc([=](const g8::Unit&, int row, int col, f32x4 v) {
            const f32x4 gt = *(const f32x4*)(MOD + ((size_t)layer * 5 + row_stream(row)) * 6144 + 2048 + col);
            f32x4* xp = (f32x4*)(X + (size_t)row * D + col); *xp = *xp + gt * v; }));
    }
    else if constexpr (PH == PH_R_XS) ph_rw_normxs(p, layer, j);
    else if constexpr (PH == PH_R_G1) {
        bf16_t* RKV = (bf16_t*)(ws + OFF_RKV); bf16_t* VF = (bf16_t*)(ws + OFF_VFIRST);
        bf16_t* A2 = (bf16_t*)(ws + OFF_A2); bf16_t* A3 = (bf16_t*)(ws + OFF_A3);
        const bool first = (j == 0);
        struct RSched { const char* XS; const char* WB; int nwg;
            __device__ __forceinline__ bool next(int i, g8::Unit& u) const {
                const int L = i * gdim() + bidx(); if (L >= nwg) return false;
                const int w = g8::xcd_remap(L, nwg);
                if (w < 816) { u.g = w / 272; const int r = w % 272; u.pm = r >> 2; u.pn = r & 3; u.B = WB + WR_RKV + (size_t)u.g * D * D * 2 + (size_t)u.pn * 256 * D * 2; }
                else { u.g = 3 + (w - 816) / 68; u.pm = (w - 816) % 68; u.pn = 0; u.B = WB + WR_L + (size_t)(u.g - 3) * 256 * D * 2; }
                u.A = XS + (size_t)(u.g == 6 ? 2 : u.g) * NROW * D * 2 + (size_t)u.pm * 256 * D * 2; return true; } };
        RSched S{ws + OFF_XS, ws + OFF_WRW + j * SZ_WRW, first ? 816 + 204 : 816 + 272};
        g8::gemm_phase(p.wv, (PG8_LAS unsigned char*)lds, D, S, g8::epi_rc([=](const g8::Unit& u, int row, int col, f32x4 v) {
            if (u.g < 3) { stbf4(RKV + ((size_t)u.g * NROW + row) * D + col, v); if (first && u.g == 2) stbf4(VF + (size_t)row * D + col, v); }
            else if (u.g == 3) { if (col < 128) { uint2 w; w.x = pk2(tanhf(v[0]), tanhf(v[1])); w.y = pk2(tanhf(v[2]), tanhf(v[3])); *(uint2*)(A2 + (size_t)row * 256 + col) = w; } }
            else if (u.g == 4) { if (col < 128) { uint2 w; w.x = pk2(v[0], v[1]); w.y = pk2(v[2], v[3]); *(uint2*)(A2 + (size_t)row * 256 + 128 + col) = w; } }
            else if (u.g == 5) { uint2 w; if (col < 128) { w.x = pk2(sigmoidf_(v[0]), sigmoidf_(v[1])); w.y = pk2(sigmoidf_(v[2]), sigmoidf_(v[3])); } else { w.x = 0u; w.y = 0u; }
                                 if (col < 128 || first || col >= 160) *(uint2*)(A3 + (size_t)row * 256 + col) = w; }
            else { if (col < 32) { uint2 w; w.x = pk2(v[0], v[1]); w.y = pk2(v[2], v[3]); *(uint2*)(A3 + (size_t)row * 256 + 128 + col) = w; } } }));
    }
    else if constexpr (PH == PH_R_G2) {
        const bool first = (j == 0);
        float* W = (float*)(ws + OFF_W); bf16_t* AV = (bf16_t*)(ws + OFF_AV); bf16_t* G = (bf16_t*)(ws + OFF_G); bf16_t* RKV = (bf16_t*)(ws + OFF_RKV); const bf16_t* VF = (const bf16_t*)(ws + OFF_VFIRST);
        const float* w0 = p.rw_w0 + (size_t)j * 2 * D; const float* a0 = p.rw_a0 + (size_t)j * 2 * D; const float* v0 = p.rw_v0;
        g8::BatchSched S1{ws + OFF_A2, ws + OFF_WRW + j * SZ_WRW + WR_B2, 0, 0, NROW / 256, 16, 1, 256};
        g8::gemm_phase(p.wv, (PG8_LAS unsigned char*)lds, 256, S1, g8::epi_rc([=](const g8::Unit& u, int row, int col, f32x4 v) {
            const int blk = u.pn >> 2, c = col & 1023; const bool dec = blk < 2;
            const float* bias = (dec ? w0 + blk * D : a0 + (blk - 2) * D) + c; const size_t doff = (size_t)(dec ? blk : blk - 2) * NROW * D + (size_t)row * D + c;
            const f32x4 x = v + *(const f32x4*)bias; f32x4 o;
#pragma unroll
            for (int e = 0; e < 4; ++e) { const float sg = __builtin_amdgcn_rcpf(1.f + __expf(-x[e])); o[e] = dec ? (-0.6065306597126334f * sg) : sg; }
            if (dec) *(f32x4*)(W + doff) = o; else stbf4(AV + doff, o); }));
        g8::BatchSched S2{ws + OFF_A3, ws + OFF_WRW + j * SZ_WRW + WR_B3, 0, 0, NROW / 256, first ? 4 : 8, 1, 256};
        g8::gemm_phase(p.wv, (PG8_LAS unsigned char*)lds, 256, S2, g8::epi_rc([=](const g8::Unit&, int row, int col, f32x4 v) {
            if (col < 1024) stbf4(G + (size_t)row * D + col, v);
            else { const int c = col - 1024; const size_t o = (size_t)row * D + c; const f32x4 vv = ldbf4(RKV + (size_t)2 * NROW * D + o), vf = ldbf4(VF + o), gz = v + *(const f32x4*)(v0 + c); f32x4 r;
#pragma unroll
                for (int e = 0; e < 4; ++e) r[e] = vv[e] + (vf[e] - vv[e]) * __builtin_amdgcn_rcpf(1.f + __expf(-gz[e]));
                stbf4(RKV + (size_t)2 * NROW * D + o, r); } }));
    }
    else if constexpr (PH == PH_R_SCAN) ph_rw_scan(p, j, lds);
    else if constexpr (PH == PH_R_SC1) ph_rw_sc1(p, j, lds);
    else if constexpr (PH == PH_R_SC2) ph_rw_sc2(p, lds);
    else if constexpr (PH == PH_R_OUT) ph_rw_out(p, j, layer < 3 ? NROW : NLAT);
    else if constexpr (PH == PH_M_NORM) ph_norm2_router(p, layer, lds, layer < 3 ? NROW : NLAT);
    else if constexpr (PH == PH_M_SEL) { ph_select(p, lds, layer < 3 ? 128 : 64); __syncthreads(); ph_moe_cvt(p, layer, lds); }
    else if constexpr (PH == PH_M_GATHER) ph_gather(p, layer < 3 ? ESLOTS : NB * CAPL);
    else if constexpr (PH == PH_M_G1) {
        bf16_t* HID = (bf16_t*)(ws + OFF_HID);
        g8::BatchSched S{ws + OFF_XE, ws + OFF_W13T, (size_t)EPAD * D * 2, (size_t)2816 * D * 2, layer < 3 ? 9 : 8, 11, NE, D};
        g8::gemm_phase(p.wv, (PG8_LAS unsigned char*)lds, D, S, g8::epi_pair([=](const g8::Unit& u, int row, int col, f32x4 a, f32x4 b) {
            uint2 w; w.x = pk2(a[0] * __builtin_amdgcn_rcpf(1.f + __expf(-a[0])) * b[0], a[1] * __builtin_amdgcn_rcpf(1.f + __expf(-a[1])) * b[1]); w.y = pk2(a[2] * __builtin_amdgcn_rcpf(1.f + __expf(-a[2])) * b[2], a[3] * __builtin_amdgcn_rcpf(1.f + __expf(-a[3])) * b[3]);
            *(uint2*)(HID + ((size_t)u.g * EPAD + row) * FF + col) = w; }));
    }
    else if constexpr (PH == PH_M_G2) {
        bf16_t* YE = (bf16_t*)(ws + OFF_YE); const float* GATE = (const float*)(ws + OFF_GATE);
        g8::BatchSched S{ws + OFF_HID, ws + OFF_W2T, (size_t)EPAD * FF * 2, (size_t)D * FF * 2, layer < 3 ? 9 : 8, 4, NE, FF};
        g8::gemm_phase(p.wv, (PG8_LAS unsigned char*)lds, FF, S, g8::epi_rc([=](const g8::Unit& u, int row, int col, f32x4 v) {
            const float gt = GATE[u.g * EPAD + row];
            uint2 w; w.x = pk2(v[0] * gt, v[1] * gt); w.y = pk2(v[2] * gt, v[3] * gt);
            *(uint2*)(YE + ((size_t)u.g * EPAD + row) * D + col) = w; }));
    }
    else if constexpr (PH == PH_M_COMB) ph_combine(p, layer, layer < 3 ? NROW : NLAT);
    else if constexpr (PH == PH_M_CVT) ph_moe_cvt(p, layer, lds);
    else if constexpr (PH == PH_FINAL) ph_final(p);
}

#if ONE_LAUNCH
#define SYNC() xcd_barrier(bar)
#ifndef PROBE_PH
#define PROBE_PH -1
#endif
#ifndef PROBE_REP
#define PROBE_REP 1
#endif
__device__ __forceinline__ Params load_params() {
    Params q{};
#if defined(__HIP_DEVICE_COMPILE__)
    typedef const __attribute__((address_space(4))) unsigned long long* KargP;
    KargP kp_ = (KargP)__builtin_amdgcn_kernarg_segment_ptr(); asm volatile("" : "+s"(kp_));
#pragma unroll
    for (int i = 0; i < 40; ++i) ((const float**)&q)[i] = (const float*)(const __attribute__((address_space(1))) float*)kp_[i];
#endif
    return q;
}
#define RUN(PH) do { for (int rep_ = 0; rep_ < ((PH) == PROBE_PH ? PROBE_REP : 1); ++rep_) { Params q = load_params(); q.wv = wv0_; run_phase<PH>(q, layer, smem); SYNC(); } } while (0)
__global__ void __launch_bounds__(NTHR, 2) mega(Params p) {
    extern __shared__ __attribute__((aligned(16))) char smem[];
    const int wv0_ = __builtin_amdgcn_readfirstlane((int)threadIdx.x >> 6);
    if (threadIdx.x == 0) *(uint4*)(smem + LDS_BYTES) = make_uint4(0u, 0u, 0u, 0u);
    __syncthreads();
    XcdBarrier bar = xcd_barrier_post((unsigned*)(p.ws + OFF_BAR), (volatile LAS unsigned*)(smem + LDS_BYTES));
    { const int layer = 0; RUN(PH_INIT); }
    for (int layer = 0; layer < 4; ++layer) {
        if ((layer & 1) == 0) {
            RUN(PH_A_NORM);
            RUN(PH_A_Z);
            RUN(PH_A_MID);
            RUN(PH_A_QKV);
            RUN(PH_A_ATTN);
            RUN(PH_A_WO);
        } else {
            RUN(PH_R_XS);
            RUN(PH_R_G1);
            RUN(PH_R_G2);
            RUN(PH_R_SC1);
            RUN(PH_R_SC2);
            RUN(PH_R_OUT);
            RUN(PH_R_WO);
        }
        RUN(PH_M_NORM);
        RUN(PH_M_SEL);
        RUN(PH_M_G1);
        RUN(PH_M_G2);
        RUN(PH_M_COMB);
    }
    { Params q = load_params(); q.wv = wv0_; run_phase<PH_FINAL>(q, 0, smem); }
}
#else
template <int PH> __global__ void __launch_bounds__(NTHR, 2) kph(Params p, int layer) {
    extern __shared__ __attribute__((aligned(16))) char smem[];
    Params q = p; q.wv = __builtin_amdgcn_readfirstlane((int)threadIdx.x >> 6);
    run_phase<PH>(q, layer, smem);
}
#endif

extern "C" void kernel_launch(void* const* d_in, const int* in_sizes, int n_in, void* d_out, int out_size, void* d_ws, size_t ws_size, hipStream_t stream) {
    if (n_in != 38 || ws_size < WS_NEED) { fprintf(stderr, "kernel_launch: bad args n_in %d ws %zu need %zu\n", n_in, ws_size, (size_t)WS_NEED); return; }
    Params p{};
    const float** pp = (const float**)&p;
    for (int i = 0; i < 38; ++i) pp[i] = (const float*)d_in[i];
    p.out = (float*)d_out; p.ws = (char*)d_ws;
    static int cus = 0;
    if (!cus) { int dev = 0; hipGetDevice(&dev); hipDeviceGetAttribute(&cus, hipDeviceAttributeMultiprocessorCount, dev); if (cus <= 0) cus = 256; }
    const int grid = cus;
#if ONE_LAUNCH
    hipFuncSetAttribute((const void*)mega, hipFuncAttributeMaxDynamicSharedMemorySize, LDS_BYTES + 16);
    hipMemsetAsync(d_ws, 0, 16384, stream);
    hipLaunchKernelGGL(mega, dim3(grid), dim3(NTHR), LDS_BYTES + 16, stream, p);
#else
    hipMemsetAsync(d_ws, 0, 16384, stream);
#define LAUNCH(PH, L) do { hipFuncSetAttribute((const void*)kph<PH>, hipFuncAttributeMaxDynamicSharedMemorySize, LDS_BYTES + 16); hipLaunchKernelGGL(kph<PH>, dim3(grid), dim3(NTHR), LDS_BYTES + 16, stream, p, L); } while (0)
    LAUNCH(PH_INIT, 0);
    for (int layer = 0; layer < 4; ++layer) {
        if ((layer & 1) == 0) { LAUNCH(PH_A_NORM, layer); LAUNCH(PH_A_Z, layer); LAUNCH(PH_A_MID, layer); LAUNCH(PH_A_QKV, layer); LAUNCH(PH_A_ATTN, layer); LAUNCH(PH_A_WO, layer); }
        else { LAUNCH(PH_R_XS, layer); LAUNCH(PH_R_G1, layer); LAUNCH(PH_R_G2, layer); LAUNCH(PH_R_SC1, layer); LAUNCH(PH_R_SC2, layer); LAUNCH(PH_R_OUT, layer); LAUNCH(PH_R_WO, layer); }
        LAUNCH(PH_M_NORM, layer); LAUNCH(PH_M_SEL, layer); LAUNCH(PH_M_G1, layer); LAUNCH(PH_M_G2, layer); LAUNCH(PH_M_COMB, layer);
    }
    LAUNCH(PH_FINAL, 0);
#endif
}
```

```cpp
#include <hip/hip_runtime.h>
#include <stdint.h>
#include <stdio.h>

#ifndef ONE_LAUNCH
#define ONE_LAUNCH 1
#endif

#define NTHR 512
typedef unsigned short bf16_t;
typedef short bf16x8 __attribute__((ext_vector_type(8)));
typedef float f32x4 __attribute__((ext_vector_type(4)));
typedef unsigned u32x4 __attribute__((ext_vector_type(4)));
typedef unsigned u32x2 __attribute__((ext_vector_type(2)));

constexpr int D = 1024, NB = 4, TL = 4096, TC = 256, NLAT = NB * TL, NCTX = NB * TC, NROW = NLAT + NCTX;
constexpr int TK = TL + TC;
constexpr int NE = 16, FF = 1408, CAPL = 512, CAPC = 32, ESLOTS = NB * CAPL + NB * CAPC;
constexpr int EPAD = 2304;
constexpr float RMS_EPS = 1e-6f, LNX_EPS = 64e-5f;
constexpr float ATT_SCALE = 0.07216878364870322f;

constexpr size_t al256(size_t x) { return (x + 255) / 256 * 256; }
constexpr size_t OFF_BAR = 0;
constexpr size_t OFF_QUEUE = 14336;
constexpr size_t OFF_MOD = 16384;
constexpr size_t OFF_ROPE_C = OFF_MOD + al256(4 * 5 * 6144 * 4);
constexpr size_t OFF_ROPE_S = OFF_ROPE_C + al256(TL * 32 * 4);
constexpr size_t OFF_X = OFF_ROPE_S + al256(TL * 32 * 4);
constexpr size_t SZ_F32 = (size_t)NROW * D * 4, SZ_BF = (size_t)NROW * D * 2;
constexpr size_t OFF_VFIRST = OFF_X + SZ_F32;
constexpr size_t OFF_H = OFF_VFIRST + SZ_F32;
constexpr size_t SZ_WMLA = (size_t)(512 * 1024 + 1536 * 256 + 2048 * 256 + 1024 * 1024) * 2;
constexpr size_t WM_IN = 0, WM_UQ = (size_t)512 * 1024 * 2, WM_UKV = WM_UQ + (size_t)1536 * 256 * 2, WM_O = WM_UKV + (size_t)2048 * 256 * 2;
constexpr size_t SZ_WRW = (size_t)(3 * 1024 * 1024 + 4 * 256 * 1024 + 1024 * 1024 + 4096 * 256 + 2048 * 256) * 2;
constexpr size_t WR_RKV = 0, WR_L = (size_t)3 * 1024 * 1024 * 2, WR_O = WR_L + (size_t)4 * 256 * 1024 * 2, WR_B2 = WR_O + (size_t)1024 * 1024 * 2, WR_B3 = WR_B2 + (size_t)4096 * 256 * 2;
constexpr size_t OFF_WMLA = OFF_H + SZ_BF;
constexpr size_t OFF_WRW = OFF_WMLA + 2 * SZ_WMLA;
constexpr size_t OFF_W13T = OFF_WRW + 2 * SZ_WRW;
constexpr size_t OFF_W2T = OFF_W13T + (size_t)NE * 2816 * D * 2;
constexpr size_t OFF_S = OFF_W2T + (size_t)NE * D * FF * 2;
constexpr size_t OFF_Z = OFF_S;
constexpr size_t OFF_CQN = OFF_Z + al256((size_t)NROW * 512 * 4);
constexpr size_t OFF_CKVN = OFF_CQN + al256((size_t)NROW * 256 * 2);
constexpr size_t OFF_KR = OFF_CKVN + al256((size_t)NROW * 256 * 2);
constexpr size_t OFF_QRAW = OFF_KR + al256((size_t)NROW * 64 * 4);
constexpr size_t OFF_KVRAW = OFF_QRAW + al256((size_t)NROW * 1536 * 4);
constexpr size_t OFF_Q = OFF_KVRAW + al256((size_t)NROW * 2048 * 4);
constexpr size_t OFF_K = OFF_Q + al256((size_t)NB * 8 * TK * 192 * 2);
constexpr size_t OFF_V = OFF_K + al256((size_t)NB * 8 * TK * 192 * 2);
constexpr size_t OFF_O = OFF_V + al256((size_t)NB * 8 * TK * 128 * 2);
constexpr size_t END_MLA = OFF_O + SZ_BF;
constexpr size_t OFF_XS = OFF_S;
constexpr size_t OFF_RKV = OFF_XS + 6 * SZ_BF;
constexpr size_t OFF_W = OFF_RKV + 3 * SZ_F32;
constexpr size_t OFF_AV = OFF_W + 2 * SZ_F32;
constexpr size_t OFF_G = OFF_AV + 2 * SZ_F32;
constexpr size_t OFF_A2 = OFF_G + SZ_F32;
constexpr size_t OFF_A3 = OFF_A2 + al256((size_t)NROW * 256 * 2);
constexpr size_t END_RW = OFF_A3 + al256((size_t)NROW * 256 * 2);
constexpr size_t OFF_Y = OFF_XS;
constexpr int NCHK = (TC + TL) / 64;
constexpr size_t OFF_CK = END_RW;
constexpr size_t END_RW2 = OFF_CK + (size_t)128 * NCHK * 4 * 4096 * 2;
constexpr size_t OFF_AFF = OFF_S;
constexpr size_t OFF_ROWIDX = OFF_AFF + al256((size_t)NROW * 16 * 4);
constexpr size_t OFF_GATE = OFF_ROWIDX + al256((size_t)NE * ESLOTS * 4);
constexpr size_t OFF_SLOT = OFF_GATE + al256((size_t)NE * EPAD * 4);
constexpr size_t OFF_XE = OFF_SLOT + al256((size_t)NROW * 16 * 4);
constexpr size_t OFF_HID = OFF_XE + al256((size_t)NE * EPAD * D * 2);
constexpr size_t OFF_YE = OFF_HID + al256((size_t)NE * EPAD * FF * 2);
constexpr size_t END_MOE = OFF_YE + al256((size_t)NE * EPAD * D * 2);
constexpr size_t WS_NEED = END_RW2 > END_MLA ? (END_RW2 > END_MOE ? END_RW2 : END_MOE) : (END_MLA > END_MOE ? END_MLA : END_MOE);

constexpr int LDS_BYTES = 152064;

struct Params {
    const float *x, *c, *ctx, *c_ctx, *mod_w, *mod_b, *norm1_g, *norm2_g, *final_g;
    const float *mla_w_in, *mla_g_q, *mla_g_kv, *mla_w_uq, *mla_w_ukv, *mla_w_o;
    const float *rw_mu, *rw_w_rkv, *rw_w0, *rw_w1, *rw_w2, *rw_a0, *rw_a1, *rw_a2, *rw_v0, *rw_v1, *rw_v2, *rw_g1, *rw_g2, *rw_k_k, *rw_k_a, *rw_r_k, *rw_lnx_g, *rw_lnx_b, *rw_w_o;
    const float *moe_router, *moe_w1, *moe_w3, *moe_w2;
    float* out; char* ws;
    int wv, pad_;
};

__device__ __forceinline__ int bidx() { int t = blockIdx.x; asm volatile("" : "+s"(t)); return t; }
__device__ __forceinline__ int gdim() { int t = gridDim.x; asm volatile("" : "+s"(t)); return t; }
__device__ __forceinline__ int tidx_w(int wv) { int l; asm volatile("v_mbcnt_lo_u32_b32 %0, -1, 0\n\tv_mbcnt_hi_u32_b32 %0, -1, %0" : "=v"(l)); return (wv << 6) | l; }
#define tidx() tidx_w(p.wv)
#define XB_TMO      128
#define XB_XCNT(j)  (256  + 64 * (j))
#define XB_XSUB(j)  (1280 + 64 * (j))
#define XB_XGEN(j)  (2304 + 64 * (j))
#define XB_TOP      3328
#define XB_TOPGEN   3392
#define XCD_BAR_WORDS 3456
#define XB_SPIN_CAP (1u << 22)
#define LAS __attribute__((address_space(3)))

__device__ __forceinline__ unsigned xb_ld(unsigned* p)              { return __hip_atomic_load(p, __ATOMIC_RELAXED, __HIP_MEMORY_SCOPE_AGENT); }
__device__ __forceinline__ unsigned xb_add(unsigned* p, unsigned v) { return __hip_atomic_fetch_add(p, v, __ATOMIC_RELAXED, __HIP_MEMORY_SCOPE_AGENT); }
__device__ __forceinline__ unsigned xb_xcc_id() { return (unsigned)__builtin_amdgcn_s_getreg((3 << 11) | 20) & 0xFu; }
#define XB_SPIN(cond, bar) do { unsigned _sp = 0; while (cond) { __builtin_amdgcn_s_sleep(1); \
    if ((++_sp & 255u) == 0u) { if (xb_ld(&(bar)[XB_TMO])) break; if (_sp > XB_SPIN_CAP) { atomicAdd(&(bar)[XB_TMO], 1u); break; } } } } while (0)

struct XcdBarrier { unsigned* bar; unsigned x; volatile LAS unsigned* st; };

__device__ __forceinline__ XcdBarrier xcd_barrier_post(unsigned* bar, volatile LAS unsigned* st) {
    XcdBarrier b; b.bar = bar; b.x = xb_xcc_id(); b.st = st;
    if (threadIdx.x == 0) (void)xb_add(&bar[XB_XCNT(b.x)], 1u);
    return b;
}
__device__ __forceinline__ void xcd_barrier_complete(unsigned* bar, unsigned x, unsigned& nloc, unsigned& nx) {
    const unsigned G = gridDim.x * gridDim.y * gridDim.z;
    unsigned sum, cnt, mine, sp = 0u;
    for (;;) {
        sum = 0u; cnt = 0u; mine = 0u;
#pragma unroll
        for (unsigned j = 0; j < 16; ++j) { const unsigned c = xb_ld(&bar[XB_XCNT(j)]); sum += c; cnt += (c > 0u) ? 1u : 0u; mine = (j == x) ? c : mine; }
        if (sum == G) break;
        __builtin_amdgcn_s_sleep(1);
        if ((++sp & 255u) == 0u) { if (xb_ld(&bar[XB_TMO])) break; if (sp > XB_SPIN_CAP) { atomicAdd(&bar[XB_TMO], 1u); break; } }
    }
    nloc = mine > 0u ? mine : 1u; nx = cnt > 0u ? cnt : 1u;
}
__device__ __forceinline__ void xcd_barrier(const XcdBarrier& b) {
    asm volatile("s_waitcnt vmcnt(0)" ::: "memory");
    __syncthreads();
    if (threadIdx.x == 0) {
        unsigned* bar = b.bar;
        __builtin_amdgcn_s_waitcnt(0);
        unsigned nloc = b.st[0], nx = b.st[1];
        if (nloc == 0u) { xcd_barrier_complete(bar, b.x, nloc, nx); b.st[0] = nloc; b.st[1] = nx; }
        const unsigned old = xb_add(&bar[XB_XSUB(b.x)], 1u);
        const unsigned gen = old / nloc;
        if (old + 1u == (gen + 1u) * nloc) {
            __builtin_amdgcn_fence(__ATOMIC_RELEASE, "agent");
            asm volatile("s_waitcnt vmcnt(0)" ::: "memory");
            const unsigned og = xb_add(&bar[XB_TOP], 1u);
            const unsigned tg = og / nx;
            if (og + 1u == (tg + 1u) * nx) xb_add(&bar[XB_TOPGEN], 1u);
            else XB_SPIN(xb_ld(&bar[XB_TOPGEN]) == tg, bar);
            __builtin_amdgcn_fence(__ATOMIC_ACQUIRE, "agent");
            xb_add(&bar[XB_XGEN(b.x)], 1u);
            asm volatile("s_waitcnt vmcnt(0)" ::: "memory");
        } else {
            XB_SPIN(xb_ld(&bar[XB_XGEN(b.x)]) == gen, bar);
            __builtin_amdgcn_fence(__ATOMIC_ACQUIRE, "agent");
            asm volatile("s_waitcnt vmcnt(0)" ::: "memory");
        }
    }
    __syncthreads();
}

__device__ __forceinline__ float bf2f(bf16_t b) { return __uint_as_float(((unsigned)b) << 16); }
typedef float f32x2_ __attribute__((ext_vector_type(2)));
typedef __bf16 bf16x2_ __attribute__((ext_vector_type(2)));
__device__ __forceinline__ unsigned pk2(float lo, float hi) { const f32x2_ v = {lo, hi}; return __builtin_bit_cast(unsigned, __builtin_convertvector(v, bf16x2_)); }
__device__ __forceinline__ bf16_t f2bf(float f) { return (bf16_t)(pk2(f, f) & 0xffffu); }
__device__ __forceinline__ float dpp_sum16(float x) {
    x += __builtin_bit_cast(float, __builtin_amdgcn_update_dpp(0, __builtin_bit_cast(int, x), 0xB1, 0xF, 0xF, true));
    x += __builtin_bit_cast(float, __builtin_amdgcn_update_dpp(0, __builtin_bit_cast(int, x), 0x4E, 0xF, 0xF, true));
    x += __builtin_bit_cast(float, __builtin_amdgcn_update_dpp(0, __builtin_bit_cast(int, x), 0x141, 0xF, 0xF, true));
    x += __builtin_bit_cast(float, __builtin_amdgcn_update_dpp(0, __builtin_bit_cast(int, x), 0x140, 0xF, 0xF, true));
    return x;
}
__device__ __forceinline__ f32x4 ldbf4(const bf16_t* p) { const uint2 w = *(const uint2*)p; return (f32x4){__uint_as_float(w.x << 16), __uint_as_float(w.x & 0xffff0000u), __uint_as_float(w.y << 16), __uint_as_float(w.y & 0xffff0000u)}; }
__device__ __forceinline__ void stbf4(bf16_t* p, f32x4 v) { uint2 w; w.x = pk2(v[0], v[1]); w.y = pk2(v[2], v[3]); *(uint2*)p = w; }
__device__ __forceinline__ float wave_sum(float v) {
    v = dpp_sum16(v); const int i = __builtin_bit_cast(int, v);
    return __builtin_bit_cast(float, __builtin_amdgcn_readlane(i, 0)) + __builtin_bit_cast(float, __builtin_amdgcn_readlane(i, 16)) + __builtin_bit_cast(float, __builtin_amdgcn_readlane(i, 32)) + __builtin_bit_cast(float, __builtin_amdgcn_readlane(i, 48));
}
__device__ __forceinline__ float sigmoidf_(float x) { return __builtin_amdgcn_rcpf(1.f + __expf(-x)); }
__device__ __forceinline__ int row_stream(int row) { return row < NLAT ? (row >> 12) : 4; }
__device__ __forceinline__ const float* modp(const Params& p, int layer, int s, int part) { return (const float*)(p.ws + OFF_MOD) + ((size_t)layer * 5 + s) * 6144 + part * 1024; }

struct SgArgs { const bf16_t* A; int lda; size_t strideA; const float* B; int ldb; size_t strideB; int M, N, K, nbatch; };
template <class Epi>
__device__ __forceinline__ void sg_gemm(const Params& p, char* lds, const SgArgs g, const Epi& epi) {
    bf16_t* As = (bf16_t*)lds;
    bf16_t* Bs = As + 128 * 40;
    const int tid = tidx(), wid = tid >> 6, lane = tid & 63;
    const int wr = wid >> 2, wc = wid & 3;
    const int tilesN = (g.N + 127) / 128, tilesM = g.M / 128, per = tilesM * tilesN, ntiles = per * g.nbatch;
    const int ar = tid >> 2, ak = (tid & 3) * 8;
    const int bn = tid & 127, bk = (tid >> 7) * 8;
    for (int tile = bidx(); tile < ntiles; tile += gdim()) {
        const int bt = tile / per, tt = tile % per;
        const int tm = tt / tilesN, tn = tt % tilesN;
        const int m0 = tm * 128, n0 = tn * 128;
        f32x4 acc[4][2];
#pragma unroll
        for (int m = 0; m < 4; ++m)
#pragma unroll
            for (int n = 0; n < 2; ++n) acc[m][n] = (f32x4){0.f, 0.f, 0.f, 0.f};
        const bool bvalid = (n0 + bn) < g.N;
        const bf16_t* ap = g.A + bt * g.strideA + (size_t)(m0 + ar) * g.lda + ak;
        const float* bp = g.B + bt * g.strideB + (size_t)bk * g.ldb + n0 + bn;
        bf16x8 areg; float breg[8];
        areg = *(const bf16x8*)ap;
#pragma unroll
        for (int j = 0; j < 8; ++j) breg[j] = bvalid ? bp[(size_t)j * g.ldb] : 0.f;
        for (int k0 = 0; k0 < g.K; k0 += 32) {
            __syncthreads();
            *(bf16x8*)(As + ar * 40 + ak) = areg;
            { u32x4 w; w.x = pk2(breg[0], breg[1]); w.y = pk2(breg[2], breg[3]); w.z = pk2(breg[4], breg[5]); w.w = pk2(breg[6], breg[7]); *(u32x4*)(Bs + bn * 40 + bk) = w; }
            __syncthreads();
            if (k0 + 32 < g.K) {
                areg = *(const bf16x8*)(ap + k0 + 32);
#pragma unroll
                for (int j = 0; j < 8; ++j) breg[j] = bvalid ? bp[(size_t)(k0 + 32 + j) * g.ldb] : 0.f;
            }
            bf16x8 af[4], bfr[2];
#pragma unroll
            for (int m = 0; m < 4; ++m) af[m] = *(const bf16x8*)(As + (wr * 64 + m * 16 + (lane & 15)) * 40 + (lane >> 4) * 8);
#pragma unroll
            for (int n = 0; n < 2; ++n) bfr[n] = *(const bf16x8*)(Bs + (wc * 32 + n * 16 + (lane & 15)) * 40 + (lane >> 4) * 8);
#pragma unroll
            for (int m = 0; m < 4; ++m)
#pragma unroll
                for (int n = 0; n < 2; ++n) acc[m][n] = __builtin_amdgcn_mfma_f32_16x16x32_bf16(af[m], bfr[n], acc[m][n], 0, 0, 0);
        }
#pragma unroll
        for (int m = 0; m < 4; ++m)
#pragma unroll
            for (int n = 0; n < 2; ++n) {
                const int col = n0 + wc * 32 + n * 16 + (lane & 15);
                if (col < g.N) {
#pragma unroll
                    for (int r = 0; r < 4; ++r) epi(bt, m0 + wr * 64 + m * 16 + (lane >> 4) * 4 + r, col, acc[m][n][r]);
                }
            }
    }
}


namespace g8 {
#define PG8_LAS __attribute__((address_space(3)))
constexpr int BM = 256, BK = 64, HALF = 128, HTB = HALF * BK * 2, STAGE_BYTES = 8 * HTB;
__device__ __forceinline__ int lds_byte(int r, int c) { const int st = (r >> 4) * 2 + (c >> 5), rr = r & 15, cc = c & 31, ob = rr * 64 + cc * 2; return st * 1024 + (ob ^ (((ob >> 9) & 1) << 5)); }
__device__ __forceinline__ void stage_rc(int b, int& R, int& C) { const int st = b / 1024, sb = b % 1024, swz = sb ^ (((sb >> 9) & 1) << 5); R = (st >> 1) * 16 + swz / 64; C = (st & 1) * 32 + (swz % 64) / 2; }
struct Unit { int pm, pn, g; const char* A; const char* B; };
__device__ __forceinline__ int xcd_remap(int L, int nwg) { const int q = nwg / 8, r = nwg % 8, xcd = L % 8, off = L / 8; return (xcd < r ? xcd * (q + 1) : r * (q + 1) + (xcd - r) * q) + off; }

template <class Epi, class Sched>
__device__ __forceinline__ void gemm_phase(const int wv_, PG8_LAS unsigned char* lds, const int K, const Sched& S, const Epi& E) {
    const int tid = tidx_w(wv_), wid = __builtin_amdgcn_readfirstlane(tid >> 6), lane = tid & 63, wr = wid >> 2, wc = wid & 3, fr = lane & 15, fq = lane >> 4;
    const int nt = K / BK;
    unsigned voffA[2];
#pragma unroll
    for (int i = 0; i < 2; ++i) { int R, C; stage_rc(tid * 16 + i * 8192, R, C); voffA[i] = (unsigned)(R * K + C) * 2u; }
    const size_t kstep = (size_t)(BK * 2);
    const size_t hstep = (size_t)HALF * K * 2;
    const unsigned ldsw = (unsigned)wid * 1024u;
    const int aoff = lds_byte(wr * 64 + fr, fq * 8), boff = lds_byte(wc * 32 + fr, fq * 8);
#define PG8_SA(b, h) (((b) * 2 + (h)) * HTB)
#define PG8_SB(b, h) ((4 + (b) * 2 + (h)) * HTB)
#define PG8_STAGE(bufoff, gbase, voff) do { _Pragma("unroll") for (int _i = 0; _i < 2; ++_i) \
        __builtin_amdgcn_global_load_lds((const unsigned*)((const char*)(gbase) + (voff)[_i]), (PG8_LAS unsigned*)(lds + (bufoff) + ldsw + _i * 8192), 16, 0, 0); } while (0)
#define PG8_LDA(dst, b, h) do { _Pragma("unroll") for (int m = 0; m < 4; ++m) _Pragma("unroll") for (int k = 0; k < 2; ++k) dst[m][k] = *(const PG8_LAS bf16x8*)(lds + PG8_SA(b, h) + aoff + m * 2048 + k * 1024); } while (0)
#define PG8_LDB(dst, b, h) do { _Pragma("unroll") for (int n = 0; n < 2; ++n) _Pragma("unroll") for (int k = 0; k < 2; ++k) dst[n][k] = *(const PG8_LAS bf16x8*)(lds + PG8_SB(b, h) + boff + n * 2048 + k * 1024); } while (0)
#define PG8_MMA(ai, bj, At, Bt) do { __builtin_amdgcn_s_setprio(1); _Pragma("unroll") for (int m = 0; m < 4; ++m) _Pragma("unroll") for (int n = 0; n < 2; ++n) _Pragma("unroll") for (int k = 0; k < 2; ++k) \
        acc[ai][bj][m][n] = __builtin_amdgcn_mfma_f32_16x16x32_bf16(Bt[n][k], At[m][k], acc[ai][bj][m][n], 0, 0, 0); __builtin_amdgcn_s_setprio(0); } while (0)
#define PG8_WAIT_V(n) asm volatile("s_waitcnt vmcnt(" #n ")" ::: "memory")
#define PG8_WAIT_L(n) asm volatile("s_waitcnt lgkmcnt(" #n ")" ::: "memory")
#define PG8_BAR __builtin_amdgcn_s_barrier()
#define PG8_SCHED __builtin_amdgcn_sched_barrier(0)
    Unit cur, nxt; int ui = 0;
    if (!S.next(0, cur)) return;
    f32x4 acc[2][2][4][2];
#pragma unroll
    for (int a = 0; a < 2; ++a)
#pragma unroll
        for (int b = 0; b < 2; ++b)
#pragma unroll
            for (int m = 0; m < 4; ++m)
#pragma unroll
                for (int n = 0; n < 2; ++n) acc[a][b][m][n] = (f32x4){0.f, 0.f, 0.f, 0.f};
    bf16x8 At[4][2], B0[2][2], B1[2][2];
    const char* cA = cur.A; const char* cB = cur.B;
    PG8_STAGE(PG8_SB(0, 0), cB, voffA); PG8_STAGE(PG8_SA(0, 0), cA, voffA); PG8_STAGE(PG8_SB(0, 1), cB + hstep, voffA); PG8_STAGE(PG8_SA(0, 1), cA + hstep, voffA);
    if (wr == 1) PG8_BAR;
    PG8_WAIT_V(4); PG8_BAR;
    PG8_STAGE(PG8_SB(1, 0), cB + kstep, voffA); PG8_STAGE(PG8_SA(1, 0), cA + kstep, voffA); PG8_STAGE(PG8_SB(1, 1), cB + hstep + kstep, voffA);
    PG8_WAIT_V(6); PG8_BAR;
    for (;;) {
        const bool has_next = S.next(ui + 1, nxt);
        const char* nA = has_next ? nxt.A : cA; const char* nB = has_next ? nxt.B : cB;
        for (int t = 0; t < nt; t += 2) {
            const bool last = (t == nt - 2);
            const char* a1 = cA + (size_t)(t + 1) * kstep;
            const char* a2 = last ? nA : cA + (size_t)(t + 2) * kstep; const char* b2 = last ? nB : cB + (size_t)(t + 2) * kstep;
            const char* a3 = a2 + kstep; const char* b3 = b2 + kstep;
            PG8_LDB(B0, 0, 0); PG8_SCHED; PG8_LDA(At, 0, 0); PG8_STAGE(PG8_SA(1, 1), a1 + hstep, voffA);
            PG8_WAIT_L(8); PG8_BAR; PG8_WAIT_L(0); PG8_MMA(0, 0, At, B0); PG8_BAR; PG8_SCHED;
            PG8_LDB(B1, 0, 1); PG8_STAGE(PG8_SB(0, 0), b2, voffA);
            PG8_BAR; PG8_WAIT_L(0); PG8_MMA(0, 1, At, B1); PG8_BAR;
            PG8_LDA(At, 0, 1); PG8_STAGE(PG8_SA(0, 0), a2, voffA);
            PG8_BAR; PG8_WAIT_L(0); PG8_MMA(1, 0, At, B0); PG8_BAR; PG8_SCHED;
            PG8_STAGE(PG8_SB(0, 1), b2 + hstep, voffA);
            PG8_WAIT_V(6); PG8_BAR; PG8_MMA(1, 1, At, B1); PG8_BAR;
            PG8_LDB(B0, 1, 0); PG8_SCHED; PG8_LDA(At, 1, 0); PG8_STAGE(PG8_SA(0, 1), a2 + hstep, voffA);
            PG8_WAIT_L(8); PG8_BAR; PG8_WAIT_L(0); PG8_MMA(0, 0, At, B0); PG8_BAR; PG8_SCHED;
            PG8_LDB(B1, 1, 1); PG8_STAGE(PG8_SB(1, 0), b3, voffA);
            PG8_BAR; PG8_WAIT_L(0); PG8_MMA(0, 1, At, B1); PG8_BAR;
            PG8_LDA(At, 1, 1); PG8_STAGE(PG8_SA(1, 0), a3, voffA);
            PG8_BAR; PG8_WAIT_L(0); PG8_MMA(1, 0, At, B0); PG8_BAR; PG8_SCHED;
            PG8_STAGE(PG8_SB(1, 1), b3 + hstep, voffA);
            PG8_WAIT_V(6); PG8_BAR; PG8_MMA(1, 1, At, B1); PG8_BAR;
        }
        E(acc, cur, wr, wc, fr, fq);
        if (!has_next) break;
#pragma unroll
        for (int a = 0; a < 2; ++a)
#pragma unroll
            for (int b = 0; b < 2; ++b)
#pragma unroll
                for (int m = 0; m < 4; ++m)
#pragma unroll
                    for (int n = 0; n < 2; ++n) acc[a][b][m][n] = (f32x4){0.f, 0.f, 0.f, 0.f};
        cur = nxt; cA = nA; cB = nB; ++ui;
    }
    PG8_WAIT_V(0);
    if (wr == 0) PG8_BAR;
    PG8_BAR;
#undef PG8_SA
#undef PG8_SB
#undef PG8_STAGE
#undef PG8_LDA
#undef PG8_LDB
#undef PG8_MMA
#undef PG8_WAIT_V
#undef PG8_WAIT_L
#undef PG8_BAR
#undef PG8_SCHED
}
template <class F> struct EpiRC { F f;
    __device__ __forceinline__ void operator()(const f32x4 (&acc)[2][2][4][2], const Unit& u, int wr, int wc, int fr, int fq) const {
#pragma unroll
        for (int ai = 0; ai < 2; ++ai)
#pragma unroll
            for (int m = 0; m < 4; ++m) { const int row = u.pm * BM + ai * HALF + wr * 64 + m * 16 + fr;
#pragma unroll
                for (int bj = 0; bj < 2; ++bj)
#pragma unroll
                    for (int n = 0; n < 2; ++n) f(u, row, u.pn * BM + bj * HALF + wc * 32 + n * 16 + 4 * fq, acc[ai][bj][m][n]);
                asm volatile("" ::: "memory"); }
    } };
template <class F> __device__ __forceinline__ EpiRC<F> epi_rc(const F& f) { return EpiRC<F>{f}; }
template <class F> struct EpiPair { F f;
    __device__ __forceinline__ void operator()(const f32x4 (&acc)[2][2][4][2], const Unit& u, int wr, int wc, int fr, int fq) const {
#pragma unroll
        for (int ai = 0; ai < 2; ++ai)
#pragma unroll
            for (int m = 0; m < 4; ++m) { const int row = u.pm * BM + ai * HALF + wr * 64 + m * 16 + fr;
#pragma unroll
                for (int n = 0; n < 2; ++n) f(u, row, u.pn * HALF + wc * 32 + n * 16 + 4 * fq, acc[ai][0][m][n], acc[ai][1][m][n]);
                asm volatile("" ::: "memory"); }
    } };
template <class F> __device__ __forceinline__ EpiPair<F> epi_pair(const F& f) { return EpiPair<F>{f}; }
template <class F, class CF, class RF> struct EpiPre { F f; CF cf; RF rf;
    __device__ __forceinline__ void operator()(const f32x4 (&acc)[2][2][4][2], const Unit& u, int wr, int wc, int fr, int fq) const {
        f32x4 cv[2][2]; float rv[2][4];
#pragma unroll
        for (int bj = 0; bj < 2; ++bj)
#pragma unroll
            for (int n = 0; n < 2; ++n) cv[bj][n] = cf(u, u.pn * BM + bj * HALF + wc * 32 + n * 16 + 4 * fq);
#pragma unroll
        for (int ai = 0; ai < 2; ++ai)
#pragma unroll
            for (int m = 0; m < 4; ++m) rv[ai][m] = rf(u, u.pm * BM + ai * HALF + wr * 64 + m * 16 + fr);
#pragma unroll
        for (int ai = 0; ai < 2; ++ai)
#pragma unroll
            for (int m = 0; m < 4; ++m) { const int row = u.pm * BM + ai * HALF + wr * 64 + m * 16 + fr;
#pragma unroll
                for (int bj = 0; bj < 2; ++bj)
#pragma unroll
                    for (int n = 0; n < 2; ++n) f(u, row, u.pn * BM + bj * HALF + wc * 32 + n * 16 + 4 * fq, acc[ai][bj][m][n], cv[bj][n], rv[ai][m]);
                asm volatile("" ::: "memory"); }
    } };
template <class F, class CF, class RF> __device__ __forceinline__ EpiPre<F, CF, RF> epi_pre(const F& f, const CF& cf, const RF& rf) { return EpiPre<F, CF, RF>{f, cf, rf}; }
template <class F, class CF> struct EpiColFirst { F f; CF cf;
    __device__ __forceinline__ void operator()(const f32x4 (&acc)[2][2][4][2], const Unit& u, int wr, int wc, int fr, int fq) const {
#pragma unroll
        for (int bj = 0; bj < 2; ++bj)
#pragma unroll
            for (int n = 0; n < 2; ++n) { const int col = u.pn * BM + bj * HALF + wc * 32 + n * 16 + 4 * fq; const f32x4 cv = cf(u, col);
#pragma unroll
                for (int ai = 0; ai < 2; ++ai)
#pragma unroll
                    for (int m = 0; m < 4; ++m) f(u, u.pm * BM + ai * HALF + wr * 64 + m * 16 + fr, col, acc[ai][bj][m][n], cv);
                asm volatile("" ::: "memory"); }
    } };
template <class F, class CF> __device__ __forceinline__ EpiColFirst<F, CF> epi_colfirst(const F& f, const CF& cf) { return EpiColFirst<F, CF>{f, cf}; }
struct EpiResid { float* X; const float* MOD; int layer;
    __device__ __forceinline__ void operator()(const f32x4 (&acc)[2][2][4][2], const Unit& u, int wr, int wc, int fr, int fq) const {
        const int row0 = u.pm * BM + wr * 64 + fr, col0 = u.pn * BM + wc * 32 + 4 * fq;
        const int strm = row0 < NLAT ? (row0 >> 12) : 4;
        const float* gp = MOD + ((size_t)layer * 5 + strm) * 6144 + 2048 + col0;
        f32x4 gt[2][2];
#pragma unroll
        for (int bj = 0; bj < 2; ++bj)
#pragma unroll
            for (int n = 0; n < 2; ++n) gt[bj][n] = *(const f32x4*)(gp + bj * HALF + n * 16);
#pragma unroll
        for (int ai = 0; ai < 2; ++ai) {
            f32x4 xv[4][2][2];
#pragma unroll
            for (int m = 0; m < 4; ++m)
#pragma unroll
                for (int bj = 0; bj < 2; ++bj)
#pragma unroll
                    for (int n = 0; n < 2; ++n) xv[m][bj][n] = *(const f32x4*)(X + (size_t)(row0 + ai * HALF + m * 16) * D + col0 + bj * HALF + n * 16);
#pragma unroll
            for (int m = 0; m < 4; ++m)
#pragma unroll
                for (int bj = 0; bj < 2; ++bj)
#pragma unroll
                    for (int n = 0; n < 2; ++n) *(f32x4*)(X + (size_t)(row0 + ai * HALF + m * 16) * D + col0 + bj * HALF + n * 16) = xv[m][bj][n] + gt[bj][n] * acc[ai][bj][m][n];
            asm volatile("" ::: "memory");
        }
    } };
struct BatchSched { const char* A; const char* B; size_t strideA, strideB; int nM, nN, nb, K;
    __device__ __forceinline__ bool next(int i, Unit& u) const {
        const int nwg = nM * nN * nb; const int L = i * gdim() + bidx(); if (L >= nwg) return false;
        const int w = xcd_remap(L, nwg); const int per = nM * nN; u.g = w / per; const int r = w % per; u.pm = r / nN; u.pn = r % nN;
        u.A = A + u.g * strideA + (size_t)u.pm * BM * K * 2; u.B = B + u.g * strideB + (size_t)u.pn * BM * K * 2; return true; } };
}

template <class SrcF, class DRow>
__device__ __forceinline__ void cvt_tiles(const int wv_, char* lds, bf16_t* dst, int Kd, int Nd, int nbatch, size_t dstride, const SrcF& src, const DRow& drow, unsigned* queue = nullptr) {
    bf16_t* T = (bf16_t*)lds;
    int* qslot = (int*)(lds + 64 * 136 * 2);
    const int tid = tidx_w(wv_);
    const int tk = Kd / 128, tn = Nd / 64, per = tk * tn, total = per * nbatch;
    constexpr int QG = 8;
    int t = queue ? 0 : bidx(), tnext = 0, sub = 0;
    if (queue) { if (tid == 0) { qslot[0] = QG * (int)__hip_atomic_fetch_add(queue, 1u, __ATOMIC_RELAXED, __HIP_MEMORY_SCOPE_AGENT); } __syncthreads(); t = qslot[0]; __syncthreads(); }
    while (t < total) {
        if (queue && sub == 0 && tid == 0) tnext = QG * (int)__hip_atomic_fetch_add(queue, 1u, __ATOMIC_RELAXED, __HIP_MEMORY_SCOPE_AGENT);
        const int bt = t / per, r = t % per, k0 = (r % tk) * 128, n0 = (r / tk) * 64;
        float4 v[4];
#pragma unroll
        for (int i = 0; i < 4; ++i) { const int k = k0 + i * 32 + (tid >> 4), n = n0 + (tid & 15) * 4; const float* sp = src(bt, k, n); v[i] = sp ? *(const float4*)sp : make_float4(0.f, 0.f, 0.f, 0.f); }
        __syncthreads();
#pragma unroll
        for (int i = 0; i < 4; ++i) { const int k = i * 32 + (tid >> 4), n = (tid & 15) * 4;
            T[(n + 0) * 136 + k] = f2bf(v[i].x); T[(n + 1) * 136 + k] = f2bf(v[i].y); T[(n + 2) * 136 + k] = f2bf(v[i].z); T[(n + 3) * 136 + k] = f2bf(v[i].w); }
        if (queue && sub == QG - 1 && tid == 0) qslot[0] = tnext;
        __syncthreads();
        { const int n = tid >> 3, kc = (tid & 7) * 16;
          const u32x4 a = *(const u32x4*)(T + n * 136 + kc), b = *(const u32x4*)(T + n * 136 + kc + 8);
          bf16_t* dp = dst + bt * dstride + (size_t)drow(n0 + n) * Kd + k0 + kc;
          *(u32x4*)dp = a; *(u32x4*)(dp + 8) = b; }
        if (queue) { if (++sub == QG) { sub = 0; t = qslot[0]; } else ++t; } else t += gdim();
    }
}
__device__ void ph_moe_cvt(const Params& p, int layer, char* lds) {
    const float* w1 = p.moe_w1 + (size_t)layer * NE * D * FF; const float* w3 = p.moe_w3 + (size_t)layer * NE * D * FF; const float* w2 = p.moe_w2 + (size_t)layer * NE * FF * D;
    cvt_tiles(p.wv, lds, (bf16_t*)(p.ws + OFF_W13T), D, 2816, NE, (size_t)2816 * D,
        [=](int e, int k, int n) -> const float* { const int pn = n >> 8, half = (n >> 7) & 1, c = pn * 128 + (n & 127); return (half ? w3 : w1) + ((size_t)e * D + k) * FF + c; },
        [=](int n) { return n; }, (unsigned*)(p.ws + OFF_QUEUE) + (layer * 2) * 16);
    cvt_tiles(p.wv, lds, (bf16_t*)(p.ws + OFF_W2T), FF, D, NE, (size_t)D * FF,
        [=](int e, int k, int n) -> const float* { return w2 + ((size_t)e * FF + k) * D + n; },
        [=](int n) { return n; }, (unsigned*)(p.ws + OFF_QUEUE) + (layer * 2 + 1) * 16);
}

__device__ void ph_init(const Params& p, char* lds) {
    const int tid = tidx(), gtid = bidx() * NTHR + tid, gsz = gdim() * NTHR;
    float4* X4 = (float4*)(p.ws + OFF_X);
    const float4* x4 = (const float4*)p.x; const float4* c4 = (const float4*)p.ctx;
    { constexpr int NQ = NROW * 256 / 4;
      auto srcv = [&](int k) { return k < NLAT * 256 ? x4[k] : c4[k - NLAT * 256]; };
      for (int i = gtid; i < NQ; i += gsz) { const float4 t0 = srcv(i), t1 = srcv(i + NQ), t2 = srcv(i + 2 * NQ), t3 = srcv(i + 3 * NQ); X4[i] = t0; X4[i + NQ] = t1; X4[i + 2 * NQ] = t2; X4[i + 3 * NQ] = t3; } }
    float* rc = (float*)(p.ws + OFF_ROPE_C); float* rs = (float*)(p.ws + OFF_ROPE_S);
    for (int i = gtid; i < TL * 32; i += gsz) {
        const int t = i >> 5, f = i & 31; const float pos = (float)((f < 16) ? (t >> 6) : (t & 63));
        const float inv = powf(10000.f, -(float)(f & 15) / 16.f); const float ang = pos * inv; rc[2 * i] = cosf(ang); rc[2 * i + 1] = sinf(ang);
    }
    float* sc = (float*)lds;
    float* red = sc + 5 * 1024;
    for (int i = tid; i < 5 * 1024; i += NTHR) { const float v = i < 4096 ? p.c[i] : p.c_ctx[i - 4096]; sc[i] = v / (1.f + expf(-v)); }
    __syncthreads();
    float* MOD = (float*)(p.ws + OFF_MOD);
    for (int item = bidx(); item < 4 * 96; item += gdim()) {
        const int l = item / 96, cg = item % 96, col = tid & 63, n = cg * 64 + col, kg = tid >> 6;
        const float* w = p.mod_w + ((size_t)l * 1024 + kg * 128) * 6144 + n;
        float a0 = 0, a1 = 0, a2 = 0, a3 = 0, a4 = 0;
#pragma unroll 16
        for (int k = 0; k < 128; ++k) { const float wv = w[(size_t)k * 6144]; const int kk = kg * 128 + k;
            a0 += sc[kk] * wv; a1 += sc[1024 + kk] * wv; a2 += sc[2048 + kk] * wv; a3 += sc[3072 + kk] * wv; a4 += sc[4096 + kk] * wv; }
        float* rr = red + (kg * 64 + col) * 5; rr[0] = a0; rr[1] = a1; rr[2] = a2; rr[3] = a3; rr[4] = a4;
        __syncthreads();
        if (tid < 320) { const int c2 = tid & 63, s = tid >> 6; float sum = 0;
            for (int q = 0; q < 8; ++q) sum += red[(q * 64 + c2) * 5 + s];
            MOD[((size_t)l * 5 + s) * 6144 + cg * 64 + c2] = sum + p.mod_b[l * 6144 + cg * 64 + c2]; }
        __syncthreads();
    }
}


__device__ void ph_small_cvt(const Params& p, char* lds) {
    for (int j = 0; j < 2; ++j) {
        char* wm = p.ws + OFF_WMLA + j * SZ_WMLA; char* wr = p.ws + OFF_WRW + j * SZ_WRW;
        const float* w_in = p.mla_w_in + (size_t)j * D * 448; const float* w_uq = p.mla_w_uq + (size_t)j * 256 * 1536; const float* w_ukv = p.mla_w_ukv + (size_t)j * 128 * 2048; const float* w_o = p.mla_w_o + (size_t)j * D * D;
        cvt_tiles(p.wv, lds, (bf16_t*)(wm + WM_IN), 1024, 512, 1, 0, [=](int, int k, int n) -> const float* { return n < 448 ? w_in + (size_t)k * 448 + n : nullptr; },
                  [=](int n) { if (n < 384 || n >= 448) return n; const int jj = n - 384; return 384 + (jj < 32 ? 2 * jj : 2 * (jj - 32) + 1); });
        cvt_tiles(p.wv, lds, (bf16_t*)(wm + WM_UQ), 256, 1536, 1, 0, [=](int, int k, int n) -> const float* { return w_uq + (size_t)k * 1536 + n; },
                  [=](int n) { const int h = n / 192, d = n % 192; if (d < 128) return n; const int jj = d - 128; return h * 192 + 128 + (jj < 32 ? 2 * jj : 2 * (jj - 32) + 1); });
        cvt_tiles(p.wv, lds, (bf16_t*)(wm + WM_UKV), 256, 2048, 1, 0, [=](int, int k, int n) -> const float* { return k < 128 ? w_ukv + (size_t)k * 2048 + n : nullptr; }, [=](int n) { return n; });
        cvt_tiles(p.wv, lds, (bf16_t*)(wm + WM_O), 1024, 1024, 1, 0, [=](int, int k, int n) -> const float* { return w_o + (size_t)k * D + n; }, [=](int n) { return n; });
        const float* w_rkv = p.rw_w_rkv + (size_t)j * 3 * D * D; const float* w1 = p.rw_w1 + (size_t)j * 2 * D * 64; const float* a1 = p.rw_a1 + (size_t)j * 2 * D * 64;
        const float* g1 = p.rw_g1 + (size_t)j * D * 128; const float* v1 = p.rw_v1; const float* rwo = p.rw_w_o + (size_t)j * D * D;
        cvt_tiles(p.wv, lds, (bf16_t*)(wr + WR_RKV), 1024, 1024, 3, (size_t)D * D, [=](int m, int k, int n) -> const float* { return w_rkv + ((size_t)m * D + k) * D + n; }, [=](int n) { return n; });
        cvt_tiles(p.wv, lds, (bf16_t*)(wr + WR_L), 1024, 256, 1, 0, [=](int, int k, int n) -> const float* { return n < 128 ? w1 + ((size_t)(n >> 6) * D + k) * 64 + (n & 63) : nullptr; }, [=](int n) { return n; });
        cvt_tiles(p.wv, lds, (bf16_t*)(wr + WR_L) + 256 * 1024, 1024, 256, 1, 0, [=](int, int k, int n) -> const float* { return n < 128 ? a1 + ((size_t)(n >> 6) * D + k) * 64 + (n & 63) : nullptr; }, [=](int n) { return n; });
        cvt_tiles(p.wv, lds, (bf16_t*)(wr + WR_L) + 2 * 256 * 1024, 1024, 256, 1, 0, [=](int, int k, int n) -> const float* { return n < 128 ? g1 + (size_t)k * 128 + n : nullptr; }, [=](int n) { return n; });
        cvt_tiles(p.wv, lds, (bf16_t*)(wr + WR_L) + 3 * 256 * 1024, 1024, 256, 1, 0, [=](int, int k, int n) -> const float* { return n < 32 ? v1 + (size_t)k * 32 + n : nullptr; }, [=](int n) { return n; });
        cvt_tiles(p.wv, lds, (bf16_t*)(wr + WR_O), 1024, 1024, 1, 0, [=](int, int k, int n) -> const float* { return rwo + (size_t)k * D + n; }, [=](int n) { return n; });
        const float* w2 = p.rw_w2 + (size_t)j * 2 * 64 * D; const float* a2 = p.rw_a2 + (size_t)j * 2 * 64 * D; const float* g2 = p.rw_g2 + (size_t)j * 128 * D; const float* v2 = p.rw_v2;
        cvt_tiles(p.wv, lds, (bf16_t*)(wr + WR_B2), 256, 4096, 1, 0, [=](int, int k, int n) -> const float* { const int blk = n >> 10, c = n & 1023, l = k - blk * 64;
            if (l < 0 || l >= 64) return nullptr; return (blk < 2 ? w2 + ((size_t)blk * 64 + l) * D : a2 + ((size_t)(blk - 2) * 64 + l) * D) + c; }, [=](int n) { return n; });
        cvt_tiles(p.wv, lds, (bf16_t*)(wr + WR_B3), 256, 2048, 1, 0, [=](int, int k, int n) -> const float* {
            if (n < 1024) return k < 128 ? g2 + (size_t)k * D + n : nullptr; return (k >= 128 && k < 160) ? v2 + (size_t)(k - 128) * D + (n - 1024) : nullptr; }, [=](int n) { return n; });
    }
}

template <bool OUTF32>
__device__ void ph_norm_mod(const Params& p, int layer, const float* g, int part_sh, int part_sc, void* outp) {
    const int wid = tidx() >> 6, lane = tidx() & 63;
    const float* X = (const float*)(p.ws + OFF_X);
    int row = bidx() * 8 + wid;
    float4 nv[4];
    if (row < NROW) {
#pragma unroll
        for (int i = 0; i < 4; ++i) nv[i] = ((const float4*)(X + (size_t)row * D))[lane + i * 64]; }
    for (; row < NROW; row += gdim() * 8) {
        const int s = row_stream(row);
        const float* sh = modp(p, layer, s, part_sh); const float* sc = modp(p, layer, s, part_sc);
        float4 v[4]; float ss = 0;
#pragma unroll
        for (int i = 0; i < 4; ++i) { v[i] = nv[i]; ss += v[i].x * v[i].x + v[i].y * v[i].y + v[i].z * v[i].z + v[i].w * v[i].w; }
        { const int nrow = row + gdim() * 8;
          if (nrow < NROW) {
#pragma unroll
              for (int i = 0; i < 4; ++i) nv[i] = ((const float4*)(X + (size_t)nrow * D))[lane + i * 64]; } }
        ss = wave_sum(ss); const float rs = rsqrtf(ss * (1.f / D) + RMS_EPS);
#pragma unroll
        for (int i = 0; i < 4; ++i) {
            const int d = (lane + i * 64) * 4;
            const float4 gg = *(const float4*)(g + d), a = *(const float4*)(sc + d), b = *(const float4*)(sh + d);
            float4 o; o.x = v[i].x * rs * gg.x * (1.f + a.x) + b.x; o.y = v[i].y * rs * gg.y * (1.f + a.y) + b.y; o.z = v[i].z * rs * gg.z * (1.f + a.z) + b.z; o.w = v[i].w * rs * gg.w * (1.f + a.w) + b.w;
            if (OUTF32) *(float4*)((float*)outp + (size_t)row * D + d) = o;
            else { uint2 w; w.x = pk2(o.x, o.y); w.y = pk2(o.z, o.w); *(uint2*)((bf16_t*)outp + (size_t)row * D + d) = w; }
        }
    }
}

__device__ void ph_mla_mid(const Params& p, int j) {
    const int wid = tidx() >> 6, lane = tidx() & 63;
    const float* Z = (const float*)(p.ws + OFF_Z);
    bf16_t* CQN = (bf16_t*)(p.ws + OFF_CQN); bf16_t* CKVN = (bf16_t*)(p.ws + OFF_CKVN); bf16_t* K = (bf16_t*)(p.ws + OFF_K);
    const float* gq = p.mla_g_q + j * 256; const float* gkv = p.mla_g_kv + j * 128;
    const float* rc = (const float*)(p.ws + OFF_ROPE_C); const float* rs = (const float*)(p.ws + OFF_ROPE_S);
    for (int row = bidx() * 8 + wid; row < NROW; row += gdim() * 8) {
        const float* z = Z + (size_t)row * 512;
        const float4 q = *(const float4*)(z + lane * 4);
        const float2 kv = *(const float2*)(z + 256 + lane * 2);
        const float kr = z[384 + lane];
        float sq = wave_sum(q.x * q.x + q.y * q.y + q.z * q.z + q.w * q.w); const float rq = rsqrtf(sq * (1.f / 256.f) + RMS_EPS);
        float sk = wave_sum(kv.x * kv.x + kv.y * kv.y); const float rk = rsqrtf(sk * (1.f / 128.f) + RMS_EPS);
        const float4 g4 = *(const float4*)(gq + lane * 4); const float2 g2 = *(const float2*)(gkv + lane * 2);
        uint2 w; w.x = pk2(q.x * rq * g4.x, q.y * rq * g4.y); w.y = pk2(q.z * rq * g4.z, q.w * rq * g4.w);
        *(uint2*)(CQN + (size_t)row * 256 + lane * 4) = w;
        *(unsigned*)(CKVN + (size_t)row * 256 + lane * 2) = pk2(kv.x * rk * g2.x, kv.y * rk * g2.y);
        *(unsigned*)(CKVN + (size_t)row * 256 + 128 + lane * 2) = 0u;
        float o = kr;
        const float other = __builtin_bit_cast(float, __builtin_amdgcn_update_dpp(0, __builtin_bit_cast(int, kr), 0xB1, 0xF, 0xF, true));
        const bool lat = row < NLAT;
        if (lat) { const int t = row & (TL - 1), i = lane >> 1; const float2 cs = *(const float2*)(rc + (t * 32 + i) * 2); const float c = cs.x, s = cs.y;
            o = (lane & 1) ? (other * s + kr * c) : (kr * c - other * s); }
        const int b = lat ? (row >> 12) : ((row - NLAT) >> 8); const int tk = lat ? 256 + (row & (TL - 1)) : ((row - NLAT) & 255);
        const bf16_t ob = f2bf(o);
#pragma unroll
        for (int h = 0; h < 8; ++h) K[((size_t)(b * 8 + h) * TK + tk) * 192 + 128 + lane] = ob;
    }
}

__device__ void ph_qkv_post(const Params& p) {
    const int wid = tidx() >> 6, lane = tidx() & 63;
    const float* QRAW = (const float*)(p.ws + OFF_QRAW); const float* KVRAW = (const float*)(p.ws + OFF_KVRAW); const float* KR = (const float*)(p.ws + OFF_KR);
    bf16_t* Q = (bf16_t*)(p.ws + OFF_Q); bf16_t* K = (bf16_t*)(p.ws + OFF_K); bf16_t* V = (bf16_t*)(p.ws + OFF_V);
    const float* rc = (const float*)(p.ws + OFF_ROPE_C); const float* rs = (const float*)(p.ws + OFF_ROPE_S);
    for (int it = bidx() * 8 + wid; it < NROW * 8; it += gdim() * 8) {
        const int row = it >> 3, h = it & 7;
        const bool lat = row < NLAT; const int b = lat ? (row >> 12) : ((row - NLAT) >> 8); const int tk = lat ? 256 + (row & (TL - 1)) : ((row - NLAT) & 255);
        const size_t orow = (size_t)(b * 8 + h) * TK + tk;
        const float* q = QRAW + (size_t)row * 1536 + h * 192;
        const float q0 = q[lane], q1 = q[64 + lane]; float q2 = q[128 + lane];
        const auto sw = __builtin_amdgcn_permlane32_swap(__float_as_uint(q2), __float_as_uint(q2), false, false);
        if (lat) { const int t = row & (TL - 1), i = lane & 31; const float c = rc[t * 32 + i], s = rs[t * 32 + i];
            const float x1 = __uint_as_float(sw[0]), x2 = __uint_as_float(sw[1]); q2 = lane < 32 ? (x1 * c - x2 * s) : (x1 * s + x2 * c); }
        bf16_t* qo = Q + orow * 192; qo[lane] = f2bf(q0); qo[64 + lane] = f2bf(q1); qo[128 + lane] = f2bf(q2);
        const float* kv = KVRAW + (size_t)row * 2048 + h * 256;
        bf16_t* ko = K + orow * 192; ko[lane] = f2bf(kv[lane]); ko[64 + lane] = f2bf(kv[64 + lane]); ko[128 + lane] = f2bf(KR[(size_t)row * 64 + lane]);
        bf16_t* vo = V + orow * 128; vo[lane] = f2bf(kv[128 + lane]); vo[64 + lane] = f2bf(kv[192 + lane]);
    }
}

__device__ void ph_attn_naive(const Params& p, char* lds) {
    const int tid = tidx(), qi = tid >> 2, part = tid & 3;
    const bf16_t* Q = (const bf16_t*)(p.ws + OFF_Q); const bf16_t* K = (const bf16_t*)(p.ws + OFF_K); const bf16_t* V = (const bf16_t*)(p.ws + OFF_V);
    bf16_t* O = (bf16_t*)(p.ws + OFF_O);
    bf16_t* Ks = (bf16_t*)lds;
    bf16_t* Vs = Ks + 32 * 192;
    const int nitems = 32 * 34;
    for (int it = bidx(); it < nitems; it += gdim()) {
        const int bh = it / 34, qb = it % 34; const int b = bh >> 3, h = bh & 7;
        const int nkeys = qb < 2 ? TC : TK;
        const int tq = qb * 128 + qi;
        const bf16_t* qp = Q + ((size_t)bh * TK + tq) * 192 + part * 48;
        float q[48];
#pragma unroll
        for (int i = 0; i < 48; ++i) q[i] = bf2f(qp[i]) * ATT_SCALE;
        float o[32];
#pragma unroll
        for (int i = 0; i < 32; ++i) o[i] = 0.f;
        float m = -1e30f, l = 0.f;
        for (int k0 = 0; k0 < nkeys; k0 += 32) {
            __syncthreads();
            {
                const bf16_t* kg = K + ((size_t)bh * TK + k0) * 192; const bf16_t* vg = V + ((size_t)bh * TK + k0) * 128;
                for (int c = tid; c < 768; c += NTHR) *(u32x4*)(Ks + c * 8) = *(const u32x4*)(kg + c * 8);
                *(u32x4*)(Vs + tid * 8) = *(const u32x4*)(vg + tid * 8);
            }
            __syncthreads();
#pragma unroll 1
            for (int kg = 0; kg < 32; kg += 8) {
                float s[8]; float tmax = -1e30f;
#pragma unroll
                for (int kk = 0; kk < 8; ++kk) {
                    const bf16_t* kr = Ks + (kg + kk) * 192 + part * 48; float acc = 0.f;
#pragma unroll
                    for (int i = 0; i < 48; ++i) acc += q[i] * bf2f(kr[i]);
                    acc += __shfl_xor(acc, 1); acc += __shfl_xor(acc, 2);
                    s[kk] = acc; tmax = fmaxf(tmax, acc);
                    asm volatile("" ::: "memory");
                }
                const float mn = fmaxf(m, tmax), alpha = expf(m - mn); m = mn; l *= alpha;
#pragma unroll
                for (int i = 0; i < 32; ++i) o[i] *= alpha;
#pragma unroll
                for (int kk = 0; kk < 8; ++kk) {
                    const float pw = expf(s[kk] - mn); l += pw;
                    const bf16_t* vr = Vs + (kg + kk) * 128 + part * 32;
#pragma unroll
                    for (int i = 0; i < 32; ++i) o[i] += pw * bf2f(vr[i]);
                    asm volatile("" ::: "memory");
                }
            }
        }
        const float rl = 1.f / l;
        const int row = qb < 2 ? (NLAT + b * TC + tq) : (b * TL + tq - TC);
        bf16_t* op = O + (size_t)row * D + h * 128 + part * 32;
#pragma unroll
        for (int i = 0; i < 32; ++i) op[i] = f2bf(o[i] * rl);
    }
}


namespace fa {
using s16x4  = __attribute__((ext_vector_type(4))) short;
using f32x16 = __attribute__((ext_vector_type(16))) float;
constexpr int DQK = 192, DV = 128, KVBLK = 64;
constexpr float THR = 8.f;
constexpr int SHM_V = KVBLK * DV * 2, SHM_K = KVBLK * DQK * 2;
constexpr int SHM_ATTN = 2 * SHM_V + 2 * SHM_K + 8 * 64 * 4;
#define KSWZ(row, colB) ((row) * 384 + ((colB) ^ ((((row) >> 1) & 7) << 4)))
#define SBAR() __builtin_amdgcn_sched_barrier(0)
__device__ __forceinline__ int crow(int r, int hi) { return (r & 3) + 8 * (r >> 2) + 4 * hi; }
__device__ __forceinline__ unsigned cvtpk(float lo, float hi) { unsigned r; asm volatile("v_cvt_pk_bf16_f32 %0, %1, %2" : "=v"(r) : "v"(lo), "v"(hi)); return r; }
__device__ __forceinline__ void partialSM(f32x16& p0, f32x16& p1, float& m_reg, float& mn, float& alpha) {
  constexpr float C = ATT_SCALE * 1.4426950408889634f;
  float pmax = p0[0];
#pragma unroll
  for (int r = 1; r < 16; ++r) pmax = fmaxf(pmax, p0[r]);
#pragma unroll
  for (int r = 0; r < 16; ++r) pmax = fmaxf(pmax, p1[r]);
  { auto rr = __builtin_amdgcn_permlane32_swap(__float_as_uint(pmax), __float_as_uint(pmax), false, false);
    pmax = fmaxf(__uint_as_float(rr[0]), __uint_as_float(rr[1])); }
  if (__builtin_expect(__all(pmax - m_reg <= THR / ATT_SCALE), 1)) { mn = m_reg; alpha = 1.f; }
  else { mn = fmaxf(m_reg, pmax); alpha = __builtin_amdgcn_exp2f((m_reg - mn) * C); m_reg = mn; }
  float mnC = -mn * C;
#pragma unroll
  for (int r = 0; r < 16; ++r) p0[r] = fmaf(p0[r], C, mnC);
#pragma unroll
  for (int r = 0; r < 16; ++r) p1[r] = fmaf(p1[r], C, mnC);
#pragma unroll
  for (int r = 0; r < 16; ++r) p0[r] = __builtin_amdgcn_exp2f(p0[r]);
}
__device__ __forceinline__ void finishSM(f32x16& p0, f32x16& p1, float alpha, float& l_reg, bf16x8& pa0, bf16x8& pa1, bf16x8& pa2, bf16x8& pa3) {
#pragma unroll
  for (int r = 0; r < 16; ++r) p1[r] = __builtin_amdgcn_exp2f(p1[r]);
  float ps = 0;
#pragma unroll
  for (int r = 0; r < 16; ++r) ps += p0[r];
#pragma unroll
  for (int r = 0; r < 16; ++r) ps += p1[r];
  { auto rr = __builtin_amdgcn_permlane32_swap(__float_as_uint(ps), __float_as_uint(ps), false, false);
    ps = __uint_as_float(rr[0]) + __uint_as_float(rr[1]); }
  l_reg = l_reg * alpha + ps;
#define PK4(P, BASE, OUT) do { unsigned a0 = cvtpk(P[BASE + 0], P[BASE + 1]), a1 = cvtpk(P[BASE + 2], P[BASE + 3]);   \
    unsigned b0 = cvtpk(P[BASE + 4], P[BASE + 5]), b1 = cvtpk(P[BASE + 6], P[BASE + 7]);                              \
    auto r0 = __builtin_amdgcn_permlane32_swap(a0, b0, false, false); auto r1 = __builtin_amdgcn_permlane32_swap(a1, b1, false, false); \
    u32x4 w = {r0[0], r1[0], r0[1], r1[1]}; OUT = *reinterpret_cast<bf16x8*>(&w); } while (0)
  PK4(p0, 0, pa0); PK4(p0, 8, pa1); PK4(p1, 0, pa2); PK4(p1, 8, pa3);
#undef PK4
}
__device__ __forceinline__ void qkt(f32x16& p0, f32x16& p1, const char* Ks, const bf16x8* qr, int r32, int hi) {
  p0 = f32x16{}; p1 = f32x16{};
  const int swz = ((r32 >> 1) & 7) << 4;
  const char* b4[4];
#pragma unroll
  for (int dr = 0; dr < 4; ++dr) b4[dr] = Ks + r32 * 384 + ((dr * 32 + hi * 16) ^ swz);
#pragma unroll
  for (int d0 = 0; d0 < 12; ++d0) {
    bf16x8 b0 = *reinterpret_cast<const bf16x8*>(b4[d0 & 3] + (d0 >> 2) * 128);
    bf16x8 b1 = *reinterpret_cast<const bf16x8*>(b4[d0 & 3] + (d0 >> 2) * 128 + 32 * 384);
    p0 = __builtin_amdgcn_mfma_f32_32x32x16_bf16(b0, qr[d0], p0, 0, 0, 0);
    p1 = __builtin_amdgcn_mfma_f32_32x32x16_bf16(b1, qr[d0], p1, 0, 0, 0); }
}
__device__ __forceinline__ int v_st(int k, int c) { const int kk = (k & ~0xC) | ((k & 4) << 1) | ((k & 8) >> 1); return ((kk >> 3) * 4 + (c >> 5)) * 512 + ((kk & 7) * 32 + (c & 31)) * 2; }
__device__ __forceinline__ int v_rd_base(int lane) { return ((lane & 3) << 3) | (((lane >> 2) & 3) << 6) | (((lane >> 4) & 1) << 5) | (((lane >> 5) & 1) << 8); }
constexpr int v_rd_off(int d0, int ks, int half) { return d0 * 512 + ks * 4096 + half * 2048; }
template <int OFF> __device__ __forceinline__ s16x4 tr_read(int vb) {
  s16x4 r; asm volatile("ds_read_b64_tr_b16 %0, %1 offset:%2" : "=&v"(r) : "v"(vb), "i"(OFF) : "memory"); return r;
}
template <int D0> __device__ __forceinline__ void pv_one(f32x16& od, int vb, bf16x8 pa0, bf16x8 pa1, bf16x8 pa2, bf16x8 pa3) {
  const s16x4 l0 = tr_read<v_rd_off(D0, 0, 0)>(vb), h0 = tr_read<v_rd_off(D0, 0, 1)>(vb), l1 = tr_read<v_rd_off(D0, 1, 0)>(vb), h1 = tr_read<v_rd_off(D0, 1, 1)>(vb);
  const s16x4 l2 = tr_read<v_rd_off(D0, 2, 0)>(vb), h2 = tr_read<v_rd_off(D0, 2, 1)>(vb), l3 = tr_read<v_rd_off(D0, 3, 0)>(vb), h3 = tr_read<v_rd_off(D0, 3, 1)>(vb);
  asm volatile("s_waitcnt lgkmcnt(0)" ::: "memory"); SBAR();
#define PK(L, H) (bf16x8){L[0], L[1], L[2], L[3], H[0], H[1], H[2], H[3]}
  od = __builtin_amdgcn_mfma_f32_32x32x16_bf16(pa0, PK(l0, h0), od, 0, 0, 0);
  od = __builtin_amdgcn_mfma_f32_32x32x16_bf16(pa1, PK(l1, h1), od, 0, 0, 0);
  od = __builtin_amdgcn_mfma_f32_32x32x16_bf16(pa2, PK(l2, h2), od, 0, 0, 0);
  od = __builtin_amdgcn_mfma_f32_32x32x16_bf16(pa3, PK(l3, h3), od, 0, 0, 0);
#undef PK
}
__device__ __forceinline__ void pv_d0(f32x16* o, int vb, bf16x8 pa0, bf16x8 pa1, bf16x8 pa2, bf16x8 pa3) {
  pv_one<0>(o[0], vb, pa0, pa1, pa2, pa3); pv_one<1>(o[1], vb, pa0, pa1, pa2, pa3); pv_one<2>(o[2], vb, pa0, pa1, pa2, pa3); pv_one<3>(o[3], vb, pa0, pa1, pa2, pa3);
}
__device__ __forceinline__ void attn_body(const int wv_, const bf16_t* __restrict__ Qb, const bf16_t* __restrict__ Kh, const bf16_t* __restrict__ Vh, bf16_t* __restrict__ Ob, int ldo, int seq, char* lds, const float* __restrict__ ropecs  ) {
  const int tid = tidx_w(wv_), wid = tid >> 6, lane = tid & 63, r32 = lane & 31, hi = lane >> 5;
  char* V_lds = lds; char* K_lds = lds + 2 * SHM_V;
  float* ws = (float*)(lds + 2 * SHM_V + 2 * SHM_K) + wid * 64; float* li_l = ws; float* al_l = ws + 32;
  float m_reg = -1e30f, l_reg = 0; f32x16 o[4] = {}; bf16x8 qr[12];
  const bf16_t* Qw = Qb + (long)(wid * 32 + r32) * DQK + hi * 8;
#pragma unroll
  for (int d0 = 0; d0 < 12; ++d0) qr[d0] = *reinterpret_cast<const bf16x8*>(Qw + d0 * 16);
  if (ropecs) {
    const float* cs = ropecs + (size_t)(wid * 32 + r32) * 64;
#pragma unroll
    for (int d0 = 8; d0 < 12; ++d0) { const int i0 = (d0 - 8) * 8 + hi * 4; const f32x4 c0 = *(const f32x4*)(cs + i0 * 2), c1 = *(const f32x4*)(cs + i0 * 2 + 4);
      u32x4 w = *reinterpret_cast<u32x4*>(&qr[d0]); const float cc[4] = {c0[0], c0[2], c1[0], c1[2]}, ss[4] = {c0[1], c0[3], c1[1], c1[3]};
#pragma unroll
      for (int m = 0; m < 4; ++m) { const float x1 = __uint_as_float(w[m] << 16), x2 = __uint_as_float(w[m] & 0xffff0000u); w[m] = cvtpk(x1 * cc[m] - x2 * ss[m], x1 * ss[m] + x2 * cc[m]); }
      qr[d0] = *reinterpret_cast<bf16x8*>(&w); }
  }
  const int sr = tid >> 4, sc = (tid & 15) * 8, vst0 = v_st(sr, sc), vst1 = v_st(32 + sr, sc);
  int kst[3];
#pragma unroll
  for (int i = 0; i < 3; ++i) { const int c = tid + 512 * i, row = c / 24, cc = c % 24; kst[i] = KSWZ(row, cc * 16); }
  const int vb0 = (int)(uintptr_t)V_lds + v_rd_base(lane);
  struct { bf16x8 vs0, vs1, ks0, ks1, ks2; } sr_[1];
#define SLOAD(i, k0) do { const bf16_t* vt = Vh + (long)(k0) * DV; const bf16_t* kt = Kh + (long)(k0) * DQK; \
    sr_[i].vs0 = *reinterpret_cast<const bf16x8*>(vt + (sr) * DV + sc); sr_[i].vs1 = *reinterpret_cast<const bf16x8*>(vt + (32 + sr) * DV + sc); \
    sr_[i].ks0 = *reinterpret_cast<const bf16x8*>(kt + tid * 8); sr_[i].ks1 = *reinterpret_cast<const bf16x8*>(kt + (tid + 512) * 8); sr_[i].ks2 = *reinterpret_cast<const bf16x8*>(kt + (tid + 1024) * 8); } while (0)
#define SWRITE(b, i) do { *(bf16x8*)(V_lds + (b) * SHM_V + vst0) = sr_[i].vs0; *(bf16x8*)(V_lds + (b) * SHM_V + vst1) = sr_[i].vs1; \
    *(bf16x8*)(K_lds + (b) * SHM_K + kst[0]) = sr_[i].ks0; *(bf16x8*)(K_lds + (b) * SHM_K + kst[1]) = sr_[i].ks1; *(bf16x8*)(K_lds + (b) * SHM_K + kst[2]) = sr_[i].ks2; } while (0)
#define SWAIT() asm volatile("s_waitcnt vmcnt(5)" ::: "memory")
#define RESC(a) do { if (__any((a) < 1.f)) { if (hi == 0) al_l[r32] = (a); asm volatile("s_waitcnt lgkmcnt(0)" ::: "memory"); \
    _Pragma("unroll") for (int d = 0; d < 4; ++d) _Pragma("unroll") for (int r = 0; r < 16; ++r) o[d][r] *= al_l[crow(r, hi)]; } } while (0)
  f32x16 pA0, pA1; float mnA, alA; bf16x8 pa0, pa1, pa2, pa3; const int NT = seq / KVBLK;
  SLOAD(0, 0); SWRITE(0, 0);
  SLOAD(0, KVBLK);
  __syncthreads();
  for (int j = 0; j < NT; j += 2) {
    SBAR(); qkt(pA0, pA1, K_lds, qr, r32, hi);
    partialSM(pA0, pA1, m_reg, mnA, alA); RESC(alA);
    finishSM(pA0, pA1, alA, l_reg, pa0, pa1, pa2, pa3); SBAR();
    SWRITE(1, 0);
    if (j + 2 < NT) SLOAD(0, (j + 2) * KVBLK);
    SBAR();
    pv_d0(o, vb0, pa0, pa1, pa2, pa3);
    __syncthreads();
    SBAR(); qkt(pA0, pA1, K_lds + SHM_K, qr, r32, hi);
    partialSM(pA0, pA1, m_reg, mnA, alA); RESC(alA);
    finishSM(pA0, pA1, alA, l_reg, pa0, pa1, pa2, pa3); SBAR();
    if (j + 2 < NT) { SWRITE(0, 0); if (j + 3 < NT) SLOAD(0, (j + 3) * KVBLK); }
    SBAR();
    pv_d0(o, vb0 + SHM_V, pa0, pa1, pa2, pa3);
    __syncthreads();
  }
  if (hi == 0) li_l[r32] = l_reg; asm volatile("s_waitcnt lgkmcnt(0)" ::: "memory");
  float rli[16];
#pragma unroll
  for (int r = 0; r < 16; ++r) rli[r] = __builtin_amdgcn_rcpf(li_l[crow(r, hi)]);
  bf16_t* Ow = Ob + (long)(wid * 32) * ldo;
#pragma unroll
  for (int r = 0; r < 16; ++r) { int orow = crow(r, hi);
#pragma unroll
    for (int d0 = 0; d0 < 4; ++d0) Ow[(long)orow * ldo + d0 * 32 + r32] = f2bf(o[d0][r] * rli[r]); }
  __syncthreads();
#undef SLOAD
#undef SWRITE
#undef SWAIT
#undef RESC
}
#undef KSWZ
}

__device__ void ph_attn(const Params& p, char* lds) {
    const bf16_t* Q = (const bf16_t*)(p.ws + OFF_Q); const bf16_t* K = (const bf16_t*)(p.ws + OFF_K); const bf16_t* V = (const bf16_t*)(p.ws + OFF_V);
    bf16_t* O = (bf16_t*)(p.ws + OFF_O);
    const int G = gdim();
    for (int i = 0;; ++i) {
        const int L = i * G + bidx(); if (L >= 544) break;
        int bh, qb;
        if (L < 512) { const int w = g8::xcd_remap(L, 512); bh = w >> 4; qb = 1 + (w & 15); } else { bh = L - 512; qb = 0; }
        const int b = bh >> 3, h = bh & 7;
        const int seq = qb == 0 ? TC : TK;
        const int row0 = qb == 0 ? NLAT + b * TC : b * TL + (qb - 1) * 256;
        fa::attn_body(p.wv, Q + ((size_t)bh * TK + qb * 256) * 192, K + (size_t)bh * TK * 192, V + (size_t)bh * TK * 128, O + (size_t)row0 * D + h * 128, D, seq, lds,
                      qb == 0 ? nullptr : (const float*)(p.ws + OFF_ROPE_C) + (size_t)(qb - 1) * 256 * 64);
    }
}

__device__ void ph_norm2_router(const Params& p, int layer, char* lds, int nrows) {
    const int tid = tidx(), wid = tid >> 6, lane = tid & 63;
    float* rt = (float*)lds;
    const float* rg = p.moe_router + (size_t)layer * D * NE;
    for (int i = tid; i < D * NE / 4; i += NTHR) { const int d = i >> 2, eq = i & 3; ((float4*)rt)[(((d >> 8) * 4 + (d & 3)) * 4 + eq) * 64 + ((d & 255) >> 2)] = ((const float4*)rg)[i]; }
    __syncthreads();
    const float* X = (const float*)(p.ws + OFF_X); bf16_t* BN = (bf16_t*)(p.ws + OFF_H); float* AFF = (float*)(p.ws + OFF_AFF);
    const float* g = p.norm2_g + layer * D;
    int row = bidx() * 8 + wid;
    float4 nv[4];
    if (row < nrows) {
#pragma unroll
        for (int i = 0; i < 4; ++i) nv[i] = ((const float4*)(X + (size_t)row * D))[lane + i * 64]; }
    for (; row < nrows; row += gdim() * 8) {
        const int s = row_stream(row);
        const float* sh = modp(p, layer, s, 3); const float* sc = modp(p, layer, s, 4);
        float4 v[4]; float ss = 0;
#pragma unroll
        for (int i = 0; i < 4; ++i) { v[i] = nv[i]; ss += v[i].x * v[i].x + v[i].y * v[i].y + v[i].z * v[i].z + v[i].w * v[i].w; }
        { const int nrow = row + gdim() * 8;
          if (nrow < nrows) {
#pragma unroll
              for (int i = 0; i < 4; ++i) nv[i] = ((const float4*)(X + (size_t)nrow * D))[lane + i * 64]; } }
        ss = wave_sum(ss); const float rs = rsqrtf(ss * (1.f / D) + RMS_EPS);
        float lg[16];
#pragma unroll
        for (int e = 0; e < 16; ++e) lg[e] = 0.f;
#pragma unroll
        for (int i = 0; i < 4; ++i) {
            const int d = (lane + i * 64) * 4;
            const float4 gg = *(const float4*)(g + d), a = *(const float4*)(sc + d), b = *(const float4*)(sh + d);
            float o[4]; o[0] = v[i].x * rs * gg.x * (1.f + a.x) + b.x; o[1] = v[i].y * rs * gg.y * (1.f + a.y) + b.y; o[2] = v[i].z * rs * gg.z * (1.f + a.z) + b.z; o[3] = v[i].w * rs * gg.w * (1.f + a.w) + b.w;
            uint2 w; w.x = pk2(o[0], o[1]); w.y = pk2(o[2], o[3]); *(uint2*)(BN + (size_t)row * D + d) = w;
#pragma unroll
            for (int jj = 0; jj < 4; ++jj) {
#pragma unroll
                for (int eq = 0; eq < 4; ++eq) { const float4 r4 = ((const float4*)rt)[((i * 4 + jj) * 4 + eq) * 64 + lane];
                    lg[4 * eq] += o[jj] * r4.x; lg[4 * eq + 1] += o[jj] * r4.y; lg[4 * eq + 2] += o[jj] * r4.z; lg[4 * eq + 3] += o[jj] * r4.w; } }
            asm volatile("" ::: "memory");
        }
        float mx = -1e30f;
#pragma unroll
        for (int e = 0; e < 16; ++e) { lg[e] = wave_sum(lg[e]); mx = fmaxf(mx, lg[e]); }
        float sum = 0;
#pragma unroll
        for (int e = 0; e < 16; ++e) { lg[e] = expf(lg[e] - mx); sum += lg[e]; }
        const float inv = 1.f / sum;
        if (lane < 16) { float val = 0;
#pragma unroll
            for (int e = 0; e < 16; ++e) val = (lane == e) ? lg[e] : val;
            AFF[(size_t)row * 16 + lane] = val * inv; }
    }
}

__device__ void ph_select(const Params& p, char* lds, int ngroups) {
    const int tid = tidx(), wid = tid >> 6, lane = tid & 63;
    unsigned* hist = (unsigned*)lds;
    unsigned* ctl = hist + 256;
    unsigned* wsum = ctl + 8;
    int* rowl = (int*)(wsum + 16);
    const float* AFF = (const float*)(p.ws + OFF_AFF);
    int* ROWIDX = (int*)(p.ws + OFF_ROWIDX); float* GATE = (float*)(p.ws + OFF_GATE); int* SLOT = (int*)(p.ws + OFF_SLOT);
    for (int gidx = bidx(); gidx < ngroups; gidx += gdim()) {
        const bool lat = gidx < 64; const int b = (gidx & 63) >> 4, e = gidx & 15;
        const int n = lat ? TL : TC, cap = lat ? CAPL : CAPC;
        const int row0 = lat ? b * TL : NLAT + b * TC, slot0 = lat ? b * CAPL : NB * CAPL + b * CAPC;
        unsigned key[8];
#pragma unroll
        for (int i = 0; i < 8; ++i) { const int idx = tid * 8 + i; key[i] = idx < n ? __float_as_uint(AFF[(size_t)(row0 + idx) * 16 + e]) : 0u; }
        unsigned prefix = 0u, remaining = (unsigned)cap;
#pragma unroll
        for (int pass = 0; pass < 4; ++pass) {
            const int sh = 24 - 8 * pass;
            __syncthreads();
            if (tid < 256) hist[tid] = 0u;
            __syncthreads();
#pragma unroll
            for (int i = 0; i < 8; ++i) { const int idx = tid * 8 + i;
                const bool cand = idx < n && (pass == 0 || (key[i] >> (sh + 8)) == prefix);
                if (cand) atomicAdd(&hist[(key[i] >> sh) & 255u], 1u); }
            __syncthreads();
            if (tid < 256) { unsigned gt = 0; for (int jj = tid + 1; jj < 256; ++jj) gt += hist[jj];
                const unsigned mine = hist[tid];
                if (gt < remaining && remaining <= gt + mine) { ctl[0] = (unsigned)tid; ctl[1] = remaining - gt; } }
            __syncthreads();
            prefix = (prefix << 8) | ctl[0]; remaining = ctl[1];
        }
        const unsigned T = prefix, m = remaining;
        unsigned cgt = 0, ceq = 0;
#pragma unroll
        for (int i = 0; i < 8; ++i) { const int idx = tid * 8 + i; if (idx < n) { cgt += key[i] > T ? 1u : 0u; ceq += key[i] == T ? 1u : 0u; } }
        auto block_excl = [&](unsigned v) -> unsigned {
            unsigned inc = v;
#pragma unroll
            for (int o = 1; o < 64; o <<= 1) { const unsigned t = (unsigned)__builtin_amdgcn_ds_bpermute((lane - o) << 2, (int)inc); if (lane >= o) inc += t; }
            __syncthreads();
            if (lane == 63) wsum[wid] = inc;
            __syncthreads();
            unsigned base = 0;
#pragma unroll
            for (int w = 0; w < 8; ++w) base += (w < wid) ? wsum[w] : 0u;
            return base + inc - v; };
        unsigned eqbase = block_excl(ceq);
        unsigned nsel = 0; bool sel[8];
#pragma unroll
        for (int i = 0; i < 8; ++i) { const int idx = tid * 8 + i; bool s_ = false;
            if (idx < n) { if (key[i] > T) s_ = true; else if (key[i] == T) { s_ = eqbase < m; ++eqbase; } }
            sel[i] = s_; nsel += s_ ? 1u : 0u; }
        unsigned sbase = block_excl(nsel);
#pragma unroll
        for (int i = 0; i < 8; ++i) { const int idx = tid * 8 + i;
            if (idx < n) {
                if (sel[i]) { const int sl = slot0 + (int)sbase; rowl[sbase] = row0 + idx; ++sbase; ROWIDX[e * ESLOTS + sl] = row0 + idx; GATE[e * EPAD + sl] = __uint_as_float(key[i]); SLOT[(size_t)(row0 + idx) * 16 + e] = sl; }
                else SLOT[(size_t)(row0 + idx) * 16 + e] = -1; } }
        __syncthreads();
        { const bf16_t* BN = (const bf16_t*)(p.ws + OFF_H); bf16_t* XE = (bf16_t*)(p.ws + OFF_XE);
          for (int r = wid; r < cap; r += 32) {
              u32x4 t_[4][2];
#pragma unroll
              for (int u = 0; u < 4; ++u) { const u32x4* src = (const u32x4*)(BN + (size_t)rowl[r + 8 * u] * D); t_[u][0] = src[lane]; t_[u][1] = src[lane + 64]; }
#pragma unroll
              for (int u = 0; u < 4; ++u) { u32x4* dst = (u32x4*)(XE + ((size_t)e * EPAD + slot0 + r + 8 * u) * D); dst[lane] = t_[u][0]; dst[lane + 64] = t_[u][1]; } } }
    }
}

__device__ void ph_gather(const Params& p, int nslots) {
    const int wid = tidx() >> 6, lane = tidx() & 63;
    const int* ROWIDX = (const int*)(p.ws + OFF_ROWIDX); const bf16_t* BN = (const bf16_t*)(p.ws + OFF_H); bf16_t* XE = (bf16_t*)(p.ws + OFF_XE);
    for (int it = bidx() * 8 + wid; it < NE * ESLOTS; it += gdim() * 8) {
        const int e = it / ESLOTS, sl = it % ESLOTS; if (sl >= nslots) continue; const int row = ROWIDX[it];
        const u32x4* src = (const u32x4*)(BN + (size_t)row * D); u32x4* dst = (u32x4*)(XE + ((size_t)e * EPAD + sl) * D);
        dst[lane] = src[lane]; dst[lane + 64] = src[lane + 64];
    }
}

__device__ void ph_combine(const Params& p, int layer, int nrows) {
    const int wid = tidx() >> 6, lane = tidx() & 63;
    const int* SLOT = (const int*)(p.ws + OFF_SLOT); const bf16_t* YE = (const bf16_t*)(p.ws + OFF_YE); float* X = (float*)(p.ws + OFF_X);
    int row = bidx() * 8 + wid;
    int sl = (row < nrows && lane < 16) ? SLOT[(size_t)row * 16 + lane] : -1;
    while (row < nrows) {
        const int nrow = row + gdim() * 8;
        const int sln = (nrow < nrows && lane < 16) ? SLOT[(size_t)nrow * 16 + lane] : -1;
        const float* gt = modp(p, layer, row_stream(row), 5);
        float* xr = X + (size_t)row * D + lane * 8;
        f32x4 xv[4];
#pragma unroll
        for (int i = 0; i < 2; ++i) { xv[2 * i] = *(const f32x4*)(xr + 512 * i); xv[2 * i + 1] = *(const f32x4*)(xr + 512 * i + 4); }
        unsigned long long m = __ballot(sl >= 0);
        float acc[16];
#pragma unroll
        for (int i = 0; i < 16; ++i) acc[i] = 0.f;
        while (m) {
            const int e0 = __builtin_ctzll(m); m &= m - 1; const bool two = m != 0; const int e1 = two ? __builtin_ctzll(m) : e0; if (two) m &= m - 1;
            const int s0 = __builtin_amdgcn_readlane(sl, e0), s1 = __builtin_amdgcn_readlane(sl, e1);
            const bf16_t* y0 = YE + ((size_t)e0 * EPAD + s0) * D + lane * 8; const bf16_t* y1 = YE + ((size_t)e1 * EPAD + s1) * D + lane * 8;
            const u32x4 a0 = *(const u32x4*)y0, a1 = *(const u32x4*)(y0 + 512), b0 = *(const u32x4*)y1, b1 = *(const u32x4*)(y1 + 512);
            const float f1 = two ? 1.f : 0.f;
#pragma unroll
            for (int i = 0; i < 4; ++i) { acc[2 * i] += __uint_as_float(a0[i] << 16) + f1 * __uint_as_float(b0[i] << 16); acc[2 * i + 1] += __uint_as_float(a0[i] & 0xffff0000u) + f1 * __uint_as_float(b0[i] & 0xffff0000u);
                acc[8 + 2 * i] += __uint_as_float(a1[i] << 16) + f1 * __uint_as_float(b1[i] << 16); acc[8 + 2 * i + 1] += __uint_as_float(a1[i] & 0xffff0000u) + f1 * __uint_as_float(b1[i] & 0xffff0000u); }
        }
#pragma unroll
        for (int i = 0; i < 2; ++i) { const f32x4 g0 = *(const f32x4*)(gt + lane * 8 + 512 * i), g1 = *(const f32x4*)(gt + lane * 8 + 512 * i + 4);
            f32x4 o0 = xv[2 * i], o1 = xv[2 * i + 1];
#pragma unroll
            for (int e = 0; e < 4; ++e) { o0[e] += g0[e] * acc[8 * i + e]; o1[e] += g1[e] * acc[8 * i + 4 + e]; }
            *(f32x4*)(xr + 512 * i) = o0; *(f32x4*)(xr + 512 * i + 4) = o1; }
        row = nrow; sl = sln;
    }
}

__device__ void ph_rw_normxs(const Params& p, int layer, int j) {
    const int wid = tidx() >> 6, lane = tidx() & 63;
    const float* X = (const float*)(p.ws + OFF_X); bf16_t* XS = (bf16_t*)(p.ws + OFF_XS);
    const float* mu = p.rw_mu + (size_t)j * 6 * D; const float* g = p.norm1_g + layer * D;
    float4 fc[4], fp[4], fn[4];
#define XS_LOAD(R) do { const bool lat_ = (R) < NLAT; const int t_ = lat_ ? ((R) & (TL - 1)) : (((R) - NLAT) & (TC - 1)); const int len_ = lat_ ? TL : TC; \
        _Pragma("unroll") for (int i = 0; i < 4; ++i) { fc[i] = ((const float4*)(X + (size_t)(R) * D))[lane + i * 64]; \
            fp[i] = t_ > 0 ? ((const float4*)(X + (size_t)((R) - 1) * D))[lane + i * 64] : make_float4(0, 0, 0, 0); \
            fn[i] = t_ < len_ - 1 ? ((const float4*)(X + (size_t)((R) + 1) * D))[lane + i * 64] : make_float4(0, 0, 0, 0); } } while (0)
    int row = bidx() * 8 + wid;
    if (row < NROW) XS_LOAD(row);
    for (; row < NROW; row += gdim() * 8) {
        const int s_ = row_stream(row);
        const float* sh = modp(p, layer, s_, 0); const float* sc = modp(p, layer, s_, 1);
        const bool lat = row < NLAT; const int t = lat ? (row & (TL - 1)) : ((row - NLAT) & (TC - 1)); const int len = lat ? TL : TC;
        const bool hp = t > 0, hn = t < len - 1;
        float4 xc[4], xp[4], xn[4]; float sc_ = 0, sp_ = 0, sn_ = 0;
#pragma unroll
        for (int i = 0; i < 4; ++i) { xc[i] = fc[i]; xp[i] = fp[i]; xn[i] = fn[i]; }
        { const int nrow = row + gdim() * 8; if (nrow < NROW) XS_LOAD(nrow); }
#pragma unroll
        for (int i = 0; i < 4; ++i) {
            sc_ += xc[i].x * xc[i].x + xc[i].y * xc[i].y + xc[i].z * xc[i].z + xc[i].w * xc[i].w;
            sp_ += xp[i].x * xp[i].x + xp[i].y * xp[i].y + xp[i].z * xp[i].z + xp[i].w * xp[i].w;
            sn_ += xn[i].x * xn[i].x + xn[i].y * xn[i].y + xn[i].z * xn[i].z + xn[i].w * xn[i].w; }
        sc_ = wave_sum(sc_); sp_ = wave_sum(sp_); sn_ = wave_sum(sn_);
        const float rc = rsqrtf(sc_ * (1.f / D) + RMS_EPS), rp = hp ? rsqrtf(sp_ * (1.f / D) + RMS_EPS) : 0.f, rn = hn ? rsqrtf(sn_ * (1.f / D) + RMS_EPS) : 0.f;
#pragma unroll
        for (int i = 0; i < 4; ++i) {
            const int d = (lane + i * 64) * 4;
            const float4 gg = *(const float4*)(g + d), a = *(const float4*)(sc + d), bsh = *(const float4*)(sh + d);
            float h[4], xx[4];
            const float gm[4] = {gg.x * (1.f + a.x), gg.y * (1.f + a.y), gg.z * (1.f + a.z), gg.w * (1.f + a.w)}; const float bb[4] = {bsh.x, bsh.y, bsh.z, bsh.w};
            const float c4[4] = {xc[i].x, xc[i].y, xc[i].z, xc[i].w}, p4[4] = {xp[i].x, xp[i].y, xp[i].z, xp[i].w}, n4[4] = {xn[i].x, xn[i].y, xn[i].z, xn[i].w};
#pragma unroll
            for (int e = 0; e < 4; ++e) { h[e] = c4[e] * rc * gm[e] + bb[e];
                const float hpv = hp ? p4[e] * rp * gm[e] + bb[e] : 0.f, hnv = hn ? n4[e] * rn * gm[e] + bb[e] : 0.f;
                xx[e] = 0.5f * (hpv + hnv) - h[e]; }
#pragma unroll
            for (int m = 0; m < 6; ++m) { const float4 u = *(const float4*)(mu + m * D + d);
                uint2 w; w.x = pk2(h[0] + xx[0] * u.x, h[1] + xx[1] * u.y); w.y = pk2(h[2] + xx[2] * u.z, h[3] + xx[3] * u.w);
                *(uint2*)(XS + ((size_t)m * NROW + row) * D + d) = w; }
        }
    }
#undef XS_LOAD
}

__device__ __forceinline__ int scan_row(int i, int b, int z) {
    return i < TC ? NLAT + b * TC + (z ? TC - 1 - i : i) : b * TL + (z ? TL - 1 - (i - TC) : i - TC);
}
__device__ __forceinline__ float dpp_sum8(float x) {
    x += __builtin_bit_cast(float, __builtin_amdgcn_update_dpp(0, __builtin_bit_cast(int, x), 0xB1, 0xF, 0xF, true));
    x += __builtin_bit_cast(float, __builtin_amdgcn_update_dpp(0, __builtin_bit_cast(int, x), 0x4E, 0xF, 0xF, true));
    x += __builtin_bit_cast(float, __builtin_amdgcn_update_dpp(0, __builtin_bit_cast(int, x), 0x141, 0xF, 0xF, true));
    return x;
}
__device__ void ph_rw_scan(const Params& p, int j, char* lds) {
    const int tid = tidx(), wid = __builtin_amdgcn_readfirstlane(tid >> 6), lane = tid & 63;
    const size_t PL = (size_t)NROW * D;
    const float* RKV = (const float*)(p.ws + OFF_RKV); float* Y = (float*)(p.ws + OFF_Y);
    constexpr int CH = 32, BUFB = 5 * CH * 256 + CH * 128 + CH * 16, YB = CH * 32 * 4, NCH = (TC + TL) / CH;
    const bool loader = wid >= 4; const int lw = wid - 4;
    for (int it = bidx(); it < 256; it += gdim()) {
        const int vh = it & 1, z = (it >> 1) & 1, h = (it >> 2) & 15, b = it >> 6;
        const char* pl0 = (const char*)((const float*)(p.ws + OFF_W) + z * PL); const char* pl1 = (const char*)(RKV + PL);
        const char* pl2 = (const char*)((const float*)(p.ws + OFF_AV) + z * PL); const char* pl3 = (const char*)RKV;
        const char* vpl = (const char*)(RKV + 2 * PL);
        float* yout = Y + z * PL;
        __builtin_amdgcn_s_barrier();
        if (loader) {
            const int pq = lane & 15;
            const f32x4 kkv = *(const f32x4*)(p.rw_k_k + j * D + h * 64 + pq * 4), kav = *(const f32x4*)(p.rw_k_a + j * D + h * 64 + pq * 4);
            auto issue = [&](int c) {
                char* buf = lds + (c % 3) * BUFB;
#pragma unroll
                for (int q = 0; q < 8; ++q) { const int pi = q >> 1, tg = lw * 2 + (q & 1); const int row = scan_row(c * CH + tg * 4 + (lane >> 4), b, z);
                    const char* base = pi == 0 ? pl0 : pi == 1 ? pl1 : pi == 2 ? pl2 : pl3;
                    __builtin_amdgcn_global_load_lds((const unsigned*)(base + (size_t)row * D * 4 + h * 256 + (lane & 15) * 16), (LAS unsigned*)(buf + pi * (CH * 256) + tg * 1024), 16, 0, 0); }
                { const int row = scan_row(c * CH + lw * 8 + (lane >> 3), b, z);
                  __builtin_amdgcn_global_load_lds((const unsigned*)(vpl + (size_t)row * D * 4 + (h * 64 + vh * 32) * 4 + (lane & 7) * 16), (LAS unsigned*)(buf + 5 * CH * 256 + lw * 1024), 16, 0, 0); }
            };
            auto prep = [&](int c) {
                char* buf = lds + (c % 3) * BUFB;
#pragma unroll
                for (int ps = 0; ps < 2; ++ps) { const int ptok = lw * 8 + ps * 4 + (lane >> 4);
                    f32x4* kp = (f32x4*)(buf + 1 * CH * 256 + ptok * 256 + pq * 16); f32x4* ap = (f32x4*)(buf + 2 * CH * 256 + ptok * 256 + pq * 16); f32x4* dp = (f32x4*)(buf + 4 * CH * 256 + ptok * 256 + pq * 16);
                    f32x4* rp = (f32x4*)(buf + 3 * CH * 256 + ptok * 256 + pq * 16); const f32x4 wv = *(const f32x4*)(buf + ptok * 256 + pq * 16);
                    const f32x4 k = *kp, a = *ap, r = *rp; f32x4 kk = k * kkv;
                    float ss = kk[0] * kk[0] + kk[1] * kk[1] + kk[2] * kk[2] + kk[3] * kk[3]; ss = dpp_sum16(ss);
                    const float inv = 1.f / fmaxf(sqrtf(ss), 1e-12f); kk = kk * inv;
                    const f32x4 kd = k * (1.f + (a - 1.f) * kav), bb = kk * a;
                    const f32x4 t1 = bb * r, t2 = kd * r;
                    const float br = dpp_sum16((t1[0] + t1[1]) + (t1[2] + t1[3])), kr = dpp_sum16((t2[0] + t2[1]) + (t2[2] + t2[3]));
                    *dp = kd; *ap = bb; *kp = kk; *rp = wv * r;
                    if (pq == 0) *(float2*)(buf + 5 * CH * 256 + CH * 128 + ptok * 16) = make_float2(br, kr); }
            };
            issue(0); issue(1);
            asm volatile("s_waitcnt vmcnt(9)" ::: "memory");
            prep(0);
            asm volatile("s_waitcnt lgkmcnt(0)" ::: "memory"); __builtin_amdgcn_s_barrier();
            for (int c = 0; c < NCH; ++c) {
                if (c >= 1) { const float* yb = (const float*)(lds + 3 * BUFB + ((c - 1) & 1) * YB);
                    const int lt = tid - 256, t = lt >> 3, q = lt & 7; const int row = scan_row((c - 1) * CH + t, b, z);
                    *(f32x4*)(yout + (size_t)row * D + h * 64 + vh * 32 + q * 4) = *(const f32x4*)(yb + t * 32 + q * 4); }
                if (c + 2 < NCH) { issue(c + 2); asm volatile("s_waitcnt vmcnt(9)" ::: "memory"); } else asm volatile("s_waitcnt vmcnt(0)" ::: "memory");
                if (c + 1 < NCH) prep(c + 1);
                asm volatile("s_waitcnt lgkmcnt(0)" ::: "memory"); __builtin_amdgcn_s_barrier();
            }
            { const float* yb = (const float*)(lds + 3 * BUFB + ((NCH - 1) & 1) * YB);
              const int lt = tid - 256, t = lt >> 3, q = lt & 7; const int row = scan_row((NCH - 1) * CH + t, b, z);
              *(f32x4*)(yout + (size_t)row * D + h * 64 + vh * 32 + q * 4) = *(const f32x4*)(yb + t * 32 + q * 4); }
        } else {
            const int vr = lane >> 3, ks = lane & 7;
            f32x4 Sa = {0.f, 0.f, 0.f, 0.f}, Sb = {0.f, 0.f, 0.f, 0.f};
            __builtin_amdgcn_s_barrier();
            struct Ops { f32x4 w0, w1, kk0, kk1, bb0, bb1, r0, r1, kd0, kd1; float v; float2 sc; };
#define SC_LOAD(O, t) do { const char* q_ = bq + (t) * 256; O.w0 = *(const f32x4*)(q_); O.w1 = *(const f32x4*)(q_ + 16); O.kk0 = *(const f32x4*)(q_ + CH * 256); O.kk1 = *(const f32x4*)(q_ + CH * 256 + 16); \
                O.bb0 = *(const f32x4*)(q_ + 2 * CH * 256); O.bb1 = *(const f32x4*)(q_ + 2 * CH * 256 + 16); O.r0 = *(const f32x4*)(q_ + 3 * CH * 256); O.r1 = *(const f32x4*)(q_ + 3 * CH * 256 + 16); \
                O.kd0 = *(const f32x4*)(q_ + 4 * CH * 256); O.kd1 = *(const f32x4*)(q_ + 4 * CH * 256 + 16); O.v = *(const float*)(vq + (t) * 128); O.sc = *(const float2*)(buf + 5 * CH * 256 + CH * 128 + (t) * 16); } while (0)
#define SC_STEP(O, t) do { const f32x4 d1 = Sa * O.kk0 + Sb * O.kk1, d2 = Sa * O.r0 + Sb * O.r1; \
                float sa = -((d1[0] + d1[1]) + (d1[2] + d1[3])), yy = (d2[0] + d2[1]) + (d2[2] + d2[3]); \
                sa = dpp_sum8(sa); yy = dpp_sum8(yy); \
                Sa = Sa * O.w0 + (sa * O.bb0 + O.v * O.kd0); Sb = Sb * O.w1 + (sa * O.bb1 + O.v * O.kd1); \
                if (ks == 0) yb[(t) * 32 + wid * 8 + vr] = yy + sa * O.sc.x + O.v * O.sc.y; } while (0)
            for (int c = 0; c < NCH; ++c) {
                const char* buf = lds + (c % 3) * BUFB; float* yb = (float*)(lds + 3 * BUFB + (c & 1) * YB);
                const char* bq = buf + ks * 32; const char* vq = buf + 5 * CH * 256 + (wid * 8 + vr) * 4;
                Ops oA, oB, oC;
                SC_LOAD(oA, 0); SC_LOAD(oB, 1);
#pragma unroll
                for (int t = 0; t < CH; t += 3) {
                    if (t + 2 < CH) SC_LOAD(oC, t + 2);
                    SC_STEP(oA, t);
                    if (t + 3 < CH) SC_LOAD(oA, t + 3);
                    if (t + 1 < CH) SC_STEP(oB, t + 1);
                    if (t + 4 < CH) SC_LOAD(oB, t + 4);
                    if (t + 2 < CH) SC_STEP(oC, t + 2);
                }
                asm volatile("s_waitcnt lgkmcnt(0)" ::: "memory"); __builtin_amdgcn_s_barrier();
            }
#undef SC_LOAD
#undef SC_STEP
        }
    }
}


namespace ck {
constexpr int P = 72, MB = 64 * P * 2;
typedef __attribute__((address_space(3))) char lchar;
__device__ __forceinline__ f32x4 mm_tile(const lchar* Aop, const lchar* Bop, int ti, int tj, int c, int q, f32x4 acc) {
#pragma unroll
    for (int ks = 0; ks < 2; ++ks) {
        const bf16x8 a = *(const LAS bf16x8*)(Aop + ((16 * ti + c) * P + 32 * ks + 8 * q) * 2);
        const bf16x8 b = *(const LAS bf16x8*)(Bop + ((16 * tj + c) * P + 32 * ks + 8 * q) * 2);
        acc = __builtin_amdgcn_mfma_f32_16x16x32_bf16(a, b, acc, 0, 0, 0);
    }
    return acc;
}
__device__ __forceinline__ f32x4 mm_diag(const lchar* Aop, const lchar* Bop, int tt, int c, int q, f32x4 acc) {
    const int ks = tt >> 1;
    bf16x8 a = *(const LAS bf16x8*)(Aop + ((16 * tt + c) * P + 32 * ks + 8 * q) * 2);
    const bf16x8 b = *(const LAS bf16x8*)(Bop + ((16 * tt + c) * P + 32 * ks + 8 * q) * 2);
    if ((q >> 1) != (tt & 1)) a = (bf16x8){0, 0, 0, 0, 0, 0, 0, 0};
    return __builtin_amdgcn_mfma_f32_16x16x32_bf16(a, b, acc, 0, 0, 0);
}
__device__ __forceinline__ void st_tile(lchar* dst, int ti, int tj, int c, int q, f32x4 v) {
    u32x2 w; w.x = pk2(v[0], v[1]); w.y = pk2(v[2], v[3]); *(LAS u32x2*)(dst + ((16 * tj + c) * P + 16 * ti + 4 * q) * 2) = w;
}
__device__ __forceinline__ f32x4 ld_tile(const lchar* src, int ti, int tj, int c, int q) {
    const u32x2 w = *(const LAS u32x2*)(src + ((16 * tj + c) * P + 16 * ti + 4 * q) * 2);
    return (f32x4){__uint_as_float(w.x << 16), __uint_as_float(w.x & 0xffff0000u), __uint_as_float(w.y << 16), __uint_as_float(w.y & 0xffff0000u)};
}
__device__ __forceinline__ void st_glob(bf16_t* dst, int ti, int tj, int c, int q, f32x4 v) {
    uint2 w; w.x = pk2(v[0], v[1]); w.y = pk2(v[2], v[3]); *(uint2*)(dst + (16 * tj + c) * 64 + 16 * ti + 4 * q) = w;
}
typedef float f32x16 __attribute__((ext_vector_type(16)));
__device__ __forceinline__ f32x16 mm32(const lchar* Aop, const lchar* Bop, int ti, int tj, int r32, int hi, f32x16 acc) {
#pragma unroll
    for (int ks = 0; ks < 4; ++ks) {
        const bf16x8 a = *(const LAS bf16x8*)(Aop + ((32 * ti + r32) * P + 16 * ks + 8 * hi) * 2);
        const bf16x8 b = *(const LAS bf16x8*)(Bop + ((32 * tj + r32) * P + 16 * ks + 8 * hi) * 2);
        acc = __builtin_amdgcn_mfma_f32_32x32x16_bf16(a, b, acc, 0, 0, 0);
    }
    return acc;
}
__device__ __forceinline__ void st32(lchar* dst, int ti, int tj, int r32, int hi, const f32x16& v) {
#pragma unroll
    for (int g = 0; g < 4; ++g) { u32x2 w; w.x = pk2(v[4 * g], v[4 * g + 1]); w.y = pk2(v[4 * g + 2], v[4 * g + 3]); *(LAS u32x2*)(dst + ((32 * tj + r32) * P + 32 * ti + 8 * g + 4 * hi) * 2) = w; }
}
__device__ __forceinline__ f32x16 ld32(const lchar* src, int ti, int tj, int r32, int hi) {
    f32x16 v;
#pragma unroll
    for (int g = 0; g < 4; ++g) { const u32x2 w = *(const LAS u32x2*)(src + ((32 * tj + r32) * P + 32 * ti + 8 * g + 4 * hi) * 2);
        v[4 * g] = __uint_as_float(w.x << 16); v[4 * g + 1] = __uint_as_float(w.x & 0xffff0000u); v[4 * g + 2] = __uint_as_float(w.y << 16); v[4 * g + 3] = __uint_as_float(w.y & 0xffff0000u); }
    return v;
}
__device__ __forceinline__ void stg32(bf16_t* dst, int ti, int tj, int r32, int hi, const f32x16& v) {
#pragma unroll
    for (int g = 0; g < 4; ++g) { uint2 w; w.x = pk2(v[4 * g], v[4 * g + 1]); w.y = pk2(v[4 * g + 2], v[4 * g + 3]); *(uint2*)(dst + (32 * tj + r32) * 64 + 32 * ti + 8 * g + 4 * hi) = w; }
}
}

#define LBAR() do { asm volatile("s_waitcnt lgkmcnt(0)" ::: "memory"); __builtin_amdgcn_s_barrier(); asm volatile("" ::: "memory"); } while (0)
__device__ void ph_rw_sc1(const Params& p, int j, char* lds) {
    using namespace ck;
    const int tid = tidx(), wid = __builtin_amdgcn_readfirstlane(tid >> 6), lane = tid & 63, c = lane & 15, q = lane >> 4;
    const size_t PL = (size_t)NROW * D;
    const bf16_t* RKV = (const bf16_t*)(p.ws + OFF_RKV); const float* LW = (const float*)(p.ws + OFF_W); const bf16_t* AV = (const bf16_t*)(p.ws + OFF_AV);
    bf16_t* CK = (bf16_t*)(p.ws + OFF_CK);
    lchar* B0 = (lchar*)lds;
#define BUF(i) (B0 + (i) * MB)
    LAS float* Lbuf = (LAS float*)BUF(8);
    LAS float* Lseg = (LAS float*)(B0 + 16 * MB);
    LAS float* GC = Lseg + 8 * 64;
    const int pt = tid >> 3, cg = tid & 7;
    f32x4 nlw[2], nkk[2], nka[2]; u32x4 nkx, nax, nrx, nvx;
#define SC1_LOAD(IT) do { const int seq_ = (IT) / NCHK, ch_ = (IT) % NCHK; const int z_ = seq_ & 1, h_ = (seq_ >> 1) & 15, b_ = seq_ >> 5; \
        const size_t go_ = (size_t)scan_row(ch_ * 64 + pt, b_, z_) * D + h_ * 64 + cg * 8; \
        _Pragma("unroll") for (int e = 0; e < 2; ++e) nlw[e] = *(const f32x4*)(LW + z_ * PL + go_ + 4 * e); \
        nkx = *(const u32x4*)(RKV + PL + go_); nax = *(const u32x4*)(AV + z_ * PL + go_); nrx = *(const u32x4*)(RKV + go_); nvx = *(const u32x4*)(RKV + 2 * PL + go_); \
        _Pragma("unroll") for (int e = 0; e < 2; ++e) { nkk[e] = *(const f32x4*)(p.rw_k_k + j * D + h_ * 64 + cg * 8 + 4 * e); nka[e] = *(const f32x4*)(p.rw_k_a + j * D + h_ * 64 + cg * 8 + 4 * e); } } while (0)
    if (bidx() < 128 * NCHK) SC1_LOAD(bidx());
    for (int it = bidx(); it < 128 * NCHK; it += gdim()) {
        const int seq = it / NCHK; const int h = (seq >> 1) & 15;
        f32x4 lw[2], kx[2], ax[2], rx[2], vx[2], kkc[2], kac[2];
#pragma unroll
        for (int e = 0; e < 2; ++e) { lw[e] = nlw[e]; kkc[e] = nkk[e]; kac[e] = nka[e];
            kx[e] = (f32x4){__uint_as_float(nkx[2 * e] << 16), __uint_as_float(nkx[2 * e] & 0xffff0000u), __uint_as_float(nkx[2 * e + 1] << 16), __uint_as_float(nkx[2 * e + 1] & 0xffff0000u)};
            ax[e] = (f32x4){__uint_as_float(nax[2 * e] << 16), __uint_as_float(nax[2 * e] & 0xffff0000u), __uint_as_float(nax[2 * e + 1] << 16), __uint_as_float(nax[2 * e + 1] & 0xffff0000u)};
            rx[e] = (f32x4){__uint_as_float(nrx[2 * e] << 16), __uint_as_float(nrx[2 * e] & 0xffff0000u), __uint_as_float(nrx[2 * e + 1] << 16), __uint_as_float(nrx[2 * e + 1] & 0xffff0000u)};
            vx[e] = (f32x4){__uint_as_float(nvx[2 * e] << 16), __uint_as_float(nvx[2 * e] & 0xffff0000u), __uint_as_float(nvx[2 * e + 1] << 16), __uint_as_float(nvx[2 * e + 1] & 0xffff0000u)}; }
        if (it + gdim() < 128 * NCHK) SC1_LOAD(it + gdim());
        LBAR();
#pragma unroll
        for (int e = 0; e < 2; ++e) *(LAS f32x4*)(Lbuf + pt * 64 + cg * 8 + 4 * e) = lw[e];
        f32x4 kk[2], bq[2], kd[2];
        { float ss = 0.f;
#pragma unroll
          for (int e = 0; e < 2; ++e) { kk[e] = kx[e] * kkc[e]; ss += kk[e][0] * kk[e][0] + kk[e][1] * kk[e][1] + kk[e][2] * kk[e][2] + kk[e][3] * kk[e][3]; }
          ss = dpp_sum8(ss); const float inv = __builtin_amdgcn_rsqf(fmaxf(ss, 1e-24f));
#pragma unroll
          for (int e = 0; e < 2; ++e) { kk[e] = kk[e] * inv; bq[e] = kk[e] * ax[e]; kd[e] = kx[e] * (1.f + (ax[e] - 1.f) * kac[e]); } }
        LBAR();
        { const int k = tid & 63, sg = tid >> 6; float run = 0.f;
#pragma unroll
          for (int u = 0; u < 8; ++u) { run += Lbuf[(sg * 8 + u) * 64 + k]; Lbuf[(sg * 8 + u) * 64 + k] = run; }
          Lseg[sg * 64 + k] = run; }
        LBAR();
        f32x4 Lt[2], Lp[2], Lc[2];
        { const int sg = pt >> 3, sgp = (pt - 1) >> 3;
#pragma unroll
          for (int e = 0; e < 2; ++e) { f32x4 o0 = {0.f, 0.f, 0.f, 0.f}, o1 = o0, oc = o0;
#pragma unroll
              for (int u = 0; u < 8; ++u) { const f32x4 sv = *(const LAS f32x4*)(Lseg + u * 64 + cg * 8 + 4 * e); if (u < sg) o0 = o0 + sv; if (u < sgp) o1 = o1 + sv; if (u < 7) oc = oc + sv; }
              Lt[e] = *(const LAS f32x4*)(Lbuf + pt * 64 + cg * 8 + 4 * e) + o0;
              Lp[e] = pt > 0 ? *(const LAS f32x4*)(Lbuf + (pt - 1) * 64 + cg * 8 + 4 * e) + o1 : (f32x4){0.f, 0.f, 0.f, 0.f};
              Lc[e] = *(const LAS f32x4*)(Lbuf + 63 * 64 + cg * 8 + 4 * e) + oc; } }
        LBAR();
        {
            float at[8], bt[8], kt[8], rt[8], bh[8], kh[8], vv[8];
#pragma unroll
            for (int e = 0; e < 2; ++e)
#pragma unroll
                for (int u = 0; u < 4; ++u) { const int x = 4 * e + u; const float eL = __expf(Lt[e][u]), emL = __expf(-Lt[e][u]), eP = __expf(Lp[e][u]), eC = __expf(Lc[e][u] - Lt[e][u]);
                    at[x] = -kk[e][u] * eP; bt[x] = bq[e][u] * emL; kt[x] = kd[e][u] * emL; rt[x] = rx[e][u] * eL; bh[x] = bq[e][u] * eC; kh[x] = kd[e][u] * eC; vv[x] = vx[e][u];
                    if (pt == 63) GC[cg * 8 + x] = eL; }
#define ST8(bufi, arr) do { u32x4 w_ = {pk2(arr[0], arr[1]), pk2(arr[2], arr[3]), pk2(arr[4], arr[5]), pk2(arr[6], arr[7])}; *(LAS u32x4*)(BUF(bufi) + (pt * P + cg * 8) * 2) = w_; } while (0)
            ST8(0, at); ST8(1, bt); ST8(2, kt); ST8(3, rt); ST8(8, bh); ST8(9, kh); ST8(10, vv);
#undef ST8
        }
        LBAR();
        {
            const int k = tid & 63, tg = tid >> 6;
#define TR8(src, dst) do { unsigned w_[4]; _Pragma("unroll") for (int x = 0; x < 4; ++x) { const unsigned lo = *(const LAS bf16_t*)(BUF(src) + ((tg * 8 + 2 * x) * P + k) * 2), hi2 = *(const LAS bf16_t*)(BUF(src) + ((tg * 8 + 2 * x + 1) * P + k) * 2); w_[x] = lo | (hi2 << 16); } \
                *(LAS u32x4*)(BUF(dst) + (k * P + tg * 8) * 2) = (u32x4){w_[0], w_[1], w_[2], w_[3]}; } while (0)
            TR8(0, 4); TR8(8, 5); TR8(9, 6); TR8(10, 7);
#undef TR8
        }
        LBAR();
        const f32x4 Z4 = {0.f, 0.f, 0.f, 0.f};
        const f32x16 Z16 = {0.f, 0.f, 0.f, 0.f, 0.f, 0.f, 0.f, 0.f, 0.f, 0.f, 0.f, 0.f, 0.f, 0.f, 0.f, 0.f};
        const int r32 = lane & 31, hi = lane >> 5;
#pragma unroll 1
        for (int u = 0; u < 3; ++u) { const int tl = u * 8 + wid; if (tl >= 20) break; const int m = tl >> 2, ti = (tl >> 1) & 1, tj = tl & 1; const int jj = 32 * tj + r32;
            if (m == 0) { f32x16 v = mm32(BUF(0), BUF(1), ti, tj, r32, hi, Z16), w;
#pragma unroll
                for (int e = 0; e < 16; ++e) { const int ii = 32 * ti + 8 * (e >> 2) + 4 * hi + (e & 3); const bool dg = (ii >> 4) == (jj >> 4);
                    v[e] = (dg && jj < ii) ? v[e] : 0.f; w[e] = v[e] + ((ii == jj) ? 1.f : 0.f); }
                st32(BUF(8), ti, tj, r32, hi, v); st32(BUF(14), ti, tj, r32, hi, w); }
            else if (m == 1) { const f32x16 v = mm32(BUF(1), BUF(0), ti, tj, r32, hi, Z16); f32x16 vd, vo, w;
#pragma unroll
                for (int e = 0; e < 16; ++e) { const int ii = 32 * ti + 8 * (e >> 2) + 4 * hi + (e & 3); const bool dg = (ii >> 4) == (jj >> 4), up = ii < jj;
                    vd[e] = (dg && up) ? v[e] : 0.f; vo[e] = (!dg && up) ? v[e] : 0.f; w[e] = vd[e] + ((ii == jj) ? 1.f : 0.f); }
                st32(BUF(9), ti, tj, r32, hi, vd); st32(BUF(15), ti, tj, r32, hi, vo); st32(BUF(13), ti, tj, r32, hi, w); }
            else if (m == 2) { f32x16 v = mm32(BUF(2), BUF(0), ti, tj, r32, hi, Z16);
#pragma unroll
                for (int e = 0; e < 16; ++e) { const int ii = 32 * ti + 8 * (e >> 2) + 4 * hi + (e & 3); v[e] = ii < jj ? v[e] : 0.f; }
                st32(BUF(10), ti, tj, r32, hi, v); }
            else { f32x16 v = mm32(m == 3 ? BUF(1) : BUF(2), BUF(3), ti, tj, r32, hi, Z16);
#pragma unroll
                for (int e = 0; e < 16; ++e) { const int ii = 32 * ti + 8 * (e >> 2) + 4 * hi + (e & 3); v[e] = ii <= jj ? v[e] : 0.f; }
                st32(m == 3 ? BUF(11) : BUF(12), ti, tj, r32, hi, v); } }
        LBAR();
#define WSYNC() asm volatile("s_waitcnt lgkmcnt(0)" ::: "memory")
        if (wid < 4) {
            const int tt = wid;
#define SQD(sr, st, dr, dt) do { const f32x4 a_ = mm_diag(BUF(st), BUF(sr), tt, c, q, Z4), b_ = mm_diag(BUF(sr), BUF(st), tt, c, q, Z4); WSYNC(); \
                st_tile(BUF(dr), tt, tt, c, q, a_); st_tile(BUF(dt), tt, tt, c, q, b_); WSYNC(); } while (0)
#define UPD(pr) do { const f32x4 dt_ = mm_diag(BUF(pr), BUF(13), tt, c, q, ld_tile(BUF(13), tt, tt, c, q)); \
                const f32x4 dr_ = mm_diag(BUF(13), BUF(pr), tt, c, q, ld_tile(BUF(14), tt, tt, c, q)); WSYNC(); \
                st_tile(BUF(13), tt, tt, c, q, dt_); st_tile(BUF(14), tt, tt, c, q, dr_); WSYNC(); } while (0)
            SQD(8, 9, 0, 1); UPD(0); SQD(0, 1, 8, 9); UPD(8); SQD(8, 9, 0, 1); UPD(0);
#undef SQD
#undef UPD
        } else {
            const int ti = (wid >> 1) & 1, tj = wid & 1; st32(BUF(2), ti, tj, r32, hi, mm32(BUF(10), BUF(7), ti, tj, r32, hi, Z16));
        }
        LBAR();
        { const int m = wid >> 2, ti = (wid >> 1) & 1, tj = wid & 1;
          if (m == 0) st32(BUF(8), ti, tj, r32, hi, mm32(BUF(15), BUF(14), ti, tj, r32, hi, Z16));
          else        st32(BUF(9), ti, tj, r32, hi, mm32(BUF(14), BUF(15), ti, tj, r32, hi, Z16)); }
        LBAR();
        if (wid < 4) { const int ti = (wid >> 1) & 1, tj = wid & 1; st32(BUF(0), ti, tj, r32, hi, mm32(BUF(9), BUF(8), ti, tj, r32, hi, Z16)); }
        LBAR();
        if (wid < 4) { const int ti = (wid >> 1) & 1, tj = wid & 1; st32(BUF(1), ti, tj, r32, hi, mm32(BUF(0), BUF(13), ti, tj, r32, hi, ld32(BUF(13), ti, tj, r32, hi))); }
        LBAR();
        if (wid < 4) { const int ti = (wid >> 1) & 1, tj = wid & 1; st32(BUF(14), ti, tj, r32, hi, mm32(BUF(8), BUF(1), ti, tj, r32, hi, ld32(BUF(1), ti, tj, r32, hi))); }
        LBAR();
        { const int m = wid >> 2, ti = (wid >> 1) & 1, tj = wid & 1;
          if (m == 0) st32(BUF(8), ti, tj, r32, hi, mm32(BUF(14), BUF(4), ti, tj, r32, hi, Z16));
          else        st32(BUF(0), ti, tj, r32, hi, mm32(BUF(14), BUF(2), ti, tj, r32, hi, Z16)); }
        LBAR();
        bf16_t* ckp = CK + (size_t)it * 4 * 4096;
#pragma unroll 1
        for (int u = 0; u < 2; ++u) { const int tl = u * 8 + wid, m = tl >> 2, ti = (tl >> 1) & 1, tj = tl & 1;
            if (m == 0) { f32x16 v = mm32(BUF(8), BUF(5), ti, tj, r32, hi, Z16); const int jj = 32 * tj + r32; const float gc = GC[jj];
#pragma unroll
                for (int e = 0; e < 16; ++e) { const int ii = 32 * ti + 8 * (e >> 2) + 4 * hi + (e & 3); v[e] += (ii == jj) ? gc : 0.f; }
                st32(BUF(1), ti, tj, r32, hi, v); }
            else if (m == 1) st32(BUF(4), ti, tj, r32, hi, mm32(BUF(8), BUF(11), ti, tj, r32, hi, ld32(BUF(3), ti, tj, r32, hi)));
            else if (m == 2) st32(BUF(2), ti, tj, r32, hi, mm32(BUF(6), BUF(7), ti, tj, r32, hi, mm32(BUF(5), BUF(0), ti, tj, r32, hi, Z16)));
            else             st32(BUF(9), ti, tj, r32, hi, mm32(BUF(7), BUF(12), ti, tj, r32, hi, mm32(BUF(0), BUF(11), ti, tj, r32, hi, Z16))); }
        LBAR();
        { const int orow = tid >> 3, oc = (tid & 7) * 8;
          *(u32x4*)(ckp + orow * 64 + oc) = *(const LAS u32x4*)(BUF(1) + (orow * P + oc) * 2);
          *(u32x4*)(ckp + 4096 + orow * 64 + oc) = *(const LAS u32x4*)(BUF(2) + (orow * P + oc) * 2);
          *(u32x4*)(ckp + 2 * 4096 + orow * 64 + oc) = *(const LAS u32x4*)(BUF(4) + (orow * P + oc) * 2);
          *(u32x4*)(ckp + 3 * 4096 + orow * 64 + oc) = *(const LAS u32x4*)(BUF(9) + (orow * P + oc) * 2); }
    }
#undef BUF
#undef SC1_LOAD
}

__device__ void ph_rw_sc2(const Params& p, char* lds) {
    using namespace ck;
    const int tid = tidx(), wid = __builtin_amdgcn_readfirstlane(tid >> 6), lane = tid & 63, c = lane & 15, q = lane >> 4;
    const size_t PL = (size_t)NROW * D;
    const bf16_t* CK = (const bf16_t*)(p.ws + OFF_CK); bf16_t* Y = (bf16_t*)(p.ws + OFF_Y);
    lchar* GB = (lchar*)lds;
    lchar* RB = GB + 2 * MB;
    lchar* SB = GB + 4 * MB;
    constexpr int SBB = 32 * P * 2;
    for (int it = bidx(); it < 256; it += gdim()) {
        const int vh = it & 1, seq = it >> 1, z = seq & 1, h = (seq >> 1) & 15, b = seq >> 5;
        const bf16_t* ck0 = CK + (size_t)seq * NCHK * 4 * 4096;
        const int s_ti = wid & 3, s_tj = wid >> 2;
        const int y_ti = wid & 1, y_tj = wid >> 1;
        const int hoff = 4096 + (vh * 32 + 16 * s_tj + c) * 64 + 16 * s_ti + 4 * q, yoff = 3 * 4096 + (16 * y_tj + c) * 64 + vh * 32 + 16 * y_ti + 4 * q;
        struct PF { u32x4 g, r; uint2 h, y; };
#define PF_LOAD(X, k) do { const bf16_t* cc_ = ck0 + (size_t)(k) * 4 * 4096; X.h = *(const uint2*)(cc_ + hoff); X.y = *(const uint2*)(cc_ + yoff); X.g = *(const u32x4*)(cc_ + tid * 8); X.r = *(const u32x4*)(cc_ + 2 * 4096 + tid * 8); } while (0)
#define PF_STAGE(X, bufi) do { *(LAS u32x4*)(GB + (bufi) * MB + ((tid >> 3) * P + (tid & 7) * 8) * 2) = X.g; *(LAS u32x4*)(RB + (bufi) * MB + ((tid >> 3) * P + (tid & 7) * 8) * 2) = X.r; } while (0)
#define SC2_STEP(k, CUR, NXT) do { const uint2 hi_ = CUR.h, yi_ = CUR.y; const int cur = (k) & 1; \
            if ((k) + 4 < NCHK) PF_LOAD(CUR, (k) + 4); \
            const f32x4 hinit = {__uint_as_float(hi_.x << 16), __uint_as_float(hi_.x & 0xffff0000u), __uint_as_float(hi_.y << 16), __uint_as_float(hi_.y & 0xffff0000u)}; \
            const f32x4 yinit = {__uint_as_float(yi_.x << 16), __uint_as_float(yi_.x & 0xffff0000u), __uint_as_float(yi_.y << 16), __uint_as_float(yi_.y & 0xffff0000u)}; \
            const lchar* Sold = SB + cur * SBB; lchar* Snew = SB + (cur ^ 1) * SBB; \
            const f32x4 sn = mm_tile(GB + cur * MB, Sold, s_ti, s_tj, c, q, hinit);        \
            const f32x4 yv = mm_tile(Sold, RB + cur * MB, y_ti, y_tj, c, q, yinit);        \
            st_tile(Snew, s_ti, s_tj, c, q, sn); \
            { const int row = scan_row((k) * 64 + 16 * y_tj + c, b, z); stbf4(Y + z * PL + (size_t)row * D + h * 64 + vh * 32 + 16 * y_ti + 4 * q, yv); } \
            if ((k) + 1 < NCHK) PF_STAGE(NXT, cur ^ 1); \
            LBAR(); } while (0)
        PF s0, s1, s2, s3;
        PF_LOAD(s0, 0); PF_LOAD(s1, 1); PF_LOAD(s2, 2); PF_LOAD(s3, 3);
        LBAR();
        for (int i = tid; i < SBB / 4; i += NTHR) ((LAS unsigned*)SB)[i] = 0u;
        PF_STAGE(s0, 0);
        LBAR();
        for (int ch = 0; ch < NCHK; ch += 4) {
            SC2_STEP(ch, s0, s1); SC2_STEP(ch + 1, s1, s2); SC2_STEP(ch + 2, s2, s3); SC2_STEP(ch + 3, s3, s0);
        }
#undef PF_LOAD
#undef PF_STAGE
#undef SC2_STEP
    }
}
#undef LBAR

__device__ void ph_rw_out(const Params& p, int j, int nrows) {
    const int wid = tidx() >> 6, lane = tidx() & 63;
    const bf16_t* RKV = (const bf16_t*)(p.ws + OFF_RKV); const bf16_t* AV = (const bf16_t*)(p.ws + OFF_AV); const bf16_t* G = (const bf16_t*)(p.ws + OFF_G); const bf16_t* Y = (const bf16_t*)(p.ws + OFF_Y);
    bf16_t* OUT = (bf16_t*)(p.ws + OFF_H);
    const size_t PL = (size_t)NROW * D;
    const float* r_k = p.rw_r_k + j * D; const float* lg = p.rw_lnx_g + j * D; const float* lb = p.rw_lnx_b + j * D; const float* k_a = p.rw_k_a + j * D;
    uint2 nb[8][4];
#define OUT_LOAD(R) do { _Pragma("unroll") for (int i = 0; i < 4; ++i) { const size_t o_ = (size_t)(R) * D + lane * 4 + i * 256; \
        nb[0][i] = *(const uint2*)(Y + o_); nb[1][i] = *(const uint2*)(Y + PL + o_); nb[2][i] = *(const uint2*)(RKV + o_); nb[3][i] = *(const uint2*)(RKV + PL + o_); \
        nb[4][i] = *(const uint2*)(RKV + 2 * PL + o_); nb[5][i] = *(const uint2*)(AV + o_); nb[6][i] = *(const uint2*)(AV + PL + o_); nb[7][i] = *(const uint2*)(G + o_); } } while (0)
#define UNPK(w) ((f32x4){__uint_as_float((w).x << 16), __uint_as_float((w).x & 0xffff0000u), __uint_as_float((w).y << 16), __uint_as_float((w).y & 0xffff0000u)})
    int row = bidx() * 8 + wid;
    if (row < nrows) OUT_LOAD(row);
    for (; row < nrows; row += gdim() * 8) {
        uint2 cb[8][4];
#pragma unroll
        for (int q_ = 0; q_ < 8; ++q_)
#pragma unroll
            for (int i = 0; i < 4; ++i) cb[q_][i] = nb[q_][i];
        { const int nrow = row + gdim() * 8; if (nrow < nrows) OUT_LOAD(nrow); }
#pragma unroll
        for (int i = 0; i < 4; ++i) {
            const size_t o = (size_t)row * D + lane * 4 + i * 256; const int c = lane * 4 + i * 256;
            const f32x4 y = UNPK(cb[0][i]) + UNPK(cb[1][i]);
            const float mean = dpp_sum16(y[0] + y[1] + y[2] + y[3]) * (1.f / 64.f);
            const f32x4 dd = y - mean;
            const float rstd = rsqrtf(dpp_sum16(dd[0] * dd[0] + dd[1] * dd[1] + dd[2] * dd[2] + dd[3] * dd[3]) * (1.f / 64.f) + LNX_EPS);
            const f32x4 r = UNPK(cb[2][i]), k = UNPK(cb[3][i]), v = UNPK(cb[4][i]);
            const f32x4 a0 = UNPK(cb[5][i]), a1 = UNPK(cb[6][i]);
            const f32x4 kds = k * (2.f + (a0 + a1 - 2.f) * *(const f32x4*)(k_a + c));
            const f32x4 t4 = r * kds * *(const f32x4*)(r_k + c);
            const float bs = dpp_sum16(t4[0] + t4[1] + t4[2] + t4[3]);
            const f32x4 res = (dd * rstd * *(const f32x4*)(lg + c) + *(const f32x4*)(lb + c) + bs * v) * UNPK(cb[7][i]);
            uint2 w; w.x = pk2(res[0], res[1]); w.y = pk2(res[2], res[3]); *(uint2*)(OUT + o) = w;
        }
    }
#undef OUT_LOAD
#undef UNPK
}

__device__ void ph_final(const Params& p) {
    const int wid = tidx() >> 6, lane = tidx() & 63;
    const float* X = (const float*)(p.ws + OFF_X);
    for (int row = bidx() * 8 + wid; row < NLAT; row += gdim() * 8) {
        const float4* xr = (const float4*)(X + (size_t)row * D);
        float4 v[4]; float ss = 0;
#pragma unroll
        for (int i = 0; i < 4; ++i) { v[i] = xr[lane + i * 64]; ss += v[i].x * v[i].x + v[i].y * v[i].y + v[i].z * v[i].z + v[i].w * v[i].w; }
        ss = wave_sum(ss); const float rs = rsqrtf(ss * (1.f / D) + RMS_EPS);
#pragma unroll
        for (int i = 0; i < 4; ++i) { const int d = (lane + i * 64) * 4; const float4 gg = *(const float4*)(p.final_g + d);
            float4 o; o.x = v[i].x * rs * gg.x; o.y = v[i].y * rs * gg.y; o.z = v[i].z * rs * gg.z; o.w = v[i].w * rs * gg.w;
            *(float4*)(p.out + (size_t)row * D + d) = o; }
    }
}

enum { PH_INIT = 0, PH_A_NORM, PH_A_Z, PH_A_MID, PH_A_QKV, PH_A_POST, PH_A_ATTN, PH_A_WO,
       PH_R_NORM, PH_R_XS, PH_R_G1, PH_R_G2, PH_R_PREP, PH_R_SCAN, PH_R_OUT, PH_R_WO,
       PH_M_NORM, PH_M_SEL, PH_M_GATHER, PH_M_G1, PH_M_G2, PH_M_COMB, PH_FINAL, PH_M_CVT, PH_R_SC1, PH_R_SC2 };

template <int PH>
__device__ __forceinline__ void run_phase(const Params& p, int layer, char* lds) {
    const int j = layer >> 1;
    char* ws = p.ws;
    if constexpr (PH == PH_INIT) { ph_init(p, lds); __syncthreads(); ph_small_cvt(p, lds); }
    else if constexpr (PH == PH_A_NORM) ph_norm_mod<false>(p, layer, p.norm1_g + layer * D, 0, 1, ws + OFF_H);
    else if constexpr (PH == PH_A_Z) {
        float* Z = (float*)(ws + OFF_Z);
        g8::BatchSched S{ws + OFF_H, ws + OFF_WMLA + j * SZ_WMLA + WM_IN, 0, 0, NROW / 256, 2, 1, D};
        g8::gemm_phase(p.wv, (PG8_LAS unsigned char*)lds, D, S, g8::epi_rc([=](const g8::Unit&, int row, int col, f32x4 v) { *(f32x4*)(Z + (size_t)row * 512 + col) = v; }));
    }
    else if constexpr (PH == PH_A_MID) ph_mla_mid(p, j);
    else if constexpr (PH == PH_A_QKV) {
        bf16_t* Q = (bf16_t*)(ws + OFF_Q); bf16_t* K = (bf16_t*)(ws + OFF_K); bf16_t* V = (bf16_t*)(ws + OFF_V);
        g8::BatchSched S1{ws + OFF_CQN, ws + OFF_WMLA + j * SZ_WMLA + WM_UQ, 0, 0, NROW / 256, 6, 1, 256};
        g8::gemm_phase(p.wv, (PG8_LAS unsigned char*)lds, 256, S1, g8::epi_rc([=](const g8::Unit&, int row, int col, f32x4 v) {
            const bool lat = row < NLAT; const int b = lat ? (row >> 12) : ((row - NLAT) >> 8); const int tk = lat ? 256 + (row & (TL - 1)) : ((row - NLAT) & 255);
            const int h = col / 192, d = col - h * 192;
            uint2 w; w.x = pk2(v[0], v[1]); w.y = pk2(v[2], v[3]);
            *(uint2*)(Q + ((size_t)(b * 8 + h) * TK + tk) * 192 + d) = w; }));
        g8::BatchSched S2{ws + OFF_CKVN, ws + OFF_WMLA + j * SZ_WMLA + WM_UKV, 0, 0, NROW / 256, 8, 1, 256};
        g8::gemm_phase(p.wv, (PG8_LAS unsigned char*)lds, 256, S2, g8::epi_rc([=](const g8::Unit&, int row, int col, f32x4 v) {
            const bool lat = row < NLAT; const int b = lat ? (row >> 12) : ((row - NLAT) >> 8); const int tk = lat ? 256 + (row & (TL - 1)) : ((row - NLAT) & 255);
            const int h = col >> 8, d = col & 255; const size_t orow = (size_t)(b * 8 + h) * TK + tk;
            uint2 w; w.x = pk2(v[0], v[1]); w.y = pk2(v[2], v[3]);
            if (d < 128) *(uint2*)(K + orow * 192 + d) = w; else *(uint2*)(V + orow * 128 + (d - 128)) = w; }));
    }
    else if constexpr (PH == PH_A_ATTN) ph_attn(p, lds);
    else if constexpr (PH == PH_A_WO || PH == PH_R_WO) {
        float* X = (float*)(ws + OFF_X); const float* MOD = (const float*)(ws + OFF_MOD);
        g8::BatchSched S{ws + (PH == PH_A_WO ? OFF_O : OFF_H), PH == PH_A_WO ? ws + OFF_WMLA + j * SZ_WMLA + WM_O : ws + OFF_WRW + j * SZ_WRW + WR_O, 0, 0, (layer < 3 ? NROW : NLAT) / 256, 4, 1, D};
        g8::gemm_phase(p.wv, (PG8_LAS unsigned char*)lds, D, S, g8::EpiResid{X, MOD, layer});
    }
    else if constexpr (PH == PH_R_XS) ph_rw_normxs(p, layer, j);
    else if constexpr (PH == PH_R_G1) {
        bf16_t* RKV = (bf16_t*)(ws + OFF_RKV); bf16_t* VF = (bf16_t*)(ws + OFF_VFIRST);
        bf16_t* A2 = (bf16_t*)(ws + OFF_A2); bf16_t* A3 = (bf16_t*)(ws + OFF_A3);
        const bool first = (j == 0);
        struct RSched { const char* XS; const char* WB; int nwg;
            __device__ __forceinline__ bool next(int i, g8::Unit& u) const {
                const int L = i * gdim() + bidx(); if (L >= nwg) return false;
                const int w = g8::xcd_remap(L, nwg);
                if (w < 816) { u.g = w / 272; const int r = w % 272; u.pm = r >> 2; u.pn = r & 3; u.B = WB + WR_RKV + (size_t)u.g * D * D * 2 + (size_t)u.pn * 256 * D * 2; }
                else { u.g = 3 + (w - 816) / 68; u.pm = (w - 816) % 68; u.pn = 0; u.B = WB + WR_L + (size_t)(u.g - 3) * 256 * D * 2; }
                u.A = XS + (size_t)(u.g == 6 ? 2 : u.g) * NROW * D * 2 + (size_t)u.pm * 256 * D * 2; return true; } };
        RSched S{ws + OFF_XS, ws + OFF_WRW + j * SZ_WRW, first ? 816 + 204 : 816 + 272};
        g8::gemm_phase(p.wv, (PG8_LAS unsigned char*)lds, D, S, g8::epi_rc([=](const g8::Unit& u, int row, int col, f32x4 v) {
            if (u.g < 3) { stbf4(RKV + ((size_t)u.g * NROW + row) * D + col, v); if (first && u.g == 2) stbf4(VF + (size_t)row * D + col, v); }
            else if (u.g == 3) { if (col < 128) { uint2 w; w.x = pk2(tanhf(v[0]), tanhf(v[1])); w.y = pk2(tanhf(v[2]), tanhf(v[3])); *(uint2*)(A2 + (size_t)row * 256 + col) = w; } }
            else if (u.g == 4) { if (col < 128) { uint2 w; w.x = pk2(v[0], v[1]); w.y = pk2(v[2], v[3]); *(uint2*)(A2 + (size_t)row * 256 + 128 + col) = w; } }
            else if (u.g == 5) { uint2 w; if (col < 128) { w.x = pk2(sigmoidf_(v[0]), sigmoidf_(v[1])); w.y = pk2(sigmoidf_(v[2]), sigmoidf_(v[3])); } else { w.x = 0u; w.y = 0u; }
                                 if (col < 128 || first || col >= 160) *(uint2*)(A3 + (size_t)row * 256 + col) = w; }
            else { if (col < 32) { uint2 w; w.x = pk2(v[0], v[1]); w.y = pk2(v[2], v[3]); *(uint2*)(A3 + (size_t)row * 256 + 128 + col) = w; } } }));
    }
    else if constexpr (PH == PH_R_G2) {
        const bool first = (j == 0);
        float* W = (float*)(ws + OFF_W); bf16_t* AV = (bf16_t*)(ws + OFF_AV); bf16_t* G = (bf16_t*)(ws + OFF_G); bf16_t* RKV = (bf16_t*)(ws + OFF_RKV); const bf16_t* VF = (const bf16_t*)(ws + OFF_VFIRST);
        const float* w0 = p.rw_w0 + (size_t)j * 2 * D; const float* a0 = p.rw_a0 + (size_t)j * 2 * D; const float* v0 = p.rw_v0;
        g8::BatchSched S1{ws + OFF_A2, ws + OFF_WRW + j * SZ_WRW + WR_B2, 0, 0, NROW / 256, 16, 1, 256};
        g8::gemm_phase(p.wv, (PG8_LAS unsigned char*)lds, 256, S1, g8::epi_colfirst([=](const g8::Unit& u, int row, int col, f32x4 v, f32x4 bias) {
            const int blk = u.pn >> 2, c = col & 1023; const bool dec = blk < 2;
            const size_t doff = (size_t)(dec ? blk : blk - 2) * NROW * D + (size_t)row * D + c;
            const f32x4 x = v + bias; f32x4 o;
#pragma unroll
            for (int e = 0; e < 4; ++e) { const float sg = __builtin_amdgcn_rcpf(1.f + __expf(-x[e])); o[e] = dec ? (-0.6065306597126334f * sg) : sg; }
            if (dec) *(f32x4*)(W + doff) = o; else stbf4(AV + doff, o); },
            [=](const g8::Unit& u, int col) { const int blk = u.pn >> 2, c = col & 1023; return *(const f32x4*)((blk < 2 ? w0 + blk * D : a0 + (blk - 2) * D) + c); }));
        g8::BatchSched S2{ws + OFF_A3, ws + OFF_WRW + j * SZ_WRW + WR_B3, 0, 0, NROW / 256, first ? 4 : 8, 1, 256};
        g8::gemm_phase(p.wv, (PG8_LAS unsigned char*)lds, 256, S2, g8::epi_rc([=](const g8::Unit&, int row, int col, f32x4 v) {
            if (col < 1024) stbf4(G + (size_t)row * D + col, v);
            else { const int c = col - 1024; const size_t o = (size_t)row * D + c; const f32x4 vv = ldbf4(RKV + (size_t)2 * NROW * D + o), vf = ldbf4(VF + o), gz = v + *(const f32x4*)(v0 + c); f32x4 r;
#pragma unroll
                for (int e = 0; e < 4; ++e) r[e] = vv[e] + (vf[e] - vv[e]) * __builtin_amdgcn_rcpf(1.f + __expf(-gz[e]));
                stbf4(RKV + (size_t)2 * NROW * D + o, r); } }));
    }
    else if constexpr (PH == PH_R_SCAN) ph_rw_scan(p, j, lds);
    else if constexpr (PH == PH_R_SC1) ph_rw_sc1(p, j, lds);
    else if constexpr (PH == PH_R_SC2) ph_rw_sc2(p, lds);
    else if constexpr (PH == PH_R_OUT) ph_rw_out(p, j, layer < 3 ? NROW : NLAT);
    else if constexpr (PH == PH_M_NORM) ph_norm2_router(p, layer, lds, layer < 3 ? NROW : NLAT);
    else if constexpr (PH == PH_M_SEL) { ph_select(p, lds, layer < 3 ? 128 : 64); __syncthreads(); ph_moe_cvt(p, layer, lds); }
    else if constexpr (PH == PH_M_GATHER) ph_gather(p, layer < 3 ? ESLOTS : NB * CAPL);
    else if constexpr (PH == PH_M_G1) {
        bf16_t* HID = (bf16_t*)(ws + OFF_HID);
        g8::BatchSched S{ws + OFF_XE, ws + OFF_W13T, (size_t)EPAD * D * 2, (size_t)2816 * D * 2, layer < 3 ? 9 : 8, 11, NE, D};
        g8::gemm_phase(p.wv, (PG8_LAS unsigned char*)lds, D, S, g8::epi_pair([=](const g8::Unit& u, int row, int col, f32x4 a, f32x4 b) {
            uint2 w; w.x = pk2(a[0] * __builtin_amdgcn_rcpf(1.f + __expf(-a[0])) * b[0], a[1] * __builtin_amdgcn_rcpf(1.f + __expf(-a[1])) * b[1]); w.y = pk2(a[2] * __builtin_amdgcn_rcpf(1.f + __expf(-a[2])) * b[2], a[3] * __builtin_amdgcn_rcpf(1.f + __expf(-a[3])) * b[3]);
            *(uint2*)(HID + ((size_t)u.g * EPAD + row) * FF + col) = w; }));
    }
    else if constexpr (PH == PH_M_G2) {
        bf16_t* YE = (bf16_t*)(ws + OFF_YE); const float* GATE = (const float*)(ws + OFF_GATE);
        g8::BatchSched S{ws + OFF_HID, ws + OFF_W2T, (size_t)EPAD * FF * 2, (size_t)D * FF * 2, layer < 3 ? 9 : 8, 4, NE, FF};
        g8::gemm_phase(p.wv, (PG8_LAS unsigned char*)lds, FF, S, g8::epi_pre([=](const g8::Unit& u, int row, int col, f32x4 v, f32x4, float gt) {
            uint2 w; w.x = pk2(v[0] * gt, v[1] * gt); w.y = pk2(v[2] * gt, v[3] * gt);
            *(uint2*)(YE + ((size_t)u.g * EPAD + row) * D + col) = w; },
            [=](const g8::Unit&, int) { return (f32x4){0.f, 0.f, 0.f, 0.f}; }, [=](const g8::Unit& u, int row) { return GATE[u.g * EPAD + row]; }));
    }
    else if constexpr (PH == PH_M_COMB) ph_combine(p, layer, layer < 3 ? NROW : NLAT);
    else if constexpr (PH == PH_M_CVT) ph_moe_cvt(p, layer, lds);
    else if constexpr (PH == PH_FINAL) ph_final(p);
}

#if ONE_LAUNCH
#define SYNC() xcd_barrier(bar)
#ifndef PROBE_PH
#define PROBE_PH -1
#endif
#ifndef PROBE_REP
#define PROBE_REP 1
#endif
__device__ __forceinline__ Params load_params() {
    Params q{};
#if defined(__HIP_DEVICE_COMPILE__)
    typedef const __attribute__((address_space(4))) unsigned long long* KargP;
    KargP kp_ = (KargP)__builtin_amdgcn_kernarg_segment_ptr(); asm volatile("" : "+s"(kp_));
#pragma unroll
    for (int i = 0; i < 40; ++i) ((const float**)&q)[i] = (const float*)(const __attribute__((address_space(1))) float*)kp_[i];
#endif
    return q;
}
#define RUN(PH) do { for (int rep_ = 0; rep_ < ((PH) == PROBE_PH ? PROBE_REP : 1); ++rep_) { Params q = load_params(); q.wv = wv0_; run_phase<PH>(q, layer, smem); SYNC(); } } while (0)
__global__ void __launch_bounds__(NTHR, 2) mega(Params p) {
    extern __shared__ __attribute__((aligned(16))) char smem[];
    const int wv0_ = __builtin_amdgcn_readfirstlane((int)threadIdx.x >> 6);
    if (threadIdx.x == 0) *(uint4*)(smem + LDS_BYTES) = make_uint4(0u, 0u, 0u, 0u);
    __syncthreads();
    XcdBarrier bar = xcd_barrier_post((unsigned*)(p.ws + OFF_BAR), (volatile LAS unsigned*)(smem + LDS_BYTES));
    { const int layer = 0; RUN(PH_INIT); }
    for (int layer = 0; layer < 4; ++layer) {
        if ((layer & 1) == 0) {
            RUN(PH_A_NORM);
            RUN(PH_A_Z);
            RUN(PH_A_MID);
            RUN(PH_A_QKV);
            RUN(PH_A_ATTN);
            RUN(PH_A_WO);
        } else {
            RUN(PH_R_XS);
            RUN(PH_R_G1);
            RUN(PH_R_G2);
            RUN(PH_R_SC1);
            RUN(PH_R_SC2);
            RUN(PH_R_OUT);
            RUN(PH_R_WO);
        }
        RUN(PH_M_NORM);
        RUN(PH_M_SEL);
        RUN(PH_M_G1);
        RUN(PH_M_G2);
        RUN(PH_M_COMB);
    }
    { Params q = load_params(); q.wv = wv0_; run_phase<PH_FINAL>(q, 0, smem); }
}
#else
template <int PH> __global__ void __launch_bounds__(NTHR, 2) kph(Params p, int layer) {
    extern __shared__ __attribute__((aligned(16))) char smem[];
    Params q = p; q.wv = __builtin_amdgcn_readfirstlane((int)threadIdx.x >> 6);
    run_phase<PH>(q, layer, smem);
}
#endif

extern "C" void kernel_launch(void* const* d_in, const int* in_sizes, int n_in, void* d_out, int out_size, void* d_ws, size_t ws_size, hipStream_t stream) {
    if (n_in != 38 || ws_size < WS_NEED) { fprintf(stderr, "kernel_launch: bad args n_in %d ws %zu need %zu\n", n_in, ws_size, (size_t)WS_NEED); return; }
    Params p{};
    const float** pp = (const float**)&p;
    for (int i = 0; i < 38; ++i) pp[i] = (const float*)d_in[i];
    p.out = (float*)d_out; p.ws = (char*)d_ws;
    static int cus = 0;
    if (!cus) { int dev = 0; hipGetDevice(&dev); hipDeviceGetAttribute(&cus, hipDeviceAttributeMultiprocessorCount, dev); if (cus <= 0) cus = 256; }
    const int grid = cus;
#if ONE_LAUNCH
    hipFuncSetAttribute((const void*)mega, hipFuncAttributeMaxDynamicSharedMemorySize, LDS_BYTES + 16);
    hipMemsetAsync(d_ws, 0, 16384, stream);
    hipLaunchKernelGGL(mega, dim3(grid), dim3(NTHR), LDS_BYTES + 16, stream, p);
#else
    hipMemsetAsync(d_ws, 0, 16384, stream);
#define LAUNCH(PH, L) do { hipFuncSetAttribute((const void*)kph<PH>, hipFuncAttributeMaxDynamicSharedMemorySize, LDS_BYTES + 16); hipLaunchKernelGGL(kph<PH>, dim3(grid), dim3(NTHR), LDS_BYTES + 16, stream, p, L); } while (0)
    LAUNCH(PH_INIT, 0);
    for (int layer = 0; layer < 4; ++layer) {
        if ((layer & 1) == 0) { LAUNCH(PH_A_NORM, layer); LAUNCH(PH_A_Z, layer); LAUNCH(PH_A_MID, layer); LAUNCH(PH_A_QKV, layer); LAUNCH(PH_A_ATTN, layer); LAUNCH(PH_A_WO, layer); }
        else { LAUNCH(PH_R_XS, layer); LAUNCH(PH_R_G1, layer); LAUNCH(PH_R_G2, layer); LAUNCH(PH_R_SC1, layer); LAUNCH(PH_R_SC2, layer); LAUNCH(PH_R_OUT, layer); LAUNCH(PH_R_WO, layer); }
        LAUNCH(PH_M_NORM, layer); LAUNCH(PH_M_SEL, layer); LAUNCH(PH_M_G1, layer); LAUNCH(PH_M_G2, layer); LAUNCH(PH_M_COMB, layer);
    }
    LAUNCH(PH_FINAL, 0);
#endif
}
```

```cpp
#include <hip/hip_runtime.h>
#include <stdint.h>
#include <stdio.h>

#ifndef ONE_LAUNCH
#define ONE_LAUNCH 1
#endif

#define NTHR 512
typedef unsigned short bf16_t;
typedef short bf16x8 __attribute__((ext_vector_type(8)));
typedef float f32x4 __attribute__((ext_vector_type(4)));
typedef unsigned u32x4 __attribute__((ext_vector_type(4)));
typedef unsigned u32x2 __attribute__((ext_vector_type(2)));

constexpr int D = 1024, NB = 4, TL = 4096, TC = 256, NLAT = NB * TL, NCTX = NB * TC, NROW = NLAT + NCTX;
constexpr int TK = TL + TC;
constexpr int NE = 16, FF = 1408, CAPL = 512, CAPC = 32, ESLOTS = NB * CAPL + NB * CAPC;
constexpr int EPAD = 2304;
constexpr float RMS_EPS = 1e-6f, LNX_EPS = 64e-5f;
constexpr float ATT_SCALE = 0.07216878364870322f;

constexpr size_t al256(size_t x) { return (x + 255) / 256 * 256; }
constexpr size_t OFF_BAR = 0;
constexpr size_t OFF_QUEUE = 14336;
constexpr size_t OFF_MOD = 16384;
constexpr size_t OFF_ROPE_C = OFF_MOD + al256(4 * 5 * 6144 * 4);
constexpr size_t OFF_ROPE_S = OFF_ROPE_C + al256(TL * 32 * 4);
constexpr size_t OFF_X = OFF_ROPE_S + al256(TL * 32 * 4);
constexpr size_t SZ_F32 = (size_t)NROW * D * 4, SZ_BF = (size_t)NROW * D * 2;
constexpr size_t OFF_VFIRST = OFF_X + SZ_F32;
constexpr size_t OFF_H = OFF_VFIRST + SZ_F32;
constexpr size_t SZ_WMLA = (size_t)(512 * 1024 + 1536 * 256 + 2048 * 256 + 1024 * 1024) * 2;
constexpr size_t WM_IN = 0, WM_UQ = (size_t)512 * 1024 * 2, WM_UKV = WM_UQ + (size_t)1536 * 256 * 2, WM_O = WM_UKV + (size_t)2048 * 256 * 2;
constexpr size_t SZ_WRW = (size_t)(3 * 1024 * 1024 + 4 * 256 * 1024 + 1024 * 1024 + 4096 * 256 + 2048 * 256) * 2;
constexpr size_t WR_RKV = 0, WR_L = (size_t)3 * 1024 * 1024 * 2, WR_O = WR_L + (size_t)4 * 256 * 1024 * 2, WR_B2 = WR_O + (size_t)1024 * 1024 * 2, WR_B3 = WR_B2 + (size_t)4096 * 256 * 2;
constexpr size_t OFF_WMLA = OFF_H + SZ_BF;
constexpr size_t OFF_WRW = OFF_WMLA + 2 * SZ_WMLA;
constexpr size_t OFF_W13T = OFF_WRW + 2 * SZ_WRW;
constexpr size_t OFF_W2T = OFF_W13T + (size_t)NE * 2816 * D * 2;
constexpr size_t OFF_S = OFF_W2T + (size_t)NE * D * FF * 2;
constexpr size_t OFF_Z = OFF_S;
constexpr size_t OFF_CQN = OFF_Z + al256((size_t)NROW * 512 * 4);
constexpr size_t OFF_CKVN = OFF_CQN + al256((size_t)NROW * 256 * 2);
constexpr size_t OFF_KR = OFF_CKVN + al256((size_t)NROW * 256 * 2);
constexpr size_t OFF_QRAW = OFF_KR + al256((size_t)NROW * 64 * 4);
constexpr size_t OFF_KVRAW = OFF_QRAW + al256((size_t)NROW * 1536 * 4);
constexpr size_t OFF_Q = OFF_KVRAW + al256((size_t)NROW * 2048 * 4);
constexpr size_t OFF_K = OFF_Q + al256((size_t)NB * 8 * TK * 192 * 2);
constexpr size_t OFF_V = OFF_K + al256((size_t)NB * 8 * TK * 192 * 2);
constexpr size_t OFF_O = OFF_V + al256((size_t)NB * 8 * TK * 128 * 2);
constexpr size_t END_MLA = OFF_O + SZ_BF;
constexpr size_t OFF_XS = OFF_S;
constexpr size_t OFF_RKV = OFF_XS + 6 * SZ_BF;
constexpr size_t OFF_W = OFF_RKV + 3 * SZ_F32;
constexpr size_t OFF_AV = OFF_W + 2 * SZ_F32;
constexpr size_t OFF_G = OFF_AV + 2 * SZ_F32;
constexpr size_t OFF_A2 = OFF_G + SZ_F32;
constexpr size_t OFF_A3 = OFF_A2 + al256((size_t)NROW * 256 * 2);
constexpr size_t END_RW = OFF_A3 + al256((size_t)NROW * 256 * 2);
constexpr size_t OFF_Y = OFF_XS;
constexpr int NCHK = (TC + TL) / 64;
constexpr size_t OFF_CK = END_RW;
constexpr size_t END_RW2 = OFF_CK + (size_t)128 * NCHK * 4 * 4096 * 2;
constexpr size_t OFF_AFF = OFF_S;
constexpr size_t OFF_ROWIDX = OFF_AFF + al256((size_t)NROW * 16 * 4);
constexpr size_t OFF_GATE = OFF_ROWIDX + al256((size_t)NE * ESLOTS * 4);
constexpr size_t OFF_SLOT = OFF_GATE + al256((size_t)NE * EPAD * 4);
constexpr size_t OFF_XE = OFF_SLOT + al256((size_t)NROW * 16 * 4);
constexpr size_t OFF_HID = OFF_XE + al256((size_t)NE * EPAD * D * 2);
constexpr size_t OFF_YE = OFF_HID + al256((size_t)NE * EPAD * FF * 2);
constexpr size_t END_MOE = OFF_YE + al256((size_t)NE * EPAD * D * 2);
constexpr size_t WS_NEED = END_RW2 > END_MLA ? (END_RW2 > END_MOE ? END_RW2 : END_MOE) : (END_MLA > END_MOE ? END_MLA : END_MOE);

constexpr int LDS_BYTES = 152064;

struct Params {
    const float *x, *c, *ctx, *c_ctx, *mod_w, *mod_b, *norm1_g, *norm2_g, *final_g;
    const float *mla_w_in, *mla_g_q, *mla_g_kv, *mla_w_uq, *mla_w_ukv, *mla_w_o;
    const float *rw_mu, *rw_w_rkv, *rw_w0, *rw_w1, *rw_w2, *rw_a0, *rw_a1, *rw_a2, *rw_v0, *rw_v1, *rw_v2, *rw_g1, *rw_g2, *rw_k_k, *rw_k_a, *rw_r_k, *rw_lnx_g, *rw_lnx_b, *rw_w_o;
    const float *moe_router, *moe_w1, *moe_w3, *moe_w2;
    float* out; char* ws;
    int wv, pad_;
};

__device__ __forceinline__ int bidx() { int t = blockIdx.x; asm volatile("" : "+s"(t)); return t; }
__device__ __forceinline__ int gdim() { int t = gridDim.x; asm volatile("" : "+s"(t)); return t; }
__device__ __forceinline__ int tidx_w(int wv) { int l; asm volatile("v_mbcnt_lo_u32_b32 %0, -1, 0\n\tv_mbcnt_hi_u32_b32 %0, -1, %0" : "=v"(l)); return (wv << 6) | l; }
#define tidx() tidx_w(p.wv)
#define XB_TMO      128
#define XB_XCNT(j)  (256  + 64 * (j))
#define XB_XSUB(j)  (1280 + 64 * (j))
#define XB_XGEN(j)  (2304 + 64 * (j))
#define XB_TOP      3328
#define XB_TOPGEN   3392
#define XCD_BAR_WORDS 3456
#define XB_SPIN_CAP (1u << 22)
#define LAS __attribute__((address_space(3)))

__device__ __forceinline__ unsigned xb_ld(unsigned* p)              { return __hip_atomic_load(p, __ATOMIC_RELAXED, __HIP_MEMORY_SCOPE_AGENT); }
__device__ __forceinline__ unsigned xb_add(unsigned* p, unsigned v) { return __hip_atomic_fetch_add(p, v, __ATOMIC_RELAXED, __HIP_MEMORY_SCOPE_AGENT); }
__device__ __forceinline__ unsigned xb_xcc_id() { return (unsigned)__builtin_amdgcn_s_getreg((3 << 11) | 20) & 0xFu; }
#define XB_SPIN(cond, bar) do { unsigned _sp = 0; while (cond) { __builtin_amdgcn_s_sleep(1); \
    if ((++_sp & 255u) == 0u) { if (xb_ld(&(bar)[XB_TMO])) break; if (_sp > XB_SPIN_CAP) { atomicAdd(&(bar)[XB_TMO], 1u); break; } } } } while (0)

struct XcdBarrier { unsigned* bar; unsigned x; volatile LAS unsigned* st; };

__device__ __forceinline__ XcdBarrier xcd_barrier_post(unsigned* bar, volatile LAS unsigned* st) {
    XcdBarrier b; b.bar = bar; b.x = xb_xcc_id(); b.st = st;
    if (threadIdx.x == 0) (void)xb_add(&bar[XB_XCNT(b.x)], 1u);
    return b;
}
__device__ __forceinline__ void xcd_barrier_complete(unsigned* bar, unsigned x, unsigned& nloc, unsigned& nx) {
    const unsigned G = gridDim.x * gridDim.y * gridDim.z;
    unsigned sum, cnt, mine, sp = 0u;
    for (;;) {
        sum = 0u; cnt = 0u; mine = 0u;
#pragma unroll
        for (unsigned j = 0; j < 16; ++j) { const unsigned c = xb_ld(&bar[XB_XCNT(j)]); sum += c; cnt += (c > 0u) ? 1u : 0u; mine = (j == x) ? c : mine; }
        if (sum == G) break;
        __builtin_amdgcn_s_sleep(1);
        if ((++sp & 255u) == 0u) { if (xb_ld(&bar[XB_TMO])) break; if (sp > XB_SPIN_CAP) { atomicAdd(&bar[XB_TMO], 1u); break; } }
    }
    nloc = mine > 0u ? mine : 1u; nx = cnt > 0u ? cnt : 1u;
}
__device__ __forceinline__ void xcd_barrier(const XcdBarrier& b) {
    asm volatile("s_waitcnt vmcnt(0)" ::: "memory");
    __syncthreads();
    if (threadIdx.x == 0) {
        unsigned* bar = b.bar;
        __builtin_amdgcn_s_waitcnt(0);
        unsigned nloc = b.st[0], nx = b.st[1];
        if (nloc == 0u) { xcd_barrier_complete(bar, b.x, nloc, nx); b.st[0] = nloc; b.st[1] = nx; }
        const unsigned old = xb_add(&bar[XB_XSUB(b.x)], 1u);
        const unsigned gen = old / nloc;
        if (old + 1u == (gen + 1u) * nloc) {
            __builtin_amdgcn_fence(__ATOMIC_RELEASE, "agent");
            asm volatile("s_waitcnt vmcnt(0)" ::: "memory");
            const unsigned og = xb_add(&bar[XB_TOP], 1u);
            const unsigned tg = og / nx;
            if (og + 1u == (tg + 1u) * nx) xb_add(&bar[XB_TOPGEN], 1u);
            else XB_SPIN(xb_ld(&bar[XB_TOPGEN]) == tg, bar);
            __builtin_amdgcn_fence(__ATOMIC_ACQUIRE, "agent");
            xb_add(&bar[XB_XGEN(b.x)], 1u);
            asm volatile("s_waitcnt vmcnt(0)" ::: "memory");
        } else {
            XB_SPIN(xb_ld(&bar[XB_XGEN(b.x)]) == gen, bar);
            __builtin_amdgcn_fence(__ATOMIC_ACQUIRE, "agent");
            asm volatile("s_waitcnt vmcnt(0)" ::: "memory");
        }
    }
    __syncthreads();
}

__device__ __forceinline__ float bf2f(bf16_t b) { return __uint_as_float(((unsigned)b) << 16); }
typedef float f32x2_ __attribute__((ext_vector_type(2)));
typedef __bf16 bf16x2_ __attribute__((ext_vector_type(2)));
__device__ __forceinline__ unsigned pk2(float lo, float hi) { const f32x2_ v = {lo, hi}; return __builtin_bit_cast(unsigned, __builtin_convertvector(v, bf16x2_)); }
__device__ __forceinline__ bf16_t f2bf(float f) { return (bf16_t)(pk2(f, f) & 0xffffu); }
__device__ __forceinline__ float dpp_sum16(float x) {
    x += __builtin_bit_cast(float, __builtin_amdgcn_update_dpp(0, __builtin_bit_cast(int, x), 0xB1, 0xF, 0xF, true));
    x += __builtin_bit_cast(float, __builtin_amdgcn_update_dpp(0, __builtin_bit_cast(int, x), 0x4E, 0xF, 0xF, true));
    x += __builtin_bit_cast(float, __builtin_amdgcn_update_dpp(0, __builtin_bit_cast(int, x), 0x141, 0xF, 0xF, true));
    x += __builtin_bit_cast(float, __builtin_amdgcn_update_dpp(0, __builtin_bit_cast(int, x), 0x140, 0xF, 0xF, true));
    return x;
}
__device__ __forceinline__ f32x4 ldbf4(const bf16_t* p) { const uint2 w = *(const uint2*)p; return (f32x4){__uint_as_float(w.x << 16), __uint_as_float(w.x & 0xffff0000u), __uint_as_float(w.y << 16), __uint_as_float(w.y & 0xffff0000u)}; }
__device__ __forceinline__ void stbf4(bf16_t* p, f32x4 v) { uint2 w; w.x = pk2(v[0], v[1]); w.y = pk2(v[2], v[3]); *(uint2*)p = w; }
__device__ __forceinline__ float wave_sum(float v) {
    v = dpp_sum16(v); const int i = __builtin_bit_cast(int, v);
    return __builtin_bit_cast(float, __builtin_amdgcn_readlane(i, 0)) + __builtin_bit_cast(float, __builtin_amdgcn_readlane(i, 16)) + __builtin_bit_cast(float, __builtin_amdgcn_readlane(i, 32)) + __builtin_bit_cast(float, __builtin_amdgcn_readlane(i, 48));
}
__device__ __forceinline__ float sigmoidf_(float x) { return __builtin_amdgcn_rcpf(1.f + __expf(-x)); }
__device__ __forceinline__ int row_stream(int row) { return row < NLAT ? (row >> 12) : 4; }
__device__ __forceinline__ const float* modp(const Params& p, int layer, int s, int part) { return (const float*)(p.ws + OFF_MOD) + ((size_t)layer * 5 + s) * 6144 + part * 1024; }

struct SgArgs { const bf16_t* A; int lda; size_t strideA; const float* B; int ldb; size_t strideB; int M, N, K, nbatch; };
template <class Epi>
__device__ __forceinline__ void sg_gemm(const Params& p, char* lds, const SgArgs g, const Epi& epi) {
    bf16_t* As = (bf16_t*)lds;
    bf16_t* Bs = As + 128 * 40;
    const int tid = tidx(), wid = tid >> 6, lane = tid & 63;
    const int wr = wid >> 2, wc = wid & 3;
    const int tilesN = (g.N + 127) / 128, tilesM = g.M / 128, per = tilesM * tilesN, ntiles = per * g.nbatch;
    const int ar = tid >> 2, ak = (tid & 3) * 8;
    const int bn = tid & 127, bk = (tid >> 7) * 8;
    for (int tile = bidx(); tile < ntiles; tile += gdim()) {
        const int bt = tile / per, tt = tile % per;
        const int tm = tt / tilesN, tn = tt % tilesN;
        const int m0 = tm * 128, n0 = tn * 128;
        f32x4 acc[4][2];
#pragma unroll
        for (int m = 0; m < 4; ++m)
#pragma unroll
            for (int n = 0; n < 2; ++n) acc[m][n] = (f32x4){0.f, 0.f, 0.f, 0.f};
        const bool bvalid = (n0 + bn) < g.N;
        const bf16_t* ap = g.A + bt * g.strideA + (size_t)(m0 + ar) * g.lda + ak;
        const float* bp = g.B + bt * g.strideB + (size_t)bk * g.ldb + n0 + bn;
        bf16x8 areg; float breg[8];
        areg = *(const bf16x8*)ap;
#pragma unroll
        for (int j = 0; j < 8; ++j) breg[j] = bvalid ? bp[(size_t)j * g.ldb] : 0.f;
        for (int k0 = 0; k0 < g.K; k0 += 32) {
            __syncthreads();
            *(bf16x8*)(As + ar * 40 + ak) = areg;
            { u32x4 w; w.x = pk2(breg[0], breg[1]); w.y = pk2(breg[2], breg[3]); w.z = pk2(breg[4], breg[5]); w.w = pk2(breg[6], breg[7]); *(u32x4*)(Bs + bn * 40 + bk) = w; }
            __syncthreads();
            if (k0 + 32 < g.K) {
                areg = *(const bf16x8*)(ap + k0 + 32);
#pragma unroll
                for (int j = 0; j < 8; ++j) breg[j] = bvalid ? bp[(size_t)(k0 + 32 + j) * g.ldb] : 0.f;
            }
            bf16x8 af[4], bfr[2];
#pragma unroll
            for (int m = 0; m < 4; ++m) af[m] = *(const bf16x8*)(As + (wr * 64 + m * 16 + (lane & 15)) * 40 + (lane >> 4) * 8);
#pragma unroll
            for (int n = 0; n < 2; ++n) bfr[n] = *(const bf16x8*)(Bs + (wc * 32 + n * 16 + (lane & 15)) * 40 + (lane >> 4) * 8);
#pragma unroll
            for (int m = 0; m < 4; ++m)
#pragma unroll
                for (int n = 0; n < 2; ++n) acc[m][n] = __builtin_amdgcn_mfma_f32_16x16x32_bf16(af[m], bfr[n], acc[m][n], 0, 0, 0);
        }
#pragma unroll
        for (int m = 0; m < 4; ++m)
#pragma unroll
            for (int n = 0; n < 2; ++n) {
                const int col = n0 + wc * 32 + n * 16 + (lane & 15);
                if (col < g.N) {
#pragma unroll
                    for (int r = 0; r < 4; ++r) epi(bt, m0 + wr * 64 + m * 16 + (lane >> 4) * 4 + r, col, acc[m][n][r]);
                }
            }
    }
}


namespace g8 {
#define PG8_LAS __attribute__((address_space(3)))
constexpr int BM = 256, BK = 64, HALF = 128, HTB = HALF * BK * 2, STAGE_BYTES = 8 * HTB;
__device__ __forceinline__ int lds_byte(int r, int c) { const int st = (r >> 4) * 2 + (c >> 5), rr = r & 15, cc = c & 31, ob = rr * 64 + cc * 2; return st * 1024 + (ob ^ (((ob >> 9) & 1) << 5)); }
__device__ __forceinline__ void stage_rc(int b, int& R, int& C) { const int st = b / 1024, sb = b % 1024, swz = sb ^ (((sb >> 9) & 1) << 5); R = (st >> 1) * 16 + swz / 64; C = (st & 1) * 32 + (swz % 64) / 2; }
struct Unit { int pm, pn, g; const char* A; const char* B; };
__device__ __forceinline__ int xcd_remap(int L, int nwg) { const int q = nwg / 8, r = nwg % 8, xcd = L % 8, off = L / 8; return (xcd < r ? xcd * (q + 1) : r * (q + 1) + (xcd - r) * q) + off; }

template <class Epi, class Sched>
__device__ __forceinline__ void gemm_phase(const int wv_, PG8_LAS unsigned char* lds, const int K, const Sched& S, const Epi& E) {
    const int tid = tidx_w(wv_), wid = __builtin_amdgcn_readfirstlane(tid >> 6), lane = tid & 63, wr = wid >> 2, wc = wid & 3, fr = lane & 15, fq = lane >> 4;
    const int nt = K / BK;
    unsigned voffA[2];
#pragma unroll
    for (int i = 0; i < 2; ++i) { int R, C; stage_rc(tid * 16 + i * 8192, R, C); voffA[i] = (unsigned)(R * K + C) * 2u; }
    const size_t kstep = (size_t)(BK * 2);
    const size_t hstep = (size_t)HALF * K * 2;
    const unsigned ldsw = (unsigned)wid * 1024u;
    const int aoff = lds_byte(wr * 64 + fr, fq * 8), boff = lds_byte(wc * 32 + fr, fq * 8);
#define PG8_SA(b, h) (((b) * 2 + (h)) * HTB)
#define PG8_SB(b, h) ((4 + (b) * 2 + (h)) * HTB)
#define PG8_STAGE(bufoff, gbase, voff) do { _Pragma("unroll") for (int _i = 0; _i < 2; ++_i) \
        __builtin_amdgcn_global_load_lds((const unsigned*)((const char*)(gbase) + (voff)[_i]), (PG8_LAS unsigned*)(lds + (bufoff) + ldsw + _i * 8192), 16, 0, 0); } while (0)
#define PG8_LDA(dst, b, h) do { _Pragma("unroll") for (int m = 0; m < 4; ++m) _Pragma("unroll") for (int k = 0; k < 2; ++k) dst[m][k] = *(const PG8_LAS bf16x8*)(lds + PG8_SA(b, h) + aoff + m * 2048 + k * 1024); } while (0)
#define PG8_LDB(dst, b, h) do { _Pragma("unroll") for (int n = 0; n < 2; ++n) _Pragma("unroll") for (int k = 0; k < 2; ++k) dst[n][k] = *(const PG8_LAS bf16x8*)(lds + PG8_SB(b, h) + boff + n * 2048 + k * 1024); } while (0)
#define PG8_MMA(ai, bj, At, Bt) do { __builtin_amdgcn_s_setprio(1); _Pragma("unroll") for (int m = 0; m < 4; ++m) _Pragma("unroll") for (int n = 0; n < 2; ++n) _Pragma("unroll") for (int k = 0; k < 2; ++k) \
        acc[ai][bj][m][n] = __builtin_amdgcn_mfma_f32_16x16x32_bf16(Bt[n][k], At[m][k], acc[ai][bj][m][n], 0, 0, 0); __builtin_amdgcn_s_setprio(0); } while (0)
#define PG8_WAIT_V(n) asm volatile("s_waitcnt vmcnt(" #n ")" ::: "memory")
#define PG8_WAIT_L(n) asm volatile("s_waitcnt lgkmcnt(" #n ")" ::: "memory")
#define PG8_BAR __builtin_amdgcn_s_barrier()
#define PG8_SCHED __builtin_amdgcn_sched_barrier(0)
    Unit cur, nxt; int ui = 0;
    if (!S.next(0, cur)) return;
    f32x4 acc[2][2][4][2];
#pragma unroll
    for (int a = 0; a < 2; ++a)
#pragma unroll
        for (int b = 0; b < 2; ++b)
#pragma unroll
            for (int m = 0; m < 4; ++m)
#pragma unroll
                for (int n = 0; n < 2; ++n) acc[a][b][m][n] = (f32x4){0.f, 0.f, 0.f, 0.f};
    bf16x8 At[4][2], B0[2][2], B1[2][2];
    const char* cA = cur.A; const char* cB = cur.B;
    PG8_STAGE(PG8_SB(0, 0), cB, voffA); PG8_STAGE(PG8_SA(0, 0), cA, voffA); PG8_STAGE(PG8_SB(0, 1), cB + hstep, voffA); PG8_STAGE(PG8_SA(0, 1), cA + hstep, voffA);
    if (wr == 1) PG8_BAR;
    PG8_WAIT_V(4); PG8_BAR;
    PG8_STAGE(PG8_SB(1, 0), cB + kstep, voffA); PG8_STAGE(PG8_SA(1, 0), cA + kstep, voffA); PG8_STAGE(PG8_SB(1, 1), cB + hstep + kstep, voffA);
    PG8_WAIT_V(6); PG8_BAR;
    for (;;) {
        const bool has_next = S.next(ui + 1, nxt);
        const char* nA = has_next ? nxt.A : cA; const char* nB = has_next ? nxt.B : cB;
        for (int t = 0; t < nt; t += 2) {
            const bool last = (t == nt - 2);
            const char* a1 = cA + (size_t)(t + 1) * kstep;
            const char* a2 = last ? nA : cA + (size_t)(t + 2) * kstep; const char* b2 = last ? nB : cB + (size_t)(t + 2) * kstep;
            const char* a3 = a2 + kstep; const char* b3 = b2 + kstep;
            PG8_LDB(B0, 0, 0); PG8_SCHED; PG8_LDA(At, 0, 0); PG8_STAGE(PG8_SA(1, 1), a1 + hstep, voffA);
            PG8_WAIT_L(8); PG8_BAR; PG8_WAIT_L(0); PG8_MMA(0, 0, At, B0); PG8_BAR; PG8_SCHED;
            PG8_LDB(B1, 0, 1); PG8_STAGE(PG8_SB(0, 0), b2, voffA);
            PG8_BAR; PG8_WAIT_L(0); PG8_MMA(0, 1, At, B1); PG8_BAR;
            PG8_LDA(At, 0, 1); PG8_STAGE(PG8_SA(0, 0), a2, voffA);
            PG8_BAR; PG8_WAIT_L(0); PG8_MMA(1, 0, At, B0); PG8_BAR; PG8_SCHED;
            PG8_STAGE(PG8_SB(0, 1), b2 + hstep, voffA);
            PG8_WAIT_V(6); PG8_BAR; PG8_MMA(1, 1, At, B1); PG8_BAR;
            PG8_LDB(B0, 1, 0); PG8_SCHED; PG8_LDA(At, 1, 0); PG8_STAGE(PG8_SA(0, 1), a2 + hstep, voffA);
            PG8_WAIT_L(8); PG8_BAR; PG8_WAIT_L(0); PG8_MMA(0, 0, At, B0); PG8_BAR; PG8_SCHED;
            PG8_LDB(B1, 1, 1); PG8_STAGE(PG8_SB(1, 0), b3, voffA);
            PG8_BAR; PG8_WAIT_L(0); PG8_MMA(0, 1, At, B1); PG8_BAR;
            PG8_LDA(At, 1, 1); PG8_STAGE(PG8_SA(1, 0), a3, voffA);
            PG8_BAR; PG8_WAIT_L(0); PG8_MMA(1, 0, At, B0); PG8_BAR; PG8_SCHED;
            PG8_STAGE(PG8_SB(1, 1), b3 + hstep, voffA);
            PG8_WAIT_V(6); PG8_BAR; PG8_MMA(1, 1, At, B1); PG8_BAR;
        }
        E(acc, cur, wr, wc, fr, fq);
        if (!has_next) break;
#pragma unroll
        for (int a = 0; a < 2; ++a)
#pragma unroll
            for (int b = 0; b < 2; ++b)
#pragma unroll
                for (int m = 0; m < 4; ++m)
#pragma unroll
                    for (int n = 0; n < 2; ++n) acc[a][b][m][n] = (f32x4){0.f, 0.f, 0.f, 0.f};
        cur = nxt; cA = nA; cB = nB; ++ui;
    }
    PG8_WAIT_V(0);
    if (wr == 0) PG8_BAR;
    PG8_BAR;
#undef PG8_SA
#undef PG8_SB
#undef PG8_STAGE
#undef PG8_LDA
#undef PG8_LDB
#undef PG8_MMA
#undef PG8_WAIT_V
#undef PG8_WAIT_L
#undef PG8_BAR
#undef PG8_SCHED
}
template <class F> struct EpiRC { F f;
    __device__ __forceinline__ void operator()(const f32x4 (&acc)[2][2][4][2], const Unit& u, int wr, int wc, int fr, int fq) const {
#pragma unroll
        for (int ai = 0; ai < 2; ++ai)
#pragma unroll
            for (int m = 0; m < 4; ++m) { const int row = u.pm * BM + ai * HALF + wr * 64 + m * 16 + fr;
#pragma unroll
                for (int bj = 0; bj < 2; ++bj)
#pragma unroll
                    for (int n = 0; n < 2; ++n) f(u, row, u.pn * BM + bj * HALF + wc * 32 + n * 16 + 4 * fq, acc[ai][bj][m][n]);
                asm volatile("" ::: "memory"); }
    } };
template <class F> __device__ __forceinline__ EpiRC<F> epi_rc(const F& f) { return EpiRC<F>{f}; }
template <class F> struct EpiPair { F f;
    __device__ __forceinline__ void operator()(const f32x4 (&acc)[2][2][4][2], const Unit& u, int wr, int wc, int fr, int fq) const {
#pragma unroll
        for (int ai = 0; ai < 2; ++ai)
#pragma unroll
            for (int m = 0; m < 4; ++m) { const int row = u.pm * BM + ai * HALF + wr * 64 + m * 16 + fr;
#pragma unroll
                for (int n = 0; n < 2; ++n) f(u, row, u.pn * HALF + wc * 32 + n * 16 + 4 * fq, acc[ai][0][m][n], acc[ai][1][m][n]);
                asm volatile("" ::: "memory"); }
    } };
template <class F> __device__ __forceinline__ EpiPair<F> epi_pair(const F& f) { return EpiPair<F>{f}; }
template <class F, class CF, class RF> struct EpiPre { F f; CF cf; RF rf;
    __device__ __forceinline__ void operator()(const f32x4 (&acc)[2][2][4][2], const Unit& u, int wr, int wc, int fr, int fq) const {
        f32x4 cv[2][2]; float rv[2][4];
#pragma unroll
        for (int bj = 0; bj < 2; ++bj)
#pragma unroll
            for (int n = 0; n < 2; ++n) cv[bj][n] = cf(u, u.pn * BM + bj * HALF + wc * 32 + n * 16 + 4 * fq);
#pragma unroll
        for (int ai = 0; ai < 2; ++ai)
#pragma unroll
            for (int m = 0; m < 4; ++m) rv[ai][m] = rf(u, u.pm * BM + ai * HALF + wr * 64 + m * 16 + fr);
#pragma unroll
        for (int ai = 0; ai < 2; ++ai)
#pragma unroll
            for (int m = 0; m < 4; ++m) { const int row = u.pm * BM + ai * HALF + wr * 64 + m * 16 + fr;
#pragma unroll
                for (int bj = 0; bj < 2; ++bj)
#pragma unroll
                    for (int n = 0; n < 2; ++n) f(u, row, u.pn * BM + bj * HALF + wc * 32 + n * 16 + 4 * fq, acc[ai][bj][m][n], cv[bj][n], rv[ai][m]);
                asm volatile("" ::: "memory"); }
    } };
template <class F, class CF, class RF> __device__ __forceinline__ EpiPre<F, CF, RF> epi_pre(const F& f, const CF& cf, const RF& rf) { return EpiPre<F, CF, RF>{f, cf, rf}; }
template <class F, class CF> struct EpiColFirst { F f; CF cf;
    __device__ __forceinline__ void operator()(const f32x4 (&acc)[2][2][4][2], const Unit& u, int wr, int wc, int fr, int fq) const {
#pragma unroll
        for (int bj = 0; bj < 2; ++bj)
#pragma unroll
            for (int n = 0; n < 2; ++n) { const int col = u.pn * BM + bj * HALF + wc * 32 + n * 16 + 4 * fq; const f32x4 cv = cf(u, col);
#pragma unroll
                for (int ai = 0; ai < 2; ++ai)
#pragma unroll
                    for (int m = 0; m < 4; ++m) f(u, u.pm * BM + ai * HALF + wr * 64 + m * 16 + fr, col, acc[ai][bj][m][n], cv);
                asm volatile("" ::: "memory"); }
    } };
template <class F, class CF> __device__ __forceinline__ EpiColFirst<F, CF> epi_colfirst(const F& f, const CF& cf) { return EpiColFirst<F, CF>{f, cf}; }
struct EpiResid { float* X; const float* MOD; int layer;
    __device__ __forceinline__ void operator()(const f32x4 (&acc)[2][2][4][2], const Unit& u, int wr, int wc, int fr, int fq) const {
        const int row0 = u.pm * BM + wr * 64 + fr, col0 = u.pn * BM + wc * 32 + 4 * fq;
        const int strm = row0 < NLAT ? (row0 >> 12) : 4;
        const float* gp = MOD + ((size_t)layer * 5 + strm) * 6144 + 2048 + col0;
        f32x4 gt[2][2];
#pragma unroll
        for (int bj = 0; bj < 2; ++bj)
#pragma unroll
            for (int n = 0; n < 2; ++n) gt[bj][n] = *(const f32x4*)(gp + bj * HALF + n * 16);
#pragma unroll
        for (int ai = 0; ai < 2; ++ai) {
            f32x4 xv[4][2][2];
#pragma unroll
            for (int m = 0; m < 4; ++m)
#pragma unroll
                for (int bj = 0; bj < 2; ++bj)
#pragma unroll
                    for (int n = 0; n < 2; ++n) xv[m][bj][n] = *(const f32x4*)(X + (size_t)(row0 + ai * HALF + m * 16) * D + col0 + bj * HALF + n * 16);
#pragma unroll
            for (int m = 0; m < 4; ++m)
#pragma unroll
                for (int bj = 0; bj < 2; ++bj)
#pragma unroll
                    for (int n = 0; n < 2; ++n) *(f32x4*)(X + (size_t)(row0 + ai * HALF + m * 16) * D + col0 + bj * HALF + n * 16) = xv[m][bj][n] + gt[bj][n] * acc[ai][bj][m][n];
            asm volatile("" ::: "memory");
        }
    } };
struct BatchSched { const char* A; const char* B; size_t strideA, strideB; int nM, nN, nb, K;
    __device__ __forceinline__ bool next(int i, Unit& u) const {
        const int nwg = nM * nN * nb; const int L = i * gdim() + bidx(); if (L >= nwg) return false;
        const int w = xcd_remap(L, nwg); const int per = nM * nN; u.g = w / per; const int r = w % per; u.pm = r / nN; u.pn = r % nN;
        u.A = A + u.g * strideA + (size_t)u.pm * BM * K * 2; u.B = B + u.g * strideB + (size_t)u.pn * BM * K * 2; return true; } };
}

template <class SrcF, class DRow>
__device__ __forceinline__ void cvt_tiles(const int wv_, char* lds, bf16_t* dst, int Kd, int Nd, int nbatch, size_t dstride, const SrcF& src, const DRow& drow, unsigned* queue = nullptr) {
    bf16_t* T = (bf16_t*)lds;
    int* qslot = (int*)(lds + 64 * 136 * 2);
    const int tid = tidx_w(wv_);
    const int tk = Kd / 128, tn = Nd / 64, per = tk * tn, total = per * nbatch;
    constexpr int QG = 8;
    int t = queue ? 0 : bidx(), tnext = 0, sub = 0;
    if (queue) { if (tid == 0) { qslot[0] = QG * (int)__hip_atomic_fetch_add(queue, 1u, __ATOMIC_RELAXED, __HIP_MEMORY_SCOPE_AGENT); } __syncthreads(); t = qslot[0]; __syncthreads(); }
    while (t < total) {
        if (queue && sub == 0 && tid == 0) tnext = QG * (int)__hip_atomic_fetch_add(queue, 1u, __ATOMIC_RELAXED, __HIP_MEMORY_SCOPE_AGENT);
        const int bt = t / per, r = t % per, k0 = (r % tk) * 128, n0 = (r / tk) * 64;
        float4 v[4];
#pragma unroll
        for (int i = 0; i < 4; ++i) { const int k = k0 + i * 32 + (tid >> 4), n = n0 + (tid & 15) * 4; const float* sp = src(bt, k, n); v[i] = sp ? *(const float4*)sp : make_float4(0.f, 0.f, 0.f, 0.f); }
        __syncthreads();
#pragma unroll
        for (int i = 0; i < 4; ++i) { const int k = i * 32 + (tid >> 4), n = (tid & 15) * 4;
            T[(n + 0) * 136 + k] = f2bf(v[i].x); T[(n + 1) * 136 + k] = f2bf(v[i].y); T[(n + 2) * 136 + k] = f2bf(v[i].z); T[(n + 3) * 136 + k] = f2bf(v[i].w); }
        if (queue && sub == QG - 1 && tid == 0) qslot[0] = tnext;
        __syncthreads();
        { const int n = tid >> 3, kc = (tid & 7) * 16;
          const u32x4 a = *(const u32x4*)(T + n * 136 + kc), b = *(const u32x4*)(T + n * 136 + kc + 8);
          bf16_t* dp = dst + bt * dstride + (size_t)drow(n0 + n) * Kd + k0 + kc;
          *(u32x4*)dp = a; *(u32x4*)(dp + 8) = b; }
        if (queue) { if (++sub == QG) { sub = 0; t = qslot[0]; } else ++t; } else t += gdim();
    }
}
__device__ void ph_moe_cvt(const Params& p, int layer, char* lds) {
    const float* w1 = p.moe_w1 + (size_t)layer * NE * D * FF; const float* w3 = p.moe_w3 + (size_t)layer * NE * D * FF; const float* w2 = p.moe_w2 + (size_t)layer * NE * FF * D;
    cvt_tiles(p.wv, lds, (bf16_t*)(p.ws + OFF_W13T), D, 2816, NE, (size_t)2816 * D,
        [=](int e, int k, int n) -> const float* { const int pn = n >> 8, half = (n >> 7) & 1, c = pn * 128 + (n & 127); return (half ? w3 : w1) + ((size_t)e * D + k) * FF + c; },
        [=](int n) { return n; }, (unsigned*)(p.ws + OFF_QUEUE) + (layer * 2) * 16);
    cvt_tiles(p.wv, lds, (bf16_t*)(p.ws + OFF_W2T), FF, D, NE, (size_t)D * FF,
        [=](int e, int k, int n) -> const float* { return w2 + ((size_t)e * FF + k) * D + n; },
        [=](int n) { return n; }, (unsigned*)(p.ws + OFF_QUEUE) + (layer * 2 + 1) * 16);
}

__device__ void ph_init(const Params& p, char* lds) {
    const int tid = tidx(), gtid = bidx() * NTHR + tid, gsz = gdim() * NTHR;
    float4* X4 = (float4*)(p.ws + OFF_X);
    const float4* x4 = (const float4*)p.x; const float4* c4 = (const float4*)p.ctx;
    { constexpr int NQ = NROW * 256 / 4;
      auto srcv = [&](int k) { return k < NLAT * 256 ? x4[k] : c4[k - NLAT * 256]; };
      for (int i = gtid; i < NQ; i += gsz) { const float4 t0 = srcv(i), t1 = srcv(i + NQ), t2 = srcv(i + 2 * NQ), t3 = srcv(i + 3 * NQ); X4[i] = t0; X4[i + NQ] = t1; X4[i + 2 * NQ] = t2; X4[i + 3 * NQ] = t3; } }
    float* rc = (float*)(p.ws + OFF_ROPE_C); float* rs = (float*)(p.ws + OFF_ROPE_S);
    for (int i = gtid; i < TL * 32; i += gsz) {
        const int t = i >> 5, f = i & 31; const float pos = (float)((f < 16) ? (t >> 6) : (t & 63));
        const float inv = powf(10000.f, -(float)(f & 15) / 16.f); const float ang = pos * inv; rc[2 * i] = cosf(ang); rc[2 * i + 1] = sinf(ang);
    }
    float* sc = (float*)lds;
    float* red = sc + 5 * 1024;
    for (int i = tid; i < 5 * 1024; i += NTHR) { const float v = i < 4096 ? p.c[i] : p.c_ctx[i - 4096]; sc[i] = v / (1.f + expf(-v)); }
    __syncthreads();
    float* MOD = (float*)(p.ws + OFF_MOD);
    for (int item = bidx(); item < 4 * 96; item += gdim()) {
        const int l = item / 96, cg = item % 96, col = tid & 63, n = cg * 64 + col, kg = tid >> 6;
        const float* w = p.mod_w + ((size_t)l * 1024 + kg * 128) * 6144 + n;
        float a0 = 0, a1 = 0, a2 = 0, a3 = 0, a4 = 0;
#pragma unroll 16
        for (int k = 0; k < 128; ++k) { const float wv = w[(size_t)k * 6144]; const int kk = kg * 128 + k;
            a0 += sc[kk] * wv; a1 += sc[1024 + kk] * wv; a2 += sc[2048 + kk] * wv; a3 += sc[3072 + kk] * wv; a4 += sc[4096 + kk] * wv; }
        float* rr = red + (kg * 64 + col) * 5; rr[0] = a0; rr[1] = a1; rr[2] = a2; rr[3] = a3; rr[4] = a4;
        __syncthreads();
        if (tid < 320) { const int c2 = tid & 63, s = tid >> 6; float sum = 0;
            for (int q = 0; q < 8; ++q) sum += red[(q * 64 + c2) * 5 + s];
            MOD[((size_t)l * 5 + s) * 6144 + cg * 64 + c2] = sum + p.mod_b[l * 6144 + cg * 64 + c2]; }
        __syncthreads();
    }
}


__device__ void ph_small_cvt(const Params& p, char* lds) {
    for (int j = 0; j < 2; ++j) {
        char* wm = p.ws + OFF_WMLA + j * SZ_WMLA; char* wr = p.ws + OFF_WRW + j * SZ_WRW;
        const float* w_in = p.mla_w_in + (size_t)j * D * 448; const float* w_uq = p.mla_w_uq + (size_t)j * 256 * 1536; const float* w_ukv = p.mla_w_ukv + (size_t)j * 128 * 2048; const float* w_o = p.mla_w_o + (size_t)j * D * D;
        cvt_tiles(p.wv, lds, (bf16_t*)(wm + WM_IN), 1024, 512, 1, 0, [=](int, int k, int n) -> const float* { return n < 448 ? w_in + (size_t)k * 448 + n : nullptr; },
                  [=](int n) { if (n < 384 || n >= 448) return n; const int jj = n - 384; return 384 + (jj < 32 ? 2 * jj : 2 * (jj - 32) + 1); });
        cvt_tiles(p.wv, lds, (bf16_t*)(wm + WM_UQ), 256, 1536, 1, 0, [=](int, int k, int n) -> const float* { return w_uq + (size_t)k * 1536 + n; },
                  [=](int n) { const int h = n / 192, d = n % 192; if (d < 128) return n; const int jj = d - 128; return h * 192 + 128 + (jj < 32 ? 2 * jj : 2 * (jj - 32) + 1); });
        cvt_tiles(p.wv, lds, (bf16_t*)(wm + WM_UKV), 256, 2048, 1, 0, [=](int, int k, int n) -> const float* { return k < 128 ? w_ukv + (size_t)k * 2048 + n : nullptr; }, [=](int n) { return n; });
        cvt_tiles(p.wv, lds, (bf16_t*)(wm + WM_O), 1024, 1024, 1, 0, [=](int, int k, int n) -> const float* { return w_o + (size_t)k * D + n; }, [=](int n) { return n; });
        const float* w_rkv = p.rw_w_rkv + (size_t)j * 3 * D * D; const float* w1 = p.rw_w1 + (size_t)j * 2 * D * 64; const float* a1 = p.rw_a1 + (size_t)j * 2 * D * 64;
        const float* g1 = p.rw_g1 + (size_t)j * D * 128; const float* v1 = p.rw_v1; const float* rwo = p.rw_w_o + (size_t)j * D * D;
        cvt_tiles(p.wv, lds, (bf16_t*)(wr + WR_RKV), 1024, 1024, 3, (size_t)D * D, [=](int m, int k, int n) -> const float* { return w_rkv + ((size_t)m * D + k) * D + n; }, [=](int n) { return n; });
        cvt_tiles(p.wv, lds, (bf16_t*)(wr + WR_L), 1024, 256, 1, 0, [=](int, int k, int n) -> const float* { return n < 128 ? w1 + ((size_t)(n >> 6) * D + k) * 64 + (n & 63) : nullptr; }, [=](int n) { return n; });
        cvt_tiles(p.wv, lds, (bf16_t*)(wr + WR_L) + 256 * 1024, 1024, 256, 1, 0, [=](int, int k, int n) -> const float* { return n < 128 ? a1 + ((size_t)(n >> 6) * D + k) * 64 + (n & 63) : nullptr; }, [=](int n) { return n; });
        cvt_tiles(p.wv, lds, (bf16_t*)(wr + WR_L) + 2 * 256 * 1024, 1024, 256, 1, 0, [=](int, int k, int n) -> const float* { return n < 128 ? g1 + (size_t)k * 128 + n : nullptr; }, [=](int n) { return n; });
        cvt_tiles(p.wv, lds, (bf16_t*)(wr + WR_L) + 3 * 256 * 1024, 1024, 256, 1, 0, [=](int, int k, int n) -> const float* { return n < 32 ? v1 + (size_t)k * 32 + n : nullptr; }, [=](int n) { return n; });
        cvt_tiles(p.wv, lds, (bf16_t*)(wr + WR_O), 1024, 1024, 1, 0, [=](int, int k, int n) -> const float* { return rwo + (size_t)k * D + n; }, [=](int n) { return n; });
        const float* w2 = p.rw_w2 + (size_t)j * 2 * 64 * D; const float* a2 = p.rw_a2 + (size_t)j * 2 * 64 * D; const float* g2 = p.rw_g2 + (size_t)j * 128 * D; const float* v2 = p.rw_v2;
        cvt_tiles(p.wv, lds, (bf16_t*)(wr + WR_B2), 256, 4096, 1, 0, [=](int, int k, int n) -> const float* { const int blk = n >> 10, c = n & 1023, l = k - blk * 64;
            if (l < 0 || l >= 64) return nullptr; return (blk < 2 ? w2 + ((size_t)blk * 64 + l) * D : a2 + ((size_t)(blk - 2) * 64 + l) * D) + c; }, [=](int n) { return n; });
        cvt_tiles(p.wv, lds, (bf16_t*)(wr + WR_B3), 256, 2048, 1, 0, [=](int, int k, int n) -> const float* {
            if (n < 1024) return k < 128 ? g2 + (size_t)k * D + n : nullptr; return (k >= 128 && k < 160) ? v2 + (size_t)(k - 128) * D + (n - 1024) : nullptr; }, [=](int n) { return n; });
    }
}

template <bool OUTF32>
__device__ void ph_norm_mod(const Params& p, int layer, const float* g, int part_sh, int part_sc, void* outp) {
    const int wid = tidx() >> 6, lane = tidx() & 63;
    const float* X = (const float*)(p.ws + OFF_X);
    int row = bidx() * 8 + wid;
    float4 nv[4];
    if (row < NROW) {
#pragma unroll
        for (int i = 0; i < 4; ++i) nv[i] = ((const float4*)(X + (size_t)row * D))[lane + i * 64]; }
    for (; row < NROW; row += gdim() * 8) {
        const int s = row_stream(row);
        const float* sh = modp(p, layer, s, part_sh); const float* sc = modp(p, layer, s, part_sc);
        float4 v[4]; float ss = 0;
#pragma unroll
        for (int i = 0; i < 4; ++i) { v[i] = nv[i]; ss += v[i].x * v[i].x + v[i].y * v[i].y + v[i].z * v[i].z + v[i].w * v[i].w; }
        { const int nrow = row + gdim() * 8;
          if (nrow < NROW) {
#pragma unroll
              for (int i = 0; i < 4; ++i) nv[i] = ((const float4*)(X + (size_t)nrow * D))[lane + i * 64]; } }
        ss = wave_sum(ss); const float rs = rsqrtf(ss * (1.f / D) + RMS_EPS);
#pragma unroll
        for (int i = 0; i < 4; ++i) {
            const int d = (lane + i * 64) * 4;
            const float4 gg = *(const float4*)(g + d), a = *(const float4*)(sc + d), b = *(const float4*)(sh + d);
            float4 o; o.x = v[i].x * rs * gg.x * (1.f + a.x) + b.x; o.y = v[i].y * rs * gg.y * (1.f + a.y) + b.y; o.z = v[i].z * rs * gg.z * (1.f + a.z) + b.z; o.w = v[i].w * rs * gg.w * (1.f + a.w) + b.w;
            if (OUTF32) *(float4*)((float*)outp + (size_t)row * D + d) = o;
            else { uint2 w; w.x = pk2(o.x, o.y); w.y = pk2(o.z, o.w); *(uint2*)((bf16_t*)outp + (size_t)row * D + d) = w; }
        }
    }
}

__device__ void ph_mla_mid(const Params& p, int j) {
    const int wid = tidx() >> 6, lane = tidx() & 63;
    const float* Z = (const float*)(p.ws + OFF_Z);
    bf16_t* CQN = (bf16_t*)(p.ws + OFF_CQN); bf16_t* CKVN = (bf16_t*)(p.ws + OFF_CKVN); bf16_t* K = (bf16_t*)(p.ws + OFF_K);
    const float* gq = p.mla_g_q + j * 256; const float* gkv = p.mla_g_kv + j * 128;
    const float* rc = (const float*)(p.ws + OFF_ROPE_C); const float* rs = (const float*)(p.ws + OFF_ROPE_S);
    for (int row = bidx() * 8 + wid; row < NROW; row += gdim() * 8) {
        const float* z = Z + (size_t)row * 512;
        const float4 q = *(const float4*)(z + lane * 4);
        const float2 kv = *(const float2*)(z + 256 + lane * 2);
        const float kr = z[384 + lane];
        float sq = wave_sum(q.x * q.x + q.y * q.y + q.z * q.z + q.w * q.w); const float rq = rsqrtf(sq * (1.f / 256.f) + RMS_EPS);
        float sk = wave_sum(kv.x * kv.x + kv.y * kv.y); const float rk = rsqrtf(sk * (1.f / 128.f) + RMS_EPS);
        const float4 g4 = *(const float4*)(gq + lane * 4); const float2 g2 = *(const float2*)(gkv + lane * 2);
        uint2 w; w.x = pk2(q.x * rq * g4.x, q.y * rq * g4.y); w.y = pk2(q.z * rq * g4.z, q.w * rq * g4.w);
        *(uint2*)(CQN + (size_t)row * 256 + lane * 4) = w;
        *(unsigned*)(CKVN + (size_t)row * 256 + lane * 2) = pk2(kv.x * rk * g2.x, kv.y * rk * g2.y);
        *(unsigned*)(CKVN + (size_t)row * 256 + 128 + lane * 2) = 0u;
        float o = kr;
        const float other = __builtin_bit_cast(float, __builtin_amdgcn_update_dpp(0, __builtin_bit_cast(int, kr), 0xB1, 0xF, 0xF, true));
        const bool lat = row < NLAT;
        if (lat) { const int t = row & (TL - 1), i = lane >> 1; const float2 cs = *(const float2*)(rc + (t * 32 + i) * 2); const float c = cs.x, s = cs.y;
            o = (lane & 1) ? (other * s + kr * c) : (kr * c - other * s); }
        const int b = lat ? (row >> 12) : ((row - NLAT) >> 8); const int tk = lat ? 256 + (row & (TL - 1)) : ((row - NLAT) & 255);
        const bf16_t ob = f2bf(o);
#pragma unroll
        for (int h = 0; h < 8; ++h) K[((size_t)(b * 8 + h) * TK + tk) * 192 + 128 + lane] = ob;
    }
}

__device__ void ph_qkv_post(const Params& p) {
    const int wid = tidx() >> 6, lane = tidx() & 63;
    const float* QRAW = (const float*)(p.ws + OFF_QRAW); const float* KVRAW = (const float*)(p.ws + OFF_KVRAW); const float* KR = (const float*)(p.ws + OFF_KR);
    bf16_t* Q = (bf16_t*)(p.ws + OFF_Q); bf16_t* K = (bf16_t*)(p.ws + OFF_K); bf16_t* V = (bf16_t*)(p.ws + OFF_V);
    const float* rc = (const float*)(p.ws + OFF_ROPE_C); const float* rs = (const float*)(p.ws + OFF_ROPE_S);
    for (int it = bidx() * 8 + wid; it < NROW * 8; it += gdim() * 8) {
        const int row = it >> 3, h = it & 7;
        const bool lat = row < NLAT; const int b = lat ? (row >> 12) : ((row - NLAT) >> 8); const int tk = lat ? 256 + (row & (TL - 1)) : ((row - NLAT) & 255);
        const size_t orow = (size_t)(b * 8 + h) * TK + tk;
        const float* q = QRAW + (size_t)row * 1536 + h * 192;
        const float q0 = q[lane], q1 = q[64 + lane]; float q2 = q[128 + lane];
        const auto sw = __builtin_amdgcn_permlane32_swap(__float_as_uint(q2), __float_as_uint(q2), false, false);
        if (lat) { const int t = row & (TL - 1), i = lane & 31; const float c = rc[t * 32 + i], s = rs[t * 32 + i];
            const float x1 = __uint_as_float(sw[0]), x2 = __uint_as_float(sw[1]); q2 = lane < 32 ? (x1 * c - x2 * s) : (x1 * s + x2 * c); }
        bf16_t* qo = Q + orow * 192; qo[lane] = f2bf(q0); qo[64 + lane] = f2bf(q1); qo[128 + lane] = f2bf(q2);
        const float* kv = KVRAW + (size_t)row * 2048 + h * 256;
        bf16_t* ko = K + orow * 192; ko[lane] = f2bf(kv[lane]); ko[64 + lane] = f2bf(kv[64 + lane]); ko[128 + lane] = f2bf(KR[(size_t)row * 64 + lane]);
        bf16_t* vo = V + orow * 128; vo[lane] = f2bf(kv[128 + lane]); vo[64 + lane] = f2bf(kv[192 + lane]);
    }
}

__device__ void ph_attn_naive(const Params& p, char* lds) {
    const int tid = tidx(), qi = tid >> 2, part = tid & 3;
    const bf16_t* Q = (const bf16_t*)(p.ws + OFF_Q); const bf16_t* K = (const bf16_t*)(p.ws + OFF_K); const bf16_t* V = (const bf16_t*)(p.ws + OFF_V);
    bf16_t* O = (bf16_t*)(p.ws + OFF_O);
    bf16_t* Ks = (bf16_t*)lds;
    bf16_t* Vs = Ks + 32 * 192;
    const int nitems = 32 * 34;
    for (int it = bidx(); it < nitems; it += gdim()) {
        const int bh = it / 34, qb = it % 34; const int b = bh >> 3, h = bh & 7;
        const int nkeys = qb < 2 ? TC : TK;
        const int tq = qb * 128 + qi;
        const bf16_t* qp = Q + ((size_t)bh * TK + tq) * 192 + part * 48;
        float q[48];
#pragma unroll
        for (int i = 0; i < 48; ++i) q[i] = bf2f(qp[i]) * ATT_SCALE;
        float o[32];
#pragma unroll
        for (int i = 0; i < 32; ++i) o[i] = 0.f;
        float m = -1e30f, l = 0.f;
        for (int k0 = 0; k0 < nkeys; k0 += 32) {
            __syncthreads();
            {
                const bf16_t* kg = K + ((size_t)bh * TK + k0) * 192; const bf16_t* vg = V + ((size_t)bh * TK + k0) * 128;
                for (int c = tid; c < 768; c += NTHR) *(u32x4*)(Ks + c * 8) = *(const u32x4*)(kg + c * 8);
                *(u32x4*)(Vs + tid * 8) = *(const u32x4*)(vg + tid * 8);
            }
            __syncthreads();
#pragma unroll 1
            for (int kg = 0; kg < 32; kg += 8) {
                float s[8]; float tmax = -1e30f;
#pragma unroll
                for (int kk = 0; kk < 8; ++kk) {
                    const bf16_t* kr = Ks + (kg + kk) * 192 + part * 48; float acc = 0.f;
#pragma unroll
                    for (int i = 0; i < 48; ++i) acc += q[i] * bf2f(kr[i]);
                    acc += __shfl_xor(acc, 1); acc += __shfl_xor(acc, 2);
                    s[kk] = acc; tmax = fmaxf(tmax, acc);
                    asm volatile("" ::: "memory");
                }
                const float mn = fmaxf(m, tmax), alpha = expf(m - mn); m = mn; l *= alpha;
#pragma unroll
                for (int i = 0; i < 32; ++i) o[i] *= alpha;
#pragma unroll
                for (int kk = 0; kk < 8; ++kk) {
                    const float pw = expf(s[kk] - mn); l += pw;
                    const bf16_t* vr = Vs + (kg + kk) * 128 + part * 32;
#pragma unroll
                    for (int i = 0; i < 32; ++i) o[i] += pw * bf2f(vr[i]);
                    asm volatile("" ::: "memory");
                }
            }
        }
        const float rl = 1.f / l;
        const int row = qb < 2 ? (NLAT + b * TC + tq) : (b * TL + tq - TC);
        bf16_t* op = O + (size_t)row * D + h * 128 + part * 32;
#pragma unroll
        for (int i = 0; i < 32; ++i) op[i] = f2bf(o[i] * rl);
    }
}


namespace fa {
using s16x4  = __attribute__((ext_vector_type(4))) short;
using f32x16 = __attribute__((ext_vector_type(16))) float;
constexpr int DQK = 192, DV = 128, KVBLK = 64;
constexpr float THR = 8.f;
constexpr int SHM_V = KVBLK * DV * 2, SHM_K = KVBLK * DQK * 2;
constexpr int SHM_ATTN = 2 * SHM_V + 2 * SHM_K + 8 * 64 * 4;
#define KSWZ(row, colB) ((row) * 384 + ((colB) ^ ((((row) >> 1) & 7) << 4)))
#define SBAR() __builtin_amdgcn_sched_barrier(0)
__device__ __forceinline__ int crow(int r, int hi) { return (r & 3) + 8 * (r >> 2) + 4 * hi; }
__device__ __forceinline__ unsigned cvtpk(float lo, float hi) { unsigned r; asm volatile("v_cvt_pk_bf16_f32 %0, %1, %2" : "=v"(r) : "v"(lo), "v"(hi)); return r; }
__device__ __forceinline__ void partialSM(f32x16& p0, f32x16& p1, float& m_reg, float& mn, float& alpha) {
  constexpr float C = ATT_SCALE * 1.4426950408889634f;
  float pmax = p0[0];
#pragma unroll
  for (int r = 1; r < 16; ++r) pmax = fmaxf(pmax, p0[r]);
#pragma unroll
  for (int r = 0; r < 16; ++r) pmax = fmaxf(pmax, p1[r]);
  { auto rr = __builtin_amdgcn_permlane32_swap(__float_as_uint(pmax), __float_as_uint(pmax), false, false);
    pmax = fmaxf(__uint_as_float(rr[0]), __uint_as_float(rr[1])); }
  if (__builtin_expect(__all(pmax - m_reg <= THR / ATT_SCALE), 1)) { mn = m_reg; alpha = 1.f; }
  else { mn = fmaxf(m_reg, pmax); alpha = __builtin_amdgcn_exp2f((m_reg - mn) * C); m_reg = mn; }
  float mnC = -mn * C;
#pragma unroll
  for (int r = 0; r < 16; ++r) p0[r] = fmaf(p0[r], C, mnC);
#pragma unroll
  for (int r = 0; r < 16; ++r) p1[r] = fmaf(p1[r], C, mnC);
#pragma unroll
  for (int r = 0; r < 16; ++r) p0[r] = __builtin_amdgcn_exp2f(p0[r]);
}
__device__ __forceinline__ void finishSM(f32x16& p0, f32x16& p1, float alpha, float& l_reg, bf16x8& pa0, bf16x8& pa1, bf16x8& pa2, bf16x8& pa3) {
#pragma unroll
  for (int r = 0; r < 16; ++r) p1[r] = __builtin_amdgcn_exp2f(p1[r]);
  float ps = 0;
#pragma unroll
  for (int r = 0; r < 16; ++r) ps += p0[r];
#pragma unroll
  for (int r = 0; r < 16; ++r) ps += p1[r];
  { auto rr = __builtin_amdgcn_permlane32_swap(__float_as_uint(ps), __float_as_uint(ps), false, false);
    ps = __uint_as_float(rr[0]) + __uint_as_float(rr[1]); }
  l_reg = l_reg * alpha + ps;
#define PK4(P, BASE, OUT) do { unsigned a0 = cvtpk(P[BASE + 0], P[BASE + 1]), a1 = cvtpk(P[BASE + 2], P[BASE + 3]);   \
    unsigned b0 = cvtpk(P[BASE + 4], P[BASE + 5]), b1 = cvtpk(P[BASE + 6], P[BASE + 7]);                              \
    auto r0 = __builtin_amdgcn_permlane32_swap(a0, b0, false, false); auto r1 = __builtin_amdgcn_permlane32_swap(a1, b1, false, false); \
    u32x4 w = {r0[0], r1[0], r0[1], r1[1]}; OUT = *reinterpret_cast<bf16x8*>(&w); } while (0)
  PK4(p0, 0, pa0); PK4(p0, 8, pa1); PK4(p1, 0, pa2); PK4(p1, 8, pa3);
#undef PK4
}
__device__ __forceinline__ void qkt(f32x16& p0, f32x16& p1, const char* Ks, const bf16x8* qr, int r32, int hi) {
  p0 = f32x16{}; p1 = f32x16{};
  const int swz = ((r32 >> 1) & 7) << 4;
  const char* b4[4];
#pragma unroll
  for (int dr = 0; dr < 4; ++dr) b4[dr] = Ks + r32 * 384 + ((dr * 32 + hi * 16) ^ swz);
#pragma unroll
  for (int d0 = 0; d0 < 12; ++d0) {
    bf16x8 b0 = *reinterpret_cast<const bf16x8*>(b4[d0 & 3] + (d0 >> 2) * 128);
    bf16x8 b1 = *reinterpret_cast<const bf16x8*>(b4[d0 & 3] + (d0 >> 2) * 128 + 32 * 384);
    p0 = __builtin_amdgcn_mfma_f32_32x32x16_bf16(b0, qr[d0], p0, 0, 0, 0);
    p1 = __builtin_amdgcn_mfma_f32_32x32x16_bf16(b1, qr[d0], p1, 0, 0, 0); }
}
__device__ __forceinline__ int v_st(int k, int c) { const int kk = (k & ~0xC) | ((k & 4) << 1) | ((k & 8) >> 1); return ((kk >> 3) * 4 + (c >> 5)) * 512 + ((kk & 7) * 32 + (c & 31)) * 2; }
__device__ __forceinline__ int v_rd_base(int lane) { return ((lane & 3) << 3) | (((lane >> 2) & 3) << 6) | (((lane >> 4) & 1) << 5) | (((lane >> 5) & 1) << 8); }
constexpr int v_rd_off(int d0, int ks, int half) { return d0 * 512 + ks * 4096 + half * 2048; }
template <int OFF> __device__ __forceinline__ s16x4 tr_read(int vb) {
  s16x4 r; asm volatile("ds_read_b64_tr_b16 %0, %1 offset:%2" : "=&v"(r) : "v"(vb), "i"(OFF) : "memory"); return r;
}
template <int D0> __device__ __forceinline__ void pv_one(f32x16& od, int vb, bf16x8 pa0, bf16x8 pa1, bf16x8 pa2, bf16x8 pa3) {
  const s16x4 l0 = tr_read<v_rd_off(D0, 0, 0)>(vb), h0 = tr_read<v_rd_off(D0, 0, 1)>(vb), l1 = tr_read<v_rd_off(D0, 1, 0)>(vb), h1 = tr_read<v_rd_off(D0, 1, 1)>(vb);
  const s16x4 l2 = tr_read<v_rd_off(D0, 2, 0)>(vb), h2 = tr_read<v_rd_off(D0, 2, 1)>(vb), l3 = tr_read<v_rd_off(D0, 3, 0)>(vb), h3 = tr_read<v_rd_off(D0, 3, 1)>(vb);
  asm volatile("s_waitcnt lgkmcnt(0)" ::: "memory"); SBAR();
#define PK(L, H) (bf16x8){L[0], L[1], L[2], L[3], H[0], H[1], H[2], H[3]}
  od = __builtin_amdgcn_mfma_f32_32x32x16_bf16(pa0, PK(l0, h0), od, 0, 0, 0);
  od = __builtin_amdgcn_mfma_f32_32x32x16_bf16(pa1, PK(l1, h1), od, 0, 0, 0);
  od = __builtin_amdgcn_mfma_f32_32x32x16_bf16(pa2, PK(l2, h2), od, 0, 0, 0);
  od = __builtin_amdgcn_mfma_f32_32x32x16_bf16(pa3, PK(l3, h3), od, 0, 0, 0);
#undef PK
}
__device__ __forceinline__ void pv_d0(f32x16* o, int vb, bf16x8 pa0, bf16x8 pa1, bf16x8 pa2, bf16x8 pa3) {
  pv_one<0>(o[0], vb, pa0, pa1, pa2, pa3); pv_one<1>(o[1], vb, pa0, pa1, pa2, pa3); pv_one<2>(o[2], vb, pa0, pa1, pa2, pa3); pv_one<3>(o[3], vb, pa0, pa1, pa2, pa3);
}
__device__ __forceinline__ void attn_body(const int wv_, const bf16_t* __restrict__ Qb, const bf16_t* __restrict__ Kh, const bf16_t* __restrict__ Vh, bf16_t* __restrict__ Ob, int ldo, int seq, char* lds, const float* __restrict__ ropecs  ) {
  const int tid = tidx_w(wv_), wid = tid >> 6, lane = tid & 63, r32 = lane & 31, hi = lane >> 5;
  char* V_lds = lds; char* K_lds = lds + 2 * SHM_V;
  float* ws = (float*)(lds + 2 * SHM_V + 2 * SHM_K) + wid * 64; float* li_l = ws; float* al_l = ws + 32;
  float m_reg = -1e30f, l_reg = 0; f32x16 o[4] = {}; bf16x8 qr[12];
  const bf16_t* Qw = Qb + (long)(wid * 32 + r32) * DQK + hi * 8;
#pragma unroll
  for (int d0 = 0; d0 < 12; ++d0) qr[d0] = *reinterpret_cast<const bf16x8*>(Qw + d0 * 16);
  if (ropecs) {
    const float* cs = ropecs + (size_t)(wid * 32 + r32) * 64;
#pragma unroll
    for (int d0 = 8; d0 < 12; ++d0) { const int i0 = (d0 - 8) * 8 + hi * 4; const f32x4 c0 = *(const f32x4*)(cs + i0 * 2), c1 = *(const f32x4*)(cs + i0 * 2 + 4);
      u32x4 w = *reinterpret_cast<u32x4*>(&qr[d0]); const float cc[4] = {c0[0], c0[2], c1[0], c1[2]}, ss[4] = {c0[1], c0[3], c1[1], c1[3]};
#pragma unroll
      for (int m = 0; m < 4; ++m) { const float x1 = __uint_as_float(w[m] << 16), x2 = __uint_as_float(w[m] & 0xffff0000u); w[m] = cvtpk(x1 * cc[m] - x2 * ss[m], x1 * ss[m] + x2 * cc[m]); }
      qr[d0] = *reinterpret_cast<bf16x8*>(&w); }
  }
  const int sr = tid >> 4, sc = (tid & 15) * 8, vst0 = v_st(sr, sc), vst1 = v_st(32 + sr, sc);
  int kst[3];
#pragma unroll
  for (int i = 0; i < 3; ++i) { const int c = tid + 512 * i, row = c / 24, cc = c % 24; kst[i] = KSWZ(row, cc * 16); }
  const int vb0 = (int)(uintptr_t)V_lds + v_rd_base(lane);
  struct { bf16x8 vs0, vs1, ks0, ks1, ks2; } sr_[1];
#define SLOAD(i, k0) do { const bf16_t* vt = Vh + (long)(k0) * DV; const bf16_t* kt = Kh + (long)(k0) * DQK; \
    sr_[i].vs0 = *reinterpret_cast<const bf16x8*>(vt + (sr) * DV + sc); sr_[i].vs1 = *reinterpret_cast<const bf16x8*>(vt + (32 + sr) * DV + sc); \
    sr_[i].ks0 = *reinterpret_cast<const bf16x8*>(kt + tid * 8); sr_[i].ks1 = *reinterpret_cast<const bf16x8*>(kt + (tid + 512) * 8); sr_[i].ks2 = *reinterpret_cast<const bf16x8*>(kt + (tid + 1024) * 8); } while (0)
#define SWRITE(b, i) do { *(bf16x8*)(V_lds + (b) * SHM_V + vst0) = sr_[i].vs0; *(bf16x8*)(V_lds + (b) * SHM_V + vst1) = sr_[i].vs1; \
    *(bf16x8*)(K_lds + (b) * SHM_K + kst[0]) = sr_[i].ks0; *(bf16x8*)(K_lds + (b) * SHM_K + kst[1]) = sr_[i].ks1; *(bf16x8*)(K_lds + (b) * SHM_K + kst[2]) = sr_[i].ks2; } while (0)
#define SWAIT() asm volatile("s_waitcnt vmcnt(5)" ::: "memory")
#define RESC(a) do { if (__any((a) < 1.f)) { if (hi == 0) al_l[r32] = (a); asm volatile("s_waitcnt lgkmcnt(0)" ::: "memory"); \
    _Pragma("unroll") for (int d = 0; d < 4; ++d) _Pragma("unroll") for (int r = 0; r < 16; ++r) o[d][r] *= al_l[crow(r, hi)]; } } while (0)
  f32x16 pA0, pA1; float mnA, alA; bf16x8 pa0, pa1, pa2, pa3; const int NT = seq / KVBLK;
  SLOAD(0, 0); SWRITE(0, 0);
  SLOAD(0, KVBLK);
  __syncthreads();
  for (int j = 0; j < NT; j += 2) {
    SBAR(); qkt(pA0, pA1, K_lds, qr, r32, hi);
    partialSM(pA0, pA1, m_reg, mnA, alA); RESC(alA);
    finishSM(pA0, pA1, alA, l_reg, pa0, pa1, pa2, pa3); SBAR();
    SWRITE(1, 0);
    if (j + 2 < NT) SLOAD(0, (j + 2) * KVBLK);
    SBAR();
    pv_d0(o, vb0, pa0, pa1, pa2, pa3);
    __syncthreads();
    SBAR(); qkt(pA0, pA1, K_lds + SHM_K, qr, r32, hi);
    partialSM(pA0, pA1, m_reg, mnA, alA); RESC(alA);
    finishSM(pA0, pA1, alA, l_reg, pa0, pa1, pa2, pa3); SBAR();
    if (j + 2 < NT) { SWRITE(0, 0); if (j + 3 < NT) SLOAD(0, (j + 3) * KVBLK); }
    SBAR();
    pv_d0(o, vb0 + SHM_V, pa0, pa1, pa2, pa3);
    __syncthreads();
  }
  if (hi == 0) li_l[r32] = l_reg; asm volatile("s_waitcnt lgkmcnt(0)" ::: "memory");
  float rli[16];
#pragma unroll
  for (int r = 0; r < 16; ++r) rli[r] = __builtin_amdgcn_rcpf(li_l[crow(r, hi)]);
  bf16_t* Ow = Ob + (long)(wid * 32) * ldo;
#pragma unroll
  for (int r = 0; r < 16; ++r) { int orow = crow(r, hi);
#pragma unroll
    for (int d0 = 0; d0 < 4; ++d0) Ow[(long)orow * ldo + d0 * 32 + r32] = f2bf(o[d0][r] * rli[r]); }
  __syncthreads();
#undef SLOAD
#undef SWRITE
#undef SWAIT
#undef RESC
}
#undef KSWZ
}

__device__ void ph_attn(const Params& p, char* lds) {
    const bf16_t* Q = (const bf16_t*)(p.ws + OFF_Q); const bf16_t* K = (const bf16_t*)(p.ws + OFF_K); const bf16_t* V = (const bf16_t*)(p.ws + OFF_V);
    bf16_t* O = (bf16_t*)(p.ws + OFF_O);
    const int G = gdim();
    for (int i = 0;; ++i) {
        const int L = i * G + bidx(); if (L >= 544) break;
        int bh, qb;
        if (L < 512) { const int w = g8::xcd_remap(L, 512); bh = w >> 4; qb = 1 + (w & 15); } else { bh = L - 512; qb = 0; }
        const int b = bh >> 3, h = bh & 7;
        const int seq = qb == 0 ? TC : TK;
        const int row0 = qb == 0 ? NLAT + b * TC : b * TL + (qb - 1) * 256;
        fa::attn_body(p.wv, Q + ((size_t)bh * TK + qb * 256) * 192, K + (size_t)bh * TK * 192, V + (size_t)bh * TK * 128, O + (size_t)row0 * D + h * 128, D, seq, lds,
                      qb == 0 ? nullptr : (const float*)(p.ws + OFF_ROPE_C) + (size_t)(qb - 1) * 256 * 64);
    }
}

__device__ void ph_norm2_router(const Params& p, int layer, char* lds, int nrows) {
    const int tid = tidx(), wid = tid >> 6, lane = tid & 63;
    float* rt = (float*)lds;
    const float* rg = p.moe_router + (size_t)layer * D * NE;
    for (int i = tid; i < D * NE / 4; i += NTHR) { const int d = i >> 2, eq = i & 3; ((float4*)rt)[(((d >> 8) * 4 + (d & 3)) * 4 + eq) * 64 + ((d & 255) >> 2)] = ((const float4*)rg)[i]; }
    __syncthreads();
    const float* X = (const float*)(p.ws + OFF_X); bf16_t* BN = (bf16_t*)(p.ws + OFF_H); float* AFF = (float*)(p.ws + OFF_AFF);
    const float* g = p.norm2_g + layer * D;
    int row = bidx() * 8 + wid;
    float4 nv[4];
    if (row < nrows) {
#pragma unroll
        for (int i = 0; i < 4; ++i) nv[i] = ((const float4*)(X + (size_t)row * D))[lane + i * 64]; }
    for (; row < nrows; row += gdim() * 8) {
        const int s = row_stream(row);
        const float* sh = modp(p, layer, s, 3); const float* sc = modp(p, layer, s, 4);
        float4 v[4]; float ss = 0;
#pragma unroll
        for (int i = 0; i < 4; ++i) { v[i] = nv[i]; ss += v[i].x * v[i].x + v[i].y * v[i].y + v[i].z * v[i].z + v[i].w * v[i].w; }
        { const int nrow = row + gdim() * 8;
          if (nrow < nrows) {
#pragma unroll
              for (int i = 0; i < 4; ++i) nv[i] = ((const float4*)(X + (size_t)nrow * D))[lane + i * 64]; } }
        ss = wave_sum(ss); const float rs = rsqrtf(ss * (1.f / D) + RMS_EPS);
        float lg[16];
#pragma unroll
        for (int e = 0; e < 16; ++e) lg[e] = 0.f;
#pragma unroll
        for (int i = 0; i < 4; ++i) {
            const int d = (lane + i * 64) * 4;
            const float4 gg = *(const float4*)(g + d), a = *(const float4*)(sc + d), b = *(const float4*)(sh + d);
            float o[4]; o[0] = v[i].x * rs * gg.x * (1.f + a.x) + b.x; o[1] = v[i].y * rs * gg.y * (1.f + a.y) + b.y; o[2] = v[i].z * rs * gg.z * (1.f + a.z) + b.z; o[3] = v[i].w * rs * gg.w * (1.f + a.w) + b.w;
            uint2 w; w.x = pk2(o[0], o[1]); w.y = pk2(o[2], o[3]); *(uint2*)(BN + (size_t)row * D + d) = w;
#pragma unroll
            for (int jj = 0; jj < 4; ++jj) {
#pragma unroll
                for (int eq = 0; eq < 4; ++eq) { const float4 r4 = ((const float4*)rt)[((i * 4 + jj) * 4 + eq) * 64 + lane];
                    lg[4 * eq] += o[jj] * r4.x; lg[4 * eq + 1] += o[jj] * r4.y; lg[4 * eq + 2] += o[jj] * r4.z; lg[4 * eq + 3] += o[jj] * r4.w; } }
            asm volatile("" ::: "memory");
        }
        float mx = -1e30f;
#pragma unroll
        for (int e = 0; e < 16; ++e) { lg[e] = wave_sum(lg[e]); mx = fmaxf(mx, lg[e]); }
        float sum = 0;
#pragma unroll
        for (int e = 0; e < 16; ++e) { lg[e] = expf(lg[e] - mx); sum += lg[e]; }
        const float inv = 1.f / sum;
        if (lane < 16) { float val = 0;
#pragma unroll
            for (int e = 0; e < 16; ++e) val = (lane == e) ? lg[e] : val;
            AFF[(size_t)row * 16 + lane] = val * inv; }
    }
}

__device__ void ph_select(const Params& p, char* lds, int ngroups) {
    const int tid = tidx(), wid = tid >> 6, lane = tid & 63;
    unsigned* hist = (unsigned*)lds;
    unsigned* ctl = hist + 256;
    unsigned* wsum = ctl + 8;
    int* rowl = (int*)(wsum + 16);
    const float* AFF = (const float*)(p.ws + OFF_AFF);
    int* ROWIDX = (int*)(p.ws + OFF_ROWIDX); float* GATE = (float*)(p.ws + OFF_GATE); int* SLOT = (int*)(p.ws + OFF_SLOT);
    for (int gidx = bidx(); gidx < ngroups; gidx += gdim()) {
        const bool lat = gidx < 64; const int b = (gidx & 63) >> 4, e = gidx & 15;
        const int n = lat ? TL : TC, cap = lat ? CAPL : CAPC;
        const int row0 = lat ? b * TL : NLAT + b * TC, slot0 = lat ? b * CAPL : NB * CAPL + b * CAPC;
        unsigned key[8];
#pragma unroll
        for (int i = 0; i < 8; ++i) { const int idx = tid * 8 + i; key[i] = idx < n ? __float_as_uint(AFF[(size_t)(row0 + idx) * 16 + e]) : 0u; }
        unsigned prefix = 0u, remaining = (unsigned)cap;
#pragma unroll
        for (int pass = 0; pass < 4; ++pass) {
            const int sh = 24 - 8 * pass;
            __syncthreads();
            if (tid < 256) hist[tid] = 0u;
            __syncthreads();
#pragma unroll
            for (int i = 0; i < 8; ++i) { const int idx = tid * 8 + i;
                const bool cand = idx < n && (pass == 0 || (key[i] >> (sh + 8)) == prefix);
                if (cand) atomicAdd(&hist[(key[i] >> sh) & 255u], 1u); }
            __syncthreads();
            if (tid < 256) { unsigned gt = 0; for (int jj = tid + 1; jj < 256; ++jj) gt += hist[jj];
                const unsigned mine = hist[tid];
                if (gt < remaining && remaining <= gt + mine) { ctl[0] = (unsigned)tid; ctl[1] = remaining - gt; } }
            __syncthreads();
            prefix = (prefix << 8) | ctl[0]; remaining = ctl[1];
        }
        const unsigned T = prefix, m = remaining;
        unsigned cgt = 0, ceq = 0;
#pragma unroll
        for (int i = 0; i < 8; ++i) { const int idx = tid * 8 + i; if (idx < n) { cgt += key[i] > T ? 1u : 0u; ceq += key[i] == T ? 1u : 0u; } }
        auto block_excl = [&](unsigned v) -> unsigned {
            unsigned inc = v;
#pragma unroll
            for (int o = 1; o < 64; o <<= 1) { const unsigned t = (unsigned)__builtin_amdgcn_ds_bpermute((lane - o) << 2, (int)inc); if (lane >= o) inc += t; }
            __syncthreads();
            if (lane == 63) wsum[wid] = inc;
            __syncthreads();
            unsigned base = 0;
#pragma unroll
            for (int w = 0; w < 8; ++w) base += (w < wid) ? wsum[w] : 0u;
            return base + inc - v; };
        unsigned eqbase = block_excl(ceq);
        unsigned nsel = 0; bool sel[8];
#pragma unroll
        for (int i = 0; i < 8; ++i) { const int idx = tid * 8 + i; bool s_ = false;
            if (idx < n) { if (key[i] > T) s_ = true; else if (key[i] == T) { s_ = eqbase < m; ++eqbase; } }
            sel[i] = s_; nsel += s_ ? 1u : 0u; }
        unsigned sbase = block_excl(nsel);
#pragma unroll
        for (int i = 0; i < 8; ++i) { const int idx = tid * 8 + i;
            if (idx < n) {
                if (sel[i]) { const int sl = slot0 + (int)sbase; rowl[sbase] = row0 + idx; ++sbase; ROWIDX[e * ESLOTS + sl] = row0 + idx; GATE[e * EPAD + sl] = __uint_as_float(key[i]); SLOT[(size_t)(row0 + idx) * 16 + e] = sl; }
                else SLOT[(size_t)(row0 + idx) * 16 + e] = -1; } }
        __syncthreads();
        { const bf16_t* BN = (const bf16_t*)(p.ws + OFF_H); bf16_t* XE = (bf16_t*)(p.ws + OFF_XE);
          for (int r = wid; r < cap; r += 32) {
              u32x4 t_[4][2];
#pragma unroll
              for (int u = 0; u < 4; ++u) { const u32x4* src = (const u32x4*)(BN + (size_t)rowl[r + 8 * u] * D); t_[u][0] = src[lane]; t_[u][1] = src[lane + 64]; }
#pragma unroll
              for (int u = 0; u < 4; ++u) { u32x4* dst = (u32x4*)(XE + ((size_t)e * EPAD + slot0 + r + 8 * u) * D); dst[lane] = t_[u][0]; dst[lane + 64] = t_[u][1]; } } }
    }
}

__device__ void ph_gather(const Params& p, int nslots) {
    const int wid = tidx() >> 6, lane = tidx() & 63;
    const int* ROWIDX = (const int*)(p.ws + OFF_ROWIDX); const bf16_t* BN = (const bf16_t*)(p.ws + OFF_H); bf16_t* XE = (bf16_t*)(p.ws + OFF_XE);
    for (int it = bidx() * 8 + wid; it < NE * ESLOTS; it += gdim() * 8) {
        const int e = it / ESLOTS, sl = it % ESLOTS; if (sl >= nslots) continue; const int row = ROWIDX[it];
        const u32x4* src = (const u32x4*)(BN + (size_t)row * D); u32x4* dst = (u32x4*)(XE + ((size_t)e * EPAD + sl) * D);
        dst[lane] = src[lane]; dst[lane + 64] = src[lane + 64];
    }
}

__device__ void ph_combine(const Params& p, int layer, int nrows) {
    const int wid = tidx() >> 6, lane = tidx() & 63;
    const int* SLOT = (const int*)(p.ws + OFF_SLOT); const bf16_t* YE = (const bf16_t*)(p.ws + OFF_YE); float* X = (float*)(p.ws + OFF_X);
    int row = bidx() * 8 + wid;
    int sl = (row < nrows && lane < 16) ? SLOT[(size_t)row * 16 + lane] : -1;
    while (row < nrows) {
        const int nrow = row + gdim() * 8;
        const int sln = (nrow < nrows && lane < 16) ? SLOT[(size_t)nrow * 16 + lane] : -1;
        const float* gt = modp(p, layer, row_stream(row), 5);
        float* xr = X + (size_t)row * D + lane * 8;
        f32x4 xv[4];
#pragma unroll
        for (int i = 0; i < 2; ++i) { xv[2 * i] = *(const f32x4*)(xr + 512 * i); xv[2 * i + 1] = *(const f32x4*)(xr + 512 * i + 4); }
        unsigned long long m = __ballot(sl >= 0);
        float acc[16];
#pragma unroll
        for (int i = 0; i < 16; ++i) acc[i] = 0.f;
        while (m) {
            const int e0 = __builtin_ctzll(m); m &= m - 1; const bool two = m != 0; const int e1 = two ? __builtin_ctzll(m) : e0; if (two) m &= m - 1;
            const int s0 = __builtin_amdgcn_readlane(sl, e0), s1 = __builtin_amdgcn_readlane(sl, e1);
            const bf16_t* y0 = YE + ((size_t)e0 * EPAD + s0) * D + lane * 8; const bf16_t* y1 = YE + ((size_t)e1 * EPAD + s1) * D + lane * 8;
            const u32x4 a0 = *(const u32x4*)y0, a1 = *(const u32x4*)(y0 + 512), b0 = *(const u32x4*)y1, b1 = *(const u32x4*)(y1 + 512);
            const float f1 = two ? 1.f : 0.f;
#pragma unroll
            for (int i = 0; i < 4; ++i) { acc[2 * i] += __uint_as_float(a0[i] << 16) + f1 * __uint_as_float(b0[i] << 16); acc[2 * i + 1] += __uint_as_float(a0[i] & 0xffff0000u) + f1 * __uint_as_float(b0[i] & 0xffff0000u);
                acc[8 + 2 * i] += __uint_as_float(a1[i] << 16) + f1 * __uint_as_float(b1[i] << 16); acc[8 + 2 * i + 1] += __uint_as_float(a1[i] & 0xffff0000u) + f1 * __uint_as_float(b1[i] & 0xffff0000u); }
        }
#pragma unroll
        for (int i = 0; i < 2; ++i) { const f32x4 g0 = *(const f32x4*)(gt + lane * 8 + 512 * i), g1 = *(const f32x4*)(gt + lane * 8 + 512 * i + 4);
            f32x4 o0 = xv[2 * i], o1 = xv[2 * i + 1];
#pragma unroll
            for (int e = 0; e < 4; ++e) { o0[e] += g0[e] * acc[8 * i + e]; o1[e] += g1[e] * acc[8 * i + 4 + e]; }
            *(f32x4*)(xr + 512 * i) = o0; *(f32x4*)(xr + 512 * i + 4) = o1; }
        row = nrow; sl = sln;
    }
}

template <bool FINAL>
__device__ void ph_comb_norm(const Params& p, int lprev, int layer, int nrows) {
    const int wid = tidx() >> 6, lane = tidx() & 63;
    const int* SLOT = (const int*)(p.ws + OFF_SLOT); const bf16_t* YE = (const bf16_t*)(p.ws + OFF_YE); float* X = (float*)(p.ws + OFF_X);
    bf16_t* H = (bf16_t*)(p.ws + OFF_H);
    const float* g = FINAL ? p.final_g : p.norm1_g + layer * D;
    int row = bidx() * 8 + wid;
    int sl = (row < nrows && lane < 16) ? SLOT[(size_t)row * 16 + lane] : -1;
    while (row < nrows) {
        const int nrow = row + gdim() * 8;
        const int sln = (nrow < nrows && lane < 16) ? SLOT[(size_t)nrow * 16 + lane] : -1;
        const int strm = row_stream(row);
        const float* gt = modp(p, lprev, strm, 5);
        float* xr = X + (size_t)row * D + lane * 8;
        f32x4 xv[4];
#pragma unroll
        for (int i = 0; i < 2; ++i) { xv[2 * i] = *(const f32x4*)(xr + 512 * i); xv[2 * i + 1] = *(const f32x4*)(xr + 512 * i + 4); }
        unsigned long long m = __ballot(sl >= 0);
        float acc[16];
#pragma unroll
        for (int i = 0; i < 16; ++i) acc[i] = 0.f;
        while (m) {
            const int e0 = __builtin_ctzll(m); m &= m - 1; const bool two = m != 0; const int e1 = two ? __builtin_ctzll(m) : e0; if (two) m &= m - 1;
            const int s0 = __builtin_amdgcn_readlane(sl, e0), s1 = __builtin_amdgcn_readlane(sl, e1);
            const bf16_t* y0 = YE + ((size_t)e0 * EPAD + s0) * D + lane * 8; const bf16_t* y1 = YE + ((size_t)e1 * EPAD + s1) * D + lane * 8;
            const u32x4 a0 = *(const u32x4*)y0, a1 = *(const u32x4*)(y0 + 512), b0 = *(const u32x4*)y1, b1 = *(const u32x4*)(y1 + 512);
            const float f1 = two ? 1.f : 0.f;
#pragma unroll
            for (int i = 0; i < 4; ++i) { acc[2 * i] += __uint_as_float(a0[i] << 16) + f1 * __uint_as_float(b0[i] << 16); acc[2 * i + 1] += __uint_as_float(a0[i] & 0xffff0000u) + f1 * __uint_as_float(b0[i] & 0xffff0000u);
                acc[8 + 2 * i] += __uint_as_float(a1[i] << 16) + f1 * __uint_as_float(b1[i] << 16); acc[8 + 2 * i + 1] += __uint_as_float(a1[i] & 0xffff0000u) + f1 * __uint_as_float(b1[i] & 0xffff0000u); }
        }
        float ss = 0.f;
#pragma unroll
        for (int i = 0; i < 2; ++i) { const f32x4 g0 = *(const f32x4*)(gt + lane * 8 + 512 * i), g1 = *(const f32x4*)(gt + lane * 8 + 512 * i + 4);
#pragma unroll
            for (int e = 0; e < 4; ++e) { xv[2 * i][e] += g0[e] * acc[8 * i + e]; xv[2 * i + 1][e] += g1[e] * acc[8 * i + 4 + e]; ss += xv[2 * i][e] * xv[2 * i][e] + xv[2 * i + 1][e] * xv[2 * i + 1][e]; }
            if (!FINAL) { *(f32x4*)(xr + 512 * i) = xv[2 * i]; *(f32x4*)(xr + 512 * i + 4) = xv[2 * i + 1]; } }
        ss = wave_sum(ss); const float rs = rsqrtf(ss * (1.f / D) + RMS_EPS);
        const float* sh = FINAL ? nullptr : modp(p, layer, strm, 0); const float* sc = FINAL ? nullptr : modp(p, layer, strm, 1);
#pragma unroll
        for (int i = 0; i < 2; ++i)
#pragma unroll
            for (int hh = 0; hh < 2; ++hh) { const int d = lane * 8 + 512 * i + 4 * hh; const f32x4 gg = *(const f32x4*)(g + d); f32x4 o = xv[2 * i + hh] * rs * gg;
                if (FINAL) *(f32x4*)(p.out + (size_t)row * D + d) = o;
                else { o = o * (1.f + *(const f32x4*)(sc + d)) + *(const f32x4*)(sh + d); stbf4(H + (size_t)row * D + d, o); } }
        row = nrow; sl = sln;
    }
}

__device__ void ph_rw_normxs(const Params& p, int layer, int j) {
    const int wid = tidx() >> 6, lane = tidx() & 63;
    const float* X = (const float*)(p.ws + OFF_X); bf16_t* XS = (bf16_t*)(p.ws + OFF_XS);
    const float* mu = p.rw_mu + (size_t)j * 6 * D; const float* g = p.norm1_g + layer * D;
    float4 fc[4], fp[4], fn[4];
#define XS_LOAD(R) do { const bool lat_ = (R) < NLAT; const int t_ = lat_ ? ((R) & (TL - 1)) : (((R) - NLAT) & (TC - 1)); const int len_ = lat_ ? TL : TC; \
        _Pragma("unroll") for (int i = 0; i < 4; ++i) { fc[i] = ((const float4*)(X + (size_t)(R) * D))[lane + i * 64]; \
            fp[i] = t_ > 0 ? ((const float4*)(X + (size_t)((R) - 1) * D))[lane + i * 64] : make_float4(0, 0, 0, 0); \
            fn[i] = t_ < len_ - 1 ? ((const float4*)(X + (size_t)((R) + 1) * D))[lane + i * 64] : make_float4(0, 0, 0, 0); } } while (0)
    int row = bidx() * 8 + wid;
    if (row < NROW) XS_LOAD(row);
    for (; row < NROW; row += gdim() * 8) {
        const int s_ = row_stream(row);
        const float* sh = modp(p, layer, s_, 0); const float* sc = modp(p, layer, s_, 1);
        const bool lat = row < NLAT; const int t = lat ? (row & (TL - 1)) : ((row - NLAT) & (TC - 1)); const int len = lat ? TL : TC;
        const bool hp = t > 0, hn = t < len - 1;
        float4 xc[4], xp[4], xn[4]; float sc_ = 0, sp_ = 0, sn_ = 0;
#pragma unroll
        for (int i = 0; i < 4; ++i) { xc[i] = fc[i]; xp[i] = fp[i]; xn[i] = fn[i]; }
        { const int nrow = row + gdim() * 8; if (nrow < NROW) XS_LOAD(nrow); }
#pragma unroll
        for (int i = 0; i < 4; ++i) {
            sc_ += xc[i].x * xc[i].x + xc[i].y * xc[i].y + xc[i].z * xc[i].z + xc[i].w * xc[i].w;
            sp_ += xp[i].x * xp[i].x + xp[i].y * xp[i].y + xp[i].z * xp[i].z + xp[i].w * xp[i].w;
            sn_ += xn[i].x * xn[i].x + xn[i].y * xn[i].y + xn[i].z * xn[i].z + xn[i].w * xn[i].w; }
        sc_ = wave_sum(sc_); sp_ = wave_sum(sp_); sn_ = wave_sum(sn_);
        const float rc = rsqrtf(sc_ * (1.f / D) + RMS_EPS), rp = hp ? rsqrtf(sp_ * (1.f / D) + RMS_EPS) : 0.f, rn = hn ? rsqrtf(sn_ * (1.f / D) + RMS_EPS) : 0.f;
#pragma unroll
        for (int i = 0; i < 4; ++i) {
            const int d = (lane + i * 64) * 4;
            const float4 gg = *(const float4*)(g + d), a = *(const float4*)(sc + d), bsh = *(const float4*)(sh + d);
            float h[4], xx[4];
            const float gm[4] = {gg.x * (1.f + a.x), gg.y * (1.f + a.y), gg.z * (1.f + a.z), gg.w * (1.f + a.w)}; const float bb[4] = {bsh.x, bsh.y, bsh.z, bsh.w};
            const float c4[4] = {xc[i].x, xc[i].y, xc[i].z, xc[i].w}, p4[4] = {xp[i].x, xp[i].y, xp[i].z, xp[i].w}, n4[4] = {xn[i].x, xn[i].y, xn[i].z, xn[i].w};
#pragma unroll
            for (int e = 0; e < 4; ++e) { h[e] = c4[e] * rc * gm[e] + bb[e];
                const float hpv = hp ? p4[e] * rp * gm[e] + bb[e] : 0.f, hnv = hn ? n4[e] * rn * gm[e] + bb[e] : 0.f;
                xx[e] = 0.5f * (hpv + hnv) - h[e]; }
#pragma unroll
            for (int m = 0; m < 6; ++m) { const float4 u = *(const float4*)(mu + m * D + d);
                uint2 w; w.x = pk2(h[0] + xx[0] * u.x, h[1] + xx[1] * u.y); w.y = pk2(h[2] + xx[2] * u.z, h[3] + xx[3] * u.w);
                *(uint2*)(XS + ((size_t)m * NROW + row) * D + d) = w; }
        }
    }
#undef XS_LOAD
}

__device__ __forceinline__ int scan_row(int i, int b, int z) {
    return i < TC ? NLAT + b * TC + (z ? TC - 1 - i : i) : b * TL + (z ? TL - 1 - (i - TC) : i - TC);
}
__device__ __forceinline__ float dpp_sum8(float x) {
    x += __builtin_bit_cast(float, __builtin_amdgcn_update_dpp(0, __builtin_bit_cast(int, x), 0xB1, 0xF, 0xF, true));
    x += __builtin_bit_cast(float, __builtin_amdgcn_update_dpp(0, __builtin_bit_cast(int, x), 0x4E, 0xF, 0xF, true));
    x += __builtin_bit_cast(float, __builtin_amdgcn_update_dpp(0, __builtin_bit_cast(int, x), 0x141, 0xF, 0xF, true));
    return x;
}
__device__ void ph_rw_scan(const Params& p, int j, char* lds) {
    const int tid = tidx(), wid = __builtin_amdgcn_readfirstlane(tid >> 6), lane = tid & 63;
    const size_t PL = (size_t)NROW * D;
    const float* RKV = (const float*)(p.ws + OFF_RKV); float* Y = (float*)(p.ws + OFF_Y);
    constexpr int CH = 32, BUFB = 5 * CH * 256 + CH * 128 + CH * 16, YB = CH * 32 * 4, NCH = (TC + TL) / CH;
    const bool loader = wid >= 4; const int lw = wid - 4;
    for (int it = bidx(); it < 256; it += gdim()) {
        const int vh = it & 1, z = (it >> 1) & 1, h = (it >> 2) & 15, b = it >> 6;
        const char* pl0 = (const char*)((const float*)(p.ws + OFF_W) + z * PL); const char* pl1 = (const char*)(RKV + PL);
        const char* pl2 = (const char*)((const float*)(p.ws + OFF_AV) + z * PL); const char* pl3 = (const char*)RKV;
        const char* vpl = (const char*)(RKV + 2 * PL);
        float* yout = Y + z * PL;
        __builtin_amdgcn_s_barrier();
        if (loader) {
            const int pq = lane & 15;
            const f32x4 kkv = *(const f32x4*)(p.rw_k_k + j * D + h * 64 + pq * 4), kav = *(const f32x4*)(p.rw_k_a + j * D + h * 64 + pq * 4);
            auto issue = [&](int c) {
                char* buf = lds + (c % 3) * BUFB;
#pragma unroll
                for (int q = 0; q < 8; ++q) { const int pi = q >> 1, tg = lw * 2 + (q & 1); const int row = scan_row(c * CH + tg * 4 + (lane >> 4), b, z);
                    const char* base = pi == 0 ? pl0 : pi == 1 ? pl1 : pi == 2 ? pl2 : pl3;
                    __builtin_amdgcn_global_load_lds((const unsigned*)(base + (size_t)row * D * 4 + h * 256 + (lane & 15) * 16), (LAS unsigned*)(buf + pi * (CH * 256) + tg * 1024), 16, 0, 0); }
                { const int row = scan_row(c * CH + lw * 8 + (lane >> 3), b, z);
                  __builtin_amdgcn_global_load_lds((const unsigned*)(vpl + (size_t)row * D * 4 + (h * 64 + vh * 32) * 4 + (lane & 7) * 16), (LAS unsigned*)(buf + 5 * CH * 256 + lw * 1024), 16, 0, 0); }
            };
            auto prep = [&](int c) {
                char* buf = lds + (c % 3) * BUFB;
#pragma unroll
                for (int ps = 0; ps < 2; ++ps) { const int ptok = lw * 8 + ps * 4 + (lane >> 4);
                    f32x4* kp = (f32x4*)(buf + 1 * CH * 256 + ptok * 256 + pq * 16); f32x4* ap = (f32x4*)(buf + 2 * CH * 256 + ptok * 256 + pq * 16); f32x4* dp = (f32x4*)(buf + 4 * CH * 256 + ptok * 256 + pq * 16);
                    f32x4* rp = (f32x4*)(buf + 3 * CH * 256 + ptok * 256 + pq * 16); const f32x4 wv = *(const f32x4*)(buf + ptok * 256 + pq * 16);
                    const f32x4 k = *kp, a = *ap, r = *rp; f32x4 kk = k * kkv;
                    float ss = kk[0] * kk[0] + kk[1] * kk[1] + kk[2] * kk[2] + kk[3] * kk[3]; ss = dpp_sum16(ss);
                    const float inv = 1.f / fmaxf(sqrtf(ss), 1e-12f); kk = kk * inv;
                    const f32x4 kd = k * (1.f + (a - 1.f) * kav), bb = kk * a;
                    const f32x4 t1 = bb * r, t2 = kd * r;
                    const float br = dpp_sum16((t1[0] + t1[1]) + (t1[2] + t1[3])), kr = dpp_sum16((t2[0] + t2[1]) + (t2[2] + t2[3]));
                    *dp = kd; *ap = bb; *kp = kk; *rp = wv * r;
                    if (pq == 0) *(float2*)(buf + 5 * CH * 256 + CH * 128 + ptok * 16) = make_float2(br, kr); }
            };
            issue(0); issue(1);
            asm volatile("s_waitcnt vmcnt(9)" ::: "memory");
            prep(0);
            asm volatile("s_waitcnt lgkmcnt(0)" ::: "memory"); __builtin_amdgcn_s_barrier();
            for (int c = 0; c < NCH; ++c) {
                if (c >= 1) { const float* yb = (const float*)(lds + 3 * BUFB + ((c - 1) & 1) * YB);
                    const int lt = tid - 256, t = lt >> 3, q = lt & 7; const int row = scan_row((c - 1) * CH + t, b, z);
                    *(f32x4*)(yout + (size_t)row * D + h * 64 + vh * 32 + q * 4) = *(const f32x4*)(yb + t * 32 + q * 4); }
                if (c + 2 < NCH) { issue(c + 2); asm volatile("s_waitcnt vmcnt(9)" ::: "memory"); } else asm volatile("s_waitcnt vmcnt(0)" ::: "memory");
                if (c + 1 < NCH) prep(c + 1);
                asm volatile("s_waitcnt lgkmcnt(0)" ::: "memory"); __builtin_amdgcn_s_barrier();
            }
            { const float* yb = (const float*)(lds + 3 * BUFB + ((NCH - 1) & 1) * YB);
              const int lt = tid - 256, t = lt >> 3, q = lt & 7; const int row = scan_row((NCH - 1) * CH + t, b, z);
              *(f32x4*)(yout + (size_t)row * D + h * 64 + vh * 32 + q * 4) = *(const f32x4*)(yb + t * 32 + q * 4); }
        } else {
            const int vr = lane >> 3, ks = lane & 7;
            f32x4 Sa = {0.f, 0.f, 0.f, 0.f}, Sb = {0.f, 0.f, 0.f, 0.f};
            __builtin_amdgcn_s_barrier();
            struct Ops { f32x4 w0, w1, kk0, kk1, bb0, bb1, r0, r1, kd0, kd1; float v; float2 sc; };
#define SC_LOAD(O, t) do { const char* q_ = bq + (t) * 256; O.w0 = *(const f32x4*)(q_); O.w1 = *(const f32x4*)(q_ + 16); O.kk0 = *(const f32x4*)(q_ + CH * 256); O.kk1 = *(const f32x4*)(q_ + CH * 256 + 16); \
                O.bb0 = *(const f32x4*)(q_ + 2 * CH * 256); O.bb1 = *(const f32x4*)(q_ + 2 * CH * 256 + 16); O.r0 = *(const f32x4*)(q_ + 3 * CH * 256); O.r1 = *(const f32x4*)(q_ + 3 * CH * 256 + 16); \
                O.kd0 = *(const f32x4*)(q_ + 4 * CH * 256); O.kd1 = *(const f32x4*)(q_ + 4 * CH * 256 + 16); O.v = *(const float*)(vq + (t) * 128); O.sc = *(const float2*)(buf + 5 * CH * 256 + CH * 128 + (t) * 16); } while (0)
#define SC_STEP(O, t) do { const f32x4 d1 = Sa * O.kk0 + Sb * O.kk1, d2 = Sa * O.r0 + Sb * O.r1; \
                float sa = -((d1[0] + d1[1]) + (d1[2] + d1[3])), yy = (d2[0] + d2[1]) + (d2[2] + d2[3]); \
                sa = dpp_sum8(sa); yy = dpp_sum8(yy); \
                Sa = Sa * O.w0 + (sa * O.bb0 + O.v * O.kd0); Sb = Sb * O.w1 + (sa * O.bb1 + O.v * O.kd1); \
                if (ks == 0) yb[(t) * 32 + wid * 8 + vr] = yy + sa * O.sc.x + O.v * O.sc.y; } while (0)
            for (int c = 0; c < NCH; ++c) {
                const char* buf = lds + (c % 3) * BUFB; float* yb = (float*)(lds + 3 * BUFB + (c & 1) * YB);
                const char* bq = buf + ks * 32; const char* vq = buf + 5 * CH * 256 + (wid * 8 + vr) * 4;
                Ops oA, oB, oC;
                SC_LOAD(oA, 0); SC_LOAD(oB, 1);
#pragma unroll
                for (int t = 0; t < CH; t += 3) {
                    if (t + 2 < CH) SC_LOAD(oC, t + 2);
                    SC_STEP(oA, t);
                    if (t + 3 < CH) SC_LOAD(oA, t + 3);
                    if (t + 1 < CH) SC_STEP(oB, t + 1);
                    if (t + 4 < CH) SC_LOAD(oB, t + 4);
                    if (t + 2 < CH) SC_STEP(oC, t + 2);
                }
                asm volatile("s_waitcnt lgkmcnt(0)" ::: "memory"); __builtin_amdgcn_s_barrier();
            }
#undef SC_LOAD
#undef SC_STEP
        }
    }
}


namespace ck {
constexpr int P = 72, MB = 64 * P * 2;
typedef __attribute__((address_space(3))) char lchar;
__device__ __forceinline__ f32x4 mm_tile(const lchar* Aop, const lchar* Bop, int ti, int tj, int c, int q, f32x4 acc) {
#pragma unroll
    for (int ks = 0; ks < 2; ++ks) {
        const bf16x8 a = *(const LAS bf16x8*)(Aop + ((16 * ti + c) * P + 32 * ks + 8 * q) * 2);
        const bf16x8 b = *(const LAS bf16x8*)(Bop + ((16 * tj + c) * P + 32 * ks + 8 * q) * 2);
        acc = __builtin_amdgcn_mfma_f32_16x16x32_bf16(a, b, acc, 0, 0, 0);
    }
    return acc;
}
__device__ __forceinline__ f32x4 mm_diag(const lchar* Aop, const lchar* Bop, int tt, int c, int q, f32x4 acc) {
    const int ks = tt >> 1;
    bf16x8 a = *(const LAS bf16x8*)(Aop + ((16 * tt + c) * P + 32 * ks + 8 * q) * 2);
    const bf16x8 b = *(const LAS bf16x8*)(Bop + ((16 * tt + c) * P + 32 * ks + 8 * q) * 2);
    if ((q >> 1) != (tt & 1)) a = (bf16x8){0, 0, 0, 0, 0, 0, 0, 0};
    return __builtin_amdgcn_mfma_f32_16x16x32_bf16(a, b, acc, 0, 0, 0);
}
__device__ __forceinline__ void st_tile(lchar* dst, int ti, int tj, int c, int q, f32x4 v) {
    u32x2 w; w.x = pk2(v[0], v[1]); w.y = pk2(v[2], v[3]); *(LAS u32x2*)(dst + ((16 * tj + c) * P + 16 * ti + 4 * q) * 2) = w;
}
__device__ __forceinline__ f32x4 ld_tile(const lchar* src, int ti, int tj, int c, int q) {
    const u32x2 w = *(const LAS u32x2*)(src + ((16 * tj + c) * P + 16 * ti + 4 * q) * 2);
    return (f32x4){__uint_as_float(w.x << 16), __uint_as_float(w.x & 0xffff0000u), __uint_as_float(w.y << 16), __uint_as_float(w.y & 0xffff0000u)};
}
__device__ __forceinline__ void st_glob(bf16_t* dst, int ti, int tj, int c, int q, f32x4 v) {
    uint2 w; w.x = pk2(v[0], v[1]); w.y = pk2(v[2], v[3]); *(uint2*)(dst + (16 * tj + c) * 64 + 16 * ti + 4 * q) = w;
}
typedef float f32x16 __attribute__((ext_vector_type(16)));
__device__ __forceinline__ f32x16 mm32(const lchar* Aop, const lchar* Bop, int ti, int tj, int r32, int hi, f32x16 acc) {
#pragma unroll
    for (int ks = 0; ks < 4; ++ks) {
        const bf16x8 a = *(const LAS bf16x8*)(Aop + ((32 * ti + r32) * P + 16 * ks + 8 * hi) * 2);
        const bf16x8 b = *(const LAS bf16x8*)(Bop + ((32 * tj + r32) * P + 16 * ks + 8 * hi) * 2);
        acc = __builtin_amdgcn_mfma_f32_32x32x16_bf16(a, b, acc, 0, 0, 0);
    }
    return acc;
}
__device__ __forceinline__ void st32(lchar* dst, int ti, int tj, int r32, int hi, const f32x16& v) {
#pragma unroll
    for (int g = 0; g < 4; ++g) { u32x2 w; w.x = pk2(v[4 * g], v[4 * g + 1]); w.y = pk2(v[4 * g + 2], v[4 * g + 3]); *(LAS u32x2*)(dst + ((32 * tj + r32) * P + 32 * ti + 8 * g + 4 * hi) * 2) = w; }
}
__device__ __forceinline__ f32x16 ld32(const lchar* src, int ti, int tj, int r32, int hi) {
    f32x16 v;
#pragma unroll
    for (int g = 0; g < 4; ++g) { const u32x2 w = *(const LAS u32x2*)(src + ((32 * tj + r32) * P + 32 * ti + 8 * g + 4 * hi) * 2);
        v[4 * g] = __uint_as_float(w.x << 16); v[4 * g + 1] = __uint_as_float(w.x & 0xffff0000u); v[4 * g + 2] = __uint_as_float(w.y << 16); v[4 * g + 3] = __uint_as_float(w.y & 0xffff0000u); }
    return v;
}
__device__ __forceinline__ void stg32(bf16_t* dst, int ti, int tj, int r32, int hi, const f32x16& v) {
#pragma unroll
    for (int g = 0; g < 4; ++g) { uint2 w; w.x = pk2(v[4 * g], v[4 * g + 1]); w.y = pk2(v[4 * g + 2], v[4 * g + 3]); *(uint2*)(dst + (32 * tj + r32) * 64 + 32 * ti + 8 * g + 4 * hi) = w; }
}
}

#define LBAR() do { asm volatile("s_waitcnt lgkmcnt(0)" ::: "memory"); __builtin_amdgcn_s_barrier(); asm volatile("" ::: "memory"); } while (0)
__device__ void ph_rw_sc1(const Params& p, int j, char* lds) {
    using namespace ck;
    const int tid = tidx(), wid = __builtin_amdgcn_readfirstlane(tid >> 6), lane = tid & 63, c = lane & 15, q = lane >> 4;
    const size_t PL = (size_t)NROW * D;
    const bf16_t* RKV = (const bf16_t*)(p.ws + OFF_RKV); const float* LW = (const float*)(p.ws + OFF_W); const bf16_t* AV = (const bf16_t*)(p.ws + OFF_AV);
    bf16_t* CK = (bf16_t*)(p.ws + OFF_CK);
    lchar* B0 = (lchar*)lds;
#define BUF(i) (B0 + (i) * MB)
    LAS float* Lbuf = (LAS float*)BUF(8);
    LAS float* Lseg = (LAS float*)(B0 + 16 * MB);
    LAS float* GC = Lseg + 8 * 64;
    const int pt = tid >> 3, cg = tid & 7;
    f32x4 nlw[2], nkk[2], nka[2]; u32x4 nkx, nax, nrx, nvx;
#define SC1_LOAD(IT) do { const int seq_ = (IT) / NCHK, ch_ = (IT) % NCHK; const int z_ = seq_ & 1, h_ = (seq_ >> 1) & 15, b_ = seq_ >> 5; \
        const size_t go_ = (size_t)scan_row(ch_ * 64 + pt, b_, z_) * D + h_ * 64 + cg * 8; \
        _Pragma("unroll") for (int e = 0; e < 2; ++e) nlw[e] = *(const f32x4*)(LW + z_ * PL + go_ + 4 * e); \
        nkx = *(const u32x4*)(RKV + PL + go_); nax = *(const u32x4*)(AV + z_ * PL + go_); nrx = *(const u32x4*)(RKV + go_); nvx = *(const u32x4*)(RKV + 2 * PL + go_); \
        _Pragma("unroll") for (int e = 0; e < 2; ++e) { nkk[e] = *(const f32x4*)(p.rw_k_k + j * D + h_ * 64 + cg * 8 + 4 * e); nka[e] = *(const f32x4*)(p.rw_k_a + j * D + h_ * 64 + cg * 8 + 4 * e); } } while (0)
    if (bidx() < 128 * NCHK) SC1_LOAD(bidx());
    for (int it = bidx(); it < 128 * NCHK; it += gdim()) {
        const int seq = it / NCHK; const int h = (seq >> 1) & 15;
        f32x4 lw[2], kx[2], ax[2], rx[2], vx[2], kkc[2], kac[2];
#pragma unroll
        for (int e = 0; e < 2; ++e) { lw[e] = nlw[e]; kkc[e] = nkk[e]; kac[e] = nka[e];
            kx[e] = (f32x4){__uint_as_float(nkx[2 * e] << 16), __uint_as_float(nkx[2 * e] & 0xffff0000u), __uint_as_float(nkx[2 * e + 1] << 16), __uint_as_float(nkx[2 * e + 1] & 0xffff0000u)};
            ax[e] = (f32x4){__uint_as_float(nax[2 * e] << 16), __uint_as_float(nax[2 * e] & 0xffff0000u), __uint_as_float(nax[2 * e + 1] << 16), __uint_as_float(nax[2 * e + 1] & 0xffff0000u)};
            rx[e] = (f32x4){__uint_as_float(nrx[2 * e] << 16), __uint_as_float(nrx[2 * e] & 0xffff0000u), __uint_as_float(nrx[2 * e + 1] << 16), __uint_as_float(nrx[2 * e + 1] & 0xffff0000u)};
            vx[e] = (f32x4){__uint_as_float(nvx[2 * e] << 16), __uint_as_float(nvx[2 * e] & 0xffff0000u), __uint_as_float(nvx[2 * e + 1] << 16), __uint_as_float(nvx[2 * e + 1] & 0xffff0000u)}; }
        if (it + gdim() < 128 * NCHK) SC1_LOAD(it + gdim());
        LBAR();
#pragma unroll
        for (int e = 0; e < 2; ++e) *(LAS f32x4*)(Lbuf + pt * 64 + cg * 8 + 4 * e) = lw[e];
        f32x4 kk[2], bq[2], kd[2];
        { float ss = 0.f;
#pragma unroll
          for (int e = 0; e < 2; ++e) { kk[e] = kx[e] * kkc[e]; ss += kk[e][0] * kk[e][0] + kk[e][1] * kk[e][1] + kk[e][2] * kk[e][2] + kk[e][3] * kk[e][3]; }
          ss = dpp_sum8(ss); const float inv = __builtin_amdgcn_rsqf(fmaxf(ss, 1e-24f));
#pragma unroll
          for (int e = 0; e < 2; ++e) { kk[e] = kk[e] * inv; bq[e] = kk[e] * ax[e]; kd[e] = kx[e] * (1.f + (ax[e] - 1.f) * kac[e]); } }
        LBAR();
        { const int k = tid & 63, sg = tid >> 6; float run = 0.f;
#pragma unroll
          for (int u = 0; u < 8; ++u) { run += Lbuf[(sg * 8 + u) * 64 + k]; Lbuf[(sg * 8 + u) * 64 + k] = run; }
          Lseg[sg * 64 + k] = run; }
        LBAR();
        f32x4 Lt[2], Lp[2], Lc[2];
        { const int sg = pt >> 3, sgp = (pt - 1) >> 3;
#pragma unroll
          for (int e = 0; e < 2; ++e) { f32x4 o0 = {0.f, 0.f, 0.f, 0.f}, o1 = o0, oc = o0;
#pragma unroll
              for (int u = 0; u < 8; ++u) { const f32x4 sv = *(const LAS f32x4*)(Lseg + u * 64 + cg * 8 + 4 * e); if (u < sg) o0 = o0 + sv; if (u < sgp) o1 = o1 + sv; if (u < 7) oc = oc + sv; }
              Lt[e] = *(const LAS f32x4*)(Lbuf + pt * 64 + cg * 8 + 4 * e) + o0;
              Lp[e] = pt > 0 ? *(const LAS f32x4*)(Lbuf + (pt - 1) * 64 + cg * 8 + 4 * e) + o1 : (f32x4){0.f, 0.f, 0.f, 0.f};
              Lc[e] = *(const LAS f32x4*)(Lbuf + 63 * 64 + cg * 8 + 4 * e) + oc; } }
        LBAR();
        {
            float at[8], bt[8], kt[8], rt[8], bh[8], kh[8], vv[8];
#pragma unroll
            for (int e = 0; e < 2; ++e)
#pragma unroll
                for (int u = 0; u < 4; ++u) { const int x = 4 * e + u; const float eL = __expf(Lt[e][u]), emL = __expf(-Lt[e][u]), eP = __expf(Lp[e][u]), eC = __expf(Lc[e][u] - Lt[e][u]);
                    at[x] = -kk[e][u] * eP; bt[x] = bq[e][u] * emL; kt[x] = kd[e][u] * emL; rt[x] = rx[e][u] * eL; bh[x] = bq[e][u] * eC; kh[x] = kd[e][u] * eC; vv[x] = vx[e][u];
                    if (pt == 63) GC[cg * 8 + x] = eL; }
#define ST8(bufi, arr) do { u32x4 w_ = {pk2(arr[0], arr[1]), pk2(arr[2], arr[3]), pk2(arr[4], arr[5]), pk2(arr[6], arr[7])}; *(LAS u32x4*)(BUF(bufi) + (pt * P + cg * 8) * 2) = w_; } while (0)
            ST8(0, at); ST8(1, bt); ST8(2, kt); ST8(3, rt); ST8(8, bh); ST8(9, kh); ST8(10, vv);
#undef ST8
        }
        LBAR();
        {
            const int k = tid & 63, tg = tid >> 6;
#define TR8(src, dst) do { unsigned w_[4]; _Pragma("unroll") for (int x = 0; x < 4; ++x) { const unsigned lo = *(const LAS bf16_t*)(BUF(src) + ((tg * 8 + 2 * x) * P + k) * 2), hi2 = *(const LAS bf16_t*)(BUF(src) + ((tg * 8 + 2 * x + 1) * P + k) * 2); w_[x] = lo | (hi2 << 16); } \
                *(LAS u32x4*)(BUF(dst) + (k * P + tg * 8) * 2) = (u32x4){w_[0], w_[1], w_[2], w_[3]}; } while (0)
            TR8(0, 4); TR8(8, 5); TR8(9, 6); TR8(10, 7);
#undef TR8
        }
        LBAR();
        const f32x4 Z4 = {0.f, 0.f, 0.f, 0.f};
        const f32x16 Z16 = {0.f, 0.f, 0.f, 0.f, 0.f, 0.f, 0.f, 0.f, 0.f, 0.f, 0.f, 0.f, 0.f, 0.f, 0.f, 0.f};
        const int r32 = lane & 31, hi = lane >> 5;
#pragma unroll 1
        for (int u = 0; u < 3; ++u) { const int tl = u * 8 + wid; if (tl >= 20) break; const int m = tl >> 2, ti = (tl >> 1) & 1, tj = tl & 1; const int jj = 32 * tj + r32;
            if (m == 0) { f32x16 v = mm32(BUF(0), BUF(1), ti, tj, r32, hi, Z16), w;
#pragma unroll
                for (int e = 0; e < 16; ++e) { const int ii = 32 * ti + 8 * (e >> 2) + 4 * hi + (e & 3); const bool dg = (ii >> 4) == (jj >> 4);
                    v[e] = (dg && jj < ii) ? v[e] : 0.f; w[e] = v[e] + ((ii == jj) ? 1.f : 0.f); }
                st32(BUF(8), ti, tj, r32, hi, v); st32(BUF(14), ti, tj, r32, hi, w); }
            else if (m == 1) { const f32x16 v = mm32(BUF(1), BUF(0), ti, tj, r32, hi, Z16); f32x16 vd, vo, w;
#pragma unroll
                for (int e = 0; e < 16; ++e) { const int ii = 32 * ti + 8 * (e >> 2) + 4 * hi + (e & 3); const bool dg = (ii >> 4) == (jj >> 4), up = ii < jj;
                    vd[e] = (dg && up) ? v[e] : 0.f; vo[e] = (!dg && up) ? v[e] : 0.f; w[e] = vd[e] + ((ii == jj) ? 1.f : 0.f); }
                st32(BUF(9), ti, tj, r32, hi, vd); st32(BUF(15), ti, tj, r32, hi, vo); st32(BUF(13), ti, tj, r32, hi, w); }
            else if (m == 2) { f32x16 v = mm32(BUF(2), BUF(0), ti, tj, r32, hi, Z16);
#pragma unroll
                for (int e = 0; e < 16; ++e) { const int ii = 32 * ti + 8 * (e >> 2) + 4 * hi + (e & 3); v[e] = ii < jj ? v[e] : 0.f; }
                st32(BUF(10), ti, tj, r32, hi, v); }
            else { f32x16 v = mm32(m == 3 ? BUF(1) : BUF(2), BUF(3), ti, tj, r32, hi, Z16);
#pragma unroll
                for (int e = 0; e < 16; ++e) { const int ii = 32 * ti + 8 * (e >> 2) + 4 * hi + (e & 3); v[e] = ii <= jj ? v[e] : 0.f; }
                st32(m == 3 ? BUF(11) : BUF(12), ti, tj, r32, hi, v); } }
        LBAR();
#define WSYNC() asm volatile("s_waitcnt lgkmcnt(0)" ::: "memory")
        if (wid < 4) {
            const int tt = wid;
#define SQD(sr, st, dr, dt) do { const f32x4 a_ = mm_diag(BUF(st), BUF(sr), tt, c, q, Z4), b_ = mm_diag(BUF(sr), BUF(st), tt, c, q, Z4); WSYNC(); \
                st_tile(BUF(dr), tt, tt, c, q, a_); st_tile(BUF(dt), tt, tt, c, q, b_); WSYNC(); } while (0)
#define UPD(pr) do { const f32x4 dt_ = mm_diag(BUF(pr), BUF(13), tt, c, q, ld_tile(BUF(13), tt, tt, c, q)); \
                const f32x4 dr_ = mm_diag(BUF(13), BUF(pr), tt, c, q, ld_tile(BUF(14), tt, tt, c, q)); WSYNC(); \
                st_tile(BUF(13), tt, tt, c, q, dt_); st_tile(BUF(14), tt, tt, c, q, dr_); WSYNC(); } while (0)
            SQD(8, 9, 0, 1); UPD(0); SQD(0, 1, 8, 9); UPD(8); SQD(8, 9, 0, 1); UPD(0);
#undef SQD
#undef UPD
        } else {
            const int ti = (wid >> 1) & 1, tj = wid & 1; st32(BUF(2), ti, tj, r32, hi, mm32(BUF(10), BUF(7), ti, tj, r32, hi, Z16));
        }
        LBAR();
        { const int m = wid >> 2, ti = (wid >> 1) & 1, tj = wid & 1;
          if (m == 0) st32(BUF(8), ti, tj, r32, hi, mm32(BUF(15), BUF(14), ti, tj, r32, hi, Z16));
          else        st32(BUF(9), ti, tj, r32, hi, mm32(BUF(14), BUF(15), ti, tj, r32, hi, Z16)); }
        LBAR();
        if (wid < 4) { const int ti = (wid >> 1) & 1, tj = wid & 1; st32(BUF(0), ti, tj, r32, hi, mm32(BUF(9), BUF(8), ti, tj, r32, hi, Z16)); }
        LBAR();
        if (wid < 4) { const int ti = (wid >> 1) & 1, tj = wid & 1; st32(BUF(1), ti, tj, r32, hi, mm32(BUF(0), BUF(13), ti, tj, r32, hi, ld32(BUF(13), ti, tj, r32, hi))); }
        LBAR();
        if (wid < 4) { const int ti = (wid >> 1) & 1, tj = wid & 1; st32(BUF(14), ti, tj, r32, hi, mm32(BUF(8), BUF(1), ti, tj, r32, hi, ld32(BUF(1), ti, tj, r32, hi))); }
        LBAR();
        { const int m = wid >> 2, ti = (wid >> 1) & 1, tj = wid & 1;
          if (m == 0) st32(BUF(8), ti, tj, r32, hi, mm32(BUF(14), BUF(4), ti, tj, r32, hi, Z16));
          else        st32(BUF(0), ti, tj, r32, hi, mm32(BUF(14), BUF(2), ti, tj, r32, hi, Z16)); }
        LBAR();
        bf16_t* ckp = CK + (size_t)it * 4 * 4096;
#pragma unroll 1
        for (int u = 0; u < 2; ++u) { const int tl = u * 8 + wid, m = tl >> 2, ti = (tl >> 1) & 1, tj = tl & 1;
            if (m == 0) { f32x16 v = mm32(BUF(8), BUF(5), ti, tj, r32, hi, Z16); const int jj = 32 * tj + r32; const float gc = GC[jj];
#pragma unroll
                for (int e = 0; e < 16; ++e) { const int ii = 32 * ti + 8 * (e >> 2) + 4 * hi + (e & 3); v[e] += (ii == jj) ? gc : 0.f; }
                st32(BUF(1), ti, tj, r32, hi, v); }
            else if (m == 1) st32(BUF(4), ti, tj, r32, hi, mm32(BUF(8), BUF(11), ti, tj, r32, hi, ld32(BUF(3), ti, tj, r32, hi)));
            else if (m == 2) st32(BUF(2), ti, tj, r32, hi, mm32(BUF(6), BUF(7), ti, tj, r32, hi, mm32(BUF(5), BUF(0), ti, tj, r32, hi, Z16)));
            else             st32(BUF(9), ti, tj, r32, hi, mm32(BUF(7), BUF(12), ti, tj, r32, hi, mm32(BUF(0), BUF(11), ti, tj, r32, hi, Z16))); }
        LBAR();
        { const int orow = tid >> 3, oc = (tid & 7) * 8;
          *(u32x4*)(ckp + orow * 64 + oc) = *(const LAS u32x4*)(BUF(1) + (orow * P + oc) * 2);
          *(u32x4*)(ckp + 4096 + orow * 64 + oc) = *(const LAS u32x4*)(BUF(2) + (orow * P + oc) * 2);
          *(u32x4*)(ckp + 2 * 4096 + orow * 64 + oc) = *(const LAS u32x4*)(BUF(4) + (orow * P + oc) * 2);
          *(u32x4*)(ckp + 3 * 4096 + orow * 64 + oc) = *(const LAS u32x4*)(BUF(9) + (orow * P + oc) * 2); }
    }
#undef BUF
#undef SC1_LOAD
}

__device__ void ph_rw_sc2(const Params& p, char* lds) {
    using namespace ck;
    const int tid = tidx(), wid = __builtin_amdgcn_readfirstlane(tid >> 6), lane = tid & 63, c = lane & 15, q = lane >> 4;
    const size_t PL = (size_t)NROW * D;
    const bf16_t* CK = (const bf16_t*)(p.ws + OFF_CK); bf16_t* Y = (bf16_t*)(p.ws + OFF_Y);
    lchar* GB = (lchar*)lds;
    lchar* RB = GB + 2 * MB;
    lchar* SB = GB + 4 * MB;
    constexpr int SBB = 32 * P * 2;
    for (int it = bidx(); it < 256; it += gdim()) {
        const int vh = it & 1, seq = it >> 1, z = seq & 1, h = (seq >> 1) & 15, b = seq >> 5;
        const bf16_t* ck0 = CK + (size_t)seq * NCHK * 4 * 4096;
        const int s_ti = wid & 3, s_tj = wid >> 2;
        const int y_ti = wid & 1, y_tj = wid >> 1;
        const int hoff = 4096 + (vh * 32 + 16 * s_tj + c) * 64 + 16 * s_ti + 4 * q, yoff = 3 * 4096 + (16 * y_tj + c) * 64 + vh * 32 + 16 * y_ti + 4 * q;
        struct PF { u32x4 g, r; uint2 h, y; };
#define PF_LOAD(X, k) do { const bf16_t* cc_ = ck0 + (size_t)(k) * 4 * 4096; X.h = *(const uint2*)(cc_ + hoff); X.y = *(const uint2*)(cc_ + yoff); X.g = *(const u32x4*)(cc_ + tid * 8); X.r = *(const u32x4*)(cc_ + 2 * 4096 + tid * 8); } while (0)
#define PF_STAGE(X, bufi) do { *(LAS u32x4*)(GB + (bufi) * MB + ((tid >> 3) * P + (tid & 7) * 8) * 2) = X.g; *(LAS u32x4*)(RB + (bufi) * MB + ((tid >> 3) * P + (tid & 7) * 8) * 2) = X.r; } while (0)
#define SC2_STEP(k, CUR, NXT) do { const uint2 hi_ = CUR.h, yi_ = CUR.y; const int cur = (k) & 1; \
            if ((k) + 4 < NCHK) PF_LOAD(CUR, (k) + 4); \
            const f32x4 hinit = {__uint_as_float(hi_.x << 16), __uint_as_float(hi_.x & 0xffff0000u), __uint_as_float(hi_.y << 16), __uint_as_float(hi_.y & 0xffff0000u)}; \
            const f32x4 yinit = {__uint_as_float(yi_.x << 16), __uint_as_float(yi_.x & 0xffff0000u), __uint_as_float(yi_.y << 16), __uint_as_float(yi_.y & 0xffff0000u)}; \
            const lchar* Sold = SB + cur * SBB; lchar* Snew = SB + (cur ^ 1) * SBB; \
            const f32x4 sn = mm_tile(GB + cur * MB, Sold, s_ti, s_tj, c, q, hinit);        \
            const f32x4 yv = mm_tile(Sold, RB + cur * MB, y_ti, y_tj, c, q, yinit);        \
            st_tile(Snew, s_ti, s_tj, c, q, sn); \
            { const int row = scan_row((k) * 64 + 16 * y_tj + c, b, z); stbf4(Y + z * PL + (size_t)row * D + h * 64 + vh * 32 + 16 * y_ti + 4 * q, yv); } \
            if ((k) + 1 < NCHK) PF_STAGE(NXT, cur ^ 1); \
            LBAR(); } while (0)
        PF s0, s1, s2, s3;
        PF_LOAD(s0, 0); PF_LOAD(s1, 1); PF_LOAD(s2, 2); PF_LOAD(s3, 3);
        LBAR();
        for (int i = tid; i < SBB / 4; i += NTHR) ((LAS unsigned*)SB)[i] = 0u;
        PF_STAGE(s0, 0);
        LBAR();
        for (int ch = 0; ch < NCHK; ch += 4) {
            SC2_STEP(ch, s0, s1); SC2_STEP(ch + 1, s1, s2); SC2_STEP(ch + 2, s2, s3); SC2_STEP(ch + 3, s3, s0);
        }
#undef PF_LOAD
#undef PF_STAGE
#undef SC2_STEP
    }
}
#undef LBAR

__device__ void ph_rw_out(const Params& p, int j, int nrows) {
    const int wid = tidx() >> 6, lane = tidx() & 63;
    const bf16_t* RKV = (const bf16_t*)(p.ws + OFF_RKV); const bf16_t* AV = (const bf16_t*)(p.ws + OFF_AV); const bf16_t* G = (const bf16_t*)(p.ws + OFF_G); const bf16_t* Y = (const bf16_t*)(p.ws + OFF_Y);
    bf16_t* OUT = (bf16_t*)(p.ws + OFF_H);
    const size_t PL = (size_t)NROW * D;
    const float* r_k = p.rw_r_k + j * D; const float* lg = p.rw_lnx_g + j * D; const float* lb = p.rw_lnx_b + j * D; const float* k_a = p.rw_k_a + j * D;
    uint2 nb[8][4];
#define OUT_LOAD(R) do { _Pragma("unroll") for (int i = 0; i < 4; ++i) { const size_t o_ = (size_t)(R) * D + lane * 4 + i * 256; \
        nb[0][i] = *(const uint2*)(Y + o_); nb[1][i] = *(const uint2*)(Y + PL + o_); nb[2][i] = *(const uint2*)(RKV + o_); nb[3][i] = *(const uint2*)(RKV + PL + o_); \
        nb[4][i] = *(const uint2*)(RKV + 2 * PL + o_); nb[5][i] = *(const uint2*)(AV + o_); nb[6][i] = *(const uint2*)(AV + PL + o_); nb[7][i] = *(const uint2*)(G + o_); } } while (0)
#define UNPK(w) ((f32x4){__uint_as_float((w).x << 16), __uint_as_float((w).x & 0xffff0000u), __uint_as_float((w).y << 16), __uint_as_float((w).y & 0xffff0000u)})
    int row = bidx() * 8 + wid;
    if (row < nrows) OUT_LOAD(row);
    for (; row < nrows; row += gdim() * 8) {
        uint2 cb[8][4];
#pragma unroll
        for (int q_ = 0; q_ < 8; ++q_)
#pragma unroll
            for (int i = 0; i < 4; ++i) cb[q_][i] = nb[q_][i];
        { const int nrow = row + gdim() * 8; if (nrow < nrows) OUT_LOAD(nrow); }
#pragma unroll
        for (int i = 0; i < 4; ++i) {
            const size_t o = (size_t)row * D + lane * 4 + i * 256; const int c = lane * 4 + i * 256;
            const f32x4 y = UNPK(cb[0][i]) + UNPK(cb[1][i]);
            const float mean = dpp_sum16(y[0] + y[1] + y[2] + y[3]) * (1.f / 64.f);
            const f32x4 dd = y - mean;
            const float rstd = rsqrtf(dpp_sum16(dd[0] * dd[0] + dd[1] * dd[1] + dd[2] * dd[2] + dd[3] * dd[3]) * (1.f / 64.f) + LNX_EPS);
            const f32x4 r = UNPK(cb[2][i]), k = UNPK(cb[3][i]), v = UNPK(cb[4][i]);
            const f32x4 a0 = UNPK(cb[5][i]), a1 = UNPK(cb[6][i]);
            const f32x4 kds = k * (2.f + (a0 + a1 - 2.f) * *(const f32x4*)(k_a + c));
            const f32x4 t4 = r * kds * *(const f32x4*)(r_k + c);
            const float bs = dpp_sum16(t4[0] + t4[1] + t4[2] + t4[3]);
            const f32x4 res = (dd * rstd * *(const f32x4*)(lg + c) + *(const f32x4*)(lb + c) + bs * v) * UNPK(cb[7][i]);
            uint2 w; w.x = pk2(res[0], res[1]); w.y = pk2(res[2], res[3]); *(uint2*)(OUT + o) = w;
        }
    }
#undef OUT_LOAD
#undef UNPK
}

__device__ void ph_final(const Params& p) {
    const int wid = tidx() >> 6, lane = tidx() & 63;
    const float* X = (const float*)(p.ws + OFF_X);
    for (int row = bidx() * 8 + wid; row < NLAT; row += gdim() * 8) {
        const float4* xr = (const float4*)(X + (size_t)row * D);
        float4 v[4]; float ss = 0;
#pragma unroll
        for (int i = 0; i < 4; ++i) { v[i] = xr[lane + i * 64]; ss += v[i].x * v[i].x + v[i].y * v[i].y + v[i].z * v[i].z + v[i].w * v[i].w; }
        ss = wave_sum(ss); const float rs = rsqrtf(ss * (1.f / D) + RMS_EPS);
#pragma unroll
        for (int i = 0; i < 4; ++i) { const int d = (lane + i * 64) * 4; const float4 gg = *(const float4*)(p.final_g + d);
            float4 o; o.x = v[i].x * rs * gg.x; o.y = v[i].y * rs * gg.y; o.z = v[i].z * rs * gg.z; o.w = v[i].w * rs * gg.w;
            *(float4*)(p.out + (size_t)row * D + d) = o; }
    }
}

enum { PH_INIT = 0, PH_A_NORM, PH_A_Z, PH_A_MID, PH_A_QKV, PH_A_POST, PH_A_ATTN, PH_A_WO,
       PH_R_NORM, PH_R_XS, PH_R_G1, PH_R_G2, PH_R_PREP, PH_R_SCAN, PH_R_OUT, PH_R_WO,
       PH_M_NORM, PH_M_SEL, PH_M_GATHER, PH_M_G1, PH_M_G2, PH_M_COMB, PH_FINAL, PH_M_CVT, PH_R_SC1, PH_R_SC2 };

template <int PH>
__device__ __forceinline__ void run_phase(const Params& p, int layer, char* lds) {
    const int j = layer >> 1;
    char* ws = p.ws;
    if constexpr (PH == PH_INIT) { ph_init(p, lds); __syncthreads(); ph_small_cvt(p, lds); }
    else if constexpr (PH == PH_A_NORM) { if (layer == 0) ph_norm_mod<false>(p, layer, p.norm1_g + layer * D, 0, 1, ws + OFF_H); else ph_comb_norm<false>(p, layer - 1, layer, NROW); }
    else if constexpr (PH == PH_A_Z) {
        float* Z = (float*)(ws + OFF_Z);
        g8::BatchSched S{ws + OFF_H, ws + OFF_WMLA + j * SZ_WMLA + WM_IN, 0, 0, NROW / 256, 2, 1, D};
        g8::gemm_phase(p.wv, (PG8_LAS unsigned char*)lds, D, S, g8::epi_rc([=](const g8::Unit&, int row, int col, f32x4 v) { *(f32x4*)(Z + (size_t)row * 512 + col) = v; }));
    }
    else if constexpr (PH == PH_A_MID) ph_mla_mid(p, j);
    else if constexpr (PH == PH_A_QKV) {
        bf16_t* Q = (bf16_t*)(ws + OFF_Q); bf16_t* K = (bf16_t*)(ws + OFF_K); bf16_t* V = (bf16_t*)(ws + OFF_V);
        g8::BatchSched S1{ws + OFF_CQN, ws + OFF_WMLA + j * SZ_WMLA + WM_UQ, 0, 0, NROW / 256, 6, 1, 256};
        g8::gemm_phase(p.wv, (PG8_LAS unsigned char*)lds, 256, S1, g8::epi_rc([=](const g8::Unit&, int row, int col, f32x4 v) {
            const bool lat = row < NLAT; const int b = lat ? (row >> 12) : ((row - NLAT) >> 8); const int tk = lat ? 256 + (row & (TL - 1)) : ((row - NLAT) & 255);
            const int h = col / 192, d = col - h * 192;
            uint2 w; w.x = pk2(v[0], v[1]); w.y = pk2(v[2], v[3]);
            *(uint2*)(Q + ((size_t)(b * 8 + h) * TK + tk) * 192 + d) = w; }));
        g8::BatchSched S2{ws + OFF_CKVN, ws + OFF_WMLA + j * SZ_WMLA + WM_UKV, 0, 0, NROW / 256, 8, 1, 256};
        g8::gemm_phase(p.wv, (PG8_LAS unsigned char*)lds, 256, S2, g8::epi_rc([=](const g8::Unit&, int row, int col, f32x4 v) {
            const bool lat = row < NLAT; const int b = lat ? (row >> 12) : ((row - NLAT) >> 8); const int tk = lat ? 256 + (row & (TL - 1)) : ((row - NLAT) & 255);
            const int h = col >> 8, d = col & 255; const size_t orow = (size_t)(b * 8 + h) * TK + tk;
            uint2 w; w.x = pk2(v[0], v[1]); w.y = pk2(v[2], v[3]);
            if (d < 128) *(uint2*)(K + orow * 192 + d) = w; else *(uint2*)(V + orow * 128 + (d - 128)) = w; }));
    }
    else if constexpr (PH == PH_A_ATTN) ph_attn(p, lds);
    else if constexpr (PH == PH_A_WO || PH == PH_R_WO) {
        float* X = (float*)(ws + OFF_X); const float* MOD = (const float*)(ws + OFF_MOD);
        g8::BatchSched S{ws + (PH == PH_A_WO ? OFF_O : OFF_H), PH == PH_A_WO ? ws + OFF_WMLA + j * SZ_WMLA + WM_O : ws + OFF_WRW + j * SZ_WRW + WR_O, 0, 0, (layer < 3 ? NROW : NLAT) / 256, 4, 1, D};
        g8::gemm_phase(p.wv, (PG8_LAS unsigned char*)lds, D, S, g8::EpiResid{X, MOD, layer});
    }
    else if constexpr (PH == PH_R_XS) ph_rw_normxs(p, layer, j);
    else if constexpr (PH == PH_R_G1) {
        bf16_t* RKV = (bf16_t*)(ws + OFF_RKV); bf16_t* VF = (bf16_t*)(ws + OFF_VFIRST);
        bf16_t* A2 = (bf16_t*)(ws + OFF_A2); bf16_t* A3 = (bf16_t*)(ws + OFF_A3);
        const bool first = (j == 0);
        struct RSched { const char* XS; const char* WB; int nwg;
            __device__ __forceinline__ bool next(int i, g8::Unit& u) const {
                const int L = i * gdim() + bidx(); if (L >= nwg) return false;
                const int w = g8::xcd_remap(L, nwg);
                if (w < 816) { u.g = w / 272; const int r = w % 272; u.pm = r >> 2; u.pn = r & 3; u.B = WB + WR_RKV + (size_t)u.g * D * D * 2 + (size_t)u.pn * 256 * D * 2; }
                else { u.g = 3 + (w - 816) / 68; u.pm = (w - 816) % 68; u.pn = 0; u.B = WB + WR_L + (size_t)(u.g - 3) * 256 * D * 2; }
                u.A = XS + (size_t)(u.g == 6 ? 2 : u.g) * NROW * D * 2 + (size_t)u.pm * 256 * D * 2; return true; } };
        RSched S{ws + OFF_XS, ws + OFF_WRW + j * SZ_WRW, first ? 816 + 204 : 816 + 272};
        g8::gemm_phase(p.wv, (PG8_LAS unsigned char*)lds, D, S, g8::epi_rc([=](const g8::Unit& u, int row, int col, f32x4 v) {
            if (u.g < 3) { stbf4(RKV + ((size_t)u.g * NROW + row) * D + col, v); if (first && u.g == 2) stbf4(VF + (size_t)row * D + col, v); }
            else if (u.g == 3) { if (col < 128) { f32x4 t; for (int e = 0; e < 4; ++e) t[e] = 1.f - 2.f * __builtin_amdgcn_rcpf(1.f + __expf(2.f * v[e]));
                uint2 w; w.x = pk2(t[0], t[1]); w.y = pk2(t[2], t[3]); *(uint2*)(A2 + (size_t)row * 256 + col) = w; } }
            else if (u.g == 4) { if (col < 128) { uint2 w; w.x = pk2(v[0], v[1]); w.y = pk2(v[2], v[3]); *(uint2*)(A2 + (size_t)row * 256 + 128 + col) = w; } }
            else if (u.g == 5) { uint2 w; if (col < 128) { w.x = pk2(sigmoidf_(v[0]), sigmoidf_(v[1])); w.y = pk2(sigmoidf_(v[2]), sigmoidf_(v[3])); } else { w.x = 0u; w.y = 0u; }
                                 if (col < 128 || first || col >= 160) *(uint2*)(A3 + (size_t)row * 256 + col) = w; }
            else { if (col < 32) { uint2 w; w.x = pk2(v[0], v[1]); w.y = pk2(v[2], v[3]); *(uint2*)(A3 + (size_t)row * 256 + 128 + col) = w; } } }));
    }
    else if constexpr (PH == PH_R_G2) {
        const bool first = (j == 0);
        float* W = (float*)(ws + OFF_W); bf16_t* AV = (bf16_t*)(ws + OFF_AV); bf16_t* G = (bf16_t*)(ws + OFF_G); bf16_t* RKV = (bf16_t*)(ws + OFF_RKV); const bf16_t* VF = (const bf16_t*)(ws + OFF_VFIRST);
        const float* w0 = p.rw_w0 + (size_t)j * 2 * D; const float* a0 = p.rw_a0 + (size_t)j * 2 * D; const float* v0 = p.rw_v0;
        g8::BatchSched S1{ws + OFF_A2, ws + OFF_WRW + j * SZ_WRW + WR_B2, 0, 0, NROW / 256, 16, 1, 256};
        g8::gemm_phase(p.wv, (PG8_LAS unsigned char*)lds, 256, S1, g8::epi_colfirst([=](const g8::Unit& u, int row, int col, f32x4 v, f32x4 bias) {
            const int blk = u.pn >> 2, c = col & 1023; const bool dec = blk < 2;
            const size_t doff = (size_t)(dec ? blk : blk - 2) * NROW * D + (size_t)row * D + c;
            const f32x4 x = v + bias; f32x4 o;
#pragma unroll
            for (int e = 0; e < 4; ++e) { const float sg = __builtin_amdgcn_rcpf(1.f + __expf(-x[e])); o[e] = dec ? (-0.6065306597126334f * sg) : sg; }
            if (dec) *(f32x4*)(W + doff) = o; else stbf4(AV + doff, o); },
            [=](const g8::Unit& u, int col) { const int blk = u.pn >> 2, c = col & 1023; return *(const f32x4*)((blk < 2 ? w0 + blk * D : a0 + (blk - 2) * D) + c); }));
        g8::BatchSched S2{ws + OFF_A3, ws + OFF_WRW + j * SZ_WRW + WR_B3, 0, 0, NROW / 256, first ? 4 : 8, 1, 256};
        g8::gemm_phase(p.wv, (PG8_LAS unsigned char*)lds, 256, S2, g8::epi_rc([=](const g8::Unit&, int row, int col, f32x4 v) {
            if (col < 1024) stbf4(G + (size_t)row * D + col, v);
            else { const int c = col - 1024; const size_t o = (size_t)row * D + c; const f32x4 vv = ldbf4(RKV + (size_t)2 * NROW * D + o), vf = ldbf4(VF + o), gz = v + *(const f32x4*)(v0 + c); f32x4 r;
#pragma unroll
                for (int e = 0; e < 4; ++e) r[e] = vv[e] + (vf[e] - vv[e]) * __builtin_amdgcn_rcpf(1.f + __expf(-gz[e]));
                stbf4(RKV + (size_t)2 * NROW * D + o, r); } }));
    }
    else if constexpr (PH == PH_R_SCAN) ph_rw_scan(p, j, lds);
    else if constexpr (PH == PH_R_SC1) ph_rw_sc1(p, j, lds);
    else if constexpr (PH == PH_R_SC2) ph_rw_sc2(p, lds);
    else if constexpr (PH == PH_R_OUT) ph_rw_out(p, j, layer < 3 ? NROW : NLAT);
    else if constexpr (PH == PH_M_NORM) ph_norm2_router(p, layer, lds, layer < 3 ? NROW : NLAT);
    else if constexpr (PH == PH_M_SEL) { ph_select(p, lds, layer < 3 ? 128 : 64); __syncthreads(); ph_moe_cvt(p, layer, lds); }
    else if constexpr (PH == PH_M_GATHER) ph_gather(p, layer < 3 ? ESLOTS : NB * CAPL);
    else if constexpr (PH == PH_M_G1) {
        bf16_t* HID = (bf16_t*)(ws + OFF_HID);
        g8::BatchSched S{ws + OFF_XE, ws + OFF_W13T, (size_t)EPAD * D * 2, (size_t)2816 * D * 2, layer < 3 ? 9 : 8, 11, NE, D};
        g8::gemm_phase(p.wv, (PG8_LAS unsigned char*)lds, D, S, g8::epi_pair([=](const g8::Unit& u, int row, int col, f32x4 a, f32x4 b) {
            uint2 w; w.x = pk2(a[0] * __builtin_amdgcn_rcpf(1.f + __expf(-a[0])) * b[0], a[1] * __builtin_amdgcn_rcpf(1.f + __expf(-a[1])) * b[1]); w.y = pk2(a[2] * __builtin_amdgcn_rcpf(1.f + __expf(-a[2])) * b[2], a[3] * __builtin_amdgcn_rcpf(1.f + __expf(-a[3])) * b[3]);
            *(uint2*)(HID + ((size_t)u.g * EPAD + row) * FF + col) = w; }));
    }
    else if constexpr (PH == PH_M_G2) {
        bf16_t* YE = (bf16_t*)(ws + OFF_YE); const float* GATE = (const float*)(ws + OFF_GATE);
        g8::BatchSched S{ws + OFF_HID, ws + OFF_W2T, (size_t)EPAD * FF * 2, (size_t)D * FF * 2, layer < 3 ? 9 : 8, 4, NE, FF};
        g8::gemm_phase(p.wv, (PG8_LAS unsigned char*)lds, FF, S, g8::epi_pre([=](const g8::Unit& u, int row, int col, f32x4 v, f32x4, float gt) {
            uint2 w; w.x = pk2(v[0] * gt, v[1] * gt); w.y = pk2(v[2] * gt, v[3] * gt);
            *(uint2*)(YE + ((size_t)u.g * EPAD + row) * D + col) = w; },
            [=](const g8::Unit&, int) { return (f32x4){0.f, 0.f, 0.f, 0.f}; }, [=](const g8::Unit& u, int row) { return GATE[u.g * EPAD + row]; }));
    }
    else if constexpr (PH == PH_M_COMB) ph_combine(p, layer, layer < 3 ? NROW : NLAT);
    else if constexpr (PH == PH_M_CVT) ph_moe_cvt(p, layer, lds);
    else if constexpr (PH == PH_FINAL) ph_comb_norm<true>(p, 3, 0, NLAT);
}

#if ONE_LAUNCH
#define SYNC() xcd_barrier(bar)
#ifndef PROBE_PH
#define PROBE_PH -1
#endif
#ifndef PROBE_REP
#define PROBE_REP 1
#endif
__device__ __forceinline__ Params load_params() {
    Params q{};
#if defined(__HIP_DEVICE_COMPILE__)
    typedef const __attribute__((address_space(4))) unsigned long long* KargP;
    KargP kp_ = (KargP)__builtin_amdgcn_kernarg_segment_ptr(); asm volatile("" : "+s"(kp_));
#pragma unroll
    for (int i = 0; i < 40; ++i) ((const float**)&q)[i] = (const float*)(const __attribute__((address_space(1))) float*)kp_[i];
#endif
    return q;
}
#define RUN(PH) do { for (int rep_ = 0; rep_ < ((PH) == PROBE_PH ? PROBE_REP : 1); ++rep_) { Params q = load_params(); q.wv = wv0_; run_phase<PH>(q, layer, smem); SYNC(); } } while (0)
__global__ void __launch_bounds__(NTHR, 2) mega(Params p) {
    extern __shared__ __attribute__((aligned(16))) char smem[];
    const int wv0_ = __builtin_amdgcn_readfirstlane((int)threadIdx.x >> 6);
    if (threadIdx.x == 0) *(uint4*)(smem + LDS_BYTES) = make_uint4(0u, 0u, 0u, 0u);
    __syncthreads();
    XcdBarrier bar = xcd_barrier_post((unsigned*)(p.ws + OFF_BAR), (volatile LAS unsigned*)(smem + LDS_BYTES));
    { const int layer = 0; RUN(PH_INIT); }
    for (int layer = 0; layer < 4; ++layer) {
        if ((layer & 1) == 0) {
            RUN(PH_A_NORM);
            RUN(PH_A_Z);
            RUN(PH_A_MID);
            RUN(PH_A_QKV);
            RUN(PH_A_ATTN);
            RUN(PH_A_WO);
        } else {
            RUN(PH_R_XS);
            RUN(PH_R_G1);
            RUN(PH_R_G2);
            RUN(PH_R_SC1);
            RUN(PH_R_SC2);
            RUN(PH_R_OUT);
            RUN(PH_R_WO);
        }
        RUN(PH_M_NORM);
        RUN(PH_M_SEL);
        RUN(PH_M_G1);
        RUN(PH_M_G2);
        if ((layer & 1) == 0) RUN(PH_M_COMB);
    }
    { Params q = load_params(); q.wv = wv0_; run_phase<PH_FINAL>(q, 0, smem); }
}
#else
template <int PH> __global__ void __launch_bounds__(NTHR, 2) kph(Params p, int layer) {
    extern __shared__ __attribute__((aligned(16))) char smem[];
    Params q = p; q.wv = __builtin_amdgcn_readfirstlane((int)threadIdx.x >> 6);
    run_phase<PH>(q, layer, smem);
}
#endif

extern "C" void kernel_launch(void* const* d_in, const int* in_sizes, int n_in, void* d_out, int out_size, void* d_ws, size_t ws_size, hipStream_t stream) {
    if (n_in != 38 || ws_size < WS_NEED) { fprintf(stderr, "kernel_launch: bad args n_in %d ws %zu need %zu\n", n_in, ws_size, (size_t)WS_NEED); return; }
    Params p{};
    const float** pp = (const float**)&p;
    for (int i = 0; i < 38; ++i) pp[i] = (const float*)d_in[i];
    p.out = (float*)d_out; p.ws = (char*)d_ws;
    static int cus = 0;
    if (!cus) { int dev = 0; hipGetDevice(&dev); hipDeviceGetAttribute(&cus, hipDeviceAttributeMultiprocessorCount, dev); if (cus <= 0) cus = 256; }
    const int grid = cus;
#if ONE_LAUNCH
    hipFuncSetAttribute((const void*)mega, hipFuncAttributeMaxDynamicSharedMemorySize, LDS_BYTES + 16);
    hipMemsetAsync(d_ws, 0, 16384, stream);
    hipLaunchKernelGGL(mega, dim3(grid), dim3(NTHR), LDS_BYTES + 16, stream, p);
#else
    hipMemsetAsync(d_ws, 0, 16384, stream);
#define LAUNCH(PH, L) do { hipFuncSetAttribute((const void*)kph<PH>, hipFuncAttributeMaxDynamicSharedMemorySize, LDS_BYTES + 16); hipLaunchKernelGGL(kph<PH>, dim3(grid), dim3(NTHR), LDS_BYTES + 16, stream, p, L); } while (0)
    LAUNCH(PH_INIT, 0);
    for (int layer = 0; layer < 4; ++layer) {
        if ((layer & 1) == 0) { LAUNCH(PH_A_NORM, layer); LAUNCH(PH_A_Z, layer); LAUNCH(PH_A_MID, layer); LAUNCH(PH_A_QKV, layer); LAUNCH(PH_A_ATTN, layer); LAUNCH(PH_A_WO, layer); }
        else { LAUNCH(PH_R_XS, layer); LAUNCH(PH_R_G1, layer); LAUNCH(PH_R_G2, layer); LAUNCH(PH_R_SC1, layer); LAUNCH(PH_R_SC2, layer); LAUNCH(PH_R_OUT, layer); LAUNCH(PH_R_WO, layer); }
        LAUNCH(PH_M_NORM, layer); LAUNCH(PH_M_SEL, layer); LAUNCH(PH_M_G1, layer); LAUNCH(PH_M_G2, layer); if ((layer & 1) == 0) LAUNCH(PH_M_COMB, layer);
    }
    LAUNCH(PH_FINAL, 0);
#endif
}
```

```cpp
#include <hip/hip_runtime.h>
#include <stdint.h>
#include <stdio.h>

#ifndef ONE_LAUNCH
#define ONE_LAUNCH 1
#endif

#define NTHR 512
typedef unsigned short bf16_t;
typedef short bf16x8 __attribute__((ext_vector_type(8)));
typedef float f32x4 __attribute__((ext_vector_type(4)));
typedef unsigned u32x4 __attribute__((ext_vector_type(4)));
typedef unsigned u32x2 __attribute__((ext_vector_type(2)));

constexpr int D = 1024, NB = 4, TL = 4096, TC = 256, NLAT = NB * TL, NCTX = NB * TC, NROW = NLAT + NCTX;
constexpr int TK = TL + TC;
constexpr int NE = 16, FF = 1408, CAPL = 512, CAPC = 32, ESLOTS = NB * CAPL + NB * CAPC;
constexpr int EPAD = 2304;
constexpr float RMS_EPS = 1e-6f, LNX_EPS = 64e-5f;
constexpr float ATT_SCALE = 0.07216878364870322f;

constexpr size_t al256(size_t x) { return (x + 255) / 256 * 256; }
constexpr size_t OFF_BAR = 0;
constexpr size_t OFF_QUEUE = 14336;
constexpr size_t OFF_MOD = 16384;
constexpr size_t OFF_ROPE_C = OFF_MOD + al256(4 * 5 * 6144 * 4);
constexpr size_t OFF_ROPE_S = OFF_ROPE_C + al256(TL * 32 * 4);
constexpr size_t OFF_X = OFF_ROPE_S + al256(TL * 32 * 4);
constexpr size_t SZ_F32 = (size_t)NROW * D * 4, SZ_BF = (size_t)NROW * D * 2;
constexpr size_t OFF_VFIRST = OFF_X + SZ_F32;
constexpr size_t OFF_H = OFF_VFIRST + SZ_F32;
constexpr size_t SZ_WMLA = (size_t)(512 * 1024 + 1536 * 256 + 2048 * 256 + 1024 * 1024) * 2;
constexpr size_t WM_IN = 0, WM_UQ = (size_t)512 * 1024 * 2, WM_UKV = WM_UQ + (size_t)1536 * 256 * 2, WM_O = WM_UKV + (size_t)2048 * 256 * 2;
constexpr size_t SZ_WRW = (size_t)(3 * 1024 * 1024 + 4 * 256 * 1024 + 1024 * 1024 + 4096 * 256 + 2048 * 256) * 2;
constexpr size_t WR_RKV = 0, WR_L = (size_t)3 * 1024 * 1024 * 2, WR_O = WR_L + (size_t)4 * 256 * 1024 * 2, WR_B2 = WR_O + (size_t)1024 * 1024 * 2, WR_B3 = WR_B2 + (size_t)4096 * 256 * 2;
constexpr size_t OFF_WMLA = OFF_H + SZ_BF;
constexpr size_t OFF_WRW = OFF_WMLA + 2 * SZ_WMLA;
constexpr size_t OFF_W13T = OFF_WRW + 2 * SZ_WRW;
constexpr size_t OFF_W2T = OFF_W13T + (size_t)NE * 2816 * D * 2;
constexpr size_t OFF_S = OFF_W2T + (size_t)NE * D * FF * 2;
constexpr size_t OFF_Z = OFF_S;
constexpr size_t OFF_CQN = OFF_Z + al256((size_t)NROW * 512 * 4);
constexpr size_t OFF_CKVN = OFF_CQN + al256((size_t)NROW * 256 * 2);
constexpr size_t OFF_KR = OFF_CKVN + al256((size_t)NROW * 256 * 2);
constexpr size_t OFF_QRAW = OFF_KR + al256((size_t)NROW * 64 * 4);
constexpr size_t OFF_KVRAW = OFF_QRAW + al256((size_t)NROW * 1536 * 4);
constexpr size_t OFF_Q = OFF_KVRAW + al256((size_t)NROW * 2048 * 4);
constexpr size_t OFF_K = OFF_Q + al256((size_t)NB * 8 * TK * 192 * 2);
constexpr size_t OFF_V = OFF_K + al256((size_t)NB * 8 * TK * 192 * 2);
constexpr size_t OFF_O = OFF_V + al256((size_t)NB * 8 * TK * 128 * 2);
constexpr size_t END_MLA = OFF_O + SZ_BF;
constexpr size_t OFF_XS = OFF_S;
constexpr size_t OFF_RKV = OFF_XS + 6 * SZ_BF;
constexpr size_t OFF_W = OFF_RKV + 3 * SZ_F32;
constexpr size_t OFF_AV = OFF_W + 2 * SZ_F32;
constexpr size_t OFF_G = OFF_AV + 2 * SZ_F32;
constexpr size_t OFF_A2 = OFF_G + SZ_F32;
constexpr size_t OFF_A3 = OFF_A2 + al256((size_t)NROW * 256 * 2);
constexpr size_t END_RW = OFF_A3 + al256((size_t)NROW * 256 * 2);
constexpr size_t OFF_Y = OFF_XS;
constexpr int NCHK = (TC + TL) / 64;
constexpr size_t OFF_CK = END_RW;
constexpr size_t END_RW2 = OFF_CK + (size_t)128 * NCHK * 4 * 4096 * 2;
constexpr size_t OFF_AFF = OFF_S;
constexpr size_t OFF_ROWIDX = OFF_AFF + al256((size_t)NROW * 16 * 4);
constexpr size_t OFF_GATE = OFF_ROWIDX + al256((size_t)NE * ESLOTS * 4);
constexpr size_t OFF_SLOT = OFF_GATE + al256((size_t)NE * EPAD * 4);
constexpr size_t OFF_XE = OFF_SLOT + al256((size_t)NROW * 16 * 4);
constexpr size_t OFF_HID = OFF_XE + al256((size_t)NE * EPAD * D * 2);
constexpr size_t OFF_YE = OFF_HID + al256((size_t)NE * EPAD * FF * 2);
constexpr size_t END_MOE = OFF_YE + al256((size_t)NE * EPAD * D * 2);
constexpr size_t WS_NEED = END_RW2 > END_MLA ? (END_RW2 > END_MOE ? END_RW2 : END_MOE) : (END_MLA > END_MOE ? END_MLA : END_MOE);

constexpr int LDS_BYTES = 152064;

struct Params {
    const float *x, *c, *ctx, *c_ctx, *mod_w, *mod_b, *norm1_g, *norm2_g, *final_g;
    const float *mla_w_in, *mla_g_q, *mla_g_kv, *mla_w_uq, *mla_w_ukv, *mla_w_o;
    const float *rw_mu, *rw_w_rkv, *rw_w0, *rw_w1, *rw_w2, *rw_a0, *rw_a1, *rw_a2, *rw_v0, *rw_v1, *rw_v2, *rw_g1, *rw_g2, *rw_k_k, *rw_k_a, *rw_r_k, *rw_lnx_g, *rw_lnx_b, *rw_w_o;
    const float *moe_router, *moe_w1, *moe_w3, *moe_w2;
    float* out; char* ws;
    int wv, pad_;
};

__device__ __forceinline__ int bidx() { int t = blockIdx.x; asm volatile("" : "+s"(t)); return t; }
__device__ __forceinline__ int gdim() { int t = gridDim.x; asm volatile("" : "+s"(t)); return t; }
__device__ __forceinline__ int tidx_w(int wv) { int l; asm volatile("v_mbcnt_lo_u32_b32 %0, -1, 0\n\tv_mbcnt_hi_u32_b32 %0, -1, %0" : "=v"(l)); return (wv << 6) | l; }
#define tidx() tidx_w(p.wv)
#define XB_TMO      128
#define XB_XCNT(j)  (256  + 64 * (j))
#define XB_XSUB(j)  (1280 + 64 * (j))
#define XB_XGEN(j)  (2304 + 64 * (j))
#define XB_TOP      3328
#define XB_TOPGEN   3392
#define XCD_BAR_WORDS 3456
#define XB_SPIN_CAP (1u << 22)
#define LAS __attribute__((address_space(3)))

__device__ __forceinline__ unsigned xb_ld(unsigned* p)              { return __hip_atomic_load(p, __ATOMIC_RELAXED, __HIP_MEMORY_SCOPE_AGENT); }
__device__ __forceinline__ unsigned xb_add(unsigned* p, unsigned v) { return __hip_atomic_fetch_add(p, v, __ATOMIC_RELAXED, __HIP_MEMORY_SCOPE_AGENT); }
__device__ __forceinline__ unsigned xb_xcc_id() { return (unsigned)__builtin_amdgcn_s_getreg((3 << 11) | 20) & 0xFu; }
#define XB_SPIN(cond, bar) do { unsigned _sp = 0; while (cond) { __builtin_amdgcn_s_sleep(1); \
    if ((++_sp & 255u) == 0u) { if (xb_ld(&(bar)[XB_TMO])) break; if (_sp > XB_SPIN_CAP) { atomicAdd(&(bar)[XB_TMO], 1u); break; } } } } while (0)

struct XcdBarrier { unsigned* bar; unsigned x; volatile LAS unsigned* st; };

__device__ __forceinline__ XcdBarrier xcd_barrier_post(unsigned* bar, volatile LAS unsigned* st) {
    XcdBarrier b; b.bar = bar; b.x = xb_xcc_id(); b.st = st;
    if (threadIdx.x == 0) (void)xb_add(&bar[XB_XCNT(b.x)], 1u);
    return b;
}
__device__ __forceinline__ void xcd_barrier_complete(unsigned* bar, unsigned x, unsigned& nloc, unsigned& nx) {
    const unsigned G = gridDim.x * gridDim.y * gridDim.z;
    unsigned sum, cnt, mine, sp = 0u;
    for (;;) {
        sum = 0u; cnt = 0u; mine = 0u;
#pragma unroll
        for (unsigned j = 0; j < 16; ++j) { const unsigned c = xb_ld(&bar[XB_XCNT(j)]); sum += c; cnt += (c > 0u) ? 1u : 0u; mine = (j == x) ? c : mine; }
        if (sum == G) break;
        __builtin_amdgcn_s_sleep(1);
        if ((++sp & 255u) == 0u) { if (xb_ld(&bar[XB_TMO])) break; if (sp > XB_SPIN_CAP) { atomicAdd(&bar[XB_TMO], 1u); break; } }
    }
    nloc = mine > 0u ? mine : 1u; nx = cnt > 0u ? cnt : 1u;
}
__device__ __forceinline__ void xcd_barrier(const XcdBarrier& b) {
    asm volatile("s_waitcnt vmcnt(0)" ::: "memory");
    __syncthreads();
    if (threadIdx.x == 0) {
        unsigned* bar = b.bar;
        __builtin_amdgcn_s_waitcnt(0);
        unsigned nloc = b.st[0], nx = b.st[1];
        if (nloc == 0u) { xcd_barrier_complete(bar, b.x, nloc, nx); b.st[0] = nloc; b.st[1] = nx; }
        const unsigned old = xb_add(&bar[XB_XSUB(b.x)], 1u);
        const unsigned gen = old / nloc;
        if (old + 1u == (gen + 1u) * nloc) {
            __builtin_amdgcn_fence(__ATOMIC_RELEASE, "agent");
            asm volatile("s_waitcnt vmcnt(0)" ::: "memory");
            const unsigned og = xb_add(&bar[XB_TOP], 1u);
            const unsigned tg = og / nx;
            if (og + 1u == (tg + 1u) * nx) xb_add(&bar[XB_TOPGEN], 1u);
            else XB_SPIN(xb_ld(&bar[XB_TOPGEN]) == tg, bar);
            __builtin_amdgcn_fence(__ATOMIC_ACQUIRE, "agent");
            xb_add(&bar[XB_XGEN(b.x)], 1u);
            asm volatile("s_waitcnt vmcnt(0)" ::: "memory");
        } else {
            XB_SPIN(xb_ld(&bar[XB_XGEN(b.x)]) == gen, bar);
            __builtin_amdgcn_fence(__ATOMIC_ACQUIRE, "agent");
            asm volatile("s_waitcnt vmcnt(0)" ::: "memory");
        }
    }
    __syncthreads();
}

__device__ __forceinline__ float bf2f(bf16_t b) { return __uint_as_float(((unsigned)b) << 16); }
typedef float f32x2_ __attribute__((ext_vector_type(2)));
typedef __bf16 bf16x2_ __attribute__((ext_vector_type(2)));
__device__ __forceinline__ unsigned pk2(float lo, float hi) { const f32x2_ v = {lo, hi}; return __builtin_bit_cast(unsigned, __builtin_convertvector(v, bf16x2_)); }
__device__ __forceinline__ bf16_t f2bf(float f) { return (bf16_t)(pk2(f, f) & 0xffffu); }
__device__ __forceinline__ float dpp_sum16(float x) {
    x += __builtin_bit_cast(float, __builtin_amdgcn_update_dpp(0, __builtin_bit_cast(int, x), 0xB1, 0xF, 0xF, true));
    x += __builtin_bit_cast(float, __builtin_amdgcn_update_dpp(0, __builtin_bit_cast(int, x), 0x4E, 0xF, 0xF, true));
    x += __builtin_bit_cast(float, __builtin_amdgcn_update_dpp(0, __builtin_bit_cast(int, x), 0x141, 0xF, 0xF, true));
    x += __builtin_bit_cast(float, __builtin_amdgcn_update_dpp(0, __builtin_bit_cast(int, x), 0x140, 0xF, 0xF, true));
    return x;
}
__device__ __forceinline__ f32x4 ldbf4(const bf16_t* p) { const uint2 w = *(const uint2*)p; return (f32x4){__uint_as_float(w.x << 16), __uint_as_float(w.x & 0xffff0000u), __uint_as_float(w.y << 16), __uint_as_float(w.y & 0xffff0000u)}; }
__device__ __forceinline__ void stbf4(bf16_t* p, f32x4 v) { uint2 w; w.x = pk2(v[0], v[1]); w.y = pk2(v[2], v[3]); *(uint2*)p = w; }
typedef bf16_t xt_t;
__device__ __forceinline__ f32x4 xldv(const xt_t* X, size_t i) { return ldbf4(X + i); }
__device__ __forceinline__ void xstv(xt_t* X, size_t i, f32x4 v) { stbf4(X + i, v); }
__device__ __forceinline__ float4 xld(const xt_t* X, size_t i) { const f32x4 v = ldbf4(X + i); return make_float4(v[0], v[1], v[2], v[3]); }
__device__ __forceinline__ void xst(xt_t* X, size_t i, float4 v) { stbf4(X + i, (f32x4){v.x, v.y, v.z, v.w}); }
__device__ __forceinline__ float wave_sum(float v) {
    v = dpp_sum16(v); const int i = __builtin_bit_cast(int, v);
    return __builtin_bit_cast(float, __builtin_amdgcn_readlane(i, 0)) + __builtin_bit_cast(float, __builtin_amdgcn_readlane(i, 16)) + __builtin_bit_cast(float, __builtin_amdgcn_readlane(i, 32)) + __builtin_bit_cast(float, __builtin_amdgcn_readlane(i, 48));
}
__device__ __forceinline__ float sigmoidf_(float x) { return __builtin_amdgcn_rcpf(1.f + __expf(-x)); }
__device__ __forceinline__ int row_stream(int row) { return row < NLAT ? (row >> 12) : 4; }
__device__ __forceinline__ const float* modp(const Params& p, int layer, int s, int part) { return (const float*)(p.ws + OFF_MOD) + ((size_t)layer * 5 + s) * 6144 + part * 1024; }

struct SgArgs { const bf16_t* A; int lda; size_t strideA; const float* B; int ldb; size_t strideB; int M, N, K, nbatch; };
template <class Epi>
__device__ __forceinline__ void sg_gemm(const Params& p, char* lds, const SgArgs g, const Epi& epi) {
    bf16_t* As = (bf16_t*)lds;
    bf16_t* Bs = As + 128 * 40;
    const int tid = tidx(), wid = tid >> 6, lane = tid & 63;
    const int wr = wid >> 2, wc = wid & 3;
    const int tilesN = (g.N + 127) / 128, tilesM = g.M / 128, per = tilesM * tilesN, ntiles = per * g.nbatch;
    const int ar = tid >> 2, ak = (tid & 3) * 8;
    const int bn = tid & 127, bk = (tid >> 7) * 8;
    for (int tile = bidx(); tile < ntiles; tile += gdim()) {
        const int bt = tile / per, tt = tile % per;
        const int tm = tt / tilesN, tn = tt % tilesN;
        const int m0 = tm * 128, n0 = tn * 128;
        f32x4 acc[4][2];
#pragma unroll
        for (int m = 0; m < 4; ++m)
#pragma unroll
            for (int n = 0; n < 2; ++n) acc[m][n] = (f32x4){0.f, 0.f, 0.f, 0.f};
        const bool bvalid = (n0 + bn) < g.N;
        const bf16_t* ap = g.A + bt * g.strideA + (size_t)(m0 + ar) * g.lda + ak;
        const float* bp = g.B + bt * g.strideB + (size_t)bk * g.ldb + n0 + bn;
        bf16x8 areg; float breg[8];
        areg = *(const bf16x8*)ap;
#pragma unroll
        for (int j = 0; j < 8; ++j) breg[j] = bvalid ? bp[(size_t)j * g.ldb] : 0.f;
        for (int k0 = 0; k0 < g.K; k0 += 32) {
            __syncthreads();
            *(bf16x8*)(As + ar * 40 + ak) = areg;
            { u32x4 w; w.x = pk2(breg[0], breg[1]); w.y = pk2(breg[2], breg[3]); w.z = pk2(breg[4], breg[5]); w.w = pk2(breg[6], breg[7]); *(u32x4*)(Bs + bn * 40 + bk) = w; }
            __syncthreads();
            if (k0 + 32 < g.K) {
                areg = *(const bf16x8*)(ap + k0 + 32);
#pragma unroll
                for (int j = 0; j < 8; ++j) breg[j] = bvalid ? bp[(size_t)(k0 + 32 + j) * g.ldb] : 0.f;
            }
            bf16x8 af[4], bfr[2];
#pragma unroll
            for (int m = 0; m < 4; ++m) af[m] = *(const bf16x8*)(As + (wr * 64 + m * 16 + (lane & 15)) * 40 + (lane >> 4) * 8);
#pragma unroll
            for (int n = 0; n < 2; ++n) bfr[n] = *(const bf16x8*)(Bs + (wc * 32 + n * 16 + (lane & 15)) * 40 + (lane >> 4) * 8);
#pragma unroll
            for (int m = 0; m < 4; ++m)
#pragma unroll
                for (int n = 0; n < 2; ++n) acc[m][n] = __builtin_amdgcn_mfma_f32_16x16x32_bf16(af[m], bfr[n], acc[m][n], 0, 0, 0);
        }
#pragma unroll
        for (int m = 0; m < 4; ++m)
#pragma unroll
            for (int n = 0; n < 2; ++n) {
                const int col = n0 + wc * 32 + n * 16 + (lane & 15);
                if (col < g.N) {
#pragma unroll
                    for (int r = 0; r < 4; ++r) epi(bt, m0 + wr * 64 + m * 16 + (lane >> 4) * 4 + r, col, acc[m][n][r]);
                }
            }
    }
}


namespace g8 {
#define PG8_LAS __attribute__((address_space(3)))
constexpr int BM = 256, BK = 64, HALF = 128, HTB = HALF * BK * 2, STAGE_BYTES = 8 * HTB;
__device__ __forceinline__ int lds_byte(int r, int c) { const int st = (r >> 4) * 2 + (c >> 5), rr = r & 15, cc = c & 31, ob = rr * 64 + cc * 2; return st * 1024 + (ob ^ (((ob >> 9) & 1) << 5)); }
__device__ __forceinline__ void stage_rc(int b, int& R, int& C) { const int st = b / 1024, sb = b % 1024, swz = sb ^ (((sb >> 9) & 1) << 5); R = (st >> 1) * 16 + swz / 64; C = (st & 1) * 32 + (swz % 64) / 2; }
struct Unit { int pm, pn, g; const char* A; const char* B; };
__device__ __forceinline__ int xcd_remap(int L, int nwg) { const int q = nwg / 8, r = nwg % 8, xcd = L % 8, off = L / 8; return (xcd < r ? xcd * (q + 1) : r * (q + 1) + (xcd - r) * q) + off; }

template <class Epi, class Sched>
__device__ __forceinline__ void gemm_phase(const int wv_, PG8_LAS unsigned char* lds, const int K, const Sched& S, const Epi& E) {
    const int tid = tidx_w(wv_), wid = __builtin_amdgcn_readfirstlane(tid >> 6), lane = tid & 63, wr = wid >> 2, wc = wid & 3, fr = lane & 15, fq = lane >> 4;
    const int nt = K / BK;
    unsigned voffA[2];
#pragma unroll
    for (int i = 0; i < 2; ++i) { int R, C; stage_rc(tid * 16 + i * 8192, R, C); voffA[i] = (unsigned)(R * K + C) * 2u; }
    const size_t kstep = (size_t)(BK * 2);
    const size_t hstep = (size_t)HALF * K * 2;
    const unsigned ldsw = (unsigned)wid * 1024u;
    const int aoff = lds_byte(wr * 64 + fr, fq * 8), boff = lds_byte(wc * 32 + fr, fq * 8);
#define PG8_SA(b, h) (((b) * 2 + (h)) * HTB)
#define PG8_SB(b, h) ((4 + (b) * 2 + (h)) * HTB)
#define PG8_STAGE(bufoff, gbase, voff) do { _Pragma("unroll") for (int _i = 0; _i < 2; ++_i) \
        __builtin_amdgcn_global_load_lds((const unsigned*)((const char*)(gbase) + (voff)[_i]), (PG8_LAS unsigned*)(lds + (bufoff) + ldsw + _i * 8192), 16, 0, 0); } while (0)
#define PG8_LDA(dst, b, h) do { _Pragma("unroll") for (int m = 0; m < 4; ++m) _Pragma("unroll") for (int k = 0; k < 2; ++k) dst[m][k] = *(const PG8_LAS bf16x8*)(lds + PG8_SA(b, h) + aoff + m * 2048 + k * 1024); } while (0)
#define PG8_LDB(dst, b, h) do { _Pragma("unroll") for (int n = 0; n < 2; ++n) _Pragma("unroll") for (int k = 0; k < 2; ++k) dst[n][k] = *(const PG8_LAS bf16x8*)(lds + PG8_SB(b, h) + boff + n * 2048 + k * 1024); } while (0)
#define PG8_MMA(ai, bj, At, Bt) do { __builtin_amdgcn_s_setprio(1); _Pragma("unroll") for (int m = 0; m < 4; ++m) _Pragma("unroll") for (int n = 0; n < 2; ++n) _Pragma("unroll") for (int k = 0; k < 2; ++k) \
        acc[ai][bj][m][n] = __builtin_amdgcn_mfma_f32_16x16x32_bf16(Bt[n][k], At[m][k], acc[ai][bj][m][n], 0, 0, 0); __builtin_amdgcn_s_setprio(0); } while (0)
#define PG8_WAIT_V(n) asm volatile("s_waitcnt vmcnt(" #n ")" ::: "memory")
#define PG8_WAIT_L(n) asm volatile("s_waitcnt lgkmcnt(" #n ")" ::: "memory")
#define PG8_BAR __builtin_amdgcn_s_barrier()
#define PG8_SCHED __builtin_amdgcn_sched_barrier(0)
    Unit cur, nxt; int ui = 0;
    if (!S.next(0, cur)) return;
    f32x4 acc[2][2][4][2];
#pragma unroll
    for (int a = 0; a < 2; ++a)
#pragma unroll
        for (int b = 0; b < 2; ++b)
#pragma unroll
            for (int m = 0; m < 4; ++m)
#pragma unroll
                for (int n = 0; n < 2; ++n) acc[a][b][m][n] = (f32x4){0.f, 0.f, 0.f, 0.f};
    bf16x8 At[4][2], B0[2][2], B1[2][2];
    const char* cA = cur.A; const char* cB = cur.B;
    PG8_STAGE(PG8_SB(0, 0), cB, voffA); PG8_STAGE(PG8_SA(0, 0), cA, voffA); PG8_STAGE(PG8_SB(0, 1), cB + hstep, voffA); PG8_STAGE(PG8_SA(0, 1), cA + hstep, voffA);
    if (wr == 1) PG8_BAR;
    PG8_WAIT_V(4); PG8_BAR;
    PG8_STAGE(PG8_SB(1, 0), cB + kstep, voffA); PG8_STAGE(PG8_SA(1, 0), cA + kstep, voffA); PG8_STAGE(PG8_SB(1, 1), cB + hstep + kstep, voffA);
    PG8_WAIT_V(6); PG8_BAR;
    for (;;) {
        const bool has_next = S.next(ui + 1, nxt);
        const char* nA = has_next ? nxt.A : cA; const char* nB = has_next ? nxt.B : cB;
        for (int t = 0; t < nt; t += 2) {
            const bool last = (t == nt - 2);
            const char* a1 = cA + (size_t)(t + 1) * kstep;
            const char* a2 = last ? nA : cA + (size_t)(t + 2) * kstep; const char* b2 = last ? nB : cB + (size_t)(t + 2) * kstep;
            const char* a3 = a2 + kstep; const char* b3 = b2 + kstep;
            PG8_LDB(B0, 0, 0); PG8_SCHED; PG8_LDA(At, 0, 0); PG8_STAGE(PG8_SA(1, 1), a1 + hstep, voffA);
            PG8_WAIT_L(8); PG8_BAR; PG8_WAIT_L(0); PG8_MMA(0, 0, At, B0); PG8_BAR; PG8_SCHED;
            PG8_LDB(B1, 0, 1); PG8_STAGE(PG8_SB(0, 0), b2, voffA);
            PG8_BAR; PG8_WAIT_L(0); PG8_MMA(0, 1, At, B1); PG8_BAR;
            PG8_LDA(At, 0, 1); PG8_STAGE(PG8_SA(0, 0), a2, voffA);
            PG8_BAR; PG8_WAIT_L(0); PG8_MMA(1, 0, At, B0); PG8_BAR; PG8_SCHED;
            PG8_STAGE(PG8_SB(0, 1), b2 + hstep, voffA);
            PG8_WAIT_V(6); PG8_BAR; PG8_MMA(1, 1, At, B1); PG8_BAR;
            PG8_LDB(B0, 1, 0); PG8_SCHED; PG8_LDA(At, 1, 0); PG8_STAGE(PG8_SA(0, 1), a2 + hstep, voffA);
            PG8_WAIT_L(8); PG8_BAR; PG8_WAIT_L(0); PG8_MMA(0, 0, At, B0); PG8_BAR; PG8_SCHED;
            PG8_LDB(B1, 1, 1); PG8_STAGE(PG8_SB(1, 0), b3, voffA);
            PG8_BAR; PG8_WAIT_L(0); PG8_MMA(0, 1, At, B1); PG8_BAR;
            PG8_LDA(At, 1, 1); PG8_STAGE(PG8_SA(1, 0), a3, voffA);
            PG8_BAR; PG8_WAIT_L(0); PG8_MMA(1, 0, At, B0); PG8_BAR; PG8_SCHED;
            PG8_STAGE(PG8_SB(1, 1), b3 + hstep, voffA);
            PG8_WAIT_V(6); PG8_BAR; PG8_MMA(1, 1, At, B1); PG8_BAR;
        }
        E(acc, cur, wr, wc, fr, fq);
        if (!has_next) break;
#pragma unroll
        for (int a = 0; a < 2; ++a)
#pragma unroll
            for (int b = 0; b < 2; ++b)
#pragma unroll
                for (int m = 0; m < 4; ++m)
#pragma unroll
                    for (int n = 0; n < 2; ++n) acc[a][b][m][n] = (f32x4){0.f, 0.f, 0.f, 0.f};
        cur = nxt; cA = nA; cB = nB; ++ui;
    }
    PG8_WAIT_V(0);
    if (wr == 0) PG8_BAR;
    PG8_BAR;
#undef PG8_SA
#undef PG8_SB
#undef PG8_STAGE
#undef PG8_LDA
#undef PG8_LDB
#undef PG8_MMA
#undef PG8_WAIT_V
#undef PG8_WAIT_L
#undef PG8_BAR
#undef PG8_SCHED
}
template <class F> struct EpiRC { F f;
    __device__ __forceinline__ void operator()(const f32x4 (&acc)[2][2][4][2], const Unit& u, int wr, int wc, int fr, int fq) const {
#pragma unroll
        for (int ai = 0; ai < 2; ++ai)
#pragma unroll
            for (int m = 0; m < 4; ++m) { const int row = u.pm * BM + ai * HALF + wr * 64 + m * 16 + fr;
#pragma unroll
                for (int bj = 0; bj < 2; ++bj)
#pragma unroll
                    for (int n = 0; n < 2; ++n) f(u, row, u.pn * BM + bj * HALF + wc * 32 + n * 16 + 4 * fq, acc[ai][bj][m][n]);
                asm volatile("" ::: "memory"); }
    } };
template <class F> __device__ __forceinline__ EpiRC<F> epi_rc(const F& f) { return EpiRC<F>{f}; }
template <class F> struct EpiPair { F f;
    __device__ __forceinline__ void operator()(const f32x4 (&acc)[2][2][4][2], const Unit& u, int wr, int wc, int fr, int fq) const {
#pragma unroll
        for (int ai = 0; ai < 2; ++ai)
#pragma unroll
            for (int m = 0; m < 4; ++m) { const int row = u.pm * BM + ai * HALF + wr * 64 + m * 16 + fr;
#pragma unroll
                for (int n = 0; n < 2; ++n) f(u, row, u.pn * HALF + wc * 32 + n * 16 + 4 * fq, acc[ai][0][m][n], acc[ai][1][m][n]);
                asm volatile("" ::: "memory"); }
    } };
template <class F> __device__ __forceinline__ EpiPair<F> epi_pair(const F& f) { return EpiPair<F>{f}; }
template <class F, class CF, class RF> struct EpiPre { F f; CF cf; RF rf;
    __device__ __forceinline__ void operator()(const f32x4 (&acc)[2][2][4][2], const Unit& u, int wr, int wc, int fr, int fq) const {
        f32x4 cv[2][2]; float rv[2][4];
#pragma unroll
        for (int bj = 0; bj < 2; ++bj)
#pragma unroll
            for (int n = 0; n < 2; ++n) cv[bj][n] = cf(u, u.pn * BM + bj * HALF + wc * 32 + n * 16 + 4 * fq);
#pragma unroll
        for (int ai = 0; ai < 2; ++ai)
#pragma unroll
            for (int m = 0; m < 4; ++m) rv[ai][m] = rf(u, u.pm * BM + ai * HALF + wr * 64 + m * 16 + fr);
#pragma unroll
        for (int ai = 0; ai < 2; ++ai)
#pragma unroll
            for (int m = 0; m < 4; ++m) { const int row = u.pm * BM + ai * HALF + wr * 64 + m * 16 + fr;
#pragma unroll
                for (int bj = 0; bj < 2; ++bj)
#pragma unroll
                    for (int n = 0; n < 2; ++n) f(u, row, u.pn * BM + bj * HALF + wc * 32 + n * 16 + 4 * fq, acc[ai][bj][m][n], cv[bj][n], rv[ai][m]);
                asm volatile("" ::: "memory"); }
    } };
template <class F, class CF, class RF> __device__ __forceinline__ EpiPre<F, CF, RF> epi_pre(const F& f, const CF& cf, const RF& rf) { return EpiPre<F, CF, RF>{f, cf, rf}; }
template <class F, class CF> struct EpiColFirst { F f; CF cf;
    __device__ __forceinline__ void operator()(const f32x4 (&acc)[2][2][4][2], const Unit& u, int wr, int wc, int fr, int fq) const {
#pragma unroll
        for (int bj = 0; bj < 2; ++bj)
#pragma unroll
            for (int n = 0; n < 2; ++n) { const int col = u.pn * BM + bj * HALF + wc * 32 + n * 16 + 4 * fq; const f32x4 cv = cf(u, col);
#pragma unroll
                for (int ai = 0; ai < 2; ++ai)
#pragma unroll
                    for (int m = 0; m < 4; ++m) f(u, u.pm * BM + ai * HALF + wr * 64 + m * 16 + fr, col, acc[ai][bj][m][n], cv);
                asm volatile("" ::: "memory"); }
    } };
template <class F, class CF> __device__ __forceinline__ EpiColFirst<F, CF> epi_colfirst(const F& f, const CF& cf) { return EpiColFirst<F, CF>{f, cf}; }
struct EpiResid { xt_t* X; const float* MOD; int layer;
    __device__ __forceinline__ void operator()(const f32x4 (&acc)[2][2][4][2], const Unit& u, int wr, int wc, int fr, int fq) const {
        const int row0 = u.pm * BM + wr * 64 + fr, col0 = u.pn * BM + wc * 32 + 4 * fq;
        const int strm = row0 < NLAT ? (row0 >> 12) : 4;
        const float* gp = MOD + ((size_t)layer * 5 + strm) * 6144 + 2048 + col0;
        f32x4 gt[2][2];
#pragma unroll
        for (int bj = 0; bj < 2; ++bj)
#pragma unroll
            for (int n = 0; n < 2; ++n) gt[bj][n] = *(const f32x4*)(gp + bj * HALF + n * 16);
#pragma unroll
        for (int ai = 0; ai < 2; ++ai) {
            f32x4 xv[4][2][2];
#pragma unroll
            for (int m = 0; m < 4; ++m)
#pragma unroll
                for (int bj = 0; bj < 2; ++bj)
#pragma unroll
                    for (int n = 0; n < 2; ++n) xv[m][bj][n] = xldv(X, (size_t)(row0 + ai * HALF + m * 16) * D + col0 + bj * HALF + n * 16);
#pragma unroll
            for (int m = 0; m < 4; ++m)
#pragma unroll
                for (int bj = 0; bj < 2; ++bj)
#pragma unroll
                    for (int n = 0; n < 2; ++n) xstv(X, (size_t)(row0 + ai * HALF + m * 16) * D + col0 + bj * HALF + n * 16, xv[m][bj][n] + gt[bj][n] * acc[ai][bj][m][n]);
            asm volatile("" ::: "memory");
        }
    } };
struct BatchSched { const char* A; const char* B; size_t strideA, strideB; int nM, nN, nb, K;
    __device__ __forceinline__ bool next(int i, Unit& u) const {
        const int nwg = nM * nN * nb; const int L = i * gdim() + bidx(); if (L >= nwg) return false;
        const int w = xcd_remap(L, nwg); const int per = nM * nN; u.g = w / per; const int r = w % per; u.pm = r / nN; u.pn = r % nN;
        u.A = A + u.g * strideA + (size_t)u.pm * BM * K * 2; u.B = B + u.g * strideB + (size_t)u.pn * BM * K * 2; return true; } };
}

template <class SrcF, class DRow>
__device__ __forceinline__ void cvt_tiles(const int wv_, char* lds, bf16_t* dst, int Kd, int Nd, int nbatch, size_t dstride, const SrcF& src, const DRow& drow, unsigned* queue = nullptr) {
    bf16_t* T = (bf16_t*)lds;
    int* qslot = (int*)(lds + 64 * 136 * 2);
    const int tid = tidx_w(wv_);
    const int tk = Kd / 128, tn = Nd / 64, per = tk * tn, total = per * nbatch;
    constexpr int QG = 8;
    int t = queue ? 0 : bidx(), tnext = 0, sub = 0;
    if (queue) { if (tid == 0) { qslot[0] = QG * (int)__hip_atomic_fetch_add(queue, 1u, __ATOMIC_RELAXED, __HIP_MEMORY_SCOPE_AGENT); } __syncthreads(); t = qslot[0]; __syncthreads(); }
    while (t < total) {
        if (queue && sub == 0 && tid == 0) tnext = QG * (int)__hip_atomic_fetch_add(queue, 1u, __ATOMIC_RELAXED, __HIP_MEMORY_SCOPE_AGENT);
        const int bt = t / per, r = t % per, k0 = (r % tk) * 128, n0 = (r / tk) * 64;
        float4 v[4];
#pragma unroll
        for (int i = 0; i < 4; ++i) { const int k = k0 + i * 32 + (tid >> 4), n = n0 + (tid & 15) * 4; const float* sp = src(bt, k, n); v[i] = sp ? *(const float4*)sp : make_float4(0.f, 0.f, 0.f, 0.f); }
        __syncthreads();
#pragma unroll
        for (int i = 0; i < 4; ++i) { const int k = i * 32 + (tid >> 4), n = (tid & 15) * 4;
            T[(n + 0) * 136 + k] = f2bf(v[i].x); T[(n + 1) * 136 + k] = f2bf(v[i].y); T[(n + 2) * 136 + k] = f2bf(v[i].z); T[(n + 3) * 136 + k] = f2bf(v[i].w); }
        if (queue && sub == QG - 1 && tid == 0) qslot[0] = tnext;
        __syncthreads();
        { const int n = tid >> 3, kc = (tid & 7) * 16;
          const u32x4 a = *(const u32x4*)(T + n * 136 + kc), b = *(const u32x4*)(T + n * 136 + kc + 8);
          bf16_t* dp = dst + bt * dstride + (size_t)drow(n0 + n) * Kd + k0 + kc;
          *(u32x4*)dp = a; *(u32x4*)(dp + 8) = b; }
        if (queue) { if (++sub == QG) { sub = 0; t = qslot[0]; } else ++t; } else t += gdim();
    }
}
__device__ void ph_moe_cvt(const Params& p, int layer, char* lds) {
    const float* w1 = p.moe_w1 + (size_t)layer * NE * D * FF; const float* w3 = p.moe_w3 + (size_t)layer * NE * D * FF; const float* w2 = p.moe_w2 + (size_t)layer * NE * FF * D;
    cvt_tiles(p.wv, lds, (bf16_t*)(p.ws + OFF_W13T), D, 2816, NE, (size_t)2816 * D,
        [=](int e, int k, int n) -> const float* { const int pn = n >> 8, half = (n >> 7) & 1, c = pn * 128 + (n & 127); return (half ? w3 : w1) + ((size_t)e * D + k) * FF + c; },
        [=](int n) { return n; }, (unsigned*)(p.ws + OFF_QUEUE) + (layer * 2) * 16);
    cvt_tiles(p.wv, lds, (bf16_t*)(p.ws + OFF_W2T), FF, D, NE, (size_t)D * FF,
        [=](int e, int k, int n) -> const float* { return w2 + ((size_t)e * FF + k) * D + n; },
        [=](int n) { return n; }, (unsigned*)(p.ws + OFF_QUEUE) + (layer * 2 + 1) * 16);
}

__device__ void ph_init(const Params& p, char* lds) {
    const int tid = tidx(), gtid = bidx() * NTHR + tid, gsz = gdim() * NTHR;
    xt_t* Xs = (xt_t*)(p.ws + OFF_X);
    const float4* x4 = (const float4*)p.x; const float4* c4 = (const float4*)p.ctx;
    { constexpr int NQ = NROW * 256 / 4;
      auto srcv = [&](int k) { return k < NLAT * 256 ? x4[k] : c4[k - NLAT * 256]; };
      for (int i = gtid; i < NQ; i += gsz) { const float4 t0 = srcv(i), t1 = srcv(i + NQ), t2 = srcv(i + 2 * NQ), t3 = srcv(i + 3 * NQ); xst(Xs, (size_t)4 * i, t0); xst(Xs, (size_t)4 * (i + NQ), t1); xst(Xs, (size_t)4 * (i + 2 * NQ), t2); xst(Xs, (size_t)4 * (i + 3 * NQ), t3); } }
    float* rc = (float*)(p.ws + OFF_ROPE_C); float* rs = (float*)(p.ws + OFF_ROPE_S);
    for (int i = gtid; i < TL * 32; i += gsz) {
        const int t = i >> 5, f = i & 31; const float pos = (float)((f < 16) ? (t >> 6) : (t & 63));
        const float inv = powf(10000.f, -(float)(f & 15) / 16.f); const float ang = pos * inv; rc[2 * i] = cosf(ang); rc[2 * i + 1] = sinf(ang);
    }
    float* sc = (float*)lds;
    float* red = sc + 5 * 1024;
    for (int i = tid; i < 5 * 1024; i += NTHR) { const float v = i < 4096 ? p.c[i] : p.c_ctx[i - 4096]; sc[i] = v / (1.f + expf(-v)); }
    __syncthreads();
    float* MOD = (float*)(p.ws + OFF_MOD);
    for (int item = bidx(); item < 4 * 96; item += gdim()) {
        const int l = item / 96, cg = item % 96, col = tid & 63, n = cg * 64 + col, kg = tid >> 6;
        const float* w = p.mod_w + ((size_t)l * 1024 + kg * 128) * 6144 + n;
        float a0 = 0, a1 = 0, a2 = 0, a3 = 0, a4 = 0;
#pragma unroll 16
        for (int k = 0; k < 128; ++k) { const float wv = w[(size_t)k * 6144]; const int kk = kg * 128 + k;
            a0 += sc[kk] * wv; a1 += sc[1024 + kk] * wv; a2 += sc[2048 + kk] * wv; a3 += sc[3072 + kk] * wv; a4 += sc[4096 + kk] * wv; }
        float* rr = red + (kg * 64 + col) * 5; rr[0] = a0; rr[1] = a1; rr[2] = a2; rr[3] = a3; rr[4] = a4;
        __syncthreads();
        if (tid < 320) { const int c2 = tid & 63, s = tid >> 6; float sum = 0;
            for (int q = 0; q < 8; ++q) sum += red[(q * 64 + c2) * 5 + s];
            MOD[((size_t)l * 5 + s) * 6144 + cg * 64 + c2] = sum + p.mod_b[l * 6144 + cg * 64 + c2]; }
        __syncthreads();
    }
}


__device__ void ph_small_cvt(const Params& p, char* lds) {
    for (int j = 0; j < 2; ++j) {
        char* wm = p.ws + OFF_WMLA + j * SZ_WMLA; char* wr = p.ws + OFF_WRW + j * SZ_WRW;
        const float* w_in = p.mla_w_in + (size_t)j * D * 448; const float* w_uq = p.mla_w_uq + (size_t)j * 256 * 1536; const float* w_ukv = p.mla_w_ukv + (size_t)j * 128 * 2048; const float* w_o = p.mla_w_o + (size_t)j * D * D;
        cvt_tiles(p.wv, lds, (bf16_t*)(wm + WM_IN), 1024, 512, 1, 0, [=](int, int k, int n) -> const float* { return n < 448 ? w_in + (size_t)k * 448 + n : nullptr; },
                  [=](int n) { if (n < 384 || n >= 448) return n; const int jj = n - 384; return 384 + (jj < 32 ? 2 * jj : 2 * (jj - 32) + 1); });
        cvt_tiles(p.wv, lds, (bf16_t*)(wm + WM_UQ), 256, 1536, 1, 0, [=](int, int k, int n) -> const float* { return w_uq + (size_t)k * 1536 + n; },
                  [=](int n) { const int h = n / 192, d = n % 192; if (d < 128) return n; const int jj = d - 128; return h * 192 + 128 + (jj < 32 ? 2 * jj : 2 * (jj - 32) + 1); });
        cvt_tiles(p.wv, lds, (bf16_t*)(wm + WM_UKV), 256, 2048, 1, 0, [=](int, int k, int n) -> const float* { return k < 128 ? w_ukv + (size_t)k * 2048 + n : nullptr; }, [=](int n) { return n; });
        cvt_tiles(p.wv, lds, (bf16_t*)(wm + WM_O), 1024, 1024, 1, 0, [=](int, int k, int n) -> const float* { return w_o + (size_t)k * D + n; }, [=](int n) { return n; });
        const float* w_rkv = p.rw_w_rkv + (size_t)j * 3 * D * D; const float* w1 = p.rw_w1 + (size_t)j * 2 * D * 64; const float* a1 = p.rw_a1 + (size_t)j * 2 * D * 64;
        const float* g1 = p.rw_g1 + (size_t)j * D * 128; const float* v1 = p.rw_v1; const float* rwo = p.rw_w_o + (size_t)j * D * D;
        cvt_tiles(p.wv, lds, (bf16_t*)(wr + WR_RKV), 1024, 1024, 3, (size_t)D * D, [=](int m, int k, int n) -> const float* { return w_rkv + ((size_t)m * D + k) * D + n; }, [=](int n) { return n; });
        cvt_tiles(p.wv, lds, (bf16_t*)(wr + WR_L), 1024, 256, 1, 0, [=](int, int k, int n) -> const float* { return n < 128 ? w1 + ((size_t)(n >> 6) * D + k) * 64 + (n & 63) : nullptr; }, [=](int n) { return n; });
        cvt_tiles(p.wv, lds, (bf16_t*)(wr + WR_L) + 256 * 1024, 1024, 256, 1, 0, [=](int, int k, int n) -> const float* { return n < 128 ? a1 + ((size_t)(n >> 6) * D + k) * 64 + (n & 63) : nullptr; }, [=](int n) { return n; });
        cvt_tiles(p.wv, lds, (bf16_t*)(wr + WR_L) + 2 * 256 * 1024, 1024, 256, 1, 0, [=](int, int k, int n) -> const float* { return n < 128 ? g1 + (size_t)k * 128 + n : nullptr; }, [=](int n) { return n; });
        cvt_tiles(p.wv, lds, (bf16_t*)(wr + WR_L) + 3 * 256 * 1024, 1024, 256, 1, 0, [=](int, int k, int n) -> const float* { return n < 32 ? v1 + (size_t)k * 32 + n : nullptr; }, [=](int n) { return n; });
        cvt_tiles(p.wv, lds, (bf16_t*)(wr + WR_O), 1024, 1024, 1, 0, [=](int, int k, int n) -> const float* { return rwo + (size_t)k * D + n; }, [=](int n) { return n; });
        const float* w2 = p.rw_w2 + (size_t)j * 2 * 64 * D; const float* a2 = p.rw_a2 + (size_t)j * 2 * 64 * D; const float* g2 = p.rw_g2 + (size_t)j * 128 * D; const float* v2 = p.rw_v2;
        cvt_tiles(p.wv, lds, (bf16_t*)(wr + WR_B2), 256, 4096, 1, 0, [=](int, int k, int n) -> const float* { const int blk = n >> 10, c = n & 1023, l = k - blk * 64;
            if (l < 0 || l >= 64) return nullptr; return (blk < 2 ? w2 + ((size_t)blk * 64 + l) * D : a2 + ((size_t)(blk - 2) * 64 + l) * D) + c; }, [=](int n) { return n; });
        cvt_tiles(p.wv, lds, (bf16_t*)(wr + WR_B3), 256, 2048, 1, 0, [=](int, int k, int n) -> const float* {
            if (n < 1024) return k < 128 ? g2 + (size_t)k * D + n : nullptr; return (k >= 128 && k < 160) ? v2 + (size_t)(k - 128) * D + (n - 1024) : nullptr; }, [=](int n) { return n; });
    }
}

template <bool OUTF32>
__device__ void ph_norm_mod(const Params& p, int layer, const float* g, int part_sh, int part_sc, void* outp) {
    const int wid = tidx() >> 6, lane = tidx() & 63;
    const xt_t* X = (const xt_t*)(p.ws + OFF_X);
    int row = bidx() * 8 + wid;
    float4 nv[4];
    if (row < NROW) {
#pragma unroll
        for (int i = 0; i < 4; ++i) nv[i] = xld(X, (size_t)row * D + (lane + i * 64) * 4); }
    for (; row < NROW; row += gdim() * 8) {
        const int s = row_stream(row);
        const float* sh = modp(p, layer, s, part_sh); const float* sc = modp(p, layer, s, part_sc);
        float4 v[4]; float ss = 0;
#pragma unroll
        for (int i = 0; i < 4; ++i) { v[i] = nv[i]; ss += v[i].x * v[i].x + v[i].y * v[i].y + v[i].z * v[i].z + v[i].w * v[i].w; }
        { const int nrow = row + gdim() * 8;
          if (nrow < NROW) {
#pragma unroll
              for (int i = 0; i < 4; ++i) nv[i] = xld(X, (size_t)nrow * D + (lane + i * 64) * 4); } }
        ss = wave_sum(ss); const float rs = rsqrtf(ss * (1.f / D) + RMS_EPS);
#pragma unroll
        for (int i = 0; i < 4; ++i) {
            const int d = (lane + i * 64) * 4;
            const float4 gg = *(const float4*)(g + d), a = *(const float4*)(sc + d), b = *(const float4*)(sh + d);
            float4 o; o.x = v[i].x * rs * gg.x * (1.f + a.x) + b.x; o.y = v[i].y * rs * gg.y * (1.f + a.y) + b.y; o.z = v[i].z * rs * gg.z * (1.f + a.z) + b.z; o.w = v[i].w * rs * gg.w * (1.f + a.w) + b.w;
            if (OUTF32) *(float4*)((float*)outp + (size_t)row * D + d) = o;
            else { uint2 w; w.x = pk2(o.x, o.y); w.y = pk2(o.z, o.w); *(uint2*)((bf16_t*)outp + (size_t)row * D + d) = w; }
        }
    }
}

__device__ void ph_mla_mid(const Params& p, int j) {
    const int wid = tidx() >> 6, lane = tidx() & 63;
    const float* Z = (const float*)(p.ws + OFF_Z);
    bf16_t* CQN = (bf16_t*)(p.ws + OFF_CQN); bf16_t* CKVN = (bf16_t*)(p.ws + OFF_CKVN); bf16_t* K = (bf16_t*)(p.ws + OFF_K);
    const float* gq = p.mla_g_q + j * 256; const float* gkv = p.mla_g_kv + j * 128;
    const float* rc = (const float*)(p.ws + OFF_ROPE_C); const float* rs = (const float*)(p.ws + OFF_ROPE_S);
    for (int row = bidx() * 8 + wid; row < NROW; row += gdim() * 8) {
        const float* z = Z + (size_t)row * 512;
        const float4 q = *(const float4*)(z + lane * 4);
        const float2 kv = *(const float2*)(z + 256 + lane * 2);
        const float kr = z[384 + lane];
        float sq = wave_sum(q.x * q.x + q.y * q.y + q.z * q.z + q.w * q.w); const float rq = rsqrtf(sq * (1.f / 256.f) + RMS_EPS);
        float sk = wave_sum(kv.x * kv.x + kv.y * kv.y); const float rk = rsqrtf(sk * (1.f / 128.f) + RMS_EPS);
        const float4 g4 = *(const float4*)(gq + lane * 4); const float2 g2 = *(const float2*)(gkv + lane * 2);
        uint2 w; w.x = pk2(q.x * rq * g4.x, q.y * rq * g4.y); w.y = pk2(q.z * rq * g4.z, q.w * rq * g4.w);
        *(uint2*)(CQN + (size_t)row * 256 + lane * 4) = w;
        *(unsigned*)(CKVN + (size_t)row * 256 + lane * 2) = pk2(kv.x * rk * g2.x, kv.y * rk * g2.y);
        *(unsigned*)(CKVN + (size_t)row * 256 + 128 + lane * 2) = 0u;
        float o = kr;
        const float other = __builtin_bit_cast(float, __builtin_amdgcn_update_dpp(0, __builtin_bit_cast(int, kr), 0xB1, 0xF, 0xF, true));
        const bool lat = row < NLAT;
        if (lat) { const int t = row & (TL - 1), i = lane >> 1; const float2 cs = *(const float2*)(rc + (t * 32 + i) * 2); const float c = cs.x, s = cs.y;
            o = (lane & 1) ? (other * s + kr * c) : (kr * c - other * s); }
        const int b = lat ? (row >> 12) : ((row - NLAT) >> 8); const int tk = lat ? 256 + (row & (TL - 1)) : ((row - NLAT) & 255);
        const bf16_t ob = f2bf(o);
#pragma unroll
        for (int h = 0; h < 8; ++h) K[((size_t)(b * 8 + h) * TK + tk) * 192 + 128 + lane] = ob;
    }
}

__device__ void ph_qkv_post(const Params& p) {
    const int wid = tidx() >> 6, lane = tidx() & 63;
    const float* QRAW = (const float*)(p.ws + OFF_QRAW); const float* KVRAW = (const float*)(p.ws + OFF_KVRAW); const float* KR = (const float*)(p.ws + OFF_KR);
    bf16_t* Q = (bf16_t*)(p.ws + OFF_Q); bf16_t* K = (bf16_t*)(p.ws + OFF_K); bf16_t* V = (bf16_t*)(p.ws + OFF_V);
    const float* rc = (const float*)(p.ws + OFF_ROPE_C); const float* rs = (const float*)(p.ws + OFF_ROPE_S);
    for (int it = bidx() * 8 + wid; it < NROW * 8; it += gdim() * 8) {
        const int row = it >> 3, h = it & 7;
        const bool lat = row < NLAT; const int b = lat ? (row >> 12) : ((row - NLAT) >> 8); const int tk = lat ? 256 + (row & (TL - 1)) : ((row - NLAT) & 255);
        const size_t orow = (size_t)(b * 8 + h) * TK + tk;
        const float* q = QRAW + (size_t)row * 1536 + h * 192;
        const float q0 = q[lane], q1 = q[64 + lane]; float q2 = q[128 + lane];
        const auto sw = __builtin_amdgcn_permlane32_swap(__float_as_uint(q2), __float_as_uint(q2), false, false);
        if (lat) { const int t = row & (TL - 1), i = lane & 31; const float c = rc[t * 32 + i], s = rs[t * 32 + i];
            const float x1 = __uint_as_float(sw[0]), x2 = __uint_as_float(sw[1]); q2 = lane < 32 ? (x1 * c - x2 * s) : (x1 * s + x2 * c); }
        bf16_t* qo = Q + orow * 192; qo[lane] = f2bf(q0); qo[64 + lane] = f2bf(q1); qo[128 + lane] = f2bf(q2);
        const float* kv = KVRAW + (size_t)row * 2048 + h * 256;
        bf16_t* ko = K + orow * 192; ko[lane] = f2bf(kv[lane]); ko[64 + lane] = f2bf(kv[64 + lane]); ko[128 + lane] = f2bf(KR[(size_t)row * 64 + lane]);
        bf16_t* vo = V + orow * 128; vo[lane] = f2bf(kv[128 + lane]); vo[64 + lane] = f2bf(kv[192 + lane]);
    }
}

__device__ void ph_attn_naive(const Params& p, char* lds) {
    const int tid = tidx(), qi = tid >> 2, part = tid & 3;
    const bf16_t* Q = (const bf16_t*)(p.ws + OFF_Q); const bf16_t* K = (const bf16_t*)(p.ws + OFF_K); const bf16_t* V = (const bf16_t*)(p.ws + OFF_V);
    bf16_t* O = (bf16_t*)(p.ws + OFF_O);
    bf16_t* Ks = (bf16_t*)lds;
    bf16_t* Vs = Ks + 32 * 192;
    const int nitems = 32 * 34;
    for (int it = bidx(); it < nitems; it += gdim()) {
        const int bh = it / 34, qb = it % 34; const int b = bh >> 3, h = bh & 7;
        const int nkeys = qb < 2 ? TC : TK;
        const int tq = qb * 128 + qi;
        const bf16_t* qp = Q + ((size_t)bh * TK + tq) * 192 + part * 48;
        float q[48];
#pragma unroll
        for (int i = 0; i < 48; ++i) q[i] = bf2f(qp[i]) * ATT_SCALE;
        float o[32];
#pragma unroll
        for (int i = 0; i < 32; ++i) o[i] = 0.f;
        float m = -1e30f, l = 0.f;
        for (int k0 = 0; k0 < nkeys; k0 += 32) {
            __syncthreads();
            {
                const bf16_t* kg = K + ((size_t)bh * TK + k0) * 192; const bf16_t* vg = V + ((size_t)bh * TK + k0) * 128;
                for (int c = tid; c < 768; c += NTHR) *(u32x4*)(Ks + c * 8) = *(const u32x4*)(kg + c * 8);
                *(u32x4*)(Vs + tid * 8) = *(const u32x4*)(vg + tid * 8);
            }
            __syncthreads();
#pragma unroll 1
            for (int kg = 0; kg < 32; kg += 8) {
                float s[8]; float tmax = -1e30f;
#pragma unroll
                for (int kk = 0; kk < 8; ++kk) {
                    const bf16_t* kr = Ks + (kg + kk) * 192 + part * 48; float acc = 0.f;
#pragma unroll
                    for (int i = 0; i < 48; ++i) acc += q[i] * bf2f(kr[i]);
                    acc += __shfl_xor(acc, 1); acc += __shfl_xor(acc, 2);
                    s[kk] = acc; tmax = fmaxf(tmax, acc);
                    asm volatile("" ::: "memory");
                }
                const float mn = fmaxf(m, tmax), alpha = expf(m - mn); m = mn; l *= alpha;
#pragma unroll
                for (int i = 0; i < 32; ++i) o[i] *= alpha;
#pragma unroll
                for (int kk = 0; kk < 8; ++kk) {
                    const float pw = expf(s[kk] - mn); l += pw;
                    const bf16_t* vr = Vs + (kg + kk) * 128 + part * 32;
#pragma unroll
                    for (int i = 0; i < 32; ++i) o[i] += pw * bf2f(vr[i]);
                    asm volatile("" ::: "memory");
                }
            }
        }
        const float rl = 1.f / l;
        const int row = qb < 2 ? (NLAT + b * TC + tq) : (b * TL + tq - TC);
        bf16_t* op = O + (size_t)row * D + h * 128 + part * 32;
#pragma unroll
        for (int i = 0; i < 32; ++i) op[i] = f2bf(o[i] * rl);
    }
}


namespace fa {
using s16x4  = __attribute__((ext_vector_type(4))) short;
using f32x16 = __attribute__((ext_vector_type(16))) float;
constexpr int DQK = 192, DV = 128, KVBLK = 64;
constexpr float THR = 8.f;
constexpr int SHM_V = KVBLK * DV * 2, SHM_K = KVBLK * DQK * 2;
constexpr int SHM_ATTN = 2 * SHM_V + 2 * SHM_K + 8 * 64 * 4;
#define KSWZ(row, colB) ((row) * 384 + ((colB) ^ ((((row) >> 1) & 7) << 4)))
#define SBAR() __builtin_amdgcn_sched_barrier(0)
__device__ __forceinline__ int crow(int r, int hi) { return (r & 3) + 8 * (r >> 2) + 4 * hi; }
__device__ __forceinline__ unsigned cvtpk(float lo, float hi) { unsigned r; asm volatile("v_cvt_pk_bf16_f32 %0, %1, %2" : "=v"(r) : "v"(lo), "v"(hi)); return r; }
__device__ __forceinline__ void partialSM(f32x16& p0, f32x16& p1, float& m_reg, float& mn, float& alpha) {
  constexpr float C = ATT_SCALE * 1.4426950408889634f;
  float pmax = p0[0];
#pragma unroll
  for (int r = 1; r < 16; ++r) pmax = fmaxf(pmax, p0[r]);
#pragma unroll
  for (int r = 0; r < 16; ++r) pmax = fmaxf(pmax, p1[r]);
  { auto rr = __builtin_amdgcn_permlane32_swap(__float_as_uint(pmax), __float_as_uint(pmax), false, false);
    pmax = fmaxf(__uint_as_float(rr[0]), __uint_as_float(rr[1])); }
  if (__builtin_expect(__all(pmax - m_reg <= THR / ATT_SCALE), 1)) { mn = m_reg; alpha = 1.f; }
  else { mn = fmaxf(m_reg, pmax); alpha = __builtin_amdgcn_exp2f((m_reg - mn) * C); m_reg = mn; }
  float mnC = -mn * C;
#pragma unroll
  for (int r = 0; r < 16; ++r) p0[r] = fmaf(p0[r], C, mnC);
#pragma unroll
  for (int r = 0; r < 16; ++r) p1[r] = fmaf(p1[r], C, mnC);
#pragma unroll
  for (int r = 0; r < 16; ++r) p0[r] = __builtin_amdgcn_exp2f(p0[r]);
}
__device__ __forceinline__ void finishSM(f32x16& p0, f32x16& p1, float alpha, float& l_reg, bf16x8& pa0, bf16x8& pa1, bf16x8& pa2, bf16x8& pa3) {
#pragma unroll
  for (int r = 0; r < 16; ++r) p1[r] = __builtin_amdgcn_exp2f(p1[r]);
  float ps = 0;
#pragma unroll
  for (int r = 0; r < 16; ++r) ps += p0[r];
#pragma unroll
  for (int r = 0; r < 16; ++r) ps += p1[r];
  { auto rr = __builtin_amdgcn_permlane32_swap(__float_as_uint(ps), __float_as_uint(ps), false, false);
    ps = __uint_as_float(rr[0]) + __uint_as_float(rr[1]); }
  l_reg = l_reg * alpha + ps;
#define PK4(P, BASE, OUT) do { unsigned a0 = cvtpk(P[BASE + 0], P[BASE + 1]), a1 = cvtpk(P[BASE + 2], P[BASE + 3]);   \
    unsigned b0 = cvtpk(P[BASE + 4], P[BASE + 5]), b1 = cvtpk(P[BASE + 6], P[BASE + 7]);                              \
    auto r0 = __builtin_amdgcn_permlane32_swap(a0, b0, false, false); auto r1 = __builtin_amdgcn_permlane32_swap(a1, b1, false, false); \
    u32x4 w = {r0[0], r1[0], r0[1], r1[1]}; OUT = *reinterpret_cast<bf16x8*>(&w); } while (0)
  PK4(p0, 0, pa0); PK4(p0, 8, pa1); PK4(p1, 0, pa2); PK4(p1, 8, pa3);
#undef PK4
}
__device__ __forceinline__ void qkt(f32x16& p0, f32x16& p1, const char* Ks, const bf16x8* qr, int r32, int hi) {
  p0 = f32x16{}; p1 = f32x16{};
  const int swz = ((r32 >> 1) & 7) << 4;
  const char* b4[4];
#pragma unroll
  for (int dr = 0; dr < 4; ++dr) b4[dr] = Ks + r32 * 384 + ((dr * 32 + hi * 16) ^ swz);
#pragma unroll
  for (int d0 = 0; d0 < 12; ++d0) {
    bf16x8 b0 = *reinterpret_cast<const bf16x8*>(b4[d0 & 3] + (d0 >> 2) * 128);
    bf16x8 b1 = *reinterpret_cast<const bf16x8*>(b4[d0 & 3] + (d0 >> 2) * 128 + 32 * 384);
    p0 = __builtin_amdgcn_mfma_f32_32x32x16_bf16(b0, qr[d0], p0, 0, 0, 0);
    p1 = __builtin_amdgcn_mfma_f32_32x32x16_bf16(b1, qr[d0], p1, 0, 0, 0); }
}
__device__ __forceinline__ int v_st(int k, int c) { const int kk = (k & ~0xC) | ((k & 4) << 1) | ((k & 8) >> 1); return ((kk >> 3) * 4 + (c >> 5)) * 512 + ((kk & 7) * 32 + (c & 31)) * 2; }
__device__ __forceinline__ int v_rd_base(int lane) { return ((lane & 3) << 3) | (((lane >> 2) & 3) << 6) | (((lane >> 4) & 1) << 5) | (((lane >> 5) & 1) << 8); }
constexpr int v_rd_off(int d0, int ks, int half) { return d0 * 512 + ks * 4096 + half * 2048; }
template <int OFF> __device__ __forceinline__ s16x4 tr_read(int vb) {
  s16x4 r; asm volatile("ds_read_b64_tr_b16 %0, %1 offset:%2" : "=&v"(r) : "v"(vb), "i"(OFF) : "memory"); return r;
}
template <int D0> __device__ __forceinline__ void pv_one(f32x16& od, int vb, bf16x8 pa0, bf16x8 pa1, bf16x8 pa2, bf16x8 pa3) {
  const s16x4 l0 = tr_read<v_rd_off(D0, 0, 0)>(vb), h0 = tr_read<v_rd_off(D0, 0, 1)>(vb), l1 = tr_read<v_rd_off(D0, 1, 0)>(vb), h1 = tr_read<v_rd_off(D0, 1, 1)>(vb);
  const s16x4 l2 = tr_read<v_rd_off(D0, 2, 0)>(vb), h2 = tr_read<v_rd_off(D0, 2, 1)>(vb), l3 = tr_read<v_rd_off(D0, 3, 0)>(vb), h3 = tr_read<v_rd_off(D0, 3, 1)>(vb);
  asm volatile("s_waitcnt lgkmcnt(0)" ::: "memory"); SBAR();
#define PK(L, H) (bf16x8){L[0], L[1], L[2], L[3], H[0], H[1], H[2], H[3]}
  od = __builtin_amdgcn_mfma_f32_32x32x16_bf16(pa0, PK(l0, h0), od, 0, 0, 0);
  od = __builtin_amdgcn_mfma_f32_32x32x16_bf16(pa1, PK(l1, h1), od, 0, 0, 0);
  od = __builtin_amdgcn_mfma_f32_32x32x16_bf16(pa2, PK(l2, h2), od, 0, 0, 0);
  od = __builtin_amdgcn_mfma_f32_32x32x16_bf16(pa3, PK(l3, h3), od, 0, 0, 0);
#undef PK
}
__device__ __forceinline__ void pv_d0(f32x16* o, int vb, bf16x8 pa0, bf16x8 pa1, bf16x8 pa2, bf16x8 pa3) {
  pv_one<0>(o[0], vb, pa0, pa1, pa2, pa3); pv_one<1>(o[1], vb, pa0, pa1, pa2, pa3); pv_one<2>(o[2], vb, pa0, pa1, pa2, pa3); pv_one<3>(o[3], vb, pa0, pa1, pa2, pa3);
}
__device__ __forceinline__ void attn_body(const int wv_, const bf16_t* __restrict__ Qb, const bf16_t* __restrict__ Kh, const bf16_t* __restrict__ Vh, bf16_t* __restrict__ Ob, int ldo, int seq, char* lds, const float* __restrict__ ropecs  ) {
  const int tid = tidx_w(wv_), wid = tid >> 6, lane = tid & 63, r32 = lane & 31, hi = lane >> 5;
  char* V_lds = lds; char* K_lds = lds + 2 * SHM_V;
  float* ws = (float*)(lds + 2 * SHM_V + 2 * SHM_K) + wid * 64; float* li_l = ws; float* al_l = ws + 32;
  float m_reg = -1e30f, l_reg = 0; f32x16 o[4] = {}; bf16x8 qr[12];
  const bf16_t* Qw = Qb + (long)(wid * 32 + r32) * DQK + hi * 8;
#pragma unroll
  for (int d0 = 0; d0 < 12; ++d0) qr[d0] = *reinterpret_cast<const bf16x8*>(Qw + d0 * 16);
  if (ropecs) {
    const float* cs = ropecs + (size_t)(wid * 32 + r32) * 64;
#pragma unroll
    for (int d0 = 8; d0 < 12; ++d0) { const int i0 = (d0 - 8) * 8 + hi * 4; const f32x4 c0 = *(const f32x4*)(cs + i0 * 2), c1 = *(const f32x4*)(cs + i0 * 2 + 4);
      u32x4 w = *reinterpret_cast<u32x4*>(&qr[d0]); const float cc[4] = {c0[0], c0[2], c1[0], c1[2]}, ss[4] = {c0[1], c0[3], c1[1], c1[3]};
#pragma unroll
      for (int m = 0; m < 4; ++m) { const float x1 = __uint_as_float(w[m] << 16), x2 = __uint_as_float(w[m] & 0xffff0000u); w[m] = cvtpk(x1 * cc[m] - x2 * ss[m], x1 * ss[m] + x2 * cc[m]); }
      qr[d0] = *reinterpret_cast<bf16x8*>(&w); }
  }
  const int sr = tid >> 4, sc = (tid & 15) * 8, vst0 = v_st(sr, sc), vst1 = v_st(32 + sr, sc);
  int kst[3];
#pragma unroll
  for (int i = 0; i < 3; ++i) { const int c = tid + 512 * i, row = c / 24, cc = c % 24; kst[i] = KSWZ(row, cc * 16); }
  const int vb0 = (int)(uintptr_t)V_lds + v_rd_base(lane);
  struct { bf16x8 vs0, vs1, ks0, ks1, ks2; } sr_[1];
#define SLOAD(i, k0) do { const bf16_t* vt = Vh + (long)(k0) * DV; const bf16_t* kt = Kh + (long)(k0) * DQK; \
    sr_[i].vs0 = *reinterpret_cast<const bf16x8*>(vt + (sr) * DV + sc); sr_[i].vs1 = *reinterpret_cast<const bf16x8*>(vt + (32 + sr) * DV + sc); \
    sr_[i].ks0 = *reinterpret_cast<const bf16x8*>(kt + tid * 8); sr_[i].ks1 = *reinterpret_cast<const bf16x8*>(kt + (tid + 512) * 8); sr_[i].ks2 = *reinterpret_cast<const bf16x8*>(kt + (tid + 1024) * 8); } while (0)
#define SWRITE(b, i) do { *(bf16x8*)(V_lds + (b) * SHM_V + vst0) = sr_[i].vs0; *(bf16x8*)(V_lds + (b) * SHM_V + vst1) = sr_[i].vs1; \
    *(bf16x8*)(K_lds + (b) * SHM_K + kst[0]) = sr_[i].ks0; *(bf16x8*)(K_lds + (b) * SHM_K + kst[1]) = sr_[i].ks1; *(bf16x8*)(K_lds + (b) * SHM_K + kst[2]) = sr_[i].ks2; } while (0)
#define SWAIT() asm volatile("s_waitcnt vmcnt(5)" ::: "memory")
#define RESC(a) do { if (__any((a) < 1.f)) { if (hi == 0) al_l[r32] = (a); asm volatile("s_waitcnt lgkmcnt(0)" ::: "memory"); \
    _Pragma("unroll") for (int d = 0; d < 4; ++d) _Pragma("unroll") for (int r = 0; r < 16; ++r) o[d][r] *= al_l[crow(r, hi)]; } } while (0)
  f32x16 pA0, pA1; float mnA, alA; bf16x8 pa0, pa1, pa2, pa3; const int NT = seq / KVBLK;
  SLOAD(0, 0); SWRITE(0, 0);
  SLOAD(0, KVBLK);
  __syncthreads();
  for (int j = 0; j < NT; j += 2) {
    SBAR(); qkt(pA0, pA1, K_lds, qr, r32, hi);
    partialSM(pA0, pA1, m_reg, mnA, alA); RESC(alA);
    finishSM(pA0, pA1, alA, l_reg, pa0, pa1, pa2, pa3); SBAR();
    SWRITE(1, 0);
    if (j + 2 < NT) SLOAD(0, (j + 2) * KVBLK);
    SBAR();
    pv_d0(o, vb0, pa0, pa1, pa2, pa3);
    __syncthreads();
    SBAR(); qkt(pA0, pA1, K_lds + SHM_K, qr, r32, hi);
    partialSM(pA0, pA1, m_reg, mnA, alA); RESC(alA);
    finishSM(pA0, pA1, alA, l_reg, pa0, pa1, pa2, pa3); SBAR();
    if (j + 2 < NT) { SWRITE(0, 0); if (j + 3 < NT) SLOAD(0, (j + 3) * KVBLK); }
    SBAR();
    pv_d0(o, vb0 + SHM_V, pa0, pa1, pa2, pa3);
    __syncthreads();
  }
  if (hi == 0) li_l[r32] = l_reg; asm volatile("s_waitcnt lgkmcnt(0)" ::: "memory");
  float rli[16];
#pragma unroll
  for (int r = 0; r < 16; ++r) rli[r] = __builtin_amdgcn_rcpf(li_l[crow(r, hi)]);
  bf16_t* Ow = Ob + (long)(wid * 32) * ldo;
#pragma unroll
  for (int r = 0; r < 16; ++r) { int orow = crow(r, hi);
#pragma unroll
    for (int d0 = 0; d0 < 4; ++d0) Ow[(long)orow * ldo + d0 * 32 + r32] = f2bf(o[d0][r] * rli[r]); }
  __syncthreads();
#undef SLOAD
#undef SWRITE
#undef SWAIT
#undef RESC
}
#undef KSWZ
}

__device__ void ph_attn(const Params& p, char* lds) {
    const bf16_t* Q = (const bf16_t*)(p.ws + OFF_Q); const bf16_t* K = (const bf16_t*)(p.ws + OFF_K); const bf16_t* V = (const bf16_t*)(p.ws + OFF_V);
    bf16_t* O = (bf16_t*)(p.ws + OFF_O);
    const int G = gdim();
    for (int i = 0;; ++i) {
        const int L = i * G + bidx(); if (L >= 544) break;
        int bh, qb;
        if (L < 512) { const int w = g8::xcd_remap(L, 512); bh = w >> 4; qb = 1 + (w & 15); } else { bh = L - 512; qb = 0; }
        const int b = bh >> 3, h = bh & 7;
        const int seq = qb == 0 ? TC : TK;
        const int row0 = qb == 0 ? NLAT + b * TC : b * TL + (qb - 1) * 256;
        fa::attn_body(p.wv, Q + ((size_t)bh * TK + qb * 256) * 192, K + (size_t)bh * TK * 192, V + (size_t)bh * TK * 128, O + (size_t)row0 * D + h * 128, D, seq, lds,
                      qb == 0 ? nullptr : (const float*)(p.ws + OFF_ROPE_C) + (size_t)(qb - 1) * 256 * 64);
    }
}

__device__ void ph_norm2_router(const Params& p, int layer, char* lds, int nrows) {
    const int tid = tidx(), wid = tid >> 6, lane = tid & 63;
    float* rt = (float*)lds;
    const float* rg = p.moe_router + (size_t)layer * D * NE;
    for (int i = tid; i < D * NE / 4; i += NTHR) { const int d = i >> 2, eq = i & 3; ((float4*)rt)[(((d >> 8) * 4 + (d & 3)) * 4 + eq) * 64 + ((d & 255) >> 2)] = ((const float4*)rg)[i]; }
    __syncthreads();
    const xt_t* X = (const xt_t*)(p.ws + OFF_X); bf16_t* BN = (bf16_t*)(p.ws + OFF_H); float* AFF = (float*)(p.ws + OFF_AFF);
    const float* g = p.norm2_g + layer * D;
    int row = bidx() * 8 + wid;
    float4 nv[4];
    if (row < nrows) {
#pragma unroll
        for (int i = 0; i < 4; ++i) nv[i] = xld(X, (size_t)row * D + (lane + i * 64) * 4); }
    for (; row < nrows; row += gdim() * 8) {
        const int s = row_stream(row);
        const float* sh = modp(p, layer, s, 3); const float* sc = modp(p, layer, s, 4);
        float4 v[4]; float ss = 0;
#pragma unroll
        for (int i = 0; i < 4; ++i) { v[i] = nv[i]; ss += v[i].x * v[i].x + v[i].y * v[i].y + v[i].z * v[i].z + v[i].w * v[i].w; }
        { const int nrow = row + gdim() * 8;
          if (nrow < nrows) {
#pragma unroll
              for (int i = 0; i < 4; ++i) nv[i] = xld(X, (size_t)nrow * D + (lane + i * 64) * 4); } }
        ss = wave_sum(ss); const float rs = rsqrtf(ss * (1.f / D) + RMS_EPS);
        float lg[16];
#pragma unroll
        for (int e = 0; e < 16; ++e) lg[e] = 0.f;
#pragma unroll
        for (int i = 0; i < 4; ++i) {
            const int d = (lane + i * 64) * 4;
            const float4 gg = *(const float4*)(g + d), a = *(const float4*)(sc + d), b = *(const float4*)(sh + d);
            float o[4]; o[0] = v[i].x * rs * gg.x * (1.f + a.x) + b.x; o[1] = v[i].y * rs * gg.y * (1.f + a.y) + b.y; o[2] = v[i].z * rs * gg.z * (1.f + a.z) + b.z; o[3] = v[i].w * rs * gg.w * (1.f + a.w) + b.w;
            uint2 w; w.x = pk2(o[0], o[1]); w.y = pk2(o[2], o[3]); *(uint2*)(BN + (size_t)row * D + d) = w;
#pragma unroll
            for (int jj = 0; jj < 4; ++jj) {
#pragma unroll
                for (int eq = 0; eq < 4; ++eq) { const float4 r4 = ((const float4*)rt)[((i * 4 + jj) * 4 + eq) * 64 + lane];
                    lg[4 * eq] += o[jj] * r4.x; lg[4 * eq + 1] += o[jj] * r4.y; lg[4 * eq + 2] += o[jj] * r4.z; lg[4 * eq + 3] += o[jj] * r4.w; } }
            asm volatile("" ::: "memory");
        }
        float mx = -1e30f;
#pragma unroll
        for (int e = 0; e < 16; ++e) { lg[e] = wave_sum(lg[e]); mx = fmaxf(mx, lg[e]); }
        float sum = 0;
#pragma unroll
        for (int e = 0; e < 16; ++e) { lg[e] = expf(lg[e] - mx); sum += lg[e]; }
        const float inv = 1.f / sum;
        if (lane < 16) { float val = 0;
#pragma unroll
            for (int e = 0; e < 16; ++e) val = (lane == e) ? lg[e] : val;
            AFF[(size_t)row * 16 + lane] = val * inv; }
    }
}

__device__ void ph_select(const Params& p, char* lds, int ngroups) {
    const int tid = tidx(), wid = tid >> 6, lane = tid & 63;
    unsigned* hist = (unsigned*)lds;
    unsigned* ctl = hist + 256;
    unsigned* wsum = ctl + 8;
    int* rowl = (int*)(wsum + 16);
    const float* AFF = (const float*)(p.ws + OFF_AFF);
    int* ROWIDX = (int*)(p.ws + OFF_ROWIDX); float* GATE = (float*)(p.ws + OFF_GATE); int* SLOT = (int*)(p.ws + OFF_SLOT);
    for (int gidx = bidx(); gidx < ngroups; gidx += gdim()) {
        const bool lat = gidx < 64; const int b = (gidx & 63) >> 4, e = gidx & 15;
        const int n = lat ? TL : TC, cap = lat ? CAPL : CAPC;
        const int row0 = lat ? b * TL : NLAT + b * TC, slot0 = lat ? b * CAPL : NB * CAPL + b * CAPC;
        unsigned key[8];
#pragma unroll
        for (int i = 0; i < 8; ++i) { const int idx = tid * 8 + i; key[i] = idx < n ? __float_as_uint(AFF[(size_t)(row0 + idx) * 16 + e]) : 0u; }
        unsigned prefix = 0u, remaining = (unsigned)cap;
#pragma unroll
        for (int pass = 0; pass < 4; ++pass) {
            const int sh = 24 - 8 * pass;
            __syncthreads();
            if (tid < 256) hist[tid] = 0u;
            __syncthreads();
#pragma unroll
            for (int i = 0; i < 8; ++i) { const int idx = tid * 8 + i;
                const bool cand = idx < n && (pass == 0 || (key[i] >> (sh + 8)) == prefix);
                if (cand) atomicAdd(&hist[(key[i] >> sh) & 255u], 1u); }
            __syncthreads();
            if (tid < 256) { unsigned gt = 0; for (int jj = tid + 1; jj < 256; ++jj) gt += hist[jj];
                const unsigned mine = hist[tid];
                if (gt < remaining && remaining <= gt + mine) { ctl[0] = (unsigned)tid; ctl[1] = remaining - gt; } }
            __syncthreads();
            prefix = (prefix << 8) | ctl[0]; remaining = ctl[1];
        }
        const unsigned T = prefix, m = remaining;
        unsigned cgt = 0, ceq = 0;
#pragma unroll
        for (int i = 0; i < 8; ++i) { const int idx = tid * 8 + i; if (idx < n) { cgt += key[i] > T ? 1u : 0u; ceq += key[i] == T ? 1u : 0u; } }
        auto block_excl = [&](unsigned v) -> unsigned {
            unsigned inc = v;
#pragma unroll
            for (int o = 1; o < 64; o <<= 1) { const unsigned t = (unsigned)__builtin_amdgcn_ds_bpermute((lane - o) << 2, (int)inc); if (lane >= o) inc += t; }
            __syncthreads();
            if (lane == 63) wsum[wid] = inc;
            __syncthreads();
            unsigned base = 0;
#pragma unroll
            for (int w = 0; w < 8; ++w) base += (w < wid) ? wsum[w] : 0u;
            return base + inc - v; };
        unsigned eqbase = block_excl(ceq);
        unsigned nsel = 0; bool sel[8];
#pragma unroll
        for (int i = 0; i < 8; ++i) { const int idx = tid * 8 + i; bool s_ = false;
            if (idx < n) { if (key[i] > T) s_ = true; else if (key[i] == T) { s_ = eqbase < m; ++eqbase; } }
            sel[i] = s_; nsel += s_ ? 1u : 0u; }
        unsigned sbase = block_excl(nsel);
#pragma unroll
        for (int i = 0; i < 8; ++i) { const int idx = tid * 8 + i;
            if (idx < n) {
                if (sel[i]) { const int sl = slot0 + (int)sbase; rowl[sbase] = row0 + idx; ++sbase; ROWIDX[e * ESLOTS + sl] = row0 + idx; GATE[e * EPAD + sl] = __uint_as_float(key[i]); SLOT[(size_t)(row0 + idx) * 16 + e] = sl; }
                else SLOT[(size_t)(row0 + idx) * 16 + e] = -1; } }
        __syncthreads();
        { const bf16_t* BN = (const bf16_t*)(p.ws + OFF_H); bf16_t* XE = (bf16_t*)(p.ws + OFF_XE);
          for (int r = wid; r < cap; r += 32) {
              u32x4 t_[4][2];
#pragma unroll
              for (int u = 0; u < 4; ++u) { const u32x4* src = (const u32x4*)(BN + (size_t)rowl[r + 8 * u] * D); t_[u][0] = src[lane]; t_[u][1] = src[lane + 64]; }
#pragma unroll
              for (int u = 0; u < 4; ++u) { u32x4* dst = (u32x4*)(XE + ((size_t)e * EPAD + slot0 + r + 8 * u) * D); dst[lane] = t_[u][0]; dst[lane + 64] = t_[u][1]; } } }
    }
}

__device__ void ph_gather(const Params& p, int nslots) {
    const int wid = tidx() >> 6, lane = tidx() & 63;
    const int* ROWIDX = (const int*)(p.ws + OFF_ROWIDX); const bf16_t* BN = (const bf16_t*)(p.ws + OFF_H); bf16_t* XE = (bf16_t*)(p.ws + OFF_XE);
    for (int it = bidx() * 8 + wid; it < NE * ESLOTS; it += gdim() * 8) {
        const int e = it / ESLOTS, sl = it % ESLOTS; if (sl >= nslots) continue; const int row = ROWIDX[it];
        const u32x4* src = (const u32x4*)(BN + (size_t)row * D); u32x4* dst = (u32x4*)(XE + ((size_t)e * EPAD + sl) * D);
        dst[lane] = src[lane]; dst[lane + 64] = src[lane + 64];
    }
}

__device__ void ph_combine(const Params& p, int layer, int nrows) {
    const int wid = tidx() >> 6, lane = tidx() & 63;
    const int* SLOT = (const int*)(p.ws + OFF_SLOT); const bf16_t* YE = (const bf16_t*)(p.ws + OFF_YE); xt_t* X = (xt_t*)(p.ws + OFF_X);
    int row = bidx() * 8 + wid;
    int sl = (row < nrows && lane < 16) ? SLOT[(size_t)row * 16 + lane] : -1;
    while (row < nrows) {
        const int nrow = row + gdim() * 8;
        const int sln = (nrow < nrows && lane < 16) ? SLOT[(size_t)nrow * 16 + lane] : -1;
        const float* gt = modp(p, layer, row_stream(row), 5);
        xt_t* xr = X + (size_t)row * D + lane * 8;
        f32x4 xv[4];
#pragma unroll
        for (int i = 0; i < 2; ++i) { xv[2 * i] = xldv(xr, 512 * i); xv[2 * i + 1] = xldv(xr, 512 * i + 4); }
        unsigned long long m = __ballot(sl >= 0);
        float acc[16];
#pragma unroll
        for (int i = 0; i < 16; ++i) acc[i] = 0.f;
        while (m) {
            const int e0 = __builtin_ctzll(m); m &= m - 1; const bool two = m != 0; const int e1 = two ? __builtin_ctzll(m) : e0; if (two) m &= m - 1;
            const int s0 = __builtin_amdgcn_readlane(sl, e0), s1 = __builtin_amdgcn_readlane(sl, e1);
            const bf16_t* y0 = YE + ((size_t)e0 * EPAD + s0) * D + lane * 8; const bf16_t* y1 = YE + ((size_t)e1 * EPAD + s1) * D + lane * 8;
            const u32x4 a0 = *(const u32x4*)y0, a1 = *(const u32x4*)(y0 + 512), b0 = *(const u32x4*)y1, b1 = *(const u32x4*)(y1 + 512);
            const float f1 = two ? 1.f : 0.f;
#pragma unroll
            for (int i = 0; i < 4; ++i) { acc[2 * i] += __uint_as_float(a0[i] << 16) + f1 * __uint_as_float(b0[i] << 16); acc[2 * i + 1] += __uint_as_float(a0[i] & 0xffff0000u) + f1 * __uint_as_float(b0[i] & 0xffff0000u);
                acc[8 + 2 * i] += __uint_as_float(a1[i] << 16) + f1 * __uint_as_float(b1[i] << 16); acc[8 + 2 * i + 1] += __uint_as_float(a1[i] & 0xffff0000u) + f1 * __uint_as_float(b1[i] & 0xffff0000u); }
        }
#pragma unroll
        for (int i = 0; i < 2; ++i) { const f32x4 g0 = *(const f32x4*)(gt + lane * 8 + 512 * i), g1 = *(const f32x4*)(gt + lane * 8 + 512 * i + 4);
            f32x4 o0 = xv[2 * i], o1 = xv[2 * i + 1];
#pragma unroll
            for (int e = 0; e < 4; ++e) { o0[e] += g0[e] * acc[8 * i + e]; o1[e] += g1[e] * acc[8 * i + 4 + e]; }
            xstv(xr, 512 * i, o0); xstv(xr, 512 * i + 4, o1); }
        row = nrow; sl = sln;
    }
}

template <bool FINAL>
__device__ void ph_comb_norm(const Params& p, int lprev, int layer, int nrows) {
    const int wid = tidx() >> 6, lane = tidx() & 63;
    const int* SLOT = (const int*)(p.ws + OFF_SLOT); const bf16_t* YE = (const bf16_t*)(p.ws + OFF_YE); xt_t* X = (xt_t*)(p.ws + OFF_X);
    bf16_t* H = (bf16_t*)(p.ws + OFF_H);
    const float* g = FINAL ? p.final_g : p.norm1_g + layer * D;
    int row = bidx() * 8 + wid;
    int sl = (row < nrows && lane < 16) ? SLOT[(size_t)row * 16 + lane] : -1;
    while (row < nrows) {
        const int nrow = row + gdim() * 8;
        const int sln = (nrow < nrows && lane < 16) ? SLOT[(size_t)nrow * 16 + lane] : -1;
        const int strm = row_stream(row);
        const float* gt = modp(p, lprev, strm, 5);
        xt_t* xr = X + (size_t)row * D + lane * 8;
        f32x4 xv[4];
#pragma unroll
        for (int i = 0; i < 2; ++i) { xv[2 * i] = xldv(xr, 512 * i); xv[2 * i + 1] = xldv(xr, 512 * i + 4); }
        unsigned long long m = __ballot(sl >= 0);
        float acc[16];
#pragma unroll
        for (int i = 0; i < 16; ++i) acc[i] = 0.f;
        while (m) {
            const int e0 = __builtin_ctzll(m); m &= m - 1; const bool two = m != 0; const int e1 = two ? __builtin_ctzll(m) : e0; if (two) m &= m - 1;
            const int s0 = __builtin_amdgcn_readlane(sl, e0), s1 = __builtin_amdgcn_readlane(sl, e1);
            const bf16_t* y0 = YE + ((size_t)e0 * EPAD + s0) * D + lane * 8; const bf16_t* y1 = YE + ((size_t)e1 * EPAD + s1) * D + lane * 8;
            const u32x4 a0 = *(const u32x4*)y0, a1 = *(const u32x4*)(y0 + 512), b0 = *(const u32x4*)y1, b1 = *(const u32x4*)(y1 + 512);
            const float f1 = two ? 1.f : 0.f;
#pragma unroll
            for (int i = 0; i < 4; ++i) { acc[2 * i] += __uint_as_float(a0[i] << 16) + f1 * __uint_as_float(b0[i] << 16); acc[2 * i + 1] += __uint_as_float(a0[i] & 0xffff0000u) + f1 * __uint_as_float(b0[i] & 0xffff0000u);
                acc[8 + 2 * i] += __uint_as_float(a1[i] << 16) + f1 * __uint_as_float(b1[i] << 16); acc[8 + 2 * i + 1] += __uint_as_float(a1[i] & 0xffff0000u) + f1 * __uint_as_float(b1[i] & 0xffff0000u); }
        }
        float ss = 0.f;
#pragma unroll
        for (int i = 0; i < 2; ++i) { const f32x4 g0 = *(const f32x4*)(gt + lane * 8 + 512 * i), g1 = *(const f32x4*)(gt + lane * 8 + 512 * i + 4);
#pragma unroll
            for (int e = 0; e < 4; ++e) { xv[2 * i][e] += g0[e] * acc[8 * i + e]; xv[2 * i + 1][e] += g1[e] * acc[8 * i + 4 + e]; ss += xv[2 * i][e] * xv[2 * i][e] + xv[2 * i + 1][e] * xv[2 * i + 1][e]; }
            if (!FINAL) { xstv(xr, 512 * i, xv[2 * i]); xstv(xr, 512 * i + 4, xv[2 * i + 1]); } }
        ss = wave_sum(ss); const float rs = rsqrtf(ss * (1.f / D) + RMS_EPS);
        const float* sh = FINAL ? nullptr : modp(p, layer, strm, 0); const float* sc = FINAL ? nullptr : modp(p, layer, strm, 1);
#pragma unroll
        for (int i = 0; i < 2; ++i)
#pragma unroll
            for (int hh = 0; hh < 2; ++hh) { const int d = lane * 8 + 512 * i + 4 * hh; const f32x4 gg = *(const f32x4*)(g + d); f32x4 o = xv[2 * i + hh] * rs * gg;
                if (FINAL) *(f32x4*)(p.out + (size_t)row * D + d) = o;
                else { o = o * (1.f + *(const f32x4*)(sc + d)) + *(const f32x4*)(sh + d); stbf4(H + (size_t)row * D + d, o); } }
        row = nrow; sl = sln;
    }
}

__device__ void ph_rw_normxs(const Params& p, int layer, int j) {
    const int wid = tidx() >> 6, lane = tidx() & 63;
    const xt_t* X = (const xt_t*)(p.ws + OFF_X); bf16_t* XS = (bf16_t*)(p.ws + OFF_XS);
    const float* mu = p.rw_mu + (size_t)j * 6 * D; const float* g = p.norm1_g + layer * D;
    float4 fc[4], fp[4], fn[4];
#define XS_LOAD(R) do { const bool lat_ = (R) < NLAT; const int t_ = lat_ ? ((R) & (TL - 1)) : (((R) - NLAT) & (TC - 1)); const int len_ = lat_ ? TL : TC; \
        _Pragma("unroll") for (int i = 0; i < 4; ++i) { fc[i] = xld(X, (size_t)(R) * D + (lane + i * 64) * 4); \
            fp[i] = t_ > 0 ? xld(X, (size_t)((R) - 1) * D + (lane + i * 64) * 4) : make_float4(0, 0, 0, 0); \
            fn[i] = t_ < len_ - 1 ? xld(X, (size_t)((R) + 1) * D + (lane + i * 64) * 4) : make_float4(0, 0, 0, 0); } } while (0)
    int row = bidx() * 8 + wid;
    if (row < NROW) XS_LOAD(row);
    for (; row < NROW; row += gdim() * 8) {
        const int s_ = row_stream(row);
        const float* sh = modp(p, layer, s_, 0); const float* sc = modp(p, layer, s_, 1);
        const bool lat = row < NLAT; const int t = lat ? (row & (TL - 1)) : ((row - NLAT) & (TC - 1)); const int len = lat ? TL : TC;
        const bool hp = t > 0, hn = t < len - 1;
        float4 xc[4], xp[4], xn[4]; float sc_ = 0, sp_ = 0, sn_ = 0;
#pragma unroll
        for (int i = 0; i < 4; ++i) { xc[i] = fc[i]; xp[i] = fp[i]; xn[i] = fn[i]; }
        { const int nrow = row + gdim() * 8; if (nrow < NROW) XS_LOAD(nrow); }
#pragma unroll
        for (int i = 0; i < 4; ++i) {
            sc_ += xc[i].x * xc[i].x + xc[i].y * xc[i].y + xc[i].z * xc[i].z + xc[i].w * xc[i].w;
            sp_ += xp[i].x * xp[i].x + xp[i].y * xp[i].y + xp[i].z * xp[i].z + xp[i].w * xp[i].w;
            sn_ += xn[i].x * xn[i].x + xn[i].y * xn[i].y + xn[i].z * xn[i].z + xn[i].w * xn[i].w; }
        sc_ = wave_sum(sc_); sp_ = wave_sum(sp_); sn_ = wave_sum(sn_);
        const float rc = rsqrtf(sc_ * (1.f / D) + RMS_EPS), rp = hp ? rsqrtf(sp_ * (1.f / D) + RMS_EPS) : 0.f, rn = hn ? rsqrtf(sn_ * (1.f / D) + RMS_EPS) : 0.f;
#pragma unroll
        for (int i = 0; i < 4; ++i) {
            const int d = (lane + i * 64) * 4;
            const float4 gg = *(const float4*)(g + d), a = *(const float4*)(sc + d), bsh = *(const float4*)(sh + d);
            float h[4], xx[4];
            const float gm[4] = {gg.x * (1.f + a.x), gg.y * (1.f + a.y), gg.z * (1.f + a.z), gg.w * (1.f + a.w)}; const float bb[4] = {bsh.x, bsh.y, bsh.z, bsh.w};
            const float c4[4] = {xc[i].x, xc[i].y, xc[i].z, xc[i].w}, p4[4] = {xp[i].x, xp[i].y, xp[i].z, xp[i].w}, n4[4] = {xn[i].x, xn[i].y, xn[i].z, xn[i].w};
#pragma unroll
            for (int e = 0; e < 4; ++e) { h[e] = c4[e] * rc * gm[e] + bb[e];
                const float hpv = hp ? p4[e] * rp * gm[e] + bb[e] : 0.f, hnv = hn ? n4[e] * rn * gm[e] + bb[e] : 0.f;
                xx[e] = 0.5f * (hpv + hnv) - h[e]; }
#pragma unroll
            for (int m = 0; m < 6; ++m) { const float4 u = *(const float4*)(mu + m * D + d);
                uint2 w; w.x = pk2(h[0] + xx[0] * u.x, h[1] + xx[1] * u.y); w.y = pk2(h[2] + xx[2] * u.z, h[3] + xx[3] * u.w);
                *(uint2*)(XS + ((size_t)m * NROW + row) * D + d) = w; }
        }
    }
#undef XS_LOAD
}

__device__ __forceinline__ int scan_row(int i, int b, int z) {
    return i < TC ? NLAT + b * TC + (z ? TC - 1 - i : i) : b * TL + (z ? TL - 1 - (i - TC) : i - TC);
}
__device__ __forceinline__ float dpp_sum8(float x) {
    x += __builtin_bit_cast(float, __builtin_amdgcn_update_dpp(0, __builtin_bit_cast(int, x), 0xB1, 0xF, 0xF, true));
    x += __builtin_bit_cast(float, __builtin_amdgcn_update_dpp(0, __builtin_bit_cast(int, x), 0x4E, 0xF, 0xF, true));
    x += __builtin_bit_cast(float, __builtin_amdgcn_update_dpp(0, __builtin_bit_cast(int, x), 0x141, 0xF, 0xF, true));
    return x;
}
__device__ void ph_rw_scan(const Params& p, int j, char* lds) {
    const int tid = tidx(), wid = __builtin_amdgcn_readfirstlane(tid >> 6), lane = tid & 63;
    const size_t PL = (size_t)NROW * D;
    const float* RKV = (const float*)(p.ws + OFF_RKV); float* Y = (float*)(p.ws + OFF_Y);
    constexpr int CH = 32, BUFB = 5 * CH * 256 + CH * 128 + CH * 16, YB = CH * 32 * 4, NCH = (TC + TL) / CH;
    const bool loader = wid >= 4; const int lw = wid - 4;
    for (int it = bidx(); it < 256; it += gdim()) {
        const int vh = it & 1, z = (it >> 1) & 1, h = (it >> 2) & 15, b = it >> 6;
        const char* pl0 = (const char*)((const float*)(p.ws + OFF_W) + z * PL); const char* pl1 = (const char*)(RKV + PL);
        const char* pl2 = (const char*)((const float*)(p.ws + OFF_AV) + z * PL); const char* pl3 = (const char*)RKV;
        const char* vpl = (const char*)(RKV + 2 * PL);
        float* yout = Y + z * PL;
        __builtin_amdgcn_s_barrier();
        if (loader) {
            const int pq = lane & 15;
            const f32x4 kkv = *(const f32x4*)(p.rw_k_k + j * D + h * 64 + pq * 4), kav = *(const f32x4*)(p.rw_k_a + j * D + h * 64 + pq * 4);
            auto issue = [&](int c) {
                char* buf = lds + (c % 3) * BUFB;
#pragma unroll
                for (int q = 0; q < 8; ++q) { const int pi = q >> 1, tg = lw * 2 + (q & 1); const int row = scan_row(c * CH + tg * 4 + (lane >> 4), b, z);
                    const char* base = pi == 0 ? pl0 : pi == 1 ? pl1 : pi == 2 ? pl2 : pl3;
                    __builtin_amdgcn_global_load_lds((const unsigned*)(base + (size_t)row * D * 4 + h * 256 + (lane & 15) * 16), (LAS unsigned*)(buf + pi * (CH * 256) + tg * 1024), 16, 0, 0); }
                { const int row = scan_row(c * CH + lw * 8 + (lane >> 3), b, z);
                  __builtin_amdgcn_global_load_lds((const unsigned*)(vpl + (size_t)row * D * 4 + (h * 64 + vh * 32) * 4 + (lane & 7) * 16), (LAS unsigned*)(buf + 5 * CH * 256 + lw * 1024), 16, 0, 0); }
            };
            auto prep = [&](int c) {
                char* buf = lds + (c % 3) * BUFB;
#pragma unroll
                for (int ps = 0; ps < 2; ++ps) { const int ptok = lw * 8 + ps * 4 + (lane >> 4);
                    f32x4* kp = (f32x4*)(buf + 1 * CH * 256 + ptok * 256 + pq * 16); f32x4* ap = (f32x4*)(buf + 2 * CH * 256 + ptok * 256 + pq * 16); f32x4* dp = (f32x4*)(buf + 4 * CH * 256 + ptok * 256 + pq * 16);
                    f32x4* rp = (f32x4*)(buf + 3 * CH * 256 + ptok * 256 + pq * 16); const f32x4 wv = *(const f32x4*)(buf + ptok * 256 + pq * 16);
                    const f32x4 k = *kp, a = *ap, r = *rp; f32x4 kk = k * kkv;
                    float ss = kk[0] * kk[0] + kk[1] * kk[1] + kk[2] * kk[2] + kk[3] * kk[3]; ss = dpp_sum16(ss);
                    const float inv = 1.f / fmaxf(sqrtf(ss), 1e-12f); kk = kk * inv;
                    const f32x4 kd = k * (1.f + (a - 1.f) * kav), bb = kk * a;
                    const f32x4 t1 = bb * r, t2 = kd * r;
                    const float br = dpp_sum16((t1[0] + t1[1]) + (t1[2] + t1[3])), kr = dpp_sum16((t2[0] + t2[1]) + (t2[2] + t2[3]));
                    *dp = kd; *ap = bb; *kp = kk; *rp = wv * r;
                    if (pq == 0) *(float2*)(buf + 5 * CH * 256 + CH * 128 + ptok * 16) = make_float2(br, kr); }
            };
            issue(0); issue(1);
            asm volatile("s_waitcnt vmcnt(9)" ::: "memory");
            prep(0);
            asm volatile("s_waitcnt lgkmcnt(0)" ::: "memory"); __builtin_amdgcn_s_barrier();
            for (int c = 0; c < NCH; ++c) {
                if (c >= 1) { const float* yb = (const float*)(lds + 3 * BUFB + ((c - 1) & 1) * YB);
                    const int lt = tid - 256, t = lt >> 3, q = lt & 7; const int row = scan_row((c - 1) * CH + t, b, z);
                    *(f32x4*)(yout + (size_t)row * D + h * 64 + vh * 32 + q * 4) = *(const f32x4*)(yb + t * 32 + q * 4); }
                if (c + 2 < NCH) { issue(c + 2); asm volatile("s_waitcnt vmcnt(9)" ::: "memory"); } else asm volatile("s_waitcnt vmcnt(0)" ::: "memory");
                if (c + 1 < NCH) prep(c + 1);
                asm volatile("s_waitcnt lgkmcnt(0)" ::: "memory"); __builtin_amdgcn_s_barrier();
            }
            { const float* yb = (const float*)(lds + 3 * BUFB + ((NCH - 1) & 1) * YB);
              const int lt = tid - 256, t = lt >> 3, q = lt & 7; const int row = scan_row((NCH - 1) * CH + t, b, z);
              *(f32x4*)(yout + (size_t)row * D + h * 64 + vh * 32 + q * 4) = *(const f32x4*)(yb + t * 32 + q * 4); }
        } else {
            const int vr = lane >> 3, ks = lane & 7;
            f32x4 Sa = {0.f, 0.f, 0.f, 0.f}, Sb = {0.f, 0.f, 0.f, 0.f};
            __builtin_amdgcn_s_barrier();
            struct Ops { f32x4 w0, w1, kk0, kk1, bb0, bb1, r0, r1, kd0, kd1; float v; float2 sc; };
#define SC_LOAD(O, t) do { const char* q_ = bq + (t) * 256; O.w0 = *(const f32x4*)(q_); O.w1 = *(const f32x4*)(q_ + 16); O.kk0 = *(const f32x4*)(q_ + CH * 256); O.kk1 = *(const f32x4*)(q_ + CH * 256 + 16); \
                O.bb0 = *(const f32x4*)(q_ + 2 * CH * 256); O.bb1 = *(const f32x4*)(q_ + 2 * CH * 256 + 16); O.r0 = *(const f32x4*)(q_ + 3 * CH * 256); O.r1 = *(const f32x4*)(q_ + 3 * CH * 256 + 16); \
                O.kd0 = *(const f32x4*)(q_ + 4 * CH * 256); O.kd1 = *(const f32x4*)(q_ + 4 * CH * 256 + 16); O.v = *(const float*)(vq + (t) * 128); O.sc = *(const float2*)(buf + 5 * CH * 256 + CH * 128 + (t) * 16); } while (0)
#define SC_STEP(O, t) do { const f32x4 d1 = Sa * O.kk0 + Sb * O.kk1, d2 = Sa * O.r0 + Sb * O.r1; \
                float sa = -((d1[0] + d1[1]) + (d1[2] + d1[3])), yy = (d2[0] + d2[1]) + (d2[2] + d2[3]); \
                sa = dpp_sum8(sa); yy = dpp_sum8(yy); \
                Sa = Sa * O.w0 + (sa * O.bb0 + O.v * O.kd0); Sb = Sb * O.w1 + (sa * O.bb1 + O.v * O.kd1); \
                if (ks == 0) yb[(t) * 32 + wid * 8 + vr] = yy + sa * O.sc.x + O.v * O.sc.y; } while (0)
            for (int c = 0; c < NCH; ++c) {
                const char* buf = lds + (c % 3) * BUFB; float* yb = (float*)(lds + 3 * BUFB + (c & 1) * YB);
                const char* bq = buf + ks * 32; const char* vq = buf + 5 * CH * 256 + (wid * 8 + vr) * 4;
                Ops oA, oB, oC;
                SC_LOAD(oA, 0); SC_LOAD(oB, 1);
#pragma unroll
                for (int t = 0; t < CH; t += 3) {
                    if (t + 2 < CH) SC_LOAD(oC, t + 2);
                    SC_STEP(oA, t);
                    if (t + 3 < CH) SC_LOAD(oA, t + 3);
                    if (t + 1 < CH) SC_STEP(oB, t + 1);
                    if (t + 4 < CH) SC_LOAD(oB, t + 4);
                    if (t + 2 < CH) SC_STEP(oC, t + 2);
                }
                asm volatile("s_waitcnt lgkmcnt(0)" ::: "memory"); __builtin_amdgcn_s_barrier();
            }
#undef SC_LOAD
#undef SC_STEP
        }
    }
}


namespace ck {
constexpr int P = 72, MB = 64 * P * 2;
typedef __attribute__((address_space(3))) char lchar;
__device__ __forceinline__ f32x4 mm_tile(const lchar* Aop, const lchar* Bop, int ti, int tj, int c, int q, f32x4 acc) {
#pragma unroll
    for (int ks = 0; ks < 2; ++ks) {
        const bf16x8 a = *(const LAS bf16x8*)(Aop + ((16 * ti + c) * P + 32 * ks + 8 * q) * 2);
        const bf16x8 b = *(const LAS bf16x8*)(Bop + ((16 * tj + c) * P + 32 * ks + 8 * q) * 2);
        acc = __builtin_amdgcn_mfma_f32_16x16x32_bf16(a, b, acc, 0, 0, 0);
    }
    return acc;
}
__device__ __forceinline__ f32x4 mm_diag(const lchar* Aop, const lchar* Bop, int tt, int c, int q, f32x4 acc) {
    const int ks = tt >> 1;
    bf16x8 a = *(const LAS bf16x8*)(Aop + ((16 * tt + c) * P + 32 * ks + 8 * q) * 2);
    const bf16x8 b = *(const LAS bf16x8*)(Bop + ((16 * tt + c) * P + 32 * ks + 8 * q) * 2);
    if ((q >> 1) != (tt & 1)) a = (bf16x8){0, 0, 0, 0, 0, 0, 0, 0};
    return __builtin_amdgcn_mfma_f32_16x16x32_bf16(a, b, acc, 0, 0, 0);
}
__device__ __forceinline__ void st_tile(lchar* dst, int ti, int tj, int c, int q, f32x4 v) {
    u32x2 w; w.x = pk2(v[0], v[1]); w.y = pk2(v[2], v[3]); *(LAS u32x2*)(dst + ((16 * tj + c) * P + 16 * ti + 4 * q) * 2) = w;
}
__device__ __forceinline__ f32x4 ld_tile(const lchar* src, int ti, int tj, int c, int q) {
    const u32x2 w = *(const LAS u32x2*)(src + ((16 * tj + c) * P + 16 * ti + 4 * q) * 2);
    return (f32x4){__uint_as_float(w.x << 16), __uint_as_float(w.x & 0xffff0000u), __uint_as_float(w.y << 16), __uint_as_float(w.y & 0xffff0000u)};
}
__device__ __forceinline__ void st_glob(bf16_t* dst, int ti, int tj, int c, int q, f32x4 v) {
    uint2 w; w.x = pk2(v[0], v[1]); w.y = pk2(v[2], v[3]); *(uint2*)(dst + (16 * tj + c) * 64 + 16 * ti + 4 * q) = w;
}
typedef float f32x16 __attribute__((ext_vector_type(16)));
__device__ __forceinline__ f32x16 mm32(const lchar* Aop, const lchar* Bop, int ti, int tj, int r32, int hi, f32x16 acc) {
#pragma unroll
    for (int ks = 0; ks < 4; ++ks) {
        const bf16x8 a = *(const LAS bf16x8*)(Aop + ((32 * ti + r32) * P + 16 * ks + 8 * hi) * 2);
        const bf16x8 b = *(const LAS bf16x8*)(Bop + ((32 * tj + r32) * P + 16 * ks + 8 * hi) * 2);
        acc = __builtin_amdgcn_mfma_f32_32x32x16_bf16(a, b, acc, 0, 0, 0);
    }
    return acc;
}
__device__ __forceinline__ void st32(lchar* dst, int ti, int tj, int r32, int hi, const f32x16& v) {
#pragma unroll
    for (int g = 0; g < 4; ++g) { u32x2 w; w.x = pk2(v[4 * g], v[4 * g + 1]); w.y = pk2(v[4 * g + 2], v[4 * g + 3]); *(LAS u32x2*)(dst + ((32 * tj + r32) * P + 32 * ti + 8 * g + 4 * hi) * 2) = w; }
}
__device__ __forceinline__ f32x16 ld32(const lchar* src, int ti, int tj, int r32, int hi) {
    f32x16 v;
#pragma unroll
    for (int g = 0; g < 4; ++g) { const u32x2 w = *(const LAS u32x2*)(src + ((32 * tj + r32) * P + 32 * ti + 8 * g + 4 * hi) * 2);
        v[4 * g] = __uint_as_float(w.x << 16); v[4 * g + 1] = __uint_as_float(w.x & 0xffff0000u); v[4 * g + 2] = __uint_as_float(w.y << 16); v[4 * g + 3] = __uint_as_float(w.y & 0xffff0000u); }
    return v;
}
__device__ __forceinline__ void stg32(bf16_t* dst, int ti, int tj, int r32, int hi, const f32x16& v) {
#pragma unroll
    for (int g = 0; g < 4; ++g) { uint2 w; w.x = pk2(v[4 * g], v[4 * g + 1]); w.y = pk2(v[4 * g + 2], v[4 * g + 3]); *(uint2*)(dst + (32 * tj + r32) * 64 + 32 * ti + 8 * g + 4 * hi) = w; }
}
}

#define LBAR() do { asm volatile("s_waitcnt lgkmcnt(0)" ::: "memory"); __builtin_amdgcn_s_barrier(); asm volatile("" ::: "memory"); } while (0)
__device__ void ph_rw_sc1(const Params& p, int j, char* lds) {
    using namespace ck;
    const int tid = tidx(), wid = __builtin_amdgcn_readfirstlane(tid >> 6), lane = tid & 63, c = lane & 15, q = lane >> 4;
    const size_t PL = (size_t)NROW * D;
    const bf16_t* RKV = (const bf16_t*)(p.ws + OFF_RKV); const float* LW = (const float*)(p.ws + OFF_W); const bf16_t* AV = (const bf16_t*)(p.ws + OFF_AV);
    bf16_t* CK = (bf16_t*)(p.ws + OFF_CK);
    lchar* B0 = (lchar*)lds;
#define BUF(i) (B0 + (i) * MB)
    LAS float* Lbuf = (LAS float*)BUF(8);
    LAS float* Lseg = (LAS float*)(B0 + 16 * MB);
    LAS float* GC = Lseg + 8 * 64;
    const int pt = tid >> 3, cg = tid & 7;
    f32x4 nlw[2], nkk[2], nka[2]; u32x4 nkx, nax, nrx, nvx;
#define SC1_LOAD(IT) do { const int seq_ = (IT) / NCHK, ch_ = (IT) % NCHK; const int z_ = seq_ & 1, h_ = (seq_ >> 1) & 15, b_ = seq_ >> 5; \
        const size_t go_ = (size_t)scan_row(ch_ * 64 + pt, b_, z_) * D + h_ * 64 + cg * 8; \
        _Pragma("unroll") for (int e = 0; e < 2; ++e) nlw[e] = *(const f32x4*)(LW + z_ * PL + go_ + 4 * e); \
        nkx = *(const u32x4*)(RKV + PL + go_); nax = *(const u32x4*)(AV + z_ * PL + go_); nrx = *(const u32x4*)(RKV + go_); nvx = *(const u32x4*)(RKV + 2 * PL + go_); \
        _Pragma("unroll") for (int e = 0; e < 2; ++e) { nkk[e] = *(const f32x4*)(p.rw_k_k + j * D + h_ * 64 + cg * 8 + 4 * e); nka[e] = *(const f32x4*)(p.rw_k_a + j * D + h_ * 64 + cg * 8 + 4 * e); } } while (0)
    if (bidx() < 128 * NCHK) SC1_LOAD(bidx());
    for (int it = bidx(); it < 128 * NCHK; it += gdim()) {
        const int seq = it / NCHK; const int h = (seq >> 1) & 15;
        f32x4 lw[2], kx[2], ax[2], rx[2], vx[2], kkc[2], kac[2];
#pragma unroll
        for (int e = 0; e < 2; ++e) { lw[e] = nlw[e]; kkc[e] = nkk[e]; kac[e] = nka[e];
            kx[e] = (f32x4){__uint_as_float(nkx[2 * e] << 16), __uint_as_float(nkx[2 * e] & 0xffff0000u), __uint_as_float(nkx[2 * e + 1] << 16), __uint_as_float(nkx[2 * e + 1] & 0xffff0000u)};
            ax[e] = (f32x4){__uint_as_float(nax[2 * e] << 16), __uint_as_float(nax[2 * e] & 0xffff0000u), __uint_as_float(nax[2 * e + 1] << 16), __uint_as_float(nax[2 * e + 1] & 0xffff0000u)};
            rx[e] = (f32x4){__uint_as_float(nrx[2 * e] << 16), __uint_as_float(nrx[2 * e] & 0xffff0000u), __uint_as_float(nrx[2 * e + 1] << 16), __uint_as_float(nrx[2 * e + 1] & 0xffff0000u)};
            vx[e] = (f32x4){__uint_as_float(nvx[2 * e] << 16), __uint_as_float(nvx[2 * e] & 0xffff0000u), __uint_as_float(nvx[2 * e + 1] << 16), __uint_as_float(nvx[2 * e + 1] & 0xffff0000u)}; }
        if (it + gdim() < 128 * NCHK) SC1_LOAD(it + gdim());
        LBAR();
#pragma unroll
        for (int e = 0; e < 2; ++e) *(LAS f32x4*)(Lbuf + pt * 64 + cg * 8 + 4 * e) = lw[e];
        f32x4 kk[2], bq[2], kd[2];
        { float ss = 0.f;
#pragma unroll
          for (int e = 0; e < 2; ++e) { kk[e] = kx[e] * kkc[e]; ss += kk[e][0] * kk[e][0] + kk[e][1] * kk[e][1] + kk[e][2] * kk[e][2] + kk[e][3] * kk[e][3]; }
          ss = dpp_sum8(ss); const float inv = __builtin_amdgcn_rsqf(fmaxf(ss, 1e-24f));
#pragma unroll
          for (int e = 0; e < 2; ++e) { kk[e] = kk[e] * inv; bq[e] = kk[e] * ax[e]; kd[e] = kx[e] * (1.f + (ax[e] - 1.f) * kac[e]); } }
        LBAR();
        { const int k = tid & 63, sg = tid >> 6; float run = 0.f;
#pragma unroll
          for (int u = 0; u < 8; ++u) { run += Lbuf[(sg * 8 + u) * 64 + k]; Lbuf[(sg * 8 + u) * 64 + k] = run; }
          Lseg[sg * 64 + k] = run; }
        LBAR();
        f32x4 Lt[2], Lp[2], Lc[2];
        { const int sg = pt >> 3, sgp = (pt - 1) >> 3;
#pragma unroll
          for (int e = 0; e < 2; ++e) { f32x4 o0 = {0.f, 0.f, 0.f, 0.f}, o1 = o0, oc = o0;
#pragma unroll
              for (int u = 0; u < 8; ++u) { const f32x4 sv = *(const LAS f32x4*)(Lseg + u * 64 + cg * 8 + 4 * e); if (u < sg) o0 = o0 + sv; if (u < sgp) o1 = o1 + sv; if (u < 7) oc = oc + sv; }
              Lt[e] = *(const LAS f32x4*)(Lbuf + pt * 64 + cg * 8 + 4 * e) + o0;
              Lp[e] = pt > 0 ? *(const LAS f32x4*)(Lbuf + (pt - 1) * 64 + cg * 8 + 4 * e) + o1 : (f32x4){0.f, 0.f, 0.f, 0.f};
              Lc[e] = *(const LAS f32x4*)(Lbuf + 63 * 64 + cg * 8 + 4 * e) + oc; } }
        LBAR();
        {
            float at[8], bt[8], kt[8], rt[8], bh[8], kh[8], vv[8];
#pragma unroll
            for (int e = 0; e < 2; ++e)
#pragma unroll
                for (int u = 0; u < 4; ++u) { const int x = 4 * e + u; const float eL = __expf(Lt[e][u]), emL = __expf(-Lt[e][u]), eP = __expf(Lp[e][u]), eC = __expf(Lc[e][u] - Lt[e][u]);
                    at[x] = -kk[e][u] * eP; bt[x] = bq[e][u] * emL; kt[x] = kd[e][u] * emL; rt[x] = rx[e][u] * eL; bh[x] = bq[e][u] * eC; kh[x] = kd[e][u] * eC; vv[x] = vx[e][u];
                    if (pt == 63) GC[cg * 8 + x] = eL; }
#define ST8(bufi, arr) do { u32x4 w_ = {pk2(arr[0], arr[1]), pk2(arr[2], arr[3]), pk2(arr[4], arr[5]), pk2(arr[6], arr[7])}; *(LAS u32x4*)(BUF(bufi) + (pt * P + cg * 8) * 2) = w_; } while (0)
            ST8(0, at); ST8(1, bt); ST8(2, kt); ST8(3, rt); ST8(8, bh); ST8(9, kh); ST8(10, vv);
#undef ST8
        }
        LBAR();
        {
            const int k = tid & 63, tg = tid >> 6;
#define TR8(src, dst) do { unsigned w_[4]; _Pragma("unroll") for (int x = 0; x < 4; ++x) { const unsigned lo = *(const LAS bf16_t*)(BUF(src) + ((tg * 8 + 2 * x) * P + k) * 2), hi2 = *(const LAS bf16_t*)(BUF(src) + ((tg * 8 + 2 * x + 1) * P + k) * 2); w_[x] = lo | (hi2 << 16); } \
                *(LAS u32x4*)(BUF(dst) + (k * P + tg * 8) * 2) = (u32x4){w_[0], w_[1], w_[2], w_[3]}; } while (0)
            TR8(0, 4); TR8(8, 5); TR8(9, 6); TR8(10, 7);
#undef TR8
        }
        LBAR();
        const f32x4 Z4 = {0.f, 0.f, 0.f, 0.f};
        const f32x16 Z16 = {0.f, 0.f, 0.f, 0.f, 0.f, 0.f, 0.f, 0.f, 0.f, 0.f, 0.f, 0.f, 0.f, 0.f, 0.f, 0.f};
        const int r32 = lane & 31, hi = lane >> 5;
#pragma unroll 1
        for (int u = 0; u < 3; ++u) { const int tl = u * 8 + wid; if (tl >= 20) break; const int m = tl >> 2, ti = (tl >> 1) & 1, tj = tl & 1; const int jj = 32 * tj + r32;
            if (m == 0) { f32x16 v = mm32(BUF(0), BUF(1), ti, tj, r32, hi, Z16), w;
#pragma unroll
                for (int e = 0; e < 16; ++e) { const int ii = 32 * ti + 8 * (e >> 2) + 4 * hi + (e & 3); const bool dg = (ii >> 4) == (jj >> 4);
                    v[e] = (dg && jj < ii) ? v[e] : 0.f; w[e] = v[e] + ((ii == jj) ? 1.f : 0.f); }
                st32(BUF(8), ti, tj, r32, hi, v); st32(BUF(14), ti, tj, r32, hi, w); }
            else if (m == 1) { const f32x16 v = mm32(BUF(1), BUF(0), ti, tj, r32, hi, Z16); f32x16 vd, vo, w;
#pragma unroll
                for (int e = 0; e < 16; ++e) { const int ii = 32 * ti + 8 * (e >> 2) + 4 * hi + (e & 3); const bool dg = (ii >> 4) == (jj >> 4), up = ii < jj;
                    vd[e] = (dg && up) ? v[e] : 0.f; vo[e] = (!dg && up) ? v[e] : 0.f; w[e] = vd[e] + ((ii == jj) ? 1.f : 0.f); }
                st32(BUF(9), ti, tj, r32, hi, vd); st32(BUF(15), ti, tj, r32, hi, vo); st32(BUF(13), ti, tj, r32, hi, w); }
            else if (m == 2) { f32x16 v = mm32(BUF(2), BUF(0), ti, tj, r32, hi, Z16);
#pragma unroll
                for (int e = 0; e < 16; ++e) { const int ii = 32 * ti + 8 * (e >> 2) + 4 * hi + (e & 3); v[e] = ii < jj ? v[e] : 0.f; }
                st32(BUF(10), ti, tj, r32, hi, v); }
            else { f32x16 v = mm32(m == 3 ? BUF(1) : BUF(2), BUF(3), ti, tj, r32, hi, Z16);
#pragma unroll
                for (int e = 0; e < 16; ++e) { const int ii = 32 * ti + 8 * (e >> 2) + 4 * hi + (e & 3); v[e] = ii <= jj ? v[e] : 0.f; }
                st32(m == 3 ? BUF(11) : BUF(12), ti, tj, r32, hi, v); } }
        LBAR();
#define WSYNC() asm volatile("s_waitcnt lgkmcnt(0)" ::: "memory")
        if (wid < 4) {
            const int tt = wid;
#define SQD(sr, st, dr, dt) do { const f32x4 a_ = mm_diag(BUF(st), BUF(sr), tt, c, q, Z4), b_ = mm_diag(BUF(sr), BUF(st), tt, c, q, Z4); WSYNC(); \
                st_tile(BUF(dr), tt, tt, c, q, a_); st_tile(BUF(dt), tt, tt, c, q, b_); WSYNC(); } while (0)
#define UPD(pr) do { const f32x4 dt_ = mm_diag(BUF(pr), BUF(13), tt, c, q, ld_tile(BUF(13), tt, tt, c, q)); \
                const f32x4 dr_ = mm_diag(BUF(13), BUF(pr), tt, c, q, ld_tile(BUF(14), tt, tt, c, q)); WSYNC(); \
                st_tile(BUF(13), tt, tt, c, q, dt_); st_tile(BUF(14), tt, tt, c, q, dr_); WSYNC(); } while (0)
            SQD(8, 9, 0, 1); UPD(0); SQD(0, 1, 8, 9); UPD(8); SQD(8, 9, 0, 1); UPD(0);
#undef SQD
#undef UPD
        } else {
            const int ti = (wid >> 1) & 1, tj = wid & 1; st32(BUF(2), ti, tj, r32, hi, mm32(BUF(10), BUF(7), ti, tj, r32, hi, Z16));
        }
        LBAR();
        { const int m = wid >> 2, ti = (wid >> 1) & 1, tj = wid & 1;
          if (m == 0) st32(BUF(8), ti, tj, r32, hi, mm32(BUF(15), BUF(14), ti, tj, r32, hi, Z16));
          else        st32(BUF(9), ti, tj, r32, hi, mm32(BUF(14), BUF(15), ti, tj, r32, hi, Z16)); }
        LBAR();
        if (wid < 4) { const int ti = (wid >> 1) & 1, tj = wid & 1; st32(BUF(0), ti, tj, r32, hi, mm32(BUF(9), BUF(8), ti, tj, r32, hi, Z16)); }
        LBAR();
        if (wid < 4) { const int ti = (wid >> 1) & 1, tj = wid & 1; st32(BUF(1), ti, tj, r32, hi, mm32(BUF(0), BUF(13), ti, tj, r32, hi, ld32(BUF(13), ti, tj, r32, hi))); }
        LBAR();
        if (wid < 4) { const int ti = (wid >> 1) & 1, tj = wid & 1; st32(BUF(14), ti, tj, r32, hi, mm32(BUF(8), BUF(1), ti, tj, r32, hi, ld32(BUF(1), ti, tj, r32, hi))); }
        LBAR();
        { const int m = wid >> 2, ti = (wid >> 1) & 1, tj = wid & 1;
          if (m == 0) st32(BUF(8), ti, tj, r32, hi, mm32(BUF(14), BUF(4), ti, tj, r32, hi, Z16));
          else        st32(BUF(0), ti, tj, r32, hi, mm32(BUF(14), BUF(2), ti, tj, r32, hi, Z16)); }
        LBAR();
        bf16_t* ckp = CK + (size_t)it * 4 * 4096;
#pragma unroll 1
        for (int u = 0; u < 2; ++u) { const int tl = u * 8 + wid, m = tl >> 2, ti = (tl >> 1) & 1, tj = tl & 1;
            if (m == 0) { f32x16 v = mm32(BUF(8), BUF(5), ti, tj, r32, hi, Z16); const int jj = 32 * tj + r32; const float gc = GC[jj];
#pragma unroll
                for (int e = 0; e < 16; ++e) { const int ii = 32 * ti + 8 * (e >> 2) + 4 * hi + (e & 3); v[e] += (ii == jj) ? gc : 0.f; }
                st32(BUF(1), ti, tj, r32, hi, v); }
            else if (m == 1) st32(BUF(4), ti, tj, r32, hi, mm32(BUF(8), BUF(11), ti, tj, r32, hi, ld32(BUF(3), ti, tj, r32, hi)));
            else if (m == 2) st32(BUF(2), ti, tj, r32, hi, mm32(BUF(6), BUF(7), ti, tj, r32, hi, mm32(BUF(5), BUF(0), ti, tj, r32, hi, Z16)));
            else             st32(BUF(9), ti, tj, r32, hi, mm32(BUF(7), BUF(12), ti, tj, r32, hi, mm32(BUF(0), BUF(11), ti, tj, r32, hi, Z16))); }
        LBAR();
        { const int orow = tid >> 3, oc = (tid & 7) * 8;
          *(u32x4*)(ckp + orow * 64 + oc) = *(const LAS u32x4*)(BUF(1) + (orow * P + oc) * 2);
          *(u32x4*)(ckp + 4096 + orow * 64 + oc) = *(const LAS u32x4*)(BUF(2) + (orow * P + oc) * 2);
          *(u32x4*)(ckp + 2 * 4096 + orow * 64 + oc) = *(const LAS u32x4*)(BUF(4) + (orow * P + oc) * 2);
          *(u32x4*)(ckp + 3 * 4096 + orow * 64 + oc) = *(const LAS u32x4*)(BUF(9) + (orow * P + oc) * 2); }
    }
#undef BUF
#undef SC1_LOAD
}

__device__ void ph_rw_sc2(const Params& p, char* lds) {
    using namespace ck;
    const int tid = tidx(), wid = __builtin_amdgcn_readfirstlane(tid >> 6), lane = tid & 63, c = lane & 15, q = lane >> 4;
    const size_t PL = (size_t)NROW * D;
    const bf16_t* CK = (const bf16_t*)(p.ws + OFF_CK); bf16_t* Y = (bf16_t*)(p.ws + OFF_Y);
    lchar* GB = (lchar*)lds;
    lchar* RB = GB + 2 * MB;
    lchar* SB = GB + 4 * MB;
    constexpr int SBB = 32 * P * 2;
    for (int it = bidx(); it < 256; it += gdim()) {
        const int vh = it & 1, seq = it >> 1, z = seq & 1, h = (seq >> 1) & 15, b = seq >> 5;
        const bf16_t* ck0 = CK + (size_t)seq * NCHK * 4 * 4096;
        const int s_ti = wid & 3, s_tj = wid >> 2;
        const int y_ti = wid & 1, y_tj = wid >> 1;
        const int hoff = 4096 + (vh * 32 + 16 * s_tj + c) * 64 + 16 * s_ti + 4 * q, yoff = 3 * 4096 + (16 * y_tj + c) * 64 + vh * 32 + 16 * y_ti + 4 * q;
        struct PF { u32x4 g, r; uint2 h, y; };
#define PF_LOAD(X, k) do { const bf16_t* cc_ = ck0 + (size_t)(k) * 4 * 4096; X.h = *(const uint2*)(cc_ + hoff); X.y = *(const uint2*)(cc_ + yoff); X.g = *(const u32x4*)(cc_ + tid * 8); X.r = *(const u32x4*)(cc_ + 2 * 4096 + tid * 8); } while (0)
#define PF_STAGE(X, bufi) do { *(LAS u32x4*)(GB + (bufi) * MB + ((tid >> 3) * P + (tid & 7) * 8) * 2) = X.g; *(LAS u32x4*)(RB + (bufi) * MB + ((tid >> 3) * P + (tid & 7) * 8) * 2) = X.r; } while (0)
#define SC2_STEP(k, CUR, NXT) do { const uint2 hi_ = CUR.h, yi_ = CUR.y; const int cur = (k) & 1; \
            if ((k) + 4 < NCHK) PF_LOAD(CUR, (k) + 4); \
            const f32x4 hinit = {__uint_as_float(hi_.x << 16), __uint_as_float(hi_.x & 0xffff0000u), __uint_as_float(hi_.y << 16), __uint_as_float(hi_.y & 0xffff0000u)}; \
            const f32x4 yinit = {__uint_as_float(yi_.x << 16), __uint_as_float(yi_.x & 0xffff0000u), __uint_as_float(yi_.y << 16), __uint_as_float(yi_.y & 0xffff0000u)}; \
            const lchar* Sold = SB + cur * SBB; lchar* Snew = SB + (cur ^ 1) * SBB; \
            const f32x4 sn = mm_tile(GB + cur * MB, Sold, s_ti, s_tj, c, q, hinit);        \
            const f32x4 yv = mm_tile(Sold, RB + cur * MB, y_ti, y_tj, c, q, yinit);        \
            st_tile(Snew, s_ti, s_tj, c, q, sn); \
            { const int row = scan_row((k) * 64 + 16 * y_tj + c, b, z); stbf4(Y + z * PL + (size_t)row * D + h * 64 + vh * 32 + 16 * y_ti + 4 * q, yv); } \
            if ((k) + 1 < NCHK) PF_STAGE(NXT, cur ^ 1); \
            LBAR(); } while (0)
        PF s0, s1, s2, s3;
        PF_LOAD(s0, 0); PF_LOAD(s1, 1); PF_LOAD(s2, 2); PF_LOAD(s3, 3);
        LBAR();
        for (int i = tid; i < SBB / 4; i += NTHR) ((LAS unsigned*)SB)[i] = 0u;
        PF_STAGE(s0, 0);
        LBAR();
        for (int ch = 0; ch < NCHK; ch += 4) {
            SC2_STEP(ch, s0, s1); SC2_STEP(ch + 1, s1, s2); SC2_STEP(ch + 2, s2, s3); SC2_STEP(ch + 3, s3, s0);
        }
#undef PF_LOAD
#undef PF_STAGE
#undef SC2_STEP
    }
}
#undef LBAR

__device__ void ph_rw_out(const Params& p, int j, int nrows) {
    const int wid = tidx() >> 6, lane = tidx() & 63;
    const bf16_t* RKV = (const bf16_t*)(p.ws + OFF_RKV); const bf16_t* AV = (const bf16_t*)(p.ws + OFF_AV); const bf16_t* G = (const bf16_t*)(p.ws + OFF_G); const bf16_t* Y = (const bf16_t*)(p.ws + OFF_Y);
    bf16_t* OUT = (bf16_t*)(p.ws + OFF_H);
    const size_t PL = (size_t)NROW * D;
    const float* r_k = p.rw_r_k + j * D; const float* lg = p.rw_lnx_g + j * D; const float* lb = p.rw_lnx_b + j * D; const float* k_a = p.rw_k_a + j * D;
    uint2 nb[8][4];
#define OUT_LOAD(R) do { _Pragma("unroll") for (int i = 0; i < 4; ++i) { const size_t o_ = (size_t)(R) * D + lane * 4 + i * 256; \
        nb[0][i] = *(const uint2*)(Y + o_); nb[1][i] = *(const uint2*)(Y + PL + o_); nb[2][i] = *(const uint2*)(RKV + o_); nb[3][i] = *(const uint2*)(RKV + PL + o_); \
        nb[4][i] = *(const uint2*)(RKV + 2 * PL + o_); nb[5][i] = *(const uint2*)(AV + o_); nb[6][i] = *(const uint2*)(AV + PL + o_); nb[7][i] = *(const uint2*)(G + o_); } } while (0)
#define UNPK(w) ((f32x4){__uint_as_float((w).x << 16), __uint_as_float((w).x & 0xffff0000u), __uint_as_float((w).y << 16), __uint_as_float((w).y & 0xffff0000u)})
    int row = bidx() * 8 + wid;
    if (row < nrows) OUT_LOAD(row);
    for (; row < nrows; row += gdim() * 8) {
        uint2 cb[8][4];
#pragma unroll
        for (int q_ = 0; q_ < 8; ++q_)
#pragma unroll
            for (int i = 0; i < 4; ++i) cb[q_][i] = nb[q_][i];
        { const int nrow = row + gdim() * 8; if (nrow < nrows) OUT_LOAD(nrow); }
#pragma unroll
        for (int i = 0; i < 4; ++i) {
            const size_t o = (size_t)row * D + lane * 4 + i * 256; const int c = lane * 4 + i * 256;
            const f32x4 y = UNPK(cb[0][i]) + UNPK(cb[1][i]);
            const float mean = dpp_sum16(y[0] + y[1] + y[2] + y[3]) * (1.f / 64.f);
            const f32x4 dd = y - mean;
            const float rstd = rsqrtf(dpp_sum16(dd[0] * dd[0] + dd[1] * dd[1] + dd[2] * dd[2] + dd[3] * dd[3]) * (1.f / 64.f) + LNX_EPS);
            const f32x4 r = UNPK(cb[2][i]), k = UNPK(cb[3][i]), v = UNPK(cb[4][i]);
            const f32x4 a0 = UNPK(cb[5][i]), a1 = UNPK(cb[6][i]);
            const f32x4 kds = k * (2.f + (a0 + a1 - 2.f) * *(const f32x4*)(k_a + c));
            const f32x4 t4 = r * kds * *(const f32x4*)(r_k + c);
            const float bs = dpp_sum16(t4[0] + t4[1] + t4[2] + t4[3]);
            const f32x4 res = (dd * rstd * *(const f32x4*)(lg + c) + *(const f32x4*)(lb + c) + bs * v) * UNPK(cb[7][i]);
            uint2 w; w.x = pk2(res[0], res[1]); w.y = pk2(res[2], res[3]); *(uint2*)(OUT + o) = w;
        }
    }
#undef OUT_LOAD
#undef UNPK
}

__device__ void ph_final(const Params& p) {
    const int wid = tidx() >> 6, lane = tidx() & 63;
    const float* X = (const float*)(p.ws + OFF_X);
    for (int row = bidx() * 8 + wid; row < NLAT; row += gdim() * 8) {
        const float4* xr = (const float4*)(X + (size_t)row * D);
        float4 v[4]; float ss = 0;
#pragma unroll
        for (int i = 0; i < 4; ++i) { v[i] = xr[lane + i * 64]; ss += v[i].x * v[i].x + v[i].y * v[i].y + v[i].z * v[i].z + v[i].w * v[i].w; }
        ss = wave_sum(ss); const float rs = rsqrtf(ss * (1.f / D) + RMS_EPS);
#pragma unroll
        for (int i = 0; i < 4; ++i) { const int d = (lane + i * 64) * 4; const float4 gg = *(const float4*)(p.final_g + d);
            float4 o; o.x = v[i].x * rs * gg.x; o.y = v[i].y * rs * gg.y; o.z = v[i].z * rs * gg.z; o.w = v[i].w * rs * gg.w;
            *(float4*)(p.out + (size_t)row * D + d) = o; }
    }
}

enum { PH_INIT = 0, PH_A_NORM, PH_A_Z, PH_A_MID, PH_A_QKV, PH_A_POST, PH_A_ATTN, PH_A_WO,
       PH_R_NORM, PH_R_XS, PH_R_G1, PH_R_G2, PH_R_PREP, PH_R_SCAN, PH_R_OUT, PH_R_WO,
       PH_M_NORM, PH_M_SEL, PH_M_GATHER, PH_M_G1, PH_M_G2, PH_M_COMB, PH_FINAL, PH_M_CVT, PH_R_SC1, PH_R_SC2 };

template <int PH>
__device__ __forceinline__ void run_phase(const Params& p, int layer, char* lds) {
    const int j = layer >> 1;
    char* ws = p.ws;
    if constexpr (PH == PH_INIT) { ph_init(p, lds); __syncthreads(); ph_small_cvt(p, lds); }
    else if constexpr (PH == PH_A_NORM) { if (layer == 0) ph_norm_mod<false>(p, layer, p.norm1_g + layer * D, 0, 1, ws + OFF_H); else ph_comb_norm<false>(p, layer - 1, layer, NROW); }
    else if constexpr (PH == PH_A_Z) {
        float* Z = (float*)(ws + OFF_Z);
        g8::BatchSched S{ws + OFF_H, ws + OFF_WMLA + j * SZ_WMLA + WM_IN, 0, 0, NROW / 256, 2, 1, D};
        g8::gemm_phase(p.wv, (PG8_LAS unsigned char*)lds, D, S, g8::epi_rc([=](const g8::Unit&, int row, int col, f32x4 v) { *(f32x4*)(Z + (size_t)row * 512 + col) = v; }));
    }
    else if constexpr (PH == PH_A_MID) ph_mla_mid(p, j);
    else if constexpr (PH == PH_A_QKV) {
        bf16_t* Q = (bf16_t*)(ws + OFF_Q); bf16_t* K = (bf16_t*)(ws + OFF_K); bf16_t* V = (bf16_t*)(ws + OFF_V);
        g8::BatchSched S1{ws + OFF_CQN, ws + OFF_WMLA + j * SZ_WMLA + WM_UQ, 0, 0, NROW / 256, 6, 1, 256};
        g8::gemm_phase(p.wv, (PG8_LAS unsigned char*)lds, 256, S1, g8::epi_rc([=](const g8::Unit&, int row, int col, f32x4 v) {
            const bool lat = row < NLAT; const int b = lat ? (row >> 12) : ((row - NLAT) >> 8); const int tk = lat ? 256 + (row & (TL - 1)) : ((row - NLAT) & 255);
            const int h = col / 192, d = col - h * 192;
            uint2 w; w.x = pk2(v[0], v[1]); w.y = pk2(v[2], v[3]);
            *(uint2*)(Q + ((size_t)(b * 8 + h) * TK + tk) * 192 + d) = w; }));
        g8::BatchSched S2{ws + OFF_CKVN, ws + OFF_WMLA + j * SZ_WMLA + WM_UKV, 0, 0, NROW / 256, 8, 1, 256};
        g8::gemm_phase(p.wv, (PG8_LAS unsigned char*)lds, 256, S2, g8::epi_rc([=](const g8::Unit&, int row, int col, f32x4 v) {
            const bool lat = row < NLAT; const int b = lat ? (row >> 12) : ((row - NLAT) >> 8); const int tk = lat ? 256 + (row & (TL - 1)) : ((row - NLAT) & 255);
            const int h = col >> 8, d = col & 255; const size_t orow = (size_t)(b * 8 + h) * TK + tk;
            uint2 w; w.x = pk2(v[0], v[1]); w.y = pk2(v[2], v[3]);
            if (d < 128) *(uint2*)(K + orow * 192 + d) = w; else *(uint2*)(V + orow * 128 + (d - 128)) = w; }));
    }
    else if constexpr (PH == PH_A_ATTN) ph_attn(p, lds);
    else if constexpr (PH == PH_A_WO || PH == PH_R_WO) {
        xt_t* X = (xt_t*)(ws + OFF_X); const float* MOD = (const float*)(ws + OFF_MOD);
        g8::BatchSched S{ws + (PH == PH_A_WO ? OFF_O : OFF_H), PH == PH_A_WO ? ws + OFF_WMLA + j * SZ_WMLA + WM_O : ws + OFF_WRW + j * SZ_WRW + WR_O, 0, 0, (layer < 3 ? NROW : NLAT) / 256, 4, 1, D};
        g8::gemm_phase(p.wv, (PG8_LAS unsigned char*)lds, D, S, g8::EpiResid{X, MOD, layer});
    }
    else if constexpr (PH == PH_R_XS) ph_rw_normxs(p, layer, j);
    else if constexpr (PH == PH_R_G1) {
        bf16_t* RKV = (bf16_t*)(ws + OFF_RKV); bf16_t* VF = (bf16_t*)(ws + OFF_VFIRST);
        bf16_t* A2 = (bf16_t*)(ws + OFF_A2); bf16_t* A3 = (bf16_t*)(ws + OFF_A3);
        const bool first = (j == 0);
        struct RSched { const char* XS; const char* WB; int nwg;
            __device__ __forceinline__ bool next(int i, g8::Unit& u) const {
                const int L = i * gdim() + bidx(); if (L >= nwg) return false;
                const int w = g8::xcd_remap(L, nwg);
                if (w < 816) { u.g = w / 272; const int r = w % 272; u.pm = r >> 2; u.pn = r & 3; u.B = WB + WR_RKV + (size_t)u.g * D * D * 2 + (size_t)u.pn * 256 * D * 2; }
                else { u.g = 3 + (w - 816) / 68; u.pm = (w - 816) % 68; u.pn = 0; u.B = WB + WR_L + (size_t)(u.g - 3) * 256 * D * 2; }
                u.A = XS + (size_t)(u.g == 6 ? 2 : u.g) * NROW * D * 2 + (size_t)u.pm * 256 * D * 2; return true; } };
        RSched S{ws + OFF_XS, ws + OFF_WRW + j * SZ_WRW, first ? 816 + 204 : 816 + 272};
        g8::gemm_phase(p.wv, (PG8_LAS unsigned char*)lds, D, S, g8::epi_rc([=](const g8::Unit& u, int row, int col, f32x4 v) {
            if (u.g < 3) { stbf4(RKV + ((size_t)u.g * NROW + row) * D + col, v); if (first && u.g == 2) stbf4(VF + (size_t)row * D + col, v); }
            else if (u.g == 3) { if (col < 128) { f32x4 t; for (int e = 0; e < 4; ++e) t[e] = 1.f - 2.f * __builtin_amdgcn_rcpf(1.f + __expf(2.f * v[e]));
                uint2 w; w.x = pk2(t[0], t[1]); w.y = pk2(t[2], t[3]); *(uint2*)(A2 + (size_t)row * 256 + col) = w; } }
            else if (u.g == 4) { if (col < 128) { uint2 w; w.x = pk2(v[0], v[1]); w.y = pk2(v[2], v[3]); *(uint2*)(A2 + (size_t)row * 256 + 128 + col) = w; } }
            else if (u.g == 5) { uint2 w; if (col < 128) { w.x = pk2(sigmoidf_(v[0]), sigmoidf_(v[1])); w.y = pk2(sigmoidf_(v[2]), sigmoidf_(v[3])); } else { w.x = 0u; w.y = 0u; }
                                 if (col < 128 || first || col >= 160) *(uint2*)(A3 + (size_t)row * 256 + col) = w; }
            else { if (col < 32) { uint2 w; w.x = pk2(v[0], v[1]); w.y = pk2(v[2], v[3]); *(uint2*)(A3 + (size_t)row * 256 + 128 + col) = w; } } }));
    }
    else if constexpr (PH == PH_R_G2) {
        const bool first = (j == 0);
        float* W = (float*)(ws + OFF_W); bf16_t* AV = (bf16_t*)(ws + OFF_AV); bf16_t* G = (bf16_t*)(ws + OFF_G); bf16_t* RKV = (bf16_t*)(ws + OFF_RKV); const bf16_t* VF = (const bf16_t*)(ws + OFF_VFIRST);
        const float* w0 = p.rw_w0 + (size_t)j * 2 * D; const float* a0 = p.rw_a0 + (size_t)j * 2 * D; const float* v0 = p.rw_v0;
        g8::BatchSched S1{ws + OFF_A2, ws + OFF_WRW + j * SZ_WRW + WR_B2, 0, 0, NROW / 256, 16, 1, 256};
        g8::gemm_phase(p.wv, (PG8_LAS unsigned char*)lds, 256, S1, g8::epi_colfirst([=](const g8::Unit& u, int row, int col, f32x4 v, f32x4 bias) {
            const int blk = u.pn >> 2, c = col & 1023; const bool dec = blk < 2;
            const size_t doff = (size_t)(dec ? blk : blk - 2) * NROW * D + (size_t)row * D + c;
            const f32x4 x = v + bias; f32x4 o;
#pragma unroll
            for (int e = 0; e < 4; ++e) { const float sg = __builtin_amdgcn_rcpf(1.f + __expf(-x[e])); o[e] = dec ? (-0.6065306597126334f * sg) : sg; }
            if (dec) *(f32x4*)(W + doff) = o; else stbf4(AV + doff, o); },
            [=](const g8::Unit& u, int col) { const int blk = u.pn >> 2, c = col & 1023; return *(const f32x4*)((blk < 2 ? w0 + blk * D : a0 + (blk - 2) * D) + c); }));
        g8::BatchSched S2{ws + OFF_A3, ws + OFF_WRW + j * SZ_WRW + WR_B3, 0, 0, NROW / 256, first ? 4 : 8, 1, 256};
        g8::gemm_phase(p.wv, (PG8_LAS unsigned char*)lds, 256, S2, g8::epi_rc([=](const g8::Unit&, int row, int col, f32x4 v) {
            if (col < 1024) stbf4(G + (size_t)row * D + col, v);
            else { const int c = col - 1024; const size_t o = (size_t)row * D + c; const f32x4 vv = ldbf4(RKV + (size_t)2 * NROW * D + o), vf = ldbf4(VF + o), gz = v + *(const f32x4*)(v0 + c); f32x4 r;
#pragma unroll
                for (int e = 0; e < 4; ++e) r[e] = vv[e] + (vf[e] - vv[e]) * __builtin_amdgcn_rcpf(1.f + __expf(-gz[e]));
                stbf4(RKV + (size_t)2 * NROW * D + o, r); } }));
    }
    else if constexpr (PH == PH_R_SCAN) ph_rw_scan(p, j, lds);
    else if constexpr (PH == PH_R_SC1) ph_rw_sc1(p, j, lds);
    else if constexpr (PH == PH_R_SC2) ph_rw_sc2(p, lds);
    else if constexpr (PH == PH_R_OUT) ph_rw_out(p, j, layer < 3 ? NROW : NLAT);
    else if constexpr (PH == PH_M_NORM) ph_norm2_router(p, layer, lds, layer < 3 ? NROW : NLAT);
    else if constexpr (PH == PH_M_SEL) { ph_select(p, lds, layer < 3 ? 128 : 64); __syncthreads(); ph_moe_cvt(p, layer, lds); }
    else if constexpr (PH == PH_M_GATHER) ph_gather(p, layer < 3 ? ESLOTS : NB * CAPL);
    else if constexpr (PH == PH_M_G1) {
        bf16_t* HID = (bf16_t*)(ws + OFF_HID);
        g8::BatchSched S{ws + OFF_XE, ws + OFF_W13T, (size_t)EPAD * D * 2, (size_t)2816 * D * 2, layer < 3 ? 9 : 8, 11, NE, D};
        g8::gemm_phase(p.wv, (PG8_LAS unsigned char*)lds, D, S, g8::epi_pair([=](const g8::Unit& u, int row, int col, f32x4 a, f32x4 b) {
            uint2 w; w.x = pk2(a[0] * __builtin_amdgcn_rcpf(1.f + __expf(-a[0])) * b[0], a[1] * __builtin_amdgcn_rcpf(1.f + __expf(-a[1])) * b[1]); w.y = pk2(a[2] * __builtin_amdgcn_rcpf(1.f + __expf(-a[2])) * b[2], a[3] * __builtin_amdgcn_rcpf(1.f + __expf(-a[3])) * b[3]);
            *(uint2*)(HID + ((size_t)u.g * EPAD + row) * FF + col) = w; }));
    }
    else if constexpr (PH == PH_M_G2) {
        bf16_t* YE = (bf16_t*)(ws + OFF_YE); const float* GATE = (const float*)(ws + OFF_GATE);
        g8::BatchSched S{ws + OFF_HID, ws + OFF_W2T, (size_t)EPAD * FF * 2, (size_t)D * FF * 2, layer < 3 ? 9 : 8, 4, NE, FF};
        g8::gemm_phase(p.wv, (PG8_LAS unsigned char*)lds, FF, S, g8::epi_pre([=](const g8::Unit& u, int row, int col, f32x4 v, f32x4, float gt) {
            uint2 w; w.x = pk2(v[0] * gt, v[1] * gt); w.y = pk2(v[2] * gt, v[3] * gt);
            *(uint2*)(YE + ((size_t)u.g * EPAD + row) * D + col) = w; },
            [=](const g8::Unit&, int) { return (f32x4){0.f, 0.f, 0.f, 0.f}; }, [=](const g8::Unit& u, int row) { return GATE[u.g * EPAD + row]; }));
    }
    else if constexpr (PH == PH_M_COMB) ph_combine(p, layer, layer < 3 ? NROW : NLAT);
    else if constexpr (PH == PH_M_CVT) ph_moe_cvt(p, layer, lds);
    else if constexpr (PH == PH_FINAL) ph_comb_norm<true>(p, 3, 0, NLAT);
}

#if ONE_LAUNCH
#define SYNC() xcd_barrier(bar)
#ifndef PROBE_PH
#define PROBE_PH -1
#endif
#ifndef PROBE_REP
#define PROBE_REP 1
#endif
__device__ __forceinline__ Params load_params() {
    Params q{};
#if defined(__HIP_DEVICE_COMPILE__)
    typedef const __attribute__((address_space(4))) unsigned long long* KargP;
    KargP kp_ = (KargP)__builtin_amdgcn_kernarg_segment_ptr(); asm volatile("" : "+s"(kp_));
#pragma unroll
    for (int i = 0; i < 40; ++i) ((const float**)&q)[i] = (const float*)(const __attribute__((address_space(1))) float*)kp_[i];
#endif
    return q;
}
#define RUN(PH) do { for (int rep_ = 0; rep_ < ((PH) == PROBE_PH ? PROBE_REP : 1); ++rep_) { Params q = load_params(); q.wv = wv0_; run_phase<PH>(q, layer, smem); SYNC(); } } while (0)
__global__ void __launch_bounds__(NTHR, 2) mega(Params p) {
    extern __shared__ __attribute__((aligned(16))) char smem[];
    const int wv0_ = __builtin_amdgcn_readfirstlane((int)threadIdx.x >> 6);
    if (threadIdx.x == 0) *(uint4*)(smem + LDS_BYTES) = make_uint4(0u, 0u, 0u, 0u);
    __syncthreads();
    XcdBarrier bar = xcd_barrier_post((unsigned*)(p.ws + OFF_BAR), (volatile LAS unsigned*)(smem + LDS_BYTES));
    { const int layer = 0; RUN(PH_INIT); }
    for (int layer = 0; layer < 4; ++layer) {
        if ((layer & 1) == 0) {
            RUN(PH_A_NORM);
            RUN(PH_A_Z);
            RUN(PH_A_MID);
            RUN(PH_A_QKV);
            RUN(PH_A_ATTN);
            RUN(PH_A_WO);
        } else {
            RUN(PH_R_XS);
            RUN(PH_R_G1);
            RUN(PH_R_G2);
            RUN(PH_R_SC1);
            RUN(PH_R_SC2);
            RUN(PH_R_OUT);
            RUN(PH_R_WO);
        }
        RUN(PH_M_NORM);
        RUN(PH_M_SEL);
        RUN(PH_M_G1);
        RUN(PH_M_G2);
        if ((layer & 1) == 0) RUN(PH_M_COMB);
    }
    { Params q = load_params(); q.wv = wv0_; run_phase<PH_FINAL>(q, 0, smem); }
}
#else
template <int PH> __global__ void __launch_bounds__(NTHR, 2) kph(Params p, int layer) {
    extern __shared__ __attribute__((aligned(16))) char smem[];
    Params q = p; q.wv = __builtin_amdgcn_readfirstlane((int)threadIdx.x >> 6);
    run_phase<PH>(q, layer, smem);
}
#endif

extern "C" void kernel_launch(void* const* d_in, const int* in_sizes, int n_in, void* d_out, int out_size, void* d_ws, size_t ws_size, hipStream_t stream) {
    if (n_in != 38 || ws_size < WS_NEED) { fprintf(stderr, "kernel_launch: bad args n_in %d ws %zu need %zu\n", n_in, ws_size, (size_t)WS_NEED); return; }
    Params p{};
    const float** pp = (const float**)&p;
    for (int i = 0; i < 38; ++i) pp[i] = (const float*)d_in[i];
    p.out = (float*)d_out; p.ws = (char*)d_ws;
    static int cus = 0;
    if (!cus) { int dev = 0; hipGetDevice(&dev); hipDeviceGetAttribute(&cus, hipDeviceAttributeMultiprocessorCount, dev); if (cus <= 0) cus = 256; }
    const int grid = cus;
#if ONE_LAUNCH
    hipFuncSetAttribute((const void*)mega, hipFuncAttributeMaxDynamicSharedMemorySize, LDS_BYTES + 16);
    hipMemsetAsync(d_ws, 0, 16384, stream);
    hipLaunchKernelGGL(mega, dim3(grid), dim3(NTHR), LDS_BYTES + 16, stream, p);
#else
    hipMemsetAsync(d_ws, 0, 16384, stream);
#define LAUNCH(PH, L) do { hipFuncSetAttribute((const void*)kph<PH>, hipFuncAttributeMaxDynamicSharedMemorySize, LDS_BYTES + 16); hipLaunchKernelGGL(kph<PH>, dim3(grid), dim3(NTHR), LDS_BYTES + 16, stream, p, L); } while (0)
    LAUNCH(PH_INIT, 0);
    for (int layer = 0; layer < 4; ++layer) {
        if ((layer & 1) == 0) { LAUNCH(PH_A_NORM, layer); LAUNCH(PH_A_Z, layer); LAUNCH(PH_A_MID, layer); LAUNCH(PH_A_QKV, layer); LAUNCH(PH_A_ATTN, layer); LAUNCH(PH_A_WO, layer); }
        else { LAUNCH(PH_R_XS, layer); LAUNCH(PH_R_G1, layer); LAUNCH(PH_R_G2, layer); LAUNCH(PH_R_SC1, layer); LAUNCH(PH_R_SC2, layer); LAUNCH(PH_R_OUT, layer); LAUNCH(PH_R_WO, layer); }
        LAUNCH(PH_M_NORM, layer); LAUNCH(PH_M_SEL, layer); LAUNCH(PH_M_G1, layer); LAUNCH(PH_M_G2, layer); if ((layer & 1) == 0) LAUNCH(PH_M_COMB, layer);
    }
    LAUNCH(PH_FINAL, 0);
#endif
}
```

```cpp
#include <hip/hip_runtime.h>
#include <stdint.h>
#include <stdio.h>

#ifndef ONE_LAUNCH
#define ONE_LAUNCH 1
#endif

#define NTHR 512
typedef unsigned short bf16_t;
typedef short bf16x8 __attribute__((ext_vector_type(8)));
typedef float f32x4 __attribute__((ext_vector_type(4)));
typedef unsigned u32x4 __attribute__((ext_vector_type(4)));
typedef unsigned u32x2 __attribute__((ext_vector_type(2)));

constexpr int D = 1024, NB = 4, TL = 4096, TC = 256, NLAT = NB * TL, NCTX = NB * TC, NROW = NLAT + NCTX;
constexpr int TK = TL + TC;
constexpr int NE = 16, FF = 1408, CAPL = 512, CAPC = 32, ESLOTS = NB * CAPL + NB * CAPC;
constexpr int EPAD = 2304;
constexpr float RMS_EPS = 1e-6f, LNX_EPS = 64e-5f;
constexpr float ATT_SCALE = 0.07216878364870322f;

constexpr size_t al256(size_t x) { return (x + 255) / 256 * 256; }
constexpr size_t OFF_BAR = 0;
constexpr size_t OFF_QUEUE = 14336;
constexpr size_t OFF_MOD = 16384;
constexpr size_t OFF_ROPE_C = OFF_MOD + al256(4 * 5 * 6144 * 4);
constexpr size_t OFF_ROPE_S = OFF_ROPE_C + al256(TL * 32 * 4);
constexpr size_t OFF_X = OFF_ROPE_S + al256(TL * 32 * 4);
constexpr size_t SZ_F32 = (size_t)NROW * D * 4, SZ_BF = (size_t)NROW * D * 2;
constexpr size_t OFF_VFIRST = OFF_X + SZ_F32;
constexpr size_t OFF_H = OFF_VFIRST + SZ_F32;
constexpr size_t SZ_WMLA = (size_t)(512 * 1024 + 1536 * 256 + 2048 * 256 + 1024 * 1024) * 2;
constexpr size_t WM_IN = 0, WM_UQ = (size_t)512 * 1024 * 2, WM_UKV = WM_UQ + (size_t)1536 * 256 * 2, WM_O = WM_UKV + (size_t)2048 * 256 * 2;
constexpr size_t SZ_WRW = (size_t)(3 * 1024 * 1024 + 4 * 256 * 1024 + 1024 * 1024 + 4096 * 256 + 2048 * 256) * 2;
constexpr size_t WR_RKV = 0, WR_L = (size_t)3 * 1024 * 1024 * 2, WR_O = WR_L + (size_t)4 * 256 * 1024 * 2, WR_B2 = WR_O + (size_t)1024 * 1024 * 2, WR_B3 = WR_B2 + (size_t)4096 * 256 * 2;
constexpr size_t OFF_WMLA = OFF_H + SZ_BF;
constexpr size_t OFF_WRW = OFF_WMLA + 2 * SZ_WMLA;
constexpr size_t OFF_W13T = OFF_WRW + 2 * SZ_WRW;
constexpr size_t OFF_W2T = OFF_W13T + (size_t)NE * 2816 * D * 2;
constexpr size_t OFF_S = OFF_W2T + (size_t)NE * D * FF * 2;
constexpr size_t OFF_Z = OFF_S;
constexpr size_t OFF_CQN = OFF_Z + al256((size_t)NROW * 512 * 4);
constexpr size_t OFF_CKVN = OFF_CQN + al256((size_t)NROW * 256 * 2);
constexpr size_t OFF_KR = OFF_CKVN + al256((size_t)NROW * 256 * 2);
constexpr size_t OFF_QRAW = OFF_KR + al256((size_t)NROW * 64 * 4);
constexpr size_t OFF_KVRAW = OFF_QRAW + al256((size_t)NROW * 1536 * 4);
constexpr size_t OFF_Q = OFF_KVRAW + al256((size_t)NROW * 2048 * 4);
constexpr size_t OFF_K = OFF_Q + al256((size_t)NB * 8 * TK * 192 * 2);
constexpr size_t OFF_V = OFF_K + al256((size_t)NB * 8 * TK * 192 * 2);
constexpr size_t OFF_O = OFF_V + al256((size_t)NB * 8 * TK * 128 * 2);
constexpr size_t END_MLA = OFF_O + SZ_BF;
constexpr size_t OFF_XS = OFF_S;
constexpr size_t OFF_RKV = OFF_XS + 6 * SZ_BF;
constexpr size_t OFF_W = OFF_RKV + 3 * SZ_F32;
constexpr size_t OFF_AV = OFF_W + 2 * SZ_F32;
constexpr size_t OFF_G = OFF_AV + 2 * SZ_F32;
constexpr size_t OFF_A2 = OFF_G + SZ_F32;
constexpr size_t OFF_A3 = OFF_A2 + al256((size_t)NROW * 256 * 2);
constexpr size_t END_RW = OFF_A3 + al256((size_t)NROW * 256 * 2);
constexpr size_t OFF_Y = OFF_XS;
constexpr int NCHK = (TC + TL) / 64;
constexpr size_t OFF_CK = END_RW;
constexpr size_t END_RW2 = OFF_CK + (size_t)128 * NCHK * 4 * 4096 * 2;
constexpr size_t OFF_AFF = OFF_S;
constexpr size_t OFF_ROWIDX = OFF_AFF + al256((size_t)NROW * 16 * 4);
constexpr size_t OFF_GATE = OFF_ROWIDX + al256((size_t)NE * ESLOTS * 4);
constexpr size_t OFF_SLOT = OFF_GATE + al256((size_t)NE * EPAD * 4);
constexpr size_t OFF_XE = OFF_SLOT + al256((size_t)NROW * 16 * 4);
constexpr size_t OFF_HID = OFF_XE + al256((size_t)NE * EPAD * D * 2);
constexpr size_t OFF_YE = OFF_HID + al256((size_t)NE * EPAD * FF * 2);
constexpr size_t END_MOE = OFF_YE + al256((size_t)NE * EPAD * D * 2);
constexpr size_t WS_NEED = END_RW2 > END_MLA ? (END_RW2 > END_MOE ? END_RW2 : END_MOE) : (END_MLA > END_MOE ? END_MLA : END_MOE);

constexpr int LDS_BYTES = 152064;

struct Params {
    const float *x, *c, *ctx, *c_ctx, *mod_w, *mod_b, *norm1_g, *norm2_g, *final_g;
    const float *mla_w_in, *mla_g_q, *mla_g_kv, *mla_w_uq, *mla_w_ukv, *mla_w_o;
    const float *rw_mu, *rw_w_rkv, *rw_w0, *rw_w1, *rw_w2, *rw_a0, *rw_a1, *rw_a2, *rw_v0, *rw_v1, *rw_v2, *rw_g1, *rw_g2, *rw_k_k, *rw_k_a, *rw_r_k, *rw_lnx_g, *rw_lnx_b, *rw_w_o;
    const float *moe_router, *moe_w1, *moe_w3, *moe_w2;
    float* out; char* ws;
    int wv, pad_;
};

__device__ __forceinline__ int bidx() { int t = blockIdx.x; asm volatile("" : "+s"(t)); return t; }
__device__ __forceinline__ int gdim() { int t = gridDim.x; asm volatile("" : "+s"(t)); return t; }
__device__ __forceinline__ int tidx_w(int wv) { int l; asm volatile("v_mbcnt_lo_u32_b32 %0, -1, 0\n\tv_mbcnt_hi_u32_b32 %0, -1, %0" : "=v"(l)); return (wv << 6) | l; }
#define tidx() tidx_w(p.wv)
#define XB_TMO      128
#define XB_XCNT(j)  (256  + 64 * (j))
#define XB_XSUB(j)  (1280 + 64 * (j))
#define XB_XGEN(j)  (2304 + 64 * (j))
#define XB_TOP      3328
#define XB_TOPGEN   3392
#define XCD_BAR_WORDS 3456
#define XB_SPIN_CAP (1u << 22)
#define LAS __attribute__((address_space(3)))

__device__ __forceinline__ unsigned xb_ld(unsigned* p)              { return __hip_atomic_load(p, __ATOMIC_RELAXED, __HIP_MEMORY_SCOPE_AGENT); }
__device__ __forceinline__ unsigned xb_add(unsigned* p, unsigned v) { return __hip_atomic_fetch_add(p, v, __ATOMIC_RELAXED, __HIP_MEMORY_SCOPE_AGENT); }
__device__ __forceinline__ unsigned xb_xcc_id() { return (unsigned)__builtin_amdgcn_s_getreg((3 << 11) | 20) & 0xFu; }
#define XB_SPIN(cond, bar) do { unsigned _sp = 0; while (cond) { __builtin_amdgcn_s_sleep(1); \
    if ((++_sp & 255u) == 0u) { if (xb_ld(&(bar)[XB_TMO])) break; if (_sp > XB_SPIN_CAP) { atomicAdd(&(bar)[XB_TMO], 1u); break; } } } } while (0)

struct XcdBarrier { unsigned* bar; unsigned x; volatile LAS unsigned* st; };

__device__ __forceinline__ XcdBarrier xcd_barrier_post(unsigned* bar, volatile LAS unsigned* st) {
    XcdBarrier b; b.bar = bar; b.x = xb_xcc_id(); b.st = st;
    if (threadIdx.x == 0) (void)xb_add(&bar[XB_XCNT(b.x)], 1u);
    return b;
}
__device__ __forceinline__ void xcd_barrier_complete(unsigned* bar, unsigned x, unsigned& nloc, unsigned& nx) {
    const unsigned G = gridDim.x * gridDim.y * gridDim.z;
    unsigned sum, cnt, mine, sp = 0u;
    for (;;) {
        sum = 0u; cnt = 0u; mine = 0u;
#pragma unroll
        for (unsigned j = 0; j < 16; ++j) { const unsigned c = xb_ld(&bar[XB_XCNT(j)]); sum += c; cnt += (c > 0u) ? 1u : 0u; mine = (j == x) ? c : mine; }
        if (sum == G) break;
        __builtin_amdgcn_s_sleep(1);
        if ((++sp & 255u) == 0u) { if (xb_ld(&bar[XB_TMO])) break; if (sp > XB_SPIN_CAP) { atomicAdd(&bar[XB_TMO], 1u); break; } }
    }
    nloc = mine > 0u ? mine : 1u; nx = cnt > 0u ? cnt : 1u;
}
__device__ __forceinline__ void xcd_barrier(const XcdBarrier& b) {
    asm volatile("s_waitcnt vmcnt(0)" ::: "memory");
    __syncthreads();
    if (threadIdx.x == 0) {
        unsigned* bar = b.bar;
        __builtin_amdgcn_s_waitcnt(0);
        unsigned nloc = b.st[0], nx = b.st[1];
        if (nloc == 0u) { xcd_barrier_complete(bar, b.x, nloc, nx); b.st[0] = nloc; b.st[1] = nx; }
        const unsigned old = xb_add(&bar[XB_XSUB(b.x)], 1u);
        const unsigned gen = old / nloc;
        if (old + 1u == (gen + 1u) * nloc) {
            __builtin_amdgcn_fence(__ATOMIC_RELEASE, "agent");
            asm volatile("s_waitcnt vmcnt(0)" ::: "memory");
            const unsigned og = xb_add(&bar[XB_TOP], 1u);
            const unsigned tg = og / nx;
            if (og + 1u == (tg + 1u) * nx) xb_add(&bar[XB_TOPGEN], 1u);
            else XB_SPIN(xb_ld(&bar[XB_TOPGEN]) == tg, bar);
            __builtin_amdgcn_fence(__ATOMIC_ACQUIRE, "agent");
            xb_add(&bar[XB_XGEN(b.x)], 1u);
            asm volatile("s_waitcnt vmcnt(0)" ::: "memory");
        } else {
            XB_SPIN(xb_ld(&bar[XB_XGEN(b.x)]) == gen, bar);
            __builtin_amdgcn_fence(__ATOMIC_ACQUIRE, "agent");
            asm volatile("s_waitcnt vmcnt(0)" ::: "memory");
        }
    }
    __syncthreads();
}

__device__ __forceinline__ float bf2f(bf16_t b) { return __uint_as_float(((unsigned)b) << 16); }
typedef float f32x2_ __attribute__((ext_vector_type(2)));
typedef __bf16 bf16x2_ __attribute__((ext_vector_type(2)));
__device__ __forceinline__ unsigned pk2(float lo, float hi) { const f32x2_ v = {lo, hi}; return __builtin_bit_cast(unsigned, __builtin_convertvector(v, bf16x2_)); }
__device__ __forceinline__ bf16_t f2bf(float f) { return (bf16_t)(pk2(f, f) & 0xffffu); }
__device__ __forceinline__ float dpp_sum16(float x) {
    x += __builtin_bit_cast(float, __builtin_amdgcn_update_dpp(0, __builtin_bit_cast(int, x), 0xB1, 0xF, 0xF, true));
    x += __builtin_bit_cast(float, __builtin_amdgcn_update_dpp(0, __builtin_bit_cast(int, x), 0x4E, 0xF, 0xF, true));
    x += __builtin_bit_cast(float, __builtin_amdgcn_update_dpp(0, __builtin_bit_cast(int, x), 0x141, 0xF, 0xF, true));
    x += __builtin_bit_cast(float, __builtin_amdgcn_update_dpp(0, __builtin_bit_cast(int, x), 0x140, 0xF, 0xF, true));
    return x;
}
__device__ __forceinline__ f32x4 ldbf4(const bf16_t* p) { const uint2 w = *(const uint2*)p; return (f32x4){__uint_as_float(w.x << 16), __uint_as_float(w.x & 0xffff0000u), __uint_as_float(w.y << 16), __uint_as_float(w.y & 0xffff0000u)}; }
__device__ __forceinline__ void stbf4(bf16_t* p, f32x4 v) { uint2 w; w.x = pk2(v[0], v[1]); w.y = pk2(v[2], v[3]); *(uint2*)p = w; }
typedef bf16_t xt_t;
__device__ __forceinline__ f32x4 xldv(const xt_t* X, size_t i) { return ldbf4(X + i); }
__device__ __forceinline__ void xstv(xt_t* X, size_t i, f32x4 v) { stbf4(X + i, v); }
__device__ __forceinline__ float4 xld(const xt_t* X, size_t i) { const f32x4 v = ldbf4(X + i); return make_float4(v[0], v[1], v[2], v[3]); }
__device__ __forceinline__ void xst(xt_t* X, size_t i, float4 v) { stbf4(X + i, (f32x4){v.x, v.y, v.z, v.w}); }
__device__ __forceinline__ float wave_sum(float v) {
    v = dpp_sum16(v); const int i = __builtin_bit_cast(int, v);
    return __builtin_bit_cast(float, __builtin_amdgcn_readlane(i, 0)) + __builtin_bit_cast(float, __builtin_amdgcn_readlane(i, 16)) + __builtin_bit_cast(float, __builtin_amdgcn_readlane(i, 32)) + __builtin_bit_cast(float, __builtin_amdgcn_readlane(i, 48));
}
__device__ __forceinline__ float sigmoidf_(float x) { return __builtin_amdgcn_rcpf(1.f + __expf(-x)); }
__device__ __forceinline__ int row_stream(int row) { return row < NLAT ? (row >> 12) : 4; }
__device__ __forceinline__ const float* modp(const Params& p, int layer, int s, int part) { return (const float*)(p.ws + OFF_MOD) + ((size_t)layer * 5 + s) * 6144 + part * 1024; }

struct SgArgs { const bf16_t* A; int lda; size_t strideA; const float* B; int ldb; size_t strideB; int M, N, K, nbatch; };
template <class Epi>
__device__ __forceinline__ void sg_gemm(const Params& p, char* lds, const SgArgs g, const Epi& epi) {
    bf16_t* As = (bf16_t*)lds;
    bf16_t* Bs = As + 128 * 40;
    const int tid = tidx(), wid = tid >> 6, lane = tid & 63;
    const int wr = wid >> 2, wc = wid & 3;
    const int tilesN = (g.N + 127) / 128, tilesM = g.M / 128, per = tilesM * tilesN, ntiles = per * g.nbatch;
    const int ar = tid >> 2, ak = (tid & 3) * 8;
    const int bn = tid & 127, bk = (tid >> 7) * 8;
    for (int tile = bidx(); tile < ntiles; tile += gdim()) {
        const int bt = tile / per, tt = tile % per;
        const int tm = tt / tilesN, tn = tt % tilesN;
        const int m0 = tm * 128, n0 = tn * 128;
        f32x4 acc[4][2];
#pragma unroll
        for (int m = 0; m < 4; ++m)
#pragma unroll
            for (int n = 0; n < 2; ++n) acc[m][n] = (f32x4){0.f, 0.f, 0.f, 0.f};
        const bool bvalid = (n0 + bn) < g.N;
        const bf16_t* ap = g.A + bt * g.strideA + (size_t)(m0 + ar) * g.lda + ak;
        const float* bp = g.B + bt * g.strideB + (size_t)bk * g.ldb + n0 + bn;
        bf16x8 areg; float breg[8];
        areg = *(const bf16x8*)ap;
#pragma unroll
        for (int j = 0; j < 8; ++j) breg[j] = bvalid ? bp[(size_t)j * g.ldb] : 0.f;
        for (int k0 = 0; k0 < g.K; k0 += 32) {
            __syncthreads();
            *(bf16x8*)(As + ar * 40 + ak) = areg;
            { u32x4 w; w.x = pk2(breg[0], breg[1]); w.y = pk2(breg[2], breg[3]); w.z = pk2(breg[4], breg[5]); w.w = pk2(breg[6], breg[7]); *(u32x4*)(Bs + bn * 40 + bk) = w; }
            __syncthreads();
            if (k0 + 32 < g.K) {
                areg = *(const bf16x8*)(ap + k0 + 32);
#pragma unroll
                for (int j = 0; j < 8; ++j) breg[j] = bvalid ? bp[(size_t)(k0 + 32 + j) * g.ldb] : 0.f;
            }
            bf16x8 af[4], bfr[2];
#pragma unroll
            for (int m = 0; m < 4; ++m) af[m] = *(const bf16x8*)(As + (wr * 64 + m * 16 + (lane & 15)) * 40 + (lane >> 4) * 8);
#pragma unroll
            for (int n = 0; n < 2; ++n) bfr[n] = *(const bf16x8*)(Bs + (wc * 32 + n * 16 + (lane & 15)) * 40 + (lane >> 4) * 8);
#pragma unroll
            for (int m = 0; m < 4; ++m)
#pragma unroll
                for (int n = 0; n < 2; ++n) acc[m][n] = __builtin_amdgcn_mfma_f32_16x16x32_bf16(af[m], bfr[n], acc[m][n], 0, 0, 0);
        }
#pragma unroll
        for (int m = 0; m < 4; ++m)
#pragma unroll
            for (int n = 0; n < 2; ++n) {
                const int col = n0 + wc * 32 + n * 16 + (lane & 15);
                if (col < g.N) {
#pragma unroll
                    for (int r = 0; r < 4; ++r) epi(bt, m0 + wr * 64 + m * 16 + (lane >> 4) * 4 + r, col, acc[m][n][r]);
                }
            }
    }
}


namespace g8 {
#define PG8_LAS __attribute__((address_space(3)))
constexpr int BM = 256, BK = 64, HALF = 128, HTB = HALF * BK * 2, STAGE_BYTES = 8 * HTB;
__device__ __forceinline__ int lds_byte(int r, int c) { const int st = (r >> 4) * 2 + (c >> 5), rr = r & 15, cc = c & 31, ob = rr * 64 + cc * 2; return st * 1024 + (ob ^ (((ob >> 9) & 1) << 5)); }
__device__ __forceinline__ void stage_rc(int b, int& R, int& C) { const int st = b / 1024, sb = b % 1024, swz = sb ^ (((sb >> 9) & 1) << 5); R = (st >> 1) * 16 + swz / 64; C = (st & 1) * 32 + (swz % 64) / 2; }
struct Unit { int pm, pn, g; const char* A; const char* B; };
__device__ __forceinline__ int xcd_remap(int L, int nwg) { const int q = nwg / 8, r = nwg % 8, xcd = L % 8, off = L / 8; return (xcd < r ? xcd * (q + 1) : r * (q + 1) + (xcd - r) * q) + off; }

template <class Epi, class Sched>
__device__ __forceinline__ void gemm_phase(const int wv_, PG8_LAS unsigned char* lds, const int K, const Sched& S, const Epi& E) {
    const int tid = tidx_w(wv_), wid = __builtin_amdgcn_readfirstlane(tid >> 6), lane = tid & 63, wr = wid >> 2, wc = wid & 3, fr = lane & 15, fq = lane >> 4;
    const int nt = K / BK;
    unsigned voffA[2];
#pragma unroll
    for (int i = 0; i < 2; ++i) { int R, C; stage_rc(tid * 16 + i * 8192, R, C); voffA[i] = (unsigned)(R * K + C) * 2u; }
    const size_t kstep = (size_t)(BK * 2);
    const size_t hstep = (size_t)HALF * K * 2;
    const unsigned ldsw = (unsigned)wid * 1024u;
    const int aoff = lds_byte(wr * 64 + fr, fq * 8), boff = lds_byte(wc * 32 + fr, fq * 8);
#define PG8_SA(b, h) (((b) * 2 + (h)) * HTB)
#define PG8_SB(b, h) ((4 + (b) * 2 + (h)) * HTB)
#define PG8_STAGE(bufoff, gbase, voff) do { _Pragma("unroll") for (int _i = 0; _i < 2; ++_i) \
        __builtin_amdgcn_global_load_lds((const unsigned*)((const char*)(gbase) + (voff)[_i]), (PG8_LAS unsigned*)(lds + (bufoff) + ldsw + _i * 8192), 16, 0, 0); } while (0)
#define PG8_LDA(dst, b, h) do { _Pragma("unroll") for (int m = 0; m < 4; ++m) _Pragma("unroll") for (int k = 0; k < 2; ++k) dst[m][k] = *(const PG8_LAS bf16x8*)(lds + PG8_SA(b, h) + aoff + m * 2048 + k * 1024); } while (0)
#define PG8_LDB(dst, b, h) do { _Pragma("unroll") for (int n = 0; n < 2; ++n) _Pragma("unroll") for (int k = 0; k < 2; ++k) dst[n][k] = *(const PG8_LAS bf16x8*)(lds + PG8_SB(b, h) + boff + n * 2048 + k * 1024); } while (0)
#define PG8_MMA(ai, bj, At, Bt) do { __builtin_amdgcn_s_setprio(1); _Pragma("unroll") for (int m = 0; m < 4; ++m) _Pragma("unroll") for (int n = 0; n < 2; ++n) _Pragma("unroll") for (int k = 0; k < 2; ++k) \
        acc[ai][bj][m][n] = __builtin_amdgcn_mfma_f32_16x16x32_bf16(Bt[n][k], At[m][k], acc[ai][bj][m][n], 0, 0, 0); __builtin_amdgcn_s_setprio(0); } while (0)
#define PG8_WAIT_V(n) asm volatile("s_waitcnt vmcnt(" #n ")" ::: "memory")
#define PG8_WAIT_L(n) asm volatile("s_waitcnt lgkmcnt(" #n ")" ::: "memory")
#define PG8_BAR __builtin_amdgcn_s_barrier()
#define PG8_SCHED __builtin_amdgcn_sched_barrier(0)
    Unit cur, nxt; int ui = 0;
    if (!S.next(0, cur)) return;
    f32x4 acc[2][2][4][2];
#pragma unroll
    for (int a = 0; a < 2; ++a)
#pragma unroll
        for (int b = 0; b < 2; ++b)
#pragma unroll
            for (int m = 0; m < 4; ++m)
#pragma unroll
                for (int n = 0; n < 2; ++n) acc[a][b][m][n] = (f32x4){0.f, 0.f, 0.f, 0.f};
    bf16x8 At[4][2], B0[2][2], B1[2][2];
    const char* cA = cur.A; const char* cB = cur.B;
    PG8_STAGE(PG8_SB(0, 0), cB, voffA); PG8_STAGE(PG8_SA(0, 0), cA, voffA); PG8_STAGE(PG8_SB(0, 1), cB + hstep, voffA); PG8_STAGE(PG8_SA(0, 1), cA + hstep, voffA);
    if (wr == 1) PG8_BAR;
    PG8_WAIT_V(4); PG8_BAR;
    PG8_STAGE(PG8_SB(1, 0), cB + kstep, voffA); PG8_STAGE(PG8_SA(1, 0), cA + kstep, voffA); PG8_STAGE(PG8_SB(1, 1), cB + hstep + kstep, voffA);
    PG8_WAIT_V(6); PG8_BAR;
    for (;;) {
        const bool has_next = S.next(ui + 1, nxt);
        const char* nA = has_next ? nxt.A : cA; const char* nB = has_next ? nxt.B : cB;
        for (int t = 0; t < nt; t += 2) {
            const bool last = (t == nt - 2);
            const char* a1 = cA + (size_t)(t + 1) * kstep;
            const char* a2 = last ? nA : cA + (size_t)(t + 2) * kstep; const char* b2 = last ? nB : cB + (size_t)(t + 2) * kstep;
            const char* a3 = a2 + kstep; const char* b3 = b2 + kstep;
            PG8_LDB(B0, 0, 0); PG8_SCHED; PG8_LDA(At, 0, 0); PG8_STAGE(PG8_SA(1, 1), a1 + hstep, voffA);
            PG8_WAIT_L(8); PG8_BAR; PG8_WAIT_L(0); PG8_MMA(0, 0, At, B0); PG8_BAR; PG8_SCHED;
            PG8_LDB(B1, 0, 1); PG8_STAGE(PG8_SB(0, 0), b2, voffA);
            PG8_BAR; PG8_WAIT_L(0); PG8_MMA(0, 1, At, B1); PG8_BAR;
            PG8_LDA(At, 0, 1); PG8_STAGE(PG8_SA(0, 0), a2, voffA);
            PG8_BAR; PG8_WAIT_L(0); PG8_MMA(1, 0, At, B0); PG8_BAR; PG8_SCHED;
            PG8_STAGE(PG8_SB(0, 1), b2 + hstep, voffA);
            PG8_WAIT_V(6); PG8_BAR; PG8_MMA(1, 1, At, B1); PG8_BAR;
            PG8_LDB(B0, 1, 0); PG8_SCHED; PG8_LDA(At, 1, 0); PG8_STAGE(PG8_SA(0, 1), a2 + hstep, voffA);
            PG8_WAIT_L(8); PG8_BAR; PG8_WAIT_L(0); PG8_MMA(0, 0, At, B0); PG8_BAR; PG8_SCHED;
            PG8_LDB(B1, 1, 1); PG8_STAGE(PG8_SB(1, 0), b3, voffA);
            PG8_BAR; PG8_WAIT_L(0); PG8_MMA(0, 1, At, B1); PG8_BAR;
            PG8_LDA(At, 1, 1); PG8_STAGE(PG8_SA(1, 0), a3, voffA);
            PG8_BAR; PG8_WAIT_L(0); PG8_MMA(1, 0, At, B0); PG8_BAR; PG8_SCHED;
            PG8_STAGE(PG8_SB(1, 1), b3 + hstep, voffA);
            PG8_WAIT_V(6); PG8_BAR; PG8_MMA(1, 1, At, B1); PG8_BAR;
        }
        E(acc, cur, wr, wc, fr, fq);
        if (!has_next) break;
#pragma unroll
        for (int a = 0; a < 2; ++a)
#pragma unroll
            for (int b = 0; b < 2; ++b)
#pragma unroll
                for (int m = 0; m < 4; ++m)
#pragma unroll
                    for (int n = 0; n < 2; ++n) acc[a][b][m][n] = (f32x4){0.f, 0.f, 0.f, 0.f};
        cur = nxt; cA = nA; cB = nB; ++ui;
    }
    PG8_WAIT_V(0);
    if (wr == 0) PG8_BAR;
    PG8_BAR;
#undef PG8_SA
#undef PG8_SB
#undef PG8_STAGE
#undef PG8_LDA
#undef PG8_LDB
#undef PG8_MMA
#undef PG8_WAIT_V
#undef PG8_WAIT_L
#undef PG8_BAR
#undef PG8_SCHED
}
template <class F> struct EpiRC { F f;
    __device__ __forceinline__ void operator()(const f32x4 (&acc)[2][2][4][2], const Unit& u, int wr, int wc, int fr, int fq) const {
#pragma unroll
        for (int ai = 0; ai < 2; ++ai)
#pragma unroll
            for (int m = 0; m < 4; ++m) { const int row = u.pm * BM + ai * HALF + wr * 64 + m * 16 + fr;
#pragma unroll
                for (int bj = 0; bj < 2; ++bj)
#pragma unroll
                    for (int n = 0; n < 2; ++n) f(u, row, u.pn * BM + bj * HALF + wc * 32 + n * 16 + 4 * fq, acc[ai][bj][m][n]);
                asm volatile("" ::: "memory"); }
    } };
template <class F> __device__ __forceinline__ EpiRC<F> epi_rc(const F& f) { return EpiRC<F>{f}; }
template <class F> struct EpiPair { F f;
    __device__ __forceinline__ void operator()(const f32x4 (&acc)[2][2][4][2], const Unit& u, int wr, int wc, int fr, int fq) const {
#pragma unroll
        for (int ai = 0; ai < 2; ++ai)
#pragma unroll
            for (int m = 0; m < 4; ++m) { const int row = u.pm * BM + ai * HALF + wr * 64 + m * 16 + fr;
#pragma unroll
                for (int n = 0; n < 2; ++n) f(u, row, u.pn * HALF + wc * 32 + n * 16 + 4 * fq, acc[ai][0][m][n], acc[ai][1][m][n]);
                asm volatile("" ::: "memory"); }
    } };
template <class F> __device__ __forceinline__ EpiPair<F> epi_pair(const F& f) { return EpiPair<F>{f}; }
template <class F, class CF, class RF> struct EpiPre { F f; CF cf; RF rf;
    __device__ __forceinline__ void operator()(const f32x4 (&acc)[2][2][4][2], const Unit& u, int wr, int wc, int fr, int fq) const {
        f32x4 cv[2][2]; float rv[2][4];
#pragma unroll
        for (int bj = 0; bj < 2; ++bj)
#pragma unroll
            for (int n = 0; n < 2; ++n) cv[bj][n] = cf(u, u.pn * BM + bj * HALF + wc * 32 + n * 16 + 4 * fq);
#pragma unroll
        for (int ai = 0; ai < 2; ++ai)
#pragma unroll
            for (int m = 0; m < 4; ++m) rv[ai][m] = rf(u, u.pm * BM + ai * HALF + wr * 64 + m * 16 + fr);
#pragma unroll
        for (int ai = 0; ai < 2; ++ai)
#pragma unroll
            for (int m = 0; m < 4; ++m) { const int row = u.pm * BM + ai * HALF + wr * 64 + m * 16 + fr;
#pragma unroll
                for (int bj = 0; bj < 2; ++bj)
#pragma unroll
                    for (int n = 0; n < 2; ++n) f(u, row, u.pn * BM + bj * HALF + wc * 32 + n * 16 + 4 * fq, acc[ai][bj][m][n], cv[bj][n], rv[ai][m]);
                asm volatile("" ::: "memory"); }
    } };
template <class F, class CF, class RF> __device__ __forceinline__ EpiPre<F, CF, RF> epi_pre(const F& f, const CF& cf, const RF& rf) { return EpiPre<F, CF, RF>{f, cf, rf}; }
template <class F, class CF> struct EpiColFirst { F f; CF cf;
    __device__ __forceinline__ void operator()(const f32x4 (&acc)[2][2][4][2], const Unit& u, int wr, int wc, int fr, int fq) const {
#pragma unroll
        for (int bj = 0; bj < 2; ++bj)
#pragma unroll
            for (int n = 0; n < 2; ++n) { const int col = u.pn * BM + bj * HALF + wc * 32 + n * 16 + 4 * fq; const f32x4 cv = cf(u, col);
#pragma unroll
                for (int ai = 0; ai < 2; ++ai)
#pragma unroll
                    for (int m = 0; m < 4; ++m) f(u, u.pm * BM + ai * HALF + wr * 64 + m * 16 + fr, col, acc[ai][bj][m][n], cv);
                asm volatile("" ::: "memory"); }
    } };
template <class F, class CF> __device__ __forceinline__ EpiColFirst<F, CF> epi_colfirst(const F& f, const CF& cf) { return EpiColFirst<F, CF>{f, cf}; }
struct EpiResid { xt_t* X; const float* MOD; int layer;
    __device__ __forceinline__ void operator()(const f32x4 (&acc)[2][2][4][2], const Unit& u, int wr, int wc, int fr, int fq) const {
        const int row0 = u.pm * BM + wr * 64 + fr, col0 = u.pn * BM + wc * 32 + 4 * fq;
        const int strm = row0 < NLAT ? (row0 >> 12) : 4;
        const float* gp = MOD + ((size_t)layer * 5 + strm) * 6144 + 2048 + col0;
        f32x4 gt[2][2];
#pragma unroll
        for (int bj = 0; bj < 2; ++bj)
#pragma unroll
            for (int n = 0; n < 2; ++n) gt[bj][n] = *(const f32x4*)(gp + bj * HALF + n * 16);
#pragma unroll
        for (int ai = 0; ai < 2; ++ai) {
            f32x4 xv[4][2][2];
#pragma unroll
            for (int m = 0; m < 4; ++m)
#pragma unroll
                for (int bj = 0; bj < 2; ++bj)
#pragma unroll
                    for (int n = 0; n < 2; ++n) xv[m][bj][n] = xldv(X, (size_t)(row0 + ai * HALF + m * 16) * D + col0 + bj * HALF + n * 16);
#pragma unroll
            for (int m = 0; m < 4; ++m)
#pragma unroll
                for (int bj = 0; bj < 2; ++bj)
#pragma unroll
                    for (int n = 0; n < 2; ++n) xstv(X, (size_t)(row0 + ai * HALF + m * 16) * D + col0 + bj * HALF + n * 16, xv[m][bj][n] + gt[bj][n] * acc[ai][bj][m][n]);
            asm volatile("" ::: "memory");
        }
    } };
struct BatchSched { const char* A; const char* B; size_t strideA, strideB; int nM, nN, nb, K;
    __device__ __forceinline__ bool next(int i, Unit& u) const {
        const int nwg = nM * nN * nb; const int L = i * gdim() + bidx(); if (L >= nwg) return false;
        const int w = xcd_remap(L, nwg); const int per = nM * nN; u.g = w / per; const int r = w % per; u.pm = r / nN; u.pn = r % nN;
        u.A = A + u.g * strideA + (size_t)u.pm * BM * K * 2; u.B = B + u.g * strideB + (size_t)u.pn * BM * K * 2; return true; } };
}

template <class SrcF, class DRow>
__device__ __forceinline__ void cvt_tiles(const int wv_, char* lds, bf16_t* dst, int Kd, int Nd, int nbatch, size_t dstride, const SrcF& src, const DRow& drow, unsigned* queue = nullptr) {
    bf16_t* T = (bf16_t*)lds;
    int* qslot = (int*)(lds + 64 * 136 * 2);
    const int tid = tidx_w(wv_);
    const int tk = Kd / 128, tn = Nd / 64, per = tk * tn, total = per * nbatch;
    constexpr int QG = 8;
    int t = queue ? 0 : bidx(), tnext = 0, sub = 0;
    if (queue) { if (tid == 0) { qslot[0] = QG * (int)__hip_atomic_fetch_add(queue, 1u, __ATOMIC_RELAXED, __HIP_MEMORY_SCOPE_AGENT); } __syncthreads(); t = qslot[0]; __syncthreads(); }
    while (t < total) {
        if (queue && sub == 0 && tid == 0) tnext = QG * (int)__hip_atomic_fetch_add(queue, 1u, __ATOMIC_RELAXED, __HIP_MEMORY_SCOPE_AGENT);
        const int bt = t / per, r = t % per, k0 = (r % tk) * 128, n0 = (r / tk) * 64;
        float4 v[4];
#pragma unroll
        for (int i = 0; i < 4; ++i) { const int k = k0 + i * 32 + (tid >> 4), n = n0 + (tid & 15) * 4; const float* sp = src(bt, k, n); v[i] = sp ? *(const float4*)sp : make_float4(0.f, 0.f, 0.f, 0.f); }
        __syncthreads();
#pragma unroll
        for (int i = 0; i < 4; ++i) { const int k = i * 32 + (tid >> 4), n = (tid & 15) * 4;
            T[(n + 0) * 136 + k] = f2bf(v[i].x); T[(n + 1) * 136 + k] = f2bf(v[i].y); T[(n + 2) * 136 + k] = f2bf(v[i].z); T[(n + 3) * 136 + k] = f2bf(v[i].w); }
        if (queue && sub == QG - 1 && tid == 0) qslot[0] = tnext;
        __syncthreads();
        { const int n = tid >> 3, kc = (tid & 7) * 16;
          const u32x4 a = *(const u32x4*)(T + n * 136 + kc), b = *(const u32x4*)(T + n * 136 + kc + 8);
          bf16_t* dp = dst + bt * dstride + (size_t)drow(n0 + n) * Kd + k0 + kc;
          *(u32x4*)dp = a; *(u32x4*)(dp + 8) = b; }
        if (queue) { if (++sub == QG) { sub = 0; t = qslot[0]; } else ++t; } else t += gdim();
    }
}
__device__ void ph_moe_cvt(const Params& p, int layer, char* lds) {
    const float* w1 = p.moe_w1 + (size_t)layer * NE * D * FF; const float* w3 = p.moe_w3 + (size_t)layer * NE * D * FF; const float* w2 = p.moe_w2 + (size_t)layer * NE * FF * D;
    cvt_tiles(p.wv, lds, (bf16_t*)(p.ws + OFF_W13T), D, 2816, NE, (size_t)2816 * D,
        [=](int e, int k, int n) -> const float* { const int pn = n >> 8, half = (n >> 7) & 1, c = pn * 128 + (n & 127); return (half ? w3 : w1) + ((size_t)e * D + k) * FF + c; },
        [=](int n) { return n; }, (unsigned*)(p.ws + OFF_QUEUE) + (layer * 2) * 16);
    cvt_tiles(p.wv, lds, (bf16_t*)(p.ws + OFF_W2T), FF, D, NE, (size_t)D * FF,
        [=](int e, int k, int n) -> const float* { return w2 + ((size_t)e * FF + k) * D + n; },
        [=](int n) { return n; }, (unsigned*)(p.ws + OFF_QUEUE) + (layer * 2 + 1) * 16);
}

__device__ void ph_init(const Params& p, char* lds) {
    const int tid = tidx(), gtid = bidx() * NTHR + tid, gsz = gdim() * NTHR;
    xt_t* Xs = (xt_t*)(p.ws + OFF_X);
    const float4* x4 = (const float4*)p.x; const float4* c4 = (const float4*)p.ctx;
    { constexpr int NQ = NROW * 256 / 4;
      auto srcv = [&](int k) { return k < NLAT * 256 ? x4[k] : c4[k - NLAT * 256]; };
      for (int i = gtid; i < NQ; i += gsz) { const float4 t0 = srcv(i), t1 = srcv(i + NQ), t2 = srcv(i + 2 * NQ), t3 = srcv(i + 3 * NQ); xst(Xs, (size_t)4 * i, t0); xst(Xs, (size_t)4 * (i + NQ), t1); xst(Xs, (size_t)4 * (i + 2 * NQ), t2); xst(Xs, (size_t)4 * (i + 3 * NQ), t3); } }
    float* rc = (float*)(p.ws + OFF_ROPE_C); float* rs = (float*)(p.ws + OFF_ROPE_S);
    for (int i = gtid; i < TL * 32; i += gsz) {
        const int t = i >> 5, f = i & 31; const float pos = (float)((f < 16) ? (t >> 6) : (t & 63));
        const float inv = powf(10000.f, -(float)(f & 15) / 16.f); const float ang = pos * inv; rc[2 * i] = cosf(ang); rc[2 * i + 1] = sinf(ang);
    }
    float* sc = (float*)lds;
    float* red = sc + 5 * 1024;
    for (int i = tid; i < 5 * 1024; i += NTHR) { const float v = i < 4096 ? p.c[i] : p.c_ctx[i - 4096]; sc[i] = v / (1.f + expf(-v)); }
    __syncthreads();
    float* MOD = (float*)(p.ws + OFF_MOD);
    for (int item = bidx(); item < 4 * 96; item += gdim()) {
        const int l = item / 96, cg = item % 96, col = tid & 63, n = cg * 64 + col, kg = tid >> 6;
        const float* w = p.mod_w + ((size_t)l * 1024 + kg * 128) * 6144 + n;
        float a0 = 0, a1 = 0, a2 = 0, a3 = 0, a4 = 0;
#pragma unroll 16
        for (int k = 0; k < 128; ++k) { const float wv = w[(size_t)k * 6144]; const int kk = kg * 128 + k;
            a0 += sc[kk] * wv; a1 += sc[1024 + kk] * wv; a2 += sc[2048 + kk] * wv; a3 += sc[3072 + kk] * wv; a4 += sc[4096 + kk] * wv; }
        float* rr = red + (kg * 64 + col) * 5; rr[0] = a0; rr[1] = a1; rr[2] = a2; rr[3] = a3; rr[4] = a4;
        __syncthreads();
        if (tid < 320) { const int c2 = tid & 63, s = tid >> 6; float sum = 0;
            for (int q = 0; q < 8; ++q) sum += red[(q * 64 + c2) * 5 + s];
            MOD[((size_t)l * 5 + s) * 6144 + cg * 64 + c2] = sum + p.mod_b[l * 6144 + cg * 64 + c2]; }
        __syncthreads();
    }
}


__device__ void ph_small_cvt(const Params& p, char* lds) {
    for (int j = 0; j < 2; ++j) {
        char* wm = p.ws + OFF_WMLA + j * SZ_WMLA; char* wr = p.ws + OFF_WRW + j * SZ_WRW;
        const float* w_in = p.mla_w_in + (size_t)j * D * 448; const float* w_uq = p.mla_w_uq + (size_t)j * 256 * 1536; const float* w_ukv = p.mla_w_ukv + (size_t)j * 128 * 2048; const float* w_o = p.mla_w_o + (size_t)j * D * D;
        cvt_tiles(p.wv, lds, (bf16_t*)(wm + WM_IN), 1024, 512, 1, 0, [=](int, int k, int n) -> const float* { return n < 448 ? w_in + (size_t)k * 448 + n : nullptr; },
                  [=](int n) { if (n < 384 || n >= 448) return n; const int jj = n - 384; return 384 + (jj < 32 ? 2 * jj : 2 * (jj - 32) + 1); });
        cvt_tiles(p.wv, lds, (bf16_t*)(wm + WM_UQ), 256, 1536, 1, 0, [=](int, int k, int n) -> const float* { return w_uq + (size_t)k * 1536 + n; },
                  [=](int n) { const int h = n / 192, d = n % 192; if (d < 128) return n; const int jj = d - 128; return h * 192 + 128 + (jj < 32 ? 2 * jj : 2 * (jj - 32) + 1); });
        cvt_tiles(p.wv, lds, (bf16_t*)(wm + WM_UKV), 128, 2048, 1, 0, [=](int, int k, int n) -> const float* { return w_ukv + (size_t)k * 2048 + n; }, [=](int n) { return n; });
        cvt_tiles(p.wv, lds, (bf16_t*)(wm + WM_O), 1024, 1024, 1, 0, [=](int, int k, int n) -> const float* { return w_o + (size_t)k * D + n; }, [=](int n) { return n; });
        const float* w_rkv = p.rw_w_rkv + (size_t)j * 3 * D * D; const float* w1 = p.rw_w1 + (size_t)j * 2 * D * 64; const float* a1 = p.rw_a1 + (size_t)j * 2 * D * 64;
        const float* g1 = p.rw_g1 + (size_t)j * D * 128; const float* v1 = p.rw_v1; const float* rwo = p.rw_w_o + (size_t)j * D * D;
        cvt_tiles(p.wv, lds, (bf16_t*)(wr + WR_RKV), 1024, 1024, 3, (size_t)D * D, [=](int m, int k, int n) -> const float* { return w_rkv + ((size_t)m * D + k) * D + n; }, [=](int n) { return n; });
        cvt_tiles(p.wv, lds, (bf16_t*)(wr + WR_L), 1024, 256, 1, 0, [=](int, int k, int n) -> const float* { return n < 128 ? w1 + ((size_t)(n >> 6) * D + k) * 64 + (n & 63) : nullptr; }, [=](int n) { return n; });
        cvt_tiles(p.wv, lds, (bf16_t*)(wr + WR_L) + 256 * 1024, 1024, 256, 1, 0, [=](int, int k, int n) -> const float* { return n < 128 ? a1 + ((size_t)(n >> 6) * D + k) * 64 + (n & 63) : nullptr; }, [=](int n) { return n; });
        cvt_tiles(p.wv, lds, (bf16_t*)(wr + WR_L) + 2 * 256 * 1024, 1024, 256, 1, 0, [=](int, int k, int n) -> const float* { return n < 128 ? g1 + (size_t)k * 128 + n : nullptr; }, [=](int n) { return n; });
        cvt_tiles(p.wv, lds, (bf16_t*)(wr + WR_L) + 3 * 256 * 1024, 1024, 256, 1, 0, [=](int, int k, int n) -> const float* { return n < 32 ? v1 + (size_t)k * 32 + n : nullptr; }, [=](int n) { return n; });
        cvt_tiles(p.wv, lds, (bf16_t*)(wr + WR_O), 1024, 1024, 1, 0, [=](int, int k, int n) -> const float* { return rwo + (size_t)k * D + n; }, [=](int n) { return n; });
        const float* w2 = p.rw_w2 + (size_t)j * 2 * 64 * D; const float* a2 = p.rw_a2 + (size_t)j * 2 * 64 * D; const float* g2 = p.rw_g2 + (size_t)j * 128 * D; const float* v2 = p.rw_v2;
        cvt_tiles(p.wv, lds, (bf16_t*)(wr + WR_B2), 128, 2048, 2, (size_t)2048 * 128, [=](int bt, int k, int n) -> const float* { const int zz = n >> 10, c = n & 1023, l = k - zz * 64;
            if (l < 0 || l >= 64) return nullptr; return (bt == 0 ? w2 : a2) + ((size_t)zz * 64 + l) * D + c; }, [=](int n) { return n; });
        cvt_tiles(p.wv, lds, (bf16_t*)(wr + WR_B3), 128, 1024, 2, (size_t)1024 * 128, [=](int bt, int k, int n) -> const float* {
            if (bt == 0) return g2 + (size_t)k * D + n; return k < 32 ? v2 + (size_t)k * D + n : nullptr; }, [=](int n) { return n; });
    }
}

template <bool OUTF32>
__device__ void ph_norm_mod(const Params& p, int layer, const float* g, int part_sh, int part_sc, void* outp) {
    const int wid = tidx() >> 6, lane = tidx() & 63;
    const xt_t* X = (const xt_t*)(p.ws + OFF_X);
    int row = bidx() * 8 + wid;
    float4 nv[4];
    if (row < NROW) {
#pragma unroll
        for (int i = 0; i < 4; ++i) nv[i] = xld(X, (size_t)row * D + (lane + i * 64) * 4); }
    for (; row < NROW; row += gdim() * 8) {
        const int s = row_stream(row);
        const float* sh = modp(p, layer, s, part_sh); const float* sc = modp(p, layer, s, part_sc);
        float4 v[4]; float ss = 0;
#pragma unroll
        for (int i = 0; i < 4; ++i) { v[i] = nv[i]; ss += v[i].x * v[i].x + v[i].y * v[i].y + v[i].z * v[i].z + v[i].w * v[i].w; }
        { const int nrow = row + gdim() * 8;
          if (nrow < NROW) {
#pragma unroll
              for (int i = 0; i < 4; ++i) nv[i] = xld(X, (size_t)nrow * D + (lane + i * 64) * 4); } }
        ss = wave_sum(ss); const float rs = rsqrtf(ss * (1.f / D) + RMS_EPS);
#pragma unroll
        for (int i = 0; i < 4; ++i) {
            const int d = (lane + i * 64) * 4;
            const float4 gg = *(const float4*)(g + d), a = *(const float4*)(sc + d), b = *(const float4*)(sh + d);
            float4 o; o.x = v[i].x * rs * gg.x * (1.f + a.x) + b.x; o.y = v[i].y * rs * gg.y * (1.f + a.y) + b.y; o.z = v[i].z * rs * gg.z * (1.f + a.z) + b.z; o.w = v[i].w * rs * gg.w * (1.f + a.w) + b.w;
            if (OUTF32) *(float4*)((float*)outp + (size_t)row * D + d) = o;
            else { uint2 w; w.x = pk2(o.x, o.y); w.y = pk2(o.z, o.w); *(uint2*)((bf16_t*)outp + (size_t)row * D + d) = w; }
        }
    }
}

__device__ void ph_mla_mid(const Params& p, int j) {
    const int wid = tidx() >> 6, lane = tidx() & 63;
    const float* Z = (const float*)(p.ws + OFF_Z);
    bf16_t* CQN = (bf16_t*)(p.ws + OFF_CQN); bf16_t* CKVN = (bf16_t*)(p.ws + OFF_CKVN); bf16_t* K = (bf16_t*)(p.ws + OFF_K);
    const float* gq = p.mla_g_q + j * 256; const float* gkv = p.mla_g_kv + j * 128;
    const float* rc = (const float*)(p.ws + OFF_ROPE_C); const float* rs = (const float*)(p.ws + OFF_ROPE_S);
    for (int row = bidx() * 8 + wid; row < NROW; row += gdim() * 8) {
        const float* z = Z + (size_t)row * 512;
        const float4 q = *(const float4*)(z + lane * 4);
        const float2 kv = *(const float2*)(z + 256 + lane * 2);
        const float kr = z[384 + lane];
        float sq = wave_sum(q.x * q.x + q.y * q.y + q.z * q.z + q.w * q.w); const float rq = rsqrtf(sq * (1.f / 256.f) + RMS_EPS);
        float sk = wave_sum(kv.x * kv.x + kv.y * kv.y); const float rk = rsqrtf(sk * (1.f / 128.f) + RMS_EPS);
        const float4 g4 = *(const float4*)(gq + lane * 4); const float2 g2 = *(const float2*)(gkv + lane * 2);
        uint2 w; w.x = pk2(q.x * rq * g4.x, q.y * rq * g4.y); w.y = pk2(q.z * rq * g4.z, q.w * rq * g4.w);
        *(uint2*)(CQN + (size_t)row * 256 + lane * 4) = w;
        *(unsigned*)(CKVN + (size_t)row * 128 + lane * 2) = pk2(kv.x * rk * g2.x, kv.y * rk * g2.y);
        float o = kr;
        const float other = __builtin_bit_cast(float, __builtin_amdgcn_update_dpp(0, __builtin_bit_cast(int, kr), 0xB1, 0xF, 0xF, true));
        const bool lat = row < NLAT;
        if (lat) { const int t = row & (TL - 1), i = lane >> 1; const float2 cs = *(const float2*)(rc + (t * 32 + i) * 2); const float c = cs.x, s = cs.y;
            o = (lane & 1) ? (other * s + kr * c) : (kr * c - other * s); }
        const int b = lat ? (row >> 12) : ((row - NLAT) >> 8); const int tk = lat ? 256 + (row & (TL - 1)) : ((row - NLAT) & 255);
        const bf16_t ob = f2bf(o);
#pragma unroll
        for (int h = 0; h < 8; ++h) K[((size_t)(b * 8 + h) * TK + tk) * 192 + 128 + lane] = ob;
    }
}

__device__ void ph_qkv_post(const Params& p) {
    const int wid = tidx() >> 6, lane = tidx() & 63;
    const float* QRAW = (const float*)(p.ws + OFF_QRAW); const float* KVRAW = (const float*)(p.ws + OFF_KVRAW); const float* KR = (const float*)(p.ws + OFF_KR);
    bf16_t* Q = (bf16_t*)(p.ws + OFF_Q); bf16_t* K = (bf16_t*)(p.ws + OFF_K); bf16_t* V = (bf16_t*)(p.ws + OFF_V);
    const float* rc = (const float*)(p.ws + OFF_ROPE_C); const float* rs = (const float*)(p.ws + OFF_ROPE_S);
    for (int it = bidx() * 8 + wid; it < NROW * 8; it += gdim() * 8) {
        const int row = it >> 3, h = it & 7;
        const bool lat = row < NLAT; const int b = lat ? (row >> 12) : ((row - NLAT) >> 8); const int tk = lat ? 256 + (row & (TL - 1)) : ((row - NLAT) & 255);
        const size_t orow = (size_t)(b * 8 + h) * TK + tk;
        const float* q = QRAW + (size_t)row * 1536 + h * 192;
        const float q0 = q[lane], q1 = q[64 + lane]; float q2 = q[128 + lane];
        const auto sw = __builtin_amdgcn_permlane32_swap(__float_as_uint(q2), __float_as_uint(q2), false, false);
        if (lat) { const int t = row & (TL - 1), i = lane & 31; const float c = rc[t * 32 + i], s = rs[t * 32 + i];
            const float x1 = __uint_as_float(sw[0]), x2 = __uint_as_float(sw[1]); q2 = lane < 32 ? (x1 * c - x2 * s) : (x1 * s + x2 * c); }
        bf16_t* qo = Q + orow * 192; qo[lane] = f2bf(q0); qo[64 + lane] = f2bf(q1); qo[128 + lane] = f2bf(q2);
        const float* kv = KVRAW + (size_t)row * 2048 + h * 256;
        bf16_t* ko = K + orow * 192; ko[lane] = f2bf(kv[lane]); ko[64 + lane] = f2bf(kv[64 + lane]); ko[128 + lane] = f2bf(KR[(size_t)row * 64 + lane]);
        bf16_t* vo = V + orow * 128; vo[lane] = f2bf(kv[128 + lane]); vo[64 + lane] = f2bf(kv[192 + lane]);
    }
}

__device__ void ph_attn_naive(const Params& p, char* lds) {
    const int tid = tidx(), qi = tid >> 2, part = tid & 3;
    const bf16_t* Q = (const bf16_t*)(p.ws + OFF_Q); const bf16_t* K = (const bf16_t*)(p.ws + OFF_K); const bf16_t* V = (const bf16_t*)(p.ws + OFF_V);
    bf16_t* O = (bf16_t*)(p.ws + OFF_O);
    bf16_t* Ks = (bf16_t*)lds;
    bf16_t* Vs = Ks + 32 * 192;
    const int nitems = 32 * 34;
    for (int it = bidx(); it < nitems; it += gdim()) {
        const int bh = it / 34, qb = it % 34; const int b = bh >> 3, h = bh & 7;
        const int nkeys = qb < 2 ? TC : TK;
        const int tq = qb * 128 + qi;
        const bf16_t* qp = Q + ((size_t)bh * TK + tq) * 192 + part * 48;
        float q[48];
#pragma unroll
        for (int i = 0; i < 48; ++i) q[i] = bf2f(qp[i]) * ATT_SCALE;
        float o[32];
#pragma unroll
        for (int i = 0; i < 32; ++i) o[i] = 0.f;
        float m = -1e30f, l = 0.f;
        for (int k0 = 0; k0 < nkeys; k0 += 32) {
            __syncthreads();
            {
                const bf16_t* kg = K + ((size_t)bh * TK + k0) * 192; const bf16_t* vg = V + ((size_t)bh * TK + k0) * 128;
                for (int c = tid; c < 768; c += NTHR) *(u32x4*)(Ks + c * 8) = *(const u32x4*)(kg + c * 8);
                *(u32x4*)(Vs + tid * 8) = *(const u32x4*)(vg + tid * 8);
            }
            __syncthreads();
#pragma unroll 1
            for (int kg = 0; kg < 32; kg += 8) {
                float s[8]; float tmax = -1e30f;
#pragma unroll
                for (int kk = 0; kk < 8; ++kk) {
                    const bf16_t* kr = Ks + (kg + kk) * 192 + part * 48; float acc = 0.f;
#pragma unroll
                    for (int i = 0; i < 48; ++i) acc += q[i] * bf2f(kr[i]);
                    acc += __shfl_xor(acc, 1); acc += __shfl_xor(acc, 2);
                    s[kk] = acc; tmax = fmaxf(tmax, acc);
                    asm volatile("" ::: "memory");
                }
                const float mn = fmaxf(m, tmax), alpha = expf(m - mn); m = mn; l *= alpha;
#pragma unroll
                for (int i = 0; i < 32; ++i) o[i] *= alpha;
#pragma unroll
                for (int kk = 0; kk < 8; ++kk) {
                    const float pw = expf(s[kk] - mn); l += pw;
                    const bf16_t* vr = Vs + (kg + kk) * 128 + part * 32;
#pragma unroll
                    for (int i = 0; i < 32; ++i) o[i] += pw * bf2f(vr[i]);
                    asm volatile("" ::: "memory");
                }
            }
        }
        const float rl = 1.f / l;
        const int row = qb < 2 ? (NLAT + b * TC + tq) : (b * TL + tq - TC);
        bf16_t* op = O + (size_t)row * D + h * 128 + part * 32;
#pragma unroll
        for (int i = 0; i < 32; ++i) op[i] = f2bf(o[i] * rl);
    }
}


namespace fa {
using s16x4  = __attribute__((ext_vector_type(4))) short;
using f32x16 = __attribute__((ext_vector_type(16))) float;
constexpr int DQK = 192, DV = 128, KVBLK = 64;
constexpr float THR = 8.f;
constexpr int SHM_V = KVBLK * DV * 2, SHM_K = KVBLK * DQK * 2;
constexpr int SHM_ATTN = 2 * SHM_V + 2 * SHM_K + 8 * 64 * 4;
#define KSWZ(row, colB) ((row) * 384 + ((colB) ^ ((((row) >> 1) & 7) << 4)))
#define SBAR() __builtin_amdgcn_sched_barrier(0)
__device__ __forceinline__ int crow(int r, int hi) { return (r & 3) + 8 * (r >> 2) + 4 * hi; }
__device__ __forceinline__ unsigned cvtpk(float lo, float hi) { unsigned r; asm volatile("v_cvt_pk_bf16_f32 %0, %1, %2" : "=v"(r) : "v"(lo), "v"(hi)); return r; }
__device__ __forceinline__ void partialSM(f32x16& p0, f32x16& p1, float& m_reg, float& mn, float& alpha) {
  constexpr float C = ATT_SCALE * 1.4426950408889634f;
  float pmax = p0[0];
#pragma unroll
  for (int r = 1; r < 16; ++r) pmax = fmaxf(pmax, p0[r]);
#pragma unroll
  for (int r = 0; r < 16; ++r) pmax = fmaxf(pmax, p1[r]);
  { auto rr = __builtin_amdgcn_permlane32_swap(__float_as_uint(pmax), __float_as_uint(pmax), false, false);
    pmax = fmaxf(__uint_as_float(rr[0]), __uint_as_float(rr[1])); }
  if (__builtin_expect(__all(pmax - m_reg <= THR / ATT_SCALE), 1)) { mn = m_reg; alpha = 1.f; }
  else { mn = fmaxf(m_reg, pmax); alpha = __builtin_amdgcn_exp2f((m_reg - mn) * C); m_reg = mn; }
  float mnC = -mn * C;
#pragma unroll
  for (int r = 0; r < 16; ++r) p0[r] = fmaf(p0[r], C, mnC);
#pragma unroll
  for (int r = 0; r < 16; ++r) p1[r] = fmaf(p1[r], C, mnC);
#pragma unroll
  for (int r = 0; r < 16; ++r) p0[r] = __builtin_amdgcn_exp2f(p0[r]);
}
__device__ __forceinline__ void finishSM(f32x16& p0, f32x16& p1, float alpha, float& l_reg, bf16x8& pa0, bf16x8& pa1, bf16x8& pa2, bf16x8& pa3) {
#pragma unroll
  for (int r = 0; r < 16; ++r) p1[r] = __builtin_amdgcn_exp2f(p1[r]);
  float ps = 0;
#pragma unroll
  for (int r = 0; r < 16; ++r) ps += p0[r];
#pragma unroll
  for (int r = 0; r < 16; ++r) ps += p1[r];
  { auto rr = __builtin_amdgcn_permlane32_swap(__float_as_uint(ps), __float_as_uint(ps), false, false);
    ps = __uint_as_float(rr[0]) + __uint_as_float(rr[1]); }
  l_reg = l_reg * alpha + ps;
#define PK4(P, BASE, OUT) do { unsigned a0 = cvtpk(P[BASE + 0], P[BASE + 1]), a1 = cvtpk(P[BASE + 2], P[BASE + 3]);   \
    unsigned b0 = cvtpk(P[BASE + 4], P[BASE + 5]), b1 = cvtpk(P[BASE + 6], P[BASE + 7]);                              \
    auto r0 = __builtin_amdgcn_permlane32_swap(a0, b0, false, false); auto r1 = __builtin_amdgcn_permlane32_swap(a1, b1, false, false); \
    u32x4 w = {r0[0], r1[0], r0[1], r1[1]}; OUT = *reinterpret_cast<bf16x8*>(&w); } while (0)
  PK4(p0, 0, pa0); PK4(p0, 8, pa1); PK4(p1, 0, pa2); PK4(p1, 8, pa3);
#undef PK4
}
__device__ __forceinline__ void qkt(f32x16& p0, f32x16& p1, const char* Ks, const bf16x8* qr, int r32, int hi) {
  p0 = f32x16{}; p1 = f32x16{};
  const int swz = ((r32 >> 1) & 7) << 4;
  const char* b4[4];
#pragma unroll
  for (int dr = 0; dr < 4; ++dr) b4[dr] = Ks + r32 * 384 + ((dr * 32 + hi * 16) ^ swz);
#pragma unroll
  for (int d0 = 0; d0 < 12; ++d0) {
    bf16x8 b0 = *reinterpret_cast<const bf16x8*>(b4[d0 & 3] + (d0 >> 2) * 128);
    bf16x8 b1 = *reinterpret_cast<const bf16x8*>(b4[d0 & 3] + (d0 >> 2) * 128 + 32 * 384);
    p0 = __builtin_amdgcn_mfma_f32_32x32x16_bf16(b0, qr[d0], p0, 0, 0, 0);
    p1 = __builtin_amdgcn_mfma_f32_32x32x16_bf16(b1, qr[d0], p1, 0, 0, 0); }
}
__device__ __forceinline__ int v_st(int k, int c) { const int kk = (k & ~0xC) | ((k & 4) << 1) | ((k & 8) >> 1); return ((kk >> 3) * 4 + (c >> 5)) * 512 + ((kk & 7) * 32 + (c & 31)) * 2; }
__device__ __forceinline__ int v_rd_base(int lane) { return ((lane & 3) << 3) | (((lane >> 2) & 3) << 6) | (((lane >> 4) & 1) << 5) | (((lane >> 5) & 1) << 8); }
constexpr int v_rd_off(int d0, int ks, int half) { return d0 * 512 + ks * 4096 + half * 2048; }
template <int OFF> __device__ __forceinline__ s16x4 tr_read(int vb) {
  s16x4 r; asm volatile("ds_read_b64_tr_b16 %0, %1 offset:%2" : "=&v"(r) : "v"(vb), "i"(OFF) : "memory"); return r;
}
template <int D0> __device__ __forceinline__ void pv_one(f32x16& od, int vb, bf16x8 pa0, bf16x8 pa1, bf16x8 pa2, bf16x8 pa3) {
  const s16x4 l0 = tr_read<v_rd_off(D0, 0, 0)>(vb), h0 = tr_read<v_rd_off(D0, 0, 1)>(vb), l1 = tr_read<v_rd_off(D0, 1, 0)>(vb), h1 = tr_read<v_rd_off(D0, 1, 1)>(vb);
  const s16x4 l2 = tr_read<v_rd_off(D0, 2, 0)>(vb), h2 = tr_read<v_rd_off(D0, 2, 1)>(vb), l3 = tr_read<v_rd_off(D0, 3, 0)>(vb), h3 = tr_read<v_rd_off(D0, 3, 1)>(vb);
  asm volatile("s_waitcnt lgkmcnt(0)" ::: "memory"); SBAR();
#define PK(L, H) (bf16x8){L[0], L[1], L[2], L[3], H[0], H[1], H[2], H[3]}
  od = __builtin_amdgcn_mfma_f32_32x32x16_bf16(pa0, PK(l0, h0), od, 0, 0, 0);
  od = __builtin_amdgcn_mfma_f32_32x32x16_bf16(pa1, PK(l1, h1), od, 0, 0, 0);
  od = __builtin_amdgcn_mfma_f32_32x32x16_bf16(pa2, PK(l2, h2), od, 0, 0, 0);
  od = __builtin_amdgcn_mfma_f32_32x32x16_bf16(pa3, PK(l3, h3), od, 0, 0, 0);
#undef PK
}
__device__ __forceinline__ void pv_d0(f32x16* o, int vb, bf16x8 pa0, bf16x8 pa1, bf16x8 pa2, bf16x8 pa3) {
  pv_one<0>(o[0], vb, pa0, pa1, pa2, pa3); pv_one<1>(o[1], vb, pa0, pa1, pa2, pa3); pv_one<2>(o[2], vb, pa0, pa1, pa2, pa3); pv_one<3>(o[3], vb, pa0, pa1, pa2, pa3);
}
__device__ __forceinline__ void attn_body(const int wv_, const bf16_t* __restrict__ Qb, const bf16_t* __restrict__ Kh, const bf16_t* __restrict__ Vh, bf16_t* __restrict__ Ob, int ldo, int seq, char* lds, const float* __restrict__ ropecs  ) {
  const int tid = tidx_w(wv_), wid = tid >> 6, lane = tid & 63, r32 = lane & 31, hi = lane >> 5;
  char* V_lds = lds; char* K_lds = lds + 2 * SHM_V;
  float* ws = (float*)(lds + 2 * SHM_V + 2 * SHM_K) + wid * 64; float* li_l = ws; float* al_l = ws + 32;
  float m_reg = -1e30f, l_reg = 0; f32x16 o[4] = {}; bf16x8 qr[12];
  const bf16_t* Qw = Qb + (long)(wid * 32 + r32) * DQK + hi * 8;
#pragma unroll
  for (int d0 = 0; d0 < 12; ++d0) qr[d0] = *reinterpret_cast<const bf16x8*>(Qw + d0 * 16);
  if (ropecs) {
    const float* cs = ropecs + (size_t)(wid * 32 + r32) * 64;
#pragma unroll
    for (int d0 = 8; d0 < 12; ++d0) { const int i0 = (d0 - 8) * 8 + hi * 4; const f32x4 c0 = *(const f32x4*)(cs + i0 * 2), c1 = *(const f32x4*)(cs + i0 * 2 + 4);
      u32x4 w = *reinterpret_cast<u32x4*>(&qr[d0]); const float cc[4] = {c0[0], c0[2], c1[0], c1[2]}, ss[4] = {c0[1], c0[3], c1[1], c1[3]};
#pragma unroll
      for (int m = 0; m < 4; ++m) { const float x1 = __uint_as_float(w[m] << 16), x2 = __uint_as_float(w[m] & 0xffff0000u); w[m] = cvtpk(x1 * cc[m] - x2 * ss[m], x1 * ss[m] + x2 * cc[m]); }
      qr[d0] = *reinterpret_cast<bf16x8*>(&w); }
  }
  const int sr = tid >> 4, sc = (tid & 15) * 8, vst0 = v_st(sr, sc), vst1 = v_st(32 + sr, sc);
  int kst[3];
#pragma unroll
  for (int i = 0; i < 3; ++i) { const int c = tid + 512 * i, row = c / 24, cc = c % 24; kst[i] = KSWZ(row, cc * 16); }
  const int vb0 = (int)(uintptr_t)V_lds + v_rd_base(lane);
  struct { bf16x8 vs0, vs1, ks0, ks1, ks2; } sr_[1];
#define SLOAD(i, k0) do { const bf16_t* vt = Vh + (long)(k0) * DV; const bf16_t* kt = Kh + (long)(k0) * DQK; \
    sr_[i].vs0 = *reinterpret_cast<const bf16x8*>(vt + (sr) * DV + sc); sr_[i].vs1 = *reinterpret_cast<const bf16x8*>(vt + (32 + sr) * DV + sc); \
    sr_[i].ks0 = *reinterpret_cast<const bf16x8*>(kt + tid * 8); sr_[i].ks1 = *reinterpret_cast<const bf16x8*>(kt + (tid + 512) * 8); sr_[i].ks2 = *reinterpret_cast<const bf16x8*>(kt + (tid + 1024) * 8); } while (0)
#define SWRITE(b, i) do { *(bf16x8*)(V_lds + (b) * SHM_V + vst0) = sr_[i].vs0; *(bf16x8*)(V_lds + (b) * SHM_V + vst1) = sr_[i].vs1; \
    *(bf16x8*)(K_lds + (b) * SHM_K + kst[0]) = sr_[i].ks0; *(bf16x8*)(K_lds + (b) * SHM_K + kst[1]) = sr_[i].ks1; *(bf16x8*)(K_lds + (b) * SHM_K + kst[2]) = sr_[i].ks2; } while (0)
#define SWAIT() asm volatile("s_waitcnt vmcnt(5)" ::: "memory")
#define RESC(a) do { if (__any((a) < 1.f)) { if (hi == 0) al_l[r32] = (a); asm volatile("s_waitcnt lgkmcnt(0)" ::: "memory"); \
    _Pragma("unroll") for (int d = 0; d < 4; ++d) _Pragma("unroll") for (int r = 0; r < 16; ++r) o[d][r] *= al_l[crow(r, hi)]; } } while (0)
  f32x16 pA0, pA1; float mnA, alA; bf16x8 pa0, pa1, pa2, pa3; const int NT = seq / KVBLK;
  SLOAD(0, 0); SWRITE(0, 0);
  SLOAD(0, KVBLK);
  __syncthreads();
  for (int j = 0; j < NT; j += 2) {
    SBAR(); qkt(pA0, pA1, K_lds, qr, r32, hi);
    partialSM(pA0, pA1, m_reg, mnA, alA); RESC(alA);
    finishSM(pA0, pA1, alA, l_reg, pa0, pa1, pa2, pa3); SBAR();
    SWRITE(1, 0);
    if (j + 2 < NT) SLOAD(0, (j + 2) * KVBLK);
    SBAR();
    pv_d0(o, vb0, pa0, pa1, pa2, pa3);
    __syncthreads();
    SBAR(); qkt(pA0, pA1, K_lds + SHM_K, qr, r32, hi);
    partialSM(pA0, pA1, m_reg, mnA, alA); RESC(alA);
    finishSM(pA0, pA1, alA, l_reg, pa0, pa1, pa2, pa3); SBAR();
    if (j + 2 < NT) { SWRITE(0, 0); if (j + 3 < NT) SLOAD(0, (j + 3) * KVBLK); }
    SBAR();
    pv_d0(o, vb0 + SHM_V, pa0, pa1, pa2, pa3);
    __syncthreads();
  }
  if (hi == 0) li_l[r32] = l_reg; asm volatile("s_waitcnt lgkmcnt(0)" ::: "memory");
  float rli[16];
#pragma unroll
  for (int r = 0; r < 16; ++r) rli[r] = __builtin_amdgcn_rcpf(li_l[crow(r, hi)]);
  bf16_t* Ow = Ob + (long)(wid * 32) * ldo;
#pragma unroll
  for (int r = 0; r < 16; ++r) { int orow = crow(r, hi);
#pragma unroll
    for (int d0 = 0; d0 < 4; ++d0) Ow[(long)orow * ldo + d0 * 32 + r32] = f2bf(o[d0][r] * rli[r]); }
  __syncthreads();
#undef SLOAD
#undef SWRITE
#undef SWAIT
#undef RESC
}
#undef KSWZ
}

__device__ void ph_attn(const Params& p, char* lds) {
    const bf16_t* Q = (const bf16_t*)(p.ws + OFF_Q); const bf16_t* K = (const bf16_t*)(p.ws + OFF_K); const bf16_t* V = (const bf16_t*)(p.ws + OFF_V);
    bf16_t* O = (bf16_t*)(p.ws + OFF_O);
    const int G = gdim();
    for (int i = 0;; ++i) {
        const int L = i * G + bidx(); if (L >= 544) break;
        int bh, qb;
        if (L < 512) { const int w = g8::xcd_remap(L, 512); bh = w >> 4; qb = 1 + (w & 15); } else { bh = L - 512; qb = 0; }
        const int b = bh >> 3, h = bh & 7;
        const int seq = qb == 0 ? TC : TK;
        const int row0 = qb == 0 ? NLAT + b * TC : b * TL + (qb - 1) * 256;
        fa::attn_body(p.wv, Q + ((size_t)bh * TK + qb * 256) * 192, K + (size_t)bh * TK * 192, V + (size_t)bh * TK * 128, O + (size_t)row0 * D + h * 128, D, seq, lds,
                      qb == 0 ? nullptr : (const float*)(p.ws + OFF_ROPE_C) + (size_t)(qb - 1) * 256 * 64);
    }
}

__device__ void ph_norm2_router(const Params& p, int layer, char* lds, int nrows) {
    const int tid = tidx(), wid = tid >> 6, lane = tid & 63;
    float* rt = (float*)lds;
    const float* rg = p.moe_router + (size_t)layer * D * NE;
    for (int i = tid; i < D * NE / 4; i += NTHR) { const int d = i >> 2, eq = i & 3; ((float4*)rt)[(((d >> 8) * 4 + (d & 3)) * 4 + eq) * 64 + ((d & 255) >> 2)] = ((const float4*)rg)[i]; }
    __syncthreads();
    const xt_t* X = (const xt_t*)(p.ws + OFF_X); bf16_t* BN = (bf16_t*)(p.ws + OFF_H); float* AFF = (float*)(p.ws + OFF_AFF);
    const float* g = p.norm2_g + layer * D;
    int row = bidx() * 8 + wid;
    float4 nv[4];
    if (row < nrows) {
#pragma unroll
        for (int i = 0; i < 4; ++i) nv[i] = xld(X, (size_t)row * D + (lane + i * 64) * 4); }
    for (; row < nrows; row += gdim() * 8) {
        const int s = row_stream(row);
        const float* sh = modp(p, layer, s, 3); const float* sc = modp(p, layer, s, 4);
        float4 v[4]; float ss = 0;
#pragma unroll
        for (int i = 0; i < 4; ++i) { v[i] = nv[i]; ss += v[i].x * v[i].x + v[i].y * v[i].y + v[i].z * v[i].z + v[i].w * v[i].w; }
        { const int nrow = row + gdim() * 8;
          if (nrow < nrows) {
#pragma unroll
              for (int i = 0; i < 4; ++i) nv[i] = xld(X, (size_t)nrow * D + (lane + i * 64) * 4); } }
        ss = wave_sum(ss); const float rs = rsqrtf(ss * (1.f / D) + RMS_EPS);
        float lg[16];
#pragma unroll
        for (int e = 0; e < 16; ++e) lg[e] = 0.f;
#pragma unroll
        for (int i = 0; i < 4; ++i) {
            const int d = (lane + i * 64) * 4;
            const float4 gg = *(const float4*)(g + d), a = *(const float4*)(sc + d), b = *(const float4*)(sh + d);
            float o[4]; o[0] = v[i].x * rs * gg.x * (1.f + a.x) + b.x; o[1] = v[i].y * rs * gg.y * (1.f + a.y) + b.y; o[2] = v[i].z * rs * gg.z * (1.f + a.z) + b.z; o[3] = v[i].w * rs * gg.w * (1.f + a.w) + b.w;
            uint2 w; w.x = pk2(o[0], o[1]); w.y = pk2(o[2], o[3]); *(uint2*)(BN + (size_t)row * D + d) = w;
#pragma unroll
            for (int jj = 0; jj < 4; ++jj) {
#pragma unroll
                for (int eq = 0; eq < 4; ++eq) { const float4 r4 = ((const float4*)rt)[((i * 4 + jj) * 4 + eq) * 64 + lane];
                    lg[4 * eq] += o[jj] * r4.x; lg[4 * eq + 1] += o[jj] * r4.y; lg[4 * eq + 2] += o[jj] * r4.z; lg[4 * eq + 3] += o[jj] * r4.w; } }
            asm volatile("" ::: "memory");
        }
        float mx = -1e30f;
#pragma unroll
        for (int e = 0; e < 16; ++e) { lg[e] = wave_sum(lg[e]); mx = fmaxf(mx, lg[e]); }
        float sum = 0;
#pragma unroll
        for (int e = 0; e < 16; ++e) { lg[e] = expf(lg[e] - mx); sum += lg[e]; }
        const float inv = 1.f / sum;
        if (lane < 16) { float val = 0;
#pragma unroll
            for (int e = 0; e < 16; ++e) val = (lane == e) ? lg[e] : val;
            AFF[(size_t)row * 16 + lane] = val * inv; }
    }
}

__device__ void ph_select(const Params& p, char* lds, int ngroups) {
    const int tid = tidx(), wid = tid >> 6, lane = tid & 63;
    unsigned* hist = (unsigned*)lds;
    unsigned* ctl = hist + 256;
    unsigned* wsum = ctl + 8;
    int* rowl = (int*)(wsum + 16);
    const float* AFF = (const float*)(p.ws + OFF_AFF);
    int* ROWIDX = (int*)(p.ws + OFF_ROWIDX); float* GATE = (float*)(p.ws + OFF_GATE); int* SLOT = (int*)(p.ws + OFF_SLOT);
    for (int gidx = bidx(); gidx < ngroups; gidx += gdim()) {
        const bool lat = gidx < 64; const int b = (gidx & 63) >> 4, e = gidx & 15;
        const int n = lat ? TL : TC, cap = lat ? CAPL : CAPC;
        const int row0 = lat ? b * TL : NLAT + b * TC, slot0 = lat ? b * CAPL : NB * CAPL + b * CAPC;
        unsigned key[8];
#pragma unroll
        for (int i = 0; i < 8; ++i) { const int idx = tid * 8 + i; key[i] = idx < n ? __float_as_uint(AFF[(size_t)(row0 + idx) * 16 + e]) : 0u; }
        unsigned prefix = 0u, remaining = (unsigned)cap;
#pragma unroll
        for (int pass = 0; pass < 4; ++pass) {
            const int sh = 24 - 8 * pass;
            __syncthreads();
            if (tid < 256) hist[tid] = 0u;
            __syncthreads();
#pragma unroll
            for (int i = 0; i < 8; ++i) { const int idx = tid * 8 + i;
                const bool cand = idx < n && (pass == 0 || (key[i] >> (sh + 8)) == prefix);
                if (cand) atomicAdd(&hist[(key[i] >> sh) & 255u], 1u); }
            __syncthreads();
            if (tid < 256) { unsigned gt = 0; for (int jj = tid + 1; jj < 256; ++jj) gt += hist[jj];
                const unsigned mine = hist[tid];
                if (gt < remaining && remaining <= gt + mine) { ctl[0] = (unsigned)tid; ctl[1] = remaining - gt; } }
            __syncthreads();
            prefix = (prefix << 8) | ctl[0]; remaining = ctl[1];
        }
        const unsigned T = prefix, m = remaining;
        unsigned cgt = 0, ceq = 0;
#pragma unroll
        for (int i = 0; i < 8; ++i) { const int idx = tid * 8 + i; if (idx < n) { cgt += key[i] > T ? 1u : 0u; ceq += key[i] == T ? 1u : 0u; } }
        auto block_excl = [&](unsigned v) -> unsigned {
            unsigned inc = v;
#pragma unroll
            for (int o = 1; o < 64; o <<= 1) { const unsigned t = (unsigned)__builtin_amdgcn_ds_bpermute((lane - o) << 2, (int)inc); if (lane >= o) inc += t; }
            __syncthreads();
            if (lane == 63) wsum[wid] = inc;
            __syncthreads();
            unsigned base = 0;
#pragma unroll
            for (int w = 0; w < 8; ++w) base += (w < wid) ? wsum[w] : 0u;
            return base + inc - v; };
        unsigned eqbase = block_excl(ceq);
        unsigned nsel = 0; bool sel[8];
#pragma unroll
        for (int i = 0; i < 8; ++i) { const int idx = tid * 8 + i; bool s_ = false;
            if (idx < n) { if (key[i] > T) s_ = true; else if (key[i] == T) { s_ = eqbase < m; ++eqbase; } }
            sel[i] = s_; nsel += s_ ? 1u : 0u; }
        unsigned sbase = block_excl(nsel);
#pragma unroll
        for (int i = 0; i < 8; ++i) { const int idx = tid * 8 + i;
            if (idx < n) {
                if (sel[i]) { const int sl = slot0 + (int)sbase; rowl[sbase] = row0 + idx; ++sbase; ROWIDX[e * ESLOTS + sl] = row0 + idx; GATE[e * EPAD + sl] = __uint_as_float(key[i]); SLOT[(size_t)(row0 + idx) * 16 + e] = sl; }
                else SLOT[(size_t)(row0 + idx) * 16 + e] = -1; } }
        __syncthreads();
        { const bf16_t* BN = (const bf16_t*)(p.ws + OFF_H); bf16_t* XE = (bf16_t*)(p.ws + OFF_XE);
          for (int r = wid; r < cap; r += 32) {
              u32x4 t_[4][2];
#pragma unroll
              for (int u = 0; u < 4; ++u) { const u32x4* src = (const u32x4*)(BN + (size_t)rowl[r + 8 * u] * D); t_[u][0] = src[lane]; t_[u][1] = src[lane + 64]; }
#pragma unroll
              for (int u = 0; u < 4; ++u) { u32x4* dst = (u32x4*)(XE + ((size_t)e * EPAD + slot0 + r + 8 * u) * D); dst[lane] = t_[u][0]; dst[lane + 64] = t_[u][1]; } } }
    }
}

__device__ void ph_gather(const Params& p, int nslots) {
    const int wid = tidx() >> 6, lane = tidx() & 63;
    const int* ROWIDX = (const int*)(p.ws + OFF_ROWIDX); const bf16_t* BN = (const bf16_t*)(p.ws + OFF_H); bf16_t* XE = (bf16_t*)(p.ws + OFF_XE);
    for (int it = bidx() * 8 + wid; it < NE * ESLOTS; it += gdim() * 8) {
        const int e = it / ESLOTS, sl = it % ESLOTS; if (sl >= nslots) continue; const int row = ROWIDX[it];
        const u32x4* src = (const u32x4*)(BN + (size_t)row * D); u32x4* dst = (u32x4*)(XE + ((size_t)e * EPAD + sl) * D);
        dst[lane] = src[lane]; dst[lane + 64] = src[lane + 64];
    }
}

__device__ void ph_combine(const Params& p, int layer, int nrows) {
    const int wid = tidx() >> 6, lane = tidx() & 63;
    const int* SLOT = (const int*)(p.ws + OFF_SLOT); const bf16_t* YE = (const bf16_t*)(p.ws + OFF_YE); xt_t* X = (xt_t*)(p.ws + OFF_X);
    int row = bidx() * 8 + wid;
    int sl = (row < nrows && lane < 16) ? SLOT[(size_t)row * 16 + lane] : -1;
    while (row < nrows) {
        const int nrow = row + gdim() * 8;
        const int sln = (nrow < nrows && lane < 16) ? SLOT[(size_t)nrow * 16 + lane] : -1;
        const float* gt = modp(p, layer, row_stream(row), 5);
        xt_t* xr = X + (size_t)row * D + lane * 8;
        f32x4 xv[4];
#pragma unroll
        for (int i = 0; i < 2; ++i) { xv[2 * i] = xldv(xr, 512 * i); xv[2 * i + 1] = xldv(xr, 512 * i + 4); }
        unsigned long long m = __ballot(sl >= 0);
        float acc[16];
#pragma unroll
        for (int i = 0; i < 16; ++i) acc[i] = 0.f;
        while (m) {
            const int e0 = __builtin_ctzll(m); m &= m - 1; const bool two = m != 0; const int e1 = two ? __builtin_ctzll(m) : e0; if (two) m &= m - 1;
            const int s0 = __builtin_amdgcn_readlane(sl, e0), s1 = __builtin_amdgcn_readlane(sl, e1);
            const bf16_t* y0 = YE + ((size_t)e0 * EPAD + s0) * D + lane * 8; const bf16_t* y1 = YE + ((size_t)e1 * EPAD + s1) * D + lane * 8;
            const u32x4 a0 = *(const u32x4*)y0, a1 = *(const u32x4*)(y0 + 512), b0 = *(const u32x4*)y1, b1 = *(const u32x4*)(y1 + 512);
            const float f1 = two ? 1.f : 0.f;
#pragma unroll
            for (int i = 0; i < 4; ++i) { acc[2 * i] += __uint_as_float(a0[i] << 16) + f1 * __uint_as_float(b0[i] << 16); acc[2 * i + 1] += __uint_as_float(a0[i] & 0xffff0000u) + f1 * __uint_as_float(b0[i] & 0xffff0000u);
                acc[8 + 2 * i] += __uint_as_float(a1[i] << 16) + f1 * __uint_as_float(b1[i] << 16); acc[8 + 2 * i + 1] += __uint_as_float(a1[i] & 0xffff0000u) + f1 * __uint_as_float(b1[i] & 0xffff0000u); }
        }
#pragma unroll
        for (int i = 0; i < 2; ++i) { const f32x4 g0 = *(const f32x4*)(gt + lane * 8 + 512 * i), g1 = *(const f32x4*)(gt + lane * 8 + 512 * i + 4);
            f32x4 o0 = xv[2 * i], o1 = xv[2 * i + 1];
#pragma unroll
            for (int e = 0; e < 4; ++e) { o0[e] += g0[e] * acc[8 * i + e]; o1[e] += g1[e] * acc[8 * i + 4 + e]; }
            xstv(xr, 512 * i, o0); xstv(xr, 512 * i + 4, o1); }
        row = nrow; sl = sln;
    }
}

template <bool FINAL>
__device__ void ph_comb_norm(const Params& p, int lprev, int layer, int nrows) {
    const int wid = tidx() >> 6, lane = tidx() & 63;
    const int* SLOT = (const int*)(p.ws + OFF_SLOT); const bf16_t* YE = (const bf16_t*)(p.ws + OFF_YE); xt_t* X = (xt_t*)(p.ws + OFF_X);
    bf16_t* H = (bf16_t*)(p.ws + OFF_H);
    const float* g = FINAL ? p.final_g : p.norm1_g + layer * D;
    int row = bidx() * 8 + wid;
    int sl = (row < nrows && lane < 16) ? SLOT[(size_t)row * 16 + lane] : -1;
    while (row < nrows) {
        const int nrow = row + gdim() * 8;
        const int sln = (nrow < nrows && lane < 16) ? SLOT[(size_t)nrow * 16 + lane] : -1;
        const int strm = row_stream(row);
        const float* gt = modp(p, lprev, strm, 5);
        xt_t* xr = X + (size_t)row * D + lane * 8;
        f32x4 xv[4];
#pragma unroll
        for (int i = 0; i < 2; ++i) { xv[2 * i] = xldv(xr, 512 * i); xv[2 * i + 1] = xldv(xr, 512 * i + 4); }
        unsigned long long m = __ballot(sl >= 0);
        float acc[16];
#pragma unroll
        for (int i = 0; i < 16; ++i) acc[i] = 0.f;
        while (m) {
            const int e0 = __builtin_ctzll(m); m &= m - 1; const bool two = m != 0; const int e1 = two ? __builtin_ctzll(m) : e0; if (two) m &= m - 1;
            const int s0 = __builtin_amdgcn_readlane(sl, e0), s1 = __builtin_amdgcn_readlane(sl, e1);
            const bf16_t* y0 = YE + ((size_t)e0 * EPAD + s0) * D + lane * 8; const bf16_t* y1 = YE + ((size_t)e1 * EPAD + s1) * D + lane * 8;
            const u32x4 a0 = *(const u32x4*)y0, a1 = *(const u32x4*)(y0 + 512), b0 = *(const u32x4*)y1, b1 = *(const u32x4*)(y1 + 512);
            const float f1 = two ? 1.f : 0.f;
#pragma unroll
            for (int i = 0; i < 4; ++i) { acc[2 * i] += __uint_as_float(a0[i] << 16) + f1 * __uint_as_float(b0[i] << 16); acc[2 * i + 1] += __uint_as_float(a0[i] & 0xffff0000u) + f1 * __uint_as_float(b0[i] & 0xffff0000u);
                acc[8 + 2 * i] += __uint_as_float(a1[i] << 16) + f1 * __uint_as_float(b1[i] << 16); acc[8 + 2 * i + 1] += __uint_as_float(a1[i] & 0xffff0000u) + f1 * __uint_as_float(b1[i] & 0xffff0000u); }
        }
        float ss = 0.f;
#pragma unroll
        for (int i = 0; i < 2; ++i) { const f32x4 g0 = *(const f32x4*)(gt + lane * 8 + 512 * i), g1 = *(const f32x4*)(gt + lane * 8 + 512 * i + 4);
#pragma unroll
            for (int e = 0; e < 4; ++e) { xv[2 * i][e] += g0[e] * acc[8 * i + e]; xv[2 * i + 1][e] += g1[e] * acc[8 * i + 4 + e]; ss += xv[2 * i][e] * xv[2 * i][e] + xv[2 * i + 1][e] * xv[2 * i + 1][e]; }
            if (!FINAL) { xstv(xr, 512 * i, xv[2 * i]); xstv(xr, 512 * i + 4, xv[2 * i + 1]); } }
        ss = wave_sum(ss); const float rs = rsqrtf(ss * (1.f / D) + RMS_EPS);
        const float* sh = FINAL ? nullptr : modp(p, layer, strm, 0); const float* sc = FINAL ? nullptr : modp(p, layer, strm, 1);
#pragma unroll
        for (int i = 0; i < 2; ++i)
#pragma unroll
            for (int hh = 0; hh < 2; ++hh) { const int d = lane * 8 + 512 * i + 4 * hh; const f32x4 gg = *(const f32x4*)(g + d); f32x4 o = xv[2 * i + hh] * rs * gg;
                if (FINAL) *(f32x4*)(p.out + (size_t)row * D + d) = o;
                else { o = o * (1.f + *(const f32x4*)(sc + d)) + *(const f32x4*)(sh + d); stbf4(H + (size_t)row * D + d, o); } }
        row = nrow; sl = sln;
    }
}

__device__ void ph_rw_normxs(const Params& p, int layer, int j) {
    const int wid = tidx() >> 6, lane = tidx() & 63;
    const xt_t* X = (const xt_t*)(p.ws + OFF_X); bf16_t* XS = (bf16_t*)(p.ws + OFF_XS);
    const float* mu = p.rw_mu + (size_t)j * 6 * D; const float* g = p.norm1_g + layer * D;
    float4 fc[4], fp[4], fn[4];
#define XS_LOAD(R) do { const bool lat_ = (R) < NLAT; const int t_ = lat_ ? ((R) & (TL - 1)) : (((R) - NLAT) & (TC - 1)); const int len_ = lat_ ? TL : TC; \
        _Pragma("unroll") for (int i = 0; i < 4; ++i) { fc[i] = xld(X, (size_t)(R) * D + (lane + i * 64) * 4); \
            fp[i] = t_ > 0 ? xld(X, (size_t)((R) - 1) * D + (lane + i * 64) * 4) : make_float4(0, 0, 0, 0); \
            fn[i] = t_ < len_ - 1 ? xld(X, (size_t)((R) + 1) * D + (lane + i * 64) * 4) : make_float4(0, 0, 0, 0); } } while (0)
    int row = bidx() * 8 + wid;
    if (row < NROW) XS_LOAD(row);
    for (; row < NROW; row += gdim() * 8) {
        const int s_ = row_stream(row);
        const float* sh = modp(p, layer, s_, 0); const float* sc = modp(p, layer, s_, 1);
        const bool lat = row < NLAT; const int t = lat ? (row & (TL - 1)) : ((row - NLAT) & (TC - 1)); const int len = lat ? TL : TC;
        const bool hp = t > 0, hn = t < len - 1;
        float4 xc[4], xp[4], xn[4]; float sc_ = 0, sp_ = 0, sn_ = 0;
#pragma unroll
        for (int i = 0; i < 4; ++i) { xc[i] = fc[i]; xp[i] = fp[i]; xn[i] = fn[i]; }
        { const int nrow = row + gdim() * 8; if (nrow < NROW) XS_LOAD(nrow); }
#pragma unroll
        for (int i = 0; i < 4; ++i) {
            sc_ += xc[i].x * xc[i].x + xc[i].y * xc[i].y + xc[i].z * xc[i].z + xc[i].w * xc[i].w;
            sp_ += xp[i].x * xp[i].x + xp[i].y * xp[i].y + xp[i].z * xp[i].z + xp[i].w * xp[i].w;
            sn_ += xn[i].x * xn[i].x + xn[i].y * xn[i].y + xn[i].z * xn[i].z + xn[i].w * xn[i].w; }
        sc_ = wave_sum(sc_); sp_ = wave_sum(sp_); sn_ = wave_sum(sn_);
        const float rc = rsqrtf(sc_ * (1.f / D) + RMS_EPS), rp = hp ? rsqrtf(sp_ * (1.f / D) + RMS_EPS) : 0.f, rn = hn ? rsqrtf(sn_ * (1.f / D) + RMS_EPS) : 0.f;
#pragma unroll
        for (int i = 0; i < 4; ++i) {
            const int d = (lane + i * 64) * 4;
            const float4 gg = *(const float4*)(g + d), a = *(const float4*)(sc + d), bsh = *(const float4*)(sh + d);
            float h[4], xx[4];
            const float gm[4] = {gg.x * (1.f + a.x), gg.y * (1.f + a.y), gg.z * (1.f + a.z), gg.w * (1.f + a.w)}; const float bb[4] = {bsh.x, bsh.y, bsh.z, bsh.w};
            const float c4[4] = {xc[i].x, xc[i].y, xc[i].z, xc[i].w}, p4[4] = {xp[i].x, xp[i].y, xp[i].z, xp[i].w}, n4[4] = {xn[i].x, xn[i].y, xn[i].z, xn[i].w};
#pragma unroll
            for (int e = 0; e < 4; ++e) { h[e] = c4[e] * rc * gm[e] + bb[e];
                const float hpv = hp ? p4[e] * rp * gm[e] + bb[e] : 0.f, hnv = hn ? n4[e] * rn * gm[e] + bb[e] : 0.f;
                xx[e] = 0.5f * (hpv + hnv) - h[e]; }
#pragma unroll
            for (int m = 0; m < 6; ++m) { const float4 u = *(const float4*)(mu + m * D + d);
                uint2 w; w.x = pk2(h[0] + xx[0] * u.x, h[1] + xx[1] * u.y); w.y = pk2(h[2] + xx[2] * u.z, h[3] + xx[3] * u.w);
                *(uint2*)(XS + ((size_t)m * NROW + row) * D + d) = w; }
        }
    }
#undef XS_LOAD
}

__device__ __forceinline__ int scan_row(int i, int b, int z) {
    return i < TC ? NLAT + b * TC + (z ? TC - 1 - i : i) : b * TL + (z ? TL - 1 - (i - TC) : i - TC);
}
__device__ __forceinline__ float dpp_sum8(float x) {
    x += __builtin_bit_cast(float, __builtin_amdgcn_update_dpp(0, __builtin_bit_cast(int, x), 0xB1, 0xF, 0xF, true));
    x += __builtin_bit_cast(float, __builtin_amdgcn_update_dpp(0, __builtin_bit_cast(int, x), 0x4E, 0xF, 0xF, true));
    x += __builtin_bit_cast(float, __builtin_amdgcn_update_dpp(0, __builtin_bit_cast(int, x), 0x141, 0xF, 0xF, true));
    return x;
}
__device__ void ph_rw_scan(const Params& p, int j, char* lds) {
    const int tid = tidx(), wid = __builtin_amdgcn_readfirstlane(tid >> 6), lane = tid & 63;
    const size_t PL = (size_t)NROW * D;
    const float* RKV = (const float*)(p.ws + OFF_RKV); float* Y = (float*)(p.ws + OFF_Y);
    constexpr int CH = 32, BUFB = 5 * CH * 256 + CH * 128 + CH * 16, YB = CH * 32 * 4, NCH = (TC + TL) / CH;
    const bool loader = wid >= 4; const int lw = wid - 4;
    for (int it = bidx(); it < 256; it += gdim()) {
        const int vh = it & 1, z = (it >> 1) & 1, h = (it >> 2) & 15, b = it >> 6;
        const char* pl0 = (const char*)((const float*)(p.ws + OFF_W) + z * PL); const char* pl1 = (const char*)(RKV + PL);
        const char* pl2 = (const char*)((const float*)(p.ws + OFF_AV) + z * PL); const char* pl3 = (const char*)RKV;
        const char* vpl = (const char*)(RKV + 2 * PL);
        float* yout = Y + z * PL;
        __builtin_amdgcn_s_barrier();
        if (loader) {
            const int pq = lane & 15;
            const f32x4 kkv = *(const f32x4*)(p.rw_k_k + j * D + h * 64 + pq * 4), kav = *(const f32x4*)(p.rw_k_a + j * D + h * 64 + pq * 4);
            auto issue = [&](int c) {
                char* buf = lds + (c % 3) * BUFB;
#pragma unroll
                for (int q = 0; q < 8; ++q) { const int pi = q >> 1, tg = lw * 2 + (q & 1); const int row = scan_row(c * CH + tg * 4 + (lane >> 4), b, z);
                    const char* base = pi == 0 ? pl0 : pi == 1 ? pl1 : pi == 2 ? pl2 : pl3;
                    __builtin_amdgcn_global_load_lds((const unsigned*)(base + (size_t)row * D * 4 + h * 256 + (lane & 15) * 16), (LAS unsigned*)(buf + pi * (CH * 256) + tg * 1024), 16, 0, 0); }
                { const int row = scan_row(c * CH + lw * 8 + (lane >> 3), b, z);
                  __builtin_amdgcn_global_load_lds((const unsigned*)(vpl + (size_t)row * D * 4 + (h * 64 + vh * 32) * 4 + (lane & 7) * 16), (LAS unsigned*)(buf + 5 * CH * 256 + lw * 1024), 16, 0, 0); }
            };
            auto prep = [&](int c) {
                char* buf = lds + (c % 3) * BUFB;
#pragma unroll
                for (int ps = 0; ps < 2; ++ps) { const int ptok = lw * 8 + ps * 4 + (lane >> 4);
                    f32x4* kp = (f32x4*)(buf + 1 * CH * 256 + ptok * 256 + pq * 16); f32x4* ap = (f32x4*)(buf + 2 * CH * 256 + ptok * 256 + pq * 16); f32x4* dp = (f32x4*)(buf + 4 * CH * 256 + ptok * 256 + pq * 16);
                    f32x4* rp = (f32x4*)(buf + 3 * CH * 256 + ptok * 256 + pq * 16); const f32x4 wv = *(const f32x4*)(buf + ptok * 256 + pq * 16);
                    const f32x4 k = *kp, a = *ap, r = *rp; f32x4 kk = k * kkv;
                    float ss = kk[0] * kk[0] + kk[1] * kk[1] + kk[2] * kk[2] + kk[3] * kk[3]; ss = dpp_sum16(ss);
                    const float inv = 1.f / fmaxf(sqrtf(ss), 1e-12f); kk = kk * inv;
                    const f32x4 kd = k * (1.f + (a - 1.f) * kav), bb = kk * a;
                    const f32x4 t1 = bb * r, t2 = kd * r;
                    const float br = dpp_sum16((t1[0] + t1[1]) + (t1[2] + t1[3])), kr = dpp_sum16((t2[0] + t2[1]) + (t2[2] + t2[3]));
                    *dp = kd; *ap = bb; *kp = kk; *rp = wv * r;
                    if (pq == 0) *(float2*)(buf + 5 * CH * 256 + CH * 128 + ptok * 16) = make_float2(br, kr); }
            };
            issue(0); issue(1);
            asm volatile("s_waitcnt vmcnt(9)" ::: "memory");
            prep(0);
            asm volatile("s_waitcnt lgkmcnt(0)" ::: "memory"); __builtin_amdgcn_s_barrier();
            for (int c = 0; c < NCH; ++c) {
                if (c >= 1) { const float* yb = (const float*)(lds + 3 * BUFB + ((c - 1) & 1) * YB);
                    const int lt = tid - 256, t = lt >> 3, q = lt & 7; const int row = scan_row((c - 1) * CH + t, b, z);
                    *(f32x4*)(yout + (size_t)row * D + h * 64 + vh * 32 + q * 4) = *(const f32x4*)(yb + t * 32 + q * 4); }
                if (c + 2 < NCH) { issue(c + 2); asm volatile("s_waitcnt vmcnt(9)" ::: "memory"); } else asm volatile("s_waitcnt vmcnt(0)" ::: "memory");
                if (c + 1 < NCH) prep(c + 1);
                asm volatile("s_waitcnt lgkmcnt(0)" ::: "memory"); __builtin_amdgcn_s_barrier();
            }
            { const float* yb = (const float*)(lds + 3 * BUFB + ((NCH - 1) & 1) * YB);
              const int lt = tid - 256, t = lt >> 3, q = lt & 7; const int row = scan_row((NCH - 1) * CH + t, b, z);
              *(f32x4*)(yout + (size_t)row * D + h * 64 + vh * 32 + q * 4) = *(const f32x4*)(yb + t * 32 + q * 4); }
        } else {
            const int vr = lane >> 3, ks = lane & 7;
            f32x4 Sa = {0.f, 0.f, 0.f, 0.f}, Sb = {0.f, 0.f, 0.f, 0.f};
            __builtin_amdgcn_s_barrier();
            struct Ops { f32x4 w0, w1, kk0, kk1, bb0, bb1, r0, r1, kd0, kd1; float v; float2 sc; };
#define SC_LOAD(O, t) do { const char* q_ = bq + (t) * 256; O.w0 = *(const f32x4*)(q_); O.w1 = *(const f32x4*)(q_ + 16); O.kk0 = *(const f32x4*)(q_ + CH * 256); O.kk1 = *(const f32x4*)(q_ + CH * 256 + 16); \
                O.bb0 = *(const f32x4*)(q_ + 2 * CH * 256); O.bb1 = *(const f32x4*)(q_ + 2 * CH * 256 + 16); O.r0 = *(const f32x4*)(q_ + 3 * CH * 256); O.r1 = *(const f32x4*)(q_ + 3 * CH * 256 + 16); \
                O.kd0 = *(const f32x4*)(q_ + 4 * CH * 256); O.kd1 = *(const f32x4*)(q_ + 4 * CH * 256 + 16); O.v = *(const float*)(vq + (t) * 128); O.sc = *(const float2*)(buf + 5 * CH * 256 + CH * 128 + (t) * 16); } while (0)
#define SC_STEP(O, t) do { const f32x4 d1 = Sa * O.kk0 + Sb * O.kk1, d2 = Sa * O.r0 + Sb * O.r1; \
                float sa = -((d1[0] + d1[1]) + (d1[2] + d1[3])), yy = (d2[0] + d2[1]) + (d2[2] + d2[3]); \
                sa = dpp_sum8(sa); yy = dpp_sum8(yy); \
                Sa = Sa * O.w0 + (sa * O.bb0 + O.v * O.kd0); Sb = Sb * O.w1 + (sa * O.bb1 + O.v * O.kd1); \
                if (ks == 0) yb[(t) * 32 + wid * 8 + vr] = yy + sa * O.sc.x + O.v * O.sc.y; } while (0)
            for (int c = 0; c < NCH; ++c) {
                const char* buf = lds + (c % 3) * BUFB; float* yb = (float*)(lds + 3 * BUFB + (c & 1) * YB);
                const char* bq = buf + ks * 32; const char* vq = buf + 5 * CH * 256 + (wid * 8 + vr) * 4;
                Ops oA, oB, oC;
                SC_LOAD(oA, 0); SC_LOAD(oB, 1);
#pragma unroll
                for (int t = 0; t < CH; t += 3) {
                    if (t + 2 < CH) SC_LOAD(oC, t + 2);
                    SC_STEP(oA, t);
                    if (t + 3 < CH) SC_LOAD(oA, t + 3);
                    if (t + 1 < CH) SC_STEP(oB, t + 1);
                    if (t + 4 < CH) SC_LOAD(oB, t + 4);
                    if (t + 2 < CH) SC_STEP(oC, t + 2);
                }
                asm volatile("s_waitcnt lgkmcnt(0)" ::: "memory"); __builtin_amdgcn_s_barrier();
            }
#undef SC_LOAD
#undef SC_STEP
        }
    }
}


namespace ck {
constexpr int P = 72, MB = 64 * P * 2;
typedef __attribute__((address_space(3))) char lchar;
__device__ __forceinline__ f32x4 mm_tile(const lchar* Aop, const lchar* Bop, int ti, int tj, int c, int q, f32x4 acc) {
#pragma unroll
    for (int ks = 0; ks < 2; ++ks) {
        const bf16x8 a = *(const LAS bf16x8*)(Aop + ((16 * ti + c) * P + 32 * ks + 8 * q) * 2);
        const bf16x8 b = *(const LAS bf16x8*)(Bop + ((16 * tj + c) * P + 32 * ks + 8 * q) * 2);
        acc = __builtin_amdgcn_mfma_f32_16x16x32_bf16(a, b, acc, 0, 0, 0);
    }
    return acc;
}
__device__ __forceinline__ f32x4 mm_diag(const lchar* Aop, const lchar* Bop, int tt, int c, int q, f32x4 acc) {
    const int ks = tt >> 1;
    bf16x8 a = *(const LAS bf16x8*)(Aop + ((16 * tt + c) * P + 32 * ks + 8 * q) * 2);
    const bf16x8 b = *(const LAS bf16x8*)(Bop + ((16 * tt + c) * P + 32 * ks + 8 * q) * 2);
    if ((q >> 1) != (tt & 1)) a = (bf16x8){0, 0, 0, 0, 0, 0, 0, 0};
    return __builtin_amdgcn_mfma_f32_16x16x32_bf16(a, b, acc, 0, 0, 0);
}
__device__ __forceinline__ void st_tile(lchar* dst, int ti, int tj, int c, int q, f32x4 v) {
    u32x2 w; w.x = pk2(v[0], v[1]); w.y = pk2(v[2], v[3]); *(LAS u32x2*)(dst + ((16 * tj + c) * P + 16 * ti + 4 * q) * 2) = w;
}
__device__ __forceinline__ f32x4 ld_tile(const lchar* src, int ti, int tj, int c, int q) {
    const u32x2 w = *(const LAS u32x2*)(src + ((16 * tj + c) * P + 16 * ti + 4 * q) * 2);
    return (f32x4){__uint_as_float(w.x << 16), __uint_as_float(w.x & 0xffff0000u), __uint_as_float(w.y << 16), __uint_as_float(w.y & 0xffff0000u)};
}
__device__ __forceinline__ void st_glob(bf16_t* dst, int ti, int tj, int c, int q, f32x4 v) {
    uint2 w; w.x = pk2(v[0], v[1]); w.y = pk2(v[2], v[3]); *(uint2*)(dst + (16 * tj + c) * 64 + 16 * ti + 4 * q) = w;
}
typedef float f32x16 __attribute__((ext_vector_type(16)));
__device__ __forceinline__ f32x16 mm32(const lchar* Aop, const lchar* Bop, int ti, int tj, int r32, int hi, f32x16 acc) {
#pragma unroll
    for (int ks = 0; ks < 4; ++ks) {
        const bf16x8 a = *(const LAS bf16x8*)(Aop + ((32 * ti + r32) * P + 16 * ks + 8 * hi) * 2);
        const bf16x8 b = *(const LAS bf16x8*)(Bop + ((32 * tj + r32) * P + 16 * ks + 8 * hi) * 2);
        acc = __builtin_amdgcn_mfma_f32_32x32x16_bf16(a, b, acc, 0, 0, 0);
    }
    return acc;
}
__device__ __forceinline__ void st32(lchar* dst, int ti, int tj, int r32, int hi, const f32x16& v) {
#pragma unroll
    for (int g = 0; g < 4; ++g) { u32x2 w; w.x = pk2(v[4 * g], v[4 * g + 1]); w.y = pk2(v[4 * g + 2], v[4 * g + 3]); *(LAS u32x2*)(dst + ((32 * tj + r32) * P + 32 * ti + 8 * g + 4 * hi) * 2) = w; }
}
__device__ __forceinline__ f32x16 ld32(const lchar* src, int ti, int tj, int r32, int hi) {
    f32x16 v;
#pragma unroll
    for (int g = 0; g < 4; ++g) { const u32x2 w = *(const LAS u32x2*)(src + ((32 * tj + r32) * P + 32 * ti + 8 * g + 4 * hi) * 2);
        v[4 * g] = __uint_as_float(w.x << 16); v[4 * g + 1] = __uint_as_float(w.x & 0xffff0000u); v[4 * g + 2] = __uint_as_float(w.y << 16); v[4 * g + 3] = __uint_as_float(w.y & 0xffff0000u); }
    return v;
}
__device__ __forceinline__ void stg32(bf16_t* dst, int ti, int tj, int r32, int hi, const f32x16& v) {
#pragma unroll
    for (int g = 0; g < 4; ++g) { uint2 w; w.x = pk2(v[4 * g], v[4 * g + 1]); w.y = pk2(v[4 * g + 2], v[4 * g + 3]); *(uint2*)(dst + (32 * tj + r32) * 64 + 32 * ti + 8 * g + 4 * hi) = w; }
}
}

#define LBAR() do { asm volatile("s_waitcnt lgkmcnt(0)" ::: "memory"); __builtin_amdgcn_s_barrier(); asm volatile("" ::: "memory"); } while (0)
__device__ void ph_rw_sc1(const Params& p, int j, char* lds) {
    using namespace ck;
    const int tid = tidx(), wid = __builtin_amdgcn_readfirstlane(tid >> 6), lane = tid & 63, c = lane & 15, q = lane >> 4;
    const size_t PL = (size_t)NROW * D;
    const bf16_t* RKV = (const bf16_t*)(p.ws + OFF_RKV); const float* LW = (const float*)(p.ws + OFF_W); const bf16_t* AV = (const bf16_t*)(p.ws + OFF_AV);
    bf16_t* CK = (bf16_t*)(p.ws + OFF_CK);
    lchar* B0 = (lchar*)lds;
#define BUF(i) (B0 + (i) * MB)
    LAS float* Lbuf = (LAS float*)BUF(8);
    LAS float* Lseg = (LAS float*)(B0 + 16 * MB);
    LAS float* GC = Lseg + 8 * 64;
    const int pt = tid >> 3, cg = tid & 7;
    f32x4 nlw[2], nkk[2], nka[2]; u32x4 nkx, nax, nrx, nvx;
#define SC1_LOAD(IT) do { const int seq_ = (IT) / NCHK, ch_ = (IT) % NCHK; const int z_ = seq_ & 1, h_ = (seq_ >> 1) & 15, b_ = seq_ >> 5; \
        const size_t go_ = (size_t)scan_row(ch_ * 64 + pt, b_, z_) * D + h_ * 64 + cg * 8; \
        _Pragma("unroll") for (int e = 0; e < 2; ++e) nlw[e] = *(const f32x4*)(LW + z_ * PL + go_ + 4 * e); \
        nkx = *(const u32x4*)(RKV + PL + go_); nax = *(const u32x4*)(AV + z_ * PL + go_); nrx = *(const u32x4*)(RKV + go_); nvx = *(const u32x4*)(RKV + 2 * PL + go_); \
        _Pragma("unroll") for (int e = 0; e < 2; ++e) { nkk[e] = *(const f32x4*)(p.rw_k_k + j * D + h_ * 64 + cg * 8 + 4 * e); nka[e] = *(const f32x4*)(p.rw_k_a + j * D + h_ * 64 + cg * 8 + 4 * e); } } while (0)
    if (bidx() < 128 * NCHK) SC1_LOAD(bidx());
    for (int it = bidx(); it < 128 * NCHK; it += gdim()) {
        const int seq = it / NCHK; const int h = (seq >> 1) & 15;
        f32x4 lw[2], kx[2], ax[2], rx[2], vx[2], kkc[2], kac[2];
#pragma unroll
        for (int e = 0; e < 2; ++e) { lw[e] = nlw[e]; kkc[e] = nkk[e]; kac[e] = nka[e];
            kx[e] = (f32x4){__uint_as_float(nkx[2 * e] << 16), __uint_as_float(nkx[2 * e] & 0xffff0000u), __uint_as_float(nkx[2 * e + 1] << 16), __uint_as_float(nkx[2 * e + 1] & 0xffff0000u)};
            ax[e] = (f32x4){__uint_as_float(nax[2 * e] << 16), __uint_as_float(nax[2 * e] & 0xffff0000u), __uint_as_float(nax[2 * e + 1] << 16), __uint_as_float(nax[2 * e + 1] & 0xffff0000u)};
            rx[e] = (f32x4){__uint_as_float(nrx[2 * e] << 16), __uint_as_float(nrx[2 * e] & 0xffff0000u), __uint_as_float(nrx[2 * e + 1] << 16), __uint_as_float(nrx[2 * e + 1] & 0xffff0000u)};
            vx[e] = (f32x4){__uint_as_float(nvx[2 * e] << 16), __uint_as_float(nvx[2 * e] & 0xffff0000u), __uint_as_float(nvx[2 * e + 1] << 16), __uint_as_float(nvx[2 * e + 1] & 0xffff0000u)}; }
        if (it + gdim() < 128 * NCHK) SC1_LOAD(it + gdim());
        LBAR();
#pragma unroll
        for (int e = 0; e < 2; ++e) *(LAS f32x4*)(Lbuf + pt * 64 + cg * 8 + 4 * e) = lw[e];
        f32x4 kk[2], bq[2], kd[2];
        { float ss = 0.f;
#pragma unroll
          for (int e = 0; e < 2; ++e) { kk[e] = kx[e] * kkc[e]; ss += kk[e][0] * kk[e][0] + kk[e][1] * kk[e][1] + kk[e][2] * kk[e][2] + kk[e][3] * kk[e][3]; }
          ss = dpp_sum8(ss); const float inv = __builtin_amdgcn_rsqf(fmaxf(ss, 1e-24f));
#pragma unroll
          for (int e = 0; e < 2; ++e) { kk[e] = kk[e] * inv; bq[e] = kk[e] * ax[e]; kd[e] = kx[e] * (1.f + (ax[e] - 1.f) * kac[e]); } }
        LBAR();
        { const int k = tid & 63, sg = tid >> 6; float run = 0.f;
#pragma unroll
          for (int u = 0; u < 8; ++u) { run += Lbuf[(sg * 8 + u) * 64 + k]; Lbuf[(sg * 8 + u) * 64 + k] = run; }
          Lseg[sg * 64 + k] = run; }
        LBAR();
        f32x4 Lt[2], Lp[2], Lc[2];
        { const int sg = pt >> 3, sgp = (pt - 1) >> 3;
#pragma unroll
          for (int e = 0; e < 2; ++e) { f32x4 o0 = {0.f, 0.f, 0.f, 0.f}, o1 = o0, oc = o0;
#pragma unroll
              for (int u = 0; u < 8; ++u) { const f32x4 sv = *(const LAS f32x4*)(Lseg + u * 64 + cg * 8 + 4 * e); if (u < sg) o0 = o0 + sv; if (u < sgp) o1 = o1 + sv; if (u < 7) oc = oc + sv; }
              Lt[e] = *(const LAS f32x4*)(Lbuf + pt * 64 + cg * 8 + 4 * e) + o0;
              Lp[e] = pt > 0 ? *(const LAS f32x4*)(Lbuf + (pt - 1) * 64 + cg * 8 + 4 * e) + o1 : (f32x4){0.f, 0.f, 0.f, 0.f};
              Lc[e] = *(const LAS f32x4*)(Lbuf + 63 * 64 + cg * 8 + 4 * e) + oc; } }
        LBAR();
        {
            float at[8], bt[8], kt[8], rt[8], bh[8], kh[8], vv[8];
#pragma unroll
            for (int e = 0; e < 2; ++e)
#pragma unroll
                for (int u = 0; u < 4; ++u) { const int x = 4 * e + u; const float eL = __expf(Lt[e][u]), emL = __expf(-Lt[e][u]), eP = __expf(Lp[e][u]), eC = __expf(Lc[e][u] - Lt[e][u]);
                    at[x] = -kk[e][u] * eP; bt[x] = bq[e][u] * emL; kt[x] = kd[e][u] * emL; rt[x] = rx[e][u] * eL; bh[x] = bq[e][u] * eC; kh[x] = kd[e][u] * eC; vv[x] = vx[e][u];
                    if (pt == 63) GC[cg * 8 + x] = eL; }
#define ST8(bufi, arr) do { u32x4 w_ = {pk2(arr[0], arr[1]), pk2(arr[2], arr[3]), pk2(arr[4], arr[5]), pk2(arr[6], arr[7])}; *(LAS u32x4*)(BUF(bufi) + (pt * P + cg * 8) * 2) = w_; } while (0)
            ST8(0, at); ST8(1, bt); ST8(2, kt); ST8(3, rt); ST8(8, bh); ST8(9, kh); ST8(10, vv);
#undef ST8
        }
        LBAR();
        {
            const int k = tid & 63, tg = tid >> 6;
#define TR8(src, dst) do { unsigned w_[4]; _Pragma("unroll") for (int x = 0; x < 4; ++x) { const unsigned lo = *(const LAS bf16_t*)(BUF(src) + ((tg * 8 + 2 * x) * P + k) * 2), hi2 = *(const LAS bf16_t*)(BUF(src) + ((tg * 8 + 2 * x + 1) * P + k) * 2); w_[x] = lo | (hi2 << 16); } \
                *(LAS u32x4*)(BUF(dst) + (k * P + tg * 8) * 2) = (u32x4){w_[0], w_[1], w_[2], w_[3]}; } while (0)
            TR8(0, 4); TR8(8, 5); TR8(9, 6); TR8(10, 7);
#undef TR8
        }
        LBAR();
        const f32x4 Z4 = {0.f, 0.f, 0.f, 0.f};
        const f32x16 Z16 = {0.f, 0.f, 0.f, 0.f, 0.f, 0.f, 0.f, 0.f, 0.f, 0.f, 0.f, 0.f, 0.f, 0.f, 0.f, 0.f};
        const int r32 = lane & 31, hi = lane >> 5;
#pragma unroll 1
        for (int u = 0; u < 3; ++u) { const int tl = u * 8 + wid; if (tl >= 20) break; const int m = tl >> 2, ti = (tl >> 1) & 1, tj = tl & 1; const int jj = 32 * tj + r32;
            if (m == 0) { f32x16 v = mm32(BUF(0), BUF(1), ti, tj, r32, hi, Z16), w;
#pragma unroll
                for (int e = 0; e < 16; ++e) { const int ii = 32 * ti + 8 * (e >> 2) + 4 * hi + (e & 3); const bool dg = (ii >> 4) == (jj >> 4);
                    v[e] = (dg && jj < ii) ? v[e] : 0.f; w[e] = v[e] + ((ii == jj) ? 1.f : 0.f); }
                st32(BUF(8), ti, tj, r32, hi, v); st32(BUF(14), ti, tj, r32, hi, w); }
            else if (m == 1) { const f32x16 v = mm32(BUF(1), BUF(0), ti, tj, r32, hi, Z16); f32x16 vd, vo, w;
#pragma unroll
                for (int e = 0; e < 16; ++e) { const int ii = 32 * ti + 8 * (e >> 2) + 4 * hi + (e & 3); const bool dg = (ii >> 4) == (jj >> 4), up = ii < jj;
                    vd[e] = (dg && up) ? v[e] : 0.f; vo[e] = (!dg && up) ? v[e] : 0.f; w[e] = vd[e] + ((ii == jj) ? 1.f : 0.f); }
                st32(BUF(9), ti, tj, r32, hi, vd); st32(BUF(15), ti, tj, r32, hi, vo); st32(BUF(13), ti, tj, r32, hi, w); }
            else if (m == 2) { f32x16 v = mm32(BUF(2), BUF(0), ti, tj, r32, hi, Z16);
#pragma unroll
                for (int e = 0; e < 16; ++e) { const int ii = 32 * ti + 8 * (e >> 2) + 4 * hi + (e & 3); v[e] = ii < jj ? v[e] : 0.f; }
                st32(BUF(10), ti, tj, r32, hi, v); }
            else { f32x16 v = mm32(m == 3 ? BUF(1) : BUF(2), BUF(3), ti, tj, r32, hi, Z16);
#pragma unroll
                for (int e = 0; e < 16; ++e) { const int ii = 32 * ti + 8 * (e >> 2) + 4 * hi + (e & 3); v[e] = ii <= jj ? v[e] : 0.f; }
                st32(m == 3 ? BUF(11) : BUF(12), ti, tj, r32, hi, v); } }
        LBAR();
#define WSYNC() asm volatile("s_waitcnt lgkmcnt(0)" ::: "memory")
        if (wid < 4) {
            const int tt = wid;
#define SQD(sr, st, dr, dt) do { const f32x4 a_ = mm_diag(BUF(st), BUF(sr), tt, c, q, Z4), b_ = mm_diag(BUF(sr), BUF(st), tt, c, q, Z4); WSYNC(); \
                st_tile(BUF(dr), tt, tt, c, q, a_); st_tile(BUF(dt), tt, tt, c, q, b_); WSYNC(); } while (0)
#define UPD(pr) do { const f32x4 dt_ = mm_diag(BUF(pr), BUF(13), tt, c, q, ld_tile(BUF(13), tt, tt, c, q)); \
                const f32x4 dr_ = mm_diag(BUF(13), BUF(pr), tt, c, q, ld_tile(BUF(14), tt, tt, c, q)); WSYNC(); \
                st_tile(BUF(13), tt, tt, c, q, dt_); st_tile(BUF(14), tt, tt, c, q, dr_); WSYNC(); } while (0)
            SQD(8, 9, 0, 1); UPD(0); SQD(0, 1, 8, 9); UPD(8); SQD(8, 9, 0, 1); UPD(0);
#undef SQD
#undef UPD
        } else {
            const int ti = (wid >> 1) & 1, tj = wid & 1; st32(BUF(2), ti, tj, r32, hi, mm32(BUF(10), BUF(7), ti, tj, r32, hi, Z16));
        }
        LBAR();
        { const int m = wid >> 2, ti = (wid >> 1) & 1, tj = wid & 1;
          if (m == 0) st32(BUF(8), ti, tj, r32, hi, mm32(BUF(15), BUF(14), ti, tj, r32, hi, Z16));
          else        st32(BUF(9), ti, tj, r32, hi, mm32(BUF(14), BUF(15), ti, tj, r32, hi, Z16)); }
        LBAR();
        if (wid < 4) { const int ti = (wid >> 1) & 1, tj = wid & 1; st32(BUF(0), ti, tj, r32, hi, mm32(BUF(9), BUF(8), ti, tj, r32, hi, Z16)); }
        LBAR();
        if (wid < 4) { const int ti = (wid >> 1) & 1, tj = wid & 1; st32(BUF(1), ti, tj, r32, hi, mm32(BUF(0), BUF(13), ti, tj, r32, hi, ld32(BUF(13), ti, tj, r32, hi))); }
        LBAR();
        if (wid < 4) { const int ti = (wid >> 1) & 1, tj = wid & 1; st32(BUF(14), ti, tj, r32, hi, mm32(BUF(8), BUF(1), ti, tj, r32, hi, ld32(BUF(1), ti, tj, r32, hi))); }
        LBAR();
        { const int m = wid >> 2, ti = (wid >> 1) & 1, tj = wid & 1;
          if (m == 0) st32(BUF(8), ti, tj, r32, hi, mm32(BUF(14), BUF(4), ti, tj, r32, hi, Z16));
          else        st32(BUF(0), ti, tj, r32, hi, mm32(BUF(14), BUF(2), ti, tj, r32, hi, Z16)); }
        LBAR();
        bf16_t* ckp = CK + (size_t)it * 4 * 4096;
#pragma unroll 1
        for (int u = 0; u < 2; ++u) { const int tl = u * 8 + wid, m = tl >> 2, ti = (tl >> 1) & 1, tj = tl & 1;
            if (m == 0) { f32x16 v = mm32(BUF(8), BUF(5), ti, tj, r32, hi, Z16); const int jj = 32 * tj + r32; const float gc = GC[jj];
#pragma unroll
                for (int e = 0; e < 16; ++e) { const int ii = 32 * ti + 8 * (e >> 2) + 4 * hi + (e & 3); v[e] += (ii == jj) ? gc : 0.f; }
                st32(BUF(1), ti, tj, r32, hi, v); }
            else if (m == 1) st32(BUF(4), ti, tj, r32, hi, mm32(BUF(8), BUF(11), ti, tj, r32, hi, ld32(BUF(3), ti, tj, r32, hi)));
            else if (m == 2) st32(BUF(2), ti, tj, r32, hi, mm32(BUF(6), BUF(7), ti, tj, r32, hi, mm32(BUF(5), BUF(0), ti, tj, r32, hi, Z16)));
            else             st32(BUF(9), ti, tj, r32, hi, mm32(BUF(7), BUF(12), ti, tj, r32, hi, mm32(BUF(0), BUF(11), ti, tj, r32, hi, Z16))); }
        LBAR();
        { const int orow = tid >> 3, oc = (tid & 7) * 8;
          *(u32x4*)(ckp + orow * 64 + oc) = *(const LAS u32x4*)(BUF(1) + (orow * P + oc) * 2);
          *(u32x4*)(ckp + 4096 + orow * 64 + oc) = *(const LAS u32x4*)(BUF(2) + (orow * P + oc) * 2);
          *(u32x4*)(ckp + 2 * 4096 + orow * 64 + oc) = *(const LAS u32x4*)(BUF(4) + (orow * P + oc) * 2);
          *(u32x4*)(ckp + 3 * 4096 + orow * 64 + oc) = *(const LAS u32x4*)(BUF(9) + (orow * P + oc) * 2); }
    }
#undef BUF
#undef SC1_LOAD
}

__device__ void ph_rw_sc2(const Params& p, char* lds) {
    using namespace ck;
    const int tid = tidx(), wid = __builtin_amdgcn_readfirstlane(tid >> 6), lane = tid & 63, c = lane & 15, q = lane >> 4;
    const size_t PL = (size_t)NROW * D;
    const bf16_t* CK = (const bf16_t*)(p.ws + OFF_CK); bf16_t* Y = (bf16_t*)(p.ws + OFF_Y);
    lchar* GB = (lchar*)lds;
    lchar* RB = GB + 2 * MB;
    lchar* SB = GB + 4 * MB;
    constexpr int SBB = 32 * P * 2;
    for (int it = bidx(); it < 256; it += gdim()) {
        const int vh = it & 1, seq = it >> 1, z = seq & 1, h = (seq >> 1) & 15, b = seq >> 5;
        const bf16_t* ck0 = CK + (size_t)seq * NCHK * 4 * 4096;
        const int s_ti = wid & 3, s_tj = wid >> 2;
        const int y_ti = wid & 1, y_tj = wid >> 1;
        const int hoff = 4096 + (vh * 32 + 16 * s_tj + c) * 64 + 16 * s_ti + 4 * q, yoff = 3 * 4096 + (16 * y_tj + c) * 64 + vh * 32 + 16 * y_ti + 4 * q;
        struct PF { u32x4 g, r; uint2 h, y; };
#define PF_LOAD(X, k) do { const bf16_t* cc_ = ck0 + (size_t)(k) * 4 * 4096; X.h = *(const uint2*)(cc_ + hoff); X.y = *(const uint2*)(cc_ + yoff); X.g = *(const u32x4*)(cc_ + tid * 8); X.r = *(const u32x4*)(cc_ + 2 * 4096 + tid * 8); } while (0)
#define PF_STAGE(X, bufi) do { *(LAS u32x4*)(GB + (bufi) * MB + ((tid >> 3) * P + (tid & 7) * 8) * 2) = X.g; *(LAS u32x4*)(RB + (bufi) * MB + ((tid >> 3) * P + (tid & 7) * 8) * 2) = X.r; } while (0)
#define SC2_STEP(k, CUR, NXT) do { const uint2 hi_ = CUR.h, yi_ = CUR.y; const int cur = (k) & 1; \
            if ((k) + 4 < NCHK) PF_LOAD(CUR, (k) + 4); \
            const f32x4 hinit = {__uint_as_float(hi_.x << 16), __uint_as_float(hi_.x & 0xffff0000u), __uint_as_float(hi_.y << 16), __uint_as_float(hi_.y & 0xffff0000u)}; \
            const f32x4 yinit = {__uint_as_float(yi_.x << 16), __uint_as_float(yi_.x & 0xffff0000u), __uint_as_float(yi_.y << 16), __uint_as_float(yi_.y & 0xffff0000u)}; \
            const lchar* Sold = SB + cur * SBB; lchar* Snew = SB + (cur ^ 1) * SBB; \
            const f32x4 sn = mm_tile(GB + cur * MB, Sold, s_ti, s_tj, c, q, hinit);        \
            const f32x4 yv = mm_tile(Sold, RB + cur * MB, y_ti, y_tj, c, q, yinit);        \
            st_tile(Snew, s_ti, s_tj, c, q, sn); \
            { const int row = scan_row((k) * 64 + 16 * y_tj + c, b, z); stbf4(Y + z * PL + (size_t)row * D + h * 64 + vh * 32 + 16 * y_ti + 4 * q, yv); } \
            if ((k) + 1 < NCHK) PF_STAGE(NXT, cur ^ 1); \
            LBAR(); } while (0)
        PF s0, s1, s2, s3;
        PF_LOAD(s0, 0); PF_LOAD(s1, 1); PF_LOAD(s2, 2); PF_LOAD(s3, 3);
        LBAR();
        for (int i = tid; i < SBB / 4; i += NTHR) ((LAS unsigned*)SB)[i] = 0u;
        PF_STAGE(s0, 0);
        LBAR();
        for (int ch = 0; ch < NCHK; ch += 4) {
            SC2_STEP(ch, s0, s1); SC2_STEP(ch + 1, s1, s2); SC2_STEP(ch + 2, s2, s3); SC2_STEP(ch + 3, s3, s0);
        }
#undef PF_LOAD
#undef PF_STAGE
#undef SC2_STEP
    }
}
#undef LBAR

__device__ void ph_rw_out(const Params& p, int j, int nrows) {
    const int wid = tidx() >> 6, lane = tidx() & 63;
    const bf16_t* RKV = (const bf16_t*)(p.ws + OFF_RKV); const bf16_t* AV = (const bf16_t*)(p.ws + OFF_AV); const bf16_t* G = (const bf16_t*)(p.ws + OFF_G); const bf16_t* Y = (const bf16_t*)(p.ws + OFF_Y);
    bf16_t* OUT = (bf16_t*)(p.ws + OFF_H);
    const size_t PL = (size_t)NROW * D;
    const float* r_k = p.rw_r_k + j * D; const float* lg = p.rw_lnx_g + j * D; const float* lb = p.rw_lnx_b + j * D; const float* k_a = p.rw_k_a + j * D;
    uint2 nb[8][4];
#define OUT_LOAD(R) do { _Pragma("unroll") for (int i = 0; i < 4; ++i) { const size_t o_ = (size_t)(R) * D + lane * 4 + i * 256; \
        nb[0][i] = *(const uint2*)(Y + o_); nb[1][i] = *(const uint2*)(Y + PL + o_); nb[2][i] = *(const uint2*)(RKV + o_); nb[3][i] = *(const uint2*)(RKV + PL + o_); \
        nb[4][i] = *(const uint2*)(RKV + 2 * PL + o_); nb[5][i] = *(const uint2*)(AV + o_); nb[6][i] = *(const uint2*)(AV + PL + o_); nb[7][i] = *(const uint2*)(G + o_); } } while (0)
#define UNPK(w) ((f32x4){__uint_as_float((w).x << 16), __uint_as_float((w).x & 0xffff0000u), __uint_as_float((w).y << 16), __uint_as_float((w).y & 0xffff0000u)})
    int row = bidx() * 8 + wid;
    if (row < nrows) OUT_LOAD(row);
    for (; row < nrows; row += gdim() * 8) {
        uint2 cb[8][4];
#pragma unroll
        for (int q_ = 0; q_ < 8; ++q_)
#pragma unroll
            for (int i = 0; i < 4; ++i) cb[q_][i] = nb[q_][i];
        { const int nrow = row + gdim() * 8; if (nrow < nrows) OUT_LOAD(nrow); }
#pragma unroll
        for (int i = 0; i < 4; ++i) {
            const size_t o = (size_t)row * D + lane * 4 + i * 256; const int c = lane * 4 + i * 256;
            const f32x4 y = UNPK(cb[0][i]) + UNPK(cb[1][i]);
            const float mean = dpp_sum16(y[0] + y[1] + y[2] + y[3]) * (1.f / 64.f);
            const f32x4 dd = y - mean;
            const float rstd = rsqrtf(dpp_sum16(dd[0] * dd[0] + dd[1] * dd[1] + dd[2] * dd[2] + dd[3] * dd[3]) * (1.f / 64.f) + LNX_EPS);
            const f32x4 r = UNPK(cb[2][i]), k = UNPK(cb[3][i]), v = UNPK(cb[4][i]);
            const f32x4 a0 = UNPK(cb[5][i]), a1 = UNPK(cb[6][i]);
            const f32x4 kds = k * (2.f + (a0 + a1 - 2.f) * *(const f32x4*)(k_a + c));
            const f32x4 t4 = r * kds * *(const f32x4*)(r_k + c);
            const float bs = dpp_sum16(t4[0] + t4[1] + t4[2] + t4[3]);
            const f32x4 res = (dd * rstd * *(const f32x4*)(lg + c) + *(const f32x4*)(lb + c) + bs * v) * UNPK(cb[7][i]);
            uint2 w; w.x = pk2(res[0], res[1]); w.y = pk2(res[2], res[3]); *(uint2*)(OUT + o) = w;
        }
    }
#undef OUT_LOAD
#undef UNPK
}

__device__ void ph_final(const Params& p) {
    const int wid = tidx() >> 6, lane = tidx() & 63;
    const float* X = (const float*)(p.ws + OFF_X);
    for (int row = bidx() * 8 + wid; row < NLAT; row += gdim() * 8) {
        const float4* xr = (const float4*)(X + (size_t)row * D);
        float4 v[4]; float ss = 0;
#pragma unroll
        for (int i = 0; i < 4; ++i) { v[i] = xr[lane + i * 64]; ss += v[i].x * v[i].x + v[i].y * v[i].y + v[i].z * v[i].z + v[i].w * v[i].w; }
        ss = wave_sum(ss); const float rs = rsqrtf(ss * (1.f / D) + RMS_EPS);
#pragma unroll
        for (int i = 0; i < 4; ++i) { const int d = (lane + i * 64) * 4; const float4 gg = *(const float4*)(p.final_g + d);
            float4 o; o.x = v[i].x * rs * gg.x; o.y = v[i].y * rs * gg.y; o.z = v[i].z * rs * gg.z; o.w = v[i].w * rs * gg.w;
            *(float4*)(p.out + (size_t)row * D + d) = o; }
    }
}

enum { PH_INIT = 0, PH_A_NORM, PH_A_Z, PH_A_MID, PH_A_QKV, PH_A_POST, PH_A_ATTN, PH_A_WO,
       PH_R_NORM, PH_R_XS, PH_R_G1, PH_R_G2, PH_R_PREP, PH_R_SCAN, PH_R_OUT, PH_R_WO,
       PH_M_NORM, PH_M_SEL, PH_M_GATHER, PH_M_G1, PH_M_G2, PH_M_COMB, PH_FINAL, PH_M_CVT, PH_R_SC1, PH_R_SC2 };

template <int PH>
__device__ __forceinline__ void run_phase(const Params& p, int layer, char* lds) {
    const int j = layer >> 1;
    char* ws = p.ws;
    if constexpr (PH == PH_INIT) { ph_init(p, lds); __syncthreads(); ph_small_cvt(p, lds); }
    else if constexpr (PH == PH_A_NORM) { if (layer == 0) ph_norm_mod<false>(p, layer, p.norm1_g + layer * D, 0, 1, ws + OFF_H); else ph_comb_norm<false>(p, layer - 1, layer, NROW); }
    else if constexpr (PH == PH_A_Z) {
        float* Z = (float*)(ws + OFF_Z);
        g8::BatchSched S{ws + OFF_H, ws + OFF_WMLA + j * SZ_WMLA + WM_IN, 0, 0, NROW / 256, 2, 1, D};
        g8::gemm_phase(p.wv, (PG8_LAS unsigned char*)lds, D, S, g8::epi_rc([=](const g8::Unit&, int row, int col, f32x4 v) { *(f32x4*)(Z + (size_t)row * 512 + col) = v; }));
    }
    else if constexpr (PH == PH_A_MID) ph_mla_mid(p, j);
    else if constexpr (PH == PH_A_QKV) {
        bf16_t* Q = (bf16_t*)(ws + OFF_Q); bf16_t* K = (bf16_t*)(ws + OFF_K); bf16_t* V = (bf16_t*)(ws + OFF_V);
        g8::BatchSched S1{ws + OFF_CQN, ws + OFF_WMLA + j * SZ_WMLA + WM_UQ, 0, 0, NROW / 256, 6, 1, 256};
        g8::gemm_phase(p.wv, (PG8_LAS unsigned char*)lds, 256, S1, g8::epi_rc([=](const g8::Unit&, int row, int col, f32x4 v) {
            const bool lat = row < NLAT; const int b = lat ? (row >> 12) : ((row - NLAT) >> 8); const int tk = lat ? 256 + (row & (TL - 1)) : ((row - NLAT) & 255);
            const int h = col / 192, d = col - h * 192;
            uint2 w; w.x = pk2(v[0], v[1]); w.y = pk2(v[2], v[3]);
            *(uint2*)(Q + ((size_t)(b * 8 + h) * TK + tk) * 192 + d) = w; }));
        g8::BatchSched S2{ws + OFF_CKVN, ws + OFF_WMLA + j * SZ_WMLA + WM_UKV, 0, 0, NROW / 256, 8, 1, 128};
        g8::gemm_phase(p.wv, (PG8_LAS unsigned char*)lds, 128, S2, g8::epi_rc([=](const g8::Unit&, int row, int col, f32x4 v) {
            const bool lat = row < NLAT; const int b = lat ? (row >> 12) : ((row - NLAT) >> 8); const int tk = lat ? 256 + (row & (TL - 1)) : ((row - NLAT) & 255);
            const int h = col >> 8, d = col & 255; const size_t orow = (size_t)(b * 8 + h) * TK + tk;
            uint2 w; w.x = pk2(v[0], v[1]); w.y = pk2(v[2], v[3]);
            if (d < 128) *(uint2*)(K + orow * 192 + d) = w; else *(uint2*)(V + orow * 128 + (d - 128)) = w; }));
    }
    else if constexpr (PH == PH_A_ATTN) ph_attn(p, lds);
    else if constexpr (PH == PH_A_WO || PH == PH_R_WO) {
        xt_t* X = (xt_t*)(ws + OFF_X); const float* MOD = (const float*)(ws + OFF_MOD);
        g8::BatchSched S{ws + (PH == PH_A_WO ? OFF_O : OFF_H), PH == PH_A_WO ? ws + OFF_WMLA + j * SZ_WMLA + WM_O : ws + OFF_WRW + j * SZ_WRW + WR_O, 0, 0, (layer < 3 ? NROW : NLAT) / 256, 4, 1, D};
        g8::gemm_phase(p.wv, (PG8_LAS unsigned char*)lds, D, S, g8::EpiResid{X, MOD, layer});
    }
    else if constexpr (PH == PH_R_XS) ph_rw_normxs(p, layer, j);
    else if constexpr (PH == PH_R_G1) {
        bf16_t* RKV = (bf16_t*)(ws + OFF_RKV); bf16_t* VF = (bf16_t*)(ws + OFF_VFIRST);
        bf16_t* A2 = (bf16_t*)(ws + OFF_A2); bf16_t* A3 = (bf16_t*)(ws + OFF_A3);
        const bool first = (j == 0);
        struct RSched { const char* XS; const char* WB; int nwg;
            __device__ __forceinline__ bool next(int i, g8::Unit& u) const {
                const int L = i * gdim() + bidx(); if (L >= nwg) return false;
                const int w = g8::xcd_remap(L, nwg);
                if (w < 816) { u.g = w / 272; const int r = w % 272; u.pm = r >> 2; u.pn = r & 3; u.B = WB + WR_RKV + (size_t)u.g * D * D * 2 + (size_t)u.pn * 256 * D * 2; }
                else { u.g = 3 + (w - 816) / 68; u.pm = (w - 816) % 68; u.pn = 0; u.B = WB + WR_L + (size_t)(u.g - 3) * 256 * D * 2; }
                u.A = XS + (size_t)(u.g == 6 ? 2 : u.g) * NROW * D * 2 + (size_t)u.pm * 256 * D * 2; return true; } };
        RSched S{ws + OFF_XS, ws + OFF_WRW + j * SZ_WRW, first ? 816 + 204 : 816 + 272};
        g8::gemm_phase(p.wv, (PG8_LAS unsigned char*)lds, D, S, g8::epi_rc([=](const g8::Unit& u, int row, int col, f32x4 v) {
            if (u.g < 3) { stbf4(RKV + ((size_t)u.g * NROW + row) * D + col, v); if (first && u.g == 2) stbf4(VF + (size_t)row * D + col, v); }
            else if (col < 128) {
                f32x4 t = v;
                if (u.g == 3) { for (int e = 0; e < 4; ++e) t[e] = 1.f - 2.f * __builtin_amdgcn_rcpf(1.f + __expf(2.f * v[e])); }
                else if (u.g == 5) { for (int e = 0; e < 4; ++e) t[e] = sigmoidf_(v[e]); }
                bf16_t* dst = (u.g == 3 ? A2 : u.g == 4 ? A2 + (size_t)NROW * 128 : u.g == 5 ? A3 : A3 + (size_t)NROW * 128);
                stbf4(dst + (size_t)row * 128 + col, t); } }));
    }
    else if constexpr (PH == PH_R_G2) {
        const bool first = (j == 0);
        float* W = (float*)(ws + OFF_W); bf16_t* AV = (bf16_t*)(ws + OFF_AV); bf16_t* G = (bf16_t*)(ws + OFF_G); bf16_t* RKV = (bf16_t*)(ws + OFF_RKV); const bf16_t* VF = (const bf16_t*)(ws + OFF_VFIRST);
        const float* w0 = p.rw_w0 + (size_t)j * 2 * D; const float* a0 = p.rw_a0 + (size_t)j * 2 * D; const float* v0 = p.rw_v0;
        g8::BatchSched S1{ws + OFF_A2, ws + OFF_WRW + j * SZ_WRW + WR_B2, (size_t)NROW * 128 * 2, (size_t)2048 * 128 * 2, NROW / 256, 8, 2, 128};
        g8::gemm_phase(p.wv, (PG8_LAS unsigned char*)lds, 128, S1, g8::epi_colfirst([=](const g8::Unit& u, int row, int col, f32x4 v, f32x4 bias) {
            const int zz = u.pn >> 2, c = col & 1023; const bool dec = u.g == 0;
            const size_t doff = (size_t)zz * NROW * D + (size_t)row * D + c;
            const f32x4 x = v + bias; f32x4 o;
#pragma unroll
            for (int e = 0; e < 4; ++e) { const float sg = __builtin_amdgcn_rcpf(1.f + __expf(-x[e])); o[e] = dec ? (-0.6065306597126334f * sg) : sg; }
            if (dec) *(f32x4*)(W + doff) = o; else stbf4(AV + doff, o); },
            [=](const g8::Unit& u, int col) { const int zz = u.pn >> 2, c = col & 1023; return *(const f32x4*)((u.g == 0 ? w0 : a0) + zz * D + c); }));
        g8::BatchSched S2{ws + OFF_A3, ws + OFF_WRW + j * SZ_WRW + WR_B3, (size_t)NROW * 128 * 2, (size_t)1024 * 128 * 2, NROW / 256, 4, first ? 1 : 2, 128};
        g8::gemm_phase(p.wv, (PG8_LAS unsigned char*)lds, 128, S2, g8::epi_rc([=](const g8::Unit& u, int row, int col, f32x4 v) {
            if (u.g == 0) stbf4(G + (size_t)row * D + col, v);
            else { const size_t o = (size_t)row * D + col; const f32x4 vv = ldbf4(RKV + (size_t)2 * NROW * D + o), vf = ldbf4(VF + o), gz = v + *(const f32x4*)(v0 + col); f32x4 r;
#pragma unroll
                for (int e = 0; e < 4; ++e) r[e] = vv[e] + (vf[e] - vv[e]) * __builtin_amdgcn_rcpf(1.f + __expf(-gz[e]));
                stbf4(RKV + (size_t)2 * NROW * D + o, r); } }));
    }
    else if constexpr (PH == PH_R_SCAN) ph_rw_scan(p, j, lds);
    else if constexpr (PH == PH_R_SC1) ph_rw_sc1(p, j, lds);
    else if constexpr (PH == PH_R_SC2) ph_rw_sc2(p, lds);
    else if constexpr (PH == PH_R_OUT) ph_rw_out(p, j, layer < 3 ? NROW : NLAT);
    else if constexpr (PH == PH_M_NORM) ph_norm2_router(p, layer, lds, layer < 3 ? NROW : NLAT);
    else if constexpr (PH == PH_M_SEL) { ph_select(p, lds, layer < 3 ? 128 : 64); __syncthreads(); ph_moe_cvt(p, layer, lds); }
    else if constexpr (PH == PH_M_GATHER) ph_gather(p, layer < 3 ? ESLOTS : NB * CAPL);
    else if constexpr (PH == PH_M_G1) {
        bf16_t* HID = (bf16_t*)(ws + OFF_HID);
        g8::BatchSched S{ws + OFF_XE, ws + OFF_W13T, (size_t)EPAD * D * 2, (size_t)2816 * D * 2, layer < 3 ? 9 : 8, 11, NE, D};
        g8::gemm_phase(p.wv, (PG8_LAS unsigned char*)lds, D, S, g8::epi_pair([=](const g8::Unit& u, int row, int col, f32x4 a, f32x4 b) {
            uint2 w; w.x = pk2(a[0] * __builtin_amdgcn_rcpf(1.f + __expf(-a[0])) * b[0], a[1] * __builtin_amdgcn_rcpf(1.f + __expf(-a[1])) * b[1]); w.y = pk2(a[2] * __builtin_amdgcn_rcpf(1.f + __expf(-a[2])) * b[2], a[3] * __builtin_amdgcn_rcpf(1.f + __expf(-a[3])) * b[3]);
            *(uint2*)(HID + ((size_t)u.g * EPAD + row) * FF + col) = w; }));
    }
    else if constexpr (PH == PH_M_G2) {
        bf16_t* YE = (bf16_t*)(ws + OFF_YE); const float* GATE = (const float*)(ws + OFF_GATE);
        g8::BatchSched S{ws + OFF_HID, ws + OFF_W2T, (size_t)EPAD * FF * 2, (size_t)D * FF * 2, layer < 3 ? 9 : 8, 4, NE, FF};
        g8::gemm_phase(p.wv, (PG8_LAS unsigned char*)lds, FF, S, g8::epi_pre([=](const g8::Unit& u, int row, int col, f32x4 v, f32x4, float gt) {
            uint2 w; w.x = pk2(v[0] * gt, v[1] * gt); w.y = pk2(v[2] * gt, v[3] * gt);
            *(uint2*)(YE + ((size_t)u.g * EPAD + row) * D + col) = w; },
            [=](const g8::Unit&, int) { return (f32x4){0.f, 0.f, 0.f, 0.f}; }, [=](const g8::Unit& u, int row) { return GATE[u.g * EPAD + row]; }));
    }
    else if constexpr (PH == PH_M_COMB) ph_combine(p, layer, layer < 3 ? NROW : NLAT);
    else if constexpr (PH == PH_M_CVT) ph_moe_cvt(p, layer, lds);
    else if constexpr (PH == PH_FINAL) ph_comb_norm<true>(p, 3, 0, NLAT);
}

#if ONE_LAUNCH
#define SYNC() xcd_barrier(bar)
#ifndef PROBE_PH
#define PROBE_PH -1
#endif
#ifndef PROBE_REP
#define PROBE_REP 1
#endif
__device__ __forceinline__ Params load_params() {
    Params q{};
#if defined(__HIP_DEVICE_COMPILE__)
    typedef const __attribute__((address_space(4))) unsigned long long* KargP;
    KargP kp_ = (KargP)__builtin_amdgcn_kernarg_segment_ptr(); asm volatile("" : "+s"(kp_));
#pragma unroll
    for (int i = 0; i < 40; ++i) ((const float**)&q)[i] = (const float*)(const __attribute__((address_space(1))) float*)kp_[i];
#endif
    return q;
}
#define RUN(PH) do { for (int rep_ = 0; rep_ < ((PH) == PROBE_PH ? PROBE_REP : 1); ++rep_) { Params q = load_params(); q.wv = wv0_; run_phase<PH>(q, layer, smem); SYNC(); } } while (0)
__global__ void __launch_bounds__(NTHR, 2) mega(Params p) {
    extern __shared__ __attribute__((aligned(16))) char smem[];
    const int wv0_ = __builtin_amdgcn_readfirstlane((int)threadIdx.x >> 6);
    if (threadIdx.x == 0) *(uint4*)(smem + LDS_BYTES) = make_uint4(0u, 0u, 0u, 0u);
    __syncthreads();
    XcdBarrier bar = xcd_barrier_post((unsigned*)(p.ws + OFF_BAR), (volatile LAS unsigned*)(smem + LDS_BYTES));
    { const int layer = 0; RUN(PH_INIT); }
    for (int layer = 0; layer < 4; ++layer) {
        if ((layer & 1) == 0) {
            RUN(PH_A_NORM);
            RUN(PH_A_Z);
            RUN(PH_A_MID);
            RUN(PH_A_QKV);
            RUN(PH_A_ATTN);
            RUN(PH_A_WO);
        } else {
            RUN(PH_R_XS);
            RUN(PH_R_G1);
            RUN(PH_R_G2);
            RUN(PH_R_SC1);
            RUN(PH_R_SC2);
            RUN(PH_R_OUT);
            RUN(PH_R_WO);
        }
        RUN(PH_M_NORM);
        RUN(PH_M_SEL);
        RUN(PH_M_G1);
        RUN(PH_M_G2);
        if ((layer & 1) == 0) RUN(PH_M_COMB);
    }
    { Params q = load_params(); q.wv = wv0_; run_phase<PH_FINAL>(q, 0, smem); }
}
#else
template <int PH> __global__ void __launch_bounds__(NTHR, 2) kph(Params p, int layer) {
    extern __shared__ __attribute__((aligned(16))) char smem[];
    Params q = p; q.wv = __builtin_amdgcn_readfirstlane((int)threadIdx.x >> 6);
    run_phase<PH>(q, layer, smem);
}
#endif

extern "C" void kernel_launch(void* const* d_in, const int* in_sizes, int n_in, void* d_out, int out_size, void* d_ws, size_t ws_size, hipStream_t stream) {
    if (n_in != 38 || ws_size < WS_NEED) { fprintf(stderr, "kernel_launch: bad args n_in %d ws %zu need %zu\n", n_in, ws_size, (size_t)WS_NEED); return; }
    Params p{};
    const float** pp = (const float**)&p;
    for (int i = 0; i < 38; ++i) pp[i] = (const float*)d_in[i];
    p.out = (float*)d_out; p.ws = (char*)d_ws;
    static int cus = 0;
    if (!cus) { int dev = 0; hipGetDevice(&dev); hipDeviceGetAttribute(&cus, hipDeviceAttributeMultiprocessorCount, dev); if (cus <= 0) cus = 256; }
    const int grid = cus;
#if ONE_LAUNCH
    hipFuncSetAttribute((const void*)mega, hipFuncAttributeMaxDynamicSharedMemorySize, LDS_BYTES + 16);
    hipMemsetAsync(d_ws, 0, 16384, stream);
    hipLaunchKernelGGL(mega, dim3(grid), dim3(NTHR), LDS_BYTES + 16, stream, p);
#else
    hipMemsetAsync(d_ws, 0, 16384, stream);
#define LAUNCH(PH, L) do { hipFuncSetAttribute((const void*)kph<PH>, hipFuncAttributeMaxDynamicSharedMemorySize, LDS_BYTES + 16); hipLaunchKernelGGL(kph<PH>, dim3(grid), dim3(NTHR), LDS_BYTES + 16, stream, p, L); } while (0)
    LAUNCH(PH_INIT, 0);
    for (int layer = 0; layer < 4; ++layer) {
        if ((layer & 1) == 0) { LAUNCH(PH_A_NORM, layer); LAUNCH(PH_A_Z, layer); LAUNCH(PH_A_MID, layer); LAUNCH(PH_A_QKV, layer); LAUNCH(PH_A_ATTN, layer); LAUNCH(PH_A_WO, layer); }
        else { LAUNCH(PH_R_XS, layer); LAUNCH(PH_R_G1, layer); LAUNCH(PH_R_G2, layer); LAUNCH(PH_R_SC1, layer); LAUNCH(PH_R_SC2, layer); LAUNCH(PH_R_OUT, layer); LAUNCH(PH_R_WO, layer); }
        LAUNCH(PH_M_NORM, layer); LAUNCH(PH_M_SEL, layer); LAUNCH(PH_M_G1, layer); LAUNCH(PH_M_G2, layer); if ((layer & 1) == 0) LAUNCH(PH_M_COMB, layer);
    }
    LAUNCH(PH_FINAL, 0);
#endif
}
```

```cpp
#include <hip/hip_runtime.h>
#include <stdint.h>
#include <stdio.h>

#ifndef ONE_LAUNCH
#define ONE_LAUNCH 1
#endif

#define NTHR 512
typedef unsigned short bf16_t;
typedef short bf16x8 __attribute__((ext_vector_type(8)));
typedef float f32x4 __attribute__((ext_vector_type(4)));
typedef unsigned u32x4 __attribute__((ext_vector_type(4)));
typedef unsigned u32x2 __attribute__((ext_vector_type(2)));

constexpr int D = 1024, NB = 4, TL = 4096, TC = 256, NLAT = NB * TL, NCTX = NB * TC, NROW = NLAT + NCTX;
constexpr int TK = TL + TC;
constexpr int NE = 16, FF = 1408, CAPL = 512, CAPC = 32, ESLOTS = NB * CAPL + NB * CAPC;
constexpr int EPAD = 2304;
constexpr float RMS_EPS = 1e-6f, LNX_EPS = 64e-5f;
constexpr float ATT_SCALE = 0.07216878364870322f;

constexpr size_t al256(size_t x) { return (x + 255) / 256 * 256; }
constexpr size_t OFF_BAR = 0;
constexpr size_t OFF_QUEUE = 14336;
constexpr size_t OFF_MOD = 16384;
constexpr size_t OFF_ROPE_C = OFF_MOD + al256(4 * 5 * 6144 * 4);
constexpr size_t OFF_ROPE_S = OFF_ROPE_C + al256(TL * 32 * 4);
constexpr size_t OFF_X = OFF_ROPE_S + al256(TL * 32 * 4);
constexpr size_t SZ_F32 = (size_t)NROW * D * 4, SZ_BF = (size_t)NROW * D * 2;
constexpr size_t OFF_VFIRST = OFF_X + SZ_BF;
constexpr size_t OFF_H = OFF_VFIRST + SZ_BF;
constexpr size_t SZ_WMLA = (size_t)(512 * 1024 + 1536 * 256 + 2048 * 256 + 1024 * 1024) * 2;
constexpr size_t WM_IN = 0, WM_UQ = (size_t)512 * 1024 * 2, WM_UKV = WM_UQ + (size_t)1536 * 256 * 2, WM_O = WM_UKV + (size_t)2048 * 256 * 2;
constexpr size_t SZ_WRW = (size_t)(3 * 1024 * 1024 + 4 * 256 * 1024 + 1024 * 1024 + 4096 * 256 + 2048 * 256) * 2;
constexpr size_t WR_RKV = 0, WR_L = (size_t)3 * 1024 * 1024 * 2, WR_O = WR_L + (size_t)4 * 256 * 1024 * 2, WR_B2 = WR_O + (size_t)1024 * 1024 * 2, WR_B3 = WR_B2 + (size_t)4096 * 256 * 2;
constexpr size_t OFF_WMLA = OFF_H + SZ_BF;
constexpr size_t OFF_WRW = OFF_WMLA + 2 * SZ_WMLA;
constexpr size_t OFF_W13T = OFF_WRW + 2 * SZ_WRW;
constexpr size_t OFF_W2T = OFF_W13T + (size_t)NE * 2816 * D * 2;
constexpr size_t SZ_WMOE = (size_t)NE * 2816 * D * 2 + (size_t)NE * D * FF * 2;
constexpr size_t OFF_S = OFF_W13T + 2 * SZ_WMOE;
constexpr size_t OFF_Z = OFF_S;
constexpr size_t OFF_CQN = OFF_Z + al256((size_t)NROW * 512 * 4);
constexpr size_t OFF_CKVN = OFF_CQN + al256((size_t)NROW * 256 * 2);
constexpr size_t OFF_KR = OFF_CKVN + al256((size_t)NROW * 256 * 2);
constexpr size_t OFF_QRAW = OFF_KR + al256((size_t)NROW * 64 * 4);
constexpr size_t OFF_KVRAW = OFF_QRAW + al256((size_t)NROW * 1536 * 4);
constexpr size_t OFF_Q = OFF_KVRAW + al256((size_t)NROW * 2048 * 4);
constexpr size_t OFF_K = OFF_Q + al256((size_t)NB * 8 * TK * 192 * 2);
constexpr size_t OFF_V = OFF_K + al256((size_t)NB * 8 * TK * 192 * 2);
constexpr size_t OFF_O = OFF_V + al256((size_t)NB * 8 * TK * 128 * 2);
constexpr size_t END_MLA = OFF_O + SZ_BF;
constexpr size_t OFF_XS = OFF_S;
constexpr size_t OFF_RKV = OFF_XS + 6 * SZ_BF;
constexpr size_t OFF_W = OFF_RKV + 3 * SZ_BF;
constexpr size_t OFF_AV = OFF_W + 2 * SZ_F32;
constexpr size_t OFF_G = OFF_AV + 2 * SZ_BF;
constexpr size_t OFF_A2 = OFF_G + SZ_BF;
constexpr size_t OFF_A3 = OFF_A2 + al256((size_t)NROW * 256 * 2);
constexpr size_t END_RW = OFF_A3 + al256((size_t)NROW * 256 * 2);
constexpr size_t OFF_Y = OFF_XS;
constexpr int NCHK = (TC + TL) / 64;
constexpr size_t OFF_CK = END_RW;
constexpr size_t END_RW2 = OFF_CK + (size_t)128 * NCHK * 4 * 4096 * 2;
constexpr size_t OFF_AFF = OFF_S;
constexpr size_t OFF_ROWIDX = OFF_AFF + al256((size_t)NROW * 16 * 4);
constexpr size_t OFF_GATE = OFF_ROWIDX + al256((size_t)NE * ESLOTS * 4);
constexpr size_t OFF_SLOT = OFF_GATE + al256((size_t)NE * EPAD * 4);
constexpr size_t OFF_XE = OFF_SLOT + al256((size_t)NROW * 16 * 4);
constexpr size_t OFF_HID = OFF_XE + al256((size_t)NE * EPAD * D * 2);
constexpr size_t OFF_YE = OFF_HID + al256((size_t)NE * EPAD * FF * 2);
constexpr size_t END_MOE = OFF_YE + al256((size_t)NE * EPAD * D * 2);
constexpr size_t WS_NEED = END_RW2 > END_MLA ? (END_RW2 > END_MOE ? END_RW2 : END_MOE) : (END_MLA > END_MOE ? END_MLA : END_MOE);

constexpr int LDS_BYTES = 152064;

struct Params {
    const float *x, *c, *ctx, *c_ctx, *mod_w, *mod_b, *norm1_g, *norm2_g, *final_g;
    const float *mla_w_in, *mla_g_q, *mla_g_kv, *mla_w_uq, *mla_w_ukv, *mla_w_o;
    const float *rw_mu, *rw_w_rkv, *rw_w0, *rw_w1, *rw_w2, *rw_a0, *rw_a1, *rw_a2, *rw_v0, *rw_v1, *rw_v2, *rw_g1, *rw_g2, *rw_k_k, *rw_k_a, *rw_r_k, *rw_lnx_g, *rw_lnx_b, *rw_w_o;
    const float *moe_router, *moe_w1, *moe_w3, *moe_w2;
    float* out; char* ws;
    int wv, pad_;
};

__device__ __forceinline__ int bidx() { int t = blockIdx.x; asm volatile("" : "+s"(t)); return t; }
__device__ __forceinline__ int gdim() { int t = gridDim.x; asm volatile("" : "+s"(t)); return t; }
__device__ __forceinline__ int tidx_w(int wv) { int l; asm volatile("v_mbcnt_lo_u32_b32 %0, -1, 0\n\tv_mbcnt_hi_u32_b32 %0, -1, %0" : "=v"(l)); return (wv << 6) | l; }
#define tidx() tidx_w(p.wv)
#define XB_TMO      128
#define XB_XCNT(j)  (256  + 64 * (j))
#define XB_XSUB(j)  (1280 + 64 * (j))
#define XB_XGEN(j)  (2304 + 64 * (j))
#define XB_TOP      3328
#define XB_TOPGEN   3392
#define XCD_BAR_WORDS 3456
#define XB_SPIN_CAP (1u << 22)
#define LAS __attribute__((address_space(3)))

__device__ __forceinline__ unsigned xb_ld(unsigned* p)              { return __hip_atomic_load(p, __ATOMIC_RELAXED, __HIP_MEMORY_SCOPE_AGENT); }
__device__ __forceinline__ unsigned xb_add(unsigned* p, unsigned v) { return __hip_atomic_fetch_add(p, v, __ATOMIC_RELAXED, __HIP_MEMORY_SCOPE_AGENT); }
__device__ __forceinline__ unsigned xb_xcc_id() { return (unsigned)__builtin_amdgcn_s_getreg((3 << 11) | 20) & 0xFu; }
#define XB_SPIN(cond, bar) do { unsigned _sp = 0; while (cond) { __builtin_amdgcn_s_sleep(1); \
    if ((++_sp & 255u) == 0u) { if (xb_ld(&(bar)[XB_TMO])) break; if (_sp > XB_SPIN_CAP) { atomicAdd(&(bar)[XB_TMO], 1u); break; } } } } while (0)

struct XcdBarrier { unsigned* bar; unsigned x; volatile LAS unsigned* st; };

__device__ __forceinline__ XcdBarrier xcd_barrier_post(unsigned* bar, volatile LAS unsigned* st) {
    XcdBarrier b; b.bar = bar; b.x = xb_xcc_id(); b.st = st;
    if (threadIdx.x == 0) (void)xb_add(&bar[XB_XCNT(b.x)], 1u);
    return b;
}
__device__ __forceinline__ void xcd_barrier_complete(unsigned* bar, unsigned x, unsigned& nloc, unsigned& nx) {
    const unsigned G = gridDim.x * gridDim.y * gridDim.z;
    unsigned sum, cnt, mine, sp = 0u;
    for (;;) {
        sum = 0u; cnt = 0u; mine = 0u;
#pragma unroll
        for (unsigned j = 0; j < 16; ++j) { const unsigned c = xb_ld(&bar[XB_XCNT(j)]); sum += c; cnt += (c > 0u) ? 1u : 0u; mine = (j == x) ? c : mine; }
        if (sum == G) break;
        __builtin_amdgcn_s_sleep(1);
        if ((++sp & 255u) == 0u) { if (xb_ld(&bar[XB_TMO])) break; if (sp > XB_SPIN_CAP) { atomicAdd(&bar[XB_TMO], 1u); break; } }
    }
    nloc = mine > 0u ? mine : 1u; nx = cnt > 0u ? cnt : 1u;
}
__device__ __forceinline__ void xcd_barrier(const XcdBarrier& b) {
    asm volatile("s_waitcnt vmcnt(0)" ::: "memory");
    __syncthreads();
    if (threadIdx.x == 0) {
        unsigned* bar = b.bar;
        __builtin_amdgcn_s_waitcnt(0);
        unsigned nloc = b.st[0], nx = b.st[1];
        if (nloc == 0u) { xcd_barrier_complete(bar, b.x, nloc, nx); b.st[0] = nloc; b.st[1] = nx; }
        const unsigned old = xb_add(&bar[XB_XSUB(b.x)], 1u);
        const unsigned gen = old / nloc;
        if (old + 1u == (gen + 1u) * nloc) {
            __builtin_amdgcn_fence(__ATOMIC_RELEASE, "agent");
            asm volatile("s_waitcnt vmcnt(0)" ::: "memory");
            const unsigned og = xb_add(&bar[XB_TOP], 1u);
            const unsigned tg = og / nx;
            if (og + 1u == (tg + 1u) * nx) xb_add(&bar[XB_TOPGEN], 1u);
            else XB_SPIN(xb_ld(&bar[XB_TOPGEN]) == tg, bar);
            __builtin_amdgcn_fence(__ATOMIC_ACQUIRE, "agent");
            xb_add(&bar[XB_XGEN(b.x)], 1u);
            asm volatile("s_waitcnt vmcnt(0)" ::: "memory");
        } else {
            XB_SPIN(xb_ld(&bar[XB_XGEN(b.x)]) == gen, bar);
            __builtin_amdgcn_fence(__ATOMIC_ACQUIRE, "agent");
            asm volatile("s_waitcnt vmcnt(0)" ::: "memory");
        }
    }
    __syncthreads();
}

__device__ __forceinline__ float bf2f(bf16_t b) { return __uint_as_float(((unsigned)b) << 16); }
typedef float f32x2_ __attribute__((ext_vector_type(2)));
typedef __bf16 bf16x2_ __attribute__((ext_vector_type(2)));
__device__ __forceinline__ unsigned pk2(float lo, float hi) { const f32x2_ v = {lo, hi}; return __builtin_bit_cast(unsigned, __builtin_convertvector(v, bf16x2_)); }
__device__ __forceinline__ bf16_t f2bf(float f) { return (bf16_t)(pk2(f, f) & 0xffffu); }
__device__ __forceinline__ float dpp_sum16(float x) {
    x += __builtin_bit_cast(float, __builtin_amdgcn_update_dpp(0, __builtin_bit_cast(int, x), 0xB1, 0xF, 0xF, true));
    x += __builtin_bit_cast(float, __builtin_amdgcn_update_dpp(0, __builtin_bit_cast(int, x), 0x4E, 0xF, 0xF, true));
    x += __builtin_bit_cast(float, __builtin_amdgcn_update_dpp(0, __builtin_bit_cast(int, x), 0x141, 0xF, 0xF, true));
    x += __builtin_bit_cast(float, __builtin_amdgcn_update_dpp(0, __builtin_bit_cast(int, x), 0x140, 0xF, 0xF, true));
    return x;
}
__device__ __forceinline__ f32x4 ldbf4(const bf16_t* p) { const uint2 w = *(const uint2*)p; return (f32x4){__uint_as_float(w.x << 16), __uint_as_float(w.x & 0xffff0000u), __uint_as_float(w.y << 16), __uint_as_float(w.y & 0xffff0000u)}; }
__device__ __forceinline__ void stbf4(bf16_t* p, f32x4 v) { uint2 w; w.x = pk2(v[0], v[1]); w.y = pk2(v[2], v[3]); *(uint2*)p = w; }
typedef bf16_t xt_t;
__device__ __forceinline__ f32x4 xldv(const xt_t* X, size_t i) { return ldbf4(X + i); }
__device__ __forceinline__ void xstv(xt_t* X, size_t i, f32x4 v) { stbf4(X + i, v); }
__device__ __forceinline__ float4 xld(const xt_t* X, size_t i) { const f32x4 v = ldbf4(X + i); return make_float4(v[0], v[1], v[2], v[3]); }
__device__ __forceinline__ void xst(xt_t* X, size_t i, float4 v) { stbf4(X + i, (f32x4){v.x, v.y, v.z, v.w}); }
__device__ __forceinline__ float wave_sum(float v) {
    v = dpp_sum16(v); const int i = __builtin_bit_cast(int, v);
    return __builtin_bit_cast(float, __builtin_amdgcn_readlane(i, 0)) + __builtin_bit_cast(float, __builtin_amdgcn_readlane(i, 16)) + __builtin_bit_cast(float, __builtin_amdgcn_readlane(i, 32)) + __builtin_bit_cast(float, __builtin_amdgcn_readlane(i, 48));
}
__device__ __forceinline__ float sigmoidf_(float x) { return __builtin_amdgcn_rcpf(1.f + __expf(-x)); }
__device__ __forceinline__ int row_stream(int row) { return row < NLAT ? (row >> 12) : 4; }
__device__ __forceinline__ const float* modp(const Params& p, int layer, int s, int part) { return (const float*)(p.ws + OFF_MOD) + ((size_t)layer * 5 + s) * 6144 + part * 1024; }

struct SgArgs { const bf16_t* A; int lda; size_t strideA; const float* B; int ldb; size_t strideB; int M, N, K, nbatch; };
template <class Epi>
__device__ __forceinline__ void sg_gemm(const Params& p, char* lds, const SgArgs g, const Epi& epi) {
    bf16_t* As = (bf16_t*)lds;
    bf16_t* Bs = As + 128 * 40;
    const int tid = tidx(), wid = tid >> 6, lane = tid & 63;
    const int wr = wid >> 2, wc = wid & 3;
    const int tilesN = (g.N + 127) / 128, tilesM = g.M / 128, per = tilesM * tilesN, ntiles = per * g.nbatch;
    const int ar = tid >> 2, ak = (tid & 3) * 8;
    const int bn = tid & 127, bk = (tid >> 7) * 8;
    for (int tile = bidx(); tile < ntiles; tile += gdim()) {
        const int bt = tile / per, tt = tile % per;
        const int tm = tt / tilesN, tn = tt % tilesN;
        const int m0 = tm * 128, n0 = tn * 128;
        f32x4 acc[4][2];
#pragma unroll
        for (int m = 0; m < 4; ++m)
#pragma unroll
            for (int n = 0; n < 2; ++n) acc[m][n] = (f32x4){0.f, 0.f, 0.f, 0.f};
        const bool bvalid = (n0 + bn) < g.N;
        const bf16_t* ap = g.A + bt * g.strideA + (size_t)(m0 + ar) * g.lda + ak;
        const float* bp = g.B + bt * g.strideB + (size_t)bk * g.ldb + n0 + bn;
        bf16x8 areg; float breg[8];
        areg = *(const bf16x8*)ap;
#pragma unroll
        for (int j = 0; j < 8; ++j) breg[j] = bvalid ? bp[(size_t)j * g.ldb] : 0.f;
        for (int k0 = 0; k0 < g.K; k0 += 32) {
            __syncthreads();
            *(bf16x8*)(As + ar * 40 + ak) = areg;
            { u32x4 w; w.x = pk2(breg[0], breg[1]); w.y = pk2(breg[2], breg[3]); w.z = pk2(breg[4], breg[5]); w.w = pk2(breg[6], breg[7]); *(u32x4*)(Bs + bn * 40 + bk) = w; }
            __syncthreads();
            if (k0 + 32 < g.K) {
                areg = *(const bf16x8*)(ap + k0 + 32);
#pragma unroll
                for (int j = 0; j < 8; ++j) breg[j] = bvalid ? bp[(size_t)(k0 + 32 + j) * g.ldb] : 0.f;
            }
            bf16x8 af[4], bfr[2];
#pragma unroll
            for (int m = 0; m < 4; ++m) af[m] = *(const bf16x8*)(As + (wr * 64 + m * 16 + (lane & 15)) * 40 + (lane >> 4) * 8);
#pragma unroll
            for (int n = 0; n < 2; ++n) bfr[n] = *(const bf16x8*)(Bs + (wc * 32 + n * 16 + (lane & 15)) * 40 + (lane >> 4) * 8);
#pragma unroll
            for (int m = 0; m < 4; ++m)
#pragma unroll
                for (int n = 0; n < 2; ++n) acc[m][n] = __builtin_amdgcn_mfma_f32_16x16x32_bf16(af[m], bfr[n], acc[m][n], 0, 0, 0);
        }
#pragma unroll
        for (int m = 0; m < 4; ++m)
#pragma unroll
            for (int n = 0; n < 2; ++n) {
                const int col = n0 + wc * 32 + n * 16 + (lane & 15);
                if (col < g.N) {
#pragma unroll
                    for (int r = 0; r < 4; ++r) epi(bt, m0 + wr * 64 + m * 16 + (lane >> 4) * 4 + r, col, acc[m][n][r]);
                }
            }
    }
}


namespace g8 {
#define PG8_LAS __attribute__((address_space(3)))
constexpr int BM = 256, BK = 64, HALF = 128, HTB = HALF * BK * 2, STAGE_BYTES = 8 * HTB;
__device__ __forceinline__ int lds_byte(int r, int c) { const int st = (r >> 4) * 2 + (c >> 5), rr = r & 15, cc = c & 31, ob = rr * 64 + cc * 2; return st * 1024 + (ob ^ (((ob >> 9) & 1) << 5)); }
__device__ __forceinline__ void stage_rc(int b, int& R, int& C) { const int st = b / 1024, sb = b % 1024, swz = sb ^ (((sb >> 9) & 1) << 5); R = (st >> 1) * 16 + swz / 64; C = (st & 1) * 32 + (swz % 64) / 2; }
struct Unit { int pm, pn, g; const char* A; const char* B; };
__device__ __forceinline__ int xcd_remap(int L, int nwg) { const int q = nwg / 8, r = nwg % 8, xcd = L % 8, off = L / 8; return (xcd < r ? xcd * (q + 1) : r * (q + 1) + (xcd - r) * q) + off; }

template <class Epi, class Sched>
__device__ __forceinline__ void gemm_phase(const int wv_, PG8_LAS unsigned char* lds, const int K, const Sched& S, const Epi& E) {
    const int tid = tidx_w(wv_), wid = __builtin_amdgcn_readfirstlane(tid >> 6), lane = tid & 63, wr = wid >> 2, wc = wid & 3, fr = lane & 15, fq = lane >> 4;
    const int nt = K / BK;
    unsigned voffA[2];
#pragma unroll
    for (int i = 0; i < 2; ++i) { int R, C; stage_rc(tid * 16 + i * 8192, R, C); voffA[i] = (unsigned)(R * K + C) * 2u; }
    const size_t kstep = (size_t)(BK * 2);
    const size_t hstep = (size_t)HALF * K * 2;
    const unsigned ldsw = (unsigned)wid * 1024u;
    const int aoff = lds_byte(wr * 64 + fr, fq * 8), boff = lds_byte(wc * 32 + fr, fq * 8);
#define PG8_SA(b, h) (((b) * 2 + (h)) * HTB)
#define PG8_SB(b, h) ((4 + (b) * 2 + (h)) * HTB)
#define PG8_STAGE(bufoff, gbase, voff) do { _Pragma("unroll") for (int _i = 0; _i < 2; ++_i) \
        __builtin_amdgcn_global_load_lds((const unsigned*)((const char*)(gbase) + (voff)[_i]), (PG8_LAS unsigned*)(lds + (bufoff) + ldsw + _i * 8192), 16, 0, 0); } while (0)
#define PG8_LDA(dst, b, h) do { _Pragma("unroll") for (int m = 0; m < 4; ++m) _Pragma("unroll") for (int k = 0; k < 2; ++k) dst[m][k] = *(const PG8_LAS bf16x8*)(lds + PG8_SA(b, h) + aoff + m * 2048 + k * 1024); } while (0)
#define PG8_LDB(dst, b, h) do { _Pragma("unroll") for (int n = 0; n < 2; ++n) _Pragma("unroll") for (int k = 0; k < 2; ++k) dst[n][k] = *(const PG8_LAS bf16x8*)(lds + PG8_SB(b, h) + boff + n * 2048 + k * 1024); } while (0)
#define PG8_MMA(ai, bj, At, Bt) do { __builtin_amdgcn_s_setprio(1); _Pragma("unroll") for (int m = 0; m < 4; ++m) _Pragma("unroll") for (int n = 0; n < 2; ++n) _Pragma("unroll") for (int k = 0; k < 2; ++k) \
        acc[ai][bj][m][n] = __builtin_amdgcn_mfma_f32_16x16x32_bf16(Bt[n][k], At[m][k], acc[ai][bj][m][n], 0, 0, 0); __builtin_amdgcn_s_setprio(0); } while (0)
#define PG8_WAIT_V(n) asm volatile("s_waitcnt vmcnt(" #n ")" ::: "memory")
#define PG8_WAIT_L(n) asm volatile("s_waitcnt lgkmcnt(" #n ")" ::: "memory")
#define PG8_BAR __builtin_amdgcn_s_barrier()
#define PG8_SCHED __builtin_amdgcn_sched_barrier(0)
    Unit cur, nxt; int ui = 0;
    if (!S.next(0, cur)) return;
    f32x4 acc[2][2][4][2];
#pragma unroll
    for (int a = 0; a < 2; ++a)
#pragma unroll
        for (int b = 0; b < 2; ++b)
#pragma unroll
            for (int m = 0; m < 4; ++m)
#pragma unroll
                for (int n = 0; n < 2; ++n) acc[a][b][m][n] = (f32x4){0.f, 0.f, 0.f, 0.f};
    bf16x8 At[4][2], B0[2][2], B1[2][2];
    const char* cA = cur.A; const char* cB = cur.B;
    PG8_STAGE(PG8_SB(0, 0), cB, voffA); PG8_STAGE(PG8_SA(0, 0), cA, voffA); PG8_STAGE(PG8_SB(0, 1), cB + hstep, voffA); PG8_STAGE(PG8_SA(0, 1), cA + hstep, voffA);
    if (wr == 1) PG8_BAR;
    PG8_WAIT_V(4); PG8_BAR;
    PG8_STAGE(PG8_SB(1, 0), cB + kstep, voffA); PG8_STAGE(PG8_SA(1, 0), cA + kstep, voffA); PG8_STAGE(PG8_SB(1, 1), cB + hstep + kstep, voffA);
    PG8_WAIT_V(6); PG8_BAR;
    for (;;) {
        const bool has_next = S.next(ui + 1, nxt);
        const char* nA = has_next ? nxt.A : cA; const char* nB = has_next ? nxt.B : cB;
        for (int t = 0; t < nt; t += 2) {
            const bool last = (t == nt - 2);
            const char* a1 = cA + (size_t)(t + 1) * kstep;
            const char* a2 = last ? nA : cA + (size_t)(t + 2) * kstep; const char* b2 = last ? nB : cB + (size_t)(t + 2) * kstep;
            const char* a3 = a2 + kstep; const char* b3 = b2 + kstep;
            PG8_LDB(B0, 0, 0); PG8_SCHED; PG8_LDA(At, 0, 0); PG8_STAGE(PG8_SA(1, 1), a1 + hstep, voffA);
            PG8_WAIT_L(8); PG8_BAR; PG8_WAIT_L(0); PG8_MMA(0, 0, At, B0); PG8_BAR; PG8_SCHED;
            PG8_LDB(B1, 0, 1); PG8_STAGE(PG8_SB(0, 0), b2, voffA);
            PG8_BAR; PG8_WAIT_L(0); PG8_MMA(0, 1, At, B1); PG8_BAR;
            PG8_LDA(At, 0, 1); PG8_STAGE(PG8_SA(0, 0), a2, voffA);
            PG8_BAR; PG8_WAIT_L(0); PG8_MMA(1, 0, At, B0); PG8_BAR; PG8_SCHED;
            PG8_STAGE(PG8_SB(0, 1), b2 + hstep, voffA);
            PG8_WAIT_V(6); PG8_BAR; PG8_MMA(1, 1, At, B1); PG8_BAR;
            PG8_LDB(B0, 1, 0); PG8_SCHED; PG8_LDA(At, 1, 0); PG8_STAGE(PG8_SA(0, 1), a2 + hstep, voffA);
            PG8_WAIT_L(8); PG8_BAR; PG8_WAIT_L(0); PG8_MMA(0, 0, At, B0); PG8_BAR; PG8_SCHED;
            PG8_LDB(B1, 1, 1); PG8_STAGE(PG8_SB(1, 0), b3, voffA);
            PG8_BAR; PG8_WAIT_L(0); PG8_MMA(0, 1, At, B1); PG8_BAR;
            PG8_LDA(At, 1, 1); PG8_STAGE(PG8_SA(1, 0), a3, voffA);
            PG8_BAR; PG8_WAIT_L(0); PG8_MMA(1, 0, At, B0); PG8_BAR; PG8_SCHED;
            PG8_STAGE(PG8_SB(1, 1), b3 + hstep, voffA);
            PG8_WAIT_V(6); PG8_BAR; PG8_MMA(1, 1, At, B1); PG8_BAR;
        }
        E(acc, cur, wr, wc, fr, fq);
        if (!has_next) break;
#pragma unroll
        for (int a = 0; a < 2; ++a)
#pragma unroll
            for (int b = 0; b < 2; ++b)
#pragma unroll
                for (int m = 0; m < 4; ++m)
#pragma unroll
                    for (int n = 0; n < 2; ++n) acc[a][b][m][n] = (f32x4){0.f, 0.f, 0.f, 0.f};
        cur = nxt; cA = nA; cB = nB; ++ui;
    }
    PG8_WAIT_V(0);
    if (wr == 0) PG8_BAR;
    PG8_BAR;
#undef PG8_SA
#undef PG8_SB
#undef PG8_STAGE
#undef PG8_LDA
#undef PG8_LDB
#undef PG8_MMA
#undef PG8_WAIT_V
#undef PG8_WAIT_L
#undef PG8_BAR
#undef PG8_SCHED
}
template <class F> struct EpiRC { F f;
    __device__ __forceinline__ void operator()(const f32x4 (&acc)[2][2][4][2], const Unit& u, int wr, int wc, int fr, int fq) const {
#pragma unroll
        for (int ai = 0; ai < 2; ++ai)
#pragma unroll
            for (int m = 0; m < 4; ++m) { const int row = u.pm * BM + ai * HALF + wr * 64 + m * 16 + fr;
#pragma unroll
                for (int bj = 0; bj < 2; ++bj)
#pragma unroll
                    for (int n = 0; n < 2; ++n) f(u, row, u.pn * BM + bj * HALF + wc * 32 + n * 16 + 4 * fq, acc[ai][bj][m][n]);
                asm volatile("" ::: "memory"); }
    } };
template <class F> __device__ __forceinline__ EpiRC<F> epi_rc(const F& f) { return EpiRC<F>{f}; }
template <class F> struct EpiPair { F f;
    __device__ __forceinline__ void operator()(const f32x4 (&acc)[2][2][4][2], const Unit& u, int wr, int wc, int fr, int fq) const {
#pragma unroll
        for (int ai = 0; ai < 2; ++ai)
#pragma unroll
            for (int m = 0; m < 4; ++m) { const int row = u.pm * BM + ai * HALF + wr * 64 + m * 16 + fr;
#pragma unroll
                for (int n = 0; n < 2; ++n) f(u, row, u.pn * HALF + wc * 32 + n * 16 + 4 * fq, acc[ai][0][m][n], acc[ai][1][m][n]);
                asm volatile("" ::: "memory"); }
    } };
template <class F> __device__ __forceinline__ EpiPair<F> epi_pair(const F& f) { return EpiPair<F>{f}; }
template <class F, class CF, class RF> struct EpiPre { F f; CF cf; RF rf;
    __device__ __forceinline__ void operator()(const f32x4 (&acc)[2][2][4][2], const Unit& u, int wr, int wc, int fr, int fq) const {
        f32x4 cv[2][2]; float rv[2][4];
#pragma unroll
        for (int bj = 0; bj < 2; ++bj)
#pragma unroll
            for (int n = 0; n < 2; ++n) cv[bj][n] = cf(u, u.pn * BM + bj * HALF + wc * 32 + n * 16 + 4 * fq);
#pragma unroll
        for (int ai = 0; ai < 2; ++ai)
#pragma unroll
            for (int m = 0; m < 4; ++m) rv[ai][m] = rf(u, u.pm * BM + ai * HALF + wr * 64 + m * 16 + fr);
#pragma unroll
        for (int ai = 0; ai < 2; ++ai)
#pragma unroll
            for (int m = 0; m < 4; ++m) { const int row = u.pm * BM + ai * HALF + wr * 64 + m * 16 + fr;
#pragma unroll
                for (int bj = 0; bj < 2; ++bj)
#pragma unroll
                    for (int n = 0; n < 2; ++n) f(u, row, u.pn * BM + bj * HALF + wc * 32 + n * 16 + 4 * fq, acc[ai][bj][m][n], cv[bj][n], rv[ai][m]);
                asm volatile("" ::: "memory"); }
    } };
template <class F, class CF, class RF> __device__ __forceinline__ EpiPre<F, CF, RF> epi_pre(const F& f, const CF& cf, const RF& rf) { return EpiPre<F, CF, RF>{f, cf, rf}; }
template <class F, class CF> struct EpiColFirst { F f; CF cf;
    __device__ __forceinline__ void operator()(const f32x4 (&acc)[2][2][4][2], const Unit& u, int wr, int wc, int fr, int fq) const {
#pragma unroll
        for (int bj = 0; bj < 2; ++bj)
#pragma unroll
            for (int n = 0; n < 2; ++n) { const int col = u.pn * BM + bj * HALF + wc * 32 + n * 16 + 4 * fq; const f32x4 cv = cf(u, col);
#pragma unroll
                for (int ai = 0; ai < 2; ++ai)
#pragma unroll
                    for (int m = 0; m < 4; ++m) f(u, u.pm * BM + ai * HALF + wr * 64 + m * 16 + fr, col, acc[ai][bj][m][n], cv);
                asm volatile("" ::: "memory"); }
    } };
template <class F, class CF> __device__ __forceinline__ EpiColFirst<F, CF> epi_colfirst(const F& f, const CF& cf) { return EpiColFirst<F, CF>{f, cf}; }
struct EpiResid { xt_t* X; const float* MOD; int layer;
    __device__ __forceinline__ void operator()(const f32x4 (&acc)[2][2][4][2], const Unit& u, int wr, int wc, int fr, int fq) const {
        const int row0 = u.pm * BM + wr * 64 + fr, col0 = u.pn * BM + wc * 32 + 4 * fq;
        const int strm = row0 < NLAT ? (row0 >> 12) : 4;
        const float* gp = MOD + ((size_t)layer * 5 + strm) * 6144 + 2048 + col0;
        f32x4 gt[2][2];
#pragma unroll
        for (int bj = 0; bj < 2; ++bj)
#pragma unroll
            for (int n = 0; n < 2; ++n) gt[bj][n] = *(const f32x4*)(gp + bj * HALF + n * 16);
#pragma unroll
        for (int ai = 0; ai < 2; ++ai) {
            f32x4 xv[4][2][2];
#pragma unroll
            for (int m = 0; m < 4; ++m)
#pragma unroll
                for (int bj = 0; bj < 2; ++bj)
#pragma unroll
                    for (int n = 0; n < 2; ++n) xv[m][bj][n] = xldv(X, (size_t)(row0 + ai * HALF + m * 16) * D + col0 + bj * HALF + n * 16);
#pragma unroll
            for (int m = 0; m < 4; ++m)
#pragma unroll
                for (int bj = 0; bj < 2; ++bj)
#pragma unroll
                    for (int n = 0; n < 2; ++n) xstv(X, (size_t)(row0 + ai * HALF + m * 16) * D + col0 + bj * HALF + n * 16, xv[m][bj][n] + gt[bj][n] * acc[ai][bj][m][n]);
            asm volatile("" ::: "memory");
        }
    } };
struct BatchSched { const char* A; const char* B; size_t strideA, strideB; int nM, nN, nb, K;
    __device__ __forceinline__ bool next(int i, Unit& u) const {
        const int nwg = nM * nN * nb; const int L = i * gdim() + bidx(); if (L >= nwg) return false;
        const int w = xcd_remap(L, nwg); const int per = nM * nN; u.g = w / per; const int r = w % per; u.pm = r / nN; u.pn = r % nN;
        u.A = A + u.g * strideA + (size_t)u.pm * BM * K * 2; u.B = B + u.g * strideB + (size_t)u.pn * BM * K * 2; return true; } };
}

template <class SrcF, class DRow>
__device__ __forceinline__ int cvt_tiles(const int wv_, char* lds, bf16_t* dst, int Kd, int Nd, int nbatch, size_t dstride, const SrcF& src, const DRow& drow, unsigned* queue = nullptr) {
    bf16_t* T = (bf16_t*)lds;
    const int tid = tidx_w(wv_);
    const int tk = Kd / 128, tn = Nd / 64, per = tk * tn, total = per * nbatch;
    {
        for (int t = bidx(); t < total; t += gdim()) {
            const int bt = t / per, r = t % per, k0 = (r % tk) * 128, n0 = (r / tk) * 64;
            float4 v[4];
#pragma unroll
            for (int i = 0; i < 4; ++i) { const int k = k0 + i * 32 + (tid >> 4), n = n0 + (tid & 15) * 4; const float* sp = src(bt, k, n); v[i] = sp ? *(const float4*)sp : make_float4(0.f, 0.f, 0.f, 0.f); }
            __syncthreads();
#pragma unroll
            for (int i = 0; i < 4; ++i) { const int k = i * 32 + (tid >> 4), n = (tid & 15) * 4;
                T[(n + 0) * 136 + k] = f2bf(v[i].x); T[(n + 1) * 136 + k] = f2bf(v[i].y); T[(n + 2) * 136 + k] = f2bf(v[i].z); T[(n + 3) * 136 + k] = f2bf(v[i].w); }
            __syncthreads();
            { const int n = tid >> 3, kc = (tid & 7) * 16;
              const u32x4 a = *(const u32x4*)(T + n * 136 + kc), b = *(const u32x4*)(T + n * 136 + kc + 8);
              bf16_t* dp = dst + bt * dstride + (size_t)drow(n0 + n) * Kd + k0 + kc;
              *(u32x4*)dp = a; *(u32x4*)(dp + 8) = b; }
        }
    }
    return 0;
}
__device__ __forceinline__ int moe_cvt(const Params& p, int layer, char* lds, int budget) {
    constexpr int QG = 2, T13 = NE * 8 * 44, TOT = T13 + NE * 11 * 16;
    bf16_t* T = (bf16_t*)lds;
    int* qslot = (int*)(lds + 64 * 136 * 2);
    const int tid = tidx();
    const float* w1 = p.moe_w1 + (size_t)layer * NE * D * FF; const float* w3 = p.moe_w3 + (size_t)layer * NE * D * FF; const float* w2 = p.moe_w2 + (size_t)layer * NE * FF * D;
    bf16_t* W13 = (bf16_t*)(p.ws + OFF_W13T + (size_t)(layer & 1) * SZ_WMOE); bf16_t* W2 = (bf16_t*)(p.ws + OFF_W2T + (size_t)(layer & 1) * SZ_WMOE);
    unsigned* queue = (unsigned*)(p.ws + OFF_QUEUE) + layer * 32;
    const bool ahead = budget < 0;
    int done = 0, tnext = 0;
    __syncthreads();
    if (tid == 0) qslot[0] = QG * (int)__hip_atomic_fetch_add(queue, 1u, __ATOMIC_RELAXED, __HIP_MEMORY_SCOPE_AGENT);
    __syncthreads();
    int t0 = __builtin_amdgcn_readfirstlane(qslot[0]);
    while (t0 < TOT && (ahead || done < budget)) {
        const bool more = ahead || done + 1 < budget;
        if (more && tid == 0) tnext = QG * (int)__hip_atomic_fetch_add(queue, 1u, __ATOMIC_RELAXED, __HIP_MEMORY_SCOPE_AGENT);
#pragma unroll 1
        for (int sub = 0; sub < QG; ++sub) {
            const int t = t0 + sub;
            const float* sp; bf16_t* dp; int ss, ds;
            if (t < T13) { const int e = t / 352, r = t % 352, k0 = (r & 7) * 128, n0 = (r >> 3) * 64; const int c0 = (n0 >> 8) * 128 + (n0 & 127);
                sp = (((n0 >> 7) & 1) ? w3 : w1) + ((size_t)e * D + k0) * FF + c0; ss = FF; dp = W13 + ((size_t)e * 2816 + n0) * D + k0; ds = D; }
            else { const int u = t - T13, e = u / 176, r = u % 176, k0 = (r % 11) * 128, n0 = (r / 11) * 64;
                sp = w2 + ((size_t)e * FF + k0) * D + n0; ss = D; dp = W2 + ((size_t)e * D + n0) * FF + k0; ds = FF; }
            float4 v[4];
#pragma unroll
            for (int i = 0; i < 4; ++i) v[i] = *(const float4*)(sp + (size_t)(i * 32 + (tid >> 4)) * ss + (tid & 15) * 4);
            __syncthreads();
#pragma unroll
            for (int i = 0; i < 4; ++i) { const int k = i * 32 + (tid >> 4), n = (tid & 15) * 4;
                T[(n + 0) * 136 + k] = f2bf(v[i].x); T[(n + 1) * 136 + k] = f2bf(v[i].y); T[(n + 2) * 136 + k] = f2bf(v[i].z); T[(n + 3) * 136 + k] = f2bf(v[i].w); }
            if (sub == QG - 1 && tid == 0) qslot[0] = more ? tnext : TOT;
            __syncthreads();
            { const int n = tid >> 3, kc = (tid & 7) * 16;
              const u32x4 a = *(const u32x4*)(T + n * 136 + kc), b = *(const u32x4*)(T + n * 136 + kc + 8);
              bf16_t* o = dp + (size_t)n * ds + kc;
              *(u32x4*)o = a; *(u32x4*)(o + 8) = b; }
        }
        ++done; t0 = __builtin_amdgcn_readfirstlane(qslot[0]);
    }
    __syncthreads();
    return done;
}
__device__ __forceinline__ void bg_cvt(const Params& p, int layer, char* lds, int budget) {
#pragma unroll 1
    for (int l = layer; l < 4 && l <= layer + 1 && budget > 0; ++l) budget -= moe_cvt(p, l, lds, budget);
}
__device__ __forceinline__ bool idle_tail(int nunits) { const int r = nunits % gdim(); return r != 0 && bidx() >= r; }
__device__ void ph_init(const Params& p, char* lds) {
    const int tid = tidx(), gtid = bidx() * NTHR + tid, gsz = gdim() * NTHR;
    xt_t* Xs = (xt_t*)(p.ws + OFF_X);
    const float4* x4 = (const float4*)p.x; const float4* c4 = (const float4*)p.ctx;
    { constexpr int NQ = NROW * 256 / 4;
      auto srcv = [&](int k) { return k < NLAT * 256 ? x4[k] : c4[k - NLAT * 256]; };
      for (int i = gtid; i < NQ; i += gsz) { const float4 t0 = srcv(i), t1 = srcv(i + NQ), t2 = srcv(i + 2 * NQ), t3 = srcv(i + 3 * NQ); xst(Xs, (size_t)4 * i, t0); xst(Xs, (size_t)4 * (i + NQ), t1); xst(Xs, (size_t)4 * (i + 2 * NQ), t2); xst(Xs, (size_t)4 * (i + 3 * NQ), t3); } }
    float* rc = (float*)(p.ws + OFF_ROPE_C); float* rs = (float*)(p.ws + OFF_ROPE_S);
    for (int i = gtid; i < TL * 32; i += gsz) {
        const int t = i >> 5, f = i & 31; const float pos = (float)((f < 16) ? (t >> 6) : (t & 63));
        const float inv = powf(10000.f, -(float)(f & 15) / 16.f); const float ang = pos * inv; rc[2 * i] = cosf(ang); rc[2 * i + 1] = sinf(ang);
    }
    float* sc = (float*)lds;
    float* red = sc + 5 * 1024;
    for (int i = tid; i < 5 * 1024; i += NTHR) { const float v = i < 4096 ? p.c[i] : p.c_ctx[i - 4096]; sc[i] = v / (1.f + expf(-v)); }
    __syncthreads();
    float* MOD = (float*)(p.ws + OFF_MOD);
    for (int item = bidx(); item < 4 * 96; item += gdim()) {
        const int l = item / 96, cg = item % 96, col = tid & 63, n = cg * 64 + col, kg = tid >> 6;
        const float* w = p.mod_w + ((size_t)l * 1024 + kg * 128) * 6144 + n;
        float a0 = 0, a1 = 0, a2 = 0, a3 = 0, a4 = 0;
#pragma unroll 16
        for (int k = 0; k < 128; ++k) { const float wv = w[(size_t)k * 6144]; const int kk = kg * 128 + k;
            a0 += sc[kk] * wv; a1 += sc[1024 + kk] * wv; a2 += sc[2048 + kk] * wv; a3 += sc[3072 + kk] * wv; a4 += sc[4096 + kk] * wv; }
        float* rr = red + (kg * 64 + col) * 5; rr[0] = a0; rr[1] = a1; rr[2] = a2; rr[3] = a3; rr[4] = a4;
        __syncthreads();
        if (tid < 320) { const int c2 = tid & 63, s = tid >> 6; float sum = 0;
            for (int q = 0; q < 8; ++q) sum += red[(q * 64 + c2) * 5 + s];
            MOD[((size_t)l * 5 + s) * 6144 + cg * 64 + c2] = sum + p.mod_b[l * 6144 + cg * 64 + c2]; }
        __syncthreads();
    }
}


__device__ void ph_small_cvt(const Params& p, char* lds) {
    for (int j = 0; j < 2; ++j) {
        char* wm = p.ws + OFF_WMLA + j * SZ_WMLA; char* wr = p.ws + OFF_WRW + j * SZ_WRW;
        const float* w_in = p.mla_w_in + (size_t)j * D * 448; const float* w_uq = p.mla_w_uq + (size_t)j * 256 * 1536; const float* w_ukv = p.mla_w_ukv + (size_t)j * 128 * 2048; const float* w_o = p.mla_w_o + (size_t)j * D * D;
        cvt_tiles(p.wv, lds, (bf16_t*)(wm + WM_IN), 1024, 512, 1, 0, [=](int, int k, int n) -> const float* { return n < 448 ? w_in + (size_t)k * 448 + n : nullptr; },
                  [=](int n) { if (n < 384 || n >= 448) return n; const int jj = n - 384; return 384 + (jj < 32 ? 2 * jj : 2 * (jj - 32) + 1); });
        cvt_tiles(p.wv, lds, (bf16_t*)(wm + WM_UQ), 256, 1536, 1, 0, [=](int, int k, int n) -> const float* { return w_uq + (size_t)k * 1536 + n; },
                  [=](int n) { const int h = n / 192, d = n % 192; if (d < 128) return n; const int jj = d - 128; return h * 192 + 128 + (jj < 32 ? 2 * jj : 2 * (jj - 32) + 1); });
        cvt_tiles(p.wv, lds, (bf16_t*)(wm + WM_UKV), 128, 2048, 1, 0, [=](int, int k, int n) -> const float* { return w_ukv + (size_t)k * 2048 + n; }, [=](int n) { return n; });
        cvt_tiles(p.wv, lds, (bf16_t*)(wm + WM_O), 1024, 1024, 1, 0, [=](int, int k, int n) -> const float* { return w_o + (size_t)k * D + n; }, [=](int n) { return n; });
        const float* w_rkv = p.rw_w_rkv + (size_t)j * 3 * D * D; const float* w1 = p.rw_w1 + (size_t)j * 2 * D * 64; const float* a1 = p.rw_a1 + (size_t)j * 2 * D * 64;
        const float* g1 = p.rw_g1 + (size_t)j * D * 128; const float* v1 = p.rw_v1; const float* rwo = p.rw_w_o + (size_t)j * D * D;
        cvt_tiles(p.wv, lds, (bf16_t*)(wr + WR_RKV), 1024, 1024, 3, (size_t)D * D, [=](int m, int k, int n) -> const float* { return w_rkv + ((size_t)m * D + k) * D + n; }, [=](int n) { return n; });
        cvt_tiles(p.wv, lds, (bf16_t*)(wr + WR_L), 1024, 256, 1, 0, [=](int, int k, int n) -> const float* { return n < 128 ? w1 + ((size_t)(n >> 6) * D + k) * 64 + (n & 63) : nullptr; }, [=](int n) { return n; });
        cvt_tiles(p.wv, lds, (bf16_t*)(wr + WR_L) + 256 * 1024, 1024, 256, 1, 0, [=](int, int k, int n) -> const float* { return n < 128 ? a1 + ((size_t)(n >> 6) * D + k) * 64 + (n & 63) : nullptr; }, [=](int n) { return n; });
        cvt_tiles(p.wv, lds, (bf16_t*)(wr + WR_L) + 2 * 256 * 1024, 1024, 256, 1, 0, [=](int, int k, int n) -> const float* { return n < 128 ? g1 + (size_t)k * 128 + n : nullptr; }, [=](int n) { return n; });
        cvt_tiles(p.wv, lds, (bf16_t*)(wr + WR_L) + 3 * 256 * 1024, 1024, 256, 1, 0, [=](int, int k, int n) -> const float* { return n < 32 ? v1 + (size_t)k * 32 + n : nullptr; }, [=](int n) { return n; });
        cvt_tiles(p.wv, lds, (bf16_t*)(wr + WR_O), 1024, 1024, 1, 0, [=](int, int k, int n) -> const float* { return rwo + (size_t)k * D + n; }, [=](int n) { return n; });
        const float* w2 = p.rw_w2 + (size_t)j * 2 * 64 * D; const float* a2 = p.rw_a2 + (size_t)j * 2 * 64 * D; const float* g2 = p.rw_g2 + (size_t)j * 128 * D; const float* v2 = p.rw_v2;
        cvt_tiles(p.wv, lds, (bf16_t*)(wr + WR_B2), 128, 2048, 2, (size_t)2048 * 128, [=](int bt, int k, int n) -> const float* { const int zz = n >> 10, c = n & 1023, l = k - zz * 64;
            if (l < 0 || l >= 64) return nullptr; return (bt == 0 ? w2 : a2) + ((size_t)zz * 64 + l) * D + c; }, [=](int n) { return n; });
        cvt_tiles(p.wv, lds, (bf16_t*)(wr + WR_B3), 128, 1024, 2, (size_t)1024 * 128, [=](int bt, int k, int n) -> const float* {
            if (bt == 0) return g2 + (size_t)k * D + n; return k < 32 ? v2 + (size_t)k * D + n : nullptr; }, [=](int n) { return n; });
    }
}

template <bool OUTF32>
__device__ void ph_norm_mod(const Params& p, int layer, const float* g, int part_sh, int part_sc, void* outp) {
    const int wid = tidx() >> 6, lane = tidx() & 63;
    const xt_t* X = (const xt_t*)(p.ws + OFF_X);
    int row = bidx() * 8 + wid;
    float4 nv[4];
    if (row < NROW) {
#pragma unroll
        for (int i = 0; i < 4; ++i) nv[i] = xld(X, (size_t)row * D + (lane + i * 64) * 4); }
    for (; row < NROW; row += gdim() * 8) {
        const int s = row_stream(row);
        const float* sh = modp(p, layer, s, part_sh); const float* sc = modp(p, layer, s, part_sc);
        float4 v[4]; float ss = 0;
#pragma unroll
        for (int i = 0; i < 4; ++i) { v[i] = nv[i]; ss += v[i].x * v[i].x + v[i].y * v[i].y + v[i].z * v[i].z + v[i].w * v[i].w; }
        { const int nrow = row + gdim() * 8;
          if (nrow < NROW) {
#pragma unroll
              for (int i = 0; i < 4; ++i) nv[i] = xld(X, (size_t)nrow * D + (lane + i * 64) * 4); } }
        ss = wave_sum(ss); const float rs = rsqrtf(ss * (1.f / D) + RMS_EPS);
#pragma unroll
        for (int i = 0; i < 4; ++i) {
            const int d = (lane + i * 64) * 4;
            const float4 gg = *(const float4*)(g + d), a = *(const float4*)(sc + d), b = *(const float4*)(sh + d);
            float4 o; o.x = v[i].x * rs * gg.x * (1.f + a.x) + b.x; o.y = v[i].y * rs * gg.y * (1.f + a.y) + b.y; o.z = v[i].z * rs * gg.z * (1.f + a.z) + b.z; o.w = v[i].w * rs * gg.w * (1.f + a.w) + b.w;
            if (OUTF32) *(float4*)((float*)outp + (size_t)row * D + d) = o;
            else { uint2 w; w.x = pk2(o.x, o.y); w.y = pk2(o.z, o.w); *(uint2*)((bf16_t*)outp + (size_t)row * D + d) = w; }
        }
    }
}

__device__ void ph_mla_mid(const Params& p, int j) {
    const int wid = tidx() >> 6, lane = tidx() & 63;
    const float* Z = (const float*)(p.ws + OFF_Z);
    bf16_t* CQN = (bf16_t*)(p.ws + OFF_CQN); bf16_t* CKVN = (bf16_t*)(p.ws + OFF_CKVN); bf16_t* K = (bf16_t*)(p.ws + OFF_K);
    const float* gq = p.mla_g_q + j * 256; const float* gkv = p.mla_g_kv + j * 128;
    const float* rc = (const float*)(p.ws + OFF_ROPE_C); const float* rs = (const float*)(p.ws + OFF_ROPE_S);
    for (int row = bidx() * 8 + wid; row < NROW; row += gdim() * 8) {
        const float* z = Z + (size_t)row * 512;
        const float4 q = *(const float4*)(z + lane * 4);
        const float2 kv = *(const float2*)(z + 256 + lane * 2);
        const float kr = z[384 + lane];
        float sq = wave_sum(q.x * q.x + q.y * q.y + q.z * q.z + q.w * q.w); const float rq = rsqrtf(sq * (1.f / 256.f) + RMS_EPS);
        float sk = wave_sum(kv.x * kv.x + kv.y * kv.y); const float rk = rsqrtf(sk * (1.f / 128.f) + RMS_EPS);
        const float4 g4 = *(const float4*)(gq + lane * 4); const float2 g2 = *(const float2*)(gkv + lane * 2);
        uint2 w; w.x = pk2(q.x * rq * g4.x, q.y * rq * g4.y); w.y = pk2(q.z * rq * g4.z, q.w * rq * g4.w);
        *(uint2*)(CQN + (size_t)row * 256 + lane * 4) = w;
        *(unsigned*)(CKVN + (size_t)row * 128 + lane * 2) = pk2(kv.x * rk * g2.x, kv.y * rk * g2.y);
        float o = kr;
        const float other = __builtin_bit_cast(float, __builtin_amdgcn_update_dpp(0, __builtin_bit_cast(int, kr), 0xB1, 0xF, 0xF, true));
        const bool lat = row < NLAT;
        if (lat) { const int t = row & (TL - 1), i = lane >> 1; const float2 cs = *(const float2*)(rc + (t * 32 + i) * 2); const float c = cs.x, s = cs.y;
            o = (lane & 1) ? (other * s + kr * c) : (kr * c - other * s); }
        const int b = lat ? (row >> 12) : ((row - NLAT) >> 8); const int tk = lat ? 256 + (row & (TL - 1)) : ((row - NLAT) & 255);
        const bf16_t ob = f2bf(o);
#pragma unroll
        for (int h = 0; h < 8; ++h) K[((size_t)(b * 8 + h) * TK + tk) * 192 + 128 + lane] = ob;
    }
}

__device__ void ph_qkv_post(const Params& p) {
    const int wid = tidx() >> 6, lane = tidx() & 63;
    const float* QRAW = (const float*)(p.ws + OFF_QRAW); const float* KVRAW = (const float*)(p.ws + OFF_KVRAW); const float* KR = (const float*)(p.ws + OFF_KR);
    bf16_t* Q = (bf16_t*)(p.ws + OFF_Q); bf16_t* K = (bf16_t*)(p.ws + OFF_K); bf16_t* V = (bf16_t*)(p.ws + OFF_V);
    const float* rc = (const float*)(p.ws + OFF_ROPE_C); const float* rs = (const float*)(p.ws + OFF_ROPE_S);
    for (int it = bidx() * 8 + wid; it < NROW * 8; it += gdim() * 8) {
        const int row = it >> 3, h = it & 7;
        const bool lat = row < NLAT; const int b = lat ? (row >> 12) : ((row - NLAT) >> 8); const int tk = lat ? 256 + (row & (TL - 1)) : ((row - NLAT) & 255);
        const size_t orow = (size_t)(b * 8 + h) * TK + tk;
        const float* q = QRAW + (size_t)row * 1536 + h * 192;
        const float q0 = q[lane], q1 = q[64 + lane]; float q2 = q[128 + lane];
        const auto sw = __builtin_amdgcn_permlane32_swap(__float_as_uint(q2), __float_as_uint(q2), false, false);
        if (lat) { const int t = row & (TL - 1), i = lane & 31; const float c = rc[t * 32 + i], s = rs[t * 32 + i];
            const float x1 = __uint_as_float(sw[0]), x2 = __uint_as_float(sw[1]); q2 = lane < 32 ? (x1 * c - x2 * s) : (x1 * s + x2 * c); }
        bf16_t* qo = Q + orow * 192; qo[lane] = f2bf(q0); qo[64 + lane] = f2bf(q1); qo[128 + lane] = f2bf(q2);
        const float* kv = KVRAW + (size_t)row * 2048 + h * 256;
        bf16_t* ko = K + orow * 192; ko[lane] = f2bf(kv[lane]); ko[64 + lane] = f2bf(kv[64 + lane]); ko[128 + lane] = f2bf(KR[(size_t)row * 64 + lane]);
        bf16_t* vo = V + orow * 128; vo[lane] = f2bf(kv[128 + lane]); vo[64 + lane] = f2bf(kv[192 + lane]);
    }
}

__device__ void ph_attn_naive(const Params& p, char* lds) {
    const int tid = tidx(), qi = tid >> 2, part = tid & 3;
    const bf16_t* Q = (const bf16_t*)(p.ws + OFF_Q); const bf16_t* K = (const bf16_t*)(p.ws + OFF_K); const bf16_t* V = (const bf16_t*)(p.ws + OFF_V);
    bf16_t* O = (bf16_t*)(p.ws + OFF_O);
    bf16_t* Ks = (bf16_t*)lds;
    bf16_t* Vs = Ks + 32 * 192;
    const int nitems = 32 * 34;
    for (int it = bidx(); it < nitems; it += gdim()) {
        const int bh = it / 34, qb = it % 34; const int b = bh >> 3, h = bh & 7;
        const int nkeys = qb < 2 ? TC : TK;
        const int tq = qb * 128 + qi;
        const bf16_t* qp = Q + ((size_t)bh * TK + tq) * 192 + part * 48;
        float q[48];
#pragma unroll
        for (int i = 0; i < 48; ++i) q[i] = bf2f(qp[i]) * ATT_SCALE;
        float o[32];
#pragma unroll
        for (int i = 0; i < 32; ++i) o[i] = 0.f;
        float m = -1e30f, l = 0.f;
        for (int k0 = 0; k0 < nkeys; k0 += 32) {
            __syncthreads();
            {
                const bf16_t* kg = K + ((size_t)bh * TK + k0) * 192; const bf16_t* vg = V + ((size_t)bh * TK + k0) * 128;
                for (int c = tid; c < 768; c += NTHR) *(u32x4*)(Ks + c * 8) = *(const u32x4*)(kg + c * 8);
                *(u32x4*)(Vs + tid * 8) = *(const u32x4*)(vg + tid * 8);
            }
            __syncthreads();
#pragma unroll 1
            for (int kg = 0; kg < 32; kg += 8) {
                float s[8]; float tmax = -1e30f;
#pragma unroll
                for (int kk = 0; kk < 8; ++kk) {
                    const bf16_t* kr = Ks + (kg + kk) * 192 + part * 48; float acc = 0.f;
#pragma unroll
                    for (int i = 0; i < 48; ++i) acc += q[i] * bf2f(kr[i]);
                    acc += __shfl_xor(acc, 1); acc += __shfl_xor(acc, 2);
                    s[kk] = acc; tmax = fmaxf(tmax, acc);
                    asm volatile("" ::: "memory");
                }
                const float mn = fmaxf(m, tmax), alpha = expf(m - mn); m = mn; l *= alpha;
#pragma unroll
                for (int i = 0; i < 32; ++i) o[i] *= alpha;
#pragma unroll
                for (int kk = 0; kk < 8; ++kk) {
                    const float pw = expf(s[kk] - mn); l += pw;
                    const bf16_t* vr = Vs + (kg + kk) * 128 + part * 32;
#pragma unroll
                    for (int i = 0; i < 32; ++i) o[i] += pw * bf2f(vr[i]);
                    asm volatile("" ::: "memory");
                }
            }
        }
        const float rl = 1.f / l;
        const int row = qb < 2 ? (NLAT + b * TC + tq) : (b * TL + tq - TC);
        bf16_t* op = O + (size_t)row * D + h * 128 + part * 32;
#pragma unroll
        for (int i = 0; i < 32; ++i) op[i] = f2bf(o[i] * rl);
    }
}


namespace fa {
using s16x4  = __attribute__((ext_vector_type(4))) short;
using f32x16 = __attribute__((ext_vector_type(16))) float;
constexpr int DQK = 192, DV = 128, KVBLK = 64;
constexpr float THR = 8.f;
constexpr int SHM_V = KVBLK * DV * 2, SHM_K = KVBLK * DQK * 2;
constexpr int SHM_ATTN = 2 * SHM_V + 2 * SHM_K + 8 * 64 * 4;
#define KSWZ(row, colB) ((row) * 384 + ((colB) ^ ((((row) >> 1) & 7) << 4)))
#define SBAR() __builtin_amdgcn_sched_barrier(0)
__device__ __forceinline__ int crow(int r, int hi) { return (r & 3) + 8 * (r >> 2) + 4 * hi; }
__device__ __forceinline__ unsigned cvtpk(float lo, float hi) { unsigned r; asm volatile("v_cvt_pk_bf16_f32 %0, %1, %2" : "=v"(r) : "v"(lo), "v"(hi)); return r; }
__device__ __forceinline__ void partialSM(f32x16& p0, f32x16& p1, float& m_reg, float& mn, float& alpha) {
  constexpr float C = ATT_SCALE * 1.4426950408889634f;
  float pmax = p0[0];
#pragma unroll
  for (int r = 1; r < 16; ++r) pmax = fmaxf(pmax, p0[r]);
#pragma unroll
  for (int r = 0; r < 16; ++r) pmax = fmaxf(pmax, p1[r]);
  { auto rr = __builtin_amdgcn_permlane32_swap(__float_as_uint(pmax), __float_as_uint(pmax), false, false);
    pmax = fmaxf(__uint_as_float(rr[0]), __uint_as_float(rr[1])); }
  if (__builtin_expect(__all(pmax - m_reg <= THR / ATT_SCALE), 1)) { mn = m_reg; alpha = 1.f; }
  else { mn = fmaxf(m_reg, pmax); alpha = __builtin_amdgcn_exp2f((m_reg - mn) * C); m_reg = mn; }
  float mnC = -mn * C;
#pragma unroll
  for (int r = 0; r < 16; ++r) p0[r] = fmaf(p0[r], C, mnC);
#pragma unroll
  for (int r = 0; r < 16; ++r) p1[r] = fmaf(p1[r], C, mnC);
#pragma unroll
  for (int r = 0; r < 16; ++r) p0[r] = __builtin_amdgcn_exp2f(p0[r]);
}
__device__ __forceinline__ void finishSM(f32x16& p0, f32x16& p1, float alpha, float& l_reg, bf16x8& pa0, bf16x8& pa1, bf16x8& pa2, bf16x8& pa3) {
#pragma unroll
  for (int r = 0; r < 16; ++r) p1[r] = __builtin_amdgcn_exp2f(p1[r]);
  float ps = 0;
#pragma unroll
  for (int r = 0; r < 16; ++r) ps += p0[r];
#pragma unroll
  for (int r = 0; r < 16; ++r) ps += p1[r];
  { auto rr = __builtin_amdgcn_permlane32_swap(__float_as_uint(ps), __float_as_uint(ps), false, false);
    ps = __uint_as_float(rr[0]) + __uint_as_float(rr[1]); }
  l_reg = l_reg * alpha + ps;
#define PK4(P, BASE, OUT) do { unsigned a0 = cvtpk(P[BASE + 0], P[BASE + 1]), a1 = cvtpk(P[BASE + 2], P[BASE + 3]);   \
    unsigned b0 = cvtpk(P[BASE + 4], P[BASE + 5]), b1 = cvtpk(P[BASE + 6], P[BASE + 7]);                              \
    auto r0 = __builtin_amdgcn_permlane32_swap(a0, b0, false, false); auto r1 = __builtin_amdgcn_permlane32_swap(a1, b1, false, false); \
    u32x4 w = {r0[0], r1[0], r0[1], r1[1]}; OUT = *reinterpret_cast<bf16x8*>(&w); } while (0)
  PK4(p0, 0, pa0); PK4(p0, 8, pa1); PK4(p1, 0, pa2); PK4(p1, 8, pa3);
#undef PK4
}
__device__ __forceinline__ void qkt(f32x16& p0, f32x16& p1, const char* Ks, const bf16x8* qr, int r32, int hi) {
  p0 = f32x16{}; p1 = f32x16{};
  const int swz = ((r32 >> 1) & 7) << 4;
  const char* b4[4];
#pragma unroll
  for (int dr = 0; dr < 4; ++dr) b4[dr] = Ks + r32 * 384 + ((dr * 32 + hi * 16) ^ swz);
#pragma unroll
  for (int d0 = 0; d0 < 12; ++d0) {
    bf16x8 b0 = *reinterpret_cast<const bf16x8*>(b4[d0 & 3] + (d0 >> 2) * 128);
    bf16x8 b1 = *reinterpret_cast<const bf16x8*>(b4[d0 & 3] + (d0 >> 2) * 128 + 32 * 384);
    p0 = __builtin_amdgcn_mfma_f32_32x32x16_bf16(b0, qr[d0], p0, 0, 0, 0);
    p1 = __builtin_amdgcn_mfma_f32_32x32x16_bf16(b1, qr[d0], p1, 0, 0, 0); }
}
__device__ __forceinline__ int v_st(int k, int c) { const int kk = (k & ~0xC) | ((k & 4) << 1) | ((k & 8) >> 1); return ((kk >> 3) * 4 + (c >> 5)) * 512 + ((kk & 7) * 32 + (c & 31)) * 2; }
__device__ __forceinline__ int v_rd_base(int lane) { return ((lane & 3) << 3) | (((lane >> 2) & 3) << 6) | (((lane >> 4) & 1) << 5) | (((lane >> 5) & 1) << 8); }
constexpr int v_rd_off(int d0, int ks, int half) { return d0 * 512 + ks * 4096 + half * 2048; }
template <int OFF> __device__ __forceinline__ s16x4 tr_read(int vb) {
  s16x4 r; asm volatile("ds_read_b64_tr_b16 %0, %1 offset:%2" : "=&v"(r) : "v"(vb), "i"(OFF) : "memory"); return r;
}
template <int D0> __device__ __forceinline__ void pv_one(f32x16& od, int vb, bf16x8 pa0, bf16x8 pa1, bf16x8 pa2, bf16x8 pa3) {
  const s16x4 l0 = tr_read<v_rd_off(D0, 0, 0)>(vb), h0 = tr_read<v_rd_off(D0, 0, 1)>(vb), l1 = tr_read<v_rd_off(D0, 1, 0)>(vb), h1 = tr_read<v_rd_off(D0, 1, 1)>(vb);
  const s16x4 l2 = tr_read<v_rd_off(D0, 2, 0)>(vb), h2 = tr_read<v_rd_off(D0, 2, 1)>(vb), l3 = tr_read<v_rd_off(D0, 3, 0)>(vb), h3 = tr_read<v_rd_off(D0, 3, 1)>(vb);
  asm volatile("s_waitcnt lgkmcnt(0)" ::: "memory"); SBAR();
#define PK(L, H) (bf16x8){L[0], L[1], L[2], L[3], H[0], H[1], H[2], H[3]}
  od = __builtin_amdgcn_mfma_f32_32x32x16_bf16(pa0, PK(l0, h0), od, 0, 0, 0);
  od = __builtin_amdgcn_mfma_f32_32x32x16_bf16(pa1, PK(l1, h1), od, 0, 0, 0);
  od = __builtin_amdgcn_mfma_f32_32x32x16_bf16(pa2, PK(l2, h2), od, 0, 0, 0);
  od = __builtin_amdgcn_mfma_f32_32x32x16_bf16(pa3, PK(l3, h3), od, 0, 0, 0);
#undef PK
}
__device__ __forceinline__ void pv_d0(f32x16* o, int vb, bf16x8 pa0, bf16x8 pa1, bf16x8 pa2, bf16x8 pa3) {
  pv_one<0>(o[0], vb, pa0, pa1, pa2, pa3); pv_one<1>(o[1], vb, pa0, pa1, pa2, pa3); pv_one<2>(o[2], vb, pa0, pa1, pa2, pa3); pv_one<3>(o[3], vb, pa0, pa1, pa2, pa3);
}
__device__ __forceinline__ void attn_body(const int wv_, const bf16_t* __restrict__ Qb, const bf16_t* __restrict__ Kh, const bf16_t* __restrict__ Vh, bf16_t* __restrict__ Ob, int ldo, int seq, char* lds, const float* __restrict__ ropecs  ) {
  const int tid = tidx_w(wv_), wid = tid >> 6, lane = tid & 63, r32 = lane & 31, hi = lane >> 5;
  char* V_lds = lds; char* K_lds = lds + 2 * SHM_V;
  float* ws = (float*)(lds + 2 * SHM_V + 2 * SHM_K) + wid * 64; float* li_l = ws; float* al_l = ws + 32;
  float m_reg = -1e30f, l_reg = 0; f32x16 o[4] = {}; bf16x8 qr[12];
  const bf16_t* Qw = Qb + (long)(wid * 32 + r32) * DQK + hi * 8;
#pragma unroll
  for (int d0 = 0; d0 < 12; ++d0) qr[d0] = *reinterpret_cast<const bf16x8*>(Qw + d0 * 16);
  if (ropecs) {
    const float* cs = ropecs + (size_t)(wid * 32 + r32) * 64;
#pragma unroll
    for (int d0 = 8; d0 < 12; ++d0) { const int i0 = (d0 - 8) * 8 + hi * 4; const f32x4 c0 = *(const f32x4*)(cs + i0 * 2), c1 = *(const f32x4*)(cs + i0 * 2 + 4);
      u32x4 w = *reinterpret_cast<u32x4*>(&qr[d0]); const float cc[4] = {c0[0], c0[2], c1[0], c1[2]}, ss[4] = {c0[1], c0[3], c1[1], c1[3]};
#pragma unroll
      for (int m = 0; m < 4; ++m) { const float x1 = __uint_as_float(w[m] << 16), x2 = __uint_as_float(w[m] & 0xffff0000u); w[m] = cvtpk(x1 * cc[m] - x2 * ss[m], x1 * ss[m] + x2 * cc[m]); }
      qr[d0] = *reinterpret_cast<bf16x8*>(&w); }
  }
  const int sr = tid >> 4, sc = (tid & 15) * 8, vst0 = v_st(sr, sc), vst1 = v_st(32 + sr, sc);
  int kst[3];
#pragma unroll
  for (int i = 0; i < 3; ++i) { const int c = tid + 512 * i, row = c / 24, cc = c % 24; kst[i] = KSWZ(row, cc * 16); }
  const int vb0 = (int)(uintptr_t)V_lds + v_rd_base(lane);
  struct { bf16x8 vs0, vs1, ks0, ks1, ks2; } sr_[1];
#define SLOAD(i, k0) do { const bf16_t* vt = Vh + (long)(k0) * DV; const bf16_t* kt = Kh + (long)(k0) * DQK; \
    sr_[i].vs0 = *reinterpret_cast<const bf16x8*>(vt + (sr) * DV + sc); sr_[i].vs1 = *reinterpret_cast<const bf16x8*>(vt + (32 + sr) * DV + sc); \
    sr_[i].ks0 = *reinterpret_cast<const bf16x8*>(kt + tid * 8); sr_[i].ks1 = *reinterpret_cast<const bf16x8*>(kt + (tid + 512) * 8); sr_[i].ks2 = *reinterpret_cast<const bf16x8*>(kt + (tid + 1024) * 8); } while (0)
#define SWRITE(b, i) do { *(bf16x8*)(V_lds + (b) * SHM_V + vst0) = sr_[i].vs0; *(bf16x8*)(V_lds + (b) * SHM_V + vst1) = sr_[i].vs1; \
    *(bf16x8*)(K_lds + (b) * SHM_K + kst[0]) = sr_[i].ks0; *(bf16x8*)(K_lds + (b) * SHM_K + kst[1]) = sr_[i].ks1; *(bf16x8*)(K_lds + (b) * SHM_K + kst[2]) = sr_[i].ks2; } while (0)
#define SWAIT() asm volatile("s_waitcnt vmcnt(5)" ::: "memory")
#define RESC(a) do { if (__any((a) < 1.f)) { if (hi == 0) al_l[r32] = (a); asm volatile("s_waitcnt lgkmcnt(0)" ::: "memory"); \
    _Pragma("unroll") for (int d = 0; d < 4; ++d) _Pragma("unroll") for (int r = 0; r < 16; ++r) o[d][r] *= al_l[crow(r, hi)]; } } while (0)
  f32x16 pA0, pA1; float mnA, alA; bf16x8 pa0, pa1, pa2, pa3; const int NT = seq / KVBLK;
  SLOAD(0, 0); SWRITE(0, 0);
  SLOAD(0, KVBLK);
  __syncthreads();
  for (int j = 0; j < NT; j += 2) {
    SBAR(); qkt(pA0, pA1, K_lds, qr, r32, hi);
    partialSM(pA0, pA1, m_reg, mnA, alA); RESC(alA);
    finishSM(pA0, pA1, alA, l_reg, pa0, pa1, pa2, pa3); SBAR();
    SWRITE(1, 0);
    if (j + 2 < NT) SLOAD(0, (j + 2) * KVBLK);
    SBAR();
    pv_d0(o, vb0, pa0, pa1, pa2, pa3);
    __syncthreads();
    SBAR(); qkt(pA0, pA1, K_lds + SHM_K, qr, r32, hi);
    partialSM(pA0, pA1, m_reg, mnA, alA); RESC(alA);
    finishSM(pA0, pA1, alA, l_reg, pa0, pa1, pa2, pa3); SBAR();
    if (j + 2 < NT) { SWRITE(0, 0); if (j + 3 < NT) SLOAD(0, (j + 3) * KVBLK); }
    SBAR();
    pv_d0(o, vb0 + SHM_V, pa0, pa1, pa2, pa3);
    __syncthreads();
  }
  if (hi == 0) li_l[r32] = l_reg; asm volatile("s_waitcnt lgkmcnt(0)" ::: "memory");
  float rli[16];
#pragma unroll
  for (int r = 0; r < 16; ++r) rli[r] = __builtin_amdgcn_rcpf(li_l[crow(r, hi)]);
  bf16_t* Ow = Ob + (long)(wid * 32) * ldo;
#pragma unroll
  for (int r = 0; r < 16; ++r) { int orow = crow(r, hi);
#pragma unroll
    for (int d0 = 0; d0 < 4; ++d0) Ow[(long)orow * ldo + d0 * 32 + r32] = f2bf(o[d0][r] * rli[r]); }
  __syncthreads();
#undef SLOAD
#undef SWRITE
#undef SWAIT
#undef RESC
}
#undef KSWZ
}

__device__ void ph_attn(const Params& p, char* lds) {
    const bf16_t* Q = (const bf16_t*)(p.ws + OFF_Q); const bf16_t* K = (const bf16_t*)(p.ws + OFF_K); const bf16_t* V = (const bf16_t*)(p.ws + OFF_V);
    bf16_t* O = (bf16_t*)(p.ws + OFF_O);
    const int G = gdim();
    for (int i = 0;; ++i) {
        const int L = i * G + bidx(); if (L >= 544) break;
        int bh, qb;
        if (L < 512) { const int w = g8::xcd_remap(L, 512); bh = w >> 4; qb = 1 + (w & 15); } else { bh = L - 512; qb = 0; }
        const int b = bh >> 3, h = bh & 7;
        const int seq = qb == 0 ? TC : TK;
        const int row0 = qb == 0 ? NLAT + b * TC : b * TL + (qb - 1) * 256;
        fa::attn_body(p.wv, Q + ((size_t)bh * TK + qb * 256) * 192, K + (size_t)bh * TK * 192, V + (size_t)bh * TK * 128, O + (size_t)row0 * D + h * 128, D, seq, lds,
                      qb == 0 ? nullptr : (const float*)(p.ws + OFF_ROPE_C) + (size_t)(qb - 1) * 256 * 64);
    }
}

__device__ void ph_norm2_router(const Params& p, int layer, char* lds, int nrows) {
    const int tid = tidx(), wid = tid >> 6, lane = tid & 63;
    float* rt = (float*)lds;
    const float* rg = p.moe_router + (size_t)layer * D * NE;
    for (int i = tid; i < D * NE / 4; i += NTHR) { const int d = i >> 2, eq = i & 3; ((float4*)rt)[(((d >> 8) * 4 + (d & 3)) * 4 + eq) * 64 + ((d & 255) >> 2)] = ((const float4*)rg)[i]; }
    __syncthreads();
    const xt_t* X = (const xt_t*)(p.ws + OFF_X); bf16_t* BN = (bf16_t*)(p.ws + OFF_H); float* AFF = (float*)(p.ws + OFF_AFF);
    const float* g = p.norm2_g + layer * D;
    int row = bidx() * 8 + wid;
    float4 nv[4];
    if (row < nrows) {
#pragma unroll
        for (int i = 0; i < 4; ++i) nv[i] = xld(X, (size_t)row * D + (lane + i * 64) * 4); }
    for (; row < nrows; row += gdim() * 8) {
        const int s = row_stream(row);
        const float* sh = modp(p, layer, s, 3); const float* sc = modp(p, layer, s, 4);
        float4 v[4]; float ss = 0;
#pragma unroll
        for (int i = 0; i < 4; ++i) { v[i] = nv[i]; ss += v[i].x * v[i].x + v[i].y * v[i].y + v[i].z * v[i].z + v[i].w * v[i].w; }
        { const int nrow = row + gdim() * 8;
          if (nrow < nrows) {
#pragma unroll
              for (int i = 0; i < 4; ++i) nv[i] = xld(X, (size_t)nrow * D + (lane + i * 64) * 4); } }
        ss = wave_sum(ss); const float rs = rsqrtf(ss * (1.f / D) + RMS_EPS);
        float lg[16];
#pragma unroll
        for (int e = 0; e < 16; ++e) lg[e] = 0.f;
#pragma unroll
        for (int i = 0; i < 4; ++i) {
            const int d = (lane + i * 64) * 4;
            const float4 gg = *(const float4*)(g + d), a = *(const float4*)(sc + d), b = *(const float4*)(sh + d);
            float o[4]; o[0] = v[i].x * rs * gg.x * (1.f + a.x) + b.x; o[1] = v[i].y * rs * gg.y * (1.f + a.y) + b.y; o[2] = v[i].z * rs * gg.z * (1.f + a.z) + b.z; o[3] = v[i].w * rs * gg.w * (1.f + a.w) + b.w;
            uint2 w; w.x = pk2(o[0], o[1]); w.y = pk2(o[2], o[3]); *(uint2*)(BN + (size_t)row * D + d) = w;
#pragma unroll
            for (int jj = 0; jj < 4; ++jj) {
#pragma unroll
                for (int eq = 0; eq < 4; ++eq) { const float4 r4 = ((const float4*)rt)[((i * 4 + jj) * 4 + eq) * 64 + lane];
                    lg[4 * eq] += o[jj] * r4.x; lg[4 * eq + 1] += o[jj] * r4.y; lg[4 * eq + 2] += o[jj] * r4.z; lg[4 * eq + 3] += o[jj] * r4.w; } }
            asm volatile("" ::: "memory");
        }
        float mx = -1e30f;
#pragma unroll
        for (int e = 0; e < 16; ++e) { lg[e] = wave_sum(lg[e]); mx = fmaxf(mx, lg[e]); }
        float sum = 0;
#pragma unroll
        for (int e = 0; e < 16; ++e) { lg[e] = expf(lg[e] - mx); sum += lg[e]; }
        const float inv = 1.f / sum;
        if (lane < 16) { float val = 0;
#pragma unroll
            for (int e = 0; e < 16; ++e) val = (lane == e) ? lg[e] : val;
            AFF[(size_t)row * 16 + lane] = val * inv; }
    }
}

__device__ void ph_select(const Params& p, char* lds, int ngroups) {
    const int tid = tidx(), wid = tid >> 6, lane = tid & 63;
    unsigned* hist = (unsigned*)lds;
    unsigned* ctl = hist + 256;
    unsigned* wsum = ctl + 8;
    int* rowl = (int*)(wsum + 16);
    const float* AFF = (const float*)(p.ws + OFF_AFF);
    int* ROWIDX = (int*)(p.ws + OFF_ROWIDX); float* GATE = (float*)(p.ws + OFF_GATE); int* SLOT = (int*)(p.ws + OFF_SLOT);
    for (int gidx = bidx(); gidx < ngroups; gidx += gdim()) {
        const bool lat = gidx < 64; const int b = (gidx & 63) >> 4, e = gidx & 15;
        const int n = lat ? TL : TC, cap = lat ? CAPL : CAPC;
        const int row0 = lat ? b * TL : NLAT + b * TC, slot0 = lat ? b * CAPL : NB * CAPL + b * CAPC;
        unsigned key[8];
#pragma unroll
        for (int i = 0; i < 8; ++i) { const int idx = tid * 8 + i; key[i] = idx < n ? __float_as_uint(AFF[(size_t)(row0 + idx) * 16 + e]) : 0u; }
        unsigned prefix = 0u, remaining = (unsigned)cap;
#pragma unroll
        for (int pass = 0; pass < 4; ++pass) {
            const int sh = 24 - 8 * pass;
            __syncthreads();
            if (tid < 256) hist[tid] = 0u;
            __syncthreads();
#pragma unroll
            for (int i = 0; i < 8; ++i) { const int idx = tid * 8 + i;
                const bool cand = idx < n && (pass == 0 || (key[i] >> (sh + 8)) == prefix);
                if (cand) atomicAdd(&hist[(key[i] >> sh) & 255u], 1u); }
            __syncthreads();
            if (tid < 256) { unsigned gt = 0; for (int jj = tid + 1; jj < 256; ++jj) gt += hist[jj];
                const unsigned mine = hist[tid];
                if (gt < remaining && remaining <= gt + mine) { ctl[0] = (unsigned)tid; ctl[1] = remaining - gt; } }
            __syncthreads();
            prefix = (prefix << 8) | ctl[0]; remaining = ctl[1];
        }
        const unsigned T = prefix, m = remaining;
        unsigned cgt = 0, ceq = 0;
#pragma unroll
        for (int i = 0; i < 8; ++i) { const int idx = tid * 8 + i; if (idx < n) { cgt += key[i] > T ? 1u : 0u; ceq += key[i] == T ? 1u : 0u; } }
        auto block_excl = [&](unsigned v) -> unsigned {
            unsigned inc = v;
#pragma unroll
            for (int o = 1; o < 64; o <<= 1) { const unsigned t = (unsigned)__builtin_amdgcn_ds_bpermute((lane - o) << 2, (int)inc); if (lane >= o) inc += t; }
            __syncthreads();
            if (lane == 63) wsum[wid] = inc;
            __syncthreads();
            unsigned base = 0;
#pragma unroll
            for (int w = 0; w < 8; ++w) base += (w < wid) ? wsum[w] : 0u;
            return base + inc - v; };
        unsigned eqbase = block_excl(ceq);
        unsigned nsel = 0; bool sel[8];
#pragma unroll
        for (int i = 0; i < 8; ++i) { const int idx = tid * 8 + i; bool s_ = false;
            if (idx < n) { if (key[i] > T) s_ = true; else if (key[i] == T) { s_ = eqbase < m; ++eqbase; } }
            sel[i] = s_; nsel += s_ ? 1u : 0u; }
        unsigned sbase = block_excl(nsel);
#pragma unroll
        for (int i = 0; i < 8; ++i) { const int idx = tid * 8 + i;
            if (idx < n) {
                if (sel[i]) { const int sl = slot0 + (int)sbase; rowl[sbase] = row0 + idx; ++sbase; ROWIDX[e * ESLOTS + sl] = row0 + idx; GATE[e * EPAD + sl] = __uint_as_float(key[i]); SLOT[(size_t)(row0 + idx) * 16 + e] = sl; }
                else SLOT[(size_t)(row0 + idx) * 16 + e] = -1; } }
        __syncthreads();
        { const bf16_t* BN = (const bf16_t*)(p.ws + OFF_H); bf16_t* XE = (bf16_t*)(p.ws + OFF_XE);
          for (int r = wid; r < cap; r += 32) {
              u32x4 t_[4][2];
#pragma unroll
              for (int u = 0; u < 4; ++u) { const u32x4* src = (const u32x4*)(BN + (size_t)rowl[r + 8 * u] * D); t_[u][0] = src[lane]; t_[u][1] = src[lane + 64]; }
#pragma unroll
              for (int u = 0; u < 4; ++u) { u32x4* dst = (u32x4*)(XE + ((size_t)e * EPAD + slot0 + r + 8 * u) * D); dst[lane] = t_[u][0]; dst[lane + 64] = t_[u][1]; } } }
    }
}

__device__ void ph_gather(const Params& p, int nslots) {
    const int wid = tidx() >> 6, lane = tidx() & 63;
    const int* ROWIDX = (const int*)(p.ws + OFF_ROWIDX); const bf16_t* BN = (const bf16_t*)(p.ws + OFF_H); bf16_t* XE = (bf16_t*)(p.ws + OFF_XE);
    for (int it = bidx() * 8 + wid; it < NE * ESLOTS; it += gdim() * 8) {
        const int e = it / ESLOTS, sl = it % ESLOTS; if (sl >= nslots) continue; const int row = ROWIDX[it];
        const u32x4* src = (const u32x4*)(BN + (size_t)row * D); u32x4* dst = (u32x4*)(XE + ((size_t)e * EPAD + sl) * D);
        dst[lane] = src[lane]; dst[lane + 64] = src[lane + 64];
    }
}

__device__ void ph_combine(const Params& p, int layer, int nrows) {
    const int wid = tidx() >> 6, lane = tidx() & 63;
    const int* SLOT = (const int*)(p.ws + OFF_SLOT); const bf16_t* YE = (const bf16_t*)(p.ws + OFF_YE); xt_t* X = (xt_t*)(p.ws + OFF_X);
    int row = bidx() * 8 + wid;
    int sl = (row < nrows && lane < 16) ? SLOT[(size_t)row * 16 + lane] : -1;
    while (row < nrows) {
        const int nrow = row + gdim() * 8;
        const int sln = (nrow < nrows && lane < 16) ? SLOT[(size_t)nrow * 16 + lane] : -1;
        const float* gt = modp(p, layer, row_stream(row), 5);
        xt_t* xr = X + (size_t)row * D + lane * 8;
        f32x4 xv[4];
#pragma unroll
        for (int i = 0; i < 2; ++i) { xv[2 * i] = xldv(xr, 512 * i); xv[2 * i + 1] = xldv(xr, 512 * i + 4); }
        unsigned long long m = __ballot(sl >= 0);
        float acc[16];
#pragma unroll
        for (int i = 0; i < 16; ++i) acc[i] = 0.f;
        while (m) {
            const int e0 = __builtin_ctzll(m); m &= m - 1; const bool two = m != 0; const int e1 = two ? __builtin_ctzll(m) : e0; if (two) m &= m - 1;
            const int s0 = __builtin_amdgcn_readlane(sl, e0), s1 = __builtin_amdgcn_readlane(sl, e1);
            const bf16_t* y0 = YE + ((size_t)e0 * EPAD + s0) * D + lane * 8; const bf16_t* y1 = YE + ((size_t)e1 * EPAD + s1) * D + lane * 8;
            const u32x4 a0 = *(const u32x4*)y0, a1 = *(const u32x4*)(y0 + 512), b0 = *(const u32x4*)y1, b1 = *(const u32x4*)(y1 + 512);
            const float f1 = two ? 1.f : 0.f;
#pragma unroll
            for (int i = 0; i < 4; ++i) { acc[2 * i] += __uint_as_float(a0[i] << 16) + f1 * __uint_as_float(b0[i] << 16); acc[2 * i + 1] += __uint_as_float(a0[i] & 0xffff0000u) + f1 * __uint_as_float(b0[i] & 0xffff0000u);
                acc[8 + 2 * i] += __uint_as_float(a1[i] << 16) + f1 * __uint_as_float(b1[i] << 16); acc[8 + 2 * i + 1] += __uint_as_float(a1[i] & 0xffff0000u) + f1 * __uint_as_float(b1[i] & 0xffff0000u); }
        }
#pragma unroll
        for (int i = 0; i < 2; ++i) { const f32x4 g0 = *(const f32x4*)(gt + lane * 8 + 512 * i), g1 = *(const f32x4*)(gt + lane * 8 + 512 * i + 4);
            f32x4 o0 = xv[2 * i], o1 = xv[2 * i + 1];
#pragma unroll
            for (int e = 0; e < 4; ++e) { o0[e] += g0[e] * acc[8 * i + e]; o1[e] += g1[e] * acc[8 * i + 4 + e]; }
            xstv(xr, 512 * i, o0); xstv(xr, 512 * i + 4, o1); }
        row = nrow; sl = sln;
    }
}

template <bool FINAL>
__device__ void ph_comb_norm(const Params& p, int lprev, int layer, int nrows) {
    const int wid = tidx() >> 6, lane = tidx() & 63;
    const int* SLOT = (const int*)(p.ws + OFF_SLOT); const bf16_t* YE = (const bf16_t*)(p.ws + OFF_YE); xt_t* X = (xt_t*)(p.ws + OFF_X);
    bf16_t* H = (bf16_t*)(p.ws + OFF_H);
    const float* g = FINAL ? p.final_g : p.norm1_g + layer * D;
    int row = bidx() * 8 + wid;
    int sl = (row < nrows && lane < 16) ? SLOT[(size_t)row * 16 + lane] : -1;
    while (row < nrows) {
        const int nrow = row + gdim() * 8;
        const int sln = (nrow < nrows && lane < 16) ? SLOT[(size_t)nrow * 16 + lane] : -1;
        const int strm = row_stream(row);
        const float* gt = modp(p, lprev, strm, 5);
        xt_t* xr = X + (size_t)row * D + lane * 8;
        f32x4 xv[4];
#pragma unroll
        for (int i = 0; i < 2; ++i) { xv[2 * i] = xldv(xr, 512 * i); xv[2 * i + 1] = xldv(xr, 512 * i + 4); }
        unsigned long long m = __ballot(sl >= 0);
        float acc[16];
#pragma unroll
        for (int i = 0; i < 16; ++i) acc[i] = 0.f;
        while (m) {
            const int e0 = __builtin_ctzll(m); m &= m - 1; const bool two = m != 0; const int e1 = two ? __builtin_ctzll(m) : e0; if (two) m &= m - 1;
            const int s0 = __builtin_amdgcn_readlane(sl, e0), s1 = __builtin_amdgcn_readlane(sl, e1);
            const bf16_t* y0 = YE + ((size_t)e0 * EPAD + s0) * D + lane * 8; const bf16_t* y1 = YE + ((size_t)e1 * EPAD + s1) * D + lane * 8;
            const u32x4 a0 = *(const u32x4*)y0, a1 = *(const u32x4*)(y0 + 512), b0 = *(const u32x4*)y1, b1 = *(const u32x4*)(y1 + 512);
            const float f1 = two ? 1.f : 0.f;
#pragma unroll
            for (int i = 0; i < 4; ++i) { acc[2 * i] += __uint_as_float(a0[i] << 16) + f1 * __uint_as_float(b0[i] << 16); acc[2 * i + 1] += __uint_as_float(a0[i] & 0xffff0000u) + f1 * __uint_as_float(b0[i] & 0xffff0000u);
                acc[8 + 2 * i] += __uint_as_float(a1[i] << 16) + f1 * __uint_as_float(b1[i] << 16); acc[8 + 2 * i + 1] += __uint_as_float(a1[i] & 0xffff0000u) + f1 * __uint_as_float(b1[i] & 0xffff0000u); }
        }
        float ss = 0.f;
#pragma unroll
        for (int i = 0; i < 2; ++i) { const f32x4 g0 = *(const f32x4*)(gt + lane * 8 + 512 * i), g1 = *(const f32x4*)(gt + lane * 8 + 512 * i + 4);
#pragma unroll
            for (int e = 0; e < 4; ++e) { xv[2 * i][e] += g0[e] * acc[8 * i + e]; xv[2 * i + 1][e] += g1[e] * acc[8 * i + 4 + e]; ss += xv[2 * i][e] * xv[2 * i][e] + xv[2 * i + 1][e] * xv[2 * i + 1][e]; }
            if (!FINAL) { xstv(xr, 512 * i, xv[2 * i]); xstv(xr, 512 * i + 4, xv[2 * i + 1]); } }
        ss = wave_sum(ss); const float rs = rsqrtf(ss * (1.f / D) + RMS_EPS);
        const float* sh = FINAL ? nullptr : modp(p, layer, strm, 0); const float* sc = FINAL ? nullptr : modp(p, layer, strm, 1);
#pragma unroll
        for (int i = 0; i < 2; ++i)
#pragma unroll
            for (int hh = 0; hh < 2; ++hh) { const int d = lane * 8 + 512 * i + 4 * hh; const f32x4 gg = *(const f32x4*)(g + d); f32x4 o = xv[2 * i + hh] * rs * gg;
                if (FINAL) *(f32x4*)(p.out + (size_t)row * D + d) = o;
                else { o = o * (1.f + *(const f32x4*)(sc + d)) + *(const f32x4*)(sh + d); stbf4(H + (size_t)row * D + d, o); } }
        row = nrow; sl = sln;
    }
}

__device__ void ph_rw_normxs(const Params& p, int layer, int j) {
    const int wid = tidx() >> 6, lane = tidx() & 63;
    const xt_t* X = (const xt_t*)(p.ws + OFF_X); bf16_t* XS = (bf16_t*)(p.ws + OFF_XS);
    const float* mu = p.rw_mu + (size_t)j * 6 * D; const float* g = p.norm1_g + layer * D;
    float4 fc[4], fp[4], fn[4];
#define XS_LOAD(R) do { const bool lat_ = (R) < NLAT; const int t_ = lat_ ? ((R) & (TL - 1)) : (((R) - NLAT) & (TC - 1)); const int len_ = lat_ ? TL : TC; \
        _Pragma("unroll") for (int i = 0; i < 4; ++i) { fc[i] = xld(X, (size_t)(R) * D + (lane + i * 64) * 4); \
            fp[i] = t_ > 0 ? xld(X, (size_t)((R) - 1) * D + (lane + i * 64) * 4) : make_float4(0, 0, 0, 0); \
            fn[i] = t_ < len_ - 1 ? xld(X, (size_t)((R) + 1) * D + (lane + i * 64) * 4) : make_float4(0, 0, 0, 0); } } while (0)
    int row = bidx() * 8 + wid;
    if (row < NROW) XS_LOAD(row);
    for (; row < NROW; row += gdim() * 8) {
        const int s_ = row_stream(row);
        const float* sh = modp(p, layer, s_, 0); const float* sc = modp(p, layer, s_, 1);
        const bool lat = row < NLAT; const int t = lat ? (row & (TL - 1)) : ((row - NLAT) & (TC - 1)); const int len = lat ? TL : TC;
        const bool hp = t > 0, hn = t < len - 1;
        float4 xc[4], xp[4], xn[4]; float sc_ = 0, sp_ = 0, sn_ = 0;
#pragma unroll
        for (int i = 0; i < 4; ++i) { xc[i] = fc[i]; xp[i] = fp[i]; xn[i] = fn[i]; }
        { const int nrow = row + gdim() * 8; if (nrow < NROW) XS_LOAD(nrow); }
#pragma unroll
        for (int i = 0; i < 4; ++i) {
            sc_ += xc[i].x * xc[i].x + xc[i].y * xc[i].y + xc[i].z * xc[i].z + xc[i].w * xc[i].w;
            sp_ += xp[i].x * xp[i].x + xp[i].y * xp[i].y + xp[i].z * xp[i].z + xp[i].w * xp[i].w;
            sn_ += xn[i].x * xn[i].x + xn[i].y * xn[i].y + xn[i].z * xn[i].z + xn[i].w * xn[i].w; }
        sc_ = wave_sum(sc_); sp_ = wave_sum(sp_); sn_ = wave_sum(sn_);
        const float rc = rsqrtf(sc_ * (1.f / D) + RMS_EPS), rp = hp ? rsqrtf(sp_ * (1.f / D) + RMS_EPS) : 0.f, rn = hn ? rsqrtf(sn_ * (1.f / D) + RMS_EPS) : 0.f;
#pragma unroll
        for (int i = 0; i < 4; ++i) {
            const int d = (lane + i * 64) * 4;
            const float4 gg = *(const float4*)(g + d), a = *(const float4*)(sc + d), bsh = *(const float4*)(sh + d);
            float h[4], xx[4];
            const float gm[4] = {gg.x * (1.f + a.x), gg.y * (1.f + a.y), gg.z * (1.f + a.z), gg.w * (1.f + a.w)}; const float bb[4] = {bsh.x, bsh.y, bsh.z, bsh.w};
            const float c4[4] = {xc[i].x, xc[i].y, xc[i].z, xc[i].w}, p4[4] = {xp[i].x, xp[i].y, xp[i].z, xp[i].w}, n4[4] = {xn[i].x, xn[i].y, xn[i].z, xn[i].w};
#pragma unroll
            for (int e = 0; e < 4; ++e) { h[e] = c4[e] * rc * gm[e] + bb[e];
                const float hpv = hp ? p4[e] * rp * gm[e] + bb[e] : 0.f, hnv = hn ? n4[e] * rn * gm[e] + bb[e] : 0.f;
                xx[e] = 0.5f * (hpv + hnv) - h[e]; }
#pragma unroll
            for (int m = 0; m < 6; ++m) { const float4 u = *(const float4*)(mu + m * D + d);
                uint2 w; w.x = pk2(h[0] + xx[0] * u.x, h[1] + xx[1] * u.y); w.y = pk2(h[2] + xx[2] * u.z, h[3] + xx[3] * u.w);
                *(uint2*)(XS + ((size_t)m * NROW + row) * D + d) = w; }
        }
    }
#undef XS_LOAD
}

__device__ __forceinline__ int scan_row(int i, int b, int z) {
    return i < TC ? NLAT + b * TC + (z ? TC - 1 - i : i) : b * TL + (z ? TL - 1 - (i - TC) : i - TC);
}
__device__ __forceinline__ float dpp_sum8(float x) {
    x += __builtin_bit_cast(float, __builtin_amdgcn_update_dpp(0, __builtin_bit_cast(int, x), 0xB1, 0xF, 0xF, true));
    x += __builtin_bit_cast(float, __builtin_amdgcn_update_dpp(0, __builtin_bit_cast(int, x), 0x4E, 0xF, 0xF, true));
    x += __builtin_bit_cast(float, __builtin_amdgcn_update_dpp(0, __builtin_bit_cast(int, x), 0x141, 0xF, 0xF, true));
    return x;
}
__device__ void ph_rw_scan(const Params& p, int j, char* lds) {
    const int tid = tidx(), wid = __builtin_amdgcn_readfirstlane(tid >> 6), lane = tid & 63;
    const size_t PL = (size_t)NROW * D;
    const float* RKV = (const float*)(p.ws + OFF_RKV); float* Y = (float*)(p.ws + OFF_Y);
    constexpr int CH = 32, BUFB = 5 * CH * 256 + CH * 128 + CH * 16, YB = CH * 32 * 4, NCH = (TC + TL) / CH;
    const bool loader = wid >= 4; const int lw = wid - 4;
    for (int it = bidx(); it < 256; it += gdim()) {
        const int vh = it & 1, z = (it >> 1) & 1, h = (it >> 2) & 15, b = it >> 6;
        const char* pl0 = (const char*)((const float*)(p.ws + OFF_W) + z * PL); const char* pl1 = (const char*)(RKV + PL);
        const char* pl2 = (const char*)((const float*)(p.ws + OFF_AV) + z * PL); const char* pl3 = (const char*)RKV;
        const char* vpl = (const char*)(RKV + 2 * PL);
        float* yout = Y + z * PL;
        __builtin_amdgcn_s_barrier();
        if (loader) {
            const int pq = lane & 15;
            const f32x4 kkv = *(const f32x4*)(p.rw_k_k + j * D + h * 64 + pq * 4), kav = *(const f32x4*)(p.rw_k_a + j * D + h * 64 + pq * 4);
            auto issue = [&](int c) {
                char* buf = lds + (c % 3) * BUFB;
#pragma unroll
                for (int q = 0; q < 8; ++q) { const int pi = q >> 1, tg = lw * 2 + (q & 1); const int row = scan_row(c * CH + tg * 4 + (lane >> 4), b, z);
                    const char* base = pi == 0 ? pl0 : pi == 1 ? pl1 : pi == 2 ? pl2 : pl3;
                    __builtin_amdgcn_global_load_lds((const unsigned*)(base + (size_t)row * D * 4 + h * 256 + (lane & 15) * 16), (LAS unsigned*)(buf + pi * (CH * 256) + tg * 1024), 16, 0, 0); }
                { const int row = scan_row(c * CH + lw * 8 + (lane >> 3), b, z);
                  __builtin_amdgcn_global_load_lds((const unsigned*)(vpl + (size_t)row * D * 4 + (h * 64 + vh * 32) * 4 + (lane & 7) * 16), (LAS unsigned*)(buf + 5 * CH * 256 + lw * 1024), 16, 0, 0); }
            };
            auto prep = [&](int c) {
                char* buf = lds + (c % 3) * BUFB;
#pragma unroll
                for (int ps = 0; ps < 2; ++ps) { const int ptok = lw * 8 + ps * 4 + (lane >> 4);
                    f32x4* kp = (f32x4*)(buf + 1 * CH * 256 + ptok * 256 + pq * 16); f32x4* ap = (f32x4*)(buf + 2 * CH * 256 + ptok * 256 + pq * 16); f32x4* dp = (f32x4*)(buf + 4 * CH * 256 + ptok * 256 + pq * 16);
                    f32x4* rp = (f32x4*)(buf + 3 * CH * 256 + ptok * 256 + pq * 16); const f32x4 wv = *(const f32x4*)(buf + ptok * 256 + pq * 16);
                    const f32x4 k = *kp, a = *ap, r = *rp; f32x4 kk = k * kkv;
                    float ss = kk[0] * kk[0] + kk[1] * kk[1] + kk[2] * kk[2] + kk[3] * kk[3]; ss = dpp_sum16(ss);
                    const float inv = 1.f / fmaxf(sqrtf(ss), 1e-12f); kk = kk * inv;
                    const f32x4 kd = k * (1.f + (a - 1.f) * kav), bb = kk * a;
                    const f32x4 t1 = bb * r, t2 = kd * r;
                    const float br = dpp_sum16((t1[0] + t1[1]) + (t1[2] + t1[3])), kr = dpp_sum16((t2[0] + t2[1]) + (t2[2] + t2[3]));
                    *dp = kd; *ap = bb; *kp = kk; *rp = wv * r;
                    if (pq == 0) *(float2*)(buf + 5 * CH * 256 + CH * 128 + ptok * 16) = make_float2(br, kr); }
            };
            issue(0); issue(1);
            asm volatile("s_waitcnt vmcnt(9)" ::: "memory");
            prep(0);
            asm volatile("s_waitcnt lgkmcnt(0)" ::: "memory"); __builtin_amdgcn_s_barrier();
            for (int c = 0; c < NCH; ++c) {
                if (c >= 1) { const float* yb = (const float*)(lds + 3 * BUFB + ((c - 1) & 1) * YB);
                    const int lt = tid - 256, t = lt >> 3, q = lt & 7; const int row = scan_row((c - 1) * CH + t, b, z);
                    *(f32x4*)(yout + (size_t)row * D + h * 64 + vh * 32 + q * 4) = *(const f32x4*)(yb + t * 32 + q * 4); }
                if (c + 2 < NCH) { issue(c + 2); asm volatile("s_waitcnt vmcnt(9)" ::: "memory"); } else asm volatile("s_waitcnt vmcnt(0)" ::: "memory");
                if (c + 1 < NCH) prep(c + 1);
                asm volatile("s_waitcnt lgkmcnt(0)" ::: "memory"); __builtin_amdgcn_s_barrier();
            }
            { const float* yb = (const float*)(lds + 3 * BUFB + ((NCH - 1) & 1) * YB);
              const int lt = tid - 256, t = lt >> 3, q = lt & 7; const int row = scan_row((NCH - 1) * CH + t, b, z);
              *(f32x4*)(yout + (size_t)row * D + h * 64 + vh * 32 + q * 4) = *(const f32x4*)(yb + t * 32 + q * 4); }
        } else {
            const int vr = lane >> 3, ks = lane & 7;
            f32x4 Sa = {0.f, 0.f, 0.f, 0.f}, Sb = {0.f, 0.f, 0.f, 0.f};
            __builtin_amdgcn_s_barrier();
            struct Ops { f32x4 w0, w1, kk0, kk1, bb0, bb1, r0, r1, kd0, kd1; float v; float2 sc; };
#define SC_LOAD(O, t) do { const char* q_ = bq + (t) * 256; O.w0 = *(const f32x4*)(q_); O.w1 = *(const f32x4*)(q_ + 16); O.kk0 = *(const f32x4*)(q_ + CH * 256); O.kk1 = *(const f32x4*)(q_ + CH * 256 + 16); \
                O.bb0 = *(const f32x4*)(q_ + 2 * CH * 256); O.bb1 = *(const f32x4*)(q_ + 2 * CH * 256 + 16); O.r0 = *(const f32x4*)(q_ + 3 * CH * 256); O.r1 = *(const f32x4*)(q_ + 3 * CH * 256 + 16); \
                O.kd0 = *(const f32x4*)(q_ + 4 * CH * 256); O.kd1 = *(const f32x4*)(q_ + 4 * CH * 256 + 16); O.v = *(const float*)(vq + (t) * 128); O.sc = *(const float2*)(buf + 5 * CH * 256 + CH * 128 + (t) * 16); } while (0)
#define SC_STEP(O, t) do { const f32x4 d1 = Sa * O.kk0 + Sb * O.kk1, d2 = Sa * O.r0 + Sb * O.r1; \
                float sa = -((d1[0] + d1[1]) + (d1[2] + d1[3])), yy = (d2[0] + d2[1]) + (d2[2] + d2[3]); \
                sa = dpp_sum8(sa); yy = dpp_sum8(yy); \
                Sa = Sa * O.w0 + (sa * O.bb0 + O.v * O.kd0); Sb = Sb * O.w1 + (sa * O.bb1 + O.v * O.kd1); \
                if (ks == 0) yb[(t) * 32 + wid * 8 + vr] = yy + sa * O.sc.x + O.v * O.sc.y; } while (0)
            for (int c = 0; c < NCH; ++c) {
                const char* buf = lds + (c % 3) * BUFB; float* yb = (float*)(lds + 3 * BUFB + (c & 1) * YB);
                const char* bq = buf + ks * 32; const char* vq = buf + 5 * CH * 256 + (wid * 8 + vr) * 4;
                Ops oA, oB, oC;
                SC_LOAD(oA, 0); SC_LOAD(oB, 1);
#pragma unroll
                for (int t = 0; t < CH; t += 3) {
                    if (t + 2 < CH) SC_LOAD(oC, t + 2);
                    SC_STEP(oA, t);
                    if (t + 3 < CH) SC_LOAD(oA, t + 3);
                    if (t + 1 < CH) SC_STEP(oB, t + 1);
                    if (t + 4 < CH) SC_LOAD(oB, t + 4);
                    if (t + 2 < CH) SC_STEP(oC, t + 2);
                }
                asm volatile("s_waitcnt lgkmcnt(0)" ::: "memory"); __builtin_amdgcn_s_barrier();
            }
#undef SC_LOAD
#undef SC_STEP
        }
    }
}


namespace ck {
constexpr int P = 72, MB = 64 * P * 2;
typedef __attribute__((address_space(3))) char lchar;
__device__ __forceinline__ f32x4 mm_tile(const lchar* Aop, const lchar* Bop, int ti, int tj, int c, int q, f32x4 acc) {
#pragma unroll
    for (int ks = 0; ks < 2; ++ks) {
        const bf16x8 a = *(const LAS bf16x8*)(Aop + ((16 * ti + c) * P + 32 * ks + 8 * q) * 2);
        const bf16x8 b = *(const LAS bf16x8*)(Bop + ((16 * tj + c) * P + 32 * ks + 8 * q) * 2);
        acc = __builtin_amdgcn_mfma_f32_16x16x32_bf16(a, b, acc, 0, 0, 0);
    }
    return acc;
}
__device__ __forceinline__ f32x4 mm_diag(const lchar* Aop, const lchar* Bop, int tt, int c, int q, f32x4 acc) {
    const int ks = tt >> 1;
    bf16x8 a = *(const LAS bf16x8*)(Aop + ((16 * tt + c) * P + 32 * ks + 8 * q) * 2);
    const bf16x8 b = *(const LAS bf16x8*)(Bop + ((16 * tt + c) * P + 32 * ks + 8 * q) * 2);
    if ((q >> 1) != (tt & 1)) a = (bf16x8){0, 0, 0, 0, 0, 0, 0, 0};
    return __builtin_amdgcn_mfma_f32_16x16x32_bf16(a, b, acc, 0, 0, 0);
}
__device__ __forceinline__ void st_tile(lchar* dst, int ti, int tj, int c, int q, f32x4 v) {
    u32x2 w; w.x = pk2(v[0], v[1]); w.y = pk2(v[2], v[3]); *(LAS u32x2*)(dst + ((16 * tj + c) * P + 16 * ti + 4 * q) * 2) = w;
}
__device__ __forceinline__ f32x4 ld_tile(const lchar* src, int ti, int tj, int c, int q) {
    const u32x2 w = *(const LAS u32x2*)(src + ((16 * tj + c) * P + 16 * ti + 4 * q) * 2);
    return (f32x4){__uint_as_float(w.x << 16), __uint_as_float(w.x & 0xffff0000u), __uint_as_float(w.y << 16), __uint_as_float(w.y & 0xffff0000u)};
}
__device__ __forceinline__ void st_glob(bf16_t* dst, int ti, int tj, int c, int q, f32x4 v) {
    uint2 w; w.x = pk2(v[0], v[1]); w.y = pk2(v[2], v[3]); *(uint2*)(dst + (16 * tj + c) * 64 + 16 * ti + 4 * q) = w;
}
typedef float f32x16 __attribute__((ext_vector_type(16)));
__device__ __forceinline__ f32x16 mm32(const lchar* Aop, const lchar* Bop, int ti, int tj, int r32, int hi, f32x16 acc) {
#pragma unroll
    for (int ks = 0; ks < 4; ++ks) {
        const bf16x8 a = *(const LAS bf16x8*)(Aop + ((32 * ti + r32) * P + 16 * ks + 8 * hi) * 2);
        const bf16x8 b = *(const LAS bf16x8*)(Bop + ((32 * tj + r32) * P + 16 * ks + 8 * hi) * 2);
        acc = __builtin_amdgcn_mfma_f32_32x32x16_bf16(a, b, acc, 0, 0, 0);
    }
    return acc;
}
__device__ __forceinline__ void st32(lchar* dst, int ti, int tj, int r32, int hi, const f32x16& v) {
#pragma unroll
    for (int g = 0; g < 4; ++g) { u32x2 w; w.x = pk2(v[4 * g], v[4 * g + 1]); w.y = pk2(v[4 * g + 2], v[4 * g + 3]); *(LAS u32x2*)(dst + ((32 * tj + r32) * P + 32 * ti + 8 * g + 4 * hi) * 2) = w; }
}
__device__ __forceinline__ f32x16 ld32(const lchar* src, int ti, int tj, int r32, int hi) {
    f32x16 v;
#pragma unroll
    for (int g = 0; g < 4; ++g) { const u32x2 w = *(const LAS u32x2*)(src + ((32 * tj + r32) * P + 32 * ti + 8 * g + 4 * hi) * 2);
        v[4 * g] = __uint_as_float(w.x << 16); v[4 * g + 1] = __uint_as_float(w.x & 0xffff0000u); v[4 * g + 2] = __uint_as_float(w.y << 16); v[4 * g + 3] = __uint_as_float(w.y & 0xffff0000u); }
    return v;
}
__device__ __forceinline__ void stg32(bf16_t* dst, int ti, int tj, int r32, int hi, const f32x16& v) {
#pragma unroll
    for (int g = 0; g < 4; ++g) { uint2 w; w.x = pk2(v[4 * g], v[4 * g + 1]); w.y = pk2(v[4 * g + 2], v[4 * g + 3]); *(uint2*)(dst + (32 * tj + r32) * 64 + 32 * ti + 8 * g + 4 * hi) = w; }
}
}

#define LBAR() do { asm volatile("s_waitcnt lgkmcnt(0)" ::: "memory"); __builtin_amdgcn_s_barrier(); asm volatile("" ::: "memory"); } while (0)
__device__ void ph_rw_sc1(const Params& p, int j, char* lds) {
    using namespace ck;
    const int tid = tidx(), wid = __builtin_amdgcn_readfirstlane(tid >> 6), lane = tid & 63, c = lane & 15, q = lane >> 4;
    const size_t PL = (size_t)NROW * D;
    const bf16_t* RKV = (const bf16_t*)(p.ws + OFF_RKV); const float* LW = (const float*)(p.ws + OFF_W); const bf16_t* AV = (const bf16_t*)(p.ws + OFF_AV);
    bf16_t* CK = (bf16_t*)(p.ws + OFF_CK);
    lchar* B0 = (lchar*)lds;
#define BUF(i) (B0 + (i) * MB)
    LAS float* Lbuf = (LAS float*)BUF(8);
    LAS float* Lseg = (LAS float*)(B0 + 16 * MB);
    LAS float* GC = Lseg + 8 * 64;
    const int pt = tid >> 3, cg = tid & 7;
    f32x4 nlw[2], nkk[2], nka[2]; u32x4 nkx, nax, nrx, nvx;
#define SC1_LOAD(IT) do { const int seq_ = (IT) / NCHK, ch_ = (IT) % NCHK; const int z_ = seq_ & 1, h_ = (seq_ >> 1) & 15, b_ = seq_ >> 5; \
        const size_t go_ = (size_t)scan_row(ch_ * 64 + pt, b_, z_) * D + h_ * 64 + cg * 8; \
        _Pragma("unroll") for (int e = 0; e < 2; ++e) nlw[e] = *(const f32x4*)(LW + z_ * PL + go_ + 4 * e); \
        nkx = *(const u32x4*)(RKV + PL + go_); nax = *(const u32x4*)(AV + z_ * PL + go_); nrx = *(const u32x4*)(RKV + go_); nvx = *(const u32x4*)(RKV + 2 * PL + go_); \
        _Pragma("unroll") for (int e = 0; e < 2; ++e) { nkk[e] = *(const f32x4*)(p.rw_k_k + j * D + h_ * 64 + cg * 8 + 4 * e); nka[e] = *(const f32x4*)(p.rw_k_a + j * D + h_ * 64 + cg * 8 + 4 * e); } } while (0)
    if (bidx() < 128 * NCHK) SC1_LOAD(bidx());
    for (int it = bidx(); it < 128 * NCHK; it += gdim()) {
        const int seq = it / NCHK; const int h = (seq >> 1) & 15;
        f32x4 lw[2], kx[2], ax[2], rx[2], vx[2], kkc[2], kac[2];
#pragma unroll
        for (int e = 0; e < 2; ++e) { lw[e] = nlw[e]; kkc[e] = nkk[e]; kac[e] = nka[e];
            kx[e] = (f32x4){__uint_as_float(nkx[2 * e] << 16), __uint_as_float(nkx[2 * e] & 0xffff0000u), __uint_as_float(nkx[2 * e + 1] << 16), __uint_as_float(nkx[2 * e + 1] & 0xffff0000u)};
            ax[e] = (f32x4){__uint_as_float(nax[2 * e] << 16), __uint_as_float(nax[2 * e] & 0xffff0000u), __uint_as_float(nax[2 * e + 1] << 16), __uint_as_float(nax[2 * e + 1] & 0xffff0000u)};
            rx[e] = (f32x4){__uint_as_float(nrx[2 * e] << 16), __uint_as_float(nrx[2 * e] & 0xffff0000u), __uint_as_float(nrx[2 * e + 1] << 16), __uint_as_float(nrx[2 * e + 1] & 0xffff0000u)};
            vx[e] = (f32x4){__uint_as_float(nvx[2 * e] << 16), __uint_as_float(nvx[2 * e] & 0xffff0000u), __uint_as_float(nvx[2 * e + 1] << 16), __uint_as_float(nvx[2 * e + 1] & 0xffff0000u)}; }
        if (it + gdim() < 128 * NCHK) SC1_LOAD(it + gdim());
        LBAR();
#pragma unroll
        for (int e = 0; e < 2; ++e) *(LAS f32x4*)(Lbuf + pt * 64 + cg * 8 + 4 * e) = lw[e];
        f32x4 kk[2], bq[2], kd[2];
        { float ss = 0.f;
#pragma unroll
          for (int e = 0; e < 2; ++e) { kk[e] = kx[e] * kkc[e]; ss += kk[e][0] * kk[e][0] + kk[e][1] * kk[e][1] + kk[e][2] * kk[e][2] + kk[e][3] * kk[e][3]; }
          ss = dpp_sum8(ss); const float inv = __builtin_amdgcn_rsqf(fmaxf(ss, 1e-24f));
#pragma unroll
          for (int e = 0; e < 2; ++e) { kk[e] = kk[e] * inv; bq[e] = kk[e] * ax[e]; kd[e] = kx[e] * (1.f + (ax[e] - 1.f) * kac[e]); } }
        LBAR();
        { const int k = tid & 63, sg = tid >> 6; float run = 0.f;
#pragma unroll
          for (int u = 0; u < 8; ++u) { run += Lbuf[(sg * 8 + u) * 64 + k]; Lbuf[(sg * 8 + u) * 64 + k] = run; }
          Lseg[sg * 64 + k] = run; }
        LBAR();
        f32x4 Lt[2], Lp[2], Lc[2];
        { const int sg = pt >> 3, sgp = (pt - 1) >> 3;
#pragma unroll
          for (int e = 0; e < 2; ++e) { f32x4 o0 = {0.f, 0.f, 0.f, 0.f}, o1 = o0, oc = o0;
#pragma unroll
              for (int u = 0; u < 8; ++u) { const f32x4 sv = *(const LAS f32x4*)(Lseg + u * 64 + cg * 8 + 4 * e); if (u < sg) o0 = o0 + sv; if (u < sgp) o1 = o1 + sv; if (u < 7) oc = oc + sv; }
              Lt[e] = *(const LAS f32x4*)(Lbuf + pt * 64 + cg * 8 + 4 * e) + o0;
              Lp[e] = pt > 0 ? *(const LAS f32x4*)(Lbuf + (pt - 1) * 64 + cg * 8 + 4 * e) + o1 : (f32x4){0.f, 0.f, 0.f, 0.f};
              Lc[e] = *(const LAS f32x4*)(Lbuf + 63 * 64 + cg * 8 + 4 * e) + oc; } }
        LBAR();
        {
            float at[8], bt[8], kt[8], rt[8], bh[8], kh[8], vv[8];
#pragma unroll
            for (int e = 0; e < 2; ++e)
#pragma unroll
                for (int u = 0; u < 4; ++u) { const int x = 4 * e + u; const float eL = __expf(Lt[e][u]), emL = __expf(-Lt[e][u]), eP = __expf(Lp[e][u]), eC = __expf(Lc[e][u] - Lt[e][u]);
                    at[x] = -kk[e][u] * eP; bt[x] = bq[e][u] * emL; kt[x] = kd[e][u] * emL; rt[x] = rx[e][u] * eL; bh[x] = bq[e][u] * eC; kh[x] = kd[e][u] * eC; vv[x] = vx[e][u];
                    if (pt == 63) GC[cg * 8 + x] = eL; }
#define ST8(bufi, arr) do { u32x4 w_ = {pk2(arr[0], arr[1]), pk2(arr[2], arr[3]), pk2(arr[4], arr[5]), pk2(arr[6], arr[7])}; *(LAS u32x4*)(BUF(bufi) + (pt * P + cg * 8) * 2) = w_; } while (0)
            ST8(0, at); ST8(1, bt); ST8(2, kt); ST8(3, rt); ST8(8, bh); ST8(9, kh); ST8(10, vv);
#undef ST8
        }
        LBAR();
        {
            const int k = tid & 63, tg = tid >> 6;
#define TR8(src, dst) do { unsigned w_[4]; _Pragma("unroll") for (int x = 0; x < 4; ++x) { const unsigned lo = *(const LAS bf16_t*)(BUF(src) + ((tg * 8 + 2 * x) * P + k) * 2), hi2 = *(const LAS bf16_t*)(BUF(src) + ((tg * 8 + 2 * x + 1) * P + k) * 2); w_[x] = lo | (hi2 << 16); } \
                *(LAS u32x4*)(BUF(dst) + (k * P + tg * 8) * 2) = (u32x4){w_[0], w_[1], w_[2], w_[3]}; } while (0)
            TR8(0, 4); TR8(8, 5); TR8(9, 6); TR8(10, 7);
#undef TR8
        }
        LBAR();
        const f32x4 Z4 = {0.f, 0.f, 0.f, 0.f};
        const f32x16 Z16 = {0.f, 0.f, 0.f, 0.f, 0.f, 0.f, 0.f, 0.f, 0.f, 0.f, 0.f, 0.f, 0.f, 0.f, 0.f, 0.f};
        const int r32 = lane & 31, hi = lane >> 5;
#pragma unroll 1
        for (int u = 0; u < 3; ++u) { const int tl = u * 8 + wid; if (tl >= 20) break; const int m = tl >> 2, ti = (tl >> 1) & 1, tj = tl & 1; const int jj = 32 * tj + r32;
            if (m == 0) { f32x16 v = mm32(BUF(0), BUF(1), ti, tj, r32, hi, Z16), w;
#pragma unroll
                for (int e = 0; e < 16; ++e) { const int ii = 32 * ti + 8 * (e >> 2) + 4 * hi + (e & 3); const bool dg = (ii >> 4) == (jj >> 4);
                    v[e] = (dg && jj < ii) ? v[e] : 0.f; w[e] = v[e] + ((ii == jj) ? 1.f : 0.f); }
                st32(BUF(8), ti, tj, r32, hi, v); st32(BUF(14), ti, tj, r32, hi, w); }
            else if (m == 1) { const f32x16 v = mm32(BUF(1), BUF(0), ti, tj, r32, hi, Z16); f32x16 vd, vo, w;
#pragma unroll
                for (int e = 0; e < 16; ++e) { const int ii = 32 * ti + 8 * (e >> 2) + 4 * hi + (e & 3); const bool dg = (ii >> 4) == (jj >> 4), up = ii < jj;
                    vd[e] = (dg && up) ? v[e] : 0.f; vo[e] = (!dg && up) ? v[e] : 0.f; w[e] = vd[e] + ((ii == jj) ? 1.f : 0.f); }
                st32(BUF(9), ti, tj, r32, hi, vd); st32(BUF(15), ti, tj, r32, hi, vo); st32(BUF(13), ti, tj, r32, hi, w); }
            else if (m == 2) { f32x16 v = mm32(BUF(2), BUF(0), ti, tj, r32, hi, Z16);
#pragma unroll
                for (int e = 0; e < 16; ++e) { const int ii = 32 * ti + 8 * (e >> 2) + 4 * hi + (e & 3); v[e] = ii < jj ? v[e] : 0.f; }
                st32(BUF(10), ti, tj, r32, hi, v); }
            else { f32x16 v = mm32(m == 3 ? BUF(1) : BUF(2), BUF(3), ti, tj, r32, hi, Z16);
#pragma unroll
                for (int e = 0; e < 16; ++e) { const int ii = 32 * ti + 8 * (e >> 2) + 4 * hi + (e & 3); v[e] = ii <= jj ? v[e] : 0.f; }
                st32(m == 3 ? BUF(11) : BUF(12), ti, tj, r32, hi, v); } }
        LBAR();
#define WSYNC() asm volatile("s_waitcnt lgkmcnt(0)" ::: "memory")
        if (wid < 4) {
            const int tt = wid;
#define SQD(sr, st, dr, dt) do { const f32x4 a_ = mm_diag(BUF(st), BUF(sr), tt, c, q, Z4), b_ = mm_diag(BUF(sr), BUF(st), tt, c, q, Z4); WSYNC(); \
                st_tile(BUF(dr), tt, tt, c, q, a_); st_tile(BUF(dt), tt, tt, c, q, b_); WSYNC(); } while (0)
#define UPD(pr) do { const f32x4 dt_ = mm_diag(BUF(pr), BUF(13), tt, c, q, ld_tile(BUF(13), tt, tt, c, q)); \
                const f32x4 dr_ = mm_diag(BUF(13), BUF(pr), tt, c, q, ld_tile(BUF(14), tt, tt, c, q)); WSYNC(); \
                st_tile(BUF(13), tt, tt, c, q, dt_); st_tile(BUF(14), tt, tt, c, q, dr_); WSYNC(); } while (0)
            SQD(8, 9, 0, 1); UPD(0); SQD(0, 1, 8, 9); UPD(8); SQD(8, 9, 0, 1); UPD(0);
#undef SQD
#undef UPD
        } else {
            const int ti = (wid >> 1) & 1, tj = wid & 1; st32(BUF(2), ti, tj, r32, hi, mm32(BUF(10), BUF(7), ti, tj, r32, hi, Z16));
        }
        LBAR();
        { const int m = wid >> 2, ti = (wid >> 1) & 1, tj = wid & 1;
          if (m == 0) st32(BUF(8), ti, tj, r32, hi, mm32(BUF(15), BUF(14), ti, tj, r32, hi, Z16));
          else        st32(BUF(9), ti, tj, r32, hi, mm32(BUF(14), BUF(15), ti, tj, r32, hi, Z16)); }
        LBAR();
        if (wid < 4) { const int ti = (wid >> 1) & 1, tj = wid & 1; st32(BUF(0), ti, tj, r32, hi, mm32(BUF(9), BUF(8), ti, tj, r32, hi, Z16)); }
        LBAR();
        if (wid < 4) { const int ti = (wid >> 1) & 1, tj = wid & 1; st32(BUF(1), ti, tj, r32, hi, mm32(BUF(0), BUF(13), ti, tj, r32, hi, ld32(BUF(13), ti, tj, r32, hi))); }
        LBAR();
        if (wid < 4) { const int ti = (wid >> 1) & 1, tj = wid & 1; st32(BUF(14), ti, tj, r32, hi, mm32(BUF(8), BUF(1), ti, tj, r32, hi, ld32(BUF(1), ti, tj, r32, hi))); }
        LBAR();
        { const int m = wid >> 2, ti = (wid >> 1) & 1, tj = wid & 1;
          if (m == 0) st32(BUF(8), ti, tj, r32, hi, mm32(BUF(14), BUF(4), ti, tj, r32, hi, Z16));
          else        st32(BUF(0), ti, tj, r32, hi, mm32(BUF(14), BUF(2), ti, tj, r32, hi, Z16)); }
        LBAR();
        bf16_t* ckp = CK + (size_t)it * 4 * 4096;
#pragma unroll 1
        for (int u = 0; u < 2; ++u) { const int tl = u * 8 + wid, m = tl >> 2, ti = (tl >> 1) & 1, tj = tl & 1;
            if (m == 0) { f32x16 v = mm32(BUF(8), BUF(5), ti, tj, r32, hi, Z16); const int jj = 32 * tj + r32; const float gc = GC[jj];
#pragma unroll
                for (int e = 0; e < 16; ++e) { const int ii = 32 * ti + 8 * (e >> 2) + 4 * hi + (e & 3); v[e] += (ii == jj) ? gc : 0.f; }
                st32(BUF(1), ti, tj, r32, hi, v); }
            else if (m == 1) st32(BUF(4), ti, tj, r32, hi, mm32(BUF(8), BUF(11), ti, tj, r32, hi, ld32(BUF(3), ti, tj, r32, hi)));
            else if (m == 2) st32(BUF(2), ti, tj, r32, hi, mm32(BUF(6), BUF(7), ti, tj, r32, hi, mm32(BUF(5), BUF(0), ti, tj, r32, hi, Z16)));
            else             st32(BUF(9), ti, tj, r32, hi, mm32(BUF(7), BUF(12), ti, tj, r32, hi, mm32(BUF(0), BUF(11), ti, tj, r32, hi, Z16))); }
        LBAR();
        { const int orow = tid >> 3, oc = (tid & 7) * 8;
          *(u32x4*)(ckp + orow * 64 + oc) = *(const LAS u32x4*)(BUF(1) + (orow * P + oc) * 2);
          *(u32x4*)(ckp + 4096 + orow * 64 + oc) = *(const LAS u32x4*)(BUF(2) + (orow * P + oc) * 2);
          *(u32x4*)(ckp + 2 * 4096 + orow * 64 + oc) = *(const LAS u32x4*)(BUF(4) + (orow * P + oc) * 2);
          *(u32x4*)(ckp + 3 * 4096 + orow * 64 + oc) = *(const LAS u32x4*)(BUF(9) + (orow * P + oc) * 2); }
    }
#undef BUF
#undef SC1_LOAD
}

__device__ void ph_rw_sc2(const Params& p, char* lds) {
    using namespace ck;
    const int tid = tidx(), wid = __builtin_amdgcn_readfirstlane(tid >> 6), lane = tid & 63, c = lane & 15, q = lane >> 4;
    const size_t PL = (size_t)NROW * D;
    const bf16_t* CK = (const bf16_t*)(p.ws + OFF_CK); bf16_t* Y = (bf16_t*)(p.ws + OFF_Y);
    lchar* GB = (lchar*)lds;
    lchar* RB = GB + 2 * MB;
    lchar* SB = GB + 4 * MB;
    constexpr int SBB = 32 * P * 2;
    for (int it = bidx(); it < 256; it += gdim()) {
        const int vh = it & 1, seq = it >> 1, z = seq & 1, h = (seq >> 1) & 15, b = seq >> 5;
        const bf16_t* ck0 = CK + (size_t)seq * NCHK * 4 * 4096;
        const int s_ti = wid & 3, s_tj = wid >> 2;
        const int y_ti = wid & 1, y_tj = wid >> 1;
        const int hoff = 4096 + (vh * 32 + 16 * s_tj + c) * 64 + 16 * s_ti + 4 * q, yoff = 3 * 4096 + (16 * y_tj + c) * 64 + vh * 32 + 16 * y_ti + 4 * q;
        struct PF { u32x4 g, r; uint2 h, y; };
#define PF_LOAD(X, k) do { const bf16_t* cc_ = ck0 + (size_t)(k) * 4 * 4096; X.h = *(const uint2*)(cc_ + hoff); X.y = *(const uint2*)(cc_ + yoff); X.g = *(const u32x4*)(cc_ + tid * 8); X.r = *(const u32x4*)(cc_ + 2 * 4096 + tid * 8); } while (0)
#define PF_STAGE(X, bufi) do { *(LAS u32x4*)(GB + (bufi) * MB + ((tid >> 3) * P + (tid & 7) * 8) * 2) = X.g; *(LAS u32x4*)(RB + (bufi) * MB + ((tid >> 3) * P + (tid & 7) * 8) * 2) = X.r; } while (0)
#define SC2_STEP(k, CUR, NXT) do { const uint2 hi_ = CUR.h, yi_ = CUR.y; const int cur = (k) & 1; \
            if ((k) + 4 < NCHK) PF_LOAD(CUR, (k) + 4); \
            const f32x4 hinit = {__uint_as_float(hi_.x << 16), __uint_as_float(hi_.x & 0xffff0000u), __uint_as_float(hi_.y << 16), __uint_as_float(hi_.y & 0xffff0000u)}; \
            const f32x4 yinit = {__uint_as_float(yi_.x << 16), __uint_as_float(yi_.x & 0xffff0000u), __uint_as_float(yi_.y << 16), __uint_as_float(yi_.y & 0xffff0000u)}; \
            const lchar* Sold = SB + cur * SBB; lchar* Snew = SB + (cur ^ 1) * SBB; \
            const f32x4 sn = mm_tile(GB + cur * MB, Sold, s_ti, s_tj, c, q, hinit);        \
            const f32x4 yv = mm_tile(Sold, RB + cur * MB, y_ti, y_tj, c, q, yinit);        \
            st_tile(Snew, s_ti, s_tj, c, q, sn); \
            { const int row = scan_row((k) * 64 + 16 * y_tj + c, b, z); stbf4(Y + z * PL + (size_t)row * D + h * 64 + vh * 32 + 16 * y_ti + 4 * q, yv); } \
            if ((k) + 1 < NCHK) PF_STAGE(NXT, cur ^ 1); \
            LBAR(); } while (0)
        PF s0, s1, s2, s3;
        PF_LOAD(s0, 0); PF_LOAD(s1, 1); PF_LOAD(s2, 2); PF_LOAD(s3, 3);
        LBAR();
        for (int i = tid; i < SBB / 4; i += NTHR) ((LAS unsigned*)SB)[i] = 0u;
        PF_STAGE(s0, 0);
        LBAR();
        for (int ch = 0; ch < NCHK; ch += 4) {
            SC2_STEP(ch, s0, s1); SC2_STEP(ch + 1, s1, s2); SC2_STEP(ch + 2, s2, s3); SC2_STEP(ch + 3, s3, s0);
        }
#undef PF_LOAD
#undef PF_STAGE
#undef SC2_STEP
    }
}
#undef LBAR

__device__ void ph_rw_out(const Params& p, int j, int nrows) {
    const int wid = tidx() >> 6, lane = tidx() & 63;
    const bf16_t* RKV = (const bf16_t*)(p.ws + OFF_RKV); const bf16_t* AV = (const bf16_t*)(p.ws + OFF_AV); const bf16_t* G = (const bf16_t*)(p.ws + OFF_G); const bf16_t* Y = (const bf16_t*)(p.ws + OFF_Y);
    bf16_t* OUT = (bf16_t*)(p.ws + OFF_H);
    const size_t PL = (size_t)NROW * D;
    const float* r_k = p.rw_r_k + j * D; const float* lg = p.rw_lnx_g + j * D; const float* lb = p.rw_lnx_b + j * D; const float* k_a = p.rw_k_a + j * D;
    uint2 nb[8][4];
#define OUT_LOAD(R) do { _Pragma("unroll") for (int i = 0; i < 4; ++i) { const size_t o_ = (size_t)(R) * D + lane * 4 + i * 256; \
        nb[0][i] = *(const uint2*)(Y + o_); nb[1][i] = *(const uint2*)(Y + PL + o_); nb[2][i] = *(const uint2*)(RKV + o_); nb[3][i] = *(const uint2*)(RKV + PL + o_); \
        nb[4][i] = *(const uint2*)(RKV + 2 * PL + o_); nb[5][i] = *(const uint2*)(AV + o_); nb[6][i] = *(const uint2*)(AV + PL + o_); nb[7][i] = *(const uint2*)(G + o_); } } while (0)
#define UNPK(w) ((f32x4){__uint_as_float((w).x << 16), __uint_as_float((w).x & 0xffff0000u), __uint_as_float((w).y << 16), __uint_as_float((w).y & 0xffff0000u)})
    int row = bidx() * 8 + wid;
    if (row < nrows) OUT_LOAD(row);
    for (; row < nrows; row += gdim() * 8) {
        uint2 cb[8][4];
#pragma unroll
        for (int q_ = 0; q_ < 8; ++q_)
#pragma unroll
            for (int i = 0; i < 4; ++i) cb[q_][i] = nb[q_][i];
        { const int nrow = row + gdim() * 8; if (nrow < nrows) OUT_LOAD(nrow); }
#pragma unroll
        for (int i = 0; i < 4; ++i) {
            const size_t o = (size_t)row * D + lane * 4 + i * 256; const int c = lane * 4 + i * 256;
            const f32x4 y = UNPK(cb[0][i]) + UNPK(cb[1][i]);
            const float mean = dpp_sum16(y[0] + y[1] + y[2] + y[3]) * (1.f / 64.f);
            const f32x4 dd = y - mean;
            const float rstd = rsqrtf(dpp_sum16(dd[0] * dd[0] + dd[1] * dd[1] + dd[2] * dd[2] + dd[3] * dd[3]) * (1.f / 64.f) + LNX_EPS);
            const f32x4 r = UNPK(cb[2][i]), k = UNPK(cb[3][i]), v = UNPK(cb[4][i]);
            const f32x4 a0 = UNPK(cb[5][i]), a1 = UNPK(cb[6][i]);
            const f32x4 kds = k * (2.f + (a0 + a1 - 2.f) * *(const f32x4*)(k_a + c));
            const f32x4 t4 = r * kds * *(const f32x4*)(r_k + c);
            const float bs = dpp_sum16(t4[0] + t4[1] + t4[2] + t4[3]);
            const f32x4 res = (dd * rstd * *(const f32x4*)(lg + c) + *(const f32x4*)(lb + c) + bs * v) * UNPK(cb[7][i]);
            uint2 w; w.x = pk2(res[0], res[1]); w.y = pk2(res[2], res[3]); *(uint2*)(OUT + o) = w;
        }
    }
#undef OUT_LOAD
#undef UNPK
}

__device__ void ph_final(const Params& p) {
    const int wid = tidx() >> 6, lane = tidx() & 63;
    const float* X = (const float*)(p.ws + OFF_X);
    for (int row = bidx() * 8 + wid; row < NLAT; row += gdim() * 8) {
        const float4* xr = (const float4*)(X + (size_t)row * D);
        float4 v[4]; float ss = 0;
#pragma unroll
        for (int i = 0; i < 4; ++i) { v[i] = xr[lane + i * 64]; ss += v[i].x * v[i].x + v[i].y * v[i].y + v[i].z * v[i].z + v[i].w * v[i].w; }
        ss = wave_sum(ss); const float rs = rsqrtf(ss * (1.f / D) + RMS_EPS);
#pragma unroll
        for (int i = 0; i < 4; ++i) { const int d = (lane + i * 64) * 4; const float4 gg = *(const float4*)(p.final_g + d);
            float4 o; o.x = v[i].x * rs * gg.x; o.y = v[i].y * rs * gg.y; o.z = v[i].z * rs * gg.z; o.w = v[i].w * rs * gg.w;
            *(float4*)(p.out + (size_t)row * D + d) = o; }
    }
}

enum { PH_INIT = 0, PH_A_NORM, PH_A_Z, PH_A_MID, PH_A_QKV, PH_A_POST, PH_A_ATTN, PH_A_WO,
       PH_R_NORM, PH_R_XS, PH_R_G1, PH_R_G2, PH_R_PREP, PH_R_SCAN, PH_R_OUT, PH_R_WO,
       PH_M_NORM, PH_M_SEL, PH_M_GATHER, PH_M_G1, PH_M_G2, PH_M_COMB, PH_FINAL, PH_M_CVT, PH_R_SC1, PH_R_SC2 };

#ifndef BG_Z
#define BG_Z 4
#define BG_ATTN 2
#define BG_WO 3
#define BG_RG1 6
#define BG_MG1 4
#define BG_MG2 6
#endif
template <int PH>
__device__ __forceinline__ void run_phase(const Params& p, int layer, char* lds) {
    const int j = layer >> 1;
    char* ws = p.ws;
    if constexpr (PH == PH_INIT) { ph_init(p, lds); __syncthreads(); ph_small_cvt(p, lds); }
    else if constexpr (PH == PH_A_NORM) { if (layer == 0) ph_norm_mod<false>(p, layer, p.norm1_g + layer * D, 0, 1, ws + OFF_H); else ph_comb_norm<false>(p, layer - 1, layer, NROW); }
    else if constexpr (PH == PH_A_Z) {
        float* Z = (float*)(ws + OFF_Z);
        g8::BatchSched S{ws + OFF_H, ws + OFF_WMLA + j * SZ_WMLA + WM_IN, 0, 0, NROW / 256, 2, 1, D};
        g8::gemm_phase(p.wv, (PG8_LAS unsigned char*)lds, D, S, g8::epi_rc([=](const g8::Unit&, int row, int col, f32x4 v) { *(f32x4*)(Z + (size_t)row * 512 + col) = v; }));
        if (idle_tail(NROW / 256 * 2)) bg_cvt(p, layer, lds, BG_Z);
    }
    else if constexpr (PH == PH_A_MID) ph_mla_mid(p, j);
    else if constexpr (PH == PH_A_QKV) {
        bf16_t* Q = (bf16_t*)(ws + OFF_Q); bf16_t* K = (bf16_t*)(ws + OFF_K); bf16_t* V = (bf16_t*)(ws + OFF_V);
        g8::BatchSched S1{ws + OFF_CQN, ws + OFF_WMLA + j * SZ_WMLA + WM_UQ, 0, 0, NROW / 256, 6, 1, 256};
        g8::gemm_phase(p.wv, (PG8_LAS unsigned char*)lds, 256, S1, g8::epi_rc([=](const g8::Unit&, int row, int col, f32x4 v) {
            const bool lat = row < NLAT; const int b = lat ? (row >> 12) : ((row - NLAT) >> 8); const int tk = lat ? 256 + (row & (TL - 1)) : ((row - NLAT) & 255);
            const int h = col / 192, d = col - h * 192;
            uint2 w; w.x = pk2(v[0], v[1]); w.y = pk2(v[2], v[3]);
            *(uint2*)(Q + ((size_t)(b * 8 + h) * TK + tk) * 192 + d) = w; }));
        g8::BatchSched S2{ws + OFF_CKVN, ws + OFF_WMLA + j * SZ_WMLA + WM_UKV, 0, 0, NROW / 256, 8, 1, 128};
        g8::gemm_phase(p.wv, (PG8_LAS unsigned char*)lds, 128, S2, g8::epi_rc([=](const g8::Unit&, int row, int col, f32x4 v) {
            const bool lat = row < NLAT; const int b = lat ? (row >> 12) : ((row - NLAT) >> 8); const int tk = lat ? 256 + (row & (TL - 1)) : ((row - NLAT) & 255);
            const int h = col >> 8, d = col & 255; const size_t orow = (size_t)(b * 8 + h) * TK + tk;
            uint2 w; w.x = pk2(v[0], v[1]); w.y = pk2(v[2], v[3]);
            if (d < 128) *(uint2*)(K + orow * 192 + d) = w; else *(uint2*)(V + orow * 128 + (d - 128)) = w; }));
    }
    else if constexpr (PH == PH_A_ATTN) { ph_attn(p, lds); if (idle_tail(544)) bg_cvt(p, layer, lds, BG_ATTN); }
    else if constexpr (PH == PH_A_WO || PH == PH_R_WO) {
        xt_t* X = (xt_t*)(ws + OFF_X); const float* MOD = (const float*)(ws + OFF_MOD);
        g8::BatchSched S{ws + (PH == PH_A_WO ? OFF_O : OFF_H), PH == PH_A_WO ? ws + OFF_WMLA + j * SZ_WMLA + WM_O : ws + OFF_WRW + j * SZ_WRW + WR_O, 0, 0, (layer < 3 ? NROW : NLAT) / 256, 4, 1, D};
        g8::gemm_phase(p.wv, (PG8_LAS unsigned char*)lds, D, S, g8::EpiResid{X, MOD, layer});
        if (idle_tail((layer < 3 ? NROW : NLAT) / 256 * 4)) bg_cvt(p, layer, lds, BG_WO);
    }
    else if constexpr (PH == PH_R_XS) ph_rw_normxs(p, layer, j);
    else if constexpr (PH == PH_R_G1) {
        bf16_t* RKV = (bf16_t*)(ws + OFF_RKV); bf16_t* VF = (bf16_t*)(ws + OFF_VFIRST);
        bf16_t* A2 = (bf16_t*)(ws + OFF_A2); bf16_t* A3 = (bf16_t*)(ws + OFF_A3);
        const bool first = (j == 0);
        struct RSched { const char* XS; const char* WB; int nwg;
            __device__ __forceinline__ bool next(int i, g8::Unit& u) const {
                const int L = i * gdim() + bidx(); if (L >= nwg) return false;
                const int w = g8::xcd_remap(L, nwg);
                if (w < 816) { u.g = w / 272; const int r = w % 272; u.pm = r >> 2; u.pn = r & 3; u.B = WB + WR_RKV + (size_t)u.g * D * D * 2 + (size_t)u.pn * 256 * D * 2; }
                else { u.g = 3 + (w - 816) / 68; u.pm = (w - 816) % 68; u.pn = 0; u.B = WB + WR_L + (size_t)(u.g - 3) * 256 * D * 2; }
                u.A = XS + (size_t)(u.g == 6 ? 2 : u.g) * NROW * D * 2 + (size_t)u.pm * 256 * D * 2; return true; } };
        RSched S{ws + OFF_XS, ws + OFF_WRW + j * SZ_WRW, first ? 816 + 204 : 816 + 272};
        g8::gemm_phase(p.wv, (PG8_LAS unsigned char*)lds, D, S, g8::epi_rc([=](const g8::Unit& u, int row, int col, f32x4 v) {
            if (u.g < 3) { stbf4(RKV + ((size_t)u.g * NROW + row) * D + col, v); if (first && u.g == 2) stbf4(VF + (size_t)row * D + col, v); }
            else if (col < 128) {
                f32x4 t = v;
                if (u.g == 3) { for (int e = 0; e < 4; ++e) t[e] = 1.f - 2.f * __builtin_amdgcn_rcpf(1.f + __expf(2.f * v[e])); }
                else if (u.g == 5) { for (int e = 0; e < 4; ++e) t[e] = sigmoidf_(v[e]); }
                bf16_t* dst = (u.g == 3 ? A2 : u.g == 4 ? A2 + (size_t)NROW * 128 : u.g == 5 ? A3 : A3 + (size_t)NROW * 128);
                stbf4(dst + (size_t)row * 128 + col, t); } }));
        if (idle_tail(S.nwg)) bg_cvt(p, layer, lds, BG_RG1);
    }
    else if constexpr (PH == PH_R_G2) {
        const bool first = (j == 0);
        float* W = (float*)(ws + OFF_W); bf16_t* AV = (bf16_t*)(ws + OFF_AV); bf16_t* G = (bf16_t*)(ws + OFF_G); bf16_t* RKV = (bf16_t*)(ws + OFF_RKV); const bf16_t* VF = (const bf16_t*)(ws + OFF_VFIRST);
        const float* w0 = p.rw_w0 + (size_t)j * 2 * D; const float* a0 = p.rw_a0 + (size_t)j * 2 * D; const float* v0 = p.rw_v0;
        g8::BatchSched S1{ws + OFF_A2, ws + OFF_WRW + j * SZ_WRW + WR_B2, (size_t)NROW * 128 * 2, (size_t)2048 * 128 * 2, NROW / 256, 8, 2, 128};
        g8::gemm_phase(p.wv, (PG8_LAS unsigned char*)lds, 128, S1, g8::epi_colfirst([=](const g8::Unit& u, int row, int col, f32x4 v, f32x4 bias) {
            const int zz = u.pn >> 2, c = col & 1023; const bool dec = u.g == 0;
            const size_t doff = (size_t)zz * NROW * D + (size_t)row * D + c;
            const f32x4 x = v + bias; f32x4 o;
#pragma unroll
            for (int e = 0; e < 4; ++e) { const float sg = __builtin_amdgcn_rcpf(1.f + __expf(-x[e])); o[e] = dec ? (-0.6065306597126334f * sg) : sg; }
            if (dec) *(f32x4*)(W + doff) = o; else stbf4(AV + doff, o); },
            [=](const g8::Unit& u, int col) { const int zz = u.pn >> 2, c = col & 1023; return *(const f32x4*)((u.g == 0 ? w0 : a0) + zz * D + c); }));
        g8::BatchSched S2{ws + OFF_A3, ws + OFF_WRW + j * SZ_WRW + WR_B3, (size_t)NROW * 128 * 2, (size_t)1024 * 128 * 2, NROW / 256, 4, first ? 1 : 2, 128};
        g8::gemm_phase(p.wv, (PG8_LAS unsigned char*)lds, 128, S2, g8::epi_rc([=](const g8::Unit& u, int row, int col, f32x4 v) {
            if (u.g == 0) stbf4(G + (size_t)row * D + col, v);
            else { const size_t o = (size_t)row * D + col; const f32x4 vv = ldbf4(RKV + (size_t)2 * NROW * D + o), vf = ldbf4(VF + o), gz = v + *(const f32x4*)(v0 + col); f32x4 r;
#pragma unroll
                for (int e = 0; e < 4; ++e) r[e] = vv[e] + (vf[e] - vv[e]) * __builtin_amdgcn_rcpf(1.f + __expf(-gz[e]));
                stbf4(RKV + (size_t)2 * NROW * D + o, r); } }));
    }
    else if constexpr (PH == PH_R_SCAN) ph_rw_scan(p, j, lds);
    else if constexpr (PH == PH_R_SC1) ph_rw_sc1(p, j, lds);
    else if constexpr (PH == PH_R_SC2) ph_rw_sc2(p, lds);
    else if constexpr (PH == PH_R_OUT) ph_rw_out(p, j, layer < 3 ? NROW : NLAT);
    else if constexpr (PH == PH_M_NORM) ph_norm2_router(p, layer, lds, layer < 3 ? NROW : NLAT);
    else if constexpr (PH == PH_M_SEL) { ph_select(p, lds, layer < 3 ? 128 : 64); __syncthreads(); moe_cvt(p, layer, lds, -1); }
    else if constexpr (PH == PH_M_GATHER) ph_gather(p, layer < 3 ? ESLOTS : NB * CAPL);
    else if constexpr (PH == PH_M_G1) {
        bf16_t* HID = (bf16_t*)(ws + OFF_HID);
        g8::BatchSched S{ws + OFF_XE, ws + OFF_W13T + (size_t)(layer & 1) * SZ_WMOE, (size_t)EPAD * D * 2, (size_t)2816 * D * 2, layer < 3 ? 9 : 8, 11, NE, D};
        g8::gemm_phase(p.wv, (PG8_LAS unsigned char*)lds, D, S, g8::epi_pair([=](const g8::Unit& u, int row, int col, f32x4 a, f32x4 b) {
            uint2 w; w.x = pk2(a[0] * __builtin_amdgcn_rcpf(1.f + __expf(-a[0])) * b[0], a[1] * __builtin_amdgcn_rcpf(1.f + __expf(-a[1])) * b[1]); w.y = pk2(a[2] * __builtin_amdgcn_rcpf(1.f + __expf(-a[2])) * b[2], a[3] * __builtin_amdgcn_rcpf(1.f + __expf(-a[3])) * b[3]);
            *(uint2*)(HID + ((size_t)u.g * EPAD + row) * FF + col) = w; }));
        if (layer < 3 && idle_tail(9 * 11 * NE)) moe_cvt(p, layer + 1, lds, BG_MG1);
    }
    else if constexpr (PH == PH_M_G2) {
        bf16_t* YE = (bf16_t*)(ws + OFF_YE); const float* GATE = (const float*)(ws + OFF_GATE);
        g8::BatchSched S{ws + OFF_HID, ws + OFF_W2T + (size_t)(layer & 1) * SZ_WMOE, (size_t)EPAD * FF * 2, (size_t)D * FF * 2, layer < 3 ? 9 : 8, 4, NE, FF};
        g8::gemm_phase(p.wv, (PG8_LAS unsigned char*)lds, FF, S, g8::epi_pre([=](const g8::Unit& u, int row, int col, f32x4 v, f32x4, float gt) {
            uint2 w; w.x = pk2(v[0] * gt, v[1] * gt); w.y = pk2(v[2] * gt, v[3] * gt);
            *(uint2*)(YE + ((size_t)u.g * EPAD + row) * D + col) = w; },
            [=](const g8::Unit&, int) { return (f32x4){0.f, 0.f, 0.f, 0.f}; }, [=](const g8::Unit& u, int row) { return GATE[u.g * EPAD + row]; }));
        if (layer < 3 && idle_tail(9 * 4 * NE)) moe_cvt(p, layer + 1, lds, BG_MG2);
    }
    else if constexpr (PH == PH_M_COMB) ph_combine(p, layer, layer < 3 ? NROW : NLAT);
    else if constexpr (PH == PH_M_CVT) moe_cvt(p, layer, lds, -1);
    else if constexpr (PH == PH_FINAL) ph_comb_norm<true>(p, 3, 0, NLAT);
}

#if ONE_LAUNCH
#define SYNC() xcd_barrier(bar)
#ifndef PROBE_PH
#define PROBE_PH -1
#endif
#ifndef PROBE_REP
#define PROBE_REP 1
#endif
__device__ __forceinline__ Params load_params() {
    Params q{};
#if defined(__HIP_DEVICE_COMPILE__)
    typedef const __attribute__((address_space(4))) unsigned long long* KargP;
    KargP kp_ = (KargP)__builtin_amdgcn_kernarg_segment_ptr(); asm volatile("" : "+s"(kp_));
#pragma unroll
    for (int i = 0; i < 40; ++i) ((const float**)&q)[i] = (const float*)(const __attribute__((address_space(1))) float*)kp_[i];
#endif
    return q;
}
#define RUN(PH) do { for (int rep_ = 0; rep_ < ((PH) == PROBE_PH ? PROBE_REP : 1); ++rep_) { Params q = load_params(); q.wv = wv0_; run_phase<PH>(q, layer, smem); SYNC(); } } while (0)
__global__ void __launch_bounds__(NTHR, 2) mega(Params p) {
    extern __shared__ __attribute__((aligned(16))) char smem[];
    const int wv0_ = __builtin_amdgcn_readfirstlane((int)threadIdx.x >> 6);
    if (threadIdx.x == 0) *(uint4*)(smem + LDS_BYTES) = make_uint4(0u, 0u, 0u, 0u);
    __syncthreads();
    XcdBarrier bar = xcd_barrier_post((unsigned*)(p.ws + OFF_BAR), (volatile LAS unsigned*)(smem + LDS_BYTES));
    { const int layer = 0; RUN(PH_INIT); }
    for (int layer = 0; layer < 4; ++layer) {
        if ((layer & 1) == 0) {
            RUN(PH_A_NORM);
            RUN(PH_A_Z);
            RUN(PH_A_MID);
            RUN(PH_A_QKV);
            RUN(PH_A_ATTN);
            RUN(PH_A_WO);
        } else {
            RUN(PH_R_XS);
            RUN(PH_R_G1);
            RUN(PH_R_G2);
            RUN(PH_R_SC1);
            RUN(PH_R_SC2);
            RUN(PH_R_OUT);
            RUN(PH_R_WO);
        }
        RUN(PH_M_NORM);
        RUN(PH_M_SEL);
        RUN(PH_M_G1);
        RUN(PH_M_G2);
        if ((layer & 1) == 0) RUN(PH_M_COMB);
    }
    { Params q = load_params(); q.wv = wv0_; run_phase<PH_FINAL>(q, 0, smem); }
}
#else
template <int PH> __global__ void __launch_bounds__(NTHR, 2) kph(Params p, int layer) {
    extern __shared__ __attribute__((aligned(16))) char smem[];
    Params q = p; q.wv = __builtin_amdgcn_readfirstlane((int)threadIdx.x >> 6);
    run_phase<PH>(q, layer, smem);
}
#endif

extern "C" void kernel_launch(void* const* d_in, const int* in_sizes, int n_in, void* d_out, int out_size, void* d_ws, size_t ws_size, hipStream_t stream) {
    if (n_in != 38 || ws_size < WS_NEED) { fprintf(stderr, "kernel_launch: bad args n_in %d ws %zu need %zu\n", n_in, ws_size, (size_t)WS_NEED); return; }
    Params p{};
    const float** pp = (const float**)&p;
    for (int i = 0; i < 38; ++i) pp[i] = (const float*)d_in[i];
    p.out = (float*)d_out; p.ws = (char*)d_ws;
    static int cus = 0;
    if (!cus) { int dev = 0; hipGetDevice(&dev); hipDeviceGetAttribute(&cus, hipDeviceAttributeMultiprocessorCount, dev); if (cus <= 0) cus = 256; }
    const int grid = cus;
#if ONE_LAUNCH
    hipFuncSetAttribute((const void*)mega, hipFuncAttributeMaxDynamicSharedMemorySize, LDS_BYTES + 16);
    hipMemsetAsync(d_ws, 0, 16384, stream);
    hipLaunchKernelGGL(mega, dim3(grid), dim3(NTHR), LDS_BYTES + 16, stream, p);
#else
    hipMemsetAsync(d_ws, 0, 16384, stream);
#define LAUNCH(PH, L) do { hipFuncSetAttribute((const void*)kph<PH>, hipFuncAttributeMaxDynamicSharedMemorySize, LDS_BYTES + 16); hipLaunchKernelGGL(kph<PH>, dim3(grid), dim3(NTHR), LDS_BYTES + 16, stream, p, L); } while (0)
    LAUNCH(PH_INIT, 0);
    for (int layer = 0; layer < 4; ++layer) {
        if ((layer & 1) == 0) { LAUNCH(PH_A_NORM, layer); LAUNCH(PH_A_Z, layer); LAUNCH(PH_A_MID, layer); LAUNCH(PH_A_QKV, layer); LAUNCH(PH_A_ATTN, layer); LAUNCH(PH_A_WO, layer); }
        else { LAUNCH(PH_R_XS, layer); LAUNCH(PH_R_G1, layer); LAUNCH(PH_R_G2, layer); LAUNCH(PH_R_SC1, layer); LAUNCH(PH_R_SC2, layer); LAUNCH(PH_R_OUT, layer); LAUNCH(PH_R_WO, layer); }
        LAUNCH(PH_M_NORM, layer); LAUNCH(PH_M_SEL, layer); LAUNCH(PH_M_G1, layer); LAUNCH(PH_M_G2, layer); if ((layer & 1) == 0) LAUNCH(PH_M_COMB, layer);
    }
    LAUNCH(PH_FINAL, 0);
#endif
}
```

```cpp
#include <hip/hip_runtime.h>
#include <stdint.h>
#include <stdio.h>

#ifndef ONE_LAUNCH
#define ONE_LAUNCH 1
#endif

#define NTHR 512
typedef unsigned short bf16_t;
typedef short bf16x8 __attribute__((ext_vector_type(8)));
typedef float f32x4 __attribute__((ext_vector_type(4)));
typedef unsigned u32x4 __attribute__((ext_vector_type(4)));
typedef unsigned u32x2 __attribute__((ext_vector_type(2)));

constexpr int D = 1024, NB = 4, TL = 4096, TC = 256, NLAT = NB * TL, NCTX = NB * TC, NROW = NLAT + NCTX;
constexpr int TK = TL + TC;
constexpr int NE = 16, FF = 1408, CAPL = 512, CAPC = 32, ESLOTS = NB * CAPL + NB * CAPC;
constexpr int EPAD = 2304;
constexpr float RMS_EPS = 1e-6f, LNX_EPS = 64e-5f;
constexpr float ATT_SCALE = 0.07216878364870322f;

constexpr size_t al256(size_t x) { return (x + 255) / 256 * 256; }
constexpr size_t OFF_BAR = 0;
constexpr size_t OFF_QUEUE = 14336;
constexpr size_t OFF_MOD = 16384;
constexpr size_t OFF_ROPE_C = OFF_MOD + al256(4 * 5 * 6144 * 4);
constexpr size_t OFF_ROPE_S = OFF_ROPE_C + al256(TL * 32 * 4);
constexpr size_t OFF_X = OFF_ROPE_S + al256(TL * 32 * 4);
constexpr size_t SZ_F32 = (size_t)NROW * D * 4, SZ_BF = (size_t)NROW * D * 2;
constexpr size_t OFF_VFIRST = OFF_X + SZ_BF;
constexpr size_t OFF_H = OFF_VFIRST + SZ_BF;
constexpr size_t SZ_WMLA = (size_t)(512 * 1024 + 1536 * 256 + 2048 * 256 + 1024 * 1024) * 2;
constexpr size_t WM_IN = 0, WM_UQ = (size_t)512 * 1024 * 2, WM_UKV = WM_UQ + (size_t)1536 * 256 * 2, WM_O = WM_UKV + (size_t)2048 * 256 * 2;
constexpr size_t SZ_WRW = (size_t)(3 * 1024 * 1024 + 4 * 256 * 1024 + 1024 * 1024 + 4096 * 256 + 2048 * 256) * 2;
constexpr size_t WR_RKV = 0, WR_L = (size_t)3 * 1024 * 1024 * 2, WR_O = WR_L + (size_t)4 * 256 * 1024 * 2, WR_B2 = WR_O + (size_t)1024 * 1024 * 2, WR_B3 = WR_B2 + (size_t)4096 * 256 * 2;
constexpr size_t OFF_WMLA = OFF_H + SZ_BF;
constexpr size_t OFF_WRW = OFF_WMLA + 2 * SZ_WMLA;
constexpr size_t OFF_W13T = OFF_WRW + 2 * SZ_WRW;
constexpr size_t OFF_W2T = OFF_W13T + (size_t)NE * 2816 * D * 2;
constexpr size_t SZ_WMOE = (size_t)NE * 2816 * D * 2 + (size_t)NE * D * FF * 2;
constexpr size_t OFF_S = OFF_W13T + 2 * SZ_WMOE;
constexpr size_t OFF_Z = OFF_S;
constexpr size_t OFF_CQN = OFF_Z + al256((size_t)NROW * 512 * 4);
constexpr size_t OFF_CKVN = OFF_CQN + al256((size_t)NROW * 256 * 2);
constexpr size_t OFF_KR = OFF_CKVN + al256((size_t)NROW * 256 * 2);
constexpr size_t OFF_QRAW = OFF_KR + al256((size_t)NROW * 64 * 4);
constexpr size_t OFF_KVRAW = OFF_QRAW + al256((size_t)NROW * 1536 * 4);
constexpr size_t OFF_Q = OFF_KVRAW + al256((size_t)NROW * 2048 * 4);
constexpr size_t OFF_K = OFF_Q + al256((size_t)NB * 8 * TK * 192 * 2);
constexpr size_t OFF_V = OFF_K + al256((size_t)NB * 8 * TK * 192 * 2);
constexpr size_t OFF_O = OFF_V + al256((size_t)NB * 8 * TK * 128 * 2);
constexpr size_t END_MLA = OFF_O + SZ_BF;
constexpr size_t OFF_XS = OFF_S;
constexpr size_t OFF_RKV = OFF_XS + 6 * SZ_BF;
constexpr size_t OFF_W = OFF_RKV + 3 * SZ_BF;
constexpr size_t OFF_AV = OFF_W + 2 * SZ_F32;
constexpr size_t OFF_G = OFF_AV + 2 * SZ_BF;
constexpr size_t OFF_A2 = OFF_G + SZ_BF;
constexpr size_t OFF_A3 = OFF_A2 + al256((size_t)NROW * 256 * 2);
constexpr size_t END_RW = OFF_A3 + al256((size_t)NROW * 256 * 2);
constexpr size_t OFF_Y = OFF_XS;
constexpr int NCHK = (TC + TL) / 64;
constexpr size_t OFF_CK = END_RW;
constexpr size_t END_RW2 = OFF_CK + (size_t)128 * NCHK * 4 * 4096 * 2;
constexpr size_t OFF_AFF = OFF_S;
constexpr size_t OFF_ROWIDX = OFF_AFF + al256((size_t)NROW * 16 * 4);
constexpr size_t OFF_GATE = OFF_ROWIDX + al256((size_t)NE * ESLOTS * 4);
constexpr size_t OFF_SLOT = OFF_GATE + al256((size_t)NE * EPAD * 4);
constexpr size_t OFF_XE = OFF_SLOT + al256((size_t)NROW * 16 * 4);
constexpr size_t OFF_HID = OFF_XE + al256((size_t)NE * EPAD * D * 2);
constexpr size_t OFF_YE = OFF_HID + al256((size_t)NE * EPAD * FF * 2);
constexpr size_t END_MOE = OFF_YE + al256((size_t)NE * EPAD * D * 2);
constexpr size_t WS_NEED = END_RW2 > END_MLA ? (END_RW2 > END_MOE ? END_RW2 : END_MOE) : (END_MLA > END_MOE ? END_MLA : END_MOE);

constexpr int LDS_BYTES = 152064;

struct Params {
    const float *x, *c, *ctx, *c_ctx, *mod_w, *mod_b, *norm1_g, *norm2_g, *final_g;
    const float *mla_w_in, *mla_g_q, *mla_g_kv, *mla_w_uq, *mla_w_ukv, *mla_w_o;
    const float *rw_mu, *rw_w_rkv, *rw_w0, *rw_w1, *rw_w2, *rw_a0, *rw_a1, *rw_a2, *rw_v0, *rw_v1, *rw_v2, *rw_g1, *rw_g2, *rw_k_k, *rw_k_a, *rw_r_k, *rw_lnx_g, *rw_lnx_b, *rw_w_o;
    const float *moe_router, *moe_w1, *moe_w3, *moe_w2;
    float* out; char* ws;
    int wv, pad_;
};

__device__ __forceinline__ int bidx() { int t = blockIdx.x; asm volatile("" : "+s"(t)); return t; }
__device__ __forceinline__ int gdim() { int t = gridDim.x; asm volatile("" : "+s"(t)); return t; }
__device__ __forceinline__ int tidx_w(int wv) { int l; asm volatile("v_mbcnt_lo_u32_b32 %0, -1, 0\n\tv_mbcnt_hi_u32_b32 %0, -1, %0" : "=v"(l)); return (wv << 6) | l; }
#define tidx() tidx_w(p.wv)
#define XB_TMO      128
#define XB_XCNT(j)  (256  + 64 * (j))
#define XB_XSUB(j)  (1280 + 64 * (j))
#define XB_XGEN(j)  (2304 + 64 * (j))
#define XB_TOP      3328
#define XB_TOPGEN   3392
#define XCD_BAR_WORDS 3456
#define XB_SPIN_CAP (1u << 22)
#define LAS __attribute__((address_space(3)))

__device__ __forceinline__ unsigned xb_ld(unsigned* p)              { return __hip_atomic_load(p, __ATOMIC_RELAXED, __HIP_MEMORY_SCOPE_AGENT); }
__device__ __forceinline__ unsigned xb_add(unsigned* p, unsigned v) { return __hip_atomic_fetch_add(p, v, __ATOMIC_RELAXED, __HIP_MEMORY_SCOPE_AGENT); }
__device__ __forceinline__ unsigned xb_xcc_id() { return (unsigned)__builtin_amdgcn_s_getreg((3 << 11) | 20) & 0xFu; }
#define XB_SPIN(cond, bar) do { unsigned _sp = 0; while (cond) { __builtin_amdgcn_s_sleep(1); \
    if ((++_sp & 255u) == 0u) { if (xb_ld(&(bar)[XB_TMO])) break; if (_sp > XB_SPIN_CAP) { atomicAdd(&(bar)[XB_TMO], 1u); break; } } } } while (0)

struct XcdBarrier { unsigned* bar; unsigned x; volatile LAS unsigned* st; };

__device__ __forceinline__ XcdBarrier xcd_barrier_post(unsigned* bar, volatile LAS unsigned* st) {
    XcdBarrier b; b.bar = bar; b.x = xb_xcc_id(); b.st = st;
    if (threadIdx.x == 0) (void)xb_add(&bar[XB_XCNT(b.x)], 1u);
    return b;
}
__device__ __forceinline__ void xcd_barrier_complete(unsigned* bar, unsigned x, unsigned& nloc, unsigned& nx) {
    const unsigned G = gridDim.x * gridDim.y * gridDim.z;
    unsigned sum, cnt, mine, sp = 0u;
    for (;;) {
        sum = 0u; cnt = 0u; mine = 0u;
#pragma unroll
        for (unsigned j = 0; j < 16; ++j) { const unsigned c = xb_ld(&bar[XB_XCNT(j)]); sum += c; cnt += (c > 0u) ? 1u : 0u; mine = (j == x) ? c : mine; }
        if (sum == G) break;
        __builtin_amdgcn_s_sleep(1);
        if ((++sp & 255u) == 0u) { if (xb_ld(&bar[XB_TMO])) break; if (sp > XB_SPIN_CAP) { atomicAdd(&bar[XB_TMO], 1u); break; } }
    }
    nloc = mine > 0u ? mine : 1u; nx = cnt > 0u ? cnt : 1u;
}
__device__ __forceinline__ void xcd_barrier(const XcdBarrier& b) {
    asm volatile("s_waitcnt vmcnt(0)" ::: "memory");
    __syncthreads();
    if (threadIdx.x == 0) {
        unsigned* bar = b.bar;
        __builtin_amdgcn_s_waitcnt(0);
        unsigned nloc = b.st[0], nx = b.st[1];
        if (nloc == 0u) { xcd_barrier_complete(bar, b.x, nloc, nx); b.st[0] = nloc; b.st[1] = nx; }
        const unsigned old = xb_add(&bar[XB_XSUB(b.x)], 1u);
        const unsigned gen = old / nloc;
        if (old + 1u == (gen + 1u) * nloc) {
            __builtin_amdgcn_fence(__ATOMIC_RELEASE, "agent");
            asm volatile("s_waitcnt vmcnt(0)" ::: "memory");
            const unsigned og = xb_add(&bar[XB_TOP], 1u);
            const unsigned tg = og / nx;
            if (og + 1u == (tg + 1u) * nx) xb_add(&bar[XB_TOPGEN], 1u);
            else XB_SPIN(xb_ld(&bar[XB_TOPGEN]) == tg, bar);
            __builtin_amdgcn_fence(__ATOMIC_ACQUIRE, "agent");
            xb_add(&bar[XB_XGEN(b.x)], 1u);
            asm volatile("s_waitcnt vmcnt(0)" ::: "memory");
        } else {
            XB_SPIN(xb_ld(&bar[XB_XGEN(b.x)]) == gen, bar);
            __builtin_amdgcn_fence(__ATOMIC_ACQUIRE, "agent");
            asm volatile("s_waitcnt vmcnt(0)" ::: "memory");
        }
    }
    __syncthreads();
}

__device__ __forceinline__ float bf2f(bf16_t b) { return __uint_as_float(((unsigned)b) << 16); }
typedef float f32x2_ __attribute__((ext_vector_type(2)));
typedef __bf16 bf16x2_ __attribute__((ext_vector_type(2)));
__device__ __forceinline__ unsigned pk2(float lo, float hi) { const f32x2_ v = {lo, hi}; return __builtin_bit_cast(unsigned, __builtin_convertvector(v, bf16x2_)); }
__device__ __forceinline__ bf16_t f2bf(float f) { return (bf16_t)(pk2(f, f) & 0xffffu); }
__device__ __forceinline__ float dpp_sum16(float x) {
    x += __builtin_bit_cast(float, __builtin_amdgcn_update_dpp(0, __builtin_bit_cast(int, x), 0xB1, 0xF, 0xF, true));
    x += __builtin_bit_cast(float, __builtin_amdgcn_update_dpp(0, __builtin_bit_cast(int, x), 0x4E, 0xF, 0xF, true));
    x += __builtin_bit_cast(float, __builtin_amdgcn_update_dpp(0, __builtin_bit_cast(int, x), 0x141, 0xF, 0xF, true));
    x += __builtin_bit_cast(float, __builtin_amdgcn_update_dpp(0, __builtin_bit_cast(int, x), 0x140, 0xF, 0xF, true));
    return x;
}
__device__ __forceinline__ f32x4 ldbf4(const bf16_t* p) { const uint2 w = *(const uint2*)p; return (f32x4){__uint_as_float(w.x << 16), __uint_as_float(w.x & 0xffff0000u), __uint_as_float(w.y << 16), __uint_as_float(w.y & 0xffff0000u)}; }
__device__ __forceinline__ void stbf4(bf16_t* p, f32x4 v) { uint2 w; w.x = pk2(v[0], v[1]); w.y = pk2(v[2], v[3]); *(uint2*)p = w; }
typedef bf16_t xt_t;
__device__ __forceinline__ f32x4 xldv(const xt_t* X, size_t i) { return ldbf4(X + i); }
__device__ __forceinline__ void xstv(xt_t* X, size_t i, f32x4 v) { stbf4(X + i, v); }
__device__ __forceinline__ float4 xld(const xt_t* X, size_t i) { const f32x4 v = ldbf4(X + i); return make_float4(v[0], v[1], v[2], v[3]); }
__device__ __forceinline__ void xst(xt_t* X, size_t i, float4 v) { stbf4(X + i, (f32x4){v.x, v.y, v.z, v.w}); }
__device__ __forceinline__ float wave_sum(float v) {
    v = dpp_sum16(v); const int i = __builtin_bit_cast(int, v);
    return __builtin_bit_cast(float, __builtin_amdgcn_readlane(i, 0)) + __builtin_bit_cast(float, __builtin_amdgcn_readlane(i, 16)) + __builtin_bit_cast(float, __builtin_amdgcn_readlane(i, 32)) + __builtin_bit_cast(float, __builtin_amdgcn_readlane(i, 48));
}
__device__ __forceinline__ float sigmoidf_(float x) { return __builtin_amdgcn_rcpf(1.f + __expf(-x)); }
__device__ __forceinline__ int row_stream(int row) { return row < NLAT ? (row >> 12) : 4; }
__device__ __forceinline__ const float* modp(const Params& p, int layer, int s, int part) { return (const float*)(p.ws + OFF_MOD) + ((size_t)layer * 5 + s) * 6144 + part * 1024; }

struct SgArgs { const bf16_t* A; int lda; size_t strideA; const float* B; int ldb; size_t strideB; int M, N, K, nbatch; };
template <class Epi>
__device__ __forceinline__ void sg_gemm(const Params& p, char* lds, const SgArgs g, const Epi& epi) {
    bf16_t* As = (bf16_t*)lds;
    bf16_t* Bs = As + 128 * 40;
    const int tid = tidx(), wid = tid >> 6, lane = tid & 63;
    const int wr = wid >> 2, wc = wid & 3;
    const int tilesN = (g.N + 127) / 128, tilesM = g.M / 128, per = tilesM * tilesN, ntiles = per * g.nbatch;
    const int ar = tid >> 2, ak = (tid & 3) * 8;
    const int bn = tid & 127, bk = (tid >> 7) * 8;
    for (int tile = bidx(); tile < ntiles; tile += gdim()) {
        const int bt = tile / per, tt = tile % per;
        const int tm = tt / tilesN, tn = tt % tilesN;
        const int m0 = tm * 128, n0 = tn * 128;
        f32x4 acc[4][2];
#pragma unroll
        for (int m = 0; m < 4; ++m)
#pragma unroll
            for (int n = 0; n < 2; ++n) acc[m][n] = (f32x4){0.f, 0.f, 0.f, 0.f};
        const bool bvalid = (n0 + bn) < g.N;
        const bf16_t* ap = g.A + bt * g.strideA + (size_t)(m0 + ar) * g.lda + ak;
        const float* bp = g.B + bt * g.strideB + (size_t)bk * g.ldb + n0 + bn;
        bf16x8 areg; float breg[8];
        areg = *(const bf16x8*)ap;
#pragma unroll
        for (int j = 0; j < 8; ++j) breg[j] = bvalid ? bp[(size_t)j * g.ldb] : 0.f;
        for (int k0 = 0; k0 < g.K; k0 += 32) {
            __syncthreads();
            *(bf16x8*)(As + ar * 40 + ak) = areg;
            { u32x4 w; w.x = pk2(breg[0], breg[1]); w.y = pk2(breg[2], breg[3]); w.z = pk2(breg[4], breg[5]); w.w = pk2(breg[6], breg[7]); *(u32x4*)(Bs + bn * 40 + bk) = w; }
            __syncthreads();
            if (k0 + 32 < g.K) {
                areg = *(const bf16x8*)(ap + k0 + 32);
#pragma unroll
                for (int j = 0; j < 8; ++j) breg[j] = bvalid ? bp[(size_t)(k0 + 32 + j) * g.ldb] : 0.f;
            }
            bf16x8 af[4], bfr[2];
#pragma unroll
            for (int m = 0; m < 4; ++m) af[m] = *(const bf16x8*)(As + (wr * 64 + m * 16 + (lane & 15)) * 40 + (lane >> 4) * 8);
#pragma unroll
            for (int n = 0; n < 2; ++n) bfr[n] = *(const bf16x8*)(Bs + (wc * 32 + n * 16 + (lane & 15)) * 40 + (lane >> 4) * 8);
#pragma unroll
            for (int m = 0; m < 4; ++m)
#pragma unroll
                for (int n = 0; n < 2; ++n) acc[m][n] = __builtin_amdgcn_mfma_f32_16x16x32_bf16(af[m], bfr[n], acc[m][n], 0, 0, 0);
        }
#pragma unroll
        for (int m = 0; m < 4; ++m)
#pragma unroll
            for (int n = 0; n < 2; ++n) {
                const int col = n0 + wc * 32 + n * 16 + (lane & 15);
                if (col < g.N) {
#pragma unroll
                    for (int r = 0; r < 4; ++r) epi(bt, m0 + wr * 64 + m * 16 + (lane >> 4) * 4 + r, col, acc[m][n][r]);
                }
            }
    }
}


namespace g8 {
#define PG8_LAS __attribute__((address_space(3)))
constexpr int BM = 256, BK = 64, HALF = 128, HTB = HALF * BK * 2, STAGE_BYTES = 8 * HTB;
__device__ __forceinline__ int lds_byte(int r, int c) { const int st = (r >> 4) * 2 + (c >> 5), rr = r & 15, cc = c & 31, ob = rr * 64 + cc * 2; return st * 1024 + (ob ^ (((ob >> 9) & 1) << 5)); }
__device__ __forceinline__ void stage_rc(int b, int& R, int& C) { const int st = b / 1024, sb = b % 1024, swz = sb ^ (((sb >> 9) & 1) << 5); R = (st >> 1) * 16 + swz / 64; C = (st & 1) * 32 + (swz % 64) / 2; }
struct Unit { int pm, pn, g; const char* A; const char* B; };
__device__ __forceinline__ int xcd_remap(int L, int nwg) { const int q = nwg / 8, r = nwg % 8, xcd = L % 8, off = L / 8; return (xcd < r ? xcd * (q + 1) : r * (q + 1) + (xcd - r) * q) + off; }

template <class Epi, class Sched>
__device__ __forceinline__ void gemm_phase(const int wv_, PG8_LAS unsigned char* lds, const int K, const Sched& S, const Epi& E) {
    const int tid = tidx_w(wv_), wid = __builtin_amdgcn_readfirstlane(tid >> 6), lane = tid & 63, wr = wid >> 2, wc = wid & 3, fr = lane & 15, fq = lane >> 4;
    const int nt = K / BK;
    unsigned voffA[2];
#pragma unroll
    for (int i = 0; i < 2; ++i) { int R, C; stage_rc(tid * 16 + i * 8192, R, C); voffA[i] = (unsigned)(R * K + C) * 2u; }
    const size_t kstep = (size_t)(BK * 2);
    const size_t hstep = (size_t)HALF * K * 2;
    const unsigned ldsw = (unsigned)wid * 1024u;
    const int aoff = lds_byte(wr * 64 + fr, fq * 8), boff = lds_byte(wc * 32 + fr, fq * 8);
#define PG8_SA(b, h) (((b) * 2 + (h)) * HTB)
#define PG8_SB(b, h) ((4 + (b) * 2 + (h)) * HTB)
#define PG8_STAGE(bufoff, gbase, voff) do { _Pragma("unroll") for (int _i = 0; _i < 2; ++_i) \
        __builtin_amdgcn_global_load_lds((const unsigned*)((const char*)(gbase) + (voff)[_i]), (PG8_LAS unsigned*)(lds + (bufoff) + ldsw + _i * 8192), 16, 0, 0); } while (0)
#define PG8_LDA(dst, b, h) do { _Pragma("unroll") for (int m = 0; m < 4; ++m) _Pragma("unroll") for (int k = 0; k < 2; ++k) dst[m][k] = *(const PG8_LAS bf16x8*)(lds + PG8_SA(b, h) + aoff + m * 2048 + k * 1024); } while (0)
#define PG8_LDB(dst, b, h) do { _Pragma("unroll") for (int n = 0; n < 2; ++n) _Pragma("unroll") for (int k = 0; k < 2; ++k) dst[n][k] = *(const PG8_LAS bf16x8*)(lds + PG8_SB(b, h) + boff + n * 2048 + k * 1024); } while (0)
#define PG8_MMA(ai, bj, At, Bt) do { __builtin_amdgcn_s_setprio(1); _Pragma("unroll") for (int m = 0; m < 4; ++m) _Pragma("unroll") for (int n = 0; n < 2; ++n) _Pragma("unroll") for (int k = 0; k < 2; ++k) \
        acc[ai][bj][m][n] = __builtin_amdgcn_mfma_f32_16x16x32_bf16(Bt[n][k], At[m][k], acc[ai][bj][m][n], 0, 0, 0); __builtin_amdgcn_s_setprio(0); } while (0)
#define PG8_WAIT_V(n) asm volatile("s_waitcnt vmcnt(" #n ")" ::: "memory")
#define PG8_WAIT_L(n) asm volatile("s_waitcnt lgkmcnt(" #n ")" ::: "memory")
#define PG8_BAR __builtin_amdgcn_s_barrier()
#define PG8_SCHED __builtin_amdgcn_sched_barrier(0)
    Unit cur, nxt; int ui = 0;
    if (!S.next(0, cur)) return;
    f32x4 acc[2][2][4][2];
#pragma unroll
    for (int a = 0; a < 2; ++a)
#pragma unroll
        for (int b = 0; b < 2; ++b)
#pragma unroll
            for (int m = 0; m < 4; ++m)
#pragma unroll
                for (int n = 0; n < 2; ++n) acc[a][b][m][n] = (f32x4){0.f, 0.f, 0.f, 0.f};
    bf16x8 At[4][2], B0[2][2], B1[2][2];
    const char* cA = cur.A; const char* cB = cur.B;
    PG8_STAGE(PG8_SB(0, 0), cB, voffA); PG8_STAGE(PG8_SA(0, 0), cA, voffA); PG8_STAGE(PG8_SB(0, 1), cB + hstep, voffA); PG8_STAGE(PG8_SA(0, 1), cA + hstep, voffA);
    if (wr == 1) PG8_BAR;
    PG8_WAIT_V(4); PG8_BAR;
    PG8_STAGE(PG8_SB(1, 0), cB + kstep, voffA); PG8_STAGE(PG8_SA(1, 0), cA + kstep, voffA); PG8_STAGE(PG8_SB(1, 1), cB + hstep + kstep, voffA);
    PG8_WAIT_V(6); PG8_BAR;
    for (;;) {
        const bool has_next = S.next(ui + 1, nxt);
        const char* nA = has_next ? nxt.A : cA; const char* nB = has_next ? nxt.B : cB;
        for (int t = 0; t < nt; t += 2) {
            const bool last = (t == nt - 2);
            const char* a1 = cA + (size_t)(t + 1) * kstep;
            const char* a2 = last ? nA : cA + (size_t)(t + 2) * kstep; const char* b2 = last ? nB : cB + (size_t)(t + 2) * kstep;
            const char* a3 = a2 + kstep; const char* b3 = b2 + kstep;
            PG8_LDB(B0, 0, 0); PG8_SCHED; PG8_LDA(At, 0, 0); PG8_STAGE(PG8_SA(1, 1), a1 + hstep, voffA);
            PG8_WAIT_L(8); PG8_BAR; PG8_WAIT_L(0); PG8_MMA(0, 0, At, B0); PG8_BAR; PG8_SCHED;
            PG8_LDB(B1, 0, 1); PG8_STAGE(PG8_SB(0, 0), b2, voffA);
            PG8_BAR; PG8_WAIT_L(0); PG8_MMA(0, 1, At, B1); PG8_BAR;
            PG8_LDA(At, 0, 1); PG8_STAGE(PG8_SA(0, 0), a2, voffA);
            PG8_BAR; PG8_WAIT_L(0); PG8_MMA(1, 0, At, B0); PG8_BAR; PG8_SCHED;
            PG8_STAGE(PG8_SB(0, 1), b2 + hstep, voffA);
            PG8_WAIT_V(6); PG8_BAR; PG8_MMA(1, 1, At, B1); PG8_BAR;
            PG8_LDB(B0, 1, 0); PG8_SCHED; PG8_LDA(At, 1, 0); PG8_STAGE(PG8_SA(0, 1), a2 + hstep, voffA);
            PG8_WAIT_L(8); PG8_BAR; PG8_WAIT_L(0); PG8_MMA(0, 0, At, B0); PG8_BAR; PG8_SCHED;
            PG8_LDB(B1, 1, 1); PG8_STAGE(PG8_SB(1, 0), b3, voffA);
            PG8_BAR; PG8_WAIT_L(0); PG8_MMA(0, 1, At, B1); PG8_BAR;
            PG8_LDA(At, 1, 1); PG8_STAGE(PG8_SA(1, 0), a3, voffA);
            PG8_BAR; PG8_WAIT_L(0); PG8_MMA(1, 0, At, B0); PG8_BAR; PG8_SCHED;
            PG8_STAGE(PG8_SB(1, 1), b3 + hstep, voffA);
            PG8_WAIT_V(6); PG8_BAR; PG8_MMA(1, 1, At, B1); PG8_BAR;
        }
        E(acc, cur, wr, wc, fr, fq);
        if (!has_next) break;
#pragma unroll
        for (int a = 0; a < 2; ++a)
#pragma unroll
            for (int b = 0; b < 2; ++b)
#pragma unroll
                for (int m = 0; m < 4; ++m)
#pragma unroll
                    for (int n = 0; n < 2; ++n) acc[a][b][m][n] = (f32x4){0.f, 0.f, 0.f, 0.f};
        cur = nxt; cA = nA; cB = nB; ++ui;
    }
    PG8_WAIT_V(0);
    if (wr == 0) PG8_BAR;
    PG8_BAR;
#undef PG8_SA
#undef PG8_SB
#undef PG8_STAGE
#undef PG8_LDA
#undef PG8_LDB
#undef PG8_MMA
#undef PG8_WAIT_V
#undef PG8_WAIT_L
#undef PG8_BAR
#undef PG8_SCHED
}
template <class F> struct EpiRC { F f;
    __device__ __forceinline__ void operator()(const f32x4 (&acc)[2][2][4][2], const Unit& u, int wr, int wc, int fr, int fq) const {
#pragma unroll
        for (int ai = 0; ai < 2; ++ai)
#pragma unroll
            for (int m = 0; m < 4; ++m) { const int row = u.pm * BM + ai * HALF + wr * 64 + m * 16 + fr;
#pragma unroll
                for (int bj = 0; bj < 2; ++bj)
#pragma unroll
                    for (int n = 0; n < 2; ++n) f(u, row, u.pn * BM + bj * HALF + wc * 32 + n * 16 + 4 * fq, acc[ai][bj][m][n]);
                asm volatile("" ::: "memory"); }
    } };
template <class F> __device__ __forceinline__ EpiRC<F> epi_rc(const F& f) { return EpiRC<F>{f}; }
template <class F> struct EpiPair { F f;
    __device__ __forceinline__ void operator()(const f32x4 (&acc)[2][2][4][2], const Unit& u, int wr, int wc, int fr, int fq) const {
#pragma unroll
        for (int ai = 0; ai < 2; ++ai)
#pragma unroll
            for (int m = 0; m < 4; ++m) { const int row = u.pm * BM + ai * HALF + wr * 64 + m * 16 + fr;
#pragma unroll
                for (int n = 0; n < 2; ++n) f(u, row, u.pn * HALF + wc * 32 + n * 16 + 4 * fq, acc[ai][0][m][n], acc[ai][1][m][n]);
                asm volatile("" ::: "memory"); }
    } };
template <class F> __device__ __forceinline__ EpiPair<F> epi_pair(const F& f) { return EpiPair<F>{f}; }
template <class F, class CF, class RF> struct EpiPre { F f; CF cf; RF rf;
    __device__ __forceinline__ void operator()(const f32x4 (&acc)[2][2][4][2], const Unit& u, int wr, int wc, int fr, int fq) const {
        f32x4 cv[2][2]; float rv[2][4];
#pragma unroll
        for (int bj = 0; bj < 2; ++bj)
#pragma unroll
            for (int n = 0; n < 2; ++n) cv[bj][n] = cf(u, u.pn * BM + bj * HALF + wc * 32 + n * 16 + 4 * fq);
#pragma unroll
        for (int ai = 0; ai < 2; ++ai)
#pragma unroll
            for (int m = 0; m < 4; ++m) rv[ai][m] = rf(u, u.pm * BM + ai * HALF + wr * 64 + m * 16 + fr);
#pragma unroll
        for (int ai = 0; ai < 2; ++ai)
#pragma unroll
            for (int m = 0; m < 4; ++m) { const int row = u.pm * BM + ai * HALF + wr * 64 + m * 16 + fr;
#pragma unroll
                for (int bj = 0; bj < 2; ++bj)
#pragma unroll
                    for (int n = 0; n < 2; ++n) f(u, row, u.pn * BM + bj * HALF + wc * 32 + n * 16 + 4 * fq, acc[ai][bj][m][n], cv[bj][n], rv[ai][m]);
                asm volatile("" ::: "memory"); }
    } };
template <class F, class CF, class RF> __device__ __forceinline__ EpiPre<F, CF, RF> epi_pre(const F& f, const CF& cf, const RF& rf) { return EpiPre<F, CF, RF>{f, cf, rf}; }
template <class F, class CF> struct EpiColFirst { F f; CF cf;
    __device__ __forceinline__ void operator()(const f32x4 (&acc)[2][2][4][2], const Unit& u, int wr, int wc, int fr, int fq) const {
#pragma unroll
        for (int bj = 0; bj < 2; ++bj)
#pragma unroll
            for (int n = 0; n < 2; ++n) { const int col = u.pn * BM + bj * HALF + wc * 32 + n * 16 + 4 * fq; const f32x4 cv = cf(u, col);
#pragma unroll
                for (int ai = 0; ai < 2; ++ai)
#pragma unroll
                    for (int m = 0; m < 4; ++m) f(u, u.pm * BM + ai * HALF + wr * 64 + m * 16 + fr, col, acc[ai][bj][m][n], cv);
                asm volatile("" ::: "memory"); }
    } };
template <class F, class CF> __device__ __forceinline__ EpiColFirst<F, CF> epi_colfirst(const F& f, const CF& cf) { return EpiColFirst<F, CF>{f, cf}; }
struct EpiResid { xt_t* X; const float* MOD; int layer;
    __device__ __forceinline__ void operator()(const f32x4 (&acc)[2][2][4][2], const Unit& u, int wr, int wc, int fr, int fq) const {
        const int row0 = u.pm * BM + wr * 64 + fr, col0 = u.pn * BM + wc * 32 + 4 * fq;
        const int strm = row0 < NLAT ? (row0 >> 12) : 4;
        const float* gp = MOD + ((size_t)layer * 5 + strm) * 6144 + 2048 + col0;
        f32x4 gt[2][2];
#pragma unroll
        for (int bj = 0; bj < 2; ++bj)
#pragma unroll
            for (int n = 0; n < 2; ++n) gt[bj][n] = *(const f32x4*)(gp + bj * HALF + n * 16);
#pragma unroll
        for (int ai = 0; ai < 2; ++ai) {
            f32x4 xv[4][2][2];
#pragma unroll
            for (int m = 0; m < 4; ++m)
#pragma unroll
                for (int bj = 0; bj < 2; ++bj)
#pragma unroll
                    for (int n = 0; n < 2; ++n) xv[m][bj][n] = xldv(X, (size_t)(row0 + ai * HALF + m * 16) * D + col0 + bj * HALF + n * 16);
#pragma unroll
            for (int m = 0; m < 4; ++m)
#pragma unroll
                for (int bj = 0; bj < 2; ++bj)
#pragma unroll
                    for (int n = 0; n < 2; ++n) xstv(X, (size_t)(row0 + ai * HALF + m * 16) * D + col0 + bj * HALF + n * 16, xv[m][bj][n] + gt[bj][n] * acc[ai][bj][m][n]);
            asm volatile("" ::: "memory");
        }
    } };
struct BatchSched { const char* A; const char* B; size_t strideA, strideB; int nM, nN, nb, K;
    __device__ __forceinline__ bool next(int i, Unit& u) const {
        const int nwg = nM * nN * nb; const int L = i * gdim() + bidx(); if (L >= nwg) return false;
        const int w = xcd_remap(L, nwg); const int per = nM * nN; u.g = w / per; const int r = w % per; u.pm = r / nN; u.pn = r % nN;
        u.A = A + u.g * strideA + (size_t)u.pm * BM * K * 2; u.B = B + u.g * strideB + (size_t)u.pn * BM * K * 2; return true; } };
}

template <class SrcF, class DRow>
__device__ __forceinline__ int cvt_tiles(const int wv_, char* lds, bf16_t* dst, int Kd, int Nd, int nbatch, size_t dstride, const SrcF& src, const DRow& drow, unsigned* queue = nullptr) {
    bf16_t* T = (bf16_t*)lds;
    const int tid = tidx_w(wv_);
    const int tk = Kd / 128, tn = Nd / 64, per = tk * tn, total = per * nbatch;
    {
        for (int t = bidx(); t < total; t += gdim()) {
            const int bt = t / per, r = t % per, k0 = (r % tk) * 128, n0 = (r / tk) * 64;
            float4 v[4];
#pragma unroll
            for (int i = 0; i < 4; ++i) { const int k = k0 + i * 32 + (tid >> 4), n = n0 + (tid & 15) * 4; const float* sp = src(bt, k, n); v[i] = sp ? *(const float4*)sp : make_float4(0.f, 0.f, 0.f, 0.f); }
            __syncthreads();
#pragma unroll
            for (int i = 0; i < 4; ++i) { const int k = i * 32 + (tid >> 4), n = (tid & 15) * 4;
                T[(n + 0) * 136 + k] = f2bf(v[i].x); T[(n + 1) * 136 + k] = f2bf(v[i].y); T[(n + 2) * 136 + k] = f2bf(v[i].z); T[(n + 3) * 136 + k] = f2bf(v[i].w); }
            __syncthreads();
            { const int n = tid >> 3, kc = (tid & 7) * 16;
              const u32x4 a = *(const u32x4*)(T + n * 136 + kc), b = *(const u32x4*)(T + n * 136 + kc + 8);
              bf16_t* dp = dst + bt * dstride + (size_t)drow(n0 + n) * Kd + k0 + kc;
              *(u32x4*)dp = a; *(u32x4*)(dp + 8) = b; }
        }
    }
    return 0;
}
__device__ __forceinline__ int moe_cvt(const Params& p, int layer, char* lds, int budget) {
    constexpr int QG = 2, T13 = NE * 8 * 44, TOT = T13 + NE * 11 * 16;
    bf16_t* T = (bf16_t*)lds;
    int* qslot = (int*)(lds + 64 * 136 * 2);
    const int tid = tidx();
    const float* w1 = p.moe_w1 + (size_t)layer * NE * D * FF; const float* w3 = p.moe_w3 + (size_t)layer * NE * D * FF; const float* w2 = p.moe_w2 + (size_t)layer * NE * FF * D;
    bf16_t* W13 = (bf16_t*)(p.ws + OFF_W13T + (size_t)(layer & 1) * SZ_WMOE); bf16_t* W2 = (bf16_t*)(p.ws + OFF_W2T + (size_t)(layer & 1) * SZ_WMOE);
    unsigned* queue = (unsigned*)(p.ws + OFF_QUEUE) + layer * 32;
    const bool ahead = budget < 0;
    int done = 0, tnext = 0;
    __syncthreads();
    if (tid == 0) qslot[0] = QG * (int)__hip_atomic_fetch_add(queue, 1u, __ATOMIC_RELAXED, __HIP_MEMORY_SCOPE_AGENT);
    __syncthreads();
    int t0 = __builtin_amdgcn_readfirstlane(qslot[0]);
    while (t0 < TOT && (ahead || done < budget)) {
        const bool more = ahead || done + 1 < budget;
        if (more && tid == 0) tnext = QG * (int)__hip_atomic_fetch_add(queue, 1u, __ATOMIC_RELAXED, __HIP_MEMORY_SCOPE_AGENT);
#pragma unroll 1
        for (int sub = 0; sub < QG; ++sub) {
            const int t = t0 + sub;
            const float* sp; bf16_t* dp; int ss, ds;
            if (t < T13) { const int e = t / 352, r = t % 352, k0 = (r & 7) * 128, n0 = (r >> 3) * 64; const int c0 = (n0 >> 8) * 128 + (n0 & 127);
                sp = (((n0 >> 7) & 1) ? w3 : w1) + ((size_t)e * D + k0) * FF + c0; ss = FF; dp = W13 + ((size_t)e * 2816 + n0) * D + k0; ds = D; }
            else { const int u = t - T13, e = u / 176, r = u % 176, k0 = (r % 11) * 128, n0 = (r / 11) * 64;
                sp = w2 + ((size_t)e * FF + k0) * D + n0; ss = D; dp = W2 + ((size_t)e * D + n0) * FF + k0; ds = FF; }
            float4 v[4];
#pragma unroll
            for (int i = 0; i < 4; ++i) v[i] = *(const float4*)(sp + (size_t)(i * 32 + (tid >> 4)) * ss + (tid & 15) * 4);
            __syncthreads();
#pragma unroll
            for (int i = 0; i < 4; ++i) { const int k = i * 32 + (tid >> 4), n = (tid & 15) * 4;
                T[(n + 0) * 136 + k] = f2bf(v[i].x); T[(n + 1) * 136 + k] = f2bf(v[i].y); T[(n + 2) * 136 + k] = f2bf(v[i].z); T[(n + 3) * 136 + k] = f2bf(v[i].w); }
            if (sub == QG - 1 && tid == 0) qslot[0] = more ? tnext : TOT;
            __syncthreads();
            { const int n = tid >> 3, kc = (tid & 7) * 16;
              const u32x4 a = *(const u32x4*)(T + n * 136 + kc), b = *(const u32x4*)(T + n * 136 + kc + 8);
              bf16_t* o = dp + (size_t)n * ds + kc;
              *(u32x4*)o = a; *(u32x4*)(o + 8) = b; }
        }
        ++done; t0 = __builtin_amdgcn_readfirstlane(qslot[0]);
    }
    __syncthreads();
    return done;
}
__device__ __forceinline__ void bg_cvt(const Params& p, int layer, char* lds, int budget) {
#pragma unroll 1
    for (int l = layer; l < 4 && l <= layer + 1 && budget > 0; ++l) budget -= moe_cvt(p, l, lds, budget);
}
__device__ __forceinline__ bool idle_tail(int nunits) { const int r = nunits % gdim(); return r != 0 && bidx() >= r; }
__device__ void ph_init(const Params& p, char* lds) {
    const int tid = tidx(), gtid = bidx() * NTHR + tid, gsz = gdim() * NTHR;
    xt_t* Xs = (xt_t*)(p.ws + OFF_X);
    const float4* x4 = (const float4*)p.x; const float4* c4 = (const float4*)p.ctx;
    { constexpr int NQ = NROW * 256 / 4;
      auto srcv = [&](int k) { return k < NLAT * 256 ? x4[k] : c4[k - NLAT * 256]; };
      for (int i = gtid; i < NQ; i += gsz) { const float4 t0 = srcv(i), t1 = srcv(i + NQ), t2 = srcv(i + 2 * NQ), t3 = srcv(i + 3 * NQ); xst(Xs, (size_t)4 * i, t0); xst(Xs, (size_t)4 * (i + NQ), t1); xst(Xs, (size_t)4 * (i + 2 * NQ), t2); xst(Xs, (size_t)4 * (i + 3 * NQ), t3); } }
    float* rc = (float*)(p.ws + OFF_ROPE_C); float* rs = (float*)(p.ws + OFF_ROPE_S);
    for (int i = gtid; i < TL * 32; i += gsz) {
        const int t = i >> 5, f = i & 31; const float pos = (float)((f < 16) ? (t >> 6) : (t & 63));
        const float inv = powf(10000.f, -(float)(f & 15) / 16.f); const float ang = pos * inv; rc[2 * i] = cosf(ang); rc[2 * i + 1] = sinf(ang);
    }
    float* sc = (float*)lds;
    float* red = sc + 5 * 1024;
    for (int i = tid; i < 5 * 1024; i += NTHR) { const float v = i < 4096 ? p.c[i] : p.c_ctx[i - 4096]; sc[i] = v / (1.f + expf(-v)); }
    __syncthreads();
    float* MOD = (float*)(p.ws + OFF_MOD);
    for (int item = bidx(); item < 4 * 96; item += gdim()) {
        const int l = item / 96, cg = item % 96, col = tid & 63, n = cg * 64 + col, kg = tid >> 6;
        const float* w = p.mod_w + ((size_t)l * 1024 + kg * 128) * 6144 + n;
        float a0 = 0, a1 = 0, a2 = 0, a3 = 0, a4 = 0;
#pragma unroll 16
        for (int k = 0; k < 128; ++k) { const float wv = w[(size_t)k * 6144]; const int kk = kg * 128 + k;
            a0 += sc[kk] * wv; a1 += sc[1024 + kk] * wv; a2 += sc[2048 + kk] * wv; a3 += sc[3072 + kk] * wv; a4 += sc[4096 + kk] * wv; }
        float* rr = red + (kg * 64 + col) * 5; rr[0] = a0; rr[1] = a1; rr[2] = a2; rr[3] = a3; rr[4] = a4;
        __syncthreads();
        if (tid < 320) { const int c2 = tid & 63, s = tid >> 6; float sum = 0;
            for (int q = 0; q < 8; ++q) sum += red[(q * 64 + c2) * 5 + s];
            MOD[((size_t)l * 5 + s) * 6144 + cg * 64 + c2] = sum + p.mod_b[l * 6144 + cg * 64 + c2]; }
        __syncthreads();
    }
}


__device__ void ph_small_cvt(const Params& p, char* lds) {
    for (int j = 0; j < 2; ++j) {
        char* wm = p.ws + OFF_WMLA + j * SZ_WMLA; char* wr = p.ws + OFF_WRW + j * SZ_WRW;
        const float* w_in = p.mla_w_in + (size_t)j * D * 448; const float* w_uq = p.mla_w_uq + (size_t)j * 256 * 1536; const float* w_ukv = p.mla_w_ukv + (size_t)j * 128 * 2048; const float* w_o = p.mla_w_o + (size_t)j * D * D;
        cvt_tiles(p.wv, lds, (bf16_t*)(wm + WM_IN), 1024, 512, 1, 0, [=](int, int k, int n) -> const float* { return n < 448 ? w_in + (size_t)k * 448 + n : nullptr; },
                  [=](int n) { if (n < 384 || n >= 448) return n; const int jj = n - 384; return 384 + (jj < 32 ? 2 * jj : 2 * (jj - 32) + 1); });
        cvt_tiles(p.wv, lds, (bf16_t*)(wm + WM_UQ), 256, 1536, 1, 0, [=](int, int k, int n) -> const float* { return w_uq + (size_t)k * 1536 + n; },
                  [=](int n) { const int h = n / 192, d = n % 192; if (d < 128) return n; const int jj = d - 128; return h * 192 + 128 + (jj < 32 ? 2 * jj : 2 * (jj - 32) + 1); });
        cvt_tiles(p.wv, lds, (bf16_t*)(wm + WM_UKV), 128, 2048, 1, 0, [=](int, int k, int n) -> const float* { return w_ukv + (size_t)k * 2048 + n; }, [=](int n) { return n; });
        cvt_tiles(p.wv, lds, (bf16_t*)(wm + WM_O), 1024, 1024, 1, 0, [=](int, int k, int n) -> const float* { return w_o + (size_t)k * D + n; }, [=](int n) { return n; });
        const float* w_rkv = p.rw_w_rkv + (size_t)j * 3 * D * D; const float* w1 = p.rw_w1 + (size_t)j * 2 * D * 64; const float* a1 = p.rw_a1 + (size_t)j * 2 * D * 64;
        const float* g1 = p.rw_g1 + (size_t)j * D * 128; const float* v1 = p.rw_v1; const float* rwo = p.rw_w_o + (size_t)j * D * D;
        cvt_tiles(p.wv, lds, (bf16_t*)(wr + WR_RKV), 1024, 1024, 3, (size_t)D * D, [=](int m, int k, int n) -> const float* { return w_rkv + ((size_t)m * D + k) * D + n; }, [=](int n) { return n; });
        cvt_tiles(p.wv, lds, (bf16_t*)(wr + WR_L), 1024, 256, 1, 0, [=](int, int k, int n) -> const float* { return n < 128 ? w1 + ((size_t)(n >> 6) * D + k) * 64 + (n & 63) : nullptr; }, [=](int n) { return n; });
        cvt_tiles(p.wv, lds, (bf16_t*)(wr + WR_L) + 256 * 1024, 1024, 256, 1, 0, [=](int, int k, int n) -> const float* { return n < 128 ? a1 + ((size_t)(n >> 6) * D + k) * 64 + (n & 63) : nullptr; }, [=](int n) { return n; });
        cvt_tiles(p.wv, lds, (bf16_t*)(wr + WR_L) + 2 * 256 * 1024, 1024, 256, 1, 0, [=](int, int k, int n) -> const float* { return n < 128 ? g1 + (size_t)k * 128 + n : nullptr; }, [=](int n) { return n; });
        cvt_tiles(p.wv, lds, (bf16_t*)(wr + WR_L) + 3 * 256 * 1024, 1024, 256, 1, 0, [=](int, int k, int n) -> const float* { return n < 32 ? v1 + (size_t)k * 32 + n : nullptr; }, [=](int n) { return n; });
        cvt_tiles(p.wv, lds, (bf16_t*)(wr + WR_O), 1024, 1024, 1, 0, [=](int, int k, int n) -> const float* { return rwo + (size_t)k * D + n; }, [=](int n) { return n; });
        const float* w2 = p.rw_w2 + (size_t)j * 2 * 64 * D; const float* a2 = p.rw_a2 + (size_t)j * 2 * 64 * D; const float* g2 = p.rw_g2 + (size_t)j * 128 * D; const float* v2 = p.rw_v2;
        cvt_tiles(p.wv, lds, (bf16_t*)(wr + WR_B2), 128, 2048, 2, (size_t)2048 * 128, [=](int bt, int k, int n) -> const float* { const int zz = n >> 10, c = n & 1023, l = k - zz * 64;
            if (l < 0 || l >= 64) return nullptr; return (bt == 0 ? w2 : a2) + ((size_t)zz * 64 + l) * D + c; }, [=](int n) { return n; });
        cvt_tiles(p.wv, lds, (bf16_t*)(wr + WR_B3), 128, 1024, 2, (size_t)1024 * 128, [=](int bt, int k, int n) -> const float* {
            if (bt == 0) return g2 + (size_t)k * D + n; return k < 32 ? v2 + (size_t)k * D + n : nullptr; }, [=](int n) { return n; });
    }
}

template <bool OUTF32>
__device__ void ph_norm_mod(const Params& p, int layer, const float* g, int part_sh, int part_sc, void* outp) {
    const int wid = tidx() >> 6, lane = tidx() & 63;
    const xt_t* X = (const xt_t*)(p.ws + OFF_X);
    int row = bidx() * 8 + wid;
    float4 nv[4];
    if (row < NROW) {
#pragma unroll
        for (int i = 0; i < 4; ++i) nv[i] = xld(X, (size_t)row * D + (lane + i * 64) * 4); }
    for (; row < NROW; row += gdim() * 8) {
        const int s = row_stream(row);
        const float* sh = modp(p, layer, s, part_sh); const float* sc = modp(p, layer, s, part_sc);
        float4 v[4]; float ss = 0;
#pragma unroll
        for (int i = 0; i < 4; ++i) { v[i] = nv[i]; ss += v[i].x * v[i].x + v[i].y * v[i].y + v[i].z * v[i].z + v[i].w * v[i].w; }
        { const int nrow = row + gdim() * 8;
          if (nrow < NROW) {
#pragma unroll
              for (int i = 0; i < 4; ++i) nv[i] = xld(X, (size_t)nrow * D + (lane + i * 64) * 4); } }
        ss = wave_sum(ss); const float rs = rsqrtf(ss * (1.f / D) + RMS_EPS);
#pragma unroll
        for (int i = 0; i < 4; ++i) {
            const int d = (lane + i * 64) * 4;
            const float4 gg = *(const float4*)(g + d), a = *(const float4*)(sc + d), b = *(const float4*)(sh + d);
            float4 o; o.x = v[i].x * rs * gg.x * (1.f + a.x) + b.x; o.y = v[i].y * rs * gg.y * (1.f + a.y) + b.y; o.z = v[i].z * rs * gg.z * (1.f + a.z) + b.z; o.w = v[i].w * rs * gg.w * (1.f + a.w) + b.w;
            if (OUTF32) *(float4*)((float*)outp + (size_t)row * D + d) = o;
            else { uint2 w; w.x = pk2(o.x, o.y); w.y = pk2(o.z, o.w); *(uint2*)((bf16_t*)outp + (size_t)row * D + d) = w; }
        }
    }
}

__device__ void ph_mla_mid(const Params& p, int j) {
    const int wid = tidx() >> 6, lane = tidx() & 63;
    const float* Z = (const float*)(p.ws + OFF_Z);
    bf16_t* CQN = (bf16_t*)(p.ws + OFF_CQN); bf16_t* CKVN = (bf16_t*)(p.ws + OFF_CKVN); bf16_t* K = (bf16_t*)(p.ws + OFF_K);
    const float* gq = p.mla_g_q + j * 256; const float* gkv = p.mla_g_kv + j * 128;
    const float* rc = (const float*)(p.ws + OFF_ROPE_C); const float* rs = (const float*)(p.ws + OFF_ROPE_S);
    for (int row = bidx() * 8 + wid; row < NROW; row += gdim() * 8) {
        const float* z = Z + (size_t)row * 512;
        const float4 q = *(const float4*)(z + lane * 4);
        const float2 kv = *(const float2*)(z + 256 + lane * 2);
        const float kr = z[384 + lane];
        float sq = wave_sum(q.x * q.x + q.y * q.y + q.z * q.z + q.w * q.w); const float rq = rsqrtf(sq * (1.f / 256.f) + RMS_EPS);
        float sk = wave_sum(kv.x * kv.x + kv.y * kv.y); const float rk = rsqrtf(sk * (1.f / 128.f) + RMS_EPS);
        const float4 g4 = *(const float4*)(gq + lane * 4); const float2 g2 = *(const float2*)(gkv + lane * 2);
        uint2 w; w.x = pk2(q.x * rq * g4.x, q.y * rq * g4.y); w.y = pk2(q.z * rq * g4.z, q.w * rq * g4.w);
        *(uint2*)(CQN + (size_t)row * 256 + lane * 4) = w;
        *(unsigned*)(CKVN + (size_t)row * 128 + lane * 2) = pk2(kv.x * rk * g2.x, kv.y * rk * g2.y);
        float o = kr;
        const float other = __builtin_bit_cast(float, __builtin_amdgcn_update_dpp(0, __builtin_bit_cast(int, kr), 0xB1, 0xF, 0xF, true));
        const bool lat = row < NLAT;
        if (lat) { const int t = row & (TL - 1), i = lane >> 1; const float2 cs = *(const float2*)(rc + (t * 32 + i) * 2); const float c = cs.x, s = cs.y;
            o = (lane & 1) ? (other * s + kr * c) : (kr * c - other * s); }
        const int b = lat ? (row >> 12) : ((row - NLAT) >> 8); const int tk = lat ? 256 + (row & (TL - 1)) : ((row - NLAT) & 255);
        const bf16_t ob = f2bf(o);
#pragma unroll
        for (int h = 0; h < 8; ++h) K[((size_t)(b * 8 + h) * TK + tk) * 192 + 128 + lane] = ob;
    }
}

__device__ void ph_qkv_post(const Params& p) {
    const int wid = tidx() >> 6, lane = tidx() & 63;
    const float* QRAW = (const float*)(p.ws + OFF_QRAW); const float* KVRAW = (const float*)(p.ws + OFF_KVRAW); const float* KR = (const float*)(p.ws + OFF_KR);
    bf16_t* Q = (bf16_t*)(p.ws + OFF_Q); bf16_t* K = (bf16_t*)(p.ws + OFF_K); bf16_t* V = (bf16_t*)(p.ws + OFF_V);
    const float* rc = (const float*)(p.ws + OFF_ROPE_C); const float* rs = (const float*)(p.ws + OFF_ROPE_S);
    for (int it = bidx() * 8 + wid; it < NROW * 8; it += gdim() * 8) {
        const int row = it >> 3, h = it & 7;
        const bool lat = row < NLAT; const int b = lat ? (row >> 12) : ((row - NLAT) >> 8); const int tk = lat ? 256 + (row & (TL - 1)) : ((row - NLAT) & 255);
        const size_t orow = (size_t)(b * 8 + h) * TK + tk;
        const float* q = QRAW + (size_t)row * 1536 + h * 192;
        const float q0 = q[lane], q1 = q[64 + lane]; float q2 = q[128 + lane];
        const auto sw = __builtin_amdgcn_permlane32_swap(__float_as_uint(q2), __float_as_uint(q2), false, false);
        if (lat) { const int t = row & (TL - 1), i = lane & 31; const float c = rc[t * 32 + i], s = rs[t * 32 + i];
            const float x1 = __uint_as_float(sw[0]), x2 = __uint_as_float(sw[1]); q2 = lane < 32 ? (x1 * c - x2 * s) : (x1 * s + x2 * c); }
        bf16_t* qo = Q + orow * 192; qo[lane] = f2bf(q0); qo[64 + lane] = f2bf(q1); qo[128 + lane] = f2bf(q2);
        const float* kv = KVRAW + (size_t)row * 2048 + h * 256;
        bf16_t* ko = K + orow * 192; ko[lane] = f2bf(kv[lane]); ko[64 + lane] = f2bf(kv[64 + lane]); ko[128 + lane] = f2bf(KR[(size_t)row * 64 + lane]);
        bf16_t* vo = V + orow * 128; vo[lane] = f2bf(kv[128 + lane]); vo[64 + lane] = f2bf(kv[192 + lane]);
    }
}

__device__ void ph_attn_naive(const Params& p, char* lds) {
    const int tid = tidx(), qi = tid >> 2, part = tid & 3;
    const bf16_t* Q = (const bf16_t*)(p.ws + OFF_Q); const bf16_t* K = (const bf16_t*)(p.ws + OFF_K); const bf16_t* V = (const bf16_t*)(p.ws + OFF_V);
    bf16_t* O = (bf16_t*)(p.ws + OFF_O);
    bf16_t* Ks = (bf16_t*)lds;
    bf16_t* Vs = Ks + 32 * 192;
    const int nitems = 32 * 34;
    for (int it = bidx(); it < nitems; it += gdim()) {
        const int bh = it / 34, qb = it % 34; const int b = bh >> 3, h = bh & 7;
        const int nkeys = qb < 2 ? TC : TK;
        const int tq = qb * 128 + qi;
        const bf16_t* qp = Q + ((size_t)bh * TK + tq) * 192 + part * 48;
        float q[48];
#pragma unroll
        for (int i = 0; i < 48; ++i) q[i] = bf2f(qp[i]) * ATT_SCALE;
        float o[32];
#pragma unroll
        for (int i = 0; i < 32; ++i) o[i] = 0.f;
        float m = -1e30f, l = 0.f;
        for (int k0 = 0; k0 < nkeys; k0 += 32) {
            __syncthreads();
            {
                const bf16_t* kg = K + ((size_t)bh * TK + k0) * 192; const bf16_t* vg = V + ((size_t)bh * TK + k0) * 128;
                for (int c = tid; c < 768; c += NTHR) *(u32x4*)(Ks + c * 8) = *(const u32x4*)(kg + c * 8);
                *(u32x4*)(Vs + tid * 8) = *(const u32x4*)(vg + tid * 8);
            }
            __syncthreads();
#pragma unroll 1
            for (int kg = 0; kg < 32; kg += 8) {
                float s[8]; float tmax = -1e30f;
#pragma unroll
                for (int kk = 0; kk < 8; ++kk) {
                    const bf16_t* kr = Ks + (kg + kk) * 192 + part * 48; float acc = 0.f;
#pragma unroll
                    for (int i = 0; i < 48; ++i) acc += q[i] * bf2f(kr[i]);
                    acc += __shfl_xor(acc, 1); acc += __shfl_xor(acc, 2);
                    s[kk] = acc; tmax = fmaxf(tmax, acc);
                    asm volatile("" ::: "memory");
                }
                const float mn = fmaxf(m, tmax), alpha = expf(m - mn); m = mn; l *= alpha;
#pragma unroll
                for (int i = 0; i < 32; ++i) o[i] *= alpha;
#pragma unroll
                for (int kk = 0; kk < 8; ++kk) {
                    const float pw = expf(s[kk] - mn); l += pw;
                    const bf16_t* vr = Vs + (kg + kk) * 128 + part * 32;
#pragma unroll
                    for (int i = 0; i < 32; ++i) o[i] += pw * bf2f(vr[i]);
                    asm volatile("" ::: "memory");
                }
            }
        }
        const float rl = 1.f / l;
        const int row = qb < 2 ? (NLAT + b * TC + tq) : (b * TL + tq - TC);
        bf16_t* op = O + (size_t)row * D + h * 128 + part * 32;
#pragma unroll
        for (int i = 0; i < 32; ++i) op[i] = f2bf(o[i] * rl);
    }
}


namespace fa {
using s16x4  = __attribute__((ext_vector_type(4))) short;
using f32x16 = __attribute__((ext_vector_type(16))) float;
constexpr int DQK = 192, DV = 128, KVBLK = 64;
constexpr float THR = 8.f;
constexpr int SHM_V = KVBLK * DV * 2, SHM_K = KVBLK * DQK * 2;
constexpr int SHM_ATTN = 2 * SHM_V + 2 * SHM_K + 8 * 64 * 4;
#define KSWZ(row, colB) ((row) * 384 + ((colB) ^ ((((row) >> 1) & 7) << 4)))
#define SBAR() __builtin_amdgcn_sched_barrier(0)
__device__ __forceinline__ int crow(int r, int hi) { return (r & 3) + 8 * (r >> 2) + 4 * hi; }
__device__ __forceinline__ unsigned cvtpk(float lo, float hi) { unsigned r; asm volatile("v_cvt_pk_bf16_f32 %0, %1, %2" : "=v"(r) : "v"(lo), "v"(hi)); return r; }
__device__ __forceinline__ void partialSM(f32x16& p0, f32x16& p1, float& m_reg, float& mn, float& alpha) {
  constexpr float C = ATT_SCALE * 1.4426950408889634f;
  float pmax = p0[0];
#pragma unroll
  for (int r = 1; r < 16; ++r) pmax = fmaxf(pmax, p0[r]);
#pragma unroll
  for (int r = 0; r < 16; ++r) pmax = fmaxf(pmax, p1[r]);
  { auto rr = __builtin_amdgcn_permlane32_swap(__float_as_uint(pmax), __float_as_uint(pmax), false, false);
    pmax = fmaxf(__uint_as_float(rr[0]), __uint_as_float(rr[1])); }
  if (__builtin_expect(__all(pmax - m_reg <= THR / ATT_SCALE), 1)) { mn = m_reg; alpha = 1.f; }
  else { mn = fmaxf(m_reg, pmax); alpha = __builtin_amdgcn_exp2f((m_reg - mn) * C); m_reg = mn; }
  float mnC = -mn * C;
#pragma unroll
  for (int r = 0; r < 16; ++r) p0[r] = fmaf(p0[r], C, mnC);
#pragma unroll
  for (int r = 0; r < 16; ++r) p1[r] = fmaf(p1[r], C, mnC);
#pragma unroll
  for (int r = 0; r < 16; ++r) p0[r] = __builtin_amdgcn_exp2f(p0[r]);
}
__device__ __forceinline__ void finishSM(f32x16& p0, f32x16& p1, float alpha, float& l_reg, bf16x8& pa0, bf16x8& pa1, bf16x8& pa2, bf16x8& pa3) {
#pragma unroll
  for (int r = 0; r < 16; ++r) p1[r] = __builtin_amdgcn_exp2f(p1[r]);
  float ps = 0;
#pragma unroll
  for (int r = 0; r < 16; ++r) ps += p0[r];
#pragma unroll
  for (int r = 0; r < 16; ++r) ps += p1[r];
  { auto rr = __builtin_amdgcn_permlane32_swap(__float_as_uint(ps), __float_as_uint(ps), false, false);
    ps = __uint_as_float(rr[0]) + __uint_as_float(rr[1]); }
  l_reg = l_reg * alpha + ps;
#define PK4(P, BASE, OUT) do { unsigned a0 = cvtpk(P[BASE + 0], P[BASE + 1]), a1 = cvtpk(P[BASE + 2], P[BASE + 3]);   \
    unsigned b0 = cvtpk(P[BASE + 4], P[BASE + 5]), b1 = cvtpk(P[BASE + 6], P[BASE + 7]);                              \
    auto r0 = __builtin_amdgcn_permlane32_swap(a0, b0, false, false); auto r1 = __builtin_amdgcn_permlane32_swap(a1, b1, false, false); \
    u32x4 w = {r0[0], r1[0], r0[1], r1[1]}; OUT = *reinterpret_cast<bf16x8*>(&w); } while (0)
  PK4(p0, 0, pa0); PK4(p0, 8, pa1); PK4(p1, 0, pa2); PK4(p1, 8, pa3);
#undef PK4
}
__device__ __forceinline__ void qkt(f32x16& p0, f32x16& p1, const char* Ks, const bf16x8* qr, int r32, int hi) {
  p0 = f32x16{}; p1 = f32x16{};
  const int swz = ((r32 >> 1) & 7) << 4;
  const char* b4[4];
#pragma unroll
  for (int dr = 0; dr < 4; ++dr) b4[dr] = Ks + r32 * 384 + ((dr * 32 + hi * 16) ^ swz);
#pragma unroll
  for (int d0 = 0; d0 < 12; ++d0) {
    bf16x8 b0 = *reinterpret_cast<const bf16x8*>(b4[d0 & 3] + (d0 >> 2) * 128);
    bf16x8 b1 = *reinterpret_cast<const bf16x8*>(b4[d0 & 3] + (d0 >> 2) * 128 + 32 * 384);
    p0 = __builtin_amdgcn_mfma_f32_32x32x16_bf16(b0, qr[d0], p0, 0, 0, 0);
    p1 = __builtin_amdgcn_mfma_f32_32x32x16_bf16(b1, qr[d0], p1, 0, 0, 0); }
}
__device__ __forceinline__ int v_st(int k, int c) { const int kk = (k & ~0xC) | ((k & 4) << 1) | ((k & 8) >> 1); return ((kk >> 3) * 4 + (c >> 5)) * 512 + ((kk & 7) * 32 + (c & 31)) * 2; }
__device__ __forceinline__ int v_rd_base(int lane) { return ((lane & 3) << 3) | (((lane >> 2) & 3) << 6) | (((lane >> 4) & 1) << 5) | (((lane >> 5) & 1) << 8); }
constexpr int v_rd_off(int d0, int ks, int half) { return d0 * 512 + ks * 4096 + half * 2048; }
template <int OFF> __device__ __forceinline__ s16x4 tr_read(int vb) {
  s16x4 r; asm volatile("ds_read_b64_tr_b16 %0, %1 offset:%2" : "=&v"(r) : "v"(vb), "i"(OFF) : "memory"); return r;
}
template <int D0> __device__ __forceinline__ void pv_one(f32x16& od, int vb, bf16x8 pa0, bf16x8 pa1, bf16x8 pa2, bf16x8 pa3) {
  const s16x4 l0 = tr_read<v_rd_off(D0, 0, 0)>(vb), h0 = tr_read<v_rd_off(D0, 0, 1)>(vb), l1 = tr_read<v_rd_off(D0, 1, 0)>(vb), h1 = tr_read<v_rd_off(D0, 1, 1)>(vb);
  const s16x4 l2 = tr_read<v_rd_off(D0, 2, 0)>(vb), h2 = tr_read<v_rd_off(D0, 2, 1)>(vb), l3 = tr_read<v_rd_off(D0, 3, 0)>(vb), h3 = tr_read<v_rd_off(D0, 3, 1)>(vb);
  asm volatile("s_waitcnt lgkmcnt(0)" ::: "memory"); SBAR();
#define PK(L, H) (bf16x8){L[0], L[1], L[2], L[3], H[0], H[1], H[2], H[3]}
  od = __builtin_amdgcn_mfma_f32_32x32x16_bf16(pa0, PK(l0, h0), od, 0, 0, 0);
  od = __builtin_amdgcn_mfma_f32_32x32x16_bf16(pa1, PK(l1, h1), od, 0, 0, 0);
  od = __builtin_amdgcn_mfma_f32_32x32x16_bf16(pa2, PK(l2, h2), od, 0, 0, 0);
  od = __builtin_amdgcn_mfma_f32_32x32x16_bf16(pa3, PK(l3, h3), od, 0, 0, 0);
#undef PK
}
__device__ __forceinline__ void pv_d0(f32x16* o, int vb, bf16x8 pa0, bf16x8 pa1, bf16x8 pa2, bf16x8 pa3) {
  pv_one<0>(o[0], vb, pa0, pa1, pa2, pa3); pv_one<1>(o[1], vb, pa0, pa1, pa2, pa3); pv_one<2>(o[2], vb, pa0, pa1, pa2, pa3); pv_one<3>(o[3], vb, pa0, pa1, pa2, pa3);
}
__device__ __forceinline__ void attn_body(const int wv_, const bf16_t* __restrict__ Qb, const bf16_t* __restrict__ Kh, const bf16_t* __restrict__ Vh, bf16_t* __restrict__ Ob, int ldo, int seq, char* lds, const float* __restrict__ ropecs  ) {
  const int tid = tidx_w(wv_), wid = tid >> 6, lane = tid & 63, r32 = lane & 31, hi = lane >> 5;
  char* V_lds = lds; char* K_lds = lds + 2 * SHM_V;
  float* ws = (float*)(lds + 2 * SHM_V + 2 * SHM_K) + wid * 64; float* li_l = ws; float* al_l = ws + 32;
  float m_reg = -1e30f, l_reg = 0; f32x16 o[4] = {}; bf16x8 qr[12];
  const bf16_t* Qw = Qb + (long)(wid * 32 + r32) * DQK + hi * 8;
#pragma unroll
  for (int d0 = 0; d0 < 12; ++d0) qr[d0] = *reinterpret_cast<const bf16x8*>(Qw + d0 * 16);
  if (ropecs) {
    const float* cs = ropecs + (size_t)(wid * 32 + r32) * 64;
#pragma unroll
    for (int d0 = 8; d0 < 12; ++d0) { const int i0 = (d0 - 8) * 8 + hi * 4; const f32x4 c0 = *(const f32x4*)(cs + i0 * 2), c1 = *(const f32x4*)(cs + i0 * 2 + 4);
      u32x4 w = *reinterpret_cast<u32x4*>(&qr[d0]); const float cc[4] = {c0[0], c0[2], c1[0], c1[2]}, ss[4] = {c0[1], c0[3], c1[1], c1[3]};
#pragma unroll
      for (int m = 0; m < 4; ++m) { const float x1 = __uint_as_float(w[m] << 16), x2 = __uint_as_float(w[m] & 0xffff0000u); w[m] = cvtpk(x1 * cc[m] - x2 * ss[m], x1 * ss[m] + x2 * cc[m]); }
      qr[d0] = *reinterpret_cast<bf16x8*>(&w); }
  }
  const int sr = tid >> 4, sc = (tid & 15) * 8, vst0 = v_st(sr, sc), vst1 = v_st(32 + sr, sc);
  int kst[3];
#pragma unroll
  for (int i = 0; i < 3; ++i) { const int c = tid + 512 * i, row = c / 24, cc = c % 24; kst[i] = KSWZ(row, cc * 16); }
  const int vb0 = (int)(uintptr_t)V_lds + v_rd_base(lane);
  struct { bf16x8 vs0, vs1, ks0, ks1, ks2; } sr_[1];
#define SLOAD(i, k0) do { const bf16_t* vt = Vh + (long)(k0) * DV; const bf16_t* kt = Kh + (long)(k0) * DQK; \
    sr_[i].vs0 = *reinterpret_cast<const bf16x8*>(vt + (sr) * DV + sc); sr_[i].vs1 = *reinterpret_cast<const bf16x8*>(vt + (32 + sr) * DV + sc); \
    sr_[i].ks0 = *reinterpret_cast<const bf16x8*>(kt + tid * 8); sr_[i].ks1 = *reinterpret_cast<const bf16x8*>(kt + (tid + 512) * 8); sr_[i].ks2 = *reinterpret_cast<const bf16x8*>(kt + (tid + 1024) * 8); } while (0)
#define SWRITE(b, i) do { *(bf16x8*)(V_lds + (b) * SHM_V + vst0) = sr_[i].vs0; *(bf16x8*)(V_lds + (b) * SHM_V + vst1) = sr_[i].vs1; \
    *(bf16x8*)(K_lds + (b) * SHM_K + kst[0]) = sr_[i].ks0; *(bf16x8*)(K_lds + (b) * SHM_K + kst[1]) = sr_[i].ks1; *(bf16x8*)(K_lds + (b) * SHM_K + kst[2]) = sr_[i].ks2; } while (0)
#define SWAIT() asm volatile("s_waitcnt vmcnt(5)" ::: "memory")
#define RESC(a) do { if (__any((a) < 1.f)) { if (hi == 0) al_l[r32] = (a); asm volatile("s_waitcnt lgkmcnt(0)" ::: "memory"); \
    _Pragma("unroll") for (int d = 0; d < 4; ++d) _Pragma("unroll") for (int r = 0; r < 16; ++r) o[d][r] *= al_l[crow(r, hi)]; } } while (0)
  f32x16 pA0, pA1; float mnA, alA; bf16x8 pa0, pa1, pa2, pa3; const int NT = seq / KVBLK;
  SLOAD(0, 0); SWRITE(0, 0);
  SLOAD(0, KVBLK);
  __syncthreads();
  for (int j = 0; j < NT; j += 2) {
    SBAR(); qkt(pA0, pA1, K_lds, qr, r32, hi);
    partialSM(pA0, pA1, m_reg, mnA, alA); RESC(alA);
    finishSM(pA0, pA1, alA, l_reg, pa0, pa1, pa2, pa3); SBAR();
    SWRITE(1, 0);
    if (j + 2 < NT) SLOAD(0, (j + 2) * KVBLK);
    SBAR();
    pv_d0(o, vb0, pa0, pa1, pa2, pa3);
    __syncthreads();
    SBAR(); qkt(pA0, pA1, K_lds + SHM_K, qr, r32, hi);
    partialSM(pA0, pA1, m_reg, mnA, alA); RESC(alA);
    finishSM(pA0, pA1, alA, l_reg, pa0, pa1, pa2, pa3); SBAR();
    if (j + 2 < NT) { SWRITE(0, 0); if (j + 3 < NT) SLOAD(0, (j + 3) * KVBLK); }
    SBAR();
    pv_d0(o, vb0 + SHM_V, pa0, pa1, pa2, pa3);
    __syncthreads();
  }
  if (hi == 0) li_l[r32] = l_reg; asm volatile("s_waitcnt lgkmcnt(0)" ::: "memory");
  float rli[16];
#pragma unroll
  for (int r = 0; r < 16; ++r) rli[r] = __builtin_amdgcn_rcpf(li_l[crow(r, hi)]);
  bf16_t* Ow = Ob + (long)(wid * 32) * ldo;
#pragma unroll
  for (int r = 0; r < 16; ++r) { int orow = crow(r, hi);
#pragma unroll
    for (int d0 = 0; d0 < 4; ++d0) Ow[(long)orow * ldo + d0 * 32 + r32] = f2bf(o[d0][r] * rli[r]); }
  __syncthreads();
#undef SLOAD
#undef SWRITE
#undef SWAIT
#undef RESC
}
#undef KSWZ
}

__device__ void ph_attn(const Params& p, char* lds) {
    const bf16_t* Q = (const bf16_t*)(p.ws + OFF_Q); const bf16_t* K = (const bf16_t*)(p.ws + OFF_K); const bf16_t* V = (const bf16_t*)(p.ws + OFF_V);
    bf16_t* O = (bf16_t*)(p.ws + OFF_O);
    const int G = gdim();
    for (int i = 0;; ++i) {
        const int L = i * G + bidx(); if (L >= 544) break;
        int bh, qb;
        if (L < 512) { const int w = g8::xcd_remap(L, 512); bh = w >> 4; qb = 1 + (w & 15); } else { bh = L - 512; qb = 0; }
        const int b = bh >> 3, h = bh & 7;
        const int seq = qb == 0 ? TC : TK;
        const int row0 = qb == 0 ? NLAT + b * TC : b * TL + (qb - 1) * 256;
        fa::attn_body(p.wv, Q + ((size_t)bh * TK + qb * 256) * 192, K + (size_t)bh * TK * 192, V + (size_t)bh * TK * 128, O + (size_t)row0 * D + h * 128, D, seq, lds,
                      qb == 0 ? nullptr : (const float*)(p.ws + OFF_ROPE_C) + (size_t)(qb - 1) * 256 * 64);
    }
}

__device__ void ph_norm2_router(const Params& p, int layer, char* lds, int nrows) {
    const int tid = tidx(), wid = tid >> 6, lane = tid & 63;
    float* rt = (float*)lds;
    const float* rg = p.moe_router + (size_t)layer * D * NE;
    for (int i = tid; i < D * NE / 4; i += NTHR) { const int d = i >> 2, eq = i & 3; ((float4*)rt)[(((d >> 8) * 4 + (d & 3)) * 4 + eq) * 64 + ((d & 255) >> 2)] = ((const float4*)rg)[i]; }
    __syncthreads();
    const xt_t* X = (const xt_t*)(p.ws + OFF_X); bf16_t* BN = (bf16_t*)(p.ws + OFF_H); float* AFF = (float*)(p.ws + OFF_AFF);
    const float* g = p.norm2_g + layer * D;
    int row = bidx() * 8 + wid;
    float4 nv[4];
    if (row < nrows) {
#pragma unroll
        for (int i = 0; i < 4; ++i) nv[i] = xld(X, (size_t)row * D + (lane + i * 64) * 4); }
    for (; row < nrows; row += gdim() * 8) {
        const int s = row_stream(row);
        const float* sh = modp(p, layer, s, 3); const float* sc = modp(p, layer, s, 4);
        float4 v[4]; float ss = 0;
#pragma unroll
        for (int i = 0; i < 4; ++i) { v[i] = nv[i]; ss += v[i].x * v[i].x + v[i].y * v[i].y + v[i].z * v[i].z + v[i].w * v[i].w; }
        { const int nrow = row + gdim() * 8;
          if (nrow < nrows) {
#pragma unroll
              for (int i = 0; i < 4; ++i) nv[i] = xld(X, (size_t)nrow * D + (lane + i * 64) * 4); } }
        ss = wave_sum(ss); const float rs = rsqrtf(ss * (1.f / D) + RMS_EPS);
        float lg[16];
#pragma unroll
        for (int e = 0; e < 16; ++e) lg[e] = 0.f;
#pragma unroll
        for (int i = 0; i < 4; ++i) {
            const int d = (lane + i * 64) * 4;
            const float4 gg = *(const float4*)(g + d), a = *(const float4*)(sc + d), b = *(const float4*)(sh + d);
            float o[4]; o[0] = v[i].x * rs * gg.x * (1.f + a.x) + b.x; o[1] = v[i].y * rs * gg.y * (1.f + a.y) + b.y; o[2] = v[i].z * rs * gg.z * (1.f + a.z) + b.z; o[3] = v[i].w * rs * gg.w * (1.f + a.w) + b.w;
            uint2 w; w.x = pk2(o[0], o[1]); w.y = pk2(o[2], o[3]); *(uint2*)(BN + (size_t)row * D + d) = w;
#pragma unroll
            for (int jj = 0; jj < 4; ++jj) {
#pragma unroll
                for (int eq = 0; eq < 4; ++eq) { const float4 r4 = ((const float4*)rt)[((i * 4 + jj) * 4 + eq) * 64 + lane];
                    lg[4 * eq] += o[jj] * r4.x; lg[4 * eq + 1] += o[jj] * r4.y; lg[4 * eq + 2] += o[jj] * r4.z; lg[4 * eq + 3] += o[jj] * r4.w; } }
            asm volatile("" ::: "memory");
        }
        float mx = -1e30f;
#pragma unroll
        for (int e = 0; e < 16; ++e) { lg[e] = wave_sum(lg[e]); mx = fmaxf(mx, lg[e]); }
        float sum = 0;
#pragma unroll
        for (int e = 0; e < 16; ++e) { lg[e] = expf(lg[e] - mx); sum += lg[e]; }
        const float inv = 1.f / sum;
        if (lane < 16) { float val = 0;
#pragma unroll
            for (int e = 0; e < 16; ++e) val = (lane == e) ? lg[e] : val;
            AFF[(size_t)row * 16 + lane] = val * inv; }
    }
}

__device__ void ph_select(const Params& p, char* lds, int ngroups) {
    const int tid = tidx(), wid = tid >> 6, lane = tid & 63;
    unsigned* hist = (unsigned*)lds;
    unsigned* ctl = hist + 256;
    unsigned* wsum = ctl + 8;
    int* rowl = (int*)(wsum + 16);
    const float* AFF = (const float*)(p.ws + OFF_AFF);
    int* ROWIDX = (int*)(p.ws + OFF_ROWIDX); float* GATE = (float*)(p.ws + OFF_GATE); int* SLOT = (int*)(p.ws + OFF_SLOT);
    for (int gidx = bidx(); gidx < ngroups; gidx += gdim()) {
        const bool lat = gidx < 64; const int b = (gidx & 63) >> 4, e = gidx & 15;
        const int n = lat ? TL : TC, cap = lat ? CAPL : CAPC;
        const int row0 = lat ? b * TL : NLAT + b * TC, slot0 = lat ? b * CAPL : NB * CAPL + b * CAPC;
        unsigned key[8];
#pragma unroll
        for (int i = 0; i < 8; ++i) { const int idx = tid * 8 + i; key[i] = idx < n ? __float_as_uint(AFF[(size_t)(row0 + idx) * 16 + e]) : 0u; }
        unsigned prefix = 0u, remaining = (unsigned)cap;
#pragma unroll
        for (int pass = 0; pass < 4; ++pass) {
            const int sh = 24 - 8 * pass;
            __syncthreads();
            if (tid < 256) hist[tid] = 0u;
            __syncthreads();
#pragma unroll
            for (int i = 0; i < 8; ++i) { const int idx = tid * 8 + i;
                const bool cand = idx < n && (pass == 0 || (key[i] >> (sh + 8)) == prefix);
                if (cand) atomicAdd(&hist[(key[i] >> sh) & 255u], 1u); }
            __syncthreads();
            if (tid < 256) { unsigned gt = 0; for (int jj = tid + 1; jj < 256; ++jj) gt += hist[jj];
                const unsigned mine = hist[tid];
                if (gt < remaining && remaining <= gt + mine) { ctl[0] = (unsigned)tid; ctl[1] = remaining - gt; } }
            __syncthreads();
            prefix = (prefix << 8) | ctl[0]; remaining = ctl[1];
        }
        const unsigned T = prefix, m = remaining;
        unsigned cgt = 0, ceq = 0;
#pragma unroll
        for (int i = 0; i < 8; ++i) { const int idx = tid * 8 + i; if (idx < n) { cgt += key[i] > T ? 1u : 0u; ceq += key[i] == T ? 1u : 0u; } }
        auto block_excl = [&](unsigned v) -> unsigned {
            unsigned inc = v;
#pragma unroll
            for (int o = 1; o < 64; o <<= 1) { const unsigned t = (unsigned)__builtin_amdgcn_ds_bpermute((lane - o) << 2, (int)inc); if (lane >= o) inc += t; }
            __syncthreads();
            if (lane == 63) wsum[wid] = inc;
            __syncthreads();
            unsigned base = 0;
#pragma unroll
            for (int w = 0; w < 8; ++w) base += (w < wid) ? wsum[w] : 0u;
            return base + inc - v; };
        unsigned eqbase = block_excl(ceq);
        unsigned nsel = 0; bool sel[8];
#pragma unroll
        for (int i = 0; i < 8; ++i) { const int idx = tid * 8 + i; bool s_ = false;
            if (idx < n) { if (key[i] > T) s_ = true; else if (key[i] == T) { s_ = eqbase < m; ++eqbase; } }
            sel[i] = s_; nsel += s_ ? 1u : 0u; }
        unsigned sbase = block_excl(nsel);
#pragma unroll
        for (int i = 0; i < 8; ++i) { const int idx = tid * 8 + i;
            if (idx < n) {
                if (sel[i]) { const int sl = slot0 + (int)sbase; rowl[sbase] = row0 + idx; ++sbase; ROWIDX[e * ESLOTS + sl] = row0 + idx; GATE[e * EPAD + sl] = __uint_as_float(key[i]); SLOT[(size_t)(row0 + idx) * 16 + e] = sl; }
                else SLOT[(size_t)(row0 + idx) * 16 + e] = -1; } }
        __syncthreads();
        { const bf16_t* BN = (const bf16_t*)(p.ws + OFF_H); bf16_t* XE = (bf16_t*)(p.ws + OFF_XE);
          for (int r = wid; r < cap; r += 32) {
              u32x4 t_[4][2];
#pragma unroll
              for (int u = 0; u < 4; ++u) { const u32x4* src = (const u32x4*)(BN + (size_t)rowl[r + 8 * u] * D); t_[u][0] = src[lane]; t_[u][1] = src[lane + 64]; }
#pragma unroll
              for (int u = 0; u < 4; ++u) { u32x4* dst = (u32x4*)(XE + ((size_t)e * EPAD + slot0 + r + 8 * u) * D); dst[lane] = t_[u][0]; dst[lane + 64] = t_[u][1]; } } }
    }
}

__device__ void ph_gather(const Params& p, int nslots) {
    const int wid = tidx() >> 6, lane = tidx() & 63;
    const int* ROWIDX = (const int*)(p.ws + OFF_ROWIDX); const bf16_t* BN = (const bf16_t*)(p.ws + OFF_H); bf16_t* XE = (bf16_t*)(p.ws + OFF_XE);
    for (int it = bidx() * 8 + wid; it < NE * ESLOTS; it += gdim() * 8) {
        const int e = it / ESLOTS, sl = it % ESLOTS; if (sl >= nslots) continue; const int row = ROWIDX[it];
        const u32x4* src = (const u32x4*)(BN + (size_t)row * D); u32x4* dst = (u32x4*)(XE + ((size_t)e * EPAD + sl) * D);
        dst[lane] = src[lane]; dst[lane + 64] = src[lane + 64];
    }
}

__device__ void ph_combine(const Params& p, int layer, int nrows) {
    const int wid = tidx() >> 6, lane = tidx() & 63;
    const int* SLOT = (const int*)(p.ws + OFF_SLOT); const bf16_t* YE = (const bf16_t*)(p.ws + OFF_YE); xt_t* X = (xt_t*)(p.ws + OFF_X);
    int row = bidx() * 8 + wid;
    int sl = (row < nrows && lane < 16) ? SLOT[(size_t)row * 16 + lane] : -1;
    while (row < nrows) {
        const int nrow = row + gdim() * 8;
        const int sln = (nrow < nrows && lane < 16) ? SLOT[(size_t)nrow * 16 + lane] : -1;
        const float* gt = modp(p, layer, row_stream(row), 5);
        xt_t* xr = X + (size_t)row * D + lane * 8;
        f32x4 xv[4];
#pragma unroll
        for (int i = 0; i < 2; ++i) { xv[2 * i] = xldv(xr, 512 * i); xv[2 * i + 1] = xldv(xr, 512 * i + 4); }
        unsigned long long m = __ballot(sl >= 0);
        float acc[16];
#pragma unroll
        for (int i = 0; i < 16; ++i) acc[i] = 0.f;
        while (m) {
            const int e0 = __builtin_ctzll(m); m &= m - 1; const bool two = m != 0; const int e1 = two ? __builtin_ctzll(m) : e0; if (two) m &= m - 1;
            const int s0 = __builtin_amdgcn_readlane(sl, e0), s1 = __builtin_amdgcn_readlane(sl, e1);
            const bf16_t* y0 = YE + ((size_t)e0 * EPAD + s0) * D + lane * 8; const bf16_t* y1 = YE + ((size_t)e1 * EPAD + s1) * D + lane * 8;
            const u32x4 a0 = *(const u32x4*)y0, a1 = *(const u32x4*)(y0 + 512), b0 = *(const u32x4*)y1, b1 = *(const u32x4*)(y1 + 512);
            const float f1 = two ? 1.f : 0.f;
#pragma unroll
            for (int i = 0; i < 4; ++i) { acc[2 * i] += __uint_as_float(a0[i] << 16) + f1 * __uint_as_float(b0[i] << 16); acc[2 * i + 1] += __uint_as_float(a0[i] & 0xffff0000u) + f1 * __uint_as_float(b0[i] & 0xffff0000u);
                acc[8 + 2 * i] += __uint_as_float(a1[i] << 16) + f1 * __uint_as_float(b1[i] << 16); acc[8 + 2 * i + 1] += __uint_as_float(a1[i] & 0xffff0000u) + f1 * __uint_as_float(b1[i] & 0xffff0000u); }
        }
#pragma unroll
        for (int i = 0; i < 2; ++i) { const f32x4 g0 = *(const f32x4*)(gt + lane * 8 + 512 * i), g1 = *(const f32x4*)(gt + lane * 8 + 512 * i + 4);
            f32x4 o0 = xv[2 * i], o1 = xv[2 * i + 1];
#pragma unroll
            for (int e = 0; e < 4; ++e) { o0[e] += g0[e] * acc[8 * i + e]; o1[e] += g1[e] * acc[8 * i + 4 + e]; }
            xstv(xr, 512 * i, o0); xstv(xr, 512 * i + 4, o1); }
        row = nrow; sl = sln;
    }
}

template <bool FINAL>
__device__ void ph_comb_norm(const Params& p, int lprev, int layer, int nrows) {
    const int wid = tidx() >> 6, lane = tidx() & 63;
    const int* SLOT = (const int*)(p.ws + OFF_SLOT); const bf16_t* YE = (const bf16_t*)(p.ws + OFF_YE); xt_t* X = (xt_t*)(p.ws + OFF_X);
    bf16_t* H = (bf16_t*)(p.ws + OFF_H);
    const float* g = FINAL ? p.final_g : p.norm1_g + layer * D;
    int row = bidx() * 8 + wid;
    int sl = (row < nrows && lane < 16) ? SLOT[(size_t)row * 16 + lane] : -1;
    while (row < nrows) {
        const int nrow = row + gdim() * 8;
        const int sln = (nrow < nrows && lane < 16) ? SLOT[(size_t)nrow * 16 + lane] : -1;
        const int strm = row_stream(row);
        const float* gt = modp(p, lprev, strm, 5);
        xt_t* xr = X + (size_t)row * D + lane * 8;
        f32x4 xv[4];
#pragma unroll
        for (int i = 0; i < 2; ++i) { xv[2 * i] = xldv(xr, 512 * i); xv[2 * i + 1] = xldv(xr, 512 * i + 4); }
        unsigned long long m = __ballot(sl >= 0);
        float acc[16];
#pragma unroll
        for (int i = 0; i < 16; ++i) acc[i] = 0.f;
        while (m) {
            const int e0 = __builtin_ctzll(m); m &= m - 1; const bool two = m != 0; const int e1 = two ? __builtin_ctzll(m) : e0; if (two) m &= m - 1;
            const int s0 = __builtin_amdgcn_readlane(sl, e0), s1 = __builtin_amdgcn_readlane(sl, e1);
            const bf16_t* y0 = YE + ((size_t)e0 * EPAD + s0) * D + lane * 8; const bf16_t* y1 = YE + ((size_t)e1 * EPAD + s1) * D + lane * 8;
            const u32x4 a0 = *(const u32x4*)y0, a1 = *(const u32x4*)(y0 + 512), b0 = *(const u32x4*)y1, b1 = *(const u32x4*)(y1 + 512);
            const float f1 = two ? 1.f : 0.f;
#pragma unroll
            for (int i = 0; i < 4; ++i) { acc[2 * i] += __uint_as_float(a0[i] << 16) + f1 * __uint_as_float(b0[i] << 16); acc[2 * i + 1] += __uint_as_float(a0[i] & 0xffff0000u) + f1 * __uint_as_float(b0[i] & 0xffff0000u);
                acc[8 + 2 * i] += __uint_as_float(a1[i] << 16) + f1 * __uint_as_float(b1[i] << 16); acc[8 + 2 * i + 1] += __uint_as_float(a1[i] & 0xffff0000u) + f1 * __uint_as_float(b1[i] & 0xffff0000u); }
        }
        float ss = 0.f;
#pragma unroll
        for (int i = 0; i < 2; ++i) { const f32x4 g0 = *(const f32x4*)(gt + lane * 8 + 512 * i), g1 = *(const f32x4*)(gt + lane * 8 + 512 * i + 4);
#pragma unroll
            for (int e = 0; e < 4; ++e) { xv[2 * i][e] += g0[e] * acc[8 * i + e]; xv[2 * i + 1][e] += g1[e] * acc[8 * i + 4 + e]; ss += xv[2 * i][e] * xv[2 * i][e] + xv[2 * i + 1][e] * xv[2 * i + 1][e]; }
            if (!FINAL) { xstv(xr, 512 * i, xv[2 * i]); xstv(xr, 512 * i + 4, xv[2 * i + 1]); } }
        ss = wave_sum(ss); const float rs = rsqrtf(ss * (1.f / D) + RMS_EPS);
        const float* sh = FINAL ? nullptr : modp(p, layer, strm, 0); const float* sc = FINAL ? nullptr : modp(p, layer, strm, 1);
#pragma unroll
        for (int i = 0; i < 2; ++i)
#pragma unroll
            for (int hh = 0; hh < 2; ++hh) { const int d = lane * 8 + 512 * i + 4 * hh; const f32x4 gg = *(const f32x4*)(g + d); f32x4 o = xv[2 * i + hh] * rs * gg;
                if (FINAL) *(f32x4*)(p.out + (size_t)row * D + d) = o;
                else { o = o * (1.f + *(const f32x4*)(sc + d)) + *(const f32x4*)(sh + d); stbf4(H + (size_t)row * D + d, o); } }
        row = nrow; sl = sln;
    }
}

__device__ void ph_rw_normxs(const Params& p, int layer, int j) {
    const int wid = tidx() >> 6, lane = tidx() & 63;
    const xt_t* X = (const xt_t*)(p.ws + OFF_X); bf16_t* XS = (bf16_t*)(p.ws + OFF_XS);
    const float* mu = p.rw_mu + (size_t)j * 6 * D; const float* g = p.norm1_g + layer * D;
    float4 fc[4], fp[4], fn[4];
#define XS_LOAD(R) do { const bool lat_ = (R) < NLAT; const int t_ = lat_ ? ((R) & (TL - 1)) : (((R) - NLAT) & (TC - 1)); const int len_ = lat_ ? TL : TC; \
        _Pragma("unroll") for (int i = 0; i < 4; ++i) { fc[i] = xld(X, (size_t)(R) * D + (lane + i * 64) * 4); \
            fp[i] = t_ > 0 ? xld(X, (size_t)((R) - 1) * D + (lane + i * 64) * 4) : make_float4(0, 0, 0, 0); \
            fn[i] = t_ < len_ - 1 ? xld(X, (size_t)((R) + 1) * D + (lane + i * 64) * 4) : make_float4(0, 0, 0, 0); } } while (0)
    int row = bidx() * 8 + wid;
    if (row < NROW) XS_LOAD(row);
    for (; row < NROW; row += gdim() * 8) {
        const int s_ = row_stream(row);
        const float* sh = modp(p, layer, s_, 0); const float* sc = modp(p, layer, s_, 1);
        const bool lat = row < NLAT; const int t = lat ? (row & (TL - 1)) : ((row - NLAT) & (TC - 1)); const int len = lat ? TL : TC;
        const bool hp = t > 0, hn = t < len - 1;
        float4 xc[4], xp[4], xn[4]; float sc_ = 0, sp_ = 0, sn_ = 0;
#pragma unroll
        for (int i = 0; i < 4; ++i) { xc[i] = fc[i]; xp[i] = fp[i]; xn[i] = fn[i]; }
        { const int nrow = row + gdim() * 8; if (nrow < NROW) XS_LOAD(nrow); }
#pragma unroll
        for (int i = 0; i < 4; ++i) {
            sc_ += xc[i].x * xc[i].x + xc[i].y * xc[i].y + xc[i].z * xc[i].z + xc[i].w * xc[i].w;
            sp_ += xp[i].x * xp[i].x + xp[i].y * xp[i].y + xp[i].z * xp[i].z + xp[i].w * xp[i].w;
            sn_ += xn[i].x * xn[i].x + xn[i].y * xn[i].y + xn[i].z * xn[i].z + xn[i].w * xn[i].w; }
        sc_ = wave_sum(sc_); sp_ = wave_sum(sp_); sn_ = wave_sum(sn_);
        const float rc = rsqrtf(sc_ * (1.f / D) + RMS_EPS), rp = hp ? rsqrtf(sp_ * (1.f / D) + RMS_EPS) : 0.f, rn = hn ? rsqrtf(sn_ * (1.f / D) + RMS_EPS) : 0.f;
#pragma unroll
        for (int i = 0; i < 4; ++i) {
            const int d = (lane + i * 64) * 4;
            const float4 gg = *(const float4*)(g + d), a = *(const float4*)(sc + d), bsh = *(const float4*)(sh + d);
            float h[4], xx[4];
            const float gm[4] = {gg.x * (1.f + a.x), gg.y * (1.f + a.y), gg.z * (1.f + a.z), gg.w * (1.f + a.w)}; const float bb[4] = {bsh.x, bsh.y, bsh.z, bsh.w};
            const float c4[4] = {xc[i].x, xc[i].y, xc[i].z, xc[i].w}, p4[4] = {xp[i].x, xp[i].y, xp[i].z, xp[i].w}, n4[4] = {xn[i].x, xn[i].y, xn[i].z, xn[i].w};
#pragma unroll
            for (int e = 0; e < 4; ++e) { h[e] = c4[e] * rc * gm[e] + bb[e];
                const float hpv = hp ? p4[e] * rp * gm[e] + bb[e] : 0.f, hnv = hn ? n4[e] * rn * gm[e] + bb[e] : 0.f;
                xx[e] = 0.5f * (hpv + hnv) - h[e]; }
#pragma unroll
            for (int m = 0; m < 6; ++m) { const float4 u = *(const float4*)(mu + m * D + d);
                uint2 w; w.x = pk2(h[0] + xx[0] * u.x, h[1] + xx[1] * u.y); w.y = pk2(h[2] + xx[2] * u.z, h[3] + xx[3] * u.w);
                *(uint2*)(XS + ((size_t)m * NROW + row) * D + d) = w; }
        }
    }
#undef XS_LOAD
}

__device__ __forceinline__ int scan_row(int i, int b, int z) {
    return i < TC ? NLAT + b * TC + (z ? TC - 1 - i : i) : b * TL + (z ? TL - 1 - (i - TC) : i - TC);
}
__device__ __forceinline__ float dpp_sum8(float x) {
    x += __builtin_bit_cast(float, __builtin_amdgcn_update_dpp(0, __builtin_bit_cast(int, x), 0xB1, 0xF, 0xF, true));
    x += __builtin_bit_cast(float, __builtin_amdgcn_update_dpp(0, __builtin_bit_cast(int, x), 0x4E, 0xF, 0xF, true));
    x += __builtin_bit_cast(float, __builtin_amdgcn_update_dpp(0, __builtin_bit_cast(int, x), 0x141, 0xF, 0xF, true));
    return x;
}
__device__ void ph_rw_scan(const Params& p, int j, char* lds) {
    const int tid = tidx(), wid = __builtin_amdgcn_readfirstlane(tid >> 6), lane = tid & 63;
    const size_t PL = (size_t)NROW * D;
    const float* RKV = (const float*)(p.ws + OFF_RKV); float* Y = (float*)(p.ws + OFF_Y);
    constexpr int CH = 32, BUFB = 5 * CH * 256 + CH * 128 + CH * 16, YB = CH * 32 * 4, NCH = (TC + TL) / CH;
    const bool loader = wid >= 4; const int lw = wid - 4;
    for (int it = bidx(); it < 256; it += gdim()) {
        const int vh = it & 1, z = (it >> 1) & 1, h = (it >> 2) & 15, b = it >> 6;
        const char* pl0 = (const char*)((const float*)(p.ws + OFF_W) + z * PL); const char* pl1 = (const char*)(RKV + PL);
        const char* pl2 = (const char*)((const float*)(p.ws + OFF_AV) + z * PL); const char* pl3 = (const char*)RKV;
        const char* vpl = (const char*)(RKV + 2 * PL);
        float* yout = Y + z * PL;
        __builtin_amdgcn_s_barrier();
        if (loader) {
            const int pq = lane & 15;
            const f32x4 kkv = *(const f32x4*)(p.rw_k_k + j * D + h * 64 + pq * 4), kav = *(const f32x4*)(p.rw_k_a + j * D + h * 64 + pq * 4);
            auto issue = [&](int c) {
                char* buf = lds + (c % 3) * BUFB;
#pragma unroll
                for (int q = 0; q < 8; ++q) { const int pi = q >> 1, tg = lw * 2 + (q & 1); const int row = scan_row(c * CH + tg * 4 + (lane >> 4), b, z);
                    const char* base = pi == 0 ? pl0 : pi == 1 ? pl1 : pi == 2 ? pl2 : pl3;
                    __builtin_amdgcn_global_load_lds((const unsigned*)(base + (size_t)row * D * 4 + h * 256 + (lane & 15) * 16), (LAS unsigned*)(buf + pi * (CH * 256) + tg * 1024), 16, 0, 0); }
                { const int row = scan_row(c * CH + lw * 8 + (lane >> 3), b, z);
                  __builtin_amdgcn_global_load_lds((const unsigned*)(vpl + (size_t)row * D * 4 + (h * 64 + vh * 32) * 4 + (lane & 7) * 16), (LAS unsigned*)(buf + 5 * CH * 256 + lw * 1024), 16, 0, 0); }
            };
            auto prep = [&](int c) {
                char* buf = lds + (c % 3) * BUFB;
#pragma unroll
                for (int ps = 0; ps < 2; ++ps) { const int ptok = lw * 8 + ps * 4 + (lane >> 4);
                    f32x4* kp = (f32x4*)(buf + 1 * CH * 256 + ptok * 256 + pq * 16); f32x4* ap = (f32x4*)(buf + 2 * CH * 256 + ptok * 256 + pq * 16); f32x4* dp = (f32x4*)(buf + 4 * CH * 256 + ptok * 256 + pq * 16);
                    f32x4* rp = (f32x4*)(buf + 3 * CH * 256 + ptok * 256 + pq * 16); const f32x4 wv = *(const f32x4*)(buf + ptok * 256 + pq * 16);
                    const f32x4 k = *kp, a = *ap, r = *rp; f32x4 kk = k * kkv;
                    float ss = kk[0] * kk[0] + kk[1] * kk[1] + kk[2] * kk[2] + kk[3] * kk[3]; ss = dpp_sum16(ss);
                    const float inv = 1.f / fmaxf(sqrtf(ss), 1e-12f); kk = kk * inv;
                    const f32x4 kd = k * (1.f + (a - 1.f) * kav), bb = kk * a;
                    const f32x4 t1 = bb * r, t2 = kd * r;
                    const float br = dpp_sum16((t1[0] + t1[1]) + (t1[2] + t1[3])), kr = dpp_sum16((t2[0] + t2[1]) + (t2[2] + t2[3]));
                    *dp = kd; *ap = bb; *kp = kk; *rp = wv * r;
                    if (pq == 0) *(float2*)(buf + 5 * CH * 256 + CH * 128 + ptok * 16) = make_float2(br, kr); }
            };
            issue(0); issue(1);
            asm volatile("s_waitcnt vmcnt(9)" ::: "memory");
            prep(0);
            asm volatile("s_waitcnt lgkmcnt(0)" ::: "memory"); __builtin_amdgcn_s_barrier();
            for (int c = 0; c < NCH; ++c) {
                if (c >= 1) { const float* yb = (const float*)(lds + 3 * BUFB + ((c - 1) & 1) * YB);
                    const int lt = tid - 256, t = lt >> 3, q = lt & 7; const int row = scan_row((c - 1) * CH + t, b, z);
                    *(f32x4*)(yout + (size_t)row * D + h * 64 + vh * 32 + q * 4) = *(const f32x4*)(yb + t * 32 + q * 4); }
                if (c + 2 < NCH) { issue(c + 2); asm volatile("s_waitcnt vmcnt(9)" ::: "memory"); } else asm volatile("s_waitcnt vmcnt(0)" ::: "memory");
                if (c + 1 < NCH) prep(c + 1);
                asm volatile("s_waitcnt lgkmcnt(0)" ::: "memory"); __builtin_amdgcn_s_barrier();
            }
            { const float* yb = (const float*)(lds + 3 * BUFB + ((NCH - 1) & 1) * YB);
              const int lt = tid - 256, t = lt >> 3, q = lt & 7; const int row = scan_row((NCH - 1) * CH + t, b, z);
              *(f32x4*)(yout + (size_t)row * D + h * 64 + vh * 32 + q * 4) = *(const f32x4*)(yb + t * 32 + q * 4); }
        } else {
            const int vr = lane >> 3, ks = lane & 7;
            f32x4 Sa = {0.f, 0.f, 0.f, 0.f}, Sb = {0.f, 0.f, 0.f, 0.f};
            __builtin_amdgcn_s_barrier();
            struct Ops { f32x4 w0, w1, kk0, kk1, bb0, bb1, r0, r1, kd0, kd1; float v; float2 sc; };
#define SC_LOAD(O, t) do { const char* q_ = bq + (t) * 256; O.w0 = *(const f32x4*)(q_); O.w1 = *(const f32x4*)(q_ + 16); O.kk0 = *(const f32x4*)(q_ + CH * 256); O.kk1 = *(const f32x4*)(q_ + CH * 256 + 16); \
                O.bb0 = *(const f32x4*)(q_ + 2 * CH * 256); O.bb1 = *(const f32x4*)(q_ + 2 * CH * 256 + 16); O.r0 = *(const f32x4*)(q_ + 3 * CH * 256); O.r1 = *(const f32x4*)(q_ + 3 * CH * 256 + 16); \
                O.kd0 = *(const f32x4*)(q_ + 4 * CH * 256); O.kd1 = *(const f32x4*)(q_ + 4 * CH * 256 + 16); O.v = *(const float*)(vq + (t) * 128); O.sc = *(const float2*)(buf + 5 * CH * 256 + CH * 128 + (t) * 16); } while (0)
#define SC_STEP(O, t) do { const f32x4 d1 = Sa * O.kk0 + Sb * O.kk1, d2 = Sa * O.r0 + Sb * O.r1; \
                float sa = -((d1[0] + d1[1]) + (d1[2] + d1[3])), yy = (d2[0] + d2[1]) + (d2[2] + d2[3]); \
                sa = dpp_sum8(sa); yy = dpp_sum8(yy); \
                Sa = Sa * O.w0 + (sa * O.bb0 + O.v * O.kd0); Sb = Sb * O.w1 + (sa * O.bb1 + O.v * O.kd1); \
                if (ks == 0) yb[(t) * 32 + wid * 8 + vr] = yy + sa * O.sc.x + O.v * O.sc.y; } while (0)
            for (int c = 0; c < NCH; ++c) {
                const char* buf = lds + (c % 3) * BUFB; float* yb = (float*)(lds + 3 * BUFB + (c & 1) * YB);
                const char* bq = buf + ks * 32; const char* vq = buf + 5 * CH * 256 + (wid * 8 + vr) * 4;
                Ops oA, oB, oC;
                SC_LOAD(oA, 0); SC_LOAD(oB, 1);
#pragma unroll
                for (int t = 0; t < CH; t += 3) {
                    if (t + 2 < CH) SC_LOAD(oC, t + 2);
                    SC_STEP(oA, t);
                    if (t + 3 < CH) SC_LOAD(oA, t + 3);
                    if (t + 1 < CH) SC_STEP(oB, t + 1);
                    if (t + 4 < CH) SC_LOAD(oB, t + 4);
                    if (t + 2 < CH) SC_STEP(oC, t + 2);
                }
                asm volatile("s_waitcnt lgkmcnt(0)" ::: "memory"); __builtin_amdgcn_s_barrier();
            }
#undef SC_LOAD
#undef SC_STEP
        }
    }
}


namespace ck {
constexpr int P = 72, MB = 64 * P * 2;
typedef __attribute__((address_space(3))) char lchar;
__device__ __forceinline__ f32x4 mm_tile(const lchar* Aop, const lchar* Bop, int ti, int tj, int c, int q, f32x4 acc) {
#pragma unroll
    for (int ks = 0; ks < 2; ++ks) {
        const bf16x8 a = *(const LAS bf16x8*)(Aop + ((16 * ti + c) * P + 32 * ks + 8 * q) * 2);
        const bf16x8 b = *(const LAS bf16x8*)(Bop + ((16 * tj + c) * P + 32 * ks + 8 * q) * 2);
        acc = __builtin_amdgcn_mfma_f32_16x16x32_bf16(a, b, acc, 0, 0, 0);
    }
    return acc;
}
__device__ __forceinline__ f32x4 mm_diag(const lchar* Aop, const lchar* Bop, int tt, int c, int q, f32x4 acc) {
    const int ks = tt >> 1;
    bf16x8 a = *(const LAS bf16x8*)(Aop + ((16 * tt + c) * P + 32 * ks + 8 * q) * 2);
    const bf16x8 b = *(const LAS bf16x8*)(Bop + ((16 * tt + c) * P + 32 * ks + 8 * q) * 2);
    if ((q >> 1) != (tt & 1)) a = (bf16x8){0, 0, 0, 0, 0, 0, 0, 0};
    return __builtin_amdgcn_mfma_f32_16x16x32_bf16(a, b, acc, 0, 0, 0);
}
__device__ __forceinline__ void st_tile(lchar* dst, int ti, int tj, int c, int q, f32x4 v) {
    u32x2 w; w.x = pk2(v[0], v[1]); w.y = pk2(v[2], v[3]); *(LAS u32x2*)(dst + ((16 * tj + c) * P + 16 * ti + 4 * q) * 2) = w;
}
__device__ __forceinline__ f32x4 ld_tile(const lchar* src, int ti, int tj, int c, int q) {
    const u32x2 w = *(const LAS u32x2*)(src + ((16 * tj + c) * P + 16 * ti + 4 * q) * 2);
    return (f32x4){__uint_as_float(w.x << 16), __uint_as_float(w.x & 0xffff0000u), __uint_as_float(w.y << 16), __uint_as_float(w.y & 0xffff0000u)};
}
__device__ __forceinline__ void st_glob(bf16_t* dst, int ti, int tj, int c, int q, f32x4 v) {
    uint2 w; w.x = pk2(v[0], v[1]); w.y = pk2(v[2], v[3]); *(uint2*)(dst + (16 * tj + c) * 64 + 16 * ti + 4 * q) = w;
}
typedef float f32x16 __attribute__((ext_vector_type(16)));
__device__ __forceinline__ f32x16 mm32(const lchar* Aop, const lchar* Bop, int ti, int tj, int r32, int hi, f32x16 acc) {
#pragma unroll
    for (int ks = 0; ks < 4; ++ks) {
        const bf16x8 a = *(const LAS bf16x8*)(Aop + ((32 * ti + r32) * P + 16 * ks + 8 * hi) * 2);
        const bf16x8 b = *(const LAS bf16x8*)(Bop + ((32 * tj + r32) * P + 16 * ks + 8 * hi) * 2);
        acc = __builtin_amdgcn_mfma_f32_32x32x16_bf16(a, b, acc, 0, 0, 0);
    }
    return acc;
}
__device__ __forceinline__ void st32(lchar* dst, int ti, int tj, int r32, int hi, const f32x16& v) {
#pragma unroll
    for (int g = 0; g < 4; ++g) { u32x2 w; w.x = pk2(v[4 * g], v[4 * g + 1]); w.y = pk2(v[4 * g + 2], v[4 * g + 3]); *(LAS u32x2*)(dst + ((32 * tj + r32) * P + 32 * ti + 8 * g + 4 * hi) * 2) = w; }
}
__device__ __forceinline__ f32x16 ld32(const lchar* src, int ti, int tj, int r32, int hi) {
    f32x16 v;
#pragma unroll
    for (int g = 0; g < 4; ++g) { const u32x2 w = *(const LAS u32x2*)(src + ((32 * tj + r32) * P + 32 * ti + 8 * g + 4 * hi) * 2);
        v[4 * g] = __uint_as_float(w.x << 16); v[4 * g + 1] = __uint_as_float(w.x & 0xffff0000u); v[4 * g + 2] = __uint_as_float(w.y << 16); v[4 * g + 3] = __uint_as_float(w.y & 0xffff0000u); }
    return v;
}
__device__ __forceinline__ void stg32(bf16_t* dst, int ti, int tj, int r32, int hi, const f32x16& v) {
#pragma unroll
    for (int g = 0; g < 4; ++g) { uint2 w; w.x = pk2(v[4 * g], v[4 * g + 1]); w.y = pk2(v[4 * g + 2], v[4 * g + 3]); *(uint2*)(dst + (32 * tj + r32) * 64 + 32 * ti + 8 * g + 4 * hi) = w; }
}
}

#define LBAR() do { asm volatile("s_waitcnt lgkmcnt(0)" ::: "memory"); __builtin_amdgcn_s_barrier(); asm volatile("" ::: "memory"); } while (0)
__device__ void ph_rw_sc1(const Params& p, int j, char* lds) {
    using namespace ck;
    const int tid = tidx(), wid = __builtin_amdgcn_readfirstlane(tid >> 6), lane = tid & 63, c = lane & 15, q = lane >> 4;
    const size_t PL = (size_t)NROW * D;
    const bf16_t* RKV = (const bf16_t*)(p.ws + OFF_RKV); const float* LW = (const float*)(p.ws + OFF_W); const bf16_t* AV = (const bf16_t*)(p.ws + OFF_AV);
    bf16_t* CK = (bf16_t*)(p.ws + OFF_CK);
    lchar* B0 = (lchar*)lds;
#define BUF(i) (B0 + (i) * MB)
    LAS float* Lbuf = (LAS float*)BUF(8);
    LAS float* Lseg = (LAS float*)(B0 + 16 * MB);
    LAS float* GC = Lseg + 8 * 64;
    const int pt = tid >> 3, cg = tid & 7;
    f32x4 nlw[2], nkk[2], nka[2]; u32x4 nkx, nax, nrx, nvx;
#define SC1_LOAD(IT) do { const int seq_ = (IT) / NCHK, ch_ = (IT) % NCHK; const int z_ = seq_ & 1, h_ = (seq_ >> 1) & 15, b_ = seq_ >> 5; \
        const size_t go_ = (size_t)scan_row(ch_ * 64 + pt, b_, z_) * D + h_ * 64 + cg * 8; \
        _Pragma("unroll") for (int e = 0; e < 2; ++e) nlw[e] = *(const f32x4*)(LW + z_ * PL + go_ + 4 * e); \
        nkx = *(const u32x4*)(RKV + PL + go_); nax = *(const u32x4*)(AV + z_ * PL + go_); nrx = *(const u32x4*)(RKV + go_); nvx = *(const u32x4*)(RKV + 2 * PL + go_); \
        _Pragma("unroll") for (int e = 0; e < 2; ++e) { nkk[e] = *(const f32x4*)(p.rw_k_k + j * D + h_ * 64 + cg * 8 + 4 * e); nka[e] = *(const f32x4*)(p.rw_k_a + j * D + h_ * 64 + cg * 8 + 4 * e); } } while (0)
    if (bidx() < 128 * NCHK) SC1_LOAD(bidx());
    for (int it = bidx(); it < 128 * NCHK; it += gdim()) {
        const int seq = it / NCHK; const int h = (seq >> 1) & 15;
        f32x4 lw[2], kx[2], ax[2], rx[2], vx[2], kkc[2], kac[2];
#pragma unroll
        for (int e = 0; e < 2; ++e) { lw[e] = nlw[e]; kkc[e] = nkk[e]; kac[e] = nka[e];
            kx[e] = (f32x4){__uint_as_float(nkx[2 * e] << 16), __uint_as_float(nkx[2 * e] & 0xffff0000u), __uint_as_float(nkx[2 * e + 1] << 16), __uint_as_float(nkx[2 * e + 1] & 0xffff0000u)};
            ax[e] = (f32x4){__uint_as_float(nax[2 * e] << 16), __uint_as_float(nax[2 * e] & 0xffff0000u), __uint_as_float(nax[2 * e + 1] << 16), __uint_as_float(nax[2 * e + 1] & 0xffff0000u)};
            rx[e] = (f32x4){__uint_as_float(nrx[2 * e] << 16), __uint_as_float(nrx[2 * e] & 0xffff0000u), __uint_as_float(nrx[2 * e + 1] << 16), __uint_as_float(nrx[2 * e + 1] & 0xffff0000u)};
            vx[e] = (f32x4){__uint_as_float(nvx[2 * e] << 16), __uint_as_float(nvx[2 * e] & 0xffff0000u), __uint_as_float(nvx[2 * e + 1] << 16), __uint_as_float(nvx[2 * e + 1] & 0xffff0000u)}; }
        if (it + gdim() < 128 * NCHK) SC1_LOAD(it + gdim());
        LBAR();
#pragma unroll
        for (int e = 0; e < 2; ++e) *(LAS f32x4*)(Lbuf + pt * 64 + cg * 8 + 4 * e) = lw[e];
        f32x4 kk[2], bq[2], kd[2];
        { float ss = 0.f;
#pragma unroll
          for (int e = 0; e < 2; ++e) { kk[e] = kx[e] * kkc[e]; ss += kk[e][0] * kk[e][0] + kk[e][1] * kk[e][1] + kk[e][2] * kk[e][2] + kk[e][3] * kk[e][3]; }
          ss = dpp_sum8(ss); const float inv = __builtin_amdgcn_rsqf(fmaxf(ss, 1e-24f));
#pragma unroll
          for (int e = 0; e < 2; ++e) { kk[e] = kk[e] * inv; bq[e] = kk[e] * ax[e]; kd[e] = kx[e] * (1.f + (ax[e] - 1.f) * kac[e]); } }
        LBAR();
        { const int k = tid & 63, sg = tid >> 6; float run = 0.f;
#pragma unroll
          for (int u = 0; u < 8; ++u) { run += Lbuf[(sg * 8 + u) * 64 + k]; Lbuf[(sg * 8 + u) * 64 + k] = run; }
          Lseg[sg * 64 + k] = run; }
        LBAR();
        f32x4 Lt[2], Lp[2], Lc[2];
        { const int sg = pt >> 3, sgp = (pt - 1) >> 3;
#pragma unroll
          for (int e = 0; e < 2; ++e) { f32x4 o0 = {0.f, 0.f, 0.f, 0.f}, o1 = o0, oc = o0;
#pragma unroll
              for (int u = 0; u < 8; ++u) { const f32x4 sv = *(const LAS f32x4*)(Lseg + u * 64 + cg * 8 + 4 * e); if (u < sg) o0 = o0 + sv; if (u < sgp) o1 = o1 + sv; if (u < 7) oc = oc + sv; }
              Lt[e] = *(const LAS f32x4*)(Lbuf + pt * 64 + cg * 8 + 4 * e) + o0;
              Lp[e] = pt > 0 ? *(const LAS f32x4*)(Lbuf + (pt - 1) * 64 + cg * 8 + 4 * e) + o1 : (f32x4){0.f, 0.f, 0.f, 0.f};
              Lc[e] = *(const LAS f32x4*)(Lbuf + 63 * 64 + cg * 8 + 4 * e) + oc; } }
        LBAR();
        {
            float at[8], bt[8], kt[8], rt[8], bh[8], kh[8], vv[8];
#pragma unroll
            for (int e = 0; e < 2; ++e)
#pragma unroll
                for (int u = 0; u < 4; ++u) { const int x = 4 * e + u; const float eL = __expf(Lt[e][u]), emL = __expf(-Lt[e][u]), eP = __expf(Lp[e][u]), eC = __expf(Lc[e][u] - Lt[e][u]);
                    at[x] = -kk[e][u] * eP; bt[x] = bq[e][u] * emL; kt[x] = kd[e][u] * emL; rt[x] = rx[e][u] * eL; bh[x] = bq[e][u] * eC; kh[x] = kd[e][u] * eC; vv[x] = vx[e][u];
                    if (pt == 63) GC[cg * 8 + x] = eL; }
#define ST8(bufi, arr) do { u32x4 w_ = {pk2(arr[0], arr[1]), pk2(arr[2], arr[3]), pk2(arr[4], arr[5]), pk2(arr[6], arr[7])}; *(LAS u32x4*)(BUF(bufi) + (pt * P + cg * 8) * 2) = w_; } while (0)
            ST8(0, at); ST8(1, bt); ST8(2, kt); ST8(3, rt); ST8(8, bh); ST8(9, kh); ST8(10, vv);
#undef ST8
        }
        LBAR();
        {
            const int k = tid & 63, tg = tid >> 6;
#define TR8(src, dst) do { unsigned w_[4]; _Pragma("unroll") for (int x = 0; x < 4; ++x) { const unsigned lo = *(const LAS bf16_t*)(BUF(src) + ((tg * 8 + 2 * x) * P + k) * 2), hi2 = *(const LAS bf16_t*)(BUF(src) + ((tg * 8 + 2 * x + 1) * P + k) * 2); w_[x] = lo | (hi2 << 16); } \
                *(LAS u32x4*)(BUF(dst) + (k * P + tg * 8) * 2) = (u32x4){w_[0], w_[1], w_[2], w_[3]}; } while (0)
            TR8(0, 4); TR8(8, 5); TR8(9, 6); TR8(10, 7);
#undef TR8
        }
        LBAR();
        const f32x4 Z4 = {0.f, 0.f, 0.f, 0.f};
        const f32x16 Z16 = {0.f, 0.f, 0.f, 0.f, 0.f, 0.f, 0.f, 0.f, 0.f, 0.f, 0.f, 0.f, 0.f, 0.f, 0.f, 0.f};
        const int r32 = lane & 31, hi = lane >> 5;
#pragma unroll 1
        for (int u = 0; u < 2; ++u) { const int tl = u * 8 + wid;
            if (tl >= 14) {
                if (tl == 14) { st32(BUF(8), 0, 1, r32, hi, Z16); st32(BUF(8), 1, 0, r32, hi, Z16); st32(BUF(14), 0, 1, r32, hi, Z16); st32(BUF(14), 1, 0, r32, hi, Z16); st32(BUF(9), 1, 0, r32, hi, Z16); }
                else { st32(BUF(15), 1, 0, r32, hi, Z16); st32(BUF(13), 1, 0, r32, hi, Z16); st32(BUF(10), 1, 0, r32, hi, Z16); st32(BUF(11), 1, 0, r32, hi, Z16); st32(BUF(12), 1, 0, r32, hi, Z16); }
                break; }
            const int m = (tl + 1) / 3, rr = (tl + 1) % 3, ti = rr == 2, tj = m == 0 ? ti : (rr >= 1); const int jj = 32 * tj + r32;
            if (m == 0) { f32x16 v = mm32(BUF(0), BUF(1), ti, tj, r32, hi, Z16), w;
#pragma unroll
                for (int e = 0; e < 16; ++e) { const int ii = 32 * ti + 8 * (e >> 2) + 4 * hi + (e & 3); const bool dg = (ii >> 4) == (jj >> 4);
                    v[e] = (dg && jj < ii) ? v[e] : 0.f; w[e] = v[e] + ((ii == jj) ? 1.f : 0.f); }
                st32(BUF(8), ti, tj, r32, hi, v); st32(BUF(14), ti, tj, r32, hi, w); }
            else if (m == 1) { const f32x16 v = mm32(BUF(1), BUF(0), ti, tj, r32, hi, Z16); f32x16 vd, vo, w;
#pragma unroll
                for (int e = 0; e < 16; ++e) { const int ii = 32 * ti + 8 * (e >> 2) + 4 * hi + (e & 3); const bool dg = (ii >> 4) == (jj >> 4), up = ii < jj;
                    vd[e] = (dg && up) ? v[e] : 0.f; vo[e] = (!dg && up) ? v[e] : 0.f; w[e] = vd[e] + ((ii == jj) ? 1.f : 0.f); }
                st32(BUF(9), ti, tj, r32, hi, vd); st32(BUF(15), ti, tj, r32, hi, vo); st32(BUF(13), ti, tj, r32, hi, w); }
            else if (m == 2) { f32x16 v = mm32(BUF(2), BUF(0), ti, tj, r32, hi, Z16);
#pragma unroll
                for (int e = 0; e < 16; ++e) { const int ii = 32 * ti + 8 * (e >> 2) + 4 * hi + (e & 3); v[e] = ii < jj ? v[e] : 0.f; }
                st32(BUF(10), ti, tj, r32, hi, v); }
            else { f32x16 v = mm32(m == 3 ? BUF(1) : BUF(2), BUF(3), ti, tj, r32, hi, Z16);
#pragma unroll
                for (int e = 0; e < 16; ++e) { const int ii = 32 * ti + 8 * (e >> 2) + 4 * hi + (e & 3); v[e] = ii <= jj ? v[e] : 0.f; }
                st32(m == 3 ? BUF(11) : BUF(12), ti, tj, r32, hi, v); } }
        LBAR();
#define WSYNC() asm volatile("s_waitcnt lgkmcnt(0)" ::: "memory")
        if (wid < 4) {
            const int tt = wid;
#define SQD(sr, st, dr, dt) do { const f32x4 a_ = mm_diag(BUF(st), BUF(sr), tt, c, q, Z4), b_ = mm_diag(BUF(sr), BUF(st), tt, c, q, Z4); WSYNC(); \
                st_tile(BUF(dr), tt, tt, c, q, a_); st_tile(BUF(dt), tt, tt, c, q, b_); WSYNC(); } while (0)
#define UPD(pr) do { const f32x4 dt_ = mm_diag(BUF(pr), BUF(13), tt, c, q, ld_tile(BUF(13), tt, tt, c, q)); \
                const f32x4 dr_ = mm_diag(BUF(13), BUF(pr), tt, c, q, ld_tile(BUF(14), tt, tt, c, q)); WSYNC(); \
                st_tile(BUF(13), tt, tt, c, q, dt_); st_tile(BUF(14), tt, tt, c, q, dr_); WSYNC(); } while (0)
            SQD(8, 9, 0, 1); UPD(0); SQD(0, 1, 8, 9); UPD(8); SQD(8, 9, 0, 1); UPD(0);
#undef SQD
#undef UPD
        } else {
            const int ti = (wid >> 1) & 1, tj = wid & 1; st32(BUF(2), ti, tj, r32, hi, mm32(BUF(10), BUF(7), ti, tj, r32, hi, Z16));
        }
        LBAR();
        { const int m = wid >> 2, ti = (wid >> 1) & 1, tj = wid & 1;
          if (m == 0) st32(BUF(8), ti, tj, r32, hi, mm32(BUF(15), BUF(14), ti, tj, r32, hi, Z16));
          else        st32(BUF(9), ti, tj, r32, hi, mm32(BUF(14), BUF(15), ti, tj, r32, hi, Z16)); }
        LBAR();
        if (wid < 4) { const int ti = (wid >> 1) & 1, tj = wid & 1; st32(BUF(0), ti, tj, r32, hi, mm32(BUF(9), BUF(8), ti, tj, r32, hi, Z16)); }
        LBAR();
        if (wid < 4) { const int ti = (wid >> 1) & 1, tj = wid & 1; st32(BUF(1), ti, tj, r32, hi, mm32(BUF(0), BUF(13), ti, tj, r32, hi, ld32(BUF(13), ti, tj, r32, hi))); }
        LBAR();
        if (wid < 4) { const int ti = (wid >> 1) & 1, tj = wid & 1; st32(BUF(14), ti, tj, r32, hi, mm32(BUF(8), BUF(1), ti, tj, r32, hi, ld32(BUF(1), ti, tj, r32, hi))); }
        LBAR();
        { const int m = wid >> 2, ti = (wid >> 1) & 1, tj = wid & 1;
          if (m == 0) st32(BUF(8), ti, tj, r32, hi, mm32(BUF(14), BUF(4), ti, tj, r32, hi, Z16));
          else        st32(BUF(0), ti, tj, r32, hi, mm32(BUF(14), BUF(2), ti, tj, r32, hi, Z16)); }
        LBAR();
        bf16_t* ckp = CK + (size_t)it * 4 * 4096;
#pragma unroll 1
        for (int u = 0; u < 2; ++u) { const int tl = u * 8 + wid, m = tl >> 2, ti = (tl >> 1) & 1, tj = tl & 1;
            if (m == 0) { f32x16 v = mm32(BUF(8), BUF(5), ti, tj, r32, hi, Z16); const int jj = 32 * tj + r32; const float gc = GC[jj];
#pragma unroll
                for (int e = 0; e < 16; ++e) { const int ii = 32 * ti + 8 * (e >> 2) + 4 * hi + (e & 3); v[e] += (ii == jj) ? gc : 0.f; }
                st32(BUF(1), ti, tj, r32, hi, v); }
            else if (m == 1) st32(BUF(4), ti, tj, r32, hi, mm32(BUF(8), BUF(11), ti, tj, r32, hi, ld32(BUF(3), ti, tj, r32, hi)));
            else if (m == 2) st32(BUF(2), ti, tj, r32, hi, mm32(BUF(6), BUF(7), ti, tj, r32, hi, mm32(BUF(5), BUF(0), ti, tj, r32, hi, Z16)));
            else             st32(BUF(9), ti, tj, r32, hi, mm32(BUF(7), BUF(12), ti, tj, r32, hi, mm32(BUF(0), BUF(11), ti, tj, r32, hi, Z16))); }
        LBAR();
        { const int orow = tid >> 3, oc = (tid & 7) * 8;
          *(u32x4*)(ckp + orow * 64 + oc) = *(const LAS u32x4*)(BUF(1) + (orow * P + oc) * 2);
          *(u32x4*)(ckp + 4096 + orow * 64 + oc) = *(const LAS u32x4*)(BUF(2) + (orow * P + oc) * 2);
          *(u32x4*)(ckp + 2 * 4096 + orow * 64 + oc) = *(const LAS u32x4*)(BUF(4) + (orow * P + oc) * 2);
          *(u32x4*)(ckp + 3 * 4096 + orow * 64 + oc) = *(const LAS u32x4*)(BUF(9) + (orow * P + oc) * 2); }
    }
#undef BUF
#undef SC1_LOAD
}

__device__ void ph_rw_sc2(const Params& p, char* lds) {
    using namespace ck;
    const int tid = tidx(), wid = __builtin_amdgcn_readfirstlane(tid >> 6), lane = tid & 63, c = lane & 15, q = lane >> 4;
    const size_t PL = (size_t)NROW * D;
    const bf16_t* CK = (const bf16_t*)(p.ws + OFF_CK); bf16_t* Y = (bf16_t*)(p.ws + OFF_Y);
    lchar* GB = (lchar*)lds;
    lchar* RB = GB + 2 * MB;
    lchar* SB = GB + 4 * MB;
    constexpr int SBB = 32 * P * 2;
    for (int it = bidx(); it < 256; it += gdim()) {
        const int vh = it & 1, seq = it >> 1, z = seq & 1, h = (seq >> 1) & 15, b = seq >> 5;
        const bf16_t* ck0 = CK + (size_t)seq * NCHK * 4 * 4096;
        const int s_ti = wid & 3, s_tj = wid >> 2;
        const int y_ti = wid & 1, y_tj = wid >> 1;
        const int hoff = 4096 + (vh * 32 + 16 * s_tj + c) * 64 + 16 * s_ti + 4 * q, yoff = 3 * 4096 + (16 * y_tj + c) * 64 + vh * 32 + 16 * y_ti + 4 * q;
        struct PF { u32x4 g, r; uint2 h, y; };
#define PF_LOAD(X, k) do { const bf16_t* cc_ = ck0 + (size_t)(k) * 4 * 4096; X.h = *(const uint2*)(cc_ + hoff); X.y = *(const uint2*)(cc_ + yoff); X.g = *(const u32x4*)(cc_ + tid * 8); X.r = *(const u32x4*)(cc_ + 2 * 4096 + tid * 8); } while (0)
#define PF_STAGE(X, bufi) do { *(LAS u32x4*)(GB + (bufi) * MB + ((tid >> 3) * P + (tid & 7) * 8) * 2) = X.g; *(LAS u32x4*)(RB + (bufi) * MB + ((tid >> 3) * P + (tid & 7) * 8) * 2) = X.r; } while (0)
#define SC2_STEP(k, CUR, NXT) do { const uint2 hi_ = CUR.h, yi_ = CUR.y; const int cur = (k) & 1; \
            if ((k) + 4 < NCHK) PF_LOAD(CUR, (k) + 4); \
            const f32x4 hinit = {__uint_as_float(hi_.x << 16), __uint_as_float(hi_.x & 0xffff0000u), __uint_as_float(hi_.y << 16), __uint_as_float(hi_.y & 0xffff0000u)}; \
            const f32x4 yinit = {__uint_as_float(yi_.x << 16), __uint_as_float(yi_.x & 0xffff0000u), __uint_as_float(yi_.y << 16), __uint_as_float(yi_.y & 0xffff0000u)}; \
            const lchar* Sold = SB + cur * SBB; lchar* Snew = SB + (cur ^ 1) * SBB; \
            const f32x4 sn = mm_tile(GB + cur * MB, Sold, s_ti, s_tj, c, q, hinit);        \
            const f32x4 yv = mm_tile(Sold, RB + cur * MB, y_ti, y_tj, c, q, yinit);        \
            st_tile(Snew, s_ti, s_tj, c, q, sn); \
            { const int row = scan_row((k) * 64 + 16 * y_tj + c, b, z); stbf4(Y + z * PL + (size_t)row * D + h * 64 + vh * 32 + 16 * y_ti + 4 * q, yv); } \
            if ((k) + 1 < NCHK) PF_STAGE(NXT, cur ^ 1); \
            LBAR(); } while (0)
        PF s0, s1, s2, s3;
        PF_LOAD(s0, 0); PF_LOAD(s1, 1); PF_LOAD(s2, 2); PF_LOAD(s3, 3);
        LBAR();
        for (int i = tid; i < SBB / 4; i += NTHR) ((LAS unsigned*)SB)[i] = 0u;
        PF_STAGE(s0, 0);
        LBAR();
        for (int ch = 0; ch < NCHK; ch += 4) {
            SC2_STEP(ch, s0, s1); SC2_STEP(ch + 1, s1, s2); SC2_STEP(ch + 2, s2, s3); SC2_STEP(ch + 3, s3, s0);
        }
#undef PF_LOAD
#undef PF_STAGE
#undef SC2_STEP
    }
}
#undef LBAR

__device__ void ph_rw_out(const Params& p, int j, int nrows) {
    const int wid = tidx() >> 6, lane = tidx() & 63;
    const bf16_t* RKV = (const bf16_t*)(p.ws + OFF_RKV); const bf16_t* AV = (const bf16_t*)(p.ws + OFF_AV); const bf16_t* G = (const bf16_t*)(p.ws + OFF_G); const bf16_t* Y = (const bf16_t*)(p.ws + OFF_Y);
    bf16_t* OUT = (bf16_t*)(p.ws + OFF_H);
    const size_t PL = (size_t)NROW * D;
    const float* r_k = p.rw_r_k + j * D; const float* lg = p.rw_lnx_g + j * D; const float* lb = p.rw_lnx_b + j * D; const float* k_a = p.rw_k_a + j * D;
    uint2 nb[8][4];
#define OUT_LOAD(R) do { _Pragma("unroll") for (int i = 0; i < 4; ++i) { const size_t o_ = (size_t)(R) * D + lane * 4 + i * 256; \
        nb[0][i] = *(const uint2*)(Y + o_); nb[1][i] = *(const uint2*)(Y + PL + o_); nb[2][i] = *(const uint2*)(RKV + o_); nb[3][i] = *(const uint2*)(RKV + PL + o_); \
        nb[4][i] = *(const uint2*)(RKV + 2 * PL + o_); nb[5][i] = *(const uint2*)(AV + o_); nb[6][i] = *(const uint2*)(AV + PL + o_); nb[7][i] = *(const uint2*)(G + o_); } } while (0)
#define UNPK(w) ((f32x4){__uint_as_float((w).x << 16), __uint_as_float((w).x & 0xffff0000u), __uint_as_float((w).y << 16), __uint_as_float((w).y & 0xffff0000u)})
    int row = bidx() * 8 + wid;
    if (row < nrows) OUT_LOAD(row);
    for (; row < nrows; row += gdim() * 8) {
        uint2 cb[8][4];
#pragma unroll
        for (int q_ = 0; q_ < 8; ++q_)
#pragma unroll
            for (int i = 0; i < 4; ++i) cb[q_][i] = nb[q_][i];
        { const int nrow = row + gdim() * 8; if (nrow < nrows) OUT_LOAD(nrow); }
#pragma unroll
        for (int i = 0; i < 4; ++i) {
            const size_t o = (size_t)row * D + lane * 4 + i * 256; const int c = lane * 4 + i * 256;
            const f32x4 y = UNPK(cb[0][i]) + UNPK(cb[1][i]);
            const float mean = dpp_sum16(y[0] + y[1] + y[2] + y[3]) * (1.f / 64.f);
            const f32x4 dd = y - mean;
            const float rstd = rsqrtf(dpp_sum16(dd[0] * dd[0] + dd[1] * dd[1] + dd[2] * dd[2] + dd[3] * dd[3]) * (1.f / 64.f) + LNX_EPS);
            const f32x4 r = UNPK(cb[2][i]), k = UNPK(cb[3][i]), v = UNPK(cb[4][i]);
            const f32x4 a0 = UNPK(cb[5][i]), a1 = UNPK(cb[6][i]);
            const f32x4 kds = k * (2.f + (a0 + a1 - 2.f) * *(const f32x4*)(k_a + c));
            const f32x4 t4 = r * kds * *(const f32x4*)(r_k + c);
            const float bs = dpp_sum16(t4[0] + t4[1] + t4[2] + t4[3]);
            const f32x4 res = (dd * rstd * *(const f32x4*)(lg + c) + *(const f32x4*)(lb + c) + bs * v) * UNPK(cb[7][i]);
            uint2 w; w.x = pk2(res[0], res[1]); w.y = pk2(res[2], res[3]); *(uint2*)(OUT + o) = w;
        }
    }
#undef OUT_LOAD
#undef UNPK
}

__device__ void ph_final(const Params& p) {
    const int wid = tidx() >> 6, lane = tidx() & 63;
    const float* X = (const float*)(p.ws + OFF_X);
    for (int row = bidx() * 8 + wid; row < NLAT; row += gdim() * 8) {
        const float4* xr = (const float4*)(X + (size_t)row * D);
        float4 v[4]; float ss = 0;
#pragma unroll
        for (int i = 0; i < 4; ++i) { v[i] = xr[lane + i * 64]; ss += v[i].x * v[i].x + v[i].y * v[i].y + v[i].z * v[i].z + v[i].w * v[i].w; }
        ss = wave_sum(ss); const float rs = rsqrtf(ss * (1.f / D) + RMS_EPS);
#pragma unroll
        for (int i = 0; i < 4; ++i) { const int d = (lane + i * 64) * 4; const float4 gg = *(const float4*)(p.final_g + d);
            float4 o; o.x = v[i].x * rs * gg.x; o.y = v[i].y * rs * gg.y; o.z = v[i].z * rs * gg.z; o.w = v[i].w * rs * gg.w;
            *(float4*)(p.out + (size_t)row * D + d) = o; }
    }
}

enum { PH_INIT = 0, PH_A_NORM, PH_A_Z, PH_A_MID, PH_A_QKV, PH_A_POST, PH_A_ATTN, PH_A_WO,
       PH_R_NORM, PH_R_XS, PH_R_G1, PH_R_G2, PH_R_PREP, PH_R_SCAN, PH_R_OUT, PH_R_WO,
       PH_M_NORM, PH_M_SEL, PH_M_GATHER, PH_M_G1, PH_M_G2, PH_M_COMB, PH_FINAL, PH_M_CVT, PH_R_SC1, PH_R_SC2 };

#ifndef BG_Z
#define BG_Z 4
#define BG_ATTN 2
#define BG_WO 3
#define BG_RG1 6
#define BG_MG1 4
#define BG_MG2 6
#endif
template <int PH>
__device__ __forceinline__ void run_phase(const Params& p, int layer, char* lds) {
    const int j = layer >> 1;
    char* ws = p.ws;
    if constexpr (PH == PH_INIT) { ph_init(p, lds); __syncthreads(); ph_small_cvt(p, lds); }
    else if constexpr (PH == PH_A_NORM) { if (layer == 0) ph_norm_mod<false>(p, layer, p.norm1_g + layer * D, 0, 1, ws + OFF_H); else ph_comb_norm<false>(p, layer - 1, layer, NROW); }
    else if constexpr (PH == PH_A_Z) {
        float* Z = (float*)(ws + OFF_Z);
        g8::BatchSched S{ws + OFF_H, ws + OFF_WMLA + j * SZ_WMLA + WM_IN, 0, 0, NROW / 256, 2, 1, D};
        g8::gemm_phase(p.wv, (PG8_LAS unsigned char*)lds, D, S, g8::epi_rc([=](const g8::Unit&, int row, int col, f32x4 v) { *(f32x4*)(Z + (size_t)row * 512 + col) = v; }));
        if (idle_tail(NROW / 256 * 2)) bg_cvt(p, layer, lds, BG_Z);
    }
    else if constexpr (PH == PH_A_MID) ph_mla_mid(p, j);
    else if constexpr (PH == PH_A_QKV) {
        bf16_t* Q = (bf16_t*)(ws + OFF_Q); bf16_t* K = (bf16_t*)(ws + OFF_K); bf16_t* V = (bf16_t*)(ws + OFF_V);
        g8::BatchSched S1{ws + OFF_CQN, ws + OFF_WMLA + j * SZ_WMLA + WM_UQ, 0, 0, NROW / 256, 6, 1, 256};
        g8::gemm_phase(p.wv, (PG8_LAS unsigned char*)lds, 256, S1, g8::epi_rc([=](const g8::Unit&, int row, int col, f32x4 v) {
            const bool lat = row < NLAT; const int b = lat ? (row >> 12) : ((row - NLAT) >> 8); const int tk = lat ? 256 + (row & (TL - 1)) : ((row - NLAT) & 255);
            const int h = col / 192, d = col - h * 192;
            uint2 w; w.x = pk2(v[0], v[1]); w.y = pk2(v[2], v[3]);
            *(uint2*)(Q + ((size_t)(b * 8 + h) * TK + tk) * 192 + d) = w; }));
        g8::BatchSched S2{ws + OFF_CKVN, ws + OFF_WMLA + j * SZ_WMLA + WM_UKV, 0, 0, NROW / 256, 8, 1, 128};
        g8::gemm_phase(p.wv, (PG8_LAS unsigned char*)lds, 128, S2, g8::epi_rc([=](const g8::Unit&, int row, int col, f32x4 v) {
            const bool lat = row < NLAT; const int b = lat ? (row >> 12) : ((row - NLAT) >> 8); const int tk = lat ? 256 + (row & (TL - 1)) : ((row - NLAT) & 255);
            const int h = col >> 8, d = col & 255; const size_t orow = (size_t)(b * 8 + h) * TK + tk;
            uint2 w; w.x = pk2(v[0], v[1]); w.y = pk2(v[2], v[3]);
            if (d < 128) *(uint2*)(K + orow * 192 + d) = w; else *(uint2*)(V + orow * 128 + (d - 128)) = w; }));
    }
    else if constexpr (PH == PH_A_ATTN) { ph_attn(p, lds); if (idle_tail(544)) bg_cvt(p, layer, lds, BG_ATTN); }
    else if constexpr (PH == PH_A_WO || PH == PH_R_WO) {
        xt_t* X = (xt_t*)(ws + OFF_X); const float* MOD = (const float*)(ws + OFF_MOD);
        g8::BatchSched S{ws + (PH == PH_A_WO ? OFF_O : OFF_H), PH == PH_A_WO ? ws + OFF_WMLA + j * SZ_WMLA + WM_O : ws + OFF_WRW + j * SZ_WRW + WR_O, 0, 0, (layer < 3 ? NROW : NLAT) / 256, 4, 1, D};
        g8::gemm_phase(p.wv, (PG8_LAS unsigned char*)lds, D, S, g8::EpiResid{X, MOD, layer});
        if (idle_tail((layer < 3 ? NROW : NLAT) / 256 * 4)) bg_cvt(p, layer, lds, BG_WO);
    }
    else if constexpr (PH == PH_R_XS) ph_rw_normxs(p, layer, j);
    else if constexpr (PH == PH_R_G1) {
        bf16_t* RKV = (bf16_t*)(ws + OFF_RKV); bf16_t* VF = (bf16_t*)(ws + OFF_VFIRST);
        bf16_t* A2 = (bf16_t*)(ws + OFF_A2); bf16_t* A3 = (bf16_t*)(ws + OFF_A3);
        const bool first = (j == 0);
        struct RSched { const char* XS; const char* WB; int nwg;
            __device__ __forceinline__ bool next(int i, g8::Unit& u) const {
                const int L = i * gdim() + bidx(); if (L >= nwg) return false;
                const int w = g8::xcd_remap(L, nwg);
                if (w < 816) { u.g = w / 272; const int r = w % 272; u.pm = r >> 2; u.pn = r & 3; u.B = WB + WR_RKV + (size_t)u.g * D * D * 2 + (size_t)u.pn * 256 * D * 2; }
                else { u.g = 3 + (w - 816) / 68; u.pm = (w - 816) % 68; u.pn = 0; u.B = WB + WR_L + (size_t)(u.g - 3) * 256 * D * 2; }
                u.A = XS + (size_t)(u.g == 6 ? 2 : u.g) * NROW * D * 2 + (size_t)u.pm * 256 * D * 2; return true; } };
        RSched S{ws + OFF_XS, ws + OFF_WRW + j * SZ_WRW, first ? 816 + 204 : 816 + 272};
        g8::gemm_phase(p.wv, (PG8_LAS unsigned char*)lds, D, S, g8::epi_rc([=](const g8::Unit& u, int row, int col, f32x4 v) {
            if (u.g < 3) { stbf4(RKV + ((size_t)u.g * NROW + row) * D + col, v); if (first && u.g == 2) stbf4(VF + (size_t)row * D + col, v); }
            else if (col < 128) {
                f32x4 t = v;
                if (u.g == 3) { for (int e = 0; e < 4; ++e) t[e] = 1.f - 2.f * __builtin_amdgcn_rcpf(1.f + __expf(2.f * v[e])); }
                else if (u.g == 5) { for (int e = 0; e < 4; ++e) t[e] = sigmoidf_(v[e]); }
                bf16_t* dst = (u.g == 3 ? A2 : u.g == 4 ? A2 + (size_t)NROW * 128 : u.g == 5 ? A3 : A3 + (size_t)NROW * 128);
                stbf4(dst + (size_t)row * 128 + col, t); } }));
        if (idle_tail(S.nwg)) bg_cvt(p, layer, lds, BG_RG1);
    }
    else if constexpr (PH == PH_R_G2) {
        const bool first = (j == 0);
        float* W = (float*)(ws + OFF_W); bf16_t* AV = (bf16_t*)(ws + OFF_AV); bf16_t* G = (bf16_t*)(ws + OFF_G); bf16_t* RKV = (bf16_t*)(ws + OFF_RKV); const bf16_t* VF = (const bf16_t*)(ws + OFF_VFIRST);
        const float* w0 = p.rw_w0 + (size_t)j * 2 * D; const float* a0 = p.rw_a0 + (size_t)j * 2 * D; const float* v0 = p.rw_v0;
        g8::BatchSched S1{ws + OFF_A2, ws + OFF_WRW + j * SZ_WRW + WR_B2, (size_t)NROW * 128 * 2, (size_t)2048 * 128 * 2, NROW / 256, 8, 2, 128};
        g8::gemm_phase(p.wv, (PG8_LAS unsigned char*)lds, 128, S1, g8::epi_colfirst([=](const g8::Unit& u, int row, int col, f32x4 v, f32x4 bias) {
            const int zz = u.pn >> 2, c = col & 1023; const bool dec = u.g == 0;
            const size_t doff = (size_t)zz * NROW * D + (size_t)row * D + c;
            const f32x4 x = v + bias; f32x4 o;
#pragma unroll
            for (int e = 0; e < 4; ++e) { const float sg = __builtin_amdgcn_rcpf(1.f + __expf(-x[e])); o[e] = dec ? (-0.6065306597126334f * sg) : sg; }
            if (dec) *(f32x4*)(W + doff) = o; else stbf4(AV + doff, o); },
            [=](const g8::Unit& u, int col) { const int zz = u.pn >> 2, c = col & 1023; return *(const f32x4*)((u.g == 0 ? w0 : a0) + zz * D + c); }));
        g8::BatchSched S2{ws + OFF_A3, ws + OFF_WRW + j * SZ_WRW + WR_B3, (size_t)NROW * 128 * 2, (size_t)1024 * 128 * 2, NROW / 256, 4, first ? 1 : 2, 128};
        g8::gemm_phase(p.wv, (PG8_LAS unsigned char*)lds, 128, S2, g8::epi_rc([=](const g8::Unit& u, int row, int col, f32x4 v) {
            if (u.g == 0) stbf4(G + (size_t)row * D + col, v);
            else { const size_t o = (size_t)row * D + col; const f32x4 vv = ldbf4(RKV + (size_t)2 * NROW * D + o), vf = ldbf4(VF + o), gz = v + *(const f32x4*)(v0 + col); f32x4 r;
#pragma unroll
                for (int e = 0; e < 4; ++e) r[e] = vv[e] + (vf[e] - vv[e]) * __builtin_amdgcn_rcpf(1.f + __expf(-gz[e]));
                stbf4(RKV + (size_t)2 * NROW * D + o, r); } }));
    }
    else if constexpr (PH == PH_R_SCAN) ph_rw_scan(p, j, lds);
    else if constexpr (PH == PH_R_SC1) ph_rw_sc1(p, j, lds);
    else if constexpr (PH == PH_R_SC2) ph_rw_sc2(p, lds);
    else if constexpr (PH == PH_R_OUT) ph_rw_out(p, j, layer < 3 ? NROW : NLAT);
    else if constexpr (PH == PH_M_NORM) ph_norm2_router(p, layer, lds, layer < 3 ? NROW : NLAT);
    else if constexpr (PH == PH_M_SEL) { ph_select(p, lds, layer < 3 ? 128 : 64); __syncthreads(); moe_cvt(p, layer, lds, -1); }
    else if constexpr (PH == PH_M_GATHER) ph_gather(p, layer < 3 ? ESLOTS : NB * CAPL);
    else if constexpr (PH == PH_M_G1) {
        bf16_t* HID = (bf16_t*)(ws + OFF_HID);
        g8::BatchSched S{ws + OFF_XE, ws + OFF_W13T + (size_t)(layer & 1) * SZ_WMOE, (size_t)EPAD * D * 2, (size_t)2816 * D * 2, layer < 3 ? 9 : 8, 11, NE, D};
        g8::gemm_phase(p.wv, (PG8_LAS unsigned char*)lds, D, S, g8::epi_pair([=](const g8::Unit& u, int row, int col, f32x4 a, f32x4 b) {
            uint2 w; w.x = pk2(a[0] * __builtin_amdgcn_rcpf(1.f + __expf(-a[0])) * b[0], a[1] * __builtin_amdgcn_rcpf(1.f + __expf(-a[1])) * b[1]); w.y = pk2(a[2] * __builtin_amdgcn_rcpf(1.f + __expf(-a[2])) * b[2], a[3] * __builtin_amdgcn_rcpf(1.f + __expf(-a[3])) * b[3]);
            *(uint2*)(HID + ((size_t)u.g * EPAD + row) * FF + col) = w; }));
        if (layer < 3 && idle_tail(9 * 11 * NE)) moe_cvt(p, layer + 1, lds, BG_MG1);
    }
    else if constexpr (PH == PH_M_G2) {
        bf16_t* YE = (bf16_t*)(ws + OFF_YE); const float* GATE = (const float*)(ws + OFF_GATE);
        g8::BatchSched S{ws + OFF_HID, ws + OFF_W2T + (size_t)(layer & 1) * SZ_WMOE, (size_t)EPAD * FF * 2, (size_t)D * FF * 2, layer < 3 ? 9 : 8, 4, NE, FF};
        g8::gemm_phase(p.wv, (PG8_LAS unsigned char*)lds, FF, S, g8::epi_pre([=](const g8::Unit& u, int row, int col, f32x4 v, f32x4, float gt) {
            uint2 w; w.x = pk2(v[0] * gt, v[1] * gt); w.y = pk2(v[2] * gt, v[3] * gt);
            *(uint2*)(YE + ((size_t)u.g * EPAD + row) * D + col) = w; },
            [=](const g8::Unit&, int) { return (f32x4){0.f, 0.f, 0.f, 0.f}; }, [=](const g8::Unit& u, int row) { return GATE[u.g * EPAD + row]; }));
        if (layer < 3 && idle_tail(9 * 4 * NE)) moe_cvt(p, layer + 1, lds, BG_MG2);
    }
    else if constexpr (PH == PH_M_COMB) ph_combine(p, layer, layer < 3 ? NROW : NLAT);
    else if constexpr (PH == PH_M_CVT) moe_cvt(p, layer, lds, -1);
    else if constexpr (PH == PH_FINAL) ph_comb_norm<true>(p, 3, 0, NLAT);
}

#if ONE_LAUNCH
#define SYNC() xcd_barrier(bar)
#ifndef PROBE_PH
#define PROBE_PH -1
#endif
#ifndef PROBE_REP
#define PROBE_REP 1
#endif
__device__ __forceinline__ Params load_params() {
    Params q{};
#if defined(__HIP_DEVICE_COMPILE__)
    typedef const __attribute__((address_space(4))) unsigned long long* KargP;
    KargP kp_ = (KargP)__builtin_amdgcn_kernarg_segment_ptr(); asm volatile("" : "+s"(kp_));
#pragma unroll
    for (int i = 0; i < 40; ++i) ((const float**)&q)[i] = (const float*)(const __attribute__((address_space(1))) float*)kp_[i];
#endif
    return q;
}
#define RUN(PH) do { for (int rep_ = 0; rep_ < ((PH) == PROBE_PH ? PROBE_REP : 1); ++rep_) { Params q = load_params(); q.wv = wv0_; run_phase<PH>(q, layer, smem); SYNC(); } } while (0)
__global__ void __launch_bounds__(NTHR, 2) mega(Params p) {
    extern __shared__ __attribute__((aligned(16))) char smem[];
    const int wv0_ = __builtin_amdgcn_readfirstlane((int)threadIdx.x >> 6);
    if (threadIdx.x == 0) *(uint4*)(smem + LDS_BYTES) = make_uint4(0u, 0u, 0u, 0u);
    __syncthreads();
    XcdBarrier bar = xcd_barrier_post((unsigned*)(p.ws + OFF_BAR), (volatile LAS unsigned*)(smem + LDS_BYTES));
    { const int layer = 0; RUN(PH_INIT); }
    for (int layer = 0; layer < 4; ++layer) {
        if ((layer & 1) == 0) {
            RUN(PH_A_NORM);
            RUN(PH_A_Z);
            RUN(PH_A_MID);
            RUN(PH_A_QKV);
            RUN(PH_A_ATTN);
            RUN(PH_A_WO);
        } else {
            RUN(PH_R_XS);
            RUN(PH_R_G1);
            RUN(PH_R_G2);
            RUN(PH_R_SC1);
            RUN(PH_R_SC2);
            RUN(PH_R_OUT);
            RUN(PH_R_WO);
        }
        RUN(PH_M_NORM);
        RUN(PH_M_SEL);
        RUN(PH_M_G1);
        RUN(PH_M_G2);
        if ((layer & 1) == 0) RUN(PH_M_COMB);
    }
    { Params q = load_params(); q.wv = wv0_; run_phase<PH_FINAL>(q, 0, smem); }
}
#else
template <int PH> __global__ void __launch_bounds__(NTHR, 2) kph(Params p, int layer) {
    extern __shared__ __attribute__((aligned(16))) char smem[];
    Params q = p; q.wv = __builtin_amdgcn_readfirstlane((int)threadIdx.x >> 6);
    run_phase<PH>(q, layer, smem);
}
#endif

extern "C" void kernel_launch(void* const* d_in, const int* in_sizes, int n_in, void* d_out, int out_size, void* d_ws, size_t ws_size, hipStream_t stream) {
    if (n_in != 38 || ws_size < WS_NEED) { fprintf(stderr, "kernel_launch: bad args n_in %d ws %zu need %zu\n", n_in, ws_size, (size_t)WS_NEED); return; }
    Params p{};
    const float** pp = (const float**)&p;
    for (int i = 0; i < 38; ++i) pp[i] = (const float*)d_in[i];
    p.out = (float*)d_out; p.ws = (char*)d_ws;
    static int cus = 0;
    if (!cus) { int dev = 0; hipGetDevice(&dev); hipDeviceGetAttribute(&cus, hipDeviceAttributeMultiprocessorCount, dev); if (cus <= 0) cus = 256; }
    const int grid = cus;
#if ONE_LAUNCH
    hipFuncSetAttribute((const void*)mega, hipFuncAttributeMaxDynamicSharedMemorySize, LDS_BYTES + 16);
    hipMemsetAsync(d_ws, 0, 16384, stream);
    hipLaunchKernelGGL(mega, dim3(grid), dim3(NTHR), LDS_BYTES + 16, stream, p);
#else
    hipMemsetAsync(d_ws, 0, 16384, stream);
#define LAUNCH(PH, L) do { hipFuncSetAttribute((const void*)kph<PH>, hipFuncAttributeMaxDynamicSharedMemorySize, LDS_BYTES + 16); hipLaunchKernelGGL(kph<PH>, dim3(grid), dim3(NTHR), LDS_BYTES + 16, stream, p, L); } while (0)
    LAUNCH(PH_INIT, 0);
    for (int layer = 0; layer < 4; ++layer) {
        if ((layer & 1) == 0) { LAUNCH(PH_A_NORM, layer); LAUNCH(PH_A_Z, layer); LAUNCH(PH_A_MID, layer); LAUNCH(PH_A_QKV, layer); LAUNCH(PH_A_ATTN, layer); LAUNCH(PH_A_WO, layer); }
        else { LAUNCH(PH_R_XS, layer); LAUNCH(PH_R_G1, layer); LAUNCH(PH_R_G2, layer); LAUNCH(PH_R_SC1, layer); LAUNCH(PH_R_SC2, layer); LAUNCH(PH_R_OUT, layer); LAUNCH(PH_R_WO, layer); }
        LAUNCH(PH_M_NORM, layer); LAUNCH(PH_M_SEL, layer); LAUNCH(PH_M_G1, layer); LAUNCH(PH_M_G2, layer); if ((layer & 1) == 0) LAUNCH(PH_M_COMB, layer);
    }
    LAUNCH(PH_FINAL, 0);
#endif
}
```

```cpp
#include <hip/hip_runtime.h>
#include <stdint.h>
#include <stdio.h>

#ifndef ONE_LAUNCH
#define ONE_LAUNCH 1
#endif

#define NTHR 512
typedef unsigned short bf16_t;
typedef short bf16x8 __attribute__((ext_vector_type(8)));
typedef float f32x4 __attribute__((ext_vector_type(4)));
typedef unsigned u32x4 __attribute__((ext_vector_type(4)));
typedef unsigned u32x2 __attribute__((ext_vector_type(2)));

constexpr int D = 1024, NB = 4, TL = 4096, TC = 256, NLAT = NB * TL, NCTX = NB * TC, NROW = NLAT + NCTX;
constexpr int TK = TL + TC;
constexpr int NE = 16, FF = 1408, CAPL = 512, CAPC = 32, ESLOTS = NB * CAPL + NB * CAPC;
constexpr int EPAD = 2304;
constexpr float RMS_EPS = 1e-6f, LNX_EPS = 64e-5f;
constexpr float ATT_SCALE = 0.07216878364870322f;

constexpr size_t al256(size_t x) { return (x + 255) / 256 * 256; }
constexpr size_t OFF_BAR = 0;
constexpr size_t OFF_QUEUE = 14336;
constexpr size_t OFF_MOD = 16384;
constexpr size_t OFF_ROPE_C = OFF_MOD + al256(4 * 5 * 6144 * 4);
constexpr size_t OFF_ROPE_S = OFF_ROPE_C + al256(TL * 32 * 4);
constexpr size_t OFF_X = OFF_ROPE_S + al256(TL * 32 * 4);
constexpr size_t SZ_F32 = (size_t)NROW * D * 4, SZ_BF = (size_t)NROW * D * 2;
constexpr size_t OFF_VFIRST = OFF_X + SZ_BF;
constexpr size_t OFF_H = OFF_VFIRST + SZ_BF;
constexpr size_t SZ_WMLA = (size_t)(512 * 1024 + 1536 * 256 + 2048 * 256 + 1024 * 1024) * 2;
constexpr size_t WM_IN = 0, WM_UQ = (size_t)512 * 1024 * 2, WM_UKV = WM_UQ + (size_t)1536 * 256 * 2, WM_O = WM_UKV + (size_t)2048 * 256 * 2;
constexpr size_t SZ_WRW = (size_t)(3 * 1024 * 1024 + 4 * 256 * 1024 + 1024 * 1024 + 4096 * 256 + 2048 * 256) * 2;
constexpr size_t WR_RKV = 0, WR_L = (size_t)3 * 1024 * 1024 * 2, WR_O = WR_L + (size_t)4 * 256 * 1024 * 2, WR_B2 = WR_O + (size_t)1024 * 1024 * 2, WR_B3 = WR_B2 + (size_t)4096 * 256 * 2;
constexpr size_t OFF_WMLA = OFF_H + SZ_BF;
constexpr size_t OFF_WRW = OFF_WMLA + 2 * SZ_WMLA;
constexpr size_t OFF_W13T = OFF_WRW + 2 * SZ_WRW;
constexpr size_t OFF_W2T = OFF_W13T + (size_t)NE * 2816 * D * 2;
constexpr size_t SZ_WMOE = (size_t)NE * 2816 * D * 2 + (size_t)NE * D * FF * 2;
constexpr size_t OFF_S = OFF_W13T + 2 * SZ_WMOE;
constexpr size_t OFF_Z = OFF_S;
constexpr size_t OFF_CQN = OFF_Z + al256((size_t)NROW * 512 * 4);
constexpr size_t OFF_CKVN = OFF_CQN + al256((size_t)NROW * 256 * 2);
constexpr size_t OFF_KR = OFF_CKVN + al256((size_t)NROW * 256 * 2);
constexpr size_t OFF_QRAW = OFF_KR + al256((size_t)NROW * 64 * 4);
constexpr size_t OFF_KVRAW = OFF_QRAW + al256((size_t)NROW * 1536 * 4);
constexpr size_t OFF_Q = OFF_KVRAW + al256((size_t)NROW * 2048 * 4);
constexpr size_t OFF_K = OFF_Q + al256((size_t)NB * 8 * TK * 192 * 2);
constexpr size_t OFF_V = OFF_K + al256((size_t)NB * 8 * TK * 192 * 2);
constexpr size_t OFF_O = OFF_V + al256((size_t)NB * 8 * TK * 128 * 2);
constexpr size_t END_MLA = OFF_O + SZ_BF;
constexpr size_t OFF_XS = OFF_S;
constexpr size_t OFF_RKV = OFF_XS + 6 * SZ_BF;
constexpr size_t OFF_W = OFF_RKV + 3 * SZ_BF;
constexpr size_t OFF_AV = OFF_W + 2 * SZ_F32;
constexpr size_t OFF_G = OFF_AV + 2 * SZ_BF;
constexpr size_t OFF_A2 = OFF_G + SZ_BF;
constexpr size_t OFF_A3 = OFF_A2 + al256((size_t)NROW * 256 * 2);
constexpr size_t END_RW = OFF_A3 + al256((size_t)NROW * 256 * 2);
constexpr size_t OFF_Y = OFF_XS;
constexpr int NCHK = (TC + TL) / 64;
constexpr size_t OFF_CK = END_RW;
constexpr size_t END_RW2 = OFF_CK + (size_t)128 * NCHK * 4 * 4096 * 2;
constexpr size_t OFF_AFF = OFF_S;
constexpr size_t OFF_ROWIDX = OFF_AFF + al256((size_t)NROW * 16 * 4);
constexpr size_t OFF_GATE = OFF_ROWIDX + al256((size_t)NE * ESLOTS * 4);
constexpr size_t OFF_SLOT = OFF_GATE + al256((size_t)NE * EPAD * 4);
constexpr size_t OFF_XE = OFF_SLOT + al256((size_t)NROW * 16 * 4);
constexpr size_t OFF_HID = OFF_XE + al256((size_t)NE * EPAD * D * 2);
constexpr size_t OFF_YE = OFF_HID + al256((size_t)NE * EPAD * FF * 2);
constexpr size_t END_MOE = OFF_YE + al256((size_t)NE * EPAD * D * 2);
constexpr size_t WS_NEED = END_RW2 > END_MLA ? (END_RW2 > END_MOE ? END_RW2 : END_MOE) : (END_MLA > END_MOE ? END_MLA : END_MOE);

constexpr int LDS_BYTES = 152064;

struct Params {
    const float *x, *c, *ctx, *c_ctx, *mod_w, *mod_b, *norm1_g, *norm2_g, *final_g;
    const float *mla_w_in, *mla_g_q, *mla_g_kv, *mla_w_uq, *mla_w_ukv, *mla_w_o;
    const float *rw_mu, *rw_w_rkv, *rw_w0, *rw_w1, *rw_w2, *rw_a0, *rw_a1, *rw_a2, *rw_v0, *rw_v1, *rw_v2, *rw_g1, *rw_g2, *rw_k_k, *rw_k_a, *rw_r_k, *rw_lnx_g, *rw_lnx_b, *rw_w_o;
    const float *moe_router, *moe_w1, *moe_w3, *moe_w2;
    float* out; char* ws;
    int wv, pad_;
};

__device__ __forceinline__ int bidx() { int t = blockIdx.x; asm volatile("" : "+s"(t)); return t; }
__device__ __forceinline__ int gdim() { int t = gridDim.x; asm volatile("" : "+s"(t)); return t; }
__device__ __forceinline__ int tidx_w(int wv) { int l; asm volatile("v_mbcnt_lo_u32_b32 %0, -1, 0\n\tv_mbcnt_hi_u32_b32 %0, -1, %0" : "=v"(l)); return (wv << 6) | l; }
#define tidx() tidx_w(p.wv)
#define XB_TMO      128
#define XB_XCNT(j)  (256  + 64 * (j))
#define XB_XSUB(j)  (1280 + 64 * (j))
#define XB_XGEN(j)  (2304 + 64 * (j))
#define XB_TOP      3328
#define XB_TOPGEN   3392
#define XCD_BAR_WORDS 3456
#define XB_SPIN_CAP (1u << 22)
#define LAS __attribute__((address_space(3)))

__device__ __forceinline__ unsigned xb_ld(unsigned* p)              { return __hip_atomic_load(p, __ATOMIC_RELAXED, __HIP_MEMORY_SCOPE_AGENT); }
__device__ __forceinline__ unsigned xb_add(unsigned* p, unsigned v) { return __hip_atomic_fetch_add(p, v, __ATOMIC_RELAXED, __HIP_MEMORY_SCOPE_AGENT); }
__device__ __forceinline__ unsigned xb_xcc_id() { return (unsigned)__builtin_amdgcn_s_getreg((3 << 11) | 20) & 0xFu; }
#define XB_SPIN(cond, bar) do { unsigned _sp = 0; while (cond) { __builtin_amdgcn_s_sleep(1); \
    if ((++_sp & 255u) == 0u) { if (xb_ld(&(bar)[XB_TMO])) break; if (_sp > XB_SPIN_CAP) { atomicAdd(&(bar)[XB_TMO], 1u); break; } } } } while (0)

struct XcdBarrier { unsigned* bar; unsigned x; volatile LAS unsigned* st; };

__device__ __forceinline__ XcdBarrier xcd_barrier_post(unsigned* bar, volatile LAS unsigned* st) {
    XcdBarrier b; b.bar = bar; b.x = xb_xcc_id(); b.st = st;
    if (threadIdx.x == 0) (void)xb_add(&bar[XB_XCNT(b.x)], 1u);
    return b;
}
__device__ __forceinline__ void xcd_barrier_complete(unsigned* bar, unsigned x, unsigned& nloc, unsigned& nx) {
    const unsigned G = gridDim.x * gridDim.y * gridDim.z;
    unsigned sum, cnt, mine, sp = 0u;
    for (;;) {
        sum = 0u; cnt = 0u; mine = 0u;
#pragma unroll
        for (unsigned j = 0; j < 16; ++j) { const unsigned c = xb_ld(&bar[XB_XCNT(j)]); sum += c; cnt += (c > 0u) ? 1u : 0u; mine = (j == x) ? c : mine; }
        if (sum == G) break;
        __builtin_amdgcn_s_sleep(1);
        if ((++sp & 255u) == 0u) { if (xb_ld(&bar[XB_TMO])) break; if (sp > XB_SPIN_CAP) { atomicAdd(&bar[XB_TMO], 1u); break; } }
    }
    nloc = mine > 0u ? mine : 1u; nx = cnt > 0u ? cnt : 1u;
}
__device__ __forceinline__ void xcd_barrier(const XcdBarrier& b) {
    asm volatile("s_waitcnt vmcnt(0)" ::: "memory");
    __syncthreads();
    if (threadIdx.x == 0) {
        unsigned* bar = b.bar;
        __builtin_amdgcn_s_waitcnt(0);
        unsigned nloc = b.st[0], nx = b.st[1];
        if (nloc == 0u) { xcd_barrier_complete(bar, b.x, nloc, nx); b.st[0] = nloc; b.st[1] = nx; }
        const unsigned old = xb_add(&bar[XB_XSUB(b.x)], 1u);
        const unsigned gen = old / nloc;
        if (old + 1u == (gen + 1u) * nloc) {
            __builtin_amdgcn_fence(__ATOMIC_RELEASE, "agent");
            asm volatile("s_waitcnt vmcnt(0)" ::: "memory");
            const unsigned og = xb_add(&bar[XB_TOP], 1u);
            const unsigned tg = og / nx;
            if (og + 1u == (tg + 1u) * nx) xb_add(&bar[XB_TOPGEN], 1u);
            else XB_SPIN(xb_ld(&bar[XB_TOPGEN]) == tg, bar);
            __builtin_amdgcn_fence(__ATOMIC_ACQUIRE, "agent");
            xb_add(&bar[XB_XGEN(b.x)], 1u);
            asm volatile("s_waitcnt vmcnt(0)" ::: "memory");
        } else {
            XB_SPIN(xb_ld(&bar[XB_XGEN(b.x)]) == gen, bar);
            __builtin_amdgcn_fence(__ATOMIC_ACQUIRE, "agent");
            asm volatile("s_waitcnt vmcnt(0)" ::: "memory");
        }
    }
    __syncthreads();
}

__device__ __forceinline__ float bf2f(bf16_t b) { return __uint_as_float(((unsigned)b) << 16); }
typedef float f32x2_ __attribute__((ext_vector_type(2)));
typedef __bf16 bf16x2_ __attribute__((ext_vector_type(2)));
__device__ __forceinline__ unsigned pk2(float lo, float hi) { const f32x2_ v = {lo, hi}; return __builtin_bit_cast(unsigned, __builtin_convertvector(v, bf16x2_)); }
__device__ __forceinline__ bf16_t f2bf(float f) { return (bf16_t)(pk2(f, f) & 0xffffu); }
__device__ __forceinline__ float dpp_sum16(float x) {
    x += __builtin_bit_cast(float, __builtin_amdgcn_update_dpp(0, __builtin_bit_cast(int, x), 0xB1, 0xF, 0xF, true));
    x += __builtin_bit_cast(float, __builtin_amdgcn_update_dpp(0, __builtin_bit_cast(int, x), 0x4E, 0xF, 0xF, true));
    x += __builtin_bit_cast(float, __builtin_amdgcn_update_dpp(0, __builtin_bit_cast(int, x), 0x141, 0xF, 0xF, true));
    x += __builtin_bit_cast(float, __builtin_amdgcn_update_dpp(0, __builtin_bit_cast(int, x), 0x140, 0xF, 0xF, true));
    return x;
}
__device__ __forceinline__ f32x4 ldbf4(const bf16_t* p) { const uint2 w = *(const uint2*)p; return (f32x4){__uint_as_float(w.x << 16), __uint_as_float(w.x & 0xffff0000u), __uint_as_float(w.y << 16), __uint_as_float(w.y & 0xffff0000u)}; }
__device__ __forceinline__ void stbf4(bf16_t* p, f32x4 v) { uint2 w; w.x = pk2(v[0], v[1]); w.y = pk2(v[2], v[3]); *(uint2*)p = w; }
typedef bf16_t xt_t;
__device__ __forceinline__ f32x4 xldv(const xt_t* X, size_t i) { return ldbf4(X + i); }
__device__ __forceinline__ void xstv(xt_t* X, size_t i, f32x4 v) { stbf4(X + i, v); }
__device__ __forceinline__ float4 xld(const xt_t* X, size_t i) { const f32x4 v = ldbf4(X + i); return make_float4(v[0], v[1], v[2], v[3]); }
__device__ __forceinline__ void xst(xt_t* X, size_t i, float4 v) { stbf4(X + i, (f32x4){v.x, v.y, v.z, v.w}); }
__device__ __forceinline__ float wave_sum(float v) {
    v = dpp_sum16(v); const int i = __builtin_bit_cast(int, v);
    return __builtin_bit_cast(float, __builtin_amdgcn_readlane(i, 0)) + __builtin_bit_cast(float, __builtin_amdgcn_readlane(i, 16)) + __builtin_bit_cast(float, __builtin_amdgcn_readlane(i, 32)) + __builtin_bit_cast(float, __builtin_amdgcn_readlane(i, 48));
}
__device__ __forceinline__ float sigmoidf_(float x) { return __builtin_amdgcn_rcpf(1.f + __expf(-x)); }
__device__ __forceinline__ int row_stream(int row) { return row < NLAT ? (row >> 12) : 4; }
__device__ __forceinline__ const float* modp(const Params& p, int layer, int s, int part) { return (const float*)(p.ws + OFF_MOD) + ((size_t)layer * 5 + s) * 6144 + part * 1024; }

struct SgArgs { const bf16_t* A; int lda; size_t strideA; const float* B; int ldb; size_t strideB; int M, N, K, nbatch; };
template <class Epi>
__device__ __forceinline__ void sg_gemm(const Params& p, char* lds, const SgArgs g, const Epi& epi) {
    bf16_t* As = (bf16_t*)lds;
    bf16_t* Bs = As + 128 * 40;
    const int tid = tidx(), wid = tid >> 6, lane = tid & 63;
    const int wr = wid >> 2, wc = wid & 3;
    const int tilesN = (g.N + 127) / 128, tilesM = g.M / 128, per = tilesM * tilesN, ntiles = per * g.nbatch;
    const int ar = tid >> 2, ak = (tid & 3) * 8;
    const int bn = tid & 127, bk = (tid >> 7) * 8;
    for (int tile = bidx(); tile < ntiles; tile += gdim()) {
        const int bt = tile / per, tt = tile % per;
        const int tm = tt / tilesN, tn = tt % tilesN;
        const int m0 = tm * 128, n0 = tn * 128;
        f32x4 acc[4][2];
#pragma unroll
        for (int m = 0; m < 4; ++m)
#pragma unroll
            for (int n = 0; n < 2; ++n) acc[m][n] = (f32x4){0.f, 0.f, 0.f, 0.f};
        const bool bvalid = (n0 + bn) < g.N;
        const bf16_t* ap = g.A + bt * g.strideA + (size_t)(m0 + ar) * g.lda + ak;
        const float* bp = g.B + bt * g.strideB + (size_t)bk * g.ldb + n0 + bn;
        bf16x8 areg; float breg[8];
        areg = *(const bf16x8*)ap;
#pragma unroll
        for (int j = 0; j < 8; ++j) breg[j] = bvalid ? bp[(size_t)j * g.ldb] : 0.f;
        for (int k0 = 0; k0 < g.K; k0 += 32) {
            __syncthreads();
            *(bf16x8*)(As + ar * 40 + ak) = areg;
            { u32x4 w; w.x = pk2(breg[0], breg[1]); w.y = pk2(breg[2], breg[3]); w.z = pk2(breg[4], breg[5]); w.w = pk2(breg[6], breg[7]); *(u32x4*)(Bs + bn * 40 + bk) = w; }
            __syncthreads();
            if (k0 + 32 < g.K) {
                areg = *(const bf16x8*)(ap + k0 + 32);
#pragma unroll
                for (int j = 0; j < 8; ++j) breg[j] = bvalid ? bp[(size_t)(k0 + 32 + j) * g.ldb] : 0.f;
            }
            bf16x8 af[4], bfr[2];
#pragma unroll
            for (int m = 0; m < 4; ++m) af[m] = *(const bf16x8*)(As + (wr * 64 + m * 16 + (lane & 15)) * 40 + (lane >> 4) * 8);
#pragma unroll
            for (int n = 0; n < 2; ++n) bfr[n] = *(const bf16x8*)(Bs + (wc * 32 + n * 16 + (lane & 15)) * 40 + (lane >> 4) * 8);
#pragma unroll
            for (int m = 0; m < 4; ++m)
#pragma unroll
                for (int n = 0; n < 2; ++n) acc[m][n] = __builtin_amdgcn_mfma_f32_16x16x32_bf16(af[m], bfr[n], acc[m][n], 0, 0, 0);
        }
#pragma unroll
        for (int m = 0; m < 4; ++m)
#pragma unroll
            for (int n = 0; n < 2; ++n) {
                const int col = n0 + wc * 32 + n * 16 + (lane & 15);
                if (col < g.N) {
#pragma unroll
                    for (int r = 0; r < 4; ++r) epi(bt, m0 + wr * 64 + m * 16 + (lane >> 4) * 4 + r, col, acc[m][n][r]);
                }
            }
    }
}


namespace g8 {
#define PG8_LAS __attribute__((address_space(3)))
constexpr int BM = 256, BK = 64, HALF = 128, HTB = HALF * BK * 2, STAGE_BYTES = 8 * HTB;
__device__ __forceinline__ int lds_byte(int r, int c) { const int st = (r >> 4) * 2 + (c >> 5), rr = r & 15, cc = c & 31, ob = rr * 64 + cc * 2; return st * 1024 + (ob ^ (((ob >> 9) & 1) << 5)); }
__device__ __forceinline__ void stage_rc(int b, int& R, int& C) { const int st = b / 1024, sb = b % 1024, swz = sb ^ (((sb >> 9) & 1) << 5); R = (st >> 1) * 16 + swz / 64; C = (st & 1) * 32 + (swz % 64) / 2; }
struct Unit { int pm, pn, g; const char* A; const char* B; };
__device__ __forceinline__ int xcd_remap(int L, int nwg) { const int q = nwg / 8, r = nwg % 8, xcd = L % 8, off = L / 8; return (xcd < r ? xcd * (q + 1) : r * (q + 1) + (xcd - r) * q) + off; }

template <class Epi, class Sched>
__device__ __forceinline__ void gemm_phase(const int wv_, PG8_LAS unsigned char* lds, const int K, const Sched& S, const Epi& E) {
    const int tid = tidx_w(wv_), wid = __builtin_amdgcn_readfirstlane(tid >> 6), lane = tid & 63, wr = wid >> 2, wc = wid & 3, fr = lane & 15, fq = lane >> 4;
    const int nt = K / BK;
    unsigned voffA[2];
#pragma unroll
    for (int i = 0; i < 2; ++i) { int R, C; stage_rc(tid * 16 + i * 8192, R, C); voffA[i] = (unsigned)(R * K + C) * 2u; }
    const size_t kstep = (size_t)(BK * 2);
    const size_t hstep = (size_t)HALF * K * 2;
    const unsigned ldsw = (unsigned)wid * 1024u;
    const int aoff = lds_byte(wr * 64 + fr, fq * 8), boff = lds_byte(wc * 32 + fr, fq * 8);
#define PG8_SA(b, h) (((b) * 2 + (h)) * HTB)
#define PG8_SB(b, h) ((4 + (b) * 2 + (h)) * HTB)
#define PG8_STAGE(bufoff, gbase, voff) do { _Pragma("unroll") for (int _i = 0; _i < 2; ++_i) \
        __builtin_amdgcn_global_load_lds((const unsigned*)((const char*)(gbase) + (voff)[_i]), (PG8_LAS unsigned*)(lds + (bufoff) + ldsw + _i * 8192), 16, 0, 0); } while (0)
#define PG8_LDA(dst, b, h) do { _Pragma("unroll") for (int m = 0; m < 4; ++m) _Pragma("unroll") for (int k = 0; k < 2; ++k) dst[m][k] = *(const PG8_LAS bf16x8*)(lds + PG8_SA(b, h) + aoff + m * 2048 + k * 1024); } while (0)
#define PG8_LDB(dst, b, h) do { _Pragma("unroll") for (int n = 0; n < 2; ++n) _Pragma("unroll") for (int k = 0; k < 2; ++k) dst[n][k] = *(const PG8_LAS bf16x8*)(lds + PG8_SB(b, h) + boff + n * 2048 + k * 1024); } while (0)
#define PG8_MMA(ai, bj, At, Bt) do { __builtin_amdgcn_s_setprio(1); _Pragma("unroll") for (int m = 0; m < 4; ++m) _Pragma("unroll") for (int n = 0; n < 2; ++n) _Pragma("unroll") for (int k = 0; k < 2; ++k) \
        acc[ai][bj][m][n] = __builtin_amdgcn_mfma_f32_16x16x32_bf16(Bt[n][k], At[m][k], acc[ai][bj][m][n], 0, 0, 0); __builtin_amdgcn_s_setprio(0); } while (0)
#define PG8_WAIT_V(n) asm volatile("s_waitcnt vmcnt(" #n ")" ::: "memory")
#define PG8_WAIT_L(n) asm volatile("s_waitcnt lgkmcnt(" #n ")" ::: "memory")
#define PG8_BAR __builtin_amdgcn_s_barrier()
#define PG8_SCHED __builtin_amdgcn_sched_barrier(0)
    Unit cur, nxt; int ui = 0;
    if (!S.next(0, cur)) return;
    f32x4 acc[2][2][4][2];
#pragma unroll
    for (int a = 0; a < 2; ++a)
#pragma unroll
        for (int b = 0; b < 2; ++b)
#pragma unroll
            for (int m = 0; m < 4; ++m)
#pragma unroll
                for (int n = 0; n < 2; ++n) acc[a][b][m][n] = (f32x4){0.f, 0.f, 0.f, 0.f};
    bf16x8 At[4][2], B0[2][2], B1[2][2];
    const char* cA = cur.A; const char* cB = cur.B;
    PG8_STAGE(PG8_SB(0, 0), cB, voffA); PG8_STAGE(PG8_SA(0, 0), cA, voffA); PG8_STAGE(PG8_SB(0, 1), cB + hstep, voffA); PG8_STAGE(PG8_SA(0, 1), cA + hstep, voffA);
    if (wr == 1) PG8_BAR;
    PG8_WAIT_V(4); PG8_BAR;
    PG8_STAGE(PG8_SB(1, 0), cB + kstep, voffA); PG8_STAGE(PG8_SA(1, 0), cA + kstep, voffA); PG8_STAGE(PG8_SB(1, 1), cB + hstep + kstep, voffA);
    PG8_WAIT_V(6); PG8_BAR;
    for (;;) {
        const bool has_next = S.next(ui + 1, nxt);
        const char* nA = has_next ? nxt.A : cA; const char* nB = has_next ? nxt.B : cB;
        for (int t = 0; t < nt; t += 2) {
            const bool last = (t == nt - 2);
            const char* a1 = cA + (size_t)(t + 1) * kstep;
            const char* a2 = last ? nA : cA + (size_t)(t + 2) * kstep; const char* b2 = last ? nB : cB + (size_t)(t + 2) * kstep;
            const char* a3 = a2 + kstep; const char* b3 = b2 + kstep;
            PG8_LDB(B0, 0, 0); PG8_SCHED; PG8_LDA(At, 0, 0); PG8_STAGE(PG8_SA(1, 1), a1 + hstep, voffA);
            PG8_WAIT_L(8); PG8_BAR; PG8_WAIT_L(0); PG8_MMA(0, 0, At, B0); PG8_BAR; PG8_SCHED;
            PG8_LDB(B1, 0, 1); PG8_STAGE(PG8_SB(0, 0), b2, voffA);
            PG8_BAR; PG8_WAIT_L(0); PG8_MMA(0, 1, At, B1); PG8_BAR;
            PG8_LDA(At, 0, 1); PG8_STAGE(PG8_SA(0, 0), a2, voffA);
            PG8_BAR; PG8_WAIT_L(0); PG8_MMA(1, 0, At, B0); PG8_BAR; PG8_SCHED;
            PG8_STAGE(PG8_SB(0, 1), b2 + hstep, voffA);
            PG8_WAIT_V(6); PG8_BAR; PG8_MMA(1, 1, At, B1); PG8_BAR;
            PG8_LDB(B0, 1, 0); PG8_SCHED; PG8_LDA(At, 1, 0); PG8_STAGE(PG8_SA(0, 1), a2 + hstep, voffA);
            PG8_WAIT_L(8); PG8_BAR; PG8_WAIT_L(0); PG8_MMA(0, 0, At, B0); PG8_BAR; PG8_SCHED;
            PG8_LDB(B1, 1, 1); PG8_STAGE(PG8_SB(1, 0), b3, voffA);
            PG8_BAR; PG8_WAIT_L(0); PG8_MMA(0, 1, At, B1); PG8_BAR;
            PG8_LDA(At, 1, 1); PG8_STAGE(PG8_SA(1, 0), a3, voffA);
            PG8_BAR; PG8_WAIT_L(0); PG8_MMA(1, 0, At, B0); PG8_BAR; PG8_SCHED;
            PG8_STAGE(PG8_SB(1, 1), b3 + hstep, voffA);
            PG8_WAIT_V(6); PG8_BAR; PG8_MMA(1, 1, At, B1); PG8_BAR;
        }
        E(acc, cur, wr, wc, fr, fq);
        if (!has_next) break;
#pragma unroll
        for (int a = 0; a < 2; ++a)
#pragma unroll
            for (int b = 0; b < 2; ++b)
#pragma unroll
                for (int m = 0; m < 4; ++m)
#pragma unroll
                    for (int n = 0; n < 2; ++n) acc[a][b][m][n] = (f32x4){0.f, 0.f, 0.f, 0.f};
        cur = nxt; cA = nA; cB = nB; ++ui;
    }
    PG8_WAIT_V(0);
    if (wr == 0) PG8_BAR;
    PG8_BAR;
#undef PG8_SA
#undef PG8_SB
#undef PG8_STAGE
#undef PG8_LDA
#undef PG8_LDB
#undef PG8_MMA
#undef PG8_WAIT_V
#undef PG8_WAIT_L
#undef PG8_BAR
#undef PG8_SCHED
}
template <class F> struct EpiRC { F f;
    __device__ __forceinline__ void operator()(const f32x4 (&acc)[2][2][4][2], const Unit& u, int wr, int wc, int fr, int fq) const {
#pragma unroll
        for (int ai = 0; ai < 2; ++ai)
#pragma unroll
            for (int m = 0; m < 4; ++m) { const int row = u.pm * BM + ai * HALF + wr * 64 + m * 16 + fr;
#pragma unroll
                for (int bj = 0; bj < 2; ++bj)
#pragma unroll
                    for (int n = 0; n < 2; ++n) f(u, row, u.pn * BM + bj * HALF + wc * 32 + n * 16 + 4 * fq, acc[ai][bj][m][n]);
                asm volatile("" ::: "memory"); }
    } };
template <class F> __device__ __forceinline__ EpiRC<F> epi_rc(const F& f) { return EpiRC<F>{f}; }
template <class F> struct EpiPair { F f;
    __device__ __forceinline__ void operator()(const f32x4 (&acc)[2][2][4][2], const Unit& u, int wr, int wc, int fr, int fq) const {
#pragma unroll
        for (int ai = 0; ai < 2; ++ai)
#pragma unroll
            for (int m = 0; m < 4; ++m) { const int row = u.pm * BM + ai * HALF + wr * 64 + m * 16 + fr;
#pragma unroll
                for (int n = 0; n < 2; ++n) f(u, row, u.pn * HALF + wc * 32 + n * 16 + 4 * fq, acc[ai][0][m][n], acc[ai][1][m][n]);
                asm volatile("" ::: "memory"); }
    } };
template <class F> __device__ __forceinline__ EpiPair<F> epi_pair(const F& f) { return EpiPair<F>{f}; }
template <class F, class CF, class RF> struct EpiPre { F f; CF cf; RF rf;
    __device__ __forceinline__ void operator()(const f32x4 (&acc)[2][2][4][2], const Unit& u, int wr, int wc, int fr, int fq) const {
        f32x4 cv[2][2]; float rv[2][4];
#pragma unroll
        for (int bj = 0; bj < 2; ++bj)
#pragma unroll
            for (int n = 0; n < 2; ++n) cv[bj][n] = cf(u, u.pn * BM + bj * HALF + wc * 32 + n * 16 + 4 * fq);
#pragma unroll
        for (int ai = 0; ai < 2; ++ai)
#pragma unroll
            for (int m = 0; m < 4; ++m) rv[ai][m] = rf(u, u.pm * BM + ai * HALF + wr * 64 + m * 16 + fr);
#pragma unroll
        for (int ai = 0; ai < 2; ++ai)
#pragma unroll
            for (int m = 0; m < 4; ++m) { const int row = u.pm * BM + ai * HALF + wr * 64 + m * 16 + fr;
#pragma unroll
                for (int bj = 0; bj < 2; ++bj)
#pragma unroll
                    for (int n = 0; n < 2; ++n) f(u, row, u.pn * BM + bj * HALF + wc * 32 + n * 16 + 4 * fq, acc[ai][bj][m][n], cv[bj][n], rv[ai][m]);
                asm volatile("" ::: "memory"); }
    } };
template <class F, class CF, class RF> __device__ __forceinline__ EpiPre<F, CF, RF> epi_pre(const F& f, const CF& cf, const RF& rf) { return EpiPre<F, CF, RF>{f, cf, rf}; }
template <class F, class CF> struct EpiColFirst { F f; CF cf;
    __device__ __forceinline__ void operator()(const f32x4 (&acc)[2][2][4][2], const Unit& u, int wr, int wc, int fr, int fq) const {
#pragma unroll
        for (int bj = 0; bj < 2; ++bj)
#pragma unroll
            for (int n = 0; n < 2; ++n) { const int col = u.pn * BM + bj * HALF + wc * 32 + n * 16 + 4 * fq; const f32x4 cv = cf(u, col);
#pragma unroll
                for (int ai = 0; ai < 2; ++ai)
#pragma unroll
                    for (int m = 0; m < 4; ++m) f(u, u.pm * BM + ai * HALF + wr * 64 + m * 16 + fr, col, acc[ai][bj][m][n], cv);
                asm volatile("" ::: "memory"); }
    } };
template <class F, class CF> __device__ __forceinline__ EpiColFirst<F, CF> epi_colfirst(const F& f, const CF& cf) { return EpiColFirst<F, CF>{f, cf}; }
struct EpiResid { xt_t* X; const float* MOD; int layer;
    __device__ __forceinline__ void operator()(const f32x4 (&acc)[2][2][4][2], const Unit& u, int wr, int wc, int fr, int fq) const {
        const int row0 = u.pm * BM + wr * 64 + fr, col0 = u.pn * BM + wc * 32 + 4 * fq;
        const int strm = row0 < NLAT ? (row0 >> 12) : 4;
        const float* gp = MOD + ((size_t)layer * 5 + strm) * 6144 + 2048 + col0;
        f32x4 gt[2][2];
#pragma unroll
        for (int bj = 0; bj < 2; ++bj)
#pragma unroll
            for (int n = 0; n < 2; ++n) gt[bj][n] = *(const f32x4*)(gp + bj * HALF + n * 16);
#pragma unroll
        for (int ai = 0; ai < 2; ++ai) {
            f32x4 xv[4][2][2];
#pragma unroll
            for (int m = 0; m < 4; ++m)
#pragma unroll
                for (int bj = 0; bj < 2; ++bj)
#pragma unroll
                    for (int n = 0; n < 2; ++n) xv[m][bj][n] = xldv(X, (size_t)(row0 + ai * HALF + m * 16) * D + col0 + bj * HALF + n * 16);
#pragma unroll
            for (int m = 0; m < 4; ++m)
#pragma unroll
                for (int bj = 0; bj < 2; ++bj)
#pragma unroll
                    for (int n = 0; n < 2; ++n) xstv(X, (size_t)(row0 + ai * HALF + m * 16) * D + col0 + bj * HALF + n * 16, xv[m][bj][n] + gt[bj][n] * acc[ai][bj][m][n]);
            asm volatile("" ::: "memory");
        }
    } };
struct BatchSched { const char* A; const char* B; size_t strideA, strideB; int nM, nN, nb, K; int rev = 0;
    __device__ __forceinline__ bool next(int i, Unit& u) const {
        const int nwg = nM * nN * nb; const int L = i * gdim() + (rev ? gdim() - 1 - bidx() : bidx()); if (L >= nwg) return false;
        const int w = xcd_remap(L, nwg); const int per = nM * nN; u.g = w / per; const int r = w % per; u.pm = r / nN; u.pn = r % nN;
        u.A = A + u.g * strideA + (size_t)u.pm * BM * K * 2; u.B = B + u.g * strideB + (size_t)u.pn * BM * K * 2; return true; } };
}

template <class SrcF, class DRow>
__device__ __forceinline__ int cvt_tiles(const int wv_, char* lds, bf16_t* dst, int Kd, int Nd, int nbatch, size_t dstride, const SrcF& src, const DRow& drow, unsigned* queue = nullptr) {
    bf16_t* T = (bf16_t*)lds;
    const int tid = tidx_w(wv_);
    const int tk = Kd / 128, tn = Nd / 64, per = tk * tn, total = per * nbatch;
    {
        for (int t = bidx(); t < total; t += gdim()) {
            const int bt = t / per, r = t % per, k0 = (r % tk) * 128, n0 = (r / tk) * 64;
            float4 v[4];
#pragma unroll
            for (int i = 0; i < 4; ++i) { const int k = k0 + i * 32 + (tid >> 4), n = n0 + (tid & 15) * 4; const float* sp = src(bt, k, n); v[i] = sp ? *(const float4*)sp : make_float4(0.f, 0.f, 0.f, 0.f); }
            __syncthreads();
#pragma unroll
            for (int i = 0; i < 4; ++i) { const int k = i * 32 + (tid >> 4), n = (tid & 15) * 4;
                T[(n + 0) * 136 + k] = f2bf(v[i].x); T[(n + 1) * 136 + k] = f2bf(v[i].y); T[(n + 2) * 136 + k] = f2bf(v[i].z); T[(n + 3) * 136 + k] = f2bf(v[i].w); }
            __syncthreads();
            { const int n = tid >> 3, kc = (tid & 7) * 16;
              const u32x4 a = *(const u32x4*)(T + n * 136 + kc), b = *(const u32x4*)(T + n * 136 + kc + 8);
              bf16_t* dp = dst + bt * dstride + (size_t)drow(n0 + n) * Kd + k0 + kc;
              *(u32x4*)dp = a; *(u32x4*)(dp + 8) = b; }
        }
    }
    return 0;
}
__device__ __forceinline__ int moe_cvt(const Params& p, int layer, char* lds, int budget) {
    constexpr int QG = 2, T13 = NE * 8 * 44, TOT = T13 + NE * 11 * 16;
    bf16_t* T = (bf16_t*)lds;
    int* qslot = (int*)(lds + 64 * 136 * 2);
    const int tid = tidx();
    const float* w1 = p.moe_w1 + (size_t)layer * NE * D * FF; const float* w3 = p.moe_w3 + (size_t)layer * NE * D * FF; const float* w2 = p.moe_w2 + (size_t)layer * NE * FF * D;
    bf16_t* W13 = (bf16_t*)(p.ws + OFF_W13T + (size_t)(layer & 1) * SZ_WMOE); bf16_t* W2 = (bf16_t*)(p.ws + OFF_W2T + (size_t)(layer & 1) * SZ_WMOE);
    unsigned* queue = (unsigned*)(p.ws + OFF_QUEUE) + layer * 32;
    const bool ahead = budget < 0;
    int done = 0, tnext = 0;
    __syncthreads();
    if (tid == 0) qslot[0] = QG * (int)__hip_atomic_fetch_add(queue, 1u, __ATOMIC_RELAXED, __HIP_MEMORY_SCOPE_AGENT);
    __syncthreads();
    int t0 = __builtin_amdgcn_readfirstlane(qslot[0]);
    while (t0 < TOT && (ahead || done < budget)) {
        const bool more = ahead || done + 1 < budget;
        if (more && tid == 0) tnext = QG * (int)__hip_atomic_fetch_add(queue, 1u, __ATOMIC_RELAXED, __HIP_MEMORY_SCOPE_AGENT);
#pragma unroll 1
        for (int sub = 0; sub < QG; ++sub) {
            const int t = t0 + sub;
            const float* sp; bf16_t* dp; int ss, ds;
            if (t < T13) { const int e = t / 352, r = t % 352, k0 = (r & 7) * 128, n0 = (r >> 3) * 64; const int c0 = (n0 >> 8) * 128 + (n0 & 127);
                sp = (((n0 >> 7) & 1) ? w3 : w1) + ((size_t)e * D + k0) * FF + c0; ss = FF; dp = W13 + ((size_t)e * 2816 + n0) * D + k0; ds = D; }
            else { const int u = t - T13, e = u / 176, r = u % 176, k0 = (r % 11) * 128, n0 = (r / 11) * 64;
                sp = w2 + ((size_t)e * FF + k0) * D + n0; ss = D; dp = W2 + ((size_t)e * D + n0) * FF + k0; ds = FF; }
            float4 v[4];
#pragma unroll
            for (int i = 0; i < 4; ++i) v[i] = *(const float4*)(sp + (size_t)(i * 32 + (tid >> 4)) * ss + (tid & 15) * 4);
            __syncthreads();
#pragma unroll
            for (int i = 0; i < 4; ++i) { const int k = i * 32 + (tid >> 4), n = (tid & 15) * 4;
                T[(n + 0) * 136 + k] = f2bf(v[i].x); T[(n + 1) * 136 + k] = f2bf(v[i].y); T[(n + 2) * 136 + k] = f2bf(v[i].z); T[(n + 3) * 136 + k] = f2bf(v[i].w); }
            if (sub == QG - 1 && tid == 0) qslot[0] = more ? tnext : TOT;
            __syncthreads();
            { const int n = tid >> 3, kc = (tid & 7) * 16;
              const u32x4 a = *(const u32x4*)(T + n * 136 + kc), b = *(const u32x4*)(T + n * 136 + kc + 8);
              bf16_t* o = dp + (size_t)n * ds + kc;
              *(u32x4*)o = a; *(u32x4*)(o + 8) = b; }
        }
        ++done; t0 = __builtin_amdgcn_readfirstlane(qslot[0]);
    }
    __syncthreads();
    return done;
}
__device__ __forceinline__ void bg_cvt(const Params& p, int layer, char* lds, int budget) {
#pragma unroll 1
    for (int l = layer; l < 4 && l <= layer + 1 && budget > 0; ++l) budget -= moe_cvt(p, l, lds, budget);
}
__device__ __forceinline__ bool idle_tail(int nunits) { const int r = nunits % gdim(); return r != 0 && bidx() >= r; }
__device__ void ph_init(const Params& p, char* lds) {
    const int tid = tidx(), gtid = bidx() * NTHR + tid, gsz = gdim() * NTHR;
    xt_t* Xs = (xt_t*)(p.ws + OFF_X);
    const float4* x4 = (const float4*)p.x; const float4* c4 = (const float4*)p.ctx;
    { constexpr int NQ = NROW * 256 / 4;
      auto srcv = [&](int k) { return k < NLAT * 256 ? x4[k] : c4[k - NLAT * 256]; };
      for (int i = gtid; i < NQ; i += gsz) { const float4 t0 = srcv(i), t1 = srcv(i + NQ), t2 = srcv(i + 2 * NQ), t3 = srcv(i + 3 * NQ); xst(Xs, (size_t)4 * i, t0); xst(Xs, (size_t)4 * (i + NQ), t1); xst(Xs, (size_t)4 * (i + 2 * NQ), t2); xst(Xs, (size_t)4 * (i + 3 * NQ), t3); } }
    float* rc = (float*)(p.ws + OFF_ROPE_C); float* rs = (float*)(p.ws + OFF_ROPE_S);
    for (int i = gtid; i < TL * 32; i += gsz) {
        const int t = i >> 5, f = i & 31; const float pos = (float)((f < 16) ? (t >> 6) : (t & 63));
        const float inv = powf(10000.f, -(float)(f & 15) / 16.f); const float ang = pos * inv; rc[2 * i] = cosf(ang); rc[2 * i + 1] = sinf(ang);
    }
    float* sc = (float*)lds;
    float* red = sc + 5 * 1024;
    for (int i = tid; i < 5 * 1024; i += NTHR) { const float v = i < 4096 ? p.c[i] : p.c_ctx[i - 4096]; sc[i] = v / (1.f + expf(-v)); }
    __syncthreads();
    float* MOD = (float*)(p.ws + OFF_MOD);
    for (int item = bidx(); item < 4 * 96; item += gdim()) {
        const int l = item / 96, cg = item % 96, col = tid & 63, n = cg * 64 + col, kg = tid >> 6;
        const float* w = p.mod_w + ((size_t)l * 1024 + kg * 128) * 6144 + n;
        float a0 = 0, a1 = 0, a2 = 0, a3 = 0, a4 = 0;
#pragma unroll 16
        for (int k = 0; k < 128; ++k) { const float wv = w[(size_t)k * 6144]; const int kk = kg * 128 + k;
            a0 += sc[kk] * wv; a1 += sc[1024 + kk] * wv; a2 += sc[2048 + kk] * wv; a3 += sc[3072 + kk] * wv; a4 += sc[4096 + kk] * wv; }
        float* rr = red + (kg * 64 + col) * 5; rr[0] = a0; rr[1] = a1; rr[2] = a2; rr[3] = a3; rr[4] = a4;
        __syncthreads();
        if (tid < 320) { const int c2 = tid & 63, s = tid >> 6; float sum = 0;
            for (int q = 0; q < 8; ++q) sum += red[(q * 64 + c2) * 5 + s];
            MOD[((size_t)l * 5 + s) * 6144 + cg * 64 + c2] = sum + p.mod_b[l * 6144 + cg * 64 + c2]; }
        __syncthreads();
    }
}


__device__ void ph_small_cvt(const Params& p, char* lds) {
    for (int j = 0; j < 2; ++j) {
        char* wm = p.ws + OFF_WMLA + j * SZ_WMLA; char* wr = p.ws + OFF_WRW + j * SZ_WRW;
        const float* w_in = p.mla_w_in + (size_t)j * D * 448; const float* w_uq = p.mla_w_uq + (size_t)j * 256 * 1536; const float* w_ukv = p.mla_w_ukv + (size_t)j * 128 * 2048; const float* w_o = p.mla_w_o + (size_t)j * D * D;
        cvt_tiles(p.wv, lds, (bf16_t*)(wm + WM_IN), 1024, 512, 1, 0, [=](int, int k, int n) -> const float* { return n < 448 ? w_in + (size_t)k * 448 + n : nullptr; },
                  [=](int n) { if (n < 384 || n >= 448) return n; const int jj = n - 384; return 384 + (jj < 32 ? 2 * jj : 2 * (jj - 32) + 1); });
        cvt_tiles(p.wv, lds, (bf16_t*)(wm + WM_UQ), 256, 1536, 1, 0, [=](int, int k, int n) -> const float* { return w_uq + (size_t)k * 1536 + n; },
                  [=](int n) { const int h = n / 192, d = n % 192; if (d < 128) return n; const int jj = d - 128; return h * 192 + 128 + (jj < 32 ? 2 * jj : 2 * (jj - 32) + 1); });
        cvt_tiles(p.wv, lds, (bf16_t*)(wm + WM_UKV), 128, 2048, 1, 0, [=](int, int k, int n) -> const float* { return w_ukv + (size_t)k * 2048 + n; }, [=](int n) { return n; });
        cvt_tiles(p.wv, lds, (bf16_t*)(wm + WM_O), 1024, 1024, 1, 0, [=](int, int k, int n) -> const float* { return w_o + (size_t)k * D + n; }, [=](int n) { return n; });
        const float* w_rkv = p.rw_w_rkv + (size_t)j * 3 * D * D; const float* w1 = p.rw_w1 + (size_t)j * 2 * D * 64; const float* a1 = p.rw_a1 + (size_t)j * 2 * D * 64;
        const float* g1 = p.rw_g1 + (size_t)j * D * 128; const float* v1 = p.rw_v1; const float* rwo = p.rw_w_o + (size_t)j * D * D;
        cvt_tiles(p.wv, lds, (bf16_t*)(wr + WR_RKV), 1024, 1024, 3, (size_t)D * D, [=](int m, int k, int n) -> const float* { return w_rkv + ((size_t)m * D + k) * D + n; }, [=](int n) { return n; });
        cvt_tiles(p.wv, lds, (bf16_t*)(wr + WR_L), 1024, 256, 1, 0, [=](int, int k, int n) -> const float* { return n < 128 ? w1 + ((size_t)(n >> 6) * D + k) * 64 + (n & 63) : nullptr; }, [=](int n) { return n; });
        cvt_tiles(p.wv, lds, (bf16_t*)(wr + WR_L) + 256 * 1024, 1024, 256, 1, 0, [=](int, int k, int n) -> const float* { return n < 128 ? a1 + ((size_t)(n >> 6) * D + k) * 64 + (n & 63) : nullptr; }, [=](int n) { return n; });
        cvt_tiles(p.wv, lds, (bf16_t*)(wr + WR_L) + 2 * 256 * 1024, 1024, 256, 1, 0, [=](int, int k, int n) -> const float* { return n < 128 ? g1 + (size_t)k * 128 + n : nullptr; }, [=](int n) { return n; });
        cvt_tiles(p.wv, lds, (bf16_t*)(wr + WR_L) + 3 * 256 * 1024, 1024, 256, 1, 0, [=](int, int k, int n) -> const float* { return n < 32 ? v1 + (size_t)k * 32 + n : nullptr; }, [=](int n) { return n; });
        cvt_tiles(p.wv, lds, (bf16_t*)(wr + WR_O), 1024, 1024, 1, 0, [=](int, int k, int n) -> const float* { return rwo + (size_t)k * D + n; }, [=](int n) { return n; });
        const float* w2 = p.rw_w2 + (size_t)j * 2 * 64 * D; const float* a2 = p.rw_a2 + (size_t)j * 2 * 64 * D; const float* g2 = p.rw_g2 + (size_t)j * 128 * D; const float* v2 = p.rw_v2;
        cvt_tiles(p.wv, lds, (bf16_t*)(wr + WR_B2), 128, 2048, 2, (size_t)2048 * 128, [=](int bt, int k, int n) -> const float* { const int zz = n >> 10, c = n & 1023, l = k - zz * 64;
            if (l < 0 || l >= 64) return nullptr; return (bt == 0 ? w2 : a2) + ((size_t)zz * 64 + l) * D + c; }, [=](int n) { return n; });
        cvt_tiles(p.wv, lds, (bf16_t*)(wr + WR_B3), 128, 1024, 2, (size_t)1024 * 128, [=](int bt, int k, int n) -> const float* {
            if (bt == 0) return g2 + (size_t)k * D + n; return k < 32 ? v2 + (size_t)k * D + n : nullptr; }, [=](int n) { return n; });
    }
}

template <bool OUTF32>
__device__ void ph_norm_mod(const Params& p, int layer, const float* g, int part_sh, int part_sc, void* outp) {
    const int wid = tidx() >> 6, lane = tidx() & 63;
    const xt_t* X = (const xt_t*)(p.ws + OFF_X);
    int row = bidx() * 8 + wid;
    float4 nv[4];
    if (row < NROW) {
#pragma unroll
        for (int i = 0; i < 4; ++i) nv[i] = xld(X, (size_t)row * D + (lane + i * 64) * 4); }
    for (; row < NROW; row += gdim() * 8) {
        const int s = row_stream(row);
        const float* sh = modp(p, layer, s, part_sh); const float* sc = modp(p, layer, s, part_sc);
        float4 v[4]; float ss = 0;
#pragma unroll
        for (int i = 0; i < 4; ++i) { v[i] = nv[i]; ss += v[i].x * v[i].x + v[i].y * v[i].y + v[i].z * v[i].z + v[i].w * v[i].w; }
        { const int nrow = row + gdim() * 8;
          if (nrow < NROW) {
#pragma unroll
              for (int i = 0; i < 4; ++i) nv[i] = xld(X, (size_t)nrow * D + (lane + i * 64) * 4); } }
        ss = wave_sum(ss); const float rs = rsqrtf(ss * (1.f / D) + RMS_EPS);
#pragma unroll
        for (int i = 0; i < 4; ++i) {
            const int d = (lane + i * 64) * 4;
            const float4 gg = *(const float4*)(g + d), a = *(const float4*)(sc + d), b = *(const float4*)(sh + d);
            float4 o; o.x = v[i].x * rs * gg.x * (1.f + a.x) + b.x; o.y = v[i].y * rs * gg.y * (1.f + a.y) + b.y; o.z = v[i].z * rs * gg.z * (1.f + a.z) + b.z; o.w = v[i].w * rs * gg.w * (1.f + a.w) + b.w;
            if (OUTF32) *(float4*)((float*)outp + (size_t)row * D + d) = o;
            else { uint2 w; w.x = pk2(o.x, o.y); w.y = pk2(o.z, o.w); *(uint2*)((bf16_t*)outp + (size_t)row * D + d) = w; }
        }
    }
}

__device__ void ph_mla_mid(const Params& p, int j) {
    const int wid = tidx() >> 6, lane = tidx() & 63;
    const float* Z = (const float*)(p.ws + OFF_Z);
    bf16_t* CQN = (bf16_t*)(p.ws + OFF_CQN); bf16_t* CKVN = (bf16_t*)(p.ws + OFF_CKVN); bf16_t* K = (bf16_t*)(p.ws + OFF_K);
    const float* gq = p.mla_g_q + j * 256; const float* gkv = p.mla_g_kv + j * 128;
    const float* rc = (const float*)(p.ws + OFF_ROPE_C); const float* rs = (const float*)(p.ws + OFF_ROPE_S);
    for (int row = bidx() * 8 + wid; row < NROW; row += gdim() * 8) {
        const float* z = Z + (size_t)row * 512;
        const float4 q = *(const float4*)(z + lane * 4);
        const float2 kv = *(const float2*)(z + 256 + lane * 2);
        const float kr = z[384 + lane];
        float sq = wave_sum(q.x * q.x + q.y * q.y + q.z * q.z + q.w * q.w); const float rq = rsqrtf(sq * (1.f / 256.f) + RMS_EPS);
        float sk = wave_sum(kv.x * kv.x + kv.y * kv.y); const float rk = rsqrtf(sk * (1.f / 128.f) + RMS_EPS);
        const float4 g4 = *(const float4*)(gq + lane * 4); const float2 g2 = *(const float2*)(gkv + lane * 2);
        uint2 w; w.x = pk2(q.x * rq * g4.x, q.y * rq * g4.y); w.y = pk2(q.z * rq * g4.z, q.w * rq * g4.w);
        *(uint2*)(CQN + (size_t)row * 256 + lane * 4) = w;
        *(unsigned*)(CKVN + (size_t)row * 128 + lane * 2) = pk2(kv.x * rk * g2.x, kv.y * rk * g2.y);
        float o = kr;
        const float other = __builtin_bit_cast(float, __builtin_amdgcn_update_dpp(0, __builtin_bit_cast(int, kr), 0xB1, 0xF, 0xF, true));
        const bool lat = row < NLAT;
        if (lat) { const int t = row & (TL - 1), i = lane >> 1; const float2 cs = *(const float2*)(rc + (t * 32 + i) * 2); const float c = cs.x, s = cs.y;
            o = (lane & 1) ? (other * s + kr * c) : (kr * c - other * s); }
        const int b = lat ? (row >> 12) : ((row - NLAT) >> 8); const int tk = lat ? 256 + (row & (TL - 1)) : ((row - NLAT) & 255);
        const bf16_t ob = f2bf(o);
#pragma unroll
        for (int h = 0; h < 8; ++h) K[((size_t)(b * 8 + h) * TK + tk) * 192 + 128 + lane] = ob;
    }
}

__device__ void ph_qkv_post(const Params& p) {
    const int wid = tidx() >> 6, lane = tidx() & 63;
    const float* QRAW = (const float*)(p.ws + OFF_QRAW); const float* KVRAW = (const float*)(p.ws + OFF_KVRAW); const float* KR = (const float*)(p.ws + OFF_KR);
    bf16_t* Q = (bf16_t*)(p.ws + OFF_Q); bf16_t* K = (bf16_t*)(p.ws + OFF_K); bf16_t* V = (bf16_t*)(p.ws + OFF_V);
    const float* rc = (const float*)(p.ws + OFF_ROPE_C); const float* rs = (const float*)(p.ws + OFF_ROPE_S);
    for (int it = bidx() * 8 + wid; it < NROW * 8; it += gdim() * 8) {
        const int row = it >> 3, h = it & 7;
        const bool lat = row < NLAT; const int b = lat ? (row >> 12) : ((row - NLAT) >> 8); const int tk = lat ? 256 + (row & (TL - 1)) : ((row - NLAT) & 255);
        const size_t orow = (size_t)(b * 8 + h) * TK + tk;
        const float* q = QRAW + (size_t)row * 1536 + h * 192;
        const float q0 = q[lane], q1 = q[64 + lane]; float q2 = q[128 + lane];
        const auto sw = __builtin_amdgcn_permlane32_swap(__float_as_uint(q2), __float_as_uint(q2), false, false);
        if (lat) { const int t = row & (TL - 1), i = lane & 31; const float c = rc[t * 32 + i], s = rs[t * 32 + i];
            const float x1 = __uint_as_float(sw[0]), x2 = __uint_as_float(sw[1]); q2 = lane < 32 ? (x1 * c - x2 * s) : (x1 * s + x2 * c); }
        bf16_t* qo = Q + orow * 192; qo[lane] = f2bf(q0); qo[64 + lane] = f2bf(q1); qo[128 + lane] = f2bf(q2);
        const float* kv = KVRAW + (size_t)row * 2048 + h * 256;
        bf16_t* ko = K + orow * 192; ko[lane] = f2bf(kv[lane]); ko[64 + lane] = f2bf(kv[64 + lane]); ko[128 + lane] = f2bf(KR[(size_t)row * 64 + lane]);
        bf16_t* vo = V + orow * 128; vo[lane] = f2bf(kv[128 + lane]); vo[64 + lane] = f2bf(kv[192 + lane]);
    }
}

__device__ void ph_attn_naive(const Params& p, char* lds) {
    const int tid = tidx(), qi = tid >> 2, part = tid & 3;
    const bf16_t* Q = (const bf16_t*)(p.ws + OFF_Q); const bf16_t* K = (const bf16_t*)(p.ws + OFF_K); const bf16_t* V = (const bf16_t*)(p.ws + OFF_V);
    bf16_t* O = (bf16_t*)(p.ws + OFF_O);
    bf16_t* Ks = (bf16_t*)lds;
    bf16_t* Vs = Ks + 32 * 192;
    const int nitems = 32 * 34;
    for (int it = bidx(); it < nitems; it += gdim()) {
        const int bh = it / 34, qb = it % 34; const int b = bh >> 3, h = bh & 7;
        const int nkeys = qb < 2 ? TC : TK;
        const int tq = qb * 128 + qi;
        const bf16_t* qp = Q + ((size_t)bh * TK + tq) * 192 + part * 48;
        float q[48];
#pragma unroll
        for (int i = 0; i < 48; ++i) q[i] = bf2f(qp[i]) * ATT_SCALE;
        float o[32];
#pragma unroll
        for (int i = 0; i < 32; ++i) o[i] = 0.f;
        float m = -1e30f, l = 0.f;
        for (int k0 = 0; k0 < nkeys; k0 += 32) {
            __syncthreads();
            {
                const bf16_t* kg = K + ((size_t)bh * TK + k0) * 192; const bf16_t* vg = V + ((size_t)bh * TK + k0) * 128;
                for (int c = tid; c < 768; c += NTHR) *(u32x4*)(Ks + c * 8) = *(const u32x4*)(kg + c * 8);
                *(u32x4*)(Vs + tid * 8) = *(const u32x4*)(vg + tid * 8);
            }
            __syncthreads();
#pragma unroll 1
            for (int kg = 0; kg < 32; kg += 8) {
                float s[8]; float tmax = -1e30f;
#pragma unroll
                for (int kk = 0; kk < 8; ++kk) {
                    const bf16_t* kr = Ks + (kg + kk) * 192 + part * 48; float acc = 0.f;
#pragma unroll
                    for (int i = 0; i < 48; ++i) acc += q[i] * bf2f(kr[i]);
                    acc += __shfl_xor(acc, 1); acc += __shfl_xor(acc, 2);
                    s[kk] = acc; tmax = fmaxf(tmax, acc);
                    asm volatile("" ::: "memory");
                }
                const float mn = fmaxf(m, tmax), alpha = expf(m - mn); m = mn; l *= alpha;
#pragma unroll
                for (int i = 0; i < 32; ++i) o[i] *= alpha;
#pragma unroll
                for (int kk = 0; kk < 8; ++kk) {
                    const float pw = expf(s[kk] - mn); l += pw;
                    const bf16_t* vr = Vs + (kg + kk) * 128 + part * 32;
#pragma unroll
                    for (int i = 0; i < 32; ++i) o[i] += pw * bf2f(vr[i]);
                    asm volatile("" ::: "memory");
                }
            }
        }
        const float rl = 1.f / l;
        const int row = qb < 2 ? (NLAT + b * TC + tq) : (b * TL + tq - TC);
        bf16_t* op = O + (size_t)row * D + h * 128 + part * 32;
#pragma unroll
        for (int i = 0; i < 32; ++i) op[i] = f2bf(o[i] * rl);
    }
}


namespace fa {
using s16x4  = __attribute__((ext_vector_type(4))) short;
using f32x16 = __attribute__((ext_vector_type(16))) float;
constexpr int DQK = 192, DV = 128, KVBLK = 64;
constexpr float THR = 8.f;
constexpr int SHM_V = KVBLK * DV * 2, SHM_K = KVBLK * DQK * 2;
constexpr int SHM_ATTN = 2 * SHM_V + 2 * SHM_K + 8 * 64 * 4;
#define KSWZ(row, colB) ((row) * 384 + ((colB) ^ ((((row) >> 1) & 7) << 4)))
#define SBAR() __builtin_amdgcn_sched_barrier(0)
__device__ __forceinline__ int crow(int r, int hi) { return (r & 3) + 8 * (r >> 2) + 4 * hi; }
__device__ __forceinline__ unsigned cvtpk(float lo, float hi) { unsigned r; asm volatile("v_cvt_pk_bf16_f32 %0, %1, %2" : "=v"(r) : "v"(lo), "v"(hi)); return r; }
__device__ __forceinline__ void partialSM(f32x16& p0, f32x16& p1, float& m_reg, float& mn, float& alpha) {
  constexpr float C = ATT_SCALE * 1.4426950408889634f;
  float pmax = p0[0];
#pragma unroll
  for (int r = 1; r < 16; ++r) pmax = fmaxf(pmax, p0[r]);
#pragma unroll
  for (int r = 0; r < 16; ++r) pmax = fmaxf(pmax, p1[r]);
  { auto rr = __builtin_amdgcn_permlane32_swap(__float_as_uint(pmax), __float_as_uint(pmax), false, false);
    pmax = fmaxf(__uint_as_float(rr[0]), __uint_as_float(rr[1])); }
  if (__builtin_expect(__all(pmax - m_reg <= THR / ATT_SCALE), 1)) { mn = m_reg; alpha = 1.f; }
  else { mn = fmaxf(m_reg, pmax); alpha = __builtin_amdgcn_exp2f((m_reg - mn) * C); m_reg = mn; }
  float mnC = -mn * C;
#pragma unroll
  for (int r = 0; r < 16; ++r) p0[r] = fmaf(p0[r], C, mnC);
#pragma unroll
  for (int r = 0; r < 16; ++r) p1[r] = fmaf(p1[r], C, mnC);
#pragma unroll
  for (int r = 0; r < 16; ++r) p0[r] = __builtin_amdgcn_exp2f(p0[r]);
}
__device__ __forceinline__ void finishSM(f32x16& p0, f32x16& p1, float alpha, float& l_reg, bf16x8& pa0, bf16x8& pa1, bf16x8& pa2, bf16x8& pa3) {
#pragma unroll
  for (int r = 0; r < 16; ++r) p1[r] = __builtin_amdgcn_exp2f(p1[r]);
  float ps = 0;
#pragma unroll
  for (int r = 0; r < 16; ++r) ps += p0[r];
#pragma unroll
  for (int r = 0; r < 16; ++r) ps += p1[r];
  { auto rr = __builtin_amdgcn_permlane32_swap(__float_as_uint(ps), __float_as_uint(ps), false, false);
    ps = __uint_as_float(rr[0]) + __uint_as_float(rr[1]); }
  l_reg = l_reg * alpha + ps;
#define PK4(P, BASE, OUT) do { unsigned a0 = cvtpk(P[BASE + 0], P[BASE + 1]), a1 = cvtpk(P[BASE + 2], P[BASE + 3]);   \
    unsigned b0 = cvtpk(P[BASE + 4], P[BASE + 5]), b1 = cvtpk(P[BASE + 6], P[BASE + 7]);                              \
    auto r0 = __builtin_amdgcn_permlane32_swap(a0, b0, false, false); auto r1 = __builtin_amdgcn_permlane32_swap(a1, b1, false, false); \
    u32x4 w = {r0[0], r1[0], r0[1], r1[1]}; OUT = *reinterpret_cast<bf16x8*>(&w); } while (0)
  PK4(p0, 0, pa0); PK4(p0, 8, pa1); PK4(p1, 0, pa2); PK4(p1, 8, pa3);
#undef PK4
}
__device__ __forceinline__ void qkt(f32x16& p0, f32x16& p1, const char* Ks, const bf16x8* qr, int r32, int hi) {
  p0 = f32x16{}; p1 = f32x16{};
  const int swz = ((r32 >> 1) & 7) << 4;
  const char* b4[4];
#pragma unroll
  for (int dr = 0; dr < 4; ++dr) b4[dr] = Ks + r32 * 384 + ((dr * 32 + hi * 16) ^ swz);
#pragma unroll
  for (int d0 = 0; d0 < 12; ++d0) {
    bf16x8 b0 = *reinterpret_cast<const bf16x8*>(b4[d0 & 3] + (d0 >> 2) * 128);
    bf16x8 b1 = *reinterpret_cast<const bf16x8*>(b4[d0 & 3] + (d0 >> 2) * 128 + 32 * 384);
    p0 = __builtin_amdgcn_mfma_f32_32x32x16_bf16(b0, qr[d0], p0, 0, 0, 0);
    p1 = __builtin_amdgcn_mfma_f32_32x32x16_bf16(b1, qr[d0], p1, 0, 0, 0); }
}
__device__ __forceinline__ int v_st(int k, int c) { const int kk = (k & ~0xC) | ((k & 4) << 1) | ((k & 8) >> 1); return ((kk >> 3) * 4 + (c >> 5)) * 512 + ((kk & 7) * 32 + (c & 31)) * 2; }
__device__ __forceinline__ int v_rd_base(int lane) { return ((lane & 3) << 3) | (((lane >> 2) & 3) << 6) | (((lane >> 4) & 1) << 5) | (((lane >> 5) & 1) << 8); }
constexpr int v_rd_off(int d0, int ks, int half) { return d0 * 512 + ks * 4096 + half * 2048; }
template <int OFF> __device__ __forceinline__ s16x4 tr_read(int vb) {
  s16x4 r; asm volatile("ds_read_b64_tr_b16 %0, %1 offset:%2" : "=&v"(r) : "v"(vb), "i"(OFF) : "memory"); return r;
}
template <int D0> __device__ __forceinline__ void pv_one(f32x16& od, int vb, bf16x8 pa0, bf16x8 pa1, bf16x8 pa2, bf16x8 pa3) {
  const s16x4 l0 = tr_read<v_rd_off(D0, 0, 0)>(vb), h0 = tr_read<v_rd_off(D0, 0, 1)>(vb), l1 = tr_read<v_rd_off(D0, 1, 0)>(vb), h1 = tr_read<v_rd_off(D0, 1, 1)>(vb);
  const s16x4 l2 = tr_read<v_rd_off(D0, 2, 0)>(vb), h2 = tr_read<v_rd_off(D0, 2, 1)>(vb), l3 = tr_read<v_rd_off(D0, 3, 0)>(vb), h3 = tr_read<v_rd_off(D0, 3, 1)>(vb);
  asm volatile("s_waitcnt lgkmcnt(0)" ::: "memory"); SBAR();
#define PK(L, H) (bf16x8){L[0], L[1], L[2], L[3], H[0], H[1], H[2], H[3]}
  od = __builtin_amdgcn_mfma_f32_32x32x16_bf16(pa0, PK(l0, h0), od, 0, 0, 0);
  od = __builtin_amdgcn_mfma_f32_32x32x16_bf16(pa1, PK(l1, h1), od, 0, 0, 0);
  od = __builtin_amdgcn_mfma_f32_32x32x16_bf16(pa2, PK(l2, h2), od, 0, 0, 0);
  od = __builtin_amdgcn_mfma_f32_32x32x16_bf16(pa3, PK(l3, h3), od, 0, 0, 0);
#undef PK
}
__device__ __forceinline__ void pv_d0(f32x16* o, int vb, bf16x8 pa0, bf16x8 pa1, bf16x8 pa2, bf16x8 pa3) {
  pv_one<0>(o[0], vb, pa0, pa1, pa2, pa3); pv_one<1>(o[1], vb, pa0, pa1, pa2, pa3); pv_one<2>(o[2], vb, pa0, pa1, pa2, pa3); pv_one<3>(o[3], vb, pa0, pa1, pa2, pa3);
}
__device__ __forceinline__ void attn_body(const int wv_, const bf16_t* __restrict__ Qb, const bf16_t* __restrict__ Kh, const bf16_t* __restrict__ Vh, bf16_t* __restrict__ Ob, int ldo, int seq, char* lds, const float* __restrict__ ropecs  ) {
  const int tid = tidx_w(wv_), wid = tid >> 6, lane = tid & 63, r32 = lane & 31, hi = lane >> 5;
  char* V_lds = lds; char* K_lds = lds + 2 * SHM_V;
  float* ws = (float*)(lds + 2 * SHM_V + 2 * SHM_K) + wid * 64; float* li_l = ws; float* al_l = ws + 32;
  float m_reg = -1e30f, l_reg = 0; f32x16 o[4] = {}; bf16x8 qr[12];
  const bf16_t* Qw = Qb + (long)(wid * 32 + r32) * DQK + hi * 8;
#pragma unroll
  for (int d0 = 0; d0 < 12; ++d0) qr[d0] = *reinterpret_cast<const bf16x8*>(Qw + d0 * 16);
  if (ropecs) {
    const float* cs = ropecs + (size_t)(wid * 32 + r32) * 64;
#pragma unroll
    for (int d0 = 8; d0 < 12; ++d0) { const int i0 = (d0 - 8) * 8 + hi * 4; const f32x4 c0 = *(const f32x4*)(cs + i0 * 2), c1 = *(const f32x4*)(cs + i0 * 2 + 4);
      u32x4 w = *reinterpret_cast<u32x4*>(&qr[d0]); const float cc[4] = {c0[0], c0[2], c1[0], c1[2]}, ss[4] = {c0[1], c0[3], c1[1], c1[3]};
#pragma unroll
      for (int m = 0; m < 4; ++m) { const float x1 = __uint_as_float(w[m] << 16), x2 = __uint_as_float(w[m] & 0xffff0000u); w[m] = cvtpk(x1 * cc[m] - x2 * ss[m], x1 * ss[m] + x2 * cc[m]); }
      qr[d0] = *reinterpret_cast<bf16x8*>(&w); }
  }
  const int sr = tid >> 4, sc = (tid & 15) * 8, vst0 = v_st(sr, sc), vst1 = v_st(32 + sr, sc);
  int kst[3];
#pragma unroll
  for (int i = 0; i < 3; ++i) { const int c = tid + 512 * i, row = c / 24, cc = c % 24; kst[i] = KSWZ(row, cc * 16); }
  const int vb0 = (int)(uintptr_t)V_lds + v_rd_base(lane);
  struct { bf16x8 vs0, vs1, ks0, ks1, ks2; } sr_[1];
#define SLOAD(i, k0) do { const bf16_t* vt = Vh + (long)(k0) * DV; const bf16_t* kt = Kh + (long)(k0) * DQK; \
    sr_[i].vs0 = *reinterpret_cast<const bf16x8*>(vt + (sr) * DV + sc); sr_[i].vs1 = *reinterpret_cast<const bf16x8*>(vt + (32 + sr) * DV + sc); \
    sr_[i].ks0 = *reinterpret_cast<const bf16x8*>(kt + tid * 8); sr_[i].ks1 = *reinterpret_cast<const bf16x8*>(kt + (tid + 512) * 8); sr_[i].ks2 = *reinterpret_cast<const bf16x8*>(kt + (tid + 1024) * 8); } while (0)
#define SWRITE(b, i) do { *(bf16x8*)(V_lds + (b) * SHM_V + vst0) = sr_[i].vs0; *(bf16x8*)(V_lds + (b) * SHM_V + vst1) = sr_[i].vs1; \
    *(bf16x8*)(K_lds + (b) * SHM_K + kst[0]) = sr_[i].ks0; *(bf16x8*)(K_lds + (b) * SHM_K + kst[1]) = sr_[i].ks1; *(bf16x8*)(K_lds + (b) * SHM_K + kst[2]) = sr_[i].ks2; } while (0)
#define SWAIT() asm volatile("s_waitcnt vmcnt(5)" ::: "memory")
#define RESC(a) do { if (__any((a) < 1.f)) { if (hi == 0) al_l[r32] = (a); asm volatile("s_waitcnt lgkmcnt(0)" ::: "memory"); \
    _Pragma("unroll") for (int d = 0; d < 4; ++d) _Pragma("unroll") for (int r = 0; r < 16; ++r) o[d][r] *= al_l[crow(r, hi)]; } } while (0)
  f32x16 pA0, pA1; float mnA, alA; bf16x8 pa0, pa1, pa2, pa3; const int NT = seq / KVBLK;
  SLOAD(0, 0); SWRITE(0, 0);
  SLOAD(0, KVBLK);
  __syncthreads();
  for (int j = 0; j < NT; j += 2) {
    SBAR(); qkt(pA0, pA1, K_lds, qr, r32, hi);
    partialSM(pA0, pA1, m_reg, mnA, alA); RESC(alA);
    finishSM(pA0, pA1, alA, l_reg, pa0, pa1, pa2, pa3); SBAR();
    SWRITE(1, 0);
    if (j + 2 < NT) SLOAD(0, (j + 2) * KVBLK);
    SBAR();
    pv_d0(o, vb0, pa0, pa1, pa2, pa3);
    __syncthreads();
    SBAR(); qkt(pA0, pA1, K_lds + SHM_K, qr, r32, hi);
    partialSM(pA0, pA1, m_reg, mnA, alA); RESC(alA);
    finishSM(pA0, pA1, alA, l_reg, pa0, pa1, pa2, pa3); SBAR();
    if (j + 2 < NT) { SWRITE(0, 0); if (j + 3 < NT) SLOAD(0, (j + 3) * KVBLK); }
    SBAR();
    pv_d0(o, vb0 + SHM_V, pa0, pa1, pa2, pa3);
    __syncthreads();
  }
  if (hi == 0) li_l[r32] = l_reg; asm volatile("s_waitcnt lgkmcnt(0)" ::: "memory");
  float rli[16];
#pragma unroll
  for (int r = 0; r < 16; ++r) rli[r] = __builtin_amdgcn_rcpf(li_l[crow(r, hi)]);
  bf16_t* Ow = Ob + (long)(wid * 32) * ldo;
#pragma unroll
  for (int r = 0; r < 16; ++r) { int orow = crow(r, hi);
#pragma unroll
    for (int d0 = 0; d0 < 4; ++d0) Ow[(long)orow * ldo + d0 * 32 + r32] = f2bf(o[d0][r] * rli[r]); }
  __syncthreads();
#undef SLOAD
#undef SWRITE
#undef SWAIT
#undef RESC
}
#undef KSWZ
}

__device__ void ph_attn(const Params& p, char* lds) {
    const bf16_t* Q = (const bf16_t*)(p.ws + OFF_Q); const bf16_t* K = (const bf16_t*)(p.ws + OFF_K); const bf16_t* V = (const bf16_t*)(p.ws + OFF_V);
    bf16_t* O = (bf16_t*)(p.ws + OFF_O);
    const int G = gdim();
    for (int i = 0;; ++i) {
        const int L = i * G + bidx(); if (L >= 544) break;
        int bh, qb;
        if (L < 512) { const int w = g8::xcd_remap(L, 512); bh = w >> 4; qb = 1 + (w & 15); } else { bh = L - 512; qb = 0; }
        const int b = bh >> 3, h = bh & 7;
        const int seq = qb == 0 ? TC : TK;
        const int row0 = qb == 0 ? NLAT + b * TC : b * TL + (qb - 1) * 256;
        fa::attn_body(p.wv, Q + ((size_t)bh * TK + qb * 256) * 192, K + (size_t)bh * TK * 192, V + (size_t)bh * TK * 128, O + (size_t)row0 * D + h * 128, D, seq, lds,
                      qb == 0 ? nullptr : (const float*)(p.ws + OFF_ROPE_C) + (size_t)(qb - 1) * 256 * 64);
    }
}

__device__ void ph_norm2_router(const Params& p, int layer, char* lds, int nrows) {
    const int tid = tidx(), wid = tid >> 6, lane = tid & 63;
    float* rt = (float*)lds;
    const float* rg = p.moe_router + (size_t)layer * D * NE;
    for (int i = tid; i < D * NE / 4; i += NTHR) { const int d = i >> 2, eq = i & 3; ((float4*)rt)[(((d >> 8) * 4 + (d & 3)) * 4 + eq) * 64 + ((d & 255) >> 2)] = ((const float4*)rg)[i]; }
    __syncthreads();
    const xt_t* X = (const xt_t*)(p.ws + OFF_X); bf16_t* BN = (bf16_t*)(p.ws + OFF_H); float* AFF = (float*)(p.ws + OFF_AFF);
    const float* g = p.norm2_g + layer * D;
    int row = bidx() * 8 + wid;
    float4 nv[4];
    if (row < nrows) {
#pragma unroll
        for (int i = 0; i < 4; ++i) nv[i] = xld(X, (size_t)row * D + (lane + i * 64) * 4); }
    for (; row < nrows; row += gdim() * 8) {
        const int s = row_stream(row);
        const float* sh = modp(p, layer, s, 3); const float* sc = modp(p, layer, s, 4);
        float4 v[4]; float ss = 0;
#pragma unroll
        for (int i = 0; i < 4; ++i) { v[i] = nv[i]; ss += v[i].x * v[i].x + v[i].y * v[i].y + v[i].z * v[i].z + v[i].w * v[i].w; }
        { const int nrow = row + gdim() * 8;
          if (nrow < nrows) {
#pragma unroll
              for (int i = 0; i < 4; ++i) nv[i] = xld(X, (size_t)nrow * D + (lane + i * 64) * 4); } }
        ss = wave_sum(ss); const float rs = rsqrtf(ss * (1.f / D) + RMS_EPS);
        float lg[16];
#pragma unroll
        for (int e = 0; e < 16; ++e) lg[e] = 0.f;
#pragma unroll
        for (int i = 0; i < 4; ++i) {
            const int d = (lane + i * 64) * 4;
            const float4 gg = *(const float4*)(g + d), a = *(const float4*)(sc + d), b = *(const float4*)(sh + d);
            float o[4]; o[0] = v[i].x * rs * gg.x * (1.f + a.x) + b.x; o[1] = v[i].y * rs * gg.y * (1.f + a.y) + b.y; o[2] = v[i].z * rs * gg.z * (1.f + a.z) + b.z; o[3] = v[i].w * rs * gg.w * (1.f + a.w) + b.w;
            uint2 w; w.x = pk2(o[0], o[1]); w.y = pk2(o[2], o[3]); *(uint2*)(BN + (size_t)row * D + d) = w;
#pragma unroll
            for (int jj = 0; jj < 4; ++jj) {
#pragma unroll
                for (int eq = 0; eq < 4; ++eq) { const float4 r4 = ((const float4*)rt)[((i * 4 + jj) * 4 + eq) * 64 + lane];
                    lg[4 * eq] += o[jj] * r4.x; lg[4 * eq + 1] += o[jj] * r4.y; lg[4 * eq + 2] += o[jj] * r4.z; lg[4 * eq + 3] += o[jj] * r4.w; } }
            asm volatile("" ::: "memory");
        }
        float mx = -1e30f;
#pragma unroll
        for (int e = 0; e < 16; ++e) { lg[e] = wave_sum(lg[e]); mx = fmaxf(mx, lg[e]); }
        float sum = 0;
#pragma unroll
        for (int e = 0; e < 16; ++e) { lg[e] = expf(lg[e] - mx); sum += lg[e]; }
        const float inv = 1.f / sum;
        if (lane < 16) { float val = 0;
#pragma unroll
            for (int e = 0; e < 16; ++e) val = (lane == e) ? lg[e] : val;
            AFF[(size_t)row * 16 + lane] = val * inv; }
    }
}

__device__ void ph_select(const Params& p, char* lds, int ngroups) {
    const int tid = tidx(), wid = tid >> 6, lane = tid & 63;
    unsigned* hist = (unsigned*)lds;
    unsigned* ctl = hist + 256;
    unsigned* wsum = ctl + 8;
    int* rowl = (int*)(wsum + 16);
    const float* AFF = (const float*)(p.ws + OFF_AFF);
    int* ROWIDX = (int*)(p.ws + OFF_ROWIDX); float* GATE = (float*)(p.ws + OFF_GATE); int* SLOT = (int*)(p.ws + OFF_SLOT);
    for (int gidx = bidx(); gidx < ngroups; gidx += gdim()) {
        const bool lat = gidx < 64; const int b = (gidx & 63) >> 4, e = gidx & 15;
        const int n = lat ? TL : TC, cap = lat ? CAPL : CAPC;
        const int row0 = lat ? b * TL : NLAT + b * TC, slot0 = lat ? b * CAPL : NB * CAPL + b * CAPC;
        unsigned key[8];
#pragma unroll
        for (int i = 0; i < 8; ++i) { const int idx = tid * 8 + i; key[i] = idx < n ? __float_as_uint(AFF[(size_t)(row0 + idx) * 16 + e]) : 0u; }
        unsigned prefix = 0u, remaining = (unsigned)cap;
#pragma unroll
        for (int pass = 0; pass < 4; ++pass) {
            const int sh = 24 - 8 * pass;
            __syncthreads();
            if (tid < 256) hist[tid] = 0u;
            __syncthreads();
#pragma unroll
            for (int i = 0; i < 8; ++i) { const int idx = tid * 8 + i;
                const bool cand = idx < n && (pass == 0 || (key[i] >> (sh + 8)) == prefix);
                if (cand) atomicAdd(&hist[(key[i] >> sh) & 255u], 1u); }
            __syncthreads();
            if (tid < 256) { unsigned gt = 0; for (int jj = tid + 1; jj < 256; ++jj) gt += hist[jj];
                const unsigned mine = hist[tid];
                if (gt < remaining && remaining <= gt + mine) { ctl[0] = (unsigned)tid; ctl[1] = remaining - gt; } }
            __syncthreads();
            prefix = (prefix << 8) | ctl[0]; remaining = ctl[1];
        }
        const unsigned T = prefix, m = remaining;
        unsigned cgt = 0, ceq = 0;
#pragma unroll
        for (int i = 0; i < 8; ++i) { const int idx = tid * 8 + i; if (idx < n) { cgt += key[i] > T ? 1u : 0u; ceq += key[i] == T ? 1u : 0u; } }
        auto block_excl = [&](unsigned v) -> unsigned {
            unsigned inc = v;
#pragma unroll
            for (int o = 1; o < 64; o <<= 1) { const unsigned t = (unsigned)__builtin_amdgcn_ds_bpermute((lane - o) << 2, (int)inc); if (lane >= o) inc += t; }
            __syncthreads();
            if (lane == 63) wsum[wid] = inc;
            __syncthreads();
            unsigned base = 0;
#pragma unroll
            for (int w = 0; w < 8; ++w) base += (w < wid) ? wsum[w] : 0u;
            return base + inc - v; };
        unsigned eqbase = block_excl(ceq);
        unsigned nsel = 0; bool sel[8];
#pragma unroll
        for (int i = 0; i < 8; ++i) { const int idx = tid * 8 + i; bool s_ = false;
            if (idx < n) { if (key[i] > T) s_ = true; else if (key[i] == T) { s_ = eqbase < m; ++eqbase; } }
            sel[i] = s_; nsel += s_ ? 1u : 0u; }
        unsigned sbase = block_excl(nsel);
#pragma unroll
        for (int i = 0; i < 8; ++i) { const int idx = tid * 8 + i;
            if (idx < n) {
                if (sel[i]) { const int sl = slot0 + (int)sbase; rowl[sbase] = row0 + idx; ++sbase; ROWIDX[e * ESLOTS + sl] = row0 + idx; GATE[e * EPAD + sl] = __uint_as_float(key[i]); SLOT[(size_t)(row0 + idx) * 16 + e] = sl; }
                else SLOT[(size_t)(row0 + idx) * 16 + e] = -1; } }
        __syncthreads();
        { const bf16_t* BN = (const bf16_t*)(p.ws + OFF_H); bf16_t* XE = (bf16_t*)(p.ws + OFF_XE);
          for (int r = wid; r < cap; r += 32) {
              u32x4 t_[4][2];
#pragma unroll
              for (int u = 0; u < 4; ++u) { const u32x4* src = (const u32x4*)(BN + (size_t)rowl[r + 8 * u] * D); t_[u][0] = src[lane]; t_[u][1] = src[lane + 64]; }
#pragma unroll
              for (int u = 0; u < 4; ++u) { u32x4* dst = (u32x4*)(XE + ((size_t)e * EPAD + slot0 + r + 8 * u) * D); dst[lane] = t_[u][0]; dst[lane + 64] = t_[u][1]; } } }
    }
}

__device__ void ph_gather(const Params& p, int nslots) {
    const int wid = tidx() >> 6, lane = tidx() & 63;
    const int* ROWIDX = (const int*)(p.ws + OFF_ROWIDX); const bf16_t* BN = (const bf16_t*)(p.ws + OFF_H); bf16_t* XE = (bf16_t*)(p.ws + OFF_XE);
    for (int it = bidx() * 8 + wid; it < NE * ESLOTS; it += gdim() * 8) {
        const int e = it / ESLOTS, sl = it % ESLOTS; if (sl >= nslots) continue; const int row = ROWIDX[it];
        const u32x4* src = (const u32x4*)(BN + (size_t)row * D); u32x4* dst = (u32x4*)(XE + ((size_t)e * EPAD + sl) * D);
        dst[lane] = src[lane]; dst[lane + 64] = src[lane + 64];
    }
}

__device__ void ph_combine(const Params& p, int layer, int nrows) {
    const int wid = tidx() >> 6, lane = tidx() & 63;
    const int* SLOT = (const int*)(p.ws + OFF_SLOT); const bf16_t* YE = (const bf16_t*)(p.ws + OFF_YE); xt_t* X = (xt_t*)(p.ws + OFF_X);
    int row = bidx() * 8 + wid;
    int sl = (row < nrows && lane < 16) ? SLOT[(size_t)row * 16 + lane] : -1;
    while (row < nrows) {
        const int nrow = row + gdim() * 8;
        const int sln = (nrow < nrows && lane < 16) ? SLOT[(size_t)nrow * 16 + lane] : -1;
        const float* gt = modp(p, layer, row_stream(row), 5);
        xt_t* xr = X + (size_t)row * D + lane * 8;
        f32x4 xv[4];
#pragma unroll
        for (int i = 0; i < 2; ++i) { xv[2 * i] = xldv(xr, 512 * i); xv[2 * i + 1] = xldv(xr, 512 * i + 4); }
        unsigned long long m = __ballot(sl >= 0);
        float acc[16];
#pragma unroll
        for (int i = 0; i < 16; ++i) acc[i] = 0.f;
        while (m) {
            const int e0 = __builtin_ctzll(m); m &= m - 1; const bool two = m != 0; const int e1 = two ? __builtin_ctzll(m) : e0; if (two) m &= m - 1;
            const int s0 = __builtin_amdgcn_readlane(sl, e0), s1 = __builtin_amdgcn_readlane(sl, e1);
            const bf16_t* y0 = YE + ((size_t)e0 * EPAD + s0) * D + lane * 8; const bf16_t* y1 = YE + ((size_t)e1 * EPAD + s1) * D + lane * 8;
            const u32x4 a0 = *(const u32x4*)y0, a1 = *(const u32x4*)(y0 + 512), b0 = *(const u32x4*)y1, b1 = *(const u32x4*)(y1 + 512);
            const float f1 = two ? 1.f : 0.f;
#pragma unroll
            for (int i = 0; i < 4; ++i) { acc[2 * i] += __uint_as_float(a0[i] << 16) + f1 * __uint_as_float(b0[i] << 16); acc[2 * i + 1] += __uint_as_float(a0[i] & 0xffff0000u) + f1 * __uint_as_float(b0[i] & 0xffff0000u);
                acc[8 + 2 * i] += __uint_as_float(a1[i] << 16) + f1 * __uint_as_float(b1[i] << 16); acc[8 + 2 * i + 1] += __uint_as_float(a1[i] & 0xffff0000u) + f1 * __uint_as_float(b1[i] & 0xffff0000u); }
        }
#pragma unroll
        for (int i = 0; i < 2; ++i) { const f32x4 g0 = *(const f32x4*)(gt + lane * 8 + 512 * i), g1 = *(const f32x4*)(gt + lane * 8 + 512 * i + 4);
            f32x4 o0 = xv[2 * i], o1 = xv[2 * i + 1];
#pragma unroll
            for (int e = 0; e < 4; ++e) { o0[e] += g0[e] * acc[8 * i + e]; o1[e] += g1[e] * acc[8 * i + 4 + e]; }
            xstv(xr, 512 * i, o0); xstv(xr, 512 * i + 4, o1); }
        row = nrow; sl = sln;
    }
}

template <bool FINAL>
__device__ void ph_comb_norm(const Params& p, int lprev, int layer, int nrows) {
    const int wid = tidx() >> 6, lane = tidx() & 63;
    const int* SLOT = (const int*)(p.ws + OFF_SLOT); const bf16_t* YE = (const bf16_t*)(p.ws + OFF_YE); xt_t* X = (xt_t*)(p.ws + OFF_X);
    bf16_t* H = (bf16_t*)(p.ws + OFF_H);
    const float* g = FINAL ? p.final_g : p.norm1_g + layer * D;
    int row = bidx() * 8 + wid;
    int sl = (row < nrows && lane < 16) ? SLOT[(size_t)row * 16 + lane] : -1;
    while (row < nrows) {
        const int nrow = row + gdim() * 8;
        const int sln = (nrow < nrows && lane < 16) ? SLOT[(size_t)nrow * 16 + lane] : -1;
        const int strm = row_stream(row);
        const float* gt = modp(p, lprev, strm, 5);
        xt_t* xr = X + (size_t)row * D + lane * 8;
        f32x4 xv[4];
#pragma unroll
        for (int i = 0; i < 2; ++i) { xv[2 * i] = xldv(xr, 512 * i); xv[2 * i + 1] = xldv(xr, 512 * i + 4); }
        unsigned long long m = __ballot(sl >= 0);
        float acc[16];
#pragma unroll
        for (int i = 0; i < 16; ++i) acc[i] = 0.f;
        while (m) {
            const int e0 = __builtin_ctzll(m); m &= m - 1; const bool two = m != 0; const int e1 = two ? __builtin_ctzll(m) : e0; if (two) m &= m - 1;
            const int s0 = __builtin_amdgcn_readlane(sl, e0), s1 = __builtin_amdgcn_readlane(sl, e1);
            const bf16_t* y0 = YE + ((size_t)e0 * EPAD + s0) * D + lane * 8; const bf16_t* y1 = YE + ((size_t)e1 * EPAD + s1) * D + lane * 8;
            const u32x4 a0 = *(const u32x4*)y0, a1 = *(const u32x4*)(y0 + 512), b0 = *(const u32x4*)y1, b1 = *(const u32x4*)(y1 + 512);
            const float f1 = two ? 1.f : 0.f;
#pragma unroll
            for (int i = 0; i < 4; ++i) { acc[2 * i] += __uint_as_float(a0[i] << 16) + f1 * __uint_as_float(b0[i] << 16); acc[2 * i + 1] += __uint_as_float(a0[i] & 0xffff0000u) + f1 * __uint_as_float(b0[i] & 0xffff0000u);
                acc[8 + 2 * i] += __uint_as_float(a1[i] << 16) + f1 * __uint_as_float(b1[i] << 16); acc[8 + 2 * i + 1] += __uint_as_float(a1[i] & 0xffff0000u) + f1 * __uint_as_float(b1[i] & 0xffff0000u); }
        }
        float ss = 0.f;
#pragma unroll
        for (int i = 0; i < 2; ++i) { const f32x4 g0 = *(const f32x4*)(gt + lane * 8 + 512 * i), g1 = *(const f32x4*)(gt + lane * 8 + 512 * i + 4);
#pragma unroll
            for (int e = 0; e < 4; ++e) { xv[2 * i][e] += g0[e] * acc[8 * i + e]; xv[2 * i + 1][e] += g1[e] * acc[8 * i + 4 + e]; ss += xv[2 * i][e] * xv[2 * i][e] + xv[2 * i + 1][e] * xv[2 * i + 1][e]; }
            if (!FINAL) { xstv(xr, 512 * i, xv[2 * i]); xstv(xr, 512 * i + 4, xv[2 * i + 1]); } }
        ss = wave_sum(ss); const float rs = rsqrtf(ss * (1.f / D) + RMS_EPS);
        const float* sh = FINAL ? nullptr : modp(p, layer, strm, 0); const float* sc = FINAL ? nullptr : modp(p, layer, strm, 1);
#pragma unroll
        for (int i = 0; i < 2; ++i)
#pragma unroll
            for (int hh = 0; hh < 2; ++hh) { const int d = lane * 8 + 512 * i + 4 * hh; const f32x4 gg = *(const f32x4*)(g + d); f32x4 o = xv[2 * i + hh] * rs * gg;
                if (FINAL) *(f32x4*)(p.out + (size_t)row * D + d) = o;
                else { o = o * (1.f + *(const f32x4*)(sc + d)) + *(const f32x4*)(sh + d); stbf4(H + (size_t)row * D + d, o); } }
        row = nrow; sl = sln;
    }
}

__device__ void ph_rw_normxs(const Params& p, int layer, int j) {
    const int wid = tidx() >> 6, lane = tidx() & 63;
    const xt_t* X = (const xt_t*)(p.ws + OFF_X); bf16_t* XS = (bf16_t*)(p.ws + OFF_XS);
    const float* mu = p.rw_mu + (size_t)j * 6 * D; const float* g = p.norm1_g + layer * D;
    float4 fc[4], fp[4], fn[4];
#define XS_LOAD(R) do { const bool lat_ = (R) < NLAT; const int t_ = lat_ ? ((R) & (TL - 1)) : (((R) - NLAT) & (TC - 1)); const int len_ = lat_ ? TL : TC; \
        _Pragma("unroll") for (int i = 0; i < 4; ++i) { fc[i] = xld(X, (size_t)(R) * D + (lane + i * 64) * 4); \
            fp[i] = t_ > 0 ? xld(X, (size_t)((R) - 1) * D + (lane + i * 64) * 4) : make_float4(0, 0, 0, 0); \
            fn[i] = t_ < len_ - 1 ? xld(X, (size_t)((R) + 1) * D + (lane + i * 64) * 4) : make_float4(0, 0, 0, 0); } } while (0)
    int row = bidx() * 8 + wid;
    if (row < NROW) XS_LOAD(row);
    for (; row < NROW; row += gdim() * 8) {
        const int s_ = row_stream(row);
        const float* sh = modp(p, layer, s_, 0); const float* sc = modp(p, layer, s_, 1);
        const bool lat = row < NLAT; const int t = lat ? (row & (TL - 1)) : ((row - NLAT) & (TC - 1)); const int len = lat ? TL : TC;
        const bool hp = t > 0, hn = t < len - 1;
        float4 xc[4], xp[4], xn[4]; float sc_ = 0, sp_ = 0, sn_ = 0;
#pragma unroll
        for (int i = 0; i < 4; ++i) { xc[i] = fc[i]; xp[i] = fp[i]; xn[i] = fn[i]; }
        { const int nrow = row + gdim() * 8; if (nrow < NROW) XS_LOAD(nrow); }
#pragma unroll
        for (int i = 0; i < 4; ++i) {
            sc_ += xc[i].x * xc[i].x + xc[i].y * xc[i].y + xc[i].z * xc[i].z + xc[i].w * xc[i].w;
            sp_ += xp[i].x * xp[i].x + xp[i].y * xp[i].y + xp[i].z * xp[i].z + xp[i].w * xp[i].w;
            sn_ += xn[i].x * xn[i].x + xn[i].y * xn[i].y + xn[i].z * xn[i].z + xn[i].w * xn[i].w; }
        sc_ = wave_sum(sc_); sp_ = wave_sum(sp_); sn_ = wave_sum(sn_);
        const float rc = rsqrtf(sc_ * (1.f / D) + RMS_EPS), rp = hp ? rsqrtf(sp_ * (1.f / D) + RMS_EPS) : 0.f, rn = hn ? rsqrtf(sn_ * (1.f / D) + RMS_EPS) : 0.f;
#pragma unroll
        for (int i = 0; i < 4; ++i) {
            const int d = (lane + i * 64) * 4;
            const float4 gg = *(const float4*)(g + d), a = *(const float4*)(sc + d), bsh = *(const float4*)(sh + d);
            float h[4], xx[4];
            const float gm[4] = {gg.x * (1.f + a.x), gg.y * (1.f + a.y), gg.z * (1.f + a.z), gg.w * (1.f + a.w)}; const float bb[4] = {bsh.x, bsh.y, bsh.z, bsh.w};
            const float c4[4] = {xc[i].x, xc[i].y, xc[i].z, xc[i].w}, p4[4] = {xp[i].x, xp[i].y, xp[i].z, xp[i].w}, n4[4] = {xn[i].x, xn[i].y, xn[i].z, xn[i].w};
#pragma unroll
            for (int e = 0; e < 4; ++e) { h[e] = c4[e] * rc * gm[e] + bb[e];
                const float hpv = hp ? p4[e] * rp * gm[e] + bb[e] : 0.f, hnv = hn ? n4[e] * rn * gm[e] + bb[e] : 0.f;
                xx[e] = 0.5f * (hpv + hnv) - h[e]; }
#pragma unroll
            for (int m = 0; m < 6; ++m) { const float4 u = *(const float4*)(mu + m * D + d);
                uint2 w; w.x = pk2(h[0] + xx[0] * u.x, h[1] + xx[1] * u.y); w.y = pk2(h[2] + xx[2] * u.z, h[3] + xx[3] * u.w);
                *(uint2*)(XS + ((size_t)m * NROW + row) * D + d) = w; }
        }
    }
#undef XS_LOAD
}

__device__ __forceinline__ int scan_row(int i, int b, int z) {
    return i < TC ? NLAT + b * TC + (z ? TC - 1 - i : i) : b * TL + (z ? TL - 1 - (i - TC) : i - TC);
}
__device__ __forceinline__ float dpp_sum8(float x) {
    x += __builtin_bit_cast(float, __builtin_amdgcn_update_dpp(0, __builtin_bit_cast(int, x), 0xB1, 0xF, 0xF, true));
    x += __builtin_bit_cast(float, __builtin_amdgcn_update_dpp(0, __builtin_bit_cast(int, x), 0x4E, 0xF, 0xF, true));
    x += __builtin_bit_cast(float, __builtin_amdgcn_update_dpp(0, __builtin_bit_cast(int, x), 0x141, 0xF, 0xF, true));
    return x;
}
__device__ void ph_rw_scan(const Params& p, int j, char* lds) {
    const int tid = tidx(), wid = __builtin_amdgcn_readfirstlane(tid >> 6), lane = tid & 63;
    const size_t PL = (size_t)NROW * D;
    const float* RKV = (const float*)(p.ws + OFF_RKV); float* Y = (float*)(p.ws + OFF_Y);
    constexpr int CH = 32, BUFB = 5 * CH * 256 + CH * 128 + CH * 16, YB = CH * 32 * 4, NCH = (TC + TL) / CH;
    const bool loader = wid >= 4; const int lw = wid - 4;
    for (int it = bidx(); it < 256; it += gdim()) {
        const int vh = it & 1, z = (it >> 1) & 1, h = (it >> 2) & 15, b = it >> 6;
        const char* pl0 = (const char*)((const float*)(p.ws + OFF_W) + z * PL); const char* pl1 = (const char*)(RKV + PL);
        const char* pl2 = (const char*)((const float*)(p.ws + OFF_AV) + z * PL); const char* pl3 = (const char*)RKV;
        const char* vpl = (const char*)(RKV + 2 * PL);
        float* yout = Y + z * PL;
        __builtin_amdgcn_s_barrier();
        if (loader) {
            const int pq = lane & 15;
            const f32x4 kkv = *(const f32x4*)(p.rw_k_k + j * D + h * 64 + pq * 4), kav = *(const f32x4*)(p.rw_k_a + j * D + h * 64 + pq * 4);
            auto issue = [&](int c) {
                char* buf = lds + (c % 3) * BUFB;
#pragma unroll
                for (int q = 0; q < 8; ++q) { const int pi = q >> 1, tg = lw * 2 + (q & 1); const int row = scan_row(c * CH + tg * 4 + (lane >> 4), b, z);
                    const char* base = pi == 0 ? pl0 : pi == 1 ? pl1 : pi == 2 ? pl2 : pl3;
                    __builtin_amdgcn_global_load_lds((const unsigned*)(base + (size_t)row * D * 4 + h * 256 + (lane & 15) * 16), (LAS unsigned*)(buf + pi * (CH * 256) + tg * 1024), 16, 0, 0); }
                { const int row = scan_row(c * CH + lw * 8 + (lane >> 3), b, z);
                  __builtin_amdgcn_global_load_lds((const unsigned*)(vpl + (size_t)row * D * 4 + (h * 64 + vh * 32) * 4 + (lane & 7) * 16), (LAS unsigned*)(buf + 5 * CH * 256 + lw * 1024), 16, 0, 0); }
            };
            auto prep = [&](int c) {
                char* buf = lds + (c % 3) * BUFB;
#pragma unroll
                for (int ps = 0; ps < 2; ++ps) { const int ptok = lw * 8 + ps * 4 + (lane >> 4);
                    f32x4* kp = (f32x4*)(buf + 1 * CH * 256 + ptok * 256 + pq * 16); f32x4* ap = (f32x4*)(buf + 2 * CH * 256 + ptok * 256 + pq * 16); f32x4* dp = (f32x4*)(buf + 4 * CH * 256 + ptok * 256 + pq * 16);
                    f32x4* rp = (f32x4*)(buf + 3 * CH * 256 + ptok * 256 + pq * 16); const f32x4 wv = *(const f32x4*)(buf + ptok * 256 + pq * 16);
                    const f32x4 k = *kp, a = *ap, r = *rp; f32x4 kk = k * kkv;
                    float ss = kk[0] * kk[0] + kk[1] * kk[1] + kk[2] * kk[2] + kk[3] * kk[3]; ss = dpp_sum16(ss);
                    const float inv = 1.f / fmaxf(sqrtf(ss), 1e-12f); kk = kk * inv;
                    const f32x4 kd = k * (1.f + (a - 1.f) * kav), bb = kk * a;
                    const f32x4 t1 = bb * r, t2 = kd * r;
                    const float br = dpp_sum16((t1[0] + t1[1]) + (t1[2] + t1[3])), kr = dpp_sum16((t2[0] + t2[1]) + (t2[2] + t2[3]));
                    *dp = kd; *ap = bb; *kp = kk; *rp = wv * r;
                    if (pq == 0) *(float2*)(buf + 5 * CH * 256 + CH * 128 + ptok * 16) = make_float2(br, kr); }
            };
            issue(0); issue(1);
            asm volatile("s_waitcnt vmcnt(9)" ::: "memory");
            prep(0);
            asm volatile("s_waitcnt lgkmcnt(0)" ::: "memory"); __builtin_amdgcn_s_barrier();
            for (int c = 0; c < NCH; ++c) {
                if (c >= 1) { const float* yb = (const float*)(lds + 3 * BUFB + ((c - 1) & 1) * YB);
                    const int lt = tid - 256, t = lt >> 3, q = lt & 7; const int row = scan_row((c - 1) * CH + t, b, z);
                    *(f32x4*)(yout + (size_t)row * D + h * 64 + vh * 32 + q * 4) = *(const f32x4*)(yb + t * 32 + q * 4); }
                if (c + 2 < NCH) { issue(c + 2); asm volatile("s_waitcnt vmcnt(9)" ::: "memory"); } else asm volatile("s_waitcnt vmcnt(0)" ::: "memory");
                if (c + 1 < NCH) prep(c + 1);
                asm volatile("s_waitcnt lgkmcnt(0)" ::: "memory"); __builtin_amdgcn_s_barrier();
            }
            { const float* yb = (const float*)(lds + 3 * BUFB + ((NCH - 1) & 1) * YB);
              const int lt = tid - 256, t = lt >> 3, q = lt & 7; const int row = scan_row((NCH - 1) * CH + t, b, z);
              *(f32x4*)(yout + (size_t)row * D + h * 64 + vh * 32 + q * 4) = *(const f32x4*)(yb + t * 32 + q * 4); }
        } else {
            const int vr = lane >> 3, ks = lane & 7;
            f32x4 Sa = {0.f, 0.f, 0.f, 0.f}, Sb = {0.f, 0.f, 0.f, 0.f};
            __builtin_amdgcn_s_barrier();
            struct Ops { f32x4 w0, w1, kk0, kk1, bb0, bb1, r0, r1, kd0, kd1; float v; float2 sc; };
#define SC_LOAD(O, t) do { const char* q_ = bq + (t) * 256; O.w0 = *(const f32x4*)(q_); O.w1 = *(const f32x4*)(q_ + 16); O.kk0 = *(const f32x4*)(q_ + CH * 256); O.kk1 = *(const f32x4*)(q_ + CH * 256 + 16); \
                O.bb0 = *(const f32x4*)(q_ + 2 * CH * 256); O.bb1 = *(const f32x4*)(q_ + 2 * CH * 256 + 16); O.r0 = *(const f32x4*)(q_ + 3 * CH * 256); O.r1 = *(const f32x4*)(q_ + 3 * CH * 256 + 16); \
                O.kd0 = *(const f32x4*)(q_ + 4 * CH * 256); O.kd1 = *(const f32x4*)(q_ + 4 * CH * 256 + 16); O.v = *(const float*)(vq + (t) * 128); O.sc = *(const float2*)(buf + 5 * CH * 256 + CH * 128 + (t) * 16); } while (0)
#define SC_STEP(O, t) do { const f32x4 d1 = Sa * O.kk0 + Sb * O.kk1, d2 = Sa * O.r0 + Sb * O.r1; \
                float sa = -((d1[0] + d1[1]) + (d1[2] + d1[3])), yy = (d2[0] + d2[1]) + (d2[2] + d2[3]); \
                sa = dpp_sum8(sa); yy = dpp_sum8(yy); \
                Sa = Sa * O.w0 + (sa * O.bb0 + O.v * O.kd0); Sb = Sb * O.w1 + (sa * O.bb1 + O.v * O.kd1); \
                if (ks == 0) yb[(t) * 32 + wid * 8 + vr] = yy + sa * O.sc.x + O.v * O.sc.y; } while (0)
            for (int c = 0; c < NCH; ++c) {
                const char* buf = lds + (c % 3) * BUFB; float* yb = (float*)(lds + 3 * BUFB + (c & 1) * YB);
                const char* bq = buf + ks * 32; const char* vq = buf + 5 * CH * 256 + (wid * 8 + vr) * 4;
                Ops oA, oB, oC;
                SC_LOAD(oA, 0); SC_LOAD(oB, 1);
#pragma unroll
                for (int t = 0; t < CH; t += 3) {
                    if (t + 2 < CH) SC_LOAD(oC, t + 2);
                    SC_STEP(oA, t);
                    if (t + 3 < CH) SC_LOAD(oA, t + 3);
                    if (t + 1 < CH) SC_STEP(oB, t + 1);
                    if (t + 4 < CH) SC_LOAD(oB, t + 4);
                    if (t + 2 < CH) SC_STEP(oC, t + 2);
                }
                asm volatile("s_waitcnt lgkmcnt(0)" ::: "memory"); __builtin_amdgcn_s_barrier();
            }
#undef SC_LOAD
#undef SC_STEP
        }
    }
}


namespace ck {
constexpr int P = 72, MB = 64 * P * 2;
typedef __attribute__((address_space(3))) char lchar;
__device__ __forceinline__ f32x4 mm_tile(const lchar* Aop, const lchar* Bop, int ti, int tj, int c, int q, f32x4 acc) {
#pragma unroll
    for (int ks = 0; ks < 2; ++ks) {
        const bf16x8 a = *(const LAS bf16x8*)(Aop + ((16 * ti + c) * P + 32 * ks + 8 * q) * 2);
        const bf16x8 b = *(const LAS bf16x8*)(Bop + ((16 * tj + c) * P + 32 * ks + 8 * q) * 2);
        acc = __builtin_amdgcn_mfma_f32_16x16x32_bf16(a, b, acc, 0, 0, 0);
    }
    return acc;
}
__device__ __forceinline__ f32x4 mm_diag(const lchar* Aop, const lchar* Bop, int tt, int c, int q, f32x4 acc) {
    const int ks = tt >> 1;
    bf16x8 a = *(const LAS bf16x8*)(Aop + ((16 * tt + c) * P + 32 * ks + 8 * q) * 2);
    const bf16x8 b = *(const LAS bf16x8*)(Bop + ((16 * tt + c) * P + 32 * ks + 8 * q) * 2);
    if ((q >> 1) != (tt & 1)) a = (bf16x8){0, 0, 0, 0, 0, 0, 0, 0};
    return __builtin_amdgcn_mfma_f32_16x16x32_bf16(a, b, acc, 0, 0, 0);
}
__device__ __forceinline__ void st_tile(lchar* dst, int ti, int tj, int c, int q, f32x4 v) {
    u32x2 w; w.x = pk2(v[0], v[1]); w.y = pk2(v[2], v[3]); *(LAS u32x2*)(dst + ((16 * tj + c) * P + 16 * ti + 4 * q) * 2) = w;
}
__device__ __forceinline__ f32x4 ld_tile(const lchar* src, int ti, int tj, int c, int q) {
    const u32x2 w = *(const LAS u32x2*)(src + ((16 * tj + c) * P + 16 * ti + 4 * q) * 2);
    return (f32x4){__uint_as_float(w.x << 16), __uint_as_float(w.x & 0xffff0000u), __uint_as_float(w.y << 16), __uint_as_float(w.y & 0xffff0000u)};
}
__device__ __forceinline__ void st_glob(bf16_t* dst, int ti, int tj, int c, int q, f32x4 v) {
    uint2 w; w.x = pk2(v[0], v[1]); w.y = pk2(v[2], v[3]); *(uint2*)(dst + (16 * tj + c) * 64 + 16 * ti + 4 * q) = w;
}
typedef float f32x16 __attribute__((ext_vector_type(16)));
__device__ __forceinline__ f32x16 mm32(const lchar* Aop, const lchar* Bop, int ti, int tj, int r32, int hi, f32x16 acc) {
#pragma unroll
    for (int ks = 0; ks < 4; ++ks) {
        const bf16x8 a = *(const LAS bf16x8*)(Aop + ((32 * ti + r32) * P + 16 * ks + 8 * hi) * 2);
        const bf16x8 b = *(const LAS bf16x8*)(Bop + ((32 * tj + r32) * P + 16 * ks + 8 * hi) * 2);
        acc = __builtin_amdgcn_mfma_f32_32x32x16_bf16(a, b, acc, 0, 0, 0);
    }
    return acc;
}
__device__ __forceinline__ void st32(lchar* dst, int ti, int tj, int r32, int hi, const f32x16& v) {
#pragma unroll
    for (int g = 0; g < 4; ++g) { u32x2 w; w.x = pk2(v[4 * g], v[4 * g + 1]); w.y = pk2(v[4 * g + 2], v[4 * g + 3]); *(LAS u32x2*)(dst + ((32 * tj + r32) * P + 32 * ti + 8 * g + 4 * hi) * 2) = w; }
}
__device__ __forceinline__ f32x16 ld32(const lchar* src, int ti, int tj, int r32, int hi) {
    f32x16 v;
#pragma unroll
    for (int g = 0; g < 4; ++g) { const u32x2 w = *(const LAS u32x2*)(src + ((32 * tj + r32) * P + 32 * ti + 8 * g + 4 * hi) * 2);
        v[4 * g] = __uint_as_float(w.x << 16); v[4 * g + 1] = __uint_as_float(w.x & 0xffff0000u); v[4 * g + 2] = __uint_as_float(w.y << 16); v[4 * g + 3] = __uint_as_float(w.y & 0xffff0000u); }
    return v;
}
__device__ __forceinline__ void stg32(bf16_t* dst, int ti, int tj, int r32, int hi, const f32x16& v) {
#pragma unroll
    for (int g = 0; g < 4; ++g) { uint2 w; w.x = pk2(v[4 * g], v[4 * g + 1]); w.y = pk2(v[4 * g + 2], v[4 * g + 3]); *(uint2*)(dst + (32 * tj + r32) * 64 + 32 * ti + 8 * g + 4 * hi) = w; }
}
}

#define LBAR() do { asm volatile("s_waitcnt lgkmcnt(0)" ::: "memory"); __builtin_amdgcn_s_barrier(); asm volatile("" ::: "memory"); } while (0)
__device__ void ph_rw_sc1(const Params& p, int j, char* lds) {
    using namespace ck;
    const int tid = tidx(), wid = __builtin_amdgcn_readfirstlane(tid >> 6), lane = tid & 63, c = lane & 15, q = lane >> 4;
    const size_t PL = (size_t)NROW * D;
    const bf16_t* RKV = (const bf16_t*)(p.ws + OFF_RKV); const float* LW = (const float*)(p.ws + OFF_W); const bf16_t* AV = (const bf16_t*)(p.ws + OFF_AV);
    bf16_t* CK = (bf16_t*)(p.ws + OFF_CK);
    lchar* B0 = (lchar*)lds;
#define BUF(i) (B0 + (i) * MB)
    LAS float* Lbuf = (LAS float*)BUF(8);
    LAS float* Lseg = (LAS float*)(B0 + 16 * MB);
    LAS float* GC = Lseg + 8 * 64;
    const int pt = tid >> 3, cg = tid & 7;
    f32x4 nlw[2], nkk[2], nka[2]; u32x4 nkx, nax, nrx, nvx;
#define SC1_LOAD(IT) do { const int seq_ = (IT) / NCHK, ch_ = (IT) % NCHK; const int z_ = seq_ & 1, h_ = (seq_ >> 1) & 15, b_ = seq_ >> 5; \
        const size_t go_ = (size_t)scan_row(ch_ * 64 + pt, b_, z_) * D + h_ * 64 + cg * 8; \
        _Pragma("unroll") for (int e = 0; e < 2; ++e) nlw[e] = *(const f32x4*)(LW + z_ * PL + go_ + 4 * e); \
        nkx = *(const u32x4*)(RKV + PL + go_); nax = *(const u32x4*)(AV + z_ * PL + go_); nrx = *(const u32x4*)(RKV + go_); nvx = *(const u32x4*)(RKV + 2 * PL + go_); \
        _Pragma("unroll") for (int e = 0; e < 2; ++e) { nkk[e] = *(const f32x4*)(p.rw_k_k + j * D + h_ * 64 + cg * 8 + 4 * e); nka[e] = *(const f32x4*)(p.rw_k_a + j * D + h_ * 64 + cg * 8 + 4 * e); } } while (0)
    if (bidx() < 128 * NCHK) SC1_LOAD(bidx());
    for (int it = bidx(); it < 128 * NCHK; it += gdim()) {
        const int seq = it / NCHK; const int h = (seq >> 1) & 15;
        f32x4 lw[2], kx[2], ax[2], rx[2], vx[2], kkc[2], kac[2];
#pragma unroll
        for (int e = 0; e < 2; ++e) { lw[e] = nlw[e]; kkc[e] = nkk[e]; kac[e] = nka[e];
            kx[e] = (f32x4){__uint_as_float(nkx[2 * e] << 16), __uint_as_float(nkx[2 * e] & 0xffff0000u), __uint_as_float(nkx[2 * e + 1] << 16), __uint_as_float(nkx[2 * e + 1] & 0xffff0000u)};
            ax[e] = (f32x4){__uint_as_float(nax[2 * e] << 16), __uint_as_float(nax[2 * e] & 0xffff0000u), __uint_as_float(nax[2 * e + 1] << 16), __uint_as_float(nax[2 * e + 1] & 0xffff0000u)};
            rx[e] = (f32x4){__uint_as_float(nrx[2 * e] << 16), __uint_as_float(nrx[2 * e] & 0xffff0000u), __uint_as_float(nrx[2 * e + 1] << 16), __uint_as_float(nrx[2 * e + 1] & 0xffff0000u)};
            vx[e] = (f32x4){__uint_as_float(nvx[2 * e] << 16), __uint_as_float(nvx[2 * e] & 0xffff0000u), __uint_as_float(nvx[2 * e + 1] << 16), __uint_as_float(nvx[2 * e + 1] & 0xffff0000u)}; }
        if (it + gdim() < 128 * NCHK) SC1_LOAD(it + gdim());
        LBAR();
#pragma unroll
        for (int e = 0; e < 2; ++e) *(LAS f32x4*)(Lbuf + pt * 64 + cg * 8 + 4 * e) = lw[e];
        f32x4 kk[2], bq[2], kd[2];
        { float ss = 0.f;
#pragma unroll
          for (int e = 0; e < 2; ++e) { kk[e] = kx[e] * kkc[e]; ss += kk[e][0] * kk[e][0] + kk[e][1] * kk[e][1] + kk[e][2] * kk[e][2] + kk[e][3] * kk[e][3]; }
          ss = dpp_sum8(ss); const float inv = __builtin_amdgcn_rsqf(fmaxf(ss, 1e-24f));
#pragma unroll
          for (int e = 0; e < 2; ++e) { kk[e] = kk[e] * inv; bq[e] = kk[e] * ax[e]; kd[e] = kx[e] * (1.f + (ax[e] - 1.f) * kac[e]); } }
        LBAR();
        { const int k = tid & 63, sg = tid >> 6; float run = 0.f;
#pragma unroll
          for (int u = 0; u < 8; ++u) { run += Lbuf[(sg * 8 + u) * 64 + k]; Lbuf[(sg * 8 + u) * 64 + k] = run; }
          Lseg[sg * 64 + k] = run; }
        LBAR();
        f32x4 Lt[2], Lp[2], Lc[2];
        { const int sg = pt >> 3, sgp = (pt - 1) >> 3;
#pragma unroll
          for (int e = 0; e < 2; ++e) { f32x4 o0 = {0.f, 0.f, 0.f, 0.f}, o1 = o0, oc = o0;
#pragma unroll
              for (int u = 0; u < 8; ++u) { const f32x4 sv = *(const LAS f32x4*)(Lseg + u * 64 + cg * 8 + 4 * e); if (u < sg) o0 = o0 + sv; if (u < sgp) o1 = o1 + sv; if (u < 7) oc = oc + sv; }
              Lt[e] = *(const LAS f32x4*)(Lbuf + pt * 64 + cg * 8 + 4 * e) + o0;
              Lp[e] = pt > 0 ? *(const LAS f32x4*)(Lbuf + (pt - 1) * 64 + cg * 8 + 4 * e) + o1 : (f32x4){0.f, 0.f, 0.f, 0.f};
              Lc[e] = *(const LAS f32x4*)(Lbuf + 63 * 64 + cg * 8 + 4 * e) + oc; } }
        LBAR();
        {
            float at[8], bt[8], kt[8], rt[8], bh[8], kh[8], vv[8];
#pragma unroll
            for (int e = 0; e < 2; ++e)
#pragma unroll
                for (int u = 0; u < 4; ++u) { const int x = 4 * e + u; const float eL = __expf(Lt[e][u]), emL = __expf(-Lt[e][u]), eP = __expf(Lp[e][u]), eC = __expf(Lc[e][u] - Lt[e][u]);
                    at[x] = -kk[e][u] * eP; bt[x] = bq[e][u] * emL; kt[x] = kd[e][u] * emL; rt[x] = rx[e][u] * eL; bh[x] = bq[e][u] * eC; kh[x] = kd[e][u] * eC; vv[x] = vx[e][u];
                    if (pt == 63) GC[cg * 8 + x] = eL; }
#define ST8(bufi, arr) do { u32x4 w_ = {pk2(arr[0], arr[1]), pk2(arr[2], arr[3]), pk2(arr[4], arr[5]), pk2(arr[6], arr[7])}; *(LAS u32x4*)(BUF(bufi) + (pt * P + cg * 8) * 2) = w_; } while (0)
            ST8(0, at); ST8(1, bt); ST8(2, kt); ST8(3, rt); ST8(8, bh); ST8(9, kh); ST8(10, vv);
#undef ST8
        }
        LBAR();
        {
            const int k = tid & 63, tg = tid >> 6;
#define TR8(src, dst) do { unsigned w_[4]; _Pragma("unroll") for (int x = 0; x < 4; ++x) { const unsigned lo = *(const LAS bf16_t*)(BUF(src) + ((tg * 8 + 2 * x) * P + k) * 2), hi2 = *(const LAS bf16_t*)(BUF(src) + ((tg * 8 + 2 * x + 1) * P + k) * 2); w_[x] = lo | (hi2 << 16); } \
                *(LAS u32x4*)(BUF(dst) + (k * P + tg * 8) * 2) = (u32x4){w_[0], w_[1], w_[2], w_[3]}; } while (0)
            TR8(0, 4); TR8(8, 5); TR8(9, 6); TR8(10, 7);
#undef TR8
        }
        LBAR();
        const f32x4 Z4 = {0.f, 0.f, 0.f, 0.f};
        const f32x16 Z16 = {0.f, 0.f, 0.f, 0.f, 0.f, 0.f, 0.f, 0.f, 0.f, 0.f, 0.f, 0.f, 0.f, 0.f, 0.f, 0.f};
        const int r32 = lane & 31, hi = lane >> 5;
#pragma unroll 1
        for (int u = 0; u < 2; ++u) { const int tl = u * 8 + wid;
            if (tl >= 14) {
                if (tl == 14) { st32(BUF(8), 0, 1, r32, hi, Z16); st32(BUF(8), 1, 0, r32, hi, Z16); st32(BUF(14), 0, 1, r32, hi, Z16); st32(BUF(14), 1, 0, r32, hi, Z16); st32(BUF(9), 1, 0, r32, hi, Z16); }
                else { st32(BUF(15), 1, 0, r32, hi, Z16); st32(BUF(13), 1, 0, r32, hi, Z16); st32(BUF(10), 1, 0, r32, hi, Z16); st32(BUF(11), 1, 0, r32, hi, Z16); st32(BUF(12), 1, 0, r32, hi, Z16); }
                break; }
            const int m = (tl + 1) / 3, rr = (tl + 1) % 3, ti = rr == 2, tj = m == 0 ? ti : (rr >= 1); const int jj = 32 * tj + r32;
            if (m == 0) { f32x16 v = mm32(BUF(0), BUF(1), ti, tj, r32, hi, Z16), w;
#pragma unroll
                for (int e = 0; e < 16; ++e) { const int ii = 32 * ti + 8 * (e >> 2) + 4 * hi + (e & 3); const bool dg = (ii >> 4) == (jj >> 4);
                    v[e] = (dg && jj < ii) ? v[e] : 0.f; w[e] = v[e] + ((ii == jj) ? 1.f : 0.f); }
                st32(BUF(8), ti, tj, r32, hi, v); st32(BUF(14), ti, tj, r32, hi, w); }
            else if (m == 1) { const f32x16 v = mm32(BUF(1), BUF(0), ti, tj, r32, hi, Z16); f32x16 vd, vo, w;
#pragma unroll
                for (int e = 0; e < 16; ++e) { const int ii = 32 * ti + 8 * (e >> 2) + 4 * hi + (e & 3); const bool dg = (ii >> 4) == (jj >> 4), up = ii < jj;
                    vd[e] = (dg && up) ? v[e] : 0.f; vo[e] = (!dg && up) ? v[e] : 0.f; w[e] = vd[e] + ((ii == jj) ? 1.f : 0.f); }
                st32(BUF(9), ti, tj, r32, hi, vd); st32(BUF(15), ti, tj, r32, hi, vo); st32(BUF(13), ti, tj, r32, hi, w); }
            else if (m == 2) { f32x16 v = mm32(BUF(2), BUF(0), ti, tj, r32, hi, Z16);
#pragma unroll
                for (int e = 0; e < 16; ++e) { const int ii = 32 * ti + 8 * (e >> 2) + 4 * hi + (e & 3); v[e] = ii < jj ? v[e] : 0.f; }
                st32(BUF(10), ti, tj, r32, hi, v); }
            else { f32x16 v = mm32(m == 3 ? BUF(1) : BUF(2), BUF(3), ti, tj, r32, hi, Z16);
#pragma unroll
                for (int e = 0; e < 16; ++e) { const int ii = 32 * ti + 8 * (e >> 2) + 4 * hi + (e & 3); v[e] = ii <= jj ? v[e] : 0.f; }
                st32(m == 3 ? BUF(11) : BUF(12), ti, tj, r32, hi, v); } }
        LBAR();
#define WSYNC() asm volatile("s_waitcnt lgkmcnt(0)" ::: "memory")
        if (wid < 4) {
            const int tt = wid;
#define SQD(sr, st, dr, dt) do { const f32x4 a_ = mm_diag(BUF(st), BUF(sr), tt, c, q, Z4), b_ = mm_diag(BUF(sr), BUF(st), tt, c, q, Z4); WSYNC(); \
                st_tile(BUF(dr), tt, tt, c, q, a_); st_tile(BUF(dt), tt, tt, c, q, b_); WSYNC(); } while (0)
#define UPD(pr) do { const f32x4 dt_ = mm_diag(BUF(pr), BUF(13), tt, c, q, ld_tile(BUF(13), tt, tt, c, q)); \
                const f32x4 dr_ = mm_diag(BUF(13), BUF(pr), tt, c, q, ld_tile(BUF(14), tt, tt, c, q)); WSYNC(); \
                st_tile(BUF(13), tt, tt, c, q, dt_); st_tile(BUF(14), tt, tt, c, q, dr_); WSYNC(); } while (0)
            SQD(8, 9, 0, 1); UPD(0); SQD(0, 1, 8, 9); UPD(8); SQD(8, 9, 0, 1); UPD(0);
#undef SQD
#undef UPD
        } else {
            const int ti = (wid >> 1) & 1, tj = wid & 1; st32(BUF(2), ti, tj, r32, hi, mm32(BUF(10), BUF(7), ti, tj, r32, hi, Z16));
        }
        LBAR();
        { const int m = wid >> 2, ti = (wid >> 1) & 1, tj = wid & 1;
          if (m == 0) st32(BUF(8), ti, tj, r32, hi, mm32(BUF(15), BUF(14), ti, tj, r32, hi, Z16));
          else        st32(BUF(9), ti, tj, r32, hi, mm32(BUF(14), BUF(15), ti, tj, r32, hi, Z16)); }
        LBAR();
        if (wid < 4) { const int ti = (wid >> 1) & 1, tj = wid & 1; st32(BUF(0), ti, tj, r32, hi, mm32(BUF(9), BUF(8), ti, tj, r32, hi, Z16)); }
        LBAR();
        if (wid < 4) { const int ti = (wid >> 1) & 1, tj = wid & 1; st32(BUF(1), ti, tj, r32, hi, mm32(BUF(0), BUF(13), ti, tj, r32, hi, ld32(BUF(13), ti, tj, r32, hi))); }
        LBAR();
        if (wid < 4) { const int ti = (wid >> 1) & 1, tj = wid & 1; st32(BUF(14), ti, tj, r32, hi, mm32(BUF(8), BUF(1), ti, tj, r32, hi, ld32(BUF(1), ti, tj, r32, hi))); }
        LBAR();
        { const int m = wid >> 2, ti = (wid >> 1) & 1, tj = wid & 1;
          if (m == 0) st32(BUF(8), ti, tj, r32, hi, mm32(BUF(14), BUF(4), ti, tj, r32, hi, Z16));
          else        st32(BUF(0), ti, tj, r32, hi, mm32(BUF(14), BUF(2), ti, tj, r32, hi, Z16)); }
        LBAR();
        bf16_t* ckp = CK + (size_t)it * 4 * 4096;
#pragma unroll 1
        for (int u = 0; u < 2; ++u) { const int tl = u * 8 + wid, m = tl >> 2, ti = (tl >> 1) & 1, tj = tl & 1;
            if (m == 0) { f32x16 v = mm32(BUF(8), BUF(5), ti, tj, r32, hi, Z16); const int jj = 32 * tj + r32; const float gc = GC[jj];
#pragma unroll
                for (int e = 0; e < 16; ++e) { const int ii = 32 * ti + 8 * (e >> 2) + 4 * hi + (e & 3); v[e] += (ii == jj) ? gc : 0.f; }
                st32(BUF(1), ti, tj, r32, hi, v); }
            else if (m == 1) st32(BUF(4), ti, tj, r32, hi, mm32(BUF(8), BUF(11), ti, tj, r32, hi, ld32(BUF(3), ti, tj, r32, hi)));
            else if (m == 2) st32(BUF(2), ti, tj, r32, hi, mm32(BUF(6), BUF(7), ti, tj, r32, hi, mm32(BUF(5), BUF(0), ti, tj, r32, hi, Z16)));
            else             st32(BUF(9), ti, tj, r32, hi, mm32(BUF(7), BUF(12), ti, tj, r32, hi, mm32(BUF(0), BUF(11), ti, tj, r32, hi, Z16))); }
        LBAR();
        { const int orow = tid >> 3, oc = (tid & 7) * 8;
          *(u32x4*)(ckp + orow * 64 + oc) = *(const LAS u32x4*)(BUF(1) + (orow * P + oc) * 2);
          *(u32x4*)(ckp + 4096 + orow * 64 + oc) = *(const LAS u32x4*)(BUF(2) + (orow * P + oc) * 2);
          *(u32x4*)(ckp + 2 * 4096 + orow * 64 + oc) = *(const LAS u32x4*)(BUF(4) + (orow * P + oc) * 2);
          *(u32x4*)(ckp + 3 * 4096 + orow * 64 + oc) = *(const LAS u32x4*)(BUF(9) + (orow * P + oc) * 2); }
    }
#undef BUF
#undef SC1_LOAD
}

__device__ void ph_rw_sc2(const Params& p, char* lds) {
    using namespace ck;
    const int tid = tidx(), wid = __builtin_amdgcn_readfirstlane(tid >> 6), lane = tid & 63, c = lane & 15, q = lane >> 4;
    const size_t PL = (size_t)NROW * D;
    const bf16_t* CK = (const bf16_t*)(p.ws + OFF_CK); bf16_t* Y = (bf16_t*)(p.ws + OFF_Y);
    lchar* GB = (lchar*)lds;
    lchar* RB = GB + 2 * MB;
    lchar* SB = GB + 4 * MB;
    constexpr int SBB = 32 * P * 2;
    for (int it = bidx(); it < 256; it += gdim()) {
        const int vh = it & 1, seq = it >> 1, z = seq & 1, h = (seq >> 1) & 15, b = seq >> 5;
        const bf16_t* ck0 = CK + (size_t)seq * NCHK * 4 * 4096;
        const int s_ti = wid & 3, s_tj = wid >> 2;
        const int y_ti = wid & 1, y_tj = wid >> 1;
        const int hoff = 4096 + (vh * 32 + 16 * s_tj + c) * 64 + 16 * s_ti + 4 * q, yoff = 3 * 4096 + (16 * y_tj + c) * 64 + vh * 32 + 16 * y_ti + 4 * q;
        struct PF { u32x4 g, r; uint2 h, y; };
#define PF_LOAD(X, k) do { const bf16_t* cc_ = ck0 + (size_t)(k) * 4 * 4096; X.h = *(const uint2*)(cc_ + hoff); X.y = *(const uint2*)(cc_ + yoff); X.g = *(const u32x4*)(cc_ + tid * 8); X.r = *(const u32x4*)(cc_ + 2 * 4096 + tid * 8); } while (0)
#define PF_STAGE(X, bufi) do { *(LAS u32x4*)(GB + (bufi) * MB + ((tid >> 3) * P + (tid & 7) * 8) * 2) = X.g; *(LAS u32x4*)(RB + (bufi) * MB + ((tid >> 3) * P + (tid & 7) * 8) * 2) = X.r; } while (0)
#define SC2_STEP(k, CUR, NXT) do { const uint2 hi_ = CUR.h, yi_ = CUR.y; const int cur = (k) & 1; \
            if ((k) + 4 < NCHK) PF_LOAD(CUR, (k) + 4); \
            const f32x4 hinit = {__uint_as_float(hi_.x << 16), __uint_as_float(hi_.x & 0xffff0000u), __uint_as_float(hi_.y << 16), __uint_as_float(hi_.y & 0xffff0000u)}; \
            const f32x4 yinit = {__uint_as_float(yi_.x << 16), __uint_as_float(yi_.x & 0xffff0000u), __uint_as_float(yi_.y << 16), __uint_as_float(yi_.y & 0xffff0000u)}; \
            const lchar* Sold = SB + cur * SBB; lchar* Snew = SB + (cur ^ 1) * SBB; \
            const f32x4 sn = mm_tile(GB + cur * MB, Sold, s_ti, s_tj, c, q, hinit);        \
            const f32x4 yv = mm_tile(Sold, RB + cur * MB, y_ti, y_tj, c, q, yinit);        \
            st_tile(Snew, s_ti, s_tj, c, q, sn); \
            { const int row = scan_row((k) * 64 + 16 * y_tj + c, b, z); stbf4(Y + z * PL + (size_t)row * D + h * 64 + vh * 32 + 16 * y_ti + 4 * q, yv); } \
            if ((k) + 1 < NCHK) PF_STAGE(NXT, cur ^ 1); \
            LBAR(); } while (0)
        PF s0, s1, s2, s3;
        PF_LOAD(s0, 0); PF_LOAD(s1, 1); PF_LOAD(s2, 2); PF_LOAD(s3, 3);
        LBAR();
        for (int i = tid; i < SBB / 4; i += NTHR) ((LAS unsigned*)SB)[i] = 0u;
        PF_STAGE(s0, 0);
        LBAR();
        for (int ch = 0; ch < NCHK; ch += 4) {
            SC2_STEP(ch, s0, s1); SC2_STEP(ch + 1, s1, s2); SC2_STEP(ch + 2, s2, s3); SC2_STEP(ch + 3, s3, s0);
        }
#undef PF_LOAD
#undef PF_STAGE
#undef SC2_STEP
    }
}
#undef LBAR

__device__ void ph_rw_out(const Params& p, int j, int nrows) {
    const int wid = tidx() >> 6, lane = tidx() & 63;
    const bf16_t* RKV = (const bf16_t*)(p.ws + OFF_RKV); const bf16_t* AV = (const bf16_t*)(p.ws + OFF_AV); const bf16_t* G = (const bf16_t*)(p.ws + OFF_G); const bf16_t* Y = (const bf16_t*)(p.ws + OFF_Y);
    bf16_t* OUT = (bf16_t*)(p.ws + OFF_H);
    const size_t PL = (size_t)NROW * D;
    const float* r_k = p.rw_r_k + j * D; const float* lg = p.rw_lnx_g + j * D; const float* lb = p.rw_lnx_b + j * D; const float* k_a = p.rw_k_a + j * D;
    uint2 nb[8][4];
#define OUT_LOAD(R) do { _Pragma("unroll") for (int i = 0; i < 4; ++i) { const size_t o_ = (size_t)(R) * D + lane * 4 + i * 256; \
        nb[0][i] = *(const uint2*)(Y + o_); nb[1][i] = *(const uint2*)(Y + PL + o_); nb[2][i] = *(const uint2*)(RKV + o_); nb[3][i] = *(const uint2*)(RKV + PL + o_); \
        nb[4][i] = *(const uint2*)(RKV + 2 * PL + o_); nb[5][i] = *(const uint2*)(AV + o_); nb[6][i] = *(const uint2*)(AV + PL + o_); nb[7][i] = *(const uint2*)(G + o_); } } while (0)
#define UNPK(w) ((f32x4){__uint_as_float((w).x << 16), __uint_as_float((w).x & 0xffff0000u), __uint_as_float((w).y << 16), __uint_as_float((w).y & 0xffff0000u)})
    int row = bidx() * 8 + wid;
    if (row < nrows) OUT_LOAD(row);
    for (; row < nrows; row += gdim() * 8) {
        uint2 cb[8][4];
#pragma unroll
        for (int q_ = 0; q_ < 8; ++q_)
#pragma unroll
            for (int i = 0; i < 4; ++i) cb[q_][i] = nb[q_][i];
        { const int nrow = row + gdim() * 8; if (nrow < nrows) OUT_LOAD(nrow); }
#pragma unroll
        for (int i = 0; i < 4; ++i) {
            const size_t o = (size_t)row * D + lane * 4 + i * 256; const int c = lane * 4 + i * 256;
            const f32x4 y = UNPK(cb[0][i]) + UNPK(cb[1][i]);
            const float mean = dpp_sum16(y[0] + y[1] + y[2] + y[3]) * (1.f / 64.f);
            const f32x4 dd = y - mean;
            const float rstd = rsqrtf(dpp_sum16(dd[0] * dd[0] + dd[1] * dd[1] + dd[2] * dd[2] + dd[3] * dd[3]) * (1.f / 64.f) + LNX_EPS);
            const f32x4 r = UNPK(cb[2][i]), k = UNPK(cb[3][i]), v = UNPK(cb[4][i]);
            const f32x4 a0 = UNPK(cb[5][i]), a1 = UNPK(cb[6][i]);
            const f32x4 kds = k * (2.f + (a0 + a1 - 2.f) * *(const f32x4*)(k_a + c));
            const f32x4 t4 = r * kds * *(const f32x4*)(r_k + c);
            const float bs = dpp_sum16(t4[0] + t4[1] + t4[2] + t4[3]);
            const f32x4 res = (dd * rstd * *(const f32x4*)(lg + c) + *(const f32x4*)(lb + c) + bs * v) * UNPK(cb[7][i]);
            uint2 w; w.x = pk2(res[0], res[1]); w.y = pk2(res[2], res[3]); *(uint2*)(OUT + o) = w;
        }
    }
#undef OUT_LOAD
#undef UNPK
}

__device__ void ph_final(const Params& p) {
    const int wid = tidx() >> 6, lane = tidx() & 63;
    const float* X = (const float*)(p.ws + OFF_X);
    for (int row = bidx() * 8 + wid; row < NLAT; row += gdim() * 8) {
        const float4* xr = (const float4*)(X + (size_t)row * D);
        float4 v[4]; float ss = 0;
#pragma unroll
        for (int i = 0; i < 4; ++i) { v[i] = xr[lane + i * 64]; ss += v[i].x * v[i].x + v[i].y * v[i].y + v[i].z * v[i].z + v[i].w * v[i].w; }
        ss = wave_sum(ss); const float rs = rsqrtf(ss * (1.f / D) + RMS_EPS);
#pragma unroll
        for (int i = 0; i < 4; ++i) { const int d = (lane + i * 64) * 4; const float4 gg = *(const float4*)(p.final_g + d);
            float4 o; o.x = v[i].x * rs * gg.x; o.y = v[i].y * rs * gg.y; o.z = v[i].z * rs * gg.z; o.w = v[i].w * rs * gg.w;
            *(float4*)(p.out + (size_t)row * D + d) = o; }
    }
}

enum { PH_INIT = 0, PH_A_NORM, PH_A_Z, PH_A_MID, PH_A_QKV, PH_A_POST, PH_A_ATTN, PH_A_WO,
       PH_R_NORM, PH_R_XS, PH_R_G1, PH_R_G2, PH_R_PREP, PH_R_SCAN, PH_R_OUT, PH_R_WO,
       PH_M_NORM, PH_M_SEL, PH_M_GATHER, PH_M_G1, PH_M_G2, PH_M_COMB, PH_FINAL, PH_M_CVT, PH_R_SC1, PH_R_SC2 };

#ifndef BG_Z
#define BG_Z 4
#define BG_ATTN 2
#define BG_WO 3
#define BG_RG1 6
#define BG_MG1 4
#define BG_MG2 6
#endif
template <int PH>
__device__ __forceinline__ void run_phase(const Params& p, int layer, char* lds) {
    const int j = layer >> 1;
    char* ws = p.ws;
    if constexpr (PH == PH_INIT) { ph_init(p, lds); __syncthreads(); ph_small_cvt(p, lds); }
    else if constexpr (PH == PH_A_NORM) { if (layer == 0) ph_norm_mod<false>(p, layer, p.norm1_g + layer * D, 0, 1, ws + OFF_H); else ph_comb_norm<false>(p, layer - 1, layer, NROW); }
    else if constexpr (PH == PH_A_Z) {
        float* Z = (float*)(ws + OFF_Z);
        g8::BatchSched S{ws + OFF_H, ws + OFF_WMLA + j * SZ_WMLA + WM_IN, 0, 0, NROW / 256, 2, 1, D};
        g8::gemm_phase(p.wv, (PG8_LAS unsigned char*)lds, D, S, g8::epi_rc([=](const g8::Unit&, int row, int col, f32x4 v) { *(f32x4*)(Z + (size_t)row * 512 + col) = v; }));
        if (idle_tail(NROW / 256 * 2)) bg_cvt(p, layer, lds, BG_Z);
    }
    else if constexpr (PH == PH_A_MID) ph_mla_mid(p, j);
    else if constexpr (PH == PH_A_QKV) {
        bf16_t* Q = (bf16_t*)(ws + OFF_Q); bf16_t* K = (bf16_t*)(ws + OFF_K); bf16_t* V = (bf16_t*)(ws + OFF_V);
        g8::BatchSched S1{ws + OFF_CQN, ws + OFF_WMLA + j * SZ_WMLA + WM_UQ, 0, 0, NROW / 256, 6, 1, 256, 1};
        g8::gemm_phase(p.wv, (PG8_LAS unsigned char*)lds, 256, S1, g8::epi_rc([=](const g8::Unit&, int row, int col, f32x4 v) {
            const bool lat = row < NLAT; const int b = lat ? (row >> 12) : ((row - NLAT) >> 8); const int tk = lat ? 256 + (row & (TL - 1)) : ((row - NLAT) & 255);
            const int h = col / 192, d = col - h * 192;
            uint2 w; w.x = pk2(v[0], v[1]); w.y = pk2(v[2], v[3]);
            *(uint2*)(Q + ((size_t)(b * 8 + h) * TK + tk) * 192 + d) = w; }));
        g8::BatchSched S2{ws + OFF_CKVN, ws + OFF_WMLA + j * SZ_WMLA + WM_UKV, 0, 0, NROW / 256, 8, 1, 128};
        g8::gemm_phase(p.wv, (PG8_LAS unsigned char*)lds, 128, S2, g8::epi_rc([=](const g8::Unit&, int row, int col, f32x4 v) {
            const bool lat = row < NLAT; const int b = lat ? (row >> 12) : ((row - NLAT) >> 8); const int tk = lat ? 256 + (row & (TL - 1)) : ((row - NLAT) & 255);
            const int h = col >> 8, d = col & 255; const size_t orow = (size_t)(b * 8 + h) * TK + tk;
            uint2 w; w.x = pk2(v[0], v[1]); w.y = pk2(v[2], v[3]);
            if (d < 128) *(uint2*)(K + orow * 192 + d) = w; else *(uint2*)(V + orow * 128 + (d - 128)) = w; }));
    }
    else if constexpr (PH == PH_A_ATTN) { ph_attn(p, lds); if (idle_tail(544)) bg_cvt(p, layer, lds, BG_ATTN); }
    else if constexpr (PH == PH_A_WO || PH == PH_R_WO) {
        xt_t* X = (xt_t*)(ws + OFF_X); const float* MOD = (const float*)(ws + OFF_MOD);
        g8::BatchSched S{ws + (PH == PH_A_WO ? OFF_O : OFF_H), PH == PH_A_WO ? ws + OFF_WMLA + j * SZ_WMLA + WM_O : ws + OFF_WRW + j * SZ_WRW + WR_O, 0, 0, (layer < 3 ? NROW : NLAT) / 256, 4, 1, D};
        g8::gemm_phase(p.wv, (PG8_LAS unsigned char*)lds, D, S, g8::EpiResid{X, MOD, layer});
        if (idle_tail((layer < 3 ? NROW : NLAT) / 256 * 4)) bg_cvt(p, layer, lds, BG_WO);
    }
    else if constexpr (PH == PH_R_XS) ph_rw_normxs(p, layer, j);
    else if constexpr (PH == PH_R_G1) {
        bf16_t* RKV = (bf16_t*)(ws + OFF_RKV); bf16_t* VF = (bf16_t*)(ws + OFF_VFIRST);
        bf16_t* A2 = (bf16_t*)(ws + OFF_A2); bf16_t* A3 = (bf16_t*)(ws + OFF_A3);
        const bool first = (j == 0);
        struct RSched { const char* XS; const char* WB; int nwg;
            __device__ __forceinline__ bool next(int i, g8::Unit& u) const {
                const int L = i * gdim() + bidx(); if (L >= nwg) return false;
                const int w = g8::xcd_remap(L, nwg);
                if (w < 816) { u.g = w / 272; const int r = w % 272; u.pm = r >> 2; u.pn = r & 3; u.B = WB + WR_RKV + (size_t)u.g * D * D * 2 + (size_t)u.pn * 256 * D * 2; }
                else { u.g = 3 + (w - 816) / 68; u.pm = (w - 816) % 68; u.pn = 0; u.B = WB + WR_L + (size_t)(u.g - 3) * 256 * D * 2; }
                u.A = XS + (size_t)(u.g == 6 ? 2 : u.g) * NROW * D * 2 + (size_t)u.pm * 256 * D * 2; return true; } };
        RSched S{ws + OFF_XS, ws + OFF_WRW + j * SZ_WRW, first ? 816 + 204 : 816 + 272};
        g8::gemm_phase(p.wv, (PG8_LAS unsigned char*)lds, D, S, g8::epi_rc([=](const g8::Unit& u, int row, int col, f32x4 v) {
            if (u.g < 3) { stbf4(RKV + ((size_t)u.g * NROW + row) * D + col, v); if (first && u.g == 2) stbf4(VF + (size_t)row * D + col, v); }
            else if (col < 128) {
                f32x4 t = v;
                if (u.g == 3) { for (int e = 0; e < 4; ++e) t[e] = 1.f - 2.f * __builtin_amdgcn_rcpf(1.f + __expf(2.f * v[e])); }
                else if (u.g == 5) { for (int e = 0; e < 4; ++e) t[e] = sigmoidf_(v[e]); }
                bf16_t* dst = (u.g == 3 ? A2 : u.g == 4 ? A2 + (size_t)NROW * 128 : u.g == 5 ? A3 : A3 + (size_t)NROW * 128);
                stbf4(dst + (size_t)row * 128 + col, t); } }));
        if (idle_tail(S.nwg)) bg_cvt(p, layer, lds, BG_RG1);
    }
    else if constexpr (PH == PH_R_G2) {
        const bool first = (j == 0);
        float* W = (float*)(ws + OFF_W); bf16_t* AV = (bf16_t*)(ws + OFF_AV); bf16_t* G = (bf16_t*)(ws + OFF_G); bf16_t* RKV = (bf16_t*)(ws + OFF_RKV); const bf16_t* VF = (const bf16_t*)(ws + OFF_VFIRST);
        const float* w0 = p.rw_w0 + (size_t)j * 2 * D; const float* a0 = p.rw_a0 + (size_t)j * 2 * D; const float* v0 = p.rw_v0;
        g8::BatchSched S1{ws + OFF_A2, ws + OFF_WRW + j * SZ_WRW + WR_B2, (size_t)NROW * 128 * 2, (size_t)2048 * 128 * 2, NROW / 256, 8, 2, 128};
        g8::gemm_phase(p.wv, (PG8_LAS unsigned char*)lds, 128, S1, g8::epi_colfirst([=](const g8::Unit& u, int row, int col, f32x4 v, f32x4 bias) {
            const int zz = u.pn >> 2, c = col & 1023; const bool dec = u.g == 0;
            const size_t doff = (size_t)zz * NROW * D + (size_t)row * D + c;
            const f32x4 x = v + bias; f32x4 o;
#pragma unroll
            for (int e = 0; e < 4; ++e) { const float sg = __builtin_amdgcn_rcpf(1.f + __expf(-x[e])); o[e] = dec ? (-0.6065306597126334f * sg) : sg; }
            if (dec) *(f32x4*)(W + doff) = o; else stbf4(AV + doff, o); },
            [=](const g8::Unit& u, int col) { const int zz = u.pn >> 2, c = col & 1023; return *(const f32x4*)((u.g == 0 ? w0 : a0) + zz * D + c); }));
        g8::BatchSched S2{ws + OFF_A3, ws + OFF_WRW + j * SZ_WRW + WR_B3, (size_t)NROW * 128 * 2, (size_t)1024 * 128 * 2, NROW / 256, 4, first ? 1 : 2, 128, 1};
        g8::gemm_phase(p.wv, (PG8_LAS unsigned char*)lds, 128, S2, g8::epi_rc([=](const g8::Unit& u, int row, int col, f32x4 v) {
            if (u.g == 0) stbf4(G + (size_t)row * D + col, v);
            else { const size_t o = (size_t)row * D + col; const f32x4 vv = ldbf4(RKV + (size_t)2 * NROW * D + o), vf = ldbf4(VF + o), gz = v + *(const f32x4*)(v0 + col); f32x4 r;
#pragma unroll
                for (int e = 0; e < 4; ++e) r[e] = vv[e] + (vf[e] - vv[e]) * __builtin_amdgcn_rcpf(1.f + __expf(-gz[e]));
                stbf4(RKV + (size_t)2 * NROW * D + o, r); } }));
    }
    else if constexpr (PH == PH_R_SCAN) ph_rw_scan(p, j, lds);
    else if constexpr (PH == PH_R_SC1) ph_rw_sc1(p, j, lds);
    else if constexpr (PH == PH_R_SC2) ph_rw_sc2(p, lds);
    else if constexpr (PH == PH_R_OUT) ph_rw_out(p, j, layer < 3 ? NROW : NLAT);
    else if constexpr (PH == PH_M_NORM) ph_norm2_router(p, layer, lds, layer < 3 ? NROW : NLAT);
    else if constexpr (PH == PH_M_SEL) { ph_select(p, lds, layer < 3 ? 128 : 64); __syncthreads(); moe_cvt(p, layer, lds, -1); }
    else if constexpr (PH == PH_M_GATHER) ph_gather(p, layer < 3 ? ESLOTS : NB * CAPL);
    else if constexpr (PH == PH_M_G1) {
        bf16_t* HID = (bf16_t*)(ws + OFF_HID);
        g8::BatchSched S{ws + OFF_XE, ws + OFF_W13T + (size_t)(layer & 1) * SZ_WMOE, (size_t)EPAD * D * 2, (size_t)2816 * D * 2, layer < 3 ? 9 : 8, 11, NE, D};
        g8::gemm_phase(p.wv, (PG8_LAS unsigned char*)lds, D, S, g8::epi_pair([=](const g8::Unit& u, int row, int col, f32x4 a, f32x4 b) {
            uint2 w; w.x = pk2(a[0] * __builtin_amdgcn_rcpf(1.f + __expf(-a[0])) * b[0], a[1] * __builtin_amdgcn_rcpf(1.f + __expf(-a[1])) * b[1]); w.y = pk2(a[2] * __builtin_amdgcn_rcpf(1.f + __expf(-a[2])) * b[2], a[3] * __builtin_amdgcn_rcpf(1.f + __expf(-a[3])) * b[3]);
            *(uint2*)(HID + ((size_t)u.g * EPAD + row) * FF + col) = w; }));
        if (layer < 3 && idle_tail(9 * 11 * NE)) moe_cvt(p, layer + 1, lds, BG_MG1);
    }
    else if constexpr (PH == PH_M_G2) {
        bf16_t* YE = (bf16_t*)(ws + OFF_YE); const float* GATE = (const float*)(ws + OFF_GATE);
        g8::BatchSched S{ws + OFF_HID, ws + OFF_W2T + (size_t)(layer & 1) * SZ_WMOE, (size_t)EPAD * FF * 2, (size_t)D * FF * 2, layer < 3 ? 9 : 8, 4, NE, FF};
        g8::gemm_phase(p.wv, (PG8_LAS unsigned char*)lds, FF, S, g8::epi_pre([=](const g8::Unit& u, int row, int col, f32x4 v, f32x4, float gt) {
            uint2 w; w.x = pk2(v[0] * gt, v[1] * gt); w.y = pk2(v[2] * gt, v[3] * gt);
            *(uint2*)(YE + ((size_t)u.g * EPAD + row) * D + col) = w; },
            [=](const g8::Unit&, int) { return (f32x4){0.f, 0.f, 0.f, 0.f}; }, [=](const g8::Unit& u, int row) { return GATE[u.g * EPAD + row]; }));
        if (layer < 3 && idle_tail(9 * 4 * NE)) moe_cvt(p, layer + 1, lds, BG_MG2);
    }
    else if constexpr (PH == PH_M_COMB) ph_combine(p, layer, layer < 3 ? NROW : NLAT);
    else if constexpr (PH == PH_M_CVT) moe_cvt(p, layer, lds, -1);
    else if constexpr (PH == PH_FINAL) ph_comb_norm<true>(p, 3, 0, NLAT);
}

#if ONE_LAUNCH
#define SYNC() xcd_barrier(bar)
#ifndef PROBE_PH
#define PROBE_PH -1
#endif
#ifndef PROBE_REP
#define PROBE_REP 1
#endif
__device__ __forceinline__ Params load_params() {
    Params q{};
#if defined(__HIP_DEVICE_COMPILE__)
    typedef const __attribute__((address_space(4))) unsigned long long* KargP;
    KargP kp_ = (KargP)__builtin_amdgcn_kernarg_segment_ptr(); asm volatile("" : "+s"(kp_));
#pragma unroll
    for (int i = 0; i < 40; ++i) ((const float**)&q)[i] = (const float*)(const __attribute__((address_space(1))) float*)kp_[i];
#endif
    return q;
}
#define RUN(PH) do { for (int rep_ = 0; rep_ < ((PH) == PROBE_PH ? PROBE_REP : 1); ++rep_) { Params q = load_params(); q.wv = wv0_; run_phase<PH>(q, layer, smem); SYNC(); } } while (0)
__global__ void __launch_bounds__(NTHR, 2) mega(Params p) {
    extern __shared__ __attribute__((aligned(16))) char smem[];
    const int wv0_ = __builtin_amdgcn_readfirstlane((int)threadIdx.x >> 6);
    if (threadIdx.x == 0) *(uint4*)(smem + LDS_BYTES) = make_uint4(0u, 0u, 0u, 0u);
    __syncthreads();
    XcdBarrier bar = xcd_barrier_post((unsigned*)(p.ws + OFF_BAR), (volatile LAS unsigned*)(smem + LDS_BYTES));
    { const int layer = 0; RUN(PH_INIT); }
    for (int layer = 0; layer < 4; ++layer) {
        if ((layer & 1) == 0) {
            RUN(PH_A_NORM);
            RUN(PH_A_Z);
            RUN(PH_A_MID);
            RUN(PH_A_QKV);
            RUN(PH_A_ATTN);
            RUN(PH_A_WO);
        } else {
            RUN(PH_R_XS);
            RUN(PH_R_G1);
            RUN(PH_R_G2);
            RUN(PH_R_SC1);
            RUN(PH_R_SC2);
            RUN(PH_R_OUT);
            RUN(PH_R_WO);
        }
        RUN(PH_M_NORM);
        RUN(PH_M_SEL);
        RUN(PH_M_G1);
        RUN(PH_M_G2);
        if ((layer & 1) == 0) RUN(PH_M_COMB);
    }
    { Params q = load_params(); q.wv = wv0_; run_phase<PH_FINAL>(q, 0, smem); }
}
#else
template <int PH> __global__ void __launch_bounds__(NTHR, 2) kph(Params p, int layer) {
    extern __shared__ __attribute__((aligned(16))) char smem[];
    Params q = p; q.wv = __builtin_amdgcn_readfirstlane((int)threadIdx.x >> 6);
    run_phase<PH>(q, layer, smem);
}
#endif

extern "C" void kernel_launch(void* const* d_in, const int* in_sizes, int n_in, void* d_out, int out_size, void* d_ws, size_t ws_size, hipStream_t stream) {
    if (n_in != 38 || ws_size < WS_NEED) { fprintf(stderr, "kernel_launch: bad args n_in %d ws %zu need %zu\n", n_in, ws_size, (size_t)WS_NEED); return; }
    Params p{};
    const float** pp = (const float**)&p;
    for (int i = 0; i < 38; ++i) pp[i] = (const float*)d_in[i];
    p.out = (float*)d_out; p.ws = (char*)d_ws;
    static int cus = 0;
    if (!cus) { int dev = 0; hipGetDevice(&dev); hipDeviceGetAttribute(&cus, hipDeviceAttributeMultiprocessorCount, dev); if (cus <= 0) cus = 256; }
    const int grid = cus;
#if ONE_LAUNCH
    hipFuncSetAttribute((const void*)mega, hipFuncAttributeMaxDynamicSharedMemorySize, LDS_BYTES + 16);
    hipMemsetAsync(d_ws, 0, 16384, stream);
    hipLaunchKernelGGL(mega, dim3(grid), dim3(NTHR), LDS_BYTES + 16, stream, p);
#else
    hipMemsetAsync(d_ws, 0, 16384, stream);
#define LAUNCH(PH, L) do { hipFuncSetAttribute((const void*)kph<PH>, hipFuncAttributeMaxDynamicSharedMemorySize, LDS_BYTES + 16); hipLaunchKernelGGL(kph<PH>, dim3(grid), dim3(NTHR), LDS_BYTES + 16, stream, p, L); } while (0)
    LAUNCH(PH_INIT, 0);
    for (int layer = 0; layer < 4; ++layer) {
        if ((layer & 1) == 0) { LAUNCH(PH_A_NORM, layer); LAUNCH(PH_A_Z, layer); LAUNCH(PH_A_MID, layer); LAUNCH(PH_A_QKV, layer); LAUNCH(PH_A_ATTN, layer); LAUNCH(PH_A_WO, layer); }
        else { LAUNCH(PH_R_XS, layer); LAUNCH(PH_R_G1, layer); LAUNCH(PH_R_G2, layer); LAUNCH(PH_R_SC1, layer); LAUNCH(PH_R_SC2, layer); LAUNCH(PH_R_OUT, layer); LAUNCH(PH_R_WO, layer); }
        LAUNCH(PH_M_NORM, layer); LAUNCH(PH_M_SEL, layer); LAUNCH(PH_M_G1, layer); LAUNCH(PH_M_G2, layer); if ((layer & 1) == 0) LAUNCH(PH_M_COMB, layer);
    }
    LAUNCH(PH_FINAL, 0);
#endif
}
```

```cpp
#include <hip/hip_runtime.h>
#include <stdint.h>
#include <stdio.h>

#ifndef ONE_LAUNCH
#define ONE_LAUNCH 1
#endif

#define NTHR 512
typedef unsigned short bf16_t;
typedef short bf16x8 __attribute__((ext_vector_type(8)));
typedef float f32x4 __attribute__((ext_vector_type(4)));
typedef unsigned u32x4 __attribute__((ext_vector_type(4)));
typedef unsigned u32x2 __attribute__((ext_vector_type(2)));

constexpr int D = 1024, NB = 4, TL = 4096, TC = 256, NLAT = NB * TL, NCTX = NB * TC, NROW = NLAT + NCTX;
constexpr int TK = TL + TC;
constexpr int NE = 16, FF = 1408, CAPL = 512, CAPC = 32, ESLOTS = NB * CAPL + NB * CAPC;
constexpr int EPAD = 2304;
constexpr float RMS_EPS = 1e-6f, LNX_EPS = 64e-5f;
constexpr float ATT_SCALE = 0.07216878364870322f;

constexpr size_t al256(size_t x) { return (x + 255) / 256 * 256; }
constexpr size_t OFF_BAR = 0;
constexpr size_t OFF_QUEUE = 14336;
constexpr size_t OFF_MOD = 16384;
constexpr size_t OFF_ROPE_C = OFF_MOD + al256(4 * 5 * 6144 * 4);
constexpr size_t OFF_ROPE_S = OFF_ROPE_C + al256(TL * 32 * 4);
constexpr size_t OFF_X = OFF_ROPE_S + al256(TL * 32 * 4);
constexpr size_t SZ_F32 = (size_t)NROW * D * 4, SZ_BF = (size_t)NROW * D * 2;
constexpr size_t OFF_VFIRST = OFF_X + SZ_BF;
constexpr size_t OFF_H = OFF_VFIRST + SZ_BF;
constexpr size_t SZ_WMLA = (size_t)(512 * 1024 + 1536 * 256 + 2048 * 256 + 1024 * 1024) * 2;
constexpr size_t WM_IN = 0, WM_UQ = (size_t)512 * 1024 * 2, WM_UKV = WM_UQ + (size_t)1536 * 256 * 2, WM_O = WM_UKV + (size_t)2048 * 256 * 2;
constexpr size_t SZ_WRW = (size_t)(3 * 1024 * 1024 + 4 * 256 * 1024 + 1024 * 1024 + 4096 * 256 + 2048 * 256) * 2;
constexpr size_t WR_RKV = 0, WR_L = (size_t)3 * 1024 * 1024 * 2, WR_O = WR_L + (size_t)4 * 256 * 1024 * 2, WR_B2 = WR_O + (size_t)1024 * 1024 * 2, WR_B3 = WR_B2 + (size_t)4096 * 256 * 2;
constexpr size_t OFF_WMLA = OFF_H + SZ_BF;
constexpr size_t OFF_WRW = OFF_WMLA + 2 * SZ_WMLA;
constexpr size_t OFF_W13T = OFF_WRW + 2 * SZ_WRW;
constexpr size_t OFF_W2T = OFF_W13T + (size_t)NE * 2816 * D * 2;
constexpr size_t SZ_WMOE = (size_t)NE * 2816 * D * 2 + (size_t)NE * D * FF * 2;
constexpr size_t OFF_S = OFF_W13T + 2 * SZ_WMOE;
constexpr size_t OFF_Z = OFF_S;
constexpr size_t OFF_CQN = OFF_Z + al256((size_t)NROW * 512 * 4);
constexpr size_t OFF_CKVN = OFF_CQN + al256((size_t)NROW * 256 * 2);
constexpr size_t OFF_KR = OFF_CKVN + al256((size_t)NROW * 256 * 2);
constexpr size_t OFF_QRAW = OFF_KR + al256((size_t)NROW * 64 * 4);
constexpr size_t OFF_KVRAW = OFF_QRAW + al256((size_t)NROW * 1536 * 4);
constexpr size_t OFF_Q = OFF_KVRAW + al256((size_t)NROW * 2048 * 4);
constexpr size_t OFF_K = OFF_Q + al256((size_t)NB * 8 * TK * 192 * 2);
constexpr size_t OFF_V = OFF_K + al256((size_t)NB * 8 * TK * 192 * 2);
constexpr size_t OFF_O = OFF_V + al256((size_t)NB * 8 * TK * 128 * 2);
constexpr size_t END_MLA = OFF_O + SZ_BF;
constexpr size_t OFF_XS = OFF_S;
constexpr size_t OFF_RKV = OFF_XS + 6 * SZ_BF;
constexpr size_t OFF_W = OFF_RKV + 3 * SZ_BF;
constexpr size_t OFF_AV = OFF_W + 2 * SZ_F32;
constexpr size_t OFF_G = OFF_AV + 2 * SZ_BF;
constexpr size_t OFF_A2 = OFF_G + SZ_BF;
constexpr size_t OFF_A3 = OFF_A2 + al256((size_t)NROW * 256 * 2);
constexpr size_t END_RW = OFF_A3 + al256((size_t)NROW * 256 * 2);
constexpr size_t OFF_Y = OFF_XS;
constexpr int NCHK = (TC + TL) / 64;
constexpr size_t OFF_CK = END_RW;
constexpr size_t END_RW2 = OFF_CK + (size_t)128 * NCHK * 4 * 4096 * 2;
constexpr size_t OFF_AFF = OFF_S;
constexpr size_t OFF_ROWIDX = OFF_AFF + al256((size_t)NROW * 16 * 4);
constexpr size_t OFF_GATE = OFF_ROWIDX + al256((size_t)NE * ESLOTS * 4);
constexpr size_t OFF_SLOT = OFF_GATE + al256((size_t)NE * EPAD * 4);
constexpr size_t OFF_XE = OFF_SLOT + al256((size_t)NROW * 16 * 4);
constexpr size_t OFF_HID = OFF_XE + al256((size_t)NE * EPAD * D * 2);
constexpr size_t OFF_YE = OFF_HID + al256((size_t)NE * EPAD * FF * 2);
constexpr size_t END_MOE = OFF_YE + al256((size_t)NE * EPAD * D * 2);
constexpr size_t WS_NEED = END_RW2 > END_MLA ? (END_RW2 > END_MOE ? END_RW2 : END_MOE) : (END_MLA > END_MOE ? END_MLA : END_MOE);

constexpr int LDS_BYTES = 152064;

struct Params {
    const float *x, *c, *ctx, *c_ctx, *mod_w, *mod_b, *norm1_g, *norm2_g, *final_g;
    const float *mla_w_in, *mla_g_q, *mla_g_kv, *mla_w_uq, *mla_w_ukv, *mla_w_o;
    const float *rw_mu, *rw_w_rkv, *rw_w0, *rw_w1, *rw_w2, *rw_a0, *rw_a1, *rw_a2, *rw_v0, *rw_v1, *rw_v2, *rw_g1, *rw_g2, *rw_k_k, *rw_k_a, *rw_r_k, *rw_lnx_g, *rw_lnx_b, *rw_w_o;
    const float *moe_router, *moe_w1, *moe_w3, *moe_w2;
    float* out; char* ws;
    int wv, pad_;
};

__device__ __forceinline__ int bidx() { int t = blockIdx.x; asm volatile("" : "+s"(t)); return t; }
__device__ __forceinline__ int gdim() { int t = gridDim.x; asm volatile("" : "+s"(t)); return t; }
__device__ __forceinline__ int tidx_w(int wv) { int l; asm volatile("v_mbcnt_lo_u32_b32 %0, -1, 0\n\tv_mbcnt_hi_u32_b32 %0, -1, %0" : "=v"(l)); return (wv << 6) | l; }
#define tidx() tidx_w(p.wv)
#define XB_TMO      128
#define XB_XCNT(j)  (256  + 64 * (j))
#define XB_XSUB(j)  (1280 + 64 * (j))
#define XB_XGEN(j)  (2304 + 64 * (j))
#define XB_TOP      3328
#define XB_TOPGEN   3392
#define XCD_BAR_WORDS 3456
#define XB_SPIN_CAP (1u << 22)
#define LAS __attribute__((address_space(3)))

__device__ __forceinline__ unsigned xb_ld(unsigned* p)              { return __hip_atomic_load(p, __ATOMIC_RELAXED, __HIP_MEMORY_SCOPE_AGENT); }
__device__ __forceinline__ unsigned xb_add(unsigned* p, unsigned v) { return __hip_atomic_fetch_add(p, v, __ATOMIC_RELAXED, __HIP_MEMORY_SCOPE_AGENT); }
__device__ __forceinline__ unsigned xb_xcc_id() { return (unsigned)__builtin_amdgcn_s_getreg((3 << 11) | 20) & 0xFu; }
#define XB_SPIN(cond, bar) do { unsigned _sp = 0; while (cond) { __builtin_amdgcn_s_sleep(1); \
    if ((++_sp & 255u) == 0u) { if (xb_ld(&(bar)[XB_TMO])) break; if (_sp > XB_SPIN_CAP) { atomicAdd(&(bar)[XB_TMO], 1u); break; } } } } while (0)

struct XcdBarrier { unsigned* bar; unsigned x; volatile LAS unsigned* st; };

__device__ __forceinline__ XcdBarrier xcd_barrier_post(unsigned* bar, volatile LAS unsigned* st) {
    XcdBarrier b; b.bar = bar; b.x = xb_xcc_id(); b.st = st;
    if (threadIdx.x == 0) (void)xb_add(&bar[XB_XCNT(b.x)], 1u);
    return b;
}
__device__ __forceinline__ void xcd_barrier_complete(unsigned* bar, unsigned x, unsigned& nloc, unsigned& nx) {
    const unsigned G = gridDim.x * gridDim.y * gridDim.z;
    unsigned sum, cnt, mine, sp = 0u;
    for (;;) {
        sum = 0u; cnt = 0u; mine = 0u;
#pragma unroll
        for (unsigned j = 0; j < 16; ++j) { const unsigned c = xb_ld(&bar[XB_XCNT(j)]); sum += c; cnt += (c > 0u) ? 1u : 0u; mine = (j == x) ? c : mine; }
        if (sum == G) break;
        __builtin_amdgcn_s_sleep(1);
        if ((++sp & 255u) == 0u) { if (xb_ld(&bar[XB_TMO])) break; if (sp > XB_SPIN_CAP) { atomicAdd(&bar[XB_TMO], 1u); break; } }
    }
    nloc = mine > 0u ? mine : 1u; nx = cnt > 0u ? cnt : 1u;
}
__device__ __forceinline__ void xcd_barrier(const XcdBarrier& b) {
    asm volatile("s_waitcnt vmcnt(0)" ::: "memory");
    __syncthreads();
    if (threadIdx.x == 0) {
        unsigned* bar = b.bar;
        __builtin_amdgcn_s_waitcnt(0);
        unsigned nloc = b.st[0], nx = b.st[1];
        if (nloc == 0u) { xcd_barrier_complete(bar, b.x, nloc, nx); b.st[0] = nloc; b.st[1] = nx; }
        const unsigned old = xb_add(&bar[XB_XSUB(b.x)], 1u);
        const unsigned gen = old / nloc;
        if (old + 1u == (gen + 1u) * nloc) {
            __builtin_amdgcn_fence(__ATOMIC_RELEASE, "agent");
            asm volatile("s_waitcnt vmcnt(0)" ::: "memory");
            const unsigned og = xb_add(&bar[XB_TOP], 1u);
            const unsigned tg = og / nx;
            if (og + 1u == (tg + 1u) * nx) xb_add(&bar[XB_TOPGEN], 1u);
            else XB_SPIN(xb_ld(&bar[XB_TOPGEN]) == tg, bar);
            __builtin_amdgcn_fence(__ATOMIC_ACQUIRE, "agent");
            xb_add(&bar[XB_XGEN(b.x)], 1u);
            asm volatile("s_waitcnt vmcnt(0)" ::: "memory");
        } else {
            XB_SPIN(xb_ld(&bar[XB_XGEN(b.x)]) == gen, bar);
            __builtin_amdgcn_fence(__ATOMIC_ACQUIRE, "agent");
            asm volatile("s_waitcnt vmcnt(0)" ::: "memory");
        }
    }
    __syncthreads();
}

__device__ __forceinline__ float bf2f(bf16_t b) { return __uint_as_float(((unsigned)b) << 16); }
typedef float f32x2_ __attribute__((ext_vector_type(2)));
typedef __bf16 bf16x2_ __attribute__((ext_vector_type(2)));
__device__ __forceinline__ unsigned pk2(float lo, float hi) { const f32x2_ v = {lo, hi}; return __builtin_bit_cast(unsigned, __builtin_convertvector(v, bf16x2_)); }
__device__ __forceinline__ bf16_t f2bf(float f) { return (bf16_t)(pk2(f, f) & 0xffffu); }
__device__ __forceinline__ float dpp_sum16(float x) {
    x += __builtin_bit_cast(float, __builtin_amdgcn_update_dpp(0, __builtin_bit_cast(int, x), 0xB1, 0xF, 0xF, true));
    x += __builtin_bit_cast(float, __builtin_amdgcn_update_dpp(0, __builtin_bit_cast(int, x), 0x4E, 0xF, 0xF, true));
    x += __builtin_bit_cast(float, __builtin_amdgcn_update_dpp(0, __builtin_bit_cast(int, x), 0x141, 0xF, 0xF, true));
    x += __builtin_bit_cast(float, __builtin_amdgcn_update_dpp(0, __builtin_bit_cast(int, x), 0x140, 0xF, 0xF, true));
    return x;
}
__device__ __forceinline__ f32x4 ldbf4(const bf16_t* p) { const uint2 w = *(const uint2*)p; return (f32x4){__uint_as_float(w.x << 16), __uint_as_float(w.x & 0xffff0000u), __uint_as_float(w.y << 16), __uint_as_float(w.y & 0xffff0000u)}; }
__device__ __forceinline__ void stbf4(bf16_t* p, f32x4 v) { uint2 w; w.x = pk2(v[0], v[1]); w.y = pk2(v[2], v[3]); *(uint2*)p = w; }
typedef bf16_t xt_t;
__device__ __forceinline__ f32x4 xldv(const xt_t* X, size_t i) { return ldbf4(X + i); }
__device__ __forceinline__ void xstv(xt_t* X, size_t i, f32x4 v) { stbf4(X + i, v); }
__device__ __forceinline__ float4 xld(const xt_t* X, size_t i) { const f32x4 v = ldbf4(X + i); return make_float4(v[0], v[1], v[2], v[3]); }
__device__ __forceinline__ void xst(xt_t* X, size_t i, float4 v) { stbf4(X + i, (f32x4){v.x, v.y, v.z, v.w}); }
__device__ __forceinline__ float wave_sum(float v) {
    v = dpp_sum16(v); const int i = __builtin_bit_cast(int, v);
    return __builtin_bit_cast(float, __builtin_amdgcn_readlane(i, 0)) + __builtin_bit_cast(float, __builtin_amdgcn_readlane(i, 16)) + __builtin_bit_cast(float, __builtin_amdgcn_readlane(i, 32)) + __builtin_bit_cast(float, __builtin_amdgcn_readlane(i, 48));
}
__device__ __forceinline__ float sigmoidf_(float x) { return __builtin_amdgcn_rcpf(1.f + __expf(-x)); }
__device__ __forceinline__ int row_stream(int row) { return row < NLAT ? (row >> 12) : 4; }
__device__ __forceinline__ const float* modp(const Params& p, int layer, int s, int part) { return (const float*)(p.ws + OFF_MOD) + ((size_t)layer * 5 + s) * 6144 + part * 1024; }

struct SgArgs { const bf16_t* A; int lda; size_t strideA; const float* B; int ldb; size_t strideB; int M, N, K, nbatch; };
template <class Epi>
__device__ __forceinline__ void sg_gemm(const Params& p, char* lds, const SgArgs g, const Epi& epi) {
    bf16_t* As = (bf16_t*)lds;
    bf16_t* Bs = As + 128 * 40;
    const int tid = tidx(), wid = tid >> 6, lane = tid & 63;
    const int wr = wid >> 2, wc = wid & 3;
    const int tilesN = (g.N + 127) / 128, tilesM = g.M / 128, per = tilesM * tilesN, ntiles = per * g.nbatch;
    const int ar = tid >> 2, ak = (tid & 3) * 8;
    const int bn = tid & 127, bk = (tid >> 7) * 8;
    for (int tile = bidx(); tile < ntiles; tile += gdim()) {
        const int bt = tile / per, tt = tile % per;
        const int tm = tt / tilesN, tn = tt % tilesN;
        const int m0 = tm * 128, n0 = tn * 128;
        f32x4 acc[4][2];
#pragma unroll
        for (int m = 0; m < 4; ++m)
#pragma unroll
            for (int n = 0; n < 2; ++n) acc[m][n] = (f32x4){0.f, 0.f, 0.f, 0.f};
        const bool bvalid = (n0 + bn) < g.N;
        const bf16_t* ap = g.A + bt * g.strideA + (size_t)(m0 + ar) * g.lda + ak;
        const float* bp = g.B + bt * g.strideB + (size_t)bk * g.ldb + n0 + bn;
        bf16x8 areg; float breg[8];
        areg = *(const bf16x8*)ap;
#pragma unroll
        for (int j = 0; j < 8; ++j) breg[j] = bvalid ? bp[(size_t)j * g.ldb] : 0.f;
        for (int k0 = 0; k0 < g.K; k0 += 32) {
            __syncthreads();
            *(bf16x8*)(As + ar * 40 + ak) = areg;
            { u32x4 w; w.x = pk2(breg[0], breg[1]); w.y = pk2(breg[2], breg[3]); w.z = pk2(breg[4], breg[5]); w.w = pk2(breg[6], breg[7]); *(u32x4*)(Bs + bn * 40 + bk) = w; }
            __syncthreads();
            if (k0 + 32 < g.K) {
                areg = *(const bf16x8*)(ap + k0 + 32);
#pragma unroll
                for (int j = 0; j < 8; ++j) breg[j] = bvalid ? bp[(size_t)(k0 + 32 + j) * g.ldb] : 0.f;
            }
            bf16x8 af[4], bfr[2];
#pragma unroll
            for (int m = 0; m < 4; ++m) af[m] = *(const bf16x8*)(As + (wr * 64 + m * 16 + (lane & 15)) * 40 + (lane >> 4) * 8);
#pragma unroll
            for (int n = 0; n < 2; ++n) bfr[n] = *(const bf16x8*)(Bs + (wc * 32 + n * 16 + (lane & 15)) * 40 + (lane >> 4) * 8);
#pragma unroll
            for (int m = 0; m < 4; ++m)
#pragma unroll
                for (int n = 0; n < 2; ++n) acc[m][n] = __builtin_amdgcn_mfma_f32_16x16x32_bf16(af[m], bfr[n], acc[m][n], 0, 0, 0);
        }
#pragma unroll
        for (int m = 0; m < 4; ++m)
#pragma unroll
            for (int n = 0; n < 2; ++n) {
                const int col = n0 + wc * 32 + n * 16 + (lane & 15);
                if (col < g.N) {
#pragma unroll
                    for (int r = 0; r < 4; ++r) epi(bt, m0 + wr * 64 + m * 16 + (lane >> 4) * 4 + r, col, acc[m][n][r]);
                }
            }
    }
}


namespace g8 {
#define PG8_LAS __attribute__((address_space(3)))
constexpr int BM = 256, BK = 64, HALF = 128, HTB = HALF * BK * 2, STAGE_BYTES = 8 * HTB;
__device__ __forceinline__ int lds_byte(int r, int c) { const int st = (r >> 4) * 2 + (c >> 5), rr = r & 15, cc = c & 31, ob = rr * 64 + cc * 2; return st * 1024 + (ob ^ (((ob >> 9) & 1) << 5)); }
__device__ __forceinline__ void stage_rc(int b, int& R, int& C) { const int st = b / 1024, sb = b % 1024, swz = sb ^ (((sb >> 9) & 1) << 5); R = (st >> 1) * 16 + swz / 64; C = (st & 1) * 32 + (swz % 64) / 2; }
struct Unit { int pm, pn, g; const char* A; const char* B; };
__device__ __forceinline__ int xcd_remap(int L, int nwg) { const int q = nwg / 8, r = nwg % 8, xcd = L % 8, off = L / 8; return (xcd < r ? xcd * (q + 1) : r * (q + 1) + (xcd - r) * q) + off; }

template <class Epi, class Sched>
__device__ __forceinline__ void gemm_phase(const int wv_, PG8_LAS unsigned char* lds, const int K, const Sched& S, const Epi& E) {
    const int tid = tidx_w(wv_), wid = __builtin_amdgcn_readfirstlane(tid >> 6), lane = tid & 63, wr = wid >> 2, wc = wid & 3, fr = lane & 15, fq = lane >> 4;
    const int nt = K / BK;
    unsigned voffA[2];
#pragma unroll
    for (int i = 0; i < 2; ++i) { int R, C; stage_rc(tid * 16 + i * 8192, R, C); voffA[i] = (unsigned)(R * K + C) * 2u; }
    const size_t kstep = (size_t)(BK * 2);
    const size_t hstep = (size_t)HALF * K * 2;
    const unsigned ldsw = (unsigned)wid * 1024u;
    const int aoff = lds_byte(wr * 64 + fr, fq * 8), boff = lds_byte(wc * 32 + fr, fq * 8);
#define PG8_SA(b, h) (((b) * 2 + (h)) * HTB)
#define PG8_SB(b, h) ((4 + (b) * 2 + (h)) * HTB)
#define PG8_STAGE(bufoff, gbase, voff) do { _Pragma("unroll") for (int _i = 0; _i < 2; ++_i) \
        __builtin_amdgcn_global_load_lds((const unsigned*)((const char*)(gbase) + (voff)[_i]), (PG8_LAS unsigned*)(lds + (bufoff) + ldsw + _i * 8192), 16, 0, 0); } while (0)
#define PG8_LDA(dst, b, h) do { _Pragma("unroll") for (int m = 0; m < 4; ++m) _Pragma("unroll") for (int k = 0; k < 2; ++k) dst[m][k] = *(const PG8_LAS bf16x8*)(lds + PG8_SA(b, h) + aoff + m * 2048 + k * 1024); } while (0)
#define PG8_LDB(dst, b, h) do { _Pragma("unroll") for (int n = 0; n < 2; ++n) _Pragma("unroll") for (int k = 0; k < 2; ++k) dst[n][k] = *(const PG8_LAS bf16x8*)(lds + PG8_SB(b, h) + boff + n * 2048 + k * 1024); } while (0)
#define PG8_MMA(ai, bj, At, Bt) do { __builtin_amdgcn_s_setprio(1); _Pragma("unroll") for (int m = 0; m < 4; ++m) _Pragma("unroll") for (int n = 0; n < 2; ++n) _Pragma("unroll") for (int k = 0; k < 2; ++k) \
        acc[ai][bj][m][n] = __builtin_amdgcn_mfma_f32_16x16x32_bf16(Bt[n][k], At[m][k], acc[ai][bj][m][n], 0, 0, 0); __builtin_amdgcn_s_setprio(0); } while (0)
#define PG8_WAIT_V(n) asm volatile("s_waitcnt vmcnt(" #n ")" ::: "memory")
#define PG8_WAIT_L(n) asm volatile("s_waitcnt lgkmcnt(" #n ")" ::: "memory")
#define PG8_BAR __builtin_amdgcn_s_barrier()
#define PG8_SCHED __builtin_amdgcn_sched_barrier(0)
    Unit cur, nxt; int ui = 0;
    if (!S.next(0, cur)) return;
    f32x4 acc[2][2][4][2];
#pragma unroll
    for (int a = 0; a < 2; ++a)
#pragma unroll
        for (int b = 0; b < 2; ++b)
#pragma unroll
            for (int m = 0; m < 4; ++m)
#pragma unroll
                for (int n = 0; n < 2; ++n) acc[a][b][m][n] = (f32x4){0.f, 0.f, 0.f, 0.f};
    bf16x8 At[4][2], B0[2][2], B1[2][2];
    const char* cA = cur.A; const char* cB = cur.B;
    PG8_STAGE(PG8_SB(0, 0), cB, voffA); PG8_STAGE(PG8_SA(0, 0), cA, voffA); PG8_STAGE(PG8_SB(0, 1), cB + hstep, voffA); PG8_STAGE(PG8_SA(0, 1), cA + hstep, voffA);
    if (wr == 1) PG8_BAR;
    PG8_WAIT_V(4); PG8_BAR;
    PG8_STAGE(PG8_SB(1, 0), cB + kstep, voffA); PG8_STAGE(PG8_SA(1, 0), cA + kstep, voffA); PG8_STAGE(PG8_SB(1, 1), cB + hstep + kstep, voffA);
    PG8_WAIT_V(6); PG8_BAR;
    for (;;) {
        const bool has_next = S.next(ui + 1, nxt);
        const char* nA = has_next ? nxt.A : cA; const char* nB = has_next ? nxt.B : cB;
        for (int t = 0; t < nt; t += 2) {
            const bool last = (t == nt - 2);
            const char* a1 = cA + (size_t)(t + 1) * kstep;
            const char* a2 = last ? nA : cA + (size_t)(t + 2) * kstep; const char* b2 = last ? nB : cB + (size_t)(t + 2) * kstep;
            const char* a3 = a2 + kstep; const char* b3 = b2 + kstep;
            PG8_LDB(B0, 0, 0); PG8_SCHED; PG8_LDA(At, 0, 0); PG8_STAGE(PG8_SA(1, 1), a1 + hstep, voffA);
            PG8_WAIT_L(8); PG8_BAR; PG8_WAIT_L(0); PG8_MMA(0, 0, At, B0); PG8_BAR; PG8_SCHED;
            PG8_LDB(B1, 0, 1); PG8_STAGE(PG8_SB(0, 0), b2, voffA);
            PG8_BAR; PG8_WAIT_L(0); PG8_MMA(0, 1, At, B1); PG8_BAR;
            PG8_LDA(At, 0, 1); PG8_STAGE(PG8_SA(0, 0), a2, voffA);
            PG8_BAR; PG8_WAIT_L(0); PG8_MMA(1, 0, At, B0); PG8_BAR; PG8_SCHED;
            PG8_STAGE(PG8_SB(0, 1), b2 + hstep, voffA);
            PG8_WAIT_V(6); PG8_BAR; PG8_MMA(1, 1, At, B1); PG8_BAR;
            PG8_LDB(B0, 1, 0); PG8_SCHED; PG8_LDA(At, 1, 0); PG8_STAGE(PG8_SA(0, 1), a2 + hstep, voffA);
            PG8_WAIT_L(8); PG8_BAR; PG8_WAIT_L(0); PG8_MMA(0, 0, At, B0); PG8_BAR; PG8_SCHED;
            PG8_LDB(B1, 1, 1); PG8_STAGE(PG8_SB(1, 0), b3, voffA);
            PG8_BAR; PG8_WAIT_L(0); PG8_MMA(0, 1, At, B1); PG8_BAR;
            PG8_LDA(At, 1, 1); PG8_STAGE(PG8_SA(1, 0), a3, voffA);
            PG8_BAR; PG8_WAIT_L(0); PG8_MMA(1, 0, At, B0); PG8_BAR; PG8_SCHED;
            PG8_STAGE(PG8_SB(1, 1), b3 + hstep, voffA);
            PG8_WAIT_V(6); PG8_BAR; PG8_MMA(1, 1, At, B1); PG8_BAR;
        }
        E(acc, cur, wr, wc, fr, fq);
        if (!has_next) break;
#pragma unroll
        for (int a = 0; a < 2; ++a)
#pragma unroll
            for (int b = 0; b < 2; ++b)
#pragma unroll
                for (int m = 0; m < 4; ++m)
#pragma unroll
                    for (int n = 0; n < 2; ++n) acc[a][b][m][n] = (f32x4){0.f, 0.f, 0.f, 0.f};
        cur = nxt; cA = nA; cB = nB; ++ui;
    }
    PG8_WAIT_V(0);
    if (wr == 0) PG8_BAR;
    PG8_BAR;
#undef PG8_SA
#undef PG8_SB
#undef PG8_STAGE
#undef PG8_LDA
#undef PG8_LDB
#undef PG8_MMA
#undef PG8_WAIT_V
#undef PG8_WAIT_L
#undef PG8_BAR
#undef PG8_SCHED
}
template <class F> struct EpiRC { F f;
    __device__ __forceinline__ void operator()(const f32x4 (&acc)[2][2][4][2], const Unit& u, int wr, int wc, int fr, int fq) const {
#pragma unroll
        for (int ai = 0; ai < 2; ++ai)
#pragma unroll
            for (int m = 0; m < 4; ++m) { const int row = u.pm * BM + ai * HALF + wr * 64 + m * 16 + fr;
#pragma unroll
                for (int bj = 0; bj < 2; ++bj)
#pragma unroll
                    for (int n = 0; n < 2; ++n) f(u, row, u.pn * BM + bj * HALF + wc * 32 + n * 16 + 4 * fq, acc[ai][bj][m][n]);
                asm volatile("" ::: "memory"); }
    } };
template <class F> __device__ __forceinline__ EpiRC<F> epi_rc(const F& f) { return EpiRC<F>{f}; }
template <class F> struct EpiPair { F f;
    __device__ __forceinline__ void operator()(const f32x4 (&acc)[2][2][4][2], const Unit& u, int wr, int wc, int fr, int fq) const {
#pragma unroll
        for (int ai = 0; ai < 2; ++ai)
#pragma unroll
            for (int m = 0; m < 4; ++m) { const int row = u.pm * BM + ai * HALF + wr * 64 + m * 16 + fr;
#pragma unroll
                for (int n = 0; n < 2; ++n) f(u, row, u.pn * HALF + wc * 32 + n * 16 + 4 * fq, acc[ai][0][m][n], acc[ai][1][m][n]);
                asm volatile("" ::: "memory"); }
    } };
template <class F> __device__ __forceinline__ EpiPair<F> epi_pair(const F& f) { return EpiPair<F>{f}; }
template <class F, class CF, class RF> struct EpiPre { F f; CF cf; RF rf;
    __device__ __forceinline__ void operator()(const f32x4 (&acc)[2][2][4][2], const Unit& u, int wr, int wc, int fr, int fq) const {
        f32x4 cv[2][2]; float rv[2][4];
#pragma unroll
        for (int bj = 0; bj < 2; ++bj)
#pragma unroll
            for (int n = 0; n < 2; ++n) cv[bj][n] = cf(u, u.pn * BM + bj * HALF + wc * 32 + n * 16 + 4 * fq);
#pragma unroll
        for (int ai = 0; ai < 2; ++ai)
#pragma unroll
            for (int m = 0; m < 4; ++m) rv[ai][m] = rf(u, u.pm * BM + ai * HALF + wr * 64 + m * 16 + fr);
#pragma unroll
        for (int ai = 0; ai < 2; ++ai)
#pragma unroll
            for (int m = 0; m < 4; ++m) { const int row = u.pm * BM + ai * HALF + wr * 64 + m * 16 + fr;
#pragma unroll
                for (int bj = 0; bj < 2; ++bj)
#pragma unroll
                    for (int n = 0; n < 2; ++n) f(u, row, u.pn * BM + bj * HALF + wc * 32 + n * 16 + 4 * fq, acc[ai][bj][m][n], cv[bj][n], rv[ai][m]);
                asm volatile("" ::: "memory"); }
    } };
template <class F, class CF, class RF> __device__ __forceinline__ EpiPre<F, CF, RF> epi_pre(const F& f, const CF& cf, const RF& rf) { return EpiPre<F, CF, RF>{f, cf, rf}; }
template <class F, class CF> struct EpiColFirst { F f; CF cf;
    __device__ __forceinline__ void operator()(const f32x4 (&acc)[2][2][4][2], const Unit& u, int wr, int wc, int fr, int fq) const {
#pragma unroll
        for (int bj = 0; bj < 2; ++bj)
#pragma unroll
            for (int n = 0; n < 2; ++n) { const int col = u.pn * BM + bj * HALF + wc * 32 + n * 16 + 4 * fq; const f32x4 cv = cf(u, col);
#pragma unroll
                for (int ai = 0; ai < 2; ++ai)
#pragma unroll
                    for (int m = 0; m < 4; ++m) f(u, u.pm * BM + ai * HALF + wr * 64 + m * 16 + fr, col, acc[ai][bj][m][n], cv);
                asm volatile("" ::: "memory"); }
    } };
template <class F, class CF> __device__ __forceinline__ EpiColFirst<F, CF> epi_colfirst(const F& f, const CF& cf) { return EpiColFirst<F, CF>{f, cf}; }
struct EpiResid { xt_t* X; const float* MOD; int layer;
    __device__ __forceinline__ void operator()(const f32x4 (&acc)[2][2][4][2], const Unit& u, int wr, int wc, int fr, int fq) const {
        const int row0 = u.pm * BM + wr * 64 + fr, col0 = u.pn * BM + wc * 32 + 4 * fq;
        const int strm = row0 < NLAT ? (row0 >> 12) : 4;
        const float* gp = MOD + ((size_t)layer * 5 + strm) * 6144 + 2048 + col0;
        f32x4 gt[2][2];
#pragma unroll
        for (int bj = 0; bj < 2; ++bj)
#pragma unroll
            for (int n = 0; n < 2; ++n) gt[bj][n] = *(const f32x4*)(gp + bj * HALF + n * 16);
#pragma unroll
        for (int ai = 0; ai < 2; ++ai) {
            f32x4 xv[4][2][2];
#pragma unroll
            for (int m = 0; m < 4; ++m)
#pragma unroll
                for (int bj = 0; bj < 2; ++bj)
#pragma unroll
                    for (int n = 0; n < 2; ++n) xv[m][bj][n] = xldv(X, (size_t)(row0 + ai * HALF + m * 16) * D + col0 + bj * HALF + n * 16);
#pragma unroll
            for (int m = 0; m < 4; ++m)
#pragma unroll
                for (int bj = 0; bj < 2; ++bj)
#pragma unroll
                    for (int n = 0; n < 2; ++n) xstv(X, (size_t)(row0 + ai * HALF + m * 16) * D + col0 + bj * HALF + n * 16, xv[m][bj][n] + gt[bj][n] * acc[ai][bj][m][n]);
            asm volatile("" ::: "memory");
        }
    } };
struct BatchSched { const char* A; const char* B; size_t strideA, strideB; int nM, nN, nb, K; int rev = 0;
    __device__ __forceinline__ bool next(int i, Unit& u) const {
        const int nwg = nM * nN * nb; const int L = i * gdim() + (rev ? gdim() - 1 - bidx() : bidx()); if (L >= nwg) return false;
        const int w = xcd_remap(L, nwg); const int per = nM * nN; u.g = w / per; const int r = w % per; u.pm = r / nN; u.pn = r % nN;
        u.A = A + u.g * strideA + (size_t)u.pm * BM * K * 2; u.B = B + u.g * strideB + (size_t)u.pn * BM * K * 2; return true; } };
}

template <class SrcF, class DRow>
__device__ __forceinline__ int cvt_tiles(const int wv_, char* lds, bf16_t* dst, int Kd, int Nd, int nbatch, size_t dstride, const SrcF& src, const DRow& drow, int* rot = nullptr) {
    bf16_t* T = (bf16_t*)lds;
    const int tid = tidx_w(wv_);
    const int tk = Kd / 128, tn = Nd / 64, per = tk * tn, total = per * nbatch;
    {
        int first = bidx() - (rot ? *rot % gdim() : 0); if (first < 0) first += gdim();
        if (rot) *rot += total;
        for (int t = first; t < total; t += gdim()) {
            const int bt = t / per, r = t % per, k0 = (r % tk) * 128, n0 = (r / tk) * 64;
            float4 v[4];
#pragma unroll
            for (int i = 0; i < 4; ++i) { const int k = k0 + i * 32 + (tid >> 4), n = n0 + (tid & 15) * 4; const float* sp = src(bt, k, n); v[i] = sp ? *(const float4*)sp : make_float4(0.f, 0.f, 0.f, 0.f); }
            __syncthreads();
#pragma unroll
            for (int i = 0; i < 4; ++i) { const int k = i * 32 + (tid >> 4), n = (tid & 15) * 4;
                T[(n + 0) * 136 + k] = f2bf(v[i].x); T[(n + 1) * 136 + k] = f2bf(v[i].y); T[(n + 2) * 136 + k] = f2bf(v[i].z); T[(n + 3) * 136 + k] = f2bf(v[i].w); }
            __syncthreads();
            { const int n = tid >> 3, kc = (tid & 7) * 16;
              const u32x4 a = *(const u32x4*)(T + n * 136 + kc), b = *(const u32x4*)(T + n * 136 + kc + 8);
              bf16_t* dp = dst + bt * dstride + (size_t)drow(n0 + n) * Kd + k0 + kc;
              *(u32x4*)dp = a; *(u32x4*)(dp + 8) = b; }
        }
    }
    return 0;
}
__device__ __forceinline__ int moe_cvt(const Params& p, int layer, char* lds, int budget) {
    constexpr int QG = 2, T13 = NE * 8 * 44, TOT = T13 + NE * 11 * 16;
    bf16_t* T = (bf16_t*)lds;
    int* qslot = (int*)(lds + 64 * 136 * 2);
    const int tid = tidx();
    const float* w1 = p.moe_w1 + (size_t)layer * NE * D * FF; const float* w3 = p.moe_w3 + (size_t)layer * NE * D * FF; const float* w2 = p.moe_w2 + (size_t)layer * NE * FF * D;
    bf16_t* W13 = (bf16_t*)(p.ws + OFF_W13T + (size_t)(layer & 1) * SZ_WMOE); bf16_t* W2 = (bf16_t*)(p.ws + OFF_W2T + (size_t)(layer & 1) * SZ_WMOE);
    unsigned* queue = (unsigned*)(p.ws + OFF_QUEUE) + layer * 32;
    const bool ahead = budget < 0;
    int done = 0, tnext = 0;
    __syncthreads();
    if (tid == 0) qslot[0] = QG * (int)__hip_atomic_fetch_add(queue, 1u, __ATOMIC_RELAXED, __HIP_MEMORY_SCOPE_AGENT);
    __syncthreads();
    int t0 = __builtin_amdgcn_readfirstlane(qslot[0]);
    while (t0 < TOT && (ahead || done < budget)) {
        const bool more = ahead || done + 1 < budget;
        if (more && tid == 0) tnext = QG * (int)__hip_atomic_fetch_add(queue, 1u, __ATOMIC_RELAXED, __HIP_MEMORY_SCOPE_AGENT);
#pragma unroll 1
        for (int sub = 0; sub < QG; ++sub) {
            const int t = t0 + sub;
            const float* sp; bf16_t* dp; int ss, ds;
            if (t < T13) { const int e = t / 352, r = t % 352, k0 = (r & 7) * 128, n0 = (r >> 3) * 64; const int c0 = (n0 >> 8) * 128 + (n0 & 127);
                sp = (((n0 >> 7) & 1) ? w3 : w1) + ((size_t)e * D + k0) * FF + c0; ss = FF; dp = W13 + ((size_t)e * 2816 + n0) * D + k0; ds = D; }
            else { const int u = t - T13, e = u / 176, r = u % 176, k0 = (r % 11) * 128, n0 = (r / 11) * 64;
                sp = w2 + ((size_t)e * FF + k0) * D + n0; ss = D; dp = W2 + ((size_t)e * D + n0) * FF + k0; ds = FF; }
            float4 v[4];
#pragma unroll
            for (int i = 0; i < 4; ++i) v[i] = *(const float4*)(sp + (size_t)(i * 32 + (tid >> 4)) * ss + (tid & 15) * 4);
            __syncthreads();
#pragma unroll
            for (int i = 0; i < 4; ++i) { const int k = i * 32 + (tid >> 4), n = (tid & 15) * 4;
                T[(n + 0) * 136 + k] = f2bf(v[i].x); T[(n + 1) * 136 + k] = f2bf(v[i].y); T[(n + 2) * 136 + k] = f2bf(v[i].z); T[(n + 3) * 136 + k] = f2bf(v[i].w); }
            if (sub == QG - 1 && tid == 0) qslot[0] = more ? tnext : TOT;
            __syncthreads();
            { const int n = tid >> 3, kc = (tid & 7) * 16;
              const u32x4 a = *(const u32x4*)(T + n * 136 + kc), b = *(const u32x4*)(T + n * 136 + kc + 8);
              bf16_t* o = dp + (size_t)n * ds + kc;
              *(u32x4*)o = a; *(u32x4*)(o + 8) = b; }
        }
        ++done; t0 = __builtin_amdgcn_readfirstlane(qslot[0]);
    }
    __syncthreads();
    return done;
}
__device__ __forceinline__ void bg_cvt(const Params& p, int layer, char* lds, int budget) {
#pragma unroll 1
    for (int l = layer; l < 4 && l <= layer + 1 && budget > 0; ++l) budget -= moe_cvt(p, l, lds, budget);
}
__device__ __forceinline__ bool idle_tail(int nunits) { const int r = nunits % gdim(); return r != 0 && bidx() >= r; }
__device__ void ph_init(const Params& p, char* lds) {
    const int tid = tidx(), gtid = bidx() * NTHR + tid, gsz = gdim() * NTHR;
    xt_t* Xs = (xt_t*)(p.ws + OFF_X);
    const float4* x4 = (const float4*)p.x; const float4* c4 = (const float4*)p.ctx;
    { constexpr int NQ = NROW * 256 / 4;
      auto srcv = [&](int k) { return k < NLAT * 256 ? x4[k] : c4[k - NLAT * 256]; };
      for (int i = gtid; i < NQ; i += gsz) { const float4 t0 = srcv(i), t1 = srcv(i + NQ), t2 = srcv(i + 2 * NQ), t3 = srcv(i + 3 * NQ); xst(Xs, (size_t)4 * i, t0); xst(Xs, (size_t)4 * (i + NQ), t1); xst(Xs, (size_t)4 * (i + 2 * NQ), t2); xst(Xs, (size_t)4 * (i + 3 * NQ), t3); } }
    float* rc = (float*)(p.ws + OFF_ROPE_C); float* rs = (float*)(p.ws + OFF_ROPE_S);
    for (int i = gtid; i < TL * 32; i += gsz) {
        const int t = i >> 5, f = i & 31; const float pos = (float)((f < 16) ? (t >> 6) : (t & 63));
        const float inv = powf(10000.f, -(float)(f & 15) / 16.f); const float ang = pos * inv; rc[2 * i] = cosf(ang); rc[2 * i + 1] = sinf(ang);
    }
    float* sc = (float*)lds;
    float* red = sc + 5 * 1024;
    for (int i = tid; i < 5 * 1024; i += NTHR) { const float v = i < 4096 ? p.c[i] : p.c_ctx[i - 4096]; sc[i] = v / (1.f + expf(-v)); }
    __syncthreads();
    float* MOD = (float*)(p.ws + OFF_MOD);
    for (int item = bidx(); item < 4 * 96; item += gdim()) {
        const int l = item / 96, cg = item % 96, col = tid & 63, n = cg * 64 + col, kg = tid >> 6;
        const float* w = p.mod_w + ((size_t)l * 1024 + kg * 128) * 6144 + n;
        float a0 = 0, a1 = 0, a2 = 0, a3 = 0, a4 = 0;
#pragma unroll 16
        for (int k = 0; k < 128; ++k) { const float wv = w[(size_t)k * 6144]; const int kk = kg * 128 + k;
            a0 += sc[kk] * wv; a1 += sc[1024 + kk] * wv; a2 += sc[2048 + kk] * wv; a3 += sc[3072 + kk] * wv; a4 += sc[4096 + kk] * wv; }
        float* rr = red + (kg * 64 + col) * 5; rr[0] = a0; rr[1] = a1; rr[2] = a2; rr[3] = a3; rr[4] = a4;
        __syncthreads();
        if (tid < 320) { const int c2 = tid & 63, s = tid >> 6; float sum = 0;
            for (int q = 0; q < 8; ++q) sum += red[(q * 64 + c2) * 5 + s];
            MOD[((size_t)l * 5 + s) * 6144 + cg * 64 + c2] = sum + p.mod_b[l * 6144 + cg * 64 + c2]; }
        __syncthreads();
    }
}


__device__ void ph_small_cvt(const Params& p, char* lds) {
    int rot = 128;
    for (int j = 0; j < 2; ++j) {
        char* wm = p.ws + OFF_WMLA + j * SZ_WMLA; char* wr = p.ws + OFF_WRW + j * SZ_WRW;
        const float* w_in = p.mla_w_in + (size_t)j * D * 448; const float* w_uq = p.mla_w_uq + (size_t)j * 256 * 1536; const float* w_ukv = p.mla_w_ukv + (size_t)j * 128 * 2048; const float* w_o = p.mla_w_o + (size_t)j * D * D;
        cvt_tiles(p.wv, lds, (bf16_t*)(wm + WM_IN), 1024, 512, 1, 0, [=](int, int k, int n) -> const float* { return n < 448 ? w_in + (size_t)k * 448 + n : nullptr; },
                  [=](int n) { if (n < 384 || n >= 448) return n; const int jj = n - 384; return 384 + (jj < 32 ? 2 * jj : 2 * (jj - 32) + 1); }, &rot);
        cvt_tiles(p.wv, lds, (bf16_t*)(wm + WM_UQ), 256, 1536, 1, 0, [=](int, int k, int n) -> const float* { return w_uq + (size_t)k * 1536 + n; },
                  [=](int n) { const int h = n / 192, d = n % 192; if (d < 128) return n; const int jj = d - 128; return h * 192 + 128 + (jj < 32 ? 2 * jj : 2 * (jj - 32) + 1); }, &rot);
        cvt_tiles(p.wv, lds, (bf16_t*)(wm + WM_UKV), 128, 2048, 1, 0, [=](int, int k, int n) -> const float* { return w_ukv + (size_t)k * 2048 + n; }, [=](int n) { return n; }, &rot);
        cvt_tiles(p.wv, lds, (bf16_t*)(wm + WM_O), 1024, 1024, 1, 0, [=](int, int k, int n) -> const float* { return w_o + (size_t)k * D + n; }, [=](int n) { return n; }, &rot);
        const float* w_rkv = p.rw_w_rkv + (size_t)j * 3 * D * D; const float* w1 = p.rw_w1 + (size_t)j * 2 * D * 64; const float* a1 = p.rw_a1 + (size_t)j * 2 * D * 64;
        const float* g1 = p.rw_g1 + (size_t)j * D * 128; const float* v1 = p.rw_v1; const float* rwo = p.rw_w_o + (size_t)j * D * D;
        cvt_tiles(p.wv, lds, (bf16_t*)(wr + WR_RKV), 1024, 1024, 3, (size_t)D * D, [=](int m, int k, int n) -> const float* { return w_rkv + ((size_t)m * D + k) * D + n; }, [=](int n) { return n; }, &rot);
        cvt_tiles(p.wv, lds, (bf16_t*)(wr + WR_L), 1024, 256, 1, 0, [=](int, int k, int n) -> const float* { return n < 128 ? w1 + ((size_t)(n >> 6) * D + k) * 64 + (n & 63) : nullptr; }, [=](int n) { return n; }, &rot);
        cvt_tiles(p.wv, lds, (bf16_t*)(wr + WR_L) + 256 * 1024, 1024, 256, 1, 0, [=](int, int k, int n) -> const float* { return n < 128 ? a1 + ((size_t)(n >> 6) * D + k) * 64 + (n & 63) : nullptr; }, [=](int n) { return n; }, &rot);
        cvt_tiles(p.wv, lds, (bf16_t*)(wr + WR_L) + 2 * 256 * 1024, 1024, 256, 1, 0, [=](int, int k, int n) -> const float* { return n < 128 ? g1 + (size_t)k * 128 + n : nullptr; }, [=](int n) { return n; }, &rot);
        cvt_tiles(p.wv, lds, (bf16_t*)(wr + WR_L) + 3 * 256 * 1024, 1024, 256, 1, 0, [=](int, int k, int n) -> const float* { return n < 32 ? v1 + (size_t)k * 32 + n : nullptr; }, [=](int n) { return n; }, &rot);
        cvt_tiles(p.wv, lds, (bf16_t*)(wr + WR_O), 1024, 1024, 1, 0, [=](int, int k, int n) -> const float* { return rwo + (size_t)k * D + n; }, [=](int n) { return n; }, &rot);
        const float* w2 = p.rw_w2 + (size_t)j * 2 * 64 * D; const float* a2 = p.rw_a2 + (size_t)j * 2 * 64 * D; const float* g2 = p.rw_g2 + (size_t)j * 128 * D; const float* v2 = p.rw_v2;
        cvt_tiles(p.wv, lds, (bf16_t*)(wr + WR_B2), 128, 2048, 2, (size_t)2048 * 128, [=](int bt, int k, int n) -> const float* { const int zz = n >> 10, c = n & 1023, l = k - zz * 64;
            if (l < 0 || l >= 64) return nullptr; return (bt == 0 ? w2 : a2) + ((size_t)zz * 64 + l) * D + c; }, [=](int n) { return n; }, &rot);
        cvt_tiles(p.wv, lds, (bf16_t*)(wr + WR_B3), 128, 1024, 2, (size_t)1024 * 128, [=](int bt, int k, int n) -> const float* {
            if (bt == 0) return g2 + (size_t)k * D + n; return k < 32 ? v2 + (size_t)k * D + n : nullptr; }, [=](int n) { return n; }, &rot);
    }
}

template <bool OUTF32>
__device__ void ph_norm_mod(const Params& p, int layer, const float* g, int part_sh, int part_sc, void* outp) {
    const int wid = tidx() >> 6, lane = tidx() & 63;
    const xt_t* X = (const xt_t*)(p.ws + OFF_X);
    int row = bidx() * 8 + wid;
    float4 nv[4];
    if (row < NROW) {
#pragma unroll
        for (int i = 0; i < 4; ++i) nv[i] = xld(X, (size_t)row * D + (lane + i * 64) * 4); }
    for (; row < NROW; row += gdim() * 8) {
        const int s = row_stream(row);
        const float* sh = modp(p, layer, s, part_sh); const float* sc = modp(p, layer, s, part_sc);
        float4 v[4]; float ss = 0;
#pragma unroll
        for (int i = 0; i < 4; ++i) { v[i] = nv[i]; ss += v[i].x * v[i].x + v[i].y * v[i].y + v[i].z * v[i].z + v[i].w * v[i].w; }
        { const int nrow = row + gdim() * 8;
          if (nrow < NROW) {
#pragma unroll
              for (int i = 0; i < 4; ++i) nv[i] = xld(X, (size_t)nrow * D + (lane + i * 64) * 4); } }
        ss = wave_sum(ss); const float rs = rsqrtf(ss * (1.f / D) + RMS_EPS);
#pragma unroll
        for (int i = 0; i < 4; ++i) {
            const int d = (lane + i * 64) * 4;
            const float4 gg = *(const float4*)(g + d), a = *(const float4*)(sc + d), b = *(const float4*)(sh + d);
            float4 o; o.x = v[i].x * rs * gg.x * (1.f + a.x) + b.x; o.y = v[i].y * rs * gg.y * (1.f + a.y) + b.y; o.z = v[i].z * rs * gg.z * (1.f + a.z) + b.z; o.w = v[i].w * rs * gg.w * (1.f + a.w) + b.w;
            if (OUTF32) *(float4*)((float*)outp + (size_t)row * D + d) = o;
            else { uint2 w; w.x = pk2(o.x, o.y); w.y = pk2(o.z, o.w); *(uint2*)((bf16_t*)outp + (size_t)row * D + d) = w; }
        }
    }
}

__device__ void ph_mla_mid(const Params& p, int j) {
    const int wid = tidx() >> 6, lane = tidx() & 63;
    const float* Z = (const float*)(p.ws + OFF_Z);
    bf16_t* CQN = (bf16_t*)(p.ws + OFF_CQN); bf16_t* CKVN = (bf16_t*)(p.ws + OFF_CKVN); bf16_t* K = (bf16_t*)(p.ws + OFF_K);
    const float* gq = p.mla_g_q + j * 256; const float* gkv = p.mla_g_kv + j * 128;
    const float* rc = (const float*)(p.ws + OFF_ROPE_C); const float* rs = (const float*)(p.ws + OFF_ROPE_S);
    for (int row = bidx() * 8 + wid; row < NROW; row += gdim() * 8) {
        const float* z = Z + (size_t)row * 512;
        const float4 q = *(const float4*)(z + lane * 4);
        const float2 kv = *(const float2*)(z + 256 + lane * 2);
        const float kr = z[384 + lane];
        float sq = wave_sum(q.x * q.x + q.y * q.y + q.z * q.z + q.w * q.w); const float rq = rsqrtf(sq * (1.f / 256.f) + RMS_EPS);
        float sk = wave_sum(kv.x * kv.x + kv.y * kv.y); const float rk = rsqrtf(sk * (1.f / 128.f) + RMS_EPS);
        const float4 g4 = *(const float4*)(gq + lane * 4); const float2 g2 = *(const float2*)(gkv + lane * 2);
        uint2 w; w.x = pk2(q.x * rq * g4.x, q.y * rq * g4.y); w.y = pk2(q.z * rq * g4.z, q.w * rq * g4.w);
        *(uint2*)(CQN + (size_t)row * 256 + lane * 4) = w;
        *(unsigned*)(CKVN + (size_t)row * 128 + lane * 2) = pk2(kv.x * rk * g2.x, kv.y * rk * g2.y);
        float o = kr;
        const float other = __builtin_bit_cast(float, __builtin_amdgcn_update_dpp(0, __builtin_bit_cast(int, kr), 0xB1, 0xF, 0xF, true));
        const bool lat = row < NLAT;
        if (lat) { const int t = row & (TL - 1), i = lane >> 1; const float2 cs = *(const float2*)(rc + (t * 32 + i) * 2); const float c = cs.x, s = cs.y;
            o = (lane & 1) ? (other * s + kr * c) : (kr * c - other * s); }
        const int b = lat ? (row >> 12) : ((row - NLAT) >> 8); const int tk = lat ? 256 + (row & (TL - 1)) : ((row - NLAT) & 255);
        const bf16_t ob = f2bf(o);
#pragma unroll
        for (int h = 0; h < 8; ++h) K[((size_t)(b * 8 + h) * TK + tk) * 192 + 128 + lane] = ob;
    }
}

__device__ void ph_qkv_post(const Params& p) {
    const int wid = tidx() >> 6, lane = tidx() & 63;
    const float* QRAW = (const float*)(p.ws + OFF_QRAW); const float* KVRAW = (const float*)(p.ws + OFF_KVRAW); const float* KR = (const float*)(p.ws + OFF_KR);
    bf16_t* Q = (bf16_t*)(p.ws + OFF_Q); bf16_t* K = (bf16_t*)(p.ws + OFF_K); bf16_t* V = (bf16_t*)(p.ws + OFF_V);
    const float* rc = (const float*)(p.ws + OFF_ROPE_C); const float* rs = (const float*)(p.ws + OFF_ROPE_S);
    for (int it = bidx() * 8 + wid; it < NROW * 8; it += gdim() * 8) {
        const int row = it >> 3, h = it & 7;
        const bool lat = row < NLAT; const int b = lat ? (row >> 12) : ((row - NLAT) >> 8); const int tk = lat ? 256 + (row & (TL - 1)) : ((row - NLAT) & 255);
        const size_t orow = (size_t)(b * 8 + h) * TK + tk;
        const float* q = QRAW + (size_t)row * 1536 + h * 192;
        const float q0 = q[lane], q1 = q[64 + lane]; float q2 = q[128 + lane];
        const auto sw = __builtin_amdgcn_permlane32_swap(__float_as_uint(q2), __float_as_uint(q2), false, false);
        if (lat) { const int t = row & (TL - 1), i = lane & 31; const float c = rc[t * 32 + i], s = rs[t * 32 + i];
            const float x1 = __uint_as_float(sw[0]), x2 = __uint_as_float(sw[1]); q2 = lane < 32 ? (x1 * c - x2 * s) : (x1 * s + x2 * c); }
        bf16_t* qo = Q + orow * 192; qo[lane] = f2bf(q0); qo[64 + lane] = f2bf(q1); qo[128 + lane] = f2bf(q2);
        const float* kv = KVRAW + (size_t)row * 2048 + h * 256;
        bf16_t* ko = K + orow * 192; ko[lane] = f2bf(kv[lane]); ko[64 + lane] = f2bf(kv[64 + lane]); ko[128 + lane] = f2bf(KR[(size_t)row * 64 + lane]);
        bf16_t* vo = V + orow * 128; vo[lane] = f2bf(kv[128 + lane]); vo[64 + lane] = f2bf(kv[192 + lane]);
    }
}

__device__ void ph_attn_naive(const Params& p, char* lds) {
    const int tid = tidx(), qi = tid >> 2, part = tid & 3;
    const bf16_t* Q = (const bf16_t*)(p.ws + OFF_Q); const bf16_t* K = (const bf16_t*)(p.ws + OFF_K); const bf16_t* V = (const bf16_t*)(p.ws + OFF_V);
    bf16_t* O = (bf16_t*)(p.ws + OFF_O);
    bf16_t* Ks = (bf16_t*)lds;
    bf16_t* Vs = Ks + 32 * 192;
    const int nitems = 32 * 34;
    for (int it = bidx(); it < nitems; it += gdim()) {
        const int bh = it / 34, qb = it % 34; const int b = bh >> 3, h = bh & 7;
        const int nkeys = qb < 2 ? TC : TK;
        const int tq = qb * 128 + qi;
        const bf16_t* qp = Q + ((size_t)bh * TK + tq) * 192 + part * 48;
        float q[48];
#pragma unroll
        for (int i = 0; i < 48; ++i) q[i] = bf2f(qp[i]) * ATT_SCALE;
        float o[32];
#pragma unroll
        for (int i = 0; i < 32; ++i) o[i] = 0.f;
        float m = -1e30f, l = 0.f;
        for (int k0 = 0; k0 < nkeys; k0 += 32) {
            __syncthreads();
            {
                const bf16_t* kg = K + ((size_t)bh * TK + k0) * 192; const bf16_t* vg = V + ((size_t)bh * TK + k0) * 128;
                for (int c = tid; c < 768; c += NTHR) *(u32x4*)(Ks + c * 8) = *(const u32x4*)(kg + c * 8);
                *(u32x4*)(Vs + tid * 8) = *(const u32x4*)(vg + tid * 8);
            }
            __syncthreads();
#pragma unroll 1
            for (int kg = 0; kg < 32; kg += 8) {
                float s[8]; float tmax = -1e30f;
#pragma unroll
                for (int kk = 0; kk < 8; ++kk) {
                    const bf16_t* kr = Ks + (kg + kk) * 192 + part * 48; float acc = 0.f;
#pragma unroll
                    for (int i = 0; i < 48; ++i) acc += q[i] * bf2f(kr[i]);
                    acc += __shfl_xor(acc, 1); acc += __shfl_xor(acc, 2);
                    s[kk] = acc; tmax = fmaxf(tmax, acc);
                    asm volatile("" ::: "memory");
                }
                const float mn = fmaxf(m, tmax), alpha = expf(m - mn); m = mn; l *= alpha;
#pragma unroll
                for (int i = 0; i < 32; ++i) o[i] *= alpha;
#pragma unroll
                for (int kk = 0; kk < 8; ++kk) {
                    const float pw = expf(s[kk] - mn); l += pw;
                    const bf16_t* vr = Vs + (kg + kk) * 128 + part * 32;
#pragma unroll
                    for (int i = 0; i < 32; ++i) o[i] += pw * bf2f(vr[i]);
                    asm volatile("" ::: "memory");
                }
            }
        }
        const float rl = 1.f / l;
        const int row = qb < 2 ? (NLAT + b * TC + tq) : (b * TL + tq - TC);
        bf16_t* op = O + (size_t)row * D + h * 128 + part * 32;
#pragma unroll
        for (int i = 0; i < 32; ++i) op[i] = f2bf(o[i] * rl);
    }
}


namespace fa {
using s16x4  = __attribute__((ext_vector_type(4))) short;
using f32x16 = __attribute__((ext_vector_type(16))) float;
constexpr int DQK = 192, DV = 128, KVBLK = 64;
constexpr float THR = 8.f;
constexpr int SHM_V = KVBLK * DV * 2, SHM_K = KVBLK * DQK * 2;
constexpr int SHM_ATTN = 2 * SHM_V + 2 * SHM_K + 8 * 64 * 4;
#define KSWZ(row, colB) ((row) * 384 + ((colB) ^ ((((row) >> 1) & 7) << 4)))
#define SBAR() __builtin_amdgcn_sched_barrier(0)
__device__ __forceinline__ int crow(int r, int hi) { return (r & 3) + 8 * (r >> 2) + 4 * hi; }
__device__ __forceinline__ unsigned cvtpk(float lo, float hi) { unsigned r; asm volatile("v_cvt_pk_bf16_f32 %0, %1, %2" : "=v"(r) : "v"(lo), "v"(hi)); return r; }
__device__ __forceinline__ void partialSM(f32x16& p0, f32x16& p1, float& m_reg, float& mn, float& alpha) {
  constexpr float C = ATT_SCALE * 1.4426950408889634f;
  float pmax = p0[0];
#pragma unroll
  for (int r = 1; r < 16; ++r) pmax = fmaxf(pmax, p0[r]);
#pragma unroll
  for (int r = 0; r < 16; ++r) pmax = fmaxf(pmax, p1[r]);
  { auto rr = __builtin_amdgcn_permlane32_swap(__float_as_uint(pmax), __float_as_uint(pmax), false, false);
    pmax = fmaxf(__uint_as_float(rr[0]), __uint_as_float(rr[1])); }
  if (__builtin_expect(__all(pmax - m_reg <= THR / ATT_SCALE), 1)) { mn = m_reg; alpha = 1.f; }
  else { mn = fmaxf(m_reg, pmax); alpha = __builtin_amdgcn_exp2f((m_reg - mn) * C); m_reg = mn; }
  float mnC = -mn * C;
#pragma unroll
  for (int r = 0; r < 16; ++r) p0[r] = fmaf(p0[r], C, mnC);
#pragma unroll
  for (int r = 0; r < 16; ++r) p1[r] = fmaf(p1[r], C, mnC);
#pragma unroll
  for (int r = 0; r < 16; ++r) p0[r] = __builtin_amdgcn_exp2f(p0[r]);
}
__device__ __forceinline__ void finishSM(f32x16& p0, f32x16& p1, float alpha, float& l_reg, bf16x8& pa0, bf16x8& pa1, bf16x8& pa2, bf16x8& pa3) {
#pragma unroll
  for (int r = 0; r < 16; ++r) p1[r] = __builtin_amdgcn_exp2f(p1[r]);
  float ps = 0;
#pragma unroll
  for (int r = 0; r < 16; ++r) ps += p0[r];
#pragma unroll
  for (int r = 0; r < 16; ++r) ps += p1[r];
  { auto rr = __builtin_amdgcn_permlane32_swap(__float_as_uint(ps), __float_as_uint(ps), false, false);
    ps = __uint_as_float(rr[0]) + __uint_as_float(rr[1]); }
  l_reg = l_reg * alpha + ps;
#define PK4(P, BASE, OUT) do { unsigned a0 = cvtpk(P[BASE + 0], P[BASE + 1]), a1 = cvtpk(P[BASE + 2], P[BASE + 3]);   \
    unsigned b0 = cvtpk(P[BASE + 4], P[BASE + 5]), b1 = cvtpk(P[BASE + 6], P[BASE + 7]);                              \
    auto r0 = __builtin_amdgcn_permlane32_swap(a0, b0, false, false); auto r1 = __builtin_amdgcn_permlane32_swap(a1, b1, false, false); \
    u32x4 w = {r0[0], r1[0], r0[1], r1[1]}; OUT = *reinterpret_cast<bf16x8*>(&w); } while (0)
  PK4(p0, 0, pa0); PK4(p0, 8, pa1); PK4(p1, 0, pa2); PK4(p1, 8, pa3);
#undef PK4
}
__device__ __forceinline__ void qkt(f32x16& p0, f32x16& p1, const char* Ks, const bf16x8* qr, int r32, int hi) {
  p0 = f32x16{}; p1 = f32x16{};
  const int swz = ((r32 >> 1) & 7) << 4;
  const char* b4[4];
#pragma unroll
  for (int dr = 0; dr < 4; ++dr) b4[dr] = Ks + r32 * 384 + ((dr * 32 + hi * 16) ^ swz);
#pragma unroll
  for (int d0 = 0; d0 < 12; ++d0) {
    bf16x8 b0 = *reinterpret_cast<const bf16x8*>(b4[d0 & 3] + (d0 >> 2) * 128);
    bf16x8 b1 = *reinterpret_cast<const bf16x8*>(b4[d0 & 3] + (d0 >> 2) * 128 + 32 * 384);
    p0 = __builtin_amdgcn_mfma_f32_32x32x16_bf16(b0, qr[d0], p0, 0, 0, 0);
    p1 = __builtin_amdgcn_mfma_f32_32x32x16_bf16(b1, qr[d0], p1, 0, 0, 0); }
}
__device__ __forceinline__ int v_st(int k, int c) { const int kk = (k & ~0xC) | ((k & 4) << 1) | ((k & 8) >> 1); return ((kk >> 3) * 4 + (c >> 5)) * 512 + ((kk & 7) * 32 + (c & 31)) * 2; }
__device__ __forceinline__ int v_rd_base(int lane) { return ((lane & 3) << 3) | (((lane >> 2) & 3) << 6) | (((lane >> 4) & 1) << 5) | (((lane >> 5) & 1) << 8); }
constexpr int v_rd_off(int d0, int ks, int half) { return d0 * 512 + ks * 4096 + half * 2048; }
template <int OFF> __device__ __forceinline__ s16x4 tr_read(int vb) {
  s16x4 r; asm volatile("ds_read_b64_tr_b16 %0, %1 offset:%2" : "=&v"(r) : "v"(vb), "i"(OFF) : "memory"); return r;
}
template <int D0> __device__ __forceinline__ void pv_one(f32x16& od, int vb, bf16x8 pa0, bf16x8 pa1, bf16x8 pa2, bf16x8 pa3) {
  const s16x4 l0 = tr_read<v_rd_off(D0, 0, 0)>(vb), h0 = tr_read<v_rd_off(D0, 0, 1)>(vb), l1 = tr_read<v_rd_off(D0, 1, 0)>(vb), h1 = tr_read<v_rd_off(D0, 1, 1)>(vb);
  const s16x4 l2 = tr_read<v_rd_off(D0, 2, 0)>(vb), h2 = tr_read<v_rd_off(D0, 2, 1)>(vb), l3 = tr_read<v_rd_off(D0, 3, 0)>(vb), h3 = tr_read<v_rd_off(D0, 3, 1)>(vb);
  asm volatile("s_waitcnt lgkmcnt(0)" ::: "memory"); SBAR();
#define PK(L, H) (bf16x8){L[0], L[1], L[2], L[3], H[0], H[1], H[2], H[3]}
  od = __builtin_amdgcn_mfma_f32_32x32x16_bf16(pa0, PK(l0, h0), od, 0, 0, 0);
  od = __builtin_amdgcn_mfma_f32_32x32x16_bf16(pa1, PK(l1, h1), od, 0, 0, 0);
  od = __builtin_amdgcn_mfma_f32_32x32x16_bf16(pa2, PK(l2, h2), od, 0, 0, 0);
  od = __builtin_amdgcn_mfma_f32_32x32x16_bf16(pa3, PK(l3, h3), od, 0, 0, 0);
#undef PK
}
__device__ __forceinline__ void pv_d0(f32x16* o, int vb, bf16x8 pa0, bf16x8 pa1, bf16x8 pa2, bf16x8 pa3) {
  pv_one<0>(o[0], vb, pa0, pa1, pa2, pa3); pv_one<1>(o[1], vb, pa0, pa1, pa2, pa3); pv_one<2>(o[2], vb, pa0, pa1, pa2, pa3); pv_one<3>(o[3], vb, pa0, pa1, pa2, pa3);
}
__device__ __forceinline__ void attn_body(const int wv_, const bf16_t* __restrict__ Qb, const bf16_t* __restrict__ Kh, const bf16_t* __restrict__ Vh, bf16_t* __restrict__ Ob, int ldo, int seq, char* lds, const float* __restrict__ ropecs  ) {
  const int tid = tidx_w(wv_), wid = tid >> 6, lane = tid & 63, r32 = lane & 31, hi = lane >> 5;
  char* V_lds = lds; char* K_lds = lds + 2 * SHM_V;
  float* ws = (float*)(lds + 2 * SHM_V + 2 * SHM_K) + wid * 64; float* li_l = ws; float* al_l = ws + 32;
  float m_reg = -1e30f, l_reg = 0; f32x16 o[4] = {}; bf16x8 qr[12];
  const bf16_t* Qw = Qb + (long)(wid * 32 + r32) * DQK + hi * 8;
#pragma unroll
  for (int d0 = 0; d0 < 12; ++d0) qr[d0] = *reinterpret_cast<const bf16x8*>(Qw + d0 * 16);
  if (ropecs) {
    const float* cs = ropecs + (size_t)(wid * 32 + r32) * 64;
#pragma unroll
    for (int d0 = 8; d0 < 12; ++d0) { const int i0 = (d0 - 8) * 8 + hi * 4; const f32x4 c0 = *(const f32x4*)(cs + i0 * 2), c1 = *(const f32x4*)(cs + i0 * 2 + 4);
      u32x4 w = *reinterpret_cast<u32x4*>(&qr[d0]); const float cc[4] = {c0[0], c0[2], c1[0], c1[2]}, ss[4] = {c0[1], c0[3], c1[1], c1[3]};
#pragma unroll
      for (int m = 0; m < 4; ++m) { const float x1 = __uint_as_float(w[m] << 16), x2 = __uint_as_float(w[m] & 0xffff0000u); w[m] = cvtpk(x1 * cc[m] - x2 * ss[m], x1 * ss[m] + x2 * cc[m]); }
      qr[d0] = *reinterpret_cast<bf16x8*>(&w); }
  }
  const int sr = tid >> 4, sc = (tid & 15) * 8, vst0 = v_st(sr, sc), vst1 = v_st(32 + sr, sc);
  int kst[3];
#pragma unroll
  for (int i = 0; i < 3; ++i) { const int c = tid + 512 * i, row = c / 24, cc = c % 24; kst[i] = KSWZ(row, cc * 16); }
  const int vb0 = (int)(uintptr_t)V_lds + v_rd_base(lane);
  struct { bf16x8 vs0, vs1, ks0, ks1, ks2; } sr_[1];
#define SLOAD(i, k0) do { const bf16_t* vt = Vh + (long)(k0) * DV; const bf16_t* kt = Kh + (long)(k0) * DQK; \
    sr_[i].vs0 = *reinterpret_cast<const bf16x8*>(vt + (sr) * DV + sc); sr_[i].vs1 = *reinterpret_cast<const bf16x8*>(vt + (32 + sr) * DV + sc); \
    sr_[i].ks0 = *reinterpret_cast<const bf16x8*>(kt + tid * 8); sr_[i].ks1 = *reinterpret_cast<const bf16x8*>(kt + (tid + 512) * 8); sr_[i].ks2 = *reinterpret_cast<const bf16x8*>(kt + (tid + 1024) * 8); } while (0)
#define SWRITE(b, i) do { *(bf16x8*)(V_lds + (b) * SHM_V + vst0) = sr_[i].vs0; *(bf16x8*)(V_lds + (b) * SHM_V + vst1) = sr_[i].vs1; \
    *(bf16x8*)(K_lds + (b) * SHM_K + kst[0]) = sr_[i].ks0; *(bf16x8*)(K_lds + (b) * SHM_K + kst[1]) = sr_[i].ks1; *(bf16x8*)(K_lds + (b) * SHM_K + kst[2]) = sr_[i].ks2; } while (0)
#define SWAIT() asm volatile("s_waitcnt vmcnt(5)" ::: "memory")
#define RESC(a) do { if (__any((a) < 1.f)) { if (hi == 0) al_l[r32] = (a); asm volatile("s_waitcnt lgkmcnt(0)" ::: "memory"); \
    _Pragma("unroll") for (int d = 0; d < 4; ++d) _Pragma("unroll") for (int r = 0; r < 16; ++r) o[d][r] *= al_l[crow(r, hi)]; } } while (0)
  f32x16 pA0, pA1; float mnA, alA; bf16x8 pa0, pa1, pa2, pa3; const int NT = seq / KVBLK;
  SLOAD(0, 0); SWRITE(0, 0);
  SLOAD(0, KVBLK);
  __syncthreads();
  for (int j = 0; j < NT; j += 2) {
    SBAR(); qkt(pA0, pA1, K_lds, qr, r32, hi);
    partialSM(pA0, pA1, m_reg, mnA, alA); RESC(alA);
    finishSM(pA0, pA1, alA, l_reg, pa0, pa1, pa2, pa3); SBAR();
    SWRITE(1, 0);
    if (j + 2 < NT) SLOAD(0, (j + 2) * KVBLK);
    SBAR();
    pv_d0(o, vb0, pa0, pa1, pa2, pa3);
    __syncthreads();
    SBAR(); qkt(pA0, pA1, K_lds + SHM_K, qr, r32, hi);
    partialSM(pA0, pA1, m_reg, mnA, alA); RESC(alA);
    finishSM(pA0, pA1, alA, l_reg, pa0, pa1, pa2, pa3); SBAR();
    if (j + 2 < NT) { SWRITE(0, 0); if (j + 3 < NT) SLOAD(0, (j + 3) * KVBLK); }
    SBAR();
    pv_d0(o, vb0 + SHM_V, pa0, pa1, pa2, pa3);
    __syncthreads();
  }
  if (hi == 0) li_l[r32] = l_reg; asm volatile("s_waitcnt lgkmcnt(0)" ::: "memory");
  float rli[16];
#pragma unroll
  for (int r = 0; r < 16; ++r) rli[r] = __builtin_amdgcn_rcpf(li_l[crow(r, hi)]);
  bf16_t* Ow = Ob + (long)(wid * 32) * ldo;
#pragma unroll
  for (int r = 0; r < 16; ++r) { int orow = crow(r, hi);
#pragma unroll
    for (int d0 = 0; d0 < 4; ++d0) Ow[(long)orow * ldo + d0 * 32 + r32] = f2bf(o[d0][r] * rli[r]); }
  __syncthreads();
#undef SLOAD
#undef SWRITE
#undef SWAIT
#undef RESC
}
#undef KSWZ
}

__device__ void ph_attn(const Params& p, char* lds) {
    const bf16_t* Q = (const bf16_t*)(p.ws + OFF_Q); const bf16_t* K = (const bf16_t*)(p.ws + OFF_K); const bf16_t* V = (const bf16_t*)(p.ws + OFF_V);
    bf16_t* O = (bf16_t*)(p.ws + OFF_O);
    const int G = gdim();
    for (int i = 0;; ++i) {
        const int L = i * G + bidx(); if (L >= 544) break;
        int bh, qb;
        if (L < 512) { const int w = g8::xcd_remap(L, 512); bh = w >> 4; qb = 1 + (w & 15); } else { bh = L - 512; qb = 0; }
        const int b = bh >> 3, h = bh & 7;
        const int seq = qb == 0 ? TC : TK;
        const int row0 = qb == 0 ? NLAT + b * TC : b * TL + (qb - 1) * 256;
        fa::attn_body(p.wv, Q + ((size_t)bh * TK + qb * 256) * 192, K + (size_t)bh * TK * 192, V + (size_t)bh * TK * 128, O + (size_t)row0 * D + h * 128, D, seq, lds,
                      qb == 0 ? nullptr : (const float*)(p.ws + OFF_ROPE_C) + (size_t)(qb - 1) * 256 * 64);
    }
}

__device__ void ph_norm2_router(const Params& p, int layer, char* lds, int nrows) {
    const int tid = tidx(), wid = tid >> 6, lane = tid & 63;
    float* rt = (float*)lds;
    const float* rg = p.moe_router + (size_t)layer * D * NE;
    for (int i = tid; i < D * NE / 4; i += NTHR) { const int d = i >> 2, eq = i & 3; ((float4*)rt)[(((d >> 8) * 4 + (d & 3)) * 4 + eq) * 64 + ((d & 255) >> 2)] = ((const float4*)rg)[i]; }
    __syncthreads();
    const xt_t* X = (const xt_t*)(p.ws + OFF_X); bf16_t* BN = (bf16_t*)(p.ws + OFF_H); float* AFF = (float*)(p.ws + OFF_AFF);
    const float* g = p.norm2_g + layer * D;
    int row = bidx() * 8 + wid;
    float4 nv[4];
    if (row < nrows) {
#pragma unroll
        for (int i = 0; i < 4; ++i) nv[i] = xld(X, (size_t)row * D + (lane + i * 64) * 4); }
    for (; row < nrows; row += gdim() * 8) {
        const int s = row_stream(row);
        const float* sh = modp(p, layer, s, 3); const float* sc = modp(p, layer, s, 4);
        float4 v[4]; float ss = 0;
#pragma unroll
        for (int i = 0; i < 4; ++i) { v[i] = nv[i]; ss += v[i].x * v[i].x + v[i].y * v[i].y + v[i].z * v[i].z + v[i].w * v[i].w; }
        { const int nrow = row + gdim() * 8;
          if (nrow < nrows) {
#pragma unroll
              for (int i = 0; i < 4; ++i) nv[i] = xld(X, (size_t)nrow * D + (lane + i * 64) * 4); } }
        ss = wave_sum(ss); const float rs = rsqrtf(ss * (1.f / D) + RMS_EPS);
        float lg[16];
#pragma unroll
        for (int e = 0; e < 16; ++e) lg[e] = 0.f;
#pragma unroll
        for (int i = 0; i < 4; ++i) {
            const int d = (lane + i * 64) * 4;
            const float4 gg = *(const float4*)(g + d), a = *(const float4*)(sc + d), b = *(const float4*)(sh + d);
            float o[4]; o[0] = v[i].x * rs * gg.x * (1.f + a.x) + b.x; o[1] = v[i].y * rs * gg.y * (1.f + a.y) + b.y; o[2] = v[i].z * rs * gg.z * (1.f + a.z) + b.z; o[3] = v[i].w * rs * gg.w * (1.f + a.w) + b.w;
            uint2 w; w.x = pk2(o[0], o[1]); w.y = pk2(o[2], o[3]); *(uint2*)(BN + (size_t)row * D + d) = w;
#pragma unroll
            for (int jj = 0; jj < 4; ++jj) {
#pragma unroll
                for (int eq = 0; eq < 4; ++eq) { const float4 r4 = ((const float4*)rt)[((i * 4 + jj) * 4 + eq) * 64 + lane];
                    lg[4 * eq] += o[jj] * r4.x; lg[4 * eq + 1] += o[jj] * r4.y; lg[4 * eq + 2] += o[jj] * r4.z; lg[4 * eq + 3] += o[jj] * r4.w; } }
            asm volatile("" ::: "memory");
        }
        float mx = -1e30f;
#pragma unroll
        for (int e = 0; e < 16; ++e) { lg[e] = wave_sum(lg[e]); mx = fmaxf(mx, lg[e]); }
        float sum = 0;
#pragma unroll
        for (int e = 0; e < 16; ++e) { lg[e] = expf(lg[e] - mx); sum += lg[e]; }
        const float inv = 1.f / sum;
        if (lane < 16) { float val = 0;
#pragma unroll
            for (int e = 0; e < 16; ++e) val = (lane == e) ? lg[e] : val;
            AFF[(size_t)row * 16 + lane] = val * inv; }
    }
}

__device__ void ph_select(const Params& p, char* lds, int ngroups) {
    const int tid = tidx(), wid = tid >> 6, lane = tid & 63;
    unsigned* hist = (unsigned*)lds;
    unsigned* ctl = hist + 256;
    unsigned* wsum = ctl + 8;
    int* rowl = (int*)(wsum + 16);
    const float* AFF = (const float*)(p.ws + OFF_AFF);
    int* ROWIDX = (int*)(p.ws + OFF_ROWIDX); float* GATE = (float*)(p.ws + OFF_GATE); int* SLOT = (int*)(p.ws + OFF_SLOT);
    for (int gidx = bidx(); gidx < ngroups; gidx += gdim()) {
        const bool lat = gidx < 64; const int b = (gidx & 63) >> 4, e = gidx & 15;
        const int n = lat ? TL : TC, cap = lat ? CAPL : CAPC;
        const int row0 = lat ? b * TL : NLAT + b * TC, slot0 = lat ? b * CAPL : NB * CAPL + b * CAPC;
        unsigned key[8];
#pragma unroll
        for (int i = 0; i < 8; ++i) { const int idx = tid * 8 + i; key[i] = idx < n ? __float_as_uint(AFF[(size_t)(row0 + idx) * 16 + e]) : 0u; }
        unsigned prefix = 0u, remaining = (unsigned)cap;
#pragma unroll
        for (int pass = 0; pass < 4; ++pass) {
            const int sh = 24 - 8 * pass;
            __syncthreads();
            if (tid < 256) hist[tid] = 0u;
            __syncthreads();
#pragma unroll
            for (int i = 0; i < 8; ++i) { const int idx = tid * 8 + i;
                const bool cand = idx < n && (pass == 0 || (key[i] >> (sh + 8)) == prefix);
                if (cand) atomicAdd(&hist[(key[i] >> sh) & 255u], 1u); }
            __syncthreads();
            if (tid < 256) { unsigned gt = 0; for (int jj = tid + 1; jj < 256; ++jj) gt += hist[jj];
                const unsigned mine = hist[tid];
                if (gt < remaining && remaining <= gt + mine) { ctl[0] = (unsigned)tid; ctl[1] = remaining - gt; } }
            __syncthreads();
            prefix = (prefix << 8) | ctl[0]; remaining = ctl[1];
        }
        const unsigned T = prefix, m = remaining;
        unsigned cgt = 0, ceq = 0;
#pragma unroll
        for (int i = 0; i < 8; ++i) { const int idx = tid * 8 + i; if (idx < n) { cgt += key[i] > T ? 1u : 0u; ceq += key[i] == T ? 1u : 0u; } }
        auto block_excl = [&](unsigned v) -> unsigned {
            unsigned inc = v;
#pragma unroll
            for (int o = 1; o < 64; o <<= 1) { const unsigned t = (unsigned)__builtin_amdgcn_ds_bpermute((lane - o) << 2, (int)inc); if (lane >= o) inc += t; }
            __syncthreads();
            if (lane == 63) wsum[wid] = inc;
            __syncthreads();
            unsigned base = 0;
#pragma unroll
            for (int w = 0; w < 8; ++w) base += (w < wid) ? wsum[w] : 0u;
            return base + inc - v; };
        unsigned eqbase = block_excl(ceq);
        unsigned nsel = 0; bool sel[8];
#pragma unroll
        for (int i = 0; i < 8; ++i) { const int idx = tid * 8 + i; bool s_ = false;
            if (idx < n) { if (key[i] > T) s_ = true; else if (key[i] == T) { s_ = eqbase < m; ++eqbase; } }
            sel[i] = s_; nsel += s_ ? 1u : 0u; }
        unsigned sbase = block_excl(nsel);
#pragma unroll
        for (int i = 0; i < 8; ++i) { const int idx = tid * 8 + i;
            if (idx < n) {
                if (sel[i]) { const int sl = slot0 + (int)sbase; rowl[sbase] = row0 + idx; ++sbase; ROWIDX[e * ESLOTS + sl] = row0 + idx; GATE[e * EPAD + sl] = __uint_as_float(key[i]); SLOT[(size_t)(row0 + idx) * 16 + e] = sl; }
                else SLOT[(size_t)(row0 + idx) * 16 + e] = -1; } }
        __syncthreads();
        { const bf16_t* BN = (const bf16_t*)(p.ws + OFF_H); bf16_t* XE = (bf16_t*)(p.ws + OFF_XE);
          for (int r = wid; r < cap; r += 32) {
              u32x4 t_[4][2];
#pragma unroll
              for (int u = 0; u < 4; ++u) { const u32x4* src = (const u32x4*)(BN + (size_t)rowl[r + 8 * u] * D); t_[u][0] = src[lane]; t_[u][1] = src[lane + 64]; }
#pragma unroll
              for (int u = 0; u < 4; ++u) { u32x4* dst = (u32x4*)(XE + ((size_t)e * EPAD + slot0 + r + 8 * u) * D); dst[lane] = t_[u][0]; dst[lane + 64] = t_[u][1]; } } }
    }
}

__device__ void ph_gather(const Params& p, int nslots) {
    const int wid = tidx() >> 6, lane = tidx() & 63;
    const int* ROWIDX = (const int*)(p.ws + OFF_ROWIDX); const bf16_t* BN = (const bf16_t*)(p.ws + OFF_H); bf16_t* XE = (bf16_t*)(p.ws + OFF_XE);
    for (int it = bidx() * 8 + wid; it < NE * ESLOTS; it += gdim() * 8) {
        const int e = it / ESLOTS, sl = it % ESLOTS; if (sl >= nslots) continue; const int row = ROWIDX[it];
        const u32x4* src = (const u32x4*)(BN + (size_t)row * D); u32x4* dst = (u32x4*)(XE + ((size_t)e * EPAD + sl) * D);
        dst[lane] = src[lane]; dst[lane + 64] = src[lane + 64];
    }
}

__device__ void ph_combine(const Params& p, int layer, int nrows) {
    const int wid = tidx() >> 6, lane = tidx() & 63;
    const int* SLOT = (const int*)(p.ws + OFF_SLOT); const bf16_t* YE = (const bf16_t*)(p.ws + OFF_YE); xt_t* X = (xt_t*)(p.ws + OFF_X);
    int row = bidx() * 8 + wid;
    int sl = (row < nrows && lane < 16) ? SLOT[(size_t)row * 16 + lane] : -1;
    while (row < nrows) {
        const int nrow = row + gdim() * 8;
        const int sln = (nrow < nrows && lane < 16) ? SLOT[(size_t)nrow * 16 + lane] : -1;
        const float* gt = modp(p, layer, row_stream(row), 5);
        xt_t* xr = X + (size_t)row * D + lane * 8;
        f32x4 xv[4];
#pragma unroll
        for (int i = 0; i < 2; ++i) { xv[2 * i] = xldv(xr, 512 * i); xv[2 * i + 1] = xldv(xr, 512 * i + 4); }
        unsigned long long m = __ballot(sl >= 0);
        float acc[16];
#pragma unroll
        for (int i = 0; i < 16; ++i) acc[i] = 0.f;
        while (m) {
            const int e0 = __builtin_ctzll(m); m &= m - 1; const bool two = m != 0; const int e1 = two ? __builtin_ctzll(m) : e0; if (two) m &= m - 1;
            const int s0 = __builtin_amdgcn_readlane(sl, e0), s1 = __builtin_amdgcn_readlane(sl, e1);
            const bf16_t* y0 = YE + ((size_t)e0 * EPAD + s0) * D + lane * 8; const bf16_t* y1 = YE + ((size_t)e1 * EPAD + s1) * D + lane * 8;
            const u32x4 a0 = *(const u32x4*)y0, a1 = *(const u32x4*)(y0 + 512), b0 = *(const u32x4*)y1, b1 = *(const u32x4*)(y1 + 512);
            const float f1 = two ? 1.f : 0.f;
#pragma unroll
            for (int i = 0; i < 4; ++i) { acc[2 * i] += __uint_as_float(a0[i] << 16) + f1 * __uint_as_float(b0[i] << 16); acc[2 * i + 1] += __uint_as_float(a0[i] & 0xffff0000u) + f1 * __uint_as_float(b0[i] & 0xffff0000u);
                acc[8 + 2 * i] += __uint_as_float(a1[i] << 16) + f1 * __uint_as_float(b1[i] << 16); acc[8 + 2 * i + 1] += __uint_as_float(a1[i] & 0xffff0000u) + f1 * __uint_as_float(b1[i] & 0xffff0000u); }
        }
#pragma unroll
        for (int i = 0; i < 2; ++i) { const f32x4 g0 = *(const f32x4*)(gt + lane * 8 + 512 * i), g1 = *(const f32x4*)(gt + lane * 8 + 512 * i + 4);
            f32x4 o0 = xv[2 * i], o1 = xv[2 * i + 1];
#pragma unroll
            for (int e = 0; e < 4; ++e) { o0[e] += g0[e] * acc[8 * i + e]; o1[e] += g1[e] * acc[8 * i + 4 + e]; }
            xstv(xr, 512 * i, o0); xstv(xr, 512 * i + 4, o1); }
        row = nrow; sl = sln;
    }
}

template <bool FINAL>
__device__ void ph_comb_norm(const Params& p, int lprev, int layer, int nrows) {
    const int wid = tidx() >> 6, lane = tidx() & 63;
    const int* SLOT = (const int*)(p.ws + OFF_SLOT); const bf16_t* YE = (const bf16_t*)(p.ws + OFF_YE); xt_t* X = (xt_t*)(p.ws + OFF_X);
    bf16_t* H = (bf16_t*)(p.ws + OFF_H);
    const float* g = FINAL ? p.final_g : p.norm1_g + layer * D;
    int row = bidx() * 8 + wid;
    int sl = (row < nrows && lane < 16) ? SLOT[(size_t)row * 16 + lane] : -1;
    while (row < nrows) {
        const int nrow = row + gdim() * 8;
        const int sln = (nrow < nrows && lane < 16) ? SLOT[(size_t)nrow * 16 + lane] : -1;
        const int strm = row_stream(row);
        const float* gt = modp(p, lprev, strm, 5);
        xt_t* xr = X + (size_t)row * D + lane * 8;
        f32x4 xv[4];
#pragma unroll
        for (int i = 0; i < 2; ++i) { xv[2 * i] = xldv(xr, 512 * i); xv[2 * i + 1] = xldv(xr, 512 * i + 4); }
        unsigned long long m = __ballot(sl >= 0);
        float acc[16];
#pragma unroll
        for (int i = 0; i < 16; ++i) acc[i] = 0.f;
        while (m) {
            const int e0 = __builtin_ctzll(m); m &= m - 1; const bool two = m != 0; const int e1 = two ? __builtin_ctzll(m) : e0; if (two) m &= m - 1;
            const int s0 = __builtin_amdgcn_readlane(sl, e0), s1 = __builtin_amdgcn_readlane(sl, e1);
            const bf16_t* y0 = YE + ((size_t)e0 * EPAD + s0) * D + lane * 8; const bf16_t* y1 = YE + ((size_t)e1 * EPAD + s1) * D + lane * 8;
            const u32x4 a0 = *(const u32x4*)y0, a1 = *(const u32x4*)(y0 + 512), b0 = *(const u32x4*)y1, b1 = *(const u32x4*)(y1 + 512);
            const float f1 = two ? 1.f : 0.f;
#pragma unroll
            for (int i = 0; i < 4; ++i) { acc[2 * i] += __uint_as_float(a0[i] << 16) + f1 * __uint_as_float(b0[i] << 16); acc[2 * i + 1] += __uint_as_float(a0[i] & 0xffff0000u) + f1 * __uint_as_float(b0[i] & 0xffff0000u);
                acc[8 + 2 * i] += __uint_as_float(a1[i] << 16) + f1 * __uint_as_float(b1[i] << 16); acc[8 + 2 * i + 1] += __uint_as_float(a1[i] & 0xffff0000u) + f1 * __uint_as_float(b1[i] & 0xffff0000u); }
        }
        float ss = 0.f;
#pragma unroll
        for (int i = 0; i < 2; ++i) { const f32x4 g0 = *(const f32x4*)(gt + lane * 8 + 512 * i), g1 = *(const f32x4*)(gt + lane * 8 + 512 * i + 4);
#pragma unroll
            for (int e = 0; e < 4; ++e) { xv[2 * i][e] += g0[e] * acc[8 * i + e]; xv[2 * i + 1][e] += g1[e] * acc[8 * i + 4 + e]; ss += xv[2 * i][e] * xv[2 * i][e] + xv[2 * i + 1][e] * xv[2 * i + 1][e]; }
            if (!FINAL) { xstv(xr, 512 * i, xv[2 * i]); xstv(xr, 512 * i + 4, xv[2 * i + 1]); } }
        ss = wave_sum(ss); const float rs = rsqrtf(ss * (1.f / D) + RMS_EPS);
        const float* sh = FINAL ? nullptr : modp(p, layer, strm, 0); const float* sc = FINAL ? nullptr : modp(p, layer, strm, 1);
#pragma unroll
        for (int i = 0; i < 2; ++i)
#pragma unroll
            for (int hh = 0; hh < 2; ++hh) { const int d = lane * 8 + 512 * i + 4 * hh; const f32x4 gg = *(const f32x4*)(g + d); f32x4 o = xv[2 * i + hh] * rs * gg;
                if (FINAL) *(f32x4*)(p.out + (size_t)row * D + d) = o;
                else { o = o * (1.f + *(const f32x4*)(sc + d)) + *(const f32x4*)(sh + d); stbf4(H + (size_t)row * D + d, o); } }
        row = nrow; sl = sln;
    }
}

__device__ void ph_rw_normxs(const Params& p, int layer, int j) {
    const int wid = tidx() >> 6, lane = tidx() & 63;
    const xt_t* X = (const xt_t*)(p.ws + OFF_X); bf16_t* XS = (bf16_t*)(p.ws + OFF_XS);
    const float* mu = p.rw_mu + (size_t)j * 6 * D; const float* g = p.norm1_g + layer * D;
    float4 fc[4], fp[4], fn[4];
#define XS_LOAD(R) do { const bool lat_ = (R) < NLAT; const int t_ = lat_ ? ((R) & (TL - 1)) : (((R) - NLAT) & (TC - 1)); const int len_ = lat_ ? TL : TC; \
        _Pragma("unroll") for (int i = 0; i < 4; ++i) { fc[i] = xld(X, (size_t)(R) * D + (lane + i * 64) * 4); \
            fp[i] = t_ > 0 ? xld(X, (size_t)((R) - 1) * D + (lane + i * 64) * 4) : make_float4(0, 0, 0, 0); \
            fn[i] = t_ < len_ - 1 ? xld(X, (size_t)((R) + 1) * D + (lane + i * 64) * 4) : make_float4(0, 0, 0, 0); } } while (0)
    int row = bidx() * 8 + wid;
    if (row < NROW) XS_LOAD(row);
    for (; row < NROW; row += gdim() * 8) {
        const int s_ = row_stream(row);
        const float* sh = modp(p, layer, s_, 0); const float* sc = modp(p, layer, s_, 1);
        const bool lat = row < NLAT; const int t = lat ? (row & (TL - 1)) : ((row - NLAT) & (TC - 1)); const int len = lat ? TL : TC;
        const bool hp = t > 0, hn = t < len - 1;
        float4 xc[4], xp[4], xn[4]; float sc_ = 0, sp_ = 0, sn_ = 0;
#pragma unroll
        for (int i = 0; i < 4; ++i) { xc[i] = fc[i]; xp[i] = fp[i]; xn[i] = fn[i]; }
        { const int nrow = row + gdim() * 8; if (nrow < NROW) XS_LOAD(nrow); }
#pragma unroll
        for (int i = 0; i < 4; ++i) {
            sc_ += xc[i].x * xc[i].x + xc[i].y * xc[i].y + xc[i].z * xc[i].z + xc[i].w * xc[i].w;
            sp_ += xp[i].x * xp[i].x + xp[i].y * xp[i].y + xp[i].z * xp[i].z + xp[i].w * xp[i].w;
            sn_ += xn[i].x * xn[i].x + xn[i].y * xn[i].y + xn[i].z * xn[i].z + xn[i].w * xn[i].w; }
        sc_ = wave_sum(sc_); sp_ = wave_sum(sp_); sn_ = wave_sum(sn_);
        const float rc = rsqrtf(sc_ * (1.f / D) + RMS_EPS), rp = hp ? rsqrtf(sp_ * (1.f / D) + RMS_EPS) : 0.f, rn = hn ? rsqrtf(sn_ * (1.f / D) + RMS_EPS) : 0.f;
#pragma unroll
        for (int i = 0; i < 4; ++i) {
            const int d = (lane + i * 64) * 4;
            const float4 gg = *(const float4*)(g + d), a = *(const float4*)(sc + d), bsh = *(const float4*)(sh + d);
            float h[4], xx[4];
            const float gm[4] = {gg.x * (1.f + a.x), gg.y * (1.f + a.y), gg.z * (1.f + a.z), gg.w * (1.f + a.w)}; const float bb[4] = {bsh.x, bsh.y, bsh.z, bsh.w};
            const float c4[4] = {xc[i].x, xc[i].y, xc[i].z, xc[i].w}, p4[4] = {xp[i].x, xp[i].y, xp[i].z, xp[i].w}, n4[4] = {xn[i].x, xn[i].y, xn[i].z, xn[i].w};
#pragma unroll
            for (int e = 0; e < 4; ++e) { h[e] = c4[e] * rc * gm[e] + bb[e];
                const float hpv = hp ? p4[e] * rp * gm[e] + bb[e] : 0.f, hnv = hn ? n4[e] * rn * gm[e] + bb[e] : 0.f;
                xx[e] = 0.5f * (hpv + hnv) - h[e]; }
#pragma unroll
            for (int m = 0; m < 6; ++m) { const float4 u = *(const float4*)(mu + m * D + d);
                uint2 w; w.x = pk2(h[0] + xx[0] * u.x, h[1] + xx[1] * u.y); w.y = pk2(h[2] + xx[2] * u.z, h[3] + xx[3] * u.w);
                *(uint2*)(XS + ((size_t)m * NROW + row) * D + d) = w; }
        }
    }
#undef XS_LOAD
}

__device__ __forceinline__ int scan_row(int i, int b, int z) {
    return i < TC ? NLAT + b * TC + (z ? TC - 1 - i : i) : b * TL + (z ? TL - 1 - (i - TC) : i - TC);
}
__device__ __forceinline__ float dpp_sum8(float x) {
    x += __builtin_bit_cast(float, __builtin_amdgcn_update_dpp(0, __builtin_bit_cast(int, x), 0xB1, 0xF, 0xF, true));
    x += __builtin_bit_cast(float, __builtin_amdgcn_update_dpp(0, __builtin_bit_cast(int, x), 0x4E, 0xF, 0xF, true));
    x += __builtin_bit_cast(float, __builtin_amdgcn_update_dpp(0, __builtin_bit_cast(int, x), 0x141, 0xF, 0xF, true));
    return x;
}
__device__ void ph_rw_scan(const Params& p, int j, char* lds) {
    const int tid = tidx(), wid = __builtin_amdgcn_readfirstlane(tid >> 6), lane = tid & 63;
    const size_t PL = (size_t)NROW * D;
    const float* RKV = (const float*)(p.ws + OFF_RKV); float* Y = (float*)(p.ws + OFF_Y);
    constexpr int CH = 32, BUFB = 5 * CH * 256 + CH * 128 + CH * 16, YB = CH * 32 * 4, NCH = (TC + TL) / CH;
    const bool loader = wid >= 4; const int lw = wid - 4;
    for (int it = bidx(); it < 256; it += gdim()) {
        const int vh = it & 1, z = (it >> 1) & 1, h = (it >> 2) & 15, b = it >> 6;
        const char* pl0 = (const char*)((const float*)(p.ws + OFF_W) + z * PL); const char* pl1 = (const char*)(RKV + PL);
        const char* pl2 = (const char*)((const float*)(p.ws + OFF_AV) + z * PL); const char* pl3 = (const char*)RKV;
        const char* vpl = (const char*)(RKV + 2 * PL);
        float* yout = Y + z * PL;
        __builtin_amdgcn_s_barrier();
        if (loader) {
            const int pq = lane & 15;
            const f32x4 kkv = *(const f32x4*)(p.rw_k_k + j * D + h * 64 + pq * 4), kav = *(const f32x4*)(p.rw_k_a + j * D + h * 64 + pq * 4);
            auto issue = [&](int c) {
                char* buf = lds + (c % 3) * BUFB;
#pragma unroll
                for (int q = 0; q < 8; ++q) { const int pi = q >> 1, tg = lw * 2 + (q & 1); const int row = scan_row(c * CH + tg * 4 + (lane >> 4), b, z);
                    const char* base = pi == 0 ? pl0 : pi == 1 ? pl1 : pi == 2 ? pl2 : pl3;
                    __builtin_amdgcn_global_load_lds((const unsigned*)(base + (size_t)row * D * 4 + h * 256 + (lane & 15) * 16), (LAS unsigned*)(buf + pi * (CH * 256) + tg * 1024), 16, 0, 0); }
                { const int row = scan_row(c * CH + lw * 8 + (lane >> 3), b, z);
                  __builtin_amdgcn_global_load_lds((const unsigned*)(vpl + (size_t)row * D * 4 + (h * 64 + vh * 32) * 4 + (lane & 7) * 16), (LAS unsigned*)(buf + 5 * CH * 256 + lw * 1024), 16, 0, 0); }
            };
            auto prep = [&](int c) {
                char* buf = lds + (c % 3) * BUFB;
#pragma unroll
                for (int ps = 0; ps < 2; ++ps) { const int ptok = lw * 8 + ps * 4 + (lane >> 4);
                    f32x4* kp = (f32x4*)(buf + 1 * CH * 256 + ptok * 256 + pq * 16); f32x4* ap = (f32x4*)(buf + 2 * CH * 256 + ptok * 256 + pq * 16); f32x4* dp = (f32x4*)(buf + 4 * CH * 256 + ptok * 256 + pq * 16);
                    f32x4* rp = (f32x4*)(buf + 3 * CH * 256 + ptok * 256 + pq * 16); const f32x4 wv = *(const f32x4*)(buf + ptok * 256 + pq * 16);
                    const f32x4 k = *kp, a = *ap, r = *rp; f32x4 kk = k * kkv;
                    float ss = kk[0] * kk[0] + kk[1] * kk[1] + kk[2] * kk[2] + kk[3] * kk[3]; ss = dpp_sum16(ss);
                    const float inv = 1.f / fmaxf(sqrtf(ss), 1e-12f); kk = kk * inv;
                    const f32x4 kd = k * (1.f + (a - 1.f) * kav), bb = kk * a;
                    const f32x4 t1 = bb * r, t2 = kd * r;
                    const float br = dpp_sum16((t1[0] + t1[1]) + (t1[2] + t1[3])), kr = dpp_sum16((t2[0] + t2[1]) + (t2[2] + t2[3]));
                    *dp = kd; *ap = bb; *kp = kk; *rp = wv * r;
                    if (pq == 0) *(float2*)(buf + 5 * CH * 256 + CH * 128 + ptok * 16) = make_float2(br, kr); }
            };
            issue(0); issue(1);
            asm volatile("s_waitcnt vmcnt(9)" ::: "memory");
            prep(0);
            asm volatile("s_waitcnt lgkmcnt(0)" ::: "memory"); __builtin_amdgcn_s_barrier();
            for (int c = 0; c < NCH; ++c) {
                if (c >= 1) { const float* yb = (const float*)(lds + 3 * BUFB + ((c - 1) & 1) * YB);
                    const int lt = tid - 256, t = lt >> 3, q = lt & 7; const int row = scan_row((c - 1) * CH + t, b, z);
                    *(f32x4*)(yout + (size_t)row * D + h * 64 + vh * 32 + q * 4) = *(const f32x4*)(yb + t * 32 + q * 4); }
                if (c + 2 < NCH) { issue(c + 2); asm volatile("s_waitcnt vmcnt(9)" ::: "memory"); } else asm volatile("s_waitcnt vmcnt(0)" ::: "memory");
                if (c + 1 < NCH) prep(c + 1);
                asm volatile("s_waitcnt lgkmcnt(0)" ::: "memory"); __builtin_amdgcn_s_barrier();
            }
            { const float* yb = (const float*)(lds + 3 * BUFB + ((NCH - 1) & 1) * YB);
              const int lt = tid - 256, t = lt >> 3, q = lt & 7; const int row = scan_row((NCH - 1) * CH + t, b, z);
              *(f32x4*)(yout + (size_t)row * D + h * 64 + vh * 32 + q * 4) = *(const f32x4*)(yb + t * 32 + q * 4); }
        } else {
            const int vr = lane >> 3, ks = lane & 7;
            f32x4 Sa = {0.f, 0.f, 0.f, 0.f}, Sb = {0.f, 0.f, 0.f, 0.f};
            __builtin_amdgcn_s_barrier();
            struct Ops { f32x4 w0, w1, kk0, kk1, bb0, bb1, r0, r1, kd0, kd1; float v; float2 sc; };
#define SC_LOAD(O, t) do { const char* q_ = bq + (t) * 256; O.w0 = *(const f32x4*)(q_); O.w1 = *(const f32x4*)(q_ + 16); O.kk0 = *(const f32x4*)(q_ + CH * 256); O.kk1 = *(const f32x4*)(q_ + CH * 256 + 16); \
                O.bb0 = *(const f32x4*)(q_ + 2 * CH * 256); O.bb1 = *(const f32x4*)(q_ + 2 * CH * 256 + 16); O.r0 = *(const f32x4*)(q_ + 3 * CH * 256); O.r1 = *(const f32x4*)(q_ + 3 * CH * 256 + 16); \
                O.kd0 = *(const f32x4*)(q_ + 4 * CH * 256); O.kd1 = *(const f32x4*)(q_ + 4 * CH * 256 + 16); O.v = *(const float*)(vq + (t) * 128); O.sc = *(const float2*)(buf + 5 * CH * 256 + CH * 128 + (t) * 16); } while (0)
#define SC_STEP(O, t) do { const f32x4 d1 = Sa * O.kk0 + Sb * O.kk1, d2 = Sa * O.r0 + Sb * O.r1; \
                float sa = -((d1[0] + d1[1]) + (d1[2] + d1[3])), yy = (d2[0] + d2[1]) + (d2[2] + d2[3]); \
                sa = dpp_sum8(sa); yy = dpp_sum8(yy); \
                Sa = Sa * O.w0 + (sa * O.bb0 + O.v * O.kd0); Sb = Sb * O.w1 + (sa * O.bb1 + O.v * O.kd1); \
                if (ks == 0) yb[(t) * 32 + wid * 8 + vr] = yy + sa * O.sc.x + O.v * O.sc.y; } while (0)
            for (int c = 0; c < NCH; ++c) {
                const char* buf = lds + (c % 3) * BUFB; float* yb = (float*)(lds + 3 * BUFB + (c & 1) * YB);
                const char* bq = buf + ks * 32; const char* vq = buf + 5 * CH * 256 + (wid * 8 + vr) * 4;
                Ops oA, oB, oC;
                SC_LOAD(oA, 0); SC_LOAD(oB, 1);
#pragma unroll
                for (int t = 0; t < CH; t += 3) {
                    if (t + 2 < CH) SC_LOAD(oC, t + 2);
                    SC_STEP(oA, t);
                    if (t + 3 < CH) SC_LOAD(oA, t + 3);
                    if (t + 1 < CH) SC_STEP(oB, t + 1);
                    if (t + 4 < CH) SC_LOAD(oB, t + 4);
                    if (t + 2 < CH) SC_STEP(oC, t + 2);
                }
                asm volatile("s_waitcnt lgkmcnt(0)" ::: "memory"); __builtin_amdgcn_s_barrier();
            }
#undef SC_LOAD
#undef SC_STEP
        }
    }
}


namespace ck {
constexpr int P = 72, MB = 64 * P * 2;
typedef __attribute__((address_space(3))) char lchar;
__device__ __forceinline__ f32x4 mm_tile(const lchar* Aop, const lchar* Bop, int ti, int tj, int c, int q, f32x4 acc) {
#pragma unroll
    for (int ks = 0; ks < 2; ++ks) {
        const bf16x8 a = *(const LAS bf16x8*)(Aop + ((16 * ti + c) * P + 32 * ks + 8 * q) * 2);
        const bf16x8 b = *(const LAS bf16x8*)(Bop + ((16 * tj + c) * P + 32 * ks + 8 * q) * 2);
        acc = __builtin_amdgcn_mfma_f32_16x16x32_bf16(a, b, acc, 0, 0, 0);
    }
    return acc;
}
__device__ __forceinline__ f32x4 mm_diag(const lchar* Aop, const lchar* Bop, int tt, int c, int q, f32x4 acc) {
    const int ks = tt >> 1;
    bf16x8 a = *(const LAS bf16x8*)(Aop + ((16 * tt + c) * P + 32 * ks + 8 * q) * 2);
    const bf16x8 b = *(const LAS bf16x8*)(Bop + ((16 * tt + c) * P + 32 * ks + 8 * q) * 2);
    if ((q >> 1) != (tt & 1)) a = (bf16x8){0, 0, 0, 0, 0, 0, 0, 0};
    return __builtin_amdgcn_mfma_f32_16x16x32_bf16(a, b, acc, 0, 0, 0);
}
__device__ __forceinline__ void st_tile(lchar* dst, int ti, int tj, int c, int q, f32x4 v) {
    u32x2 w; w.x = pk2(v[0], v[1]); w.y = pk2(v[2], v[3]); *(LAS u32x2*)(dst + ((16 * tj + c) * P + 16 * ti + 4 * q) * 2) = w;
}
__device__ __forceinline__ f32x4 ld_tile(const lchar* src, int ti, int tj, int c, int q) {
    const u32x2 w = *(const LAS u32x2*)(src + ((16 * tj + c) * P + 16 * ti + 4 * q) * 2);
    return (f32x4){__uint_as_float(w.x << 16), __uint_as_float(w.x & 0xffff0000u), __uint_as_float(w.y << 16), __uint_as_float(w.y & 0xffff0000u)};
}
__device__ __forceinline__ void st_glob(bf16_t* dst, int ti, int tj, int c, int q, f32x4 v) {
    uint2 w; w.x = pk2(v[0], v[1]); w.y = pk2(v[2], v[3]); *(uint2*)(dst + (16 * tj + c) * 64 + 16 * ti + 4 * q) = w;
}
typedef float f32x16 __attribute__((ext_vector_type(16)));
__device__ __forceinline__ f32x16 mm32(const lchar* Aop, const lchar* Bop, int ti, int tj, int r32, int hi, f32x16 acc) {
#pragma unroll
    for (int ks = 0; ks < 4; ++ks) {
        const bf16x8 a = *(const LAS bf16x8*)(Aop + ((32 * ti + r32) * P + 16 * ks + 8 * hi) * 2);
        const bf16x8 b = *(const LAS bf16x8*)(Bop + ((32 * tj + r32) * P + 16 * ks + 8 * hi) * 2);
        acc = __builtin_amdgcn_mfma_f32_32x32x16_bf16(a, b, acc, 0, 0, 0);
    }
    return acc;
}
__device__ __forceinline__ void st32(lchar* dst, int ti, int tj, int r32, int hi, const f32x16& v) {
#pragma unroll
    for (int g = 0; g < 4; ++g) { u32x2 w; w.x = pk2(v[4 * g], v[4 * g + 1]); w.y = pk2(v[4 * g + 2], v[4 * g + 3]); *(LAS u32x2*)(dst + ((32 * tj + r32) * P + 32 * ti + 8 * g + 4 * hi) * 2) = w; }
}
__device__ __forceinline__ f32x16 ld32(const lchar* src, int ti, int tj, int r32, int hi) {
    f32x16 v;
#pragma unroll
    for (int g = 0; g < 4; ++g) { const u32x2 w = *(const LAS u32x2*)(src + ((32 * tj + r32) * P + 32 * ti + 8 * g + 4 * hi) * 2);
        v[4 * g] = __uint_as_float(w.x << 16); v[4 * g + 1] = __uint_as_float(w.x & 0xffff0000u); v[4 * g + 2] = __uint_as_float(w.y << 16); v[4 * g + 3] = __uint_as_float(w.y & 0xffff0000u); }
    return v;
}
__device__ __forceinline__ void stg32(bf16_t* dst, int ti, int tj, int r32, int hi, const f32x16& v) {
#pragma unroll
    for (int g = 0; g < 4; ++g) { uint2 w; w.x = pk2(v[4 * g], v[4 * g + 1]); w.y = pk2(v[4 * g + 2], v[4 * g + 3]); *(uint2*)(dst + (32 * tj + r32) * 64 + 32 * ti + 8 * g + 4 * hi) = w; }
}
}

#define LBAR() do { asm volatile("s_waitcnt lgkmcnt(0)" ::: "memory"); __builtin_amdgcn_s_barrier(); asm volatile("" ::: "memory"); } while (0)
__device__ void ph_rw_sc1(const Params& p, int j, char* lds) {
    using namespace ck;
    const int tid = tidx(), wid = __builtin_amdgcn_readfirstlane(tid >> 6), lane = tid & 63, c = lane & 15, q = lane >> 4;
    const size_t PL = (size_t)NROW * D;
    const bf16_t* RKV = (const bf16_t*)(p.ws + OFF_RKV); const float* LW = (const float*)(p.ws + OFF_W); const bf16_t* AV = (const bf16_t*)(p.ws + OFF_AV);
    bf16_t* CK = (bf16_t*)(p.ws + OFF_CK);
    lchar* B0 = (lchar*)lds;
#define BUF(i) (B0 + (i) * MB)
    LAS float* Lbuf = (LAS float*)BUF(8);
    LAS float* Lseg = (LAS float*)(B0 + 16 * MB);
    LAS float* GC = Lseg + 8 * 64;
    const int pt = tid >> 3, cg = tid & 7;
    f32x4 nlw[2], nkk[2], nka[2]; u32x4 nkx, nax, nrx, nvx;
#define SC1_LOAD(IT) do { const int seq_ = (IT) / NCHK, ch_ = (IT) % NCHK; const int z_ = seq_ & 1, h_ = (seq_ >> 1) & 15, b_ = seq_ >> 5; \
        const size_t go_ = (size_t)scan_row(ch_ * 64 + pt, b_, z_) * D + h_ * 64 + cg * 8; \
        _Pragma("unroll") for (int e = 0; e < 2; ++e) nlw[e] = *(const f32x4*)(LW + z_ * PL + go_ + 4 * e); \
        nkx = *(const u32x4*)(RKV + PL + go_); nax = *(const u32x4*)(AV + z_ * PL + go_); nrx = *(const u32x4*)(RKV + go_); nvx = *(const u32x4*)(RKV + 2 * PL + go_); \
        _Pragma("unroll") for (int e = 0; e < 2; ++e) { nkk[e] = *(const f32x4*)(p.rw_k_k + j * D + h_ * 64 + cg * 8 + 4 * e); nka[e] = *(const f32x4*)(p.rw_k_a + j * D + h_ * 64 + cg * 8 + 4 * e); } } while (0)
    if (bidx() < 128 * NCHK) SC1_LOAD(bidx());
    for (int it = bidx(); it < 128 * NCHK; it += gdim()) {
        const int seq = it / NCHK; const int h = (seq >> 1) & 15;
        f32x4 lw[2], kx[2], ax[2], rx[2], vx[2], kkc[2], kac[2];
#pragma unroll
        for (int e = 0; e < 2; ++e) { lw[e] = nlw[e]; kkc[e] = nkk[e]; kac[e] = nka[e];
            kx[e] = (f32x4){__uint_as_float(nkx[2 * e] << 16), __uint_as_float(nkx[2 * e] & 0xffff0000u), __uint_as_float(nkx[2 * e + 1] << 16), __uint_as_float(nkx[2 * e + 1] & 0xffff0000u)};
            ax[e] = (f32x4){__uint_as_float(nax[2 * e] << 16), __uint_as_float(nax[2 * e] & 0xffff0000u), __uint_as_float(nax[2 * e + 1] << 16), __uint_as_float(nax[2 * e + 1] & 0xffff0000u)};
            rx[e] = (f32x4){__uint_as_float(nrx[2 * e] << 16), __uint_as_float(nrx[2 * e] & 0xffff0000u), __uint_as_float(nrx[2 * e + 1] << 16), __uint_as_float(nrx[2 * e + 1] & 0xffff0000u)};
            vx[e] = (f32x4){__uint_as_float(nvx[2 * e] << 16), __uint_as_float(nvx[2 * e] & 0xffff0000u), __uint_as_float(nvx[2 * e + 1] << 16), __uint_as_float(nvx[2 * e + 1] & 0xffff0000u)}; }
        if (it + gdim() < 128 * NCHK) SC1_LOAD(it + gdim());
        LBAR();
#pragma unroll
        for (int e = 0; e < 2; ++e) *(LAS f32x4*)(Lbuf + pt * 64 + cg * 8 + 4 * e) = lw[e];
        f32x4 kk[2], bq[2], kd[2];
        { float ss = 0.f;
#pragma unroll
          for (int e = 0; e < 2; ++e) { kk[e] = kx[e] * kkc[e]; ss += kk[e][0] * kk[e][0] + kk[e][1] * kk[e][1] + kk[e][2] * kk[e][2] + kk[e][3] * kk[e][3]; }
          ss = dpp_sum8(ss); const float inv = __builtin_amdgcn_rsqf(fmaxf(ss, 1e-24f));
#pragma unroll
          for (int e = 0; e < 2; ++e) { kk[e] = kk[e] * inv; bq[e] = kk[e] * ax[e]; kd[e] = kx[e] * (1.f + (ax[e] - 1.f) * kac[e]); } }
        LBAR();
        { const int k = tid & 63, sg = tid >> 6; float run = 0.f;
#pragma unroll
          for (int u = 0; u < 8; ++u) { run += Lbuf[(sg * 8 + u) * 64 + k]; Lbuf[(sg * 8 + u) * 64 + k] = run; }
          Lseg[sg * 64 + k] = run; }
        LBAR();
        f32x4 Lt[2], Lp[2], Lc[2];
        { const int sg = pt >> 3, sgp = (pt - 1) >> 3;
#pragma unroll
          for (int e = 0; e < 2; ++e) { f32x4 o0 = {0.f, 0.f, 0.f, 0.f}, o1 = o0, oc = o0;
#pragma unroll
              for (int u = 0; u < 8; ++u) { const f32x4 sv = *(const LAS f32x4*)(Lseg + u * 64 + cg * 8 + 4 * e); if (u < sg) o0 = o0 + sv; if (u < sgp) o1 = o1 + sv; if (u < 7) oc = oc + sv; }
              Lt[e] = *(const LAS f32x4*)(Lbuf + pt * 64 + cg * 8 + 4 * e) + o0;
              Lp[e] = pt > 0 ? *(const LAS f32x4*)(Lbuf + (pt - 1) * 64 + cg * 8 + 4 * e) + o1 : (f32x4){0.f, 0.f, 0.f, 0.f};
              Lc[e] = *(const LAS f32x4*)(Lbuf + 63 * 64 + cg * 8 + 4 * e) + oc; } }
        LBAR();
        {
            float at[8], bt[8], kt[8], rt[8], bh[8], kh[8], vv[8];
#pragma unroll
            for (int e = 0; e < 2; ++e)
#pragma unroll
                for (int u = 0; u < 4; ++u) { const int x = 4 * e + u; const float eL = __expf(Lt[e][u]), emL = __expf(-Lt[e][u]), eP = __expf(Lp[e][u]), eC = __expf(Lc[e][u] - Lt[e][u]);
                    at[x] = -kk[e][u] * eP; bt[x] = bq[e][u] * emL; kt[x] = kd[e][u] * emL; rt[x] = rx[e][u] * eL; bh[x] = bq[e][u] * eC; kh[x] = kd[e][u] * eC; vv[x] = vx[e][u];
                    if (pt == 63) GC[cg * 8 + x] = eL; }
#define ST8(bufi, arr) do { u32x4 w_ = {pk2(arr[0], arr[1]), pk2(arr[2], arr[3]), pk2(arr[4], arr[5]), pk2(arr[6], arr[7])}; *(LAS u32x4*)(BUF(bufi) + (pt * P + cg * 8) * 2) = w_; } while (0)
            ST8(0, at); ST8(1, bt); ST8(2, kt); ST8(3, rt); ST8(8, bh); ST8(9, kh); ST8(10, vv);
#undef ST8
        }
        LBAR();
        {
            const int k = tid & 63, tg = tid >> 6;
#define TR8(src, dst) do { unsigned w_[4]; _Pragma("unroll") for (int x = 0; x < 4; ++x) { const unsigned lo = *(const LAS bf16_t*)(BUF(src) + ((tg * 8 + 2 * x) * P + k) * 2), hi2 = *(const LAS bf16_t*)(BUF(src) + ((tg * 8 + 2 * x + 1) * P + k) * 2); w_[x] = lo | (hi2 << 16); } \
                *(LAS u32x4*)(BUF(dst) + (k * P + tg * 8) * 2) = (u32x4){w_[0], w_[1], w_[2], w_[3]}; } while (0)
            TR8(0, 4); TR8(8, 5); TR8(9, 6); TR8(10, 7);
#undef TR8
        }
        LBAR();
        const f32x4 Z4 = {0.f, 0.f, 0.f, 0.f};
        const f32x16 Z16 = {0.f, 0.f, 0.f, 0.f, 0.f, 0.f, 0.f, 0.f, 0.f, 0.f, 0.f, 0.f, 0.f, 0.f, 0.f, 0.f};
        const int r32 = lane & 31, hi = lane >> 5;
#pragma unroll 1
        for (int u = 0; u < 2; ++u) { const int tl = u * 8 + wid;
            if (tl >= 14) {
                if (tl == 14) { st32(BUF(8), 0, 1, r32, hi, Z16); st32(BUF(8), 1, 0, r32, hi, Z16); st32(BUF(14), 0, 1, r32, hi, Z16); st32(BUF(14), 1, 0, r32, hi, Z16); st32(BUF(9), 1, 0, r32, hi, Z16); }
                else { st32(BUF(15), 1, 0, r32, hi, Z16); st32(BUF(13), 1, 0, r32, hi, Z16); st32(BUF(10), 1, 0, r32, hi, Z16); st32(BUF(11), 1, 0, r32, hi, Z16); st32(BUF(12), 1, 0, r32, hi, Z16); }
                break; }
            const int m = (tl + 1) / 3, rr = (tl + 1) % 3, ti = rr == 2, tj = m == 0 ? ti : (rr >= 1); const int jj = 32 * tj + r32;
            if (m == 0) { f32x16 v = mm32(BUF(0), BUF(1), ti, tj, r32, hi, Z16), w;
#pragma unroll
                for (int e = 0; e < 16; ++e) { const int ii = 32 * ti + 8 * (e >> 2) + 4 * hi + (e & 3); const bool dg = (ii >> 4) == (jj >> 4);
                    v[e] = (dg && jj < ii) ? v[e] : 0.f; w[e] = v[e] + ((ii == jj) ? 1.f : 0.f); }
                st32(BUF(8), ti, tj, r32, hi, v); st32(BUF(14), ti, tj, r32, hi, w); }
            else if (m == 1) { const f32x16 v = mm32(BUF(1), BUF(0), ti, tj, r32, hi, Z16); f32x16 vd, vo, w;
#pragma unroll
                for (int e = 0; e < 16; ++e) { const int ii = 32 * ti + 8 * (e >> 2) + 4 * hi + (e & 3); const bool dg = (ii >> 4) == (jj >> 4), up = ii < jj;
                    vd[e] = (dg && up) ? v[e] : 0.f; vo[e] = (!dg && up) ? v[e] : 0.f; w[e] = vd[e] + ((ii == jj) ? 1.f : 0.f); }
                st32(BUF(9), ti, tj, r32, hi, vd); st32(BUF(15), ti, tj, r32, hi, vo); st32(BUF(13), ti, tj, r32, hi, w); }
            else if (m == 2) { f32x16 v = mm32(BUF(2), BUF(0), ti, tj, r32, hi, Z16);
#pragma unroll
                for (int e = 0; e < 16; ++e) { const int ii = 32 * ti + 8 * (e >> 2) + 4 * hi + (e & 3); v[e] = ii < jj ? v[e] : 0.f; }
                st32(BUF(10), ti, tj, r32, hi, v); }
            else { f32x16 v = mm32(m == 3 ? BUF(1) : BUF(2), BUF(3), ti, tj, r32, hi, Z16);
#pragma unroll
                for (int e = 0; e < 16; ++e) { const int ii = 32 * ti + 8 * (e >> 2) + 4 * hi + (e & 3); v[e] = ii <= jj ? v[e] : 0.f; }
                st32(m == 3 ? BUF(11) : BUF(12), ti, tj, r32, hi, v); } }
        LBAR();
#define WSYNC() asm volatile("s_waitcnt lgkmcnt(0)" ::: "memory")
        if (wid < 4) {
            const int tt = wid;
#define SQD(sr, st, dr, dt) do { const f32x4 a_ = mm_diag(BUF(st), BUF(sr), tt, c, q, Z4), b_ = mm_diag(BUF(sr), BUF(st), tt, c, q, Z4); WSYNC(); \
                st_tile(BUF(dr), tt, tt, c, q, a_); st_tile(BUF(dt), tt, tt, c, q, b_); WSYNC(); } while (0)
#define UPD(pr) do { const f32x4 dt_ = mm_diag(BUF(pr), BUF(13), tt, c, q, ld_tile(BUF(13), tt, tt, c, q)); \
                const f32x4 dr_ = mm_diag(BUF(13), BUF(pr), tt, c, q, ld_tile(BUF(14), tt, tt, c, q)); WSYNC(); \
                st_tile(BUF(13), tt, tt, c, q, dt_); st_tile(BUF(14), tt, tt, c, q, dr_); WSYNC(); } while (0)
            SQD(8, 9, 0, 1); UPD(0); SQD(0, 1, 8, 9); UPD(8); SQD(8, 9, 0, 1); UPD(0);
#undef SQD
#undef UPD
        } else {
            const int ti = (wid >> 1) & 1, tj = wid & 1; st32(BUF(2), ti, tj, r32, hi, mm32(BUF(10), BUF(7), ti, tj, r32, hi, Z16));
        }
        LBAR();
        { const int m = wid >> 2, ti = (wid >> 1) & 1, tj = wid & 1;
          if (m == 0) st32(BUF(8), ti, tj, r32, hi, mm32(BUF(15), BUF(14), ti, tj, r32, hi, Z16));
          else        st32(BUF(9), ti, tj, r32, hi, mm32(BUF(14), BUF(15), ti, tj, r32, hi, Z16)); }
        LBAR();
        if (wid < 4) { const int ti = (wid >> 1) & 1, tj = wid & 1; st32(BUF(0), ti, tj, r32, hi, mm32(BUF(9), BUF(8), ti, tj, r32, hi, Z16)); }
        LBAR();
        if (wid < 4) { const int ti = (wid >> 1) & 1, tj = wid & 1; st32(BUF(1), ti, tj, r32, hi, mm32(BUF(0), BUF(13), ti, tj, r32, hi, ld32(BUF(13), ti, tj, r32, hi))); }
        LBAR();
        if (wid < 4) { const int ti = (wid >> 1) & 1, tj = wid & 1; st32(BUF(14), ti, tj, r32, hi, mm32(BUF(8), BUF(1), ti, tj, r32, hi, ld32(BUF(1), ti, tj, r32, hi))); }
        LBAR();
        { const int m = wid >> 2, ti = (wid >> 1) & 1, tj = wid & 1;
          if (m == 0) st32(BUF(8), ti, tj, r32, hi, mm32(BUF(14), BUF(4), ti, tj, r32, hi, Z16));
          else        st32(BUF(0), ti, tj, r32, hi, mm32(BUF(14), BUF(2), ti, tj, r32, hi, Z16)); }
        LBAR();
        bf16_t* ckp = CK + (size_t)it * 4 * 4096;
#pragma unroll 1
        for (int u = 0; u < 2; ++u) { const int tl = u * 8 + wid, m = tl >> 2, ti = (tl >> 1) & 1, tj = tl & 1;
            if (m == 0) { f32x16 v = mm32(BUF(8), BUF(5), ti, tj, r32, hi, Z16); const int jj = 32 * tj + r32; const float gc = GC[jj];
#pragma unroll
                for (int e = 0; e < 16; ++e) { const int ii = 32 * ti + 8 * (e >> 2) + 4 * hi + (e & 3); v[e] += (ii == jj) ? gc : 0.f; }
                st32(BUF(1), ti, tj, r32, hi, v); }
            else if (m == 1) st32(BUF(4), ti, tj, r32, hi, mm32(BUF(8), BUF(11), ti, tj, r32, hi, ld32(BUF(3), ti, tj, r32, hi)));
            else if (m == 2) st32(BUF(2), ti, tj, r32, hi, mm32(BUF(6), BUF(7), ti, tj, r32, hi, mm32(BUF(5), BUF(0), ti, tj, r32, hi, Z16)));
            else             st32(BUF(9), ti, tj, r32, hi, mm32(BUF(7), BUF(12), ti, tj, r32, hi, mm32(BUF(0), BUF(11), ti, tj, r32, hi, Z16))); }
        LBAR();
        { const int orow = tid >> 3, oc = (tid & 7) * 8;
          *(u32x4*)(ckp + orow * 64 + oc) = *(const LAS u32x4*)(BUF(1) + (orow * P + oc) * 2);
          *(u32x4*)(ckp + 4096 + orow * 64 + oc) = *(const LAS u32x4*)(BUF(2) + (orow * P + oc) * 2);
          *(u32x4*)(ckp + 2 * 4096 + orow * 64 + oc) = *(const LAS u32x4*)(BUF(4) + (orow * P + oc) * 2);
          *(u32x4*)(ckp + 3 * 4096 + orow * 64 + oc) = *(const LAS u32x4*)(BUF(9) + (orow * P + oc) * 2); }
    }
#undef BUF
#undef SC1_LOAD
}

__device__ void ph_rw_sc2(const Params& p, char* lds) {
    using namespace ck;
    const int tid = tidx(), wid = __builtin_amdgcn_readfirstlane(tid >> 6), lane = tid & 63, c = lane & 15, q = lane >> 4;
    const size_t PL = (size_t)NROW * D;
    const bf16_t* CK = (const bf16_t*)(p.ws + OFF_CK); bf16_t* Y = (bf16_t*)(p.ws + OFF_Y);
    lchar* GB = (lchar*)lds;
    lchar* RB = GB + 2 * MB;
    lchar* SB = GB + 4 * MB;
    constexpr int SBB = 32 * P * 2;
    for (int it = bidx(); it < 256; it += gdim()) {
        const int vh = it & 1, seq = it >> 1, z = seq & 1, h = (seq >> 1) & 15, b = seq >> 5;
        const bf16_t* ck0 = CK + (size_t)seq * NCHK * 4 * 4096;
        const int s_ti = wid & 3, s_tj = wid >> 2;
        const int y_ti = wid & 1, y_tj = wid >> 1;
        const int hoff = 4096 + (vh * 32 + 16 * s_tj + c) * 64 + 16 * s_ti + 4 * q, yoff = 3 * 4096 + (16 * y_tj + c) * 64 + vh * 32 + 16 * y_ti + 4 * q;
        struct PF { u32x4 g, r; uint2 h, y; };
#define PF_LOAD(X, k) do { const bf16_t* cc_ = ck0 + (size_t)(k) * 4 * 4096; X.h = *(const uint2*)(cc_ + hoff); X.y = *(const uint2*)(cc_ + yoff); X.g = *(const u32x4*)(cc_ + tid * 8); X.r = *(const u32x4*)(cc_ + 2 * 4096 + tid * 8); } while (0)
#define PF_STAGE(X, bufi) do { *(LAS u32x4*)(GB + (bufi) * MB + ((tid >> 3) * P + (tid & 7) * 8) * 2) = X.g; *(LAS u32x4*)(RB + (bufi) * MB + ((tid >> 3) * P + (tid & 7) * 8) * 2) = X.r; } while (0)
#define SC2_STEP(k, CUR, NXT) do { const uint2 hi_ = CUR.h, yi_ = CUR.y; const int cur = (k) & 1; \
            if ((k) + 4 < NCHK) PF_LOAD(CUR, (k) + 4); \
            const f32x4 hinit = {__uint_as_float(hi_.x << 16), __uint_as_float(hi_.x & 0xffff0000u), __uint_as_float(hi_.y << 16), __uint_as_float(hi_.y & 0xffff0000u)}; \
            const f32x4 yinit = {__uint_as_float(yi_.x << 16), __uint_as_float(yi_.x & 0xffff0000u), __uint_as_float(yi_.y << 16), __uint_as_float(yi_.y & 0xffff0000u)}; \
            const lchar* Sold = SB + cur * SBB; lchar* Snew = SB + (cur ^ 1) * SBB; \
            const f32x4 sn = mm_tile(GB + cur * MB, Sold, s_ti, s_tj, c, q, hinit);        \
            const f32x4 yv = mm_tile(Sold, RB + cur * MB, y_ti, y_tj, c, q, yinit);        \
            st_tile(Snew, s_ti, s_tj, c, q, sn); \
            { const int row = scan_row((k) * 64 + 16 * y_tj + c, b, z); stbf4(Y + z * PL + (size_t)row * D + h * 64 + vh * 32 + 16 * y_ti + 4 * q, yv); } \
            if ((k) + 1 < NCHK) PF_STAGE(NXT, cur ^ 1); \
            LBAR(); } while (0)
        PF s0, s1, s2, s3;
        PF_LOAD(s0, 0); PF_LOAD(s1, 1); PF_LOAD(s2, 2); PF_LOAD(s3, 3);
        LBAR();
        for (int i = tid; i < SBB / 4; i += NTHR) ((LAS unsigned*)SB)[i] = 0u;
        PF_STAGE(s0, 0);
        LBAR();
        for (int ch = 0; ch < NCHK; ch += 4) {
            SC2_STEP(ch, s0, s1); SC2_STEP(ch + 1, s1, s2); SC2_STEP(ch + 2, s2, s3); SC2_STEP(ch + 3, s3, s0);
        }
#undef PF_LOAD
#undef PF_STAGE
#undef SC2_STEP
    }
}
#undef LBAR

__device__ void ph_rw_out(const Params& p, int j, int nrows) {
    const int wid = tidx() >> 6, lane = tidx() & 63;
    const bf16_t* RKV = (const bf16_t*)(p.ws + OFF_RKV); const bf16_t* AV = (const bf16_t*)(p.ws + OFF_AV); const bf16_t* G = (const bf16_t*)(p.ws + OFF_G); const bf16_t* Y = (const bf16_t*)(p.ws + OFF_Y);
    bf16_t* OUT = (bf16_t*)(p.ws + OFF_H);
    const size_t PL = (size_t)NROW * D;
    const float* r_k = p.rw_r_k + j * D; const float* lg = p.rw_lnx_g + j * D; const float* lb = p.rw_lnx_b + j * D; const float* k_a = p.rw_k_a + j * D;
    uint2 nb[8][4];
#define OUT_LOAD(R) do { _Pragma("unroll") for (int i = 0; i < 4; ++i) { const size_t o_ = (size_t)(R) * D + lane * 4 + i * 256; \
        nb[0][i] = *(const uint2*)(Y + o_); nb[1][i] = *(const uint2*)(Y + PL + o_); nb[2][i] = *(const uint2*)(RKV + o_); nb[3][i] = *(const uint2*)(RKV + PL + o_); \
        nb[4][i] = *(const uint2*)(RKV + 2 * PL + o_); nb[5][i] = *(const uint2*)(AV + o_); nb[6][i] = *(const uint2*)(AV + PL + o_); nb[7][i] = *(const uint2*)(G + o_); } } while (0)
#define UNPK(w) ((f32x4){__uint_as_float((w).x << 16), __uint_as_float((w).x & 0xffff0000u), __uint_as_float((w).y << 16), __uint_as_float((w).y & 0xffff0000u)})
    int row = bidx() * 8 + wid;
    if (row < nrows) OUT_LOAD(row);
    for (; row < nrows; row += gdim() * 8) {
        uint2 cb[8][4];
#pragma unroll
        for (int q_ = 0; q_ < 8; ++q_)
#pragma unroll
            for (int i = 0; i < 4; ++i) cb[q_][i] = nb[q_][i];
        { const int nrow = row + gdim() * 8; if (nrow < nrows) OUT_LOAD(nrow); }
#pragma unroll
        for (int i = 0; i < 4; ++i) {
            const size_t o = (size_t)row * D + lane * 4 + i * 256; const int c = lane * 4 + i * 256;
            const f32x4 y = UNPK(cb[0][i]) + UNPK(cb[1][i]);
            const float mean = dpp_sum16(y[0] + y[1] + y[2] + y[3]) * (1.f / 64.f);
            const f32x4 dd = y - mean;
            const float rstd = rsqrtf(dpp_sum16(dd[0] * dd[0] + dd[1] * dd[1] + dd[2] * dd[2] + dd[3] * dd[3]) * (1.f / 64.f) + LNX_EPS);
            const f32x4 r = UNPK(cb[2][i]), k = UNPK(cb[3][i]), v = UNPK(cb[4][i]);
            const f32x4 a0 = UNPK(cb[5][i]), a1 = UNPK(cb[6][i]);
            const f32x4 kds = k * (2.f + (a0 + a1 - 2.f) * *(const f32x4*)(k_a + c));
            const f32x4 t4 = r * kds * *(const f32x4*)(r_k + c);
            const float bs = dpp_sum16(t4[0] + t4[1] + t4[2] + t4[3]);
            const f32x4 res = (dd * rstd * *(const f32x4*)(lg + c) + *(const f32x4*)(lb + c) + bs * v) * UNPK(cb[7][i]);
            uint2 w; w.x = pk2(res[0], res[1]); w.y = pk2(res[2], res[3]); *(uint2*)(OUT + o) = w;
        }
    }
#undef OUT_LOAD
#undef UNPK
}

__device__ void ph_final(const Params& p) {
    const int wid = tidx() >> 6, lane = tidx() & 63;
    const float* X = (const float*)(p.ws + OFF_X);
    for (int row = bidx() * 8 + wid; row < NLAT; row += gdim() * 8) {
        const float4* xr = (const float4*)(X + (size_t)row * D);
        float4 v[4]; float ss = 0;
#pragma unroll
        for (int i = 0; i < 4; ++i) { v[i] = xr[lane + i * 64]; ss += v[i].x * v[i].x + v[i].y * v[i].y + v[i].z * v[i].z + v[i].w * v[i].w; }
        ss = wave_sum(ss); const float rs = rsqrtf(ss * (1.f / D) + RMS_EPS);
#pragma unroll
        for (int i = 0; i < 4; ++i) { const int d = (lane + i * 64) * 4; const float4 gg = *(const float4*)(p.final_g + d);
            float4 o; o.x = v[i].x * rs * gg.x; o.y = v[i].y * rs * gg.y; o.z = v[i].z * rs * gg.z; o.w = v[i].w * rs * gg.w;
            *(float4*)(p.out + (size_t)row * D + d) = o; }
    }
}

enum { PH_INIT = 0, PH_A_NORM, PH_A_Z, PH_A_MID, PH_A_QKV, PH_A_POST, PH_A_ATTN, PH_A_WO,
       PH_R_NORM, PH_R_XS, PH_R_G1, PH_R_G2, PH_R_PREP, PH_R_SCAN, PH_R_OUT, PH_R_WO,
       PH_M_NORM, PH_M_SEL, PH_M_GATHER, PH_M_G1, PH_M_G2, PH_M_COMB, PH_FINAL, PH_M_CVT, PH_R_SC1, PH_R_SC2 };

#ifndef BG_Z
#define BG_Z 4
#define BG_ATTN 2
#define BG_WO 3
#define BG_RG1 6
#define BG_MG1 4
#define BG_MG2 6
#endif
template <int PH>
__device__ __forceinline__ void run_phase(const Params& p, int layer, char* lds) {
    const int j = layer >> 1;
    char* ws = p.ws;
    if constexpr (PH == PH_INIT) { ph_init(p, lds); __syncthreads(); ph_small_cvt(p, lds); }
    else if constexpr (PH == PH_A_NORM) { if (layer == 0) ph_norm_mod<false>(p, layer, p.norm1_g + layer * D, 0, 1, ws + OFF_H); else ph_comb_norm<false>(p, layer - 1, layer, NROW); }
    else if constexpr (PH == PH_A_Z) {
        float* Z = (float*)(ws + OFF_Z);
        g8::BatchSched S{ws + OFF_H, ws + OFF_WMLA + j * SZ_WMLA + WM_IN, 0, 0, NROW / 256, 2, 1, D};
        g8::gemm_phase(p.wv, (PG8_LAS unsigned char*)lds, D, S, g8::epi_rc([=](const g8::Unit&, int row, int col, f32x4 v) { *(f32x4*)(Z + (size_t)row * 512 + col) = v; }));
        if (idle_tail(NROW / 256 * 2)) bg_cvt(p, layer, lds, BG_Z);
    }
    else if constexpr (PH == PH_A_MID) ph_mla_mid(p, j);
    else if constexpr (PH == PH_A_QKV) {
        bf16_t* Q = (bf16_t*)(ws + OFF_Q); bf16_t* K = (bf16_t*)(ws + OFF_K); bf16_t* V = (bf16_t*)(ws + OFF_V);
        g8::BatchSched S1{ws + OFF_CQN, ws + OFF_WMLA + j * SZ_WMLA + WM_UQ, 0, 0, NROW / 256, 6, 1, 256, 1};
        g8::gemm_phase(p.wv, (PG8_LAS unsigned char*)lds, 256, S1, g8::epi_rc([=](const g8::Unit&, int row, int col, f32x4 v) {
            const bool lat = row < NLAT; const int b = lat ? (row >> 12) : ((row - NLAT) >> 8); const int tk = lat ? 256 + (row & (TL - 1)) : ((row - NLAT) & 255);
            const int h = col / 192, d = col - h * 192;
            uint2 w; w.x = pk2(v[0], v[1]); w.y = pk2(v[2], v[3]);
            *(uint2*)(Q + ((size_t)(b * 8 + h) * TK + tk) * 192 + d) = w; }));
        g8::BatchSched S2{ws + OFF_CKVN, ws + OFF_WMLA + j * SZ_WMLA + WM_UKV, 0, 0, NROW / 256, 8, 1, 128};
        g8::gemm_phase(p.wv, (PG8_LAS unsigned char*)lds, 128, S2, g8::epi_rc([=](const g8::Unit&, int row, int col, f32x4 v) {
            const bool lat = row < NLAT; const int b = lat ? (row >> 12) : ((row - NLAT) >> 8); const int tk = lat ? 256 + (row & (TL - 1)) : ((row - NLAT) & 255);
            const int h = col >> 8, d = col & 255; const size_t orow = (size_t)(b * 8 + h) * TK + tk;
            uint2 w; w.x = pk2(v[0], v[1]); w.y = pk2(v[2], v[3]);
            if (d < 128) *(uint2*)(K + orow * 192 + d) = w; else *(uint2*)(V + orow * 128 + (d - 128)) = w; }));
    }
    else if constexpr (PH == PH_A_ATTN) { ph_attn(p, lds); if (idle_tail(544)) bg_cvt(p, layer, lds, BG_ATTN); }
    else if constexpr (PH == PH_A_WO || PH == PH_R_WO) {
        xt_t* X = (xt_t*)(ws + OFF_X); const float* MOD = (const float*)(ws + OFF_MOD);
        g8::BatchSched S{ws + (PH == PH_A_WO ? OFF_O : OFF_H), PH == PH_A_WO ? ws + OFF_WMLA + j * SZ_WMLA + WM_O : ws + OFF_WRW + j * SZ_WRW + WR_O, 0, 0, (layer < 3 ? NROW : NLAT) / 256, 4, 1, D};
        g8::gemm_phase(p.wv, (PG8_LAS unsigned char*)lds, D, S, g8::EpiResid{X, MOD, layer});
        if (idle_tail((layer < 3 ? NROW : NLAT) / 256 * 4)) bg_cvt(p, layer, lds, BG_WO);
    }
    else if constexpr (PH == PH_R_XS) ph_rw_normxs(p, layer, j);
    else if constexpr (PH == PH_R_G1) {
        bf16_t* RKV = (bf16_t*)(ws + OFF_RKV); bf16_t* VF = (bf16_t*)(ws + OFF_VFIRST);
        bf16_t* A2 = (bf16_t*)(ws + OFF_A2); bf16_t* A3 = (bf16_t*)(ws + OFF_A3);
        const bool first = (j == 0);
        struct RSched { const char* XS; const char* WB; int nwg;
            __device__ __forceinline__ bool next(int i, g8::Unit& u) const {
                const int L = i * gdim() + bidx(); if (L >= nwg) return false;
                const int w = g8::xcd_remap(L, nwg);
                if (w < 816) { u.g = w / 272; const int r = w % 272; u.pm = r >> 2; u.pn = r & 3; u.B = WB + WR_RKV + (size_t)u.g * D * D * 2 + (size_t)u.pn * 256 * D * 2; }
                else { u.g = 3 + (w - 816) / 68; u.pm = (w - 816) % 68; u.pn = 0; u.B = WB + WR_L + (size_t)(u.g - 3) * 256 * D * 2; }
                u.A = XS + (size_t)(u.g == 6 ? 2 : u.g) * NROW * D * 2 + (size_t)u.pm * 256 * D * 2; return true; } };
        RSched S{ws + OFF_XS, ws + OFF_WRW + j * SZ_WRW, first ? 816 + 204 : 816 + 272};
        g8::gemm_phase(p.wv, (PG8_LAS unsigned char*)lds, D, S, g8::epi_rc([=](const g8::Unit& u, int row, int col, f32x4 v) {
            if (u.g < 3) { stbf4(RKV + ((size_t)u.g * NROW + row) * D + col, v); if (first && u.g == 2) stbf4(VF + (size_t)row * D + col, v); }
            else if (col < 128) {
                f32x4 t = v;
                if (u.g == 3) { for (int e = 0; e < 4; ++e) t[e] = 1.f - 2.f * __builtin_amdgcn_rcpf(1.f + __expf(2.f * v[e])); }
                else if (u.g == 5) { for (int e = 0; e < 4; ++e) t[e] = sigmoidf_(v[e]); }
                bf16_t* dst = (u.g == 3 ? A2 : u.g == 4 ? A2 + (size_t)NROW * 128 : u.g == 5 ? A3 : A3 + (size_t)NROW * 128);
                stbf4(dst + (size_t)row * 128 + col, t); } }));
        if (idle_tail(S.nwg)) bg_cvt(p, layer, lds, BG_RG1);
    }
    else if constexpr (PH == PH_R_G2) {
        const bool first = (j == 0);
        float* W = (float*)(ws + OFF_W); bf16_t* AV = (bf16_t*)(ws + OFF_AV); bf16_t* G = (bf16_t*)(ws + OFF_G); bf16_t* RKV = (bf16_t*)(ws + OFF_RKV); const bf16_t* VF = (const bf16_t*)(ws + OFF_VFIRST);
        const float* w0 = p.rw_w0 + (size_t)j * 2 * D; const float* a0 = p.rw_a0 + (size_t)j * 2 * D; const float* v0 = p.rw_v0;
        g8::BatchSched S1{ws + OFF_A2, ws + OFF_WRW + j * SZ_WRW + WR_B2, (size_t)NROW * 128 * 2, (size_t)2048 * 128 * 2, NROW / 256, 8, 2, 128};
        g8::gemm_phase(p.wv, (PG8_LAS unsigned char*)lds, 128, S1, g8::epi_colfirst([=](const g8::Unit& u, int row, int col, f32x4 v, f32x4 bias) {
            const int zz = u.pn >> 2, c = col & 1023; const bool dec = u.g == 0;
            const size_t doff = (size_t)zz * NROW * D + (size_t)row * D + c;
            const f32x4 x = v + bias; f32x4 o;
#pragma unroll
            for (int e = 0; e < 4; ++e) { const float sg = __builtin_amdgcn_rcpf(1.f + __expf(-x[e])); o[e] = dec ? (-0.6065306597126334f * sg) : sg; }
            if (dec) *(f32x4*)(W + doff) = o; else stbf4(AV + doff, o); },
            [=](const g8::Unit& u, int col) { const int zz = u.pn >> 2, c = col & 1023; return *(const f32x4*)((u.g == 0 ? w0 : a0) + zz * D + c); }));
        g8::BatchSched S2{ws + OFF_A3, ws + OFF_WRW + j * SZ_WRW + WR_B3, (size_t)NROW * 128 * 2, (size_t)1024 * 128 * 2, NROW / 256, 4, first ? 1 : 2, 128, 1};
        g8::gemm_phase(p.wv, (PG8_LAS unsigned char*)lds, 128, S2, g8::epi_rc([=](const g8::Unit& u, int row, int col, f32x4 v) {
            if (u.g == 0) stbf4(G + (size_t)row * D + col, v);
            else { const size_t o = (size_t)row * D + col; const f32x4 vv = ldbf4(RKV + (size_t)2 * NROW * D + o), vf = ldbf4(VF + o), gz = v + *(const f32x4*)(v0 + col); f32x4 r;
#pragma unroll
                for (int e = 0; e < 4; ++e) r[e] = vv[e] + (vf[e] - vv[e]) * __builtin_amdgcn_rcpf(1.f + __expf(-gz[e]));
                stbf4(RKV + (size_t)2 * NROW * D + o, r); } }));
    }
    else if constexpr (PH == PH_R_SCAN) ph_rw_scan(p, j, lds);
    else if constexpr (PH == PH_R_SC1) ph_rw_sc1(p, j, lds);
    else if constexpr (PH == PH_R_SC2) ph_rw_sc2(p, lds);
    else if constexpr (PH == PH_R_OUT) ph_rw_out(p, j, layer < 3 ? NROW : NLAT);
    else if constexpr (PH == PH_M_NORM) ph_norm2_router(p, layer, lds, layer < 3 ? NROW : NLAT);
    else if constexpr (PH == PH_M_SEL) { ph_select(p, lds, layer < 3 ? 128 : 64); __syncthreads(); moe_cvt(p, layer, lds, -1); }
    else if constexpr (PH == PH_M_GATHER) ph_gather(p, layer < 3 ? ESLOTS : NB * CAPL);
    else if constexpr (PH == PH_M_G1) {
        bf16_t* HID = (bf16_t*)(ws + OFF_HID);
        g8::BatchSched S{ws + OFF_XE, ws + OFF_W13T + (size_t)(layer & 1) * SZ_WMOE, (size_t)EPAD * D * 2, (size_t)2816 * D * 2, layer < 3 ? 9 : 8, 11, NE, D};
        g8::gemm_phase(p.wv, (PG8_LAS unsigned char*)lds, D, S, g8::epi_pair([=](const g8::Unit& u, int row, int col, f32x4 a, f32x4 b) {
            uint2 w; w.x = pk2(a[0] * __builtin_amdgcn_rcpf(1.f + __expf(-a[0])) * b[0], a[1] * __builtin_amdgcn_rcpf(1.f + __expf(-a[1])) * b[1]); w.y = pk2(a[2] * __builtin_amdgcn_rcpf(1.f + __expf(-a[2])) * b[2], a[3] * __builtin_amdgcn_rcpf(1.f + __expf(-a[3])) * b[3]);
            *(uint2*)(HID + ((size_t)u.g * EPAD + row) * FF + col) = w; }));
        if (layer < 3 && idle_tail(9 * 11 * NE)) moe_cvt(p, layer + 1, lds, BG_MG1);
    }
    else if constexpr (PH == PH_M_G2) {
        bf16_t* YE = (bf16_t*)(ws + OFF_YE); const float* GATE = (const float*)(ws + OFF_GATE);
        g8::BatchSched S{ws + OFF_HID, ws + OFF_W2T + (size_t)(layer & 1) * SZ_WMOE, (size_t)EPAD * FF * 2, (size_t)D * FF * 2, layer < 3 ? 9 : 8, 4, NE, FF};
        g8::gemm_phase(p.wv, (PG8_LAS unsigned char*)lds, FF, S, g8::epi_pre([=](const g8::Unit& u, int row, int col, f32x4 v, f32x4, float gt) {
            uint2 w; w.x = pk2(v[0] * gt, v[1] * gt); w.y = pk2(v[2] * gt, v[3] * gt);
            *(uint2*)(YE + ((size_t)u.g * EPAD + row) * D + col) = w; },
            [=](const g8::Unit&, int) { return (f32x4){0.f, 0.f, 0.f, 0.f}; }, [=](const g8::Unit& u, int row) { return GATE[u.g * EPAD + row]; }));
        if (layer < 3 && idle_tail(9 * 4 * NE)) moe_cvt(p, layer + 1, lds, BG_MG2);
    }
    else if constexpr (PH == PH_M_COMB) ph_combine(p, layer, layer < 3 ? NROW : NLAT);
    else if constexpr (PH == PH_M_CVT) moe_cvt(p, layer, lds, -1);
    else if constexpr (PH == PH_FINAL) ph_comb_norm<true>(p, 3, 0, NLAT);
}

#if ONE_LAUNCH
#define SYNC() xcd_barrier(bar)
#ifndef PROBE_PH
#define PROBE_PH -1
#endif
#ifndef PROBE_REP
#define PROBE_REP 1
#endif
__device__ __forceinline__ Params load_params() {
    Params q{};
#if defined(__HIP_DEVICE_COMPILE__)
    typedef const __attribute__((address_space(4))) unsigned long long* KargP;
    KargP kp_ = (KargP)__builtin_amdgcn_kernarg_segment_ptr(); asm volatile("" : "+s"(kp_));
#pragma unroll
    for (int i = 0; i < 40; ++i) ((const float**)&q)[i] = (const float*)(const __attribute__((address_space(1))) float*)kp_[i];
#endif
    return q;
}
#define RUN(PH) do { for (int rep_ = 0; rep_ < ((PH) == PROBE_PH ? PROBE_REP : 1); ++rep_) { Params q = load_params(); q.wv = wv0_; run_phase<PH>(q, layer, smem); SYNC(); } } while (0)
__global__ void __launch_bounds__(NTHR, 2) mega(Params p) {
    extern __shared__ __attribute__((aligned(16))) char smem[];
    const int wv0_ = __builtin_amdgcn_readfirstlane((int)threadIdx.x >> 6);
    if (threadIdx.x == 0) *(uint4*)(smem + LDS_BYTES) = make_uint4(0u, 0u, 0u, 0u);
    __syncthreads();
    XcdBarrier bar = xcd_barrier_post((unsigned*)(p.ws + OFF_BAR), (volatile LAS unsigned*)(smem + LDS_BYTES));
    { const int layer = 0; RUN(PH_INIT); }
    for (int layer = 0; layer < 4; ++layer) {
        if ((layer & 1) == 0) {
            RUN(PH_A_NORM);
            RUN(PH_A_Z);
            RUN(PH_A_MID);
            RUN(PH_A_QKV);
            RUN(PH_A_ATTN);
            RUN(PH_A_WO);
        } else {
            RUN(PH_R_XS);
            RUN(PH_R_G1);
            RUN(PH_R_G2);
            RUN(PH_R_SC1);
            RUN(PH_R_SC2);
            RUN(PH_R_OUT);
            RUN(PH_R_WO);
        }
        RUN(PH_M_NORM);
        RUN(PH_M_SEL);
        RUN(PH_M_G1);
        RUN(PH_M_G2);
        if ((layer & 1) == 0) RUN(PH_M_COMB);
    }
    { Params q = load_params(); q.wv = wv0_; run_phase<PH_FINAL>(q, 0, smem); }
}
#else
template <int PH> __global__ void __launch_bounds__(NTHR, 2) kph(Params p, int layer) {
    extern __shared__ __attribute__((aligned(16))) char smem[];
    Params q = p; q.wv = __builtin_amdgcn_readfirstlane((int)threadIdx.x >> 6);
    run_phase<PH>(q, layer, smem);
}
#endif

extern "C" void kernel_launch(void* const* d_in, const int* in_sizes, int n_in, void* d_out, int out_size, void* d_ws, size_t ws_size, hipStream_t stream) {
    if (n_in != 38 || ws_size < WS_NEED) { fprintf(stderr, "kernel_launch: bad args n_in %d ws %zu need %zu\n", n_in, ws_size, (size_t)WS_NEED); return; }
    Params p{};
    const float** pp = (const float**)&p;
    for (int i = 0; i < 38; ++i) pp[i] = (const float*)d_in[i];
    p.out = (float*)d_out; p.ws = (char*)d_ws;
    static int cus = 0;
    if (!cus) { int dev = 0; hipGetDevice(&dev); hipDeviceGetAttribute(&cus, hipDeviceAttributeMultiprocessorCount, dev); if (cus <= 0) cus = 256; }
    const int grid = cus;
#if ONE_LAUNCH
    hipFuncSetAttribute((const void*)mega, hipFuncAttributeMaxDynamicSharedMemorySize, LDS_BYTES + 16);
    hipMemsetAsync(d_ws, 0, 16384, stream);
    hipLaunchKernelGGL(mega, dim3(grid), dim3(NTHR), LDS_BYTES + 16, stream, p);
#else
    hipMemsetAsync(d_ws, 0, 16384, stream);
#define LAUNCH(PH, L) do { hipFuncSetAttribute((const void*)kph<PH>, hipFuncAttributeMaxDynamicSharedMemorySize, LDS_BYTES + 16); hipLaunchKernelGGL(kph<PH>, dim3(grid), dim3(NTHR), LDS_BYTES + 16, stream, p, L); } while (0)
    LAUNCH(PH_INIT, 0);
    for (int layer = 0; layer < 4; ++layer) {
        if ((layer & 1) == 0) { LAUNCH(PH_A_NORM, layer); LAUNCH(PH_A_Z, layer); LAUNCH(PH_A_MID, layer); LAUNCH(PH_A_QKV, layer); LAUNCH(PH_A_ATTN, layer); LAUNCH(PH_A_WO, layer); }
        else { LAUNCH(PH_R_XS, layer); LAUNCH(PH_R_G1, layer); LAUNCH(PH_R_G2, layer); LAUNCH(PH_R_SC1, layer); LAUNCH(PH_R_SC2, layer); LAUNCH(PH_R_OUT, layer); LAUNCH(PH_R_WO, layer); }
        LAUNCH(PH_M_NORM, layer); LAUNCH(PH_M_SEL, layer); LAUNCH(PH_M_G1, layer); LAUNCH(PH_M_G2, layer); if ((layer & 1) == 0) LAUNCH(PH_M_COMB, layer);
    }
    LAUNCH(PH_FINAL, 0);
#endif
}
```

```cpp
#include <hip/hip_runtime.h>
#include <stdint.h>
#include <stdio.h>

#ifndef ONE_LAUNCH
#define ONE_LAUNCH 1
#endif

#define NTHR 512
typedef unsigned short bf16_t;
typedef short bf16x8 __attribute__((ext_vector_type(8)));
typedef float f32x4 __attribute__((ext_vector_type(4)));
typedef unsigned u32x4 __attribute__((ext_vector_type(4)));
typedef unsigned u32x2 __attribute__((ext_vector_type(2)));

constexpr int D = 1024, NB = 4, TL = 4096, TC = 256, NLAT = NB * TL, NCTX = NB * TC, NROW = NLAT + NCTX;
constexpr int TK = TL + TC;
constexpr int NE = 16, FF = 1408, CAPL = 512, CAPC = 32, ESLOTS = NB * CAPL + NB * CAPC;
constexpr int EPAD = 2304;
constexpr float RMS_EPS = 1e-6f, LNX_EPS = 64e-5f;
constexpr float ATT_SCALE = 0.07216878364870322f;

constexpr size_t al256(size_t x) { return (x + 255) / 256 * 256; }
constexpr size_t OFF_BAR = 0;
constexpr size_t OFF_QUEUE = 14336;
constexpr size_t OFF_MOD = 16384;
constexpr size_t OFF_ROPE_C = OFF_MOD + al256(4 * 5 * 6144 * 4);
constexpr size_t OFF_ROPE_S = OFF_ROPE_C + al256(TL * 32 * 4);
constexpr size_t OFF_X = OFF_ROPE_S + al256(TL * 32 * 4);
constexpr size_t SZ_F32 = (size_t)NROW * D * 4, SZ_BF = (size_t)NROW * D * 2;
constexpr size_t OFF_VFIRST = OFF_X + SZ_BF;
constexpr size_t OFF_H = OFF_VFIRST + SZ_BF;
constexpr size_t SZ_WMLA = (size_t)(512 * 1024 + 1536 * 256 + 2048 * 256 + 1024 * 1024) * 2;
constexpr size_t WM_IN = 0, WM_UQ = (size_t)512 * 1024 * 2, WM_UKV = WM_UQ + (size_t)1536 * 256 * 2, WM_O = WM_UKV + (size_t)2048 * 256 * 2;
constexpr size_t SZ_WRW = (size_t)(3 * 1024 * 1024 + 4 * 256 * 1024 + 1024 * 1024 + 4096 * 256 + 2048 * 256) * 2;
constexpr size_t WR_RKV = 0, WR_L = (size_t)3 * 1024 * 1024 * 2, WR_O = WR_L + (size_t)4 * 256 * 1024 * 2, WR_B2 = WR_O + (size_t)1024 * 1024 * 2, WR_B3 = WR_B2 + (size_t)4096 * 256 * 2;
constexpr size_t OFF_WMLA = OFF_H + SZ_BF;
constexpr size_t OFF_WRW = OFF_WMLA + 2 * SZ_WMLA;
constexpr size_t OFF_W13T = OFF_WRW + 2 * SZ_WRW;
constexpr size_t OFF_W2T = OFF_W13T + (size_t)NE * 2816 * D * 2;
constexpr size_t SZ_WMOE = (size_t)NE * 2816 * D * 2 + (size_t)NE * D * FF * 2;
constexpr size_t OFF_S = OFF_W13T + 2 * SZ_WMOE;
constexpr size_t OFF_Z = OFF_S;
constexpr size_t OFF_CQN = OFF_Z + al256((size_t)NROW * 512 * 4);
constexpr size_t OFF_CKVN = OFF_CQN + al256((size_t)NROW * 256 * 2);
constexpr size_t OFF_KR = OFF_CKVN + al256((size_t)NROW * 256 * 2);
constexpr size_t OFF_QRAW = OFF_KR + al256((size_t)NROW * 64 * 4);
constexpr size_t OFF_KVRAW = OFF_QRAW + al256((size_t)NROW * 1536 * 4);
constexpr size_t OFF_Q = OFF_KVRAW + al256((size_t)NROW * 2048 * 4);
constexpr size_t OFF_K = OFF_Q + al256((size_t)NB * 8 * TK * 192 * 2);
constexpr size_t OFF_V = OFF_K + al256((size_t)NB * 8 * TK * 192 * 2);
constexpr size_t OFF_O = OFF_V + al256((size_t)NB * 8 * TK * 128 * 2);
constexpr size_t END_MLA = OFF_O + SZ_BF;
constexpr size_t OFF_XS = OFF_S;
constexpr size_t OFF_RKV = OFF_XS + 6 * SZ_BF;
constexpr size_t OFF_W = OFF_RKV + 3 * SZ_BF;
constexpr size_t OFF_AV = OFF_W + 2 * SZ_F32;
constexpr size_t OFF_G = OFF_AV + 2 * SZ_BF;
constexpr size_t OFF_A2 = OFF_G + SZ_BF;
constexpr size_t OFF_A3 = OFF_A2 + al256((size_t)NROW * 256 * 2);
constexpr size_t END_RW = OFF_A3 + al256((size_t)NROW * 256 * 2);
constexpr size_t OFF_Y = OFF_XS;
constexpr int NCHK = (TC + TL) / 64;
constexpr size_t OFF_CK = END_RW;
constexpr size_t END_RW2 = OFF_CK + (size_t)128 * NCHK * 4 * 4096 * 2;
constexpr size_t OFF_AFF = OFF_S;
constexpr size_t OFF_ROWIDX = OFF_AFF + al256((size_t)NROW * 16 * 4);
constexpr size_t OFF_GATE = OFF_ROWIDX + al256((size_t)NE * ESLOTS * 4);
constexpr size_t OFF_SLOT = OFF_GATE + al256((size_t)NE * EPAD * 4);
constexpr size_t OFF_XE = OFF_SLOT + al256((size_t)NROW * 16 * 4);
constexpr size_t OFF_HID = OFF_XE + al256((size_t)NE * EPAD * D * 2);
constexpr size_t OFF_YE = OFF_HID + al256((size_t)NE * EPAD * FF * 2);
constexpr size_t END_MOE = OFF_YE + al256((size_t)NE * EPAD * D * 2);
constexpr size_t WS_NEED = END_RW2 > END_MLA ? (END_RW2 > END_MOE ? END_RW2 : END_MOE) : (END_MLA > END_MOE ? END_MLA : END_MOE);

constexpr int LDS_BYTES = 152064;

struct Params {
    const float *x, *c, *ctx, *c_ctx, *mod_w, *mod_b, *norm1_g, *norm2_g, *final_g;
    const float *mla_w_in, *mla_g_q, *mla_g_kv, *mla_w_uq, *mla_w_ukv, *mla_w_o;
    const float *rw_mu, *rw_w_rkv, *rw_w0, *rw_w1, *rw_w2, *rw_a0, *rw_a1, *rw_a2, *rw_v0, *rw_v1, *rw_v2, *rw_g1, *rw_g2, *rw_k_k, *rw_k_a, *rw_r_k, *rw_lnx_g, *rw_lnx_b, *rw_w_o;
    const float *moe_router, *moe_w1, *moe_w3, *moe_w2;
    float* out; char* ws;
    int wv, pad_;
};

__device__ __forceinline__ int bidx() { int t = blockIdx.x; asm volatile("" : "+s"(t)); return t; }
__device__ __forceinline__ int gdim() { int t = gridDim.x; asm volatile("" : "+s"(t)); return t; }
__device__ __forceinline__ int tidx_w(int wv) { int l; asm volatile("v_mbcnt_lo_u32_b32 %0, -1, 0\n\tv_mbcnt_hi_u32_b32 %0, -1, %0" : "=v"(l)); return (wv << 6) | l; }
#define tidx() tidx_w(p.wv)
#define XB_TMO      128
#define XB_XCNT(j)  (256  + 64 * (j))
#define XB_XSUB(j)  (1280 + 64 * (j))
#define XB_XGEN(j)  (2304 + 64 * (j))
#define XB_TOP      3328
#define XB_TOPGEN   3392
#define XCD_BAR_WORDS 3456
#define XB_SPIN_CAP (1u << 22)
#define LAS __attribute__((address_space(3)))

__device__ __forceinline__ unsigned xb_ld(unsigned* p)              { return __hip_atomic_load(p, __ATOMIC_RELAXED, __HIP_MEMORY_SCOPE_AGENT); }
__device__ __forceinline__ unsigned xb_add(unsigned* p, unsigned v) { return __hip_atomic_fetch_add(p, v, __ATOMIC_RELAXED, __HIP_MEMORY_SCOPE_AGENT); }
__device__ __forceinline__ unsigned xb_xcc_id() { return (unsigned)__builtin_amdgcn_s_getreg((3 << 11) | 20) & 0xFu; }
#define XB_SPIN(cond, bar) do { unsigned _sp = 0; while (cond) { __builtin_amdgcn_s_sleep(1); \
    if ((++_sp & 255u) == 0u) { if (xb_ld(&(bar)[XB_TMO])) break; if (_sp > XB_SPIN_CAP) { atomicAdd(&(bar)[XB_TMO], 1u); break; } } } } while (0)

struct XcdBarrier { unsigned* bar; unsigned x; volatile LAS unsigned* st; };

__device__ __forceinline__ XcdBarrier xcd_barrier_post(unsigned* bar, volatile LAS unsigned* st) {
    XcdBarrier b; b.bar = bar; b.x = xb_xcc_id(); b.st = st;
    if (threadIdx.x == 0) (void)xb_add(&bar[XB_XCNT(b.x)], 1u);
    return b;
}
__device__ __forceinline__ void xcd_barrier_complete(unsigned* bar, unsigned x, unsigned& nloc, unsigned& nx) {
    const unsigned G = gridDim.x * gridDim.y * gridDim.z;
    unsigned sum, cnt, mine, sp = 0u;
    for (;;) {
        sum = 0u; cnt = 0u; mine = 0u;
#pragma unroll
        for (unsigned j = 0; j < 16; ++j) { const unsigned c = xb_ld(&bar[XB_XCNT(j)]); sum += c; cnt += (c > 0u) ? 1u : 0u; mine = (j == x) ? c : mine; }
        if (sum == G) break;
        __builtin_amdgcn_s_sleep(1);
        if ((++sp & 255u) == 0u) { if (xb_ld(&bar[XB_TMO])) break; if (sp > XB_SPIN_CAP) { atomicAdd(&bar[XB_TMO], 1u); break; } }
    }
    nloc = mine > 0u ? mine : 1u; nx = cnt > 0u ? cnt : 1u;
}
__device__ __forceinline__ void xcd_barrier(const XcdBarrier& b) {
    asm volatile("s_waitcnt vmcnt(0)" ::: "memory");
    __syncthreads();
    if (threadIdx.x == 0) {
        unsigned* bar = b.bar;
        __builtin_amdgcn_s_waitcnt(0);
        unsigned nloc = b.st[0], nx = b.st[1];
        if (nloc == 0u) { xcd_barrier_complete(bar, b.x, nloc, nx); b.st[0] = nloc; b.st[1] = nx; }
        const unsigned old = xb_add(&bar[XB_XSUB(b.x)], 1u);
        const unsigned gen = old / nloc;
        if (old + 1u == (gen + 1u) * nloc) {
            __builtin_amdgcn_fence(__ATOMIC_RELEASE, "agent");
            asm volatile("s_waitcnt vmcnt(0)" ::: "memory");
            const unsigned og = xb_add(&bar[XB_TOP], 1u);
            const unsigned tg = og / nx;
            if (og + 1u == (tg + 1u) * nx) xb_add(&bar[XB_TOPGEN], 1u);
            else XB_SPIN(xb_ld(&bar[XB_TOPGEN]) == tg, bar);
            __builtin_amdgcn_fence(__ATOMIC_ACQUIRE, "agent");
            xb_add(&bar[XB_XGEN(b.x)], 1u);
            asm volatile("s_waitcnt vmcnt(0)" ::: "memory");
        } else {
            XB_SPIN(xb_ld(&bar[XB_XGEN(b.x)]) == gen, bar);
            __builtin_amdgcn_fence(__ATOMIC_ACQUIRE, "agent");
            asm volatile("s_waitcnt vmcnt(0)" ::: "memory");
        }
    }
    __syncthreads();
}

__device__ __forceinline__ float bf2f(bf16_t b) { return __uint_as_float(((unsigned)b) << 16); }
typedef float f32x2_ __attribute__((ext_vector_type(2)));
typedef __bf16 bf16x2_ __attribute__((ext_vector_type(2)));
__device__ __forceinline__ unsigned pk2(float lo, float hi) { const f32x2_ v = {lo, hi}; return __builtin_bit_cast(unsigned, __builtin_convertvector(v, bf16x2_)); }
__device__ __forceinline__ bf16_t f2bf(float f) { return (bf16_t)(pk2(f, f) & 0xffffu); }
__device__ __forceinline__ float dpp_sum16(float x) {
    x += __builtin_bit_cast(float, __builtin_amdgcn_update_dpp(0, __builtin_bit_cast(int, x), 0xB1, 0xF, 0xF, true));
    x += __builtin_bit_cast(float, __builtin_amdgcn_update_dpp(0, __builtin_bit_cast(int, x), 0x4E, 0xF, 0xF, true));
    x += __builtin_bit_cast(float, __builtin_amdgcn_update_dpp(0, __builtin_bit_cast(int, x), 0x141, 0xF, 0xF, true));
    x += __builtin_bit_cast(float, __builtin_amdgcn_update_dpp(0, __builtin_bit_cast(int, x), 0x140, 0xF, 0xF, true));
    return x;
}
__device__ __forceinline__ f32x4 ldbf4(const bf16_t* p) { const uint2 w = *(const uint2*)p; return (f32x4){__uint_as_float(w.x << 16), __uint_as_float(w.x & 0xffff0000u), __uint_as_float(w.y << 16), __uint_as_float(w.y & 0xffff0000u)}; }
__device__ __forceinline__ void stbf4(bf16_t* p, f32x4 v) { uint2 w; w.x = pk2(v[0], v[1]); w.y = pk2(v[2], v[3]); *(uint2*)p = w; }
typedef bf16_t xt_t;
__device__ __forceinline__ f32x4 xldv(const xt_t* X, size_t i) { return ldbf4(X + i); }
__device__ __forceinline__ void xstv(xt_t* X, size_t i, f32x4 v) { stbf4(X + i, v); }
__device__ __forceinline__ float4 xld(const xt_t* X, size_t i) { const f32x4 v = ldbf4(X + i); return make_float4(v[0], v[1], v[2], v[3]); }
__device__ __forceinline__ void xst(xt_t* X, size_t i, float4 v) { stbf4(X + i, (f32x4){v.x, v.y, v.z, v.w}); }
__device__ __forceinline__ float wave_sum(float v) {
    v = dpp_sum16(v); const int i = __builtin_bit_cast(int, v);
    return __builtin_bit_cast(float, __builtin_amdgcn_readlane(i, 0)) + __builtin_bit_cast(float, __builtin_amdgcn_readlane(i, 16)) + __builtin_bit_cast(float, __builtin_amdgcn_readlane(i, 32)) + __builtin_bit_cast(float, __builtin_amdgcn_readlane(i, 48));
}
__device__ __forceinline__ float sigmoidf_(float x) { return __builtin_amdgcn_rcpf(1.f + __expf(-x)); }
__device__ __forceinline__ int row_stream(int row) { return row < NLAT ? (row >> 12) : 4; }
__device__ __forceinline__ const float* modp(const Params& p, int layer, int s, int part) { return (const float*)(p.ws + OFF_MOD) + ((size_t)layer * 5 + s) * 6144 + part * 1024; }

struct SgArgs { const bf16_t* A; int lda; size_t strideA; const float* B; int ldb; size_t strideB; int M, N, K, nbatch; };
template <class Epi>
__device__ __forceinline__ void sg_gemm(const Params& p, char* lds, const SgArgs g, const Epi& epi) {
    bf16_t* As = (bf16_t*)lds;
    bf16_t* Bs = As + 128 * 40;
    const int tid = tidx(), wid = tid >> 6, lane = tid & 63;
    const int wr = wid >> 2, wc = wid & 3;
    const int tilesN = (g.N + 127) / 128, tilesM = g.M / 128, per = tilesM * tilesN, ntiles = per * g.nbatch;
    const int ar = tid >> 2, ak = (tid & 3) * 8;
    const int bn = tid & 127, bk = (tid >> 7) * 8;
    for (int tile = bidx(); tile < ntiles; tile += gdim()) {
        const int bt = tile / per, tt = tile % per;
        const int tm = tt / tilesN, tn = tt % tilesN;
        const int m0 = tm * 128, n0 = tn * 128;
        f32x4 acc[4][2];
#pragma unroll
        for (int m = 0; m < 4; ++m)
#pragma unroll
            for (int n = 0; n < 2; ++n) acc[m][n] = (f32x4){0.f, 0.f, 0.f, 0.f};
        const bool bvalid = (n0 + bn) < g.N;
        const bf16_t* ap = g.A + bt * g.strideA + (size_t)(m0 + ar) * g.lda + ak;
        const float* bp = g.B + bt * g.strideB + (size_t)bk * g.ldb + n0 + bn;
        bf16x8 areg; float breg[8];
        areg = *(const bf16x8*)ap;
#pragma unroll
        for (int j = 0; j < 8; ++j) breg[j] = bvalid ? bp[(size_t)j * g.ldb] : 0.f;
        for (int k0 = 0; k0 < g.K; k0 += 32) {
            __syncthreads();
            *(bf16x8*)(As + ar * 40 + ak) = areg;
            { u32x4 w; w.x = pk2(breg[0], breg[1]); w.y = pk2(breg[2], breg[3]); w.z = pk2(breg[4], breg[5]); w.w = pk2(breg[6], breg[7]); *(u32x4*)(Bs + bn * 40 + bk) = w; }
            __syncthreads();
            if (k0 + 32 < g.K) {
                areg = *(const bf16x8*)(ap + k0 + 32);
#pragma unroll
                for (int j = 0; j < 8; ++j) breg[j] = bvalid ? bp[(size_t)(k0 + 32 + j) * g.ldb] : 0.f;
            }
            bf16x8 af[4], bfr[2];
#pragma unroll
            for (int m = 0; m < 4; ++m) af[m] = *(const bf16x8*)(As + (wr * 64 + m * 16 + (lane & 15)) * 40 + (lane >> 4) * 8);
#pragma unroll
            for (int n = 0; n < 2; ++n) bfr[n] = *(const bf16x8*)(Bs + (wc * 32 + n * 16 + (lane & 15)) * 40 + (lane >> 4) * 8);
#pragma unroll
            for (int m = 0; m < 4; ++m)
#pragma unroll
                for (int n = 0; n < 2; ++n) acc[m][n] = __builtin_amdgcn_mfma_f32_16x16x32_bf16(af[m], bfr[n], acc[m][n], 0, 0, 0);
        }
#pragma unroll
        for (int m = 0; m < 4; ++m)
#pragma unroll
            for (int n = 0; n < 2; ++n) {
                const int col = n0 + wc * 32 + n * 16 + (lane & 15);
                if (col < g.N) {
#pragma unroll
                    for (int r = 0; r < 4; ++r) epi(bt, m0 + wr * 64 + m * 16 + (lane >> 4) * 4 + r, col, acc[m][n][r]);
                }
            }
    }
}


namespace g8 {
#define PG8_LAS __attribute__((address_space(3)))
constexpr int BM = 256, BK = 64, HALF = 128, HTB = HALF * BK * 2, STAGE_BYTES = 8 * HTB;
__device__ __forceinline__ int lds_byte(int r, int c) { const int st = (r >> 4) * 2 + (c >> 5), rr = r & 15, cc = c & 31, ob = rr * 64 + cc * 2; return st * 1024 + (ob ^ (((ob >> 9) & 1) << 5)); }
__device__ __forceinline__ void stage_rc(int b, int& R, int& C) { const int st = b / 1024, sb = b % 1024, swz = sb ^ (((sb >> 9) & 1) << 5); R = (st >> 1) * 16 + swz / 64; C = (st & 1) * 32 + (swz % 64) / 2; }
struct Unit { int pm, pn, g; const char* A; const char* B; };
__device__ __forceinline__ int xcd_remap(int L, int nwg) { const int q = nwg / 8, r = nwg % 8, xcd = L % 8, off = L / 8; return (xcd < r ? xcd * (q + 1) : r * (q + 1) + (xcd - r) * q) + off; }

template <class Epi, class Sched>
__device__ __forceinline__ void gemm_phase(const int wv_, PG8_LAS unsigned char* lds, const int K, const Sched& S, const Epi& E) {
    const int tid = tidx_w(wv_), wid = __builtin_amdgcn_readfirstlane(tid >> 6), lane = tid & 63, wr = wid >> 2, wc = wid & 3, fr = lane & 15, fq = lane >> 4;
    const int nt = K / BK;
    unsigned voffA[2];
#pragma unroll
    for (int i = 0; i < 2; ++i) { int R, C; stage_rc(tid * 16 + i * 8192, R, C); voffA[i] = (unsigned)(R * K + C) * 2u; }
    const size_t kstep = (size_t)(BK * 2);
    const size_t hstep = (size_t)HALF * K * 2;
    const unsigned ldsw = (unsigned)wid * 1024u;
    const int aoff = lds_byte(wr * 64 + fr, fq * 8), boff = lds_byte(wc * 32 + fr, fq * 8);
#define PG8_SA(b, h) (((b) * 2 + (h)) * HTB)
#define PG8_SB(b, h) ((4 + (b) * 2 + (h)) * HTB)
#define PG8_STAGE(bufoff, gbase, voff) do { _Pragma("unroll") for (int _i = 0; _i < 2; ++_i) \
        __builtin_amdgcn_global_load_lds((const unsigned*)((const char*)(gbase) + (voff)[_i]), (PG8_LAS unsigned*)(lds + (bufoff) + ldsw + _i * 8192), 16, 0, 0); } while (0)
#define PG8_LDA(dst, b, h) do { _Pragma("unroll") for (int m = 0; m < 4; ++m) _Pragma("unroll") for (int k = 0; k < 2; ++k) dst[m][k] = *(const PG8_LAS bf16x8*)(lds + PG8_SA(b, h) + aoff + m * 2048 + k * 1024); } while (0)
#define PG8_LDB(dst, b, h) do { _Pragma("unroll") for (int n = 0; n < 2; ++n) _Pragma("unroll") for (int k = 0; k < 2; ++k) dst[n][k] = *(const PG8_LAS bf16x8*)(lds + PG8_SB(b, h) + boff + n * 2048 + k * 1024); } while (0)
#define PG8_MMA(ai, bj, At, Bt) do { __builtin_amdgcn_s_setprio(1); _Pragma("unroll") for (int m = 0; m < 4; ++m) _Pragma("unroll") for (int n = 0; n < 2; ++n) _Pragma("unroll") for (int k = 0; k < 2; ++k) \
        acc[ai][bj][m][n] = __builtin_amdgcn_mfma_f32_16x16x32_bf16(Bt[n][k], At[m][k], acc[ai][bj][m][n], 0, 0, 0); __builtin_amdgcn_s_setprio(0); } while (0)
#define PG8_WAIT_V(n) asm volatile("s_waitcnt vmcnt(" #n ")" ::: "memory")
#define PG8_WAIT_L(n) asm volatile("s_waitcnt lgkmcnt(" #n ")" ::: "memory")
#define PG8_BAR __builtin_amdgcn_s_barrier()
#define PG8_SCHED __builtin_amdgcn_sched_barrier(0)
    Unit cur, nxt; int ui = 0;
    if (!S.next(0, cur)) return;
    f32x4 acc[2][2][4][2];
#pragma unroll
    for (int a = 0; a < 2; ++a)
#pragma unroll
        for (int b = 0; b < 2; ++b)
#pragma unroll
            for (int m = 0; m < 4; ++m)
#pragma unroll
                for (int n = 0; n < 2; ++n) acc[a][b][m][n] = (f32x4){0.f, 0.f, 0.f, 0.f};
    bf16x8 At[4][2], B0[2][2], B1[2][2];
    const char* cA = cur.A; const char* cB = cur.B;
    PG8_STAGE(PG8_SB(0, 0), cB, voffA); PG8_STAGE(PG8_SA(0, 0), cA, voffA); PG8_STAGE(PG8_SB(0, 1), cB + hstep, voffA); PG8_STAGE(PG8_SA(0, 1), cA + hstep, voffA);
    if (wr == 1) PG8_BAR;
    PG8_WAIT_V(4); PG8_BAR;
    PG8_STAGE(PG8_SB(1, 0), cB + kstep, voffA); PG8_STAGE(PG8_SA(1, 0), cA + kstep, voffA); PG8_STAGE(PG8_SB(1, 1), cB + hstep + kstep, voffA);
    PG8_WAIT_V(6); PG8_BAR;
    for (;;) {
        const bool has_next = S.next(ui + 1, nxt);
        const char* nA = has_next ? nxt.A : cA; const char* nB = has_next ? nxt.B : cB;
        for (int t = 0; t < nt; t += 2) {
            const bool last = (t == nt - 2);
            const char* a1 = cA + (size_t)(t + 1) * kstep;
            const char* a2 = last ? nA : cA + (size_t)(t + 2) * kstep; const char* b2 = last ? nB : cB + (size_t)(t + 2) * kstep;
            const char* a3 = a2 + kstep; const char* b3 = b2 + kstep;
            PG8_LDB(B0, 0, 0); PG8_SCHED; PG8_LDA(At, 0, 0); PG8_STAGE(PG8_SA(1, 1), a1 + hstep, voffA);
            PG8_WAIT_L(8); PG8_BAR; PG8_WAIT_L(0); PG8_MMA(0, 0, At, B0); PG8_BAR; PG8_SCHED;
            PG8_LDB(B1, 0, 1); PG8_STAGE(PG8_SB(0, 0), b2, voffA);
            PG8_BAR; PG8_WAIT_L(0); PG8_MMA(0, 1, At, B1); PG8_BAR;
            PG8_LDA(At, 0, 1); PG8_STAGE(PG8_SA(0, 0), a2, voffA);
            PG8_BAR; PG8_WAIT_L(0); PG8_MMA(1, 0, At, B0); PG8_BAR; PG8_SCHED;
            PG8_STAGE(PG8_SB(0, 1), b2 + hstep, voffA);
            PG8_WAIT_V(6); PG8_BAR; PG8_MMA(1, 1, At, B1); PG8_BAR;
            PG8_LDB(B0, 1, 0); PG8_SCHED; PG8_LDA(At, 1, 0); PG8_STAGE(PG8_SA(0, 1), a2 + hstep, voffA);
            PG8_WAIT_L(8); PG8_BAR; PG8_WAIT_L(0); PG8_MMA(0, 0, At, B0); PG8_BAR; PG8_SCHED;
            PG8_LDB(B1, 1, 1); PG8_STAGE(PG8_SB(1, 0), b3, voffA);
            PG8_BAR; PG8_WAIT_L(0); PG8_MMA(0, 1, At, B1); PG8_BAR;
            PG8_LDA(At, 1, 1); PG8_STAGE(PG8_SA(1, 0), a3, voffA);
            PG8_BAR; PG8_WAIT_L(0); PG8_MMA(1, 0, At, B0); PG8_BAR; PG8_SCHED;
            PG8_STAGE(PG8_SB(1, 1), b3 + hstep, voffA);
            PG8_WAIT_V(6); PG8_BAR; PG8_MMA(1, 1, At, B1); PG8_BAR;
        }
        E(acc, cur, wr, wc, fr, fq);
        if (!has_next) break;
#pragma unroll
        for (int a = 0; a < 2; ++a)
#pragma unroll
            for (int b = 0; b < 2; ++b)
#pragma unroll
                for (int m = 0; m < 4; ++m)
#pragma unroll
                    for (int n = 0; n < 2; ++n) acc[a][b][m][n] = (f32x4){0.f, 0.f, 0.f, 0.f};
        cur = nxt; cA = nA; cB = nB; ++ui;
    }
    PG8_WAIT_V(0);
    if (wr == 0) PG8_BAR;
    PG8_BAR;
#undef PG8_SA
#undef PG8_SB
#undef PG8_STAGE
#undef PG8_LDA
#undef PG8_LDB
#undef PG8_MMA
#undef PG8_WAIT_V
#undef PG8_WAIT_L
#undef PG8_BAR
#undef PG8_SCHED
}
template <class F> struct EpiRC { F f;
    __device__ __forceinline__ void operator()(const f32x4 (&acc)[2][2][4][2], const Unit& u, int wr, int wc, int fr, int fq) const {
#pragma unroll
        for (int ai = 0; ai < 2; ++ai)
#pragma unroll
            for (int m = 0; m < 4; ++m) { const int row = u.pm * BM + ai * HALF + wr * 64 + m * 16 + fr;
#pragma unroll
                for (int bj = 0; bj < 2; ++bj)
#pragma unroll
                    for (int n = 0; n < 2; ++n) f(u, row, u.pn * BM + bj * HALF + wc * 32 + n * 16 + 4 * fq, acc[ai][bj][m][n]);
                asm volatile("" ::: "memory"); }
    } };
template <class F> __device__ __forceinline__ EpiRC<F> epi_rc(const F& f) { return EpiRC<F>{f}; }
template <class F> struct EpiPair { F f;
    __device__ __forceinline__ void operator()(const f32x4 (&acc)[2][2][4][2], const Unit& u, int wr, int wc, int fr, int fq) const {
#pragma unroll
        for (int ai = 0; ai < 2; ++ai)
#pragma unroll
            for (int m = 0; m < 4; ++m) { const int row = u.pm * BM + ai * HALF + wr * 64 + m * 16 + fr;
#pragma unroll
                for (int n = 0; n < 2; ++n) f(u, row, u.pn * HALF + wc * 32 + n * 16 + 4 * fq, acc[ai][0][m][n], acc[ai][1][m][n]);
                asm volatile("" ::: "memory"); }
    } };
template <class F> __device__ __forceinline__ EpiPair<F> epi_pair(const F& f) { return EpiPair<F>{f}; }
template <class F, class CF, class RF> struct EpiPre { F f; CF cf; RF rf;
    __device__ __forceinline__ void operator()(const f32x4 (&acc)[2][2][4][2], const Unit& u, int wr, int wc, int fr, int fq) const {
        f32x4 cv[2][2]; float rv[2][4];
#pragma unroll
        for (int bj = 0; bj < 2; ++bj)
#pragma unroll
            for (int n = 0; n < 2; ++n) cv[bj][n] = cf(u, u.pn * BM + bj * HALF + wc * 32 + n * 16 + 4 * fq);
#pragma unroll
        for (int ai = 0; ai < 2; ++ai)
#pragma unroll
            for (int m = 0; m < 4; ++m) rv[ai][m] = rf(u, u.pm * BM + ai * HALF + wr * 64 + m * 16 + fr);
#pragma unroll
        for (int ai = 0; ai < 2; ++ai)
#pragma unroll
            for (int m = 0; m < 4; ++m) { const int row = u.pm * BM + ai * HALF + wr * 64 + m * 16 + fr;
#pragma unroll
                for (int bj = 0; bj < 2; ++bj)
#pragma unroll
                    for (int n = 0; n < 2; ++n) f(u, row, u.pn * BM + bj * HALF + wc * 32 + n * 16 + 4 * fq, acc[ai][bj][m][n], cv[bj][n], rv[ai][m]);
                asm volatile("" ::: "memory"); }
    } };
template <class F, class CF, class RF> __device__ __forceinline__ EpiPre<F, CF, RF> epi_pre(const F& f, const CF& cf, const RF& rf) { return EpiPre<F, CF, RF>{f, cf, rf}; }
template <class F, class CF> struct EpiColFirst { F f; CF cf;
    __device__ __forceinline__ void operator()(const f32x4 (&acc)[2][2][4][2], const Unit& u, int wr, int wc, int fr, int fq) const {
#pragma unroll
        for (int bj = 0; bj < 2; ++bj)
#pragma unroll
            for (int n = 0; n < 2; ++n) { const int col = u.pn * BM + bj * HALF + wc * 32 + n * 16 + 4 * fq; const f32x4 cv = cf(u, col);
#pragma unroll
                for (int ai = 0; ai < 2; ++ai)
#pragma unroll
                    for (int m = 0; m < 4; ++m) f(u, u.pm * BM + ai * HALF + wr * 64 + m * 16 + fr, col, acc[ai][bj][m][n], cv);
                asm volatile("" ::: "memory"); }
    } };
template <class F, class CF> __device__ __forceinline__ EpiColFirst<F, CF> epi_colfirst(const F& f, const CF& cf) { return EpiColFirst<F, CF>{f, cf}; }
struct EpiResid { xt_t* X; const float* MOD; int layer;
    __device__ __forceinline__ void operator()(const f32x4 (&acc)[2][2][4][2], const Unit& u, int wr, int wc, int fr, int fq) const {
        const int row0 = u.pm * BM + wr * 64 + fr, col0 = u.pn * BM + wc * 32 + 4 * fq;
        const int strm = row0 < NLAT ? (row0 >> 12) : 4;
        const float* gp = MOD + ((size_t)layer * 5 + strm) * 6144 + 2048 + col0;
        f32x4 gt[2][2];
#pragma unroll
        for (int bj = 0; bj < 2; ++bj)
#pragma unroll
            for (int n = 0; n < 2; ++n) gt[bj][n] = *(const f32x4*)(gp + bj * HALF + n * 16);
#pragma unroll
        for (int ai = 0; ai < 2; ++ai) {
            f32x4 xv[4][2][2];
#pragma unroll
            for (int m = 0; m < 4; ++m)
#pragma unroll
                for (int bj = 0; bj < 2; ++bj)
#pragma unroll
                    for (int n = 0; n < 2; ++n) xv[m][bj][n] = xldv(X, (size_t)(row0 + ai * HALF + m * 16) * D + col0 + bj * HALF + n * 16);
#pragma unroll
            for (int m = 0; m < 4; ++m)
#pragma unroll
                for (int bj = 0; bj < 2; ++bj)
#pragma unroll
                    for (int n = 0; n < 2; ++n) xstv(X, (size_t)(row0 + ai * HALF + m * 16) * D + col0 + bj * HALF + n * 16, xv[m][bj][n] + gt[bj][n] * acc[ai][bj][m][n]);
            asm volatile("" ::: "memory");
        }
    } };
struct BatchSched { const char* A; const char* B; size_t strideA, strideB; int nM, nN, nb, K; int rev = 0;
    __device__ __forceinline__ bool next(int i, Unit& u) const {
        const int nwg = nM * nN * nb; const int L = i * gdim() + (rev ? gdim() - 1 - bidx() : bidx()); if (L >= nwg) return false;
        const int w = xcd_remap(L, nwg); const int per = nM * nN; u.g = w / per; const int r = w % per; u.pm = r / nN; u.pn = r % nN;
        u.A = A + u.g * strideA + (size_t)u.pm * BM * K * 2; u.B = B + u.g * strideB + (size_t)u.pn * BM * K * 2; return true; } };
}

template <class SrcF, class DRow>
__device__ __forceinline__ int cvt_tiles(const int wv_, char* lds, bf16_t* dst, int Kd, int Nd, int nbatch, size_t dstride, const SrcF& src, const DRow& drow, int* rot = nullptr) {
    bf16_t* T = (bf16_t*)lds;
    const int tid = tidx_w(wv_);
    const int tk = Kd / 128, tn = Nd / 64, per = tk * tn, total = per * nbatch;
    {
        int first = bidx() - (rot ? *rot % gdim() : 0); if (first < 0) first += gdim();
        if (rot) *rot += total;
        for (int t = first; t < total; t += gdim()) {
            const int bt = t / per, r = t % per, k0 = (r % tk) * 128, n0 = (r / tk) * 64;
            float4 v[4];
#pragma unroll
            for (int i = 0; i < 4; ++i) { const int k = k0 + i * 32 + (tid >> 4), n = n0 + (tid & 15) * 4; const float* sp = src(bt, k, n); v[i] = sp ? *(const float4*)sp : make_float4(0.f, 0.f, 0.f, 0.f); }
            __syncthreads();
#pragma unroll
            for (int i = 0; i < 4; ++i) { const int k = i * 32 + (tid >> 4), n = (tid & 15) * 4;
                T[(n + 0) * 136 + k] = f2bf(v[i].x); T[(n + 1) * 136 + k] = f2bf(v[i].y); T[(n + 2) * 136 + k] = f2bf(v[i].z); T[(n + 3) * 136 + k] = f2bf(v[i].w); }
            __syncthreads();
            { const int n = tid >> 3, kc = (tid & 7) * 16;
              const u32x4 a = *(const u32x4*)(T + n * 136 + kc), b = *(const u32x4*)(T + n * 136 + kc + 8);
              bf16_t* dp = dst + bt * dstride + (size_t)drow(n0 + n) * Kd + k0 + kc;
              *(u32x4*)dp = a; *(u32x4*)(dp + 8) = b; }
        }
    }
    return 0;
}
__device__ __forceinline__ int moe_cvt(const Params& p, int layer, char* lds, int budget) {
    constexpr int QG = 2, T13 = NE * 8 * 44, TOT = T13 + NE * 11 * 16;
    bf16_t* T = (bf16_t*)lds;
    int* qslot = (int*)(lds + 64 * 136 * 2);
    const int tid = tidx();
    const float* w1 = p.moe_w1 + (size_t)layer * NE * D * FF; const float* w3 = p.moe_w3 + (size_t)layer * NE * D * FF; const float* w2 = p.moe_w2 + (size_t)layer * NE * FF * D;
    bf16_t* W13 = (bf16_t*)(p.ws + OFF_W13T + (size_t)(layer & 1) * SZ_WMOE); bf16_t* W2 = (bf16_t*)(p.ws + OFF_W2T + (size_t)(layer & 1) * SZ_WMOE);
    unsigned* queue = (unsigned*)(p.ws + OFF_QUEUE) + layer * 32;
    const bool ahead = budget < 0;
    int done = 0, tnext = 0;
    __syncthreads();
    if (tid == 0) qslot[0] = QG * (int)__hip_atomic_fetch_add(queue, 1u, __ATOMIC_RELAXED, __HIP_MEMORY_SCOPE_AGENT);
    __syncthreads();
    int t0 = __builtin_amdgcn_readfirstlane(qslot[0]);
    while (t0 < TOT && (ahead || done < budget)) {
        const bool more = ahead || done + 1 < budget;
        if (more && tid == 0) tnext = QG * (int)__hip_atomic_fetch_add(queue, 1u, __ATOMIC_RELAXED, __HIP_MEMORY_SCOPE_AGENT);
#pragma unroll 1
        for (int sub = 0; sub < QG; ++sub) {
            const int t = t0 + sub;
            const float* sp; bf16_t* dp; int ss, ds;
            if (t < T13) { const int e = t / 352, r = t % 352, k0 = (r & 7) * 128, n0 = (r >> 3) * 64; const int c0 = (n0 >> 8) * 128 + (n0 & 127);
                sp = (((n0 >> 7) & 1) ? w3 : w1) + ((size_t)e * D + k0) * FF + c0; ss = FF; dp = W13 + ((size_t)e * 2816 + n0) * D + k0; ds = D; }
            else { const int u = t - T13, e = u / 176, r = u % 176, k0 = (r % 11) * 128, n0 = (r / 11) * 64;
                sp = w2 + ((size_t)e * FF + k0) * D + n0; ss = D; dp = W2 + ((size_t)e * D + n0) * FF + k0; ds = FF; }
            float4 v[4];
#pragma unroll
            for (int i = 0; i < 4; ++i) v[i] = *(const float4*)(sp + (size_t)(i * 32 + (tid >> 4)) * ss + (tid & 15) * 4);
            __syncthreads();
#pragma unroll
            for (int i = 0; i < 4; ++i) { const int k = i * 32 + (tid >> 4), n = (tid & 15) * 4;
                T[(n + 0) * 136 + k] = f2bf(v[i].x); T[(n + 1) * 136 + k] = f2bf(v[i].y); T[(n + 2) * 136 + k] = f2bf(v[i].z); T[(n + 3) * 136 + k] = f2bf(v[i].w); }
            if (sub == QG - 1 && tid == 0) qslot[0] = more ? tnext : TOT;
            __syncthreads();
            { const int n = tid >> 3, kc = (tid & 7) * 16;
              const u32x4 a = *(const u32x4*)(T + n * 136 + kc), b = *(const u32x4*)(T + n * 136 + kc + 8);
              bf16_t* o = dp + (size_t)n * ds + kc;
              *(u32x4*)o = a; *(u32x4*)(o + 8) = b; }
        }
        ++done; t0 = __builtin_amdgcn_readfirstlane(qslot[0]);
    }
    __syncthreads();
    return done;
}
__device__ __forceinline__ void bg_cvt(const Params& p, int layer, char* lds, int budget) {
#pragma unroll 1
    for (int l = layer; l < 4 && l <= layer + 1 && budget > 0; ++l) budget -= moe_cvt(p, l, lds, budget);
}
__device__ __forceinline__ bool idle_tail(int nunits) { const int r = nunits % gdim(); return r != 0 && bidx() >= r; }
__device__ void ph_init(const Params& p, char* lds) {
    const int tid = tidx(), gtid = bidx() * NTHR + tid, gsz = gdim() * NTHR;
    xt_t* Xs = (xt_t*)(p.ws + OFF_X);
    const float4* x4 = (const float4*)p.x; const float4* c4 = (const float4*)p.ctx;
    { constexpr int NQ = NROW * 256 / 4;
      auto srcv = [&](int k) { return k < NLAT * 256 ? x4[k] : c4[k - NLAT * 256]; };
      for (int i = gtid; i < NQ; i += gsz) { const float4 t0 = srcv(i), t1 = srcv(i + NQ), t2 = srcv(i + 2 * NQ), t3 = srcv(i + 3 * NQ); xst(Xs, (size_t)4 * i, t0); xst(Xs, (size_t)4 * (i + NQ), t1); xst(Xs, (size_t)4 * (i + 2 * NQ), t2); xst(Xs, (size_t)4 * (i + 3 * NQ), t3); } }
    float* rc = (float*)(p.ws + OFF_ROPE_C); float* rs = (float*)(p.ws + OFF_ROPE_S);
    for (int i = gtid; i < TL * 32; i += gsz) {
        const int t = i >> 5, f = i & 31; const float pos = (float)((f < 16) ? (t >> 6) : (t & 63));
        const float inv = powf(10000.f, -(float)(f & 15) / 16.f); const float ang = pos * inv; rc[2 * i] = cosf(ang); rc[2 * i + 1] = sinf(ang);
    }
    float* sc = (float*)lds;
    float* red = sc + 5 * 1024;
    for (int i = tid; i < 5 * 1024; i += NTHR) { const float v = i < 4096 ? p.c[i] : p.c_ctx[i - 4096]; sc[i] = v / (1.f + expf(-v)); }
    __syncthreads();
    float* MOD = (float*)(p.ws + OFF_MOD);
    for (int item = bidx(); item < 4 * 96; item += gdim()) {
        const int l = item / 96, cg = item % 96, col = tid & 63, n = cg * 64 + col, kg = tid >> 6;
        const float* w = p.mod_w + ((size_t)l * 1024 + kg * 128) * 6144 + n;
        float a0 = 0, a1 = 0, a2 = 0, a3 = 0, a4 = 0;
#pragma unroll 16
        for (int k = 0; k < 128; ++k) { const float wv = w[(size_t)k * 6144]; const int kk = kg * 128 + k;
            a0 += sc[kk] * wv; a1 += sc[1024 + kk] * wv; a2 += sc[2048 + kk] * wv; a3 += sc[3072 + kk] * wv; a4 += sc[4096 + kk] * wv; }
        float* rr = red + (kg * 64 + col) * 5; rr[0] = a0; rr[1] = a1; rr[2] = a2; rr[3] = a3; rr[4] = a4;
        __syncthreads();
        if (tid < 320) { const int c2 = tid & 63, s = tid >> 6; float sum = 0;
            for (int q = 0; q < 8; ++q) sum += red[(q * 64 + c2) * 5 + s];
            MOD[((size_t)l * 5 + s) * 6144 + cg * 64 + c2] = sum + p.mod_b[l * 6144 + cg * 64 + c2]; }
        __syncthreads();
    }
}


__device__ void ph_small_cvt(const Params& p, char* lds) {
    int rot = 128;
    for (int j = 0; j < 2; ++j) {
        char* wm = p.ws + OFF_WMLA + j * SZ_WMLA; char* wr = p.ws + OFF_WRW + j * SZ_WRW;
        const float* w_in = p.mla_w_in + (size_t)j * D * 448; const float* w_uq = p.mla_w_uq + (size_t)j * 256 * 1536; const float* w_ukv = p.mla_w_ukv + (size_t)j * 128 * 2048; const float* w_o = p.mla_w_o + (size_t)j * D * D;
        cvt_tiles(p.wv, lds, (bf16_t*)(wm + WM_IN), 1024, 512, 1, 0, [=](int, int k, int n) -> const float* { return n < 448 ? w_in + (size_t)k * 448 + n : nullptr; },
                  [=](int n) { if (n < 384 || n >= 448) return n; const int jj = n - 384; return 384 + (jj < 32 ? 2 * jj : 2 * (jj - 32) + 1); }, &rot);
        cvt_tiles(p.wv, lds, (bf16_t*)(wm + WM_UQ), 256, 1536, 1, 0, [=](int, int k, int n) -> const float* { return w_uq + (size_t)k * 1536 + n; },
                  [=](int n) { const int h = n / 192, d = n % 192; if (d < 128) return n; const int jj = d - 128; return h * 192 + 128 + (jj < 32 ? 2 * jj : 2 * (jj - 32) + 1); }, &rot);
        cvt_tiles(p.wv, lds, (bf16_t*)(wm + WM_UKV), 128, 2048, 1, 0, [=](int, int k, int n) -> const float* { return w_ukv + (size_t)k * 2048 + n; }, [=](int n) { return n; }, &rot);
        cvt_tiles(p.wv, lds, (bf16_t*)(wm + WM_O), 1024, 1024, 1, 0, [=](int, int k, int n) -> const float* { return w_o + (size_t)k * D + n; }, [=](int n) { return n; }, &rot);
        const float* w_rkv = p.rw_w_rkv + (size_t)j * 3 * D * D; const float* w1 = p.rw_w1 + (size_t)j * 2 * D * 64; const float* a1 = p.rw_a1 + (size_t)j * 2 * D * 64;
        const float* g1 = p.rw_g1 + (size_t)j * D * 128; const float* v1 = p.rw_v1; const float* rwo = p.rw_w_o + (size_t)j * D * D;
        cvt_tiles(p.wv, lds, (bf16_t*)(wr + WR_RKV), 1024, 1024, 3, (size_t)D * D, [=](int m, int k, int n) -> const float* { return w_rkv + ((size_t)m * D + k) * D + n; }, [=](int n) { return n; }, &rot);
        cvt_tiles(p.wv, lds, (bf16_t*)(wr + WR_L), 1024, 256, 1, 0, [=](int, int k, int n) -> const float* { return n < 128 ? w1 + ((size_t)(n >> 6) * D + k) * 64 + (n & 63) : nullptr; }, [=](int n) { return n; }, &rot);
        cvt_tiles(p.wv, lds, (bf16_t*)(wr + WR_L) + 256 * 1024, 1024, 256, 1, 0, [=](int, int k, int n) -> const float* { return n < 128 ? a1 + ((size_t)(n >> 6) * D + k) * 64 + (n & 63) : nullptr; }, [=](int n) { return n; }, &rot);
        cvt_tiles(p.wv, lds, (bf16_t*)(wr + WR_L) + 2 * 256 * 1024, 1024, 256, 1, 0, [=](int, int k, int n) -> const float* { return n < 128 ? g1 + (size_t)k * 128 + n : nullptr; }, [=](int n) { return n; }, &rot);
        cvt_tiles(p.wv, lds, (bf16_t*)(wr + WR_L) + 3 * 256 * 1024, 1024, 256, 1, 0, [=](int, int k, int n) -> const float* { return n < 32 ? v1 + (size_t)k * 32 + n : nullptr; }, [=](int n) { return n; }, &rot);
        cvt_tiles(p.wv, lds, (bf16_t*)(wr + WR_O), 1024, 1024, 1, 0, [=](int, int k, int n) -> const float* { return rwo + (size_t)k * D + n; }, [=](int n) { return n; }, &rot);
        const float* w2 = p.rw_w2 + (size_t)j * 2 * 64 * D; const float* a2 = p.rw_a2 + (size_t)j * 2 * 64 * D; const float* g2 = p.rw_g2 + (size_t)j * 128 * D; const float* v2 = p.rw_v2;
        cvt_tiles(p.wv, lds, (bf16_t*)(wr + WR_B2), 128, 2048, 2, (size_t)2048 * 128, [=](int bt, int k, int n) -> const float* { const int zz = n >> 10, c = n & 1023, l = k - zz * 64;
            if (l < 0 || l >= 64) return nullptr; return (bt == 0 ? w2 : a2) + ((size_t)zz * 64 + l) * D + c; }, [=](int n) { return n; }, &rot);
        cvt_tiles(p.wv, lds, (bf16_t*)(wr + WR_B3), 128, 1024, 2, (size_t)1024 * 128, [=](int bt, int k, int n) -> const float* {
            if (bt == 0) return g2 + (size_t)k * D + n; return k < 32 ? v2 + (size_t)k * D + n : nullptr; }, [=](int n) { return n; }, &rot);
    }
}

template <bool OUTF32>
__device__ void ph_norm_mod(const Params& p, int layer, const float* g, int part_sh, int part_sc, void* outp) {
    const int wid = tidx() >> 6, lane = tidx() & 63;
    const xt_t* X = (const xt_t*)(p.ws + OFF_X);
    const int w_ = bidx() * 8 + wid, nw_ = gdim() * 8;
    int row = (int)((long long)w_ * NROW / nw_); const int rend = (int)((long long)(w_ + 1) * NROW / nw_);
    float4 nv[4], gm[4], bb[4]; int scur = -1;
    if (row < rend) {
#pragma unroll
        for (int i = 0; i < 4; ++i) nv[i] = xld(X, (size_t)row * D + (lane + i * 64) * 4); }
    for (; row < rend; ++row) {
        const int s = row_stream(row);
        if (s != scur) { scur = s; const float* sh = modp(p, layer, s, part_sh); const float* sc = modp(p, layer, s, part_sc);
#pragma unroll
            for (int i = 0; i < 4; ++i) { const int d = (lane + i * 64) * 4; const float4 gg = *(const float4*)(g + d), a = *(const float4*)(sc + d); bb[i] = *(const float4*)(sh + d);
                gm[i] = make_float4(gg.x * (1.f + a.x), gg.y * (1.f + a.y), gg.z * (1.f + a.z), gg.w * (1.f + a.w)); } }
        float4 v[4]; float ss = 0;
#pragma unroll
        for (int i = 0; i < 4; ++i) { v[i] = nv[i]; ss += v[i].x * v[i].x + v[i].y * v[i].y + v[i].z * v[i].z + v[i].w * v[i].w; }
        { const int nrow = row + 1;
          if (nrow < rend) {
#pragma unroll
              for (int i = 0; i < 4; ++i) nv[i] = xld(X, (size_t)nrow * D + (lane + i * 64) * 4); } }
        ss = wave_sum(ss); const float rs = rsqrtf(ss * (1.f / D) + RMS_EPS);
#pragma unroll
        for (int i = 0; i < 4; ++i) {
            const int d = (lane + i * 64) * 4;
            float4 o; o.x = v[i].x * rs * gm[i].x + bb[i].x; o.y = v[i].y * rs * gm[i].y + bb[i].y; o.z = v[i].z * rs * gm[i].z + bb[i].z; o.w = v[i].w * rs * gm[i].w + bb[i].w;
            if (OUTF32) *(float4*)((float*)outp + (size_t)row * D + d) = o;
            else { uint2 w; w.x = pk2(o.x, o.y); w.y = pk2(o.z, o.w); *(uint2*)((bf16_t*)outp + (size_t)row * D + d) = w; }
        }
    }
}

__device__ void ph_mla_mid(const Params& p, int j) {
    const int wid = tidx() >> 6, lane = tidx() & 63;
    const float* Z = (const float*)(p.ws + OFF_Z);
    bf16_t* CQN = (bf16_t*)(p.ws + OFF_CQN); bf16_t* CKVN = (bf16_t*)(p.ws + OFF_CKVN); bf16_t* K = (bf16_t*)(p.ws + OFF_K);
    const float* gq = p.mla_g_q + j * 256; const float* gkv = p.mla_g_kv + j * 128;
    const float* rc = (const float*)(p.ws + OFF_ROPE_C); const float* rs = (const float*)(p.ws + OFF_ROPE_S);
    for (int row = bidx() * 8 + wid; row < NROW; row += gdim() * 8) {
        const float* z = Z + (size_t)row * 512;
        const float4 q = *(const float4*)(z + lane * 4);
        const float2 kv = *(const float2*)(z + 256 + lane * 2);
        const float kr = z[384 + lane];
        float sq = wave_sum(q.x * q.x + q.y * q.y + q.z * q.z + q.w * q.w); const float rq = rsqrtf(sq * (1.f / 256.f) + RMS_EPS);
        float sk = wave_sum(kv.x * kv.x + kv.y * kv.y); const float rk = rsqrtf(sk * (1.f / 128.f) + RMS_EPS);
        const float4 g4 = *(const float4*)(gq + lane * 4); const float2 g2 = *(const float2*)(gkv + lane * 2);
        uint2 w; w.x = pk2(q.x * rq * g4.x, q.y * rq * g4.y); w.y = pk2(q.z * rq * g4.z, q.w * rq * g4.w);
        *(uint2*)(CQN + (size_t)row * 256 + lane * 4) = w;
        *(unsigned*)(CKVN + (size_t)row * 128 + lane * 2) = pk2(kv.x * rk * g2.x, kv.y * rk * g2.y);
        float o = kr;
        const float other = __builtin_bit_cast(float, __builtin_amdgcn_update_dpp(0, __builtin_bit_cast(int, kr), 0xB1, 0xF, 0xF, true));
        const bool lat = row < NLAT;
        if (lat) { const int t = row & (TL - 1), i = lane >> 1; const float2 cs = *(const float2*)(rc + (t * 32 + i) * 2); const float c = cs.x, s = cs.y;
            o = (lane & 1) ? (other * s + kr * c) : (kr * c - other * s); }
        const int b = lat ? (row >> 12) : ((row - NLAT) >> 8); const int tk = lat ? 256 + (row & (TL - 1)) : ((row - NLAT) & 255);
        const bf16_t ob = f2bf(o);
#pragma unroll
        for (int h = 0; h < 8; ++h) K[((size_t)(b * 8 + h) * TK + tk) * 192 + 128 + lane] = ob;
    }
}

__device__ void ph_qkv_post(const Params& p) {
    const int wid = tidx() >> 6, lane = tidx() & 63;
    const float* QRAW = (const float*)(p.ws + OFF_QRAW); const float* KVRAW = (const float*)(p.ws + OFF_KVRAW); const float* KR = (const float*)(p.ws + OFF_KR);
    bf16_t* Q = (bf16_t*)(p.ws + OFF_Q); bf16_t* K = (bf16_t*)(p.ws + OFF_K); bf16_t* V = (bf16_t*)(p.ws + OFF_V);
    const float* rc = (const float*)(p.ws + OFF_ROPE_C); const float* rs = (const float*)(p.ws + OFF_ROPE_S);
    for (int it = bidx() * 8 + wid; it < NROW * 8; it += gdim() * 8) {
        const int row = it >> 3, h = it & 7;
        const bool lat = row < NLAT; const int b = lat ? (row >> 12) : ((row - NLAT) >> 8); const int tk = lat ? 256 + (row & (TL - 1)) : ((row - NLAT) & 255);
        const size_t orow = (size_t)(b * 8 + h) * TK + tk;
        const float* q = QRAW + (size_t)row * 1536 + h * 192;
        const float q0 = q[lane], q1 = q[64 + lane]; float q2 = q[128 + lane];
        const auto sw = __builtin_amdgcn_permlane32_swap(__float_as_uint(q2), __float_as_uint(q2), false, false);
        if (lat) { const int t = row & (TL - 1), i = lane & 31; const float c = rc[t * 32 + i], s = rs[t * 32 + i];
            const float x1 = __uint_as_float(sw[0]), x2 = __uint_as_float(sw[1]); q2 = lane < 32 ? (x1 * c - x2 * s) : (x1 * s + x2 * c); }
        bf16_t* qo = Q + orow * 192; qo[lane] = f2bf(q0); qo[64 + lane] = f2bf(q1); qo[128 + lane] = f2bf(q2);
        const float* kv = KVRAW + (size_t)row * 2048 + h * 256;
        bf16_t* ko = K + orow * 192; ko[lane] = f2bf(kv[lane]); ko[64 + lane] = f2bf(kv[64 + lane]); ko[128 + lane] = f2bf(KR[(size_t)row * 64 + lane]);
        bf16_t* vo = V + orow * 128; vo[lane] = f2bf(kv[128 + lane]); vo[64 + lane] = f2bf(kv[192 + lane]);
    }
}

__device__ void ph_attn_naive(const Params& p, char* lds) {
    const int tid = tidx(), qi = tid >> 2, part = tid & 3;
    const bf16_t* Q = (const bf16_t*)(p.ws + OFF_Q); const bf16_t* K = (const bf16_t*)(p.ws + OFF_K); const bf16_t* V = (const bf16_t*)(p.ws + OFF_V);
    bf16_t* O = (bf16_t*)(p.ws + OFF_O);
    bf16_t* Ks = (bf16_t*)lds;
    bf16_t* Vs = Ks + 32 * 192;
    const int nitems = 32 * 34;
    for (int it = bidx(); it < nitems; it += gdim()) {
        const int bh = it / 34, qb = it % 34; const int b = bh >> 3, h = bh & 7;
        const int nkeys = qb < 2 ? TC : TK;
        const int tq = qb * 128 + qi;
        const bf16_t* qp = Q + ((size_t)bh * TK + tq) * 192 + part * 48;
        float q[48];
#pragma unroll
        for (int i = 0; i < 48; ++i) q[i] = bf2f(qp[i]) * ATT_SCALE;
        float o[32];
#pragma unroll
        for (int i = 0; i < 32; ++i) o[i] = 0.f;
        float m = -1e30f, l = 0.f;
        for (int k0 = 0; k0 < nkeys; k0 += 32) {
            __syncthreads();
            {
                const bf16_t* kg = K + ((size_t)bh * TK + k0) * 192; const bf16_t* vg = V + ((size_t)bh * TK + k0) * 128;
                for (int c = tid; c < 768; c += NTHR) *(u32x4*)(Ks + c * 8) = *(const u32x4*)(kg + c * 8);
                *(u32x4*)(Vs + tid * 8) = *(const u32x4*)(vg + tid * 8);
            }
            __syncthreads();
#pragma unroll 1
            for (int kg = 0; kg < 32; kg += 8) {
                float s[8]; float tmax = -1e30f;
#pragma unroll
                for (int kk = 0; kk < 8; ++kk) {
                    const bf16_t* kr = Ks + (kg + kk) * 192 + part * 48; float acc = 0.f;
#pragma unroll
                    for (int i = 0; i < 48; ++i) acc += q[i] * bf2f(kr[i]);
                    acc += __shfl_xor(acc, 1); acc += __shfl_xor(acc, 2);
                    s[kk] = acc; tmax = fmaxf(tmax, acc);
                    asm volatile("" ::: "memory");
                }
                const float mn = fmaxf(m, tmax), alpha = expf(m - mn); m = mn; l *= alpha;
#pragma unroll
                for (int i = 0; i < 32; ++i) o[i] *= alpha;
#pragma unroll
                for (int kk = 0; kk < 8; ++kk) {
                    const float pw = expf(s[kk] - mn); l += pw;
                    const bf16_t* vr = Vs + (kg + kk) * 128 + part * 32;
#pragma unroll
                    for (int i = 0; i < 32; ++i) o[i] += pw * bf2f(vr[i]);
                    asm volatile("" ::: "memory");
                }
            }
        }
        const float rl = 1.f / l;
        const int row = qb < 2 ? (NLAT + b * TC + tq) : (b * TL + tq - TC);
        bf16_t* op = O + (size_t)row * D + h * 128 + part * 32;
#pragma unroll
        for (int i = 0; i < 32; ++i) op[i] = f2bf(o[i] * rl);
    }
}


namespace fa {
using s16x4  = __attribute__((ext_vector_type(4))) short;
using f32x16 = __attribute__((ext_vector_type(16))) float;
constexpr int DQK = 192, DV = 128, KVBLK = 64;
constexpr float THR = 8.f;
constexpr int SHM_V = KVBLK * DV * 2, SHM_K = KVBLK * DQK * 2;
constexpr int SHM_ATTN = 2 * SHM_V + 2 * SHM_K + 8 * 64 * 4;
#define KSWZ(row, colB) ((row) * 384 + ((colB) ^ ((((row) >> 1) & 7) << 4)))
#define SBAR() __builtin_amdgcn_sched_barrier(0)
__device__ __forceinline__ int crow(int r, int hi) { return (r & 3) + 8 * (r >> 2) + 4 * hi; }
__device__ __forceinline__ unsigned cvtpk(float lo, float hi) { unsigned r; asm volatile("v_cvt_pk_bf16_f32 %0, %1, %2" : "=v"(r) : "v"(lo), "v"(hi)); return r; }
__device__ __forceinline__ void partialSM(f32x16& p0, f32x16& p1, float& m_reg, float& mn, float& alpha) {
  constexpr float C = ATT_SCALE * 1.4426950408889634f;
  float pmax = p0[0];
#pragma unroll
  for (int r = 1; r < 16; ++r) pmax = fmaxf(pmax, p0[r]);
#pragma unroll
  for (int r = 0; r < 16; ++r) pmax = fmaxf(pmax, p1[r]);
  { auto rr = __builtin_amdgcn_permlane32_swap(__float_as_uint(pmax), __float_as_uint(pmax), false, false);
    pmax = fmaxf(__uint_as_float(rr[0]), __uint_as_float(rr[1])); }
  if (__builtin_expect(__all(pmax - m_reg <= THR / ATT_SCALE), 1)) { mn = m_reg; alpha = 1.f; }
  else { mn = fmaxf(m_reg, pmax); alpha = __builtin_amdgcn_exp2f((m_reg - mn) * C); m_reg = mn; }
  float mnC = -mn * C;
#pragma unroll
  for (int r = 0; r < 16; ++r) p0[r] = fmaf(p0[r], C, mnC);
#pragma unroll
  for (int r = 0; r < 16; ++r) p1[r] = fmaf(p1[r], C, mnC);
#pragma unroll
  for (int r = 0; r < 16; ++r) p0[r] = __builtin_amdgcn_exp2f(p0[r]);
}
__device__ __forceinline__ void finishSM(f32x16& p0, f32x16& p1, float alpha, float& l_reg, bf16x8& pa0, bf16x8& pa1, bf16x8& pa2, bf16x8& pa3) {
#pragma unroll
  for (int r = 0; r < 16; ++r) p1[r] = __builtin_amdgcn_exp2f(p1[r]);
  float ps = 0;
#pragma unroll
  for (int r = 0; r < 16; ++r) ps += p0[r];
#pragma unroll
  for (int r = 0; r < 16; ++r) ps += p1[r];
  { auto rr = __builtin_amdgcn_permlane32_swap(__float_as_uint(ps), __float_as_uint(ps), false, false);
    ps = __uint_as_float(rr[0]) + __uint_as_float(rr[1]); }
  l_reg = l_reg * alpha + ps;
#define PK4(P, BASE, OUT) do { unsigned a0 = cvtpk(P[BASE + 0], P[BASE + 1]), a1 = cvtpk(P[BASE + 2], P[BASE + 3]);   \
    unsigned b0 = cvtpk(P[BASE + 4], P[BASE + 5]), b1 = cvtpk(P[BASE + 6], P[BASE + 7]);                              \
    auto r0 = __builtin_amdgcn_permlane32_swap(a0, b0, false, false); auto r1 = __builtin_amdgcn_permlane32_swap(a1, b1, false, false); \
    u32x4 w = {r0[0], r1[0], r0[1], r1[1]}; OUT = *reinterpret_cast<bf16x8*>(&w); } while (0)
  PK4(p0, 0, pa0); PK4(p0, 8, pa1); PK4(p1, 0, pa2); PK4(p1, 8, pa3);
#undef PK4
}
__device__ __forceinline__ void qkt(f32x16& p0, f32x16& p1, const char* Ks, const bf16x8* qr, int r32, int hi) {
  p0 = f32x16{}; p1 = f32x16{};
  const int swz = ((r32 >> 1) & 7) << 4;
  const char* b4[4];
#pragma unroll
  for (int dr = 0; dr < 4; ++dr) b4[dr] = Ks + r32 * 384 + ((dr * 32 + hi * 16) ^ swz);
#pragma unroll
  for (int d0 = 0; d0 < 12; ++d0) {
    bf16x8 b0 = *reinterpret_cast<const bf16x8*>(b4[d0 & 3] + (d0 >> 2) * 128);
    bf16x8 b1 = *reinterpret_cast<const bf16x8*>(b4[d0 & 3] + (d0 >> 2) * 128 + 32 * 384);
    p0 = __builtin_amdgcn_mfma_f32_32x32x16_bf16(b0, qr[d0], p0, 0, 0, 0);
    p1 = __builtin_amdgcn_mfma_f32_32x32x16_bf16(b1, qr[d0], p1, 0, 0, 0); }
}
__device__ __forceinline__ int v_st(int k, int c) { const int kk = (k & ~0xC) | ((k & 4) << 1) | ((k & 8) >> 1); return ((kk >> 3) * 4 + (c >> 5)) * 512 + ((kk & 7) * 32 + (c & 31)) * 2; }
__device__ __forceinline__ int v_rd_base(int lane) { return ((lane & 3) << 3) | (((lane >> 2) & 3) << 6) | (((lane >> 4) & 1) << 5) | (((lane >> 5) & 1) << 8); }
constexpr int v_rd_off(int d0, int ks, int half) { return d0 * 512 + ks * 4096 + half * 2048; }
template <int OFF> __device__ __forceinline__ s16x4 tr_read(int vb) {
  s16x4 r; asm volatile("ds_read_b64_tr_b16 %0, %1 offset:%2" : "=&v"(r) : "v"(vb), "i"(OFF) : "memory"); return r;
}
template <int D0> __device__ __forceinline__ void pv_one(f32x16& od, int vb, bf16x8 pa0, bf16x8 pa1, bf16x8 pa2, bf16x8 pa3) {
  const s16x4 l0 = tr_read<v_rd_off(D0, 0, 0)>(vb), h0 = tr_read<v_rd_off(D0, 0, 1)>(vb), l1 = tr_read<v_rd_off(D0, 1, 0)>(vb), h1 = tr_read<v_rd_off(D0, 1, 1)>(vb);
  const s16x4 l2 = tr_read<v_rd_off(D0, 2, 0)>(vb), h2 = tr_read<v_rd_off(D0, 2, 1)>(vb), l3 = tr_read<v_rd_off(D0, 3, 0)>(vb), h3 = tr_read<v_rd_off(D0, 3, 1)>(vb);
  asm volatile("s_waitcnt lgkmcnt(0)" ::: "memory"); SBAR();
#define PK(L, H) (bf16x8){L[0], L[1], L[2], L[3], H[0], H[1], H[2], H[3]}
  od = __builtin_amdgcn_mfma_f32_32x32x16_bf16(pa0, PK(l0, h0), od, 0, 0, 0);
  od = __builtin_amdgcn_mfma_f32_32x32x16_bf16(pa1, PK(l1, h1), od, 0, 0, 0);
  od = __builtin_amdgcn_mfma_f32_32x32x16_bf16(pa2, PK(l2, h2), od, 0, 0, 0);
  od = __builtin_amdgcn_mfma_f32_32x32x16_bf16(pa3, PK(l3, h3), od, 0, 0, 0);
#undef PK
}
__device__ __forceinline__ void pv_d0(f32x16* o, int vb, bf16x8 pa0, bf16x8 pa1, bf16x8 pa2, bf16x8 pa3) {
  pv_one<0>(o[0], vb, pa0, pa1, pa2, pa3); pv_one<1>(o[1], vb, pa0, pa1, pa2, pa3); pv_one<2>(o[2], vb, pa0, pa1, pa2, pa3); pv_one<3>(o[3], vb, pa0, pa1, pa2, pa3);
}
__device__ __forceinline__ void attn_body(const int wv_, const bf16_t* __restrict__ Qb, const bf16_t* __restrict__ Kh, const bf16_t* __restrict__ Vh, bf16_t* __restrict__ Ob, int ldo, int seq, char* lds, const float* __restrict__ ropecs  ) {
  const int tid = tidx_w(wv_), wid = tid >> 6, lane = tid & 63, r32 = lane & 31, hi = lane >> 5;
  char* V_lds = lds; char* K_lds = lds + 2 * SHM_V;
  float* ws = (float*)(lds + 2 * SHM_V + 2 * SHM_K) + wid * 64; float* li_l = ws; float* al_l = ws + 32;
  float m_reg = -1e30f, l_reg = 0; f32x16 o[4] = {}; bf16x8 qr[12];
  const bf16_t* Qw = Qb + (long)(wid * 32 + r32) * DQK + hi * 8;
#pragma unroll
  for (int d0 = 0; d0 < 12; ++d0) qr[d0] = *reinterpret_cast<const bf16x8*>(Qw + d0 * 16);
  if (ropecs) {
    const float* cs = ropecs + (size_t)(wid * 32 + r32) * 64;
#pragma unroll
    for (int d0 = 8; d0 < 12; ++d0) { const int i0 = (d0 - 8) * 8 + hi * 4; const f32x4 c0 = *(const f32x4*)(cs + i0 * 2), c1 = *(const f32x4*)(cs + i0 * 2 + 4);
      u32x4 w = *reinterpret_cast<u32x4*>(&qr[d0]); const float cc[4] = {c0[0], c0[2], c1[0], c1[2]}, ss[4] = {c0[1], c0[3], c1[1], c1[3]};
#pragma unroll
      for (int m = 0; m < 4; ++m) { const float x1 = __uint_as_float(w[m] << 16), x2 = __uint_as_float(w[m] & 0xffff0000u); w[m] = cvtpk(x1 * cc[m] - x2 * ss[m], x1 * ss[m] + x2 * cc[m]); }
      qr[d0] = *reinterpret_cast<bf16x8*>(&w); }
  }
  const int sr = tid >> 4, sc = (tid & 15) * 8, vst0 = v_st(sr, sc), vst1 = v_st(32 + sr, sc);
  int kst[3];
#pragma unroll
  for (int i = 0; i < 3; ++i) { const int c = tid + 512 * i, row = c / 24, cc = c % 24; kst[i] = KSWZ(row, cc * 16); }
  const int vb0 = (int)(uintptr_t)V_lds + v_rd_base(lane);
  struct { bf16x8 vs0, vs1, ks0, ks1, ks2; } sr_[1];
#define SLOAD(i, k0) do { const bf16_t* vt = Vh + (long)(k0) * DV; const bf16_t* kt = Kh + (long)(k0) * DQK; \
    sr_[i].vs0 = *reinterpret_cast<const bf16x8*>(vt + (sr) * DV + sc); sr_[i].vs1 = *reinterpret_cast<const bf16x8*>(vt + (32 + sr) * DV + sc); \
    sr_[i].ks0 = *reinterpret_cast<const bf16x8*>(kt + tid * 8); sr_[i].ks1 = *reinterpret_cast<const bf16x8*>(kt + (tid + 512) * 8); sr_[i].ks2 = *reinterpret_cast<const bf16x8*>(kt + (tid + 1024) * 8); } while (0)
#define SWRITE(b, i) do { *(bf16x8*)(V_lds + (b) * SHM_V + vst0) = sr_[i].vs0; *(bf16x8*)(V_lds + (b) * SHM_V + vst1) = sr_[i].vs1; \
    *(bf16x8*)(K_lds + (b) * SHM_K + kst[0]) = sr_[i].ks0; *(bf16x8*)(K_lds + (b) * SHM_K + kst[1]) = sr_[i].ks1; *(bf16x8*)(K_lds + (b) * SHM_K + kst[2]) = sr_[i].ks2; } while (0)
#define SWAIT() asm volatile("s_waitcnt vmcnt(5)" ::: "memory")
#define RESC(a) do { if (__any((a) < 1.f)) { if (hi == 0) al_l[r32] = (a); asm volatile("s_waitcnt lgkmcnt(0)" ::: "memory"); \
    _Pragma("unroll") for (int d = 0; d < 4; ++d) _Pragma("unroll") for (int r = 0; r < 16; ++r) o[d][r] *= al_l[crow(r, hi)]; } } while (0)
  f32x16 pA0, pA1; float mnA, alA; bf16x8 pa0, pa1, pa2, pa3; const int NT = seq / KVBLK;
  SLOAD(0, 0); SWRITE(0, 0);
  SLOAD(0, KVBLK);
  __syncthreads();
  for (int j = 0; j < NT; j += 2) {
    SBAR(); qkt(pA0, pA1, K_lds, qr, r32, hi);
    partialSM(pA0, pA1, m_reg, mnA, alA); RESC(alA);
    finishSM(pA0, pA1, alA, l_reg, pa0, pa1, pa2, pa3); SBAR();
    SWRITE(1, 0);
    if (j + 2 < NT) SLOAD(0, (j + 2) * KVBLK);
    SBAR();
    pv_d0(o, vb0, pa0, pa1, pa2, pa3);
    __syncthreads();
    SBAR(); qkt(pA0, pA1, K_lds + SHM_K, qr, r32, hi);
    partialSM(pA0, pA1, m_reg, mnA, alA); RESC(alA);
    finishSM(pA0, pA1, alA, l_reg, pa0, pa1, pa2, pa3); SBAR();
    if (j + 2 < NT) { SWRITE(0, 0); if (j + 3 < NT) SLOAD(0, (j + 3) * KVBLK); }
    SBAR();
    pv_d0(o, vb0 + SHM_V, pa0, pa1, pa2, pa3);
    __syncthreads();
  }
  if (hi == 0) li_l[r32] = l_reg; asm volatile("s_waitcnt lgkmcnt(0)" ::: "memory");
  float rli[16];
#pragma unroll
  for (int r = 0; r < 16; ++r) rli[r] = __builtin_amdgcn_rcpf(li_l[crow(r, hi)]);
  bf16_t* Ow = Ob + (long)(wid * 32) * ldo;
#pragma unroll
  for (int r = 0; r < 16; ++r) { int orow = crow(r, hi);
#pragma unroll
    for (int d0 = 0; d0 < 4; ++d0) Ow[(long)orow * ldo + d0 * 32 + r32] = f2bf(o[d0][r] * rli[r]); }
  __syncthreads();
#undef SLOAD
#undef SWRITE
#undef SWAIT
#undef RESC
}
#undef KSWZ
}

__device__ void ph_attn(const Params& p, char* lds) {
    const bf16_t* Q = (const bf16_t*)(p.ws + OFF_Q); const bf16_t* K = (const bf16_t*)(p.ws + OFF_K); const bf16_t* V = (const bf16_t*)(p.ws + OFF_V);
    bf16_t* O = (bf16_t*)(p.ws + OFF_O);
    const int G = gdim();
    for (int i = 0;; ++i) {
        const int L = i * G + bidx(); if (L >= 544) break;
        int bh, qb;
        if (L < 512) { const int w = g8::xcd_remap(L, 512); bh = w >> 4; qb = 1 + (w & 15); } else { bh = L - 512; qb = 0; }
        const int b = bh >> 3, h = bh & 7;
        const int seq = qb == 0 ? TC : TK;
        const int row0 = qb == 0 ? NLAT + b * TC : b * TL + (qb - 1) * 256;
        fa::attn_body(p.wv, Q + ((size_t)bh * TK + qb * 256) * 192, K + (size_t)bh * TK * 192, V + (size_t)bh * TK * 128, O + (size_t)row0 * D + h * 128, D, seq, lds,
                      qb == 0 ? nullptr : (const float*)(p.ws + OFF_ROPE_C) + (size_t)(qb - 1) * 256 * 64);
    }
}

__device__ void ph_norm2_router(const Params& p, int layer, char* lds, int nrows) {
    const int tid = tidx(), wid = tid >> 6, lane = tid & 63;
    float* rt = (float*)lds;
    const float* rg = p.moe_router + (size_t)layer * D * NE;
    for (int i = tid; i < D * NE / 4; i += NTHR) { const int d = i >> 2, eq = i & 3; ((float4*)rt)[(((d >> 8) * 4 + (d & 3)) * 4 + eq) * 64 + ((d & 255) >> 2)] = ((const float4*)rg)[i]; }
    __syncthreads();
    const xt_t* X = (const xt_t*)(p.ws + OFF_X); bf16_t* BN = (bf16_t*)(p.ws + OFF_H); float* AFF = (float*)(p.ws + OFF_AFF);
    const float* g = p.norm2_g + layer * D;
    const int w_ = bidx() * 8 + wid, nw_ = gdim() * 8;
    int row = (int)((long long)w_ * nrows / nw_); const int rend = (int)((long long)(w_ + 1) * nrows / nw_);
    float4 nv[4], gm[4], bb[4]; int scur = -1;
    if (row < rend) {
#pragma unroll
        for (int i = 0; i < 4; ++i) nv[i] = xld(X, (size_t)row * D + (lane + i * 64) * 4); }
    for (; row < rend; ++row) {
        const int s = row_stream(row);
        if (s != scur) { scur = s; const float* sh = modp(p, layer, s, 3); const float* sc = modp(p, layer, s, 4);
#pragma unroll
            for (int i = 0; i < 4; ++i) { const int d = (lane + i * 64) * 4; const float4 gg = *(const float4*)(g + d), a = *(const float4*)(sc + d); bb[i] = *(const float4*)(sh + d);
                gm[i] = make_float4(gg.x * (1.f + a.x), gg.y * (1.f + a.y), gg.z * (1.f + a.z), gg.w * (1.f + a.w)); } }
        float4 v[4]; float ss = 0;
#pragma unroll
        for (int i = 0; i < 4; ++i) { v[i] = nv[i]; ss += v[i].x * v[i].x + v[i].y * v[i].y + v[i].z * v[i].z + v[i].w * v[i].w; }
        { const int nrow = row + 1;
          if (nrow < rend) {
#pragma unroll
              for (int i = 0; i < 4; ++i) nv[i] = xld(X, (size_t)nrow * D + (lane + i * 64) * 4); } }
        ss = wave_sum(ss); const float rs = rsqrtf(ss * (1.f / D) + RMS_EPS);
        float lg[16];
#pragma unroll
        for (int e = 0; e < 16; ++e) lg[e] = 0.f;
#pragma unroll
        for (int i = 0; i < 4; ++i) {
            const int d = (lane + i * 64) * 4;
            float o[4]; o[0] = v[i].x * rs * gm[i].x + bb[i].x; o[1] = v[i].y * rs * gm[i].y + bb[i].y; o[2] = v[i].z * rs * gm[i].z + bb[i].z; o[3] = v[i].w * rs * gm[i].w + bb[i].w;
            uint2 w; w.x = pk2(o[0], o[1]); w.y = pk2(o[2], o[3]); *(uint2*)(BN + (size_t)row * D + d) = w;
#pragma unroll
            for (int jj = 0; jj < 4; ++jj) {
#pragma unroll
                for (int eq = 0; eq < 4; ++eq) { const float4 r4 = ((const float4*)rt)[((i * 4 + jj) * 4 + eq) * 64 + lane];
                    lg[4 * eq] += o[jj] * r4.x; lg[4 * eq + 1] += o[jj] * r4.y; lg[4 * eq + 2] += o[jj] * r4.z; lg[4 * eq + 3] += o[jj] * r4.w; } }
            asm volatile("" ::: "memory");
        }
        float mx = -1e30f;
#pragma unroll
        for (int e = 0; e < 16; ++e) { lg[e] = wave_sum(lg[e]); mx = fmaxf(mx, lg[e]); }
        float sum = 0;
#pragma unroll
        for (int e = 0; e < 16; ++e) { lg[e] = expf(lg[e] - mx); sum += lg[e]; }
        const float inv = 1.f / sum;
        if (lane < 16) { float val = 0;
#pragma unroll
            for (int e = 0; e < 16; ++e) val = (lane == e) ? lg[e] : val;
            AFF[(size_t)row * 16 + lane] = val * inv; }
    }
}

__device__ void ph_select(const Params& p, char* lds, int ngroups) {
    const int tid = tidx(), wid = tid >> 6, lane = tid & 63;
    unsigned* hist = (unsigned*)lds;
    unsigned* ctl = hist + 256;
    unsigned* wsum = ctl + 8;
    int* rowl = (int*)(wsum + 16);
    const float* AFF = (const float*)(p.ws + OFF_AFF);
    int* ROWIDX = (int*)(p.ws + OFF_ROWIDX); float* GATE = (float*)(p.ws + OFF_GATE); int* SLOT = (int*)(p.ws + OFF_SLOT);
    for (int gidx = bidx(); gidx < ngroups; gidx += gdim()) {
        const bool lat = gidx < 64; const int b = (gidx & 63) >> 4, e = gidx & 15;
        const int n = lat ? TL : TC, cap = lat ? CAPL : CAPC;
        const int row0 = lat ? b * TL : NLAT + b * TC, slot0 = lat ? b * CAPL : NB * CAPL + b * CAPC;
        unsigned key[8];
#pragma unroll
        for (int i = 0; i < 8; ++i) { const int idx = tid * 8 + i; key[i] = idx < n ? __float_as_uint(AFF[(size_t)(row0 + idx) * 16 + e]) : 0u; }
        unsigned prefix = 0u, remaining = (unsigned)cap;
#pragma unroll
        for (int pass = 0; pass < 4; ++pass) {
            const int sh = 24 - 8 * pass;
            __syncthreads();
            if (tid < 256) hist[tid] = 0u;
            __syncthreads();
#pragma unroll
            for (int i = 0; i < 8; ++i) { const int idx = tid * 8 + i;
                const bool cand = idx < n && (pass == 0 || (key[i] >> (sh + 8)) == prefix);
                if (cand) atomicAdd(&hist[(key[i] >> sh) & 255u], 1u); }
            __syncthreads();
            if (tid < 256) { unsigned gt = 0; for (int jj = tid + 1; jj < 256; ++jj) gt += hist[jj];
                const unsigned mine = hist[tid];
                if (gt < remaining && remaining <= gt + mine) { ctl[0] = (unsigned)tid; ctl[1] = remaining - gt; } }
            __syncthreads();
            prefix = (prefix << 8) | ctl[0]; remaining = ctl[1];
        }
        const unsigned T = prefix, m = remaining;
        unsigned cgt = 0, ceq = 0;
#pragma unroll
        for (int i = 0; i < 8; ++i) { const int idx = tid * 8 + i; if (idx < n) { cgt += key[i] > T ? 1u : 0u; ceq += key[i] == T ? 1u : 0u; } }
        auto block_excl = [&](unsigned v) -> unsigned {
            unsigned inc = v;
#pragma unroll
            for (int o = 1; o < 64; o <<= 1) { const unsigned t = (unsigned)__builtin_amdgcn_ds_bpermute((lane - o) << 2, (int)inc); if (lane >= o) inc += t; }
            __syncthreads();
            if (lane == 63) wsum[wid] = inc;
            __syncthreads();
            unsigned base = 0;
#pragma unroll
            for (int w = 0; w < 8; ++w) base += (w < wid) ? wsum[w] : 0u;
            return base + inc - v; };
        unsigned eqbase = block_excl(ceq);
        unsigned nsel = 0; bool sel[8];
#pragma unroll
        for (int i = 0; i < 8; ++i) { const int idx = tid * 8 + i; bool s_ = false;
            if (idx < n) { if (key[i] > T) s_ = true; else if (key[i] == T) { s_ = eqbase < m; ++eqbase; } }
            sel[i] = s_; nsel += s_ ? 1u : 0u; }
        unsigned sbase = block_excl(nsel);
#pragma unroll
        for (int i = 0; i < 8; ++i) { const int idx = tid * 8 + i;
            if (idx < n) {
                if (sel[i]) { const int sl = slot0 + (int)sbase; rowl[sbase] = row0 + idx; ++sbase; ROWIDX[e * ESLOTS + sl] = row0 + idx; GATE[e * EPAD + sl] = __uint_as_float(key[i]); SLOT[(size_t)(row0 + idx) * 16 + e] = sl; }
                else SLOT[(size_t)(row0 + idx) * 16 + e] = -1; } }
        __syncthreads();
        { const bf16_t* BN = (const bf16_t*)(p.ws + OFF_H); bf16_t* XE = (bf16_t*)(p.ws + OFF_XE);
          for (int r = wid; r < cap; r += 32) {
              u32x4 t_[4][2];
#pragma unroll
              for (int u = 0; u < 4; ++u) { const u32x4* src = (const u32x4*)(BN + (size_t)rowl[r + 8 * u] * D); t_[u][0] = src[lane]; t_[u][1] = src[lane + 64]; }
#pragma unroll
              for (int u = 0; u < 4; ++u) { u32x4* dst = (u32x4*)(XE + ((size_t)e * EPAD + slot0 + r + 8 * u) * D); dst[lane] = t_[u][0]; dst[lane + 64] = t_[u][1]; } } }
    }
}

__device__ void ph_gather(const Params& p, int nslots) {
    const int wid = tidx() >> 6, lane = tidx() & 63;
    const int* ROWIDX = (const int*)(p.ws + OFF_ROWIDX); const bf16_t* BN = (const bf16_t*)(p.ws + OFF_H); bf16_t* XE = (bf16_t*)(p.ws + OFF_XE);
    for (int it = bidx() * 8 + wid; it < NE * ESLOTS; it += gdim() * 8) {
        const int e = it / ESLOTS, sl = it % ESLOTS; if (sl >= nslots) continue; const int row = ROWIDX[it];
        const u32x4* src = (const u32x4*)(BN + (size_t)row * D); u32x4* dst = (u32x4*)(XE + ((size_t)e * EPAD + sl) * D);
        dst[lane] = src[lane]; dst[lane + 64] = src[lane + 64];
    }
}

__device__ void ph_combine(const Params& p, int layer, int nrows) {
    const int wid = tidx() >> 6, lane = tidx() & 63;
    const int* SLOT = (const int*)(p.ws + OFF_SLOT); const bf16_t* YE = (const bf16_t*)(p.ws + OFF_YE); xt_t* X = (xt_t*)(p.ws + OFF_X);
    int row = bidx() * 8 + wid;
    int sl = (row < nrows && lane < 16) ? SLOT[(size_t)row * 16 + lane] : -1;
    while (row < nrows) {
        const int nrow = row + gdim() * 8;
        const int sln = (nrow < nrows && lane < 16) ? SLOT[(size_t)nrow * 16 + lane] : -1;
        const float* gt = modp(p, layer, row_stream(row), 5);
        xt_t* xr = X + (size_t)row * D + lane * 8;
        f32x4 xv[4];
#pragma unroll
        for (int i = 0; i < 2; ++i) { xv[2 * i] = xldv(xr, 512 * i); xv[2 * i + 1] = xldv(xr, 512 * i + 4); }
        unsigned long long m = __ballot(sl >= 0);
        float acc[16];
#pragma unroll
        for (int i = 0; i < 16; ++i) acc[i] = 0.f;
        while (m) {
            const int e0 = __builtin_ctzll(m); m &= m - 1; const bool two = m != 0; const int e1 = two ? __builtin_ctzll(m) : e0; if (two) m &= m - 1;
            const int s0 = __builtin_amdgcn_readlane(sl, e0), s1 = __builtin_amdgcn_readlane(sl, e1);
            const bf16_t* y0 = YE + ((size_t)e0 * EPAD + s0) * D + lane * 8; const bf16_t* y1 = YE + ((size_t)e1 * EPAD + s1) * D + lane * 8;
            const u32x4 a0 = *(const u32x4*)y0, a1 = *(const u32x4*)(y0 + 512), b0 = *(const u32x4*)y1, b1 = *(const u32x4*)(y1 + 512);
            const float f1 = two ? 1.f : 0.f;
#pragma unroll
            for (int i = 0; i < 4; ++i) { acc[2 * i] += __uint_as_float(a0[i] << 16) + f1 * __uint_as_float(b0[i] << 16); acc[2 * i + 1] += __uint_as_float(a0[i] & 0xffff0000u) + f1 * __uint_as_float(b0[i] & 0xffff0000u);
                acc[8 + 2 * i] += __uint_as_float(a1[i] << 16) + f1 * __uint_as_float(b1[i] << 16); acc[8 + 2 * i + 1] += __uint_as_float(a1[i] & 0xffff0000u) + f1 * __uint_as_float(b1[i] & 0xffff0000u); }
        }
#pragma unroll
        for (int i = 0; i < 2; ++i) { const f32x4 g0 = *(const f32x4*)(gt + lane * 8 + 512 * i), g1 = *(const f32x4*)(gt + lane * 8 + 512 * i + 4);
            f32x4 o0 = xv[2 * i], o1 = xv[2 * i + 1];
#pragma unroll
            for (int e = 0; e < 4; ++e) { o0[e] += g0[e] * acc[8 * i + e]; o1[e] += g1[e] * acc[8 * i + 4 + e]; }
            xstv(xr, 512 * i, o0); xstv(xr, 512 * i + 4, o1); }
        row = nrow; sl = sln;
    }
}

template <bool FINAL>
__device__ void ph_comb_norm(const Params& p, int lprev, int layer, int nrows) {
    const int wid = tidx() >> 6, lane = tidx() & 63;
    const int* SLOT = (const int*)(p.ws + OFF_SLOT); const bf16_t* YE = (const bf16_t*)(p.ws + OFF_YE); xt_t* X = (xt_t*)(p.ws + OFF_X);
    bf16_t* H = (bf16_t*)(p.ws + OFF_H);
    const float* g = FINAL ? p.final_g : p.norm1_g + layer * D;
    int row = bidx() * 8 + wid;
    int sl = (row < nrows && lane < 16) ? SLOT[(size_t)row * 16 + lane] : -1;
    while (row < nrows) {
        const int nrow = row + gdim() * 8;
        const int sln = (nrow < nrows && lane < 16) ? SLOT[(size_t)nrow * 16 + lane] : -1;
        const int strm = row_stream(row);
        const float* gt = modp(p, lprev, strm, 5);
        xt_t* xr = X + (size_t)row * D + lane * 8;
        f32x4 xv[4];
#pragma unroll
        for (int i = 0; i < 2; ++i) { xv[2 * i] = xldv(xr, 512 * i); xv[2 * i + 1] = xldv(xr, 512 * i + 4); }
        unsigned long long m = __ballot(sl >= 0);
        float acc[16];
#pragma unroll
        for (int i = 0; i < 16; ++i) acc[i] = 0.f;
        while (m) {
            const int e0 = __builtin_ctzll(m); m &= m - 1; const bool two = m != 0; const int e1 = two ? __builtin_ctzll(m) : e0; if (two) m &= m - 1;
            const int s0 = __builtin_amdgcn_readlane(sl, e0), s1 = __builtin_amdgcn_readlane(sl, e1);
            const bf16_t* y0 = YE + ((size_t)e0 * EPAD + s0) * D + lane * 8; const bf16_t* y1 = YE + ((size_t)e1 * EPAD + s1) * D + lane * 8;
            const u32x4 a0 = *(const u32x4*)y0, a1 = *(const u32x4*)(y0 + 512), b0 = *(const u32x4*)y1, b1 = *(const u32x4*)(y1 + 512);
            const float f1 = two ? 1.f : 0.f;
#pragma unroll
            for (int i = 0; i < 4; ++i) { acc[2 * i] += __uint_as_float(a0[i] << 16) + f1 * __uint_as_float(b0[i] << 16); acc[2 * i + 1] += __uint_as_float(a0[i] & 0xffff0000u) + f1 * __uint_as_float(b0[i] & 0xffff0000u);
                acc[8 + 2 * i] += __uint_as_float(a1[i] << 16) + f1 * __uint_as_float(b1[i] << 16); acc[8 + 2 * i + 1] += __uint_as_float(a1[i] & 0xffff0000u) + f1 * __uint_as_float(b1[i] & 0xffff0000u); }
        }
        float ss = 0.f;
#pragma unroll
        for (int i = 0; i < 2; ++i) { const f32x4 g0 = *(const f32x4*)(gt + lane * 8 + 512 * i), g1 = *(const f32x4*)(gt + lane * 8 + 512 * i + 4);
#pragma unroll
            for (int e = 0; e < 4; ++e) { xv[2 * i][e] += g0[e] * acc[8 * i + e]; xv[2 * i + 1][e] += g1[e] * acc[8 * i + 4 + e]; ss += xv[2 * i][e] * xv[2 * i][e] + xv[2 * i + 1][e] * xv[2 * i + 1][e]; }
            if (!FINAL) { xstv(xr, 512 * i, xv[2 * i]); xstv(xr, 512 * i + 4, xv[2 * i + 1]); } }
        ss = wave_sum(ss); const float rs = rsqrtf(ss * (1.f / D) + RMS_EPS);
        const float* sh = FINAL ? nullptr : modp(p, layer, strm, 0); const float* sc = FINAL ? nullptr : modp(p, layer, strm, 1);
#pragma unroll
        for (int i = 0; i < 2; ++i)
#pragma unroll
            for (int hh = 0; hh < 2; ++hh) { const int d = lane * 8 + 512 * i + 4 * hh; const f32x4 gg = *(const f32x4*)(g + d); f32x4 o = xv[2 * i + hh] * rs * gg;
                if (FINAL) *(f32x4*)(p.out + (size_t)row * D + d) = o;
                else { o = o * (1.f + *(const f32x4*)(sc + d)) + *(const f32x4*)(sh + d); stbf4(H + (size_t)row * D + d, o); } }
        row = nrow; sl = sln;
    }
}

__device__ void ph_rw_normxs(const Params& p, int layer, int j) {
    const int wid = tidx() >> 6, lane = tidx() & 63;
    const xt_t* X = (const xt_t*)(p.ws + OFF_X); bf16_t* XS = (bf16_t*)(p.ws + OFF_XS);
    const float* mu = p.rw_mu + (size_t)j * 6 * D; const float* g = p.norm1_g + layer * D;
    const int w = bidx() * 8 + wid, nw = gdim() * 8;
    const int r0 = (int)((long long)w * NROW / nw), r1 = (int)((long long)(w + 1) * NROW / nw);
    if (r0 >= r1) return;
    float4 um[6][4];
#pragma unroll
    for (int m = 0; m < 6; ++m)
#pragma unroll
        for (int i = 0; i < 4; ++i) um[m][i] = *(const float4*)(mu + m * D + (lane + i * 64) * 4);
    float4 gm[4], bb[4]; int scur = -1;
    float4 hp[4], hc[4], hn[4], raw[4];
#define XS_NORM(dst, src, R) do { const int s_ = row_stream(R); \
        if (s_ != scur) { scur = s_; const float* sh_ = modp(p, layer, s_, 0); const float* sc_ = modp(p, layer, s_, 1); \
            _Pragma("unroll") for (int i = 0; i < 4; ++i) { const int d_ = (lane + i * 64) * 4; const float4 gg_ = *(const float4*)(g + d_), a_ = *(const float4*)(sc_ + d_); bb[i] = *(const float4*)(sh_ + d_); \
                gm[i] = make_float4(gg_.x * (1.f + a_.x), gg_.y * (1.f + a_.y), gg_.z * (1.f + a_.z), gg_.w * (1.f + a_.w)); } } \
        float ss_ = 0.f; \
        _Pragma("unroll") for (int i = 0; i < 4; ++i) ss_ += src[i].x * src[i].x + src[i].y * src[i].y + src[i].z * src[i].z + src[i].w * src[i].w; \
        ss_ = wave_sum(ss_); const float rs_ = rsqrtf(ss_ * (1.f / D) + RMS_EPS); \
        _Pragma("unroll") for (int i = 0; i < 4; ++i) dst[i] = make_float4(src[i].x * rs_ * gm[i].x + bb[i].x, src[i].y * rs_ * gm[i].y + bb[i].y, src[i].z * rs_ * gm[i].z + bb[i].z, src[i].w * rs_ * gm[i].w + bb[i].w); } while (0)
#define XS_RAW(R) do { _Pragma("unroll") for (int i = 0; i < 4; ++i) raw[i] = xld(X, (size_t)(R) * D + (lane + i * 64) * 4); } while (0)
    if (r0 > 0) { XS_RAW(r0 - 1); XS_NORM(hp, raw, r0 - 1); }
    else {
#pragma unroll
        for (int i = 0; i < 4; ++i) hp[i] = make_float4(0.f, 0.f, 0.f, 0.f); }
    XS_RAW(r0); XS_NORM(hc, raw, r0);
    if (r0 + 1 < NROW) XS_RAW(r0 + 1);
    for (int row = r0; row < r1; ++row) {
        const bool lat = row < NLAT; const int t = lat ? (row & (TL - 1)) : ((row - NLAT) & (TC - 1)); const int len = lat ? TL : TC;
        const float fp_ = t > 0 ? 0.5f : 0.f, fn_ = t < len - 1 ? 0.5f : 0.f;
        if (row + 1 < NROW) XS_NORM(hn, raw, row + 1);
        else {
#pragma unroll
            for (int i = 0; i < 4; ++i) hn[i] = make_float4(0.f, 0.f, 0.f, 0.f); }
        if (row + 1 < r1 && row + 2 < NROW) XS_RAW(row + 2);
#pragma unroll
        for (int i = 0; i < 4; ++i) {
            const int d = (lane + i * 64) * 4;
            const float4 h = hc[i];
            const float4 xx = make_float4(fp_ * hp[i].x + fn_ * hn[i].x - h.x, fp_ * hp[i].y + fn_ * hn[i].y - h.y, fp_ * hp[i].z + fn_ * hn[i].z - h.z, fp_ * hp[i].w + fn_ * hn[i].w - h.w);
#pragma unroll
            for (int m = 0; m < 6; ++m) { const float4 u = um[m][i];
                uint2 wv_; wv_.x = pk2(h.x + xx.x * u.x, h.y + xx.y * u.y); wv_.y = pk2(h.z + xx.z * u.z, h.w + xx.w * u.w);
                *(uint2*)(XS + ((size_t)m * NROW + row) * D + d) = wv_; }
        }
#pragma unroll
        for (int i = 0; i < 4; ++i) { hp[i] = hc[i]; hc[i] = hn[i]; }
    }
#undef XS_NORM
#undef XS_RAW
}

__device__ __forceinline__ int scan_row(int i, int b, int z) {
    return i < TC ? NLAT + b * TC + (z ? TC - 1 - i : i) : b * TL + (z ? TL - 1 - (i - TC) : i - TC);
}
__device__ __forceinline__ float dpp_sum8(float x) {
    x += __builtin_bit_cast(float, __builtin_amdgcn_update_dpp(0, __builtin_bit_cast(int, x), 0xB1, 0xF, 0xF, true));
    x += __builtin_bit_cast(float, __builtin_amdgcn_update_dpp(0, __builtin_bit_cast(int, x), 0x4E, 0xF, 0xF, true));
    x += __builtin_bit_cast(float, __builtin_amdgcn_update_dpp(0, __builtin_bit_cast(int, x), 0x141, 0xF, 0xF, true));
    return x;
}
__device__ void ph_rw_scan(const Params& p, int j, char* lds) {
    const int tid = tidx(), wid = __builtin_amdgcn_readfirstlane(tid >> 6), lane = tid & 63;
    const size_t PL = (size_t)NROW * D;
    const float* RKV = (const float*)(p.ws + OFF_RKV); float* Y = (float*)(p.ws + OFF_Y);
    constexpr int CH = 32, BUFB = 5 * CH * 256 + CH * 128 + CH * 16, YB = CH * 32 * 4, NCH = (TC + TL) / CH;
    const bool loader = wid >= 4; const int lw = wid - 4;
    for (int it = bidx(); it < 256; it += gdim()) {
        const int vh = it & 1, z = (it >> 1) & 1, h = (it >> 2) & 15, b = it >> 6;
        const char* pl0 = (const char*)((const float*)(p.ws + OFF_W) + z * PL); const char* pl1 = (const char*)(RKV + PL);
        const char* pl2 = (const char*)((const float*)(p.ws + OFF_AV) + z * PL); const char* pl3 = (const char*)RKV;
        const char* vpl = (const char*)(RKV + 2 * PL);
        float* yout = Y + z * PL;
        __builtin_amdgcn_s_barrier();
        if (loader) {
            const int pq = lane & 15;
            const f32x4 kkv = *(const f32x4*)(p.rw_k_k + j * D + h * 64 + pq * 4), kav = *(const f32x4*)(p.rw_k_a + j * D + h * 64 + pq * 4);
            auto issue = [&](int c) {
                char* buf = lds + (c % 3) * BUFB;
#pragma unroll
                for (int q = 0; q < 8; ++q) { const int pi = q >> 1, tg = lw * 2 + (q & 1); const int row = scan_row(c * CH + tg * 4 + (lane >> 4), b, z);
                    const char* base = pi == 0 ? pl0 : pi == 1 ? pl1 : pi == 2 ? pl2 : pl3;
                    __builtin_amdgcn_global_load_lds((const unsigned*)(base + (size_t)row * D * 4 + h * 256 + (lane & 15) * 16), (LAS unsigned*)(buf + pi * (CH * 256) + tg * 1024), 16, 0, 0); }
                { const int row = scan_row(c * CH + lw * 8 + (lane >> 3), b, z);
                  __builtin_amdgcn_global_load_lds((const unsigned*)(vpl + (size_t)row * D * 4 + (h * 64 + vh * 32) * 4 + (lane & 7) * 16), (LAS unsigned*)(buf + 5 * CH * 256 + lw * 1024), 16, 0, 0); }
            };
            auto prep = [&](int c) {
                char* buf = lds + (c % 3) * BUFB;
#pragma unroll
                for (int ps = 0; ps < 2; ++ps) { const int ptok = lw * 8 + ps * 4 + (lane >> 4);
                    f32x4* kp = (f32x4*)(buf + 1 * CH * 256 + ptok * 256 + pq * 16); f32x4* ap = (f32x4*)(buf + 2 * CH * 256 + ptok * 256 + pq * 16); f32x4* dp = (f32x4*)(buf + 4 * CH * 256 + ptok * 256 + pq * 16);
                    f32x4* rp = (f32x4*)(buf + 3 * CH * 256 + ptok * 256 + pq * 16); const f32x4 wv = *(const f32x4*)(buf + ptok * 256 + pq * 16);
                    const f32x4 k = *kp, a = *ap, r = *rp; f32x4 kk = k * kkv;
                    float ss = kk[0] * kk[0] + kk[1] * kk[1] + kk[2] * kk[2] + kk[3] * kk[3]; ss = dpp_sum16(ss);
                    const float inv = 1.f / fmaxf(sqrtf(ss), 1e-12f); kk = kk * inv;
                    const f32x4 kd = k * (1.f + (a - 1.f) * kav), bb = kk * a;
                    const f32x4 t1 = bb * r, t2 = kd * r;
                    const float br = dpp_sum16((t1[0] + t1[1]) + (t1[2] + t1[3])), kr = dpp_sum16((t2[0] + t2[1]) + (t2[2] + t2[3]));
                    *dp = kd; *ap = bb; *kp = kk; *rp = wv * r;
                    if (pq == 0) *(float2*)(buf + 5 * CH * 256 + CH * 128 + ptok * 16) = make_float2(br, kr); }
            };
            issue(0); issue(1);
            asm volatile("s_waitcnt vmcnt(9)" ::: "memory");
            prep(0);
            asm volatile("s_waitcnt lgkmcnt(0)" ::: "memory"); __builtin_amdgcn_s_barrier();
            for (int c = 0; c < NCH; ++c) {
                if (c >= 1) { const float* yb = (const float*)(lds + 3 * BUFB + ((c - 1) & 1) * YB);
                    const int lt = tid - 256, t = lt >> 3, q = lt & 7; const int row = scan_row((c - 1) * CH + t, b, z);
                    *(f32x4*)(yout + (size_t)row * D + h * 64 + vh * 32 + q * 4) = *(const f32x4*)(yb + t * 32 + q * 4); }
                if (c + 2 < NCH) { issue(c + 2); asm volatile("s_waitcnt vmcnt(9)" ::: "memory"); } else asm volatile("s_waitcnt vmcnt(0)" ::: "memory");
                if (c + 1 < NCH) prep(c + 1);
                asm volatile("s_waitcnt lgkmcnt(0)" ::: "memory"); __builtin_amdgcn_s_barrier();
            }
            { const float* yb = (const float*)(lds + 3 * BUFB + ((NCH - 1) & 1) * YB);
              const int lt = tid - 256, t = lt >> 3, q = lt & 7; const int row = scan_row((NCH - 1) * CH + t, b, z);
              *(f32x4*)(yout + (size_t)row * D + h * 64 + vh * 32 + q * 4) = *(const f32x4*)(yb + t * 32 + q * 4); }
        } else {
            const int vr = lane >> 3, ks = lane & 7;
            f32x4 Sa = {0.f, 0.f, 0.f, 0.f}, Sb = {0.f, 0.f, 0.f, 0.f};
            __builtin_amdgcn_s_barrier();
            struct Ops { f32x4 w0, w1, kk0, kk1, bb0, bb1, r0, r1, kd0, kd1; float v; float2 sc; };
#define SC_LOAD(O, t) do { const char* q_ = bq + (t) * 256; O.w0 = *(const f32x4*)(q_); O.w1 = *(const f32x4*)(q_ + 16); O.kk0 = *(const f32x4*)(q_ + CH * 256); O.kk1 = *(const f32x4*)(q_ + CH * 256 + 16); \
                O.bb0 = *(const f32x4*)(q_ + 2 * CH * 256); O.bb1 = *(const f32x4*)(q_ + 2 * CH * 256 + 16); O.r0 = *(const f32x4*)(q_ + 3 * CH * 256); O.r1 = *(const f32x4*)(q_ + 3 * CH * 256 + 16); \
                O.kd0 = *(const f32x4*)(q_ + 4 * CH * 256); O.kd1 = *(const f32x4*)(q_ + 4 * CH * 256 + 16); O.v = *(const float*)(vq + (t) * 128); O.sc = *(const float2*)(buf + 5 * CH * 256 + CH * 128 + (t) * 16); } while (0)
#define SC_STEP(O, t) do { const f32x4 d1 = Sa * O.kk0 + Sb * O.kk1, d2 = Sa * O.r0 + Sb * O.r1; \
                float sa = -((d1[0] + d1[1]) + (d1[2] + d1[3])), yy = (d2[0] + d2[1]) + (d2[2] + d2[3]); \
                sa = dpp_sum8(sa); yy = dpp_sum8(yy); \
                Sa = Sa * O.w0 + (sa * O.bb0 + O.v * O.kd0); Sb = Sb * O.w1 + (sa * O.bb1 + O.v * O.kd1); \
                if (ks == 0) yb[(t) * 32 + wid * 8 + vr] = yy + sa * O.sc.x + O.v * O.sc.y; } while (0)
            for (int c = 0; c < NCH; ++c) {
                const char* buf = lds + (c % 3) * BUFB; float* yb = (float*)(lds + 3 * BUFB + (c & 1) * YB);
                const char* bq = buf + ks * 32; const char* vq = buf + 5 * CH * 256 + (wid * 8 + vr) * 4;
                Ops oA, oB, oC;
                SC_LOAD(oA, 0); SC_LOAD(oB, 1);
#pragma unroll
                for (int t = 0; t < CH; t += 3) {
                    if (t + 2 < CH) SC_LOAD(oC, t + 2);
                    SC_STEP(oA, t);
                    if (t + 3 < CH) SC_LOAD(oA, t + 3);
                    if (t + 1 < CH) SC_STEP(oB, t + 1);
                    if (t + 4 < CH) SC_LOAD(oB, t + 4);
                    if (t + 2 < CH) SC_STEP(oC, t + 2);
                }
                asm volatile("s_waitcnt lgkmcnt(0)" ::: "memory"); __builtin_amdgcn_s_barrier();
            }
#undef SC_LOAD
#undef SC_STEP
        }
    }
}


namespace ck {
constexpr int P = 72, MB = 64 * P * 2;
typedef __attribute__((address_space(3))) char lchar;
__device__ __forceinline__ f32x4 mm_tile(const lchar* Aop, const lchar* Bop, int ti, int tj, int c, int q, f32x4 acc) {
#pragma unroll
    for (int ks = 0; ks < 2; ++ks) {
        const bf16x8 a = *(const LAS bf16x8*)(Aop + ((16 * ti + c) * P + 32 * ks + 8 * q) * 2);
        const bf16x8 b = *(const LAS bf16x8*)(Bop + ((16 * tj + c) * P + 32 * ks + 8 * q) * 2);
        acc = __builtin_amdgcn_mfma_f32_16x16x32_bf16(a, b, acc, 0, 0, 0);
    }
    return acc;
}
__device__ __forceinline__ f32x4 mm_diag(const lchar* Aop, const lchar* Bop, int tt, int c, int q, f32x4 acc) {
    const int ks = tt >> 1;
    bf16x8 a = *(const LAS bf16x8*)(Aop + ((16 * tt + c) * P + 32 * ks + 8 * q) * 2);
    const bf16x8 b = *(const LAS bf16x8*)(Bop + ((16 * tt + c) * P + 32 * ks + 8 * q) * 2);
    if ((q >> 1) != (tt & 1)) a = (bf16x8){0, 0, 0, 0, 0, 0, 0, 0};
    return __builtin_amdgcn_mfma_f32_16x16x32_bf16(a, b, acc, 0, 0, 0);
}
__device__ __forceinline__ void st_tile(lchar* dst, int ti, int tj, int c, int q, f32x4 v) {
    u32x2 w; w.x = pk2(v[0], v[1]); w.y = pk2(v[2], v[3]); *(LAS u32x2*)(dst + ((16 * tj + c) * P + 16 * ti + 4 * q) * 2) = w;
}
__device__ __forceinline__ f32x4 ld_tile(const lchar* src, int ti, int tj, int c, int q) {
    const u32x2 w = *(const LAS u32x2*)(src + ((16 * tj + c) * P + 16 * ti + 4 * q) * 2);
    return (f32x4){__uint_as_float(w.x << 16), __uint_as_float(w.x & 0xffff0000u), __uint_as_float(w.y << 16), __uint_as_float(w.y & 0xffff0000u)};
}
__device__ __forceinline__ void st_glob(bf16_t* dst, int ti, int tj, int c, int q, f32x4 v) {
    uint2 w; w.x = pk2(v[0], v[1]); w.y = pk2(v[2], v[3]); *(uint2*)(dst + (16 * tj + c) * 64 + 16 * ti + 4 * q) = w;
}
typedef float f32x16 __attribute__((ext_vector_type(16)));
__device__ __forceinline__ f32x16 mm32(const lchar* Aop, const lchar* Bop, int ti, int tj, int r32, int hi, f32x16 acc) {
#pragma unroll
    for (int ks = 0; ks < 4; ++ks) {
        const bf16x8 a = *(const LAS bf16x8*)(Aop + ((32 * ti + r32) * P + 16 * ks + 8 * hi) * 2);
        const bf16x8 b = *(const LAS bf16x8*)(Bop + ((32 * tj + r32) * P + 16 * ks + 8 * hi) * 2);
        acc = __builtin_amdgcn_mfma_f32_32x32x16_bf16(a, b, acc, 0, 0, 0);
    }
    return acc;
}
__device__ __forceinline__ void st32(lchar* dst, int ti, int tj, int r32, int hi, const f32x16& v) {
#pragma unroll
    for (int g = 0; g < 4; ++g) { u32x2 w; w.x = pk2(v[4 * g], v[4 * g + 1]); w.y = pk2(v[4 * g + 2], v[4 * g + 3]); *(LAS u32x2*)(dst + ((32 * tj + r32) * P + 32 * ti + 8 * g + 4 * hi) * 2) = w; }
}
__device__ __forceinline__ f32x16 ld32(const lchar* src, int ti, int tj, int r32, int hi) {
    f32x16 v;
#pragma unroll
    for (int g = 0; g < 4; ++g) { const u32x2 w = *(const LAS u32x2*)(src + ((32 * tj + r32) * P + 32 * ti + 8 * g + 4 * hi) * 2);
        v[4 * g] = __uint_as_float(w.x << 16); v[4 * g + 1] = __uint_as_float(w.x & 0xffff0000u); v[4 * g + 2] = __uint_as_float(w.y << 16); v[4 * g + 3] = __uint_as_float(w.y & 0xffff0000u); }
    return v;
}
__device__ __forceinline__ void stg32(bf16_t* dst, int ti, int tj, int r32, int hi, const f32x16& v) {
#pragma unroll
    for (int g = 0; g < 4; ++g) { uint2 w; w.x = pk2(v[4 * g], v[4 * g + 1]); w.y = pk2(v[4 * g + 2], v[4 * g + 3]); *(uint2*)(dst + (32 * tj + r32) * 64 + 32 * ti + 8 * g + 4 * hi) = w; }
}
}

#define LBAR() do { asm volatile("s_waitcnt lgkmcnt(0)" ::: "memory"); __builtin_amdgcn_s_barrier(); asm volatile("" ::: "memory"); } while (0)
__device__ void ph_rw_sc1(const Params& p, int j, char* lds) {
    using namespace ck;
    const int tid = tidx(), wid = __builtin_amdgcn_readfirstlane(tid >> 6), lane = tid & 63, c = lane & 15, q = lane >> 4;
    const size_t PL = (size_t)NROW * D;
    const bf16_t* RKV = (const bf16_t*)(p.ws + OFF_RKV); const float* LW = (const float*)(p.ws + OFF_W); const bf16_t* AV = (const bf16_t*)(p.ws + OFF_AV);
    bf16_t* CK = (bf16_t*)(p.ws + OFF_CK);
    lchar* B0 = (lchar*)lds;
#define BUF(i) (B0 + (i) * MB)
    LAS float* Lbuf = (LAS float*)BUF(8);
    LAS float* Lseg = (LAS float*)(B0 + 16 * MB);
    LAS float* GC = Lseg + 8 * 64;
    const int pt = tid >> 3, cg = tid & 7;
    f32x4 nlw[2], nkk[2], nka[2]; u32x4 nkx, nax, nrx, nvx;
#define SC1_LOAD(IT) do { const int seq_ = (IT) / NCHK, ch_ = (IT) % NCHK; const int z_ = seq_ & 1, h_ = (seq_ >> 1) & 15, b_ = seq_ >> 5; \
        const size_t go_ = (size_t)scan_row(ch_ * 64 + pt, b_, z_) * D + h_ * 64 + cg * 8; \
        _Pragma("unroll") for (int e = 0; e < 2; ++e) nlw[e] = *(const f32x4*)(LW + z_ * PL + go_ + 4 * e); \
        nkx = *(const u32x4*)(RKV + PL + go_); nax = *(const u32x4*)(AV + z_ * PL + go_); nrx = *(const u32x4*)(RKV + go_); nvx = *(const u32x4*)(RKV + 2 * PL + go_); \
        _Pragma("unroll") for (int e = 0; e < 2; ++e) { nkk[e] = *(const f32x4*)(p.rw_k_k + j * D + h_ * 64 + cg * 8 + 4 * e); nka[e] = *(const f32x4*)(p.rw_k_a + j * D + h_ * 64 + cg * 8 + 4 * e); } } while (0)
    if (bidx() < 128 * NCHK) SC1_LOAD(bidx());
    for (int it = bidx(); it < 128 * NCHK; it += gdim()) {
        const int seq = it / NCHK; const int h = (seq >> 1) & 15;
        f32x4 lw[2], kx[2], ax[2], rx[2], vx[2], kkc[2], kac[2];
#pragma unroll
        for (int e = 0; e < 2; ++e) { lw[e] = nlw[e]; kkc[e] = nkk[e]; kac[e] = nka[e];
            kx[e] = (f32x4){__uint_as_float(nkx[2 * e] << 16), __uint_as_float(nkx[2 * e] & 0xffff0000u), __uint_as_float(nkx[2 * e + 1] << 16), __uint_as_float(nkx[2 * e + 1] & 0xffff0000u)};
            ax[e] = (f32x4){__uint_as_float(nax[2 * e] << 16), __uint_as_float(nax[2 * e] & 0xffff0000u), __uint_as_float(nax[2 * e + 1] << 16), __uint_as_float(nax[2 * e + 1] & 0xffff0000u)};
            rx[e] = (f32x4){__uint_as_float(nrx[2 * e] << 16), __uint_as_float(nrx[2 * e] & 0xffff0000u), __uint_as_float(nrx[2 * e + 1] << 16), __uint_as_float(nrx[2 * e + 1] & 0xffff0000u)};
            vx[e] = (f32x4){__uint_as_float(nvx[2 * e] << 16), __uint_as_float(nvx[2 * e] & 0xffff0000u), __uint_as_float(nvx[2 * e + 1] << 16), __uint_as_float(nvx[2 * e + 1] & 0xffff0000u)}; }
        if (it + gdim() < 128 * NCHK) SC1_LOAD(it + gdim());
        LBAR();
#pragma unroll
        for (int e = 0; e < 2; ++e) *(LAS f32x4*)(Lbuf + pt * 64 + cg * 8 + 4 * e) = lw[e];
        f32x4 kk[2], bq[2], kd[2];
        { float ss = 0.f;
#pragma unroll
          for (int e = 0; e < 2; ++e) { kk[e] = kx[e] * kkc[e]; ss += kk[e][0] * kk[e][0] + kk[e][1] * kk[e][1] + kk[e][2] * kk[e][2] + kk[e][3] * kk[e][3]; }
          ss = dpp_sum8(ss); const float inv = __builtin_amdgcn_rsqf(fmaxf(ss, 1e-24f));
#pragma unroll
          for (int e = 0; e < 2; ++e) { kk[e] = kk[e] * inv; bq[e] = kk[e] * ax[e]; kd[e] = kx[e] * (1.f + (ax[e] - 1.f) * kac[e]); } }
        LBAR();
        { const int k = tid & 63, sg = tid >> 6; float run = 0.f;
#pragma unroll
          for (int u = 0; u < 8; ++u) { run += Lbuf[(sg * 8 + u) * 64 + k]; Lbuf[(sg * 8 + u) * 64 + k] = run; }
          Lseg[sg * 64 + k] = run; }
        LBAR();
        f32x4 Lt[2], Lp[2], Lc[2];
        { const int sg = pt >> 3, sgp = (pt - 1) >> 3;
#pragma unroll
          for (int e = 0; e < 2; ++e) { f32x4 o0 = {0.f, 0.f, 0.f, 0.f}, o1 = o0, oc = o0;
#pragma unroll
              for (int u = 0; u < 8; ++u) { const f32x4 sv = *(const LAS f32x4*)(Lseg + u * 64 + cg * 8 + 4 * e); if (u < sg) o0 = o0 + sv; if (u < sgp) o1 = o1 + sv; if (u < 7) oc = oc + sv; }
              Lt[e] = *(const LAS f32x4*)(Lbuf + pt * 64 + cg * 8 + 4 * e) + o0;
              Lp[e] = pt > 0 ? *(const LAS f32x4*)(Lbuf + (pt - 1) * 64 + cg * 8 + 4 * e) + o1 : (f32x4){0.f, 0.f, 0.f, 0.f};
              Lc[e] = *(const LAS f32x4*)(Lbuf + 63 * 64 + cg * 8 + 4 * e) + oc; } }
        LBAR();
        {
            float at[8], bt[8], kt[8], rt[8], bh[8], kh[8], vv[8];
#pragma unroll
            for (int e = 0; e < 2; ++e)
#pragma unroll
                for (int u = 0; u < 4; ++u) { const int x = 4 * e + u; const float eL = __expf(Lt[e][u]), emL = __expf(-Lt[e][u]), eP = __expf(Lp[e][u]), eC = __expf(Lc[e][u] - Lt[e][u]);
                    at[x] = -kk[e][u] * eP; bt[x] = bq[e][u] * emL; kt[x] = kd[e][u] * emL; rt[x] = rx[e][u] * eL; bh[x] = bq[e][u] * eC; kh[x] = kd[e][u] * eC; vv[x] = vx[e][u];
                    if (pt == 63) GC[cg * 8 + x] = eL; }
#define ST8(bufi, arr) do { u32x4 w_ = {pk2(arr[0], arr[1]), pk2(arr[2], arr[3]), pk2(arr[4], arr[5]), pk2(arr[6], arr[7])}; *(LAS u32x4*)(BUF(bufi) + (pt * P + cg * 8) * 2) = w_; } while (0)
            ST8(0, at); ST8(1, bt); ST8(2, kt); ST8(3, rt); ST8(8, bh); ST8(9, kh); ST8(10, vv);
#undef ST8
        }
        LBAR();
        {
            const int k = tid & 63, tg = tid >> 6;
#define TR8(src, dst) do { unsigned w_[4]; _Pragma("unroll") for (int x = 0; x < 4; ++x) { const unsigned lo = *(const LAS bf16_t*)(BUF(src) + ((tg * 8 + 2 * x) * P + k) * 2), hi2 = *(const LAS bf16_t*)(BUF(src) + ((tg * 8 + 2 * x + 1) * P + k) * 2); w_[x] = lo | (hi2 << 16); } \
                *(LAS u32x4*)(BUF(dst) + (k * P + tg * 8) * 2) = (u32x4){w_[0], w_[1], w_[2], w_[3]}; } while (0)
            TR8(0, 4); TR8(8, 5); TR8(9, 6); TR8(10, 7);
#undef TR8
        }
        LBAR();
        const f32x4 Z4 = {0.f, 0.f, 0.f, 0.f};
        const f32x16 Z16 = {0.f, 0.f, 0.f, 0.f, 0.f, 0.f, 0.f, 0.f, 0.f, 0.f, 0.f, 0.f, 0.f, 0.f, 0.f, 0.f};
        const int r32 = lane & 31, hi = lane >> 5;
#pragma unroll 1
        for (int u = 0; u < 2; ++u) { const int tl = u * 8 + wid;
            if (tl >= 14) {
                if (tl == 14) { st32(BUF(8), 0, 1, r32, hi, Z16); st32(BUF(8), 1, 0, r32, hi, Z16); st32(BUF(14), 0, 1, r32, hi, Z16); st32(BUF(14), 1, 0, r32, hi, Z16); st32(BUF(9), 1, 0, r32, hi, Z16); }
                else { st32(BUF(15), 1, 0, r32, hi, Z16); st32(BUF(13), 1, 0, r32, hi, Z16); st32(BUF(10), 1, 0, r32, hi, Z16); st32(BUF(11), 1, 0, r32, hi, Z16); st32(BUF(12), 1, 0, r32, hi, Z16); }
                break; }
            const int m = (tl + 1) / 3, rr = (tl + 1) % 3, ti = rr == 2, tj = m == 0 ? ti : (rr >= 1); const int jj = 32 * tj + r32;
            if (m == 0) { f32x16 v = mm32(BUF(0), BUF(1), ti, tj, r32, hi, Z16), w;
#pragma unroll
                for (int e = 0; e < 16; ++e) { const int ii = 32 * ti + 8 * (e >> 2) + 4 * hi + (e & 3); const bool dg = (ii >> 4) == (jj >> 4);
                    v[e] = (dg && jj < ii) ? v[e] : 0.f; w[e] = v[e] + ((ii == jj) ? 1.f : 0.f); }
                st32(BUF(8), ti, tj, r32, hi, v); st32(BUF(14), ti, tj, r32, hi, w); }
            else if (m == 1) { const f32x16 v = mm32(BUF(1), BUF(0), ti, tj, r32, hi, Z16); f32x16 vd, vo, w;
#pragma unroll
                for (int e = 0; e < 16; ++e) { const int ii = 32 * ti + 8 * (e >> 2) + 4 * hi + (e & 3); const bool dg = (ii >> 4) == (jj >> 4), up = ii < jj;
                    vd[e] = (dg && up) ? v[e] : 0.f; vo[e] = (!dg && up) ? v[e] : 0.f; w[e] = vd[e] + ((ii == jj) ? 1.f : 0.f); }
                st32(BUF(9), ti, tj, r32, hi, vd); st32(BUF(15), ti, tj, r32, hi, vo); st32(BUF(13), ti, tj, r32, hi, w); }
            else if (m == 2) { f32x16 v = mm32(BUF(2), BUF(0), ti, tj, r32, hi, Z16);
#pragma unroll
                for (int e = 0; e < 16; ++e) { const int ii = 32 * ti + 8 * (e >> 2) + 4 * hi + (e & 3); v[e] = ii < jj ? v[e] : 0.f; }
                st32(BUF(10), ti, tj, r32, hi, v); }
            else { f32x16 v = mm32(m == 3 ? BUF(1) : BUF(2), BUF(3), ti, tj, r32, hi, Z16);
#pragma unroll
                for (int e = 0; e < 16; ++e) { const int ii = 32 * ti + 8 * (e >> 2) + 4 * hi + (e & 3); v[e] = ii <= jj ? v[e] : 0.f; }
                st32(m == 3 ? BUF(11) : BUF(12), ti, tj, r32, hi, v); } }
        LBAR();
#define WSYNC() asm volatile("s_waitcnt lgkmcnt(0)" ::: "memory")
        if (wid < 4) {
            const int tt = wid;
#define SQD(sr, st, dr, dt) do { const f32x4 a_ = mm_diag(BUF(st), BUF(sr), tt, c, q, Z4), b_ = mm_diag(BUF(sr), BUF(st), tt, c, q, Z4); WSYNC(); \
                st_tile(BUF(dr), tt, tt, c, q, a_); st_tile(BUF(dt), tt, tt, c, q, b_); WSYNC(); } while (0)
#define UPD(pr) do { const f32x4 dt_ = mm_diag(BUF(pr), BUF(13), tt, c, q, ld_tile(BUF(13), tt, tt, c, q)); \
                const f32x4 dr_ = mm_diag(BUF(13), BUF(pr), tt, c, q, ld_tile(BUF(14), tt, tt, c, q)); WSYNC(); \
                st_tile(BUF(13), tt, tt, c, q, dt_); st_tile(BUF(14), tt, tt, c, q, dr_); WSYNC(); } while (0)
            SQD(8, 9, 0, 1); UPD(0); SQD(0, 1, 8, 9); UPD(8); SQD(8, 9, 0, 1); UPD(0);
#undef SQD
#undef UPD
        } else {
            const int ti = (wid >> 1) & 1, tj = wid & 1; st32(BUF(2), ti, tj, r32, hi, mm32(BUF(10), BUF(7), ti, tj, r32, hi, Z16));
        }
        LBAR();
        { const int m = wid >> 2, ti = (wid >> 1) & 1, tj = wid & 1;
          if (m == 0) st32(BUF(8), ti, tj, r32, hi, mm32(BUF(15), BUF(14), ti, tj, r32, hi, Z16));
          else        st32(BUF(9), ti, tj, r32, hi, mm32(BUF(14), BUF(15), ti, tj, r32, hi, Z16)); }
        LBAR();
        if (wid < 4) { const int ti = (wid >> 1) & 1, tj = wid & 1; st32(BUF(0), ti, tj, r32, hi, mm32(BUF(9), BUF(8), ti, tj, r32, hi, Z16)); }
        LBAR();
        if (wid < 4) { const int ti = (wid >> 1) & 1, tj = wid & 1; st32(BUF(1), ti, tj, r32, hi, mm32(BUF(0), BUF(13), ti, tj, r32, hi, ld32(BUF(13), ti, tj, r32, hi))); }
        LBAR();
        if (wid < 4) { const int ti = (wid >> 1) & 1, tj = wid & 1; st32(BUF(14), ti, tj, r32, hi, mm32(BUF(8), BUF(1), ti, tj, r32, hi, ld32(BUF(1), ti, tj, r32, hi))); }
        LBAR();
        { const int m = wid >> 2, ti = (wid >> 1) & 1, tj = wid & 1;
          if (m == 0) st32(BUF(8), ti, tj, r32, hi, mm32(BUF(14), BUF(4), ti, tj, r32, hi, Z16));
          else        st32(BUF(0), ti, tj, r32, hi, mm32(BUF(14), BUF(2), ti, tj, r32, hi, Z16)); }
        LBAR();
        bf16_t* ckp = CK + (size_t)it * 4 * 4096;
#pragma unroll 1
        for (int u = 0; u < 2; ++u) { const int tl = u * 8 + wid, m = tl >> 2, ti = (tl >> 1) & 1, tj = tl & 1;
            if (m == 0) { f32x16 v = mm32(BUF(8), BUF(5), ti, tj, r32, hi, Z16); const int jj = 32 * tj + r32; const float gc = GC[jj];
#pragma unroll
                for (int e = 0; e < 16; ++e) { const int ii = 32 * ti + 8 * (e >> 2) + 4 * hi + (e & 3); v[e] += (ii == jj) ? gc : 0.f; }
                st32(BUF(1), ti, tj, r32, hi, v); }
            else if (m == 1) st32(BUF(4), ti, tj, r32, hi, mm32(BUF(8), BUF(11), ti, tj, r32, hi, ld32(BUF(3), ti, tj, r32, hi)));
            else if (m == 2) st32(BUF(2), ti, tj, r32, hi, mm32(BUF(6), BUF(7), ti, tj, r32, hi, mm32(BUF(5), BUF(0), ti, tj, r32, hi, Z16)));
            else             st32(BUF(9), ti, tj, r32, hi, mm32(BUF(7), BUF(12), ti, tj, r32, hi, mm32(BUF(0), BUF(11), ti, tj, r32, hi, Z16))); }
        LBAR();
        { const int orow = tid >> 3, oc = (tid & 7) * 8;
          *(u32x4*)(ckp + orow * 64 + oc) = *(const LAS u32x4*)(BUF(1) + (orow * P + oc) * 2);
          *(u32x4*)(ckp + 4096 + orow * 64 + oc) = *(const LAS u32x4*)(BUF(2) + (orow * P + oc) * 2);
          *(u32x4*)(ckp + 2 * 4096 + orow * 64 + oc) = *(const LAS u32x4*)(BUF(4) + (orow * P + oc) * 2);
          *(u32x4*)(ckp + 3 * 4096 + orow * 64 + oc) = *(const LAS u32x4*)(BUF(9) + (orow * P + oc) * 2); }
    }
#undef BUF
#undef SC1_LOAD
}

__device__ void ph_rw_sc2(const Params& p, char* lds) {
    using namespace ck;
    const int tid = tidx(), wid = __builtin_amdgcn_readfirstlane(tid >> 6), lane = tid & 63, c = lane & 15, q = lane >> 4;
    const size_t PL = (size_t)NROW * D;
    const bf16_t* CK = (const bf16_t*)(p.ws + OFF_CK); bf16_t* Y = (bf16_t*)(p.ws + OFF_Y);
    lchar* GB = (lchar*)lds;
    lchar* RB = GB + 2 * MB;
    lchar* SB = GB + 4 * MB;
    constexpr int SBB = 32 * P * 2;
    for (int it = bidx(); it < 256; it += gdim()) {
        const int vh = it & 1, seq = it >> 1, z = seq & 1, h = (seq >> 1) & 15, b = seq >> 5;
        const bf16_t* ck0 = CK + (size_t)seq * NCHK * 4 * 4096;
        const int s_ti = wid & 3, s_tj = wid >> 2;
        const int y_ti = wid & 1, y_tj = wid >> 1;
        const int hoff = 4096 + (vh * 32 + 16 * s_tj + c) * 64 + 16 * s_ti + 4 * q, yoff = 3 * 4096 + (16 * y_tj + c) * 64 + vh * 32 + 16 * y_ti + 4 * q;
        struct PF { u32x4 g, r; uint2 h, y; };
#define PF_LOAD(X, k) do { const bf16_t* cc_ = ck0 + (size_t)(k) * 4 * 4096; X.h = *(const uint2*)(cc_ + hoff); X.y = *(const uint2*)(cc_ + yoff); X.g = *(const u32x4*)(cc_ + tid * 8); X.r = *(const u32x4*)(cc_ + 2 * 4096 + tid * 8); } while (0)
#define PF_STAGE(X, bufi) do { *(LAS u32x4*)(GB + (bufi) * MB + ((tid >> 3) * P + (tid & 7) * 8) * 2) = X.g; *(LAS u32x4*)(RB + (bufi) * MB + ((tid >> 3) * P + (tid & 7) * 8) * 2) = X.r; } while (0)
#define SC2_STEP(k, CUR, NXT) do { const uint2 hi_ = CUR.h, yi_ = CUR.y; const int cur = (k) & 1; \
            if ((k) + 4 < NCHK) PF_LOAD(CUR, (k) + 4); \
            const f32x4 hinit = {__uint_as_float(hi_.x << 16), __uint_as_float(hi_.x & 0xffff0000u), __uint_as_float(hi_.y << 16), __uint_as_float(hi_.y & 0xffff0000u)}; \
            const f32x4 yinit = {__uint_as_float(yi_.x << 16), __uint_as_float(yi_.x & 0xffff0000u), __uint_as_float(yi_.y << 16), __uint_as_float(yi_.y & 0xffff0000u)}; \
            const lchar* Sold = SB + cur * SBB; lchar* Snew = SB + (cur ^ 1) * SBB; \
            const f32x4 sn = mm_tile(GB + cur * MB, Sold, s_ti, s_tj, c, q, hinit);        \
            const f32x4 yv = mm_tile(Sold, RB + cur * MB, y_ti, y_tj, c, q, yinit);        \
            st_tile(Snew, s_ti, s_tj, c, q, sn); \
            { const int row = scan_row((k) * 64 + 16 * y_tj + c, b, z); stbf4(Y + z * PL + (size_t)row * D + h * 64 + vh * 32 + 16 * y_ti + 4 * q, yv); } \
            if ((k) + 1 < NCHK) PF_STAGE(NXT, cur ^ 1); \
            LBAR(); } while (0)
        PF s0, s1, s2, s3;
        PF_LOAD(s0, 0); PF_LOAD(s1, 1); PF_LOAD(s2, 2); PF_LOAD(s3, 3);
        LBAR();
        for (int i = tid; i < SBB / 4; i += NTHR) ((LAS unsigned*)SB)[i] = 0u;
        PF_STAGE(s0, 0);
        LBAR();
        for (int ch = 0; ch < NCHK; ch += 4) {
            SC2_STEP(ch, s0, s1); SC2_STEP(ch + 1, s1, s2); SC2_STEP(ch + 2, s2, s3); SC2_STEP(ch + 3, s3, s0);
        }
#undef PF_LOAD
#undef PF_STAGE
#undef SC2_STEP
    }
}
#undef LBAR

__device__ void ph_rw_out(const Params& p, int j, int nrows) {
    const int wid = tidx() >> 6, lane = tidx() & 63;
    const bf16_t* RKV = (const bf16_t*)(p.ws + OFF_RKV); const bf16_t* AV = (const bf16_t*)(p.ws + OFF_AV); const bf16_t* G = (const bf16_t*)(p.ws + OFF_G); const bf16_t* Y = (const bf16_t*)(p.ws + OFF_Y);
    bf16_t* OUT = (bf16_t*)(p.ws + OFF_H);
    const size_t PL = (size_t)NROW * D;
    const float* r_k = p.rw_r_k + j * D; const float* lg = p.rw_lnx_g + j * D; const float* lb = p.rw_lnx_b + j * D; const float* k_a = p.rw_k_a + j * D;
    uint2 nb[8][4];
#define OUT_LOAD(R) do { _Pragma("unroll") for (int i = 0; i < 4; ++i) { const size_t o_ = (size_t)(R) * D + lane * 4 + i * 256; \
        nb[0][i] = *(const uint2*)(Y + o_); nb[1][i] = *(const uint2*)(Y + PL + o_); nb[2][i] = *(const uint2*)(RKV + o_); nb[3][i] = *(const uint2*)(RKV + PL + o_); \
        nb[4][i] = *(const uint2*)(RKV + 2 * PL + o_); nb[5][i] = *(const uint2*)(AV + o_); nb[6][i] = *(const uint2*)(AV + PL + o_); nb[7][i] = *(const uint2*)(G + o_); } } while (0)
#define UNPK(w) ((f32x4){__uint_as_float((w).x << 16), __uint_as_float((w).x & 0xffff0000u), __uint_as_float((w).y << 16), __uint_as_float((w).y & 0xffff0000u)})
    int row = bidx() * 8 + wid;
    if (row < nrows) OUT_LOAD(row);
    for (; row < nrows; row += gdim() * 8) {
        uint2 cb[8][4];
#pragma unroll
        for (int q_ = 0; q_ < 8; ++q_)
#pragma unroll
            for (int i = 0; i < 4; ++i) cb[q_][i] = nb[q_][i];
        { const int nrow = row + gdim() * 8; if (nrow < nrows) OUT_LOAD(nrow); }
#pragma unroll
        for (int i = 0; i < 4; ++i) {
            const size_t o = (size_t)row * D + lane * 4 + i * 256; const int c = lane * 4 + i * 256;
            const f32x4 y = UNPK(cb[0][i]) + UNPK(cb[1][i]);
            const float mean = dpp_sum16(y[0] + y[1] + y[2] + y[3]) * (1.f / 64.f);
            const f32x4 dd = y - mean;
            const float rstd = rsqrtf(dpp_sum16(dd[0] * dd[0] + dd[1] * dd[1] + dd[2] * dd[2] + dd[3] * dd[3]) * (1.f / 64.f) + LNX_EPS);
            const f32x4 r = UNPK(cb[2][i]), k = UNPK(cb[3][i]), v = UNPK(cb[4][i]);
            const f32x4 a0 = UNPK(cb[5][i]), a1 = UNPK(cb[6][i]);
            const f32x4 kds = k * (2.f + (a0 + a1 - 2.f) * *(const f32x4*)(k_a + c));
            const f32x4 t4 = r * kds * *(const f32x4*)(r_k + c);
            const float bs = dpp_sum16(t4[0] + t4[1] + t4[2] + t4[3]);
            const f32x4 res = (dd * rstd * *(const f32x4*)(lg + c) + *(const f32x4*)(lb + c) + bs * v) * UNPK(cb[7][i]);
            uint2 w; w.x = pk2(res[0], res[1]); w.y = pk2(res[2], res[3]); *(uint2*)(OUT + o) = w;
        }
    }
#undef OUT_LOAD
#undef UNPK
}

__device__ void ph_final(const Params& p) {
    const int wid = tidx() >> 6, lane = tidx() & 63;
    const float* X = (const float*)(p.ws + OFF_X);
    for (int row = bidx() * 8 + wid; row < NLAT; row += gdim() * 8) {
        const float4* xr = (const float4*)(X + (size_t)row * D);
        float4 v[4]; float ss = 0;
#pragma unroll
        for (int i = 0; i < 4; ++i) { v[i] = xr[lane + i * 64]; ss += v[i].x * v[i].x + v[i].y * v[i].y + v[i].z * v[i].z + v[i].w * v[i].w; }
        ss = wave_sum(ss); const float rs = rsqrtf(ss * (1.f / D) + RMS_EPS);
#pragma unroll
        for (int i = 0; i < 4; ++i) { const int d = (lane + i * 64) * 4; const float4 gg = *(const float4*)(p.final_g + d);
            float4 o; o.x = v[i].x * rs * gg.x; o.y = v[i].y * rs * gg.y; o.z = v[i].z * rs * gg.z; o.w = v[i].w * rs * gg.w;
            *(float4*)(p.out + (size_t)row * D + d) = o; }
    }
}

enum { PH_INIT = 0, PH_A_NORM, PH_A_Z, PH_A_MID, PH_A_QKV, PH_A_POST, PH_A_ATTN, PH_A_WO,
       PH_R_NORM, PH_R_XS, PH_R_G1, PH_R_G2, PH_R_PREP, PH_R_SCAN, PH_R_OUT, PH_R_WO,
       PH_M_NORM, PH_M_SEL, PH_M_GATHER, PH_M_G1, PH_M_G2, PH_M_COMB, PH_FINAL, PH_M_CVT, PH_R_SC1, PH_R_SC2 };

#ifndef BG_Z
#define BG_Z 4
#define BG_ATTN 2
#define BG_WO 3
#define BG_RG1 6
#define BG_MG1 4
#define BG_MG2 6
#endif
template <int PH>
__device__ __forceinline__ void run_phase(const Params& p, int layer, char* lds) {
    const int j = layer >> 1;
    char* ws = p.ws;
    if constexpr (PH == PH_INIT) { ph_init(p, lds); __syncthreads(); ph_small_cvt(p, lds); }
    else if constexpr (PH == PH_A_NORM) { if (layer == 0) ph_norm_mod<false>(p, layer, p.norm1_g + layer * D, 0, 1, ws + OFF_H); else ph_comb_norm<false>(p, layer - 1, layer, NROW); }
    else if constexpr (PH == PH_A_Z) {
        float* Z = (float*)(ws + OFF_Z);
        g8::BatchSched S{ws + OFF_H, ws + OFF_WMLA + j * SZ_WMLA + WM_IN, 0, 0, NROW / 256, 2, 1, D};
        g8::gemm_phase(p.wv, (PG8_LAS unsigned char*)lds, D, S, g8::epi_rc([=](const g8::Unit&, int row, int col, f32x4 v) { *(f32x4*)(Z + (size_t)row * 512 + col) = v; }));
        if (idle_tail(NROW / 256 * 2)) bg_cvt(p, layer, lds, BG_Z);
    }
    else if constexpr (PH == PH_A_MID) ph_mla_mid(p, j);
    else if constexpr (PH == PH_A_QKV) {
        bf16_t* Q = (bf16_t*)(ws + OFF_Q); bf16_t* K = (bf16_t*)(ws + OFF_K); bf16_t* V = (bf16_t*)(ws + OFF_V);
        g8::BatchSched S1{ws + OFF_CQN, ws + OFF_WMLA + j * SZ_WMLA + WM_UQ, 0, 0, NROW / 256, 6, 1, 256, 1};
        g8::gemm_phase(p.wv, (PG8_LAS unsigned char*)lds, 256, S1, g8::epi_rc([=](const g8::Unit&, int row, int col, f32x4 v) {
            const bool lat = row < NLAT; const int b = lat ? (row >> 12) : ((row - NLAT) >> 8); const int tk = lat ? 256 + (row & (TL - 1)) : ((row - NLAT) & 255);
            const int h = col / 192, d = col - h * 192;
            uint2 w; w.x = pk2(v[0], v[1]); w.y = pk2(v[2], v[3]);
            *(uint2*)(Q + ((size_t)(b * 8 + h) * TK + tk) * 192 + d) = w; }));
        g8::BatchSched S2{ws + OFF_CKVN, ws + OFF_WMLA + j * SZ_WMLA + WM_UKV, 0, 0, NROW / 256, 8, 1, 128};
        g8::gemm_phase(p.wv, (PG8_LAS unsigned char*)lds, 128, S2, g8::epi_rc([=](const g8::Unit&, int row, int col, f32x4 v) {
            const bool lat = row < NLAT; const int b = lat ? (row >> 12) : ((row - NLAT) >> 8); const int tk = lat ? 256 + (row & (TL - 1)) : ((row - NLAT) & 255);
            const int h = col >> 8, d = col & 255; const size_t orow = (size_t)(b * 8 + h) * TK + tk;
            uint2 w; w.x = pk2(v[0], v[1]); w.y = pk2(v[2], v[3]);
            if (d < 128) *(uint2*)(K + orow * 192 + d) = w; else *(uint2*)(V + orow * 128 + (d - 128)) = w; }));
    }
    else if constexpr (PH == PH_A_ATTN) { ph_attn(p, lds); if (idle_tail(544)) bg_cvt(p, layer, lds, BG_ATTN); }
    else if constexpr (PH == PH_A_WO || PH == PH_R_WO) {
        xt_t* X = (xt_t*)(ws + OFF_X); const float* MOD = (const float*)(ws + OFF_MOD);
        g8::BatchSched S{ws + (PH == PH_A_WO ? OFF_O : OFF_H), PH == PH_A_WO ? ws + OFF_WMLA + j * SZ_WMLA + WM_O : ws + OFF_WRW + j * SZ_WRW + WR_O, 0, 0, (layer < 3 ? NROW : NLAT) / 256, 4, 1, D};
        g8::gemm_phase(p.wv, (PG8_LAS unsigned char*)lds, D, S, g8::EpiResid{X, MOD, layer});
        if (idle_tail((layer < 3 ? NROW : NLAT) / 256 * 4)) bg_cvt(p, layer, lds, BG_WO);
    }
    else if constexpr (PH == PH_R_XS) ph_rw_normxs(p, layer, j);
    else if constexpr (PH == PH_R_G1) {
        bf16_t* RKV = (bf16_t*)(ws + OFF_RKV); bf16_t* VF = (bf16_t*)(ws + OFF_VFIRST);
        bf16_t* A2 = (bf16_t*)(ws + OFF_A2); bf16_t* A3 = (bf16_t*)(ws + OFF_A3);
        const bool first = (j == 0);
        struct RSched { const char* XS; const char* WB; int nwg;
            __device__ __forceinline__ bool next(int i, g8::Unit& u) const {
                const int L = i * gdim() + bidx(); if (L >= nwg) return false;
                const int w = g8::xcd_remap(L, nwg);
                if (w < 816) { u.g = w / 272; const int r = w % 272; u.pm = r >> 2; u.pn = r & 3; u.B = WB + WR_RKV + (size_t)u.g * D * D * 2 + (size_t)u.pn * 256 * D * 2; }
                else { u.g = 3 + (w - 816) / 68; u.pm = (w - 816) % 68; u.pn = 0; u.B = WB + WR_L + (size_t)(u.g - 3) * 256 * D * 2; }
                u.A = XS + (size_t)(u.g == 6 ? 2 : u.g) * NROW * D * 2 + (size_t)u.pm * 256 * D * 2; return true; } };
        RSched S{ws + OFF_XS, ws + OFF_WRW + j * SZ_WRW, first ? 816 + 204 : 816 + 272};
        g8::gemm_phase(p.wv, (PG8_LAS unsigned char*)lds, D, S, g8::epi_rc([=](const g8::Unit& u, int row, int col, f32x4 v) {
            if (u.g < 3) { stbf4(RKV + ((size_t)u.g * NROW + row) * D + col, v); if (first && u.g == 2) stbf4(VF + (size_t)row * D + col, v); }
            else if (col < 128) {
                f32x4 t = v;
                if (u.g == 3) { for (int e = 0; e < 4; ++e) t[e] = 1.f - 2.f * __builtin_amdgcn_rcpf(1.f + __expf(2.f * v[e])); }
                else if (u.g == 5) { for (int e = 0; e < 4; ++e) t[e] = sigmoidf_(v[e]); }
                bf16_t* dst = (u.g == 3 ? A2 : u.g == 4 ? A2 + (size_t)NROW * 128 : u.g == 5 ? A3 : A3 + (size_t)NROW * 128);
                stbf4(dst + (size_t)row * 128 + col, t); } }));
        if (idle_tail(S.nwg)) bg_cvt(p, layer, lds, BG_RG1);
    }
    else if constexpr (PH == PH_R_G2) {
        const bool first = (j == 0);
        float* W = (float*)(ws + OFF_W); bf16_t* AV = (bf16_t*)(ws + OFF_AV); bf16_t* G = (bf16_t*)(ws + OFF_G); bf16_t* RKV = (bf16_t*)(ws + OFF_RKV); const bf16_t* VF = (const bf16_t*)(ws + OFF_VFIRST);
        const float* w0 = p.rw_w0 + (size_t)j * 2 * D; const float* a0 = p.rw_a0 + (size_t)j * 2 * D; const float* v0 = p.rw_v0;
        g8::BatchSched S1{ws + OFF_A2, ws + OFF_WRW + j * SZ_WRW + WR_B2, (size_t)NROW * 128 * 2, (size_t)2048 * 128 * 2, NROW / 256, 8, 2, 128};
        g8::gemm_phase(p.wv, (PG8_LAS unsigned char*)lds, 128, S1, g8::epi_colfirst([=](const g8::Unit& u, int row, int col, f32x4 v, f32x4 bias) {
            const int zz = u.pn >> 2, c = col & 1023; const bool dec = u.g == 0;
            const size_t doff = (size_t)zz * NROW * D + (size_t)row * D + c;
            const f32x4 x = v + bias; f32x4 o;
#pragma unroll
            for (int e = 0; e < 4; ++e) { const float sg = __builtin_amdgcn_rcpf(1.f + __expf(-x[e])); o[e] = dec ? (-0.6065306597126334f * sg) : sg; }
            if (dec) *(f32x4*)(W + doff) = o; else stbf4(AV + doff, o); },
            [=](const g8::Unit& u, int col) { const int zz = u.pn >> 2, c = col & 1023; return *(const f32x4*)((u.g == 0 ? w0 : a0) + zz * D + c); }));
        g8::BatchSched S2{ws + OFF_A3, ws + OFF_WRW + j * SZ_WRW + WR_B3, (size_t)NROW * 128 * 2, (size_t)1024 * 128 * 2, NROW / 256, 4, first ? 1 : 2, 128, 1};
        g8::gemm_phase(p.wv, (PG8_LAS unsigned char*)lds, 128, S2, g8::epi_rc([=](const g8::Unit& u, int row, int col, f32x4 v) {
            if (u.g == 0) stbf4(G + (size_t)row * D + col, v);
            else { const size_t o = (size_t)row * D + col; const f32x4 vv = ldbf4(RKV + (size_t)2 * NROW * D + o), vf = ldbf4(VF + o), gz = v + *(const f32x4*)(v0 + col); f32x4 r;
#pragma unroll
                for (int e = 0; e < 4; ++e) r[e] = vv[e] + (vf[e] - vv[e]) * __builtin_amdgcn_rcpf(1.f + __expf(-gz[e]));
                stbf4(RKV + (size_t)2 * NROW * D + o, r); } }));
    }
    else if constexpr (PH == PH_R_SCAN) ph_rw_scan(p, j, lds);
    else if constexpr (PH == PH_R_SC1) ph_rw_sc1(p, j, lds);
    else if constexpr (PH == PH_R_SC2) ph_rw_sc2(p, lds);
    else if constexpr (PH == PH_R_OUT) ph_rw_out(p, j, layer < 3 ? NROW : NLAT);
    else if constexpr (PH == PH_M_NORM) ph_norm2_router(p, layer, lds, layer < 3 ? NROW : NLAT);
    else if constexpr (PH == PH_M_SEL) { ph_select(p, lds, layer < 3 ? 128 : 64); __syncthreads(); moe_cvt(p, layer, lds, -1); }
    else if constexpr (PH == PH_M_GATHER) ph_gather(p, layer < 3 ? ESLOTS : NB * CAPL);
    else if constexpr (PH == PH_M_G1) {
        bf16_t* HID = (bf16_t*)(ws + OFF_HID);
        g8::BatchSched S{ws + OFF_XE, ws + OFF_W13T + (size_t)(layer & 1) * SZ_WMOE, (size_t)EPAD * D * 2, (size_t)2816 * D * 2, layer < 3 ? 9 : 8, 11, NE, D};
        g8::gemm_phase(p.wv, (PG8_LAS unsigned char*)lds, D, S, g8::epi_pair([=](const g8::Unit& u, int row, int col, f32x4 a, f32x4 b) {
            uint2 w; w.x = pk2(a[0] * __builtin_amdgcn_rcpf(1.f + __expf(-a[0])) * b[0], a[1] * __builtin_amdgcn_rcpf(1.f + __expf(-a[1])) * b[1]); w.y = pk2(a[2] * __builtin_amdgcn_rcpf(1.f + __expf(-a[2])) * b[2], a[3] * __builtin_amdgcn_rcpf(1.f + __expf(-a[3])) * b[3]);
            *(uint2*)(HID + ((size_t)u.g * EPAD + row) * FF + col) = w; }));
        if (layer < 3 && idle_tail(9 * 11 * NE)) moe_cvt(p, layer + 1, lds, BG_MG1);
    }
    else if constexpr (PH == PH_M_G2) {
        bf16_t* YE = (bf16_t*)(ws + OFF_YE); const float* GATE = (const float*)(ws + OFF_GATE);
        g8::BatchSched S{ws + OFF_HID, ws + OFF_W2T + (size_t)(layer & 1) * SZ_WMOE, (size_t)EPAD * FF * 2, (size_t)D * FF * 2, layer < 3 ? 9 : 8, 4, NE, FF};
        g8::gemm_phase(p.wv, (PG8_LAS unsigned char*)lds, FF, S, g8::epi_pre([=](const g8::Unit& u, int row, int col, f32x4 v, f32x4, float gt) {
            uint2 w; w.x = pk2(v[0] * gt, v[1] * gt); w.y = pk2(v[2] * gt, v[3] * gt);
            *(uint2*)(YE + ((size_t)u.g * EPAD + row) * D + col) = w; },
            [=](const g8::Unit&, int) { return (f32x4){0.f, 0.f, 0.f, 0.f}; }, [=](const g8::Unit& u, int row) { return GATE[u.g * EPAD + row]; }));
        if (layer < 3 && idle_tail(9 * 4 * NE)) moe_cvt(p, layer + 1, lds, BG_MG2);
    }
    else if constexpr (PH == PH_M_COMB) ph_combine(p, layer, layer < 3 ? NROW : NLAT);
    else if constexpr (PH == PH_M_CVT) moe_cvt(p, layer, lds, -1);
    else if constexpr (PH == PH_FINAL) ph_comb_norm<true>(p, 3, 0, NLAT);
}

#if ONE_LAUNCH
#define SYNC() xcd_barrier(bar)
#ifndef PROBE_PH
#define PROBE_PH -1
#endif
#ifndef PROBE_REP
#define PROBE_REP 1
#endif
__device__ __forceinline__ Params load_params() {
    Params q{};
#if defined(__HIP_DEVICE_COMPILE__)
    typedef const __attribute__((address_space(4))) unsigned long long* KargP;
    KargP kp_ = (KargP)__builtin_amdgcn_kernarg_segment_ptr(); asm volatile("" : "+s"(kp_));
#pragma unroll
    for (int i = 0; i < 40; ++i) ((const float**)&q)[i] = (const float*)(const __attribute__((address_space(1))) float*)kp_[i];
#endif
    return q;
}
#define RUN(PH) do { for (int rep_ = 0; rep_ < ((PH) == PROBE_PH ? PROBE_REP : 1); ++rep_) { Params q = load_params(); q.wv = wv0_; run_phase<PH>(q, layer, smem); SYNC(); } } while (0)
__global__ void __launch_bounds__(NTHR, 2) mega(Params p) {
    extern __shared__ __attribute__((aligned(16))) char smem[];
    const int wv0_ = __builtin_amdgcn_readfirstlane((int)threadIdx.x >> 6);
    if (threadIdx.x == 0) *(uint4*)(smem + LDS_BYTES) = make_uint4(0u, 0u, 0u, 0u);
    __syncthreads();
    XcdBarrier bar = xcd_barrier_post((unsigned*)(p.ws + OFF_BAR), (volatile LAS unsigned*)(smem + LDS_BYTES));
    { const int layer = 0; RUN(PH_INIT); }
    for (int layer = 0; layer < 4; ++layer) {
        if ((layer & 1) == 0) {
            RUN(PH_A_NORM);
            RUN(PH_A_Z);
            RUN(PH_A_MID);
            RUN(PH_A_QKV);
            RUN(PH_A_ATTN);
            RUN(PH_A_WO);
        } else {
            RUN(PH_R_XS);
            RUN(PH_R_G1);
            RUN(PH_R_G2);
            RUN(PH_R_SC1);
            RUN(PH_R_SC2);
            RUN(PH_R_OUT);
            RUN(PH_R_WO);
        }
        RUN(PH_M_NORM);
        RUN(PH_M_SEL);
        RUN(PH_M_G1);
        RUN(PH_M_G2);
        if ((layer & 1) == 0) RUN(PH_M_COMB);
    }
    { Params q = load_params(); q.wv = wv0_; run_phase<PH_FINAL>(q, 0, smem); }
}
#else
template <int PH> __global__ void __launch_bounds__(NTHR, 2) kph(Params p, int layer) {
    extern __shared__ __attribute__((aligned(16))) char smem[];
    Params q = p; q.wv = __builtin_amdgcn_readfirstlane((int)threadIdx.x >> 6);
    run_phase<PH>(q, layer, smem);
}
#endif

extern "C" void kernel_launch(void* const* d_in, const int* in_sizes, int n_in, void* d_out, int out_size, void* d_ws, size_t ws_size, hipStream_t stream) {
    if (n_in != 38 || ws_size < WS_NEED) { fprintf(stderr, "kernel_launch: bad args n_in %d ws %zu need %zu\n", n_in, ws_size, (size_t)WS_NEED); return; }
    Params p{};
    const float** pp = (const float**)&p;
    for (int i = 0; i < 38; ++i) pp[i] = (const float*)d_in[i];
    p.out = (float*)d_out; p.ws = (char*)d_ws;
    static int cus = 0;
    if (!cus) { int dev = 0; hipGetDevice(&dev); hipDeviceGetAttribute(&cus, hipDeviceAttributeMultiprocessorCount, dev); if (cus <= 0) cus = 256; }
    const int grid = cus;
#if ONE_LAUNCH
    hipFuncSetAttribute((const void*)mega, hipFuncAttributeMaxDynamicSharedMemorySize, LDS_BYTES + 16);
    hipMemsetAsync(d_ws, 0, 16384, stream);
    hipLaunchKernelGGL(mega, dim3(grid), dim3(NTHR), LDS_BYTES + 16, stream, p);
#else
    hipMemsetAsync(d_ws, 0, 16384, stream);
#define LAUNCH(PH, L) do { hipFuncSetAttribute((const void*)kph<PH>, hipFuncAttributeMaxDynamicSharedMemorySize, LDS_BYTES + 16); hipLaunchKernelGGL(kph<PH>, dim3(grid), dim3(NTHR), LDS_BYTES + 16, stream, p, L); } while (0)
    LAUNCH(PH_INIT, 0);
    for (int layer = 0; layer < 4; ++layer) {
        if ((layer & 1) == 0) { LAUNCH(PH_A_NORM, layer); LAUNCH(PH_A_Z, layer); LAUNCH(PH_A_MID, layer); LAUNCH(PH_A_QKV, layer); LAUNCH(PH_A_ATTN, layer); LAUNCH(PH_A_WO, layer); }
        else { LAUNCH(PH_R_XS, layer); LAUNCH(PH_R_G1, layer); LAUNCH(PH_R_G2, layer); LAUNCH(PH_R_SC1, layer); LAUNCH(PH_R_SC2, layer); LAUNCH(PH_R_OUT, layer); LAUNCH(PH_R_WO, layer); }
        LAUNCH(PH_M_NORM, layer); LAUNCH(PH_M_SEL, layer); LAUNCH(PH_M_G1, layer); LAUNCH(PH_M_G2, layer); if ((layer & 1) == 0) LAUNCH(PH_M_COMB, layer);
    }
    LAUNCH(PH_FINAL, 0);
#endif
}
```

```cpp
#include <hip/hip_runtime.h>
#include <stdint.h>
#include <stdio.h>

#ifndef ONE_LAUNCH
#define ONE_LAUNCH 1
#endif

#define NTHR 512
typedef unsigned short bf16_t;
typedef short bf16x8 __attribute__((ext_vector_type(8)));
typedef float f32x4 __attribute__((ext_vector_type(4)));
typedef unsigned u32x4 __attribute__((ext_vector_type(4)));
typedef unsigned u32x2 __attribute__((ext_vector_type(2)));

constexpr int D = 1024, NB = 4, TL = 4096, TC = 256, NLAT = NB * TL, NCTX = NB * TC, NROW = NLAT + NCTX;
constexpr int TK = TL + TC;
constexpr int NE = 16, FF = 1408, CAPL = 512, CAPC = 32, ESLOTS = NB * CAPL + NB * CAPC;
constexpr int EPAD = 2304;
constexpr float RMS_EPS = 1e-6f, LNX_EPS = 64e-5f;
constexpr float ATT_SCALE = 0.07216878364870322f;

constexpr size_t al256(size_t x) { return (x + 255) / 256 * 256; }
constexpr size_t OFF_BAR = 0;
constexpr size_t OFF_QUEUE = 14336;
constexpr size_t OFF_MOD = 16384;
constexpr size_t OFF_ROPE_C = OFF_MOD + al256(4 * 5 * 6144 * 4);
constexpr size_t OFF_ROPE_S = OFF_ROPE_C + al256(TL * 32 * 4);
constexpr size_t OFF_X = OFF_ROPE_S + al256(TL * 32 * 4);
constexpr size_t SZ_F32 = (size_t)NROW * D * 4, SZ_BF = (size_t)NROW * D * 2;
constexpr size_t OFF_VFIRST = OFF_X + SZ_BF;
constexpr size_t OFF_H = OFF_VFIRST + SZ_BF;
constexpr size_t SZ_WMLA = (size_t)(512 * 1024 + 1536 * 256 + 2048 * 256 + 1024 * 1024) * 2;
constexpr size_t WM_IN = 0, WM_UQ = (size_t)512 * 1024 * 2, WM_UKV = WM_UQ + (size_t)1536 * 256 * 2, WM_O = WM_UKV + (size_t)2048 * 256 * 2;
constexpr size_t SZ_WRW = (size_t)(3 * 1024 * 1024 + 4 * 256 * 1024 + 1024 * 1024 + 4096 * 256 + 2048 * 256) * 2;
constexpr size_t WR_RKV = 0, WR_L = (size_t)3 * 1024 * 1024 * 2, WR_O = WR_L + (size_t)4 * 256 * 1024 * 2, WR_B2 = WR_O + (size_t)1024 * 1024 * 2, WR_B3 = WR_B2 + (size_t)4096 * 256 * 2;
constexpr size_t OFF_WMLA = OFF_H + SZ_BF;
constexpr size_t OFF_WRW = OFF_WMLA + 2 * SZ_WMLA;
constexpr size_t OFF_W13T = OFF_WRW + 2 * SZ_WRW;
constexpr size_t OFF_W2T = OFF_W13T + (size_t)NE * 2816 * D * 2;
constexpr size_t SZ_WMOE = (size_t)NE * 2816 * D * 2 + (size_t)NE * D * FF * 2;
constexpr size_t OFF_S = OFF_W13T + 2 * SZ_WMOE;
constexpr size_t OFF_Z = OFF_S;
constexpr size_t OFF_CQN = OFF_Z + al256((size_t)NROW * 512 * 4);
constexpr size_t OFF_CKVN = OFF_CQN + al256((size_t)NROW * 256 * 2);
constexpr size_t OFF_KR = OFF_CKVN + al256((size_t)NROW * 256 * 2);
constexpr size_t OFF_QRAW = OFF_KR + al256((size_t)NROW * 64 * 4);
constexpr size_t OFF_KVRAW = OFF_QRAW + al256((size_t)NROW * 1536 * 4);
constexpr size_t OFF_Q = OFF_KVRAW + al256((size_t)NROW * 2048 * 4);
constexpr size_t OFF_K = OFF_Q + al256((size_t)NB * 8 * TK * 192 * 2);
constexpr size_t OFF_V = OFF_K + al256((size_t)NB * 8 * TK * 192 * 2);
constexpr size_t OFF_O = OFF_V + al256((size_t)NB * 8 * TK * 128 * 2);
constexpr size_t END_MLA = OFF_O + SZ_BF;
constexpr size_t OFF_XS = OFF_S;
constexpr size_t OFF_RKV = OFF_XS + 6 * SZ_BF;
constexpr size_t OFF_W = OFF_RKV + 3 * SZ_BF;
constexpr size_t OFF_AV = OFF_W + 2 * SZ_F32;
constexpr size_t OFF_G = OFF_AV + 2 * SZ_BF;
constexpr size_t OFF_A2 = OFF_G + SZ_BF;
constexpr size_t OFF_A3 = OFF_A2 + al256((size_t)NROW * 256 * 2);
constexpr size_t END_RW = OFF_A3 + al256((size_t)NROW * 256 * 2);
constexpr size_t OFF_Y = OFF_XS;
constexpr int NCHK = (TC + TL) / 64;
constexpr size_t OFF_CK = END_RW;
constexpr size_t END_RW2 = OFF_CK + (size_t)128 * NCHK * 4 * 4096 * 2;
constexpr size_t OFF_AFF = OFF_S;
constexpr size_t OFF_ROWIDX = OFF_AFF + al256((size_t)NROW * 16 * 4);
constexpr size_t OFF_GATE = OFF_ROWIDX + al256((size_t)NE * ESLOTS * 4);
constexpr size_t OFF_SLOT = OFF_GATE + al256((size_t)NE * EPAD * 4);
constexpr size_t OFF_XE = OFF_SLOT + al256((size_t)NROW * 16 * 4);
constexpr size_t OFF_HID = OFF_XE + al256((size_t)NE * EPAD * D * 2);
constexpr size_t OFF_YE = OFF_HID + al256((size_t)NE * EPAD * FF * 2);
constexpr size_t END_MOE = OFF_YE + al256((size_t)NE * EPAD * D * 2);
constexpr size_t WS_NEED = END_RW2 > END_MLA ? (END_RW2 > END_MOE ? END_RW2 : END_MOE) : (END_MLA > END_MOE ? END_MLA : END_MOE);

constexpr int LDS_BYTES = 152064;

struct Params {
    const float *x, *c, *ctx, *c_ctx, *mod_w, *mod_b, *norm1_g, *norm2_g, *final_g;
    const float *mla_w_in, *mla_g_q, *mla_g_kv, *mla_w_uq, *mla_w_ukv, *mla_w_o;
    const float *rw_mu, *rw_w_rkv, *rw_w0, *rw_w1, *rw_w2, *rw_a0, *rw_a1, *rw_a2, *rw_v0, *rw_v1, *rw_v2, *rw_g1, *rw_g2, *rw_k_k, *rw_k_a, *rw_r_k, *rw_lnx_g, *rw_lnx_b, *rw_w_o;
    const float *moe_router, *moe_w1, *moe_w3, *moe_w2;
    float* out; char* ws;
    int wv, pad_;
};

__device__ __forceinline__ int bidx() { int t = blockIdx.x; asm volatile("" : "+s"(t)); return t; }
__device__ __forceinline__ int gdim() { int t = gridDim.x; asm volatile("" : "+s"(t)); return t; }
__device__ __forceinline__ int tidx_w(int wv) { int l; asm volatile("v_mbcnt_lo_u32_b32 %0, -1, 0\n\tv_mbcnt_hi_u32_b32 %0, -1, %0" : "=v"(l)); return (wv << 6) | l; }
#define tidx() tidx_w(p.wv)
#define XB_TMO      128
#define XB_XCNT(j)  (256  + 64 * (j))
#define XB_XSUB(j)  (1280 + 64 * (j))
#define XB_XGEN(j)  (2304 + 64 * (j))
#define XB_TOP      3328
#define XB_TOPGEN   3392
#define XCD_BAR_WORDS 3456
#define XB_SPIN_CAP (1u << 22)
#define LAS __attribute__((address_space(3)))

__device__ __forceinline__ unsigned xb_ld(unsigned* p)              { return __hip_atomic_load(p, __ATOMIC_RELAXED, __HIP_MEMORY_SCOPE_AGENT); }
__device__ __forceinline__ unsigned xb_add(unsigned* p, unsigned v) { return __hip_atomic_fetch_add(p, v, __ATOMIC_RELAXED, __HIP_MEMORY_SCOPE_AGENT); }
__device__ __forceinline__ unsigned xb_xcc_id() { return (unsigned)__builtin_amdgcn_s_getreg((3 << 11) | 20) & 0xFu; }
#define XB_SPIN(cond, bar) do { unsigned _sp = 0; while (cond) { __builtin_amdgcn_s_sleep(1); \
    if ((++_sp & 255u) == 0u) { if (xb_ld(&(bar)[XB_TMO])) break; if (_sp > XB_SPIN_CAP) { atomicAdd(&(bar)[XB_TMO], 1u); break; } } } } while (0)

struct XcdBarrier { unsigned* bar; unsigned x; volatile LAS unsigned* st; };

__device__ __forceinline__ XcdBarrier xcd_barrier_post(unsigned* bar, volatile LAS unsigned* st) {
    XcdBarrier b; b.bar = bar; b.x = xb_xcc_id(); b.st = st;
    if (threadIdx.x == 0) (void)xb_add(&bar[XB_XCNT(b.x)], 1u);
    return b;
}
__device__ __forceinline__ void xcd_barrier_complete(unsigned* bar, unsigned x, unsigned& nloc, unsigned& nx) {
    const unsigned G = gridDim.x * gridDim.y * gridDim.z;
    unsigned sum, cnt, mine, sp = 0u;
    for (;;) {
        sum = 0u; cnt = 0u; mine = 0u;
#pragma unroll
        for (unsigned j = 0; j < 16; ++j) { const unsigned c = xb_ld(&bar[XB_XCNT(j)]); sum += c; cnt += (c > 0u) ? 1u : 0u; mine = (j == x) ? c : mine; }
        if (sum == G) break;
        __builtin_amdgcn_s_sleep(1);
        if ((++sp & 255u) == 0u) { if (xb_ld(&bar[XB_TMO])) break; if (sp > XB_SPIN_CAP) { atomicAdd(&bar[XB_TMO], 1u); break; } }
    }
    nloc = mine > 0u ? mine : 1u; nx = cnt > 0u ? cnt : 1u;
}
__device__ __forceinline__ void xcd_barrier(const XcdBarrier& b) {
    asm volatile("s_waitcnt vmcnt(0)" ::: "memory");
    __syncthreads();
    if (threadIdx.x == 0) {
        unsigned* bar = b.bar;
        __builtin_amdgcn_s_waitcnt(0);
        unsigned nloc = b.st[0], nx = b.st[1];
        if (nloc == 0u) { xcd_barrier_complete(bar, b.x, nloc, nx); b.st[0] = nloc; b.st[1] = nx; }
        const unsigned old = xb_add(&bar[XB_XSUB(b.x)], 1u);
        const unsigned gen = old / nloc;
        if (old + 1u == (gen + 1u) * nloc) {
            __builtin_amdgcn_fence(__ATOMIC_RELEASE, "agent");
            asm volatile("s_waitcnt vmcnt(0)" ::: "memory");
            const unsigned og = xb_add(&bar[XB_TOP], 1u);
            const unsigned tg = og / nx;
            if (og + 1u == (tg + 1u) * nx) xb_add(&bar[XB_TOPGEN], 1u);
            else XB_SPIN(xb_ld(&bar[XB_TOPGEN]) == tg, bar);
            __builtin_amdgcn_fence(__ATOMIC_ACQUIRE, "agent");
            xb_add(&bar[XB_XGEN(b.x)], 1u);
            asm volatile("s_waitcnt vmcnt(0)" ::: "memory");
        } else {
            XB_SPIN(xb_ld(&bar[XB_XGEN(b.x)]) == gen, bar);
            __builtin_amdgcn_fence(__ATOMIC_ACQUIRE, "agent");
            asm volatile("s_waitcnt vmcnt(0)" ::: "memory");
        }
    }
    __syncthreads();
}

__device__ __forceinline__ float bf2f(bf16_t b) { return __uint_as_float(((unsigned)b) << 16); }
typedef float f32x2_ __attribute__((ext_vector_type(2)));
typedef __bf16 bf16x2_ __attribute__((ext_vector_type(2)));
__device__ __forceinline__ unsigned pk2(float lo, float hi) { const f32x2_ v = {lo, hi}; return __builtin_bit_cast(unsigned, __builtin_convertvector(v, bf16x2_)); }
__device__ __forceinline__ bf16_t f2bf(float f) { return (bf16_t)(pk2(f, f) & 0xffffu); }
__device__ __forceinline__ float dpp_sum16(float x) {
    x += __builtin_bit_cast(float, __builtin_amdgcn_update_dpp(0, __builtin_bit_cast(int, x), 0xB1, 0xF, 0xF, true));
    x += __builtin_bit_cast(float, __builtin_amdgcn_update_dpp(0, __builtin_bit_cast(int, x), 0x4E, 0xF, 0xF, true));
    x += __builtin_bit_cast(float, __builtin_amdgcn_update_dpp(0, __builtin_bit_cast(int, x), 0x141, 0xF, 0xF, true));
    x += __builtin_bit_cast(float, __builtin_amdgcn_update_dpp(0, __builtin_bit_cast(int, x), 0x140, 0xF, 0xF, true));
    return x;
}
__device__ __forceinline__ f32x4 ldbf4(const bf16_t* p) { const uint2 w = *(const uint2*)p; return (f32x4){__uint_as_float(w.x << 16), __uint_as_float(w.x & 0xffff0000u), __uint_as_float(w.y << 16), __uint_as_float(w.y & 0xffff0000u)}; }
__device__ __forceinline__ void stbf4(bf16_t* p, f32x4 v) { uint2 w; w.x = pk2(v[0], v[1]); w.y = pk2(v[2], v[3]); *(uint2*)p = w; }
typedef bf16_t xt_t;
__device__ __forceinline__ f32x4 xldv(const xt_t* X, size_t i) { return ldbf4(X + i); }
__device__ __forceinline__ void xstv(xt_t* X, size_t i, f32x4 v) { stbf4(X + i, v); }
__device__ __forceinline__ float4 xld(const xt_t* X, size_t i) { const f32x4 v = ldbf4(X + i); return make_float4(v[0], v[1], v[2], v[3]); }
__device__ __forceinline__ void xst(xt_t* X, size_t i, float4 v) { stbf4(X + i, (f32x4){v.x, v.y, v.z, v.w}); }
__device__ __forceinline__ float wave_sum(float v) {
    v = dpp_sum16(v); const int i = __builtin_bit_cast(int, v);
    return __builtin_bit_cast(float, __builtin_amdgcn_readlane(i, 0)) + __builtin_bit_cast(float, __builtin_amdgcn_readlane(i, 16)) + __builtin_bit_cast(float, __builtin_amdgcn_readlane(i, 32)) + __builtin_bit_cast(float, __builtin_amdgcn_readlane(i, 48));
}
__device__ __forceinline__ float sigmoidf_(float x) { return __builtin_amdgcn_rcpf(1.f + __expf(-x)); }
__device__ __forceinline__ int row_stream(int row) { return row < NLAT ? (row >> 12) : 4; }
__device__ __forceinline__ const float* modp(const Params& p, int layer, int s, int part) { return (const float*)(p.ws + OFF_MOD) + ((size_t)layer * 5 + s) * 6144 + part * 1024; }

struct SgArgs { const bf16_t* A; int lda; size_t strideA; const float* B; int ldb; size_t strideB; int M, N, K, nbatch; };
template <class Epi>
__device__ __forceinline__ void sg_gemm(const Params& p, char* lds, const SgArgs g, const Epi& epi) {
    bf16_t* As = (bf16_t*)lds;
    bf16_t* Bs = As + 128 * 40;
    const int tid = tidx(), wid = tid >> 6, lane = tid & 63;
    const int wr = wid >> 2, wc = wid & 3;
    const int tilesN = (g.N + 127) / 128, tilesM = g.M / 128, per = tilesM * tilesN, ntiles = per * g.nbatch;
    const int ar = tid >> 2, ak = (tid & 3) * 8;
    const int bn = tid & 127, bk = (tid >> 7) * 8;
    for (int tile = bidx(); tile < ntiles; tile += gdim()) {
        const int bt = tile / per, tt = tile % per;
        const int tm = tt / tilesN, tn = tt % tilesN;
        const int m0 = tm * 128, n0 = tn * 128;
        f32x4 acc[4][2];
#pragma unroll
        for (int m = 0; m < 4; ++m)
#pragma unroll
            for (int n = 0; n < 2; ++n) acc[m][n] = (f32x4){0.f, 0.f, 0.f, 0.f};
        const bool bvalid = (n0 + bn) < g.N;
        const bf16_t* ap = g.A + bt * g.strideA + (size_t)(m0 + ar) * g.lda + ak;
        const float* bp = g.B + bt * g.strideB + (size_t)bk * g.ldb + n0 + bn;
        bf16x8 areg; float breg[8];
        areg = *(const bf16x8*)ap;
#pragma unroll
        for (int j = 0; j < 8; ++j) breg[j] = bvalid ? bp[(size_t)j * g.ldb] : 0.f;
        for (int k0 = 0; k0 < g.K; k0 += 32) {
            __syncthreads();
            *(bf16x8*)(As + ar * 40 + ak) = areg;
            { u32x4 w; w.x = pk2(breg[0], breg[1]); w.y = pk2(breg[2], breg[3]); w.z = pk2(breg[4], breg[5]); w.w = pk2(breg[6], breg[7]); *(u32x4*)(Bs + bn * 40 + bk) = w; }
            __syncthreads();
            if (k0 + 32 < g.K) {
                areg = *(const bf16x8*)(ap + k0 + 32);
#pragma unroll
                for (int j = 0; j < 8; ++j) breg[j] = bvalid ? bp[(size_t)(k0 + 32 + j) * g.ldb] : 0.f;
            }
            bf16x8 af[4], bfr[2];
#pragma unroll
            for (int m = 0; m < 4; ++m) af[m] = *(const bf16x8*)(As + (wr * 64 + m * 16 + (lane & 15)) * 40 + (lane >> 4) * 8);
#pragma unroll
            for (int n = 0; n < 2; ++n) bfr[n] = *(const bf16x8*)(Bs + (wc * 32 + n * 16 + (lane & 15)) * 40 + (lane >> 4) * 8);
#pragma unroll
            for (int m = 0; m < 4; ++m)
#pragma unroll
                for (int n = 0; n < 2; ++n) acc[m][n] = __builtin_amdgcn_mfma_f32_16x16x32_bf16(af[m], bfr[n], acc[m][n], 0, 0, 0);
        }
#pragma unroll
        for (int m = 0; m < 4; ++m)
#pragma unroll
            for (int n = 0; n < 2; ++n) {
                const int col = n0 + wc * 32 + n * 16 + (lane & 15);
                if (col < g.N) {
#pragma unroll
                    for (int r = 0; r < 4; ++r) epi(bt, m0 + wr * 64 + m * 16 + (lane >> 4) * 4 + r, col, acc[m][n][r]);
                }
            }
    }
}


namespace g8 {
#define PG8_LAS __attribute__((address_space(3)))
constexpr int BM = 256, BK = 64, HALF = 128, HTB = HALF * BK * 2, STAGE_BYTES = 8 * HTB;
__device__ __forceinline__ int lds_byte(int r, int c) { const int st = (r >> 4) * 2 + (c >> 5), rr = r & 15, cc = c & 31, ob = rr * 64 + cc * 2; return st * 1024 + (ob ^ (((ob >> 9) & 1) << 5)); }
__device__ __forceinline__ void stage_rc(int b, int& R, int& C) { const int st = b / 1024, sb = b % 1024, swz = sb ^ (((sb >> 9) & 1) << 5); R = (st >> 1) * 16 + swz / 64; C = (st & 1) * 32 + (swz % 64) / 2; }
struct Unit { int pm, pn, g; const char* A; const char* B; };
__device__ __forceinline__ int xcd_remap(int L, int nwg) { const int q = nwg / 8, r = nwg % 8, xcd = L % 8, off = L / 8; return (xcd < r ? xcd * (q + 1) : r * (q + 1) + (xcd - r) * q) + off; }

template <class Epi, class Sched>
__device__ __forceinline__ void gemm_phase(const int wv_, PG8_LAS unsigned char* lds, const int K, const Sched& S, const Epi& E) {
    const int tid = tidx_w(wv_), wid = __builtin_amdgcn_readfirstlane(tid >> 6), lane = tid & 63, wr = wid >> 2, wc = wid & 3, fr = lane & 15, fq = lane >> 4;
    const int nt = K / BK;
    unsigned voffA[2];
#pragma unroll
    for (int i = 0; i < 2; ++i) { int R, C; stage_rc(tid * 16 + i * 8192, R, C); voffA[i] = (unsigned)(R * K + C) * 2u; }
    const size_t kstep = (size_t)(BK * 2);
    const size_t hstep = (size_t)HALF * K * 2;
    const unsigned ldsw = (unsigned)wid * 1024u;
    const int aoff = lds_byte(wr * 64 + fr, fq * 8), boff = lds_byte(wc * 32 + fr, fq * 8);
#define PG8_SA(b, h) (((b) * 2 + (h)) * HTB)
#define PG8_SB(b, h) ((4 + (b) * 2 + (h)) * HTB)
#define PG8_STAGE(bufoff, gbase, voff) do { _Pragma("unroll") for (int _i = 0; _i < 2; ++_i) \
        __builtin_amdgcn_global_load_lds((const unsigned*)((const char*)(gbase) + (voff)[_i]), (PG8_LAS unsigned*)(lds + (bufoff) + ldsw + _i * 8192), 16, 0, 0); } while (0)
#define PG8_LDA(dst, b, h) do { _Pragma("unroll") for (int m = 0; m < 4; ++m) _Pragma("unroll") for (int k = 0; k < 2; ++k) dst[m][k] = *(const PG8_LAS bf16x8*)(lds + PG8_SA(b, h) + aoff + m * 2048 + k * 1024); } while (0)
#define PG8_LDB(dst, b, h) do { _Pragma("unroll") for (int n = 0; n < 2; ++n) _Pragma("unroll") for (int k = 0; k < 2; ++k) dst[n][k] = *(const PG8_LAS bf16x8*)(lds + PG8_SB(b, h) + boff + n * 2048 + k * 1024); } while (0)
#define PG8_MMA(ai, bj, At, Bt) do { __builtin_amdgcn_s_setprio(1); _Pragma("unroll") for (int m = 0; m < 4; ++m) _Pragma("unroll") for (int n = 0; n < 2; ++n) _Pragma("unroll") for (int k = 0; k < 2; ++k) \
        acc[ai][bj][m][n] = __builtin_amdgcn_mfma_f32_16x16x32_bf16(Bt[n][k], At[m][k], acc[ai][bj][m][n], 0, 0, 0); __builtin_amdgcn_s_setprio(0); } while (0)
#define PG8_WAIT_V(n) asm volatile("s_waitcnt vmcnt(" #n ")" ::: "memory")
#define PG8_WAIT_L(n) asm volatile("s_waitcnt lgkmcnt(" #n ")" ::: "memory")
#define PG8_BAR __builtin_amdgcn_s_barrier()
#define PG8_SCHED __builtin_amdgcn_sched_barrier(0)
    Unit cur, nxt; int ui = 0;
    if (!S.next(0, cur)) return;
    f32x4 acc[2][2][4][2];
#pragma unroll
    for (int a = 0; a < 2; ++a)
#pragma unroll
        for (int b = 0; b < 2; ++b)
#pragma unroll
            for (int m = 0; m < 4; ++m)
#pragma unroll
                for (int n = 0; n < 2; ++n) acc[a][b][m][n] = (f32x4){0.f, 0.f, 0.f, 0.f};
    bf16x8 At[4][2], B0[2][2], B1[2][2];
    const char* cA = cur.A; const char* cB = cur.B;
    PG8_STAGE(PG8_SB(0, 0), cB, voffA); PG8_STAGE(PG8_SA(0, 0), cA, voffA); PG8_STAGE(PG8_SB(0, 1), cB + hstep, voffA); PG8_STAGE(PG8_SA(0, 1), cA + hstep, voffA);
    if (wr == 1) PG8_BAR;
    PG8_WAIT_V(4); PG8_BAR;
    PG8_STAGE(PG8_SB(1, 0), cB + kstep, voffA); PG8_STAGE(PG8_SA(1, 0), cA + kstep, voffA); PG8_STAGE(PG8_SB(1, 1), cB + hstep + kstep, voffA);
    PG8_WAIT_V(6); PG8_BAR;
    for (;;) {
        const bool has_next = S.next(ui + 1, nxt);
        const char* nA = has_next ? nxt.A : cA; const char* nB = has_next ? nxt.B : cB;
        for (int t = 0; t < nt; t += 2) {
            const bool last = (t == nt - 2);
            const char* a1 = cA + (size_t)(t + 1) * kstep;
            const char* a2 = last ? nA : cA + (size_t)(t + 2) * kstep; const char* b2 = last ? nB : cB + (size_t)(t + 2) * kstep;
            const char* a3 = a2 + kstep; const char* b3 = b2 + kstep;
            PG8_LDB(B0, 0, 0); PG8_SCHED; PG8_LDA(At, 0, 0); PG8_STAGE(PG8_SA(1, 1), a1 + hstep, voffA);
            PG8_WAIT_L(8); PG8_BAR; PG8_WAIT_L(0); PG8_MMA(0, 0, At, B0); PG8_BAR; PG8_SCHED;
            PG8_LDB(B1, 0, 1); PG8_STAGE(PG8_SB(0, 0), b2, voffA);
            PG8_BAR; PG8_WAIT_L(0); PG8_MMA(0, 1, At, B1); PG8_BAR;
            PG8_LDA(At, 0, 1); PG8_STAGE(PG8_SA(0, 0), a2, voffA);
            PG8_BAR; PG8_WAIT_L(0); PG8_MMA(1, 0, At, B0); PG8_BAR; PG8_SCHED;
            PG8_STAGE(PG8_SB(0, 1), b2 + hstep, voffA);
            PG8_WAIT_V(6); PG8_BAR; PG8_MMA(1, 1, At, B1); PG8_BAR;
            PG8_LDB(B0, 1, 0); PG8_SCHED; PG8_LDA(At, 1, 0); PG8_STAGE(PG8_SA(0, 1), a2 + hstep, voffA);
            PG8_WAIT_L(8); PG8_BAR; PG8_WAIT_L(0); PG8_MMA(0, 0, At, B0); PG8_BAR; PG8_SCHED;
            PG8_LDB(B1, 1, 1); PG8_STAGE(PG8_SB(1, 0), b3, voffA);
            PG8_BAR; PG8_WAIT_L(0); PG8_MMA(0, 1, At, B1); PG8_BAR;
            PG8_LDA(At, 1, 1); PG8_STAGE(PG8_SA(1, 0), a3, voffA);
            PG8_BAR; PG8_WAIT_L(0); PG8_MMA(1, 0, At, B0); PG8_BAR; PG8_SCHED;
            PG8_STAGE(PG8_SB(1, 1), b3 + hstep, voffA);
            PG8_WAIT_V(6); PG8_BAR; PG8_MMA(1, 1, At, B1); PG8_BAR;
        }
        E(acc, cur, wr, wc, fr, fq);
        if (!has_next) break;
#pragma unroll
        for (int a = 0; a < 2; ++a)
#pragma unroll
            for (int b = 0; b < 2; ++b)
#pragma unroll
                for (int m = 0; m < 4; ++m)
#pragma unroll
                    for (int n = 0; n < 2; ++n) acc[a][b][m][n] = (f32x4){0.f, 0.f, 0.f, 0.f};
        cur = nxt; cA = nA; cB = nB; ++ui;
    }
    PG8_WAIT_V(0);
    if (wr == 0) PG8_BAR;
    PG8_BAR;
#undef PG8_SA
#undef PG8_SB
#undef PG8_STAGE
#undef PG8_LDA
#undef PG8_LDB
#undef PG8_MMA
#undef PG8_WAIT_V
#undef PG8_WAIT_L
#undef PG8_BAR
#undef PG8_SCHED
}
template <class F> struct EpiRC { F f;
    __device__ __forceinline__ void operator()(const f32x4 (&acc)[2][2][4][2], const Unit& u, int wr, int wc, int fr, int fq) const {
#pragma unroll
        for (int ai = 0; ai < 2; ++ai)
#pragma unroll
            for (int m = 0; m < 4; ++m) { const int row = u.pm * BM + ai * HALF + wr * 64 + m * 16 + fr;
#pragma unroll
                for (int bj = 0; bj < 2; ++bj)
#pragma unroll
                    for (int n = 0; n < 2; ++n) f(u, row, u.pn * BM + bj * HALF + wc * 32 + n * 16 + 4 * fq, acc[ai][bj][m][n]);
                asm volatile("" ::: "memory"); }
    } };
template <class F> __device__ __forceinline__ EpiRC<F> epi_rc(const F& f) { return EpiRC<F>{f}; }
template <class F> struct EpiPair { F f;
    __device__ __forceinline__ void operator()(const f32x4 (&acc)[2][2][4][2], const Unit& u, int wr, int wc, int fr, int fq) const {
#pragma unroll
        for (int ai = 0; ai < 2; ++ai)
#pragma unroll
            for (int m = 0; m < 4; ++m) { const int row = u.pm * BM + ai * HALF + wr * 64 + m * 16 + fr;
#pragma unroll
                for (int n = 0; n < 2; ++n) f(u, row, u.pn * HALF + wc * 32 + n * 16 + 4 * fq, acc[ai][0][m][n], acc[ai][1][m][n]);
                asm volatile("" ::: "memory"); }
    } };
template <class F> __device__ __forceinline__ EpiPair<F> epi_pair(const F& f) { return EpiPair<F>{f}; }
template <class F, class CF, class RF> struct EpiPre { F f; CF cf; RF rf;
    __device__ __forceinline__ void operator()(const f32x4 (&acc)[2][2][4][2], const Unit& u, int wr, int wc, int fr, int fq) const {
        f32x4 cv[2][2]; float rv[2][4];
#pragma unroll
        for (int bj = 0; bj < 2; ++bj)
#pragma unroll
            for (int n = 0; n < 2; ++n) cv[bj][n] = cf(u, u.pn * BM + bj * HALF + wc * 32 + n * 16 + 4 * fq);
#pragma unroll
        for (int ai = 0; ai < 2; ++ai)
#pragma unroll
            for (int m = 0; m < 4; ++m) rv[ai][m] = rf(u, u.pm * BM + ai * HALF + wr * 64 + m * 16 + fr);
#pragma unroll
        for (int ai = 0; ai < 2; ++ai)
#pragma unroll
            for (int m = 0; m < 4; ++m) { const int row = u.pm * BM + ai * HALF + wr * 64 + m * 16 + fr;
#pragma unroll
                for (int bj = 0; bj < 2; ++bj)
#pragma unroll
                    for (int n = 0; n < 2; ++n) f(u, row, u.pn * BM + bj * HALF + wc * 32 + n * 16 + 4 * fq, acc[ai][bj][m][n], cv[bj][n], rv[ai][m]);
                asm volatile("" ::: "memory"); }
    } };
template <class F, class CF, class RF> __device__ __forceinline__ EpiPre<F, CF, RF> epi_pre(const F& f, const CF& cf, const RF& rf) { return EpiPre<F, CF, RF>{f, cf, rf}; }
template <class F, class CF> struct EpiColFirst { F f; CF cf;
    __device__ __forceinline__ void operator()(const f32x4 (&acc)[2][2][4][2], const Unit& u, int wr, int wc, int fr, int fq) const {
#pragma unroll
        for (int bj = 0; bj < 2; ++bj)
#pragma unroll
            for (int n = 0; n < 2; ++n) { const int col = u.pn * BM + bj * HALF + wc * 32 + n * 16 + 4 * fq; const f32x4 cv = cf(u, col);
#pragma unroll
                for (int ai = 0; ai < 2; ++ai)
#pragma unroll
                    for (int m = 0; m < 4; ++m) f(u, u.pm * BM + ai * HALF + wr * 64 + m * 16 + fr, col, acc[ai][bj][m][n], cv);
                asm volatile("" ::: "memory"); }
    } };
template <class F, class CF> __device__ __forceinline__ EpiColFirst<F, CF> epi_colfirst(const F& f, const CF& cf) { return EpiColFirst<F, CF>{f, cf}; }
struct EpiResid { xt_t* X; const float* MOD; int layer;
    __device__ __forceinline__ void operator()(const f32x4 (&acc)[2][2][4][2], const Unit& u, int wr, int wc, int fr, int fq) const {
        const int row0 = u.pm * BM + wr * 64 + fr, col0 = u.pn * BM + wc * 32 + 4 * fq;
        const int strm = row0 < NLAT ? (row0 >> 12) : 4;
        const float* gp = MOD + ((size_t)layer * 5 + strm) * 6144 + 2048 + col0;
        f32x4 gt[2][2];
#pragma unroll
        for (int bj = 0; bj < 2; ++bj)
#pragma unroll
            for (int n = 0; n < 2; ++n) gt[bj][n] = *(const f32x4*)(gp + bj * HALF + n * 16);
#pragma unroll
        for (int ai = 0; ai < 2; ++ai) {
            f32x4 xv[4][2][2];
#pragma unroll
            for (int m = 0; m < 4; ++m)
#pragma unroll
                for (int bj = 0; bj < 2; ++bj)
#pragma unroll
                    for (int n = 0; n < 2; ++n) xv[m][bj][n] = xldv(X, (size_t)(row0 + ai * HALF + m * 16) * D + col0 + bj * HALF + n * 16);
#pragma unroll
            for (int m = 0; m < 4; ++m)
#pragma unroll
                for (int bj = 0; bj < 2; ++bj)
#pragma unroll
                    for (int n = 0; n < 2; ++n) xstv(X, (size_t)(row0 + ai * HALF + m * 16) * D + col0 + bj * HALF + n * 16, xv[m][bj][n] + gt[bj][n] * acc[ai][bj][m][n]);
            asm volatile("" ::: "memory");
        }
    } };
struct BatchSched { const char* A; const char* B; size_t strideA, strideB; int nM, nN, nb, K; int rev = 0;
    __device__ __forceinline__ bool next(int i, Unit& u) const {
        const int nwg = nM * nN * nb; const int L = i * gdim() + (rev ? gdim() - 1 - bidx() : bidx()); if (L >= nwg) return false;
        const int w = xcd_remap(L, nwg); const int per = nM * nN; u.g = w / per; const int r = w % per; u.pm = r / nN; u.pn = r % nN;
        u.A = A + u.g * strideA + (size_t)u.pm * BM * K * 2; u.B = B + u.g * strideB + (size_t)u.pn * BM * K * 2; return true; } };
}

template <class SrcF, class DRow>
__device__ __forceinline__ int cvt_tiles(const int wv_, char* lds, bf16_t* dst, int Kd, int Nd, int nbatch, size_t dstride, const SrcF& src, const DRow& drow, int* rot = nullptr) {
    bf16_t* T = (bf16_t*)lds;
    const int tid = tidx_w(wv_);
    const int tk = Kd / 128, tn = Nd / 64, per = tk * tn, total = per * nbatch;
    {
        int first = bidx() - (rot ? *rot % gdim() : 0); if (first < 0) first += gdim();
        if (rot) *rot += total;
        for (int t = first; t < total; t += gdim()) {
            const int bt = t / per, r = t % per, k0 = (r % tk) * 128, n0 = (r / tk) * 64;
            float4 v[4];
#pragma unroll
            for (int i = 0; i < 4; ++i) { const int k = k0 + i * 32 + (tid >> 4), n = n0 + (tid & 15) * 4; const float* sp = src(bt, k, n); v[i] = sp ? *(const float4*)sp : make_float4(0.f, 0.f, 0.f, 0.f); }
            __syncthreads();
#pragma unroll
            for (int i = 0; i < 4; ++i) { const int k = i * 32 + (tid >> 4), n = (tid & 15) * 4;
                T[(n + 0) * 136 + k] = f2bf(v[i].x); T[(n + 1) * 136 + k] = f2bf(v[i].y); T[(n + 2) * 136 + k] = f2bf(v[i].z); T[(n + 3) * 136 + k] = f2bf(v[i].w); }
            __syncthreads();
            { const int n = tid >> 3, kc = (tid & 7) * 16;
              const u32x4 a = *(const u32x4*)(T + n * 136 + kc), b = *(const u32x4*)(T + n * 136 + kc + 8);
              bf16_t* dp = dst + bt * dstride + (size_t)drow(n0 + n) * Kd + k0 + kc;
              *(u32x4*)dp = a; *(u32x4*)(dp + 8) = b; }
        }
    }
    return 0;
}
__device__ __forceinline__ int moe_cvt(const Params& p, int layer, char* lds, int budget) {
    constexpr int QG = 2, T13 = NE * 8 * 44, TOT = T13 + NE * 11 * 16;
    bf16_t* T = (bf16_t*)lds;
    int* qslot = (int*)(lds + 64 * 136 * 2);
    const int tid = tidx();
    const float* w1 = p.moe_w1 + (size_t)layer * NE * D * FF; const float* w3 = p.moe_w3 + (size_t)layer * NE * D * FF; const float* w2 = p.moe_w2 + (size_t)layer * NE * FF * D;
    bf16_t* W13 = (bf16_t*)(p.ws + OFF_W13T + (size_t)(layer & 1) * SZ_WMOE); bf16_t* W2 = (bf16_t*)(p.ws + OFF_W2T + (size_t)(layer & 1) * SZ_WMOE);
    unsigned* queue = (unsigned*)(p.ws + OFF_QUEUE) + layer * 32;
    const bool ahead = budget < 0;
    int done = 0, tnext = 0;
    __syncthreads();
    if (tid == 0) qslot[0] = QG * (int)__hip_atomic_fetch_add(queue, 1u, __ATOMIC_RELAXED, __HIP_MEMORY_SCOPE_AGENT);
    __syncthreads();
    int t0 = __builtin_amdgcn_readfirstlane(qslot[0]);
    while (t0 < TOT && (ahead || done < budget)) {
        const bool more = ahead || done + 1 < budget;
        if (more && tid == 0) tnext = QG * (int)__hip_atomic_fetch_add(queue, 1u, __ATOMIC_RELAXED, __HIP_MEMORY_SCOPE_AGENT);
#pragma unroll 1
        for (int sub = 0; sub < QG; ++sub) {
            const int t = t0 + sub;
            const float* sp; bf16_t* dp; int ss, ds;
            if (t < T13) { const int e = t / 352, r = t % 352, k0 = (r & 7) * 128, n0 = (r >> 3) * 64; const int c0 = (n0 >> 8) * 128 + (n0 & 127);
                sp = (((n0 >> 7) & 1) ? w3 : w1) + ((size_t)e * D + k0) * FF + c0; ss = FF; dp = W13 + ((size_t)e * 2816 + n0) * D + k0; ds = D; }
            else { const int u = t - T13, e = u / 176, r = u % 176, k0 = (r % 11) * 128, n0 = (r / 11) * 64;
                sp = w2 + ((size_t)e * FF + k0) * D + n0; ss = D; dp = W2 + ((size_t)e * D + n0) * FF + k0; ds = FF; }
            float4 v[4];
#pragma unroll
            for (int i = 0; i < 4; ++i) v[i] = *(const float4*)(sp + (size_t)(i * 32 + (tid >> 4)) * ss + (tid & 15) * 4);
            __syncthreads();
#pragma unroll
            for (int i = 0; i < 4; ++i) { const int k = i * 32 + (tid >> 4), n = (tid & 15) * 4;
                T[(n + 0) * 136 + k] = f2bf(v[i].x); T[(n + 1) * 136 + k] = f2bf(v[i].y); T[(n + 2) * 136 + k] = f2bf(v[i].z); T[(n + 3) * 136 + k] = f2bf(v[i].w); }
            if (sub == QG - 1 && tid == 0) qslot[0] = more ? tnext : TOT;
            __syncthreads();
            { const int n = tid >> 3, kc = (tid & 7) * 16;
              const u32x4 a = *(const u32x4*)(T + n * 136 + kc), b = *(const u32x4*)(T + n * 136 + kc + 8);
              bf16_t* o = dp + (size_t)n * ds + kc;
              *(u32x4*)o = a; *(u32x4*)(o + 8) = b; }
        }
        ++done; t0 = __builtin_amdgcn_readfirstlane(qslot[0]);
    }
    __syncthreads();
    return done;
}
__device__ __forceinline__ void bg_cvt(const Params& p, int layer, char* lds, int budget) {
#pragma unroll 1
    for (int l = layer; l < 4 && l <= layer + 1 && budget > 0; ++l) budget -= moe_cvt(p, l, lds, budget);
}
__device__ __forceinline__ bool idle_tail(int nunits) { const int r = nunits % gdim(); return r != 0 && bidx() >= r; }
__device__ void ph_init(const Params& p, char* lds) {
    const int tid = tidx(), gtid = bidx() * NTHR + tid, gsz = gdim() * NTHR;
    xt_t* Xs = (xt_t*)(p.ws + OFF_X);
    const float4* x4 = (const float4*)p.x; const float4* c4 = (const float4*)p.ctx;
    { constexpr int NQ = NROW * 256 / 4;
      auto srcv = [&](int k) { return k < NLAT * 256 ? x4[k] : c4[k - NLAT * 256]; };
      for (int i = gtid; i < NQ; i += gsz) { const float4 t0 = srcv(i), t1 = srcv(i + NQ), t2 = srcv(i + 2 * NQ), t3 = srcv(i + 3 * NQ); xst(Xs, (size_t)4 * i, t0); xst(Xs, (size_t)4 * (i + NQ), t1); xst(Xs, (size_t)4 * (i + 2 * NQ), t2); xst(Xs, (size_t)4 * (i + 3 * NQ), t3); } }
    float* rc = (float*)(p.ws + OFF_ROPE_C); float* rs = (float*)(p.ws + OFF_ROPE_S);
    for (int i = gtid; i < TL * 32; i += gsz) {
        const int t = i >> 5, f = i & 31; const float pos = (float)((f < 16) ? (t >> 6) : (t & 63));
        const float inv = powf(10000.f, -(float)(f & 15) / 16.f); const float ang = pos * inv; rc[2 * i] = cosf(ang); rc[2 * i + 1] = sinf(ang);
    }
    float* sc = (float*)lds;
    float* red = sc + 5 * 1024;
    for (int i = tid; i < 5 * 1024; i += NTHR) { const float v = i < 4096 ? p.c[i] : p.c_ctx[i - 4096]; sc[i] = v / (1.f + expf(-v)); }
    __syncthreads();
    float* MOD = (float*)(p.ws + OFF_MOD);
    for (int item = bidx(); item < 4 * 96; item += gdim()) {
        const int l = item / 96, cg = item % 96, col = tid & 63, n = cg * 64 + col, kg = tid >> 6;
        const float* w = p.mod_w + ((size_t)l * 1024 + kg * 128) * 6144 + n;
        float a0 = 0, a1 = 0, a2 = 0, a3 = 0, a4 = 0;
#pragma unroll 16
        for (int k = 0; k < 128; ++k) { const float wv = w[(size_t)k * 6144]; const int kk = kg * 128 + k;
            a0 += sc[kk] * wv; a1 += sc[1024 + kk] * wv; a2 += sc[2048 + kk] * wv; a3 += sc[3072 + kk] * wv; a4 += sc[4096 + kk] * wv; }
        float* rr = red + (kg * 64 + col) * 5; rr[0] = a0; rr[1] = a1; rr[2] = a2; rr[3] = a3; rr[4] = a4;
        __syncthreads();
        if (tid < 320) { const int c2 = tid & 63, s = tid >> 6; float sum = 0;
            for (int q = 0; q < 8; ++q) sum += red[(q * 64 + c2) * 5 + s];
            MOD[((size_t)l * 5 + s) * 6144 + cg * 64 + c2] = sum + p.mod_b[l * 6144 + cg * 64 + c2]; }
        __syncthreads();
    }
}


__device__ void ph_small_cvt(const Params& p, char* lds) {
    int rot = 128;
    for (int j = 0; j < 2; ++j) {
        char* wm = p.ws + OFF_WMLA + j * SZ_WMLA; char* wr = p.ws + OFF_WRW + j * SZ_WRW;
        const float* w_in = p.mla_w_in + (size_t)j * D * 448; const float* w_uq = p.mla_w_uq + (size_t)j * 256 * 1536; const float* w_ukv = p.mla_w_ukv + (size_t)j * 128 * 2048; const float* w_o = p.mla_w_o + (size_t)j * D * D;
        cvt_tiles(p.wv, lds, (bf16_t*)(wm + WM_IN), 1024, 512, 1, 0, [=](int, int k, int n) -> const float* { return n < 448 ? w_in + (size_t)k * 448 + n : nullptr; },
                  [=](int n) { if (n < 384 || n >= 448) return n; const int jj = n - 384; return 384 + (jj < 32 ? 2 * jj : 2 * (jj - 32) + 1); }, &rot);
        cvt_tiles(p.wv, lds, (bf16_t*)(wm + WM_UQ), 256, 1536, 1, 0, [=](int, int k, int n) -> const float* { return w_uq + (size_t)k * 1536 + n; },
                  [=](int n) { const int h = n / 192, d = n % 192; if (d < 128) return n; const int jj = d - 128; return h * 192 + 128 + (jj < 32 ? 2 * jj : 2 * (jj - 32) + 1); }, &rot);
        cvt_tiles(p.wv, lds, (bf16_t*)(wm + WM_UKV), 128, 2048, 1, 0, [=](int, int k, int n) -> const float* { return w_ukv + (size_t)k * 2048 + n; }, [=](int n) { return n; }, &rot);
        cvt_tiles(p.wv, lds, (bf16_t*)(wm + WM_O), 1024, 1024, 1, 0, [=](int, int k, int n) -> const float* { return w_o + (size_t)k * D + n; }, [=](int n) { return n; }, &rot);
        const float* w_rkv = p.rw_w_rkv + (size_t)j * 3 * D * D; const float* w1 = p.rw_w1 + (size_t)j * 2 * D * 64; const float* a1 = p.rw_a1 + (size_t)j * 2 * D * 64;
        const float* g1 = p.rw_g1 + (size_t)j * D * 128; const float* v1 = p.rw_v1; const float* rwo = p.rw_w_o + (size_t)j * D * D;
        cvt_tiles(p.wv, lds, (bf16_t*)(wr + WR_RKV), 1024, 1024, 3, (size_t)D * D, [=](int m, int k, int n) -> const float* { return w_rkv + ((size_t)m * D + k) * D + n; }, [=](int n) { return n; }, &rot);
        cvt_tiles(p.wv, lds, (bf16_t*)(wr + WR_L), 1024, 256, 1, 0, [=](int, int k, int n) -> const float* { return n < 128 ? w1 + ((size_t)(n >> 6) * D + k) * 64 + (n & 63) : nullptr; }, [=](int n) { return n; }, &rot);
        cvt_tiles(p.wv, lds, (bf16_t*)(wr + WR_L) + 256 * 1024, 1024, 256, 1, 0, [=](int, int k, int n) -> const float* { return n < 128 ? a1 + ((size_t)(n >> 6) * D + k) * 64 + (n & 63) : nullptr; }, [=](int n) { return n; }, &rot);
        cvt_tiles(p.wv, lds, (bf16_t*)(wr + WR_L) + 2 * 256 * 1024, 1024, 256, 1, 0, [=](int, int k, int n) -> const float* { return n < 128 ? g1 + (size_t)k * 128 + n : nullptr; }, [=](int n) { return n; }, &rot);
        cvt_tiles(p.wv, lds, (bf16_t*)(wr + WR_L) + 3 * 256 * 1024, 1024, 256, 1, 0, [=](int, int k, int n) -> const float* { return n < 32 ? v1 + (size_t)k * 32 + n : nullptr; }, [=](int n) { return n; }, &rot);
        cvt_tiles(p.wv, lds, (bf16_t*)(wr + WR_O), 1024, 1024, 1, 0, [=](int, int k, int n) -> const float* { return rwo + (size_t)k * D + n; }, [=](int n) { return n; }, &rot);
        const float* w2 = p.rw_w2 + (size_t)j * 2 * 64 * D; const float* a2 = p.rw_a2 + (size_t)j * 2 * 64 * D; const float* g2 = p.rw_g2 + (size_t)j * 128 * D; const float* v2 = p.rw_v2;
        cvt_tiles(p.wv, lds, (bf16_t*)(wr + WR_B2), 128, 2048, 2, (size_t)2048 * 128, [=](int bt, int k, int n) -> const float* { const int zz = n >> 10, c = n & 1023, l = k - zz * 64;
            if (l < 0 || l >= 64) return nullptr; return (bt == 0 ? w2 : a2) + ((size_t)zz * 64 + l) * D + c; }, [=](int n) { return n; }, &rot);
        cvt_tiles(p.wv, lds, (bf16_t*)(wr + WR_B3), 128, 1024, 2, (size_t)1024 * 128, [=](int bt, int k, int n) -> const float* {
            if (bt == 0) return g2 + (size_t)k * D + n; return k < 32 ? v2 + (size_t)k * D + n : nullptr; }, [=](int n) { return n; }, &rot);
    }
}

template <bool OUTF32>
__device__ void ph_norm_mod(const Params& p, int layer, const float* g, int part_sh, int part_sc, void* outp) {
    const int wid = tidx() >> 6, lane = tidx() & 63;
    const xt_t* X = (const xt_t*)(p.ws + OFF_X);
    const int w_ = bidx() * 8 + wid, nw_ = gdim() * 8;
    int row = (int)((long long)w_ * NROW / nw_); const int rend = (int)((long long)(w_ + 1) * NROW / nw_);
    float4 nv[4], gm[4], bb[4]; int scur = -1;
    if (row < rend) {
#pragma unroll
        for (int i = 0; i < 4; ++i) nv[i] = xld(X, (size_t)row * D + (lane + i * 64) * 4); }
    for (; row < rend; ++row) {
        const int s = row_stream(row);
        if (s != scur) { scur = s; const float* sh = modp(p, layer, s, part_sh); const float* sc = modp(p, layer, s, part_sc);
#pragma unroll
            for (int i = 0; i < 4; ++i) { const int d = (lane + i * 64) * 4; const float4 gg = *(const float4*)(g + d), a = *(const float4*)(sc + d); bb[i] = *(const float4*)(sh + d);
                gm[i] = make_float4(gg.x * (1.f + a.x), gg.y * (1.f + a.y), gg.z * (1.f + a.z), gg.w * (1.f + a.w)); } }
        float4 v[4]; float ss = 0;
#pragma unroll
        for (int i = 0; i < 4; ++i) { v[i] = nv[i]; ss += v[i].x * v[i].x + v[i].y * v[i].y + v[i].z * v[i].z + v[i].w * v[i].w; }
        { const int nrow = row + 1;
          if (nrow < rend) {
#pragma unroll
              for (int i = 0; i < 4; ++i) nv[i] = xld(X, (size_t)nrow * D + (lane + i * 64) * 4); } }
        ss = wave_sum(ss); const float rs = rsqrtf(ss * (1.f / D) + RMS_EPS);
#pragma unroll
        for (int i = 0; i < 4; ++i) {
            const int d = (lane + i * 64) * 4;
            float4 o; o.x = v[i].x * rs * gm[i].x + bb[i].x; o.y = v[i].y * rs * gm[i].y + bb[i].y; o.z = v[i].z * rs * gm[i].z + bb[i].z; o.w = v[i].w * rs * gm[i].w + bb[i].w;
            if (OUTF32) *(float4*)((float*)outp + (size_t)row * D + d) = o;
            else { uint2 w; w.x = pk2(o.x, o.y); w.y = pk2(o.z, o.w); *(uint2*)((bf16_t*)outp + (size_t)row * D + d) = w; }
        }
    }
}

__device__ void ph_mla_mid(const Params& p, int j) {
    const int wid = tidx() >> 6, lane = tidx() & 63;
    const float* Z = (const float*)(p.ws + OFF_Z);
    bf16_t* CQN = (bf16_t*)(p.ws + OFF_CQN); bf16_t* CKVN = (bf16_t*)(p.ws + OFF_CKVN); bf16_t* K = (bf16_t*)(p.ws + OFF_K);
    const float* gq = p.mla_g_q + j * 256; const float* gkv = p.mla_g_kv + j * 128;
    const float* rc = (const float*)(p.ws + OFF_ROPE_C); const float* rs = (const float*)(p.ws + OFF_ROPE_S);
    for (int row = bidx() * 8 + wid; row < NROW; row += gdim() * 8) {
        const float* z = Z + (size_t)row * 512;
        const float4 q = *(const float4*)(z + lane * 4);
        const float2 kv = *(const float2*)(z + 256 + lane * 2);
        const float kr = z[384 + lane];
        float sq = wave_sum(q.x * q.x + q.y * q.y + q.z * q.z + q.w * q.w); const float rq = rsqrtf(sq * (1.f / 256.f) + RMS_EPS);
        float sk = wave_sum(kv.x * kv.x + kv.y * kv.y); const float rk = rsqrtf(sk * (1.f / 128.f) + RMS_EPS);
        const float4 g4 = *(const float4*)(gq + lane * 4); const float2 g2 = *(const float2*)(gkv + lane * 2);
        uint2 w; w.x = pk2(q.x * rq * g4.x, q.y * rq * g4.y); w.y = pk2(q.z * rq * g4.z, q.w * rq * g4.w);
        *(uint2*)(CQN + (size_t)row * 256 + lane * 4) = w;
        *(unsigned*)(CKVN + (size_t)row * 128 + lane * 2) = pk2(kv.x * rk * g2.x, kv.y * rk * g2.y);
        float o = kr;
        const float other = __builtin_bit_cast(float, __builtin_amdgcn_update_dpp(0, __builtin_bit_cast(int, kr), 0xB1, 0xF, 0xF, true));
        const bool lat = row < NLAT;
        if (lat) { const int t = row & (TL - 1), i = lane >> 1; const float2 cs = *(const float2*)(rc + (t * 32 + i) * 2); const float c = cs.x, s = cs.y;
            o = (lane & 1) ? (other * s + kr * c) : (kr * c - other * s); }
        const int b = lat ? (row >> 12) : ((row - NLAT) >> 8); const int tk = lat ? 256 + (row & (TL - 1)) : ((row - NLAT) & 255);
        const bf16_t ob = f2bf(o);
#pragma unroll
        for (int h = 0; h < 8; ++h) K[((size_t)(b * 8 + h) * TK + tk) * 192 + 128 + lane] = ob;
    }
}

__device__ void ph_qkv_post(const Params& p) {
    const int wid = tidx() >> 6, lane = tidx() & 63;
    const float* QRAW = (const float*)(p.ws + OFF_QRAW); const float* KVRAW = (const float*)(p.ws + OFF_KVRAW); const float* KR = (const float*)(p.ws + OFF_KR);
    bf16_t* Q = (bf16_t*)(p.ws + OFF_Q); bf16_t* K = (bf16_t*)(p.ws + OFF_K); bf16_t* V = (bf16_t*)(p.ws + OFF_V);
    const float* rc = (const float*)(p.ws + OFF_ROPE_C); const float* rs = (const float*)(p.ws + OFF_ROPE_S);
    for (int it = bidx() * 8 + wid; it < NROW * 8; it += gdim() * 8) {
        const int row = it >> 3, h = it & 7;
        const bool lat = row < NLAT; const int b = lat ? (row >> 12) : ((row - NLAT) >> 8); const int tk = lat ? 256 + (row & (TL - 1)) : ((row - NLAT) & 255);
        const size_t orow = (size_t)(b * 8 + h) * TK + tk;
        const float* q = QRAW + (size_t)row * 1536 + h * 192;
        const float q0 = q[lane], q1 = q[64 + lane]; float q2 = q[128 + lane];
        const auto sw = __builtin_amdgcn_permlane32_swap(__float_as_uint(q2), __float_as_uint(q2), false, false);
        if (lat) { const int t = row & (TL - 1), i = lane & 31; const float c = rc[t * 32 + i], s = rs[t * 32 + i];
            const float x1 = __uint_as_float(sw[0]), x2 = __uint_as_float(sw[1]); q2 = lane < 32 ? (x1 * c - x2 * s) : (x1 * s + x2 * c); }
        bf16_t* qo = Q + orow * 192; qo[lane] = f2bf(q0); qo[64 + lane] = f2bf(q1); qo[128 + lane] = f2bf(q2);
        const float* kv = KVRAW + (size_t)row * 2048 + h * 256;
        bf16_t* ko = K + orow * 192; ko[lane] = f2bf(kv[lane]); ko[64 + lane] = f2bf(kv[64 + lane]); ko[128 + lane] = f2bf(KR[(size_t)row * 64 + lane]);
        bf16_t* vo = V + orow * 128; vo[lane] = f2bf(kv[128 + lane]); vo[64 + lane] = f2bf(kv[192 + lane]);
    }
}

__device__ void ph_attn_naive(const Params& p, char* lds) {
    const int tid = tidx(), qi = tid >> 2, part = tid & 3;
    const bf16_t* Q = (const bf16_t*)(p.ws + OFF_Q); const bf16_t* K = (const bf16_t*)(p.ws + OFF_K); const bf16_t* V = (const bf16_t*)(p.ws + OFF_V);
    bf16_t* O = (bf16_t*)(p.ws + OFF_O);
    bf16_t* Ks = (bf16_t*)lds;
    bf16_t* Vs = Ks + 32 * 192;
    const int nitems = 32 * 34;
    for (int it = bidx(); it < nitems; it += gdim()) {
        const int bh = it / 34, qb = it % 34; const int b = bh >> 3, h = bh & 7;
        const int nkeys = qb < 2 ? TC : TK;
        const int tq = qb * 128 + qi;
        const bf16_t* qp = Q + ((size_t)bh * TK + tq) * 192 + part * 48;
        float q[48];
#pragma unroll
        for (int i = 0; i < 48; ++i) q[i] = bf2f(qp[i]) * ATT_SCALE;
        float o[32];
#pragma unroll
        for (int i = 0; i < 32; ++i) o[i] = 0.f;
        float m = -1e30f, l = 0.f;
        for (int k0 = 0; k0 < nkeys; k0 += 32) {
            __syncthreads();
            {
                const bf16_t* kg = K + ((size_t)bh * TK + k0) * 192; const bf16_t* vg = V + ((size_t)bh * TK + k0) * 128;
                for (int c = tid; c < 768; c += NTHR) *(u32x4*)(Ks + c * 8) = *(const u32x4*)(kg + c * 8);
                *(u32x4*)(Vs + tid * 8) = *(const u32x4*)(vg + tid * 8);
            }
            __syncthreads();
#pragma unroll 1
            for (int kg = 0; kg < 32; kg += 8) {
                float s[8]; float tmax = -1e30f;
#pragma unroll
                for (int kk = 0; kk < 8; ++kk) {
                    const bf16_t* kr = Ks + (kg + kk) * 192 + part * 48; float acc = 0.f;
#pragma unroll
                    for (int i = 0; i < 48; ++i) acc += q[i] * bf2f(kr[i]);
                    acc += __shfl_xor(acc, 1); acc += __shfl_xor(acc, 2);
                    s[kk] = acc; tmax = fmaxf(tmax, acc);
                    asm volatile("" ::: "memory");
                }
                const float mn = fmaxf(m, tmax), alpha = expf(m - mn); m = mn; l *= alpha;
#pragma unroll
                for (int i = 0; i < 32; ++i) o[i] *= alpha;
#pragma unroll
                for (int kk = 0; kk < 8; ++kk) {
                    const float pw = expf(s[kk] - mn); l += pw;
                    const bf16_t* vr = Vs + (kg + kk) * 128 + part * 32;
#pragma unroll
                    for (int i = 0; i < 32; ++i) o[i] += pw * bf2f(vr[i]);
                    asm volatile("" ::: "memory");
                }
            }
        }
        const float rl = 1.f / l;
        const int row = qb < 2 ? (NLAT + b * TC + tq) : (b * TL + tq - TC);
        bf16_t* op = O + (size_t)row * D + h * 128 + part * 32;
#pragma unroll
        for (int i = 0; i < 32; ++i) op[i] = f2bf(o[i] * rl);
    }
}


namespace fa {
using s16x4  = __attribute__((ext_vector_type(4))) short;
using f32x16 = __attribute__((ext_vector_type(16))) float;
constexpr int DQK = 192, DV = 128, KVBLK = 64;
constexpr float THR = 8.f;
constexpr int SHM_V = KVBLK * DV * 2, SHM_K = KVBLK * DQK * 2;
constexpr int SHM_ATTN = 2 * SHM_V + 2 * SHM_K + 8 * 64 * 4;
#define KSWZ(row, colB) ((row) * 384 + ((colB) ^ ((((row) >> 1) & 7) << 4)))
#define SBAR() __builtin_amdgcn_sched_barrier(0)
__device__ __forceinline__ int crow(int r, int hi) { return (r & 3) + 8 * (r >> 2) + 4 * hi; }
__device__ __forceinline__ unsigned cvtpk(float lo, float hi) { unsigned r; asm volatile("v_cvt_pk_bf16_f32 %0, %1, %2" : "=v"(r) : "v"(lo), "v"(hi)); return r; }
__device__ __forceinline__ void partialSM(f32x16& p0, f32x16& p1, float& m_reg, float& mn, float& alpha) {
  constexpr float C = ATT_SCALE * 1.4426950408889634f;
  float pmax = p0[0];
#pragma unroll
  for (int r = 1; r < 16; ++r) pmax = fmaxf(pmax, p0[r]);
#pragma unroll
  for (int r = 0; r < 16; ++r) pmax = fmaxf(pmax, p1[r]);
  { auto rr = __builtin_amdgcn_permlane32_swap(__float_as_uint(pmax), __float_as_uint(pmax), false, false);
    pmax = fmaxf(__uint_as_float(rr[0]), __uint_as_float(rr[1])); }
  if (__builtin_expect(__all(pmax - m_reg <= THR / ATT_SCALE), 1)) { mn = m_reg; alpha = 1.f; }
  else { mn = fmaxf(m_reg, pmax); alpha = __builtin_amdgcn_exp2f((m_reg - mn) * C); m_reg = mn; }
  float mnC = -mn * C;
#pragma unroll
  for (int r = 0; r < 16; ++r) p0[r] = fmaf(p0[r], C, mnC);
#pragma unroll
  for (int r = 0; r < 16; ++r) p1[r] = fmaf(p1[r], C, mnC);
#pragma unroll
  for (int r = 0; r < 16; ++r) p0[r] = __builtin_amdgcn_exp2f(p0[r]);
}
__device__ __forceinline__ void finishSM(f32x16& p0, f32x16& p1, float alpha, float& l_reg, bf16x8& pa0, bf16x8& pa1, bf16x8& pa2, bf16x8& pa3) {
#pragma unroll
  for (int r = 0; r < 16; ++r) p1[r] = __builtin_amdgcn_exp2f(p1[r]);
  float ps = 0;
#pragma unroll
  for (int r = 0; r < 16; ++r) ps += p0[r];
#pragma unroll
  for (int r = 0; r < 16; ++r) ps += p1[r];
  { auto rr = __builtin_amdgcn_permlane32_swap(__float_as_uint(ps), __float_as_uint(ps), false, false);
    ps = __uint_as_float(rr[0]) + __uint_as_float(rr[1]); }
  l_reg = l_reg * alpha + ps;
#define PK4(P, BASE, OUT) do { unsigned a0 = cvtpk(P[BASE + 0], P[BASE + 1]), a1 = cvtpk(P[BASE + 2], P[BASE + 3]);   \
    unsigned b0 = cvtpk(P[BASE + 4], P[BASE + 5]), b1 = cvtpk(P[BASE + 6], P[BASE + 7]);                              \
    auto r0 = __builtin_amdgcn_permlane32_swap(a0, b0, false, false); auto r1 = __builtin_amdgcn_permlane32_swap(a1, b1, false, false); \
    u32x4 w = {r0[0], r1[0], r0[1], r1[1]}; OUT = *reinterpret_cast<bf16x8*>(&w); } while (0)
  PK4(p0, 0, pa0); PK4(p0, 8, pa1); PK4(p1, 0, pa2); PK4(p1, 8, pa3);
#undef PK4
}
__device__ __forceinline__ void qkt(f32x16& p0, f32x16& p1, const char* Ks, const bf16x8* qr, int r32, int hi) {
  p0 = f32x16{}; p1 = f32x16{};
  const int swz = ((r32 >> 1) & 7) << 4;
  const char* b4[4];
#pragma unroll
  for (int dr = 0; dr < 4; ++dr) b4[dr] = Ks + r32 * 384 + ((dr * 32 + hi * 16) ^ swz);
#pragma unroll
  for (int d0 = 0; d0 < 12; ++d0) {
    bf16x8 b0 = *reinterpret_cast<const bf16x8*>(b4[d0 & 3] + (d0 >> 2) * 128);
    bf16x8 b1 = *reinterpret_cast<const bf16x8*>(b4[d0 & 3] + (d0 >> 2) * 128 + 32 * 384);
    p0 = __builtin_amdgcn_mfma_f32_32x32x16_bf16(b0, qr[d0], p0, 0, 0, 0);
    p1 = __builtin_amdgcn_mfma_f32_32x32x16_bf16(b1, qr[d0], p1, 0, 0, 0); }
}
__device__ __forceinline__ int v_st(int k, int c) { const int kk = (k & ~0xC) | ((k & 4) << 1) | ((k & 8) >> 1); return ((kk >> 3) * 4 + (c >> 5)) * 512 + ((kk & 7) * 32 + (c & 31)) * 2; }
__device__ __forceinline__ int v_rd_base(int lane) { return ((lane & 3) << 3) | (((lane >> 2) & 3) << 6) | (((lane >> 4) & 1) << 5) | (((lane >> 5) & 1) << 8); }
constexpr int v_rd_off(int d0, int ks, int half) { return d0 * 512 + ks * 4096 + half * 2048; }
template <int OFF> __device__ __forceinline__ s16x4 tr_read(int vb) {
  s16x4 r; asm volatile("ds_read_b64_tr_b16 %0, %1 offset:%2" : "=&v"(r) : "v"(vb), "i"(OFF) : "memory"); return r;
}
template <int D0> __device__ __forceinline__ void pv_one(f32x16& od, int vb, bf16x8 pa0, bf16x8 pa1, bf16x8 pa2, bf16x8 pa3) {
  const s16x4 l0 = tr_read<v_rd_off(D0, 0, 0)>(vb), h0 = tr_read<v_rd_off(D0, 0, 1)>(vb), l1 = tr_read<v_rd_off(D0, 1, 0)>(vb), h1 = tr_read<v_rd_off(D0, 1, 1)>(vb);
  const s16x4 l2 = tr_read<v_rd_off(D0, 2, 0)>(vb), h2 = tr_read<v_rd_off(D0, 2, 1)>(vb), l3 = tr_read<v_rd_off(D0, 3, 0)>(vb), h3 = tr_read<v_rd_off(D0, 3, 1)>(vb);
  asm volatile("s_waitcnt lgkmcnt(0)" ::: "memory"); SBAR();
#define PK(L, H) (bf16x8){L[0], L[1], L[2], L[3], H[0], H[1], H[2], H[3]}
  od = __builtin_amdgcn_mfma_f32_32x32x16_bf16(pa0, PK(l0, h0), od, 0, 0, 0);
  od = __builtin_amdgcn_mfma_f32_32x32x16_bf16(pa1, PK(l1, h1), od, 0, 0, 0);
  od = __builtin_amdgcn_mfma_f32_32x32x16_bf16(pa2, PK(l2, h2), od, 0, 0, 0);
  od = __builtin_amdgcn_mfma_f32_32x32x16_bf16(pa3, PK(l3, h3), od, 0, 0, 0);
#undef PK
}
__device__ __forceinline__ void pv_d0(f32x16* o, int vb, bf16x8 pa0, bf16x8 pa1, bf16x8 pa2, bf16x8 pa3) {
  pv_one<0>(o[0], vb, pa0, pa1, pa2, pa3); pv_one<1>(o[1], vb, pa0, pa1, pa2, pa3); pv_one<2>(o[2], vb, pa0, pa1, pa2, pa3); pv_one<3>(o[3], vb, pa0, pa1, pa2, pa3);
}
__device__ __forceinline__ void attn_body(const int wv_, const bf16_t* __restrict__ Qb, const bf16_t* __restrict__ Kh, const bf16_t* __restrict__ Vh, bf16_t* __restrict__ Ob, int ldo, int seq, char* lds, const float* __restrict__ ropecs  ) {
  const int tid = tidx_w(wv_), wid = tid >> 6, lane = tid & 63, r32 = lane & 31, hi = lane >> 5;
  char* V_lds = lds; char* K_lds = lds + 2 * SHM_V;
  float* ws = (float*)(lds + 2 * SHM_V + 2 * SHM_K) + wid * 64; float* li_l = ws; float* al_l = ws + 32;
  float m_reg = -1e30f, l_reg = 0; f32x16 o[4] = {}; bf16x8 qr[12];
  const bf16_t* Qw = Qb + (long)(wid * 32 + r32) * DQK + hi * 8;
#pragma unroll
  for (int d0 = 0; d0 < 12; ++d0) qr[d0] = *reinterpret_cast<const bf16x8*>(Qw + d0 * 16);
  if (ropecs) {
    const float* cs = ropecs + (size_t)(wid * 32 + r32) * 64;
#pragma unroll
    for (int d0 = 8; d0 < 12; ++d0) { const int i0 = (d0 - 8) * 8 + hi * 4; const f32x4 c0 = *(const f32x4*)(cs + i0 * 2), c1 = *(const f32x4*)(cs + i0 * 2 + 4);
      u32x4 w = *reinterpret_cast<u32x4*>(&qr[d0]); const float cc[4] = {c0[0], c0[2], c1[0], c1[2]}, ss[4] = {c0[1], c0[3], c1[1], c1[3]};
#pragma unroll
      for (int m = 0; m < 4; ++m) { const float x1 = __uint_as_float(w[m] << 16), x2 = __uint_as_float(w[m] & 0xffff0000u); w[m] = cvtpk(x1 * cc[m] - x2 * ss[m], x1 * ss[m] + x2 * cc[m]); }
      qr[d0] = *reinterpret_cast<bf16x8*>(&w); }
  }
  const int sr = tid >> 4, sc = (tid & 15) * 8, vst0 = v_st(sr, sc), vst1 = v_st(32 + sr, sc);
  int kst[3];
#pragma unroll
  for (int i = 0; i < 3; ++i) { const int c = tid + 512 * i, row = c / 24, cc = c % 24; kst[i] = KSWZ(row, cc * 16); }
  const int vb0 = (int)(uintptr_t)V_lds + v_rd_base(lane);
  struct { bf16x8 vs0, vs1, ks0, ks1, ks2; } sr_[1];
#define SLOAD(i, k0) do { const bf16_t* vt = Vh + (long)(k0) * DV; const bf16_t* kt = Kh + (long)(k0) * DQK; \
    sr_[i].vs0 = *reinterpret_cast<const bf16x8*>(vt + (sr) * DV + sc); sr_[i].vs1 = *reinterpret_cast<const bf16x8*>(vt + (32 + sr) * DV + sc); \
    sr_[i].ks0 = *reinterpret_cast<const bf16x8*>(kt + tid * 8); sr_[i].ks1 = *reinterpret_cast<const bf16x8*>(kt + (tid + 512) * 8); sr_[i].ks2 = *reinterpret_cast<const bf16x8*>(kt + (tid + 1024) * 8); } while (0)
#define SWRITE(b, i) do { *(bf16x8*)(V_lds + (b) * SHM_V + vst0) = sr_[i].vs0; *(bf16x8*)(V_lds + (b) * SHM_V + vst1) = sr_[i].vs1; \
    *(bf16x8*)(K_lds + (b) * SHM_K + kst[0]) = sr_[i].ks0; *(bf16x8*)(K_lds + (b) * SHM_K + kst[1]) = sr_[i].ks1; *(bf16x8*)(K_lds + (b) * SHM_K + kst[2]) = sr_[i].ks2; } while (0)
#define SWAIT() asm volatile("s_waitcnt vmcnt(5)" ::: "memory")
#define RESC(a) do { if (__any((a) < 1.f)) { if (hi == 0) al_l[r32] = (a); asm volatile("s_waitcnt lgkmcnt(0)" ::: "memory"); \
    _Pragma("unroll") for (int d = 0; d < 4; ++d) _Pragma("unroll") for (int r = 0; r < 16; ++r) o[d][r] *= al_l[crow(r, hi)]; } } while (0)
  f32x16 pA0, pA1; float mnA, alA; bf16x8 pa0, pa1, pa2, pa3; const int NT = seq / KVBLK;
  SLOAD(0, 0); SWRITE(0, 0);
  SLOAD(0, KVBLK);
  __syncthreads();
  for (int j = 0; j < NT; j += 2) {
    SBAR(); qkt(pA0, pA1, K_lds, qr, r32, hi);
    partialSM(pA0, pA1, m_reg, mnA, alA); RESC(alA);
    finishSM(pA0, pA1, alA, l_reg, pa0, pa1, pa2, pa3); SBAR();
    SWRITE(1, 0);
    if (j + 2 < NT) SLOAD(0, (j + 2) * KVBLK);
    SBAR();
    pv_d0(o, vb0, pa0, pa1, pa2, pa3);
    __syncthreads();
    SBAR(); qkt(pA0, pA1, K_lds + SHM_K, qr, r32, hi);
    partialSM(pA0, pA1, m_reg, mnA, alA); RESC(alA);
    finishSM(pA0, pA1, alA, l_reg, pa0, pa1, pa2, pa3); SBAR();
    if (j + 2 < NT) { SWRITE(0, 0); if (j + 3 < NT) SLOAD(0, (j + 3) * KVBLK); }
    SBAR();
    pv_d0(o, vb0 + SHM_V, pa0, pa1, pa2, pa3);
    __syncthreads();
  }
  if (hi == 0) li_l[r32] = l_reg; asm volatile("s_waitcnt lgkmcnt(0)" ::: "memory");
  float rli[16];
#pragma unroll
  for (int r = 0; r < 16; ++r) rli[r] = __builtin_amdgcn_rcpf(li_l[crow(r, hi)]);
  bf16_t* Ow = Ob + (long)(wid * 32) * ldo;
#pragma unroll
  for (int r = 0; r < 16; ++r) { int orow = crow(r, hi);
#pragma unroll
    for (int d0 = 0; d0 < 4; ++d0) Ow[(long)orow * ldo + d0 * 32 + r32] = f2bf(o[d0][r] * rli[r]); }
  __syncthreads();
#undef SLOAD
#undef SWRITE
#undef SWAIT
#undef RESC
}
#undef KSWZ
}

__device__ void ph_attn(const Params& p, char* lds) {
    const bf16_t* Q = (const bf16_t*)(p.ws + OFF_Q); const bf16_t* K = (const bf16_t*)(p.ws + OFF_K); const bf16_t* V = (const bf16_t*)(p.ws + OFF_V);
    bf16_t* O = (bf16_t*)(p.ws + OFF_O);
    const int G = gdim();
    for (int i = 0;; ++i) {
        const int L = i * G + bidx(); if (L >= 544) break;
        int bh, qb;
        if (L < 512) { const int w = g8::xcd_remap(L, 512); bh = w >> 4; qb = 1 + (w & 15); } else { bh = L - 512; qb = 0; }
        const int b = bh >> 3, h = bh & 7;
        const int seq = qb == 0 ? TC : TK;
        const int row0 = qb == 0 ? NLAT + b * TC : b * TL + (qb - 1) * 256;
        fa::attn_body(p.wv, Q + ((size_t)bh * TK + qb * 256) * 192, K + (size_t)bh * TK * 192, V + (size_t)bh * TK * 128, O + (size_t)row0 * D + h * 128, D, seq, lds,
                      qb == 0 ? nullptr : (const float*)(p.ws + OFF_ROPE_C) + (size_t)(qb - 1) * 256 * 64);
    }
}

__device__ void ph_norm2_router(const Params& p, int layer, char* lds, int nrows) {
    const int tid = tidx(), wid = tid >> 6, lane = tid & 63;
    float* rt = (float*)lds;
    const float* rg = p.moe_router + (size_t)layer * D * NE;
    for (int i = tid; i < D * NE / 4; i += NTHR) { const int d = i >> 2, eq = i & 3; ((float4*)rt)[(((d >> 8) * 4 + (d & 3)) * 4 + eq) * 64 + ((d & 255) >> 2)] = ((const float4*)rg)[i]; }
    __syncthreads();
    const xt_t* X = (const xt_t*)(p.ws + OFF_X); bf16_t* BN = (bf16_t*)(p.ws + OFF_H); float* AFF = (float*)(p.ws + OFF_AFF);
    const float* g = p.norm2_g + layer * D;
    const int w_ = bidx() * 8 + wid, nw_ = gdim() * 8;
    int row = (int)((long long)w_ * nrows / nw_); const int rend = (int)((long long)(w_ + 1) * nrows / nw_);
    float4 nv[4], gm[4], bb[4]; int scur = -1;
    if (row < rend) {
#pragma unroll
        for (int i = 0; i < 4; ++i) nv[i] = xld(X, (size_t)row * D + (lane + i * 64) * 4); }
    for (; row < rend; ++row) {
        const int s = row_stream(row);
        if (s != scur) { scur = s; const float* sh = modp(p, layer, s, 3); const float* sc = modp(p, layer, s, 4);
#pragma unroll
            for (int i = 0; i < 4; ++i) { const int d = (lane + i * 64) * 4; const float4 gg = *(const float4*)(g + d), a = *(const float4*)(sc + d); bb[i] = *(const float4*)(sh + d);
                gm[i] = make_float4(gg.x * (1.f + a.x), gg.y * (1.f + a.y), gg.z * (1.f + a.z), gg.w * (1.f + a.w)); } }
        float4 v[4]; float ss = 0;
#pragma unroll
        for (int i = 0; i < 4; ++i) { v[i] = nv[i]; ss += v[i].x * v[i].x + v[i].y * v[i].y + v[i].z * v[i].z + v[i].w * v[i].w; }
        { const int nrow = row + 1;
          if (nrow < rend) {
#pragma unroll
              for (int i = 0; i < 4; ++i) nv[i] = xld(X, (size_t)nrow * D + (lane + i * 64) * 4); } }
        ss = wave_sum(ss); const float rs = rsqrtf(ss * (1.f / D) + RMS_EPS);
        float lg[16];
#pragma unroll
        for (int e = 0; e < 16; ++e) lg[e] = 0.f;
#pragma unroll
        for (int i = 0; i < 4; ++i) {
            const int d = (lane + i * 64) * 4;
            float o[4]; o[0] = v[i].x * rs * gm[i].x + bb[i].x; o[1] = v[i].y * rs * gm[i].y + bb[i].y; o[2] = v[i].z * rs * gm[i].z + bb[i].z; o[3] = v[i].w * rs * gm[i].w + bb[i].w;
            uint2 w; w.x = pk2(o[0], o[1]); w.y = pk2(o[2], o[3]); *(uint2*)(BN + (size_t)row * D + d) = w;
#pragma unroll
            for (int jj = 0; jj < 4; ++jj) {
#pragma unroll
                for (int eq = 0; eq < 4; ++eq) { const float4 r4 = ((const float4*)rt)[((i * 4 + jj) * 4 + eq) * 64 + lane];
                    lg[4 * eq] += o[jj] * r4.x; lg[4 * eq + 1] += o[jj] * r4.y; lg[4 * eq + 2] += o[jj] * r4.z; lg[4 * eq + 3] += o[jj] * r4.w; } }
            asm volatile("" ::: "memory");
        }
        float mx = -1e30f;
#pragma unroll
        for (int e = 0; e < 16; ++e) { lg[e] = wave_sum(lg[e]); mx = fmaxf(mx, lg[e]); }
        float sum = 0;
#pragma unroll
        for (int e = 0; e < 16; ++e) { lg[e] = expf(lg[e] - mx); sum += lg[e]; }
        const float inv = 1.f / sum;
        if (lane < 16) { float val = 0;
#pragma unroll
            for (int e = 0; e < 16; ++e) val = (lane == e) ? lg[e] : val;
            AFF[(size_t)row * 16 + lane] = val * inv; }
    }
}

__device__ void ph_norm2_router_mm(const Params& p, int layer, char* lds, int nrows) {
    typedef __attribute__((address_space(3))) char lch;
    constexpr int PB = 2064;
    constexpr int O_RH = 0, O_RL = 16 * PB, O_A = 32 * PB, A_BUF = 16 * PB, O_P = O_A + 2 * A_BUF, P_BUF = 8 * 8 * 16 * 4;
    const int tid = tidx(), wid = __builtin_amdgcn_readfirstlane(tid >> 6), lane = tid & 63;
    lch* L = (lch*)lds;
    const float* rg = p.moe_router + (size_t)layer * D * NE;
    for (int i = tid; i < D * NE / 4; i += NTHR) { const int d = i >> 2, eq = i & 3; const float4 r4 = ((const float4*)rg)[i]; const float rr[4] = {r4.x, r4.y, r4.z, r4.w};
#pragma unroll
        for (int u = 0; u < 4; ++u) { const unsigned h = pk2(rr[u], rr[u]) & 0xffffu; const float lo = rr[u] - __uint_as_float(h << 16);
            *(LAS bf16_t*)(L + O_RH + (4 * eq + u) * PB + d * 2) = (bf16_t)h; *(LAS bf16_t*)(L + O_RL + (4 * eq + u) * PB + d * 2) = f2bf(lo); } }
    const xt_t* X = (const xt_t*)(p.ws + OFF_X); bf16_t* BN = (bf16_t*)(p.ws + OFF_H); float* AFF = (float*)(p.ws + OFF_AFF);
    const float* g = p.norm2_g + layer * D;
    const int nch = nrows / 8;
    int ch = (int)((long long)bidx() * nch / gdim()); const int chend = (int)((long long)(bidx() + 1) * nch / gdim());
    float4 nv[4], gm[4], bb[4]; int scur = -1;
    if (ch < chend) {
#pragma unroll
        for (int i = 0; i < 4; ++i) nv[i] = xld(X, (size_t)(ch * 8 + wid) * D + (lane + i * 64) * 4); }
    for (int it = 0; ch < chend; ++ch, ++it) {
        const int row = ch * 8 + wid, buf = it & 1;
        const int s = row_stream(row);
        if (s != scur) { scur = s; const float* sh = modp(p, layer, s, 3); const float* sc = modp(p, layer, s, 4);
#pragma unroll
            for (int i = 0; i < 4; ++i) { const int d = (lane + i * 64) * 4; const float4 gg = *(const float4*)(g + d), a = *(const float4*)(sc + d); bb[i] = *(const float4*)(sh + d);
                gm[i] = make_float4(gg.x * (1.f + a.x), gg.y * (1.f + a.y), gg.z * (1.f + a.z), gg.w * (1.f + a.w)); } }
        float4 v[4]; float ss = 0;
#pragma unroll
        for (int i = 0; i < 4; ++i) { v[i] = nv[i]; ss += v[i].x * v[i].x + v[i].y * v[i].y + v[i].z * v[i].z + v[i].w * v[i].w; }
        if (ch + 1 < chend) {
#pragma unroll
            for (int i = 0; i < 4; ++i) nv[i] = xld(X, (size_t)(row + 8) * D + (lane + i * 64) * 4); }
        ss = wave_sum(ss); const float rs = rsqrtf(ss * (1.f / D) + RMS_EPS);
        lch* AH = L + O_A + buf * A_BUF + wid * PB; lch* AL = AH + 8 * PB;
#pragma unroll
        for (int i = 0; i < 4; ++i) {
            const int d = (lane + i * 64) * 4;
            float o[4]; o[0] = v[i].x * rs * gm[i].x + bb[i].x; o[1] = v[i].y * rs * gm[i].y + bb[i].y; o[2] = v[i].z * rs * gm[i].z + bb[i].z; o[3] = v[i].w * rs * gm[i].w + bb[i].w;
            u32x2 wh; wh.x = pk2(o[0], o[1]); wh.y = pk2(o[2], o[3]);
            uint2 wg_; wg_.x = wh.x; wg_.y = wh.y; *(uint2*)(BN + (size_t)row * D + d) = wg_;
            u32x2 wl; wl.x = pk2(o[0] - __uint_as_float(wh.x << 16), o[1] - __uint_as_float(wh.x & 0xffff0000u)); wl.y = pk2(o[2] - __uint_as_float(wh.y << 16), o[3] - __uint_as_float(wh.y & 0xffff0000u));
            *(LAS u32x2*)(AH + d * 2) = wh; *(LAS u32x2*)(AL + d * 2) = wl;
        }
        __syncthreads();
        {
            f32x4 acc = {0.f, 0.f, 0.f, 0.f};
            const lch* ah = L + O_A + buf * A_BUF + (lane & 7) * PB + (128 * wid + 8 * (lane >> 4)) * 2;
            const lch* bh = L + O_RH + (lane & 15) * PB + (128 * wid + 8 * (lane >> 4)) * 2;
#pragma unroll
            for (int ks = 0; ks < 4; ++ks) {
                const bf16x8 a_h = *(const LAS bf16x8*)(ah + ks * 64), a_l = *(const LAS bf16x8*)(ah + 8 * PB + ks * 64);
                const bf16x8 b_h = *(const LAS bf16x8*)(bh + ks * 64), b_l = *(const LAS bf16x8*)(bh + 16 * PB + ks * 64);
                acc = __builtin_amdgcn_mfma_f32_16x16x32_bf16(a_h, b_h, acc, 0, 0, 0);
                acc = __builtin_amdgcn_mfma_f32_16x16x32_bf16(a_h, b_l, acc, 0, 0, 0);
                acc = __builtin_amdgcn_mfma_f32_16x16x32_bf16(a_l, b_h, acc, 0, 0, 0);
            }
            if (lane < 32) {
#pragma unroll
                for (int e = 0; e < 4; ++e) *(LAS float*)(L + O_P + buf * P_BUF + ((wid * 8 + 4 * (lane >> 4) + e) * 16 + (lane & 15)) * 4) = acc[e]; }
        }
        __syncthreads();
        if (tid < 128) {
            float lg = 0.f;
#pragma unroll
            for (int w8 = 0; w8 < 8; ++w8) lg += *(const LAS float*)(L + O_P + buf * P_BUF + (w8 * 128 + tid) * 4);
            float mx = lg;
            mx = fmaxf(mx, __builtin_bit_cast(float, __builtin_amdgcn_update_dpp(0, __builtin_bit_cast(int, mx), 0xB1, 0xF, 0xF, true)));
            mx = fmaxf(mx, __builtin_bit_cast(float, __builtin_amdgcn_update_dpp(0, __builtin_bit_cast(int, mx), 0x4E, 0xF, 0xF, true)));
            mx = fmaxf(mx, __builtin_bit_cast(float, __builtin_amdgcn_update_dpp(0, __builtin_bit_cast(int, mx), 0x141, 0xF, 0xF, true)));
            mx = fmaxf(mx, __builtin_bit_cast(float, __builtin_amdgcn_update_dpp(0, __builtin_bit_cast(int, mx), 0x140, 0xF, 0xF, true)));
            const float ex = expf(lg - mx); const float sum = dpp_sum16(ex);
            AFF[(size_t)(ch * 8) * 16 + tid] = ex / sum;
        }
    }
}

__device__ void ph_select(const Params& p, char* lds, int ngroups) {
    const int tid = tidx(), wid = tid >> 6, lane = tid & 63;
    unsigned* hist = (unsigned*)lds;
    unsigned* ctl = hist + 256;
    unsigned* wsum = ctl + 8;
    int* rowl = (int*)(wsum + 16);
    const float* AFF = (const float*)(p.ws + OFF_AFF);
    int* ROWIDX = (int*)(p.ws + OFF_ROWIDX); float* GATE = (float*)(p.ws + OFF_GATE); int* SLOT = (int*)(p.ws + OFF_SLOT);
    for (int gidx = bidx(); gidx < ngroups; gidx += gdim()) {
        const bool lat = gidx < 64; const int b = (gidx & 63) >> 4, e = gidx & 15;
        const int n = lat ? TL : TC, cap = lat ? CAPL : CAPC;
        const int row0 = lat ? b * TL : NLAT + b * TC, slot0 = lat ? b * CAPL : NB * CAPL + b * CAPC;
        unsigned key[8];
#pragma unroll
        for (int i = 0; i < 8; ++i) { const int idx = tid * 8 + i; key[i] = idx < n ? __float_as_uint(AFF[(size_t)(row0 + idx) * 16 + e]) : 0u; }
        unsigned prefix = 0u, remaining = (unsigned)cap;
#pragma unroll
        for (int pass = 0; pass < 4; ++pass) {
            const int sh = 24 - 8 * pass;
            __syncthreads();
            if (tid < 256) hist[tid] = 0u;
            __syncthreads();
#pragma unroll
            for (int i = 0; i < 8; ++i) { const int idx = tid * 8 + i;
                const bool cand = idx < n && (pass == 0 || (key[i] >> (sh + 8)) == prefix);
                if (cand) atomicAdd(&hist[(key[i] >> sh) & 255u], 1u); }
            __syncthreads();
            if (tid < 256) { unsigned gt = 0; for (int jj = tid + 1; jj < 256; ++jj) gt += hist[jj];
                const unsigned mine = hist[tid];
                if (gt < remaining && remaining <= gt + mine) { ctl[0] = (unsigned)tid; ctl[1] = remaining - gt; } }
            __syncthreads();
            prefix = (prefix << 8) | ctl[0]; remaining = ctl[1];
        }
        const unsigned T = prefix, m = remaining;
        unsigned cgt = 0, ceq = 0;
#pragma unroll
        for (int i = 0; i < 8; ++i) { const int idx = tid * 8 + i; if (idx < n) { cgt += key[i] > T ? 1u : 0u; ceq += key[i] == T ? 1u : 0u; } }
        auto block_excl = [&](unsigned v) -> unsigned {
            unsigned inc = v;
#pragma unroll
            for (int o = 1; o < 64; o <<= 1) { const unsigned t = (unsigned)__builtin_amdgcn_ds_bpermute((lane - o) << 2, (int)inc); if (lane >= o) inc += t; }
            __syncthreads();
            if (lane == 63) wsum[wid] = inc;
            __syncthreads();
            unsigned base = 0;
#pragma unroll
            for (int w = 0; w < 8; ++w) base += (w < wid) ? wsum[w] : 0u;
            return base + inc - v; };
        unsigned eqbase = block_excl(ceq);
        unsigned nsel = 0; bool sel[8];
#pragma unroll
        for (int i = 0; i < 8; ++i) { const int idx = tid * 8 + i; bool s_ = false;
            if (idx < n) { if (key[i] > T) s_ = true; else if (key[i] == T) { s_ = eqbase < m; ++eqbase; } }
            sel[i] = s_; nsel += s_ ? 1u : 0u; }
        unsigned sbase = block_excl(nsel);
#pragma unroll
        for (int i = 0; i < 8; ++i) { const int idx = tid * 8 + i;
            if (idx < n) {
                if (sel[i]) { const int sl = slot0 + (int)sbase; rowl[sbase] = row0 + idx; ++sbase; ROWIDX[e * ESLOTS + sl] = row0 + idx; GATE[e * EPAD + sl] = __uint_as_float(key[i]); SLOT[(size_t)(row0 + idx) * 16 + e] = sl; }
                else SLOT[(size_t)(row0 + idx) * 16 + e] = -1; } }
        __syncthreads();
        { const bf16_t* BN = (const bf16_t*)(p.ws + OFF_H); bf16_t* XE = (bf16_t*)(p.ws + OFF_XE);
          for (int r = wid; r < cap; r += 32) {
              u32x4 t_[4][2];
#pragma unroll
              for (int u = 0; u < 4; ++u) { const u32x4* src = (const u32x4*)(BN + (size_t)rowl[r + 8 * u] * D); t_[u][0] = src[lane]; t_[u][1] = src[lane + 64]; }
#pragma unroll
              for (int u = 0; u < 4; ++u) { u32x4* dst = (u32x4*)(XE + ((size_t)e * EPAD + slot0 + r + 8 * u) * D); dst[lane] = t_[u][0]; dst[lane + 64] = t_[u][1]; } } }
    }
}

__device__ void ph_gather(const Params& p, int nslots) {
    const int wid = tidx() >> 6, lane = tidx() & 63;
    const int* ROWIDX = (const int*)(p.ws + OFF_ROWIDX); const bf16_t* BN = (const bf16_t*)(p.ws + OFF_H); bf16_t* XE = (bf16_t*)(p.ws + OFF_XE);
    for (int it = bidx() * 8 + wid; it < NE * ESLOTS; it += gdim() * 8) {
        const int e = it / ESLOTS, sl = it % ESLOTS; if (sl >= nslots) continue; const int row = ROWIDX[it];
        const u32x4* src = (const u32x4*)(BN + (size_t)row * D); u32x4* dst = (u32x4*)(XE + ((size_t)e * EPAD + sl) * D);
        dst[lane] = src[lane]; dst[lane + 64] = src[lane + 64];
    }
}

__device__ void ph_combine(const Params& p, int layer, int nrows) {
    const int wid = tidx() >> 6, lane = tidx() & 63;
    const int* SLOT = (const int*)(p.ws + OFF_SLOT); const bf16_t* YE = (const bf16_t*)(p.ws + OFF_YE); xt_t* X = (xt_t*)(p.ws + OFF_X);
    int row = bidx() * 8 + wid;
    int sl = (row < nrows && lane < 16) ? SLOT[(size_t)row * 16 + lane] : -1;
    while (row < nrows) {
        const int nrow = row + gdim() * 8;
        const int sln = (nrow < nrows && lane < 16) ? SLOT[(size_t)nrow * 16 + lane] : -1;
        const float* gt = modp(p, layer, row_stream(row), 5);
        xt_t* xr = X + (size_t)row * D + lane * 8;
        f32x4 xv[4];
#pragma unroll
        for (int i = 0; i < 2; ++i) { xv[2 * i] = xldv(xr, 512 * i); xv[2 * i + 1] = xldv(xr, 512 * i + 4); }
        unsigned long long m = __ballot(sl >= 0);
        float acc[16];
#pragma unroll
        for (int i = 0; i < 16; ++i) acc[i] = 0.f;
        while (m) {
            const int e0 = __builtin_ctzll(m); m &= m - 1; const bool two = m != 0; const int e1 = two ? __builtin_ctzll(m) : e0; if (two) m &= m - 1;
            const int s0 = __builtin_amdgcn_readlane(sl, e0), s1 = __builtin_amdgcn_readlane(sl, e1);
            const bf16_t* y0 = YE + ((size_t)e0 * EPAD + s0) * D + lane * 8; const bf16_t* y1 = YE + ((size_t)e1 * EPAD + s1) * D + lane * 8;
            const u32x4 a0 = *(const u32x4*)y0, a1 = *(const u32x4*)(y0 + 512), b0 = *(const u32x4*)y1, b1 = *(const u32x4*)(y1 + 512);
            const float f1 = two ? 1.f : 0.f;
#pragma unroll
            for (int i = 0; i < 4; ++i) { acc[2 * i] += __uint_as_float(a0[i] << 16) + f1 * __uint_as_float(b0[i] << 16); acc[2 * i + 1] += __uint_as_float(a0[i] & 0xffff0000u) + f1 * __uint_as_float(b0[i] & 0xffff0000u);
                acc[8 + 2 * i] += __uint_as_float(a1[i] << 16) + f1 * __uint_as_float(b1[i] << 16); acc[8 + 2 * i + 1] += __uint_as_float(a1[i] & 0xffff0000u) + f1 * __uint_as_float(b1[i] & 0xffff0000u); }
        }
#pragma unroll
        for (int i = 0; i < 2; ++i) { const f32x4 g0 = *(const f32x4*)(gt + lane * 8 + 512 * i), g1 = *(const f32x4*)(gt + lane * 8 + 512 * i + 4);
            f32x4 o0 = xv[2 * i], o1 = xv[2 * i + 1];
#pragma unroll
            for (int e = 0; e < 4; ++e) { o0[e] += g0[e] * acc[8 * i + e]; o1[e] += g1[e] * acc[8 * i + 4 + e]; }
            xstv(xr, 512 * i, o0); xstv(xr, 512 * i + 4, o1); }
        row = nrow; sl = sln;
    }
}

template <bool FINAL>
__device__ void ph_comb_norm(const Params& p, int lprev, int layer, int nrows) {
    const int wid = tidx() >> 6, lane = tidx() & 63;
    const int* SLOT = (const int*)(p.ws + OFF_SLOT); const bf16_t* YE = (const bf16_t*)(p.ws + OFF_YE); xt_t* X = (xt_t*)(p.ws + OFF_X);
    bf16_t* H = (bf16_t*)(p.ws + OFF_H);
    const float* g = FINAL ? p.final_g : p.norm1_g + layer * D;
    int row = bidx() * 8 + wid;
    int sl = (row < nrows && lane < 16) ? SLOT[(size_t)row * 16 + lane] : -1;
    while (row < nrows) {
        const int nrow = row + gdim() * 8;
        const int sln = (nrow < nrows && lane < 16) ? SLOT[(size_t)nrow * 16 + lane] : -1;
        const int strm = row_stream(row);
        const float* gt = modp(p, lprev, strm, 5);
        xt_t* xr = X + (size_t)row * D + lane * 8;
        f32x4 xv[4];
#pragma unroll
        for (int i = 0; i < 2; ++i) { xv[2 * i] = xldv(xr, 512 * i); xv[2 * i + 1] = xldv(xr, 512 * i + 4); }
        unsigned long long m = __ballot(sl >= 0);
        float acc[16];
#pragma unroll
        for (int i = 0; i < 16; ++i) acc[i] = 0.f;
        while (m) {
            const int e0 = __builtin_ctzll(m); m &= m - 1; const bool two = m != 0; const int e1 = two ? __builtin_ctzll(m) : e0; if (two) m &= m - 1;
            const int s0 = __builtin_amdgcn_readlane(sl, e0), s1 = __builtin_amdgcn_readlane(sl, e1);
            const bf16_t* y0 = YE + ((size_t)e0 * EPAD + s0) * D + lane * 8; const bf16_t* y1 = YE + ((size_t)e1 * EPAD + s1) * D + lane * 8;
            const u32x4 a0 = *(const u32x4*)y0, a1 = *(const u32x4*)(y0 + 512), b0 = *(const u32x4*)y1, b1 = *(const u32x4*)(y1 + 512);
            const float f1 = two ? 1.f : 0.f;
#pragma unroll
            for (int i = 0; i < 4; ++i) { acc[2 * i] += __uint_as_float(a0[i] << 16) + f1 * __uint_as_float(b0[i] << 16); acc[2 * i + 1] += __uint_as_float(a0[i] & 0xffff0000u) + f1 * __uint_as_float(b0[i] & 0xffff0000u);
                acc[8 + 2 * i] += __uint_as_float(a1[i] << 16) + f1 * __uint_as_float(b1[i] << 16); acc[8 + 2 * i + 1] += __uint_as_float(a1[i] & 0xffff0000u) + f1 * __uint_as_float(b1[i] & 0xffff0000u); }
        }
        float ss = 0.f;
#pragma unroll
        for (int i = 0; i < 2; ++i) { const f32x4 g0 = *(const f32x4*)(gt + lane * 8 + 512 * i), g1 = *(const f32x4*)(gt + lane * 8 + 512 * i + 4);
#pragma unroll
            for (int e = 0; e < 4; ++e) { xv[2 * i][e] += g0[e] * acc[8 * i + e]; xv[2 * i + 1][e] += g1[e] * acc[8 * i + 4 + e]; ss += xv[2 * i][e] * xv[2 * i][e] + xv[2 * i + 1][e] * xv[2 * i + 1][e]; }
            if (!FINAL) { xstv(xr, 512 * i, xv[2 * i]); xstv(xr, 512 * i + 4, xv[2 * i + 1]); } }
        ss = wave_sum(ss); const float rs = rsqrtf(ss * (1.f / D) + RMS_EPS);
        const float* sh = FINAL ? nullptr : modp(p, layer, strm, 0); const float* sc = FINAL ? nullptr : modp(p, layer, strm, 1);
#pragma unroll
        for (int i = 0; i < 2; ++i)
#pragma unroll
            for (int hh = 0; hh < 2; ++hh) { const int d = lane * 8 + 512 * i + 4 * hh; const f32x4 gg = *(const f32x4*)(g + d); f32x4 o = xv[2 * i + hh] * rs * gg;
                if (FINAL) *(f32x4*)(p.out + (size_t)row * D + d) = o;
                else { o = o * (1.f + *(const f32x4*)(sc + d)) + *(const f32x4*)(sh + d); stbf4(H + (size_t)row * D + d, o); } }
        row = nrow; sl = sln;
    }
}

__device__ void ph_rw_normxs(const Params& p, int layer, int j) {
    const int wid = tidx() >> 6, lane = tidx() & 63;
    const xt_t* X = (const xt_t*)(p.ws + OFF_X); bf16_t* XS = (bf16_t*)(p.ws + OFF_XS);
    const float* mu = p.rw_mu + (size_t)j * 6 * D; const float* g = p.norm1_g + layer * D;
    const int w = bidx() * 8 + wid, nw = gdim() * 8;
    const int r0 = (int)((long long)w * NROW / nw), r1 = (int)((long long)(w + 1) * NROW / nw);
    if (r0 >= r1) return;
    float4 um[6][4];
#pragma unroll
    for (int m = 0; m < 6; ++m)
#pragma unroll
        for (int i = 0; i < 4; ++i) um[m][i] = *(const float4*)(mu + m * D + (lane + i * 64) * 4);
    float4 gm[4], bb[4]; int scur = -1;
    float4 hp[4], hc[4], hn[4], raw[4];
#define XS_NORM(dst, src, R) do { const int s_ = row_stream(R); \
        if (s_ != scur) { scur = s_; const float* sh_ = modp(p, layer, s_, 0); const float* sc_ = modp(p, layer, s_, 1); \
            _Pragma("unroll") for (int i = 0; i < 4; ++i) { const int d_ = (lane + i * 64) * 4; const float4 gg_ = *(const float4*)(g + d_), a_ = *(const float4*)(sc_ + d_); bb[i] = *(const float4*)(sh_ + d_); \
                gm[i] = make_float4(gg_.x * (1.f + a_.x), gg_.y * (1.f + a_.y), gg_.z * (1.f + a_.z), gg_.w * (1.f + a_.w)); } } \
        float ss_ = 0.f; \
        _Pragma("unroll") for (int i = 0; i < 4; ++i) ss_ += src[i].x * src[i].x + src[i].y * src[i].y + src[i].z * src[i].z + src[i].w * src[i].w; \
        ss_ = wave_sum(ss_); const float rs_ = rsqrtf(ss_ * (1.f / D) + RMS_EPS); \
        _Pragma("unroll") for (int i = 0; i < 4; ++i) dst[i] = make_float4(src[i].x * rs_ * gm[i].x + bb[i].x, src[i].y * rs_ * gm[i].y + bb[i].y, src[i].z * rs_ * gm[i].z + bb[i].z, src[i].w * rs_ * gm[i].w + bb[i].w); } while (0)
#define XS_RAW(R) do { _Pragma("unroll") for (int i = 0; i < 4; ++i) raw[i] = xld(X, (size_t)(R) * D + (lane + i * 64) * 4); } while (0)
    if (r0 > 0) { XS_RAW(r0 - 1); XS_NORM(hp, raw, r0 - 1); }
    else {
#pragma unroll
        for (int i = 0; i < 4; ++i) hp[i] = make_float4(0.f, 0.f, 0.f, 0.f); }
    XS_RAW(r0); XS_NORM(hc, raw, r0);
    if (r0 + 1 < NROW) XS_RAW(r0 + 1);
    for (int row = r0; row < r1; ++row) {
        const bool lat = row < NLAT; const int t = lat ? (row & (TL - 1)) : ((row - NLAT) & (TC - 1)); const int len = lat ? TL : TC;
        const float fp_ = t > 0 ? 0.5f : 0.f, fn_ = t < len - 1 ? 0.5f : 0.f;
        if (row + 1 < NROW) XS_NORM(hn, raw, row + 1);
        else {
#pragma unroll
            for (int i = 0; i < 4; ++i) hn[i] = make_float4(0.f, 0.f, 0.f, 0.f); }
        if (row + 1 < r1 && row + 2 < NROW) XS_RAW(row + 2);
#pragma unroll
        for (int i = 0; i < 4; ++i) {
            const int d = (lane + i * 64) * 4;
            const float4 h = hc[i];
            const float4 xx = make_float4(fp_ * hp[i].x + fn_ * hn[i].x - h.x, fp_ * hp[i].y + fn_ * hn[i].y - h.y, fp_ * hp[i].z + fn_ * hn[i].z - h.z, fp_ * hp[i].w + fn_ * hn[i].w - h.w);
#pragma unroll
            for (int m = 0; m < 6; ++m) { const float4 u = um[m][i];
                uint2 wv_; wv_.x = pk2(h.x + xx.x * u.x, h.y + xx.y * u.y); wv_.y = pk2(h.z + xx.z * u.z, h.w + xx.w * u.w);
                *(uint2*)(XS + ((size_t)m * NROW + row) * D + d) = wv_; }
        }
#pragma unroll
        for (int i = 0; i < 4; ++i) { hp[i] = hc[i]; hc[i] = hn[i]; }
    }
#undef XS_NORM
#undef XS_RAW
}

__device__ __forceinline__ int scan_row(int i, int b, int z) {
    return i < TC ? NLAT + b * TC + (z ? TC - 1 - i : i) : b * TL + (z ? TL - 1 - (i - TC) : i - TC);
}
__device__ __forceinline__ float dpp_sum8(float x) {
    x += __builtin_bit_cast(float, __builtin_amdgcn_update_dpp(0, __builtin_bit_cast(int, x), 0xB1, 0xF, 0xF, true));
    x += __builtin_bit_cast(float, __builtin_amdgcn_update_dpp(0, __builtin_bit_cast(int, x), 0x4E, 0xF, 0xF, true));
    x += __builtin_bit_cast(float, __builtin_amdgcn_update_dpp(0, __builtin_bit_cast(int, x), 0x141, 0xF, 0xF, true));
    return x;
}
__device__ void ph_rw_scan(const Params& p, int j, char* lds) {
    const int tid = tidx(), wid = __builtin_amdgcn_readfirstlane(tid >> 6), lane = tid & 63;
    const size_t PL = (size_t)NROW * D;
    const float* RKV = (const float*)(p.ws + OFF_RKV); float* Y = (float*)(p.ws + OFF_Y);
    constexpr int CH = 32, BUFB = 5 * CH * 256 + CH * 128 + CH * 16, YB = CH * 32 * 4, NCH = (TC + TL) / CH;
    const bool loader = wid >= 4; const int lw = wid - 4;
    for (int it = bidx(); it < 256; it += gdim()) {
        const int vh = it & 1, z = (it >> 1) & 1, h = (it >> 2) & 15, b = it >> 6;
        const char* pl0 = (const char*)((const float*)(p.ws + OFF_W) + z * PL); const char* pl1 = (const char*)(RKV + PL);
        const char* pl2 = (const char*)((const float*)(p.ws + OFF_AV) + z * PL); const char* pl3 = (const char*)RKV;
        const char* vpl = (const char*)(RKV + 2 * PL);
        float* yout = Y + z * PL;
        __builtin_amdgcn_s_barrier();
        if (loader) {
            const int pq = lane & 15;
            const f32x4 kkv = *(const f32x4*)(p.rw_k_k + j * D + h * 64 + pq * 4), kav = *(const f32x4*)(p.rw_k_a + j * D + h * 64 + pq * 4);
            auto issue = [&](int c) {
                char* buf = lds + (c % 3) * BUFB;
#pragma unroll
                for (int q = 0; q < 8; ++q) { const int pi = q >> 1, tg = lw * 2 + (q & 1); const int row = scan_row(c * CH + tg * 4 + (lane >> 4), b, z);
                    const char* base = pi == 0 ? pl0 : pi == 1 ? pl1 : pi == 2 ? pl2 : pl3;
                    __builtin_amdgcn_global_load_lds((const unsigned*)(base + (size_t)row * D * 4 + h * 256 + (lane & 15) * 16), (LAS unsigned*)(buf + pi * (CH * 256) + tg * 1024), 16, 0, 0); }
                { const int row = scan_row(c * CH + lw * 8 + (lane >> 3), b, z);
                  __builtin_amdgcn_global_load_lds((const unsigned*)(vpl + (size_t)row * D * 4 + (h * 64 + vh * 32) * 4 + (lane & 7) * 16), (LAS unsigned*)(buf + 5 * CH * 256 + lw * 1024), 16, 0, 0); }
            };
            auto prep = [&](int c) {
                char* buf = lds + (c % 3) * BUFB;
#pragma unroll
                for (int ps = 0; ps < 2; ++ps) { const int ptok = lw * 8 + ps * 4 + (lane >> 4);
                    f32x4* kp = (f32x4*)(buf + 1 * CH * 256 + ptok * 256 + pq * 16); f32x4* ap = (f32x4*)(buf + 2 * CH * 256 + ptok * 256 + pq * 16); f32x4* dp = (f32x4*)(buf + 4 * CH * 256 + ptok * 256 + pq * 16);
                    f32x4* rp = (f32x4*)(buf + 3 * CH * 256 + ptok * 256 + pq * 16); const f32x4 wv = *(const f32x4*)(buf + ptok * 256 + pq * 16);
                    const f32x4 k = *kp, a = *ap, r = *rp; f32x4 kk = k * kkv;
                    float ss = kk[0] * kk[0] + kk[1] * kk[1] + kk[2] * kk[2] + kk[3] * kk[3]; ss = dpp_sum16(ss);
                    const float inv = 1.f / fmaxf(sqrtf(ss), 1e-12f); kk = kk * inv;
                    const f32x4 kd = k * (1.f + (a - 1.f) * kav), bb = kk * a;
                    const f32x4 t1 = bb * r, t2 = kd * r;
                    const float br = dpp_sum16((t1[0] + t1[1]) + (t1[2] + t1[3])), kr = dpp_sum16((t2[0] + t2[1]) + (t2[2] + t2[3]));
                    *dp = kd; *ap = bb; *kp = kk; *rp = wv * r;
                    if (pq == 0) *(float2*)(buf + 5 * CH * 256 + CH * 128 + ptok * 16) = make_float2(br, kr); }
            };
            issue(0); issue(1);
            asm volatile("s_waitcnt vmcnt(9)" ::: "memory");
            prep(0);
            asm volatile("s_waitcnt lgkmcnt(0)" ::: "memory"); __builtin_amdgcn_s_barrier();
            for (int c = 0; c < NCH; ++c) {
                if (c >= 1) { const float* yb = (const float*)(lds + 3 * BUFB + ((c - 1) & 1) * YB);
                    const int lt = tid - 256, t = lt >> 3, q = lt & 7; const int row = scan_row((c - 1) * CH + t, b, z);
                    *(f32x4*)(yout + (size_t)row * D + h * 64 + vh * 32 + q * 4) = *(const f32x4*)(yb + t * 32 + q * 4); }
                if (c + 2 < NCH) { issue(c + 2); asm volatile("s_waitcnt vmcnt(9)" ::: "memory"); } else asm volatile("s_waitcnt vmcnt(0)" ::: "memory");
                if (c + 1 < NCH) prep(c + 1);
                asm volatile("s_waitcnt lgkmcnt(0)" ::: "memory"); __builtin_amdgcn_s_barrier();
            }
            { const float* yb = (const float*)(lds + 3 * BUFB + ((NCH - 1) & 1) * YB);
              const int lt = tid - 256, t = lt >> 3, q = lt & 7; const int row = scan_row((NCH - 1) * CH + t, b, z);
              *(f32x4*)(yout + (size_t)row * D + h * 64 + vh * 32 + q * 4) = *(const f32x4*)(yb + t * 32 + q * 4); }
        } else {
            const int vr = lane >> 3, ks = lane & 7;
            f32x4 Sa = {0.f, 0.f, 0.f, 0.f}, Sb = {0.f, 0.f, 0.f, 0.f};
            __builtin_amdgcn_s_barrier();
            struct Ops { f32x4 w0, w1, kk0, kk1, bb0, bb1, r0, r1, kd0, kd1; float v; float2 sc; };
#define SC_LOAD(O, t) do { const char* q_ = bq + (t) * 256; O.w0 = *(const f32x4*)(q_); O.w1 = *(const f32x4*)(q_ + 16); O.kk0 = *(const f32x4*)(q_ + CH * 256); O.kk1 = *(const f32x4*)(q_ + CH * 256 + 16); \
                O.bb0 = *(const f32x4*)(q_ + 2 * CH * 256); O.bb1 = *(const f32x4*)(q_ + 2 * CH * 256 + 16); O.r0 = *(const f32x4*)(q_ + 3 * CH * 256); O.r1 = *(const f32x4*)(q_ + 3 * CH * 256 + 16); \
                O.kd0 = *(const f32x4*)(q_ + 4 * CH * 256); O.kd1 = *(const f32x4*)(q_ + 4 * CH * 256 + 16); O.v = *(const float*)(vq + (t) * 128); O.sc = *(const float2*)(buf + 5 * CH * 256 + CH * 128 + (t) * 16); } while (0)
#define SC_STEP(O, t) do { const f32x4 d1 = Sa * O.kk0 + Sb * O.kk1, d2 = Sa * O.r0 + Sb * O.r1; \
                float sa = -((d1[0] + d1[1]) + (d1[2] + d1[3])), yy = (d2[0] + d2[1]) + (d2[2] + d2[3]); \
                sa = dpp_sum8(sa); yy = dpp_sum8(yy); \
                Sa = Sa * O.w0 + (sa * O.bb0 + O.v * O.kd0); Sb = Sb * O.w1 + (sa * O.bb1 + O.v * O.kd1); \
                if (ks == 0) yb[(t) * 32 + wid * 8 + vr] = yy + sa * O.sc.x + O.v * O.sc.y; } while (0)
            for (int c = 0; c < NCH; ++c) {
                const char* buf = lds + (c % 3) * BUFB; float* yb = (float*)(lds + 3 * BUFB + (c & 1) * YB);
                const char* bq = buf + ks * 32; const char* vq = buf + 5 * CH * 256 + (wid * 8 + vr) * 4;
                Ops oA, oB, oC;
                SC_LOAD(oA, 0); SC_LOAD(oB, 1);
#pragma unroll
                for (int t = 0; t < CH; t += 3) {
                    if (t + 2 < CH) SC_LOAD(oC, t + 2);
                    SC_STEP(oA, t);
                    if (t + 3 < CH) SC_LOAD(oA, t + 3);
                    if (t + 1 < CH) SC_STEP(oB, t + 1);
                    if (t + 4 < CH) SC_LOAD(oB, t + 4);
                    if (t + 2 < CH) SC_STEP(oC, t + 2);
                }
                asm volatile("s_waitcnt lgkmcnt(0)" ::: "memory"); __builtin_amdgcn_s_barrier();
            }
#undef SC_LOAD
#undef SC_STEP
        }
    }
}


namespace ck {
constexpr int P = 72, MB = 64 * P * 2;
typedef __attribute__((address_space(3))) char lchar;
__device__ __forceinline__ f32x4 mm_tile(const lchar* Aop, const lchar* Bop, int ti, int tj, int c, int q, f32x4 acc) {
#pragma unroll
    for (int ks = 0; ks < 2; ++ks) {
        const bf16x8 a = *(const LAS bf16x8*)(Aop + ((16 * ti + c) * P + 32 * ks + 8 * q) * 2);
        const bf16x8 b = *(const LAS bf16x8*)(Bop + ((16 * tj + c) * P + 32 * ks + 8 * q) * 2);
        acc = __builtin_amdgcn_mfma_f32_16x16x32_bf16(a, b, acc, 0, 0, 0);
    }
    return acc;
}
__device__ __forceinline__ f32x4 mm_diag(const lchar* Aop, const lchar* Bop, int tt, int c, int q, f32x4 acc) {
    const int ks = tt >> 1;
    bf16x8 a = *(const LAS bf16x8*)(Aop + ((16 * tt + c) * P + 32 * ks + 8 * q) * 2);
    const bf16x8 b = *(const LAS bf16x8*)(Bop + ((16 * tt + c) * P + 32 * ks + 8 * q) * 2);
    if ((q >> 1) != (tt & 1)) a = (bf16x8){0, 0, 0, 0, 0, 0, 0, 0};
    return __builtin_amdgcn_mfma_f32_16x16x32_bf16(a, b, acc, 0, 0, 0);
}
__device__ __forceinline__ void st_tile(lchar* dst, int ti, int tj, int c, int q, f32x4 v) {
    u32x2 w; w.x = pk2(v[0], v[1]); w.y = pk2(v[2], v[3]); *(LAS u32x2*)(dst + ((16 * tj + c) * P + 16 * ti + 4 * q) * 2) = w;
}
__device__ __forceinline__ f32x4 ld_tile(const lchar* src, int ti, int tj, int c, int q) {
    const u32x2 w = *(const LAS u32x2*)(src + ((16 * tj + c) * P + 16 * ti + 4 * q) * 2);
    return (f32x4){__uint_as_float(w.x << 16), __uint_as_float(w.x & 0xffff0000u), __uint_as_float(w.y << 16), __uint_as_float(w.y & 0xffff0000u)};
}
__device__ __forceinline__ void st_glob(bf16_t* dst, int ti, int tj, int c, int q, f32x4 v) {
    uint2 w; w.x = pk2(v[0], v[1]); w.y = pk2(v[2], v[3]); *(uint2*)(dst + (16 * tj + c) * 64 + 16 * ti + 4 * q) = w;
}
typedef float f32x16 __attribute__((ext_vector_type(16)));
__device__ __forceinline__ f32x16 mm32(const lchar* Aop, const lchar* Bop, int ti, int tj, int r32, int hi, f32x16 acc) {
#pragma unroll
    for (int ks = 0; ks < 4; ++ks) {
        const bf16x8 a = *(const LAS bf16x8*)(Aop + ((32 * ti + r32) * P + 16 * ks + 8 * hi) * 2);
        const bf16x8 b = *(const LAS bf16x8*)(Bop + ((32 * tj + r32) * P + 16 * ks + 8 * hi) * 2);
        acc = __builtin_amdgcn_mfma_f32_32x32x16_bf16(a, b, acc, 0, 0, 0);
    }
    return acc;
}
__device__ __forceinline__ void st32(lchar* dst, int ti, int tj, int r32, int hi, const f32x16& v) {
#pragma unroll
    for (int g = 0; g < 4; ++g) { u32x2 w; w.x = pk2(v[4 * g], v[4 * g + 1]); w.y = pk2(v[4 * g + 2], v[4 * g + 3]); *(LAS u32x2*)(dst + ((32 * tj + r32) * P + 32 * ti + 8 * g + 4 * hi) * 2) = w; }
}
__device__ __forceinline__ f32x16 ld32(const lchar* src, int ti, int tj, int r32, int hi) {
    f32x16 v;
#pragma unroll
    for (int g = 0; g < 4; ++g) { const u32x2 w = *(const LAS u32x2*)(src + ((32 * tj + r32) * P + 32 * ti + 8 * g + 4 * hi) * 2);
        v[4 * g] = __uint_as_float(w.x << 16); v[4 * g + 1] = __uint_as_float(w.x & 0xffff0000u); v[4 * g + 2] = __uint_as_float(w.y << 16); v[4 * g + 3] = __uint_as_float(w.y & 0xffff0000u); }
    return v;
}
__device__ __forceinline__ void stg32(bf16_t* dst, int ti, int tj, int r32, int hi, const f32x16& v) {
#pragma unroll
    for (int g = 0; g < 4; ++g) { uint2 w; w.x = pk2(v[4 * g], v[4 * g + 1]); w.y = pk2(v[4 * g + 2], v[4 * g + 3]); *(uint2*)(dst + (32 * tj + r32) * 64 + 32 * ti + 8 * g + 4 * hi) = w; }
}
}

#define LBAR() do { asm volatile("s_waitcnt lgkmcnt(0)" ::: "memory"); __builtin_amdgcn_s_barrier(); asm volatile("" ::: "memory"); } while (0)
__device__ void ph_rw_sc1(const Params& p, int j, char* lds) {
    using namespace ck;
    const int tid = tidx(), wid = __builtin_amdgcn_readfirstlane(tid >> 6), lane = tid & 63, c = lane & 15, q = lane >> 4;
    const size_t PL = (size_t)NROW * D;
    const bf16_t* RKV = (const bf16_t*)(p.ws + OFF_RKV); const float* LW = (const float*)(p.ws + OFF_W); const bf16_t* AV = (const bf16_t*)(p.ws + OFF_AV);
    bf16_t* CK = (bf16_t*)(p.ws + OFF_CK);
    lchar* B0 = (lchar*)lds;
#define BUF(i) (B0 + (i) * MB)
    LAS float* Lbuf = (LAS float*)BUF(8);
    LAS float* Lseg = (LAS float*)(B0 + 16 * MB);
    LAS float* GC = Lseg + 8 * 64;
    const int pt = tid >> 3, cg = tid & 7;
    f32x4 nlw[2], nkk[2], nka[2]; u32x4 nkx, nax, nrx, nvx;
#define SC1_LOAD(IT) do { const int seq_ = (IT) / NCHK, ch_ = (IT) % NCHK; const int z_ = seq_ & 1, h_ = (seq_ >> 1) & 15, b_ = seq_ >> 5; \
        const size_t go_ = (size_t)scan_row(ch_ * 64 + pt, b_, z_) * D + h_ * 64 + cg * 8; \
        _Pragma("unroll") for (int e = 0; e < 2; ++e) nlw[e] = *(const f32x4*)(LW + z_ * PL + go_ + 4 * e); \
        nkx = *(const u32x4*)(RKV + PL + go_); nax = *(const u32x4*)(AV + z_ * PL + go_); nrx = *(const u32x4*)(RKV + go_); nvx = *(const u32x4*)(RKV + 2 * PL + go_); \
        _Pragma("unroll") for (int e = 0; e < 2; ++e) { nkk[e] = *(const f32x4*)(p.rw_k_k + j * D + h_ * 64 + cg * 8 + 4 * e); nka[e] = *(const f32x4*)(p.rw_k_a + j * D + h_ * 64 + cg * 8 + 4 * e); } } while (0)
    if (bidx() < 128 * NCHK) SC1_LOAD(bidx());
    for (int it = bidx(); it < 128 * NCHK; it += gdim()) {
        const int seq = it / NCHK; const int h = (seq >> 1) & 15;
        f32x4 lw[2], kx[2], ax[2], rx[2], vx[2], kkc[2], kac[2];
#pragma unroll
        for (int e = 0; e < 2; ++e) { lw[e] = nlw[e]; kkc[e] = nkk[e]; kac[e] = nka[e];
            kx[e] = (f32x4){__uint_as_float(nkx[2 * e] << 16), __uint_as_float(nkx[2 * e] & 0xffff0000u), __uint_as_float(nkx[2 * e + 1] << 16), __uint_as_float(nkx[2 * e + 1] & 0xffff0000u)};
            ax[e] = (f32x4){__uint_as_float(nax[2 * e] << 16), __uint_as_float(nax[2 * e] & 0xffff0000u), __uint_as_float(nax[2 * e + 1] << 16), __uint_as_float(nax[2 * e + 1] & 0xffff0000u)};
            rx[e] = (f32x4){__uint_as_float(nrx[2 * e] << 16), __uint_as_float(nrx[2 * e] & 0xffff0000u), __uint_as_float(nrx[2 * e + 1] << 16), __uint_as_float(nrx[2 * e + 1] & 0xffff0000u)};
            vx[e] = (f32x4){__uint_as_float(nvx[2 * e] << 16), __uint_as_float(nvx[2 * e] & 0xffff0000u), __uint_as_float(nvx[2 * e + 1] << 16), __uint_as_float(nvx[2 * e + 1] & 0xffff0000u)}; }
        if (it + gdim() < 128 * NCHK) SC1_LOAD(it + gdim());
        LBAR();
#pragma unroll
        for (int e = 0; e < 2; ++e) *(LAS f32x4*)(Lbuf + pt * 64 + cg * 8 + 4 * e) = lw[e];
        f32x4 kk[2], bq[2], kd[2];
        { float ss = 0.f;
#pragma unroll
          for (int e = 0; e < 2; ++e) { kk[e] = kx[e] * kkc[e]; ss += kk[e][0] * kk[e][0] + kk[e][1] * kk[e][1] + kk[e][2] * kk[e][2] + kk[e][3] * kk[e][3]; }
          ss = dpp_sum8(ss); const float inv = __builtin_amdgcn_rsqf(fmaxf(ss, 1e-24f));
#pragma unroll
          for (int e = 0; e < 2; ++e) { kk[e] = kk[e] * inv; bq[e] = kk[e] * ax[e]; kd[e] = kx[e] * (1.f + (ax[e] - 1.f) * kac[e]); } }
        LBAR();
        { const int k = tid & 63, sg = tid >> 6; float run = 0.f;
#pragma unroll
          for (int u = 0; u < 8; ++u) { run += Lbuf[(sg * 8 + u) * 64 + k]; Lbuf[(sg * 8 + u) * 64 + k] = run; }
          Lseg[sg * 64 + k] = run; }
        LBAR();
        f32x4 Lt[2], Lp[2], Lc[2];
        { const int sg = pt >> 3, sgp = (pt - 1) >> 3;
#pragma unroll
          for (int e = 0; e < 2; ++e) { f32x4 o0 = {0.f, 0.f, 0.f, 0.f}, o1 = o0, oc = o0;
#pragma unroll
              for (int u = 0; u < 8; ++u) { const f32x4 sv = *(const LAS f32x4*)(Lseg + u * 64 + cg * 8 + 4 * e); if (u < sg) o0 = o0 + sv; if (u < sgp) o1 = o1 + sv; if (u < 7) oc = oc + sv; }
              Lt[e] = *(const LAS f32x4*)(Lbuf + pt * 64 + cg * 8 + 4 * e) + o0;
              Lp[e] = pt > 0 ? *(const LAS f32x4*)(Lbuf + (pt - 1) * 64 + cg * 8 + 4 * e) + o1 : (f32x4){0.f, 0.f, 0.f, 0.f};
              Lc[e] = *(const LAS f32x4*)(Lbuf + 63 * 64 + cg * 8 + 4 * e) + oc; } }
        LBAR();
        {
            float at[8], bt[8], kt[8], rt[8], bh[8], kh[8], vv[8];
#pragma unroll
            for (int e = 0; e < 2; ++e)
#pragma unroll
                for (int u = 0; u < 4; ++u) { const int x = 4 * e + u; const float eL = __expf(Lt[e][u]), emL = __expf(-Lt[e][u]), eP = __expf(Lp[e][u]), eC = __expf(Lc[e][u] - Lt[e][u]);
                    at[x] = -kk[e][u] * eP; bt[x] = bq[e][u] * emL; kt[x] = kd[e][u] * emL; rt[x] = rx[e][u] * eL; bh[x] = bq[e][u] * eC; kh[x] = kd[e][u] * eC; vv[x] = vx[e][u];
                    if (pt == 63) GC[cg * 8 + x] = eL; }
#define ST8(bufi, arr) do { u32x4 w_ = {pk2(arr[0], arr[1]), pk2(arr[2], arr[3]), pk2(arr[4], arr[5]), pk2(arr[6], arr[7])}; *(LAS u32x4*)(BUF(bufi) + (pt * P + cg * 8) * 2) = w_; } while (0)
            ST8(0, at); ST8(1, bt); ST8(2, kt); ST8(3, rt); ST8(8, bh); ST8(9, kh); ST8(10, vv);
#undef ST8
        }
        LBAR();
        {
            const int k = tid & 63, tg = tid >> 6;
#define TR8(src, dst) do { unsigned w_[4]; _Pragma("unroll") for (int x = 0; x < 4; ++x) { const unsigned lo = *(const LAS bf16_t*)(BUF(src) + ((tg * 8 + 2 * x) * P + k) * 2), hi2 = *(const LAS bf16_t*)(BUF(src) + ((tg * 8 + 2 * x + 1) * P + k) * 2); w_[x] = lo | (hi2 << 16); } \
                *(LAS u32x4*)(BUF(dst) + (k * P + tg * 8) * 2) = (u32x4){w_[0], w_[1], w_[2], w_[3]}; } while (0)
            TR8(0, 4); TR8(8, 5); TR8(9, 6); TR8(10, 7);
#undef TR8
        }
        LBAR();
        const f32x4 Z4 = {0.f, 0.f, 0.f, 0.f};
        const f32x16 Z16 = {0.f, 0.f, 0.f, 0.f, 0.f, 0.f, 0.f, 0.f, 0.f, 0.f, 0.f, 0.f, 0.f, 0.f, 0.f, 0.f};
        const int r32 = lane & 31, hi = lane >> 5;
#pragma unroll 1
        for (int u = 0; u < 2; ++u) { const int tl = u * 8 + wid;
            if (tl >= 14) {
                if (tl == 14) { st32(BUF(8), 0, 1, r32, hi, Z16); st32(BUF(8), 1, 0, r32, hi, Z16); st32(BUF(14), 0, 1, r32, hi, Z16); st32(BUF(14), 1, 0, r32, hi, Z16); st32(BUF(9), 1, 0, r32, hi, Z16); }
                else { st32(BUF(15), 1, 0, r32, hi, Z16); st32(BUF(13), 1, 0, r32, hi, Z16); st32(BUF(10), 1, 0, r32, hi, Z16); st32(BUF(11), 1, 0, r32, hi, Z16); st32(BUF(12), 1, 0, r32, hi, Z16); }
                break; }
            const int m = (tl + 1) / 3, rr = (tl + 1) % 3, ti = rr == 2, tj = m == 0 ? ti : (rr >= 1); const int jj = 32 * tj + r32;
            if (m == 0) { f32x16 v = mm32(BUF(0), BUF(1), ti, tj, r32, hi, Z16), w;
#pragma unroll
                for (int e = 0; e < 16; ++e) { const int ii = 32 * ti + 8 * (e >> 2) + 4 * hi + (e & 3); const bool dg = (ii >> 4) == (jj >> 4);
                    v[e] = (dg && jj < ii) ? v[e] : 0.f; w[e] = v[e] + ((ii == jj) ? 1.f : 0.f); }
                st32(BUF(8), ti, tj, r32, hi, v); st32(BUF(14), ti, tj, r32, hi, w); }
            else if (m == 1) { const f32x16 v = mm32(BUF(1), BUF(0), ti, tj, r32, hi, Z16); f32x16 vd, vo, w;
#pragma unroll
                for (int e = 0; e < 16; ++e) { const int ii = 32 * ti + 8 * (e >> 2) + 4 * hi + (e & 3); const bool dg = (ii >> 4) == (jj >> 4), up = ii < jj;
                    vd[e] = (dg && up) ? v[e] : 0.f; vo[e] = (!dg && up) ? v[e] : 0.f; w[e] = vd[e] + ((ii == jj) ? 1.f : 0.f); }
                st32(BUF(9), ti, tj, r32, hi, vd); st32(BUF(15), ti, tj, r32, hi, vo); st32(BUF(13), ti, tj, r32, hi, w); }
            else if (m == 2) { f32x16 v = mm32(BUF(2), BUF(0), ti, tj, r32, hi, Z16);
#pragma unroll
                for (int e = 0; e < 16; ++e) { const int ii = 32 * ti + 8 * (e >> 2) + 4 * hi + (e & 3); v[e] = ii < jj ? v[e] : 0.f; }
                st32(BUF(10), ti, tj, r32, hi, v); }
            else { f32x16 v = mm32(m == 3 ? BUF(1) : BUF(2), BUF(3), ti, tj, r32, hi, Z16);
#pragma unroll
                for (int e = 0; e < 16; ++e) { const int ii = 32 * ti + 8 * (e >> 2) + 4 * hi + (e & 3); v[e] = ii <= jj ? v[e] : 0.f; }
                st32(m == 3 ? BUF(11) : BUF(12), ti, tj, r32, hi, v); } }
        LBAR();
#define WSYNC() asm volatile("s_waitcnt lgkmcnt(0)" ::: "memory")
        if (wid < 4) {
            const int tt = wid;
#define SQD(sr, st, dr, dt) do { const f32x4 a_ = mm_diag(BUF(st), BUF(sr), tt, c, q, Z4), b_ = mm_diag(BUF(sr), BUF(st), tt, c, q, Z4); WSYNC(); \
                st_tile(BUF(dr), tt, tt, c, q, a_); st_tile(BUF(dt), tt, tt, c, q, b_); WSYNC(); } while (0)
#define UPD(pr) do { const f32x4 dt_ = mm_diag(BUF(pr), BUF(13), tt, c, q, ld_tile(BUF(13), tt, tt, c, q)); \
                const f32x4 dr_ = mm_diag(BUF(13), BUF(pr), tt, c, q, ld_tile(BUF(14), tt, tt, c, q)); WSYNC(); \
                st_tile(BUF(13), tt, tt, c, q, dt_); st_tile(BUF(14), tt, tt, c, q, dr_); WSYNC(); } while (0)
            SQD(8, 9, 0, 1); UPD(0); SQD(0, 1, 8, 9); UPD(8); SQD(8, 9, 0, 1); UPD(0);
#undef SQD
#undef UPD
        } else {
            const int ti = (wid >> 1) & 1, tj = wid & 1; st32(BUF(2), ti, tj, r32, hi, mm32(BUF(10), BUF(7), ti, tj, r32, hi, Z16));
        }
        LBAR();
        { const int m = wid >> 2, ti = (wid >> 1) & 1, tj = wid & 1;
          if (m == 0) st32(BUF(8), ti, tj, r32, hi, mm32(BUF(15), BUF(14), ti, tj, r32, hi, Z16));
          else        st32(BUF(9), ti, tj, r32, hi, mm32(BUF(14), BUF(15), ti, tj, r32, hi, Z16)); }
        LBAR();
        if (wid < 4) { const int ti = (wid >> 1) & 1, tj = wid & 1; st32(BUF(0), ti, tj, r32, hi, mm32(BUF(9), BUF(8), ti, tj, r32, hi, Z16)); }
        LBAR();
        if (wid < 4) { const int ti = (wid >> 1) & 1, tj = wid & 1; st32(BUF(1), ti, tj, r32, hi, mm32(BUF(0), BUF(13), ti, tj, r32, hi, ld32(BUF(13), ti, tj, r32, hi))); }
        LBAR();
        if (wid < 4) { const int ti = (wid >> 1) & 1, tj = wid & 1; st32(BUF(14), ti, tj, r32, hi, mm32(BUF(8), BUF(1), ti, tj, r32, hi, ld32(BUF(1), ti, tj, r32, hi))); }
        LBAR();
        { const int m = wid >> 2, ti = (wid >> 1) & 1, tj = wid & 1;
          if (m == 0) st32(BUF(8), ti, tj, r32, hi, mm32(BUF(14), BUF(4), ti, tj, r32, hi, Z16));
          else        st32(BUF(0), ti, tj, r32, hi, mm32(BUF(14), BUF(2), ti, tj, r32, hi, Z16)); }
        LBAR();
        bf16_t* ckp = CK + (size_t)it * 4 * 4096;
#pragma unroll 1
        for (int u = 0; u < 2; ++u) { const int tl = u * 8 + wid, m = tl >> 2, ti = (tl >> 1) & 1, tj = tl & 1;
            if (m == 0) { f32x16 v = mm32(BUF(8), BUF(5), ti, tj, r32, hi, Z16); const int jj = 32 * tj + r32; const float gc = GC[jj];
#pragma unroll
                for (int e = 0; e < 16; ++e) { const int ii = 32 * ti + 8 * (e >> 2) + 4 * hi + (e & 3); v[e] += (ii == jj) ? gc : 0.f; }
                st32(BUF(1), ti, tj, r32, hi, v); }
            else if (m == 1) st32(BUF(4), ti, tj, r32, hi, mm32(BUF(8), BUF(11), ti, tj, r32, hi, ld32(BUF(3), ti, tj, r32, hi)));
            else if (m == 2) st32(BUF(2), ti, tj, r32, hi, mm32(BUF(6), BUF(7), ti, tj, r32, hi, mm32(BUF(5), BUF(0), ti, tj, r32, hi, Z16)));
            else             st32(BUF(9), ti, tj, r32, hi, mm32(BUF(7), BUF(12), ti, tj, r32, hi, mm32(BUF(0), BUF(11), ti, tj, r32, hi, Z16))); }
        LBAR();
        { const int orow = tid >> 3, oc = (tid & 7) * 8;
          *(u32x4*)(ckp + orow * 64 + oc) = *(const LAS u32x4*)(BUF(1) + (orow * P + oc) * 2);
          *(u32x4*)(ckp + 4096 + orow * 64 + oc) = *(const LAS u32x4*)(BUF(2) + (orow * P + oc) * 2);
          *(u32x4*)(ckp + 2 * 4096 + orow * 64 + oc) = *(const LAS u32x4*)(BUF(4) + (orow * P + oc) * 2);
          *(u32x4*)(ckp + 3 * 4096 + orow * 64 + oc) = *(const LAS u32x4*)(BUF(9) + (orow * P + oc) * 2); }
    }
#undef BUF
#undef SC1_LOAD
}

__device__ void ph_rw_sc2(const Params& p, char* lds) {
    using namespace ck;
    const int tid = tidx(), wid = __builtin_amdgcn_readfirstlane(tid >> 6), lane = tid & 63, c = lane & 15, q = lane >> 4;
    const size_t PL = (size_t)NROW * D;
    const bf16_t* CK = (const bf16_t*)(p.ws + OFF_CK); bf16_t* Y = (bf16_t*)(p.ws + OFF_Y);
    lchar* GB = (lchar*)lds;
    lchar* RB = GB + 2 * MB;
    lchar* SB = GB + 4 * MB;
    constexpr int SBB = 32 * P * 2;
    for (int it = bidx(); it < 256; it += gdim()) {
        const int vh = it & 1, seq = it >> 1, z = seq & 1, h = (seq >> 1) & 15, b = seq >> 5;
        const bf16_t* ck0 = CK + (size_t)seq * NCHK * 4 * 4096;
        const int s_ti = wid & 3, s_tj = wid >> 2;
        const int y_ti = wid & 1, y_tj = wid >> 1;
        const int hoff = 4096 + (vh * 32 + 16 * s_tj + c) * 64 + 16 * s_ti + 4 * q, yoff = 3 * 4096 + (16 * y_tj + c) * 64 + vh * 32 + 16 * y_ti + 4 * q;
        struct PF { u32x4 g, r; uint2 h, y; };
#define PF_LOAD(X, k) do { const bf16_t* cc_ = ck0 + (size_t)(k) * 4 * 4096; X.h = *(const uint2*)(cc_ + hoff); X.y = *(const uint2*)(cc_ + yoff); X.g = *(const u32x4*)(cc_ + tid * 8); X.r = *(const u32x4*)(cc_ + 2 * 4096 + tid * 8); } while (0)
#define PF_STAGE(X, bufi) do { *(LAS u32x4*)(GB + (bufi) * MB + ((tid >> 3) * P + (tid & 7) * 8) * 2) = X.g; *(LAS u32x4*)(RB + (bufi) * MB + ((tid >> 3) * P + (tid & 7) * 8) * 2) = X.r; } while (0)
#define SC2_STEP(k, CUR, NXT) do { const uint2 hi_ = CUR.h, yi_ = CUR.y; const int cur = (k) & 1; \
            if ((k) + 4 < NCHK) PF_LOAD(CUR, (k) + 4); \
            const f32x4 hinit = {__uint_as_float(hi_.x << 16), __uint_as_float(hi_.x & 0xffff0000u), __uint_as_float(hi_.y << 16), __uint_as_float(hi_.y & 0xffff0000u)}; \
            const f32x4 yinit = {__uint_as_float(yi_.x << 16), __uint_as_float(yi_.x & 0xffff0000u), __uint_as_float(yi_.y << 16), __uint_as_float(yi_.y & 0xffff0000u)}; \
            const lchar* Sold = SB + cur * SBB; lchar* Snew = SB + (cur ^ 1) * SBB; \
            const f32x4 sn = mm_tile(GB + cur * MB, Sold, s_ti, s_tj, c, q, hinit);        \
            const f32x4 yv = mm_tile(Sold, RB + cur * MB, y_ti, y_tj, c, q, yinit);        \
            st_tile(Snew, s_ti, s_tj, c, q, sn); \
            { const int row = scan_row((k) * 64 + 16 * y_tj + c, b, z); stbf4(Y + z * PL + (size_t)row * D + h * 64 + vh * 32 + 16 * y_ti + 4 * q, yv); } \
            if ((k) + 1 < NCHK) PF_STAGE(NXT, cur ^ 1); \
            LBAR(); } while (0)
        PF s0, s1, s2, s3;
        PF_LOAD(s0, 0); PF_LOAD(s1, 1); PF_LOAD(s2, 2); PF_LOAD(s3, 3);
        LBAR();
        for (int i = tid; i < SBB / 4; i += NTHR) ((LAS unsigned*)SB)[i] = 0u;
        PF_STAGE(s0, 0);
        LBAR();
        for (int ch = 0; ch < NCHK; ch += 4) {
            SC2_STEP(ch, s0, s1); SC2_STEP(ch + 1, s1, s2); SC2_STEP(ch + 2, s2, s3); SC2_STEP(ch + 3, s3, s0);
        }
#undef PF_LOAD
#undef PF_STAGE
#undef SC2_STEP
    }
}
#undef LBAR

__device__ void ph_rw_out(const Params& p, int j, int nrows) {
    const int wid = tidx() >> 6, lane = tidx() & 63;
    const bf16_t* RKV = (const bf16_t*)(p.ws + OFF_RKV); const bf16_t* AV = (const bf16_t*)(p.ws + OFF_AV); const bf16_t* G = (const bf16_t*)(p.ws + OFF_G); const bf16_t* Y = (const bf16_t*)(p.ws + OFF_Y);
    bf16_t* OUT = (bf16_t*)(p.ws + OFF_H);
    const size_t PL = (size_t)NROW * D;
    const float* r_k = p.rw_r_k + j * D; const float* lg = p.rw_lnx_g + j * D; const float* lb = p.rw_lnx_b + j * D; const float* k_a = p.rw_k_a + j * D;
    uint2 nb[8][4];
#define OUT_LOAD(R) do { _Pragma("unroll") for (int i = 0; i < 4; ++i) { const size_t o_ = (size_t)(R) * D + lane * 4 + i * 256; \
        nb[0][i] = *(const uint2*)(Y + o_); nb[1][i] = *(const uint2*)(Y + PL + o_); nb[2][i] = *(const uint2*)(RKV + o_); nb[3][i] = *(const uint2*)(RKV + PL + o_); \
        nb[4][i] = *(const uint2*)(RKV + 2 * PL + o_); nb[5][i] = *(const uint2*)(AV + o_); nb[6][i] = *(const uint2*)(AV + PL + o_); nb[7][i] = *(const uint2*)(G + o_); } } while (0)
#define UNPK(w) ((f32x4){__uint_as_float((w).x << 16), __uint_as_float((w).x & 0xffff0000u), __uint_as_float((w).y << 16), __uint_as_float((w).y & 0xffff0000u)})
    int row = bidx() * 8 + wid;
    if (row < nrows) OUT_LOAD(row);
    for (; row < nrows; row += gdim() * 8) {
        uint2 cb[8][4];
#pragma unroll
        for (int q_ = 0; q_ < 8; ++q_)
#pragma unroll
            for (int i = 0; i < 4; ++i) cb[q_][i] = nb[q_][i];
        { const int nrow = row + gdim() * 8; if (nrow < nrows) OUT_LOAD(nrow); }
#pragma unroll
        for (int i = 0; i < 4; ++i) {
            const size_t o = (size_t)row * D + lane * 4 + i * 256; const int c = lane * 4 + i * 256;
            const f32x4 y = UNPK(cb[0][i]) + UNPK(cb[1][i]);
            const float mean = dpp_sum16(y[0] + y[1] + y[2] + y[3]) * (1.f / 64.f);
            const f32x4 dd = y - mean;
            const float rstd = rsqrtf(dpp_sum16(dd[0] * dd[0] + dd[1] * dd[1] + dd[2] * dd[2] + dd[3] * dd[3]) * (1.f / 64.f) + LNX_EPS);
            const f32x4 r = UNPK(cb[2][i]), k = UNPK(cb[3][i]), v = UNPK(cb[4][i]);
            const f32x4 a0 = UNPK(cb[5][i]), a1 = UNPK(cb[6][i]);
            const f32x4 kds = k * (2.f + (a0 + a1 - 2.f) * *(const f32x4*)(k_a + c));
            const f32x4 t4 = r * kds * *(const f32x4*)(r_k + c);
            const float bs = dpp_sum16(t4[0] + t4[1] + t4[2] + t4[3]);
            const f32x4 res = (dd * rstd * *(const f32x4*)(lg + c) + *(const f32x4*)(lb + c) + bs * v) * UNPK(cb[7][i]);
            uint2 w; w.x = pk2(res[0], res[1]); w.y = pk2(res[2], res[3]); *(uint2*)(OUT + o) = w;
        }
    }
#undef OUT_LOAD
#undef UNPK
}

__device__ void ph_final(const Params& p) {
    const int wid = tidx() >> 6, lane = tidx() & 63;
    const float* X = (const float*)(p.ws + OFF_X);
    for (int row = bidx() * 8 + wid; row < NLAT; row += gdim() * 8) {
        const float4* xr = (const float4*)(X + (size_t)row * D);
        float4 v[4]; float ss = 0;
#pragma unroll
        for (int i = 0; i < 4; ++i) { v[i] = xr[lane + i * 64]; ss += v[i].x * v[i].x + v[i].y * v[i].y + v[i].z * v[i].z + v[i].w * v[i].w; }
        ss = wave_sum(ss); const float rs = rsqrtf(ss * (1.f / D) + RMS_EPS);
#pragma unroll
        for (int i = 0; i < 4; ++i) { const int d = (lane + i * 64) * 4; const float4 gg = *(const float4*)(p.final_g + d);
            float4 o; o.x = v[i].x * rs * gg.x; o.y = v[i].y * rs * gg.y; o.z = v[i].z * rs * gg.z; o.w = v[i].w * rs * gg.w;
            *(float4*)(p.out + (size_t)row * D + d) = o; }
    }
}

enum { PH_INIT = 0, PH_A_NORM, PH_A_Z, PH_A_MID, PH_A_QKV, PH_A_POST, PH_A_ATTN, PH_A_WO,
       PH_R_NORM, PH_R_XS, PH_R_G1, PH_R_G2, PH_R_PREP, PH_R_SCAN, PH_R_OUT, PH_R_WO,
       PH_M_NORM, PH_M_SEL, PH_M_GATHER, PH_M_G1, PH_M_G2, PH_M_COMB, PH_FINAL, PH_M_CVT, PH_R_SC1, PH_R_SC2 };

#ifndef BG_Z
#define BG_Z 4
#define BG_ATTN 2
#define BG_WO 3
#define BG_RG1 6
#define BG_MG1 4
#define BG_MG2 6
#endif
template <int PH>
__device__ __forceinline__ void run_phase(const Params& p, int layer, char* lds) {
    const int j = layer >> 1;
    char* ws = p.ws;
    if constexpr (PH == PH_INIT) { ph_init(p, lds); __syncthreads(); ph_small_cvt(p, lds); }
    else if constexpr (PH == PH_A_NORM) { if (layer == 0) ph_norm_mod<false>(p, layer, p.norm1_g + layer * D, 0, 1, ws + OFF_H); else ph_comb_norm<false>(p, layer - 1, layer, NROW); }
    else if constexpr (PH == PH_A_Z) {
        float* Z = (float*)(ws + OFF_Z);
        g8::BatchSched S{ws + OFF_H, ws + OFF_WMLA + j * SZ_WMLA + WM_IN, 0, 0, NROW / 256, 2, 1, D};
        g8::gemm_phase(p.wv, (PG8_LAS unsigned char*)lds, D, S, g8::epi_rc([=](const g8::Unit&, int row, int col, f32x4 v) { *(f32x4*)(Z + (size_t)row * 512 + col) = v; }));
        if (idle_tail(NROW / 256 * 2)) bg_cvt(p, layer, lds, BG_Z);
    }
    else if constexpr (PH == PH_A_MID) ph_mla_mid(p, j);
    else if constexpr (PH == PH_A_QKV) {
        bf16_t* Q = (bf16_t*)(ws + OFF_Q); bf16_t* K = (bf16_t*)(ws + OFF_K); bf16_t* V = (bf16_t*)(ws + OFF_V);
        g8::BatchSched S1{ws + OFF_CQN, ws + OFF_WMLA + j * SZ_WMLA + WM_UQ, 0, 0, NROW / 256, 6, 1, 256, 1};
        g8::gemm_phase(p.wv, (PG8_LAS unsigned char*)lds, 256, S1, g8::epi_rc([=](const g8::Unit&, int row, int col, f32x4 v) {
            const bool lat = row < NLAT; const int b = lat ? (row >> 12) : ((row - NLAT) >> 8); const int tk = lat ? 256 + (row & (TL - 1)) : ((row - NLAT) & 255);
            const int h = col / 192, d = col - h * 192;
            uint2 w; w.x = pk2(v[0], v[1]); w.y = pk2(v[2], v[3]);
            *(uint2*)(Q + ((size_t)(b * 8 + h) * TK + tk) * 192 + d) = w; }));
        g8::BatchSched S2{ws + OFF_CKVN, ws + OFF_WMLA + j * SZ_WMLA + WM_UKV, 0, 0, NROW / 256, 8, 1, 128};
        g8::gemm_phase(p.wv, (PG8_LAS unsigned char*)lds, 128, S2, g8::epi_rc([=](const g8::Unit&, int row, int col, f32x4 v) {
            const bool lat = row < NLAT; const int b = lat ? (row >> 12) : ((row - NLAT) >> 8); const int tk = lat ? 256 + (row & (TL - 1)) : ((row - NLAT) & 255);
            const int h = col >> 8, d = col & 255; const size_t orow = (size_t)(b * 8 + h) * TK + tk;
            uint2 w; w.x = pk2(v[0], v[1]); w.y = pk2(v[2], v[3]);
            if (d < 128) *(uint2*)(K + orow * 192 + d) = w; else *(uint2*)(V + orow * 128 + (d - 128)) = w; }));
    }
    else if constexpr (PH == PH_A_ATTN) { ph_attn(p, lds); if (idle_tail(544)) bg_cvt(p, layer, lds, BG_ATTN); }
    else if constexpr (PH == PH_A_WO || PH == PH_R_WO) {
        xt_t* X = (xt_t*)(ws + OFF_X); const float* MOD = (const float*)(ws + OFF_MOD);
        g8::BatchSched S{ws + (PH == PH_A_WO ? OFF_O : OFF_H), PH == PH_A_WO ? ws + OFF_WMLA + j * SZ_WMLA + WM_O : ws + OFF_WRW + j * SZ_WRW + WR_O, 0, 0, (layer < 3 ? NROW : NLAT) / 256, 4, 1, D};
        g8::gemm_phase(p.wv, (PG8_LAS unsigned char*)lds, D, S, g8::EpiResid{X, MOD, layer});
        if (idle_tail((layer < 3 ? NROW : NLAT) / 256 * 4)) bg_cvt(p, layer, lds, BG_WO);
    }
    else if constexpr (PH == PH_R_XS) ph_rw_normxs(p, layer, j);
    else if constexpr (PH == PH_R_G1) {
        bf16_t* RKV = (bf16_t*)(ws + OFF_RKV); bf16_t* VF = (bf16_t*)(ws + OFF_VFIRST);
        bf16_t* A2 = (bf16_t*)(ws + OFF_A2); bf16_t* A3 = (bf16_t*)(ws + OFF_A3);
        const bool first = (j == 0);
        struct RSched { const char* XS; const char* WB; int nwg;
            __device__ __forceinline__ bool next(int i, g8::Unit& u) const {
                const int L = i * gdim() + bidx(); if (L >= nwg) return false;
                const int w = g8::xcd_remap(L, nwg);
                if (w < 816) { u.g = w / 272; const int r = w % 272; u.pm = r >> 2; u.pn = r & 3; u.B = WB + WR_RKV + (size_t)u.g * D * D * 2 + (size_t)u.pn * 256 * D * 2; }
                else { u.g = 3 + (w - 816) / 68; u.pm = (w - 816) % 68; u.pn = 0; u.B = WB + WR_L + (size_t)(u.g - 3) * 256 * D * 2; }
                u.A = XS + (size_t)(u.g == 6 ? 2 : u.g) * NROW * D * 2 + (size_t)u.pm * 256 * D * 2; return true; } };
        RSched S{ws + OFF_XS, ws + OFF_WRW + j * SZ_WRW, first ? 816 + 204 : 816 + 272};
        g8::gemm_phase(p.wv, (PG8_LAS unsigned char*)lds, D, S, g8::epi_rc([=](const g8::Unit& u, int row, int col, f32x4 v) {
            if (u.g < 3) { stbf4(RKV + ((size_t)u.g * NROW + row) * D + col, v); if (first && u.g == 2) stbf4(VF + (size_t)row * D + col, v); }
            else if (col < 128) {
                f32x4 t = v;
                if (u.g == 3) { for (int e = 0; e < 4; ++e) t[e] = 1.f - 2.f * __builtin_amdgcn_rcpf(1.f + __expf(2.f * v[e])); }
                else if (u.g == 5) { for (int e = 0; e < 4; ++e) t[e] = sigmoidf_(v[e]); }
                bf16_t* dst = (u.g == 3 ? A2 : u.g == 4 ? A2 + (size_t)NROW * 128 : u.g == 5 ? A3 : A3 + (size_t)NROW * 128);
                stbf4(dst + (size_t)row * 128 + col, t); } }));
        if (idle_tail(S.nwg)) bg_cvt(p, layer, lds, BG_RG1);
    }
    else if constexpr (PH == PH_R_G2) {
        const bool first = (j == 0);
        float* W = (float*)(ws + OFF_W); bf16_t* AV = (bf16_t*)(ws + OFF_AV); bf16_t* G = (bf16_t*)(ws + OFF_G); bf16_t* RKV = (bf16_t*)(ws + OFF_RKV); const bf16_t* VF = (const bf16_t*)(ws + OFF_VFIRST);
        const float* w0 = p.rw_w0 + (size_t)j * 2 * D; const float* a0 = p.rw_a0 + (size_t)j * 2 * D; const float* v0 = p.rw_v0;
        g8::BatchSched S1{ws + OFF_A2, ws + OFF_WRW + j * SZ_WRW + WR_B2, (size_t)NROW * 128 * 2, (size_t)2048 * 128 * 2, NROW / 256, 8, 2, 128};
        g8::gemm_phase(p.wv, (PG8_LAS unsigned char*)lds, 128, S1, g8::epi_colfirst([=](const g8::Unit& u, int row, int col, f32x4 v, f32x4 bias) {
            const int zz = u.pn >> 2, c = col & 1023; const bool dec = u.g == 0;
            const size_t doff = (size_t)zz * NROW * D + (size_t)row * D + c;
            const f32x4 x = v + bias; f32x4 o;
#pragma unroll
            for (int e = 0; e < 4; ++e) { const float sg = __builtin_amdgcn_rcpf(1.f + __expf(-x[e])); o[e] = dec ? (-0.6065306597126334f * sg) : sg; }
            if (dec) *(f32x4*)(W + doff) = o; else stbf4(AV + doff, o); },
            [=](const g8::Unit& u, int col) { const int zz = u.pn >> 2, c = col & 1023; return *(const f32x4*)((u.g == 0 ? w0 : a0) + zz * D + c); }));
        g8::BatchSched S2{ws + OFF_A3, ws + OFF_WRW + j * SZ_WRW + WR_B3, (size_t)NROW * 128 * 2, (size_t)1024 * 128 * 2, NROW / 256, 4, first ? 1 : 2, 128, 1};
        g8::gemm_phase(p.wv, (PG8_LAS unsigned char*)lds, 128, S2, g8::epi_rc([=](const g8::Unit& u, int row, int col, f32x4 v) {
            if (u.g == 0) stbf4(G + (size_t)row * D + col, v);
            else { const size_t o = (size_t)row * D + col; const f32x4 vv = ldbf4(RKV + (size_t)2 * NROW * D + o), vf = ldbf4(VF + o), gz = v + *(const f32x4*)(v0 + col); f32x4 r;
#pragma unroll
                for (int e = 0; e < 4; ++e) r[e] = vv[e] + (vf[e] - vv[e]) * __builtin_amdgcn_rcpf(1.f + __expf(-gz[e]));
                stbf4(RKV + (size_t)2 * NROW * D + o, r); } }));
    }
    else if constexpr (PH == PH_R_SCAN) ph_rw_scan(p, j, lds);
    else if constexpr (PH == PH_R_SC1) ph_rw_sc1(p, j, lds);
    else if constexpr (PH == PH_R_SC2) ph_rw_sc2(p, lds);
    else if constexpr (PH == PH_R_OUT) ph_rw_out(p, j, layer < 3 ? NROW : NLAT);
    else if constexpr (PH == PH_M_NORM) ph_norm2_router_mm(p, layer, lds, layer < 3 ? NROW : NLAT);
    else if constexpr (PH == PH_M_SEL) { ph_select(p, lds, layer < 3 ? 128 : 64); __syncthreads(); moe_cvt(p, layer, lds, -1); }
    else if constexpr (PH == PH_M_GATHER) ph_gather(p, layer < 3 ? ESLOTS : NB * CAPL);
    else if constexpr (PH == PH_M_G1) {
        bf16_t* HID = (bf16_t*)(ws + OFF_HID);
        g8::BatchSched S{ws + OFF_XE, ws + OFF_W13T + (size_t)(layer & 1) * SZ_WMOE, (size_t)EPAD * D * 2, (size_t)2816 * D * 2, layer < 3 ? 9 : 8, 11, NE, D};
        g8::gemm_phase(p.wv, (PG8_LAS unsigned char*)lds, D, S, g8::epi_pair([=](const g8::Unit& u, int row, int col, f32x4 a, f32x4 b) {
            uint2 w; w.x = pk2(a[0] * __builtin_amdgcn_rcpf(1.f + __expf(-a[0])) * b[0], a[1] * __builtin_amdgcn_rcpf(1.f + __expf(-a[1])) * b[1]); w.y = pk2(a[2] * __builtin_amdgcn_rcpf(1.f + __expf(-a[2])) * b[2], a[3] * __builtin_amdgcn_rcpf(1.f + __expf(-a[3])) * b[3]);
            *(uint2*)(HID + ((size_t)u.g * EPAD + row) * FF + col) = w; }));
        if (layer < 3 && idle_tail(9 * 11 * NE)) moe_cvt(p, layer + 1, lds, BG_MG1);
    }
    else if constexpr (PH == PH_M_G2) {
        bf16_t* YE = (bf16_t*)(ws + OFF_YE); const float* GATE = (const float*)(ws + OFF_GATE);
        g8::BatchSched S{ws + OFF_HID, ws + OFF_W2T + (size_t)(layer & 1) * SZ_WMOE, (size_t)EPAD * FF * 2, (size_t)D * FF * 2, layer < 3 ? 9 : 8, 4, NE, FF};
        g8::gemm_phase(p.wv, (PG8_LAS unsigned char*)lds, FF, S, g8::epi_pre([=](const g8::Unit& u, int row, int col, f32x4 v, f32x4, float gt) {
            uint2 w; w.x = pk2(v[0] * gt, v[1] * gt); w.y = pk2(v[2] * gt, v[3] * gt);
            *(uint2*)(YE + ((size_t)u.g * EPAD + row) * D + col) = w; },
            [=](const g8::Unit&, int) { return (f32x4){0.f, 0.f, 0.f, 0.f}; }, [=](const g8::Unit& u, int row) { return GATE[u.g * EPAD + row]; }));
        if (layer < 3 && idle_tail(9 * 4 * NE)) moe_cvt(p, layer + 1, lds, BG_MG2);
    }
    else if constexpr (PH == PH_M_COMB) ph_combine(p, layer, layer < 3 ? NROW : NLAT);
    else if constexpr (PH == PH_M_CVT) moe_cvt(p, layer, lds, -1);
    else if constexpr (PH == PH_FINAL) ph_comb_norm<true>(p, 3, 0, NLAT);
}

#if ONE_LAUNCH
#define SYNC() xcd_barrier(bar)
#ifndef PROBE_PH
#define PROBE_PH -1
#endif
#ifndef PROBE_REP
#define PROBE_REP 1
#endif
__device__ __forceinline__ Params load_params() {
    Params q{};
#if defined(__HIP_DEVICE_COMPILE__)
    typedef const __attribute__((address_space(4))) unsigned long long* KargP;
    KargP kp_ = (KargP)__builtin_amdgcn_kernarg_segment_ptr(); asm volatile("" : "+s"(kp_));
#pragma unroll
    for (int i = 0; i < 40; ++i) ((const float**)&q)[i] = (const float*)(const __attribute__((address_space(1))) float*)kp_[i];
#endif
    return q;
}
#define RUN(PH) do { for (int rep_ = 0; rep_ < ((PH) == PROBE_PH ? PROBE_REP : 1); ++rep_) { Params q = load_params(); q.wv = wv0_; run_phase<PH>(q, layer, smem); SYNC(); } } while (0)
__global__ void __launch_bounds__(NTHR, 2) mega(Params p) {
    extern __shared__ __attribute__((aligned(16))) char smem[];
    const int wv0_ = __builtin_amdgcn_readfirstlane((int)threadIdx.x >> 6);
    if (threadIdx.x == 0) *(uint4*)(smem + LDS_BYTES) = make_uint4(0u, 0u, 0u, 0u);
    __syncthreads();
    XcdBarrier bar = xcd_barrier_post((unsigned*)(p.ws + OFF_BAR), (volatile LAS unsigned*)(smem + LDS_BYTES));
    { const int layer = 0; RUN(PH_INIT); }
    for (int layer = 0; layer < 4; ++layer) {
        if ((layer & 1) == 0) {
            RUN(PH_A_NORM);
            RUN(PH_A_Z);
            RUN(PH_A_MID);
            RUN(PH_A_QKV);
            RUN(PH_A_ATTN);
            RUN(PH_A_WO);
        } else {
            RUN(PH_R_XS);
            RUN(PH_R_G1);
            RUN(PH_R_G2);
            RUN(PH_R_SC1);
            RUN(PH_R_SC2);
            RUN(PH_R_OUT);
            RUN(PH_R_WO);
        }
        RUN(PH_M_NORM);
        RUN(PH_M_SEL);
        RUN(PH_M_G1);
        RUN(PH_M_G2);
        if ((layer & 1) == 0) RUN(PH_M_COMB);
    }
    { Params q = load_params(); q.wv = wv0_; run_phase<PH_FINAL>(q, 0, smem); }
}
#else
template <int PH> __global__ void __launch_bounds__(NTHR, 2) kph(Params p, int layer) {
    extern __shared__ __attribute__((aligned(16))) char smem[];
    Params q = p; q.wv = __builtin_amdgcn_readfirstlane((int)threadIdx.x >> 6);
    run_phase<PH>(q, layer, smem);
}
#endif

extern "C" void kernel_launch(void* const* d_in, const int* in_sizes, int n_in, void* d_out, int out_size, void* d_ws, size_t ws_size, hipStream_t stream) {
    if (n_in != 38 || ws_size < WS_NEED) { fprintf(stderr, "kernel_launch: bad args n_in %d ws %zu need %zu\n", n_in, ws_size, (size_t)WS_NEED); return; }
    Params p{};
    const float** pp = (const float**)&p;
    for (int i = 0; i < 38; ++i) pp[i] = (const float*)d_in[i];
    p.out = (float*)d_out; p.ws = (char*)d_ws;
    static int cus = 0;
    if (!cus) { int dev = 0; hipGetDevice(&dev); hipDeviceGetAttribute(&cus, hipDeviceAttributeMultiprocessorCount, dev); if (cus <= 0) cus = 256; }
    const int grid = cus;
#if ONE_LAUNCH
    hipFuncSetAttribute((const void*)mega, hipFuncAttributeMaxDynamicSharedMemorySize, LDS_BYTES + 16);
    hipMemsetAsync(d_ws, 0, 16384, stream);
    hipLaunchKernelGGL(mega, dim3(grid), dim3(NTHR), LDS_BYTES + 16, stream, p);
#else
    hipMemsetAsync(d_ws, 0, 16384, stream);
#define LAUNCH(PH, L) do { hipFuncSetAttribute((const void*)kph<PH>, hipFuncAttributeMaxDynamicSharedMemorySize, LDS_BYTES + 16); hipLaunchKernelGGL(kph<PH>, dim3(grid), dim3(NTHR), LDS_BYTES + 16, stream, p, L); } while (0)
    LAUNCH(PH_INIT, 0);
    for (int layer = 0; layer < 4; ++layer) {
        if ((layer & 1) == 0) { LAUNCH(PH_A_NORM, layer); LAUNCH(PH_A_Z, layer); LAUNCH(PH_A_MID, layer); LAUNCH(PH_A_QKV, layer); LAUNCH(PH_A_ATTN, layer); LAUNCH(PH_A_WO, layer); }
        else { LAUNCH(PH_R_XS, layer); LAUNCH(PH_R_G1, layer); LAUNCH(PH_R_G2, layer); LAUNCH(PH_R_SC1, layer); LAUNCH(PH_R_SC2, layer); LAUNCH(PH_R_OUT, layer); LAUNCH(PH_R_WO, layer); }
        LAUNCH(PH_M_NORM, layer); LAUNCH(PH_M_SEL, layer); LAUNCH(PH_M_G1, layer); LAUNCH(PH_M_G2, layer); if ((layer & 1) == 0) LAUNCH(PH_M_COMB, layer);
    }
    LAUNCH(PH_FINAL, 0);
#endif
}
```

```cpp
#include <hip/hip_runtime.h>
#include <stdint.h>
#include <stdio.h>

#ifndef ONE_LAUNCH
#define ONE_LAUNCH 1
#endif

#define NTHR 512
typedef unsigned short bf16_t;
typedef short bf16x8 __attribute__((ext_vector_type(8)));
typedef float f32x4 __attribute__((ext_vector_type(4)));
typedef unsigned u32x4 __attribute__((ext_vector_type(4)));
typedef unsigned u32x2 __attribute__((ext_vector_type(2)));

constexpr int D = 1024, NB = 4, TL = 4096, TC = 256, NLAT = NB * TL, NCTX = NB * TC, NROW = NLAT + NCTX;
constexpr int TK = TL + TC;
constexpr int NE = 16, FF = 1408, CAPL = 512, CAPC = 32, ESLOTS = NB * CAPL + NB * CAPC;
constexpr int EPAD = 2304;
constexpr float RMS_EPS = 1e-6f, LNX_EPS = 64e-5f;
constexpr float ATT_SCALE = 0.07216878364870322f;

constexpr size_t al256(size_t x) { return (x + 255) / 256 * 256; }
constexpr size_t OFF_BAR = 0;
constexpr size_t OFF_QUEUE = 14336;
constexpr size_t OFF_MOD = 16384;
constexpr size_t OFF_ROPE_C = OFF_MOD + al256(4 * 5 * 6144 * 4);
constexpr size_t OFF_ROPE_S = OFF_ROPE_C + al256(TL * 32 * 4);
constexpr size_t OFF_X = OFF_ROPE_S + al256(TL * 32 * 4);
constexpr size_t SZ_F32 = (size_t)NROW * D * 4, SZ_BF = (size_t)NROW * D * 2;
constexpr size_t OFF_VFIRST = OFF_X + SZ_BF;
constexpr size_t OFF_H = OFF_VFIRST + SZ_BF;
constexpr size_t SZ_WMLA = (size_t)(512 * 1024 + 1536 * 256 + 2048 * 256 + 1024 * 1024) * 2;
constexpr size_t WM_IN = 0, WM_UQ = (size_t)512 * 1024 * 2, WM_UKV = WM_UQ + (size_t)1536 * 256 * 2, WM_O = WM_UKV + (size_t)2048 * 256 * 2;
constexpr size_t SZ_WRW = (size_t)(3 * 1024 * 1024 + 4 * 256 * 1024 + 1024 * 1024 + 4096 * 256 + 2048 * 256) * 2;
constexpr size_t WR_RKV = 0, WR_L = (size_t)3 * 1024 * 1024 * 2, WR_O = WR_L + (size_t)4 * 256 * 1024 * 2, WR_B2 = WR_O + (size_t)1024 * 1024 * 2, WR_B3 = WR_B2 + (size_t)4096 * 256 * 2;
constexpr size_t OFF_WMLA = OFF_H + SZ_BF;
constexpr size_t OFF_WRW = OFF_WMLA + 2 * SZ_WMLA;
constexpr size_t OFF_W13T = OFF_WRW + 2 * SZ_WRW;
constexpr size_t OFF_W2T = OFF_W13T + (size_t)NE * 2816 * D * 2;
constexpr size_t SZ_WMOE = (size_t)NE * 2816 * D * 2 + (size_t)NE * D * FF * 2;
constexpr size_t OFF_S = OFF_W13T + 2 * SZ_WMOE;
constexpr size_t OFF_Z = OFF_S;
constexpr size_t OFF_CQN = OFF_Z + al256((size_t)NROW * 512 * 4);
constexpr size_t OFF_CKVN = OFF_CQN + al256((size_t)NROW * 256 * 2);
constexpr size_t OFF_KR = OFF_CKVN + al256((size_t)NROW * 256 * 2);
constexpr size_t OFF_QRAW = OFF_KR + al256((size_t)NROW * 64 * 4);
constexpr size_t OFF_KVRAW = OFF_QRAW + al256((size_t)NROW * 1536 * 4);
constexpr size_t OFF_Q = OFF_KVRAW + al256((size_t)NROW * 2048 * 4);
constexpr size_t OFF_K = OFF_Q + al256((size_t)NB * 8 * TK * 192 * 2);
constexpr size_t OFF_V = OFF_K + al256((size_t)NB * 8 * TK * 192 * 2);
constexpr size_t OFF_O = OFF_V + al256((size_t)NB * 8 * TK * 128 * 2);
constexpr size_t END_MLA = OFF_O + SZ_BF;
constexpr size_t OFF_XS = OFF_S;
constexpr size_t OFF_RKV = OFF_XS + 6 * SZ_BF;
constexpr size_t OFF_W = OFF_RKV + 3 * SZ_BF;
constexpr size_t OFF_AV = OFF_W + 2 * SZ_F32;
constexpr size_t OFF_G = OFF_AV + 2 * SZ_BF;
constexpr size_t OFF_A2 = OFF_G + SZ_BF;
constexpr size_t OFF_A3 = OFF_A2 + al256((size_t)NROW * 256 * 2);
constexpr size_t END_RW = OFF_A3 + al256((size_t)NROW * 256 * 2);
constexpr size_t OFF_Y = OFF_XS;
constexpr int NCHK = (TC + TL) / 64;
constexpr size_t OFF_CK = END_RW;
constexpr size_t END_RW2 = OFF_CK + (size_t)128 * NCHK * 4 * 4096 * 2;
constexpr size_t OFF_AFF = OFF_S;
constexpr size_t OFF_ROWIDX = OFF_AFF + al256((size_t)NROW * 16 * 4);
constexpr size_t OFF_GATE = OFF_ROWIDX + al256((size_t)NE * ESLOTS * 4);
constexpr size_t OFF_SLOT = OFF_GATE + al256((size_t)NE * EPAD * 4);
constexpr size_t OFF_XE = OFF_SLOT + al256((size_t)NROW * 16 * 4);
constexpr size_t OFF_HID = OFF_XE + al256((size_t)NE * EPAD * D * 2);
constexpr size_t OFF_YE = OFF_HID + al256((size_t)NE * EPAD * FF * 2);
constexpr size_t END_MOE = OFF_YE + al256((size_t)NE * EPAD * D * 2);
constexpr size_t WS_NEED = END_RW2 > END_MLA ? (END_RW2 > END_MOE ? END_RW2 : END_MOE) : (END_MLA > END_MOE ? END_MLA : END_MOE);

constexpr int LDS_BYTES = 152064;

struct Params {
    const float *x, *c, *ctx, *c_ctx, *mod_w, *mod_b, *norm1_g, *norm2_g, *final_g;
    const float *mla_w_in, *mla_g_q, *mla_g_kv, *mla_w_uq, *mla_w_ukv, *mla_w_o;
    const float *rw_mu, *rw_w_rkv, *rw_w0, *rw_w1, *rw_w2, *rw_a0, *rw_a1, *rw_a2, *rw_v0, *rw_v1, *rw_v2, *rw_g1, *rw_g2, *rw_k_k, *rw_k_a, *rw_r_k, *rw_lnx_g, *rw_lnx_b, *rw_w_o;
    const float *moe_router, *moe_w1, *moe_w3, *moe_w2;
    float* out; char* ws;
    int wv, pad_;
};

__device__ __forceinline__ int bidx() { int t = blockIdx.x; asm volatile("" : "+s"(t)); return t; }
__device__ __forceinline__ int gdim() { int t = gridDim.x; asm volatile("" : "+s"(t)); return t; }
__device__ __forceinline__ int tidx_w(int wv) { int l; asm volatile("v_mbcnt_lo_u32_b32 %0, -1, 0\n\tv_mbcnt_hi_u32_b32 %0, -1, %0" : "=v"(l)); return (wv << 6) | l; }
#define tidx() tidx_w(p.wv)
#define XB_TMO      128
#define XB_XCNT(j)  (256  + 64 * (j))
#define XB_XSUB(j)  (1280 + 64 * (j))
#define XB_XGEN(j)  (2304 + 64 * (j))
#define XB_TOP      3328
#define XB_TOPGEN   3392
#define XCD_BAR_WORDS 3456
#define XB_SPIN_CAP (1u << 22)
#define LAS __attribute__((address_space(3)))

__device__ __forceinline__ unsigned xb_ld(unsigned* p)              { return __hip_atomic_load(p, __ATOMIC_RELAXED, __HIP_MEMORY_SCOPE_AGENT); }
__device__ __forceinline__ unsigned xb_add(unsigned* p, unsigned v) { return __hip_atomic_fetch_add(p, v, __ATOMIC_RELAXED, __HIP_MEMORY_SCOPE_AGENT); }
__device__ __forceinline__ unsigned xb_xcc_id() { return (unsigned)__builtin_amdgcn_s_getreg((3 << 11) | 20) & 0xFu; }
#define XB_SPIN(cond, bar) do { unsigned _sp = 0; while (cond) { __builtin_amdgcn_s_sleep(1); \
    if ((++_sp & 255u) == 0u) { if (xb_ld(&(bar)[XB_TMO])) break; if (_sp > XB_SPIN_CAP) { atomicAdd(&(bar)[XB_TMO], 1u); break; } } } } while (0)

struct XcdBarrier { unsigned* bar; unsigned x; volatile LAS unsigned* st; };

__device__ __forceinline__ XcdBarrier xcd_barrier_post(unsigned* bar, volatile LAS unsigned* st) {
    XcdBarrier b; b.bar = bar; b.x = xb_xcc_id(); b.st = st;
    if (threadIdx.x == 0) (void)xb_add(&bar[XB_XCNT(b.x)], 1u);
    return b;
}
__device__ __forceinline__ void xcd_barrier_complete(unsigned* bar, unsigned x, unsigned& nloc, unsigned& nx) {
    const unsigned G = gridDim.x * gridDim.y * gridDim.z;
    unsigned sum, cnt, mine, sp = 0u;
    for (;;) {
        sum = 0u; cnt = 0u; mine = 0u;
#pragma unroll
        for (unsigned j = 0; j < 16; ++j) { const unsigned c = xb_ld(&bar[XB_XCNT(j)]); sum += c; cnt += (c > 0u) ? 1u : 0u; mine = (j == x) ? c : mine; }
        if (sum == G) break;
        __builtin_amdgcn_s_sleep(1);
        if ((++sp & 255u) == 0u) { if (xb_ld(&bar[XB_TMO])) break; if (sp > XB_SPIN_CAP) { atomicAdd(&bar[XB_TMO], 1u); break; } }
    }
    nloc = mine > 0u ? mine : 1u; nx = cnt > 0u ? cnt : 1u;
}
__device__ __forceinline__ void xcd_barrier(const XcdBarrier& b) {
    asm volatile("s_waitcnt vmcnt(0)" ::: "memory");
    __syncthreads();
    if (threadIdx.x == 0) {
        unsigned* bar = b.bar;
        __builtin_amdgcn_s_waitcnt(0);
        unsigned nloc = b.st[0], nx = b.st[1];
        if (nloc == 0u) { xcd_barrier_complete(bar, b.x, nloc, nx); b.st[0] = nloc; b.st[1] = nx; }
        const unsigned old = xb_add(&bar[XB_XSUB(b.x)], 1u);
        const unsigned gen = old / nloc;
        if (old + 1u == (gen + 1u) * nloc) {
            __builtin_amdgcn_fence(__ATOMIC_RELEASE, "agent");
            asm volatile("s_waitcnt vmcnt(0)" ::: "memory");
            const unsigned og = xb_add(&bar[XB_TOP], 1u);
            const unsigned tg = og / nx;
            if (og + 1u == (tg + 1u) * nx) xb_add(&bar[XB_TOPGEN], 1u);
            else XB_SPIN(xb_ld(&bar[XB_TOPGEN]) == tg, bar);
            __builtin_amdgcn_fence(__ATOMIC_ACQUIRE, "agent");
            xb_add(&bar[XB_XGEN(b.x)], 1u);
            asm volatile("s_waitcnt vmcnt(0)" ::: "memory");
        } else {
            XB_SPIN(xb_ld(&bar[XB_XGEN(b.x)]) == gen, bar);
            __builtin_amdgcn_fence(__ATOMIC_ACQUIRE, "agent");
            asm volatile("s_waitcnt vmcnt(0)" ::: "memory");
        }
    }
    __syncthreads();
}

__device__ __forceinline__ float bf2f(bf16_t b) { return __uint_as_float(((unsigned)b) << 16); }
typedef float f32x2_ __attribute__((ext_vector_type(2)));
typedef __bf16 bf16x2_ __attribute__((ext_vector_type(2)));
__device__ __forceinline__ unsigned pk2(float lo, float hi) { const f32x2_ v = {lo, hi}; return __builtin_bit_cast(unsigned, __builtin_convertvector(v, bf16x2_)); }
__device__ __forceinline__ bf16_t f2bf(float f) { return (bf16_t)(pk2(f, f) & 0xffffu); }
__device__ __forceinline__ float dpp_sum16(float x) {
    x += __builtin_bit_cast(float, __builtin_amdgcn_update_dpp(0, __builtin_bit_cast(int, x), 0xB1, 0xF, 0xF, true));
    x += __builtin_bit_cast(float, __builtin_amdgcn_update_dpp(0, __builtin_bit_cast(int, x), 0x4E, 0xF, 0xF, true));
    x += __builtin_bit_cast(float, __builtin_amdgcn_update_dpp(0, __builtin_bit_cast(int, x), 0x141, 0xF, 0xF, true));
    x += __builtin_bit_cast(float, __builtin_amdgcn_update_dpp(0, __builtin_bit_cast(int, x), 0x140, 0xF, 0xF, true));
    return x;
}
__device__ __forceinline__ f32x4 ldbf4(const bf16_t* p) { const uint2 w = *(const uint2*)p; return (f32x4){__uint_as_float(w.x << 16), __uint_as_float(w.x & 0xffff0000u), __uint_as_float(w.y << 16), __uint_as_float(w.y & 0xffff0000u)}; }
__device__ __forceinline__ void stbf4(bf16_t* p, f32x4 v) { uint2 w; w.x = pk2(v[0], v[1]); w.y = pk2(v[2], v[3]); *(uint2*)p = w; }
typedef bf16_t xt_t;
__device__ __forceinline__ f32x4 xldv(const xt_t* X, size_t i) { return ldbf4(X + i); }
__device__ __forceinline__ void xstv(xt_t* X, size_t i, f32x4 v) { stbf4(X + i, v); }
__device__ __forceinline__ float4 xld(const xt_t* X, size_t i) { const f32x4 v = ldbf4(X + i); return make_float4(v[0], v[1], v[2], v[3]); }
__device__ __forceinline__ void xst(xt_t* X, size_t i, float4 v) { stbf4(X + i, (f32x4){v.x, v.y, v.z, v.w}); }
__device__ __forceinline__ float wave_sum(float v) {
    v = dpp_sum16(v); const int i = __builtin_bit_cast(int, v);
    return __builtin_bit_cast(float, __builtin_amdgcn_readlane(i, 0)) + __builtin_bit_cast(float, __builtin_amdgcn_readlane(i, 16)) + __builtin_bit_cast(float, __builtin_amdgcn_readlane(i, 32)) + __builtin_bit_cast(float, __builtin_amdgcn_readlane(i, 48));
}
__device__ __forceinline__ float sigmoidf_(float x) { return __builtin_amdgcn_rcpf(1.f + __expf(-x)); }
__device__ __forceinline__ int row_stream(int row) { return row < NLAT ? (row >> 12) : 4; }
__device__ __forceinline__ const float* modp(const Params& p, int layer, int s, int part) { return (const float*)(p.ws + OFF_MOD) + ((size_t)layer * 5 + s) * 6144 + part * 1024; }

struct SgArgs { const bf16_t* A; int lda; size_t strideA; const float* B; int ldb; size_t strideB; int M, N, K, nbatch; };
template <class Epi>
__device__ __forceinline__ void sg_gemm(const Params& p, char* lds, const SgArgs g, const Epi& epi) {
    bf16_t* As = (bf16_t*)lds;
    bf16_t* Bs = As + 128 * 40;
    const int tid = tidx(), wid = tid >> 6, lane = tid & 63;
    const int wr = wid >> 2, wc = wid & 3;
    const int tilesN = (g.N + 127) / 128, tilesM = g.M / 128, per = tilesM * tilesN, ntiles = per * g.nbatch;
    const int ar = tid >> 2, ak = (tid & 3) * 8;
    const int bn = tid & 127, bk = (tid >> 7) * 8;
    for (int tile = bidx(); tile < ntiles; tile += gdim()) {
        const int bt = tile / per, tt = tile % per;
        const int tm = tt / tilesN, tn = tt % tilesN;
        const int m0 = tm * 128, n0 = tn * 128;
        f32x4 acc[4][2];
#pragma unroll
        for (int m = 0; m < 4; ++m)
#pragma unroll
            for (int n = 0; n < 2; ++n) acc[m][n] = (f32x4){0.f, 0.f, 0.f, 0.f};
        const bool bvalid = (n0 + bn) < g.N;
        const bf16_t* ap = g.A + bt * g.strideA + (size_t)(m0 + ar) * g.lda + ak;
        const float* bp = g.B + bt * g.strideB + (size_t)bk * g.ldb + n0 + bn;
        bf16x8 areg; float breg[8];
        areg = *(const bf16x8*)ap;
#pragma unroll
        for (int j = 0; j < 8; ++j) breg[j] = bvalid ? bp[(size_t)j * g.ldb] : 0.f;
        for (int k0 = 0; k0 < g.K; k0 += 32) {
            __syncthreads();
            *(bf16x8*)(As + ar * 40 + ak) = areg;
            { u32x4 w; w.x = pk2(breg[0], breg[1]); w.y = pk2(breg[2], breg[3]); w.z = pk2(breg[4], breg[5]); w.w = pk2(breg[6], breg[7]); *(u32x4*)(Bs + bn * 40 + bk) = w; }
            __syncthreads();
            if (k0 + 32 < g.K) {
                areg = *(const bf16x8*)(ap + k0 + 32);
#pragma unroll
                for (int j = 0; j < 8; ++j) breg[j] = bvalid ? bp[(size_t)(k0 + 32 + j) * g.ldb] : 0.f;
            }
            bf16x8 af[4], bfr[2];
#pragma unroll
            for (int m = 0; m < 4; ++m) af[m] = *(const bf16x8*)(As + (wr * 64 + m * 16 + (lane & 15)) * 40 + (lane >> 4) * 8);
#pragma unroll
            for (int n = 0; n < 2; ++n) bfr[n] = *(const bf16x8*)(Bs + (wc * 32 + n * 16 + (lane & 15)) * 40 + (lane >> 4) * 8);
#pragma unroll
            for (int m = 0; m < 4; ++m)
#pragma unroll
                for (int n = 0; n < 2; ++n) acc[m][n] = __builtin_amdgcn_mfma_f32_16x16x32_bf16(af[m], bfr[n], acc[m][n], 0, 0, 0);
        }
#pragma unroll
        for (int m = 0; m < 4; ++m)
#pragma unroll
            for (int n = 0; n < 2; ++n) {
                const int col = n0 + wc * 32 + n * 16 + (lane & 15);
                if (col < g.N) {
#pragma unroll
                    for (int r = 0; r < 4; ++r) epi(bt, m0 + wr * 64 + m * 16 + (lane >> 4) * 4 + r, col, acc[m][n][r]);
                }
            }
    }
}


namespace g8 {
#define PG8_LAS __attribute__((address_space(3)))
constexpr int BM = 256, BK = 64, HALF = 128, HTB = HALF * BK * 2, STAGE_BYTES = 8 * HTB;
__device__ __forceinline__ int lds_byte(int r, int c) { const int st = (r >> 4) * 2 + (c >> 5), rr = r & 15, cc = c & 31, ob = rr * 64 + cc * 2; return st * 1024 + (ob ^ (((ob >> 9) & 1) << 5)); }
__device__ __forceinline__ void stage_rc(int b, int& R, int& C) { const int st = b / 1024, sb = b % 1024, swz = sb ^ (((sb >> 9) & 1) << 5); R = (st >> 1) * 16 + swz / 64; C = (st & 1) * 32 + (swz % 64) / 2; }
struct Unit { int pm, pn, g; const char* A; const char* B; };
__device__ __forceinline__ int xcd_remap(int L, int nwg) { const int q = nwg / 8, r = nwg % 8, xcd = L % 8, off = L / 8; return (xcd < r ? xcd * (q + 1) : r * (q + 1) + (xcd - r) * q) + off; }

template <class Epi, class Sched>
__device__ __forceinline__ void gemm_phase(const int wv_, PG8_LAS unsigned char* lds, const int K, const Sched& S, const Epi& E) {
    const int tid = tidx_w(wv_), wid = __builtin_amdgcn_readfirstlane(tid >> 6), lane = tid & 63, wr = wid >> 2, wc = wid & 3, fr = lane & 15, fq = lane >> 4;
    const int nt = K / BK;
    unsigned voffA[2];
#pragma unroll
    for (int i = 0; i < 2; ++i) { int R, C; stage_rc(tid * 16 + i * 8192, R, C); voffA[i] = (unsigned)(R * K + C) * 2u; }
    const size_t kstep = (size_t)(BK * 2);
    const size_t hstep = (size_t)HALF * K * 2;
    const unsigned ldsw = (unsigned)wid * 1024u;
    const int aoff = lds_byte(wr * 64 + fr, fq * 8), boff = lds_byte(wc * 32 + fr, fq * 8);
#define PG8_SA(b, h) (((b) * 2 + (h)) * HTB)
#define PG8_SB(b, h) ((4 + (b) * 2 + (h)) * HTB)
#define PG8_STAGE(bufoff, gbase, voff) do { _Pragma("unroll") for (int _i = 0; _i < 2; ++_i) \
        __builtin_amdgcn_global_load_lds((const unsigned*)((const char*)(gbase) + (voff)[_i]), (PG8_LAS unsigned*)(lds + (bufoff) + ldsw + _i * 8192), 16, 0, 0); } while (0)
#define PG8_LDA(dst, b, h) do { _Pragma("unroll") for (int m = 0; m < 4; ++m) _Pragma("unroll") for (int k = 0; k < 2; ++k) dst[m][k] = *(const PG8_LAS bf16x8*)(lds + PG8_SA(b, h) + aoff + m * 2048 + k * 1024); } while (0)
#define PG8_LDB(dst, b, h) do { _Pragma("unroll") for (int n = 0; n < 2; ++n) _Pragma("unroll") for (int k = 0; k < 2; ++k) dst[n][k] = *(const PG8_LAS bf16x8*)(lds + PG8_SB(b, h) + boff + n * 2048 + k * 1024); } while (0)
#define PG8_MMA(ai, bj, At, Bt) do { __builtin_amdgcn_s_setprio(1); _Pragma("unroll") for (int m = 0; m < 4; ++m) _Pragma("unroll") for (int n = 0; n < 2; ++n) _Pragma("unroll") for (int k = 0; k < 2; ++k) \
        acc[ai][bj][m][n] = __builtin_amdgcn_mfma_f32_16x16x32_bf16(Bt[n][k], At[m][k], acc[ai][bj][m][n], 0, 0, 0); __builtin_amdgcn_s_setprio(0); } while (0)
#define PG8_WAIT_V(n) asm volatile("s_waitcnt vmcnt(" #n ")" ::: "memory")
#define PG8_WAIT_L(n) asm volatile("s_waitcnt lgkmcnt(" #n ")" ::: "memory")
#define PG8_BAR __builtin_amdgcn_s_barrier()
#define PG8_SCHED __builtin_amdgcn_sched_barrier(0)
    Unit cur, nxt; int ui = 0;
    if (!S.next(0, cur)) return;
    f32x4 acc[2][2][4][2];
#pragma unroll
    for (int a = 0; a < 2; ++a)
#pragma unroll
        for (int b = 0; b < 2; ++b)
#pragma unroll
            for (int m = 0; m < 4; ++m)
#pragma unroll
                for (int n = 0; n < 2; ++n) acc[a][b][m][n] = (f32x4){0.f, 0.f, 0.f, 0.f};
    bf16x8 At[4][2], B0[2][2], B1[2][2];
    const char* cA = cur.A; const char* cB = cur.B;
    PG8_STAGE(PG8_SB(0, 0), cB, voffA); PG8_STAGE(PG8_SA(0, 0), cA, voffA); PG8_STAGE(PG8_SB(0, 1), cB + hstep, voffA); PG8_STAGE(PG8_SA(0, 1), cA + hstep, voffA);
    if (wr == 1) PG8_BAR;
    PG8_WAIT_V(4); PG8_BAR;
    PG8_STAGE(PG8_SB(1, 0), cB + kstep, voffA); PG8_STAGE(PG8_SA(1, 0), cA + kstep, voffA); PG8_STAGE(PG8_SB(1, 1), cB + hstep + kstep, voffA);
    PG8_WAIT_V(6); PG8_BAR;
    for (;;) {
        const bool has_next = S.next(ui + 1, nxt);
        const char* nA = has_next ? nxt.A : cA; const char* nB = has_next ? nxt.B : cB;
        for (int t = 0; t < nt; t += 2) {
            const bool last = (t == nt - 2);
            const char* a1 = cA + (size_t)(t + 1) * kstep;
            const char* a2 = last ? nA : cA + (size_t)(t + 2) * kstep; const char* b2 = last ? nB : cB + (size_t)(t + 2) * kstep;
            const char* a3 = a2 + kstep; const char* b3 = b2 + kstep;
            PG8_LDB(B0, 0, 0); PG8_SCHED; PG8_LDA(At, 0, 0); PG8_STAGE(PG8_SA(1, 1), a1 + hstep, voffA);
            PG8_WAIT_L(8); PG8_BAR; PG8_WAIT_L(0); PG8_MMA(0, 0, At, B0); PG8_BAR; PG8_SCHED;
            PG8_LDB(B1, 0, 1); PG8_STAGE(PG8_SB(0, 0), b2, voffA);
            PG8_BAR; PG8_WAIT_L(0); PG8_MMA(0, 1, At, B1); PG8_BAR;
            PG8_LDA(At, 0, 1); PG8_STAGE(PG8_SA(0, 0), a2, voffA);
            PG8_BAR; PG8_WAIT_L(0); PG8_MMA(1, 0, At, B0); PG8_BAR; PG8_SCHED;
            PG8_STAGE(PG8_SB(0, 1), b2 + hstep, voffA);
            PG8_WAIT_V(6); PG8_BAR; PG8_MMA(1, 1, At, B1); PG8_BAR;
            PG8_LDB(B0, 1, 0); PG8_SCHED; PG8_LDA(At, 1, 0); PG8_STAGE(PG8_SA(0, 1), a2 + hstep, voffA);
            PG8_WAIT_L(8); PG8_BAR; PG8_WAIT_L(0); PG8_MMA(0, 0, At, B0); PG8_BAR; PG8_SCHED;
            PG8_LDB(B1, 1, 1); PG8_STAGE(PG8_SB(1, 0), b3, voffA);
            PG8_BAR; PG8_WAIT_L(0); PG8_MMA(0, 1, At, B1); PG8_BAR;
            PG8_LDA(At, 1, 1); PG8_STAGE(PG8_SA(1, 0), a3, voffA);
            PG8_BAR; PG8_WAIT_L(0); PG8_MMA(1, 0, At, B0); PG8_BAR; PG8_SCHED;
            PG8_STAGE(PG8_SB(1, 1), b3 + hstep, voffA);
            PG8_WAIT_V(6); PG8_BAR; PG8_MMA(1, 1, At, B1); PG8_BAR;
        }
        E(acc, cur, wr, wc, fr, fq);
        if (!has_next) break;
#pragma unroll
        for (int a = 0; a < 2; ++a)
#pragma unroll
            for (int b = 0; b < 2; ++b)
#pragma unroll
                for (int m = 0; m < 4; ++m)
#pragma unroll
                    for (int n = 0; n < 2; ++n) acc[a][b][m][n] = (f32x4){0.f, 0.f, 0.f, 0.f};
        cur = nxt; cA = nA; cB = nB; ++ui;
    }
    PG8_WAIT_V(0);
    if (wr == 0) PG8_BAR;
    PG8_BAR;
#undef PG8_SA
#undef PG8_SB
#undef PG8_STAGE
#undef PG8_LDA
#undef PG8_LDB
#undef PG8_MMA
#undef PG8_WAIT_V
#undef PG8_WAIT_L
#undef PG8_BAR
#undef PG8_SCHED
}
template <class F> struct EpiRC { F f;
    __device__ __forceinline__ void operator()(const f32x4 (&acc)[2][2][4][2], const Unit& u, int wr, int wc, int fr, int fq) const {
#pragma unroll
        for (int ai = 0; ai < 2; ++ai)
#pragma unroll
            for (int m = 0; m < 4; ++m) { const int row = u.pm * BM + ai * HALF + wr * 64 + m * 16 + fr;
#pragma unroll
                for (int bj = 0; bj < 2; ++bj)
#pragma unroll
                    for (int n = 0; n < 2; ++n) f(u, row, u.pn * BM + bj * HALF + wc * 32 + n * 16 + 4 * fq, acc[ai][bj][m][n]);
                asm volatile("" ::: "memory"); }
    } };
template <class F> __device__ __forceinline__ EpiRC<F> epi_rc(const F& f) { return EpiRC<F>{f}; }
template <class F> struct EpiPair { F f;
    __device__ __forceinline__ void operator()(const f32x4 (&acc)[2][2][4][2], const Unit& u, int wr, int wc, int fr, int fq) const {
#pragma unroll
        for (int ai = 0; ai < 2; ++ai)
#pragma unroll
            for (int m = 0; m < 4; ++m) { const int row = u.pm * BM + ai * HALF + wr * 64 + m * 16 + fr;
#pragma unroll
                for (int n = 0; n < 2; ++n) f(u, row, u.pn * HALF + wc * 32 + n * 16 + 4 * fq, acc[ai][0][m][n], acc[ai][1][m][n]);
                asm volatile("" ::: "memory"); }
    } };
template <class F> __device__ __forceinline__ EpiPair<F> epi_pair(const F& f) { return EpiPair<F>{f}; }
template <class F, class CF, class RF> struct EpiPre { F f; CF cf; RF rf;
    __device__ __forceinline__ void operator()(const f32x4 (&acc)[2][2][4][2], const Unit& u, int wr, int wc, int fr, int fq) const {
        f32x4 cv[2][2]; float rv[2][4];
#pragma unroll
        for (int bj = 0; bj < 2; ++bj)
#pragma unroll
            for (int n = 0; n < 2; ++n) cv[bj][n] = cf(u, u.pn * BM + bj * HALF + wc * 32 + n * 16 + 4 * fq);
#pragma unroll
        for (int ai = 0; ai < 2; ++ai)
#pragma unroll
            for (int m = 0; m < 4; ++m) rv[ai][m] = rf(u, u.pm * BM + ai * HALF + wr * 64 + m * 16 + fr);
#pragma unroll
        for (int ai = 0; ai < 2; ++ai)
#pragma unroll
            for (int m = 0; m < 4; ++m) { const int row = u.pm * BM + ai * HALF + wr * 64 + m * 16 + fr;
#pragma unroll
                for (int bj = 0; bj < 2; ++bj)
#pragma unroll
                    for (int n = 0; n < 2; ++n) f(u, row, u.pn * BM + bj * HALF + wc * 32 + n * 16 + 4 * fq, acc[ai][bj][m][n], cv[bj][n], rv[ai][m]);
                asm volatile("" ::: "memory"); }
    } };
template <class F, class CF, class RF> __device__ __forceinline__ EpiPre<F, CF, RF> epi_pre(const F& f, const CF& cf, const RF& rf) { return EpiPre<F, CF, RF>{f, cf, rf}; }
template <class F, class CF> struct EpiColFirst { F f; CF cf;
    __device__ __forceinline__ void operator()(const f32x4 (&acc)[2][2][4][2], const Unit& u, int wr, int wc, int fr, int fq) const {
#pragma unroll
        for (int bj = 0; bj < 2; ++bj)
#pragma unroll
            for (int n = 0; n < 2; ++n) { const int col = u.pn * BM + bj * HALF + wc * 32 + n * 16 + 4 * fq; const f32x4 cv = cf(u, col);
#pragma unroll
                for (int ai = 0; ai < 2; ++ai)
#pragma unroll
                    for (int m = 0; m < 4; ++m) f(u, u.pm * BM + ai * HALF + wr * 64 + m * 16 + fr, col, acc[ai][bj][m][n], cv);
                asm volatile("" ::: "memory"); }
    } };
template <class F, class CF> __device__ __forceinline__ EpiColFirst<F, CF> epi_colfirst(const F& f, const CF& cf) { return EpiColFirst<F, CF>{f, cf}; }
struct EpiResid { xt_t* X; const float* MOD; int layer;
    __device__ __forceinline__ void operator()(const f32x4 (&acc)[2][2][4][2], const Unit& u, int wr, int wc, int fr, int fq) const {
        const int row0 = u.pm * BM + wr * 64 + fr, col0 = u.pn * BM + wc * 32 + 4 * fq;
        const int strm = row0 < NLAT ? (row0 >> 12) : 4;
        const float* gp = MOD + ((size_t)layer * 5 + strm) * 6144 + 2048 + col0;
        f32x4 gt[2][2];
#pragma unroll
        for (int bj = 0; bj < 2; ++bj)
#pragma unroll
            for (int n = 0; n < 2; ++n) gt[bj][n] = *(const f32x4*)(gp + bj * HALF + n * 16);
#pragma unroll
        for (int ai = 0; ai < 2; ++ai) {
            f32x4 xv[4][2][2];
#pragma unroll
            for (int m = 0; m < 4; ++m)
#pragma unroll
                for (int bj = 0; bj < 2; ++bj)
#pragma unroll
                    for (int n = 0; n < 2; ++n) xv[m][bj][n] = xldv(X, (size_t)(row0 + ai * HALF + m * 16) * D + col0 + bj * HALF + n * 16);
#pragma unroll
            for (int m = 0; m < 4; ++m)
#pragma unroll
                for (int bj = 0; bj < 2; ++bj)
#pragma unroll
                    for (int n = 0; n < 2; ++n) xstv(X, (size_t)(row0 + ai * HALF + m * 16) * D + col0 + bj * HALF + n * 16, xv[m][bj][n] + gt[bj][n] * acc[ai][bj][m][n]);
            asm volatile("" ::: "memory");
        }
    } };
struct BatchSched { const char* A; const char* B; size_t strideA, strideB; int nM, nN, nb, K; int rev = 0;
    __device__ __forceinline__ bool next(int i, Unit& u) const {
        const int nwg = nM * nN * nb; const int L = i * gdim() + (rev ? gdim() - 1 - bidx() : bidx()); if (L >= nwg) return false;
        const int w = xcd_remap(L, nwg); const int per = nM * nN; u.g = w / per; const int r = w % per; u.pm = r / nN; u.pn = r % nN;
        u.A = A + u.g * strideA + (size_t)u.pm * BM * K * 2; u.B = B + u.g * strideB + (size_t)u.pn * BM * K * 2; return true; } };
}

template <class SrcF, class DRow>
__device__ __forceinline__ int cvt_tiles(const int wv_, char* lds, bf16_t* dst, int Kd, int Nd, int nbatch, size_t dstride, const SrcF& src, const DRow& drow, int* rot = nullptr) {
    bf16_t* T = (bf16_t*)lds;
    const int tid = tidx_w(wv_);
    const int tk = Kd / 128, tn = Nd / 64, per = tk * tn, total = per * nbatch;
    {
        int first = bidx() - (rot ? *rot % gdim() : 0); if (first < 0) first += gdim();
        if (rot) *rot += total;
        for (int t = first; t < total; t += gdim()) {
            const int bt = t / per, r = t % per, k0 = (r % tk) * 128, n0 = (r / tk) * 64;
            float4 v[4];
#pragma unroll
            for (int i = 0; i < 4; ++i) { const int k = k0 + i * 32 + (tid >> 4), n = n0 + (tid & 15) * 4; const float* sp = src(bt, k, n); v[i] = sp ? *(const float4*)sp : make_float4(0.f, 0.f, 0.f, 0.f); }
            __syncthreads();
#pragma unroll
            for (int i = 0; i < 4; ++i) { const int k = i * 32 + (tid >> 4), n = (tid & 15) * 4;
                T[(n + 0) * 136 + k] = f2bf(v[i].x); T[(n + 1) * 136 + k] = f2bf(v[i].y); T[(n + 2) * 136 + k] = f2bf(v[i].z); T[(n + 3) * 136 + k] = f2bf(v[i].w); }
            __syncthreads();
            { const int n = tid >> 3, kc = (tid & 7) * 16;
              const u32x4 a = *(const u32x4*)(T + n * 136 + kc), b = *(const u32x4*)(T + n * 136 + kc + 8);
              bf16_t* dp = dst + bt * dstride + (size_t)drow(n0 + n) * Kd + k0 + kc;
              *(u32x4*)dp = a; *(u32x4*)(dp + 8) = b; }
        }
    }
    return 0;
}
__device__ __forceinline__ int moe_cvt(const Params& p, int layer, char* lds, int budget) {
    constexpr int QG = 2, T13 = NE * 8 * 44, TOT = T13 + NE * 11 * 16;
    bf16_t* T = (bf16_t*)lds;
    int* qslot = (int*)(lds + 64 * 136 * 2);
    const int tid = tidx();
    const float* w1 = p.moe_w1 + (size_t)layer * NE * D * FF; const float* w3 = p.moe_w3 + (size_t)layer * NE * D * FF; const float* w2 = p.moe_w2 + (size_t)layer * NE * FF * D;
    bf16_t* W13 = (bf16_t*)(p.ws + OFF_W13T + (size_t)(layer & 1) * SZ_WMOE); bf16_t* W2 = (bf16_t*)(p.ws + OFF_W2T + (size_t)(layer & 1) * SZ_WMOE);
    unsigned* queue = (unsigned*)(p.ws + OFF_QUEUE) + layer * 32;
    const bool ahead = budget < 0;
    int done = 0, tnext = 0;
    __syncthreads();
    if (tid == 0) qslot[0] = QG * (int)__hip_atomic_fetch_add(queue, 1u, __ATOMIC_RELAXED, __HIP_MEMORY_SCOPE_AGENT);
    __syncthreads();
    int t0 = __builtin_amdgcn_readfirstlane(qslot[0]);
    while (t0 < TOT && (ahead || done < budget)) {
        const bool more = ahead || done + 1 < budget;
        if (more && tid == 0) tnext = QG * (int)__hip_atomic_fetch_add(queue, 1u, __ATOMIC_RELAXED, __HIP_MEMORY_SCOPE_AGENT);
#pragma unroll 1
        for (int sub = 0; sub < QG; ++sub) {
            const int t = t0 + sub;
            const float* sp; bf16_t* dp; int ss, ds;
            if (t < T13) { const int e = t / 352, r = t % 352, k0 = (r & 7) * 128, n0 = (r >> 3) * 64; const int c0 = (n0 >> 8) * 128 + (n0 & 127);
                sp = (((n0 >> 7) & 1) ? w3 : w1) + ((size_t)e * D + k0) * FF + c0; ss = FF; dp = W13 + ((size_t)e * 2816 + n0) * D + k0; ds = D; }
            else { const int u = t - T13, e = u / 176, r = u % 176, k0 = (r % 11) * 128, n0 = (r / 11) * 64;
                sp = w2 + ((size_t)e * FF + k0) * D + n0; ss = D; dp = W2 + ((size_t)e * D + n0) * FF + k0; ds = FF; }
            float4 v[4];
#pragma unroll
            for (int i = 0; i < 4; ++i) v[i] = *(const float4*)(sp + (size_t)(i * 32 + (tid >> 4)) * ss + (tid & 15) * 4);
            __syncthreads();
#pragma unroll
            for (int i = 0; i < 4; ++i) { const int k = i * 32 + (tid >> 4), n = (tid & 15) * 4;
                T[(n + 0) * 136 + k] = f2bf(v[i].x); T[(n + 1) * 136 + k] = f2bf(v[i].y); T[(n + 2) * 136 + k] = f2bf(v[i].z); T[(n + 3) * 136 + k] = f2bf(v[i].w); }
            if (sub == QG - 1 && tid == 0) qslot[0] = more ? tnext : TOT;
            __syncthreads();
            { const int n = tid >> 3, kc = (tid & 7) * 16;
              const u32x4 a = *(const u32x4*)(T + n * 136 + kc), b = *(const u32x4*)(T + n * 136 + kc + 8);
              bf16_t* o = dp + (size_t)n * ds + kc;
              *(u32x4*)o = a; *(u32x4*)(o + 8) = b; }
        }
        ++done; t0 = __builtin_amdgcn_readfirstlane(qslot[0]);
    }
    __syncthreads();
    return done;
}
__device__ __forceinline__ void bg_cvt(const Params& p, int layer, char* lds, int budget) {
#pragma unroll 1
    for (int l = layer; l < 4 && l <= layer + 1 && budget > 0; ++l) budget -= moe_cvt(p, l, lds, budget);
}
__device__ __forceinline__ bool idle_tail(int nunits) { const int r = nunits % gdim(); return r != 0 && bidx() >= r; }
__device__ void ph_init(const Params& p, char* lds) {
    const int tid = tidx(), gtid = bidx() * NTHR + tid, gsz = gdim() * NTHR;
    xt_t* Xs = (xt_t*)(p.ws + OFF_X);
    const float4* x4 = (const float4*)p.x; const float4* c4 = (const float4*)p.ctx;
    { constexpr int NQ = NROW * 256 / 4;
      auto srcv = [&](int k) { return k < NLAT * 256 ? x4[k] : c4[k - NLAT * 256]; };
      for (int i = gtid; i < NQ; i += gsz) { const float4 t0 = srcv(i), t1 = srcv(i + NQ), t2 = srcv(i + 2 * NQ), t3 = srcv(i + 3 * NQ); xst(Xs, (size_t)4 * i, t0); xst(Xs, (size_t)4 * (i + NQ), t1); xst(Xs, (size_t)4 * (i + 2 * NQ), t2); xst(Xs, (size_t)4 * (i + 3 * NQ), t3); } }
    float* rc = (float*)(p.ws + OFF_ROPE_C); float* rs = (float*)(p.ws + OFF_ROPE_S);
    for (int i = gtid; i < TL * 32; i += gsz) {
        const int t = i >> 5, f = i & 31; const float pos = (float)((f < 16) ? (t >> 6) : (t & 63));
        const float inv = powf(10000.f, -(float)(f & 15) / 16.f); const float ang = pos * inv; rc[2 * i] = cosf(ang); rc[2 * i + 1] = sinf(ang);
    }
    float* sc = (float*)lds;
    float* red = sc + 5 * 1024;
    for (int i = tid; i < 5 * 1024; i += NTHR) { const float v = i < 4096 ? p.c[i] : p.c_ctx[i - 4096]; sc[i] = v / (1.f + expf(-v)); }
    __syncthreads();
    float* MOD = (float*)(p.ws + OFF_MOD);
    for (int item = bidx(); item < 4 * 96; item += gdim()) {
        const int l = item / 96, cg = item % 96, col = tid & 63, n = cg * 64 + col, kg = tid >> 6;
        const float* w = p.mod_w + ((size_t)l * 1024 + kg * 128) * 6144 + n;
        float a0 = 0, a1 = 0, a2 = 0, a3 = 0, a4 = 0;
#pragma unroll 16
        for (int k = 0; k < 128; ++k) { const float wv = w[(size_t)k * 6144]; const int kk = kg * 128 + k;
            a0 += sc[kk] * wv; a1 += sc[1024 + kk] * wv; a2 += sc[2048 + kk] * wv; a3 += sc[3072 + kk] * wv; a4 += sc[4096 + kk] * wv; }
        float* rr = red + (kg * 64 + col) * 5; rr[0] = a0; rr[1] = a1; rr[2] = a2; rr[3] = a3; rr[4] = a4;
        __syncthreads();
        if (tid < 320) { const int c2 = tid & 63, s = tid >> 6; float sum = 0;
            for (int q = 0; q < 8; ++q) sum += red[(q * 64 + c2) * 5 + s];
            MOD[((size_t)l * 5 + s) * 6144 + cg * 64 + c2] = sum + p.mod_b[l * 6144 + cg * 64 + c2]; }
        __syncthreads();
    }
}


__device__ void ph_small_cvt(const Params& p, char* lds) {
    int rot = 128;
    for (int j = 0; j < 2; ++j) {
        char* wm = p.ws + OFF_WMLA + j * SZ_WMLA; char* wr = p.ws + OFF_WRW + j * SZ_WRW;
        const float* w_in = p.mla_w_in + (size_t)j * D * 448; const float* w_uq = p.mla_w_uq + (size_t)j * 256 * 1536; const float* w_ukv = p.mla_w_ukv + (size_t)j * 128 * 2048; const float* w_o = p.mla_w_o + (size_t)j * D * D;
        cvt_tiles(p.wv, lds, (bf16_t*)(wm + WM_IN), 1024, 512, 1, 0, [=](int, int k, int n) -> const float* { return n < 448 ? w_in + (size_t)k * 448 + n : nullptr; },
                  [=](int n) { if (n < 384 || n >= 448) return n; const int jj = n - 384; return 384 + (jj < 32 ? 2 * jj : 2 * (jj - 32) + 1); }, &rot);
        cvt_tiles(p.wv, lds, (bf16_t*)(wm + WM_UQ), 256, 1536, 1, 0, [=](int, int k, int n) -> const float* { return w_uq + (size_t)k * 1536 + n; },
                  [=](int n) { const int h = n / 192, d = n % 192; if (d < 128) return n; const int jj = d - 128; return h * 192 + 128 + (jj < 32 ? 2 * jj : 2 * (jj - 32) + 1); }, &rot);
        cvt_tiles(p.wv, lds, (bf16_t*)(wm + WM_UKV), 128, 2048, 1, 0, [=](int, int k, int n) -> const float* { return w_ukv + (size_t)k * 2048 + n; }, [=](int n) { return n; }, &rot);
        cvt_tiles(p.wv, lds, (bf16_t*)(wm + WM_O), 1024, 1024, 1, 0, [=](int, int k, int n) -> const float* { return w_o + (size_t)k * D + n; }, [=](int n) { return n; }, &rot);
        const float* w_rkv = p.rw_w_rkv + (size_t)j * 3 * D * D; const float* w1 = p.rw_w1 + (size_t)j * 2 * D * 64; const float* a1 = p.rw_a1 + (size_t)j * 2 * D * 64;
        const float* g1 = p.rw_g1 + (size_t)j * D * 128; const float* v1 = p.rw_v1; const float* rwo = p.rw_w_o + (size_t)j * D * D;
        cvt_tiles(p.wv, lds, (bf16_t*)(wr + WR_RKV), 1024, 1024, 3, (size_t)D * D, [=](int m, int k, int n) -> const float* { return w_rkv + ((size_t)m * D + k) * D + n; }, [=](int n) { return n; }, &rot);
        cvt_tiles(p.wv, lds, (bf16_t*)(wr + WR_L), 1024, 256, 1, 0, [=](int, int k, int n) -> const float* { return n < 128 ? w1 + ((size_t)(n >> 6) * D + k) * 64 + (n & 63) : nullptr; }, [=](int n) { return n; }, &rot);
        cvt_tiles(p.wv, lds, (bf16_t*)(wr + WR_L) + 256 * 1024, 1024, 256, 1, 0, [=](int, int k, int n) -> const float* { return n < 128 ? a1 + ((size_t)(n >> 6) * D + k) * 64 + (n & 63) : nullptr; }, [=](int n) { return n; }, &rot);
        cvt_tiles(p.wv, lds, (bf16_t*)(wr + WR_L) + 2 * 256 * 1024, 1024, 256, 1, 0, [=](int, int k, int n) -> const float* { return n < 128 ? g1 + (size_t)k * 128 + n : nullptr; }, [=](int n) { return n; }, &rot);
        cvt_tiles(p.wv, lds, (bf16_t*)(wr + WR_L) + 3 * 256 * 1024, 1024, 256, 1, 0, [=](int, int k, int n) -> const float* { return n < 32 ? v1 + (size_t)k * 32 + n : nullptr; }, [=](int n) { return n; }, &rot);
        cvt_tiles(p.wv, lds, (bf16_t*)(wr + WR_O), 1024, 1024, 1, 0, [=](int, int k, int n) -> const float* { return rwo + (size_t)k * D + n; }, [=](int n) { return n; }, &rot);
        const float* w2 = p.rw_w2 + (size_t)j * 2 * 64 * D; const float* a2 = p.rw_a2 + (size_t)j * 2 * 64 * D; const float* g2 = p.rw_g2 + (size_t)j * 128 * D; const float* v2 = p.rw_v2;
        cvt_tiles(p.wv, lds, (bf16_t*)(wr + WR_B2), 128, 2048, 2, (size_t)2048 * 128, [=](int bt, int k, int n) -> const float* { const int zz = n >> 10, c = n & 1023, l = k - zz * 64;
            if (l < 0 || l >= 64) return nullptr; return (bt == 0 ? w2 : a2) + ((size_t)zz * 64 + l) * D + c; }, [=](int n) { return n; }, &rot);
        cvt_tiles(p.wv, lds, (bf16_t*)(wr + WR_B3), 128, 1024, 2, (size_t)1024 * 128, [=](int bt, int k, int n) -> const float* {
            if (bt == 0) return g2 + (size_t)k * D + n; return k < 32 ? v2 + (size_t)k * D + n : nullptr; }, [=](int n) { return n; }, &rot);
    }
}

template <bool OUTF32>
__device__ void ph_norm_mod(const Params& p, int layer, const float* g, int part_sh, int part_sc, void* outp) {
    const int wid = tidx() >> 6, lane = tidx() & 63;
    const xt_t* X = (const xt_t*)(p.ws + OFF_X);
    const int w_ = bidx() * 8 + wid, nw_ = gdim() * 8;
    int row = (int)((long long)w_ * NROW / nw_); const int rend = (int)((long long)(w_ + 1) * NROW / nw_);
    float4 nv[4], gm[4], bb[4]; int scur = -1;
    if (row < rend) {
#pragma unroll
        for (int i = 0; i < 4; ++i) nv[i] = xld(X, (size_t)row * D + (lane + i * 64) * 4); }
    for (; row < rend; ++row) {
        const int s = row_stream(row);
        if (s != scur) { scur = s; const float* sh = modp(p, layer, s, part_sh); const float* sc = modp(p, layer, s, part_sc);
#pragma unroll
            for (int i = 0; i < 4; ++i) { const int d = (lane + i * 64) * 4; const float4 gg = *(const float4*)(g + d), a = *(const float4*)(sc + d); bb[i] = *(const float4*)(sh + d);
                gm[i] = make_float4(gg.x * (1.f + a.x), gg.y * (1.f + a.y), gg.z * (1.f + a.z), gg.w * (1.f + a.w)); } }
        float4 v[4]; float ss = 0;
#pragma unroll
        for (int i = 0; i < 4; ++i) { v[i] = nv[i]; ss += v[i].x * v[i].x + v[i].y * v[i].y + v[i].z * v[i].z + v[i].w * v[i].w; }
        { const int nrow = row + 1;
          if (nrow < rend) {
#pragma unroll
              for (int i = 0; i < 4; ++i) nv[i] = xld(X, (size_t)nrow * D + (lane + i * 64) * 4); } }
        ss = wave_sum(ss); const float rs = rsqrtf(ss * (1.f / D) + RMS_EPS);
#pragma unroll
        for (int i = 0; i < 4; ++i) {
            const int d = (lane + i * 64) * 4;
            float4 o; o.x = v[i].x * rs * gm[i].x + bb[i].x; o.y = v[i].y * rs * gm[i].y + bb[i].y; o.z = v[i].z * rs * gm[i].z + bb[i].z; o.w = v[i].w * rs * gm[i].w + bb[i].w;
            if (OUTF32) *(float4*)((float*)outp + (size_t)row * D + d) = o;
            else { uint2 w; w.x = pk2(o.x, o.y); w.y = pk2(o.z, o.w); *(uint2*)((bf16_t*)outp + (size_t)row * D + d) = w; }
        }
    }
}

__device__ void ph_mla_mid(const Params& p, int j) {
    const int wid = tidx() >> 6, lane = tidx() & 63;
    const float* Z = (const float*)(p.ws + OFF_Z);
    bf16_t* CQN = (bf16_t*)(p.ws + OFF_CQN); bf16_t* CKVN = (bf16_t*)(p.ws + OFF_CKVN); bf16_t* K = (bf16_t*)(p.ws + OFF_K);
    const float* gq = p.mla_g_q + j * 256; const float* gkv = p.mla_g_kv + j * 128;
    const float* rc = (const float*)(p.ws + OFF_ROPE_C); const float* rs = (const float*)(p.ws + OFF_ROPE_S);
    for (int row = bidx() * 8 + wid; row < NROW; row += gdim() * 8) {
        const float* z = Z + (size_t)row * 512;
        const float4 q = *(const float4*)(z + lane * 4);
        const float2 kv = *(const float2*)(z + 256 + lane * 2);
        const float kr = z[384 + lane];
        float sq = wave_sum(q.x * q.x + q.y * q.y + q.z * q.z + q.w * q.w); const float rq = rsqrtf(sq * (1.f / 256.f) + RMS_EPS);
        float sk = wave_sum(kv.x * kv.x + kv.y * kv.y); const float rk = rsqrtf(sk * (1.f / 128.f) + RMS_EPS);
        const float4 g4 = *(const float4*)(gq + lane * 4); const float2 g2 = *(const float2*)(gkv + lane * 2);
        uint2 w; w.x = pk2(q.x * rq * g4.x, q.y * rq * g4.y); w.y = pk2(q.z * rq * g4.z, q.w * rq * g4.w);
        *(uint2*)(CQN + (size_t)row * 256 + lane * 4) = w;
        *(unsigned*)(CKVN + (size_t)row * 128 + lane * 2) = pk2(kv.x * rk * g2.x, kv.y * rk * g2.y);
        float o = kr;
        const float other = __builtin_bit_cast(float, __builtin_amdgcn_update_dpp(0, __builtin_bit_cast(int, kr), 0xB1, 0xF, 0xF, true));
        const bool lat = row < NLAT;
        if (lat) { const int t = row & (TL - 1), i = lane >> 1; const float2 cs = *(const float2*)(rc + (t * 32 + i) * 2); const float c = cs.x, s = cs.y;
            o = (lane & 1) ? (other * s + kr * c) : (kr * c - other * s); }
        const int b = lat ? (row >> 12) : ((row - NLAT) >> 8); const int tk = lat ? 256 + (row & (TL - 1)) : ((row - NLAT) & 255);
        const bf16_t ob = f2bf(o);
#pragma unroll
        for (int h = 0; h < 8; ++h) K[((size_t)(b * 8 + h) * TK + tk) * 192 + 128 + lane] = ob;
    }
}

__device__ void ph_qkv_post(const Params& p) {
    const int wid = tidx() >> 6, lane = tidx() & 63;
    const float* QRAW = (const float*)(p.ws + OFF_QRAW); const float* KVRAW = (const float*)(p.ws + OFF_KVRAW); const float* KR = (const float*)(p.ws + OFF_KR);
    bf16_t* Q = (bf16_t*)(p.ws + OFF_Q); bf16_t* K = (bf16_t*)(p.ws + OFF_K); bf16_t* V = (bf16_t*)(p.ws + OFF_V);
    const float* rc = (const float*)(p.ws + OFF_ROPE_C); const float* rs = (const float*)(p.ws + OFF_ROPE_S);
    for (int it = bidx() * 8 + wid; it < NROW * 8; it += gdim() * 8) {
        const int row = it >> 3, h = it & 7;
        const bool lat = row < NLAT; const int b = lat ? (row >> 12) : ((row - NLAT) >> 8); const int tk = lat ? 256 + (row & (TL - 1)) : ((row - NLAT) & 255);
        const size_t orow = (size_t)(b * 8 + h) * TK + tk;
        const float* q = QRAW + (size_t)row * 1536 + h * 192;
        const float q0 = q[lane], q1 = q[64 + lane]; float q2 = q[128 + lane];
        const auto sw = __builtin_amdgcn_permlane32_swap(__float_as_uint(q2), __float_as_uint(q2), false, false);
        if (lat) { const int t = row & (TL - 1), i = lane & 31; const float c = rc[t * 32 + i], s = rs[t * 32 + i];
            const float x1 = __uint_as_float(sw[0]), x2 = __uint_as_float(sw[1]); q2 = lane < 32 ? (x1 * c - x2 * s) : (x1 * s + x2 * c); }
        bf16_t* qo = Q + orow * 192; qo[lane] = f2bf(q0); qo[64 + lane] = f2bf(q1); qo[128 + lane] = f2bf(q2);
        const float* kv = KVRAW + (size_t)row * 2048 + h * 256;
        bf16_t* ko = K + orow * 192; ko[lane] = f2bf(kv[lane]); ko[64 + lane] = f2bf(kv[64 + lane]); ko[128 + lane] = f2bf(KR[(size_t)row * 64 + lane]);
        bf16_t* vo = V + orow * 128; vo[lane] = f2bf(kv[128 + lane]); vo[64 + lane] = f2bf(kv[192 + lane]);
    }
}

__device__ void ph_attn_naive(const Params& p, char* lds) {
    const int tid = tidx(), qi = tid >> 2, part = tid & 3;
    const bf16_t* Q = (const bf16_t*)(p.ws + OFF_Q); const bf16_t* K = (const bf16_t*)(p.ws + OFF_K); const bf16_t* V = (const bf16_t*)(p.ws + OFF_V);
    bf16_t* O = (bf16_t*)(p.ws + OFF_O);
    bf16_t* Ks = (bf16_t*)lds;
    bf16_t* Vs = Ks + 32 * 192;
    const int nitems = 32 * 34;
    for (int it = bidx(); it < nitems; it += gdim()) {
        const int bh = it / 34, qb = it % 34; const int b = bh >> 3, h = bh & 7;
        const int nkeys = qb < 2 ? TC : TK;
        const int tq = qb * 128 + qi;
        const bf16_t* qp = Q + ((size_t)bh * TK + tq) * 192 + part * 48;
        float q[48];
#pragma unroll
        for (int i = 0; i < 48; ++i) q[i] = bf2f(qp[i]) * ATT_SCALE;
        float o[32];
#pragma unroll
        for (int i = 0; i < 32; ++i) o[i] = 0.f;
        float m = -1e30f, l = 0.f;
        for (int k0 = 0; k0 < nkeys; k0 += 32) {
            __syncthreads();
            {
                const bf16_t* kg = K + ((size_t)bh * TK + k0) * 192; const bf16_t* vg = V + ((size_t)bh * TK + k0) * 128;
                for (int c = tid; c < 768; c += NTHR) *(u32x4*)(Ks + c * 8) = *(const u32x4*)(kg + c * 8);
                *(u32x4*)(Vs + tid * 8) = *(const u32x4*)(vg + tid * 8);
            }
            __syncthreads();
#pragma unroll 1
            for (int kg = 0; kg < 32; kg += 8) {
                float s[8]; float tmax = -1e30f;
#pragma unroll
                for (int kk = 0; kk < 8; ++kk) {
                    const bf16_t* kr = Ks + (kg + kk) * 192 + part * 48; float acc = 0.f;
#pragma unroll
                    for (int i = 0; i < 48; ++i) acc += q[i] * bf2f(kr[i]);
                    acc += __shfl_xor(acc, 1); acc += __shfl_xor(acc, 2);
                    s[kk] = acc; tmax = fmaxf(tmax, acc);
                    asm volatile("" ::: "memory");
                }
                const float mn = fmaxf(m, tmax), alpha = expf(m - mn); m = mn; l *= alpha;
#pragma unroll
                for (int i = 0; i < 32; ++i) o[i] *= alpha;
#pragma unroll
                for (int kk = 0; kk < 8; ++kk) {
                    const float pw = expf(s[kk] - mn); l += pw;
                    const bf16_t* vr = Vs + (kg + kk) * 128 + part * 32;
#pragma unroll
                    for (int i = 0; i < 32; ++i) o[i] += pw * bf2f(vr[i]);
                    asm volatile("" ::: "memory");
                }
            }
        }
        const float rl = 1.f / l;
        const int row = qb < 2 ? (NLAT + b * TC + tq) : (b * TL + tq - TC);
        bf16_t* op = O + (size_t)row * D + h * 128 + part * 32;
#pragma unroll
        for (int i = 0; i < 32; ++i) op[i] = f2bf(o[i] * rl);
    }
}


namespace fa {
using s16x4  = __attribute__((ext_vector_type(4))) short;
using f32x16 = __attribute__((ext_vector_type(16))) float;
constexpr int DQK = 192, DV = 128, KVBLK = 64;
constexpr float THR = 8.f;
constexpr int SHM_V = KVBLK * DV * 2, SHM_K = KVBLK * DQK * 2;
constexpr int SHM_ATTN = 2 * SHM_V + 2 * SHM_K + 8 * 64 * 4;
#define KSWZ(row, colB) ((row) * 384 + ((colB) ^ ((((row) >> 1) & 7) << 4)))
#define SBAR() __builtin_amdgcn_sched_barrier(0)
__device__ __forceinline__ int crow(int r, int hi) { return (r & 3) + 8 * (r >> 2) + 4 * hi; }
__device__ __forceinline__ unsigned cvtpk(float lo, float hi) { unsigned r; asm volatile("v_cvt_pk_bf16_f32 %0, %1, %2" : "=v"(r) : "v"(lo), "v"(hi)); return r; }
__device__ __forceinline__ void partialSM(f32x16& p0, f32x16& p1, float& m_reg, float& mn, float& alpha) {
  constexpr float C = ATT_SCALE * 1.4426950408889634f;
  float pmax = p0[0];
#pragma unroll
  for (int r = 1; r < 16; ++r) pmax = fmaxf(pmax, p0[r]);
#pragma unroll
  for (int r = 0; r < 16; ++r) pmax = fmaxf(pmax, p1[r]);
  { auto rr = __builtin_amdgcn_permlane32_swap(__float_as_uint(pmax), __float_as_uint(pmax), false, false);
    pmax = fmaxf(__uint_as_float(rr[0]), __uint_as_float(rr[1])); }
  if (__builtin_expect(__all(pmax - m_reg <= THR / ATT_SCALE), 1)) { mn = m_reg; alpha = 1.f; }
  else { mn = fmaxf(m_reg, pmax); alpha = __builtin_amdgcn_exp2f((m_reg - mn) * C); m_reg = mn; }
  float mnC = -mn * C;
#pragma unroll
  for (int r = 0; r < 16; ++r) p0[r] = fmaf(p0[r], C, mnC);
#pragma unroll
  for (int r = 0; r < 16; ++r) p1[r] = fmaf(p1[r], C, mnC);
#pragma unroll
  for (int r = 0; r < 16; ++r) p0[r] = __builtin_amdgcn_exp2f(p0[r]);
}
__device__ __forceinline__ void finishSM(f32x16& p0, f32x16& p1, float alpha, float& l_reg, bf16x8& pa0, bf16x8& pa1, bf16x8& pa2, bf16x8& pa3) {
#pragma unroll
  for (int r = 0; r < 16; ++r) p1[r] = __builtin_amdgcn_exp2f(p1[r]);
  float ps = 0;
#pragma unroll
  for (int r = 0; r < 16; ++r) ps += p0[r];
#pragma unroll
  for (int r = 0; r < 16; ++r) ps += p1[r];
  { auto rr = __builtin_amdgcn_permlane32_swap(__float_as_uint(ps), __float_as_uint(ps), false, false);
    ps = __uint_as_float(rr[0]) + __uint_as_float(rr[1]); }
  l_reg = l_reg * alpha + ps;
#define PK4(P, BASE, OUT) do { unsigned a0 = cvtpk(P[BASE + 0], P[BASE + 1]), a1 = cvtpk(P[BASE + 2], P[BASE + 3]);   \
    unsigned b0 = cvtpk(P[BASE + 4], P[BASE + 5]), b1 = cvtpk(P[BASE + 6], P[BASE + 7]);                              \
    auto r0 = __builtin_amdgcn_permlane32_swap(a0, b0, false, false); auto r1 = __builtin_amdgcn_permlane32_swap(a1, b1, false, false); \
    u32x4 w = {r0[0], r1[0], r0[1], r1[1]}; OUT = *reinterpret_cast<bf16x8*>(&w); } while (0)
  PK4(p0, 0, pa0); PK4(p0, 8, pa1); PK4(p1, 0, pa2); PK4(p1, 8, pa3);
#undef PK4
}
__device__ __forceinline__ void qkt(f32x16& p0, f32x16& p1, const char* Ks, const bf16x8* qr, int r32, int hi) {
  p0 = f32x16{}; p1 = f32x16{};
  const int swz = ((r32 >> 1) & 7) << 4;
  const char* b4[4];
#pragma unroll
  for (int dr = 0; dr < 4; ++dr) b4[dr] = Ks + r32 * 384 + ((dr * 32 + hi * 16) ^ swz);
#pragma unroll
  for (int d0 = 0; d0 < 12; ++d0) {
    bf16x8 b0 = *reinterpret_cast<const bf16x8*>(b4[d0 & 3] + (d0 >> 2) * 128);
    bf16x8 b1 = *reinterpret_cast<const bf16x8*>(b4[d0 & 3] + (d0 >> 2) * 128 + 32 * 384);
    p0 = __builtin_amdgcn_mfma_f32_32x32x16_bf16(b0, qr[d0], p0, 0, 0, 0);
    p1 = __builtin_amdgcn_mfma_f32_32x32x16_bf16(b1, qr[d0], p1, 0, 0, 0); }
}
__device__ __forceinline__ int v_st(int k, int c) { const int kk = (k & ~0xC) | ((k & 4) << 1) | ((k & 8) >> 1); return ((kk >> 3) * 4 + (c >> 5)) * 512 + ((kk & 7) * 32 + (c & 31)) * 2; }
__device__ __forceinline__ int v_rd_base(int lane) { return ((lane & 3) << 3) | (((lane >> 2) & 3) << 6) | (((lane >> 4) & 1) << 5) | (((lane >> 5) & 1) << 8); }
constexpr int v_rd_off(int d0, int ks, int half) { return d0 * 512 + ks * 4096 + half * 2048; }
template <int OFF> __device__ __forceinline__ s16x4 tr_read(int vb) {
  s16x4 r; asm volatile("ds_read_b64_tr_b16 %0, %1 offset:%2" : "=&v"(r) : "v"(vb), "i"(OFF) : "memory"); return r;
}
template <int D0> __device__ __forceinline__ void pv_one(f32x16& od, int vb, bf16x8 pa0, bf16x8 pa1, bf16x8 pa2, bf16x8 pa3) {
  const s16x4 l0 = tr_read<v_rd_off(D0, 0, 0)>(vb), h0 = tr_read<v_rd_off(D0, 0, 1)>(vb), l1 = tr_read<v_rd_off(D0, 1, 0)>(vb), h1 = tr_read<v_rd_off(D0, 1, 1)>(vb);
  const s16x4 l2 = tr_read<v_rd_off(D0, 2, 0)>(vb), h2 = tr_read<v_rd_off(D0, 2, 1)>(vb), l3 = tr_read<v_rd_off(D0, 3, 0)>(vb), h3 = tr_read<v_rd_off(D0, 3, 1)>(vb);
  asm volatile("s_waitcnt lgkmcnt(0)" ::: "memory"); SBAR();
#define PK(L, H) (bf16x8){L[0], L[1], L[2], L[3], H[0], H[1], H[2], H[3]}
  od = __builtin_amdgcn_mfma_f32_32x32x16_bf16(pa0, PK(l0, h0), od, 0, 0, 0);
  od = __builtin_amdgcn_mfma_f32_32x32x16_bf16(pa1, PK(l1, h1), od, 0, 0, 0);
  od = __builtin_amdgcn_mfma_f32_32x32x16_bf16(pa2, PK(l2, h2), od, 0, 0, 0);
  od = __builtin_amdgcn_mfma_f32_32x32x16_bf16(pa3, PK(l3, h3), od, 0, 0, 0);
#undef PK
}
__device__ __forceinline__ void pv_d0(f32x16* o, int vb, bf16x8 pa0, bf16x8 pa1, bf16x8 pa2, bf16x8 pa3) {
  pv_one<0>(o[0], vb, pa0, pa1, pa2, pa3); pv_one<1>(o[1], vb, pa0, pa1, pa2, pa3); pv_one<2>(o[2], vb, pa0, pa1, pa2, pa3); pv_one<3>(o[3], vb, pa0, pa1, pa2, pa3);
}
__device__ __forceinline__ void attn_body(const int wv_, const bf16_t* __restrict__ Qb, const bf16_t* __restrict__ Kh, const bf16_t* __restrict__ Vh, bf16_t* __restrict__ Ob, int ldo, int seq, char* lds, const float* __restrict__ ropecs  ) {
  const int tid = tidx_w(wv_), wid = tid >> 6, lane = tid & 63, r32 = lane & 31, hi = lane >> 5;
  char* V_lds = lds; char* K_lds = lds + 2 * SHM_V;
  float* ws = (float*)(lds + 2 * SHM_V + 2 * SHM_K) + wid * 64; float* li_l = ws; float* al_l = ws + 32;
  float m_reg = -1e30f, l_reg = 0; f32x16 o[4] = {}; bf16x8 qr[12];
  const bf16_t* Qw = Qb + (long)(wid * 32 + r32) * DQK + hi * 8;
#pragma unroll
  for (int d0 = 0; d0 < 12; ++d0) qr[d0] = *reinterpret_cast<const bf16x8*>(Qw + d0 * 16);
  if (ropecs) {
    const float* cs = ropecs + (size_t)(wid * 32 + r32) * 64;
#pragma unroll
    for (int d0 = 8; d0 < 12; ++d0) { const int i0 = (d0 - 8) * 8 + hi * 4; const f32x4 c0 = *(const f32x4*)(cs + i0 * 2), c1 = *(const f32x4*)(cs + i0 * 2 + 4);
      u32x4 w = *reinterpret_cast<u32x4*>(&qr[d0]); const float cc[4] = {c0[0], c0[2], c1[0], c1[2]}, ss[4] = {c0[1], c0[3], c1[1], c1[3]};
#pragma unroll
      for (int m = 0; m < 4; ++m) { const float x1 = __uint_as_float(w[m] << 16), x2 = __uint_as_float(w[m] & 0xffff0000u); w[m] = cvtpk(x1 * cc[m] - x2 * ss[m], x1 * ss[m] + x2 * cc[m]); }
      qr[d0] = *reinterpret_cast<bf16x8*>(&w); }
  }
  const int sr = tid >> 4, sc = (tid & 15) * 8, vst0 = v_st(sr, sc), vst1 = v_st(32 + sr, sc);
  int kst[3];
#pragma unroll
  for (int i = 0; i < 3; ++i) { const int c = tid + 512 * i, row = c / 24, cc = c % 24; kst[i] = KSWZ(row, cc * 16); }
  const int vb0 = (int)(uintptr_t)V_lds + v_rd_base(lane);
  struct { bf16x8 vs0, vs1, ks0, ks1, ks2; } sr_[1];
#define SLOAD(i, k0) do { const bf16_t* vt = Vh + (long)(k0) * DV; const bf16_t* kt = Kh + (long)(k0) * DQK; \
    sr_[i].vs0 = *reinterpret_cast<const bf16x8*>(vt + (sr) * DV + sc); sr_[i].vs1 = *reinterpret_cast<const bf16x8*>(vt + (32 + sr) * DV + sc); \
    sr_[i].ks0 = *reinterpret_cast<const bf16x8*>(kt + tid * 8); sr_[i].ks1 = *reinterpret_cast<const bf16x8*>(kt + (tid + 512) * 8); sr_[i].ks2 = *reinterpret_cast<const bf16x8*>(kt + (tid + 1024) * 8); } while (0)
#define SWRITE(b, i) do { *(bf16x8*)(V_lds + (b) * SHM_V + vst0) = sr_[i].vs0; *(bf16x8*)(V_lds + (b) * SHM_V + vst1) = sr_[i].vs1; \
    *(bf16x8*)(K_lds + (b) * SHM_K + kst[0]) = sr_[i].ks0; *(bf16x8*)(K_lds + (b) * SHM_K + kst[1]) = sr_[i].ks1; *(bf16x8*)(K_lds + (b) * SHM_K + kst[2]) = sr_[i].ks2; } while (0)
#define SWAIT() asm volatile("s_waitcnt vmcnt(5)" ::: "memory")
#define RESC(a) do { if (__any((a) < 1.f)) { if (hi == 0) al_l[r32] = (a); asm volatile("s_waitcnt lgkmcnt(0)" ::: "memory"); \
    _Pragma("unroll") for (int d = 0; d < 4; ++d) _Pragma("unroll") for (int r = 0; r < 16; ++r) o[d][r] *= al_l[crow(r, hi)]; } } while (0)
  f32x16 pA0, pA1; float mnA, alA; bf16x8 pa0, pa1, pa2, pa3; const int NT = seq / KVBLK;
  SLOAD(0, 0); SWRITE(0, 0);
  SLOAD(0, KVBLK);
  __syncthreads();
  for (int j = 0; j < NT; j += 2) {
    SBAR(); qkt(pA0, pA1, K_lds, qr, r32, hi);
    partialSM(pA0, pA1, m_reg, mnA, alA); RESC(alA);
    finishSM(pA0, pA1, alA, l_reg, pa0, pa1, pa2, pa3); SBAR();
    SWRITE(1, 0);
    if (j + 2 < NT) SLOAD(0, (j + 2) * KVBLK);
    SBAR();
    pv_d0(o, vb0, pa0, pa1, pa2, pa3);
    __syncthreads();
    SBAR(); qkt(pA0, pA1, K_lds + SHM_K, qr, r32, hi);
    partialSM(pA0, pA1, m_reg, mnA, alA); RESC(alA);
    finishSM(pA0, pA1, alA, l_reg, pa0, pa1, pa2, pa3); SBAR();
    if (j + 2 < NT) { SWRITE(0, 0); if (j + 3 < NT) SLOAD(0, (j + 3) * KVBLK); }
    SBAR();
    pv_d0(o, vb0 + SHM_V, pa0, pa1, pa2, pa3);
    __syncthreads();
  }
  if (hi == 0) li_l[r32] = l_reg; asm volatile("s_waitcnt lgkmcnt(0)" ::: "memory");
  float rli[16];
#pragma unroll
  for (int r = 0; r < 16; ++r) rli[r] = __builtin_amdgcn_rcpf(li_l[crow(r, hi)]);
  bf16_t* Ow = Ob + (long)(wid * 32) * ldo;
#pragma unroll
  for (int r = 0; r < 16; ++r) { int orow = crow(r, hi);
#pragma unroll
    for (int d0 = 0; d0 < 4; ++d0) Ow[(long)orow * ldo + d0 * 32 + r32] = f2bf(o[d0][r] * rli[r]); }
  __syncthreads();
#undef SLOAD
#undef SWRITE
#undef SWAIT
#undef RESC
}
#undef KSWZ
}

__device__ void ph_attn(const Params& p, char* lds) {
    const bf16_t* Q = (const bf16_t*)(p.ws + OFF_Q); const bf16_t* K = (const bf16_t*)(p.ws + OFF_K); const bf16_t* V = (const bf16_t*)(p.ws + OFF_V);
    bf16_t* O = (bf16_t*)(p.ws + OFF_O);
    const int G = gdim();
    for (int i = 0;; ++i) {
        const int L = i * G + bidx(); if (L >= 544) break;
        int bh, qb;
        if (L < 512) { const int w = g8::xcd_remap(L, 512); bh = w >> 4; qb = 1 + (w & 15); } else { bh = L - 512; qb = 0; }
        const int b = bh >> 3, h = bh & 7;
        const int seq = qb == 0 ? TC : TK;
        const int row0 = qb == 0 ? NLAT + b * TC : b * TL + (qb - 1) * 256;
        fa::attn_body(p.wv, Q + ((size_t)bh * TK + qb * 256) * 192, K + (size_t)bh * TK * 192, V + (size_t)bh * TK * 128, O + (size_t)row0 * D + h * 128, D, seq, lds,
                      qb == 0 ? nullptr : (const float*)(p.ws + OFF_ROPE_C) + (size_t)(qb - 1) * 256 * 64);
    }
}

__device__ void ph_norm2_router(const Params& p, int layer, char* lds, int nrows) {
    const int tid = tidx(), wid = tid >> 6, lane = tid & 63;
    float* rt = (float*)lds;
    const float* rg = p.moe_router + (size_t)layer * D * NE;
    for (int i = tid; i < D * NE / 4; i += NTHR) { const int d = i >> 2, eq = i & 3; ((float4*)rt)[(((d >> 8) * 4 + (d & 3)) * 4 + eq) * 64 + ((d & 255) >> 2)] = ((const float4*)rg)[i]; }
    __syncthreads();
    const xt_t* X = (const xt_t*)(p.ws + OFF_X); bf16_t* BN = (bf16_t*)(p.ws + OFF_H); float* AFF = (float*)(p.ws + OFF_AFF);
    const float* g = p.norm2_g + layer * D;
    const int w_ = bidx() * 8 + wid, nw_ = gdim() * 8;
    int row = (int)((long long)w_ * nrows / nw_); const int rend = (int)((long long)(w_ + 1) * nrows / nw_);
    float4 nv[4], gm[4], bb[4]; int scur = -1;
    if (row < rend) {
#pragma unroll
        for (int i = 0; i < 4; ++i) nv[i] = xld(X, (size_t)row * D + (lane + i * 64) * 4); }
    for (; row < rend; ++row) {
        const int s = row_stream(row);
        if (s != scur) { scur = s; const float* sh = modp(p, layer, s, 3); const float* sc = modp(p, layer, s, 4);
#pragma unroll
            for (int i = 0; i < 4; ++i) { const int d = (lane + i * 64) * 4; const float4 gg = *(const float4*)(g + d), a = *(const float4*)(sc + d); bb[i] = *(const float4*)(sh + d);
                gm[i] = make_float4(gg.x * (1.f + a.x), gg.y * (1.f + a.y), gg.z * (1.f + a.z), gg.w * (1.f + a.w)); } }
        float4 v[4]; float ss = 0;
#pragma unroll
        for (int i = 0; i < 4; ++i) { v[i] = nv[i]; ss += v[i].x * v[i].x + v[i].y * v[i].y + v[i].z * v[i].z + v[i].w * v[i].w; }
        { const int nrow = row + 1;
          if (nrow < rend) {
#pragma unroll
              for (int i = 0; i < 4; ++i) nv[i] = xld(X, (size_t)nrow * D + (lane + i * 64) * 4); } }
        ss = wave_sum(ss); const float rs = rsqrtf(ss * (1.f / D) + RMS_EPS);
        float lg[16];
#pragma unroll
        for (int e = 0; e < 16; ++e) lg[e] = 0.f;
#pragma unroll
        for (int i = 0; i < 4; ++i) {
            const int d = (lane + i * 64) * 4;
            float o[4]; o[0] = v[i].x * rs * gm[i].x + bb[i].x; o[1] = v[i].y * rs * gm[i].y + bb[i].y; o[2] = v[i].z * rs * gm[i].z + bb[i].z; o[3] = v[i].w * rs * gm[i].w + bb[i].w;
            uint2 w; w.x = pk2(o[0], o[1]); w.y = pk2(o[2], o[3]); *(uint2*)(BN + (size_t)row * D + d) = w;
#pragma unroll
            for (int jj = 0; jj < 4; ++jj) {
#pragma unroll
                for (int eq = 0; eq < 4; ++eq) { const float4 r4 = ((const float4*)rt)[((i * 4 + jj) * 4 + eq) * 64 + lane];
                    lg[4 * eq] += o[jj] * r4.x; lg[4 * eq + 1] += o[jj] * r4.y; lg[4 * eq + 2] += o[jj] * r4.z; lg[4 * eq + 3] += o[jj] * r4.w; } }
            asm volatile("" ::: "memory");
        }
        float mx = -1e30f;
#pragma unroll
        for (int e = 0; e < 16; ++e) { lg[e] = wave_sum(lg[e]); mx = fmaxf(mx, lg[e]); }
        float sum = 0;
#pragma unroll
        for (int e = 0; e < 16; ++e) { lg[e] = expf(lg[e] - mx); sum += lg[e]; }
        const float inv = 1.f / sum;
        if (lane < 16) { float val = 0;
#pragma unroll
            for (int e = 0; e < 16; ++e) val = (lane == e) ? lg[e] : val;
            AFF[(size_t)row * 16 + lane] = val * inv; }
    }
}

__device__ void ph_norm2_router_mm(const Params& p, int layer, char* lds, int nrows) {
    typedef __attribute__((address_space(3))) char lch;
    constexpr int PB = 2064;
    constexpr int O_RH = 0, O_RL = 16 * PB, O_A = 32 * PB, A_BUF = 16 * PB, O_P = O_A + 2 * A_BUF, P_BUF = 8 * 8 * 16 * 4;
    const int tid = tidx(), wid = __builtin_amdgcn_readfirstlane(tid >> 6), lane = tid & 63;
    lch* L = (lch*)lds;
    const float* rg = p.moe_router + (size_t)layer * D * NE;
    for (int i = tid; i < D * NE / 4; i += NTHR) { const int d = i >> 2, eq = i & 3; const float4 r4 = ((const float4*)rg)[i]; const float rr[4] = {r4.x, r4.y, r4.z, r4.w};
#pragma unroll
        for (int u = 0; u < 4; ++u) { const unsigned h = pk2(rr[u], rr[u]) & 0xffffu; const float lo = rr[u] - __uint_as_float(h << 16);
            *(LAS bf16_t*)(L + O_RH + (4 * eq + u) * PB + d * 2) = (bf16_t)h; *(LAS bf16_t*)(L + O_RL + (4 * eq + u) * PB + d * 2) = f2bf(lo); } }
    const xt_t* X = (const xt_t*)(p.ws + OFF_X); bf16_t* BN = (bf16_t*)(p.ws + OFF_H); float* AFF = (float*)(p.ws + OFF_AFF);
    const float* g = p.norm2_g + layer * D;
    const int nch = nrows / 8;
    int ch = (int)((long long)bidx() * nch / gdim()); const int chend = (int)((long long)(bidx() + 1) * nch / gdim());
    float4 nv[4], gm[4], bb[4]; int scur = -1;
    if (ch < chend) {
#pragma unroll
        for (int i = 0; i < 4; ++i) nv[i] = xld(X, (size_t)(ch * 8 + wid) * D + (lane + i * 64) * 4); }
    for (int it = 0; ch < chend; ++ch, ++it) {
        const int row = ch * 8 + wid, buf = it & 1;
        const int s = row_stream(row);
        if (s != scur) { scur = s; const float* sh = modp(p, layer, s, 3); const float* sc = modp(p, layer, s, 4);
#pragma unroll
            for (int i = 0; i < 4; ++i) { const int d = (lane + i * 64) * 4; const float4 gg = *(const float4*)(g + d), a = *(const float4*)(sc + d); bb[i] = *(const float4*)(sh + d);
                gm[i] = make_float4(gg.x * (1.f + a.x), gg.y * (1.f + a.y), gg.z * (1.f + a.z), gg.w * (1.f + a.w)); } }
        float4 v[4]; float ss = 0;
#pragma unroll
        for (int i = 0; i < 4; ++i) { v[i] = nv[i]; ss += v[i].x * v[i].x + v[i].y * v[i].y + v[i].z * v[i].z + v[i].w * v[i].w; }
        if (ch + 1 < chend) {
#pragma unroll
            for (int i = 0; i < 4; ++i) nv[i] = xld(X, (size_t)(row + 8) * D + (lane + i * 64) * 4); }
        ss = wave_sum(ss); const float rs = rsqrtf(ss * (1.f / D) + RMS_EPS);
        lch* AH = L + O_A + buf * A_BUF + wid * PB; lch* AL = AH + 8 * PB;
#pragma unroll
        for (int i = 0; i < 4; ++i) {
            const int d = (lane + i * 64) * 4;
            float o[4]; o[0] = v[i].x * rs * gm[i].x + bb[i].x; o[1] = v[i].y * rs * gm[i].y + bb[i].y; o[2] = v[i].z * rs * gm[i].z + bb[i].z; o[3] = v[i].w * rs * gm[i].w + bb[i].w;
            u32x2 wh; wh.x = pk2(o[0], o[1]); wh.y = pk2(o[2], o[3]);
            uint2 wg_; wg_.x = wh.x; wg_.y = wh.y; *(uint2*)(BN + (size_t)row * D + d) = wg_;
            u32x2 wl; wl.x = pk2(o[0] - __uint_as_float(wh.x << 16), o[1] - __uint_as_float(wh.x & 0xffff0000u)); wl.y = pk2(o[2] - __uint_as_float(wh.y << 16), o[3] - __uint_as_float(wh.y & 0xffff0000u));
            *(LAS u32x2*)(AH + d * 2) = wh; *(LAS u32x2*)(AL + d * 2) = wl;
        }
        __syncthreads();
        {
            f32x4 acc = {0.f, 0.f, 0.f, 0.f};
            const lch* ah = L + O_A + buf * A_BUF + (lane & 7) * PB + (128 * wid + 8 * (lane >> 4)) * 2;
            const lch* bh = L + O_RH + (lane & 15) * PB + (128 * wid + 8 * (lane >> 4)) * 2;
#pragma unroll
            for (int ks = 0; ks < 4; ++ks) {
                const bf16x8 a_h = *(const LAS bf16x8*)(ah + ks * 64), a_l = *(const LAS bf16x8*)(ah + 8 * PB + ks * 64);
                const bf16x8 b_h = *(const LAS bf16x8*)(bh + ks * 64), b_l = *(const LAS bf16x8*)(bh + 16 * PB + ks * 64);
                acc = __builtin_amdgcn_mfma_f32_16x16x32_bf16(a_h, b_h, acc, 0, 0, 0);
                acc = __builtin_amdgcn_mfma_f32_16x16x32_bf16(a_h, b_l, acc, 0, 0, 0);
                acc = __builtin_amdgcn_mfma_f32_16x16x32_bf16(a_l, b_h, acc, 0, 0, 0);
            }
            if (lane < 32) {
#pragma unroll
                for (int e = 0; e < 4; ++e) *(LAS float*)(L + O_P + buf * P_BUF + ((wid * 8 + 4 * (lane >> 4) + e) * 16 + (lane & 15)) * 4) = acc[e]; }
        }
        __syncthreads();
        if (tid < 128) {
            float lg = 0.f;
#pragma unroll
            for (int w8 = 0; w8 < 8; ++w8) lg += *(const LAS float*)(L + O_P + buf * P_BUF + (w8 * 128 + tid) * 4);
            float mx = lg;
            mx = fmaxf(mx, __builtin_bit_cast(float, __builtin_amdgcn_update_dpp(0, __builtin_bit_cast(int, mx), 0xB1, 0xF, 0xF, true)));
            mx = fmaxf(mx, __builtin_bit_cast(float, __builtin_amdgcn_update_dpp(0, __builtin_bit_cast(int, mx), 0x4E, 0xF, 0xF, true)));
            mx = fmaxf(mx, __builtin_bit_cast(float, __builtin_amdgcn_update_dpp(0, __builtin_bit_cast(int, mx), 0x141, 0xF, 0xF, true)));
            mx = fmaxf(mx, __builtin_bit_cast(float, __builtin_amdgcn_update_dpp(0, __builtin_bit_cast(int, mx), 0x140, 0xF, 0xF, true)));
            const float ex = expf(lg - mx); const float sum = dpp_sum16(ex);
            AFF[(size_t)(ch * 8) * 16 + tid] = ex / sum;
        }
    }
}

__device__ void ph_select(const Params& p, char* lds, int ngroups) {
    const int tid = tidx(), wid = tid >> 6, lane = tid & 63;
    unsigned* hist = (unsigned*)lds;
    unsigned* ctl = hist + 256;
    unsigned* wsum = ctl + 8;
    int* rowl = (int*)(wsum + 16);
    const float* AFF = (const float*)(p.ws + OFF_AFF);
    int* ROWIDX = (int*)(p.ws + OFF_ROWIDX); float* GATE = (float*)(p.ws + OFF_GATE); int* SLOT = (int*)(p.ws + OFF_SLOT);
    for (int gidx = bidx(); gidx < ngroups; gidx += gdim()) {
        const bool lat = gidx < 64; const int b = (gidx & 63) >> 4, e = gidx & 15;
        const int n = lat ? TL : TC, cap = lat ? CAPL : CAPC;
        const int row0 = lat ? b * TL : NLAT + b * TC, slot0 = lat ? b * CAPL : NB * CAPL + b * CAPC;
        unsigned key[8];
#pragma unroll
        for (int i = 0; i < 8; ++i) { const int idx = tid * 8 + i; key[i] = idx < n ? __float_as_uint(AFF[(size_t)(row0 + idx) * 16 + e]) : 0u; }
        unsigned prefix = 0u, remaining = (unsigned)cap;
#pragma unroll
        for (int pass = 0; pass < 4; ++pass) {
            const int sh = 24 - 8 * pass;
            __syncthreads();
            if (tid < 256) hist[tid] = 0u;
            __syncthreads();
#pragma unroll
            for (int i = 0; i < 8; ++i) { const int idx = tid * 8 + i;
                const bool cand = idx < n && (pass == 0 || (key[i] >> (sh + 8)) == prefix);
                if (cand) atomicAdd(&hist[(key[i] >> sh) & 255u], 1u); }
            __syncthreads();
            if (tid < 256) { unsigned gt = 0; for (int jj = tid + 1; jj < 256; ++jj) gt += hist[jj];
                const unsigned mine = hist[tid];
                if (gt < remaining && remaining <= gt + mine) { ctl[0] = (unsigned)tid; ctl[1] = remaining - gt; } }
            __syncthreads();
            prefix = (prefix << 8) | ctl[0]; remaining = ctl[1];
        }
        const unsigned T = prefix, m = remaining;
        unsigned cgt = 0, ceq = 0;
#pragma unroll
        for (int i = 0; i < 8; ++i) { const int idx = tid * 8 + i; if (idx < n) { cgt += key[i] > T ? 1u : 0u; ceq += key[i] == T ? 1u : 0u; } }
        auto block_excl = [&](unsigned v) -> unsigned {
            unsigned inc = v;
#pragma unroll
            for (int o = 1; o < 64; o <<= 1) { const unsigned t = (unsigned)__builtin_amdgcn_ds_bpermute((lane - o) << 2, (int)inc); if (lane >= o) inc += t; }
            __syncthreads();
            if (lane == 63) wsum[wid] = inc;
            __syncthreads();
            unsigned base = 0;
#pragma unroll
            for (int w = 0; w < 8; ++w) base += (w < wid) ? wsum[w] : 0u;
            return base + inc - v; };
        unsigned eqbase = block_excl(ceq);
        unsigned nsel = 0; bool sel[8];
#pragma unroll
        for (int i = 0; i < 8; ++i) { const int idx = tid * 8 + i; bool s_ = false;
            if (idx < n) { if (key[i] > T) s_ = true; else if (key[i] == T) { s_ = eqbase < m; ++eqbase; } }
            sel[i] = s_; nsel += s_ ? 1u : 0u; }
        unsigned sbase = block_excl(nsel);
#pragma unroll
        for (int i = 0; i < 8; ++i) { const int idx = tid * 8 + i;
            if (idx < n) {
                if (sel[i]) { const int sl = slot0 + (int)sbase; rowl[sbase] = row0 + idx; ++sbase; ROWIDX[e * ESLOTS + sl] = row0 + idx; GATE[e * EPAD + sl] = __uint_as_float(key[i]); SLOT[(size_t)(row0 + idx) * 16 + e] = sl; }
                else SLOT[(size_t)(row0 + idx) * 16 + e] = -1; } }
        __syncthreads();
        { const bf16_t* BN = (const bf16_t*)(p.ws + OFF_H); bf16_t* XE = (bf16_t*)(p.ws + OFF_XE);
          for (int r = wid; r < cap; r += 32) {
              u32x4 t_[4][2];
#pragma unroll
              for (int u = 0; u < 4; ++u) { const u32x4* src = (const u32x4*)(BN + (size_t)rowl[r + 8 * u] * D); t_[u][0] = src[lane]; t_[u][1] = src[lane + 64]; }
#pragma unroll
              for (int u = 0; u < 4; ++u) { u32x4* dst = (u32x4*)(XE + ((size_t)e * EPAD + slot0 + r + 8 * u) * D); dst[lane] = t_[u][0]; dst[lane + 64] = t_[u][1]; } } }
    }
}

__device__ void ph_gather(const Params& p, int nslots) {
    const int wid = tidx() >> 6, lane = tidx() & 63;
    const int* ROWIDX = (const int*)(p.ws + OFF_ROWIDX); const bf16_t* BN = (const bf16_t*)(p.ws + OFF_H); bf16_t* XE = (bf16_t*)(p.ws + OFF_XE);
    for (int it = bidx() * 8 + wid; it < NE * ESLOTS; it += gdim() * 8) {
        const int e = it / ESLOTS, sl = it % ESLOTS; if (sl >= nslots) continue; const int row = ROWIDX[it];
        const u32x4* src = (const u32x4*)(BN + (size_t)row * D); u32x4* dst = (u32x4*)(XE + ((size_t)e * EPAD + sl) * D);
        dst[lane] = src[lane]; dst[lane + 64] = src[lane + 64];
    }
}

__device__ void ph_combine(const Params& p, int layer, int nrows) {
    const int wid = tidx() >> 6, lane = tidx() & 63;
    const int* SLOT = (const int*)(p.ws + OFF_SLOT); const bf16_t* YE = (const bf16_t*)(p.ws + OFF_YE); xt_t* X = (xt_t*)(p.ws + OFF_X);
    int row = bidx() * 8 + wid;
    int sl = (row < nrows && lane < 16) ? SLOT[(size_t)row * 16 + lane] : -1;
    while (row < nrows) {
        const int nrow = row + gdim() * 8;
        const int sln = (nrow < nrows && lane < 16) ? SLOT[(size_t)nrow * 16 + lane] : -1;
        const float* gt = modp(p, layer, row_stream(row), 5);
        xt_t* xr = X + (size_t)row * D + lane * 8;
        f32x4 xv[4];
#pragma unroll
        for (int i = 0; i < 2; ++i) { xv[2 * i] = xldv(xr, 512 * i); xv[2 * i + 1] = xldv(xr, 512 * i + 4); }
        unsigned long long m = __ballot(sl >= 0);
        float acc[16];
#pragma unroll
        for (int i = 0; i < 16; ++i) acc[i] = 0.f;
        while (m) {
            const int e0 = __builtin_ctzll(m); m &= m - 1; const bool two = m != 0; const int e1 = two ? __builtin_ctzll(m) : e0; if (two) m &= m - 1;
            const int s0 = __builtin_amdgcn_readlane(sl, e0), s1 = __builtin_amdgcn_readlane(sl, e1);
            const bf16_t* y0 = YE + ((size_t)e0 * EPAD + s0) * D + lane * 8; const bf16_t* y1 = YE + ((size_t)e1 * EPAD + s1) * D + lane * 8;
            const u32x4 a0 = *(const u32x4*)y0, a1 = *(const u32x4*)(y0 + 512), b0 = *(const u32x4*)y1, b1 = *(const u32x4*)(y1 + 512);
            const float f1 = two ? 1.f : 0.f;
#pragma unroll
            for (int i = 0; i < 4; ++i) { acc[2 * i] += __uint_as_float(a0[i] << 16) + f1 * __uint_as_float(b0[i] << 16); acc[2 * i + 1] += __uint_as_float(a0[i] & 0xffff0000u) + f1 * __uint_as_float(b0[i] & 0xffff0000u);
                acc[8 + 2 * i] += __uint_as_float(a1[i] << 16) + f1 * __uint_as_float(b1[i] << 16); acc[8 + 2 * i + 1] += __uint_as_float(a1[i] & 0xffff0000u) + f1 * __uint_as_float(b1[i] & 0xffff0000u); }
        }
#pragma unroll
        for (int i = 0; i < 2; ++i) { const f32x4 g0 = *(const f32x4*)(gt + lane * 8 + 512 * i), g1 = *(const f32x4*)(gt + lane * 8 + 512 * i + 4);
            f32x4 o0 = xv[2 * i], o1 = xv[2 * i + 1];
#pragma unroll
            for (int e = 0; e < 4; ++e) { o0[e] += g0[e] * acc[8 * i + e]; o1[e] += g1[e] * acc[8 * i + 4 + e]; }
            xstv(xr, 512 * i, o0); xstv(xr, 512 * i + 4, o1); }
        row = nrow; sl = sln;
    }
}

template <bool FINAL>
__device__ void ph_comb_norm(const Params& p, int lprev, int layer, int nrows) {
    const int wid = tidx() >> 6, lane = tidx() & 63;
    const int* SLOT = (const int*)(p.ws + OFF_SLOT); const bf16_t* YE = (const bf16_t*)(p.ws + OFF_YE); xt_t* X = (xt_t*)(p.ws + OFF_X);
    bf16_t* H = (bf16_t*)(p.ws + OFF_H);
    const float* g = FINAL ? p.final_g : p.norm1_g + layer * D;
    int row = bidx() * 8 + wid;
    int sl = (row < nrows && lane < 16) ? SLOT[(size_t)row * 16 + lane] : -1;
    while (row < nrows) {
        const int nrow = row + gdim() * 8;
        const int sln = (nrow < nrows && lane < 16) ? SLOT[(size_t)nrow * 16 + lane] : -1;
        const int strm = row_stream(row);
        const float* gt = modp(p, lprev, strm, 5);
        xt_t* xr = X + (size_t)row * D + lane * 8;
        f32x4 xv[4];
#pragma unroll
        for (int i = 0; i < 2; ++i) { xv[2 * i] = xldv(xr, 512 * i); xv[2 * i + 1] = xldv(xr, 512 * i + 4); }
        unsigned long long m = __ballot(sl >= 0);
        float acc[16];
#pragma unroll
        for (int i = 0; i < 16; ++i) acc[i] = 0.f;
        while (m) {
            const int e0 = __builtin_ctzll(m); m &= m - 1; const bool two = m != 0; const int e1 = two ? __builtin_ctzll(m) : e0; if (two) m &= m - 1;
            const int s0 = __builtin_amdgcn_readlane(sl, e0), s1 = __builtin_amdgcn_readlane(sl, e1);
            const bf16_t* y0 = YE + ((size_t)e0 * EPAD + s0) * D + lane * 8; const bf16_t* y1 = YE + ((size_t)e1 * EPAD + s1) * D + lane * 8;
            const u32x4 a0 = *(const u32x4*)y0, a1 = *(const u32x4*)(y0 + 512), b0 = *(const u32x4*)y1, b1 = *(const u32x4*)(y1 + 512);
            const float f1 = two ? 1.f : 0.f;
#pragma unroll
            for (int i = 0; i < 4; ++i) { acc[2 * i] += __uint_as_float(a0[i] << 16) + f1 * __uint_as_float(b0[i] << 16); acc[2 * i + 1] += __uint_as_float(a0[i] & 0xffff0000u) + f1 * __uint_as_float(b0[i] & 0xffff0000u);
                acc[8 + 2 * i] += __uint_as_float(a1[i] << 16) + f1 * __uint_as_float(b1[i] << 16); acc[8 + 2 * i + 1] += __uint_as_float(a1[i] & 0xffff0000u) + f1 * __uint_as_float(b1[i] & 0xffff0000u); }
        }
        float ss = 0.f;
#pragma unroll
        for (int i = 0; i < 2; ++i) { const f32x4 g0 = *(const f32x4*)(gt + lane * 8 + 512 * i), g1 = *(const f32x4*)(gt + lane * 8 + 512 * i + 4);
#pragma unroll
            for (int e = 0; e < 4; ++e) { xv[2 * i][e] += g0[e] * acc[8 * i + e]; xv[2 * i + 1][e] += g1[e] * acc[8 * i + 4 + e]; ss += xv[2 * i][e] * xv[2 * i][e] + xv[2 * i + 1][e] * xv[2 * i + 1][e]; }
            if (!FINAL) { xstv(xr, 512 * i, xv[2 * i]); xstv(xr, 512 * i + 4, xv[2 * i + 1]); } }
        ss = wave_sum(ss); const float rs = rsqrtf(ss * (1.f / D) + RMS_EPS);
        const float* sh = FINAL ? nullptr : modp(p, layer, strm, 0); const float* sc = FINAL ? nullptr : modp(p, layer, strm, 1);
#pragma unroll
        for (int i = 0; i < 2; ++i)
#pragma unroll
            for (int hh = 0; hh < 2; ++hh) { const int d = lane * 8 + 512 * i + 4 * hh; const f32x4 gg = *(const f32x4*)(g + d); f32x4 o = xv[2 * i + hh] * rs * gg;
                if (FINAL) *(f32x4*)(p.out + (size_t)row * D + d) = o;
                else { o = o * (1.f + *(const f32x4*)(sc + d)) + *(const f32x4*)(sh + d); stbf4(H + (size_t)row * D + d, o); } }
        row = nrow; sl = sln;
    }
}

__device__ void ph_rw_normxs(const Params& p, int layer, int j) {
    const int wid = tidx() >> 6, lane = tidx() & 63;
    const xt_t* X = (const xt_t*)(p.ws + OFF_X); bf16_t* XS = (bf16_t*)(p.ws + OFF_XS);
    const float* mu = p.rw_mu + (size_t)j * 6 * D; const float* g = p.norm1_g + layer * D;
    const int w = bidx() * 8 + wid, nw = gdim() * 8;
    const int r0 = (int)((long long)w * NROW / nw), r1 = (int)((long long)(w + 1) * NROW / nw);
    if (r0 >= r1) return;
    float4 um[6][4];
#pragma unroll
    for (int m = 0; m < 6; ++m)
#pragma unroll
        for (int i = 0; i < 4; ++i) um[m][i] = *(const float4*)(mu + m * D + (lane + i * 64) * 4);
    float4 gm[4], bb[4]; int scur = -1;
    float4 hp[4], hc[4], hn[4], raw[4];
#define XS_NORM(dst, src, R) do { const int s_ = row_stream(R); \
        if (s_ != scur) { scur = s_; const float* sh_ = modp(p, layer, s_, 0); const float* sc_ = modp(p, layer, s_, 1); \
            _Pragma("unroll") for (int i = 0; i < 4; ++i) { const int d_ = (lane + i * 64) * 4; const float4 gg_ = *(const float4*)(g + d_), a_ = *(const float4*)(sc_ + d_); bb[i] = *(const float4*)(sh_ + d_); \
                gm[i] = make_float4(gg_.x * (1.f + a_.x), gg_.y * (1.f + a_.y), gg_.z * (1.f + a_.z), gg_.w * (1.f + a_.w)); } } \
        float ss_ = 0.f; \
        _Pragma("unroll") for (int i = 0; i < 4; ++i) ss_ += src[i].x * src[i].x + src[i].y * src[i].y + src[i].z * src[i].z + src[i].w * src[i].w; \
        ss_ = wave_sum(ss_); const float rs_ = rsqrtf(ss_ * (1.f / D) + RMS_EPS); \
        _Pragma("unroll") for (int i = 0; i < 4; ++i) dst[i] = make_float4(src[i].x * rs_ * gm[i].x + bb[i].x, src[i].y * rs_ * gm[i].y + bb[i].y, src[i].z * rs_ * gm[i].z + bb[i].z, src[i].w * rs_ * gm[i].w + bb[i].w); } while (0)
#define XS_RAW(R) do { _Pragma("unroll") for (int i = 0; i < 4; ++i) raw[i] = xld(X, (size_t)(R) * D + (lane + i * 64) * 4); } while (0)
    if (r0 > 0) { XS_RAW(r0 - 1); XS_NORM(hp, raw, r0 - 1); }
    else {
#pragma unroll
        for (int i = 0; i < 4; ++i) hp[i] = make_float4(0.f, 0.f, 0.f, 0.f); }
    XS_RAW(r0); XS_NORM(hc, raw, r0);
    if (r0 + 1 < NROW) XS_RAW(r0 + 1);
    for (int row = r0; row < r1; ++row) {
        const bool lat = row < NLAT; const int t = lat ? (row & (TL - 1)) : ((row - NLAT) & (TC - 1)); const int len = lat ? TL : TC;
        const float fp_ = t > 0 ? 0.5f : 0.f, fn_ = t < len - 1 ? 0.5f : 0.f;
        if (row + 1 < NROW) XS_NORM(hn, raw, row + 1);
        else {
#pragma unroll
            for (int i = 0; i < 4; ++i) hn[i] = make_float4(0.f, 0.f, 0.f, 0.f); }
        if (row + 1 < r1 && row + 2 < NROW) XS_RAW(row + 2);
#pragma unroll
        for (int i = 0; i < 4; ++i) {
            const int d = (lane + i * 64) * 4;
            const float4 h = hc[i];
            const float4 xx = make_float4(fp_ * hp[i].x + fn_ * hn[i].x - h.x, fp_ * hp[i].y + fn_ * hn[i].y - h.y, fp_ * hp[i].z + fn_ * hn[i].z - h.z, fp_ * hp[i].w + fn_ * hn[i].w - h.w);
#pragma unroll
            for (int m = 0; m < 6; ++m) { const float4 u = um[m][i];
                uint2 wv_; wv_.x = pk2(h.x + xx.x * u.x, h.y + xx.y * u.y); wv_.y = pk2(h.z + xx.z * u.z, h.w + xx.w * u.w);
                *(uint2*)(XS + ((size_t)m * NROW + row) * D + d) = wv_; }
        }
#pragma unroll
        for (int i = 0; i < 4; ++i) { hp[i] = hc[i]; hc[i] = hn[i]; }
    }
#undef XS_NORM
#undef XS_RAW
}

__device__ __forceinline__ int scan_row(int i, int b, int z) {
    return i < TC ? NLAT + b * TC + (z ? TC - 1 - i : i) : b * TL + (z ? TL - 1 - (i - TC) : i - TC);
}
__device__ __forceinline__ float dpp_sum8(float x) {
    x += __builtin_bit_cast(float, __builtin_amdgcn_update_dpp(0, __builtin_bit_cast(int, x), 0xB1, 0xF, 0xF, true));
    x += __builtin_bit_cast(float, __builtin_amdgcn_update_dpp(0, __builtin_bit_cast(int, x), 0x4E, 0xF, 0xF, true));
    x += __builtin_bit_cast(float, __builtin_amdgcn_update_dpp(0, __builtin_bit_cast(int, x), 0x141, 0xF, 0xF, true));
    return x;
}
__device__ void ph_rw_scan(const Params& p, int j, char* lds) {
    const int tid = tidx(), wid = __builtin_amdgcn_readfirstlane(tid >> 6), lane = tid & 63;
    const size_t PL = (size_t)NROW * D;
    const float* RKV = (const float*)(p.ws + OFF_RKV); float* Y = (float*)(p.ws + OFF_Y);
    constexpr int CH = 32, BUFB = 5 * CH * 256 + CH * 128 + CH * 16, YB = CH * 32 * 4, NCH = (TC + TL) / CH;
    const bool loader = wid >= 4; const int lw = wid - 4;
    for (int it = bidx(); it < 256; it += gdim()) {
        const int vh = it & 1, z = (it >> 1) & 1, h = (it >> 2) & 15, b = it >> 6;
        const char* pl0 = (const char*)((const float*)(p.ws + OFF_W) + z * PL); const char* pl1 = (const char*)(RKV + PL);
        const char* pl2 = (const char*)((const float*)(p.ws + OFF_AV) + z * PL); const char* pl3 = (const char*)RKV;
        const char* vpl = (const char*)(RKV + 2 * PL);
        float* yout = Y + z * PL;
        __builtin_amdgcn_s_barrier();
        if (loader) {
            const int pq = lane & 15;
            const f32x4 kkv = *(const f32x4*)(p.rw_k_k + j * D + h * 64 + pq * 4), kav = *(const f32x4*)(p.rw_k_a + j * D + h * 64 + pq * 4);
            auto issue = [&](int c) {
                char* buf = lds + (c % 3) * BUFB;
#pragma unroll
                for (int q = 0; q < 8; ++q) { const int pi = q >> 1, tg = lw * 2 + (q & 1); const int row = scan_row(c * CH + tg * 4 + (lane >> 4), b, z);
                    const char* base = pi == 0 ? pl0 : pi == 1 ? pl1 : pi == 2 ? pl2 : pl3;
                    __builtin_amdgcn_global_load_lds((const unsigned*)(base + (size_t)row * D * 4 + h * 256 + (lane & 15) * 16), (LAS unsigned*)(buf + pi * (CH * 256) + tg * 1024), 16, 0, 0); }
                { const int row = scan_row(c * CH + lw * 8 + (lane >> 3), b, z);
                  __builtin_amdgcn_global_load_lds((const unsigned*)(vpl + (size_t)row * D * 4 + (h * 64 + vh * 32) * 4 + (lane & 7) * 16), (LAS unsigned*)(buf + 5 * CH * 256 + lw * 1024), 16, 0, 0); }
            };
            auto prep = [&](int c) {
                char* buf = lds + (c % 3) * BUFB;
#pragma unroll
                for (int ps = 0; ps < 2; ++ps) { const int ptok = lw * 8 + ps * 4 + (lane >> 4);
                    f32x4* kp = (f32x4*)(buf + 1 * CH * 256 + ptok * 256 + pq * 16); f32x4* ap = (f32x4*)(buf + 2 * CH * 256 + ptok * 256 + pq * 16); f32x4* dp = (f32x4*)(buf + 4 * CH * 256 + ptok * 256 + pq * 16);
                    f32x4* rp = (f32x4*)(buf + 3 * CH * 256 + ptok * 256 + pq * 16); const f32x4 wv = *(const f32x4*)(buf + ptok * 256 + pq * 16);
                    const f32x4 k = *kp, a = *ap, r = *rp; f32x4 kk = k * kkv;
                    float ss = kk[0] * kk[0] + kk[1] * kk[1] + kk[2] * kk[2] + kk[3] * kk[3]; ss = dpp_sum16(ss);
                    const float inv = 1.f / fmaxf(sqrtf(ss), 1e-12f); kk = kk * inv;
                    const f32x4 kd = k * (1.f + (a - 1.f) * kav), bb = kk * a;
                    const f32x4 t1 = bb * r, t2 = kd * r;
                    const float br = dpp_sum16((t1[0] + t1[1]) + (t1[2] + t1[3])), kr = dpp_sum16((t2[0] + t2[1]) + (t2[2] + t2[3]));
                    *dp = kd; *ap = bb; *kp = kk; *rp = wv * r;
                    if (pq == 0) *(float2*)(buf + 5 * CH * 256 + CH * 128 + ptok * 16) = make_float2(br, kr); }
            };
            issue(0); issue(1);
            asm volatile("s_waitcnt vmcnt(9)" ::: "memory");
            prep(0);
            asm volatile("s_waitcnt lgkmcnt(0)" ::: "memory"); __builtin_amdgcn_s_barrier();
            for (int c = 0; c < NCH; ++c) {
                if (c >= 1) { const float* yb = (const float*)(lds + 3 * BUFB + ((c - 1) & 1) * YB);
                    const int lt = tid - 256, t = lt >> 3, q = lt & 7; const int row = scan_row((c - 1) * CH + t, b, z);
                    *(f32x4*)(yout + (size_t)row * D + h * 64 + vh * 32 + q * 4) = *(const f32x4*)(yb + t * 32 + q * 4); }
                if (c + 2 < NCH) { issue(c + 2); asm volatile("s_waitcnt vmcnt(9)" ::: "memory"); } else asm volatile("s_waitcnt vmcnt(0)" ::: "memory");
                if (c + 1 < NCH) prep(c + 1);
                asm volatile("s_waitcnt lgkmcnt(0)" ::: "memory"); __builtin_amdgcn_s_barrier();
            }
            { const float* yb = (const float*)(lds + 3 * BUFB + ((NCH - 1) & 1) * YB);
              const int lt = tid - 256, t = lt >> 3, q = lt & 7; const int row = scan_row((NCH - 1) * CH + t, b, z);
              *(f32x4*)(yout + (size_t)row * D + h * 64 + vh * 32 + q * 4) = *(const f32x4*)(yb + t * 32 + q * 4); }
        } else {
            const int vr = lane >> 3, ks = lane & 7;
            f32x4 Sa = {0.f, 0.f, 0.f, 0.f}, Sb = {0.f, 0.f, 0.f, 0.f};
            __builtin_amdgcn_s_barrier();
            struct Ops { f32x4 w0, w1, kk0, kk1, bb0, bb1, r0, r1, kd0, kd1; float v; float2 sc; };
#define SC_LOAD(O, t) do { const char* q_ = bq + (t) * 256; O.w0 = *(const f32x4*)(q_); O.w1 = *(const f32x4*)(q_ + 16); O.kk0 = *(const f32x4*)(q_ + CH * 256); O.kk1 = *(const f32x4*)(q_ + CH * 256 + 16); \
                O.bb0 = *(const f32x4*)(q_ + 2 * CH * 256); O.bb1 = *(const f32x4*)(q_ + 2 * CH * 256 + 16); O.r0 = *(const f32x4*)(q_ + 3 * CH * 256); O.r1 = *(const f32x4*)(q_ + 3 * CH * 256 + 16); \
                O.kd0 = *(const f32x4*)(q_ + 4 * CH * 256); O.kd1 = *(const f32x4*)(q_ + 4 * CH * 256 + 16); O.v = *(const float*)(vq + (t) * 128); O.sc = *(const float2*)(buf + 5 * CH * 256 + CH * 128 + (t) * 16); } while (0)
#define SC_STEP(O, t) do { const f32x4 d1 = Sa * O.kk0 + Sb * O.kk1, d2 = Sa * O.r0 + Sb * O.r1; \
                float sa = -((d1[0] + d1[1]) + (d1[2] + d1[3])), yy = (d2[0] + d2[1]) + (d2[2] + d2[3]); \
                sa = dpp_sum8(sa); yy = dpp_sum8(yy); \
                Sa = Sa * O.w0 + (sa * O.bb0 + O.v * O.kd0); Sb = Sb * O.w1 + (sa * O.bb1 + O.v * O.kd1); \
                if (ks == 0) yb[(t) * 32 + wid * 8 + vr] = yy + sa * O.sc.x + O.v * O.sc.y; } while (0)
            for (int c = 0; c < NCH; ++c) {
                const char* buf = lds + (c % 3) * BUFB; float* yb = (float*)(lds + 3 * BUFB + (c & 1) * YB);
                const char* bq = buf + ks * 32; const char* vq = buf + 5 * CH * 256 + (wid * 8 + vr) * 4;
                Ops oA, oB, oC;
                SC_LOAD(oA, 0); SC_LOAD(oB, 1);
#pragma unroll
                for (int t = 0; t < CH; t += 3) {
                    if (t + 2 < CH) SC_LOAD(oC, t + 2);
                    SC_STEP(oA, t);
                    if (t + 3 < CH) SC_LOAD(oA, t + 3);
                    if (t + 1 < CH) SC_STEP(oB, t + 1);
                    if (t + 4 < CH) SC_LOAD(oB, t + 4);
                    if (t + 2 < CH) SC_STEP(oC, t + 2);
                }
                asm volatile("s_waitcnt lgkmcnt(0)" ::: "memory"); __builtin_amdgcn_s_barrier();
            }
#undef SC_LOAD
#undef SC_STEP
        }
    }
}


namespace ck {
constexpr int P = 72, MB = 64 * P * 2;
typedef __attribute__((address_space(3))) char lchar;
__device__ __forceinline__ f32x4 mm_tile(const lchar* Aop, const lchar* Bop, int ti, int tj, int c, int q, f32x4 acc) {
#pragma unroll
    for (int ks = 0; ks < 2; ++ks) {
        const bf16x8 a = *(const LAS bf16x8*)(Aop + ((16 * ti + c) * P + 32 * ks + 8 * q) * 2);
        const bf16x8 b = *(const LAS bf16x8*)(Bop + ((16 * tj + c) * P + 32 * ks + 8 * q) * 2);
        acc = __builtin_amdgcn_mfma_f32_16x16x32_bf16(a, b, acc, 0, 0, 0);
    }
    return acc;
}
__device__ __forceinline__ f32x4 mm_diag(const lchar* Aop, const lchar* Bop, int tt, int c, int q, f32x4 acc) {
    const int ks = tt >> 1;
    bf16x8 a = *(const LAS bf16x8*)(Aop + ((16 * tt + c) * P + 32 * ks + 8 * q) * 2);
    const bf16x8 b = *(const LAS bf16x8*)(Bop + ((16 * tt + c) * P + 32 * ks + 8 * q) * 2);
    if ((q >> 1) != (tt & 1)) a = (bf16x8){0, 0, 0, 0, 0, 0, 0, 0};
    return __builtin_amdgcn_mfma_f32_16x16x32_bf16(a, b, acc, 0, 0, 0);
}
__device__ __forceinline__ void st_tile(lchar* dst, int ti, int tj, int c, int q, f32x4 v) {
    u32x2 w; w.x = pk2(v[0], v[1]); w.y = pk2(v[2], v[3]); *(LAS u32x2*)(dst + ((16 * tj + c) * P + 16 * ti + 4 * q) * 2) = w;
}
__device__ __forceinline__ f32x4 ld_tile(const lchar* src, int ti, int tj, int c, int q) {
    const u32x2 w = *(const LAS u32x2*)(src + ((16 * tj + c) * P + 16 * ti + 4 * q) * 2);
    return (f32x4){__uint_as_float(w.x << 16), __uint_as_float(w.x & 0xffff0000u), __uint_as_float(w.y << 16), __uint_as_float(w.y & 0xffff0000u)};
}
__device__ __forceinline__ void st_glob(bf16_t* dst, int ti, int tj, int c, int q, f32x4 v) {
    uint2 w; w.x = pk2(v[0], v[1]); w.y = pk2(v[2], v[3]); *(uint2*)(dst + (16 * tj + c) * 64 + 16 * ti + 4 * q) = w;
}
typedef float f32x16 __attribute__((ext_vector_type(16)));
__device__ __forceinline__ f32x16 mm32(const lchar* Aop, const lchar* Bop, int ti, int tj, int r32, int hi, f32x16 acc) {
    bf16x8 a[4], b[4];
#pragma unroll
    for (int ks = 0; ks < 4; ++ks) {
        a[ks] = *(const LAS bf16x8*)(Aop + ((32 * ti + r32) * P + 16 * ks + 8 * hi) * 2);
        b[ks] = *(const LAS bf16x8*)(Bop + ((32 * tj + r32) * P + 16 * ks + 8 * hi) * 2); }
    __builtin_amdgcn_sched_barrier(0);
#pragma unroll
    for (int ks = 0; ks < 4; ++ks) acc = __builtin_amdgcn_mfma_f32_32x32x16_bf16(a[ks], b[ks], acc, 0, 0, 0);
    return acc;
}
__device__ __forceinline__ void st32(lchar* dst, int ti, int tj, int r32, int hi, const f32x16& v) {
#pragma unroll
    for (int g = 0; g < 4; ++g) { u32x2 w; w.x = pk2(v[4 * g], v[4 * g + 1]); w.y = pk2(v[4 * g + 2], v[4 * g + 3]); *(LAS u32x2*)(dst + ((32 * tj + r32) * P + 32 * ti + 8 * g + 4 * hi) * 2) = w; }
}
__device__ __forceinline__ f32x16 ld32(const lchar* src, int ti, int tj, int r32, int hi) {
    f32x16 v;
#pragma unroll
    for (int g = 0; g < 4; ++g) { const u32x2 w = *(const LAS u32x2*)(src + ((32 * tj + r32) * P + 32 * ti + 8 * g + 4 * hi) * 2);
        v[4 * g] = __uint_as_float(w.x << 16); v[4 * g + 1] = __uint_as_float(w.x & 0xffff0000u); v[4 * g + 2] = __uint_as_float(w.y << 16); v[4 * g + 3] = __uint_as_float(w.y & 0xffff0000u); }
    return v;
}
__device__ __forceinline__ void stg32(bf16_t* dst, int ti, int tj, int r32, int hi, const f32x16& v) {
#pragma unroll
    for (int g = 0; g < 4; ++g) { uint2 w; w.x = pk2(v[4 * g], v[4 * g + 1]); w.y = pk2(v[4 * g + 2], v[4 * g + 3]); *(uint2*)(dst + (32 * tj + r32) * 64 + 32 * ti + 8 * g + 4 * hi) = w; }
}
}

#define LBAR() do { asm volatile("s_waitcnt lgkmcnt(0)" ::: "memory"); __builtin_amdgcn_s_barrier(); asm volatile("" ::: "memory"); } while (0)
__device__ void ph_rw_sc1(const Params& p, int j, char* lds) {
    using namespace ck;
    const int tid = tidx(), wid = __builtin_amdgcn_readfirstlane(tid >> 6), lane = tid & 63, c = lane & 15, q = lane >> 4;
    const size_t PL = (size_t)NROW * D;
    const bf16_t* RKV = (const bf16_t*)(p.ws + OFF_RKV); const float* LW = (const float*)(p.ws + OFF_W); const bf16_t* AV = (const bf16_t*)(p.ws + OFF_AV);
    bf16_t* CK = (bf16_t*)(p.ws + OFF_CK);
    lchar* B0 = (lchar*)lds;
#define BUF(i) (B0 + (i) * MB)
    LAS float* Lbuf = (LAS float*)BUF(8);
    LAS float* Lseg = (LAS float*)(B0 + 16 * MB);
    LAS float* GC = Lseg + 8 * 64;
    const int pt = tid >> 3, cg = tid & 7;
    f32x4 nlw[2], nkk[2], nka[2]; u32x4 nkx, nax, nrx, nvx;
#define SC1_LOAD(IT) do { const int seq_ = (IT) / NCHK, ch_ = (IT) % NCHK; const int z_ = seq_ & 1, h_ = (seq_ >> 1) & 15, b_ = seq_ >> 5; \
        const size_t go_ = (size_t)scan_row(ch_ * 64 + pt, b_, z_) * D + h_ * 64 + cg * 8; \
        _Pragma("unroll") for (int e = 0; e < 2; ++e) nlw[e] = *(const f32x4*)(LW + z_ * PL + go_ + 4 * e); \
        nkx = *(const u32x4*)(RKV + PL + go_); nax = *(const u32x4*)(AV + z_ * PL + go_); nrx = *(const u32x4*)(RKV + go_); nvx = *(const u32x4*)(RKV + 2 * PL + go_); \
        _Pragma("unroll") for (int e = 0; e < 2; ++e) { nkk[e] = *(const f32x4*)(p.rw_k_k + j * D + h_ * 64 + cg * 8 + 4 * e); nka[e] = *(const f32x4*)(p.rw_k_a + j * D + h_ * 64 + cg * 8 + 4 * e); } } while (0)
    if (bidx() < 128 * NCHK) SC1_LOAD(bidx());
    for (int it = bidx(); it < 128 * NCHK; it += gdim()) {
        const int seq = it / NCHK; const int h = (seq >> 1) & 15;
        f32x4 lw[2], kx[2], ax[2], rx[2], vx[2], kkc[2], kac[2];
#pragma unroll
        for (int e = 0; e < 2; ++e) { lw[e] = nlw[e]; kkc[e] = nkk[e]; kac[e] = nka[e];
            kx[e] = (f32x4){__uint_as_float(nkx[2 * e] << 16), __uint_as_float(nkx[2 * e] & 0xffff0000u), __uint_as_float(nkx[2 * e + 1] << 16), __uint_as_float(nkx[2 * e + 1] & 0xffff0000u)};
            ax[e] = (f32x4){__uint_as_float(nax[2 * e] << 16), __uint_as_float(nax[2 * e] & 0xffff0000u), __uint_as_float(nax[2 * e + 1] << 16), __uint_as_float(nax[2 * e + 1] & 0xffff0000u)};
            rx[e] = (f32x4){__uint_as_float(nrx[2 * e] << 16), __uint_as_float(nrx[2 * e] & 0xffff0000u), __uint_as_float(nrx[2 * e + 1] << 16), __uint_as_float(nrx[2 * e + 1] & 0xffff0000u)};
            vx[e] = (f32x4){__uint_as_float(nvx[2 * e] << 16), __uint_as_float(nvx[2 * e] & 0xffff0000u), __uint_as_float(nvx[2 * e + 1] << 16), __uint_as_float(nvx[2 * e + 1] & 0xffff0000u)}; }
        if (it + gdim() < 128 * NCHK) SC1_LOAD(it + gdim());
        LBAR();
#pragma unroll
        for (int e = 0; e < 2; ++e) *(LAS f32x4*)(Lbuf + pt * 64 + cg * 8 + 4 * e) = lw[e];
        f32x4 kk[2], bq[2], kd[2];
        { float ss = 0.f;
#pragma unroll
          for (int e = 0; e < 2; ++e) { kk[e] = kx[e] * kkc[e]; ss += kk[e][0] * kk[e][0] + kk[e][1] * kk[e][1] + kk[e][2] * kk[e][2] + kk[e][3] * kk[e][3]; }
          ss = dpp_sum8(ss); const float inv = __builtin_amdgcn_rsqf(fmaxf(ss, 1e-24f));
#pragma unroll
          for (int e = 0; e < 2; ++e) { kk[e] = kk[e] * inv; bq[e] = kk[e] * ax[e]; kd[e] = kx[e] * (1.f + (ax[e] - 1.f) * kac[e]); } }
        LBAR();
        { const int k = tid & 63, sg = tid >> 6; float run = 0.f;
#pragma unroll
          for (int u = 0; u < 8; ++u) { run += Lbuf[(sg * 8 + u) * 64 + k]; Lbuf[(sg * 8 + u) * 64 + k] = run; }
          Lseg[sg * 64 + k] = run; }
        LBAR();
        f32x4 Lt[2], Lp[2], Lc[2];
        { const int sg = pt >> 3, sgp = (pt - 1) >> 3;
#pragma unroll
          for (int e = 0; e < 2; ++e) { f32x4 o0 = {0.f, 0.f, 0.f, 0.f}, o1 = o0, oc = o0;
#pragma unroll
              for (int u = 0; u < 8; ++u) { const f32x4 sv = *(const LAS f32x4*)(Lseg + u * 64 + cg * 8 + 4 * e); if (u < sg) o0 = o0 + sv; if (u < sgp) o1 = o1 + sv; if (u < 7) oc = oc + sv; }
              Lt[e] = *(const LAS f32x4*)(Lbuf + pt * 64 + cg * 8 + 4 * e) + o0;
              Lp[e] = pt > 0 ? *(const LAS f32x4*)(Lbuf + (pt - 1) * 64 + cg * 8 + 4 * e) + o1 : (f32x4){0.f, 0.f, 0.f, 0.f};
              Lc[e] = *(const LAS f32x4*)(Lbuf + 63 * 64 + cg * 8 + 4 * e) + oc; } }
        LBAR();
        {
            float at[8], bt[8], kt[8], rt[8], bh[8], kh[8], vv[8];
#pragma unroll
            for (int e = 0; e < 2; ++e)
#pragma unroll
                for (int u = 0; u < 4; ++u) { const int x = 4 * e + u; const float eL = __expf(Lt[e][u]), emL = __expf(-Lt[e][u]), eP = __expf(Lp[e][u]), eC = __expf(Lc[e][u] - Lt[e][u]);
                    at[x] = -kk[e][u] * eP; bt[x] = bq[e][u] * emL; kt[x] = kd[e][u] * emL; rt[x] = rx[e][u] * eL; bh[x] = bq[e][u] * eC; kh[x] = kd[e][u] * eC; vv[x] = vx[e][u];
                    if (pt == 63) GC[cg * 8 + x] = eL; }
#define ST8(bufi, arr) do { u32x4 w_ = {pk2(arr[0], arr[1]), pk2(arr[2], arr[3]), pk2(arr[4], arr[5]), pk2(arr[6], arr[7])}; *(LAS u32x4*)(BUF(bufi) + (pt * P + cg * 8) * 2) = w_; } while (0)
            ST8(0, at); ST8(1, bt); ST8(2, kt); ST8(3, rt); ST8(8, bh); ST8(9, kh); ST8(10, vv);
#undef ST8
        }
        LBAR();
        {
            const int k = tid & 63, tg = tid >> 6;
#define TR8(src, dst) do { unsigned w_[4]; _Pragma("unroll") for (int x = 0; x < 4; ++x) { const unsigned lo = *(const LAS bf16_t*)(BUF(src) + ((tg * 8 + 2 * x) * P + k) * 2), hi2 = *(const LAS bf16_t*)(BUF(src) + ((tg * 8 + 2 * x + 1) * P + k) * 2); w_[x] = lo | (hi2 << 16); } \
                *(LAS u32x4*)(BUF(dst) + (k * P + tg * 8) * 2) = (u32x4){w_[0], w_[1], w_[2], w_[3]}; } while (0)
            TR8(0, 4); TR8(8, 5); TR8(9, 6); TR8(10, 7);
#undef TR8
        }
        LBAR();
        const f32x4 Z4 = {0.f, 0.f, 0.f, 0.f};
        const f32x16 Z16 = {0.f, 0.f, 0.f, 0.f, 0.f, 0.f, 0.f, 0.f, 0.f, 0.f, 0.f, 0.f, 0.f, 0.f, 0.f, 0.f};
        const int r32 = lane & 31, hi = lane >> 5;
#pragma unroll 1
        for (int u = 0; u < 2; ++u) { const int tl = u * 8 + wid;
            if (tl >= 14) {
                if (tl == 14) { st32(BUF(8), 0, 1, r32, hi, Z16); st32(BUF(8), 1, 0, r32, hi, Z16); st32(BUF(14), 0, 1, r32, hi, Z16); st32(BUF(14), 1, 0, r32, hi, Z16); st32(BUF(9), 1, 0, r32, hi, Z16); }
                else { st32(BUF(15), 1, 0, r32, hi, Z16); st32(BUF(13), 1, 0, r32, hi, Z16); st32(BUF(10), 1, 0, r32, hi, Z16); st32(BUF(11), 1, 0, r32, hi, Z16); st32(BUF(12), 1, 0, r32, hi, Z16); }
                break; }
            const int m = (tl + 1) / 3, rr = (tl + 1) % 3, ti = rr == 2, tj = m == 0 ? ti : (rr >= 1); const int jj = 32 * tj + r32;
            if (m == 0) { f32x16 v = mm32(BUF(0), BUF(1), ti, tj, r32, hi, Z16), w;
#pragma unroll
                for (int e = 0; e < 16; ++e) { const int ii = 32 * ti + 8 * (e >> 2) + 4 * hi + (e & 3); const bool dg = (ii >> 4) == (jj >> 4);
                    v[e] = (dg && jj < ii) ? v[e] : 0.f; w[e] = v[e] + ((ii == jj) ? 1.f : 0.f); }
                st32(BUF(8), ti, tj, r32, hi, v); st32(BUF(14), ti, tj, r32, hi, w); }
            else if (m == 1) { const f32x16 v = mm32(BUF(1), BUF(0), ti, tj, r32, hi, Z16); f32x16 vd, vo, w;
#pragma unroll
                for (int e = 0; e < 16; ++e) { const int ii = 32 * ti + 8 * (e >> 2) + 4 * hi + (e & 3); const bool dg = (ii >> 4) == (jj >> 4), up = ii < jj;
                    vd[e] = (dg && up) ? v[e] : 0.f; vo[e] = (!dg && up) ? v[e] : 0.f; w[e] = vd[e] + ((ii == jj) ? 1.f : 0.f); }
                st32(BUF(9), ti, tj, r32, hi, vd); st32(BUF(15), ti, tj, r32, hi, vo); st32(BUF(13), ti, tj, r32, hi, w); }
            else if (m == 2) { f32x16 v = mm32(BUF(2), BUF(0), ti, tj, r32, hi, Z16);
#pragma unroll
                for (int e = 0; e < 16; ++e) { const int ii = 32 * ti + 8 * (e >> 2) + 4 * hi + (e & 3); v[e] = ii < jj ? v[e] : 0.f; }
                st32(BUF(10), ti, tj, r32, hi, v); }
            else { f32x16 v = mm32(m == 3 ? BUF(1) : BUF(2), BUF(3), ti, tj, r32, hi, Z16);
#pragma unroll
                for (int e = 0; e < 16; ++e) { const int ii = 32 * ti + 8 * (e >> 2) + 4 * hi + (e & 3); v[e] = ii <= jj ? v[e] : 0.f; }
                st32(m == 3 ? BUF(11) : BUF(12), ti, tj, r32, hi, v); } }
        LBAR();
#define WSYNC() asm volatile("s_waitcnt lgkmcnt(0)" ::: "memory")
        if (wid < 4) {
            const int tt = wid;
#define SQD(sr, st, dr, dt) do { const f32x4 a_ = mm_diag(BUF(st), BUF(sr), tt, c, q, Z4), b_ = mm_diag(BUF(sr), BUF(st), tt, c, q, Z4); WSYNC(); \
                st_tile(BUF(dr), tt, tt, c, q, a_); st_tile(BUF(dt), tt, tt, c, q, b_); WSYNC(); } while (0)
#define UPD(pr) do { const f32x4 dt_ = mm_diag(BUF(pr), BUF(13), tt, c, q, ld_tile(BUF(13), tt, tt, c, q)); \
                const f32x4 dr_ = mm_diag(BUF(13), BUF(pr), tt, c, q, ld_tile(BUF(14), tt, tt, c, q)); WSYNC(); \
                st_tile(BUF(13), tt, tt, c, q, dt_); st_tile(BUF(14), tt, tt, c, q, dr_); WSYNC(); } while (0)
            SQD(8, 9, 0, 1); UPD(0); SQD(0, 1, 8, 9); UPD(8); SQD(8, 9, 0, 1); UPD(0);
#undef SQD
#undef UPD
        } else {
            const int ti = (wid >> 1) & 1, tj = wid & 1; st32(BUF(2), ti, tj, r32, hi, mm32(BUF(10), BUF(7), ti, tj, r32, hi, Z16));
        }
        LBAR();
        { const int m = wid >> 2, ti = (wid >> 1) & 1, tj = wid & 1;
          if (m == 0) st32(BUF(8), ti, tj, r32, hi, mm32(BUF(15), BUF(14), ti, tj, r32, hi, Z16));
          else        st32(BUF(9), ti, tj, r32, hi, mm32(BUF(14), BUF(15), ti, tj, r32, hi, Z16)); }
        LBAR();
        if (wid < 4) { const int ti = (wid >> 1) & 1, tj = wid & 1; st32(BUF(0), ti, tj, r32, hi, mm32(BUF(9), BUF(8), ti, tj, r32, hi, Z16)); }
        LBAR();
        if (wid < 4) { const int ti = (wid >> 1) & 1, tj = wid & 1; st32(BUF(1), ti, tj, r32, hi, mm32(BUF(0), BUF(13), ti, tj, r32, hi, ld32(BUF(13), ti, tj, r32, hi))); }
        LBAR();
        if (wid < 4) { const int ti = (wid >> 1) & 1, tj = wid & 1; st32(BUF(14), ti, tj, r32, hi, mm32(BUF(8), BUF(1), ti, tj, r32, hi, ld32(BUF(1), ti, tj, r32, hi))); }
        LBAR();
        { const int m = wid >> 2, ti = (wid >> 1) & 1, tj = wid & 1;
          if (m == 0) st32(BUF(8), ti, tj, r32, hi, mm32(BUF(14), BUF(4), ti, tj, r32, hi, Z16));
          else        st32(BUF(0), ti, tj, r32, hi, mm32(BUF(14), BUF(2), ti, tj, r32, hi, Z16)); }
        LBAR();
        bf16_t* ckp = CK + (size_t)it * 4 * 4096;
#pragma unroll 1
        for (int u = 0; u < 2; ++u) { const int tl = u * 8 + wid, m = tl >> 2, ti = (tl >> 1) & 1, tj = tl & 1;
            if (m == 0) { f32x16 v = mm32(BUF(8), BUF(5), ti, tj, r32, hi, Z16); const int jj = 32 * tj + r32; const float gc = GC[jj];
#pragma unroll
                for (int e = 0; e < 16; ++e) { const int ii = 32 * ti + 8 * (e >> 2) + 4 * hi + (e & 3); v[e] += (ii == jj) ? gc : 0.f; }
                st32(BUF(1), ti, tj, r32, hi, v); }
            else if (m == 1) st32(BUF(4), ti, tj, r32, hi, mm32(BUF(8), BUF(11), ti, tj, r32, hi, ld32(BUF(3), ti, tj, r32, hi)));
            else if (m == 2) st32(BUF(2), ti, tj, r32, hi, mm32(BUF(6), BUF(7), ti, tj, r32, hi, mm32(BUF(5), BUF(0), ti, tj, r32, hi, Z16)));
            else             st32(BUF(9), ti, tj, r32, hi, mm32(BUF(7), BUF(12), ti, tj, r32, hi, mm32(BUF(0), BUF(11), ti, tj, r32, hi, Z16))); }
        LBAR();
        { const int orow = tid >> 3, oc = (tid & 7) * 8;
          *(u32x4*)(ckp + orow * 64 + oc) = *(const LAS u32x4*)(BUF(1) + (orow * P + oc) * 2);
          *(u32x4*)(ckp + 4096 + orow * 64 + oc) = *(const LAS u32x4*)(BUF(2) + (orow * P + oc) * 2);
          *(u32x4*)(ckp + 2 * 4096 + orow * 64 + oc) = *(const LAS u32x4*)(BUF(4) + (orow * P + oc) * 2);
          *(u32x4*)(ckp + 3 * 4096 + orow * 64 + oc) = *(const LAS u32x4*)(BUF(9) + (orow * P + oc) * 2); }
    }
#undef BUF
#undef SC1_LOAD
}

__device__ void ph_rw_sc2(const Params& p, char* lds) {
    using namespace ck;
    const int tid = tidx(), wid = __builtin_amdgcn_readfirstlane(tid >> 6), lane = tid & 63, c = lane & 15, q = lane >> 4;
    const size_t PL = (size_t)NROW * D;
    const bf16_t* CK = (const bf16_t*)(p.ws + OFF_CK); bf16_t* Y = (bf16_t*)(p.ws + OFF_Y);
    lchar* GB = (lchar*)lds;
    lchar* RB = GB + 2 * MB;
    lchar* SB = GB + 4 * MB;
    constexpr int SBB = 32 * P * 2;
    for (int it = bidx(); it < 256; it += gdim()) {
        const int vh = it & 1, seq = it >> 1, z = seq & 1, h = (seq >> 1) & 15, b = seq >> 5;
        const bf16_t* ck0 = CK + (size_t)seq * NCHK * 4 * 4096;
        const int s_ti = wid & 3, s_tj = wid >> 2;
        const int y_ti = wid & 1, y_tj = wid >> 1;
        const int hoff = 4096 + (vh * 32 + 16 * s_tj + c) * 64 + 16 * s_ti + 4 * q, yoff = 3 * 4096 + (16 * y_tj + c) * 64 + vh * 32 + 16 * y_ti + 4 * q;
        struct PF { u32x4 g, r; uint2 h, y; };
#define PF_LOAD(X, k) do { const bf16_t* cc_ = ck0 + (size_t)(k) * 4 * 4096; X.h = *(const uint2*)(cc_ + hoff); X.y = *(const uint2*)(cc_ + yoff); X.g = *(const u32x4*)(cc_ + tid * 8); X.r = *(const u32x4*)(cc_ + 2 * 4096 + tid * 8); } while (0)
#define PF_STAGE(X, bufi) do { *(LAS u32x4*)(GB + (bufi) * MB + ((tid >> 3) * P + (tid & 7) * 8) * 2) = X.g; *(LAS u32x4*)(RB + (bufi) * MB + ((tid >> 3) * P + (tid & 7) * 8) * 2) = X.r; } while (0)
#define SC2_STEP(k, CUR, NXT) do { const uint2 hi_ = CUR.h, yi_ = CUR.y; const int cur = (k) & 1; \
            if ((k) + 4 < NCHK) PF_LOAD(CUR, (k) + 4); \
            const f32x4 hinit = {__uint_as_float(hi_.x << 16), __uint_as_float(hi_.x & 0xffff0000u), __uint_as_float(hi_.y << 16), __uint_as_float(hi_.y & 0xffff0000u)}; \
            const f32x4 yinit = {__uint_as_float(yi_.x << 16), __uint_as_float(yi_.x & 0xffff0000u), __uint_as_float(yi_.y << 16), __uint_as_float(yi_.y & 0xffff0000u)}; \
            const lchar* Sold = SB + cur * SBB; lchar* Snew = SB + (cur ^ 1) * SBB; \
            const f32x4 sn = mm_tile(GB + cur * MB, Sold, s_ti, s_tj, c, q, hinit);        \
            const f32x4 yv = mm_tile(Sold, RB + cur * MB, y_ti, y_tj, c, q, yinit);        \
            st_tile(Snew, s_ti, s_tj, c, q, sn); \
            { const int row = scan_row((k) * 64 + 16 * y_tj + c, b, z); stbf4(Y + z * PL + (size_t)row * D + h * 64 + vh * 32 + 16 * y_ti + 4 * q, yv); } \
            if ((k) + 1 < NCHK) PF_STAGE(NXT, cur ^ 1); \
            LBAR(); } while (0)
        PF s0, s1, s2, s3;
        PF_LOAD(s0, 0); PF_LOAD(s1, 1); PF_LOAD(s2, 2); PF_LOAD(s3, 3);
        LBAR();
        for (int i = tid; i < SBB / 4; i += NTHR) ((LAS unsigned*)SB)[i] = 0u;
        PF_STAGE(s0, 0);
        LBAR();
        for (int ch = 0; ch < NCHK; ch += 4) {
            SC2_STEP(ch, s0, s1); SC2_STEP(ch + 1, s1, s2); SC2_STEP(ch + 2, s2, s3); SC2_STEP(ch + 3, s3, s0);
        }
#undef PF_LOAD
#undef PF_STAGE
#undef SC2_STEP
    }
}
#undef LBAR

__device__ void ph_rw_out(const Params& p, int j, int nrows) {
    const int wid = tidx() >> 6, lane = tidx() & 63;
    const bf16_t* RKV = (const bf16_t*)(p.ws + OFF_RKV); const bf16_t* AV = (const bf16_t*)(p.ws + OFF_AV); const bf16_t* G = (const bf16_t*)(p.ws + OFF_G); const bf16_t* Y = (const bf16_t*)(p.ws + OFF_Y);
    bf16_t* OUT = (bf16_t*)(p.ws + OFF_H);
    const size_t PL = (size_t)NROW * D;
    const float* r_k = p.rw_r_k + j * D; const float* lg = p.rw_lnx_g + j * D; const float* lb = p.rw_lnx_b + j * D; const float* k_a = p.rw_k_a + j * D;
    uint2 nb[8][4];
#define OUT_LOAD(R) do { _Pragma("unroll") for (int i = 0; i < 4; ++i) { const size_t o_ = (size_t)(R) * D + lane * 4 + i * 256; \
        nb[0][i] = *(const uint2*)(Y + o_); nb[1][i] = *(const uint2*)(Y + PL + o_); nb[2][i] = *(const uint2*)(RKV + o_); nb[3][i] = *(const uint2*)(RKV + PL + o_); \
        nb[4][i] = *(const uint2*)(RKV + 2 * PL + o_); nb[5][i] = *(const uint2*)(AV + o_); nb[6][i] = *(const uint2*)(AV + PL + o_); nb[7][i] = *(const uint2*)(G + o_); } } while (0)
#define UNPK(w) ((f32x4){__uint_as_float((w).x << 16), __uint_as_float((w).x & 0xffff0000u), __uint_as_float((w).y << 16), __uint_as_float((w).y & 0xffff0000u)})
    int row = bidx() * 8 + wid;
    if (row < nrows) OUT_LOAD(row);
    for (; row < nrows; row += gdim() * 8) {
        uint2 cb[8][4];
#pragma unroll
        for (int q_ = 0; q_ < 8; ++q_)
#pragma unroll
            for (int i = 0; i < 4; ++i) cb[q_][i] = nb[q_][i];
        { const int nrow = row + gdim() * 8; if (nrow < nrows) OUT_LOAD(nrow); }
#pragma unroll
        for (int i = 0; i < 4; ++i) {
            const size_t o = (size_t)row * D + lane * 4 + i * 256; const int c = lane * 4 + i * 256;
            const f32x4 y = UNPK(cb[0][i]) + UNPK(cb[1][i]);
            const float mean = dpp_sum16(y[0] + y[1] + y[2] + y[3]) * (1.f / 64.f);
            const f32x4 dd = y - mean;
            const float rstd = rsqrtf(dpp_sum16(dd[0] * dd[0] + dd[1] * dd[1] + dd[2] * dd[2] + dd[3] * dd[3]) * (1.f / 64.f) + LNX_EPS);
            const f32x4 r = UNPK(cb[2][i]), k = UNPK(cb[3][i]), v = UNPK(cb[4][i]);
            const f32x4 a0 = UNPK(cb[5][i]), a1 = UNPK(cb[6][i]);
            const f32x4 kds = k * (2.f + (a0 + a1 - 2.f) * *(const f32x4*)(k_a + c));
            const f32x4 t4 = r * kds * *(const f32x4*)(r_k + c);
            const float bs = dpp_sum16(t4[0] + t4[1] + t4[2] + t4[3]);
            const f32x4 res = (dd * rstd * *(const f32x4*)(lg + c) + *(const f32x4*)(lb + c) + bs * v) * UNPK(cb[7][i]);
            uint2 w; w.x = pk2(res[0], res[1]); w.y = pk2(res[2], res[3]); *(uint2*)(OUT + o) = w;
        }
    }
#undef OUT_LOAD
#undef UNPK
}

__device__ void ph_final(const Params& p) {
    const int wid = tidx() >> 6, lane = tidx() & 63;
    const float* X = (const float*)(p.ws + OFF_X);
    for (int row = bidx() * 8 + wid; row < NLAT; row += gdim() * 8) {
        const float4* xr = (const float4*)(X + (size_t)row * D);
        float4 v[4]; float ss = 0;
#pragma unroll
        for (int i = 0; i < 4; ++i) { v[i] = xr[lane + i * 64]; ss += v[i].x * v[i].x + v[i].y * v[i].y + v[i].z * v[i].z + v[i].w * v[i].w; }
        ss = wave_sum(ss); const float rs = rsqrtf(ss * (1.f / D) + RMS_EPS);
#pragma unroll
        for (int i = 0; i < 4; ++i) { const int d = (lane + i * 64) * 4; const float4 gg = *(const float4*)(p.final_g + d);
            float4 o; o.x = v[i].x * rs * gg.x; o.y = v[i].y * rs * gg.y; o.z = v[i].z * rs * gg.z; o.w = v[i].w * rs * gg.w;
            *(float4*)(p.out + (size_t)row * D + d) = o; }
    }
}

enum { PH_INIT = 0, PH_A_NORM, PH_A_Z, PH_A_MID, PH_A_QKV, PH_A_POST, PH_A_ATTN, PH_A_WO,
       PH_R_NORM, PH_R_XS, PH_R_G1, PH_R_G2, PH_R_PREP, PH_R_SCAN, PH_R_OUT, PH_R_WO,
       PH_M_NORM, PH_M_SEL, PH_M_GATHER, PH_M_G1, PH_M_G2, PH_M_COMB, PH_FINAL, PH_M_CVT, PH_R_SC1, PH_R_SC2 };

#ifndef BG_Z
#define BG_Z 4
#define BG_ATTN 2
#define BG_WO 3
#define BG_RG1 6
#define BG_MG1 4
#define BG_MG2 6
#endif
template <int PH>
__device__ __forceinline__ void run_phase(const Params& p, int layer, char* lds) {
    const int j = layer >> 1;
    char* ws = p.ws;
    if constexpr (PH == PH_INIT) { ph_init(p, lds); __syncthreads(); ph_small_cvt(p, lds); }
    else if constexpr (PH == PH_A_NORM) { if (layer == 0) ph_norm_mod<false>(p, layer, p.norm1_g + layer * D, 0, 1, ws + OFF_H); else ph_comb_norm<false>(p, layer - 1, layer, NROW); }
    else if constexpr (PH == PH_A_Z) {
        float* Z = (float*)(ws + OFF_Z);
        g8::BatchSched S{ws + OFF_H, ws + OFF_WMLA + j * SZ_WMLA + WM_IN, 0, 0, NROW / 256, 2, 1, D};
        g8::gemm_phase(p.wv, (PG8_LAS unsigned char*)lds, D, S, g8::epi_rc([=](const g8::Unit&, int row, int col, f32x4 v) { *(f32x4*)(Z + (size_t)row * 512 + col) = v; }));
        if (idle_tail(NROW / 256 * 2)) bg_cvt(p, layer, lds, BG_Z);
    }
    else if constexpr (PH == PH_A_MID) ph_mla_mid(p, j);
    else if constexpr (PH == PH_A_QKV) {
        bf16_t* Q = (bf16_t*)(ws + OFF_Q); bf16_t* K = (bf16_t*)(ws + OFF_K); bf16_t* V = (bf16_t*)(ws + OFF_V);
        g8::BatchSched S1{ws + OFF_CQN, ws + OFF_WMLA + j * SZ_WMLA + WM_UQ, 0, 0, NROW / 256, 6, 1, 256, 1};
        g8::gemm_phase(p.wv, (PG8_LAS unsigned char*)lds, 256, S1, g8::epi_rc([=](const g8::Unit&, int row, int col, f32x4 v) {
            const bool lat = row < NLAT; const int b = lat ? (row >> 12) : ((row - NLAT) >> 8); const int tk = lat ? 256 + (row & (TL - 1)) : ((row - NLAT) & 255);
            const int h = col / 192, d = col - h * 192;
            uint2 w; w.x = pk2(v[0], v[1]); w.y = pk2(v[2], v[3]);
            *(uint2*)(Q + ((size_t)(b * 8 + h) * TK + tk) * 192 + d) = w; }));
        g8::BatchSched S2{ws + OFF_CKVN, ws + OFF_WMLA + j * SZ_WMLA + WM_UKV, 0, 0, NROW / 256, 8, 1, 128};
        g8::gemm_phase(p.wv, (PG8_LAS unsigned char*)lds, 128, S2, g8::epi_rc([=](const g8::Unit&, int row, int col, f32x4 v) {
            const bool lat = row < NLAT; const int b = lat ? (row >> 12) : ((row - NLAT) >> 8); const int tk = lat ? 256 + (row & (TL - 1)) : ((row - NLAT) & 255);
            const int h = col >> 8, d = col & 255; const size_t orow = (size_t)(b * 8 + h) * TK + tk;
            uint2 w; w.x = pk2(v[0], v[1]); w.y = pk2(v[2], v[3]);
            if (d < 128) *(uint2*)(K + orow * 192 + d) = w; else *(uint2*)(V + orow * 128 + (d - 128)) = w; }));
    }
    else if constexpr (PH == PH_A_ATTN) { ph_attn(p, lds); if (idle_tail(544)) bg_cvt(p, layer, lds, BG_ATTN); }
    else if constexpr (PH == PH_A_WO || PH == PH_R_WO) {
        xt_t* X = (xt_t*)(ws + OFF_X); const float* MOD = (const float*)(ws + OFF_MOD);
        g8::BatchSched S{ws + (PH == PH_A_WO ? OFF_O : OFF_H), PH == PH_A_WO ? ws + OFF_WMLA + j * SZ_WMLA + WM_O : ws + OFF_WRW + j * SZ_WRW + WR_O, 0, 0, (layer < 3 ? NROW : NLAT) / 256, 4, 1, D};
        g8::gemm_phase(p.wv, (PG8_LAS unsigned char*)lds, D, S, g8::EpiResid{X, MOD, layer});
        if (idle_tail((layer < 3 ? NROW : NLAT) / 256 * 4)) bg_cvt(p, layer, lds, BG_WO);
    }
    else if constexpr (PH == PH_R_XS) ph_rw_normxs(p, layer, j);
    else if constexpr (PH == PH_R_G1) {
        bf16_t* RKV = (bf16_t*)(ws + OFF_RKV); bf16_t* VF = (bf16_t*)(ws + OFF_VFIRST);
        bf16_t* A2 = (bf16_t*)(ws + OFF_A2); bf16_t* A3 = (bf16_t*)(ws + OFF_A3);
        const bool first = (j == 0);
        struct RSched { const char* XS; const char* WB; int nwg;
            __device__ __forceinline__ bool next(int i, g8::Unit& u) const {
                const int L = i * gdim() + bidx(); if (L >= nwg) return false;
                const int w = g8::xcd_remap(L, nwg);
                if (w < 816) { u.g = w / 272; const int r = w % 272; u.pm = r >> 2; u.pn = r & 3; u.B = WB + WR_RKV + (size_t)u.g * D * D * 2 + (size_t)u.pn * 256 * D * 2; }
                else { u.g = 3 + (w - 816) / 68; u.pm = (w - 816) % 68; u.pn = 0; u.B = WB + WR_L + (size_t)(u.g - 3) * 256 * D * 2; }
                u.A = XS + (size_t)(u.g == 6 ? 2 : u.g) * NROW * D * 2 + (size_t)u.pm * 256 * D * 2; return true; } };
        RSched S{ws + OFF_XS, ws + OFF_WRW + j * SZ_WRW, first ? 816 + 204 : 816 + 272};
        g8::gemm_phase(p.wv, (PG8_LAS unsigned char*)lds, D, S, g8::epi_rc([=](const g8::Unit& u, int row, int col, f32x4 v) {
            if (u.g < 3) { stbf4(RKV + ((size_t)u.g * NROW + row) * D + col, v); if (first && u.g == 2) stbf4(VF + (size_t)row * D + col, v); }
            else if (col < 128) {
                f32x4 t = v;
                if (u.g == 3) { for (int e = 0; e < 4; ++e) t[e] = 1.f - 2.f * __builtin_amdgcn_rcpf(1.f + __expf(2.f * v[e])); }
                else if (u.g == 5) { for (int e = 0; e < 4; ++e) t[e] = sigmoidf_(v[e]); }
                bf16_t* dst = (u.g == 3 ? A2 : u.g == 4 ? A2 + (size_t)NROW * 128 : u.g == 5 ? A3 : A3 + (size_t)NROW * 128);
                stbf4(dst + (size_t)row * 128 + col, t); } }));
        if (idle_tail(S.nwg)) bg_cvt(p, layer, lds, BG_RG1);
    }
    else if constexpr (PH == PH_R_G2) {
        const bool first = (j == 0);
        float* W = (float*)(ws + OFF_W); bf16_t* AV = (bf16_t*)(ws + OFF_AV); bf16_t* G = (bf16_t*)(ws + OFF_G); bf16_t* RKV = (bf16_t*)(ws + OFF_RKV); const bf16_t* VF = (const bf16_t*)(ws + OFF_VFIRST);
        const float* w0 = p.rw_w0 + (size_t)j * 2 * D; const float* a0 = p.rw_a0 + (size_t)j * 2 * D; const float* v0 = p.rw_v0;
        g8::BatchSched S1{ws + OFF_A2, ws + OFF_WRW + j * SZ_WRW + WR_B2, (size_t)NROW * 128 * 2, (size_t)2048 * 128 * 2, NROW / 256, 8, 2, 128};
        g8::gemm_phase(p.wv, (PG8_LAS unsigned char*)lds, 128, S1, g8::epi_colfirst([=](const g8::Unit& u, int row, int col, f32x4 v, f32x4 bias) {
            const int zz = u.pn >> 2, c = col & 1023; const bool dec = u.g == 0;
            const size_t doff = (size_t)zz * NROW * D + (size_t)row * D + c;
            const f32x4 x = v + bias; f32x4 o;
#pragma unroll
            for (int e = 0; e < 4; ++e) { const float sg = __builtin_amdgcn_rcpf(1.f + __expf(-x[e])); o[e] = dec ? (-0.6065306597126334f * sg) : sg; }
            if (dec) *(f32x4*)(W + doff) = o; else stbf4(AV + doff, o); },
            [=](const g8::Unit& u, int col) { const int zz = u.pn >> 2, c = col & 1023; return *(const f32x4*)((u.g == 0 ? w0 : a0) + zz * D + c); }));
        g8::BatchSched S2{ws + OFF_A3, ws + OFF_WRW + j * SZ_WRW + WR_B3, (size_t)NROW * 128 * 2, (size_t)1024 * 128 * 2, NROW / 256, 4, first ? 1 : 2, 128, 1};
        g8::gemm_phase(p.wv, (PG8_LAS unsigned char*)lds, 128, S2, g8::epi_rc([=](const g8::Unit& u, int row, int col, f32x4 v) {
            if (u.g == 0) stbf4(G + (size_t)row * D + col, v);
            else { const size_t o = (size_t)row * D + col; const f32x4 vv = ldbf4(RKV + (size_t)2 * NROW * D + o), vf = ldbf4(VF + o), gz = v + *(const f32x4*)(v0 + col); f32x4 r;
#pragma unroll
                for (int e = 0; e < 4; ++e) r[e] = vv[e] + (vf[e] - vv[e]) * __builtin_amdgcn_rcpf(1.f + __expf(-gz[e]));
                stbf4(RKV + (size_t)2 * NROW * D + o, r); } }));
    }
    else if constexpr (PH == PH_R_SCAN) ph_rw_scan(p, j, lds);
    else if constexpr (PH == PH_R_SC1) ph_rw_sc1(p, j, lds);
    else if constexpr (PH == PH_R_SC2) ph_rw_sc2(p, lds);
    else if constexpr (PH == PH_R_OUT) ph_rw_out(p, j, layer < 3 ? NROW : NLAT);
    else if constexpr (PH == PH_M_NORM) ph_norm2_router_mm(p, layer, lds, layer < 3 ? NROW : NLAT);
    else if constexpr (PH == PH_M_SEL) { ph_select(p, lds, layer < 3 ? 128 : 64); __syncthreads(); moe_cvt(p, layer, lds, -1); }
    else if constexpr (PH == PH_M_GATHER) ph_gather(p, layer < 3 ? ESLOTS : NB * CAPL);
    else if constexpr (PH == PH_M_G1) {
        bf16_t* HID = (bf16_t*)(ws + OFF_HID);
        g8::BatchSched S{ws + OFF_XE, ws + OFF_W13T + (size_t)(layer & 1) * SZ_WMOE, (size_t)EPAD * D * 2, (size_t)2816 * D * 2, layer < 3 ? 9 : 8, 11, NE, D};
        g8::gemm_phase(p.wv, (PG8_LAS unsigned char*)lds, D, S, g8::epi_pair([=](const g8::Unit& u, int row, int col, f32x4 a, f32x4 b) {
            uint2 w; w.x = pk2(a[0] * __builtin_amdgcn_rcpf(1.f + __expf(-a[0])) * b[0], a[1] * __builtin_amdgcn_rcpf(1.f + __expf(-a[1])) * b[1]); w.y = pk2(a[2] * __builtin_amdgcn_rcpf(1.f + __expf(-a[2])) * b[2], a[3] * __builtin_amdgcn_rcpf(1.f + __expf(-a[3])) * b[3]);
            *(uint2*)(HID + ((size_t)u.g * EPAD + row) * FF + col) = w; }));
        if (layer < 3 && idle_tail(9 * 11 * NE)) moe_cvt(p, layer + 1, lds, BG_MG1);
    }
    else if constexpr (PH == PH_M_G2) {
        bf16_t* YE = (bf16_t*)(ws + OFF_YE); const float* GATE = (const float*)(ws + OFF_GATE);
        g8::BatchSched S{ws + OFF_HID, ws + OFF_W2T + (size_t)(layer & 1) * SZ_WMOE, (size_t)EPAD * FF * 2, (size_t)D * FF * 2, layer < 3 ? 9 : 8, 4, NE, FF};
        g8::gemm_phase(p.wv, (PG8_LAS unsigned char*)lds, FF, S, g8::epi_pre([=](const g8::Unit& u, int row, int col, f32x4 v, f32x4, float gt) {
            uint2 w; w.x = pk2(v[0] * gt, v[1] * gt); w.y = pk2(v[2] * gt, v[3] * gt);
            *(uint2*)(YE + ((size_t)u.g * EPAD + row) * D + col) = w; },
            [=](const g8::Unit&, int) { return (f32x4){0.f, 0.f, 0.f, 0.f}; }, [=](const g8::Unit& u, int row) { return GATE[u.g * EPAD + row]; }));
        if (layer < 3 && idle_tail(9 * 4 * NE)) moe_cvt(p, layer + 1, lds, BG_MG2);
    }
    else if constexpr (PH == PH_M_COMB) ph_combine(p, layer, layer < 3 ? NROW : NLAT);
    else if constexpr (PH == PH_M_CVT) moe_cvt(p, layer, lds, -1);
    else if constexpr (PH == PH_FINAL) ph_comb_norm<true>(p, 3, 0, NLAT);
}

#if ONE_LAUNCH
#define SYNC() xcd_barrier(bar)
#ifndef PROBE_PH
#define PROBE_PH -1
#endif
#ifndef PROBE_REP
#define PROBE_REP 1
#endif
__device__ __forceinline__ Params load_params() {
    Params q{};
#if defined(__HIP_DEVICE_COMPILE__)
    typedef const __attribute__((address_space(4))) unsigned long long* KargP;
    KargP kp_ = (KargP)__builtin_amdgcn_kernarg_segment_ptr(); asm volatile("" : "+s"(kp_));
#pragma unroll
    for (int i = 0; i < 40; ++i) ((const float**)&q)[i] = (const float*)(const __attribute__((address_space(1))) float*)kp_[i];
#endif
    return q;
}
#define RUN(PH) do { for (int rep_ = 0; rep_ < ((PH) == PROBE_PH ? PROBE_REP : 1); ++rep_) { Params q = load_params(); q.wv = wv0_; run_phase<PH>(q, layer, smem); SYNC(); } } while (0)
__global__ void __launch_bounds__(NTHR, 2) mega(Params p) {
    extern __shared__ __attribute__((aligned(16))) char smem[];
    const int wv0_ = __builtin_amdgcn_readfirstlane((int)threadIdx.x >> 6);
    if (threadIdx.x == 0) *(uint4*)(smem + LDS_BYTES) = make_uint4(0u, 0u, 0u, 0u);
    __syncthreads();
    XcdBarrier bar = xcd_barrier_post((unsigned*)(p.ws + OFF_BAR), (volatile LAS unsigned*)(smem + LDS_BYTES));
    { const int layer = 0; RUN(PH_INIT); }
    for (int layer = 0; layer < 4; ++layer) {
        if ((layer & 1) == 0) {
            RUN(PH_A_NORM);
            RUN(PH_A_Z);
            RUN(PH_A_MID);
            RUN(PH_A_QKV);
            RUN(PH_A_ATTN);
            RUN(PH_A_WO);
        } else {
            RUN(PH_R_XS);
            RUN(PH_R_G1);
            RUN(PH_R_G2);
            RUN(PH_R_SC1);
            RUN(PH_R_SC2);
            RUN(PH_R_OUT);
            RUN(PH_R_WO);
        }
        RUN(PH_M_NORM);
        RUN(PH_M_SEL);
        RUN(PH_M_G1);
        RUN(PH_M_G2);
        if ((layer & 1) == 0) RUN(PH_M_COMB);
    }
    { Params q = load_params(); q.wv = wv0_; run_phase<PH_FINAL>(q, 0, smem); }
}
#else
template <int PH> __global__ void __launch_bounds__(NTHR, 2) kph(Params p, int layer) {
    extern __shared__ __attribute__((aligned(16))) char smem[];
    Params q = p; q.wv = __builtin_amdgcn_readfirstlane((int)threadIdx.x >> 6);
    run_phase<PH>(q, layer, smem);
}
#endif

extern "C" void kernel_launch(void* const* d_in, const int* in_sizes, int n_in, void* d_out, int out_size, void* d_ws, size_t ws_size, hipStream_t stream) {
    if (n_in != 38 || ws_size < WS_NEED) { fprintf(stderr, "kernel_launch: bad args n_in %d ws %zu need %zu\n", n_in, ws_size, (size_t)WS_NEED); return; }
    Params p{};
    const float** pp = (const float**)&p;
    for (int i = 0; i < 38; ++i) pp[i] = (const float*)d_in[i];
    p.out = (float*)d_out; p.ws = (char*)d_ws;
    static int cus = 0;
    if (!cus) { int dev = 0; hipGetDevice(&dev); hipDeviceGetAttribute(&cus, hipDeviceAttributeMultiprocessorCount, dev); if (cus <= 0) cus = 256; }
    const int grid = cus;
#if ONE_LAUNCH
    hipFuncSetAttribute((const void*)mega, hipFuncAttributeMaxDynamicSharedMemorySize, LDS_BYTES + 16);
    hipMemsetAsync(d_ws, 0, 16384, stream);
    hipLaunchKernelGGL(mega, dim3(grid), dim3(NTHR), LDS_BYTES + 16, stream, p);
#else
    hipMemsetAsync(d_ws, 0, 16384, stream);
#define LAUNCH(PH, L) do { hipFuncSetAttribute((const void*)kph<PH>, hipFuncAttributeMaxDynamicSharedMemorySize, LDS_BYTES + 16); hipLaunchKernelGGL(kph<PH>, dim3(grid), dim3(NTHR), LDS_BYTES + 16, stream, p, L); } while (0)
    LAUNCH(PH_INIT, 0);
    for (int layer = 0; layer < 4; ++layer) {
        if ((layer & 1) == 0) { LAUNCH(PH_A_NORM, layer); LAUNCH(PH_A_Z, layer); LAUNCH(PH_A_MID, layer); LAUNCH(PH_A_QKV, layer); LAUNCH(PH_A_ATTN, layer); LAUNCH(PH_A_WO, layer); }
        else { LAUNCH(PH_R_XS, layer); LAUNCH(PH_R_G1, layer); LAUNCH(PH_R_G2, layer); LAUNCH(PH_R_SC1, layer); LAUNCH(PH_R_SC2, layer); LAUNCH(PH_R_OUT, layer); LAUNCH(PH_R_WO, layer); }
        LAUNCH(PH_M_NORM, layer); LAUNCH(PH_M_SEL, layer); LAUNCH(PH_M_G1, layer); LAUNCH(PH_M_G2, layer); if ((layer & 1) == 0) LAUNCH(PH_M_COMB, layer);
    }
    LAUNCH(PH_FINAL, 0);
#endif
}
```

```cpp
#include <hip/hip_runtime.h>
#include <stdint.h>
#include <stdio.h>

#ifndef ONE_LAUNCH
#define ONE_LAUNCH 1
#endif

#define NTHR 512
typedef unsigned short bf16_t;
typedef short bf16x8 __attribute__((ext_vector_type(8)));
typedef float f32x4 __attribute__((ext_vector_type(4)));
typedef unsigned u32x4 __attribute__((ext_vector_type(4)));
typedef unsigned u32x2 __attribute__((ext_vector_type(2)));

constexpr int D = 1024, NB = 4, TL = 4096, TC = 256, NLAT = NB * TL, NCTX = NB * TC, NROW = NLAT + NCTX;
constexpr int TK = TL + TC;
constexpr int NE = 16, FF = 1408, CAPL = 512, CAPC = 32, ESLOTS = NB * CAPL + NB * CAPC;
constexpr int EPAD = 2304;
constexpr float RMS_EPS = 1e-6f, LNX_EPS = 64e-5f;
constexpr float ATT_SCALE = 0.07216878364870322f;

constexpr size_t al256(size_t x) { return (x + 255) / 256 * 256; }
constexpr size_t OFF_BAR = 0;
constexpr size_t OFF_QUEUE = 14336;
constexpr size_t OFF_MOD = 16384;
constexpr size_t OFF_ROPE_C = OFF_MOD + al256(4 * 5 * 6144 * 4);
constexpr size_t OFF_ROPE_S = OFF_ROPE_C + al256(TL * 32 * 4);
constexpr size_t OFF_X = OFF_ROPE_S + al256(TL * 32 * 4);
constexpr size_t SZ_F32 = (size_t)NROW * D * 4, SZ_BF = (size_t)NROW * D * 2;
constexpr size_t OFF_VFIRST = OFF_X + SZ_BF;
constexpr size_t OFF_H = OFF_VFIRST + SZ_BF;
constexpr size_t SZ_WMLA = (size_t)(512 * 1024 + 1536 * 256 + 2048 * 256 + 1024 * 1024) * 2;
constexpr size_t WM_IN = 0, WM_UQ = (size_t)512 * 1024 * 2, WM_UKV = WM_UQ + (size_t)1536 * 256 * 2, WM_O = WM_UKV + (size_t)2048 * 256 * 2;
constexpr size_t SZ_WRW = (size_t)(3 * 1024 * 1024 + 4 * 256 * 1024 + 1024 * 1024 + 4096 * 256 + 2048 * 256) * 2;
constexpr size_t WR_RKV = 0, WR_L = (size_t)3 * 1024 * 1024 * 2, WR_O = WR_L + (size_t)4 * 256 * 1024 * 2, WR_B2 = WR_O + (size_t)1024 * 1024 * 2, WR_B3 = WR_B2 + (size_t)4096 * 256 * 2;
constexpr size_t OFF_WMLA = OFF_H + SZ_BF;
constexpr size_t OFF_WRW = OFF_WMLA + 2 * SZ_WMLA;
constexpr size_t OFF_W13T = OFF_WRW + 2 * SZ_WRW;
constexpr size_t OFF_W2T = OFF_W13T + (size_t)NE * 2816 * D * 2;
constexpr size_t SZ_WMOE = (size_t)NE * 2816 * D * 2 + (size_t)NE * D * FF * 2;
constexpr size_t OFF_S = OFF_W13T + 2 * SZ_WMOE;
constexpr size_t OFF_Z = OFF_S;
constexpr size_t OFF_CQN = OFF_Z + al256((size_t)NROW * 512 * 4);
constexpr size_t OFF_CKVN = OFF_CQN + al256((size_t)NROW * 256 * 2);
constexpr size_t OFF_KR = OFF_CKVN + al256((size_t)NROW * 256 * 2);
constexpr size_t OFF_QRAW = OFF_KR + al256((size_t)NROW * 64 * 4);
constexpr size_t OFF_KVRAW = OFF_QRAW + al256((size_t)NROW * 1536 * 4);
constexpr size_t OFF_Q = OFF_KVRAW + al256((size_t)NROW * 2048 * 4);
constexpr size_t OFF_K = OFF_Q + al256((size_t)NB * 8 * TK * 192 * 2);
constexpr size_t OFF_V = OFF_K + al256((size_t)NB * 8 * TK * 192 * 2);
constexpr size_t OFF_O = OFF_V + al256((size_t)NB * 8 * TK * 128 * 2);
constexpr size_t END_MLA = OFF_O + SZ_BF;
constexpr size_t OFF_XS = OFF_S;
constexpr size_t OFF_RKV = OFF_XS + 6 * SZ_BF;
constexpr size_t OFF_W = OFF_RKV + 3 * SZ_BF;
constexpr size_t OFF_AV = OFF_W + 2 * SZ_F32;
constexpr size_t OFF_G = OFF_AV + 2 * SZ_BF;
constexpr size_t OFF_A2 = OFF_G + SZ_BF;
constexpr size_t OFF_A3 = OFF_A2 + al256((size_t)NROW * 256 * 2);
constexpr size_t END_RW = OFF_A3 + al256((size_t)NROW * 256 * 2);
constexpr size_t OFF_Y = OFF_XS;
constexpr int NCHK = (TC + TL) / 64;
constexpr size_t OFF_CK = END_RW;
constexpr size_t END_RW2 = OFF_CK + (size_t)128 * NCHK * 4 * 4096 * 2;
constexpr size_t OFF_AFF = OFF_S;
constexpr size_t OFF_ROWIDX = OFF_AFF + al256((size_t)NROW * 16 * 4);
constexpr size_t OFF_GATE = OFF_ROWIDX + al256((size_t)NE * ESLOTS * 4);
constexpr size_t OFF_SLOT = OFF_GATE + al256((size_t)NE * EPAD * 4);
constexpr size_t OFF_XE = OFF_SLOT + al256((size_t)NROW * 16 * 4);
constexpr size_t OFF_HID = OFF_XE + al256((size_t)NE * EPAD * D * 2);
constexpr size_t OFF_YE = OFF_HID + al256((size_t)NE * EPAD * FF * 2);
constexpr size_t END_MOE = OFF_YE + al256((size_t)NE * EPAD * D * 2);
constexpr size_t WS_NEED = END_RW2 > END_MLA ? (END_RW2 > END_MOE ? END_RW2 : END_MOE) : (END_MLA > END_MOE ? END_MLA : END_MOE);

constexpr int LDS_BYTES = 152064;

struct Params {
    const float *x, *c, *ctx, *c_ctx, *mod_w, *mod_b, *norm1_g, *norm2_g, *final_g;
    const float *mla_w_in, *mla_g_q, *mla_g_kv, *mla_w_uq, *mla_w_ukv, *mla_w_o;
    const float *rw_mu, *rw_w_rkv, *rw_w0, *rw_w1, *rw_w2, *rw_a0, *rw_a1, *rw_a2, *rw_v0, *rw_v1, *rw_v2, *rw_g1, *rw_g2, *rw_k_k, *rw_k_a, *rw_r_k, *rw_lnx_g, *rw_lnx_b, *rw_w_o;
    const float *moe_router, *moe_w1, *moe_w3, *moe_w2;
    float* out; char* ws;
    int wv, pad_;
};

__device__ __forceinline__ int bidx() { int t = blockIdx.x; asm volatile("" : "+s"(t)); return t; }
__device__ __forceinline__ int gdim() { int t = gridDim.x; asm volatile("" : "+s"(t)); return t; }
__device__ __forceinline__ int tidx_w(int wv) { int l; asm volatile("v_mbcnt_lo_u32_b32 %0, -1, 0\n\tv_mbcnt_hi_u32_b32 %0, -1, %0" : "=v"(l)); return (wv << 6) | l; }
#define tidx() tidx_w(p.wv)
#define XB_TMO      128
#define XB_XCNT(j)  (256  + 64 * (j))
#define XB_XSUB(j)  (1280 + 64 * (j))
#define XB_XGEN(j)  (2304 + 64 * (j))
#define XB_TOP      3328
#define XB_TOPGEN   3392
#define XCD_BAR_WORDS 3456
#define XB_SPIN_CAP (1u << 22)
#define LAS __attribute__((address_space(3)))

__device__ __forceinline__ unsigned xb_ld(unsigned* p)              { return __hip_atomic_load(p, __ATOMIC_RELAXED, __HIP_MEMORY_SCOPE_AGENT); }
__device__ __forceinline__ unsigned xb_add(unsigned* p, unsigned v) { return __hip_atomic_fetch_add(p, v, __ATOMIC_RELAXED, __HIP_MEMORY_SCOPE_AGENT); }
__device__ __forceinline__ unsigned xb_xcc_id() { return (unsigned)__builtin_amdgcn_s_getreg((3 << 11) | 20) & 0xFu; }
#define XB_SPIN(cond, bar) do { unsigned _sp = 0; while (cond) { __builtin_amdgcn_s_sleep(1); \
    if ((++_sp & 255u) == 0u) { if (xb_ld(&(bar)[XB_TMO])) break; if (_sp > XB_SPIN_CAP) { atomicAdd(&(bar)[XB_TMO], 1u); break; } } } } while (0)

struct XcdBarrier { unsigned* bar; unsigned x; volatile LAS unsigned* st; };

__device__ __forceinline__ XcdBarrier xcd_barrier_post(unsigned* bar, volatile LAS unsigned* st) {
    XcdBarrier b; b.bar = bar; b.x = xb_xcc_id(); b.st = st;
    if (threadIdx.x == 0) (void)xb_add(&bar[XB_XCNT(b.x)], 1u);
    return b;
}
__device__ __forceinline__ void xcd_barrier_complete(unsigned* bar, unsigned x, unsigned& nloc, unsigned& nx) {
    const unsigned G = gridDim.x * gridDim.y * gridDim.z;
    unsigned sum, cnt, mine, sp = 0u;
    for (;;) {
        sum = 0u; cnt = 0u; mine = 0u;
#pragma unroll
        for (unsigned j = 0; j < 16; ++j) { const unsigned c = xb_ld(&bar[XB_XCNT(j)]); sum += c; cnt += (c > 0u) ? 1u : 0u; mine = (j == x) ? c : mine; }
        if (sum == G) break;
        __builtin_amdgcn_s_sleep(1);
        if ((++sp & 255u) == 0u) { if (xb_ld(&bar[XB_TMO])) break; if (sp > XB_SPIN_CAP) { atomicAdd(&bar[XB_TMO], 1u); break; } }
    }
    nloc = mine > 0u ? mine : 1u; nx = cnt > 0u ? cnt : 1u;
}
__device__ __forceinline__ void xcd_barrier(const XcdBarrier& b) {
    asm volatile("s_waitcnt vmcnt(0)" ::: "memory");
    __syncthreads();
    if (threadIdx.x == 0) {
        unsigned* bar = b.bar;
        __builtin_amdgcn_s_waitcnt(0);
        unsigned nloc = b.st[0], nx = b.st[1];
        if (nloc == 0u) { xcd_barrier_complete(bar, b.x, nloc, nx); b.st[0] = nloc; b.st[1] = nx; }
        const unsigned old = xb_add(&bar[XB_XSUB(b.x)], 1u);
        const unsigned gen = old / nloc;
        if (old + 1u == (gen + 1u) * nloc) {
            __builtin_amdgcn_fence(__ATOMIC_RELEASE, "agent");
            asm volatile("s_waitcnt vmcnt(0)" ::: "memory");
            const unsigned og = xb_add(&bar[XB_TOP], 1u);
            const unsigned tg = og / nx;
            if (og + 1u == (tg + 1u) * nx) xb_add(&bar[XB_TOPGEN], 1u);
            else XB_SPIN(xb_ld(&bar[XB_TOPGEN]) == tg, bar);
            __builtin_amdgcn_fence(__ATOMIC_ACQUIRE, "agent");
            xb_add(&bar[XB_XGEN(b.x)], 1u);
            asm volatile("s_waitcnt vmcnt(0)" ::: "memory");
        } else {
            XB_SPIN(xb_ld(&bar[XB_XGEN(b.x)]) == gen, bar);
            __builtin_amdgcn_fence(__ATOMIC_ACQUIRE, "agent");
            asm volatile("s_waitcnt vmcnt(0)" ::: "memory");
        }
    }
    __syncthreads();
}

__device__ __forceinline__ float bf2f(bf16_t b) { return __uint_as_float(((unsigned)b) << 16); }
typedef float f32x2_ __attribute__((ext_vector_type(2)));
typedef __bf16 bf16x2_ __attribute__((ext_vector_type(2)));
__device__ __forceinline__ unsigned pk2(float lo, float hi) { const f32x2_ v = {lo, hi}; return __builtin_bit_cast(unsigned, __builtin_convertvector(v, bf16x2_)); }
__device__ __forceinline__ bf16_t f2bf(float f) { return (bf16_t)(pk2(f, f) & 0xffffu); }
__device__ __forceinline__ float dpp_sum16(float x) {
    x += __builtin_bit_cast(float, __builtin_amdgcn_update_dpp(0, __builtin_bit_cast(int, x), 0xB1, 0xF, 0xF, true));
    x += __builtin_bit_cast(float, __builtin_amdgcn_update_dpp(0, __builtin_bit_cast(int, x), 0x4E, 0xF, 0xF, true));
    x += __builtin_bit_cast(float, __builtin_amdgcn_update_dpp(0, __builtin_bit_cast(int, x), 0x141, 0xF, 0xF, true));
    x += __builtin_bit_cast(float, __builtin_amdgcn_update_dpp(0, __builtin_bit_cast(int, x), 0x140, 0xF, 0xF, true));
    return x;
}
__device__ __forceinline__ f32x4 ldbf4(const bf16_t* p) { const uint2 w = *(const uint2*)p; return (f32x4){__uint_as_float(w.x << 16), __uint_as_float(w.x & 0xffff0000u), __uint_as_float(w.y << 16), __uint_as_float(w.y & 0xffff0000u)}; }
__device__ __forceinline__ void stbf4(bf16_t* p, f32x4 v) { uint2 w; w.x = pk2(v[0], v[1]); w.y = pk2(v[2], v[3]); *(uint2*)p = w; }
typedef bf16_t xt_t;
__device__ __forceinline__ f32x4 xldv(const xt_t* X, size_t i) { return ldbf4(X + i); }
__device__ __forceinline__ void xstv(xt_t* X, size_t i, f32x4 v) { stbf4(X + i, v); }
__device__ __forceinline__ float4 xld(const xt_t* X, size_t i) { const f32x4 v = ldbf4(X + i); return make_float4(v[0], v[1], v[2], v[3]); }
__device__ __forceinline__ void xst(xt_t* X, size_t i, float4 v) { stbf4(X + i, (f32x4){v.x, v.y, v.z, v.w}); }
__device__ __forceinline__ float wave_sum(float v) {
    v = dpp_sum16(v); const int i = __builtin_bit_cast(int, v);
    return __builtin_bit_cast(float, __builtin_amdgcn_readlane(i, 0)) + __builtin_bit_cast(float, __builtin_amdgcn_readlane(i, 16)) + __builtin_bit_cast(float, __builtin_amdgcn_readlane(i, 32)) + __builtin_bit_cast(float, __builtin_amdgcn_readlane(i, 48));
}
__device__ __forceinline__ float sigmoidf_(float x) { return __builtin_amdgcn_rcpf(1.f + __expf(-x)); }
__device__ __forceinline__ int row_stream(int row) { return row < NLAT ? (row >> 12) : 4; }
__device__ __forceinline__ const float* modp(const Params& p, int layer, int s, int part) { return (const float*)(p.ws + OFF_MOD) + ((size_t)layer * 5 + s) * 6144 + part * 1024; }

struct SgArgs { const bf16_t* A; int lda; size_t strideA; const float* B; int ldb; size_t strideB; int M, N, K, nbatch; };
template <class Epi>
__device__ __forceinline__ void sg_gemm(const Params& p, char* lds, const SgArgs g, const Epi& epi) {
    bf16_t* As = (bf16_t*)lds;
    bf16_t* Bs = As + 128 * 40;
    const int tid = tidx(), wid = tid >> 6, lane = tid & 63;
    const int wr = wid >> 2, wc = wid & 3;
    const int tilesN = (g.N + 127) / 128, tilesM = g.M / 128, per = tilesM * tilesN, ntiles = per * g.nbatch;
    const int ar = tid >> 2, ak = (tid & 3) * 8;
    const int bn = tid & 127, bk = (tid >> 7) * 8;
    for (int tile = bidx(); tile < ntiles; tile += gdim()) {
        const int bt = tile / per, tt = tile % per;
        const int tm = tt / tilesN, tn = tt % tilesN;
        const int m0 = tm * 128, n0 = tn * 128;
        f32x4 acc[4][2];
#pragma unroll
        for (int m = 0; m < 4; ++m)
#pragma unroll
            for (int n = 0; n < 2; ++n) acc[m][n] = (f32x4){0.f, 0.f, 0.f, 0.f};
        const bool bvalid = (n0 + bn) < g.N;
        const bf16_t* ap = g.A + bt * g.strideA + (size_t)(m0 + ar) * g.lda + ak;
        const float* bp = g.B + bt * g.strideB + (size_t)bk * g.ldb + n0 + bn;
        bf16x8 areg; float breg[8];
        areg = *(const bf16x8*)ap;
#pragma unroll
        for (int j = 0; j < 8; ++j) breg[j] = bvalid ? bp[(size_t)j * g.ldb] : 0.f;
        for (int k0 = 0; k0 < g.K; k0 += 32) {
            __syncthreads();
            *(bf16x8*)(As + ar * 40 + ak) = areg;
            { u32x4 w; w.x = pk2(breg[0], breg[1]); w.y = pk2(breg[2], breg[3]); w.z = pk2(breg[4], breg[5]); w.w = pk2(breg[6], breg[7]); *(u32x4*)(Bs + bn * 40 + bk) = w; }
            __syncthreads();
            if (k0 + 32 < g.K) {
                areg = *(const bf16x8*)(ap + k0 + 32);
#pragma unroll
                for (int j = 0; j < 8; ++j) breg[j] = bvalid ? bp[(size_t)(k0 + 32 + j) * g.ldb] : 0.f;
            }
            bf16x8 af[4], bfr[2];
#pragma unroll
            for (int m = 0; m < 4; ++m) af[m] = *(const bf16x8*)(As + (wr * 64 + m * 16 + (lane & 15)) * 40 + (lane >> 4) * 8);
#pragma unroll
            for (int n = 0; n < 2; ++n) bfr[n] = *(const bf16x8*)(Bs + (wc * 32 + n * 16 + (lane & 15)) * 40 + (lane >> 4) * 8);
#pragma unroll
            for (int m = 0; m < 4; ++m)
#pragma unroll
                for (int n = 0; n < 2; ++n) acc[m][n] = __builtin_amdgcn_mfma_f32_16x16x32_bf16(af[m], bfr[n], acc[m][n], 0, 0, 0);
        }
#pragma unroll
        for (int m = 0; m < 4; ++m)
#pragma unroll
            for (int n = 0; n < 2; ++n) {
                const int col = n0 + wc * 32 + n * 16 + (lane & 15);
                if (col < g.N) {
#pragma unroll
                    for (int r = 0; r < 4; ++r) epi(bt, m0 + wr * 64 + m * 16 + (lane >> 4) * 4 + r, col, acc[m][n][r]);
                }
            }
    }
}


namespace g8 {
#define PG8_LAS __attribute__((address_space(3)))
constexpr int BM = 256, BK = 64, HALF = 128, HTB = HALF * BK * 2, STAGE_BYTES = 8 * HTB;
__device__ __forceinline__ int lds_byte(int r, int c) { const int st = (r >> 4) * 2 + (c >> 5), rr = r & 15, cc = c & 31, ob = rr * 64 + cc * 2; return st * 1024 + (ob ^ (((ob >> 9) & 1) << 5)); }
__device__ __forceinline__ void stage_rc(int b, int& R, int& C) { const int st = b / 1024, sb = b % 1024, swz = sb ^ (((sb >> 9) & 1) << 5); R = (st >> 1) * 16 + swz / 64; C = (st & 1) * 32 + (swz % 64) / 2; }
struct Unit { int pm, pn, g; const char* A; const char* B; };
__device__ __forceinline__ int xcd_remap(int L, int nwg) { const int q = nwg / 8, r = nwg % 8, xcd = L % 8, off = L / 8; return (xcd < r ? xcd * (q + 1) : r * (q + 1) + (xcd - r) * q) + off; }

template <class Epi, class Sched>
__device__ __forceinline__ void gemm_phase(const int wv_, PG8_LAS unsigned char* lds, const int K, const Sched& S, const Epi& E) {
    const int tid = tidx_w(wv_), wid = __builtin_amdgcn_readfirstlane(tid >> 6), lane = tid & 63, wr = wid >> 2, wc = wid & 3, fr = lane & 15, fq = lane >> 4;
    const int nt = K / BK;
    unsigned voffA[2];
#pragma unroll
    for (int i = 0; i < 2; ++i) { int R, C; stage_rc(tid * 16 + i * 8192, R, C); voffA[i] = (unsigned)(R * K + C) * 2u; }
    const size_t kstep = (size_t)(BK * 2);
    const size_t hstep = (size_t)HALF * K * 2;
    const unsigned ldsw = (unsigned)wid * 1024u;
    const int aoff = lds_byte(wr * 64 + fr, fq * 8), boff = lds_byte(wc * 32 + fr, fq * 8);
#define PG8_SA(b, h) (((b) * 2 + (h)) * HTB)
#define PG8_SB(b, h) ((4 + (b) * 2 + (h)) * HTB)
#define PG8_STAGE(bufoff, gbase, voff) do { _Pragma("unroll") for (int _i = 0; _i < 2; ++_i) \
        __builtin_amdgcn_global_load_lds((const unsigned*)((const char*)(gbase) + (voff)[_i]), (PG8_LAS unsigned*)(lds + (bufoff) + ldsw + _i * 8192), 16, 0, 0); } while (0)
#define PG8_LDA(dst, b, h) do { _Pragma("unroll") for (int m = 0; m < 4; ++m) _Pragma("unroll") for (int k = 0; k < 2; ++k) dst[m][k] = *(const PG8_LAS bf16x8*)(lds + PG8_SA(b, h) + aoff + m * 2048 + k * 1024); } while (0)
#define PG8_LDB(dst, b, h) do { _Pragma("unroll") for (int n = 0; n < 2; ++n) _Pragma("unroll") for (int k = 0; k < 2; ++k) dst[n][k] = *(const PG8_LAS bf16x8*)(lds + PG8_SB(b, h) + boff + n * 2048 + k * 1024); } while (0)
#define PG8_MMA(ai, bj, At, Bt) do { __builtin_amdgcn_s_setprio(1); _Pragma("unroll") for (int m = 0; m < 4; ++m) _Pragma("unroll") for (int n = 0; n < 2; ++n) _Pragma("unroll") for (int k = 0; k < 2; ++k) \
        acc[ai][bj][m][n] = __builtin_amdgcn_mfma_f32_16x16x32_bf16(Bt[n][k], At[m][k], acc[ai][bj][m][n], 0, 0, 0); __builtin_amdgcn_s_setprio(0); } while (0)
#define PG8_WAIT_V(n) asm volatile("s_waitcnt vmcnt(" #n ")" ::: "memory")
#define PG8_WAIT_L(n) asm volatile("s_waitcnt lgkmcnt(" #n ")" ::: "memory")
#define PG8_BAR __builtin_amdgcn_s_barrier()
#define PG8_SCHED __builtin_amdgcn_sched_barrier(0)
    Unit cur, nxt; int ui = 0;
    if (!S.next(0, cur)) return;
    f32x4 acc[2][2][4][2];
#pragma unroll
    for (int a = 0; a < 2; ++a)
#pragma unroll
        for (int b = 0; b < 2; ++b)
#pragma unroll
            for (int m = 0; m < 4; ++m)
#pragma unroll
                for (int n = 0; n < 2; ++n) acc[a][b][m][n] = (f32x4){0.f, 0.f, 0.f, 0.f};
    bf16x8 At[4][2], B0[2][2], B1[2][2];
    const char* cA = cur.A; const char* cB = cur.B;
    PG8_STAGE(PG8_SB(0, 0), cB, voffA); PG8_STAGE(PG8_SA(0, 0), cA, voffA); PG8_STAGE(PG8_SB(0, 1), cB + hstep, voffA); PG8_STAGE(PG8_SA(0, 1), cA + hstep, voffA);
    if (wr == 1) PG8_BAR;
    PG8_WAIT_V(4); PG8_BAR;
    PG8_STAGE(PG8_SB(1, 0), cB + kstep, voffA); PG8_STAGE(PG8_SA(1, 0), cA + kstep, voffA); PG8_STAGE(PG8_SB(1, 1), cB + hstep + kstep, voffA);
    PG8_WAIT_V(6); PG8_BAR;
    for (;;) {
        const bool has_next = S.next(ui + 1, nxt);
        const char* nA = has_next ? nxt.A : cA; const char* nB = has_next ? nxt.B : cB;
        for (int t = 0; t < nt; t += 2) {
            const bool last = (t == nt - 2);
            const char* a1 = cA + (size_t)(t + 1) * kstep;
            const char* a2 = last ? nA : cA + (size_t)(t + 2) * kstep; const char* b2 = last ? nB : cB + (size_t)(t + 2) * kstep;
            const char* a3 = a2 + kstep; const char* b3 = b2 + kstep;
            PG8_LDB(B0, 0, 0); PG8_SCHED; PG8_LDA(At, 0, 0); PG8_STAGE(PG8_SA(1, 1), a1 + hstep, voffA);
            PG8_WAIT_L(8); PG8_BAR; PG8_WAIT_L(0); PG8_MMA(0, 0, At, B0); PG8_BAR; PG8_SCHED;
            PG8_LDB(B1, 0, 1); PG8_STAGE(PG8_SB(0, 0), b2, voffA);
            PG8_BAR; PG8_WAIT_L(0); PG8_MMA(0, 1, At, B1); PG8_BAR;
            PG8_LDA(At, 0, 1); PG8_STAGE(PG8_SA(0, 0), a2, voffA);
            PG8_BAR; PG8_WAIT_L(0); PG8_MMA(1, 0, At, B0); PG8_BAR; PG8_SCHED;
            PG8_STAGE(PG8_SB(0, 1), b2 + hstep, voffA);
            PG8_WAIT_V(6); PG8_BAR; PG8_MMA(1, 1, At, B1); PG8_BAR;
            PG8_LDB(B0, 1, 0); PG8_SCHED; PG8_LDA(At, 1, 0); PG8_STAGE(PG8_SA(0, 1), a2 + hstep, voffA);
            PG8_WAIT_L(8); PG8_BAR; PG8_WAIT_L(0); PG8_MMA(0, 0, At, B0); PG8_BAR; PG8_SCHED;
            PG8_LDB(B1, 1, 1); PG8_STAGE(PG8_SB(1, 0), b3, voffA);
            PG8_BAR; PG8_WAIT_L(0); PG8_MMA(0, 1, At, B1); PG8_BAR;
            PG8_LDA(At, 1, 1); PG8_STAGE(PG8_SA(1, 0), a3, voffA);
            PG8_BAR; PG8_WAIT_L(0); PG8_MMA(1, 0, At, B0); PG8_BAR; PG8_SCHED;
            PG8_STAGE(PG8_SB(1, 1), b3 + hstep, voffA);
            PG8_WAIT_V(6); PG8_BAR; PG8_MMA(1, 1, At, B1); PG8_BAR;
        }
        E(acc, cur, wr, wc, fr, fq);
        if (!has_next) break;
#pragma unroll
        for (int a = 0; a < 2; ++a)
#pragma unroll
            for (int b = 0; b < 2; ++b)
#pragma unroll
                for (int m = 0; m < 4; ++m)
#pragma unroll
                    for (int n = 0; n < 2; ++n) acc[a][b][m][n] = (f32x4){0.f, 0.f, 0.f, 0.f};
        cur = nxt; cA = nA; cB = nB; ++ui;
    }
    PG8_WAIT_V(0);
    if (wr == 0) PG8_BAR;
    PG8_BAR;
#undef PG8_SA
#undef PG8_SB
#undef PG8_STAGE
#undef PG8_LDA
#undef PG8_LDB
#undef PG8_MMA
#undef PG8_WAIT_V
#undef PG8_WAIT_L
#undef PG8_BAR
#undef PG8_SCHED
}
template <class F> struct EpiRC { F f;
    __device__ __forceinline__ void operator()(const f32x4 (&acc)[2][2][4][2], const Unit& u, int wr, int wc, int fr, int fq) const {
#pragma unroll
        for (int ai = 0; ai < 2; ++ai)
#pragma unroll
            for (int m = 0; m < 4; ++m) { const int row = u.pm * BM + ai * HALF + wr * 64 + m * 16 + fr;
#pragma unroll
                for (int bj = 0; bj < 2; ++bj)
#pragma unroll
                    for (int n = 0; n < 2; ++n) f(u, row, u.pn * BM + bj * HALF + wc * 32 + n * 16 + 4 * fq, acc[ai][bj][m][n]);
                asm volatile("" ::: "memory"); }
    } };
template <class F> __device__ __forceinline__ EpiRC<F> epi_rc(const F& f) { return EpiRC<F>{f}; }
template <class F> struct EpiPair { F f;
    __device__ __forceinline__ void operator()(const f32x4 (&acc)[2][2][4][2], const Unit& u, int wr, int wc, int fr, int fq) const {
#pragma unroll
        for (int ai = 0; ai < 2; ++ai)
#pragma unroll
            for (int m = 0; m < 4; ++m) { const int row = u.pm * BM + ai * HALF + wr * 64 + m * 16 + fr;
#pragma unroll
                for (int n = 0; n < 2; ++n) f(u, row, u.pn * HALF + wc * 32 + n * 16 + 4 * fq, acc[ai][0][m][n], acc[ai][1][m][n]);
                asm volatile("" ::: "memory"); }
    } };
template <class F> __device__ __forceinline__ EpiPair<F> epi_pair(const F& f) { return EpiPair<F>{f}; }
template <class F, class CF, class RF> struct EpiPre { F f; CF cf; RF rf;
    __device__ __forceinline__ void operator()(const f32x4 (&acc)[2][2][4][2], const Unit& u, int wr, int wc, int fr, int fq) const {
        f32x4 cv[2][2]; float rv[2][4];
#pragma unroll
        for (int bj = 0; bj < 2; ++bj)
#pragma unroll
            for (int n = 0; n < 2; ++n) cv[bj][n] = cf(u, u.pn * BM + bj * HALF + wc * 32 + n * 16 + 4 * fq);
#pragma unroll
        for (int ai = 0; ai < 2; ++ai)
#pragma unroll
            for (int m = 0; m < 4; ++m) rv[ai][m] = rf(u, u.pm * BM + ai * HALF + wr * 64 + m * 16 + fr);
#pragma unroll
        for (int ai = 0; ai < 2; ++ai)
#pragma unroll
            for (int m = 0; m < 4; ++m) { const int row = u.pm * BM + ai * HALF + wr * 64 + m * 16 + fr;
#pragma unroll
                for (int bj = 0; bj < 2; ++bj)
#pragma unroll
                    for (int n = 0; n < 2; ++n) f(u, row, u.pn * BM + bj * HALF + wc * 32 + n * 16 + 4 * fq, acc[ai][bj][m][n], cv[bj][n], rv[ai][m]);
                asm volatile("" ::: "memory"); }
    } };
template <class F, class CF, class RF> __device__ __forceinline__ EpiPre<F, CF, RF> epi_pre(const F& f, const CF& cf, const RF& rf) { return EpiPre<F, CF, RF>{f, cf, rf}; }
template <class F, class CF> struct EpiColFirst { F f; CF cf;
    __device__ __forceinline__ void operator()(const f32x4 (&acc)[2][2][4][2], const Unit& u, int wr, int wc, int fr, int fq) const {
#pragma unroll
        for (int bj = 0; bj < 2; ++bj)
#pragma unroll
            for (int n = 0; n < 2; ++n) { const int col = u.pn * BM + bj * HALF + wc * 32 + n * 16 + 4 * fq; const f32x4 cv = cf(u, col);
#pragma unroll
                for (int ai = 0; ai < 2; ++ai)
#pragma unroll
                    for (int m = 0; m < 4; ++m) f(u, u.pm * BM + ai * HALF + wr * 64 + m * 16 + fr, col, acc[ai][bj][m][n], cv);
                asm volatile("" ::: "memory"); }
    } };
template <class F, class CF> __device__ __forceinline__ EpiColFirst<F, CF> epi_colfirst(const F& f, const CF& cf) { return EpiColFirst<F, CF>{f, cf}; }
struct EpiResid { xt_t* X; const float* MOD; int layer;
    __device__ __forceinline__ void operator()(const f32x4 (&acc)[2][2][4][2], const Unit& u, int wr, int wc, int fr, int fq) const {
        const int row0 = u.pm * BM + wr * 64 + fr, col0 = u.pn * BM + wc * 32 + 4 * fq;
        const int strm = row0 < NLAT ? (row0 >> 12) : 4;
        const float* gp = MOD + ((size_t)layer * 5 + strm) * 6144 + 2048 + col0;
        f32x4 gt[2][2];
#pragma unroll
        for (int bj = 0; bj < 2; ++bj)
#pragma unroll
            for (int n = 0; n < 2; ++n) gt[bj][n] = *(const f32x4*)(gp + bj * HALF + n * 16);
#pragma unroll
        for (int ai = 0; ai < 2; ++ai) {
            f32x4 xv[4][2][2];
#pragma unroll
            for (int m = 0; m < 4; ++m)
#pragma unroll
                for (int bj = 0; bj < 2; ++bj)
#pragma unroll
                    for (int n = 0; n < 2; ++n) xv[m][bj][n] = xldv(X, (size_t)(row0 + ai * HALF + m * 16) * D + col0 + bj * HALF + n * 16);
#pragma unroll
            for (int m = 0; m < 4; ++m)
#pragma unroll
                for (int bj = 0; bj < 2; ++bj)
#pragma unroll
                    for (int n = 0; n < 2; ++n) xstv(X, (size_t)(row0 + ai * HALF + m * 16) * D + col0 + bj * HALF + n * 16, xv[m][bj][n] + gt[bj][n] * acc[ai][bj][m][n]);
            asm volatile("" ::: "memory");
        }
    } };
struct BatchSched { const char* A; const char* B; size_t strideA, strideB; int nM, nN, nb, K; int rev = 0;
    __device__ __forceinline__ bool next(int i, Unit& u) const {
        const int nwg = nM * nN * nb; const int L = i * gdim() + (rev ? gdim() - 1 - bidx() : bidx()); if (L >= nwg) return false;
        const int w = xcd_remap(L, nwg); const int per = nM * nN; u.g = w / per; const int r = w % per; u.pm = r / nN; u.pn = r % nN;
        u.A = A + u.g * strideA + (size_t)u.pm * BM * K * 2; u.B = B + u.g * strideB + (size_t)u.pn * BM * K * 2; return true; } };
}

template <class SrcF, class DRow>
__device__ __forceinline__ int cvt_tiles(const int wv_, char* lds, bf16_t* dst, int Kd, int Nd, int nbatch, size_t dstride, const SrcF& src, const DRow& drow, int* rot = nullptr) {
    bf16_t* T = (bf16_t*)lds;
    const int tid = tidx_w(wv_);
    const int tk = Kd / 128, tn = Nd / 64, per = tk * tn, total = per * nbatch;
    {
        int first = bidx() - (rot ? *rot % gdim() : 0); if (first < 0) first += gdim();
        if (rot) *rot += total;
        for (int t = first; t < total; t += gdim()) {
            const int bt = t / per, r = t % per, k0 = (r % tk) * 128, n0 = (r / tk) * 64;
            float4 v[4];
#pragma unroll
            for (int i = 0; i < 4; ++i) { const int k = k0 + i * 32 + (tid >> 4), n = n0 + (tid & 15) * 4; const float* sp = src(bt, k, n); v[i] = sp ? *(const float4*)sp : make_float4(0.f, 0.f, 0.f, 0.f); }
            __syncthreads();
#pragma unroll
            for (int i = 0; i < 4; ++i) { const int k = i * 32 + (tid >> 4), n = (tid & 15) * 4;
                T[(n + 0) * 136 + k] = f2bf(v[i].x); T[(n + 1) * 136 + k] = f2bf(v[i].y); T[(n + 2) * 136 + k] = f2bf(v[i].z); T[(n + 3) * 136 + k] = f2bf(v[i].w); }
            __syncthreads();
            { const int n = tid >> 3, kc = (tid & 7) * 16;
              const u32x4 a = *(const u32x4*)(T + n * 136 + kc), b = *(const u32x4*)(T + n * 136 + kc + 8);
              bf16_t* dp = dst + bt * dstride + (size_t)drow(n0 + n) * Kd + k0 + kc;
              *(u32x4*)dp = a; *(u32x4*)(dp + 8) = b; }
        }
    }
    return 0;
}
__device__ __forceinline__ int moe_cvt(const Params& p, int layer, char* lds, int budget) {
    constexpr int QG = 2, T13 = NE * 8 * 44, TOT = T13 + NE * 11 * 16;
    bf16_t* T = (bf16_t*)lds;
    int* qslot = (int*)(lds + 64 * 136 * 2);
    const int tid = tidx();
    const float* w1 = p.moe_w1 + (size_t)layer * NE * D * FF; const float* w3 = p.moe_w3 + (size_t)layer * NE * D * FF; const float* w2 = p.moe_w2 + (size_t)layer * NE * FF * D;
    bf16_t* W13 = (bf16_t*)(p.ws + OFF_W13T + (size_t)(layer & 1) * SZ_WMOE); bf16_t* W2 = (bf16_t*)(p.ws + OFF_W2T + (size_t)(layer & 1) * SZ_WMOE);
    unsigned* queue = (unsigned*)(p.ws + OFF_QUEUE) + layer * 32;
    const bool ahead = budget < 0;
    int done = 0, tnext = 0;
    __syncthreads();
    if (tid == 0) qslot[0] = QG * (int)__hip_atomic_fetch_add(queue, 1u, __ATOMIC_RELAXED, __HIP_MEMORY_SCOPE_AGENT);
    __syncthreads();
    int t0 = __builtin_amdgcn_readfirstlane(qslot[0]);
    while (t0 < TOT && (ahead || done < budget)) {
        const bool more = ahead || done + 1 < budget;
        if (more && tid == 0) tnext = QG * (int)__hip_atomic_fetch_add(queue, 1u, __ATOMIC_RELAXED, __HIP_MEMORY_SCOPE_AGENT);
#pragma unroll 1
        for (int sub = 0; sub < QG; ++sub) {
            const int t = t0 + sub;
            const float* sp; bf16_t* dp; int ss, ds;
            if (t < T13) { const int e = t / 352, r = t % 352, k0 = (r & 7) * 128, n0 = (r >> 3) * 64; const int c0 = (n0 >> 8) * 128 + (n0 & 127);
                sp = (((n0 >> 7) & 1) ? w3 : w1) + ((size_t)e * D + k0) * FF + c0; ss = FF; dp = W13 + ((size_t)e * 2816 + n0) * D + k0; ds = D; }
            else { const int u = t - T13, e = u / 176, r = u % 176, k0 = (r % 11) * 128, n0 = (r / 11) * 64;
                sp = w2 + ((size_t)e * FF + k0) * D + n0; ss = D; dp = W2 + ((size_t)e * D + n0) * FF + k0; ds = FF; }
            float4 v[4];
#pragma unroll
            for (int i = 0; i < 4; ++i) v[i] = *(const float4*)(sp + (size_t)(i * 32 + (tid >> 4)) * ss + (tid & 15) * 4);
            __syncthreads();
#pragma unroll
            for (int i = 0; i < 4; ++i) { const int k = i * 32 + (tid >> 4), n = (tid & 15) * 4;
                T[(n + 0) * 136 + k] = f2bf(v[i].x); T[(n + 1) * 136 + k] = f2bf(v[i].y); T[(n + 2) * 136 + k] = f2bf(v[i].z); T[(n + 3) * 136 + k] = f2bf(v[i].w); }
            if (sub == QG - 1 && tid == 0) qslot[0] = more ? tnext : TOT;
            __syncthreads();
            { const int n = tid >> 3, kc = (tid & 7) * 16;
              const u32x4 a = *(const u32x4*)(T + n * 136 + kc), b = *(const u32x4*)(T + n * 136 + kc + 8);
              bf16_t* o = dp + (size_t)n * ds + kc;
              *(u32x4*)o = a; *(u32x4*)(o + 8) = b; }
        }
        ++done; t0 = __builtin_amdgcn_readfirstlane(qslot[0]);
    }
    __syncthreads();
    return done;
}
__device__ __forceinline__ void bg_cvt(const Params& p, int layer, char* lds, int budget) {
#pragma unroll 1
    for (int l = layer; l < 4 && l <= layer + 1 && budget > 0; ++l) budget -= moe_cvt(p, l, lds, budget);
}
__device__ __forceinline__ bool idle_tail(int nunits) { const int r = nunits % gdim(); return r != 0 && bidx() >= r; }
__device__ void ph_init(const Params& p, char* lds) {
    const int tid = tidx(), gtid = bidx() * NTHR + tid, gsz = gdim() * NTHR;
    xt_t* Xs = (xt_t*)(p.ws + OFF_X);
    const float4* x4 = (const float4*)p.x; const float4* c4 = (const float4*)p.ctx;
    { constexpr int NQ = NROW * 256 / 4;
      auto srcv = [&](int k) { return k < NLAT * 256 ? x4[k] : c4[k - NLAT * 256]; };
      for (int i = gtid; i < NQ; i += gsz) { const float4 t0 = srcv(i), t1 = srcv(i + NQ), t2 = srcv(i + 2 * NQ), t3 = srcv(i + 3 * NQ); xst(Xs, (size_t)4 * i, t0); xst(Xs, (size_t)4 * (i + NQ), t1); xst(Xs, (size_t)4 * (i + 2 * NQ), t2); xst(Xs, (size_t)4 * (i + 3 * NQ), t3); } }
    float* rc = (float*)(p.ws + OFF_ROPE_C); float* rs = (float*)(p.ws + OFF_ROPE_S);
    for (int i = gtid; i < TL * 32; i += gsz) {
        const int t = i >> 5, f = i & 31; const float pos = (float)((f < 16) ? (t >> 6) : (t & 63));
        const float inv = powf(10000.f, -(float)(f & 15) / 16.f); const float ang = pos * inv; rc[2 * i] = cosf(ang); rc[2 * i + 1] = sinf(ang);
    }
    float* sc = (float*)lds;
    float* red = sc + 5 * 1024;
    for (int i = tid; i < 5 * 1024; i += NTHR) { const float v = i < 4096 ? p.c[i] : p.c_ctx[i - 4096]; sc[i] = v / (1.f + expf(-v)); }
    __syncthreads();
    float* MOD = (float*)(p.ws + OFF_MOD);
    for (int item = bidx(); item < 4 * 96; item += gdim()) {
        const int l = item / 96, cg = item % 96, col = tid & 63, n = cg * 64 + col, kg = tid >> 6;
        const float* w = p.mod_w + ((size_t)l * 1024 + kg * 128) * 6144 + n;
        float a0 = 0, a1 = 0, a2 = 0, a3 = 0, a4 = 0;
#pragma unroll 16
        for (int k = 0; k < 128; ++k) { const float wv = w[(size_t)k * 6144]; const int kk = kg * 128 + k;
            a0 += sc[kk] * wv; a1 += sc[1024 + kk] * wv; a2 += sc[2048 + kk] * wv; a3 += sc[3072 + kk] * wv; a4 += sc[4096 + kk] * wv; }
        float* rr = red + (kg * 64 + col) * 5; rr[0] = a0; rr[1] = a1; rr[2] = a2; rr[3] = a3; rr[4] = a4;
        __syncthreads();
        if (tid < 320) { const int c2 = tid & 63, s = tid >> 6; float sum = 0;
            for (int q = 0; q < 8; ++q) sum += red[(q * 64 + c2) * 5 + s];
            MOD[((size_t)l * 5 + s) * 6144 + cg * 64 + c2] = sum + p.mod_b[l * 6144 + cg * 64 + c2]; }
        __syncthreads();
    }
}


__device__ void ph_small_cvt(const Params& p, char* lds) {
    int rot = 128;
    for (int j = 0; j < 2; ++j) {
        char* wm = p.ws + OFF_WMLA + j * SZ_WMLA; char* wr = p.ws + OFF_WRW + j * SZ_WRW;
        const float* w_in = p.mla_w_in + (size_t)j * D * 448; const float* w_uq = p.mla_w_uq + (size_t)j * 256 * 1536; const float* w_ukv = p.mla_w_ukv + (size_t)j * 128 * 2048; const float* w_o = p.mla_w_o + (size_t)j * D * D;
        cvt_tiles(p.wv, lds, (bf16_t*)(wm + WM_IN), 1024, 512, 1, 0, [=](int, int k, int n) -> const float* { return n < 448 ? w_in + (size_t)k * 448 + n : nullptr; },
                  [=](int n) { if (n < 384 || n >= 448) return n; const int jj = n - 384; return 384 + (jj < 32 ? 2 * jj : 2 * (jj - 32) + 1); }, &rot);
        cvt_tiles(p.wv, lds, (bf16_t*)(wm + WM_UQ), 256, 1536, 1, 0, [=](int, int k, int n) -> const float* { return w_uq + (size_t)k * 1536 + n; },
                  [=](int n) { const int h = n / 192, d = n % 192; if (d < 128) return n; const int jj = d - 128; return h * 192 + 128 + (jj < 32 ? 2 * jj : 2 * (jj - 32) + 1); }, &rot);
        cvt_tiles(p.wv, lds, (bf16_t*)(wm + WM_UKV), 128, 2048, 1, 0, [=](int, int k, int n) -> const float* { return w_ukv + (size_t)k * 2048 + n; }, [=](int n) { return n; }, &rot);
        cvt_tiles(p.wv, lds, (bf16_t*)(wm + WM_O), 1024, 1024, 1, 0, [=](int, int k, int n) -> const float* { return w_o + (size_t)k * D + n; }, [=](int n) { return n; }, &rot);
        const float* w_rkv = p.rw_w_rkv + (size_t)j * 3 * D * D; const float* w1 = p.rw_w1 + (size_t)j * 2 * D * 64; const float* a1 = p.rw_a1 + (size_t)j * 2 * D * 64;
        const float* g1 = p.rw_g1 + (size_t)j * D * 128; const float* v1 = p.rw_v1; const float* rwo = p.rw_w_o + (size_t)j * D * D;
        cvt_tiles(p.wv, lds, (bf16_t*)(wr + WR_RKV), 1024, 1024, 3, (size_t)D * D, [=](int m, int k, int n) -> const float* { return w_rkv + ((size_t)m * D + k) * D + n; }, [=](int n) { return n; }, &rot);
        cvt_tiles(p.wv, lds, (bf16_t*)(wr + WR_L), 1024, 256, 1, 0, [=](int, int k, int n) -> const float* { return n < 128 ? w1 + ((size_t)(n >> 6) * D + k) * 64 + (n & 63) : nullptr; }, [=](int n) { return n; }, &rot);
        cvt_tiles(p.wv, lds, (bf16_t*)(wr + WR_L) + 256 * 1024, 1024, 256, 1, 0, [=](int, int k, int n) -> const float* { return n < 128 ? a1 + ((size_t)(n >> 6) * D + k) * 64 + (n & 63) : nullptr; }, [=](int n) { return n; }, &rot);
        cvt_tiles(p.wv, lds, (bf16_t*)(wr + WR_L) + 2 * 256 * 1024, 1024, 256, 1, 0, [=](int, int k, int n) -> const float* { return n < 128 ? g1 + (size_t)k * 128 + n : nullptr; }, [=](int n) { return n; }, &rot);
        cvt_tiles(p.wv, lds, (bf16_t*)(wr + WR_L) + 3 * 256 * 1024, 1024, 256, 1, 0, [=](int, int k, int n) -> const float* { return n < 32 ? v1 + (size_t)k * 32 + n : nullptr; }, [=](int n) { return n; }, &rot);
        cvt_tiles(p.wv, lds, (bf16_t*)(wr + WR_O), 1024, 1024, 1, 0, [=](int, int k, int n) -> const float* { return rwo + (size_t)k * D + n; }, [=](int n) { return n; }, &rot);
        const float* w2 = p.rw_w2 + (size_t)j * 2 * 64 * D; const float* a2 = p.rw_a2 + (size_t)j * 2 * 64 * D; const float* g2 = p.rw_g2 + (size_t)j * 128 * D; const float* v2 = p.rw_v2;
        cvt_tiles(p.wv, lds, (bf16_t*)(wr + WR_B2), 128, 2048, 2, (size_t)2048 * 128, [=](int bt, int k, int n) -> const float* { const int zz = n >> 10, c = n & 1023, l = k - zz * 64;
            if (l < 0 || l >= 64) return nullptr; return (bt == 0 ? w2 : a2) + ((size_t)zz * 64 + l) * D + c; }, [=](int n) { return n; }, &rot);
        cvt_tiles(p.wv, lds, (bf16_t*)(wr + WR_B3), 128, 1024, 2, (size_t)1024 * 128, [=](int bt, int k, int n) -> const float* {
            if (bt == 0) return g2 + (size_t)k * D + n; return k < 32 ? v2 + (size_t)k * D + n : nullptr; }, [=](int n) { return n; }, &rot);
    }
}

template <bool OUTF32>
__device__ void ph_norm_mod(const Params& p, int layer, const float* g, int part_sh, int part_sc, void* outp) {
    const int wid = tidx() >> 6, lane = tidx() & 63;
    const xt_t* X = (const xt_t*)(p.ws + OFF_X);
    const int w_ = bidx() * 8 + wid, nw_ = gdim() * 8;
    int row = (int)((long long)w_ * NROW / nw_); const int rend = (int)((long long)(w_ + 1) * NROW / nw_);
    float4 nv[4], gm[4], bb[4]; int scur = -1;
    if (row < rend) {
#pragma unroll
        for (int i = 0; i < 4; ++i) nv[i] = xld(X, (size_t)row * D + (lane + i * 64) * 4); }
    for (; row < rend; ++row) {
        const int s = row_stream(row);
        if (s != scur) { scur = s; const float* sh = modp(p, layer, s, part_sh); const float* sc = modp(p, layer, s, part_sc);
#pragma unroll
            for (int i = 0; i < 4; ++i) { const int d = (lane + i * 64) * 4; const float4 gg = *(const float4*)(g + d), a = *(const float4*)(sc + d); bb[i] = *(const float4*)(sh + d);
                gm[i] = make_float4(gg.x * (1.f + a.x), gg.y * (1.f + a.y), gg.z * (1.f + a.z), gg.w * (1.f + a.w)); } }
        float4 v[4]; float ss = 0;
#pragma unroll
        for (int i = 0; i < 4; ++i) { v[i] = nv[i]; ss += v[i].x * v[i].x + v[i].y * v[i].y + v[i].z * v[i].z + v[i].w * v[i].w; }
        { const int nrow = row + 1;
          if (nrow < rend) {
#pragma unroll
              for (int i = 0; i < 4; ++i) nv[i] = xld(X, (size_t)nrow * D + (lane + i * 64) * 4); } }
        ss = wave_sum(ss); const float rs = rsqrtf(ss * (1.f / D) + RMS_EPS);
#pragma unroll
        for (int i = 0; i < 4; ++i) {
            const int d = (lane + i * 64) * 4;
            float4 o; o.x = v[i].x * rs * gm[i].x + bb[i].x; o.y = v[i].y * rs * gm[i].y + bb[i].y; o.z = v[i].z * rs * gm[i].z + bb[i].z; o.w = v[i].w * rs * gm[i].w + bb[i].w;
            if (OUTF32) *(float4*)((float*)outp + (size_t)row * D + d) = o;
            else { uint2 w; w.x = pk2(o.x, o.y); w.y = pk2(o.z, o.w); *(uint2*)((bf16_t*)outp + (size_t)row * D + d) = w; }
        }
    }
}

__device__ void ph_mla_mid(const Params& p, int j) {
    const int wid = tidx() >> 6, lane = tidx() & 63;
    const float* Z = (const float*)(p.ws + OFF_Z);
    bf16_t* CQN = (bf16_t*)(p.ws + OFF_CQN); bf16_t* CKVN = (bf16_t*)(p.ws + OFF_CKVN); bf16_t* K = (bf16_t*)(p.ws + OFF_K);
    const float* gq = p.mla_g_q + j * 256; const float* gkv = p.mla_g_kv + j * 128;
    const float* rc = (const float*)(p.ws + OFF_ROPE_C); const float* rs = (const float*)(p.ws + OFF_ROPE_S);
    for (int row = bidx() * 8 + wid; row < NROW; row += gdim() * 8) {
        const float* z = Z + (size_t)row * 512;
        const float4 q = *(const float4*)(z + lane * 4);
        const float2 kv = *(const float2*)(z + 256 + lane * 2);
        const float kr = z[384 + lane];
        float sq = wave_sum(q.x * q.x + q.y * q.y + q.z * q.z + q.w * q.w); const float rq = rsqrtf(sq * (1.f / 256.f) + RMS_EPS);
        float sk = wave_sum(kv.x * kv.x + kv.y * kv.y); const float rk = rsqrtf(sk * (1.f / 128.f) + RMS_EPS);
        const float4 g4 = *(const float4*)(gq + lane * 4); const float2 g2 = *(const float2*)(gkv + lane * 2);
        uint2 w; w.x = pk2(q.x * rq * g4.x, q.y * rq * g4.y); w.y = pk2(q.z * rq * g4.z, q.w * rq * g4.w);
        *(uint2*)(CQN + (size_t)row * 256 + lane * 4) = w;
        *(unsigned*)(CKVN + (size_t)row * 128 + lane * 2) = pk2(kv.x * rk * g2.x, kv.y * rk * g2.y);
        float o = kr;
        const float other = __builtin_bit_cast(float, __builtin_amdgcn_update_dpp(0, __builtin_bit_cast(int, kr), 0xB1, 0xF, 0xF, true));
        const bool lat = row < NLAT;
        if (lat) { const int t = row & (TL - 1), i = lane >> 1; const float2 cs = *(const float2*)(rc + (t * 32 + i) * 2); const float c = cs.x, s = cs.y;
            o = (lane & 1) ? (other * s + kr * c) : (kr * c - other * s); }
        const int b = lat ? (row >> 12) : ((row - NLAT) >> 8); const int tk = lat ? 256 + (row & (TL - 1)) : ((row - NLAT) & 255);
        const bf16_t ob = f2bf(o);
#pragma unroll
        for (int h = 0; h < 8; ++h) K[((size_t)(b * 8 + h) * TK + tk) * 192 + 128 + lane] = ob;
    }
}

__device__ void ph_qkv_post(const Params& p) {
    const int wid = tidx() >> 6, lane = tidx() & 63;
    const float* QRAW = (const float*)(p.ws + OFF_QRAW); const float* KVRAW = (const float*)(p.ws + OFF_KVRAW); const float* KR = (const float*)(p.ws + OFF_KR);
    bf16_t* Q = (bf16_t*)(p.ws + OFF_Q); bf16_t* K = (bf16_t*)(p.ws + OFF_K); bf16_t* V = (bf16_t*)(p.ws + OFF_V);
    const float* rc = (const float*)(p.ws + OFF_ROPE_C); const float* rs = (const float*)(p.ws + OFF_ROPE_S);
    for (int it = bidx() * 8 + wid; it < NROW * 8; it += gdim() * 8) {
        const int row = it >> 3, h = it & 7;
        const bool lat = row < NLAT; const int b = lat ? (row >> 12) : ((row - NLAT) >> 8); const int tk = lat ? 256 + (row & (TL - 1)) : ((row - NLAT) & 255);
        const size_t orow = (size_t)(b * 8 + h) * TK + tk;
        const float* q = QRAW + (size_t)row * 1536 + h * 192;
        const float q0 = q[lane], q1 = q[64 + lane]; float q2 = q[128 + lane];
        const auto sw = __builtin_amdgcn_permlane32_swap(__float_as_uint(q2), __float_as_uint(q2), false, false);
        if (lat) { const int t = row & (TL - 1), i = lane & 31; const float c = rc[t * 32 + i], s = rs[t * 32 + i];
            const float x1 = __uint_as_float(sw[0]), x2 = __uint_as_float(sw[1]); q2 = lane < 32 ? (x1 * c - x2 * s) : (x1 * s + x2 * c); }
        bf16_t* qo = Q + orow * 192; qo[lane] = f2bf(q0); qo[64 + lane] = f2bf(q1); qo[128 + lane] = f2bf(q2);
        const float* kv = KVRAW + (size_t)row * 2048 + h * 256;
        bf16_t* ko = K + orow * 192; ko[lane] = f2bf(kv[lane]); ko[64 + lane] = f2bf(kv[64 + lane]); ko[128 + lane] = f2bf(KR[(size_t)row * 64 + lane]);
        bf16_t* vo = V + orow * 128; vo[lane] = f2bf(kv[128 + lane]); vo[64 + lane] = f2bf(kv[192 + lane]);
    }
}

__device__ void ph_attn_naive(const Params& p, char* lds) {
    const int tid = tidx(), qi = tid >> 2, part = tid & 3;
    const bf16_t* Q = (const bf16_t*)(p.ws + OFF_Q); const bf16_t* K = (const bf16_t*)(p.ws + OFF_K); const bf16_t* V = (const bf16_t*)(p.ws + OFF_V);
    bf16_t* O = (bf16_t*)(p.ws + OFF_O);
    bf16_t* Ks = (bf16_t*)lds;
    bf16_t* Vs = Ks + 32 * 192;
    const int nitems = 32 * 34;
    for (int it = bidx(); it < nitems; it += gdim()) {
        const int bh = it / 34, qb = it % 34; const int b = bh >> 3, h = bh & 7;
        const int nkeys = qb < 2 ? TC : TK;
        const int tq = qb * 128 + qi;
        const bf16_t* qp = Q + ((size_t)bh * TK + tq) * 192 + part * 48;
        float q[48];
#pragma unroll
        for (int i = 0; i < 48; ++i) q[i] = bf2f(qp[i]) * ATT_SCALE;
        float o[32];
#pragma unroll
        for (int i = 0; i < 32; ++i) o[i] = 0.f;
        float m = -1e30f, l = 0.f;
        for (int k0 = 0; k0 < nkeys; k0 += 32) {
            __syncthreads();
            {
                const bf16_t* kg = K + ((size_t)bh * TK + k0) * 192; const bf16_t* vg = V + ((size_t)bh * TK + k0) * 128;
                for (int c = tid; c < 768; c += NTHR) *(u32x4*)(Ks + c * 8) = *(const u32x4*)(kg + c * 8);
                *(u32x4*)(Vs + tid * 8) = *(const u32x4*)(vg + tid * 8);
            }
            __syncthreads();
#pragma unroll 1
            for (int kg = 0; kg < 32; kg += 8) {
                float s[8]; float tmax = -1e30f;
#pragma unroll
                for (int kk = 0; kk < 8; ++kk) {
                    const bf16_t* kr = Ks + (kg + kk) * 192 + part * 48; float acc = 0.f;
#pragma unroll
                    for (int i = 0; i < 48; ++i) acc += q[i] * bf2f(kr[i]);
                    acc += __shfl_xor(acc, 1); acc += __shfl_xor(acc, 2);
                    s[kk] = acc; tmax = fmaxf(tmax, acc);
                    asm volatile("" ::: "memory");
                }
                const float mn = fmaxf(m, tmax), alpha = expf(m - mn); m = mn; l *= alpha;
#pragma unroll
                for (int i = 0; i < 32; ++i) o[i] *= alpha;
#pragma unroll
                for (int kk = 0; kk < 8; ++kk) {
                    const float pw = expf(s[kk] - mn); l += pw;
                    const bf16_t* vr = Vs + (kg + kk) * 128 + part * 32;
#pragma unroll
                    for (int i = 0; i < 32; ++i) o[i] += pw * bf2f(vr[i]);
                    asm volatile("" ::: "memory");
                }
            }
        }
        const float rl = 1.f / l;
        const int row = qb < 2 ? (NLAT + b * TC + tq) : (b * TL + tq - TC);
        bf16_t* op = O + (size_t)row * D + h * 128 + part * 32;
#pragma unroll
        for (int i = 0; i < 32; ++i) op[i] = f2bf(o[i] * rl);
    }
}


namespace fa {
using s16x4  = __attribute__((ext_vector_type(4))) short;
using f32x16 = __attribute__((ext_vector_type(16))) float;
constexpr int DQK = 192, DV = 128, KVBLK = 64;
constexpr float THR = 8.f;
constexpr int SHM_V = KVBLK * DV * 2, SHM_K = KVBLK * DQK * 2;
constexpr int SHM_ATTN = 2 * SHM_V + 2 * SHM_K + 8 * 64 * 4;
#define KSWZ(row, colB) ((row) * 384 + ((colB) ^ ((((row) >> 1) & 7) << 4)))
#define SBAR() __builtin_amdgcn_sched_barrier(0)
__device__ __forceinline__ int crow(int r, int hi) { return (r & 3) + 8 * (r >> 2) + 4 * hi; }
__device__ __forceinline__ unsigned cvtpk(float lo, float hi) { unsigned r; asm volatile("v_cvt_pk_bf16_f32 %0, %1, %2" : "=v"(r) : "v"(lo), "v"(hi)); return r; }
__device__ __forceinline__ void partialSM(f32x16& p0, f32x16& p1, float& m_reg, float& mn, float& alpha) {
  constexpr float C = ATT_SCALE * 1.4426950408889634f;
  float pmax = p0[0];
#pragma unroll
  for (int r = 1; r < 16; ++r) pmax = fmaxf(pmax, p0[r]);
#pragma unroll
  for (int r = 0; r < 16; ++r) pmax = fmaxf(pmax, p1[r]);
  { auto rr = __builtin_amdgcn_permlane32_swap(__float_as_uint(pmax), __float_as_uint(pmax), false, false);
    pmax = fmaxf(__uint_as_float(rr[0]), __uint_as_float(rr[1])); }
  if (__builtin_expect(__all(pmax - m_reg <= THR / ATT_SCALE), 1)) { mn = m_reg; alpha = 1.f; }
  else { mn = fmaxf(m_reg, pmax); alpha = __builtin_amdgcn_exp2f((m_reg - mn) * C); m_reg = mn; }
  float mnC = -mn * C;
#pragma unroll
  for (int r = 0; r < 16; ++r) p0[r] = fmaf(p0[r], C, mnC);
#pragma unroll
  for (int r = 0; r < 16; ++r) p1[r] = fmaf(p1[r], C, mnC);
#pragma unroll
  for (int r = 0; r < 16; ++r) p0[r] = __builtin_amdgcn_exp2f(p0[r]);
}
__device__ __forceinline__ void finishSM(f32x16& p0, f32x16& p1, float alpha, float& l_reg, bf16x8& pa0, bf16x8& pa1, bf16x8& pa2, bf16x8& pa3) {
#pragma unroll
  for (int r = 0; r < 16; ++r) p1[r] = __builtin_amdgcn_exp2f(p1[r]);
  float ps = 0;
#pragma unroll
  for (int r = 0; r < 16; ++r) ps += p0[r];
#pragma unroll
  for (int r = 0; r < 16; ++r) ps += p1[r];
  { auto rr = __builtin_amdgcn_permlane32_swap(__float_as_uint(ps), __float_as_uint(ps), false, false);
    ps = __uint_as_float(rr[0]) + __uint_as_float(rr[1]); }
  l_reg = l_reg * alpha + ps;
#define PK4(P, BASE, OUT) do { unsigned a0 = cvtpk(P[BASE + 0], P[BASE + 1]), a1 = cvtpk(P[BASE + 2], P[BASE + 3]);   \
    unsigned b0 = cvtpk(P[BASE + 4], P[BASE + 5]), b1 = cvtpk(P[BASE + 6], P[BASE + 7]);                              \
    auto r0 = __builtin_amdgcn_permlane32_swap(a0, b0, false, false); auto r1 = __builtin_amdgcn_permlane32_swap(a1, b1, false, false); \
    u32x4 w = {r0[0], r1[0], r0[1], r1[1]}; OUT = *reinterpret_cast<bf16x8*>(&w); } while (0)
  PK4(p0, 0, pa0); PK4(p0, 8, pa1); PK4(p1, 0, pa2); PK4(p1, 8, pa3);
#undef PK4
}
__device__ __forceinline__ void qkt(f32x16& p0, f32x16& p1, const char* Ks, const bf16x8* qr, int r32, int hi) {
  p0 = f32x16{}; p1 = f32x16{};
  const int swz = ((r32 >> 1) & 7) << 4;
  const char* b4[4];
#pragma unroll
  for (int dr = 0; dr < 4; ++dr) b4[dr] = Ks + r32 * 384 + ((dr * 32 + hi * 16) ^ swz);
#pragma unroll
  for (int d0 = 0; d0 < 12; ++d0) {
    bf16x8 b0 = *reinterpret_cast<const bf16x8*>(b4[d0 & 3] + (d0 >> 2) * 128);
    bf16x8 b1 = *reinterpret_cast<const bf16x8*>(b4[d0 & 3] + (d0 >> 2) * 128 + 32 * 384);
    p0 = __builtin_amdgcn_mfma_f32_32x32x16_bf16(b0, qr[d0], p0, 0, 0, 0);
    p1 = __builtin_amdgcn_mfma_f32_32x32x16_bf16(b1, qr[d0], p1, 0, 0, 0); }
}
__device__ __forceinline__ int v_st(int k, int c) { const int kk = (k & ~0xC) | ((k & 4) << 1) | ((k & 8) >> 1); return ((kk >> 3) * 4 + (c >> 5)) * 512 + ((kk & 7) * 32 + (c & 31)) * 2; }
__device__ __forceinline__ int v_rd_base(int lane) { return ((lane & 3) << 3) | (((lane >> 2) & 3) << 6) | (((lane >> 4) & 1) << 5) | (((lane >> 5) & 1) << 8); }
constexpr int v_rd_off(int d0, int ks, int half) { return d0 * 512 + ks * 4096 + half * 2048; }
template <int OFF> __device__ __forceinline__ s16x4 tr_read(int vb) {
  s16x4 r; asm volatile("ds_read_b64_tr_b16 %0, %1 offset:%2" : "=&v"(r) : "v"(vb), "i"(OFF) : "memory"); return r;
}
template <int D0> __device__ __forceinline__ void pv_one(f32x16& od, int vb, bf16x8 pa0, bf16x8 pa1, bf16x8 pa2, bf16x8 pa3) {
  const s16x4 l0 = tr_read<v_rd_off(D0, 0, 0)>(vb), h0 = tr_read<v_rd_off(D0, 0, 1)>(vb), l1 = tr_read<v_rd_off(D0, 1, 0)>(vb), h1 = tr_read<v_rd_off(D0, 1, 1)>(vb);
  const s16x4 l2 = tr_read<v_rd_off(D0, 2, 0)>(vb), h2 = tr_read<v_rd_off(D0, 2, 1)>(vb), l3 = tr_read<v_rd_off(D0, 3, 0)>(vb), h3 = tr_read<v_rd_off(D0, 3, 1)>(vb);
  asm volatile("s_waitcnt lgkmcnt(0)" ::: "memory"); SBAR();
#define PK(L, H) (bf16x8){L[0], L[1], L[2], L[3], H[0], H[1], H[2], H[3]}
  od = __builtin_amdgcn_mfma_f32_32x32x16_bf16(pa0, PK(l0, h0), od, 0, 0, 0);
  od = __builtin_amdgcn_mfma_f32_32x32x16_bf16(pa1, PK(l1, h1), od, 0, 0, 0);
  od = __builtin_amdgcn_mfma_f32_32x32x16_bf16(pa2, PK(l2, h2), od, 0, 0, 0);
  od = __builtin_amdgcn_mfma_f32_32x32x16_bf16(pa3, PK(l3, h3), od, 0, 0, 0);
#undef PK
}
__device__ __forceinline__ void pv_d0(f32x16* o, int vb, bf16x8 pa0, bf16x8 pa1, bf16x8 pa2, bf16x8 pa3) {
  pv_one<0>(o[0], vb, pa0, pa1, pa2, pa3); pv_one<1>(o[1], vb, pa0, pa1, pa2, pa3); pv_one<2>(o[2], vb, pa0, pa1, pa2, pa3); pv_one<3>(o[3], vb, pa0, pa1, pa2, pa3);
}
__device__ __forceinline__ void attn_body(const int wv_, const bf16_t* __restrict__ Qb, const bf16_t* __restrict__ Kh, const bf16_t* __restrict__ Vh, bf16_t* __restrict__ Ob, int ldo, int seq, char* lds, const float* __restrict__ ropecs  ) {
  const int tid = tidx_w(wv_), wid = tid >> 6, lane = tid & 63, r32 = lane & 31, hi = lane >> 5;
  char* V_lds = lds; char* K_lds = lds + 2 * SHM_V;
  float* ws = (float*)(lds + 2 * SHM_V + 2 * SHM_K) + wid * 64; float* li_l = ws; float* al_l = ws + 32;
  float m_reg = -1e30f, l_reg = 0; f32x16 o[4] = {}; bf16x8 qr[12];
  const bf16_t* Qw = Qb + (long)(wid * 32 + r32) * DQK + hi * 8;
#pragma unroll
  for (int d0 = 0; d0 < 12; ++d0) qr[d0] = *reinterpret_cast<const bf16x8*>(Qw + d0 * 16);
  if (ropecs) {
    const float* cs = ropecs + (size_t)(wid * 32 + r32) * 64;
#pragma unroll
    for (int d0 = 8; d0 < 12; ++d0) { const int i0 = (d0 - 8) * 8 + hi * 4; const f32x4 c0 = *(const f32x4*)(cs + i0 * 2), c1 = *(const f32x4*)(cs + i0 * 2 + 4);
      u32x4 w = *reinterpret_cast<u32x4*>(&qr[d0]); const float cc[4] = {c0[0], c0[2], c1[0], c1[2]}, ss[4] = {c0[1], c0[3], c1[1], c1[3]};
#pragma unroll
      for (int m = 0; m < 4; ++m) { const float x1 = __uint_as_float(w[m] << 16), x2 = __uint_as_float(w[m] & 0xffff0000u); w[m] = cvtpk(x1 * cc[m] - x2 * ss[m], x1 * ss[m] + x2 * cc[m]); }
      qr[d0] = *reinterpret_cast<bf16x8*>(&w); }
  }
  const int sr = tid >> 4, sc = (tid & 15) * 8, vst0 = v_st(sr, sc), vst1 = v_st(32 + sr, sc);
  int kst[3];
#pragma unroll
  for (int i = 0; i < 3; ++i) { const int c = tid + 512 * i, row = c / 24, cc = c % 24; kst[i] = KSWZ(row, cc * 16); }
  const int vb0 = (int)(uintptr_t)V_lds + v_rd_base(lane);
  struct { bf16x8 vs0, vs1, ks0, ks1, ks2; } sr_[1];
#define SLOAD(i, k0) do { const bf16_t* vt = Vh + (long)(k0) * DV; const bf16_t* kt = Kh + (long)(k0) * DQK; \
    sr_[i].vs0 = *reinterpret_cast<const bf16x8*>(vt + (sr) * DV + sc); sr_[i].vs1 = *reinterpret_cast<const bf16x8*>(vt + (32 + sr) * DV + sc); \
    sr_[i].ks0 = *reinterpret_cast<const bf16x8*>(kt + tid * 8); sr_[i].ks1 = *reinterpret_cast<const bf16x8*>(kt + (tid + 512) * 8); sr_[i].ks2 = *reinterpret_cast<const bf16x8*>(kt + (tid + 1024) * 8); } while (0)
#define SWRITE(b, i) do { *(bf16x8*)(V_lds + (b) * SHM_V + vst0) = sr_[i].vs0; *(bf16x8*)(V_lds + (b) * SHM_V + vst1) = sr_[i].vs1; \
    *(bf16x8*)(K_lds + (b) * SHM_K + kst[0]) = sr_[i].ks0; *(bf16x8*)(K_lds + (b) * SHM_K + kst[1]) = sr_[i].ks1; *(bf16x8*)(K_lds + (b) * SHM_K + kst[2]) = sr_[i].ks2; } while (0)
#define SWAIT() asm volatile("s_waitcnt vmcnt(5)" ::: "memory")
#define RESC(a) do { if (__any((a) < 1.f)) { if (hi == 0) al_l[r32] = (a); asm volatile("s_waitcnt lgkmcnt(0)" ::: "memory"); \
    _Pragma("unroll") for (int d = 0; d < 4; ++d) _Pragma("unroll") for (int r = 0; r < 16; ++r) o[d][r] *= al_l[crow(r, hi)]; } } while (0)
  f32x16 pA0, pA1; float mnA, alA; bf16x8 pa0, pa1, pa2, pa3; const int NT = seq / KVBLK;
  SLOAD(0, 0); SWRITE(0, 0);
  SLOAD(0, KVBLK);
  __syncthreads();
  for (int j = 0; j < NT; j += 2) {
    SBAR(); qkt(pA0, pA1, K_lds, qr, r32, hi);
    partialSM(pA0, pA1, m_reg, mnA, alA); RESC(alA);
    finishSM(pA0, pA1, alA, l_reg, pa0, pa1, pa2, pa3); SBAR();
    SWRITE(1, 0);
    if (j + 2 < NT) SLOAD(0, (j + 2) * KVBLK);
    SBAR();
    pv_d0(o, vb0, pa0, pa1, pa2, pa3);
    __syncthreads();
    SBAR(); qkt(pA0, pA1, K_lds + SHM_K, qr, r32, hi);
    partialSM(pA0, pA1, m_reg, mnA, alA); RESC(alA);
    finishSM(pA0, pA1, alA, l_reg, pa0, pa1, pa2, pa3); SBAR();
    if (j + 2 < NT) { SWRITE(0, 0); if (j + 3 < NT) SLOAD(0, (j + 3) * KVBLK); }
    SBAR();
    pv_d0(o, vb0 + SHM_V, pa0, pa1, pa2, pa3);
    __syncthreads();
  }
  if (hi == 0) li_l[r32] = l_reg; asm volatile("s_waitcnt lgkmcnt(0)" ::: "memory");
  float rli[16];
#pragma unroll
  for (int r = 0; r < 16; ++r) rli[r] = __builtin_amdgcn_rcpf(li_l[crow(r, hi)]);
  bf16_t* Ow = Ob + (long)(wid * 32) * ldo;
#pragma unroll
  for (int r = 0; r < 16; ++r) { int orow = crow(r, hi);
#pragma unroll
    for (int d0 = 0; d0 < 4; ++d0) Ow[(long)orow * ldo + d0 * 32 + r32] = f2bf(o[d0][r] * rli[r]); }
  __syncthreads();
#undef SLOAD
#undef SWRITE
#undef SWAIT
#undef RESC
}
#undef KSWZ
}

__device__ void ph_attn(const Params& p, char* lds) {
    const bf16_t* Q = (const bf16_t*)(p.ws + OFF_Q); const bf16_t* K = (const bf16_t*)(p.ws + OFF_K); const bf16_t* V = (const bf16_t*)(p.ws + OFF_V);
    bf16_t* O = (bf16_t*)(p.ws + OFF_O);
    const int G = gdim();
    for (int i = 0;; ++i) {
        const int L = i * G + bidx(); if (L >= 544) break;
        int bh, qb;
        if (L < 512) { const int w = g8::xcd_remap(L, 512); bh = w >> 4; qb = 1 + (w & 15); } else { bh = L - 512; qb = 0; }
        const int b = bh >> 3, h = bh & 7;
        const int seq = qb == 0 ? TC : TK;
        const int row0 = qb == 0 ? NLAT + b * TC : b * TL + (qb - 1) * 256;
        fa::attn_body(p.wv, Q + ((size_t)bh * TK + qb * 256) * 192, K + (size_t)bh * TK * 192, V + (size_t)bh * TK * 128, O + (size_t)row0 * D + h * 128, D, seq, lds,
                      qb == 0 ? nullptr : (const float*)(p.ws + OFF_ROPE_C) + (size_t)(qb - 1) * 256 * 64);
    }
}

__device__ void ph_norm2_router(const Params& p, int layer, char* lds, int nrows) {
    const int tid = tidx(), wid = tid >> 6, lane = tid & 63;
    float* rt = (float*)lds;
    const float* rg = p.moe_router + (size_t)layer * D * NE;
    for (int i = tid; i < D * NE / 4; i += NTHR) { const int d = i >> 2, eq = i & 3; ((float4*)rt)[(((d >> 8) * 4 + (d & 3)) * 4 + eq) * 64 + ((d & 255) >> 2)] = ((const float4*)rg)[i]; }
    __syncthreads();
    const xt_t* X = (const xt_t*)(p.ws + OFF_X); bf16_t* BN = (bf16_t*)(p.ws + OFF_H); float* AFF = (float*)(p.ws + OFF_AFF);
    const float* g = p.norm2_g + layer * D;
    const int w_ = bidx() * 8 + wid, nw_ = gdim() * 8;
    int row = (int)((long long)w_ * nrows / nw_); const int rend = (int)((long long)(w_ + 1) * nrows / nw_);
    float4 nv[4], gm[4], bb[4]; int scur = -1;
    if (row < rend) {
#pragma unroll
        for (int i = 0; i < 4; ++i) nv[i] = xld(X, (size_t)row * D + (lane + i * 64) * 4); }
    for (; row < rend; ++row) {
        const int s = row_stream(row);
        if (s != scur) { scur = s; const float* sh = modp(p, layer, s, 3); const float* sc = modp(p, layer, s, 4);
#pragma unroll
            for (int i = 0; i < 4; ++i) { const int d = (lane + i * 64) * 4; const float4 gg = *(const float4*)(g + d), a = *(const float4*)(sc + d); bb[i] = *(const float4*)(sh + d);
                gm[i] = make_float4(gg.x * (1.f + a.x), gg.y * (1.f + a.y), gg.z * (1.f + a.z), gg.w * (1.f + a.w)); } }
        float4 v[4]; float ss = 0;
#pragma unroll
        for (int i = 0; i < 4; ++i) { v[i] = nv[i]; ss += v[i].x * v[i].x + v[i].y * v[i].y + v[i].z * v[i].z + v[i].w * v[i].w; }
        { const int nrow = row + 1;
          if (nrow < rend) {
#pragma unroll
              for (int i = 0; i < 4; ++i) nv[i] = xld(X, (size_t)nrow * D + (lane + i * 64) * 4); } }
        ss = wave_sum(ss); const float rs = rsqrtf(ss * (1.f / D) + RMS_EPS);
        float lg[16];
#pragma unroll
        for (int e = 0; e < 16; ++e) lg[e] = 0.f;
#pragma unroll
        for (int i = 0; i < 4; ++i) {
            const int d = (lane + i * 64) * 4;
            float o[4]; o[0] = v[i].x * rs * gm[i].x + bb[i].x; o[1] = v[i].y * rs * gm[i].y + bb[i].y; o[2] = v[i].z * rs * gm[i].z + bb[i].z; o[3] = v[i].w * rs * gm[i].w + bb[i].w;
            uint2 w; w.x = pk2(o[0], o[1]); w.y = pk2(o[2], o[3]); *(uint2*)(BN + (size_t)row * D + d) = w;
#pragma unroll
            for (int jj = 0; jj < 4; ++jj) {
#pragma unroll
                for (int eq = 0; eq < 4; ++eq) { const float4 r4 = ((const float4*)rt)[((i * 4 + jj) * 4 + eq) * 64 + lane];
                    lg[4 * eq] += o[jj] * r4.x; lg[4 * eq + 1] += o[jj] * r4.y; lg[4 * eq + 2] += o[jj] * r4.z; lg[4 * eq + 3] += o[jj] * r4.w; } }
            asm volatile("" ::: "memory");
        }
        float mx = -1e30f;
#pragma unroll
        for (int e = 0; e < 16; ++e) { lg[e] = wave_sum(lg[e]); mx = fmaxf(mx, lg[e]); }
        float sum = 0;
#pragma unroll
        for (int e = 0; e < 16; ++e) { lg[e] = expf(lg[e] - mx); sum += lg[e]; }
        const float inv = 1.f / sum;
        if (lane < 16) { float val = 0;
#pragma unroll
            for (int e = 0; e < 16; ++e) val = (lane == e) ? lg[e] : val;
            AFF[(size_t)row * 16 + lane] = val * inv; }
    }
}

__device__ void ph_norm2_router_mm(const Params& p, int layer, char* lds, int nrows) {
    typedef __attribute__((address_space(3))) char lch;
    constexpr int PB = 2064;
    constexpr int O_RH = 0, O_RL = 16 * PB, O_A = 32 * PB, A_BUF = 16 * PB, O_P = O_A + 2 * A_BUF, P_BUF = 8 * 8 * 16 * 4;
    const int tid = tidx(), wid = __builtin_amdgcn_readfirstlane(tid >> 6), lane = tid & 63;
    lch* L = (lch*)lds;
    const float* rg = p.moe_router + (size_t)layer * D * NE;
    for (int i = tid; i < D * NE / 4; i += NTHR) { const int d = i >> 2, eq = i & 3; const float4 r4 = ((const float4*)rg)[i]; const float rr[4] = {r4.x, r4.y, r4.z, r4.w};
#pragma unroll
        for (int u = 0; u < 4; ++u) { const unsigned h = pk2(rr[u], rr[u]) & 0xffffu; const float lo = rr[u] - __uint_as_float(h << 16);
            *(LAS bf16_t*)(L + O_RH + (4 * eq + u) * PB + d * 2) = (bf16_t)h; *(LAS bf16_t*)(L + O_RL + (4 * eq + u) * PB + d * 2) = f2bf(lo); } }
    const xt_t* X = (const xt_t*)(p.ws + OFF_X); bf16_t* BN = (bf16_t*)(p.ws + OFF_H); float* AFF = (float*)(p.ws + OFF_AFF);
    const float* g = p.norm2_g + layer * D;
    const int nch = nrows / 8;
    int ch = (int)((long long)bidx() * nch / gdim()); const int chend = (int)((long long)(bidx() + 1) * nch / gdim());
    float4 nv[4], gm[4], bb[4]; int scur = -1;
    if (ch < chend) {
#pragma unroll
        for (int i = 0; i < 4; ++i) nv[i] = xld(X, (size_t)(ch * 8 + wid) * D + (lane + i * 64) * 4); }
    for (int it = 0; ch < chend; ++ch, ++it) {
        const int row = ch * 8 + wid, buf = it & 1;
        const int s = row_stream(row);
        if (s != scur) { scur = s; const float* sh = modp(p, layer, s, 3); const float* sc = modp(p, layer, s, 4);
#pragma unroll
            for (int i = 0; i < 4; ++i) { const int d = (lane + i * 64) * 4; const float4 gg = *(const float4*)(g + d), a = *(const float4*)(sc + d); bb[i] = *(const float4*)(sh + d);
                gm[i] = make_float4(gg.x * (1.f + a.x), gg.y * (1.f + a.y), gg.z * (1.f + a.z), gg.w * (1.f + a.w)); } }
        float4 v[4]; float ss = 0;
#pragma unroll
        for (int i = 0; i < 4; ++i) { v[i] = nv[i]; ss += v[i].x * v[i].x + v[i].y * v[i].y + v[i].z * v[i].z + v[i].w * v[i].w; }
        if (ch + 1 < chend) {
#pragma unroll
            for (int i = 0; i < 4; ++i) nv[i] = xld(X, (size_t)(row + 8) * D + (lane + i * 64) * 4); }
        ss = wave_sum(ss); const float rs = rsqrtf(ss * (1.f / D) + RMS_EPS);
        lch* AH = L + O_A + buf * A_BUF + wid * PB; lch* AL = AH + 8 * PB;
#pragma unroll
        for (int i = 0; i < 4; ++i) {
            const int d = (lane + i * 64) * 4;
            float o[4]; o[0] = v[i].x * rs * gm[i].x + bb[i].x; o[1] = v[i].y * rs * gm[i].y + bb[i].y; o[2] = v[i].z * rs * gm[i].z + bb[i].z; o[3] = v[i].w * rs * gm[i].w + bb[i].w;
            u32x2 wh; wh.x = pk2(o[0], o[1]); wh.y = pk2(o[2], o[3]);
            uint2 wg_; wg_.x = wh.x; wg_.y = wh.y; *(uint2*)(BN + (size_t)row * D + d) = wg_;
            u32x2 wl; wl.x = pk2(o[0] - __uint_as_float(wh.x << 16), o[1] - __uint_as_float(wh.x & 0xffff0000u)); wl.y = pk2(o[2] - __uint_as_float(wh.y << 16), o[3] - __uint_as_float(wh.y & 0xffff0000u));
            *(LAS u32x2*)(AH + d * 2) = wh; *(LAS u32x2*)(AL + d * 2) = wl;
        }
        __syncthreads();
        {
            f32x4 acc = {0.f, 0.f, 0.f, 0.f};
            const lch* ah = L + O_A + buf * A_BUF + (lane & 7) * PB + (128 * wid + 8 * (lane >> 4)) * 2;
            const lch* bh = L + O_RH + (lane & 15) * PB + (128 * wid + 8 * (lane >> 4)) * 2;
#pragma unroll
            for (int ks = 0; ks < 4; ++ks) {
                const bf16x8 a_h = *(const LAS bf16x8*)(ah + ks * 64), a_l = *(const LAS bf16x8*)(ah + 8 * PB + ks * 64);
                const bf16x8 b_h = *(const LAS bf16x8*)(bh + ks * 64), b_l = *(const LAS bf16x8*)(bh + 16 * PB + ks * 64);
                acc = __builtin_amdgcn_mfma_f32_16x16x32_bf16(a_h, b_h, acc, 0, 0, 0);
                acc = __builtin_amdgcn_mfma_f32_16x16x32_bf16(a_h, b_l, acc, 0, 0, 0);
                acc = __builtin_amdgcn_mfma_f32_16x16x32_bf16(a_l, b_h, acc, 0, 0, 0);
            }
            if (lane < 32) {
#pragma unroll
                for (int e = 0; e < 4; ++e) *(LAS float*)(L + O_P + buf * P_BUF + ((wid * 8 + 4 * (lane >> 4) + e) * 16 + (lane & 15)) * 4) = acc[e]; }
        }
        __syncthreads();
        if (tid < 128) {
            float lg = 0.f;
#pragma unroll
            for (int w8 = 0; w8 < 8; ++w8) lg += *(const LAS float*)(L + O_P + buf * P_BUF + (w8 * 128 + tid) * 4);
            float mx = lg;
            mx = fmaxf(mx, __builtin_bit_cast(float, __builtin_amdgcn_update_dpp(0, __builtin_bit_cast(int, mx), 0xB1, 0xF, 0xF, true)));
            mx = fmaxf(mx, __builtin_bit_cast(float, __builtin_amdgcn_update_dpp(0, __builtin_bit_cast(int, mx), 0x4E, 0xF, 0xF, true)));
            mx = fmaxf(mx, __builtin_bit_cast(float, __builtin_amdgcn_update_dpp(0, __builtin_bit_cast(int, mx), 0x141, 0xF, 0xF, true)));
            mx = fmaxf(mx, __builtin_bit_cast(float, __builtin_amdgcn_update_dpp(0, __builtin_bit_cast(int, mx), 0x140, 0xF, 0xF, true)));
            const float ex = expf(lg - mx); const float sum = dpp_sum16(ex);
            AFF[(size_t)(ch * 8) * 16 + tid] = ex / sum;
        }
    }
}

__device__ void ph_select(const Params& p, char* lds, int ngroups) {
    const int tid = tidx(), wid = tid >> 6, lane = tid & 63;
    unsigned* hist = (unsigned*)lds;
    unsigned* ctl = hist + 256;
    unsigned* wsum = ctl + 8;
    int* rowl = (int*)(wsum + 16);
    const float* AFF = (const float*)(p.ws + OFF_AFF);
    int* ROWIDX = (int*)(p.ws + OFF_ROWIDX); float* GATE = (float*)(p.ws + OFF_GATE); int* SLOT = (int*)(p.ws + OFF_SLOT);
    for (int gidx = bidx(); gidx < ngroups; gidx += gdim()) {
        const bool lat = gidx < 64; const int b = (gidx & 63) >> 4, e = gidx & 15;
        const int n = lat ? TL : TC, cap = lat ? CAPL : CAPC;
        const int row0 = lat ? b * TL : NLAT + b * TC, slot0 = lat ? b * CAPL : NB * CAPL + b * CAPC;
        unsigned key[8];
#pragma unroll
        for (int i = 0; i < 8; ++i) { const int idx = tid * 8 + i; key[i] = idx < n ? __float_as_uint(AFF[(size_t)(row0 + idx) * 16 + e]) : 0u; }
        unsigned prefix = 0u, remaining = (unsigned)cap;
#pragma unroll
        for (int pass = 0; pass < 4; ++pass) {
            const int sh = 24 - 8 * pass;
            __syncthreads();
            if (tid < 256) hist[tid] = 0u;
            __syncthreads();
#pragma unroll
            for (int i = 0; i < 8; ++i) { const int idx = tid * 8 + i;
                const bool cand = idx < n && (pass == 0 || (key[i] >> (sh + 8)) == prefix);
                if (cand) atomicAdd(&hist[(key[i] >> sh) & 255u], 1u); }
            __syncthreads();
            if (tid < 256) { unsigned gt = 0; for (int jj = tid + 1; jj < 256; ++jj) gt += hist[jj];
                const unsigned mine = hist[tid];
                if (gt < remaining && remaining <= gt + mine) { ctl[0] = (unsigned)tid; ctl[1] = remaining - gt; } }
            __syncthreads();
            prefix = (prefix << 8) | ctl[0]; remaining = ctl[1];
        }
        const unsigned T = prefix, m = remaining;
        unsigned cgt = 0, ceq = 0;
#pragma unroll
        for (int i = 0; i < 8; ++i) { const int idx = tid * 8 + i; if (idx < n) { cgt += key[i] > T ? 1u : 0u; ceq += key[i] == T ? 1u : 0u; } }
        auto block_excl = [&](unsigned v) -> unsigned {
            unsigned inc = v;
#pragma unroll
            for (int o = 1; o < 64; o <<= 1) { const unsigned t = (unsigned)__builtin_amdgcn_ds_bpermute((lane - o) << 2, (int)inc); if (lane >= o) inc += t; }
            __syncthreads();
            if (lane == 63) wsum[wid] = inc;
            __syncthreads();
            unsigned base = 0;
#pragma unroll
            for (int w = 0; w < 8; ++w) base += (w < wid) ? wsum[w] : 0u;
            return base + inc - v; };
        unsigned eqbase = block_excl(ceq);
        unsigned nsel = 0; bool sel[8];
#pragma unroll
        for (int i = 0; i < 8; ++i) { const int idx = tid * 8 + i; bool s_ = false;
            if (idx < n) { if (key[i] > T) s_ = true; else if (key[i] == T) { s_ = eqbase < m; ++eqbase; } }
            sel[i] = s_; nsel += s_ ? 1u : 0u; }
        unsigned sbase = block_excl(nsel);
#pragma unroll
        for (int i = 0; i < 8; ++i) { const int idx = tid * 8 + i;
            if (idx < n) {
                if (sel[i]) { const int sl = slot0 + (int)sbase; rowl[sbase] = row0 + idx; ++sbase; ROWIDX[e * ESLOTS + sl] = row0 + idx; GATE[e * EPAD + sl] = __uint_as_float(key[i]); SLOT[(size_t)(row0 + idx) * 16 + e] = sl; }
                else SLOT[(size_t)(row0 + idx) * 16 + e] = -1; } }
        __syncthreads();
        { const bf16_t* BN = (const bf16_t*)(p.ws + OFF_H); bf16_t* XE = (bf16_t*)(p.ws + OFF_XE);
          for (int r = wid; r < cap; r += 32) {
              u32x4 t_[4][2];
#pragma unroll
              for (int u = 0; u < 4; ++u) { const u32x4* src = (const u32x4*)(BN + (size_t)rowl[r + 8 * u] * D); t_[u][0] = src[lane]; t_[u][1] = src[lane + 64]; }
#pragma unroll
              for (int u = 0; u < 4; ++u) { u32x4* dst = (u32x4*)(XE + ((size_t)e * EPAD + slot0 + r + 8 * u) * D); dst[lane] = t_[u][0]; dst[lane + 64] = t_[u][1]; } } }
    }
}

__device__ void ph_gather(const Params& p, int nslots) {
    const int wid = tidx() >> 6, lane = tidx() & 63;
    const int* ROWIDX = (const int*)(p.ws + OFF_ROWIDX); const bf16_t* BN = (const bf16_t*)(p.ws + OFF_H); bf16_t* XE = (bf16_t*)(p.ws + OFF_XE);
    for (int it = bidx() * 8 + wid; it < NE * ESLOTS; it += gdim() * 8) {
        const int e = it / ESLOTS, sl = it % ESLOTS; if (sl >= nslots) continue; const int row = ROWIDX[it];
        const u32x4* src = (const u32x4*)(BN + (size_t)row * D); u32x4* dst = (u32x4*)(XE + ((size_t)e * EPAD + sl) * D);
        dst[lane] = src[lane]; dst[lane + 64] = src[lane + 64];
    }
}

__device__ void ph_combine(const Params& p, int layer, int nrows) {
    const int wid = tidx() >> 6, lane = tidx() & 63;
    const int* SLOT = (const int*)(p.ws + OFF_SLOT); const bf16_t* YE = (const bf16_t*)(p.ws + OFF_YE); xt_t* X = (xt_t*)(p.ws + OFF_X);
    int row = bidx() * 8 + wid;
    int sl = (row < nrows && lane < 16) ? SLOT[(size_t)row * 16 + lane] : -1;
    while (row < nrows) {
        const int nrow = row + gdim() * 8;
        const int sln = (nrow < nrows && lane < 16) ? SLOT[(size_t)nrow * 16 + lane] : -1;
        const float* gt = modp(p, layer, row_stream(row), 5);
        xt_t* xr = X + (size_t)row * D + lane * 8;
        f32x4 xv[4];
#pragma unroll
        for (int i = 0; i < 2; ++i) { xv[2 * i] = xldv(xr, 512 * i); xv[2 * i + 1] = xldv(xr, 512 * i + 4); }
        unsigned long long m = __ballot(sl >= 0);
        float acc[16];
#pragma unroll
        for (int i = 0; i < 16; ++i) acc[i] = 0.f;
        while (m) {
            const int e0 = __builtin_ctzll(m); m &= m - 1; const bool two = m != 0; const int e1 = two ? __builtin_ctzll(m) : e0; if (two) m &= m - 1;
            const int s0 = __builtin_amdgcn_readlane(sl, e0), s1 = __builtin_amdgcn_readlane(sl, e1);
            const bf16_t* y0 = YE + ((size_t)e0 * EPAD + s0) * D + lane * 8; const bf16_t* y1 = YE + ((size_t)e1 * EPAD + s1) * D + lane * 8;
            const u32x4 a0 = *(const u32x4*)y0, a1 = *(const u32x4*)(y0 + 512), b0 = *(const u32x4*)y1, b1 = *(const u32x4*)(y1 + 512);
            const float f1 = two ? 1.f : 0.f;
#pragma unroll
            for (int i = 0; i < 4; ++i) { acc[2 * i] += __uint_as_float(a0[i] << 16) + f1 * __uint_as_float(b0[i] << 16); acc[2 * i + 1] += __uint_as_float(a0[i] & 0xffff0000u) + f1 * __uint_as_float(b0[i] & 0xffff0000u);
                acc[8 + 2 * i] += __uint_as_float(a1[i] << 16) + f1 * __uint_as_float(b1[i] << 16); acc[8 + 2 * i + 1] += __uint_as_float(a1[i] & 0xffff0000u) + f1 * __uint_as_float(b1[i] & 0xffff0000u); }
        }
#pragma unroll
        for (int i = 0; i < 2; ++i) { const f32x4 g0 = *(const f32x4*)(gt + lane * 8 + 512 * i), g1 = *(const f32x4*)(gt + lane * 8 + 512 * i + 4);
            f32x4 o0 = xv[2 * i], o1 = xv[2 * i + 1];
#pragma unroll
            for (int e = 0; e < 4; ++e) { o0[e] += g0[e] * acc[8 * i + e]; o1[e] += g1[e] * acc[8 * i + 4 + e]; }
            xstv(xr, 512 * i, o0); xstv(xr, 512 * i + 4, o1); }
        row = nrow; sl = sln;
    }
}

template <bool FINAL>
__device__ void ph_comb_norm(const Params& p, int lprev, int layer, int nrows) {
    const int wid = tidx() >> 6, lane = tidx() & 63;
    const int* SLOT = (const int*)(p.ws + OFF_SLOT); const bf16_t* YE = (const bf16_t*)(p.ws + OFF_YE); xt_t* X = (xt_t*)(p.ws + OFF_X);
    bf16_t* H = (bf16_t*)(p.ws + OFF_H);
    const float* g = FINAL ? p.final_g : p.norm1_g + layer * D;
    int row = bidx() * 8 + wid;
    int sl = (row < nrows && lane < 16) ? SLOT[(size_t)row * 16 + lane] : -1;
    while (row < nrows) {
        const int nrow = row + gdim() * 8;
        const int sln = (nrow < nrows && lane < 16) ? SLOT[(size_t)nrow * 16 + lane] : -1;
        const int strm = row_stream(row);
        const float* gt = modp(p, lprev, strm, 5);
        xt_t* xr = X + (size_t)row * D + lane * 8;
        f32x4 xv[4];
#pragma unroll
        for (int i = 0; i < 2; ++i) { xv[2 * i] = xldv(xr, 512 * i); xv[2 * i + 1] = xldv(xr, 512 * i + 4); }
        unsigned long long m = __ballot(sl >= 0);
        float acc[16];
#pragma unroll
        for (int i = 0; i < 16; ++i) acc[i] = 0.f;
        while (m) {
            const int e0 = __builtin_ctzll(m); m &= m - 1; const bool two = m != 0; const int e1 = two ? __builtin_ctzll(m) : e0; if (two) m &= m - 1;
            const int s0 = __builtin_amdgcn_readlane(sl, e0), s1 = __builtin_amdgcn_readlane(sl, e1);
            const bf16_t* y0 = YE + ((size_t)e0 * EPAD + s0) * D + lane * 8; const bf16_t* y1 = YE + ((size_t)e1 * EPAD + s1) * D + lane * 8;
            const u32x4 a0 = *(const u32x4*)y0, a1 = *(const u32x4*)(y0 + 512), b0 = *(const u32x4*)y1, b1 = *(const u32x4*)(y1 + 512);
            const float f1 = two ? 1.f : 0.f;
#pragma unroll
            for (int i = 0; i < 4; ++i) { acc[2 * i] += __uint_as_float(a0[i] << 16) + f1 * __uint_as_float(b0[i] << 16); acc[2 * i + 1] += __uint_as_float(a0[i] & 0xffff0000u) + f1 * __uint_as_float(b0[i] & 0xffff0000u);
                acc[8 + 2 * i] += __uint_as_float(a1[i] << 16) + f1 * __uint_as_float(b1[i] << 16); acc[8 + 2 * i + 1] += __uint_as_float(a1[i] & 0xffff0000u) + f1 * __uint_as_float(b1[i] & 0xffff0000u); }
        }
        float ss = 0.f;
#pragma unroll
        for (int i = 0; i < 2; ++i) { const f32x4 g0 = *(const f32x4*)(gt + lane * 8 + 512 * i), g1 = *(const f32x4*)(gt + lane * 8 + 512 * i + 4);
#pragma unroll
            for (int e = 0; e < 4; ++e) { xv[2 * i][e] += g0[e] * acc[8 * i + e]; xv[2 * i + 1][e] += g1[e] * acc[8 * i + 4 + e]; ss += xv[2 * i][e] * xv[2 * i][e] + xv[2 * i + 1][e] * xv[2 * i + 1][e]; }
            if (!FINAL) { xstv(xr, 512 * i, xv[2 * i]); xstv(xr, 512 * i + 4, xv[2 * i + 1]); } }
        ss = wave_sum(ss); const float rs = rsqrtf(ss * (1.f / D) + RMS_EPS);
        const float* sh = FINAL ? nullptr : modp(p, layer, strm, 0); const float* sc = FINAL ? nullptr : modp(p, layer, strm, 1);
#pragma unroll
        for (int i = 0; i < 2; ++i)
#pragma unroll
            for (int hh = 0; hh < 2; ++hh) { const int d = lane * 8 + 512 * i + 4 * hh; const f32x4 gg = *(const f32x4*)(g + d); f32x4 o = xv[2 * i + hh] * rs * gg;
                if (FINAL) *(f32x4*)(p.out + (size_t)row * D + d) = o;
                else { o = o * (1.f + *(const f32x4*)(sc + d)) + *(const f32x4*)(sh + d); stbf4(H + (size_t)row * D + d, o); } }
        row = nrow; sl = sln;
    }
}

__device__ void ph_rw_normxs(const Params& p, int layer, int j) {
    const int wid = tidx() >> 6, lane = tidx() & 63;
    const xt_t* X = (const xt_t*)(p.ws + OFF_X); bf16_t* XS = (bf16_t*)(p.ws + OFF_XS);
    const float* mu = p.rw_mu + (size_t)j * 6 * D; const float* g = p.norm1_g + layer * D;
    const int w = bidx() * 8 + wid, nw = gdim() * 8;
    const int r0 = (int)((long long)w * NROW / nw), r1 = (int)((long long)(w + 1) * NROW / nw);
    if (r0 >= r1) return;
    float4 um[6][4];
#pragma unroll
    for (int m = 0; m < 6; ++m)
#pragma unroll
        for (int i = 0; i < 4; ++i) um[m][i] = *(const float4*)(mu + m * D + (lane + i * 64) * 4);
    float4 gm[4], bb[4]; int scur = -1;
    float4 hp[4], hc[4], hn[4], raw[4];
#define XS_NORM(dst, src, R) do { const int s_ = row_stream(R); \
        if (s_ != scur) { scur = s_; const float* sh_ = modp(p, layer, s_, 0); const float* sc_ = modp(p, layer, s_, 1); \
            _Pragma("unroll") for (int i = 0; i < 4; ++i) { const int d_ = (lane + i * 64) * 4; const float4 gg_ = *(const float4*)(g + d_), a_ = *(const float4*)(sc_ + d_); bb[i] = *(const float4*)(sh_ + d_); \
                gm[i] = make_float4(gg_.x * (1.f + a_.x), gg_.y * (1.f + a_.y), gg_.z * (1.f + a_.z), gg_.w * (1.f + a_.w)); } } \
        float ss_ = 0.f; \
        _Pragma("unroll") for (int i = 0; i < 4; ++i) ss_ += src[i].x * src[i].x + src[i].y * src[i].y + src[i].z * src[i].z + src[i].w * src[i].w; \
        ss_ = wave_sum(ss_); const float rs_ = rsqrtf(ss_ * (1.f / D) + RMS_EPS); \
        _Pragma("unroll") for (int i = 0; i < 4; ++i) dst[i] = make_float4(src[i].x * rs_ * gm[i].x + bb[i].x, src[i].y * rs_ * gm[i].y + bb[i].y, src[i].z * rs_ * gm[i].z + bb[i].z, src[i].w * rs_ * gm[i].w + bb[i].w); } while (0)
#define XS_RAW(R) do { _Pragma("unroll") for (int i = 0; i < 4; ++i) raw[i] = xld(X, (size_t)(R) * D + (lane + i * 64) * 4); } while (0)
    if (r0 > 0) { XS_RAW(r0 - 1); XS_NORM(hp, raw, r0 - 1); }
    else {
#pragma unroll
        for (int i = 0; i < 4; ++i) hp[i] = make_float4(0.f, 0.f, 0.f, 0.f); }
    XS_RAW(r0); XS_NORM(hc, raw, r0);
    if (r0 + 1 < NROW) XS_RAW(r0 + 1);
    for (int row = r0; row < r1; ++row) {
        const bool lat = row < NLAT; const int t = lat ? (row & (TL - 1)) : ((row - NLAT) & (TC - 1)); const int len = lat ? TL : TC;
        const float fp_ = t > 0 ? 0.5f : 0.f, fn_ = t < len - 1 ? 0.5f : 0.f;
        if (row + 1 < NROW) XS_NORM(hn, raw, row + 1);
        else {
#pragma unroll
            for (int i = 0; i < 4; ++i) hn[i] = make_float4(0.f, 0.f, 0.f, 0.f); }
        if (row + 1 < r1 && row + 2 < NROW) XS_RAW(row + 2);
#pragma unroll
        for (int i = 0; i < 4; ++i) {
            const int d = (lane + i * 64) * 4;
            const float4 h = hc[i];
            const float4 xx = make_float4(fp_ * hp[i].x + fn_ * hn[i].x - h.x, fp_ * hp[i].y + fn_ * hn[i].y - h.y, fp_ * hp[i].z + fn_ * hn[i].z - h.z, fp_ * hp[i].w + fn_ * hn[i].w - h.w);
#pragma unroll
            for (int m = 0; m < 6; ++m) { const float4 u = um[m][i];
                uint2 wv_; wv_.x = pk2(h.x + xx.x * u.x, h.y + xx.y * u.y); wv_.y = pk2(h.z + xx.z * u.z, h.w + xx.w * u.w);
                *(uint2*)(XS + ((size_t)m * NROW + row) * D + d) = wv_; }
        }
#pragma unroll
        for (int i = 0; i < 4; ++i) { hp[i] = hc[i]; hc[i] = hn[i]; }
    }
#undef XS_NORM
#undef XS_RAW
}

__device__ __forceinline__ int scan_row(int i, int b, int z) {
    return i < TC ? NLAT + b * TC + (z ? TC - 1 - i : i) : b * TL + (z ? TL - 1 - (i - TC) : i - TC);
}
__device__ __forceinline__ float dpp_sum8(float x) {
    x += __builtin_bit_cast(float, __builtin_amdgcn_update_dpp(0, __builtin_bit_cast(int, x), 0xB1, 0xF, 0xF, true));
    x += __builtin_bit_cast(float, __builtin_amdgcn_update_dpp(0, __builtin_bit_cast(int, x), 0x4E, 0xF, 0xF, true));
    x += __builtin_bit_cast(float, __builtin_amdgcn_update_dpp(0, __builtin_bit_cast(int, x), 0x141, 0xF, 0xF, true));
    return x;
}
__device__ void ph_rw_scan(const Params& p, int j, char* lds) {
    const int tid = tidx(), wid = __builtin_amdgcn_readfirstlane(tid >> 6), lane = tid & 63;
    const size_t PL = (size_t)NROW * D;
    const float* RKV = (const float*)(p.ws + OFF_RKV); float* Y = (float*)(p.ws + OFF_Y);
    constexpr int CH = 32, BUFB = 5 * CH * 256 + CH * 128 + CH * 16, YB = CH * 32 * 4, NCH = (TC + TL) / CH;
    const bool loader = wid >= 4; const int lw = wid - 4;
    for (int it = bidx(); it < 256; it += gdim()) {
        const int vh = it & 1, z = (it >> 1) & 1, h = (it >> 2) & 15, b = it >> 6;
        const char* pl0 = (const char*)((const float*)(p.ws + OFF_W) + z * PL); const char* pl1 = (const char*)(RKV + PL);
        const char* pl2 = (const char*)((const float*)(p.ws + OFF_AV) + z * PL); const char* pl3 = (const char*)RKV;
        const char* vpl = (const char*)(RKV + 2 * PL);
        float* yout = Y + z * PL;
        __builtin_amdgcn_s_barrier();
        if (loader) {
            const int pq = lane & 15;
            const f32x4 kkv = *(const f32x4*)(p.rw_k_k + j * D + h * 64 + pq * 4), kav = *(const f32x4*)(p.rw_k_a + j * D + h * 64 + pq * 4);
            auto issue = [&](int c) {
                char* buf = lds + (c % 3) * BUFB;
#pragma unroll
                for (int q = 0; q < 8; ++q) { const int pi = q >> 1, tg = lw * 2 + (q & 1); const int row = scan_row(c * CH + tg * 4 + (lane >> 4), b, z);
                    const char* base = pi == 0 ? pl0 : pi == 1 ? pl1 : pi == 2 ? pl2 : pl3;
                    __builtin_amdgcn_global_load_lds((const unsigned*)(base + (size_t)row * D * 4 + h * 256 + (lane & 15) * 16), (LAS unsigned*)(buf + pi * (CH * 256) + tg * 1024), 16, 0, 0); }
                { const int row = scan_row(c * CH + lw * 8 + (lane >> 3), b, z);
                  __builtin_amdgcn_global_load_lds((const unsigned*)(vpl + (size_t)row * D * 4 + (h * 64 + vh * 32) * 4 + (lane & 7) * 16), (LAS unsigned*)(buf + 5 * CH * 256 + lw * 1024), 16, 0, 0); }
            };
            auto prep = [&](int c) {
                char* buf = lds + (c % 3) * BUFB;
#pragma unroll
                for (int ps = 0; ps < 2; ++ps) { const int ptok = lw * 8 + ps * 4 + (lane >> 4);
                    f32x4* kp = (f32x4*)(buf + 1 * CH * 256 + ptok * 256 + pq * 16); f32x4* ap = (f32x4*)(buf + 2 * CH * 256 + ptok * 256 + pq * 16); f32x4* dp = (f32x4*)(buf + 4 * CH * 256 + ptok * 256 + pq * 16);
                    f32x4* rp = (f32x4*)(buf + 3 * CH * 256 + ptok * 256 + pq * 16); const f32x4 wv = *(const f32x4*)(buf + ptok * 256 + pq * 16);
                    const f32x4 k = *kp, a = *ap, r = *rp; f32x4 kk = k * kkv;
                    float ss = kk[0] * kk[0] + kk[1] * kk[1] + kk[2] * kk[2] + kk[3] * kk[3]; ss = dpp_sum16(ss);
                    const float inv = 1.f / fmaxf(sqrtf(ss), 1e-12f); kk = kk * inv;
                    const f32x4 kd = k * (1.f + (a - 1.f) * kav), bb = kk * a;
                    const f32x4 t1 = bb * r, t2 = kd * r;
                    const float br = dpp_sum16((t1[0] + t1[1]) + (t1[2] + t1[3])), kr = dpp_sum16((t2[0] + t2[1]) + (t2[2] + t2[3]));
                    *dp = kd; *ap = bb; *kp = kk; *rp = wv * r;
                    if (pq == 0) *(float2*)(buf + 5 * CH * 256 + CH * 128 + ptok * 16) = make_float2(br, kr); }
            };
            issue(0); issue(1);
            asm volatile("s_waitcnt vmcnt(9)" ::: "memory");
            prep(0);
            asm volatile("s_waitcnt lgkmcnt(0)" ::: "memory"); __builtin_amdgcn_s_barrier();
            for (int c = 0; c < NCH; ++c) {
                if (c >= 1) { const float* yb = (const float*)(lds + 3 * BUFB + ((c - 1) & 1) * YB);
                    const int lt = tid - 256, t = lt >> 3, q = lt & 7; const int row = scan_row((c - 1) * CH + t, b, z);
                    *(f32x4*)(yout + (size_t)row * D + h * 64 + vh * 32 + q * 4) = *(const f32x4*)(yb + t * 32 + q * 4); }
                if (c + 2 < NCH) { issue(c + 2); asm volatile("s_waitcnt vmcnt(9)" ::: "memory"); } else asm volatile("s_waitcnt vmcnt(0)" ::: "memory");
                if (c + 1 < NCH) prep(c + 1);
                asm volatile("s_waitcnt lgkmcnt(0)" ::: "memory"); __builtin_amdgcn_s_barrier();
            }
            { const float* yb = (const float*)(lds + 3 * BUFB + ((NCH - 1) & 1) * YB);
              const int lt = tid - 256, t = lt >> 3, q = lt & 7; const int row = scan_row((NCH - 1) * CH + t, b, z);
              *(f32x4*)(yout + (size_t)row * D + h * 64 + vh * 32 + q * 4) = *(const f32x4*)(yb + t * 32 + q * 4); }
        } else {
            const int vr = lane >> 3, ks = lane & 7;
            f32x4 Sa = {0.f, 0.f, 0.f, 0.f}, Sb = {0.f, 0.f, 0.f, 0.f};
            __builtin_amdgcn_s_barrier();
            struct Ops { f32x4 w0, w1, kk0, kk1, bb0, bb1, r0, r1, kd0, kd1; float v; float2 sc; };
#define SC_LOAD(O, t) do { const char* q_ = bq + (t) * 256; O.w0 = *(const f32x4*)(q_); O.w1 = *(const f32x4*)(q_ + 16); O.kk0 = *(const f32x4*)(q_ + CH * 256); O.kk1 = *(const f32x4*)(q_ + CH * 256 + 16); \
                O.bb0 = *(const f32x4*)(q_ + 2 * CH * 256); O.bb1 = *(const f32x4*)(q_ + 2 * CH * 256 + 16); O.r0 = *(const f32x4*)(q_ + 3 * CH * 256); O.r1 = *(const f32x4*)(q_ + 3 * CH * 256 + 16); \
                O.kd0 = *(const f32x4*)(q_ + 4 * CH * 256); O.kd1 = *(const f32x4*)(q_ + 4 * CH * 256 + 16); O.v = *(const float*)(vq + (t) * 128); O.sc = *(const float2*)(buf + 5 * CH * 256 + CH * 128 + (t) * 16); } while (0)
#define SC_STEP(O, t) do { const f32x4 d1 = Sa * O.kk0 + Sb * O.kk1, d2 = Sa * O.r0 + Sb * O.r1; \
                float sa = -((d1[0] + d1[1]) + (d1[2] + d1[3])), yy = (d2[0] + d2[1]) + (d2[2] + d2[3]); \
                sa = dpp_sum8(sa); yy = dpp_sum8(yy); \
                Sa = Sa * O.w0 + (sa * O.bb0 + O.v * O.kd0); Sb = Sb * O.w1 + (sa * O.bb1 + O.v * O.kd1); \
                if (ks == 0) yb[(t) * 32 + wid * 8 + vr] = yy + sa * O.sc.x + O.v * O.sc.y; } while (0)
            for (int c = 0; c < NCH; ++c) {
                const char* buf = lds + (c % 3) * BUFB; float* yb = (float*)(lds + 3 * BUFB + (c & 1) * YB);
                const char* bq = buf + ks * 32; const char* vq = buf + 5 * CH * 256 + (wid * 8 + vr) * 4;
                Ops oA, oB, oC;
                SC_LOAD(oA, 0); SC_LOAD(oB, 1);
#pragma unroll
                for (int t = 0; t < CH; t += 3) {
                    if (t + 2 < CH) SC_LOAD(oC, t + 2);
                    SC_STEP(oA, t);
                    if (t + 3 < CH) SC_LOAD(oA, t + 3);
                    if (t + 1 < CH) SC_STEP(oB, t + 1);
                    if (t + 4 < CH) SC_LOAD(oB, t + 4);
                    if (t + 2 < CH) SC_STEP(oC, t + 2);
                }
                asm volatile("s_waitcnt lgkmcnt(0)" ::: "memory"); __builtin_amdgcn_s_barrier();
            }
#undef SC_LOAD
#undef SC_STEP
        }
    }
}


namespace ck {
constexpr int P = 72, MB = 64 * P * 2;
typedef __attribute__((address_space(3))) char lchar;
__device__ __forceinline__ f32x4 mm_tile(const lchar* Aop, const lchar* Bop, int ti, int tj, int c, int q, f32x4 acc) {
#pragma unroll
    for (int ks = 0; ks < 2; ++ks) {
        const bf16x8 a = *(const LAS bf16x8*)(Aop + ((16 * ti + c) * P + 32 * ks + 8 * q) * 2);
        const bf16x8 b = *(const LAS bf16x8*)(Bop + ((16 * tj + c) * P + 32 * ks + 8 * q) * 2);
        acc = __builtin_amdgcn_mfma_f32_16x16x32_bf16(a, b, acc, 0, 0, 0);
    }
    return acc;
}
__device__ __forceinline__ f32x4 mm_diag(const lchar* Aop, const lchar* Bop, int tt, int c, int q, f32x4 acc) {
    const int ks = tt >> 1;
    bf16x8 a = *(const LAS bf16x8*)(Aop + ((16 * tt + c) * P + 32 * ks + 8 * q) * 2);
    const bf16x8 b = *(const LAS bf16x8*)(Bop + ((16 * tt + c) * P + 32 * ks + 8 * q) * 2);
    if ((q >> 1) != (tt & 1)) a = (bf16x8){0, 0, 0, 0, 0, 0, 0, 0};
    return __builtin_amdgcn_mfma_f32_16x16x32_bf16(a, b, acc, 0, 0, 0);
}
__device__ __forceinline__ void st_tile(lchar* dst, int ti, int tj, int c, int q, f32x4 v) {
    u32x2 w; w.x = pk2(v[0], v[1]); w.y = pk2(v[2], v[3]); *(LAS u32x2*)(dst + ((16 * tj + c) * P + 16 * ti + 4 * q) * 2) = w;
}
__device__ __forceinline__ f32x4 ld_tile(const lchar* src, int ti, int tj, int c, int q) {
    const u32x2 w = *(const LAS u32x2*)(src + ((16 * tj + c) * P + 16 * ti + 4 * q) * 2);
    return (f32x4){__uint_as_float(w.x << 16), __uint_as_float(w.x & 0xffff0000u), __uint_as_float(w.y << 16), __uint_as_float(w.y & 0xffff0000u)};
}
__device__ __forceinline__ void st_glob(bf16_t* dst, int ti, int tj, int c, int q, f32x4 v) {
    uint2 w; w.x = pk2(v[0], v[1]); w.y = pk2(v[2], v[3]); *(uint2*)(dst + (16 * tj + c) * 64 + 16 * ti + 4 * q) = w;
}
typedef float f32x16 __attribute__((ext_vector_type(16)));
__device__ __forceinline__ f32x16 mm32(const lchar* Aop, const lchar* Bop, int ti, int tj, int r32, int hi, f32x16 acc) {
    bf16x8 a[4], b[4];
#pragma unroll
    for (int ks = 0; ks < 4; ++ks) {
        a[ks] = *(const LAS bf16x8*)(Aop + ((32 * ti + r32) * P + 16 * ks + 8 * hi) * 2);
        b[ks] = *(const LAS bf16x8*)(Bop + ((32 * tj + r32) * P + 16 * ks + 8 * hi) * 2); }
    __builtin_amdgcn_sched_barrier(0);
#pragma unroll
    for (int ks = 0; ks < 4; ++ks) acc = __builtin_amdgcn_mfma_f32_32x32x16_bf16(a[ks], b[ks], acc, 0, 0, 0);
    return acc;
}
__device__ __forceinline__ void st32(lchar* dst, int ti, int tj, int r32, int hi, const f32x16& v) {
#pragma unroll
    for (int g = 0; g < 4; ++g) { u32x2 w; w.x = pk2(v[4 * g], v[4 * g + 1]); w.y = pk2(v[4 * g + 2], v[4 * g + 3]); *(LAS u32x2*)(dst + ((32 * tj + r32) * P + 32 * ti + 8 * g + 4 * hi) * 2) = w; }
}
__device__ __forceinline__ f32x16 ld32(const lchar* src, int ti, int tj, int r32, int hi) {
    f32x16 v;
#pragma unroll
    for (int g = 0; g < 4; ++g) { const u32x2 w = *(const LAS u32x2*)(src + ((32 * tj + r32) * P + 32 * ti + 8 * g + 4 * hi) * 2);
        v[4 * g] = __uint_as_float(w.x << 16); v[4 * g + 1] = __uint_as_float(w.x & 0xffff0000u); v[4 * g + 2] = __uint_as_float(w.y << 16); v[4 * g + 3] = __uint_as_float(w.y & 0xffff0000u); }
    return v;
}
__device__ __forceinline__ void stg32(bf16_t* dst, int ti, int tj, int r32, int hi, const f32x16& v) {
#pragma unroll
    for (int g = 0; g < 4; ++g) { uint2 w; w.x = pk2(v[4 * g], v[4 * g + 1]); w.y = pk2(v[4 * g + 2], v[4 * g + 3]); *(uint2*)(dst + (32 * tj + r32) * 64 + 32 * ti + 8 * g + 4 * hi) = w; }
}
}

#define LBAR() do { asm volatile("s_waitcnt lgkmcnt(0)" ::: "memory"); __builtin_amdgcn_s_barrier(); asm volatile("" ::: "memory"); } while (0)
__device__ void ph_rw_sc1(const Params& p, int j, char* lds) {
    using namespace ck;
    const int tid = tidx(), wid = __builtin_amdgcn_readfirstlane(tid >> 6), lane = tid & 63, c = lane & 15, q = lane >> 4;
    const size_t PL = (size_t)NROW * D;
    const bf16_t* RKV = (const bf16_t*)(p.ws + OFF_RKV); const float* LW = (const float*)(p.ws + OFF_W); const bf16_t* AV = (const bf16_t*)(p.ws + OFF_AV);
    bf16_t* CK = (bf16_t*)(p.ws + OFF_CK);
    lchar* B0 = (lchar*)lds;
#define BUF(i) (B0 + (i) * MB)
    LAS float* Lbuf = (LAS float*)BUF(8);
    LAS float* Lseg = (LAS float*)(B0 + 16 * MB);
    LAS float* GC = Lseg + 8 * 64;
    const int pt = tid >> 3, cg = tid & 7;
    f32x4 nlw[2], nkk[2], nka[2]; u32x4 nkx, nax, nrx, nvx;
#define SC1_LOAD(IT) do { const int seq_ = (IT) / NCHK, ch_ = (IT) % NCHK; const int z_ = seq_ & 1, h_ = (seq_ >> 1) & 15, b_ = seq_ >> 5; \
        const size_t go_ = (size_t)scan_row(ch_ * 64 + pt, b_, z_) * D + h_ * 64 + cg * 8; \
        _Pragma("unroll") for (int e = 0; e < 2; ++e) nlw[e] = *(const f32x4*)(LW + z_ * PL + go_ + 4 * e); \
        nkx = *(const u32x4*)(RKV + PL + go_); nax = *(const u32x4*)(AV + z_ * PL + go_); nrx = *(const u32x4*)(RKV + go_); nvx = *(const u32x4*)(RKV + 2 * PL + go_); \
        _Pragma("unroll") for (int e = 0; e < 2; ++e) { nkk[e] = *(const f32x4*)(p.rw_k_k + j * D + h_ * 64 + cg * 8 + 4 * e); nka[e] = *(const f32x4*)(p.rw_k_a + j * D + h_ * 64 + cg * 8 + 4 * e); } } while (0)
    if (bidx() < 128 * NCHK) SC1_LOAD(bidx());
    for (int it = bidx(); it < 128 * NCHK; it += gdim()) {
        const int seq = it / NCHK; const int h = (seq >> 1) & 15;
        f32x4 lw[2], kx[2], ax[2], rx[2], vx[2], kkc[2], kac[2];
#pragma unroll
        for (int e = 0; e < 2; ++e) { lw[e] = nlw[e]; kkc[e] = nkk[e]; kac[e] = nka[e];
            kx[e] = (f32x4){__uint_as_float(nkx[2 * e] << 16), __uint_as_float(nkx[2 * e] & 0xffff0000u), __uint_as_float(nkx[2 * e + 1] << 16), __uint_as_float(nkx[2 * e + 1] & 0xffff0000u)};
            ax[e] = (f32x4){__uint_as_float(nax[2 * e] << 16), __uint_as_float(nax[2 * e] & 0xffff0000u), __uint_as_float(nax[2 * e + 1] << 16), __uint_as_float(nax[2 * e + 1] & 0xffff0000u)};
            rx[e] = (f32x4){__uint_as_float(nrx[2 * e] << 16), __uint_as_float(nrx[2 * e] & 0xffff0000u), __uint_as_float(nrx[2 * e + 1] << 16), __uint_as_float(nrx[2 * e + 1] & 0xffff0000u)};
            vx[e] = (f32x4){__uint_as_float(nvx[2 * e] << 16), __uint_as_float(nvx[2 * e] & 0xffff0000u), __uint_as_float(nvx[2 * e + 1] << 16), __uint_as_float(nvx[2 * e + 1] & 0xffff0000u)}; }
        if (it + gdim() < 128 * NCHK) SC1_LOAD(it + gdim());
        LBAR();
#pragma unroll
        for (int e = 0; e < 2; ++e) *(LAS f32x4*)(Lbuf + pt * 64 + cg * 8 + 4 * e) = lw[e];
        f32x4 kk[2], bq[2], kd[2];
        { float ss = 0.f;
#pragma unroll
          for (int e = 0; e < 2; ++e) { kk[e] = kx[e] * kkc[e]; ss += kk[e][0] * kk[e][0] + kk[e][1] * kk[e][1] + kk[e][2] * kk[e][2] + kk[e][3] * kk[e][3]; }
          ss = dpp_sum8(ss); const float inv = __builtin_amdgcn_rsqf(fmaxf(ss, 1e-24f));
#pragma unroll
          for (int e = 0; e < 2; ++e) { kk[e] = kk[e] * inv; bq[e] = kk[e] * ax[e]; kd[e] = kx[e] * (1.f + (ax[e] - 1.f) * kac[e]); } }
        LBAR();
        { const int k = tid & 63, sg = tid >> 6; float run = 0.f;
#pragma unroll
          for (int u = 0; u < 8; ++u) { run += Lbuf[(sg * 8 + u) * 64 + k]; Lbuf[(sg * 8 + u) * 64 + k] = run; }
          Lseg[sg * 64 + k] = run; }
        LBAR();
        f32x4 Lt[2], Lp[2], Lc[2];
        { const int sg = pt >> 3, sgp = (pt - 1) >> 3;
#pragma unroll
          for (int e = 0; e < 2; ++e) { f32x4 o0 = {0.f, 0.f, 0.f, 0.f}, o1 = o0, oc = o0;
#pragma unroll
              for (int u = 0; u < 8; ++u) { const f32x4 sv = *(const LAS f32x4*)(Lseg + u * 64 + cg * 8 + 4 * e); if (u < sg) o0 = o0 + sv; if (u < sgp) o1 = o1 + sv; if (u < 7) oc = oc + sv; }
              Lt[e] = *(const LAS f32x4*)(Lbuf + pt * 64 + cg * 8 + 4 * e) + o0;
              Lp[e] = pt > 0 ? *(const LAS f32x4*)(Lbuf + (pt - 1) * 64 + cg * 8 + 4 * e) + o1 : (f32x4){0.f, 0.f, 0.f, 0.f};
              Lc[e] = *(const LAS f32x4*)(Lbuf + 63 * 64 + cg * 8 + 4 * e) + oc; } }
        LBAR();
        {
            float at[8], bt[8], kt[8], rt[8], bh[8], kh[8], vv[8];
#pragma unroll
            for (int e = 0; e < 2; ++e)
#pragma unroll
                for (int u = 0; u < 4; ++u) { const int x = 4 * e + u; const float eL = __expf(Lt[e][u]), emL = __expf(-Lt[e][u]), eP = __expf(Lp[e][u]), eC = __expf(Lc[e][u] - Lt[e][u]);
                    at[x] = -kk[e][u] * eP; bt[x] = bq[e][u] * emL; kt[x] = kd[e][u] * emL; rt[x] = rx[e][u] * eL; bh[x] = bq[e][u] * eC; kh[x] = kd[e][u] * eC; vv[x] = vx[e][u];
                    if (pt == 63) GC[cg * 8 + x] = eL; }
#define ST8(bufi, arr) do { u32x4 w_ = {pk2(arr[0], arr[1]), pk2(arr[2], arr[3]), pk2(arr[4], arr[5]), pk2(arr[6], arr[7])}; *(LAS u32x4*)(BUF(bufi) + (pt * P + cg * 8) * 2) = w_; } while (0)
            ST8(0, at); ST8(1, bt); ST8(2, kt); ST8(3, rt); ST8(8, bh); ST8(9, kh); ST8(10, vv);
#undef ST8
        }
        LBAR();
        {
            const int k = tid & 63, tg = tid >> 6;
#define TR8(src, dst) do { unsigned w_[4]; _Pragma("unroll") for (int x = 0; x < 4; ++x) { const unsigned lo = *(const LAS bf16_t*)(BUF(src) + ((tg * 8 + 2 * x) * P + k) * 2), hi2 = *(const LAS bf16_t*)(BUF(src) + ((tg * 8 + 2 * x + 1) * P + k) * 2); w_[x] = lo | (hi2 << 16); } \
                *(LAS u32x4*)(BUF(dst) + (k * P + tg * 8) * 2) = (u32x4){w_[0], w_[1], w_[2], w_[3]}; } while (0)
            TR8(0, 4); TR8(8, 5); TR8(9, 6); TR8(10, 7);
#undef TR8
        }
        LBAR();
        const f32x4 Z4 = {0.f, 0.f, 0.f, 0.f};
        const f32x16 Z16 = {0.f, 0.f, 0.f, 0.f, 0.f, 0.f, 0.f, 0.f, 0.f, 0.f, 0.f, 0.f, 0.f, 0.f, 0.f, 0.f};
        const int r32 = lane & 31, hi = lane >> 5;
#pragma unroll 1
        for (int u = 0; u < 2; ++u) { const int tl = u * 8 + wid;
            if (tl >= 14) {
                if (tl == 14) { st32(BUF(8), 0, 1, r32, hi, Z16); st32(BUF(8), 1, 0, r32, hi, Z16); st32(BUF(14), 0, 1, r32, hi, Z16); st32(BUF(14), 1, 0, r32, hi, Z16); st32(BUF(9), 1, 0, r32, hi, Z16); }
                else { st32(BUF(15), 1, 0, r32, hi, Z16); st32(BUF(13), 1, 0, r32, hi, Z16); st32(BUF(10), 1, 0, r32, hi, Z16); st32(BUF(11), 1, 0, r32, hi, Z16); st32(BUF(12), 1, 0, r32, hi, Z16); }
                break; }
            const int m = (tl + 1) / 3, rr = (tl + 1) % 3, ti = rr == 2, tj = m == 0 ? ti : (rr >= 1); const int jj = 32 * tj + r32;
            if (m == 0) { f32x16 v = mm32(BUF(0), BUF(1), ti, tj, r32, hi, Z16), w;
#pragma unroll
                for (int e = 0; e < 16; ++e) { const int ii = 32 * ti + 8 * (e >> 2) + 4 * hi + (e & 3); const bool dg = (ii >> 4) == (jj >> 4);
                    v[e] = (dg && jj < ii) ? v[e] : 0.f; w[e] = v[e] + ((ii == jj) ? 1.f : 0.f); }
                st32(BUF(8), ti, tj, r32, hi, v); st32(BUF(14), ti, tj, r32, hi, w); }
            else if (m == 1) { const f32x16 v = mm32(BUF(1), BUF(0), ti, tj, r32, hi, Z16); f32x16 vd, vo, w;
#pragma unroll
                for (int e = 0; e < 16; ++e) { const int ii = 32 * ti + 8 * (e >> 2) + 4 * hi + (e & 3); const bool dg = (ii >> 4) == (jj >> 4), up = ii < jj;
                    vd[e] = (dg && up) ? v[e] : 0.f; vo[e] = (!dg && up) ? v[e] : 0.f; w[e] = vd[e] + ((ii == jj) ? 1.f : 0.f); }
                st32(BUF(9), ti, tj, r32, hi, vd); st32(BUF(15), ti, tj, r32, hi, vo); st32(BUF(13), ti, tj, r32, hi, w); }
            else if (m == 2) { f32x16 v = mm32(BUF(2), BUF(0), ti, tj, r32, hi, Z16);
#pragma unroll
                for (int e = 0; e < 16; ++e) { const int ii = 32 * ti + 8 * (e >> 2) + 4 * hi + (e & 3); v[e] = ii < jj ? v[e] : 0.f; }
                st32(BUF(10), ti, tj, r32, hi, v); }
            else { f32x16 v = mm32(m == 3 ? BUF(1) : BUF(2), BUF(3), ti, tj, r32, hi, Z16);
#pragma unroll
                for (int e = 0; e < 16; ++e) { const int ii = 32 * ti + 8 * (e >> 2) + 4 * hi + (e & 3); v[e] = ii <= jj ? v[e] : 0.f; }
                st32(m == 3 ? BUF(11) : BUF(12), ti, tj, r32, hi, v); } }
        LBAR();
#define WSYNC() asm volatile("s_waitcnt lgkmcnt(0)" ::: "memory")
        if (wid < 4) {
            const int tt = wid;
#define SQD(sr, st, dr, dt) do { const f32x4 a_ = mm_diag(BUF(st), BUF(sr), tt, c, q, Z4), b_ = mm_diag(BUF(sr), BUF(st), tt, c, q, Z4); WSYNC(); \
                st_tile(BUF(dr), tt, tt, c, q, a_); st_tile(BUF(dt), tt, tt, c, q, b_); WSYNC(); } while (0)
#define UPD(pr) do { const f32x4 dt_ = mm_diag(BUF(pr), BUF(13), tt, c, q, ld_tile(BUF(13), tt, tt, c, q)); \
                const f32x4 dr_ = mm_diag(BUF(13), BUF(pr), tt, c, q, ld_tile(BUF(14), tt, tt, c, q)); WSYNC(); \
                st_tile(BUF(13), tt, tt, c, q, dt_); st_tile(BUF(14), tt, tt, c, q, dr_); WSYNC(); } while (0)
#define UPSQ(sr, st, dr, dt) do { const f32x4 dt_ = mm_diag(BUF(sr), BUF(13), tt, c, q, ld_tile(BUF(13), tt, tt, c, q)); \
                const f32x4 dr_ = mm_diag(BUF(13), BUF(sr), tt, c, q, ld_tile(BUF(14), tt, tt, c, q)); \
                const f32x4 a_ = mm_diag(BUF(st), BUF(sr), tt, c, q, Z4), b_ = mm_diag(BUF(sr), BUF(st), tt, c, q, Z4); WSYNC(); \
                st_tile(BUF(13), tt, tt, c, q, dt_); st_tile(BUF(14), tt, tt, c, q, dr_); st_tile(BUF(dr), tt, tt, c, q, a_); st_tile(BUF(dt), tt, tt, c, q, b_); WSYNC(); } while (0)
            SQD(8, 9, 0, 1); UPSQ(0, 1, 8, 9); UPSQ(8, 9, 0, 1); UPD(0);
#undef UPSQ
#undef SQD
#undef UPD
        } else {
            const int ti = (wid >> 1) & 1, tj = wid & 1; st32(BUF(2), ti, tj, r32, hi, mm32(BUF(10), BUF(7), ti, tj, r32, hi, Z16));
        }
        LBAR();
        { const int m = wid >> 2, ti = (wid >> 1) & 1, tj = wid & 1;
          if (m == 0) st32(BUF(8), ti, tj, r32, hi, mm32(BUF(15), BUF(14), ti, tj, r32, hi, Z16));
          else        st32(BUF(9), ti, tj, r32, hi, mm32(BUF(14), BUF(15), ti, tj, r32, hi, Z16)); }
        LBAR();
        { const int ti = (wid >> 1) & 1, tj = wid & 1;
          if (wid < 4) st32(BUF(0), ti, tj, r32, hi, mm32(BUF(9), BUF(8), ti, tj, r32, hi, Z16));
          else         st32(BUF(1), ti, tj, r32, hi, mm32(BUF(8), BUF(13), ti, tj, r32, hi, ld32(BUF(13), ti, tj, r32, hi))); }
        LBAR();
        if (wid < 4) { const int ti = (wid >> 1) & 1, tj = wid & 1; st32(BUF(14), ti, tj, r32, hi, mm32(BUF(0), BUF(1), ti, tj, r32, hi, ld32(BUF(1), ti, tj, r32, hi))); }
        LBAR();
        { const int m = wid >> 2, ti = (wid >> 1) & 1, tj = wid & 1;
          if (m == 0) st32(BUF(8), ti, tj, r32, hi, mm32(BUF(14), BUF(4), ti, tj, r32, hi, Z16));
          else        st32(BUF(0), ti, tj, r32, hi, mm32(BUF(14), BUF(2), ti, tj, r32, hi, Z16)); }
        LBAR();
        bf16_t* ckp = CK + (size_t)it * 4 * 4096;
#pragma unroll 1
        for (int u = 0; u < 2; ++u) { const int tl = u * 8 + wid, m = tl >> 2, ti = (tl >> 1) & 1, tj = tl & 1;
            if (m == 0) { f32x16 v = mm32(BUF(8), BUF(5), ti, tj, r32, hi, Z16); const int jj = 32 * tj + r32; const float gc = GC[jj];
#pragma unroll
                for (int e = 0; e < 16; ++e) { const int ii = 32 * ti + 8 * (e >> 2) + 4 * hi + (e & 3); v[e] += (ii == jj) ? gc : 0.f; }
                st32(BUF(1), ti, tj, r32, hi, v); }
            else if (m == 1) st32(BUF(4), ti, tj, r32, hi, mm32(BUF(8), BUF(11), ti, tj, r32, hi, ld32(BUF(3), ti, tj, r32, hi)));
            else if (m == 2) st32(BUF(2), ti, tj, r32, hi, mm32(BUF(6), BUF(7), ti, tj, r32, hi, mm32(BUF(5), BUF(0), ti, tj, r32, hi, Z16)));
            else             st32(BUF(9), ti, tj, r32, hi, mm32(BUF(7), BUF(12), ti, tj, r32, hi, mm32(BUF(0), BUF(11), ti, tj, r32, hi, Z16))); }
        LBAR();
        { const int orow = tid >> 3, oc = (tid & 7) * 8;
          *(u32x4*)(ckp + orow * 64 + oc) = *(const LAS u32x4*)(BUF(1) + (orow * P + oc) * 2);
          *(u32x4*)(ckp + 4096 + orow * 64 + oc) = *(const LAS u32x4*)(BUF(2) + (orow * P + oc) * 2);
          *(u32x4*)(ckp + 2 * 4096 + orow * 64 + oc) = *(const LAS u32x4*)(BUF(4) + (orow * P + oc) * 2);
          *(u32x4*)(ckp + 3 * 4096 + orow * 64 + oc) = *(const LAS u32x4*)(BUF(9) + (orow * P + oc) * 2); }
    }
#undef BUF
#undef SC1_LOAD
}

__device__ void ph_rw_sc2(const Params& p, char* lds) {
    using namespace ck;
    const int tid = tidx(), wid = __builtin_amdgcn_readfirstlane(tid >> 6), lane = tid & 63, c = lane & 15, q = lane >> 4;
    const size_t PL = (size_t)NROW * D;
    const bf16_t* CK = (const bf16_t*)(p.ws + OFF_CK); bf16_t* Y = (bf16_t*)(p.ws + OFF_Y);
    lchar* GB = (lchar*)lds;
    lchar* RB = GB + 2 * MB;
    lchar* SB = GB + 4 * MB;
    constexpr int SBB = 32 * P * 2;
    for (int it = bidx(); it < 256; it += gdim()) {
        const int vh = it & 1, seq = it >> 1, z = seq & 1, h = (seq >> 1) & 15, b = seq >> 5;
        const bf16_t* ck0 = CK + (size_t)seq * NCHK * 4 * 4096;
        const int s_ti = wid & 3, s_tj = wid >> 2;
        const int y_ti = wid & 1, y_tj = wid >> 1;
        const int hoff = 4096 + (vh * 32 + 16 * s_tj + c) * 64 + 16 * s_ti + 4 * q, yoff = 3 * 4096 + (16 * y_tj + c) * 64 + vh * 32 + 16 * y_ti + 4 * q;
        struct PF { u32x4 g, r; uint2 h, y; };
#define PF_LOAD(X, k) do { const bf16_t* cc_ = ck0 + (size_t)(k) * 4 * 4096; X.h = *(const uint2*)(cc_ + hoff); X.y = *(const uint2*)(cc_ + yoff); X.g = *(const u32x4*)(cc_ + tid * 8); X.r = *(const u32x4*)(cc_ + 2 * 4096 + tid * 8); } while (0)
#define PF_STAGE(X, bufi) do { *(LAS u32x4*)(GB + (bufi) * MB + ((tid >> 3) * P + (tid & 7) * 8) * 2) = X.g; *(LAS u32x4*)(RB + (bufi) * MB + ((tid >> 3) * P + (tid & 7) * 8) * 2) = X.r; } while (0)
#define SC2_STEP(k, CUR, NXT) do { const uint2 hi_ = CUR.h, yi_ = CUR.y; const int cur = (k) & 1; \
            if ((k) + 4 < NCHK) PF_LOAD(CUR, (k) + 4); \
            const f32x4 hinit = {__uint_as_float(hi_.x << 16), __uint_as_float(hi_.x & 0xffff0000u), __uint_as_float(hi_.y << 16), __uint_as_float(hi_.y & 0xffff0000u)}; \
            const f32x4 yinit = {__uint_as_float(yi_.x << 16), __uint_as_float(yi_.x & 0xffff0000u), __uint_as_float(yi_.y << 16), __uint_as_float(yi_.y & 0xffff0000u)}; \
            const lchar* Sold = SB + cur * SBB; lchar* Snew = SB + (cur ^ 1) * SBB; \
            const f32x4 sn = mm_tile(GB + cur * MB, Sold, s_ti, s_tj, c, q, hinit);        \
            const f32x4 yv = mm_tile(Sold, RB + cur * MB, y_ti, y_tj, c, q, yinit);        \
            st_tile(Snew, s_ti, s_tj, c, q, sn); \
            { const int row = scan_row((k) * 64 + 16 * y_tj + c, b, z); stbf4(Y + z * PL + (size_t)row * D + h * 64 + vh * 32 + 16 * y_ti + 4 * q, yv); } \
            if ((k) + 1 < NCHK) PF_STAGE(NXT, cur ^ 1); \
            LBAR(); } while (0)
        PF s0, s1, s2, s3;
        PF_LOAD(s0, 0); PF_LOAD(s1, 1); PF_LOAD(s2, 2); PF_LOAD(s3, 3);
        LBAR();
        for (int i = tid; i < SBB / 4; i += NTHR) ((LAS unsigned*)SB)[i] = 0u;
        PF_STAGE(s0, 0);
        LBAR();
        for (int ch = 0; ch < NCHK; ch += 4) {
            SC2_STEP(ch, s0, s1); SC2_STEP(ch + 1, s1, s2); SC2_STEP(ch + 2, s2, s3); SC2_STEP(ch + 3, s3, s0);
        }
#undef PF_LOAD
#undef PF_STAGE
#undef SC2_STEP
    }
}
#undef LBAR

__device__ void ph_rw_out(const Params& p, int j, int nrows) {
    const int wid = tidx() >> 6, lane = tidx() & 63;
    const bf16_t* RKV = (const bf16_t*)(p.ws + OFF_RKV); const bf16_t* AV = (const bf16_t*)(p.ws + OFF_AV); const bf16_t* G = (const bf16_t*)(p.ws + OFF_G); const bf16_t* Y = (const bf16_t*)(p.ws + OFF_Y);
    bf16_t* OUT = (bf16_t*)(p.ws + OFF_H);
    const size_t PL = (size_t)NROW * D;
    const float* r_k = p.rw_r_k + j * D; const float* lg = p.rw_lnx_g + j * D; const float* lb = p.rw_lnx_b + j * D; const float* k_a = p.rw_k_a + j * D;
    uint2 nb[8][4];
#define OUT_LOAD(R) do { _Pragma("unroll") for (int i = 0; i < 4; ++i) { const size_t o_ = (size_t)(R) * D + lane * 4 + i * 256; \
        nb[0][i] = *(const uint2*)(Y + o_); nb[1][i] = *(const uint2*)(Y + PL + o_); nb[2][i] = *(const uint2*)(RKV + o_); nb[3][i] = *(const uint2*)(RKV + PL + o_); \
        nb[4][i] = *(const uint2*)(RKV + 2 * PL + o_); nb[5][i] = *(const uint2*)(AV + o_); nb[6][i] = *(const uint2*)(AV + PL + o_); nb[7][i] = *(const uint2*)(G + o_); } } while (0)
#define UNPK(w) ((f32x4){__uint_as_float((w).x << 16), __uint_as_float((w).x & 0xffff0000u), __uint_as_float((w).y << 16), __uint_as_float((w).y & 0xffff0000u)})
    int row = bidx() * 8 + wid;
    if (row < nrows) OUT_LOAD(row);
    for (; row < nrows; row += gdim() * 8) {
        uint2 cb[8][4];
#pragma unroll
        for (int q_ = 0; q_ < 8; ++q_)
#pragma unroll
            for (int i = 0; i < 4; ++i) cb[q_][i] = nb[q_][i];
        { const int nrow = row + gdim() * 8; if (nrow < nrows) OUT_LOAD(nrow); }
#pragma unroll
        for (int i = 0; i < 4; ++i) {
            const size_t o = (size_t)row * D + lane * 4 + i * 256; const int c = lane * 4 + i * 256;
            const f32x4 y = UNPK(cb[0][i]) + UNPK(cb[1][i]);
            const float mean = dpp_sum16(y[0] + y[1] + y[2] + y[3]) * (1.f / 64.f);
            const f32x4 dd = y - mean;
            const float rstd = rsqrtf(dpp_sum16(dd[0] * dd[0] + dd[1] * dd[1] + dd[2] * dd[2] + dd[3] * dd[3]) * (1.f / 64.f) + LNX_EPS);
            const f32x4 r = UNPK(cb[2][i]), k = UNPK(cb[3][i]), v = UNPK(cb[4][i]);
            const f32x4 a0 = UNPK(cb[5][i]), a1 = UNPK(cb[6][i]);
            const f32x4 kds = k * (2.f + (a0 + a1 - 2.f) * *(const f32x4*)(k_a + c));
            const f32x4 t4 = r * kds * *(const f32x4*)(r_k + c);
            const float bs = dpp_sum16(t4[0] + t4[1] + t4[2] + t4[3]);
            const f32x4 res = (dd * rstd * *(const f32x4*)(lg + c) + *(const f32x4*)(lb + c) + bs * v) * UNPK(cb[7][i]);
            uint2 w; w.x = pk2(res[0], res[1]); w.y = pk2(res[2], res[3]); *(uint2*)(OUT + o) = w;
        }
    }
#undef OUT_LOAD
#undef UNPK
}

__device__ void ph_final(const Params& p) {
    const int wid = tidx() >> 6, lane = tidx() & 63;
    const float* X = (const float*)(p.ws + OFF_X);
    for (int row = bidx() * 8 + wid; row < NLAT; row += gdim() * 8) {
        const float4* xr = (const float4*)(X + (size_t)row * D);
        float4 v[4]; float ss = 0;
#pragma unroll
        for (int i = 0; i < 4; ++i) { v[i] = xr[lane + i * 64]; ss += v[i].x * v[i].x + v[i].y * v[i].y + v[i].z * v[i].z + v[i].w * v[i].w; }
        ss = wave_sum(ss); const float rs = rsqrtf(ss * (1.f / D) + RMS_EPS);
#pragma unroll
        for (int i = 0; i < 4; ++i) { const int d = (lane + i * 64) * 4; const float4 gg = *(const float4*)(p.final_g + d);
            float4 o; o.x = v[i].x * rs * gg.x; o.y = v[i].y * rs * gg.y; o.z = v[i].z * rs * gg.z; o.w = v[i].w * rs * gg.w;
            *(float4*)(p.out + (size_t)row * D + d) = o; }
    }
}

enum { PH_INIT = 0, PH_A_NORM, PH_A_Z, PH_A_MID, PH_A_QKV, PH_A_POST, PH_A_ATTN, PH_A_WO,
       PH_R_NORM, PH_R_XS, PH_R_G1, PH_R_G2, PH_R_PREP, PH_R_SCAN, PH_R_OUT, PH_R_WO,
       PH_M_NORM, PH_M_SEL, PH_M_GATHER, PH_M_G1, PH_M_G2, PH_M_COMB, PH_FINAL, PH_M_CVT, PH_R_SC1, PH_R_SC2 };

#ifndef BG_Z
#define BG_Z 4
#define BG_ATTN 2
#define BG_WO 3
#define BG_RG1 6
#define BG_MG1 4
#define BG_MG2 6
#endif
template <int PH>
__device__ __forceinline__ void run_phase(const Params& p, int layer, char* lds) {
    const int j = layer >> 1;
    char* ws = p.ws;
    if constexpr (PH == PH_INIT) { ph_init(p, lds); __syncthreads(); ph_small_cvt(p, lds); }
    else if constexpr (PH == PH_A_NORM) { if (layer == 0) ph_norm_mod<false>(p, layer, p.norm1_g + layer * D, 0, 1, ws + OFF_H); else ph_comb_norm<false>(p, layer - 1, layer, NROW); }
    else if constexpr (PH == PH_A_Z) {
        float* Z = (float*)(ws + OFF_Z);
        g8::BatchSched S{ws + OFF_H, ws + OFF_WMLA + j * SZ_WMLA + WM_IN, 0, 0, NROW / 256, 2, 1, D};
        g8::gemm_phase(p.wv, (PG8_LAS unsigned char*)lds, D, S, g8::epi_rc([=](const g8::Unit&, int row, int col, f32x4 v) { *(f32x4*)(Z + (size_t)row * 512 + col) = v; }));
        if (idle_tail(NROW / 256 * 2)) bg_cvt(p, layer, lds, BG_Z);
    }
    else if constexpr (PH == PH_A_MID) ph_mla_mid(p, j);
    else if constexpr (PH == PH_A_QKV) {
        bf16_t* Q = (bf16_t*)(ws + OFF_Q); bf16_t* K = (bf16_t*)(ws + OFF_K); bf16_t* V = (bf16_t*)(ws + OFF_V);
        g8::BatchSched S1{ws + OFF_CQN, ws + OFF_WMLA + j * SZ_WMLA + WM_UQ, 0, 0, NROW / 256, 6, 1, 256, 1};
        g8::gemm_phase(p.wv, (PG8_LAS unsigned char*)lds, 256, S1, g8::epi_rc([=](const g8::Unit&, int row, int col, f32x4 v) {
            const bool lat = row < NLAT; const int b = lat ? (row >> 12) : ((row - NLAT) >> 8); const int tk = lat ? 256 + (row & (TL - 1)) : ((row - NLAT) & 255);
            const int h = col / 192, d = col - h * 192;
            uint2 w; w.x = pk2(v[0], v[1]); w.y = pk2(v[2], v[3]);
            *(uint2*)(Q + ((size_t)(b * 8 + h) * TK + tk) * 192 + d) = w; }));
        g8::BatchSched S2{ws + OFF_CKVN, ws + OFF_WMLA + j * SZ_WMLA + WM_UKV, 0, 0, NROW / 256, 8, 1, 128};
        g8::gemm_phase(p.wv, (PG8_LAS unsigned char*)lds, 128, S2, g8::epi_rc([=](const g8::Unit&, int row, int col, f32x4 v) {
            const bool lat = row < NLAT; const int b = lat ? (row >> 12) : ((row - NLAT) >> 8); const int tk = lat ? 256 + (row & (TL - 1)) : ((row - NLAT) & 255);
            const int h = col >> 8, d = col & 255; const size_t orow = (size_t)(b * 8 + h) * TK + tk;
            uint2 w; w.x = pk2(v[0], v[1]); w.y = pk2(v[2], v[3]);
            if (d < 128) *(uint2*)(K + orow * 192 + d) = w; else *(uint2*)(V + orow * 128 + (d - 128)) = w; }));
    }
    else if constexpr (PH == PH_A_ATTN) { ph_attn(p, lds); if (idle_tail(544)) bg_cvt(p, layer, lds, BG_ATTN); }
    else if constexpr (PH == PH_A_WO || PH == PH_R_WO) {
        xt_t* X = (xt_t*)(ws + OFF_X); const float* MOD = (const float*)(ws + OFF_MOD);
        g8::BatchSched S{ws + (PH == PH_A_WO ? OFF_O : OFF_H), PH == PH_A_WO ? ws + OFF_WMLA + j * SZ_WMLA + WM_O : ws + OFF_WRW + j * SZ_WRW + WR_O, 0, 0, (layer < 3 ? NROW : NLAT) / 256, 4, 1, D};
        g8::gemm_phase(p.wv, (PG8_LAS unsigned char*)lds, D, S, g8::EpiResid{X, MOD, layer});
        if (idle_tail((layer < 3 ? NROW : NLAT) / 256 * 4)) bg_cvt(p, layer, lds, BG_WO);
    }
    else if constexpr (PH == PH_R_XS) ph_rw_normxs(p, layer, j);
    else if constexpr (PH == PH_R_G1) {
        bf16_t* RKV = (bf16_t*)(ws + OFF_RKV); bf16_t* VF = (bf16_t*)(ws + OFF_VFIRST);
        bf16_t* A2 = (bf16_t*)(ws + OFF_A2); bf16_t* A3 = (bf16_t*)(ws + OFF_A3);
        const bool first = (j == 0);
        struct RSched { const char* XS; const char* WB; int nwg;
            __device__ __forceinline__ bool next(int i, g8::Unit& u) const {
                const int L = i * gdim() + bidx(); if (L >= nwg) return false;
                const int w = g8::xcd_remap(L, nwg);
                if (w < 816) { u.g = w / 272; const int r = w % 272; u.pm = r >> 2; u.pn = r & 3; u.B = WB + WR_RKV + (size_t)u.g * D * D * 2 + (size_t)u.pn * 256 * D * 2; }
                else { u.g = 3 + (w - 816) / 68; u.pm = (w - 816) % 68; u.pn = 0; u.B = WB + WR_L + (size_t)(u.g - 3) * 256 * D * 2; }
                u.A = XS + (size_t)(u.g == 6 ? 2 : u.g) * NROW * D * 2 + (size_t)u.pm * 256 * D * 2; return true; } };
        RSched S{ws + OFF_XS, ws + OFF_WRW + j * SZ_WRW, first ? 816 + 204 : 816 + 272};
        g8::gemm_phase(p.wv, (PG8_LAS unsigned char*)lds, D, S, g8::epi_rc([=](const g8::Unit& u, int row, int col, f32x4 v) {
            if (u.g < 3) { stbf4(RKV + ((size_t)u.g * NROW + row) * D + col, v); if (first && u.g == 2) stbf4(VF + (size_t)row * D + col, v); }
            else if (col < 128) {
                f32x4 t = v;
                if (u.g == 3) { for (int e = 0; e < 4; ++e) t[e] = 1.f - 2.f * __builtin_amdgcn_rcpf(1.f + __expf(2.f * v[e])); }
                else if (u.g == 5) { for (int e = 0; e < 4; ++e) t[e] = sigmoidf_(v[e]); }
                bf16_t* dst = (u.g == 3 ? A2 : u.g == 4 ? A2 + (size_t)NROW * 128 : u.g == 5 ? A3 : A3 + (size_t)NROW * 128);
                stbf4(dst + (size_t)row * 128 + col, t); } }));
        if (idle_tail(S.nwg)) bg_cvt(p, layer, lds, BG_RG1);
    }
    else if constexpr (PH == PH_R_G2) {
        const bool first = (j == 0);
        float* W = (float*)(ws + OFF_W); bf16_t* AV = (bf16_t*)(ws + OFF_AV); bf16_t* G = (bf16_t*)(ws + OFF_G); bf16_t* RKV = (bf16_t*)(ws + OFF_RKV); const bf16_t* VF = (const bf16_t*)(ws + OFF_VFIRST);
        const float* w0 = p.rw_w0 + (size_t)j * 2 * D; const float* a0 = p.rw_a0 + (size_t)j * 2 * D; const float* v0 = p.rw_v0;
        g8::BatchSched S1{ws + OFF_A2, ws + OFF_WRW + j * SZ_WRW + WR_B2, (size_t)NROW * 128 * 2, (size_t)2048 * 128 * 2, NROW / 256, 8, 2, 128};
        g8::gemm_phase(p.wv, (PG8_LAS unsigned char*)lds, 128, S1, g8::epi_colfirst([=](const g8::Unit& u, int row, int col, f32x4 v, f32x4 bias) {
            const int zz = u.pn >> 2, c = col & 1023; const bool dec = u.g == 0;
            const size_t doff = (size_t)zz * NROW * D + (size_t)row * D + c;
            const f32x4 x = v + bias; f32x4 o;
#pragma unroll
            for (int e = 0; e < 4; ++e) { const float sg = __builtin_amdgcn_rcpf(1.f + __expf(-x[e])); o[e] = dec ? (-0.6065306597126334f * sg) : sg; }
            if (dec) *(f32x4*)(W + doff) = o; else stbf4(AV + doff, o); },
            [=](const g8::Unit& u, int col) { const int zz = u.pn >> 2, c = col & 1023; return *(const f32x4*)((u.g == 0 ? w0 : a0) + zz * D + c); }));
        g8::BatchSched S2{ws + OFF_A3, ws + OFF_WRW + j * SZ_WRW + WR_B3, (size_t)NROW * 128 * 2, (size_t)1024 * 128 * 2, NROW / 256, 4, first ? 1 : 2, 128, 1};
        g8::gemm_phase(p.wv, (PG8_LAS unsigned char*)lds, 128, S2, g8::epi_rc([=](const g8::Unit& u, int row, int col, f32x4 v) {
            if (u.g == 0) stbf4(G + (size_t)row * D + col, v);
            else { const size_t o = (size_t)row * D + col; const f32x4 vv = ldbf4(RKV + (size_t)2 * NROW * D + o), vf = ldbf4(VF + o), gz = v + *(const f32x4*)(v0 + col); f32x4 r;
#pragma unroll
                for (int e = 0; e < 4; ++e) r[e] = vv[e] + (vf[e] - vv[e]) * __builtin_amdgcn_rcpf(1.f + __expf(-gz[e]));
                stbf4(RKV + (size_t)2 * NROW * D + o, r); } }));
    }
    else if constexpr (PH == PH_R_SCAN) ph_rw_scan(p, j, lds);
    else if constexpr (PH == PH_R_SC1) ph_rw_sc1(p, j, lds);
    else if constexpr (PH == PH_R_SC2) ph_rw_sc2(p, lds);
    else if constexpr (PH == PH_R_OUT) ph_rw_out(p, j, layer < 3 ? NROW : NLAT);
    else if constexpr (PH == PH_M_NORM) ph_norm2_router_mm(p, layer, lds, layer < 3 ? NROW : NLAT);
    else if constexpr (PH == PH_M_SEL) { ph_select(p, lds, layer < 3 ? 128 : 64); __syncthreads(); moe_cvt(p, layer, lds, -1); }
    else if constexpr (PH == PH_M_GATHER) ph_gather(p, layer < 3 ? ESLOTS : NB * CAPL);
    else if constexpr (PH == PH_M_G1) {
        bf16_t* HID = (bf16_t*)(ws + OFF_HID);
        g8::BatchSched S{ws + OFF_XE, ws + OFF_W13T + (size_t)(layer & 1) * SZ_WMOE, (size_t)EPAD * D * 2, (size_t)2816 * D * 2, layer < 3 ? 9 : 8, 11, NE, D};
        g8::gemm_phase(p.wv, (PG8_LAS unsigned char*)lds, D, S, g8::epi_pair([=](const g8::Unit& u, int row, int col, f32x4 a, f32x4 b) {
            uint2 w; w.x = pk2(a[0] * __builtin_amdgcn_rcpf(1.f + __expf(-a[0])) * b[0], a[1] * __builtin_amdgcn_rcpf(1.f + __expf(-a[1])) * b[1]); w.y = pk2(a[2] * __builtin_amdgcn_rcpf(1.f + __expf(-a[2])) * b[2], a[3] * __builtin_amdgcn_rcpf(1.f + __expf(-a[3])) * b[3]);
            *(uint2*)(HID + ((size_t)u.g * EPAD + row) * FF + col) = w; }));
        if (layer < 3 && idle_tail(9 * 11 * NE)) moe_cvt(p, layer + 1, lds, BG_MG1);
    }
    else if constexpr (PH == PH_M_G2) {
        bf16_t* YE = (bf16_t*)(ws + OFF_YE); const float* GATE = (const float*)(ws + OFF_GATE);
        g8::BatchSched S{ws + OFF_HID, ws + OFF_W2T + (size_t)(layer & 1) * SZ_WMOE, (size_t)EPAD * FF * 2, (size_t)D * FF * 2, layer < 3 ? 9 : 8, 4, NE, FF};
        g8::gemm_phase(p.wv, (PG8_LAS unsigned char*)lds, FF, S, g8::epi_pre([=](const g8::Unit& u, int row, int col, f32x4 v, f32x4, float gt) {
            uint2 w; w.x = pk2(v[0] * gt, v[1] * gt); w.y = pk2(v[2] * gt, v[3] * gt);
            *(uint2*)(YE + ((size_t)u.g * EPAD + row) * D + col) = w; },
            [=](const g8::Unit&, int) { return (f32x4){0.f, 0.f, 0.f, 0.f}; }, [=](const g8::Unit& u, int row) { return GATE[u.g * EPAD + row]; }));
        if (layer < 3 && idle_tail(9 * 4 * NE)) moe_cvt(p, layer + 1, lds, BG_MG2);
    }
    else if constexpr (PH == PH_M_COMB) ph_combine(p, layer, layer < 3 ? NROW : NLAT);
    else if constexpr (PH == PH_M_CVT) moe_cvt(p, layer, lds, -1);
    else if constexpr (PH == PH_FINAL) ph_comb_norm<true>(p, 3, 0, NLAT);
}

#if ONE_LAUNCH
#define SYNC() xcd_barrier(bar)
#ifndef PROBE_PH
#define PROBE_PH -1
#endif
#ifndef PROBE_REP
#define PROBE_REP 1
#endif
__device__ __forceinline__ Params load_params() {
    Params q{};
#if defined(__HIP_DEVICE_COMPILE__)
    typedef const __attribute__((address_space(4))) unsigned long long* KargP;
    KargP kp_ = (KargP)__builtin_amdgcn_kernarg_segment_ptr(); asm volatile("" : "+s"(kp_));
#pragma unroll
    for (int i = 0; i < 40; ++i) ((const float**)&q)[i] = (const float*)(const __attribute__((address_space(1))) float*)kp_[i];
#endif
    return q;
}
#define RUN(PH) do { for (int rep_ = 0; rep_ < ((PH) == PROBE_PH ? PROBE_REP : 1); ++rep_) { Params q = load_params(); q.wv = wv0_; run_phase<PH>(q, layer, smem); SYNC(); } } while (0)
__global__ void __launch_bounds__(NTHR, 2) mega(Params p) {
    extern __shared__ __attribute__((aligned(16))) char smem[];
    const int wv0_ = __builtin_amdgcn_readfirstlane((int)threadIdx.x >> 6);
    if (threadIdx.x == 0) *(uint4*)(smem + LDS_BYTES) = make_uint4(0u, 0u, 0u, 0u);
    __syncthreads();
    XcdBarrier bar = xcd_barrier_post((unsigned*)(p.ws + OFF_BAR), (volatile LAS unsigned*)(smem + LDS_BYTES));
    { const int layer = 0; RUN(PH_INIT); }
    for (int layer = 0; layer < 4; ++layer) {
        if ((layer & 1) == 0) {
            RUN(PH_A_NORM);
            RUN(PH_A_Z);
            RUN(PH_A_MID);
            RUN(PH_A_QKV);
            RUN(PH_A_ATTN);
            RUN(PH_A_WO);
        } else {
            RUN(PH_R_XS);
            RUN(PH_R_G1);
            RUN(PH_R_G2);
            RUN(PH_R_SC1);
            RUN(PH_R_SC2);
            RUN(PH_R_OUT);
            RUN(PH_R_WO);
        }
        RUN(PH_M_NORM);
        RUN(PH_M_SEL);
        RUN(PH_M_G1);
        RUN(PH_M_G2);
        if ((layer & 1) == 0) RUN(PH_M_COMB);
    }
    { Params q = load_params(); q.wv = wv0_; run_phase<PH_FINAL>(q, 0, smem); }
}
#else
template <int PH> __global__ void __launch_bounds__(NTHR, 2) kph(Params p, int layer) {
    extern __shared__ __attribute__((aligned(16))) char smem[];
    Params q = p; q.wv = __builtin_amdgcn_readfirstlane((int)threadIdx.x >> 6);
    run_phase<PH>(q, layer, smem);
}
#endif

extern "C" void kernel_launch(void* const* d_in, const int* in_sizes, int n_in, void* d_out, int out_size, void* d_ws, size_t ws_size, hipStream_t stream) {
    if (n_in != 38 || ws_size < WS_NEED) { fprintf(stderr, "kernel_launch: bad args n_in %d ws %zu need %zu\n", n_in, ws_size, (size_t)WS_NEED); return; }
    Params p{};
    const float** pp = (const float**)&p;
    for (int i = 0; i < 38; ++i) pp[i] = (const float*)d_in[i];
    p.out = (float*)d_out; p.ws = (char*)d_ws;
    static int cus = 0;
    if (!cus) { int dev = 0; hipGetDevice(&dev); hipDeviceGetAttribute(&cus, hipDeviceAttributeMultiprocessorCount, dev); if (cus <= 0) cus = 256; }
    const int grid = cus;
#if ONE_LAUNCH
    hipFuncSetAttribute((const void*)mega, hipFuncAttributeMaxDynamicSharedMemorySize, LDS_BYTES + 16);
    hipMemsetAsync(d_ws, 0, 16384, stream);
    hipLaunchKernelGGL(mega, dim3(grid), dim3(NTHR), LDS_BYTES + 16, stream, p);
#else
    hipMemsetAsync(d_ws, 0, 16384, stream);
#define LAUNCH(PH, L) do { hipFuncSetAttribute((const void*)kph<PH>, hipFuncAttributeMaxDynamicSharedMemorySize, LDS_BYTES + 16); hipLaunchKernelGGL(kph<PH>, dim3(grid), dim3(NTHR), LDS_BYTES + 16, stream, p, L); } while (0)
    LAUNCH(PH_INIT, 0);
    for (int layer = 0; layer < 4; ++layer) {
        if ((layer & 1) == 0) { LAUNCH(PH_A_NORM, layer); LAUNCH(PH_A_Z, layer); LAUNCH(PH_A_MID, layer); LAUNCH(PH_A_QKV, layer); LAUNCH(PH_A_ATTN, layer); LAUNCH(PH_A_WO, layer); }
        else { LAUNCH(PH_R_XS, layer); LAUNCH(PH_R_G1, layer); LAUNCH(PH_R_G2, layer); LAUNCH(PH_R_SC1, layer); LAUNCH(PH_R_SC2, layer); LAUNCH(PH_R_OUT, layer); LAUNCH(PH_R_WO, layer); }
        LAUNCH(PH_M_NORM, layer); LAUNCH(PH_M_SEL, layer); LAUNCH(PH_M_G1, layer); LAUNCH(PH_M_G2, layer); if ((layer & 1) == 0) LAUNCH(PH_M_COMB, layer);
    }
    LAUNCH(PH_FINAL, 0);
#endif
}
```

```cpp
#include <hip/hip_runtime.h>
#include <stdint.h>
#include <stdio.h>

#ifndef ONE_LAUNCH
#define ONE_LAUNCH 1
#endif

#define NTHR 512
typedef unsigned short bf16_t;
typedef short bf16x8 __attribute__((ext_vector_type(8)));
typedef float f32x4 __attribute__((ext_vector_type(4)));
typedef unsigned u32x4 __attribute__((ext_vector_type(4)));
typedef unsigned u32x2 __attribute__((ext_vector_type(2)));

constexpr int D = 1024, NB = 4, TL = 4096, TC = 256, NLAT = NB * TL, NCTX = NB * TC, NROW = NLAT + NCTX;
constexpr int TK = TL + TC;
constexpr int NE = 16, FF = 1408, CAPL = 512, CAPC = 32, ESLOTS = NB * CAPL + NB * CAPC;
constexpr int EPAD = 2304;
constexpr float RMS_EPS = 1e-6f, LNX_EPS = 64e-5f;
constexpr float ATT_SCALE = 0.07216878364870322f;

constexpr size_t al256(size_t x) { return (x + 255) / 256 * 256; }
constexpr size_t OFF_BAR = 0;
constexpr size_t OFF_QUEUE = 14336;
constexpr size_t OFF_MOD = 16384;
constexpr size_t OFF_ROPE_C = OFF_MOD + al256(4 * 5 * 6144 * 4);
constexpr size_t OFF_ROPE_S = OFF_ROPE_C + al256(TL * 32 * 4);
constexpr size_t OFF_X = OFF_ROPE_S + al256(TL * 32 * 4);
constexpr size_t SZ_F32 = (size_t)NROW * D * 4, SZ_BF = (size_t)NROW * D * 2;
constexpr size_t OFF_VFIRST = OFF_X + SZ_BF;
constexpr size_t OFF_H = OFF_VFIRST + SZ_BF;
constexpr size_t SZ_WMLA = (size_t)(512 * 1024 + 1536 * 256 + 2048 * 256 + 1024 * 1024) * 2;
constexpr size_t WM_IN = 0, WM_UQ = (size_t)512 * 1024 * 2, WM_UKV = WM_UQ + (size_t)1536 * 256 * 2, WM_O = WM_UKV + (size_t)2048 * 256 * 2;
constexpr size_t SZ_WRW = (size_t)(3 * 1024 * 1024 + 4 * 256 * 1024 + 1024 * 1024 + 4096 * 256 + 2048 * 256) * 2;
constexpr size_t WR_RKV = 0, WR_L = (size_t)3 * 1024 * 1024 * 2, WR_O = WR_L + (size_t)4 * 256 * 1024 * 2, WR_B2 = WR_O + (size_t)1024 * 1024 * 2, WR_B3 = WR_B2 + (size_t)4096 * 256 * 2;
constexpr size_t OFF_WMLA = OFF_H + SZ_BF;
constexpr size_t OFF_WRW = OFF_WMLA + 2 * SZ_WMLA;
constexpr size_t OFF_W13T = OFF_WRW + 2 * SZ_WRW;
constexpr size_t OFF_W2T = OFF_W13T + (size_t)NE * 2816 * D * 2;
constexpr size_t SZ_WMOE = (size_t)NE * 2816 * D * 2 + (size_t)NE * D * FF * 2;
constexpr size_t OFF_S = OFF_W13T + 2 * SZ_WMOE;
constexpr size_t OFF_Z = OFF_S;
constexpr size_t OFF_CQN = OFF_Z + al256((size_t)NROW * 512 * 4);
constexpr size_t OFF_CKVN = OFF_CQN + al256((size_t)NROW * 256 * 2);
constexpr size_t OFF_KR = OFF_CKVN + al256((size_t)NROW * 256 * 2);
constexpr size_t OFF_QRAW = OFF_KR + al256((size_t)NROW * 64 * 4);
constexpr size_t OFF_KVRAW = OFF_QRAW + al256((size_t)NROW * 1536 * 4);
constexpr size_t OFF_Q = OFF_KVRAW + al256((size_t)NROW * 2048 * 4);
constexpr size_t OFF_K = OFF_Q + al256((size_t)NB * 8 * TK * 192 * 2);
constexpr size_t OFF_V = OFF_K + al256((size_t)NB * 8 * TK * 192 * 2);
constexpr size_t OFF_O = OFF_V + al256((size_t)NB * 8 * TK * 128 * 2);
constexpr size_t END_MLA = OFF_O + SZ_BF;
constexpr size_t OFF_XS = OFF_S;
constexpr size_t OFF_RKV = OFF_XS + 6 * SZ_BF;
constexpr size_t OFF_W = OFF_RKV + 3 * SZ_BF;
constexpr size_t OFF_AV = OFF_W + 2 * SZ_F32;
constexpr size_t OFF_G = OFF_AV + 2 * SZ_BF;
constexpr size_t OFF_A2 = OFF_G + SZ_BF;
constexpr size_t OFF_A3 = OFF_A2 + al256((size_t)NROW * 256 * 2);
constexpr size_t END_RW = OFF_A3 + al256((size_t)NROW * 256 * 2);
constexpr size_t OFF_Y = OFF_XS;
constexpr int NCHK = (TC + TL) / 64;
constexpr size_t OFF_CK = END_RW;
constexpr size_t OFF_BS = OFF_CK + (size_t)128 * NCHK * 4 * 4096 * 2;
constexpr size_t END_RW2 = OFF_BS + (size_t)2 * NROW * 16 * 4;
constexpr size_t OFF_AFF = OFF_S;
constexpr size_t OFF_ROWIDX = OFF_AFF + al256((size_t)NROW * 16 * 4);
constexpr size_t OFF_GATE = OFF_ROWIDX + al256((size_t)NE * ESLOTS * 4);
constexpr size_t OFF_SLOT = OFF_GATE + al256((size_t)NE * EPAD * 4);
constexpr size_t OFF_XE = OFF_SLOT + al256((size_t)NROW * 16 * 4);
constexpr size_t OFF_HID = OFF_XE + al256((size_t)NE * EPAD * D * 2);
constexpr size_t OFF_YE = OFF_HID + al256((size_t)NE * EPAD * FF * 2);
constexpr size_t END_MOE = OFF_YE + al256((size_t)NE * EPAD * D * 2);
constexpr size_t WS_NEED = END_RW2 > END_MLA ? (END_RW2 > END_MOE ? END_RW2 : END_MOE) : (END_MLA > END_MOE ? END_MLA : END_MOE);

constexpr int LDS_BYTES = 152064;

struct Params {
    const float *x, *c, *ctx, *c_ctx, *mod_w, *mod_b, *norm1_g, *norm2_g, *final_g;
    const float *mla_w_in, *mla_g_q, *mla_g_kv, *mla_w_uq, *mla_w_ukv, *mla_w_o;
    const float *rw_mu, *rw_w_rkv, *rw_w0, *rw_w1, *rw_w2, *rw_a0, *rw_a1, *rw_a2, *rw_v0, *rw_v1, *rw_v2, *rw_g1, *rw_g2, *rw_k_k, *rw_k_a, *rw_r_k, *rw_lnx_g, *rw_lnx_b, *rw_w_o;
    const float *moe_router, *moe_w1, *moe_w3, *moe_w2;
    float* out; char* ws;
    int wv, pad_;
};

__device__ __forceinline__ int bidx() { int t = blockIdx.x; asm volatile("" : "+s"(t)); return t; }
__device__ __forceinline__ int gdim() { int t = gridDim.x; asm volatile("" : "+s"(t)); return t; }
__device__ __forceinline__ int tidx_w(int wv) { int l; asm volatile("v_mbcnt_lo_u32_b32 %0, -1, 0\n\tv_mbcnt_hi_u32_b32 %0, -1, %0" : "=v"(l)); return (wv << 6) | l; }
#define tidx() tidx_w(p.wv)
#define XB_TMO      128
#define XB_XCNT(j)  (256  + 64 * (j))
#define XB_XSUB(j)  (1280 + 64 * (j))
#define XB_XGEN(j)  (2304 + 64 * (j))
#define XB_TOP      3328
#define XB_TOPGEN   3392
#define XCD_BAR_WORDS 3456
#define XB_SPIN_CAP (1u << 22)
#define LAS __attribute__((address_space(3)))

__device__ __forceinline__ unsigned xb_ld(unsigned* p)              { return __hip_atomic_load(p, __ATOMIC_RELAXED, __HIP_MEMORY_SCOPE_AGENT); }
__device__ __forceinline__ unsigned xb_add(unsigned* p, unsigned v) { return __hip_atomic_fetch_add(p, v, __ATOMIC_RELAXED, __HIP_MEMORY_SCOPE_AGENT); }
__device__ __forceinline__ unsigned xb_xcc_id() { return (unsigned)__builtin_amdgcn_s_getreg((3 << 11) | 20) & 0xFu; }
#define XB_SPIN(cond, bar) do { unsigned _sp = 0; while (cond) { __builtin_amdgcn_s_sleep(1); \
    if ((++_sp & 255u) == 0u) { if (xb_ld(&(bar)[XB_TMO])) break; if (_sp > XB_SPIN_CAP) { atomicAdd(&(bar)[XB_TMO], 1u); break; } } } } while (0)

struct XcdBarrier { unsigned* bar; unsigned x; volatile LAS unsigned* st; };

__device__ __forceinline__ XcdBarrier xcd_barrier_post(unsigned* bar, volatile LAS unsigned* st) {
    XcdBarrier b; b.bar = bar; b.x = xb_xcc_id(); b.st = st;
    if (threadIdx.x == 0) (void)xb_add(&bar[XB_XCNT(b.x)], 1u);
    return b;
}
__device__ __forceinline__ void xcd_barrier_complete(unsigned* bar, unsigned x, unsigned& nloc, unsigned& nx) {
    const unsigned G = gridDim.x * gridDim.y * gridDim.z;
    unsigned sum, cnt, mine, sp = 0u;
    for (;;) {
        sum = 0u; cnt = 0u; mine = 0u;
#pragma unroll
        for (unsigned j = 0; j < 16; ++j) { const unsigned c = xb_ld(&bar[XB_XCNT(j)]); sum += c; cnt += (c > 0u) ? 1u : 0u; mine = (j == x) ? c : mine; }
        if (sum == G) break;
        __builtin_amdgcn_s_sleep(1);
        if ((++sp & 255u) == 0u) { if (xb_ld(&bar[XB_TMO])) break; if (sp > XB_SPIN_CAP) { atomicAdd(&bar[XB_TMO], 1u); break; } }
    }
    nloc = mine > 0u ? mine : 1u; nx = cnt > 0u ? cnt : 1u;
}
__device__ __forceinline__ void xcd_barrier(const XcdBarrier& b) {
    asm volatile("s_waitcnt vmcnt(0)" ::: "memory");
    __syncthreads();
    if (threadIdx.x == 0) {
        unsigned* bar = b.bar;
        __builtin_amdgcn_s_waitcnt(0);
        unsigned nloc = b.st[0], nx = b.st[1];
        if (nloc == 0u) { xcd_barrier_complete(bar, b.x, nloc, nx); b.st[0] = nloc; b.st[1] = nx; }
        const unsigned old = xb_add(&bar[XB_XSUB(b.x)], 1u);
        const unsigned gen = old / nloc;
        if (old + 1u == (gen + 1u) * nloc) {
            __builtin_amdgcn_fence(__ATOMIC_RELEASE, "agent");
            asm volatile("s_waitcnt vmcnt(0)" ::: "memory");
            const unsigned og = xb_add(&bar[XB_TOP], 1u);
            const unsigned tg = og / nx;
            if (og + 1u == (tg + 1u) * nx) xb_add(&bar[XB_TOPGEN], 1u);
            else XB_SPIN(xb_ld(&bar[XB_TOPGEN]) == tg, bar);
            __builtin_amdgcn_fence(__ATOMIC_ACQUIRE, "agent");
            xb_add(&bar[XB_XGEN(b.x)], 1u);
            asm volatile("s_waitcnt vmcnt(0)" ::: "memory");
        } else {
            XB_SPIN(xb_ld(&bar[XB_XGEN(b.x)]) == gen, bar);
            __builtin_amdgcn_fence(__ATOMIC_ACQUIRE, "agent");
            asm volatile("s_waitcnt vmcnt(0)" ::: "memory");
        }
    }
    __syncthreads();
}

__device__ __forceinline__ float bf2f(bf16_t b) { return __uint_as_float(((unsigned)b) << 16); }
typedef float f32x2_ __attribute__((ext_vector_type(2)));
typedef __bf16 bf16x2_ __attribute__((ext_vector_type(2)));
__device__ __forceinline__ unsigned pk2(float lo, float hi) { const f32x2_ v = {lo, hi}; return __builtin_bit_cast(unsigned, __builtin_convertvector(v, bf16x2_)); }
__device__ __forceinline__ bf16_t f2bf(float f) { return (bf16_t)(pk2(f, f) & 0xffffu); }
__device__ __forceinline__ float dpp_sum16(float x) {
    x += __builtin_bit_cast(float, __builtin_amdgcn_update_dpp(0, __builtin_bit_cast(int, x), 0xB1, 0xF, 0xF, true));
    x += __builtin_bit_cast(float, __builtin_amdgcn_update_dpp(0, __builtin_bit_cast(int, x), 0x4E, 0xF, 0xF, true));
    x += __builtin_bit_cast(float, __builtin_amdgcn_update_dpp(0, __builtin_bit_cast(int, x), 0x141, 0xF, 0xF, true));
    x += __builtin_bit_cast(float, __builtin_amdgcn_update_dpp(0, __builtin_bit_cast(int, x), 0x140, 0xF, 0xF, true));
    return x;
}
__device__ __forceinline__ f32x4 ldbf4(const bf16_t* p) { const uint2 w = *(const uint2*)p; return (f32x4){__uint_as_float(w.x << 16), __uint_as_float(w.x & 0xffff0000u), __uint_as_float(w.y << 16), __uint_as_float(w.y & 0xffff0000u)}; }
__device__ __forceinline__ void stbf4(bf16_t* p, f32x4 v) { uint2 w; w.x = pk2(v[0], v[1]); w.y = pk2(v[2], v[3]); *(uint2*)p = w; }
typedef bf16_t xt_t;
__device__ __forceinline__ f32x4 xldv(const xt_t* X, size_t i) { return ldbf4(X + i); }
__device__ __forceinline__ void xstv(xt_t* X, size_t i, f32x4 v) { stbf4(X + i, v); }
__device__ __forceinline__ float4 xld(const xt_t* X, size_t i) { const f32x4 v = ldbf4(X + i); return make_float4(v[0], v[1], v[2], v[3]); }
__device__ __forceinline__ void xst(xt_t* X, size_t i, float4 v) { stbf4(X + i, (f32x4){v.x, v.y, v.z, v.w}); }
__device__ __forceinline__ float wave_sum(float v) {
    v = dpp_sum16(v); const int i = __builtin_bit_cast(int, v);
    return __builtin_bit_cast(float, __builtin_amdgcn_readlane(i, 0)) + __builtin_bit_cast(float, __builtin_amdgcn_readlane(i, 16)) + __builtin_bit_cast(float, __builtin_amdgcn_readlane(i, 32)) + __builtin_bit_cast(float, __builtin_amdgcn_readlane(i, 48));
}
__device__ __forceinline__ float sigmoidf_(float x) { return __builtin_amdgcn_rcpf(1.f + __expf(-x)); }
__device__ __forceinline__ int row_stream(int row) { return row < NLAT ? (row >> 12) : 4; }
__device__ __forceinline__ const float* modp(const Params& p, int layer, int s, int part) { return (const float*)(p.ws + OFF_MOD) + ((size_t)layer * 5 + s) * 6144 + part * 1024; }

struct SgArgs { const bf16_t* A; int lda; size_t strideA; const float* B; int ldb; size_t strideB; int M, N, K, nbatch; };
template <class Epi>
__device__ __forceinline__ void sg_gemm(const Params& p, char* lds, const SgArgs g, const Epi& epi) {
    bf16_t* As = (bf16_t*)lds;
    bf16_t* Bs = As + 128 * 40;
    const int tid = tidx(), wid = tid >> 6, lane = tid & 63;
    const int wr = wid >> 2, wc = wid & 3;
    const int tilesN = (g.N + 127) / 128, tilesM = g.M / 128, per = tilesM * tilesN, ntiles = per * g.nbatch;
    const int ar = tid >> 2, ak = (tid & 3) * 8;
    const int bn = tid & 127, bk = (tid >> 7) * 8;
    for (int tile = bidx(); tile < ntiles; tile += gdim()) {
        const int bt = tile / per, tt = tile % per;
        const int tm = tt / tilesN, tn = tt % tilesN;
        const int m0 = tm * 128, n0 = tn * 128;
        f32x4 acc[4][2];
#pragma unroll
        for (int m = 0; m < 4; ++m)
#pragma unroll
            for (int n = 0; n < 2; ++n) acc[m][n] = (f32x4){0.f, 0.f, 0.f, 0.f};
        const bool bvalid = (n0 + bn) < g.N;
        const bf16_t* ap = g.A + bt * g.strideA + (size_t)(m0 + ar) * g.lda + ak;
        const float* bp = g.B + bt * g.strideB + (size_t)bk * g.ldb + n0 + bn;
        bf16x8 areg; float breg[8];
        areg = *(const bf16x8*)ap;
#pragma unroll
        for (int j = 0; j < 8; ++j) breg[j] = bvalid ? bp[(size_t)j * g.ldb] : 0.f;
        for (int k0 = 0; k0 < g.K; k0 += 32) {
            __syncthreads();
            *(bf16x8*)(As + ar * 40 + ak) = areg;
            { u32x4 w; w.x = pk2(breg[0], breg[1]); w.y = pk2(breg[2], breg[3]); w.z = pk2(breg[4], breg[5]); w.w = pk2(breg[6], breg[7]); *(u32x4*)(Bs + bn * 40 + bk) = w; }
            __syncthreads();
            if (k0 + 32 < g.K) {
                areg = *(const bf16x8*)(ap + k0 + 32);
#pragma unroll
                for (int j = 0; j < 8; ++j) breg[j] = bvalid ? bp[(size_t)(k0 + 32 + j) * g.ldb] : 0.f;
            }
            bf16x8 af[4], bfr[2];
#pragma unroll
            for (int m = 0; m < 4; ++m) af[m] = *(const bf16x8*)(As + (wr * 64 + m * 16 + (lane & 15)) * 40 + (lane >> 4) * 8);
#pragma unroll
            for (int n = 0; n < 2; ++n) bfr[n] = *(const bf16x8*)(Bs + (wc * 32 + n * 16 + (lane & 15)) * 40 + (lane >> 4) * 8);
#pragma unroll
            for (int m = 0; m < 4; ++m)
#pragma unroll
                for (int n = 0; n < 2; ++n) acc[m][n] = __builtin_amdgcn_mfma_f32_16x16x32_bf16(af[m], bfr[n], acc[m][n], 0, 0, 0);
        }
#pragma unroll
        for (int m = 0; m < 4; ++m)
#pragma unroll
            for (int n = 0; n < 2; ++n) {
                const int col = n0 + wc * 32 + n * 16 + (lane & 15);
                if (col < g.N) {
#pragma unroll
                    for (int r = 0; r < 4; ++r) epi(bt, m0 + wr * 64 + m * 16 + (lane >> 4) * 4 + r, col, acc[m][n][r]);
                }
            }
    }
}


namespace g8 {
#define PG8_LAS __attribute__((address_space(3)))
constexpr int BM = 256, BK = 64, HALF = 128, HTB = HALF * BK * 2, STAGE_BYTES = 8 * HTB;
__device__ __forceinline__ int lds_byte(int r, int c) { const int st = (r >> 4) * 2 + (c >> 5), rr = r & 15, cc = c & 31, ob = rr * 64 + cc * 2; return st * 1024 + (ob ^ (((ob >> 9) & 1) << 5)); }
__device__ __forceinline__ void stage_rc(int b, int& R, int& C) { const int st = b / 1024, sb = b % 1024, swz = sb ^ (((sb >> 9) & 1) << 5); R = (st >> 1) * 16 + swz / 64; C = (st & 1) * 32 + (swz % 64) / 2; }
struct Unit { int pm, pn, g; const char* A; const char* B; };
__device__ __forceinline__ int xcd_remap(int L, int nwg) { const int q = nwg / 8, r = nwg % 8, xcd = L % 8, off = L / 8; return (xcd < r ? xcd * (q + 1) : r * (q + 1) + (xcd - r) * q) + off; }

template <class Epi, class Sched>
__device__ __forceinline__ void gemm_phase(const int wv_, PG8_LAS unsigned char* lds, const int K, const Sched& S, const Epi& E) {
    const int tid = tidx_w(wv_), wid = __builtin_amdgcn_readfirstlane(tid >> 6), lane = tid & 63, wr = wid >> 2, wc = wid & 3, fr = lane & 15, fq = lane >> 4;
    const int nt = K / BK;
    unsigned voffA[2];
#pragma unroll
    for (int i = 0; i < 2; ++i) { int R, C; stage_rc(tid * 16 + i * 8192, R, C); voffA[i] = (unsigned)(R * K + C) * 2u; }
    const size_t kstep = (size_t)(BK * 2);
    const size_t hstep = (size_t)HALF * K * 2;
    const unsigned ldsw = (unsigned)wid * 1024u;
    const int aoff = lds_byte(wr * 64 + fr, fq * 8), boff = lds_byte(wc * 32 + fr, fq * 8);
#define PG8_SA(b, h) (((b) * 2 + (h)) * HTB)
#define PG8_SB(b, h) ((4 + (b) * 2 + (h)) * HTB)
#define PG8_STAGE(bufoff, gbase, voff) do { _Pragma("unroll") for (int _i = 0; _i < 2; ++_i) \
        __builtin_amdgcn_global_load_lds((const unsigned*)((const char*)(gbase) + (voff)[_i]), (PG8_LAS unsigned*)(lds + (bufoff) + ldsw + _i * 8192), 16, 0, 0); } while (0)
#define PG8_LDA(dst, b, h) do { _Pragma("unroll") for (int m = 0; m < 4; ++m) _Pragma("unroll") for (int k = 0; k < 2; ++k) dst[m][k] = *(const PG8_LAS bf16x8*)(lds + PG8_SA(b, h) + aoff + m * 2048 + k * 1024); } while (0)
#define PG8_LDB(dst, b, h) do { _Pragma("unroll") for (int n = 0; n < 2; ++n) _Pragma("unroll") for (int k = 0; k < 2; ++k) dst[n][k] = *(const PG8_LAS bf16x8*)(lds + PG8_SB(b, h) + boff + n * 2048 + k * 1024); } while (0)
#define PG8_MMA(ai, bj, At, Bt) do { __builtin_amdgcn_s_setprio(1); _Pragma("unroll") for (int m = 0; m < 4; ++m) _Pragma("unroll") for (int n = 0; n < 2; ++n) _Pragma("unroll") for (int k = 0; k < 2; ++k) \
        acc[ai][bj][m][n] = __builtin_amdgcn_mfma_f32_16x16x32_bf16(Bt[n][k], At[m][k], acc[ai][bj][m][n], 0, 0, 0); __builtin_amdgcn_s_setprio(0); } while (0)
#define PG8_WAIT_V(n) asm volatile("s_waitcnt vmcnt(" #n ")" ::: "memory")
#define PG8_WAIT_L(n) asm volatile("s_waitcnt lgkmcnt(" #n ")" ::: "memory")
#define PG8_BAR __builtin_amdgcn_s_barrier()
#define PG8_SCHED __builtin_amdgcn_sched_barrier(0)
    Unit cur, nxt; int ui = 0;
    if (!S.next(0, cur)) return;
    f32x4 acc[2][2][4][2];
#pragma unroll
    for (int a = 0; a < 2; ++a)
#pragma unroll
        for (int b = 0; b < 2; ++b)
#pragma unroll
            for (int m = 0; m < 4; ++m)
#pragma unroll
                for (int n = 0; n < 2; ++n) acc[a][b][m][n] = (f32x4){0.f, 0.f, 0.f, 0.f};
    bf16x8 At[4][2], B0[2][2], B1[2][2];
    const char* cA = cur.A; const char* cB = cur.B;
    PG8_STAGE(PG8_SB(0, 0), cB, voffA); PG8_STAGE(PG8_SA(0, 0), cA, voffA); PG8_STAGE(PG8_SB(0, 1), cB + hstep, voffA); PG8_STAGE(PG8_SA(0, 1), cA + hstep, voffA);
    if (wr == 1) PG8_BAR;
    PG8_WAIT_V(4); PG8_BAR;
    PG8_STAGE(PG8_SB(1, 0), cB + kstep, voffA); PG8_STAGE(PG8_SA(1, 0), cA + kstep, voffA); PG8_STAGE(PG8_SB(1, 1), cB + hstep + kstep, voffA);
    PG8_WAIT_V(6); PG8_BAR;
    for (;;) {
        const bool has_next = S.next(ui + 1, nxt);
        const char* nA = has_next ? nxt.A : cA; const char* nB = has_next ? nxt.B : cB;
        for (int t = 0; t < nt; t += 2) {
            const bool last = (t == nt - 2);
            const char* a1 = cA + (size_t)(t + 1) * kstep;
            const char* a2 = last ? nA : cA + (size_t)(t + 2) * kstep; const char* b2 = last ? nB : cB + (size_t)(t + 2) * kstep;
            const char* a3 = a2 + kstep; const char* b3 = b2 + kstep;
            PG8_LDB(B0, 0, 0); PG8_SCHED; PG8_LDA(At, 0, 0); PG8_STAGE(PG8_SA(1, 1), a1 + hstep, voffA);
            PG8_WAIT_L(8); PG8_BAR; PG8_WAIT_L(0); PG8_MMA(0, 0, At, B0); PG8_BAR; PG8_SCHED;
            PG8_LDB(B1, 0, 1); PG8_STAGE(PG8_SB(0, 0), b2, voffA);
            PG8_BAR; PG8_WAIT_L(0); PG8_MMA(0, 1, At, B1); PG8_BAR;
            PG8_LDA(At, 0, 1); PG8_STAGE(PG8_SA(0, 0), a2, voffA);
            PG8_BAR; PG8_WAIT_L(0); PG8_MMA(1, 0, At, B0); PG8_BAR; PG8_SCHED;
            PG8_STAGE(PG8_SB(0, 1), b2 + hstep, voffA);
            PG8_WAIT_V(6); PG8_BAR; PG8_MMA(1, 1, At, B1); PG8_BAR;
            PG8_LDB(B0, 1, 0); PG8_SCHED; PG8_LDA(At, 1, 0); PG8_STAGE(PG8_SA(0, 1), a2 + hstep, voffA);
            PG8_WAIT_L(8); PG8_BAR; PG8_WAIT_L(0); PG8_MMA(0, 0, At, B0); PG8_BAR; PG8_SCHED;
            PG8_LDB(B1, 1, 1); PG8_STAGE(PG8_SB(1, 0), b3, voffA);
            PG8_BAR; PG8_WAIT_L(0); PG8_MMA(0, 1, At, B1); PG8_BAR;
            PG8_LDA(At, 1, 1); PG8_STAGE(PG8_SA(1, 0), a3, voffA);
            PG8_BAR; PG8_WAIT_L(0); PG8_MMA(1, 0, At, B0); PG8_BAR; PG8_SCHED;
            PG8_STAGE(PG8_SB(1, 1), b3 + hstep, voffA);
            PG8_WAIT_V(6); PG8_BAR; PG8_MMA(1, 1, At, B1); PG8_BAR;
        }
        E(acc, cur, wr, wc, fr, fq);
        if (!has_next) break;
#pragma unroll
        for (int a = 0; a < 2; ++a)
#pragma unroll
            for (int b = 0; b < 2; ++b)
#pragma unroll
                for (int m = 0; m < 4; ++m)
#pragma unroll
                    for (int n = 0; n < 2; ++n) acc[a][b][m][n] = (f32x4){0.f, 0.f, 0.f, 0.f};
        cur = nxt; cA = nA; cB = nB; ++ui;
    }
    PG8_WAIT_V(0);
    if (wr == 0) PG8_BAR;
    PG8_BAR;
#undef PG8_SA
#undef PG8_SB
#undef PG8_STAGE
#undef PG8_LDA
#undef PG8_LDB
#undef PG8_MMA
#undef PG8_WAIT_V
#undef PG8_WAIT_L
#undef PG8_BAR
#undef PG8_SCHED
}
template <class F> struct EpiRC { F f;
    __device__ __forceinline__ void operator()(const f32x4 (&acc)[2][2][4][2], const Unit& u, int wr, int wc, int fr, int fq) const {
#pragma unroll
        for (int ai = 0; ai < 2; ++ai)
#pragma unroll
            for (int m = 0; m < 4; ++m) { const int row = u.pm * BM + ai * HALF + wr * 64 + m * 16 + fr;
#pragma unroll
                for (int bj = 0; bj < 2; ++bj)
#pragma unroll
                    for (int n = 0; n < 2; ++n) f(u, row, u.pn * BM + bj * HALF + wc * 32 + n * 16 + 4 * fq, acc[ai][bj][m][n]);
                asm volatile("" ::: "memory"); }
    } };
template <class F> __device__ __forceinline__ EpiRC<F> epi_rc(const F& f) { return EpiRC<F>{f}; }
template <class F> struct EpiPair { F f;
    __device__ __forceinline__ void operator()(const f32x4 (&acc)[2][2][4][2], const Unit& u, int wr, int wc, int fr, int fq) const {
#pragma unroll
        for (int ai = 0; ai < 2; ++ai)
#pragma unroll
            for (int m = 0; m < 4; ++m) { const int row = u.pm * BM + ai * HALF + wr * 64 + m * 16 + fr;
#pragma unroll
                for (int n = 0; n < 2; ++n) f(u, row, u.pn * HALF + wc * 32 + n * 16 + 4 * fq, acc[ai][0][m][n], acc[ai][1][m][n]);
                asm volatile("" ::: "memory"); }
    } };
template <class F> __device__ __forceinline__ EpiPair<F> epi_pair(const F& f) { return EpiPair<F>{f}; }
template <class F, class CF, class RF> struct EpiPre { F f; CF cf; RF rf;
    __device__ __forceinline__ void operator()(const f32x4 (&acc)[2][2][4][2], const Unit& u, int wr, int wc, int fr, int fq) const {
        f32x4 cv[2][2]; float rv[2][4];
#pragma unroll
        for (int bj = 0; bj < 2; ++bj)
#pragma unroll
            for (int n = 0; n < 2; ++n) cv[bj][n] = cf(u, u.pn * BM + bj * HALF + wc * 32 + n * 16 + 4 * fq);
#pragma unroll
        for (int ai = 0; ai < 2; ++ai)
#pragma unroll
            for (int m = 0; m < 4; ++m) rv[ai][m] = rf(u, u.pm * BM + ai * HALF + wr * 64 + m * 16 + fr);
#pragma unroll
        for (int ai = 0; ai < 2; ++ai)
#pragma unroll
            for (int m = 0; m < 4; ++m) { const int row = u.pm * BM + ai * HALF + wr * 64 + m * 16 + fr;
#pragma unroll
                for (int bj = 0; bj < 2; ++bj)
#pragma unroll
                    for (int n = 0; n < 2; ++n) f(u, row, u.pn * BM + bj * HALF + wc * 32 + n * 16 + 4 * fq, acc[ai][bj][m][n], cv[bj][n], rv[ai][m]);
                asm volatile("" ::: "memory"); }
    } };
template <class F, class CF, class RF> __device__ __forceinline__ EpiPre<F, CF, RF> epi_pre(const F& f, const CF& cf, const RF& rf) { return EpiPre<F, CF, RF>{f, cf, rf}; }
template <class F, class CF> struct EpiColFirst { F f; CF cf;
    __device__ __forceinline__ void operator()(const f32x4 (&acc)[2][2][4][2], const Unit& u, int wr, int wc, int fr, int fq) const {
#pragma unroll
        for (int bj = 0; bj < 2; ++bj)
#pragma unroll
            for (int n = 0; n < 2; ++n) { const int col = u.pn * BM + bj * HALF + wc * 32 + n * 16 + 4 * fq; const f32x4 cv = cf(u, col);
#pragma unroll
                for (int ai = 0; ai < 2; ++ai)
#pragma unroll
                    for (int m = 0; m < 4; ++m) f(u, u.pm * BM + ai * HALF + wr * 64 + m * 16 + fr, col, acc[ai][bj][m][n], cv);
                asm volatile("" ::: "memory"); }
    } };
template <class F, class CF> __device__ __forceinline__ EpiColFirst<F, CF> epi_colfirst(const F& f, const CF& cf) { return EpiColFirst<F, CF>{f, cf}; }
struct EpiResid { xt_t* X; const float* MOD; int layer;
    __device__ __forceinline__ void operator()(const f32x4 (&acc)[2][2][4][2], const Unit& u, int wr, int wc, int fr, int fq) const {
        const int row0 = u.pm * BM + wr * 64 + fr, col0 = u.pn * BM + wc * 32 + 4 * fq;
        const int strm = row0 < NLAT ? (row0 >> 12) : 4;
        const float* gp = MOD + ((size_t)layer * 5 + strm) * 6144 + 2048 + col0;
        f32x4 gt[2][2];
#pragma unroll
        for (int bj = 0; bj < 2; ++bj)
#pragma unroll
            for (int n = 0; n < 2; ++n) gt[bj][n] = *(const f32x4*)(gp + bj * HALF + n * 16);
#pragma unroll
        for (int ai = 0; ai < 2; ++ai) {
            f32x4 xv[4][2][2];
#pragma unroll
            for (int m = 0; m < 4; ++m)
#pragma unroll
                for (int bj = 0; bj < 2; ++bj)
#pragma unroll
                    for (int n = 0; n < 2; ++n) xv[m][bj][n] = xldv(X, (size_t)(row0 + ai * HALF + m * 16) * D + col0 + bj * HALF + n * 16);
#pragma unroll
            for (int m = 0; m < 4; ++m)
#pragma unroll
                for (int bj = 0; bj < 2; ++bj)
#pragma unroll
                    for (int n = 0; n < 2; ++n) xstv(X, (size_t)(row0 + ai * HALF + m * 16) * D + col0 + bj * HALF + n * 16, xv[m][bj][n] + gt[bj][n] * acc[ai][bj][m][n]);
            asm volatile("" ::: "memory");
        }
    } };
struct BatchSched { const char* A; const char* B; size_t strideA, strideB; int nM, nN, nb, K; int rev = 0;
    __device__ __forceinline__ bool next(int i, Unit& u) const {
        const int nwg = nM * nN * nb; const int L = i * gdim() + (rev ? gdim() - 1 - bidx() : bidx()); if (L >= nwg) return false;
        const int w = xcd_remap(L, nwg); const int per = nM * nN; u.g = w / per; const int r = w % per; u.pm = r / nN; u.pn = r % nN;
        u.A = A + u.g * strideA + (size_t)u.pm * BM * K * 2; u.B = B + u.g * strideB + (size_t)u.pn * BM * K * 2; return true; } };
}

template <class SrcF, class DRow>
__device__ __forceinline__ int cvt_tiles(const int wv_, char* lds, bf16_t* dst, int Kd, int Nd, int nbatch, size_t dstride, const SrcF& src, const DRow& drow, int* rot = nullptr) {
    bf16_t* T = (bf16_t*)lds;
    const int tid = tidx_w(wv_);
    const int tk = Kd / 128, tn = Nd / 64, per = tk * tn, total = per * nbatch;
    {
        int first = bidx() - (rot ? *rot % gdim() : 0); if (first < 0) first += gdim();
        if (rot) *rot += total;
        for (int t = first; t < total; t += gdim()) {
            const int bt = t / per, r = t % per, k0 = (r % tk) * 128, n0 = (r / tk) * 64;
            float4 v[4];
#pragma unroll
            for (int i = 0; i < 4; ++i) { const int k = k0 + i * 32 + (tid >> 4), n = n0 + (tid & 15) * 4; const float* sp = src(bt, k, n); v[i] = sp ? *(const float4*)sp : make_float4(0.f, 0.f, 0.f, 0.f); }
            __syncthreads();
#pragma unroll
            for (int i = 0; i < 4; ++i) { const int k = i * 32 + (tid >> 4), n = (tid & 15) * 4;
                T[(n + 0) * 136 + k] = f2bf(v[i].x); T[(n + 1) * 136 + k] = f2bf(v[i].y); T[(n + 2) * 136 + k] = f2bf(v[i].z); T[(n + 3) * 136 + k] = f2bf(v[i].w); }
            __syncthreads();
            { const int n = tid >> 3, kc = (tid & 7) * 16;
              const u32x4 a = *(const u32x4*)(T + n * 136 + kc), b = *(const u32x4*)(T + n * 136 + kc + 8);
              bf16_t* dp = dst + bt * dstride + (size_t)drow(n0 + n) * Kd + k0 + kc;
              *(u32x4*)dp = a; *(u32x4*)(dp + 8) = b; }
        }
    }
    return 0;
}
__device__ __forceinline__ int moe_cvt(const Params& p, int layer, char* lds, int budget) {
    constexpr int QG = 2, T13 = NE * 8 * 44, TOT = T13 + NE * 11 * 16;
    bf16_t* T = (bf16_t*)lds;
    int* qslot = (int*)(lds + 64 * 136 * 2);
    const int tid = tidx();
    const float* w1 = p.moe_w1 + (size_t)layer * NE * D * FF; const float* w3 = p.moe_w3 + (size_t)layer * NE * D * FF; const float* w2 = p.moe_w2 + (size_t)layer * NE * FF * D;
    bf16_t* W13 = (bf16_t*)(p.ws + OFF_W13T + (size_t)(layer & 1) * SZ_WMOE); bf16_t* W2 = (bf16_t*)(p.ws + OFF_W2T + (size_t)(layer & 1) * SZ_WMOE);
    unsigned* queue = (unsigned*)(p.ws + OFF_QUEUE) + layer * 32;
    const bool ahead = budget < 0;
    int done = 0, tnext = 0;
    __syncthreads();
    if (tid == 0) qslot[0] = QG * (int)__hip_atomic_fetch_add(queue, 1u, __ATOMIC_RELAXED, __HIP_MEMORY_SCOPE_AGENT);
    __syncthreads();
    int t0 = __builtin_amdgcn_readfirstlane(qslot[0]);
    while (t0 < TOT && (ahead || done < budget)) {
        const bool more = ahead || done + 1 < budget;
        if (more && tid == 0) tnext = QG * (int)__hip_atomic_fetch_add(queue, 1u, __ATOMIC_RELAXED, __HIP_MEMORY_SCOPE_AGENT);
#pragma unroll 1
        for (int sub = 0; sub < QG; ++sub) {
            const int t = t0 + sub;
            const float* sp; bf16_t* dp; int ss, ds;
            if (t < T13) { const int e = t / 352, r = t % 352, k0 = (r & 7) * 128, n0 = (r >> 3) * 64; const int c0 = (n0 >> 8) * 128 + (n0 & 127);
                sp = (((n0 >> 7) & 1) ? w3 : w1) + ((size_t)e * D + k0) * FF + c0; ss = FF; dp = W13 + ((size_t)e * 2816 + n0) * D + k0; ds = D; }
            else { const int u = t - T13, e = u / 176, r = u % 176, k0 = (r % 11) * 128, n0 = (r / 11) * 64;
                sp = w2 + ((size_t)e * FF + k0) * D + n0; ss = D; dp = W2 + ((size_t)e * D + n0) * FF + k0; ds = FF; }
            float4 v[4];
#pragma unroll
            for (int i = 0; i < 4; ++i) v[i] = *(const float4*)(sp + (size_t)(i * 32 + (tid >> 4)) * ss + (tid & 15) * 4);
            __syncthreads();
#pragma unroll
            for (int i = 0; i < 4; ++i) { const int k = i * 32 + (tid >> 4), n = (tid & 15) * 4;
                T[(n + 0) * 136 + k] = f2bf(v[i].x); T[(n + 1) * 136 + k] = f2bf(v[i].y); T[(n + 2) * 136 + k] = f2bf(v[i].z); T[(n + 3) * 136 + k] = f2bf(v[i].w); }
            if (sub == QG - 1 && tid == 0) qslot[0] = more ? tnext : TOT;
            __syncthreads();
            { const int n = tid >> 3, kc = (tid & 7) * 16;
              const u32x4 a = *(const u32x4*)(T + n * 136 + kc), b = *(const u32x4*)(T + n * 136 + kc + 8);
              bf16_t* o = dp + (size_t)n * ds + kc;
              *(u32x4*)o = a; *(u32x4*)(o + 8) = b; }
        }
        ++done; t0 = __builtin_amdgcn_readfirstlane(qslot[0]);
    }
    __syncthreads();
    return done;
}
__device__ __forceinline__ void bg_cvt(const Params& p, int layer, char* lds, int budget) {
#pragma unroll 1
    for (int l = layer; l < 4 && l <= layer + 1 && budget > 0; ++l) budget -= moe_cvt(p, l, lds, budget);
}
__device__ __forceinline__ bool idle_tail(int nunits) { const int r = nunits % gdim(); return r != 0 && bidx() >= r; }
__device__ void ph_init(const Params& p, char* lds) {
    const int tid = tidx(), gtid = bidx() * NTHR + tid, gsz = gdim() * NTHR;
    xt_t* Xs = (xt_t*)(p.ws + OFF_X);
    const float4* x4 = (const float4*)p.x; const float4* c4 = (const float4*)p.ctx;
    { constexpr int NQ = NROW * 256 / 4;
      auto srcv = [&](int k) { return k < NLAT * 256 ? x4[k] : c4[k - NLAT * 256]; };
      for (int i = gtid; i < NQ; i += gsz) { const float4 t0 = srcv(i), t1 = srcv(i + NQ), t2 = srcv(i + 2 * NQ), t3 = srcv(i + 3 * NQ); xst(Xs, (size_t)4 * i, t0); xst(Xs, (size_t)4 * (i + NQ), t1); xst(Xs, (size_t)4 * (i + 2 * NQ), t2); xst(Xs, (size_t)4 * (i + 3 * NQ), t3); } }
    float* rc = (float*)(p.ws + OFF_ROPE_C); float* rs = (float*)(p.ws + OFF_ROPE_S);
    for (int i = gtid; i < TL * 32; i += gsz) {
        const int t = i >> 5, f = i & 31; const float pos = (float)((f < 16) ? (t >> 6) : (t & 63));
        const float inv = powf(10000.f, -(float)(f & 15) / 16.f); const float ang = pos * inv; rc[2 * i] = cosf(ang); rc[2 * i + 1] = sinf(ang);
    }
    float* sc = (float*)lds;
    float* red = sc + 5 * 1024;
    for (int i = tid; i < 5 * 1024; i += NTHR) { const float v = i < 4096 ? p.c[i] : p.c_ctx[i - 4096]; sc[i] = v / (1.f + expf(-v)); }
    __syncthreads();
    float* MOD = (float*)(p.ws + OFF_MOD);
    for (int item = bidx(); item < 4 * 96; item += gdim()) {
        const int l = item / 96, cg = item % 96, col = tid & 63, n = cg * 64 + col, kg = tid >> 6;
        const float* w = p.mod_w + ((size_t)l * 1024 + kg * 128) * 6144 + n;
        float a0 = 0, a1 = 0, a2 = 0, a3 = 0, a4 = 0;
#pragma unroll 16
        for (int k = 0; k < 128; ++k) { const float wv = w[(size_t)k * 6144]; const int kk = kg * 128 + k;
            a0 += sc[kk] * wv; a1 += sc[1024 + kk] * wv; a2 += sc[2048 + kk] * wv; a3 += sc[3072 + kk] * wv; a4 += sc[4096 + kk] * wv; }
        float* rr = red + (kg * 64 + col) * 5; rr[0] = a0; rr[1] = a1; rr[2] = a2; rr[3] = a3; rr[4] = a4;
        __syncthreads();
        if (tid < 320) { const int c2 = tid & 63, s = tid >> 6; float sum = 0;
            for (int q = 0; q < 8; ++q) sum += red[(q * 64 + c2) * 5 + s];
            MOD[((size_t)l * 5 + s) * 6144 + cg * 64 + c2] = sum + p.mod_b[l * 6144 + cg * 64 + c2]; }
        __syncthreads();
    }
}


__device__ void ph_small_cvt(const Params& p, char* lds) {
    int rot = 128;
    for (int j = 0; j < 2; ++j) {
        char* wm = p.ws + OFF_WMLA + j * SZ_WMLA; char* wr = p.ws + OFF_WRW + j * SZ_WRW;
        const float* w_in = p.mla_w_in + (size_t)j * D * 448; const float* w_uq = p.mla_w_uq + (size_t)j * 256 * 1536; const float* w_ukv = p.mla_w_ukv + (size_t)j * 128 * 2048; const float* w_o = p.mla_w_o + (size_t)j * D * D;
        cvt_tiles(p.wv, lds, (bf16_t*)(wm + WM_IN), 1024, 512, 1, 0, [=](int, int k, int n) -> const float* { return n < 448 ? w_in + (size_t)k * 448 + n : nullptr; },
                  [=](int n) { if (n < 384 || n >= 448) return n; const int jj = n - 384; return 384 + (jj < 32 ? 2 * jj : 2 * (jj - 32) + 1); }, &rot);
        cvt_tiles(p.wv, lds, (bf16_t*)(wm + WM_UQ), 256, 1536, 1, 0, [=](int, int k, int n) -> const float* { return w_uq + (size_t)k * 1536 + n; },
                  [=](int n) { const int h = n / 192, d = n % 192; if (d < 128) return n; const int jj = d - 128; return h * 192 + 128 + (jj < 32 ? 2 * jj : 2 * (jj - 32) + 1); }, &rot);
        cvt_tiles(p.wv, lds, (bf16_t*)(wm + WM_UKV), 128, 2048, 1, 0, [=](int, int k, int n) -> const float* { return w_ukv + (size_t)k * 2048 + n; }, [=](int n) { return n; }, &rot);
        cvt_tiles(p.wv, lds, (bf16_t*)(wm + WM_O), 1024, 1024, 1, 0, [=](int, int k, int n) -> const float* { return w_o + (size_t)k * D + n; }, [=](int n) { return n; }, &rot);
        const float* w_rkv = p.rw_w_rkv + (size_t)j * 3 * D * D; const float* w1 = p.rw_w1 + (size_t)j * 2 * D * 64; const float* a1 = p.rw_a1 + (size_t)j * 2 * D * 64;
        const float* g1 = p.rw_g1 + (size_t)j * D * 128; const float* v1 = p.rw_v1; const float* rwo = p.rw_w_o + (size_t)j * D * D;
        cvt_tiles(p.wv, lds, (bf16_t*)(wr + WR_RKV), 1024, 1024, 3, (size_t)D * D, [=](int m, int k, int n) -> const float* { return w_rkv + ((size_t)m * D + k) * D + n; }, [=](int n) { return n; }, &rot);
        cvt_tiles(p.wv, lds, (bf16_t*)(wr + WR_L), 1024, 256, 1, 0, [=](int, int k, int n) -> const float* { return n < 128 ? w1 + ((size_t)(n >> 6) * D + k) * 64 + (n & 63) : nullptr; }, [=](int n) { return n; }, &rot);
        cvt_tiles(p.wv, lds, (bf16_t*)(wr + WR_L) + 256 * 1024, 1024, 256, 1, 0, [=](int, int k, int n) -> const float* { return n < 128 ? a1 + ((size_t)(n >> 6) * D + k) * 64 + (n & 63) : nullptr; }, [=](int n) { return n; }, &rot);
        cvt_tiles(p.wv, lds, (bf16_t*)(wr + WR_L) + 2 * 256 * 1024, 1024, 256, 1, 0, [=](int, int k, int n) -> const float* { return n < 128 ? g1 + (size_t)k * 128 + n : nullptr; }, [=](int n) { return n; }, &rot);
        cvt_tiles(p.wv, lds, (bf16_t*)(wr + WR_L) + 3 * 256 * 1024, 1024, 256, 1, 0, [=](int, int k, int n) -> const float* { return n < 32 ? v1 + (size_t)k * 32 + n : nullptr; }, [=](int n) { return n; }, &rot);
        cvt_tiles(p.wv, lds, (bf16_t*)(wr + WR_O), 1024, 1024, 1, 0, [=](int, int k, int n) -> const float* { return rwo + (size_t)k * D + n; }, [=](int n) { return n; }, &rot);
        const float* w2 = p.rw_w2 + (size_t)j * 2 * 64 * D; const float* a2 = p.rw_a2 + (size_t)j * 2 * 64 * D; const float* g2 = p.rw_g2 + (size_t)j * 128 * D; const float* v2 = p.rw_v2;
        cvt_tiles(p.wv, lds, (bf16_t*)(wr + WR_B2), 128, 2048, 2, (size_t)2048 * 128, [=](int bt, int k, int n) -> const float* { const int zz = n >> 10, c = n & 1023, l = k - zz * 64;
            if (l < 0 || l >= 64) return nullptr; return (bt == 0 ? w2 : a2) + ((size_t)zz * 64 + l) * D + c; }, [=](int n) { return n; }, &rot);
        cvt_tiles(p.wv, lds, (bf16_t*)(wr + WR_B3), 128, 1024, 2, (size_t)1024 * 128, [=](int bt, int k, int n) -> const float* {
            if (bt == 0) return g2 + (size_t)k * D + n; return k < 32 ? v2 + (size_t)k * D + n : nullptr; }, [=](int n) { return n; }, &rot);
    }
}

template <bool OUTF32>
__device__ void ph_norm_mod(const Params& p, int layer, const float* g, int part_sh, int part_sc, void* outp) {
    const int wid = tidx() >> 6, lane = tidx() & 63;
    const xt_t* X = (const xt_t*)(p.ws + OFF_X);
    const int w_ = bidx() * 8 + wid, nw_ = gdim() * 8;
    int row = (int)((long long)w_ * NROW / nw_); const int rend = (int)((long long)(w_ + 1) * NROW / nw_);
    float4 nv[4], gm[4], bb[4]; int scur = -1;
    if (row < rend) {
#pragma unroll
        for (int i = 0; i < 4; ++i) nv[i] = xld(X, (size_t)row * D + (lane + i * 64) * 4); }
    for (; row < rend; ++row) {
        const int s = row_stream(row);
        if (s != scur) { scur = s; const float* sh = modp(p, layer, s, part_sh); const float* sc = modp(p, layer, s, part_sc);
#pragma unroll
            for (int i = 0; i < 4; ++i) { const int d = (lane + i * 64) * 4; const float4 gg = *(const float4*)(g + d), a = *(const float4*)(sc + d); bb[i] = *(const float4*)(sh + d);
                gm[i] = make_float4(gg.x * (1.f + a.x), gg.y * (1.f + a.y), gg.z * (1.f + a.z), gg.w * (1.f + a.w)); } }
        float4 v[4]; float ss = 0;
#pragma unroll
        for (int i = 0; i < 4; ++i) { v[i] = nv[i]; ss += v[i].x * v[i].x + v[i].y * v[i].y + v[i].z * v[i].z + v[i].w * v[i].w; }
        { const int nrow = row + 1;
          if (nrow < rend) {
#pragma unroll
              for (int i = 0; i < 4; ++i) nv[i] = xld(X, (size_t)nrow * D + (lane + i * 64) * 4); } }
        ss = wave_sum(ss); const float rs = rsqrtf(ss * (1.f / D) + RMS_EPS);
#pragma unroll
        for (int i = 0; i < 4; ++i) {
            const int d = (lane + i * 64) * 4;
            float4 o; o.x = v[i].x * rs * gm[i].x + bb[i].x; o.y = v[i].y * rs * gm[i].y + bb[i].y; o.z = v[i].z * rs * gm[i].z + bb[i].z; o.w = v[i].w * rs * gm[i].w + bb[i].w;
            if (OUTF32) *(float4*)((float*)outp + (size_t)row * D + d) = o;
            else { uint2 w; w.x = pk2(o.x, o.y); w.y = pk2(o.z, o.w); *(uint2*)((bf16_t*)outp + (size_t)row * D + d) = w; }
        }
    }
}

__device__ void ph_mla_mid(const Params& p, int j) {
    const int wid = tidx() >> 6, lane = tidx() & 63;
    const float* Z = (const float*)(p.ws + OFF_Z);
    bf16_t* CQN = (bf16_t*)(p.ws + OFF_CQN); bf16_t* CKVN = (bf16_t*)(p.ws + OFF_CKVN); bf16_t* K = (bf16_t*)(p.ws + OFF_K);
    const float* gq = p.mla_g_q + j * 256; const float* gkv = p.mla_g_kv + j * 128;
    const float* rc = (const float*)(p.ws + OFF_ROPE_C); const float* rs = (const float*)(p.ws + OFF_ROPE_S);
    for (int row = bidx() * 8 + wid; row < NROW; row += gdim() * 8) {
        const float* z = Z + (size_t)row * 512;
        const float4 q = *(const float4*)(z + lane * 4);
        const float2 kv = *(const float2*)(z + 256 + lane * 2);
        const float kr = z[384 + lane];
        float sq = wave_sum(q.x * q.x + q.y * q.y + q.z * q.z + q.w * q.w); const float rq = rsqrtf(sq * (1.f / 256.f) + RMS_EPS);
        float sk = wave_sum(kv.x * kv.x + kv.y * kv.y); const float rk = rsqrtf(sk * (1.f / 128.f) + RMS_EPS);
        const float4 g4 = *(const float4*)(gq + lane * 4); const float2 g2 = *(const float2*)(gkv + lane * 2);
        uint2 w; w.x = pk2(q.x * rq * g4.x, q.y * rq * g4.y); w.y = pk2(q.z * rq * g4.z, q.w * rq * g4.w);
        *(uint2*)(CQN + (size_t)row * 256 + lane * 4) = w;
        *(unsigned*)(CKVN + (size_t)row * 128 + lane * 2) = pk2(kv.x * rk * g2.x, kv.y * rk * g2.y);
        float o = kr;
        const float other = __builtin_bit_cast(float, __builtin_amdgcn_update_dpp(0, __builtin_bit_cast(int, kr), 0xB1, 0xF, 0xF, true));
        const bool lat = row < NLAT;
        if (lat) { const int t = row & (TL - 1), i = lane >> 1; const float2 cs = *(const float2*)(rc + (t * 32 + i) * 2); const float c = cs.x, s = cs.y;
            o = (lane & 1) ? (other * s + kr * c) : (kr * c - other * s); }
        const int b = lat ? (row >> 12) : ((row - NLAT) >> 8); const int tk = lat ? 256 + (row & (TL - 1)) : ((row - NLAT) & 255);
        const bf16_t ob = f2bf(o);
#pragma unroll
        for (int h = 0; h < 8; ++h) K[((size_t)(b * 8 + h) * TK + tk) * 192 + 128 + lane] = ob;
    }
}

__device__ void ph_qkv_post(const Params& p) {
    const int wid = tidx() >> 6, lane = tidx() & 63;
    const float* QRAW = (const float*)(p.ws + OFF_QRAW); const float* KVRAW = (const float*)(p.ws + OFF_KVRAW); const float* KR = (const float*)(p.ws + OFF_KR);
    bf16_t* Q = (bf16_t*)(p.ws + OFF_Q); bf16_t* K = (bf16_t*)(p.ws + OFF_K); bf16_t* V = (bf16_t*)(p.ws + OFF_V);
    const float* rc = (const float*)(p.ws + OFF_ROPE_C); const float* rs = (const float*)(p.ws + OFF_ROPE_S);
    for (int it = bidx() * 8 + wid; it < NROW * 8; it += gdim() * 8) {
        const int row = it >> 3, h = it & 7;
        const bool lat = row < NLAT; const int b = lat ? (row >> 12) : ((row - NLAT) >> 8); const int tk = lat ? 256 + (row & (TL - 1)) : ((row - NLAT) & 255);
        const size_t orow = (size_t)(b * 8 + h) * TK + tk;
        const float* q = QRAW + (size_t)row * 1536 + h * 192;
        const float q0 = q[lane], q1 = q[64 + lane]; float q2 = q[128 + lane];
        const auto sw = __builtin_amdgcn_permlane32_swap(__float_as_uint(q2), __float_as_uint(q2), false, false);
        if (lat) { const int t = row & (TL - 1), i = lane & 31; const float c = rc[t * 32 + i], s = rs[t * 32 + i];
            const float x1 = __uint_as_float(sw[0]), x2 = __uint_as_float(sw[1]); q2 = lane < 32 ? (x1 * c - x2 * s) : (x1 * s + x2 * c); }
        bf16_t* qo = Q + orow * 192; qo[lane] = f2bf(q0); qo[64 + lane] = f2bf(q1); qo[128 + lane] = f2bf(q2);
        const float* kv = KVRAW + (size_t)row * 2048 + h * 256;
        bf16_t* ko = K + orow * 192; ko[lane] = f2bf(kv[lane]); ko[64 + lane] = f2bf(kv[64 + lane]); ko[128 + lane] = f2bf(KR[(size_t)row * 64 + lane]);
        bf16_t* vo = V + orow * 128; vo[lane] = f2bf(kv[128 + lane]); vo[64 + lane] = f2bf(kv[192 + lane]);
    }
}

__device__ void ph_attn_naive(const Params& p, char* lds) {
    const int tid = tidx(), qi = tid >> 2, part = tid & 3;
    const bf16_t* Q = (const bf16_t*)(p.ws + OFF_Q); const bf16_t* K = (const bf16_t*)(p.ws + OFF_K); const bf16_t* V = (const bf16_t*)(p.ws + OFF_V);
    bf16_t* O = (bf16_t*)(p.ws + OFF_O);
    bf16_t* Ks = (bf16_t*)lds;
    bf16_t* Vs = Ks + 32 * 192;
    const int nitems = 32 * 34;
    for (int it = bidx(); it < nitems; it += gdim()) {
        const int bh = it / 34, qb = it % 34; const int b = bh >> 3, h = bh & 7;
        const int nkeys = qb < 2 ? TC : TK;
        const int tq = qb * 128 + qi;
        const bf16_t* qp = Q + ((size_t)bh * TK + tq) * 192 + part * 48;
        float q[48];
#pragma unroll
        for (int i = 0; i < 48; ++i) q[i] = bf2f(qp[i]) * ATT_SCALE;
        float o[32];
#pragma unroll
        for (int i = 0; i < 32; ++i) o[i] = 0.f;
        float m = -1e30f, l = 0.f;
        for (int k0 = 0; k0 < nkeys; k0 += 32) {
            __syncthreads();
            {
                const bf16_t* kg = K + ((size_t)bh * TK + k0) * 192; const bf16_t* vg = V + ((size_t)bh * TK + k0) * 128;
                for (int c = tid; c < 768; c += NTHR) *(u32x4*)(Ks + c * 8) = *(const u32x4*)(kg + c * 8);
                *(u32x4*)(Vs + tid * 8) = *(const u32x4*)(vg + tid * 8);
            }
            __syncthreads();
#pragma unroll 1
            for (int kg = 0; kg < 32; kg += 8) {
                float s[8]; float tmax = -1e30f;
#pragma unroll
                for (int kk = 0; kk < 8; ++kk) {
                    const bf16_t* kr = Ks + (kg + kk) * 192 + part * 48; float acc = 0.f;
#pragma unroll
                    for (int i = 0; i < 48; ++i) acc += q[i] * bf2f(kr[i]);
                    acc += __shfl_xor(acc, 1); acc += __shfl_xor(acc, 2);
                    s[kk] = acc; tmax = fmaxf(tmax, acc);
                    asm volatile("" ::: "memory");
                }
                const float mn = fmaxf(m, tmax), alpha = expf(m - mn); m = mn; l *= alpha;
#pragma unroll
                for (int i = 0; i < 32; ++i) o[i] *= alpha;
#pragma unroll
                for (int kk = 0; kk < 8; ++kk) {
                    const float pw = expf(s[kk] - mn); l += pw;
                    const bf16_t* vr = Vs + (kg + kk) * 128 + part * 32;
#pragma unroll
                    for (int i = 0; i < 32; ++i) o[i] += pw * bf2f(vr[i]);
                    asm volatile("" ::: "memory");
                }
            }
        }
        const float rl = 1.f / l;
        const int row = qb < 2 ? (NLAT + b * TC + tq) : (b * TL + tq - TC);
        bf16_t* op = O + (size_t)row * D + h * 128 + part * 32;
#pragma unroll
        for (int i = 0; i < 32; ++i) op[i] = f2bf(o[i] * rl);
    }
}


namespace fa {
using s16x4  = __attribute__((ext_vector_type(4))) short;
using f32x16 = __attribute__((ext_vector_type(16))) float;
constexpr int DQK = 192, DV = 128, KVBLK = 64;
constexpr float THR = 8.f;
constexpr int SHM_V = KVBLK * DV * 2, SHM_K = KVBLK * DQK * 2;
constexpr int SHM_ATTN = 2 * SHM_V + 2 * SHM_K + 8 * 64 * 4;
#define KSWZ(row, colB) ((row) * 384 + ((colB) ^ ((((row) >> 1) & 7) << 4)))
#define SBAR() __builtin_amdgcn_sched_barrier(0)
__device__ __forceinline__ int crow(int r, int hi) { return (r & 3) + 8 * (r >> 2) + 4 * hi; }
__device__ __forceinline__ unsigned cvtpk(float lo, float hi) { unsigned r; asm volatile("v_cvt_pk_bf16_f32 %0, %1, %2" : "=v"(r) : "v"(lo), "v"(hi)); return r; }
__device__ __forceinline__ void partialSM(f32x16& p0, f32x16& p1, float& m_reg, float& mn, float& alpha) {
  constexpr float C = ATT_SCALE * 1.4426950408889634f;
  float pmax = p0[0];
#pragma unroll
  for (int r = 1; r < 16; ++r) pmax = fmaxf(pmax, p0[r]);
#pragma unroll
  for (int r = 0; r < 16; ++r) pmax = fmaxf(pmax, p1[r]);
  { auto rr = __builtin_amdgcn_permlane32_swap(__float_as_uint(pmax), __float_as_uint(pmax), false, false);
    pmax = fmaxf(__uint_as_float(rr[0]), __uint_as_float(rr[1])); }
  if (__builtin_expect(__all(pmax - m_reg <= THR / ATT_SCALE), 1)) { mn = m_reg; alpha = 1.f; }
  else { mn = fmaxf(m_reg, pmax); alpha = __builtin_amdgcn_exp2f((m_reg - mn) * C); m_reg = mn; }
  float mnC = -mn * C;
#pragma unroll
  for (int r = 0; r < 16; ++r) p0[r] = fmaf(p0[r], C, mnC);
#pragma unroll
  for (int r = 0; r < 16; ++r) p1[r] = fmaf(p1[r], C, mnC);
#pragma unroll
  for (int r = 0; r < 16; ++r) p0[r] = __builtin_amdgcn_exp2f(p0[r]);
}
__device__ __forceinline__ void finishSM(f32x16& p0, f32x16& p1, float alpha, float& l_reg, bf16x8& pa0, bf16x8& pa1, bf16x8& pa2, bf16x8& pa3) {
#pragma unroll
  for (int r = 0; r < 16; ++r) p1[r] = __builtin_amdgcn_exp2f(p1[r]);
  float ps = 0;
#pragma unroll
  for (int r = 0; r < 16; ++r) ps += p0[r];
#pragma unroll
  for (int r = 0; r < 16; ++r) ps += p1[r];
  { auto rr = __builtin_amdgcn_permlane32_swap(__float_as_uint(ps), __float_as_uint(ps), false, false);
    ps = __uint_as_float(rr[0]) + __uint_as_float(rr[1]); }
  l_reg = l_reg * alpha + ps;
#define PK4(P, BASE, OUT) do { unsigned a0 = cvtpk(P[BASE + 0], P[BASE + 1]), a1 = cvtpk(P[BASE + 2], P[BASE + 3]);   \
    unsigned b0 = cvtpk(P[BASE + 4], P[BASE + 5]), b1 = cvtpk(P[BASE + 6], P[BASE + 7]);                              \
    auto r0 = __builtin_amdgcn_permlane32_swap(a0, b0, false, false); auto r1 = __builtin_amdgcn_permlane32_swap(a1, b1, false, false); \
    u32x4 w = {r0[0], r1[0], r0[1], r1[1]}; OUT = *reinterpret_cast<bf16x8*>(&w); } while (0)
  PK4(p0, 0, pa0); PK4(p0, 8, pa1); PK4(p1, 0, pa2); PK4(p1, 8, pa3);
#undef PK4
}
__device__ __forceinline__ void qkt(f32x16& p0, f32x16& p1, const char* Ks, const bf16x8* qr, int r32, int hi) {
  p0 = f32x16{}; p1 = f32x16{};
  const int swz = ((r32 >> 1) & 7) << 4;
  const char* b4[4];
#pragma unroll
  for (int dr = 0; dr < 4; ++dr) b4[dr] = Ks + r32 * 384 + ((dr * 32 + hi * 16) ^ swz);
#pragma unroll
  for (int d0 = 0; d0 < 12; ++d0) {
    bf16x8 b0 = *reinterpret_cast<const bf16x8*>(b4[d0 & 3] + (d0 >> 2) * 128);
    bf16x8 b1 = *reinterpret_cast<const bf16x8*>(b4[d0 & 3] + (d0 >> 2) * 128 + 32 * 384);
    p0 = __builtin_amdgcn_mfma_f32_32x32x16_bf16(b0, qr[d0], p0, 0, 0, 0);
    p1 = __builtin_amdgcn_mfma_f32_32x32x16_bf16(b1, qr[d0], p1, 0, 0, 0); }
}
__device__ __forceinline__ int v_st(int k, int c) { const int kk = (k & ~0xC) | ((k & 4) << 1) | ((k & 8) >> 1); return ((kk >> 3) * 4 + (c >> 5)) * 512 + ((kk & 7) * 32 + (c & 31)) * 2; }
__device__ __forceinline__ int v_rd_base(int lane) { return ((lane & 3) << 3) | (((lane >> 2) & 3) << 6) | (((lane >> 4) & 1) << 5) | (((lane >> 5) & 1) << 8); }
constexpr int v_rd_off(int d0, int ks, int half) { return d0 * 512 + ks * 4096 + half * 2048; }
template <int OFF> __device__ __forceinline__ s16x4 tr_read(int vb) {
  s16x4 r; asm volatile("ds_read_b64_tr_b16 %0, %1 offset:%2" : "=&v"(r) : "v"(vb), "i"(OFF) : "memory"); return r;
}
template <int D0> __device__ __forceinline__ void pv_one(f32x16& od, int vb, bf16x8 pa0, bf16x8 pa1, bf16x8 pa2, bf16x8 pa3) {
  const s16x4 l0 = tr_read<v_rd_off(D0, 0, 0)>(vb), h0 = tr_read<v_rd_off(D0, 0, 1)>(vb), l1 = tr_read<v_rd_off(D0, 1, 0)>(vb), h1 = tr_read<v_rd_off(D0, 1, 1)>(vb);
  const s16x4 l2 = tr_read<v_rd_off(D0, 2, 0)>(vb), h2 = tr_read<v_rd_off(D0, 2, 1)>(vb), l3 = tr_read<v_rd_off(D0, 3, 0)>(vb), h3 = tr_read<v_rd_off(D0, 3, 1)>(vb);
  asm volatile("s_waitcnt lgkmcnt(0)" ::: "memory"); SBAR();
#define PK(L, H) (bf16x8){L[0], L[1], L[2], L[3], H[0], H[1], H[2], H[3]}
  od = __builtin_amdgcn_mfma_f32_32x32x16_bf16(pa0, PK(l0, h0), od, 0, 0, 0);
  od = __builtin_amdgcn_mfma_f32_32x32x16_bf16(pa1, PK(l1, h1), od, 0, 0, 0);
  od = __builtin_amdgcn_mfma_f32_32x32x16_bf16(pa2, PK(l2, h2), od, 0, 0, 0);
  od = __builtin_amdgcn_mfma_f32_32x32x16_bf16(pa3, PK(l3, h3), od, 0, 0, 0);
#undef PK
}
__device__ __forceinline__ void pv_d0(f32x16* o, int vb, bf16x8 pa0, bf16x8 pa1, bf16x8 pa2, bf16x8 pa3) {
  pv_one<0>(o[0], vb, pa0, pa1, pa2, pa3); pv_one<1>(o[1], vb, pa0, pa1, pa2, pa3); pv_one<2>(o[2], vb, pa0, pa1, pa2, pa3); pv_one<3>(o[3], vb, pa0, pa1, pa2, pa3);
}
__device__ __forceinline__ void attn_body(const int wv_, const bf16_t* __restrict__ Qb, const bf16_t* __restrict__ Kh, const bf16_t* __restrict__ Vh, bf16_t* __restrict__ Ob, int ldo, int seq, char* lds, const float* __restrict__ ropecs  ) {
  const int tid = tidx_w(wv_), wid = tid >> 6, lane = tid & 63, r32 = lane & 31, hi = lane >> 5;
  char* V_lds = lds; char* K_lds = lds + 2 * SHM_V;
  float* ws = (float*)(lds + 2 * SHM_V + 2 * SHM_K) + wid * 64; float* li_l = ws; float* al_l = ws + 32;
  float m_reg = -1e30f, l_reg = 0; f32x16 o[4] = {}; bf16x8 qr[12];
  const bf16_t* Qw = Qb + (long)(wid * 32 + r32) * DQK + hi * 8;
#pragma unroll
  for (int d0 = 0; d0 < 12; ++d0) qr[d0] = *reinterpret_cast<const bf16x8*>(Qw + d0 * 16);
  if (ropecs) {
    const float* cs = ropecs + (size_t)(wid * 32 + r32) * 64;
#pragma unroll
    for (int d0 = 8; d0 < 12; ++d0) { const int i0 = (d0 - 8) * 8 + hi * 4; const f32x4 c0 = *(const f32x4*)(cs + i0 * 2), c1 = *(const f32x4*)(cs + i0 * 2 + 4);
      u32x4 w = *reinterpret_cast<u32x4*>(&qr[d0]); const float cc[4] = {c0[0], c0[2], c1[0], c1[2]}, ss[4] = {c0[1], c0[3], c1[1], c1[3]};
#pragma unroll
      for (int m = 0; m < 4; ++m) { const float x1 = __uint_as_float(w[m] << 16), x2 = __uint_as_float(w[m] & 0xffff0000u); w[m] = cvtpk(x1 * cc[m] - x2 * ss[m], x1 * ss[m] + x2 * cc[m]); }
      qr[d0] = *reinterpret_cast<bf16x8*>(&w); }
  }
  const int sr = tid >> 4, sc = (tid & 15) * 8, vst0 = v_st(sr, sc), vst1 = v_st(32 + sr, sc);
  int kst[3];
#pragma unroll
  for (int i = 0; i < 3; ++i) { const int c = tid + 512 * i, row = c / 24, cc = c % 24; kst[i] = KSWZ(row, cc * 16); }
  const int vb0 = (int)(uintptr_t)V_lds + v_rd_base(lane);
  struct { bf16x8 vs0, vs1, ks0, ks1, ks2; } sr_[1];
#define SLOAD(i, k0) do { const bf16_t* vt = Vh + (long)(k0) * DV; const bf16_t* kt = Kh + (long)(k0) * DQK; \
    sr_[i].vs0 = *reinterpret_cast<const bf16x8*>(vt + (sr) * DV + sc); sr_[i].vs1 = *reinterpret_cast<const bf16x8*>(vt + (32 + sr) * DV + sc); \
    sr_[i].ks0 = *reinterpret_cast<const bf16x8*>(kt + tid * 8); sr_[i].ks1 = *reinterpret_cast<const bf16x8*>(kt + (tid + 512) * 8); sr_[i].ks2 = *reinterpret_cast<const bf16x8*>(kt + (tid + 1024) * 8); } while (0)
#define SWRITE(b, i) do { *(bf16x8*)(V_lds + (b) * SHM_V + vst0) = sr_[i].vs0; *(bf16x8*)(V_lds + (b) * SHM_V + vst1) = sr_[i].vs1; \
    *(bf16x8*)(K_lds + (b) * SHM_K + kst[0]) = sr_[i].ks0; *(bf16x8*)(K_lds + (b) * SHM_K + kst[1]) = sr_[i].ks1; *(bf16x8*)(K_lds + (b) * SHM_K + kst[2]) = sr_[i].ks2; } while (0)
#define SWAIT() asm volatile("s_waitcnt vmcnt(5)" ::: "memory")
#define RESC(a) do { if (__any((a) < 1.f)) { if (hi == 0) al_l[r32] = (a); asm volatile("s_waitcnt lgkmcnt(0)" ::: "memory"); \
    _Pragma("unroll") for (int d = 0; d < 4; ++d) _Pragma("unroll") for (int r = 0; r < 16; ++r) o[d][r] *= al_l[crow(r, hi)]; } } while (0)
  f32x16 pA0, pA1; float mnA, alA; bf16x8 pa0, pa1, pa2, pa3; const int NT = seq / KVBLK;
  SLOAD(0, 0); SWRITE(0, 0);
  SLOAD(0, KVBLK);
  __syncthreads();
  for (int j = 0; j < NT; j += 2) {
    SBAR(); qkt(pA0, pA1, K_lds, qr, r32, hi);
    partialSM(pA0, pA1, m_reg, mnA, alA); RESC(alA);
    finishSM(pA0, pA1, alA, l_reg, pa0, pa1, pa2, pa3); SBAR();
    SWRITE(1, 0);
    if (j + 2 < NT) SLOAD(0, (j + 2) * KVBLK);
    SBAR();
    pv_d0(o, vb0, pa0, pa1, pa2, pa3);
    __syncthreads();
    SBAR(); qkt(pA0, pA1, K_lds + SHM_K, qr, r32, hi);
    partialSM(pA0, pA1, m_reg, mnA, alA); RESC(alA);
    finishSM(pA0, pA1, alA, l_reg, pa0, pa1, pa2, pa3); SBAR();
    if (j + 2 < NT) { SWRITE(0, 0); if (j + 3 < NT) SLOAD(0, (j + 3) * KVBLK); }
    SBAR();
    pv_d0(o, vb0 + SHM_V, pa0, pa1, pa2, pa3);
    __syncthreads();
  }
  if (hi == 0) li_l[r32] = l_reg; asm volatile("s_waitcnt lgkmcnt(0)" ::: "memory");
  float rli[16];
#pragma unroll
  for (int r = 0; r < 16; ++r) rli[r] = __builtin_amdgcn_rcpf(li_l[crow(r, hi)]);
  bf16_t* Ow = Ob + (long)(wid * 32) * ldo;
#pragma unroll
  for (int r = 0; r < 16; ++r) { int orow = crow(r, hi);
#pragma unroll
    for (int d0 = 0; d0 < 4; ++d0) Ow[(long)orow * ldo + d0 * 32 + r32] = f2bf(o[d0][r] * rli[r]); }
  __syncthreads();
#undef SLOAD
#undef SWRITE
#undef SWAIT
#undef RESC
}
#undef KSWZ
}

__device__ void ph_attn(const Params& p, char* lds) {
    const bf16_t* Q = (const bf16_t*)(p.ws + OFF_Q); const bf16_t* K = (const bf16_t*)(p.ws + OFF_K); const bf16_t* V = (const bf16_t*)(p.ws + OFF_V);
    bf16_t* O = (bf16_t*)(p.ws + OFF_O);
    const int G = gdim();
    for (int i = 0;; ++i) {
        const int L = i * G + bidx(); if (L >= 544) break;
        int bh, qb;
        if (L < 512) { const int w = g8::xcd_remap(L, 512); bh = w >> 4; qb = 1 + (w & 15); } else { bh = L - 512; qb = 0; }
        const int b = bh >> 3, h = bh & 7;
        const int seq = qb == 0 ? TC : TK;
        const int row0 = qb == 0 ? NLAT + b * TC : b * TL + (qb - 1) * 256;
        fa::attn_body(p.wv, Q + ((size_t)bh * TK + qb * 256) * 192, K + (size_t)bh * TK * 192, V + (size_t)bh * TK * 128, O + (size_t)row0 * D + h * 128, D, seq, lds,
                      qb == 0 ? nullptr : (const float*)(p.ws + OFF_ROPE_C) + (size_t)(qb - 1) * 256 * 64);
    }
}

__device__ void ph_norm2_router(const Params& p, int layer, char* lds, int nrows) {
    const int tid = tidx(), wid = tid >> 6, lane = tid & 63;
    float* rt = (float*)lds;
    const float* rg = p.moe_router + (size_t)layer * D * NE;
    for (int i = tid; i < D * NE / 4; i += NTHR) { const int d = i >> 2, eq = i & 3; ((float4*)rt)[(((d >> 8) * 4 + (d & 3)) * 4 + eq) * 64 + ((d & 255) >> 2)] = ((const float4*)rg)[i]; }
    __syncthreads();
    const xt_t* X = (const xt_t*)(p.ws + OFF_X); bf16_t* BN = (bf16_t*)(p.ws + OFF_H); float* AFF = (float*)(p.ws + OFF_AFF);
    const float* g = p.norm2_g + layer * D;
    const int w_ = bidx() * 8 + wid, nw_ = gdim() * 8;
    int row = (int)((long long)w_ * nrows / nw_); const int rend = (int)((long long)(w_ + 1) * nrows / nw_);
    float4 nv[4], gm[4], bb[4]; int scur = -1;
    if (row < rend) {
#pragma unroll
        for (int i = 0; i < 4; ++i) nv[i] = xld(X, (size_t)row * D + (lane + i * 64) * 4); }
    for (; row < rend; ++row) {
        const int s = row_stream(row);
        if (s != scur) { scur = s; const float* sh = modp(p, layer, s, 3); const float* sc = modp(p, layer, s, 4);
#pragma unroll
            for (int i = 0; i < 4; ++i) { const int d = (lane + i * 64) * 4; const float4 gg = *(const float4*)(g + d), a = *(const float4*)(sc + d); bb[i] = *(const float4*)(sh + d);
                gm[i] = make_float4(gg.x * (1.f + a.x), gg.y * (1.f + a.y), gg.z * (1.f + a.z), gg.w * (1.f + a.w)); } }
        float4 v[4]; float ss = 0;
#pragma unroll
        for (int i = 0; i < 4; ++i) { v[i] = nv[i]; ss += v[i].x * v[i].x + v[i].y * v[i].y + v[i].z * v[i].z + v[i].w * v[i].w; }
        { const int nrow = row + 1;
          if (nrow < rend) {
#pragma unroll
              for (int i = 0; i < 4; ++i) nv[i] = xld(X, (size_t)nrow * D + (lane + i * 64) * 4); } }
        ss = wave_sum(ss); const float rs = rsqrtf(ss * (1.f / D) + RMS_EPS);
        float lg[16];
#pragma unroll
        for (int e = 0; e < 16; ++e) lg[e] = 0.f;
#pragma unroll
        for (int i = 0; i < 4; ++i) {
            const int d = (lane + i * 64) * 4;
            float o[4]; o[0] = v[i].x * rs * gm[i].x + bb[i].x; o[1] = v[i].y * rs * gm[i].y + bb[i].y; o[2] = v[i].z * rs * gm[i].z + bb[i].z; o[3] = v[i].w * rs * gm[i].w + bb[i].w;
            uint2 w; w.x = pk2(o[0], o[1]); w.y = pk2(o[2], o[3]); *(uint2*)(BN + (size_t)row * D + d) = w;
#pragma unroll
            for (int jj = 0; jj < 4; ++jj) {
#pragma unroll
                for (int eq = 0; eq < 4; ++eq) { const float4 r4 = ((const float4*)rt)[((i * 4 + jj) * 4 + eq) * 64 + lane];
                    lg[4 * eq] += o[jj] * r4.x; lg[4 * eq + 1] += o[jj] * r4.y; lg[4 * eq + 2] += o[jj] * r4.z; lg[4 * eq + 3] += o[jj] * r4.w; } }
            asm volatile("" ::: "memory");
        }
        float mx = -1e30f;
#pragma unroll
        for (int e = 0; e < 16; ++e) { lg[e] = wave_sum(lg[e]); mx = fmaxf(mx, lg[e]); }
        float sum = 0;
#pragma unroll
        for (int e = 0; e < 16; ++e) { lg[e] = expf(lg[e] - mx); sum += lg[e]; }
        const float inv = 1.f / sum;
        if (lane < 16) { float val = 0;
#pragma unroll
            for (int e = 0; e < 16; ++e) val = (lane == e) ? lg[e] : val;
            AFF[(size_t)row * 16 + lane] = val * inv; }
    }
}

__device__ void ph_norm2_router_mm(const Params& p, int layer, char* lds, int nrows) {
    typedef __attribute__((address_space(3))) char lch;
    constexpr int PB = 2064;
    constexpr int O_RH = 0, O_RL = 16 * PB, O_A = 32 * PB, A_BUF = 16 * PB, O_P = O_A + 2 * A_BUF, P_BUF = 8 * 8 * 16 * 4;
    const int tid = tidx(), wid = __builtin_amdgcn_readfirstlane(tid >> 6), lane = tid & 63;
    lch* L = (lch*)lds;
    const float* rg = p.moe_router + (size_t)layer * D * NE;
    for (int i = tid; i < D * NE / 4; i += NTHR) { const int d = i >> 2, eq = i & 3; const float4 r4 = ((const float4*)rg)[i]; const float rr[4] = {r4.x, r4.y, r4.z, r4.w};
#pragma unroll
        for (int u = 0; u < 4; ++u) { const unsigned h = pk2(rr[u], rr[u]) & 0xffffu; const float lo = rr[u] - __uint_as_float(h << 16);
            *(LAS bf16_t*)(L + O_RH + (4 * eq + u) * PB + d * 2) = (bf16_t)h; *(LAS bf16_t*)(L + O_RL + (4 * eq + u) * PB + d * 2) = f2bf(lo); } }
    const xt_t* X = (const xt_t*)(p.ws + OFF_X); bf16_t* BN = (bf16_t*)(p.ws + OFF_H); float* AFF = (float*)(p.ws + OFF_AFF);
    const float* g = p.norm2_g + layer * D;
    const int nch = nrows / 8;
    int ch = (int)((long long)bidx() * nch / gdim()); const int chend = (int)((long long)(bidx() + 1) * nch / gdim());
    float4 nv[4], gm[4], bb[4]; int scur = -1;
    if (ch < chend) {
#pragma unroll
        for (int i = 0; i < 4; ++i) nv[i] = xld(X, (size_t)(ch * 8 + wid) * D + (lane + i * 64) * 4); }
    for (int it = 0; ch < chend; ++ch, ++it) {
        const int row = ch * 8 + wid, buf = it & 1;
        const int s = row_stream(row);
        if (s != scur) { scur = s; const float* sh = modp(p, layer, s, 3); const float* sc = modp(p, layer, s, 4);
#pragma unroll
            for (int i = 0; i < 4; ++i) { const int d = (lane + i * 64) * 4; const float4 gg = *(const float4*)(g + d), a = *(const float4*)(sc + d); bb[i] = *(const float4*)(sh + d);
                gm[i] = make_float4(gg.x * (1.f + a.x), gg.y * (1.f + a.y), gg.z * (1.f + a.z), gg.w * (1.f + a.w)); } }
        float4 v[4]; float ss = 0;
#pragma unroll
        for (int i = 0; i < 4; ++i) { v[i] = nv[i]; ss += v[i].x * v[i].x + v[i].y * v[i].y + v[i].z * v[i].z + v[i].w * v[i].w; }
        if (ch + 1 < chend) {
#pragma unroll
            for (int i = 0; i < 4; ++i) nv[i] = xld(X, (size_t)(row + 8) * D + (lane + i * 64) * 4); }
        ss = wave_sum(ss); const float rs = rsqrtf(ss * (1.f / D) + RMS_EPS);
        lch* AH = L + O_A + buf * A_BUF + wid * PB; lch* AL = AH + 8 * PB;
#pragma unroll
        for (int i = 0; i < 4; ++i) {
            const int d = (lane + i * 64) * 4;
            float o[4]; o[0] = v[i].x * rs * gm[i].x + bb[i].x; o[1] = v[i].y * rs * gm[i].y + bb[i].y; o[2] = v[i].z * rs * gm[i].z + bb[i].z; o[3] = v[i].w * rs * gm[i].w + bb[i].w;
            u32x2 wh; wh.x = pk2(o[0], o[1]); wh.y = pk2(o[2], o[3]);
            uint2 wg_; wg_.x = wh.x; wg_.y = wh.y; *(uint2*)(BN + (size_t)row * D + d) = wg_;
            u32x2 wl; wl.x = pk2(o[0] - __uint_as_float(wh.x << 16), o[1] - __uint_as_float(wh.x & 0xffff0000u)); wl.y = pk2(o[2] - __uint_as_float(wh.y << 16), o[3] - __uint_as_float(wh.y & 0xffff0000u));
            *(LAS u32x2*)(AH + d * 2) = wh; *(LAS u32x2*)(AL + d * 2) = wl;
        }
        __syncthreads();
        {
            f32x4 acc = {0.f, 0.f, 0.f, 0.f};
            const lch* ah = L + O_A + buf * A_BUF + (lane & 7) * PB + (128 * wid + 8 * (lane >> 4)) * 2;
            const lch* bh = L + O_RH + (lane & 15) * PB + (128 * wid + 8 * (lane >> 4)) * 2;
#pragma unroll
            for (int ks = 0; ks < 4; ++ks) {
                const bf16x8 a_h = *(const LAS bf16x8*)(ah + ks * 64), a_l = *(const LAS bf16x8*)(ah + 8 * PB + ks * 64);
                const bf16x8 b_h = *(const LAS bf16x8*)(bh + ks * 64), b_l = *(const LAS bf16x8*)(bh + 16 * PB + ks * 64);
                acc = __builtin_amdgcn_mfma_f32_16x16x32_bf16(a_h, b_h, acc, 0, 0, 0);
                acc = __builtin_amdgcn_mfma_f32_16x16x32_bf16(a_h, b_l, acc, 0, 0, 0);
                acc = __builtin_amdgcn_mfma_f32_16x16x32_bf16(a_l, b_h, acc, 0, 0, 0);
            }
            if (lane < 32) {
#pragma unroll
                for (int e = 0; e < 4; ++e) *(LAS float*)(L + O_P + buf * P_BUF + ((wid * 8 + 4 * (lane >> 4) + e) * 16 + (lane & 15)) * 4) = acc[e]; }
        }
        __syncthreads();
        if (tid < 128) {
            float lg = 0.f;
#pragma unroll
            for (int w8 = 0; w8 < 8; ++w8) lg += *(const LAS float*)(L + O_P + buf * P_BUF + (w8 * 128 + tid) * 4);
            float mx = lg;
            mx = fmaxf(mx, __builtin_bit_cast(float, __builtin_amdgcn_update_dpp(0, __builtin_bit_cast(int, mx), 0xB1, 0xF, 0xF, true)));
            mx = fmaxf(mx, __builtin_bit_cast(float, __builtin_amdgcn_update_dpp(0, __builtin_bit_cast(int, mx), 0x4E, 0xF, 0xF, true)));
            mx = fmaxf(mx, __builtin_bit_cast(float, __builtin_amdgcn_update_dpp(0, __builtin_bit_cast(int, mx), 0x141, 0xF, 0xF, true)));
            mx = fmaxf(mx, __builtin_bit_cast(float, __builtin_amdgcn_update_dpp(0, __builtin_bit_cast(int, mx), 0x140, 0xF, 0xF, true)));
            const float ex = expf(lg - mx); const float sum = dpp_sum16(ex);
            AFF[(size_t)(ch * 8) * 16 + tid] = ex / sum;
        }
    }
}

__device__ void ph_select(const Params& p, char* lds, int ngroups) {
    const int tid = tidx(), wid = tid >> 6, lane = tid & 63;
    unsigned* hist = (unsigned*)lds;
    unsigned* ctl = hist + 256;
    unsigned* wsum = ctl + 8;
    int* rowl = (int*)(wsum + 16);
    const float* AFF = (const float*)(p.ws + OFF_AFF);
    int* ROWIDX = (int*)(p.ws + OFF_ROWIDX); float* GATE = (float*)(p.ws + OFF_GATE); int* SLOT = (int*)(p.ws + OFF_SLOT);
    for (int gidx = bidx(); gidx < ngroups; gidx += gdim()) {
        const bool lat = gidx < 64; const int b = (gidx & 63) >> 4, e = gidx & 15;
        const int n = lat ? TL : TC, cap = lat ? CAPL : CAPC;
        const int row0 = lat ? b * TL : NLAT + b * TC, slot0 = lat ? b * CAPL : NB * CAPL + b * CAPC;
        unsigned key[8];
#pragma unroll
        for (int i = 0; i < 8; ++i) { const int idx = tid * 8 + i; key[i] = idx < n ? __float_as_uint(AFF[(size_t)(row0 + idx) * 16 + e]) : 0u; }
        unsigned prefix = 0u, remaining = (unsigned)cap;
#pragma unroll
        for (int pass = 0; pass < 4; ++pass) {
            const int sh = 24 - 8 * pass;
            __syncthreads();
            if (tid < 256) hist[tid] = 0u;
            __syncthreads();
#pragma unroll
            for (int i = 0; i < 8; ++i) { const int idx = tid * 8 + i;
                const bool cand = idx < n && (pass == 0 || (key[i] >> (sh + 8)) == prefix);
                if (cand) atomicAdd(&hist[(key[i] >> sh) & 255u], 1u); }
            __syncthreads();
            if (tid < 256) { unsigned gt = 0; for (int jj = tid + 1; jj < 256; ++jj) gt += hist[jj];
                const unsigned mine = hist[tid];
                if (gt < remaining && remaining <= gt + mine) { ctl[0] = (unsigned)tid; ctl[1] = remaining - gt; } }
            __syncthreads();
            prefix = (prefix << 8) | ctl[0]; remaining = ctl[1];
        }
        const unsigned T = prefix, m = remaining;
        unsigned cgt = 0, ceq = 0;
#pragma unroll
        for (int i = 0; i < 8; ++i) { const int idx = tid * 8 + i; if (idx < n) { cgt += key[i] > T ? 1u : 0u; ceq += key[i] == T ? 1u : 0u; } }
        auto block_excl = [&](unsigned v) -> unsigned {
            unsigned inc = v;
#pragma unroll
            for (int o = 1; o < 64; o <<= 1) { const unsigned t = (unsigned)__builtin_amdgcn_ds_bpermute((lane - o) << 2, (int)inc); if (lane >= o) inc += t; }
            __syncthreads();
            if (lane == 63) wsum[wid] = inc;
            __syncthreads();
            unsigned base = 0;
#pragma unroll
            for (int w = 0; w < 8; ++w) base += (w < wid) ? wsum[w] : 0u;
            return base + inc - v; };
        unsigned eqbase = block_excl(ceq);
        unsigned nsel = 0; bool sel[8];
#pragma unroll
        for (int i = 0; i < 8; ++i) { const int idx = tid * 8 + i; bool s_ = false;
            if (idx < n) { if (key[i] > T) s_ = true; else if (key[i] == T) { s_ = eqbase < m; ++eqbase; } }
            sel[i] = s_; nsel += s_ ? 1u : 0u; }
        unsigned sbase = block_excl(nsel);
#pragma unroll
        for (int i = 0; i < 8; ++i) { const int idx = tid * 8 + i;
            if (idx < n) {
                if (sel[i]) { const int sl = slot0 + (int)sbase; rowl[sbase] = row0 + idx; ++sbase; ROWIDX[e * ESLOTS + sl] = row0 + idx; GATE[e * EPAD + sl] = __uint_as_float(key[i]); SLOT[(size_t)(row0 + idx) * 16 + e] = sl; }
                else SLOT[(size_t)(row0 + idx) * 16 + e] = -1; } }
        __syncthreads();
        { const bf16_t* BN = (const bf16_t*)(p.ws + OFF_H); bf16_t* XE = (bf16_t*)(p.ws + OFF_XE);
          for (int r = wid; r < cap; r += 32) {
              u32x4 t_[4][2];
#pragma unroll
              for (int u = 0; u < 4; ++u) { const u32x4* src = (const u32x4*)(BN + (size_t)rowl[r + 8 * u] * D); t_[u][0] = src[lane]; t_[u][1] = src[lane + 64]; }
#pragma unroll
              for (int u = 0; u < 4; ++u) { u32x4* dst = (u32x4*)(XE + ((size_t)e * EPAD + slot0 + r + 8 * u) * D); dst[lane] = t_[u][0]; dst[lane + 64] = t_[u][1]; } } }
    }
}

__device__ void ph_gather(const Params& p, int nslots) {
    const int wid = tidx() >> 6, lane = tidx() & 63;
    const int* ROWIDX = (const int*)(p.ws + OFF_ROWIDX); const bf16_t* BN = (const bf16_t*)(p.ws + OFF_H); bf16_t* XE = (bf16_t*)(p.ws + OFF_XE);
    for (int it = bidx() * 8 + wid; it < NE * ESLOTS; it += gdim() * 8) {
        const int e = it / ESLOTS, sl = it % ESLOTS; if (sl >= nslots) continue; const int row = ROWIDX[it];
        const u32x4* src = (const u32x4*)(BN + (size_t)row * D); u32x4* dst = (u32x4*)(XE + ((size_t)e * EPAD + sl) * D);
        dst[lane] = src[lane]; dst[lane + 64] = src[lane + 64];
    }
}

__device__ void ph_combine(const Params& p, int layer, int nrows) {
    const int wid = tidx() >> 6, lane = tidx() & 63;
    const int* SLOT = (const int*)(p.ws + OFF_SLOT); const bf16_t* YE = (const bf16_t*)(p.ws + OFF_YE); xt_t* X = (xt_t*)(p.ws + OFF_X);
    int row = bidx() * 8 + wid;
    int sl = (row < nrows && lane < 16) ? SLOT[(size_t)row * 16 + lane] : -1;
    while (row < nrows) {
        const int nrow = row + gdim() * 8;
        const int sln = (nrow < nrows && lane < 16) ? SLOT[(size_t)nrow * 16 + lane] : -1;
        const float* gt = modp(p, layer, row_stream(row), 5);
        xt_t* xr = X + (size_t)row * D + lane * 8;
        f32x4 xv[4];
#pragma unroll
        for (int i = 0; i < 2; ++i) { xv[2 * i] = xldv(xr, 512 * i); xv[2 * i + 1] = xldv(xr, 512 * i + 4); }
        unsigned long long m = __ballot(sl >= 0);
        float acc[16];
#pragma unroll
        for (int i = 0; i < 16; ++i) acc[i] = 0.f;
        while (m) {
            const int e0 = __builtin_ctzll(m); m &= m - 1; const bool two = m != 0; const int e1 = two ? __builtin_ctzll(m) : e0; if (two) m &= m - 1;
            const int s0 = __builtin_amdgcn_readlane(sl, e0), s1 = __builtin_amdgcn_readlane(sl, e1);
            const bf16_t* y0 = YE + ((size_t)e0 * EPAD + s0) * D + lane * 8; const bf16_t* y1 = YE + ((size_t)e1 * EPAD + s1) * D + lane * 8;
            const u32x4 a0 = *(const u32x4*)y0, a1 = *(const u32x4*)(y0 + 512), b0 = *(const u32x4*)y1, b1 = *(const u32x4*)(y1 + 512);
            const float f1 = two ? 1.f : 0.f;
#pragma unroll
            for (int i = 0; i < 4; ++i) { acc[2 * i] += __uint_as_float(a0[i] << 16) + f1 * __uint_as_float(b0[i] << 16); acc[2 * i + 1] += __uint_as_float(a0[i] & 0xffff0000u) + f1 * __uint_as_float(b0[i] & 0xffff0000u);
                acc[8 + 2 * i] += __uint_as_float(a1[i] << 16) + f1 * __uint_as_float(b1[i] << 16); acc[8 + 2 * i + 1] += __uint_as_float(a1[i] & 0xffff0000u) + f1 * __uint_as_float(b1[i] & 0xffff0000u); }
        }
#pragma unroll
        for (int i = 0; i < 2; ++i) { const f32x4 g0 = *(const f32x4*)(gt + lane * 8 + 512 * i), g1 = *(const f32x4*)(gt + lane * 8 + 512 * i + 4);
            f32x4 o0 = xv[2 * i], o1 = xv[2 * i + 1];
#pragma unroll
            for (int e = 0; e < 4; ++e) { o0[e] += g0[e] * acc[8 * i + e]; o1[e] += g1[e] * acc[8 * i + 4 + e]; }
            xstv(xr, 512 * i, o0); xstv(xr, 512 * i + 4, o1); }
        row = nrow; sl = sln;
    }
}

template <bool FINAL>
__device__ void ph_comb_norm(const Params& p, int lprev, int layer, int nrows) {
    const int wid = tidx() >> 6, lane = tidx() & 63;
    const int* SLOT = (const int*)(p.ws + OFF_SLOT); const bf16_t* YE = (const bf16_t*)(p.ws + OFF_YE); xt_t* X = (xt_t*)(p.ws + OFF_X);
    bf16_t* H = (bf16_t*)(p.ws + OFF_H);
    const float* g = FINAL ? p.final_g : p.norm1_g + layer * D;
    int row = bidx() * 8 + wid;
    int sl = (row < nrows && lane < 16) ? SLOT[(size_t)row * 16 + lane] : -1;
    while (row < nrows) {
        const int nrow = row + gdim() * 8;
        const int sln = (nrow < nrows && lane < 16) ? SLOT[(size_t)nrow * 16 + lane] : -1;
        const int strm = row_stream(row);
        const float* gt = modp(p, lprev, strm, 5);
        xt_t* xr = X + (size_t)row * D + lane * 8;
        f32x4 xv[4];
#pragma unroll
        for (int i = 0; i < 2; ++i) { xv[2 * i] = xldv(xr, 512 * i); xv[2 * i + 1] = xldv(xr, 512 * i + 4); }
        unsigned long long m = __ballot(sl >= 0);
        float acc[16];
#pragma unroll
        for (int i = 0; i < 16; ++i) acc[i] = 0.f;
        while (m) {
            const int e0 = __builtin_ctzll(m); m &= m - 1; const bool two = m != 0; const int e1 = two ? __builtin_ctzll(m) : e0; if (two) m &= m - 1;
            const int s0 = __builtin_amdgcn_readlane(sl, e0), s1 = __builtin_amdgcn_readlane(sl, e1);
            const bf16_t* y0 = YE + ((size_t)e0 * EPAD + s0) * D + lane * 8; const bf16_t* y1 = YE + ((size_t)e1 * EPAD + s1) * D + lane * 8;
            const u32x4 a0 = *(const u32x4*)y0, a1 = *(const u32x4*)(y0 + 512), b0 = *(const u32x4*)y1, b1 = *(const u32x4*)(y1 + 512);
            const float f1 = two ? 1.f : 0.f;
#pragma unroll
            for (int i = 0; i < 4; ++i) { acc[2 * i] += __uint_as_float(a0[i] << 16) + f1 * __uint_as_float(b0[i] << 16); acc[2 * i + 1] += __uint_as_float(a0[i] & 0xffff0000u) + f1 * __uint_as_float(b0[i] & 0xffff0000u);
                acc[8 + 2 * i] += __uint_as_float(a1[i] << 16) + f1 * __uint_as_float(b1[i] << 16); acc[8 + 2 * i + 1] += __uint_as_float(a1[i] & 0xffff0000u) + f1 * __uint_as_float(b1[i] & 0xffff0000u); }
        }
        float ss = 0.f;
#pragma unroll
        for (int i = 0; i < 2; ++i) { const f32x4 g0 = *(const f32x4*)(gt + lane * 8 + 512 * i), g1 = *(const f32x4*)(gt + lane * 8 + 512 * i + 4);
#pragma unroll
            for (int e = 0; e < 4; ++e) { xv[2 * i][e] += g0[e] * acc[8 * i + e]; xv[2 * i + 1][e] += g1[e] * acc[8 * i + 4 + e]; ss += xv[2 * i][e] * xv[2 * i][e] + xv[2 * i + 1][e] * xv[2 * i + 1][e]; }
            if (!FINAL) { xstv(xr, 512 * i, xv[2 * i]); xstv(xr, 512 * i + 4, xv[2 * i + 1]); } }
        ss = wave_sum(ss); const float rs = rsqrtf(ss * (1.f / D) + RMS_EPS);
        const float* sh = FINAL ? nullptr : modp(p, layer, strm, 0); const float* sc = FINAL ? nullptr : modp(p, layer, strm, 1);
#pragma unroll
        for (int i = 0; i < 2; ++i)
#pragma unroll
            for (int hh = 0; hh < 2; ++hh) { const int d = lane * 8 + 512 * i + 4 * hh; const f32x4 gg = *(const f32x4*)(g + d); f32x4 o = xv[2 * i + hh] * rs * gg;
                if (FINAL) *(f32x4*)(p.out + (size_t)row * D + d) = o;
                else { o = o * (1.f + *(const f32x4*)(sc + d)) + *(const f32x4*)(sh + d); stbf4(H + (size_t)row * D + d, o); } }
        row = nrow; sl = sln;
    }
}

__device__ void ph_rw_normxs(const Params& p, int layer, int j) {
    const int wid = tidx() >> 6, lane = tidx() & 63;
    const xt_t* X = (const xt_t*)(p.ws + OFF_X); bf16_t* XS = (bf16_t*)(p.ws + OFF_XS);
    const float* mu = p.rw_mu + (size_t)j * 6 * D; const float* g = p.norm1_g + layer * D;
    const int w = bidx() * 8 + wid, nw = gdim() * 8;
    const int r0 = (int)((long long)w * NROW / nw), r1 = (int)((long long)(w + 1) * NROW / nw);
    if (r0 >= r1) return;
    float4 um[6][4];
#pragma unroll
    for (int m = 0; m < 6; ++m)
#pragma unroll
        for (int i = 0; i < 4; ++i) um[m][i] = *(const float4*)(mu + m * D + (lane + i * 64) * 4);
    float4 gm[4], bb[4]; int scur = -1;
    float4 hp[4], hc[4], hn[4], raw[4];
#define XS_NORM(dst, src, R) do { const int s_ = row_stream(R); \
        if (s_ != scur) { scur = s_; const float* sh_ = modp(p, layer, s_, 0); const float* sc_ = modp(p, layer, s_, 1); \
            _Pragma("unroll") for (int i = 0; i < 4; ++i) { const int d_ = (lane + i * 64) * 4; const float4 gg_ = *(const float4*)(g + d_), a_ = *(const float4*)(sc_ + d_); bb[i] = *(const float4*)(sh_ + d_); \
                gm[i] = make_float4(gg_.x * (1.f + a_.x), gg_.y * (1.f + a_.y), gg_.z * (1.f + a_.z), gg_.w * (1.f + a_.w)); } } \
        float ss_ = 0.f; \
        _Pragma("unroll") for (int i = 0; i < 4; ++i) ss_ += src[i].x * src[i].x + src[i].y * src[i].y + src[i].z * src[i].z + src[i].w * src[i].w; \
        ss_ = wave_sum(ss_); const float rs_ = rsqrtf(ss_ * (1.f / D) + RMS_EPS); \
        _Pragma("unroll") for (int i = 0; i < 4; ++i) dst[i] = make_float4(src[i].x * rs_ * gm[i].x + bb[i].x, src[i].y * rs_ * gm[i].y + bb[i].y, src[i].z * rs_ * gm[i].z + bb[i].z, src[i].w * rs_ * gm[i].w + bb[i].w); } while (0)
#define XS_RAW(R) do { _Pragma("unroll") for (int i = 0; i < 4; ++i) raw[i] = xld(X, (size_t)(R) * D + (lane + i * 64) * 4); } while (0)
    if (r0 > 0) { XS_RAW(r0 - 1); XS_NORM(hp, raw, r0 - 1); }
    else {
#pragma unroll
        for (int i = 0; i < 4; ++i) hp[i] = make_float4(0.f, 0.f, 0.f, 0.f); }
    XS_RAW(r0); XS_NORM(hc, raw, r0);
    if (r0 + 1 < NROW) XS_RAW(r0 + 1);
    for (int row = r0; row < r1; ++row) {
        const bool lat = row < NLAT; const int t = lat ? (row & (TL - 1)) : ((row - NLAT) & (TC - 1)); const int len = lat ? TL : TC;
        const float fp_ = t > 0 ? 0.5f : 0.f, fn_ = t < len - 1 ? 0.5f : 0.f;
        if (row + 1 < NROW) XS_NORM(hn, raw, row + 1);
        else {
#pragma unroll
            for (int i = 0; i < 4; ++i) hn[i] = make_float4(0.f, 0.f, 0.f, 0.f); }
        if (row + 1 < r1 && row + 2 < NROW) XS_RAW(row + 2);
#pragma unroll
        for (int i = 0; i < 4; ++i) {
            const int d = (lane + i * 64) * 4;
            const float4 h = hc[i];
            const float4 xx = make_float4(fp_ * hp[i].x + fn_ * hn[i].x - h.x, fp_ * hp[i].y + fn_ * hn[i].y - h.y, fp_ * hp[i].z + fn_ * hn[i].z - h.z, fp_ * hp[i].w + fn_ * hn[i].w - h.w);
#pragma unroll
            for (int m = 0; m < 6; ++m) { const float4 u = um[m][i];
                uint2 wv_; wv_.x = pk2(h.x + xx.x * u.x, h.y + xx.y * u.y); wv_.y = pk2(h.z + xx.z * u.z, h.w + xx.w * u.w);
                *(uint2*)(XS + ((size_t)m * NROW + row) * D + d) = wv_; }
        }
#pragma unroll
        for (int i = 0; i < 4; ++i) { hp[i] = hc[i]; hc[i] = hn[i]; }
    }
#undef XS_NORM
#undef XS_RAW
}

__device__ __forceinline__ int scan_row(int i, int b, int z) {
    return i < TC ? NLAT + b * TC + (z ? TC - 1 - i : i) : b * TL + (z ? TL - 1 - (i - TC) : i - TC);
}
__device__ __forceinline__ float dpp_sum8(float x) {
    x += __builtin_bit_cast(float, __builtin_amdgcn_update_dpp(0, __builtin_bit_cast(int, x), 0xB1, 0xF, 0xF, true));
    x += __builtin_bit_cast(float, __builtin_amdgcn_update_dpp(0, __builtin_bit_cast(int, x), 0x4E, 0xF, 0xF, true));
    x += __builtin_bit_cast(float, __builtin_amdgcn_update_dpp(0, __builtin_bit_cast(int, x), 0x141, 0xF, 0xF, true));
    return x;
}
__device__ void ph_rw_scan(const Params& p, int j, char* lds) {
    const int tid = tidx(), wid = __builtin_amdgcn_readfirstlane(tid >> 6), lane = tid & 63;
    const size_t PL = (size_t)NROW * D;
    const float* RKV = (const float*)(p.ws + OFF_RKV); float* Y = (float*)(p.ws + OFF_Y);
    constexpr int CH = 32, BUFB = 5 * CH * 256 + CH * 128 + CH * 16, YB = CH * 32 * 4, NCH = (TC + TL) / CH;
    const bool loader = wid >= 4; const int lw = wid - 4;
    for (int it = bidx(); it < 256; it += gdim()) {
        const int vh = it & 1, z = (it >> 1) & 1, h = (it >> 2) & 15, b = it >> 6;
        const char* pl0 = (const char*)((const float*)(p.ws + OFF_W) + z * PL); const char* pl1 = (const char*)(RKV + PL);
        const char* pl2 = (const char*)((const float*)(p.ws + OFF_AV) + z * PL); const char* pl3 = (const char*)RKV;
        const char* vpl = (const char*)(RKV + 2 * PL);
        float* yout = Y + z * PL;
        __builtin_amdgcn_s_barrier();
        if (loader) {
            const int pq = lane & 15;
            const f32x4 kkv = *(const f32x4*)(p.rw_k_k + j * D + h * 64 + pq * 4), kav = *(const f32x4*)(p.rw_k_a + j * D + h * 64 + pq * 4);
            auto issue = [&](int c) {
                char* buf = lds + (c % 3) * BUFB;
#pragma unroll
                for (int q = 0; q < 8; ++q) { const int pi = q >> 1, tg = lw * 2 + (q & 1); const int row = scan_row(c * CH + tg * 4 + (lane >> 4), b, z);
                    const char* base = pi == 0 ? pl0 : pi == 1 ? pl1 : pi == 2 ? pl2 : pl3;
                    __builtin_amdgcn_global_load_lds((const unsigned*)(base + (size_t)row * D * 4 + h * 256 + (lane & 15) * 16), (LAS unsigned*)(buf + pi * (CH * 256) + tg * 1024), 16, 0, 0); }
                { const int row = scan_row(c * CH + lw * 8 + (lane >> 3), b, z);
                  __builtin_amdgcn_global_load_lds((const unsigned*)(vpl + (size_t)row * D * 4 + (h * 64 + vh * 32) * 4 + (lane & 7) * 16), (LAS unsigned*)(buf + 5 * CH * 256 + lw * 1024), 16, 0, 0); }
            };
            auto prep = [&](int c) {
                char* buf = lds + (c % 3) * BUFB;
#pragma unroll
                for (int ps = 0; ps < 2; ++ps) { const int ptok = lw * 8 + ps * 4 + (lane >> 4);
                    f32x4* kp = (f32x4*)(buf + 1 * CH * 256 + ptok * 256 + pq * 16); f32x4* ap = (f32x4*)(buf + 2 * CH * 256 + ptok * 256 + pq * 16); f32x4* dp = (f32x4*)(buf + 4 * CH * 256 + ptok * 256 + pq * 16);
                    f32x4* rp = (f32x4*)(buf + 3 * CH * 256 + ptok * 256 + pq * 16); const f32x4 wv = *(const f32x4*)(buf + ptok * 256 + pq * 16);
                    const f32x4 k = *kp, a = *ap, r = *rp; f32x4 kk = k * kkv;
                    float ss = kk[0] * kk[0] + kk[1] * kk[1] + kk[2] * kk[2] + kk[3] * kk[3]; ss = dpp_sum16(ss);
                    const float inv = 1.f / fmaxf(sqrtf(ss), 1e-12f); kk = kk * inv;
                    const f32x4 kd = k * (1.f + (a - 1.f) * kav), bb = kk * a;
                    const f32x4 t1 = bb * r, t2 = kd * r;
                    const float br = dpp_sum16((t1[0] + t1[1]) + (t1[2] + t1[3])), kr = dpp_sum16((t2[0] + t2[1]) + (t2[2] + t2[3]));
                    *dp = kd; *ap = bb; *kp = kk; *rp = wv * r;
                    if (pq == 0) *(float2*)(buf + 5 * CH * 256 + CH * 128 + ptok * 16) = make_float2(br, kr); }
            };
            issue(0); issue(1);
            asm volatile("s_waitcnt vmcnt(9)" ::: "memory");
            prep(0);
            asm volatile("s_waitcnt lgkmcnt(0)" ::: "memory"); __builtin_amdgcn_s_barrier();
            for (int c = 0; c < NCH; ++c) {
                if (c >= 1) { const float* yb = (const float*)(lds + 3 * BUFB + ((c - 1) & 1) * YB);
                    const int lt = tid - 256, t = lt >> 3, q = lt & 7; const int row = scan_row((c - 1) * CH + t, b, z);
                    *(f32x4*)(yout + (size_t)row * D + h * 64 + vh * 32 + q * 4) = *(const f32x4*)(yb + t * 32 + q * 4); }
                if (c + 2 < NCH) { issue(c + 2); asm volatile("s_waitcnt vmcnt(9)" ::: "memory"); } else asm volatile("s_waitcnt vmcnt(0)" ::: "memory");
                if (c + 1 < NCH) prep(c + 1);
                asm volatile("s_waitcnt lgkmcnt(0)" ::: "memory"); __builtin_amdgcn_s_barrier();
            }
            { const float* yb = (const float*)(lds + 3 * BUFB + ((NCH - 1) & 1) * YB);
              const int lt = tid - 256, t = lt >> 3, q = lt & 7; const int row = scan_row((NCH - 1) * CH + t, b, z);
              *(f32x4*)(yout + (size_t)row * D + h * 64 + vh * 32 + q * 4) = *(const f32x4*)(yb + t * 32 + q * 4); }
        } else {
            const int vr = lane >> 3, ks = lane & 7;
            f32x4 Sa = {0.f, 0.f, 0.f, 0.f}, Sb = {0.f, 0.f, 0.f, 0.f};
            __builtin_amdgcn_s_barrier();
            struct Ops { f32x4 w0, w1, kk0, kk1, bb0, bb1, r0, r1, kd0, kd1; float v; float2 sc; };
#define SC_LOAD(O, t) do { const char* q_ = bq + (t) * 256; O.w0 = *(const f32x4*)(q_); O.w1 = *(const f32x4*)(q_ + 16); O.kk0 = *(const f32x4*)(q_ + CH * 256); O.kk1 = *(const f32x4*)(q_ + CH * 256 + 16); \
                O.bb0 = *(const f32x4*)(q_ + 2 * CH * 256); O.bb1 = *(const f32x4*)(q_ + 2 * CH * 256 + 16); O.r0 = *(const f32x4*)(q_ + 3 * CH * 256); O.r1 = *(const f32x4*)(q_ + 3 * CH * 256 + 16); \
                O.kd0 = *(const f32x4*)(q_ + 4 * CH * 256); O.kd1 = *(const f32x4*)(q_ + 4 * CH * 256 + 16); O.v = *(const float*)(vq + (t) * 128); O.sc = *(const float2*)(buf + 5 * CH * 256 + CH * 128 + (t) * 16); } while (0)
#define SC_STEP(O, t) do { const f32x4 d1 = Sa * O.kk0 + Sb * O.kk1, d2 = Sa * O.r0 + Sb * O.r1; \
                float sa = -((d1[0] + d1[1]) + (d1[2] + d1[3])), yy = (d2[0] + d2[1]) + (d2[2] + d2[3]); \
                sa = dpp_sum8(sa); yy = dpp_sum8(yy); \
                Sa = Sa * O.w0 + (sa * O.bb0 + O.v * O.kd0); Sb = Sb * O.w1 + (sa * O.bb1 + O.v * O.kd1); \
                if (ks == 0) yb[(t) * 32 + wid * 8 + vr] = yy + sa * O.sc.x + O.v * O.sc.y; } while (0)
            for (int c = 0; c < NCH; ++c) {
                const char* buf = lds + (c % 3) * BUFB; float* yb = (float*)(lds + 3 * BUFB + (c & 1) * YB);
                const char* bq = buf + ks * 32; const char* vq = buf + 5 * CH * 256 + (wid * 8 + vr) * 4;
                Ops oA, oB, oC;
                SC_LOAD(oA, 0); SC_LOAD(oB, 1);
#pragma unroll
                for (int t = 0; t < CH; t += 3) {
                    if (t + 2 < CH) SC_LOAD(oC, t + 2);
                    SC_STEP(oA, t);
                    if (t + 3 < CH) SC_LOAD(oA, t + 3);
                    if (t + 1 < CH) SC_STEP(oB, t + 1);
                    if (t + 4 < CH) SC_LOAD(oB, t + 4);
                    if (t + 2 < CH) SC_STEP(oC, t + 2);
                }
                asm volatile("s_waitcnt lgkmcnt(0)" ::: "memory"); __builtin_amdgcn_s_barrier();
            }
#undef SC_LOAD
#undef SC_STEP
        }
    }
}


namespace ck {
constexpr int P = 72, MB = 64 * P * 2;
typedef __attribute__((address_space(3))) char lchar;
__device__ __forceinline__ f32x4 mm_tile(const lchar* Aop, const lchar* Bop, int ti, int tj, int c, int q, f32x4 acc) {
#pragma unroll
    for (int ks = 0; ks < 2; ++ks) {
        const bf16x8 a = *(const LAS bf16x8*)(Aop + ((16 * ti + c) * P + 32 * ks + 8 * q) * 2);
        const bf16x8 b = *(const LAS bf16x8*)(Bop + ((16 * tj + c) * P + 32 * ks + 8 * q) * 2);
        acc = __builtin_amdgcn_mfma_f32_16x16x32_bf16(a, b, acc, 0, 0, 0);
    }
    return acc;
}
__device__ __forceinline__ f32x4 mm_diag(const lchar* Aop, const lchar* Bop, int tt, int c, int q, f32x4 acc) {
    const int ks = tt >> 1;
    bf16x8 a = *(const LAS bf16x8*)(Aop + ((16 * tt + c) * P + 32 * ks + 8 * q) * 2);
    const bf16x8 b = *(const LAS bf16x8*)(Bop + ((16 * tt + c) * P + 32 * ks + 8 * q) * 2);
    if ((q >> 1) != (tt & 1)) a = (bf16x8){0, 0, 0, 0, 0, 0, 0, 0};
    return __builtin_amdgcn_mfma_f32_16x16x32_bf16(a, b, acc, 0, 0, 0);
}
__device__ __forceinline__ void st_tile(lchar* dst, int ti, int tj, int c, int q, f32x4 v) {
    u32x2 w; w.x = pk2(v[0], v[1]); w.y = pk2(v[2], v[3]); *(LAS u32x2*)(dst + ((16 * tj + c) * P + 16 * ti + 4 * q) * 2) = w;
}
__device__ __forceinline__ f32x4 ld_tile(const lchar* src, int ti, int tj, int c, int q) {
    const u32x2 w = *(const LAS u32x2*)(src + ((16 * tj + c) * P + 16 * ti + 4 * q) * 2);
    return (f32x4){__uint_as_float(w.x << 16), __uint_as_float(w.x & 0xffff0000u), __uint_as_float(w.y << 16), __uint_as_float(w.y & 0xffff0000u)};
}
__device__ __forceinline__ void st_glob(bf16_t* dst, int ti, int tj, int c, int q, f32x4 v) {
    uint2 w; w.x = pk2(v[0], v[1]); w.y = pk2(v[2], v[3]); *(uint2*)(dst + (16 * tj + c) * 64 + 16 * ti + 4 * q) = w;
}
typedef float f32x16 __attribute__((ext_vector_type(16)));
__device__ __forceinline__ f32x16 mm32(const lchar* Aop, const lchar* Bop, int ti, int tj, int r32, int hi, f32x16 acc) {
    bf16x8 a[4], b[4];
#pragma unroll
    for (int ks = 0; ks < 4; ++ks) {
        a[ks] = *(const LAS bf16x8*)(Aop + ((32 * ti + r32) * P + 16 * ks + 8 * hi) * 2);
        b[ks] = *(const LAS bf16x8*)(Bop + ((32 * tj + r32) * P + 16 * ks + 8 * hi) * 2); }
    __builtin_amdgcn_sched_barrier(0);
#pragma unroll
    for (int ks = 0; ks < 4; ++ks) acc = __builtin_amdgcn_mfma_f32_32x32x16_bf16(a[ks], b[ks], acc, 0, 0, 0);
    return acc;
}
__device__ __forceinline__ void st32(lchar* dst, int ti, int tj, int r32, int hi, const f32x16& v) {
#pragma unroll
    for (int g = 0; g < 4; ++g) { u32x2 w; w.x = pk2(v[4 * g], v[4 * g + 1]); w.y = pk2(v[4 * g + 2], v[4 * g + 3]); *(LAS u32x2*)(dst + ((32 * tj + r32) * P + 32 * ti + 8 * g + 4 * hi) * 2) = w; }
}
__device__ __forceinline__ f32x16 ld32(const lchar* src, int ti, int tj, int r32, int hi) {
    f32x16 v;
#pragma unroll
    for (int g = 0; g < 4; ++g) { const u32x2 w = *(const LAS u32x2*)(src + ((32 * tj + r32) * P + 32 * ti + 8 * g + 4 * hi) * 2);
        v[4 * g] = __uint_as_float(w.x << 16); v[4 * g + 1] = __uint_as_float(w.x & 0xffff0000u); v[4 * g + 2] = __uint_as_float(w.y << 16); v[4 * g + 3] = __uint_as_float(w.y & 0xffff0000u); }
    return v;
}
__device__ __forceinline__ void stg32(bf16_t* dst, int ti, int tj, int r32, int hi, const f32x16& v) {
#pragma unroll
    for (int g = 0; g < 4; ++g) { uint2 w; w.x = pk2(v[4 * g], v[4 * g + 1]); w.y = pk2(v[4 * g + 2], v[4 * g + 3]); *(uint2*)(dst + (32 * tj + r32) * 64 + 32 * ti + 8 * g + 4 * hi) = w; }
}
}

#define LBAR() do { asm volatile("s_waitcnt lgkmcnt(0)" ::: "memory"); __builtin_amdgcn_s_barrier(); asm volatile("" ::: "memory"); } while (0)
__device__ void ph_rw_sc1(const Params& p, int j, char* lds) {
    using namespace ck;
    const int tid = tidx(), wid = __builtin_amdgcn_readfirstlane(tid >> 6), lane = tid & 63, c = lane & 15, q = lane >> 4;
    const size_t PL = (size_t)NROW * D;
    const bf16_t* RKV = (const bf16_t*)(p.ws + OFF_RKV); const float* LW = (const float*)(p.ws + OFF_W); const bf16_t* AV = (const bf16_t*)(p.ws + OFF_AV);
    bf16_t* CK = (bf16_t*)(p.ws + OFF_CK);
    lchar* B0 = (lchar*)lds;
#define BUF(i) (B0 + (i) * MB)
    LAS float* Lbuf = (LAS float*)BUF(8);
    LAS float* Lseg = (LAS float*)(B0 + 16 * MB);
    LAS float* GC = Lseg + 8 * 64;
    const int pt = tid >> 3, cg = tid & 7;
    f32x4 nlw[2], nkk[2], nka[2]; u32x4 nkx, nax, nrx, nvx;
#define SC1_LOAD(IT) do { const int seq_ = (IT) / NCHK, ch_ = (IT) % NCHK; const int z_ = seq_ & 1, h_ = (seq_ >> 1) & 15, b_ = seq_ >> 5; \
        const size_t go_ = (size_t)scan_row(ch_ * 64 + pt, b_, z_) * D + h_ * 64 + cg * 8; \
        _Pragma("unroll") for (int e = 0; e < 2; ++e) nlw[e] = *(const f32x4*)(LW + z_ * PL + go_ + 4 * e); \
        nkx = *(const u32x4*)(RKV + PL + go_); nax = *(const u32x4*)(AV + z_ * PL + go_); nrx = *(const u32x4*)(RKV + go_); nvx = *(const u32x4*)(RKV + 2 * PL + go_); \
        _Pragma("unroll") for (int e = 0; e < 2; ++e) { nkk[e] = *(const f32x4*)(p.rw_k_k + j * D + h_ * 64 + cg * 8 + 4 * e); nka[e] = *(const f32x4*)(p.rw_k_a + j * D + h_ * 64 + cg * 8 + 4 * e); } } while (0)
    if (bidx() < 128 * NCHK) SC1_LOAD(bidx());
    for (int it = bidx(); it < 128 * NCHK; it += gdim()) {
        const int seq = it / NCHK; const int h = (seq >> 1) & 15;
        f32x4 lw[2], kx[2], ax[2], rx[2], vx[2], kkc[2], kac[2];
#pragma unroll
        for (int e = 0; e < 2; ++e) { lw[e] = nlw[e]; kkc[e] = nkk[e]; kac[e] = nka[e];
            kx[e] = (f32x4){__uint_as_float(nkx[2 * e] << 16), __uint_as_float(nkx[2 * e] & 0xffff0000u), __uint_as_float(nkx[2 * e + 1] << 16), __uint_as_float(nkx[2 * e + 1] & 0xffff0000u)};
            ax[e] = (f32x4){__uint_as_float(nax[2 * e] << 16), __uint_as_float(nax[2 * e] & 0xffff0000u), __uint_as_float(nax[2 * e + 1] << 16), __uint_as_float(nax[2 * e + 1] & 0xffff0000u)};
            rx[e] = (f32x4){__uint_as_float(nrx[2 * e] << 16), __uint_as_float(nrx[2 * e] & 0xffff0000u), __uint_as_float(nrx[2 * e + 1] << 16), __uint_as_float(nrx[2 * e + 1] & 0xffff0000u)};
            vx[e] = (f32x4){__uint_as_float(nvx[2 * e] << 16), __uint_as_float(nvx[2 * e] & 0xffff0000u), __uint_as_float(nvx[2 * e + 1] << 16), __uint_as_float(nvx[2 * e + 1] & 0xffff0000u)}; }
        f32x4 rkc[2];
#pragma unroll
        for (int e = 0; e < 2; ++e) rkc[e] = *(const f32x4*)(p.rw_r_k + j * D + h * 64 + cg * 8 + 4 * e);
        if (it + gdim() < 128 * NCHK) SC1_LOAD(it + gdim());
        LBAR();
#pragma unroll
        for (int e = 0; e < 2; ++e) *(LAS f32x4*)(Lbuf + pt * 64 + cg * 8 + 4 * e) = lw[e];
        f32x4 kk[2], bq[2], kd[2];
        { float ss = 0.f;
#pragma unroll
          for (int e = 0; e < 2; ++e) { kk[e] = kx[e] * kkc[e]; ss += kk[e][0] * kk[e][0] + kk[e][1] * kk[e][1] + kk[e][2] * kk[e][2] + kk[e][3] * kk[e][3]; }
          ss = dpp_sum8(ss); const float inv = __builtin_amdgcn_rsqf(fmaxf(ss, 1e-24f));
#pragma unroll
          for (int e = 0; e < 2; ++e) { kk[e] = kk[e] * inv; bq[e] = kk[e] * ax[e]; kd[e] = kx[e] * (1.f + (ax[e] - 1.f) * kac[e]); } }
        LBAR();
        { const int k = tid & 63, sg = tid >> 6; float run = 0.f;
#pragma unroll
          for (int u = 0; u < 8; ++u) { run += Lbuf[(sg * 8 + u) * 64 + k]; Lbuf[(sg * 8 + u) * 64 + k] = run; }
          Lseg[sg * 64 + k] = run; }
        LBAR();
        f32x4 Lt[2], Lp[2], Lc[2];
        { const int sg = pt >> 3, sgp = (pt - 1) >> 3;
#pragma unroll
          for (int e = 0; e < 2; ++e) { f32x4 o0 = {0.f, 0.f, 0.f, 0.f}, o1 = o0, oc = o0;
#pragma unroll
              for (int u = 0; u < 8; ++u) { const f32x4 sv = *(const LAS f32x4*)(Lseg + u * 64 + cg * 8 + 4 * e); if (u < sg) o0 = o0 + sv; if (u < sgp) o1 = o1 + sv; if (u < 7) oc = oc + sv; }
              Lt[e] = *(const LAS f32x4*)(Lbuf + pt * 64 + cg * 8 + 4 * e) + o0;
              Lp[e] = pt > 0 ? *(const LAS f32x4*)(Lbuf + (pt - 1) * 64 + cg * 8 + 4 * e) + o1 : (f32x4){0.f, 0.f, 0.f, 0.f};
              Lc[e] = *(const LAS f32x4*)(Lbuf + 63 * 64 + cg * 8 + 4 * e) + oc; } }
        LBAR();
        {
            float at[8], bt[8], kt[8], rt[8], bh[8], kh[8], vv[8];
#pragma unroll
            for (int e = 0; e < 2; ++e)
#pragma unroll
                for (int u = 0; u < 4; ++u) { const int x = 4 * e + u; const float eL = __expf(Lt[e][u]), emL = __expf(-Lt[e][u]), eP = __expf(Lp[e][u]), eC = __expf(Lc[e][u] - Lt[e][u]);
                    at[x] = -kk[e][u] * eP; bt[x] = bq[e][u] * emL; kt[x] = kd[e][u] * emL; rt[x] = rx[e][u] * eL; bh[x] = bq[e][u] * eC; kh[x] = kd[e][u] * eC; vv[x] = vx[e][u];
                    if (pt == 63) GC[cg * 8 + x] = eL; }
#define ST8(bufi, arr) do { u32x4 w_ = {pk2(arr[0], arr[1]), pk2(arr[2], arr[3]), pk2(arr[4], arr[5]), pk2(arr[6], arr[7])}; *(LAS u32x4*)(BUF(bufi) + (pt * P + cg * 8) * 2) = w_; } while (0)
            ST8(0, at); ST8(1, bt); ST8(2, kt); ST8(3, rt); ST8(8, bh); ST8(9, kh); ST8(10, vv);
#undef ST8
            float bsv = 0.f;
#pragma unroll
            for (int e = 0; e < 2; ++e) bsv += rx[e][0] * kd[e][0] * rkc[e][0] + rx[e][1] * kd[e][1] * rkc[e][1] + rx[e][2] * kd[e][2] * rkc[e][2] + rx[e][3] * kd[e][3] * rkc[e][3];
            bsv = dpp_sum8(bsv);
            if (cg == 0) { const int z_ = seq & 1, b_ = seq >> 5; ((float*)(p.ws + OFF_BS))[((size_t)z_ * NROW + scan_row((it % NCHK) * 64 + pt, b_, z_)) * 16 + h] = bsv; }
        }
        LBAR();
        {
            const int k = tid & 63, tg = tid >> 6;
#define TR8(src, dst) do { unsigned w_[4]; _Pragma("unroll") for (int x = 0; x < 4; ++x) { const unsigned lo = *(const LAS bf16_t*)(BUF(src) + ((tg * 8 + 2 * x) * P + k) * 2), hi2 = *(const LAS bf16_t*)(BUF(src) + ((tg * 8 + 2 * x + 1) * P + k) * 2); w_[x] = lo | (hi2 << 16); } \
                *(LAS u32x4*)(BUF(dst) + (k * P + tg * 8) * 2) = (u32x4){w_[0], w_[1], w_[2], w_[3]}; } while (0)
            TR8(0, 4); TR8(8, 5); TR8(9, 6); TR8(10, 7);
#undef TR8
        }
        LBAR();
        const f32x4 Z4 = {0.f, 0.f, 0.f, 0.f};
        const f32x16 Z16 = {0.f, 0.f, 0.f, 0.f, 0.f, 0.f, 0.f, 0.f, 0.f, 0.f, 0.f, 0.f, 0.f, 0.f, 0.f, 0.f};
        const int r32 = lane & 31, hi = lane >> 5;
#pragma unroll 1
        for (int u = 0; u < 2; ++u) { const int tl = u * 8 + wid;
            if (tl >= 14) {
                if (tl == 14) { st32(BUF(8), 0, 1, r32, hi, Z16); st32(BUF(8), 1, 0, r32, hi, Z16); st32(BUF(14), 0, 1, r32, hi, Z16); st32(BUF(14), 1, 0, r32, hi, Z16); st32(BUF(9), 1, 0, r32, hi, Z16); }
                else { st32(BUF(15), 1, 0, r32, hi, Z16); st32(BUF(13), 1, 0, r32, hi, Z16); st32(BUF(10), 1, 0, r32, hi, Z16); st32(BUF(11), 1, 0, r32, hi, Z16); st32(BUF(12), 1, 0, r32, hi, Z16); }
                break; }
            const int m = (tl + 1) / 3, rr = (tl + 1) % 3, ti = rr == 2, tj = m == 0 ? ti : (rr >= 1); const int jj = 32 * tj + r32;
            if (m == 0) { f32x16 v = mm32(BUF(0), BUF(1), ti, tj, r32, hi, Z16), w;
#pragma unroll
                for (int e = 0; e < 16; ++e) { const int ii = 32 * ti + 8 * (e >> 2) + 4 * hi + (e & 3); const bool dg = (ii >> 4) == (jj >> 4);
                    v[e] = (dg && jj < ii) ? v[e] : 0.f; w[e] = v[e] + ((ii == jj) ? 1.f : 0.f); }
                st32(BUF(8), ti, tj, r32, hi, v); st32(BUF(14), ti, tj, r32, hi, w); }
            else if (m == 1) { const f32x16 v = mm32(BUF(1), BUF(0), ti, tj, r32, hi, Z16); f32x16 vd, vo, w;
#pragma unroll
                for (int e = 0; e < 16; ++e) { const int ii = 32 * ti + 8 * (e >> 2) + 4 * hi + (e & 3); const bool dg = (ii >> 4) == (jj >> 4), up = ii < jj;
                    vd[e] = (dg && up) ? v[e] : 0.f; vo[e] = (!dg && up) ? v[e] : 0.f; w[e] = vd[e] + ((ii == jj) ? 1.f : 0.f); }
                st32(BUF(9), ti, tj, r32, hi, vd); st32(BUF(15), ti, tj, r32, hi, vo); st32(BUF(13), ti, tj, r32, hi, w); }
            else if (m == 2) { f32x16 v = mm32(BUF(2), BUF(0), ti, tj, r32, hi, Z16);
#pragma unroll
                for (int e = 0; e < 16; ++e) { const int ii = 32 * ti + 8 * (e >> 2) + 4 * hi + (e & 3); v[e] = ii < jj ? v[e] : 0.f; }
                st32(BUF(10), ti, tj, r32, hi, v); }
            else { f32x16 v = mm32(m == 3 ? BUF(1) : BUF(2), BUF(3), ti, tj, r32, hi, Z16);
#pragma unroll
                for (int e = 0; e < 16; ++e) { const int ii = 32 * ti + 8 * (e >> 2) + 4 * hi + (e & 3); v[e] = ii <= jj ? v[e] : 0.f; }
                st32(m == 3 ? BUF(11) : BUF(12), ti, tj, r32, hi, v); } }
        LBAR();
#define WSYNC() asm volatile("s_waitcnt lgkmcnt(0)" ::: "memory")
        if (wid < 4) {
            const int tt = wid;
#define SQD(sr, st, dr, dt) do { const f32x4 a_ = mm_diag(BUF(st), BUF(sr), tt, c, q, Z4), b_ = mm_diag(BUF(sr), BUF(st), tt, c, q, Z4); WSYNC(); \
                st_tile(BUF(dr), tt, tt, c, q, a_); st_tile(BUF(dt), tt, tt, c, q, b_); WSYNC(); } while (0)
#define UPD(pr) do { const f32x4 dt_ = mm_diag(BUF(pr), BUF(13), tt, c, q, ld_tile(BUF(13), tt, tt, c, q)); \
                const f32x4 dr_ = mm_diag(BUF(13), BUF(pr), tt, c, q, ld_tile(BUF(14), tt, tt, c, q)); WSYNC(); \
                st_tile(BUF(13), tt, tt, c, q, dt_); st_tile(BUF(14), tt, tt, c, q, dr_); WSYNC(); } while (0)
#define UPSQ(sr, st, dr, dt) do { const f32x4 dt_ = mm_diag(BUF(sr), BUF(13), tt, c, q, ld_tile(BUF(13), tt, tt, c, q)); \
                const f32x4 dr_ = mm_diag(BUF(13), BUF(sr), tt, c, q, ld_tile(BUF(14), tt, tt, c, q)); \
                const f32x4 a_ = mm_diag(BUF(st), BUF(sr), tt, c, q, Z4), b_ = mm_diag(BUF(sr), BUF(st), tt, c, q, Z4); WSYNC(); \
                st_tile(BUF(13), tt, tt, c, q, dt_); st_tile(BUF(14), tt, tt, c, q, dr_); st_tile(BUF(dr), tt, tt, c, q, a_); st_tile(BUF(dt), tt, tt, c, q, b_); WSYNC(); } while (0)
            SQD(8, 9, 0, 1); UPSQ(0, 1, 8, 9); UPSQ(8, 9, 0, 1); UPD(0);
#undef UPSQ
#undef SQD
#undef UPD
        } else {
            const int ti = (wid >> 1) & 1, tj = wid & 1; st32(BUF(2), ti, tj, r32, hi, mm32(BUF(10), BUF(7), ti, tj, r32, hi, Z16));
        }
        LBAR();
        { const int m = wid >> 2, ti = (wid >> 1) & 1, tj = wid & 1;
          if (m == 0) st32(BUF(8), ti, tj, r32, hi, mm32(BUF(15), BUF(14), ti, tj, r32, hi, Z16));
          else        st32(BUF(9), ti, tj, r32, hi, mm32(BUF(14), BUF(15), ti, tj, r32, hi, Z16)); }
        LBAR();
        { const int ti = (wid >> 1) & 1, tj = wid & 1;
          if (wid < 4) st32(BUF(0), ti, tj, r32, hi, mm32(BUF(9), BUF(8), ti, tj, r32, hi, Z16));
          else         st32(BUF(1), ti, tj, r32, hi, mm32(BUF(8), BUF(13), ti, tj, r32, hi, ld32(BUF(13), ti, tj, r32, hi))); }
        LBAR();
        if (wid < 4) { const int ti = (wid >> 1) & 1, tj = wid & 1; st32(BUF(14), ti, tj, r32, hi, mm32(BUF(0), BUF(1), ti, tj, r32, hi, ld32(BUF(1), ti, tj, r32, hi))); }
        LBAR();
        { const int m = wid >> 2, ti = (wid >> 1) & 1, tj = wid & 1;
          if (m == 0) st32(BUF(8), ti, tj, r32, hi, mm32(BUF(14), BUF(4), ti, tj, r32, hi, Z16));
          else        st32(BUF(0), ti, tj, r32, hi, mm32(BUF(14), BUF(2), ti, tj, r32, hi, Z16)); }
        LBAR();
        bf16_t* ckp = CK + (size_t)it * 4 * 4096;
#pragma unroll 1
        for (int u = 0; u < 2; ++u) { const int tl = u * 8 + wid, m = tl >> 2, ti = (tl >> 1) & 1, tj = tl & 1;
            if (m == 0) { f32x16 v = mm32(BUF(8), BUF(5), ti, tj, r32, hi, Z16); const int jj = 32 * tj + r32; const float gc = GC[jj];
#pragma unroll
                for (int e = 0; e < 16; ++e) { const int ii = 32 * ti + 8 * (e >> 2) + 4 * hi + (e & 3); v[e] += (ii == jj) ? gc : 0.f; }
                st32(BUF(1), ti, tj, r32, hi, v); }
            else if (m == 1) st32(BUF(4), ti, tj, r32, hi, mm32(BUF(8), BUF(11), ti, tj, r32, hi, ld32(BUF(3), ti, tj, r32, hi)));
            else if (m == 2) st32(BUF(2), ti, tj, r32, hi, mm32(BUF(6), BUF(7), ti, tj, r32, hi, mm32(BUF(5), BUF(0), ti, tj, r32, hi, Z16)));
            else             st32(BUF(9), ti, tj, r32, hi, mm32(BUF(7), BUF(12), ti, tj, r32, hi, mm32(BUF(0), BUF(11), ti, tj, r32, hi, Z16))); }
        LBAR();
        { const int orow = tid >> 3, oc = (tid & 7) * 8;
          *(u32x4*)(ckp + orow * 64 + oc) = *(const LAS u32x4*)(BUF(1) + (orow * P + oc) * 2);
          *(u32x4*)(ckp + 4096 + orow * 64 + oc) = *(const LAS u32x4*)(BUF(2) + (orow * P + oc) * 2);
          *(u32x4*)(ckp + 2 * 4096 + orow * 64 + oc) = *(const LAS u32x4*)(BUF(4) + (orow * P + oc) * 2);
          *(u32x4*)(ckp + 3 * 4096 + orow * 64 + oc) = *(const LAS u32x4*)(BUF(9) + (orow * P + oc) * 2); }
    }
#undef BUF
#undef SC1_LOAD
}

__device__ void ph_rw_sc2(const Params& p, char* lds) {
    using namespace ck;
    const int tid = tidx(), wid = __builtin_amdgcn_readfirstlane(tid >> 6), lane = tid & 63, c = lane & 15, q = lane >> 4;
    const size_t PL = (size_t)NROW * D;
    const bf16_t* CK = (const bf16_t*)(p.ws + OFF_CK); bf16_t* Y = (bf16_t*)(p.ws + OFF_Y);
    lchar* GB = (lchar*)lds;
    lchar* RB = GB + 2 * MB;
    lchar* SB = GB + 4 * MB;
    constexpr int SBB = 32 * P * 2;
    for (int it = bidx(); it < 256; it += gdim()) {
        const int vh = it & 1, seq = it >> 1, z = seq & 1, h = (seq >> 1) & 15, b = seq >> 5;
        const bf16_t* ck0 = CK + (size_t)seq * NCHK * 4 * 4096;
        const int s_ti = wid & 3, s_tj = wid >> 2;
        const int y_ti = wid & 1, y_tj = wid >> 1;
        const int hoff = 4096 + (vh * 32 + 16 * s_tj + c) * 64 + 16 * s_ti + 4 * q, yoff = 3 * 4096 + (16 * y_tj + c) * 64 + vh * 32 + 16 * y_ti + 4 * q;
        struct PF { u32x4 g, r; uint2 h, y; };
#define PF_LOAD(X, k) do { const bf16_t* cc_ = ck0 + (size_t)(k) * 4 * 4096; X.h = *(const uint2*)(cc_ + hoff); X.y = *(const uint2*)(cc_ + yoff); X.g = *(const u32x4*)(cc_ + tid * 8); X.r = *(const u32x4*)(cc_ + 2 * 4096 + tid * 8); } while (0)
#define PF_STAGE(X, bufi) do { *(LAS u32x4*)(GB + (bufi) * MB + ((tid >> 3) * P + (tid & 7) * 8) * 2) = X.g; *(LAS u32x4*)(RB + (bufi) * MB + ((tid >> 3) * P + (tid & 7) * 8) * 2) = X.r; } while (0)
#define SC2_STEP(k, CUR, NXT) do { const uint2 hi_ = CUR.h, yi_ = CUR.y; const int cur = (k) & 1; \
            if ((k) + 4 < NCHK) PF_LOAD(CUR, (k) + 4); \
            const f32x4 hinit = {__uint_as_float(hi_.x << 16), __uint_as_float(hi_.x & 0xffff0000u), __uint_as_float(hi_.y << 16), __uint_as_float(hi_.y & 0xffff0000u)}; \
            const f32x4 yinit = {__uint_as_float(yi_.x << 16), __uint_as_float(yi_.x & 0xffff0000u), __uint_as_float(yi_.y << 16), __uint_as_float(yi_.y & 0xffff0000u)}; \
            const lchar* Sold = SB + cur * SBB; lchar* Snew = SB + (cur ^ 1) * SBB; \
            const f32x4 sn = mm_tile(GB + cur * MB, Sold, s_ti, s_tj, c, q, hinit);        \
            const f32x4 yv = mm_tile(Sold, RB + cur * MB, y_ti, y_tj, c, q, yinit);        \
            st_tile(Snew, s_ti, s_tj, c, q, sn); \
            { const int row = scan_row((k) * 64 + 16 * y_tj + c, b, z); stbf4(Y + z * PL + (size_t)row * D + h * 64 + vh * 32 + 16 * y_ti + 4 * q, yv); } \
            if ((k) + 1 < NCHK) PF_STAGE(NXT, cur ^ 1); \
            LBAR(); } while (0)
        PF s0, s1, s2, s3;
        PF_LOAD(s0, 0); PF_LOAD(s1, 1); PF_LOAD(s2, 2); PF_LOAD(s3, 3);
        LBAR();
        for (int i = tid; i < SBB / 4; i += NTHR) ((LAS unsigned*)SB)[i] = 0u;
        PF_STAGE(s0, 0);
        LBAR();
        for (int ch = 0; ch < NCHK; ch += 4) {
            SC2_STEP(ch, s0, s1); SC2_STEP(ch + 1, s1, s2); SC2_STEP(ch + 2, s2, s3); SC2_STEP(ch + 3, s3, s0);
        }
#undef PF_LOAD
#undef PF_STAGE
#undef SC2_STEP
    }
}
#undef LBAR

__device__ void ph_rw_out(const Params& p, int j, int nrows) {
    const int wid = tidx() >> 6, lane = tidx() & 63;
    const bf16_t* RKV = (const bf16_t*)(p.ws + OFF_RKV); const bf16_t* AV = (const bf16_t*)(p.ws + OFF_AV); const bf16_t* G = (const bf16_t*)(p.ws + OFF_G); const bf16_t* Y = (const bf16_t*)(p.ws + OFF_Y);
    bf16_t* OUT = (bf16_t*)(p.ws + OFF_H);
    const size_t PL = (size_t)NROW * D;
    const float* lg = p.rw_lnx_g + j * D; const float* lb = p.rw_lnx_b + j * D; const float* BS = (const float*)(p.ws + OFF_BS);
    uint2 nb[4][4]; float nbs[2][4];
#define OUT_LOAD(R) do { _Pragma("unroll") for (int i = 0; i < 4; ++i) { const size_t o_ = (size_t)(R) * D + lane * 4 + i * 256; \
        nb[0][i] = *(const uint2*)(Y + o_); nb[1][i] = *(const uint2*)(Y + PL + o_); nb[2][i] = *(const uint2*)(RKV + 2 * PL + o_); nb[3][i] = *(const uint2*)(G + o_); \
        nbs[0][i] = BS[(size_t)(R) * 16 + (lane >> 4) + 4 * i]; nbs[1][i] = BS[((size_t)NROW + (R)) * 16 + (lane >> 4) + 4 * i]; } } while (0)
#define UNPK(w) ((f32x4){__uint_as_float((w).x << 16), __uint_as_float((w).x & 0xffff0000u), __uint_as_float((w).y << 16), __uint_as_float((w).y & 0xffff0000u)})
    int row = bidx() * 8 + wid;
    if (row < nrows) OUT_LOAD(row);
    for (; row < nrows; row += gdim() * 8) {
        uint2 cb[4][4]; float cbs[4];
#pragma unroll
        for (int i = 0; i < 4; ++i) { cbs[i] = nbs[0][i] + nbs[1][i];
#pragma unroll
            for (int q_ = 0; q_ < 4; ++q_) cb[q_][i] = nb[q_][i]; }
        { const int nrow = row + gdim() * 8; if (nrow < nrows) OUT_LOAD(nrow); }
#pragma unroll
        for (int i = 0; i < 4; ++i) {
            const size_t o = (size_t)row * D + lane * 4 + i * 256; const int c = lane * 4 + i * 256;
            const f32x4 y = UNPK(cb[0][i]) + UNPK(cb[1][i]);
            const float mean = dpp_sum16(y[0] + y[1] + y[2] + y[3]) * (1.f / 64.f);
            const f32x4 dd = y - mean;
            const float rstd = rsqrtf(dpp_sum16(dd[0] * dd[0] + dd[1] * dd[1] + dd[2] * dd[2] + dd[3] * dd[3]) * (1.f / 64.f) + LNX_EPS);
            const f32x4 v = UNPK(cb[2][i]);
            const f32x4 res = (dd * rstd * *(const f32x4*)(lg + c) + *(const f32x4*)(lb + c) + cbs[i] * v) * UNPK(cb[3][i]);
            uint2 w; w.x = pk2(res[0], res[1]); w.y = pk2(res[2], res[3]); *(uint2*)(OUT + o) = w;
        }
    }
#undef OUT_LOAD
#undef UNPK
}

__device__ void ph_final(const Params& p) {
    const int wid = tidx() >> 6, lane = tidx() & 63;
    const float* X = (const float*)(p.ws + OFF_X);
    for (int row = bidx() * 8 + wid; row < NLAT; row += gdim() * 8) {
        const float4* xr = (const float4*)(X + (size_t)row * D);
        float4 v[4]; float ss = 0;
#pragma unroll
        for (int i = 0; i < 4; ++i) { v[i] = xr[lane + i * 64]; ss += v[i].x * v[i].x + v[i].y * v[i].y + v[i].z * v[i].z + v[i].w * v[i].w; }
        ss = wave_sum(ss); const float rs = rsqrtf(ss * (1.f / D) + RMS_EPS);
#pragma unroll
        for (int i = 0; i < 4; ++i) { const int d = (lane + i * 64) * 4; const float4 gg = *(const float4*)(p.final_g + d);
            float4 o; o.x = v[i].x * rs * gg.x; o.y = v[i].y * rs * gg.y; o.z = v[i].z * rs * gg.z; o.w = v[i].w * rs * gg.w;
            *(float4*)(p.out + (size_t)row * D + d) = o; }
    }
}

enum { PH_INIT = 0, PH_A_NORM, PH_A_Z, PH_A_MID, PH_A_QKV, PH_A_POST, PH_A_ATTN, PH_A_WO,
       PH_R_NORM, PH_R_XS, PH_R_G1, PH_R_G2, PH_R_PREP, PH_R_SCAN, PH_R_OUT, PH_R_WO,
       PH_M_NORM, PH_M_SEL, PH_M_GATHER, PH_M_G1, PH_M_G2, PH_M_COMB, PH_FINAL, PH_M_CVT, PH_R_SC1, PH_R_SC2 };

#ifndef BG_Z
#define BG_Z 4
#define BG_ATTN 2
#define BG_WO 3
#define BG_RG1 6
#define BG_MG1 4
#define BG_MG2 6
#endif
template <int PH>
__device__ __forceinline__ void run_phase(const Params& p, int layer, char* lds) {
    const int j = layer >> 1;
    char* ws = p.ws;
    if constexpr (PH == PH_INIT) { ph_init(p, lds); __syncthreads(); ph_small_cvt(p, lds); }
    else if constexpr (PH == PH_A_NORM) { if (layer == 0) ph_norm_mod<false>(p, layer, p.norm1_g + layer * D, 0, 1, ws + OFF_H); else ph_comb_norm<false>(p, layer - 1, layer, NROW); }
    else if constexpr (PH == PH_A_Z) {
        float* Z = (float*)(ws + OFF_Z);
        g8::BatchSched S{ws + OFF_H, ws + OFF_WMLA + j * SZ_WMLA + WM_IN, 0, 0, NROW / 256, 2, 1, D};
        g8::gemm_phase(p.wv, (PG8_LAS unsigned char*)lds, D, S, g8::epi_rc([=](const g8::Unit&, int row, int col, f32x4 v) { *(f32x4*)(Z + (size_t)row * 512 + col) = v; }));
        if (idle_tail(NROW / 256 * 2)) bg_cvt(p, layer, lds, BG_Z);
    }
    else if constexpr (PH == PH_A_MID) ph_mla_mid(p, j);
    else if constexpr (PH == PH_A_QKV) {
        bf16_t* Q = (bf16_t*)(ws + OFF_Q); bf16_t* K = (bf16_t*)(ws + OFF_K); bf16_t* V = (bf16_t*)(ws + OFF_V);
        g8::BatchSched S1{ws + OFF_CQN, ws + OFF_WMLA + j * SZ_WMLA + WM_UQ, 0, 0, NROW / 256, 6, 1, 256, 1};
        g8::gemm_phase(p.wv, (PG8_LAS unsigned char*)lds, 256, S1, g8::epi_rc([=](const g8::Unit&, int row, int col, f32x4 v) {
            const bool lat = row < NLAT; const int b = lat ? (row >> 12) : ((row - NLAT) >> 8); const int tk = lat ? 256 + (row & (TL - 1)) : ((row - NLAT) & 255);
            const int h = col / 192, d = col - h * 192;
            uint2 w; w.x = pk2(v[0], v[1]); w.y = pk2(v[2], v[3]);
            *(uint2*)(Q + ((size_t)(b * 8 + h) * TK + tk) * 192 + d) = w; }));
        g8::BatchSched S2{ws + OFF_CKVN, ws + OFF_WMLA + j * SZ_WMLA + WM_UKV, 0, 0, NROW / 256, 8, 1, 128};
        g8::gemm_phase(p.wv, (PG8_LAS unsigned char*)lds, 128, S2, g8::epi_rc([=](const g8::Unit&, int row, int col, f32x4 v) {
            const bool lat = row < NLAT; const int b = lat ? (row >> 12) : ((row - NLAT) >> 8); const int tk = lat ? 256 + (row & (TL - 1)) : ((row - NLAT) & 255);
            const int h = col >> 8, d = col & 255; const size_t orow = (size_t)(b * 8 + h) * TK + tk;
            uint2 w; w.x = pk2(v[0], v[1]); w.y = pk2(v[2], v[3]);
            if (d < 128) *(uint2*)(K + orow * 192 + d) = w; else *(uint2*)(V + orow * 128 + (d - 128)) = w; }));
    }
    else if constexpr (PH == PH_A_ATTN) { ph_attn(p, lds); if (idle_tail(544)) bg_cvt(p, layer, lds, BG_ATTN); }
    else if constexpr (PH == PH_A_WO || PH == PH_R_WO) {
        xt_t* X = (xt_t*)(ws + OFF_X); const float* MOD = (const float*)(ws + OFF_MOD);
        g8::BatchSched S{ws + (PH == PH_A_WO ? OFF_O : OFF_H), PH == PH_A_WO ? ws + OFF_WMLA + j * SZ_WMLA + WM_O : ws + OFF_WRW + j * SZ_WRW + WR_O, 0, 0, (layer < 3 ? NROW : NLAT) / 256, 4, 1, D};
        g8::gemm_phase(p.wv, (PG8_LAS unsigned char*)lds, D, S, g8::EpiResid{X, MOD, layer});
        if (idle_tail((layer < 3 ? NROW : NLAT) / 256 * 4)) bg_cvt(p, layer, lds, BG_WO);
    }
    else if constexpr (PH == PH_R_XS) ph_rw_normxs(p, layer, j);
    else if constexpr (PH == PH_R_G1) {
        bf16_t* RKV = (bf16_t*)(ws + OFF_RKV); bf16_t* VF = (bf16_t*)(ws + OFF_VFIRST);
        bf16_t* A2 = (bf16_t*)(ws + OFF_A2); bf16_t* A3 = (bf16_t*)(ws + OFF_A3);
        const bool first = (j == 0);
        struct RSched { const char* XS; const char* WB; int nwg;
            __device__ __forceinline__ bool next(int i, g8::Unit& u) const {
                const int L = i * gdim() + bidx(); if (L >= nwg) return false;
                const int w = g8::xcd_remap(L, nwg);
                if (w < 816) { u.g = w / 272; const int r = w % 272; u.pm = r >> 2; u.pn = r & 3; u.B = WB + WR_RKV + (size_t)u.g * D * D * 2 + (size_t)u.pn * 256 * D * 2; }
                else { u.g = 3 + (w - 816) / 68; u.pm = (w - 816) % 68; u.pn = 0; u.B = WB + WR_L + (size_t)(u.g - 3) * 256 * D * 2; }
                u.A = XS + (size_t)(u.g == 6 ? 2 : u.g) * NROW * D * 2 + (size_t)u.pm * 256 * D * 2; return true; } };
        RSched S{ws + OFF_XS, ws + OFF_WRW + j * SZ_WRW, first ? 816 + 204 : 816 + 272};
        g8::gemm_phase(p.wv, (PG8_LAS unsigned char*)lds, D, S, g8::epi_rc([=](const g8::Unit& u, int row, int col, f32x4 v) {
            if (u.g < 3) { stbf4(RKV + ((size_t)u.g * NROW + row) * D + col, v); if (first && u.g == 2) stbf4(VF + (size_t)row * D + col, v); }
            else if (col < 128) {
                f32x4 t = v;
                if (u.g == 3) { for (int e = 0; e < 4; ++e) t[e] = 1.f - 2.f * __builtin_amdgcn_rcpf(1.f + __expf(2.f * v[e])); }
                else if (u.g == 5) { for (int e = 0; e < 4; ++e) t[e] = sigmoidf_(v[e]); }
                bf16_t* dst = (u.g == 3 ? A2 : u.g == 4 ? A2 + (size_t)NROW * 128 : u.g == 5 ? A3 : A3 + (size_t)NROW * 128);
                stbf4(dst + (size_t)row * 128 + col, t); } }));
        if (idle_tail(S.nwg)) bg_cvt(p, layer, lds, BG_RG1);
    }
    else if constexpr (PH == PH_R_G2) {
        const bool first = (j == 0);
        float* W = (float*)(ws + OFF_W); bf16_t* AV = (bf16_t*)(ws + OFF_AV); bf16_t* G = (bf16_t*)(ws + OFF_G); bf16_t* RKV = (bf16_t*)(ws + OFF_RKV); const bf16_t* VF = (const bf16_t*)(ws + OFF_VFIRST);
        const float* w0 = p.rw_w0 + (size_t)j * 2 * D; const float* a0 = p.rw_a0 + (size_t)j * 2 * D; const float* v0 = p.rw_v0;
        g8::BatchSched S1{ws + OFF_A2, ws + OFF_WRW + j * SZ_WRW + WR_B2, (size_t)NROW * 128 * 2, (size_t)2048 * 128 * 2, NROW / 256, 8, 2, 128};
        g8::gemm_phase(p.wv, (PG8_LAS unsigned char*)lds, 128, S1, g8::epi_colfirst([=](const g8::Unit& u, int row, int col, f32x4 v, f32x4 bias) {
            const int zz = u.pn >> 2, c = col & 1023; const bool dec = u.g == 0;
            const size_t doff = (size_t)zz * NROW * D + (size_t)row * D + c;
            const f32x4 x = v + bias; f32x4 o;
#pragma unroll
            for (int e = 0; e < 4; ++e) { const float sg = __builtin_amdgcn_rcpf(1.f + __expf(-x[e])); o[e] = dec ? (-0.6065306597126334f * sg) : sg; }
            if (dec) *(f32x4*)(W + doff) = o; else stbf4(AV + doff, o); },
            [=](const g8::Unit& u, int col) { const int zz = u.pn >> 2, c = col & 1023; return *(const f32x4*)((u.g == 0 ? w0 : a0) + zz * D + c); }));
        g8::BatchSched S2{ws + OFF_A3, ws + OFF_WRW + j * SZ_WRW + WR_B3, (size_t)NROW * 128 * 2, (size_t)1024 * 128 * 2, NROW / 256, 4, first ? 1 : 2, 128, 1};
        g8::gemm_phase(p.wv, (PG8_LAS unsigned char*)lds, 128, S2, g8::epi_rc([=](const g8::Unit& u, int row, int col, f32x4 v) {
            if (u.g == 0) stbf4(G + (size_t)row * D + col, v);
            else { const size_t o = (size_t)row * D + col; const f32x4 vv = ldbf4(RKV + (size_t)2 * NROW * D + o), vf = ldbf4(VF + o), gz = v + *(const f32x4*)(v0 + col); f32x4 r;
#pragma unroll
                for (int e = 0; e < 4; ++e) r[e] = vv[e] + (vf[e] - vv[e]) * __builtin_amdgcn_rcpf(1.f + __expf(-gz[e]));
                stbf4(RKV + (size_t)2 * NROW * D + o, r); } }));
    }
    else if constexpr (PH == PH_R_SCAN) ph_rw_scan(p, j, lds);
    else if constexpr (PH == PH_R_SC1) ph_rw_sc1(p, j, lds);
    else if constexpr (PH == PH_R_SC2) ph_rw_sc2(p, lds);
    else if constexpr (PH == PH_R_OUT) ph_rw_out(p, j, layer < 3 ? NROW : NLAT);
    else if constexpr (PH == PH_M_NORM) ph_norm2_router_mm(p, layer, lds, layer < 3 ? NROW : NLAT);
    else if constexpr (PH == PH_M_SEL) { ph_select(p, lds, layer < 3 ? 128 : 64); __syncthreads(); moe_cvt(p, layer, lds, -1); }
    else if constexpr (PH == PH_M_GATHER) ph_gather(p, layer < 3 ? ESLOTS : NB * CAPL);
    else if constexpr (PH == PH_M_G1) {
        bf16_t* HID = (bf16_t*)(ws + OFF_HID);
        g8::BatchSched S{ws + OFF_XE, ws + OFF_W13T + (size_t)(layer & 1) * SZ_WMOE, (size_t)EPAD * D * 2, (size_t)2816 * D * 2, layer < 3 ? 9 : 8, 11, NE, D};
        g8::gemm_phase(p.wv, (PG8_LAS unsigned char*)lds, D, S, g8::epi_pair([=](const g8::Unit& u, int row, int col, f32x4 a, f32x4 b) {
            uint2 w; w.x = pk2(a[0] * __builtin_amdgcn_rcpf(1.f + __expf(-a[0])) * b[0], a[1] * __builtin_amdgcn_rcpf(1.f + __expf(-a[1])) * b[1]); w.y = pk2(a[2] * __builtin_amdgcn_rcpf(1.f + __expf(-a[2])) * b[2], a[3] * __builtin_amdgcn_rcpf(1.f + __expf(-a[3])) * b[3]);
            *(uint2*)(HID + ((size_t)u.g * EPAD + row) * FF + col) = w; }));
        if (layer < 3 && idle_tail(9 * 11 * NE)) moe_cvt(p, layer + 1, lds, BG_MG1);
    }
    else if constexpr (PH == PH_M_G2) {
        bf16_t* YE = (bf16_t*)(ws + OFF_YE); const float* GATE = (const float*)(ws + OFF_GATE);
        g8::BatchSched S{ws + OFF_HID, ws + OFF_W2T + (size_t)(layer & 1) * SZ_WMOE, (size_t)EPAD * FF * 2, (size_t)D * FF * 2, layer < 3 ? 9 : 8, 4, NE, FF};
        g8::gemm_phase(p.wv, (PG8_LAS unsigned char*)lds, FF, S, g8::epi_pre([=](const g8::Unit& u, int row, int col, f32x4 v, f32x4, float gt) {
            uint2 w; w.x = pk2(v[0] * gt, v[1] * gt); w.y = pk2(v[2] * gt, v[3] * gt);
            *(uint2*)(YE + ((size_t)u.g * EPAD + row) * D + col) = w; },
            [=](const g8::Unit&, int) { return (f32x4){0.f, 0.f, 0.f, 0.f}; }, [=](const g8::Unit& u, int row) { return GATE[u.g * EPAD + row]; }));
        if (layer < 3 && idle_tail(9 * 4 * NE)) moe_cvt(p, layer + 1, lds, BG_MG2);
    }
    else if constexpr (PH == PH_M_COMB) ph_combine(p, layer, layer < 3 ? NROW : NLAT);
    else if constexpr (PH == PH_M_CVT) moe_cvt(p, layer, lds, -1);
    else if constexpr (PH == PH_FINAL) ph_comb_norm<true>(p, 3, 0, NLAT);
}

#if ONE_LAUNCH
#define SYNC() xcd_barrier(bar)
#ifndef PROBE_PH
#define PROBE_PH -1
#endif
#ifndef PROBE_REP
#define PROBE_REP 1
#endif
__device__ __forceinline__ Params load_params() {
    Params q{};
#if defined(__HIP_DEVICE_COMPILE__)
    typedef const __attribute__((address_space(4))) unsigned long long* KargP;
    KargP kp_ = (KargP)__builtin_amdgcn_kernarg_segment_ptr(); asm volatile("" : "+s"(kp_));
#pragma unroll
    for (int i = 0; i < 40; ++i) ((const float**)&q)[i] = (const float*)(const __attribute__((address_space(1))) float*)kp_[i];
#endif
    return q;
}
#define RUN(PH) do { for (int rep_ = 0; rep_ < ((PH) == PROBE_PH ? PROBE_REP : 1); ++rep_) { Params q = load_params(); q.wv = wv0_; run_phase<PH>(q, layer, smem); SYNC(); } } while (0)
__global__ void __launch_bounds__(NTHR, 2) mega(Params p) {
    extern __shared__ __attribute__((aligned(16))) char smem[];
    const int wv0_ = __builtin_amdgcn_readfirstlane((int)threadIdx.x >> 6);
    if (threadIdx.x == 0) *(uint4*)(smem + LDS_BYTES) = make_uint4(0u, 0u, 0u, 0u);
    __syncthreads();
    XcdBarrier bar = xcd_barrier_post((unsigned*)(p.ws + OFF_BAR), (volatile LAS unsigned*)(smem + LDS_BYTES));
    { const int layer = 0; RUN(PH_INIT); }
    for (int layer = 0; layer < 4; ++layer) {
        if ((layer & 1) == 0) {
            RUN(PH_A_NORM);
            RUN(PH_A_Z);
            RUN(PH_A_MID);
            RUN(PH_A_QKV);
            RUN(PH_A_ATTN);
            RUN(PH_A_WO);
        } else {
            RUN(PH_R_XS);
            RUN(PH_R_G1);
            RUN(PH_R_G2);
            RUN(PH_R_SC1);
            RUN(PH_R_SC2);
            RUN(PH_R_OUT);
            RUN(PH_R_WO);
        }
        RUN(PH_M_NORM);
        RUN(PH_M_SEL);
        RUN(PH_M_G1);
        RUN(PH_M_G2);
        if ((layer & 1) == 0) RUN(PH_M_COMB);
    }
    { Params q = load_params(); q.wv = wv0_; run_phase<PH_FINAL>(q, 0, smem); }
}
#else
template <int PH> __global__ void __launch_bounds__(NTHR, 2) kph(Params p, int layer) {
    extern __shared__ __attribute__((aligned(16))) char smem[];
    Params q = p; q.wv = __builtin_amdgcn_readfirstlane((int)threadIdx.x >> 6);
    run_phase<PH>(q, layer, smem);
}
#endif

extern "C" void kernel_launch(void* const* d_in, const int* in_sizes, int n_in, void* d_out, int out_size, void* d_ws, size_t ws_size, hipStream_t stream) {
    if (n_in != 38 || ws_size < WS_NEED) { fprintf(stderr, "kernel_launch: bad args n_in %d ws %zu need %zu\n", n_in, ws_size, (size_t)WS_NEED); return; }
    Params p{};
    const float** pp = (const float**)&p;
    for (int i = 0; i < 38; ++i) pp[i] = (const float*)d_in[i];
    p.out = (float*)d_out; p.ws = (char*)d_ws;
    static int cus = 0;
    if (!cus) { int dev = 0; hipGetDevice(&dev); hipDeviceGetAttribute(&cus, hipDeviceAttributeMultiprocessorCount, dev); if (cus <= 0) cus = 256; }
    const int grid = cus;
#if ONE_LAUNCH
    hipFuncSetAttribute((const void*)mega, hipFuncAttributeMaxDynamicSharedMemorySize, LDS_BYTES + 16);
    hipMemsetAsync(d_ws, 0, 16384, stream);
    hipLaunchKernelGGL(mega, dim3(grid), dim3(NTHR), LDS_BYTES + 16, stream, p);
#else
    hipMemsetAsync(d_ws, 0, 16384, stream);
#define LAUNCH(PH, L) do { hipFuncSetAttribute((const void*)kph<PH>, hipFuncAttributeMaxDynamicSharedMemorySize, LDS_BYTES + 16); hipLaunchKernelGGL(kph<PH>, dim3(grid), dim3(NTHR), LDS_BYTES + 16, stream, p, L); } while (0)
    LAUNCH(PH_INIT, 0);
    for (int layer = 0; layer < 4; ++layer) {
        if ((layer & 1) == 0) { LAUNCH(PH_A_NORM, layer); LAUNCH(PH_A_Z, layer); LAUNCH(PH_A_MID, layer); LAUNCH(PH_A_QKV, layer); LAUNCH(PH_A_ATTN, layer); LAUNCH(PH_A_WO, layer); }
        else { LAUNCH(PH_R_XS, layer); LAUNCH(PH_R_G1, layer); LAUNCH(PH_R_G2, layer); LAUNCH(PH_R_SC1, layer); LAUNCH(PH_R_SC2, layer); LAUNCH(PH_R_OUT, layer); LAUNCH(PH_R_WO, layer); }
        LAUNCH(PH_M_NORM, layer); LAUNCH(PH_M_SEL, layer); LAUNCH(PH_M_G1, layer); LAUNCH(PH_M_G2, layer); if ((layer & 1) == 0) LAUNCH(PH_M_COMB, layer);
    }
    LAUNCH(PH_FINAL, 0);
#endif
}
```

```cpp
#include <hip/hip_runtime.h>
#include <stdint.h>
#include <stdio.h>

#ifndef ONE_LAUNCH
#define ONE_LAUNCH 1
#endif

#define NTHR 512
typedef unsigned short bf16_t;
typedef short bf16x8 __attribute__((ext_vector_type(8)));
typedef float f32x4 __attribute__((ext_vector_type(4)));
typedef unsigned u32x4 __attribute__((ext_vector_type(4)));
typedef unsigned u32x2 __attribute__((ext_vector_type(2)));

constexpr int D = 1024, NB = 4, TL = 4096, TC = 256, NLAT = NB * TL, NCTX = NB * TC, NROW = NLAT + NCTX;
constexpr int TK = TL + TC;
constexpr int NE = 16, FF = 1408, CAPL = 512, CAPC = 32, ESLOTS = NB * CAPL + NB * CAPC;
constexpr int EPAD = 2304;
constexpr float RMS_EPS = 1e-6f, LNX_EPS = 64e-5f;
constexpr float ATT_SCALE = 0.07216878364870322f;

constexpr size_t al256(size_t x) { return (x + 255) / 256 * 256; }
constexpr size_t OFF_BAR = 0;
constexpr size_t OFF_QUEUE = 14336;
constexpr size_t OFF_MOD = 16384;
constexpr size_t OFF_ROPE_C = OFF_MOD + al256(4 * 5 * 6144 * 4);
constexpr size_t OFF_ROPE_S = OFF_ROPE_C + al256(TL * 32 * 4);
constexpr size_t OFF_X = OFF_ROPE_S + al256(TL * 32 * 4);
constexpr size_t SZ_F32 = (size_t)NROW * D * 4, SZ_BF = (size_t)NROW * D * 2;
constexpr size_t OFF_VFIRST = OFF_X + SZ_BF;
constexpr size_t OFF_H = OFF_VFIRST + SZ_BF;
constexpr size_t SZ_WMLA = (size_t)(512 * 1024 + 1536 * 256 + 2048 * 256 + 1024 * 1024) * 2;
constexpr size_t WM_IN = 0, WM_UQ = (size_t)512 * 1024 * 2, WM_UKV = WM_UQ + (size_t)1536 * 256 * 2, WM_O = WM_UKV + (size_t)2048 * 256 * 2;
constexpr size_t SZ_WRW = (size_t)(3 * 1024 * 1024 + 4 * 256 * 1024 + 1024 * 1024 + 4096 * 256 + 2048 * 256) * 2;
constexpr size_t WR_RKV = 0, WR_L = (size_t)3 * 1024 * 1024 * 2, WR_O = WR_L + (size_t)4 * 256 * 1024 * 2, WR_B2 = WR_O + (size_t)1024 * 1024 * 2, WR_B3 = WR_B2 + (size_t)4096 * 256 * 2;
constexpr size_t OFF_WMLA = OFF_H + SZ_BF;
constexpr size_t OFF_WRW = OFF_WMLA + 2 * SZ_WMLA;
constexpr size_t OFF_W13T = OFF_WRW + 2 * SZ_WRW;
constexpr size_t OFF_W2T = OFF_W13T + (size_t)NE * 2816 * D * 2;
constexpr size_t SZ_WMOE = (size_t)NE * 2816 * D * 2 + (size_t)NE * D * FF * 2;
constexpr size_t OFF_S = OFF_W13T + 2 * SZ_WMOE;
constexpr size_t OFF_Z = OFF_S;
constexpr size_t OFF_CQN = OFF_Z + al256((size_t)NROW * 512 * 4);
constexpr size_t OFF_CKVN = OFF_CQN + al256((size_t)NROW * 256 * 2);
constexpr size_t OFF_KR = OFF_CKVN + al256((size_t)NROW * 256 * 2);
constexpr size_t OFF_QRAW = OFF_KR + al256((size_t)NROW * 64 * 4);
constexpr size_t OFF_KVRAW = OFF_QRAW + al256((size_t)NROW * 1536 * 4);
constexpr size_t OFF_Q = OFF_KVRAW + al256((size_t)NROW * 2048 * 4);
constexpr size_t OFF_K = OFF_Q + al256((size_t)NB * 8 * TK * 192 * 2);
constexpr size_t OFF_V = OFF_K + al256((size_t)NB * 8 * TK * 192 * 2);
constexpr size_t OFF_O = OFF_V + al256((size_t)NB * 8 * TK * 128 * 2);
constexpr size_t END_MLA = OFF_O + SZ_BF;
constexpr size_t OFF_XS = OFF_S;
constexpr size_t OFF_RKV = OFF_XS + 6 * SZ_BF;
constexpr size_t OFF_W = OFF_RKV + 3 * SZ_BF;
constexpr size_t OFF_AV = OFF_W + 2 * SZ_F32;
constexpr size_t OFF_G = OFF_AV + 2 * SZ_BF;
constexpr size_t OFF_A2 = OFF_G + SZ_BF;
constexpr size_t OFF_A3 = OFF_A2 + al256((size_t)NROW * 256 * 2);
constexpr size_t END_RW = OFF_A3 + al256((size_t)NROW * 256 * 2);
constexpr size_t OFF_Y = OFF_XS;
constexpr int NCHK = (TC + TL) / 64;
constexpr size_t OFF_CK = END_RW;
constexpr size_t OFF_BS = OFF_CK + (size_t)128 * NCHK * 4 * 4096 * 2;
constexpr size_t END_RW2 = OFF_BS + (size_t)2 * NROW * 16 * 4;
constexpr size_t OFF_AFF = OFF_S;
constexpr size_t OFF_ROWIDX = OFF_AFF + al256((size_t)NROW * 16 * 4);
constexpr size_t OFF_GATE = OFF_ROWIDX + al256((size_t)NE * ESLOTS * 4);
constexpr size_t OFF_SLOT = OFF_GATE + al256((size_t)NE * EPAD * 4);
constexpr size_t OFF_XE = OFF_SLOT + al256((size_t)NROW * 16 * 4);
constexpr size_t OFF_HID = OFF_XE + al256((size_t)NE * EPAD * D * 2);
constexpr size_t OFF_YE = OFF_HID + al256((size_t)NE * EPAD * FF * 2);
constexpr size_t END_MOE = OFF_YE + al256((size_t)NE * EPAD * D * 2);
constexpr size_t WS_NEED = END_RW2 > END_MLA ? (END_RW2 > END_MOE ? END_RW2 : END_MOE) : (END_MLA > END_MOE ? END_MLA : END_MOE);

constexpr int LDS_BYTES = 152064;

struct Params {
    const float *x, *c, *ctx, *c_ctx, *mod_w, *mod_b, *norm1_g, *norm2_g, *final_g;
    const float *mla_w_in, *mla_g_q, *mla_g_kv, *mla_w_uq, *mla_w_ukv, *mla_w_o;
    const float *rw_mu, *rw_w_rkv, *rw_w0, *rw_w1, *rw_w2, *rw_a0, *rw_a1, *rw_a2, *rw_v0, *rw_v1, *rw_v2, *rw_g1, *rw_g2, *rw_k_k, *rw_k_a, *rw_r_k, *rw_lnx_g, *rw_lnx_b, *rw_w_o;
    const float *moe_router, *moe_w1, *moe_w3, *moe_w2;
    float* out; char* ws;
    int wv, pad_;
};

__device__ __forceinline__ int bidx() { int t = blockIdx.x; asm volatile("" : "+s"(t)); return t; }
__device__ __forceinline__ int gdim() { int t = gridDim.x; asm volatile("" : "+s"(t)); return t; }
__device__ __forceinline__ int tidx_w(int wv) { int l; asm volatile("v_mbcnt_lo_u32_b32 %0, -1, 0\n\tv_mbcnt_hi_u32_b32 %0, -1, %0" : "=v"(l)); return (wv << 6) | l; }
#define tidx() tidx_w(p.wv)
#define XB_TMO      128
#define XB_XCNT(j)  (256  + 64 * (j))
#define XB_XSUB(j)  (1280 + 64 * (j))
#define XB_XGEN(j)  (2304 + 64 * (j))
#define XB_TOP      3328
#define XB_TOPGEN   3392
#define XCD_BAR_WORDS 3456
#define XB_SPIN_CAP (1u << 22)
#define LAS __attribute__((address_space(3)))

__device__ __forceinline__ unsigned xb_ld(unsigned* p)              { return __hip_atomic_load(p, __ATOMIC_RELAXED, __HIP_MEMORY_SCOPE_AGENT); }
__device__ __forceinline__ unsigned xb_add(unsigned* p, unsigned v) { return __hip_atomic_fetch_add(p, v, __ATOMIC_RELAXED, __HIP_MEMORY_SCOPE_AGENT); }
__device__ __forceinline__ unsigned xb_xcc_id() { return (unsigned)__builtin_amdgcn_s_getreg((3 << 11) | 20) & 0xFu; }
#define XB_SPIN(cond, bar) do { unsigned _sp = 0; while (cond) { __builtin_amdgcn_s_sleep(1); \
    if ((++_sp & 255u) == 0u) { if (xb_ld(&(bar)[XB_TMO])) break; if (_sp > XB_SPIN_CAP) { atomicAdd(&(bar)[XB_TMO], 1u); break; } } } } while (0)

struct XcdBarrier { unsigned* bar; unsigned x; volatile LAS unsigned* st; };

__device__ __forceinline__ XcdBarrier xcd_barrier_post(unsigned* bar, volatile LAS unsigned* st) {
    XcdBarrier b; b.bar = bar; b.x = xb_xcc_id(); b.st = st;
    if (threadIdx.x == 0) (void)xb_add(&bar[XB_XCNT(b.x)], 1u);
    return b;
}
__device__ __forceinline__ void xcd_barrier_complete(unsigned* bar, unsigned x, unsigned& nloc, unsigned& nx) {
    const unsigned G = gridDim.x * gridDim.y * gridDim.z;
    unsigned sum, cnt, mine, sp = 0u;
    for (;;) {
        sum = 0u; cnt = 0u; mine = 0u;
#pragma unroll
        for (unsigned j = 0; j < 16; ++j) { const unsigned c = xb_ld(&bar[XB_XCNT(j)]); sum += c; cnt += (c > 0u) ? 1u : 0u; mine = (j == x) ? c : mine; }
        if (sum == G) break;
        __builtin_amdgcn_s_sleep(1);
        if ((++sp & 255u) == 0u) { if (xb_ld(&bar[XB_TMO])) break; if (sp > XB_SPIN_CAP) { atomicAdd(&bar[XB_TMO], 1u); break; } }
    }
    nloc = mine > 0u ? mine : 1u; nx = cnt > 0u ? cnt : 1u;
}
__device__ __forceinline__ void xcd_barrier(const XcdBarrier& b) {
    asm volatile("s_waitcnt vmcnt(0)" ::: "memory");
    __syncthreads();
    if (threadIdx.x == 0) {
        unsigned* bar = b.bar;
        __builtin_amdgcn_s_waitcnt(0);
        unsigned nloc = b.st[0], nx = b.st[1];
        if (nloc == 0u) { xcd_barrier_complete(bar, b.x, nloc, nx); b.st[0] = nloc; b.st[1] = nx; }
        const unsigned old = xb_add(&bar[XB_XSUB(b.x)], 1u);
        const unsigned gen = old / nloc;
        if (old + 1u == (gen + 1u) * nloc) {
            __builtin_amdgcn_fence(__ATOMIC_RELEASE, "agent");
            asm volatile("s_waitcnt vmcnt(0)" ::: "memory");
            const unsigned og = xb_add(&bar[XB_TOP], 1u);
            const unsigned tg = og / nx;
            if (og + 1u == (tg + 1u) * nx) xb_add(&bar[XB_TOPGEN], 1u);
            else XB_SPIN(xb_ld(&bar[XB_TOPGEN]) == tg, bar);
            __builtin_amdgcn_fence(__ATOMIC_ACQUIRE, "agent");
            xb_add(&bar[XB_XGEN(b.x)], 1u);
            asm volatile("s_waitcnt vmcnt(0)" ::: "memory");
        } else {
            XB_SPIN(xb_ld(&bar[XB_XGEN(b.x)]) == gen, bar);
            __builtin_amdgcn_fence(__ATOMIC_ACQUIRE, "agent");
            asm volatile("s_waitcnt vmcnt(0)" ::: "memory");
        }
    }
    __syncthreads();
}

__device__ __forceinline__ float bf2f(bf16_t b) { return __uint_as_float(((unsigned)b) << 16); }
typedef float f32x2_ __attribute__((ext_vector_type(2)));
typedef __bf16 bf16x2_ __attribute__((ext_vector_type(2)));
__device__ __forceinline__ unsigned pk2(float lo, float hi) { const f32x2_ v = {lo, hi}; return __builtin_bit_cast(unsigned, __builtin_convertvector(v, bf16x2_)); }
__device__ __forceinline__ bf16_t f2bf(float f) { return (bf16_t)(pk2(f, f) & 0xffffu); }
__device__ __forceinline__ float dpp_sum16(float x) {
    x += __builtin_bit_cast(float, __builtin_amdgcn_update_dpp(0, __builtin_bit_cast(int, x), 0xB1, 0xF, 0xF, true));
    x += __builtin_bit_cast(float, __builtin_amdgcn_update_dpp(0, __builtin_bit_cast(int, x), 0x4E, 0xF, 0xF, true));
    x += __builtin_bit_cast(float, __builtin_amdgcn_update_dpp(0, __builtin_bit_cast(int, x), 0x141, 0xF, 0xF, true));
    x += __builtin_bit_cast(float, __builtin_amdgcn_update_dpp(0, __builtin_bit_cast(int, x), 0x140, 0xF, 0xF, true));
    return x;
}
__device__ __forceinline__ f32x4 ldbf4(const bf16_t* p) { const uint2 w = *(const uint2*)p; return (f32x4){__uint_as_float(w.x << 16), __uint_as_float(w.x & 0xffff0000u), __uint_as_float(w.y << 16), __uint_as_float(w.y & 0xffff0000u)}; }
__device__ __forceinline__ void stbf4(bf16_t* p, f32x4 v) { uint2 w; w.x = pk2(v[0], v[1]); w.y = pk2(v[2], v[3]); *(uint2*)p = w; }
typedef bf16_t xt_t;
__device__ __forceinline__ f32x4 xldv(const xt_t* X, size_t i) { return ldbf4(X + i); }
__device__ __forceinline__ void xstv(xt_t* X, size_t i, f32x4 v) { stbf4(X + i, v); }
__device__ __forceinline__ float4 xld(const xt_t* X, size_t i) { const f32x4 v = ldbf4(X + i); return make_float4(v[0], v[1], v[2], v[3]); }
__device__ __forceinline__ void xst(xt_t* X, size_t i, float4 v) { stbf4(X + i, (f32x4){v.x, v.y, v.z, v.w}); }
__device__ __forceinline__ float wave_sum(float v) {
    v = dpp_sum16(v); const int i = __builtin_bit_cast(int, v);
    return __builtin_bit_cast(float, __builtin_amdgcn_readlane(i, 0)) + __builtin_bit_cast(float, __builtin_amdgcn_readlane(i, 16)) + __builtin_bit_cast(float, __builtin_amdgcn_readlane(i, 32)) + __builtin_bit_cast(float, __builtin_amdgcn_readlane(i, 48));
}
__device__ __forceinline__ float sigmoidf_(float x) { return __builtin_amdgcn_rcpf(1.f + __expf(-x)); }
__device__ __forceinline__ int row_stream(int row) { return row < NLAT ? (row >> 12) : 4; }
__device__ __forceinline__ const float* modp(const Params& p, int layer, int s, int part) { return (const float*)(p.ws + OFF_MOD) + ((size_t)layer * 5 + s) * 6144 + part * 1024; }

struct SgArgs { const bf16_t* A; int lda; size_t strideA; const float* B; int ldb; size_t strideB; int M, N, K, nbatch; };
template <class Epi>
__device__ __forceinline__ void sg_gemm(const Params& p, char* lds, const SgArgs g, const Epi& epi) {
    bf16_t* As = (bf16_t*)lds;
    bf16_t* Bs = As + 128 * 40;
    const int tid = tidx(), wid = tid >> 6, lane = tid & 63;
    const int wr = wid >> 2, wc = wid & 3;
    const int tilesN = (g.N + 127) / 128, tilesM = g.M / 128, per = tilesM * tilesN, ntiles = per * g.nbatch;
    const int ar = tid >> 2, ak = (tid & 3) * 8;
    const int bn = tid & 127, bk = (tid >> 7) * 8;
    for (int tile = bidx(); tile < ntiles; tile += gdim()) {
        const int bt = tile / per, tt = tile % per;
        const int tm = tt / tilesN, tn = tt % tilesN;
        const int m0 = tm * 128, n0 = tn * 128;
        f32x4 acc[4][2];
#pragma unroll
        for (int m = 0; m < 4; ++m)
#pragma unroll
            for (int n = 0; n < 2; ++n) acc[m][n] = (f32x4){0.f, 0.f, 0.f, 0.f};
        const bool bvalid = (n0 + bn) < g.N;
        const bf16_t* ap = g.A + bt * g.strideA + (size_t)(m0 + ar) * g.lda + ak;
        const float* bp = g.B + bt * g.strideB + (size_t)bk * g.ldb + n0 + bn;
        bf16x8 areg; float breg[8];
        areg = *(const bf16x8*)ap;
#pragma unroll
        for (int j = 0; j < 8; ++j) breg[j] = bvalid ? bp[(size_t)j * g.ldb] : 0.f;
        for (int k0 = 0; k0 < g.K; k0 += 32) {
            __syncthreads();
            *(bf16x8*)(As + ar * 40 + ak) = areg;
            { u32x4 w; w.x = pk2(breg[0], breg[1]); w.y = pk2(breg[2], breg[3]); w.z = pk2(breg[4], breg[5]); w.w = pk2(breg[6], breg[7]); *(u32x4*)(Bs + bn * 40 + bk) = w; }
            __syncthreads();
            if (k0 + 32 < g.K) {
                areg = *(const bf16x8*)(ap + k0 + 32);
#pragma unroll
                for (int j = 0; j < 8; ++j) breg[j] = bvalid ? bp[(size_t)(k0 + 32 + j) * g.ldb] : 0.f;
            }
            bf16x8 af[4], bfr[2];
#pragma unroll
            for (int m = 0; m < 4; ++m) af[m] = *(const bf16x8*)(As + (wr * 64 + m * 16 + (lane & 15)) * 40 + (lane >> 4) * 8);
#pragma unroll
            for (int n = 0; n < 2; ++n) bfr[n] = *(const bf16x8*)(Bs + (wc * 32 + n * 16 + (lane & 15)) * 40 + (lane >> 4) * 8);
#pragma unroll
            for (int m = 0; m < 4; ++m)
#pragma unroll
                for (int n = 0; n < 2; ++n) acc[m][n] = __builtin_amdgcn_mfma_f32_16x16x32_bf16(af[m], bfr[n], acc[m][n], 0, 0, 0);
        }
#pragma unroll
        for (int m = 0; m < 4; ++m)
#pragma unroll
            for (int n = 0; n < 2; ++n) {
                const int col = n0 + wc * 32 + n * 16 + (lane & 15);
                if (col < g.N) {
#pragma unroll
                    for (int r = 0; r < 4; ++r) epi(bt, m0 + wr * 64 + m * 16 + (lane >> 4) * 4 + r, col, acc[m][n][r]);
                }
            }
    }
}


namespace g8 {
#define PG8_LAS __attribute__((address_space(3)))
constexpr int BM = 256, BK = 64, HALF = 128, HTB = HALF * BK * 2, STAGE_BYTES = 8 * HTB;
__device__ __forceinline__ int lds_byte(int r, int c) { const int st = (r >> 4) * 2 + (c >> 5), rr = r & 15, cc = c & 31, ob = rr * 64 + cc * 2; return st * 1024 + (ob ^ (((ob >> 9) & 1) << 5)); }
__device__ __forceinline__ void stage_rc(int b, int& R, int& C) { const int st = b / 1024, sb = b % 1024, swz = sb ^ (((sb >> 9) & 1) << 5); R = (st >> 1) * 16 + swz / 64; C = (st & 1) * 32 + (swz % 64) / 2; }
struct Unit { int pm, pn, g; const char* A; const char* B; };
__device__ __forceinline__ int xcd_remap(int L, int nwg) { const int q = nwg / 8, r = nwg % 8, xcd = L % 8, off = L / 8; return (xcd < r ? xcd * (q + 1) : r * (q + 1) + (xcd - r) * q) + off; }

template <class Epi, class Sched>
__device__ __forceinline__ void gemm_phase(const int wv_, PG8_LAS unsigned char* lds, const int K, const Sched& S, const Epi& E) {
    const int tid = tidx_w(wv_), wid = __builtin_amdgcn_readfirstlane(tid >> 6), lane = tid & 63, wr = wid >> 2, wc = wid & 3, fr = lane & 15, fq = lane >> 4;
    const int nt = K / BK;
    unsigned voffA[2];
#pragma unroll
    for (int i = 0; i < 2; ++i) { int R, C; stage_rc(tid * 16 + i * 8192, R, C); voffA[i] = (unsigned)(R * K + C) * 2u; }
    const size_t kstep = (size_t)(BK * 2);
    const size_t hstep = (size_t)HALF * K * 2;
    const unsigned ldsw = (unsigned)wid * 1024u;
    const int aoff = lds_byte(wr * 64 + fr, fq * 8), boff = lds_byte(wc * 32 + fr, fq * 8);
#define PG8_SA(b, h) (((b) * 2 + (h)) * HTB)
#define PG8_SB(b, h) ((4 + (b) * 2 + (h)) * HTB)
#define PG8_STAGE(bufoff, gbase, voff) do { _Pragma("unroll") for (int _i = 0; _i < 2; ++_i) \
        __builtin_amdgcn_global_load_lds((const unsigned*)((const char*)(gbase) + (voff)[_i]), (PG8_LAS unsigned*)(lds + (bufoff) + ldsw + _i * 8192), 16, 0, 0); } while (0)
#define PG8_LDA(dst, b, h) do { _Pragma("unroll") for (int m = 0; m < 4; ++m) _Pragma("unroll") for (int k = 0; k < 2; ++k) dst[m][k] = *(const PG8_LAS bf16x8*)(lds + PG8_SA(b, h) + aoff + m * 2048 + k * 1024); } while (0)
#define PG8_LDB(dst, b, h) do { _Pragma("unroll") for (int n = 0; n < 2; ++n) _Pragma("unroll") for (int k = 0; k < 2; ++k) dst[n][k] = *(const PG8_LAS bf16x8*)(lds + PG8_SB(b, h) + boff + n * 2048 + k * 1024); } while (0)
#define PG8_MMA(ai, bj, At, Bt) do { __builtin_amdgcn_s_setprio(1); _Pragma("unroll") for (int m = 0; m < 4; ++m) _Pragma("unroll") for (int n = 0; n < 2; ++n) _Pragma("unroll") for (int k = 0; k < 2; ++k) \
        acc[ai][bj][m][n] = __builtin_amdgcn_mfma_f32_16x16x32_bf16(Bt[n][k], At[m][k], acc[ai][bj][m][n], 0, 0, 0); __builtin_amdgcn_s_setprio(0); } while (0)
#define PG8_WAIT_V(n) asm volatile("s_waitcnt vmcnt(" #n ")" ::: "memory")
#define PG8_WAIT_L(n) asm volatile("s_waitcnt lgkmcnt(" #n ")" ::: "memory")
#define PG8_BAR __builtin_amdgcn_s_barrier()
#define PG8_SCHED __builtin_amdgcn_sched_barrier(0)
    Unit cur, nxt; int ui = 0;
    if (!S.next(0, cur)) return;
    f32x4 acc[2][2][4][2];
#pragma unroll
    for (int a = 0; a < 2; ++a)
#pragma unroll
        for (int b = 0; b < 2; ++b)
#pragma unroll
            for (int m = 0; m < 4; ++m)
#pragma unroll
                for (int n = 0; n < 2; ++n) acc[a][b][m][n] = (f32x4){0.f, 0.f, 0.f, 0.f};
    bf16x8 At[4][2], B0[2][2], B1[2][2];
    const char* cA = cur.A; const char* cB = cur.B;
    PG8_STAGE(PG8_SB(0, 0), cB, voffA); PG8_STAGE(PG8_SA(0, 0), cA, voffA); PG8_STAGE(PG8_SB(0, 1), cB + hstep, voffA); PG8_STAGE(PG8_SA(0, 1), cA + hstep, voffA);
    if (wr == 1) PG8_BAR;
    PG8_WAIT_V(4); PG8_BAR;
    PG8_STAGE(PG8_SB(1, 0), cB + kstep, voffA); PG8_STAGE(PG8_SA(1, 0), cA + kstep, voffA); PG8_STAGE(PG8_SB(1, 1), cB + hstep + kstep, voffA);
    PG8_WAIT_V(6); PG8_BAR;
    for (;;) {
        const bool has_next = S.next(ui + 1, nxt);
        const char* nA = has_next ? nxt.A : cA; const char* nB = has_next ? nxt.B : cB;
        for (int t = 0; t < nt; t += 2) {
            const bool last = (t == nt - 2);
            const char* a1 = cA + (size_t)(t + 1) * kstep;
            const char* a2 = last ? nA : cA + (size_t)(t + 2) * kstep; const char* b2 = last ? nB : cB + (size_t)(t + 2) * kstep;
            const char* a3 = a2 + kstep; const char* b3 = b2 + kstep;
            PG8_LDB(B0, 0, 0); PG8_SCHED; PG8_LDA(At, 0, 0); PG8_STAGE(PG8_SA(1, 1), a1 + hstep, voffA);
            PG8_WAIT_L(8); PG8_BAR; PG8_WAIT_L(0); PG8_MMA(0, 0, At, B0); PG8_BAR; PG8_SCHED;
            PG8_LDB(B1, 0, 1); PG8_STAGE(PG8_SB(0, 0), b2, voffA);
            PG8_BAR; PG8_WAIT_L(0); PG8_MMA(0, 1, At, B1); PG8_BAR;
            PG8_LDA(At, 0, 1); PG8_STAGE(PG8_SA(0, 0), a2, voffA);
            PG8_BAR; PG8_WAIT_L(0); PG8_MMA(1, 0, At, B0); PG8_BAR; PG8_SCHED;
            PG8_STAGE(PG8_SB(0, 1), b2 + hstep, voffA);
            PG8_WAIT_V(6); PG8_BAR; PG8_MMA(1, 1, At, B1); PG8_BAR;
            PG8_LDB(B0, 1, 0); PG8_SCHED; PG8_LDA(At, 1, 0); PG8_STAGE(PG8_SA(0, 1), a2 + hstep, voffA);
            PG8_WAIT_L(8); PG8_BAR; PG8_WAIT_L(0); PG8_MMA(0, 0, At, B0); PG8_BAR; PG8_SCHED;
            PG8_LDB(B1, 1, 1); PG8_STAGE(PG8_SB(1, 0), b3, voffA);
            PG8_BAR; PG8_WAIT_L(0); PG8_MMA(0, 1, At, B1); PG8_BAR;
            PG8_LDA(At, 1, 1); PG8_STAGE(PG8_SA(1, 0), a3, voffA);
            PG8_BAR; PG8_WAIT_L(0); PG8_MMA(1, 0, At, B0); PG8_BAR; PG8_SCHED;
            PG8_STAGE(PG8_SB(1, 1), b3 + hstep, voffA);
            PG8_WAIT_V(6); PG8_BAR; PG8_MMA(1, 1, At, B1); PG8_BAR;
        }
        E(acc, cur, wr, wc, fr, fq);
        if (!has_next) break;
#pragma unroll
        for (int a = 0; a < 2; ++a)
#pragma unroll
            for (int b = 0; b < 2; ++b)
#pragma unroll
                for (int m = 0; m < 4; ++m)
#pragma unroll
                    for (int n = 0; n < 2; ++n) acc[a][b][m][n] = (f32x4){0.f, 0.f, 0.f, 0.f};
        cur = nxt; cA = nA; cB = nB; ++ui;
    }
    PG8_WAIT_V(0);
    if (wr == 0) PG8_BAR;
    PG8_BAR;
#undef PG8_SA
#undef PG8_SB
#undef PG8_STAGE
#undef PG8_LDA
#undef PG8_LDB
#undef PG8_MMA
#undef PG8_WAIT_V
#undef PG8_WAIT_L
#undef PG8_BAR
#undef PG8_SCHED
}
template <class F> struct EpiRC { F f;
    __device__ __forceinline__ void operator()(const f32x4 (&acc)[2][2][4][2], const Unit& u, int wr, int wc, int fr, int fq) const {
#pragma unroll
        for (int ai = 0; ai < 2; ++ai)
#pragma unroll
            for (int m = 0; m < 4; ++m) { const int row = u.pm * BM + ai * HALF + wr * 64 + m * 16 + fr;
#pragma unroll
                for (int bj = 0; bj < 2; ++bj)
#pragma unroll
                    for (int n = 0; n < 2; ++n) f(u, row, u.pn * BM + bj * HALF + wc * 32 + n * 16 + 4 * fq, acc[ai][bj][m][n]);
                asm volatile("" ::: "memory"); }
    } };
template <class F> __device__ __forceinline__ EpiRC<F> epi_rc(const F& f) { return EpiRC<F>{f}; }
template <class F> struct EpiPair { F f;
    __device__ __forceinline__ void operator()(const f32x4 (&acc)[2][2][4][2], const Unit& u, int wr, int wc, int fr, int fq) const {
#pragma unroll
        for (int ai = 0; ai < 2; ++ai)
#pragma unroll
            for (int m = 0; m < 4; ++m) { const int row = u.pm * BM + ai * HALF + wr * 64 + m * 16 + fr;
#pragma unroll
                for (int n = 0; n < 2; ++n) f(u, row, u.pn * HALF + wc * 32 + n * 16 + 4 * fq, acc[ai][0][m][n], acc[ai][1][m][n]);
                asm volatile("" ::: "memory"); }
    } };
template <class F> __device__ __forceinline__ EpiPair<F> epi_pair(const F& f) { return EpiPair<F>{f}; }
template <class F, class CF, class RF> struct EpiPre { F f; CF cf; RF rf;
    __device__ __forceinline__ void operator()(const f32x4 (&acc)[2][2][4][2], const Unit& u, int wr, int wc, int fr, int fq) const {
        f32x4 cv[2][2]; float rv[2][4];
#pragma unroll
        for (int bj = 0; bj < 2; ++bj)
#pragma unroll
            for (int n = 0; n < 2; ++n) cv[bj][n] = cf(u, u.pn * BM + bj * HALF + wc * 32 + n * 16 + 4 * fq);
#pragma unroll
        for (int ai = 0; ai < 2; ++ai)
#pragma unroll
            for (int m = 0; m < 4; ++m) rv[ai][m] = rf(u, u.pm * BM + ai * HALF + wr * 64 + m * 16 + fr);
#pragma unroll
        for (int ai = 0; ai < 2; ++ai)
#pragma unroll
            for (int m = 0; m < 4; ++m) { const int row = u.pm * BM + ai * HALF + wr * 64 + m * 16 + fr;
#pragma unroll
                for (int bj = 0; bj < 2; ++bj)
#pragma unroll
                    for (int n = 0; n < 2; ++n) f(u, row, u.pn * BM + bj * HALF + wc * 32 + n * 16 + 4 * fq, acc[ai][bj][m][n], cv[bj][n], rv[ai][m]);
                asm volatile("" ::: "memory"); }
    } };
template <class F, class CF, class RF> __device__ __forceinline__ EpiPre<F, CF, RF> epi_pre(const F& f, const CF& cf, const RF& rf) { return EpiPre<F, CF, RF>{f, cf, rf}; }
template <class F, class CF> struct EpiColFirst { F f; CF cf;
    __device__ __forceinline__ void operator()(const f32x4 (&acc)[2][2][4][2], const Unit& u, int wr, int wc, int fr, int fq) const {
#pragma unroll
        for (int bj = 0; bj < 2; ++bj)
#pragma unroll
            for (int n = 0; n < 2; ++n) { const int col = u.pn * BM + bj * HALF + wc * 32 + n * 16 + 4 * fq; const f32x4 cv = cf(u, col);
#pragma unroll
                for (int ai = 0; ai < 2; ++ai)
#pragma unroll
                    for (int m = 0; m < 4; ++m) f(u, u.pm * BM + ai * HALF + wr * 64 + m * 16 + fr, col, acc[ai][bj][m][n], cv);
                asm volatile("" ::: "memory"); }
    } };
template <class F, class CF> __device__ __forceinline__ EpiColFirst<F, CF> epi_colfirst(const F& f, const CF& cf) { return EpiColFirst<F, CF>{f, cf}; }
struct EpiResid { xt_t* X; const float* MOD; int layer;
    __device__ __forceinline__ void operator()(const f32x4 (&acc)[2][2][4][2], const Unit& u, int wr, int wc, int fr, int fq) const {
        const int row0 = u.pm * BM + wr * 64 + fr, col0 = u.pn * BM + wc * 32 + 4 * fq;
        const int strm = row0 < NLAT ? (row0 >> 12) : 4;
        const float* gp = MOD + ((size_t)layer * 5 + strm) * 6144 + 2048 + col0;
        f32x4 gt[2][2];
#pragma unroll
        for (int bj = 0; bj < 2; ++bj)
#pragma unroll
            for (int n = 0; n < 2; ++n) gt[bj][n] = *(const f32x4*)(gp + bj * HALF + n * 16);
#pragma unroll
        for (int ai = 0; ai < 2; ++ai) {
            f32x4 xv[4][2][2];
#pragma unroll
            for (int m = 0; m < 4; ++m)
#pragma unroll
                for (int bj = 0; bj < 2; ++bj)
#pragma unroll
                    for (int n = 0; n < 2; ++n) xv[m][bj][n] = xldv(X, (size_t)(row0 + ai * HALF + m * 16) * D + col0 + bj * HALF + n * 16);
#pragma unroll
            for (int m = 0; m < 4; ++m)
#pragma unroll
                for (int bj = 0; bj < 2; ++bj)
#pragma unroll
                    for (int n = 0; n < 2; ++n) xstv(X, (size_t)(row0 + ai * HALF + m * 16) * D + col0 + bj * HALF + n * 16, xv[m][bj][n] + gt[bj][n] * acc[ai][bj][m][n]);
            asm volatile("" ::: "memory");
        }
    } };
struct BatchSched { const char* A; const char* B; size_t strideA, strideB; int nM, nN, nb, K; int rev = 0;
    __device__ __forceinline__ bool next(int i, Unit& u) const {
        const int nwg = nM * nN * nb; const int L = i * gdim() + (rev ? gdim() - 1 - bidx() : bidx()); if (L >= nwg) return false;
        const int w = xcd_remap(L, nwg); const int per = nM * nN; u.g = w / per; const int r = w % per; u.pm = r / nN; u.pn = r % nN;
        u.A = A + u.g * strideA + (size_t)u.pm * BM * K * 2; u.B = B + u.g * strideB + (size_t)u.pn * BM * K * 2; return true; } };
}

template <class SrcF, class DRow>
__device__ __forceinline__ int cvt_tiles(const int wv_, char* lds, bf16_t* dst, int Kd, int Nd, int nbatch, size_t dstride, const SrcF& src, const DRow& drow, int* rot = nullptr) {
    bf16_t* T = (bf16_t*)lds;
    const int tid = tidx_w(wv_);
    const int tk = Kd / 128, tn = Nd / 64, per = tk * tn, total = per * nbatch;
    {
        int first = bidx() - (rot ? *rot % gdim() : 0); if (first < 0) first += gdim();
        if (rot) *rot += total;
        for (int t = first; t < total; t += gdim()) {
            const int bt = t / per, r = t % per, k0 = (r % tk) * 128, n0 = (r / tk) * 64;
            float4 v[4];
#pragma unroll
            for (int i = 0; i < 4; ++i) { const int k = k0 + i * 32 + (tid >> 4), n = n0 + (tid & 15) * 4; const float* sp = src(bt, k, n); v[i] = sp ? *(const float4*)sp : make_float4(0.f, 0.f, 0.f, 0.f); }
            __syncthreads();
#pragma unroll
            for (int i = 0; i < 4; ++i) { const int k = i * 32 + (tid >> 4), n = (tid & 15) * 4;
                T[(n + 0) * 136 + k] = f2bf(v[i].x); T[(n + 1) * 136 + k] = f2bf(v[i].y); T[(n + 2) * 136 + k] = f2bf(v[i].z); T[(n + 3) * 136 + k] = f2bf(v[i].w); }
            __syncthreads();
            { const int n = tid >> 3, kc = (tid & 7) * 16;
              const u32x4 a = *(const u32x4*)(T + n * 136 + kc), b = *(const u32x4*)(T + n * 136 + kc + 8);
              bf16_t* dp = dst + bt * dstride + (size_t)drow(n0 + n) * Kd + k0 + kc;
              *(u32x4*)dp = a; *(u32x4*)(dp + 8) = b; }
        }
    }
    return 0;
}
__device__ __forceinline__ int moe_cvt(const Params& p, int layer, char* lds, int budget) {
    constexpr int QG = 2, T13 = NE * 8 * 44, TOT = T13 + NE * 11 * 16;
    bf16_t* T = (bf16_t*)lds;
    int* qslot = (int*)(lds + 64 * 136 * 2);
    const int tid = tidx();
    const float* w1 = p.moe_w1 + (size_t)layer * NE * D * FF; const float* w3 = p.moe_w3 + (size_t)layer * NE * D * FF; const float* w2 = p.moe_w2 + (size_t)layer * NE * FF * D;
    bf16_t* W13 = (bf16_t*)(p.ws + OFF_W13T + (size_t)(layer & 1) * SZ_WMOE); bf16_t* W2 = (bf16_t*)(p.ws + OFF_W2T + (size_t)(layer & 1) * SZ_WMOE);
    unsigned* queue = (unsigned*)(p.ws + OFF_QUEUE) + layer * 32;
    const bool ahead = budget < 0;
    int done = 0, tnext = 0;
    __syncthreads();
    if (tid == 0) qslot[0] = QG * (int)__hip_atomic_fetch_add(queue, 1u, __ATOMIC_RELAXED, __HIP_MEMORY_SCOPE_AGENT);
    __syncthreads();
    int t0 = __builtin_amdgcn_readfirstlane(qslot[0]);
    while (t0 < TOT && (ahead || done < budget)) {
        const bool more = ahead || done + 1 < budget;
        if (more && tid == 0) tnext = QG * (int)__hip_atomic_fetch_add(queue, 1u, __ATOMIC_RELAXED, __HIP_MEMORY_SCOPE_AGENT);
#pragma unroll 1
        for (int sub = 0; sub < QG; ++sub) {
            const int t = t0 + sub;
            const float* sp; bf16_t* dp; int ss, ds;
            if (t < T13) { const int e = t / 352, r = t % 352, k0 = (r & 7) * 128, n0 = (r >> 3) * 64; const int c0 = (n0 >> 8) * 128 + (n0 & 127);
                sp = (((n0 >> 7) & 1) ? w3 : w1) + ((size_t)e * D + k0) * FF + c0; ss = FF; dp = W13 + ((size_t)e * 2816 + n0) * D + k0; ds = D; }
            else { const int u = t - T13, e = u / 176, r = u % 176, k0 = (r % 11) * 128, n0 = (r / 11) * 64;
                sp = w2 + ((size_t)e * FF + k0) * D + n0; ss = D; dp = W2 + ((size_t)e * D + n0) * FF + k0; ds = FF; }
            float4 v[4];
#pragma unroll
            for (int i = 0; i < 4; ++i) v[i] = *(const float4*)(sp + (size_t)(i * 32 + (tid >> 4)) * ss + (tid & 15) * 4);
            __syncthreads();
#pragma unroll
            for (int i = 0; i < 4; ++i) { const int k = i * 32 + (tid >> 4), n = (tid & 15) * 4;
                T[(n + 0) * 136 + k] = f2bf(v[i].x); T[(n + 1) * 136 + k] = f2bf(v[i].y); T[(n + 2) * 136 + k] = f2bf(v[i].z); T[(n + 3) * 136 + k] = f2bf(v[i].w); }
            if (sub == QG - 1 && tid == 0) qslot[0] = more ? tnext : TOT;
            __syncthreads();
            { const int n = tid >> 3, kc = (tid & 7) * 16;
              const u32x4 a = *(const u32x4*)(T + n * 136 + kc), b = *(const u32x4*)(T + n * 136 + kc + 8);
              bf16_t* o = dp + (size_t)n * ds + kc;
              *(u32x4*)o = a; *(u32x4*)(o + 8) = b; }
        }
        ++done; t0 = __builtin_amdgcn_readfirstlane(qslot[0]);
    }
    __syncthreads();
    return done;
}
__device__ __forceinline__ void bg_cvt(const Params& p, int layer, char* lds, int budget) {
#pragma unroll 1
    for (int l = layer; l < 4 && l <= layer + 1 && budget > 0; ++l) budget -= moe_cvt(p, l, lds, budget);
}
__device__ __forceinline__ bool idle_tail(int nunits) { const int r = nunits % gdim(); return r != 0 && bidx() >= r; }
__device__ void ph_init(const Params& p, char* lds) {
    const int tid = tidx(), gtid = bidx() * NTHR + tid, gsz = gdim() * NTHR;
    xt_t* Xs = (xt_t*)(p.ws + OFF_X);
    const float4* x4 = (const float4*)p.x; const float4* c4 = (const float4*)p.ctx;
    { constexpr int NQ = NROW * 256 / 4;
      auto srcv = [&](int k) { return k < NLAT * 256 ? x4[k] : c4[k - NLAT * 256]; };
      for (int i = gtid; i < NQ; i += gsz) { const float4 t0 = srcv(i), t1 = srcv(i + NQ), t2 = srcv(i + 2 * NQ), t3 = srcv(i + 3 * NQ); xst(Xs, (size_t)4 * i, t0); xst(Xs, (size_t)4 * (i + NQ), t1); xst(Xs, (size_t)4 * (i + 2 * NQ), t2); xst(Xs, (size_t)4 * (i + 3 * NQ), t3); } }
    float* rc = (float*)(p.ws + OFF_ROPE_C); float* rs = (float*)(p.ws + OFF_ROPE_S);
    for (int i = gtid; i < TL * 32; i += gsz) {
        const int t = i >> 5, f = i & 31; const float pos = (float)((f < 16) ? (t >> 6) : (t & 63));
        const float inv = powf(10000.f, -(float)(f & 15) / 16.f); const float ang = pos * inv; rc[2 * i] = cosf(ang); rc[2 * i + 1] = sinf(ang);
    }
    float* sc = (float*)lds;
    float* red = sc + 5 * 1024;
    for (int i = tid; i < 5 * 1024; i += NTHR) { const float v = i < 4096 ? p.c[i] : p.c_ctx[i - 4096]; sc[i] = v / (1.f + expf(-v)); }
    __syncthreads();
    float* MOD = (float*)(p.ws + OFF_MOD);
    for (int item = bidx(); item < 4 * 96; item += gdim()) {
        const int l = item / 96, cg = item % 96, col = tid & 63, n = cg * 64 + col, kg = tid >> 6;
        const float* w = p.mod_w + ((size_t)l * 1024 + kg * 128) * 6144 + n;
        float a0 = 0, a1 = 0, a2 = 0, a3 = 0, a4 = 0;
#pragma unroll 16
        for (int k = 0; k < 128; ++k) { const float wv = w[(size_t)k * 6144]; const int kk = kg * 128 + k;
            a0 += sc[kk] * wv; a1 += sc[1024 + kk] * wv; a2 += sc[2048 + kk] * wv; a3 += sc[3072 + kk] * wv; a4 += sc[4096 + kk] * wv; }
        float* rr = red + (kg * 64 + col) * 5; rr[0] = a0; rr[1] = a1; rr[2] = a2; rr[3] = a3; rr[4] = a4;
        __syncthreads();
        if (tid < 320) { const int c2 = tid & 63, s = tid >> 6; float sum = 0;
            for (int q = 0; q < 8; ++q) sum += red[(q * 64 + c2) * 5 + s];
            MOD[((size_t)l * 5 + s) * 6144 + cg * 64 + c2] = sum + p.mod_b[l * 6144 + cg * 64 + c2]; }
        __syncthreads();
    }
}


__device__ void ph_small_cvt(const Params& p, char* lds) {
    int rot = 128;
    for (int j = 0; j < 2; ++j) {
        char* wm = p.ws + OFF_WMLA + j * SZ_WMLA; char* wr = p.ws + OFF_WRW + j * SZ_WRW;
        const float* w_in = p.mla_w_in + (size_t)j * D * 448; const float* w_uq = p.mla_w_uq + (size_t)j * 256 * 1536; const float* w_ukv = p.mla_w_ukv + (size_t)j * 128 * 2048; const float* w_o = p.mla_w_o + (size_t)j * D * D;
        cvt_tiles(p.wv, lds, (bf16_t*)(wm + WM_IN), 1024, 512, 1, 0, [=](int, int k, int n) -> const float* { return n < 448 ? w_in + (size_t)k * 448 + n : nullptr; },
                  [=](int n) { if (n < 384 || n >= 448) return n; const int jj = n - 384; return 384 + (jj < 32 ? 2 * jj : 2 * (jj - 32) + 1); }, &rot);
        cvt_tiles(p.wv, lds, (bf16_t*)(wm + WM_UQ), 256, 1536, 1, 0, [=](int, int k, int n) -> const float* { return w_uq + (size_t)k * 1536 + n; },
                  [=](int n) { const int h = n / 192, d = n % 192; if (d < 128) return n; const int jj = d - 128; return h * 192 + 128 + (jj < 32 ? 2 * jj : 2 * (jj - 32) + 1); }, &rot);
        cvt_tiles(p.wv, lds, (bf16_t*)(wm + WM_UKV), 128, 2048, 1, 0, [=](int, int k, int n) -> const float* { return w_ukv + (size_t)k * 2048 + n; }, [=](int n) { return n; }, &rot);
        cvt_tiles(p.wv, lds, (bf16_t*)(wm + WM_O), 1024, 1024, 1, 0, [=](int, int k, int n) -> const float* { return w_o + (size_t)k * D + n; }, [=](int n) { return n; }, &rot);
        const float* w_rkv = p.rw_w_rkv + (size_t)j * 3 * D * D; const float* w1 = p.rw_w1 + (size_t)j * 2 * D * 64; const float* a1 = p.rw_a1 + (size_t)j * 2 * D * 64;
        const float* g1 = p.rw_g1 + (size_t)j * D * 128; const float* v1 = p.rw_v1; const float* rwo = p.rw_w_o + (size_t)j * D * D;
        cvt_tiles(p.wv, lds, (bf16_t*)(wr + WR_RKV), 1024, 1024, 3, (size_t)D * D, [=](int m, int k, int n) -> const float* { return w_rkv + ((size_t)m * D + k) * D + n; }, [=](int n) { return n; }, &rot);
        cvt_tiles(p.wv, lds, (bf16_t*)(wr + WR_L), 1024, 256, 1, 0, [=](int, int k, int n) -> const float* { return n < 128 ? w1 + ((size_t)(n >> 6) * D + k) * 64 + (n & 63) : nullptr; }, [=](int n) { return n; }, &rot);
        cvt_tiles(p.wv, lds, (bf16_t*)(wr + WR_L) + 256 * 1024, 1024, 256, 1, 0, [=](int, int k, int n) -> const float* { return n < 128 ? a1 + ((size_t)(n >> 6) * D + k) * 64 + (n & 63) : nullptr; }, [=](int n) { return n; }, &rot);
        cvt_tiles(p.wv, lds, (bf16_t*)(wr + WR_L) + 2 * 256 * 1024, 1024, 256, 1, 0, [=](int, int k, int n) -> const float* { return n < 128 ? g1 + (size_t)k * 128 + n : nullptr; }, [=](int n) { return n; }, &rot);
        cvt_tiles(p.wv, lds, (bf16_t*)(wr + WR_L) + 3 * 256 * 1024, 1024, 256, 1, 0, [=](int, int k, int n) -> const float* { return n < 32 ? v1 + (size_t)k * 32 + n : nullptr; }, [=](int n) { return n; }, &rot);
        cvt_tiles(p.wv, lds, (bf16_t*)(wr + WR_O), 1024, 1024, 1, 0, [=](int, int k, int n) -> const float* { return rwo + (size_t)k * D + n; }, [=](int n) { return n; }, &rot);
        const float* w2 = p.rw_w2 + (size_t)j * 2 * 64 * D; const float* a2 = p.rw_a2 + (size_t)j * 2 * 64 * D; const float* g2 = p.rw_g2 + (size_t)j * 128 * D; const float* v2 = p.rw_v2;
        cvt_tiles(p.wv, lds, (bf16_t*)(wr + WR_B2), 128, 2048, 2, (size_t)2048 * 128, [=](int bt, int k, int n) -> const float* { const int zz = n >> 10, c = n & 1023, l = k - zz * 64;
            if (l < 0 || l >= 64) return nullptr; return (bt == 0 ? w2 : a2) + ((size_t)zz * 64 + l) * D + c; }, [=](int n) { return n; }, &rot);
        cvt_tiles(p.wv, lds, (bf16_t*)(wr + WR_B3), 128, 1024, 2, (size_t)1024 * 128, [=](int bt, int k, int n) -> const float* {
            if (bt == 0) return g2 + (size_t)k * D + n; return k < 32 ? v2 + (size_t)k * D + n : nullptr; }, [=](int n) { return n; }, &rot);
    }
}

template <bool OUTF32>
__device__ void ph_norm_mod(const Params& p, int layer, const float* g, int part_sh, int part_sc, void* outp) {
    const int wid = tidx() >> 6, lane = tidx() & 63;
    const xt_t* X = (const xt_t*)(p.ws + OFF_X);
    const int w_ = bidx() * 8 + wid, nw_ = gdim() * 8;
    int row = (int)((long long)w_ * NROW / nw_); const int rend = (int)((long long)(w_ + 1) * NROW / nw_);
    float4 nv[4], gm[4], bb[4]; int scur = -1;
    if (row < rend) {
#pragma unroll
        for (int i = 0; i < 4; ++i) nv[i] = xld(X, (size_t)row * D + (lane + i * 64) * 4); }
    for (; row < rend; ++row) {
        const int s = row_stream(row);
        if (s != scur) { scur = s; const float* sh = modp(p, layer, s, part_sh); const float* sc = modp(p, layer, s, part_sc);
#pragma unroll
            for (int i = 0; i < 4; ++i) { const int d = (lane + i * 64) * 4; const float4 gg = *(const float4*)(g + d), a = *(const float4*)(sc + d); bb[i] = *(const float4*)(sh + d);
                gm[i] = make_float4(gg.x * (1.f + a.x), gg.y * (1.f + a.y), gg.z * (1.f + a.z), gg.w * (1.f + a.w)); } }
        float4 v[4]; float ss = 0;
#pragma unroll
        for (int i = 0; i < 4; ++i) { v[i] = nv[i]; ss += v[i].x * v[i].x + v[i].y * v[i].y + v[i].z * v[i].z + v[i].w * v[i].w; }
        { const int nrow = row + 1;
          if (nrow < rend) {
#pragma unroll
              for (int i = 0; i < 4; ++i) nv[i] = xld(X, (size_t)nrow * D + (lane + i * 64) * 4); } }
        ss = wave_sum(ss); const float rs = rsqrtf(ss * (1.f / D) + RMS_EPS);
#pragma unroll
        for (int i = 0; i < 4; ++i) {
            const int d = (lane + i * 64) * 4;
            float4 o; o.x = v[i].x * rs * gm[i].x + bb[i].x; o.y = v[i].y * rs * gm[i].y + bb[i].y; o.z = v[i].z * rs * gm[i].z + bb[i].z; o.w = v[i].w * rs * gm[i].w + bb[i].w;
            if (OUTF32) *(float4*)((float*)outp + (size_t)row * D + d) = o;
            else { uint2 w; w.x = pk2(o.x, o.y); w.y = pk2(o.z, o.w); *(uint2*)((bf16_t*)outp + (size_t)row * D + d) = w; }
        }
    }
}

__device__ void ph_mla_mid(const Params& p, int j) {
    const int wid = tidx() >> 6, lane = tidx() & 63;
    const float* Z = (const float*)(p.ws + OFF_Z);
    bf16_t* CQN = (bf16_t*)(p.ws + OFF_CQN); bf16_t* CKVN = (bf16_t*)(p.ws + OFF_CKVN); bf16_t* K = (bf16_t*)(p.ws + OFF_K);
    const float* gq = p.mla_g_q + j * 256; const float* gkv = p.mla_g_kv + j * 128;
    const float* rc = (const float*)(p.ws + OFF_ROPE_C); const float* rs = (const float*)(p.ws + OFF_ROPE_S);
    for (int row = bidx() * 8 + wid; row < NROW; row += gdim() * 8) {
        const float* z = Z + (size_t)row * 512;
        const float4 q = *(const float4*)(z + lane * 4);
        const float2 kv = *(const float2*)(z + 256 + lane * 2);
        const float kr = z[384 + lane];
        float sq = wave_sum(q.x * q.x + q.y * q.y + q.z * q.z + q.w * q.w); const float rq = rsqrtf(sq * (1.f / 256.f) + RMS_EPS);
        float sk = wave_sum(kv.x * kv.x + kv.y * kv.y); const float rk = rsqrtf(sk * (1.f / 128.f) + RMS_EPS);
        const float4 g4 = *(const float4*)(gq + lane * 4); const float2 g2 = *(const float2*)(gkv + lane * 2);
        uint2 w; w.x = pk2(q.x * rq * g4.x, q.y * rq * g4.y); w.y = pk2(q.z * rq * g4.z, q.w * rq * g4.w);
        *(uint2*)(CQN + (size_t)row * 256 + lane * 4) = w;
        *(unsigned*)(CKVN + (size_t)row * 128 + lane * 2) = pk2(kv.x * rk * g2.x, kv.y * rk * g2.y);
        float o = kr;
        const float other = __builtin_bit_cast(float, __builtin_amdgcn_update_dpp(0, __builtin_bit_cast(int, kr), 0xB1, 0xF, 0xF, true));
        const bool lat = row < NLAT;
        if (lat) { const int t = row & (TL - 1), i = lane >> 1; const float2 cs = *(const float2*)(rc + (t * 32 + i) * 2); const float c = cs.x, s = cs.y;
            o = (lane & 1) ? (other * s + kr * c) : (kr * c - other * s); }
        const int b = lat ? (row >> 12) : ((row - NLAT) >> 8); const int tk = lat ? 256 + (row & (TL - 1)) : ((row - NLAT) & 255);
        const bf16_t ob = f2bf(o);
#pragma unroll
        for (int h = 0; h < 8; ++h) K[((size_t)(b * 8 + h) * TK + tk) * 192 + 128 + lane] = ob;
    }
}

__device__ void ph_qkv_post(const Params& p) {
    const int wid = tidx() >> 6, lane = tidx() & 63;
    const float* QRAW = (const float*)(p.ws + OFF_QRAW); const float* KVRAW = (const float*)(p.ws + OFF_KVRAW); const float* KR = (const float*)(p.ws + OFF_KR);
    bf16_t* Q = (bf16_t*)(p.ws + OFF_Q); bf16_t* K = (bf16_t*)(p.ws + OFF_K); bf16_t* V = (bf16_t*)(p.ws + OFF_V);
    const float* rc = (const float*)(p.ws + OFF_ROPE_C); const float* rs = (const float*)(p.ws + OFF_ROPE_S);
    for (int it = bidx() * 8 + wid; it < NROW * 8; it += gdim() * 8) {
        const int row = it >> 3, h = it & 7;
        const bool lat = row < NLAT; const int b = lat ? (row >> 12) : ((row - NLAT) >> 8); const int tk = lat ? 256 + (row & (TL - 1)) : ((row - NLAT) & 255);
        const size_t orow = (size_t)(b * 8 + h) * TK + tk;
        const float* q = QRAW + (size_t)row * 1536 + h * 192;
        const float q0 = q[lane], q1 = q[64 + lane]; float q2 = q[128 + lane];
        const auto sw = __builtin_amdgcn_permlane32_swap(__float_as_uint(q2), __float_as_uint(q2), false, false);
        if (lat) { const int t = row & (TL - 1), i = lane & 31; const float c = rc[t * 32 + i], s = rs[t * 32 + i];
            const float x1 = __uint_as_float(sw[0]), x2 = __uint_as_float(sw[1]); q2 = lane < 32 ? (x1 * c - x2 * s) : (x1 * s + x2 * c); }
        bf16_t* qo = Q + orow * 192; qo[lane] = f2bf(q0); qo[64 + lane] = f2bf(q1); qo[128 + lane] = f2bf(q2);
        const float* kv = KVRAW + (size_t)row * 2048 + h * 256;
        bf16_t* ko = K + orow * 192; ko[lane] = f2bf(kv[lane]); ko[64 + lane] = f2bf(kv[64 + lane]); ko[128 + lane] = f2bf(KR[(size_t)row * 64 + lane]);
        bf16_t* vo = V + orow * 128; vo[lane] = f2bf(kv[128 + lane]); vo[64 + lane] = f2bf(kv[192 + lane]);
    }
}

__device__ void ph_attn_naive(const Params& p, char* lds) {
    const int tid = tidx(), qi = tid >> 2, part = tid & 3;
    const bf16_t* Q = (const bf16_t*)(p.ws + OFF_Q); const bf16_t* K = (const bf16_t*)(p.ws + OFF_K); const bf16_t* V = (const bf16_t*)(p.ws + OFF_V);
    bf16_t* O = (bf16_t*)(p.ws + OFF_O);
    bf16_t* Ks = (bf16_t*)lds;
    bf16_t* Vs = Ks + 32 * 192;
    const int nitems = 32 * 34;
    for (int it = bidx(); it < nitems; it += gdim()) {
        const int bh = it / 34, qb = it % 34; const int b = bh >> 3, h = bh & 7;
        const int nkeys = qb < 2 ? TC : TK;
        const int tq = qb * 128 + qi;
        const bf16_t* qp = Q + ((size_t)bh * TK + tq) * 192 + part * 48;
        float q[48];
#pragma unroll
        for (int i = 0; i < 48; ++i) q[i] = bf2f(qp[i]) * ATT_SCALE;
        float o[32];
#pragma unroll
        for (int i = 0; i < 32; ++i) o[i] = 0.f;
        float m = -1e30f, l = 0.f;
        for (int k0 = 0; k0 < nkeys; k0 += 32) {
            __syncthreads();
            {
                const bf16_t* kg = K + ((size_t)bh * TK + k0) * 192; const bf16_t* vg = V + ((size_t)bh * TK + k0) * 128;
                for (int c = tid; c < 768; c += NTHR) *(u32x4*)(Ks + c * 8) = *(const u32x4*)(kg + c * 8);
                *(u32x4*)(Vs + tid * 8) = *(const u32x4*)(vg + tid * 8);
            }
            __syncthreads();
#pragma unroll 1
            for (int kg = 0; kg < 32; kg += 8) {
                float s[8]; float tmax = -1e30f;
#pragma unroll
                for (int kk = 0; kk < 8; ++kk) {
                    const bf16_t* kr = Ks + (kg + kk) * 192 + part * 48; float acc = 0.f;
#pragma unroll
                    for (int i = 0; i < 48; ++i) acc += q[i] * bf2f(kr[i]);
                    acc += __shfl_xor(acc, 1); acc += __shfl_xor(acc, 2);
                    s[kk] = acc; tmax = fmaxf(tmax, acc);
                    asm volatile("" ::: "memory");
                }
                const float mn = fmaxf(m, tmax), alpha = expf(m - mn); m = mn; l *= alpha;
#pragma unroll
                for (int i = 0; i < 32; ++i) o[i] *= alpha;
#pragma unroll
                for (int kk = 0; kk < 8; ++kk) {
                    const float pw = expf(s[kk] - mn); l += pw;
                    const bf16_t* vr = Vs + (kg + kk) * 128 + part * 32;
#pragma unroll
                    for (int i = 0; i < 32; ++i) o[i] += pw * bf2f(vr[i]);
                    asm volatile("" ::: "memory");
                }
            }
        }
        const float rl = 1.f / l;
        const int row = qb < 2 ? (NLAT + b * TC + tq) : (b * TL + tq - TC);
        bf16_t* op = O + (size_t)row * D + h * 128 + part * 32;
#pragma unroll
        for (int i = 0; i < 32; ++i) op[i] = f2bf(o[i] * rl);
    }
}


namespace fa {
using s16x4  = __attribute__((ext_vector_type(4))) short;
using f32x16 = __attribute__((ext_vector_type(16))) float;
constexpr int DQK = 192, DV = 128, KVBLK = 64;
constexpr float THR = 8.f;
constexpr int SHM_V = KVBLK * DV * 2, SHM_K = KVBLK * DQK * 2;
constexpr int SHM_ATTN = 2 * SHM_V + 2 * SHM_K + 8 * 64 * 4;
#define KSWZ(row, colB) ((row) * 384 + ((colB) ^ ((((row) >> 1) & 7) << 4)))
#define SBAR() __builtin_amdgcn_sched_barrier(0)
__device__ __forceinline__ int crow(int r, int hi) { return (r & 3) + 8 * (r >> 2) + 4 * hi; }
__device__ __forceinline__ unsigned cvtpk(float lo, float hi) { unsigned r; asm volatile("v_cvt_pk_bf16_f32 %0, %1, %2" : "=v"(r) : "v"(lo), "v"(hi)); return r; }
__device__ __forceinline__ void partialSM(f32x16& p0, f32x16& p1, float& m_reg, float& mn, float& alpha) {
  constexpr float C = ATT_SCALE * 1.4426950408889634f;
  float pmax = p0[0];
#pragma unroll
  for (int r = 1; r < 16; ++r) pmax = fmaxf(pmax, p0[r]);
#pragma unroll
  for (int r = 0; r < 16; ++r) pmax = fmaxf(pmax, p1[r]);
  { auto rr = __builtin_amdgcn_permlane32_swap(__float_as_uint(pmax), __float_as_uint(pmax), false, false);
    pmax = fmaxf(__uint_as_float(rr[0]), __uint_as_float(rr[1])); }
  if (__builtin_expect(__all(pmax - m_reg <= THR / ATT_SCALE), 1)) { mn = m_reg; alpha = 1.f; }
  else { mn = fmaxf(m_reg, pmax); alpha = __builtin_amdgcn_exp2f((m_reg - mn) * C); m_reg = mn; }
  float mnC = -mn * C;
#pragma unroll
  for (int r = 0; r < 16; ++r) p0[r] = fmaf(p0[r], C, mnC);
#pragma unroll
  for (int r = 0; r < 16; ++r) p1[r] = fmaf(p1[r], C, mnC);
#pragma unroll
  for (int r = 0; r < 16; ++r) p0[r] = __builtin_amdgcn_exp2f(p0[r]);
}
__device__ __forceinline__ void finishSM(f32x16& p0, f32x16& p1, float alpha, float& l_reg, bf16x8& pa0, bf16x8& pa1, bf16x8& pa2, bf16x8& pa3) {
#pragma unroll
  for (int r = 0; r < 16; ++r) p1[r] = __builtin_amdgcn_exp2f(p1[r]);
  float ps = 0;
#pragma unroll
  for (int r = 0; r < 16; ++r) ps += p0[r];
#pragma unroll
  for (int r = 0; r < 16; ++r) ps += p1[r];
  { auto rr = __builtin_amdgcn_permlane32_swap(__float_as_uint(ps), __float_as_uint(ps), false, false);
    ps = __uint_as_float(rr[0]) + __uint_as_float(rr[1]); }
  l_reg = l_reg * alpha + ps;
#define PK4(P, BASE, OUT) do { unsigned a0 = cvtpk(P[BASE + 0], P[BASE + 1]), a1 = cvtpk(P[BASE + 2], P[BASE + 3]);   \
    unsigned b0 = cvtpk(P[BASE + 4], P[BASE + 5]), b1 = cvtpk(P[BASE + 6], P[BASE + 7]);                              \
    auto r0 = __builtin_amdgcn_permlane32_swap(a0, b0, false, false); auto r1 = __builtin_amdgcn_permlane32_swap(a1, b1, false, false); \
    u32x4 w = {r0[0], r1[0], r0[1], r1[1]}; OUT = *reinterpret_cast<bf16x8*>(&w); } while (0)
  PK4(p0, 0, pa0); PK4(p0, 8, pa1); PK4(p1, 0, pa2); PK4(p1, 8, pa3);
#undef PK4
}
__device__ __forceinline__ void qkt(f32x16& p0, f32x16& p1, const char* Ks, const bf16x8* qr, int r32, int hi) {
  p0 = f32x16{}; p1 = f32x16{};
  const int swz = ((r32 >> 1) & 7) << 4;
  const char* b4[4];
#pragma unroll
  for (int dr = 0; dr < 4; ++dr) b4[dr] = Ks + r32 * 384 + ((dr * 32 + hi * 16) ^ swz);
#pragma unroll
  for (int d0 = 0; d0 < 12; ++d0) {
    bf16x8 b0 = *reinterpret_cast<const bf16x8*>(b4[d0 & 3] + (d0 >> 2) * 128);
    bf16x8 b1 = *reinterpret_cast<const bf16x8*>(b4[d0 & 3] + (d0 >> 2) * 128 + 32 * 384);
    p0 = __builtin_amdgcn_mfma_f32_32x32x16_bf16(b0, qr[d0], p0, 0, 0, 0);
    p1 = __builtin_amdgcn_mfma_f32_32x32x16_bf16(b1, qr[d0], p1, 0, 0, 0); }
}
__device__ __forceinline__ int v_st(int k, int c) { const int kk = (k & ~0xC) | ((k & 4) << 1) | ((k & 8) >> 1); return ((kk >> 3) * 4 + (c >> 5)) * 512 + ((kk & 7) * 32 + (c & 31)) * 2; }
__device__ __forceinline__ int v_rd_base(int lane) { return ((lane & 3) << 3) | (((lane >> 2) & 3) << 6) | (((lane >> 4) & 1) << 5) | (((lane >> 5) & 1) << 8); }
constexpr int v_rd_off(int d0, int ks, int half) { return d0 * 512 + ks * 4096 + half * 2048; }
template <int OFF> __device__ __forceinline__ s16x4 tr_read(int vb) {
  s16x4 r; asm volatile("ds_read_b64_tr_b16 %0, %1 offset:%2" : "=&v"(r) : "v"(vb), "i"(OFF) : "memory"); return r;
}
template <int D0> __device__ __forceinline__ void pv_one(f32x16& od, int vb, bf16x8 pa0, bf16x8 pa1, bf16x8 pa2, bf16x8 pa3) {
  const s16x4 l0 = tr_read<v_rd_off(D0, 0, 0)>(vb), h0 = tr_read<v_rd_off(D0, 0, 1)>(vb), l1 = tr_read<v_rd_off(D0, 1, 0)>(vb), h1 = tr_read<v_rd_off(D0, 1, 1)>(vb);
  const s16x4 l2 = tr_read<v_rd_off(D0, 2, 0)>(vb), h2 = tr_read<v_rd_off(D0, 2, 1)>(vb), l3 = tr_read<v_rd_off(D0, 3, 0)>(vb), h3 = tr_read<v_rd_off(D0, 3, 1)>(vb);
  asm volatile("s_waitcnt lgkmcnt(0)" ::: "memory"); SBAR();
#define PK(L, H) (bf16x8){L[0], L[1], L[2], L[3], H[0], H[1], H[2], H[3]}
  od = __builtin_amdgcn_mfma_f32_32x32x16_bf16(pa0, PK(l0, h0), od, 0, 0, 0);
  od = __builtin_amdgcn_mfma_f32_32x32x16_bf16(pa1, PK(l1, h1), od, 0, 0, 0);
  od = __builtin_amdgcn_mfma_f32_32x32x16_bf16(pa2, PK(l2, h2), od, 0, 0, 0);
  od = __builtin_amdgcn_mfma_f32_32x32x16_bf16(pa3, PK(l3, h3), od, 0, 0, 0);
#undef PK
}
__device__ __forceinline__ void pv_d0(f32x16* o, int vb, bf16x8 pa0, bf16x8 pa1, bf16x8 pa2, bf16x8 pa3) {
  pv_one<0>(o[0], vb, pa0, pa1, pa2, pa3); pv_one<1>(o[1], vb, pa0, pa1, pa2, pa3); pv_one<2>(o[2], vb, pa0, pa1, pa2, pa3); pv_one<3>(o[3], vb, pa0, pa1, pa2, pa3);
}
__device__ __forceinline__ void attn_body(const int wv_, const bf16_t* __restrict__ Qb, const bf16_t* __restrict__ Kh, const bf16_t* __restrict__ Vh, bf16_t* __restrict__ Ob, int ldo, int seq, char* lds, const float* __restrict__ ropecs  ) {
  const int tid = tidx_w(wv_), wid = tid >> 6, lane = tid & 63, r32 = lane & 31, hi = lane >> 5;
  char* V_lds = lds; char* K_lds = lds + 2 * SHM_V;
  float* ws = (float*)(lds + 2 * SHM_V + 2 * SHM_K) + wid * 64; float* li_l = ws; float* al_l = ws + 32;
  float m_reg = -1e30f, l_reg = 0; f32x16 o[4] = {}; bf16x8 qr[12];
  const bf16_t* Qw = Qb + (long)(wid * 32 + r32) * DQK + hi * 8;
#pragma unroll
  for (int d0 = 0; d0 < 12; ++d0) qr[d0] = *reinterpret_cast<const bf16x8*>(Qw + d0 * 16);
  if (ropecs) {
    const float* cs = ropecs + (size_t)(wid * 32 + r32) * 64;
#pragma unroll
    for (int d0 = 8; d0 < 12; ++d0) { const int i0 = (d0 - 8) * 8 + hi * 4; const f32x4 c0 = *(const f32x4*)(cs + i0 * 2), c1 = *(const f32x4*)(cs + i0 * 2 + 4);
      u32x4 w = *reinterpret_cast<u32x4*>(&qr[d0]); const float cc[4] = {c0[0], c0[2], c1[0], c1[2]}, ss[4] = {c0[1], c0[3], c1[1], c1[3]};
#pragma unroll
      for (int m = 0; m < 4; ++m) { const float x1 = __uint_as_float(w[m] << 16), x2 = __uint_as_float(w[m] & 0xffff0000u); w[m] = cvtpk(x1 * cc[m] - x2 * ss[m], x1 * ss[m] + x2 * cc[m]); }
      qr[d0] = *reinterpret_cast<bf16x8*>(&w); }
  }
  const int sr = tid >> 4, sc = (tid & 15) * 8, vst0 = v_st(sr, sc), vst1 = v_st(32 + sr, sc);
  int kst[3];
#pragma unroll
  for (int i = 0; i < 3; ++i) { const int c = tid + 512 * i, row = c / 24, cc = c % 24; kst[i] = KSWZ(row, cc * 16); }
  const int vb0 = (int)(uintptr_t)V_lds + v_rd_base(lane);
  struct { bf16x8 vs0, vs1, ks0, ks1, ks2; } sr_[1];
#define SLOAD(i, k0) do { const bf16_t* vt = Vh + (long)(k0) * DV; const bf16_t* kt = Kh + (long)(k0) * DQK; \
    sr_[i].vs0 = *reinterpret_cast<const bf16x8*>(vt + (sr) * DV + sc); sr_[i].vs1 = *reinterpret_cast<const bf16x8*>(vt + (32 + sr) * DV + sc); \
    sr_[i].ks0 = *reinterpret_cast<const bf16x8*>(kt + tid * 8); sr_[i].ks1 = *reinterpret_cast<const bf16x8*>(kt + (tid + 512) * 8); sr_[i].ks2 = *reinterpret_cast<const bf16x8*>(kt + (tid + 1024) * 8); } while (0)
#define SWRITE(b, i) do { *(bf16x8*)(V_lds + (b) * SHM_V + vst0) = sr_[i].vs0; *(bf16x8*)(V_lds + (b) * SHM_V + vst1) = sr_[i].vs1; \
    *(bf16x8*)(K_lds + (b) * SHM_K + kst[0]) = sr_[i].ks0; *(bf16x8*)(K_lds + (b) * SHM_K + kst[1]) = sr_[i].ks1; *(bf16x8*)(K_lds + (b) * SHM_K + kst[2]) = sr_[i].ks2; } while (0)
#define SWAIT() asm volatile("s_waitcnt vmcnt(5)" ::: "memory")
#define RESC(a) do { if (__any((a) < 1.f)) { if (hi == 0) al_l[r32] = (a); asm volatile("s_waitcnt lgkmcnt(0)" ::: "memory"); \
    _Pragma("unroll") for (int d = 0; d < 4; ++d) _Pragma("unroll") for (int r = 0; r < 16; ++r) o[d][r] *= al_l[crow(r, hi)]; } } while (0)
  f32x16 pA0, pA1; float mnA, alA; bf16x8 pa0, pa1, pa2, pa3; const int NT = seq / KVBLK;
  SLOAD(0, 0); SWRITE(0, 0);
  SLOAD(0, KVBLK);
  __syncthreads();
  for (int j = 0; j < NT; j += 2) {
    SBAR(); qkt(pA0, pA1, K_lds, qr, r32, hi);
    partialSM(pA0, pA1, m_reg, mnA, alA); RESC(alA);
    finishSM(pA0, pA1, alA, l_reg, pa0, pa1, pa2, pa3); SBAR();
    SWRITE(1, 0);
    if (j + 2 < NT) SLOAD(0, (j + 2) * KVBLK);
    SBAR();
    pv_d0(o, vb0, pa0, pa1, pa2, pa3);
    __syncthreads();
    SBAR(); qkt(pA0, pA1, K_lds + SHM_K, qr, r32, hi);
    partialSM(pA0, pA1, m_reg, mnA, alA); RESC(alA);
    finishSM(pA0, pA1, alA, l_reg, pa0, pa1, pa2, pa3); SBAR();
    if (j + 2 < NT) { SWRITE(0, 0); if (j + 3 < NT) SLOAD(0, (j + 3) * KVBLK); }
    SBAR();
    pv_d0(o, vb0 + SHM_V, pa0, pa1, pa2, pa3);
    __syncthreads();
  }
  if (hi == 0) li_l[r32] = l_reg; asm volatile("s_waitcnt lgkmcnt(0)" ::: "memory");
  float rli[16];
#pragma unroll
  for (int r = 0; r < 16; ++r) rli[r] = __builtin_amdgcn_rcpf(li_l[crow(r, hi)]);
  bf16_t* Ow = Ob + (long)(wid * 32) * ldo;
#pragma unroll
  for (int r = 0; r < 16; ++r) { int orow = crow(r, hi);
#pragma unroll
    for (int d0 = 0; d0 < 4; ++d0) Ow[(long)orow * ldo + d0 * 32 + r32] = f2bf(o[d0][r] * rli[r]); }
  __syncthreads();
#undef SLOAD
#undef SWRITE
#undef SWAIT
#undef RESC
}
#undef KSWZ
}

__device__ void ph_attn(const Params& p, char* lds) {
    const bf16_t* Q = (const bf16_t*)(p.ws + OFF_Q); const bf16_t* K = (const bf16_t*)(p.ws + OFF_K); const bf16_t* V = (const bf16_t*)(p.ws + OFF_V);
    bf16_t* O = (bf16_t*)(p.ws + OFF_O);
    const int G = gdim();
    for (int i = 0;; ++i) {
        const int L = i * G + bidx(); if (L >= 544) break;
        int bh, qb;
        if (L < 512) { const int w = g8::xcd_remap(L, 512); bh = w >> 4; qb = 1 + (w & 15); } else { bh = L - 512; qb = 0; }
        const int b = bh >> 3, h = bh & 7;
        const int seq = qb == 0 ? TC : TK;
        const int row0 = qb == 0 ? NLAT + b * TC : b * TL + (qb - 1) * 256;
        fa::attn_body(p.wv, Q + ((size_t)bh * TK + qb * 256) * 192, K + (size_t)bh * TK * 192, V + (size_t)bh * TK * 128, O + (size_t)row0 * D + h * 128, D, seq, lds,
                      qb == 0 ? nullptr : (const float*)(p.ws + OFF_ROPE_C) + (size_t)(qb - 1) * 256 * 64);
    }
}

__device__ void ph_norm2_router(const Params& p, int layer, char* lds, int nrows) {
    const int tid = tidx(), wid = tid >> 6, lane = tid & 63;
    float* rt = (float*)lds;
    const float* rg = p.moe_router + (size_t)layer * D * NE;
    for (int i = tid; i < D * NE / 4; i += NTHR) { const int d = i >> 2, eq = i & 3; ((float4*)rt)[(((d >> 8) * 4 + (d & 3)) * 4 + eq) * 64 + ((d & 255) >> 2)] = ((const float4*)rg)[i]; }
    __syncthreads();
    const xt_t* X = (const xt_t*)(p.ws + OFF_X); bf16_t* BN = (bf16_t*)(p.ws + OFF_H); float* AFF = (float*)(p.ws + OFF_AFF);
    const float* g = p.norm2_g + layer * D;
    const int w_ = bidx() * 8 + wid, nw_ = gdim() * 8;
    int row = (int)((long long)w_ * nrows / nw_); const int rend = (int)((long long)(w_ + 1) * nrows / nw_);
    float4 nv[4], gm[4], bb[4]; int scur = -1;
    if (row < rend) {
#pragma unroll
        for (int i = 0; i < 4; ++i) nv[i] = xld(X, (size_t)row * D + (lane + i * 64) * 4); }
    for (; row < rend; ++row) {
        const int s = row_stream(row);
        if (s != scur) { scur = s; const float* sh = modp(p, layer, s, 3); const float* sc = modp(p, layer, s, 4);
#pragma unroll
            for (int i = 0; i < 4; ++i) { const int d = (lane + i * 64) * 4; const float4 gg = *(const float4*)(g + d), a = *(const float4*)(sc + d); bb[i] = *(const float4*)(sh + d);
                gm[i] = make_float4(gg.x * (1.f + a.x), gg.y * (1.f + a.y), gg.z * (1.f + a.z), gg.w * (1.f + a.w)); } }
        float4 v[4]; float ss = 0;
#pragma unroll
        for (int i = 0; i < 4; ++i) { v[i] = nv[i]; ss += v[i].x * v[i].x + v[i].y * v[i].y + v[i].z * v[i].z + v[i].w * v[i].w; }
        { const int nrow = row + 1;
          if (nrow < rend) {
#pragma unroll
              for (int i = 0; i < 4; ++i) nv[i] = xld(X, (size_t)nrow * D + (lane + i * 64) * 4); } }
        ss = wave_sum(ss); const float rs = rsqrtf(ss * (1.f / D) + RMS_EPS);
        float lg[16];
#pragma unroll
        for (int e = 0; e < 16; ++e) lg[e] = 0.f;
#pragma unroll
        for (int i = 0; i < 4; ++i) {
            const int d = (lane + i * 64) * 4;
            float o[4]; o[0] = v[i].x * rs * gm[i].x + bb[i].x; o[1] = v[i].y * rs * gm[i].y + bb[i].y; o[2] = v[i].z * rs * gm[i].z + bb[i].z; o[3] = v[i].w * rs * gm[i].w + bb[i].w;
            uint2 w; w.x = pk2(o[0], o[1]); w.y = pk2(o[2], o[3]); *(uint2*)(BN + (size_t)row * D + d) = w;
#pragma unroll
            for (int jj = 0; jj < 4; ++jj) {
#pragma unroll
                for (int eq = 0; eq < 4; ++eq) { const float4 r4 = ((const float4*)rt)[((i * 4 + jj) * 4 + eq) * 64 + lane];
                    lg[4 * eq] += o[jj] * r4.x; lg[4 * eq + 1] += o[jj] * r4.y; lg[4 * eq + 2] += o[jj] * r4.z; lg[4 * eq + 3] += o[jj] * r4.w; } }
            asm volatile("" ::: "memory");
        }
        float mx = -1e30f;
#pragma unroll
        for (int e = 0; e < 16; ++e) { lg[e] = wave_sum(lg[e]); mx = fmaxf(mx, lg[e]); }
        float sum = 0;
#pragma unroll
        for (int e = 0; e < 16; ++e) { lg[e] = expf(lg[e] - mx); sum += lg[e]; }
        const float inv = 1.f / sum;
        if (lane < 16) { float val = 0;
#pragma unroll
            for (int e = 0; e < 16; ++e) val = (lane == e) ? lg[e] : val;
            AFF[(size_t)row * 16 + lane] = val * inv; }
    }
}

__device__ void ph_norm2_router_mm(const Params& p, int layer, char* lds, int nrows) {
    typedef __attribute__((address_space(3))) char lch;
    constexpr int PB = 2064;
    constexpr int O_RH = 0, O_RL = 16 * PB, O_A = 32 * PB, A_BUF = 16 * PB, O_P = O_A + 2 * A_BUF, P_BUF = 8 * 8 * 16 * 4;
    const int tid = tidx(), wid = __builtin_amdgcn_readfirstlane(tid >> 6), lane = tid & 63;
    lch* L = (lch*)lds;
    const float* rg = p.moe_router + (size_t)layer * D * NE;
    for (int i = tid; i < D * NE / 4; i += NTHR) { const int d = i >> 2, eq = i & 3; const float4 r4 = ((const float4*)rg)[i]; const float rr[4] = {r4.x, r4.y, r4.z, r4.w};
#pragma unroll
        for (int u = 0; u < 4; ++u) { const unsigned h = pk2(rr[u], rr[u]) & 0xffffu; const float lo = rr[u] - __uint_as_float(h << 16);
            *(LAS bf16_t*)(L + O_RH + (4 * eq + u) * PB + d * 2) = (bf16_t)h; *(LAS bf16_t*)(L + O_RL + (4 * eq + u) * PB + d * 2) = f2bf(lo); } }
    const xt_t* X = (const xt_t*)(p.ws + OFF_X); bf16_t* BN = (bf16_t*)(p.ws + OFF_H); float* AFF = (float*)(p.ws + OFF_AFF);
    const float* g = p.norm2_g + layer * D;
    const int nch = nrows / 8;
    int ch = (int)((long long)bidx() * nch / gdim()); const int chend = (int)((long long)(bidx() + 1) * nch / gdim());
    float4 nv[4], gm[4], bb[4]; int scur = -1;
    if (ch < chend) {
#pragma unroll
        for (int i = 0; i < 4; ++i) nv[i] = xld(X, (size_t)(ch * 8 + wid) * D + (lane + i * 64) * 4); }
    for (int it = 0; ch < chend; ++ch, ++it) {
        const int row = ch * 8 + wid, buf = it & 1;
        const int s = row_stream(row);
        if (s != scur) { scur = s; const float* sh = modp(p, layer, s, 3); const float* sc = modp(p, layer, s, 4);
#pragma unroll
            for (int i = 0; i < 4; ++i) { const int d = (lane + i * 64) * 4; const float4 gg = *(const float4*)(g + d), a = *(const float4*)(sc + d); bb[i] = *(const float4*)(sh + d);
                gm[i] = make_float4(gg.x * (1.f + a.x), gg.y * (1.f + a.y), gg.z * (1.f + a.z), gg.w * (1.f + a.w)); } }
        float4 v[4]; float ss = 0;
#pragma unroll
        for (int i = 0; i < 4; ++i) { v[i] = nv[i]; ss += v[i].x * v[i].x + v[i].y * v[i].y + v[i].z * v[i].z + v[i].w * v[i].w; }
        if (ch + 1 < chend) {
#pragma unroll
            for (int i = 0; i < 4; ++i) nv[i] = xld(X, (size_t)(row + 8) * D + (lane + i * 64) * 4); }
        ss = wave_sum(ss); const float rs = rsqrtf(ss * (1.f / D) + RMS_EPS);
        lch* AH = L + O_A + buf * A_BUF + wid * PB; lch* AL = AH + 8 * PB;
#pragma unroll
        for (int i = 0; i < 4; ++i) {
            const int d = (lane + i * 64) * 4;
            float o[4]; o[0] = v[i].x * rs * gm[i].x + bb[i].x; o[1] = v[i].y * rs * gm[i].y + bb[i].y; o[2] = v[i].z * rs * gm[i].z + bb[i].z; o[3] = v[i].w * rs * gm[i].w + bb[i].w;
            u32x2 wh; wh.x = pk2(o[0], o[1]); wh.y = pk2(o[2], o[3]);
            uint2 wg_; wg_.x = wh.x; wg_.y = wh.y; *(uint2*)(BN + (size_t)row * D + d) = wg_;
            u32x2 wl; wl.x = pk2(o[0] - __uint_as_float(wh.x << 16), o[1] - __uint_as_float(wh.x & 0xffff0000u)); wl.y = pk2(o[2] - __uint_as_float(wh.y << 16), o[3] - __uint_as_float(wh.y & 0xffff0000u));
            *(LAS u32x2*)(AH + d * 2) = wh; *(LAS u32x2*)(AL + d * 2) = wl;
        }
        __syncthreads();
        {
            f32x4 acc = {0.f, 0.f, 0.f, 0.f};
            const lch* ah = L + O_A + buf * A_BUF + (lane & 7) * PB + (128 * wid + 8 * (lane >> 4)) * 2;
            const lch* bh = L + O_RH + (lane & 15) * PB + (128 * wid + 8 * (lane >> 4)) * 2;
#pragma unroll
            for (int ks = 0; ks < 4; ++ks) {
                const bf16x8 a_h = *(const LAS bf16x8*)(ah + ks * 64), a_l = *(const LAS bf16x8*)(ah + 8 * PB + ks * 64);
                const bf16x8 b_h = *(const LAS bf16x8*)(bh + ks * 64), b_l = *(const LAS bf16x8*)(bh + 16 * PB + ks * 64);
                acc = __builtin_amdgcn_mfma_f32_16x16x32_bf16(a_h, b_h, acc, 0, 0, 0);
                acc = __builtin_amdgcn_mfma_f32_16x16x32_bf16(a_h, b_l, acc, 0, 0, 0);
                acc = __builtin_amdgcn_mfma_f32_16x16x32_bf16(a_l, b_h, acc, 0, 0, 0);
            }
            if (lane < 32) {
#pragma unroll
                for (int e = 0; e < 4; ++e) *(LAS float*)(L + O_P + buf * P_BUF + ((wid * 8 + 4 * (lane >> 4) + e) * 16 + (lane & 15)) * 4) = acc[e]; }
        }
        __syncthreads();
        if (tid < 128) {
            float lg = 0.f;
#pragma unroll
            for (int w8 = 0; w8 < 8; ++w8) lg += *(const LAS float*)(L + O_P + buf * P_BUF + (w8 * 128 + tid) * 4);
            float mx = lg;
            mx = fmaxf(mx, __builtin_bit_cast(float, __builtin_amdgcn_update_dpp(0, __builtin_bit_cast(int, mx), 0xB1, 0xF, 0xF, true)));
            mx = fmaxf(mx, __builtin_bit_cast(float, __builtin_amdgcn_update_dpp(0, __builtin_bit_cast(int, mx), 0x4E, 0xF, 0xF, true)));
            mx = fmaxf(mx, __builtin_bit_cast(float, __builtin_amdgcn_update_dpp(0, __builtin_bit_cast(int, mx), 0x141, 0xF, 0xF, true)));
            mx = fmaxf(mx, __builtin_bit_cast(float, __builtin_amdgcn_update_dpp(0, __builtin_bit_cast(int, mx), 0x140, 0xF, 0xF, true)));
            const float ex = expf(lg - mx); const float sum = dpp_sum16(ex);
            AFF[(size_t)(ch * 8) * 16 + tid] = ex / sum;
        }
    }
}

__device__ void ph_select(const Params& p, char* lds, int ngroups) {
    const int tid = tidx(), wid = tid >> 6, lane = tid & 63;
    unsigned* hist = (unsigned*)lds;
    unsigned* ctl = hist + 256;
    unsigned* wsum = ctl + 8;
    int* rowl = (int*)(wsum + 16);
    const float* AFF = (const float*)(p.ws + OFF_AFF);
    int* ROWIDX = (int*)(p.ws + OFF_ROWIDX); float* GATE = (float*)(p.ws + OFF_GATE); int* SLOT = (int*)(p.ws + OFF_SLOT);
    for (int gidx = bidx(); gidx < ngroups; gidx += gdim()) {
        const bool lat = gidx < 64; const int b = (gidx & 63) >> 4, e = gidx & 15;
        const int n = lat ? TL : TC, cap = lat ? CAPL : CAPC;
        const int row0 = lat ? b * TL : NLAT + b * TC, slot0 = lat ? b * CAPL : NB * CAPL + b * CAPC;
        unsigned key[8];
#pragma unroll
        for (int i = 0; i < 8; ++i) { const int idx = tid * 8 + i; key[i] = idx < n ? __float_as_uint(AFF[(size_t)(row0 + idx) * 16 + e]) : 0u; }
        unsigned prefix = 0u, remaining = (unsigned)cap;
#pragma unroll
        for (int pass = 0; pass < 4; ++pass) {
            const int sh = 24 - 8 * pass;
            __syncthreads();
            if (tid < 256) hist[tid] = 0u;
            __syncthreads();
#pragma unroll
            for (int i = 0; i < 8; ++i) { const int idx = tid * 8 + i;
                const bool cand = idx < n && (pass == 0 || (key[i] >> (sh + 8)) == prefix);
                if (cand) atomicAdd(&hist[(key[i] >> sh) & 255u], 1u); }
            __syncthreads();
            if (tid < 256) { unsigned gt = 0; for (int jj = tid + 1; jj < 256; ++jj) gt += hist[jj];
                const unsigned mine = hist[tid];
                if (gt < remaining && remaining <= gt + mine) { ctl[0] = (unsigned)tid; ctl[1] = remaining - gt; } }
            __syncthreads();
            prefix = (prefix << 8) | ctl[0]; remaining = ctl[1];
        }
        const unsigned T = prefix, m = remaining;
        unsigned cgt = 0, ceq = 0;
#pragma unroll
        for (int i = 0; i < 8; ++i) { const int idx = tid * 8 + i; if (idx < n) { cgt += key[i] > T ? 1u : 0u; ceq += key[i] == T ? 1u : 0u; } }
        auto block_excl = [&](unsigned v) -> unsigned {
            unsigned inc = v;
#pragma unroll
            for (int o = 1; o < 64; o <<= 1) { const unsigned t = (unsigned)__builtin_amdgcn_ds_bpermute((lane - o) << 2, (int)inc); if (lane >= o) inc += t; }
            __syncthreads();
            if (lane == 63) wsum[wid] = inc;
            __syncthreads();
            unsigned base = 0;
#pragma unroll
            for (int w = 0; w < 8; ++w) base += (w < wid) ? wsum[w] : 0u;
            return base + inc - v; };
        unsigned eqbase = block_excl(ceq);
        unsigned nsel = 0; bool sel[8];
#pragma unroll
        for (int i = 0; i < 8; ++i) { const int idx = tid * 8 + i; bool s_ = false;
            if (idx < n) { if (key[i] > T) s_ = true; else if (key[i] == T) { s_ = eqbase < m; ++eqbase; } }
            sel[i] = s_; nsel += s_ ? 1u : 0u; }
        unsigned sbase = block_excl(nsel);
#pragma unroll
        for (int i = 0; i < 8; ++i) { const int idx = tid * 8 + i;
            if (idx < n) {
                if (sel[i]) { const int sl = slot0 + (int)sbase; rowl[sbase] = row0 + idx; ++sbase; ROWIDX[e * ESLOTS + sl] = row0 + idx; GATE[e * EPAD + sl] = __uint_as_float(key[i]); SLOT[(size_t)(row0 + idx) * 16 + e] = sl; }
                else SLOT[(size_t)(row0 + idx) * 16 + e] = -1; } }
        __syncthreads();
        { const bf16_t* BN = (const bf16_t*)(p.ws + OFF_H); bf16_t* XE = (bf16_t*)(p.ws + OFF_XE);
          for (int r = wid; r < cap; r += 32) {
              u32x4 t_[4][2];
#pragma unroll
              for (int u = 0; u < 4; ++u) { const u32x4* src = (const u32x4*)(BN + (size_t)rowl[r + 8 * u] * D); t_[u][0] = src[lane]; t_[u][1] = src[lane + 64]; }
#pragma unroll
              for (int u = 0; u < 4; ++u) { u32x4* dst = (u32x4*)(XE + ((size_t)e * EPAD + slot0 + r + 8 * u) * D); dst[lane] = t_[u][0]; dst[lane + 64] = t_[u][1]; } } }
    }
}

__device__ void ph_gather(const Params& p, int nslots) {
    const int wid = tidx() >> 6, lane = tidx() & 63;
    const int* ROWIDX = (const int*)(p.ws + OFF_ROWIDX); const bf16_t* BN = (const bf16_t*)(p.ws + OFF_H); bf16_t* XE = (bf16_t*)(p.ws + OFF_XE);
    for (int it = bidx() * 8 + wid; it < NE * ESLOTS; it += gdim() * 8) {
        const int e = it / ESLOTS, sl = it % ESLOTS; if (sl >= nslots) continue; const int row = ROWIDX[it];
        const u32x4* src = (const u32x4*)(BN + (size_t)row * D); u32x4* dst = (u32x4*)(XE + ((size_t)e * EPAD + sl) * D);
        dst[lane] = src[lane]; dst[lane + 64] = src[lane + 64];
    }
}

__device__ void ph_combine(const Params& p, int layer, int nrows) {
    const int wid = tidx() >> 6, lane = tidx() & 63;
    const int* SLOT = (const int*)(p.ws + OFF_SLOT); const bf16_t* YE = (const bf16_t*)(p.ws + OFF_YE); xt_t* X = (xt_t*)(p.ws + OFF_X);
    int row = bidx() * 8 + wid;
    int sl = (row < nrows && lane < 16) ? SLOT[(size_t)row * 16 + lane] : -1;
    while (row < nrows) {
        const int nrow = row + gdim() * 8;
        const int sln = (nrow < nrows && lane < 16) ? SLOT[(size_t)nrow * 16 + lane] : -1;
        const float* gt = modp(p, layer, row_stream(row), 5);
        xt_t* xr = X + (size_t)row * D + lane * 8;
        f32x4 xv[4];
#pragma unroll
        for (int i = 0; i < 2; ++i) { xv[2 * i] = xldv(xr, 512 * i); xv[2 * i + 1] = xldv(xr, 512 * i + 4); }
        unsigned long long m = __ballot(sl >= 0);
        float acc[16];
#pragma unroll
        for (int i = 0; i < 16; ++i) acc[i] = 0.f;
        while (m) {
            const int e0 = __builtin_ctzll(m); m &= m - 1; const bool two = m != 0; const int e1 = two ? __builtin_ctzll(m) : e0; if (two) m &= m - 1;
            const int s0 = __builtin_amdgcn_readlane(sl, e0), s1 = __builtin_amdgcn_readlane(sl, e1);
            const bf16_t* y0 = YE + ((size_t)e0 * EPAD + s0) * D + lane * 8; const bf16_t* y1 = YE + ((size_t)e1 * EPAD + s1) * D + lane * 8;
            const u32x4 a0 = *(const u32x4*)y0, a1 = *(const u32x4*)(y0 + 512), b0 = *(const u32x4*)y1, b1 = *(const u32x4*)(y1 + 512);
            const float f1 = two ? 1.f : 0.f;
#pragma unroll
            for (int i = 0; i < 4; ++i) { acc[2 * i] += __uint_as_float(a0[i] << 16) + f1 * __uint_as_float(b0[i] << 16); acc[2 * i + 1] += __uint_as_float(a0[i] & 0xffff0000u) + f1 * __uint_as_float(b0[i] & 0xffff0000u);
                acc[8 + 2 * i] += __uint_as_float(a1[i] << 16) + f1 * __uint_as_float(b1[i] << 16); acc[8 + 2 * i + 1] += __uint_as_float(a1[i] & 0xffff0000u) + f1 * __uint_as_float(b1[i] & 0xffff0000u); }
        }
#pragma unroll
        for (int i = 0; i < 2; ++i) { const f32x4 g0 = *(const f32x4*)(gt + lane * 8 + 512 * i), g1 = *(const f32x4*)(gt + lane * 8 + 512 * i + 4);
            f32x4 o0 = xv[2 * i], o1 = xv[2 * i + 1];
#pragma unroll
            for (int e = 0; e < 4; ++e) { o0[e] += g0[e] * acc[8 * i + e]; o1[e] += g1[e] * acc[8 * i + 4 + e]; }
            xstv(xr, 512 * i, o0); xstv(xr, 512 * i + 4, o1); }
        row = nrow; sl = sln;
    }
}

template <bool FINAL>
__device__ void ph_comb_norm(const Params& p, int lprev, int layer, int nrows) {
    const int wid = tidx() >> 6, lane = tidx() & 63;
    const int* SLOT = (const int*)(p.ws + OFF_SLOT); const bf16_t* YE = (const bf16_t*)(p.ws + OFF_YE); xt_t* X = (xt_t*)(p.ws + OFF_X);
    bf16_t* H = (bf16_t*)(p.ws + OFF_H);
    const float* g = FINAL ? p.final_g : p.norm1_g + layer * D;
    int row = bidx() * 8 + wid;
    int sl = (row < nrows && lane < 16) ? SLOT[(size_t)row * 16 + lane] : -1;
    while (row < nrows) {
        const int nrow = row + gdim() * 8;
        const int sln = (nrow < nrows && lane < 16) ? SLOT[(size_t)nrow * 16 + lane] : -1;
        const int strm = row_stream(row);
        const float* gt = modp(p, lprev, strm, 5);
        xt_t* xr = X + (size_t)row * D + lane * 8;
        f32x4 xv[4];
#pragma unroll
        for (int i = 0; i < 2; ++i) { xv[2 * i] = xldv(xr, 512 * i); xv[2 * i + 1] = xldv(xr, 512 * i + 4); }
        unsigned long long m = __ballot(sl >= 0);
        float acc[16];
#pragma unroll
        for (int i = 0; i < 16; ++i) acc[i] = 0.f;
        while (m) {
            const int e0 = __builtin_ctzll(m); m &= m - 1; const bool two = m != 0; const int e1 = two ? __builtin_ctzll(m) : e0; if (two) m &= m - 1;
            const int s0 = __builtin_amdgcn_readlane(sl, e0), s1 = __builtin_amdgcn_readlane(sl, e1);
            const bf16_t* y0 = YE + ((size_t)e0 * EPAD + s0) * D + lane * 8; const bf16_t* y1 = YE + ((size_t)e1 * EPAD + s1) * D + lane * 8;
            const u32x4 a0 = *(const u32x4*)y0, a1 = *(const u32x4*)(y0 + 512), b0 = *(const u32x4*)y1, b1 = *(const u32x4*)(y1 + 512);
            const float f1 = two ? 1.f : 0.f;
#pragma unroll
            for (int i = 0; i < 4; ++i) { acc[2 * i] += __uint_as_float(a0[i] << 16) + f1 * __uint_as_float(b0[i] << 16); acc[2 * i + 1] += __uint_as_float(a0[i] & 0xffff0000u) + f1 * __uint_as_float(b0[i] & 0xffff0000u);
                acc[8 + 2 * i] += __uint_as_float(a1[i] << 16) + f1 * __uint_as_float(b1[i] << 16); acc[8 + 2 * i + 1] += __uint_as_float(a1[i] & 0xffff0000u) + f1 * __uint_as_float(b1[i] & 0xffff0000u); }
        }
        float ss = 0.f;
#pragma unroll
        for (int i = 0; i < 2; ++i) { const f32x4 g0 = *(const f32x4*)(gt + lane * 8 + 512 * i), g1 = *(const f32x4*)(gt + lane * 8 + 512 * i + 4);
#pragma unroll
            for (int e = 0; e < 4; ++e) { xv[2 * i][e] += g0[e] * acc[8 * i + e]; xv[2 * i + 1][e] += g1[e] * acc[8 * i + 4 + e]; ss += xv[2 * i][e] * xv[2 * i][e] + xv[2 * i + 1][e] * xv[2 * i + 1][e]; }
            if (!FINAL) { xstv(xr, 512 * i, xv[2 * i]); xstv(xr, 512 * i + 4, xv[2 * i + 1]); } }
        ss = wave_sum(ss); const float rs = rsqrtf(ss * (1.f / D) + RMS_EPS);
        const float* sh = FINAL ? nullptr : modp(p, layer, strm, 0); const float* sc = FINAL ? nullptr : modp(p, layer, strm, 1);
#pragma unroll
        for (int i = 0; i < 2; ++i)
#pragma unroll
            for (int hh = 0; hh < 2; ++hh) { const int d = lane * 8 + 512 * i + 4 * hh; const f32x4 gg = *(const f32x4*)(g + d); f32x4 o = xv[2 * i + hh] * rs * gg;
                if (FINAL) *(f32x4*)(p.out + (size_t)row * D + d) = o;
                else { o = o * (1.f + *(const f32x4*)(sc + d)) + *(const f32x4*)(sh + d); stbf4(H + (size_t)row * D + d, o); } }
        row = nrow; sl = sln;
    }
}

__device__ void ph_rw_normxs(const Params& p, int layer, int j) {
    const int wid = tidx() >> 6, lane = tidx() & 63;
    const xt_t* X = (const xt_t*)(p.ws + OFF_X); bf16_t* XS = (bf16_t*)(p.ws + OFF_XS);
    const float* mu = p.rw_mu + (size_t)j * 6 * D; const float* g = p.norm1_g + layer * D;
    const int w = bidx() * 8 + wid, nw = gdim() * 8;
    const int r0 = (int)((long long)w * NROW / nw), r1 = (int)((long long)(w + 1) * NROW / nw);
    if (r0 >= r1) return;
    float4 um[6][4];
#pragma unroll
    for (int m = 0; m < 6; ++m)
#pragma unroll
        for (int i = 0; i < 4; ++i) um[m][i] = *(const float4*)(mu + m * D + (lane + i * 64) * 4);
    float4 gm[4], bb[4]; int scur = -1;
    float4 hp[4], hc[4], hn[4], raw[4];
#define XS_NORM(dst, src, R) do { const int s_ = row_stream(R); \
        if (s_ != scur) { scur = s_; const float* sh_ = modp(p, layer, s_, 0); const float* sc_ = modp(p, layer, s_, 1); \
            _Pragma("unroll") for (int i = 0; i < 4; ++i) { const int d_ = (lane + i * 64) * 4; const float4 gg_ = *(const float4*)(g + d_), a_ = *(const float4*)(sc_ + d_); bb[i] = *(const float4*)(sh_ + d_); \
                gm[i] = make_float4(gg_.x * (1.f + a_.x), gg_.y * (1.f + a_.y), gg_.z * (1.f + a_.z), gg_.w * (1.f + a_.w)); } } \
        float ss_ = 0.f; \
        _Pragma("unroll") for (int i = 0; i < 4; ++i) ss_ += src[i].x * src[i].x + src[i].y * src[i].y + src[i].z * src[i].z + src[i].w * src[i].w; \
        ss_ = wave_sum(ss_); const float rs_ = rsqrtf(ss_ * (1.f / D) + RMS_EPS); \
        _Pragma("unroll") for (int i = 0; i < 4; ++i) dst[i] = make_float4(src[i].x * rs_ * gm[i].x + bb[i].x, src[i].y * rs_ * gm[i].y + bb[i].y, src[i].z * rs_ * gm[i].z + bb[i].z, src[i].w * rs_ * gm[i].w + bb[i].w); } while (0)
#define XS_RAW(R) do { _Pragma("unroll") for (int i = 0; i < 4; ++i) raw[i] = xld(X, (size_t)(R) * D + (lane + i * 64) * 4); } while (0)
    if (r0 > 0) { XS_RAW(r0 - 1); XS_NORM(hp, raw, r0 - 1); }
    else {
#pragma unroll
        for (int i = 0; i < 4; ++i) hp[i] = make_float4(0.f, 0.f, 0.f, 0.f); }
    XS_RAW(r0); XS_NORM(hc, raw, r0);
    if (r0 + 1 < NROW) XS_RAW(r0 + 1);
    for (int row = r0; row < r1; ++row) {
        const bool lat = row < NLAT; const int t = lat ? (row & (TL - 1)) : ((row - NLAT) & (TC - 1)); const int len = lat ? TL : TC;
        const float fp_ = t > 0 ? 0.5f : 0.f, fn_ = t < len - 1 ? 0.5f : 0.f;
        if (row + 1 < NROW) XS_NORM(hn, raw, row + 1);
        else {
#pragma unroll
            for (int i = 0; i < 4; ++i) hn[i] = make_float4(0.f, 0.f, 0.f, 0.f); }
        if (row + 1 < r1 && row + 2 < NROW) XS_RAW(row + 2);
#pragma unroll
        for (int i = 0; i < 4; ++i) {
            const int d = (lane + i * 64) * 4;
            const float4 h = hc[i];
            const float4 xx = make_float4(fp_ * hp[i].x + fn_ * hn[i].x - h.x, fp_ * hp[i].y + fn_ * hn[i].y - h.y, fp_ * hp[i].z + fn_ * hn[i].z - h.z, fp_ * hp[i].w + fn_ * hn[i].w - h.w);
#pragma unroll
            for (int m = 0; m < 6; ++m) { const float4 u = um[m][i];
                uint2 wv_; wv_.x = pk2(h.x + xx.x * u.x, h.y + xx.y * u.y); wv_.y = pk2(h.z + xx.z * u.z, h.w + xx.w * u.w);
                *(uint2*)(XS + ((size_t)m * NROW + row) * D + d) = wv_; }
        }
#pragma unroll
        for (int i = 0; i < 4; ++i) { hp[i] = hc[i]; hc[i] = hn[i]; }
    }
#undef XS_NORM
#undef XS_RAW
}

__device__ __forceinline__ int scan_row(int i, int b, int z) {
    return i < TC ? NLAT + b * TC + (z ? TC - 1 - i : i) : b * TL + (z ? TL - 1 - (i - TC) : i - TC);
}
__device__ __forceinline__ float dpp_sum8(float x) {
    x += __builtin_bit_cast(float, __builtin_amdgcn_update_dpp(0, __builtin_bit_cast(int, x), 0xB1, 0xF, 0xF, true));
    x += __builtin_bit_cast(float, __builtin_amdgcn_update_dpp(0, __builtin_bit_cast(int, x), 0x4E, 0xF, 0xF, true));
    x += __builtin_bit_cast(float, __builtin_amdgcn_update_dpp(0, __builtin_bit_cast(int, x), 0x141, 0xF, 0xF, true));
    return x;
}
__device__ void ph_rw_scan(const Params& p, int j, char* lds) {
    const int tid = tidx(), wid = __builtin_amdgcn_readfirstlane(tid >> 6), lane = tid & 63;
    const size_t PL = (size_t)NROW * D;
    const float* RKV = (const float*)(p.ws + OFF_RKV); float* Y = (float*)(p.ws + OFF_Y);
    constexpr int CH = 32, BUFB = 5 * CH * 256 + CH * 128 + CH * 16, YB = CH * 32 * 4, NCH = (TC + TL) / CH;
    const bool loader = wid >= 4; const int lw = wid - 4;
    for (int it = bidx(); it < 256; it += gdim()) {
        const int vh = it & 1, z = (it >> 1) & 1, h = (it >> 2) & 15, b = it >> 6;
        const char* pl0 = (const char*)((const float*)(p.ws + OFF_W) + z * PL); const char* pl1 = (const char*)(RKV + PL);
        const char* pl2 = (const char*)((const float*)(p.ws + OFF_AV) + z * PL); const char* pl3 = (const char*)RKV;
        const char* vpl = (const char*)(RKV + 2 * PL);
        float* yout = Y + z * PL;
        __builtin_amdgcn_s_barrier();
        if (loader) {
            const int pq = lane & 15;
            const f32x4 kkv = *(const f32x4*)(p.rw_k_k + j * D + h * 64 + pq * 4), kav = *(const f32x4*)(p.rw_k_a + j * D + h * 64 + pq * 4);
            auto issue = [&](int c) {
                char* buf = lds + (c % 3) * BUFB;
#pragma unroll
                for (int q = 0; q < 8; ++q) { const int pi = q >> 1, tg = lw * 2 + (q & 1); const int row = scan_row(c * CH + tg * 4 + (lane >> 4), b, z);
                    const char* base = pi == 0 ? pl0 : pi == 1 ? pl1 : pi == 2 ? pl2 : pl3;
                    __builtin_amdgcn_global_load_lds((const unsigned*)(base + (size_t)row * D * 4 + h * 256 + (lane & 15) * 16), (LAS unsigned*)(buf + pi * (CH * 256) + tg * 1024), 16, 0, 0); }
                { const int row = scan_row(c * CH + lw * 8 + (lane >> 3), b, z);
                  __builtin_amdgcn_global_load_lds((const unsigned*)(vpl + (size_t)row * D * 4 + (h * 64 + vh * 32) * 4 + (lane & 7) * 16), (LAS unsigned*)(buf + 5 * CH * 256 + lw * 1024), 16, 0, 0); }
            };
            auto prep = [&](int c) {
                char* buf = lds + (c % 3) * BUFB;
#pragma unroll
                for (int ps = 0; ps < 2; ++ps) { const int ptok = lw * 8 + ps * 4 + (lane >> 4);
                    f32x4* kp = (f32x4*)(buf + 1 * CH * 256 + ptok * 256 + pq * 16); f32x4* ap = (f32x4*)(buf + 2 * CH * 256 + ptok * 256 + pq * 16); f32x4* dp = (f32x4*)(buf + 4 * CH * 256 + ptok * 256 + pq * 16);
                    f32x4* rp = (f32x4*)(buf + 3 * CH * 256 + ptok * 256 + pq * 16); const f32x4 wv = *(const f32x4*)(buf + ptok * 256 + pq * 16);
                    const f32x4 k = *kp, a = *ap, r = *rp; f32x4 kk = k * kkv;
                    float ss = kk[0] * kk[0] + kk[1] * kk[1] + kk[2] * kk[2] + kk[3] * kk[3]; ss = dpp_sum16(ss);
                    const float inv = 1.f / fmaxf(sqrtf(ss), 1e-12f); kk = kk * inv;
                    const f32x4 kd = k * (1.f + (a - 1.f) * kav), bb = kk * a;
                    const f32x4 t1 = bb * r, t2 = kd * r;
                    const float br = dpp_sum16((t1[0] + t1[1]) + (t1[2] + t1[3])), kr = dpp_sum16((t2[0] + t2[1]) + (t2[2] + t2[3]));
                    *dp = kd; *ap = bb; *kp = kk; *rp = wv * r;
                    if (pq == 0) *(float2*)(buf + 5 * CH * 256 + CH * 128 + ptok * 16) = make_float2(br, kr); }
            };
            issue(0); issue(1);
            asm volatile("s_waitcnt vmcnt(9)" ::: "memory");
            prep(0);
            asm volatile("s_waitcnt lgkmcnt(0)" ::: "memory"); __builtin_amdgcn_s_barrier();
            for (int c = 0; c < NCH; ++c) {
                if (c >= 1) { const float* yb = (const float*)(lds + 3 * BUFB + ((c - 1) & 1) * YB);
                    const int lt = tid - 256, t = lt >> 3, q = lt & 7; const int row = scan_row((c - 1) * CH + t, b, z);
                    *(f32x4*)(yout + (size_t)row * D + h * 64 + vh * 32 + q * 4) = *(const f32x4*)(yb + t * 32 + q * 4); }
                if (c + 2 < NCH) { issue(c + 2); asm volatile("s_waitcnt vmcnt(9)" ::: "memory"); } else asm volatile("s_waitcnt vmcnt(0)" ::: "memory");
                if (c + 1 < NCH) prep(c + 1);
                asm volatile("s_waitcnt lgkmcnt(0)" ::: "memory"); __builtin_amdgcn_s_barrier();
            }
            { const float* yb = (const float*)(lds + 3 * BUFB + ((NCH - 1) & 1) * YB);
              const int lt = tid - 256, t = lt >> 3, q = lt & 7; const int row = scan_row((NCH - 1) * CH + t, b, z);
              *(f32x4*)(yout + (size_t)row * D + h * 64 + vh * 32 + q * 4) = *(const f32x4*)(yb + t * 32 + q * 4); }
        } else {
            const int vr = lane >> 3, ks = lane & 7;
            f32x4 Sa = {0.f, 0.f, 0.f, 0.f}, Sb = {0.f, 0.f, 0.f, 0.f};
            __builtin_amdgcn_s_barrier();
            struct Ops { f32x4 w0, w1, kk0, kk1, bb0, bb1, r0, r1, kd0, kd1; float v; float2 sc; };
#define SC_LOAD(O, t) do { const char* q_ = bq + (t) * 256; O.w0 = *(const f32x4*)(q_); O.w1 = *(const f32x4*)(q_ + 16); O.kk0 = *(const f32x4*)(q_ + CH * 256); O.kk1 = *(const f32x4*)(q_ + CH * 256 + 16); \
                O.bb0 = *(const f32x4*)(q_ + 2 * CH * 256); O.bb1 = *(const f32x4*)(q_ + 2 * CH * 256 + 16); O.r0 = *(const f32x4*)(q_ + 3 * CH * 256); O.r1 = *(const f32x4*)(q_ + 3 * CH * 256 + 16); \
                O.kd0 = *(const f32x4*)(q_ + 4 * CH * 256); O.kd1 = *(const f32x4*)(q_ + 4 * CH * 256 + 16); O.v = *(const float*)(vq + (t) * 128); O.sc = *(const float2*)(buf + 5 * CH * 256 + CH * 128 + (t) * 16); } while (0)
#define SC_STEP(O, t) do { const f32x4 d1 = Sa * O.kk0 + Sb * O.kk1, d2 = Sa * O.r0 + Sb * O.r1; \
                float sa = -((d1[0] + d1[1]) + (d1[2] + d1[3])), yy = (d2[0] + d2[1]) + (d2[2] + d2[3]); \
                sa = dpp_sum8(sa); yy = dpp_sum8(yy); \
                Sa = Sa * O.w0 + (sa * O.bb0 + O.v * O.kd0); Sb = Sb * O.w1 + (sa * O.bb1 + O.v * O.kd1); \
                if (ks == 0) yb[(t) * 32 + wid * 8 + vr] = yy + sa * O.sc.x + O.v * O.sc.y; } while (0)
            for (int c = 0; c < NCH; ++c) {
                const char* buf = lds + (c % 3) * BUFB; float* yb = (float*)(lds + 3 * BUFB + (c & 1) * YB);
                const char* bq = buf + ks * 32; const char* vq = buf + 5 * CH * 256 + (wid * 8 + vr) * 4;
                Ops oA, oB, oC;
                SC_LOAD(oA, 0); SC_LOAD(oB, 1);
#pragma unroll
                for (int t = 0; t < CH; t += 3) {
                    if (t + 2 < CH) SC_LOAD(oC, t + 2);
                    SC_STEP(oA, t);
                    if (t + 3 < CH) SC_LOAD(oA, t + 3);
                    if (t + 1 < CH) SC_STEP(oB, t + 1);
                    if (t + 4 < CH) SC_LOAD(oB, t + 4);
                    if (t + 2 < CH) SC_STEP(oC, t + 2);
                }
                asm volatile("s_waitcnt lgkmcnt(0)" ::: "memory"); __builtin_amdgcn_s_barrier();
            }
#undef SC_LOAD
#undef SC_STEP
        }
    }
}


namespace ck {
constexpr int P = 72, MB = 64 * P * 2;
typedef __attribute__((address_space(3))) char lchar;
__device__ __forceinline__ f32x4 mm_tile(const lchar* Aop, const lchar* Bop, int ti, int tj, int c, int q, f32x4 acc) {
#pragma unroll
    for (int ks = 0; ks < 2; ++ks) {
        const bf16x8 a = *(const LAS bf16x8*)(Aop + ((16 * ti + c) * P + 32 * ks + 8 * q) * 2);
        const bf16x8 b = *(const LAS bf16x8*)(Bop + ((16 * tj + c) * P + 32 * ks + 8 * q) * 2);
        acc = __builtin_amdgcn_mfma_f32_16x16x32_bf16(a, b, acc, 0, 0, 0);
    }
    return acc;
}
__device__ __forceinline__ f32x4 mm_diag(const lchar* Aop, const lchar* Bop, int tt, int c, int q, f32x4 acc) {
    const int ks = tt >> 1;
    bf16x8 a = *(const LAS bf16x8*)(Aop + ((16 * tt + c) * P + 32 * ks + 8 * q) * 2);
    const bf16x8 b = *(const LAS bf16x8*)(Bop + ((16 * tt + c) * P + 32 * ks + 8 * q) * 2);
    if ((q >> 1) != (tt & 1)) a = (bf16x8){0, 0, 0, 0, 0, 0, 0, 0};
    return __builtin_amdgcn_mfma_f32_16x16x32_bf16(a, b, acc, 0, 0, 0);
}
__device__ __forceinline__ void st_tile(lchar* dst, int ti, int tj, int c, int q, f32x4 v) {
    u32x2 w; w.x = pk2(v[0], v[1]); w.y = pk2(v[2], v[3]); *(LAS u32x2*)(dst + ((16 * tj + c) * P + 16 * ti + 4 * q) * 2) = w;
}
__device__ __forceinline__ f32x4 ld_tile(const lchar* src, int ti, int tj, int c, int q) {
    const u32x2 w = *(const LAS u32x2*)(src + ((16 * tj + c) * P + 16 * ti + 4 * q) * 2);
    return (f32x4){__uint_as_float(w.x << 16), __uint_as_float(w.x & 0xffff0000u), __uint_as_float(w.y << 16), __uint_as_float(w.y & 0xffff0000u)};
}
__device__ __forceinline__ void st_glob(bf16_t* dst, int ti, int tj, int c, int q, f32x4 v) {
    uint2 w; w.x = pk2(v[0], v[1]); w.y = pk2(v[2], v[3]); *(uint2*)(dst + (16 * tj + c) * 64 + 16 * ti + 4 * q) = w;
}
typedef float f32x16 __attribute__((ext_vector_type(16)));
__device__ __forceinline__ f32x16 mm32(const lchar* Aop, const lchar* Bop, int ti, int tj, int r32, int hi, f32x16 acc) {
    bf16x8 a[4], b[4];
#pragma unroll
    for (int ks = 0; ks < 4; ++ks) {
        a[ks] = *(const LAS bf16x8*)(Aop + ((32 * ti + r32) * P + 16 * ks + 8 * hi) * 2);
        b[ks] = *(const LAS bf16x8*)(Bop + ((32 * tj + r32) * P + 16 * ks + 8 * hi) * 2); }
    __builtin_amdgcn_sched_barrier(0);
#pragma unroll
    for (int ks = 0; ks < 4; ++ks) acc = __builtin_amdgcn_mfma_f32_32x32x16_bf16(a[ks], b[ks], acc, 0, 0, 0);
    return acc;
}
__device__ __forceinline__ void st32(lchar* dst, int ti, int tj, int r32, int hi, const f32x16& v) {
#pragma unroll
    for (int g = 0; g < 4; ++g) { u32x2 w; w.x = pk2(v[4 * g], v[4 * g + 1]); w.y = pk2(v[4 * g + 2], v[4 * g + 3]); *(LAS u32x2*)(dst + ((32 * tj + r32) * P + 32 * ti + 8 * g + 4 * hi) * 2) = w; }
}
__device__ __forceinline__ f32x16 ld32(const lchar* src, int ti, int tj, int r32, int hi) {
    f32x16 v;
#pragma unroll
    for (int g = 0; g < 4; ++g) { const u32x2 w = *(const LAS u32x2*)(src + ((32 * tj + r32) * P + 32 * ti + 8 * g + 4 * hi) * 2);
        v[4 * g] = __uint_as_float(w.x << 16); v[4 * g + 1] = __uint_as_float(w.x & 0xffff0000u); v[4 * g + 2] = __uint_as_float(w.y << 16); v[4 * g + 3] = __uint_as_float(w.y & 0xffff0000u); }
    return v;
}
__device__ __forceinline__ void stg32(bf16_t* dst, int ti, int tj, int r32, int hi, const f32x16& v) {
#pragma unroll
    for (int g = 0; g < 4; ++g) { uint2 w; w.x = pk2(v[4 * g], v[4 * g + 1]); w.y = pk2(v[4 * g + 2], v[4 * g + 3]); *(uint2*)(dst + (32 * tj + r32) * 64 + 32 * ti + 8 * g + 4 * hi) = w; }
}
}

#define LBAR() do { asm volatile("s_waitcnt lgkmcnt(0)" ::: "memory"); __builtin_amdgcn_s_barrier(); asm volatile("" ::: "memory"); } while (0)
__device__ void ph_rw_sc1(const Params& p, int j, char* lds) {
    using namespace ck;
    const int tid = tidx(), wid = __builtin_amdgcn_readfirstlane(tid >> 6), lane = tid & 63, c = lane & 15, q = lane >> 4;
    const size_t PL = (size_t)NROW * D;
    const bf16_t* RKV = (const bf16_t*)(p.ws + OFF_RKV); const unsigned short* LW = (const unsigned short*)(p.ws + OFF_W); const bf16_t* AV = (const bf16_t*)(p.ws + OFF_AV);
    bf16_t* CK = (bf16_t*)(p.ws + OFF_CK);
    lchar* B0 = (lchar*)lds;
#define BUF(i) (B0 + (i) * MB)
    LAS float* Lbuf = (LAS float*)BUF(8);
    LAS float* Lseg = (LAS float*)(B0 + 16 * MB);
    LAS float* GC = Lseg + 8 * 64;
    const int pt = tid >> 3, cg = tid & 7;
    f32x4 nkk[2], nka[2]; u32x4 nlw, nkx, nax, nrx, nvx;
#define SC1_LOAD(IT) do { const int seq_ = (IT) / NCHK, ch_ = (IT) % NCHK; const int z_ = seq_ & 1, h_ = (seq_ >> 1) & 15, b_ = seq_ >> 5; \
        const size_t go_ = (size_t)scan_row(ch_ * 64 + pt, b_, z_) * D + h_ * 64 + cg * 8; \
        nlw = *(const u32x4*)(LW + z_ * PL + go_); \
        nkx = *(const u32x4*)(RKV + PL + go_); nax = *(const u32x4*)(AV + z_ * PL + go_); nrx = *(const u32x4*)(RKV + go_); nvx = *(const u32x4*)(RKV + 2 * PL + go_); \
        _Pragma("unroll") for (int e = 0; e < 2; ++e) { nkk[e] = *(const f32x4*)(p.rw_k_k + j * D + h_ * 64 + cg * 8 + 4 * e); nka[e] = *(const f32x4*)(p.rw_k_a + j * D + h_ * 64 + cg * 8 + 4 * e); } } while (0)
    if (bidx() < 128 * NCHK) SC1_LOAD(bidx());
    for (int it = bidx(); it < 128 * NCHK; it += gdim()) {
        const int seq = it / NCHK; const int h = (seq >> 1) & 15;
        f32x4 lw[2], kx[2], ax[2], rx[2], vx[2], kkc[2], kac[2];
#pragma unroll
        for (int e = 0; e < 2; ++e) { constexpr float LWS = -0.6065306597126334f / 65535.f;
            lw[e] = (f32x4){(float)(nlw[2 * e] & 0xffffu) * LWS, (float)(nlw[2 * e] >> 16) * LWS, (float)(nlw[2 * e + 1] & 0xffffu) * LWS, (float)(nlw[2 * e + 1] >> 16) * LWS};
            kkc[e] = nkk[e]; kac[e] = nka[e];
            kx[e] = (f32x4){__uint_as_float(nkx[2 * e] << 16), __uint_as_float(nkx[2 * e] & 0xffff0000u), __uint_as_float(nkx[2 * e + 1] << 16), __uint_as_float(nkx[2 * e + 1] & 0xffff0000u)};
            ax[e] = (f32x4){__uint_as_float(nax[2 * e] << 16), __uint_as_float(nax[2 * e] & 0xffff0000u), __uint_as_float(nax[2 * e + 1] << 16), __uint_as_float(nax[2 * e + 1] & 0xffff0000u)};
            rx[e] = (f32x4){__uint_as_float(nrx[2 * e] << 16), __uint_as_float(nrx[2 * e] & 0xffff0000u), __uint_as_float(nrx[2 * e + 1] << 16), __uint_as_float(nrx[2 * e + 1] & 0xffff0000u)};
            vx[e] = (f32x4){__uint_as_float(nvx[2 * e] << 16), __uint_as_float(nvx[2 * e] & 0xffff0000u), __uint_as_float(nvx[2 * e + 1] << 16), __uint_as_float(nvx[2 * e + 1] & 0xffff0000u)}; }
        f32x4 rkc[2];
#pragma unroll
        for (int e = 0; e < 2; ++e) rkc[e] = *(const f32x4*)(p.rw_r_k + j * D + h * 64 + cg * 8 + 4 * e);
        if (it + gdim() < 128 * NCHK) SC1_LOAD(it + gdim());
        LBAR();
#pragma unroll
        for (int e = 0; e < 2; ++e) *(LAS f32x4*)(Lbuf + pt * 64 + cg * 8 + 4 * e) = lw[e];
        f32x4 kk[2], bq[2], kd[2];
        { float ss = 0.f;
#pragma unroll
          for (int e = 0; e < 2; ++e) { kk[e] = kx[e] * kkc[e]; ss += kk[e][0] * kk[e][0] + kk[e][1] * kk[e][1] + kk[e][2] * kk[e][2] + kk[e][3] * kk[e][3]; }
          ss = dpp_sum8(ss); const float inv = __builtin_amdgcn_rsqf(fmaxf(ss, 1e-24f));
#pragma unroll
          for (int e = 0; e < 2; ++e) { kk[e] = kk[e] * inv; bq[e] = kk[e] * ax[e]; kd[e] = kx[e] * (1.f + (ax[e] - 1.f) * kac[e]); } }
        LBAR();
        { const int k = tid & 63, sg = tid >> 6; float run = 0.f;
#pragma unroll
          for (int u = 0; u < 8; ++u) { run += Lbuf[(sg * 8 + u) * 64 + k]; Lbuf[(sg * 8 + u) * 64 + k] = run; }
          Lseg[sg * 64 + k] = run; }
        LBAR();
        f32x4 Lt[2], Lp[2], Lc[2];
        { const int sg = pt >> 3, sgp = (pt - 1) >> 3;
#pragma unroll
          for (int e = 0; e < 2; ++e) { f32x4 o0 = {0.f, 0.f, 0.f, 0.f}, o1 = o0, oc = o0;
#pragma unroll
              for (int u = 0; u < 8; ++u) { const f32x4 sv = *(const LAS f32x4*)(Lseg + u * 64 + cg * 8 + 4 * e); if (u < sg) o0 = o0 + sv; if (u < sgp) o1 = o1 + sv; if (u < 7) oc = oc + sv; }
              Lt[e] = *(const LAS f32x4*)(Lbuf + pt * 64 + cg * 8 + 4 * e) + o0;
              Lp[e] = pt > 0 ? *(const LAS f32x4*)(Lbuf + (pt - 1) * 64 + cg * 8 + 4 * e) + o1 : (f32x4){0.f, 0.f, 0.f, 0.f};
              Lc[e] = *(const LAS f32x4*)(Lbuf + 63 * 64 + cg * 8 + 4 * e) + oc; } }
        LBAR();
        {
            float at[8], bt[8], kt[8], rt[8], bh[8], kh[8], vv[8];
#pragma unroll
            for (int e = 0; e < 2; ++e)
#pragma unroll
                for (int u = 0; u < 4; ++u) { const int x = 4 * e + u; const float eL = __expf(Lt[e][u]), emL = __expf(-Lt[e][u]), eP = __expf(Lp[e][u]), eC = __expf(Lc[e][u] - Lt[e][u]);
                    at[x] = -kk[e][u] * eP; bt[x] = bq[e][u] * emL; kt[x] = kd[e][u] * emL; rt[x] = rx[e][u] * eL; bh[x] = bq[e][u] * eC; kh[x] = kd[e][u] * eC; vv[x] = vx[e][u];
                    if (pt == 63) GC[cg * 8 + x] = eL; }
#define ST8(bufi, arr) do { u32x4 w_ = {pk2(arr[0], arr[1]), pk2(arr[2], arr[3]), pk2(arr[4], arr[5]), pk2(arr[6], arr[7])}; *(LAS u32x4*)(BUF(bufi) + (pt * P + cg * 8) * 2) = w_; } while (0)
            ST8(0, at); ST8(1, bt); ST8(2, kt); ST8(3, rt); ST8(8, bh); ST8(9, kh); ST8(10, vv);
#undef ST8
            float bsv = 0.f;
#pragma unroll
            for (int e = 0; e < 2; ++e) bsv += rx[e][0] * kd[e][0] * rkc[e][0] + rx[e][1] * kd[e][1] * rkc[e][1] + rx[e][2] * kd[e][2] * rkc[e][2] + rx[e][3] * kd[e][3] * rkc[e][3];
            bsv = dpp_sum8(bsv);
            if (cg == 0) { const int z_ = seq & 1, b_ = seq >> 5; ((float*)(p.ws + OFF_BS))[((size_t)z_ * NROW + scan_row((it % NCHK) * 64 + pt, b_, z_)) * 16 + h] = bsv; }
        }
        LBAR();
        {
            const int k = tid & 63, tg = tid >> 6;
#define TR8(src, dst) do { unsigned w_[4]; _Pragma("unroll") for (int x = 0; x < 4; ++x) { const unsigned lo = *(const LAS bf16_t*)(BUF(src) + ((tg * 8 + 2 * x) * P + k) * 2), hi2 = *(const LAS bf16_t*)(BUF(src) + ((tg * 8 + 2 * x + 1) * P + k) * 2); w_[x] = lo | (hi2 << 16); } \
                *(LAS u32x4*)(BUF(dst) + (k * P + tg * 8) * 2) = (u32x4){w_[0], w_[1], w_[2], w_[3]}; } while (0)
            TR8(0, 4); TR8(8, 5); TR8(9, 6); TR8(10, 7);
#undef TR8
        }
        LBAR();
        const f32x4 Z4 = {0.f, 0.f, 0.f, 0.f};
        const f32x16 Z16 = {0.f, 0.f, 0.f, 0.f, 0.f, 0.f, 0.f, 0.f, 0.f, 0.f, 0.f, 0.f, 0.f, 0.f, 0.f, 0.f};
        const int r32 = lane & 31, hi = lane >> 5;
#pragma unroll 1
        for (int u = 0; u < 2; ++u) { const int tl = u * 8 + wid;
            if (tl >= 14) {
                if (tl == 14) { st32(BUF(8), 0, 1, r32, hi, Z16); st32(BUF(8), 1, 0, r32, hi, Z16); st32(BUF(14), 0, 1, r32, hi, Z16); st32(BUF(14), 1, 0, r32, hi, Z16); st32(BUF(9), 1, 0, r32, hi, Z16); }
                else { st32(BUF(15), 1, 0, r32, hi, Z16); st32(BUF(13), 1, 0, r32, hi, Z16); st32(BUF(10), 1, 0, r32, hi, Z16); st32(BUF(11), 1, 0, r32, hi, Z16); st32(BUF(12), 1, 0, r32, hi, Z16); }
                break; }
            const int m = (tl + 1) / 3, rr = (tl + 1) % 3, ti = rr == 2, tj = m == 0 ? ti : (rr >= 1); const int jj = 32 * tj + r32;
            if (m == 0) { f32x16 v = mm32(BUF(0), BUF(1), ti, tj, r32, hi, Z16), w;
#pragma unroll
                for (int e = 0; e < 16; ++e) { const int ii = 32 * ti + 8 * (e >> 2) + 4 * hi + (e & 3); const bool dg = (ii >> 4) == (jj >> 4);
                    v[e] = (dg && jj < ii) ? v[e] : 0.f; w[e] = v[e] + ((ii == jj) ? 1.f : 0.f); }
                st32(BUF(8), ti, tj, r32, hi, v); st32(BUF(14), ti, tj, r32, hi, w); }
            else if (m == 1) { const f32x16 v = mm32(BUF(1), BUF(0), ti, tj, r32, hi, Z16); f32x16 vd, vo, w;
#pragma unroll
                for (int e = 0; e < 16; ++e) { const int ii = 32 * ti + 8 * (e >> 2) + 4 * hi + (e & 3); const bool dg = (ii >> 4) == (jj >> 4), up = ii < jj;
                    vd[e] = (dg && up) ? v[e] : 0.f; vo[e] = (!dg && up) ? v[e] : 0.f; w[e] = vd[e] + ((ii == jj) ? 1.f : 0.f); }
                st32(BUF(9), ti, tj, r32, hi, vd); st32(BUF(15), ti, tj, r32, hi, vo); st32(BUF(13), ti, tj, r32, hi, w); }
            else if (m == 2) { f32x16 v = mm32(BUF(2), BUF(0), ti, tj, r32, hi, Z16);
#pragma unroll
                for (int e = 0; e < 16; ++e) { const int ii = 32 * ti + 8 * (e >> 2) + 4 * hi + (e & 3); v[e] = ii < jj ? v[e] : 0.f; }
                st32(BUF(10), ti, tj, r32, hi, v); }
            else { f32x16 v = mm32(m == 3 ? BUF(1) : BUF(2), BUF(3), ti, tj, r32, hi, Z16);
#pragma unroll
                for (int e = 0; e < 16; ++e) { const int ii = 32 * ti + 8 * (e >> 2) + 4 * hi + (e & 3); v[e] = ii <= jj ? v[e] : 0.f; }
                st32(m == 3 ? BUF(11) : BUF(12), ti, tj, r32, hi, v); } }
        LBAR();
#define WSYNC() asm volatile("s_waitcnt lgkmcnt(0)" ::: "memory")
        if (wid < 4) {
            const int tt = wid;
#define SQD(sr, st, dr, dt) do { const f32x4 a_ = mm_diag(BUF(st), BUF(sr), tt, c, q, Z4), b_ = mm_diag(BUF(sr), BUF(st), tt, c, q, Z4); WSYNC(); \
                st_tile(BUF(dr), tt, tt, c, q, a_); st_tile(BUF(dt), tt, tt, c, q, b_); WSYNC(); } while (0)
#define UPD(pr) do { const f32x4 dt_ = mm_diag(BUF(pr), BUF(13), tt, c, q, ld_tile(BUF(13), tt, tt, c, q)); \
                const f32x4 dr_ = mm_diag(BUF(13), BUF(pr), tt, c, q, ld_tile(BUF(14), tt, tt, c, q)); WSYNC(); \
                st_tile(BUF(13), tt, tt, c, q, dt_); st_tile(BUF(14), tt, tt, c, q, dr_); WSYNC(); } while (0)
#define UPSQ(sr, st, dr, dt) do { const f32x4 dt_ = mm_diag(BUF(sr), BUF(13), tt, c, q, ld_tile(BUF(13), tt, tt, c, q)); \
                const f32x4 dr_ = mm_diag(BUF(13), BUF(sr), tt, c, q, ld_tile(BUF(14), tt, tt, c, q)); \
                const f32x4 a_ = mm_diag(BUF(st), BUF(sr), tt, c, q, Z4), b_ = mm_diag(BUF(sr), BUF(st), tt, c, q, Z4); WSYNC(); \
                st_tile(BUF(13), tt, tt, c, q, dt_); st_tile(BUF(14), tt, tt, c, q, dr_); st_tile(BUF(dr), tt, tt, c, q, a_); st_tile(BUF(dt), tt, tt, c, q, b_); WSYNC(); } while (0)
            SQD(8, 9, 0, 1); UPSQ(0, 1, 8, 9); UPSQ(8, 9, 0, 1); UPD(0);
#undef UPSQ
#undef SQD
#undef UPD
        } else {
            const int ti = (wid >> 1) & 1, tj = wid & 1; st32(BUF(2), ti, tj, r32, hi, mm32(BUF(10), BUF(7), ti, tj, r32, hi, Z16));
        }
        LBAR();
        { const int m = wid >> 2, ti = (wid >> 1) & 1, tj = wid & 1;
          if (m == 0) st32(BUF(8), ti, tj, r32, hi, mm32(BUF(15), BUF(14), ti, tj, r32, hi, Z16));
          else        st32(BUF(9), ti, tj, r32, hi, mm32(BUF(14), BUF(15), ti, tj, r32, hi, Z16)); }
        LBAR();
        { const int ti = (wid >> 1) & 1, tj = wid & 1;
          if (wid < 4) st32(BUF(0), ti, tj, r32, hi, mm32(BUF(9), BUF(8), ti, tj, r32, hi, Z16));
          else         st32(BUF(1), ti, tj, r32, hi, mm32(BUF(8), BUF(13), ti, tj, r32, hi, ld32(BUF(13), ti, tj, r32, hi))); }
        LBAR();
        if (wid < 4) { const int ti = (wid >> 1) & 1, tj = wid & 1; st32(BUF(14), ti, tj, r32, hi, mm32(BUF(0), BUF(1), ti, tj, r32, hi, ld32(BUF(1), ti, tj, r32, hi))); }
        LBAR();
        { const int m = wid >> 2, ti = (wid >> 1) & 1, tj = wid & 1;
          if (m == 0) st32(BUF(8), ti, tj, r32, hi, mm32(BUF(14), BUF(4), ti, tj, r32, hi, Z16));
          else        st32(BUF(0), ti, tj, r32, hi, mm32(BUF(14), BUF(2), ti, tj, r32, hi, Z16)); }
        LBAR();
        bf16_t* ckp = CK + (size_t)it * 4 * 4096;
#pragma unroll 1
        for (int u = 0; u < 2; ++u) { const int tl = u * 8 + wid, m = tl >> 2, ti = (tl >> 1) & 1, tj = tl & 1;
            if (m == 0) { f32x16 v = mm32(BUF(8), BUF(5), ti, tj, r32, hi, Z16); const int jj = 32 * tj + r32; const float gc = GC[jj];
#pragma unroll
                for (int e = 0; e < 16; ++e) { const int ii = 32 * ti + 8 * (e >> 2) + 4 * hi + (e & 3); v[e] += (ii == jj) ? gc : 0.f; }
                st32(BUF(1), ti, tj, r32, hi, v); }
            else if (m == 1) st32(BUF(4), ti, tj, r32, hi, mm32(BUF(8), BUF(11), ti, tj, r32, hi, ld32(BUF(3), ti, tj, r32, hi)));
            else if (m == 2) st32(BUF(2), ti, tj, r32, hi, mm32(BUF(6), BUF(7), ti, tj, r32, hi, mm32(BUF(5), BUF(0), ti, tj, r32, hi, Z16)));
            else             st32(BUF(9), ti, tj, r32, hi, mm32(BUF(7), BUF(12), ti, tj, r32, hi, mm32(BUF(0), BUF(11), ti, tj, r32, hi, Z16))); }
        LBAR();
        { const int orow = tid >> 3, oc = (tid & 7) * 8;
          *(u32x4*)(ckp + orow * 64 + oc) = *(const LAS u32x4*)(BUF(1) + (orow * P + oc) * 2);
          *(u32x4*)(ckp + 4096 + orow * 64 + oc) = *(const LAS u32x4*)(BUF(2) + (orow * P + oc) * 2);
          *(u32x4*)(ckp + 2 * 4096 + orow * 64 + oc) = *(const LAS u32x4*)(BUF(4) + (orow * P + oc) * 2);
          *(u32x4*)(ckp + 3 * 4096 + orow * 64 + oc) = *(const LAS u32x4*)(BUF(9) + (orow * P + oc) * 2); }
    }
#undef BUF
#undef SC1_LOAD
}

__device__ void ph_rw_sc2(const Params& p, char* lds) {
    using namespace ck;
    const int tid = tidx(), wid = __builtin_amdgcn_readfirstlane(tid >> 6), lane = tid & 63, c = lane & 15, q = lane >> 4;
    const size_t PL = (size_t)NROW * D;
    const bf16_t* CK = (const bf16_t*)(p.ws + OFF_CK); bf16_t* Y = (bf16_t*)(p.ws + OFF_Y);
    lchar* GB = (lchar*)lds;
    lchar* RB = GB + 2 * MB;
    lchar* SB = GB + 4 * MB;
    constexpr int SBB = 32 * P * 2;
    for (int it = bidx(); it < 256; it += gdim()) {
        const int vh = it & 1, seq = it >> 1, z = seq & 1, h = (seq >> 1) & 15, b = seq >> 5;
        const bf16_t* ck0 = CK + (size_t)seq * NCHK * 4 * 4096;
        const int s_ti = wid & 3, s_tj = wid >> 2;
        const int y_ti = wid & 1, y_tj = wid >> 1;
        const int hoff = 4096 + (vh * 32 + 16 * s_tj + c) * 64 + 16 * s_ti + 4 * q, yoff = 3 * 4096 + (16 * y_tj + c) * 64 + vh * 32 + 16 * y_ti + 4 * q;
        struct PF { u32x4 g, r; uint2 h, y; };
#define PF_LOAD(X, k) do { const bf16_t* cc_ = ck0 + (size_t)(k) * 4 * 4096; X.h = *(const uint2*)(cc_ + hoff); X.y = *(const uint2*)(cc_ + yoff); X.g = *(const u32x4*)(cc_ + tid * 8); X.r = *(const u32x4*)(cc_ + 2 * 4096 + tid * 8); } while (0)
#define PF_STAGE(X, bufi) do { *(LAS u32x4*)(GB + (bufi) * MB + ((tid >> 3) * P + (tid & 7) * 8) * 2) = X.g; *(LAS u32x4*)(RB + (bufi) * MB + ((tid >> 3) * P + (tid & 7) * 8) * 2) = X.r; } while (0)
#define SC2_STEP(k, CUR, NXT) do { const uint2 hi_ = CUR.h, yi_ = CUR.y; const int cur = (k) & 1; \
            if ((k) + 4 < NCHK) PF_LOAD(CUR, (k) + 4); \
            const f32x4 hinit = {__uint_as_float(hi_.x << 16), __uint_as_float(hi_.x & 0xffff0000u), __uint_as_float(hi_.y << 16), __uint_as_float(hi_.y & 0xffff0000u)}; \
            const f32x4 yinit = {__uint_as_float(yi_.x << 16), __uint_as_float(yi_.x & 0xffff0000u), __uint_as_float(yi_.y << 16), __uint_as_float(yi_.y & 0xffff0000u)}; \
            const lchar* Sold = SB + cur * SBB; lchar* Snew = SB + (cur ^ 1) * SBB; \
            const f32x4 sn = mm_tile(GB + cur * MB, Sold, s_ti, s_tj, c, q, hinit);        \
            const f32x4 yv = mm_tile(Sold, RB + cur * MB, y_ti, y_tj, c, q, yinit);        \
            st_tile(Snew, s_ti, s_tj, c, q, sn); \
            { const int row = scan_row((k) * 64 + 16 * y_tj + c, b, z); stbf4(Y + z * PL + (size_t)row * D + h * 64 + vh * 32 + 16 * y_ti + 4 * q, yv); } \
            if ((k) + 1 < NCHK) PF_STAGE(NXT, cur ^ 1); \
            LBAR(); } while (0)
        PF s0, s1, s2, s3;
        PF_LOAD(s0, 0); PF_LOAD(s1, 1); PF_LOAD(s2, 2); PF_LOAD(s3, 3);
        LBAR();
        for (int i = tid; i < SBB / 4; i += NTHR) ((LAS unsigned*)SB)[i] = 0u;
        PF_STAGE(s0, 0);
        LBAR();
        for (int ch = 0; ch < NCHK; ch += 4) {
            SC2_STEP(ch, s0, s1); SC2_STEP(ch + 1, s1, s2); SC2_STEP(ch + 2, s2, s3); SC2_STEP(ch + 3, s3, s0);
        }
#undef PF_LOAD
#undef PF_STAGE
#undef SC2_STEP
    }
}
#undef LBAR

__device__ void ph_rw_out(const Params& p, int j, int nrows) {
    const int wid = tidx() >> 6, lane = tidx() & 63;
    const bf16_t* RKV = (const bf16_t*)(p.ws + OFF_RKV); const bf16_t* AV = (const bf16_t*)(p.ws + OFF_AV); const bf16_t* G = (const bf16_t*)(p.ws + OFF_G); const bf16_t* Y = (const bf16_t*)(p.ws + OFF_Y);
    bf16_t* OUT = (bf16_t*)(p.ws + OFF_H);
    const size_t PL = (size_t)NROW * D;
    const float* lg = p.rw_lnx_g + j * D; const float* lb = p.rw_lnx_b + j * D; const float* BS = (const float*)(p.ws + OFF_BS);
    uint2 nb[4][4]; float nbs[2][4];
#define OUT_LOAD(R) do { _Pragma("unroll") for (int i = 0; i < 4; ++i) { const size_t o_ = (size_t)(R) * D + lane * 4 + i * 256; \
        nb[0][i] = *(const uint2*)(Y + o_); nb[1][i] = *(const uint2*)(Y + PL + o_); nb[2][i] = *(const uint2*)(RKV + 2 * PL + o_); nb[3][i] = *(const uint2*)(G + o_); \
        nbs[0][i] = BS[(size_t)(R) * 16 + (lane >> 4) + 4 * i]; nbs[1][i] = BS[((size_t)NROW + (R)) * 16 + (lane >> 4) + 4 * i]; } } while (0)
#define UNPK(w) ((f32x4){__uint_as_float((w).x << 16), __uint_as_float((w).x & 0xffff0000u), __uint_as_float((w).y << 16), __uint_as_float((w).y & 0xffff0000u)})
    int row = bidx() * 8 + wid;
    if (row < nrows) OUT_LOAD(row);
    for (; row < nrows; row += gdim() * 8) {
        uint2 cb[4][4]; float cbs[4];
#pragma unroll
        for (int i = 0; i < 4; ++i) { cbs[i] = nbs[0][i] + nbs[1][i];
#pragma unroll
            for (int q_ = 0; q_ < 4; ++q_) cb[q_][i] = nb[q_][i]; }
        { const int nrow = row + gdim() * 8; if (nrow < nrows) OUT_LOAD(nrow); }
#pragma unroll
        for (int i = 0; i < 4; ++i) {
            const size_t o = (size_t)row * D + lane * 4 + i * 256; const int c = lane * 4 + i * 256;
            const f32x4 y = UNPK(cb[0][i]) + UNPK(cb[1][i]);
            const float mean = dpp_sum16(y[0] + y[1] + y[2] + y[3]) * (1.f / 64.f);
            const f32x4 dd = y - mean;
            const float rstd = rsqrtf(dpp_sum16(dd[0] * dd[0] + dd[1] * dd[1] + dd[2] * dd[2] + dd[3] * dd[3]) * (1.f / 64.f) + LNX_EPS);
            const f32x4 v = UNPK(cb[2][i]);
            const f32x4 res = (dd * rstd * *(const f32x4*)(lg + c) + *(const f32x4*)(lb + c) + cbs[i] * v) * UNPK(cb[3][i]);
            uint2 w; w.x = pk2(res[0], res[1]); w.y = pk2(res[2], res[3]); *(uint2*)(OUT + o) = w;
        }
    }
#undef OUT_LOAD
#undef UNPK
}

__device__ void ph_final(const Params& p) {
    const int wid = tidx() >> 6, lane = tidx() & 63;
    const float* X = (const float*)(p.ws + OFF_X);
    for (int row = bidx() * 8 + wid; row < NLAT; row += gdim() * 8) {
        const float4* xr = (const float4*)(X + (size_t)row * D);
        float4 v[4]; float ss = 0;
#pragma unroll
        for (int i = 0; i < 4; ++i) { v[i] = xr[lane + i * 64]; ss += v[i].x * v[i].x + v[i].y * v[i].y + v[i].z * v[i].z + v[i].w * v[i].w; }
        ss = wave_sum(ss); const float rs = rsqrtf(ss * (1.f / D) + RMS_EPS);
#pragma unroll
        for (int i = 0; i < 4; ++i) { const int d = (lane + i * 64) * 4; const float4 gg = *(const float4*)(p.final_g + d);
            float4 o; o.x = v[i].x * rs * gg.x; o.y = v[i].y * rs * gg.y; o.z = v[i].z * rs * gg.z; o.w = v[i].w * rs * gg.w;
            *(float4*)(p.out + (size_t)row * D + d) = o; }
    }
}

enum { PH_INIT = 0, PH_A_NORM, PH_A_Z, PH_A_MID, PH_A_QKV, PH_A_POST, PH_A_ATTN, PH_A_WO,
       PH_R_NORM, PH_R_XS, PH_R_G1, PH_R_G2, PH_R_PREP, PH_R_SCAN, PH_R_OUT, PH_R_WO,
       PH_M_NORM, PH_M_SEL, PH_M_GATHER, PH_M_G1, PH_M_G2, PH_M_COMB, PH_FINAL, PH_M_CVT, PH_R_SC1, PH_R_SC2 };

#ifndef BG_Z
#define BG_Z 4
#define BG_ATTN 2
#define BG_WO 3
#define BG_RG1 6
#define BG_MG1 4
#define BG_MG2 6
#endif
template <int PH>
__device__ __forceinline__ void run_phase(const Params& p, int layer, char* lds) {
    const int j = layer >> 1;
    char* ws = p.ws;
    if constexpr (PH == PH_INIT) { ph_init(p, lds); __syncthreads(); ph_small_cvt(p, lds); }
    else if constexpr (PH == PH_A_NORM) { if (layer == 0) ph_norm_mod<false>(p, layer, p.norm1_g + layer * D, 0, 1, ws + OFF_H); else ph_comb_norm<false>(p, layer - 1, layer, NROW); }
    else if constexpr (PH == PH_A_Z) {
        float* Z = (float*)(ws + OFF_Z);
        g8::BatchSched S{ws + OFF_H, ws + OFF_WMLA + j * SZ_WMLA + WM_IN, 0, 0, NROW / 256, 2, 1, D};
        g8::gemm_phase(p.wv, (PG8_LAS unsigned char*)lds, D, S, g8::epi_rc([=](const g8::Unit&, int row, int col, f32x4 v) { *(f32x4*)(Z + (size_t)row * 512 + col) = v; }));
        if (idle_tail(NROW / 256 * 2)) bg_cvt(p, layer, lds, BG_Z);
    }
    else if constexpr (PH == PH_A_MID) ph_mla_mid(p, j);
    else if constexpr (PH == PH_A_QKV) {
        bf16_t* Q = (bf16_t*)(ws + OFF_Q); bf16_t* K = (bf16_t*)(ws + OFF_K); bf16_t* V = (bf16_t*)(ws + OFF_V);
        g8::BatchSched S1{ws + OFF_CQN, ws + OFF_WMLA + j * SZ_WMLA + WM_UQ, 0, 0, NROW / 256, 6, 1, 256, 1};
        g8::gemm_phase(p.wv, (PG8_LAS unsigned char*)lds, 256, S1, g8::epi_rc([=](const g8::Unit&, int row, int col, f32x4 v) {
            const bool lat = row < NLAT; const int b = lat ? (row >> 12) : ((row - NLAT) >> 8); const int tk = lat ? 256 + (row & (TL - 1)) : ((row - NLAT) & 255);
            const int h = col / 192, d = col - h * 192;
            uint2 w; w.x = pk2(v[0], v[1]); w.y = pk2(v[2], v[3]);
            *(uint2*)(Q + ((size_t)(b * 8 + h) * TK + tk) * 192 + d) = w; }));
        g8::BatchSched S2{ws + OFF_CKVN, ws + OFF_WMLA + j * SZ_WMLA + WM_UKV, 0, 0, NROW / 256, 8, 1, 128};
        g8::gemm_phase(p.wv, (PG8_LAS unsigned char*)lds, 128, S2, g8::epi_rc([=](const g8::Unit&, int row, int col, f32x4 v) {
            const bool lat = row < NLAT; const int b = lat ? (row >> 12) : ((row - NLAT) >> 8); const int tk = lat ? 256 + (row & (TL - 1)) : ((row - NLAT) & 255);
            const int h = col >> 8, d = col & 255; const size_t orow = (size_t)(b * 8 + h) * TK + tk;
            uint2 w; w.x = pk2(v[0], v[1]); w.y = pk2(v[2], v[3]);
            if (d < 128) *(uint2*)(K + orow * 192 + d) = w; else *(uint2*)(V + orow * 128 + (d - 128)) = w; }));
    }
    else if constexpr (PH == PH_A_ATTN) { ph_attn(p, lds); if (idle_tail(544)) bg_cvt(p, layer, lds, BG_ATTN); }
    else if constexpr (PH == PH_A_WO || PH == PH_R_WO) {
        xt_t* X = (xt_t*)(ws + OFF_X); const float* MOD = (const float*)(ws + OFF_MOD);
        g8::BatchSched S{ws + (PH == PH_A_WO ? OFF_O : OFF_H), PH == PH_A_WO ? ws + OFF_WMLA + j * SZ_WMLA + WM_O : ws + OFF_WRW + j * SZ_WRW + WR_O, 0, 0, (layer < 3 ? NROW : NLAT) / 256, 4, 1, D};
        g8::gemm_phase(p.wv, (PG8_LAS unsigned char*)lds, D, S, g8::EpiResid{X, MOD, layer});
        if (idle_tail((layer < 3 ? NROW : NLAT) / 256 * 4)) bg_cvt(p, layer, lds, BG_WO);
    }
    else if constexpr (PH == PH_R_XS) ph_rw_normxs(p, layer, j);
    else if constexpr (PH == PH_R_G1) {
        bf16_t* RKV = (bf16_t*)(ws + OFF_RKV); bf16_t* VF = (bf16_t*)(ws + OFF_VFIRST);
        bf16_t* A2 = (bf16_t*)(ws + OFF_A2); bf16_t* A3 = (bf16_t*)(ws + OFF_A3);
        const bool first = (j == 0);
        struct RSched { const char* XS; const char* WB; int nwg;
            __device__ __forceinline__ bool next(int i, g8::Unit& u) const {
                const int L = i * gdim() + bidx(); if (L >= nwg) return false;
                const int w = g8::xcd_remap(L, nwg);
                if (w < 816) { u.g = w / 272; const int r = w % 272; u.pm = r >> 2; u.pn = r & 3; u.B = WB + WR_RKV + (size_t)u.g * D * D * 2 + (size_t)u.pn * 256 * D * 2; }
                else { u.g = 3 + (w - 816) / 68; u.pm = (w - 816) % 68; u.pn = 0; u.B = WB + WR_L + (size_t)(u.g - 3) * 256 * D * 2; }
                u.A = XS + (size_t)(u.g == 6 ? 2 : u.g) * NROW * D * 2 + (size_t)u.pm * 256 * D * 2; return true; } };
        RSched S{ws + OFF_XS, ws + OFF_WRW + j * SZ_WRW, first ? 816 + 204 : 816 + 272};
        g8::gemm_phase(p.wv, (PG8_LAS unsigned char*)lds, D, S, g8::epi_rc([=](const g8::Unit& u, int row, int col, f32x4 v) {
            if (u.g < 3) { stbf4(RKV + ((size_t)u.g * NROW + row) * D + col, v); if (first && u.g == 2) stbf4(VF + (size_t)row * D + col, v); }
            else if (col < 128) {
                f32x4 t = v;
                if (u.g == 3) { for (int e = 0; e < 4; ++e) t[e] = 1.f - 2.f * __builtin_amdgcn_rcpf(1.f + __expf(2.f * v[e])); }
                else if (u.g == 5) { for (int e = 0; e < 4; ++e) t[e] = sigmoidf_(v[e]); }
                bf16_t* dst = (u.g == 3 ? A2 : u.g == 4 ? A2 + (size_t)NROW * 128 : u.g == 5 ? A3 : A3 + (size_t)NROW * 128);
                stbf4(dst + (size_t)row * 128 + col, t); } }));
        if (idle_tail(S.nwg)) bg_cvt(p, layer, lds, BG_RG1);
    }
    else if constexpr (PH == PH_R_G2) {
        const bool first = (j == 0);
        unsigned short* W = (unsigned short*)(ws + OFF_W); bf16_t* AV = (bf16_t*)(ws + OFF_AV); bf16_t* G = (bf16_t*)(ws + OFF_G); bf16_t* RKV = (bf16_t*)(ws + OFF_RKV); const bf16_t* VF = (const bf16_t*)(ws + OFF_VFIRST);
        const float* w0 = p.rw_w0 + (size_t)j * 2 * D; const float* a0 = p.rw_a0 + (size_t)j * 2 * D; const float* v0 = p.rw_v0;
        g8::BatchSched S1{ws + OFF_A2, ws + OFF_WRW + j * SZ_WRW + WR_B2, (size_t)NROW * 128 * 2, (size_t)2048 * 128 * 2, NROW / 256, 8, 2, 128};
        g8::gemm_phase(p.wv, (PG8_LAS unsigned char*)lds, 128, S1, g8::epi_colfirst([=](const g8::Unit& u, int row, int col, f32x4 v, f32x4 bias) {
            const int zz = u.pn >> 2, c = col & 1023; const bool dec = u.g == 0;
            const size_t doff = (size_t)zz * NROW * D + (size_t)row * D + c;
            const f32x4 x = v + bias; f32x4 o;
#pragma unroll
            for (int e = 0; e < 4; ++e) o[e] = __builtin_amdgcn_rcpf(1.f + __expf(-x[e]));
            if (dec) { uint2 w; w.x = (unsigned)(o[0] * 65535.f + 0.5f) | ((unsigned)(o[1] * 65535.f + 0.5f) << 16); w.y = (unsigned)(o[2] * 65535.f + 0.5f) | ((unsigned)(o[3] * 65535.f + 0.5f) << 16); *(uint2*)(W + doff) = w; }
            else stbf4(AV + doff, o); },
            [=](const g8::Unit& u, int col) { const int zz = u.pn >> 2, c = col & 1023; return *(const f32x4*)((u.g == 0 ? w0 : a0) + zz * D + c); }));
        g8::BatchSched S2{ws + OFF_A3, ws + OFF_WRW + j * SZ_WRW + WR_B3, (size_t)NROW * 128 * 2, (size_t)1024 * 128 * 2, NROW / 256, 4, first ? 1 : 2, 128, 1};
        g8::gemm_phase(p.wv, (PG8_LAS unsigned char*)lds, 128, S2, g8::epi_rc([=](const g8::Unit& u, int row, int col, f32x4 v) {
            if (u.g == 0) stbf4(G + (size_t)row * D + col, v);
            else { const size_t o = (size_t)row * D + col; const f32x4 vv = ldbf4(RKV + (size_t)2 * NROW * D + o), vf = ldbf4(VF + o), gz = v + *(const f32x4*)(v0 + col); f32x4 r;
#pragma unroll
                for (int e = 0; e < 4; ++e) r[e] = vv[e] + (vf[e] - vv[e]) * __builtin_amdgcn_rcpf(1.f + __expf(-gz[e]));
                stbf4(RKV + (size_t)2 * NROW * D + o, r); } }));
    }
    else if constexpr (PH == PH_R_SCAN) ph_rw_scan(p, j, lds);
    else if constexpr (PH == PH_R_SC1) ph_rw_sc1(p, j, lds);
    else if constexpr (PH == PH_R_SC2) ph_rw_sc2(p, lds);
    else if constexpr (PH == PH_R_OUT) ph_rw_out(p, j, layer < 3 ? NROW : NLAT);
    else if constexpr (PH == PH_M_NORM) ph_norm2_router_mm(p, layer, lds, layer < 3 ? NROW : NLAT);
    else if constexpr (PH == PH_M_SEL) { ph_select(p, lds, layer < 3 ? 128 : 64); __syncthreads(); moe_cvt(p, layer, lds, -1); }
    else if constexpr (PH == PH_M_GATHER) ph_gather(p, layer < 3 ? ESLOTS : NB * CAPL);
    else if constexpr (PH == PH_M_G1) {
        bf16_t* HID = (bf16_t*)(ws + OFF_HID);
        g8::BatchSched S{ws + OFF_XE, ws + OFF_W13T + (size_t)(layer & 1) * SZ_WMOE, (size_t)EPAD * D * 2, (size_t)2816 * D * 2, layer < 3 ? 9 : 8, 11, NE, D};
        g8::gemm_phase(p.wv, (PG8_LAS unsigned char*)lds, D, S, g8::epi_pair([=](const g8::Unit& u, int row, int col, f32x4 a, f32x4 b) {
            uint2 w; w.x = pk2(a[0] * __builtin_amdgcn_rcpf(1.f + __expf(-a[0])) * b[0], a[1] * __builtin_amdgcn_rcpf(1.f + __expf(-a[1])) * b[1]); w.y = pk2(a[2] * __builtin_amdgcn_rcpf(1.f + __expf(-a[2])) * b[2], a[3] * __builtin_amdgcn_rcpf(1.f + __expf(-a[3])) * b[3]);
            *(uint2*)(HID + ((size_t)u.g * EPAD + row) * FF + col) = w; }));
        if (layer < 3 && idle_tail(9 * 11 * NE)) moe_cvt(p, layer + 1, lds, BG_MG1);
    }
    else if constexpr (PH == PH_M_G2) {
        bf16_t* YE = (bf16_t*)(ws + OFF_YE); const float* GATE = (const float*)(ws + OFF_GATE);
        g8::BatchSched S{ws + OFF_HID, ws + OFF_W2T + (size_t)(layer & 1) * SZ_WMOE, (size_t)EPAD * FF * 2, (size_t)D * FF * 2, layer < 3 ? 9 : 8, 4, NE, FF};
        g8::gemm_phase(p.wv, (PG8_LAS unsigned char*)lds, FF, S, g8::epi_pre([=](const g8::Unit& u, int row, int col, f32x4 v, f32x4, float gt) {
            uint2 w; w.x = pk2(v[0] * gt, v[1] * gt); w.y = pk2(v[2] * gt, v[3] * gt);
            *(uint2*)(YE + ((size_t)u.g * EPAD + row) * D + col) = w; },
            [=](const g8::Unit&, int) { return (f32x4){0.f, 0.f, 0.f, 0.f}; }, [=](const g8::Unit& u, int row) { return GATE[u.g * EPAD + row]; }));
        if (layer < 3 && idle_tail(9 * 4 * NE)) moe_cvt(p, layer + 1, lds, BG_MG2);
    }
    else if constexpr (PH == PH_M_COMB) ph_combine(p, layer, layer < 3 ? NROW : NLAT);
    else if constexpr (PH == PH_M_CVT) moe_cvt(p, layer, lds, -1);
    else if constexpr (PH == PH_FINAL) ph_comb_norm<true>(p, 3, 0, NLAT);
}

#if ONE_LAUNCH
#define SYNC() xcd_barrier(bar)
#ifndef PROBE_PH
#define PROBE_PH -1
#endif
#ifndef PROBE_REP
#define PROBE_REP 1
#endif
__device__ __forceinline__ Params load_params() {
    Params q{};
#if defined(__HIP_DEVICE_COMPILE__)
    typedef const __attribute__((address_space(4))) unsigned long long* KargP;
    KargP kp_ = (KargP)__builtin_amdgcn_kernarg_segment_ptr(); asm volatile("" : "+s"(kp_));
#pragma unroll
    for (int i = 0; i < 40; ++i) ((const float**)&q)[i] = (const float*)(const __attribute__((address_space(1))) float*)kp_[i];
#endif
    return q;
}
#define RUN(PH) do { for (int rep_ = 0; rep_ < ((PH) == PROBE_PH ? PROBE_REP : 1); ++rep_) { Params q = load_params(); q.wv = wv0_; run_phase<PH>(q, layer, smem); SYNC(); } } while (0)
__global__ void __launch_bounds__(NTHR, 2) mega(Params p) {
    extern __shared__ __attribute__((aligned(16))) char smem[];
    const int wv0_ = __builtin_amdgcn_readfirstlane((int)threadIdx.x >> 6);
    if (threadIdx.x == 0) *(uint4*)(smem + LDS_BYTES) = make_uint4(0u, 0u, 0u, 0u);
    __syncthreads();
    XcdBarrier bar = xcd_barrier_post((unsigned*)(p.ws + OFF_BAR), (volatile LAS unsigned*)(smem + LDS_BYTES));
    { const int layer = 0; RUN(PH_INIT); }
    for (int layer = 0; layer < 4; ++layer) {
        if ((layer & 1) == 0) {
            RUN(PH_A_NORM);
            RUN(PH_A_Z);
            RUN(PH_A_MID);
            RUN(PH_A_QKV);
            RUN(PH_A_ATTN);
            RUN(PH_A_WO);
        } else {
            RUN(PH_R_XS);
            RUN(PH_R_G1);
            RUN(PH_R_G2);
            RUN(PH_R_SC1);
            RUN(PH_R_SC2);
            RUN(PH_R_OUT);
            RUN(PH_R_WO);
        }
        RUN(PH_M_NORM);
        RUN(PH_M_SEL);
        RUN(PH_M_G1);
        RUN(PH_M_G2);
        if ((layer & 1) == 0) RUN(PH_M_COMB);
    }
    { Params q = load_params(); q.wv = wv0_; run_phase<PH_FINAL>(q, 0, smem); }
}
#else
template <int PH> __global__ void __launch_bounds__(NTHR, 2) kph(Params p, int layer) {
    extern __shared__ __attribute__((aligned(16))) char smem[];
    Params q = p; q.wv = __builtin_amdgcn_readfirstlane((int)threadIdx.x >> 6);
    run_phase<PH>(q, layer, smem);
}
#endif

extern "C" void kernel_launch(void* const* d_in, const int* in_sizes, int n_in, void* d_out, int out_size, void* d_ws, size_t ws_size, hipStream_t stream) {
    if (n_in != 38 || ws_size < WS_NEED) { fprintf(stderr, "kernel_launch: bad args n_in %d ws %zu need %zu\n", n_in, ws_size, (size_t)WS_NEED); return; }
    Params p{};
    const float** pp = (const float**)&p;
    for (int i = 0; i < 38; ++i) pp[i] = (const float*)d_in[i];
    p.out = (float*)d_out; p.ws = (char*)d_ws;
    static int cus = 0;
    if (!cus) { int dev = 0; hipGetDevice(&dev); hipDeviceGetAttribute(&cus, hipDeviceAttributeMultiprocessorCount, dev); if (cus <= 0) cus = 256; }
    const int grid = cus;
#if ONE_LAUNCH
    hipFuncSetAttribute((const void*)mega, hipFuncAttributeMaxDynamicSharedMemorySize, LDS_BYTES + 16);
    hipMemsetAsync(d_ws, 0, 16384, stream);
    hipLaunchKernelGGL(mega, dim3(grid), dim3(NTHR), LDS_BYTES + 16, stream, p);
#else
    hipMemsetAsync(d_ws, 0, 16384, stream);
#define LAUNCH(PH, L) do { hipFuncSetAttribute((const void*)kph<PH>, hipFuncAttributeMaxDynamicSharedMemorySize, LDS_BYTES + 16); hipLaunchKernelGGL(kph<PH>, dim3(grid), dim3(NTHR), LDS_BYTES + 16, stream, p, L); } while (0)
    LAUNCH(PH_INIT, 0);
    for (int layer = 0; layer < 4; ++layer) {
        if ((layer & 1) == 0) { LAUNCH(PH_A_NORM, layer); LAUNCH(PH_A_Z, layer); LAUNCH(PH_A_MID, layer); LAUNCH(PH_A_QKV, layer); LAUNCH(PH_A_ATTN, layer); LAUNCH(PH_A_WO, layer); }
        else { LAUNCH(PH_R_XS, layer); LAUNCH(PH_R_G1, layer); LAUNCH(PH_R_G2, layer); LAUNCH(PH_R_SC1, layer); LAUNCH(PH_R_SC2, layer); LAUNCH(PH_R_OUT, layer); LAUNCH(PH_R_WO, layer); }
        LAUNCH(PH_M_NORM, layer); LAUNCH(PH_M_SEL, layer); LAUNCH(PH_M_G1, layer); LAUNCH(PH_M_G2, layer); if ((layer & 1) == 0) LAUNCH(PH_M_COMB, layer);
    }
    LAUNCH(PH_FINAL, 0);
#endif
}
```

```cpp
#include <hip/hip_runtime.h>
#include <stdint.h>
#include <stdio.h>

#ifndef ONE_LAUNCH
#define ONE_LAUNCH 1
#endif

#define NTHR 512
typedef unsigned short bf16_t;
typedef short bf16x8 __attribute__((ext_vector_type(8)));
typedef float f32x4 __attribute__((ext_vector_type(4)));
typedef unsigned u32x4 __attribute__((ext_vector_type(4)));
typedef unsigned u32x2 __attribute__((ext_vector_type(2)));

constexpr int D = 1024, NB = 4, TL = 4096, TC = 256, NLAT = NB * TL, NCTX = NB * TC, NROW = NLAT + NCTX;
constexpr int TK = TL + TC;
constexpr int NE = 16, FF = 1408, CAPL = 512, CAPC = 32, ESLOTS = NB * CAPL + NB * CAPC;
constexpr int EPAD = 2304;
constexpr float RMS_EPS = 1e-6f, LNX_EPS = 64e-5f;
constexpr float ATT_SCALE = 0.07216878364870322f;

constexpr size_t al256(size_t x) { return (x + 255) / 256 * 256; }
constexpr size_t OFF_BAR = 0;
constexpr size_t OFF_QUEUE = 14336;
constexpr size_t OFF_MOD = 16384;
constexpr size_t OFF_ROPE_C = OFF_MOD + al256(4 * 5 * 6144 * 4);
constexpr size_t OFF_ROPE_S = OFF_ROPE_C + al256(TL * 32 * 4);
constexpr size_t OFF_X = OFF_ROPE_S + al256(TL * 32 * 4);
constexpr size_t SZ_F32 = (size_t)NROW * D * 4, SZ_BF = (size_t)NROW * D * 2;
constexpr size_t OFF_VFIRST = OFF_X + SZ_BF;
constexpr size_t OFF_H = OFF_VFIRST + SZ_BF;
constexpr size_t SZ_WMLA = (size_t)(512 * 1024 + 1536 * 256 + 2048 * 256 + 1024 * 1024) * 2;
constexpr size_t WM_IN = 0, WM_UQ = (size_t)512 * 1024 * 2, WM_UKV = WM_UQ + (size_t)1536 * 256 * 2, WM_O = WM_UKV + (size_t)2048 * 256 * 2;
constexpr size_t SZ_WRW = (size_t)(3 * 1024 * 1024 + 4 * 256 * 1024 + 1024 * 1024 + 4096 * 256 + 2048 * 256) * 2;
constexpr size_t WR_RKV = 0, WR_L = (size_t)3 * 1024 * 1024 * 2, WR_O = WR_L + (size_t)4 * 256 * 1024 * 2, WR_B2 = WR_O + (size_t)1024 * 1024 * 2, WR_B3 = WR_B2 + (size_t)4096 * 256 * 2;
constexpr size_t OFF_WMLA = OFF_H + SZ_BF;
constexpr size_t OFF_WRW = OFF_WMLA + 2 * SZ_WMLA;
constexpr size_t OFF_W13T = OFF_WRW + 2 * SZ_WRW;
constexpr size_t OFF_W2T = OFF_W13T + (size_t)NE * 2816 * D * 2;
constexpr size_t SZ_WMOE = (size_t)NE * 2816 * D * 2 + (size_t)NE * D * FF * 2;
constexpr size_t OFF_S = OFF_W13T + 2 * SZ_WMOE;
constexpr size_t OFF_Z = OFF_S;
constexpr size_t OFF_CQN = OFF_Z + al256((size_t)NROW * 512 * 4);
constexpr size_t OFF_CKVN = OFF_CQN + al256((size_t)NROW * 256 * 2);
constexpr size_t OFF_KR = OFF_CKVN + al256((size_t)NROW * 256 * 2);
constexpr size_t OFF_QRAW = OFF_KR + al256((size_t)NROW * 64 * 4);
constexpr size_t OFF_KVRAW = OFF_QRAW + al256((size_t)NROW * 1536 * 4);
constexpr size_t OFF_Q = OFF_KVRAW + al256((size_t)NROW * 2048 * 4);
constexpr size_t OFF_K = OFF_Q + al256((size_t)NB * 8 * TK * 192 * 2);
constexpr size_t OFF_V = OFF_K + al256((size_t)NB * 8 * TK * 192 * 2);
constexpr size_t OFF_O = OFF_V + al256((size_t)NB * 8 * TK * 128 * 2);
constexpr size_t END_MLA = OFF_O + SZ_BF;
constexpr size_t OFF_XS = OFF_S;
constexpr size_t OFF_RKV = OFF_XS + 6 * SZ_BF;
constexpr size_t OFF_W = OFF_RKV + 3 * SZ_BF;
constexpr size_t OFF_AV = OFF_W + 2 * SZ_F32;
constexpr size_t OFF_G = OFF_AV + 2 * SZ_BF;
constexpr size_t OFF_A2 = OFF_G + SZ_BF;
constexpr size_t OFF_A3 = OFF_A2 + al256((size_t)NROW * 256 * 2);
constexpr size_t END_RW = OFF_A3 + al256((size_t)NROW * 256 * 2);
constexpr size_t OFF_Y = OFF_XS;
constexpr int NCHK = (TC + TL) / 64;
constexpr size_t OFF_CK = END_RW;
constexpr size_t OFF_BS = OFF_CK + (size_t)128 * NCHK * 4 * 4096 * 2;
constexpr size_t END_RW2 = OFF_BS + (size_t)2 * NROW * 16 * 4;
constexpr size_t OFF_AFF = OFF_S;
constexpr size_t OFF_ROWIDX = OFF_AFF + al256((size_t)NROW * 16 * 4);
constexpr size_t OFF_GATE = OFF_ROWIDX + al256((size_t)NE * ESLOTS * 4);
constexpr size_t OFF_SLOT = OFF_GATE + al256((size_t)NE * EPAD * 4);
constexpr size_t OFF_XE = OFF_SLOT + al256((size_t)NROW * 16 * 4);
constexpr size_t OFF_HID = OFF_XE + al256((size_t)NE * EPAD * D * 2);
constexpr size_t OFF_YE = OFF_HID + al256((size_t)NE * EPAD * FF * 2);
constexpr size_t END_MOE = OFF_YE + al256((size_t)NE * EPAD * D * 2);
constexpr size_t WS_NEED = END_RW2 > END_MLA ? (END_RW2 > END_MOE ? END_RW2 : END_MOE) : (END_MLA > END_MOE ? END_MLA : END_MOE);

constexpr int LDS_BYTES = 152064;

struct Params {
    const float *x, *c, *ctx, *c_ctx, *mod_w, *mod_b, *norm1_g, *norm2_g, *final_g;
    const float *mla_w_in, *mla_g_q, *mla_g_kv, *mla_w_uq, *mla_w_ukv, *mla_w_o;
    const float *rw_mu, *rw_w_rkv, *rw_w0, *rw_w1, *rw_w2, *rw_a0, *rw_a1, *rw_a2, *rw_v0, *rw_v1, *rw_v2, *rw_g1, *rw_g2, *rw_k_k, *rw_k_a, *rw_r_k, *rw_lnx_g, *rw_lnx_b, *rw_w_o;
    const float *moe_router, *moe_w1, *moe_w3, *moe_w2;
    float* out; char* ws;
    int wv, pad_;
};

__device__ __forceinline__ int bidx() { int t = blockIdx.x; asm volatile("" : "+s"(t)); return t; }
__device__ __forceinline__ int gdim() { int t = gridDim.x; asm volatile("" : "+s"(t)); return t; }
__device__ __forceinline__ int tidx_w(int wv) { int l; asm volatile("v_mbcnt_lo_u32_b32 %0, -1, 0\n\tv_mbcnt_hi_u32_b32 %0, -1, %0" : "=v"(l)); return (wv << 6) | l; }
#define tidx() tidx_w(p.wv)
#define XB_TMO      128
#define XB_XCNT(j)  (256  + 64 * (j))
#define XB_XSUB(j)  (1280 + 64 * (j))
#define XB_XGEN(j)  (2304 + 64 * (j))
#define XB_TOP      3328
#define XB_TOPGEN   3392
#define XCD_BAR_WORDS 3456
#define XB_SPIN_CAP (1u << 22)
#define LAS __attribute__((address_space(3)))

__device__ __forceinline__ unsigned xb_ld(unsigned* p)              { return __hip_atomic_load(p, __ATOMIC_RELAXED, __HIP_MEMORY_SCOPE_AGENT); }
__device__ __forceinline__ unsigned xb_add(unsigned* p, unsigned v) { return __hip_atomic_fetch_add(p, v, __ATOMIC_RELAXED, __HIP_MEMORY_SCOPE_AGENT); }
__device__ __forceinline__ unsigned xb_xcc_id() { return (unsigned)__builtin_amdgcn_s_getreg((3 << 11) | 20) & 0xFu; }
#define XB_SPIN(cond, bar) do { unsigned _sp = 0; while (cond) { __builtin_amdgcn_s_sleep(1); \
    if ((++_sp & 255u) == 0u) { if (xb_ld(&(bar)[XB_TMO])) break; if (_sp > XB_SPIN_CAP) { atomicAdd(&(bar)[XB_TMO], 1u); break; } } } } while (0)

struct XcdBarrier { unsigned* bar; unsigned x; volatile LAS unsigned* st; };

__device__ __forceinline__ XcdBarrier xcd_barrier_post(unsigned* bar, volatile LAS unsigned* st) {
    XcdBarrier b; b.bar = bar; b.x = xb_xcc_id(); b.st = st;
    if (threadIdx.x == 0) (void)xb_add(&bar[XB_XCNT(b.x)], 1u);
    return b;
}
__device__ __forceinline__ void xcd_barrier_complete(unsigned* bar, unsigned x, unsigned& nloc, unsigned& nx) {
    const unsigned G = gridDim.x * gridDim.y * gridDim.z;
    unsigned sum, cnt, mine, sp = 0u;
    for (;;) {
        sum = 0u; cnt = 0u; mine = 0u;
#pragma unroll
        for (unsigned j = 0; j < 16; ++j) { const unsigned c = xb_ld(&bar[XB_XCNT(j)]); sum += c; cnt += (c > 0u) ? 1u : 0u; mine = (j == x) ? c : mine; }
        if (sum == G) break;
        __builtin_amdgcn_s_sleep(1);
        if ((++sp & 255u) == 0u) { if (xb_ld(&bar[XB_TMO])) break; if (sp > XB_SPIN_CAP) { atomicAdd(&bar[XB_TMO], 1u); break; } }
    }
    nloc = mine > 0u ? mine : 1u; nx = cnt > 0u ? cnt : 1u;
}
__device__ __forceinline__ void xcd_barrier(const XcdBarrier& b) {
    asm volatile("s_waitcnt vmcnt(0)" ::: "memory");
    __syncthreads();
    if (threadIdx.x == 0) {
        unsigned* bar = b.bar;
        __builtin_amdgcn_s_waitcnt(0);
        unsigned nloc = b.st[0], nx = b.st[1];
        if (nloc == 0u) { xcd_barrier_complete(bar, b.x, nloc, nx); b.st[0] = nloc; b.st[1] = nx; }
        const unsigned old = xb_add(&bar[XB_XSUB(b.x)], 1u);
        const unsigned gen = old / nloc;
        if (old + 1u == (gen + 1u) * nloc) {
            __builtin_amdgcn_fence(__ATOMIC_RELEASE, "agent");
            asm volatile("s_waitcnt vmcnt(0)" ::: "memory");
            const unsigned og = xb_add(&bar[XB_TOP], 1u);
            const unsigned tg = og / nx;
            if (og + 1u == (tg + 1u) * nx) xb_add(&bar[XB_TOPGEN], 1u);
            else XB_SPIN(xb_ld(&bar[XB_TOPGEN]) == tg, bar);
            __builtin_amdgcn_fence(__ATOMIC_ACQUIRE, "agent");
            xb_add(&bar[XB_XGEN(b.x)], 1u);
            asm volatile("s_waitcnt vmcnt(0)" ::: "memory");
        } else {
            XB_SPIN(xb_ld(&bar[XB_XGEN(b.x)]) == gen, bar);
            __builtin_amdgcn_fence(__ATOMIC_ACQUIRE, "agent");
            asm volatile("s_waitcnt vmcnt(0)" ::: "memory");
        }
    }
    __syncthreads();
}

__device__ __forceinline__ float bf2f(bf16_t b) { return __uint_as_float(((unsigned)b) << 16); }
typedef float f32x2_ __attribute__((ext_vector_type(2)));
typedef __bf16 bf16x2_ __attribute__((ext_vector_type(2)));
__device__ __forceinline__ unsigned pk2(float lo, float hi) { const f32x2_ v = {lo, hi}; return __builtin_bit_cast(unsigned, __builtin_convertvector(v, bf16x2_)); }
__device__ __forceinline__ bf16_t f2bf(float f) { return (bf16_t)(pk2(f, f) & 0xffffu); }
__device__ __forceinline__ float dpp_sum16(float x) {
    x += __builtin_bit_cast(float, __builtin_amdgcn_update_dpp(0, __builtin_bit_cast(int, x), 0xB1, 0xF, 0xF, true));
    x += __builtin_bit_cast(float, __builtin_amdgcn_update_dpp(0, __builtin_bit_cast(int, x), 0x4E, 0xF, 0xF, true));
    x += __builtin_bit_cast(float, __builtin_amdgcn_update_dpp(0, __builtin_bit_cast(int, x), 0x141, 0xF, 0xF, true));
    x += __builtin_bit_cast(float, __builtin_amdgcn_update_dpp(0, __builtin_bit_cast(int, x), 0x140, 0xF, 0xF, true));
    return x;
}
__device__ __forceinline__ f32x4 ldbf4(const bf16_t* p) { const uint2 w = *(const uint2*)p; return (f32x4){__uint_as_float(w.x << 16), __uint_as_float(w.x & 0xffff0000u), __uint_as_float(w.y << 16), __uint_as_float(w.y & 0xffff0000u)}; }
__device__ __forceinline__ void stbf4(bf16_t* p, f32x4 v) { uint2 w; w.x = pk2(v[0], v[1]); w.y = pk2(v[2], v[3]); *(uint2*)p = w; }
typedef bf16_t xt_t;
__device__ __forceinline__ f32x4 xldv(const xt_t* X, size_t i) { return ldbf4(X + i); }
__device__ __forceinline__ void xstv(xt_t* X, size_t i, f32x4 v) { stbf4(X + i, v); }
__device__ __forceinline__ float4 xld(const xt_t* X, size_t i) { const f32x4 v = ldbf4(X + i); return make_float4(v[0], v[1], v[2], v[3]); }
__device__ __forceinline__ void xst(xt_t* X, size_t i, float4 v) { stbf4(X + i, (f32x4){v.x, v.y, v.z, v.w}); }
__device__ __forceinline__ float wave_sum(float v) {
    v = dpp_sum16(v); const int i = __builtin_bit_cast(int, v);
    return __builtin_bit_cast(float, __builtin_amdgcn_readlane(i, 0)) + __builtin_bit_cast(float, __builtin_amdgcn_readlane(i, 16)) + __builtin_bit_cast(float, __builtin_amdgcn_readlane(i, 32)) + __builtin_bit_cast(float, __builtin_amdgcn_readlane(i, 48));
}
__device__ __forceinline__ float sigmoidf_(float x) { return __builtin_amdgcn_rcpf(1.f + __expf(-x)); }
__device__ __forceinline__ int row_stream(int row) { return row < NLAT ? (row >> 12) : 4; }
__device__ __forceinline__ const float* modp(const Params& p, int layer, int s, int part) { return (const float*)(p.ws + OFF_MOD) + ((size_t)layer * 5 + s) * 6144 + part * 1024; }

struct SgArgs { const bf16_t* A; int lda; size_t strideA; const float* B; int ldb; size_t strideB; int M, N, K, nbatch; };
template <class Epi>
__device__ __forceinline__ void sg_gemm(const Params& p, char* lds, const SgArgs g, const Epi& epi) {
    bf16_t* As = (bf16_t*)lds;
    bf16_t* Bs = As + 128 * 40;
    const int tid = tidx(), wid = tid >> 6, lane = tid & 63;
    const int wr = wid >> 2, wc = wid & 3;
    const int tilesN = (g.N + 127) / 128, tilesM = g.M / 128, per = tilesM * tilesN, ntiles = per * g.nbatch;
    const int ar = tid >> 2, ak = (tid & 3) * 8;
    const int bn = tid & 127, bk = (tid >> 7) * 8;
    for (int tile = bidx(); tile < ntiles; tile += gdim()) {
        const int bt = tile / per, tt = tile % per;
        const int tm = tt / tilesN, tn = tt % tilesN;
        const int m0 = tm * 128, n0 = tn * 128;
        f32x4 acc[4][2];
#pragma unroll
        for (int m = 0; m < 4; ++m)
#pragma unroll
            for (int n = 0; n < 2; ++n) acc[m][n] = (f32x4){0.f, 0.f, 0.f, 0.f};
        const bool bvalid = (n0 + bn) < g.N;
        const bf16_t* ap = g.A + bt * g.strideA + (size_t)(m0 + ar) * g.lda + ak;
        const float* bp = g.B + bt * g.strideB + (size_t)bk * g.ldb + n0 + bn;
        bf16x8 areg; float breg[8];
        areg = *(const bf16x8*)ap;
#pragma unroll
        for (int j = 0; j < 8; ++j) breg[j] = bvalid ? bp[(size_t)j * g.ldb] : 0.f;
        for (int k0 = 0; k0 < g.K; k0 += 32) {
            __syncthreads();
            *(bf16x8*)(As + ar * 40 + ak) = areg;
            { u32x4 w; w.x = pk2(breg[0], breg[1]); w.y = pk2(breg[2], breg[3]); w.z = pk2(breg[4], breg[5]); w.w = pk2(breg[6], breg[7]); *(u32x4*)(Bs + bn * 40 + bk) = w; }
            __syncthreads();
            if (k0 + 32 < g.K) {
                areg = *(const bf16x8*)(ap + k0 + 32);
#pragma unroll
                for (int j = 0; j < 8; ++j) breg[j] = bvalid ? bp[(size_t)(k0 + 32 + j) * g.ldb] : 0.f;
            }
            bf16x8 af[4], bfr[2];
#pragma unroll
            for (int m = 0; m < 4; ++m) af[m] = *(const bf16x8*)(As + (wr * 64 + m * 16 + (lane & 15)) * 40 + (lane >> 4) * 8);
#pragma unroll
            for (int n = 0; n < 2; ++n) bfr[n] = *(const bf16x8*)(Bs + (wc * 32 + n * 16 + (lane & 15)) * 40 + (lane >> 4) * 8);
#pragma unroll
            for (int m = 0; m < 4; ++m)
#pragma unroll
                for (int n = 0; n < 2; ++n) acc[m][n] = __builtin_amdgcn_mfma_f32_16x16x32_bf16(af[m], bfr[n], acc[m][n], 0, 0, 0);
        }
#pragma unroll
        for (int m = 0; m < 4; ++m)
#pragma unroll
            for (int n = 0; n < 2; ++n) {
                const int col = n0 + wc * 32 + n * 16 + (lane & 15);
                if (col < g.N) {
#pragma unroll
                    for (int r = 0; r < 4; ++r) epi(bt, m0 + wr * 64 + m * 16 + (lane >> 4) * 4 + r, col, acc[m][n][r]);
                }
            }
    }
}


namespace g8 {
#define PG8_LAS __attribute__((address_space(3)))
constexpr int BM = 256, BK = 64, HALF = 128, HTB = HALF * BK * 2, STAGE_BYTES = 8 * HTB;
__device__ __forceinline__ int lds_byte(int r, int c) { const int st = (r >> 4) * 2 + (c >> 5), rr = r & 15, cc = c & 31, ob = rr * 64 + cc * 2; return st * 1024 + (ob ^ (((ob >> 9) & 1) << 5)); }
__device__ __forceinline__ void stage_rc(int b, int& R, int& C) { const int st = b / 1024, sb = b % 1024, swz = sb ^ (((sb >> 9) & 1) << 5); R = (st >> 1) * 16 + swz / 64; C = (st & 1) * 32 + (swz % 64) / 2; }
struct Unit { int pm, pn, g; const char* A; const char* B; };
__device__ __forceinline__ int xcd_remap(int L, int nwg) { const int q = nwg / 8, r = nwg % 8, xcd = L % 8, off = L / 8; return (xcd < r ? xcd * (q + 1) : r * (q + 1) + (xcd - r) * q) + off; }

template <class Epi, class Sched>
__device__ __forceinline__ void gemm_phase(const int wv_, PG8_LAS unsigned char* lds, const int K, const Sched& S, const Epi& E) {
    const int tid = tidx_w(wv_), wid = __builtin_amdgcn_readfirstlane(tid >> 6), lane = tid & 63, wr = wid >> 2, wc = wid & 3, fr = lane & 15, fq = lane >> 4;
    const int nt = K / BK;
    unsigned voffA[2];
#pragma unroll
    for (int i = 0; i < 2; ++i) { int R, C; stage_rc(tid * 16 + i * 8192, R, C); voffA[i] = (unsigned)(R * K + C) * 2u; }
    const size_t kstep = (size_t)(BK * 2);
    const size_t hstep = (size_t)HALF * K * 2;
    const unsigned ldsw = (unsigned)wid * 1024u;
    const int aoff = lds_byte(wr * 64 + fr, fq * 8), boff = lds_byte(wc * 32 + fr, fq * 8);
#define PG8_SA(b, h) (((b) * 2 + (h)) * HTB)
#define PG8_SB(b, h) ((4 + (b) * 2 + (h)) * HTB)
#define PG8_STAGE(bufoff, gbase, voff) do { _Pragma("unroll") for (int _i = 0; _i < 2; ++_i) \
        __builtin_amdgcn_global_load_lds((const unsigned*)((const char*)(gbase) + (voff)[_i]), (PG8_LAS unsigned*)(lds + (bufoff) + ldsw + _i * 8192), 16, 0, 0); } while (0)
#define PG8_LDA(dst, b, h) do { _Pragma("unroll") for (int m = 0; m < 4; ++m) _Pragma("unroll") for (int k = 0; k < 2; ++k) dst[m][k] = *(const PG8_LAS bf16x8*)(lds + PG8_SA(b, h) + aoff + m * 2048 + k * 1024); } while (0)
#define PG8_LDB(dst, b, h) do { _Pragma("unroll") for (int n = 0; n < 2; ++n) _Pragma("unroll") for (int k = 0; k < 2; ++k) dst[n][k] = *(const PG8_LAS bf16x8*)(lds + PG8_SB(b, h) + boff + n * 2048 + k * 1024); } while (0)
#define PG8_MMA(ai, bj, At, Bt) do { __builtin_amdgcn_s_setprio(1); _Pragma("unroll") for (int m = 0; m < 4; ++m) _Pragma("unroll") for (int n = 0; n < 2; ++n) _Pragma("unroll") for (int k = 0; k < 2; ++k) \
        acc[ai][bj][m][n] = __builtin_amdgcn_mfma_f32_16x16x32_bf16(Bt[n][k], At[m][k], acc[ai][bj][m][n], 0, 0, 0); __builtin_amdgcn_s_setprio(0); } while (0)
#define PG8_WAIT_V(n) asm volatile("s_waitcnt vmcnt(" #n ")" ::: "memory")
#define PG8_WAIT_L(n) asm volatile("s_waitcnt lgkmcnt(" #n ")" ::: "memory")
#define PG8_BAR __builtin_amdgcn_s_barrier()
#define PG8_SCHED __builtin_amdgcn_sched_barrier(0)
    Unit cur, nxt; int ui = 0;
    if (!S.next(0, cur)) return;
    f32x4 acc[2][2][4][2];
#pragma unroll
    for (int a = 0; a < 2; ++a)
#pragma unroll
        for (int b = 0; b < 2; ++b)
#pragma unroll
            for (int m = 0; m < 4; ++m)
#pragma unroll
                for (int n = 0; n < 2; ++n) acc[a][b][m][n] = (f32x4){0.f, 0.f, 0.f, 0.f};
    bf16x8 At[4][2], B0[2][2], B1[2][2];
    const char* cA = cur.A; const char* cB = cur.B;
    PG8_STAGE(PG8_SB(0, 0), cB, voffA); PG8_STAGE(PG8_SA(0, 0), cA, voffA); PG8_STAGE(PG8_SB(0, 1), cB + hstep, voffA); PG8_STAGE(PG8_SA(0, 1), cA + hstep, voffA);
    if (wr == 1) PG8_BAR;
    PG8_WAIT_V(4); PG8_BAR;
    PG8_STAGE(PG8_SB(1, 0), cB + kstep, voffA); PG8_STAGE(PG8_SA(1, 0), cA + kstep, voffA); PG8_STAGE(PG8_SB(1, 1), cB + hstep + kstep, voffA);
    PG8_WAIT_V(6); PG8_BAR;
    for (;;) {
        const bool has_next = S.next(ui + 1, nxt);
        const char* nA = has_next ? nxt.A : cA; const char* nB = has_next ? nxt.B : cB;
        for (int t = 0; t < nt; t += 2) {
            const bool last = (t == nt - 2);
            const char* a1 = cA + (size_t)(t + 1) * kstep;
            const char* a2 = last ? nA : cA + (size_t)(t + 2) * kstep; const char* b2 = last ? nB : cB + (size_t)(t + 2) * kstep;
            const char* a3 = a2 + kstep; const char* b3 = b2 + kstep;
            PG8_LDB(B0, 0, 0); PG8_SCHED; PG8_LDA(At, 0, 0); PG8_STAGE(PG8_SA(1, 1), a1 + hstep, voffA);
            PG8_WAIT_L(8); PG8_BAR; PG8_WAIT_L(0); PG8_MMA(0, 0, At, B0); PG8_BAR; PG8_SCHED;
            PG8_LDB(B1, 0, 1); PG8_STAGE(PG8_SB(0, 0), b2, voffA);
            PG8_BAR; PG8_WAIT_L(0); PG8_MMA(0, 1, At, B1); PG8_BAR;
            PG8_LDA(At, 0, 1); PG8_STAGE(PG8_SA(0, 0), a2, voffA);
            PG8_BAR; PG8_WAIT_L(0); PG8_MMA(1, 0, At, B0); PG8_BAR; PG8_SCHED;
            PG8_STAGE(PG8_SB(0, 1), b2 + hstep, voffA);
            PG8_WAIT_V(6); PG8_BAR; PG8_MMA(1, 1, At, B1); PG8_BAR;
            PG8_LDB(B0, 1, 0); PG8_SCHED; PG8_LDA(At, 1, 0); PG8_STAGE(PG8_SA(0, 1), a2 + hstep, voffA);
            PG8_WAIT_L(8); PG8_BAR; PG8_WAIT_L(0); PG8_MMA(0, 0, At, B0); PG8_BAR; PG8_SCHED;
            PG8_LDB(B1, 1, 1); PG8_STAGE(PG8_SB(1, 0), b3, voffA);
            PG8_BAR; PG8_WAIT_L(0); PG8_MMA(0, 1, At, B1); PG8_BAR;
            PG8_LDA(At, 1, 1); PG8_STAGE(PG8_SA(1, 0), a3, voffA);
            PG8_BAR; PG8_WAIT_L(0); PG8_MMA(1, 0, At, B0); PG8_BAR; PG8_SCHED;
            PG8_STAGE(PG8_SB(1, 1), b3 + hstep, voffA);
            PG8_WAIT_V(6); PG8_BAR; PG8_MMA(1, 1, At, B1); PG8_BAR;
        }
        E(acc, cur, wr, wc, fr, fq);
        if (!has_next) break;
#pragma unroll
        for (int a = 0; a < 2; ++a)
#pragma unroll
            for (int b = 0; b < 2; ++b)
#pragma unroll
                for (int m = 0; m < 4; ++m)
#pragma unroll
                    for (int n = 0; n < 2; ++n) acc[a][b][m][n] = (f32x4){0.f, 0.f, 0.f, 0.f};
        cur = nxt; cA = nA; cB = nB; ++ui;
    }
    PG8_WAIT_V(0);
    if (wr == 0) PG8_BAR;
    PG8_BAR;
#undef PG8_SA
#undef PG8_SB
#undef PG8_STAGE
#undef PG8_LDA
#undef PG8_LDB
#undef PG8_MMA
#undef PG8_WAIT_V
#undef PG8_WAIT_L
#undef PG8_BAR
#undef PG8_SCHED
}
template <class F> struct EpiRC { F f;
    __device__ __forceinline__ void operator()(const f32x4 (&acc)[2][2][4][2], const Unit& u, int wr, int wc, int fr, int fq) const {
#pragma unroll
        for (int ai = 0; ai < 2; ++ai)
#pragma unroll
            for (int m = 0; m < 4; ++m) { const int row = u.pm * BM + ai * HALF + wr * 64 + m * 16 + fr;
#pragma unroll
                for (int bj = 0; bj < 2; ++bj)
#pragma unroll
                    for (int n = 0; n < 2; ++n) f(u, row, u.pn * BM + bj * HALF + wc * 32 + n * 16 + 4 * fq, acc[ai][bj][m][n]);
                asm volatile("" ::: "memory"); }
    } };
template <class F> __device__ __forceinline__ EpiRC<F> epi_rc(const F& f) { return EpiRC<F>{f}; }
template <class F> struct EpiPair { F f;
    __device__ __forceinline__ void operator()(const f32x4 (&acc)[2][2][4][2], const Unit& u, int wr, int wc, int fr, int fq) const {
#pragma unroll
        for (int ai = 0; ai < 2; ++ai)
#pragma unroll
            for (int m = 0; m < 4; ++m) { const int row = u.pm * BM + ai * HALF + wr * 64 + m * 16 + fr;
#pragma unroll
                for (int n = 0; n < 2; ++n) f(u, row, u.pn * HALF + wc * 32 + n * 16 + 4 * fq, acc[ai][0][m][n], acc[ai][1][m][n]);
                asm volatile("" ::: "memory"); }
    } };
template <class F> __device__ __forceinline__ EpiPair<F> epi_pair(const F& f) { return EpiPair<F>{f}; }
template <class F, class CF, class RF> struct EpiPre { F f; CF cf; RF rf;
    __device__ __forceinline__ void operator()(const f32x4 (&acc)[2][2][4][2], const Unit& u, int wr, int wc, int fr, int fq) const {
        f32x4 cv[2][2]; float rv[2][4];
#pragma unroll
        for (int bj = 0; bj < 2; ++bj)
#pragma unroll
            for (int n = 0; n < 2; ++n) cv[bj][n] = cf(u, u.pn * BM + bj * HALF + wc * 32 + n * 16 + 4 * fq);
#pragma unroll
        for (int ai = 0; ai < 2; ++ai)
#pragma unroll
            for (int m = 0; m < 4; ++m) rv[ai][m] = rf(u, u.pm * BM + ai * HALF + wr * 64 + m * 16 + fr);
#pragma unroll
        for (int ai = 0; ai < 2; ++ai)
#pragma unroll
            for (int m = 0; m < 4; ++m) { const int row = u.pm * BM + ai * HALF + wr * 64 + m * 16 + fr;
#pragma unroll
                for (int bj = 0; bj < 2; ++bj)
#pragma unroll
                    for (int n = 0; n < 2; ++n) f(u, row, u.pn * BM + bj * HALF + wc * 32 + n * 16 + 4 * fq, acc[ai][bj][m][n], cv[bj][n], rv[ai][m]);
                asm volatile("" ::: "memory"); }
    } };
template <class F, class CF, class RF> __device__ __forceinline__ EpiPre<F, CF, RF> epi_pre(const F& f, const CF& cf, const RF& rf) { return EpiPre<F, CF, RF>{f, cf, rf}; }
template <class F, class CF> struct EpiColFirst { F f; CF cf;
    __device__ __forceinline__ void operator()(const f32x4 (&acc)[2][2][4][2], const Unit& u, int wr, int wc, int fr, int fq) const {
#pragma unroll
        for (int bj = 0; bj < 2; ++bj)
#pragma unroll
            for (int n = 0; n < 2; ++n) { const int col = u.pn * BM + bj * HALF + wc * 32 + n * 16 + 4 * fq; const f32x4 cv = cf(u, col);
#pragma unroll
                for (int ai = 0; ai < 2; ++ai)
#pragma unroll
                    for (int m = 0; m < 4; ++m) f(u, u.pm * BM + ai * HALF + wr * 64 + m * 16 + fr, col, acc[ai][bj][m][n], cv);
                asm volatile("" ::: "memory"); }
    } };
template <class F, class CF> __device__ __forceinline__ EpiColFirst<F, CF> epi_colfirst(const F& f, const CF& cf) { return EpiColFirst<F, CF>{f, cf}; }
struct EpiResid { xt_t* X; const float* MOD; int layer;
    __device__ __forceinline__ void operator()(const f32x4 (&acc)[2][2][4][2], const Unit& u, int wr, int wc, int fr, int fq) const {
        const int row0 = u.pm * BM + wr * 64 + fr, col0 = u.pn * BM + wc * 32 + 4 * fq;
        const int strm = row0 < NLAT ? (row0 >> 12) : 4;
        const float* gp = MOD + ((size_t)layer * 5 + strm) * 6144 + 2048 + col0;
        f32x4 gt[2][2];
#pragma unroll
        for (int bj = 0; bj < 2; ++bj)
#pragma unroll
            for (int n = 0; n < 2; ++n) gt[bj][n] = *(const f32x4*)(gp + bj * HALF + n * 16);
#pragma unroll
        for (int ai = 0; ai < 2; ++ai) {
            f32x4 xv[4][2][2];
#pragma unroll
            for (int m = 0; m < 4; ++m)
#pragma unroll
                for (int bj = 0; bj < 2; ++bj)
#pragma unroll
                    for (int n = 0; n < 2; ++n) xv[m][bj][n] = xldv(X, (size_t)(row0 + ai * HALF + m * 16) * D + col0 + bj * HALF + n * 16);
#pragma unroll
            for (int m = 0; m < 4; ++m)
#pragma unroll
                for (int bj = 0; bj < 2; ++bj)
#pragma unroll
                    for (int n = 0; n < 2; ++n) xstv(X, (size_t)(row0 + ai * HALF + m * 16) * D + col0 + bj * HALF + n * 16, xv[m][bj][n] + gt[bj][n] * acc[ai][bj][m][n]);
            asm volatile("" ::: "memory");
        }
    } };
struct BatchSched { const char* A; const char* B; size_t strideA, strideB; int nM, nN, nb, K; int rev = 0;
    __device__ __forceinline__ bool next(int i, Unit& u) const {
        const int nwg = nM * nN * nb; const int L = i * gdim() + (rev ? gdim() - 1 - bidx() : bidx()); if (L >= nwg) return false;
        const int w = xcd_remap(L, nwg); const int per = nM * nN; u.g = w / per; const int r = w % per; u.pm = r / nN; u.pn = r % nN;
        u.A = A + u.g * strideA + (size_t)u.pm * BM * K * 2; u.B = B + u.g * strideB + (size_t)u.pn * BM * K * 2; return true; } };
}

template <class SrcF, class DRow>
__device__ __forceinline__ int cvt_tiles(const int wv_, char* lds, bf16_t* dst, int Kd, int Nd, int nbatch, size_t dstride, const SrcF& src, const DRow& drow, int* rot = nullptr) {
    bf16_t* T = (bf16_t*)lds;
    const int tid = tidx_w(wv_);
    const int tk = Kd / 128, tn = Nd / 64, per = tk * tn, total = per * nbatch;
    {
        int first = bidx() - (rot ? *rot % gdim() : 0); if (first < 0) first += gdim();
        if (rot) *rot += total;
        for (int t = first; t < total; t += gdim()) {
            const int bt = t / per, r = t % per, k0 = (r % tk) * 128, n0 = (r / tk) * 64;
            float4 v[4];
#pragma unroll
            for (int i = 0; i < 4; ++i) { const int k = k0 + i * 32 + (tid >> 4), n = n0 + (tid & 15) * 4; const float* sp = src(bt, k, n); v[i] = sp ? *(const float4*)sp : make_float4(0.f, 0.f, 0.f, 0.f); }
            __syncthreads();
#pragma unroll
            for (int i = 0; i < 4; ++i) { const int k = i * 32 + (tid >> 4), n = (tid & 15) * 4;
                T[(n + 0) * 136 + k] = f2bf(v[i].x); T[(n + 1) * 136 + k] = f2bf(v[i].y); T[(n + 2) * 136 + k] = f2bf(v[i].z); T[(n + 3) * 136 + k] = f2bf(v[i].w); }
            __syncthreads();
            { const int n = tid >> 3, kc = (tid & 7) * 16;
              const u32x4 a = *(const u32x4*)(T + n * 136 + kc), b = *(const u32x4*)(T + n * 136 + kc + 8);
              bf16_t* dp = dst + bt * dstride + (size_t)drow(n0 + n) * Kd + k0 + kc;
              *(u32x4*)dp = a; *(u32x4*)(dp + 8) = b; }
        }
    }
    return 0;
}
__device__ __forceinline__ int moe_cvt(const Params& p, int layer, char* lds, int budget) {
    constexpr int QG = 2, T13 = NE * 8 * 44, TOT = T13 + NE * 11 * 16;
    bf16_t* T = (bf16_t*)lds;
    int* qslot = (int*)(lds + 64 * 136 * 2);
    const int tid = tidx();
    const float* w1 = p.moe_w1 + (size_t)layer * NE * D * FF; const float* w3 = p.moe_w3 + (size_t)layer * NE * D * FF; const float* w2 = p.moe_w2 + (size_t)layer * NE * FF * D;
    bf16_t* W13 = (bf16_t*)(p.ws + OFF_W13T + (size_t)(layer & 1) * SZ_WMOE); bf16_t* W2 = (bf16_t*)(p.ws + OFF_W2T + (size_t)(layer & 1) * SZ_WMOE);
    unsigned* queue = (unsigned*)(p.ws + OFF_QUEUE) + layer * 32;
    const bool ahead = budget < 0;
    int done = 0, tnext = 0;
    __syncthreads();
    if (tid == 0) qslot[0] = QG * (int)__hip_atomic_fetch_add(queue, 1u, __ATOMIC_RELAXED, __HIP_MEMORY_SCOPE_AGENT);
    __syncthreads();
    int t0 = __builtin_amdgcn_readfirstlane(qslot[0]);
    while (t0 < TOT && (ahead || done < budget)) {
        const bool more = ahead || done + 1 < budget;
        if (more && tid == 0) tnext = QG * (int)__hip_atomic_fetch_add(queue, 1u, __ATOMIC_RELAXED, __HIP_MEMORY_SCOPE_AGENT);
#pragma unroll 1
        for (int sub = 0; sub < QG; ++sub) {
            const int t = t0 + sub;
            const float* sp; bf16_t* dp; int ss, ds;
            if (t < T13) { const int e = t / 352, r = t % 352, k0 = (r & 7) * 128, n0 = (r >> 3) * 64; const int c0 = (n0 >> 8) * 128 + (n0 & 127);
                sp = (((n0 >> 7) & 1) ? w3 : w1) + ((size_t)e * D + k0) * FF + c0; ss = FF; dp = W13 + ((size_t)e * 2816 + n0) * D + k0; ds = D; }
            else { const int u = t - T13, e = u / 176, r = u % 176, k0 = (r % 11) * 128, n0 = (r / 11) * 64;
                sp = w2 + ((size_t)e * FF + k0) * D + n0; ss = D; dp = W2 + ((size_t)e * D + n0) * FF + k0; ds = FF; }
            float4 v[4];
#pragma unroll
            for (int i = 0; i < 4; ++i) v[i] = *(const float4*)(sp + (size_t)(i * 32 + (tid >> 4)) * ss + (tid & 15) * 4);
            __syncthreads();
#pragma unroll
            for (int i = 0; i < 4; ++i) { const int k = i * 32 + (tid >> 4), n = (tid & 15) * 4;
                T[(n + 0) * 136 + k] = f2bf(v[i].x); T[(n + 1) * 136 + k] = f2bf(v[i].y); T[(n + 2) * 136 + k] = f2bf(v[i].z); T[(n + 3) * 136 + k] = f2bf(v[i].w); }
            if (sub == QG - 1 && tid == 0) qslot[0] = more ? tnext : TOT;
            __syncthreads();
            { const int n = tid >> 3, kc = (tid & 7) * 16;
              const u32x4 a = *(const u32x4*)(T + n * 136 + kc), b = *(const u32x4*)(T + n * 136 + kc + 8);
              bf16_t* o = dp + (size_t)n * ds + kc;
              *(u32x4*)o = a; *(u32x4*)(o + 8) = b; }
        }
        ++done; t0 = __builtin_amdgcn_readfirstlane(qslot[0]);
    }
    __syncthreads();
    return done;
}
__device__ __forceinline__ void bg_cvt(const Params& p, int layer, char* lds, int budget) {
#pragma unroll 1
    for (int l = layer; l < 4 && l <= layer + 1 && budget > 0; ++l) budget -= moe_cvt(p, l, lds, budget);
}
__device__ __forceinline__ bool idle_tail(int nunits) { const int r = nunits % gdim(); return r != 0 && bidx() >= r; }
__device__ void ph_init(const Params& p, char* lds) {
    const int tid = tidx(), gtid = bidx() * NTHR + tid, gsz = gdim() * NTHR;
    xt_t* Xs = (xt_t*)(p.ws + OFF_X);
    const float4* x4 = (const float4*)p.x; const float4* c4 = (const float4*)p.ctx;
    { constexpr int NQ = NROW * 256 / 4;
      auto srcv = [&](int k) { return k < NLAT * 256 ? x4[k] : c4[k - NLAT * 256]; };
      for (int i = gtid; i < NQ; i += gsz) { const float4 t0 = srcv(i), t1 = srcv(i + NQ), t2 = srcv(i + 2 * NQ), t3 = srcv(i + 3 * NQ); xst(Xs, (size_t)4 * i, t0); xst(Xs, (size_t)4 * (i + NQ), t1); xst(Xs, (size_t)4 * (i + 2 * NQ), t2); xst(Xs, (size_t)4 * (i + 3 * NQ), t3); } }
    float* rc = (float*)(p.ws + OFF_ROPE_C); float* rs = (float*)(p.ws + OFF_ROPE_S);
    for (int i = gtid; i < TL * 32; i += gsz) {
        const int t = i >> 5, f = i & 31; const float pos = (float)((f < 16) ? (t >> 6) : (t & 63));
        const float inv = powf(10000.f, -(float)(f & 15) / 16.f); const float ang = pos * inv; rc[2 * i] = cosf(ang); rc[2 * i + 1] = sinf(ang);
    }
    float* sc = (float*)lds;
    float* red = sc + 5 * 1024;
    for (int i = tid; i < 5 * 1024; i += NTHR) { const float v = i < 4096 ? p.c[i] : p.c_ctx[i - 4096]; sc[i] = v / (1.f + expf(-v)); }
    __syncthreads();
    float* MOD = (float*)(p.ws + OFF_MOD);
    for (int item = bidx(); item < 4 * 96; item += gdim()) {
        const int l = item / 96, cg = item % 96, col = tid & 63, n = cg * 64 + col, kg = tid >> 6;
        const float* w = p.mod_w + ((size_t)l * 1024 + kg * 128) * 6144 + n;
        float a0 = 0, a1 = 0, a2 = 0, a3 = 0, a4 = 0;
#pragma unroll 16
        for (int k = 0; k < 128; ++k) { const float wv = w[(size_t)k * 6144]; const int kk = kg * 128 + k;
            a0 += sc[kk] * wv; a1 += sc[1024 + kk] * wv; a2 += sc[2048 + kk] * wv; a3 += sc[3072 + kk] * wv; a4 += sc[4096 + kk] * wv; }
        float* rr = red + (kg * 64 + col) * 5; rr[0] = a0; rr[1] = a1; rr[2] = a2; rr[3] = a3; rr[4] = a4;
        __syncthreads();
        if (tid < 320) { const int c2 = tid & 63, s = tid >> 6; float sum = 0;
            for (int q = 0; q < 8; ++q) sum += red[(q * 64 + c2) * 5 + s];
            MOD[((size_t)l * 5 + s) * 6144 + cg * 64 + c2] = sum + p.mod_b[l * 6144 + cg * 64 + c2]; }
        __syncthreads();
    }
}


__device__ void ph_small_cvt(const Params& p, char* lds) {
    int rot = 128;
    for (int j = 0; j < 2; ++j) {
        char* wm = p.ws + OFF_WMLA + j * SZ_WMLA; char* wr = p.ws + OFF_WRW + j * SZ_WRW;
        const float* w_in = p.mla_w_in + (size_t)j * D * 448; const float* w_uq = p.mla_w_uq + (size_t)j * 256 * 1536; const float* w_ukv = p.mla_w_ukv + (size_t)j * 128 * 2048; const float* w_o = p.mla_w_o + (size_t)j * D * D;
        cvt_tiles(p.wv, lds, (bf16_t*)(wm + WM_IN), 1024, 512, 1, 0, [=](int, int k, int n) -> const float* { return n < 448 ? w_in + (size_t)k * 448 + n : nullptr; },
                  [=](int n) { if (n < 384 || n >= 448) return n; const int jj = n - 384; return 384 + (jj < 32 ? 2 * jj : 2 * (jj - 32) + 1); }, &rot);
        cvt_tiles(p.wv, lds, (bf16_t*)(wm + WM_UQ), 256, 1536, 1, 0, [=](int, int k, int n) -> const float* { return w_uq + (size_t)k * 1536 + n; },
                  [=](int n) { const int h = n / 192, d = n % 192; if (d < 128) return n; const int jj = d - 128; return h * 192 + 128 + (jj < 32 ? 2 * jj : 2 * (jj - 32) + 1); }, &rot);
        cvt_tiles(p.wv, lds, (bf16_t*)(wm + WM_UKV), 128, 2048, 1, 0, [=](int, int k, int n) -> const float* { return w_ukv + (size_t)k * 2048 + n; }, [=](int n) { return n; }, &rot);
        cvt_tiles(p.wv, lds, (bf16_t*)(wm + WM_O), 1024, 1024, 1, 0, [=](int, int k, int n) -> const float* { return w_o + (size_t)k * D + n; }, [=](int n) { return n; }, &rot);
        const float* w_rkv = p.rw_w_rkv + (size_t)j * 3 * D * D; const float* w1 = p.rw_w1 + (size_t)j * 2 * D * 64; const float* a1 = p.rw_a1 + (size_t)j * 2 * D * 64;
        const float* g1 = p.rw_g1 + (size_t)j * D * 128; const float* v1 = p.rw_v1; const float* rwo = p.rw_w_o + (size_t)j * D * D;
        cvt_tiles(p.wv, lds, (bf16_t*)(wr + WR_RKV), 1024, 1024, 3, (size_t)D * D, [=](int m, int k, int n) -> const float* { return w_rkv + ((size_t)m * D + k) * D + n; }, [=](int n) { return n; }, &rot);
        cvt_tiles(p.wv, lds, (bf16_t*)(wr + WR_L), 1024, 256, 1, 0, [=](int, int k, int n) -> const float* { return n < 128 ? w1 + ((size_t)(n >> 6) * D + k) * 64 + (n & 63) : nullptr; }, [=](int n) { return n; }, &rot);
        cvt_tiles(p.wv, lds, (bf16_t*)(wr + WR_L) + 256 * 1024, 1024, 256, 1, 0, [=](int, int k, int n) -> const float* { return n < 128 ? a1 + ((size_t)(n >> 6) * D + k) * 64 + (n & 63) : nullptr; }, [=](int n) { return n; }, &rot);
        cvt_tiles(p.wv, lds, (bf16_t*)(wr + WR_L) + 2 * 256 * 1024, 1024, 256, 1, 0, [=](int, int k, int n) -> const float* { return n < 128 ? g1 + (size_t)k * 128 + n : nullptr; }, [=](int n) { return n; }, &rot);
        cvt_tiles(p.wv, lds, (bf16_t*)(wr + WR_L) + 3 * 256 * 1024, 1024, 256, 1, 0, [=](int, int k, int n) -> const float* { return n < 32 ? v1 + (size_t)k * 32 + n : nullptr; }, [=](int n) { return n; }, &rot);
        cvt_tiles(p.wv, lds, (bf16_t*)(wr + WR_O), 1024, 1024, 1, 0, [=](int, int k, int n) -> const float* { return rwo + (size_t)k * D + n; }, [=](int n) { return n; }, &rot);
        const float* w2 = p.rw_w2 + (size_t)j * 2 * 64 * D; const float* a2 = p.rw_a2 + (size_t)j * 2 * 64 * D; const float* g2 = p.rw_g2 + (size_t)j * 128 * D; const float* v2 = p.rw_v2;
        cvt_tiles(p.wv, lds, (bf16_t*)(wr + WR_B2), 128, 2048, 2, (size_t)2048 * 128, [=](int bt, int k, int n) -> const float* { const int zz = n >> 10, c = n & 1023, l = k - zz * 64;
            if (l < 0 || l >= 64) return nullptr; return (bt == 0 ? w2 : a2) + ((size_t)zz * 64 + l) * D + c; }, [=](int n) { return n; }, &rot);
        cvt_tiles(p.wv, lds, (bf16_t*)(wr + WR_B3), 128, 1024, 2, (size_t)1024 * 128, [=](int bt, int k, int n) -> const float* {
            if (bt == 0) return g2 + (size_t)k * D + n; return k < 32 ? v2 + (size_t)k * D + n : nullptr; }, [=](int n) { return n; }, &rot);
    }
}

template <bool OUTF32>
__device__ void ph_norm_mod(const Params& p, int layer, const float* g, int part_sh, int part_sc, void* outp) {
    const int wid = tidx() >> 6, lane = tidx() & 63;
    const xt_t* X = (const xt_t*)(p.ws + OFF_X);
    const int w_ = bidx() * 8 + wid, nw_ = gdim() * 8;
    int row = (int)((long long)w_ * NROW / nw_); const int rend = (int)((long long)(w_ + 1) * NROW / nw_);
    float4 nv[4], gm[4], bb[4]; int scur = -1;
    if (row < rend) {
#pragma unroll
        for (int i = 0; i < 4; ++i) nv[i] = xld(X, (size_t)row * D + (lane + i * 64) * 4); }
    for (; row < rend; ++row) {
        const int s = row_stream(row);
        if (s != scur) { scur = s; const float* sh = modp(p, layer, s, part_sh); const float* sc = modp(p, layer, s, part_sc);
#pragma unroll
            for (int i = 0; i < 4; ++i) { const int d = (lane + i * 64) * 4; const float4 gg = *(const float4*)(g + d), a = *(const float4*)(sc + d); bb[i] = *(const float4*)(sh + d);
                gm[i] = make_float4(gg.x * (1.f + a.x), gg.y * (1.f + a.y), gg.z * (1.f + a.z), gg.w * (1.f + a.w)); } }
        float4 v[4]; float ss = 0;
#pragma unroll
        for (int i = 0; i < 4; ++i) { v[i] = nv[i]; ss += v[i].x * v[i].x + v[i].y * v[i].y + v[i].z * v[i].z + v[i].w * v[i].w; }
        { const int nrow = row + 1;
          if (nrow < rend) {
#pragma unroll
              for (int i = 0; i < 4; ++i) nv[i] = xld(X, (size_t)nrow * D + (lane + i * 64) * 4); } }
        ss = wave_sum(ss); const float rs = rsqrtf(ss * (1.f / D) + RMS_EPS);
#pragma unroll
        for (int i = 0; i < 4; ++i) {
            const int d = (lane + i * 64) * 4;
            float4 o; o.x = v[i].x * rs * gm[i].x + bb[i].x; o.y = v[i].y * rs * gm[i].y + bb[i].y; o.z = v[i].z * rs * gm[i].z + bb[i].z; o.w = v[i].w * rs * gm[i].w + bb[i].w;
            if (OUTF32) *(float4*)((float*)outp + (size_t)row * D + d) = o;
            else { uint2 w; w.x = pk2(o.x, o.y); w.y = pk2(o.z, o.w); *(uint2*)((bf16_t*)outp + (size_t)row * D + d) = w; }
        }
    }
}

__device__ void ph_mla_mid(const Params& p, int j) {
    const int wid = tidx() >> 6, lane = tidx() & 63;
    const bf16_t* Z = (const bf16_t*)(p.ws + OFF_Z);
    bf16_t* CQN = (bf16_t*)(p.ws + OFF_CQN); bf16_t* CKVN = (bf16_t*)(p.ws + OFF_CKVN); bf16_t* K = (bf16_t*)(p.ws + OFF_K);
    const float* gq = p.mla_g_q + j * 256; const float* gkv = p.mla_g_kv + j * 128;
    const float* rc = (const float*)(p.ws + OFF_ROPE_C); const float* rs = (const float*)(p.ws + OFF_ROPE_S);
    for (int row = bidx() * 8 + wid; row < NROW; row += gdim() * 8) {
        const bf16_t* z = Z + (size_t)row * 512;
        const f32x4 q4 = ldbf4(z + lane * 4); const float4 q = make_float4(q4[0], q4[1], q4[2], q4[3]);
        const unsigned kvw = *(const unsigned*)(z + 256 + lane * 2); const float2 kv = make_float2(__uint_as_float(kvw << 16), __uint_as_float(kvw & 0xffff0000u));
        const float kr = __uint_as_float((unsigned)z[384 + lane] << 16);
        float sq = wave_sum(q.x * q.x + q.y * q.y + q.z * q.z + q.w * q.w); const float rq = rsqrtf(sq * (1.f / 256.f) + RMS_EPS);
        float sk = wave_sum(kv.x * kv.x + kv.y * kv.y); const float rk = rsqrtf(sk * (1.f / 128.f) + RMS_EPS);
        const float4 g4 = *(const float4*)(gq + lane * 4); const float2 g2 = *(const float2*)(gkv + lane * 2);
        uint2 w; w.x = pk2(q.x * rq * g4.x, q.y * rq * g4.y); w.y = pk2(q.z * rq * g4.z, q.w * rq * g4.w);
        *(uint2*)(CQN + (size_t)row * 256 + lane * 4) = w;
        *(unsigned*)(CKVN + (size_t)row * 128 + lane * 2) = pk2(kv.x * rk * g2.x, kv.y * rk * g2.y);
        float o = kr;
        const float other = __builtin_bit_cast(float, __builtin_amdgcn_update_dpp(0, __builtin_bit_cast(int, kr), 0xB1, 0xF, 0xF, true));
        const bool lat = row < NLAT;
        if (lat) { const int t = row & (TL - 1), i = lane >> 1; const float2 cs = *(const float2*)(rc + (t * 32 + i) * 2); const float c = cs.x, s = cs.y;
            o = (lane & 1) ? (other * s + kr * c) : (kr * c - other * s); }
        const int b = lat ? (row >> 12) : ((row - NLAT) >> 8); const int tk = lat ? 256 + (row & (TL - 1)) : ((row - NLAT) & 255);
        const bf16_t ob = f2bf(o);
#pragma unroll
        for (int h = 0; h < 8; ++h) K[((size_t)(b * 8 + h) * TK + tk) * 192 + 128 + lane] = ob;
    }
}

__device__ void ph_qkv_post(const Params& p) {
    const int wid = tidx() >> 6, lane = tidx() & 63;
    const float* QRAW = (const float*)(p.ws + OFF_QRAW); const float* KVRAW = (const float*)(p.ws + OFF_KVRAW); const float* KR = (const float*)(p.ws + OFF_KR);
    bf16_t* Q = (bf16_t*)(p.ws + OFF_Q); bf16_t* K = (bf16_t*)(p.ws + OFF_K); bf16_t* V = (bf16_t*)(p.ws + OFF_V);
    const float* rc = (const float*)(p.ws + OFF_ROPE_C); const float* rs = (const float*)(p.ws + OFF_ROPE_S);
    for (int it = bidx() * 8 + wid; it < NROW * 8; it += gdim() * 8) {
        const int row = it >> 3, h = it & 7;
        const bool lat = row < NLAT; const int b = lat ? (row >> 12) : ((row - NLAT) >> 8); const int tk = lat ? 256 + (row & (TL - 1)) : ((row - NLAT) & 255);
        const size_t orow = (size_t)(b * 8 + h) * TK + tk;
        const float* q = QRAW + (size_t)row * 1536 + h * 192;
        const float q0 = q[lane], q1 = q[64 + lane]; float q2 = q[128 + lane];
        const auto sw = __builtin_amdgcn_permlane32_swap(__float_as_uint(q2), __float_as_uint(q2), false, false);
        if (lat) { const int t = row & (TL - 1), i = lane & 31; const float c = rc[t * 32 + i], s = rs[t * 32 + i];
            const float x1 = __uint_as_float(sw[0]), x2 = __uint_as_float(sw[1]); q2 = lane < 32 ? (x1 * c - x2 * s) : (x1 * s + x2 * c); }
        bf16_t* qo = Q + orow * 192; qo[lane] = f2bf(q0); qo[64 + lane] = f2bf(q1); qo[128 + lane] = f2bf(q2);
        const float* kv = KVRAW + (size_t)row * 2048 + h * 256;
        bf16_t* ko = K + orow * 192; ko[lane] = f2bf(kv[lane]); ko[64 + lane] = f2bf(kv[64 + lane]); ko[128 + lane] = f2bf(KR[(size_t)row * 64 + lane]);
        bf16_t* vo = V + orow * 128; vo[lane] = f2bf(kv[128 + lane]); vo[64 + lane] = f2bf(kv[192 + lane]);
    }
}

__device__ void ph_attn_naive(const Params& p, char* lds) {
    const int tid = tidx(), qi = tid >> 2, part = tid & 3;
    const bf16_t* Q = (const bf16_t*)(p.ws + OFF_Q); const bf16_t* K = (const bf16_t*)(p.ws + OFF_K); const bf16_t* V = (const bf16_t*)(p.ws + OFF_V);
    bf16_t* O = (bf16_t*)(p.ws + OFF_O);
    bf16_t* Ks = (bf16_t*)lds;
    bf16_t* Vs = Ks + 32 * 192;
    const int nitems = 32 * 34;
    for (int it = bidx(); it < nitems; it += gdim()) {
        const int bh = it / 34, qb = it % 34; const int b = bh >> 3, h = bh & 7;
        const int nkeys = qb < 2 ? TC : TK;
        const int tq = qb * 128 + qi;
        const bf16_t* qp = Q + ((size_t)bh * TK + tq) * 192 + part * 48;
        float q[48];
#pragma unroll
        for (int i = 0; i < 48; ++i) q[i] = bf2f(qp[i]) * ATT_SCALE;
        float o[32];
#pragma unroll
        for (int i = 0; i < 32; ++i) o[i] = 0.f;
        float m = -1e30f, l = 0.f;
        for (int k0 = 0; k0 < nkeys; k0 += 32) {
            __syncthreads();
            {
                const bf16_t* kg = K + ((size_t)bh * TK + k0) * 192; const bf16_t* vg = V + ((size_t)bh * TK + k0) * 128;
                for (int c = tid; c < 768; c += NTHR) *(u32x4*)(Ks + c * 8) = *(const u32x4*)(kg + c * 8);
                *(u32x4*)(Vs + tid * 8) = *(const u32x4*)(vg + tid * 8);
            }
            __syncthreads();
#pragma unroll 1
            for (int kg = 0; kg < 32; kg += 8) {
                float s[8]; float tmax = -1e30f;
#pragma unroll
                for (int kk = 0; kk < 8; ++kk) {
                    const bf16_t* kr = Ks + (kg + kk) * 192 + part * 48; float acc = 0.f;
#pragma unroll
                    for (int i = 0; i < 48; ++i) acc += q[i] * bf2f(kr[i]);
                    acc += __shfl_xor(acc, 1); acc += __shfl_xor(acc, 2);
                    s[kk] = acc; tmax = fmaxf(tmax, acc);
                    asm volatile("" ::: "memory");
                }
                const float mn = fmaxf(m, tmax), alpha = expf(m - mn); m = mn; l *= alpha;
#pragma unroll
                for (int i = 0; i < 32; ++i) o[i] *= alpha;
#pragma unroll
                for (int kk = 0; kk < 8; ++kk) {
                    const float pw = expf(s[kk] - mn); l += pw;
                    const bf16_t* vr = Vs + (kg + kk) * 128 + part * 32;
#pragma unroll
                    for (int i = 0; i < 32; ++i) o[i] += pw * bf2f(vr[i]);
                    asm volatile("" ::: "memory");
                }
            }
        }
        const float rl = 1.f / l;
        const int row = qb < 2 ? (NLAT + b * TC + tq) : (b * TL + tq - TC);
        bf16_t* op = O + (size_t)row * D + h * 128 + part * 32;
#pragma unroll
        for (int i = 0; i < 32; ++i) op[i] = f2bf(o[i] * rl);
    }
}


namespace fa {
using s16x4  = __attribute__((ext_vector_type(4))) short;
using f32x16 = __attribute__((ext_vector_type(16))) float;
constexpr int DQK = 192, DV = 128, KVBLK = 64;
constexpr float THR = 8.f;
constexpr int SHM_V = KVBLK * DV * 2, SHM_K = KVBLK * DQK * 2;
constexpr int SHM_ATTN = 2 * SHM_V + 2 * SHM_K + 8 * 64 * 4;
#define KSWZ(row, colB) ((row) * 384 + ((colB) ^ ((((row) >> 1) & 7) << 4)))
#define SBAR() __builtin_amdgcn_sched_barrier(0)
__device__ __forceinline__ int crow(int r, int hi) { return (r & 3) + 8 * (r >> 2) + 4 * hi; }
__device__ __forceinline__ unsigned cvtpk(float lo, float hi) { unsigned r; asm volatile("v_cvt_pk_bf16_f32 %0, %1, %2" : "=v"(r) : "v"(lo), "v"(hi)); return r; }
__device__ __forceinline__ void partialSM(f32x16& p0, f32x16& p1, float& m_reg, float& mn, float& alpha) {
  constexpr float C = ATT_SCALE * 1.4426950408889634f;
  float pmax = p0[0];
#pragma unroll
  for (int r = 1; r < 16; ++r) pmax = fmaxf(pmax, p0[r]);
#pragma unroll
  for (int r = 0; r < 16; ++r) pmax = fmaxf(pmax, p1[r]);
  { auto rr = __builtin_amdgcn_permlane32_swap(__float_as_uint(pmax), __float_as_uint(pmax), false, false);
    pmax = fmaxf(__uint_as_float(rr[0]), __uint_as_float(rr[1])); }
  if (__builtin_expect(__all(pmax - m_reg <= THR / ATT_SCALE), 1)) { mn = m_reg; alpha = 1.f; }
  else { mn = fmaxf(m_reg, pmax); alpha = __builtin_amdgcn_exp2f((m_reg - mn) * C); m_reg = mn; }
  float mnC = -mn * C;
#pragma unroll
  for (int r = 0; r < 16; ++r) p0[r] = fmaf(p0[r], C, mnC);
#pragma unroll
  for (int r = 0; r < 16; ++r) p1[r] = fmaf(p1[r], C, mnC);
#pragma unroll
  for (int r = 0; r < 16; ++r) p0[r] = __builtin_amdgcn_exp2f(p0[r]);
}
__device__ __forceinline__ void finishSM(f32x16& p0, f32x16& p1, float alpha, float& l_reg, bf16x8& pa0, bf16x8& pa1, bf16x8& pa2, bf16x8& pa3) {
#pragma unroll
  for (int r = 0; r < 16; ++r) p1[r] = __builtin_amdgcn_exp2f(p1[r]);
  float ps = 0;
#pragma unroll
  for (int r = 0; r < 16; ++r) ps += p0[r];
#pragma unroll
  for (int r = 0; r < 16; ++r) ps += p1[r];
  { auto rr = __builtin_amdgcn_permlane32_swap(__float_as_uint(ps), __float_as_uint(ps), false, false);
    ps = __uint_as_float(rr[0]) + __uint_as_float(rr[1]); }
  l_reg = l_reg * alpha + ps;
#define PK4(P, BASE, OUT) do { unsigned a0 = cvtpk(P[BASE + 0], P[BASE + 1]), a1 = cvtpk(P[BASE + 2], P[BASE + 3]);   \
    unsigned b0 = cvtpk(P[BASE + 4], P[BASE + 5]), b1 = cvtpk(P[BASE + 6], P[BASE + 7]);                              \
    auto r0 = __builtin_amdgcn_permlane32_swap(a0, b0, false, false); auto r1 = __builtin_amdgcn_permlane32_swap(a1, b1, false, false); \
    u32x4 w = {r0[0], r1[0], r0[1], r1[1]}; OUT = *reinterpret_cast<bf16x8*>(&w); } while (0)
  PK4(p0, 0, pa0); PK4(p0, 8, pa1); PK4(p1, 0, pa2); PK4(p1, 8, pa3);
#undef PK4
}
__device__ __forceinline__ void qkt(f32x16& p0, f32x16& p1, const char* Ks, const bf16x8* qr, int r32, int hi) {
  p0 = f32x16{}; p1 = f32x16{};
  const int swz = ((r32 >> 1) & 7) << 4;
  const char* b4[4];
#pragma unroll
  for (int dr = 0; dr < 4; ++dr) b4[dr] = Ks + r32 * 384 + ((dr * 32 + hi * 16) ^ swz);
#pragma unroll
  for (int d0 = 0; d0 < 12; ++d0) {
    bf16x8 b0 = *reinterpret_cast<const bf16x8*>(b4[d0 & 3] + (d0 >> 2) * 128);
    bf16x8 b1 = *reinterpret_cast<const bf16x8*>(b4[d0 & 3] + (d0 >> 2) * 128 + 32 * 384);
    p0 = __builtin_amdgcn_mfma_f32_32x32x16_bf16(b0, qr[d0], p0, 0, 0, 0);
    p1 = __builtin_amdgcn_mfma_f32_32x32x16_bf16(b1, qr[d0], p1, 0, 0, 0); }
}
__device__ __forceinline__ int v_st(int k, int c) { const int kk = (k & ~0xC) | ((k & 4) << 1) | ((k & 8) >> 1); return ((kk >> 3) * 4 + (c >> 5)) * 512 + ((kk & 7) * 32 + (c & 31)) * 2; }
__device__ __forceinline__ int v_rd_base(int lane) { return ((lane & 3) << 3) | (((lane >> 2) & 3) << 6) | (((lane >> 4) & 1) << 5) | (((lane >> 5) & 1) << 8); }
constexpr int v_rd_off(int d0, int ks, int half) { return d0 * 512 + ks * 4096 + half * 2048; }
template <int OFF> __device__ __forceinline__ s16x4 tr_read(int vb) {
  s16x4 r; asm volatile("ds_read_b64_tr_b16 %0, %1 offset:%2" : "=&v"(r) : "v"(vb), "i"(OFF) : "memory"); return r;
}
template <int D0> __device__ __forceinline__ void pv_one(f32x16& od, int vb, bf16x8 pa0, bf16x8 pa1, bf16x8 pa2, bf16x8 pa3) {
  const s16x4 l0 = tr_read<v_rd_off(D0, 0, 0)>(vb), h0 = tr_read<v_rd_off(D0, 0, 1)>(vb), l1 = tr_read<v_rd_off(D0, 1, 0)>(vb), h1 = tr_read<v_rd_off(D0, 1, 1)>(vb);
  const s16x4 l2 = tr_read<v_rd_off(D0, 2, 0)>(vb), h2 = tr_read<v_rd_off(D0, 2, 1)>(vb), l3 = tr_read<v_rd_off(D0, 3, 0)>(vb), h3 = tr_read<v_rd_off(D0, 3, 1)>(vb);
  asm volatile("s_waitcnt lgkmcnt(0)" ::: "memory"); SBAR();
#define PK(L, H) (bf16x8){L[0], L[1], L[2], L[3], H[0], H[1], H[2], H[3]}
  od = __builtin_amdgcn_mfma_f32_32x32x16_bf16(pa0, PK(l0, h0), od, 0, 0, 0);
  od = __builtin_amdgcn_mfma_f32_32x32x16_bf16(pa1, PK(l1, h1), od, 0, 0, 0);
  od = __builtin_amdgcn_mfma_f32_32x32x16_bf16(pa2, PK(l2, h2), od, 0, 0, 0);
  od = __builtin_amdgcn_mfma_f32_32x32x16_bf16(pa3, PK(l3, h3), od, 0, 0, 0);
#undef PK
}
__device__ __forceinline__ void pv_d0(f32x16* o, int vb, bf16x8 pa0, bf16x8 pa1, bf16x8 pa2, bf16x8 pa3) {
  pv_one<0>(o[0], vb, pa0, pa1, pa2, pa3); pv_one<1>(o[1], vb, pa0, pa1, pa2, pa3); pv_one<2>(o[2], vb, pa0, pa1, pa2, pa3); pv_one<3>(o[3], vb, pa0, pa1, pa2, pa3);
}
__device__ __forceinline__ void attn_body(const int wv_, const bf16_t* __restrict__ Qb, const bf16_t* __restrict__ Kh, const bf16_t* __restrict__ Vh, bf16_t* __restrict__ Ob, int ldo, int seq, char* lds, const float* __restrict__ ropecs  ) {
  const int tid = tidx_w(wv_), wid = tid >> 6, lane = tid & 63, r32 = lane & 31, hi = lane >> 5;
  char* V_lds = lds; char* K_lds = lds + 2 * SHM_V;
  float* ws = (float*)(lds + 2 * SHM_V + 2 * SHM_K) + wid * 64; float* li_l = ws; float* al_l = ws + 32;
  float m_reg = -1e30f, l_reg = 0; f32x16 o[4] = {}; bf16x8 qr[12];
  const bf16_t* Qw = Qb + (long)(wid * 32 + r32) * DQK + hi * 8;
#pragma unroll
  for (int d0 = 0; d0 < 12; ++d0) qr[d0] = *reinterpret_cast<const bf16x8*>(Qw + d0 * 16);
  if (ropecs) {
    const float* cs = ropecs + (size_t)(wid * 32 + r32) * 64;
#pragma unroll
    for (int d0 = 8; d0 < 12; ++d0) { const int i0 = (d0 - 8) * 8 + hi * 4; const f32x4 c0 = *(const f32x4*)(cs + i0 * 2), c1 = *(const f32x4*)(cs + i0 * 2 + 4);
      u32x4 w = *reinterpret_cast<u32x4*>(&qr[d0]); const float cc[4] = {c0[0], c0[2], c1[0], c1[2]}, ss[4] = {c0[1], c0[3], c1[1], c1[3]};
#pragma unroll
      for (int m = 0; m < 4; ++m) { const float x1 = __uint_as_float(w[m] << 16), x2 = __uint_as_float(w[m] & 0xffff0000u); w[m] = cvtpk(x1 * cc[m] - x2 * ss[m], x1 * ss[m] + x2 * cc[m]); }
      qr[d0] = *reinterpret_cast<bf16x8*>(&w); }
  }
  const int sr = tid >> 4, sc = (tid & 15) * 8, vst0 = v_st(sr, sc), vst1 = v_st(32 + sr, sc);
  int kst[3];
#pragma unroll
  for (int i = 0; i < 3; ++i) { const int c = tid + 512 * i, row = c / 24, cc = c % 24; kst[i] = KSWZ(row, cc * 16); }
  const int vb0 = (int)(uintptr_t)V_lds + v_rd_base(lane);
  struct { bf16x8 vs0, vs1, ks0, ks1, ks2; } sr_[1];
#define SLOAD(i, k0) do { const bf16_t* vt = Vh + (long)(k0) * DV; const bf16_t* kt = Kh + (long)(k0) * DQK; \
    sr_[i].vs0 = *reinterpret_cast<const bf16x8*>(vt + (sr) * DV + sc); sr_[i].vs1 = *reinterpret_cast<const bf16x8*>(vt + (32 + sr) * DV + sc); \
    sr_[i].ks0 = *reinterpret_cast<const bf16x8*>(kt + tid * 8); sr_[i].ks1 = *reinterpret_cast<const bf16x8*>(kt + (tid + 512) * 8); sr_[i].ks2 = *reinterpret_cast<const bf16x8*>(kt + (tid + 1024) * 8); } while (0)
#define SWRITE(b, i) do { *(bf16x8*)(V_lds + (b) * SHM_V + vst0) = sr_[i].vs0; *(bf16x8*)(V_lds + (b) * SHM_V + vst1) = sr_[i].vs1; \
    *(bf16x8*)(K_lds + (b) * SHM_K + kst[0]) = sr_[i].ks0; *(bf16x8*)(K_lds + (b) * SHM_K + kst[1]) = sr_[i].ks1; *(bf16x8*)(K_lds + (b) * SHM_K + kst[2]) = sr_[i].ks2; } while (0)
#define SWAIT() asm volatile("s_waitcnt vmcnt(5)" ::: "memory")
#define RESC(a) do { if (__any((a) < 1.f)) { if (hi == 0) al_l[r32] = (a); asm volatile("s_waitcnt lgkmcnt(0)" ::: "memory"); \
    _Pragma("unroll") for (int d = 0; d < 4; ++d) _Pragma("unroll") for (int r = 0; r < 16; ++r) o[d][r] *= al_l[crow(r, hi)]; } } while (0)
  f32x16 pA0, pA1; float mnA, alA; bf16x8 pa0, pa1, pa2, pa3; const int NT = seq / KVBLK;
  SLOAD(0, 0); SWRITE(0, 0);
  SLOAD(0, KVBLK);
  __syncthreads();
  for (int j = 0; j < NT; j += 2) {
    SBAR(); qkt(pA0, pA1, K_lds, qr, r32, hi);
    partialSM(pA0, pA1, m_reg, mnA, alA); RESC(alA);
    finishSM(pA0, pA1, alA, l_reg, pa0, pa1, pa2, pa3); SBAR();
    SWRITE(1, 0);
    if (j + 2 < NT) SLOAD(0, (j + 2) * KVBLK);
    SBAR();
    pv_d0(o, vb0, pa0, pa1, pa2, pa3);
    __syncthreads();
    SBAR(); qkt(pA0, pA1, K_lds + SHM_K, qr, r32, hi);
    partialSM(pA0, pA1, m_reg, mnA, alA); RESC(alA);
    finishSM(pA0, pA1, alA, l_reg, pa0, pa1, pa2, pa3); SBAR();
    if (j + 2 < NT) { SWRITE(0, 0); if (j + 3 < NT) SLOAD(0, (j + 3) * KVBLK); }
    SBAR();
    pv_d0(o, vb0 + SHM_V, pa0, pa1, pa2, pa3);
    __syncthreads();
  }
  if (hi == 0) li_l[r32] = l_reg; asm volatile("s_waitcnt lgkmcnt(0)" ::: "memory");
  float rli[16];
#pragma unroll
  for (int r = 0; r < 16; ++r) rli[r] = __builtin_amdgcn_rcpf(li_l[crow(r, hi)]);
  bf16_t* Ow = Ob + (long)(wid * 32) * ldo;
#pragma unroll
  for (int r = 0; r < 16; ++r) { int orow = crow(r, hi);
#pragma unroll
    for (int d0 = 0; d0 < 4; ++d0) Ow[(long)orow * ldo + d0 * 32 + r32] = f2bf(o[d0][r] * rli[r]); }
  __syncthreads();
#undef SLOAD
#undef SWRITE
#undef SWAIT
#undef RESC
}
#undef KSWZ
}

__device__ void ph_attn(const Params& p, char* lds) {
    const bf16_t* Q = (const bf16_t*)(p.ws + OFF_Q); const bf16_t* K = (const bf16_t*)(p.ws + OFF_K); const bf16_t* V = (const bf16_t*)(p.ws + OFF_V);
    bf16_t* O = (bf16_t*)(p.ws + OFF_O);
    const int G = gdim();
    for (int i = 0;; ++i) {
        const int L = i * G + bidx(); if (L >= 544) break;
        int bh, qb;
        if (L < 512) { const int w = g8::xcd_remap(L, 512); bh = w >> 4; qb = 1 + (w & 15); } else { bh = L - 512; qb = 0; }
        const int b = bh >> 3, h = bh & 7;
        const int seq = qb == 0 ? TC : TK;
        const int row0 = qb == 0 ? NLAT + b * TC : b * TL + (qb - 1) * 256;
        fa::attn_body(p.wv, Q + ((size_t)bh * TK + qb * 256) * 192, K + (size_t)bh * TK * 192, V + (size_t)bh * TK * 128, O + (size_t)row0 * D + h * 128, D, seq, lds,
                      qb == 0 ? nullptr : (const float*)(p.ws + OFF_ROPE_C) + (size_t)(qb - 1) * 256 * 64);
    }
}

__device__ void ph_norm2_router(const Params& p, int layer, char* lds, int nrows) {
    const int tid = tidx(), wid = tid >> 6, lane = tid & 63;
    float* rt = (float*)lds;
    const float* rg = p.moe_router + (size_t)layer * D * NE;
    for (int i = tid; i < D * NE / 4; i += NTHR) { const int d = i >> 2, eq = i & 3; ((float4*)rt)[(((d >> 8) * 4 + (d & 3)) * 4 + eq) * 64 + ((d & 255) >> 2)] = ((const float4*)rg)[i]; }
    __syncthreads();
    const xt_t* X = (const xt_t*)(p.ws + OFF_X); bf16_t* BN = (bf16_t*)(p.ws + OFF_H); float* AFF = (float*)(p.ws + OFF_AFF);
    const float* g = p.norm2_g + layer * D;
    const int w_ = bidx() * 8 + wid, nw_ = gdim() * 8;
    int row = (int)((long long)w_ * nrows / nw_); const int rend = (int)((long long)(w_ + 1) * nrows / nw_);
    float4 nv[4], gm[4], bb[4]; int scur = -1;
    if (row < rend) {
#pragma unroll
        for (int i = 0; i < 4; ++i) nv[i] = xld(X, (size_t)row * D + (lane + i * 64) * 4); }
    for (; row < rend; ++row) {
        const int s = row_stream(row);
        if (s != scur) { scur = s; const float* sh = modp(p, layer, s, 3); const float* sc = modp(p, layer, s, 4);
#pragma unroll
            for (int i = 0; i < 4; ++i) { const int d = (lane + i * 64) * 4; const float4 gg = *(const float4*)(g + d), a = *(const float4*)(sc + d); bb[i] = *(const float4*)(sh + d);
                gm[i] = make_float4(gg.x * (1.f + a.x), gg.y * (1.f + a.y), gg.z * (1.f + a.z), gg.w * (1.f + a.w)); } }
        float4 v[4]; float ss = 0;
#pragma unroll
        for (int i = 0; i < 4; ++i) { v[i] = nv[i]; ss += v[i].x * v[i].x + v[i].y * v[i].y + v[i].z * v[i].z + v[i].w * v[i].w; }
        { const int nrow = row + 1;
          if (nrow < rend) {
#pragma unroll
              for (int i = 0; i < 4; ++i) nv[i] = xld(X, (size_t)nrow * D + (lane + i * 64) * 4); } }
        ss = wave_sum(ss); const float rs = rsqrtf(ss * (1.f / D) + RMS_EPS);
        float lg[16];
#pragma unroll
        for (int e = 0; e < 16; ++e) lg[e] = 0.f;
#pragma unroll
        for (int i = 0; i < 4; ++i) {
            const int d = (lane + i * 64) * 4;
            float o[4]; o[0] = v[i].x * rs * gm[i].x + bb[i].x; o[1] = v[i].y * rs * gm[i].y + bb[i].y; o[2] = v[i].z * rs * gm[i].z + bb[i].z; o[3] = v[i].w * rs * gm[i].w + bb[i].w;
            uint2 w; w.x = pk2(o[0], o[1]); w.y = pk2(o[2], o[3]); *(uint2*)(BN + (size_t)row * D + d) = w;
#pragma unroll
            for (int jj = 0; jj < 4; ++jj) {
#pragma unroll
                for (int eq = 0; eq < 4; ++eq) { const float4 r4 = ((const float4*)rt)[((i * 4 + jj) * 4 + eq) * 64 + lane];
                    lg[4 * eq] += o[jj] * r4.x; lg[4 * eq + 1] += o[jj] * r4.y; lg[4 * eq + 2] += o[jj] * r4.z; lg[4 * eq + 3] += o[jj] * r4.w; } }
            asm volatile("" ::: "memory");
        }
        float mx = -1e30f;
#pragma unroll
        for (int e = 0; e < 16; ++e) { lg[e] = wave_sum(lg[e]); mx = fmaxf(mx, lg[e]); }
        float sum = 0;
#pragma unroll
        for (int e = 0; e < 16; ++e) { lg[e] = expf(lg[e] - mx); sum += lg[e]; }
        const float inv = 1.f / sum;
        if (lane < 16) { float val = 0;
#pragma unroll
            for (int e = 0; e < 16; ++e) val = (lane == e) ? lg[e] : val;
            AFF[(size_t)row * 16 + lane] = val * inv; }
    }
}

__device__ void ph_norm2_router_mm(const Params& p, int layer, char* lds, int nrows) {
    typedef __attribute__((address_space(3))) char lch;
    constexpr int PB = 2064;
    constexpr int O_RH = 0, O_RL = 16 * PB, O_A = 32 * PB, A_BUF = 16 * PB, O_P = O_A + 2 * A_BUF, P_BUF = 8 * 8 * 16 * 4;
    const int tid = tidx(), wid = __builtin_amdgcn_readfirstlane(tid >> 6), lane = tid & 63;
    lch* L = (lch*)lds;
    const float* rg = p.moe_router + (size_t)layer * D * NE;
    for (int i = tid; i < D * NE / 4; i += NTHR) { const int d = i >> 2, eq = i & 3; const float4 r4 = ((const float4*)rg)[i]; const float rr[4] = {r4.x, r4.y, r4.z, r4.w};
#pragma unroll
        for (int u = 0; u < 4; ++u) { const unsigned h = pk2(rr[u], rr[u]) & 0xffffu; const float lo = rr[u] - __uint_as_float(h << 16);
            *(LAS bf16_t*)(L + O_RH + (4 * eq + u) * PB + d * 2) = (bf16_t)h; *(LAS bf16_t*)(L + O_RL + (4 * eq + u) * PB + d * 2) = f2bf(lo); } }
    const xt_t* X = (const xt_t*)(p.ws + OFF_X); bf16_t* BN = (bf16_t*)(p.ws + OFF_H); float* AFF = (float*)(p.ws + OFF_AFF);
    const float* g = p.norm2_g + layer * D;
    const int nch = nrows / 8;
    int ch = (int)((long long)bidx() * nch / gdim()); const int chend = (int)((long long)(bidx() + 1) * nch / gdim());
    float4 nv[4], gm[4], bb[4]; int scur = -1;
    if (ch < chend) {
#pragma unroll
        for (int i = 0; i < 4; ++i) nv[i] = xld(X, (size_t)(ch * 8 + wid) * D + (lane + i * 64) * 4); }
    for (int it = 0; ch < chend; ++ch, ++it) {
        const int row = ch * 8 + wid, buf = it & 1;
        const int s = row_stream(row);
        if (s != scur) { scur = s; const float* sh = modp(p, layer, s, 3); const float* sc = modp(p, layer, s, 4);
#pragma unroll
            for (int i = 0; i < 4; ++i) { const int d = (lane + i * 64) * 4; const float4 gg = *(const float4*)(g + d), a = *(const float4*)(sc + d); bb[i] = *(const float4*)(sh + d);
                gm[i] = make_float4(gg.x * (1.f + a.x), gg.y * (1.f + a.y), gg.z * (1.f + a.z), gg.w * (1.f + a.w)); } }
        float4 v[4]; float ss = 0;
#pragma unroll
        for (int i = 0; i < 4; ++i) { v[i] = nv[i]; ss += v[i].x * v[i].x + v[i].y * v[i].y + v[i].z * v[i].z + v[i].w * v[i].w; }
        if (ch + 1 < chend) {
#pragma unroll
            for (int i = 0; i < 4; ++i) nv[i] = xld(X, (size_t)(row + 8) * D + (lane + i * 64) * 4); }
        ss = wave_sum(ss); const float rs = rsqrtf(ss * (1.f / D) + RMS_EPS);
        lch* AH = L + O_A + buf * A_BUF + wid * PB; lch* AL = AH + 8 * PB;
#pragma unroll
        for (int i = 0; i < 4; ++i) {
            const int d = (lane + i * 64) * 4;
            float o[4]; o[0] = v[i].x * rs * gm[i].x + bb[i].x; o[1] = v[i].y * rs * gm[i].y + bb[i].y; o[2] = v[i].z * rs * gm[i].z + bb[i].z; o[3] = v[i].w * rs * gm[i].w + bb[i].w;
            u32x2 wh; wh.x = pk2(o[0], o[1]); wh.y = pk2(o[2], o[3]);
            uint2 wg_; wg_.x = wh.x; wg_.y = wh.y; *(uint2*)(BN + (size_t)row * D + d) = wg_;
            u32x2 wl; wl.x = pk2(o[0] - __uint_as_float(wh.x << 16), o[1] - __uint_as_float(wh.x & 0xffff0000u)); wl.y = pk2(o[2] - __uint_as_float(wh.y << 16), o[3] - __uint_as_float(wh.y & 0xffff0000u));
            *(LAS u32x2*)(AH + d * 2) = wh; *(LAS u32x2*)(AL + d * 2) = wl;
        }
        __syncthreads();
        {
            f32x4 acc = {0.f, 0.f, 0.f, 0.f};
            const lch* ah = L + O_A + buf * A_BUF + (lane & 7) * PB + (128 * wid + 8 * (lane >> 4)) * 2;
            const lch* bh = L + O_RH + (lane & 15) * PB + (128 * wid + 8 * (lane >> 4)) * 2;
#pragma unroll
            for (int ks = 0; ks < 4; ++ks) {
                const bf16x8 a_h = *(const LAS bf16x8*)(ah + ks * 64), a_l = *(const LAS bf16x8*)(ah + 8 * PB + ks * 64);
                const bf16x8 b_h = *(const LAS bf16x8*)(bh + ks * 64), b_l = *(const LAS bf16x8*)(bh + 16 * PB + ks * 64);
                acc = __builtin_amdgcn_mfma_f32_16x16x32_bf16(a_h, b_h, acc, 0, 0, 0);
                acc = __builtin_amdgcn_mfma_f32_16x16x32_bf16(a_h, b_l, acc, 0, 0, 0);
                acc = __builtin_amdgcn_mfma_f32_16x16x32_bf16(a_l, b_h, acc, 0, 0, 0);
            }
            if (lane < 32) {
#pragma unroll
                for (int e = 0; e < 4; ++e) *(LAS float*)(L + O_P + buf * P_BUF + ((wid * 8 + 4 * (lane >> 4) + e) * 16 + (lane & 15)) * 4) = acc[e]; }
        }
        __syncthreads();
        if (tid < 128) {
            float lg = 0.f;
#pragma unroll
            for (int w8 = 0; w8 < 8; ++w8) lg += *(const LAS float*)(L + O_P + buf * P_BUF + (w8 * 128 + tid) * 4);
            float mx = lg;
            mx = fmaxf(mx, __builtin_bit_cast(float, __builtin_amdgcn_update_dpp(0, __builtin_bit_cast(int, mx), 0xB1, 0xF, 0xF, true)));
            mx = fmaxf(mx, __builtin_bit_cast(float, __builtin_amdgcn_update_dpp(0, __builtin_bit_cast(int, mx), 0x4E, 0xF, 0xF, true)));
            mx = fmaxf(mx, __builtin_bit_cast(float, __builtin_amdgcn_update_dpp(0, __builtin_bit_cast(int, mx), 0x141, 0xF, 0xF, true)));
            mx = fmaxf(mx, __builtin_bit_cast(float, __builtin_amdgcn_update_dpp(0, __builtin_bit_cast(int, mx), 0x140, 0xF, 0xF, true)));
            const float ex = expf(lg - mx); const float sum = dpp_sum16(ex);
            AFF[(size_t)(ch * 8) * 16 + tid] = ex / sum;
        }
    }
}

__device__ void ph_select(const Params& p, char* lds, int ngroups) {
    const int tid = tidx(), wid = tid >> 6, lane = tid & 63;
    unsigned* hist = (unsigned*)lds;
    unsigned* ctl = hist + 256;
    unsigned* wsum = ctl + 8;
    int* rowl = (int*)(wsum + 16);
    const float* AFF = (const float*)(p.ws + OFF_AFF);
    int* ROWIDX = (int*)(p.ws + OFF_ROWIDX); float* GATE = (float*)(p.ws + OFF_GATE); int* SLOT = (int*)(p.ws + OFF_SLOT);
    for (int gidx = bidx(); gidx < ngroups; gidx += gdim()) {
        const bool lat = gidx < 64; const int b = (gidx & 63) >> 4, e = gidx & 15;
        const int n = lat ? TL : TC, cap = lat ? CAPL : CAPC;
        const int row0 = lat ? b * TL : NLAT + b * TC, slot0 = lat ? b * CAPL : NB * CAPL + b * CAPC;
        unsigned key[8];
#pragma unroll
        for (int i = 0; i < 8; ++i) { const int idx = tid * 8 + i; key[i] = idx < n ? __float_as_uint(AFF[(size_t)(row0 + idx) * 16 + e]) : 0u; }
        unsigned prefix = 0u, remaining = (unsigned)cap;
#pragma unroll
        for (int pass = 0; pass < 4; ++pass) {
            const int sh = 24 - 8 * pass;
            __syncthreads();
            if (tid < 256) hist[tid] = 0u;
            __syncthreads();
#pragma unroll
            for (int i = 0; i < 8; ++i) { const int idx = tid * 8 + i;
                const bool cand = idx < n && (pass == 0 || (key[i] >> (sh + 8)) == prefix);
                if (cand) atomicAdd(&hist[(key[i] >> sh) & 255u], 1u); }
            __syncthreads();
            if (tid < 256) { unsigned gt = 0; for (int jj = tid + 1; jj < 256; ++jj) gt += hist[jj];
                const unsigned mine = hist[tid];
                if (gt < remaining && remaining <= gt + mine) { ctl[0] = (unsigned)tid; ctl[1] = remaining - gt; } }
            __syncthreads();
            prefix = (prefix << 8) | ctl[0]; remaining = ctl[1];
        }
        const unsigned T = prefix, m = remaining;
        unsigned cgt = 0, ceq = 0;
#pragma unroll
        for (int i = 0; i < 8; ++i) { const int idx = tid * 8 + i; if (idx < n) { cgt += key[i] > T ? 1u : 0u; ceq += key[i] == T ? 1u : 0u; } }
        auto block_excl = [&](unsigned v) -> unsigned {
            unsigned inc = v;
#pragma unroll
            for (int o = 1; o < 64; o <<= 1) { const unsigned t = (unsigned)__builtin_amdgcn_ds_bpermute((lane - o) << 2, (int)inc); if (lane >= o) inc += t; }
            __syncthreads();
            if (lane == 63) wsum[wid] = inc;
            __syncthreads();
            unsigned base = 0;
#pragma unroll
            for (int w = 0; w < 8; ++w) base += (w < wid) ? wsum[w] : 0u;
            return base + inc - v; };
        unsigned eqbase = block_excl(ceq);
        unsigned nsel = 0; bool sel[8];
#pragma unroll
        for (int i = 0; i < 8; ++i) { const int idx = tid * 8 + i; bool s_ = false;
            if (idx < n) { if (key[i] > T) s_ = true; else if (key[i] == T) { s_ = eqbase < m; ++eqbase; } }
            sel[i] = s_; nsel += s_ ? 1u : 0u; }
        unsigned sbase = block_excl(nsel);
#pragma unroll
        for (int i = 0; i < 8; ++i) { const int idx = tid * 8 + i;
            if (idx < n) {
                if (sel[i]) { const int sl = slot0 + (int)sbase; rowl[sbase] = row0 + idx; ++sbase; ROWIDX[e * ESLOTS + sl] = row0 + idx; GATE[e * EPAD + sl] = __uint_as_float(key[i]); SLOT[(size_t)(row0 + idx) * 16 + e] = sl; }
                else SLOT[(size_t)(row0 + idx) * 16 + e] = -1; } }
        __syncthreads();
        { const bf16_t* BN = (const bf16_t*)(p.ws + OFF_H); bf16_t* XE = (bf16_t*)(p.ws + OFF_XE);
          for (int r = wid; r < cap; r += 32) {
              u32x4 t_[4][2];
#pragma unroll
              for (int u = 0; u < 4; ++u) { const u32x4* src = (const u32x4*)(BN + (size_t)rowl[r + 8 * u] * D); t_[u][0] = src[lane]; t_[u][1] = src[lane + 64]; }
#pragma unroll
              for (int u = 0; u < 4; ++u) { u32x4* dst = (u32x4*)(XE + ((size_t)e * EPAD + slot0 + r + 8 * u) * D); dst[lane] = t_[u][0]; dst[lane + 64] = t_[u][1]; } } }
    }
}

__device__ void ph_gather(const Params& p, int nslots) {
    const int wid = tidx() >> 6, lane = tidx() & 63;
    const int* ROWIDX = (const int*)(p.ws + OFF_ROWIDX); const bf16_t* BN = (const bf16_t*)(p.ws + OFF_H); bf16_t* XE = (bf16_t*)(p.ws + OFF_XE);
    for (int it = bidx() * 8 + wid; it < NE * ESLOTS; it += gdim() * 8) {
        const int e = it / ESLOTS, sl = it % ESLOTS; if (sl >= nslots) continue; const int row = ROWIDX[it];
        const u32x4* src = (const u32x4*)(BN + (size_t)row * D); u32x4* dst = (u32x4*)(XE + ((size_t)e * EPAD + sl) * D);
        dst[lane] = src[lane]; dst[lane + 64] = src[lane + 64];
    }
}

__device__ void ph_combine(const Params& p, int layer, int nrows) {
    const int wid = tidx() >> 6, lane = tidx() & 63;
    const int* SLOT = (const int*)(p.ws + OFF_SLOT); const bf16_t* YE = (const bf16_t*)(p.ws + OFF_YE); xt_t* X = (xt_t*)(p.ws + OFF_X);
    int row = bidx() * 8 + wid;
    int sl = (row < nrows && lane < 16) ? SLOT[(size_t)row * 16 + lane] : -1;
    while (row < nrows) {
        const int nrow = row + gdim() * 8;
        const int sln = (nrow < nrows && lane < 16) ? SLOT[(size_t)nrow * 16 + lane] : -1;
        const float* gt = modp(p, layer, row_stream(row), 5);
        xt_t* xr = X + (size_t)row * D + lane * 8;
        f32x4 xv[4];
#pragma unroll
        for (int i = 0; i < 2; ++i) { xv[2 * i] = xldv(xr, 512 * i); xv[2 * i + 1] = xldv(xr, 512 * i + 4); }
        unsigned long long m = __ballot(sl >= 0);
        float acc[16];
#pragma unroll
        for (int i = 0; i < 16; ++i) acc[i] = 0.f;
        while (m) {
            const int e0 = __builtin_ctzll(m); m &= m - 1; const bool two = m != 0; const int e1 = two ? __builtin_ctzll(m) : e0; if (two) m &= m - 1;
            const int s0 = __builtin_amdgcn_readlane(sl, e0), s1 = __builtin_amdgcn_readlane(sl, e1);
            const bf16_t* y0 = YE + ((size_t)e0 * EPAD + s0) * D + lane * 8; const bf16_t* y1 = YE + ((size_t)e1 * EPAD + s1) * D + lane * 8;
            const u32x4 a0 = *(const u32x4*)y0, a1 = *(const u32x4*)(y0 + 512), b0 = *(const u32x4*)y1, b1 = *(const u32x4*)(y1 + 512);
            const float f1 = two ? 1.f : 0.f;
#pragma unroll
            for (int i = 0; i < 4; ++i) { acc[2 * i] += __uint_as_float(a0[i] << 16) + f1 * __uint_as_float(b0[i] << 16); acc[2 * i + 1] += __uint_as_float(a0[i] & 0xffff0000u) + f1 * __uint_as_float(b0[i] & 0xffff0000u);
                acc[8 + 2 * i] += __uint_as_float(a1[i] << 16) + f1 * __uint_as_float(b1[i] << 16); acc[8 + 2 * i + 1] += __uint_as_float(a1[i] & 0xffff0000u) + f1 * __uint_as_float(b1[i] & 0xffff0000u); }
        }
#pragma unroll
        for (int i = 0; i < 2; ++i) { const f32x4 g0 = *(const f32x4*)(gt + lane * 8 + 512 * i), g1 = *(const f32x4*)(gt + lane * 8 + 512 * i + 4);
            f32x4 o0 = xv[2 * i], o1 = xv[2 * i + 1];
#pragma unroll
            for (int e = 0; e < 4; ++e) { o0[e] += g0[e] * acc[8 * i + e]; o1[e] += g1[e] * acc[8 * i + 4 + e]; }
            xstv(xr, 512 * i, o0); xstv(xr, 512 * i + 4, o1); }
        row = nrow; sl = sln;
    }
}

template <bool FINAL>
__device__ void ph_comb_norm(const Params& p, int lprev, int layer, int nrows) {
    const int wid = tidx() >> 6, lane = tidx() & 63;
    const int* SLOT = (const int*)(p.ws + OFF_SLOT); const bf16_t* YE = (const bf16_t*)(p.ws + OFF_YE); xt_t* X = (xt_t*)(p.ws + OFF_X);
    bf16_t* H = (bf16_t*)(p.ws + OFF_H);
    const float* g = FINAL ? p.final_g : p.norm1_g + layer * D;
    int row = bidx() * 8 + wid;
    int sl = (row < nrows && lane < 16) ? SLOT[(size_t)row * 16 + lane] : -1;
    while (row < nrows) {
        const int nrow = row + gdim() * 8;
        const int sln = (nrow < nrows && lane < 16) ? SLOT[(size_t)nrow * 16 + lane] : -1;
        const int strm = row_stream(row);
        const float* gt = modp(p, lprev, strm, 5);
        xt_t* xr = X + (size_t)row * D + lane * 8;
        f32x4 xv[4];
#pragma unroll
        for (int i = 0; i < 2; ++i) { xv[2 * i] = xldv(xr, 512 * i); xv[2 * i + 1] = xldv(xr, 512 * i + 4); }
        unsigned long long m = __ballot(sl >= 0);
        float acc[16];
#pragma unroll
        for (int i = 0; i < 16; ++i) acc[i] = 0.f;
        while (m) {
            const int e0 = __builtin_ctzll(m); m &= m - 1; const bool two = m != 0; const int e1 = two ? __builtin_ctzll(m) : e0; if (two) m &= m - 1;
            const int s0 = __builtin_amdgcn_readlane(sl, e0), s1 = __builtin_amdgcn_readlane(sl, e1);
            const bf16_t* y0 = YE + ((size_t)e0 * EPAD + s0) * D + lane * 8; const bf16_t* y1 = YE + ((size_t)e1 * EPAD + s1) * D + lane * 8;
            const u32x4 a0 = *(const u32x4*)y0, a1 = *(const u32x4*)(y0 + 512), b0 = *(const u32x4*)y1, b1 = *(const u32x4*)(y1 + 512);
            const float f1 = two ? 1.f : 0.f;
#pragma unroll
            for (int i = 0; i < 4; ++i) { acc[2 * i] += __uint_as_float(a0[i] << 16) + f1 * __uint_as_float(b0[i] << 16); acc[2 * i + 1] += __uint_as_float(a0[i] & 0xffff0000u) + f1 * __uint_as_float(b0[i] & 0xffff0000u);
                acc[8 + 2 * i] += __uint_as_float(a1[i] << 16) + f1 * __uint_as_float(b1[i] << 16); acc[8 + 2 * i + 1] += __uint_as_float(a1[i] & 0xffff0000u) + f1 * __uint_as_float(b1[i] & 0xffff0000u); }
        }
        float ss = 0.f;
#pragma unroll
        for (int i = 0; i < 2; ++i) { const f32x4 g0 = *(const f32x4*)(gt + lane * 8 + 512 * i), g1 = *(const f32x4*)(gt + lane * 8 + 512 * i + 4);
#pragma unroll
            for (int e = 0; e < 4; ++e) { xv[2 * i][e] += g0[e] * acc[8 * i + e]; xv[2 * i + 1][e] += g1[e] * acc[8 * i + 4 + e]; ss += xv[2 * i][e] * xv[2 * i][e] + xv[2 * i + 1][e] * xv[2 * i + 1][e]; }
            if (!FINAL) { xstv(xr, 512 * i, xv[2 * i]); xstv(xr, 512 * i + 4, xv[2 * i + 1]); } }
        ss = wave_sum(ss); const float rs = rsqrtf(ss * (1.f / D) + RMS_EPS);
        const float* sh = FINAL ? nullptr : modp(p, layer, strm, 0); const float* sc = FINAL ? nullptr : modp(p, layer, strm, 1);
#pragma unroll
        for (int i = 0; i < 2; ++i)
#pragma unroll
            for (int hh = 0; hh < 2; ++hh) { const int d = lane * 8 + 512 * i + 4 * hh; const f32x4 gg = *(const f32x4*)(g + d); f32x4 o = xv[2 * i + hh] * rs * gg;
                if (FINAL) *(f32x4*)(p.out + (size_t)row * D + d) = o;
                else { o = o * (1.f + *(const f32x4*)(sc + d)) + *(const f32x4*)(sh + d); stbf4(H + (size_t)row * D + d, o); } }
        row = nrow; sl = sln;
    }
}

__device__ void ph_rw_normxs(const Params& p, int layer, int j) {
    const int wid = tidx() >> 6, lane = tidx() & 63;
    const xt_t* X = (const xt_t*)(p.ws + OFF_X); bf16_t* XS = (bf16_t*)(p.ws + OFF_XS);
    const float* mu = p.rw_mu + (size_t)j * 6 * D; const float* g = p.norm1_g + layer * D;
    const int w = bidx() * 8 + wid, nw = gdim() * 8;
    const int r0 = (int)((long long)w * NROW / nw), r1 = (int)((long long)(w + 1) * NROW / nw);
    if (r0 >= r1) return;
    float4 um[6][4];
#pragma unroll
    for (int m = 0; m < 6; ++m)
#pragma unroll
        for (int i = 0; i < 4; ++i) um[m][i] = *(const float4*)(mu + m * D + (lane + i * 64) * 4);
    float4 gm[4], bb[4]; int scur = -1;
    float4 hp[4], hc[4], hn[4], raw[4];
#define XS_NORM(dst, src, R) do { const int s_ = row_stream(R); \
        if (s_ != scur) { scur = s_; const float* sh_ = modp(p, layer, s_, 0); const float* sc_ = modp(p, layer, s_, 1); \
            _Pragma("unroll") for (int i = 0; i < 4; ++i) { const int d_ = (lane + i * 64) * 4; const float4 gg_ = *(const float4*)(g + d_), a_ = *(const float4*)(sc_ + d_); bb[i] = *(const float4*)(sh_ + d_); \
                gm[i] = make_float4(gg_.x * (1.f + a_.x), gg_.y * (1.f + a_.y), gg_.z * (1.f + a_.z), gg_.w * (1.f + a_.w)); } } \
        float ss_ = 0.f; \
        _Pragma("unroll") for (int i = 0; i < 4; ++i) ss_ += src[i].x * src[i].x + src[i].y * src[i].y + src[i].z * src[i].z + src[i].w * src[i].w; \
        ss_ = wave_sum(ss_); const float rs_ = rsqrtf(ss_ * (1.f / D) + RMS_EPS); \
        _Pragma("unroll") for (int i = 0; i < 4; ++i) dst[i] = make_float4(src[i].x * rs_ * gm[i].x + bb[i].x, src[i].y * rs_ * gm[i].y + bb[i].y, src[i].z * rs_ * gm[i].z + bb[i].z, src[i].w * rs_ * gm[i].w + bb[i].w); } while (0)
#define XS_RAW(R) do { _Pragma("unroll") for (int i = 0; i < 4; ++i) raw[i] = xld(X, (size_t)(R) * D + (lane + i * 64) * 4); } while (0)
    if (r0 > 0) { XS_RAW(r0 - 1); XS_NORM(hp, raw, r0 - 1); }
    else {
#pragma unroll
        for (int i = 0; i < 4; ++i) hp[i] = make_float4(0.f, 0.f, 0.f, 0.f); }
    XS_RAW(r0); XS_NORM(hc, raw, r0);
    if (r0 + 1 < NROW) XS_RAW(r0 + 1);
    for (int row = r0; row < r1; ++row) {
        const bool lat = row < NLAT; const int t = lat ? (row & (TL - 1)) : ((row - NLAT) & (TC - 1)); const int len = lat ? TL : TC;
        const float fp_ = t > 0 ? 0.5f : 0.f, fn_ = t < len - 1 ? 0.5f : 0.f;
        if (row + 1 < NROW) XS_NORM(hn, raw, row + 1);
        else {
#pragma unroll
            for (int i = 0; i < 4; ++i) hn[i] = make_float4(0.f, 0.f, 0.f, 0.f); }
        if (row + 1 < r1 && row + 2 < NROW) XS_RAW(row + 2);
#pragma unroll
        for (int i = 0; i < 4; ++i) {
            const int d = (lane + i * 64) * 4;
            const float4 h = hc[i];
            const float4 xx = make_float4(fp_ * hp[i].x + fn_ * hn[i].x - h.x, fp_ * hp[i].y + fn_ * hn[i].y - h.y, fp_ * hp[i].z + fn_ * hn[i].z - h.z, fp_ * hp[i].w + fn_ * hn[i].w - h.w);
#pragma unroll
            for (int m = 0; m < 6; ++m) { const float4 u = um[m][i];
                uint2 wv_; wv_.x = pk2(h.x + xx.x * u.x, h.y + xx.y * u.y); wv_.y = pk2(h.z + xx.z * u.z, h.w + xx.w * u.w);
                *(uint2*)(XS + ((size_t)m * NROW + row) * D + d) = wv_; }
        }
#pragma unroll
        for (int i = 0; i < 4; ++i) { hp[i] = hc[i]; hc[i] = hn[i]; }
    }
#undef XS_NORM
#undef XS_RAW
}

__device__ __forceinline__ int scan_row(int i, int b, int z) {
    return i < TC ? NLAT + b * TC + (z ? TC - 1 - i : i) : b * TL + (z ? TL - 1 - (i - TC) : i - TC);
}
__device__ __forceinline__ float dpp_sum8(float x) {
    x += __builtin_bit_cast(float, __builtin_amdgcn_update_dpp(0, __builtin_bit_cast(int, x), 0xB1, 0xF, 0xF, true));
    x += __builtin_bit_cast(float, __builtin_amdgcn_update_dpp(0, __builtin_bit_cast(int, x), 0x4E, 0xF, 0xF, true));
    x += __builtin_bit_cast(float, __builtin_amdgcn_update_dpp(0, __builtin_bit_cast(int, x), 0x141, 0xF, 0xF, true));
    return x;
}
__device__ void ph_rw_scan(const Params& p, int j, char* lds) {
    const int tid = tidx(), wid = __builtin_amdgcn_readfirstlane(tid >> 6), lane = tid & 63;
    const size_t PL = (size_t)NROW * D;
    const float* RKV = (const float*)(p.ws + OFF_RKV); float* Y = (float*)(p.ws + OFF_Y);
    constexpr int CH = 32, BUFB = 5 * CH * 256 + CH * 128 + CH * 16, YB = CH * 32 * 4, NCH = (TC + TL) / CH;
    const bool loader = wid >= 4; const int lw = wid - 4;
    for (int it = bidx(); it < 256; it += gdim()) {
        const int vh = it & 1, z = (it >> 1) & 1, h = (it >> 2) & 15, b = it >> 6;
        const char* pl0 = (const char*)((const float*)(p.ws + OFF_W) + z * PL); const char* pl1 = (const char*)(RKV + PL);
        const char* pl2 = (const char*)((const float*)(p.ws + OFF_AV) + z * PL); const char* pl3 = (const char*)RKV;
        const char* vpl = (const char*)(RKV + 2 * PL);
        float* yout = Y + z * PL;
        __builtin_amdgcn_s_barrier();
        if (loader) {
            const int pq = lane & 15;
            const f32x4 kkv = *(const f32x4*)(p.rw_k_k + j * D + h * 64 + pq * 4), kav = *(const f32x4*)(p.rw_k_a + j * D + h * 64 + pq * 4);
            auto issue = [&](int c) {
                char* buf = lds + (c % 3) * BUFB;
#pragma unroll
                for (int q = 0; q < 8; ++q) { const int pi = q >> 1, tg = lw * 2 + (q & 1); const int row = scan_row(c * CH + tg * 4 + (lane >> 4), b, z);
                    const char* base = pi == 0 ? pl0 : pi == 1 ? pl1 : pi == 2 ? pl2 : pl3;
                    __builtin_amdgcn_global_load_lds((const unsigned*)(base + (size_t)row * D * 4 + h * 256 + (lane & 15) * 16), (LAS unsigned*)(buf + pi * (CH * 256) + tg * 1024), 16, 0, 0); }
                { const int row = scan_row(c * CH + lw * 8 + (lane >> 3), b, z);
                  __builtin_amdgcn_global_load_lds((const unsigned*)(vpl + (size_t)row * D * 4 + (h * 64 + vh * 32) * 4 + (lane & 7) * 16), (LAS unsigned*)(buf + 5 * CH * 256 + lw * 1024), 16, 0, 0); }
            };
            auto prep = [&](int c) {
                char* buf = lds + (c % 3) * BUFB;
#pragma unroll
                for (int ps = 0; ps < 2; ++ps) { const int ptok = lw * 8 + ps * 4 + (lane >> 4);
                    f32x4* kp = (f32x4*)(buf + 1 * CH * 256 + ptok * 256 + pq * 16); f32x4* ap = (f32x4*)(buf + 2 * CH * 256 + ptok * 256 + pq * 16); f32x4* dp = (f32x4*)(buf + 4 * CH * 256 + ptok * 256 + pq * 16);
                    f32x4* rp = (f32x4*)(buf + 3 * CH * 256 + ptok * 256 + pq * 16); const f32x4 wv = *(const f32x4*)(buf + ptok * 256 + pq * 16);
                    const f32x4 k = *kp, a = *ap, r = *rp; f32x4 kk = k * kkv;
                    float ss = kk[0] * kk[0] + kk[1] * kk[1] + kk[2] * kk[2] + kk[3] * kk[3]; ss = dpp_sum16(ss);
                    const float inv = 1.f / fmaxf(sqrtf(ss), 1e-12f); kk = kk * inv;
                    const f32x4 kd = k * (1.f + (a - 1.f) * kav), bb = kk * a;
                    const f32x4 t1 = bb * r, t2 = kd * r;
                    const float br = dpp_sum16((t1[0] + t1[1]) + (t1[2] + t1[3])), kr = dpp_sum16((t2[0] + t2[1]) + (t2[2] + t2[3]));
                    *dp = kd; *ap = bb; *kp = kk; *rp = wv * r;
                    if (pq == 0) *(float2*)(buf + 5 * CH * 256 + CH * 128 + ptok * 16) = make_float2(br, kr); }
            };
            issue(0); issue(1);
            asm volatile("s_waitcnt vmcnt(9)" ::: "memory");
            prep(0);
            asm volatile("s_waitcnt lgkmcnt(0)" ::: "memory"); __builtin_amdgcn_s_barrier();
            for (int c = 0; c < NCH; ++c) {
                if (c >= 1) { const float* yb = (const float*)(lds + 3 * BUFB + ((c - 1) & 1) * YB);
                    const int lt = tid - 256, t = lt >> 3, q = lt & 7; const int row = scan_row((c - 1) * CH + t, b, z);
                    *(f32x4*)(yout + (size_t)row * D + h * 64 + vh * 32 + q * 4) = *(const f32x4*)(yb + t * 32 + q * 4); }
                if (c + 2 < NCH) { issue(c + 2); asm volatile("s_waitcnt vmcnt(9)" ::: "memory"); } else asm volatile("s_waitcnt vmcnt(0)" ::: "memory");
                if (c + 1 < NCH) prep(c + 1);
                asm volatile("s_waitcnt lgkmcnt(0)" ::: "memory"); __builtin_amdgcn_s_barrier();
            }
            { const float* yb = (const float*)(lds + 3 * BUFB + ((NCH - 1) & 1) * YB);
              const int lt = tid - 256, t = lt >> 3, q = lt & 7; const int row = scan_row((NCH - 1) * CH + t, b, z);
              *(f32x4*)(yout + (size_t)row * D + h * 64 + vh * 32 + q * 4) = *(const f32x4*)(yb + t * 32 + q * 4); }
        } else {
            const int vr = lane >> 3, ks = lane & 7;
            f32x4 Sa = {0.f, 0.f, 0.f, 0.f}, Sb = {0.f, 0.f, 0.f, 0.f};
            __builtin_amdgcn_s_barrier();
            struct Ops { f32x4 w0, w1, kk0, kk1, bb0, bb1, r0, r1, kd0, kd1; float v; float2 sc; };
#define SC_LOAD(O, t) do { const char* q_ = bq + (t) * 256; O.w0 = *(const f32x4*)(q_); O.w1 = *(const f32x4*)(q_ + 16); O.kk0 = *(const f32x4*)(q_ + CH * 256); O.kk1 = *(const f32x4*)(q_ + CH * 256 + 16); \
                O.bb0 = *(const f32x4*)(q_ + 2 * CH * 256); O.bb1 = *(const f32x4*)(q_ + 2 * CH * 256 + 16); O.r0 = *(const f32x4*)(q_ + 3 * CH * 256); O.r1 = *(const f32x4*)(q_ + 3 * CH * 256 + 16); \
                O.kd0 = *(const f32x4*)(q_ + 4 * CH * 256); O.kd1 = *(const f32x4*)(q_ + 4 * CH * 256 + 16); O.v = *(const float*)(vq + (t) * 128); O.sc = *(const float2*)(buf + 5 * CH * 256 + CH * 128 + (t) * 16); } while (0)
#define SC_STEP(O, t) do { const f32x4 d1 = Sa * O.kk0 + Sb * O.kk1, d2 = Sa * O.r0 + Sb * O.r1; \
                float sa = -((d1[0] + d1[1]) + (d1[2] + d1[3])), yy = (d2[0] + d2[1]) + (d2[2] + d2[3]); \
                sa = dpp_sum8(sa); yy = dpp_sum8(yy); \
                Sa = Sa * O.w0 + (sa * O.bb0 + O.v * O.kd0); Sb = Sb * O.w1 + (sa * O.bb1 + O.v * O.kd1); \
                if (ks == 0) yb[(t) * 32 + wid * 8 + vr] = yy + sa * O.sc.x + O.v * O.sc.y; } while (0)
            for (int c = 0; c < NCH; ++c) {
                const char* buf = lds + (c % 3) * BUFB; float* yb = (float*)(lds + 3 * BUFB + (c & 1) * YB);
                const char* bq = buf + ks * 32; const char* vq = buf + 5 * CH * 256 + (wid * 8 + vr) * 4;
                Ops oA, oB, oC;
                SC_LOAD(oA, 0); SC_LOAD(oB, 1);
#pragma unroll
                for (int t = 0; t < CH; t += 3) {
                    if (t + 2 < CH) SC_LOAD(oC, t + 2);
                    SC_STEP(oA, t);
                    if (t + 3 < CH) SC_LOAD(oA, t + 3);
                    if (t + 1 < CH) SC_STEP(oB, t + 1);
                    if (t + 4 < CH) SC_LOAD(oB, t + 4);
                    if (t + 2 < CH) SC_STEP(oC, t + 2);
                }
                asm volatile("s_waitcnt lgkmcnt(0)" ::: "memory"); __builtin_amdgcn_s_barrier();
            }
#undef SC_LOAD
#undef SC_STEP
        }
    }
}


namespace ck {
constexpr int P = 72, MB = 64 * P * 2;
typedef __attribute__((address_space(3))) char lchar;
__device__ __forceinline__ f32x4 mm_tile(const lchar* Aop, const lchar* Bop, int ti, int tj, int c, int q, f32x4 acc) {
#pragma unroll
    for (int ks = 0; ks < 2; ++ks) {
        const bf16x8 a = *(const LAS bf16x8*)(Aop + ((16 * ti + c) * P + 32 * ks + 8 * q) * 2);
        const bf16x8 b = *(const LAS bf16x8*)(Bop + ((16 * tj + c) * P + 32 * ks + 8 * q) * 2);
        acc = __builtin_amdgcn_mfma_f32_16x16x32_bf16(a, b, acc, 0, 0, 0);
    }
    return acc;
}
__device__ __forceinline__ f32x4 mm_diag(const lchar* Aop, const lchar* Bop, int tt, int c, int q, f32x4 acc) {
    const int ks = tt >> 1;
    bf16x8 a = *(const LAS bf16x8*)(Aop + ((16 * tt + c) * P + 32 * ks + 8 * q) * 2);
    const bf16x8 b = *(const LAS bf16x8*)(Bop + ((16 * tt + c) * P + 32 * ks + 8 * q) * 2);
    if ((q >> 1) != (tt & 1)) a = (bf16x8){0, 0, 0, 0, 0, 0, 0, 0};
    return __builtin_amdgcn_mfma_f32_16x16x32_bf16(a, b, acc, 0, 0, 0);
}
__device__ __forceinline__ void st_tile(lchar* dst, int ti, int tj, int c, int q, f32x4 v) {
    u32x2 w; w.x = pk2(v[0], v[1]); w.y = pk2(v[2], v[3]); *(LAS u32x2*)(dst + ((16 * tj + c) * P + 16 * ti + 4 * q) * 2) = w;
}
__device__ __forceinline__ f32x4 ld_tile(const lchar* src, int ti, int tj, int c, int q) {
    const u32x2 w = *(const LAS u32x2*)(src + ((16 * tj + c) * P + 16 * ti + 4 * q) * 2);
    return (f32x4){__uint_as_float(w.x << 16), __uint_as_float(w.x & 0xffff0000u), __uint_as_float(w.y << 16), __uint_as_float(w.y & 0xffff0000u)};
}
__device__ __forceinline__ void st_glob(bf16_t* dst, int ti, int tj, int c, int q, f32x4 v) {
    uint2 w; w.x = pk2(v[0], v[1]); w.y = pk2(v[2], v[3]); *(uint2*)(dst + (16 * tj + c) * 64 + 16 * ti + 4 * q) = w;
}
typedef float f32x16 __attribute__((ext_vector_type(16)));
__device__ __forceinline__ f32x16 mm32(const lchar* Aop, const lchar* Bop, int ti, int tj, int r32, int hi, f32x16 acc) {
    bf16x8 a[4], b[4];
#pragma unroll
    for (int ks = 0; ks < 4; ++ks) {
        a[ks] = *(const LAS bf16x8*)(Aop + ((32 * ti + r32) * P + 16 * ks + 8 * hi) * 2);
        b[ks] = *(const LAS bf16x8*)(Bop + ((32 * tj + r32) * P + 16 * ks + 8 * hi) * 2); }
    __builtin_amdgcn_sched_barrier(0);
#pragma unroll
    for (int ks = 0; ks < 4; ++ks) acc = __builtin_amdgcn_mfma_f32_32x32x16_bf16(a[ks], b[ks], acc, 0, 0, 0);
    return acc;
}
__device__ __forceinline__ void st32(lchar* dst, int ti, int tj, int r32, int hi, const f32x16& v) {
#pragma unroll
    for (int g = 0; g < 4; ++g) { u32x2 w; w.x = pk2(v[4 * g], v[4 * g + 1]); w.y = pk2(v[4 * g + 2], v[4 * g + 3]); *(LAS u32x2*)(dst + ((32 * tj + r32) * P + 32 * ti + 8 * g + 4 * hi) * 2) = w; }
}
__device__ __forceinline__ f32x16 ld32(const lchar* src, int ti, int tj, int r32, int hi) {
    f32x16 v;
#pragma unroll
    for (int g = 0; g < 4; ++g) { const u32x2 w = *(const LAS u32x2*)(src + ((32 * tj + r32) * P + 32 * ti + 8 * g + 4 * hi) * 2);
        v[4 * g] = __uint_as_float(w.x << 16); v[4 * g + 1] = __uint_as_float(w.x & 0xffff0000u); v[4 * g + 2] = __uint_as_float(w.y << 16); v[4 * g + 3] = __uint_as_float(w.y & 0xffff0000u); }
    return v;
}
__device__ __forceinline__ void stg32(bf16_t* dst, int ti, int tj, int r32, int hi, const f32x16& v) {
#pragma unroll
    for (int g = 0; g < 4; ++g) { uint2 w; w.x = pk2(v[4 * g], v[4 * g + 1]); w.y = pk2(v[4 * g + 2], v[4 * g + 3]); *(uint2*)(dst + (32 * tj + r32) * 64 + 32 * ti + 8 * g + 4 * hi) = w; }
}
}

#define LBAR() do { asm volatile("s_waitcnt lgkmcnt(0)" ::: "memory"); __builtin_amdgcn_s_barrier(); asm volatile("" ::: "memory"); } while (0)
__device__ void ph_rw_sc1(const Params& p, int j, char* lds) {
    using namespace ck;
    const int tid = tidx(), wid = __builtin_amdgcn_readfirstlane(tid >> 6), lane = tid & 63, c = lane & 15, q = lane >> 4;
    const size_t PL = (size_t)NROW * D;
    const bf16_t* RKV = (const bf16_t*)(p.ws + OFF_RKV); const unsigned short* LW = (const unsigned short*)(p.ws + OFF_W); const bf16_t* AV = (const bf16_t*)(p.ws + OFF_AV);
    bf16_t* CK = (bf16_t*)(p.ws + OFF_CK);
    lchar* B0 = (lchar*)lds;
#define BUF(i) (B0 + (i) * MB)
    LAS float* Lbuf = (LAS float*)BUF(8);
    LAS float* Lseg = (LAS float*)(B0 + 16 * MB);
    LAS float* GC = Lseg + 8 * 64;
    const int pt = tid >> 3, cg = tid & 7;
    f32x4 nkk[2], nka[2]; u32x4 nlw, nkx, nax, nrx, nvx;
#define SC1_LOAD(IT) do { const int seq_ = (IT) / NCHK, ch_ = (IT) % NCHK; const int z_ = seq_ & 1, h_ = (seq_ >> 1) & 15, b_ = seq_ >> 5; \
        const size_t go_ = (size_t)scan_row(ch_ * 64 + pt, b_, z_) * D + h_ * 64 + cg * 8; \
        nlw = *(const u32x4*)(LW + z_ * PL + go_); \
        nkx = *(const u32x4*)(RKV + PL + go_); nax = *(const u32x4*)(AV + z_ * PL + go_); nrx = *(const u32x4*)(RKV + go_); nvx = *(const u32x4*)(RKV + 2 * PL + go_); \
        _Pragma("unroll") for (int e = 0; e < 2; ++e) { nkk[e] = *(const f32x4*)(p.rw_k_k + j * D + h_ * 64 + cg * 8 + 4 * e); nka[e] = *(const f32x4*)(p.rw_k_a + j * D + h_ * 64 + cg * 8 + 4 * e); } } while (0)
    if (bidx() < 128 * NCHK) SC1_LOAD(bidx());
    for (int it = bidx(); it < 128 * NCHK; it += gdim()) {
        const int seq = it / NCHK; const int h = (seq >> 1) & 15;
        f32x4 lw[2], kx[2], ax[2], rx[2], vx[2], kkc[2], kac[2];
#pragma unroll
        for (int e = 0; e < 2; ++e) { constexpr float LWS = -0.6065306597126334f / 65535.f;
            lw[e] = (f32x4){(float)(nlw[2 * e] & 0xffffu) * LWS, (float)(nlw[2 * e] >> 16) * LWS, (float)(nlw[2 * e + 1] & 0xffffu) * LWS, (float)(nlw[2 * e + 1] >> 16) * LWS};
            kkc[e] = nkk[e]; kac[e] = nka[e];
            kx[e] = (f32x4){__uint_as_float(nkx[2 * e] << 16), __uint_as_float(nkx[2 * e] & 0xffff0000u), __uint_as_float(nkx[2 * e + 1] << 16), __uint_as_float(nkx[2 * e + 1] & 0xffff0000u)};
            ax[e] = (f32x4){__uint_as_float(nax[2 * e] << 16), __uint_as_float(nax[2 * e] & 0xffff0000u), __uint_as_float(nax[2 * e + 1] << 16), __uint_as_float(nax[2 * e + 1] & 0xffff0000u)};
            rx[e] = (f32x4){__uint_as_float(nrx[2 * e] << 16), __uint_as_float(nrx[2 * e] & 0xffff0000u), __uint_as_float(nrx[2 * e + 1] << 16), __uint_as_float(nrx[2 * e + 1] & 0xffff0000u)};
            vx[e] = (f32x4){__uint_as_float(nvx[2 * e] << 16), __uint_as_float(nvx[2 * e] & 0xffff0000u), __uint_as_float(nvx[2 * e + 1] << 16), __uint_as_float(nvx[2 * e + 1] & 0xffff0000u)}; }
        f32x4 rkc[2];
#pragma unroll
        for (int e = 0; e < 2; ++e) rkc[e] = *(const f32x4*)(p.rw_r_k + j * D + h * 64 + cg * 8 + 4 * e);
        if (it + gdim() < 128 * NCHK) SC1_LOAD(it + gdim());
        LBAR();
#pragma unroll
        for (int e = 0; e < 2; ++e) *(LAS f32x4*)(Lbuf + pt * 64 + cg * 8 + 4 * e) = lw[e];
        f32x4 kk[2], bq[2], kd[2];
        { float ss = 0.f;
#pragma unroll
          for (int e = 0; e < 2; ++e) { kk[e] = kx[e] * kkc[e]; ss += kk[e][0] * kk[e][0] + kk[e][1] * kk[e][1] + kk[e][2] * kk[e][2] + kk[e][3] * kk[e][3]; }
          ss = dpp_sum8(ss); const float inv = __builtin_amdgcn_rsqf(fmaxf(ss, 1e-24f));
#pragma unroll
          for (int e = 0; e < 2; ++e) { kk[e] = kk[e] * inv; bq[e] = kk[e] * ax[e]; kd[e] = kx[e] * (1.f + (ax[e] - 1.f) * kac[e]); } }
        LBAR();
        { const int k = tid & 63, sg = tid >> 6; float run = 0.f;
#pragma unroll
          for (int u = 0; u < 8; ++u) { run += Lbuf[(sg * 8 + u) * 64 + k]; Lbuf[(sg * 8 + u) * 64 + k] = run; }
          Lseg[sg * 64 + k] = run; }
        LBAR();
        f32x4 Lt[2], Lp[2], Lc[2];
        { const int sg = pt >> 3, sgp = (pt - 1) >> 3;
#pragma unroll
          for (int e = 0; e < 2; ++e) { f32x4 o0 = {0.f, 0.f, 0.f, 0.f}, o1 = o0, oc = o0;
#pragma unroll
              for (int u = 0; u < 8; ++u) { const f32x4 sv = *(const LAS f32x4*)(Lseg + u * 64 + cg * 8 + 4 * e); if (u < sg) o0 = o0 + sv; if (u < sgp) o1 = o1 + sv; if (u < 7) oc = oc + sv; }
              Lt[e] = *(const LAS f32x4*)(Lbuf + pt * 64 + cg * 8 + 4 * e) + o0;
              Lp[e] = pt > 0 ? *(const LAS f32x4*)(Lbuf + (pt - 1) * 64 + cg * 8 + 4 * e) + o1 : (f32x4){0.f, 0.f, 0.f, 0.f};
              Lc[e] = *(const LAS f32x4*)(Lbuf + 63 * 64 + cg * 8 + 4 * e) + oc; } }
        LBAR();
        {
            float at[8], bt[8], kt[8], rt[8], bh[8], kh[8], vv[8];
#pragma unroll
            for (int e = 0; e < 2; ++e)
#pragma unroll
                for (int u = 0; u < 4; ++u) { const int x = 4 * e + u; const float eL = __expf(Lt[e][u]), emL = __expf(-Lt[e][u]), eP = __expf(Lp[e][u]), eC = __expf(Lc[e][u] - Lt[e][u]);
                    at[x] = -kk[e][u] * eP; bt[x] = bq[e][u] * emL; kt[x] = kd[e][u] * emL; rt[x] = rx[e][u] * eL; bh[x] = bq[e][u] * eC; kh[x] = kd[e][u] * eC; vv[x] = vx[e][u];
                    if (pt == 63) GC[cg * 8 + x] = eL; }
#define ST8(bufi, arr) do { u32x4 w_ = {pk2(arr[0], arr[1]), pk2(arr[2], arr[3]), pk2(arr[4], arr[5]), pk2(arr[6], arr[7])}; *(LAS u32x4*)(BUF(bufi) + (pt * P + cg * 8) * 2) = w_; } while (0)
            ST8(0, at); ST8(1, bt); ST8(2, kt); ST8(3, rt); ST8(8, bh); ST8(9, kh); ST8(10, vv);
#undef ST8
            float bsv = 0.f;
#pragma unroll
            for (int e = 0; e < 2; ++e) bsv += rx[e][0] * kd[e][0] * rkc[e][0] + rx[e][1] * kd[e][1] * rkc[e][1] + rx[e][2] * kd[e][2] * rkc[e][2] + rx[e][3] * kd[e][3] * rkc[e][3];
            bsv = dpp_sum8(bsv);
            if (cg == 0) { const int z_ = seq & 1, b_ = seq >> 5; ((float*)(p.ws + OFF_BS))[((size_t)z_ * NROW + scan_row((it % NCHK) * 64 + pt, b_, z_)) * 16 + h] = bsv; }
        }
        LBAR();
        {
            const int k = tid & 63, tg = tid >> 6;
#define TR8(src, dst) do { unsigned w_[4]; _Pragma("unroll") for (int x = 0; x < 4; ++x) { const unsigned lo = *(const LAS bf16_t*)(BUF(src) + ((tg * 8 + 2 * x) * P + k) * 2), hi2 = *(const LAS bf16_t*)(BUF(src) + ((tg * 8 + 2 * x + 1) * P + k) * 2); w_[x] = lo | (hi2 << 16); } \
                *(LAS u32x4*)(BUF(dst) + (k * P + tg * 8) * 2) = (u32x4){w_[0], w_[1], w_[2], w_[3]}; } while (0)
            TR8(0, 4); TR8(8, 5); TR8(9, 6); TR8(10, 7);
#undef TR8
        }
        LBAR();
        const f32x4 Z4 = {0.f, 0.f, 0.f, 0.f};
        const f32x16 Z16 = {0.f, 0.f, 0.f, 0.f, 0.f, 0.f, 0.f, 0.f, 0.f, 0.f, 0.f, 0.f, 0.f, 0.f, 0.f, 0.f};
        const int r32 = lane & 31, hi = lane >> 5;
#pragma unroll 1
        for (int u = 0; u < 2; ++u) { const int tl = u * 8 + wid;
            if (tl >= 14) {
                if (tl == 14) { st32(BUF(8), 0, 1, r32, hi, Z16); st32(BUF(8), 1, 0, r32, hi, Z16); st32(BUF(14), 0, 1, r32, hi, Z16); st32(BUF(14), 1, 0, r32, hi, Z16); st32(BUF(9), 1, 0, r32, hi, Z16); }
                else { st32(BUF(15), 1, 0, r32, hi, Z16); st32(BUF(13), 1, 0, r32, hi, Z16); st32(BUF(10), 1, 0, r32, hi, Z16); st32(BUF(11), 1, 0, r32, hi, Z16); st32(BUF(12), 1, 0, r32, hi, Z16); }
                break; }
            const int m = (tl + 1) / 3, rr = (tl + 1) % 3, ti = rr == 2, tj = m == 0 ? ti : (rr >= 1); const int jj = 32 * tj + r32;
            if (m == 0) { f32x16 v = mm32(BUF(0), BUF(1), ti, tj, r32, hi, Z16), w;
#pragma unroll
                for (int e = 0; e < 16; ++e) { const int ii = 32 * ti + 8 * (e >> 2) + 4 * hi + (e & 3); const bool dg = (ii >> 4) == (jj >> 4);
                    v[e] = (dg && jj < ii) ? v[e] : 0.f; w[e] = v[e] + ((ii == jj) ? 1.f : 0.f); }
                st32(BUF(8), ti, tj, r32, hi, v); st32(BUF(14), ti, tj, r32, hi, w); }
            else if (m == 1) { const f32x16 v = mm32(BUF(1), BUF(0), ti, tj, r32, hi, Z16); f32x16 vd, vo, w;
#pragma unroll
                for (int e = 0; e < 16; ++e) { const int ii = 32 * ti + 8 * (e >> 2) + 4 * hi + (e & 3); const bool dg = (ii >> 4) == (jj >> 4), up = ii < jj;
                    vd[e] = (dg && up) ? v[e] : 0.f; vo[e] = (!dg && up) ? v[e] : 0.f; w[e] = vd[e] + ((ii == jj) ? 1.f : 0.f); }
                st32(BUF(9), ti, tj, r32, hi, vd); st32(BUF(15), ti, tj, r32, hi, vo); st32(BUF(13), ti, tj, r32, hi, w); }
            else if (m == 2) { f32x16 v = mm32(BUF(2), BUF(0), ti, tj, r32, hi, Z16);
#pragma unroll
                for (int e = 0; e < 16; ++e) { const int ii = 32 * ti + 8 * (e >> 2) + 4 * hi + (e & 3); v[e] = ii < jj ? v[e] : 0.f; }
                st32(BUF(10), ti, tj, r32, hi, v); }
            else { f32x16 v = mm32(m == 3 ? BUF(1) : BUF(2), BUF(3), ti, tj, r32, hi, Z16);
#pragma unroll
                for (int e = 0; e < 16; ++e) { const int ii = 32 * ti + 8 * (e >> 2) + 4 * hi + (e & 3); v[e] = ii <= jj ? v[e] : 0.f; }
                st32(m == 3 ? BUF(11) : BUF(12), ti, tj, r32, hi, v); } }
        LBAR();
#define WSYNC() asm volatile("s_waitcnt lgkmcnt(0)" ::: "memory")
        if (wid < 4) {
            const int tt = wid;
#define SQD(sr, st, dr, dt) do { const f32x4 a_ = mm_diag(BUF(st), BUF(sr), tt, c, q, Z4), b_ = mm_diag(BUF(sr), BUF(st), tt, c, q, Z4); WSYNC(); \
                st_tile(BUF(dr), tt, tt, c, q, a_); st_tile(BUF(dt), tt, tt, c, q, b_); WSYNC(); } while (0)
#define UPD(pr) do { const f32x4 dt_ = mm_diag(BUF(pr), BUF(13), tt, c, q, ld_tile(BUF(13), tt, tt, c, q)); \
                const f32x4 dr_ = mm_diag(BUF(13), BUF(pr), tt, c, q, ld_tile(BUF(14), tt, tt, c, q)); WSYNC(); \
                st_tile(BUF(13), tt, tt, c, q, dt_); st_tile(BUF(14), tt, tt, c, q, dr_); WSYNC(); } while (0)
#define UPSQ(sr, st, dr, dt) do { const f32x4 dt_ = mm_diag(BUF(sr), BUF(13), tt, c, q, ld_tile(BUF(13), tt, tt, c, q)); \
                const f32x4 dr_ = mm_diag(BUF(13), BUF(sr), tt, c, q, ld_tile(BUF(14), tt, tt, c, q)); \
                const f32x4 a_ = mm_diag(BUF(st), BUF(sr), tt, c, q, Z4), b_ = mm_diag(BUF(sr), BUF(st), tt, c, q, Z4); WSYNC(); \
                st_tile(BUF(13), tt, tt, c, q, dt_); st_tile(BUF(14), tt, tt, c, q, dr_); st_tile(BUF(dr), tt, tt, c, q, a_); st_tile(BUF(dt), tt, tt, c, q, b_); WSYNC(); } while (0)
            SQD(8, 9, 0, 1); UPSQ(0, 1, 8, 9); UPSQ(8, 9, 0, 1); UPD(0);
#undef UPSQ
#undef SQD
#undef UPD
        } else {
            const int ti = (wid >> 1) & 1, tj = wid & 1; st32(BUF(2), ti, tj, r32, hi, mm32(BUF(10), BUF(7), ti, tj, r32, hi, Z16));
        }
        LBAR();
        { const int m = wid >> 2, ti = (wid >> 1) & 1, tj = wid & 1;
          if (m == 0) st32(BUF(8), ti, tj, r32, hi, mm32(BUF(15), BUF(14), ti, tj, r32, hi, Z16));
          else        st32(BUF(9), ti, tj, r32, hi, mm32(BUF(14), BUF(15), ti, tj, r32, hi, Z16)); }
        LBAR();
        { const int ti = (wid >> 1) & 1, tj = wid & 1;
          if (wid < 4) st32(BUF(0), ti, tj, r32, hi, mm32(BUF(9), BUF(8), ti, tj, r32, hi, Z16));
          else         st32(BUF(1), ti, tj, r32, hi, mm32(BUF(8), BUF(13), ti, tj, r32, hi, ld32(BUF(13), ti, tj, r32, hi))); }
        LBAR();
        if (wid < 4) { const int ti = (wid >> 1) & 1, tj = wid & 1; st32(BUF(14), ti, tj, r32, hi, mm32(BUF(0), BUF(1), ti, tj, r32, hi, ld32(BUF(1), ti, tj, r32, hi))); }
        LBAR();
        { const int m = wid >> 2, ti = (wid >> 1) & 1, tj = wid & 1;
          if (m == 0) st32(BUF(8), ti, tj, r32, hi, mm32(BUF(14), BUF(4), ti, tj, r32, hi, Z16));
          else        st32(BUF(0), ti, tj, r32, hi, mm32(BUF(14), BUF(2), ti, tj, r32, hi, Z16)); }
        LBAR();
        bf16_t* ckp = CK + (size_t)it * 4 * 4096;
#pragma unroll 1
        for (int u = 0; u < 2; ++u) { const int tl = u * 8 + wid, m = tl >> 2, ti = (tl >> 1) & 1, tj = tl & 1;
            if (m == 0) { f32x16 v = mm32(BUF(8), BUF(5), ti, tj, r32, hi, Z16); const int jj = 32 * tj + r32; const float gc = GC[jj];
#pragma unroll
                for (int e = 0; e < 16; ++e) { const int ii = 32 * ti + 8 * (e >> 2) + 4 * hi + (e & 3); v[e] += (ii == jj) ? gc : 0.f; }
                st32(BUF(1), ti, tj, r32, hi, v); }
            else if (m == 1) st32(BUF(4), ti, tj, r32, hi, mm32(BUF(8), BUF(11), ti, tj, r32, hi, ld32(BUF(3), ti, tj, r32, hi)));
            else if (m == 2) st32(BUF(2), ti, tj, r32, hi, mm32(BUF(6), BUF(7), ti, tj, r32, hi, mm32(BUF(5), BUF(0), ti, tj, r32, hi, Z16)));
            else             st32(BUF(9), ti, tj, r32, hi, mm32(BUF(7), BUF(12), ti, tj, r32, hi, mm32(BUF(0), BUF(11), ti, tj, r32, hi, Z16))); }
        LBAR();
        { const int orow = tid >> 3, oc = (tid & 7) * 8;
          *(u32x4*)(ckp + orow * 64 + oc) = *(const LAS u32x4*)(BUF(1) + (orow * P + oc) * 2);
          *(u32x4*)(ckp + 4096 + orow * 64 + oc) = *(const LAS u32x4*)(BUF(2) + (orow * P + oc) * 2);
          *(u32x4*)(ckp + 2 * 4096 + orow * 64 + oc) = *(const LAS u32x4*)(BUF(4) + (orow * P + oc) * 2);
          *(u32x4*)(ckp + 3 * 4096 + orow * 64 + oc) = *(const LAS u32x4*)(BUF(9) + (orow * P + oc) * 2); }
    }
#undef BUF
#undef SC1_LOAD
}

__device__ void ph_rw_sc2(const Params& p, char* lds) {
    using namespace ck;
    const int tid = tidx(), wid = __builtin_amdgcn_readfirstlane(tid >> 6), lane = tid & 63, c = lane & 15, q = lane >> 4;
    const size_t PL = (size_t)NROW * D;
    const bf16_t* CK = (const bf16_t*)(p.ws + OFF_CK); bf16_t* Y = (bf16_t*)(p.ws + OFF_Y);
    lchar* GB = (lchar*)lds;
    lchar* RB = GB + 2 * MB;
    lchar* SB = GB + 4 * MB;
    constexpr int SBB = 32 * P * 2;
    for (int it = bidx(); it < 256; it += gdim()) {
        const int vh = it & 1, seq = it >> 1, z = seq & 1, h = (seq >> 1) & 15, b = seq >> 5;
        const bf16_t* ck0 = CK + (size_t)seq * NCHK * 4 * 4096;
        const int s_ti = wid & 3, s_tj = wid >> 2;
        const int y_ti = wid & 1, y_tj = wid >> 1;
        const int hoff = 4096 + (vh * 32 + 16 * s_tj + c) * 64 + 16 * s_ti + 4 * q, yoff = 3 * 4096 + (16 * y_tj + c) * 64 + vh * 32 + 16 * y_ti + 4 * q;
        struct PF { u32x4 g, r; uint2 h, y; };
#define PF_LOAD(X, k) do { const bf16_t* cc_ = ck0 + (size_t)(k) * 4 * 4096; X.h = *(const uint2*)(cc_ + hoff); X.y = *(const uint2*)(cc_ + yoff); X.g = *(const u32x4*)(cc_ + tid * 8); X.r = *(const u32x4*)(cc_ + 2 * 4096 + tid * 8); } while (0)
#define PF_STAGE(X, bufi) do { *(LAS u32x4*)(GB + (bufi) * MB + ((tid >> 3) * P + (tid & 7) * 8) * 2) = X.g; *(LAS u32x4*)(RB + (bufi) * MB + ((tid >> 3) * P + (tid & 7) * 8) * 2) = X.r; } while (0)
#define SC2_STEP(k, CUR, NXT) do { const uint2 hi_ = CUR.h, yi_ = CUR.y; const int cur = (k) & 1; \
            if ((k) + 4 < NCHK) PF_LOAD(CUR, (k) + 4); \
            const f32x4 hinit = {__uint_as_float(hi_.x << 16), __uint_as_float(hi_.x & 0xffff0000u), __uint_as_float(hi_.y << 16), __uint_as_float(hi_.y & 0xffff0000u)}; \
            const f32x4 yinit = {__uint_as_float(yi_.x << 16), __uint_as_float(yi_.x & 0xffff0000u), __uint_as_float(yi_.y << 16), __uint_as_float(yi_.y & 0xffff0000u)}; \
            const lchar* Sold = SB + cur * SBB; lchar* Snew = SB + (cur ^ 1) * SBB; \
            const f32x4 sn = mm_tile(GB + cur * MB, Sold, s_ti, s_tj, c, q, hinit);        \
            const f32x4 yv = mm_tile(Sold, RB + cur * MB, y_ti, y_tj, c, q, yinit);        \
            st_tile(Snew, s_ti, s_tj, c, q, sn); \
            { const int row = scan_row((k) * 64 + 16 * y_tj + c, b, z); stbf4(Y + z * PL + (size_t)row * D + h * 64 + vh * 32 + 16 * y_ti + 4 * q, yv); } \
            if ((k) + 1 < NCHK) PF_STAGE(NXT, cur ^ 1); \
            LBAR(); } while (0)
        PF s0, s1, s2, s3;
        PF_LOAD(s0, 0); PF_LOAD(s1, 1); PF_LOAD(s2, 2); PF_LOAD(s3, 3);
        LBAR();
        for (int i = tid; i < SBB / 4; i += NTHR) ((LAS unsigned*)SB)[i] = 0u;
        PF_STAGE(s0, 0);
        LBAR();
        for (int ch = 0; ch < NCHK; ch += 4) {
            SC2_STEP(ch, s0, s1); SC2_STEP(ch + 1, s1, s2); SC2_STEP(ch + 2, s2, s3); SC2_STEP(ch + 3, s3, s0);
        }
#undef PF_LOAD
#undef PF_STAGE
#undef SC2_STEP
    }
}
#undef LBAR

__device__ void ph_rw_out(const Params& p, int j, int nrows) {
    const int wid = tidx() >> 6, lane = tidx() & 63;
    const bf16_t* RKV = (const bf16_t*)(p.ws + OFF_RKV); const bf16_t* AV = (const bf16_t*)(p.ws + OFF_AV); const bf16_t* G = (const bf16_t*)(p.ws + OFF_G); const bf16_t* Y = (const bf16_t*)(p.ws + OFF_Y);
    bf16_t* OUT = (bf16_t*)(p.ws + OFF_H);
    const size_t PL = (size_t)NROW * D;
    const float* lg = p.rw_lnx_g + j * D; const float* lb = p.rw_lnx_b + j * D; const float* BS = (const float*)(p.ws + OFF_BS);
    uint2 nb[4][4]; float nbs[2][4];
#define OUT_LOAD(R) do { _Pragma("unroll") for (int i = 0; i < 4; ++i) { const size_t o_ = (size_t)(R) * D + lane * 4 + i * 256; \
        nb[0][i] = *(const uint2*)(Y + o_); nb[1][i] = *(const uint2*)(Y + PL + o_); nb[2][i] = *(const uint2*)(RKV + 2 * PL + o_); nb[3][i] = *(const uint2*)(G + o_); \
        nbs[0][i] = BS[(size_t)(R) * 16 + (lane >> 4) + 4 * i]; nbs[1][i] = BS[((size_t)NROW + (R)) * 16 + (lane >> 4) + 4 * i]; } } while (0)
#define UNPK(w) ((f32x4){__uint_as_float((w).x << 16), __uint_as_float((w).x & 0xffff0000u), __uint_as_float((w).y << 16), __uint_as_float((w).y & 0xffff0000u)})
    int row = bidx() * 8 + wid;
    if (row < nrows) OUT_LOAD(row);
    for (; row < nrows; row += gdim() * 8) {
        uint2 cb[4][4]; float cbs[4];
#pragma unroll
        for (int i = 0; i < 4; ++i) { cbs[i] = nbs[0][i] + nbs[1][i];
#pragma unroll
            for (int q_ = 0; q_ < 4; ++q_) cb[q_][i] = nb[q_][i]; }
        { const int nrow = row + gdim() * 8; if (nrow < nrows) OUT_LOAD(nrow); }
#pragma unroll
        for (int i = 0; i < 4; ++i) {
            const size_t o = (size_t)row * D + lane * 4 + i * 256; const int c = lane * 4 + i * 256;
            const f32x4 y = UNPK(cb[0][i]) + UNPK(cb[1][i]);
            const float mean = dpp_sum16(y[0] + y[1] + y[2] + y[3]) * (1.f / 64.f);
            const f32x4 dd = y - mean;
            const float rstd = rsqrtf(dpp_sum16(dd[0] * dd[0] + dd[1] * dd[1] + dd[2] * dd[2] + dd[3] * dd[3]) * (1.f / 64.f) + LNX_EPS);
            const f32x4 v = UNPK(cb[2][i]);
            const f32x4 res = (dd * rstd * *(const f32x4*)(lg + c) + *(const f32x4*)(lb + c) + cbs[i] * v) * UNPK(cb[3][i]);
            uint2 w; w.x = pk2(res[0], res[1]); w.y = pk2(res[2], res[3]); *(uint2*)(OUT + o) = w;
        }
    }
#undef OUT_LOAD
#undef UNPK
}

__device__ void ph_final(const Params& p) {
    const int wid = tidx() >> 6, lane = tidx() & 63;
    const float* X = (const float*)(p.ws + OFF_X);
    for (int row = bidx() * 8 + wid; row < NLAT; row += gdim() * 8) {
        const float4* xr = (const float4*)(X + (size_t)row * D);
        float4 v[4]; float ss = 0;
#pragma unroll
        for (int i = 0; i < 4; ++i) { v[i] = xr[lane + i * 64]; ss += v[i].x * v[i].x + v[i].y * v[i].y + v[i].z * v[i].z + v[i].w * v[i].w; }
        ss = wave_sum(ss); const float rs = rsqrtf(ss * (1.f / D) + RMS_EPS);
#pragma unroll
        for (int i = 0; i < 4; ++i) { const int d = (lane + i * 64) * 4; const float4 gg = *(const float4*)(p.final_g + d);
            float4 o; o.x = v[i].x * rs * gg.x; o.y = v[i].y * rs * gg.y; o.z = v[i].z * rs * gg.z; o.w = v[i].w * rs * gg.w;
            *(float4*)(p.out + (size_t)row * D + d) = o; }
    }
}

enum { PH_INIT = 0, PH_A_NORM, PH_A_Z, PH_A_MID, PH_A_QKV, PH_A_POST, PH_A_ATTN, PH_A_WO,
       PH_R_NORM, PH_R_XS, PH_R_G1, PH_R_G2, PH_R_PREP, PH_R_SCAN, PH_R_OUT, PH_R_WO,
       PH_M_NORM, PH_M_SEL, PH_M_GATHER, PH_M_G1, PH_M_G2, PH_M_COMB, PH_FINAL, PH_M_CVT, PH_R_SC1, PH_R_SC2 };

#ifndef BG_Z
#define BG_Z 4
#define BG_ATTN 2
#define BG_WO 3
#define BG_RG1 6
#define BG_MG1 4
#define BG_MG2 6
#endif
template <int PH>
__device__ __forceinline__ void run_phase(const Params& p, int layer, char* lds) {
    const int j = layer >> 1;
    char* ws = p.ws;
    if constexpr (PH == PH_INIT) { ph_init(p, lds); __syncthreads(); ph_small_cvt(p, lds); }
    else if constexpr (PH == PH_A_NORM) { if (layer == 0) ph_norm_mod<false>(p, layer, p.norm1_g + layer * D, 0, 1, ws + OFF_H); else ph_comb_norm<false>(p, layer - 1, layer, NROW); }
    else if constexpr (PH == PH_A_Z) {
        bf16_t* Z = (bf16_t*)(ws + OFF_Z);
        g8::BatchSched S{ws + OFF_H, ws + OFF_WMLA + j * SZ_WMLA + WM_IN, 0, 0, NROW / 256, 2, 1, D};
        g8::gemm_phase(p.wv, (PG8_LAS unsigned char*)lds, D, S, g8::epi_rc([=](const g8::Unit&, int row, int col, f32x4 v) { stbf4(Z + (size_t)row * 512 + col, v); }));
        if (idle_tail(NROW / 256 * 2)) bg_cvt(p, layer, lds, BG_Z);
    }
    else if constexpr (PH == PH_A_MID) ph_mla_mid(p, j);
    else if constexpr (PH == PH_A_QKV) {
        bf16_t* Q = (bf16_t*)(ws + OFF_Q); bf16_t* K = (bf16_t*)(ws + OFF_K); bf16_t* V = (bf16_t*)(ws + OFF_V);
        g8::BatchSched S1{ws + OFF_CQN, ws + OFF_WMLA + j * SZ_WMLA + WM_UQ, 0, 0, NROW / 256, 6, 1, 256, 1};
        g8::gemm_phase(p.wv, (PG8_LAS unsigned char*)lds, 256, S1, g8::epi_rc([=](const g8::Unit&, int row, int col, f32x4 v) {
            const bool lat = row < NLAT; const int b = lat ? (row >> 12) : ((row - NLAT) >> 8); const int tk = lat ? 256 + (row & (TL - 1)) : ((row - NLAT) & 255);
            const int h = col / 192, d = col - h * 192;
            uint2 w; w.x = pk2(v[0], v[1]); w.y = pk2(v[2], v[3]);
            *(uint2*)(Q + ((size_t)(b * 8 + h) * TK + tk) * 192 + d) = w; }));
        g8::BatchSched S2{ws + OFF_CKVN, ws + OFF_WMLA + j * SZ_WMLA + WM_UKV, 0, 0, NROW / 256, 8, 1, 128};
        g8::gemm_phase(p.wv, (PG8_LAS unsigned char*)lds, 128, S2, g8::epi_rc([=](const g8::Unit&, int row, int col, f32x4 v) {
            const bool lat = row < NLAT; const int b = lat ? (row >> 12) : ((row - NLAT) >> 8); const int tk = lat ? 256 + (row & (TL - 1)) : ((row - NLAT) & 255);
            const int h = col >> 8, d = col & 255; const size_t orow = (size_t)(b * 8 + h) * TK + tk;
            uint2 w; w.x = pk2(v[0], v[1]); w.y = pk2(v[2], v[3]);
            if (d < 128) *(uint2*)(K + orow * 192 + d) = w; else *(uint2*)(V + orow * 128 + (d - 128)) = w; }));
    }
    else if constexpr (PH == PH_A_ATTN) { ph_attn(p, lds); if (idle_tail(544)) bg_cvt(p, layer, lds, BG_ATTN); }
    else if constexpr (PH == PH_A_WO || PH == PH_R_WO) {
        xt_t* X = (xt_t*)(ws + OFF_X); const float* MOD = (const float*)(ws + OFF_MOD);
        g8::BatchSched S{ws + (PH == PH_A_WO ? OFF_O : OFF_H), PH == PH_A_WO ? ws + OFF_WMLA + j * SZ_WMLA + WM_O : ws + OFF_WRW + j * SZ_WRW + WR_O, 0, 0, (layer < 3 ? NROW : NLAT) / 256, 4, 1, D};
        g8::gemm_phase(p.wv, (PG8_LAS unsigned char*)lds, D, S, g8::EpiResid{X, MOD, layer});
        if (idle_tail((layer < 3 ? NROW : NLAT) / 256 * 4)) bg_cvt(p, layer, lds, BG_WO);
    }
    else if constexpr (PH == PH_R_XS) ph_rw_normxs(p, layer, j);
    else if constexpr (PH == PH_R_G1) {
        bf16_t* RKV = (bf16_t*)(ws + OFF_RKV); bf16_t* VF = (bf16_t*)(ws + OFF_VFIRST);
        bf16_t* A2 = (bf16_t*)(ws + OFF_A2); bf16_t* A3 = (bf16_t*)(ws + OFF_A3);
        const bool first = (j == 0);
        struct RSched { const char* XS; const char* WB; int nwg;
            __device__ __forceinline__ bool next(int i, g8::Unit& u) const {
                const int L = i * gdim() + bidx(); if (L >= nwg) return false;
                const int w = g8::xcd_remap(L, nwg);
                if (w < 816) { u.g = w / 272; const int r = w % 272; u.pm = r >> 2; u.pn = r & 3; u.B = WB + WR_RKV + (size_t)u.g * D * D * 2 + (size_t)u.pn * 256 * D * 2; }
                else { u.g = 3 + (w - 816) / 68; u.pm = (w - 816) % 68; u.pn = 0; u.B = WB + WR_L + (size_t)(u.g - 3) * 256 * D * 2; }
                u.A = XS + (size_t)(u.g == 6 ? 2 : u.g) * NROW * D * 2 + (size_t)u.pm * 256 * D * 2; return true; } };
        RSched S{ws + OFF_XS, ws + OFF_WRW + j * SZ_WRW, first ? 816 + 204 : 816 + 272};
        g8::gemm_phase(p.wv, (PG8_LAS unsigned char*)lds, D, S, g8::epi_rc([=](const g8::Unit& u, int row, int col, f32x4 v) {
            if (u.g < 3) { stbf4(RKV + ((size_t)u.g * NROW + row) * D + col, v); if (first && u.g == 2) stbf4(VF + (size_t)row * D + col, v); }
            else if (col < 128) {
                f32x4 t = v;
                if (u.g == 3) { for (int e = 0; e < 4; ++e) t[e] = 1.f - 2.f * __builtin_amdgcn_rcpf(1.f + __expf(2.f * v[e])); }
                else if (u.g == 5) { for (int e = 0; e < 4; ++e) t[e] = sigmoidf_(v[e]); }
                bf16_t* dst = (u.g == 3 ? A2 : u.g == 4 ? A2 + (size_t)NROW * 128 : u.g == 5 ? A3 : A3 + (size_t)NROW * 128);
                stbf4(dst + (size_t)row * 128 + col, t); } }));
        if (idle_tail(S.nwg)) bg_cvt(p, layer, lds, BG_RG1);
    }
    else if constexpr (PH == PH_R_G2) {
        const bool first = (j == 0);
        unsigned short* W = (unsigned short*)(ws + OFF_W); bf16_t* AV = (bf16_t*)(ws + OFF_AV); bf16_t* G = (bf16_t*)(ws + OFF_G); bf16_t* RKV = (bf16_t*)(ws + OFF_RKV); const bf16_t* VF = (const bf16_t*)(ws + OFF_VFIRST);
        const float* w0 = p.rw_w0 + (size_t)j * 2 * D; const float* a0 = p.rw_a0 + (size_t)j * 2 * D; const float* v0 = p.rw_v0;
        g8::BatchSched S1{ws + OFF_A2, ws + OFF_WRW + j * SZ_WRW + WR_B2, (size_t)NROW * 128 * 2, (size_t)2048 * 128 * 2, NROW / 256, 8, 2, 128};
        g8::gemm_phase(p.wv, (PG8_LAS unsigned char*)lds, 128, S1, g8::epi_colfirst([=](const g8::Unit& u, int row, int col, f32x4 v, f32x4 bias) {
            const int zz = u.pn >> 2, c = col & 1023; const bool dec = u.g == 0;
            const size_t doff = (size_t)zz * NROW * D + (size_t)row * D + c;
            const f32x4 x = v + bias; f32x4 o;
#pragma unroll
            for (int e = 0; e < 4; ++e) o[e] = __builtin_amdgcn_rcpf(1.f + __expf(-x[e]));
            if (dec) { uint2 w; w.x = (unsigned)(o[0] * 65535.f + 0.5f) | ((unsigned)(o[1] * 65535.f + 0.5f) << 16); w.y = (unsigned)(o[2] * 65535.f + 0.5f) | ((unsigned)(o[3] * 65535.f + 0.5f) << 16); *(uint2*)(W + doff) = w; }
            else stbf4(AV + doff, o); },
            [=](const g8::Unit& u, int col) { const int zz = u.pn >> 2, c = col & 1023; return *(const f32x4*)((u.g == 0 ? w0 : a0) + zz * D + c); }));
        g8::BatchSched S2{ws + OFF_A3, ws + OFF_WRW + j * SZ_WRW + WR_B3, (size_t)NROW * 128 * 2, (size_t)1024 * 128 * 2, NROW / 256, 4, first ? 1 : 2, 128, 1};
        g8::gemm_phase(p.wv, (PG8_LAS unsigned char*)lds, 128, S2, g8::epi_rc([=](const g8::Unit& u, int row, int col, f32x4 v) {
            if (u.g == 0) stbf4(G + (size_t)row * D + col, v);
            else { const size_t o = (size_t)row * D + col; const f32x4 vv = ldbf4(RKV + (size_t)2 * NROW * D + o), vf = ldbf4(VF + o), gz = v + *(const f32x4*)(v0 + col); f32x4 r;
#pragma unroll
                for (int e = 0; e < 4; ++e) r[e] = vv[e] + (vf[e] - vv[e]) * __builtin_amdgcn_rcpf(1.f + __expf(-gz[e]));
                stbf4(RKV + (size_t)2 * NROW * D + o, r); } }));
    }
    else if constexpr (PH == PH_R_SCAN) ph_rw_scan(p, j, lds);
    else if constexpr (PH == PH_R_SC1) ph_rw_sc1(p, j, lds);
    else if constexpr (PH == PH_R_SC2) ph_rw_sc2(p, lds);
    else if constexpr (PH == PH_R_OUT) ph_rw_out(p, j, layer < 3 ? NROW : NLAT);
    else if constexpr (PH == PH_M_NORM) ph_norm2_router_mm(p, layer, lds, layer < 3 ? NROW : NLAT);
    else if constexpr (PH == PH_M_SEL) { ph_select(p, lds, layer < 3 ? 128 : 64); __syncthreads(); moe_cvt(p, layer, lds, -1); }
    else if constexpr (PH == PH_M_GATHER) ph_gather(p, layer < 3 ? ESLOTS : NB * CAPL);
    else if constexpr (PH == PH_M_G1) {
        bf16_t* HID = (bf16_t*)(ws + OFF_HID);
        g8::BatchSched S{ws + OFF_XE, ws + OFF_W13T + (size_t)(layer & 1) * SZ_WMOE, (size_t)EPAD * D * 2, (size_t)2816 * D * 2, layer < 3 ? 9 : 8, 11, NE, D};
        g8::gemm_phase(p.wv, (PG8_LAS unsigned char*)lds, D, S, g8::epi_pair([=](const g8::Unit& u, int row, int col, f32x4 a, f32x4 b) {
            uint2 w; w.x = pk2(a[0] * __builtin_amdgcn_rcpf(1.f + __expf(-a[0])) * b[0], a[1] * __builtin_amdgcn_rcpf(1.f + __expf(-a[1])) * b[1]); w.y = pk2(a[2] * __builtin_amdgcn_rcpf(1.f + __expf(-a[2])) * b[2], a[3] * __builtin_amdgcn_rcpf(1.f + __expf(-a[3])) * b[3]);
            *(uint2*)(HID + ((size_t)u.g * EPAD + row) * FF + col) = w; }));
        if (layer < 3 && idle_tail(9 * 11 * NE)) moe_cvt(p, layer + 1, lds, BG_MG1);
    }
    else if constexpr (PH == PH_M_G2) {
        bf16_t* YE = (bf16_t*)(ws + OFF_YE); const float* GATE = (const float*)(ws + OFF_GATE);
        g8::BatchSched S{ws + OFF_HID, ws + OFF_W2T + (size_t)(layer & 1) * SZ_WMOE, (size_t)EPAD * FF * 2, (size_t)D * FF * 2, layer < 3 ? 9 : 8, 4, NE, FF};
        g8::gemm_phase(p.wv, (PG8_LAS unsigned char*)lds, FF, S, g8::epi_pre([=](const g8::Unit& u, int row, int col, f32x4 v, f32x4, float gt) {
            uint2 w; w.x = pk2(v[0] * gt, v[1] * gt); w.y = pk2(v[2] * gt, v[3] * gt);
            *(uint2*)(YE + ((size_t)u.g * EPAD + row) * D + col) = w; },
            [=](const g8::Unit&, int) { return (f32x4){0.f, 0.f, 0.f, 0.f}; }, [=](const g8::Unit& u, int row) { return GATE[u.g * EPAD + row]; }));
        if (layer < 3 && idle_tail(9 * 4 * NE)) moe_cvt(p, layer + 1, lds, BG_MG2);
    }
    else if constexpr (PH == PH_M_COMB) ph_combine(p, layer, layer < 3 ? NROW : NLAT);
    else if constexpr (PH == PH_M_CVT) moe_cvt(p, layer, lds, -1);
    else if constexpr (PH == PH_FINAL) ph_comb_norm<true>(p, 3, 0, NLAT);
}

#if ONE_LAUNCH
#define SYNC() xcd_barrier(bar)
#ifndef PROBE_PH
#define PROBE_PH -1
#endif
#ifndef PROBE_REP
#define PROBE_REP 1
#endif
__device__ __forceinline__ Params load_params() {
    Params q{};
#if defined(__HIP_DEVICE_COMPILE__)
    typedef const __attribute__((address_space(4))) unsigned long long* KargP;
    KargP kp_ = (KargP)__builtin_amdgcn_kernarg_segment_ptr(); asm volatile("" : "+s"(kp_));
#pragma unroll
    for (int i = 0; i < 40; ++i) ((const float**)&q)[i] = (const float*)(const __attribute__((address_space(1))) float*)kp_[i];
#endif
    return q;
}
#define RUN(PH) do { for (int rep_ = 0; rep_ < ((PH) == PROBE_PH ? PROBE_REP : 1); ++rep_) { Params q = load_params(); q.wv = wv0_; run_phase<PH>(q, layer, smem); SYNC(); } } while (0)
__global__ void __launch_bounds__(NTHR, 2) mega(Params p) {
    extern __shared__ __attribute__((aligned(16))) char smem[];
    const int wv0_ = __builtin_amdgcn_readfirstlane((int)threadIdx.x >> 6);
    if (threadIdx.x == 0) *(uint4*)(smem + LDS_BYTES) = make_uint4(0u, 0u, 0u, 0u);
    __syncthreads();
    XcdBarrier bar = xcd_barrier_post((unsigned*)(p.ws + OFF_BAR), (volatile LAS unsigned*)(smem + LDS_BYTES));
    { const int layer = 0; RUN(PH_INIT); }
    for (int layer = 0; layer < 4; ++layer) {
        if ((layer & 1) == 0) {
            RUN(PH_A_NORM);
            RUN(PH_A_Z);
            RUN(PH_A_MID);
            RUN(PH_A_QKV);
            RUN(PH_A_ATTN);
            RUN(PH_A_WO);
        } else {
            RUN(PH_R_XS);
            RUN(PH_R_G1);
            RUN(PH_R_G2);
            RUN(PH_R_SC1);
            RUN(PH_R_SC2);
            RUN(PH_R_OUT);
            RUN(PH_R_WO);
        }
        RUN(PH_M_NORM);
        RUN(PH_M_SEL);
        RUN(PH_M_G1);
        RUN(PH_M_G2);
        if ((layer & 1) == 0) RUN(PH_M_COMB);
    }
    { Params q = load_params(); q.wv = wv0_; run_phase<PH_FINAL>(q, 0, smem); }
}
#else
template <int PH> __global__ void __launch_bounds__(NTHR, 2) kph(Params p, int layer) {
    extern __shared__ __attribute__((aligned(16))) char smem[];
    Params q = p; q.wv = __builtin_amdgcn_readfirstlane((int)threadIdx.x >> 6);
    run_phase<PH>(q, layer, smem);
}
#endif

extern "C" void kernel_launch(void* const* d_in, const int* in_sizes, int n_in, void* d_out, int out_size, void* d_ws, size_t ws_size, hipStream_t stream) {
    if (n_in != 38 || ws_size < WS_NEED) { fprintf(stderr, "kernel_launch: bad args n_in %d ws %zu need %zu\n", n_in, ws_size, (size_t)WS_NEED); return; }
    Params p{};
    const float** pp = (const float**)&p;
    for (int i = 0; i < 38; ++i) pp[i] = (const float*)d_in[i];
    p.out = (float*)d_out; p.ws = (char*)d_ws;
    static int cus = 0;
    if (!cus) { int dev = 0; hipGetDevice(&dev); hipDeviceGetAttribute(&cus, hipDeviceAttributeMultiprocessorCount, dev); if (cus <= 0) cus = 256; }
    const int grid = cus;
#if ONE_LAUNCH
    hipFuncSetAttribute((const void*)mega, hipFuncAttributeMaxDynamicSharedMemorySize, LDS_BYTES + 16);
    hipMemsetAsync(d_ws, 0, 16384, stream);
    hipLaunchKernelGGL(mega, dim3(grid), dim3(NTHR), LDS_BYTES + 16, stream, p);
#else
    hipMemsetAsync(d_ws, 0, 16384, stream);
#define LAUNCH(PH, L) do { hipFuncSetAttribute((const void*)kph<PH>, hipFuncAttributeMaxDynamicSharedMemorySize, LDS_BYTES + 16); hipLaunchKernelGGL(kph<PH>, dim3(grid), dim3(NTHR), LDS_BYTES + 16, stream, p, L); } while (0)
    LAUNCH(PH_INIT, 0);
    for (int layer = 0; layer < 4; ++layer) {
        if ((layer & 1) == 0) { LAUNCH(PH_A_NORM, layer); LAUNCH(PH_A_Z, layer); LAUNCH(PH_A_MID, layer); LAUNCH(PH_A_QKV, layer); LAUNCH(PH_A_ATTN, layer); LAUNCH(PH_A_WO, layer); }
        else { LAUNCH(PH_R_XS, layer); LAUNCH(PH_R_G1, layer); LAUNCH(PH_R_G2, layer); LAUNCH(PH_R_SC1, layer); LAUNCH(PH_R_SC2, layer); LAUNCH(PH_R_OUT, layer); LAUNCH(PH_R_WO, layer); }
        LAUNCH(PH_M_NORM, layer); LAUNCH(PH_M_SEL, layer); LAUNCH(PH_M_G1, layer); LAUNCH(PH_M_G2, layer); if ((layer & 1) == 0) LAUNCH(PH_M_COMB, layer);
    }
    LAUNCH(PH_FINAL, 0);
#endif
}
```

```cpp
#include <hip/hip_runtime.h>
#include <stdint.h>
#include <stdio.h>

#ifndef ONE_LAUNCH
#define ONE_LAUNCH 1
#endif

#define NTHR 512
typedef unsigned short bf16_t;
typedef short bf16x8 __attribute__((ext_vector_type(8)));
typedef float f32x4 __attribute__((ext_vector_type(4)));
typedef unsigned u32x4 __attribute__((ext_vector_type(4)));
typedef unsigned u32x2 __attribute__((ext_vector_type(2)));

constexpr int D = 1024, NB = 4, TL = 4096, TC = 256, NLAT = NB * TL, NCTX = NB * TC, NROW = NLAT + NCTX;
constexpr int TK = TL + TC;
constexpr int NE = 16, FF = 1408, CAPL = 512, CAPC = 32, ESLOTS = NB * CAPL + NB * CAPC;
constexpr int EPAD = 2304;
constexpr float RMS_EPS = 1e-6f, LNX_EPS = 64e-5f;
constexpr float ATT_SCALE = 0.07216878364870322f;

constexpr size_t al256(size_t x) { return (x + 255) / 256 * 256; }
constexpr size_t OFF_BAR = 0;
constexpr size_t OFF_QUEUE = 14336;
constexpr size_t OFF_MOD = 16384;
constexpr size_t OFF_ROPE_C = OFF_MOD + al256(4 * 5 * 6144 * 4);
constexpr size_t OFF_ROPE_S = OFF_ROPE_C + al256(TL * 32 * 4);
constexpr size_t OFF_X = OFF_ROPE_S + al256(TL * 32 * 4);
constexpr size_t SZ_F32 = (size_t)NROW * D * 4, SZ_BF = (size_t)NROW * D * 2;
constexpr size_t OFF_VFIRST = OFF_X + SZ_BF;
constexpr size_t OFF_H = OFF_VFIRST + SZ_BF;
constexpr size_t SZ_WMLA = (size_t)(512 * 1024 + 1536 * 256 + 2048 * 256 + 1024 * 1024) * 2;
constexpr size_t WM_IN = 0, WM_UQ = (size_t)512 * 1024 * 2, WM_UKV = WM_UQ + (size_t)1536 * 256 * 2, WM_O = WM_UKV + (size_t)2048 * 256 * 2;
constexpr size_t SZ_WRW = (size_t)(3 * 1024 * 1024 + 4 * 256 * 1024 + 1024 * 1024 + 4096 * 256 + 2048 * 256) * 2;
constexpr size_t WR_RKV = 0, WR_L = (size_t)3 * 1024 * 1024 * 2, WR_O = WR_L + (size_t)4 * 256 * 1024 * 2, WR_B2 = WR_O + (size_t)1024 * 1024 * 2, WR_B3 = WR_B2 + (size_t)4096 * 256 * 2;
constexpr size_t OFF_WMLA = OFF_H + SZ_BF;
constexpr size_t OFF_WRW = OFF_WMLA + 2 * SZ_WMLA;
constexpr size_t OFF_W13T = OFF_WRW + 2 * SZ_WRW;
constexpr size_t OFF_W2T = OFF_W13T + (size_t)NE * 2816 * D * 2;
constexpr size_t SZ_WMOE = (size_t)NE * 2816 * D * 2 + (size_t)NE * D * FF * 2;
constexpr size_t OFF_S = OFF_W13T + 2 * SZ_WMOE;
constexpr size_t OFF_Z = OFF_S;
constexpr size_t OFF_CQN = OFF_Z + al256((size_t)NROW * 512 * 4);
constexpr size_t OFF_CKVN = OFF_CQN + al256((size_t)NROW * 256 * 2);
constexpr size_t OFF_KR = OFF_CKVN + al256((size_t)NROW * 256 * 2);
constexpr size_t OFF_QRAW = OFF_KR + al256((size_t)NROW * 64 * 4);
constexpr size_t OFF_KVRAW = OFF_QRAW + al256((size_t)NROW * 1536 * 4);
constexpr size_t OFF_Q = OFF_KVRAW + al256((size_t)NROW * 2048 * 4);
constexpr size_t OFF_K = OFF_Q + al256((size_t)NB * 8 * TK * 192 * 2);
constexpr size_t OFF_V = OFF_K + al256((size_t)NB * 8 * TK * 192 * 2);
constexpr size_t OFF_O = OFF_V + al256((size_t)NB * 8 * TK * 128 * 2);
constexpr size_t END_MLA = OFF_O + SZ_BF;
constexpr size_t OFF_XS = OFF_S;
constexpr size_t OFF_RKV = OFF_XS + 6 * SZ_BF;
constexpr size_t OFF_W = OFF_RKV + 3 * SZ_BF;
constexpr size_t OFF_AV = OFF_W + 2 * SZ_F32;
constexpr size_t OFF_G = OFF_AV + 2 * SZ_BF;
constexpr size_t OFF_A2 = OFF_G + SZ_BF;
constexpr size_t OFF_A3 = OFF_A2 + al256((size_t)NROW * 256 * 2);
constexpr size_t END_RW = OFF_A3 + al256((size_t)NROW * 256 * 2);
constexpr size_t OFF_Y = OFF_XS;
constexpr int NCHK = (TC + TL) / 64;
constexpr size_t OFF_CK = END_RW;
constexpr size_t OFF_BS = OFF_CK + (size_t)128 * NCHK * 4 * 4096 * 2;
constexpr size_t END_RW2 = OFF_BS + (size_t)2 * NROW * 16 * 4;
constexpr size_t OFF_AFF = OFF_S;
constexpr size_t OFF_ROWIDX = OFF_AFF + al256((size_t)NROW * 16 * 4);
constexpr size_t OFF_GATE = OFF_ROWIDX + al256((size_t)NE * ESLOTS * 4);
constexpr size_t OFF_SLOT = OFF_GATE + al256((size_t)NE * EPAD * 4);
constexpr size_t OFF_XE = OFF_SLOT + al256((size_t)NROW * 16 * 4);
constexpr size_t OFF_HID = OFF_XE + al256((size_t)NE * EPAD * D * 2);
constexpr size_t OFF_YE = OFF_HID + al256((size_t)NE * EPAD * FF * 2);
constexpr size_t END_MOE = OFF_YE + al256((size_t)NE * EPAD * D * 2);
constexpr size_t WS_NEED = END_RW2 > END_MLA ? (END_RW2 > END_MOE ? END_RW2 : END_MOE) : (END_MLA > END_MOE ? END_MLA : END_MOE);

constexpr int LDS_BYTES = 152064;

struct Params {
    const float *x, *c, *ctx, *c_ctx, *mod_w, *mod_b, *norm1_g, *norm2_g, *final_g;
    const float *mla_w_in, *mla_g_q, *mla_g_kv, *mla_w_uq, *mla_w_ukv, *mla_w_o;
    const float *rw_mu, *rw_w_rkv, *rw_w0, *rw_w1, *rw_w2, *rw_a0, *rw_a1, *rw_a2, *rw_v0, *rw_v1, *rw_v2, *rw_g1, *rw_g2, *rw_k_k, *rw_k_a, *rw_r_k, *rw_lnx_g, *rw_lnx_b, *rw_w_o;
    const float *moe_router, *moe_w1, *moe_w3, *moe_w2;
    float* out; char* ws;
    int wv, pad_;
};

__device__ __forceinline__ int bidx() { int t = blockIdx.x; asm volatile("" : "+s"(t)); return t; }
__device__ __forceinline__ int gdim() { int t = gridDim.x; asm volatile("" : "+s"(t)); return t; }
__device__ __forceinline__ int tidx_w(int wv) { int l; asm volatile("v_mbcnt_lo_u32_b32 %0, -1, 0\n\tv_mbcnt_hi_u32_b32 %0, -1, %0" : "=v"(l)); return (wv << 6) | l; }
#define tidx() tidx_w(p.wv)
#define XB_TMO      128
#define XB_XCNT(j)  (256  + 64 * (j))
#define XB_XSUB(j)  (1280 + 64 * (j))
#define XB_XGEN(j)  (2304 + 64 * (j))
#define XB_TOP      3328
#define XB_TOPGEN   3392
#define XCD_BAR_WORDS 3456
#define XB_SPIN_CAP (1u << 22)
#define LAS __attribute__((address_space(3)))

__device__ __forceinline__ unsigned xb_ld(unsigned* p)              { return __hip_atomic_load(p, __ATOMIC_RELAXED, __HIP_MEMORY_SCOPE_AGENT); }
__device__ __forceinline__ unsigned xb_add(unsigned* p, unsigned v) { return __hip_atomic_fetch_add(p, v, __ATOMIC_RELAXED, __HIP_MEMORY_SCOPE_AGENT); }
__device__ __forceinline__ unsigned xb_xcc_id() { return (unsigned)__builtin_amdgcn_s_getreg((3 << 11) | 20) & 0xFu; }
#define XB_SPIN(cond, bar) do { unsigned _sp = 0; while (cond) { __builtin_amdgcn_s_sleep(1); \
    if ((++_sp & 255u) == 0u) { if (xb_ld(&(bar)[XB_TMO])) break; if (_sp > XB_SPIN_CAP) { atomicAdd(&(bar)[XB_TMO], 1u); break; } } } } while (0)

struct XcdBarrier { unsigned* bar; unsigned x; volatile LAS unsigned* st; };

__device__ __forceinline__ XcdBarrier xcd_barrier_post(unsigned* bar, volatile LAS unsigned* st) {
    XcdBarrier b; b.bar = bar; b.x = xb_xcc_id(); b.st = st;
    if (threadIdx.x == 0) (void)xb_add(&bar[XB_XCNT(b.x)], 1u);
    return b;
}
__device__ __forceinline__ void xcd_barrier_complete(unsigned* bar, unsigned x, unsigned& nloc, unsigned& nx) {
    const unsigned G = gridDim.x * gridDim.y * gridDim.z;
    unsigned sum, cnt, mine, sp = 0u;
    for (;;) {
        sum = 0u; cnt = 0u; mine = 0u;
#pragma unroll
        for (unsigned j = 0; j < 16; ++j) { const unsigned c = xb_ld(&bar[XB_XCNT(j)]); sum += c; cnt += (c > 0u) ? 1u : 0u; mine = (j == x) ? c : mine; }
        if (sum == G) break;
        __builtin_amdgcn_s_sleep(1);
        if ((++sp & 255u) == 0u) { if (xb_ld(&bar[XB_TMO])) break; if (sp > XB_SPIN_CAP) { atomicAdd(&bar[XB_TMO], 1u); break; } }
    }
    nloc = mine > 0u ? mine : 1u; nx = cnt > 0u ? cnt : 1u;
}
__device__ __forceinline__ void xcd_barrier(const XcdBarrier& b) {
    asm volatile("s_waitcnt vmcnt(0)" ::: "memory");
    __syncthreads();
    if (threadIdx.x == 0) {
        unsigned* bar = b.bar;
        __builtin_amdgcn_s_waitcnt(0);
        unsigned nloc = b.st[0], nx = b.st[1];
        if (nloc == 0u) { xcd_barrier_complete(bar, b.x, nloc, nx); b.st[0] = nloc; b.st[1] = nx; }
        const unsigned old = xb_add(&bar[XB_XSUB(b.x)], 1u);
        const unsigned gen = old / nloc;
        if (old + 1u == (gen + 1u) * nloc) {
            __builtin_amdgcn_fence(__ATOMIC_RELEASE, "agent");
            asm volatile("s_waitcnt vmcnt(0)" ::: "memory");
            const unsigned og = xb_add(&bar[XB_TOP], 1u);
            const unsigned tg = og / nx;
            if (og + 1u == (tg + 1u) * nx) xb_add(&bar[XB_TOPGEN], 1u);
            else XB_SPIN(xb_ld(&bar[XB_TOPGEN]) == tg, bar);
            __builtin_amdgcn_fence(__ATOMIC_ACQUIRE, "agent");
            xb_add(&bar[XB_XGEN(b.x)], 1u);
            asm volatile("s_waitcnt vmcnt(0)" ::: "memory");
        } else {
            XB_SPIN(xb_ld(&bar[XB_XGEN(b.x)]) == gen, bar);
            __builtin_amdgcn_fence(__ATOMIC_ACQUIRE, "agent");
            asm volatile("s_waitcnt vmcnt(0)" ::: "memory");
        }
    }
    __syncthreads();
}

__device__ __forceinline__ float bf2f(bf16_t b) { return __uint_as_float(((unsigned)b) << 16); }
typedef float f32x2_ __attribute__((ext_vector_type(2)));
typedef __bf16 bf16x2_ __attribute__((ext_vector_type(2)));
__device__ __forceinline__ unsigned pk2(float lo, float hi) { const f32x2_ v = {lo, hi}; return __builtin_bit_cast(unsigned, __builtin_convertvector(v, bf16x2_)); }
__device__ __forceinline__ bf16_t f2bf(float f) { return (bf16_t)(pk2(f, f) & 0xffffu); }
__device__ __forceinline__ float dpp_sum16(float x) {
    x += __builtin_bit_cast(float, __builtin_amdgcn_update_dpp(0, __builtin_bit_cast(int, x), 0xB1, 0xF, 0xF, true));
    x += __builtin_bit_cast(float, __builtin_amdgcn_update_dpp(0, __builtin_bit_cast(int, x), 0x4E, 0xF, 0xF, true));
    x += __builtin_bit_cast(float, __builtin_amdgcn_update_dpp(0, __builtin_bit_cast(int, x), 0x141, 0xF, 0xF, true));
    x += __builtin_bit_cast(float, __builtin_amdgcn_update_dpp(0, __builtin_bit_cast(int, x), 0x140, 0xF, 0xF, true));
    return x;
}
__device__ __forceinline__ f32x4 ldbf4(const bf16_t* p) { const uint2 w = *(const uint2*)p; return (f32x4){__uint_as_float(w.x << 16), __uint_as_float(w.x & 0xffff0000u), __uint_as_float(w.y << 16), __uint_as_float(w.y & 0xffff0000u)}; }
__device__ __forceinline__ void stbf4(bf16_t* p, f32x4 v) { uint2 w; w.x = pk2(v[0], v[1]); w.y = pk2(v[2], v[3]); *(uint2*)p = w; }
typedef bf16_t xt_t;
__device__ __forceinline__ f32x4 xldv(const xt_t* X, size_t i) { return ldbf4(X + i); }
__device__ __forceinline__ void xstv(xt_t* X, size_t i, f32x4 v) { stbf4(X + i, v); }
__device__ __forceinline__ float4 xld(const xt_t* X, size_t i) { const f32x4 v = ldbf4(X + i); return make_float4(v[0], v[1], v[2], v[3]); }
__device__ __forceinline__ void xst(xt_t* X, size_t i, float4 v) { stbf4(X + i, (f32x4){v.x, v.y, v.z, v.w}); }
__device__ __forceinline__ float wave_sum(float v) {
    v = dpp_sum16(v); const int i = __builtin_bit_cast(int, v);
    return __builtin_bit_cast(float, __builtin_amdgcn_readlane(i, 0)) + __builtin_bit_cast(float, __builtin_amdgcn_readlane(i, 16)) + __builtin_bit_cast(float, __builtin_amdgcn_readlane(i, 32)) + __builtin_bit_cast(float, __builtin_amdgcn_readlane(i, 48));
}
__device__ __forceinline__ float sigmoidf_(float x) { return __builtin_amdgcn_rcpf(1.f + __expf(-x)); }
__device__ __forceinline__ int row_stream(int row) { return row < NLAT ? (row >> 12) : 4; }
__device__ __forceinline__ const float* modp(const Params& p, int layer, int s, int part) { return (const float*)(p.ws + OFF_MOD) + ((size_t)layer * 5 + s) * 6144 + part * 1024; }

struct SgArgs { const bf16_t* A; int lda; size_t strideA; const float* B; int ldb; size_t strideB; int M, N, K, nbatch; };
template <class Epi>
__device__ __forceinline__ void sg_gemm(const Params& p, char* lds, const SgArgs g, const Epi& epi) {
    bf16_t* As = (bf16_t*)lds;
    bf16_t* Bs = As + 128 * 40;
    const int tid = tidx(), wid = tid >> 6, lane = tid & 63;
    const int wr = wid >> 2, wc = wid & 3;
    const int tilesN = (g.N + 127) / 128, tilesM = g.M / 128, per = tilesM * tilesN, ntiles = per * g.nbatch;
    const int ar = tid >> 2, ak = (tid & 3) * 8;
    const int bn = tid & 127, bk = (tid >> 7) * 8;
    for (int tile = bidx(); tile < ntiles; tile += gdim()) {
        const int bt = tile / per, tt = tile % per;
        const int tm = tt / tilesN, tn = tt % tilesN;
        const int m0 = tm * 128, n0 = tn * 128;
        f32x4 acc[4][2];
#pragma unroll
        for (int m = 0; m < 4; ++m)
#pragma unroll
            for (int n = 0; n < 2; ++n) acc[m][n] = (f32x4){0.f, 0.f, 0.f, 0.f};
        const bool bvalid = (n0 + bn) < g.N;
        const bf16_t* ap = g.A + bt * g.strideA + (size_t)(m0 + ar) * g.lda + ak;
        const float* bp = g.B + bt * g.strideB + (size_t)bk * g.ldb + n0 + bn;
        bf16x8 areg; float breg[8];
        areg = *(const bf16x8*)ap;
#pragma unroll
        for (int j = 0; j < 8; ++j) breg[j] = bvalid ? bp[(size_t)j * g.ldb] : 0.f;
        for (int k0 = 0; k0 < g.K; k0 += 32) {
            __syncthreads();
            *(bf16x8*)(As + ar * 40 + ak) = areg;
            { u32x4 w; w.x = pk2(breg[0], breg[1]); w.y = pk2(breg[2], breg[3]); w.z = pk2(breg[4], breg[5]); w.w = pk2(breg[6], breg[7]); *(u32x4*)(Bs + bn * 40 + bk) = w; }
            __syncthreads();
            if (k0 + 32 < g.K) {
                areg = *(const bf16x8*)(ap + k0 + 32);
#pragma unroll
                for (int j = 0; j < 8; ++j) breg[j] = bvalid ? bp[(size_t)(k0 + 32 + j) * g.ldb] : 0.f;
            }
            bf16x8 af[4], bfr[2];
#pragma unroll
            for (int m = 0; m < 4; ++m) af[m] = *(const bf16x8*)(As + (wr * 64 + m * 16 + (lane & 15)) * 40 + (lane >> 4) * 8);
#pragma unroll
            for (int n = 0; n < 2; ++n) bfr[n] = *(const bf16x8*)(Bs + (wc * 32 + n * 16 + (lane & 15)) * 40 + (lane >> 4) * 8);
#pragma unroll
            for (int m = 0; m < 4; ++m)
#pragma unroll
                for (int n = 0; n < 2; ++n) acc[m][n] = __builtin_amdgcn_mfma_f32_16x16x32_bf16(af[m], bfr[n], acc[m][n], 0, 0, 0);
        }
#pragma unroll
        for (int m = 0; m < 4; ++m)
#pragma unroll
            for (int n = 0; n < 2; ++n) {
                const int col = n0 + wc * 32 + n * 16 + (lane & 15);
                if (col < g.N) {
#pragma unroll
                    for (int r = 0; r < 4; ++r) epi(bt, m0 + wr * 64 + m * 16 + (lane >> 4) * 4 + r, col, acc[m][n][r]);
                }
            }
    }
}


namespace g8 {
#define PG8_LAS __attribute__((address_space(3)))
constexpr int BM = 256, BK = 64, HALF = 128, HTB = HALF * BK * 2, STAGE_BYTES = 8 * HTB;
__device__ __forceinline__ int lds_byte(int r, int c) { const int st = (r >> 4) * 2 + (c >> 5), rr = r & 15, cc = c & 31, ob = rr * 64 + cc * 2; return st * 1024 + (ob ^ (((ob >> 9) & 1) << 5)); }
__device__ __forceinline__ void stage_rc(int b, int& R, int& C) { const int st = b / 1024, sb = b % 1024, swz = sb ^ (((sb >> 9) & 1) << 5); R = (st >> 1) * 16 + swz / 64; C = (st & 1) * 32 + (swz % 64) / 2; }
struct Unit { int pm, pn, g; const char* A; const char* B; };
__device__ __forceinline__ int xcd_remap(int L, int nwg) { const int q = nwg / 8, r = nwg % 8, xcd = L % 8, off = L / 8; return (xcd < r ? xcd * (q + 1) : r * (q + 1) + (xcd - r) * q) + off; }

template <bool GATHER = false, class Epi, class Sched>
__device__ __forceinline__ void gemm_phase(const int wv_, PG8_LAS unsigned char* lds, const int K, const Sched& S, const Epi& E) {
    const int tid = tidx_w(wv_), wid = __builtin_amdgcn_readfirstlane(tid >> 6), lane = tid & 63, wr = wid >> 2, wc = wid & 3, fr = lane & 15, fq = lane >> 4;
    const int nt = K / BK;
    unsigned voffA[2];
#pragma unroll
    for (int i = 0; i < 2; ++i) { int R, C; stage_rc(tid * 16 + i * 8192, R, C); voffA[i] = (unsigned)(R * K + C) * 2u; }
    unsigned vC00 = 0, vC01 = 0, vC10 = 0, vC11 = 0; int nR00 = 0, nR01 = 0, nR10 = 0, nR11 = 0;
    int gR0 = 0, gC0 = 0, gR1 = 0, gC1 = 0;
    if constexpr (GATHER) { stage_rc(tid * 16, gR0, gC0); stage_rc(tid * 16 + 8192, gR1, gC1); }
#define PG8_GROWS(U, r00, r01, r10, r11) do { if constexpr (GATHER) { const int* rp_ = S.rows(U); const int nv_ = S.nvalid(U); \
        r00 = gR0 < nv_ ? rp_[gR0] : 0; r01 = gR1 < nv_ ? rp_[gR1] : 0; r10 = HALF + gR0 < nv_ ? rp_[HALF + gR0] : 0; r11 = HALF + gR1 < nv_ ? rp_[HALF + gR1] : 0; } } while (0)
#define PG8_GOFF(r, c) ((unsigned)((r) * K + (c)) * 2u)
#define PG8_STAGE_A(bufoff, ptr, h, nx) do { if constexpr (GATHER) { if (nx) { const unsigned vg_[2] = {PG8_GOFF((h) ? nR10 : nR00, gC0), PG8_GOFF((h) ? nR11 : nR01, gC1)}; PG8_STAGE(bufoff, ptr, vg_); } \
            else { const unsigned vg_[2] = {(h) ? vC10 : vC00, (h) ? vC11 : vC01}; PG8_STAGE(bufoff, ptr, vg_); } } \
        else PG8_STAGE(bufoff, (ptr) + (h) * hstep, voffA); } while (0)
    const size_t kstep = (size_t)(BK * 2);
    const size_t hstep = (size_t)HALF * K * 2;
    const unsigned ldsw = (unsigned)wid * 1024u;
    const int aoff = lds_byte(wr * 64 + fr, fq * 8), boff = lds_byte(wc * 32 + fr, fq * 8);
#define PG8_SA(b, h) (((b) * 2 + (h)) * HTB)
#define PG8_SB(b, h) ((4 + (b) * 2 + (h)) * HTB)
#define PG8_STAGE(bufoff, gbase, voff) do { _Pragma("unroll") for (int _i = 0; _i < 2; ++_i) \
        __builtin_amdgcn_global_load_lds((const unsigned*)((const char*)(gbase) + (voff)[_i]), (PG8_LAS unsigned*)(lds + (bufoff) + ldsw + _i * 8192), 16, 0, 0); } while (0)
#define PG8_LDA(dst, b, h) do { _Pragma("unroll") for (int m = 0; m < 4; ++m) _Pragma("unroll") for (int k = 0; k < 2; ++k) dst[m][k] = *(const PG8_LAS bf16x8*)(lds + PG8_SA(b, h) + aoff + m * 2048 + k * 1024); } while (0)
#define PG8_LDB(dst, b, h) do { _Pragma("unroll") for (int n = 0; n < 2; ++n) _Pragma("unroll") for (int k = 0; k < 2; ++k) dst[n][k] = *(const PG8_LAS bf16x8*)(lds + PG8_SB(b, h) + boff + n * 2048 + k * 1024); } while (0)
#define PG8_MMA(ai, bj, At, Bt) do { __builtin_amdgcn_s_setprio(1); _Pragma("unroll") for (int m = 0; m < 4; ++m) _Pragma("unroll") for (int n = 0; n < 2; ++n) _Pragma("unroll") for (int k = 0; k < 2; ++k) \
        acc[ai][bj][m][n] = __builtin_amdgcn_mfma_f32_16x16x32_bf16(Bt[n][k], At[m][k], acc[ai][bj][m][n], 0, 0, 0); __builtin_amdgcn_s_setprio(0); } while (0)
#define PG8_WAIT_V(n) asm volatile("s_waitcnt vmcnt(" #n ")" ::: "memory")
#define PG8_WAIT_L(n) asm volatile("s_waitcnt lgkmcnt(" #n ")" ::: "memory")
#define PG8_BAR __builtin_amdgcn_s_barrier()
#define PG8_SCHED __builtin_amdgcn_sched_barrier(0)
    Unit cur, nxt; int ui = 0;
    if (!S.next(0, cur)) return;
    f32x4 acc[2][2][4][2];
#pragma unroll
    for (int a = 0; a < 2; ++a)
#pragma unroll
        for (int b = 0; b < 2; ++b)
#pragma unroll
            for (int m = 0; m < 4; ++m)
#pragma unroll
                for (int n = 0; n < 2; ++n) acc[a][b][m][n] = (f32x4){0.f, 0.f, 0.f, 0.f};
    bf16x8 At[4][2], B0[2][2], B1[2][2];
    const char* cA = cur.A; const char* cB = cur.B;
    PG8_GROWS(cur, nR00, nR01, nR10, nR11); vC00 = PG8_GOFF(nR00, gC0); vC01 = PG8_GOFF(nR01, gC1); vC10 = PG8_GOFF(nR10, gC0); vC11 = PG8_GOFF(nR11, gC1);
    PG8_STAGE(PG8_SB(0, 0), cB, voffA); PG8_STAGE_A(PG8_SA(0, 0), cA, 0, false); PG8_STAGE(PG8_SB(0, 1), cB + hstep, voffA); PG8_STAGE_A(PG8_SA(0, 1), cA, 1, false);
    if (wr == 1) PG8_BAR;
    PG8_WAIT_V(4); PG8_BAR;
    PG8_STAGE(PG8_SB(1, 0), cB + kstep, voffA); PG8_STAGE_A(PG8_SA(1, 0), cA + kstep, 0, false); PG8_STAGE(PG8_SB(1, 1), cB + hstep + kstep, voffA);
    PG8_WAIT_V(6); PG8_BAR;
    for (;;) {
        const bool has_next = S.next(ui + 1, nxt);
        const char* nA = has_next ? nxt.A : cA; const char* nB = has_next ? nxt.B : cB;
        if (has_next) PG8_GROWS(nxt, nR00, nR01, nR10, nR11);
        for (int t = 0; t < nt; t += 2) {
            const bool last = (t == nt - 2);
            const char* a1 = cA + (size_t)(t + 1) * kstep;
            const char* a2 = last ? nA : cA + (size_t)(t + 2) * kstep; const char* b2 = last ? nB : cB + (size_t)(t + 2) * kstep;
            const char* a3 = a2 + kstep; const char* b3 = b2 + kstep;
            PG8_LDB(B0, 0, 0); PG8_SCHED; PG8_LDA(At, 0, 0); PG8_STAGE_A(PG8_SA(1, 1), a1, 1, false);
            PG8_WAIT_L(8); PG8_BAR; PG8_WAIT_L(0); PG8_MMA(0, 0, At, B0); PG8_BAR; PG8_SCHED;
            PG8_LDB(B1, 0, 1); PG8_STAGE(PG8_SB(0, 0), b2, voffA);
            PG8_BAR; PG8_WAIT_L(0); PG8_MMA(0, 1, At, B1); PG8_BAR;
            PG8_LDA(At, 0, 1); PG8_STAGE_A(PG8_SA(0, 0), a2, 0, last);
            PG8_BAR; PG8_WAIT_L(0); PG8_MMA(1, 0, At, B0); PG8_BAR; PG8_SCHED;
            PG8_STAGE(PG8_SB(0, 1), b2 + hstep, voffA);
            PG8_WAIT_V(6); PG8_BAR; PG8_MMA(1, 1, At, B1); PG8_BAR;
            PG8_LDB(B0, 1, 0); PG8_SCHED; PG8_LDA(At, 1, 0); PG8_STAGE_A(PG8_SA(0, 1), a2, 1, last);
            PG8_WAIT_L(8); PG8_BAR; PG8_WAIT_L(0); PG8_MMA(0, 0, At, B0); PG8_BAR; PG8_SCHED;
            PG8_LDB(B1, 1, 1); PG8_STAGE(PG8_SB(1, 0), b3, voffA);
            PG8_BAR; PG8_WAIT_L(0); PG8_MMA(0, 1, At, B1); PG8_BAR;
            PG8_LDA(At, 1, 1); PG8_STAGE_A(PG8_SA(1, 0), a3, 0, last);
            PG8_BAR; PG8_WAIT_L(0); PG8_MMA(1, 0, At, B0); PG8_BAR; PG8_SCHED;
            PG8_STAGE(PG8_SB(1, 1), b3 + hstep, voffA);
            PG8_WAIT_V(6); PG8_BAR; PG8_MMA(1, 1, At, B1); PG8_BAR;
        }
        E(acc, cur, wr, wc, fr, fq);
        if (!has_next) break;
#pragma unroll
        for (int a = 0; a < 2; ++a)
#pragma unroll
            for (int b = 0; b < 2; ++b)
#pragma unroll
                for (int m = 0; m < 4; ++m)
#pragma unroll
                    for (int n = 0; n < 2; ++n) acc[a][b][m][n] = (f32x4){0.f, 0.f, 0.f, 0.f};
        cur = nxt; cA = nA; cB = nB; ++ui; vC00 = PG8_GOFF(nR00, gC0); vC01 = PG8_GOFF(nR01, gC1); vC10 = PG8_GOFF(nR10, gC0); vC11 = PG8_GOFF(nR11, gC1);
    }
    PG8_WAIT_V(0);
    if (wr == 0) PG8_BAR;
    PG8_BAR;
#undef PG8_SA
#undef PG8_SB
#undef PG8_STAGE
#undef PG8_STAGE_A
#undef PG8_GROWS
#undef PG8_GOFF
#undef PG8_LDA
#undef PG8_LDB
#undef PG8_MMA
#undef PG8_WAIT_V
#undef PG8_WAIT_L
#undef PG8_BAR
#undef PG8_SCHED
}
template <class F> struct EpiRC { F f;
    __device__ __forceinline__ void operator()(const f32x4 (&acc)[2][2][4][2], const Unit& u, int wr, int wc, int fr, int fq) const {
#pragma unroll
        for (int ai = 0; ai < 2; ++ai)
#pragma unroll
            for (int m = 0; m < 4; ++m) { const int row = u.pm * BM + ai * HALF + wr * 64 + m * 16 + fr;
#pragma unroll
                for (int bj = 0; bj < 2; ++bj)
#pragma unroll
                    for (int n = 0; n < 2; ++n) f(u, row, u.pn * BM + bj * HALF + wc * 32 + n * 16 + 4 * fq, acc[ai][bj][m][n]);
                asm volatile("" ::: "memory"); }
    } };
template <class F> __device__ __forceinline__ EpiRC<F> epi_rc(const F& f) { return EpiRC<F>{f}; }
template <class F> struct EpiPair { F f;
    __device__ __forceinline__ void operator()(const f32x4 (&acc)[2][2][4][2], const Unit& u, int wr, int wc, int fr, int fq) const {
#pragma unroll
        for (int ai = 0; ai < 2; ++ai)
#pragma unroll
            for (int m = 0; m < 4; ++m) { const int row = u.pm * BM + ai * HALF + wr * 64 + m * 16 + fr;
#pragma unroll
                for (int n = 0; n < 2; ++n) f(u, row, u.pn * HALF + wc * 32 + n * 16 + 4 * fq, acc[ai][0][m][n], acc[ai][1][m][n]);
                asm volatile("" ::: "memory"); }
    } };
template <class F> __device__ __forceinline__ EpiPair<F> epi_pair(const F& f) { return EpiPair<F>{f}; }
template <class F, class CF, class RF> struct EpiPre { F f; CF cf; RF rf;
    __device__ __forceinline__ void operator()(const f32x4 (&acc)[2][2][4][2], const Unit& u, int wr, int wc, int fr, int fq) const {
        f32x4 cv[2][2]; float rv[2][4];
#pragma unroll
        for (int bj = 0; bj < 2; ++bj)
#pragma unroll
            for (int n = 0; n < 2; ++n) cv[bj][n] = cf(u, u.pn * BM + bj * HALF + wc * 32 + n * 16 + 4 * fq);
#pragma unroll
        for (int ai = 0; ai < 2; ++ai)
#pragma unroll
            for (int m = 0; m < 4; ++m) rv[ai][m] = rf(u, u.pm * BM + ai * HALF + wr * 64 + m * 16 + fr);
#pragma unroll
        for (int ai = 0; ai < 2; ++ai)
#pragma unroll
            for (int m = 0; m < 4; ++m) { const int row = u.pm * BM + ai * HALF + wr * 64 + m * 16 + fr;
#pragma unroll
                for (int bj = 0; bj < 2; ++bj)
#pragma unroll
                    for (int n = 0; n < 2; ++n) f(u, row, u.pn * BM + bj * HALF + wc * 32 + n * 16 + 4 * fq, acc[ai][bj][m][n], cv[bj][n], rv[ai][m]);
                asm volatile("" ::: "memory"); }
    } };
template <class F, class CF, class RF> __device__ __forceinline__ EpiPre<F, CF, RF> epi_pre(const F& f, const CF& cf, const RF& rf) { return EpiPre<F, CF, RF>{f, cf, rf}; }
template <class F, class CF> struct EpiColFirst { F f; CF cf;
    __device__ __forceinline__ void operator()(const f32x4 (&acc)[2][2][4][2], const Unit& u, int wr, int wc, int fr, int fq) const {
#pragma unroll
        for (int bj = 0; bj < 2; ++bj)
#pragma unroll
            for (int n = 0; n < 2; ++n) { const int col = u.pn * BM + bj * HALF + wc * 32 + n * 16 + 4 * fq; const f32x4 cv = cf(u, col);
#pragma unroll
                for (int ai = 0; ai < 2; ++ai)
#pragma unroll
                    for (int m = 0; m < 4; ++m) f(u, u.pm * BM + ai * HALF + wr * 64 + m * 16 + fr, col, acc[ai][bj][m][n], cv);
                asm volatile("" ::: "memory"); }
    } };
template <class F, class CF> __device__ __forceinline__ EpiColFirst<F, CF> epi_colfirst(const F& f, const CF& cf) { return EpiColFirst<F, CF>{f, cf}; }
struct EpiResid { xt_t* X; const float* MOD; int layer;
    __device__ __forceinline__ void operator()(const f32x4 (&acc)[2][2][4][2], const Unit& u, int wr, int wc, int fr, int fq) const {
        const int row0 = u.pm * BM + wr * 64 + fr, col0 = u.pn * BM + wc * 32 + 4 * fq;
        const int strm = row0 < NLAT ? (row0 >> 12) : 4;
        const float* gp = MOD + ((size_t)layer * 5 + strm) * 6144 + 2048 + col0;
        f32x4 gt[2][2];
#pragma unroll
        for (int bj = 0; bj < 2; ++bj)
#pragma unroll
            for (int n = 0; n < 2; ++n) gt[bj][n] = *(const f32x4*)(gp + bj * HALF + n * 16);
#pragma unroll
        for (int ai = 0; ai < 2; ++ai) {
            f32x4 xv[4][2][2];
#pragma unroll
            for (int m = 0; m < 4; ++m)
#pragma unroll
                for (int bj = 0; bj < 2; ++bj)
#pragma unroll
                    for (int n = 0; n < 2; ++n) xv[m][bj][n] = xldv(X, (size_t)(row0 + ai * HALF + m * 16) * D + col0 + bj * HALF + n * 16);
#pragma unroll
            for (int m = 0; m < 4; ++m)
#pragma unroll
                for (int bj = 0; bj < 2; ++bj)
#pragma unroll
                    for (int n = 0; n < 2; ++n) xstv(X, (size_t)(row0 + ai * HALF + m * 16) * D + col0 + bj * HALF + n * 16, xv[m][bj][n] + gt[bj][n] * acc[ai][bj][m][n]);
            asm volatile("" ::: "memory");
        }
    } };
struct BatchSched { const char* A; const char* B; size_t strideA, strideB; int nM, nN, nb, K; int rev = 0;
    __device__ __forceinline__ bool next(int i, Unit& u) const {
        const int nwg = nM * nN * nb; const int L = i * gdim() + (rev ? gdim() - 1 - bidx() : bidx()); if (L >= nwg) return false;
        const int w = xcd_remap(L, nwg); const int per = nM * nN; u.g = w / per; const int r = w % per; u.pm = r / nN; u.pn = r % nN;
        u.A = A + u.g * strideA + (size_t)u.pm * BM * K * 2; u.B = B + u.g * strideB + (size_t)u.pn * BM * K * 2; return true; } };
}

template <class SrcF, class DRow>
__device__ __forceinline__ int cvt_tiles(const int wv_, char* lds, bf16_t* dst, int Kd, int Nd, int nbatch, size_t dstride, const SrcF& src, const DRow& drow, int* rot = nullptr) {
    bf16_t* T = (bf16_t*)lds;
    const int tid = tidx_w(wv_);
    const int tk = Kd / 128, tn = Nd / 64, per = tk * tn, total = per * nbatch;
    {
        int first = bidx() - (rot ? *rot % gdim() : 0); if (first < 0) first += gdim();
        if (rot) *rot += total;
        for (int t = first; t < total; t += gdim()) {
            const int bt = t / per, r = t % per, k0 = (r % tk) * 128, n0 = (r / tk) * 64;
            float4 v[4];
#pragma unroll
            for (int i = 0; i < 4; ++i) { const int k = k0 + i * 32 + (tid >> 4), n = n0 + (tid & 15) * 4; const float* sp = src(bt, k, n); v[i] = sp ? *(const float4*)sp : make_float4(0.f, 0.f, 0.f, 0.f); }
            __syncthreads();
#pragma unroll
            for (int i = 0; i < 4; ++i) { const int k = i * 32 + (tid >> 4), n = (tid & 15) * 4;
                T[(n + 0) * 136 + k] = f2bf(v[i].x); T[(n + 1) * 136 + k] = f2bf(v[i].y); T[(n + 2) * 136 + k] = f2bf(v[i].z); T[(n + 3) * 136 + k] = f2bf(v[i].w); }
            __syncthreads();
            { const int n = tid >> 3, kc = (tid & 7) * 16;
              const u32x4 a = *(const u32x4*)(T + n * 136 + kc), b = *(const u32x4*)(T + n * 136 + kc + 8);
              bf16_t* dp = dst + bt * dstride + (size_t)drow(n0 + n) * Kd + k0 + kc;
              *(u32x4*)dp = a; *(u32x4*)(dp + 8) = b; }
        }
    }
    return 0;
}
__device__ __forceinline__ int moe_cvt(const Params& p, int layer, char* lds, int budget) {
    constexpr int QG = 2, T13 = NE * 8 * 44, TOT = T13 + NE * 11 * 16;
    bf16_t* T = (bf16_t*)lds;
    int* qslot = (int*)(lds + 64 * 136 * 2);
    const int tid = tidx();
    const float* w1 = p.moe_w1 + (size_t)layer * NE * D * FF; const float* w3 = p.moe_w3 + (size_t)layer * NE * D * FF; const float* w2 = p.moe_w2 + (size_t)layer * NE * FF * D;
    bf16_t* W13 = (bf16_t*)(p.ws + OFF_W13T + (size_t)(layer & 1) * SZ_WMOE); bf16_t* W2 = (bf16_t*)(p.ws + OFF_W2T + (size_t)(layer & 1) * SZ_WMOE);
    unsigned* queue = (unsigned*)(p.ws + OFF_QUEUE) + layer * 32;
    const bool ahead = budget < 0;
    int done = 0, tnext = 0;
    __syncthreads();
    if (tid == 0) qslot[0] = QG * (int)__hip_atomic_fetch_add(queue, 1u, __ATOMIC_RELAXED, __HIP_MEMORY_SCOPE_AGENT);
    __syncthreads();
    int t0 = __builtin_amdgcn_readfirstlane(qslot[0]);
    while (t0 < TOT && (ahead || done < budget)) {
        const bool more = ahead || done + 1 < budget;
        if (more && tid == 0) tnext = QG * (int)__hip_atomic_fetch_add(queue, 1u, __ATOMIC_RELAXED, __HIP_MEMORY_SCOPE_AGENT);
#pragma unroll 1
        for (int sub = 0; sub < QG; ++sub) {
            const int t = t0 + sub;
            const float* sp; bf16_t* dp; int ss, ds;
            if (t < T13) { const int e = t / 352, r = t % 352, k0 = (r & 7) * 128, n0 = (r >> 3) * 64; const int c0 = (n0 >> 8) * 128 + (n0 & 127);
                sp = (((n0 >> 7) & 1) ? w3 : w1) + ((size_t)e * D + k0) * FF + c0; ss = FF; dp = W13 + ((size_t)e * 2816 + n0) * D + k0; ds = D; }
            else { const int u = t - T13, e = u / 176, r = u % 176, k0 = (r % 11) * 128, n0 = (r / 11) * 64;
                sp = w2 + ((size_t)e * FF + k0) * D + n0; ss = D; dp = W2 + ((size_t)e * D + n0) * FF + k0; ds = FF; }
            float4 v[4];
#pragma unroll
            for (int i = 0; i < 4; ++i) v[i] = *(const float4*)(sp + (size_t)(i * 32 + (tid >> 4)) * ss + (tid & 15) * 4);
            __syncthreads();
#pragma unroll
            for (int i = 0; i < 4; ++i) { const int k = i * 32 + (tid >> 4), n = (tid & 15) * 4;
                T[(n + 0) * 136 + k] = f2bf(v[i].x); T[(n + 1) * 136 + k] = f2bf(v[i].y); T[(n + 2) * 136 + k] = f2bf(v[i].z); T[(n + 3) * 136 + k] = f2bf(v[i].w); }
            if (sub == QG - 1 && tid == 0) qslot[0] = more ? tnext : TOT;
            __syncthreads();
            { const int n = tid >> 3, kc = (tid & 7) * 16;
              const u32x4 a = *(const u32x4*)(T + n * 136 + kc), b = *(const u32x4*)(T + n * 136 + kc + 8);
              bf16_t* o = dp + (size_t)n * ds + kc;
              *(u32x4*)o = a; *(u32x4*)(o + 8) = b; }
        }
        ++done; t0 = __builtin_amdgcn_readfirstlane(qslot[0]);
    }
    __syncthreads();
    return done;
}
__device__ __forceinline__ void bg_cvt(const Params& p, int layer, char* lds, int budget) {
#pragma unroll 1
    for (int l = layer; l < 4 && l <= layer + 1 && budget > 0; ++l) budget -= moe_cvt(p, l, lds, budget);
}
__device__ __forceinline__ bool idle_tail(int nunits) { const int r = nunits % gdim(); return r != 0 && bidx() >= r; }
__device__ void ph_init(const Params& p, char* lds) {
    const int tid = tidx(), gtid = bidx() * NTHR + tid, gsz = gdim() * NTHR;
    xt_t* Xs = (xt_t*)(p.ws + OFF_X);
    const float4* x4 = (const float4*)p.x; const float4* c4 = (const float4*)p.ctx;
    { constexpr int NQ = NROW * 256 / 4;
      auto srcv = [&](int k) { return k < NLAT * 256 ? x4[k] : c4[k - NLAT * 256]; };
      for (int i = gtid; i < NQ; i += gsz) { const float4 t0 = srcv(i), t1 = srcv(i + NQ), t2 = srcv(i + 2 * NQ), t3 = srcv(i + 3 * NQ); xst(Xs, (size_t)4 * i, t0); xst(Xs, (size_t)4 * (i + NQ), t1); xst(Xs, (size_t)4 * (i + 2 * NQ), t2); xst(Xs, (size_t)4 * (i + 3 * NQ), t3); } }
    float* rc = (float*)(p.ws + OFF_ROPE_C); float* rs = (float*)(p.ws + OFF_ROPE_S);
    for (int i = gtid; i < TL * 32; i += gsz) {
        const int t = i >> 5, f = i & 31; const float pos = (float)((f < 16) ? (t >> 6) : (t & 63));
        const float inv = powf(10000.f, -(float)(f & 15) / 16.f); const float ang = pos * inv; rc[2 * i] = cosf(ang); rc[2 * i + 1] = sinf(ang);
    }
    float* sc = (float*)lds;
    float* red = sc + 5 * 1024;
    for (int i = tid; i < 5 * 1024; i += NTHR) { const float v = i < 4096 ? p.c[i] : p.c_ctx[i - 4096]; sc[i] = v / (1.f + expf(-v)); }
    __syncthreads();
    float* MOD = (float*)(p.ws + OFF_MOD);
    for (int item = bidx(); item < 4 * 96; item += gdim()) {
        const int l = item / 96, cg = item % 96, col = tid & 63, n = cg * 64 + col, kg = tid >> 6;
        const float* w = p.mod_w + ((size_t)l * 1024 + kg * 128) * 6144 + n;
        float a0 = 0, a1 = 0, a2 = 0, a3 = 0, a4 = 0;
#pragma unroll 16
        for (int k = 0; k < 128; ++k) { const float wv = w[(size_t)k * 6144]; const int kk = kg * 128 + k;
            a0 += sc[kk] * wv; a1 += sc[1024 + kk] * wv; a2 += sc[2048 + kk] * wv; a3 += sc[3072 + kk] * wv; a4 += sc[4096 + kk] * wv; }
        float* rr = red + (kg * 64 + col) * 5; rr[0] = a0; rr[1] = a1; rr[2] = a2; rr[3] = a3; rr[4] = a4;
        __syncthreads();
        if (tid < 320) { const int c2 = tid & 63, s = tid >> 6; float sum = 0;
            for (int q = 0; q < 8; ++q) sum += red[(q * 64 + c2) * 5 + s];
            MOD[((size_t)l * 5 + s) * 6144 + cg * 64 + c2] = sum + p.mod_b[l * 6144 + cg * 64 + c2]; }
        __syncthreads();
    }
}


__device__ void ph_small_cvt(const Params& p, char* lds) {
    int rot = 128;
    for (int j = 0; j < 2; ++j) {
        char* wm = p.ws + OFF_WMLA + j * SZ_WMLA; char* wr = p.ws + OFF_WRW + j * SZ_WRW;
        const float* w_in = p.mla_w_in + (size_t)j * D * 448; const float* w_uq = p.mla_w_uq + (size_t)j * 256 * 1536; const float* w_ukv = p.mla_w_ukv + (size_t)j * 128 * 2048; const float* w_o = p.mla_w_o + (size_t)j * D * D;
        cvt_tiles(p.wv, lds, (bf16_t*)(wm + WM_IN), 1024, 512, 1, 0, [=](int, int k, int n) -> const float* { return n < 448 ? w_in + (size_t)k * 448 + n : nullptr; },
                  [=](int n) { if (n < 384 || n >= 448) return n; const int jj = n - 384; return 384 + (jj < 32 ? 2 * jj : 2 * (jj - 32) + 1); }, &rot);
        cvt_tiles(p.wv, lds, (bf16_t*)(wm + WM_UQ), 256, 1536, 1, 0, [=](int, int k, int n) -> const float* { return w_uq + (size_t)k * 1536 + n; },
                  [=](int n) { const int h = n / 192, d = n % 192; if (d < 128) return n; const int jj = d - 128; return h * 192 + 128 + (jj < 32 ? 2 * jj : 2 * (jj - 32) + 1); }, &rot);
        cvt_tiles(p.wv, lds, (bf16_t*)(wm + WM_UKV), 128, 2048, 1, 0, [=](int, int k, int n) -> const float* { return w_ukv + (size_t)k * 2048 + n; }, [=](int n) { return n; }, &rot);
        cvt_tiles(p.wv, lds, (bf16_t*)(wm + WM_O), 1024, 1024, 1, 0, [=](int, int k, int n) -> const float* { return w_o + (size_t)k * D + n; }, [=](int n) { return n; }, &rot);
        const float* w_rkv = p.rw_w_rkv + (size_t)j * 3 * D * D; const float* w1 = p.rw_w1 + (size_t)j * 2 * D * 64; const float* a1 = p.rw_a1 + (size_t)j * 2 * D * 64;
        const float* g1 = p.rw_g1 + (size_t)j * D * 128; const float* v1 = p.rw_v1; const float* rwo = p.rw_w_o + (size_t)j * D * D;
        cvt_tiles(p.wv, lds, (bf16_t*)(wr + WR_RKV), 1024, 1024, 3, (size_t)D * D, [=](int m, int k, int n) -> const float* { return w_rkv + ((size_t)m * D + k) * D + n; }, [=](int n) { return n; }, &rot);
        cvt_tiles(p.wv, lds, (bf16_t*)(wr + WR_L), 1024, 256, 1, 0, [=](int, int k, int n) -> const float* { return n < 128 ? w1 + ((size_t)(n >> 6) * D + k) * 64 + (n & 63) : nullptr; }, [=](int n) { return n; }, &rot);
        cvt_tiles(p.wv, lds, (bf16_t*)(wr + WR_L) + 256 * 1024, 1024, 256, 1, 0, [=](int, int k, int n) -> const float* { return n < 128 ? a1 + ((size_t)(n >> 6) * D + k) * 64 + (n & 63) : nullptr; }, [=](int n) { return n; }, &rot);
        cvt_tiles(p.wv, lds, (bf16_t*)(wr + WR_L) + 2 * 256 * 1024, 1024, 256, 1, 0, [=](int, int k, int n) -> const float* { return n < 128 ? g1 + (size_t)k * 128 + n : nullptr; }, [=](int n) { return n; }, &rot);
        cvt_tiles(p.wv, lds, (bf16_t*)(wr + WR_L) + 3 * 256 * 1024, 1024, 256, 1, 0, [=](int, int k, int n) -> const float* { return n < 32 ? v1 + (size_t)k * 32 + n : nullptr; }, [=](int n) { return n; }, &rot);
        cvt_tiles(p.wv, lds, (bf16_t*)(wr + WR_O), 1024, 1024, 1, 0, [=](int, int k, int n) -> const float* { return rwo + (size_t)k * D + n; }, [=](int n) { return n; }, &rot);
        const float* w2 = p.rw_w2 + (size_t)j * 2 * 64 * D; const float* a2 = p.rw_a2 + (size_t)j * 2 * 64 * D; const float* g2 = p.rw_g2 + (size_t)j * 128 * D; const float* v2 = p.rw_v2;
        cvt_tiles(p.wv, lds, (bf16_t*)(wr + WR_B2), 128, 2048, 2, (size_t)2048 * 128, [=](int bt, int k, int n) -> const float* { const int zz = n >> 10, c = n & 1023, l = k - zz * 64;
            if (l < 0 || l >= 64) return nullptr; return (bt == 0 ? w2 : a2) + ((size_t)zz * 64 + l) * D + c; }, [=](int n) { return n; }, &rot);
        cvt_tiles(p.wv, lds, (bf16_t*)(wr + WR_B3), 128, 1024, 2, (size_t)1024 * 128, [=](int bt, int k, int n) -> const float* {
            if (bt == 0) return g2 + (size_t)k * D + n; return k < 32 ? v2 + (size_t)k * D + n : nullptr; }, [=](int n) { return n; }, &rot);
    }
}

template <bool OUTF32>
__device__ void ph_norm_mod(const Params& p, int layer, const float* g, int part_sh, int part_sc, void* outp) {
    const int wid = tidx() >> 6, lane = tidx() & 63;
    const xt_t* X = (const xt_t*)(p.ws + OFF_X);
    const int w_ = bidx() * 8 + wid, nw_ = gdim() * 8;
    int row = (int)((long long)w_ * NROW / nw_); const int rend = (int)((long long)(w_ + 1) * NROW / nw_);
    float4 nv[4], gm[4], bb[4]; int scur = -1;
    if (row < rend) {
#pragma unroll
        for (int i = 0; i < 4; ++i) nv[i] = xld(X, (size_t)row * D + (lane + i * 64) * 4); }
    for (; row < rend; ++row) {
        const int s = row_stream(row);
        if (s != scur) { scur = s; const float* sh = modp(p, layer, s, part_sh); const float* sc = modp(p, layer, s, part_sc);
#pragma unroll
            for (int i = 0; i < 4; ++i) { const int d = (lane + i * 64) * 4; const float4 gg = *(const float4*)(g + d), a = *(const float4*)(sc + d); bb[i] = *(const float4*)(sh + d);
                gm[i] = make_float4(gg.x * (1.f + a.x), gg.y * (1.f + a.y), gg.z * (1.f + a.z), gg.w * (1.f + a.w)); } }
        float4 v[4]; float ss = 0;
#pragma unroll
        for (int i = 0; i < 4; ++i) { v[i] = nv[i]; ss += v[i].x * v[i].x + v[i].y * v[i].y + v[i].z * v[i].z + v[i].w * v[i].w; }
        { const int nrow = row + 1;
          if (nrow < rend) {
#pragma unroll
              for (int i = 0; i < 4; ++i) nv[i] = xld(X, (size_t)nrow * D + (lane + i * 64) * 4); } }
        ss = wave_sum(ss); const float rs = rsqrtf(ss * (1.f / D) + RMS_EPS);
#pragma unroll
        for (int i = 0; i < 4; ++i) {
            const int d = (lane + i * 64) * 4;
            float4 o; o.x = v[i].x * rs * gm[i].x + bb[i].x; o.y = v[i].y * rs * gm[i].y + bb[i].y; o.z = v[i].z * rs * gm[i].z + bb[i].z; o.w = v[i].w * rs * gm[i].w + bb[i].w;
            if (OUTF32) *(float4*)((float*)outp + (size_t)row * D + d) = o;
            else { uint2 w; w.x = pk2(o.x, o.y); w.y = pk2(o.z, o.w); *(uint2*)((bf16_t*)outp + (size_t)row * D + d) = w; }
        }
    }
}

__device__ void ph_mla_mid(const Params& p, int j) {
    const int wid = tidx() >> 6, lane = tidx() & 63;
    const bf16_t* Z = (const bf16_t*)(p.ws + OFF_Z);
    bf16_t* CQN = (bf16_t*)(p.ws + OFF_CQN); bf16_t* CKVN = (bf16_t*)(p.ws + OFF_CKVN); bf16_t* K = (bf16_t*)(p.ws + OFF_K);
    const float* gq = p.mla_g_q + j * 256; const float* gkv = p.mla_g_kv + j * 128;
    const float* rc = (const float*)(p.ws + OFF_ROPE_C); const float* rs = (const float*)(p.ws + OFF_ROPE_S);
    for (int row = bidx() * 8 + wid; row < NROW; row += gdim() * 8) {
        const bf16_t* z = Z + (size_t)row * 512;
        const f32x4 q4 = ldbf4(z + lane * 4); const float4 q = make_float4(q4[0], q4[1], q4[2], q4[3]);
        const unsigned kvw = *(const unsigned*)(z + 256 + lane * 2); const float2 kv = make_float2(__uint_as_float(kvw << 16), __uint_as_float(kvw & 0xffff0000u));
        const float kr = __uint_as_float((unsigned)z[384 + lane] << 16);
        float sq = wave_sum(q.x * q.x + q.y * q.y + q.z * q.z + q.w * q.w); const float rq = rsqrtf(sq * (1.f / 256.f) + RMS_EPS);
        float sk = wave_sum(kv.x * kv.x + kv.y * kv.y); const float rk = rsqrtf(sk * (1.f / 128.f) + RMS_EPS);
        const float4 g4 = *(const float4*)(gq + lane * 4); const float2 g2 = *(const float2*)(gkv + lane * 2);
        uint2 w; w.x = pk2(q.x * rq * g4.x, q.y * rq * g4.y); w.y = pk2(q.z * rq * g4.z, q.w * rq * g4.w);
        *(uint2*)(CQN + (size_t)row * 256 + lane * 4) = w;
        *(unsigned*)(CKVN + (size_t)row * 128 + lane * 2) = pk2(kv.x * rk * g2.x, kv.y * rk * g2.y);
        float o = kr;
        const float other = __builtin_bit_cast(float, __builtin_amdgcn_update_dpp(0, __builtin_bit_cast(int, kr), 0xB1, 0xF, 0xF, true));
        const bool lat = row < NLAT;
        if (lat) { const int t = row & (TL - 1), i = lane >> 1; const float2 cs = *(const float2*)(rc + (t * 32 + i) * 2); const float c = cs.x, s = cs.y;
            o = (lane & 1) ? (other * s + kr * c) : (kr * c - other * s); }
        const int b = lat ? (row >> 12) : ((row - NLAT) >> 8); const int tk = lat ? 256 + (row & (TL - 1)) : ((row - NLAT) & 255);
        const bf16_t ob = f2bf(o);
#pragma unroll
        for (int h = 0; h < 8; ++h) K[((size_t)(b * 8 + h) * TK + tk) * 192 + 128 + lane] = ob;
    }
}

__device__ void ph_qkv_post(const Params& p) {
    const int wid = tidx() >> 6, lane = tidx() & 63;
    const float* QRAW = (const float*)(p.ws + OFF_QRAW); const float* KVRAW = (const float*)(p.ws + OFF_KVRAW); const float* KR = (const float*)(p.ws + OFF_KR);
    bf16_t* Q = (bf16_t*)(p.ws + OFF_Q); bf16_t* K = (bf16_t*)(p.ws + OFF_K); bf16_t* V = (bf16_t*)(p.ws + OFF_V);
    const float* rc = (const float*)(p.ws + OFF_ROPE_C); const float* rs = (const float*)(p.ws + OFF_ROPE_S);
    for (int it = bidx() * 8 + wid; it < NROW * 8; it += gdim() * 8) {
        const int row = it >> 3, h = it & 7;
        const bool lat = row < NLAT; const int b = lat ? (row >> 12) : ((row - NLAT) >> 8); const int tk = lat ? 256 + (row & (TL - 1)) : ((row - NLAT) & 255);
        const size_t orow = (size_t)(b * 8 + h) * TK + tk;
        const float* q = QRAW + (size_t)row * 1536 + h * 192;
        const float q0 = q[lane], q1 = q[64 + lane]; float q2 = q[128 + lane];
        const auto sw = __builtin_amdgcn_permlane32_swap(__float_as_uint(q2), __float_as_uint(q2), false, false);
        if (lat) { const int t = row & (TL - 1), i = lane & 31; const float c = rc[t * 32 + i], s = rs[t * 32 + i];
            const float x1 = __uint_as_float(sw[0]), x2 = __uint_as_float(sw[1]); q2 = lane < 32 ? (x1 * c - x2 * s) : (x1 * s + x2 * c); }
        bf16_t* qo = Q + orow * 192; qo[lane] = f2bf(q0); qo[64 + lane] = f2bf(q1); qo[128 + lane] = f2bf(q2);
        const float* kv = KVRAW + (size_t)row * 2048 + h * 256;
        bf16_t* ko = K + orow * 192; ko[lane] = f2bf(kv[lane]); ko[64 + lane] = f2bf(kv[64 + lane]); ko[128 + lane] = f2bf(KR[(size_t)row * 64 + lane]);
        bf16_t* vo = V + orow * 128; vo[lane] = f2bf(kv[128 + lane]); vo[64 + lane] = f2bf(kv[192 + lane]);
    }
}

__device__ void ph_attn_naive(const Params& p, char* lds) {
    const int tid = tidx(), qi = tid >> 2, part = tid & 3;
    const bf16_t* Q = (const bf16_t*)(p.ws + OFF_Q); const bf16_t* K = (const bf16_t*)(p.ws + OFF_K); const bf16_t* V = (const bf16_t*)(p.ws + OFF_V);
    bf16_t* O = (bf16_t*)(p.ws + OFF_O);
    bf16_t* Ks = (bf16_t*)lds;
    bf16_t* Vs = Ks + 32 * 192;
    const int nitems = 32 * 34;
    for (int it = bidx(); it < nitems; it += gdim()) {
        const int bh = it / 34, qb = it % 34; const int b = bh >> 3, h = bh & 7;
        const int nkeys = qb < 2 ? TC : TK;
        const int tq = qb * 128 + qi;
        const bf16_t* qp = Q + ((size_t)bh * TK + tq) * 192 + part * 48;
        float q[48];
#pragma unroll
        for (int i = 0; i < 48; ++i) q[i] = bf2f(qp[i]) * ATT_SCALE;
        float o[32];
#pragma unroll
        for (int i = 0; i < 32; ++i) o[i] = 0.f;
        float m = -1e30f, l = 0.f;
        for (int k0 = 0; k0 < nkeys; k0 += 32) {
            __syncthreads();
            {
                const bf16_t* kg = K + ((size_t)bh * TK + k0) * 192; const bf16_t* vg = V + ((size_t)bh * TK + k0) * 128;
                for (int c = tid; c < 768; c += NTHR) *(u32x4*)(Ks + c * 8) = *(const u32x4*)(kg + c * 8);
                *(u32x4*)(Vs + tid * 8) = *(const u32x4*)(vg + tid * 8);
            }
            __syncthreads();
#pragma unroll 1
            for (int kg = 0; kg < 32; kg += 8) {
                float s[8]; float tmax = -1e30f;
#pragma unroll
                for (int kk = 0; kk < 8; ++kk) {
                    const bf16_t* kr = Ks + (kg + kk) * 192 + part * 48; float acc = 0.f;
#pragma unroll
                    for (int i = 0; i < 48; ++i) acc += q[i] * bf2f(kr[i]);
                    acc += __shfl_xor(acc, 1); acc += __shfl_xor(acc, 2);
                    s[kk] = acc; tmax = fmaxf(tmax, acc);
                    asm volatile("" ::: "memory");
                }
                const float mn = fmaxf(m, tmax), alpha = expf(m - mn); m = mn; l *= alpha;
#pragma unroll
                for (int i = 0; i < 32; ++i) o[i] *= alpha;
#pragma unroll
                for (int kk = 0; kk < 8; ++kk) {
                    const float pw = expf(s[kk] - mn); l += pw;
                    const bf16_t* vr = Vs + (kg + kk) * 128 + part * 32;
#pragma unroll
                    for (int i = 0; i < 32; ++i) o[i] += pw * bf2f(vr[i]);
                    asm volatile("" ::: "memory");
                }
            }
        }
        const float rl = 1.f / l;
        const int row = qb < 2 ? (NLAT + b * TC + tq) : (b * TL + tq - TC);
        bf16_t* op = O + (size_t)row * D + h * 128 + part * 32;
#pragma unroll
        for (int i = 0; i < 32; ++i) op[i] = f2bf(o[i] * rl);
    }
}


namespace fa {
using s16x4  = __attribute__((ext_vector_type(4))) short;
using f32x16 = __attribute__((ext_vector_type(16))) float;
constexpr int DQK = 192, DV = 128, KVBLK = 64;
constexpr float THR = 8.f;
constexpr int SHM_V = KVBLK * DV * 2, SHM_K = KVBLK * DQK * 2;
constexpr int SHM_ATTN = 2 * SHM_V + 2 * SHM_K + 8 * 64 * 4;
#define KSWZ(row, colB) ((row) * 384 + ((colB) ^ ((((row) >> 1) & 7) << 4)))
#define SBAR() __builtin_amdgcn_sched_barrier(0)
__device__ __forceinline__ int crow(int r, int hi) { return (r & 3) + 8 * (r >> 2) + 4 * hi; }
__device__ __forceinline__ unsigned cvtpk(float lo, float hi) { unsigned r; asm volatile("v_cvt_pk_bf16_f32 %0, %1, %2" : "=v"(r) : "v"(lo), "v"(hi)); return r; }
__device__ __forceinline__ void partialSM(f32x16& p0, f32x16& p1, float& m_reg, float& mn, float& alpha) {
  constexpr float C = ATT_SCALE * 1.4426950408889634f;
  float pmax = p0[0];
#pragma unroll
  for (int r = 1; r < 16; ++r) pmax = fmaxf(pmax, p0[r]);
#pragma unroll
  for (int r = 0; r < 16; ++r) pmax = fmaxf(pmax, p1[r]);
  { auto rr = __builtin_amdgcn_permlane32_swap(__float_as_uint(pmax), __float_as_uint(pmax), false, false);
    pmax = fmaxf(__uint_as_float(rr[0]), __uint_as_float(rr[1])); }
  if (__builtin_expect(__all(pmax - m_reg <= THR / ATT_SCALE), 1)) { mn = m_reg; alpha = 1.f; }
  else { mn = fmaxf(m_reg, pmax); alpha = __builtin_amdgcn_exp2f((m_reg - mn) * C); m_reg = mn; }
  float mnC = -mn * C;
#pragma unroll
  for (int r = 0; r < 16; ++r) p0[r] = fmaf(p0[r], C, mnC);
#pragma unroll
  for (int r = 0; r < 16; ++r) p1[r] = fmaf(p1[r], C, mnC);
#pragma unroll
  for (int r = 0; r < 16; ++r) p0[r] = __builtin_amdgcn_exp2f(p0[r]);
}
__device__ __forceinline__ void finishSM(f32x16& p0, f32x16& p1, float alpha, float& l_reg, bf16x8& pa0, bf16x8& pa1, bf16x8& pa2, bf16x8& pa3) {
#pragma unroll
  for (int r = 0; r < 16; ++r) p1[r] = __builtin_amdgcn_exp2f(p1[r]);
  float ps = 0;
#pragma unroll
  for (int r = 0; r < 16; ++r) ps += p0[r];
#pragma unroll
  for (int r = 0; r < 16; ++r) ps += p1[r];
  { auto rr = __builtin_amdgcn_permlane32_swap(__float_as_uint(ps), __float_as_uint(ps), false, false);
    ps = __uint_as_float(rr[0]) + __uint_as_float(rr[1]); }
  l_reg = l_reg * alpha + ps;
#define PK4(P, BASE, OUT) do { unsigned a0 = cvtpk(P[BASE + 0], P[BASE + 1]), a1 = cvtpk(P[BASE + 2], P[BASE + 3]);   \
    unsigned b0 = cvtpk(P[BASE + 4], P[BASE + 5]), b1 = cvtpk(P[BASE + 6], P[BASE + 7]);                              \
    auto r0 = __builtin_amdgcn_permlane32_swap(a0, b0, false, false); auto r1 = __builtin_amdgcn_permlane32_swap(a1, b1, false, false); \
    u32x4 w = {r0[0], r1[0], r0[1], r1[1]}; OUT = *reinterpret_cast<bf16x8*>(&w); } while (0)
  PK4(p0, 0, pa0); PK4(p0, 8, pa1); PK4(p1, 0, pa2); PK4(p1, 8, pa3);
#undef PK4
}
__device__ __forceinline__ void qkt(f32x16& p0, f32x16& p1, const char* Ks, const bf16x8* qr, int r32, int hi) {
  p0 = f32x16{}; p1 = f32x16{};
  const int swz = ((r32 >> 1) & 7) << 4;
  const char* b4[4];
#pragma unroll
  for (int dr = 0; dr < 4; ++dr) b4[dr] = Ks + r32 * 384 + ((dr * 32 + hi * 16) ^ swz);
#pragma unroll
  for (int d0 = 0; d0 < 12; ++d0) {
    bf16x8 b0 = *reinterpret_cast<const bf16x8*>(b4[d0 & 3] + (d0 >> 2) * 128);
    bf16x8 b1 = *reinterpret_cast<const bf16x8*>(b4[d0 & 3] + (d0 >> 2) * 128 + 32 * 384);
    p0 = __builtin_amdgcn_mfma_f32_32x32x16_bf16(b0, qr[d0], p0, 0, 0, 0);
    p1 = __builtin_amdgcn_mfma_f32_32x32x16_bf16(b1, qr[d0], p1, 0, 0, 0); }
}
__device__ __forceinline__ int v_st(int k, int c) { const int kk = (k & ~0xC) | ((k & 4) << 1) | ((k & 8) >> 1); return ((kk >> 3) * 4 + (c >> 5)) * 512 + ((kk & 7) * 32 + (c & 31)) * 2; }
__device__ __forceinline__ int v_rd_base(int lane) { return ((lane & 3) << 3) | (((lane >> 2) & 3) << 6) | (((lane >> 4) & 1) << 5) | (((lane >> 5) & 1) << 8); }
constexpr int v_rd_off(int d0, int ks, int half) { return d0 * 512 + ks * 4096 + half * 2048; }
template <int OFF> __device__ __forceinline__ s16x4 tr_read(int vb) {
  s16x4 r; asm volatile("ds_read_b64_tr_b16 %0, %1 offset:%2" : "=&v"(r) : "v"(vb), "i"(OFF) : "memory"); return r;
}
template <int D0> __device__ __forceinline__ void pv_one(f32x16& od, int vb, bf16x8 pa0, bf16x8 pa1, bf16x8 pa2, bf16x8 pa3) {
  const s16x4 l0 = tr_read<v_rd_off(D0, 0, 0)>(vb), h0 = tr_read<v_rd_off(D0, 0, 1)>(vb), l1 = tr_read<v_rd_off(D0, 1, 0)>(vb), h1 = tr_read<v_rd_off(D0, 1, 1)>(vb);
  const s16x4 l2 = tr_read<v_rd_off(D0, 2, 0)>(vb), h2 = tr_read<v_rd_off(D0, 2, 1)>(vb), l3 = tr_read<v_rd_off(D0, 3, 0)>(vb), h3 = tr_read<v_rd_off(D0, 3, 1)>(vb);
  asm volatile("s_waitcnt lgkmcnt(0)" ::: "memory"); SBAR();
#define PK(L, H) (bf16x8){L[0], L[1], L[2], L[3], H[0], H[1], H[2], H[3]}
  od = __builtin_amdgcn_mfma_f32_32x32x16_bf16(pa0, PK(l0, h0), od, 0, 0, 0);
  od = __builtin_amdgcn_mfma_f32_32x32x16_bf16(pa1, PK(l1, h1), od, 0, 0, 0);
  od = __builtin_amdgcn_mfma_f32_32x32x16_bf16(pa2, PK(l2, h2), od, 0, 0, 0);
  od = __builtin_amdgcn_mfma_f32_32x32x16_bf16(pa3, PK(l3, h3), od, 0, 0, 0);
#undef PK
}
__device__ __forceinline__ void pv_d0(f32x16* o, int vb, bf16x8 pa0, bf16x8 pa1, bf16x8 pa2, bf16x8 pa3) {
  pv_one<0>(o[0], vb, pa0, pa1, pa2, pa3); pv_one<1>(o[1], vb, pa0, pa1, pa2, pa3); pv_one<2>(o[2], vb, pa0, pa1, pa2, pa3); pv_one<3>(o[3], vb, pa0, pa1, pa2, pa3);
}
__device__ __forceinline__ void attn_body(const int wv_, const bf16_t* __restrict__ Qb, const bf16_t* __restrict__ Kh, const bf16_t* __restrict__ Vh, bf16_t* __restrict__ Ob, int ldo, int seq, char* lds, const float* __restrict__ ropecs  ) {
  const int tid = tidx_w(wv_), wid = tid >> 6, lane = tid & 63, r32 = lane & 31, hi = lane >> 5;
  char* V_lds = lds; char* K_lds = lds + 2 * SHM_V;
  float* ws = (float*)(lds + 2 * SHM_V + 2 * SHM_K) + wid * 64; float* li_l = ws; float* al_l = ws + 32;
  float m_reg = -1e30f, l_reg = 0; f32x16 o[4] = {}; bf16x8 qr[12];
  const bf16_t* Qw = Qb + (long)(wid * 32 + r32) * DQK + hi * 8;
#pragma unroll
  for (int d0 = 0; d0 < 12; ++d0) qr[d0] = *reinterpret_cast<const bf16x8*>(Qw + d0 * 16);
  if (ropecs) {
    const float* cs = ropecs + (size_t)(wid * 32 + r32) * 64;
#pragma unroll
    for (int d0 = 8; d0 < 12; ++d0) { const int i0 = (d0 - 8) * 8 + hi * 4; const f32x4 c0 = *(const f32x4*)(cs + i0 * 2), c1 = *(const f32x4*)(cs + i0 * 2 + 4);
      u32x4 w = *reinterpret_cast<u32x4*>(&qr[d0]); const float cc[4] = {c0[0], c0[2], c1[0], c1[2]}, ss[4] = {c0[1], c0[3], c1[1], c1[3]};
#pragma unroll
      for (int m = 0; m < 4; ++m) { const float x1 = __uint_as_float(w[m] << 16), x2 = __uint_as_float(w[m] & 0xffff0000u); w[m] = cvtpk(x1 * cc[m] - x2 * ss[m], x1 * ss[m] + x2 * cc[m]); }
      qr[d0] = *reinterpret_cast<bf16x8*>(&w); }
  }
  const int sr = tid >> 4, sc = (tid & 15) * 8, vst0 = v_st(sr, sc), vst1 = v_st(32 + sr, sc);
  int kst[3];
#pragma unroll
  for (int i = 0; i < 3; ++i) { const int c = tid + 512 * i, row = c / 24, cc = c % 24; kst[i] = KSWZ(row, cc * 16); }
  const int vb0 = (int)(uintptr_t)V_lds + v_rd_base(lane);
  struct { bf16x8 vs0, vs1, ks0, ks1, ks2; } sr_[1];
#define SLOAD(i, k0) do { const bf16_t* vt = Vh + (long)(k0) * DV; const bf16_t* kt = Kh + (long)(k0) * DQK; \
    sr_[i].vs0 = *reinterpret_cast<const bf16x8*>(vt + (sr) * DV + sc); sr_[i].vs1 = *reinterpret_cast<const bf16x8*>(vt + (32 + sr) * DV + sc); \
    sr_[i].ks0 = *reinterpret_cast<const bf16x8*>(kt + tid * 8); sr_[i].ks1 = *reinterpret_cast<const bf16x8*>(kt + (tid + 512) * 8); sr_[i].ks2 = *reinterpret_cast<const bf16x8*>(kt + (tid + 1024) * 8); } while (0)
#define SWRITE(b, i) do { *(bf16x8*)(V_lds + (b) * SHM_V + vst0) = sr_[i].vs0; *(bf16x8*)(V_lds + (b) * SHM_V + vst1) = sr_[i].vs1; \
    *(bf16x8*)(K_lds + (b) * SHM_K + kst[0]) = sr_[i].ks0; *(bf16x8*)(K_lds + (b) * SHM_K + kst[1]) = sr_[i].ks1; *(bf16x8*)(K_lds + (b) * SHM_K + kst[2]) = sr_[i].ks2; } while (0)
#define SWAIT() asm volatile("s_waitcnt vmcnt(5)" ::: "memory")
#define RESC(a) do { if (__any((a) < 1.f)) { if (hi == 0) al_l[r32] = (a); asm volatile("s_waitcnt lgkmcnt(0)" ::: "memory"); \
    _Pragma("unroll") for (int d = 0; d < 4; ++d) _Pragma("unroll") for (int r = 0; r < 16; ++r) o[d][r] *= al_l[crow(r, hi)]; } } while (0)
  f32x16 pA0, pA1; float mnA, alA; bf16x8 pa0, pa1, pa2, pa3; const int NT = seq / KVBLK;
  SLOAD(0, 0); SWRITE(0, 0);
  SLOAD(0, KVBLK);
  __syncthreads();
  for (int j = 0; j < NT; j += 2) {
    SBAR(); qkt(pA0, pA1, K_lds, qr, r32, hi);
    partialSM(pA0, pA1, m_reg, mnA, alA); RESC(alA);
    finishSM(pA0, pA1, alA, l_reg, pa0, pa1, pa2, pa3); SBAR();
    SWRITE(1, 0);
    if (j + 2 < NT) SLOAD(0, (j + 2) * KVBLK);
    SBAR();
    pv_d0(o, vb0, pa0, pa1, pa2, pa3);
    __syncthreads();
    SBAR(); qkt(pA0, pA1, K_lds + SHM_K, qr, r32, hi);
    partialSM(pA0, pA1, m_reg, mnA, alA); RESC(alA);
    finishSM(pA0, pA1, alA, l_reg, pa0, pa1, pa2, pa3); SBAR();
    if (j + 2 < NT) { SWRITE(0, 0); if (j + 3 < NT) SLOAD(0, (j + 3) * KVBLK); }
    SBAR();
    pv_d0(o, vb0 + SHM_V, pa0, pa1, pa2, pa3);
    __syncthreads();
  }
  if (hi == 0) li_l[r32] = l_reg; asm volatile("s_waitcnt lgkmcnt(0)" ::: "memory");
  float rli[16];
#pragma unroll
  for (int r = 0; r < 16; ++r) rli[r] = __builtin_amdgcn_rcpf(li_l[crow(r, hi)]);
  bf16_t* Ow = Ob + (long)(wid * 32) * ldo;
#pragma unroll
  for (int r = 0; r < 16; ++r) { int orow = crow(r, hi);
#pragma unroll
    for (int d0 = 0; d0 < 4; ++d0) Ow[(long)orow * ldo + d0 * 32 + r32] = f2bf(o[d0][r] * rli[r]); }
  __syncthreads();
#undef SLOAD
#undef SWRITE
#undef SWAIT
#undef RESC
}
#undef KSWZ
}

__device__ void ph_attn(const Params& p, char* lds) {
    const bf16_t* Q = (const bf16_t*)(p.ws + OFF_Q); const bf16_t* K = (const bf16_t*)(p.ws + OFF_K); const bf16_t* V = (const bf16_t*)(p.ws + OFF_V);
    bf16_t* O = (bf16_t*)(p.ws + OFF_O);
    const int G = gdim();
    for (int i = 0;; ++i) {
        const int L = i * G + bidx(); if (L >= 544) break;
        int bh, qb;
        if (L < 512) { const int w = g8::xcd_remap(L, 512); bh = w >> 4; qb = 1 + (w & 15); } else { bh = L - 512; qb = 0; }
        const int b = bh >> 3, h = bh & 7;
        const int seq = qb == 0 ? TC : TK;
        const int row0 = qb == 0 ? NLAT + b * TC : b * TL + (qb - 1) * 256;
        fa::attn_body(p.wv, Q + ((size_t)bh * TK + qb * 256) * 192, K + (size_t)bh * TK * 192, V + (size_t)bh * TK * 128, O + (size_t)row0 * D + h * 128, D, seq, lds,
                      qb == 0 ? nullptr : (const float*)(p.ws + OFF_ROPE_C) + (size_t)(qb - 1) * 256 * 64);
    }
}

__device__ void ph_norm2_router(const Params& p, int layer, char* lds, int nrows) {
    const int tid = tidx(), wid = tid >> 6, lane = tid & 63;
    float* rt = (float*)lds;
    const float* rg = p.moe_router + (size_t)layer * D * NE;
    for (int i = tid; i < D * NE / 4; i += NTHR) { const int d = i >> 2, eq = i & 3; ((float4*)rt)[(((d >> 8) * 4 + (d & 3)) * 4 + eq) * 64 + ((d & 255) >> 2)] = ((const float4*)rg)[i]; }
    __syncthreads();
    const xt_t* X = (const xt_t*)(p.ws + OFF_X); bf16_t* BN = (bf16_t*)(p.ws + OFF_H); float* AFF = (float*)(p.ws + OFF_AFF);
    const float* g = p.norm2_g + layer * D;
    const int w_ = bidx() * 8 + wid, nw_ = gdim() * 8;
    int row = (int)((long long)w_ * nrows / nw_); const int rend = (int)((long long)(w_ + 1) * nrows / nw_);
    float4 nv[4], gm[4], bb[4]; int scur = -1;
    if (row < rend) {
#pragma unroll
        for (int i = 0; i < 4; ++i) nv[i] = xld(X, (size_t)row * D + (lane + i * 64) * 4); }
    for (; row < rend; ++row) {
        const int s = row_stream(row);
        if (s != scur) { scur = s; const float* sh = modp(p, layer, s, 3); const float* sc = modp(p, layer, s, 4);
#pragma unroll
            for (int i = 0; i < 4; ++i) { const int d = (lane + i * 64) * 4; const float4 gg = *(const float4*)(g + d), a = *(const float4*)(sc + d); bb[i] = *(const float4*)(sh + d);
                gm[i] = make_float4(gg.x * (1.f + a.x), gg.y * (1.f + a.y), gg.z * (1.f + a.z), gg.w * (1.f + a.w)); } }
        float4 v[4]; float ss = 0;
#pragma unroll
        for (int i = 0; i < 4; ++i) { v[i] = nv[i]; ss += v[i].x * v[i].x + v[i].y * v[i].y + v[i].z * v[i].z + v[i].w * v[i].w; }
        { const int nrow = row + 1;
          if (nrow < rend) {
#pragma unroll
              for (int i = 0; i < 4; ++i) nv[i] = xld(X, (size_t)nrow * D + (lane + i * 64) * 4); } }
        ss = wave_sum(ss); const float rs = rsqrtf(ss * (1.f / D) + RMS_EPS);
        float lg[16];
#pragma unroll
        for (int e = 0; e < 16; ++e) lg[e] = 0.f;
#pragma unroll
        for (int i = 0; i < 4; ++i) {
            const int d = (lane + i * 64) * 4;
            float o[4]; o[0] = v[i].x * rs * gm[i].x + bb[i].x; o[1] = v[i].y * rs * gm[i].y + bb[i].y; o[2] = v[i].z * rs * gm[i].z + bb[i].z; o[3] = v[i].w * rs * gm[i].w + bb[i].w;
            uint2 w; w.x = pk2(o[0], o[1]); w.y = pk2(o[2], o[3]); *(uint2*)(BN + (size_t)row * D + d) = w;
#pragma unroll
            for (int jj = 0; jj < 4; ++jj) {
#pragma unroll
                for (int eq = 0; eq < 4; ++eq) { const float4 r4 = ((const float4*)rt)[((i * 4 + jj) * 4 + eq) * 64 + lane];
                    lg[4 * eq] += o[jj] * r4.x; lg[4 * eq + 1] += o[jj] * r4.y; lg[4 * eq + 2] += o[jj] * r4.z; lg[4 * eq + 3] += o[jj] * r4.w; } }
            asm volatile("" ::: "memory");
        }
        float mx = -1e30f;
#pragma unroll
        for (int e = 0; e < 16; ++e) { lg[e] = wave_sum(lg[e]); mx = fmaxf(mx, lg[e]); }
        float sum = 0;
#pragma unroll
        for (int e = 0; e < 16; ++e) { lg[e] = expf(lg[e] - mx); sum += lg[e]; }
        const float inv = 1.f / sum;
        if (lane < 16) { float val = 0;
#pragma unroll
            for (int e = 0; e < 16; ++e) val = (lane == e) ? lg[e] : val;
            AFF[(size_t)row * 16 + lane] = val * inv; }
    }
}

__device__ void ph_norm2_router_mm(const Params& p, int layer, char* lds, int nrows) {
    typedef __attribute__((address_space(3))) char lch;
    constexpr int PB = 2064;
    constexpr int O_RH = 0, O_RL = 16 * PB, O_A = 32 * PB, A_BUF = 16 * PB, O_P = O_A + 2 * A_BUF, P_BUF = 8 * 8 * 16 * 4;
    const int tid = tidx(), wid = __builtin_amdgcn_readfirstlane(tid >> 6), lane = tid & 63;
    lch* L = (lch*)lds;
    const float* rg = p.moe_router + (size_t)layer * D * NE;
    for (int i = tid; i < D * NE / 4; i += NTHR) { const int d = i >> 2, eq = i & 3; const float4 r4 = ((const float4*)rg)[i]; const float rr[4] = {r4.x, r4.y, r4.z, r4.w};
#pragma unroll
        for (int u = 0; u < 4; ++u) { const unsigned h = pk2(rr[u], rr[u]) & 0xffffu; const float lo = rr[u] - __uint_as_float(h << 16);
            *(LAS bf16_t*)(L + O_RH + (4 * eq + u) * PB + d * 2) = (bf16_t)h; *(LAS bf16_t*)(L + O_RL + (4 * eq + u) * PB + d * 2) = f2bf(lo); } }
    const xt_t* X = (const xt_t*)(p.ws + OFF_X); bf16_t* BN = (bf16_t*)(p.ws + OFF_H); float* AFF = (float*)(p.ws + OFF_AFF);
    const float* g = p.norm2_g + layer * D;
    const int nch = nrows / 8;
    int ch = (int)((long long)bidx() * nch / gdim()); const int chend = (int)((long long)(bidx() + 1) * nch / gdim());
    float4 nv[4], gm[4], bb[4]; int scur = -1;
    if (ch < chend) {
#pragma unroll
        for (int i = 0; i < 4; ++i) nv[i] = xld(X, (size_t)(ch * 8 + wid) * D + (lane + i * 64) * 4); }
    for (int it = 0; ch < chend; ++ch, ++it) {
        const int row = ch * 8 + wid, buf = it & 1;
        const int s = row_stream(row);
        if (s != scur) { scur = s; const float* sh = modp(p, layer, s, 3); const float* sc = modp(p, layer, s, 4);
#pragma unroll
            for (int i = 0; i < 4; ++i) { const int d = (lane + i * 64) * 4; const float4 gg = *(const float4*)(g + d), a = *(const float4*)(sc + d); bb[i] = *(const float4*)(sh + d);
                gm[i] = make_float4(gg.x * (1.f + a.x), gg.y * (1.f + a.y), gg.z * (1.f + a.z), gg.w * (1.f + a.w)); } }
        float4 v[4]; float ss = 0;
#pragma unroll
        for (int i = 0; i < 4; ++i) { v[i] = nv[i]; ss += v[i].x * v[i].x + v[i].y * v[i].y + v[i].z * v[i].z + v[i].w * v[i].w; }
        if (ch + 1 < chend) {
#pragma unroll
            for (int i = 0; i < 4; ++i) nv[i] = xld(X, (size_t)(row + 8) * D + (lane + i * 64) * 4); }
        ss = wave_sum(ss); const float rs = rsqrtf(ss * (1.f / D) + RMS_EPS);
        lch* AH = L + O_A + buf * A_BUF + wid * PB; lch* AL = AH + 8 * PB;
#pragma unroll
        for (int i = 0; i < 4; ++i) {
            const int d = (lane + i * 64) * 4;
            float o[4]; o[0] = v[i].x * rs * gm[i].x + bb[i].x; o[1] = v[i].y * rs * gm[i].y + bb[i].y; o[2] = v[i].z * rs * gm[i].z + bb[i].z; o[3] = v[i].w * rs * gm[i].w + bb[i].w;
            u32x2 wh; wh.x = pk2(o[0], o[1]); wh.y = pk2(o[2], o[3]);
            uint2 wg_; wg_.x = wh.x; wg_.y = wh.y; *(uint2*)(BN + (size_t)row * D + d) = wg_;
            u32x2 wl; wl.x = pk2(o[0] - __uint_as_float(wh.x << 16), o[1] - __uint_as_float(wh.x & 0xffff0000u)); wl.y = pk2(o[2] - __uint_as_float(wh.y << 16), o[3] - __uint_as_float(wh.y & 0xffff0000u));
            *(LAS u32x2*)(AH + d * 2) = wh; *(LAS u32x2*)(AL + d * 2) = wl;
        }
        __syncthreads();
        {
            f32x4 acc = {0.f, 0.f, 0.f, 0.f};
            const lch* ah = L + O_A + buf * A_BUF + (lane & 7) * PB + (128 * wid + 8 * (lane >> 4)) * 2;
            const lch* bh = L + O_RH + (lane & 15) * PB + (128 * wid + 8 * (lane >> 4)) * 2;
#pragma unroll
            for (int ks = 0; ks < 4; ++ks) {
                const bf16x8 a_h = *(const LAS bf16x8*)(ah + ks * 64), a_l = *(const LAS bf16x8*)(ah + 8 * PB + ks * 64);
                const bf16x8 b_h = *(const LAS bf16x8*)(bh + ks * 64), b_l = *(const LAS bf16x8*)(bh + 16 * PB + ks * 64);
                acc = __builtin_amdgcn_mfma_f32_16x16x32_bf16(a_h, b_h, acc, 0, 0, 0);
                acc = __builtin_amdgcn_mfma_f32_16x16x32_bf16(a_h, b_l, acc, 0, 0, 0);
                acc = __builtin_amdgcn_mfma_f32_16x16x32_bf16(a_l, b_h, acc, 0, 0, 0);
            }
            if (lane < 32) {
#pragma unroll
                for (int e = 0; e < 4; ++e) *(LAS float*)(L + O_P + buf * P_BUF + ((wid * 8 + 4 * (lane >> 4) + e) * 16 + (lane & 15)) * 4) = acc[e]; }
        }
        __syncthreads();
        if (tid < 128) {
            float lg = 0.f;
#pragma unroll
            for (int w8 = 0; w8 < 8; ++w8) lg += *(const LAS float*)(L + O_P + buf * P_BUF + (w8 * 128 + tid) * 4);
            float mx = lg;
            mx = fmaxf(mx, __builtin_bit_cast(float, __builtin_amdgcn_update_dpp(0, __builtin_bit_cast(int, mx), 0xB1, 0xF, 0xF, true)));
            mx = fmaxf(mx, __builtin_bit_cast(float, __builtin_amdgcn_update_dpp(0, __builtin_bit_cast(int, mx), 0x4E, 0xF, 0xF, true)));
            mx = fmaxf(mx, __builtin_bit_cast(float, __builtin_amdgcn_update_dpp(0, __builtin_bit_cast(int, mx), 0x141, 0xF, 0xF, true)));
            mx = fmaxf(mx, __builtin_bit_cast(float, __builtin_amdgcn_update_dpp(0, __builtin_bit_cast(int, mx), 0x140, 0xF, 0xF, true)));
            const float ex = expf(lg - mx); const float sum = dpp_sum16(ex);
            AFF[(size_t)(ch * 8) * 16 + tid] = ex / sum;
        }
    }
}

__device__ void ph_select(const Params& p, char* lds, int ngroups) {
    const int tid = tidx(), wid = tid >> 6, lane = tid & 63;
    unsigned* hist = (unsigned*)lds;
    unsigned* ctl = hist + 256;
    unsigned* wsum = ctl + 8;
    int* rowl = (int*)(wsum + 16);
    const float* AFF = (const float*)(p.ws + OFF_AFF);
    int* ROWIDX = (int*)(p.ws + OFF_ROWIDX); float* GATE = (float*)(p.ws + OFF_GATE); int* SLOT = (int*)(p.ws + OFF_SLOT);
    for (int gidx = bidx(); gidx < ngroups; gidx += gdim()) {
        const bool lat = gidx < 64; const int b = (gidx & 63) >> 4, e = gidx & 15;
        const int n = lat ? TL : TC, cap = lat ? CAPL : CAPC;
        const int row0 = lat ? b * TL : NLAT + b * TC, slot0 = lat ? b * CAPL : NB * CAPL + b * CAPC;
        unsigned key[8];
#pragma unroll
        for (int i = 0; i < 8; ++i) { const int idx = tid * 8 + i; key[i] = idx < n ? __float_as_uint(AFF[(size_t)(row0 + idx) * 16 + e]) : 0u; }
        unsigned prefix = 0u, remaining = (unsigned)cap;
#pragma unroll
        for (int pass = 0; pass < 4; ++pass) {
            const int sh = 24 - 8 * pass;
            __syncthreads();
            if (tid < 256) hist[tid] = 0u;
            __syncthreads();
#pragma unroll
            for (int i = 0; i < 8; ++i) { const int idx = tid * 8 + i;
                const bool cand = idx < n && (pass == 0 || (key[i] >> (sh + 8)) == prefix);
                if (cand) atomicAdd(&hist[(key[i] >> sh) & 255u], 1u); }
            __syncthreads();
            if (tid < 256) { unsigned gt = 0; for (int jj = tid + 1; jj < 256; ++jj) gt += hist[jj];
                const unsigned mine = hist[tid];
                if (gt < remaining && remaining <= gt + mine) { ctl[0] = (unsigned)tid; ctl[1] = remaining - gt; } }
            __syncthreads();
            prefix = (prefix << 8) | ctl[0]; remaining = ctl[1];
        }
        const unsigned T = prefix, m = remaining;
        unsigned cgt = 0, ceq = 0;
#pragma unroll
        for (int i = 0; i < 8; ++i) { const int idx = tid * 8 + i; if (idx < n) { cgt += key[i] > T ? 1u : 0u; ceq += key[i] == T ? 1u : 0u; } }
        auto block_excl = [&](unsigned v) -> unsigned {
            unsigned inc = v;
#pragma unroll
            for (int o = 1; o < 64; o <<= 1) { const unsigned t = (unsigned)__builtin_amdgcn_ds_bpermute((lane - o) << 2, (int)inc); if (lane >= o) inc += t; }
            __syncthreads();
            if (lane == 63) wsum[wid] = inc;
            __syncthreads();
            unsigned base = 0;
#pragma unroll
            for (int w = 0; w < 8; ++w) base += (w < wid) ? wsum[w] : 0u;
            return base + inc - v; };
        unsigned eqbase = block_excl(ceq);
        unsigned nsel = 0; bool sel[8];
#pragma unroll
        for (int i = 0; i < 8; ++i) { const int idx = tid * 8 + i; bool s_ = false;
            if (idx < n) { if (key[i] > T) s_ = true; else if (key[i] == T) { s_ = eqbase < m; ++eqbase; } }
            sel[i] = s_; nsel += s_ ? 1u : 0u; }
        unsigned sbase = block_excl(nsel);
#pragma unroll
        for (int i = 0; i < 8; ++i) { const int idx = tid * 8 + i;
            if (idx < n) {
                if (sel[i]) { const int sl = slot0 + (int)sbase; rowl[sbase] = row0 + idx; ++sbase; ROWIDX[e * ESLOTS + sl] = row0 + idx; GATE[e * EPAD + sl] = __uint_as_float(key[i]); SLOT[(size_t)(row0 + idx) * 16 + e] = sl; }
                else SLOT[(size_t)(row0 + idx) * 16 + e] = -1; } }
    }
}

__device__ void ph_gather(const Params& p, int nslots) {
    const int wid = tidx() >> 6, lane = tidx() & 63;
    const int* ROWIDX = (const int*)(p.ws + OFF_ROWIDX); const bf16_t* BN = (const bf16_t*)(p.ws + OFF_H); bf16_t* XE = (bf16_t*)(p.ws + OFF_XE);
    for (int it = bidx() * 8 + wid; it < NE * ESLOTS; it += gdim() * 8) {
        const int e = it / ESLOTS, sl = it % ESLOTS; if (sl >= nslots) continue; const int row = ROWIDX[it];
        const u32x4* src = (const u32x4*)(BN + (size_t)row * D); u32x4* dst = (u32x4*)(XE + ((size_t)e * EPAD + sl) * D);
        dst[lane] = src[lane]; dst[lane + 64] = src[lane + 64];
    }
}

__device__ void ph_combine(const Params& p, int layer, int nrows) {
    const int wid = tidx() >> 6, lane = tidx() & 63;
    const int* SLOT = (const int*)(p.ws + OFF_SLOT); const bf16_t* YE = (const bf16_t*)(p.ws + OFF_YE); xt_t* X = (xt_t*)(p.ws + OFF_X);
    int row = bidx() * 8 + wid;
    int sl = (row < nrows && lane < 16) ? SLOT[(size_t)row * 16 + lane] : -1;
    while (row < nrows) {
        const int nrow = row + gdim() * 8;
        const int sln = (nrow < nrows && lane < 16) ? SLOT[(size_t)nrow * 16 + lane] : -1;
        const float* gt = modp(p, layer, row_stream(row), 5);
        xt_t* xr = X + (size_t)row * D + lane * 8;
        f32x4 xv[4];
#pragma unroll
        for (int i = 0; i < 2; ++i) { xv[2 * i] = xldv(xr, 512 * i); xv[2 * i + 1] = xldv(xr, 512 * i + 4); }
        unsigned long long m = __ballot(sl >= 0);
        float acc[16];
#pragma unroll
        for (int i = 0; i < 16; ++i) acc[i] = 0.f;
        while (m) {
            const int e0 = __builtin_ctzll(m); m &= m - 1; const bool two = m != 0; const int e1 = two ? __builtin_ctzll(m) : e0; if (two) m &= m - 1;
            const int s0 = __builtin_amdgcn_readlane(sl, e0), s1 = __builtin_amdgcn_readlane(sl, e1);
            const bf16_t* y0 = YE + ((size_t)e0 * EPAD + s0) * D + lane * 8; const bf16_t* y1 = YE + ((size_t)e1 * EPAD + s1) * D + lane * 8;
            const u32x4 a0 = *(const u32x4*)y0, a1 = *(const u32x4*)(y0 + 512), b0 = *(const u32x4*)y1, b1 = *(const u32x4*)(y1 + 512);
            const float f1 = two ? 1.f : 0.f;
#pragma unroll
            for (int i = 0; i < 4; ++i) { acc[2 * i] += __uint_as_float(a0[i] << 16) + f1 * __uint_as_float(b0[i] << 16); acc[2 * i + 1] += __uint_as_float(a0[i] & 0xffff0000u) + f1 * __uint_as_float(b0[i] & 0xffff0000u);
                acc[8 + 2 * i] += __uint_as_float(a1[i] << 16) + f1 * __uint_as_float(b1[i] << 16); acc[8 + 2 * i + 1] += __uint_as_float(a1[i] & 0xffff0000u) + f1 * __uint_as_float(b1[i] & 0xffff0000u); }
        }
#pragma unroll
        for (int i = 0; i < 2; ++i) { const f32x4 g0 = *(const f32x4*)(gt + lane * 8 + 512 * i), g1 = *(const f32x4*)(gt + lane * 8 + 512 * i + 4);
            f32x4 o0 = xv[2 * i], o1 = xv[2 * i + 1];
#pragma unroll
            for (int e = 0; e < 4; ++e) { o0[e] += g0[e] * acc[8 * i + e]; o1[e] += g1[e] * acc[8 * i + 4 + e]; }
            xstv(xr, 512 * i, o0); xstv(xr, 512 * i + 4, o1); }
        row = nrow; sl = sln;
    }
}

template <bool FINAL>
__device__ void ph_comb_norm(const Params& p, int lprev, int layer, int nrows) {
    const int wid = tidx() >> 6, lane = tidx() & 63;
    const int* SLOT = (const int*)(p.ws + OFF_SLOT); const bf16_t* YE = (const bf16_t*)(p.ws + OFF_YE); xt_t* X = (xt_t*)(p.ws + OFF_X);
    bf16_t* H = (bf16_t*)(p.ws + OFF_H);
    const float* g = FINAL ? p.final_g : p.norm1_g + layer * D;
    int row = bidx() * 8 + wid;
    int sl = (row < nrows && lane < 16) ? SLOT[(size_t)row * 16 + lane] : -1;
    while (row < nrows) {
        const int nrow = row + gdim() * 8;
        const int sln = (nrow < nrows && lane < 16) ? SLOT[(size_t)nrow * 16 + lane] : -1;
        const int strm = row_stream(row);
        const float* gt = modp(p, lprev, strm, 5);
        xt_t* xr = X + (size_t)row * D + lane * 8;
        f32x4 xv[4];
#pragma unroll
        for (int i = 0; i < 2; ++i) { xv[2 * i] = xldv(xr, 512 * i); xv[2 * i + 1] = xldv(xr, 512 * i + 4); }
        unsigned long long m = __ballot(sl >= 0);
        float acc[16];
#pragma unroll
        for (int i = 0; i < 16; ++i) acc[i] = 0.f;
        while (m) {
            const int e0 = __builtin_ctzll(m); m &= m - 1; const bool two = m != 0; const int e1 = two ? __builtin_ctzll(m) : e0; if (two) m &= m - 1;
            const int s0 = __builtin_amdgcn_readlane(sl, e0), s1 = __builtin_amdgcn_readlane(sl, e1);
            const bf16_t* y0 = YE + ((size_t)e0 * EPAD + s0) * D + lane * 8; const bf16_t* y1 = YE + ((size_t)e1 * EPAD + s1) * D + lane * 8;
            const u32x4 a0 = *(const u32x4*)y0, a1 = *(const u32x4*)(y0 + 512), b0 = *(const u32x4*)y1, b1 = *(const u32x4*)(y1 + 512);
            const float f1 = two ? 1.f : 0.f;
#pragma unroll
            for (int i = 0; i < 4; ++i) { acc[2 * i] += __uint_as_float(a0[i] << 16) + f1 * __uint_as_float(b0[i] << 16); acc[2 * i + 1] += __uint_as_float(a0[i] & 0xffff0000u) + f1 * __uint_as_float(b0[i] & 0xffff0000u);
                acc[8 + 2 * i] += __uint_as_float(a1[i] << 16) + f1 * __uint_as_float(b1[i] << 16); acc[8 + 2 * i + 1] += __uint_as_float(a1[i] & 0xffff0000u) + f1 * __uint_as_float(b1[i] & 0xffff0000u); }
        }
        float ss = 0.f;
#pragma unroll
        for (int i = 0; i < 2; ++i) { const f32x4 g0 = *(const f32x4*)(gt + lane * 8 + 512 * i), g1 = *(const f32x4*)(gt + lane * 8 + 512 * i + 4);
#pragma unroll
            for (int e = 0; e < 4; ++e) { xv[2 * i][e] += g0[e] * acc[8 * i + e]; xv[2 * i + 1][e] += g1[e] * acc[8 * i + 4 + e]; ss += xv[2 * i][e] * xv[2 * i][e] + xv[2 * i + 1][e] * xv[2 * i + 1][e]; }
            if (!FINAL) { xstv(xr, 512 * i, xv[2 * i]); xstv(xr, 512 * i + 4, xv[2 * i + 1]); } }
        ss = wave_sum(ss); const float rs = rsqrtf(ss * (1.f / D) + RMS_EPS);
        const float* sh = FINAL ? nullptr : modp(p, layer, strm, 0); const float* sc = FINAL ? nullptr : modp(p, layer, strm, 1);
#pragma unroll
        for (int i = 0; i < 2; ++i)
#pragma unroll
            for (int hh = 0; hh < 2; ++hh) { const int d = lane * 8 + 512 * i + 4 * hh; const f32x4 gg = *(const f32x4*)(g + d); f32x4 o = xv[2 * i + hh] * rs * gg;
                if (FINAL) *(f32x4*)(p.out + (size_t)row * D + d) = o;
                else { o = o * (1.f + *(const f32x4*)(sc + d)) + *(const f32x4*)(sh + d); stbf4(H + (size_t)row * D + d, o); } }
        row = nrow; sl = sln;
    }
}

__device__ void ph_rw_normxs(const Params& p, int layer, int j) {
    const int wid = tidx() >> 6, lane = tidx() & 63;
    const xt_t* X = (const xt_t*)(p.ws + OFF_X); bf16_t* XS = (bf16_t*)(p.ws + OFF_XS);
    const float* mu = p.rw_mu + (size_t)j * 6 * D; const float* g = p.norm1_g + layer * D;
    const int w = bidx() * 8 + wid, nw = gdim() * 8;
    const int r0 = (int)((long long)w * NROW / nw), r1 = (int)((long long)(w + 1) * NROW / nw);
    if (r0 >= r1) return;
    float4 um[6][4];
#pragma unroll
    for (int m = 0; m < 6; ++m)
#pragma unroll
        for (int i = 0; i < 4; ++i) um[m][i] = *(const float4*)(mu + m * D + (lane + i * 64) * 4);
    float4 gm[4], bb[4]; int scur = -1;
    float4 hp[4], hc[4], hn[4], raw[4];
#define XS_NORM(dst, src, R) do { const int s_ = row_stream(R); \
        if (s_ != scur) { scur = s_; const float* sh_ = modp(p, layer, s_, 0); const float* sc_ = modp(p, layer, s_, 1); \
            _Pragma("unroll") for (int i = 0; i < 4; ++i) { const int d_ = (lane + i * 64) * 4; const float4 gg_ = *(const float4*)(g + d_), a_ = *(const float4*)(sc_ + d_); bb[i] = *(const float4*)(sh_ + d_); \
                gm[i] = make_float4(gg_.x * (1.f + a_.x), gg_.y * (1.f + a_.y), gg_.z * (1.f + a_.z), gg_.w * (1.f + a_.w)); } } \
        float ss_ = 0.f; \
        _Pragma("unroll") for (int i = 0; i < 4; ++i) ss_ += src[i].x * src[i].x + src[i].y * src[i].y + src[i].z * src[i].z + src[i].w * src[i].w; \
        ss_ = wave_sum(ss_); const float rs_ = rsqrtf(ss_ * (1.f / D) + RMS_EPS); \
        _Pragma("unroll") for (int i = 0; i < 4; ++i) dst[i] = make_float4(src[i].x * rs_ * gm[i].x + bb[i].x, src[i].y * rs_ * gm[i].y + bb[i].y, src[i].z * rs_ * gm[i].z + bb[i].z, src[i].w * rs_ * gm[i].w + bb[i].w); } while (0)
#define XS_RAW(R) do { _Pragma("unroll") for (int i = 0; i < 4; ++i) raw[i] = xld(X, (size_t)(R) * D + (lane + i * 64) * 4); } while (0)
    if (r0 > 0) { XS_RAW(r0 - 1); XS_NORM(hp, raw, r0 - 1); }
    else {
#pragma unroll
        for (int i = 0; i < 4; ++i) hp[i] = make_float4(0.f, 0.f, 0.f, 0.f); }
    XS_RAW(r0); XS_NORM(hc, raw, r0);
    if (r0 + 1 < NROW) XS_RAW(r0 + 1);
    for (int row = r0; row < r1; ++row) {
        const bool lat = row < NLAT; const int t = lat ? (row & (TL - 1)) : ((row - NLAT) & (TC - 1)); const int len = lat ? TL : TC;
        const float fp_ = t > 0 ? 0.5f : 0.f, fn_ = t < len - 1 ? 0.5f : 0.f;
        if (row + 1 < NROW) XS_NORM(hn, raw, row + 1);
        else {
#pragma unroll
            for (int i = 0; i < 4; ++i) hn[i] = make_float4(0.f, 0.f, 0.f, 0.f); }
        if (row + 1 < r1 && row + 2 < NROW) XS_RAW(row + 2);
#pragma unroll
        for (int i = 0; i < 4; ++i) {
            const int d = (lane + i * 64) * 4;
            const float4 h = hc[i];
            const float4 xx = make_float4(fp_ * hp[i].x + fn_ * hn[i].x - h.x, fp_ * hp[i].y + fn_ * hn[i].y - h.y, fp_ * hp[i].z + fn_ * hn[i].z - h.z, fp_ * hp[i].w + fn_ * hn[i].w - h.w);
#pragma unroll
            for (int m = 0; m < 6; ++m) { const float4 u = um[m][i];
                uint2 wv_; wv_.x = pk2(h.x + xx.x * u.x, h.y + xx.y * u.y); wv_.y = pk2(h.z + xx.z * u.z, h.w + xx.w * u.w);
                *(uint2*)(XS + ((size_t)m * NROW + row) * D + d) = wv_; }
        }
#pragma unroll
        for (int i = 0; i < 4; ++i) { hp[i] = hc[i]; hc[i] = hn[i]; }
    }
#undef XS_NORM
#undef XS_RAW
}

__device__ __forceinline__ int scan_row(int i, int b, int z) {
    return i < TC ? NLAT + b * TC + (z ? TC - 1 - i : i) : b * TL + (z ? TL - 1 - (i - TC) : i - TC);
}
__device__ __forceinline__ float dpp_sum8(float x) {
    x += __builtin_bit_cast(float, __builtin_amdgcn_update_dpp(0, __builtin_bit_cast(int, x), 0xB1, 0xF, 0xF, true));
    x += __builtin_bit_cast(float, __builtin_amdgcn_update_dpp(0, __builtin_bit_cast(int, x), 0x4E, 0xF, 0xF, true));
    x += __builtin_bit_cast(float, __builtin_amdgcn_update_dpp(0, __builtin_bit_cast(int, x), 0x141, 0xF, 0xF, true));
    return x;
}
__device__ void ph_rw_scan(const Params& p, int j, char* lds) {
    const int tid = tidx(), wid = __builtin_amdgcn_readfirstlane(tid >> 6), lane = tid & 63;
    const size_t PL = (size_t)NROW * D;
    const float* RKV = (const float*)(p.ws + OFF_RKV); float* Y = (float*)(p.ws + OFF_Y);
    constexpr int CH = 32, BUFB = 5 * CH * 256 + CH * 128 + CH * 16, YB = CH * 32 * 4, NCH = (TC + TL) / CH;
    const bool loader = wid >= 4; const int lw = wid - 4;
    for (int it = bidx(); it < 256; it += gdim()) {
        const int vh = it & 1, z = (it >> 1) & 1, h = (it >> 2) & 15, b = it >> 6;
        const char* pl0 = (const char*)((const float*)(p.ws + OFF_W) + z * PL); const char* pl1 = (const char*)(RKV + PL);
        const char* pl2 = (const char*)((const float*)(p.ws + OFF_AV) + z * PL); const char* pl3 = (const char*)RKV;
        const char* vpl = (const char*)(RKV + 2 * PL);
        float* yout = Y + z * PL;
        __builtin_amdgcn_s_barrier();
        if (loader) {
            const int pq = lane & 15;
            const f32x4 kkv = *(const f32x4*)(p.rw_k_k + j * D + h * 64 + pq * 4), kav = *(const f32x4*)(p.rw_k_a + j * D + h * 64 + pq * 4);
            auto issue = [&](int c) {
                char* buf = lds + (c % 3) * BUFB;
#pragma unroll
                for (int q = 0; q < 8; ++q) { const int pi = q >> 1, tg = lw * 2 + (q & 1); const int row = scan_row(c * CH + tg * 4 + (lane >> 4), b, z);
                    const char* base = pi == 0 ? pl0 : pi == 1 ? pl1 : pi == 2 ? pl2 : pl3;
                    __builtin_amdgcn_global_load_lds((const unsigned*)(base + (size_t)row * D * 4 + h * 256 + (lane & 15) * 16), (LAS unsigned*)(buf + pi * (CH * 256) + tg * 1024), 16, 0, 0); }
                { const int row = scan_row(c * CH + lw * 8 + (lane >> 3), b, z);
                  __builtin_amdgcn_global_load_lds((const unsigned*)(vpl + (size_t)row * D * 4 + (h * 64 + vh * 32) * 4 + (lane & 7) * 16), (LAS unsigned*)(buf + 5 * CH * 256 + lw * 1024), 16, 0, 0); }
            };
            auto prep = [&](int c) {
                char* buf = lds + (c % 3) * BUFB;
#pragma unroll
                for (int ps = 0; ps < 2; ++ps) { const int ptok = lw * 8 + ps * 4 + (lane >> 4);
                    f32x4* kp = (f32x4*)(buf + 1 * CH * 256 + ptok * 256 + pq * 16); f32x4* ap = (f32x4*)(buf + 2 * CH * 256 + ptok * 256 + pq * 16); f32x4* dp = (f32x4*)(buf + 4 * CH * 256 + ptok * 256 + pq * 16);
                    f32x4* rp = (f32x4*)(buf + 3 * CH * 256 + ptok * 256 + pq * 16); const f32x4 wv = *(const f32x4*)(buf + ptok * 256 + pq * 16);
                    const f32x4 k = *kp, a = *ap, r = *rp; f32x4 kk = k * kkv;
                    float ss = kk[0] * kk[0] + kk[1] * kk[1] + kk[2] * kk[2] + kk[3] * kk[3]; ss = dpp_sum16(ss);
                    const float inv = 1.f / fmaxf(sqrtf(ss), 1e-12f); kk = kk * inv;
                    const f32x4 kd = k * (1.f + (a - 1.f) * kav), bb = kk * a;
                    const f32x4 t1 = bb * r, t2 = kd * r;
                    const float br = dpp_sum16((t1[0] + t1[1]) + (t1[2] + t1[3])), kr = dpp_sum16((t2[0] + t2[1]) + (t2[2] + t2[3]));
                    *dp = kd; *ap = bb; *kp = kk; *rp = wv * r;
                    if (pq == 0) *(float2*)(buf + 5 * CH * 256 + CH * 128 + ptok * 16) = make_float2(br, kr); }
            };
            issue(0); issue(1);
            asm volatile("s_waitcnt vmcnt(9)" ::: "memory");
            prep(0);
            asm volatile("s_waitcnt lgkmcnt(0)" ::: "memory"); __builtin_amdgcn_s_barrier();
            for (int c = 0; c < NCH; ++c) {
                if (c >= 1) { const float* yb = (const float*)(lds + 3 * BUFB + ((c - 1) & 1) * YB);
                    const int lt = tid - 256, t = lt >> 3, q = lt & 7; const int row = scan_row((c - 1) * CH + t, b, z);
                    *(f32x4*)(yout + (size_t)row * D + h * 64 + vh * 32 + q * 4) = *(const f32x4*)(yb + t * 32 + q * 4); }
                if (c + 2 < NCH) { issue(c + 2); asm volatile("s_waitcnt vmcnt(9)" ::: "memory"); } else asm volatile("s_waitcnt vmcnt(0)" ::: "memory");
                if (c + 1 < NCH) prep(c + 1);
                asm volatile("s_waitcnt lgkmcnt(0)" ::: "memory"); __builtin_amdgcn_s_barrier();
            }
            { const float* yb = (const float*)(lds + 3 * BUFB + ((NCH - 1) & 1) * YB);
              const int lt = tid - 256, t = lt >> 3, q = lt & 7; const int row = scan_row((NCH - 1) * CH + t, b, z);
              *(f32x4*)(yout + (size_t)row * D + h * 64 + vh * 32 + q * 4) = *(const f32x4*)(yb + t * 32 + q * 4); }
        } else {
            const int vr = lane >> 3, ks = lane & 7;
            f32x4 Sa = {0.f, 0.f, 0.f, 0.f}, Sb = {0.f, 0.f, 0.f, 0.f};
            __builtin_amdgcn_s_barrier();
            struct Ops { f32x4 w0, w1, kk0, kk1, bb0, bb1, r0, r1, kd0, kd1; float v; float2 sc; };
#define SC_LOAD(O, t) do { const char* q_ = bq + (t) * 256; O.w0 = *(const f32x4*)(q_); O.w1 = *(const f32x4*)(q_ + 16); O.kk0 = *(const f32x4*)(q_ + CH * 256); O.kk1 = *(const f32x4*)(q_ + CH * 256 + 16); \
                O.bb0 = *(const f32x4*)(q_ + 2 * CH * 256); O.bb1 = *(const f32x4*)(q_ + 2 * CH * 256 + 16); O.r0 = *(const f32x4*)(q_ + 3 * CH * 256); O.r1 = *(const f32x4*)(q_ + 3 * CH * 256 + 16); \
                O.kd0 = *(const f32x4*)(q_ + 4 * CH * 256); O.kd1 = *(const f32x4*)(q_ + 4 * CH * 256 + 16); O.v = *(const float*)(vq + (t) * 128); O.sc = *(const float2*)(buf + 5 * CH * 256 + CH * 128 + (t) * 16); } while (0)
#define SC_STEP(O, t) do { const f32x4 d1 = Sa * O.kk0 + Sb * O.kk1, d2 = Sa * O.r0 + Sb * O.r1; \
                float sa = -((d1[0] + d1[1]) + (d1[2] + d1[3])), yy = (d2[0] + d2[1]) + (d2[2] + d2[3]); \
                sa = dpp_sum8(sa); yy = dpp_sum8(yy); \
                Sa = Sa * O.w0 + (sa * O.bb0 + O.v * O.kd0); Sb = Sb * O.w1 + (sa * O.bb1 + O.v * O.kd1); \
                if (ks == 0) yb[(t) * 32 + wid * 8 + vr] = yy + sa * O.sc.x + O.v * O.sc.y; } while (0)
            for (int c = 0; c < NCH; ++c) {
                const char* buf = lds + (c % 3) * BUFB; float* yb = (float*)(lds + 3 * BUFB + (c & 1) * YB);
                const char* bq = buf + ks * 32; const char* vq = buf + 5 * CH * 256 + (wid * 8 + vr) * 4;
                Ops oA, oB, oC;
                SC_LOAD(oA, 0); SC_LOAD(oB, 1);
#pragma unroll
                for (int t = 0; t < CH; t += 3) {
                    if (t + 2 < CH) SC_LOAD(oC, t + 2);
                    SC_STEP(oA, t);
                    if (t + 3 < CH) SC_LOAD(oA, t + 3);
                    if (t + 1 < CH) SC_STEP(oB, t + 1);
                    if (t + 4 < CH) SC_LOAD(oB, t + 4);
                    if (t + 2 < CH) SC_STEP(oC, t + 2);
                }
                asm volatile("s_waitcnt lgkmcnt(0)" ::: "memory"); __builtin_amdgcn_s_barrier();
            }
#undef SC_LOAD
#undef SC_STEP
        }
    }
}


namespace ck {
constexpr int P = 72, MB = 64 * P * 2;
typedef __attribute__((address_space(3))) char lchar;
__device__ __forceinline__ f32x4 mm_tile(const lchar* Aop, const lchar* Bop, int ti, int tj, int c, int q, f32x4 acc) {
#pragma unroll
    for (int ks = 0; ks < 2; ++ks) {
        const bf16x8 a = *(const LAS bf16x8*)(Aop + ((16 * ti + c) * P + 32 * ks + 8 * q) * 2);
        const bf16x8 b = *(const LAS bf16x8*)(Bop + ((16 * tj + c) * P + 32 * ks + 8 * q) * 2);
        acc = __builtin_amdgcn_mfma_f32_16x16x32_bf16(a, b, acc, 0, 0, 0);
    }
    return acc;
}
__device__ __forceinline__ f32x4 mm_diag(const lchar* Aop, const lchar* Bop, int tt, int c, int q, f32x4 acc) {
    const int ks = tt >> 1;
    bf16x8 a = *(const LAS bf16x8*)(Aop + ((16 * tt + c) * P + 32 * ks + 8 * q) * 2);
    const bf16x8 b = *(const LAS bf16x8*)(Bop + ((16 * tt + c) * P + 32 * ks + 8 * q) * 2);
    if ((q >> 1) != (tt & 1)) a = (bf16x8){0, 0, 0, 0, 0, 0, 0, 0};
    return __builtin_amdgcn_mfma_f32_16x16x32_bf16(a, b, acc, 0, 0, 0);
}
__device__ __forceinline__ void st_tile(lchar* dst, int ti, int tj, int c, int q, f32x4 v) {
    u32x2 w; w.x = pk2(v[0], v[1]); w.y = pk2(v[2], v[3]); *(LAS u32x2*)(dst + ((16 * tj + c) * P + 16 * ti + 4 * q) * 2) = w;
}
__device__ __forceinline__ f32x4 ld_tile(const lchar* src, int ti, int tj, int c, int q) {
    const u32x2 w = *(const LAS u32x2*)(src + ((16 * tj + c) * P + 16 * ti + 4 * q) * 2);
    return (f32x4){__uint_as_float(w.x << 16), __uint_as_float(w.x & 0xffff0000u), __uint_as_float(w.y << 16), __uint_as_float(w.y & 0xffff0000u)};
}
__device__ __forceinline__ void st_glob(bf16_t* dst, int ti, int tj, int c, int q, f32x4 v) {
    uint2 w; w.x = pk2(v[0], v[1]); w.y = pk2(v[2], v[3]); *(uint2*)(dst + (16 * tj + c) * 64 + 16 * ti + 4 * q) = w;
}
typedef float f32x16 __attribute__((ext_vector_type(16)));
__device__ __forceinline__ f32x16 mm32(const lchar* Aop, const lchar* Bop, int ti, int tj, int r32, int hi, f32x16 acc) {
    bf16x8 a[4], b[4];
#pragma unroll
    for (int ks = 0; ks < 4; ++ks) {
        a[ks] = *(const LAS bf16x8*)(Aop + ((32 * ti + r32) * P + 16 * ks + 8 * hi) * 2);
        b[ks] = *(const LAS bf16x8*)(Bop + ((32 * tj + r32) * P + 16 * ks + 8 * hi) * 2); }
    __builtin_amdgcn_sched_barrier(0);
#pragma unroll
    for (int ks = 0; ks < 4; ++ks) acc = __builtin_amdgcn_mfma_f32_32x32x16_bf16(a[ks], b[ks], acc, 0, 0, 0);
    return acc;
}
__device__ __forceinline__ void st32(lchar* dst, int ti, int tj, int r32, int hi, const f32x16& v) {
#pragma unroll
    for (int g = 0; g < 4; ++g) { u32x2 w; w.x = pk2(v[4 * g], v[4 * g + 1]); w.y = pk2(v[4 * g + 2], v[4 * g + 3]); *(LAS u32x2*)(dst + ((32 * tj + r32) * P + 32 * ti + 8 * g + 4 * hi) * 2) = w; }
}
__device__ __forceinline__ f32x16 ld32(const lchar* src, int ti, int tj, int r32, int hi) {
    f32x16 v;
#pragma unroll
    for (int g = 0; g < 4; ++g) { const u32x2 w = *(const LAS u32x2*)(src + ((32 * tj + r32) * P + 32 * ti + 8 * g + 4 * hi) * 2);
        v[4 * g] = __uint_as_float(w.x << 16); v[4 * g + 1] = __uint_as_float(w.x & 0xffff0000u); v[4 * g + 2] = __uint_as_float(w.y << 16); v[4 * g + 3] = __uint_as_float(w.y & 0xffff0000u); }
    return v;
}
__device__ __forceinline__ void stg32(bf16_t* dst, int ti, int tj, int r32, int hi, const f32x16& v) {
#pragma unroll
    for (int g = 0; g < 4; ++g) { uint2 w; w.x = pk2(v[4 * g], v[4 * g + 1]); w.y = pk2(v[4 * g + 2], v[4 * g + 3]); *(uint2*)(dst + (32 * tj + r32) * 64 + 32 * ti + 8 * g + 4 * hi) = w; }
}
}

#define LBAR() do { asm volatile("s_waitcnt lgkmcnt(0)" ::: "memory"); __builtin_amdgcn_s_barrier(); asm volatile("" ::: "memory"); } while (0)
__device__ void ph_rw_sc1(const Params& p, int j, char* lds) {
    using namespace ck;
    const int tid = tidx(), wid = __builtin_amdgcn_readfirstlane(tid >> 6), lane = tid & 63, c = lane & 15, q = lane >> 4;
    const size_t PL = (size_t)NROW * D;
    const bf16_t* RKV = (const bf16_t*)(p.ws + OFF_RKV); const unsigned short* LW = (const unsigned short*)(p.ws + OFF_W); const bf16_t* AV = (const bf16_t*)(p.ws + OFF_AV);
    bf16_t* CK = (bf16_t*)(p.ws + OFF_CK);
    lchar* B0 = (lchar*)lds;
#define BUF(i) (B0 + (i) * MB)
    LAS float* Lbuf = (LAS float*)BUF(8);
    LAS float* Lseg = (LAS float*)(B0 + 16 * MB);
    LAS float* GC = Lseg + 8 * 64;
    const int pt = tid >> 3, cg = tid & 7;
    f32x4 nkk[2], nka[2]; u32x4 nlw, nkx, nax, nrx, nvx;
#define SC1_LOAD(IT) do { const int seq_ = (IT) / NCHK, ch_ = (IT) % NCHK; const int z_ = seq_ & 1, h_ = (seq_ >> 1) & 15, b_ = seq_ >> 5; \
        const size_t go_ = (size_t)scan_row(ch_ * 64 + pt, b_, z_) * D + h_ * 64 + cg * 8; \
        nlw = *(const u32x4*)(LW + z_ * PL + go_); \
        nkx = *(const u32x4*)(RKV + PL + go_); nax = *(const u32x4*)(AV + z_ * PL + go_); nrx = *(const u32x4*)(RKV + go_); nvx = *(const u32x4*)(RKV + 2 * PL + go_); \
        _Pragma("unroll") for (int e = 0; e < 2; ++e) { nkk[e] = *(const f32x4*)(p.rw_k_k + j * D + h_ * 64 + cg * 8 + 4 * e); nka[e] = *(const f32x4*)(p.rw_k_a + j * D + h_ * 64 + cg * 8 + 4 * e); } } while (0)
    if (bidx() < 128 * NCHK) SC1_LOAD(bidx());
    for (int it = bidx(); it < 128 * NCHK; it += gdim()) {
        const int seq = it / NCHK; const int h = (seq >> 1) & 15;
        f32x4 lw[2], kx[2], ax[2], rx[2], vx[2], kkc[2], kac[2];
#pragma unroll
        for (int e = 0; e < 2; ++e) { constexpr float LWS = -0.6065306597126334f / 65535.f;
            lw[e] = (f32x4){(float)(nlw[2 * e] & 0xffffu) * LWS, (float)(nlw[2 * e] >> 16) * LWS, (float)(nlw[2 * e + 1] & 0xffffu) * LWS, (float)(nlw[2 * e + 1] >> 16) * LWS};
            kkc[e] = nkk[e]; kac[e] = nka[e];
            kx[e] = (f32x4){__uint_as_float(nkx[2 * e] << 16), __uint_as_float(nkx[2 * e] & 0xffff0000u), __uint_as_float(nkx[2 * e + 1] << 16), __uint_as_float(nkx[2 * e + 1] & 0xffff0000u)};
            ax[e] = (f32x4){__uint_as_float(nax[2 * e] << 16), __uint_as_float(nax[2 * e] & 0xffff0000u), __uint_as_float(nax[2 * e + 1] << 16), __uint_as_float(nax[2 * e + 1] & 0xffff0000u)};
            rx[e] = (f32x4){__uint_as_float(nrx[2 * e] << 16), __uint_as_float(nrx[2 * e] & 0xffff0000u), __uint_as_float(nrx[2 * e + 1] << 16), __uint_as_float(nrx[2 * e + 1] & 0xffff0000u)};
            vx[e] = (f32x4){__uint_as_float(nvx[2 * e] << 16), __uint_as_float(nvx[2 * e] & 0xffff0000u), __uint_as_float(nvx[2 * e + 1] << 16), __uint_as_float(nvx[2 * e + 1] & 0xffff0000u)}; }
        f32x4 rkc[2];
#pragma unroll
        for (int e = 0; e < 2; ++e) rkc[e] = *(const f32x4*)(p.rw_r_k + j * D + h * 64 + cg * 8 + 4 * e);
        if (it + gdim() < 128 * NCHK) SC1_LOAD(it + gdim());
        LBAR();
#pragma unroll
        for (int e = 0; e < 2; ++e) *(LAS f32x4*)(Lbuf + pt * 64 + cg * 8 + 4 * e) = lw[e];
        f32x4 kk[2], bq[2], kd[2];
        { float ss = 0.f;
#pragma unroll
          for (int e = 0; e < 2; ++e) { kk[e] = kx[e] * kkc[e]; ss += kk[e][0] * kk[e][0] + kk[e][1] * kk[e][1] + kk[e][2] * kk[e][2] + kk[e][3] * kk[e][3]; }
          ss = dpp_sum8(ss); const float inv = __builtin_amdgcn_rsqf(fmaxf(ss, 1e-24f));
#pragma unroll
          for (int e = 0; e < 2; ++e) { kk[e] = kk[e] * inv; bq[e] = kk[e] * ax[e]; kd[e] = kx[e] * (1.f + (ax[e] - 1.f) * kac[e]); } }
        LBAR();
        { const int k = tid & 63, sg = tid >> 6; float run = 0.f;
#pragma unroll
          for (int u = 0; u < 8; ++u) { run += Lbuf[(sg * 8 + u) * 64 + k]; Lbuf[(sg * 8 + u) * 64 + k] = run; }
          Lseg[sg * 64 + k] = run; }
        LBAR();
        f32x4 Lt[2], Lp[2], Lc[2];
        { const int sg = pt >> 3, sgp = (pt - 1) >> 3;
#pragma unroll
          for (int e = 0; e < 2; ++e) { f32x4 o0 = {0.f, 0.f, 0.f, 0.f}, o1 = o0, oc = o0;
#pragma unroll
              for (int u = 0; u < 8; ++u) { const f32x4 sv = *(const LAS f32x4*)(Lseg + u * 64 + cg * 8 + 4 * e); if (u < sg) o0 = o0 + sv; if (u < sgp) o1 = o1 + sv; if (u < 7) oc = oc + sv; }
              Lt[e] = *(const LAS f32x4*)(Lbuf + pt * 64 + cg * 8 + 4 * e) + o0;
              Lp[e] = pt > 0 ? *(const LAS f32x4*)(Lbuf + (pt - 1) * 64 + cg * 8 + 4 * e) + o1 : (f32x4){0.f, 0.f, 0.f, 0.f};
              Lc[e] = *(const LAS f32x4*)(Lbuf + 63 * 64 + cg * 8 + 4 * e) + oc; } }
        LBAR();
        {
            float at[8], bt[8], kt[8], rt[8], bh[8], kh[8], vv[8];
#pragma unroll
            for (int e = 0; e < 2; ++e)
#pragma unroll
                for (int u = 0; u < 4; ++u) { const int x = 4 * e + u; const float eL = __expf(Lt[e][u]), emL = __expf(-Lt[e][u]), eP = __expf(Lp[e][u]), eC = __expf(Lc[e][u] - Lt[e][u]);
                    at[x] = -kk[e][u] * eP; bt[x] = bq[e][u] * emL; kt[x] = kd[e][u] * emL; rt[x] = rx[e][u] * eL; bh[x] = bq[e][u] * eC; kh[x] = kd[e][u] * eC; vv[x] = vx[e][u];
                    if (pt == 63) GC[cg * 8 + x] = eL; }
#define ST8(bufi, arr) do { u32x4 w_ = {pk2(arr[0], arr[1]), pk2(arr[2], arr[3]), pk2(arr[4], arr[5]), pk2(arr[6], arr[7])}; *(LAS u32x4*)(BUF(bufi) + (pt * P + cg * 8) * 2) = w_; } while (0)
            ST8(0, at); ST8(1, bt); ST8(2, kt); ST8(3, rt); ST8(8, bh); ST8(9, kh); ST8(10, vv);
#undef ST8
            float bsv = 0.f;
#pragma unroll
            for (int e = 0; e < 2; ++e) bsv += rx[e][0] * kd[e][0] * rkc[e][0] + rx[e][1] * kd[e][1] * rkc[e][1] + rx[e][2] * kd[e][2] * rkc[e][2] + rx[e][3] * kd[e][3] * rkc[e][3];
            bsv = dpp_sum8(bsv);
            if (cg == 0) { const int z_ = seq & 1, b_ = seq >> 5; ((float*)(p.ws + OFF_BS))[((size_t)z_ * NROW + scan_row((it % NCHK) * 64 + pt, b_, z_)) * 16 + h] = bsv; }
        }
        LBAR();
        {
            const int k = tid & 63, tg = tid >> 6;
#define TR8(src, dst) do { unsigned w_[4]; _Pragma("unroll") for (int x = 0; x < 4; ++x) { const unsigned lo = *(const LAS bf16_t*)(BUF(src) + ((tg * 8 + 2 * x) * P + k) * 2), hi2 = *(const LAS bf16_t*)(BUF(src) + ((tg * 8 + 2 * x + 1) * P + k) * 2); w_[x] = lo | (hi2 << 16); } \
                *(LAS u32x4*)(BUF(dst) + (k * P + tg * 8) * 2) = (u32x4){w_[0], w_[1], w_[2], w_[3]}; } while (0)
            TR8(0, 4); TR8(8, 5); TR8(9, 6); TR8(10, 7);
#undef TR8
        }
        LBAR();
        const f32x4 Z4 = {0.f, 0.f, 0.f, 0.f};
        const f32x16 Z16 = {0.f, 0.f, 0.f, 0.f, 0.f, 0.f, 0.f, 0.f, 0.f, 0.f, 0.f, 0.f, 0.f, 0.f, 0.f, 0.f};
        const int r32 = lane & 31, hi = lane >> 5;
#pragma unroll 1
        for (int u = 0; u < 2; ++u) { const int tl = u * 8 + wid;
            if (tl >= 14) {
                if (tl == 14) { st32(BUF(8), 0, 1, r32, hi, Z16); st32(BUF(8), 1, 0, r32, hi, Z16); st32(BUF(14), 0, 1, r32, hi, Z16); st32(BUF(14), 1, 0, r32, hi, Z16); st32(BUF(9), 1, 0, r32, hi, Z16); }
                else { st32(BUF(15), 1, 0, r32, hi, Z16); st32(BUF(13), 1, 0, r32, hi, Z16); st32(BUF(10), 1, 0, r32, hi, Z16); st32(BUF(11), 1, 0, r32, hi, Z16); st32(BUF(12), 1, 0, r32, hi, Z16); }
                break; }
            const int m = (tl + 1) / 3, rr = (tl + 1) % 3, ti = rr == 2, tj = m == 0 ? ti : (rr >= 1); const int jj = 32 * tj + r32;
            if (m == 0) { f32x16 v = mm32(BUF(0), BUF(1), ti, tj, r32, hi, Z16), w;
#pragma unroll
                for (int e = 0; e < 16; ++e) { const int ii = 32 * ti + 8 * (e >> 2) + 4 * hi + (e & 3); const bool dg = (ii >> 4) == (jj >> 4);
                    v[e] = (dg && jj < ii) ? v[e] : 0.f; w[e] = v[e] + ((ii == jj) ? 1.f : 0.f); }
                st32(BUF(8), ti, tj, r32, hi, v); st32(BUF(14), ti, tj, r32, hi, w); }
            else if (m == 1) { const f32x16 v = mm32(BUF(1), BUF(0), ti, tj, r32, hi, Z16); f32x16 vd, vo, w;
#pragma unroll
                for (int e = 0; e < 16; ++e) { const int ii = 32 * ti + 8 * (e >> 2) + 4 * hi + (e & 3); const bool dg = (ii >> 4) == (jj >> 4), up = ii < jj;
                    vd[e] = (dg && up) ? v[e] : 0.f; vo[e] = (!dg && up) ? v[e] : 0.f; w[e] = vd[e] + ((ii == jj) ? 1.f : 0.f); }
                st32(BUF(9), ti, tj, r32, hi, vd); st32(BUF(15), ti, tj, r32, hi, vo); st32(BUF(13), ti, tj, r32, hi, w); }
            else if (m == 2) { f32x16 v = mm32(BUF(2), BUF(0), ti, tj, r32, hi, Z16);
#pragma unroll
                for (int e = 0; e < 16; ++e) { const int ii = 32 * ti + 8 * (e >> 2) + 4 * hi + (e & 3); v[e] = ii < jj ? v[e] : 0.f; }
                st32(BUF(10), ti, tj, r32, hi, v); }
            else { f32x16 v = mm32(m == 3 ? BUF(1) : BUF(2), BUF(3), ti, tj, r32, hi, Z16);
#pragma unroll
                for (int e = 0; e < 16; ++e) { const int ii = 32 * ti + 8 * (e >> 2) + 4 * hi + (e & 3); v[e] = ii <= jj ? v[e] : 0.f; }
                st32(m == 3 ? BUF(11) : BUF(12), ti, tj, r32, hi, v); } }
        LBAR();
#define WSYNC() asm volatile("s_waitcnt lgkmcnt(0)" ::: "memory")
        if (wid < 4) {
            const int tt = wid;
#define SQD(sr, st, dr, dt) do { const f32x4 a_ = mm_diag(BUF(st), BUF(sr), tt, c, q, Z4), b_ = mm_diag(BUF(sr), BUF(st), tt, c, q, Z4); WSYNC(); \
                st_tile(BUF(dr), tt, tt, c, q, a_); st_tile(BUF(dt), tt, tt, c, q, b_); WSYNC(); } while (0)
#define UPD(pr) do { const f32x4 dt_ = mm_diag(BUF(pr), BUF(13), tt, c, q, ld_tile(BUF(13), tt, tt, c, q)); \
                const f32x4 dr_ = mm_diag(BUF(13), BUF(pr), tt, c, q, ld_tile(BUF(14), tt, tt, c, q)); WSYNC(); \
                st_tile(BUF(13), tt, tt, c, q, dt_); st_tile(BUF(14), tt, tt, c, q, dr_); WSYNC(); } while (0)
#define UPSQ(sr, st, dr, dt) do { const f32x4 dt_ = mm_diag(BUF(sr), BUF(13), tt, c, q, ld_tile(BUF(13), tt, tt, c, q)); \
                const f32x4 dr_ = mm_diag(BUF(13), BUF(sr), tt, c, q, ld_tile(BUF(14), tt, tt, c, q)); \
                const f32x4 a_ = mm_diag(BUF(st), BUF(sr), tt, c, q, Z4), b_ = mm_diag(BUF(sr), BUF(st), tt, c, q, Z4); WSYNC(); \
                st_tile(BUF(13), tt, tt, c, q, dt_); st_tile(BUF(14), tt, tt, c, q, dr_); st_tile(BUF(dr), tt, tt, c, q, a_); st_tile(BUF(dt), tt, tt, c, q, b_); WSYNC(); } while (0)
            SQD(8, 9, 0, 1); UPSQ(0, 1, 8, 9); UPSQ(8, 9, 0, 1); UPD(0);
#undef UPSQ
#undef SQD
#undef UPD
        } else {
            const int ti = (wid >> 1) & 1, tj = wid & 1; st32(BUF(2), ti, tj, r32, hi, mm32(BUF(10), BUF(7), ti, tj, r32, hi, Z16));
        }
        LBAR();
        { const int m = wid >> 2, ti = (wid >> 1) & 1, tj = wid & 1;
          if (m == 0) st32(BUF(8), ti, tj, r32, hi, mm32(BUF(15), BUF(14), ti, tj, r32, hi, Z16));
          else        st32(BUF(9), ti, tj, r32, hi, mm32(BUF(14), BUF(15), ti, tj, r32, hi, Z16)); }
        LBAR();
        { const int ti = (wid >> 1) & 1, tj = wid & 1;
          if (wid < 4) st32(BUF(0), ti, tj, r32, hi, mm32(BUF(9), BUF(8), ti, tj, r32, hi, Z16));
          else         st32(BUF(1), ti, tj, r32, hi, mm32(BUF(8), BUF(13), ti, tj, r32, hi, ld32(BUF(13), ti, tj, r32, hi))); }
        LBAR();
        if (wid < 4) { const int ti = (wid >> 1) & 1, tj = wid & 1; st32(BUF(14), ti, tj, r32, hi, mm32(BUF(0), BUF(1), ti, tj, r32, hi, ld32(BUF(1), ti, tj, r32, hi))); }
        LBAR();
        { const int m = wid >> 2, ti = (wid >> 1) & 1, tj = wid & 1;
          if (m == 0) st32(BUF(8), ti, tj, r32, hi, mm32(BUF(14), BUF(4), ti, tj, r32, hi, Z16));
          else        st32(BUF(0), ti, tj, r32, hi, mm32(BUF(14), BUF(2), ti, tj, r32, hi, Z16)); }
        LBAR();
        bf16_t* ckp = CK + (size_t)it * 4 * 4096;
#pragma unroll 1
        for (int u = 0; u < 2; ++u) { const int tl = u * 8 + wid, m = tl >> 2, ti = (tl >> 1) & 1, tj = tl & 1;
            if (m == 0) { f32x16 v = mm32(BUF(8), BUF(5), ti, tj, r32, hi, Z16); const int jj = 32 * tj + r32; const float gc = GC[jj];
#pragma unroll
                for (int e = 0; e < 16; ++e) { const int ii = 32 * ti + 8 * (e >> 2) + 4 * hi + (e & 3); v[e] += (ii == jj) ? gc : 0.f; }
                st32(BUF(1), ti, tj, r32, hi, v); }
            else if (m == 1) st32(BUF(4), ti, tj, r32, hi, mm32(BUF(8), BUF(11), ti, tj, r32, hi, ld32(BUF(3), ti, tj, r32, hi)));
            else if (m == 2) st32(BUF(2), ti, tj, r32, hi, mm32(BUF(6), BUF(7), ti, tj, r32, hi, mm32(BUF(5), BUF(0), ti, tj, r32, hi, Z16)));
            else             st32(BUF(9), ti, tj, r32, hi, mm32(BUF(7), BUF(12), ti, tj, r32, hi, mm32(BUF(0), BUF(11), ti, tj, r32, hi, Z16))); }
        LBAR();
        { const int orow = tid >> 3, oc = (tid & 7) * 8;
          *(u32x4*)(ckp + orow * 64 + oc) = *(const LAS u32x4*)(BUF(1) + (orow * P + oc) * 2);
          *(u32x4*)(ckp + 4096 + orow * 64 + oc) = *(const LAS u32x4*)(BUF(2) + (orow * P + oc) * 2);
          *(u32x4*)(ckp + 2 * 4096 + orow * 64 + oc) = *(const LAS u32x4*)(BUF(4) + (orow * P + oc) * 2);
          *(u32x4*)(ckp + 3 * 4096 + orow * 64 + oc) = *(const LAS u32x4*)(BUF(9) + (orow * P + oc) * 2); }
    }
#undef BUF
#undef SC1_LOAD
}

__device__ void ph_rw_sc2(const Params& p, char* lds) {
    using namespace ck;
    const int tid = tidx(), wid = __builtin_amdgcn_readfirstlane(tid >> 6), lane = tid & 63, c = lane & 15, q = lane >> 4;
    const size_t PL = (size_t)NROW * D;
    const bf16_t* CK = (const bf16_t*)(p.ws + OFF_CK); bf16_t* Y = (bf16_t*)(p.ws + OFF_Y);
    lchar* GB = (lchar*)lds;
    lchar* RB = GB + 2 * MB;
    lchar* SB = GB + 4 * MB;
    constexpr int SBB = 32 * P * 2;
    for (int it = bidx(); it < 256; it += gdim()) {
        const int vh = it & 1, seq = it >> 1, z = seq & 1, h = (seq >> 1) & 15, b = seq >> 5;
        const bf16_t* ck0 = CK + (size_t)seq * NCHK * 4 * 4096;
        const int s_ti = wid & 3, s_tj = wid >> 2;
        const int y_ti = wid & 1, y_tj = wid >> 1;
        const int hoff = 4096 + (vh * 32 + 16 * s_tj + c) * 64 + 16 * s_ti + 4 * q, yoff = 3 * 4096 + (16 * y_tj + c) * 64 + vh * 32 + 16 * y_ti + 4 * q;
        struct PF { u32x4 g, r; uint2 h, y; };
#define PF_LOAD(X, k) do { const bf16_t* cc_ = ck0 + (size_t)(k) * 4 * 4096; X.h = *(const uint2*)(cc_ + hoff); X.y = *(const uint2*)(cc_ + yoff); X.g = *(const u32x4*)(cc_ + tid * 8); X.r = *(const u32x4*)(cc_ + 2 * 4096 + tid * 8); } while (0)
#define PF_STAGE(X, bufi) do { *(LAS u32x4*)(GB + (bufi) * MB + ((tid >> 3) * P + (tid & 7) * 8) * 2) = X.g; *(LAS u32x4*)(RB + (bufi) * MB + ((tid >> 3) * P + (tid & 7) * 8) * 2) = X.r; } while (0)
#define SC2_STEP(k, CUR, NXT) do { const uint2 hi_ = CUR.h, yi_ = CUR.y; const int cur = (k) & 1; \
            if ((k) + 4 < NCHK) PF_LOAD(CUR, (k) + 4); \
            const f32x4 hinit = {__uint_as_float(hi_.x << 16), __uint_as_float(hi_.x & 0xffff0000u), __uint_as_float(hi_.y << 16), __uint_as_float(hi_.y & 0xffff0000u)}; \
            const f32x4 yinit = {__uint_as_float(yi_.x << 16), __uint_as_float(yi_.x & 0xffff0000u), __uint_as_float(yi_.y << 16), __uint_as_float(yi_.y & 0xffff0000u)}; \
            const lchar* Sold = SB + cur * SBB; lchar* Snew = SB + (cur ^ 1) * SBB; \
            const f32x4 sn = mm_tile(GB + cur * MB, Sold, s_ti, s_tj, c, q, hinit);        \
            const f32x4 yv = mm_tile(Sold, RB + cur * MB, y_ti, y_tj, c, q, yinit);        \
            st_tile(Snew, s_ti, s_tj, c, q, sn); \
            { const int row = scan_row((k) * 64 + 16 * y_tj + c, b, z); stbf4(Y + z * PL + (size_t)row * D + h * 64 + vh * 32 + 16 * y_ti + 4 * q, yv); } \
            if ((k) + 1 < NCHK) PF_STAGE(NXT, cur ^ 1); \
            LBAR(); } while (0)
        PF s0, s1, s2, s3;
        PF_LOAD(s0, 0); PF_LOAD(s1, 1); PF_LOAD(s2, 2); PF_LOAD(s3, 3);
        LBAR();
        for (int i = tid; i < SBB / 4; i += NTHR) ((LAS unsigned*)SB)[i] = 0u;
        PF_STAGE(s0, 0);
        LBAR();
        for (int ch = 0; ch < NCHK; ch += 4) {
            SC2_STEP(ch, s0, s1); SC2_STEP(ch + 1, s1, s2); SC2_STEP(ch + 2, s2, s3); SC2_STEP(ch + 3, s3, s0);
        }
#undef PF_LOAD
#undef PF_STAGE
#undef SC2_STEP
    }
}
#undef LBAR

__device__ void ph_rw_out(const Params& p, int j, int nrows) {
    const int wid = tidx() >> 6, lane = tidx() & 63;
    const bf16_t* RKV = (const bf16_t*)(p.ws + OFF_RKV); const bf16_t* AV = (const bf16_t*)(p.ws + OFF_AV); const bf16_t* G = (const bf16_t*)(p.ws + OFF_G); const bf16_t* Y = (const bf16_t*)(p.ws + OFF_Y);
    bf16_t* OUT = (bf16_t*)(p.ws + OFF_H);
    const size_t PL = (size_t)NROW * D;
    const float* lg = p.rw_lnx_g + j * D; const float* lb = p.rw_lnx_b + j * D; const float* BS = (const float*)(p.ws + OFF_BS);
    uint2 nb[4][4]; float nbs[2][4];
#define OUT_LOAD(R) do { _Pragma("unroll") for (int i = 0; i < 4; ++i) { const size_t o_ = (size_t)(R) * D + lane * 4 + i * 256; \
        nb[0][i] = *(const uint2*)(Y + o_); nb[1][i] = *(const uint2*)(Y + PL + o_); nb[2][i] = *(const uint2*)(RKV + 2 * PL + o_); nb[3][i] = *(const uint2*)(G + o_); \
        nbs[0][i] = BS[(size_t)(R) * 16 + (lane >> 4) + 4 * i]; nbs[1][i] = BS[((size_t)NROW + (R)) * 16 + (lane >> 4) + 4 * i]; } } while (0)
#define UNPK(w) ((f32x4){__uint_as_float((w).x << 16), __uint_as_float((w).x & 0xffff0000u), __uint_as_float((w).y << 16), __uint_as_float((w).y & 0xffff0000u)})
    int row = bidx() * 8 + wid;
    if (row < nrows) OUT_LOAD(row);
    for (; row < nrows; row += gdim() * 8) {
        uint2 cb[4][4]; float cbs[4];
#pragma unroll
        for (int i = 0; i < 4; ++i) { cbs[i] = nbs[0][i] + nbs[1][i];
#pragma unroll
            for (int q_ = 0; q_ < 4; ++q_) cb[q_][i] = nb[q_][i]; }
        { const int nrow = row + gdim() * 8; if (nrow < nrows) OUT_LOAD(nrow); }
#pragma unroll
        for (int i = 0; i < 4; ++i) {
            const size_t o = (size_t)row * D + lane * 4 + i * 256; const int c = lane * 4 + i * 256;
            const f32x4 y = UNPK(cb[0][i]) + UNPK(cb[1][i]);
            const float mean = dpp_sum16(y[0] + y[1] + y[2] + y[3]) * (1.f / 64.f);
            const f32x4 dd = y - mean;
            const float rstd = rsqrtf(dpp_sum16(dd[0] * dd[0] + dd[1] * dd[1] + dd[2] * dd[2] + dd[3] * dd[3]) * (1.f / 64.f) + LNX_EPS);
            const f32x4 v = UNPK(cb[2][i]);
            const f32x4 res = (dd * rstd * *(const f32x4*)(lg + c) + *(const f32x4*)(lb + c) + cbs[i] * v) * UNPK(cb[3][i]);
            uint2 w; w.x = pk2(res[0], res[1]); w.y = pk2(res[2], res[3]); *(uint2*)(OUT + o) = w;
        }
    }
#undef OUT_LOAD
#undef UNPK
}

__device__ void ph_final(const Params& p) {
    const int wid = tidx() >> 6, lane = tidx() & 63;
    const float* X = (const float*)(p.ws + OFF_X);
    for (int row = bidx() * 8 + wid; row < NLAT; row += gdim() * 8) {
        const float4* xr = (const float4*)(X + (size_t)row * D);
        float4 v[4]; float ss = 0;
#pragma unroll
        for (int i = 0; i < 4; ++i) { v[i] = xr[lane + i * 64]; ss += v[i].x * v[i].x + v[i].y * v[i].y + v[i].z * v[i].z + v[i].w * v[i].w; }
        ss = wave_sum(ss); const float rs = rsqrtf(ss * (1.f / D) + RMS_EPS);
#pragma unroll
        for (int i = 0; i < 4; ++i) { const int d = (lane + i * 64) * 4; const float4 gg = *(const float4*)(p.final_g + d);
            float4 o; o.x = v[i].x * rs * gg.x; o.y = v[i].y * rs * gg.y; o.z = v[i].z * rs * gg.z; o.w = v[i].w * rs * gg.w;
            *(float4*)(p.out + (size_t)row * D + d) = o; }
    }
}

enum { PH_INIT = 0, PH_A_NORM, PH_A_Z, PH_A_MID, PH_A_QKV, PH_A_POST, PH_A_ATTN, PH_A_WO,
       PH_R_NORM, PH_R_XS, PH_R_G1, PH_R_G2, PH_R_PREP, PH_R_SCAN, PH_R_OUT, PH_R_WO,
       PH_M_NORM, PH_M_SEL, PH_M_GATHER, PH_M_G1, PH_M_G2, PH_M_COMB, PH_FINAL, PH_M_CVT, PH_R_SC1, PH_R_SC2 };

#ifndef BG_Z
#define BG_Z 4
#define BG_ATTN 2
#define BG_WO 3
#define BG_RG1 6
#define BG_MG1 4
#define BG_MG2 6
#endif
template <int PH>
__device__ __forceinline__ void run_phase(const Params& p, int layer, char* lds) {
    const int j = layer >> 1;
    char* ws = p.ws;
    if constexpr (PH == PH_INIT) { ph_init(p, lds); __syncthreads(); ph_small_cvt(p, lds); }
    else if constexpr (PH == PH_A_NORM) { if (layer == 0) ph_norm_mod<false>(p, layer, p.norm1_g + layer * D, 0, 1, ws + OFF_H); else ph_comb_norm<false>(p, layer - 1, layer, NROW); }
    else if constexpr (PH == PH_A_Z) {
        bf16_t* Z = (bf16_t*)(ws + OFF_Z);
        g8::BatchSched S{ws + OFF_H, ws + OFF_WMLA + j * SZ_WMLA + WM_IN, 0, 0, NROW / 256, 2, 1, D};
        g8::gemm_phase(p.wv, (PG8_LAS unsigned char*)lds, D, S, g8::epi_rc([=](const g8::Unit&, int row, int col, f32x4 v) { stbf4(Z + (size_t)row * 512 + col, v); }));
        if (idle_tail(NROW / 256 * 2)) bg_cvt(p, layer, lds, BG_Z);
    }
    else if constexpr (PH == PH_A_MID) ph_mla_mid(p, j);
    else if constexpr (PH == PH_A_QKV) {
        bf16_t* Q = (bf16_t*)(ws + OFF_Q); bf16_t* K = (bf16_t*)(ws + OFF_K); bf16_t* V = (bf16_t*)(ws + OFF_V);
        g8::BatchSched S1{ws + OFF_CQN, ws + OFF_WMLA + j * SZ_WMLA + WM_UQ, 0, 0, NROW / 256, 6, 1, 256, 1};
        g8::gemm_phase(p.wv, (PG8_LAS unsigned char*)lds, 256, S1, g8::epi_rc([=](const g8::Unit&, int row, int col, f32x4 v) {
            const bool lat = row < NLAT; const int b = lat ? (row >> 12) : ((row - NLAT) >> 8); const int tk = lat ? 256 + (row & (TL - 1)) : ((row - NLAT) & 255);
            const int h = col / 192, d = col - h * 192;
            uint2 w; w.x = pk2(v[0], v[1]); w.y = pk2(v[2], v[3]);
            *(uint2*)(Q + ((size_t)(b * 8 + h) * TK + tk) * 192 + d) = w; }));
        g8::BatchSched S2{ws + OFF_CKVN, ws + OFF_WMLA + j * SZ_WMLA + WM_UKV, 0, 0, NROW / 256, 8, 1, 128};
        g8::gemm_phase(p.wv, (PG8_LAS unsigned char*)lds, 128, S2, g8::epi_rc([=](const g8::Unit&, int row, int col, f32x4 v) {
            const bool lat = row < NLAT; const int b = lat ? (row >> 12) : ((row - NLAT) >> 8); const int tk = lat ? 256 + (row & (TL - 1)) : ((row - NLAT) & 255);
            const int h = col >> 8, d = col & 255; const size_t orow = (size_t)(b * 8 + h) * TK + tk;
            uint2 w; w.x = pk2(v[0], v[1]); w.y = pk2(v[2], v[3]);
            if (d < 128) *(uint2*)(K + orow * 192 + d) = w; else *(uint2*)(V + orow * 128 + (d - 128)) = w; }));
    }
    else if constexpr (PH == PH_A_ATTN) { ph_attn(p, lds); if (idle_tail(544)) bg_cvt(p, layer, lds, BG_ATTN); }
    else if constexpr (PH == PH_A_WO || PH == PH_R_WO) {
        xt_t* X = (xt_t*)(ws + OFF_X); const float* MOD = (const float*)(ws + OFF_MOD);
        g8::BatchSched S{ws + (PH == PH_A_WO ? OFF_O : OFF_H), PH == PH_A_WO ? ws + OFF_WMLA + j * SZ_WMLA + WM_O : ws + OFF_WRW + j * SZ_WRW + WR_O, 0, 0, (layer < 3 ? NROW : NLAT) / 256, 4, 1, D};
        g8::gemm_phase(p.wv, (PG8_LAS unsigned char*)lds, D, S, g8::EpiResid{X, MOD, layer});
        if (idle_tail((layer < 3 ? NROW : NLAT) / 256 * 4)) bg_cvt(p, layer, lds, BG_WO);
    }
    else if constexpr (PH == PH_R_XS) ph_rw_normxs(p, layer, j);
    else if constexpr (PH == PH_R_G1) {
        bf16_t* RKV = (bf16_t*)(ws + OFF_RKV); bf16_t* VF = (bf16_t*)(ws + OFF_VFIRST);
        bf16_t* A2 = (bf16_t*)(ws + OFF_A2); bf16_t* A3 = (bf16_t*)(ws + OFF_A3);
        const bool first = (j == 0);
        struct RSched { const char* XS; const char* WB; int nwg;
            __device__ __forceinline__ bool next(int i, g8::Unit& u) const {
                const int L = i * gdim() + bidx(); if (L >= nwg) return false;
                const int w = g8::xcd_remap(L, nwg);
                if (w < 816) { u.g = w / 272; const int r = w % 272; u.pm = r >> 2; u.pn = r & 3; u.B = WB + WR_RKV + (size_t)u.g * D * D * 2 + (size_t)u.pn * 256 * D * 2; }
                else { u.g = 3 + (w - 816) / 68; u.pm = (w - 816) % 68; u.pn = 0; u.B = WB + WR_L + (size_t)(u.g - 3) * 256 * D * 2; }
                u.A = XS + (size_t)(u.g == 6 ? 2 : u.g) * NROW * D * 2 + (size_t)u.pm * 256 * D * 2; return true; } };
        RSched S{ws + OFF_XS, ws + OFF_WRW + j * SZ_WRW, first ? 816 + 204 : 816 + 272};
        g8::gemm_phase(p.wv, (PG8_LAS unsigned char*)lds, D, S, g8::epi_rc([=](const g8::Unit& u, int row, int col, f32x4 v) {
            if (u.g < 3) { stbf4(RKV + ((size_t)u.g * NROW + row) * D + col, v); if (first && u.g == 2) stbf4(VF + (size_t)row * D + col, v); }
            else if (col < 128) {
                f32x4 t = v;
                if (u.g == 3) { for (int e = 0; e < 4; ++e) t[e] = 1.f - 2.f * __builtin_amdgcn_rcpf(1.f + __expf(2.f * v[e])); }
                else if (u.g == 5) { for (int e = 0; e < 4; ++e) t[e] = sigmoidf_(v[e]); }
                bf16_t* dst = (u.g == 3 ? A2 : u.g == 4 ? A2 + (size_t)NROW * 128 : u.g == 5 ? A3 : A3 + (size_t)NROW * 128);
                stbf4(dst + (size_t)row * 128 + col, t); } }));
        if (idle_tail(S.nwg)) bg_cvt(p, layer, lds, BG_RG1);
    }
    else if constexpr (PH == PH_R_G2) {
        const bool first = (j == 0);
        unsigned short* W = (unsigned short*)(ws + OFF_W); bf16_t* AV = (bf16_t*)(ws + OFF_AV); bf16_t* G = (bf16_t*)(ws + OFF_G); bf16_t* RKV = (bf16_t*)(ws + OFF_RKV); const bf16_t* VF = (const bf16_t*)(ws + OFF_VFIRST);
        const float* w0 = p.rw_w0 + (size_t)j * 2 * D; const float* a0 = p.rw_a0 + (size_t)j * 2 * D; const float* v0 = p.rw_v0;
        g8::BatchSched S1{ws + OFF_A2, ws + OFF_WRW + j * SZ_WRW + WR_B2, (size_t)NROW * 128 * 2, (size_t)2048 * 128 * 2, NROW / 256, 8, 2, 128};
        g8::gemm_phase(p.wv, (PG8_LAS unsigned char*)lds, 128, S1, g8::epi_colfirst([=](const g8::Unit& u, int row, int col, f32x4 v, f32x4 bias) {
            const int zz = u.pn >> 2, c = col & 1023; const bool dec = u.g == 0;
            const size_t doff = (size_t)zz * NROW * D + (size_t)row * D + c;
            const f32x4 x = v + bias; f32x4 o;
#pragma unroll
            for (int e = 0; e < 4; ++e) o[e] = __builtin_amdgcn_rcpf(1.f + __expf(-x[e]));
            if (dec) { uint2 w; w.x = (unsigned)(o[0] * 65535.f + 0.5f) | ((unsigned)(o[1] * 65535.f + 0.5f) << 16); w.y = (unsigned)(o[2] * 65535.f + 0.5f) | ((unsigned)(o[3] * 65535.f + 0.5f) << 16); *(uint2*)(W + doff) = w; }
            else stbf4(AV + doff, o); },
            [=](const g8::Unit& u, int col) { const int zz = u.pn >> 2, c = col & 1023; return *(const f32x4*)((u.g == 0 ? w0 : a0) + zz * D + c); }));
        g8::BatchSched S2{ws + OFF_A3, ws + OFF_WRW + j * SZ_WRW + WR_B3, (size_t)NROW * 128 * 2, (size_t)1024 * 128 * 2, NROW / 256, 4, first ? 1 : 2, 128, 1};
        g8::gemm_phase(p.wv, (PG8_LAS unsigned char*)lds, 128, S2, g8::epi_rc([=](const g8::Unit& u, int row, int col, f32x4 v) {
            if (u.g == 0) stbf4(G + (size_t)row * D + col, v);
            else { const size_t o = (size_t)row * D + col; const f32x4 vv = ldbf4(RKV + (size_t)2 * NROW * D + o), vf = ldbf4(VF + o), gz = v + *(const f32x4*)(v0 + col); f32x4 r;
#pragma unroll
                for (int e = 0; e < 4; ++e) r[e] = vv[e] + (vf[e] - vv[e]) * __builtin_amdgcn_rcpf(1.f + __expf(-gz[e]));
                stbf4(RKV + (size_t)2 * NROW * D + o, r); } }));
    }
    else if constexpr (PH == PH_R_SCAN) ph_rw_scan(p, j, lds);
    else if constexpr (PH == PH_R_SC1) ph_rw_sc1(p, j, lds);
    else if constexpr (PH == PH_R_SC2) ph_rw_sc2(p, lds);
    else if constexpr (PH == PH_R_OUT) ph_rw_out(p, j, layer < 3 ? NROW : NLAT);
    else if constexpr (PH == PH_M_NORM) ph_norm2_router_mm(p, layer, lds, layer < 3 ? NROW : NLAT);
    else if constexpr (PH == PH_M_SEL) { ph_select(p, lds, layer < 3 ? 128 : 64); __syncthreads(); moe_cvt(p, layer, lds, -1); }
    else if constexpr (PH == PH_M_GATHER) ph_gather(p, layer < 3 ? ESLOTS : NB * CAPL);
    else if constexpr (PH == PH_M_G1) {
        bf16_t* HID = (bf16_t*)(ws + OFF_HID);
        struct GSched { const char* H; const char* B; const int* ROWIDX; int nM, nval;
            __device__ __forceinline__ bool next(int i, g8::Unit& u) const {
                const int nwg = nM * 11 * NE; const int L = i * gdim() + bidx(); if (L >= nwg) return false;
                const int w = g8::xcd_remap(L, nwg); const int per = nM * 11; u.g = w / per; const int r = w % per; u.pm = r / 11; u.pn = r % 11;
                u.A = H; u.B = B + (size_t)u.g * 2816 * D * 2 + (size_t)u.pn * g8::BM * D * 2; return true; }
            __device__ __forceinline__ const int* rows(const g8::Unit& u) const { return ROWIDX + u.g * ESLOTS + u.pm * g8::BM; }
            __device__ __forceinline__ int nvalid(const g8::Unit& u) const { return nval - u.pm * g8::BM; } };
        GSched S{ws + OFF_H, ws + OFF_W13T + (size_t)(layer & 1) * SZ_WMOE, (const int*)(ws + OFF_ROWIDX), layer < 3 ? 9 : 8, layer < 3 ? ESLOTS : NB * CAPL};
        g8::gemm_phase<true>(p.wv, (PG8_LAS unsigned char*)lds, D, S, g8::epi_pair([=](const g8::Unit& u, int row, int col, f32x4 a, f32x4 b) {
            uint2 w; w.x = pk2(a[0] * __builtin_amdgcn_rcpf(1.f + __expf(-a[0])) * b[0], a[1] * __builtin_amdgcn_rcpf(1.f + __expf(-a[1])) * b[1]); w.y = pk2(a[2] * __builtin_amdgcn_rcpf(1.f + __expf(-a[2])) * b[2], a[3] * __builtin_amdgcn_rcpf(1.f + __expf(-a[3])) * b[3]);
            *(uint2*)(HID + ((size_t)u.g * EPAD + row) * FF + col) = w; }));
        if (layer < 3 && idle_tail(9 * 11 * NE)) moe_cvt(p, layer + 1, lds, BG_MG1);
    }
    else if constexpr (PH == PH_M_G2) {
        bf16_t* YE = (bf16_t*)(ws + OFF_YE); const float* GATE = (const float*)(ws + OFF_GATE);
        g8::BatchSched S{ws + OFF_HID, ws + OFF_W2T + (size_t)(layer & 1) * SZ_WMOE, (size_t)EPAD * FF * 2, (size_t)D * FF * 2, layer < 3 ? 9 : 8, 4, NE, FF};
        g8::gemm_phase(p.wv, (PG8_LAS unsigned char*)lds, FF, S, g8::epi_pre([=](const g8::Unit& u, int row, int col, f32x4 v, f32x4, float gt) {
            uint2 w; w.x = pk2(v[0] * gt, v[1] * gt); w.y = pk2(v[2] * gt, v[3] * gt);
            *(uint2*)(YE + ((size_t)u.g * EPAD + row) * D + col) = w; },
            [=](const g8::Unit&, int) { return (f32x4){0.f, 0.f, 0.f, 0.f}; }, [=](const g8::Unit& u, int row) { return GATE[u.g * EPAD + row]; }));
        if (layer < 3 && idle_tail(9 * 4 * NE)) moe_cvt(p, layer + 1, lds, BG_MG2);
    }
    else if constexpr (PH == PH_M_COMB) ph_combine(p, layer, layer < 3 ? NROW : NLAT);
    else if constexpr (PH == PH_M_CVT) moe_cvt(p, layer, lds, -1);
    else if constexpr (PH == PH_FINAL) ph_comb_norm<true>(p, 3, 0, NLAT);
}

#if ONE_LAUNCH
#define SYNC() xcd_barrier(bar)
#ifndef PROBE_PH
#define PROBE_PH -1
#endif
#ifndef PROBE_REP
#define PROBE_REP 1
#endif
__device__ __forceinline__ Params load_params() {
    Params q{};
#if defined(__HIP_DEVICE_COMPILE__)
    typedef const __attribute__((address_space(4))) unsigned long long* KargP;
    KargP kp_ = (KargP)__builtin_amdgcn_kernarg_segment_ptr(); asm volatile("" : "+s"(kp_));
#pragma unroll
    for (int i = 0; i < 40; ++i) ((const float**)&q)[i] = (const float*)(const __attribute__((address_space(1))) float*)kp_[i];
#endif
    return q;
}
#define RUN(PH) do { for (int rep_ = 0; rep_ < ((PH) == PROBE_PH ? PROBE_REP : 1); ++rep_) { Params q = load_params(); q.wv = wv0_; run_phase<PH>(q, layer, smem); SYNC(); } } while (0)
__global__ void __launch_bounds__(NTHR, 2) mega(Params p) {
    extern __shared__ __attribute__((aligned(16))) char smem[];
    const int wv0_ = __builtin_amdgcn_readfirstlane((int)threadIdx.x >> 6);
    if (threadIdx.x == 0) *(uint4*)(smem + LDS_BYTES) = make_uint4(0u, 0u, 0u, 0u);
    __syncthreads();
    XcdBarrier bar = xcd_barrier_post((unsigned*)(p.ws + OFF_BAR), (volatile LAS unsigned*)(smem + LDS_BYTES));
    { const int layer = 0; RUN(PH_INIT); }
    for (int layer = 0; layer < 4; ++layer) {
        if ((layer & 1) == 0) {
            RUN(PH_A_NORM);
            RUN(PH_A_Z);
            RUN(PH_A_MID);
            RUN(PH_A_QKV);
            RUN(PH_A_ATTN);
            RUN(PH_A_WO);
        } else {
            RUN(PH_R_XS);
            RUN(PH_R_G1);
            RUN(PH_R_G2);
            RUN(PH_R_SC1);
            RUN(PH_R_SC2);
            RUN(PH_R_OUT);
            RUN(PH_R_WO);
        }
        RUN(PH_M_NORM);
        RUN(PH_M_SEL);
        RUN(PH_M_G1);
        RUN(PH_M_G2);
        if ((layer & 1) == 0) RUN(PH_M_COMB);
    }
    { Params q = load_params(); q.wv = wv0_; run_phase<PH_FINAL>(q, 0, smem); }
}
#else
template <int PH> __global__ void __launch_bounds__(NTHR, 2) kph(Params p, int layer) {
    extern __shared__ __attribute__((aligned(16))) char smem[];
    Params q = p; q.wv = __builtin_amdgcn_readfirstlane((int)threadIdx.x >> 6);
    run_phase<PH>(q, layer, smem);
}
#endif

extern "C" void kernel_launch(void* const* d_in, const int* in_sizes, int n_in, void* d_out, int out_size, void* d_ws, size_t ws_size, hipStream_t stream) {
    if (n_in != 38 || ws_size < WS_NEED) { fprintf(stderr, "kernel_launch: bad args n_in %d ws %zu need %zu\n", n_in, ws_size, (size_t)WS_NEED); return; }
    Params p{};
    const float** pp = (const float**)&p;
    for (int i = 0; i < 38; ++i) pp[i] = (const float*)d_in[i];
    p.out = (float*)d_out; p.ws = (char*)d_ws;
    static int cus = 0;
    if (!cus) { int dev = 0; hipGetDevice(&dev); hipDeviceGetAttribute(&cus, hipDeviceAttributeMultiprocessorCount, dev); if (cus <= 0) cus = 256; }
    const int grid = cus;
#if ONE_LAUNCH
    hipFuncSetAttribute((const void*)mega, hipFuncAttributeMaxDynamicSharedMemorySize, LDS_BYTES + 16);
    hipMemsetAsync(d_ws, 0, 16384, stream);
    hipLaunchKernelGGL(mega, dim3(grid), dim3(NTHR), LDS_BYTES + 16, stream, p);
#else
    hipMemsetAsync(d_ws, 0, 16384, stream);
#define LAUNCH(PH, L) do { hipFuncSetAttribute((const void*)kph<PH>, hipFuncAttributeMaxDynamicSharedMemorySize, LDS_BYTES + 16); hipLaunchKernelGGL(kph<PH>, dim3(grid), dim3(NTHR), LDS_BYTES + 16, stream, p, L); } while (0)
    LAUNCH(PH_INIT, 0);
    for (int layer = 0; layer < 4; ++layer) {
        if ((layer & 1) == 0) { LAUNCH(PH_A_NORM, layer); LAUNCH(PH_A_Z, layer); LAUNCH(PH_A_MID, layer); LAUNCH(PH_A_QKV, layer); LAUNCH(PH_A_ATTN, layer); LAUNCH(PH_A_WO, layer); }
        else { LAUNCH(PH_R_XS, layer); LAUNCH(PH_R_G1, layer); LAUNCH(PH_R_G2, layer); LAUNCH(PH_R_SC1, layer); LAUNCH(PH_R_SC2, layer); LAUNCH(PH_R_OUT, layer); LAUNCH(PH_R_WO, layer); }
        LAUNCH(PH_M_NORM, layer); LAUNCH(PH_M_SEL, layer); LAUNCH(PH_M_G1, layer); LAUNCH(PH_M_G2, layer); if ((layer & 1) == 0) LAUNCH(PH_M_COMB, layer);
    }
    LAUNCH(PH_FINAL, 0);
#endif
}
```
